# Optimizing an MI355X kernel written in HIP

```python
import numpy as np
import jax
import jax.numpy as jnp
from jax import lax

D_MODEL = 1024
BATCH = 8
SEQ = 2048
DEPTH = 4

N_MEM = 256
EPS = 1e-6
ROPE_THETA = 10000.0
QB = 128

NSA_HEADS = 8
NSA_KV = 2
NSA_HPG = NSA_HEADS // NSA_KV
HEAD_DIM = 64
CMP_LEN = 32
CMP_STRIDE = 16
SLC_LEN = 64
SLC_TOPN = 8
WINDOW = 256
FORCE_BONUS = 1000.0

GLA_HEADS = 4
GLA_DK = 64
GLA_DV = 128
GLA_RANK = 16
GLA_TAU = 16.0
GLA_CHUNK = 64

SG_CHUNK = 128
SG_GROUPS = 8
SG_WIDTH = 2 * D_MODEL
SG_GW = SG_WIDTH // SG_GROUPS

X_HEADS = 4
X_HD = D_MODEL // X_HEADS

N_EXPERTS = 16
N_GROUPS = 4
EPG = N_EXPERTS // N_GROUPS
TOP_K = 2
D_EXPERT = 384

N_EVEN = (DEPTH + 1) // 2
N_ODD = DEPTH // 2

NSA_QW = NSA_HEADS * HEAD_DIM
NSA_KVW = NSA_KV * HEAD_DIM
GLA_QKW = GLA_HEADS * GLA_DK
GLA_VW = GLA_HEADS * GLA_DV
HYB_SIZES = (NSA_QW, NSA_KVW, NSA_KVW, NSA_KVW, NSA_KVW, NSA_KVW, NSA_KVW, 3 * NSA_HEADS,
             GLA_QKW, GLA_QKW, GLA_VW, GLA_RANK, GLA_VW)
HYB_IN = sum(HYB_SIZES)
HYB_SPLITS = tuple(int(s) for s in np.cumsum(HYB_SIZES)[:-1])
HYB_OUT = NSA_QW + GLA_VW

kernel_name = 'hybrid_nsa_gla_sgu_xmem_moe'


def rmsnorm(x, g):
    xf = x.astype(jnp.float32)
    y = xf * lax.rsqrt(jnp.mean(xf * xf, axis=-1, keepdims=True) + EPS)
    return (y * g.astype(jnp.float32)).astype(x.dtype)


def layernorm(x, g, b):
    xf = x.astype(jnp.float32)
    xc = xf - jnp.mean(xf, axis=-1, keepdims=True)
    y = xc * lax.rsqrt(jnp.mean(xc * xc, axis=-1, keepdims=True) + EPS)
    return (y * g.astype(jnp.float32) + b.astype(jnp.float32)).astype(x.dtype)


def rope(x, pos):
    half = x.shape[-1] // 2
    freq = ROPE_THETA ** (-jnp.arange(half, dtype=jnp.float32) / half)
    ang = pos.astype(jnp.float32)[..., None] * freq
    cos = jnp.cos(ang)[:, :, None, :]
    sin = jnp.sin(ang)[:, :, None, :]
    xf = x.astype(jnp.float32)
    x1, x2 = xf[..., :half], xf[..., half:]
    return jnp.concatenate([x1 * cos - x2 * sin, x2 * cos + x1 * sin], axis=-1).astype(x.dtype)


def masked_softmax(s, mask):
    s = jnp.where(mask, s.astype(jnp.float32), -jnp.inf)
    m = jnp.max(s, axis=-1, keepdims=True)
    m = jnp.where(jnp.isfinite(m), m, 0.0)
    p = jnp.exp(s - m)
    return p / jnp.maximum(jnp.sum(p, axis=-1, keepdims=True), 1e-30)


def nsa_mixer(q, k_cmp, v_cmp, k_slc, v_slc, k_win, v_win, gate_logit, positions,
              q_g, k_g, cmp_pe, cmp_w1, cmp_w2, gate_b):
    B, S = q.shape[:2]
    scale = HEAD_DIM ** -0.5
    q = rope(rmsnorm(q.reshape(B, S, NSA_HEADS, HEAD_DIM), q_g), positions)
    q = q.reshape(B, S, NSA_KV, NSA_HPG, HEAD_DIM)
    kvr = lambda t: t.reshape(B, S, NSA_KV, HEAD_DIM)
    t_idx = np.arange(S)
    nqb = S // QB

    n_cmp = (S - CMP_LEN) // CMP_STRIDE + 1
    blk_idx = np.arange(n_cmp)[:, None] * CMP_STRIDE + np.arange(CMP_LEN)[None, :]
    blk_end = blk_idx[:, -1]

    def compress(t, pe, w1, w2):
        blk = kvr(t)[:, blk_idx] + pe[:, None, :]
        blk = blk.transpose(0, 1, 3, 2, 4).reshape(B, n_cmp, NSA_KV, CMP_LEN * HEAD_DIM)
        return jax.nn.gelu(blk @ w1) @ w2

    kc = compress(k_cmp, cmp_pe[0], cmp_w1[0], cmp_w2[0])
    vc = compress(v_cmp, cmp_pe[1], cmp_w1[1], cmp_w2[1])
    kc = rope(rmsnorm(kc, k_g[0]), positions[:, blk_end])
    mask_c = jnp.asarray(blk_end[None, :] <= t_idx[:, None])
    p_c = masked_softmax(jnp.einsum('bsghd,bcgd->bghsc', q, kc) * scale, mask_c)
    o_c = jnp.einsum('bghsc,bcgd->bsghd', p_c.astype(vc.dtype), vc)

    n_slc = S // SLC_LEN
    top_n = min(SLC_TOPN, n_slc)
    cs = np.arange(n_cmp) * CMP_STRIDE
    ss = np.arange(n_slc) * SLC_LEN
    overlap = np.clip(np.minimum(cs[:, None] + CMP_LEN, ss[None, :] + SLC_LEN)
                      - np.maximum(cs[:, None], ss[None, :]), 0, None).astype(np.float32) / CMP_LEN
    imp = jnp.einsum('bghsc,cj->bgsj', p_c, jnp.asarray(overlap))
    cur = (t_idx // SLC_LEN)[:, None]
    jb = np.arange(n_slc)[None, :]
    valid = jnp.asarray(jb <= cur)
    forced = jnp.asarray((jb == 0) | (jb == cur) | (jb == cur - 1))
    score = jnp.where(valid, imp + jnp.where(forced, FORCE_BONUS, 0.0), -jnp.inf)
    top_val, top_idx = lax.top_k(score, top_n)
    top_ok = jnp.isfinite(top_val)
    ks = rope(rmsnorm(kvr(k_slc), k_g[1]), positions)
    kb = ks.reshape(B, n_slc, SLC_LEN, NSA_KV, HEAD_DIM).transpose(0, 3, 1, 2, 4)
    vb = kvr(v_slc).reshape(B, n_slc, SLC_LEN, NSA_KV, HEAD_DIM).transpose(0, 3, 1, 2, 4)
    bi = jnp.arange(B)[:, None, None, None]
    gi = jnp.arange(NSA_KV)[None, :, None, None]

    def slc_block(args):
        qb, ib, okb, tb = args
        kg = kb[bi, gi, ib].reshape(B, NSA_KV, QB, top_n * SLC_LEN, HEAD_DIM)
        vg = vb[bi, gi, ib].reshape(B, NSA_KV, QB, top_n * SLC_LEN, HEAD_DIM)
        kpos = ib[..., None] * SLC_LEN + jnp.arange(SLC_LEN)
        m = (okb[..., None] & (kpos <= tb[None, None, :, None, None])).reshape(B, NSA_KV, QB, top_n * SLC_LEN)
        p = masked_softmax(jnp.einsum('bqghd,bgqkd->bgqhk', qb, kg) * scale, m[:, :, :, None, :])
        return jnp.einsum('bgqhk,bgqkd->bqghd', p.astype(vg.dtype), vg)

    q_blk = q.reshape(B, nqb, QB, NSA_KV, NSA_HPG, HEAD_DIM).transpose(1, 0, 2, 3, 4, 5)
    i_blk = top_idx.reshape(B, NSA_KV, nqb, QB, top_n).transpose(2, 0, 1, 3, 4)
    ok_blk = top_ok.reshape(B, NSA_KV, nqb, QB, top_n).transpose(2, 0, 1, 3, 4)
    t_blk = jnp.arange(S, dtype=jnp.int32).reshape(nqb, QB)
    o_s = lax.map(slc_block, (q_blk, i_blk, ok_blk, t_blk))
    o_s = o_s.transpose(1, 0, 2, 3, 4, 5).reshape(B, S, NSA_KV, NSA_HPG, HEAD_DIM)

    nwb = WINDOW // QB
    kwin = (nwb + 1) * QB

    def band(t):
        tp = jnp.pad(t, ((0, 0), (WINDOW, 0), (0, 0), (0, 0))).reshape(B, nqb + nwb, QB, NSA_KV, HEAD_DIM)
        return jnp.concatenate([tp[:, j:j + nqb] for j in range(nwb + 1)], axis=2)

    kw = band(rope(rmsnorm(kvr(k_win), k_g[2]), positions))
    vw = band(kvr(v_win))
    kpos = np.arange(nqb)[:, None, None] * QB - WINDOW + np.arange(kwin)[None, None, :]
    tq = t_idx.reshape(nqb, QB)[:, :, None]
    mask_w = jnp.asarray((kpos >= 0) & (kpos <= tq) & (kpos > tq - WINDOW))
    qw = q.reshape(B, nqb, QB, NSA_KV, NSA_HPG, HEAD_DIM)
    p_w = masked_softmax(jnp.einsum('bnqghd,bnkgd->bnghqk', qw, kw) * scale, mask_w[None, :, None, None])
    o_w = jnp.einsum('bnghqk,bnkgd->bnqghd', p_w.astype(vw.dtype), vw).reshape(B, S, NSA_KV, NSA_HPG, HEAD_DIM)

    g = jax.nn.sigmoid(gate_logit + gate_b).reshape(B, S, NSA_KV, NSA_HPG, 3)
    o = g[..., 0:1] * o_c + g[..., 1:2] * o_s + g[..., 2:3] * o_w
    return o.reshape(B, S, NSA_QW)


def gla_mixer(q, k, v, a_low, r, wa2, ba, o_g):
    B, S = q.shape[:2]
    f32 = jnp.float32
    q = q.reshape(B, S, GLA_HEADS, GLA_DK).astype(f32) * (GLA_DK ** -0.5)
    k = k.reshape(B, S, GLA_HEADS, GLA_DK).astype(f32)
    v = v.reshape(B, S, GLA_HEADS, GLA_DV).astype(f32)
    log_a = (jax.nn.log_sigmoid((a_low @ wa2 + ba).astype(f32)) / GLA_TAU).reshape(B, S, GLA_HEADS, GLA_DK)
    n_ch = S // GLA_CHUNK

    def chunks(t):
        return t.reshape(B, n_ch, GLA_CHUNK, *t.shape[2:]).swapaxes(0, 1)

    tri = jnp.tril(jnp.ones((GLA_CHUNK, GLA_CHUNK), dtype=bool))[None, :, :, None, None]

    def step(state, xs):
        qc, kc, vc, gc = xs
        b = jnp.cumsum(gc, axis=1)
        o_inter = jnp.einsum('bchk,bhkv->bchv', qc * jnp.exp(b), state)
        diff = b[:, :, None] - b[:, None, :]
        decay = jnp.where(tri, jnp.exp(jnp.where(tri, diff, 0.0)), 0.0)
        att = jnp.einsum('bihd,bjhd,bijhd->bhij', qc, kc, decay)
        o_intra = jnp.einsum('bhij,bjhv->bihv', att, vc)
        b_last = b[:, -1]
        state = jnp.exp(b_last)[..., None] * state + jnp.einsum(
            'bjhk,bjhv->bhkv', kc * jnp.exp(b_last[:, None] - b), vc)
        return state, o_inter + o_intra

    state0 = jnp.zeros((B, GLA_HEADS, GLA_DK, GLA_DV), f32)
    _, o = lax.scan(step, state0, (chunks(q), chunks(k), chunks(v), chunks(log_a)))
    o = o.swapaxes(0, 1).reshape(B, S, GLA_HEADS, GLA_DV)
    o = rmsnorm(o, o_g).reshape(B, S, GLA_VW)
    return (o * jax.nn.silu(r.astype(f32))).astype(r.dtype)


def sgu_mixer(h, w_in, ln_g, ln_b, ws, bs, w_out):
    B, S = h.shape[:2]
    z = jax.nn.gelu(h @ w_in)
    u, v = z[..., :SG_WIDTH], z[..., SG_WIDTH:]
    v = layernorm(v, ln_g, ln_b).reshape(B, S // SG_CHUNK, SG_CHUNK, SG_GROUPS, SG_GW)
    w_causal = ws * jnp.tril(jnp.ones((SG_CHUNK, SG_CHUNK), ws.dtype))
    mixed = jnp.einsum('gts,bnsgc->bntgc', w_causal, v) + bs.T[None, None, :, :, None]
    return (u * mixed.reshape(B, S, SG_WIDTH)) @ w_out


def memory_xattn(h, mem, mem_g, wq, wkv, wo, q_g, k_g):
    B, S = h.shape[:2]
    m = rmsnorm(mem, mem_g)
    q = rmsnorm((h @ wq).reshape(B, S, X_HEADS, X_HD), q_g)
    kv = (m @ wkv).reshape(B, m.shape[1], 2, X_HEADS, X_HD)
    k = rmsnorm(kv[:, :, 0], k_g)
    v = kv[:, :, 1]
    s = jnp.einsum('bshd,bmhd->bhsm', q, k).astype(jnp.float32) * (X_HD ** -0.5)
    p = jax.nn.softmax(s, axis=-1).astype(v.dtype)
    o = jnp.einsum('bhsm,bmhd->bshd', p, v).reshape(B, S, X_HEADS * X_HD)
    return o @ wo


def moe_ffn(h, router_w, router_b, w_in, w_out):
    B, S, D = h.shape
    t = h.reshape(B * S, D)
    logits = (t @ router_w).astype(jnp.float32) + router_b.astype(jnp.float32)
    probs = jax.nn.softmax(logits, axis=-1).reshape(B * S, N_GROUPS, EPG)
    g_idx = jnp.argmax(jnp.max(probs, axis=-1), axis=-1)
    g_sel = jax.nn.one_hot(g_idx, N_GROUPS, dtype=jnp.float32)
    in_group = jnp.einsum('tge,tg->te', probs, g_sel)
    top_p, top_e = lax.top_k(in_group, TOP_K)
    top_w = top_p / jnp.sum(top_p, axis=-1, keepdims=True)
    expert = g_idx[:, None] * EPG + top_e
    gates = jnp.sum(jax.nn.one_hot(expert, N_EXPERTS, dtype=jnp.float32) * top_w[..., None], axis=1).astype(t.dtype)
    y = jnp.zeros_like(t)
    for e in range(N_EXPERTS):
        gu = t @ w_in[e]
        act = jax.nn.silu(gu[:, :D_EXPERT]) * gu[:, D_EXPERT:]
        y = y + gates[:, e:e + 1] * (act @ w_out[e])
    return y.reshape(B, S, D)


def setup_inputs(seed: int = 0) -> dict:
    key = jax.random.key(seed)
    keys = iter(jax.random.split(key, 40))

    def nrm(shape, scale):
        return jax.random.normal(next(keys), shape, jnp.float32) * scale

    def gain(shape):
        return 1.0 + 0.02 * jax.random.normal(next(keys), shape, jnp.float32)

    D = D_MODEL
    out_s = (3 * DEPTH) ** -0.5
    x = nrm((BATCH, SEQ, D), 1.0)
    mem = nrm((BATCH, N_MEM, D), 1.0)
    positions = (jax.random.randint(next(keys), (BATCH, 1), 0, 1024, dtype=jnp.int32)
                 + jnp.arange(SEQ, dtype=jnp.int32)[None, :])
    return {
        'x': x,
        'mem': mem,
        'positions': positions,
        'norm_mix': gain((DEPTH, D)),
        'norm_xattn': gain((DEPTH, D)),
        'norm_mem': gain((DEPTH, D)),
        'norm_ffn': gain((DEPTH, D)),
        'hyb_w_in': nrm((N_EVEN, D, HYB_IN), D ** -0.5),
        'hyb_w_out': nrm((N_EVEN, HYB_OUT, D), HYB_OUT ** -0.5 * out_s),
        'nsa_qnorm': gain((N_EVEN, HEAD_DIM)),
        'nsa_knorm': gain((N_EVEN, 3, HEAD_DIM)),
        'nsa_cmp_pe': nrm((N_EVEN, 2, CMP_LEN, HEAD_DIM), 0.2),
        'nsa_cmp_w1': nrm((N_EVEN, 2, CMP_LEN * HEAD_DIM, HEAD_DIM), (CMP_LEN * HEAD_DIM) ** -0.5),
        'nsa_cmp_w2': nrm((N_EVEN, 2, HEAD_DIM, HEAD_DIM), HEAD_DIM ** -0.5),
        'nsa_gate_b': nrm((N_EVEN, 3 * NSA_HEADS), 0.1),
        'gla_wa2': nrm((N_EVEN, GLA_RANK, GLA_QKW), GLA_RANK ** -0.5),
        'gla_ba': nrm((N_EVEN, GLA_QKW), 0.1),
        'gla_onorm': gain((N_EVEN, GLA_DV)),
        'sg_w_in': nrm((N_ODD, D, 2 * SG_WIDTH), D ** -0.5),
        'sg_ln_g': gain((N_ODD, SG_WIDTH)),
        'sg_ln_b': nrm((N_ODD, SG_WIDTH), 0.02),
        'sg_ws': nrm((N_ODD, SG_GROUPS, SG_CHUNK, SG_CHUNK), SG_CHUNK ** -0.5),
        'sg_bs': gain((N_ODD, SG_GROUPS, SG_CHUNK)),
        'sg_w_out': nrm((N_ODD, SG_WIDTH, D), SG_WIDTH ** -0.5 * out_s),
        'x_wq': nrm((DEPTH, D, X_HEADS * X_HD), D ** -0.5),
        'x_wkv': nrm((DEPTH, D, 2 * X_HEADS * X_HD), D ** -0.5),
        'x_wo': nrm((DEPTH, X_HEADS * X_HD, D), (X_HEADS * X_HD) ** -0.5 * out_s),
        'x_qnorm': gain((DEPTH, X_HD)),
        'x_knorm': gain((DEPTH, X_HD)),
        'router_w': nrm((D, N_EXPERTS), D ** -0.5),
        'router_b': nrm((N_EXPERTS,), 0.01),
        'moe_w_in': nrm((DEPTH, N_EXPERTS, D, 2 * D_EXPERT), D ** -0.5),
        'moe_w_out': nrm((DEPTH, N_EXPERTS, D_EXPERT, D), D_EXPERT ** -0.5 * out_s),
    }


def reference(x, mem, positions, norm_mix, norm_xattn, norm_mem, norm_ffn,
              hyb_w_in, hyb_w_out, nsa_qnorm, nsa_knorm, nsa_cmp_pe, nsa_cmp_w1, nsa_cmp_w2,
              nsa_gate_b, gla_wa2, gla_ba, gla_onorm,
              sg_w_in, sg_ln_g, sg_ln_b, sg_ws, sg_bs, sg_w_out,
              x_wq, x_wkv, x_wo, x_qnorm, x_knorm,
              router_w, router_b, moe_w_in, moe_w_out):
    for layer in range(DEPTH):
        i = layer // 2
        h = rmsnorm(x, norm_mix[layer])
        if layer % 2 == 0:
            (q_a, kc, vc, ks, vs, kw, vw, ga,
             q_b, k_b, v_b, a_low, r_b) = jnp.split(h @ hyb_w_in[i], HYB_SPLITS, axis=-1)
            o_a = nsa_mixer(q_a, kc, vc, ks, vs, kw, vw, ga, positions,
                            nsa_qnorm[i], nsa_knorm[i], nsa_cmp_pe[i], nsa_cmp_w1[i], nsa_cmp_w2[i],
                            nsa_gate_b[i])
            o_b = gla_mixer(q_b, k_b, v_b, a_low, r_b, gla_wa2[i], gla_ba[i], gla_onorm[i])
            mix = jnp.concatenate([o_a, o_b], axis=-1) @ hyb_w_out[i]
        else:
            mix = sgu_mixer(h, sg_w_in[i], sg_ln_g[i], sg_ln_b[i], sg_ws[i], sg_bs[i], sg_w_out[i])
        x = x + mix
        x = x + memory_xattn(rmsnorm(x, norm_xattn[layer]), mem, norm_mem[layer],
                             x_wq[layer], x_wkv[layer], x_wo[layer], x_qnorm[layer], x_knorm[layer])
        x = x + moe_ffn(rmsnorm(x, norm_ffn[layer]), router_w, router_b, moe_w_in[layer], moe_w_out[layer])
    return x
```

```cpp
#include <hip/hip_runtime.h>
#include <stdint.h>
#include <stdio.h>
#include <math.h>

#ifndef MK_ONE_LAUNCH
#define MK_ONE_LAUNCH 0
#endif

#define LAS __attribute__((address_space(3)))
typedef unsigned short bf16;
typedef short bf16x8 __attribute__((ext_vector_type(8)));
typedef float f32x4 __attribute__((ext_vector_type(4)));
typedef float f32x2 __attribute__((ext_vector_type(2)));
typedef unsigned u32x4 __attribute__((ext_vector_type(4)));
typedef unsigned u32x2 __attribute__((ext_vector_type(2)));

constexpr int T = 16384, D = 1024, NBATCH = 8, S = 2048, DEPTH = 4;
constexpr int NMEM = 256;
constexpr float EPS = 1e-6f;
constexpr int HYN = 3072, HYSRC = 2856;
constexpr int C_QA = 0, C_KC = 512, C_VC = 640, C_KS = 768, C_VS = 896, C_KW = 1024, C_VW = 1152, C_QB = 1280, C_KB = 1536, C_VB = 1792, C_RB = 2304, C_GA = 2816, C_AL = 2840;
constexpr int NCMP = 127;
constexpr int NEXP = 16, DEXP = 384;
constexpr int SLOTS = 2 * T + NEXP * 256;

enum { I_X = 0, I_MEM, I_POS, I_NMIX, I_NXAT, I_NMEM, I_NFFN, I_HYBIN, I_HYBOUT, I_QNORM, I_KNORM, I_CMPPE, I_CMPW1, I_CMPW2, I_GATEB, I_WA2, I_BA, I_ONORM,
       I_SGIN, I_LNG, I_LNB, I_SGWS, I_SGBS, I_SGOUT, I_XWQ, I_XWKV, I_XWO, I_XQN, I_XKN, I_RW, I_RB, I_MOEIN, I_MOEOUT, N_IN };

constexpr size_t MiB = 1u << 20;
constexpr size_t WS_CTL = 0, CTL_BYTES = 1 * MiB;
constexpr size_t WS_WHYB = 1 * MiB;
constexpr size_t WS_WHOUT = WS_WHYB + 12 * MiB;
constexpr size_t WS_WSGIN = WS_WHOUT + 4 * MiB;
constexpr size_t WS_WSGOUT = WS_WSGIN + 16 * MiB;
constexpr size_t WS_WQ = WS_WSGOUT + 8 * MiB;
constexpr size_t WS_WKV = WS_WQ + 8 * MiB;
constexpr size_t WS_WO = WS_WKV + 16 * MiB;
constexpr size_t WS_WMIN = WS_WO + 8 * MiB;
constexpr size_t WS_WMOUT = WS_WMIN + 96 * MiB;
constexpr size_t WS_RW = WS_WMOUT + 48 * MiB;
constexpr size_t WS_XN = WS_RW + 1 * MiB;
constexpr size_t WS_BIG = WS_XN + 32 * MiB;
constexpr size_t WS_QA = WS_BIG + 128 * MiB;
constexpr size_t WS_KS = WS_QA + 16 * MiB;
constexpr size_t WS_KW = WS_KS + 4 * MiB;
constexpr size_t WS_KC = WS_KW + 4 * MiB;
constexpr size_t WS_VC = WS_KC + 1 * MiB;
constexpr size_t WS_CAT = WS_VC + 1 * MiB;
constexpr size_t WS_QX = WS_CAT + 32 * MiB;
constexpr size_t WS_OX = WS_QX + 32 * MiB;
constexpr size_t WS_MN = WS_OX + 32 * MiB;
constexpr size_t WS_KV = WS_MN + 4 * MiB;
constexpr size_t WS_COS = WS_KV + 32 * MiB;
constexpr size_t WS_SIN = WS_COS + 2 * MiB;
constexpr size_t WS_LIST = WS_SIN + 2 * MiB;
constexpr size_t WS_TOK = WS_LIST + 1 * MiB;
constexpr size_t WS_END = WS_TOK + 1 * MiB;
constexpr size_t WS_Y = WS_BIG, WS_H = WS_BIG + 72 * MiB, WS_U = WS_BIG, WS_V = WS_BIG + 64 * MiB, WS_UM = WS_QX;
constexpr int CW_BAR = 4096;
constexpr int CW_CNT = 8192;

constexpr int LDS_BYTES = 159744;
constexpr int LDS_MISC = LDS_BYTES - 64;

__device__ __forceinline__ unsigned f2bf(float f) { unsigned u = __float_as_uint(f); return (u + 0x7fffu + ((u >> 16) & 1u)) >> 16; }
__device__ __forceinline__ float bf2f(unsigned b) { return __uint_as_float(b << 16); }
__device__ __forceinline__ float bflo(unsigned w) { return __uint_as_float(w << 16); }
__device__ __forceinline__ float bfhi(unsigned w) { return __uint_as_float(w & 0xffff0000u); }
__device__ __forceinline__ unsigned pk2(float lo, float hi) { return f2bf(lo) | (f2bf(hi) << 16); }
__device__ __forceinline__ float wave_sum(float v) {
#pragma unroll
    for (int o = 1; o < 64; o <<= 1) v += __shfl_xor(v, o);
    return v;
}
__device__ __forceinline__ float wave_max(float v) {
#pragma unroll
    for (int o = 1; o < 64; o <<= 1) v = fmaxf(v, __shfl_xor(v, o));
    return v;
}
__device__ __forceinline__ int opaque_tid() { int t = threadIdx.x; asm volatile("" : "+v"(t)); return t; }
#define LDS_WAIT() asm volatile("s_waitcnt lgkmcnt(0)" ::: "memory")
__device__ __forceinline__ float gelu_tanh(float x) {
    const float u = 0.7978845608028654f * (x + 0.044715f * x * x * x);
    const float e = __expf(-2.0f * fabsf(u));
    float t = (1.0f - e) / (1.0f + e); t = u < 0.f ? -t : t;
    return 0.5f * x * (1.0f + t);
}
__device__ __forceinline__ float sigmoidf_(float x) { return 1.0f / (1.0f + __expf(-x)); }

#define XB_TMO      128
#define XB_XCNT(j)  (256  + 64 * (j))
#define XB_XSUB(j)  (1280 + 64 * (j))
#define XB_XGEN(j)  (2304 + 64 * (j))
#define XB_TOP      3328
#define XB_TOPGEN   3392
#define XCD_BAR_WORDS 3456
#define XB_SPIN_CAP (1u << 22)

__device__ __forceinline__ unsigned xb_ld(unsigned* p)              { return __hip_atomic_load(p, __ATOMIC_RELAXED, __HIP_MEMORY_SCOPE_AGENT); }
__device__ __forceinline__ unsigned xb_add(unsigned* p, unsigned v) { return __hip_atomic_fetch_add(p, v, __ATOMIC_RELAXED, __HIP_MEMORY_SCOPE_AGENT); }
__device__ __forceinline__ unsigned xb_xcc_id() { return (unsigned)__builtin_amdgcn_s_getreg((3 << 11) | 20) & 0xFu; }
#define XB_SPIN(cond, bar) do { unsigned _sp = 0; while (cond) { __builtin_amdgcn_s_sleep(1); \
    if ((++_sp & 255u) == 0u) { if (xb_ld(&(bar)[XB_TMO])) break; if (_sp > XB_SPIN_CAP) { atomicAdd(&(bar)[XB_TMO], 1u); break; } } } } while (0)

struct XcdBarrier { unsigned* bar; unsigned x; volatile LAS unsigned* st; };

__device__ __forceinline__ XcdBarrier xcd_barrier_post(unsigned* bar, volatile LAS unsigned* st) {
    XcdBarrier b; b.bar = bar; b.x = xb_xcc_id(); b.st = st;
    if (threadIdx.x == 0) (void)xb_add(&bar[XB_XCNT(b.x)], 1u);
    return b;
}
__device__ __forceinline__ void xcd_barrier_complete(unsigned* bar, unsigned x, unsigned& nloc, unsigned& nx) {
    const unsigned G = gridDim.x * gridDim.y * gridDim.z;
    unsigned sum, cnt, mine, sp = 0u;
    for (;;) {
        sum = 0u; cnt = 0u; mine = 0u;
#pragma unroll
        for (unsigned j = 0; j < 16; ++j) { const unsigned c = xb_ld(&bar[XB_XCNT(j)]); sum += c; cnt += (c > 0u) ? 1u : 0u; mine = (j == x) ? c : mine; }
        if (sum == G) break;
        __builtin_amdgcn_s_sleep(1);
        if ((++sp & 255u) == 0u) { if (xb_ld(&bar[XB_TMO])) break; if (sp > XB_SPIN_CAP) { atomicAdd(&bar[XB_TMO], 1u); break; } }
    }
    nloc = mine > 0u ? mine : 1u; nx = cnt > 0u ? cnt : 1u;
}
__device__ __forceinline__ void xcd_barrier(const XcdBarrier& b) {
    asm volatile("s_waitcnt vmcnt(0)" ::: "memory");
    __syncthreads();
    if (threadIdx.x == 0) {
        unsigned* bar = b.bar;
        __builtin_amdgcn_s_waitcnt(0);
        unsigned nloc = b.st[0], nx = b.st[1];
        if (nloc == 0u) { xcd_barrier_complete(bar, b.x, nloc, nx); b.st[0] = nloc; b.st[1] = nx; }
        const unsigned old = xb_add(&bar[XB_XSUB(b.x)], 1u);
        const unsigned gen = old / nloc;
        if (old + 1u == (gen + 1u) * nloc) {
            __builtin_amdgcn_fence(__ATOMIC_RELEASE, "agent");
            asm volatile("s_waitcnt vmcnt(0)" ::: "memory");
            const unsigned og = xb_add(&bar[XB_TOP], 1u);
            const unsigned tg = og / nx;
            if (og + 1u == (tg + 1u) * nx) xb_add(&bar[XB_TOPGEN], 1u);
            else XB_SPIN(xb_ld(&bar[XB_TOPGEN]) == tg, bar);
            __builtin_amdgcn_fence(__ATOMIC_ACQUIRE, "agent");
            xb_add(&bar[XB_XGEN(b.x)], 1u);
            asm volatile("s_waitcnt vmcnt(0)" ::: "memory");
        } else {
            XB_SPIN(xb_ld(&bar[XB_XGEN(b.x)]) == gen, bar);
            __builtin_amdgcn_fence(__ATOMIC_ACQUIRE, "agent");
            asm volatile("s_waitcnt vmcnt(0)" ::: "memory");
        }
    }
    __syncthreads();
}

struct Args {
    const float* in[N_IN];
    float* out;
    unsigned char* ws;
    float freq[32];
    int ph_lo, ph_hi;
};

template <class AF, class EF>
__device__ __forceinline__ void gemm_tile_v1(AF arow, const bf16* __restrict__ Bt, int K, int m0, int n0, EF epi) {
    const int tid = opaque_tid(), wid = __builtin_amdgcn_readfirstlane(tid >> 6), lane = tid & 63, wr = wid >> 2, wc = wid & 3, fr = lane & 15, fq = lane >> 4;
    f32x4 acc[4][2][2];
#pragma unroll
    for (int mi = 0; mi < 4; ++mi)
#pragma unroll
        for (int bj = 0; bj < 2; ++bj)
#pragma unroll
            for (int ni = 0; ni < 2; ++ni) acc[mi][bj][ni] = (f32x4){0.f, 0.f, 0.f, 0.f};
    const bf16* ap[4]; const bf16* bp[2][2];
#pragma unroll
    for (int mi = 0; mi < 4; ++mi) ap[mi] = arow(m0 + wr * 64 + mi * 16 + fr) + fq * 8;
#pragma unroll
    for (int bj = 0; bj < 2; ++bj)
#pragma unroll
        for (int ni = 0; ni < 2; ++ni) bp[bj][ni] = Bt + (size_t)(n0 + bj * 128 + wc * 32 + ni * 16 + fr) * K + fq * 8;
#pragma unroll 2
    for (int k0 = 0; k0 < K; k0 += 32) {
        bf16x8 a[4], b[2][2];
#pragma unroll
        for (int mi = 0; mi < 4; ++mi) a[mi] = *(const bf16x8*)(ap[mi] + k0);
#pragma unroll
        for (int bj = 0; bj < 2; ++bj)
#pragma unroll
            for (int ni = 0; ni < 2; ++ni) b[bj][ni] = *(const bf16x8*)(bp[bj][ni] + k0);
#pragma unroll
        for (int mi = 0; mi < 4; ++mi)
#pragma unroll
            for (int bj = 0; bj < 2; ++bj)
#pragma unroll
                for (int ni = 0; ni < 2; ++ni) acc[mi][bj][ni] = __builtin_amdgcn_mfma_f32_16x16x32_bf16(b[bj][ni], a[mi], acc[mi][bj][ni], 0, 0, 0);
    }
#pragma unroll
    for (int mi = 0; mi < 4; ++mi)
#pragma unroll
        for (int ni = 0; ni < 2; ++ni) epi(m0 + wr * 64 + mi * 16 + fr, n0 + wc * 32 + ni * 16 + 4 * fq, acc[mi][0][ni], acc[mi][1][ni]);
}
__device__ __forceinline__ void st_bf16x4(bf16* p, f32x4 v) { u32x2 w; w.x = pk2(v[0], v[1]); w.y = pk2(v[2], v[3]); *(u32x2*)p = w; }

__device__ __forceinline__ int hyb_colmap(int n) {
    if (n < 1280) return n;
    if (n < 1536) return 1304 + (n - 1280);
    if (n < 1792) return 1560 + (n - 1536);
    if (n < 2304) return 1816 + (n - 1792);
    if (n < 2816) return 2344 + (n - 2304);
    if (n < 2840) return 1280 + (n - 2816);
    if (n < 2856) return 2328 + (n - 2840);
    return -1;
}
__device__ __forceinline__ void tr_item(const float* __restrict__ W, int Nsrc, int K, bf16* __restrict__ Wt, const float* __restrict__ gain, int kind, int nblk, LAS float* scr, int item, int lane) {
    const int kb = item / nblk, nb = item % nblk, k0 = 64 * kb, n0 = 32 * nb;
    const int j = lane & 31, n = n0 + j;
    int col;
    if (kind == 0) col = n; else if (kind == 1) col = hyb_colmap(n); else { const int pn = n >> 8, r = n & 255; col = (r >> 7) * 384 + pn * 128 + (r & 127); }
#pragma unroll 8
    for (int i = 0; i < 32; ++i) {
        const int kk = 2 * i + (lane >> 5); float v = 0.f;
        if (col >= 0) { v = W[(size_t)(k0 + kk) * Nsrc + col]; if (gain) v *= gain[k0 + kk]; }
        scr[kk * 33 + j] = v;
    }
    LDS_WAIT();
    const int c = lane & 7;
#pragma unroll
    for (int jx = 0; jx < 4; ++jx) {
        const int nn = (lane >> 3) + 8 * jx; const LAS float* s = scr + (8 * c) * 33 + nn;
        u32x4 o; o.x = pk2(s[0 * 33], s[1 * 33]); o.y = pk2(s[2 * 33], s[3 * 33]); o.z = pk2(s[4 * 33], s[5 * 33]); o.w = pk2(s[6 * 33], s[7 * 33]);
        *(u32x4*)(Wt + (size_t)(n0 + nn) * K + k0 + 8 * c) = o;
    }
    LDS_WAIT();
}
__device__ __forceinline__ void rms_row_to_bf16(const float* __restrict__ xrow, bf16* __restrict__ orow, float* __restrict__ copy, int lane) {
    const f32x4* xr = (const f32x4*)xrow + lane;
    f32x4 v[4]; float s = 0.f;
#pragma unroll
    for (int j = 0; j < 4; ++j) { v[j] = xr[64 * j]; s += (v[j].x * v[j].x + v[j].y * v[j].y) + (v[j].z * v[j].z + v[j].w * v[j].w); }
    const float rstd = rsqrtf(wave_sum(s) * (1.f / 1024.f) + EPS);
    u32x2* o8 = (u32x2*)orow + lane;
#pragma unroll
    for (int j = 0; j < 4; ++j) { u32x2 w; w.x = pk2(v[j].x * rstd, v[j].y * rstd); w.y = pk2(v[j].z * rstd, v[j].w * rstd); o8[64 * j] = w; }
    if (copy) { f32x4* c4 = (f32x4*)copy + lane;
#pragma unroll
        for (int j = 0; j < 4; ++j) c4[64 * j] = v[j]; }
}

__device__ __forceinline__ void phase_prologue(const Args& A, LAS unsigned char* lds) {
    const int tid = opaque_tid(), wid = __builtin_amdgcn_readfirstlane(tid >> 6), lane = tid & 63;
    const int gw = blockIdx.x * 8 + wid, NGW = gridDim.x * 8;
    LAS float* scr = (LAS float*)(lds + wid * 16384);
    unsigned char* ws = A.ws;
    constexpr int N_HYB = 2 * 1536, N_HOUT = 2 * 512, N_SGIN = 2 * 2048, N_SGOUT = 2 * 1024, N_WQ = 4 * 512, N_WKV = 4 * 1024, N_WO = 4 * 512, N_MIN = 64 * 384, N_MOUT = 64 * 192;
    constexpr int NITEMS = N_HYB + N_HOUT + N_SGIN + N_SGOUT + N_WQ + N_WKV + N_WO + N_MIN + N_MOUT;
    for (int it = gw; it < NITEMS; it += NGW) {
        int r = it;
        if (r < N_HYB) { const int sl = r / 1536; tr_item(A.in[I_HYBIN] + (size_t)sl * 1024 * HYSRC, HYSRC, 1024, (bf16*)(ws + WS_WHYB) + (size_t)sl * HYN * 1024, A.in[I_NMIX] + (2 * sl) * 1024, 1, 96, scr, r % 1536, lane); continue; } r -= N_HYB;
        if (r < N_HOUT) { const int sl = r / 512; tr_item(A.in[I_HYBOUT] + (size_t)sl * 1024 * 1024, 1024, 1024, (bf16*)(ws + WS_WHOUT) + (size_t)sl * 1024 * 1024, nullptr, 0, 32, scr, r % 512, lane); continue; } r -= N_HOUT;
        if (r < N_SGIN) { const int sl = r / 2048; tr_item(A.in[I_SGIN] + (size_t)sl * 1024 * 4096, 4096, 1024, (bf16*)(ws + WS_WSGIN) + (size_t)sl * 4096 * 1024, A.in[I_NMIX] + (2 * sl + 1) * 1024, 0, 128, scr, r % 2048, lane); continue; } r -= N_SGIN;
        if (r < N_SGOUT) { const int sl = r / 1024; tr_item(A.in[I_SGOUT] + (size_t)sl * 2048 * 1024, 1024, 2048, (bf16*)(ws + WS_WSGOUT) + (size_t)sl * 1024 * 2048, nullptr, 0, 32, scr, r % 1024, lane); continue; } r -= N_SGOUT;
        if (r < N_WQ) { const int sl = r / 512; tr_item(A.in[I_XWQ] + (size_t)sl * 1024 * 1024, 1024, 1024, (bf16*)(ws + WS_WQ) + (size_t)sl * 1024 * 1024, A.in[I_NXAT] + sl * 1024, 0, 32, scr, r % 512, lane); continue; } r -= N_WQ;
        if (r < N_WKV) { const int sl = r / 1024; tr_item(A.in[I_XWKV] + (size_t)sl * 1024 * 2048, 2048, 1024, (bf16*)(ws + WS_WKV) + (size_t)sl * 2048 * 1024, A.in[I_NMEM] + sl * 1024, 0, 64, scr, r % 1024, lane); continue; } r -= N_WKV;
        if (r < N_WO) { const int sl = r / 512; tr_item(A.in[I_XWO] + (size_t)sl * 1024 * 1024, 1024, 1024, (bf16*)(ws + WS_WO) + (size_t)sl * 1024 * 1024, nullptr, 0, 32, scr, r % 512, lane); continue; } r -= N_WO;
        if (r < N_MIN) { const int sl = r / 384; tr_item(A.in[I_MOEIN] + (size_t)sl * 1024 * 768, 768, 1024, (bf16*)(ws + WS_WMIN) + (size_t)sl * 768 * 1024, A.in[I_NFFN] + (sl >> 4) * 1024, 2, 24, scr, r % 384, lane); continue; } r -= N_MIN;
        { const int sl = r / 192; tr_item(A.in[I_MOEOUT] + (size_t)sl * 384 * 1024, 1024, 384, (bf16*)(ws + WS_WMOUT) + (size_t)sl * 1024 * 384, nullptr, 0, 32, scr, r % 192, lane); }
    }
    for (int m = gw; m < T; m += NGW) rms_row_to_bf16(A.in[I_X] + (size_t)m * D, (bf16*)(ws + WS_XN) + (size_t)m * D, A.out + (size_t)m * D, lane);
    for (int m = gw; m < NBATCH * NMEM; m += NGW) rms_row_to_bf16(A.in[I_MEM] + (size_t)m * D, (bf16*)(ws + WS_MN) + (size_t)m * D, nullptr, lane);
    const int gt = blockIdx.x * 512 + tid, NGT = gridDim.x * 512;
    const int* pos = (const int*)A.in[I_POS];
    float* cosT = (float*)(ws + WS_COS); float* sinT = (float*)(ws + WS_SIN);
    for (int i = gt; i < T * 32; i += NGT) {
        const int t = i >> 5, j = i & 31;
        const float ang = (float)pos[t] * A.freq[j];
        const double rev = (double)ang * 0.15915494309189533577;
        const float fr = (float)(rev - rint(rev));
        cosT[i] = __builtin_amdgcn_cosf(fr); sinT[i] = __builtin_amdgcn_sinf(fr);
    }
    float* RW = (float*)(ws + WS_RW);
    for (int i = gt; i < DEPTH * NEXP * D; i += NGT) { const int k = i & 1023, e = (i >> 10) & 15, l = i >> 14; RW[i] = A.in[I_RW][k * NEXP + e] * A.in[I_NFFN][l * D + k]; }
}

__device__ __forceinline__ void phase_kv_gemm(const Args& A) {
    const bf16* MN = (const bf16*)(A.ws + WS_MN); const bf16* W = (const bf16*)(A.ws + WS_WKV); bf16* KV = (bf16*)(A.ws + WS_KV);
    constexpr int NT_N = 8192 / 256, NT = (2048 / 128) * NT_N;
    for (int u = blockIdx.x; u < NT; u += gridDim.x) {
        const int m0 = (u / NT_N) * 128, n0 = (u % NT_N) * 256;
        gemm_tile_v1([&](int r) { return MN + (size_t)r * D; }, W, D, m0, n0,
            [&](int row, int col, f32x4 v0, f32x4 v1) { st_bf16x4(KV + (size_t)row * 8192 + col, v0); st_bf16x4(KV + (size_t)row * 8192 + col + 128, v1); });
    }
}
__device__ __forceinline__ void phase_knorm(const Args& A) {
    const int tid_ = opaque_tid(); const int wid = __builtin_amdgcn_readfirstlane(tid_ >> 6), lane = tid_ & 63; const int gw = blockIdx.x * 8 + wid, NGW = gridDim.x * 8;
    bf16* KV = (bf16*)(A.ws + WS_KV);
    for (int it = gw; it < DEPTH * 2048 * 4; it += NGW) {
        const int h = it & 3, m = (it >> 2) & 2047, l = it >> 13;
        bf16* p = KV + (size_t)m * 8192 + l * 2048 + h * 256 + 4 * lane;
        const u32x2 w = *(const u32x2*)p;
        float x0 = bflo(w.x), x1 = bfhi(w.x), x2 = bflo(w.y), x3 = bfhi(w.y);
        const float rstd = rsqrtf(wave_sum(x0 * x0 + x1 * x1 + x2 * x2 + x3 * x3) * (1.f / 256.f) + EPS) * 0.0625f;
        const f32x4 g = *(const f32x4*)(A.in[I_XKN] + l * 256 + 4 * lane);
        u32x2 o; o.x = pk2(x0 * rstd * g.x, x1 * rstd * g.y); o.y = pk2(x2 * rstd * g.z, x3 * rstd * g.w);
        *(u32x2*)p = o;
    }
}

template <class EF>
__device__ __forceinline__ void gemm_rows_v1(const bf16* Am, int lda, const bf16* Bt, int K, int M, int N, EF epi) {
    const int ntn = N / 256, nt = (M / 128) * ntn;
    for (int u = blockIdx.x; u < nt; u += gridDim.x) {
        const int m0 = (u / ntn) * 128, n0 = (u % ntn) * 256;
        gemm_tile_v1([&](int r) { return Am + (size_t)r * lda; }, Bt, K, m0, n0, epi);
    }
}

__device__ __forceinline__ void phase_nsa_prep(const Args& A, int i, LAS unsigned char* lds) {
    const int tid_ = opaque_tid(); const int wid = __builtin_amdgcn_readfirstlane(tid_ >> 6), lane = tid_ & 63; const int gw = blockIdx.x * 8 + wid, NGW = gridDim.x * 8;
    unsigned char* ws = A.ws;
    const bf16* HY = (const bf16*)(ws + WS_BIG);
    const float* cosT = (const float*)(ws + WS_COS); const float* sinT = (const float*)(ws + WS_SIN);
    bf16* QA = (bf16*)(ws + WS_QA); bf16* KS = (bf16*)(ws + WS_KS); bf16* KW = (bf16*)(ws + WS_KW);
    LAS float* abuf = (LAS float*)(lds + wid * 8192);
    const int NIT = T + NBATCH * NCMP * 2 * 2;
    for (int it = gw; it < NIT; it += NGW) {
        if (it < T) {
            const int t = it;
            const float c = cosT[t * 32 + (lane & 31)], s = sinT[t * 32 + (lane & 31)];
#pragma unroll
            for (int u = 0; u < 12; ++u) {
                int src; const float* gain; bf16* dst; float scale;
                if (u < 8) { src = C_QA + 64 * u; gain = A.in[I_QNORM] + i * 64; dst = QA + (size_t)t * 512 + 64 * u; scale = 0.125f; }
                else if (u < 10) { src = C_KS + 64 * (u - 8); gain = A.in[I_KNORM] + (i * 3 + 1) * 64; dst = KS + (size_t)t * 128 + 64 * (u - 8); scale = 1.f; }
                else { src = C_KW + 64 * (u - 10); gain = A.in[I_KNORM] + (i * 3 + 2) * 64; dst = KW + (size_t)t * 128 + 64 * (u - 10); scale = 1.f; }
                const float x = bf2f(HY[(size_t)t * HYN + src + lane]);
                const float y = x * rsqrtf(wave_sum(x * x) * (1.f / 64.f) + EPS) * gain[lane] * scale;
                const float pr = __shfl_xor(y, 32);
                const float o = lane < 32 ? y * c - pr * s : y * c + pr * s;
                dst[lane] = (bf16)f2bf(o);
            }
        } else {
            const int r = it - T; const int kv = r & 1, g = (r >> 1) & 1, bn = r >> 2, n = bn % NCMP, b = bn / NCMP;
            const float* pe = A.in[I_CMPPE] + (size_t)(i * 2 + kv) * 32 * 64;
            const float* w1 = A.in[I_CMPW1] + (size_t)(i * 2 + kv) * 2048 * 64;
            const float* w2 = A.in[I_CMPW2] + (size_t)(i * 2 + kv) * 64 * 64;
            const int tok0 = b * S + 16 * n, coff = (kv ? C_VC : C_KC) + g * 64;
#pragma unroll 4
            for (int l = 0; l < 32; ++l) abuf[l * 64 + lane] = bf2f(HY[(size_t)(tok0 + l) * HYN + coff + lane]) + pe[l * 64 + lane];
            LDS_WAIT();
            float acc = 0.f;
#pragma unroll 8
            for (int k = 0; k < 2048; ++k) acc += abuf[k] * w1[k * 64 + lane];
            const float h = gelu_tanh(acc);
            float o = 0.f;
#pragma unroll 8
            for (int m = 0; m < 64; ++m) o += __shfl(h, m) * w2[m * 64 + lane];
            LDS_WAIT();
            const size_t oidx = ((size_t)(b * 128 + n) * 2 + g) * 64 + lane;
            if (kv == 0) {
                const float y = o * rsqrtf(wave_sum(o * o) * (1.f / 64.f) + EPS) * A.in[I_KNORM][(i * 3 + 0) * 64 + lane];
                const int tp = tok0 + 31;
                const float c = cosT[tp * 32 + (lane & 31)], s = sinT[tp * 32 + (lane & 31)];
                const float pr = __shfl_xor(y, 32);
                const float oo = lane < 32 ? y * c - pr * s : y * c + pr * s;
                ((bf16*)(ws + WS_KC))[oidx] = (bf16)f2bf(oo);
            } else ((bf16*)(ws + WS_VC))[oidx] = (bf16)f2bf(o);
        }
    }
}

__device__ __forceinline__ void nsa_block(const LAS float* qs, const bf16* __restrict__ krow, bool ok, const bf16* __restrict__ vbase, int vstride, int lane,
                                          float (&m)[4], float (&l)[4], float (&o)[4]) {
    float s[4] = {0.f, 0.f, 0.f, 0.f};
#pragma unroll 2
    for (int c = 0; c < 8; ++c) {
        const u32x4 kw = *(const u32x4*)(krow + 8 * c);
        const float k0 = bflo(kw.x), k1 = bfhi(kw.x), k2 = bflo(kw.y), k3 = bfhi(kw.y), k4 = bflo(kw.z), k5 = bfhi(kw.z), k6 = bflo(kw.w), k7 = bfhi(kw.w);
#pragma unroll
        for (int hh = 0; hh < 4; ++hh) {
            const f32x4 qa = *(const LAS f32x4*)(qs + hh * 64 + 8 * c), qb = *(const LAS f32x4*)(qs + hh * 64 + 8 * c + 4);
            s[hh] += (qa.x * k0 + qa.y * k1) + (qa.z * k2 + qa.w * k3) + (qb.x * k4 + qb.y * k5) + (qb.z * k6 + qb.w * k7);
        }
    }
    float p[4];
#pragma unroll
    for (int hh = 0; hh < 4; ++hh) {
        const float sv = ok ? s[hh] : -INFINITY;
        const float bm = wave_max(sv);
        const float mn = fmaxf(m[hh], bm);
        if (mn == -INFINITY) { p[hh] = 0.f; continue; }
        const float alpha = __expf(m[hh] - mn);
        p[hh] = ok ? __expf(sv - mn) : 0.f;
        l[hh] = l[hh] * alpha + wave_sum(p[hh]);
        o[hh] *= alpha; m[hh] = mn;
    }
#pragma unroll 8
    for (int kk = 0; kk < 64; ++kk) {
        const float v = bf2f(vbase[(size_t)kk * vstride + lane]);
#pragma unroll
        for (int hh = 0; hh < 4; ++hh) o[hh] += __shfl(p[hh], kk) * v;
    }
}
__device__ __forceinline__ void phase_nsa_attn(const Args& A, int i, LAS unsigned char* lds) {
    const int tid_ = opaque_tid(); const int wid = __builtin_amdgcn_readfirstlane(tid_ >> 6), lane0 = tid_ & 63; const int gw = blockIdx.x * 8 + wid, NGW = gridDim.x * 8;
    unsigned char* ws = A.ws;
    const bf16* HY = (const bf16*)(ws + WS_BIG); const bf16* QA = (const bf16*)(ws + WS_QA); const bf16* KS = (const bf16*)(ws + WS_KS); const bf16* KW = (const bf16*)(ws + WS_KW);
    const bf16* KC = (const bf16*)(ws + WS_KC); const bf16* VC = (const bf16*)(ws + WS_VC); bf16* CAT = (bf16*)(ws + WS_CAT);
    LAS float* qs = (LAS float*)(lds + wid * 2048);
    LAS float* ps = qs + 256;
    for (int it = gw; it < 2 * T; it += NGW) {
        int lane = lane0; asm volatile("" : "+v"(lane));
        const int tok = it >> 1, g = it & 1, b = tok >> 11, t = tok & 2047;
#pragma unroll
        for (int hh = 0; hh < 4; ++hh) qs[hh * 64 + lane] = bf2f(QA[(size_t)tok * 512 + (g * 4 + hh) * 64 + lane]);
        LDS_WAIT();
        const int ncv = t >= 31 ? ((t - 31) >> 4) + 1 : 0;
        float oc[4] = {0.f, 0.f, 0.f, 0.f};
        float psum0 = 0.f, psum1 = 0.f;
        {
            const bool v0 = lane < ncv, v1 = lane + 64 < ncv;
            const bf16* k0p = KC + ((size_t)(b * 128 + lane) * 2 + g) * 64;
            const bf16* k1p = KC + ((size_t)(b * 128 + (lane + 64 < 127 ? lane + 64 : 126)) * 2 + g) * 64;
            float s0[4] = {0.f, 0.f, 0.f, 0.f}, s1[4] = {0.f, 0.f, 0.f, 0.f};
#pragma unroll 2
            for (int c = 0; c < 8; ++c) {
                const u32x4 ka = *(const u32x4*)(k0p + 8 * c), kb = *(const u32x4*)(k1p + 8 * c);
#pragma unroll
                for (int hh = 0; hh < 4; ++hh) {
                    const f32x4 qa = *(const LAS f32x4*)(qs + hh * 64 + 8 * c), qb = *(const LAS f32x4*)(qs + hh * 64 + 8 * c + 4);
                    s0[hh] += (qa.x * bflo(ka.x) + qa.y * bfhi(ka.x)) + (qa.z * bflo(ka.y) + qa.w * bfhi(ka.y)) + (qb.x * bflo(ka.z) + qb.y * bfhi(ka.z)) + (qb.z * bflo(ka.w) + qb.w * bfhi(ka.w));
                    s1[hh] += (qa.x * bflo(kb.x) + qa.y * bfhi(kb.x)) + (qa.z * bflo(kb.y) + qa.w * bfhi(kb.y)) + (qb.x * bflo(kb.z) + qb.y * bfhi(kb.z)) + (qb.z * bflo(kb.w) + qb.w * bfhi(kb.w));
                }
            }
            float p0[4], p1[4];
#pragma unroll
            for (int hh = 0; hh < 4; ++hh) {
                const float a0 = v0 ? s0[hh] : -INFINITY, a1 = v1 ? s1[hh] : -INFINITY;
                const float mx = wave_max(fmaxf(a0, a1));
                if (ncv > 0) {
                    const float e0 = v0 ? __expf(a0 - mx) : 0.f, e1 = v1 ? __expf(a1 - mx) : 0.f;
                    const float inv = 1.0f / wave_sum(e0 + e1);
                    p0[hh] = e0 * inv; p1[hh] = e1 * inv;
                } else { p0[hh] = 0.f; p1[hh] = 0.f; }
                psum0 += p0[hh]; psum1 += p1[hh];
            }
#pragma unroll 2
            for (int c = 0; c < ncv; ++c) {
                const float v = bf2f(VC[((size_t)(b * 128 + c) * 2 + g) * 64 + lane]);
#pragma unroll
                for (int hh = 0; hh < 4; ++hh) oc[hh] += __shfl(c < 64 ? p0[hh] : p1[hh], c & 63) * v;
            }
        }
        ps[lane] = psum0; ps[64 + lane] = psum1;
        LDS_WAIT();
        const int cur = t >> 6;
        unsigned selmask;
        {
            const int j = lane & 31;
            float imp = ps[4 * j] + ps[4 * j + 1] + ps[4 * j + 2] + 0.5f * ps[4 * j + 3] + (j > 0 ? 0.5f * ps[4 * j - 1] : 0.f);
            const bool valid = j <= cur, forced = (j == 0) || (j == cur) || (j == cur - 1);
            const float score = valid ? imp + (forced ? 1000.0f : 0.f) : -INFINITY;
            int rank = 0;
#pragma unroll 8
            for (int jj = 0; jj < 32; ++jj) { const float sj = __shfl(score, jj); rank += (sj > score || (sj == score && jj < j)) ? 1 : 0; }
            const bool sel = valid && rank < 8 && lane < 32;
            selmask = (unsigned)__ballot(sel);
        }
        LDS_WAIT();
        float o1[4] = {0.f, 0.f, 0.f, 0.f}, o2[4] = {0.f, 0.f, 0.f, 0.f};
#pragma unroll 1
        for (int pass = 0; pass < 2; ++pass) {
            float oa[4] = {0.f, 0.f, 0.f, 0.f}, ma[4] = {-INFINITY, -INFINITY, -INFINITY, -INFINITY}, la[4] = {0.f, 0.f, 0.f, 0.f};
            const int lo = pass ? (t - 255 > 0 ? t - 255 : 0) : 0;
            const unsigned bm = pass ? 0xffffffffu : selmask;
            const bf16* Kb = pass ? KW : KS; const int vc = pass ? C_VW : C_VS;
#pragma unroll 1
            for (int j = lo >> 6; j <= cur; ++j) {
                if (!((bm >> j) & 1u)) continue;
                const int key = 64 * j + lane; const size_t kt = (size_t)(b * S + key);
                nsa_block(qs, Kb + kt * 128 + g * 64, key <= t && key >= lo, HY + (size_t)(b * S + 64 * j) * HYN + vc + g * 64, HYN, lane, ma, la, oa);
            }
            if (pass == 0) {
#pragma unroll
                for (int hh = 0; hh < 4; ++hh) o1[hh] = oa[hh] / la[hh];
            } else {
#pragma unroll
                for (int hh = 0; hh < 4; ++hh) o2[hh] = oa[hh] / la[hh];
            }
        }
#pragma unroll
        for (int hh = 0; hh < 4; ++hh) {
            const int head = g * 4 + hh;
            const float* gb = A.in[I_GATEB] + i * 24 + head * 3;
            const bf16* gl = HY + (size_t)tok * HYN + C_GA + head * 3;
            const float g0 = sigmoidf_(bf2f(gl[0]) + gb[0]), g1 = sigmoidf_(bf2f(gl[1]) + gb[1]), g2 = sigmoidf_(bf2f(gl[2]) + gb[2]);
            const float o = g0 * oc[hh] + g1 * o1[hh] + g2 * o2[hh];
            CAT[(size_t)tok * 1024 + head * 64 + lane] = (bf16)f2bf(o);
        }
    }
}

__device__ __forceinline__ void phase_gla_seq(const Args& A, int i, LAS unsigned char* lds) {
    const int tid = opaque_tid(), wid = __builtin_amdgcn_readfirstlane(tid >> 6), lane = tid & 63;
    unsigned char* ws = A.ws;
    const bf16* HY = (const bf16*)(ws + WS_BIG); bf16* CAT = (bf16*)(ws + WS_CAT);
    constexpr int CH = 16;
    LAS float* la = (LAS float*)lds;
    LAS float* lk = la + 4 * CH * 64;
    LAS float* lq = lk + 4 * CH * 64;
    LAS float* lo = lq + 4 * CH * 64;
    const float* wa2 = A.in[I_WA2] + i * 16 * 256; const float* ba = A.in[I_BA] + i * 256; const float* og = A.in[I_ONORM] + i * 128;
    for (int it = blockIdx.x; it < 8; it += gridDim.x) {
        const int pl = tid >> 7, v = tid & 127, p = it * 4 + pl, b = p >> 2, h = p & 3;
        float St[64];
#pragma unroll
        for (int k = 0; k < 64; ++k) St[k] = 0.f;
        for (int c0 = 0; c0 < S; c0 += CH) {
            __syncthreads();
            for (int e = tid; e < 4 * CH * 64; e += 512) {
                const int kk = e & 63, tk = (e >> 6) % CH, pp = e / (64 * CH); const int pb = (it * 4 + pp) >> 2, ph = (it * 4 + pp) & 3;
                const size_t tok = (size_t)pb * S + c0 + tk; const bf16* row = HY + tok * HYN;
                float z = ba[ph * 64 + kk];
#pragma unroll
                for (int r = 0; r < 16; ++r) z += bf2f(row[C_AL + r]) * wa2[r * 256 + ph * 64 + kk];
                const float ls_ = fminf(z, 0.f) - log1pf(__expf(-fabsf(z)));
                la[e] = __expf(ls_ * (1.f / 16.f));
                lk[e] = bf2f(row[C_KB + ph * 64 + kk]);
                lq[e] = bf2f(row[C_QB + ph * 64 + kk]) * 0.125f;
            }
            __syncthreads();
            for (int tk = 0; tk < CH; ++tk) {
                const size_t tok = (size_t)b * S + c0 + tk;
                const float vv = bf2f(HY[tok * HYN + C_VB + h * 128 + v]);
                const LAS float* pa = la + (pl * CH + tk) * 64; const LAS float* pk = lk + (pl * CH + tk) * 64; const LAS float* pq = lq + (pl * CH + tk) * 64;
                float o = 0.f;
#pragma unroll
                for (int k4 = 0; k4 < 16; ++k4) {
                    const f32x4 a4 = *(const LAS f32x4*)(pa + 4 * k4), k4v = *(const LAS f32x4*)(pk + 4 * k4), q4 = *(const LAS f32x4*)(pq + 4 * k4);
                    St[4 * k4 + 0] = a4.x * St[4 * k4 + 0] + k4v.x * vv; o += q4.x * St[4 * k4 + 0];
                    St[4 * k4 + 1] = a4.y * St[4 * k4 + 1] + k4v.y * vv; o += q4.y * St[4 * k4 + 1];
                    St[4 * k4 + 2] = a4.z * St[4 * k4 + 2] + k4v.z * vv; o += q4.z * St[4 * k4 + 2];
                    St[4 * k4 + 3] = a4.w * St[4 * k4 + 3] + k4v.w * vv; o += q4.w * St[4 * k4 + 3];
                }
                lo[(pl * CH + tk) * 128 + v] = o;
            }
            __syncthreads();
            for (int r = wid; r < 4 * CH; r += 8) {
                const int pp = r / CH, tk = r % CH; const int pb = (it * 4 + pp) >> 2, ph = (it * 4 + pp) & 3;
                const size_t tok = (size_t)pb * S + c0 + tk;
                const float x0 = lo[r * 128 + lane], x1 = lo[r * 128 + 64 + lane];
                const float rstd = rsqrtf(wave_sum(x0 * x0 + x1 * x1) * (1.f / 128.f) + EPS);
                const float r0 = bf2f(HY[tok * HYN + C_RB + ph * 128 + lane]), r1 = bf2f(HY[tok * HYN + C_RB + ph * 128 + 64 + lane]);
                CAT[tok * 1024 + 512 + ph * 128 + lane] = (bf16)f2bf(x0 * rstd * og[lane] * (r0 * sigmoidf_(r0)));
                CAT[tok * 1024 + 512 + ph * 128 + 64 + lane] = (bf16)f2bf(x1 * rstd * og[64 + lane] * (r1 * sigmoidf_(r1)));
            }
        }
        __syncthreads();
    }
}

__device__ __forceinline__ void phase_sgu_mix(const Args& A, int i, LAS unsigned char* lds) {
    const int tid = opaque_tid(), wid = __builtin_amdgcn_readfirstlane(tid >> 6), lane = tid & 63;
    unsigned char* ws = A.ws;
    const bf16* U = (const bf16*)(ws + WS_U); const bf16* V = (const bf16*)(ws + WS_V); bf16* UM = (bf16*)(ws + WS_UM);
    LAS float* vt = (LAS float*)lds;
    LAS float* st = vt + 128 * 256;
    const float* lng = A.in[I_LNG] + i * 2048; const float* lnb = A.in[I_LNB] + i * 2048;
    for (int it = blockIdx.x; it < NBATCH * 16 * 8; it += gridDim.x) {
        const int g = it & 7, n = (it >> 3) & 15, b = it >> 7;
        const size_t tok0 = (size_t)b * S + n * 128;
        __syncthreads();
        for (int s = wid * 16; s < wid * 16 + 16; ++s) {
            const u32x4* vr = (const u32x4*)(V + (tok0 + s) * 2048) + lane;
            float x[32]; float sum = 0.f;
#pragma unroll
            for (int j = 0; j < 4; ++j) { const u32x4 w = vr[64 * j];
                x[8 * j + 0] = bflo(w.x); x[8 * j + 1] = bfhi(w.x); x[8 * j + 2] = bflo(w.y); x[8 * j + 3] = bfhi(w.y); x[8 * j + 4] = bflo(w.z); x[8 * j + 5] = bfhi(w.z); x[8 * j + 6] = bflo(w.w); x[8 * j + 7] = bfhi(w.w); }
#pragma unroll
            for (int j = 0; j < 32; ++j) sum += x[j];
            const float mean = wave_sum(sum) * (1.f / 2048.f); float q = 0.f;
#pragma unroll
            for (int j = 0; j < 32; ++j) { const float d = x[j] - mean; q += d * d; }
            const float rstd = rsqrtf(wave_sum(q) * (1.f / 2048.f) + EPS);
            const u32x2 w = *((const u32x2*)(V + (tok0 + s) * 2048 + g * 256) + lane);
            const f32x4 gg = *(const f32x4*)(lng + g * 256 + 4 * lane), bb = *(const f32x4*)(lnb + g * 256 + 4 * lane);
            f32x4 o; o.x = (bflo(w.x) - mean) * rstd * gg.x + bb.x; o.y = (bfhi(w.x) - mean) * rstd * gg.y + bb.y; o.z = (bflo(w.y) - mean) * rstd * gg.z + bb.z; o.w = (bfhi(w.y) - mean) * rstd * gg.w + bb.w;
            *(LAS f32x4*)(vt + s * 256 + 4 * lane) = o;
            (void)st;
        }
        __syncthreads();
        const int c = tid & 255, th = tid >> 8;
        const float* wsg = A.in[I_SGWS] + (size_t)(i * 8 + g) * 128 * 128; const float* bsg = A.in[I_SGBS] + (i * 8 + g) * 128;
        for (int tt = 0; tt < 64; ++tt) {
            const int t = 2 * tt + th;
            const float* wr = wsg + t * 128;
            float acc = 0.f;
            for (int s = 0; s <= t; ++s) acc += wr[s] * vt[s * 256 + c];
            acc += bsg[t];
            const float u = bf2f(U[(tok0 + t) * 2048 + g * 256 + c]);
            UM[(tok0 + t) * 2048 + g * 256 + c] = (bf16)f2bf(u * acc);
        }
    }
    __syncthreads();
}

__device__ __forceinline__ void phase_rownorm(const Args& A) {
    const int tid_ = opaque_tid(); const int wid = __builtin_amdgcn_readfirstlane(tid_ >> 6), lane = tid_ & 63; const int gw = blockIdx.x * 8 + wid, NGW = gridDim.x * 8;
    for (int m = gw; m < T; m += NGW) rms_row_to_bf16(A.out + (size_t)m * D, (bf16*)(A.ws + WS_XN) + (size_t)m * D, nullptr, lane);
}

__device__ __forceinline__ void phase_xattn(const Args& A, int L, LAS unsigned char* lds) {
    const int tid = opaque_tid(), wid = __builtin_amdgcn_readfirstlane(tid >> 6), lane = tid & 63;
    unsigned char* ws = A.ws;
    const bf16* QX = (const bf16*)(ws + WS_QX); const bf16* KV = (const bf16*)(ws + WS_KV); bf16* OX = (bf16*)(ws + WS_OX);
    constexpr int KSTR = 129;
    LAS unsigned* kl = (LAS unsigned*)lds;
    LAS float* qb = (LAS float*)(lds + 132096) + wid * 256;
    LAS float* pb = (LAS float*)(lds + 132096 + 8192) + wid * 256;
    const float* qg = A.in[I_XQN] + L * 256;
    for (int it = blockIdx.x; it < NBATCH * 4 * 8; it += gridDim.x) {
        const int qc = it & 7, h = (it >> 3) & 3, b = it >> 5;
        __syncthreads();
        for (int e = tid; e < 256 * 128; e += 512) { const int m = e >> 7, dw = e & 127;
            kl[m * KSTR + dw] = *((const unsigned*)(KV + (size_t)(b * 256 + m) * 8192 + L * 2048 + h * 256) + dw); }
        __syncthreads();
        const bf16* Vb = KV + (size_t)(b * 256) * 8192 + L * 2048 + 1024 + h * 256;
        for (int tq = 0; tq < 32; ++tq) {
            const size_t tok = (size_t)b * S + qc * 256 + wid * 32 + tq;
            const u32x2 qw = *((const u32x2*)(QX + tok * 1024 + h * 256) + lane);
            const float q0 = bflo(qw.x), q1 = bfhi(qw.x), q2 = bflo(qw.y), q3 = bfhi(qw.y);
            const float rstd = rsqrtf(wave_sum(q0 * q0 + q1 * q1 + q2 * q2 + q3 * q3) * (1.f / 256.f) + EPS);
            const f32x4 gg = *(const f32x4*)(qg + 4 * lane);
            *(LAS f32x4*)(qb + 4 * lane) = (f32x4){q0 * rstd * gg.x, q1 * rstd * gg.y, q2 * rstd * gg.z, q3 * rstd * gg.w};
            LDS_WAIT();
            float s0 = 0.f, s1 = 0.f, s2 = 0.f, s3 = 0.f;
#pragma unroll 4
            for (int dw = 0; dw < 128; ++dw) {
                const f32x2 qq = *(const LAS f32x2*)(qb + 2 * dw);
                const unsigned k0 = kl[lane * KSTR + dw], k1 = kl[(lane + 64) * KSTR + dw], k2 = kl[(lane + 128) * KSTR + dw], k3 = kl[(lane + 192) * KSTR + dw];
                s0 += qq.x * bflo(k0) + qq.y * bfhi(k0); s1 += qq.x * bflo(k1) + qq.y * bfhi(k1);
                s2 += qq.x * bflo(k2) + qq.y * bfhi(k2); s3 += qq.x * bflo(k3) + qq.y * bfhi(k3);
            }
            const float mx = wave_max(fmaxf(fmaxf(s0, s1), fmaxf(s2, s3)));
            const float e0 = __expf(s0 - mx), e1 = __expf(s1 - mx), e2 = __expf(s2 - mx), e3 = __expf(s3 - mx);
            const float inv = 1.f / wave_sum((e0 + e1) + (e2 + e3));
            pb[lane] = e0 * inv; pb[lane + 64] = e1 * inv; pb[lane + 128] = e2 * inv; pb[lane + 192] = e3 * inv;
            LDS_WAIT();
            float o0 = 0.f, o1 = 0.f, o2 = 0.f, o3 = 0.f;
#pragma unroll 8
            for (int m = 0; m < 256; ++m) {
                const float p = pb[m];
                const u32x2 vw = *((const u32x2*)(Vb + (size_t)m * 8192) + lane);
                o0 += p * bflo(vw.x); o1 += p * bfhi(vw.x); o2 += p * bflo(vw.y); o3 += p * bfhi(vw.y);
            }
            u32x2 ow; ow.x = pk2(o0, o1); ow.y = pk2(o2, o3);
            *((u32x2*)(OX + tok * 1024 + h * 256) + lane) = ow;
            LDS_WAIT();
        }
    }
    __syncthreads();
}

__device__ __forceinline__ void phase_route(const Args& A, int L) {
    const int tid_ = opaque_tid(); const int wid = __builtin_amdgcn_readfirstlane(tid_ >> 6), lane = tid_ & 63; const int gw = blockIdx.x * 8 + wid, NGW = gridDim.x * 8;
    unsigned char* ws = A.ws;
    const float* RW = (const float*)(ws + WS_RW) + (size_t)L * NEXP * D; const float* rb = A.in[I_RB];
    unsigned* cnt = (unsigned*)(ws + WS_CTL) + CW_CNT + L * 64;
    int* list = (int*)(ws + WS_LIST); int* te = (int*)(ws + WS_TOK); int* tp = te + 2 * T; float* tw = (float*)(tp + 2 * T);
    bf16* XN = (bf16*)(ws + WS_XN);
    for (int t = gw; t < T; t += NGW) {
        const f32x4* xr = (const f32x4*)(A.out + (size_t)t * D) + lane;
        f32x4 v[4]; float s = 0.f;
#pragma unroll
        for (int j = 0; j < 4; ++j) { v[j] = xr[64 * j]; s += (v[j].x * v[j].x + v[j].y * v[j].y) + (v[j].z * v[j].z + v[j].w * v[j].w); }
        const float rstd = rsqrtf(wave_sum(s) * (1.f / 1024.f) + EPS);
        u32x2* o8 = (u32x2*)(XN + (size_t)t * D) + lane;
#pragma unroll
        for (int j = 0; j < 4; ++j) { u32x2 w; w.x = pk2(v[j].x * rstd, v[j].y * rstd); w.y = pk2(v[j].z * rstd, v[j].w * rstd); o8[64 * j] = w; }
        float mylg = -INFINITY;
#pragma unroll 2
        for (int e = 0; e < 16; ++e) {
            const f32x4* wr = (const f32x4*)(RW + e * D) + lane; float a = 0.f;
#pragma unroll
            for (int j = 0; j < 4; ++j) { const f32x4 w = wr[64 * j]; a += (v[j].x * w.x + v[j].y * w.y) + (v[j].z * w.z + v[j].w * w.w); }
            const float val = wave_sum(a) * rstd + rb[e];
            mylg = lane == e ? val : mylg;
        }
        const float v0 = wave_max(mylg);
        const int e0 = __ffsll((unsigned long long)__ballot(mylg == v0)) - 1;
        const int gidx = e0 >> 2;
        const float m2 = ((lane >> 2) == gidx && lane != e0 && lane < 16) ? mylg : -INFINITY;
        const float v1 = wave_max(m2);
        const int e1 = __ffsll((unsigned long long)__ballot(m2 == v1 && (lane >> 2) == gidx && lane != e0 && lane < 16)) - 1;
        const float w0 = 1.f / (1.f + __expf(v1 - v0)), w1 = 1.f - w0;
        if (lane == 0) {
            const unsigned p0 = atomicAdd(&cnt[e0], 1u), p1 = atomicAdd(&cnt[e1], 1u);
            list[e0 * T + p0] = t; list[e1 * T + p1] = t;
            te[2 * t] = e0; te[2 * t + 1] = e1; tp[2 * t] = (int)p0; tp[2 * t + 1] = (int)p1; tw[2 * t] = w0; tw[2 * t + 1] = w1;
        }
    }
}
__device__ __forceinline__ void moe_offsets(const Args& A, int L, LAS int* off, LAS int* cn) {
    if (threadIdx.x == 0) {
        const unsigned* cnt = (const unsigned*)(A.ws + WS_CTL) + CW_CNT + L * 64;
        int o = 0;
        for (int e = 0; e < 16; ++e) { const int c = (int)__hip_atomic_load(cnt + e, __ATOMIC_RELAXED, __HIP_MEMORY_SCOPE_AGENT); off[e] = o; cn[e] = c; o += (c + 255) & ~255; }
        off[16] = o;
    }
    __syncthreads();
}
__device__ __forceinline__ void phase_moe_gemm1(const Args& A, int L, LAS unsigned char* lds) {
    unsigned char* ws = A.ws;
    LAS int* off = (LAS int*)lds; LAS int* cn = off + 32;
    moe_offsets(A, L, off, cn);
    const bf16* XN = (const bf16*)(ws + WS_XN); const int* list = (const int*)(ws + WS_LIST); bf16* H = (bf16*)(ws + WS_H);
    const int nrt = off[16] / 128, nu = nrt * 3;
    for (int u = blockIdx.x; u < nu; u += gridDim.x) {
        const int rt = u / 3, pn = u % 3, s0 = rt * 128;
        int e = 0;
#pragma unroll
        for (int q = 1; q < 16; ++q) e += (s0 >= off[q]) ? 1 : 0;
        const int base = off[e], ce = cn[e]; const int* le = list + e * T;
        const bf16* W = (const bf16*)(ws + WS_WMIN) + (size_t)(L * 16 + e) * 768 * 1024;
        gemm_tile_v1([&](int r) { const int loc = r - base; const int tk = le[loc < ce ? loc : 0]; return XN + (size_t)tk * D; }, W, D, s0, pn * 256,
            [&](int row, int col, f32x4 g, f32x4 up) {
                f32x4 o;
#pragma unroll
                for (int q = 0; q < 4; ++q) o[q] = g[q] * sigmoidf_(g[q]) * up[q];
                st_bf16x4(H + (size_t)row * DEXP + pn * 128 + (col - pn * 256), o); });
    }
}
__device__ __forceinline__ void phase_moe_gemm2(const Args& A, int L, LAS unsigned char* lds) {
    unsigned char* ws = A.ws;
    LAS int* off = (LAS int*)lds; LAS int* cn = off + 32;
    moe_offsets(A, L, off, cn);
    const bf16* H = (const bf16*)(ws + WS_H); bf16* Y = (bf16*)(ws + WS_Y);
    const int nrt = off[16] / 128, nu = nrt * 4;
    for (int u = blockIdx.x; u < nu; u += gridDim.x) {
        const int rt = u >> 2, pn = u & 3, s0 = rt * 128;
        int e = 0;
#pragma unroll
        for (int q = 1; q < 16; ++q) e += (s0 >= off[q]) ? 1 : 0;
        const bf16* W = (const bf16*)(ws + WS_WMOUT) + (size_t)(L * 16 + e) * 1024 * DEXP;
        gemm_tile_v1([&](int r) { return H + (size_t)r * DEXP; }, W, DEXP, s0, pn * 256,
            [&](int row, int col, f32x4 v0, f32x4 v1) { st_bf16x4(Y + (size_t)row * D + col, v0); st_bf16x4(Y + (size_t)row * D + col + 128, v1); });
    }
}
__device__ __forceinline__ void phase_moe_combine(const Args& A, int L, LAS unsigned char* lds) {
    LAS int* off = (LAS int*)lds; LAS int* cn = off + 32;
    moe_offsets(A, L, off, cn);
    const int tid_ = opaque_tid(); const int wid = __builtin_amdgcn_readfirstlane(tid_ >> 6), lane = tid_ & 63; const int gw = blockIdx.x * 8 + wid, NGW = gridDim.x * 8;
    unsigned char* ws = A.ws;
    const int* te = (const int*)(ws + WS_TOK); const int* tp = te + 2 * T; const float* tw = (const float*)(tp + 2 * T);
    const bf16* Y = (const bf16*)(ws + WS_Y); bf16* XN = (bf16*)(ws + WS_XN);
    for (int t = gw; t < T; t += NGW) {
        const int sl0 = off[te[2 * t]] + tp[2 * t], sl1 = off[te[2 * t + 1]] + tp[2 * t + 1];
        const float w0 = tw[2 * t], w1 = tw[2 * t + 1];
        f32x4* xr = (f32x4*)(A.out + (size_t)t * D) + lane;
        const u32x2* y0 = (const u32x2*)(Y + (size_t)sl0 * D) + lane; const u32x2* y1 = (const u32x2*)(Y + (size_t)sl1 * D) + lane;
        f32x4 v[4]; float s = 0.f;
#pragma unroll
        for (int j = 0; j < 4; ++j) {
            v[j] = xr[64 * j]; const u32x2 a = y0[64 * j], c = y1[64 * j];
            v[j].x += w0 * bflo(a.x) + w1 * bflo(c.x); v[j].y += w0 * bfhi(a.x) + w1 * bfhi(c.x); v[j].z += w0 * bflo(a.y) + w1 * bflo(c.y); v[j].w += w0 * bfhi(a.y) + w1 * bfhi(c.y);
            xr[64 * j] = v[j];
            s += (v[j].x * v[j].x + v[j].y * v[j].y) + (v[j].z * v[j].z + v[j].w * v[j].w);
        }
        const float rstd = rsqrtf(wave_sum(s) * (1.f / 1024.f) + EPS);
        u32x2* o8 = (u32x2*)(XN + (size_t)t * D) + lane;
#pragma unroll
        for (int j = 0; j < 4; ++j) { u32x2 w; w.x = pk2(v[j].x * rstd, v[j].y * rstd); w.y = pk2(v[j].z * rstd, v[j].w * rstd); o8[64 * j] = w; }
    }
}

constexpr int PH_PER_EVEN = 5 + 8, PH_PER_ODD = 3 + 8;
constexpr int NPHASES = 3 + 2 * (PH_PER_EVEN + PH_PER_ODD);

__global__ void __launch_bounds__(512, 2) mk_fwd(Args A) {
    extern __shared__ __attribute__((aligned(16))) unsigned char lds_raw[];
    LAS unsigned char* lds = (LAS unsigned char*)lds_raw;
    volatile LAS unsigned* misc = (volatile LAS unsigned*)(lds + LDS_MISC);
    const int tid = threadIdx.x;
    if (tid < 16) misc[tid] = 0u;
    __syncthreads();
    const int lo = A.ph_lo, hi = A.ph_hi;
    XcdBarrier bar; bar.bar = (unsigned*)(A.ws + WS_CTL) + CW_BAR; bar.x = 0; bar.st = misc;
    if (hi - lo > 1) bar = xcd_barrier_post((unsigned*)(A.ws + WS_CTL) + CW_BAR, misc);
    int ph = 0;
#define PH_BEGIN if (ph >= lo && ph < hi) {
#define PH_END   if (ph + 1 < hi) xcd_barrier(bar); } ++ph;
    unsigned char* ws = A.ws;

    PH_BEGIN phase_prologue(A, lds); PH_END
    PH_BEGIN phase_kv_gemm(A); PH_END
    PH_BEGIN phase_knorm(A); PH_END

    for (int L = 0; L < DEPTH; ++L) {
        const int i = L >> 1;
        if ((L & 1) == 0) {
            PH_BEGIN {
                bf16* HY = (bf16*)(ws + WS_BIG);
                gemm_rows_v1((const bf16*)(ws + WS_XN), D, (const bf16*)(ws + WS_WHYB) + (size_t)i * HYN * D, D, T, HYN,
                    [&](int row, int col, f32x4 v0, f32x4 v1) { st_bf16x4(HY + (size_t)row * HYN + col, v0); st_bf16x4(HY + (size_t)row * HYN + col + 128, v1); });
            } PH_END
            PH_BEGIN phase_nsa_prep(A, i, lds); PH_END
            PH_BEGIN phase_nsa_attn(A, i, lds); PH_END
            PH_BEGIN phase_gla_seq(A, i, lds); PH_END
            PH_BEGIN {
                float* X = A.out;
                gemm_rows_v1((const bf16*)(ws + WS_CAT), D, (const bf16*)(ws + WS_WHOUT) + (size_t)i * D * D, D, T, D,
                    [&](int row, int col, f32x4 v0, f32x4 v1) { f32x4* p = (f32x4*)(X + (size_t)row * D + col); p[0] = p[0] + v0; p[32] = p[32] + v1; });
            } PH_END
        } else {
            PH_BEGIN {
                bf16* U = (bf16*)(ws + WS_U); bf16* V = (bf16*)(ws + WS_V);
                gemm_rows_v1((const bf16*)(ws + WS_XN), D, (const bf16*)(ws + WS_WSGIN) + (size_t)i * 4096 * D, D, T, 4096,
                    [&](int row, int col, f32x4 v0, f32x4 v1) {
                        f32x4 a, c;
#pragma unroll
                        for (int q = 0; q < 4; ++q) { a[q] = gelu_tanh(v0[q]); c[q] = gelu_tanh(v1[q]); }
                        bf16* dst = col < 2048 ? U + (size_t)row * 2048 + col : V + (size_t)row * 2048 + (col - 2048);
                        st_bf16x4(dst, a); st_bf16x4(dst + 128, c); });
            } PH_END
            PH_BEGIN phase_sgu_mix(A, i, lds); PH_END
            PH_BEGIN {
                float* X = A.out;
                gemm_rows_v1((const bf16*)(ws + WS_UM), 2048, (const bf16*)(ws + WS_WSGOUT) + (size_t)i * D * 2048, 2048, T, D,
                    [&](int row, int col, f32x4 v0, f32x4 v1) { f32x4* p = (f32x4*)(X + (size_t)row * D + col); p[0] = p[0] + v0; p[32] = p[32] + v1; });
            } PH_END
        }
        PH_BEGIN phase_rownorm(A); PH_END
        PH_BEGIN {
            bf16* QX = (bf16*)(ws + WS_QX);
            gemm_rows_v1((const bf16*)(ws + WS_XN), D, (const bf16*)(ws + WS_WQ) + (size_t)L * D * D, D, T, D,
                [&](int row, int col, f32x4 v0, f32x4 v1) { st_bf16x4(QX + (size_t)row * D + col, v0); st_bf16x4(QX + (size_t)row * D + col + 128, v1); });
        } PH_END
        PH_BEGIN phase_xattn(A, L, lds); PH_END
        PH_BEGIN {
            float* X = A.out;
            gemm_rows_v1((const bf16*)(ws + WS_OX), D, (const bf16*)(ws + WS_WO) + (size_t)L * D * D, D, T, D,
                [&](int row, int col, f32x4 v0, f32x4 v1) { f32x4* p = (f32x4*)(X + (size_t)row * D + col); p[0] = p[0] + v0; p[32] = p[32] + v1; });
        } PH_END
        PH_BEGIN phase_route(A, L); PH_END
        PH_BEGIN phase_moe_gemm1(A, L, lds); PH_END
        PH_BEGIN phase_moe_gemm2(A, L, lds); PH_END
        PH_BEGIN phase_moe_combine(A, L, lds); PH_END
    }
#undef PH_BEGIN
#undef PH_END
}

extern "C" void kernel_launch(void* const* d_in, const int* in_sizes, int n_in, void* d_out, int out_size, void* d_ws, size_t ws_size, hipStream_t stream) {
    static int grid = 0;
    if (grid == 0) {
        if (n_in != N_IN || out_size != T * D || ws_size < WS_END) { fprintf(stderr, "kernel_launch: unexpected problem (n_in %d, out %d, ws %zu)\n", n_in, out_size, ws_size); grid = -1; return; }
        int dev = 0, cus = 0, per_cu = 0;
        if (hipGetDevice(&dev) != hipSuccess || hipDeviceGetAttribute(&cus, hipDeviceAttributeMultiprocessorCount, dev) != hipSuccess) { grid = -1; return; }
        if (hipFuncSetAttribute((const void*)mk_fwd, hipFuncAttributeMaxDynamicSharedMemorySize, LDS_BYTES) != hipSuccess) { fprintf(stderr, "kernel_launch: hipFuncSetAttribute failed\n"); grid = -1; return; }
        if (hipOccupancyMaxActiveBlocksPerMultiprocessor(&per_cu, (const void*)mk_fwd, 512, LDS_BYTES) != hipSuccess || per_cu < 1) fprintf(stderr, "kernel_launch: occupancy query says %d\n", per_cu);
        (void)hipGetLastError();
        grid = cus;
    }
    if (grid < 0) return;
    (void)hipMemsetAsync((char*)d_ws + WS_CTL, 0, CTL_BYTES, stream);
    Args a{};
    for (int i = 0; i < N_IN; ++i) a.in[i] = (const float*)d_in[i];
    a.out = (float*)d_out; a.ws = (unsigned char*)d_ws;
    for (int j = 0; j < 32; ++j) a.freq[j] = (float)pow(10000.0, -(double)j / 32.0);
#if MK_ONE_LAUNCH
    a.ph_lo = 0; a.ph_hi = NPHASES;
    hipLaunchKernelGGL(mk_fwd, dim3(grid), dim3(512), LDS_BYTES, stream, a);
#else
    for (int p = 0; p < NPHASES; ++p) { a.ph_lo = p; a.ph_hi = p + 1; hipLaunchKernelGGL(mk_fwd, dim3(grid), dim3(512), LDS_BYTES, stream, a); }
#endif
}
```

```cpp
#include <hip/hip_runtime.h>
#include <stdint.h>
#include <stdio.h>
#include <math.h>

#ifndef MK_ONE_LAUNCH
#define MK_ONE_LAUNCH 1
#endif

#define LAS __attribute__((address_space(3)))
typedef unsigned short bf16;
typedef short bf16x8 __attribute__((ext_vector_type(8)));
typedef float f32x4 __attribute__((ext_vector_type(4)));
typedef float f32x2 __attribute__((ext_vector_type(2)));
typedef unsigned u32x4 __attribute__((ext_vector_type(4)));
typedef unsigned u32x2 __attribute__((ext_vector_type(2)));

constexpr int T = 16384, D = 1024, NBATCH = 8, S = 2048, DEPTH = 4;
constexpr int NMEM = 256;
constexpr float EPS = 1e-6f;
constexpr int HYN = 3072, HYSRC = 2856;
constexpr int C_QA = 0, C_KC = 512, C_VC = 640, C_KS = 768, C_VS = 896, C_KW = 1024, C_VW = 1152, C_QB = 1280, C_KB = 1536, C_VB = 1792, C_RB = 2304, C_GA = 2816, C_AL = 2840;
constexpr int NCMP = 127;
constexpr int NEXP = 16, DEXP = 384;
constexpr int SLOTS = 2 * T + NEXP * 256;

enum { I_X = 0, I_MEM, I_POS, I_NMIX, I_NXAT, I_NMEM, I_NFFN, I_HYBIN, I_HYBOUT, I_QNORM, I_KNORM, I_CMPPE, I_CMPW1, I_CMPW2, I_GATEB, I_WA2, I_BA, I_ONORM,
       I_SGIN, I_LNG, I_LNB, I_SGWS, I_SGBS, I_SGOUT, I_XWQ, I_XWKV, I_XWO, I_XQN, I_XKN, I_RW, I_RB, I_MOEIN, I_MOEOUT, N_IN };

constexpr size_t MiB = 1u << 20;
constexpr size_t WS_CTL = 0, CTL_BYTES = 1 * MiB;
constexpr size_t WS_WHYB = 1 * MiB;
constexpr size_t WS_WHOUT = WS_WHYB + 12 * MiB;
constexpr size_t WS_WSGIN = WS_WHOUT + 4 * MiB;
constexpr size_t WS_WSGOUT = WS_WSGIN + 16 * MiB;
constexpr size_t WS_WQ = WS_WSGOUT + 8 * MiB;
constexpr size_t WS_WKV = WS_WQ + 8 * MiB;
constexpr size_t WS_WO = WS_WKV + 16 * MiB;
constexpr size_t WS_WMIN = WS_WO + 8 * MiB;
constexpr size_t WS_WMOUT = WS_WMIN + 96 * MiB;
constexpr size_t WS_RW = WS_WMOUT + 48 * MiB;
constexpr size_t WS_XN = WS_RW + 1 * MiB;
constexpr size_t WS_BIG = WS_XN + 32 * MiB;
constexpr size_t WS_QA = WS_BIG + 128 * MiB;
constexpr size_t WS_KS = WS_QA + 16 * MiB;
constexpr size_t WS_KW = WS_KS + 4 * MiB;
constexpr size_t WS_KC = WS_KW + 4 * MiB;
constexpr size_t WS_VC = WS_KC + 1 * MiB;
constexpr size_t WS_CAT = WS_VC + 1 * MiB;
constexpr size_t WS_QX = WS_CAT + 32 * MiB;
constexpr size_t WS_OX = WS_QX + 32 * MiB;
constexpr size_t WS_MN = WS_OX + 32 * MiB;
constexpr size_t WS_KV = WS_MN + 4 * MiB;
constexpr size_t WS_COS = WS_KV + 32 * MiB;
constexpr size_t WS_SIN = WS_COS + 2 * MiB;
constexpr size_t WS_LIST = WS_SIN + 2 * MiB;
constexpr size_t WS_TOK = WS_LIST + 1 * MiB;
constexpr size_t WS_END = WS_TOK + 1 * MiB;
constexpr size_t WS_Y = WS_BIG, WS_H = WS_BIG + 72 * MiB, WS_U = WS_BIG, WS_V = WS_BIG + 64 * MiB, WS_UM = WS_QX;
constexpr int CW_BAR = 4096;
constexpr int CW_CNT = 8192;

constexpr int LDS_BYTES = 159744;
constexpr int LDS_MISC = LDS_BYTES - 64;

__device__ __forceinline__ unsigned f2bf(float f) { unsigned u = __float_as_uint(f); return (u + 0x7fffu + ((u >> 16) & 1u)) >> 16; }
__device__ __forceinline__ float bf2f(unsigned b) { return __uint_as_float(b << 16); }
__device__ __forceinline__ float bflo(unsigned w) { return __uint_as_float(w << 16); }
__device__ __forceinline__ float bfhi(unsigned w) { return __uint_as_float(w & 0xffff0000u); }
__device__ __forceinline__ unsigned pk2(float lo, float hi) { return f2bf(lo) | (f2bf(hi) << 16); }
__device__ __forceinline__ float wave_sum(float v) {
#pragma unroll
    for (int o = 1; o < 64; o <<= 1) v += __shfl_xor(v, o);
    return v;
}
__device__ __forceinline__ float wave_max(float v) {
#pragma unroll
    for (int o = 1; o < 64; o <<= 1) v = fmaxf(v, __shfl_xor(v, o));
    return v;
}
__device__ __forceinline__ int opaque_tid() { int t = threadIdx.x; asm volatile("" : "+v"(t)); return t; }
#define LDS_WAIT() asm volatile("s_waitcnt lgkmcnt(0)" ::: "memory")
__device__ __forceinline__ float gelu_tanh(float x) {
    const float u = 0.7978845608028654f * (x + 0.044715f * x * x * x);
    const float e = __expf(-2.0f * fabsf(u));
    float t = (1.0f - e) / (1.0f + e); t = u < 0.f ? -t : t;
    return 0.5f * x * (1.0f + t);
}
__device__ __forceinline__ float sigmoidf_(float x) { return 1.0f / (1.0f + __expf(-x)); }

#define XB_TMO      128
#define XB_XCNT(j)  (256  + 64 * (j))
#define XB_XSUB(j)  (1280 + 64 * (j))
#define XB_XGEN(j)  (2304 + 64 * (j))
#define XB_TOP      3328
#define XB_TOPGEN   3392
#define XCD_BAR_WORDS 3456
#define XB_SPIN_CAP (1u << 22)

__device__ __forceinline__ unsigned xb_ld(unsigned* p)              { return __hip_atomic_load(p, __ATOMIC_RELAXED, __HIP_MEMORY_SCOPE_AGENT); }
__device__ __forceinline__ unsigned xb_add(unsigned* p, unsigned v) { return __hip_atomic_fetch_add(p, v, __ATOMIC_RELAXED, __HIP_MEMORY_SCOPE_AGENT); }
__device__ __forceinline__ unsigned xb_xcc_id() { return (unsigned)__builtin_amdgcn_s_getreg((3 << 11) | 20) & 0xFu; }
#define XB_SPIN(cond, bar) do { unsigned _sp = 0; while (cond) { __builtin_amdgcn_s_sleep(1); \
    if ((++_sp & 255u) == 0u) { if (xb_ld(&(bar)[XB_TMO])) break; if (_sp > XB_SPIN_CAP) { atomicAdd(&(bar)[XB_TMO], 1u); break; } } } } while (0)

struct XcdBarrier { unsigned* bar; unsigned x; volatile LAS unsigned* st; };

__device__ __forceinline__ XcdBarrier xcd_barrier_post(unsigned* bar, volatile LAS unsigned* st) {
    XcdBarrier b; b.bar = bar; b.x = xb_xcc_id(); b.st = st;
    if (threadIdx.x == 0) (void)xb_add(&bar[XB_XCNT(b.x)], 1u);
    return b;
}
__device__ __forceinline__ void xcd_barrier_complete(unsigned* bar, unsigned x, unsigned& nloc, unsigned& nx) {
    const unsigned G = gridDim.x * gridDim.y * gridDim.z;
    unsigned sum, cnt, mine, sp = 0u;
    for (;;) {
        sum = 0u; cnt = 0u; mine = 0u;
#pragma unroll
        for (unsigned j = 0; j < 16; ++j) { const unsigned c = xb_ld(&bar[XB_XCNT(j)]); sum += c; cnt += (c > 0u) ? 1u : 0u; mine = (j == x) ? c : mine; }
        if (sum == G) break;
        __builtin_amdgcn_s_sleep(1);
        if ((++sp & 255u) == 0u) { if (xb_ld(&bar[XB_TMO])) break; if (sp > XB_SPIN_CAP) { atomicAdd(&bar[XB_TMO], 1u); break; } }
    }
    nloc = mine > 0u ? mine : 1u; nx = cnt > 0u ? cnt : 1u;
}
__device__ __forceinline__ void xcd_barrier(const XcdBarrier& b) {
    asm volatile("s_waitcnt vmcnt(0)" ::: "memory");
    __syncthreads();
    if (threadIdx.x == 0) {
        unsigned* bar = b.bar;
        __builtin_amdgcn_s_waitcnt(0);
        unsigned nloc = b.st[0], nx = b.st[1];
        if (nloc == 0u) { xcd_barrier_complete(bar, b.x, nloc, nx); b.st[0] = nloc; b.st[1] = nx; }
        const unsigned old = xb_add(&bar[XB_XSUB(b.x)], 1u);
        const unsigned gen = old / nloc;
        if (old + 1u == (gen + 1u) * nloc) {
            __builtin_amdgcn_fence(__ATOMIC_RELEASE, "agent");
            asm volatile("s_waitcnt vmcnt(0)" ::: "memory");
            const unsigned og = xb_add(&bar[XB_TOP], 1u);
            const unsigned tg = og / nx;
            if (og + 1u == (tg + 1u) * nx) xb_add(&bar[XB_TOPGEN], 1u);
            else XB_SPIN(xb_ld(&bar[XB_TOPGEN]) == tg, bar);
            __builtin_amdgcn_fence(__ATOMIC_ACQUIRE, "agent");
            xb_add(&bar[XB_XGEN(b.x)], 1u);
            asm volatile("s_waitcnt vmcnt(0)" ::: "memory");
        } else {
            XB_SPIN(xb_ld(&bar[XB_XGEN(b.x)]) == gen, bar);
            __builtin_amdgcn_fence(__ATOMIC_ACQUIRE, "agent");
            asm volatile("s_waitcnt vmcnt(0)" ::: "memory");
        }
    }
    __syncthreads();
}

struct Args {
    const float* in[N_IN];
    float* out;
    unsigned char* ws;
    float freq[32];
    int ph_lo, ph_hi;
};

template <class AF, class EF>
__device__ __forceinline__ void gemm_tile_v1(AF arow, const bf16* __restrict__ Bt, int K, int m0, int n0, EF epi) {
    const int tid = opaque_tid(), wid = __builtin_amdgcn_readfirstlane(tid >> 6), lane = tid & 63, wr = wid >> 2, wc = wid & 3, fr = lane & 15, fq = lane >> 4;
    f32x4 acc[4][2][2];
#pragma unroll
    for (int mi = 0; mi < 4; ++mi)
#pragma unroll
        for (int bj = 0; bj < 2; ++bj)
#pragma unroll
            for (int ni = 0; ni < 2; ++ni) acc[mi][bj][ni] = (f32x4){0.f, 0.f, 0.f, 0.f};
    const bf16* ap[4]; const bf16* bp[2][2];
#pragma unroll
    for (int mi = 0; mi < 4; ++mi) ap[mi] = arow(m0 + wr * 64 + mi * 16 + fr) + fq * 8;
#pragma unroll
    for (int bj = 0; bj < 2; ++bj)
#pragma unroll
        for (int ni = 0; ni < 2; ++ni) bp[bj][ni] = Bt + (size_t)(n0 + bj * 128 + wc * 32 + ni * 16 + fr) * K + fq * 8;
#pragma unroll 2
    for (int k0 = 0; k0 < K; k0 += 32) {
        bf16x8 a[4], b[2][2];
#pragma unroll
        for (int mi = 0; mi < 4; ++mi) a[mi] = *(const bf16x8*)(ap[mi] + k0);
#pragma unroll
        for (int bj = 0; bj < 2; ++bj)
#pragma unroll
            for (int ni = 0; ni < 2; ++ni) b[bj][ni] = *(const bf16x8*)(bp[bj][ni] + k0);
#pragma unroll
        for (int mi = 0; mi < 4; ++mi)
#pragma unroll
            for (int bj = 0; bj < 2; ++bj)
#pragma unroll
                for (int ni = 0; ni < 2; ++ni) acc[mi][bj][ni] = __builtin_amdgcn_mfma_f32_16x16x32_bf16(b[bj][ni], a[mi], acc[mi][bj][ni], 0, 0, 0);
    }
#pragma unroll
    for (int mi = 0; mi < 4; ++mi)
#pragma unroll
        for (int ni = 0; ni < 2; ++ni) epi(m0 + wr * 64 + mi * 16 + fr, n0 + wc * 32 + ni * 16 + 4 * fq, acc[mi][0][ni], acc[mi][1][ni]);
}
__device__ __forceinline__ void st_bf16x4(bf16* p, f32x4 v) { u32x2 w; w.x = pk2(v[0], v[1]); w.y = pk2(v[2], v[3]); *(u32x2*)p = w; }

__device__ __forceinline__ int hyb_colmap(int n) {
    if (n < 1280) return n;
    if (n < 1536) return 1304 + (n - 1280);
    if (n < 1792) return 1560 + (n - 1536);
    if (n < 2304) return 1816 + (n - 1792);
    if (n < 2816) return 2344 + (n - 2304);
    if (n < 2840) return 1280 + (n - 2816);
    if (n < 2856) return 2328 + (n - 2840);
    return -1;
}
__device__ __forceinline__ void tr_item(const float* __restrict__ W, int Nsrc, int K, bf16* __restrict__ Wt, const float* __restrict__ gain, int kind, int nblk, LAS float* scr, int item, int lane) {
    const int kb = item / nblk, nb = item % nblk, k0 = 64 * kb, n0 = 32 * nb;
    const int j = lane & 31, n = n0 + j;
    int col;
    if (kind == 0) col = n; else if (kind == 1) col = hyb_colmap(n); else { const int pn = n >> 8, r = n & 255; col = (r >> 7) * 384 + pn * 128 + (r & 127); }
#pragma unroll 8
    for (int i = 0; i < 32; ++i) {
        const int kk = 2 * i + (lane >> 5); float v = 0.f;
        if (col >= 0) { v = W[(size_t)(k0 + kk) * Nsrc + col]; if (gain) v *= gain[k0 + kk]; }
        scr[kk * 33 + j] = v;
    }
    LDS_WAIT();
    const int c = lane & 7;
#pragma unroll
    for (int jx = 0; jx < 4; ++jx) {
        const int nn = (lane >> 3) + 8 * jx; const LAS float* s = scr + (8 * c) * 33 + nn;
        u32x4 o; o.x = pk2(s[0 * 33], s[1 * 33]); o.y = pk2(s[2 * 33], s[3 * 33]); o.z = pk2(s[4 * 33], s[5 * 33]); o.w = pk2(s[6 * 33], s[7 * 33]);
        *(u32x4*)(Wt + (size_t)(n0 + nn) * K + k0 + 8 * c) = o;
    }
    LDS_WAIT();
}
__device__ __forceinline__ void rms_row_to_bf16(const float* __restrict__ xrow, bf16* __restrict__ orow, float* __restrict__ copy, int lane) {
    const f32x4* xr = (const f32x4*)xrow + lane;
    f32x4 v[4]; float s = 0.f;
#pragma unroll
    for (int j = 0; j < 4; ++j) { v[j] = xr[64 * j]; s += (v[j].x * v[j].x + v[j].y * v[j].y) + (v[j].z * v[j].z + v[j].w * v[j].w); }
    const float rstd = rsqrtf(wave_sum(s) * (1.f / 1024.f) + EPS);
    u32x2* o8 = (u32x2*)orow + lane;
#pragma unroll
    for (int j = 0; j < 4; ++j) { u32x2 w; w.x = pk2(v[j].x * rstd, v[j].y * rstd); w.y = pk2(v[j].z * rstd, v[j].w * rstd); o8[64 * j] = w; }
    if (copy) { f32x4* c4 = (f32x4*)copy + lane;
#pragma unroll
        for (int j = 0; j < 4; ++j) c4[64 * j] = v[j]; }
}

__device__ __forceinline__ void phase_prologue(const Args& A, LAS unsigned char* lds) {
    const int tid = opaque_tid(), wid = __builtin_amdgcn_readfirstlane(tid >> 6), lane = tid & 63;
    const int gw = blockIdx.x * 8 + wid, NGW = gridDim.x * 8;
    LAS float* scr = (LAS float*)(lds + wid * 16384);
    unsigned char* ws = A.ws;
    constexpr int N_HYB = 2 * 1536, N_HOUT = 2 * 512, N_SGIN = 2 * 2048, N_SGOUT = 2 * 1024, N_WQ = 4 * 512, N_WKV = 4 * 1024, N_WO = 4 * 512, N_MIN = 64 * 384, N_MOUT = 64 * 192;
    constexpr int NITEMS = N_HYB + N_HOUT + N_SGIN + N_SGOUT + N_WQ + N_WKV + N_WO + N_MIN + N_MOUT;
    for (int it = gw; it < NITEMS; it += NGW) {
        int r = it;
        if (r < N_HYB) { const int sl = r / 1536; tr_item(A.in[I_HYBIN] + (size_t)sl * 1024 * HYSRC, HYSRC, 1024, (bf16*)(ws + WS_WHYB) + (size_t)sl * HYN * 1024, A.in[I_NMIX] + (2 * sl) * 1024, 1, 96, scr, r % 1536, lane); continue; } r -= N_HYB;
        if (r < N_HOUT) { const int sl = r / 512; tr_item(A.in[I_HYBOUT] + (size_t)sl * 1024 * 1024, 1024, 1024, (bf16*)(ws + WS_WHOUT) + (size_t)sl * 1024 * 1024, nullptr, 0, 32, scr, r % 512, lane); continue; } r -= N_HOUT;
        if (r < N_SGIN) { const int sl = r / 2048; tr_item(A.in[I_SGIN] + (size_t)sl * 1024 * 4096, 4096, 1024, (bf16*)(ws + WS_WSGIN) + (size_t)sl * 4096 * 1024, A.in[I_NMIX] + (2 * sl + 1) * 1024, 0, 128, scr, r % 2048, lane); continue; } r -= N_SGIN;
        if (r < N_SGOUT) { const int sl = r / 1024; tr_item(A.in[I_SGOUT] + (size_t)sl * 2048 * 1024, 1024, 2048, (bf16*)(ws + WS_WSGOUT) + (size_t)sl * 1024 * 2048, nullptr, 0, 32, scr, r % 1024, lane); continue; } r -= N_SGOUT;
        if (r < N_WQ) { const int sl = r / 512; tr_item(A.in[I_XWQ] + (size_t)sl * 1024 * 1024, 1024, 1024, (bf16*)(ws + WS_WQ) + (size_t)sl * 1024 * 1024, A.in[I_NXAT] + sl * 1024, 0, 32, scr, r % 512, lane); continue; } r -= N_WQ;
        if (r < N_WKV) { const int sl = r / 1024; tr_item(A.in[I_XWKV] + (size_t)sl * 1024 * 2048, 2048, 1024, (bf16*)(ws + WS_WKV) + (size_t)sl * 2048 * 1024, A.in[I_NMEM] + sl * 1024, 0, 64, scr, r % 1024, lane); continue; } r -= N_WKV;
        if (r < N_WO) { const int sl = r / 512; tr_item(A.in[I_XWO] + (size_t)sl * 1024 * 1024, 1024, 1024, (bf16*)(ws + WS_WO) + (size_t)sl * 1024 * 1024, nullptr, 0, 32, scr, r % 512, lane); continue; } r -= N_WO;
        if (r < N_MIN) { const int sl = r / 384; tr_item(A.in[I_MOEIN] + (size_t)sl * 1024 * 768, 768, 1024, (bf16*)(ws + WS_WMIN) + (size_t)sl * 768 * 1024, A.in[I_NFFN] + (sl >> 4) * 1024, 2, 24, scr, r % 384, lane); continue; } r -= N_MIN;
        { const int sl = r / 192; tr_item(A.in[I_MOEOUT] + (size_t)sl * 384 * 1024, 1024, 384, (bf16*)(ws + WS_WMOUT) + (size_t)sl * 1024 * 384, nullptr, 0, 32, scr, r % 192, lane); }
    }
    for (int m = gw; m < T; m += NGW) rms_row_to_bf16(A.in[I_X] + (size_t)m * D, (bf16*)(ws + WS_XN) + (size_t)m * D, A.out + (size_t)m * D, lane);
    for (int m = gw; m < NBATCH * NMEM; m += NGW) rms_row_to_bf16(A.in[I_MEM] + (size_t)m * D, (bf16*)(ws + WS_MN) + (size_t)m * D, nullptr, lane);
    const int gt = blockIdx.x * 512 + tid, NGT = gridDim.x * 512;
    const int* pos = (const int*)A.in[I_POS];
    float* cosT = (float*)(ws + WS_COS); float* sinT = (float*)(ws + WS_SIN);
    for (int i = gt; i < T * 32; i += NGT) {
        const int t = i >> 5, j = i & 31;
        const float ang = (float)pos[t] * A.freq[j];
        const double rev = (double)ang * 0.15915494309189533577;
        const float fr = (float)(rev - rint(rev));
        cosT[i] = __builtin_amdgcn_cosf(fr); sinT[i] = __builtin_amdgcn_sinf(fr);
    }
    float* RW = (float*)(ws + WS_RW);
    for (int i = gt; i < DEPTH * NEXP * D; i += NGT) { const int k = i & 1023, e = (i >> 10) & 15, l = i >> 14; RW[i] = A.in[I_RW][k * NEXP + e] * A.in[I_NFFN][l * D + k]; }
}

__device__ __forceinline__ void phase_kv_gemm(const Args& A) {
    const bf16* MN = (const bf16*)(A.ws + WS_MN); const bf16* W = (const bf16*)(A.ws + WS_WKV); bf16* KV = (bf16*)(A.ws + WS_KV);
    constexpr int NT_N = 8192 / 256, NT = (2048 / 128) * NT_N;
    for (int u = blockIdx.x; u < NT; u += gridDim.x) {
        const int m0 = (u / NT_N) * 128, n0 = (u % NT_N) * 256;
        gemm_tile_v1([&](int r) { return MN + (size_t)r * D; }, W, D, m0, n0,
            [&](int row, int col, f32x4 v0, f32x4 v1) { st_bf16x4(KV + (size_t)row * 8192 + col, v0); st_bf16x4(KV + (size_t)row * 8192 + col + 128, v1); });
    }
}
__device__ __forceinline__ void phase_knorm(const Args& A) {
    const int tid_ = opaque_tid(); const int wid = __builtin_amdgcn_readfirstlane(tid_ >> 6), lane = tid_ & 63; const int gw = blockIdx.x * 8 + wid, NGW = gridDim.x * 8;
    bf16* KV = (bf16*)(A.ws + WS_KV);
    for (int it = gw; it < DEPTH * 2048 * 4; it += NGW) {
        const int h = it & 3, m = (it >> 2) & 2047, l = it >> 13;
        bf16* p = KV + (size_t)m * 8192 + l * 2048 + h * 256 + 4 * lane;
        const u32x2 w = *(const u32x2*)p;
        float x0 = bflo(w.x), x1 = bfhi(w.x), x2 = bflo(w.y), x3 = bfhi(w.y);
        const float rstd = rsqrtf(wave_sum(x0 * x0 + x1 * x1 + x2 * x2 + x3 * x3) * (1.f / 256.f) + EPS) * 0.0625f;
        const f32x4 g = *(const f32x4*)(A.in[I_XKN] + l * 256 + 4 * lane);
        u32x2 o; o.x = pk2(x0 * rstd * g.x, x1 * rstd * g.y); o.y = pk2(x2 * rstd * g.z, x3 * rstd * g.w);
        *(u32x2*)p = o;
    }
}

template <class EF>
__device__ __forceinline__ void gemm_rows_v1(const bf16* Am, int lda, const bf16* Bt, int K, int M, int N, EF epi) {
    const int ntn = N / 256, nt = (M / 128) * ntn;
    for (int u = blockIdx.x; u < nt; u += gridDim.x) {
        const int m0 = (u / ntn) * 128, n0 = (u % ntn) * 256;
        gemm_tile_v1([&](int r) { return Am + (size_t)r * lda; }, Bt, K, m0, n0, epi);
    }
}

__device__ __forceinline__ void phase_nsa_prep(const Args& A, int i, LAS unsigned char* lds) {
    const int tid_ = opaque_tid(); const int wid = __builtin_amdgcn_readfirstlane(tid_ >> 6), lane = tid_ & 63; const int gw = blockIdx.x * 8 + wid, NGW = gridDim.x * 8;
    unsigned char* ws = A.ws;
    const bf16* HY = (const bf16*)(ws + WS_BIG);
    const float* cosT = (const float*)(ws + WS_COS); const float* sinT = (const float*)(ws + WS_SIN);
    bf16* QA = (bf16*)(ws + WS_QA); bf16* KS = (bf16*)(ws + WS_KS); bf16* KW = (bf16*)(ws + WS_KW);
    LAS float* abuf = (LAS float*)(lds + wid * 8192);
    const int NIT = T + NBATCH * NCMP * 2 * 2;
    for (int it = gw; it < NIT; it += NGW) {
        if (it < T) {
            const int t = it;
            const float c = cosT[t * 32 + (lane & 31)], s = sinT[t * 32 + (lane & 31)];
#pragma unroll
            for (int u = 0; u < 12; ++u) {
                int src; const float* gain; bf16* dst; float scale;
                if (u < 8) { src = C_QA + 64 * u; gain = A.in[I_QNORM] + i * 64; dst = QA + (size_t)t * 512 + 64 * u; scale = 0.125f; }
                else if (u < 10) { src = C_KS + 64 * (u - 8); gain = A.in[I_KNORM] + (i * 3 + 1) * 64; dst = KS + (size_t)t * 128 + 64 * (u - 8); scale = 1.f; }
                else { src = C_KW + 64 * (u - 10); gain = A.in[I_KNORM] + (i * 3 + 2) * 64; dst = KW + (size_t)t * 128 + 64 * (u - 10); scale = 1.f; }
                const float x = bf2f(HY[(size_t)t * HYN + src + lane]);
                const float y = x * rsqrtf(wave_sum(x * x) * (1.f / 64.f) + EPS) * gain[lane] * scale;
                const float pr = __shfl_xor(y, 32);
                const float o = lane < 32 ? y * c - pr * s : y * c + pr * s;
                dst[lane] = (bf16)f2bf(o);
            }
        } else {
            const int r = it - T; const int kv = r & 1, g = (r >> 1) & 1, bn = r >> 2, n = bn % NCMP, b = bn / NCMP;
            const float* pe = A.in[I_CMPPE] + (size_t)(i * 2 + kv) * 32 * 64;
            const float* w1 = A.in[I_CMPW1] + (size_t)(i * 2 + kv) * 2048 * 64;
            const float* w2 = A.in[I_CMPW2] + (size_t)(i * 2 + kv) * 64 * 64;
            const int tok0 = b * S + 16 * n, coff = (kv ? C_VC : C_KC) + g * 64;
#pragma unroll 4
            for (int l = 0; l < 32; ++l) abuf[l * 64 + lane] = bf2f(HY[(size_t)(tok0 + l) * HYN + coff + lane]) + pe[l * 64 + lane];
            LDS_WAIT();
            float acc = 0.f;
#pragma unroll 8
            for (int k = 0; k < 2048; ++k) acc += abuf[k] * w1[k * 64 + lane];
            const float h = gelu_tanh(acc);
            float o = 0.f;
#pragma unroll 8
            for (int m = 0; m < 64; ++m) o += __shfl(h, m) * w2[m * 64 + lane];
            LDS_WAIT();
            const size_t oidx = ((size_t)(b * 128 + n) * 2 + g) * 64 + lane;
            if (kv == 0) {
                const float y = o * rsqrtf(wave_sum(o * o) * (1.f / 64.f) + EPS) * A.in[I_KNORM][(i * 3 + 0) * 64 + lane];
                const int tp = tok0 + 31;
                const float c = cosT[tp * 32 + (lane & 31)], s = sinT[tp * 32 + (lane & 31)];
                const float pr = __shfl_xor(y, 32);
                const float oo = lane < 32 ? y * c - pr * s : y * c + pr * s;
                ((bf16*)(ws + WS_KC))[oidx] = (bf16)f2bf(oo);
            } else ((bf16*)(ws + WS_VC))[oidx] = (bf16)f2bf(o);
        }
    }
}

__device__ __forceinline__ void nsa_block(const LAS float* qs, const bf16* __restrict__ krow, bool ok, const bf16* __restrict__ vbase, int vstride, int lane,
                                          float (&m)[4], float (&l)[4], float (&o)[4]) {
    float s[4] = {0.f, 0.f, 0.f, 0.f};
#pragma unroll 2
    for (int c = 0; c < 8; ++c) {
        const u32x4 kw = *(const u32x4*)(krow + 8 * c);
        const float k0 = bflo(kw.x), k1 = bfhi(kw.x), k2 = bflo(kw.y), k3 = bfhi(kw.y), k4 = bflo(kw.z), k5 = bfhi(kw.z), k6 = bflo(kw.w), k7 = bfhi(kw.w);
#pragma unroll
        for (int hh = 0; hh < 4; ++hh) {
            const f32x4 qa = *(const LAS f32x4*)(qs + hh * 64 + 8 * c), qb = *(const LAS f32x4*)(qs + hh * 64 + 8 * c + 4);
            s[hh] += (qa.x * k0 + qa.y * k1) + (qa.z * k2 + qa.w * k3) + (qb.x * k4 + qb.y * k5) + (qb.z * k6 + qb.w * k7);
        }
    }
    float p[4];
#pragma unroll
    for (int hh = 0; hh < 4; ++hh) {
        const float sv = ok ? s[hh] : -INFINITY;
        const float bm = wave_max(sv);
        const float mn = fmaxf(m[hh], bm);
        if (mn == -INFINITY) { p[hh] = 0.f; continue; }
        const float alpha = __expf(m[hh] - mn);
        p[hh] = ok ? __expf(sv - mn) : 0.f;
        l[hh] = l[hh] * alpha + wave_sum(p[hh]);
        o[hh] *= alpha; m[hh] = mn;
    }
#pragma unroll 8
    for (int kk = 0; kk < 64; ++kk) {
        const float v = bf2f(vbase[(size_t)kk * vstride + lane]);
#pragma unroll
        for (int hh = 0; hh < 4; ++hh) o[hh] += __shfl(p[hh], kk) * v;
    }
}
__device__ __forceinline__ void phase_nsa_attn(const Args& A, int i, LAS unsigned char* lds) {
    const int tid_ = opaque_tid(); const int wid = __builtin_amdgcn_readfirstlane(tid_ >> 6), lane0 = tid_ & 63; const int gw = blockIdx.x * 8 + wid, NGW = gridDim.x * 8;
    unsigned char* ws = A.ws;
    const bf16* HY = (const bf16*)(ws + WS_BIG); const bf16* QA = (const bf16*)(ws + WS_QA); const bf16* KS = (const bf16*)(ws + WS_KS); const bf16* KW = (const bf16*)(ws + WS_KW);
    const bf16* KC = (const bf16*)(ws + WS_KC); const bf16* VC = (const bf16*)(ws + WS_VC); bf16* CAT = (bf16*)(ws + WS_CAT);
    LAS float* qs = (LAS float*)(lds + wid * 2048);
    LAS float* ps = qs + 256;
    for (int it = gw; it < 2 * T; it += NGW) {
        int lane = lane0; asm volatile("" : "+v"(lane));
        const int tok = it >> 1, g = it & 1, b = tok >> 11, t = tok & 2047;
#pragma unroll
        for (int hh = 0; hh < 4; ++hh) qs[hh * 64 + lane] = bf2f(QA[(size_t)tok * 512 + (g * 4 + hh) * 64 + lane]);
        LDS_WAIT();
        const int ncv = t >= 31 ? ((t - 31) >> 4) + 1 : 0;
        float oc[4] = {0.f, 0.f, 0.f, 0.f};
        float psum0 = 0.f, psum1 = 0.f;
        {
            const bool v0 = lane < ncv, v1 = lane + 64 < ncv;
            const bf16* k0p = KC + ((size_t)(b * 128 + lane) * 2 + g) * 64;
            const bf16* k1p = KC + ((size_t)(b * 128 + (lane + 64 < 127 ? lane + 64 : 126)) * 2 + g) * 64;
            float s0[4] = {0.f, 0.f, 0.f, 0.f}, s1[4] = {0.f, 0.f, 0.f, 0.f};
#pragma unroll 2
            for (int c = 0; c < 8; ++c) {
                const u32x4 ka = *(const u32x4*)(k0p + 8 * c), kb = *(const u32x4*)(k1p + 8 * c);
#pragma unroll
                for (int hh = 0; hh < 4; ++hh) {
                    const f32x4 qa = *(const LAS f32x4*)(qs + hh * 64 + 8 * c), qb = *(const LAS f32x4*)(qs + hh * 64 + 8 * c + 4);
                    s0[hh] += (qa.x * bflo(ka.x) + qa.y * bfhi(ka.x)) + (qa.z * bflo(ka.y) + qa.w * bfhi(ka.y)) + (qb.x * bflo(ka.z) + qb.y * bfhi(ka.z)) + (qb.z * bflo(ka.w) + qb.w * bfhi(ka.w));
                    s1[hh] += (qa.x * bflo(kb.x) + qa.y * bfhi(kb.x)) + (qa.z * bflo(kb.y) + qa.w * bfhi(kb.y)) + (qb.x * bflo(kb.z) + qb.y * bfhi(kb.z)) + (qb.z * bflo(kb.w) + qb.w * bfhi(kb.w));
                }
            }
            float p0[4], p1[4];
#pragma unroll
            for (int hh = 0; hh < 4; ++hh) {
                const float a0 = v0 ? s0[hh] : -INFINITY, a1 = v1 ? s1[hh] : -INFINITY;
                const float mx = wave_max(fmaxf(a0, a1));
                if (ncv > 0) {
                    const float e0 = v0 ? __expf(a0 - mx) : 0.f, e1 = v1 ? __expf(a1 - mx) : 0.f;
                    const float inv = 1.0f / wave_sum(e0 + e1);
                    p0[hh] = e0 * inv; p1[hh] = e1 * inv;
                } else { p0[hh] = 0.f; p1[hh] = 0.f; }
                psum0 += p0[hh]; psum1 += p1[hh];
            }
#pragma unroll 2
            for (int c = 0; c < ncv; ++c) {
                const float v = bf2f(VC[((size_t)(b * 128 + c) * 2 + g) * 64 + lane]);
#pragma unroll
                for (int hh = 0; hh < 4; ++hh) oc[hh] += __shfl(c < 64 ? p0[hh] : p1[hh], c & 63) * v;
            }
        }
        ps[lane] = psum0; ps[64 + lane] = psum1;
        LDS_WAIT();
        const int cur = t >> 6;
        unsigned selmask;
        {
            const int j = lane & 31;
            float imp = ps[4 * j] + ps[4 * j + 1] + ps[4 * j + 2] + 0.5f * ps[4 * j + 3] + (j > 0 ? 0.5f * ps[4 * j - 1] : 0.f);
            const bool valid = j <= cur, forced = (j == 0) || (j == cur) || (j == cur - 1);
            const float score = valid ? imp + (forced ? 1000.0f : 0.f) : -INFINITY;
            int rank = 0;
#pragma unroll 8
            for (int jj = 0; jj < 32; ++jj) { const float sj = __shfl(score, jj); rank += (sj > score || (sj == score && jj < j)) ? 1 : 0; }
            const bool sel = valid && rank < 8 && lane < 32;
            selmask = (unsigned)__ballot(sel);
        }
        LDS_WAIT();
        float o1[4] = {0.f, 0.f, 0.f, 0.f}, o2[4] = {0.f, 0.f, 0.f, 0.f};
#pragma unroll 1
        for (int pass = 0; pass < 2; ++pass) {
            float oa[4] = {0.f, 0.f, 0.f, 0.f}, ma[4] = {-INFINITY, -INFINITY, -INFINITY, -INFINITY}, la[4] = {0.f, 0.f, 0.f, 0.f};
            const int lo = pass ? (t - 255 > 0 ? t - 255 : 0) : 0;
            const unsigned bm = pass ? 0xffffffffu : selmask;
            const bf16* Kb = pass ? KW : KS; const int vc = pass ? C_VW : C_VS;
#pragma unroll 1
            for (int j = lo >> 6; j <= cur; ++j) {
                if (!((bm >> j) & 1u)) continue;
                const int key = 64 * j + lane; const size_t kt = (size_t)(b * S + key);
                nsa_block(qs, Kb + kt * 128 + g * 64, key <= t && key >= lo, HY + (size_t)(b * S + 64 * j) * HYN + vc + g * 64, HYN, lane, ma, la, oa);
            }
            if (pass == 0) {
#pragma unroll
                for (int hh = 0; hh < 4; ++hh) o1[hh] = oa[hh] / la[hh];
            } else {
#pragma unroll
                for (int hh = 0; hh < 4; ++hh) o2[hh] = oa[hh] / la[hh];
            }
        }
#pragma unroll
        for (int hh = 0; hh < 4; ++hh) {
            const int head = g * 4 + hh;
            const float* gb = A.in[I_GATEB] + i * 24 + head * 3;
            const bf16* gl = HY + (size_t)tok * HYN + C_GA + head * 3;
            const float g0 = sigmoidf_(bf2f(gl[0]) + gb[0]), g1 = sigmoidf_(bf2f(gl[1]) + gb[1]), g2 = sigmoidf_(bf2f(gl[2]) + gb[2]);
            const float o = g0 * oc[hh] + g1 * o1[hh] + g2 * o2[hh];
            CAT[(size_t)tok * 1024 + head * 64 + lane] = (bf16)f2bf(o);
        }
    }
}

__device__ __forceinline__ void phase_gla_seq(const Args& A, int i, LAS unsigned char* lds) {
    const int tid = opaque_tid(), wid = __builtin_amdgcn_readfirstlane(tid >> 6), lane = tid & 63;
    unsigned char* ws = A.ws;
    const bf16* HY = (const bf16*)(ws + WS_BIG); bf16* CAT = (bf16*)(ws + WS_CAT);
    constexpr int CH = 16;
    LAS float* la = (LAS float*)lds;
    LAS float* lk = la + 4 * CH * 64;
    LAS float* lq = lk + 4 * CH * 64;
    LAS float* lo = lq + 4 * CH * 64;
    const float* wa2 = A.in[I_WA2] + i * 16 * 256; const float* ba = A.in[I_BA] + i * 256; const float* og = A.in[I_ONORM] + i * 128;
    for (int it = blockIdx.x; it < 8; it += gridDim.x) {
        const int pl = tid >> 7, v = tid & 127, p = it * 4 + pl, b = p >> 2, h = p & 3;
        float St[64];
#pragma unroll
        for (int k = 0; k < 64; ++k) St[k] = 0.f;
        for (int c0 = 0; c0 < S; c0 += CH) {
            __syncthreads();
            for (int e = tid; e < 4 * CH * 64; e += 512) {
                const int kk = e & 63, tk = (e >> 6) % CH, pp = e / (64 * CH); const int pb = (it * 4 + pp) >> 2, ph = (it * 4 + pp) & 3;
                const size_t tok = (size_t)pb * S + c0 + tk; const bf16* row = HY + tok * HYN;
                float z = ba[ph * 64 + kk];
#pragma unroll
                for (int r = 0; r < 16; ++r) z += bf2f(row[C_AL + r]) * wa2[r * 256 + ph * 64 + kk];
                const float ls_ = fminf(z, 0.f) - log1pf(__expf(-fabsf(z)));
                la[e] = __expf(ls_ * (1.f / 16.f));
                lk[e] = bf2f(row[C_KB + ph * 64 + kk]);
                lq[e] = bf2f(row[C_QB + ph * 64 + kk]) * 0.125f;
            }
            __syncthreads();
            for (int tk = 0; tk < CH; ++tk) {
                const size_t tok = (size_t)b * S + c0 + tk;
                const float vv = bf2f(HY[tok * HYN + C_VB + h * 128 + v]);
                const LAS float* pa = la + (pl * CH + tk) * 64; const LAS float* pk = lk + (pl * CH + tk) * 64; const LAS float* pq = lq + (pl * CH + tk) * 64;
                float o = 0.f;
#pragma unroll
                for (int k4 = 0; k4 < 16; ++k4) {
                    const f32x4 a4 = *(const LAS f32x4*)(pa + 4 * k4), k4v = *(const LAS f32x4*)(pk + 4 * k4), q4 = *(const LAS f32x4*)(pq + 4 * k4);
                    St[4 * k4 + 0] = a4.x * St[4 * k4 + 0] + k4v.x * vv; o += q4.x * St[4 * k4 + 0];
                    St[4 * k4 + 1] = a4.y * St[4 * k4 + 1] + k4v.y * vv; o += q4.y * St[4 * k4 + 1];
                    St[4 * k4 + 2] = a4.z * St[4 * k4 + 2] + k4v.z * vv; o += q4.z * St[4 * k4 + 2];
                    St[4 * k4 + 3] = a4.w * St[4 * k4 + 3] + k4v.w * vv; o += q4.w * St[4 * k4 + 3];
                }
                lo[(pl * CH + tk) * 128 + v] = o;
            }
            __syncthreads();
            for (int r = wid; r < 4 * CH; r += 8) {
                const int pp = r / CH, tk = r % CH; const int pb = (it * 4 + pp) >> 2, ph = (it * 4 + pp) & 3;
                const size_t tok = (size_t)pb * S + c0 + tk;
                const float x0 = lo[r * 128 + lane], x1 = lo[r * 128 + 64 + lane];
                const float rstd = rsqrtf(wave_sum(x0 * x0 + x1 * x1) * (1.f / 128.f) + EPS);
                const float r0 = bf2f(HY[tok * HYN + C_RB + ph * 128 + lane]), r1 = bf2f(HY[tok * HYN + C_RB + ph * 128 + 64 + lane]);
                CAT[tok * 1024 + 512 + ph * 128 + lane] = (bf16)f2bf(x0 * rstd * og[lane] * (r0 * sigmoidf_(r0)));
                CAT[tok * 1024 + 512 + ph * 128 + 64 + lane] = (bf16)f2bf(x1 * rstd * og[64 + lane] * (r1 * sigmoidf_(r1)));
            }
        }
        __syncthreads();
    }
}

__device__ __forceinline__ void phase_sgu_mix(const Args& A, int i, LAS unsigned char* lds) {
    const int tid = opaque_tid(), wid = __builtin_amdgcn_readfirstlane(tid >> 6), lane = tid & 63;
    unsigned char* ws = A.ws;
    const bf16* U = (const bf16*)(ws + WS_U); const bf16* V = (const bf16*)(ws + WS_V); bf16* UM = (bf16*)(ws + WS_UM);
    LAS float* vt = (LAS float*)lds;
    LAS float* st = vt + 128 * 256;
    const float* lng = A.in[I_LNG] + i * 2048; const float* lnb = A.in[I_LNB] + i * 2048;
    for (int it = blockIdx.x; it < NBATCH * 16 * 8; it += gridDim.x) {
        const int g = it & 7, n = (it >> 3) & 15, b = it >> 7;
        const size_t tok0 = (size_t)b * S + n * 128;
        __syncthreads();
        for (int s = wid * 16; s < wid * 16 + 16; ++s) {
            const u32x4* vr = (const u32x4*)(V + (tok0 + s) * 2048) + lane;
            float x[32]; float sum = 0.f;
#pragma unroll
            for (int j = 0; j < 4; ++j) { const u32x4 w = vr[64 * j];
                x[8 * j + 0] = bflo(w.x); x[8 * j + 1] = bfhi(w.x); x[8 * j + 2] = bflo(w.y); x[8 * j + 3] = bfhi(w.y); x[8 * j + 4] = bflo(w.z); x[8 * j + 5] = bfhi(w.z); x[8 * j + 6] = bflo(w.w); x[8 * j + 7] = bfhi(w.w); }
#pragma unroll
            for (int j = 0; j < 32; ++j) sum += x[j];
            const float mean = wave_sum(sum) * (1.f / 2048.f); float q = 0.f;
#pragma unroll
            for (int j = 0; j < 32; ++j) { const float d = x[j] - mean; q += d * d; }
            const float rstd = rsqrtf(wave_sum(q) * (1.f / 2048.f) + EPS);
            const u32x2 w = *((const u32x2*)(V + (tok0 + s) * 2048 + g * 256) + lane);
            const f32x4 gg = *(const f32x4*)(lng + g * 256 + 4 * lane), bb = *(const f32x4*)(lnb + g * 256 + 4 * lane);
            f32x4 o; o.x = (bflo(w.x) - mean) * rstd * gg.x + bb.x; o.y = (bfhi(w.x) - mean) * rstd * gg.y + bb.y; o.z = (bflo(w.y) - mean) * rstd * gg.z + bb.z; o.w = (bfhi(w.y) - mean) * rstd * gg.w + bb.w;
            *(LAS f32x4*)(vt + s * 256 + 4 * lane) = o;
            (void)st;
        }
        __syncthreads();
        const int c = tid & 255, th = tid >> 8;
        const float* wsg = A.in[I_SGWS] + (size_t)(i * 8 + g) * 128 * 128; const float* bsg = A.in[I_SGBS] + (i * 8 + g) * 128;
        for (int tt = 0; tt < 64; ++tt) {
            const int t = 2 * tt + th;
            const float* wr = wsg + t * 128;
            float acc = 0.f;
            for (int s = 0; s <= t; ++s) acc += wr[s] * vt[s * 256 + c];
            acc += bsg[t];
            const float u = bf2f(U[(tok0 + t) * 2048 + g * 256 + c]);
            UM[(tok0 + t) * 2048 + g * 256 + c] = (bf16)f2bf(u * acc);
        }
    }
    __syncthreads();
}

__device__ __forceinline__ void phase_rownorm(const Args& A) {
    const int tid_ = opaque_tid(); const int wid = __builtin_amdgcn_readfirstlane(tid_ >> 6), lane = tid_ & 63; const int gw = blockIdx.x * 8 + wid, NGW = gridDim.x * 8;
    for (int m = gw; m < T; m += NGW) rms_row_to_bf16(A.out + (size_t)m * D, (bf16*)(A.ws + WS_XN) + (size_t)m * D, nullptr, lane);
}

__device__ __forceinline__ void phase_xattn(const Args& A, int L, LAS unsigned char* lds) {
    const int tid = opaque_tid(), wid = __builtin_amdgcn_readfirstlane(tid >> 6), lane = tid & 63;
    unsigned char* ws = A.ws;
    const bf16* QX = (const bf16*)(ws + WS_QX); const bf16* KV = (const bf16*)(ws + WS_KV); bf16* OX = (bf16*)(ws + WS_OX);
    constexpr int KSTR = 129;
    LAS unsigned* kl = (LAS unsigned*)lds;
    LAS float* qb = (LAS float*)(lds + 132096) + wid * 256;
    LAS float* pb = (LAS float*)(lds + 132096 + 8192) + wid * 256;
    const float* qg = A.in[I_XQN] + L * 256;
    for (int it = blockIdx.x; it < NBATCH * 4 * 8; it += gridDim.x) {
        const int qc = it & 7, h = (it >> 3) & 3, b = it >> 5;
        __syncthreads();
        for (int e = tid; e < 256 * 128; e += 512) { const int m = e >> 7, dw = e & 127;
            kl[m * KSTR + dw] = *((const unsigned*)(KV + (size_t)(b * 256 + m) * 8192 + L * 2048 + h * 256) + dw); }
        __syncthreads();
        const bf16* Vb = KV + (size_t)(b * 256) * 8192 + L * 2048 + 1024 + h * 256;
        for (int tq = 0; tq < 32; ++tq) {
            const size_t tok = (size_t)b * S + qc * 256 + wid * 32 + tq;
            const u32x2 qw = *((const u32x2*)(QX + tok * 1024 + h * 256) + lane);
            const float q0 = bflo(qw.x), q1 = bfhi(qw.x), q2 = bflo(qw.y), q3 = bfhi(qw.y);
            const float rstd = rsqrtf(wave_sum(q0 * q0 + q1 * q1 + q2 * q2 + q3 * q3) * (1.f / 256.f) + EPS);
            const f32x4 gg = *(const f32x4*)(qg + 4 * lane);
            *(LAS f32x4*)(qb + 4 * lane) = (f32x4){q0 * rstd * gg.x, q1 * rstd * gg.y, q2 * rstd * gg.z, q3 * rstd * gg.w};
            LDS_WAIT();
            float s0 = 0.f, s1 = 0.f, s2 = 0.f, s3 = 0.f;
#pragma unroll 4
            for (int dw = 0; dw < 128; ++dw) {
                const f32x2 qq = *(const LAS f32x2*)(qb + 2 * dw);
                const unsigned k0 = kl[lane * KSTR + dw], k1 = kl[(lane + 64) * KSTR + dw], k2 = kl[(lane + 128) * KSTR + dw], k3 = kl[(lane + 192) * KSTR + dw];
                s0 += qq.x * bflo(k0) + qq.y * bfhi(k0); s1 += qq.x * bflo(k1) + qq.y * bfhi(k1);
                s2 += qq.x * bflo(k2) + qq.y * bfhi(k2); s3 += qq.x * bflo(k3) + qq.y * bfhi(k3);
            }
            const float mx = wave_max(fmaxf(fmaxf(s0, s1), fmaxf(s2, s3)));
            const float e0 = __expf(s0 - mx), e1 = __expf(s1 - mx), e2 = __expf(s2 - mx), e3 = __expf(s3 - mx);
            const float inv = 1.f / wave_sum((e0 + e1) + (e2 + e3));
            pb[lane] = e0 * inv; pb[lane + 64] = e1 * inv; pb[lane + 128] = e2 * inv; pb[lane + 192] = e3 * inv;
            LDS_WAIT();
            float o0 = 0.f, o1 = 0.f, o2 = 0.f, o3 = 0.f;
#pragma unroll 8
            for (int m = 0; m < 256; ++m) {
                const float p = pb[m];
                const u32x2 vw = *((const u32x2*)(Vb + (size_t)m * 8192) + lane);
                o0 += p * bflo(vw.x); o1 += p * bfhi(vw.x); o2 += p * bflo(vw.y); o3 += p * bfhi(vw.y);
            }
            u32x2 ow; ow.x = pk2(o0, o1); ow.y = pk2(o2, o3);
            *((u32x2*)(OX + tok * 1024 + h * 256) + lane) = ow;
            LDS_WAIT();
        }
    }
    __syncthreads();
}

__device__ __forceinline__ void phase_route(const Args& A, int L) {
    const int tid_ = opaque_tid(); const int wid = __builtin_amdgcn_readfirstlane(tid_ >> 6), lane = tid_ & 63; const int gw = blockIdx.x * 8 + wid, NGW = gridDim.x * 8;
    unsigned char* ws = A.ws;
    const float* RW = (const float*)(ws + WS_RW) + (size_t)L * NEXP * D; const float* rb = A.in[I_RB];
    unsigned* cnt = (unsigned*)(ws + WS_CTL) + CW_CNT + L * 64;
    int* list = (int*)(ws + WS_LIST); int* te = (int*)(ws + WS_TOK); int* tp = te + 2 * T; float* tw = (float*)(tp + 2 * T);
    bf16* XN = (bf16*)(ws + WS_XN);
    for (int t = gw; t < T; t += NGW) {
        const f32x4* xr = (const f32x4*)(A.out + (size_t)t * D) + lane;
        f32x4 v[4]; float s = 0.f;
#pragma unroll
        for (int j = 0; j < 4; ++j) { v[j] = xr[64 * j]; s += (v[j].x * v[j].x + v[j].y * v[j].y) + (v[j].z * v[j].z + v[j].w * v[j].w); }
        const float rstd = rsqrtf(wave_sum(s) * (1.f / 1024.f) + EPS);
        u32x2* o8 = (u32x2*)(XN + (size_t)t * D) + lane;
#pragma unroll
        for (int j = 0; j < 4; ++j) { u32x2 w; w.x = pk2(v[j].x * rstd, v[j].y * rstd); w.y = pk2(v[j].z * rstd, v[j].w * rstd); o8[64 * j] = w; }
        float mylg = -INFINITY;
#pragma unroll 2
        for (int e = 0; e < 16; ++e) {
            const f32x4* wr = (const f32x4*)(RW + e * D) + lane; float a = 0.f;
#pragma unroll
            for (int j = 0; j < 4; ++j) { const f32x4 w = wr[64 * j]; a += (v[j].x * w.x + v[j].y * w.y) + (v[j].z * w.z + v[j].w * w.w); }
            const float val = wave_sum(a) * rstd + rb[e];
            mylg = lane == e ? val : mylg;
        }
        const float v0 = wave_max(mylg);
        const int e0 = __ffsll((unsigned long long)__ballot(mylg == v0)) - 1;
        const int gidx = e0 >> 2;
        const float m2 = ((lane >> 2) == gidx && lane != e0 && lane < 16) ? mylg : -INFINITY;
        const float v1 = wave_max(m2);
        const int e1 = __ffsll((unsigned long long)__ballot(m2 == v1 && (lane >> 2) == gidx && lane != e0 && lane < 16)) - 1;
        const float w0 = 1.f / (1.f + __expf(v1 - v0)), w1 = 1.f - w0;
        if (lane == 0) {
            const unsigned p0 = atomicAdd(&cnt[e0], 1u), p1 = atomicAdd(&cnt[e1], 1u);
            list[e0 * T + p0] = t; list[e1 * T + p1] = t;
            te[2 * t] = e0; te[2 * t + 1] = e1; tp[2 * t] = (int)p0; tp[2 * t + 1] = (int)p1; tw[2 * t] = w0; tw[2 * t + 1] = w1;
        }
    }
}
__device__ __forceinline__ void moe_offsets(const Args& A, int L, LAS int* off, LAS int* cn) {
    if (threadIdx.x == 0) {
        const unsigned* cnt = (const unsigned*)(A.ws + WS_CTL) + CW_CNT + L * 64;
        int o = 0;
        for (int e = 0; e < 16; ++e) { const int c = (int)__hip_atomic_load(cnt + e, __ATOMIC_RELAXED, __HIP_MEMORY_SCOPE_AGENT); off[e] = o; cn[e] = c; o += (c + 255) & ~255; }
        off[16] = o;
    }
    __syncthreads();
}
__device__ __forceinline__ void phase_moe_gemm1(const Args& A, int L, LAS unsigned char* lds) {
    unsigned char* ws = A.ws;
    LAS int* off = (LAS int*)lds; LAS int* cn = off + 32;
    moe_offsets(A, L, off, cn);
    const bf16* XN = (const bf16*)(ws + WS_XN); const int* list = (const int*)(ws + WS_LIST); bf16* H = (bf16*)(ws + WS_H);
    const int nrt = off[16] / 128, nu = nrt * 3;
    for (int u = blockIdx.x; u < nu; u += gridDim.x) {
        const int rt = u / 3, pn = u % 3, s0 = rt * 128;
        int e = 0;
#pragma unroll
        for (int q = 1; q < 16; ++q) e += (s0 >= off[q]) ? 1 : 0;
        const int base = off[e], ce = cn[e]; const int* le = list + e * T;
        const bf16* W = (const bf16*)(ws + WS_WMIN) + (size_t)(L * 16 + e) * 768 * 1024;
        gemm_tile_v1([&](int r) { const int loc = r - base; const int tk = le[loc < ce ? loc : 0]; return XN + (size_t)tk * D; }, W, D, s0, pn * 256,
            [&](int row, int col, f32x4 g, f32x4 up) {
                f32x4 o;
#pragma unroll
                for (int q = 0; q < 4; ++q) o[q] = g[q] * sigmoidf_(g[q]) * up[q];
                st_bf16x4(H + (size_t)row * DEXP + pn * 128 + (col - pn * 256), o); });
    }
}
__device__ __forceinline__ void phase_moe_gemm2(const Args& A, int L, LAS unsigned char* lds) {
    unsigned char* ws = A.ws;
    LAS int* off = (LAS int*)lds; LAS int* cn = off + 32;
    moe_offsets(A, L, off, cn);
    const bf16* H = (const bf16*)(ws + WS_H); bf16* Y = (bf16*)(ws + WS_Y);
    const int nrt = off[16] / 128, nu = nrt * 4;
    for (int u = blockIdx.x; u < nu; u += gridDim.x) {
        const int rt = u >> 2, pn = u & 3, s0 = rt * 128;
        int e = 0;
#pragma unroll
        for (int q = 1; q < 16; ++q) e += (s0 >= off[q]) ? 1 : 0;
        const bf16* W = (const bf16*)(ws + WS_WMOUT) + (size_t)(L * 16 + e) * 1024 * DEXP;
        gemm_tile_v1([&](int r) { return H + (size_t)r * DEXP; }, W, DEXP, s0, pn * 256,
            [&](int row, int col, f32x4 v0, f32x4 v1) { st_bf16x4(Y + (size_t)row * D + col, v0); st_bf16x4(Y + (size_t)row * D + col + 128, v1); });
    }
}
__device__ __forceinline__ void phase_moe_combine(const Args& A, int L, LAS unsigned char* lds) {
    LAS int* off = (LAS int*)lds; LAS int* cn = off + 32;
    moe_offsets(A, L, off, cn);
    const int tid_ = opaque_tid(); const int wid = __builtin_amdgcn_readfirstlane(tid_ >> 6), lane = tid_ & 63; const int gw = blockIdx.x * 8 + wid, NGW = gridDim.x * 8;
    unsigned char* ws = A.ws;
    const int* te = (const int*)(ws + WS_TOK); const int* tp = te + 2 * T; const float* tw = (const float*)(tp + 2 * T);
    const bf16* Y = (const bf16*)(ws + WS_Y); bf16* XN = (bf16*)(ws + WS_XN);
    for (int t = gw; t < T; t += NGW) {
        const int sl0 = off[te[2 * t]] + tp[2 * t], sl1 = off[te[2 * t + 1]] + tp[2 * t + 1];
        const float w0 = tw[2 * t], w1 = tw[2 * t + 1];
        f32x4* xr = (f32x4*)(A.out + (size_t)t * D) + lane;
        const u32x2* y0 = (const u32x2*)(Y + (size_t)sl0 * D) + lane; const u32x2* y1 = (const u32x2*)(Y + (size_t)sl1 * D) + lane;
        f32x4 v[4]; float s = 0.f;
#pragma unroll
        for (int j = 0; j < 4; ++j) {
            v[j] = xr[64 * j]; const u32x2 a = y0[64 * j], c = y1[64 * j];
            v[j].x += w0 * bflo(a.x) + w1 * bflo(c.x); v[j].y += w0 * bfhi(a.x) + w1 * bfhi(c.x); v[j].z += w0 * bflo(a.y) + w1 * bflo(c.y); v[j].w += w0 * bfhi(a.y) + w1 * bfhi(c.y);
            xr[64 * j] = v[j];
            s += (v[j].x * v[j].x + v[j].y * v[j].y) + (v[j].z * v[j].z + v[j].w * v[j].w);
        }
        const float rstd = rsqrtf(wave_sum(s) * (1.f / 1024.f) + EPS);
        u32x2* o8 = (u32x2*)(XN + (size_t)t * D) + lane;
#pragma unroll
        for (int j = 0; j < 4; ++j) { u32x2 w; w.x = pk2(v[j].x * rstd, v[j].y * rstd); w.y = pk2(v[j].z * rstd, v[j].w * rstd); o8[64 * j] = w; }
    }
}

constexpr int PH_PER_EVEN = 5 + 8, PH_PER_ODD = 3 + 8;
constexpr int NPHASES = 3 + 2 * (PH_PER_EVEN + PH_PER_ODD);

__global__ void __launch_bounds__(512, 2) mk_fwd(Args A) {
    extern __shared__ __attribute__((aligned(16))) unsigned char lds_raw[];
    LAS unsigned char* lds = (LAS unsigned char*)lds_raw;
    volatile LAS unsigned* misc = (volatile LAS unsigned*)(lds + LDS_MISC);
    const int tid = threadIdx.x;
    if (tid < 16) misc[tid] = 0u;
    __syncthreads();
    const int lo = A.ph_lo, hi = A.ph_hi;
    XcdBarrier bar; bar.bar = (unsigned*)(A.ws + WS_CTL) + CW_BAR; bar.x = 0; bar.st = misc;
    if (hi - lo > 1) bar = xcd_barrier_post((unsigned*)(A.ws + WS_CTL) + CW_BAR, misc);
    int ph = 0;
#define PH_BEGIN if (ph >= lo && ph < hi) {
#define PH_END   if (ph + 1 < hi) xcd_barrier(bar); } ++ph;
    unsigned char* ws = A.ws;

    PH_BEGIN phase_prologue(A, lds); PH_END
    PH_BEGIN phase_kv_gemm(A); PH_END
    PH_BEGIN phase_knorm(A); PH_END

    for (int L = 0; L < DEPTH; ++L) {
        const int i = L >> 1;
        if ((L & 1) == 0) {
            PH_BEGIN {
                bf16* HY = (bf16*)(ws + WS_BIG);
                gemm_rows_v1((const bf16*)(ws + WS_XN), D, (const bf16*)(ws + WS_WHYB) + (size_t)i * HYN * D, D, T, HYN,
                    [&](int row, int col, f32x4 v0, f32x4 v1) { st_bf16x4(HY + (size_t)row * HYN + col, v0); st_bf16x4(HY + (size_t)row * HYN + col + 128, v1); });
            } PH_END
            PH_BEGIN phase_nsa_prep(A, i, lds); PH_END
            PH_BEGIN phase_nsa_attn(A, i, lds); PH_END
            PH_BEGIN phase_gla_seq(A, i, lds); PH_END
            PH_BEGIN {
                float* X = A.out;
                gemm_rows_v1((const bf16*)(ws + WS_CAT), D, (const bf16*)(ws + WS_WHOUT) + (size_t)i * D * D, D, T, D,
                    [&](int row, int col, f32x4 v0, f32x4 v1) { f32x4* p = (f32x4*)(X + (size_t)row * D + col); p[0] = p[0] + v0; p[32] = p[32] + v1; });
            } PH_END
        } else {
            PH_BEGIN {
                bf16* U = (bf16*)(ws + WS_U); bf16* V = (bf16*)(ws + WS_V);
                gemm_rows_v1((const bf16*)(ws + WS_XN), D, (const bf16*)(ws + WS_WSGIN) + (size_t)i * 4096 * D, D, T, 4096,
                    [&](int row, int col, f32x4 v0, f32x4 v1) {
                        f32x4 a, c;
#pragma unroll
                        for (int q = 0; q < 4; ++q) { a[q] = gelu_tanh(v0[q]); c[q] = gelu_tanh(v1[q]); }
                        bf16* dst = col < 2048 ? U + (size_t)row * 2048 + col : V + (size_t)row * 2048 + (col - 2048);
                        st_bf16x4(dst, a); st_bf16x4(dst + 128, c); });
            } PH_END
            PH_BEGIN phase_sgu_mix(A, i, lds); PH_END
            PH_BEGIN {
                float* X = A.out;
                gemm_rows_v1((const bf16*)(ws + WS_UM), 2048, (const bf16*)(ws + WS_WSGOUT) + (size_t)i * D * 2048, 2048, T, D,
                    [&](int row, int col, f32x4 v0, f32x4 v1) { f32x4* p = (f32x4*)(X + (size_t)row * D + col); p[0] = p[0] + v0; p[32] = p[32] + v1; });
            } PH_END
        }
        PH_BEGIN phase_rownorm(A); PH_END
        PH_BEGIN {
            bf16* QX = (bf16*)(ws + WS_QX);
            gemm_rows_v1((const bf16*)(ws + WS_XN), D, (const bf16*)(ws + WS_WQ) + (size_t)L * D * D, D, T, D,
                [&](int row, int col, f32x4 v0, f32x4 v1) { st_bf16x4(QX + (size_t)row * D + col, v0); st_bf16x4(QX + (size_t)row * D + col + 128, v1); });
        } PH_END
        PH_BEGIN phase_xattn(A, L, lds); PH_END
        PH_BEGIN {
            float* X = A.out;
            gemm_rows_v1((const bf16*)(ws + WS_OX), D, (const bf16*)(ws + WS_WO) + (size_t)L * D * D, D, T, D,
                [&](int row, int col, f32x4 v0, f32x4 v1) { f32x4* p = (f32x4*)(X + (size_t)row * D + col); p[0] = p[0] + v0; p[32] = p[32] + v1; });
        } PH_END
        PH_BEGIN phase_route(A, L); PH_END
        PH_BEGIN phase_moe_gemm1(A, L, lds); PH_END
        PH_BEGIN phase_moe_gemm2(A, L, lds); PH_END
        PH_BEGIN phase_moe_combine(A, L, lds); PH_END
    }
#undef PH_BEGIN
#undef PH_END
}

extern "C" void kernel_launch(void* const* d_in, const int* in_sizes, int n_in, void* d_out, int out_size, void* d_ws, size_t ws_size, hipStream_t stream) {
    static int grid = 0;
    if (grid == 0) {
        if (n_in != N_IN || out_size != T * D || ws_size < WS_END) { fprintf(stderr, "kernel_launch: unexpected problem (n_in %d, out %d, ws %zu)\n", n_in, out_size, ws_size); grid = -1; return; }
        int dev = 0, cus = 0, per_cu = 0;
        if (hipGetDevice(&dev) != hipSuccess || hipDeviceGetAttribute(&cus, hipDeviceAttributeMultiprocessorCount, dev) != hipSuccess) { grid = -1; return; }
        if (hipFuncSetAttribute((const void*)mk_fwd, hipFuncAttributeMaxDynamicSharedMemorySize, LDS_BYTES) != hipSuccess) { fprintf(stderr, "kernel_launch: hipFuncSetAttribute failed\n"); grid = -1; return; }
        if (hipOccupancyMaxActiveBlocksPerMultiprocessor(&per_cu, (const void*)mk_fwd, 512, LDS_BYTES) != hipSuccess || per_cu < 1) fprintf(stderr, "kernel_launch: occupancy query says %d\n", per_cu);
        (void)hipGetLastError();
        grid = cus;
    }
    if (grid < 0) return;
    (void)hipMemsetAsync((char*)d_ws + WS_CTL, 0, CTL_BYTES, stream);
    Args a{};
    for (int i = 0; i < N_IN; ++i) a.in[i] = (const float*)d_in[i];
    a.out = (float*)d_out; a.ws = (unsigned char*)d_ws;
    for (int j = 0; j < 32; ++j) a.freq[j] = (float)pow(10000.0, -(double)j / 32.0);
#if MK_ONE_LAUNCH
    a.ph_lo = 0; a.ph_hi = NPHASES;
    hipLaunchKernelGGL(mk_fwd, dim3(grid), dim3(512), LDS_BYTES, stream, a);
#else
    for (int p = 0; p < NPHASES; ++p) { a.ph_lo = p; a.ph_hi = p + 1; hipLaunchKernelGGL(mk_fwd, dim3(grid), dim3(512), LDS_BYTES, stream, a); }
#endif
}
```

```cpp
#include <hip/hip_runtime.h>
#include <stdint.h>
#include <stdio.h>
#include <math.h>

#ifndef PROBE_MASK
#define PROBE_MASK 0
#endif
#ifndef PROBE_REPS
#define PROBE_REPS 2
#endif
#ifndef MK_ONE_LAUNCH
#define MK_ONE_LAUNCH 1
#endif

#define LAS __attribute__((address_space(3)))
typedef unsigned short bf16;
typedef short bf16x8 __attribute__((ext_vector_type(8)));
typedef float f32x4 __attribute__((ext_vector_type(4)));
typedef float f32x2 __attribute__((ext_vector_type(2)));
typedef unsigned u32x4 __attribute__((ext_vector_type(4)));
typedef unsigned u32x2 __attribute__((ext_vector_type(2)));

constexpr int T = 16384, D = 1024, NBATCH = 8, S = 2048, DEPTH = 4;
constexpr int NMEM = 256;
constexpr float EPS = 1e-6f;
constexpr int HYN = 3072, HYSRC = 2856;
constexpr int C_QA = 0, C_KC = 512, C_VC = 640, C_KS = 768, C_VS = 896, C_KW = 1024, C_VW = 1152, C_QB = 1280, C_KB = 1536, C_VB = 1792, C_RB = 2304, C_GA = 2816, C_AL = 2840;
constexpr int NCMP = 127;
constexpr int NEXP = 16, DEXP = 384;
constexpr int SLOTS = 2 * T + NEXP * 256;

enum { I_X = 0, I_MEM, I_POS, I_NMIX, I_NXAT, I_NMEM, I_NFFN, I_HYBIN, I_HYBOUT, I_QNORM, I_KNORM, I_CMPPE, I_CMPW1, I_CMPW2, I_GATEB, I_WA2, I_BA, I_ONORM,
       I_SGIN, I_LNG, I_LNB, I_SGWS, I_SGBS, I_SGOUT, I_XWQ, I_XWKV, I_XWO, I_XQN, I_XKN, I_RW, I_RB, I_MOEIN, I_MOEOUT, N_IN };

constexpr size_t MiB = 1u << 20;
constexpr size_t WS_CTL = 0, CTL_BYTES = 1 * MiB;
constexpr size_t WS_WHYB = 1 * MiB;
constexpr size_t WS_WHOUT = WS_WHYB + 12 * MiB;
constexpr size_t WS_WSGIN = WS_WHOUT + 4 * MiB;
constexpr size_t WS_WSGOUT = WS_WSGIN + 16 * MiB;
constexpr size_t WS_WQ = WS_WSGOUT + 8 * MiB;
constexpr size_t WS_WKV = WS_WQ + 8 * MiB;
constexpr size_t WS_WO = WS_WKV + 16 * MiB;
constexpr size_t WS_WMIN = WS_WO + 8 * MiB;
constexpr size_t WS_WMOUT = WS_WMIN + 96 * MiB;
constexpr size_t WS_RW = WS_WMOUT + 48 * MiB;
constexpr size_t WS_XN = WS_RW + 1 * MiB;
constexpr size_t WS_BIG = WS_XN + 32 * MiB;
constexpr size_t WS_QA = WS_BIG + 128 * MiB;
constexpr size_t WS_KS = WS_QA + 16 * MiB;
constexpr size_t WS_KW = WS_KS + 4 * MiB;
constexpr size_t WS_KC = WS_KW + 4 * MiB;
constexpr size_t WS_VC = WS_KC + 1 * MiB;
constexpr size_t WS_CAT = WS_VC + 1 * MiB;
constexpr size_t WS_QX = WS_CAT + 32 * MiB;
constexpr size_t WS_OX = WS_QX + 32 * MiB;
constexpr size_t WS_MN = WS_OX + 32 * MiB;
constexpr size_t WS_KV = WS_MN + 4 * MiB;
constexpr size_t WS_COS = WS_KV + 32 * MiB;
constexpr size_t WS_SIN = WS_COS + 2 * MiB;
constexpr size_t WS_LIST = WS_SIN + 2 * MiB;
constexpr size_t WS_TOK = WS_LIST + 1 * MiB;
constexpr size_t WS_VT = WS_TOK + 1 * MiB;
constexpr size_t WS_END = WS_VT + 16 * MiB;
constexpr size_t WS_Y = WS_BIG, WS_H = WS_BIG + 72 * MiB, WS_U = WS_BIG, WS_V = WS_BIG + 64 * MiB, WS_UM = WS_QX;
constexpr int CW_BAR = 4096;
constexpr int CW_CNT = 8192;

constexpr int LDS_BYTES = 159744;
constexpr int LDS_MISC = LDS_BYTES - 64;

__device__ __forceinline__ unsigned f2bf(float f) { unsigned u = __float_as_uint(f); return (u + 0x7fffu + ((u >> 16) & 1u)) >> 16; }
__device__ __forceinline__ float bf2f(unsigned b) { return __uint_as_float(b << 16); }
__device__ __forceinline__ float bflo(unsigned w) { return __uint_as_float(w << 16); }
__device__ __forceinline__ float bfhi(unsigned w) { return __uint_as_float(w & 0xffff0000u); }
__device__ __forceinline__ unsigned pk2(float lo, float hi) { return f2bf(lo) | (f2bf(hi) << 16); }
__device__ __forceinline__ float wave_sum(float v) {
#pragma unroll
    for (int o = 1; o < 64; o <<= 1) v += __shfl_xor(v, o);
    return v;
}
__device__ __forceinline__ float wave_max(float v) {
#pragma unroll
    for (int o = 1; o < 64; o <<= 1) v = fmaxf(v, __shfl_xor(v, o));
    return v;
}
__device__ __forceinline__ int opaque_tid() { int t = threadIdx.x; asm volatile("" : "+v"(t)); return t; }
__device__ __forceinline__ unsigned char* opq(unsigned char* p) { asm volatile("" : "+s"(p)); return p; }
#define LDS_WAIT() asm volatile("s_waitcnt lgkmcnt(0)" ::: "memory")
__device__ __forceinline__ float gelu_tanh(float x) {
    const float u = 0.7978845608028654f * (x + 0.044715f * x * x * x);
    const float e = __expf(-2.0f * fabsf(u));
    float t = (1.0f - e) / (1.0f + e); t = u < 0.f ? -t : t;
    return 0.5f * x * (1.0f + t);
}
__device__ __forceinline__ float sigmoidf_(float x) { return 1.0f / (1.0f + __expf(-x)); }

#define XB_TMO      128
#define XB_XCNT(j)  (256  + 64 * (j))
#define XB_XSUB(j)  (1280 + 64 * (j))
#define XB_XGEN(j)  (2304 + 64 * (j))
#define XB_TOP      3328
#define XB_TOPGEN   3392
#define XCD_BAR_WORDS 3456
#define XB_SPIN_CAP (1u << 22)

__device__ __forceinline__ unsigned xb_ld(unsigned* p)              { return __hip_atomic_load(p, __ATOMIC_RELAXED, __HIP_MEMORY_SCOPE_AGENT); }
__device__ __forceinline__ unsigned xb_add(unsigned* p, unsigned v) { return __hip_atomic_fetch_add(p, v, __ATOMIC_RELAXED, __HIP_MEMORY_SCOPE_AGENT); }
__device__ __forceinline__ unsigned xb_xcc_id() { return (unsigned)__builtin_amdgcn_s_getreg((3 << 11) | 20) & 0xFu; }
#define XB_SPIN(cond, bar) do { unsigned _sp = 0; while (cond) { __builtin_amdgcn_s_sleep(1); \
    if ((++_sp & 255u) == 0u) { if (xb_ld(&(bar)[XB_TMO])) break; if (_sp > XB_SPIN_CAP) { atomicAdd(&(bar)[XB_TMO], 1u); break; } } } } while (0)

struct XcdBarrier { unsigned* bar; unsigned x; volatile LAS unsigned* st; };

__device__ __forceinline__ XcdBarrier xcd_barrier_post(unsigned* bar, volatile LAS unsigned* st) {
    XcdBarrier b; b.bar = bar; b.x = xb_xcc_id(); b.st = st;
    if (threadIdx.x == 0) (void)xb_add(&bar[XB_XCNT(b.x)], 1u);
    return b;
}
__device__ __forceinline__ void xcd_barrier_complete(unsigned* bar, unsigned x, unsigned& nloc, unsigned& nx) {
    const unsigned G = gridDim.x * gridDim.y * gridDim.z;
    unsigned sum, cnt, mine, sp = 0u;
    for (;;) {
        sum = 0u; cnt = 0u; mine = 0u;
#pragma unroll
        for (unsigned j = 0; j < 16; ++j) { const unsigned c = xb_ld(&bar[XB_XCNT(j)]); sum += c; cnt += (c > 0u) ? 1u : 0u; mine = (j == x) ? c : mine; }
        if (sum == G) break;
        __builtin_amdgcn_s_sleep(1);
        if ((++sp & 255u) == 0u) { if (xb_ld(&bar[XB_TMO])) break; if (sp > XB_SPIN_CAP) { atomicAdd(&bar[XB_TMO], 1u); break; } }
    }
    nloc = mine > 0u ? mine : 1u; nx = cnt > 0u ? cnt : 1u;
}
__device__ __forceinline__ void xcd_barrier(const XcdBarrier& b) {
    asm volatile("s_waitcnt vmcnt(0)" ::: "memory");
    __syncthreads();
    if (threadIdx.x == 0) {
        unsigned* bar = b.bar;
        __builtin_amdgcn_s_waitcnt(0);
        unsigned nloc = b.st[0], nx = b.st[1];
        if (nloc == 0u) { xcd_barrier_complete(bar, b.x, nloc, nx); b.st[0] = nloc; b.st[1] = nx; }
        const unsigned old = xb_add(&bar[XB_XSUB(b.x)], 1u);
        const unsigned gen = old / nloc;
        if (old + 1u == (gen + 1u) * nloc) {
            __builtin_amdgcn_fence(__ATOMIC_RELEASE, "agent");
            asm volatile("s_waitcnt vmcnt(0)" ::: "memory");
            const unsigned og = xb_add(&bar[XB_TOP], 1u);
            const unsigned tg = og / nx;
            if (og + 1u == (tg + 1u) * nx) xb_add(&bar[XB_TOPGEN], 1u);
            else XB_SPIN(xb_ld(&bar[XB_TOPGEN]) == tg, bar);
            __builtin_amdgcn_fence(__ATOMIC_ACQUIRE, "agent");
            xb_add(&bar[XB_XGEN(b.x)], 1u);
            asm volatile("s_waitcnt vmcnt(0)" ::: "memory");
        } else {
            XB_SPIN(xb_ld(&bar[XB_XGEN(b.x)]) == gen, bar);
            __builtin_amdgcn_fence(__ATOMIC_ACQUIRE, "agent");
            asm volatile("s_waitcnt vmcnt(0)" ::: "memory");
        }
    }
    __syncthreads();
}

struct Args {
    const float* in[N_IN];
    float* out;
    unsigned char* ws;
    float freq[32];
    int ph_lo, ph_hi;
};

typedef const __attribute__((address_space(4))) Args* KArgs;
__device__ __forceinline__ KArgs kargs() { KArgs p = (KArgs)__builtin_amdgcn_kernarg_segment_ptr(); asm volatile("" : "+s"(p)); return p; }

template <class AF, class EF>
__device__ __forceinline__ void gemm_tile_v1(AF arow, const bf16* __restrict__ Bt, int K, int m0, int n0, EF epi) {
    const int tid = opaque_tid(), wid = __builtin_amdgcn_readfirstlane(tid >> 6), lane = tid & 63, wr = wid >> 2, wc = wid & 3, fr = lane & 15, fq = lane >> 4;
    f32x4 acc[4][2][2];
#pragma unroll
    for (int mi = 0; mi < 4; ++mi)
#pragma unroll
        for (int bj = 0; bj < 2; ++bj)
#pragma unroll
            for (int ni = 0; ni < 2; ++ni) acc[mi][bj][ni] = (f32x4){0.f, 0.f, 0.f, 0.f};
    const bf16* ap[4]; const bf16* bp[2][2];
#pragma unroll
    for (int mi = 0; mi < 4; ++mi) ap[mi] = arow(m0 + wr * 64 + mi * 16 + fr) + fq * 8;
#pragma unroll
    for (int bj = 0; bj < 2; ++bj)
#pragma unroll
        for (int ni = 0; ni < 2; ++ni) bp[bj][ni] = Bt + (size_t)(n0 + bj * 128 + wc * 32 + ni * 16 + fr) * K + fq * 8;
#pragma unroll 2
    for (int k0 = 0; k0 < K; k0 += 32) {
        bf16x8 a[4], b[2][2];
#pragma unroll
        for (int mi = 0; mi < 4; ++mi) a[mi] = *(const bf16x8*)(ap[mi] + k0);
#pragma unroll
        for (int bj = 0; bj < 2; ++bj)
#pragma unroll
            for (int ni = 0; ni < 2; ++ni) b[bj][ni] = *(const bf16x8*)(bp[bj][ni] + k0);
#pragma unroll
        for (int mi = 0; mi < 4; ++mi)
#pragma unroll
            for (int bj = 0; bj < 2; ++bj)
#pragma unroll
                for (int ni = 0; ni < 2; ++ni) acc[mi][bj][ni] = __builtin_amdgcn_mfma_f32_16x16x32_bf16(b[bj][ni], a[mi], acc[mi][bj][ni], 0, 0, 0);
    }
#pragma unroll
    for (int mi = 0; mi < 4; ++mi)
#pragma unroll
        for (int ni = 0; ni < 2; ++ni) epi(m0 + wr * 64 + mi * 16 + fr, n0 + wc * 32 + ni * 16 + 4 * fq, acc[mi][0][ni], acc[mi][1][ni]);
}
__device__ __forceinline__ void st_bf16x4(bf16* p, f32x4 v) { u32x2 w; w.x = pk2(v[0], v[1]); w.y = pk2(v[2], v[3]); *(u32x2*)p = w; }


namespace pg8 {
constexpr int BM = 256, BK = 64, HALF = 128, HTB = HALF * BK * 2, STAGE_BYTES = 8 * HTB, NXCD = 8, WGM = 8;
__host__ __device__ __forceinline__ int lds_byte(int r, int c) { const int st = (r >> 4) * 2 + (c >> 5), rr = r & 15, cc = c & 31, ob = rr * 64 + cc * 2; return st * 1024 + (ob ^ (((ob >> 9) & 1) << 5)); }
__host__ __device__ __forceinline__ void stage_rc(int b, int& R, int& C) { const int st = b / 1024, sb = b % 1024, swz = sb ^ (((sb >> 9) & 1) << 5); R = (st >> 1) * 16 + swz / 64; C = (st & 1) * 32 + (swz % 64) / 2; }
__host__ __device__ __forceinline__ int perm32(int rho) { const int n = rho >> 4, i = rho & 15; return 8 * (i >> 2) + 4 * n + (i & 3); }
struct Unit { int pm, pn, e; };
struct DenseOrder {
    static constexpr bool GATHER = false;
    int nM, nN, nwg, G, c, K; const char* Bt;
    __device__ __forceinline__ void init(int M, int N, int K_, const bf16* Bt_, int G_, int c_) { nM = M / BM; nN = N / BM; nwg = nM * nN; G = G_; c = c_; K = K_; Bt = (const char*)Bt_; }
    __device__ __forceinline__ bool next(int i, Unit& u) const {
        const long L = (long)i * G + c; if (L >= nwg) return false;
        int wgid = (int)L; { const int q = nwg / NXCD, r = nwg % NXCD, xcd = wgid % NXCD, off = wgid / NXCD; wgid = (xcd < r ? xcd * (q + 1) : r * (q + 1) + (xcd - r) * q) + off; }
        const int nig = WGM * nN, gid = wgid / nig, fm = gid * WGM, gsz = (nM - fm) < WGM ? (nM - fm) : WGM;
        u.pm = fm + ((wgid % nig) % gsz); u.pn = (wgid % nig) / gsz; u.e = 0; return true;
    }
    __device__ __forceinline__ unsigned a_voff(const Unit& u, int half, int R) const { return (unsigned)((u.pm * BM + half * HALF + R) * K) * 2u; }
    __device__ __forceinline__ const char* b_tile(const Unit& u) const { return Bt + (size_t)u.pn * BM * K * 2; }
};
template <bool GATH> struct MoeOrder {
    static constexpr bool GATHER = GATH;
    int nunits, ntn, G, c, K; const LAS int* off; const LAS int* cn; const int* list; const char* Bt; size_t estride;
    __device__ __forceinline__ bool next(int i, Unit& u) const {
        const int L = i * G + c; if (L >= nunits) return false;
        u.pm = L / ntn; u.pn = L % ntn; const int s0 = u.pm * BM; int e = 0;
#pragma unroll
        for (int q = 1; q < 16; ++q) e += (s0 >= off[q]) ? 1 : 0;
        u.e = e; return true;
    }
    __device__ __forceinline__ unsigned a_voff(const Unit& u, int half, int R) const {
        const int slot = u.pm * BM + half * HALF + R;
        const int loc = slot - off[u.e]; const int tk = list[u.e * T + (loc < cn[u.e] ? loc : 0)];
        return (unsigned)(tk * K) * 2u;
    }
    __device__ __forceinline__ const char* b_tile(const Unit& u) const { return Bt + (size_t)u.e * estride + (size_t)u.pn * BM * K * 2; }
};
__device__ __forceinline__ unsigned cvt_pk_bf16(float lo, float hi) { unsigned r; asm volatile("v_cvt_pk_bf16_f32 %0, %1, %2" : "=v"(r) : "v"(lo), "v"(hi)); return r; }

template <class Epi, class Sched>
__device__ __forceinline__ void gemm_phase(LAS unsigned char* lds, const bf16* Aptr, int K, const Sched& S, const Epi& E) {
    const int tid = opaque_tid(), wid = __builtin_amdgcn_readfirstlane(tid >> 6), lane = tid & 63, wr = wid >> 2, wc = wid & 3, fr = lane & 15, fq = lane >> 4;
    const int nt = K / BK;
    int Rr[2], Cc[2]; unsigned voffA[2], voffB[2];
#pragma unroll
    for (int i = 0; i < 2; ++i) { stage_rc(tid * 16 + i * 8192, Rr[i], Cc[i]); const int Rb = Epi::PERM ? ((Rr[i] & ~31) + perm32(Rr[i] & 31)) : Rr[i];
        voffA[i] = (unsigned)(Rr[i] * K + Cc[i]) * 2u; voffB[i] = (unsigned)(Rb * K + Cc[i]) * 2u; }
    const size_t kstep = (size_t)(BK * 2);
    const size_t hstep = (size_t)HALF * K * 2;
    const size_t tstep = 2 * hstep;
    const unsigned ldsw = (unsigned)wid * 1024u;
    const int aoff = lds_byte(wr * 64 + fr, fq * 8), boff = lds_byte(wc * 32 + fr, fq * 8);
    const char* const Ab = (const char*)Aptr;
#define PG8_SA(b, h) (((b) * 2 + (h)) * HTB)
#define PG8_SB(b, h) ((4 + (b) * 2 + (h)) * HTB)
#define PG8_STAGE(bufoff, gbase, voff) do { _Pragma("unroll") for (int _i = 0; _i < 2; ++_i) \
        __builtin_amdgcn_global_load_lds((const unsigned*)((const char*)(gbase) + (voff)[_i]), (LAS unsigned*)(lds + (bufoff) + ldsw + _i * 8192), 16, 0, 0); } while (0)
#define PG8_STAGE_A(bufoff, usenext, h, kofs) do { \
        if constexpr (Sched::GATHER) { const char* gb_ = Ab + (kofs); unsigned vv_[2] = {(usenext) ? vN[h][0] : vA[h][0], (usenext) ? vN[h][1] : vA[h][1]}; PG8_STAGE(bufoff, gb_, vv_); } \
        else { const char* gb_ = ((usenext) ? nA : cA) + (size_t)(h) * hstep + (kofs); PG8_STAGE(bufoff, gb_, voffA); } } while (0)
#define PG8_LDA(dst, b, h) do { _Pragma("unroll") for (int m = 0; m < 4; ++m) _Pragma("unroll") for (int k = 0; k < 2; ++k) dst[m][k] = *(const LAS bf16x8*)(lds + PG8_SA(b, h) + aoff + m * 2048 + k * 1024); } while (0)
#define PG8_LDB(dst, b, h) do { _Pragma("unroll") for (int n = 0; n < 2; ++n) _Pragma("unroll") for (int k = 0; k < 2; ++k) dst[n][k] = *(const LAS bf16x8*)(lds + PG8_SB(b, h) + boff + n * 2048 + k * 1024); } while (0)
#define PG8_MMA(ai, bj, At, Bt) do { __builtin_amdgcn_s_setprio(1); _Pragma("unroll") for (int m = 0; m < 4; ++m) _Pragma("unroll") for (int n = 0; n < 2; ++n) _Pragma("unroll") for (int k = 0; k < 2; ++k) \
        acc[ai][bj][m][n] = __builtin_amdgcn_mfma_f32_16x16x32_bf16(Bt[n][k], At[m][k], acc[ai][bj][m][n], 0, 0, 0); __builtin_amdgcn_s_setprio(0); } while (0)
#define PG8_WAIT_V(n) asm volatile("s_waitcnt vmcnt(" #n ")" ::: "memory")
#define PG8_WAIT_L(n) asm volatile("s_waitcnt lgkmcnt(" #n ")" ::: "memory")
#define PG8_BAR __builtin_amdgcn_s_barrier()
#define PG8_SCHED __builtin_amdgcn_sched_barrier(0)
    Unit cur, nxt; int ui = 0;
    if (!S.next(0, cur)) return;
    f32x4 acc[2][2][4][2];
#pragma unroll
    for (int a = 0; a < 2; ++a)
#pragma unroll
        for (int b = 0; b < 2; ++b)
#pragma unroll
            for (int m = 0; m < 4; ++m)
#pragma unroll
                for (int n = 0; n < 2; ++n) acc[a][b][m][n] = (f32x4){0.f, 0.f, 0.f, 0.f};
    bf16x8 At[4][2], B0[2][2], B1[2][2];
    unsigned vA[2][2], vN[2][2];
    const char* cA = Ab; const char* nA = Ab;
    if constexpr (Sched::GATHER) {
#pragma unroll
        for (int h = 0; h < 2; ++h)
#pragma unroll
            for (int i = 0; i < 2; ++i) { vA[h][i] = S.a_voff(cur, h, Rr[i]) + (unsigned)Cc[i] * 2u; vN[h][i] = vA[h][i]; }
    } else { cA = Ab + (size_t)cur.pm * tstep; nA = cA; }
    const char* cB = S.b_tile(cur);
    PG8_STAGE(PG8_SB(0, 0), cB, voffB); PG8_STAGE_A(PG8_SA(0, 0), false, 0, 0); PG8_STAGE(PG8_SB(0, 1), cB + hstep, voffB); PG8_STAGE_A(PG8_SA(0, 1), false, 1, 0);
    if (wr == 1) PG8_BAR;
    PG8_WAIT_V(4); PG8_BAR;
    PG8_STAGE(PG8_SB(1, 0), cB + kstep, voffB); PG8_STAGE_A(PG8_SA(1, 0), false, 0, kstep); PG8_STAGE(PG8_SB(1, 1), cB + hstep + kstep, voffB);
    PG8_WAIT_V(6); PG8_BAR;
    for (;;) {
        const bool has_next = S.next(ui + 1, nxt);
        const char* nB = has_next ? S.b_tile(nxt) : cB;
        if constexpr (Sched::GATHER) {
#pragma unroll
            for (int h = 0; h < 2; ++h)
#pragma unroll
                for (int i = 0; i < 2; ++i) vN[h][i] = has_next ? S.a_voff(nxt, h, Rr[i]) + (unsigned)Cc[i] * 2u : vA[h][i];
        } else nA = has_next ? Ab + (size_t)nxt.pm * tstep : cA;
        for (int t = 0; t < nt; t += 2) {
            const bool last = (t == nt - 2);
            const size_t k1 = (size_t)(t + 1) * kstep, k2 = last ? 0 : (size_t)(t + 2) * kstep, k3 = k2 + kstep;
            const char* b2 = last ? nB : cB + (size_t)(t + 2) * kstep; const char* b3 = b2 + kstep;
            PG8_LDB(B0, 0, 0); PG8_SCHED; PG8_LDA(At, 0, 0); PG8_STAGE_A(PG8_SA(1, 1), false, 1, k1);
            PG8_WAIT_L(8); PG8_BAR; PG8_WAIT_L(0); PG8_MMA(0, 0, At, B0); PG8_BAR; PG8_SCHED;
            PG8_LDB(B1, 0, 1); PG8_STAGE(PG8_SB(0, 0), b2, voffB);
            PG8_BAR; PG8_WAIT_L(0); PG8_MMA(0, 1, At, B1); PG8_BAR;
            PG8_LDA(At, 0, 1); PG8_STAGE_A(PG8_SA(0, 0), last, 0, k2);
            PG8_BAR; PG8_WAIT_L(0); PG8_MMA(1, 0, At, B0); PG8_BAR; PG8_SCHED;
            PG8_STAGE(PG8_SB(0, 1), b2 + hstep, voffB);
            PG8_WAIT_V(6); PG8_BAR; PG8_MMA(1, 1, At, B1); PG8_BAR;
            PG8_LDB(B0, 1, 0); PG8_SCHED; PG8_LDA(At, 1, 0); PG8_STAGE_A(PG8_SA(0, 1), last, 1, k2);
            PG8_WAIT_L(8); PG8_BAR; PG8_WAIT_L(0); PG8_MMA(0, 0, At, B0); PG8_BAR; PG8_SCHED;
            PG8_LDB(B1, 1, 1); PG8_STAGE(PG8_SB(1, 0), b3, voffB);
            PG8_BAR; PG8_WAIT_L(0); PG8_MMA(0, 1, At, B1); PG8_BAR;
            PG8_LDA(At, 1, 1); PG8_STAGE_A(PG8_SA(1, 0), last, 0, k3);
            PG8_BAR; PG8_WAIT_L(0); PG8_MMA(1, 0, At, B0); PG8_BAR; PG8_SCHED;
            PG8_STAGE(PG8_SB(1, 1), b3 + hstep, voffB);
            PG8_WAIT_V(6); PG8_BAR; PG8_MMA(1, 1, At, B1); PG8_BAR;
        }
        E(acc, cur, wr, wc, fr, fq);
        if (!has_next) break;
#pragma unroll
        for (int a = 0; a < 2; ++a)
#pragma unroll
            for (int b = 0; b < 2; ++b)
#pragma unroll
                for (int m = 0; m < 4; ++m)
#pragma unroll
                    for (int n = 0; n < 2; ++n) acc[a][b][m][n] = (f32x4){0.f, 0.f, 0.f, 0.f};
        cur = nxt; cB = nB; cA = nA; ++ui;
        if constexpr (Sched::GATHER) {
#pragma unroll
            for (int h = 0; h < 2; ++h)
#pragma unroll
                for (int i = 0; i < 2; ++i) vA[h][i] = vN[h][i];
        }
    }
    PG8_WAIT_V(0);
    if (wr == 0) PG8_BAR;
    PG8_BAR;
#undef PG8_SA
#undef PG8_SB
#undef PG8_STAGE
#undef PG8_STAGE_A
#undef PG8_LDA
#undef PG8_LDB
#undef PG8_MMA
#undef PG8_WAIT_V
#undef PG8_WAIT_L
#undef PG8_BAR
#undef PG8_SCHED
}
template <int ACT> struct EpiBf16 {
    static constexpr bool PERM = true;
    bf16* O; int ldc; int tpt; size_t tstride;
    __device__ __forceinline__ void operator()(const f32x4 (&acc)[2][2][4][2], const Unit& u, int wr, int wc, int fr, int fq) const {
        const int row0 = u.pm * BM + wr * 64 + fr; const int tt = u.pn / tpt; bf16* base = O + (size_t)tt * tstride; const int col0 = (u.pn - tt * tpt) * BM + wc * 32 + 8 * fq;
#pragma unroll
        for (int ai = 0; ai < 2; ++ai)
#pragma unroll
            for (int m = 0; m < 4; ++m) { bf16* rowp = base + (size_t)(row0 + ai * HALF + m * 16) * ldc + col0;
#pragma unroll
                for (int bj = 0; bj < 2; ++bj) { f32x4 v0 = acc[ai][bj][m][0], v1 = acc[ai][bj][m][1];
                    if (ACT == 1) {
#pragma unroll
                        for (int q = 0; q < 4; ++q) { v0[q] = gelu_tanh(v0[q]); v1[q] = gelu_tanh(v1[q]); } }
                    u32x4 w; w.x = cvt_pk_bf16(v0[0], v0[1]); w.y = cvt_pk_bf16(v0[2], v0[3]); w.z = cvt_pk_bf16(v1[0], v1[1]); w.w = cvt_pk_bf16(v1[2], v1[3]);
                    *(u32x4*)(rowp + bj * HALF) = w; } }
    }
};
struct EpiResAdd {
    static constexpr bool PERM = false;
    float* X; int ldc;
    __device__ __forceinline__ void operator()(const f32x4 (&acc)[2][2][4][2], const Unit& u, int wr, int wc, int fr, int fq) const {
        const int row0 = u.pm * BM + wr * 64 + fr, col0 = u.pn * BM + wc * 32 + 4 * fq;
#pragma unroll
        for (int ai = 0; ai < 2; ++ai)
#pragma unroll
            for (int m = 0; m < 4; ++m) { float* rowp = X + (size_t)(row0 + ai * HALF + m * 16) * ldc + col0;
#pragma unroll
                for (int bj = 0; bj < 2; ++bj)
#pragma unroll
                    for (int n = 0; n < 2; ++n) { f32x4* p = (f32x4*)(rowp + bj * HALF + n * 16); *p = *p + acc[ai][bj][m][n]; } }
    }
};
struct EpiSwiglu {
    static constexpr bool PERM = true;
    bf16* H; int ldc;
    __device__ __forceinline__ void operator()(const f32x4 (&acc)[2][2][4][2], const Unit& u, int wr, int wc, int fr, int fq) const {
        const int row0 = u.pm * BM + wr * 64 + fr, col0 = u.pn * HALF + wc * 32 + 8 * fq;
#pragma unroll
        for (int ai = 0; ai < 2; ++ai)
#pragma unroll
            for (int m = 0; m < 4; ++m) {
                float o[8];
#pragma unroll
                for (int n = 0; n < 2; ++n)
#pragma unroll
                    for (int q = 0; q < 4; ++q) { const float g = acc[ai][0][m][n][q]; o[4 * n + q] = g * sigmoidf_(g) * acc[ai][1][m][n][q]; }
                u32x4 w; w.x = cvt_pk_bf16(o[0], o[1]); w.y = cvt_pk_bf16(o[2], o[3]); w.z = cvt_pk_bf16(o[4], o[5]); w.w = cvt_pk_bf16(o[6], o[7]);
                *(u32x4*)(H + (size_t)(row0 + ai * HALF + m * 16) * ldc + col0) = w; }
    }
};
}

__device__ __forceinline__ int hyb_colmap(int n) {
    if (n < 1280) return n;
    if (n < 1536) return 1304 + (n - 1280);
    if (n < 1792) return 1560 + (n - 1536);
    if (n < 2304) return 1816 + (n - 1792);
    if (n < 2816) return 2344 + (n - 2304);
    if (n < 2840) return 1280 + (n - 2816);
    if (n < 2856) return 2328 + (n - 2840);
    return -1;
}
__device__ __forceinline__ void tr_item(const float* __restrict__ W, int Nsrc, int K, bf16* __restrict__ Wt, const float* __restrict__ gain, int kind, int nblk, LAS float* scr, int item, int lane) {
    const int kb = item / nblk, nb = item % nblk, k0 = 64 * kb, n0 = 32 * nb;
    const int j = lane & 31, n = n0 + j;
    int col;
    if (kind == 0) col = n; else if (kind == 1) col = hyb_colmap(n); else { const int pn = n >> 8, r = n & 255; col = (r >> 7) * 384 + pn * 128 + (r & 127); }
#pragma unroll 8
    for (int i = 0; i < 32; ++i) {
        const int kk = 2 * i + (lane >> 5); float v = 0.f;
        if (col >= 0) { v = W[(size_t)(k0 + kk) * Nsrc + col]; if (gain) v *= gain[k0 + kk]; }
        scr[kk * 33 + j] = v;
    }
    LDS_WAIT();
    const int c = lane & 7;
#pragma unroll
    for (int jx = 0; jx < 4; ++jx) {
        const int nn = (lane >> 3) + 8 * jx; const LAS float* s = scr + (8 * c) * 33 + nn;
        u32x4 o; o.x = pk2(s[0 * 33], s[1 * 33]); o.y = pk2(s[2 * 33], s[3 * 33]); o.z = pk2(s[4 * 33], s[5 * 33]); o.w = pk2(s[6 * 33], s[7 * 33]);
        *(u32x4*)(Wt + (size_t)(n0 + nn) * K + k0 + 8 * c) = o;
    }
    LDS_WAIT();
}
__device__ __forceinline__ void rms_row_to_bf16(const float* __restrict__ xrow, bf16* __restrict__ orow, float* __restrict__ copy, int lane) {
    const f32x4* xr = (const f32x4*)xrow + lane;
    f32x4 v[4]; float s = 0.f;
#pragma unroll
    for (int j = 0; j < 4; ++j) { v[j] = xr[64 * j]; s += (v[j].x * v[j].x + v[j].y * v[j].y) + (v[j].z * v[j].z + v[j].w * v[j].w); }
    const float rstd = rsqrtf(wave_sum(s) * (1.f / 1024.f) + EPS);
    u32x2* o8 = (u32x2*)orow + lane;
#pragma unroll
    for (int j = 0; j < 4; ++j) { u32x2 w; w.x = pk2(v[j].x * rstd, v[j].y * rstd); w.y = pk2(v[j].z * rstd, v[j].w * rstd); o8[64 * j] = w; }
    if (copy) { f32x4* c4 = (f32x4*)copy + lane;
#pragma unroll
        for (int j = 0; j < 4; ++j) c4[64 * j] = v[j]; }
}

__device__ __forceinline__ void phase_prologue(KArgs A, LAS unsigned char* lds) {
    const int tid = opaque_tid(), wid = __builtin_amdgcn_readfirstlane(tid >> 6), lane = tid & 63;
    const int gw = blockIdx.x * 8 + wid, NGW = gridDim.x * 8;
    LAS float* scr = (LAS float*)(lds + wid * 16384);
    unsigned char* ws = opq(A->ws);
    constexpr int N_HYB = 2 * 1536, N_HOUT = 2 * 512, N_SGIN = 2 * 2048, N_SGOUT = 2 * 1024, N_WQ = 4 * 512, N_WKV = 4 * 1024, N_WO = 4 * 512, N_MIN = 64 * 384, N_MOUT = 64 * 192;
    constexpr int NITEMS = N_HYB + N_HOUT + N_SGIN + N_SGOUT + N_WQ + N_WKV + N_WO + N_MIN + N_MOUT;
    for (int it = gw; it < NITEMS; it += NGW) {
        int r = it;
        if (r < N_HYB) { const int sl = r / 1536; tr_item(A->in[I_HYBIN] + (size_t)sl * 1024 * HYSRC, HYSRC, 1024, (bf16*)(ws + WS_WHYB) + (size_t)sl * HYN * 1024, A->in[I_NMIX] + (2 * sl) * 1024, 1, 96, scr, r % 1536, lane); continue; } r -= N_HYB;
        if (r < N_HOUT) { const int sl = r / 512; tr_item(A->in[I_HYBOUT] + (size_t)sl * 1024 * 1024, 1024, 1024, (bf16*)(ws + WS_WHOUT) + (size_t)sl * 1024 * 1024, nullptr, 0, 32, scr, r % 512, lane); continue; } r -= N_HOUT;
        if (r < N_SGIN) { const int sl = r / 2048; tr_item(A->in[I_SGIN] + (size_t)sl * 1024 * 4096, 4096, 1024, (bf16*)(ws + WS_WSGIN) + (size_t)sl * 4096 * 1024, A->in[I_NMIX] + (2 * sl + 1) * 1024, 0, 128, scr, r % 2048, lane); continue; } r -= N_SGIN;
        if (r < N_SGOUT) { const int sl = r / 1024; tr_item(A->in[I_SGOUT] + (size_t)sl * 2048 * 1024, 1024, 2048, (bf16*)(ws + WS_WSGOUT) + (size_t)sl * 1024 * 2048, nullptr, 0, 32, scr, r % 1024, lane); continue; } r -= N_SGOUT;
        if (r < N_WQ) { const int sl = r / 512; tr_item(A->in[I_XWQ] + (size_t)sl * 1024 * 1024, 1024, 1024, (bf16*)(ws + WS_WQ) + (size_t)sl * 1024 * 1024, A->in[I_NXAT] + sl * 1024, 0, 32, scr, r % 512, lane); continue; } r -= N_WQ;
        if (r < N_WKV) { const int sl = r / 1024; tr_item(A->in[I_XWKV] + (size_t)sl * 1024 * 2048, 2048, 1024, (bf16*)(ws + WS_WKV) + (size_t)sl * 2048 * 1024, A->in[I_NMEM] + sl * 1024, 0, 64, scr, r % 1024, lane); continue; } r -= N_WKV;
        if (r < N_WO) { const int sl = r / 512; tr_item(A->in[I_XWO] + (size_t)sl * 1024 * 1024, 1024, 1024, (bf16*)(ws + WS_WO) + (size_t)sl * 1024 * 1024, nullptr, 0, 32, scr, r % 512, lane); continue; } r -= N_WO;
        if (r < N_MIN) { const int sl = r / 384; tr_item(A->in[I_MOEIN] + (size_t)sl * 1024 * 768, 768, 1024, (bf16*)(ws + WS_WMIN) + (size_t)sl * 768 * 1024, A->in[I_NFFN] + (sl >> 4) * 1024, 2, 24, scr, r % 384, lane); continue; } r -= N_MIN;
        { const int sl = r / 192; tr_item(A->in[I_MOEOUT] + (size_t)sl * 384 * 1024, 1024, 384, (bf16*)(ws + WS_WMOUT) + (size_t)sl * 1024 * 384, nullptr, 0, 32, scr, r % 192, lane); }
    }
    for (int m = gw; m < T; m += NGW) rms_row_to_bf16(A->in[I_X] + (size_t)m * D, (bf16*)(ws + WS_XN) + (size_t)m * D, A->out + (size_t)m * D, lane);
    for (int m = gw; m < NBATCH * NMEM; m += NGW) rms_row_to_bf16(A->in[I_MEM] + (size_t)m * D, (bf16*)(ws + WS_MN) + (size_t)m * D, nullptr, lane);
    const int gt = blockIdx.x * 512 + tid, NGT = gridDim.x * 512;
    const int* pos = (const int*)A->in[I_POS];
    float* cosT = (float*)(ws + WS_COS); float* sinT = (float*)(ws + WS_SIN);
    for (int i = gt; i < T * 32; i += NGT) {
        const int t = i >> 5, j = i & 31;
        const float ang = (float)pos[t] * A->freq[j];
        const double rev = (double)ang * 0.15915494309189533577;
        const float fr = (float)(rev - rint(rev));
        cosT[i] = __builtin_amdgcn_cosf(fr); sinT[i] = __builtin_amdgcn_sinf(fr);
    }
    float* RW = (float*)(ws + WS_RW);
    for (int i = gt; i < DEPTH * NEXP * D; i += NGT) { const int k = i & 1023, e = (i >> 10) & 15, l = i >> 14; RW[i] = A->in[I_RW][k * NEXP + e] * A->in[I_NFFN][l * D + k]; }
}

__device__ __forceinline__ void phase_kv_gemm(KArgs A) {
    const bf16* MN = (const bf16*)(A->ws + WS_MN); const bf16* W = (const bf16*)(A->ws + WS_WKV); bf16* KV = (bf16*)(A->ws + WS_KV);
    constexpr int NT_N = 8192 / 256, NT = (2048 / 128) * NT_N;
    for (int u = blockIdx.x; u < NT; u += gridDim.x) {
        const int m0 = (u / NT_N) * 128, n0 = (u % NT_N) * 256;
        gemm_tile_v1([&](int r) { return MN + (size_t)r * D; }, W, D, m0, n0,
            [&](int row, int col, f32x4 v0, f32x4 v1) { st_bf16x4(KV + (size_t)row * 8192 + col, v0); st_bf16x4(KV + (size_t)row * 8192 + col + 128, v1); });
    }
}
__device__ __forceinline__ void phase_knorm(KArgs A) {
    const int tid_ = opaque_tid(); const int wid = __builtin_amdgcn_readfirstlane(tid_ >> 6), lane = tid_ & 63; const int gw = blockIdx.x * 8 + wid, NGW = gridDim.x * 8;
    bf16* KV = (bf16*)(opq(A->ws) + WS_KV);
    for (int it = gw; it < DEPTH * 2048 * 4; it += NGW) {
        const int h = it & 3, m = (it >> 2) & 2047, l = it >> 13;
        bf16* p = KV + (size_t)m * 8192 + l * 2048 + h * 256 + 4 * lane;
        const u32x2 w = *(const u32x2*)p;
        float x0 = bflo(w.x), x1 = bfhi(w.x), x2 = bflo(w.y), x3 = bfhi(w.y);
        const float rstd = rsqrtf(wave_sum(x0 * x0 + x1 * x1 + x2 * x2 + x3 * x3) * (1.f / 256.f) + EPS) * 0.0625f;
        const f32x4 g = *(const f32x4*)(A->in[I_XKN] + l * 256 + 4 * lane);
        u32x2 o; o.x = pk2(x0 * rstd * g.x, x1 * rstd * g.y); o.y = pk2(x2 * rstd * g.z, x3 * rstd * g.w);
        *(u32x2*)p = o;
    }
}

template <class EF>
__device__ __forceinline__ void gemm_rows_v1(const bf16* Am, int lda, const bf16* Bt, int K, int M, int N, EF epi) {
    const int ntn = N / 256, nt = (M / 128) * ntn;
    for (int u = blockIdx.x; u < nt; u += gridDim.x) {
        const int m0 = (u / ntn) * 128, n0 = (u % ntn) * 256;
        gemm_tile_v1([&](int r) { return Am + (size_t)r * lda; }, Bt, K, m0, n0, epi);
    }
}

__device__ __forceinline__ void phase_nsa_prep(KArgs A, int i, LAS unsigned char* lds) {
    const int tid_ = opaque_tid(); const int wid = __builtin_amdgcn_readfirstlane(tid_ >> 6), lane = tid_ & 63; const int gw = blockIdx.x * 8 + wid, NGW = gridDim.x * 8;
    unsigned char* ws = opq(A->ws);
    const bf16* HY = (const bf16*)(ws + WS_BIG);
    const float* cosT = (const float*)(ws + WS_COS); const float* sinT = (const float*)(ws + WS_SIN);
    bf16* QA = (bf16*)(ws + WS_QA); bf16* KS = (bf16*)(ws + WS_KS); bf16* KW = (bf16*)(ws + WS_KW);
    LAS float* abuf = (LAS float*)(lds + wid * 8192);
    const int NIT = T + NBATCH * NCMP * 2 * 2;
    for (int it = gw; it < NIT; it += NGW) {
        if (it < T) {
            const int t = it;
            const float c = cosT[t * 32 + (lane & 31)], s = sinT[t * 32 + (lane & 31)];
#pragma unroll
            for (int u = 0; u < 12; ++u) {
                int src; const float* gain; bf16* dst; float scale;
                if (u < 8) { src = C_QA + 64 * u; gain = A->in[I_QNORM] + i * 64; dst = QA + (size_t)t * 512 + 64 * u; scale = 0.125f; }
                else if (u < 10) { src = C_KS + 64 * (u - 8); gain = A->in[I_KNORM] + (i * 3 + 1) * 64; dst = KS + (size_t)t * 128 + 64 * (u - 8); scale = 1.f; }
                else { src = C_KW + 64 * (u - 10); gain = A->in[I_KNORM] + (i * 3 + 2) * 64; dst = KW + (size_t)t * 128 + 64 * (u - 10); scale = 1.f; }
                const float x = bf2f(HY[(size_t)t * HYN + src + lane]);
                const float y = x * rsqrtf(wave_sum(x * x) * (1.f / 64.f) + EPS) * gain[lane] * scale;
                const float pr = __shfl_xor(y, 32);
                const float o = lane < 32 ? y * c - pr * s : y * c + pr * s;
                dst[lane] = (bf16)f2bf(o);
            }
        } else {
            const int r = it - T; const int kv = r & 1, g = (r >> 1) & 1, bn = r >> 2, n = bn % NCMP, b = bn / NCMP;
            const float* pe = A->in[I_CMPPE] + (size_t)(i * 2 + kv) * 32 * 64;
            const float* w1 = A->in[I_CMPW1] + (size_t)(i * 2 + kv) * 2048 * 64;
            const float* w2 = A->in[I_CMPW2] + (size_t)(i * 2 + kv) * 64 * 64;
            const int tok0 = b * S + 16 * n, coff = (kv ? C_VC : C_KC) + g * 64;
#pragma unroll 4
            for (int l = 0; l < 32; ++l) abuf[l * 64 + lane] = bf2f(HY[(size_t)(tok0 + l) * HYN + coff + lane]) + pe[l * 64 + lane];
            LDS_WAIT();
            float acc = 0.f;
#pragma unroll 8
            for (int k = 0; k < 2048; ++k) acc += abuf[k] * w1[k * 64 + lane];
            const float h = gelu_tanh(acc);
            float o = 0.f;
#pragma unroll 8
            for (int m = 0; m < 64; ++m) o += __shfl(h, m) * w2[m * 64 + lane];
            LDS_WAIT();
            const size_t oidx = ((size_t)(b * 128 + n) * 2 + g) * 64 + lane;
            if (kv == 0) {
                const float y = o * rsqrtf(wave_sum(o * o) * (1.f / 64.f) + EPS) * A->in[I_KNORM][(i * 3 + 0) * 64 + lane];
                const int tp = tok0 + 31;
                const float c = cosT[tp * 32 + (lane & 31)], s = sinT[tp * 32 + (lane & 31)];
                const float pr = __shfl_xor(y, 32);
                const float oo = lane < 32 ? y * c - pr * s : y * c + pr * s;
                ((bf16*)(ws + WS_KC))[oidx] = (bf16)f2bf(oo);
            } else ((bf16*)(ws + WS_VC))[oidx] = (bf16)f2bf(o);
        }
    }
}

__device__ __forceinline__ void nsa_block(const LAS float* qs, const bf16* __restrict__ krow, bool ok, const bf16* __restrict__ vbase, int vstride, int lane,
                                          float (&m)[4], float (&l)[4], float (&o)[4]) {
    float s[4] = {0.f, 0.f, 0.f, 0.f};
#pragma unroll 2
    for (int c = 0; c < 8; ++c) {
        const u32x4 kw = *(const u32x4*)(krow + 8 * c);
        const float k0 = bflo(kw.x), k1 = bfhi(kw.x), k2 = bflo(kw.y), k3 = bfhi(kw.y), k4 = bflo(kw.z), k5 = bfhi(kw.z), k6 = bflo(kw.w), k7 = bfhi(kw.w);
#pragma unroll
        for (int hh = 0; hh < 4; ++hh) {
            const f32x4 qa = *(const LAS f32x4*)(qs + hh * 64 + 8 * c), qb = *(const LAS f32x4*)(qs + hh * 64 + 8 * c + 4);
            s[hh] += (qa.x * k0 + qa.y * k1) + (qa.z * k2 + qa.w * k3) + (qb.x * k4 + qb.y * k5) + (qb.z * k6 + qb.w * k7);
        }
    }
    float p[4];
#pragma unroll
    for (int hh = 0; hh < 4; ++hh) {
        const float sv = ok ? s[hh] : -INFINITY;
        const float bm = wave_max(sv);
        const float mn = fmaxf(m[hh], bm);
        if (mn == -INFINITY) { p[hh] = 0.f; continue; }
        const float alpha = __expf(m[hh] - mn);
        p[hh] = ok ? __expf(sv - mn) : 0.f;
        l[hh] = l[hh] * alpha + wave_sum(p[hh]);
        o[hh] *= alpha; m[hh] = mn;
    }
#pragma unroll 8
    for (int kk = 0; kk < 64; ++kk) {
        const float v = bf2f(vbase[(size_t)kk * vstride + lane]);
#pragma unroll
        for (int hh = 0; hh < 4; ++hh) o[hh] += __shfl(p[hh], kk) * v;
    }
}
__device__ __forceinline__ void phase_nsa_attn(KArgs A, int i, LAS unsigned char* lds) {
    const int tid_ = opaque_tid(); const int wid = __builtin_amdgcn_readfirstlane(tid_ >> 6), lane0 = tid_ & 63; const int gw = blockIdx.x * 8 + wid, NGW = gridDim.x * 8;
    unsigned char* ws = opq(A->ws);
    const bf16* HY = (const bf16*)(ws + WS_BIG); const bf16* QA = (const bf16*)(ws + WS_QA); const bf16* KS = (const bf16*)(ws + WS_KS); const bf16* KW = (const bf16*)(ws + WS_KW);
    const bf16* KC = (const bf16*)(ws + WS_KC); const bf16* VC = (const bf16*)(ws + WS_VC); bf16* CAT = (bf16*)(ws + WS_CAT);
    LAS float* qs = (LAS float*)(lds + wid * 2048);
    LAS float* ps = qs + 256;
    for (int it = gw; it < 2 * T; it += NGW) {
        int lane = lane0; asm volatile("" : "+v"(lane));
        const int tok = it >> 1, g = it & 1, b = tok >> 11, t = tok & 2047;
#pragma unroll
        for (int hh = 0; hh < 4; ++hh) qs[hh * 64 + lane] = bf2f(QA[(size_t)tok * 512 + (g * 4 + hh) * 64 + lane]);
        LDS_WAIT();
        const int ncv = t >= 31 ? ((t - 31) >> 4) + 1 : 0;
        float oc[4] = {0.f, 0.f, 0.f, 0.f};
        float psum0 = 0.f, psum1 = 0.f;
        {
            const bool v0 = lane < ncv, v1 = lane + 64 < ncv;
            const bf16* k0p = KC + ((size_t)(b * 128 + lane) * 2 + g) * 64;
            const bf16* k1p = KC + ((size_t)(b * 128 + (lane + 64 < 127 ? lane + 64 : 126)) * 2 + g) * 64;
            float s0[4] = {0.f, 0.f, 0.f, 0.f}, s1[4] = {0.f, 0.f, 0.f, 0.f};
#pragma unroll 2
            for (int c = 0; c < 8; ++c) {
                const u32x4 ka = *(const u32x4*)(k0p + 8 * c), kb = *(const u32x4*)(k1p + 8 * c);
#pragma unroll
                for (int hh = 0; hh < 4; ++hh) {
                    const f32x4 qa = *(const LAS f32x4*)(qs + hh * 64 + 8 * c), qb = *(const LAS f32x4*)(qs + hh * 64 + 8 * c + 4);
                    s0[hh] += (qa.x * bflo(ka.x) + qa.y * bfhi(ka.x)) + (qa.z * bflo(ka.y) + qa.w * bfhi(ka.y)) + (qb.x * bflo(ka.z) + qb.y * bfhi(ka.z)) + (qb.z * bflo(ka.w) + qb.w * bfhi(ka.w));
                    s1[hh] += (qa.x * bflo(kb.x) + qa.y * bfhi(kb.x)) + (qa.z * bflo(kb.y) + qa.w * bfhi(kb.y)) + (qb.x * bflo(kb.z) + qb.y * bfhi(kb.z)) + (qb.z * bflo(kb.w) + qb.w * bfhi(kb.w));
                }
            }
            float p0[4], p1[4];
#pragma unroll
            for (int hh = 0; hh < 4; ++hh) {
                const float a0 = v0 ? s0[hh] : -INFINITY, a1 = v1 ? s1[hh] : -INFINITY;
                const float mx = wave_max(fmaxf(a0, a1));
                if (ncv > 0) {
                    const float e0 = v0 ? __expf(a0 - mx) : 0.f, e1 = v1 ? __expf(a1 - mx) : 0.f;
                    const float inv = 1.0f / wave_sum(e0 + e1);
                    p0[hh] = e0 * inv; p1[hh] = e1 * inv;
                } else { p0[hh] = 0.f; p1[hh] = 0.f; }
                psum0 += p0[hh]; psum1 += p1[hh];
            }
#pragma unroll 2
            for (int c = 0; c < ncv; ++c) {
                const float v = bf2f(VC[((size_t)(b * 128 + c) * 2 + g) * 64 + lane]);
#pragma unroll
                for (int hh = 0; hh < 4; ++hh) oc[hh] += __shfl(c < 64 ? p0[hh] : p1[hh], c & 63) * v;
            }
        }
        ps[lane] = psum0; ps[64 + lane] = psum1;
        LDS_WAIT();
        const int cur = t >> 6;
        unsigned selmask;
        {
            const int j = lane & 31;
            float imp = ps[4 * j] + ps[4 * j + 1] + ps[4 * j + 2] + 0.5f * ps[4 * j + 3] + (j > 0 ? 0.5f * ps[4 * j - 1] : 0.f);
            const bool valid = j <= cur, forced = (j == 0) || (j == cur) || (j == cur - 1);
            const float score = valid ? imp + (forced ? 1000.0f : 0.f) : -INFINITY;
            int rank = 0;
#pragma unroll 8
            for (int jj = 0; jj < 32; ++jj) { const float sj = __shfl(score, jj); rank += (sj > score || (sj == score && jj < j)) ? 1 : 0; }
            const bool sel = valid && rank < 8 && lane < 32;
            selmask = (unsigned)__ballot(sel);
        }
        LDS_WAIT();
        float o1[4] = {0.f, 0.f, 0.f, 0.f}, o2[4] = {0.f, 0.f, 0.f, 0.f};
#pragma unroll 1
        for (int pass = 0; pass < 2; ++pass) {
            float oa[4] = {0.f, 0.f, 0.f, 0.f}, ma[4] = {-INFINITY, -INFINITY, -INFINITY, -INFINITY}, la[4] = {0.f, 0.f, 0.f, 0.f};
            const int lo = pass ? (t - 255 > 0 ? t - 255 : 0) : 0;
            const unsigned bm = pass ? 0xffffffffu : selmask;
            const bf16* Kb = pass ? KW : KS; const int vc = pass ? C_VW : C_VS;
#pragma unroll 1
            for (int j = lo >> 6; j <= cur; ++j) {
                if (!((bm >> j) & 1u)) continue;
                const int key = 64 * j + lane; const size_t kt = (size_t)(b * S + key);
                nsa_block(qs, Kb + kt * 128 + g * 64, key <= t && key >= lo, HY + (size_t)(b * S + 64 * j) * HYN + vc + g * 64, HYN, lane, ma, la, oa);
            }
            if (pass == 0) {
#pragma unroll
                for (int hh = 0; hh < 4; ++hh) o1[hh] = oa[hh] / la[hh];
            } else {
#pragma unroll
                for (int hh = 0; hh < 4; ++hh) o2[hh] = oa[hh] / la[hh];
            }
        }
#pragma unroll
        for (int hh = 0; hh < 4; ++hh) {
            const int head = g * 4 + hh;
            const float* gb = A->in[I_GATEB] + i * 24 + head * 3;
            const bf16* gl = HY + (size_t)tok * HYN + C_GA + head * 3;
            const float g0 = sigmoidf_(bf2f(gl[0]) + gb[0]), g1 = sigmoidf_(bf2f(gl[1]) + gb[1]), g2 = sigmoidf_(bf2f(gl[2]) + gb[2]);
            const float o = g0 * oc[hh] + g1 * o1[hh] + g2 * o2[hh];
            CAT[(size_t)tok * 1024 + head * 64 + lane] = (bf16)f2bf(o);
        }
    }
}

__device__ __forceinline__ void phase_gla_seq(KArgs A, int i, LAS unsigned char* lds) {
    const int tid = opaque_tid(), wid = __builtin_amdgcn_readfirstlane(tid >> 6), lane = tid & 63;
    unsigned char* ws = opq(A->ws);
    const bf16* HY = (const bf16*)(ws + WS_BIG); bf16* CAT = (bf16*)(ws + WS_CAT);
    constexpr int CH = 16;
    LAS float* la = (LAS float*)lds;
    LAS float* lk = la + 4 * CH * 64;
    LAS float* lq = lk + 4 * CH * 64;
    LAS float* lo = lq + 4 * CH * 64;
    const float* wa2 = A->in[I_WA2] + i * 16 * 256; const float* ba = A->in[I_BA] + i * 256; const float* og = A->in[I_ONORM] + i * 128;
    for (int it = blockIdx.x; it < 8; it += gridDim.x) {
        const int pl = tid >> 7, v = tid & 127, p = it * 4 + pl, b = p >> 2, h = p & 3;
        float St[64];
#pragma unroll
        for (int k = 0; k < 64; ++k) St[k] = 0.f;
        for (int c0 = 0; c0 < S; c0 += CH) {
            __syncthreads();
            for (int e = tid; e < 4 * CH * 64; e += 512) {
                const int kk = e & 63, tk = (e >> 6) % CH, pp = e / (64 * CH); const int pb = (it * 4 + pp) >> 2, ph = (it * 4 + pp) & 3;
                const size_t tok = (size_t)pb * S + c0 + tk; const bf16* row = HY + tok * HYN;
                float z = ba[ph * 64 + kk];
#pragma unroll
                for (int r = 0; r < 16; ++r) z += bf2f(row[C_AL + r]) * wa2[r * 256 + ph * 64 + kk];
                const float ls_ = fminf(z, 0.f) - log1pf(__expf(-fabsf(z)));
                la[e] = __expf(ls_ * (1.f / 16.f));
                lk[e] = bf2f(row[C_KB + ph * 64 + kk]);
                lq[e] = bf2f(row[C_QB + ph * 64 + kk]) * 0.125f;
            }
            __syncthreads();
            for (int tk = 0; tk < CH; ++tk) {
                const size_t tok = (size_t)b * S + c0 + tk;
                const float vv = bf2f(HY[tok * HYN + C_VB + h * 128 + v]);
                const LAS float* pa = la + (pl * CH + tk) * 64; const LAS float* pk = lk + (pl * CH + tk) * 64; const LAS float* pq = lq + (pl * CH + tk) * 64;
                float o = 0.f;
#pragma unroll
                for (int k4 = 0; k4 < 16; ++k4) {
                    const f32x4 a4 = *(const LAS f32x4*)(pa + 4 * k4), k4v = *(const LAS f32x4*)(pk + 4 * k4), q4 = *(const LAS f32x4*)(pq + 4 * k4);
                    St[4 * k4 + 0] = a4.x * St[4 * k4 + 0] + k4v.x * vv; o += q4.x * St[4 * k4 + 0];
                    St[4 * k4 + 1] = a4.y * St[4 * k4 + 1] + k4v.y * vv; o += q4.y * St[4 * k4 + 1];
                    St[4 * k4 + 2] = a4.z * St[4 * k4 + 2] + k4v.z * vv; o += q4.z * St[4 * k4 + 2];
                    St[4 * k4 + 3] = a4.w * St[4 * k4 + 3] + k4v.w * vv; o += q4.w * St[4 * k4 + 3];
                }
                lo[(pl * CH + tk) * 128 + v] = o;
            }
            __syncthreads();
            for (int r = wid; r < 4 * CH; r += 8) {
                const int pp = r / CH, tk = r % CH; const int pb = (it * 4 + pp) >> 2, ph = (it * 4 + pp) & 3;
                const size_t tok = (size_t)pb * S + c0 + tk;
                const float x0 = lo[r * 128 + lane], x1 = lo[r * 128 + 64 + lane];
                const float rstd = rsqrtf(wave_sum(x0 * x0 + x1 * x1) * (1.f / 128.f) + EPS);
                const float r0 = bf2f(HY[tok * HYN + C_RB + ph * 128 + lane]), r1 = bf2f(HY[tok * HYN + C_RB + ph * 128 + 64 + lane]);
                CAT[tok * 1024 + 512 + ph * 128 + lane] = (bf16)f2bf(x0 * rstd * og[lane] * (r0 * sigmoidf_(r0)));
                CAT[tok * 1024 + 512 + ph * 128 + 64 + lane] = (bf16)f2bf(x1 * rstd * og[64 + lane] * (r1 * sigmoidf_(r1)));
            }
        }
        __syncthreads();
    }
}

__device__ __forceinline__ void phase_sgu_mix(KArgs A, int i, LAS unsigned char* lds) {
    const int tid = opaque_tid(), wid = __builtin_amdgcn_readfirstlane(tid >> 6), lane = tid & 63;
    unsigned char* ws = opq(A->ws);
    const bf16* U = (const bf16*)(ws + WS_U); const bf16* V = (const bf16*)(ws + WS_V); bf16* UM = (bf16*)(ws + WS_UM);
    LAS float* vt = (LAS float*)lds;
    LAS float* st = vt + 128 * 256;
    const float* lng = A->in[I_LNG] + i * 2048; const float* lnb = A->in[I_LNB] + i * 2048;
    for (int it = blockIdx.x; it < NBATCH * 16 * 8; it += gridDim.x) {
        const int g = it & 7, n = (it >> 3) & 15, b = it >> 7;
        const size_t tok0 = (size_t)b * S + n * 128;
        __syncthreads();
        for (int s = wid * 16; s < wid * 16 + 16; ++s) {
            const u32x4* vr = (const u32x4*)(V + (tok0 + s) * 2048) + lane;
            float x[32]; float sum = 0.f;
#pragma unroll
            for (int j = 0; j < 4; ++j) { const u32x4 w = vr[64 * j];
                x[8 * j + 0] = bflo(w.x); x[8 * j + 1] = bfhi(w.x); x[8 * j + 2] = bflo(w.y); x[8 * j + 3] = bfhi(w.y); x[8 * j + 4] = bflo(w.z); x[8 * j + 5] = bfhi(w.z); x[8 * j + 6] = bflo(w.w); x[8 * j + 7] = bfhi(w.w); }
#pragma unroll
            for (int j = 0; j < 32; ++j) sum += x[j];
            const float mean = wave_sum(sum) * (1.f / 2048.f); float q = 0.f;
#pragma unroll
            for (int j = 0; j < 32; ++j) { const float d = x[j] - mean; q += d * d; }
            const float rstd = rsqrtf(wave_sum(q) * (1.f / 2048.f) + EPS);
            const u32x2 w = *((const u32x2*)(V + (tok0 + s) * 2048 + g * 256) + lane);
            const f32x4 gg = *(const f32x4*)(lng + g * 256 + 4 * lane), bb = *(const f32x4*)(lnb + g * 256 + 4 * lane);
            f32x4 o; o.x = (bflo(w.x) - mean) * rstd * gg.x + bb.x; o.y = (bfhi(w.x) - mean) * rstd * gg.y + bb.y; o.z = (bflo(w.y) - mean) * rstd * gg.z + bb.z; o.w = (bfhi(w.y) - mean) * rstd * gg.w + bb.w;
            *(LAS f32x4*)(vt + s * 256 + 4 * lane) = o;
            (void)st;
        }
        __syncthreads();
        const int c = tid & 255, th = tid >> 8;
        const float* wsg = A->in[I_SGWS] + (size_t)(i * 8 + g) * 128 * 128; const float* bsg = A->in[I_SGBS] + (i * 8 + g) * 128;
        for (int tt = 0; tt < 64; ++tt) {
            const int t = 2 * tt + th;
            const float* wr = wsg + t * 128;
            float acc = 0.f;
            for (int s = 0; s <= t; ++s) acc += wr[s] * vt[s * 256 + c];
            acc += bsg[t];
            const float u = bf2f(U[(tok0 + t) * 2048 + g * 256 + c]);
            UM[(tok0 + t) * 2048 + g * 256 + c] = (bf16)f2bf(u * acc);
        }
    }
    __syncthreads();
}

__device__ __forceinline__ void phase_rownorm(KArgs A) {
    const int tid_ = opaque_tid(); const int wid = __builtin_amdgcn_readfirstlane(tid_ >> 6), lane = tid_ & 63; const int gw = blockIdx.x * 8 + wid, NGW = gridDim.x * 8;
    for (int m = gw; m < T; m += NGW) rms_row_to_bf16(A->out + (size_t)m * D, (bf16*)(opq(A->ws) + WS_XN) + (size_t)m * D, nullptr, lane);
}

__device__ __forceinline__ void phase_xattn(KArgs A, int L, LAS unsigned char* lds) {
    const int tid = opaque_tid(), wid = __builtin_amdgcn_readfirstlane(tid >> 6), lane = tid & 63;
    unsigned char* ws = opq(A->ws);
    const bf16* QX = (const bf16*)(ws + WS_QX); const bf16* KV = (const bf16*)(ws + WS_KV); bf16* OX = (bf16*)(ws + WS_OX);
    constexpr int KSTR = 129;
    LAS unsigned* kl = (LAS unsigned*)lds;
    LAS float* qb = (LAS float*)(lds + 132096) + wid * 256;
    LAS float* pb = (LAS float*)(lds + 132096 + 8192) + wid * 256;
    const float* qg = A->in[I_XQN] + L * 256;
    for (int it = blockIdx.x; it < NBATCH * 4 * 8; it += gridDim.x) {
        const int qc = it & 7, h = (it >> 3) & 3, b = it >> 5;
        __syncthreads();
        for (int e = tid; e < 256 * 128; e += 512) { const int m = e >> 7, dw = e & 127;
            kl[m * KSTR + dw] = *((const unsigned*)(KV + (size_t)(b * 256 + m) * 8192 + L * 2048 + h * 256) + dw); }
        __syncthreads();
        const bf16* Vb = KV + (size_t)(b * 256) * 8192 + L * 2048 + 1024 + h * 256;
        for (int tq = 0; tq < 32; ++tq) {
            const size_t tok = (size_t)b * S + qc * 256 + wid * 32 + tq;
            const u32x2 qw = *((const u32x2*)(QX + tok * 1024 + h * 256) + lane);
            const float q0 = bflo(qw.x), q1 = bfhi(qw.x), q2 = bflo(qw.y), q3 = bfhi(qw.y);
            const float rstd = rsqrtf(wave_sum(q0 * q0 + q1 * q1 + q2 * q2 + q3 * q3) * (1.f / 256.f) + EPS);
            const f32x4 gg = *(const f32x4*)(qg + 4 * lane);
            *(LAS f32x4*)(qb + 4 * lane) = (f32x4){q0 * rstd * gg.x, q1 * rstd * gg.y, q2 * rstd * gg.z, q3 * rstd * gg.w};
            LDS_WAIT();
            float s0 = 0.f, s1 = 0.f, s2 = 0.f, s3 = 0.f;
#pragma unroll 4
            for (int dw = 0; dw < 128; ++dw) {
                const f32x2 qq = *(const LAS f32x2*)(qb + 2 * dw);
                const unsigned k0 = kl[lane * KSTR + dw], k1 = kl[(lane + 64) * KSTR + dw], k2 = kl[(lane + 128) * KSTR + dw], k3 = kl[(lane + 192) * KSTR + dw];
                s0 += qq.x * bflo(k0) + qq.y * bfhi(k0); s1 += qq.x * bflo(k1) + qq.y * bfhi(k1);
                s2 += qq.x * bflo(k2) + qq.y * bfhi(k2); s3 += qq.x * bflo(k3) + qq.y * bfhi(k3);
            }
            const float mx = wave_max(fmaxf(fmaxf(s0, s1), fmaxf(s2, s3)));
            const float e0 = __expf(s0 - mx), e1 = __expf(s1 - mx), e2 = __expf(s2 - mx), e3 = __expf(s3 - mx);
            const float inv = 1.f / wave_sum((e0 + e1) + (e2 + e3));
            pb[lane] = e0 * inv; pb[lane + 64] = e1 * inv; pb[lane + 128] = e2 * inv; pb[lane + 192] = e3 * inv;
            LDS_WAIT();
            float o0 = 0.f, o1 = 0.f, o2 = 0.f, o3 = 0.f;
#pragma unroll 8
            for (int m = 0; m < 256; ++m) {
                const float p = pb[m];
                const u32x2 vw = *((const u32x2*)(Vb + (size_t)m * 8192) + lane);
                o0 += p * bflo(vw.x); o1 += p * bfhi(vw.x); o2 += p * bflo(vw.y); o3 += p * bfhi(vw.y);
            }
            u32x2 ow; ow.x = pk2(o0, o1); ow.y = pk2(o2, o3);
            *((u32x2*)(OX + tok * 1024 + h * 256) + lane) = ow;
            LDS_WAIT();
        }
    }
    __syncthreads();
}


__device__ __forceinline__ int kperm32(int p) { const int fq = (p >> 3) & 3, j = p & 7; return (p & ~31) + 16 * (j >> 2) + 4 * fq + (j & 3); }
__device__ __forceinline__ void phase_vtrans(KArgs A, LAS unsigned char* lds) {
    const int tid = opaque_tid();
    unsigned char* ws = opq(A->ws);
    const bf16* KV = (const bf16*)(ws + WS_KV); bf16* VT = (bf16*)(ws + WS_VT);
    LAS bf16* vt = (LAS bf16*)lds;
    constexpr int VS = 258;
    for (int it = blockIdx.x; it < DEPTH * NBATCH * 4; it += gridDim.x) {
        const int h = it & 3, b = (it >> 2) & 7, l = it >> 5;
        __syncthreads();
        for (int e = tid; e < 256 * 32; e += 512) { const int m = e >> 5, c8 = e & 31;
            const u32x4 w = *(const u32x4*)(KV + (size_t)(b * 256 + m) * 8192 + l * 2048 + 1024 + h * 256 + c8 * 8);
            LAS unsigned* d = (LAS unsigned*)(vt + m * VS + c8 * 8); d[0] = w.x; d[1] = w.y; d[2] = w.z; d[3] = w.w; }
        __syncthreads();
        for (int e = tid; e < 256 * 32; e += 512) { const int dv = e & 255, p8 = e >> 8;
            unsigned short x[8];
#pragma unroll
            for (int j = 0; j < 8; ++j) x[j] = vt[kperm32(p8 * 8 + j) * VS + dv];
            u32x4 o; o.x = x[0] | ((unsigned)x[1] << 16); o.y = x[2] | ((unsigned)x[3] << 16); o.z = x[4] | ((unsigned)x[5] << 16); o.w = x[6] | ((unsigned)x[7] << 16);
            *(u32x4*)(VT + ((size_t)it * 256 + dv) * 256 + p8 * 8) = o; }
    }
    __syncthreads();
}

__device__ __forceinline__ void phase_xattn_mfma(KArgs A, int L, LAS unsigned char* lds) {
    const int tid = opaque_tid(), wid = __builtin_amdgcn_readfirstlane(tid >> 6), lane = tid & 63, fr = lane & 15, fq = lane >> 4;
    unsigned char* ws = opq(A->ws);
    const bf16* QX = (const bf16*)(ws + WS_QX); const bf16* KV = (const bf16*)(ws + WS_KV); const bf16* VT = (const bf16*)(ws + WS_VT); bf16* OX = (bf16*)(ws + WS_OX);
    constexpr int RS = 264;
    LAS bf16* kl = (LAS bf16*)lds;
    const float* qg = A->in[I_XQN] + L * 256;
    for (int it = blockIdx.x; it < NBATCH * 4 * 16; it += gridDim.x) {
        const int qt = it & 15, h = (it >> 4) & 3, b = it >> 6;
        __syncthreads();
        {
            const int row = tid >> 1, hf = tid & 1;
            const u32x4* src = (const u32x4*)(KV + (size_t)(b * 256 + row) * 8192 + L * 2048 + h * 256 + hf * 128);
#pragma unroll
            for (int i0 = 0; i0 < 16; i0 += 8) {
                u32x4 w[8];
#pragma unroll
                for (int i = 0; i < 8; ++i) w[i] = src[i0 + i];
#pragma unroll
                for (int i = 0; i < 8; ++i) *(LAS u32x4*)(kl + row * RS + hf * 128 + (i0 + i) * 8) = w[i];
            }
        }
        const size_t tok = (size_t)b * S + qt * 128 + wid * 16 + fr;
        bf16x8 qf[8];
        {
            u32x4 qw[8]; float ssq = 0.f;
#pragma unroll
            for (int s = 0; s < 8; ++s) qw[s] = *(const u32x4*)(QX + tok * 1024 + h * 256 + 32 * s + 8 * fq);
#pragma unroll
            for (int s = 0; s < 8; ++s) {
                const float a0 = bflo(qw[s].x), a1 = bfhi(qw[s].x), a2 = bflo(qw[s].y), a3 = bfhi(qw[s].y), a4 = bflo(qw[s].z), a5 = bfhi(qw[s].z), a6 = bflo(qw[s].w), a7 = bfhi(qw[s].w);
                ssq += (a0 * a0 + a1 * a1) + (a2 * a2 + a3 * a3) + (a4 * a4 + a5 * a5) + (a6 * a6 + a7 * a7);
            }
            ssq += __shfl_xor(ssq, 16); ssq += __shfl_xor(ssq, 32);
            const float rstd = rsqrtf(ssq * (1.f / 256.f) + EPS);
#pragma unroll
            for (int s = 0; s < 8; ++s) {
                const f32x4 ga = *(const f32x4*)(qg + 32 * s + 8 * fq), gb = *(const f32x4*)(qg + 32 * s + 8 * fq + 4);
                u32x4 w; w.x = pk2(bflo(qw[s].x) * rstd * ga.x, bfhi(qw[s].x) * rstd * ga.y); w.y = pk2(bflo(qw[s].y) * rstd * ga.z, bfhi(qw[s].y) * rstd * ga.w);
                w.z = pk2(bflo(qw[s].z) * rstd * gb.x, bfhi(qw[s].z) * rstd * gb.y); w.w = pk2(bflo(qw[s].w) * rstd * gb.z, bfhi(qw[s].w) * rstd * gb.w);
                qf[s] = __builtin_bit_cast(bf16x8, w);
            }
        }
        __syncthreads();
        f32x4 sc[16];
#pragma unroll
        for (int hf = 0; hf < 2; ++hf) {
            unsigned kb = (unsigned)(size_t)(kl + (128 * hf + fr) * RS + 8 * fq); asm volatile("" : "+v"(kb));
#pragma unroll
            for (int t8 = 0; t8 < 8; ++t8) { const int t = 8 * hf + t8; sc[t] = (f32x4){0.f, 0.f, 0.f, 0.f};
#pragma unroll
                for (int s = 0; s < 8; ++s) { const bf16x8 kf = *(const LAS bf16x8*)(size_t)(kb + (unsigned)((16 * t8 * RS + 32 * s) * 2));
                    sc[t] = __builtin_amdgcn_mfma_f32_16x16x32_bf16(kf, qf[s], sc[t], 0, 0, 0); }
                if (t & 1) asm volatile("" ::: "memory"); }
        }
        float mx = -INFINITY;
#pragma unroll
        for (int t = 0; t < 16; ++t) mx = fmaxf(mx, fmaxf(fmaxf(sc[t].x, sc[t].y), fmaxf(sc[t].z, sc[t].w)));
        mx = fmaxf(mx, __shfl_xor(mx, 16)); mx = fmaxf(mx, __shfl_xor(mx, 32));
        float lsum = 0.f;
#pragma unroll
        for (int t = 0; t < 16; ++t) { sc[t].x = __expf(sc[t].x - mx); sc[t].y = __expf(sc[t].y - mx); sc[t].z = __expf(sc[t].z - mx); sc[t].w = __expf(sc[t].w - mx); lsum += (sc[t].x + sc[t].y) + (sc[t].z + sc[t].w); }
        lsum += __shfl_xor(lsum, 16); lsum += __shfl_xor(lsum, 32);
        const float inv = 1.f / lsum;
        bf16x8 pf[8];
#pragma unroll
        for (int s = 0; s < 8; ++s) { u32x4 w; w.x = pk2(sc[2 * s].x, sc[2 * s].y); w.y = pk2(sc[2 * s].z, sc[2 * s].w); w.z = pk2(sc[2 * s + 1].x, sc[2 * s + 1].y); w.w = pk2(sc[2 * s + 1].z, sc[2 * s + 1].w);
            pf[s] = __builtin_bit_cast(bf16x8, w); }
        __syncthreads();
        {
            const int row = tid >> 1, hf = tid & 1;
            const u32x4* src = (const u32x4*)(VT + ((size_t)((L * 8 + b) * 4 + h) * 256 + row) * 256 + hf * 128);
#pragma unroll
            for (int i0 = 0; i0 < 16; i0 += 8) {
                u32x4 w[8];
#pragma unroll
                for (int i = 0; i < 8; ++i) w[i] = src[i0 + i];
#pragma unroll
                for (int i = 0; i < 8; ++i) *(LAS u32x4*)(kl + row * RS + hf * 128 + (i0 + i) * 8) = w[i];
            }
        }
        __syncthreads();
#pragma unroll
        for (int hf = 0; hf < 2; ++hf) {
            unsigned vb = (unsigned)(size_t)(kl + (128 * hf + fr) * RS + 8 * fq); asm volatile("" : "+v"(vb));
#pragma unroll
            for (int n8 = 0; n8 < 8; ++n8) { const int n = 8 * hf + n8; f32x4 o = (f32x4){0.f, 0.f, 0.f, 0.f};
#pragma unroll
                for (int s = 0; s < 8; ++s) { const bf16x8 vf = *(const LAS bf16x8*)(size_t)(vb + (unsigned)((16 * n8 * RS + 32 * s) * 2));
                    o = __builtin_amdgcn_mfma_f32_16x16x32_bf16(vf, pf[s], o, 0, 0, 0); }
                u32x2 w; w.x = pk2(o.x * inv, o.y * inv); w.y = pk2(o.z * inv, o.w * inv);
                *(u32x2*)(OX + tok * 1024 + h * 256 + 16 * n + 4 * fq) = w;
                if (n & 1) asm volatile("" ::: "memory"); }
        }
    }
    __syncthreads();
}

__device__ __forceinline__ void phase_route(KArgs A, int L) {
    const int tid_ = opaque_tid(); const int wid = __builtin_amdgcn_readfirstlane(tid_ >> 6), lane = tid_ & 63; const int gw = blockIdx.x * 8 + wid, NGW = gridDim.x * 8;
    unsigned char* ws = opq(A->ws);
    const float* RW = (const float*)(ws + WS_RW) + (size_t)L * NEXP * D; const float* rb = A->in[I_RB];
    unsigned* cnt = (unsigned*)(ws + WS_CTL) + CW_CNT + L * 64;
    int* list = (int*)(ws + WS_LIST); int* te = (int*)(ws + WS_TOK); int* tp = te + 2 * T; float* tw = (float*)(tp + 2 * T);
    bf16* XN = (bf16*)(ws + WS_XN);
    for (int t = gw; t < T; t += NGW) {
        const f32x4* xr = (const f32x4*)(A->out + (size_t)t * D) + lane;
        f32x4 v[4]; float s = 0.f;
#pragma unroll
        for (int j = 0; j < 4; ++j) { v[j] = xr[64 * j]; s += (v[j].x * v[j].x + v[j].y * v[j].y) + (v[j].z * v[j].z + v[j].w * v[j].w); }
        const float rstd = rsqrtf(wave_sum(s) * (1.f / 1024.f) + EPS);
        u32x2* o8 = (u32x2*)(XN + (size_t)t * D) + lane;
#pragma unroll
        for (int j = 0; j < 4; ++j) { u32x2 w; w.x = pk2(v[j].x * rstd, v[j].y * rstd); w.y = pk2(v[j].z * rstd, v[j].w * rstd); o8[64 * j] = w; }
        float mylg = -INFINITY;
#pragma unroll 2
        for (int e = 0; e < 16; ++e) {
            const f32x4* wr = (const f32x4*)(RW + e * D) + lane; float a = 0.f;
#pragma unroll
            for (int j = 0; j < 4; ++j) { const f32x4 w = wr[64 * j]; a += (v[j].x * w.x + v[j].y * w.y) + (v[j].z * w.z + v[j].w * w.w); }
            const float val = wave_sum(a) * rstd + rb[e];
            mylg = lane == e ? val : mylg;
        }
        const float v0 = wave_max(mylg);
        const int e0 = __ffsll((unsigned long long)__ballot(mylg == v0)) - 1;
        const int gidx = e0 >> 2;
        const float m2 = ((lane >> 2) == gidx && lane != e0 && lane < 16) ? mylg : -INFINITY;
        const float v1 = wave_max(m2);
        const int e1 = __ffsll((unsigned long long)__ballot(m2 == v1 && (lane >> 2) == gidx && lane != e0 && lane < 16)) - 1;
        const float w0 = 1.f / (1.f + __expf(v1 - v0)), w1 = 1.f - w0;
        if (lane == 0) {
            const unsigned p0 = atomicAdd(&cnt[e0], 1u), p1 = atomicAdd(&cnt[e1], 1u);
            list[e0 * T + p0] = t; list[e1 * T + p1] = t;
            te[2 * t] = e0; te[2 * t + 1] = e1; tp[2 * t] = (int)p0; tp[2 * t + 1] = (int)p1; tw[2 * t] = w0; tw[2 * t + 1] = w1;
        }
    }
}
__device__ __forceinline__ void moe_offsets(KArgs A, int L, LAS int* off, LAS int* cn) {
    if (threadIdx.x == 0) {
        const unsigned* cnt = (const unsigned*)(opq(A->ws) + WS_CTL) + CW_CNT + L * 64;
        int o = 0;
        for (int e = 0; e < 16; ++e) { const int c = (int)__hip_atomic_load(cnt + e, __ATOMIC_RELAXED, __HIP_MEMORY_SCOPE_AGENT); off[e] = o; cn[e] = c; o += (c + 255) & ~255; }
        off[16] = o;
    }
    __syncthreads();
}
__device__ __forceinline__ void phase_moe_gemm1(KArgs A, int L, LAS unsigned char* lds) {
    unsigned char* ws = opq(A->ws);
    LAS int* off = (LAS int*)lds; LAS int* cn = off + 32;
    moe_offsets(A, L, off, cn);
    const bf16* XN = (const bf16*)(ws + WS_XN); const int* list = (const int*)(ws + WS_LIST); bf16* H = (bf16*)(ws + WS_H);
    const int nrt = off[16] / 128, nu = nrt * 3;
    for (int u = blockIdx.x; u < nu; u += gridDim.x) {
        const int rt = u / 3, pn = u % 3, s0 = rt * 128;
        int e = 0;
#pragma unroll
        for (int q = 1; q < 16; ++q) e += (s0 >= off[q]) ? 1 : 0;
        const int base = off[e], ce = cn[e]; const int* le = list + e * T;
        const bf16* W = (const bf16*)(ws + WS_WMIN) + (size_t)(L * 16 + e) * 768 * 1024;
        gemm_tile_v1([&](int r) { const int loc = r - base; const int tk = le[loc < ce ? loc : 0]; return XN + (size_t)tk * D; }, W, D, s0, pn * 256,
            [&](int row, int col, f32x4 g, f32x4 up) {
                f32x4 o;
#pragma unroll
                for (int q = 0; q < 4; ++q) o[q] = g[q] * sigmoidf_(g[q]) * up[q];
                st_bf16x4(H + (size_t)row * DEXP + pn * 128 + (col - pn * 256), o); });
    }
}
__device__ __forceinline__ void phase_moe_gemm2(KArgs A, int L, LAS unsigned char* lds) {
    unsigned char* ws = opq(A->ws);
    LAS int* off = (LAS int*)lds; LAS int* cn = off + 32;
    moe_offsets(A, L, off, cn);
    const bf16* H = (const bf16*)(ws + WS_H); bf16* Y = (bf16*)(ws + WS_Y);
    const int nrt = off[16] / 128, nu = nrt * 4;
    for (int u = blockIdx.x; u < nu; u += gridDim.x) {
        const int rt = u >> 2, pn = u & 3, s0 = rt * 128;
        int e = 0;
#pragma unroll
        for (int q = 1; q < 16; ++q) e += (s0 >= off[q]) ? 1 : 0;
        const bf16* W = (const bf16*)(ws + WS_WMOUT) + (size_t)(L * 16 + e) * 1024 * DEXP;
        gemm_tile_v1([&](int r) { return H + (size_t)r * DEXP; }, W, DEXP, s0, pn * 256,
            [&](int row, int col, f32x4 v0, f32x4 v1) { st_bf16x4(Y + (size_t)row * D + col, v0); st_bf16x4(Y + (size_t)row * D + col + 128, v1); });
    }
}
__device__ __forceinline__ void phase_moe_combine(KArgs A, int L, LAS unsigned char* lds) {
    LAS int* off = (LAS int*)lds; LAS int* cn = off + 32;
    moe_offsets(A, L, off, cn);
    const int tid_ = opaque_tid(); const int wid = __builtin_amdgcn_readfirstlane(tid_ >> 6), lane = tid_ & 63; const int gw = blockIdx.x * 8 + wid, NGW = gridDim.x * 8;
    unsigned char* ws = opq(A->ws);
    const int* te = (const int*)(ws + WS_TOK); const int* tp = te + 2 * T; const float* tw = (const float*)(tp + 2 * T);
    const bf16* Y = (const bf16*)(ws + WS_Y); bf16* XN = (bf16*)(ws + WS_XN);
    for (int t = gw; t < T; t += NGW) {
        const int sl0 = off[te[2 * t]] + tp[2 * t], sl1 = off[te[2 * t + 1]] + tp[2 * t + 1];
        const float w0 = tw[2 * t], w1 = tw[2 * t + 1];
        f32x4* xr = (f32x4*)(A->out + (size_t)t * D) + lane;
        const u32x2* y0 = (const u32x2*)(Y + (size_t)sl0 * D) + lane; const u32x2* y1 = (const u32x2*)(Y + (size_t)sl1 * D) + lane;
        f32x4 v[4]; float s = 0.f;
#pragma unroll
        for (int j = 0; j < 4; ++j) {
            v[j] = xr[64 * j]; const u32x2 a = y0[64 * j], c = y1[64 * j];
            v[j].x += w0 * bflo(a.x) + w1 * bflo(c.x); v[j].y += w0 * bfhi(a.x) + w1 * bfhi(c.x); v[j].z += w0 * bflo(a.y) + w1 * bflo(c.y); v[j].w += w0 * bfhi(a.y) + w1 * bfhi(c.y);
            xr[64 * j] = v[j];
            s += (v[j].x * v[j].x + v[j].y * v[j].y) + (v[j].z * v[j].z + v[j].w * v[j].w);
        }
        const float rstd = rsqrtf(wave_sum(s) * (1.f / 1024.f) + EPS);
        u32x2* o8 = (u32x2*)(XN + (size_t)t * D) + lane;
#pragma unroll
        for (int j = 0; j < 4; ++j) { u32x2 w; w.x = pk2(v[j].x * rstd, v[j].y * rstd); w.y = pk2(v[j].z * rstd, v[j].w * rstd); o8[64 * j] = w; }
    }
}

constexpr int PH_PER_EVEN = 5 + 8, PH_PER_ODD = 3 + 8;
constexpr int NPHASES = 3 + 2 * (PH_PER_EVEN + PH_PER_ODD);

__global__ void __launch_bounds__(512, 2) mk_fwd(Args Araw) {
    KArgs A0 = kargs();
    extern __shared__ __attribute__((aligned(16))) unsigned char lds_raw[];
    LAS unsigned char* lds = (LAS unsigned char*)lds_raw;
    volatile LAS unsigned* misc = (volatile LAS unsigned*)(lds + LDS_MISC);
    const int tid = threadIdx.x;
    if (tid < 16) misc[tid] = 0u;
    __syncthreads();
    const int lo = A0->ph_lo, hi = A0->ph_hi;
    XcdBarrier bar; bar.bar = (unsigned*)(A0->ws + WS_CTL) + CW_BAR; bar.x = 0; bar.st = misc;
    if (hi - lo > 1) bar = xcd_barrier_post((unsigned*)(A0->ws + WS_CTL) + CW_BAR, misc);
    int ph = 0;
#define PH_BEGIN(k) if (ph >= lo && ph < hi) { KArgs A = kargs(); unsigned char* ws = opq(A->ws); _Pragma("unroll 1") for (int rep_ = 0; rep_ < (((PROBE_MASK >> (k)) & 1) ? PROBE_REPS : 1); ++rep_)
#define PH_END   if (ph + 1 < hi) xcd_barrier(bar); } ++ph;
    const int G = gridDim.x, cb = blockIdx.x;

    PH_BEGIN(0) phase_prologue(A, lds); PH_END
    PH_BEGIN(1) {
        pg8::DenseOrder S; S.init(NBATCH * NMEM, 8192, D, (const bf16*)(ws + WS_WKV), G, cb);
        pg8::EpiBf16<0> E{(bf16*)(ws + WS_KV), 8192, 32, 0};
        pg8::gemm_phase(lds, (const bf16*)(ws + WS_MN), D, S, E);
    } PH_END
    PH_BEGIN(2) { phase_knorm(A); phase_vtrans(A, lds); } PH_END

    for (int L = 0; L < DEPTH; ++L) {
        const int i = L >> 1;
        if ((L & 1) == 0) {
            PH_BEGIN(3) {
                pg8::DenseOrder S; S.init(T, HYN, D, (const bf16*)(ws + WS_WHYB) + (size_t)i * HYN * D, G, cb);
                pg8::EpiBf16<0> E{(bf16*)(ws + WS_BIG), HYN, 12, 0};
                pg8::gemm_phase(lds, (const bf16*)(ws + WS_XN), D, S, E);
            } PH_END
            PH_BEGIN(4) phase_nsa_prep(A, i, lds); PH_END
            PH_BEGIN(5) phase_nsa_attn(A, i, lds); PH_END
            PH_BEGIN(6) phase_gla_seq(A, i, lds); PH_END
            PH_BEGIN(7) {
                pg8::DenseOrder S; S.init(T, D, D, (const bf16*)(ws + WS_WHOUT) + (size_t)i * D * D, G, cb);
                pg8::EpiResAdd E{A->out, D};
                pg8::gemm_phase(lds, (const bf16*)(ws + WS_CAT), D, S, E);
            } PH_END
        } else {
            PH_BEGIN(8) {
                pg8::DenseOrder S; S.init(T, 4096, D, (const bf16*)(ws + WS_WSGIN) + (size_t)i * 4096 * D, G, cb);
                pg8::EpiBf16<1> E{(bf16*)(ws + WS_U), 2048, 8, (size_t)(WS_V - WS_U) / 2};
                pg8::gemm_phase(lds, (const bf16*)(ws + WS_XN), D, S, E);
            } PH_END
            PH_BEGIN(9) phase_sgu_mix(A, i, lds); PH_END
            PH_BEGIN(10) {
                pg8::DenseOrder S; S.init(T, D, 2048, (const bf16*)(ws + WS_WSGOUT) + (size_t)i * D * 2048, G, cb);
                pg8::EpiResAdd E{A->out, D};
                pg8::gemm_phase(lds, (const bf16*)(ws + WS_UM), 2048, S, E);
            } PH_END
        }
        PH_BEGIN(11) phase_rownorm(A); PH_END
        PH_BEGIN(12) {
            pg8::DenseOrder S; S.init(T, D, D, (const bf16*)(ws + WS_WQ) + (size_t)L * D * D, G, cb);
            pg8::EpiBf16<0> E{(bf16*)(ws + WS_QX), D, 4, 0};
            pg8::gemm_phase(lds, (const bf16*)(ws + WS_XN), D, S, E);
        } PH_END
        PH_BEGIN(13) phase_xattn_mfma(A, L, lds); PH_END
        PH_BEGIN(14) {
            pg8::DenseOrder S; S.init(T, D, D, (const bf16*)(ws + WS_WO) + (size_t)L * D * D, G, cb);
            pg8::EpiResAdd E{A->out, D};
            pg8::gemm_phase(lds, (const bf16*)(ws + WS_OX), D, S, E);
        } PH_END
        PH_BEGIN(15) phase_route(A, L); PH_END
        PH_BEGIN(16) {
            LAS int* off = (LAS int*)(lds + pg8::STAGE_BYTES); LAS int* cn = off + 32;
            moe_offsets(A, L, off, cn);
            pg8::MoeOrder<true> S{(off[16] / 256) * 3, 3, G, cb, D, off, cn, (const int*)(ws + WS_LIST), (const char*)(ws + WS_WMIN) + (size_t)L * 16 * 768 * D * 2, (size_t)768 * D * 2};
            pg8::EpiSwiglu E{(bf16*)(ws + WS_H), DEXP};
            pg8::gemm_phase(lds, (const bf16*)(ws + WS_XN), D, S, E);
        } PH_END
        PH_BEGIN(17) {
            LAS int* off = (LAS int*)(lds + pg8::STAGE_BYTES); LAS int* cn = off + 32;
            moe_offsets(A, L, off, cn);
            pg8::MoeOrder<false> S{(off[16] / 256) * 4, 4, G, cb, DEXP, off, cn, (const int*)(ws + WS_LIST), (const char*)(ws + WS_WMOUT) + (size_t)L * 16 * D * DEXP * 2, (size_t)D * DEXP * 2};
            pg8::EpiBf16<0> E{(bf16*)(ws + WS_Y), D, 4, 0};
            pg8::gemm_phase(lds, (const bf16*)(ws + WS_H), DEXP, S, E);
        } PH_END
        PH_BEGIN(18) phase_moe_combine(A, L, lds); PH_END
    }
#undef PH_BEGIN
#undef PH_END
}

extern "C" void kernel_launch(void* const* d_in, const int* in_sizes, int n_in, void* d_out, int out_size, void* d_ws, size_t ws_size, hipStream_t stream) {
    static int grid = 0;
    if (grid == 0) {
        if (n_in != N_IN || out_size != T * D || ws_size < WS_END) { fprintf(stderr, "kernel_launch: unexpected problem (n_in %d, out %d, ws %zu)\n", n_in, out_size, ws_size); grid = -1; return; }
        int dev = 0, cus = 0, per_cu = 0;
        if (hipGetDevice(&dev) != hipSuccess || hipDeviceGetAttribute(&cus, hipDeviceAttributeMultiprocessorCount, dev) != hipSuccess) { grid = -1; return; }
        if (hipFuncSetAttribute((const void*)mk_fwd, hipFuncAttributeMaxDynamicSharedMemorySize, LDS_BYTES) != hipSuccess) { fprintf(stderr, "kernel_launch: hipFuncSetAttribute failed\n"); grid = -1; return; }
        if (hipOccupancyMaxActiveBlocksPerMultiprocessor(&per_cu, (const void*)mk_fwd, 512, LDS_BYTES) != hipSuccess || per_cu < 1) fprintf(stderr, "kernel_launch: occupancy query says %d\n", per_cu);
        (void)hipGetLastError();
        grid = cus;
    }
    if (grid < 0) return;
    (void)hipMemsetAsync((char*)d_ws + WS_CTL, 0, CTL_BYTES, stream);
    Args a{};
    for (int i = 0; i < N_IN; ++i) a.in[i] = (const float*)d_in[i];
    a.out = (float*)d_out; a.ws = (unsigned char*)d_ws;
    for (int j = 0; j < 32; ++j) a.freq[j] = (float)pow(10000.0, -(double)j / 32.0);
#if MK_ONE_LAUNCH
    a.ph_lo = 0; a.ph_hi = NPHASES;
    hipLaunchKernelGGL(mk_fwd, dim3(grid), dim3(512), LDS_BYTES, stream, a);
#else
    for (int p = 0; p < NPHASES; ++p) { a.ph_lo = p; a.ph_hi = p + 1; hipLaunchKernelGGL(mk_fwd, dim3(grid), dim3(512), LDS_BYTES, stream, a); }
#endif
}
```

```cpp
#include <hip/hip_runtime.h>
#include <stdint.h>
#include <stdio.h>
#include <math.h>

#ifndef PROBE_MASK
#define PROBE_MASK 0
#endif
#ifndef PROBE_REPS
#define PROBE_REPS 2
#endif
#ifndef MK_ONE_LAUNCH
#define MK_ONE_LAUNCH 1
#endif

#define LAS __attribute__((address_space(3)))
typedef unsigned short bf16;
typedef short bf16x8 __attribute__((ext_vector_type(8)));
typedef float f32x4 __attribute__((ext_vector_type(4)));
typedef float f32x2 __attribute__((ext_vector_type(2)));
typedef unsigned u32x4 __attribute__((ext_vector_type(4)));
typedef unsigned u32x2 __attribute__((ext_vector_type(2)));

constexpr int T = 16384, D = 1024, NBATCH = 8, S = 2048, DEPTH = 4;
constexpr int NMEM = 256;
constexpr float EPS = 1e-6f;
constexpr int HYN = 3072, HYSRC = 2856;
constexpr int C_QA = 0, C_KC = 512, C_VC = 640, C_KS = 768, C_VS = 896, C_KW = 1024, C_VW = 1152, C_QB = 1280, C_KB = 1536, C_VB = 1792, C_RB = 2304, C_GA = 2816, C_AL = 2840;
constexpr int NCMP = 127;
constexpr int NEXP = 16, DEXP = 384;
constexpr int SLOTS = 2 * T + NEXP * 256;

enum { I_X = 0, I_MEM, I_POS, I_NMIX, I_NXAT, I_NMEM, I_NFFN, I_HYBIN, I_HYBOUT, I_QNORM, I_KNORM, I_CMPPE, I_CMPW1, I_CMPW2, I_GATEB, I_WA2, I_BA, I_ONORM,
       I_SGIN, I_LNG, I_LNB, I_SGWS, I_SGBS, I_SGOUT, I_XWQ, I_XWKV, I_XWO, I_XQN, I_XKN, I_RW, I_RB, I_MOEIN, I_MOEOUT, N_IN };

constexpr size_t MiB = 1u << 20;
constexpr size_t WS_CTL = 0, CTL_BYTES = 1 * MiB;
constexpr size_t WS_WHYB = 1 * MiB;
constexpr size_t WS_WHOUT = WS_WHYB + 12 * MiB;
constexpr size_t WS_WSGIN = WS_WHOUT + 4 * MiB;
constexpr size_t WS_WSGOUT = WS_WSGIN + 16 * MiB;
constexpr size_t WS_WQ = WS_WSGOUT + 8 * MiB;
constexpr size_t WS_WKV = WS_WQ + 8 * MiB;
constexpr size_t WS_WO = WS_WKV + 16 * MiB;
constexpr size_t WS_WMIN = WS_WO + 8 * MiB;
constexpr size_t WS_WMOUT = WS_WMIN + 96 * MiB;
constexpr size_t WS_RW = WS_WMOUT + 48 * MiB;
constexpr size_t WS_XN = WS_RW + 1 * MiB;
constexpr size_t WS_BIG = WS_XN + 32 * MiB;
constexpr size_t WS_QA = WS_BIG + 128 * MiB;
constexpr size_t WS_KS = WS_QA + 16 * MiB;
constexpr size_t WS_KW = WS_KS + 4 * MiB;
constexpr size_t WS_KC = WS_KW + 4 * MiB;
constexpr size_t WS_VC = WS_KC + 1 * MiB;
constexpr size_t WS_CAT = WS_VC + 1 * MiB;
constexpr size_t WS_QX = WS_CAT + 32 * MiB;
constexpr size_t WS_OX = WS_QX + 32 * MiB;
constexpr size_t WS_MN = WS_OX + 32 * MiB;
constexpr size_t WS_KV = WS_MN + 4 * MiB;
constexpr size_t WS_COS = WS_KV + 32 * MiB;
constexpr size_t WS_SIN = WS_COS + 2 * MiB;
constexpr size_t WS_LIST = WS_SIN + 2 * MiB;
constexpr size_t WS_TOK = WS_LIST + 1 * MiB;
constexpr size_t WS_VT = WS_TOK + 1 * MiB;
constexpr size_t WS_VTA = WS_VT + 16 * MiB;
constexpr size_t WS_SLOC = WS_VTA + 32 * MiB;
constexpr size_t WS_DEC = WS_SLOC + 32 * MiB;
constexpr size_t WS_STT = WS_DEC + 1 * MiB;
constexpr size_t WS_END = WS_STT + 16 * MiB;
constexpr size_t WS_Y = WS_BIG, WS_H = WS_BIG + 72 * MiB, WS_U = WS_BIG, WS_V = WS_BIG + 64 * MiB, WS_UM = WS_QX;
constexpr int CW_BAR = 4096;
constexpr int CW_CNT = 8192;

constexpr int LDS_BYTES = 159744;
constexpr int LDS_MISC = LDS_BYTES - 64;

__device__ __forceinline__ unsigned f2bf(float f) { unsigned u = __float_as_uint(f); return (u + 0x7fffu + ((u >> 16) & 1u)) >> 16; }
__device__ __forceinline__ float bf2f(unsigned b) { return __uint_as_float(b << 16); }
__device__ __forceinline__ float bflo(unsigned w) { return __uint_as_float(w << 16); }
__device__ __forceinline__ float bfhi(unsigned w) { return __uint_as_float(w & 0xffff0000u); }
__device__ __forceinline__ unsigned pk2(float lo, float hi) { return f2bf(lo) | (f2bf(hi) << 16); }
__device__ __forceinline__ float wave_sum(float v) {
#pragma unroll
    for (int o = 1; o < 64; o <<= 1) v += __shfl_xor(v, o);
    return v;
}
__device__ __forceinline__ float wave_max(float v) {
#pragma unroll
    for (int o = 1; o < 64; o <<= 1) v = fmaxf(v, __shfl_xor(v, o));
    return v;
}
__device__ __forceinline__ int opaque_tid(int wv) { int l; asm volatile("v_mbcnt_lo_u32_b32 %0, -1, 0\n\tv_mbcnt_hi_u32_b32 %0, -1, %0" : "=v"(l)); return wv * 64 + l; }
__device__ __forceinline__ unsigned char* opq(unsigned char* p) { asm volatile("" : "+s"(p)); return p; }
#define LDS_WAIT() asm volatile("s_waitcnt lgkmcnt(0)" ::: "memory")
__device__ __forceinline__ float gelu_tanh(float x) {
    const float u = 0.7978845608028654f * (x + 0.044715f * x * x * x);
    const float e = __expf(-2.0f * fabsf(u));
    float t = (1.0f - e) / (1.0f + e); t = u < 0.f ? -t : t;
    return 0.5f * x * (1.0f + t);
}
__device__ __forceinline__ float sigmoidf_(float x) { return 1.0f / (1.0f + __expf(-x)); }

#define XB_TMO      128
#define XB_XCNT(j)  (256  + 64 * (j))
#define XB_XSUB(j)  (1280 + 64 * (j))
#define XB_XGEN(j)  (2304 + 64 * (j))
#define XB_TOP      3328
#define XB_TOPGEN   3392
#define XCD_BAR_WORDS 3456
#define XB_SPIN_CAP (1u << 22)

__device__ __forceinline__ unsigned xb_ld(unsigned* p)              { return __hip_atomic_load(p, __ATOMIC_RELAXED, __HIP_MEMORY_SCOPE_AGENT); }
__device__ __forceinline__ unsigned xb_add(unsigned* p, unsigned v) { return __hip_atomic_fetch_add(p, v, __ATOMIC_RELAXED, __HIP_MEMORY_SCOPE_AGENT); }
__device__ __forceinline__ unsigned xb_xcc_id() { return (unsigned)__builtin_amdgcn_s_getreg((3 << 11) | 20) & 0xFu; }
#define XB_SPIN(cond, bar) do { unsigned _sp = 0; while (cond) { __builtin_amdgcn_s_sleep(1); \
    if ((++_sp & 255u) == 0u) { if (xb_ld(&(bar)[XB_TMO])) break; if (_sp > XB_SPIN_CAP) { atomicAdd(&(bar)[XB_TMO], 1u); break; } } } } while (0)

struct XcdBarrier { unsigned* bar; unsigned x; volatile LAS unsigned* st; };
__device__ __forceinline__ unsigned* xb_opaque(unsigned* p) { unsigned long long v = (unsigned long long)p; unsigned lo = __builtin_amdgcn_readfirstlane((unsigned)v), hi = __builtin_amdgcn_readfirstlane((unsigned)(v >> 32));
    asm volatile("" : "+s"(lo), "+s"(hi)); return (unsigned*)(((unsigned long long)hi << 32) | lo); }

__device__ __forceinline__ XcdBarrier xcd_barrier_post(unsigned* bar, volatile LAS unsigned* st) {
    XcdBarrier b; b.bar = bar; b.x = xb_xcc_id(); b.st = st;
    if (threadIdx.x == 0) (void)xb_add(&bar[XB_XCNT(b.x)], 1u);
    return b;
}
__device__ __forceinline__ void xcd_barrier_complete(unsigned* bar, unsigned x, unsigned& nloc, unsigned& nx) {
    const unsigned G = gridDim.x * gridDim.y * gridDim.z;
    unsigned sum, cnt, mine, sp = 0u;
    for (;;) {
        sum = 0u; cnt = 0u; mine = 0u;
#pragma unroll
        for (unsigned j = 0; j < 16; ++j) { const unsigned c = xb_ld(&bar[XB_XCNT(j)]); sum += c; cnt += (c > 0u) ? 1u : 0u; mine = (j == x) ? c : mine; }
        if (sum == G) break;
        __builtin_amdgcn_s_sleep(1);
        if ((++sp & 255u) == 0u) { if (xb_ld(&bar[XB_TMO])) break; if (sp > XB_SPIN_CAP) { atomicAdd(&bar[XB_TMO], 1u); break; } }
    }
    nloc = mine > 0u ? mine : 1u; nx = cnt > 0u ? cnt : 1u;
}
__device__ __forceinline__ void xcd_barrier(const XcdBarrier& b, const bool is_t0) {
    asm volatile("s_waitcnt vmcnt(0)" ::: "memory");
    __syncthreads();
    if (is_t0) {
        unsigned* bar = b.bar;
        __builtin_amdgcn_s_waitcnt(0);
        unsigned nloc = b.st[0], nx = b.st[1];
        if (nloc == 0u) { xcd_barrier_complete(bar, b.x, nloc, nx); b.st[0] = nloc; b.st[1] = nx; }
        const unsigned old = xb_add(&bar[XB_XSUB(b.x)], 1u);
        const unsigned gen = old / nloc;
        if (old + 1u == (gen + 1u) * nloc) {
            __builtin_amdgcn_fence(__ATOMIC_RELEASE, "agent");
            asm volatile("s_waitcnt vmcnt(0)" ::: "memory");
            const unsigned og = xb_add(&bar[XB_TOP], 1u);
            const unsigned tg = og / nx;
            if (og + 1u == (tg + 1u) * nx) xb_add(&bar[XB_TOPGEN], 1u);
            else XB_SPIN(xb_ld(&bar[XB_TOPGEN]) == tg, bar);
            __builtin_amdgcn_fence(__ATOMIC_ACQUIRE, "agent");
            xb_add(&bar[XB_XGEN(b.x)], 1u);
            asm volatile("s_waitcnt vmcnt(0)" ::: "memory");
        } else {
            XB_SPIN(xb_ld(&bar[XB_XGEN(b.x)]) == gen, bar);
            __builtin_amdgcn_fence(__ATOMIC_ACQUIRE, "agent");
            asm volatile("s_waitcnt vmcnt(0)" ::: "memory");
        }
    }
    __syncthreads();
}

struct Args {
    const float* in[N_IN];
    float* out;
    unsigned char* ws;
    float freq[32];
    int ph_lo, ph_hi;
};

typedef const __attribute__((address_space(4))) Args* KArgs;
__device__ __forceinline__ KArgs kargs() { KArgs p = (KArgs)__builtin_amdgcn_kernarg_segment_ptr(); asm volatile("" : "+s"(p)); return p; }

__device__ __forceinline__ void st_bf16x4(bf16* p, f32x4 v) { u32x2 w; w.x = pk2(v[0], v[1]); w.y = pk2(v[2], v[3]); *(u32x2*)p = w; }


namespace pg8 {
constexpr int BM = 256, BK = 64, HALF = 128, HTB = HALF * BK * 2, STAGE_BYTES = 8 * HTB, NXCD = 8, WGM = 8;
__host__ __device__ __forceinline__ int lds_byte(int r, int c) { const int st = (r >> 4) * 2 + (c >> 5), rr = r & 15, cc = c & 31, ob = rr * 64 + cc * 2; return st * 1024 + (ob ^ (((ob >> 9) & 1) << 5)); }
__host__ __device__ __forceinline__ void stage_rc(int b, int& R, int& C) { const int st = b / 1024, sb = b % 1024, swz = sb ^ (((sb >> 9) & 1) << 5); R = (st >> 1) * 16 + swz / 64; C = (st & 1) * 32 + (swz % 64) / 2; }
__host__ __device__ __forceinline__ int perm32(int rho) { const int n = rho >> 4, i = rho & 15; return 8 * (i >> 2) + 4 * n + (i & 3); }
struct Unit { int pm, pn, e; };
struct DenseOrder {
    static constexpr bool GATHER = false;
    int nM, nN, nwg, G, c, K; const char* Bt;
    __device__ __forceinline__ void init(int M, int N, int K_, const bf16* Bt_, int G_, int c_) { nM = M / BM; nN = N / BM; nwg = nM * nN; G = G_; c = c_; K = K_; Bt = (const char*)Bt_; }
    __device__ __forceinline__ bool next(int i, Unit& u) const {
        const long L = (long)i * G + c; if (L >= nwg) return false;
        int wgid = (int)L; { const int q = nwg / NXCD, r = nwg % NXCD, xcd = wgid % NXCD, off = wgid / NXCD; wgid = (xcd < r ? xcd * (q + 1) : r * (q + 1) + (xcd - r) * q) + off; }
        const int nig = WGM * nN, gid = wgid / nig, fm = gid * WGM, gsz = (nM - fm) < WGM ? (nM - fm) : WGM;
        u.pm = fm + ((wgid % nig) % gsz); u.pn = (wgid % nig) / gsz; u.e = 0; return true;
    }
    __device__ __forceinline__ unsigned a_voff(const Unit& u, int half, int R) const { return (unsigned)((u.pm * BM + half * HALF + R) * K) * 2u; }
    __device__ __forceinline__ const char* b_tile(const Unit& u) const { return Bt + (size_t)u.pn * BM * K * 2; }
};
template <bool GATH> struct MoeOrder {
    static constexpr bool GATHER = GATH;
    int nunits, ntn, G, c, K; const LAS int* off; const LAS int* cn; const int* list; const char* Bt; size_t estride;
    __device__ __forceinline__ bool next(int i, Unit& u) const {
        const int L = i * G + c; if (L >= nunits) return false;
        u.pm = L / ntn; u.pn = L % ntn; const int s0 = u.pm * BM; int e = 0;
#pragma unroll
        for (int q = 1; q < 16; ++q) e += (s0 >= off[q]) ? 1 : 0;
        u.e = e; return true;
    }
    __device__ __forceinline__ unsigned a_voff(const Unit& u, int half, int R) const {
        const int slot = u.pm * BM + half * HALF + R;
        const int loc = slot - off[u.e]; const int tk = list[u.e * T + (loc < cn[u.e] ? loc : 0)];
        return (unsigned)(tk * K) * 2u;
    }
    __device__ __forceinline__ const char* b_tile(const Unit& u) const { return Bt + (size_t)u.e * estride + (size_t)u.pn * BM * K * 2; }
};
__device__ __forceinline__ unsigned cvt_pk_bf16(float lo, float hi) { unsigned r; asm volatile("v_cvt_pk_bf16_f32 %0, %1, %2" : "=v"(r) : "v"(lo), "v"(hi)); return r; }

template <class Epi, class Sched>
__device__ __forceinline__ void gemm_phase(LAS unsigned char* lds, const bf16* Aptr, int K, const Sched& S, const Epi& E, int wv_) {
    const int tid = opaque_tid(wv_), wid = __builtin_amdgcn_readfirstlane(tid >> 6), lane = tid & 63, wr = wid >> 2, wc = wid & 3, fr = lane & 15, fq = lane >> 4;
    const int nt = K / BK;
    int Rr[2], Cc[2]; unsigned voffA[2], voffB[2];
#pragma unroll
    for (int i = 0; i < 2; ++i) { stage_rc(tid * 16 + i * 8192, Rr[i], Cc[i]); const int Rb = Epi::PERM ? ((Rr[i] & ~31) + perm32(Rr[i] & 31)) : Rr[i];
        voffA[i] = (unsigned)(Rr[i] * K + Cc[i]) * 2u; voffB[i] = (unsigned)(Rb * K + Cc[i]) * 2u; }
    const size_t kstep = (size_t)(BK * 2);
    const size_t hstep = (size_t)HALF * K * 2;
    const size_t tstep = 2 * hstep;
    const unsigned ldsw = (unsigned)wid * 1024u;
    const int aoff = lds_byte(wr * 64 + fr, fq * 8), boff = lds_byte(wc * 32 + fr, fq * 8);
    const char* const Ab = (const char*)Aptr;
#define PG8_SA(b, h) (((b) * 2 + (h)) * HTB)
#define PG8_SB(b, h) ((4 + (b) * 2 + (h)) * HTB)
#define PG8_STAGE(bufoff, gbase, voff) do { _Pragma("unroll") for (int _i = 0; _i < 2; ++_i) \
        __builtin_amdgcn_global_load_lds((const unsigned*)((const char*)(gbase) + (voff)[_i]), (LAS unsigned*)(lds + (bufoff) + ldsw + _i * 8192), 16, 0, 0); } while (0)
#define PG8_STAGE_A(bufoff, usenext, h, kofs) do { \
        if constexpr (Sched::GATHER) { const char* gb_ = Ab + (kofs); unsigned vv_[2] = {(usenext) ? vN[h][0] : vA[h][0], (usenext) ? vN[h][1] : vA[h][1]}; PG8_STAGE(bufoff, gb_, vv_); } \
        else { const char* gb_ = ((usenext) ? nA : cA) + (size_t)(h) * hstep + (kofs); PG8_STAGE(bufoff, gb_, voffA); } } while (0)
#define PG8_LDA(dst, b, h) do { _Pragma("unroll") for (int m = 0; m < 4; ++m) _Pragma("unroll") for (int k = 0; k < 2; ++k) dst[m][k] = *(const LAS bf16x8*)(lds + PG8_SA(b, h) + aoff + m * 2048 + k * 1024); } while (0)
#define PG8_LDB(dst, b, h) do { _Pragma("unroll") for (int n = 0; n < 2; ++n) _Pragma("unroll") for (int k = 0; k < 2; ++k) dst[n][k] = *(const LAS bf16x8*)(lds + PG8_SB(b, h) + boff + n * 2048 + k * 1024); } while (0)
#define PG8_MMA(ai, bj, At, Bt) do { __builtin_amdgcn_s_setprio(1); _Pragma("unroll") for (int m = 0; m < 4; ++m) _Pragma("unroll") for (int n = 0; n < 2; ++n) _Pragma("unroll") for (int k = 0; k < 2; ++k) \
        acc[ai][bj][m][n] = __builtin_amdgcn_mfma_f32_16x16x32_bf16(Bt[n][k], At[m][k], acc[ai][bj][m][n], 0, 0, 0); __builtin_amdgcn_s_setprio(0); } while (0)
#define PG8_WAIT_V(n) asm volatile("s_waitcnt vmcnt(" #n ")" ::: "memory")
#define PG8_WAIT_L(n) asm volatile("s_waitcnt lgkmcnt(" #n ")" ::: "memory")
#define PG8_BAR __builtin_amdgcn_s_barrier()
#define PG8_SCHED __builtin_amdgcn_sched_barrier(0)
    Unit cur, nxt; int ui = 0;
    if (!S.next(0, cur)) return;
    f32x4 acc[2][2][4][2];
#pragma unroll
    for (int a = 0; a < 2; ++a)
#pragma unroll
        for (int b = 0; b < 2; ++b)
#pragma unroll
            for (int m = 0; m < 4; ++m)
#pragma unroll
                for (int n = 0; n < 2; ++n) acc[a][b][m][n] = (f32x4){0.f, 0.f, 0.f, 0.f};
    bf16x8 At[4][2], B0[2][2], B1[2][2];
    unsigned vA[2][2], vN[2][2];
    const char* cA = Ab; const char* nA = Ab;
    if constexpr (Sched::GATHER) {
#pragma unroll
        for (int h = 0; h < 2; ++h)
#pragma unroll
            for (int i = 0; i < 2; ++i) { vA[h][i] = S.a_voff(cur, h, Rr[i]) + (unsigned)Cc[i] * 2u; vN[h][i] = vA[h][i]; }
    } else { cA = Ab + (size_t)cur.pm * tstep; nA = cA; }
    const char* cB = S.b_tile(cur);
    PG8_STAGE(PG8_SB(0, 0), cB, voffB); PG8_STAGE_A(PG8_SA(0, 0), false, 0, 0); PG8_STAGE(PG8_SB(0, 1), cB + hstep, voffB); PG8_STAGE_A(PG8_SA(0, 1), false, 1, 0);
    if (wr == 1) PG8_BAR;
    PG8_WAIT_V(4); PG8_BAR;
    PG8_STAGE(PG8_SB(1, 0), cB + kstep, voffB); PG8_STAGE_A(PG8_SA(1, 0), false, 0, kstep); PG8_STAGE(PG8_SB(1, 1), cB + hstep + kstep, voffB);
    PG8_WAIT_V(6); PG8_BAR;
    for (;;) {
        const bool has_next = S.next(ui + 1, nxt);
        const char* nB = has_next ? S.b_tile(nxt) : cB;
        if constexpr (Sched::GATHER) {
#pragma unroll
            for (int h = 0; h < 2; ++h)
#pragma unroll
                for (int i = 0; i < 2; ++i) vN[h][i] = has_next ? S.a_voff(nxt, h, Rr[i]) + (unsigned)Cc[i] * 2u : vA[h][i];
        } else nA = has_next ? Ab + (size_t)nxt.pm * tstep : cA;
        for (int t = 0; t < nt; t += 2) {
            const bool last = (t == nt - 2);
            const size_t k1 = (size_t)(t + 1) * kstep, k2 = last ? 0 : (size_t)(t + 2) * kstep, k3 = k2 + kstep;
            const char* b2 = last ? nB : cB + (size_t)(t + 2) * kstep; const char* b3 = b2 + kstep;
            PG8_LDB(B0, 0, 0); PG8_SCHED; PG8_LDA(At, 0, 0); PG8_STAGE_A(PG8_SA(1, 1), false, 1, k1);
            PG8_WAIT_L(8); PG8_BAR; PG8_WAIT_L(0); PG8_MMA(0, 0, At, B0); PG8_BAR; PG8_SCHED;
            PG8_LDB(B1, 0, 1); PG8_STAGE(PG8_SB(0, 0), b2, voffB);
            PG8_BAR; PG8_WAIT_L(0); PG8_MMA(0, 1, At, B1); PG8_BAR;
            PG8_LDA(At, 0, 1); PG8_STAGE_A(PG8_SA(0, 0), last, 0, k2);
            PG8_BAR; PG8_WAIT_L(0); PG8_MMA(1, 0, At, B0); PG8_BAR; PG8_SCHED;
            PG8_STAGE(PG8_SB(0, 1), b2 + hstep, voffB);
            PG8_WAIT_V(6); PG8_BAR; PG8_MMA(1, 1, At, B1); PG8_BAR;
            PG8_LDB(B0, 1, 0); PG8_SCHED; PG8_LDA(At, 1, 0); PG8_STAGE_A(PG8_SA(0, 1), last, 1, k2);
            PG8_WAIT_L(8); PG8_BAR; PG8_WAIT_L(0); PG8_MMA(0, 0, At, B0); PG8_BAR; PG8_SCHED;
            PG8_LDB(B1, 1, 1); PG8_STAGE(PG8_SB(1, 0), b3, voffB);
            PG8_BAR; PG8_WAIT_L(0); PG8_MMA(0, 1, At, B1); PG8_BAR;
            PG8_LDA(At, 1, 1); PG8_STAGE_A(PG8_SA(1, 0), last, 0, k3);
            PG8_BAR; PG8_WAIT_L(0); PG8_MMA(1, 0, At, B0); PG8_BAR; PG8_SCHED;
            PG8_STAGE(PG8_SB(1, 1), b3 + hstep, voffB);
            PG8_WAIT_V(6); PG8_BAR; PG8_MMA(1, 1, At, B1); PG8_BAR;
        }
        E(acc, cur, wr, wc, fr, fq);
        if (!has_next) break;
#pragma unroll
        for (int a = 0; a < 2; ++a)
#pragma unroll
            for (int b = 0; b < 2; ++b)
#pragma unroll
                for (int m = 0; m < 4; ++m)
#pragma unroll
                    for (int n = 0; n < 2; ++n) acc[a][b][m][n] = (f32x4){0.f, 0.f, 0.f, 0.f};
        cur = nxt; cB = nB; cA = nA; ++ui;
        if constexpr (Sched::GATHER) {
#pragma unroll
            for (int h = 0; h < 2; ++h)
#pragma unroll
                for (int i = 0; i < 2; ++i) vA[h][i] = vN[h][i];
        }
    }
    PG8_WAIT_V(0);
    if (wr == 0) PG8_BAR;
    PG8_BAR;
#undef PG8_SA
#undef PG8_SB
#undef PG8_STAGE
#undef PG8_STAGE_A
#undef PG8_LDA
#undef PG8_LDB
#undef PG8_MMA
#undef PG8_WAIT_V
#undef PG8_WAIT_L
#undef PG8_BAR
#undef PG8_SCHED
}
template <int ACT> struct EpiBf16 {
    static constexpr bool PERM = true;
    bf16* O; int ldc; int tpt; size_t tstride;
    __device__ __forceinline__ void operator()(const f32x4 (&acc)[2][2][4][2], const Unit& u, int wr, int wc, int fr, int fq) const {
        const int row0 = u.pm * BM + wr * 64 + fr; const int tt = u.pn / tpt; bf16* base = O + (size_t)tt * tstride; const int col0 = (u.pn - tt * tpt) * BM + wc * 32 + 8 * fq;
#pragma unroll
        for (int ai = 0; ai < 2; ++ai)
#pragma unroll
            for (int m = 0; m < 4; ++m) { bf16* rowp = base + (size_t)(row0 + ai * HALF + m * 16) * ldc + col0;
#pragma unroll
                for (int bj = 0; bj < 2; ++bj) { f32x4 v0 = acc[ai][bj][m][0], v1 = acc[ai][bj][m][1];
                    if (ACT == 1) {
#pragma unroll
                        for (int q = 0; q < 4; ++q) { v0[q] = gelu_tanh(v0[q]); v1[q] = gelu_tanh(v1[q]); } }
                    u32x4 w; w.x = cvt_pk_bf16(v0[0], v0[1]); w.y = cvt_pk_bf16(v0[2], v0[3]); w.z = cvt_pk_bf16(v1[0], v1[1]); w.w = cvt_pk_bf16(v1[2], v1[3]);
                    *(u32x4*)(rowp + bj * HALF) = w; } }
    }
};
struct EpiResAdd {
    static constexpr bool PERM = false;
    float* X; int ldc;
    __device__ __forceinline__ void operator()(const f32x4 (&acc)[2][2][4][2], const Unit& u, int wr, int wc, int fr, int fq) const {
        const int row0 = u.pm * BM + wr * 64 + fr, col0 = u.pn * BM + wc * 32 + 4 * fq;
#pragma unroll
        for (int ai = 0; ai < 2; ++ai)
#pragma unroll
            for (int m = 0; m < 4; ++m) { float* rowp = X + (size_t)(row0 + ai * HALF + m * 16) * ldc + col0;
#pragma unroll
                for (int bj = 0; bj < 2; ++bj)
#pragma unroll
                    for (int n = 0; n < 2; ++n) { f32x4* p = (f32x4*)(rowp + bj * HALF + n * 16); *p = *p + acc[ai][bj][m][n]; } }
    }
};
struct EpiSwiglu {
    static constexpr bool PERM = true;
    bf16* H; int ldc;
    __device__ __forceinline__ void operator()(const f32x4 (&acc)[2][2][4][2], const Unit& u, int wr, int wc, int fr, int fq) const {
        const int row0 = u.pm * BM + wr * 64 + fr, col0 = u.pn * HALF + wc * 32 + 8 * fq;
#pragma unroll
        for (int ai = 0; ai < 2; ++ai)
#pragma unroll
            for (int m = 0; m < 4; ++m) {
                float o[8];
#pragma unroll
                for (int n = 0; n < 2; ++n)
#pragma unroll
                    for (int q = 0; q < 4; ++q) { const float g = acc[ai][0][m][n][q]; o[4 * n + q] = g * sigmoidf_(g) * acc[ai][1][m][n][q]; }
                u32x4 w; w.x = cvt_pk_bf16(o[0], o[1]); w.y = cvt_pk_bf16(o[2], o[3]); w.z = cvt_pk_bf16(o[4], o[5]); w.w = cvt_pk_bf16(o[6], o[7]);
                *(u32x4*)(H + (size_t)(row0 + ai * HALF + m * 16) * ldc + col0) = w; }
    }
};
}

__device__ __forceinline__ int hyb_colmap(int n) {
    if (n < 1280) return n;
    if (n < 1536) return 1304 + (n - 1280);
    if (n < 1792) return 1560 + (n - 1536);
    if (n < 2304) return 1816 + (n - 1792);
    if (n < 2816) return 2344 + (n - 2304);
    if (n < 2840) return 1280 + (n - 2816);
    if (n < 2856) return 2328 + (n - 2840);
    return -1;
}
__device__ __forceinline__ void tr_item(const float* __restrict__ W, int Nsrc, int K, bf16* __restrict__ Wt, const float* __restrict__ gain, int kind, int nblk, LAS float* scr, int item, int lane) {
    const int kb = item / nblk, nb = item % nblk, k0 = 64 * kb, n0 = 32 * nb;
    const int j = lane & 31, n = n0 + j;
    int col;
    if (kind == 0) col = n; else if (kind == 1) col = hyb_colmap(n); else { const int pn = n >> 8, r = n & 255; col = (r >> 7) * 384 + pn * 128 + (r & 127); }
#pragma unroll 8
    for (int i = 0; i < 32; ++i) {
        const int kk = 2 * i + (lane >> 5); float v = 0.f;
        if (col >= 0) { v = W[(size_t)(k0 + kk) * Nsrc + col]; if (gain) v *= gain[k0 + kk]; }
        scr[kk * 33 + j] = v;
    }
    LDS_WAIT();
    const int c = lane & 7;
#pragma unroll
    for (int jx = 0; jx < 4; ++jx) {
        const int nn = (lane >> 3) + 8 * jx; const LAS float* s = scr + (8 * c) * 33 + nn;
        u32x4 o; o.x = pk2(s[0 * 33], s[1 * 33]); o.y = pk2(s[2 * 33], s[3 * 33]); o.z = pk2(s[4 * 33], s[5 * 33]); o.w = pk2(s[6 * 33], s[7 * 33]);
        *(u32x4*)(Wt + (size_t)(n0 + nn) * K + k0 + 8 * c) = o;
    }
    LDS_WAIT();
}
__device__ __forceinline__ void rms_row_to_bf16(const float* __restrict__ xrow, bf16* __restrict__ orow, float* __restrict__ copy, int lane) {
    const f32x4* xr = (const f32x4*)xrow + lane;
    f32x4 v[4]; float s = 0.f;
#pragma unroll
    for (int j = 0; j < 4; ++j) { v[j] = xr[64 * j]; s += (v[j].x * v[j].x + v[j].y * v[j].y) + (v[j].z * v[j].z + v[j].w * v[j].w); }
    const float rstd = rsqrtf(wave_sum(s) * (1.f / 1024.f) + EPS);
    u32x2* o8 = (u32x2*)orow + lane;
#pragma unroll
    for (int j = 0; j < 4; ++j) { u32x2 w; w.x = pk2(v[j].x * rstd, v[j].y * rstd); w.y = pk2(v[j].z * rstd, v[j].w * rstd); o8[64 * j] = w; }
    if (copy) { f32x4* c4 = (f32x4*)copy + lane;
#pragma unroll
        for (int j = 0; j < 4; ++j) c4[64 * j] = v[j]; }
}

__device__ __forceinline__ void phase_prologue(KArgs A, int wv_, LAS unsigned char* lds) {
    const int tid = opaque_tid(wv_), wid = __builtin_amdgcn_readfirstlane(tid >> 6), lane = tid & 63;
    const int gw = blockIdx.x * 8 + wid, NGW = gridDim.x * 8;
    LAS float* scr = (LAS float*)(lds + wid * 16384);
    unsigned char* ws = opq(A->ws);
    constexpr int N_HYB = 2 * 1536, N_HOUT = 2 * 512, N_SGIN = 2 * 2048, N_SGOUT = 2 * 1024, N_WQ = 4 * 512, N_WKV = 4 * 1024, N_WO = 4 * 512, N_MIN = 64 * 384, N_MOUT = 64 * 192;
    constexpr int NITEMS = N_HYB + N_HOUT + N_SGIN + N_SGOUT + N_WQ + N_WKV + N_WO + N_MIN + N_MOUT;
    for (int it = gw; it < NITEMS; it += NGW) {
        int r = it;
        if (r < N_HYB) { const int sl = r / 1536; tr_item(A->in[I_HYBIN] + (size_t)sl * 1024 * HYSRC, HYSRC, 1024, (bf16*)(ws + WS_WHYB) + (size_t)sl * HYN * 1024, A->in[I_NMIX] + (2 * sl) * 1024, 1, 96, scr, r % 1536, lane); continue; } r -= N_HYB;
        if (r < N_HOUT) { const int sl = r / 512; tr_item(A->in[I_HYBOUT] + (size_t)sl * 1024 * 1024, 1024, 1024, (bf16*)(ws + WS_WHOUT) + (size_t)sl * 1024 * 1024, nullptr, 0, 32, scr, r % 512, lane); continue; } r -= N_HOUT;
        if (r < N_SGIN) { const int sl = r / 2048; tr_item(A->in[I_SGIN] + (size_t)sl * 1024 * 4096, 4096, 1024, (bf16*)(ws + WS_WSGIN) + (size_t)sl * 4096 * 1024, A->in[I_NMIX] + (2 * sl + 1) * 1024, 0, 128, scr, r % 2048, lane); continue; } r -= N_SGIN;
        if (r < N_SGOUT) { const int sl = r / 1024; tr_item(A->in[I_SGOUT] + (size_t)sl * 2048 * 1024, 1024, 2048, (bf16*)(ws + WS_WSGOUT) + (size_t)sl * 1024 * 2048, nullptr, 0, 32, scr, r % 1024, lane); continue; } r -= N_SGOUT;
        if (r < N_WQ) { const int sl = r / 512; tr_item(A->in[I_XWQ] + (size_t)sl * 1024 * 1024, 1024, 1024, (bf16*)(ws + WS_WQ) + (size_t)sl * 1024 * 1024, A->in[I_NXAT] + sl * 1024, 0, 32, scr, r % 512, lane); continue; } r -= N_WQ;
        if (r < N_WKV) { const int sl = r / 1024; tr_item(A->in[I_XWKV] + (size_t)sl * 1024 * 2048, 2048, 1024, (bf16*)(ws + WS_WKV) + (size_t)sl * 2048 * 1024, A->in[I_NMEM] + sl * 1024, 0, 64, scr, r % 1024, lane); continue; } r -= N_WKV;
        if (r < N_WO) { const int sl = r / 512; tr_item(A->in[I_XWO] + (size_t)sl * 1024 * 1024, 1024, 1024, (bf16*)(ws + WS_WO) + (size_t)sl * 1024 * 1024, nullptr, 0, 32, scr, r % 512, lane); continue; } r -= N_WO;
        if (r < N_MIN) { const int sl = r / 384; tr_item(A->in[I_MOEIN] + (size_t)sl * 1024 * 768, 768, 1024, (bf16*)(ws + WS_WMIN) + (size_t)sl * 768 * 1024, A->in[I_NFFN] + (sl >> 4) * 1024, 2, 24, scr, r % 384, lane); continue; } r -= N_MIN;
        { const int sl = r / 192; tr_item(A->in[I_MOEOUT] + (size_t)sl * 384 * 1024, 1024, 384, (bf16*)(ws + WS_WMOUT) + (size_t)sl * 1024 * 384, nullptr, 0, 32, scr, r % 192, lane); }
    }
    for (int m = gw; m < T; m += NGW) rms_row_to_bf16(A->in[I_X] + (size_t)m * D, (bf16*)(ws + WS_XN) + (size_t)m * D, A->out + (size_t)m * D, lane);
    for (int m = gw; m < NBATCH * NMEM; m += NGW) rms_row_to_bf16(A->in[I_MEM] + (size_t)m * D, (bf16*)(ws + WS_MN) + (size_t)m * D, nullptr, lane);
    const int gt = blockIdx.x * 512 + tid, NGT = gridDim.x * 512;
    const int* pos = (const int*)A->in[I_POS];
    float* cosT = (float*)(ws + WS_COS); float* sinT = (float*)(ws + WS_SIN);
    for (int i = gt; i < T * 32; i += NGT) {
        const int t = i >> 5, j = i & 31;
        const float ang = (float)pos[t] * A->freq[j];
        const double rev = (double)ang * 0.15915494309189533577;
        const float fr = (float)(rev - rint(rev));
        cosT[i] = __builtin_amdgcn_cosf(fr); sinT[i] = __builtin_amdgcn_sinf(fr);
    }
    float* RW = (float*)(ws + WS_RW);
    for (int i = gt; i < DEPTH * NEXP * D; i += NGT) { const int k = i & 1023, e = (i >> 10) & 15, l = i >> 14; RW[i] = A->in[I_RW][k * NEXP + e] * A->in[I_NFFN][l * D + k]; }
}

__device__ __forceinline__ void phase_knorm(KArgs A, int wv_) {
    const int tid_ = opaque_tid(wv_); const int wid = __builtin_amdgcn_readfirstlane(tid_ >> 6), lane = tid_ & 63; const int gw = blockIdx.x * 8 + wid, NGW = gridDim.x * 8;
    bf16* KV = (bf16*)(opq(A->ws) + WS_KV);
    for (int it = gw; it < DEPTH * 2048 * 4; it += NGW) {
        const int h = it & 3, m = (it >> 2) & 2047, l = it >> 13;
        bf16* p = KV + (size_t)m * 8192 + l * 2048 + h * 256 + 4 * lane;
        const u32x2 w = *(const u32x2*)p;
        float x0 = bflo(w.x), x1 = bfhi(w.x), x2 = bflo(w.y), x3 = bfhi(w.y);
        const float rstd = rsqrtf(wave_sum(x0 * x0 + x1 * x1 + x2 * x2 + x3 * x3) * (1.f / 256.f) + EPS) * 0.0625f;
        const f32x4 g = *(const f32x4*)(A->in[I_XKN] + l * 256 + 4 * lane);
        u32x2 o; o.x = pk2(x0 * rstd * g.x, x1 * rstd * g.y); o.y = pk2(x2 * rstd * g.z, x3 * rstd * g.w);
        *(u32x2*)p = o;
    }
}

__device__ __forceinline__ int kpos64(int tok) { const int k = tok & 31; return (tok & 32) + 8 * ((k >> 2) & 3) + 4 * (k >> 4) + (k & 3); }
__device__ __forceinline__ int kperm64(int p) { const int fq = (p >> 3) & 3, j = p & 7; return (p & 32) + 16 * (j >> 2) + 4 * fq + (j & 3); }

__device__ __forceinline__ void phase_nsa_prep(KArgs A, int wv_, int i, LAS unsigned char* lds) {
    const int tid_ = opaque_tid(wv_); const int wid = __builtin_amdgcn_readfirstlane(tid_ >> 6), lane = tid_ & 63; const int gw = blockIdx.x * 8 + wid, NGW = gridDim.x * 8;
    unsigned char* ws = opq(A->ws);
    const bf16* HY = (const bf16*)(ws + WS_BIG);
    const float* cosT = (const float*)(ws + WS_COS); const float* sinT = (const float*)(ws + WS_SIN);
    bf16* QA = (bf16*)(ws + WS_QA); bf16* KS = (bf16*)(ws + WS_KS); bf16* KW = (bf16*)(ws + WS_KW);
    LAS float* abuf = (LAS float*)(lds + wid * 8192);
    const int NIT = T + NBATCH * NCMP * 2 * 2;
    for (int it = gw; it < NIT; it += NGW) {
        if (it < T) {
            const int t = it;
            const float c = cosT[t * 32 + (lane & 31)], s = sinT[t * 32 + (lane & 31)];
#pragma unroll
            for (int u = 0; u < 12; ++u) {
                int src; const float* gain; bf16* dst; float scale;
                if (u < 8) { src = C_QA + 64 * u; gain = A->in[I_QNORM] + i * 64; dst = QA + (size_t)t * 512 + 64 * u; scale = 0.125f; }
                else if (u < 10) { src = C_KS + 64 * (u - 8); gain = A->in[I_KNORM] + (i * 3 + 1) * 64; dst = KS + (size_t)t * 128 + 64 * (u - 8); scale = 1.f; }
                else { src = C_KW + 64 * (u - 10); gain = A->in[I_KNORM] + (i * 3 + 2) * 64; dst = KW + (size_t)t * 128 + 64 * (u - 10); scale = 1.f; }
                const float x = bf2f(HY[(size_t)t * HYN + src + lane]);
                const float y = x * rsqrtf(wave_sum(x * x) * (1.f / 64.f) + EPS) * gain[lane] * scale;
                const float pr = __shfl_xor(y, 32);
                const float o = lane < 32 ? y * c - pr * s : y * c + pr * s;
                dst[lane] = (bf16)f2bf(o);
            }
        } else {
            const int r = it - T; const int kv = r & 1, g = (r >> 1) & 1, bn = r >> 2, n = bn % NCMP, b = bn / NCMP;
            const float* pe = A->in[I_CMPPE] + (size_t)(i * 2 + kv) * 32 * 64;
            const float* w1 = A->in[I_CMPW1] + (size_t)(i * 2 + kv) * 2048 * 64;
            const float* w2 = A->in[I_CMPW2] + (size_t)(i * 2 + kv) * 64 * 64;
            const int tok0 = b * S + 16 * n, coff = (kv ? C_VC : C_KC) + g * 64;
#pragma unroll 4
            for (int l = 0; l < 32; ++l) abuf[l * 64 + lane] = bf2f(HY[(size_t)(tok0 + l) * HYN + coff + lane]) + pe[l * 64 + lane];
            LDS_WAIT();
            float acc = 0.f;
#pragma unroll 8
            for (int k = 0; k < 2048; ++k) acc += abuf[k] * w1[k * 64 + lane];
            const float h = gelu_tanh(acc);
            float o = 0.f;
#pragma unroll 8
            for (int m = 0; m < 64; ++m) o += __shfl(h, m) * w2[m * 64 + lane];
            LDS_WAIT();
            const size_t oidx = ((size_t)(b * 128 + n) * 2 + g) * 64 + lane;
            if (kv == 0) {
                const float y = o * rsqrtf(wave_sum(o * o) * (1.f / 64.f) + EPS) * A->in[I_KNORM][(i * 3 + 0) * 64 + lane];
                const int tp = tok0 + 31;
                const float c = cosT[tp * 32 + (lane & 31)], s = sinT[tp * 32 + (lane & 31)];
                const float pr = __shfl_xor(y, 32);
                const float oo = lane < 32 ? y * c - pr * s : y * c + pr * s;
                ((bf16*)(ws + WS_KC))[oidx] = (bf16)f2bf(oo);
            } else {
                bf16* vct = (bf16*)(ws + WS_VC) + ((size_t)(b * 2 + g) * 64 + lane) * 128;
                vct[(n & 64) + kpos64(n & 63)] = (bf16)f2bf(o);
                if (n == 126) vct[127] = 0;
                (void)oidx;
            }
        }
    }
}

__device__ __forceinline__ void nsa_block(const LAS float* qs, const bf16* __restrict__ krow, bool ok, const bf16* __restrict__ vbase, int vstride, int lane,
                                          float (&m)[4], float (&l)[4], float (&o)[4]) {
    float s[4] = {0.f, 0.f, 0.f, 0.f};
#pragma unroll 2
    for (int c = 0; c < 8; ++c) {
        const u32x4 kw = *(const u32x4*)(krow + 8 * c);
        const float k0 = bflo(kw.x), k1 = bfhi(kw.x), k2 = bflo(kw.y), k3 = bfhi(kw.y), k4 = bflo(kw.z), k5 = bfhi(kw.z), k6 = bflo(kw.w), k7 = bfhi(kw.w);
#pragma unroll
        for (int hh = 0; hh < 4; ++hh) {
            const f32x4 qa = *(const LAS f32x4*)(qs + hh * 64 + 8 * c), qb = *(const LAS f32x4*)(qs + hh * 64 + 8 * c + 4);
            s[hh] += (qa.x * k0 + qa.y * k1) + (qa.z * k2 + qa.w * k3) + (qb.x * k4 + qb.y * k5) + (qb.z * k6 + qb.w * k7);
        }
    }
    float p[4];
#pragma unroll
    for (int hh = 0; hh < 4; ++hh) {
        const float sv = ok ? s[hh] : -INFINITY;
        const float bm = wave_max(sv);
        const float mn = fmaxf(m[hh], bm);
        if (mn == -INFINITY) { p[hh] = 0.f; continue; }
        const float alpha = __expf(m[hh] - mn);
        p[hh] = ok ? __expf(sv - mn) : 0.f;
        l[hh] = l[hh] * alpha + wave_sum(p[hh]);
        o[hh] *= alpha; m[hh] = mn;
    }
#pragma unroll 8
    for (int kk = 0; kk < 64; ++kk) {
        const float v = bf2f(vbase[(size_t)kk * vstride + lane]);
#pragma unroll
        for (int hh = 0; hh < 4; ++hh) o[hh] += __shfl(p[hh], kk) * v;
    }
}
__device__ __forceinline__ void phase_nsa_attn(KArgs A, int wv_, int i, LAS unsigned char* lds) {
    const int tid_ = opaque_tid(wv_); const int wid = __builtin_amdgcn_readfirstlane(tid_ >> 6), lane0 = tid_ & 63; const int gw = blockIdx.x * 8 + wid, NGW = gridDim.x * 8;
    unsigned char* ws = opq(A->ws);
    const bf16* HY = (const bf16*)(ws + WS_BIG); const bf16* QA = (const bf16*)(ws + WS_QA); const bf16* KS = (const bf16*)(ws + WS_KS); const bf16* KW = (const bf16*)(ws + WS_KW);
    const bf16* KC = (const bf16*)(ws + WS_KC); const bf16* VC = (const bf16*)(ws + WS_VC); bf16* CAT = (bf16*)(ws + WS_CAT);
    LAS float* qs = (LAS float*)(lds + wid * 2048);
    LAS float* ps = qs + 256;
    for (int it = gw; it < 2 * T; it += NGW) {
        int lane = lane0; asm volatile("" : "+v"(lane));
        const int tok = it >> 1, g = it & 1, b = tok >> 11, t = tok & 2047;
#pragma unroll
        for (int hh = 0; hh < 4; ++hh) qs[hh * 64 + lane] = bf2f(QA[(size_t)tok * 512 + (g * 4 + hh) * 64 + lane]);
        LDS_WAIT();
        const int ncv = t >= 31 ? ((t - 31) >> 4) + 1 : 0;
        float oc[4] = {0.f, 0.f, 0.f, 0.f};
        float psum0 = 0.f, psum1 = 0.f;
        {
            const bool v0 = lane < ncv, v1 = lane + 64 < ncv;
            const bf16* k0p = KC + ((size_t)(b * 128 + lane) * 2 + g) * 64;
            const bf16* k1p = KC + ((size_t)(b * 128 + (lane + 64 < 127 ? lane + 64 : 126)) * 2 + g) * 64;
            float s0[4] = {0.f, 0.f, 0.f, 0.f}, s1[4] = {0.f, 0.f, 0.f, 0.f};
#pragma unroll 2
            for (int c = 0; c < 8; ++c) {
                const u32x4 ka = *(const u32x4*)(k0p + 8 * c), kb = *(const u32x4*)(k1p + 8 * c);
#pragma unroll
                for (int hh = 0; hh < 4; ++hh) {
                    const f32x4 qa = *(const LAS f32x4*)(qs + hh * 64 + 8 * c), qb = *(const LAS f32x4*)(qs + hh * 64 + 8 * c + 4);
                    s0[hh] += (qa.x * bflo(ka.x) + qa.y * bfhi(ka.x)) + (qa.z * bflo(ka.y) + qa.w * bfhi(ka.y)) + (qb.x * bflo(ka.z) + qb.y * bfhi(ka.z)) + (qb.z * bflo(ka.w) + qb.w * bfhi(ka.w));
                    s1[hh] += (qa.x * bflo(kb.x) + qa.y * bfhi(kb.x)) + (qa.z * bflo(kb.y) + qa.w * bfhi(kb.y)) + (qb.x * bflo(kb.z) + qb.y * bfhi(kb.z)) + (qb.z * bflo(kb.w) + qb.w * bfhi(kb.w));
                }
            }
            float p0[4], p1[4];
#pragma unroll
            for (int hh = 0; hh < 4; ++hh) {
                const float a0 = v0 ? s0[hh] : -INFINITY, a1 = v1 ? s1[hh] : -INFINITY;
                const float mx = wave_max(fmaxf(a0, a1));
                if (ncv > 0) {
                    const float e0 = v0 ? __expf(a0 - mx) : 0.f, e1 = v1 ? __expf(a1 - mx) : 0.f;
                    const float inv = 1.0f / wave_sum(e0 + e1);
                    p0[hh] = e0 * inv; p1[hh] = e1 * inv;
                } else { p0[hh] = 0.f; p1[hh] = 0.f; }
                psum0 += p0[hh]; psum1 += p1[hh];
            }
#pragma unroll 2
            for (int c = 0; c < ncv; ++c) {
                const float v = bf2f(VC[((size_t)(b * 128 + c) * 2 + g) * 64 + lane]);
#pragma unroll
                for (int hh = 0; hh < 4; ++hh) oc[hh] += __shfl(c < 64 ? p0[hh] : p1[hh], c & 63) * v;
            }
        }
        ps[lane] = psum0; ps[64 + lane] = psum1;
        LDS_WAIT();
        const int cur = t >> 6;
        unsigned selmask;
        {
            const int j = lane & 31;
            float imp = ps[4 * j] + ps[4 * j + 1] + ps[4 * j + 2] + 0.5f * ps[4 * j + 3] + (j > 0 ? 0.5f * ps[4 * j - 1] : 0.f);
            const bool valid = j <= cur, forced = (j == 0) || (j == cur) || (j == cur - 1);
            const float score = valid ? imp + (forced ? 1000.0f : 0.f) : -INFINITY;
            int rank = 0;
#pragma unroll 8
            for (int jj = 0; jj < 32; ++jj) { const float sj = __shfl(score, jj); rank += (sj > score || (sj == score && jj < j)) ? 1 : 0; }
            const bool sel = valid && rank < 8 && lane < 32;
            selmask = (unsigned)__ballot(sel);
        }
        LDS_WAIT();
        float o1[4] = {0.f, 0.f, 0.f, 0.f}, o2[4] = {0.f, 0.f, 0.f, 0.f};
#pragma unroll 1
        for (int pass = 0; pass < 2; ++pass) {
            float oa[4] = {0.f, 0.f, 0.f, 0.f}, ma[4] = {-INFINITY, -INFINITY, -INFINITY, -INFINITY}, la[4] = {0.f, 0.f, 0.f, 0.f};
            const int lo = pass ? (t - 255 > 0 ? t - 255 : 0) : 0;
            const unsigned bm = pass ? 0xffffffffu : selmask;
            const bf16* Kb = pass ? KW : KS; const int vc = pass ? C_VW : C_VS;
#pragma unroll 1
            for (int j = lo >> 6; j <= cur; ++j) {
                if (!((bm >> j) & 1u)) continue;
                const int key = 64 * j + lane; const size_t kt = (size_t)(b * S + key);
                nsa_block(qs, Kb + kt * 128 + g * 64, key <= t && key >= lo, HY + (size_t)(b * S + 64 * j) * HYN + vc + g * 64, HYN, lane, ma, la, oa);
            }
            if (pass == 0) {
#pragma unroll
                for (int hh = 0; hh < 4; ++hh) o1[hh] = oa[hh] / la[hh];
            } else {
#pragma unroll
                for (int hh = 0; hh < 4; ++hh) o2[hh] = oa[hh] / la[hh];
            }
        }
#pragma unroll
        for (int hh = 0; hh < 4; ++hh) {
            const int head = g * 4 + hh;
            const float* gb = A->in[I_GATEB] + i * 24 + head * 3;
            const bf16* gl = HY + (size_t)tok * HYN + C_GA + head * 3;
            const float g0 = sigmoidf_(bf2f(gl[0]) + gb[0]), g1 = sigmoidf_(bf2f(gl[1]) + gb[1]), g2 = sigmoidf_(bf2f(gl[2]) + gb[2]);
            const float o = g0 * oc[hh] + g1 * o1[hh] + g2 * o2[hh];
            CAT[(size_t)tok * 1024 + head * 64 + lane] = (bf16)f2bf(o);
        }
    }
}

__device__ __forceinline__ void phase_gla_seq(KArgs A, int wv_, int i, LAS unsigned char* lds) {
    const int tid = opaque_tid(wv_), wid = __builtin_amdgcn_readfirstlane(tid >> 6), lane = tid & 63;
    unsigned char* ws = opq(A->ws);
    const bf16* HY = (const bf16*)(ws + WS_BIG); bf16* CAT = (bf16*)(ws + WS_CAT);
    constexpr int CH = 16;
    LAS float* la = (LAS float*)lds;
    LAS float* lk = la + 4 * CH * 64;
    LAS float* lq = lk + 4 * CH * 64;
    LAS float* lo = lq + 4 * CH * 64;
    const float* wa2 = A->in[I_WA2] + i * 16 * 256; const float* ba = A->in[I_BA] + i * 256; const float* og = A->in[I_ONORM] + i * 128;
    for (int it = blockIdx.x; it < 8; it += gridDim.x) {
        const int pl = tid >> 7, v = tid & 127, p = it * 4 + pl, b = p >> 2, h = p & 3;
        float St[64];
#pragma unroll
        for (int k = 0; k < 64; ++k) St[k] = 0.f;
        for (int c0 = 0; c0 < S; c0 += CH) {
            __syncthreads();
            for (int e = tid; e < 4 * CH * 64; e += 512) {
                const int kk = e & 63, tk = (e >> 6) % CH, pp = e / (64 * CH); const int pb = (it * 4 + pp) >> 2, ph = (it * 4 + pp) & 3;
                const size_t tok = (size_t)pb * S + c0 + tk; const bf16* row = HY + tok * HYN;
                float z = ba[ph * 64 + kk];
#pragma unroll
                for (int r = 0; r < 16; ++r) z += bf2f(row[C_AL + r]) * wa2[r * 256 + ph * 64 + kk];
                const float ls_ = fminf(z, 0.f) - log1pf(__expf(-fabsf(z)));
                la[e] = __expf(ls_ * (1.f / 16.f));
                lk[e] = bf2f(row[C_KB + ph * 64 + kk]);
                lq[e] = bf2f(row[C_QB + ph * 64 + kk]) * 0.125f;
            }
            __syncthreads();
            for (int tk = 0; tk < CH; ++tk) {
                const size_t tok = (size_t)b * S + c0 + tk;
                const float vv = bf2f(HY[tok * HYN + C_VB + h * 128 + v]);
                const LAS float* pa = la + (pl * CH + tk) * 64; const LAS float* pk = lk + (pl * CH + tk) * 64; const LAS float* pq = lq + (pl * CH + tk) * 64;
                float o = 0.f;
#pragma unroll
                for (int k4 = 0; k4 < 16; ++k4) {
                    const f32x4 a4 = *(const LAS f32x4*)(pa + 4 * k4), k4v = *(const LAS f32x4*)(pk + 4 * k4), q4 = *(const LAS f32x4*)(pq + 4 * k4);
                    St[4 * k4 + 0] = a4.x * St[4 * k4 + 0] + k4v.x * vv; o += q4.x * St[4 * k4 + 0];
                    St[4 * k4 + 1] = a4.y * St[4 * k4 + 1] + k4v.y * vv; o += q4.y * St[4 * k4 + 1];
                    St[4 * k4 + 2] = a4.z * St[4 * k4 + 2] + k4v.z * vv; o += q4.z * St[4 * k4 + 2];
                    St[4 * k4 + 3] = a4.w * St[4 * k4 + 3] + k4v.w * vv; o += q4.w * St[4 * k4 + 3];
                }
                lo[(pl * CH + tk) * 128 + v] = o;
            }
            __syncthreads();
            for (int r = wid; r < 4 * CH; r += 8) {
                const int pp = r / CH, tk = r % CH; const int pb = (it * 4 + pp) >> 2, ph = (it * 4 + pp) & 3;
                const size_t tok = (size_t)pb * S + c0 + tk;
                const float x0 = lo[r * 128 + lane], x1 = lo[r * 128 + 64 + lane];
                const float rstd = rsqrtf(wave_sum(x0 * x0 + x1 * x1) * (1.f / 128.f) + EPS);
                const float r0 = bf2f(HY[tok * HYN + C_RB + ph * 128 + lane]), r1 = bf2f(HY[tok * HYN + C_RB + ph * 128 + 64 + lane]);
                CAT[tok * 1024 + 512 + ph * 128 + lane] = (bf16)f2bf(x0 * rstd * og[lane] * (r0 * sigmoidf_(r0)));
                CAT[tok * 1024 + 512 + ph * 128 + 64 + lane] = (bf16)f2bf(x1 * rstd * og[64 + lane] * (r1 * sigmoidf_(r1)));
            }
        }
        __syncthreads();
    }
}


__device__ __forceinline__ void phase_nsa_attn_mfma(KArgs A, int wv_, int i, LAS unsigned char* lds) {
    const int tid = opaque_tid(wv_), wid = __builtin_amdgcn_readfirstlane(tid >> 6), lane = tid & 63, fr = lane & 15, fq = lane >> 4;
    unsigned char* ws = opq(A->ws);
    const bf16* HY = (const bf16*)(ws + WS_BIG); const bf16* QA = (const bf16*)(ws + WS_QA); const bf16* KS = (const bf16*)(ws + WS_KS); const bf16* KW = (const bf16*)(ws + WS_KW);
    const bf16* KC = (const bf16*)(ws + WS_KC); const bf16* VCT = (const bf16*)(ws + WS_VC); const bf16* VTA = (const bf16*)(ws + WS_VTA); bf16* CAT = (bf16*)(ws + WS_CAT);
    constexpr int RS = 72;
    LAS bf16* ktl = (LAS bf16*)lds;
    LAS bf16* vtl = ktl + 2 * 64 * RS;
    LAS float* scl = (LAS float*)(lds + 36864) + wid * 256;
    LAS unsigned* msk = (LAS unsigned*)(lds + 36864 + 8192);
    LAS unsigned* umask = msk + 64;
    const float* gb = A->in[I_GATEB] + i * 24;
    for (int pit = blockIdx.x; pit < 256; pit += gridDim.x) {
#pragma unroll 1
        for (int hf = 0; hf < 2; ++hf) {
            const int bg = pit >> 4, xx = pit & 15, x = hf ? 31 - xx : xx, b = bg >> 1, g = bg & 1;
            const size_t tokbase = (size_t)b * S + 64 * x;
            const int tl0 = 8 * wid + (fr >> 2);
            if (tid == 0) *umask = 0u;
            bf16x8 qf[2][2];
#pragma unroll
            for (int mt = 0; mt < 2; ++mt)
#pragma unroll
                for (int s = 0; s < 2; ++s) qf[mt][s] = *(const bf16x8*)(QA + (tokbase + tl0 + 4 * mt) * 512 + (g * 4 + (fr & 3)) * 64 + 32 * s + 8 * fq);
            f32x4 outacc[2][4];
            {
                const int tmaxc = (4 * x + 3 + 15) >> 4;
                const bf16* kcb = KC + ((size_t)(b * 128 + fr) * 2 + g) * 64 + 8 * fq;
                bf16x8 pcf[2][4];
#pragma unroll
                for (int mt = 0; mt < 2; ++mt) {
                    f32x4 sc[8];
                    const bf16* kp = kcb;
#pragma unroll
                    for (int t = 0; t < 8; ++t) { sc[t] = (f32x4){0.f, 0.f, 0.f, 0.f};
                        asm volatile("" : "+v"(kp));
                        if (t < tmaxc) {
                            const bf16x8 k0 = *(const bf16x8*)(kp), k1 = *(const bf16x8*)(kp + 32);
                            sc[t] = __builtin_amdgcn_mfma_f32_16x16x32_bf16(k0, qf[mt][0], sc[t], 0, 0, 0);
                            sc[t] = __builtin_amdgcn_mfma_f32_16x16x32_bf16(k1, qf[mt][1], sc[t], 0, 0, 0); }
                        kp += 16 * 128; }
                    const int tg = 64 * x + tl0 + 4 * mt; const int ncv = tg >= 31 ? ((tg - 31) >> 4) + 1 : 0;
                    float mx = -INFINITY;
#pragma unroll
                    for (int t = 0; t < 8; ++t)
#pragma unroll
                        for (int r = 0; r < 4; ++r) { const bool v = 16 * t + 4 * fq + r < ncv; sc[t][r] = v ? sc[t][r] : -INFINITY; mx = fmaxf(mx, sc[t][r]); }
                    mx = fmaxf(mx, __shfl_xor(mx, 16)); mx = fmaxf(mx, __shfl_xor(mx, 32));
                    const float mxs = mx == -INFINITY ? 0.f : mx;
                    float sum = 0.f;
#pragma unroll
                    for (int t = 0; t < 8; ++t)
#pragma unroll
                        for (int r = 0; r < 4; ++r) { sc[t][r] = __expf(sc[t][r] - mxs); sum += sc[t][r]; }
                    sum += __shfl_xor(sum, 16); sum += __shfl_xor(sum, 32);
                    const float inv = sum > 0.f ? 1.f / sum : 0.f;
#pragma unroll
                    for (int t = 0; t < 8; ++t) sc[t] = sc[t] * inv;
#pragma unroll
                    for (int s = 0; s < 4; ++s) { u32x4 w; w.x = pk2(sc[2 * s].x, sc[2 * s].y); w.y = pk2(sc[2 * s].z, sc[2 * s].w); w.z = pk2(sc[2 * s + 1].x, sc[2 * s + 1].y); w.w = pk2(sc[2 * s + 1].z, sc[2 * s + 1].w);
                        pcf[mt][s] = __builtin_bit_cast(bf16x8, w); }
                    float w3[8];
#pragma unroll
                    for (int t = 0; t < 8; ++t) {
#pragma unroll
                        for (int r = 0; r < 4; ++r) { float v = sc[t][r]; v += __shfl_xor(v, 1); v += __shfl_xor(v, 2); sc[t][r] = v; }
                        w3[t] = __shfl(sc[t].w, (lane + 48) & 63);
                    }
#pragma unroll
                    for (int t = 0; t < 8; ++t) {
                        const float prev = fq > 0 ? w3[t] : (t > 0 ? w3[t > 0 ? t - 1 : 0] : 0.f);
                        const float imp = sc[t].x + sc[t].y + sc[t].z + 0.5f * sc[t].w + 0.5f * prev;
                        if ((fr & 3) == 0) scl[(4 * mt + (fr >> 2)) * 32 + 4 * t + fq] = imp;
                    }
                    asm volatile("" ::: "memory");
                }
                const bf16* vcb = VCT + ((size_t)(b * 2 + g) * 64 + fr) * 128 + 8 * fq;
#pragma unroll
                for (int n = 0; n < 4; ++n) {
                    outacc[0][n] = (f32x4){0.f, 0.f, 0.f, 0.f}; outacc[1][n] = (f32x4){0.f, 0.f, 0.f, 0.f};
                    asm volatile("" : "+v"(vcb));
#pragma unroll
                    for (int s = 0; s < 4; ++s) if (2 * s < tmaxc) {
                        const bf16x8 vf = *(const bf16x8*)(vcb + 32 * s);
                        outacc[0][n] = __builtin_amdgcn_mfma_f32_16x16x32_bf16(vf, pcf[0][s], outacc[0][n], 0, 0, 0);
                        outacc[1][n] = __builtin_amdgcn_mfma_f32_16x16x32_bf16(vf, pcf[1][s], outacc[1][n], 0, 0, 0); }
                    vcb += 16 * 128;
                    asm volatile("" ::: "memory");
                }
            }
            float g1v[2], g2v[2];
#pragma unroll
            for (int mt = 0; mt < 2; ++mt) {
                const int head = g * 4 + (fr & 3);
                const bf16* gl = HY + (tokbase + tl0 + 4 * mt) * HYN + C_GA + head * 3;
                const float g0 = sigmoidf_(bf2f(gl[0]) + gb[head * 3 + 0]);
                g1v[mt] = sigmoidf_(bf2f(gl[1]) + gb[head * 3 + 1]); g2v[mt] = sigmoidf_(bf2f(gl[2]) + gb[head * 3 + 2]);
#pragma unroll
                for (int n = 0; n < 4; ++n) outacc[mt][n] = outacc[mt][n] * g0;
            }
            LDS_WAIT();
            asm volatile("" ::: "memory");
            {
                const int tok8 = lane >> 3, jg = lane & 7;
                float sj[32];
#pragma unroll
                for (int q = 0; q < 8; ++q) { const f32x4 v = *(const LAS f32x4*)(scl + tok8 * 32 + 4 * q); sj[4 * q] = v.x; sj[4 * q + 1] = v.y; sj[4 * q + 2] = v.z; sj[4 * q + 3] = v.w; }
#pragma unroll
                for (int j = 0; j < 32; ++j) sj[j] = j <= x ? sj[j] + ((j == 0 || j == x || j == x - 1) ? 1000.0f : 0.f) : -INFINITY;
                unsigned bits = 0u;
                const f32x4 mv = *(const LAS f32x4*)(scl + tok8 * 32 + 4 * jg);
#pragma unroll
                for (int q = 0; q < 4; ++q) {
                    const int j = 4 * jg + q;
                    const float mine = j <= x ? mv[q] + ((j == 0 || j == x || j == x - 1) ? 1000.0f : 0.f) : -INFINITY;
                    int rank = 0;
#pragma unroll
                    for (int jj = 0; jj < 32; ++jj) rank += (sj[jj] > mine || (sj[jj] == mine && jj < j)) ? 1 : 0;
                    bits |= (j <= x && rank < 8) ? (1u << j) : 0u;
                }
                bits |= __shfl_xor(bits, 1); bits |= __shfl_xor(bits, 2); bits |= __shfl_xor(bits, 4);
                if (jg == 0) { msk[wid * 8 + tok8] = bits; atomicOr((unsigned*)umask, bits); }
            }
            __syncthreads();
#pragma unroll 1
            for (int pass = 0; pass < 2; ++pass) {
                const int jlo = pass ? (x >= 4 ? x - 4 : 0) : 0;
                const unsigned inrange = (x >= 31 ? 0xffffffffu : ((2u << x) - 1u)) & ~((1u << jlo) - 1u);
                unsigned bmask = pass ? inrange : (*umask & inrange);
                const bf16* Kb = pass ? KW : KS; const int cg = (pass ? 10 : 8) + g;
                unsigned tm[2], wm[2];
#pragma unroll
                for (int mt = 0; mt < 2; ++mt) {
                    tm[mt] = pass ? 0xffffffffu : msk[wid * 8 + 4 * mt + (fr >> 2)];
                    wm[mt] = pass ? 0xffffffffu : (msk[wid * 8 + 4 * mt] | msk[wid * 8 + 4 * mt + 1] | msk[wid * 8 + 4 * mt + 2] | msk[wid * 8 + 4 * mt + 3]);
                    wm[mt] = __builtin_amdgcn_readfirstlane(wm[mt]);
                }
                f32x4 o[2][4]; float mrun[2], lrun[2];
#pragma unroll
                for (int mt = 0; mt < 2; ++mt) { mrun[mt] = -INFINITY; lrun[mt] = 0.f;
#pragma unroll
                    for (int n = 0; n < 4; ++n) o[mt][n] = (f32x4){0.f, 0.f, 0.f, 0.f}; }
                const int srow = tid >> 3, sc16 = tid & 7;
                u32x4 pk_, pv_;
                int j = __ffs(bmask) - 1;
                {   const bf16* ksrc = Kb + ((size_t)b * S + 64 * j + srow) * 128 + g * 64 + sc16 * 8; const bf16* vsrc = VTA + ((size_t)((b * 32 + j) * 12 + cg)) * 4096 + srow * 64 + sc16 * 8;
                    pk_ = *(const u32x4*)ksrc; pv_ = *(const u32x4*)vsrc; }
                int buf = 0;
                while (j >= 0) {
                    *(LAS u32x4*)(ktl + buf * 64 * RS + srow * RS + sc16 * 8) = pk_; *(LAS u32x4*)(vtl + buf * 64 * RS + srow * RS + sc16 * 8) = pv_;
                    bmask &= bmask - 1u;
                    const int jn = bmask ? __ffs(bmask) - 1 : -1;
                    if (jn >= 0) { const bf16* ksrc = Kb + ((size_t)b * S + 64 * jn + srow) * 128 + g * 64 + sc16 * 8; const bf16* vsrc = VTA + ((size_t)((b * 32 + jn) * 12 + cg)) * 4096 + srow * 64 + sc16 * 8;
                        pk_ = *(const u32x4*)ksrc; pv_ = *(const u32x4*)vsrc; }
                    __syncthreads();
                    const LAS bf16* kt = ktl + buf * 64 * RS + fr * RS + 8 * fq; const LAS bf16* vt = vtl + buf * 64 * RS + fr * RS + 8 * fq;
#pragma unroll
                    for (int mt = 0; mt < 2; ++mt) {
                        if (!((wm[mt] >> j) & 1u)) continue;
                        f32x4 sc[4];
#pragma unroll
                        for (int t = 0; t < 4; ++t) { sc[t] = (f32x4){0.f, 0.f, 0.f, 0.f};
                            sc[t] = __builtin_amdgcn_mfma_f32_16x16x32_bf16(*(const LAS bf16x8*)(kt + t * 16 * RS), qf[mt][0], sc[t], 0, 0, 0);
                            sc[t] = __builtin_amdgcn_mfma_f32_16x16x32_bf16(*(const LAS bf16x8*)(kt + t * 16 * RS + 32), qf[mt][1], sc[t], 0, 0, 0); }
                        const int tl = tl0 + 4 * mt;
                        const bool rowok = (tm[mt] >> j) & 1u;
                        const int kphi = j == x ? tl : 63;
                        const int kplo = (pass && j == x - 4) ? tl + 1 : 0;
                        float bm = -INFINITY;
#pragma unroll
                        for (int t = 0; t < 4; ++t)
#pragma unroll
                            for (int r = 0; r < 4; ++r) { const int kp = 16 * t + 4 * fq + r; const bool v = rowok && kp <= kphi && kp >= kplo; sc[t][r] = v ? sc[t][r] : -INFINITY; bm = fmaxf(bm, sc[t][r]); }
                        bm = fmaxf(bm, __shfl_xor(bm, 16)); bm = fmaxf(bm, __shfl_xor(bm, 32));
                        const float mn = fmaxf(mrun[mt], bm); const float mns = mn == -INFINITY ? 0.f : mn;
                        const float alpha = __expf(mrun[mt] - mns);
                        float rs = 0.f;
#pragma unroll
                        for (int t = 0; t < 4; ++t)
#pragma unroll
                            for (int r = 0; r < 4; ++r) { sc[t][r] = __expf(sc[t][r] - mns); rs += sc[t][r]; }
                        rs += __shfl_xor(rs, 16); rs += __shfl_xor(rs, 32);
                        lrun[mt] = lrun[mt] * alpha + rs; mrun[mt] = mn;
                        bf16x8 pf[2];
#pragma unroll
                        for (int s = 0; s < 2; ++s) { u32x4 w; w.x = pk2(sc[2 * s].x, sc[2 * s].y); w.y = pk2(sc[2 * s].z, sc[2 * s].w); w.z = pk2(sc[2 * s + 1].x, sc[2 * s + 1].y); w.w = pk2(sc[2 * s + 1].z, sc[2 * s + 1].w);
                            pf[s] = __builtin_bit_cast(bf16x8, w); }
#pragma unroll
                        for (int n = 0; n < 4; ++n) { o[mt][n] = o[mt][n] * alpha;
                            o[mt][n] = __builtin_amdgcn_mfma_f32_16x16x32_bf16(*(const LAS bf16x8*)(vt + n * 16 * RS), pf[0], o[mt][n], 0, 0, 0);
                            o[mt][n] = __builtin_amdgcn_mfma_f32_16x16x32_bf16(*(const LAS bf16x8*)(vt + n * 16 * RS + 32), pf[1], o[mt][n], 0, 0, 0); }
                    }
                    j = jn; buf ^= 1;
                }
#pragma unroll
                for (int mt = 0; mt < 2; ++mt) { const float sc_ = (pass ? g2v[mt] : g1v[mt]) / lrun[mt];
#pragma unroll
                    for (int n = 0; n < 4; ++n) outacc[mt][n] = outacc[mt][n] + o[mt][n] * sc_; }
                __syncthreads();
            }
#pragma unroll
            for (int mt = 0; mt < 2; ++mt) {
                bf16* dst = CAT + (tokbase + tl0 + 4 * mt) * 1024 + (g * 4 + (fr & 3)) * 64 + 4 * fq;
#pragma unroll
                for (int n = 0; n < 4; ++n) { u32x2 w; w.x = pk2(outacc[mt][n].x, outacc[mt][n].y); w.y = pk2(outacc[mt][n].z, outacc[mt][n].w); *(u32x2*)(dst + 16 * n) = w; }
            }
        }
    }
    __syncthreads();
}

__device__ __forceinline__ void phase_vtiles(KArgs A, int wv_, LAS unsigned char* lds) {
    const int tid_ = opaque_tid(wv_); const int wid = __builtin_amdgcn_readfirstlane(tid_ >> 6), lane = tid_ & 63; const int gw = blockIdx.x * 8 + wid, NGW = gridDim.x * 8;
    unsigned char* ws = opq(A->ws);
    const bf16* HY = (const bf16*)(ws + WS_BIG); bf16* VTA = (bf16*)(ws + WS_VTA);
    constexpr int TS = 66;
    LAS bf16* tl = (LAS bf16*)(lds + 65536) + wid * (64 * TS);
    for (int it = gw; it < NBATCH * 32 * 12; it += NGW) {
        const int cg = it % 12, bc = it / 12;
        const int colbase = cg < 8 ? C_VB + cg * 64 : (cg < 10 ? C_VS + (cg - 8) * 64 : C_VW + (cg - 10) * 64);
        const u32x4* src = (const u32x4*)(HY + (size_t)(bc * 64 + lane) * HYN + colbase);
        u32x4 w[8];
#pragma unroll
        for (int i = 0; i < 8; ++i) w[i] = src[i];
#pragma unroll
        for (int i = 0; i < 8; ++i) { LAS unsigned* d = (LAS unsigned*)(tl + lane * TS + 8 * i); d[0] = w[i].x; d[1] = w[i].y; d[2] = w[i].z; d[3] = w[i].w; }
        LDS_WAIT();
        bf16* dst = VTA + (size_t)it * 4096 + lane * 64;
#pragma unroll
        for (int p8 = 0; p8 < 8; ++p8) {
            unsigned short x[8];
#pragma unroll
            for (int j = 0; j < 8; ++j) x[j] = tl[kperm64(p8 * 8 + j) * TS + lane];
            u32x4 o; o.x = x[0] | ((unsigned)x[1] << 16); o.y = x[2] | ((unsigned)x[3] << 16); o.z = x[4] | ((unsigned)x[5] << 16); o.w = x[6] | ((unsigned)x[7] << 16);
            *(u32x4*)(dst + p8 * 8) = o;
        }
        LDS_WAIT();
    }
}

__device__ __forceinline__ float log_sigmoid16(float z) { return (fminf(z, 0.f) - __logf(1.0f + __expf(-fabsf(z)))) * (1.f / 16.f); }
#define GLA_Z(tokv) ({ float z_ = bias; _Pragma("unroll") for (int r_ = 0; r_ < 16; ++r_) z_ += __builtin_bit_cast(float, __builtin_amdgcn_readlane(__builtin_bit_cast(int, al[r_]), (tokv))) * wc[r_]; z_; })
#define GLA_LOAD_GATE() \
    float al[16], wc[16]; \
    { const u32x4* ap_ = (const u32x4*)(HY + (size_t)(tok0 + lane) * HYN + C_AL); const u32x4 a0_ = ap_[0], a1_ = ap_[1]; \
      al[0] = bflo(a0_.x); al[1] = bfhi(a0_.x); al[2] = bflo(a0_.y); al[3] = bfhi(a0_.y); al[4] = bflo(a0_.z); al[5] = bfhi(a0_.z); al[6] = bflo(a0_.w); al[7] = bfhi(a0_.w); \
      al[8] = bflo(a1_.x); al[9] = bfhi(a1_.x); al[10] = bflo(a1_.y); al[11] = bfhi(a1_.y); al[12] = bflo(a1_.z); al[13] = bfhi(a1_.z); al[14] = bflo(a1_.w); al[15] = bfhi(a1_.w); } \
    _Pragma("unroll") for (int r_ = 0; r_ < 16; ++r_) wc[r_] = A->in[I_WA2][(i * 16 + r_) * 256 + h * 64 + lane]; \
    const float bias = A->in[I_BA][i * 256 + h * 64 + lane];

__device__ __forceinline__ void phase_gla_a(KArgs A, int wv_, int i, LAS unsigned char* lds) {
    const int tid_ = opaque_tid(wv_); const int wid = __builtin_amdgcn_readfirstlane(tid_ >> 6), lane = tid_ & 63, fr = lane & 15, fq = lane >> 4; const int gw = blockIdx.x * 8 + wid, NGW = gridDim.x * 8;
    unsigned char* ws = opq(A->ws);
    const bf16* HY = (const bf16*)(ws + WS_BIG); const bf16* VTA = (const bf16*)(ws + WS_VTA); float* SLOC = (float*)(ws + WS_SLOC); float* DEC = (float*)(ws + WS_DEC);
    constexpr int RS = 72;
    LAS bf16* kh = (LAS bf16*)lds + wid * (64 * RS);
    (void)gw;
    for (int it = wid * (int)gridDim.x + (int)blockIdx.x; it < 1024; it += NGW) {
        const int c = it & 31, bh = it >> 5, b = bh >> 2, h = bh & 3; const size_t tok0 = (size_t)b * S + c * 64;
        GLA_LOAD_GATE();
        float bl = 0.f;
#pragma unroll 4
        for (int tk = 0; tk < 64; ++tk) bl += log_sigmoid16(GLA_Z(tk));
        float bc = 0.f;
#pragma unroll 4
        for (int tk = 0; tk < 64; ++tk) {
            bc += log_sigmoid16(GLA_Z(tk));
            const float kv = bf2f(HY[(tok0 + tk) * HYN + C_KB + h * 64 + lane]);
            kh[lane * RS + kpos64(tk)] = (bf16)f2bf(kv * __expf(bl - bc));
        }
        DEC[it * 64 + lane] = __expf(bl);
        LDS_WAIT();
#pragma unroll
        for (int dvh = 0; dvh < 2; ++dvh) {
            const bf16* vt = VTA + ((size_t)((b * 32 + c) * 12 + h * 2 + dvh)) * 4096;
            bf16x8 vf[4][2];
#pragma unroll
            for (int n = 0; n < 4; ++n)
#pragma unroll
                for (int s = 0; s < 2; ++s) vf[n][s] = *(const bf16x8*)(vt + (16 * n + fr) * 64 + 32 * s + 8 * fq);
#pragma unroll
            for (int m = 0; m < 4; ++m) {
                const bf16x8 a0 = *(const LAS bf16x8*)(kh + (16 * m + fr) * RS + 8 * fq), a1 = *(const LAS bf16x8*)(kh + (16 * m + fr) * RS + 32 + 8 * fq);
#pragma unroll
                for (int n = 0; n < 4; ++n) {
                    f32x4 acc = (f32x4){0.f, 0.f, 0.f, 0.f};
                    acc = __builtin_amdgcn_mfma_f32_16x16x32_bf16(a0, vf[n][0], acc, 0, 0, 0);
                    acc = __builtin_amdgcn_mfma_f32_16x16x32_bf16(a1, vf[n][1], acc, 0, 0, 0);
                    float* dst = SLOC + ((size_t)it * 64 + 16 * m + 4 * fq) * 128 + dvh * 64 + 16 * n + fr;
                    dst[0] = acc.x; dst[128] = acc.y; dst[256] = acc.z; dst[384] = acc.w;
                }
            }
        }
        LDS_WAIT();
    }
}
__device__ __forceinline__ void phase_gla_c(KArgs A, int wv_, int i, LAS unsigned char* lds) {
    const int tid_ = opaque_tid(wv_); const int wid = __builtin_amdgcn_readfirstlane(tid_ >> 6), lane = tid_ & 63, fr = lane & 15, fq = lane >> 4; const int gw = blockIdx.x * 8 + wid, NGW = gridDim.x * 8;
    unsigned char* ws = opq(A->ws);
    const bf16* HY = (const bf16*)(ws + WS_BIG); const bf16* VTA = (const bf16*)(ws + WS_VTA); const bf16* STT = (const bf16*)(ws + WS_STT); bf16* CAT = (bf16*)(ws + WS_CAT);
    constexpr int RS = 72;
    LAS bf16* qs = (LAS bf16*)lds + wid * (128 * RS);
    LAS bf16* ks = qs + 64 * RS;
    const float* og = A->in[I_ONORM] + i * 128;
    (void)gw; (void)NGW;
    for (int blk = blockIdx.x; blk < 128; blk += gridDim.x) {
        {
            const float* SLOC = (const float*)(ws + WS_SLOC); const float* DEC = (const float*)(ws + WS_DEC); bf16* STw = (bf16*)(ws + WS_STT);
            const int tid = tid_, dv = tid & 127, ko = tid >> 7, bh = blk >> 2, c0 = (blk & 3) * 8;
            float sv[16];
#pragma unroll
            for (int j = 0; j < 16; ++j) sv[j] = 0.f;
#pragma unroll 2
            for (int c = 0; c < c0 + 8; ++c) {
                const size_t item = (size_t)bh * 32 + c;
                if (c >= c0) {
                    u32x4 o0, o1; o0.x = pk2(sv[0], sv[1]); o0.y = pk2(sv[2], sv[3]); o0.z = pk2(sv[4], sv[5]); o0.w = pk2(sv[6], sv[7]);
                    o1.x = pk2(sv[8], sv[9]); o1.y = pk2(sv[10], sv[11]); o1.z = pk2(sv[12], sv[13]); o1.w = pk2(sv[14], sv[15]);
                    u32x4* d = (u32x4*)(STw + (item * 128 + dv) * 64 + ko * 16); d[0] = o0; d[1] = o1;
                }
                if (c < c0 + 7) {
                    const float* sl = SLOC + (item * 64 + ko * 16) * 128 + dv; const float* dc = DEC + item * 64 + ko * 16;
#pragma unroll
                    for (int j = 0; j < 16; ++j) sv[j] = dc[j] * sv[j] + sl[j * 128];
                }
            }
            asm volatile("s_waitcnt vmcnt(0)" ::: "memory");
            __syncthreads();
        }
        const int it = blk * 8 + wid;
        const int c = it & 31, bh = it >> 5, b = bh >> 2, h = bh & 3; const size_t tok0 = (size_t)b * S + c * 64;
        GLA_LOAD_GATE();
        float bc = 0.f;
#pragma unroll 4
        for (int tk = 0; tk < 64; ++tk) {
            bc += log_sigmoid16(GLA_Z(tk));
            const bf16* row = HY + (tok0 + tk) * HYN;
            const float qv = bf2f(row[C_QB + h * 64 + lane]) * 0.125f, kv = bf2f(row[C_KB + h * 64 + lane]);
            qs[tk * RS + lane] = (bf16)f2bf(qv * __expf(bc)); ks[tk * RS + lane] = (bf16)f2bf(kv * __expf(-bc));
        }
        LDS_WAIT();
        bf16x8 st[8][2];
#pragma unroll
        for (int n = 0; n < 8; ++n)
#pragma unroll
            for (int s = 0; s < 2; ++s) st[n][s] = *(const bf16x8*)(STT + ((size_t)it * 128 + 16 * n + fr) * 64 + 32 * s + 8 * fq);
        const bf16* vt = VTA + ((size_t)((b * 32 + c) * 12 + h * 2)) * 4096;
#pragma unroll
        for (int mi = 0; mi < 4; ++mi) {
            const bf16x8 q0 = *(const LAS bf16x8*)(qs + (16 * mi + fr) * RS + 8 * fq), q1 = *(const LAS bf16x8*)(qs + (16 * mi + fr) * RS + 32 + 8 * fq);
            f32x4 sc[4];
#pragma unroll
            for (int t = 0; t < 4; ++t) {
                sc[t] = (f32x4){0.f, 0.f, 0.f, 0.f};
                if (t <= mi) {
                    const bf16x8 k0 = *(const LAS bf16x8*)(ks + (16 * t + fr) * RS + 8 * fq), k1 = *(const LAS bf16x8*)(ks + (16 * t + fr) * RS + 32 + 8 * fq);
                    sc[t] = __builtin_amdgcn_mfma_f32_16x16x32_bf16(k0, q0, sc[t], 0, 0, 0);
                    sc[t] = __builtin_amdgcn_mfma_f32_16x16x32_bf16(k1, q1, sc[t], 0, 0, 0);
                    if (t == mi) {
                        sc[t].x = (4 * fq + 0 <= fr) ? sc[t].x : 0.f; sc[t].y = (4 * fq + 1 <= fr) ? sc[t].y : 0.f; sc[t].z = (4 * fq + 2 <= fr) ? sc[t].z : 0.f; sc[t].w = (4 * fq + 3 <= fr) ? sc[t].w : 0.f; }
                }
            }
            bf16x8 pf[2];
#pragma unroll
            for (int s = 0; s < 2; ++s) { u32x4 w; w.x = pk2(sc[2 * s].x, sc[2 * s].y); w.y = pk2(sc[2 * s].z, sc[2 * s].w); w.z = pk2(sc[2 * s + 1].x, sc[2 * s + 1].y); w.w = pk2(sc[2 * s + 1].z, sc[2 * s + 1].w);
                pf[s] = __builtin_bit_cast(bf16x8, w); }
            f32x4 o[8]; float ssq = 0.f;
#pragma unroll
            for (int n = 0; n < 8; ++n) {
                o[n] = (f32x4){0.f, 0.f, 0.f, 0.f};
                o[n] = __builtin_amdgcn_mfma_f32_16x16x32_bf16(st[n][0], q0, o[n], 0, 0, 0);
                o[n] = __builtin_amdgcn_mfma_f32_16x16x32_bf16(st[n][1], q1, o[n], 0, 0, 0);
                const bf16* vrow = vt + (size_t)(n >> 2) * 4096 + (16 * (n & 3) + fr) * 64 + 8 * fq;
                o[n] = __builtin_amdgcn_mfma_f32_16x16x32_bf16(*(const bf16x8*)vrow, pf[0], o[n], 0, 0, 0);
                if (mi >= 2) o[n] = __builtin_amdgcn_mfma_f32_16x16x32_bf16(*(const bf16x8*)(vrow + 32), pf[1], o[n], 0, 0, 0);
                ssq += (o[n].x * o[n].x + o[n].y * o[n].y) + (o[n].z * o[n].z + o[n].w * o[n].w);
            }
            ssq += __shfl_xor(ssq, 16); ssq += __shfl_xor(ssq, 32);
            const float rstd = rsqrtf(ssq * (1.f / 128.f) + EPS);
            const size_t tok = tok0 + 16 * mi + fr;
#pragma unroll
            for (int n = 0; n < 8; ++n) {
                const int dv = 16 * n + 4 * fq;
                const u32x2 rw = *(const u32x2*)(HY + tok * HYN + C_RB + h * 128 + dv); const f32x4 g = *(const f32x4*)(og + dv);
                const float r0 = bflo(rw.x), r1 = bfhi(rw.x), r2 = bflo(rw.y), r3 = bfhi(rw.y);
                u32x2 w; w.x = pk2(o[n].x * rstd * g.x * (r0 * sigmoidf_(r0)), o[n].y * rstd * g.y * (r1 * sigmoidf_(r1)));
                w.y = pk2(o[n].z * rstd * g.z * (r2 * sigmoidf_(r2)), o[n].w * rstd * g.w * (r3 * sigmoidf_(r3)));
                *(u32x2*)(CAT + tok * 1024 + 512 + h * 128 + dv) = w;
            }
        }
        LDS_WAIT();
        __syncthreads();
    }
}

__device__ __forceinline__ void phase_sgu_mix(KArgs A, int wv_, int i, LAS unsigned char* lds) {
    const int tid = opaque_tid(wv_), wid = __builtin_amdgcn_readfirstlane(tid >> 6), lane = tid & 63;
    unsigned char* ws = opq(A->ws);
    const bf16* U = (const bf16*)(ws + WS_U); const bf16* V = (const bf16*)(ws + WS_V); bf16* UM = (bf16*)(ws + WS_UM);
    LAS float* vt = (LAS float*)lds;
    LAS float* st = vt + 128 * 256;
    const float* lng = A->in[I_LNG] + i * 2048; const float* lnb = A->in[I_LNB] + i * 2048;
    for (int it = blockIdx.x; it < NBATCH * 16 * 8; it += gridDim.x) {
        const int g = it & 7, n = (it >> 3) & 15, b = it >> 7;
        const size_t tok0 = (size_t)b * S + n * 128;
        __syncthreads();
        for (int s = wid * 16; s < wid * 16 + 16; ++s) {
            const u32x4* vr = (const u32x4*)(V + (tok0 + s) * 2048) + lane;
            float x[32]; float sum = 0.f;
#pragma unroll
            for (int j = 0; j < 4; ++j) { const u32x4 w = vr[64 * j];
                x[8 * j + 0] = bflo(w.x); x[8 * j + 1] = bfhi(w.x); x[8 * j + 2] = bflo(w.y); x[8 * j + 3] = bfhi(w.y); x[8 * j + 4] = bflo(w.z); x[8 * j + 5] = bfhi(w.z); x[8 * j + 6] = bflo(w.w); x[8 * j + 7] = bfhi(w.w); }
#pragma unroll
            for (int j = 0; j < 32; ++j) sum += x[j];
            const float mean = wave_sum(sum) * (1.f / 2048.f); float q = 0.f;
#pragma unroll
            for (int j = 0; j < 32; ++j) { const float d = x[j] - mean; q += d * d; }
            const float rstd = rsqrtf(wave_sum(q) * (1.f / 2048.f) + EPS);
            const u32x2 w = *((const u32x2*)(V + (tok0 + s) * 2048 + g * 256) + lane);
            const f32x4 gg = *(const f32x4*)(lng + g * 256 + 4 * lane), bb = *(const f32x4*)(lnb + g * 256 + 4 * lane);
            f32x4 o; o.x = (bflo(w.x) - mean) * rstd * gg.x + bb.x; o.y = (bfhi(w.x) - mean) * rstd * gg.y + bb.y; o.z = (bflo(w.y) - mean) * rstd * gg.z + bb.z; o.w = (bfhi(w.y) - mean) * rstd * gg.w + bb.w;
            *(LAS f32x4*)(vt + s * 256 + 4 * lane) = o;
            (void)st;
        }
        __syncthreads();
        const int c = tid & 255, th = tid >> 8;
        const float* wsg = A->in[I_SGWS] + (size_t)(i * 8 + g) * 128 * 128; const float* bsg = A->in[I_SGBS] + (i * 8 + g) * 128;
        for (int tt = 0; tt < 64; ++tt) {
            const int t = 2 * tt + th;
            const float* wr = wsg + t * 128;
            float acc = 0.f;
            for (int s = 0; s <= t; ++s) acc += wr[s] * vt[s * 256 + c];
            acc += bsg[t];
            const float u = bf2f(U[(tok0 + t) * 2048 + g * 256 + c]);
            UM[(tok0 + t) * 2048 + g * 256 + c] = (bf16)f2bf(u * acc);
        }
    }
    __syncthreads();
}

__device__ __forceinline__ void phase_rownorm(KArgs A, int wv_) {
    const int tid_ = opaque_tid(wv_); const int wid = __builtin_amdgcn_readfirstlane(tid_ >> 6), lane = tid_ & 63; const int gw = blockIdx.x * 8 + wid, NGW = gridDim.x * 8;
    for (int m = gw; m < T; m += NGW) rms_row_to_bf16(A->out + (size_t)m * D, (bf16*)(opq(A->ws) + WS_XN) + (size_t)m * D, nullptr, lane);
}

__device__ __forceinline__ void phase_xattn(KArgs A, int wv_, int L, LAS unsigned char* lds) {
    const int tid = opaque_tid(wv_), wid = __builtin_amdgcn_readfirstlane(tid >> 6), lane = tid & 63;
    unsigned char* ws = opq(A->ws);
    const bf16* QX = (const bf16*)(ws + WS_QX); const bf16* KV = (const bf16*)(ws + WS_KV); bf16* OX = (bf16*)(ws + WS_OX);
    constexpr int KSTR = 129;
    LAS unsigned* kl = (LAS unsigned*)lds;
    LAS float* qb = (LAS float*)(lds + 132096) + wid * 256;
    LAS float* pb = (LAS float*)(lds + 132096 + 8192) + wid * 256;
    const float* qg = A->in[I_XQN] + L * 256;
    for (int it = blockIdx.x; it < NBATCH * 4 * 8; it += gridDim.x) {
        const int qc = it & 7, h = (it >> 3) & 3, b = it >> 5;
        __syncthreads();
        for (int e = tid; e < 256 * 128; e += 512) { const int m = e >> 7, dw = e & 127;
            kl[m * KSTR + dw] = *((const unsigned*)(KV + (size_t)(b * 256 + m) * 8192 + L * 2048 + h * 256) + dw); }
        __syncthreads();
        const bf16* Vb = KV + (size_t)(b * 256) * 8192 + L * 2048 + 1024 + h * 256;
        for (int tq = 0; tq < 32; ++tq) {
            const size_t tok = (size_t)b * S + qc * 256 + wid * 32 + tq;
            const u32x2 qw = *((const u32x2*)(QX + tok * 1024 + h * 256) + lane);
            const float q0 = bflo(qw.x), q1 = bfhi(qw.x), q2 = bflo(qw.y), q3 = bfhi(qw.y);
            const float rstd = rsqrtf(wave_sum(q0 * q0 + q1 * q1 + q2 * q2 + q3 * q3) * (1.f / 256.f) + EPS);
            const f32x4 gg = *(const f32x4*)(qg + 4 * lane);
            *(LAS f32x4*)(qb + 4 * lane) = (f32x4){q0 * rstd * gg.x, q1 * rstd * gg.y, q2 * rstd * gg.z, q3 * rstd * gg.w};
            LDS_WAIT();
            float s0 = 0.f, s1 = 0.f, s2 = 0.f, s3 = 0.f;
#pragma unroll 4
            for (int dw = 0; dw < 128; ++dw) {
                const f32x2 qq = *(const LAS f32x2*)(qb + 2 * dw);
                const unsigned k0 = kl[lane * KSTR + dw], k1 = kl[(lane + 64) * KSTR + dw], k2 = kl[(lane + 128) * KSTR + dw], k3 = kl[(lane + 192) * KSTR + dw];
                s0 += qq.x * bflo(k0) + qq.y * bfhi(k0); s1 += qq.x * bflo(k1) + qq.y * bfhi(k1);
                s2 += qq.x * bflo(k2) + qq.y * bfhi(k2); s3 += qq.x * bflo(k3) + qq.y * bfhi(k3);
            }
            const float mx = wave_max(fmaxf(fmaxf(s0, s1), fmaxf(s2, s3)));
            const float e0 = __expf(s0 - mx), e1 = __expf(s1 - mx), e2 = __expf(s2 - mx), e3 = __expf(s3 - mx);
            const float inv = 1.f / wave_sum((e0 + e1) + (e2 + e3));
            pb[lane] = e0 * inv; pb[lane + 64] = e1 * inv; pb[lane + 128] = e2 * inv; pb[lane + 192] = e3 * inv;
            LDS_WAIT();
            float o0 = 0.f, o1 = 0.f, o2 = 0.f, o3 = 0.f;
#pragma unroll 8
            for (int m = 0; m < 256; ++m) {
                const float p = pb[m];
                const u32x2 vw = *((const u32x2*)(Vb + (size_t)m * 8192) + lane);
                o0 += p * bflo(vw.x); o1 += p * bfhi(vw.x); o2 += p * bflo(vw.y); o3 += p * bfhi(vw.y);
            }
            u32x2 ow; ow.x = pk2(o0, o1); ow.y = pk2(o2, o3);
            *((u32x2*)(OX + tok * 1024 + h * 256) + lane) = ow;
            LDS_WAIT();
        }
    }
    __syncthreads();
}


__device__ __forceinline__ int kperm32(int p) { const int fq = (p >> 3) & 3, j = p & 7; return (p & ~31) + 16 * (j >> 2) + 4 * fq + (j & 3); }
__device__ __forceinline__ void phase_vtrans(KArgs A, int wv_, LAS unsigned char* lds) {
    const int tid = opaque_tid(wv_);
    unsigned char* ws = opq(A->ws);
    const bf16* KV = (const bf16*)(ws + WS_KV); bf16* VT = (bf16*)(ws + WS_VT);
    LAS bf16* vt = (LAS bf16*)lds;
    constexpr int VS = 258;
    for (int it = blockIdx.x; it < DEPTH * NBATCH * 4; it += gridDim.x) {
        const int h = it & 3, b = (it >> 2) & 7, l = it >> 5;
        __syncthreads();
        for (int e = tid; e < 256 * 32; e += 512) { const int m = e >> 5, c8 = e & 31;
            const u32x4 w = *(const u32x4*)(KV + (size_t)(b * 256 + m) * 8192 + l * 2048 + 1024 + h * 256 + c8 * 8);
            LAS unsigned* d = (LAS unsigned*)(vt + m * VS + c8 * 8); d[0] = w.x; d[1] = w.y; d[2] = w.z; d[3] = w.w; }
        __syncthreads();
        for (int e = tid; e < 256 * 32; e += 512) { const int dv = e & 255, p8 = e >> 8;
            unsigned short x[8];
#pragma unroll
            for (int j = 0; j < 8; ++j) x[j] = vt[kperm32(p8 * 8 + j) * VS + dv];
            u32x4 o; o.x = x[0] | ((unsigned)x[1] << 16); o.y = x[2] | ((unsigned)x[3] << 16); o.z = x[4] | ((unsigned)x[5] << 16); o.w = x[6] | ((unsigned)x[7] << 16);
            *(u32x4*)(VT + ((size_t)it * 256 + dv) * 256 + p8 * 8) = o; }
    }
    __syncthreads();
}

__device__ __forceinline__ void phase_xattn_mfma(KArgs A, int wv_, int L, LAS unsigned char* lds) {
    const int tid = opaque_tid(wv_), wid = __builtin_amdgcn_readfirstlane(tid >> 6), lane = tid & 63, fr = lane & 15, fq = lane >> 4;
    unsigned char* ws = opq(A->ws);
    const bf16* QX = (const bf16*)(ws + WS_QX); const bf16* KV = (const bf16*)(ws + WS_KV); const bf16* VT = (const bf16*)(ws + WS_VT); bf16* OX = (bf16*)(ws + WS_OX);
    constexpr int RS = 264;
    LAS bf16* kl = (LAS bf16*)lds;
    const float* qg = A->in[I_XQN] + L * 256;
    for (int it = blockIdx.x; it < NBATCH * 4 * 16; it += gridDim.x) {
        const int qt = it & 15, h = (it >> 4) & 3, b = it >> 6;
        __syncthreads();
        {
            const int row = tid >> 1, hf = tid & 1;
            const u32x4* src = (const u32x4*)(KV + (size_t)(b * 256 + row) * 8192 + L * 2048 + h * 256 + hf * 128);
#pragma unroll
            for (int i0 = 0; i0 < 16; i0 += 8) {
                u32x4 w[8];
#pragma unroll
                for (int i = 0; i < 8; ++i) w[i] = src[i0 + i];
#pragma unroll
                for (int i = 0; i < 8; ++i) *(LAS u32x4*)(kl + row * RS + hf * 128 + (i0 + i) * 8) = w[i];
            }
        }
        const size_t tok = (size_t)b * S + qt * 128 + wid * 16 + fr;
        bf16x8 qf[8];
        {
            u32x4 qw[8]; float ssq = 0.f;
#pragma unroll
            for (int s = 0; s < 8; ++s) qw[s] = *(const u32x4*)(QX + tok * 1024 + h * 256 + 32 * s + 8 * fq);
#pragma unroll
            for (int s = 0; s < 8; ++s) {
                const float a0 = bflo(qw[s].x), a1 = bfhi(qw[s].x), a2 = bflo(qw[s].y), a3 = bfhi(qw[s].y), a4 = bflo(qw[s].z), a5 = bfhi(qw[s].z), a6 = bflo(qw[s].w), a7 = bfhi(qw[s].w);
                ssq += (a0 * a0 + a1 * a1) + (a2 * a2 + a3 * a3) + (a4 * a4 + a5 * a5) + (a6 * a6 + a7 * a7);
            }
            ssq += __shfl_xor(ssq, 16); ssq += __shfl_xor(ssq, 32);
            const float rstd = rsqrtf(ssq * (1.f / 256.f) + EPS);
#pragma unroll
            for (int s = 0; s < 8; ++s) {
                const f32x4 ga = *(const f32x4*)(qg + 32 * s + 8 * fq), gb = *(const f32x4*)(qg + 32 * s + 8 * fq + 4);
                u32x4 w; w.x = pk2(bflo(qw[s].x) * rstd * ga.x, bfhi(qw[s].x) * rstd * ga.y); w.y = pk2(bflo(qw[s].y) * rstd * ga.z, bfhi(qw[s].y) * rstd * ga.w);
                w.z = pk2(bflo(qw[s].z) * rstd * gb.x, bfhi(qw[s].z) * rstd * gb.y); w.w = pk2(bflo(qw[s].w) * rstd * gb.z, bfhi(qw[s].w) * rstd * gb.w);
                qf[s] = __builtin_bit_cast(bf16x8, w);
            }
        }
        __syncthreads();
        f32x4 sc[16];
#pragma unroll
        for (int hf = 0; hf < 2; ++hf) {
            unsigned kb = (unsigned)(size_t)(kl + (128 * hf + fr) * RS + 8 * fq); asm volatile("" : "+v"(kb));
#pragma unroll
            for (int t8 = 0; t8 < 8; ++t8) { const int t = 8 * hf + t8; sc[t] = (f32x4){0.f, 0.f, 0.f, 0.f};
#pragma unroll
                for (int s = 0; s < 8; ++s) { const bf16x8 kf = *(const LAS bf16x8*)(size_t)(kb + (unsigned)((16 * t8 * RS + 32 * s) * 2));
                    sc[t] = __builtin_amdgcn_mfma_f32_16x16x32_bf16(kf, qf[s], sc[t], 0, 0, 0); }
                if (t & 1) asm volatile("" ::: "memory"); }
        }
        float mx = -INFINITY;
#pragma unroll
        for (int t = 0; t < 16; ++t) mx = fmaxf(mx, fmaxf(fmaxf(sc[t].x, sc[t].y), fmaxf(sc[t].z, sc[t].w)));
        mx = fmaxf(mx, __shfl_xor(mx, 16)); mx = fmaxf(mx, __shfl_xor(mx, 32));
        float lsum = 0.f;
#pragma unroll
        for (int t = 0; t < 16; ++t) { sc[t].x = __expf(sc[t].x - mx); sc[t].y = __expf(sc[t].y - mx); sc[t].z = __expf(sc[t].z - mx); sc[t].w = __expf(sc[t].w - mx); lsum += (sc[t].x + sc[t].y) + (sc[t].z + sc[t].w); }
        lsum += __shfl_xor(lsum, 16); lsum += __shfl_xor(lsum, 32);
        const float inv = 1.f / lsum;
        bf16x8 pf[8];
#pragma unroll
        for (int s = 0; s < 8; ++s) { u32x4 w; w.x = pk2(sc[2 * s].x, sc[2 * s].y); w.y = pk2(sc[2 * s].z, sc[2 * s].w); w.z = pk2(sc[2 * s + 1].x, sc[2 * s + 1].y); w.w = pk2(sc[2 * s + 1].z, sc[2 * s + 1].w);
            pf[s] = __builtin_bit_cast(bf16x8, w); }
        __syncthreads();
        {
            const int row = tid >> 1, hf = tid & 1;
            const u32x4* src = (const u32x4*)(VT + ((size_t)((L * 8 + b) * 4 + h) * 256 + row) * 256 + hf * 128);
#pragma unroll
            for (int i0 = 0; i0 < 16; i0 += 8) {
                u32x4 w[8];
#pragma unroll
                for (int i = 0; i < 8; ++i) w[i] = src[i0 + i];
#pragma unroll
                for (int i = 0; i < 8; ++i) *(LAS u32x4*)(kl + row * RS + hf * 128 + (i0 + i) * 8) = w[i];
            }
        }
        __syncthreads();
#pragma unroll
        for (int hf = 0; hf < 2; ++hf) {
            unsigned vb = (unsigned)(size_t)(kl + (128 * hf + fr) * RS + 8 * fq); asm volatile("" : "+v"(vb));
#pragma unroll
            for (int n8 = 0; n8 < 8; ++n8) { const int n = 8 * hf + n8; f32x4 o = (f32x4){0.f, 0.f, 0.f, 0.f};
#pragma unroll
                for (int s = 0; s < 8; ++s) { const bf16x8 vf = *(const LAS bf16x8*)(size_t)(vb + (unsigned)((16 * n8 * RS + 32 * s) * 2));
                    o = __builtin_amdgcn_mfma_f32_16x16x32_bf16(vf, pf[s], o, 0, 0, 0); }
                u32x2 w; w.x = pk2(o.x * inv, o.y * inv); w.y = pk2(o.z * inv, o.w * inv);
                *(u32x2*)(OX + tok * 1024 + h * 256 + 16 * n + 4 * fq) = w;
                if (n & 1) asm volatile("" ::: "memory"); }
        }
    }
    __syncthreads();
}

__device__ __forceinline__ void phase_route(KArgs A, int wv_, int L) {
    const int tid_ = opaque_tid(wv_); const int wid = __builtin_amdgcn_readfirstlane(tid_ >> 6), lane = tid_ & 63; const int gw = blockIdx.x * 8 + wid, NGW = gridDim.x * 8;
    unsigned char* ws = opq(A->ws);
    const float* RW = (const float*)(ws + WS_RW) + (size_t)L * NEXP * D; const float* rb = A->in[I_RB];
    unsigned* cnt = (unsigned*)(ws + WS_CTL) + CW_CNT + L * 64;
    int* list = (int*)(ws + WS_LIST); int* te = (int*)(ws + WS_TOK); int* tp = te + 2 * T; float* tw = (float*)(tp + 2 * T);
    bf16* XN = (bf16*)(ws + WS_XN);
    for (int t = gw; t < T; t += NGW) {
        const f32x4* xr = (const f32x4*)(A->out + (size_t)t * D) + lane;
        f32x4 v[4]; float s = 0.f;
#pragma unroll
        for (int j = 0; j < 4; ++j) { v[j] = xr[64 * j]; s += (v[j].x * v[j].x + v[j].y * v[j].y) + (v[j].z * v[j].z + v[j].w * v[j].w); }
        const float rstd = rsqrtf(wave_sum(s) * (1.f / 1024.f) + EPS);
        u32x2* o8 = (u32x2*)(XN + (size_t)t * D) + lane;
#pragma unroll
        for (int j = 0; j < 4; ++j) { u32x2 w; w.x = pk2(v[j].x * rstd, v[j].y * rstd); w.y = pk2(v[j].z * rstd, v[j].w * rstd); o8[64 * j] = w; }
        float mylg = -INFINITY;
#pragma unroll 2
        for (int e = 0; e < 16; ++e) {
            const f32x4* wr = (const f32x4*)(RW + e * D) + lane; float a = 0.f;
#pragma unroll
            for (int j = 0; j < 4; ++j) { const f32x4 w = wr[64 * j]; a += (v[j].x * w.x + v[j].y * w.y) + (v[j].z * w.z + v[j].w * w.w); }
            const float val = wave_sum(a) * rstd + rb[e];
            mylg = lane == e ? val : mylg;
        }
        const float v0 = wave_max(mylg);
        const int e0 = __ffsll((unsigned long long)__ballot(mylg == v0)) - 1;
        const int gidx = e0 >> 2;
        const float m2 = ((lane >> 2) == gidx && lane != e0 && lane < 16) ? mylg : -INFINITY;
        const float v1 = wave_max(m2);
        const int e1 = __ffsll((unsigned long long)__ballot(m2 == v1 && (lane >> 2) == gidx && lane != e0 && lane < 16)) - 1;
        const float w0 = 1.f / (1.f + __expf(v1 - v0)), w1 = 1.f - w0;
        if (lane == 0) {
            const unsigned p0 = atomicAdd(&cnt[e0], 1u), p1 = atomicAdd(&cnt[e1], 1u);
            list[e0 * T + p0] = t; list[e1 * T + p1] = t;
            te[2 * t] = e0; te[2 * t + 1] = e1; tp[2 * t] = (int)p0; tp[2 * t + 1] = (int)p1; tw[2 * t] = w0; tw[2 * t + 1] = w1;
        }
    }
}
__device__ __forceinline__ void moe_offsets(KArgs A, int wv_, int L, LAS int* off, LAS int* cn) {
    if (opaque_tid(wv_) == 0) {
        const unsigned* cnt = (const unsigned*)(opq(A->ws) + WS_CTL) + CW_CNT + L * 64;
        int o = 0;
        for (int e = 0; e < 16; ++e) { const int c = (int)__hip_atomic_load(cnt + e, __ATOMIC_RELAXED, __HIP_MEMORY_SCOPE_AGENT); off[e] = o; cn[e] = c; o += (c + 255) & ~255; }
        off[16] = o;
    }
    __syncthreads();
}
__device__ __forceinline__ void phase_moe_combine(KArgs A, int wv_, int L, LAS unsigned char* lds) {
    LAS int* off = (LAS int*)lds; LAS int* cn = off + 32;
    moe_offsets(A, wv_, L, off, cn);
    const int tid_ = opaque_tid(wv_); const int wid = __builtin_amdgcn_readfirstlane(tid_ >> 6), lane = tid_ & 63; const int gw = blockIdx.x * 8 + wid, NGW = gridDim.x * 8;
    unsigned char* ws = opq(A->ws);
    const int* te = (const int*)(ws + WS_TOK); const int* tp = te + 2 * T; const float* tw = (const float*)(tp + 2 * T);
    const bf16* Y = (const bf16*)(ws + WS_Y); bf16* XN = (bf16*)(ws + WS_XN);
    for (int t = gw; t < T; t += NGW) {
        const int sl0 = off[te[2 * t]] + tp[2 * t], sl1 = off[te[2 * t + 1]] + tp[2 * t + 1];
        const float w0 = tw[2 * t], w1 = tw[2 * t + 1];
        f32x4* xr = (f32x4*)(A->out + (size_t)t * D) + lane;
        const u32x2* y0 = (const u32x2*)(Y + (size_t)sl0 * D) + lane; const u32x2* y1 = (const u32x2*)(Y + (size_t)sl1 * D) + lane;
        f32x4 v[4]; float s = 0.f;
#pragma unroll
        for (int j = 0; j < 4; ++j) {
            v[j] = xr[64 * j]; const u32x2 a = y0[64 * j], c = y1[64 * j];
            v[j].x += w0 * bflo(a.x) + w1 * bflo(c.x); v[j].y += w0 * bfhi(a.x) + w1 * bfhi(c.x); v[j].z += w0 * bflo(a.y) + w1 * bflo(c.y); v[j].w += w0 * bfhi(a.y) + w1 * bfhi(c.y);
            xr[64 * j] = v[j];
            s += (v[j].x * v[j].x + v[j].y * v[j].y) + (v[j].z * v[j].z + v[j].w * v[j].w);
        }
        const float rstd = rsqrtf(wave_sum(s) * (1.f / 1024.f) + EPS);
        u32x2* o8 = (u32x2*)(XN + (size_t)t * D) + lane;
#pragma unroll
        for (int j = 0; j < 4; ++j) { u32x2 w; w.x = pk2(v[j].x * rstd, v[j].y * rstd); w.y = pk2(v[j].z * rstd, v[j].w * rstd); o8[64 * j] = w; }
    }
}

constexpr int PH_PER_EVEN = 5 + 8, PH_PER_ODD = 3 + 8;
constexpr int NPHASES = 3 + 2 * (PH_PER_EVEN + PH_PER_ODD);

__global__ void __launch_bounds__(512, 2) mk_fwd(Args Araw) {
    KArgs A0 = kargs();
    extern __shared__ __attribute__((aligned(16))) unsigned char lds_raw[];
    LAS unsigned char* lds = (LAS unsigned char*)lds_raw;
    volatile LAS unsigned* misc = (volatile LAS unsigned*)(lds + LDS_MISC);
    const int tid = threadIdx.x;
    if (tid < 16) misc[tid] = 0u;
    __syncthreads();
    const int lo = A0->ph_lo, hi = A0->ph_hi;
    const int wv_ = __builtin_amdgcn_readfirstlane(threadIdx.x >> 6);
    if (hi - lo > 1) (void)xcd_barrier_post((unsigned*)(A0->ws + WS_CTL) + CW_BAR, misc);
    int ph = 0;
#define PH_BEGIN(k) if (ph >= lo && ph < hi) { KArgs A = kargs(); unsigned char* ws = opq(A->ws); _Pragma("unroll 1") for (int rep_ = 0; rep_ < (((PROBE_MASK >> (k)) & 1) ? PROBE_REPS : 1); ++rep_)
#define PH_END   if (ph + 1 < hi) { XcdBarrier b_; b_.bar = (unsigned*)(opq(kargs()->ws) + WS_CTL) + CW_BAR; b_.x = xb_xcc_id(); b_.st = misc; xcd_barrier(b_, opaque_tid(wv_) == 0); } } ++ph;
    const int G = gridDim.x, cb = blockIdx.x;

    PH_BEGIN(0) phase_prologue(A, wv_, lds); PH_END
    PH_BEGIN(1) {
        pg8::DenseOrder S; S.init(NBATCH * NMEM, 8192, D, (const bf16*)(ws + WS_WKV), G, cb);
        pg8::EpiBf16<0> E{(bf16*)(ws + WS_KV), 8192, 32, 0};
        pg8::gemm_phase(lds, (const bf16*)(ws + WS_MN), D, S, E, wv_);
    } PH_END
    PH_BEGIN(2) { phase_knorm(A, wv_); phase_vtrans(A, wv_, lds); } PH_END

    for (int L = 0; L < DEPTH; ++L) {
        const int i = L >> 1;
        if ((L & 1) == 0) {
            PH_BEGIN(3) {
                pg8::DenseOrder S; S.init(T, HYN, D, (const bf16*)(ws + WS_WHYB) + (size_t)i * HYN * D, G, cb);
                pg8::EpiBf16<0> E{(bf16*)(ws + WS_BIG), HYN, 12, 0};
                pg8::gemm_phase(lds, (const bf16*)(ws + WS_XN), D, S, E, wv_);
            } PH_END
            PH_BEGIN(4) { phase_nsa_prep(A, wv_, i, lds); phase_vtiles(A, wv_, lds); } PH_END
            PH_BEGIN(5) { phase_gla_a(A, wv_, i, lds); __syncthreads(); phase_nsa_attn_mfma(A, wv_, i, lds); } PH_END
            PH_BEGIN(6) phase_gla_c(A, wv_, i, lds); PH_END
            PH_BEGIN(7) {
                pg8::DenseOrder S; S.init(T, D, D, (const bf16*)(ws + WS_WHOUT) + (size_t)i * D * D, G, cb);
                pg8::EpiResAdd E{A->out, D};
                pg8::gemm_phase(lds, (const bf16*)(ws + WS_CAT), D, S, E, wv_);
            } PH_END
        } else {
            PH_BEGIN(8) {
                pg8::DenseOrder S; S.init(T, 4096, D, (const bf16*)(ws + WS_WSGIN) + (size_t)i * 4096 * D, G, cb);
                pg8::EpiBf16<1> E{(bf16*)(ws + WS_U), 2048, 8, (size_t)(WS_V - WS_U) / 2};
                pg8::gemm_phase(lds, (const bf16*)(ws + WS_XN), D, S, E, wv_);
            } PH_END
            PH_BEGIN(9) phase_sgu_mix(A, wv_, i, lds); PH_END
            PH_BEGIN(10) {
                pg8::DenseOrder S; S.init(T, D, 2048, (const bf16*)(ws + WS_WSGOUT) + (size_t)i * D * 2048, G, cb);
                pg8::EpiResAdd E{A->out, D};
                pg8::gemm_phase(lds, (const bf16*)(ws + WS_UM), 2048, S, E, wv_);
            } PH_END
        }
        PH_BEGIN(11) phase_rownorm(A, wv_); PH_END
        PH_BEGIN(12) {
            pg8::DenseOrder S; S.init(T, D, D, (const bf16*)(ws + WS_WQ) + (size_t)L * D * D, G, cb);
            pg8::EpiBf16<0> E{(bf16*)(ws + WS_QX), D, 4, 0};
            pg8::gemm_phase(lds, (const bf16*)(ws + WS_XN), D, S, E, wv_);
        } PH_END
        PH_BEGIN(13) phase_xattn_mfma(A, wv_, L, lds); PH_END
        PH_BEGIN(14) {
            pg8::DenseOrder S; S.init(T, D, D, (const bf16*)(ws + WS_WO) + (size_t)L * D * D, G, cb);
            pg8::EpiResAdd E{A->out, D};
            pg8::gemm_phase(lds, (const bf16*)(ws + WS_OX), D, S, E, wv_);
        } PH_END
        PH_BEGIN(15) phase_route(A, wv_, L); PH_END
        PH_BEGIN(16) {
            LAS int* off = (LAS int*)(lds + pg8::STAGE_BYTES); LAS int* cn = off + 32;
            moe_offsets(A, wv_, L, off, cn);
            pg8::MoeOrder<true> S{(off[16] / 256) * 3, 3, G, cb, D, off, cn, (const int*)(ws + WS_LIST), (const char*)(ws + WS_WMIN) + (size_t)L * 16 * 768 * D * 2, (size_t)768 * D * 2};
            pg8::EpiSwiglu E{(bf16*)(ws + WS_H), DEXP};
            pg8::gemm_phase(lds, (const bf16*)(ws + WS_XN), D, S, E, wv_);
        } PH_END
        PH_BEGIN(17) {
            LAS int* off = (LAS int*)(lds + pg8::STAGE_BYTES); LAS int* cn = off + 32;
            moe_offsets(A, wv_, L, off, cn);
            pg8::MoeOrder<false> S{(off[16] / 256) * 4, 4, G, cb, DEXP, off, cn, (const int*)(ws + WS_LIST), (const char*)(ws + WS_WMOUT) + (size_t)L * 16 * D * DEXP * 2, (size_t)D * DEXP * 2};
            pg8::EpiBf16<0> E{(bf16*)(ws + WS_Y), D, 4, 0};
            pg8::gemm_phase(lds, (const bf16*)(ws + WS_H), DEXP, S, E, wv_);
        } PH_END
        PH_BEGIN(18) phase_moe_combine(A, wv_, L, lds); PH_END
    }
#undef PH_BEGIN
#undef PH_END
}

extern "C" void kernel_launch(void* const* d_in, const int* in_sizes, int n_in, void* d_out, int out_size, void* d_ws, size_t ws_size, hipStream_t stream) {
    static int grid = 0;
    if (grid == 0) {
        if (n_in != N_IN || out_size != T * D || ws_size < WS_END) { fprintf(stderr, "kernel_launch: unexpected problem (n_in %d, out %d, ws %zu)\n", n_in, out_size, ws_size); grid = -1; return; }
        int dev = 0, cus = 0, per_cu = 0;
        if (hipGetDevice(&dev) != hipSuccess || hipDeviceGetAttribute(&cus, hipDeviceAttributeMultiprocessorCount, dev) != hipSuccess) { grid = -1; return; }
        if (hipFuncSetAttribute((const void*)mk_fwd, hipFuncAttributeMaxDynamicSharedMemorySize, LDS_BYTES) != hipSuccess) { fprintf(stderr, "kernel_launch: hipFuncSetAttribute failed\n"); grid = -1; return; }
        if (hipOccupancyMaxActiveBlocksPerMultiprocessor(&per_cu, (const void*)mk_fwd, 512, LDS_BYTES) != hipSuccess || per_cu < 1) fprintf(stderr, "kernel_launch: occupancy query says %d\n", per_cu);
        (void)hipGetLastError();
        grid = cus;
    }
    if (grid < 0) return;
    (void)hipMemsetAsync((char*)d_ws + WS_CTL, 0, CTL_BYTES, stream);
    Args a{};
    for (int i = 0; i < N_IN; ++i) a.in[i] = (const float*)d_in[i];
    a.out = (float*)d_out; a.ws = (unsigned char*)d_ws;
    for (int j = 0; j < 32; ++j) a.freq[j] = (float)pow(10000.0, -(double)j / 32.0);
#if MK_ONE_LAUNCH
    a.ph_lo = 0; a.ph_hi = NPHASES;
    hipLaunchKernelGGL(mk_fwd, dim3(grid), dim3(512), LDS_BYTES, stream, a);
#else
    for (int p = 0; p < NPHASES; ++p) { a.ph_lo = p; a.ph_hi = p + 1; hipLaunchKernelGGL(mk_fwd, dim3(grid), dim3(512), LDS_BYTES, stream, a); }
#endif
}
```

```cpp
#include <hip/hip_runtime.h>
#include <stdint.h>
#include <stdio.h>
#include <math.h>

#ifndef PROBE_MASK
#define PROBE_MASK 0
#endif
#ifndef PROBE_REPS
#define PROBE_REPS 2
#endif
#ifndef MK_ONE_LAUNCH
#define MK_ONE_LAUNCH 1
#endif

#define LAS __attribute__((address_space(3)))
typedef unsigned short bf16;
typedef short bf16x8 __attribute__((ext_vector_type(8)));
typedef float f32x4 __attribute__((ext_vector_type(4)));
typedef float f32x2 __attribute__((ext_vector_type(2)));
typedef unsigned u32x4 __attribute__((ext_vector_type(4)));
typedef unsigned u32x2 __attribute__((ext_vector_type(2)));

constexpr int T = 16384, D = 1024, NBATCH = 8, S = 2048, DEPTH = 4;
constexpr int NMEM = 256;
constexpr float EPS = 1e-6f;
constexpr int HYN = 3072, HYSRC = 2856;
constexpr int C_QA = 0, C_KC = 512, C_VC = 640, C_KS = 768, C_VS = 896, C_KW = 1024, C_VW = 1152, C_QB = 1280, C_KB = 1536, C_VB = 1792, C_RB = 2304, C_GA = 2816, C_AL = 2840;
constexpr int NCMP = 127;
constexpr int NEXP = 16, DEXP = 384;
constexpr int SLOTS = 2 * T + NEXP * 256;

enum { I_X = 0, I_MEM, I_POS, I_NMIX, I_NXAT, I_NMEM, I_NFFN, I_HYBIN, I_HYBOUT, I_QNORM, I_KNORM, I_CMPPE, I_CMPW1, I_CMPW2, I_GATEB, I_WA2, I_BA, I_ONORM,
       I_SGIN, I_LNG, I_LNB, I_SGWS, I_SGBS, I_SGOUT, I_XWQ, I_XWKV, I_XWO, I_XQN, I_XKN, I_RW, I_RB, I_MOEIN, I_MOEOUT, N_IN };

constexpr size_t MiB = 1u << 20;
constexpr size_t WS_CTL = 0, CTL_BYTES = 1 * MiB;
constexpr size_t WS_WHYB = 1 * MiB;
constexpr size_t WS_WHOUT = WS_WHYB + 12 * MiB;
constexpr size_t WS_WSGIN = WS_WHOUT + 4 * MiB;
constexpr size_t WS_WSGOUT = WS_WSGIN + 16 * MiB;
constexpr size_t WS_WQ = WS_WSGOUT + 8 * MiB;
constexpr size_t WS_WKV = WS_WQ + 8 * MiB;
constexpr size_t WS_WO = WS_WKV + 16 * MiB;
constexpr size_t WS_WMIN = WS_WO + 8 * MiB;
constexpr size_t WS_WMOUT = WS_WMIN + 96 * MiB;
constexpr size_t WS_RW = WS_WMOUT + 48 * MiB;
constexpr size_t WS_XN = WS_RW + 1 * MiB;
constexpr size_t WS_BIG = WS_XN + 32 * MiB;
constexpr size_t WS_QA = WS_BIG + 128 * MiB;
constexpr size_t WS_KS = WS_QA + 16 * MiB;
constexpr size_t WS_KW = WS_KS + 4 * MiB;
constexpr size_t WS_KC = WS_KW + 4 * MiB;
constexpr size_t WS_VC = WS_KC + 1 * MiB;
constexpr size_t WS_CAT = WS_VC + 1 * MiB;
constexpr size_t WS_QX = WS_CAT + 32 * MiB;
constexpr size_t WS_OX = WS_QX + 32 * MiB;
constexpr size_t WS_MN = WS_OX + 32 * MiB;
constexpr size_t WS_KV = WS_MN + 4 * MiB;
constexpr size_t WS_COS = WS_KV + 32 * MiB;
constexpr size_t WS_SIN = WS_COS + 2 * MiB;
constexpr size_t WS_LIST = WS_SIN + 2 * MiB;
constexpr size_t WS_TOK = WS_LIST + 1 * MiB;
constexpr size_t WS_VT = WS_TOK + 1 * MiB;
constexpr size_t WS_VTA = WS_VT + 16 * MiB;
constexpr size_t WS_SLOC = WS_VTA + 32 * MiB;
constexpr size_t WS_DEC = WS_SLOC + 32 * MiB;
constexpr size_t WS_STT = WS_DEC + 1 * MiB;
constexpr size_t WS_WSB = WS_STT + 16 * MiB;
constexpr size_t WS_M0 = WS_WSB + 768 * 1024;
constexpr size_t WS_END = WS_WSB + 1 * MiB;
constexpr size_t WS_Y = WS_BIG, WS_H = WS_BIG + 72 * MiB, WS_U = WS_BIG, WS_V = WS_BIG + 64 * MiB, WS_UM = WS_QX;
constexpr int CW_BAR = 4096;
constexpr int CW_CNT = 8192;

constexpr int LDS_BYTES = 159744;
constexpr int LDS_MISC = LDS_BYTES - 64;

__device__ __forceinline__ unsigned f2bf(float f) { unsigned u = __float_as_uint(f); return (u + 0x7fffu + ((u >> 16) & 1u)) >> 16; }
__device__ __forceinline__ float bf2f(unsigned b) { return __uint_as_float(b << 16); }
__device__ __forceinline__ float bflo(unsigned w) { return __uint_as_float(w << 16); }
__device__ __forceinline__ float bfhi(unsigned w) { return __uint_as_float(w & 0xffff0000u); }
__device__ __forceinline__ unsigned pk2(float lo, float hi) { return f2bf(lo) | (f2bf(hi) << 16); }
__device__ __forceinline__ float wave_sum(float v) {
#pragma unroll
    for (int o = 1; o < 64; o <<= 1) v += __shfl_xor(v, o);
    return v;
}
__device__ __forceinline__ float wave_max(float v) {
#pragma unroll
    for (int o = 1; o < 64; o <<= 1) v = fmaxf(v, __shfl_xor(v, o));
    return v;
}
__device__ __forceinline__ int opaque_tid(int wv) { int l; asm volatile("v_mbcnt_lo_u32_b32 %0, -1, 0\n\tv_mbcnt_hi_u32_b32 %0, -1, %0" : "=v"(l)); return wv * 64 + l; }
__device__ __forceinline__ unsigned char* opq(unsigned char* p) { asm volatile("" : "+s"(p)); return p; }
#define LDS_WAIT() asm volatile("s_waitcnt lgkmcnt(0)" ::: "memory")
__device__ __forceinline__ float gelu_tanh(float x) {
    const float u = 0.7978845608028654f * (x + 0.044715f * x * x * x);
    const float e = __expf(-2.0f * fabsf(u));
    float t = (1.0f - e) / (1.0f + e); t = u < 0.f ? -t : t;
    return 0.5f * x * (1.0f + t);
}
__device__ __forceinline__ float sigmoidf_(float x) { return 1.0f / (1.0f + __expf(-x)); }

#define XB_TMO      128
#define XB_XCNT(j)  (256  + 64 * (j))
#define XB_XSUB(j)  (1280 + 64 * (j))
#define XB_XGEN(j)  (2304 + 64 * (j))
#define XB_TOP      3328
#define XB_TOPGEN   3392
#define XCD_BAR_WORDS 3456
#define XB_SPIN_CAP (1u << 22)

__device__ __forceinline__ unsigned xb_ld(unsigned* p)              { return __hip_atomic_load(p, __ATOMIC_RELAXED, __HIP_MEMORY_SCOPE_AGENT); }
__device__ __forceinline__ unsigned xb_add(unsigned* p, unsigned v) { return __hip_atomic_fetch_add(p, v, __ATOMIC_RELAXED, __HIP_MEMORY_SCOPE_AGENT); }
__device__ __forceinline__ unsigned xb_xcc_id() { return (unsigned)__builtin_amdgcn_s_getreg((3 << 11) | 20) & 0xFu; }
#define XB_SPIN(cond, bar) do { unsigned _sp = 0; while (cond) { __builtin_amdgcn_s_sleep(1); \
    if ((++_sp & 255u) == 0u) { if (xb_ld(&(bar)[XB_TMO])) break; if (_sp > XB_SPIN_CAP) { atomicAdd(&(bar)[XB_TMO], 1u); break; } } } } while (0)

struct XcdBarrier { unsigned* bar; unsigned x; volatile LAS unsigned* st; };
__device__ __forceinline__ unsigned* xb_opaque(unsigned* p) { unsigned long long v = (unsigned long long)p; unsigned lo = __builtin_amdgcn_readfirstlane((unsigned)v), hi = __builtin_amdgcn_readfirstlane((unsigned)(v >> 32));
    asm volatile("" : "+s"(lo), "+s"(hi)); return (unsigned*)(((unsigned long long)hi << 32) | lo); }

__device__ __forceinline__ XcdBarrier xcd_barrier_post(unsigned* bar, volatile LAS unsigned* st) {
    XcdBarrier b; b.bar = bar; b.x = xb_xcc_id(); b.st = st;
    if (threadIdx.x == 0) (void)xb_add(&bar[XB_XCNT(b.x)], 1u);
    return b;
}
__device__ __forceinline__ void xcd_barrier_complete(unsigned* bar, unsigned x, unsigned& nloc, unsigned& nx) {
    const unsigned G = gridDim.x * gridDim.y * gridDim.z;
    unsigned sum, cnt, mine, sp = 0u;
    for (;;) {
        sum = 0u; cnt = 0u; mine = 0u;
#pragma unroll
        for (unsigned j = 0; j < 16; ++j) { const unsigned c = xb_ld(&bar[XB_XCNT(j)]); sum += c; cnt += (c > 0u) ? 1u : 0u; mine = (j == x) ? c : mine; }
        if (sum == G) break;
        __builtin_amdgcn_s_sleep(1);
        if ((++sp & 255u) == 0u) { if (xb_ld(&bar[XB_TMO])) break; if (sp > XB_SPIN_CAP) { atomicAdd(&bar[XB_TMO], 1u); break; } }
    }
    nloc = mine > 0u ? mine : 1u; nx = cnt > 0u ? cnt : 1u;
}
__device__ __forceinline__ void xcd_barrier(const XcdBarrier& b, const bool is_t0) {
    asm volatile("s_waitcnt vmcnt(0)" ::: "memory");
    __syncthreads();
    if (is_t0) {
        unsigned* bar = b.bar;
        __builtin_amdgcn_s_waitcnt(0);
        unsigned nloc = b.st[0], nx = b.st[1];
        if (nloc == 0u) { xcd_barrier_complete(bar, b.x, nloc, nx); b.st[0] = nloc; b.st[1] = nx; }
        const unsigned old = xb_add(&bar[XB_XSUB(b.x)], 1u);
        const unsigned gen = old / nloc;
        if (old + 1u == (gen + 1u) * nloc) {
            __builtin_amdgcn_fence(__ATOMIC_RELEASE, "agent");
            asm volatile("s_waitcnt vmcnt(0)" ::: "memory");
            const unsigned og = xb_add(&bar[XB_TOP], 1u);
            const unsigned tg = og / nx;
            if (og + 1u == (tg + 1u) * nx) xb_add(&bar[XB_TOPGEN], 1u);
            else XB_SPIN(xb_ld(&bar[XB_TOPGEN]) == tg, bar);
            __builtin_amdgcn_fence(__ATOMIC_ACQUIRE, "agent");
            xb_add(&bar[XB_XGEN(b.x)], 1u);
            asm volatile("s_waitcnt vmcnt(0)" ::: "memory");
        } else {
            XB_SPIN(xb_ld(&bar[XB_XGEN(b.x)]) == gen, bar);
            __builtin_amdgcn_fence(__ATOMIC_ACQUIRE, "agent");
            asm volatile("s_waitcnt vmcnt(0)" ::: "memory");
        }
    }
    __syncthreads();
}

struct Args {
    const float* in[N_IN];
    float* out;
    unsigned char* ws;
    float freq[32];
    int ph_lo, ph_hi;
};

typedef const __attribute__((address_space(4))) Args* KArgs;
__device__ __forceinline__ KArgs kargs() { KArgs p = (KArgs)__builtin_amdgcn_kernarg_segment_ptr(); asm volatile("" : "+s"(p)); return p; }

__device__ __forceinline__ void st_bf16x4(bf16* p, f32x4 v) { u32x2 w; w.x = pk2(v[0], v[1]); w.y = pk2(v[2], v[3]); *(u32x2*)p = w; }


namespace pg8 {
constexpr int BM = 256, BK = 64, HALF = 128, HTB = HALF * BK * 2, STAGE_BYTES = 8 * HTB, NXCD = 8, WGM = 8;
__host__ __device__ __forceinline__ int lds_byte(int r, int c) { const int st = (r >> 4) * 2 + (c >> 5), rr = r & 15, cc = c & 31, ob = rr * 64 + cc * 2; return st * 1024 + (ob ^ (((ob >> 9) & 1) << 5)); }
__host__ __device__ __forceinline__ void stage_rc(int b, int& R, int& C) { const int st = b / 1024, sb = b % 1024, swz = sb ^ (((sb >> 9) & 1) << 5); R = (st >> 1) * 16 + swz / 64; C = (st & 1) * 32 + (swz % 64) / 2; }
__host__ __device__ __forceinline__ int perm32(int rho) { const int n = rho >> 4, i = rho & 15; return 8 * (i >> 2) + 4 * n + (i & 3); }
struct Unit { int pm, pn, e; };
struct DenseOrder {
    static constexpr bool GATHER = false;
    int nM, nN, nwg, G, c, K; const char* Bt;
    __device__ __forceinline__ void init(int M, int N, int K_, const bf16* Bt_, int G_, int c_) { nM = M / BM; nN = N / BM; nwg = nM * nN; G = G_; c = c_; K = K_; Bt = (const char*)Bt_; }
    __device__ __forceinline__ bool next(int i, Unit& u) const {
        const long L = (long)i * G + c; if (L >= nwg) return false;
        int wgid = (int)L; { const int q = nwg / NXCD, r = nwg % NXCD, xcd = wgid % NXCD, off = wgid / NXCD; wgid = (xcd < r ? xcd * (q + 1) : r * (q + 1) + (xcd - r) * q) + off; }
        const int nig = WGM * nN, gid = wgid / nig, fm = gid * WGM, gsz = (nM - fm) < WGM ? (nM - fm) : WGM;
        u.pm = fm + ((wgid % nig) % gsz); u.pn = (wgid % nig) / gsz; u.e = 0; return true;
    }
    __device__ __forceinline__ unsigned a_voff(const Unit& u, int half, int R) const { return (unsigned)((u.pm * BM + half * HALF + R) * K) * 2u; }
    __device__ __forceinline__ const char* b_tile(const Unit& u) const { return Bt + (size_t)u.pn * BM * K * 2; }
};
template <bool GATH> struct MoeOrder {
    static constexpr bool GATHER = GATH;
    int nunits, ntn, G, c, K; const LAS int* off; const LAS int* cn; const int* list; const char* Bt; size_t estride;
    __device__ __forceinline__ bool next(int i, Unit& u) const {
        const int L = i * G + c; if (L >= nunits) return false;
        u.pm = L / ntn; u.pn = L % ntn; const int s0 = u.pm * BM; int e = 0;
#pragma unroll
        for (int q = 1; q < 16; ++q) e += (s0 >= off[q]) ? 1 : 0;
        u.e = e; return true;
    }
    __device__ __forceinline__ unsigned a_voff(const Unit& u, int half, int R) const {
        const int slot = u.pm * BM + half * HALF + R;
        const int loc = slot - off[u.e]; const int tk = list[u.e * T + (loc < cn[u.e] ? loc : 0)];
        return (unsigned)(tk * K) * 2u;
    }
    __device__ __forceinline__ const char* b_tile(const Unit& u) const { return Bt + (size_t)u.e * estride + (size_t)u.pn * BM * K * 2; }
};
__device__ __forceinline__ unsigned cvt_pk_bf16(float lo, float hi) { unsigned r; asm volatile("v_cvt_pk_bf16_f32 %0, %1, %2" : "=v"(r) : "v"(lo), "v"(hi)); return r; }

template <class Epi, class Sched>
__device__ __forceinline__ void gemm_phase(LAS unsigned char* lds, const bf16* Aptr, int K, const Sched& S, const Epi& E, int wv_) {
    const int tid = opaque_tid(wv_), wid = __builtin_amdgcn_readfirstlane(tid >> 6), lane = tid & 63, wr = wid >> 2, wc = wid & 3, fr = lane & 15, fq = lane >> 4;
    const int nt = K / BK;
    int Rr[2], Cc[2]; unsigned voffA[2], voffB[2];
#pragma unroll
    for (int i = 0; i < 2; ++i) { stage_rc(tid * 16 + i * 8192, Rr[i], Cc[i]); const int Rb = Epi::PERM ? ((Rr[i] & ~31) + perm32(Rr[i] & 31)) : Rr[i];
        voffA[i] = (unsigned)(Rr[i] * K + Cc[i]) * 2u; voffB[i] = (unsigned)(Rb * K + Cc[i]) * 2u; }
    const size_t kstep = (size_t)(BK * 2);
    const size_t hstep = (size_t)HALF * K * 2;
    const size_t tstep = 2 * hstep;
    const unsigned ldsw = (unsigned)wid * 1024u;
    const int aoff = lds_byte(wr * 64 + fr, fq * 8), boff = lds_byte(wc * 32 + fr, fq * 8);
    const char* const Ab = (const char*)Aptr;
#define PG8_SA(b, h) (((b) * 2 + (h)) * HTB)
#define PG8_SB(b, h) ((4 + (b) * 2 + (h)) * HTB)
#define PG8_STAGE(bufoff, gbase, voff) do { _Pragma("unroll") for (int _i = 0; _i < 2; ++_i) \
        __builtin_amdgcn_global_load_lds((const unsigned*)((const char*)(gbase) + (voff)[_i]), (LAS unsigned*)(lds + (bufoff) + ldsw + _i * 8192), 16, 0, 0); } while (0)
#define PG8_STAGE_A(bufoff, usenext, h, kofs) do { \
        if constexpr (Sched::GATHER) { const char* gb_ = Ab + (kofs); unsigned vv_[2] = {(usenext) ? vN[h][0] : vA[h][0], (usenext) ? vN[h][1] : vA[h][1]}; PG8_STAGE(bufoff, gb_, vv_); } \
        else { const char* gb_ = ((usenext) ? nA : cA) + (size_t)(h) * hstep + (kofs); PG8_STAGE(bufoff, gb_, voffA); } } while (0)
#define PG8_LDA(dst, b, h) do { _Pragma("unroll") for (int m = 0; m < 4; ++m) _Pragma("unroll") for (int k = 0; k < 2; ++k) dst[m][k] = *(const LAS bf16x8*)(lds + PG8_SA(b, h) + aoff + m * 2048 + k * 1024); } while (0)
#define PG8_LDB(dst, b, h) do { _Pragma("unroll") for (int n = 0; n < 2; ++n) _Pragma("unroll") for (int k = 0; k < 2; ++k) dst[n][k] = *(const LAS bf16x8*)(lds + PG8_SB(b, h) + boff + n * 2048 + k * 1024); } while (0)
#define PG8_MMA(ai, bj, At, Bt) do { __builtin_amdgcn_s_setprio(1); _Pragma("unroll") for (int m = 0; m < 4; ++m) _Pragma("unroll") for (int n = 0; n < 2; ++n) _Pragma("unroll") for (int k = 0; k < 2; ++k) \
        acc[ai][bj][m][n] = __builtin_amdgcn_mfma_f32_16x16x32_bf16(Bt[n][k], At[m][k], acc[ai][bj][m][n], 0, 0, 0); __builtin_amdgcn_s_setprio(0); } while (0)
#define PG8_WAIT_V(n) asm volatile("s_waitcnt vmcnt(" #n ")" ::: "memory")
#define PG8_WAIT_L(n) asm volatile("s_waitcnt lgkmcnt(" #n ")" ::: "memory")
#define PG8_BAR __builtin_amdgcn_s_barrier()
#define PG8_SCHED __builtin_amdgcn_sched_barrier(0)
    Unit cur, nxt; int ui = 0;
    if (!S.next(0, cur)) return;
    f32x4 acc[2][2][4][2];
#pragma unroll
    for (int a = 0; a < 2; ++a)
#pragma unroll
        for (int b = 0; b < 2; ++b)
#pragma unroll
            for (int m = 0; m < 4; ++m)
#pragma unroll
                for (int n = 0; n < 2; ++n) acc[a][b][m][n] = (f32x4){0.f, 0.f, 0.f, 0.f};
    bf16x8 At[4][2], B0[2][2], B1[2][2];
    unsigned vA[2][2], vN[2][2];
    const char* cA = Ab; const char* nA = Ab;
    if constexpr (Sched::GATHER) {
#pragma unroll
        for (int h = 0; h < 2; ++h)
#pragma unroll
            for (int i = 0; i < 2; ++i) { vA[h][i] = S.a_voff(cur, h, Rr[i]) + (unsigned)Cc[i] * 2u; vN[h][i] = vA[h][i]; }
    } else { cA = Ab + (size_t)cur.pm * tstep; nA = cA; }
    const char* cB = S.b_tile(cur);
    PG8_STAGE(PG8_SB(0, 0), cB, voffB); PG8_STAGE_A(PG8_SA(0, 0), false, 0, 0); PG8_STAGE(PG8_SB(0, 1), cB + hstep, voffB); PG8_STAGE_A(PG8_SA(0, 1), false, 1, 0);
    if (wr == 1) PG8_BAR;
    PG8_WAIT_V(4); PG8_BAR;
    PG8_STAGE(PG8_SB(1, 0), cB + kstep, voffB); PG8_STAGE_A(PG8_SA(1, 0), false, 0, kstep); PG8_STAGE(PG8_SB(1, 1), cB + hstep + kstep, voffB);
    PG8_WAIT_V(6); PG8_BAR;
    for (;;) {
        const bool has_next = S.next(ui + 1, nxt);
        const char* nB = has_next ? S.b_tile(nxt) : cB;
        if constexpr (Sched::GATHER) {
#pragma unroll
            for (int h = 0; h < 2; ++h)
#pragma unroll
                for (int i = 0; i < 2; ++i) vN[h][i] = has_next ? S.a_voff(nxt, h, Rr[i]) + (unsigned)Cc[i] * 2u : vA[h][i];
        } else nA = has_next ? Ab + (size_t)nxt.pm * tstep : cA;
        for (int t = 0; t < nt; t += 2) {
            const bool last = (t == nt - 2);
            const size_t k1 = (size_t)(t + 1) * kstep, k2 = last ? 0 : (size_t)(t + 2) * kstep, k3 = k2 + kstep;
            const char* b2 = last ? nB : cB + (size_t)(t + 2) * kstep; const char* b3 = b2 + kstep;
            PG8_LDB(B0, 0, 0); PG8_SCHED; PG8_LDA(At, 0, 0); PG8_STAGE_A(PG8_SA(1, 1), false, 1, k1);
            PG8_WAIT_L(8); PG8_BAR; PG8_WAIT_L(0); PG8_MMA(0, 0, At, B0); PG8_BAR; PG8_SCHED;
            PG8_LDB(B1, 0, 1); PG8_STAGE(PG8_SB(0, 0), b2, voffB);
            PG8_BAR; PG8_WAIT_L(0); PG8_MMA(0, 1, At, B1); PG8_BAR;
            PG8_LDA(At, 0, 1); PG8_STAGE_A(PG8_SA(0, 0), last, 0, k2);
            PG8_BAR; PG8_WAIT_L(0); PG8_MMA(1, 0, At, B0); PG8_BAR; PG8_SCHED;
            PG8_STAGE(PG8_SB(0, 1), b2 + hstep, voffB);
            PG8_WAIT_V(6); PG8_BAR; PG8_MMA(1, 1, At, B1); PG8_BAR;
            PG8_LDB(B0, 1, 0); PG8_SCHED; PG8_LDA(At, 1, 0); PG8_STAGE_A(PG8_SA(0, 1), last, 1, k2);
            PG8_WAIT_L(8); PG8_BAR; PG8_WAIT_L(0); PG8_MMA(0, 0, At, B0); PG8_BAR; PG8_SCHED;
            PG8_LDB(B1, 1, 1); PG8_STAGE(PG8_SB(1, 0), b3, voffB);
            PG8_BAR; PG8_WAIT_L(0); PG8_MMA(0, 1, At, B1); PG8_BAR;
            PG8_LDA(At, 1, 1); PG8_STAGE_A(PG8_SA(1, 0), last, 0, k3);
            PG8_BAR; PG8_WAIT_L(0); PG8_MMA(1, 0, At, B0); PG8_BAR; PG8_SCHED;
            PG8_STAGE(PG8_SB(1, 1), b3 + hstep, voffB);
            PG8_WAIT_V(6); PG8_BAR; PG8_MMA(1, 1, At, B1); PG8_BAR;
        }
        E(acc, cur, wr, wc, fr, fq);
        if (!has_next) break;
#pragma unroll
        for (int a = 0; a < 2; ++a)
#pragma unroll
            for (int b = 0; b < 2; ++b)
#pragma unroll
                for (int m = 0; m < 4; ++m)
#pragma unroll
                    for (int n = 0; n < 2; ++n) acc[a][b][m][n] = (f32x4){0.f, 0.f, 0.f, 0.f};
        cur = nxt; cB = nB; cA = nA; ++ui;
        if constexpr (Sched::GATHER) {
#pragma unroll
            for (int h = 0; h < 2; ++h)
#pragma unroll
                for (int i = 0; i < 2; ++i) vA[h][i] = vN[h][i];
        }
    }
    PG8_WAIT_V(0);
    if (wr == 0) PG8_BAR;
    PG8_BAR;
#undef PG8_SA
#undef PG8_SB
#undef PG8_STAGE
#undef PG8_STAGE_A
#undef PG8_LDA
#undef PG8_LDB
#undef PG8_MMA
#undef PG8_WAIT_V
#undef PG8_WAIT_L
#undef PG8_BAR
#undef PG8_SCHED
}
template <int ACT> struct EpiBf16 {
    static constexpr bool PERM = true;
    bf16* O; int ldc; int tpt; size_t tstride;
    __device__ __forceinline__ void operator()(const f32x4 (&acc)[2][2][4][2], const Unit& u, int wr, int wc, int fr, int fq) const {
        const int row0 = u.pm * BM + wr * 64 + fr; const int tt = u.pn / tpt; bf16* base = O + (size_t)tt * tstride; const int col0 = (u.pn - tt * tpt) * BM + wc * 32 + 8 * fq;
#pragma unroll
        for (int ai = 0; ai < 2; ++ai)
#pragma unroll
            for (int m = 0; m < 4; ++m) { bf16* rowp = base + (size_t)(row0 + ai * HALF + m * 16) * ldc + col0;
#pragma unroll
                for (int bj = 0; bj < 2; ++bj) { f32x4 v0 = acc[ai][bj][m][0], v1 = acc[ai][bj][m][1];
                    if (ACT == 1) {
#pragma unroll
                        for (int q = 0; q < 4; ++q) { v0[q] = gelu_tanh(v0[q]); v1[q] = gelu_tanh(v1[q]); } }
                    u32x4 w; w.x = cvt_pk_bf16(v0[0], v0[1]); w.y = cvt_pk_bf16(v0[2], v0[3]); w.z = cvt_pk_bf16(v1[0], v1[1]); w.w = cvt_pk_bf16(v1[2], v1[3]);
                    *(u32x4*)(rowp + bj * HALF) = w; } }
    }
};
struct EpiResAdd {
    static constexpr bool PERM = false;
    float* X; int ldc;
    __device__ __forceinline__ void operator()(const f32x4 (&acc)[2][2][4][2], const Unit& u, int wr, int wc, int fr, int fq) const {
        const int row0 = u.pm * BM + wr * 64 + fr, col0 = u.pn * BM + wc * 32 + 4 * fq;
#pragma unroll
        for (int ai = 0; ai < 2; ++ai)
#pragma unroll
            for (int m = 0; m < 4; ++m) { float* rowp = X + (size_t)(row0 + ai * HALF + m * 16) * ldc + col0;
#pragma unroll
                for (int bj = 0; bj < 2; ++bj)
#pragma unroll
                    for (int n = 0; n < 2; ++n) { f32x4* p = (f32x4*)(rowp + bj * HALF + n * 16); *p = *p + acc[ai][bj][m][n]; } }
    }
};
struct EpiSwiglu {
    static constexpr bool PERM = true;
    bf16* H; int ldc;
    __device__ __forceinline__ void operator()(const f32x4 (&acc)[2][2][4][2], const Unit& u, int wr, int wc, int fr, int fq) const {
        const int row0 = u.pm * BM + wr * 64 + fr, col0 = u.pn * HALF + wc * 32 + 8 * fq;
#pragma unroll
        for (int ai = 0; ai < 2; ++ai)
#pragma unroll
            for (int m = 0; m < 4; ++m) {
                float o[8];
#pragma unroll
                for (int n = 0; n < 2; ++n)
#pragma unroll
                    for (int q = 0; q < 4; ++q) { const float g = acc[ai][0][m][n][q]; o[4 * n + q] = g * sigmoidf_(g) * acc[ai][1][m][n][q]; }
                u32x4 w; w.x = cvt_pk_bf16(o[0], o[1]); w.y = cvt_pk_bf16(o[2], o[3]); w.z = cvt_pk_bf16(o[4], o[5]); w.w = cvt_pk_bf16(o[6], o[7]);
                *(u32x4*)(H + (size_t)(row0 + ai * HALF + m * 16) * ldc + col0) = w; }
    }
};
}

__device__ __forceinline__ int hyb_colmap(int n) {
    if (n < 1280) return n;
    if (n < 1536) return 1304 + (n - 1280);
    if (n < 1792) return 1560 + (n - 1536);
    if (n < 2304) return 1816 + (n - 1792);
    if (n < 2816) return 2344 + (n - 2304);
    if (n < 2840) return 1280 + (n - 2816);
    if (n < 2856) return 2328 + (n - 2840);
    return -1;
}
__device__ __forceinline__ void tr_item(const float* __restrict__ W, int Nsrc, int K, bf16* __restrict__ Wt, const float* __restrict__ gain, int kind, int nblk, LAS float* scr, int item, int lane) {
    const int kb = item / nblk, nb = item % nblk, k0 = 64 * kb, n0 = 32 * nb;
    const int j = lane & 31, n = n0 + j;
    int col;
    if (kind == 0) col = n; else if (kind == 1) col = hyb_colmap(n); else { const int pn = n >> 8, r = n & 255; col = (r >> 7) * 384 + pn * 128 + (r & 127); }
#pragma unroll 8
    for (int i = 0; i < 32; ++i) {
        const int kk = 2 * i + (lane >> 5); float v = 0.f;
        if (col >= 0) { v = W[(size_t)(k0 + kk) * Nsrc + col]; if (gain) v *= gain[k0 + kk]; }
        scr[kk * 33 + j] = v;
    }
    LDS_WAIT();
    const int c = lane & 7;
#pragma unroll
    for (int jx = 0; jx < 4; ++jx) {
        const int nn = (lane >> 3) + 8 * jx; const LAS float* s = scr + (8 * c) * 33 + nn;
        u32x4 o; o.x = pk2(s[0 * 33], s[1 * 33]); o.y = pk2(s[2 * 33], s[3 * 33]); o.z = pk2(s[4 * 33], s[5 * 33]); o.w = pk2(s[6 * 33], s[7 * 33]);
        *(u32x4*)(Wt + (size_t)(n0 + nn) * K + k0 + 8 * c) = o;
    }
    LDS_WAIT();
}
__device__ __forceinline__ void rms_row_to_bf16(const float* __restrict__ xrow, bf16* __restrict__ orow, float* __restrict__ copy, int lane) {
    const f32x4* xr = (const f32x4*)xrow + lane;
    f32x4 v[4]; float s = 0.f;
#pragma unroll
    for (int j = 0; j < 4; ++j) { v[j] = xr[64 * j]; s += (v[j].x * v[j].x + v[j].y * v[j].y) + (v[j].z * v[j].z + v[j].w * v[j].w); }
    const float rstd = rsqrtf(wave_sum(s) * (1.f / 1024.f) + EPS);
    u32x2* o8 = (u32x2*)orow + lane;
#pragma unroll
    for (int j = 0; j < 4; ++j) { u32x2 w; w.x = pk2(v[j].x * rstd, v[j].y * rstd); w.y = pk2(v[j].z * rstd, v[j].w * rstd); o8[64 * j] = w; }
    if (copy) { f32x4* c4 = (f32x4*)copy + lane;
#pragma unroll
        for (int j = 0; j < 4; ++j) c4[64 * j] = v[j]; }
}

__device__ __forceinline__ void phase_prologue(KArgs A, int wv_, LAS unsigned char* lds) {
    const int tid = opaque_tid(wv_), wid = __builtin_amdgcn_readfirstlane(tid >> 6), lane = tid & 63;
    const int gw = blockIdx.x * 8 + wid, NGW = gridDim.x * 8;
    LAS float* scr = (LAS float*)(lds + wid * 16384);
    unsigned char* ws = opq(A->ws);
    constexpr int N_HYB = 2 * 1536, N_HOUT = 2 * 512, N_SGIN = 2 * 2048, N_SGOUT = 2 * 1024, N_WQ = 4 * 512, N_WKV = 4 * 1024, N_WO = 4 * 512, N_MIN = 64 * 384, N_MOUT = 64 * 192;
    constexpr int NITEMS = N_HYB + N_HOUT + N_SGIN + N_SGOUT + N_WQ + N_WKV + N_WO + N_MIN + N_MOUT;
    for (int it = gw; it < NITEMS; it += NGW) {
        int r = it;
        if (r < N_HYB) { const int sl = r / 1536; tr_item(A->in[I_HYBIN] + (size_t)sl * 1024 * HYSRC, HYSRC, 1024, (bf16*)(ws + WS_WHYB) + (size_t)sl * HYN * 1024, A->in[I_NMIX] + (2 * sl) * 1024, 1, 96, scr, r % 1536, lane); continue; } r -= N_HYB;
        if (r < N_HOUT) { const int sl = r / 512; tr_item(A->in[I_HYBOUT] + (size_t)sl * 1024 * 1024, 1024, 1024, (bf16*)(ws + WS_WHOUT) + (size_t)sl * 1024 * 1024, nullptr, 0, 32, scr, r % 512, lane); continue; } r -= N_HOUT;
        if (r < N_SGIN) { const int sl = r / 2048; tr_item(A->in[I_SGIN] + (size_t)sl * 1024 * 4096, 4096, 1024, (bf16*)(ws + WS_WSGIN) + (size_t)sl * 4096 * 1024, A->in[I_NMIX] + (2 * sl + 1) * 1024, 0, 128, scr, r % 2048, lane); continue; } r -= N_SGIN;
        if (r < N_SGOUT) { const int sl = r / 1024; tr_item(A->in[I_SGOUT] + (size_t)sl * 2048 * 1024, 1024, 2048, (bf16*)(ws + WS_WSGOUT) + (size_t)sl * 1024 * 2048, nullptr, 0, 32, scr, r % 1024, lane); continue; } r -= N_SGOUT;
        if (r < N_WQ) { const int sl = r / 512; tr_item(A->in[I_XWQ] + (size_t)sl * 1024 * 1024, 1024, 1024, (bf16*)(ws + WS_WQ) + (size_t)sl * 1024 * 1024, A->in[I_NXAT] + sl * 1024, 0, 32, scr, r % 512, lane); continue; } r -= N_WQ;
        if (r < N_WKV) { const int sl = r / 1024; tr_item(A->in[I_XWKV] + (size_t)sl * 1024 * 2048, 2048, 1024, (bf16*)(ws + WS_WKV) + (size_t)sl * 2048 * 1024, A->in[I_NMEM] + sl * 1024, 0, 64, scr, r % 1024, lane); continue; } r -= N_WKV;
        if (r < N_WO) { const int sl = r / 512; tr_item(A->in[I_XWO] + (size_t)sl * 1024 * 1024, 1024, 1024, (bf16*)(ws + WS_WO) + (size_t)sl * 1024 * 1024, nullptr, 0, 32, scr, r % 512, lane); continue; } r -= N_WO;
        if (r < N_MIN) { const int sl = r / 384; tr_item(A->in[I_MOEIN] + (size_t)sl * 1024 * 768, 768, 1024, (bf16*)(ws + WS_WMIN) + (size_t)sl * 768 * 1024, A->in[I_NFFN] + (sl >> 4) * 1024, 2, 24, scr, r % 384, lane); continue; } r -= N_MIN;
        { const int sl = r / 192; tr_item(A->in[I_MOEOUT] + (size_t)sl * 384 * 1024, 1024, 384, (bf16*)(ws + WS_WMOUT) + (size_t)sl * 1024 * 384, nullptr, 0, 32, scr, r % 192, lane); }
    }
    for (int m = gw; m < T; m += NGW) rms_row_to_bf16(A->in[I_X] + (size_t)m * D, (bf16*)(ws + WS_XN) + (size_t)m * D, A->out + (size_t)m * D, lane);
    for (int m = gw; m < NBATCH * NMEM; m += NGW) rms_row_to_bf16(A->in[I_MEM] + (size_t)m * D, (bf16*)(ws + WS_MN) + (size_t)m * D, nullptr, lane);
    const int gt = blockIdx.x * 512 + tid, NGT = gridDim.x * 512;
    const int* pos = (const int*)A->in[I_POS];
    float* cosT = (float*)(ws + WS_COS); float* sinT = (float*)(ws + WS_SIN);
    for (int i = gt; i < T * 32; i += NGT) {
        const int t = i >> 5, j = i & 31;
        const float ang = (float)pos[t] * A->freq[j];
        const double rev = (double)ang * 0.15915494309189533577;
        const float fr = (float)(rev - rint(rev));
        cosT[i] = __builtin_amdgcn_cosf(fr); sinT[i] = __builtin_amdgcn_sinf(fr);
    }
    { bf16* WSB = (bf16*)(ws + WS_WSB); float* M0 = (float*)(ws + WS_M0); const float* wsg = A->in[I_SGWS];
      for (int e = gt; e < 2 * 8 * 128 * 128; e += NGT) { const int s = e & 127, t = (e >> 7) & 127; WSB[e] = (bf16)f2bf(s <= t ? wsg[e] : 0.f); }
      for (int e = gt; e < 2 * 8 * 128; e += NGT) { const int t = e & 127; const float* r = wsg + (size_t)e * 128; float a = 0.f; for (int s = 0; s <= t; ++s) a += r[s]; M0[e] = a; } }
    float* RW = (float*)(ws + WS_RW);
    for (int i = gt; i < DEPTH * NEXP * D; i += NGT) { const int k = i & 1023, e = (i >> 10) & 15, l = i >> 14; RW[i] = A->in[I_RW][k * NEXP + e] * A->in[I_NFFN][l * D + k]; }
}

__device__ __forceinline__ void phase_knorm(KArgs A, int wv_) {
    const int tid_ = opaque_tid(wv_); const int wid = __builtin_amdgcn_readfirstlane(tid_ >> 6), lane = tid_ & 63; const int gw = blockIdx.x * 8 + wid, NGW = gridDim.x * 8;
    bf16* KV = (bf16*)(opq(A->ws) + WS_KV);
    for (int it = gw; it < DEPTH * 2048 * 4; it += NGW) {
        const int h = it & 3, m = (it >> 2) & 2047, l = it >> 13;
        bf16* p = KV + (size_t)m * 8192 + l * 2048 + h * 256 + 4 * lane;
        const u32x2 w = *(const u32x2*)p;
        float x0 = bflo(w.x), x1 = bfhi(w.x), x2 = bflo(w.y), x3 = bfhi(w.y);
        const float rstd = rsqrtf(wave_sum(x0 * x0 + x1 * x1 + x2 * x2 + x3 * x3) * (1.f / 256.f) + EPS) * 0.0625f;
        const f32x4 g = *(const f32x4*)(A->in[I_XKN] + l * 256 + 4 * lane);
        u32x2 o; o.x = pk2(x0 * rstd * g.x, x1 * rstd * g.y); o.y = pk2(x2 * rstd * g.z, x3 * rstd * g.w);
        *(u32x2*)p = o;
    }
}

__device__ __forceinline__ int kpos64(int tok) { const int k = tok & 31; return (tok & 32) + 8 * ((k >> 2) & 3) + 4 * (k >> 4) + (k & 3); }
__device__ __forceinline__ int kperm64(int p) { const int fq = (p >> 3) & 3, j = p & 7; return (p & 32) + 16 * (j >> 2) + 4 * fq + (j & 3); }

__device__ __forceinline__ void phase_nsa_prep(KArgs A, int wv_, int i, LAS unsigned char* lds) {
    const int tid_ = opaque_tid(wv_); const int wid = __builtin_amdgcn_readfirstlane(tid_ >> 6), lane = tid_ & 63; const int gw = blockIdx.x * 8 + wid, NGW = gridDim.x * 8;
    unsigned char* ws = opq(A->ws);
    const bf16* HY = (const bf16*)(ws + WS_BIG);
    const float* cosT = (const float*)(ws + WS_COS); const float* sinT = (const float*)(ws + WS_SIN);
    bf16* QA = (bf16*)(ws + WS_QA); bf16* KS = (bf16*)(ws + WS_KS); bf16* KW = (bf16*)(ws + WS_KW);
    LAS float* abuf = (LAS float*)(lds + wid * 8192);
    const int NIT = T + NBATCH * NCMP * 2 * 2;
    for (int it = gw; it < NIT; it += NGW) {
        if (it < T) {
            const int t = it;
            const float c = cosT[t * 32 + (lane & 31)], s = sinT[t * 32 + (lane & 31)];
#pragma unroll
            for (int u = 0; u < 12; ++u) {
                int src; const float* gain; bf16* dst; float scale;
                if (u < 8) { src = C_QA + 64 * u; gain = A->in[I_QNORM] + i * 64; dst = QA + (size_t)t * 512 + 64 * u; scale = 0.125f; }
                else if (u < 10) { src = C_KS + 64 * (u - 8); gain = A->in[I_KNORM] + (i * 3 + 1) * 64; dst = KS + (size_t)t * 128 + 64 * (u - 8); scale = 1.f; }
                else { src = C_KW + 64 * (u - 10); gain = A->in[I_KNORM] + (i * 3 + 2) * 64; dst = KW + (size_t)t * 128 + 64 * (u - 10); scale = 1.f; }
                const float x = bf2f(HY[(size_t)t * HYN + src + lane]);
                const float y = x * rsqrtf(wave_sum(x * x) * (1.f / 64.f) + EPS) * gain[lane] * scale;
                const float pr = __shfl_xor(y, 32);
                const float o = lane < 32 ? y * c - pr * s : y * c + pr * s;
                dst[lane] = (bf16)f2bf(o);
            }
        } else {
            const int r = it - T; const int kv = r & 1, g = (r >> 1) & 1, bn = r >> 2, n = bn % NCMP, b = bn / NCMP;
            const float* pe = A->in[I_CMPPE] + (size_t)(i * 2 + kv) * 32 * 64;
            const float* w1 = A->in[I_CMPW1] + (size_t)(i * 2 + kv) * 2048 * 64;
            const float* w2 = A->in[I_CMPW2] + (size_t)(i * 2 + kv) * 64 * 64;
            const int tok0 = b * S + 16 * n, coff = (kv ? C_VC : C_KC) + g * 64;
#pragma unroll 4
            for (int l = 0; l < 32; ++l) abuf[l * 64 + lane] = bf2f(HY[(size_t)(tok0 + l) * HYN + coff + lane]) + pe[l * 64 + lane];
            LDS_WAIT();
            float acc = 0.f;
#pragma unroll 8
            for (int k = 0; k < 2048; ++k) acc += abuf[k] * w1[k * 64 + lane];
            const float h = gelu_tanh(acc);
            float o = 0.f;
#pragma unroll 8
            for (int m = 0; m < 64; ++m) o += __shfl(h, m) * w2[m * 64 + lane];
            LDS_WAIT();
            const size_t oidx = ((size_t)(b * 128 + n) * 2 + g) * 64 + lane;
            if (kv == 0) {
                const float y = o * rsqrtf(wave_sum(o * o) * (1.f / 64.f) + EPS) * A->in[I_KNORM][(i * 3 + 0) * 64 + lane];
                const int tp = tok0 + 31;
                const float c = cosT[tp * 32 + (lane & 31)], s = sinT[tp * 32 + (lane & 31)];
                const float pr = __shfl_xor(y, 32);
                const float oo = lane < 32 ? y * c - pr * s : y * c + pr * s;
                ((bf16*)(ws + WS_KC))[oidx] = (bf16)f2bf(oo);
            } else {
                bf16* vct = (bf16*)(ws + WS_VC) + ((size_t)(b * 2 + g) * 64 + lane) * 128;
                vct[(n & 64) + kpos64(n & 63)] = (bf16)f2bf(o);
                if (n == 126) vct[127] = 0;
                (void)oidx;
            }
        }
    }
}

__device__ __forceinline__ void nsa_block(const LAS float* qs, const bf16* __restrict__ krow, bool ok, const bf16* __restrict__ vbase, int vstride, int lane,
                                          float (&m)[4], float (&l)[4], float (&o)[4]) {
    float s[4] = {0.f, 0.f, 0.f, 0.f};
#pragma unroll 2
    for (int c = 0; c < 8; ++c) {
        const u32x4 kw = *(const u32x4*)(krow + 8 * c);
        const float k0 = bflo(kw.x), k1 = bfhi(kw.x), k2 = bflo(kw.y), k3 = bfhi(kw.y), k4 = bflo(kw.z), k5 = bfhi(kw.z), k6 = bflo(kw.w), k7 = bfhi(kw.w);
#pragma unroll
        for (int hh = 0; hh < 4; ++hh) {
            const f32x4 qa = *(const LAS f32x4*)(qs + hh * 64 + 8 * c), qb = *(const LAS f32x4*)(qs + hh * 64 + 8 * c + 4);
            s[hh] += (qa.x * k0 + qa.y * k1) + (qa.z * k2 + qa.w * k3) + (qb.x * k4 + qb.y * k5) + (qb.z * k6 + qb.w * k7);
        }
    }
    float p[4];
#pragma unroll
    for (int hh = 0; hh < 4; ++hh) {
        const float sv = ok ? s[hh] : -INFINITY;
        const float bm = wave_max(sv);
        const float mn = fmaxf(m[hh], bm);
        if (mn == -INFINITY) { p[hh] = 0.f; continue; }
        const float alpha = __expf(m[hh] - mn);
        p[hh] = ok ? __expf(sv - mn) : 0.f;
        l[hh] = l[hh] * alpha + wave_sum(p[hh]);
        o[hh] *= alpha; m[hh] = mn;
    }
#pragma unroll 8
    for (int kk = 0; kk < 64; ++kk) {
        const float v = bf2f(vbase[(size_t)kk * vstride + lane]);
#pragma unroll
        for (int hh = 0; hh < 4; ++hh) o[hh] += __shfl(p[hh], kk) * v;
    }
}
__device__ __forceinline__ void phase_nsa_attn(KArgs A, int wv_, int i, LAS unsigned char* lds) {
    const int tid_ = opaque_tid(wv_); const int wid = __builtin_amdgcn_readfirstlane(tid_ >> 6), lane0 = tid_ & 63; const int gw = blockIdx.x * 8 + wid, NGW = gridDim.x * 8;
    unsigned char* ws = opq(A->ws);
    const bf16* HY = (const bf16*)(ws + WS_BIG); const bf16* QA = (const bf16*)(ws + WS_QA); const bf16* KS = (const bf16*)(ws + WS_KS); const bf16* KW = (const bf16*)(ws + WS_KW);
    const bf16* KC = (const bf16*)(ws + WS_KC); const bf16* VC = (const bf16*)(ws + WS_VC); bf16* CAT = (bf16*)(ws + WS_CAT);
    LAS float* qs = (LAS float*)(lds + wid * 2048);
    LAS float* ps = qs + 256;
    for (int it = gw; it < 2 * T; it += NGW) {
        int lane = lane0; asm volatile("" : "+v"(lane));
        const int tok = it >> 1, g = it & 1, b = tok >> 11, t = tok & 2047;
#pragma unroll
        for (int hh = 0; hh < 4; ++hh) qs[hh * 64 + lane] = bf2f(QA[(size_t)tok * 512 + (g * 4 + hh) * 64 + lane]);
        LDS_WAIT();
        const int ncv = t >= 31 ? ((t - 31) >> 4) + 1 : 0;
        float oc[4] = {0.f, 0.f, 0.f, 0.f};
        float psum0 = 0.f, psum1 = 0.f;
        {
            const bool v0 = lane < ncv, v1 = lane + 64 < ncv;
            const bf16* k0p = KC + ((size_t)(b * 128 + lane) * 2 + g) * 64;
            const bf16* k1p = KC + ((size_t)(b * 128 + (lane + 64 < 127 ? lane + 64 : 126)) * 2 + g) * 64;
            float s0[4] = {0.f, 0.f, 0.f, 0.f}, s1[4] = {0.f, 0.f, 0.f, 0.f};
#pragma unroll 2
            for (int c = 0; c < 8; ++c) {
                const u32x4 ka = *(const u32x4*)(k0p + 8 * c), kb = *(const u32x4*)(k1p + 8 * c);
#pragma unroll
                for (int hh = 0; hh < 4; ++hh) {
                    const f32x4 qa = *(const LAS f32x4*)(qs + hh * 64 + 8 * c), qb = *(const LAS f32x4*)(qs + hh * 64 + 8 * c + 4);
                    s0[hh] += (qa.x * bflo(ka.x) + qa.y * bfhi(ka.x)) + (qa.z * bflo(ka.y) + qa.w * bfhi(ka.y)) + (qb.x * bflo(ka.z) + qb.y * bfhi(ka.z)) + (qb.z * bflo(ka.w) + qb.w * bfhi(ka.w));
                    s1[hh] += (qa.x * bflo(kb.x) + qa.y * bfhi(kb.x)) + (qa.z * bflo(kb.y) + qa.w * bfhi(kb.y)) + (qb.x * bflo(kb.z) + qb.y * bfhi(kb.z)) + (qb.z * bflo(kb.w) + qb.w * bfhi(kb.w));
                }
            }
            float p0[4], p1[4];
#pragma unroll
            for (int hh = 0; hh < 4; ++hh) {
                const float a0 = v0 ? s0[hh] : -INFINITY, a1 = v1 ? s1[hh] : -INFINITY;
                const float mx = wave_max(fmaxf(a0, a1));
                if (ncv > 0) {
                    const float e0 = v0 ? __expf(a0 - mx) : 0.f, e1 = v1 ? __expf(a1 - mx) : 0.f;
                    const float inv = 1.0f / wave_sum(e0 + e1);
                    p0[hh] = e0 * inv; p1[hh] = e1 * inv;
                } else { p0[hh] = 0.f; p1[hh] = 0.f; }
                psum0 += p0[hh]; psum1 += p1[hh];
            }
#pragma unroll 2
            for (int c = 0; c < ncv; ++c) {
                const float v = bf2f(VC[((size_t)(b * 128 + c) * 2 + g) * 64 + lane]);
#pragma unroll
                for (int hh = 0; hh < 4; ++hh) oc[hh] += __shfl(c < 64 ? p0[hh] : p1[hh], c & 63) * v;
            }
        }
        ps[lane] = psum0; ps[64 + lane] = psum1;
        LDS_WAIT();
        const int cur = t >> 6;
        unsigned selmask;
        {
            const int j = lane & 31;
            float imp = ps[4 * j] + ps[4 * j + 1] + ps[4 * j + 2] + 0.5f * ps[4 * j + 3] + (j > 0 ? 0.5f * ps[4 * j - 1] : 0.f);
            const bool valid = j <= cur, forced = (j == 0) || (j == cur) || (j == cur - 1);
            const float score = valid ? imp + (forced ? 1000.0f : 0.f) : -INFINITY;
            int rank = 0;
#pragma unroll 8
            for (int jj = 0; jj < 32; ++jj) { const float sj = __shfl(score, jj); rank += (sj > score || (sj == score && jj < j)) ? 1 : 0; }
            const bool sel = valid && rank < 8 && lane < 32;
            selmask = (unsigned)__ballot(sel);
        }
        LDS_WAIT();
        float o1[4] = {0.f, 0.f, 0.f, 0.f}, o2[4] = {0.f, 0.f, 0.f, 0.f};
#pragma unroll 1
        for (int pass = 0; pass < 2; ++pass) {
            float oa[4] = {0.f, 0.f, 0.f, 0.f}, ma[4] = {-INFINITY, -INFINITY, -INFINITY, -INFINITY}, la[4] = {0.f, 0.f, 0.f, 0.f};
            const int lo = pass ? (t - 255 > 0 ? t - 255 : 0) : 0;
            const unsigned bm = pass ? 0xffffffffu : selmask;
            const bf16* Kb = pass ? KW : KS; const int vc = pass ? C_VW : C_VS;
#pragma unroll 1
            for (int j = lo >> 6; j <= cur; ++j) {
                if (!((bm >> j) & 1u)) continue;
                const int key = 64 * j + lane; const size_t kt = (size_t)(b * S + key);
                nsa_block(qs, Kb + kt * 128 + g * 64, key <= t && key >= lo, HY + (size_t)(b * S + 64 * j) * HYN + vc + g * 64, HYN, lane, ma, la, oa);
            }
            if (pass == 0) {
#pragma unroll
                for (int hh = 0; hh < 4; ++hh) o1[hh] = oa[hh] / la[hh];
            } else {
#pragma unroll
                for (int hh = 0; hh < 4; ++hh) o2[hh] = oa[hh] / la[hh];
            }
        }
#pragma unroll
        for (int hh = 0; hh < 4; ++hh) {
            const int head = g * 4 + hh;
            const float* gb = A->in[I_GATEB] + i * 24 + head * 3;
            const bf16* gl = HY + (size_t)tok * HYN + C_GA + head * 3;
            const float g0 = sigmoidf_(bf2f(gl[0]) + gb[0]), g1 = sigmoidf_(bf2f(gl[1]) + gb[1]), g2 = sigmoidf_(bf2f(gl[2]) + gb[2]);
            const float o = g0 * oc[hh] + g1 * o1[hh] + g2 * o2[hh];
            CAT[(size_t)tok * 1024 + head * 64 + lane] = (bf16)f2bf(o);
        }
    }
}

__device__ __forceinline__ void phase_gla_seq(KArgs A, int wv_, int i, LAS unsigned char* lds) {
    const int tid = opaque_tid(wv_), wid = __builtin_amdgcn_readfirstlane(tid >> 6), lane = tid & 63;
    unsigned char* ws = opq(A->ws);
    const bf16* HY = (const bf16*)(ws + WS_BIG); bf16* CAT = (bf16*)(ws + WS_CAT);
    constexpr int CH = 16;
    LAS float* la = (LAS float*)lds;
    LAS float* lk = la + 4 * CH * 64;
    LAS float* lq = lk + 4 * CH * 64;
    LAS float* lo = lq + 4 * CH * 64;
    const float* wa2 = A->in[I_WA2] + i * 16 * 256; const float* ba = A->in[I_BA] + i * 256; const float* og = A->in[I_ONORM] + i * 128;
    for (int it = blockIdx.x; it < 8; it += gridDim.x) {
        const int pl = tid >> 7, v = tid & 127, p = it * 4 + pl, b = p >> 2, h = p & 3;
        float St[64];
#pragma unroll
        for (int k = 0; k < 64; ++k) St[k] = 0.f;
        for (int c0 = 0; c0 < S; c0 += CH) {
            __syncthreads();
            for (int e = tid; e < 4 * CH * 64; e += 512) {
                const int kk = e & 63, tk = (e >> 6) % CH, pp = e / (64 * CH); const int pb = (it * 4 + pp) >> 2, ph = (it * 4 + pp) & 3;
                const size_t tok = (size_t)pb * S + c0 + tk; const bf16* row = HY + tok * HYN;
                float z = ba[ph * 64 + kk];
#pragma unroll
                for (int r = 0; r < 16; ++r) z += bf2f(row[C_AL + r]) * wa2[r * 256 + ph * 64 + kk];
                const float ls_ = fminf(z, 0.f) - log1pf(__expf(-fabsf(z)));
                la[e] = __expf(ls_ * (1.f / 16.f));
                lk[e] = bf2f(row[C_KB + ph * 64 + kk]);
                lq[e] = bf2f(row[C_QB + ph * 64 + kk]) * 0.125f;
            }
            __syncthreads();
            for (int tk = 0; tk < CH; ++tk) {
                const size_t tok = (size_t)b * S + c0 + tk;
                const float vv = bf2f(HY[tok * HYN + C_VB + h * 128 + v]);
                const LAS float* pa = la + (pl * CH + tk) * 64; const LAS float* pk = lk + (pl * CH + tk) * 64; const LAS float* pq = lq + (pl * CH + tk) * 64;
                float o = 0.f;
#pragma unroll
                for (int k4 = 0; k4 < 16; ++k4) {
                    const f32x4 a4 = *(const LAS f32x4*)(pa + 4 * k4), k4v = *(const LAS f32x4*)(pk + 4 * k4), q4 = *(const LAS f32x4*)(pq + 4 * k4);
                    St[4 * k4 + 0] = a4.x * St[4 * k4 + 0] + k4v.x * vv; o += q4.x * St[4 * k4 + 0];
                    St[4 * k4 + 1] = a4.y * St[4 * k4 + 1] + k4v.y * vv; o += q4.y * St[4 * k4 + 1];
                    St[4 * k4 + 2] = a4.z * St[4 * k4 + 2] + k4v.z * vv; o += q4.z * St[4 * k4 + 2];
                    St[4 * k4 + 3] = a4.w * St[4 * k4 + 3] + k4v.w * vv; o += q4.w * St[4 * k4 + 3];
                }
                lo[(pl * CH + tk) * 128 + v] = o;
            }
            __syncthreads();
            for (int r = wid; r < 4 * CH; r += 8) {
                const int pp = r / CH, tk = r % CH; const int pb = (it * 4 + pp) >> 2, ph = (it * 4 + pp) & 3;
                const size_t tok = (size_t)pb * S + c0 + tk;
                const float x0 = lo[r * 128 + lane], x1 = lo[r * 128 + 64 + lane];
                const float rstd = rsqrtf(wave_sum(x0 * x0 + x1 * x1) * (1.f / 128.f) + EPS);
                const float r0 = bf2f(HY[tok * HYN + C_RB + ph * 128 + lane]), r1 = bf2f(HY[tok * HYN + C_RB + ph * 128 + 64 + lane]);
                CAT[tok * 1024 + 512 + ph * 128 + lane] = (bf16)f2bf(x0 * rstd * og[lane] * (r0 * sigmoidf_(r0)));
                CAT[tok * 1024 + 512 + ph * 128 + 64 + lane] = (bf16)f2bf(x1 * rstd * og[64 + lane] * (r1 * sigmoidf_(r1)));
            }
        }
        __syncthreads();
    }
}


__device__ __forceinline__ void phase_nsa_attn_mfma(KArgs A, int wv_, int i, LAS unsigned char* lds) {
    const int tid = opaque_tid(wv_), wid = __builtin_amdgcn_readfirstlane(tid >> 6), lane = tid & 63, fr = lane & 15, fq = lane >> 4;
    unsigned char* ws = opq(A->ws);
    const bf16* HY = (const bf16*)(ws + WS_BIG); const bf16* QA = (const bf16*)(ws + WS_QA); const bf16* KS = (const bf16*)(ws + WS_KS); const bf16* KW = (const bf16*)(ws + WS_KW);
    const bf16* KC = (const bf16*)(ws + WS_KC); const bf16* VCT = (const bf16*)(ws + WS_VC); const bf16* VTA = (const bf16*)(ws + WS_VTA); bf16* CAT = (bf16*)(ws + WS_CAT);
    constexpr int RS = 72;
    LAS bf16* ktl = (LAS bf16*)lds;
    LAS bf16* vtl = ktl + 2 * 64 * RS;
    LAS float* scl = (LAS float*)(lds + 36864) + wid * 256;
    LAS unsigned* msk = (LAS unsigned*)(lds + 36864 + 8192);
    LAS unsigned* umask = msk + 64;
    const float* gb = A->in[I_GATEB] + i * 24;
    for (int pit = blockIdx.x; pit < 256; pit += gridDim.x) {
#pragma unroll 1
        for (int hf = 0; hf < 2; ++hf) {
            const int bg = pit >> 4, xx = pit & 15, x = hf ? 31 - xx : xx, b = bg >> 1, g = bg & 1;
            const size_t tokbase = (size_t)b * S + 64 * x;
            const int tl0 = 8 * wid + (fr >> 2);
            if (tid == 0) *umask = 0u;
            bf16x8 qf[2][2];
#pragma unroll
            for (int mt = 0; mt < 2; ++mt)
#pragma unroll
                for (int s = 0; s < 2; ++s) qf[mt][s] = *(const bf16x8*)(QA + (tokbase + tl0 + 4 * mt) * 512 + (g * 4 + (fr & 3)) * 64 + 32 * s + 8 * fq);
            f32x4 outacc[2][4];
            {
                const int tmaxc = (4 * x + 3 + 15) >> 4;
                const bf16* kcb = KC + ((size_t)(b * 128 + fr) * 2 + g) * 64 + 8 * fq;
                bf16x8 pcf[2][4];
#pragma unroll
                for (int mt = 0; mt < 2; ++mt) {
                    f32x4 sc[8];
                    const bf16* kp = kcb;
#pragma unroll
                    for (int t = 0; t < 8; ++t) { sc[t] = (f32x4){0.f, 0.f, 0.f, 0.f};
                        asm volatile("" : "+v"(kp));
                        if (t < tmaxc) {
                            const bf16x8 k0 = *(const bf16x8*)(kp), k1 = *(const bf16x8*)(kp + 32);
                            sc[t] = __builtin_amdgcn_mfma_f32_16x16x32_bf16(k0, qf[mt][0], sc[t], 0, 0, 0);
                            sc[t] = __builtin_amdgcn_mfma_f32_16x16x32_bf16(k1, qf[mt][1], sc[t], 0, 0, 0); }
                        kp += 16 * 128; }
                    const int tg = 64 * x + tl0 + 4 * mt; const int ncv = tg >= 31 ? ((tg - 31) >> 4) + 1 : 0;
                    float mx = -INFINITY;
#pragma unroll
                    for (int t = 0; t < 8; ++t)
#pragma unroll
                        for (int r = 0; r < 4; ++r) { const bool v = 16 * t + 4 * fq + r < ncv; sc[t][r] = v ? sc[t][r] : -INFINITY; mx = fmaxf(mx, sc[t][r]); }
                    mx = fmaxf(mx, __shfl_xor(mx, 16)); mx = fmaxf(mx, __shfl_xor(mx, 32));
                    const float mxs = mx == -INFINITY ? 0.f : mx;
                    float sum = 0.f;
#pragma unroll
                    for (int t = 0; t < 8; ++t)
#pragma unroll
                        for (int r = 0; r < 4; ++r) { sc[t][r] = __expf(sc[t][r] - mxs); sum += sc[t][r]; }
                    sum += __shfl_xor(sum, 16); sum += __shfl_xor(sum, 32);
                    const float inv = sum > 0.f ? 1.f / sum : 0.f;
#pragma unroll
                    for (int t = 0; t < 8; ++t) sc[t] = sc[t] * inv;
#pragma unroll
                    for (int s = 0; s < 4; ++s) { u32x4 w; w.x = pk2(sc[2 * s].x, sc[2 * s].y); w.y = pk2(sc[2 * s].z, sc[2 * s].w); w.z = pk2(sc[2 * s + 1].x, sc[2 * s + 1].y); w.w = pk2(sc[2 * s + 1].z, sc[2 * s + 1].w);
                        pcf[mt][s] = __builtin_bit_cast(bf16x8, w); }
                    float w3[8];
#pragma unroll
                    for (int t = 0; t < 8; ++t) {
#pragma unroll
                        for (int r = 0; r < 4; ++r) { float v = sc[t][r]; v += __shfl_xor(v, 1); v += __shfl_xor(v, 2); sc[t][r] = v; }
                        w3[t] = __shfl(sc[t].w, (lane + 48) & 63);
                    }
#pragma unroll
                    for (int t = 0; t < 8; ++t) {
                        const float prev = fq > 0 ? w3[t] : (t > 0 ? w3[t > 0 ? t - 1 : 0] : 0.f);
                        const float imp = sc[t].x + sc[t].y + sc[t].z + 0.5f * sc[t].w + 0.5f * prev;
                        if ((fr & 3) == 0) scl[(4 * mt + (fr >> 2)) * 32 + 4 * t + fq] = imp;
                    }
                    asm volatile("" ::: "memory");
                }
                const bf16* vcb = VCT + ((size_t)(b * 2 + g) * 64 + fr) * 128 + 8 * fq;
#pragma unroll
                for (int n = 0; n < 4; ++n) {
                    outacc[0][n] = (f32x4){0.f, 0.f, 0.f, 0.f}; outacc[1][n] = (f32x4){0.f, 0.f, 0.f, 0.f};
                    asm volatile("" : "+v"(vcb));
#pragma unroll
                    for (int s = 0; s < 4; ++s) if (2 * s < tmaxc) {
                        const bf16x8 vf = *(const bf16x8*)(vcb + 32 * s);
                        outacc[0][n] = __builtin_amdgcn_mfma_f32_16x16x32_bf16(vf, pcf[0][s], outacc[0][n], 0, 0, 0);
                        outacc[1][n] = __builtin_amdgcn_mfma_f32_16x16x32_bf16(vf, pcf[1][s], outacc[1][n], 0, 0, 0); }
                    vcb += 16 * 128;
                    asm volatile("" ::: "memory");
                }
            }
            float g1v[2], g2v[2];
#pragma unroll
            for (int mt = 0; mt < 2; ++mt) {
                const int head = g * 4 + (fr & 3);
                const bf16* gl = HY + (tokbase + tl0 + 4 * mt) * HYN + C_GA + head * 3;
                const float g0 = sigmoidf_(bf2f(gl[0]) + gb[head * 3 + 0]);
                g1v[mt] = sigmoidf_(bf2f(gl[1]) + gb[head * 3 + 1]); g2v[mt] = sigmoidf_(bf2f(gl[2]) + gb[head * 3 + 2]);
#pragma unroll
                for (int n = 0; n < 4; ++n) outacc[mt][n] = outacc[mt][n] * g0;
            }
            LDS_WAIT();
            asm volatile("" ::: "memory");
            {
                const int tok8 = lane >> 3, jg = lane & 7;
                float sj[32];
#pragma unroll
                for (int q = 0; q < 8; ++q) { const f32x4 v = *(const LAS f32x4*)(scl + tok8 * 32 + 4 * q); sj[4 * q] = v.x; sj[4 * q + 1] = v.y; sj[4 * q + 2] = v.z; sj[4 * q + 3] = v.w; }
#pragma unroll
                for (int j = 0; j < 32; ++j) sj[j] = j <= x ? sj[j] + ((j == 0 || j == x || j == x - 1) ? 1000.0f : 0.f) : -INFINITY;
                unsigned bits = 0u;
                const f32x4 mv = *(const LAS f32x4*)(scl + tok8 * 32 + 4 * jg);
#pragma unroll
                for (int q = 0; q < 4; ++q) {
                    const int j = 4 * jg + q;
                    const float mine = j <= x ? mv[q] + ((j == 0 || j == x || j == x - 1) ? 1000.0f : 0.f) : -INFINITY;
                    int rank = 0;
#pragma unroll
                    for (int jj = 0; jj < 32; ++jj) rank += (sj[jj] > mine || (sj[jj] == mine && jj < j)) ? 1 : 0;
                    bits |= (j <= x && rank < 8) ? (1u << j) : 0u;
                }
                bits |= __shfl_xor(bits, 1); bits |= __shfl_xor(bits, 2); bits |= __shfl_xor(bits, 4);
                if (jg == 0) { msk[wid * 8 + tok8] = bits; atomicOr((unsigned*)umask, bits); }
            }
            __syncthreads();
#pragma unroll 1
            for (int pass = 0; pass < 2; ++pass) {
                const int jlo = pass ? (x >= 4 ? x - 4 : 0) : 0;
                const unsigned inrange = (x >= 31 ? 0xffffffffu : ((2u << x) - 1u)) & ~((1u << jlo) - 1u);
                unsigned bmask = pass ? inrange : (*umask & inrange);
                const bf16* Kb = pass ? KW : KS; const int cg = (pass ? 10 : 8) + g;
                unsigned tm[2], wm[2];
#pragma unroll
                for (int mt = 0; mt < 2; ++mt) {
                    tm[mt] = pass ? 0xffffffffu : msk[wid * 8 + 4 * mt + (fr >> 2)];
                    wm[mt] = pass ? 0xffffffffu : (msk[wid * 8 + 4 * mt] | msk[wid * 8 + 4 * mt + 1] | msk[wid * 8 + 4 * mt + 2] | msk[wid * 8 + 4 * mt + 3]);
                    wm[mt] = __builtin_amdgcn_readfirstlane(wm[mt]);
                }
                f32x4 o[2][4]; float mrun[2], lrun[2];
#pragma unroll
                for (int mt = 0; mt < 2; ++mt) { mrun[mt] = -INFINITY; lrun[mt] = 0.f;
#pragma unroll
                    for (int n = 0; n < 4; ++n) o[mt][n] = (f32x4){0.f, 0.f, 0.f, 0.f}; }
                const int srow = tid >> 3, sc16 = tid & 7;
                u32x4 pk_, pv_;
                int j = __ffs(bmask) - 1;
                {   const bf16* ksrc = Kb + ((size_t)b * S + 64 * j + srow) * 128 + g * 64 + sc16 * 8; const bf16* vsrc = VTA + ((size_t)((b * 32 + j) * 12 + cg)) * 4096 + srow * 64 + sc16 * 8;
                    pk_ = *(const u32x4*)ksrc; pv_ = *(const u32x4*)vsrc; }
                int buf = 0;
                while (j >= 0) {
                    *(LAS u32x4*)(ktl + buf * 64 * RS + srow * RS + sc16 * 8) = pk_; *(LAS u32x4*)(vtl + buf * 64 * RS + srow * RS + sc16 * 8) = pv_;
                    bmask &= bmask - 1u;
                    const int jn = bmask ? __ffs(bmask) - 1 : -1;
                    if (jn >= 0) { const bf16* ksrc = Kb + ((size_t)b * S + 64 * jn + srow) * 128 + g * 64 + sc16 * 8; const bf16* vsrc = VTA + ((size_t)((b * 32 + jn) * 12 + cg)) * 4096 + srow * 64 + sc16 * 8;
                        pk_ = *(const u32x4*)ksrc; pv_ = *(const u32x4*)vsrc; }
                    __syncthreads();
                    const LAS bf16* kt = ktl + buf * 64 * RS + fr * RS + 8 * fq; const LAS bf16* vt = vtl + buf * 64 * RS + fr * RS + 8 * fq;
#pragma unroll
                    for (int mt = 0; mt < 2; ++mt) {
                        if (!((wm[mt] >> j) & 1u)) continue;
                        f32x4 sc[4];
#pragma unroll
                        for (int t = 0; t < 4; ++t) { sc[t] = (f32x4){0.f, 0.f, 0.f, 0.f};
                            sc[t] = __builtin_amdgcn_mfma_f32_16x16x32_bf16(*(const LAS bf16x8*)(kt + t * 16 * RS), qf[mt][0], sc[t], 0, 0, 0);
                            sc[t] = __builtin_amdgcn_mfma_f32_16x16x32_bf16(*(const LAS bf16x8*)(kt + t * 16 * RS + 32), qf[mt][1], sc[t], 0, 0, 0); }
                        const int tl = tl0 + 4 * mt;
                        const bool rowok = (tm[mt] >> j) & 1u;
                        const int kphi = j == x ? tl : 63;
                        const int kplo = (pass && j == x - 4) ? tl + 1 : 0;
                        float bm = -INFINITY;
#pragma unroll
                        for (int t = 0; t < 4; ++t)
#pragma unroll
                            for (int r = 0; r < 4; ++r) { const int kp = 16 * t + 4 * fq + r; const bool v = rowok && kp <= kphi && kp >= kplo; sc[t][r] = v ? sc[t][r] : -INFINITY; bm = fmaxf(bm, sc[t][r]); }
                        bm = fmaxf(bm, __shfl_xor(bm, 16)); bm = fmaxf(bm, __shfl_xor(bm, 32));
                        const float mn = fmaxf(mrun[mt], bm); const float mns = mn == -INFINITY ? 0.f : mn;
                        const float alpha = __expf(mrun[mt] - mns);
                        float rs = 0.f;
#pragma unroll
                        for (int t = 0; t < 4; ++t)
#pragma unroll
                            for (int r = 0; r < 4; ++r) { sc[t][r] = __expf(sc[t][r] - mns); rs += sc[t][r]; }
                        rs += __shfl_xor(rs, 16); rs += __shfl_xor(rs, 32);
                        lrun[mt] = lrun[mt] * alpha + rs; mrun[mt] = mn;
                        bf16x8 pf[2];
#pragma unroll
                        for (int s = 0; s < 2; ++s) { u32x4 w; w.x = pk2(sc[2 * s].x, sc[2 * s].y); w.y = pk2(sc[2 * s].z, sc[2 * s].w); w.z = pk2(sc[2 * s + 1].x, sc[2 * s + 1].y); w.w = pk2(sc[2 * s + 1].z, sc[2 * s + 1].w);
                            pf[s] = __builtin_bit_cast(bf16x8, w); }
#pragma unroll
                        for (int n = 0; n < 4; ++n) { o[mt][n] = o[mt][n] * alpha;
                            o[mt][n] = __builtin_amdgcn_mfma_f32_16x16x32_bf16(*(const LAS bf16x8*)(vt + n * 16 * RS), pf[0], o[mt][n], 0, 0, 0);
                            o[mt][n] = __builtin_amdgcn_mfma_f32_16x16x32_bf16(*(const LAS bf16x8*)(vt + n * 16 * RS + 32), pf[1], o[mt][n], 0, 0, 0); }
                    }
                    j = jn; buf ^= 1;
                }
#pragma unroll
                for (int mt = 0; mt < 2; ++mt) { const float sc_ = (pass ? g2v[mt] : g1v[mt]) / lrun[mt];
#pragma unroll
                    for (int n = 0; n < 4; ++n) outacc[mt][n] = outacc[mt][n] + o[mt][n] * sc_; }
                __syncthreads();
            }
#pragma unroll
            for (int mt = 0; mt < 2; ++mt) {
                bf16* dst = CAT + (tokbase + tl0 + 4 * mt) * 1024 + (g * 4 + (fr & 3)) * 64 + 4 * fq;
#pragma unroll
                for (int n = 0; n < 4; ++n) { u32x2 w; w.x = pk2(outacc[mt][n].x, outacc[mt][n].y); w.y = pk2(outacc[mt][n].z, outacc[mt][n].w); *(u32x2*)(dst + 16 * n) = w; }
            }
        }
    }
    __syncthreads();
}

__device__ __forceinline__ void phase_vtiles(KArgs A, int wv_, LAS unsigned char* lds) {
    const int tid_ = opaque_tid(wv_); const int wid = __builtin_amdgcn_readfirstlane(tid_ >> 6), lane = tid_ & 63; const int gw = blockIdx.x * 8 + wid, NGW = gridDim.x * 8;
    unsigned char* ws = opq(A->ws);
    const bf16* HY = (const bf16*)(ws + WS_BIG); bf16* VTA = (bf16*)(ws + WS_VTA);
    constexpr int TS = 66;
    LAS bf16* tl = (LAS bf16*)(lds + 65536) + wid * (64 * TS);
    for (int it = gw; it < NBATCH * 32 * 12; it += NGW) {
        const int cg = it % 12, bc = it / 12;
        const int colbase = cg < 8 ? C_VB + cg * 64 : (cg < 10 ? C_VS + (cg - 8) * 64 : C_VW + (cg - 10) * 64);
        const u32x4* src = (const u32x4*)(HY + (size_t)(bc * 64 + lane) * HYN + colbase);
        u32x4 w[8];
#pragma unroll
        for (int i = 0; i < 8; ++i) w[i] = src[i];
#pragma unroll
        for (int i = 0; i < 8; ++i) { LAS unsigned* d = (LAS unsigned*)(tl + lane * TS + 8 * i); d[0] = w[i].x; d[1] = w[i].y; d[2] = w[i].z; d[3] = w[i].w; }
        LDS_WAIT();
        bf16* dst = VTA + (size_t)it * 4096 + lane * 64;
#pragma unroll
        for (int p8 = 0; p8 < 8; ++p8) {
            unsigned short x[8];
#pragma unroll
            for (int j = 0; j < 8; ++j) x[j] = tl[kperm64(p8 * 8 + j) * TS + lane];
            u32x4 o; o.x = x[0] | ((unsigned)x[1] << 16); o.y = x[2] | ((unsigned)x[3] << 16); o.z = x[4] | ((unsigned)x[5] << 16); o.w = x[6] | ((unsigned)x[7] << 16);
            *(u32x4*)(dst + p8 * 8) = o;
        }
        LDS_WAIT();
    }
}

__device__ __forceinline__ float log_sigmoid16(float z) { return (fminf(z, 0.f) - __logf(1.0f + __expf(-fabsf(z)))) * (1.f / 16.f); }
#define GLA_Z(tokv) ({ float z_ = bias; _Pragma("unroll") for (int r_ = 0; r_ < 16; ++r_) z_ += __builtin_bit_cast(float, __builtin_amdgcn_readlane(__builtin_bit_cast(int, al[r_]), (tokv))) * wc[r_]; z_; })
#define GLA_LOAD_GATE() \
    float al[16], wc[16]; \
    { const u32x4* ap_ = (const u32x4*)(HY + (size_t)(tok0 + lane) * HYN + C_AL); const u32x4 a0_ = ap_[0], a1_ = ap_[1]; \
      al[0] = bflo(a0_.x); al[1] = bfhi(a0_.x); al[2] = bflo(a0_.y); al[3] = bfhi(a0_.y); al[4] = bflo(a0_.z); al[5] = bfhi(a0_.z); al[6] = bflo(a0_.w); al[7] = bfhi(a0_.w); \
      al[8] = bflo(a1_.x); al[9] = bfhi(a1_.x); al[10] = bflo(a1_.y); al[11] = bfhi(a1_.y); al[12] = bflo(a1_.z); al[13] = bfhi(a1_.z); al[14] = bflo(a1_.w); al[15] = bfhi(a1_.w); } \
    _Pragma("unroll") for (int r_ = 0; r_ < 16; ++r_) wc[r_] = A->in[I_WA2][(i * 16 + r_) * 256 + h * 64 + lane]; \
    const float bias = A->in[I_BA][i * 256 + h * 64 + lane];

__device__ __forceinline__ void phase_gla_a(KArgs A, int wv_, int i, LAS unsigned char* lds) {
    const int tid_ = opaque_tid(wv_); const int wid = __builtin_amdgcn_readfirstlane(tid_ >> 6), lane = tid_ & 63, fr = lane & 15, fq = lane >> 4; const int gw = blockIdx.x * 8 + wid, NGW = gridDim.x * 8;
    unsigned char* ws = opq(A->ws);
    const bf16* HY = (const bf16*)(ws + WS_BIG); const bf16* VTA = (const bf16*)(ws + WS_VTA); float* SLOC = (float*)(ws + WS_SLOC); float* DEC = (float*)(ws + WS_DEC);
    constexpr int RS = 72;
    LAS bf16* kh = (LAS bf16*)lds + wid * (64 * RS);
    (void)gw;
    for (int it = wid * (int)gridDim.x + (int)blockIdx.x; it < 1024; it += NGW) {
        const int c = it & 31, bh = it >> 5, b = bh >> 2, h = bh & 3; const size_t tok0 = (size_t)b * S + c * 64;
        GLA_LOAD_GATE();
        float bl = 0.f;
#pragma unroll 4
        for (int tk = 0; tk < 64; ++tk) bl += log_sigmoid16(GLA_Z(tk));
        float bc = 0.f;
#pragma unroll 4
        for (int tk = 0; tk < 64; ++tk) {
            bc += log_sigmoid16(GLA_Z(tk));
            const float kv = bf2f(HY[(tok0 + tk) * HYN + C_KB + h * 64 + lane]);
            kh[lane * RS + kpos64(tk)] = (bf16)f2bf(kv * __expf(bl - bc));
        }
        DEC[it * 64 + lane] = __expf(bl);
        LDS_WAIT();
#pragma unroll
        for (int dvh = 0; dvh < 2; ++dvh) {
            const bf16* vt = VTA + ((size_t)((b * 32 + c) * 12 + h * 2 + dvh)) * 4096;
            bf16x8 vf[4][2];
#pragma unroll
            for (int n = 0; n < 4; ++n)
#pragma unroll
                for (int s = 0; s < 2; ++s) vf[n][s] = *(const bf16x8*)(vt + (16 * n + fr) * 64 + 32 * s + 8 * fq);
#pragma unroll
            for (int m = 0; m < 4; ++m) {
                const bf16x8 a0 = *(const LAS bf16x8*)(kh + (16 * m + fr) * RS + 8 * fq), a1 = *(const LAS bf16x8*)(kh + (16 * m + fr) * RS + 32 + 8 * fq);
#pragma unroll
                for (int n = 0; n < 4; ++n) {
                    f32x4 acc = (f32x4){0.f, 0.f, 0.f, 0.f};
                    acc = __builtin_amdgcn_mfma_f32_16x16x32_bf16(a0, vf[n][0], acc, 0, 0, 0);
                    acc = __builtin_amdgcn_mfma_f32_16x16x32_bf16(a1, vf[n][1], acc, 0, 0, 0);
                    float* dst = SLOC + ((size_t)it * 64 + 16 * m + 4 * fq) * 128 + dvh * 64 + 16 * n + fr;
                    dst[0] = acc.x; dst[128] = acc.y; dst[256] = acc.z; dst[384] = acc.w;
                }
            }
        }
        LDS_WAIT();
    }
}
__device__ __forceinline__ void phase_gla_c(KArgs A, int wv_, int i, LAS unsigned char* lds) {
    const int tid_ = opaque_tid(wv_); const int wid = __builtin_amdgcn_readfirstlane(tid_ >> 6), lane = tid_ & 63, fr = lane & 15, fq = lane >> 4; const int gw = blockIdx.x * 8 + wid, NGW = gridDim.x * 8;
    unsigned char* ws = opq(A->ws);
    const bf16* HY = (const bf16*)(ws + WS_BIG); const bf16* VTA = (const bf16*)(ws + WS_VTA); const bf16* STT = (const bf16*)(ws + WS_STT); bf16* CAT = (bf16*)(ws + WS_CAT);
    constexpr int RS = 72;
    LAS bf16* qs = (LAS bf16*)lds + wid * (128 * RS);
    LAS bf16* ks = qs + 64 * RS;
    const float* og = A->in[I_ONORM] + i * 128;
    (void)gw; (void)NGW;
    for (int blk = blockIdx.x; blk < 128; blk += gridDim.x) {
        {
            const float* SLOC = (const float*)(ws + WS_SLOC); const float* DEC = (const float*)(ws + WS_DEC); bf16* STw = (bf16*)(ws + WS_STT);
            const int tid = tid_, dv = tid & 127, ko = tid >> 7, bh = blk >> 2, c0 = (blk & 3) * 8;
            float sv[16];
#pragma unroll
            for (int j = 0; j < 16; ++j) sv[j] = 0.f;
#pragma unroll 2
            for (int c = 0; c < c0 + 8; ++c) {
                const size_t item = (size_t)bh * 32 + c;
                if (c >= c0) {
                    u32x4 o0, o1; o0.x = pk2(sv[0], sv[1]); o0.y = pk2(sv[2], sv[3]); o0.z = pk2(sv[4], sv[5]); o0.w = pk2(sv[6], sv[7]);
                    o1.x = pk2(sv[8], sv[9]); o1.y = pk2(sv[10], sv[11]); o1.z = pk2(sv[12], sv[13]); o1.w = pk2(sv[14], sv[15]);
                    u32x4* d = (u32x4*)(STw + (item * 128 + dv) * 64 + ko * 16); d[0] = o0; d[1] = o1;
                }
                if (c < c0 + 7) {
                    const float* sl = SLOC + (item * 64 + ko * 16) * 128 + dv; const float* dc = DEC + item * 64 + ko * 16;
#pragma unroll
                    for (int j = 0; j < 16; ++j) sv[j] = dc[j] * sv[j] + sl[j * 128];
                }
            }
            asm volatile("s_waitcnt vmcnt(0)" ::: "memory");
            __syncthreads();
        }
        const int it = blk * 8 + wid;
        const int c = it & 31, bh = it >> 5, b = bh >> 2, h = bh & 3; const size_t tok0 = (size_t)b * S + c * 64;
        GLA_LOAD_GATE();
        float bc = 0.f;
#pragma unroll 4
        for (int tk = 0; tk < 64; ++tk) {
            bc += log_sigmoid16(GLA_Z(tk));
            const bf16* row = HY + (tok0 + tk) * HYN;
            const float qv = bf2f(row[C_QB + h * 64 + lane]) * 0.125f, kv = bf2f(row[C_KB + h * 64 + lane]);
            qs[tk * RS + lane] = (bf16)f2bf(qv * __expf(bc)); ks[tk * RS + lane] = (bf16)f2bf(kv * __expf(-bc));
        }
        LDS_WAIT();
        bf16x8 st[8][2];
#pragma unroll
        for (int n = 0; n < 8; ++n)
#pragma unroll
            for (int s = 0; s < 2; ++s) st[n][s] = *(const bf16x8*)(STT + ((size_t)it * 128 + 16 * n + fr) * 64 + 32 * s + 8 * fq);
        const bf16* vt = VTA + ((size_t)((b * 32 + c) * 12 + h * 2)) * 4096;
#pragma unroll
        for (int mi = 0; mi < 4; ++mi) {
            const bf16x8 q0 = *(const LAS bf16x8*)(qs + (16 * mi + fr) * RS + 8 * fq), q1 = *(const LAS bf16x8*)(qs + (16 * mi + fr) * RS + 32 + 8 * fq);
            f32x4 sc[4];
#pragma unroll
            for (int t = 0; t < 4; ++t) {
                sc[t] = (f32x4){0.f, 0.f, 0.f, 0.f};
                if (t <= mi) {
                    const bf16x8 k0 = *(const LAS bf16x8*)(ks + (16 * t + fr) * RS + 8 * fq), k1 = *(const LAS bf16x8*)(ks + (16 * t + fr) * RS + 32 + 8 * fq);
                    sc[t] = __builtin_amdgcn_mfma_f32_16x16x32_bf16(k0, q0, sc[t], 0, 0, 0);
                    sc[t] = __builtin_amdgcn_mfma_f32_16x16x32_bf16(k1, q1, sc[t], 0, 0, 0);
                    if (t == mi) {
                        sc[t].x = (4 * fq + 0 <= fr) ? sc[t].x : 0.f; sc[t].y = (4 * fq + 1 <= fr) ? sc[t].y : 0.f; sc[t].z = (4 * fq + 2 <= fr) ? sc[t].z : 0.f; sc[t].w = (4 * fq + 3 <= fr) ? sc[t].w : 0.f; }
                }
            }
            bf16x8 pf[2];
#pragma unroll
            for (int s = 0; s < 2; ++s) { u32x4 w; w.x = pk2(sc[2 * s].x, sc[2 * s].y); w.y = pk2(sc[2 * s].z, sc[2 * s].w); w.z = pk2(sc[2 * s + 1].x, sc[2 * s + 1].y); w.w = pk2(sc[2 * s + 1].z, sc[2 * s + 1].w);
                pf[s] = __builtin_bit_cast(bf16x8, w); }
            f32x4 o[8]; float ssq = 0.f;
#pragma unroll
            for (int n = 0; n < 8; ++n) {
                o[n] = (f32x4){0.f, 0.f, 0.f, 0.f};
                o[n] = __builtin_amdgcn_mfma_f32_16x16x32_bf16(st[n][0], q0, o[n], 0, 0, 0);
                o[n] = __builtin_amdgcn_mfma_f32_16x16x32_bf16(st[n][1], q1, o[n], 0, 0, 0);
                const bf16* vrow = vt + (size_t)(n >> 2) * 4096 + (16 * (n & 3) + fr) * 64 + 8 * fq;
                o[n] = __builtin_amdgcn_mfma_f32_16x16x32_bf16(*(const bf16x8*)vrow, pf[0], o[n], 0, 0, 0);
                if (mi >= 2) o[n] = __builtin_amdgcn_mfma_f32_16x16x32_bf16(*(const bf16x8*)(vrow + 32), pf[1], o[n], 0, 0, 0);
                ssq += (o[n].x * o[n].x + o[n].y * o[n].y) + (o[n].z * o[n].z + o[n].w * o[n].w);
            }
            ssq += __shfl_xor(ssq, 16); ssq += __shfl_xor(ssq, 32);
            const float rstd = rsqrtf(ssq * (1.f / 128.f) + EPS);
            const size_t tok = tok0 + 16 * mi + fr;
#pragma unroll
            for (int n = 0; n < 8; ++n) {
                const int dv = 16 * n + 4 * fq;
                const u32x2 rw = *(const u32x2*)(HY + tok * HYN + C_RB + h * 128 + dv); const f32x4 g = *(const f32x4*)(og + dv);
                const float r0 = bflo(rw.x), r1 = bfhi(rw.x), r2 = bflo(rw.y), r3 = bfhi(rw.y);
                u32x2 w; w.x = pk2(o[n].x * rstd * g.x * (r0 * sigmoidf_(r0)), o[n].y * rstd * g.y * (r1 * sigmoidf_(r1)));
                w.y = pk2(o[n].z * rstd * g.z * (r2 * sigmoidf_(r2)), o[n].w * rstd * g.w * (r3 * sigmoidf_(r3)));
                *(u32x2*)(CAT + tok * 1024 + 512 + h * 128 + dv) = w;
            }
        }
        LDS_WAIT();
        __syncthreads();
    }
}

__device__ __forceinline__ void phase_sgu_mix(KArgs A, int wv_, int i, LAS unsigned char* lds) {
    const int tid = opaque_tid(wv_), wid = __builtin_amdgcn_readfirstlane(tid >> 6), lane = tid & 63;
    unsigned char* ws = opq(A->ws);
    const bf16* U = (const bf16*)(ws + WS_U); const bf16* V = (const bf16*)(ws + WS_V); bf16* UM = (bf16*)(ws + WS_UM);
    LAS float* vt = (LAS float*)lds;
    LAS float* st = vt + 128 * 256;
    const float* lng = A->in[I_LNG] + i * 2048; const float* lnb = A->in[I_LNB] + i * 2048;
    for (int it = blockIdx.x; it < NBATCH * 16 * 8; it += gridDim.x) {
        const int g = it & 7, n = (it >> 3) & 15, b = it >> 7;
        const size_t tok0 = (size_t)b * S + n * 128;
        __syncthreads();
        for (int s = wid * 16; s < wid * 16 + 16; ++s) {
            const u32x4* vr = (const u32x4*)(V + (tok0 + s) * 2048) + lane;
            float x[32]; float sum = 0.f;
#pragma unroll
            for (int j = 0; j < 4; ++j) { const u32x4 w = vr[64 * j];
                x[8 * j + 0] = bflo(w.x); x[8 * j + 1] = bfhi(w.x); x[8 * j + 2] = bflo(w.y); x[8 * j + 3] = bfhi(w.y); x[8 * j + 4] = bflo(w.z); x[8 * j + 5] = bfhi(w.z); x[8 * j + 6] = bflo(w.w); x[8 * j + 7] = bfhi(w.w); }
#pragma unroll
            for (int j = 0; j < 32; ++j) sum += x[j];
            const float mean = wave_sum(sum) * (1.f / 2048.f); float q = 0.f;
#pragma unroll
            for (int j = 0; j < 32; ++j) { const float d = x[j] - mean; q += d * d; }
            const float rstd = rsqrtf(wave_sum(q) * (1.f / 2048.f) + EPS);
            const u32x2 w = *((const u32x2*)(V + (tok0 + s) * 2048 + g * 256) + lane);
            const f32x4 gg = *(const f32x4*)(lng + g * 256 + 4 * lane), bb = *(const f32x4*)(lnb + g * 256 + 4 * lane);
            f32x4 o; o.x = (bflo(w.x) - mean) * rstd * gg.x + bb.x; o.y = (bfhi(w.x) - mean) * rstd * gg.y + bb.y; o.z = (bflo(w.y) - mean) * rstd * gg.z + bb.z; o.w = (bfhi(w.y) - mean) * rstd * gg.w + bb.w;
            *(LAS f32x4*)(vt + s * 256 + 4 * lane) = o;
            (void)st;
        }
        __syncthreads();
        const int c = tid & 255, th = tid >> 8;
        const float* wsg = A->in[I_SGWS] + (size_t)(i * 8 + g) * 128 * 128; const float* bsg = A->in[I_SGBS] + (i * 8 + g) * 128;
        for (int tt = 0; tt < 64; ++tt) {
            const int t = 2 * tt + th;
            const float* wr = wsg + t * 128;
            float acc = 0.f;
            for (int s = 0; s <= t; ++s) acc += wr[s] * vt[s * 256 + c];
            acc += bsg[t];
            const float u = bf2f(U[(tok0 + t) * 2048 + g * 256 + c]);
            UM[(tok0 + t) * 2048 + g * 256 + c] = (bf16)f2bf(u * acc);
        }
    }
    __syncthreads();
}


__device__ __forceinline__ void phase_sgu_mix_mfma(KArgs A, int wv_, int i, LAS unsigned char* lds) {
    const int tid = opaque_tid(wv_), wid = __builtin_amdgcn_readfirstlane(tid >> 6), lane = tid & 63, fr = lane & 15, fq = lane >> 4;
    unsigned char* ws = opq(A->ws);
    const bf16* U = (const bf16*)(ws + WS_U); const bf16* V = (const bf16*)(ws + WS_V); bf16* UM = (bf16*)(ws + WS_UM);
    const bf16* WSB = (const bf16*)(ws + WS_WSB) + (size_t)i * 8 * 16384; const float* M0 = (const float*)(ws + WS_M0) + i * 8 * 128;
    constexpr int VS = 136;
    LAS bf16* vT = (LAS bf16*)lds;
    LAS float* st = (LAS float*)(lds + 256 * VS * 2);
    const float* lng = A->in[I_LNG] + i * 2048; const float* lnb = A->in[I_LNB] + i * 2048; const float* bsg = A->in[I_SGBS] + i * 8 * 128;
    for (int it = blockIdx.x; it < 256; it += gridDim.x) {
        const int gh = it & 1, n_ = (it >> 1) & 15, b = it >> 5; const size_t tok0 = (size_t)b * S + n_ * 128;
        __syncthreads();
        for (int s = wid * 16; s < wid * 16 + 16; ++s) {
            const u32x4* vr = (const u32x4*)(V + (tok0 + s) * 2048) + lane;
            float x[32]; float sum = 0.f;
#pragma unroll
            for (int j = 0; j < 4; ++j) { const u32x4 w = vr[64 * j];
                x[8 * j + 0] = bflo(w.x); x[8 * j + 1] = bfhi(w.x); x[8 * j + 2] = bflo(w.y); x[8 * j + 3] = bfhi(w.y); x[8 * j + 4] = bflo(w.z); x[8 * j + 5] = bfhi(w.z); x[8 * j + 6] = bflo(w.w); x[8 * j + 7] = bfhi(w.w); }
#pragma unroll
            for (int j = 0; j < 32; ++j) sum += x[j];
            const float mean = wave_sum(sum) * (1.f / 2048.f); float q = 0.f;
#pragma unroll
            for (int j = 0; j < 32; ++j) { const float d = x[j] - mean; q += d * d; }
            const float rstd = rsqrtf(wave_sum(q) * (1.f / 2048.f) + EPS);
            if (lane == 0) { st[2 * s] = mean; st[2 * s + 1] = rstd; }
        }
#pragma unroll 1
        for (int gg = 0; gg < 4; ++gg) {
            const int g = gh * 4 + gg;
            __syncthreads();
            {
                const int s = tid & 127, cq = tid >> 7;
                const float mean = st[2 * s], rstd = st[2 * s + 1];
                const u32x4* src = (const u32x4*)(V + (tok0 + s) * 2048 + g * 256 + cq * 64);
#pragma unroll
                for (int i8 = 0; i8 < 8; ++i8) {
                    const u32x4 w = src[i8];
                    LAS bf16* d = vT + (cq * 64 + i8 * 8) * VS + s;
                    d[0 * VS] = (bf16)f2bf((bflo(w.x) - mean) * rstd); d[1 * VS] = (bf16)f2bf((bfhi(w.x) - mean) * rstd); d[2 * VS] = (bf16)f2bf((bflo(w.y) - mean) * rstd); d[3 * VS] = (bf16)f2bf((bfhi(w.y) - mean) * rstd);
                    d[4 * VS] = (bf16)f2bf((bflo(w.z) - mean) * rstd); d[5 * VS] = (bf16)f2bf((bfhi(w.z) - mean) * rstd); d[6 * VS] = (bf16)f2bf((bflo(w.w) - mean) * rstd); d[7 * VS] = (bf16)f2bf((bfhi(w.w) - mean) * rstd);
                }
            }
            __syncthreads();
            bf16x8 vf[2][4];
#pragma unroll
            for (int m = 0; m < 2; ++m)
#pragma unroll
                for (int k = 0; k < 4; ++k) vf[m][k] = *(const LAS bf16x8*)(vT + (32 * wid + 16 * m + fr) * VS + 32 * k + 8 * fq);
            const bf16* wb = WSB + ((size_t)g * 128 + fr) * 128 + 8 * fq;
            f32x4 gc[2], bc[2];
#pragma unroll
            for (int m = 0; m < 2; ++m) { gc[m] = *(const f32x4*)(lng + g * 256 + 32 * wid + 16 * m + 4 * fq); bc[m] = *(const f32x4*)(lnb + g * 256 + 32 * wid + 16 * m + 4 * fq); }
#pragma unroll
            for (int n = 0; n < 8; ++n) {
                f32x4 a0 = (f32x4){0.f, 0.f, 0.f, 0.f}, a1 = (f32x4){0.f, 0.f, 0.f, 0.f};
                asm volatile("" : "+v"(wb));
#pragma unroll
                for (int k = 0; k < 4; ++k) if (k <= (n >> 1)) {
                    const bf16x8 wf = *(const bf16x8*)(wb + 32 * k);
                    a0 = __builtin_amdgcn_mfma_f32_16x16x32_bf16(vf[0][k], wf, a0, 0, 0, 0);
                    a1 = __builtin_amdgcn_mfma_f32_16x16x32_bf16(vf[1][k], wf, a1, 0, 0, 0); }
                wb += 16 * 128;
                const int t = 16 * n + fr; const float m0 = M0[g * 128 + t], bsv = bsg[g * 128 + t];
                const size_t ro = (tok0 + t) * 2048 + g * 256 + 32 * wid + 4 * fq;
#pragma unroll
                for (int m = 0; m < 2; ++m) {
                    const f32x4 a = m ? a1 : a0;
                    const u32x2 uw = *(const u32x2*)(U + ro + 16 * m);
                    u32x2 w; w.x = pk2((a.x * gc[m].x + bc[m].x * m0 + bsv) * bflo(uw.x), (a.y * gc[m].y + bc[m].y * m0 + bsv) * bfhi(uw.x));
                    w.y = pk2((a.z * gc[m].z + bc[m].z * m0 + bsv) * bflo(uw.y), (a.w * gc[m].w + bc[m].w * m0 + bsv) * bfhi(uw.y));
                    *(u32x2*)(UM + ro + 16 * m) = w;
                }
                asm volatile("" ::: "memory");
            }
        }
    }
    __syncthreads();
}

__device__ __forceinline__ void phase_rownorm(KArgs A, int wv_) {
    const int tid_ = opaque_tid(wv_); const int wid = __builtin_amdgcn_readfirstlane(tid_ >> 6), lane = tid_ & 63; const int gw = blockIdx.x * 8 + wid, NGW = gridDim.x * 8;
    for (int m = gw; m < T; m += NGW) rms_row_to_bf16(A->out + (size_t)m * D, (bf16*)(opq(A->ws) + WS_XN) + (size_t)m * D, nullptr, lane);
}

__device__ __forceinline__ void phase_xattn(KArgs A, int wv_, int L, LAS unsigned char* lds) {
    const int tid = opaque_tid(wv_), wid = __builtin_amdgcn_readfirstlane(tid >> 6), lane = tid & 63;
    unsigned char* ws = opq(A->ws);
    const bf16* QX = (const bf16*)(ws + WS_QX); const bf16* KV = (const bf16*)(ws + WS_KV); bf16* OX = (bf16*)(ws + WS_OX);
    constexpr int KSTR = 129;
    LAS unsigned* kl = (LAS unsigned*)lds;
    LAS float* qb = (LAS float*)(lds + 132096) + wid * 256;
    LAS float* pb = (LAS float*)(lds + 132096 + 8192) + wid * 256;
    const float* qg = A->in[I_XQN] + L * 256;
    for (int it = blockIdx.x; it < NBATCH * 4 * 8; it += gridDim.x) {
        const int qc = it & 7, h = (it >> 3) & 3, b = it >> 5;
        __syncthreads();
        for (int e = tid; e < 256 * 128; e += 512) { const int m = e >> 7, dw = e & 127;
            kl[m * KSTR + dw] = *((const unsigned*)(KV + (size_t)(b * 256 + m) * 8192 + L * 2048 + h * 256) + dw); }
        __syncthreads();
        const bf16* Vb = KV + (size_t)(b * 256) * 8192 + L * 2048 + 1024 + h * 256;
        for (int tq = 0; tq < 32; ++tq) {
            const size_t tok = (size_t)b * S + qc * 256 + wid * 32 + tq;
            const u32x2 qw = *((const u32x2*)(QX + tok * 1024 + h * 256) + lane);
            const float q0 = bflo(qw.x), q1 = bfhi(qw.x), q2 = bflo(qw.y), q3 = bfhi(qw.y);
            const float rstd = rsqrtf(wave_sum(q0 * q0 + q1 * q1 + q2 * q2 + q3 * q3) * (1.f / 256.f) + EPS);
            const f32x4 gg = *(const f32x4*)(qg + 4 * lane);
            *(LAS f32x4*)(qb + 4 * lane) = (f32x4){q0 * rstd * gg.x, q1 * rstd * gg.y, q2 * rstd * gg.z, q3 * rstd * gg.w};
            LDS_WAIT();
            float s0 = 0.f, s1 = 0.f, s2 = 0.f, s3 = 0.f;
#pragma unroll 4
            for (int dw = 0; dw < 128; ++dw) {
                const f32x2 qq = *(const LAS f32x2*)(qb + 2 * dw);
                const unsigned k0 = kl[lane * KSTR + dw], k1 = kl[(lane + 64) * KSTR + dw], k2 = kl[(lane + 128) * KSTR + dw], k3 = kl[(lane + 192) * KSTR + dw];
                s0 += qq.x * bflo(k0) + qq.y * bfhi(k0); s1 += qq.x * bflo(k1) + qq.y * bfhi(k1);
                s2 += qq.x * bflo(k2) + qq.y * bfhi(k2); s3 += qq.x * bflo(k3) + qq.y * bfhi(k3);
            }
            const float mx = wave_max(fmaxf(fmaxf(s0, s1), fmaxf(s2, s3)));
            const float e0 = __expf(s0 - mx), e1 = __expf(s1 - mx), e2 = __expf(s2 - mx), e3 = __expf(s3 - mx);
            const float inv = 1.f / wave_sum((e0 + e1) + (e2 + e3));
            pb[lane] = e0 * inv; pb[lane + 64] = e1 * inv; pb[lane + 128] = e2 * inv; pb[lane + 192] = e3 * inv;
            LDS_WAIT();
            float o0 = 0.f, o1 = 0.f, o2 = 0.f, o3 = 0.f;
#pragma unroll 8
            for (int m = 0; m < 256; ++m) {
                const float p = pb[m];
                const u32x2 vw = *((const u32x2*)(Vb + (size_t)m * 8192) + lane);
                o0 += p * bflo(vw.x); o1 += p * bfhi(vw.x); o2 += p * bflo(vw.y); o3 += p * bfhi(vw.y);
            }
            u32x2 ow; ow.x = pk2(o0, o1); ow.y = pk2(o2, o3);
            *((u32x2*)(OX + tok * 1024 + h * 256) + lane) = ow;
            LDS_WAIT();
        }
    }
    __syncthreads();
}


__device__ __forceinline__ int kperm32(int p) { const int fq = (p >> 3) & 3, j = p & 7; return (p & ~31) + 16 * (j >> 2) + 4 * fq + (j & 3); }
__device__ __forceinline__ void phase_vtrans(KArgs A, int wv_, LAS unsigned char* lds) {
    const int tid = opaque_tid(wv_);
    unsigned char* ws = opq(A->ws);
    const bf16* KV = (const bf16*)(ws + WS_KV); bf16* VT = (bf16*)(ws + WS_VT);
    LAS bf16* vt = (LAS bf16*)lds;
    constexpr int VS = 258;
    for (int it = blockIdx.x; it < DEPTH * NBATCH * 4; it += gridDim.x) {
        const int h = it & 3, b = (it >> 2) & 7, l = it >> 5;
        __syncthreads();
        for (int e = tid; e < 256 * 32; e += 512) { const int m = e >> 5, c8 = e & 31;
            const u32x4 w = *(const u32x4*)(KV + (size_t)(b * 256 + m) * 8192 + l * 2048 + 1024 + h * 256 + c8 * 8);
            LAS unsigned* d = (LAS unsigned*)(vt + m * VS + c8 * 8); d[0] = w.x; d[1] = w.y; d[2] = w.z; d[3] = w.w; }
        __syncthreads();
        for (int e = tid; e < 256 * 32; e += 512) { const int dv = e & 255, p8 = e >> 8;
            unsigned short x[8];
#pragma unroll
            for (int j = 0; j < 8; ++j) x[j] = vt[kperm32(p8 * 8 + j) * VS + dv];
            u32x4 o; o.x = x[0] | ((unsigned)x[1] << 16); o.y = x[2] | ((unsigned)x[3] << 16); o.z = x[4] | ((unsigned)x[5] << 16); o.w = x[6] | ((unsigned)x[7] << 16);
            *(u32x4*)(VT + ((size_t)it * 256 + dv) * 256 + p8 * 8) = o; }
    }
    __syncthreads();
}

__device__ __forceinline__ void phase_xattn_mfma(KArgs A, int wv_, int L, LAS unsigned char* lds) {
    const int tid = opaque_tid(wv_), wid = __builtin_amdgcn_readfirstlane(tid >> 6), lane = tid & 63, fr = lane & 15, fq = lane >> 4;
    unsigned char* ws = opq(A->ws);
    const bf16* QX = (const bf16*)(ws + WS_QX); const bf16* KV = (const bf16*)(ws + WS_KV); const bf16* VT = (const bf16*)(ws + WS_VT); bf16* OX = (bf16*)(ws + WS_OX);
    constexpr int RS = 264;
    LAS bf16* kl = (LAS bf16*)lds;
    const float* qg = A->in[I_XQN] + L * 256;
    for (int it = blockIdx.x; it < NBATCH * 4 * 16; it += gridDim.x) {
        const int qt = it & 15, h = (it >> 4) & 3, b = it >> 6;
        __syncthreads();
        {
            const int row = tid >> 1, hf = tid & 1;
            const u32x4* src = (const u32x4*)(KV + (size_t)(b * 256 + row) * 8192 + L * 2048 + h * 256 + hf * 128);
#pragma unroll
            for (int i0 = 0; i0 < 16; i0 += 8) {
                u32x4 w[8];
#pragma unroll
                for (int i = 0; i < 8; ++i) w[i] = src[i0 + i];
#pragma unroll
                for (int i = 0; i < 8; ++i) *(LAS u32x4*)(kl + row * RS + hf * 128 + (i0 + i) * 8) = w[i];
            }
        }
        const size_t tok = (size_t)b * S + qt * 128 + wid * 16 + fr;
        bf16x8 qf[8];
        {
            u32x4 qw[8]; float ssq = 0.f;
#pragma unroll
            for (int s = 0; s < 8; ++s) qw[s] = *(const u32x4*)(QX + tok * 1024 + h * 256 + 32 * s + 8 * fq);
#pragma unroll
            for (int s = 0; s < 8; ++s) {
                const float a0 = bflo(qw[s].x), a1 = bfhi(qw[s].x), a2 = bflo(qw[s].y), a3 = bfhi(qw[s].y), a4 = bflo(qw[s].z), a5 = bfhi(qw[s].z), a6 = bflo(qw[s].w), a7 = bfhi(qw[s].w);
                ssq += (a0 * a0 + a1 * a1) + (a2 * a2 + a3 * a3) + (a4 * a4 + a5 * a5) + (a6 * a6 + a7 * a7);
            }
            ssq += __shfl_xor(ssq, 16); ssq += __shfl_xor(ssq, 32);
            const float rstd = rsqrtf(ssq * (1.f / 256.f) + EPS);
#pragma unroll
            for (int s = 0; s < 8; ++s) {
                const f32x4 ga = *(const f32x4*)(qg + 32 * s + 8 * fq), gb = *(const f32x4*)(qg + 32 * s + 8 * fq + 4);
                u32x4 w; w.x = pk2(bflo(qw[s].x) * rstd * ga.x, bfhi(qw[s].x) * rstd * ga.y); w.y = pk2(bflo(qw[s].y) * rstd * ga.z, bfhi(qw[s].y) * rstd * ga.w);
                w.z = pk2(bflo(qw[s].z) * rstd * gb.x, bfhi(qw[s].z) * rstd * gb.y); w.w = pk2(bflo(qw[s].w) * rstd * gb.z, bfhi(qw[s].w) * rstd * gb.w);
                qf[s] = __builtin_bit_cast(bf16x8, w);
            }
        }
        __syncthreads();
        f32x4 sc[16];
#pragma unroll
        for (int hf = 0; hf < 2; ++hf) {
            unsigned kb = (unsigned)(size_t)(kl + (128 * hf + fr) * RS + 8 * fq); asm volatile("" : "+v"(kb));
#pragma unroll
            for (int t8 = 0; t8 < 8; ++t8) { const int t = 8 * hf + t8; sc[t] = (f32x4){0.f, 0.f, 0.f, 0.f};
#pragma unroll
                for (int s = 0; s < 8; ++s) { const bf16x8 kf = *(const LAS bf16x8*)(size_t)(kb + (unsigned)((16 * t8 * RS + 32 * s) * 2));
                    sc[t] = __builtin_amdgcn_mfma_f32_16x16x32_bf16(kf, qf[s], sc[t], 0, 0, 0); }
                if (t & 1) asm volatile("" ::: "memory"); }
        }
        float mx = -INFINITY;
#pragma unroll
        for (int t = 0; t < 16; ++t) mx = fmaxf(mx, fmaxf(fmaxf(sc[t].x, sc[t].y), fmaxf(sc[t].z, sc[t].w)));
        mx = fmaxf(mx, __shfl_xor(mx, 16)); mx = fmaxf(mx, __shfl_xor(mx, 32));
        float lsum = 0.f;
#pragma unroll
        for (int t = 0; t < 16; ++t) { sc[t].x = __expf(sc[t].x - mx); sc[t].y = __expf(sc[t].y - mx); sc[t].z = __expf(sc[t].z - mx); sc[t].w = __expf(sc[t].w - mx); lsum += (sc[t].x + sc[t].y) + (sc[t].z + sc[t].w); }
        lsum += __shfl_xor(lsum, 16); lsum += __shfl_xor(lsum, 32);
        const float inv = 1.f / lsum;
        bf16x8 pf[8];
#pragma unroll
        for (int s = 0; s < 8; ++s) { u32x4 w; w.x = pk2(sc[2 * s].x, sc[2 * s].y); w.y = pk2(sc[2 * s].z, sc[2 * s].w); w.z = pk2(sc[2 * s + 1].x, sc[2 * s + 1].y); w.w = pk2(sc[2 * s + 1].z, sc[2 * s + 1].w);
            pf[s] = __builtin_bit_cast(bf16x8, w); }
        __syncthreads();
        {
            const int row = tid >> 1, hf = tid & 1;
            const u32x4* src = (const u32x4*)(VT + ((size_t)((L * 8 + b) * 4 + h) * 256 + row) * 256 + hf * 128);
#pragma unroll
            for (int i0 = 0; i0 < 16; i0 += 8) {
                u32x4 w[8];
#pragma unroll
                for (int i = 0; i < 8; ++i) w[i] = src[i0 + i];
#pragma unroll
                for (int i = 0; i < 8; ++i) *(LAS u32x4*)(kl + row * RS + hf * 128 + (i0 + i) * 8) = w[i];
            }
        }
        __syncthreads();
#pragma unroll
        for (int hf = 0; hf < 2; ++hf) {
            unsigned vb = (unsigned)(size_t)(kl + (128 * hf + fr) * RS + 8 * fq); asm volatile("" : "+v"(vb));
#pragma unroll
            for (int n8 = 0; n8 < 8; ++n8) { const int n = 8 * hf + n8; f32x4 o = (f32x4){0.f, 0.f, 0.f, 0.f};
#pragma unroll
                for (int s = 0; s < 8; ++s) { const bf16x8 vf = *(const LAS bf16x8*)(size_t)(vb + (unsigned)((16 * n8 * RS + 32 * s) * 2));
                    o = __builtin_amdgcn_mfma_f32_16x16x32_bf16(vf, pf[s], o, 0, 0, 0); }
                u32x2 w; w.x = pk2(o.x * inv, o.y * inv); w.y = pk2(o.z * inv, o.w * inv);
                *(u32x2*)(OX + tok * 1024 + h * 256 + 16 * n + 4 * fq) = w;
                if (n & 1) asm volatile("" ::: "memory"); }
        }
    }
    __syncthreads();
}

__device__ __forceinline__ void phase_route(KArgs A, int wv_, int L) {
    const int tid_ = opaque_tid(wv_); const int wid = __builtin_amdgcn_readfirstlane(tid_ >> 6), lane = tid_ & 63; const int gw = blockIdx.x * 8 + wid, NGW = gridDim.x * 8;
    unsigned char* ws = opq(A->ws);
    const float* RW = (const float*)(ws + WS_RW) + (size_t)L * NEXP * D; const float* rb = A->in[I_RB];
    unsigned* cnt = (unsigned*)(ws + WS_CTL) + CW_CNT + L * 64;
    int* list = (int*)(ws + WS_LIST); int* te = (int*)(ws + WS_TOK); int* tp = te + 2 * T; float* tw = (float*)(tp + 2 * T);
    bf16* XN = (bf16*)(ws + WS_XN);
    for (int t = gw; t < T; t += NGW) {
        const f32x4* xr = (const f32x4*)(A->out + (size_t)t * D) + lane;
        f32x4 v[4]; float s = 0.f;
#pragma unroll
        for (int j = 0; j < 4; ++j) { v[j] = xr[64 * j]; s += (v[j].x * v[j].x + v[j].y * v[j].y) + (v[j].z * v[j].z + v[j].w * v[j].w); }
        const float rstd = rsqrtf(wave_sum(s) * (1.f / 1024.f) + EPS);
        u32x2* o8 = (u32x2*)(XN + (size_t)t * D) + lane;
#pragma unroll
        for (int j = 0; j < 4; ++j) { u32x2 w; w.x = pk2(v[j].x * rstd, v[j].y * rstd); w.y = pk2(v[j].z * rstd, v[j].w * rstd); o8[64 * j] = w; }
        float mylg = -INFINITY;
#pragma unroll 2
        for (int e = 0; e < 16; ++e) {
            const f32x4* wr = (const f32x4*)(RW + e * D) + lane; float a = 0.f;
#pragma unroll
            for (int j = 0; j < 4; ++j) { const f32x4 w = wr[64 * j]; a += (v[j].x * w.x + v[j].y * w.y) + (v[j].z * w.z + v[j].w * w.w); }
            const float val = wave_sum(a) * rstd + rb[e];
            mylg = lane == e ? val : mylg;
        }
        const float v0 = wave_max(mylg);
        const int e0 = __ffsll((unsigned long long)__ballot(mylg == v0)) - 1;
        const int gidx = e0 >> 2;
        const float m2 = ((lane >> 2) == gidx && lane != e0 && lane < 16) ? mylg : -INFINITY;
        const float v1 = wave_max(m2);
        const int e1 = __ffsll((unsigned long long)__ballot(m2 == v1 && (lane >> 2) == gidx && lane != e0 && lane < 16)) - 1;
        const float w0 = 1.f / (1.f + __expf(v1 - v0)), w1 = 1.f - w0;
        if (lane == 0) {
            const unsigned p0 = atomicAdd(&cnt[e0], 1u), p1 = atomicAdd(&cnt[e1], 1u);
            list[e0 * T + p0] = t; list[e1 * T + p1] = t;
            te[2 * t] = e0; te[2 * t + 1] = e1; tp[2 * t] = (int)p0; tp[2 * t + 1] = (int)p1; tw[2 * t] = w0; tw[2 * t + 1] = w1;
        }
    }
}
__device__ __forceinline__ void moe_offsets(KArgs A, int wv_, int L, LAS int* off, LAS int* cn) {
    if (opaque_tid(wv_) == 0) {
        const unsigned* cnt = (const unsigned*)(opq(A->ws) + WS_CTL) + CW_CNT + L * 64;
        int o = 0;
        for (int e = 0; e < 16; ++e) { const int c = (int)__hip_atomic_load(cnt + e, __ATOMIC_RELAXED, __HIP_MEMORY_SCOPE_AGENT); off[e] = o; cn[e] = c; o += (c + 255) & ~255; }
        off[16] = o;
    }
    __syncthreads();
}
__device__ __forceinline__ void phase_moe_combine(KArgs A, int wv_, int L, LAS unsigned char* lds) {
    LAS int* off = (LAS int*)lds; LAS int* cn = off + 32;
    moe_offsets(A, wv_, L, off, cn);
    const int tid_ = opaque_tid(wv_); const int wid = __builtin_amdgcn_readfirstlane(tid_ >> 6), lane = tid_ & 63; const int gw = blockIdx.x * 8 + wid, NGW = gridDim.x * 8;
    unsigned char* ws = opq(A->ws);
    const int* te = (const int*)(ws + WS_TOK); const int* tp = te + 2 * T; const float* tw = (const float*)(tp + 2 * T);
    const bf16* Y = (const bf16*)(ws + WS_Y); bf16* XN = (bf16*)(ws + WS_XN);
    for (int t = gw; t < T; t += NGW) {
        const int sl0 = off[te[2 * t]] + tp[2 * t], sl1 = off[te[2 * t + 1]] + tp[2 * t + 1];
        const float w0 = tw[2 * t], w1 = tw[2 * t + 1];
        f32x4* xr = (f32x4*)(A->out + (size_t)t * D) + lane;
        const u32x2* y0 = (const u32x2*)(Y + (size_t)sl0 * D) + lane; const u32x2* y1 = (const u32x2*)(Y + (size_t)sl1 * D) + lane;
        f32x4 v[4]; float s = 0.f;
#pragma unroll
        for (int j = 0; j < 4; ++j) {
            v[j] = xr[64 * j]; const u32x2 a = y0[64 * j], c = y1[64 * j];
            v[j].x += w0 * bflo(a.x) + w1 * bflo(c.x); v[j].y += w0 * bfhi(a.x) + w1 * bfhi(c.x); v[j].z += w0 * bflo(a.y) + w1 * bflo(c.y); v[j].w += w0 * bfhi(a.y) + w1 * bfhi(c.y);
            xr[64 * j] = v[j];
            s += (v[j].x * v[j].x + v[j].y * v[j].y) + (v[j].z * v[j].z + v[j].w * v[j].w);
        }
        const float rstd = rsqrtf(wave_sum(s) * (1.f / 1024.f) + EPS);
        u32x2* o8 = (u32x2*)(XN + (size_t)t * D) + lane;
#pragma unroll
        for (int j = 0; j < 4; ++j) { u32x2 w; w.x = pk2(v[j].x * rstd, v[j].y * rstd); w.y = pk2(v[j].z * rstd, v[j].w * rstd); o8[64 * j] = w; }
    }
}

constexpr int PH_PER_EVEN = 5 + 8, PH_PER_ODD = 3 + 8;
constexpr int NPHASES = 3 + 2 * (PH_PER_EVEN + PH_PER_ODD);

__global__ void __launch_bounds__(512, 2) mk_fwd(Args Araw) {
    KArgs A0 = kargs();
    extern __shared__ __attribute__((aligned(16))) unsigned char lds_raw[];
    LAS unsigned char* lds = (LAS unsigned char*)lds_raw;
    volatile LAS unsigned* misc = (volatile LAS unsigned*)(lds + LDS_MISC);
    const int tid = threadIdx.x;
    if (tid < 16) misc[tid] = 0u;
    __syncthreads();
    const int lo = A0->ph_lo, hi = A0->ph_hi;
    const int wv_ = __builtin_amdgcn_readfirstlane(threadIdx.x >> 6);
    if (hi - lo > 1) (void)xcd_barrier_post((unsigned*)(A0->ws + WS_CTL) + CW_BAR, misc);
    int ph = 0;
#define PH_BEGIN(k) if (ph >= lo && ph < hi) { KArgs A = kargs(); unsigned char* ws = opq(A->ws); _Pragma("unroll 1") for (int rep_ = 0; rep_ < (((PROBE_MASK >> (k)) & 1) ? PROBE_REPS : 1); ++rep_)
#define PH_END   if (ph + 1 < hi) { XcdBarrier b_; b_.bar = (unsigned*)(opq(kargs()->ws) + WS_CTL) + CW_BAR; b_.x = xb_xcc_id(); b_.st = misc; xcd_barrier(b_, opaque_tid(wv_) == 0); } } ++ph;
    const int G = gridDim.x, cb = blockIdx.x;

    PH_BEGIN(0) phase_prologue(A, wv_, lds); PH_END
    PH_BEGIN(1) {
        pg8::DenseOrder S; S.init(NBATCH * NMEM, 8192, D, (const bf16*)(ws + WS_WKV), G, cb);
        pg8::EpiBf16<0> E{(bf16*)(ws + WS_KV), 8192, 32, 0};
        pg8::gemm_phase(lds, (const bf16*)(ws + WS_MN), D, S, E, wv_);
    } PH_END
    PH_BEGIN(2) { phase_knorm(A, wv_); phase_vtrans(A, wv_, lds); } PH_END

    for (int L = 0; L < DEPTH; ++L) {
        const int i = L >> 1;
        if ((L & 1) == 0) {
            PH_BEGIN(3) {
                pg8::DenseOrder S; S.init(T, HYN, D, (const bf16*)(ws + WS_WHYB) + (size_t)i * HYN * D, G, cb);
                pg8::EpiBf16<0> E{(bf16*)(ws + WS_BIG), HYN, 12, 0};
                pg8::gemm_phase(lds, (const bf16*)(ws + WS_XN), D, S, E, wv_);
            } PH_END
            PH_BEGIN(4) { phase_nsa_prep(A, wv_, i, lds); phase_vtiles(A, wv_, lds); } PH_END
            PH_BEGIN(5) { phase_gla_a(A, wv_, i, lds); __syncthreads(); phase_nsa_attn_mfma(A, wv_, i, lds); } PH_END
            PH_BEGIN(6) phase_gla_c(A, wv_, i, lds); PH_END
            PH_BEGIN(7) {
                pg8::DenseOrder S; S.init(T, D, D, (const bf16*)(ws + WS_WHOUT) + (size_t)i * D * D, G, cb);
                pg8::EpiResAdd E{A->out, D};
                pg8::gemm_phase(lds, (const bf16*)(ws + WS_CAT), D, S, E, wv_);
            } PH_END
        } else {
            PH_BEGIN(8) {
                pg8::DenseOrder S; S.init(T, 4096, D, (const bf16*)(ws + WS_WSGIN) + (size_t)i * 4096 * D, G, cb);
                pg8::EpiBf16<1> E{(bf16*)(ws + WS_U), 2048, 8, (size_t)(WS_V - WS_U) / 2};
                pg8::gemm_phase(lds, (const bf16*)(ws + WS_XN), D, S, E, wv_);
            } PH_END
            PH_BEGIN(9) phase_sgu_mix_mfma(A, wv_, i, lds); PH_END
            PH_BEGIN(10) {
                pg8::DenseOrder S; S.init(T, D, 2048, (const bf16*)(ws + WS_WSGOUT) + (size_t)i * D * 2048, G, cb);
                pg8::EpiResAdd E{A->out, D};
                pg8::gemm_phase(lds, (const bf16*)(ws + WS_UM), 2048, S, E, wv_);
            } PH_END
        }
        PH_BEGIN(11) phase_rownorm(A, wv_); PH_END
        PH_BEGIN(12) {
            pg8::DenseOrder S; S.init(T, D, D, (const bf16*)(ws + WS_WQ) + (size_t)L * D * D, G, cb);
            pg8::EpiBf16<0> E{(bf16*)(ws + WS_QX), D, 4, 0};
            pg8::gemm_phase(lds, (const bf16*)(ws + WS_XN), D, S, E, wv_);
        } PH_END
        PH_BEGIN(13) phase_xattn_mfma(A, wv_, L, lds); PH_END
        PH_BEGIN(14) {
            pg8::DenseOrder S; S.init(T, D, D, (const bf16*)(ws + WS_WO) + (size_t)L * D * D, G, cb);
            pg8::EpiResAdd E{A->out, D};
            pg8::gemm_phase(lds, (const bf16*)(ws + WS_OX), D, S, E, wv_);
        } PH_END
        PH_BEGIN(15) phase_route(A, wv_, L); PH_END
        PH_BEGIN(16) {
            LAS int* off = (LAS int*)(lds + pg8::STAGE_BYTES); LAS int* cn = off + 32;
            moe_offsets(A, wv_, L, off, cn);
            pg8::MoeOrder<true> S{(off[16] / 256) * 3, 3, G, cb, D, off, cn, (const int*)(ws + WS_LIST), (const char*)(ws + WS_WMIN) + (size_t)L * 16 * 768 * D * 2, (size_t)768 * D * 2};
            pg8::EpiSwiglu E{(bf16*)(ws + WS_H), DEXP};
            pg8::gemm_phase(lds, (const bf16*)(ws + WS_XN), D, S, E, wv_);
        } PH_END
        PH_BEGIN(17) {
            LAS int* off = (LAS int*)(lds + pg8::STAGE_BYTES); LAS int* cn = off + 32;
            moe_offsets(A, wv_, L, off, cn);
            pg8::MoeOrder<false> S{(off[16] / 256) * 4, 4, G, cb, DEXP, off, cn, (const int*)(ws + WS_LIST), (const char*)(ws + WS_WMOUT) + (size_t)L * 16 * D * DEXP * 2, (size_t)D * DEXP * 2};
            pg8::EpiBf16<0> E{(bf16*)(ws + WS_Y), D, 4, 0};
            pg8::gemm_phase(lds, (const bf16*)(ws + WS_H), DEXP, S, E, wv_);
        } PH_END
        PH_BEGIN(18) phase_moe_combine(A, wv_, L, lds); PH_END
    }
#undef PH_BEGIN
#undef PH_END
}

extern "C" void kernel_launch(void* const* d_in, const int* in_sizes, int n_in, void* d_out, int out_size, void* d_ws, size_t ws_size, hipStream_t stream) {
    static int grid = 0;
    if (grid == 0) {
        if (n_in != N_IN || out_size != T * D || ws_size < WS_END) { fprintf(stderr, "kernel_launch: unexpected problem (n_in %d, out %d, ws %zu)\n", n_in, out_size, ws_size); grid = -1; return; }
        int dev = 0, cus = 0, per_cu = 0;
        if (hipGetDevice(&dev) != hipSuccess || hipDeviceGetAttribute(&cus, hipDeviceAttributeMultiprocessorCount, dev) != hipSuccess) { grid = -1; return; }
        if (hipFuncSetAttribute((const void*)mk_fwd, hipFuncAttributeMaxDynamicSharedMemorySize, LDS_BYTES) != hipSuccess) { fprintf(stderr, "kernel_launch: hipFuncSetAttribute failed\n"); grid = -1; return; }
        if (hipOccupancyMaxActiveBlocksPerMultiprocessor(&per_cu, (const void*)mk_fwd, 512, LDS_BYTES) != hipSuccess || per_cu < 1) fprintf(stderr, "kernel_launch: occupancy query says %d\n", per_cu);
        (void)hipGetLastError();
        grid = cus;
    }
    if (grid < 0) return;
    (void)hipMemsetAsync((char*)d_ws + WS_CTL, 0, CTL_BYTES, stream);
    Args a{};
    for (int i = 0; i < N_IN; ++i) a.in[i] = (const float*)d_in[i];
    a.out = (float*)d_out; a.ws = (unsigned char*)d_ws;
    for (int j = 0; j < 32; ++j) a.freq[j] = (float)pow(10000.0, -(double)j / 32.0);
#if MK_ONE_LAUNCH
    a.ph_lo = 0; a.ph_hi = NPHASES;
    hipLaunchKernelGGL(mk_fwd, dim3(grid), dim3(512), LDS_BYTES, stream, a);
#else
    for (int p = 0; p < NPHASES; ++p) { a.ph_lo = p; a.ph_hi = p + 1; hipLaunchKernelGGL(mk_fwd, dim3(grid), dim3(512), LDS_BYTES, stream, a); }
#endif
}
```

```cpp
#include <hip/hip_runtime.h>
#include <stdint.h>
#include <stdio.h>
#include <math.h>

#ifndef PROBE_MASK
#define PROBE_MASK 0
#endif
#ifndef PROBE_TMASK
#define PROBE_TMASK 0
#endif
#ifndef PROBE_REPS
#define PROBE_REPS 2
#endif
#ifndef MK_ONE_LAUNCH
#define MK_ONE_LAUNCH 1
#endif

#define LAS __attribute__((address_space(3)))
typedef unsigned short bf16;
typedef short bf16x8 __attribute__((ext_vector_type(8)));
typedef float f32x4 __attribute__((ext_vector_type(4)));
typedef float f32x2 __attribute__((ext_vector_type(2)));
typedef unsigned u32x4 __attribute__((ext_vector_type(4)));
typedef unsigned u32x2 __attribute__((ext_vector_type(2)));

constexpr int T = 16384, D = 1024, NBATCH = 8, S = 2048, DEPTH = 4;
constexpr int NMEM = 256;
constexpr float EPS = 1e-6f;
constexpr int HYN = 3072, HYSRC = 2856;
constexpr int C_QA = 0, C_KC = 512, C_VC = 640, C_KS = 768, C_VS = 896, C_KW = 1024, C_VW = 1152, C_QB = 1280, C_KB = 1536, C_VB = 1792, C_RB = 2304, C_GA = 2816, C_AL = 2840;
constexpr int NCMP = 127;
constexpr int NEXP = 16, DEXP = 384;
constexpr int SLOTS = 2 * T + NEXP * 256;

enum { I_X = 0, I_MEM, I_POS, I_NMIX, I_NXAT, I_NMEM, I_NFFN, I_HYBIN, I_HYBOUT, I_QNORM, I_KNORM, I_CMPPE, I_CMPW1, I_CMPW2, I_GATEB, I_WA2, I_BA, I_ONORM,
       I_SGIN, I_LNG, I_LNB, I_SGWS, I_SGBS, I_SGOUT, I_XWQ, I_XWKV, I_XWO, I_XQN, I_XKN, I_RW, I_RB, I_MOEIN, I_MOEOUT, N_IN };

constexpr size_t MiB = 1u << 20;
constexpr size_t WS_CTL = 0, CTL_BYTES = 1 * MiB;
constexpr size_t WS_WHYB = 1 * MiB;
constexpr size_t WS_WHOUT = WS_WHYB + 12 * MiB;
constexpr size_t WS_WSGIN = WS_WHOUT + 4 * MiB;
constexpr size_t WS_WSGOUT = WS_WSGIN + 16 * MiB;
constexpr size_t WS_WQ = WS_WSGOUT + 8 * MiB;
constexpr size_t WS_WKV = WS_WQ + 8 * MiB;
constexpr size_t WS_WO = WS_WKV + 16 * MiB;
constexpr size_t WS_WMIN = WS_WO + 8 * MiB;
constexpr size_t WS_WMOUT = WS_WMIN + 96 * MiB;
constexpr size_t WS_RW = WS_WMOUT + 48 * MiB;
constexpr size_t WS_XN = WS_RW + 1 * MiB;
constexpr size_t WS_BIG = WS_XN + 32 * MiB;
constexpr size_t WS_QA = WS_BIG + 128 * MiB;
constexpr size_t WS_KS = WS_QA + 16 * MiB;
constexpr size_t WS_KW = WS_KS + 4 * MiB;
constexpr size_t WS_KC = WS_KW + 4 * MiB;
constexpr size_t WS_VC = WS_KC + 1 * MiB;
constexpr size_t WS_CAT = WS_VC + 1 * MiB;
constexpr size_t WS_QX = WS_CAT + 32 * MiB;
constexpr size_t WS_OX = WS_QX + 32 * MiB;
constexpr size_t WS_MN = WS_OX + 32 * MiB;
constexpr size_t WS_KV = WS_MN + 4 * MiB;
constexpr size_t WS_COS = WS_KV + 32 * MiB;
constexpr size_t WS_SIN = WS_COS + 2 * MiB;
constexpr size_t WS_LIST = WS_SIN + 2 * MiB;
constexpr size_t WS_TOK = WS_LIST + 1 * MiB;
constexpr size_t WS_VT = WS_TOK + 1 * MiB;
constexpr size_t WS_VTA = WS_VT + 16 * MiB;
constexpr size_t WS_SLOC = WS_VTA + 32 * MiB;
constexpr size_t WS_DEC = WS_SLOC + 32 * MiB;
constexpr size_t WS_STT = WS_DEC + 1 * MiB;
constexpr size_t WS_WSB = WS_STT + 16 * MiB;
constexpr size_t WS_M0 = WS_WSB + 768 * 1024;
constexpr size_t WS_END = WS_WSB + 1 * MiB;
constexpr size_t WS_Y = WS_BIG, WS_H = WS_BIG + 72 * MiB, WS_U = WS_BIG, WS_V = WS_BIG + 64 * MiB, WS_UM = WS_QX;
constexpr int CW_BAR = 4096;
constexpr int CW_CNT = 8192;

constexpr int LDS_BYTES = 159744;
constexpr int LDS_MISC = LDS_BYTES - 64;

__device__ __forceinline__ unsigned f2bf(float f) { unsigned u = __float_as_uint(f); return (u + 0x7fffu + ((u >> 16) & 1u)) >> 16; }
__device__ __forceinline__ float bf2f(unsigned b) { return __uint_as_float(b << 16); }
__device__ __forceinline__ float bflo(unsigned w) { return __uint_as_float(w << 16); }
__device__ __forceinline__ float bfhi(unsigned w) { return __uint_as_float(w & 0xffff0000u); }
__device__ __forceinline__ unsigned pk2(float lo, float hi) { return f2bf(lo) | (f2bf(hi) << 16); }
__device__ __forceinline__ float wave_sum(float v) {
#pragma unroll
    for (int o = 1; o < 64; o <<= 1) v += __shfl_xor(v, o);
    return v;
}
__device__ __forceinline__ float wave_max(float v) {
#pragma unroll
    for (int o = 1; o < 64; o <<= 1) v = fmaxf(v, __shfl_xor(v, o));
    return v;
}
__device__ __forceinline__ int opaque_tid(int wv) { int l; asm volatile("v_mbcnt_lo_u32_b32 %0, -1, 0\n\tv_mbcnt_hi_u32_b32 %0, -1, %0" : "=v"(l)); return wv * 64 + l; }
__device__ __forceinline__ unsigned char* opq(unsigned char* p) { asm volatile("" : "+s"(p)); return p; }
#define LDS_WAIT() asm volatile("s_waitcnt lgkmcnt(0)" ::: "memory")
__device__ __forceinline__ float gelu_tanh(float x) {
    const float u = 0.7978845608028654f * (x + 0.044715f * x * x * x);
    const float e = __expf(-2.0f * fabsf(u));
    float t = (1.0f - e) / (1.0f + e); t = u < 0.f ? -t : t;
    return 0.5f * x * (1.0f + t);
}
__device__ __forceinline__ float sigmoidf_(float x) { return 1.0f / (1.0f + __expf(-x)); }

#define XB_TMO      128
#define XB_XCNT(j)  (256  + 64 * (j))
#define XB_XSUB(j)  (1280 + 64 * (j))
#define XB_XGEN(j)  (2304 + 64 * (j))
#define XB_TOP      3328
#define XB_TOPGEN   3392
#define XCD_BAR_WORDS 3456
#define XB_SPIN_CAP (1u << 22)

__device__ __forceinline__ unsigned xb_ld(unsigned* p)              { return __hip_atomic_load(p, __ATOMIC_RELAXED, __HIP_MEMORY_SCOPE_AGENT); }
__device__ __forceinline__ unsigned xb_add(unsigned* p, unsigned v) { return __hip_atomic_fetch_add(p, v, __ATOMIC_RELAXED, __HIP_MEMORY_SCOPE_AGENT); }
__device__ __forceinline__ unsigned xb_xcc_id() { return (unsigned)__builtin_amdgcn_s_getreg((3 << 11) | 20) & 0xFu; }
#define XB_SPIN(cond, bar) do { unsigned _sp = 0; while (cond) { __builtin_amdgcn_s_sleep(1); \
    if ((++_sp & 255u) == 0u) { if (xb_ld(&(bar)[XB_TMO])) break; if (_sp > XB_SPIN_CAP) { atomicAdd(&(bar)[XB_TMO], 1u); break; } } } } while (0)

struct XcdBarrier { unsigned* bar; unsigned x; volatile LAS unsigned* st; };
__device__ __forceinline__ unsigned* xb_opaque(unsigned* p) { unsigned long long v = (unsigned long long)p; unsigned lo = __builtin_amdgcn_readfirstlane((unsigned)v), hi = __builtin_amdgcn_readfirstlane((unsigned)(v >> 32));
    asm volatile("" : "+s"(lo), "+s"(hi)); return (unsigned*)(((unsigned long long)hi << 32) | lo); }

__device__ __forceinline__ XcdBarrier xcd_barrier_post(unsigned* bar, volatile LAS unsigned* st) {
    XcdBarrier b; b.bar = bar; b.x = xb_xcc_id(); b.st = st;
    if (threadIdx.x == 0) (void)xb_add(&bar[XB_XCNT(b.x)], 1u);
    return b;
}
__device__ __forceinline__ void xcd_barrier_complete(unsigned* bar, unsigned x, unsigned& nloc, unsigned& nx) {
    const unsigned G = gridDim.x * gridDim.y * gridDim.z;
    unsigned sum, cnt, mine, sp = 0u;
    for (;;) {
        sum = 0u; cnt = 0u; mine = 0u;
#pragma unroll
        for (unsigned j = 0; j < 16; ++j) { const unsigned c = xb_ld(&bar[XB_XCNT(j)]); sum += c; cnt += (c > 0u) ? 1u : 0u; mine = (j == x) ? c : mine; }
        if (sum == G) break;
        __builtin_amdgcn_s_sleep(1);
        if ((++sp & 255u) == 0u) { if (xb_ld(&bar[XB_TMO])) break; if (sp > XB_SPIN_CAP) { atomicAdd(&bar[XB_TMO], 1u); break; } }
    }
    nloc = mine > 0u ? mine : 1u; nx = cnt > 0u ? cnt : 1u;
}
__device__ __forceinline__ void xcd_barrier(const XcdBarrier& b, const bool is_t0) {
    asm volatile("s_waitcnt vmcnt(0)" ::: "memory");
    __syncthreads();
    if (is_t0) {
        unsigned* bar = b.bar;
        __builtin_amdgcn_s_waitcnt(0);
        unsigned nloc = b.st[0], nx = b.st[1];
        if (nloc == 0u) { xcd_barrier_complete(bar, b.x, nloc, nx); b.st[0] = nloc; b.st[1] = nx; }
        const unsigned old = xb_add(&bar[XB_XSUB(b.x)], 1u);
        const unsigned gen = old / nloc;
        if (old + 1u == (gen + 1u) * nloc) {
            __builtin_amdgcn_fence(__ATOMIC_RELEASE, "agent");
            asm volatile("s_waitcnt vmcnt(0)" ::: "memory");
            const unsigned og = xb_add(&bar[XB_TOP], 1u);
            const unsigned tg = og / nx;
            if (og + 1u == (tg + 1u) * nx) xb_add(&bar[XB_TOPGEN], 1u);
            else XB_SPIN(xb_ld(&bar[XB_TOPGEN]) == tg, bar);
            __builtin_amdgcn_fence(__ATOMIC_ACQUIRE, "agent");
            xb_add(&bar[XB_XGEN(b.x)], 1u);
            asm volatile("s_waitcnt vmcnt(0)" ::: "memory");
        } else {
            XB_SPIN(xb_ld(&bar[XB_XGEN(b.x)]) == gen, bar);
            __builtin_amdgcn_fence(__ATOMIC_ACQUIRE, "agent");
            asm volatile("s_waitcnt vmcnt(0)" ::: "memory");
        }
    }
    __syncthreads();
}

struct Args {
    const float* in[N_IN];
    float* out;
    unsigned char* ws;
    float freq[32];
    int ph_lo, ph_hi;
};

typedef const __attribute__((address_space(4))) Args* KArgs;
__device__ __forceinline__ KArgs kargs() { KArgs p = (KArgs)__builtin_amdgcn_kernarg_segment_ptr(); asm volatile("" : "+s"(p)); return p; }

__device__ __forceinline__ void st_bf16x4(bf16* p, f32x4 v) { u32x2 w; w.x = pk2(v[0], v[1]); w.y = pk2(v[2], v[3]); *(u32x2*)p = w; }


namespace pg8 {
constexpr int BM = 256, BK = 64, HALF = 128, HTB = HALF * BK * 2, STAGE_BYTES = 8 * HTB, NXCD = 8, WGM = 8;
__host__ __device__ __forceinline__ int lds_byte(int r, int c) { const int st = (r >> 4) * 2 + (c >> 5), rr = r & 15, cc = c & 31, ob = rr * 64 + cc * 2; return st * 1024 + (ob ^ (((ob >> 9) & 1) << 5)); }
__host__ __device__ __forceinline__ void stage_rc(int b, int& R, int& C) { const int st = b / 1024, sb = b % 1024, swz = sb ^ (((sb >> 9) & 1) << 5); R = (st >> 1) * 16 + swz / 64; C = (st & 1) * 32 + (swz % 64) / 2; }
__host__ __device__ __forceinline__ int perm32(int rho) { const int n = rho >> 4, i = rho & 15; return 8 * (i >> 2) + 4 * n + (i & 3); }
struct Unit { int pm, pn, e; };
struct DenseOrder {
    static constexpr bool GATHER = false;
    int nM, nN, nwg, G, c, K; const char* Bt;
    __device__ __forceinline__ void init(int M, int N, int K_, const bf16* Bt_, int G_, int c_) { nM = M / BM; nN = N / BM; nwg = nM * nN; G = G_; c = c_; K = K_; Bt = (const char*)Bt_; }
    __device__ __forceinline__ bool next(int i, Unit& u) const {
        const long L = (long)i * G + c; if (L >= nwg) return false;
        int wgid = (int)L; { const int q = nwg / NXCD, r = nwg % NXCD, xcd = wgid % NXCD, off = wgid / NXCD; wgid = (xcd < r ? xcd * (q + 1) : r * (q + 1) + (xcd - r) * q) + off; }
        const int nig = WGM * nN, gid = wgid / nig, fm = gid * WGM, gsz = (nM - fm) < WGM ? (nM - fm) : WGM;
        u.pm = fm + ((wgid % nig) % gsz); u.pn = (wgid % nig) / gsz; u.e = 0; return true;
    }
    __device__ __forceinline__ unsigned a_voff(const Unit& u, int half, int R) const { return (unsigned)((u.pm * BM + half * HALF + R) * K) * 2u; }
    __device__ __forceinline__ const char* b_tile(const Unit& u) const { return Bt + (size_t)u.pn * BM * K * 2; }
};
template <bool GATH> struct MoeOrder {
    static constexpr bool GATHER = GATH;
    int nunits, ntn, G, c, K; const LAS int* off; const LAS int* cn; const int* list; const char* Bt; size_t estride;
    __device__ __forceinline__ bool next(int i, Unit& u) const {
        const int L = i * G + c; if (L >= nunits) return false;
        u.pm = L / ntn; u.pn = L % ntn; const int s0 = u.pm * BM; int e = 0;
#pragma unroll
        for (int q = 1; q < 16; ++q) e += (s0 >= off[q]) ? 1 : 0;
        u.e = e; return true;
    }
    __device__ __forceinline__ unsigned a_voff(const Unit& u, int half, int R) const {
        const int slot = u.pm * BM + half * HALF + R;
        const int loc = slot - off[u.e]; const int tk = list[u.e * T + (loc < cn[u.e] ? loc : 0)];
        return (unsigned)(tk * K) * 2u;
    }
    __device__ __forceinline__ const char* b_tile(const Unit& u) const { return Bt + (size_t)u.e * estride + (size_t)u.pn * BM * K * 2; }
};
__device__ __forceinline__ unsigned cvt_pk_bf16(float lo, float hi) { unsigned r; asm volatile("v_cvt_pk_bf16_f32 %0, %1, %2" : "=v"(r) : "v"(lo), "v"(hi)); return r; }

template <class Epi, class Sched>
__device__ __forceinline__ void gemm_phase(LAS unsigned char* lds, const bf16* Aptr, int K, const Sched& S, const Epi& E, int wv_) {
    const int tid = opaque_tid(wv_), wid = __builtin_amdgcn_readfirstlane(tid >> 6), lane = tid & 63, wr = wid >> 2, wc = wid & 3, fr = lane & 15, fq = lane >> 4;
    const int nt = K / BK;
    int Rr[2], Cc[2]; unsigned voffA[2], voffB[2];
#pragma unroll
    for (int i = 0; i < 2; ++i) { stage_rc(tid * 16 + i * 8192, Rr[i], Cc[i]); const int Rb = Epi::PERM ? ((Rr[i] & ~31) + perm32(Rr[i] & 31)) : Rr[i];
        voffA[i] = (unsigned)(Rr[i] * K + Cc[i]) * 2u; voffB[i] = (unsigned)(Rb * K + Cc[i]) * 2u; }
    const size_t kstep = (size_t)(BK * 2);
    const size_t hstep = (size_t)HALF * K * 2;
    const size_t tstep = 2 * hstep;
    const unsigned ldsw = (unsigned)wid * 1024u;
    const int aoff = lds_byte(wr * 64 + fr, fq * 8), boff = lds_byte(wc * 32 + fr, fq * 8);
    const char* const Ab = (const char*)Aptr;
#define PG8_SA(b, h) (((b) * 2 + (h)) * HTB)
#define PG8_SB(b, h) ((4 + (b) * 2 + (h)) * HTB)
#define PG8_STAGE(bufoff, gbase, voff) do { _Pragma("unroll") for (int _i = 0; _i < 2; ++_i) \
        __builtin_amdgcn_global_load_lds((const unsigned*)((const char*)(gbase) + (voff)[_i]), (LAS unsigned*)(lds + (bufoff) + ldsw + _i * 8192), 16, 0, 0); } while (0)
#define PG8_STAGE_A(bufoff, usenext, h, kofs) do { \
        if constexpr (Sched::GATHER) { const char* gb_ = Ab + (kofs); unsigned vv_[2] = {(usenext) ? vN[h][0] : vA[h][0], (usenext) ? vN[h][1] : vA[h][1]}; PG8_STAGE(bufoff, gb_, vv_); } \
        else { const char* gb_ = ((usenext) ? nA : cA) + (size_t)(h) * hstep + (kofs); PG8_STAGE(bufoff, gb_, voffA); } } while (0)
#define PG8_LDA(dst, b, h) do { _Pragma("unroll") for (int m = 0; m < 4; ++m) _Pragma("unroll") for (int k = 0; k < 2; ++k) dst[m][k] = *(const LAS bf16x8*)(lds + PG8_SA(b, h) + aoff + m * 2048 + k * 1024); } while (0)
#define PG8_LDB(dst, b, h) do { _Pragma("unroll") for (int n = 0; n < 2; ++n) _Pragma("unroll") for (int k = 0; k < 2; ++k) dst[n][k] = *(const LAS bf16x8*)(lds + PG8_SB(b, h) + boff + n * 2048 + k * 1024); } while (0)
#define PG8_MMA(ai, bj, At, Bt) do { __builtin_amdgcn_s_setprio(1); _Pragma("unroll") for (int m = 0; m < 4; ++m) _Pragma("unroll") for (int n = 0; n < 2; ++n) _Pragma("unroll") for (int k = 0; k < 2; ++k) \
        acc[ai][bj][m][n] = __builtin_amdgcn_mfma_f32_16x16x32_bf16(Bt[n][k], At[m][k], acc[ai][bj][m][n], 0, 0, 0); __builtin_amdgcn_s_setprio(0); } while (0)
#define PG8_WAIT_V(n) asm volatile("s_waitcnt vmcnt(" #n ")" ::: "memory")
#define PG8_WAIT_L(n) asm volatile("s_waitcnt lgkmcnt(" #n ")" ::: "memory")
#define PG8_BAR __builtin_amdgcn_s_barrier()
#define PG8_SCHED __builtin_amdgcn_sched_barrier(0)
    Unit cur, nxt; int ui = 0;
    if (!S.next(0, cur)) return;
    f32x4 acc[2][2][4][2];
#pragma unroll
    for (int a = 0; a < 2; ++a)
#pragma unroll
        for (int b = 0; b < 2; ++b)
#pragma unroll
            for (int m = 0; m < 4; ++m)
#pragma unroll
                for (int n = 0; n < 2; ++n) acc[a][b][m][n] = (f32x4){0.f, 0.f, 0.f, 0.f};
    bf16x8 At[4][2], B0[2][2], B1[2][2];
    unsigned vA[2][2], vN[2][2];
    const char* cA = Ab; const char* nA = Ab;
    if constexpr (Sched::GATHER) {
#pragma unroll
        for (int h = 0; h < 2; ++h)
#pragma unroll
            for (int i = 0; i < 2; ++i) { vA[h][i] = S.a_voff(cur, h, Rr[i]) + (unsigned)Cc[i] * 2u; vN[h][i] = vA[h][i]; }
    } else { cA = Ab + (size_t)cur.pm * tstep; nA = cA; }
    const char* cB = S.b_tile(cur);
    PG8_STAGE(PG8_SB(0, 0), cB, voffB); PG8_STAGE_A(PG8_SA(0, 0), false, 0, 0); PG8_STAGE(PG8_SB(0, 1), cB + hstep, voffB); PG8_STAGE_A(PG8_SA(0, 1), false, 1, 0);
    if (wr == 1) PG8_BAR;
    PG8_WAIT_V(4); PG8_BAR;
    PG8_STAGE(PG8_SB(1, 0), cB + kstep, voffB); PG8_STAGE_A(PG8_SA(1, 0), false, 0, kstep); PG8_STAGE(PG8_SB(1, 1), cB + hstep + kstep, voffB);
    PG8_WAIT_V(6); PG8_BAR;
    for (;;) {
        const bool has_next = S.next(ui + 1, nxt);
        const char* nB = has_next ? S.b_tile(nxt) : cB;
        if constexpr (Sched::GATHER) {
#pragma unroll
            for (int h = 0; h < 2; ++h)
#pragma unroll
                for (int i = 0; i < 2; ++i) vN[h][i] = has_next ? S.a_voff(nxt, h, Rr[i]) + (unsigned)Cc[i] * 2u : vA[h][i];
        } else nA = has_next ? Ab + (size_t)nxt.pm * tstep : cA;
        for (int t = 0; t < nt; t += 2) {
            const bool last = (t == nt - 2);
            const size_t k1 = (size_t)(t + 1) * kstep, k2 = last ? 0 : (size_t)(t + 2) * kstep, k3 = k2 + kstep;
            const char* b2 = last ? nB : cB + (size_t)(t + 2) * kstep; const char* b3 = b2 + kstep;
            PG8_LDB(B0, 0, 0); PG8_SCHED; PG8_LDA(At, 0, 0); PG8_STAGE_A(PG8_SA(1, 1), false, 1, k1);
            PG8_WAIT_L(8); PG8_BAR; PG8_WAIT_L(0); PG8_MMA(0, 0, At, B0); PG8_BAR; PG8_SCHED;
            PG8_LDB(B1, 0, 1); PG8_STAGE(PG8_SB(0, 0), b2, voffB);
            PG8_BAR; PG8_WAIT_L(0); PG8_MMA(0, 1, At, B1); PG8_BAR;
            PG8_LDA(At, 0, 1); PG8_STAGE_A(PG8_SA(0, 0), last, 0, k2);
            PG8_BAR; PG8_WAIT_L(0); PG8_MMA(1, 0, At, B0); PG8_BAR; PG8_SCHED;
            PG8_STAGE(PG8_SB(0, 1), b2 + hstep, voffB);
            PG8_WAIT_V(6); PG8_BAR; PG8_MMA(1, 1, At, B1); PG8_BAR;
            PG8_LDB(B0, 1, 0); PG8_SCHED; PG8_LDA(At, 1, 0); PG8_STAGE_A(PG8_SA(0, 1), last, 1, k2);
            PG8_WAIT_L(8); PG8_BAR; PG8_WAIT_L(0); PG8_MMA(0, 0, At, B0); PG8_BAR; PG8_SCHED;
            PG8_LDB(B1, 1, 1); PG8_STAGE(PG8_SB(1, 0), b3, voffB);
            PG8_BAR; PG8_WAIT_L(0); PG8_MMA(0, 1, At, B1); PG8_BAR;
            PG8_LDA(At, 1, 1); PG8_STAGE_A(PG8_SA(1, 0), last, 0, k3);
            PG8_BAR; PG8_WAIT_L(0); PG8_MMA(1, 0, At, B0); PG8_BAR; PG8_SCHED;
            PG8_STAGE(PG8_SB(1, 1), b3 + hstep, voffB);
            PG8_WAIT_V(6); PG8_BAR; PG8_MMA(1, 1, At, B1); PG8_BAR;
        }
        E(acc, cur, wr, wc, fr, fq);
        if (!has_next) break;
#pragma unroll
        for (int a = 0; a < 2; ++a)
#pragma unroll
            for (int b = 0; b < 2; ++b)
#pragma unroll
                for (int m = 0; m < 4; ++m)
#pragma unroll
                    for (int n = 0; n < 2; ++n) acc[a][b][m][n] = (f32x4){0.f, 0.f, 0.f, 0.f};
        cur = nxt; cB = nB; cA = nA; ++ui;
        if constexpr (Sched::GATHER) {
#pragma unroll
            for (int h = 0; h < 2; ++h)
#pragma unroll
                for (int i = 0; i < 2; ++i) vA[h][i] = vN[h][i];
        }
    }
    PG8_WAIT_V(0);
    if (wr == 0) PG8_BAR;
    PG8_BAR;
#undef PG8_SA
#undef PG8_SB
#undef PG8_STAGE
#undef PG8_STAGE_A
#undef PG8_LDA
#undef PG8_LDB
#undef PG8_MMA
#undef PG8_WAIT_V
#undef PG8_WAIT_L
#undef PG8_BAR
#undef PG8_SCHED
}
template <int ACT> struct EpiBf16 {
    static constexpr bool PERM = true;
    bf16* O; int ldc; int tpt; size_t tstride;
    __device__ __forceinline__ void operator()(const f32x4 (&acc)[2][2][4][2], const Unit& u, int wr, int wc, int fr, int fq) const {
        const int row0 = u.pm * BM + wr * 64 + fr; const int tt = u.pn / tpt; bf16* base = O + (size_t)tt * tstride; const int col0 = (u.pn - tt * tpt) * BM + wc * 32 + 8 * fq;
#pragma unroll
        for (int ai = 0; ai < 2; ++ai)
#pragma unroll
            for (int m = 0; m < 4; ++m) { bf16* rowp = base + (size_t)(row0 + ai * HALF + m * 16) * ldc + col0;
#pragma unroll
                for (int bj = 0; bj < 2; ++bj) { f32x4 v0 = acc[ai][bj][m][0], v1 = acc[ai][bj][m][1];
                    if (ACT == 1) {
#pragma unroll
                        for (int q = 0; q < 4; ++q) { v0[q] = gelu_tanh(v0[q]); v1[q] = gelu_tanh(v1[q]); } }
                    u32x4 w; w.x = cvt_pk_bf16(v0[0], v0[1]); w.y = cvt_pk_bf16(v0[2], v0[3]); w.z = cvt_pk_bf16(v1[0], v1[1]); w.w = cvt_pk_bf16(v1[2], v1[3]);
                    *(u32x4*)(rowp + bj * HALF) = w; } }
    }
};
struct EpiResAdd {
    static constexpr bool PERM = false;
    float* X; int ldc;
    __device__ __forceinline__ void operator()(const f32x4 (&acc)[2][2][4][2], const Unit& u, int wr, int wc, int fr, int fq) const {
        const int row0 = u.pm * BM + wr * 64 + fr, col0 = u.pn * BM + wc * 32 + 4 * fq;
#pragma unroll
        for (int ai = 0; ai < 2; ++ai)
#pragma unroll
            for (int m = 0; m < 4; ++m) { float* rowp = X + (size_t)(row0 + ai * HALF + m * 16) * ldc + col0;
#pragma unroll
                for (int bj = 0; bj < 2; ++bj)
#pragma unroll
                    for (int n = 0; n < 2; ++n) { f32x4* p = (f32x4*)(rowp + bj * HALF + n * 16); *p = *p + acc[ai][bj][m][n]; } }
    }
};
struct EpiSwiglu {
    static constexpr bool PERM = true;
    bf16* H; int ldc;
    __device__ __forceinline__ void operator()(const f32x4 (&acc)[2][2][4][2], const Unit& u, int wr, int wc, int fr, int fq) const {
        const int row0 = u.pm * BM + wr * 64 + fr, col0 = u.pn * HALF + wc * 32 + 8 * fq;
#pragma unroll
        for (int ai = 0; ai < 2; ++ai)
#pragma unroll
            for (int m = 0; m < 4; ++m) {
                float o[8];
#pragma unroll
                for (int n = 0; n < 2; ++n)
#pragma unroll
                    for (int q = 0; q < 4; ++q) { const float g = acc[ai][0][m][n][q]; o[4 * n + q] = g * sigmoidf_(g) * acc[ai][1][m][n][q]; }
                u32x4 w; w.x = cvt_pk_bf16(o[0], o[1]); w.y = cvt_pk_bf16(o[2], o[3]); w.z = cvt_pk_bf16(o[4], o[5]); w.w = cvt_pk_bf16(o[6], o[7]);
                *(u32x4*)(H + (size_t)(row0 + ai * HALF + m * 16) * ldc + col0) = w; }
    }
};
}

__device__ __forceinline__ int hyb_colmap(int n) {
    if (n < 1280) return n;
    if (n < 1536) return 1304 + (n - 1280);
    if (n < 1792) return 1560 + (n - 1536);
    if (n < 2304) return 1816 + (n - 1792);
    if (n < 2816) return 2344 + (n - 2304);
    if (n < 2840) return 1280 + (n - 2816);
    if (n < 2856) return 2328 + (n - 2840);
    return -1;
}
__device__ __forceinline__ void tr_item(const float* __restrict__ W, int Nsrc, int K, bf16* __restrict__ Wt, const float* __restrict__ gain, int kind, int nblk, LAS float* scr, int item, int lane) {
    const int kb = item / nblk, nb = item % nblk, k0 = 64 * kb, n0 = 32 * nb;
    const int j = lane & 31, n = n0 + j;
    int col;
    if (kind == 0) col = n; else if (kind == 1) col = hyb_colmap(n); else { const int pn = n >> 8, r = n & 255; col = (r >> 7) * 384 + pn * 128 + (r & 127); }
#pragma unroll 8
    for (int i = 0; i < 32; ++i) {
        const int kk = 2 * i + (lane >> 5); float v = 0.f;
        if (col >= 0) { v = W[(size_t)(k0 + kk) * Nsrc + col]; if (gain) v *= gain[k0 + kk]; }
        scr[kk * 33 + j] = v;
    }
    LDS_WAIT();
    const int c = lane & 7;
#pragma unroll
    for (int jx = 0; jx < 4; ++jx) {
        const int nn = (lane >> 3) + 8 * jx; const LAS float* s = scr + (8 * c) * 33 + nn;
        u32x4 o; o.x = pk2(s[0 * 33], s[1 * 33]); o.y = pk2(s[2 * 33], s[3 * 33]); o.z = pk2(s[4 * 33], s[5 * 33]); o.w = pk2(s[6 * 33], s[7 * 33]);
        *(u32x4*)(Wt + (size_t)(n0 + nn) * K + k0 + 8 * c) = o;
    }
    LDS_WAIT();
}
__device__ __forceinline__ void rms_row_to_bf16(const float* __restrict__ xrow, bf16* __restrict__ orow, float* __restrict__ copy, int lane) {
    const f32x4* xr = (const f32x4*)xrow + lane;
    f32x4 v[4]; float s = 0.f;
#pragma unroll
    for (int j = 0; j < 4; ++j) { v[j] = xr[64 * j]; s += (v[j].x * v[j].x + v[j].y * v[j].y) + (v[j].z * v[j].z + v[j].w * v[j].w); }
    const float rstd = rsqrtf(wave_sum(s) * (1.f / 1024.f) + EPS);
    u32x2* o8 = (u32x2*)orow + lane;
#pragma unroll
    for (int j = 0; j < 4; ++j) { u32x2 w; w.x = pk2(v[j].x * rstd, v[j].y * rstd); w.y = pk2(v[j].z * rstd, v[j].w * rstd); o8[64 * j] = w; }
    if (copy) { f32x4* c4 = (f32x4*)copy + lane;
#pragma unroll
        for (int j = 0; j < 4; ++j) c4[64 * j] = v[j]; }
}

__device__ __forceinline__ void phase_prologue(KArgs A, int wv_, LAS unsigned char* lds) {
    const int tid = opaque_tid(wv_), wid = __builtin_amdgcn_readfirstlane(tid >> 6), lane = tid & 63;
    const int gw = blockIdx.x * 8 + wid, NGW = gridDim.x * 8;
    LAS float* scr = (LAS float*)(lds + wid * 16384);
    unsigned char* ws = opq(A->ws);
    constexpr int N_HYB = 2 * 1536, N_HOUT = 2 * 512, N_SGIN = 2 * 2048, N_SGOUT = 2 * 1024, N_WQ = 4 * 512, N_WKV = 4 * 1024, N_WO = 4 * 512, N_MIN = 64 * 384, N_MOUT = 64 * 192;
    constexpr int NITEMS = N_HYB + N_HOUT + N_SGIN + N_SGOUT + N_WQ + N_WKV + N_WO + N_MIN + N_MOUT;
    for (int it = gw; it < NITEMS; it += NGW) {
        int r = it;
        if (r < N_HYB) { const int sl = r / 1536; tr_item(A->in[I_HYBIN] + (size_t)sl * 1024 * HYSRC, HYSRC, 1024, (bf16*)(ws + WS_WHYB) + (size_t)sl * HYN * 1024, A->in[I_NMIX] + (2 * sl) * 1024, 1, 96, scr, r % 1536, lane); continue; } r -= N_HYB;
        if (r < N_HOUT) { const int sl = r / 512; tr_item(A->in[I_HYBOUT] + (size_t)sl * 1024 * 1024, 1024, 1024, (bf16*)(ws + WS_WHOUT) + (size_t)sl * 1024 * 1024, nullptr, 0, 32, scr, r % 512, lane); continue; } r -= N_HOUT;
        if (r < N_SGIN) { const int sl = r / 2048; tr_item(A->in[I_SGIN] + (size_t)sl * 1024 * 4096, 4096, 1024, (bf16*)(ws + WS_WSGIN) + (size_t)sl * 4096 * 1024, A->in[I_NMIX] + (2 * sl + 1) * 1024, 0, 128, scr, r % 2048, lane); continue; } r -= N_SGIN;
        if (r < N_SGOUT) { const int sl = r / 1024; tr_item(A->in[I_SGOUT] + (size_t)sl * 2048 * 1024, 1024, 2048, (bf16*)(ws + WS_WSGOUT) + (size_t)sl * 1024 * 2048, nullptr, 0, 32, scr, r % 1024, lane); continue; } r -= N_SGOUT;
        if (r < N_WQ) { const int sl = r / 512; tr_item(A->in[I_XWQ] + (size_t)sl * 1024 * 1024, 1024, 1024, (bf16*)(ws + WS_WQ) + (size_t)sl * 1024 * 1024, A->in[I_NXAT] + sl * 1024, 0, 32, scr, r % 512, lane); continue; } r -= N_WQ;
        if (r < N_WKV) { const int sl = r / 1024; tr_item(A->in[I_XWKV] + (size_t)sl * 1024 * 2048, 2048, 1024, (bf16*)(ws + WS_WKV) + (size_t)sl * 2048 * 1024, A->in[I_NMEM] + sl * 1024, 0, 64, scr, r % 1024, lane); continue; } r -= N_WKV;
        if (r < N_WO) { const int sl = r / 512; tr_item(A->in[I_XWO] + (size_t)sl * 1024 * 1024, 1024, 1024, (bf16*)(ws + WS_WO) + (size_t)sl * 1024 * 1024, nullptr, 0, 32, scr, r % 512, lane); continue; } r -= N_WO;
        if (r < N_MIN) { const int sl = r / 384; tr_item(A->in[I_MOEIN] + (size_t)sl * 1024 * 768, 768, 1024, (bf16*)(ws + WS_WMIN) + (size_t)sl * 768 * 1024, A->in[I_NFFN] + (sl >> 4) * 1024, 2, 24, scr, r % 384, lane); continue; } r -= N_MIN;
        { const int sl = r / 192; tr_item(A->in[I_MOEOUT] + (size_t)sl * 384 * 1024, 1024, 384, (bf16*)(ws + WS_WMOUT) + (size_t)sl * 1024 * 384, nullptr, 0, 32, scr, r % 192, lane); }
    }
    for (int m = gw; m < T; m += NGW) rms_row_to_bf16(A->in[I_X] + (size_t)m * D, (bf16*)(ws + WS_XN) + (size_t)m * D, A->out + (size_t)m * D, lane);
    for (int m = gw; m < NBATCH * NMEM; m += NGW) rms_row_to_bf16(A->in[I_MEM] + (size_t)m * D, (bf16*)(ws + WS_MN) + (size_t)m * D, nullptr, lane);
    const int gt = blockIdx.x * 512 + tid, NGT = gridDim.x * 512;
    const int* pos = (const int*)A->in[I_POS];
    float* cosT = (float*)(ws + WS_COS); float* sinT = (float*)(ws + WS_SIN);
    for (int i = gt; i < T * 32; i += NGT) {
        const int t = i >> 5, j = i & 31;
        const float ang = (float)pos[t] * A->freq[j];
        const double rev = (double)ang * 0.15915494309189533577;
        const float fr = (float)(rev - rint(rev));
        cosT[i] = __builtin_amdgcn_cosf(fr); sinT[i] = __builtin_amdgcn_sinf(fr);
    }
    { bf16* WSB = (bf16*)(ws + WS_WSB); float* M0 = (float*)(ws + WS_M0); const float* wsg = A->in[I_SGWS];
      for (int e = gt; e < 2 * 8 * 128 * 128; e += NGT) { const int s = e & 127, t = (e >> 7) & 127; WSB[e] = (bf16)f2bf(s <= t ? wsg[e] : 0.f); }
      for (int e = gt; e < 2 * 8 * 128; e += NGT) { const int t = e & 127; const float* r = wsg + (size_t)e * 128; float a = 0.f; for (int s = 0; s <= t; ++s) a += r[s]; M0[e] = a; } }
    float* RW = (float*)(ws + WS_RW);
    for (int i = gt; i < DEPTH * NEXP * D; i += NGT) { const int k = i & 1023, e = (i >> 10) & 15, l = i >> 14; RW[i] = A->in[I_RW][k * NEXP + e] * A->in[I_NFFN][l * D + k]; }
}

__device__ __forceinline__ void phase_knorm(KArgs A, int wv_) {
    const int tid_ = opaque_tid(wv_); const int wid = __builtin_amdgcn_readfirstlane(tid_ >> 6), lane = tid_ & 63; const int gw = blockIdx.x * 8 + wid, NGW = gridDim.x * 8;
    bf16* KV = (bf16*)(opq(A->ws) + WS_KV);
    for (int it = gw; it < DEPTH * 2048 * 4; it += NGW) {
        const int h = it & 3, m = (it >> 2) & 2047, l = it >> 13;
        bf16* p = KV + (size_t)m * 8192 + l * 2048 + h * 256 + 4 * lane;
        const u32x2 w = *(const u32x2*)p;
        float x0 = bflo(w.x), x1 = bfhi(w.x), x2 = bflo(w.y), x3 = bfhi(w.y);
        const float rstd = rsqrtf(wave_sum(x0 * x0 + x1 * x1 + x2 * x2 + x3 * x3) * (1.f / 256.f) + EPS) * 0.0625f;
        const f32x4 g = *(const f32x4*)(A->in[I_XKN] + l * 256 + 4 * lane);
        u32x2 o; o.x = pk2(x0 * rstd * g.x, x1 * rstd * g.y); o.y = pk2(x2 * rstd * g.z, x3 * rstd * g.w);
        *(u32x2*)p = o;
    }
}

__device__ __forceinline__ int kpos64(int tok) { const int k = tok & 31; return (tok & 32) + 8 * ((k >> 2) & 3) + 4 * (k >> 4) + (k & 3); }
__device__ __forceinline__ int kperm64(int p) { const int fq = (p >> 3) & 3, j = p & 7; return (p & 32) + 16 * (j >> 2) + 4 * fq + (j & 3); }

__device__ __forceinline__ void phase_nsa_prep(KArgs A, int wv_, int i, LAS unsigned char* lds) {
    const int tid_ = opaque_tid(wv_); const int wid = __builtin_amdgcn_readfirstlane(tid_ >> 6), lane = tid_ & 63; const int gw = blockIdx.x * 8 + wid, NGW = gridDim.x * 8;
    unsigned char* ws = opq(A->ws);
    const bf16* HY = (const bf16*)(ws + WS_BIG);
    const float* cosT = (const float*)(ws + WS_COS); const float* sinT = (const float*)(ws + WS_SIN);
    bf16* QA = (bf16*)(ws + WS_QA); bf16* KS = (bf16*)(ws + WS_KS); bf16* KW = (bf16*)(ws + WS_KW);
    LAS float* abuf = (LAS float*)(lds + wid * 8192);
    const int NIT = T + NBATCH * NCMP * 2 * 2;
    for (int it = gw; it < NIT; it += NGW) {
        if (it < T) {
            const int t = it;
            const float c = cosT[t * 32 + (lane & 31)], s = sinT[t * 32 + (lane & 31)];
#pragma unroll
            for (int u = 0; u < 12; ++u) {
                int src; const float* gain; bf16* dst; float scale;
                if (u < 8) { src = C_QA + 64 * u; gain = A->in[I_QNORM] + i * 64; dst = QA + (size_t)t * 512 + 64 * u; scale = 0.125f; }
                else if (u < 10) { src = C_KS + 64 * (u - 8); gain = A->in[I_KNORM] + (i * 3 + 1) * 64; dst = KS + (size_t)t * 128 + 64 * (u - 8); scale = 1.f; }
                else { src = C_KW + 64 * (u - 10); gain = A->in[I_KNORM] + (i * 3 + 2) * 64; dst = KW + (size_t)t * 128 + 64 * (u - 10); scale = 1.f; }
                const float x = bf2f(HY[(size_t)t * HYN + src + lane]);
                const float y = x * rsqrtf(wave_sum(x * x) * (1.f / 64.f) + EPS) * gain[lane] * scale;
                const float pr = __shfl_xor(y, 32);
                const float o = lane < 32 ? y * c - pr * s : y * c + pr * s;
                dst[lane] = (bf16)f2bf(o);
            }
        } else {
            const int r = it - T; const int kv = r & 1, g = (r >> 1) & 1, bn = r >> 2, n = bn % NCMP, b = bn / NCMP;
            const float* pe = A->in[I_CMPPE] + (size_t)(i * 2 + kv) * 32 * 64;
            const float* w1 = A->in[I_CMPW1] + (size_t)(i * 2 + kv) * 2048 * 64;
            const float* w2 = A->in[I_CMPW2] + (size_t)(i * 2 + kv) * 64 * 64;
            const int tok0 = b * S + 16 * n, coff = (kv ? C_VC : C_KC) + g * 64;
#pragma unroll 4
            for (int l = 0; l < 32; ++l) abuf[l * 64 + lane] = bf2f(HY[(size_t)(tok0 + l) * HYN + coff + lane]) + pe[l * 64 + lane];
            LDS_WAIT();
            float acc = 0.f;
#pragma unroll 8
            for (int k = 0; k < 2048; ++k) acc += abuf[k] * w1[k * 64 + lane];
            const float h = gelu_tanh(acc);
            float o = 0.f;
#pragma unroll 8
            for (int m = 0; m < 64; ++m) o += __shfl(h, m) * w2[m * 64 + lane];
            LDS_WAIT();
            const size_t oidx = ((size_t)(b * 128 + n) * 2 + g) * 64 + lane;
            if (kv == 0) {
                const float y = o * rsqrtf(wave_sum(o * o) * (1.f / 64.f) + EPS) * A->in[I_KNORM][(i * 3 + 0) * 64 + lane];
                const int tp = tok0 + 31;
                const float c = cosT[tp * 32 + (lane & 31)], s = sinT[tp * 32 + (lane & 31)];
                const float pr = __shfl_xor(y, 32);
                const float oo = lane < 32 ? y * c - pr * s : y * c + pr * s;
                ((bf16*)(ws + WS_KC))[oidx] = (bf16)f2bf(oo);
            } else {
                bf16* vct = (bf16*)(ws + WS_VC) + ((size_t)(b * 2 + g) * 64 + lane) * 128;
                vct[(n & 64) + kpos64(n & 63)] = (bf16)f2bf(o);
                if (n == 126) vct[127] = 0;
                (void)oidx;
            }
        }
    }
}

__device__ __forceinline__ void nsa_block(const LAS float* qs, const bf16* __restrict__ krow, bool ok, const bf16* __restrict__ vbase, int vstride, int lane,
                                          float (&m)[4], float (&l)[4], float (&o)[4]) {
    float s[4] = {0.f, 0.f, 0.f, 0.f};
#pragma unroll 2
    for (int c = 0; c < 8; ++c) {
        const u32x4 kw = *(const u32x4*)(krow + 8 * c);
        const float k0 = bflo(kw.x), k1 = bfhi(kw.x), k2 = bflo(kw.y), k3 = bfhi(kw.y), k4 = bflo(kw.z), k5 = bfhi(kw.z), k6 = bflo(kw.w), k7 = bfhi(kw.w);
#pragma unroll
        for (int hh = 0; hh < 4; ++hh) {
            const f32x4 qa = *(const LAS f32x4*)(qs + hh * 64 + 8 * c), qb = *(const LAS f32x4*)(qs + hh * 64 + 8 * c + 4);
            s[hh] += (qa.x * k0 + qa.y * k1) + (qa.z * k2 + qa.w * k3) + (qb.x * k4 + qb.y * k5) + (qb.z * k6 + qb.w * k7);
        }
    }
    float p[4];
#pragma unroll
    for (int hh = 0; hh < 4; ++hh) {
        const float sv = ok ? s[hh] : -INFINITY;
        const float bm = wave_max(sv);
        const float mn = fmaxf(m[hh], bm);
        if (mn == -INFINITY) { p[hh] = 0.f; continue; }
        const float alpha = __expf(m[hh] - mn);
        p[hh] = ok ? __expf(sv - mn) : 0.f;
        l[hh] = l[hh] * alpha + wave_sum(p[hh]);
        o[hh] *= alpha; m[hh] = mn;
    }
#pragma unroll 8
    for (int kk = 0; kk < 64; ++kk) {
        const float v = bf2f(vbase[(size_t)kk * vstride + lane]);
#pragma unroll
        for (int hh = 0; hh < 4; ++hh) o[hh] += __shfl(p[hh], kk) * v;
    }
}
__device__ __forceinline__ void phase_nsa_attn(KArgs A, int wv_, int i, LAS unsigned char* lds) {
    const int tid_ = opaque_tid(wv_); const int wid = __builtin_amdgcn_readfirstlane(tid_ >> 6), lane0 = tid_ & 63; const int gw = blockIdx.x * 8 + wid, NGW = gridDim.x * 8;
    unsigned char* ws = opq(A->ws);
    const bf16* HY = (const bf16*)(ws + WS_BIG); const bf16* QA = (const bf16*)(ws + WS_QA); const bf16* KS = (const bf16*)(ws + WS_KS); const bf16* KW = (const bf16*)(ws + WS_KW);
    const bf16* KC = (const bf16*)(ws + WS_KC); const bf16* VC = (const bf16*)(ws + WS_VC); bf16* CAT = (bf16*)(ws + WS_CAT);
    LAS float* qs = (LAS float*)(lds + wid * 2048);
    LAS float* ps = qs + 256;
    for (int it = gw; it < 2 * T; it += NGW) {
        int lane = lane0; asm volatile("" : "+v"(lane));
        const int tok = it >> 1, g = it & 1, b = tok >> 11, t = tok & 2047;
#pragma unroll
        for (int hh = 0; hh < 4; ++hh) qs[hh * 64 + lane] = bf2f(QA[(size_t)tok * 512 + (g * 4 + hh) * 64 + lane]);
        LDS_WAIT();
        const int ncv = t >= 31 ? ((t - 31) >> 4) + 1 : 0;
        float oc[4] = {0.f, 0.f, 0.f, 0.f};
        float psum0 = 0.f, psum1 = 0.f;
        {
            const bool v0 = lane < ncv, v1 = lane + 64 < ncv;
            const bf16* k0p = KC + ((size_t)(b * 128 + lane) * 2 + g) * 64;
            const bf16* k1p = KC + ((size_t)(b * 128 + (lane + 64 < 127 ? lane + 64 : 126)) * 2 + g) * 64;
            float s0[4] = {0.f, 0.f, 0.f, 0.f}, s1[4] = {0.f, 0.f, 0.f, 0.f};
#pragma unroll 2
            for (int c = 0; c < 8; ++c) {
                const u32x4 ka = *(const u32x4*)(k0p + 8 * c), kb = *(const u32x4*)(k1p + 8 * c);
#pragma unroll
                for (int hh = 0; hh < 4; ++hh) {
                    const f32x4 qa = *(const LAS f32x4*)(qs + hh * 64 + 8 * c), qb = *(const LAS f32x4*)(qs + hh * 64 + 8 * c + 4);
                    s0[hh] += (qa.x * bflo(ka.x) + qa.y * bfhi(ka.x)) + (qa.z * bflo(ka.y) + qa.w * bfhi(ka.y)) + (qb.x * bflo(ka.z) + qb.y * bfhi(ka.z)) + (qb.z * bflo(ka.w) + qb.w * bfhi(ka.w));
                    s1[hh] += (qa.x * bflo(kb.x) + qa.y * bfhi(kb.x)) + (qa.z * bflo(kb.y) + qa.w * bfhi(kb.y)) + (qb.x * bflo(kb.z) + qb.y * bfhi(kb.z)) + (qb.z * bflo(kb.w) + qb.w * bfhi(kb.w));
                }
            }
            float p0[4], p1[4];
#pragma unroll
            for (int hh = 0; hh < 4; ++hh) {
                const float a0 = v0 ? s0[hh] : -INFINITY, a1 = v1 ? s1[hh] : -INFINITY;
                const float mx = wave_max(fmaxf(a0, a1));
                if (ncv > 0) {
                    const float e0 = v0 ? __expf(a0 - mx) : 0.f, e1 = v1 ? __expf(a1 - mx) : 0.f;
                    const float inv = 1.0f / wave_sum(e0 + e1);
                    p0[hh] = e0 * inv; p1[hh] = e1 * inv;
                } else { p0[hh] = 0.f; p1[hh] = 0.f; }
                psum0 += p0[hh]; psum1 += p1[hh];
            }
#pragma unroll 2
            for (int c = 0; c < ncv; ++c) {
                const float v = bf2f(VC[((size_t)(b * 128 + c) * 2 + g) * 64 + lane]);
#pragma unroll
                for (int hh = 0; hh < 4; ++hh) oc[hh] += __shfl(c < 64 ? p0[hh] : p1[hh], c & 63) * v;
            }
        }
        ps[lane] = psum0; ps[64 + lane] = psum1;
        LDS_WAIT();
        const int cur = t >> 6;
        unsigned selmask;
        {
            const int j = lane & 31;
            float imp = ps[4 * j] + ps[4 * j + 1] + ps[4 * j + 2] + 0.5f * ps[4 * j + 3] + (j > 0 ? 0.5f * ps[4 * j - 1] : 0.f);
            const bool valid = j <= cur, forced = (j == 0) || (j == cur) || (j == cur - 1);
            const float score = valid ? imp + (forced ? 1000.0f : 0.f) : -INFINITY;
            int rank = 0;
#pragma unroll 8
            for (int jj = 0; jj < 32; ++jj) { const float sj = __shfl(score, jj); rank += (sj > score || (sj == score && jj < j)) ? 1 : 0; }
            const bool sel = valid && rank < 8 && lane < 32;
            selmask = (unsigned)__ballot(sel);
        }
        LDS_WAIT();
        float o1[4] = {0.f, 0.f, 0.f, 0.f}, o2[4] = {0.f, 0.f, 0.f, 0.f};
#pragma unroll 1
        for (int pass = 0; pass < 2; ++pass) {
            float oa[4] = {0.f, 0.f, 0.f, 0.f}, ma[4] = {-INFINITY, -INFINITY, -INFINITY, -INFINITY}, la[4] = {0.f, 0.f, 0.f, 0.f};
            const int lo = pass ? (t - 255 > 0 ? t - 255 : 0) : 0;
            const unsigned bm = pass ? 0xffffffffu : selmask;
            const bf16* Kb = pass ? KW : KS; const int vc = pass ? C_VW : C_VS;
#pragma unroll 1
            for (int j = lo >> 6; j <= cur; ++j) {
                if (!((bm >> j) & 1u)) continue;
                const int key = 64 * j + lane; const size_t kt = (size_t)(b * S + key);
                nsa_block(qs, Kb + kt * 128 + g * 64, key <= t && key >= lo, HY + (size_t)(b * S + 64 * j) * HYN + vc + g * 64, HYN, lane, ma, la, oa);
            }
            if (pass == 0) {
#pragma unroll
                for (int hh = 0; hh < 4; ++hh) o1[hh] = oa[hh] / la[hh];
            } else {
#pragma unroll
                for (int hh = 0; hh < 4; ++hh) o2[hh] = oa[hh] / la[hh];
            }
        }
#pragma unroll
        for (int hh = 0; hh < 4; ++hh) {
            const int head = g * 4 + hh;
            const float* gb = A->in[I_GATEB] + i * 24 + head * 3;
            const bf16* gl = HY + (size_t)tok * HYN + C_GA + head * 3;
            const float g0 = sigmoidf_(bf2f(gl[0]) + gb[0]), g1 = sigmoidf_(bf2f(gl[1]) + gb[1]), g2 = sigmoidf_(bf2f(gl[2]) + gb[2]);
            const float o = g0 * oc[hh] + g1 * o1[hh] + g2 * o2[hh];
            CAT[(size_t)tok * 1024 + head * 64 + lane] = (bf16)f2bf(o);
        }
    }
}

__device__ __forceinline__ void phase_gla_seq(KArgs A, int wv_, int i, LAS unsigned char* lds) {
    const int tid = opaque_tid(wv_), wid = __builtin_amdgcn_readfirstlane(tid >> 6), lane = tid & 63;
    unsigned char* ws = opq(A->ws);
    const bf16* HY = (const bf16*)(ws + WS_BIG); bf16* CAT = (bf16*)(ws + WS_CAT);
    constexpr int CH = 16;
    LAS float* la = (LAS float*)lds;
    LAS float* lk = la + 4 * CH * 64;
    LAS float* lq = lk + 4 * CH * 64;
    LAS float* lo = lq + 4 * CH * 64;
    const float* wa2 = A->in[I_WA2] + i * 16 * 256; const float* ba = A->in[I_BA] + i * 256; const float* og = A->in[I_ONORM] + i * 128;
    for (int it = blockIdx.x; it < 8; it += gridDim.x) {
        const int pl = tid >> 7, v = tid & 127, p = it * 4 + pl, b = p >> 2, h = p & 3;
        float St[64];
#pragma unroll
        for (int k = 0; k < 64; ++k) St[k] = 0.f;
        for (int c0 = 0; c0 < S; c0 += CH) {
            __syncthreads();
            for (int e = tid; e < 4 * CH * 64; e += 512) {
                const int kk = e & 63, tk = (e >> 6) % CH, pp = e / (64 * CH); const int pb = (it * 4 + pp) >> 2, ph = (it * 4 + pp) & 3;
                const size_t tok = (size_t)pb * S + c0 + tk; const bf16* row = HY + tok * HYN;
                float z = ba[ph * 64 + kk];
#pragma unroll
                for (int r = 0; r < 16; ++r) z += bf2f(row[C_AL + r]) * wa2[r * 256 + ph * 64 + kk];
                const float ls_ = fminf(z, 0.f) - log1pf(__expf(-fabsf(z)));
                la[e] = __expf(ls_ * (1.f / 16.f));
                lk[e] = bf2f(row[C_KB + ph * 64 + kk]);
                lq[e] = bf2f(row[C_QB + ph * 64 + kk]) * 0.125f;
            }
            __syncthreads();
            for (int tk = 0; tk < CH; ++tk) {
                const size_t tok = (size_t)b * S + c0 + tk;
                const float vv = bf2f(HY[tok * HYN + C_VB + h * 128 + v]);
                const LAS float* pa = la + (pl * CH + tk) * 64; const LAS float* pk = lk + (pl * CH + tk) * 64; const LAS float* pq = lq + (pl * CH + tk) * 64;
                float o = 0.f;
#pragma unroll
                for (int k4 = 0; k4 < 16; ++k4) {
                    const f32x4 a4 = *(const LAS f32x4*)(pa + 4 * k4), k4v = *(const LAS f32x4*)(pk + 4 * k4), q4 = *(const LAS f32x4*)(pq + 4 * k4);
                    St[4 * k4 + 0] = a4.x * St[4 * k4 + 0] + k4v.x * vv; o += q4.x * St[4 * k4 + 0];
                    St[4 * k4 + 1] = a4.y * St[4 * k4 + 1] + k4v.y * vv; o += q4.y * St[4 * k4 + 1];
                    St[4 * k4 + 2] = a4.z * St[4 * k4 + 2] + k4v.z * vv; o += q4.z * St[4 * k4 + 2];
                    St[4 * k4 + 3] = a4.w * St[4 * k4 + 3] + k4v.w * vv; o += q4.w * St[4 * k4 + 3];
                }
                lo[(pl * CH + tk) * 128 + v] = o;
            }
            __syncthreads();
            for (int r = wid; r < 4 * CH; r += 8) {
                const int pp = r / CH, tk = r % CH; const int pb = (it * 4 + pp) >> 2, ph = (it * 4 + pp) & 3;
                const size_t tok = (size_t)pb * S + c0 + tk;
                const float x0 = lo[r * 128 + lane], x1 = lo[r * 128 + 64 + lane];
                const float rstd = rsqrtf(wave_sum(x0 * x0 + x1 * x1) * (1.f / 128.f) + EPS);
                const float r0 = bf2f(HY[tok * HYN + C_RB + ph * 128 + lane]), r1 = bf2f(HY[tok * HYN + C_RB + ph * 128 + 64 + lane]);
                CAT[tok * 1024 + 512 + ph * 128 + lane] = (bf16)f2bf(x0 * rstd * og[lane] * (r0 * sigmoidf_(r0)));
                CAT[tok * 1024 + 512 + ph * 128 + 64 + lane] = (bf16)f2bf(x1 * rstd * og[64 + lane] * (r1 * sigmoidf_(r1)));
            }
        }
        __syncthreads();
    }
}


__device__ __forceinline__ void phase_nsa_attn_mfma(KArgs A, int wv_, int i, LAS unsigned char* lds) {
    const int tid = opaque_tid(wv_), wid = __builtin_amdgcn_readfirstlane(tid >> 6), lane = tid & 63, fr = lane & 15, fq = lane >> 4;
    unsigned char* ws = opq(A->ws);
    const bf16* HY = (const bf16*)(ws + WS_BIG); const bf16* QA = (const bf16*)(ws + WS_QA); const bf16* KS = (const bf16*)(ws + WS_KS); const bf16* KW = (const bf16*)(ws + WS_KW);
    const bf16* KC = (const bf16*)(ws + WS_KC); const bf16* VCT = (const bf16*)(ws + WS_VC); const bf16* VTA = (const bf16*)(ws + WS_VTA); bf16* CAT = (bf16*)(ws + WS_CAT);
    constexpr int RS = 72;
    LAS bf16* ktl = (LAS bf16*)lds;
    LAS bf16* vtl = ktl + 2 * 64 * RS;
    LAS float* scl = (LAS float*)(lds + 36864) + wid * 256;
    LAS unsigned* msk = (LAS unsigned*)(lds + 36864 + 8192);
    LAS unsigned* umask = msk + 64;
    const float* gb = A->in[I_GATEB] + i * 24;
    for (int pit = blockIdx.x; pit < 256; pit += gridDim.x) {
#pragma unroll 1
        for (int hf = 0; hf < 2; ++hf) {
            const int bg = pit >> 4, xx = pit & 15, x = hf ? 31 - xx : xx, b = bg >> 1, g = bg & 1;
            const size_t tokbase = (size_t)b * S + 64 * x;
            const int tl0 = 8 * wid + (fr >> 2);
            if (tid == 0) *umask = 0u;
            bf16x8 qf[2][2];
#pragma unroll
            for (int mt = 0; mt < 2; ++mt)
#pragma unroll
                for (int s = 0; s < 2; ++s) qf[mt][s] = *(const bf16x8*)(QA + (tokbase + tl0 + 4 * mt) * 512 + (g * 4 + (fr & 3)) * 64 + 32 * s + 8 * fq);
            f32x4 outacc[2][4];
            {
                const int tmaxc = (4 * x + 3 + 15) >> 4;
                const bf16* kcb = KC + ((size_t)(b * 128 + fr) * 2 + g) * 64 + 8 * fq;
                bf16x8 pcf[2][4];
#pragma unroll
                for (int mt = 0; mt < 2; ++mt) {
                    f32x4 sc[8];
                    const bf16* kp = kcb;
#pragma unroll
                    for (int t = 0; t < 8; ++t) { sc[t] = (f32x4){0.f, 0.f, 0.f, 0.f};
                        asm volatile("" : "+v"(kp));
                        if (t < tmaxc) {
                            const bf16x8 k0 = *(const bf16x8*)(kp), k1 = *(const bf16x8*)(kp + 32);
                            sc[t] = __builtin_amdgcn_mfma_f32_16x16x32_bf16(k0, qf[mt][0], sc[t], 0, 0, 0);
                            sc[t] = __builtin_amdgcn_mfma_f32_16x16x32_bf16(k1, qf[mt][1], sc[t], 0, 0, 0); }
                        kp += 16 * 128; }
                    const int tg = 64 * x + tl0 + 4 * mt; const int ncv = tg >= 31 ? ((tg - 31) >> 4) + 1 : 0;
                    float mx = -INFINITY;
#pragma unroll
                    for (int t = 0; t < 8; ++t)
#pragma unroll
                        for (int r = 0; r < 4; ++r) { const bool v = 16 * t + 4 * fq + r < ncv; sc[t][r] = v ? sc[t][r] : -INFINITY; mx = fmaxf(mx, sc[t][r]); }
                    mx = fmaxf(mx, __shfl_xor(mx, 16)); mx = fmaxf(mx, __shfl_xor(mx, 32));
                    const float mxs = mx == -INFINITY ? 0.f : mx;
                    float sum = 0.f;
#pragma unroll
                    for (int t = 0; t < 8; ++t)
#pragma unroll
                        for (int r = 0; r < 4; ++r) { sc[t][r] = __expf(sc[t][r] - mxs); sum += sc[t][r]; }
                    sum += __shfl_xor(sum, 16); sum += __shfl_xor(sum, 32);
                    const float inv = sum > 0.f ? 1.f / sum : 0.f;
#pragma unroll
                    for (int t = 0; t < 8; ++t) sc[t] = sc[t] * inv;
#pragma unroll
                    for (int s = 0; s < 4; ++s) { u32x4 w; w.x = pk2(sc[2 * s].x, sc[2 * s].y); w.y = pk2(sc[2 * s].z, sc[2 * s].w); w.z = pk2(sc[2 * s + 1].x, sc[2 * s + 1].y); w.w = pk2(sc[2 * s + 1].z, sc[2 * s + 1].w);
                        pcf[mt][s] = __builtin_bit_cast(bf16x8, w); }
                    float w3[8];
#pragma unroll
                    for (int t = 0; t < 8; ++t) {
#pragma unroll
                        for (int r = 0; r < 4; ++r) { float v = sc[t][r]; v += __shfl_xor(v, 1); v += __shfl_xor(v, 2); sc[t][r] = v; }
                        w3[t] = __shfl(sc[t].w, (lane + 48) & 63);
                    }
#pragma unroll
                    for (int t = 0; t < 8; ++t) {
                        const float prev = fq > 0 ? w3[t] : (t > 0 ? w3[t > 0 ? t - 1 : 0] : 0.f);
                        const float imp = sc[t].x + sc[t].y + sc[t].z + 0.5f * sc[t].w + 0.5f * prev;
                        if ((fr & 3) == 0) scl[(4 * mt + (fr >> 2)) * 32 + 4 * t + fq] = imp;
                    }
                    asm volatile("" ::: "memory");
                }
                const bf16* vcb = VCT + ((size_t)(b * 2 + g) * 64 + fr) * 128 + 8 * fq;
#pragma unroll
                for (int n = 0; n < 4; ++n) {
                    outacc[0][n] = (f32x4){0.f, 0.f, 0.f, 0.f}; outacc[1][n] = (f32x4){0.f, 0.f, 0.f, 0.f};
                    asm volatile("" : "+v"(vcb));
#pragma unroll
                    for (int s = 0; s < 4; ++s) if (2 * s < tmaxc) {
                        const bf16x8 vf = *(const bf16x8*)(vcb + 32 * s);
                        outacc[0][n] = __builtin_amdgcn_mfma_f32_16x16x32_bf16(vf, pcf[0][s], outacc[0][n], 0, 0, 0);
                        outacc[1][n] = __builtin_amdgcn_mfma_f32_16x16x32_bf16(vf, pcf[1][s], outacc[1][n], 0, 0, 0); }
                    vcb += 16 * 128;
                    asm volatile("" ::: "memory");
                }
            }
            float g1v[2], g2v[2];
#pragma unroll
            for (int mt = 0; mt < 2; ++mt) {
                const int head = g * 4 + (fr & 3);
                const bf16* gl = HY + (tokbase + tl0 + 4 * mt) * HYN + C_GA + head * 3;
                const float g0 = sigmoidf_(bf2f(gl[0]) + gb[head * 3 + 0]);
                g1v[mt] = sigmoidf_(bf2f(gl[1]) + gb[head * 3 + 1]); g2v[mt] = sigmoidf_(bf2f(gl[2]) + gb[head * 3 + 2]);
#pragma unroll
                for (int n = 0; n < 4; ++n) outacc[mt][n] = outacc[mt][n] * g0;
            }
            LDS_WAIT();
            asm volatile("" ::: "memory");
            {
                const int tok8 = lane >> 3, jg = lane & 7;
                float sj[32];
#pragma unroll
                for (int q = 0; q < 8; ++q) { const f32x4 v = *(const LAS f32x4*)(scl + tok8 * 32 + 4 * q); sj[4 * q] = v.x; sj[4 * q + 1] = v.y; sj[4 * q + 2] = v.z; sj[4 * q + 3] = v.w; }
#pragma unroll
                for (int j = 0; j < 32; ++j) sj[j] = j <= x ? sj[j] + ((j == 0 || j == x || j == x - 1) ? 1000.0f : 0.f) : -INFINITY;
                unsigned bits = 0u;
                const f32x4 mv = *(const LAS f32x4*)(scl + tok8 * 32 + 4 * jg);
#pragma unroll
                for (int q = 0; q < 4; ++q) {
                    const int j = 4 * jg + q;
                    const float mine = j <= x ? mv[q] + ((j == 0 || j == x || j == x - 1) ? 1000.0f : 0.f) : -INFINITY;
                    int rank = 0;
#pragma unroll
                    for (int jj = 0; jj < 32; ++jj) rank += (sj[jj] > mine || (sj[jj] == mine && jj < j)) ? 1 : 0;
                    bits |= (j <= x && rank < 8) ? (1u << j) : 0u;
                }
                bits |= __shfl_xor(bits, 1); bits |= __shfl_xor(bits, 2); bits |= __shfl_xor(bits, 4);
                if (jg == 0) { msk[wid * 8 + tok8] = bits; atomicOr((unsigned*)umask, bits); }
            }
            __syncthreads();
#pragma unroll 1
            for (int pass = 0; pass < 2; ++pass) {
                const int jlo = pass ? (x >= 4 ? x - 4 : 0) : 0;
                const unsigned inrange = (x >= 31 ? 0xffffffffu : ((2u << x) - 1u)) & ~((1u << jlo) - 1u);
                unsigned bmask = pass ? inrange : (*umask & inrange);
                const bf16* Kb = pass ? KW : KS; const int cg = (pass ? 10 : 8) + g;
                unsigned tm[2], wm[2];
#pragma unroll
                for (int mt = 0; mt < 2; ++mt) {
                    tm[mt] = pass ? 0xffffffffu : msk[wid * 8 + 4 * mt + (fr >> 2)];
                    wm[mt] = pass ? 0xffffffffu : (msk[wid * 8 + 4 * mt] | msk[wid * 8 + 4 * mt + 1] | msk[wid * 8 + 4 * mt + 2] | msk[wid * 8 + 4 * mt + 3]);
                    wm[mt] = __builtin_amdgcn_readfirstlane(wm[mt]);
                }
                f32x4 o[2][4]; float mrun[2], lrun[2];
#pragma unroll
                for (int mt = 0; mt < 2; ++mt) { mrun[mt] = -INFINITY; lrun[mt] = 0.f;
#pragma unroll
                    for (int n = 0; n < 4; ++n) o[mt][n] = (f32x4){0.f, 0.f, 0.f, 0.f}; }
                const int srow = tid >> 3, sc16 = tid & 7;
                u32x4 pk_, pv_;
                int j = __ffs(bmask) - 1;
                {   const bf16* ksrc = Kb + ((size_t)b * S + 64 * j + srow) * 128 + g * 64 + sc16 * 8; const bf16* vsrc = VTA + ((size_t)((b * 32 + j) * 12 + cg)) * 4096 + srow * 64 + sc16 * 8;
                    pk_ = *(const u32x4*)ksrc; pv_ = *(const u32x4*)vsrc; }
                int buf = 0;
                while (j >= 0) {
                    *(LAS u32x4*)(ktl + buf * 64 * RS + srow * RS + sc16 * 8) = pk_; *(LAS u32x4*)(vtl + buf * 64 * RS + srow * RS + sc16 * 8) = pv_;
                    bmask &= bmask - 1u;
                    const int jn = bmask ? __ffs(bmask) - 1 : -1;
                    if (jn >= 0) { const bf16* ksrc = Kb + ((size_t)b * S + 64 * jn + srow) * 128 + g * 64 + sc16 * 8; const bf16* vsrc = VTA + ((size_t)((b * 32 + jn) * 12 + cg)) * 4096 + srow * 64 + sc16 * 8;
                        pk_ = *(const u32x4*)ksrc; pv_ = *(const u32x4*)vsrc; }
                    __syncthreads();
                    const LAS bf16* kt = ktl + buf * 64 * RS + fr * RS + 8 * fq; const LAS bf16* vt = vtl + buf * 64 * RS + fr * RS + 8 * fq;
#pragma unroll
                    for (int mt = 0; mt < 2; ++mt) {
                        if (!((wm[mt] >> j) & 1u)) continue;
                        f32x4 sc[4];
#pragma unroll
                        for (int t = 0; t < 4; ++t) { sc[t] = (f32x4){0.f, 0.f, 0.f, 0.f};
                            sc[t] = __builtin_amdgcn_mfma_f32_16x16x32_bf16(*(const LAS bf16x8*)(kt + t * 16 * RS), qf[mt][0], sc[t], 0, 0, 0);
                            sc[t] = __builtin_amdgcn_mfma_f32_16x16x32_bf16(*(const LAS bf16x8*)(kt + t * 16 * RS + 32), qf[mt][1], sc[t], 0, 0, 0); }
                        const int tl = tl0 + 4 * mt;
                        const bool rowok = (tm[mt] >> j) & 1u;
                        const int kphi = j == x ? tl : 63;
                        const int kplo = (pass && j == x - 4) ? tl + 1 : 0;
                        float bm = -INFINITY;
#pragma unroll
                        for (int t = 0; t < 4; ++t)
#pragma unroll
                            for (int r = 0; r < 4; ++r) { const int kp = 16 * t + 4 * fq + r; const bool v = rowok && kp <= kphi && kp >= kplo; sc[t][r] = v ? sc[t][r] : -INFINITY; bm = fmaxf(bm, sc[t][r]); }
                        bm = fmaxf(bm, __shfl_xor(bm, 16)); bm = fmaxf(bm, __shfl_xor(bm, 32));
                        const float mn = fmaxf(mrun[mt], bm); const float mns = mn == -INFINITY ? 0.f : mn;
                        const float alpha = __expf(mrun[mt] - mns);
                        float rs = 0.f;
#pragma unroll
                        for (int t = 0; t < 4; ++t)
#pragma unroll
                            for (int r = 0; r < 4; ++r) { sc[t][r] = __expf(sc[t][r] - mns); rs += sc[t][r]; }
                        rs += __shfl_xor(rs, 16); rs += __shfl_xor(rs, 32);
                        lrun[mt] = lrun[mt] * alpha + rs; mrun[mt] = mn;
                        bf16x8 pf[2];
#pragma unroll
                        for (int s = 0; s < 2; ++s) { u32x4 w; w.x = pk2(sc[2 * s].x, sc[2 * s].y); w.y = pk2(sc[2 * s].z, sc[2 * s].w); w.z = pk2(sc[2 * s + 1].x, sc[2 * s + 1].y); w.w = pk2(sc[2 * s + 1].z, sc[2 * s + 1].w);
                            pf[s] = __builtin_bit_cast(bf16x8, w); }
#pragma unroll
                        for (int n = 0; n < 4; ++n) { o[mt][n] = o[mt][n] * alpha;
                            o[mt][n] = __builtin_amdgcn_mfma_f32_16x16x32_bf16(*(const LAS bf16x8*)(vt + n * 16 * RS), pf[0], o[mt][n], 0, 0, 0);
                            o[mt][n] = __builtin_amdgcn_mfma_f32_16x16x32_bf16(*(const LAS bf16x8*)(vt + n * 16 * RS + 32), pf[1], o[mt][n], 0, 0, 0); }
                    }
                    j = jn; buf ^= 1;
                }
#pragma unroll
                for (int mt = 0; mt < 2; ++mt) { const float sc_ = (pass ? g2v[mt] : g1v[mt]) / lrun[mt];
#pragma unroll
                    for (int n = 0; n < 4; ++n) outacc[mt][n] = outacc[mt][n] + o[mt][n] * sc_; }
                __syncthreads();
            }
#pragma unroll
            for (int mt = 0; mt < 2; ++mt) {
                bf16* dst = CAT + (tokbase + tl0 + 4 * mt) * 1024 + (g * 4 + (fr & 3)) * 64 + 4 * fq;
#pragma unroll
                for (int n = 0; n < 4; ++n) { u32x2 w; w.x = pk2(outacc[mt][n].x, outacc[mt][n].y); w.y = pk2(outacc[mt][n].z, outacc[mt][n].w); *(u32x2*)(dst + 16 * n) = w; }
            }
        }
    }
    __syncthreads();
}

__device__ __forceinline__ void phase_vtiles(KArgs A, int wv_, LAS unsigned char* lds) {
    const int tid_ = opaque_tid(wv_); const int wid = __builtin_amdgcn_readfirstlane(tid_ >> 6), lane = tid_ & 63; const int gw = blockIdx.x * 8 + wid, NGW = gridDim.x * 8;
    unsigned char* ws = opq(A->ws);
    const bf16* HY = (const bf16*)(ws + WS_BIG); bf16* VTA = (bf16*)(ws + WS_VTA);
    constexpr int TS = 66;
    LAS bf16* tl = (LAS bf16*)(lds + 65536) + wid * (64 * TS);
    for (int it = gw; it < NBATCH * 32 * 12; it += NGW) {
        const int cg = it % 12, bc = it / 12;
        const int colbase = cg < 8 ? C_VB + cg * 64 : (cg < 10 ? C_VS + (cg - 8) * 64 : C_VW + (cg - 10) * 64);
        const u32x4* src = (const u32x4*)(HY + (size_t)(bc * 64 + lane) * HYN + colbase);
        u32x4 w[8];
#pragma unroll
        for (int i = 0; i < 8; ++i) w[i] = src[i];
#pragma unroll
        for (int i = 0; i < 8; ++i) { LAS unsigned* d = (LAS unsigned*)(tl + lane * TS + 8 * i); d[0] = w[i].x; d[1] = w[i].y; d[2] = w[i].z; d[3] = w[i].w; }
        LDS_WAIT();
        bf16* dst = VTA + (size_t)it * 4096 + lane * 64;
#pragma unroll
        for (int p8 = 0; p8 < 8; ++p8) {
            unsigned short x[8];
#pragma unroll
            for (int j = 0; j < 8; ++j) x[j] = tl[kperm64(p8 * 8 + j) * TS + lane];
            u32x4 o; o.x = x[0] | ((unsigned)x[1] << 16); o.y = x[2] | ((unsigned)x[3] << 16); o.z = x[4] | ((unsigned)x[5] << 16); o.w = x[6] | ((unsigned)x[7] << 16);
            *(u32x4*)(dst + p8 * 8) = o;
        }
        LDS_WAIT();
    }
}

__device__ __forceinline__ float log_sigmoid16(float z) { return (fminf(z, 0.f) - __logf(1.0f + __expf(-fabsf(z)))) * (1.f / 16.f); }
#define GLA_Z(tokv) ({ float z_ = bias; _Pragma("unroll") for (int r_ = 0; r_ < 16; ++r_) z_ += __builtin_bit_cast(float, __builtin_amdgcn_readlane(__builtin_bit_cast(int, al[r_]), (tokv))) * wc[r_]; z_; })
#define GLA_LOAD_GATE() \
    float al[16], wc[16]; \
    { const u32x4* ap_ = (const u32x4*)(HY + (size_t)(tok0 + lane) * HYN + C_AL); const u32x4 a0_ = ap_[0], a1_ = ap_[1]; \
      al[0] = bflo(a0_.x); al[1] = bfhi(a0_.x); al[2] = bflo(a0_.y); al[3] = bfhi(a0_.y); al[4] = bflo(a0_.z); al[5] = bfhi(a0_.z); al[6] = bflo(a0_.w); al[7] = bfhi(a0_.w); \
      al[8] = bflo(a1_.x); al[9] = bfhi(a1_.x); al[10] = bflo(a1_.y); al[11] = bfhi(a1_.y); al[12] = bflo(a1_.z); al[13] = bfhi(a1_.z); al[14] = bflo(a1_.w); al[15] = bfhi(a1_.w); } \
    _Pragma("unroll") for (int r_ = 0; r_ < 16; ++r_) wc[r_] = A->in[I_WA2][(i * 16 + r_) * 256 + h * 64 + lane]; \
    const float bias = A->in[I_BA][i * 256 + h * 64 + lane];

__device__ __forceinline__ void phase_gla_a(KArgs A, int wv_, int i, LAS unsigned char* lds) {
    const int tid_ = opaque_tid(wv_); const int wid = __builtin_amdgcn_readfirstlane(tid_ >> 6), lane = tid_ & 63, fr = lane & 15, fq = lane >> 4; const int gw = blockIdx.x * 8 + wid, NGW = gridDim.x * 8;
    unsigned char* ws = opq(A->ws);
    const bf16* HY = (const bf16*)(ws + WS_BIG); const bf16* VTA = (const bf16*)(ws + WS_VTA); float* SLOC = (float*)(ws + WS_SLOC); float* DEC = (float*)(ws + WS_DEC);
    constexpr int RS = 72;
    LAS bf16* kh = (LAS bf16*)lds + wid * (64 * RS);
    (void)gw;
    for (int it = wid * (int)gridDim.x + (int)blockIdx.x; it < 1024; it += NGW) {
        const int c = it & 31, bh = it >> 5, b = bh >> 2, h = bh & 3; const size_t tok0 = (size_t)b * S + c * 64;
        GLA_LOAD_GATE();
        float bl = 0.f;
#pragma unroll 4
        for (int tk = 0; tk < 64; ++tk) bl += log_sigmoid16(GLA_Z(tk));
        float bc = 0.f;
#pragma unroll 4
        for (int tk = 0; tk < 64; ++tk) {
            bc += log_sigmoid16(GLA_Z(tk));
            const float kv = bf2f(HY[(tok0 + tk) * HYN + C_KB + h * 64 + lane]);
            kh[lane * RS + kpos64(tk)] = (bf16)f2bf(kv * __expf(bl - bc));
        }
        DEC[it * 64 + lane] = __expf(bl);
        LDS_WAIT();
#pragma unroll
        for (int dvh = 0; dvh < 2; ++dvh) {
            const bf16* vt = VTA + ((size_t)((b * 32 + c) * 12 + h * 2 + dvh)) * 4096;
            bf16x8 vf[4][2];
#pragma unroll
            for (int n = 0; n < 4; ++n)
#pragma unroll
                for (int s = 0; s < 2; ++s) vf[n][s] = *(const bf16x8*)(vt + (16 * n + fr) * 64 + 32 * s + 8 * fq);
#pragma unroll
            for (int m = 0; m < 4; ++m) {
                const bf16x8 a0 = *(const LAS bf16x8*)(kh + (16 * m + fr) * RS + 8 * fq), a1 = *(const LAS bf16x8*)(kh + (16 * m + fr) * RS + 32 + 8 * fq);
#pragma unroll
                for (int n = 0; n < 4; ++n) {
                    f32x4 acc = (f32x4){0.f, 0.f, 0.f, 0.f};
                    acc = __builtin_amdgcn_mfma_f32_16x16x32_bf16(a0, vf[n][0], acc, 0, 0, 0);
                    acc = __builtin_amdgcn_mfma_f32_16x16x32_bf16(a1, vf[n][1], acc, 0, 0, 0);
                    float* dst = SLOC + ((size_t)it * 64 + 16 * m + 4 * fq) * 128 + dvh * 64 + 16 * n + fr;
                    dst[0] = acc.x; dst[128] = acc.y; dst[256] = acc.z; dst[384] = acc.w;
                }
            }
        }
        LDS_WAIT();
    }
}
__device__ __forceinline__ void phase_gla_c(KArgs A, int wv_, int i, LAS unsigned char* lds) {
    const int tid_ = opaque_tid(wv_); const int wid = __builtin_amdgcn_readfirstlane(tid_ >> 6), lane = tid_ & 63, fr = lane & 15, fq = lane >> 4; const int gw = blockIdx.x * 8 + wid, NGW = gridDim.x * 8;
    unsigned char* ws = opq(A->ws);
    const bf16* HY = (const bf16*)(ws + WS_BIG); const bf16* VTA = (const bf16*)(ws + WS_VTA); const bf16* STT = (const bf16*)(ws + WS_STT); bf16* CAT = (bf16*)(ws + WS_CAT);
    constexpr int RS = 72;
    LAS bf16* qs = (LAS bf16*)lds + wid * (128 * RS);
    LAS bf16* ks = qs + 64 * RS;
    const float* og = A->in[I_ONORM] + i * 128;
    (void)gw; (void)NGW;
    for (int blk = blockIdx.x; blk < 128; blk += gridDim.x) {
        {
            const float* SLOC = (const float*)(ws + WS_SLOC); const float* DEC = (const float*)(ws + WS_DEC); bf16* STw = (bf16*)(ws + WS_STT);
            const int tid = tid_, dv = tid & 127, ko = tid >> 7, bh = blk >> 2, c0 = (blk & 3) * 8;
            float sv[16];
#pragma unroll
            for (int j = 0; j < 16; ++j) sv[j] = 0.f;
#pragma unroll 2
            for (int c = 0; c < c0 + 8; ++c) {
                const size_t item = (size_t)bh * 32 + c;
                if (c >= c0) {
                    u32x4 o0, o1; o0.x = pk2(sv[0], sv[1]); o0.y = pk2(sv[2], sv[3]); o0.z = pk2(sv[4], sv[5]); o0.w = pk2(sv[6], sv[7]);
                    o1.x = pk2(sv[8], sv[9]); o1.y = pk2(sv[10], sv[11]); o1.z = pk2(sv[12], sv[13]); o1.w = pk2(sv[14], sv[15]);
                    u32x4* d = (u32x4*)(STw + (item * 128 + dv) * 64 + ko * 16); d[0] = o0; d[1] = o1;
                }
                if (c < c0 + 7) {
                    const float* sl = SLOC + (item * 64 + ko * 16) * 128 + dv; const float* dc = DEC + item * 64 + ko * 16;
#pragma unroll
                    for (int j = 0; j < 16; ++j) sv[j] = dc[j] * sv[j] + sl[j * 128];
                }
            }
            asm volatile("s_waitcnt vmcnt(0)" ::: "memory");
            __syncthreads();
        }
        const int it = blk * 8 + wid;
        const int c = it & 31, bh = it >> 5, b = bh >> 2, h = bh & 3; const size_t tok0 = (size_t)b * S + c * 64;
        GLA_LOAD_GATE();
        float bc = 0.f;
#pragma unroll 4
        for (int tk = 0; tk < 64; ++tk) {
            bc += log_sigmoid16(GLA_Z(tk));
            const bf16* row = HY + (tok0 + tk) * HYN;
            const float qv = bf2f(row[C_QB + h * 64 + lane]) * 0.125f, kv = bf2f(row[C_KB + h * 64 + lane]);
            qs[tk * RS + lane] = (bf16)f2bf(qv * __expf(bc)); ks[tk * RS + lane] = (bf16)f2bf(kv * __expf(-bc));
        }
        LDS_WAIT();
        bf16x8 st[8][2];
#pragma unroll
        for (int n = 0; n < 8; ++n)
#pragma unroll
            for (int s = 0; s < 2; ++s) st[n][s] = *(const bf16x8*)(STT + ((size_t)it * 128 + 16 * n + fr) * 64 + 32 * s + 8 * fq);
        const bf16* vt = VTA + ((size_t)((b * 32 + c) * 12 + h * 2)) * 4096;
#pragma unroll
        for (int mi = 0; mi < 4; ++mi) {
            const bf16x8 q0 = *(const LAS bf16x8*)(qs + (16 * mi + fr) * RS + 8 * fq), q1 = *(const LAS bf16x8*)(qs + (16 * mi + fr) * RS + 32 + 8 * fq);
            f32x4 sc[4];
#pragma unroll
            for (int t = 0; t < 4; ++t) {
                sc[t] = (f32x4){0.f, 0.f, 0.f, 0.f};
                if (t <= mi) {
                    const bf16x8 k0 = *(const LAS bf16x8*)(ks + (16 * t + fr) * RS + 8 * fq), k1 = *(const LAS bf16x8*)(ks + (16 * t + fr) * RS + 32 + 8 * fq);
                    sc[t] = __builtin_amdgcn_mfma_f32_16x16x32_bf16(k0, q0, sc[t], 0, 0, 0);
                    sc[t] = __builtin_amdgcn_mfma_f32_16x16x32_bf16(k1, q1, sc[t], 0, 0, 0);
                    if (t == mi) {
                        sc[t].x = (4 * fq + 0 <= fr) ? sc[t].x : 0.f; sc[t].y = (4 * fq + 1 <= fr) ? sc[t].y : 0.f; sc[t].z = (4 * fq + 2 <= fr) ? sc[t].z : 0.f; sc[t].w = (4 * fq + 3 <= fr) ? sc[t].w : 0.f; }
                }
            }
            bf16x8 pf[2];
#pragma unroll
            for (int s = 0; s < 2; ++s) { u32x4 w; w.x = pk2(sc[2 * s].x, sc[2 * s].y); w.y = pk2(sc[2 * s].z, sc[2 * s].w); w.z = pk2(sc[2 * s + 1].x, sc[2 * s + 1].y); w.w = pk2(sc[2 * s + 1].z, sc[2 * s + 1].w);
                pf[s] = __builtin_bit_cast(bf16x8, w); }
            f32x4 o[8]; float ssq = 0.f;
#pragma unroll
            for (int n = 0; n < 8; ++n) {
                o[n] = (f32x4){0.f, 0.f, 0.f, 0.f};
                o[n] = __builtin_amdgcn_mfma_f32_16x16x32_bf16(st[n][0], q0, o[n], 0, 0, 0);
                o[n] = __builtin_amdgcn_mfma_f32_16x16x32_bf16(st[n][1], q1, o[n], 0, 0, 0);
                const bf16* vrow = vt + (size_t)(n >> 2) * 4096 + (16 * (n & 3) + fr) * 64 + 8 * fq;
                o[n] = __builtin_amdgcn_mfma_f32_16x16x32_bf16(*(const bf16x8*)vrow, pf[0], o[n], 0, 0, 0);
                if (mi >= 2) o[n] = __builtin_amdgcn_mfma_f32_16x16x32_bf16(*(const bf16x8*)(vrow + 32), pf[1], o[n], 0, 0, 0);
                ssq += (o[n].x * o[n].x + o[n].y * o[n].y) + (o[n].z * o[n].z + o[n].w * o[n].w);
            }
            ssq += __shfl_xor(ssq, 16); ssq += __shfl_xor(ssq, 32);
            const float rstd = rsqrtf(ssq * (1.f / 128.f) + EPS);
            const size_t tok = tok0 + 16 * mi + fr;
#pragma unroll
            for (int n = 0; n < 8; ++n) {
                const int dv = 16 * n + 4 * fq;
                const u32x2 rw = *(const u32x2*)(HY + tok * HYN + C_RB + h * 128 + dv); const f32x4 g = *(const f32x4*)(og + dv);
                const float r0 = bflo(rw.x), r1 = bfhi(rw.x), r2 = bflo(rw.y), r3 = bfhi(rw.y);
                u32x2 w; w.x = pk2(o[n].x * rstd * g.x * (r0 * sigmoidf_(r0)), o[n].y * rstd * g.y * (r1 * sigmoidf_(r1)));
                w.y = pk2(o[n].z * rstd * g.z * (r2 * sigmoidf_(r2)), o[n].w * rstd * g.w * (r3 * sigmoidf_(r3)));
                *(u32x2*)(CAT + tok * 1024 + 512 + h * 128 + dv) = w;
            }
        }
        LDS_WAIT();
        __syncthreads();
    }
}

__device__ __forceinline__ void phase_sgu_mix(KArgs A, int wv_, int i, LAS unsigned char* lds) {
    const int tid = opaque_tid(wv_), wid = __builtin_amdgcn_readfirstlane(tid >> 6), lane = tid & 63;
    unsigned char* ws = opq(A->ws);
    const bf16* U = (const bf16*)(ws + WS_U); const bf16* V = (const bf16*)(ws + WS_V); bf16* UM = (bf16*)(ws + WS_UM);
    LAS float* vt = (LAS float*)lds;
    LAS float* st = vt + 128 * 256;
    const float* lng = A->in[I_LNG] + i * 2048; const float* lnb = A->in[I_LNB] + i * 2048;
    for (int it = blockIdx.x; it < NBATCH * 16 * 8; it += gridDim.x) {
        const int g = it & 7, n = (it >> 3) & 15, b = it >> 7;
        const size_t tok0 = (size_t)b * S + n * 128;
        __syncthreads();
        for (int s = wid * 16; s < wid * 16 + 16; ++s) {
            const u32x4* vr = (const u32x4*)(V + (tok0 + s) * 2048) + lane;
            float x[32]; float sum = 0.f;
#pragma unroll
            for (int j = 0; j < 4; ++j) { const u32x4 w = vr[64 * j];
                x[8 * j + 0] = bflo(w.x); x[8 * j + 1] = bfhi(w.x); x[8 * j + 2] = bflo(w.y); x[8 * j + 3] = bfhi(w.y); x[8 * j + 4] = bflo(w.z); x[8 * j + 5] = bfhi(w.z); x[8 * j + 6] = bflo(w.w); x[8 * j + 7] = bfhi(w.w); }
#pragma unroll
            for (int j = 0; j < 32; ++j) sum += x[j];
            const float mean = wave_sum(sum) * (1.f / 2048.f); float q = 0.f;
#pragma unroll
            for (int j = 0; j < 32; ++j) { const float d = x[j] - mean; q += d * d; }
            const float rstd = rsqrtf(wave_sum(q) * (1.f / 2048.f) + EPS);
            const u32x2 w = *((const u32x2*)(V + (tok0 + s) * 2048 + g * 256) + lane);
            const f32x4 gg = *(const f32x4*)(lng + g * 256 + 4 * lane), bb = *(const f32x4*)(lnb + g * 256 + 4 * lane);
            f32x4 o; o.x = (bflo(w.x) - mean) * rstd * gg.x + bb.x; o.y = (bfhi(w.x) - mean) * rstd * gg.y + bb.y; o.z = (bflo(w.y) - mean) * rstd * gg.z + bb.z; o.w = (bfhi(w.y) - mean) * rstd * gg.w + bb.w;
            *(LAS f32x4*)(vt + s * 256 + 4 * lane) = o;
            (void)st;
        }
        __syncthreads();
        const int c = tid & 255, th = tid >> 8;
        const float* wsg = A->in[I_SGWS] + (size_t)(i * 8 + g) * 128 * 128; const float* bsg = A->in[I_SGBS] + (i * 8 + g) * 128;
        for (int tt = 0; tt < 64; ++tt) {
            const int t = 2 * tt + th;
            const float* wr = wsg + t * 128;
            float acc = 0.f;
            for (int s = 0; s <= t; ++s) acc += wr[s] * vt[s * 256 + c];
            acc += bsg[t];
            const float u = bf2f(U[(tok0 + t) * 2048 + g * 256 + c]);
            UM[(tok0 + t) * 2048 + g * 256 + c] = (bf16)f2bf(u * acc);
        }
    }
    __syncthreads();
}


__device__ __forceinline__ void phase_sgu_mix_mfma(KArgs A, int wv_, int i, LAS unsigned char* lds) {
    const int tid = opaque_tid(wv_), wid = __builtin_amdgcn_readfirstlane(tid >> 6), lane = tid & 63, fr = lane & 15, fq = lane >> 4;
    unsigned char* ws = opq(A->ws);
    const bf16* U = (const bf16*)(ws + WS_U); const bf16* V = (const bf16*)(ws + WS_V); bf16* UM = (bf16*)(ws + WS_UM);
    const bf16* WSB = (const bf16*)(ws + WS_WSB) + (size_t)i * 8 * 16384; const float* M0 = (const float*)(ws + WS_M0) + i * 8 * 128;
    constexpr int VS = 136;
    LAS bf16* vT = (LAS bf16*)lds;
    LAS float* st = (LAS float*)(lds + 256 * VS * 2);
    const float* lng = A->in[I_LNG] + i * 2048; const float* lnb = A->in[I_LNB] + i * 2048; const float* bsg = A->in[I_SGBS] + i * 8 * 128;
    for (int it = blockIdx.x; it < 256; it += gridDim.x) {
        const int gh = it & 1, n_ = (it >> 1) & 15, b = it >> 5; const size_t tok0 = (size_t)b * S + n_ * 128;
        __syncthreads();
        for (int s = wid * 16; s < wid * 16 + 16; ++s) {
            const u32x4* vr = (const u32x4*)(V + (tok0 + s) * 2048) + lane;
            float x[32]; float sum = 0.f;
#pragma unroll
            for (int j = 0; j < 4; ++j) { const u32x4 w = vr[64 * j];
                x[8 * j + 0] = bflo(w.x); x[8 * j + 1] = bfhi(w.x); x[8 * j + 2] = bflo(w.y); x[8 * j + 3] = bfhi(w.y); x[8 * j + 4] = bflo(w.z); x[8 * j + 5] = bfhi(w.z); x[8 * j + 6] = bflo(w.w); x[8 * j + 7] = bfhi(w.w); }
#pragma unroll
            for (int j = 0; j < 32; ++j) sum += x[j];
            const float mean = wave_sum(sum) * (1.f / 2048.f); float q = 0.f;
#pragma unroll
            for (int j = 0; j < 32; ++j) { const float d = x[j] - mean; q += d * d; }
            const float rstd = rsqrtf(wave_sum(q) * (1.f / 2048.f) + EPS);
            if (lane == 0) { st[2 * s] = mean; st[2 * s + 1] = rstd; }
        }
#pragma unroll 1
        for (int gg = 0; gg < 4; ++gg) {
            const int g = gh * 4 + gg;
            __syncthreads();
            {
                const int s = tid & 127, cq = tid >> 7;
                const float mean = st[2 * s], rstd = st[2 * s + 1];
                const u32x4* src = (const u32x4*)(V + (tok0 + s) * 2048 + g * 256 + cq * 64);
#pragma unroll
                for (int i8 = 0; i8 < 8; ++i8) {
                    const u32x4 w = src[i8];
                    LAS bf16* d = vT + (cq * 64 + i8 * 8) * VS + s;
                    d[0 * VS] = (bf16)f2bf((bflo(w.x) - mean) * rstd); d[1 * VS] = (bf16)f2bf((bfhi(w.x) - mean) * rstd); d[2 * VS] = (bf16)f2bf((bflo(w.y) - mean) * rstd); d[3 * VS] = (bf16)f2bf((bfhi(w.y) - mean) * rstd);
                    d[4 * VS] = (bf16)f2bf((bflo(w.z) - mean) * rstd); d[5 * VS] = (bf16)f2bf((bfhi(w.z) - mean) * rstd); d[6 * VS] = (bf16)f2bf((bflo(w.w) - mean) * rstd); d[7 * VS] = (bf16)f2bf((bfhi(w.w) - mean) * rstd);
                }
            }
            __syncthreads();
            bf16x8 vf[2][4];
#pragma unroll
            for (int m = 0; m < 2; ++m)
#pragma unroll
                for (int k = 0; k < 4; ++k) vf[m][k] = *(const LAS bf16x8*)(vT + (32 * wid + 16 * m + fr) * VS + 32 * k + 8 * fq);
            const bf16* wb = WSB + ((size_t)g * 128 + fr) * 128 + 8 * fq;
            f32x4 gc[2], bc[2];
#pragma unroll
            for (int m = 0; m < 2; ++m) { gc[m] = *(const f32x4*)(lng + g * 256 + 32 * wid + 16 * m + 4 * fq); bc[m] = *(const f32x4*)(lnb + g * 256 + 32 * wid + 16 * m + 4 * fq); }
#pragma unroll
            for (int n = 0; n < 8; ++n) {
                f32x4 a0 = (f32x4){0.f, 0.f, 0.f, 0.f}, a1 = (f32x4){0.f, 0.f, 0.f, 0.f};
                asm volatile("" : "+v"(wb));
#pragma unroll
                for (int k = 0; k < 4; ++k) if (k <= (n >> 1)) {
                    const bf16x8 wf = *(const bf16x8*)(wb + 32 * k);
                    a0 = __builtin_amdgcn_mfma_f32_16x16x32_bf16(vf[0][k], wf, a0, 0, 0, 0);
                    a1 = __builtin_amdgcn_mfma_f32_16x16x32_bf16(vf[1][k], wf, a1, 0, 0, 0); }
                wb += 16 * 128;
                const int t = 16 * n + fr; const float m0 = M0[g * 128 + t], bsv = bsg[g * 128 + t];
                const size_t ro = (tok0 + t) * 2048 + g * 256 + 32 * wid + 4 * fq;
#pragma unroll
                for (int m = 0; m < 2; ++m) {
                    const f32x4 a = m ? a1 : a0;
                    const u32x2 uw = *(const u32x2*)(U + ro + 16 * m);
                    u32x2 w; w.x = pk2((a.x * gc[m].x + bc[m].x * m0 + bsv) * bflo(uw.x), (a.y * gc[m].y + bc[m].y * m0 + bsv) * bfhi(uw.x));
                    w.y = pk2((a.z * gc[m].z + bc[m].z * m0 + bsv) * bflo(uw.y), (a.w * gc[m].w + bc[m].w * m0 + bsv) * bfhi(uw.y));
                    *(u32x2*)(UM + ro + 16 * m) = w;
                }
                asm volatile("" ::: "memory");
            }
        }
    }
    __syncthreads();
}

__device__ __forceinline__ void phase_rownorm(KArgs A, int wv_) {
    const int tid_ = opaque_tid(wv_); const int wid = __builtin_amdgcn_readfirstlane(tid_ >> 6), lane = tid_ & 63; const int gw = blockIdx.x * 8 + wid, NGW = gridDim.x * 8;
    for (int m = gw; m < T; m += NGW) rms_row_to_bf16(A->out + (size_t)m * D, (bf16*)(opq(A->ws) + WS_XN) + (size_t)m * D, nullptr, lane);
}

__device__ __forceinline__ void phase_xattn(KArgs A, int wv_, int L, LAS unsigned char* lds) {
    const int tid = opaque_tid(wv_), wid = __builtin_amdgcn_readfirstlane(tid >> 6), lane = tid & 63;
    unsigned char* ws = opq(A->ws);
    const bf16* QX = (const bf16*)(ws + WS_QX); const bf16* KV = (const bf16*)(ws + WS_KV); bf16* OX = (bf16*)(ws + WS_OX);
    constexpr int KSTR = 129;
    LAS unsigned* kl = (LAS unsigned*)lds;
    LAS float* qb = (LAS float*)(lds + 132096) + wid * 256;
    LAS float* pb = (LAS float*)(lds + 132096 + 8192) + wid * 256;
    const float* qg = A->in[I_XQN] + L * 256;
    for (int it = blockIdx.x; it < NBATCH * 4 * 8; it += gridDim.x) {
        const int qc = it & 7, h = (it >> 3) & 3, b = it >> 5;
        __syncthreads();
        for (int e = tid; e < 256 * 128; e += 512) { const int m = e >> 7, dw = e & 127;
            kl[m * KSTR + dw] = *((const unsigned*)(KV + (size_t)(b * 256 + m) * 8192 + L * 2048 + h * 256) + dw); }
        __syncthreads();
        const bf16* Vb = KV + (size_t)(b * 256) * 8192 + L * 2048 + 1024 + h * 256;
        for (int tq = 0; tq < 32; ++tq) {
            const size_t tok = (size_t)b * S + qc * 256 + wid * 32 + tq;
            const u32x2 qw = *((const u32x2*)(QX + tok * 1024 + h * 256) + lane);
            const float q0 = bflo(qw.x), q1 = bfhi(qw.x), q2 = bflo(qw.y), q3 = bfhi(qw.y);
            const float rstd = rsqrtf(wave_sum(q0 * q0 + q1 * q1 + q2 * q2 + q3 * q3) * (1.f / 256.f) + EPS);
            const f32x4 gg = *(const f32x4*)(qg + 4 * lane);
            *(LAS f32x4*)(qb + 4 * lane) = (f32x4){q0 * rstd * gg.x, q1 * rstd * gg.y, q2 * rstd * gg.z, q3 * rstd * gg.w};
            LDS_WAIT();
            float s0 = 0.f, s1 = 0.f, s2 = 0.f, s3 = 0.f;
#pragma unroll 4
            for (int dw = 0; dw < 128; ++dw) {
                const f32x2 qq = *(const LAS f32x2*)(qb + 2 * dw);
                const unsigned k0 = kl[lane * KSTR + dw], k1 = kl[(lane + 64) * KSTR + dw], k2 = kl[(lane + 128) * KSTR + dw], k3 = kl[(lane + 192) * KSTR + dw];
                s0 += qq.x * bflo(k0) + qq.y * bfhi(k0); s1 += qq.x * bflo(k1) + qq.y * bfhi(k1);
                s2 += qq.x * bflo(k2) + qq.y * bfhi(k2); s3 += qq.x * bflo(k3) + qq.y * bfhi(k3);
            }
            const float mx = wave_max(fmaxf(fmaxf(s0, s1), fmaxf(s2, s3)));
            const float e0 = __expf(s0 - mx), e1 = __expf(s1 - mx), e2 = __expf(s2 - mx), e3 = __expf(s3 - mx);
            const float inv = 1.f / wave_sum((e0 + e1) + (e2 + e3));
            pb[lane] = e0 * inv; pb[lane + 64] = e1 * inv; pb[lane + 128] = e2 * inv; pb[lane + 192] = e3 * inv;
            LDS_WAIT();
            float o0 = 0.f, o1 = 0.f, o2 = 0.f, o3 = 0.f;
#pragma unroll 8
            for (int m = 0; m < 256; ++m) {
                const float p = pb[m];
                const u32x2 vw = *((const u32x2*)(Vb + (size_t)m * 8192) + lane);
                o0 += p * bflo(vw.x); o1 += p * bfhi(vw.x); o2 += p * bflo(vw.y); o3 += p * bfhi(vw.y);
            }
            u32x2 ow; ow.x = pk2(o0, o1); ow.y = pk2(o2, o3);
            *((u32x2*)(OX + tok * 1024 + h * 256) + lane) = ow;
            LDS_WAIT();
        }
    }
    __syncthreads();
}


__device__ __forceinline__ int kperm32(int p) { const int fq = (p >> 3) & 3, j = p & 7; return (p & ~31) + 16 * (j >> 2) + 4 * fq + (j & 3); }
__device__ __forceinline__ void phase_vtrans(KArgs A, int wv_, LAS unsigned char* lds) {
    const int tid = opaque_tid(wv_);
    unsigned char* ws = opq(A->ws);
    const bf16* KV = (const bf16*)(ws + WS_KV); bf16* VT = (bf16*)(ws + WS_VT);
    LAS bf16* vt = (LAS bf16*)lds;
    constexpr int VS = 258;
    for (int it = blockIdx.x; it < DEPTH * NBATCH * 4; it += gridDim.x) {
        const int h = it & 3, b = (it >> 2) & 7, l = it >> 5;
        __syncthreads();
        for (int e = tid; e < 256 * 32; e += 512) { const int m = e >> 5, c8 = e & 31;
            const u32x4 w = *(const u32x4*)(KV + (size_t)(b * 256 + m) * 8192 + l * 2048 + 1024 + h * 256 + c8 * 8);
            LAS unsigned* d = (LAS unsigned*)(vt + m * VS + c8 * 8); d[0] = w.x; d[1] = w.y; d[2] = w.z; d[3] = w.w; }
        __syncthreads();
        for (int e = tid; e < 256 * 32; e += 512) { const int dv = e & 255, p8 = e >> 8;
            unsigned short x[8];
#pragma unroll
            for (int j = 0; j < 8; ++j) x[j] = vt[kperm32(p8 * 8 + j) * VS + dv];
            u32x4 o; o.x = x[0] | ((unsigned)x[1] << 16); o.y = x[2] | ((unsigned)x[3] << 16); o.z = x[4] | ((unsigned)x[5] << 16); o.w = x[6] | ((unsigned)x[7] << 16);
            *(u32x4*)(VT + ((size_t)it * 256 + dv) * 256 + p8 * 8) = o; }
    }
    __syncthreads();
}

__device__ __forceinline__ void phase_xattn_mfma(KArgs A, int wv_, int L, LAS unsigned char* lds) {
    const int tid = opaque_tid(wv_), wid = __builtin_amdgcn_readfirstlane(tid >> 6), lane = tid & 63, fr = lane & 15, fq = lane >> 4;
    unsigned char* ws = opq(A->ws);
    const bf16* QX = (const bf16*)(ws + WS_QX); const bf16* KV = (const bf16*)(ws + WS_KV); const bf16* VT = (const bf16*)(ws + WS_VT); bf16* OX = (bf16*)(ws + WS_OX);
    constexpr int RS = 264;
    LAS bf16* kl = (LAS bf16*)lds;
    const float* qg = A->in[I_XQN] + L * 256;
    for (int it = blockIdx.x; it < NBATCH * 4 * 16; it += gridDim.x) {
        const int qt = it & 15, h = (it >> 4) & 3, b = it >> 6;
        __syncthreads();
        {
            const int row = tid >> 1, hf = tid & 1;
            const u32x4* src = (const u32x4*)(KV + (size_t)(b * 256 + row) * 8192 + L * 2048 + h * 256 + hf * 128);
#pragma unroll
            for (int i0 = 0; i0 < 16; i0 += 8) {
                u32x4 w[8];
#pragma unroll
                for (int i = 0; i < 8; ++i) w[i] = src[i0 + i];
#pragma unroll
                for (int i = 0; i < 8; ++i) *(LAS u32x4*)(kl + row * RS + hf * 128 + (i0 + i) * 8) = w[i];
            }
        }
        const size_t tok = (size_t)b * S + qt * 128 + wid * 16 + fr;
        bf16x8 qf[8];
        {
            u32x4 qw[8]; float ssq = 0.f;
#pragma unroll
            for (int s = 0; s < 8; ++s) qw[s] = *(const u32x4*)(QX + tok * 1024 + h * 256 + 32 * s + 8 * fq);
#pragma unroll
            for (int s = 0; s < 8; ++s) {
                const float a0 = bflo(qw[s].x), a1 = bfhi(qw[s].x), a2 = bflo(qw[s].y), a3 = bfhi(qw[s].y), a4 = bflo(qw[s].z), a5 = bfhi(qw[s].z), a6 = bflo(qw[s].w), a7 = bfhi(qw[s].w);
                ssq += (a0 * a0 + a1 * a1) + (a2 * a2 + a3 * a3) + (a4 * a4 + a5 * a5) + (a6 * a6 + a7 * a7);
            }
            ssq += __shfl_xor(ssq, 16); ssq += __shfl_xor(ssq, 32);
            const float rstd = rsqrtf(ssq * (1.f / 256.f) + EPS);
#pragma unroll
            for (int s = 0; s < 8; ++s) {
                const f32x4 ga = *(const f32x4*)(qg + 32 * s + 8 * fq), gb = *(const f32x4*)(qg + 32 * s + 8 * fq + 4);
                u32x4 w; w.x = pk2(bflo(qw[s].x) * rstd * ga.x, bfhi(qw[s].x) * rstd * ga.y); w.y = pk2(bflo(qw[s].y) * rstd * ga.z, bfhi(qw[s].y) * rstd * ga.w);
                w.z = pk2(bflo(qw[s].z) * rstd * gb.x, bfhi(qw[s].z) * rstd * gb.y); w.w = pk2(bflo(qw[s].w) * rstd * gb.z, bfhi(qw[s].w) * rstd * gb.w);
                qf[s] = __builtin_bit_cast(bf16x8, w);
            }
        }
        __syncthreads();
        f32x4 sc[16];
#pragma unroll
        for (int hf = 0; hf < 2; ++hf) {
            unsigned kb = (unsigned)(size_t)(kl + (128 * hf + fr) * RS + 8 * fq); asm volatile("" : "+v"(kb));
#pragma unroll
            for (int t8 = 0; t8 < 8; ++t8) { const int t = 8 * hf + t8; sc[t] = (f32x4){0.f, 0.f, 0.f, 0.f};
#pragma unroll
                for (int s = 0; s < 8; ++s) { const bf16x8 kf = *(const LAS bf16x8*)(size_t)(kb + (unsigned)((16 * t8 * RS + 32 * s) * 2));
                    sc[t] = __builtin_amdgcn_mfma_f32_16x16x32_bf16(kf, qf[s], sc[t], 0, 0, 0); }
                if (t & 1) asm volatile("" ::: "memory"); }
        }
        float mx = -INFINITY;
#pragma unroll
        for (int t = 0; t < 16; ++t) mx = fmaxf(mx, fmaxf(fmaxf(sc[t].x, sc[t].y), fmaxf(sc[t].z, sc[t].w)));
        mx = fmaxf(mx, __shfl_xor(mx, 16)); mx = fmaxf(mx, __shfl_xor(mx, 32));
        float lsum = 0.f;
#pragma unroll
        for (int t = 0; t < 16; ++t) { sc[t].x = __expf(sc[t].x - mx); sc[t].y = __expf(sc[t].y - mx); sc[t].z = __expf(sc[t].z - mx); sc[t].w = __expf(sc[t].w - mx); lsum += (sc[t].x + sc[t].y) + (sc[t].z + sc[t].w); }
        lsum += __shfl_xor(lsum, 16); lsum += __shfl_xor(lsum, 32);
        const float inv = 1.f / lsum;
        bf16x8 pf[8];
#pragma unroll
        for (int s = 0; s < 8; ++s) { u32x4 w; w.x = pk2(sc[2 * s].x, sc[2 * s].y); w.y = pk2(sc[2 * s].z, sc[2 * s].w); w.z = pk2(sc[2 * s + 1].x, sc[2 * s + 1].y); w.w = pk2(sc[2 * s + 1].z, sc[2 * s + 1].w);
            pf[s] = __builtin_bit_cast(bf16x8, w); }
        __syncthreads();
        {
            const int row = tid >> 1, hf = tid & 1;
            const u32x4* src = (const u32x4*)(VT + ((size_t)((L * 8 + b) * 4 + h) * 256 + row) * 256 + hf * 128);
#pragma unroll
            for (int i0 = 0; i0 < 16; i0 += 8) {
                u32x4 w[8];
#pragma unroll
                for (int i = 0; i < 8; ++i) w[i] = src[i0 + i];
#pragma unroll
                for (int i = 0; i < 8; ++i) *(LAS u32x4*)(kl + row * RS + hf * 128 + (i0 + i) * 8) = w[i];
            }
        }
        __syncthreads();
#pragma unroll
        for (int hf = 0; hf < 2; ++hf) {
            unsigned vb = (unsigned)(size_t)(kl + (128 * hf + fr) * RS + 8 * fq); asm volatile("" : "+v"(vb));
#pragma unroll
            for (int n8 = 0; n8 < 8; ++n8) { const int n = 8 * hf + n8; f32x4 o = (f32x4){0.f, 0.f, 0.f, 0.f};
#pragma unroll
                for (int s = 0; s < 8; ++s) { const bf16x8 vf = *(const LAS bf16x8*)(size_t)(vb + (unsigned)((16 * n8 * RS + 32 * s) * 2));
                    o = __builtin_amdgcn_mfma_f32_16x16x32_bf16(vf, pf[s], o, 0, 0, 0); }
                u32x2 w; w.x = pk2(o.x * inv, o.y * inv); w.y = pk2(o.z * inv, o.w * inv);
                *(u32x2*)(OX + tok * 1024 + h * 256 + 16 * n + 4 * fq) = w;
                if (n & 1) asm volatile("" ::: "memory"); }
        }
    }
    __syncthreads();
}

__device__ __forceinline__ void phase_route(KArgs A, int wv_, int L, LAS unsigned char* lds) {
    const int tid_ = opaque_tid(wv_); const int wid = __builtin_amdgcn_readfirstlane(tid_ >> 6), lane = tid_ & 63;
    unsigned char* ws = opq(A->ws);
    const float* RW = (const float*)(ws + WS_RW) + (size_t)L * NEXP * D; const float* rb = A->in[I_RB];
    unsigned* cnt = (unsigned*)(ws + WS_CTL) + CW_CNT + L * 64;
    int* list = (int*)(ws + WS_LIST); int* te = (int*)(ws + WS_TOK); int* tp = te + 2 * T; float* tw = (float*)(tp + 2 * T);
    bf16* XN = (bf16*)(ws + WS_XN);
    LAS unsigned* lcnt = (LAS unsigned*)lds;
    LAS unsigned* lbase = lcnt + 16;
    for (int blk = blockIdx.x; blk < T / 64; blk += gridDim.x) {
        __syncthreads();
        if (tid_ < 16) lcnt[tid_] = 0u;
        __syncthreads();
        int e0s = 0, e1s = 0, r0s = 0, r1s = 0; float w0s = 0.f;
#pragma unroll 1
        for (int q = 0; q < 8; ++q) {
            const int t = blk * 64 + wid * 8 + q;
            const f32x4* xr = (const f32x4*)(A->out + (size_t)t * D) + lane;
            f32x4 v[4]; float s = 0.f;
#pragma unroll
            for (int j = 0; j < 4; ++j) { v[j] = xr[64 * j]; s += (v[j].x * v[j].x + v[j].y * v[j].y) + (v[j].z * v[j].z + v[j].w * v[j].w); }
            const float rstd = rsqrtf(wave_sum(s) * (1.f / 1024.f) + EPS);
            u32x2* o8 = (u32x2*)(XN + (size_t)t * D) + lane;
#pragma unroll
            for (int j = 0; j < 4; ++j) { u32x2 w; w.x = pk2(v[j].x * rstd, v[j].y * rstd); w.y = pk2(v[j].z * rstd, v[j].w * rstd); o8[64 * j] = w; }
            float mylg = -INFINITY;
#pragma unroll 2
            for (int e = 0; e < 16; ++e) {
                const f32x4* wr = (const f32x4*)(RW + e * D) + lane; float a = 0.f;
#pragma unroll
                for (int j = 0; j < 4; ++j) { const f32x4 w = wr[64 * j]; a += (v[j].x * w.x + v[j].y * w.y) + (v[j].z * w.z + v[j].w * w.w); }
                const float val = wave_sum(a) * rstd + rb[e];
                mylg = lane == e ? val : mylg;
            }
            const float v0 = wave_max(mylg);
            const int e0 = __ffsll((unsigned long long)__ballot(mylg == v0)) - 1;
            const int gidx = e0 >> 2;
            const float m2 = ((lane >> 2) == gidx && lane != e0 && lane < 16) ? mylg : -INFINITY;
            const float v1 = wave_max(m2);
            const int e1 = __ffsll((unsigned long long)__ballot(m2 == v1 && (lane >> 2) == gidx && lane != e0 && lane < 16)) - 1;
            const float w0 = 1.f / (1.f + __expf(v1 - v0));
            unsigned r0 = 0, r1 = 0;
            if (lane == 0) { r0 = atomicAdd((unsigned*)(lcnt + e0), 1u); r1 = atomicAdd((unsigned*)(lcnt + e1), 1u); }
            r0 = __builtin_amdgcn_readfirstlane(r0); r1 = __builtin_amdgcn_readfirstlane(r1);
            if (lane == q) { e0s = e0; e1s = e1; r0s = (int)r0; r1s = (int)r1; w0s = w0; }
        }
        __syncthreads();
        if (tid_ < 16) lbase[tid_] = atomicAdd(&cnt[tid_], lcnt[tid_]);
        __syncthreads();
        if (lane < 8) {
            const int t = blk * 64 + wid * 8 + lane;
            const int p0 = (int)lbase[e0s] + r0s, p1 = (int)lbase[e1s] + r1s;
            list[e0s * T + p0] = t; list[e1s * T + p1] = t;
            te[2 * t] = e0s; te[2 * t + 1] = e1s; tp[2 * t] = p0; tp[2 * t + 1] = p1; tw[2 * t] = w0s; tw[2 * t + 1] = 1.f - w0s;
        }
    }
    __syncthreads();
}
__device__ __forceinline__ void moe_offsets(KArgs A, int wv_, int L, LAS int* off, LAS int* cn) {
    if (opaque_tid(wv_) == 0) {
        const unsigned* cnt = (const unsigned*)(opq(A->ws) + WS_CTL) + CW_CNT + L * 64;
        int o = 0;
        for (int e = 0; e < 16; ++e) { const int c = (int)__hip_atomic_load(cnt + e, __ATOMIC_RELAXED, __HIP_MEMORY_SCOPE_AGENT); off[e] = o; cn[e] = c; o += (c + 255) & ~255; }
        off[16] = o;
    }
    __syncthreads();
}
__device__ __forceinline__ void phase_moe_combine(KArgs A, int wv_, int L, LAS unsigned char* lds) {
    LAS int* off = (LAS int*)lds; LAS int* cn = off + 32;
    moe_offsets(A, wv_, L, off, cn);
    const int tid_ = opaque_tid(wv_); const int wid = __builtin_amdgcn_readfirstlane(tid_ >> 6), lane = tid_ & 63; const int gw = blockIdx.x * 8 + wid, NGW = gridDim.x * 8;
    unsigned char* ws = opq(A->ws);
    const int* te = (const int*)(ws + WS_TOK); const int* tp = te + 2 * T; const float* tw = (const float*)(tp + 2 * T);
    const bf16* Y = (const bf16*)(ws + WS_Y); bf16* XN = (bf16*)(ws + WS_XN);
    for (int t = gw; t < T; t += NGW) {
        const int sl0 = off[te[2 * t]] + tp[2 * t], sl1 = off[te[2 * t + 1]] + tp[2 * t + 1];
        const float w0 = tw[2 * t], w1 = tw[2 * t + 1];
        f32x4* xr = (f32x4*)(A->out + (size_t)t * D) + lane;
        const u32x2* y0 = (const u32x2*)(Y + (size_t)sl0 * D) + lane; const u32x2* y1 = (const u32x2*)(Y + (size_t)sl1 * D) + lane;
        f32x4 v[4]; float s = 0.f;
#pragma unroll
        for (int j = 0; j < 4; ++j) {
            v[j] = xr[64 * j]; const u32x2 a = y0[64 * j], c = y1[64 * j];
            v[j].x += w0 * bflo(a.x) + w1 * bflo(c.x); v[j].y += w0 * bfhi(a.x) + w1 * bfhi(c.x); v[j].z += w0 * bflo(a.y) + w1 * bflo(c.y); v[j].w += w0 * bfhi(a.y) + w1 * bfhi(c.y);
            xr[64 * j] = v[j];
            s += (v[j].x * v[j].x + v[j].y * v[j].y) + (v[j].z * v[j].z + v[j].w * v[j].w);
        }
        const float rstd = rsqrtf(wave_sum(s) * (1.f / 1024.f) + EPS);
        u32x2* o8 = (u32x2*)(XN + (size_t)t * D) + lane;
#pragma unroll
        for (int j = 0; j < 4; ++j) { u32x2 w; w.x = pk2(v[j].x * rstd, v[j].y * rstd); w.y = pk2(v[j].z * rstd, v[j].w * rstd); o8[64 * j] = w; }
    }
}

constexpr int PH_PER_EVEN = 5 + 8, PH_PER_ODD = 3 + 8;
constexpr int NPHASES = 3 + 2 * (PH_PER_EVEN + PH_PER_ODD);

__global__ void __launch_bounds__(512, 2) mk_fwd(Args Araw) {
    KArgs A0 = kargs();
    extern __shared__ __attribute__((aligned(16))) unsigned char lds_raw[];
    LAS unsigned char* lds = (LAS unsigned char*)lds_raw;
    volatile LAS unsigned* misc = (volatile LAS unsigned*)(lds + LDS_MISC);
    const int tid = threadIdx.x;
    if (tid < 16) misc[tid] = 0u;
    __syncthreads();
    const int lo = A0->ph_lo, hi = A0->ph_hi;
    const int wv_ = __builtin_amdgcn_readfirstlane(threadIdx.x >> 6);
    if (hi - lo > 1) (void)xcd_barrier_post((unsigned*)(A0->ws + WS_CTL) + CW_BAR, misc);
    int ph = 0;
    unsigned long long tacc_ = 0;
#define PH_BEGIN(k) if (ph >= lo && ph < hi) { const bool tprobe_ = (PROBE_TMASK >> (k)) & 1; unsigned long long tp0_ = 0; if (PROBE_TMASK && tprobe_) tp0_ = __builtin_amdgcn_s_memrealtime(); KArgs A = kargs(); unsigned char* ws = opq(A->ws); _Pragma("unroll 1") for (int rep_ = 0; rep_ < (((PROBE_MASK >> (k)) & 1) ? PROBE_REPS : 1); ++rep_)
#define PH_END   if (ph + 1 < hi) { XcdBarrier b_; b_.bar = (unsigned*)(opq(kargs()->ws) + WS_CTL) + CW_BAR; b_.x = xb_xcc_id(); b_.st = misc; xcd_barrier(b_, opaque_tid(wv_) == 0); } if (PROBE_TMASK && tprobe_) tacc_ += __builtin_amdgcn_s_memrealtime() - tp0_; } ++ph;
    const int G = gridDim.x, cb = blockIdx.x;

    PH_BEGIN(0) phase_prologue(A, wv_, lds); PH_END
    PH_BEGIN(1) {
        pg8::DenseOrder S; S.init(NBATCH * NMEM, 8192, D, (const bf16*)(ws + WS_WKV), G, cb);
        pg8::EpiBf16<0> E{(bf16*)(ws + WS_KV), 8192, 32, 0};
        pg8::gemm_phase(lds, (const bf16*)(ws + WS_MN), D, S, E, wv_);
    } PH_END
    PH_BEGIN(2) { phase_knorm(A, wv_); phase_vtrans(A, wv_, lds); } PH_END

    for (int L = 0; L < DEPTH; ++L) {
        const int i = L >> 1;
        if ((L & 1) == 0) {
            PH_BEGIN(3) {
                pg8::DenseOrder S; S.init(T, HYN, D, (const bf16*)(ws + WS_WHYB) + (size_t)i * HYN * D, G, cb);
                pg8::EpiBf16<0> E{(bf16*)(ws + WS_BIG), HYN, 12, 0};
                pg8::gemm_phase(lds, (const bf16*)(ws + WS_XN), D, S, E, wv_);
            } PH_END
            PH_BEGIN(4) { phase_nsa_prep(A, wv_, i, lds); phase_vtiles(A, wv_, lds); } PH_END
            PH_BEGIN(5) { phase_gla_a(A, wv_, i, lds); __syncthreads(); phase_nsa_attn_mfma(A, wv_, i, lds); } PH_END
            PH_BEGIN(6) phase_gla_c(A, wv_, i, lds); PH_END
            PH_BEGIN(7) {
                pg8::DenseOrder S; S.init(T, D, D, (const bf16*)(ws + WS_WHOUT) + (size_t)i * D * D, G, cb);
                pg8::EpiResAdd E{A->out, D};
                pg8::gemm_phase(lds, (const bf16*)(ws + WS_CAT), D, S, E, wv_);
            } PH_END
        } else {
            PH_BEGIN(8) {
                pg8::DenseOrder S; S.init(T, 4096, D, (const bf16*)(ws + WS_WSGIN) + (size_t)i * 4096 * D, G, cb);
                pg8::EpiBf16<1> E{(bf16*)(ws + WS_U), 2048, 8, (size_t)(WS_V - WS_U) / 2};
                pg8::gemm_phase(lds, (const bf16*)(ws + WS_XN), D, S, E, wv_);
            } PH_END
            PH_BEGIN(9) phase_sgu_mix_mfma(A, wv_, i, lds); PH_END
            PH_BEGIN(10) {
                pg8::DenseOrder S; S.init(T, D, 2048, (const bf16*)(ws + WS_WSGOUT) + (size_t)i * D * 2048, G, cb);
                pg8::EpiResAdd E{A->out, D};
                pg8::gemm_phase(lds, (const bf16*)(ws + WS_UM), 2048, S, E, wv_);
            } PH_END
        }
        PH_BEGIN(11) phase_rownorm(A, wv_); PH_END
        PH_BEGIN(12) {
            pg8::DenseOrder S; S.init(T, D, D, (const bf16*)(ws + WS_WQ) + (size_t)L * D * D, G, cb);
            pg8::EpiBf16<0> E{(bf16*)(ws + WS_QX), D, 4, 0};
            pg8::gemm_phase(lds, (const bf16*)(ws + WS_XN), D, S, E, wv_);
        } PH_END
        PH_BEGIN(13) phase_xattn_mfma(A, wv_, L, lds); PH_END
        PH_BEGIN(14) {
            pg8::DenseOrder S; S.init(T, D, D, (const bf16*)(ws + WS_WO) + (size_t)L * D * D, G, cb);
            pg8::EpiResAdd E{A->out, D};
            pg8::gemm_phase(lds, (const bf16*)(ws + WS_OX), D, S, E, wv_);
        } PH_END
        PH_BEGIN(15) phase_route(A, wv_, L, lds); PH_END
        PH_BEGIN(16) {
            LAS int* off = (LAS int*)(lds + pg8::STAGE_BYTES); LAS int* cn = off + 32;
            moe_offsets(A, wv_, L, off, cn);
            pg8::MoeOrder<true> S{(off[16] / 256) * 3, 3, G, cb, D, off, cn, (const int*)(ws + WS_LIST), (const char*)(ws + WS_WMIN) + (size_t)L * 16 * 768 * D * 2, (size_t)768 * D * 2};
            pg8::EpiSwiglu E{(bf16*)(ws + WS_H), DEXP};
            pg8::gemm_phase(lds, (const bf16*)(ws + WS_XN), D, S, E, wv_);
        } PH_END
        PH_BEGIN(17) {
            LAS int* off = (LAS int*)(lds + pg8::STAGE_BYTES); LAS int* cn = off + 32;
            moe_offsets(A, wv_, L, off, cn);
            pg8::MoeOrder<false> S{(off[16] / 256) * 4, 4, G, cb, DEXP, off, cn, (const int*)(ws + WS_LIST), (const char*)(ws + WS_WMOUT) + (size_t)L * 16 * D * DEXP * 2, (size_t)D * DEXP * 2};
            pg8::EpiBf16<0> E{(bf16*)(ws + WS_Y), D, 4, 0};
            pg8::gemm_phase(lds, (const bf16*)(ws + WS_H), DEXP, S, E, wv_);
        } PH_END
        PH_BEGIN(18) phase_moe_combine(A, wv_, L, lds); PH_END
    }
#undef PH_BEGIN
#undef PH_END
    if (PROBE_TMASK && blockIdx.x == 0) { const unsigned long long t0 = __builtin_amdgcn_s_memrealtime(); while (__builtin_amdgcn_s_memrealtime() - t0 < tacc_) __builtin_amdgcn_s_sleep(8); }
}

extern "C" void kernel_launch(void* const* d_in, const int* in_sizes, int n_in, void* d_out, int out_size, void* d_ws, size_t ws_size, hipStream_t stream) {
    static int grid = 0;
    if (grid == 0) {
        if (n_in != N_IN || out_size != T * D || ws_size < WS_END) { fprintf(stderr, "kernel_launch: unexpected problem (n_in %d, out %d, ws %zu)\n", n_in, out_size, ws_size); grid = -1; return; }
        int dev = 0, cus = 0, per_cu = 0;
        if (hipGetDevice(&dev) != hipSuccess || hipDeviceGetAttribute(&cus, hipDeviceAttributeMultiprocessorCount, dev) != hipSuccess) { grid = -1; return; }
        if (hipFuncSetAttribute((const void*)mk_fwd, hipFuncAttributeMaxDynamicSharedMemorySize, LDS_BYTES) != hipSuccess) { fprintf(stderr, "kernel_launch: hipFuncSetAttribute failed\n"); grid = -1; return; }
        if (hipOccupancyMaxActiveBlocksPerMultiprocessor(&per_cu, (const void*)mk_fwd, 512, LDS_BYTES) != hipSuccess || per_cu < 1) fprintf(stderr, "kernel_launch: occupancy query says %d\n", per_cu);
        (void)hipGetLastError();
        grid = cus;
    }
    if (grid < 0) return;
    (void)hipMemsetAsync((char*)d_ws + WS_CTL, 0, CTL_BYTES, stream);
    Args a{};
    for (int i = 0; i < N_IN; ++i) a.in[i] = (const float*)d_in[i];
    a.out = (float*)d_out; a.ws = (unsigned char*)d_ws;
    for (int j = 0; j < 32; ++j) a.freq[j] = (float)pow(10000.0, -(double)j / 32.0);
#if MK_ONE_LAUNCH
    a.ph_lo = 0; a.ph_hi = NPHASES;
    hipLaunchKernelGGL(mk_fwd, dim3(grid), dim3(512), LDS_BYTES, stream, a);
#else
    for (int p = 0; p < NPHASES; ++p) { a.ph_lo = p; a.ph_hi = p + 1; hipLaunchKernelGGL(mk_fwd, dim3(grid), dim3(512), LDS_BYTES, stream, a); }
#endif
}
```

```cpp
#include <hip/hip_runtime.h>
#include <stdint.h>
#include <stdio.h>
#include <math.h>

#ifndef PROBE_MASK
#define PROBE_MASK 0
#endif
#ifndef PROBE_TMASK
#define PROBE_TMASK 0
#endif
#ifndef PROBE_REPS
#define PROBE_REPS 2
#endif
#ifndef MK_ONE_LAUNCH
#define MK_ONE_LAUNCH 1
#endif

#define LAS __attribute__((address_space(3)))
typedef unsigned short bf16;
typedef short bf16x8 __attribute__((ext_vector_type(8)));
typedef float f32x4 __attribute__((ext_vector_type(4)));
typedef float f32x2 __attribute__((ext_vector_type(2)));
typedef unsigned u32x4 __attribute__((ext_vector_type(4)));
typedef unsigned u32x2 __attribute__((ext_vector_type(2)));

constexpr int T = 16384, D = 1024, NBATCH = 8, S = 2048, DEPTH = 4;
constexpr int NMEM = 256;
constexpr float EPS = 1e-6f;
constexpr int HYN = 3072, HYSRC = 2856;
constexpr int C_QA = 0, C_KC = 512, C_VC = 640, C_KS = 768, C_VS = 896, C_KW = 1024, C_VW = 1152, C_QB = 1280, C_KB = 1536, C_VB = 1792, C_RB = 2304, C_GA = 2816, C_AL = 2840;
constexpr int NCMP = 127;
constexpr int NEXP = 16, DEXP = 384;
constexpr int SLOTS = 2 * T + NEXP * 256;

enum { I_X = 0, I_MEM, I_POS, I_NMIX, I_NXAT, I_NMEM, I_NFFN, I_HYBIN, I_HYBOUT, I_QNORM, I_KNORM, I_CMPPE, I_CMPW1, I_CMPW2, I_GATEB, I_WA2, I_BA, I_ONORM,
       I_SGIN, I_LNG, I_LNB, I_SGWS, I_SGBS, I_SGOUT, I_XWQ, I_XWKV, I_XWO, I_XQN, I_XKN, I_RW, I_RB, I_MOEIN, I_MOEOUT, N_IN };

constexpr size_t MiB = 1u << 20;
constexpr size_t WS_CTL = 0, CTL_BYTES = 1 * MiB;
constexpr size_t WS_WHYB = 1 * MiB;
constexpr size_t WS_WHOUT = WS_WHYB + 12 * MiB;
constexpr size_t WS_WSGIN = WS_WHOUT + 4 * MiB;
constexpr size_t WS_WSGOUT = WS_WSGIN + 16 * MiB;
constexpr size_t WS_WQ = WS_WSGOUT + 8 * MiB;
constexpr size_t WS_WKV = WS_WQ + 8 * MiB;
constexpr size_t WS_WO = WS_WKV + 16 * MiB;
constexpr size_t WS_WMIN = WS_WO + 8 * MiB;
constexpr size_t WS_WMOUT = WS_WMIN + 96 * MiB;
constexpr size_t WS_RW = WS_WMOUT + 48 * MiB;
constexpr size_t WS_XN = WS_RW + 1 * MiB;
constexpr size_t WS_BIG = WS_XN + 32 * MiB;
constexpr size_t WS_QA = WS_BIG + 128 * MiB;
constexpr size_t WS_KS = WS_QA + 16 * MiB;
constexpr size_t WS_KW = WS_KS + 4 * MiB;
constexpr size_t WS_KC = WS_KW + 4 * MiB;
constexpr size_t WS_VC = WS_KC + 1 * MiB;
constexpr size_t WS_CAT = WS_VC + 1 * MiB;
constexpr size_t WS_QX = WS_CAT + 32 * MiB;
constexpr size_t WS_OX = WS_QX + 32 * MiB;
constexpr size_t WS_MN = WS_OX + 32 * MiB;
constexpr size_t WS_KV = WS_MN + 4 * MiB;
constexpr size_t WS_COS = WS_KV + 32 * MiB;
constexpr size_t WS_SIN = WS_COS + 2 * MiB;
constexpr size_t WS_LIST = WS_SIN + 2 * MiB;
constexpr size_t WS_TOK = WS_LIST + 1 * MiB;
constexpr size_t WS_VT = WS_TOK + 1 * MiB;
constexpr size_t WS_VTA = WS_VT + 16 * MiB;
constexpr size_t WS_SLOC = WS_VTA + 32 * MiB;
constexpr size_t WS_DEC = WS_SLOC + 32 * MiB;
constexpr size_t WS_STT = WS_DEC + 1 * MiB;
constexpr size_t WS_WSB = WS_STT + 16 * MiB;
constexpr size_t WS_M0 = WS_WSB + 768 * 1024;
constexpr size_t WS_W1T = WS_WSB + 1 * MiB;
constexpr size_t WS_END = WS_W1T + 1 * MiB;
constexpr size_t WS_Y = WS_BIG, WS_H = WS_BIG + 72 * MiB, WS_U = WS_BIG, WS_V = WS_BIG + 64 * MiB, WS_UM = WS_QX;
constexpr int CW_BAR = 4096;
constexpr int CW_CNT = 8192;

constexpr int LDS_BYTES = 159744;
constexpr int LDS_MISC = LDS_BYTES - 64;

__device__ __forceinline__ unsigned f2bf(float f) { unsigned u = __float_as_uint(f); return (u + 0x7fffu + ((u >> 16) & 1u)) >> 16; }
__device__ __forceinline__ float bf2f(unsigned b) { return __uint_as_float(b << 16); }
__device__ __forceinline__ float bflo(unsigned w) { return __uint_as_float(w << 16); }
__device__ __forceinline__ float bfhi(unsigned w) { return __uint_as_float(w & 0xffff0000u); }
__device__ __forceinline__ unsigned pk2(float lo, float hi) { return f2bf(lo) | (f2bf(hi) << 16); }
__device__ __forceinline__ float wave_sum(float v) {
#pragma unroll
    for (int o = 1; o < 64; o <<= 1) v += __shfl_xor(v, o);
    return v;
}
__device__ __forceinline__ float wave_max(float v) {
#pragma unroll
    for (int o = 1; o < 64; o <<= 1) v = fmaxf(v, __shfl_xor(v, o));
    return v;
}
__device__ __forceinline__ int opaque_tid(int wv) { int l; asm volatile("v_mbcnt_lo_u32_b32 %0, -1, 0\n\tv_mbcnt_hi_u32_b32 %0, -1, %0" : "=v"(l)); return wv * 64 + l; }
__device__ __forceinline__ unsigned char* opq(unsigned char* p) { asm volatile("" : "+s"(p)); return p; }
#define LDS_WAIT() asm volatile("s_waitcnt lgkmcnt(0)" ::: "memory")
__device__ __forceinline__ float gelu_tanh(float x) {
    const float u = 0.7978845608028654f * (x + 0.044715f * x * x * x);
    const float e = __expf(-2.0f * fabsf(u));
    float t = (1.0f - e) / (1.0f + e); t = u < 0.f ? -t : t;
    return 0.5f * x * (1.0f + t);
}
__device__ __forceinline__ float sigmoidf_(float x) { return 1.0f / (1.0f + __expf(-x)); }

#define XB_TMO      128
#define XB_XCNT(j)  (256  + 64 * (j))
#define XB_XSUB(j)  (1280 + 64 * (j))
#define XB_XGEN(j)  (2304 + 64 * (j))
#define XB_TOP      3328
#define XB_TOPGEN   3392
#define XCD_BAR_WORDS 3456
#define XB_SPIN_CAP (1u << 22)

__device__ __forceinline__ unsigned xb_ld(unsigned* p)              { return __hip_atomic_load(p, __ATOMIC_RELAXED, __HIP_MEMORY_SCOPE_AGENT); }
__device__ __forceinline__ unsigned xb_add(unsigned* p, unsigned v) { return __hip_atomic_fetch_add(p, v, __ATOMIC_RELAXED, __HIP_MEMORY_SCOPE_AGENT); }
__device__ __forceinline__ unsigned xb_xcc_id() { return (unsigned)__builtin_amdgcn_s_getreg((3 << 11) | 20) & 0xFu; }
#define XB_SPIN(cond, bar) do { unsigned _sp = 0; while (cond) { __builtin_amdgcn_s_sleep(1); \
    if ((++_sp & 255u) == 0u) { if (xb_ld(&(bar)[XB_TMO])) break; if (_sp > XB_SPIN_CAP) { atomicAdd(&(bar)[XB_TMO], 1u); break; } } } } while (0)

struct XcdBarrier { unsigned* bar; unsigned x; volatile LAS unsigned* st; };
__device__ __forceinline__ unsigned* xb_opaque(unsigned* p) { unsigned long long v = (unsigned long long)p; unsigned lo = __builtin_amdgcn_readfirstlane((unsigned)v), hi = __builtin_amdgcn_readfirstlane((unsigned)(v >> 32));
    asm volatile("" : "+s"(lo), "+s"(hi)); return (unsigned*)(((unsigned long long)hi << 32) | lo); }

__device__ __forceinline__ XcdBarrier xcd_barrier_post(unsigned* bar, volatile LAS unsigned* st) {
    XcdBarrier b; b.bar = bar; b.x = xb_xcc_id(); b.st = st;
    if (threadIdx.x == 0) (void)xb_add(&bar[XB_XCNT(b.x)], 1u);
    return b;
}
__device__ __forceinline__ void xcd_barrier_complete(unsigned* bar, unsigned x, unsigned& nloc, unsigned& nx) {
    const unsigned G = gridDim.x * gridDim.y * gridDim.z;
    unsigned sum, cnt, mine, sp = 0u;
    for (;;) {
        sum = 0u; cnt = 0u; mine = 0u;
#pragma unroll
        for (unsigned j = 0; j < 16; ++j) { const unsigned c = xb_ld(&bar[XB_XCNT(j)]); sum += c; cnt += (c > 0u) ? 1u : 0u; mine = (j == x) ? c : mine; }
        if (sum == G) break;
        __builtin_amdgcn_s_sleep(1);
        if ((++sp & 255u) == 0u) { if (xb_ld(&bar[XB_TMO])) break; if (sp > XB_SPIN_CAP) { atomicAdd(&bar[XB_TMO], 1u); break; } }
    }
    nloc = mine > 0u ? mine : 1u; nx = cnt > 0u ? cnt : 1u;
}
__device__ __forceinline__ void xcd_barrier(const XcdBarrier& b, const bool is_t0) {
    asm volatile("s_waitcnt vmcnt(0)" ::: "memory");
    __syncthreads();
    if (is_t0) {
        unsigned* bar = b.bar;
        __builtin_amdgcn_s_waitcnt(0);
        unsigned nloc = b.st[0], nx = b.st[1];
        if (nloc == 0u) { xcd_barrier_complete(bar, b.x, nloc, nx); b.st[0] = nloc; b.st[1] = nx; }
        const unsigned old = xb_add(&bar[XB_XSUB(b.x)], 1u);
        const unsigned gen = old / nloc;
        if (old + 1u == (gen + 1u) * nloc) {
            __builtin_amdgcn_fence(__ATOMIC_RELEASE, "agent");
            asm volatile("s_waitcnt vmcnt(0)" ::: "memory");
            const unsigned og = xb_add(&bar[XB_TOP], 1u);
            const unsigned tg = og / nx;
            if (og + 1u == (tg + 1u) * nx) xb_add(&bar[XB_TOPGEN], 1u);
            else XB_SPIN(xb_ld(&bar[XB_TOPGEN]) == tg, bar);
            __builtin_amdgcn_fence(__ATOMIC_ACQUIRE, "agent");
            xb_add(&bar[XB_XGEN(b.x)], 1u);
            asm volatile("s_waitcnt vmcnt(0)" ::: "memory");
        } else {
            XB_SPIN(xb_ld(&bar[XB_XGEN(b.x)]) == gen, bar);
            __builtin_amdgcn_fence(__ATOMIC_ACQUIRE, "agent");
            asm volatile("s_waitcnt vmcnt(0)" ::: "memory");
        }
    }
    __syncthreads();
}

struct Args {
    const float* in[N_IN];
    float* out;
    unsigned char* ws;
    float freq[32];
    int ph_lo, ph_hi;
};

typedef const __attribute__((address_space(4))) Args* KArgs;
__device__ __forceinline__ KArgs kargs() { KArgs p = (KArgs)__builtin_amdgcn_kernarg_segment_ptr(); asm volatile("" : "+s"(p)); return p; }

__device__ __forceinline__ void st_bf16x4(bf16* p, f32x4 v) { u32x2 w; w.x = pk2(v[0], v[1]); w.y = pk2(v[2], v[3]); *(u32x2*)p = w; }


namespace pg8 {
constexpr int BM = 256, BK = 64, HALF = 128, HTB = HALF * BK * 2, STAGE_BYTES = 8 * HTB, NXCD = 8, WGM = 8;
__host__ __device__ __forceinline__ int lds_byte(int r, int c) { const int st = (r >> 4) * 2 + (c >> 5), rr = r & 15, cc = c & 31, ob = rr * 64 + cc * 2; return st * 1024 + (ob ^ (((ob >> 9) & 1) << 5)); }
__host__ __device__ __forceinline__ void stage_rc(int b, int& R, int& C) { const int st = b / 1024, sb = b % 1024, swz = sb ^ (((sb >> 9) & 1) << 5); R = (st >> 1) * 16 + swz / 64; C = (st & 1) * 32 + (swz % 64) / 2; }
__host__ __device__ __forceinline__ int perm32(int rho) { const int n = rho >> 4, i = rho & 15; return 8 * (i >> 2) + 4 * n + (i & 3); }
struct Unit { int pm, pn, e; };
struct DenseOrder {
    static constexpr bool GATHER = false;
    int nM, nN, nwg, G, c, K; const char* Bt;
    __device__ __forceinline__ void init(int M, int N, int K_, const bf16* Bt_, int G_, int c_) { nM = M / BM; nN = N / BM; nwg = nM * nN; G = G_; c = c_; K = K_; Bt = (const char*)Bt_; }
    __device__ __forceinline__ bool next(int i, Unit& u) const {
        const long L = (long)i * G + c; if (L >= nwg) return false;
        int wgid = (int)L; { const int q = nwg / NXCD, r = nwg % NXCD, xcd = wgid % NXCD, off = wgid / NXCD; wgid = (xcd < r ? xcd * (q + 1) : r * (q + 1) + (xcd - r) * q) + off; }
        const int nig = WGM * nN, gid = wgid / nig, fm = gid * WGM, gsz = (nM - fm) < WGM ? (nM - fm) : WGM;
        u.pm = fm + ((wgid % nig) % gsz); u.pn = (wgid % nig) / gsz; u.e = 0; return true;
    }
    __device__ __forceinline__ unsigned a_voff(const Unit& u, int half, int R) const { return (unsigned)((u.pm * BM + half * HALF + R) * K) * 2u; }
    __device__ __forceinline__ const char* b_tile(const Unit& u) const { return Bt + (size_t)u.pn * BM * K * 2; }
};
template <bool GATH> struct MoeOrder {
    static constexpr bool GATHER = GATH;
    int nunits, ntn, G, c, K; const LAS int* off; const LAS int* cn; const int* list; const char* Bt; size_t estride;
    __device__ __forceinline__ bool next(int i, Unit& u) const {
        const int L = i * G + c; if (L >= nunits) return false;
        u.pm = L / ntn; u.pn = L % ntn; const int s0 = u.pm * BM; int e = 0;
#pragma unroll
        for (int q = 1; q < 16; ++q) e += (s0 >= off[q]) ? 1 : 0;
        u.e = e; return true;
    }
    __device__ __forceinline__ unsigned a_voff(const Unit& u, int half, int R) const {
        const int slot = u.pm * BM + half * HALF + R;
        const int loc = slot - off[u.e]; const int tk = list[u.e * T + (loc < cn[u.e] ? loc : 0)];
        return (unsigned)(tk * K) * 2u;
    }
    __device__ __forceinline__ const char* b_tile(const Unit& u) const { return Bt + (size_t)u.e * estride + (size_t)u.pn * BM * K * 2; }
};
__device__ __forceinline__ unsigned cvt_pk_bf16(float lo, float hi) { unsigned r; asm volatile("v_cvt_pk_bf16_f32 %0, %1, %2" : "=v"(r) : "v"(lo), "v"(hi)); return r; }

template <class Epi, class Sched>
__device__ __forceinline__ void gemm_phase(LAS unsigned char* lds, const bf16* Aptr, int K, const Sched& S, const Epi& E, int wv_) {
    const int tid = opaque_tid(wv_), wid = __builtin_amdgcn_readfirstlane(tid >> 6), lane = tid & 63, wr = wid >> 2, wc = wid & 3, fr = lane & 15, fq = lane >> 4;
    const int nt = K / BK;
    int Rr[2], Cc[2]; unsigned voffA[2], voffB[2];
#pragma unroll
    for (int i = 0; i < 2; ++i) { stage_rc(tid * 16 + i * 8192, Rr[i], Cc[i]); const int Rb = Epi::PERM ? ((Rr[i] & ~31) + perm32(Rr[i] & 31)) : Rr[i];
        voffA[i] = (unsigned)(Rr[i] * K + Cc[i]) * 2u; voffB[i] = (unsigned)(Rb * K + Cc[i]) * 2u; }
    const size_t kstep = (size_t)(BK * 2);
    const size_t hstep = (size_t)HALF * K * 2;
    const size_t tstep = 2 * hstep;
    const unsigned ldsw = (unsigned)wid * 1024u;
    const int aoff = lds_byte(wr * 64 + fr, fq * 8), boff = lds_byte(wc * 32 + fr, fq * 8);
    const char* const Ab = (const char*)Aptr;
#define PG8_SA(b, h) (((b) * 2 + (h)) * HTB)
#define PG8_SB(b, h) ((4 + (b) * 2 + (h)) * HTB)
#define PG8_STAGE(bufoff, gbase, voff) do { _Pragma("unroll") for (int _i = 0; _i < 2; ++_i) \
        __builtin_amdgcn_global_load_lds((const unsigned*)((const char*)(gbase) + (voff)[_i]), (LAS unsigned*)(lds + (bufoff) + ldsw + _i * 8192), 16, 0, 0); } while (0)
#define PG8_STAGE_A(bufoff, usenext, h, kofs) do { \
        if constexpr (Sched::GATHER) { const char* gb_ = Ab + (kofs); unsigned vv_[2] = {(usenext) ? vN[h][0] : vA[h][0], (usenext) ? vN[h][1] : vA[h][1]}; PG8_STAGE(bufoff, gb_, vv_); } \
        else { const char* gb_ = ((usenext) ? nA : cA) + (size_t)(h) * hstep + (kofs); PG8_STAGE(bufoff, gb_, voffA); } } while (0)
#define PG8_LDA(dst, b, h) do { _Pragma("unroll") for (int m = 0; m < 4; ++m) _Pragma("unroll") for (int k = 0; k < 2; ++k) dst[m][k] = *(const LAS bf16x8*)(lds + PG8_SA(b, h) + aoff + m * 2048 + k * 1024); } while (0)
#define PG8_LDB(dst, b, h) do { _Pragma("unroll") for (int n = 0; n < 2; ++n) _Pragma("unroll") for (int k = 0; k < 2; ++k) dst[n][k] = *(const LAS bf16x8*)(lds + PG8_SB(b, h) + boff + n * 2048 + k * 1024); } while (0)
#define PG8_MMA(ai, bj, At, Bt) do { __builtin_amdgcn_s_setprio(1); _Pragma("unroll") for (int m = 0; m < 4; ++m) _Pragma("unroll") for (int n = 0; n < 2; ++n) _Pragma("unroll") for (int k = 0; k < 2; ++k) \
        acc[ai][bj][m][n] = __builtin_amdgcn_mfma_f32_16x16x32_bf16(Bt[n][k], At[m][k], acc[ai][bj][m][n], 0, 0, 0); __builtin_amdgcn_s_setprio(0); } while (0)
#define PG8_WAIT_V(n) asm volatile("s_waitcnt vmcnt(" #n ")" ::: "memory")
#define PG8_WAIT_L(n) asm volatile("s_waitcnt lgkmcnt(" #n ")" ::: "memory")
#define PG8_BAR __builtin_amdgcn_s_barrier()
#define PG8_SCHED __builtin_amdgcn_sched_barrier(0)
    Unit cur, nxt; int ui = 0;
    if (!S.next(0, cur)) return;
    f32x4 acc[2][2][4][2];
#pragma unroll
    for (int a = 0; a < 2; ++a)
#pragma unroll
        for (int b = 0; b < 2; ++b)
#pragma unroll
            for (int m = 0; m < 4; ++m)
#pragma unroll
                for (int n = 0; n < 2; ++n) acc[a][b][m][n] = (f32x4){0.f, 0.f, 0.f, 0.f};
    bf16x8 At[4][2], B0[2][2], B1[2][2];
    unsigned vA[2][2], vN[2][2];
    const char* cA = Ab; const char* nA = Ab;
    if constexpr (Sched::GATHER) {
#pragma unroll
        for (int h = 0; h < 2; ++h)
#pragma unroll
            for (int i = 0; i < 2; ++i) { vA[h][i] = S.a_voff(cur, h, Rr[i]) + (unsigned)Cc[i] * 2u; vN[h][i] = vA[h][i]; }
    } else { cA = Ab + (size_t)cur.pm * tstep; nA = cA; }
    const char* cB = S.b_tile(cur);
    PG8_STAGE(PG8_SB(0, 0), cB, voffB); PG8_STAGE_A(PG8_SA(0, 0), false, 0, 0); PG8_STAGE(PG8_SB(0, 1), cB + hstep, voffB); PG8_STAGE_A(PG8_SA(0, 1), false, 1, 0);
    if (wr == 1) PG8_BAR;
    PG8_WAIT_V(4); PG8_BAR;
    PG8_STAGE(PG8_SB(1, 0), cB + kstep, voffB); PG8_STAGE_A(PG8_SA(1, 0), false, 0, kstep); PG8_STAGE(PG8_SB(1, 1), cB + hstep + kstep, voffB);
    PG8_WAIT_V(6); PG8_BAR;
    for (;;) {
        const bool has_next = S.next(ui + 1, nxt);
        const char* nB = has_next ? S.b_tile(nxt) : cB;
        if constexpr (Sched::GATHER) {
#pragma unroll
            for (int h = 0; h < 2; ++h)
#pragma unroll
                for (int i = 0; i < 2; ++i) vN[h][i] = has_next ? S.a_voff(nxt, h, Rr[i]) + (unsigned)Cc[i] * 2u : vA[h][i];
        } else nA = has_next ? Ab + (size_t)nxt.pm * tstep : cA;
        for (int t = 0; t < nt; t += 2) {
            const bool last = (t == nt - 2);
            const size_t k1 = (size_t)(t + 1) * kstep, k2 = last ? 0 : (size_t)(t + 2) * kstep, k3 = k2 + kstep;
            const char* b2 = last ? nB : cB + (size_t)(t + 2) * kstep; const char* b3 = b2 + kstep;
            PG8_LDB(B0, 0, 0); PG8_SCHED; PG8_LDA(At, 0, 0); PG8_STAGE_A(PG8_SA(1, 1), false, 1, k1);
            PG8_WAIT_L(8); PG8_BAR; PG8_WAIT_L(0); PG8_MMA(0, 0, At, B0); PG8_BAR; PG8_SCHED;
            PG8_LDB(B1, 0, 1); PG8_STAGE(PG8_SB(0, 0), b2, voffB);
            PG8_BAR; PG8_WAIT_L(0); PG8_MMA(0, 1, At, B1); PG8_BAR;
            PG8_LDA(At, 0, 1); PG8_STAGE_A(PG8_SA(0, 0), last, 0, k2);
            PG8_BAR; PG8_WAIT_L(0); PG8_MMA(1, 0, At, B0); PG8_BAR; PG8_SCHED;
            PG8_STAGE(PG8_SB(0, 1), b2 + hstep, voffB);
            PG8_WAIT_V(6); PG8_BAR; PG8_MMA(1, 1, At, B1); PG8_BAR;
            PG8_LDB(B0, 1, 0); PG8_SCHED; PG8_LDA(At, 1, 0); PG8_STAGE_A(PG8_SA(0, 1), last, 1, k2);
            PG8_WAIT_L(8); PG8_BAR; PG8_WAIT_L(0); PG8_MMA(0, 0, At, B0); PG8_BAR; PG8_SCHED;
            PG8_LDB(B1, 1, 1); PG8_STAGE(PG8_SB(1, 0), b3, voffB);
            PG8_BAR; PG8_WAIT_L(0); PG8_MMA(0, 1, At, B1); PG8_BAR;
            PG8_LDA(At, 1, 1); PG8_STAGE_A(PG8_SA(1, 0), last, 0, k3);
            PG8_BAR; PG8_WAIT_L(0); PG8_MMA(1, 0, At, B0); PG8_BAR; PG8_SCHED;
            PG8_STAGE(PG8_SB(1, 1), b3 + hstep, voffB);
            PG8_WAIT_V(6); PG8_BAR; PG8_MMA(1, 1, At, B1); PG8_BAR;
        }
        E(acc, cur, wr, wc, fr, fq);
        if (!has_next) break;
#pragma unroll
        for (int a = 0; a < 2; ++a)
#pragma unroll
            for (int b = 0; b < 2; ++b)
#pragma unroll
                for (int m = 0; m < 4; ++m)
#pragma unroll
                    for (int n = 0; n < 2; ++n) acc[a][b][m][n] = (f32x4){0.f, 0.f, 0.f, 0.f};
        cur = nxt; cB = nB; cA = nA; ++ui;
        if constexpr (Sched::GATHER) {
#pragma unroll
            for (int h = 0; h < 2; ++h)
#pragma unroll
                for (int i = 0; i < 2; ++i) vA[h][i] = vN[h][i];
        }
    }
    PG8_WAIT_V(0);
    if (wr == 0) PG8_BAR;
    PG8_BAR;
#undef PG8_SA
#undef PG8_SB
#undef PG8_STAGE
#undef PG8_STAGE_A
#undef PG8_LDA
#undef PG8_LDB
#undef PG8_MMA
#undef PG8_WAIT_V
#undef PG8_WAIT_L
#undef PG8_BAR
#undef PG8_SCHED
}
template <int ACT> struct EpiBf16 {
    static constexpr bool PERM = true;
    bf16* O; int ldc; int tpt; size_t tstride;
    __device__ __forceinline__ void operator()(const f32x4 (&acc)[2][2][4][2], const Unit& u, int wr, int wc, int fr, int fq) const {
        const int row0 = u.pm * BM + wr * 64 + fr; const int tt = u.pn / tpt; bf16* base = O + (size_t)tt * tstride; const int col0 = (u.pn - tt * tpt) * BM + wc * 32 + 8 * fq;
#pragma unroll
        for (int ai = 0; ai < 2; ++ai)
#pragma unroll
            for (int m = 0; m < 4; ++m) { bf16* rowp = base + (size_t)(row0 + ai * HALF + m * 16) * ldc + col0;
#pragma unroll
                for (int bj = 0; bj < 2; ++bj) { f32x4 v0 = acc[ai][bj][m][0], v1 = acc[ai][bj][m][1];
                    if (ACT == 1) {
#pragma unroll
                        for (int q = 0; q < 4; ++q) { v0[q] = gelu_tanh(v0[q]); v1[q] = gelu_tanh(v1[q]); } }
                    u32x4 w; w.x = cvt_pk_bf16(v0[0], v0[1]); w.y = cvt_pk_bf16(v0[2], v0[3]); w.z = cvt_pk_bf16(v1[0], v1[1]); w.w = cvt_pk_bf16(v1[2], v1[3]);
                    *(u32x4*)(rowp + bj * HALF) = w; } }
    }
};
struct EpiResAdd {
    static constexpr bool PERM = false;
    float* X; int ldc;
    __device__ __forceinline__ void operator()(const f32x4 (&acc)[2][2][4][2], const Unit& u, int wr, int wc, int fr, int fq) const {
        const int row0 = u.pm * BM + wr * 64 + fr, col0 = u.pn * BM + wc * 32 + 4 * fq;
#pragma unroll
        for (int ai = 0; ai < 2; ++ai)
#pragma unroll
            for (int m2 = 0; m2 < 4; m2 += 2) {
                f32x4 x[2][2][2];
#pragma unroll
                for (int mm = 0; mm < 2; ++mm)
#pragma unroll
                    for (int bj = 0; bj < 2; ++bj)
#pragma unroll
                        for (int n = 0; n < 2; ++n) x[mm][bj][n] = *(const f32x4*)(X + (size_t)(row0 + ai * HALF + (m2 + mm) * 16) * ldc + col0 + bj * HALF + n * 16);
#pragma unroll
                for (int mm = 0; mm < 2; ++mm)
#pragma unroll
                    for (int bj = 0; bj < 2; ++bj)
#pragma unroll
                        for (int n = 0; n < 2; ++n) *(f32x4*)(X + (size_t)(row0 + ai * HALF + (m2 + mm) * 16) * ldc + col0 + bj * HALF + n * 16) = x[mm][bj][n] + acc[ai][bj][m2 + mm][n];
            }
    }
};
struct EpiSwiglu {
    static constexpr bool PERM = true;
    bf16* H; int ldc;
    __device__ __forceinline__ void operator()(const f32x4 (&acc)[2][2][4][2], const Unit& u, int wr, int wc, int fr, int fq) const {
        const int row0 = u.pm * BM + wr * 64 + fr, col0 = u.pn * HALF + wc * 32 + 8 * fq;
#pragma unroll
        for (int ai = 0; ai < 2; ++ai)
#pragma unroll
            for (int m = 0; m < 4; ++m) {
                float o[8];
#pragma unroll
                for (int n = 0; n < 2; ++n)
#pragma unroll
                    for (int q = 0; q < 4; ++q) { const float g = acc[ai][0][m][n][q]; o[4 * n + q] = g * sigmoidf_(g) * acc[ai][1][m][n][q]; }
                u32x4 w; w.x = cvt_pk_bf16(o[0], o[1]); w.y = cvt_pk_bf16(o[2], o[3]); w.z = cvt_pk_bf16(o[4], o[5]); w.w = cvt_pk_bf16(o[6], o[7]);
                *(u32x4*)(H + (size_t)(row0 + ai * HALF + m * 16) * ldc + col0) = w; }
    }
};
}

__device__ __forceinline__ int hyb_colmap(int n) {
    if (n < 1280) return n;
    if (n < 1536) return 1304 + (n - 1280);
    if (n < 1792) return 1560 + (n - 1536);
    if (n < 2304) return 1816 + (n - 1792);
    if (n < 2816) return 2344 + (n - 2304);
    if (n < 2840) return 1280 + (n - 2816);
    if (n < 2856) return 2328 + (n - 2840);
    return -1;
}
__device__ __forceinline__ void tr_item(const float* __restrict__ W, int Nsrc, int K, bf16* __restrict__ Wt, const float* __restrict__ gain, int kind, int nblk, LAS float* scr, int item, int lane) {
    const int kb = item / nblk, nb = item % nblk, k0 = 64 * kb, n0 = 32 * nb;
    const int j = lane & 31, n = n0 + j;
    int col;
    if (kind == 0) col = n; else if (kind == 1) col = hyb_colmap(n); else { const int pn = n >> 8, r = n & 255; col = (r >> 7) * 384 + pn * 128 + (r & 127); }
#pragma unroll 8
    for (int i = 0; i < 32; ++i) {
        const int kk = 2 * i + (lane >> 5); float v = 0.f;
        if (col >= 0) { v = W[(size_t)(k0 + kk) * Nsrc + col]; if (gain) v *= gain[k0 + kk]; }
        scr[kk * 33 + j] = v;
    }
    LDS_WAIT();
    const int c = lane & 7;
#pragma unroll
    for (int jx = 0; jx < 4; ++jx) {
        const int nn = (lane >> 3) + 8 * jx; const LAS float* s = scr + (8 * c) * 33 + nn;
        u32x4 o; o.x = pk2(s[0 * 33], s[1 * 33]); o.y = pk2(s[2 * 33], s[3 * 33]); o.z = pk2(s[4 * 33], s[5 * 33]); o.w = pk2(s[6 * 33], s[7 * 33]);
        *(u32x4*)(Wt + (size_t)(n0 + nn) * K + k0 + 8 * c) = o;
    }
    LDS_WAIT();
}
__device__ __forceinline__ void rms_row_to_bf16(const float* __restrict__ xrow, bf16* __restrict__ orow, float* __restrict__ copy, int lane) {
    const f32x4* xr = (const f32x4*)xrow + lane;
    f32x4 v[4]; float s = 0.f;
#pragma unroll
    for (int j = 0; j < 4; ++j) { v[j] = xr[64 * j]; s += (v[j].x * v[j].x + v[j].y * v[j].y) + (v[j].z * v[j].z + v[j].w * v[j].w); }
    const float rstd = rsqrtf(wave_sum(s) * (1.f / 1024.f) + EPS);
    u32x2* o8 = (u32x2*)orow + lane;
#pragma unroll
    for (int j = 0; j < 4; ++j) { u32x2 w; w.x = pk2(v[j].x * rstd, v[j].y * rstd); w.y = pk2(v[j].z * rstd, v[j].w * rstd); o8[64 * j] = w; }
    if (copy) { f32x4* c4 = (f32x4*)copy + lane;
#pragma unroll
        for (int j = 0; j < 4; ++j) c4[64 * j] = v[j]; }
}

__device__ __forceinline__ void phase_prologue(KArgs A, int wv_, LAS unsigned char* lds) {
    const int tid = opaque_tid(wv_), wid = __builtin_amdgcn_readfirstlane(tid >> 6), lane = tid & 63;
    const int gw = blockIdx.x * 8 + wid, NGW = gridDim.x * 8;
    LAS float* scr = (LAS float*)(lds + wid * 16384);
    unsigned char* ws = opq(A->ws);
    constexpr int N_HYB = 2 * 1536, N_HOUT = 2 * 512, N_SGIN = 2 * 2048, N_SGOUT = 2 * 1024, N_WQ = 4 * 512, N_WKV = 4 * 1024, N_WO = 4 * 512, N_MIN = 64 * 384, N_MOUT = 64 * 192, N_W1T = 4 * 64;
    constexpr int NITEMS = N_HYB + N_HOUT + N_SGIN + N_SGOUT + N_WQ + N_WKV + N_WO + N_MIN + N_MOUT + N_W1T;
    for (int it = gw; it < NITEMS; it += NGW) {
        int r = it;
        if (r < N_HYB) { const int sl = r / 1536; tr_item(A->in[I_HYBIN] + (size_t)sl * 1024 * HYSRC, HYSRC, 1024, (bf16*)(ws + WS_WHYB) + (size_t)sl * HYN * 1024, A->in[I_NMIX] + (2 * sl) * 1024, 1, 96, scr, r % 1536, lane); continue; } r -= N_HYB;
        if (r < N_HOUT) { const int sl = r / 512; tr_item(A->in[I_HYBOUT] + (size_t)sl * 1024 * 1024, 1024, 1024, (bf16*)(ws + WS_WHOUT) + (size_t)sl * 1024 * 1024, nullptr, 0, 32, scr, r % 512, lane); continue; } r -= N_HOUT;
        if (r < N_SGIN) { const int sl = r / 2048; tr_item(A->in[I_SGIN] + (size_t)sl * 1024 * 4096, 4096, 1024, (bf16*)(ws + WS_WSGIN) + (size_t)sl * 4096 * 1024, A->in[I_NMIX] + (2 * sl + 1) * 1024, 0, 128, scr, r % 2048, lane); continue; } r -= N_SGIN;
        if (r < N_SGOUT) { const int sl = r / 1024; tr_item(A->in[I_SGOUT] + (size_t)sl * 2048 * 1024, 1024, 2048, (bf16*)(ws + WS_WSGOUT) + (size_t)sl * 1024 * 2048, nullptr, 0, 32, scr, r % 1024, lane); continue; } r -= N_SGOUT;
        if (r < N_WQ) { const int sl = r / 512; tr_item(A->in[I_XWQ] + (size_t)sl * 1024 * 1024, 1024, 1024, (bf16*)(ws + WS_WQ) + (size_t)sl * 1024 * 1024, A->in[I_NXAT] + sl * 1024, 0, 32, scr, r % 512, lane); continue; } r -= N_WQ;
        if (r < N_WKV) { const int sl = r / 1024; tr_item(A->in[I_XWKV] + (size_t)sl * 1024 * 2048, 2048, 1024, (bf16*)(ws + WS_WKV) + (size_t)sl * 2048 * 1024, A->in[I_NMEM] + sl * 1024, 0, 64, scr, r % 1024, lane); continue; } r -= N_WKV;
        if (r < N_WO) { const int sl = r / 512; tr_item(A->in[I_XWO] + (size_t)sl * 1024 * 1024, 1024, 1024, (bf16*)(ws + WS_WO) + (size_t)sl * 1024 * 1024, nullptr, 0, 32, scr, r % 512, lane); continue; } r -= N_WO;
        if (r < N_MIN) { const int sl = r / 384; tr_item(A->in[I_MOEIN] + (size_t)sl * 1024 * 768, 768, 1024, (bf16*)(ws + WS_WMIN) + (size_t)sl * 768 * 1024, A->in[I_NFFN] + (sl >> 4) * 1024, 2, 24, scr, r % 384, lane); continue; } r -= N_MIN;
        if (r < N_MOUT) { const int sl = r / 192; tr_item(A->in[I_MOEOUT] + (size_t)sl * 384 * 1024, 1024, 384, (bf16*)(ws + WS_WMOUT) + (size_t)sl * 1024 * 384, nullptr, 0, 32, scr, r % 192, lane); continue; } r -= N_MOUT;
        { const int sl = r / 64; tr_item(A->in[I_CMPW1] + (size_t)sl * 2048 * 64, 64, 2048, (bf16*)(ws + WS_W1T) + (size_t)sl * 64 * 2048, nullptr, 0, 2, scr, r % 64, lane); }
    }
    for (int m = gw; m < T; m += NGW) rms_row_to_bf16(A->in[I_X] + (size_t)m * D, (bf16*)(ws + WS_XN) + (size_t)m * D, A->out + (size_t)m * D, lane);
    for (int m = gw; m < NBATCH * NMEM; m += NGW) rms_row_to_bf16(A->in[I_MEM] + (size_t)m * D, (bf16*)(ws + WS_MN) + (size_t)m * D, nullptr, lane);
    const int gt = blockIdx.x * 512 + tid, NGT = gridDim.x * 512;
    const int* pos = (const int*)A->in[I_POS];
    float* cosT = (float*)(ws + WS_COS); float* sinT = (float*)(ws + WS_SIN);
    for (int i = gt; i < T * 32; i += NGT) {
        const int t = i >> 5, j = i & 31;
        const float ang = (float)pos[t] * A->freq[j];
        const double rev = (double)ang * 0.15915494309189533577;
        const float fr = (float)(rev - rint(rev));
        cosT[i] = __builtin_amdgcn_cosf(fr); sinT[i] = __builtin_amdgcn_sinf(fr);
    }
    { bf16* WSB = (bf16*)(ws + WS_WSB); float* M0 = (float*)(ws + WS_M0); const float* wsg = A->in[I_SGWS];
      for (int e = gt; e < 2 * 8 * 128 * 128; e += NGT) { const int s = e & 127, t = (e >> 7) & 127; WSB[e] = (bf16)f2bf(s <= t ? wsg[e] : 0.f); }
      for (int e = gt; e < 2 * 8 * 128; e += NGT) { const int t = e & 127; const float* r = wsg + (size_t)e * 128; float a = 0.f; for (int s = 0; s <= t; ++s) a += r[s]; M0[e] = a; } }
    float* RW = (float*)(ws + WS_RW);
    for (int i = gt; i < DEPTH * NEXP * D; i += NGT) { const int k = i & 1023, e = (i >> 10) & 15, l = i >> 14; RW[i] = A->in[I_RW][k * NEXP + e] * A->in[I_NFFN][l * D + k]; }
}

__device__ __forceinline__ void phase_knorm(KArgs A, int wv_) {
    const int tid_ = opaque_tid(wv_); const int wid = __builtin_amdgcn_readfirstlane(tid_ >> 6), lane = tid_ & 63; const int gw = blockIdx.x * 8 + wid, NGW = gridDim.x * 8;
    bf16* KV = (bf16*)(opq(A->ws) + WS_KV);
    for (int it = gw; it < DEPTH * 2048 * 4; it += NGW) {
        const int h = it & 3, m = (it >> 2) & 2047, l = it >> 13;
        bf16* p = KV + (size_t)m * 8192 + l * 2048 + h * 256 + 4 * lane;
        const u32x2 w = *(const u32x2*)p;
        float x0 = bflo(w.x), x1 = bfhi(w.x), x2 = bflo(w.y), x3 = bfhi(w.y);
        const float rstd = rsqrtf(wave_sum(x0 * x0 + x1 * x1 + x2 * x2 + x3 * x3) * (1.f / 256.f) + EPS) * 0.0625f;
        const f32x4 g = *(const f32x4*)(A->in[I_XKN] + l * 256 + 4 * lane);
        u32x2 o; o.x = pk2(x0 * rstd * g.x, x1 * rstd * g.y); o.y = pk2(x2 * rstd * g.z, x3 * rstd * g.w);
        *(u32x2*)p = o;
    }
}

__device__ __forceinline__ int kpos64(int tok) { const int k = tok & 31; return (tok & 32) + 8 * ((k >> 2) & 3) + 4 * (k >> 4) + (k & 3); }
__device__ __forceinline__ int kperm64(int p) { const int fq = (p >> 3) & 3, j = p & 7; return (p & 32) + 16 * (j >> 2) + 4 * fq + (j & 3); }

__device__ __forceinline__ void phase_nsa_prep(KArgs A, int wv_, int i, LAS unsigned char* lds) {
    const int tid_ = opaque_tid(wv_); const int wid = __builtin_amdgcn_readfirstlane(tid_ >> 6), lane = tid_ & 63; const int gw = blockIdx.x * 8 + wid, NGW = gridDim.x * 8;
    unsigned char* ws = opq(A->ws);
    const bf16* HY = (const bf16*)(ws + WS_BIG);
    const float* cosT = (const float*)(ws + WS_COS); const float* sinT = (const float*)(ws + WS_SIN);
    bf16* QA = (bf16*)(ws + WS_QA); bf16* KS = (bf16*)(ws + WS_KS); bf16* KW = (bf16*)(ws + WS_KW);
    LAS float* abuf = (LAS float*)(lds + wid * 8192);
    const int NIT = T;
    for (int it = gw; it < NIT; it += NGW) {
        if (it < T) {
            const int t = it;
            const float c = cosT[t * 32 + (lane & 31)], s = sinT[t * 32 + (lane & 31)];
#pragma unroll
            for (int u = 0; u < 12; ++u) {
                int src; const float* gain; bf16* dst; float scale;
                if (u < 8) { src = C_QA + 64 * u; gain = A->in[I_QNORM] + i * 64; dst = QA + (size_t)t * 512 + 64 * u; scale = 0.125f; }
                else if (u < 10) { src = C_KS + 64 * (u - 8); gain = A->in[I_KNORM] + (i * 3 + 1) * 64; dst = KS + (size_t)t * 128 + 64 * (u - 8); scale = 1.f; }
                else { src = C_KW + 64 * (u - 10); gain = A->in[I_KNORM] + (i * 3 + 2) * 64; dst = KW + (size_t)t * 128 + 64 * (u - 10); scale = 1.f; }
                const float x = bf2f(HY[(size_t)t * HYN + src + lane]);
                const float y = x * rsqrtf(wave_sum(x * x) * (1.f / 64.f) + EPS) * gain[lane] * scale;
                const float pr = __shfl_xor(y, 32);
                const float o = lane < 32 ? y * c - pr * s : y * c + pr * s;
                dst[lane] = (bf16)f2bf(o);
            }
        }
    }
}


__device__ __forceinline__ void phase_compress_mfma(KArgs A, int wv_, int i, LAS unsigned char* lds) {
    const int tid = opaque_tid(wv_), wid = __builtin_amdgcn_readfirstlane(tid >> 6), lane = tid & 63, fr = lane & 15, fq = lane >> 4;
    unsigned char* ws = opq(A->ws);
    const bf16* HY = (const bf16*)(ws + WS_BIG);
    const float* cosT = (const float*)(ws + WS_COS); const float* sinT = (const float*)(ws + WS_SIN);
    LAS float* part = (LAS float*)lds;
    LAS float* hbuf = part + 8 * 1024;
    LAS float* obuf = hbuf + 1024;
    for (int it = blockIdx.x; it < 2 * 127; it += gridDim.x) {
        const int kv = it / 127, tile = it % 127;
        const float* pe = A->in[I_CMPPE] + (size_t)(i * 2 + kv) * 32 * 64;
        const float* w2 = A->in[I_CMPW2] + (size_t)(i * 2 + kv) * 64 * 64;
        const bf16* w1t = (const bf16*)(ws + WS_W1T) + (size_t)(i * 2 + kv) * 64 * 2048;
        const int coff = kv ? C_VC : C_KC;
        {
            const int R = tile * 16 + fr, g = R & 1, bn = R >> 1, n = bn % NCMP, b = bn / NCMP;
            const bf16* arow = HY + (size_t)(b * S + 16 * n) * HYN + coff + g * 64;
            f32x4 acc[4];
#pragma unroll
            for (int t = 0; t < 4; ++t) acc[t] = (f32x4){0.f, 0.f, 0.f, 0.f};
#pragma unroll 2
            for (int s = 0; s < 8; ++s) {
                const int k0 = 256 * wid + 32 * s, l = k0 >> 6, d0 = (k0 & 63) + 8 * fq;
                const u32x4 hw = *(const u32x4*)(arow + (size_t)l * HYN + d0);
                const f32x4 p0 = *(const f32x4*)(pe + l * 64 + d0), p1 = *(const f32x4*)(pe + l * 64 + d0 + 4);
                u32x4 aw; aw.x = pk2(bflo(hw.x) + p0.x, bfhi(hw.x) + p0.y); aw.y = pk2(bflo(hw.y) + p0.z, bfhi(hw.y) + p0.w); aw.z = pk2(bflo(hw.z) + p1.x, bfhi(hw.z) + p1.y); aw.w = pk2(bflo(hw.w) + p1.z, bfhi(hw.w) + p1.w);
                const bf16x8 af = __builtin_bit_cast(bf16x8, aw);
#pragma unroll
                for (int t = 0; t < 4; ++t) { const bf16x8 bfr = *(const bf16x8*)(w1t + (size_t)(16 * t + fr) * 2048 + k0 + 8 * fq);
                    acc[t] = __builtin_amdgcn_mfma_f32_16x16x32_bf16(af, bfr, acc[t], 0, 0, 0); }
            }
            __syncthreads();
#pragma unroll
            for (int t = 0; t < 4; ++t)
#pragma unroll
                for (int r = 0; r < 4; ++r) part[wid * 1024 + (4 * fq + r) * 64 + 16 * t + fr] = acc[t][r];
        }
        __syncthreads();
        for (int e = tid; e < 1024; e += 512) { float a = 0.f;
#pragma unroll
            for (int w = 0; w < 8; ++w) a += part[w * 1024 + e];
            hbuf[e] = gelu_tanh(a); }
        __syncthreads();
        for (int e = tid; e < 1024; e += 512) { const int r = e >> 6, j = e & 63; float o = 0.f;
#pragma unroll 8
            for (int m = 0; m < 64; ++m) o += hbuf[r * 64 + m] * w2[m * 64 + j];
            obuf[e] = o; }
        __syncthreads();
        for (int r = wid; r < 16; r += 8) {
            const int R = tile * 16 + r, g = R & 1, bn = R >> 1, n = bn % NCMP, b = bn / NCMP;
            const float o = obuf[r * 64 + lane];
            if (kv == 0) {
                const float y = o * rsqrtf(wave_sum(o * o) * (1.f / 64.f) + EPS) * A->in[I_KNORM][(i * 3 + 0) * 64 + lane];
                const int tp = b * S + 16 * n + 31;
                const float c = cosT[tp * 32 + (lane & 31)], sn = sinT[tp * 32 + (lane & 31)];
                const float pr = __shfl_xor(y, 32);
                const float oo = lane < 32 ? y * c - pr * sn : y * c + pr * sn;
                ((bf16*)(ws + WS_KC))[((size_t)(b * 128 + n) * 2 + g) * 64 + lane] = (bf16)f2bf(oo);
            } else {
                bf16* vct = (bf16*)(ws + WS_VC) + ((size_t)(b * 2 + g) * 64 + lane) * 128;
                vct[(n & 64) + kpos64(n & 63)] = (bf16)f2bf(o);
                if (n == 126) vct[127] = 0;
            }
        }
    }
    __syncthreads();
}

__device__ __forceinline__ void nsa_block(const LAS float* qs, const bf16* __restrict__ krow, bool ok, const bf16* __restrict__ vbase, int vstride, int lane,
                                          float (&m)[4], float (&l)[4], float (&o)[4]) {
    float s[4] = {0.f, 0.f, 0.f, 0.f};
#pragma unroll 2
    for (int c = 0; c < 8; ++c) {
        const u32x4 kw = *(const u32x4*)(krow + 8 * c);
        const float k0 = bflo(kw.x), k1 = bfhi(kw.x), k2 = bflo(kw.y), k3 = bfhi(kw.y), k4 = bflo(kw.z), k5 = bfhi(kw.z), k6 = bflo(kw.w), k7 = bfhi(kw.w);
#pragma unroll
        for (int hh = 0; hh < 4; ++hh) {
            const f32x4 qa = *(const LAS f32x4*)(qs + hh * 64 + 8 * c), qb = *(const LAS f32x4*)(qs + hh * 64 + 8 * c + 4);
            s[hh] += (qa.x * k0 + qa.y * k1) + (qa.z * k2 + qa.w * k3) + (qb.x * k4 + qb.y * k5) + (qb.z * k6 + qb.w * k7);
        }
    }
    float p[4];
#pragma unroll
    for (int hh = 0; hh < 4; ++hh) {
        const float sv = ok ? s[hh] : -INFINITY;
        const float bm = wave_max(sv);
        const float mn = fmaxf(m[hh], bm);
        if (mn == -INFINITY) { p[hh] = 0.f; continue; }
        const float alpha = __expf(m[hh] - mn);
        p[hh] = ok ? __expf(sv - mn) : 0.f;
        l[hh] = l[hh] * alpha + wave_sum(p[hh]);
        o[hh] *= alpha; m[hh] = mn;
    }
#pragma unroll 8
    for (int kk = 0; kk < 64; ++kk) {
        const float v = bf2f(vbase[(size_t)kk * vstride + lane]);
#pragma unroll
        for (int hh = 0; hh < 4; ++hh) o[hh] += __shfl(p[hh], kk) * v;
    }
}
__device__ __forceinline__ void phase_nsa_attn(KArgs A, int wv_, int i, LAS unsigned char* lds) {
    const int tid_ = opaque_tid(wv_); const int wid = __builtin_amdgcn_readfirstlane(tid_ >> 6), lane0 = tid_ & 63; const int gw = blockIdx.x * 8 + wid, NGW = gridDim.x * 8;
    unsigned char* ws = opq(A->ws);
    const bf16* HY = (const bf16*)(ws + WS_BIG); const bf16* QA = (const bf16*)(ws + WS_QA); const bf16* KS = (const bf16*)(ws + WS_KS); const bf16* KW = (const bf16*)(ws + WS_KW);
    const bf16* KC = (const bf16*)(ws + WS_KC); const bf16* VC = (const bf16*)(ws + WS_VC); bf16* CAT = (bf16*)(ws + WS_CAT);
    LAS float* qs = (LAS float*)(lds + wid * 2048);
    LAS float* ps = qs + 256;
    for (int it = gw; it < 2 * T; it += NGW) {
        int lane = lane0; asm volatile("" : "+v"(lane));
        const int tok = it >> 1, g = it & 1, b = tok >> 11, t = tok & 2047;
#pragma unroll
        for (int hh = 0; hh < 4; ++hh) qs[hh * 64 + lane] = bf2f(QA[(size_t)tok * 512 + (g * 4 + hh) * 64 + lane]);
        LDS_WAIT();
        const int ncv = t >= 31 ? ((t - 31) >> 4) + 1 : 0;
        float oc[4] = {0.f, 0.f, 0.f, 0.f};
        float psum0 = 0.f, psum1 = 0.f;
        {
            const bool v0 = lane < ncv, v1 = lane + 64 < ncv;
            const bf16* k0p = KC + ((size_t)(b * 128 + lane) * 2 + g) * 64;
            const bf16* k1p = KC + ((size_t)(b * 128 + (lane + 64 < 127 ? lane + 64 : 126)) * 2 + g) * 64;
            float s0[4] = {0.f, 0.f, 0.f, 0.f}, s1[4] = {0.f, 0.f, 0.f, 0.f};
#pragma unroll 2
            for (int c = 0; c < 8; ++c) {
                const u32x4 ka = *(const u32x4*)(k0p + 8 * c), kb = *(const u32x4*)(k1p + 8 * c);
#pragma unroll
                for (int hh = 0; hh < 4; ++hh) {
                    const f32x4 qa = *(const LAS f32x4*)(qs + hh * 64 + 8 * c), qb = *(const LAS f32x4*)(qs + hh * 64 + 8 * c + 4);
                    s0[hh] += (qa.x * bflo(ka.x) + qa.y * bfhi(ka.x)) + (qa.z * bflo(ka.y) + qa.w * bfhi(ka.y)) + (qb.x * bflo(ka.z) + qb.y * bfhi(ka.z)) + (qb.z * bflo(ka.w) + qb.w * bfhi(ka.w));
                    s1[hh] += (qa.x * bflo(kb.x) + qa.y * bfhi(kb.x)) + (qa.z * bflo(kb.y) + qa.w * bfhi(kb.y)) + (qb.x * bflo(kb.z) + qb.y * bfhi(kb.z)) + (qb.z * bflo(kb.w) + qb.w * bfhi(kb.w));
                }
            }
            float p0[4], p1[4];
#pragma unroll
            for (int hh = 0; hh < 4; ++hh) {
                const float a0 = v0 ? s0[hh] : -INFINITY, a1 = v1 ? s1[hh] : -INFINITY;
                const float mx = wave_max(fmaxf(a0, a1));
                if (ncv > 0) {
                    const float e0 = v0 ? __expf(a0 - mx) : 0.f, e1 = v1 ? __expf(a1 - mx) : 0.f;
                    const float inv = 1.0f / wave_sum(e0 + e1);
                    p0[hh] = e0 * inv; p1[hh] = e1 * inv;
                } else { p0[hh] = 0.f; p1[hh] = 0.f; }
                psum0 += p0[hh]; psum1 += p1[hh];
            }
#pragma unroll 2
            for (int c = 0; c < ncv; ++c) {
                const float v = bf2f(VC[((size_t)(b * 128 + c) * 2 + g) * 64 + lane]);
#pragma unroll
                for (int hh = 0; hh < 4; ++hh) oc[hh] += __shfl(c < 64 ? p0[hh] : p1[hh], c & 63) * v;
            }
        }
        ps[lane] = psum0; ps[64 + lane] = psum1;
        LDS_WAIT();
        const int cur = t >> 6;
        unsigned selmask;
        {
            const int j = lane & 31;
            float imp = ps[4 * j] + ps[4 * j + 1] + ps[4 * j + 2] + 0.5f * ps[4 * j + 3] + (j > 0 ? 0.5f * ps[4 * j - 1] : 0.f);
            const bool valid = j <= cur, forced = (j == 0) || (j == cur) || (j == cur - 1);
            const float score = valid ? imp + (forced ? 1000.0f : 0.f) : -INFINITY;
            int rank = 0;
#pragma unroll 8
            for (int jj = 0; jj < 32; ++jj) { const float sj = __shfl(score, jj); rank += (sj > score || (sj == score && jj < j)) ? 1 : 0; }
            const bool sel = valid && rank < 8 && lane < 32;
            selmask = (unsigned)__ballot(sel);
        }
        LDS_WAIT();
        float o1[4] = {0.f, 0.f, 0.f, 0.f}, o2[4] = {0.f, 0.f, 0.f, 0.f};
#pragma unroll 1
        for (int pass = 0; pass < 2; ++pass) {
            float oa[4] = {0.f, 0.f, 0.f, 0.f}, ma[4] = {-INFINITY, -INFINITY, -INFINITY, -INFINITY}, la[4] = {0.f, 0.f, 0.f, 0.f};
            const int lo = pass ? (t - 255 > 0 ? t - 255 : 0) : 0;
            const unsigned bm = pass ? 0xffffffffu : selmask;
            const bf16* Kb = pass ? KW : KS; const int vc = pass ? C_VW : C_VS;
#pragma unroll 1
            for (int j = lo >> 6; j <= cur; ++j) {
                if (!((bm >> j) & 1u)) continue;
                const int key = 64 * j + lane; const size_t kt = (size_t)(b * S + key);
                nsa_block(qs, Kb + kt * 128 + g * 64, key <= t && key >= lo, HY + (size_t)(b * S + 64 * j) * HYN + vc + g * 64, HYN, lane, ma, la, oa);
            }
            if (pass == 0) {
#pragma unroll
                for (int hh = 0; hh < 4; ++hh) o1[hh] = oa[hh] / la[hh];
            } else {
#pragma unroll
                for (int hh = 0; hh < 4; ++hh) o2[hh] = oa[hh] / la[hh];
            }
        }
#pragma unroll
        for (int hh = 0; hh < 4; ++hh) {
            const int head = g * 4 + hh;
            const float* gb = A->in[I_GATEB] + i * 24 + head * 3;
            const bf16* gl = HY + (size_t)tok * HYN + C_GA + head * 3;
            const float g0 = sigmoidf_(bf2f(gl[0]) + gb[0]), g1 = sigmoidf_(bf2f(gl[1]) + gb[1]), g2 = sigmoidf_(bf2f(gl[2]) + gb[2]);
            const float o = g0 * oc[hh] + g1 * o1[hh] + g2 * o2[hh];
            CAT[(size_t)tok * 1024 + head * 64 + lane] = (bf16)f2bf(o);
        }
    }
}

__device__ __forceinline__ void phase_gla_seq(KArgs A, int wv_, int i, LAS unsigned char* lds) {
    const int tid = opaque_tid(wv_), wid = __builtin_amdgcn_readfirstlane(tid >> 6), lane = tid & 63;
    unsigned char* ws = opq(A->ws);
    const bf16* HY = (const bf16*)(ws + WS_BIG); bf16* CAT = (bf16*)(ws + WS_CAT);
    constexpr int CH = 16;
    LAS float* la = (LAS float*)lds;
    LAS float* lk = la + 4 * CH * 64;
    LAS float* lq = lk + 4 * CH * 64;
    LAS float* lo = lq + 4 * CH * 64;
    const float* wa2 = A->in[I_WA2] + i * 16 * 256; const float* ba = A->in[I_BA] + i * 256; const float* og = A->in[I_ONORM] + i * 128;
    for (int it = blockIdx.x; it < 8; it += gridDim.x) {
        const int pl = tid >> 7, v = tid & 127, p = it * 4 + pl, b = p >> 2, h = p & 3;
        float St[64];
#pragma unroll
        for (int k = 0; k < 64; ++k) St[k] = 0.f;
        for (int c0 = 0; c0 < S; c0 += CH) {
            __syncthreads();
            for (int e = tid; e < 4 * CH * 64; e += 512) {
                const int kk = e & 63, tk = (e >> 6) % CH, pp = e / (64 * CH); const int pb = (it * 4 + pp) >> 2, ph = (it * 4 + pp) & 3;
                const size_t tok = (size_t)pb * S + c0 + tk; const bf16* row = HY + tok * HYN;
                float z = ba[ph * 64 + kk];
#pragma unroll
                for (int r = 0; r < 16; ++r) z += bf2f(row[C_AL + r]) * wa2[r * 256 + ph * 64 + kk];
                const float ls_ = fminf(z, 0.f) - log1pf(__expf(-fabsf(z)));
                la[e] = __expf(ls_ * (1.f / 16.f));
                lk[e] = bf2f(row[C_KB + ph * 64 + kk]);
                lq[e] = bf2f(row[C_QB + ph * 64 + kk]) * 0.125f;
            }
            __syncthreads();
            for (int tk = 0; tk < CH; ++tk) {
                const size_t tok = (size_t)b * S + c0 + tk;
                const float vv = bf2f(HY[tok * HYN + C_VB + h * 128 + v]);
                const LAS float* pa = la + (pl * CH + tk) * 64; const LAS float* pk = lk + (pl * CH + tk) * 64; const LAS float* pq = lq + (pl * CH + tk) * 64;
                float o = 0.f;
#pragma unroll
                for (int k4 = 0; k4 < 16; ++k4) {
                    const f32x4 a4 = *(const LAS f32x4*)(pa + 4 * k4), k4v = *(const LAS f32x4*)(pk + 4 * k4), q4 = *(const LAS f32x4*)(pq + 4 * k4);
                    St[4 * k4 + 0] = a4.x * St[4 * k4 + 0] + k4v.x * vv; o += q4.x * St[4 * k4 + 0];
                    St[4 * k4 + 1] = a4.y * St[4 * k4 + 1] + k4v.y * vv; o += q4.y * St[4 * k4 + 1];
                    St[4 * k4 + 2] = a4.z * St[4 * k4 + 2] + k4v.z * vv; o += q4.z * St[4 * k4 + 2];
                    St[4 * k4 + 3] = a4.w * St[4 * k4 + 3] + k4v.w * vv; o += q4.w * St[4 * k4 + 3];
                }
                lo[(pl * CH + tk) * 128 + v] = o;
            }
            __syncthreads();
            for (int r = wid; r < 4 * CH; r += 8) {
                const int pp = r / CH, tk = r % CH; const int pb = (it * 4 + pp) >> 2, ph = (it * 4 + pp) & 3;
                const size_t tok = (size_t)pb * S + c0 + tk;
                const float x0 = lo[r * 128 + lane], x1 = lo[r * 128 + 64 + lane];
                const float rstd = rsqrtf(wave_sum(x0 * x0 + x1 * x1) * (1.f / 128.f) + EPS);
                const float r0 = bf2f(HY[tok * HYN + C_RB + ph * 128 + lane]), r1 = bf2f(HY[tok * HYN + C_RB + ph * 128 + 64 + lane]);
                CAT[tok * 1024 + 512 + ph * 128 + lane] = (bf16)f2bf(x0 * rstd * og[lane] * (r0 * sigmoidf_(r0)));
                CAT[tok * 1024 + 512 + ph * 128 + 64 + lane] = (bf16)f2bf(x1 * rstd * og[64 + lane] * (r1 * sigmoidf_(r1)));
            }
        }
        __syncthreads();
    }
}


__device__ __forceinline__ void phase_nsa_attn_mfma(KArgs A, int wv_, int i, LAS unsigned char* lds) {
    const int tid = opaque_tid(wv_), wid = __builtin_amdgcn_readfirstlane(tid >> 6), lane = tid & 63, fr = lane & 15, fq = lane >> 4;
    unsigned char* ws = opq(A->ws);
    const bf16* HY = (const bf16*)(ws + WS_BIG); const bf16* QA = (const bf16*)(ws + WS_QA); const bf16* KS = (const bf16*)(ws + WS_KS); const bf16* KW = (const bf16*)(ws + WS_KW);
    const bf16* KC = (const bf16*)(ws + WS_KC); const bf16* VCT = (const bf16*)(ws + WS_VC); const bf16* VTA = (const bf16*)(ws + WS_VTA); bf16* CAT = (bf16*)(ws + WS_CAT);
    constexpr int RS = 72;
    LAS bf16* ktl = (LAS bf16*)lds;
    LAS bf16* vtl = ktl + 2 * 64 * RS;
    LAS float* scl = (LAS float*)(lds + 36864) + wid * 256;
    LAS unsigned* msk = (LAS unsigned*)(lds + 36864 + 8192);
    LAS unsigned* umask = msk + 64;
    const float* gb = A->in[I_GATEB] + i * 24;
    for (int pit = blockIdx.x; pit < 256; pit += gridDim.x) {
#pragma unroll 1
        for (int hf = 0; hf < 2; ++hf) {
            const int bg = pit >> 4, xx = pit & 15, x = hf ? 31 - xx : xx, b = bg >> 1, g = bg & 1;
            const size_t tokbase = (size_t)b * S + 64 * x;
            const int tl0 = 8 * wid + (fr >> 2);
            if (tid == 0) *umask = 0u;
            bf16x8 qf[2][2];
#pragma unroll
            for (int mt = 0; mt < 2; ++mt)
#pragma unroll
                for (int s = 0; s < 2; ++s) qf[mt][s] = *(const bf16x8*)(QA + (tokbase + tl0 + 4 * mt) * 512 + (g * 4 + (fr & 3)) * 64 + 32 * s + 8 * fq);
            f32x4 outacc[2][4];
            {
                const int tmaxc = (4 * x + 3 + 15) >> 4;
                const bf16* kcb = KC + ((size_t)(b * 128 + fr) * 2 + g) * 64 + 8 * fq;
                bf16x8 pcf[2][4];
#pragma unroll
                for (int mt = 0; mt < 2; ++mt) {
                    f32x4 sc[8];
                    const bf16* kp = kcb;
#pragma unroll
                    for (int t = 0; t < 8; ++t) { sc[t] = (f32x4){0.f, 0.f, 0.f, 0.f};
                        asm volatile("" : "+v"(kp));
                        if (t < tmaxc) {
                            const bf16x8 k0 = *(const bf16x8*)(kp), k1 = *(const bf16x8*)(kp + 32);
                            sc[t] = __builtin_amdgcn_mfma_f32_16x16x32_bf16(k0, qf[mt][0], sc[t], 0, 0, 0);
                            sc[t] = __builtin_amdgcn_mfma_f32_16x16x32_bf16(k1, qf[mt][1], sc[t], 0, 0, 0); }
                        kp += 16 * 128; }
                    const int tg = 64 * x + tl0 + 4 * mt; const int ncv = tg >= 31 ? ((tg - 31) >> 4) + 1 : 0;
                    float mx = -INFINITY;
#pragma unroll
                    for (int t = 0; t < 8; ++t)
#pragma unroll
                        for (int r = 0; r < 4; ++r) { const bool v = 16 * t + 4 * fq + r < ncv; sc[t][r] = v ? sc[t][r] : -INFINITY; mx = fmaxf(mx, sc[t][r]); }
                    mx = fmaxf(mx, __shfl_xor(mx, 16)); mx = fmaxf(mx, __shfl_xor(mx, 32));
                    const float mxs = mx == -INFINITY ? 0.f : mx;
                    float sum = 0.f;
#pragma unroll
                    for (int t = 0; t < 8; ++t)
#pragma unroll
                        for (int r = 0; r < 4; ++r) { sc[t][r] = __expf(sc[t][r] - mxs); sum += sc[t][r]; }
                    sum += __shfl_xor(sum, 16); sum += __shfl_xor(sum, 32);
                    const float inv = sum > 0.f ? 1.f / sum : 0.f;
#pragma unroll
                    for (int t = 0; t < 8; ++t) sc[t] = sc[t] * inv;
#pragma unroll
                    for (int s = 0; s < 4; ++s) { u32x4 w; w.x = pk2(sc[2 * s].x, sc[2 * s].y); w.y = pk2(sc[2 * s].z, sc[2 * s].w); w.z = pk2(sc[2 * s + 1].x, sc[2 * s + 1].y); w.w = pk2(sc[2 * s + 1].z, sc[2 * s + 1].w);
                        pcf[mt][s] = __builtin_bit_cast(bf16x8, w); }
                    float w3[8];
#pragma unroll
                    for (int t = 0; t < 8; ++t) {
#pragma unroll
                        for (int r = 0; r < 4; ++r) { float v = sc[t][r]; v += __shfl_xor(v, 1); v += __shfl_xor(v, 2); sc[t][r] = v; }
                        w3[t] = __shfl(sc[t].w, (lane + 48) & 63);
                    }
#pragma unroll
                    for (int t = 0; t < 8; ++t) {
                        const float prev = fq > 0 ? w3[t] : (t > 0 ? w3[t > 0 ? t - 1 : 0] : 0.f);
                        const float imp = sc[t].x + sc[t].y + sc[t].z + 0.5f * sc[t].w + 0.5f * prev;
                        if ((fr & 3) == 0) scl[(4 * mt + (fr >> 2)) * 32 + 4 * t + fq] = imp;
                    }
                    asm volatile("" ::: "memory");
                }
                const bf16* vcb = VCT + ((size_t)(b * 2 + g) * 64 + fr) * 128 + 8 * fq;
#pragma unroll
                for (int n = 0; n < 4; ++n) {
                    outacc[0][n] = (f32x4){0.f, 0.f, 0.f, 0.f}; outacc[1][n] = (f32x4){0.f, 0.f, 0.f, 0.f};
                    asm volatile("" : "+v"(vcb));
#pragma unroll
                    for (int s = 0; s < 4; ++s) if (2 * s < tmaxc) {
                        const bf16x8 vf = *(const bf16x8*)(vcb + 32 * s);
                        outacc[0][n] = __builtin_amdgcn_mfma_f32_16x16x32_bf16(vf, pcf[0][s], outacc[0][n], 0, 0, 0);
                        outacc[1][n] = __builtin_amdgcn_mfma_f32_16x16x32_bf16(vf, pcf[1][s], outacc[1][n], 0, 0, 0); }
                    vcb += 16 * 128;
                    asm volatile("" ::: "memory");
                }
            }
            float g1v[2], g2v[2];
#pragma unroll
            for (int mt = 0; mt < 2; ++mt) {
                const int head = g * 4 + (fr & 3);
                const bf16* gl = HY + (tokbase + tl0 + 4 * mt) * HYN + C_GA + head * 3;
                const float g0 = sigmoidf_(bf2f(gl[0]) + gb[head * 3 + 0]);
                g1v[mt] = sigmoidf_(bf2f(gl[1]) + gb[head * 3 + 1]); g2v[mt] = sigmoidf_(bf2f(gl[2]) + gb[head * 3 + 2]);
#pragma unroll
                for (int n = 0; n < 4; ++n) outacc[mt][n] = outacc[mt][n] * g0;
            }
            LDS_WAIT();
            asm volatile("" ::: "memory");
            {
                const int tok8 = lane >> 3, jg = lane & 7;
                float sj[32];
#pragma unroll
                for (int q = 0; q < 8; ++q) { const f32x4 v = *(const LAS f32x4*)(scl + tok8 * 32 + 4 * q); sj[4 * q] = v.x; sj[4 * q + 1] = v.y; sj[4 * q + 2] = v.z; sj[4 * q + 3] = v.w; }
#pragma unroll
                for (int j = 0; j < 32; ++j) sj[j] = j <= x ? sj[j] + ((j == 0 || j == x || j == x - 1) ? 1000.0f : 0.f) : -INFINITY;
                unsigned bits = 0u;
                const f32x4 mv = *(const LAS f32x4*)(scl + tok8 * 32 + 4 * jg);
#pragma unroll
                for (int q = 0; q < 4; ++q) {
                    const int j = 4 * jg + q;
                    const float mine = j <= x ? mv[q] + ((j == 0 || j == x || j == x - 1) ? 1000.0f : 0.f) : -INFINITY;
                    int rank = 0;
#pragma unroll
                    for (int jj = 0; jj < 32; ++jj) rank += (sj[jj] > mine || (sj[jj] == mine && jj < j)) ? 1 : 0;
                    bits |= (j <= x && rank < 8) ? (1u << j) : 0u;
                }
                bits |= __shfl_xor(bits, 1); bits |= __shfl_xor(bits, 2); bits |= __shfl_xor(bits, 4);
                if (jg == 0) { msk[wid * 8 + tok8] = bits; atomicOr((unsigned*)umask, bits); }
            }
            __syncthreads();
#pragma unroll 1
            for (int pass = 0; pass < 2; ++pass) {
                const int jlo = pass ? (x >= 4 ? x - 4 : 0) : 0;
                const unsigned inrange = (x >= 31 ? 0xffffffffu : ((2u << x) - 1u)) & ~((1u << jlo) - 1u);
                unsigned bmask = pass ? inrange : (*umask & inrange);
                const bf16* Kb = pass ? KW : KS; const int cg = (pass ? 10 : 8) + g;
                unsigned tm[2], wm[2];
#pragma unroll
                for (int mt = 0; mt < 2; ++mt) {
                    tm[mt] = pass ? 0xffffffffu : msk[wid * 8 + 4 * mt + (fr >> 2)];
                    wm[mt] = pass ? 0xffffffffu : (msk[wid * 8 + 4 * mt] | msk[wid * 8 + 4 * mt + 1] | msk[wid * 8 + 4 * mt + 2] | msk[wid * 8 + 4 * mt + 3]);
                    wm[mt] = __builtin_amdgcn_readfirstlane(wm[mt]);
                }
                f32x4 o[2][4]; float mrun[2], lrun[2];
#pragma unroll
                for (int mt = 0; mt < 2; ++mt) { mrun[mt] = -INFINITY; lrun[mt] = 0.f;
#pragma unroll
                    for (int n = 0; n < 4; ++n) o[mt][n] = (f32x4){0.f, 0.f, 0.f, 0.f}; }
                const int srow = tid >> 3, sc16 = tid & 7;
                u32x4 pk_, pv_;
                int j = __ffs(bmask) - 1;
                {   const bf16* ksrc = Kb + ((size_t)b * S + 64 * j + srow) * 128 + g * 64 + sc16 * 8; const bf16* vsrc = VTA + ((size_t)((b * 32 + j) * 12 + cg)) * 4096 + srow * 64 + sc16 * 8;
                    pk_ = *(const u32x4*)ksrc; pv_ = *(const u32x4*)vsrc; }
                int buf = 0;
                while (j >= 0) {
                    *(LAS u32x4*)(ktl + buf * 64 * RS + srow * RS + sc16 * 8) = pk_; *(LAS u32x4*)(vtl + buf * 64 * RS + srow * RS + sc16 * 8) = pv_;
                    bmask &= bmask - 1u;
                    const int jn = bmask ? __ffs(bmask) - 1 : -1;
                    if (jn >= 0) { const bf16* ksrc = Kb + ((size_t)b * S + 64 * jn + srow) * 128 + g * 64 + sc16 * 8; const bf16* vsrc = VTA + ((size_t)((b * 32 + jn) * 12 + cg)) * 4096 + srow * 64 + sc16 * 8;
                        pk_ = *(const u32x4*)ksrc; pv_ = *(const u32x4*)vsrc; }
                    __syncthreads();
                    const LAS bf16* kt = ktl + buf * 64 * RS + fr * RS + 8 * fq; const LAS bf16* vt = vtl + buf * 64 * RS + fr * RS + 8 * fq;
#pragma unroll
                    for (int mt = 0; mt < 2; ++mt) {
                        if (!((wm[mt] >> j) & 1u)) continue;
                        f32x4 sc[4];
#pragma unroll
                        for (int t = 0; t < 4; ++t) { sc[t] = (f32x4){0.f, 0.f, 0.f, 0.f};
                            sc[t] = __builtin_amdgcn_mfma_f32_16x16x32_bf16(*(const LAS bf16x8*)(kt + t * 16 * RS), qf[mt][0], sc[t], 0, 0, 0);
                            sc[t] = __builtin_amdgcn_mfma_f32_16x16x32_bf16(*(const LAS bf16x8*)(kt + t * 16 * RS + 32), qf[mt][1], sc[t], 0, 0, 0); }
                        const int tl = tl0 + 4 * mt;
                        const bool rowok = (tm[mt] >> j) & 1u;
                        const int kphi = j == x ? tl : 63;
                        const int kplo = (pass && j == x - 4) ? tl + 1 : 0;
                        float bm = -INFINITY;
#pragma unroll
                        for (int t = 0; t < 4; ++t)
#pragma unroll
                            for (int r = 0; r < 4; ++r) { const int kp = 16 * t + 4 * fq + r; const bool v = rowok && kp <= kphi && kp >= kplo; sc[t][r] = v ? sc[t][r] : -INFINITY; bm = fmaxf(bm, sc[t][r]); }
                        bm = fmaxf(bm, __shfl_xor(bm, 16)); bm = fmaxf(bm, __shfl_xor(bm, 32));
                        const float mn = fmaxf(mrun[mt], bm); const float mns = mn == -INFINITY ? 0.f : mn;
                        const float alpha = __expf(mrun[mt] - mns);
                        float rs = 0.f;
#pragma unroll
                        for (int t = 0; t < 4; ++t)
#pragma unroll
                            for (int r = 0; r < 4; ++r) { sc[t][r] = __expf(sc[t][r] - mns); rs += sc[t][r]; }
                        rs += __shfl_xor(rs, 16); rs += __shfl_xor(rs, 32);
                        lrun[mt] = lrun[mt] * alpha + rs; mrun[mt] = mn;
                        bf16x8 pf[2];
#pragma unroll
                        for (int s = 0; s < 2; ++s) { u32x4 w; w.x = pk2(sc[2 * s].x, sc[2 * s].y); w.y = pk2(sc[2 * s].z, sc[2 * s].w); w.z = pk2(sc[2 * s + 1].x, sc[2 * s + 1].y); w.w = pk2(sc[2 * s + 1].z, sc[2 * s + 1].w);
                            pf[s] = __builtin_bit_cast(bf16x8, w); }
#pragma unroll
                        for (int n = 0; n < 4; ++n) { o[mt][n] = o[mt][n] * alpha;
                            o[mt][n] = __builtin_amdgcn_mfma_f32_16x16x32_bf16(*(const LAS bf16x8*)(vt + n * 16 * RS), pf[0], o[mt][n], 0, 0, 0);
                            o[mt][n] = __builtin_amdgcn_mfma_f32_16x16x32_bf16(*(const LAS bf16x8*)(vt + n * 16 * RS + 32), pf[1], o[mt][n], 0, 0, 0); }
                    }
                    j = jn; buf ^= 1;
                }
#pragma unroll
                for (int mt = 0; mt < 2; ++mt) { const float sc_ = (pass ? g2v[mt] : g1v[mt]) / lrun[mt];
#pragma unroll
                    for (int n = 0; n < 4; ++n) outacc[mt][n] = outacc[mt][n] + o[mt][n] * sc_; }
                __syncthreads();
            }
#pragma unroll
            for (int mt = 0; mt < 2; ++mt) {
                bf16* dst = CAT + (tokbase + tl0 + 4 * mt) * 1024 + (g * 4 + (fr & 3)) * 64 + 4 * fq;
#pragma unroll
                for (int n = 0; n < 4; ++n) { u32x2 w; w.x = pk2(outacc[mt][n].x, outacc[mt][n].y); w.y = pk2(outacc[mt][n].z, outacc[mt][n].w); *(u32x2*)(dst + 16 * n) = w; }
            }
        }
    }
    __syncthreads();
}

__device__ __forceinline__ void phase_vtiles(KArgs A, int wv_, LAS unsigned char* lds) {
    const int tid_ = opaque_tid(wv_); const int wid = __builtin_amdgcn_readfirstlane(tid_ >> 6), lane = tid_ & 63; const int gw = blockIdx.x * 8 + wid, NGW = gridDim.x * 8;
    unsigned char* ws = opq(A->ws);
    const bf16* HY = (const bf16*)(ws + WS_BIG); bf16* VTA = (bf16*)(ws + WS_VTA);
    constexpr int TS = 66;
    LAS bf16* tl = (LAS bf16*)(lds + 65536) + wid * (64 * TS);
    for (int it = gw; it < NBATCH * 32 * 12; it += NGW) {
        const int cg = it % 12, bc = it / 12;
        const int colbase = cg < 8 ? C_VB + cg * 64 : (cg < 10 ? C_VS + (cg - 8) * 64 : C_VW + (cg - 10) * 64);
        const u32x4* src = (const u32x4*)(HY + (size_t)(bc * 64 + lane) * HYN + colbase);
        u32x4 w[8];
#pragma unroll
        for (int i = 0; i < 8; ++i) w[i] = src[i];
#pragma unroll
        for (int i = 0; i < 8; ++i) { LAS unsigned* d = (LAS unsigned*)(tl + lane * TS + 8 * i); d[0] = w[i].x; d[1] = w[i].y; d[2] = w[i].z; d[3] = w[i].w; }
        LDS_WAIT();
        bf16* dst = VTA + (size_t)it * 4096 + lane * 64;
#pragma unroll
        for (int p8 = 0; p8 < 8; ++p8) {
            unsigned short x[8];
#pragma unroll
            for (int j = 0; j < 8; ++j) x[j] = tl[kperm64(p8 * 8 + j) * TS + lane];
            u32x4 o; o.x = x[0] | ((unsigned)x[1] << 16); o.y = x[2] | ((unsigned)x[3] << 16); o.z = x[4] | ((unsigned)x[5] << 16); o.w = x[6] | ((unsigned)x[7] << 16);
            *(u32x4*)(dst + p8 * 8) = o;
        }
        LDS_WAIT();
    }
}

__device__ __forceinline__ float log_sigmoid16(float z) { return (fminf(z, 0.f) - __logf(1.0f + __expf(-fabsf(z)))) * (1.f / 16.f); }
#define GLA_Z(tokv) ({ float z_ = bias; _Pragma("unroll") for (int r_ = 0; r_ < 16; ++r_) z_ += __builtin_bit_cast(float, __builtin_amdgcn_readlane(__builtin_bit_cast(int, al[r_]), (tokv))) * wc[r_]; z_; })
#define GLA_LOAD_GATE() \
    float al[16], wc[16]; \
    { const u32x4* ap_ = (const u32x4*)(HY + (size_t)(tok0 + lane) * HYN + C_AL); const u32x4 a0_ = ap_[0], a1_ = ap_[1]; \
      al[0] = bflo(a0_.x); al[1] = bfhi(a0_.x); al[2] = bflo(a0_.y); al[3] = bfhi(a0_.y); al[4] = bflo(a0_.z); al[5] = bfhi(a0_.z); al[6] = bflo(a0_.w); al[7] = bfhi(a0_.w); \
      al[8] = bflo(a1_.x); al[9] = bfhi(a1_.x); al[10] = bflo(a1_.y); al[11] = bfhi(a1_.y); al[12] = bflo(a1_.z); al[13] = bfhi(a1_.z); al[14] = bflo(a1_.w); al[15] = bfhi(a1_.w); } \
    _Pragma("unroll") for (int r_ = 0; r_ < 16; ++r_) wc[r_] = A->in[I_WA2][(i * 16 + r_) * 256 + h * 64 + lane]; \
    const float bias = A->in[I_BA][i * 256 + h * 64 + lane];

__device__ __forceinline__ void phase_gla_a(KArgs A, int wv_, int i, LAS unsigned char* lds) {
    const int tid_ = opaque_tid(wv_); const int wid = __builtin_amdgcn_readfirstlane(tid_ >> 6), lane = tid_ & 63, fr = lane & 15, fq = lane >> 4; const int gw = blockIdx.x * 8 + wid, NGW = gridDim.x * 8;
    unsigned char* ws = opq(A->ws);
    const bf16* HY = (const bf16*)(ws + WS_BIG); const bf16* VTA = (const bf16*)(ws + WS_VTA); float* SLOC = (float*)(ws + WS_SLOC); float* DEC = (float*)(ws + WS_DEC);
    constexpr int RS = 72;
    LAS bf16* kh = (LAS bf16*)lds + wid * (64 * RS);
    (void)gw;
    for (int it = wid * (int)gridDim.x + (int)blockIdx.x; it < 1024; it += NGW) {
        const int c = it & 31, bh = it >> 5, b = bh >> 2, h = bh & 3; const size_t tok0 = (size_t)b * S + c * 64;
        GLA_LOAD_GATE();
        float bl = 0.f;
#pragma unroll 4
        for (int tk = 0; tk < 64; ++tk) bl += log_sigmoid16(GLA_Z(tk));
        float bc = 0.f;
#pragma unroll 4
        for (int tk = 0; tk < 64; ++tk) {
            bc += log_sigmoid16(GLA_Z(tk));
            const float kv = bf2f(HY[(tok0 + tk) * HYN + C_KB + h * 64 + lane]);
            kh[lane * RS + kpos64(tk)] = (bf16)f2bf(kv * __expf(bl - bc));
        }
        DEC[it * 64 + lane] = __expf(bl);
        LDS_WAIT();
#pragma unroll
        for (int dvh = 0; dvh < 2; ++dvh) {
            const bf16* vt = VTA + ((size_t)((b * 32 + c) * 12 + h * 2 + dvh)) * 4096;
            bf16x8 vf[4][2];
#pragma unroll
            for (int n = 0; n < 4; ++n)
#pragma unroll
                for (int s = 0; s < 2; ++s) vf[n][s] = *(const bf16x8*)(vt + (16 * n + fr) * 64 + 32 * s + 8 * fq);
#pragma unroll
            for (int m = 0; m < 4; ++m) {
                const bf16x8 a0 = *(const LAS bf16x8*)(kh + (16 * m + fr) * RS + 8 * fq), a1 = *(const LAS bf16x8*)(kh + (16 * m + fr) * RS + 32 + 8 * fq);
#pragma unroll
                for (int n = 0; n < 4; ++n) {
                    f32x4 acc = (f32x4){0.f, 0.f, 0.f, 0.f};
                    acc = __builtin_amdgcn_mfma_f32_16x16x32_bf16(a0, vf[n][0], acc, 0, 0, 0);
                    acc = __builtin_amdgcn_mfma_f32_16x16x32_bf16(a1, vf[n][1], acc, 0, 0, 0);
                    float* dst = SLOC + ((size_t)it * 64 + 16 * m + 4 * fq) * 128 + dvh * 64 + 16 * n + fr;
                    dst[0] = acc.x; dst[128] = acc.y; dst[256] = acc.z; dst[384] = acc.w;
                }
            }
        }
        LDS_WAIT();
    }
}
__device__ __forceinline__ void phase_gla_c(KArgs A, int wv_, int i, LAS unsigned char* lds) {
    const int tid_ = opaque_tid(wv_); const int wid = __builtin_amdgcn_readfirstlane(tid_ >> 6), lane = tid_ & 63, fr = lane & 15, fq = lane >> 4; const int gw = blockIdx.x * 8 + wid, NGW = gridDim.x * 8;
    unsigned char* ws = opq(A->ws);
    const bf16* HY = (const bf16*)(ws + WS_BIG); const bf16* VTA = (const bf16*)(ws + WS_VTA); const bf16* STT = (const bf16*)(ws + WS_STT); bf16* CAT = (bf16*)(ws + WS_CAT);
    constexpr int RS = 72;
    LAS bf16* qs = (LAS bf16*)lds + wid * (128 * RS);
    LAS bf16* ks = qs + 64 * RS;
    const float* og = A->in[I_ONORM] + i * 128;
    (void)gw; (void)NGW;
    for (int blk = blockIdx.x; blk < 128; blk += gridDim.x) {
        {
            const float* SLOC = (const float*)(ws + WS_SLOC); const float* DEC = (const float*)(ws + WS_DEC); bf16* STw = (bf16*)(ws + WS_STT);
            const int tid = tid_, dv = tid & 127, ko = tid >> 7, bh = blk >> 2, c0 = (blk & 3) * 8;
            float sv[16];
#pragma unroll
            for (int j = 0; j < 16; ++j) sv[j] = 0.f;
#pragma unroll 2
            for (int c = 0; c < c0 + 8; ++c) {
                const size_t item = (size_t)bh * 32 + c;
                if (c >= c0) {
                    u32x4 o0, o1; o0.x = pk2(sv[0], sv[1]); o0.y = pk2(sv[2], sv[3]); o0.z = pk2(sv[4], sv[5]); o0.w = pk2(sv[6], sv[7]);
                    o1.x = pk2(sv[8], sv[9]); o1.y = pk2(sv[10], sv[11]); o1.z = pk2(sv[12], sv[13]); o1.w = pk2(sv[14], sv[15]);
                    u32x4* d = (u32x4*)(STw + (item * 128 + dv) * 64 + ko * 16); d[0] = o0; d[1] = o1;
                }
                if (c < c0 + 7) {
                    const float* sl = SLOC + (item * 64 + ko * 16) * 128 + dv; const float* dc = DEC + item * 64 + ko * 16;
#pragma unroll
                    for (int j = 0; j < 16; ++j) sv[j] = dc[j] * sv[j] + sl[j * 128];
                }
            }
            asm volatile("s_waitcnt vmcnt(0)" ::: "memory");
            __syncthreads();
        }
        const int it = blk * 8 + wid;
        const int c = it & 31, bh = it >> 5, b = bh >> 2, h = bh & 3; const size_t tok0 = (size_t)b * S + c * 64;
        GLA_LOAD_GATE();
        float bc = 0.f;
#pragma unroll 4
        for (int tk = 0; tk < 64; ++tk) {
            bc += log_sigmoid16(GLA_Z(tk));
            const bf16* row = HY + (tok0 + tk) * HYN;
            const float qv = bf2f(row[C_QB + h * 64 + lane]) * 0.125f, kv = bf2f(row[C_KB + h * 64 + lane]);
            qs[tk * RS + lane] = (bf16)f2bf(qv * __expf(bc)); ks[tk * RS + lane] = (bf16)f2bf(kv * __expf(-bc));
        }
        LDS_WAIT();
        bf16x8 st[8][2];
#pragma unroll
        for (int n = 0; n < 8; ++n)
#pragma unroll
            for (int s = 0; s < 2; ++s) st[n][s] = *(const bf16x8*)(STT + ((size_t)it * 128 + 16 * n + fr) * 64 + 32 * s + 8 * fq);
        const bf16* vt = VTA + ((size_t)((b * 32 + c) * 12 + h * 2)) * 4096;
#pragma unroll
        for (int mi = 0; mi < 4; ++mi) {
            const bf16x8 q0 = *(const LAS bf16x8*)(qs + (16 * mi + fr) * RS + 8 * fq), q1 = *(const LAS bf16x8*)(qs + (16 * mi + fr) * RS + 32 + 8 * fq);
            f32x4 sc[4];
#pragma unroll
            for (int t = 0; t < 4; ++t) {
                sc[t] = (f32x4){0.f, 0.f, 0.f, 0.f};
                if (t <= mi) {
                    const bf16x8 k0 = *(const LAS bf16x8*)(ks + (16 * t + fr) * RS + 8 * fq), k1 = *(const LAS bf16x8*)(ks + (16 * t + fr) * RS + 32 + 8 * fq);
                    sc[t] = __builtin_amdgcn_mfma_f32_16x16x32_bf16(k0, q0, sc[t], 0, 0, 0);
                    sc[t] = __builtin_amdgcn_mfma_f32_16x16x32_bf16(k1, q1, sc[t], 0, 0, 0);
                    if (t == mi) {
                        sc[t].x = (4 * fq + 0 <= fr) ? sc[t].x : 0.f; sc[t].y = (4 * fq + 1 <= fr) ? sc[t].y : 0.f; sc[t].z = (4 * fq + 2 <= fr) ? sc[t].z : 0.f; sc[t].w = (4 * fq + 3 <= fr) ? sc[t].w : 0.f; }
                }
            }
            bf16x8 pf[2];
#pragma unroll
            for (int s = 0; s < 2; ++s) { u32x4 w; w.x = pk2(sc[2 * s].x, sc[2 * s].y); w.y = pk2(sc[2 * s].z, sc[2 * s].w); w.z = pk2(sc[2 * s + 1].x, sc[2 * s + 1].y); w.w = pk2(sc[2 * s + 1].z, sc[2 * s + 1].w);
                pf[s] = __builtin_bit_cast(bf16x8, w); }
            f32x4 o[8]; float ssq = 0.f;
#pragma unroll
            for (int n = 0; n < 8; ++n) {
                o[n] = (f32x4){0.f, 0.f, 0.f, 0.f};
                o[n] = __builtin_amdgcn_mfma_f32_16x16x32_bf16(st[n][0], q0, o[n], 0, 0, 0);
                o[n] = __builtin_amdgcn_mfma_f32_16x16x32_bf16(st[n][1], q1, o[n], 0, 0, 0);
                const bf16* vrow = vt + (size_t)(n >> 2) * 4096 + (16 * (n & 3) + fr) * 64 + 8 * fq;
                o[n] = __builtin_amdgcn_mfma_f32_16x16x32_bf16(*(const bf16x8*)vrow, pf[0], o[n], 0, 0, 0);
                if (mi >= 2) o[n] = __builtin_amdgcn_mfma_f32_16x16x32_bf16(*(const bf16x8*)(vrow + 32), pf[1], o[n], 0, 0, 0);
                ssq += (o[n].x * o[n].x + o[n].y * o[n].y) + (o[n].z * o[n].z + o[n].w * o[n].w);
            }
            ssq += __shfl_xor(ssq, 16); ssq += __shfl_xor(ssq, 32);
            const float rstd = rsqrtf(ssq * (1.f / 128.f) + EPS);
            const size_t tok = tok0 + 16 * mi + fr;
#pragma unroll
            for (int n = 0; n < 8; ++n) {
                const int dv = 16 * n + 4 * fq;
                const u32x2 rw = *(const u32x2*)(HY + tok * HYN + C_RB + h * 128 + dv); const f32x4 g = *(const f32x4*)(og + dv);
                const float r0 = bflo(rw.x), r1 = bfhi(rw.x), r2 = bflo(rw.y), r3 = bfhi(rw.y);
                u32x2 w; w.x = pk2(o[n].x * rstd * g.x * (r0 * sigmoidf_(r0)), o[n].y * rstd * g.y * (r1 * sigmoidf_(r1)));
                w.y = pk2(o[n].z * rstd * g.z * (r2 * sigmoidf_(r2)), o[n].w * rstd * g.w * (r3 * sigmoidf_(r3)));
                *(u32x2*)(CAT + tok * 1024 + 512 + h * 128 + dv) = w;
            }
        }
        LDS_WAIT();
        __syncthreads();
    }
}

__device__ __forceinline__ void phase_sgu_mix(KArgs A, int wv_, int i, LAS unsigned char* lds) {
    const int tid = opaque_tid(wv_), wid = __builtin_amdgcn_readfirstlane(tid >> 6), lane = tid & 63;
    unsigned char* ws = opq(A->ws);
    const bf16* U = (const bf16*)(ws + WS_U); const bf16* V = (const bf16*)(ws + WS_V); bf16* UM = (bf16*)(ws + WS_UM);
    LAS float* vt = (LAS float*)lds;
    LAS float* st = vt + 128 * 256;
    const float* lng = A->in[I_LNG] + i * 2048; const float* lnb = A->in[I_LNB] + i * 2048;
    for (int it = blockIdx.x; it < NBATCH * 16 * 8; it += gridDim.x) {
        const int g = it & 7, n = (it >> 3) & 15, b = it >> 7;
        const size_t tok0 = (size_t)b * S + n * 128;
        __syncthreads();
        for (int s = wid * 16; s < wid * 16 + 16; ++s) {
            const u32x4* vr = (const u32x4*)(V + (tok0 + s) * 2048) + lane;
            float x[32]; float sum = 0.f;
#pragma unroll
            for (int j = 0; j < 4; ++j) { const u32x4 w = vr[64 * j];
                x[8 * j + 0] = bflo(w.x); x[8 * j + 1] = bfhi(w.x); x[8 * j + 2] = bflo(w.y); x[8 * j + 3] = bfhi(w.y); x[8 * j + 4] = bflo(w.z); x[8 * j + 5] = bfhi(w.z); x[8 * j + 6] = bflo(w.w); x[8 * j + 7] = bfhi(w.w); }
#pragma unroll
            for (int j = 0; j < 32; ++j) sum += x[j];
            const float mean = wave_sum(sum) * (1.f / 2048.f); float q = 0.f;
#pragma unroll
            for (int j = 0; j < 32; ++j) { const float d = x[j] - mean; q += d * d; }
            const float rstd = rsqrtf(wave_sum(q) * (1.f / 2048.f) + EPS);
            const u32x2 w = *((const u32x2*)(V + (tok0 + s) * 2048 + g * 256) + lane);
            const f32x4 gg = *(const f32x4*)(lng + g * 256 + 4 * lane), bb = *(const f32x4*)(lnb + g * 256 + 4 * lane);
            f32x4 o; o.x = (bflo(w.x) - mean) * rstd * gg.x + bb.x; o.y = (bfhi(w.x) - mean) * rstd * gg.y + bb.y; o.z = (bflo(w.y) - mean) * rstd * gg.z + bb.z; o.w = (bfhi(w.y) - mean) * rstd * gg.w + bb.w;
            *(LAS f32x4*)(vt + s * 256 + 4 * lane) = o;
            (void)st;
        }
        __syncthreads();
        const int c = tid & 255, th = tid >> 8;
        const float* wsg = A->in[I_SGWS] + (size_t)(i * 8 + g) * 128 * 128; const float* bsg = A->in[I_SGBS] + (i * 8 + g) * 128;
        for (int tt = 0; tt < 64; ++tt) {
            const int t = 2 * tt + th;
            const float* wr = wsg + t * 128;
            float acc = 0.f;
            for (int s = 0; s <= t; ++s) acc += wr[s] * vt[s * 256 + c];
            acc += bsg[t];
            const float u = bf2f(U[(tok0 + t) * 2048 + g * 256 + c]);
            UM[(tok0 + t) * 2048 + g * 256 + c] = (bf16)f2bf(u * acc);
        }
    }
    __syncthreads();
}


__device__ __forceinline__ void phase_sgu_mix_mfma(KArgs A, int wv_, int i, LAS unsigned char* lds) {
    const int tid = opaque_tid(wv_), wid = __builtin_amdgcn_readfirstlane(tid >> 6), lane = tid & 63, fr = lane & 15, fq = lane >> 4;
    unsigned char* ws = opq(A->ws);
    const bf16* U = (const bf16*)(ws + WS_U); const bf16* V = (const bf16*)(ws + WS_V); bf16* UM = (bf16*)(ws + WS_UM);
    const bf16* WSB = (const bf16*)(ws + WS_WSB) + (size_t)i * 8 * 16384; const float* M0 = (const float*)(ws + WS_M0) + i * 8 * 128;
    constexpr int VS = 136;
    LAS bf16* vT = (LAS bf16*)lds;
    LAS float* st = (LAS float*)(lds + 256 * VS * 2);
    const float* lng = A->in[I_LNG] + i * 2048; const float* lnb = A->in[I_LNB] + i * 2048; const float* bsg = A->in[I_SGBS] + i * 8 * 128;
    for (int it = blockIdx.x; it < 256; it += gridDim.x) {
        const int gh = it & 1, n_ = (it >> 1) & 15, b = it >> 5; const size_t tok0 = (size_t)b * S + n_ * 128;
        __syncthreads();
        for (int s = wid * 16; s < wid * 16 + 16; ++s) {
            const u32x4* vr = (const u32x4*)(V + (tok0 + s) * 2048) + lane;
            float x[32]; float sum = 0.f;
#pragma unroll
            for (int j = 0; j < 4; ++j) { const u32x4 w = vr[64 * j];
                x[8 * j + 0] = bflo(w.x); x[8 * j + 1] = bfhi(w.x); x[8 * j + 2] = bflo(w.y); x[8 * j + 3] = bfhi(w.y); x[8 * j + 4] = bflo(w.z); x[8 * j + 5] = bfhi(w.z); x[8 * j + 6] = bflo(w.w); x[8 * j + 7] = bfhi(w.w); }
#pragma unroll
            for (int j = 0; j < 32; ++j) sum += x[j];
            const float mean = wave_sum(sum) * (1.f / 2048.f); float q = 0.f;
#pragma unroll
            for (int j = 0; j < 32; ++j) { const float d = x[j] - mean; q += d * d; }
            const float rstd = rsqrtf(wave_sum(q) * (1.f / 2048.f) + EPS);
            if (lane == 0) { st[2 * s] = mean; st[2 * s + 1] = rstd; }
        }
#pragma unroll 1
        for (int gg = 0; gg < 4; ++gg) {
            const int g = gh * 4 + gg;
            __syncthreads();
            {
                const int s = tid & 127, cq = tid >> 7;
                const float mean = st[2 * s], rstd = st[2 * s + 1];
                const u32x4* src = (const u32x4*)(V + (tok0 + s) * 2048 + g * 256 + cq * 64);
#pragma unroll
                for (int i8 = 0; i8 < 8; ++i8) {
                    const u32x4 w = src[i8];
                    LAS bf16* d = vT + (cq * 64 + i8 * 8) * VS + s;
                    d[0 * VS] = (bf16)f2bf((bflo(w.x) - mean) * rstd); d[1 * VS] = (bf16)f2bf((bfhi(w.x) - mean) * rstd); d[2 * VS] = (bf16)f2bf((bflo(w.y) - mean) * rstd); d[3 * VS] = (bf16)f2bf((bfhi(w.y) - mean) * rstd);
                    d[4 * VS] = (bf16)f2bf((bflo(w.z) - mean) * rstd); d[5 * VS] = (bf16)f2bf((bfhi(w.z) - mean) * rstd); d[6 * VS] = (bf16)f2bf((bflo(w.w) - mean) * rstd); d[7 * VS] = (bf16)f2bf((bfhi(w.w) - mean) * rstd);
                }
            }
            __syncthreads();
            bf16x8 vf[2][4];
#pragma unroll
            for (int m = 0; m < 2; ++m)
#pragma unroll
                for (int k = 0; k < 4; ++k) vf[m][k] = *(const LAS bf16x8*)(vT + (32 * wid + 16 * m + fr) * VS + 32 * k + 8 * fq);
            const bf16* wb = WSB + ((size_t)g * 128 + fr) * 128 + 8 * fq;
            f32x4 gc[2], bc[2];
#pragma unroll
            for (int m = 0; m < 2; ++m) { gc[m] = *(const f32x4*)(lng + g * 256 + 32 * wid + 16 * m + 4 * fq); bc[m] = *(const f32x4*)(lnb + g * 256 + 32 * wid + 16 * m + 4 * fq); }
#pragma unroll
            for (int n = 0; n < 8; ++n) {
                f32x4 a0 = (f32x4){0.f, 0.f, 0.f, 0.f}, a1 = (f32x4){0.f, 0.f, 0.f, 0.f};
                asm volatile("" : "+v"(wb));
#pragma unroll
                for (int k = 0; k < 4; ++k) if (k <= (n >> 1)) {
                    const bf16x8 wf = *(const bf16x8*)(wb + 32 * k);
                    a0 = __builtin_amdgcn_mfma_f32_16x16x32_bf16(vf[0][k], wf, a0, 0, 0, 0);
                    a1 = __builtin_amdgcn_mfma_f32_16x16x32_bf16(vf[1][k], wf, a1, 0, 0, 0); }
                wb += 16 * 128;
                const int t = 16 * n + fr; const float m0 = M0[g * 128 + t], bsv = bsg[g * 128 + t];
                const size_t ro = (tok0 + t) * 2048 + g * 256 + 32 * wid + 4 * fq;
#pragma unroll
                for (int m = 0; m < 2; ++m) {
                    const f32x4 a = m ? a1 : a0;
                    const u32x2 uw = *(const u32x2*)(U + ro + 16 * m);
                    u32x2 w; w.x = pk2((a.x * gc[m].x + bc[m].x * m0 + bsv) * bflo(uw.x), (a.y * gc[m].y + bc[m].y * m0 + bsv) * bfhi(uw.x));
                    w.y = pk2((a.z * gc[m].z + bc[m].z * m0 + bsv) * bflo(uw.y), (a.w * gc[m].w + bc[m].w * m0 + bsv) * bfhi(uw.y));
                    *(u32x2*)(UM + ro + 16 * m) = w;
                }
                asm volatile("" ::: "memory");
            }
        }
    }
    __syncthreads();
}

__device__ __forceinline__ void phase_rownorm(KArgs A, int wv_) {
    const int tid_ = opaque_tid(wv_); const int wid = __builtin_amdgcn_readfirstlane(tid_ >> 6), lane = tid_ & 63; const int gw = blockIdx.x * 8 + wid, NGW = gridDim.x * 8;
    for (int m = gw; m < T; m += NGW) rms_row_to_bf16(A->out + (size_t)m * D, (bf16*)(opq(A->ws) + WS_XN) + (size_t)m * D, nullptr, lane);
}

__device__ __forceinline__ void phase_xattn(KArgs A, int wv_, int L, LAS unsigned char* lds) {
    const int tid = opaque_tid(wv_), wid = __builtin_amdgcn_readfirstlane(tid >> 6), lane = tid & 63;
    unsigned char* ws = opq(A->ws);
    const bf16* QX = (const bf16*)(ws + WS_QX); const bf16* KV = (const bf16*)(ws + WS_KV); bf16* OX = (bf16*)(ws + WS_OX);
    constexpr int KSTR = 129;
    LAS unsigned* kl = (LAS unsigned*)lds;
    LAS float* qb = (LAS float*)(lds + 132096) + wid * 256;
    LAS float* pb = (LAS float*)(lds + 132096 + 8192) + wid * 256;
    const float* qg = A->in[I_XQN] + L * 256;
    for (int it = blockIdx.x; it < NBATCH * 4 * 8; it += gridDim.x) {
        const int qc = it & 7, h = (it >> 3) & 3, b = it >> 5;
        __syncthreads();
        for (int e = tid; e < 256 * 128; e += 512) { const int m = e >> 7, dw = e & 127;
            kl[m * KSTR + dw] = *((const unsigned*)(KV + (size_t)(b * 256 + m) * 8192 + L * 2048 + h * 256) + dw); }
        __syncthreads();
        const bf16* Vb = KV + (size_t)(b * 256) * 8192 + L * 2048 + 1024 + h * 256;
        for (int tq = 0; tq < 32; ++tq) {
            const size_t tok = (size_t)b * S + qc * 256 + wid * 32 + tq;
            const u32x2 qw = *((const u32x2*)(QX + tok * 1024 + h * 256) + lane);
            const float q0 = bflo(qw.x), q1 = bfhi(qw.x), q2 = bflo(qw.y), q3 = bfhi(qw.y);
            const float rstd = rsqrtf(wave_sum(q0 * q0 + q1 * q1 + q2 * q2 + q3 * q3) * (1.f / 256.f) + EPS);
            const f32x4 gg = *(const f32x4*)(qg + 4 * lane);
            *(LAS f32x4*)(qb + 4 * lane) = (f32x4){q0 * rstd * gg.x, q1 * rstd * gg.y, q2 * rstd * gg.z, q3 * rstd * gg.w};
            LDS_WAIT();
            float s0 = 0.f, s1 = 0.f, s2 = 0.f, s3 = 0.f;
#pragma unroll 4
            for (int dw = 0; dw < 128; ++dw) {
                const f32x2 qq = *(const LAS f32x2*)(qb + 2 * dw);
                const unsigned k0 = kl[lane * KSTR + dw], k1 = kl[(lane + 64) * KSTR + dw], k2 = kl[(lane + 128) * KSTR + dw], k3 = kl[(lane + 192) * KSTR + dw];
                s0 += qq.x * bflo(k0) + qq.y * bfhi(k0); s1 += qq.x * bflo(k1) + qq.y * bfhi(k1);
                s2 += qq.x * bflo(k2) + qq.y * bfhi(k2); s3 += qq.x * bflo(k3) + qq.y * bfhi(k3);
            }
            const float mx = wave_max(fmaxf(fmaxf(s0, s1), fmaxf(s2, s3)));
            const float e0 = __expf(s0 - mx), e1 = __expf(s1 - mx), e2 = __expf(s2 - mx), e3 = __expf(s3 - mx);
            const float inv = 1.f / wave_sum((e0 + e1) + (e2 + e3));
            pb[lane] = e0 * inv; pb[lane + 64] = e1 * inv; pb[lane + 128] = e2 * inv; pb[lane + 192] = e3 * inv;
            LDS_WAIT();
            float o0 = 0.f, o1 = 0.f, o2 = 0.f, o3 = 0.f;
#pragma unroll 8
            for (int m = 0; m < 256; ++m) {
                const float p = pb[m];
                const u32x2 vw = *((const u32x2*)(Vb + (size_t)m * 8192) + lane);
                o0 += p * bflo(vw.x); o1 += p * bfhi(vw.x); o2 += p * bflo(vw.y); o3 += p * bfhi(vw.y);
            }
            u32x2 ow; ow.x = pk2(o0, o1); ow.y = pk2(o2, o3);
            *((u32x2*)(OX + tok * 1024 + h * 256) + lane) = ow;
            LDS_WAIT();
        }
    }
    __syncthreads();
}


__device__ __forceinline__ int kperm32(int p) { const int fq = (p >> 3) & 3, j = p & 7; return (p & ~31) + 16 * (j >> 2) + 4 * fq + (j & 3); }
__device__ __forceinline__ void phase_vtrans(KArgs A, int wv_, LAS unsigned char* lds) {
    const int tid = opaque_tid(wv_);
    unsigned char* ws = opq(A->ws);
    const bf16* KV = (const bf16*)(ws + WS_KV); bf16* VT = (bf16*)(ws + WS_VT);
    LAS bf16* vt = (LAS bf16*)lds;
    constexpr int VS = 258;
    for (int it = blockIdx.x; it < DEPTH * NBATCH * 4; it += gridDim.x) {
        const int h = it & 3, b = (it >> 2) & 7, l = it >> 5;
        __syncthreads();
        for (int e = tid; e < 256 * 32; e += 512) { const int m = e >> 5, c8 = e & 31;
            const u32x4 w = *(const u32x4*)(KV + (size_t)(b * 256 + m) * 8192 + l * 2048 + 1024 + h * 256 + c8 * 8);
            LAS unsigned* d = (LAS unsigned*)(vt + m * VS + c8 * 8); d[0] = w.x; d[1] = w.y; d[2] = w.z; d[3] = w.w; }
        __syncthreads();
        for (int e = tid; e < 256 * 32; e += 512) { const int dv = e & 255, p8 = e >> 8;
            unsigned short x[8];
#pragma unroll
            for (int j = 0; j < 8; ++j) x[j] = vt[kperm32(p8 * 8 + j) * VS + dv];
            u32x4 o; o.x = x[0] | ((unsigned)x[1] << 16); o.y = x[2] | ((unsigned)x[3] << 16); o.z = x[4] | ((unsigned)x[5] << 16); o.w = x[6] | ((unsigned)x[7] << 16);
            *(u32x4*)(VT + ((size_t)it * 256 + dv) * 256 + p8 * 8) = o; }
    }
    __syncthreads();
}

__device__ __forceinline__ void phase_xattn_mfma(KArgs A, int wv_, int L, LAS unsigned char* lds) {
    const int tid = opaque_tid(wv_), wid = __builtin_amdgcn_readfirstlane(tid >> 6), lane = tid & 63, fr = lane & 15, fq = lane >> 4;
    unsigned char* ws = opq(A->ws);
    const bf16* QX = (const bf16*)(ws + WS_QX); const bf16* KV = (const bf16*)(ws + WS_KV); const bf16* VT = (const bf16*)(ws + WS_VT); bf16* OX = (bf16*)(ws + WS_OX);
    constexpr int RS = 264;
    LAS bf16* kl = (LAS bf16*)lds;
    const float* qg = A->in[I_XQN] + L * 256;
    for (int it = blockIdx.x; it < NBATCH * 4 * 16; it += gridDim.x) {
        const int qt = it & 15, h = (it >> 4) & 3, b = it >> 6;
        __syncthreads();
        {
            const int row = tid >> 1, hf = tid & 1;
            const u32x4* src = (const u32x4*)(KV + (size_t)(b * 256 + row) * 8192 + L * 2048 + h * 256 + hf * 128);
#pragma unroll
            for (int i0 = 0; i0 < 16; i0 += 8) {
                u32x4 w[8];
#pragma unroll
                for (int i = 0; i < 8; ++i) w[i] = src[i0 + i];
#pragma unroll
                for (int i = 0; i < 8; ++i) *(LAS u32x4*)(kl + row * RS + hf * 128 + (i0 + i) * 8) = w[i];
            }
        }
        const size_t tok = (size_t)b * S + qt * 128 + wid * 16 + fr;
        bf16x8 qf[8];
        {
            u32x4 qw[8]; float ssq = 0.f;
#pragma unroll
            for (int s = 0; s < 8; ++s) qw[s] = *(const u32x4*)(QX + tok * 1024 + h * 256 + 32 * s + 8 * fq);
#pragma unroll
            for (int s = 0; s < 8; ++s) {
                const float a0 = bflo(qw[s].x), a1 = bfhi(qw[s].x), a2 = bflo(qw[s].y), a3 = bfhi(qw[s].y), a4 = bflo(qw[s].z), a5 = bfhi(qw[s].z), a6 = bflo(qw[s].w), a7 = bfhi(qw[s].w);
                ssq += (a0 * a0 + a1 * a1) + (a2 * a2 + a3 * a3) + (a4 * a4 + a5 * a5) + (a6 * a6 + a7 * a7);
            }
            ssq += __shfl_xor(ssq, 16); ssq += __shfl_xor(ssq, 32);
            const float rstd = rsqrtf(ssq * (1.f / 256.f) + EPS);
#pragma unroll
            for (int s = 0; s < 8; ++s) {
                const f32x4 ga = *(const f32x4*)(qg + 32 * s + 8 * fq), gb = *(const f32x4*)(qg + 32 * s + 8 * fq + 4);
                u32x4 w; w.x = pk2(bflo(qw[s].x) * rstd * ga.x, bfhi(qw[s].x) * rstd * ga.y); w.y = pk2(bflo(qw[s].y) * rstd * ga.z, bfhi(qw[s].y) * rstd * ga.w);
                w.z = pk2(bflo(qw[s].z) * rstd * gb.x, bfhi(qw[s].z) * rstd * gb.y); w.w = pk2(bflo(qw[s].w) * rstd * gb.z, bfhi(qw[s].w) * rstd * gb.w);
                qf[s] = __builtin_bit_cast(bf16x8, w);
            }
        }
        __syncthreads();
        f32x4 sc[16];
#pragma unroll
        for (int hf = 0; hf < 2; ++hf) {
            unsigned kb = (unsigned)(size_t)(kl + (128 * hf + fr) * RS + 8 * fq); asm volatile("" : "+v"(kb));
#pragma unroll
            for (int t8 = 0; t8 < 8; ++t8) { const int t = 8 * hf + t8; sc[t] = (f32x4){0.f, 0.f, 0.f, 0.f};
#pragma unroll
                for (int s = 0; s < 8; ++s) { const bf16x8 kf = *(const LAS bf16x8*)(size_t)(kb + (unsigned)((16 * t8 * RS + 32 * s) * 2));
                    sc[t] = __builtin_amdgcn_mfma_f32_16x16x32_bf16(kf, qf[s], sc[t], 0, 0, 0); }
                if (t & 1) asm volatile("" ::: "memory"); }
        }
        float mx = -INFINITY;
#pragma unroll
        for (int t = 0; t < 16; ++t) mx = fmaxf(mx, fmaxf(fmaxf(sc[t].x, sc[t].y), fmaxf(sc[t].z, sc[t].w)));
        mx = fmaxf(mx, __shfl_xor(mx, 16)); mx = fmaxf(mx, __shfl_xor(mx, 32));
        float lsum = 0.f;
#pragma unroll
        for (int t = 0; t < 16; ++t) { sc[t].x = __expf(sc[t].x - mx); sc[t].y = __expf(sc[t].y - mx); sc[t].z = __expf(sc[t].z - mx); sc[t].w = __expf(sc[t].w - mx); lsum += (sc[t].x + sc[t].y) + (sc[t].z + sc[t].w); }
        lsum += __shfl_xor(lsum, 16); lsum += __shfl_xor(lsum, 32);
        const float inv = 1.f / lsum;
        bf16x8 pf[8];
#pragma unroll
        for (int s = 0; s < 8; ++s) { u32x4 w; w.x = pk2(sc[2 * s].x, sc[2 * s].y); w.y = pk2(sc[2 * s].z, sc[2 * s].w); w.z = pk2(sc[2 * s + 1].x, sc[2 * s + 1].y); w.w = pk2(sc[2 * s + 1].z, sc[2 * s + 1].w);
            pf[s] = __builtin_bit_cast(bf16x8, w); }
        __syncthreads();
        {
            const int row = tid >> 1, hf = tid & 1;
            const u32x4* src = (const u32x4*)(VT + ((size_t)((L * 8 + b) * 4 + h) * 256 + row) * 256 + hf * 128);
#pragma unroll
            for (int i0 = 0; i0 < 16; i0 += 8) {
                u32x4 w[8];
#pragma unroll
                for (int i = 0; i < 8; ++i) w[i] = src[i0 + i];
#pragma unroll
                for (int i = 0; i < 8; ++i) *(LAS u32x4*)(kl + row * RS + hf * 128 + (i0 + i) * 8) = w[i];
            }
        }
        __syncthreads();
#pragma unroll
        for (int hf = 0; hf < 2; ++hf) {
            unsigned vb = (unsigned)(size_t)(kl + (128 * hf + fr) * RS + 8 * fq); asm volatile("" : "+v"(vb));
#pragma unroll
            for (int n8 = 0; n8 < 8; ++n8) { const int n = 8 * hf + n8; f32x4 o = (f32x4){0.f, 0.f, 0.f, 0.f};
#pragma unroll
                for (int s = 0; s < 8; ++s) { const bf16x8 vf = *(const LAS bf16x8*)(size_t)(vb + (unsigned)((16 * n8 * RS + 32 * s) * 2));
                    o = __builtin_amdgcn_mfma_f32_16x16x32_bf16(vf, pf[s], o, 0, 0, 0); }
                u32x2 w; w.x = pk2(o.x * inv, o.y * inv); w.y = pk2(o.z * inv, o.w * inv);
                *(u32x2*)(OX + tok * 1024 + h * 256 + 16 * n + 4 * fq) = w;
                if (n & 1) asm volatile("" ::: "memory"); }
        }
    }
    __syncthreads();
}

__device__ __forceinline__ void phase_route(KArgs A, int wv_, int L, LAS unsigned char* lds) {
    const int tid_ = opaque_tid(wv_); const int wid = __builtin_amdgcn_readfirstlane(tid_ >> 6), lane = tid_ & 63;
    unsigned char* ws = opq(A->ws);
    const float* RW = (const float*)(ws + WS_RW) + (size_t)L * NEXP * D;
    unsigned* cnt = (unsigned*)(ws + WS_CTL) + CW_CNT + L * 64;
    int* list = (int*)(ws + WS_LIST); int* te = (int*)(ws + WS_TOK); int* tp = te + 2 * T; float* tw = (float*)(tp + 2 * T);
    bf16* XN = (bf16*)(ws + WS_XN);
    LAS float* rwl = (LAS float*)lds;
    LAS unsigned* lcnt = (LAS unsigned*)(lds + 65536);
    LAS unsigned* lbase = lcnt + 16;
    const float rbv = A->in[I_RB][lane >> 2];
    for (int e4 = tid_; e4 < NEXP * D / 4; e4 += 512) *(LAS f32x4*)(rwl + 4 * e4) = *(const f32x4*)(RW + 4 * e4);
    for (int blk = blockIdx.x; blk < T / 64; blk += gridDim.x) {
        __syncthreads();
        if (tid_ < 16) lcnt[tid_] = 0u;
        __syncthreads();
        int e0s = 0, e1s = 0, r0s = 0, r1s = 0; float w0s = 0.f;
#pragma unroll 1
        for (int q = 0; q < 8; ++q) {
            const int t = blk * 64 + wid * 8 + q;
            const f32x4* xr = (const f32x4*)(A->out + (size_t)t * D) + lane;
            f32x4 v[4]; float s = 0.f;
#pragma unroll
            for (int j = 0; j < 4; ++j) { v[j] = xr[64 * j]; s += (v[j].x * v[j].x + v[j].y * v[j].y) + (v[j].z * v[j].z + v[j].w * v[j].w); }
            const float rstd = rsqrtf(wave_sum(s) * (1.f / 1024.f) + EPS);
            u32x2* o8 = (u32x2*)(XN + (size_t)t * D) + lane;
#pragma unroll
            for (int j = 0; j < 4; ++j) { u32x2 w; w.x = pk2(v[j].x * rstd, v[j].y * rstd); w.y = pk2(v[j].z * rstd, v[j].w * rstd); o8[64 * j] = w; }
            float a[16];
#pragma unroll
            for (int e = 0; e < 16; ++e) {
                const LAS f32x4* wr = (const LAS f32x4*)(rwl + e * D) + lane; float acc = 0.f;
#pragma unroll
                for (int j = 0; j < 4; ++j) { const f32x4 w = wr[64 * j]; acc += (v[j].x * w.x + v[j].y * w.y) + (v[j].z * w.z + v[j].w * w.w); }
                a[e] = acc;
            }
            float a8[8], a4[4], a2[2], a1;
            { const bool up = lane & 32;
#pragma unroll
              for (int k = 0; k < 8; ++k) { const float send = up ? a[k] : a[k + 8], keep = up ? a[k + 8] : a[k]; a8[k] = keep + __shfl_xor(send, 32); } }
            { const bool up = lane & 16;
#pragma unroll
              for (int k = 0; k < 4; ++k) { const float send = up ? a8[k] : a8[k + 4], keep = up ? a8[k + 4] : a8[k]; a4[k] = keep + __shfl_xor(send, 16); } }
            { const bool up = lane & 8;
#pragma unroll
              for (int k = 0; k < 2; ++k) { const float send = up ? a4[k] : a4[k + 2], keep = up ? a4[k + 2] : a4[k]; a2[k] = keep + __shfl_xor(send, 8); } }
            { const bool up = lane & 4; const float send = up ? a2[0] : a2[1], keep = up ? a2[1] : a2[0]; a1 = keep + __shfl_xor(send, 4); }
            a1 += __shfl_xor(a1, 2); a1 += __shfl_xor(a1, 1);
            const float lg = a1 * rstd + rbv;
            const float v0 = wave_max(lg);
            const int e0 = (__ffsll((unsigned long long)__ballot(lg == v0)) - 1) >> 2;
            const int gidx = e0 >> 2;
            const bool c2 = (lane >> 4) == gidx && (lane >> 2) != e0;
            const float m2 = c2 ? lg : -INFINITY;
            const float v1 = wave_max(m2);
            const int e1 = (__ffsll((unsigned long long)__ballot(c2 && m2 == v1)) - 1) >> 2;
            const float w0 = 1.f / (1.f + __expf(v1 - v0));
            unsigned r0 = 0, r1 = 0;
            if (lane == 0) { r0 = atomicAdd((unsigned*)(lcnt + e0), 1u); r1 = atomicAdd((unsigned*)(lcnt + e1), 1u); }
            r0 = __builtin_amdgcn_readfirstlane(r0); r1 = __builtin_amdgcn_readfirstlane(r1);
            if (lane == q) { e0s = e0; e1s = e1; r0s = (int)r0; r1s = (int)r1; w0s = w0; }
        }
        __syncthreads();
        if (tid_ < 16) lbase[tid_] = atomicAdd(&cnt[tid_], lcnt[tid_]);
        __syncthreads();
        if (lane < 8) {
            const int t = blk * 64 + wid * 8 + lane;
            const int p0 = (int)lbase[e0s] + r0s, p1 = (int)lbase[e1s] + r1s;
            list[e0s * T + p0] = t; list[e1s * T + p1] = t;
            te[2 * t] = e0s; te[2 * t + 1] = e1s; tp[2 * t] = p0; tp[2 * t + 1] = p1; tw[2 * t] = w0s; tw[2 * t + 1] = 1.f - w0s;
        }
    }
    __syncthreads();
}
__device__ __forceinline__ void moe_offsets(KArgs A, int wv_, int L, LAS int* off, LAS int* cn) {
    if (opaque_tid(wv_) == 0) {
        const unsigned* cnt = (const unsigned*)(opq(A->ws) + WS_CTL) + CW_CNT + L * 64;
        int o = 0;
        for (int e = 0; e < 16; ++e) { const int c = (int)__hip_atomic_load(cnt + e, __ATOMIC_RELAXED, __HIP_MEMORY_SCOPE_AGENT); off[e] = o; cn[e] = c; o += (c + 255) & ~255; }
        off[16] = o;
    }
    __syncthreads();
}
__device__ __forceinline__ void phase_moe_combine(KArgs A, int wv_, int L, LAS unsigned char* lds) {
    LAS int* off = (LAS int*)lds; LAS int* cn = off + 32;
    moe_offsets(A, wv_, L, off, cn);
    const int tid_ = opaque_tid(wv_); const int wid = __builtin_amdgcn_readfirstlane(tid_ >> 6), lane = tid_ & 63; const int gw = blockIdx.x * 8 + wid, NGW = gridDim.x * 8;
    unsigned char* ws = opq(A->ws);
    const int* te = (const int*)(ws + WS_TOK); const int* tp = te + 2 * T; const float* tw = (const float*)(tp + 2 * T);
    const bf16* Y = (const bf16*)(ws + WS_Y); bf16* XN = (bf16*)(ws + WS_XN);
    for (int t = gw; t < T; t += NGW) {
        const int sl0 = off[te[2 * t]] + tp[2 * t], sl1 = off[te[2 * t + 1]] + tp[2 * t + 1];
        const float w0 = tw[2 * t], w1 = tw[2 * t + 1];
        f32x4* xr = (f32x4*)(A->out + (size_t)t * D) + lane;
        const u32x2* y0 = (const u32x2*)(Y + (size_t)sl0 * D) + lane; const u32x2* y1 = (const u32x2*)(Y + (size_t)sl1 * D) + lane;
        f32x4 v[4]; float s = 0.f;
#pragma unroll
        for (int j = 0; j < 4; ++j) {
            v[j] = xr[64 * j]; const u32x2 a = y0[64 * j], c = y1[64 * j];
            v[j].x += w0 * bflo(a.x) + w1 * bflo(c.x); v[j].y += w0 * bfhi(a.x) + w1 * bfhi(c.x); v[j].z += w0 * bflo(a.y) + w1 * bflo(c.y); v[j].w += w0 * bfhi(a.y) + w1 * bfhi(c.y);
            xr[64 * j] = v[j];
            s += (v[j].x * v[j].x + v[j].y * v[j].y) + (v[j].z * v[j].z + v[j].w * v[j].w);
        }
        const float rstd = rsqrtf(wave_sum(s) * (1.f / 1024.f) + EPS);
        u32x2* o8 = (u32x2*)(XN + (size_t)t * D) + lane;
#pragma unroll
        for (int j = 0; j < 4; ++j) { u32x2 w; w.x = pk2(v[j].x * rstd, v[j].y * rstd); w.y = pk2(v[j].z * rstd, v[j].w * rstd); o8[64 * j] = w; }
    }
}

constexpr int PH_PER_EVEN = 5 + 8, PH_PER_ODD = 3 + 8;
constexpr int NPHASES = 3 + 2 * (PH_PER_EVEN + PH_PER_ODD);

__global__ void __launch_bounds__(512, 2) mk_fwd(Args Araw) {
    KArgs A0 = kargs();
    extern __shared__ __attribute__((aligned(16))) unsigned char lds_raw[];
    LAS unsigned char* lds = (LAS unsigned char*)lds_raw;
    volatile LAS unsigned* misc = (volatile LAS unsigned*)(lds + LDS_MISC);
    const int tid = threadIdx.x;
    if (tid < 16) misc[tid] = 0u;
    __syncthreads();
    const int lo = A0->ph_lo, hi = A0->ph_hi;
    const int wv_ = __builtin_amdgcn_readfirstlane(threadIdx.x >> 6);
    if (hi - lo > 1) (void)xcd_barrier_post((unsigned*)(A0->ws + WS_CTL) + CW_BAR, misc);
    int ph = 0;
    unsigned long long tacc_ = 0;
#define PH_BEGIN(k) if (ph >= lo && ph < hi) { const bool tprobe_ = (PROBE_TMASK >> (k)) & 1; unsigned long long tp0_ = 0; if (PROBE_TMASK && tprobe_) tp0_ = __builtin_amdgcn_s_memrealtime(); KArgs A = kargs(); unsigned char* ws = opq(A->ws); _Pragma("unroll 1") for (int rep_ = 0; rep_ < (((PROBE_MASK >> (k)) & 1) ? PROBE_REPS : 1); ++rep_)
#define PH_END   if (ph + 1 < hi) { XcdBarrier b_; b_.bar = (unsigned*)(opq(kargs()->ws) + WS_CTL) + CW_BAR; b_.x = xb_xcc_id(); b_.st = misc; xcd_barrier(b_, opaque_tid(wv_) == 0); } if (PROBE_TMASK && tprobe_) tacc_ += __builtin_amdgcn_s_memrealtime() - tp0_; } ++ph;
    const int G = gridDim.x, cb = blockIdx.x;

    PH_BEGIN(0) phase_prologue(A, wv_, lds); PH_END
    PH_BEGIN(1) {
        pg8::DenseOrder S; S.init(NBATCH * NMEM, 8192, D, (const bf16*)(ws + WS_WKV), G, cb);
        pg8::EpiBf16<0> E{(bf16*)(ws + WS_KV), 8192, 32, 0};
        pg8::gemm_phase(lds, (const bf16*)(ws + WS_MN), D, S, E, wv_);
    } PH_END
    PH_BEGIN(2) { phase_knorm(A, wv_); phase_vtrans(A, wv_, lds); } PH_END

    for (int L = 0; L < DEPTH; ++L) {
        const int i = L >> 1;
        if ((L & 1) == 0) {
            PH_BEGIN(3) {
                pg8::DenseOrder S; S.init(T, HYN, D, (const bf16*)(ws + WS_WHYB) + (size_t)i * HYN * D, G, cb);
                pg8::EpiBf16<0> E{(bf16*)(ws + WS_BIG), HYN, 12, 0};
                pg8::gemm_phase(lds, (const bf16*)(ws + WS_XN), D, S, E, wv_);
            } PH_END
            PH_BEGIN(4) { phase_compress_mfma(A, wv_, i, lds); phase_nsa_prep(A, wv_, i, lds); phase_vtiles(A, wv_, lds); } PH_END
            PH_BEGIN(5) { phase_gla_a(A, wv_, i, lds); __syncthreads(); phase_nsa_attn_mfma(A, wv_, i, lds); } PH_END
            PH_BEGIN(6) phase_gla_c(A, wv_, i, lds); PH_END
            PH_BEGIN(7) {
                pg8::DenseOrder S; S.init(T, D, D, (const bf16*)(ws + WS_WHOUT) + (size_t)i * D * D, G, cb);
                pg8::EpiResAdd E{A->out, D};
                pg8::gemm_phase(lds, (const bf16*)(ws + WS_CAT), D, S, E, wv_);
            } PH_END
        } else {
            PH_BEGIN(8) {
                pg8::DenseOrder S; S.init(T, 4096, D, (const bf16*)(ws + WS_WSGIN) + (size_t)i * 4096 * D, G, cb);
                pg8::EpiBf16<1> E{(bf16*)(ws + WS_U), 2048, 8, (size_t)(WS_V - WS_U) / 2};
                pg8::gemm_phase(lds, (const bf16*)(ws + WS_XN), D, S, E, wv_);
            } PH_END
            PH_BEGIN(9) phase_sgu_mix_mfma(A, wv_, i, lds); PH_END
            PH_BEGIN(10) {
                pg8::DenseOrder S; S.init(T, D, 2048, (const bf16*)(ws + WS_WSGOUT) + (size_t)i * D * 2048, G, cb);
                pg8::EpiResAdd E{A->out, D};
                pg8::gemm_phase(lds, (const bf16*)(ws + WS_UM), 2048, S, E, wv_);
            } PH_END
        }
        PH_BEGIN(11) phase_rownorm(A, wv_); PH_END
        PH_BEGIN(12) {
            pg8::DenseOrder S; S.init(T, D, D, (const bf16*)(ws + WS_WQ) + (size_t)L * D * D, G, cb);
            pg8::EpiBf16<0> E{(bf16*)(ws + WS_QX), D, 4, 0};
            pg8::gemm_phase(lds, (const bf16*)(ws + WS_XN), D, S, E, wv_);
        } PH_END
        PH_BEGIN(13) phase_xattn_mfma(A, wv_, L, lds); PH_END
        PH_BEGIN(14) {
            pg8::DenseOrder S; S.init(T, D, D, (const bf16*)(ws + WS_WO) + (size_t)L * D * D, G, cb);
            pg8::EpiResAdd E{A->out, D};
            pg8::gemm_phase(lds, (const bf16*)(ws + WS_OX), D, S, E, wv_);
        } PH_END
        PH_BEGIN(15) phase_route(A, wv_, L, lds); PH_END
        PH_BEGIN(16) {
            LAS int* off = (LAS int*)(lds + pg8::STAGE_BYTES); LAS int* cn = off + 32;
            moe_offsets(A, wv_, L, off, cn);
            pg8::MoeOrder<true> S{(off[16] / 256) * 3, 3, G, cb, D, off, cn, (const int*)(ws + WS_LIST), (const char*)(ws + WS_WMIN) + (size_t)L * 16 * 768 * D * 2, (size_t)768 * D * 2};
            pg8::EpiSwiglu E{(bf16*)(ws + WS_H), DEXP};
            pg8::gemm_phase(lds, (const bf16*)(ws + WS_XN), D, S, E, wv_);
        } PH_END
        PH_BEGIN(17) {
            LAS int* off = (LAS int*)(lds + pg8::STAGE_BYTES); LAS int* cn = off + 32;
            moe_offsets(A, wv_, L, off, cn);
            pg8::MoeOrder<false> S{(off[16] / 256) * 4, 4, G, cb, DEXP, off, cn, (const int*)(ws + WS_LIST), (const char*)(ws + WS_WMOUT) + (size_t)L * 16 * D * DEXP * 2, (size_t)D * DEXP * 2};
            pg8::EpiBf16<0> E{(bf16*)(ws + WS_Y), D, 4, 0};
            pg8::gemm_phase(lds, (const bf16*)(ws + WS_H), DEXP, S, E, wv_);
        } PH_END
        PH_BEGIN(18) phase_moe_combine(A, wv_, L, lds); PH_END
    }
#undef PH_BEGIN
#undef PH_END
    if (PROBE_TMASK && blockIdx.x == 0) { const unsigned long long t0 = __builtin_amdgcn_s_memrealtime(); while (__builtin_amdgcn_s_memrealtime() - t0 < tacc_) __builtin_amdgcn_s_sleep(8); }
}

extern "C" void kernel_launch(void* const* d_in, const int* in_sizes, int n_in, void* d_out, int out_size, void* d_ws, size_t ws_size, hipStream_t stream) {
    static int grid = 0;
    if (grid == 0) {
        if (n_in != N_IN || out_size != T * D || ws_size < WS_END) { fprintf(stderr, "kernel_launch: unexpected problem (n_in %d, out %d, ws %zu)\n", n_in, out_size, ws_size); grid = -1; return; }
        int dev = 0, cus = 0, per_cu = 0;
        if (hipGetDevice(&dev) != hipSuccess || hipDeviceGetAttribute(&cus, hipDeviceAttributeMultiprocessorCount, dev) != hipSuccess) { grid = -1; return; }
        if (hipFuncSetAttribute((const void*)mk_fwd, hipFuncAttributeMaxDynamicSharedMemorySize, LDS_BYTES) != hipSuccess) { fprintf(stderr, "kernel_launch: hipFuncSetAttribute failed\n"); grid = -1; return; }
        if (hipOccupancyMaxActiveBlocksPerMultiprocessor(&per_cu, (const void*)mk_fwd, 512, LDS_BYTES) != hipSuccess || per_cu < 1) fprintf(stderr, "kernel_launch: occupancy query says %d\n", per_cu);
        (void)hipGetLastError();
        grid = cus;
    }
    if (grid < 0) return;
    (void)hipMemsetAsync((char*)d_ws + WS_CTL, 0, CTL_BYTES, stream);
    Args a{};
    for (int i = 0; i < N_IN; ++i) a.in[i] = (const float*)d_in[i];
    a.out = (float*)d_out; a.ws = (unsigned char*)d_ws;
    for (int j = 0; j < 32; ++j) a.freq[j] = (float)pow(10000.0, -(double)j / 32.0);
#if MK_ONE_LAUNCH
    a.ph_lo = 0; a.ph_hi = NPHASES;
    hipLaunchKernelGGL(mk_fwd, dim3(grid), dim3(512), LDS_BYTES, stream, a);
#else
    for (int p = 0; p < NPHASES; ++p) { a.ph_lo = p; a.ph_hi = p + 1; hipLaunchKernelGGL(mk_fwd, dim3(grid), dim3(512), LDS_BYTES, stream, a); }
#endif
}
```

```cpp
#include <hip/hip_runtime.h>
#include <stdint.h>
#include <stdio.h>
#include <math.h>

#ifndef PROBE_MASK
#define PROBE_MASK 0
#endif
#ifndef PROBE_TMASK
#define PROBE_TMASK 0
#endif
#ifndef PROBE_REPS
#define PROBE_REPS 2
#endif
#ifndef MK_ONE_LAUNCH
#define MK_ONE_LAUNCH 1
#endif

#define LAS __attribute__((address_space(3)))
typedef unsigned short bf16;
typedef short bf16x8 __attribute__((ext_vector_type(8)));
typedef float f32x4 __attribute__((ext_vector_type(4)));
typedef float f32x2 __attribute__((ext_vector_type(2)));
typedef unsigned u32x4 __attribute__((ext_vector_type(4)));
typedef unsigned u32x2 __attribute__((ext_vector_type(2)));

constexpr int T = 16384, D = 1024, NBATCH = 8, S = 2048, DEPTH = 4;
constexpr int NMEM = 256;
constexpr float EPS = 1e-6f;
constexpr int HYN = 3072, HYSRC = 2856;
constexpr int C_QA = 0, C_KC = 512, C_VC = 640, C_KS = 768, C_VS = 896, C_KW = 1024, C_VW = 1152, C_QB = 1280, C_KB = 1536, C_VB = 1792, C_RB = 2304, C_GA = 2816, C_AL = 2840;
constexpr int NCMP = 127;
constexpr int NEXP = 16, DEXP = 384;
constexpr int SLOTS = 2 * T + NEXP * 256;

enum { I_X = 0, I_MEM, I_POS, I_NMIX, I_NXAT, I_NMEM, I_NFFN, I_HYBIN, I_HYBOUT, I_QNORM, I_KNORM, I_CMPPE, I_CMPW1, I_CMPW2, I_GATEB, I_WA2, I_BA, I_ONORM,
       I_SGIN, I_LNG, I_LNB, I_SGWS, I_SGBS, I_SGOUT, I_XWQ, I_XWKV, I_XWO, I_XQN, I_XKN, I_RW, I_RB, I_MOEIN, I_MOEOUT, N_IN };

constexpr size_t MiB = 1u << 20;
constexpr size_t WS_CTL = 0, CTL_BYTES = 1 * MiB;
constexpr size_t WS_WHYB = 1 * MiB;
constexpr size_t WS_WHOUT = WS_WHYB + 12 * MiB;
constexpr size_t WS_WSGIN = WS_WHOUT + 4 * MiB;
constexpr size_t WS_WSGOUT = WS_WSGIN + 16 * MiB;
constexpr size_t WS_WQ = WS_WSGOUT + 8 * MiB;
constexpr size_t WS_WKV = WS_WQ + 8 * MiB;
constexpr size_t WS_WO = WS_WKV + 16 * MiB;
constexpr size_t WS_WMIN = WS_WO + 8 * MiB;
constexpr size_t WS_WMOUT = WS_WMIN + 96 * MiB;
constexpr size_t WS_RW = WS_WMOUT + 48 * MiB;
constexpr size_t WS_XN = WS_RW + 1 * MiB;
constexpr size_t WS_BIG = WS_XN + 32 * MiB;
constexpr size_t WS_QA = WS_BIG + 128 * MiB;
constexpr size_t WS_KS = WS_QA + 16 * MiB;
constexpr size_t WS_KW = WS_KS + 4 * MiB;
constexpr size_t WS_KC = WS_KW + 4 * MiB;
constexpr size_t WS_VC = WS_KC + 1 * MiB;
constexpr size_t WS_CAT = WS_VC + 1 * MiB;
constexpr size_t WS_QX = WS_CAT + 32 * MiB;
constexpr size_t WS_OX = WS_QX + 32 * MiB;
constexpr size_t WS_MN = WS_OX + 32 * MiB;
constexpr size_t WS_KV = WS_MN + 4 * MiB;
constexpr size_t WS_COS = WS_KV + 32 * MiB;
constexpr size_t WS_SIN = WS_COS + 2 * MiB;
constexpr size_t WS_LIST = WS_SIN + 2 * MiB;
constexpr size_t WS_TOK = WS_LIST + 1 * MiB;
constexpr size_t WS_VT = WS_TOK + 1 * MiB;
constexpr size_t WS_VTA = WS_VT + 16 * MiB;
constexpr size_t WS_SLOC = WS_VTA + 32 * MiB;
constexpr size_t WS_DEC = WS_SLOC + 32 * MiB;
constexpr size_t WS_STT = WS_DEC + 1 * MiB;
constexpr size_t WS_WSB = WS_STT + 16 * MiB;
constexpr size_t WS_M0 = WS_WSB + 768 * 1024;
constexpr size_t WS_W1T = WS_WSB + 1 * MiB;
constexpr size_t WS_END = WS_W1T + 1 * MiB;
constexpr size_t WS_Y = WS_BIG, WS_H = WS_BIG + 72 * MiB, WS_U = WS_BIG, WS_V = WS_BIG + 64 * MiB, WS_UM = WS_QX;
constexpr int CW_BAR = 4096;
constexpr int CW_CNT = 8192;

constexpr int LDS_BYTES = 159744;
constexpr int LDS_MISC = LDS_BYTES - 64;

__device__ __forceinline__ unsigned f2bf(float f) { unsigned u = __float_as_uint(f); return (u + 0x7fffu + ((u >> 16) & 1u)) >> 16; }
__device__ __forceinline__ float bf2f(unsigned b) { return __uint_as_float(b << 16); }
__device__ __forceinline__ float bflo(unsigned w) { return __uint_as_float(w << 16); }
__device__ __forceinline__ float bfhi(unsigned w) { return __uint_as_float(w & 0xffff0000u); }
__device__ __forceinline__ unsigned pk2(float lo, float hi) { return f2bf(lo) | (f2bf(hi) << 16); }
__device__ __forceinline__ float wave_sum(float v) {
#pragma unroll
    for (int o = 1; o < 64; o <<= 1) v += __shfl_xor(v, o);
    return v;
}
__device__ __forceinline__ float wave_max(float v) {
#pragma unroll
    for (int o = 1; o < 64; o <<= 1) v = fmaxf(v, __shfl_xor(v, o));
    return v;
}
__device__ __forceinline__ int opaque_tid(int wv) { int l; asm volatile("v_mbcnt_lo_u32_b32 %0, -1, 0\n\tv_mbcnt_hi_u32_b32 %0, -1, %0" : "=v"(l)); return wv * 64 + l; }
__device__ __forceinline__ unsigned char* opq(unsigned char* p) { asm volatile("" : "+s"(p)); return p; }
#define LDS_WAIT() asm volatile("s_waitcnt lgkmcnt(0)" ::: "memory")
__device__ __forceinline__ float gelu_tanh(float x) {
    const float u = 0.7978845608028654f * (x + 0.044715f * x * x * x);
    const float e = __expf(-2.0f * fabsf(u));
    float t = (1.0f - e) / (1.0f + e); t = u < 0.f ? -t : t;
    return 0.5f * x * (1.0f + t);
}
__device__ __forceinline__ float sigmoidf_(float x) { return 1.0f / (1.0f + __expf(-x)); }

#define XB_TMO      128
#define XB_XCNT(j)  (256  + 64 * (j))
#define XB_XSUB(j)  (1280 + 64 * (j))
#define XB_XGEN(j)  (2304 + 64 * (j))
#define XB_TOP      3328
#define XB_TOPGEN   3392
#define XCD_BAR_WORDS 3456
#define XB_SPIN_CAP (1u << 22)

__device__ __forceinline__ unsigned xb_ld(unsigned* p)              { return __hip_atomic_load(p, __ATOMIC_RELAXED, __HIP_MEMORY_SCOPE_AGENT); }
__device__ __forceinline__ unsigned xb_add(unsigned* p, unsigned v) { return __hip_atomic_fetch_add(p, v, __ATOMIC_RELAXED, __HIP_MEMORY_SCOPE_AGENT); }
__device__ __forceinline__ unsigned xb_xcc_id() { return (unsigned)__builtin_amdgcn_s_getreg((3 << 11) | 20) & 0xFu; }
#define XB_SPIN(cond, bar) do { unsigned _sp = 0; while (cond) { __builtin_amdgcn_s_sleep(1); \
    if ((++_sp & 255u) == 0u) { if (xb_ld(&(bar)[XB_TMO])) break; if (_sp > XB_SPIN_CAP) { atomicAdd(&(bar)[XB_TMO], 1u); break; } } } } while (0)

struct XcdBarrier { unsigned* bar; unsigned x; volatile LAS unsigned* st; };
__device__ __forceinline__ unsigned* xb_opaque(unsigned* p) { unsigned long long v = (unsigned long long)p; unsigned lo = __builtin_amdgcn_readfirstlane((unsigned)v), hi = __builtin_amdgcn_readfirstlane((unsigned)(v >> 32));
    asm volatile("" : "+s"(lo), "+s"(hi)); return (unsigned*)(((unsigned long long)hi << 32) | lo); }

__device__ __forceinline__ XcdBarrier xcd_barrier_post(unsigned* bar, volatile LAS unsigned* st) {
    XcdBarrier b; b.bar = bar; b.x = xb_xcc_id(); b.st = st;
    if (threadIdx.x == 0) (void)xb_add(&bar[XB_XCNT(b.x)], 1u);
    return b;
}
__device__ __forceinline__ void xcd_barrier_complete(unsigned* bar, unsigned x, unsigned& nloc, unsigned& nx) {
    const unsigned G = gridDim.x * gridDim.y * gridDim.z;
    unsigned sum, cnt, mine, sp = 0u;
    for (;;) {
        sum = 0u; cnt = 0u; mine = 0u;
#pragma unroll
        for (unsigned j = 0; j < 16; ++j) { const unsigned c = xb_ld(&bar[XB_XCNT(j)]); sum += c; cnt += (c > 0u) ? 1u : 0u; mine = (j == x) ? c : mine; }
        if (sum == G) break;
        __builtin_amdgcn_s_sleep(1);
        if ((++sp & 255u) == 0u) { if (xb_ld(&bar[XB_TMO])) break; if (sp > XB_SPIN_CAP) { atomicAdd(&bar[XB_TMO], 1u); break; } }
    }
    nloc = mine > 0u ? mine : 1u; nx = cnt > 0u ? cnt : 1u;
}
__device__ __forceinline__ void xcd_barrier(const XcdBarrier& b, const bool is_t0) {
    asm volatile("s_waitcnt vmcnt(0)" ::: "memory");
    __syncthreads();
    if (is_t0) {
        unsigned* bar = b.bar;
        __builtin_amdgcn_s_waitcnt(0);
        unsigned nloc = b.st[0], nx = b.st[1];
        if (nloc == 0u) { xcd_barrier_complete(bar, b.x, nloc, nx); b.st[0] = nloc; b.st[1] = nx; }
        const unsigned old = xb_add(&bar[XB_XSUB(b.x)], 1u);
        const unsigned gen = old / nloc;
        if (old + 1u == (gen + 1u) * nloc) {
            __builtin_amdgcn_fence(__ATOMIC_RELEASE, "agent");
            asm volatile("s_waitcnt vmcnt(0)" ::: "memory");
            const unsigned og = xb_add(&bar[XB_TOP], 1u);
            const unsigned tg = og / nx;
            if (og + 1u == (tg + 1u) * nx) xb_add(&bar[XB_TOPGEN], 1u);
            else XB_SPIN(xb_ld(&bar[XB_TOPGEN]) == tg, bar);
            __builtin_amdgcn_fence(__ATOMIC_ACQUIRE, "agent");
            xb_add(&bar[XB_XGEN(b.x)], 1u);
            asm volatile("s_waitcnt vmcnt(0)" ::: "memory");
        } else {
            XB_SPIN(xb_ld(&bar[XB_XGEN(b.x)]) == gen, bar);
            __builtin_amdgcn_fence(__ATOMIC_ACQUIRE, "agent");
            asm volatile("s_waitcnt vmcnt(0)" ::: "memory");
        }
    }
    __syncthreads();
}

struct Args {
    const float* in[N_IN];
    float* out;
    unsigned char* ws;
    float freq[32];
    int ph_lo, ph_hi;
};

typedef const __attribute__((address_space(4))) Args* KArgs;
__device__ __forceinline__ KArgs kargs() { KArgs p = (KArgs)__builtin_amdgcn_kernarg_segment_ptr(); asm volatile("" : "+s"(p)); return p; }

__device__ __forceinline__ void st_bf16x4(bf16* p, f32x4 v) { u32x2 w; w.x = pk2(v[0], v[1]); w.y = pk2(v[2], v[3]); *(u32x2*)p = w; }


namespace pg8 {
constexpr int BM = 256, BK = 64, HALF = 128, HTB = HALF * BK * 2, STAGE_BYTES = 8 * HTB, NXCD = 8, WGM = 8;
__host__ __device__ __forceinline__ int lds_byte(int r, int c) { const int st = (r >> 4) * 2 + (c >> 5), rr = r & 15, cc = c & 31, ob = rr * 64 + cc * 2; return st * 1024 + (ob ^ (((ob >> 9) & 1) << 5)); }
__host__ __device__ __forceinline__ void stage_rc(int b, int& R, int& C) { const int st = b / 1024, sb = b % 1024, swz = sb ^ (((sb >> 9) & 1) << 5); R = (st >> 1) * 16 + swz / 64; C = (st & 1) * 32 + (swz % 64) / 2; }
__host__ __device__ __forceinline__ int perm32(int rho) { const int n = rho >> 4, i = rho & 15; return 8 * (i >> 2) + 4 * n + (i & 3); }
struct Unit { int pm, pn, e; };
struct DenseOrder {
    static constexpr bool GATHER = false;
    int nM, nN, nwg, G, c, K; const char* Bt;
    __device__ __forceinline__ void init(int M, int N, int K_, const bf16* Bt_, int G_, int c_) { nM = M / BM; nN = N / BM; nwg = nM * nN; G = G_; c = c_; K = K_; Bt = (const char*)Bt_; }
    __device__ __forceinline__ bool next(int i, Unit& u) const {
        const long L = (long)i * G + c; if (L >= nwg) return false;
        int wgid = (int)L; { const int q = nwg / NXCD, r = nwg % NXCD, xcd = wgid % NXCD, off = wgid / NXCD; wgid = (xcd < r ? xcd * (q + 1) : r * (q + 1) + (xcd - r) * q) + off; }
        const int nig = WGM * nN, gid = wgid / nig, fm = gid * WGM, gsz = (nM - fm) < WGM ? (nM - fm) : WGM;
        u.pm = fm + ((wgid % nig) % gsz); u.pn = (wgid % nig) / gsz; u.e = 0; return true;
    }
    __device__ __forceinline__ unsigned a_voff(const Unit& u, int half, int R) const { return (unsigned)((u.pm * BM + half * HALF + R) * K) * 2u; }
    __device__ __forceinline__ const char* b_tile(const Unit& u) const { return Bt + (size_t)u.pn * BM * K * 2; }
};
template <bool GATH> struct MoeOrder {
    static constexpr bool GATHER = GATH;
    int nunits, ntn, G, c, K; const LAS int* off; const LAS int* cn; const int* list; const char* Bt; size_t estride;
    __device__ __forceinline__ bool next(int i, Unit& u) const {
        const int L = i * G + c; if (L >= nunits) return false;
        u.pm = L / ntn; u.pn = L % ntn; const int s0 = u.pm * BM; int e = 0;
#pragma unroll
        for (int q = 1; q < 16; ++q) e += (s0 >= off[q]) ? 1 : 0;
        u.e = e; return true;
    }
    __device__ __forceinline__ unsigned a_voff(const Unit& u, int half, int R) const {
        const int slot = u.pm * BM + half * HALF + R;
        const int loc = slot - off[u.e]; const int tk = list[u.e * T + (loc < cn[u.e] ? loc : 0)];
        return (unsigned)(tk * K) * 2u;
    }
    __device__ __forceinline__ const char* b_tile(const Unit& u) const { return Bt + (size_t)u.e * estride + (size_t)u.pn * BM * K * 2; }
};
__device__ __forceinline__ unsigned cvt_pk_bf16(float lo, float hi) { unsigned r; asm volatile("v_cvt_pk_bf16_f32 %0, %1, %2" : "=v"(r) : "v"(lo), "v"(hi)); return r; }

template <class Epi, class Sched>
__device__ __forceinline__ void gemm_phase(LAS unsigned char* lds, const bf16* Aptr, int K, const Sched& S, const Epi& E, int wv_) {
    const int tid = opaque_tid(wv_), wid = __builtin_amdgcn_readfirstlane(tid >> 6), lane = tid & 63, wr = wid >> 2, wc = wid & 3, fr = lane & 15, fq = lane >> 4;
    const int nt = K / BK;
    int Rr[2], Cc[2]; unsigned voffA[2], voffB[2];
#pragma unroll
    for (int i = 0; i < 2; ++i) { stage_rc(tid * 16 + i * 8192, Rr[i], Cc[i]); const int Rb = Epi::PERM ? ((Rr[i] & ~31) + perm32(Rr[i] & 31)) : Rr[i];
        voffA[i] = (unsigned)(Rr[i] * K + Cc[i]) * 2u; voffB[i] = (unsigned)(Rb * K + Cc[i]) * 2u; }
    const size_t kstep = (size_t)(BK * 2);
    const size_t hstep = (size_t)HALF * K * 2;
    const size_t tstep = 2 * hstep;
    const unsigned ldsw = (unsigned)wid * 1024u;
    const int aoff = lds_byte(wr * 64 + fr, fq * 8), boff = lds_byte(wc * 32 + fr, fq * 8);
    const char* const Ab = (const char*)Aptr;
#define PG8_SA(b, h) (((b) * 2 + (h)) * HTB)
#define PG8_SB(b, h) ((4 + (b) * 2 + (h)) * HTB)
#define PG8_STAGE(bufoff, gbase, voff) do { _Pragma("unroll") for (int _i = 0; _i < 2; ++_i) \
        __builtin_amdgcn_global_load_lds((const unsigned*)((const char*)(gbase) + (voff)[_i]), (LAS unsigned*)(lds + (bufoff) + ldsw + _i * 8192), 16, 0, 0); } while (0)
#define PG8_STAGE_A(bufoff, usenext, h, kofs) do { \
        if constexpr (Sched::GATHER) { const char* gb_ = Ab + (kofs); unsigned vv_[2] = {(usenext) ? vN[h][0] : vA[h][0], (usenext) ? vN[h][1] : vA[h][1]}; PG8_STAGE(bufoff, gb_, vv_); } \
        else { const char* gb_ = ((usenext) ? nA : cA) + (size_t)(h) * hstep + (kofs); PG8_STAGE(bufoff, gb_, voffA); } } while (0)
#define PG8_LDA(dst, b, h) do { _Pragma("unroll") for (int m = 0; m < 4; ++m) _Pragma("unroll") for (int k = 0; k < 2; ++k) dst[m][k] = *(const LAS bf16x8*)(lds + PG8_SA(b, h) + aoff + m * 2048 + k * 1024); } while (0)
#define PG8_LDB(dst, b, h) do { _Pragma("unroll") for (int n = 0; n < 2; ++n) _Pragma("unroll") for (int k = 0; k < 2; ++k) dst[n][k] = *(const LAS bf16x8*)(lds + PG8_SB(b, h) + boff + n * 2048 + k * 1024); } while (0)
#define PG8_MMA(ai, bj, At, Bt) do { __builtin_amdgcn_s_setprio(1); _Pragma("unroll") for (int m = 0; m < 4; ++m) _Pragma("unroll") for (int n = 0; n < 2; ++n) _Pragma("unroll") for (int k = 0; k < 2; ++k) \
        acc[ai][bj][m][n] = __builtin_amdgcn_mfma_f32_16x16x32_bf16(Bt[n][k], At[m][k], acc[ai][bj][m][n], 0, 0, 0); __builtin_amdgcn_s_setprio(0); } while (0)
#define PG8_WAIT_V(n) asm volatile("s_waitcnt vmcnt(" #n ")" ::: "memory")
#define PG8_WAIT_L(n) asm volatile("s_waitcnt lgkmcnt(" #n ")" ::: "memory")
#define PG8_BAR __builtin_amdgcn_s_barrier()
#define PG8_SCHED __builtin_amdgcn_sched_barrier(0)
    Unit cur, nxt; int ui = 0;
    if (!S.next(0, cur)) return;
    f32x4 acc[2][2][4][2];
#pragma unroll
    for (int a = 0; a < 2; ++a)
#pragma unroll
        for (int b = 0; b < 2; ++b)
#pragma unroll
            for (int m = 0; m < 4; ++m)
#pragma unroll
                for (int n = 0; n < 2; ++n) acc[a][b][m][n] = (f32x4){0.f, 0.f, 0.f, 0.f};
    bf16x8 At[4][2], B0[2][2], B1[2][2];
    unsigned vA[2][2], vN[2][2];
    const char* cA = Ab; const char* nA = Ab;
    if constexpr (Sched::GATHER) {
#pragma unroll
        for (int h = 0; h < 2; ++h)
#pragma unroll
            for (int i = 0; i < 2; ++i) { vA[h][i] = S.a_voff(cur, h, Rr[i]) + (unsigned)Cc[i] * 2u; vN[h][i] = vA[h][i]; }
    } else { cA = Ab + (size_t)cur.pm * tstep; nA = cA; }
    const char* cB = S.b_tile(cur);
    PG8_STAGE(PG8_SB(0, 0), cB, voffB); PG8_STAGE_A(PG8_SA(0, 0), false, 0, 0); PG8_STAGE(PG8_SB(0, 1), cB + hstep, voffB); PG8_STAGE_A(PG8_SA(0, 1), false, 1, 0);
    if (wr == 1) PG8_BAR;
    PG8_WAIT_V(4); PG8_BAR;
    PG8_STAGE(PG8_SB(1, 0), cB + kstep, voffB); PG8_STAGE_A(PG8_SA(1, 0), false, 0, kstep); PG8_STAGE(PG8_SB(1, 1), cB + hstep + kstep, voffB);
    PG8_WAIT_V(6); PG8_BAR;
    for (;;) {
        const bool has_next = S.next(ui + 1, nxt);
        const char* nB = has_next ? S.b_tile(nxt) : cB;
        if constexpr (Sched::GATHER) {
#pragma unroll
            for (int h = 0; h < 2; ++h)
#pragma unroll
                for (int i = 0; i < 2; ++i) vN[h][i] = has_next ? S.a_voff(nxt, h, Rr[i]) + (unsigned)Cc[i] * 2u : vA[h][i];
        } else nA = has_next ? Ab + (size_t)nxt.pm * tstep : cA;
        for (int t = 0; t < nt; t += 2) {
            const bool last = (t == nt - 2);
            const size_t k1 = (size_t)(t + 1) * kstep, k2 = last ? 0 : (size_t)(t + 2) * kstep, k3 = k2 + kstep;
            const char* b2 = last ? nB : cB + (size_t)(t + 2) * kstep; const char* b3 = b2 + kstep;
            PG8_LDB(B0, 0, 0); PG8_SCHED; PG8_LDA(At, 0, 0); PG8_STAGE_A(PG8_SA(1, 1), false, 1, k1);
            PG8_WAIT_L(8); PG8_BAR; PG8_WAIT_L(0); PG8_MMA(0, 0, At, B0); PG8_BAR; PG8_SCHED;
            PG8_LDB(B1, 0, 1); PG8_STAGE(PG8_SB(0, 0), b2, voffB);
            PG8_BAR; PG8_WAIT_L(0); PG8_MMA(0, 1, At, B1); PG8_BAR;
            PG8_LDA(At, 0, 1); PG8_STAGE_A(PG8_SA(0, 0), last, 0, k2);
            PG8_BAR; PG8_WAIT_L(0); PG8_MMA(1, 0, At, B0); PG8_BAR; PG8_SCHED;
            PG8_STAGE(PG8_SB(0, 1), b2 + hstep, voffB);
            PG8_WAIT_V(6); PG8_BAR; PG8_MMA(1, 1, At, B1); PG8_BAR;
            PG8_LDB(B0, 1, 0); PG8_SCHED; PG8_LDA(At, 1, 0); PG8_STAGE_A(PG8_SA(0, 1), last, 1, k2);
            PG8_WAIT_L(8); PG8_BAR; PG8_WAIT_L(0); PG8_MMA(0, 0, At, B0); PG8_BAR; PG8_SCHED;
            PG8_LDB(B1, 1, 1); PG8_STAGE(PG8_SB(1, 0), b3, voffB);
            PG8_BAR; PG8_WAIT_L(0); PG8_MMA(0, 1, At, B1); PG8_BAR;
            PG8_LDA(At, 1, 1); PG8_STAGE_A(PG8_SA(1, 0), last, 0, k3);
            PG8_BAR; PG8_WAIT_L(0); PG8_MMA(1, 0, At, B0); PG8_BAR; PG8_SCHED;
            PG8_STAGE(PG8_SB(1, 1), b3 + hstep, voffB);
            PG8_WAIT_V(6); PG8_BAR; PG8_MMA(1, 1, At, B1); PG8_BAR;
        }
        E(acc, cur, wr, wc, fr, fq);
        if (!has_next) break;
#pragma unroll
        for (int a = 0; a < 2; ++a)
#pragma unroll
            for (int b = 0; b < 2; ++b)
#pragma unroll
                for (int m = 0; m < 4; ++m)
#pragma unroll
                    for (int n = 0; n < 2; ++n) acc[a][b][m][n] = (f32x4){0.f, 0.f, 0.f, 0.f};
        cur = nxt; cB = nB; cA = nA; ++ui;
        if constexpr (Sched::GATHER) {
#pragma unroll
            for (int h = 0; h < 2; ++h)
#pragma unroll
                for (int i = 0; i < 2; ++i) vA[h][i] = vN[h][i];
        }
    }
    PG8_WAIT_V(0);
    if (wr == 0) PG8_BAR;
    PG8_BAR;
#undef PG8_SA
#undef PG8_SB
#undef PG8_STAGE
#undef PG8_STAGE_A
#undef PG8_LDA
#undef PG8_LDB
#undef PG8_MMA
#undef PG8_WAIT_V
#undef PG8_WAIT_L
#undef PG8_BAR
#undef PG8_SCHED
}
template <int ACT> struct EpiBf16 {
    static constexpr bool PERM = true;
    bf16* O; int ldc; int tpt; size_t tstride;
    __device__ __forceinline__ void operator()(const f32x4 (&acc)[2][2][4][2], const Unit& u, int wr, int wc, int fr, int fq) const {
        const int row0 = u.pm * BM + wr * 64 + fr; const int tt = u.pn / tpt; bf16* base = O + (size_t)tt * tstride; const int col0 = (u.pn - tt * tpt) * BM + wc * 32 + 8 * fq;
#pragma unroll
        for (int ai = 0; ai < 2; ++ai)
#pragma unroll
            for (int m = 0; m < 4; ++m) { bf16* rowp = base + (size_t)(row0 + ai * HALF + m * 16) * ldc + col0;
#pragma unroll
                for (int bj = 0; bj < 2; ++bj) { f32x4 v0 = acc[ai][bj][m][0], v1 = acc[ai][bj][m][1];
                    if (ACT == 1) {
#pragma unroll
                        for (int q = 0; q < 4; ++q) { v0[q] = gelu_tanh(v0[q]); v1[q] = gelu_tanh(v1[q]); } }
                    u32x4 w; w.x = cvt_pk_bf16(v0[0], v0[1]); w.y = cvt_pk_bf16(v0[2], v0[3]); w.z = cvt_pk_bf16(v1[0], v1[1]); w.w = cvt_pk_bf16(v1[2], v1[3]);
                    *(u32x4*)(rowp + bj * HALF) = w; } }
    }
};
struct EpiResAdd {
    static constexpr bool PERM = false;
    float* X; int ldc;
    __device__ __forceinline__ void operator()(const f32x4 (&acc)[2][2][4][2], const Unit& u, int wr, int wc, int fr, int fq) const {
        const int row0 = u.pm * BM + wr * 64 + fr, col0 = u.pn * BM + wc * 32 + 4 * fq;
#pragma unroll
        for (int ai = 0; ai < 2; ++ai)
#pragma unroll
            for (int m2 = 0; m2 < 4; m2 += 2) {
                f32x4 x[2][2][2];
#pragma unroll
                for (int mm = 0; mm < 2; ++mm)
#pragma unroll
                    for (int bj = 0; bj < 2; ++bj)
#pragma unroll
                        for (int n = 0; n < 2; ++n) x[mm][bj][n] = *(const f32x4*)(X + (size_t)(row0 + ai * HALF + (m2 + mm) * 16) * ldc + col0 + bj * HALF + n * 16);
#pragma unroll
                for (int mm = 0; mm < 2; ++mm)
#pragma unroll
                    for (int bj = 0; bj < 2; ++bj)
#pragma unroll
                        for (int n = 0; n < 2; ++n) *(f32x4*)(X + (size_t)(row0 + ai * HALF + (m2 + mm) * 16) * ldc + col0 + bj * HALF + n * 16) = x[mm][bj][n] + acc[ai][bj][m2 + mm][n];
            }
    }
};
struct EpiSwiglu {
    static constexpr bool PERM = true;
    bf16* H; int ldc;
    __device__ __forceinline__ void operator()(const f32x4 (&acc)[2][2][4][2], const Unit& u, int wr, int wc, int fr, int fq) const {
        const int row0 = u.pm * BM + wr * 64 + fr, col0 = u.pn * HALF + wc * 32 + 8 * fq;
#pragma unroll
        for (int ai = 0; ai < 2; ++ai)
#pragma unroll
            for (int m = 0; m < 4; ++m) {
                float o[8];
#pragma unroll
                for (int n = 0; n < 2; ++n)
#pragma unroll
                    for (int q = 0; q < 4; ++q) { const float g = acc[ai][0][m][n][q]; o[4 * n + q] = g * sigmoidf_(g) * acc[ai][1][m][n][q]; }
                u32x4 w; w.x = cvt_pk_bf16(o[0], o[1]); w.y = cvt_pk_bf16(o[2], o[3]); w.z = cvt_pk_bf16(o[4], o[5]); w.w = cvt_pk_bf16(o[6], o[7]);
                *(u32x4*)(H + (size_t)(row0 + ai * HALF + m * 16) * ldc + col0) = w; }
    }
};
}

__device__ __forceinline__ int hyb_colmap(int n) {
    if (n < 1280) return n;
    if (n < 1536) return 1304 + (n - 1280);
    if (n < 1792) return 1560 + (n - 1536);
    if (n < 2304) return 1816 + (n - 1792);
    if (n < 2816) return 2344 + (n - 2304);
    if (n < 2840) return 1280 + (n - 2816);
    if (n < 2856) return 2328 + (n - 2840);
    return -1;
}
__device__ __forceinline__ void tr_item(const float* __restrict__ W, int Nsrc, int K, bf16* __restrict__ Wt, const float* __restrict__ gain, int kind, int nblk, LAS float* scr, int item, int lane) {
    const int kb = item / nblk, nb = item % nblk, k0 = 64 * kb, n0 = 32 * nb;
    const int j = lane & 31, n = n0 + j;
    int col;
    if (kind == 0) col = n; else if (kind == 1) col = hyb_colmap(n); else { const int pn = n >> 8, r = n & 255; col = (r >> 7) * 384 + pn * 128 + (r & 127); }
#pragma unroll 8
    for (int i = 0; i < 32; ++i) {
        const int kk = 2 * i + (lane >> 5); float v = 0.f;
        if (col >= 0) { v = W[(size_t)(k0 + kk) * Nsrc + col]; if (gain) v *= gain[k0 + kk]; }
        scr[kk * 33 + j] = v;
    }
    LDS_WAIT();
    const int c = lane & 7;
#pragma unroll
    for (int jx = 0; jx < 4; ++jx) {
        const int nn = (lane >> 3) + 8 * jx; const LAS float* s = scr + (8 * c) * 33 + nn;
        u32x4 o; o.x = pk2(s[0 * 33], s[1 * 33]); o.y = pk2(s[2 * 33], s[3 * 33]); o.z = pk2(s[4 * 33], s[5 * 33]); o.w = pk2(s[6 * 33], s[7 * 33]);
        *(u32x4*)(Wt + (size_t)(n0 + nn) * K + k0 + 8 * c) = o;
    }
    LDS_WAIT();
}
__device__ __forceinline__ void rms_row_to_bf16(const float* __restrict__ xrow, bf16* __restrict__ orow, float* __restrict__ copy, int lane) {
    const f32x4* xr = (const f32x4*)xrow + lane;
    f32x4 v[4]; float s = 0.f;
#pragma unroll
    for (int j = 0; j < 4; ++j) { v[j] = xr[64 * j]; s += (v[j].x * v[j].x + v[j].y * v[j].y) + (v[j].z * v[j].z + v[j].w * v[j].w); }
    const float rstd = rsqrtf(wave_sum(s) * (1.f / 1024.f) + EPS);
    u32x2* o8 = (u32x2*)orow + lane;
#pragma unroll
    for (int j = 0; j < 4; ++j) { u32x2 w; w.x = pk2(v[j].x * rstd, v[j].y * rstd); w.y = pk2(v[j].z * rstd, v[j].w * rstd); o8[64 * j] = w; }
    if (copy) { f32x4* c4 = (f32x4*)copy + lane;
#pragma unroll
        for (int j = 0; j < 4; ++j) c4[64 * j] = v[j]; }
}

__device__ __forceinline__ void phase_prologue(KArgs A, int wv_, LAS unsigned char* lds) {
    const int tid = opaque_tid(wv_), wid = __builtin_amdgcn_readfirstlane(tid >> 6), lane = tid & 63;
    const int gw = blockIdx.x * 8 + wid, NGW = gridDim.x * 8;
    LAS float* scr = (LAS float*)(lds + wid * 16384);
    unsigned char* ws = opq(A->ws);
    constexpr int N_HYB = 2 * 1536, N_HOUT = 2 * 512, N_SGIN = 2 * 2048, N_SGOUT = 2 * 1024, N_WQ = 4 * 512, N_WKV = 4 * 1024, N_WO = 4 * 512, N_MIN = 64 * 384, N_MOUT = 64 * 192, N_W1T = 4 * 64;
    constexpr int NITEMS = N_HYB + N_HOUT + N_SGIN + N_SGOUT + N_WQ + N_WKV + N_WO + N_MIN + N_MOUT + N_W1T;
    for (int it = gw; it < NITEMS; it += NGW) {
        int r = it;
        if (r < N_HYB) { const int sl = r / 1536; tr_item(A->in[I_HYBIN] + (size_t)sl * 1024 * HYSRC, HYSRC, 1024, (bf16*)(ws + WS_WHYB) + (size_t)sl * HYN * 1024, A->in[I_NMIX] + (2 * sl) * 1024, 1, 96, scr, r % 1536, lane); continue; } r -= N_HYB;
        if (r < N_HOUT) { const int sl = r / 512; tr_item(A->in[I_HYBOUT] + (size_t)sl * 1024 * 1024, 1024, 1024, (bf16*)(ws + WS_WHOUT) + (size_t)sl * 1024 * 1024, nullptr, 0, 32, scr, r % 512, lane); continue; } r -= N_HOUT;
        if (r < N_SGIN) { const int sl = r / 2048; tr_item(A->in[I_SGIN] + (size_t)sl * 1024 * 4096, 4096, 1024, (bf16*)(ws + WS_WSGIN) + (size_t)sl * 4096 * 1024, A->in[I_NMIX] + (2 * sl + 1) * 1024, 0, 128, scr, r % 2048, lane); continue; } r -= N_SGIN;
        if (r < N_SGOUT) { const int sl = r / 1024; tr_item(A->in[I_SGOUT] + (size_t)sl * 2048 * 1024, 1024, 2048, (bf16*)(ws + WS_WSGOUT) + (size_t)sl * 1024 * 2048, nullptr, 0, 32, scr, r % 1024, lane); continue; } r -= N_SGOUT;
        if (r < N_WQ) { const int sl = r / 512; tr_item(A->in[I_XWQ] + (size_t)sl * 1024 * 1024, 1024, 1024, (bf16*)(ws + WS_WQ) + (size_t)sl * 1024 * 1024, A->in[I_NXAT] + sl * 1024, 0, 32, scr, r % 512, lane); continue; } r -= N_WQ;
        if (r < N_WKV) { const int sl = r / 1024; tr_item(A->in[I_XWKV] + (size_t)sl * 1024 * 2048, 2048, 1024, (bf16*)(ws + WS_WKV) + (size_t)sl * 2048 * 1024, A->in[I_NMEM] + sl * 1024, 0, 64, scr, r % 1024, lane); continue; } r -= N_WKV;
        if (r < N_WO) { const int sl = r / 512; tr_item(A->in[I_XWO] + (size_t)sl * 1024 * 1024, 1024, 1024, (bf16*)(ws + WS_WO) + (size_t)sl * 1024 * 1024, nullptr, 0, 32, scr, r % 512, lane); continue; } r -= N_WO;
        if (r < N_MIN) { const int sl = r / 384; tr_item(A->in[I_MOEIN] + (size_t)sl * 1024 * 768, 768, 1024, (bf16*)(ws + WS_WMIN) + (size_t)sl * 768 * 1024, A->in[I_NFFN] + (sl >> 4) * 1024, 2, 24, scr, r % 384, lane); continue; } r -= N_MIN;
        if (r < N_MOUT) { const int sl = r / 192; tr_item(A->in[I_MOEOUT] + (size_t)sl * 384 * 1024, 1024, 384, (bf16*)(ws + WS_WMOUT) + (size_t)sl * 1024 * 384, nullptr, 0, 32, scr, r % 192, lane); continue; } r -= N_MOUT;
        { const int sl = r / 64; tr_item(A->in[I_CMPW1] + (size_t)sl * 2048 * 64, 64, 2048, (bf16*)(ws + WS_W1T) + (size_t)sl * 64 * 2048, nullptr, 0, 2, scr, r % 64, lane); }
    }
    for (int m = gw; m < T; m += NGW) rms_row_to_bf16(A->in[I_X] + (size_t)m * D, (bf16*)(ws + WS_XN) + (size_t)m * D, A->out + (size_t)m * D, lane);
    for (int m = gw; m < NBATCH * NMEM; m += NGW) rms_row_to_bf16(A->in[I_MEM] + (size_t)m * D, (bf16*)(ws + WS_MN) + (size_t)m * D, nullptr, lane);
    const int gt = blockIdx.x * 512 + tid, NGT = gridDim.x * 512;
    const int* pos = (const int*)A->in[I_POS];
    float* cosT = (float*)(ws + WS_COS); float* sinT = (float*)(ws + WS_SIN);
    for (int i = gt; i < T * 32; i += NGT) {
        const int t = i >> 5, j = i & 31;
        const float ang = (float)pos[t] * A->freq[j];
        const double rev = (double)ang * 0.15915494309189533577;
        const float fr = (float)(rev - rint(rev));
        cosT[i] = __builtin_amdgcn_cosf(fr); sinT[i] = __builtin_amdgcn_sinf(fr);
    }
    { bf16* WSB = (bf16*)(ws + WS_WSB); float* M0 = (float*)(ws + WS_M0); const float* wsg = A->in[I_SGWS];
      for (int e = gt; e < 2 * 8 * 128 * 128; e += NGT) { const int s = e & 127, t = (e >> 7) & 127; WSB[e] = (bf16)f2bf(s <= t ? wsg[e] : 0.f); }
      for (int e = gt; e < 2 * 8 * 128; e += NGT) { const int t = e & 127; const float* r = wsg + (size_t)e * 128; float a = 0.f; for (int s = 0; s <= t; ++s) a += r[s]; M0[e] = a; } }
    float* RW = (float*)(ws + WS_RW);
    for (int i = gt; i < DEPTH * NEXP * D; i += NGT) { const int k = i & 1023, e = (i >> 10) & 15, l = i >> 14; RW[i] = A->in[I_RW][k * NEXP + e] * A->in[I_NFFN][l * D + k]; }
}

__device__ __forceinline__ void phase_knorm(KArgs A, int wv_) {
    const int tid_ = opaque_tid(wv_); const int wid = __builtin_amdgcn_readfirstlane(tid_ >> 6), lane = tid_ & 63; const int gw = blockIdx.x * 8 + wid, NGW = gridDim.x * 8;
    bf16* KV = (bf16*)(opq(A->ws) + WS_KV);
    for (int it = gw; it < DEPTH * 2048 * 4; it += NGW) {
        const int h = it & 3, m = (it >> 2) & 2047, l = it >> 13;
        bf16* p = KV + (size_t)m * 8192 + l * 2048 + h * 256 + 4 * lane;
        const u32x2 w = *(const u32x2*)p;
        float x0 = bflo(w.x), x1 = bfhi(w.x), x2 = bflo(w.y), x3 = bfhi(w.y);
        const float rstd = rsqrtf(wave_sum(x0 * x0 + x1 * x1 + x2 * x2 + x3 * x3) * (1.f / 256.f) + EPS) * 0.0625f;
        const f32x4 g = *(const f32x4*)(A->in[I_XKN] + l * 256 + 4 * lane);
        u32x2 o; o.x = pk2(x0 * rstd * g.x, x1 * rstd * g.y); o.y = pk2(x2 * rstd * g.z, x3 * rstd * g.w);
        *(u32x2*)p = o;
    }
}

__device__ __forceinline__ int kpos64(int tok) { const int k = tok & 31; return (tok & 32) + 8 * ((k >> 2) & 3) + 4 * (k >> 4) + (k & 3); }
__device__ __forceinline__ int kperm64(int p) { const int fq = (p >> 3) & 3, j = p & 7; return (p & 32) + 16 * (j >> 2) + 4 * fq + (j & 3); }

__device__ __forceinline__ void phase_nsa_prep(KArgs A, int wv_, int i, LAS unsigned char* lds) {
    const int tid_ = opaque_tid(wv_); const int wid = __builtin_amdgcn_readfirstlane(tid_ >> 6), lane = tid_ & 63; const int gw = blockIdx.x * 8 + wid, NGW = gridDim.x * 8;
    unsigned char* ws = opq(A->ws);
    const bf16* HY = (const bf16*)(ws + WS_BIG);
    const float* cosT = (const float*)(ws + WS_COS); const float* sinT = (const float*)(ws + WS_SIN);
    bf16* QA = (bf16*)(ws + WS_QA); bf16* KS = (bf16*)(ws + WS_KS); bf16* KW = (bf16*)(ws + WS_KW);
    LAS float* abuf = (LAS float*)(lds + wid * 8192);
    const int NIT = T;
    for (int it = gw; it < NIT; it += NGW) {
        if (it < T) {
            const int t = it;
            const float c = cosT[t * 32 + (lane & 31)], s = sinT[t * 32 + (lane & 31)];
            float xin[12];
#pragma unroll
            for (int u = 0; u < 12; ++u) xin[u] = bf2f(HY[(size_t)t * HYN + (u < 8 ? C_QA + 64 * u : (u < 10 ? C_KS + 64 * (u - 8) : C_KW + 64 * (u - 10))) + lane]);
#pragma unroll
            for (int u = 0; u < 12; ++u) {
                int src; const float* gain; bf16* dst; float scale;
                if (u < 8) { src = C_QA + 64 * u; gain = A->in[I_QNORM] + i * 64; dst = QA + (size_t)t * 512 + 64 * u; scale = 0.125f; }
                else if (u < 10) { src = C_KS + 64 * (u - 8); gain = A->in[I_KNORM] + (i * 3 + 1) * 64; dst = KS + (size_t)t * 128 + 64 * (u - 8); scale = 1.f; }
                else { src = C_KW + 64 * (u - 10); gain = A->in[I_KNORM] + (i * 3 + 2) * 64; dst = KW + (size_t)t * 128 + 64 * (u - 10); scale = 1.f; }
                const float x = xin[u]; (void)src;
                const float y = x * rsqrtf(wave_sum(x * x) * (1.f / 64.f) + EPS) * gain[lane] * scale;
                const float pr = __shfl_xor(y, 32);
                const float o = lane < 32 ? y * c - pr * s : y * c + pr * s;
                dst[lane] = (bf16)f2bf(o);
            }
        }
    }
}


__device__ __forceinline__ void phase_compress_mfma(KArgs A, int wv_, int i, LAS unsigned char* lds) {
    const int tid = opaque_tid(wv_), wid = __builtin_amdgcn_readfirstlane(tid >> 6), lane = tid & 63, fr = lane & 15, fq = lane >> 4;
    unsigned char* ws = opq(A->ws);
    const bf16* HY = (const bf16*)(ws + WS_BIG);
    const float* cosT = (const float*)(ws + WS_COS); const float* sinT = (const float*)(ws + WS_SIN);
    LAS float* part = (LAS float*)lds;
    LAS float* hbuf = part + 8 * 1024;
    LAS float* obuf = hbuf + 1024;
    for (int it = blockIdx.x; it < 2 * 127; it += gridDim.x) {
        const int kv = it / 127, tile = it % 127;
        const float* pe = A->in[I_CMPPE] + (size_t)(i * 2 + kv) * 32 * 64;
        const float* w2 = A->in[I_CMPW2] + (size_t)(i * 2 + kv) * 64 * 64;
        const bf16* w1t = (const bf16*)(ws + WS_W1T) + (size_t)(i * 2 + kv) * 64 * 2048;
        const int coff = kv ? C_VC : C_KC;
        {
            const int R = tile * 16 + fr, g = R & 1, bn = R >> 1, n = bn % NCMP, b = bn / NCMP;
            const bf16* arow = HY + (size_t)(b * S + 16 * n) * HYN + coff + g * 64;
            f32x4 acc[4];
#pragma unroll
            for (int t = 0; t < 4; ++t) acc[t] = (f32x4){0.f, 0.f, 0.f, 0.f};
#pragma unroll 2
            for (int s = 0; s < 8; ++s) {
                const int k0 = 256 * wid + 32 * s, l = k0 >> 6, d0 = (k0 & 63) + 8 * fq;
                const u32x4 hw = *(const u32x4*)(arow + (size_t)l * HYN + d0);
                const f32x4 p0 = *(const f32x4*)(pe + l * 64 + d0), p1 = *(const f32x4*)(pe + l * 64 + d0 + 4);
                u32x4 aw; aw.x = pk2(bflo(hw.x) + p0.x, bfhi(hw.x) + p0.y); aw.y = pk2(bflo(hw.y) + p0.z, bfhi(hw.y) + p0.w); aw.z = pk2(bflo(hw.z) + p1.x, bfhi(hw.z) + p1.y); aw.w = pk2(bflo(hw.w) + p1.z, bfhi(hw.w) + p1.w);
                const bf16x8 af = __builtin_bit_cast(bf16x8, aw);
#pragma unroll
                for (int t = 0; t < 4; ++t) { const bf16x8 bfr = *(const bf16x8*)(w1t + (size_t)(16 * t + fr) * 2048 + k0 + 8 * fq);
                    acc[t] = __builtin_amdgcn_mfma_f32_16x16x32_bf16(af, bfr, acc[t], 0, 0, 0); }
            }
            __syncthreads();
#pragma unroll
            for (int t = 0; t < 4; ++t)
#pragma unroll
                for (int r = 0; r < 4; ++r) part[wid * 1024 + (4 * fq + r) * 64 + 16 * t + fr] = acc[t][r];
        }
        __syncthreads();
        for (int e = tid; e < 1024; e += 512) { float a = 0.f;
#pragma unroll
            for (int w = 0; w < 8; ++w) a += part[w * 1024 + e];
            hbuf[e] = gelu_tanh(a); }
        __syncthreads();
        for (int e = tid; e < 1024; e += 512) { const int r = e >> 6, j = e & 63; float o = 0.f;
#pragma unroll 8
            for (int m = 0; m < 64; ++m) o += hbuf[r * 64 + m] * w2[m * 64 + j];
            obuf[e] = o; }
        __syncthreads();
        for (int r = wid; r < 16; r += 8) {
            const int R = tile * 16 + r, g = R & 1, bn = R >> 1, n = bn % NCMP, b = bn / NCMP;
            const float o = obuf[r * 64 + lane];
            if (kv == 0) {
                const float y = o * rsqrtf(wave_sum(o * o) * (1.f / 64.f) + EPS) * A->in[I_KNORM][(i * 3 + 0) * 64 + lane];
                const int tp = b * S + 16 * n + 31;
                const float c = cosT[tp * 32 + (lane & 31)], sn = sinT[tp * 32 + (lane & 31)];
                const float pr = __shfl_xor(y, 32);
                const float oo = lane < 32 ? y * c - pr * sn : y * c + pr * sn;
                ((bf16*)(ws + WS_KC))[((size_t)(b * 128 + n) * 2 + g) * 64 + lane] = (bf16)f2bf(oo);
            } else {
                bf16* vct = (bf16*)(ws + WS_VC) + ((size_t)(b * 2 + g) * 64 + lane) * 128;
                vct[(n & 64) + kpos64(n & 63)] = (bf16)f2bf(o);
                if (n == 126) vct[127] = 0;
            }
        }
    }
    __syncthreads();
}

__device__ __forceinline__ void nsa_block(const LAS float* qs, const bf16* __restrict__ krow, bool ok, const bf16* __restrict__ vbase, int vstride, int lane,
                                          float (&m)[4], float (&l)[4], float (&o)[4]) {
    float s[4] = {0.f, 0.f, 0.f, 0.f};
#pragma unroll 2
    for (int c = 0; c < 8; ++c) {
        const u32x4 kw = *(const u32x4*)(krow + 8 * c);
        const float k0 = bflo(kw.x), k1 = bfhi(kw.x), k2 = bflo(kw.y), k3 = bfhi(kw.y), k4 = bflo(kw.z), k5 = bfhi(kw.z), k6 = bflo(kw.w), k7 = bfhi(kw.w);
#pragma unroll
        for (int hh = 0; hh < 4; ++hh) {
            const f32x4 qa = *(const LAS f32x4*)(qs + hh * 64 + 8 * c), qb = *(const LAS f32x4*)(qs + hh * 64 + 8 * c + 4);
            s[hh] += (qa.x * k0 + qa.y * k1) + (qa.z * k2 + qa.w * k3) + (qb.x * k4 + qb.y * k5) + (qb.z * k6 + qb.w * k7);
        }
    }
    float p[4];
#pragma unroll
    for (int hh = 0; hh < 4; ++hh) {
        const float sv = ok ? s[hh] : -INFINITY;
        const float bm = wave_max(sv);
        const float mn = fmaxf(m[hh], bm);
        if (mn == -INFINITY) { p[hh] = 0.f; continue; }
        const float alpha = __expf(m[hh] - mn);
        p[hh] = ok ? __expf(sv - mn) : 0.f;
        l[hh] = l[hh] * alpha + wave_sum(p[hh]);
        o[hh] *= alpha; m[hh] = mn;
    }
#pragma unroll 8
    for (int kk = 0; kk < 64; ++kk) {
        const float v = bf2f(vbase[(size_t)kk * vstride + lane]);
#pragma unroll
        for (int hh = 0; hh < 4; ++hh) o[hh] += __shfl(p[hh], kk) * v;
    }
}
__device__ __forceinline__ void phase_nsa_attn(KArgs A, int wv_, int i, LAS unsigned char* lds) {
    const int tid_ = opaque_tid(wv_); const int wid = __builtin_amdgcn_readfirstlane(tid_ >> 6), lane0 = tid_ & 63; const int gw = blockIdx.x * 8 + wid, NGW = gridDim.x * 8;
    unsigned char* ws = opq(A->ws);
    const bf16* HY = (const bf16*)(ws + WS_BIG); const bf16* QA = (const bf16*)(ws + WS_QA); const bf16* KS = (const bf16*)(ws + WS_KS); const bf16* KW = (const bf16*)(ws + WS_KW);
    const bf16* KC = (const bf16*)(ws + WS_KC); const bf16* VC = (const bf16*)(ws + WS_VC); bf16* CAT = (bf16*)(ws + WS_CAT);
    LAS float* qs = (LAS float*)(lds + wid * 2048);
    LAS float* ps = qs + 256;
    for (int it = gw; it < 2 * T; it += NGW) {
        int lane = lane0; asm volatile("" : "+v"(lane));
        const int tok = it >> 1, g = it & 1, b = tok >> 11, t = tok & 2047;
#pragma unroll
        for (int hh = 0; hh < 4; ++hh) qs[hh * 64 + lane] = bf2f(QA[(size_t)tok * 512 + (g * 4 + hh) * 64 + lane]);
        LDS_WAIT();
        const int ncv = t >= 31 ? ((t - 31) >> 4) + 1 : 0;
        float oc[4] = {0.f, 0.f, 0.f, 0.f};
        float psum0 = 0.f, psum1 = 0.f;
        {
            const bool v0 = lane < ncv, v1 = lane + 64 < ncv;
            const bf16* k0p = KC + ((size_t)(b * 128 + lane) * 2 + g) * 64;
            const bf16* k1p = KC + ((size_t)(b * 128 + (lane + 64 < 127 ? lane + 64 : 126)) * 2 + g) * 64;
            float s0[4] = {0.f, 0.f, 0.f, 0.f}, s1[4] = {0.f, 0.f, 0.f, 0.f};
#pragma unroll 2
            for (int c = 0; c < 8; ++c) {
                const u32x4 ka = *(const u32x4*)(k0p + 8 * c), kb = *(const u32x4*)(k1p + 8 * c);
#pragma unroll
                for (int hh = 0; hh < 4; ++hh) {
                    const f32x4 qa = *(const LAS f32x4*)(qs + hh * 64 + 8 * c), qb = *(const LAS f32x4*)(qs + hh * 64 + 8 * c + 4);
                    s0[hh] += (qa.x * bflo(ka.x) + qa.y * bfhi(ka.x)) + (qa.z * bflo(ka.y) + qa.w * bfhi(ka.y)) + (qb.x * bflo(ka.z) + qb.y * bfhi(ka.z)) + (qb.z * bflo(ka.w) + qb.w * bfhi(ka.w));
                    s1[hh] += (qa.x * bflo(kb.x) + qa.y * bfhi(kb.x)) + (qa.z * bflo(kb.y) + qa.w * bfhi(kb.y)) + (qb.x * bflo(kb.z) + qb.y * bfhi(kb.z)) + (qb.z * bflo(kb.w) + qb.w * bfhi(kb.w));
                }
            }
            float p0[4], p1[4];
#pragma unroll
            for (int hh = 0; hh < 4; ++hh) {
                const float a0 = v0 ? s0[hh] : -INFINITY, a1 = v1 ? s1[hh] : -INFINITY;
                const float mx = wave_max(fmaxf(a0, a1));
                if (ncv > 0) {
                    const float e0 = v0 ? __expf(a0 - mx) : 0.f, e1 = v1 ? __expf(a1 - mx) : 0.f;
                    const float inv = 1.0f / wave_sum(e0 + e1);
                    p0[hh] = e0 * inv; p1[hh] = e1 * inv;
                } else { p0[hh] = 0.f; p1[hh] = 0.f; }
                psum0 += p0[hh]; psum1 += p1[hh];
            }
#pragma unroll 2
            for (int c = 0; c < ncv; ++c) {
                const float v = bf2f(VC[((size_t)(b * 128 + c) * 2 + g) * 64 + lane]);
#pragma unroll
                for (int hh = 0; hh < 4; ++hh) oc[hh] += __shfl(c < 64 ? p0[hh] : p1[hh], c & 63) * v;
            }
        }
        ps[lane] = psum0; ps[64 + lane] = psum1;
        LDS_WAIT();
        const int cur = t >> 6;
        unsigned selmask;
        {
            const int j = lane & 31;
            float imp = ps[4 * j] + ps[4 * j + 1] + ps[4 * j + 2] + 0.5f * ps[4 * j + 3] + (j > 0 ? 0.5f * ps[4 * j - 1] : 0.f);
            const bool valid = j <= cur, forced = (j == 0) || (j == cur) || (j == cur - 1);
            const float score = valid ? imp + (forced ? 1000.0f : 0.f) : -INFINITY;
            int rank = 0;
#pragma unroll 8
            for (int jj = 0; jj < 32; ++jj) { const float sj = __shfl(score, jj); rank += (sj > score || (sj == score && jj < j)) ? 1 : 0; }
            const bool sel = valid && rank < 8 && lane < 32;
            selmask = (unsigned)__ballot(sel);
        }
        LDS_WAIT();
        float o1[4] = {0.f, 0.f, 0.f, 0.f}, o2[4] = {0.f, 0.f, 0.f, 0.f};
#pragma unroll 1
        for (int pass = 0; pass < 2; ++pass) {
            float oa[4] = {0.f, 0.f, 0.f, 0.f}, ma[4] = {-INFINITY, -INFINITY, -INFINITY, -INFINITY}, la[4] = {0.f, 0.f, 0.f, 0.f};
            const int lo = pass ? (t - 255 > 0 ? t - 255 : 0) : 0;
            const unsigned bm = pass ? 0xffffffffu : selmask;
            const bf16* Kb = pass ? KW : KS; const int vc = pass ? C_VW : C_VS;
#pragma unroll 1
            for (int j = lo >> 6; j <= cur; ++j) {
                if (!((bm >> j) & 1u)) continue;
                const int key = 64 * j + lane; const size_t kt = (size_t)(b * S + key);
                nsa_block(qs, Kb + kt * 128 + g * 64, key <= t && key >= lo, HY + (size_t)(b * S + 64 * j) * HYN + vc + g * 64, HYN, lane, ma, la, oa);
            }
            if (pass == 0) {
#pragma unroll
                for (int hh = 0; hh < 4; ++hh) o1[hh] = oa[hh] / la[hh];
            } else {
#pragma unroll
                for (int hh = 0; hh < 4; ++hh) o2[hh] = oa[hh] / la[hh];
            }
        }
#pragma unroll
        for (int hh = 0; hh < 4; ++hh) {
            const int head = g * 4 + hh;
            const float* gb = A->in[I_GATEB] + i * 24 + head * 3;
            const bf16* gl = HY + (size_t)tok * HYN + C_GA + head * 3;
            const float g0 = sigmoidf_(bf2f(gl[0]) + gb[0]), g1 = sigmoidf_(bf2f(gl[1]) + gb[1]), g2 = sigmoidf_(bf2f(gl[2]) + gb[2]);
            const float o = g0 * oc[hh] + g1 * o1[hh] + g2 * o2[hh];
            CAT[(size_t)tok * 1024 + head * 64 + lane] = (bf16)f2bf(o);
        }
    }
}

__device__ __forceinline__ void phase_gla_seq(KArgs A, int wv_, int i, LAS unsigned char* lds) {
    const int tid = opaque_tid(wv_), wid = __builtin_amdgcn_readfirstlane(tid >> 6), lane = tid & 63;
    unsigned char* ws = opq(A->ws);
    const bf16* HY = (const bf16*)(ws + WS_BIG); bf16* CAT = (bf16*)(ws + WS_CAT);
    constexpr int CH = 16;
    LAS float* la = (LAS float*)lds;
    LAS float* lk = la + 4 * CH * 64;
    LAS float* lq = lk + 4 * CH * 64;
    LAS float* lo = lq + 4 * CH * 64;
    const float* wa2 = A->in[I_WA2] + i * 16 * 256; const float* ba = A->in[I_BA] + i * 256; const float* og = A->in[I_ONORM] + i * 128;
    for (int it = blockIdx.x; it < 8; it += gridDim.x) {
        const int pl = tid >> 7, v = tid & 127, p = it * 4 + pl, b = p >> 2, h = p & 3;
        float St[64];
#pragma unroll
        for (int k = 0; k < 64; ++k) St[k] = 0.f;
        for (int c0 = 0; c0 < S; c0 += CH) {
            __syncthreads();
            for (int e = tid; e < 4 * CH * 64; e += 512) {
                const int kk = e & 63, tk = (e >> 6) % CH, pp = e / (64 * CH); const int pb = (it * 4 + pp) >> 2, ph = (it * 4 + pp) & 3;
                const size_t tok = (size_t)pb * S + c0 + tk; const bf16* row = HY + tok * HYN;
                float z = ba[ph * 64 + kk];
#pragma unroll
                for (int r = 0; r < 16; ++r) z += bf2f(row[C_AL + r]) * wa2[r * 256 + ph * 64 + kk];
                const float ls_ = fminf(z, 0.f) - log1pf(__expf(-fabsf(z)));
                la[e] = __expf(ls_ * (1.f / 16.f));
                lk[e] = bf2f(row[C_KB + ph * 64 + kk]);
                lq[e] = bf2f(row[C_QB + ph * 64 + kk]) * 0.125f;
            }
            __syncthreads();
            for (int tk = 0; tk < CH; ++tk) {
                const size_t tok = (size_t)b * S + c0 + tk;
                const float vv = bf2f(HY[tok * HYN + C_VB + h * 128 + v]);
                const LAS float* pa = la + (pl * CH + tk) * 64; const LAS float* pk = lk + (pl * CH + tk) * 64; const LAS float* pq = lq + (pl * CH + tk) * 64;
                float o = 0.f;
#pragma unroll
                for (int k4 = 0; k4 < 16; ++k4) {
                    const f32x4 a4 = *(const LAS f32x4*)(pa + 4 * k4), k4v = *(const LAS f32x4*)(pk + 4 * k4), q4 = *(const LAS f32x4*)(pq + 4 * k4);
                    St[4 * k4 + 0] = a4.x * St[4 * k4 + 0] + k4v.x * vv; o += q4.x * St[4 * k4 + 0];
                    St[4 * k4 + 1] = a4.y * St[4 * k4 + 1] + k4v.y * vv; o += q4.y * St[4 * k4 + 1];
                    St[4 * k4 + 2] = a4.z * St[4 * k4 + 2] + k4v.z * vv; o += q4.z * St[4 * k4 + 2];
                    St[4 * k4 + 3] = a4.w * St[4 * k4 + 3] + k4v.w * vv; o += q4.w * St[4 * k4 + 3];
                }
                lo[(pl * CH + tk) * 128 + v] = o;
            }
            __syncthreads();
            for (int r = wid; r < 4 * CH; r += 8) {
                const int pp = r / CH, tk = r % CH; const int pb = (it * 4 + pp) >> 2, ph = (it * 4 + pp) & 3;
                const size_t tok = (size_t)pb * S + c0 + tk;
                const float x0 = lo[r * 128 + lane], x1 = lo[r * 128 + 64 + lane];
                const float rstd = rsqrtf(wave_sum(x0 * x0 + x1 * x1) * (1.f / 128.f) + EPS);
                const float r0 = bf2f(HY[tok * HYN + C_RB + ph * 128 + lane]), r1 = bf2f(HY[tok * HYN + C_RB + ph * 128 + 64 + lane]);
                CAT[tok * 1024 + 512 + ph * 128 + lane] = (bf16)f2bf(x0 * rstd * og[lane] * (r0 * sigmoidf_(r0)));
                CAT[tok * 1024 + 512 + ph * 128 + 64 + lane] = (bf16)f2bf(x1 * rstd * og[64 + lane] * (r1 * sigmoidf_(r1)));
            }
        }
        __syncthreads();
    }
}


__device__ __forceinline__ void phase_nsa_attn_mfma(KArgs A, int wv_, int i, LAS unsigned char* lds) {
    const int tid = opaque_tid(wv_), wid = __builtin_amdgcn_readfirstlane(tid >> 6), lane = tid & 63, fr = lane & 15, fq = lane >> 4;
    unsigned char* ws = opq(A->ws);
    const bf16* HY = (const bf16*)(ws + WS_BIG); const bf16* QA = (const bf16*)(ws + WS_QA); const bf16* KS = (const bf16*)(ws + WS_KS); const bf16* KW = (const bf16*)(ws + WS_KW);
    const bf16* KC = (const bf16*)(ws + WS_KC); const bf16* VCT = (const bf16*)(ws + WS_VC); const bf16* VTA = (const bf16*)(ws + WS_VTA); bf16* CAT = (bf16*)(ws + WS_CAT);
    constexpr int RS = 72;
    LAS bf16* ktl = (LAS bf16*)lds;
    LAS bf16* vtl = ktl + 2 * 64 * RS;
    LAS float* scl = (LAS float*)(lds + 36864) + wid * 256;
    LAS unsigned* msk = (LAS unsigned*)(lds + 36864 + 8192);
    LAS unsigned* umask = msk + 64;
    const float* gb = A->in[I_GATEB] + i * 24;
    for (int pit = blockIdx.x; pit < 256; pit += gridDim.x) {
#pragma unroll 1
        for (int hf = 0; hf < 2; ++hf) {
            const int bg = pit >> 4, xx = pit & 15, x = hf ? 31 - xx : xx, b = bg >> 1, g = bg & 1;
            const size_t tokbase = (size_t)b * S + 64 * x;
            const int tl0 = 8 * wid + (fr >> 2);
            if (tid == 0) *umask = 0u;
            bf16x8 qf[2][2];
#pragma unroll
            for (int mt = 0; mt < 2; ++mt)
#pragma unroll
                for (int s = 0; s < 2; ++s) qf[mt][s] = *(const bf16x8*)(QA + (tokbase + tl0 + 4 * mt) * 512 + (g * 4 + (fr & 3)) * 64 + 32 * s + 8 * fq);
            f32x4 outacc[2][4];
            {
                const int tmaxc = (4 * x + 3 + 15) >> 4;
                const bf16* kcb = KC + ((size_t)(b * 128 + fr) * 2 + g) * 64 + 8 * fq;
                bf16x8 pcf[2][4];
#pragma unroll
                for (int mt = 0; mt < 2; ++mt) {
                    f32x4 sc[8];
                    const bf16* kp = kcb;
#pragma unroll
                    for (int t = 0; t < 8; ++t) { sc[t] = (f32x4){0.f, 0.f, 0.f, 0.f};
                        asm volatile("" : "+v"(kp));
                        if (t < tmaxc) {
                            const bf16x8 k0 = *(const bf16x8*)(kp), k1 = *(const bf16x8*)(kp + 32);
                            sc[t] = __builtin_amdgcn_mfma_f32_16x16x32_bf16(k0, qf[mt][0], sc[t], 0, 0, 0);
                            sc[t] = __builtin_amdgcn_mfma_f32_16x16x32_bf16(k1, qf[mt][1], sc[t], 0, 0, 0); }
                        kp += 16 * 128; }
                    const int tg = 64 * x + tl0 + 4 * mt; const int ncv = tg >= 31 ? ((tg - 31) >> 4) + 1 : 0;
                    float mx = -INFINITY;
#pragma unroll
                    for (int t = 0; t < 8; ++t)
#pragma unroll
                        for (int r = 0; r < 4; ++r) { const bool v = 16 * t + 4 * fq + r < ncv; sc[t][r] = v ? sc[t][r] : -INFINITY; mx = fmaxf(mx, sc[t][r]); }
                    mx = fmaxf(mx, __shfl_xor(mx, 16)); mx = fmaxf(mx, __shfl_xor(mx, 32));
                    const float mxs = mx == -INFINITY ? 0.f : mx;
                    float sum = 0.f;
#pragma unroll
                    for (int t = 0; t < 8; ++t)
#pragma unroll
                        for (int r = 0; r < 4; ++r) { sc[t][r] = __expf(sc[t][r] - mxs); sum += sc[t][r]; }
                    sum += __shfl_xor(sum, 16); sum += __shfl_xor(sum, 32);
                    const float inv = sum > 0.f ? 1.f / sum : 0.f;
#pragma unroll
                    for (int t = 0; t < 8; ++t) sc[t] = sc[t] * inv;
#pragma unroll
                    for (int s = 0; s < 4; ++s) { u32x4 w; w.x = pk2(sc[2 * s].x, sc[2 * s].y); w.y = pk2(sc[2 * s].z, sc[2 * s].w); w.z = pk2(sc[2 * s + 1].x, sc[2 * s + 1].y); w.w = pk2(sc[2 * s + 1].z, sc[2 * s + 1].w);
                        pcf[mt][s] = __builtin_bit_cast(bf16x8, w); }
                    float w3[8];
#pragma unroll
                    for (int t = 0; t < 8; ++t) {
#pragma unroll
                        for (int r = 0; r < 4; ++r) { float v = sc[t][r]; v += __shfl_xor(v, 1); v += __shfl_xor(v, 2); sc[t][r] = v; }
                        w3[t] = __shfl(sc[t].w, (lane + 48) & 63);
                    }
#pragma unroll
                    for (int t = 0; t < 8; ++t) {
                        const float prev = fq > 0 ? w3[t] : (t > 0 ? w3[t > 0 ? t - 1 : 0] : 0.f);
                        const float imp = sc[t].x + sc[t].y + sc[t].z + 0.5f * sc[t].w + 0.5f * prev;
                        if ((fr & 3) == 0) scl[(4 * mt + (fr >> 2)) * 32 + 4 * t + fq] = imp;
                    }
                    asm volatile("" ::: "memory");
                }
                const bf16* vcb = VCT + ((size_t)(b * 2 + g) * 64 + fr) * 128 + 8 * fq;
#pragma unroll
                for (int n = 0; n < 4; ++n) {
                    outacc[0][n] = (f32x4){0.f, 0.f, 0.f, 0.f}; outacc[1][n] = (f32x4){0.f, 0.f, 0.f, 0.f};
                    asm volatile("" : "+v"(vcb));
#pragma unroll
                    for (int s = 0; s < 4; ++s) if (2 * s < tmaxc) {
                        const bf16x8 vf = *(const bf16x8*)(vcb + 32 * s);
                        outacc[0][n] = __builtin_amdgcn_mfma_f32_16x16x32_bf16(vf, pcf[0][s], outacc[0][n], 0, 0, 0);
                        outacc[1][n] = __builtin_amdgcn_mfma_f32_16x16x32_bf16(vf, pcf[1][s], outacc[1][n], 0, 0, 0); }
                    vcb += 16 * 128;
                    asm volatile("" ::: "memory");
                }
            }
            float g1v[2], g2v[2];
#pragma unroll
            for (int mt = 0; mt < 2; ++mt) {
                const int head = g * 4 + (fr & 3);
                const bf16* gl = HY + (tokbase + tl0 + 4 * mt) * HYN + C_GA + head * 3;
                const float g0 = sigmoidf_(bf2f(gl[0]) + gb[head * 3 + 0]);
                g1v[mt] = sigmoidf_(bf2f(gl[1]) + gb[head * 3 + 1]); g2v[mt] = sigmoidf_(bf2f(gl[2]) + gb[head * 3 + 2]);
#pragma unroll
                for (int n = 0; n < 4; ++n) outacc[mt][n] = outacc[mt][n] * g0;
            }
            LDS_WAIT();
            asm volatile("" ::: "memory");
            {
                const int tok8 = lane >> 3, jg = lane & 7;
                float sj[32];
#pragma unroll
                for (int q = 0; q < 8; ++q) { const f32x4 v = *(const LAS f32x4*)(scl + tok8 * 32 + 4 * q); sj[4 * q] = v.x; sj[4 * q + 1] = v.y; sj[4 * q + 2] = v.z; sj[4 * q + 3] = v.w; }
#pragma unroll
                for (int j = 0; j < 32; ++j) sj[j] = j <= x ? sj[j] + ((j == 0 || j == x || j == x - 1) ? 1000.0f : 0.f) : -INFINITY;
                unsigned bits = 0u;
                const f32x4 mv = *(const LAS f32x4*)(scl + tok8 * 32 + 4 * jg);
#pragma unroll
                for (int q = 0; q < 4; ++q) {
                    const int j = 4 * jg + q;
                    const float mine = j <= x ? mv[q] + ((j == 0 || j == x || j == x - 1) ? 1000.0f : 0.f) : -INFINITY;
                    int rank = 0;
#pragma unroll
                    for (int jj = 0; jj < 32; ++jj) rank += (sj[jj] > mine || (sj[jj] == mine && jj < j)) ? 1 : 0;
                    bits |= (j <= x && rank < 8) ? (1u << j) : 0u;
                }
                bits |= __shfl_xor(bits, 1); bits |= __shfl_xor(bits, 2); bits |= __shfl_xor(bits, 4);
                if (jg == 0) { msk[wid * 8 + tok8] = bits; atomicOr((unsigned*)umask, bits); }
            }
            __syncthreads();
#pragma unroll 1
            for (int pass = 0; pass < 2; ++pass) {
                const int jlo = pass ? (x >= 4 ? x - 4 : 0) : 0;
                const unsigned inrange = (x >= 31 ? 0xffffffffu : ((2u << x) - 1u)) & ~((1u << jlo) - 1u);
                unsigned bmask = pass ? inrange : (*umask & inrange);
                const bf16* Kb = pass ? KW : KS; const int cg = (pass ? 10 : 8) + g;
                unsigned tm[2], wm[2];
#pragma unroll
                for (int mt = 0; mt < 2; ++mt) {
                    tm[mt] = pass ? 0xffffffffu : msk[wid * 8 + 4 * mt + (fr >> 2)];
                    wm[mt] = pass ? 0xffffffffu : (msk[wid * 8 + 4 * mt] | msk[wid * 8 + 4 * mt + 1] | msk[wid * 8 + 4 * mt + 2] | msk[wid * 8 + 4 * mt + 3]);
                    wm[mt] = __builtin_amdgcn_readfirstlane(wm[mt]);
                }
                f32x4 o[2][4]; float mrun[2], lrun[2];
#pragma unroll
                for (int mt = 0; mt < 2; ++mt) { mrun[mt] = -INFINITY; lrun[mt] = 0.f;
#pragma unroll
                    for (int n = 0; n < 4; ++n) o[mt][n] = (f32x4){0.f, 0.f, 0.f, 0.f}; }
                const int srow = tid >> 3, sc16 = tid & 7;
                u32x4 pk_, pv_;
                int j = __ffs(bmask) - 1;
                {   const bf16* ksrc = Kb + ((size_t)b * S + 64 * j + srow) * 128 + g * 64 + sc16 * 8; const bf16* vsrc = VTA + ((size_t)((b * 32 + j) * 12 + cg)) * 4096 + srow * 64 + sc16 * 8;
                    pk_ = *(const u32x4*)ksrc; pv_ = *(const u32x4*)vsrc; }
                int buf = 0;
                while (j >= 0) {
                    *(LAS u32x4*)(ktl + buf * 64 * RS + srow * RS + sc16 * 8) = pk_; *(LAS u32x4*)(vtl + buf * 64 * RS + srow * RS + sc16 * 8) = pv_;
                    bmask &= bmask - 1u;
                    const int jn = bmask ? __ffs(bmask) - 1 : -1;
                    if (jn >= 0) { const bf16* ksrc = Kb + ((size_t)b * S + 64 * jn + srow) * 128 + g * 64 + sc16 * 8; const bf16* vsrc = VTA + ((size_t)((b * 32 + jn) * 12 + cg)) * 4096 + srow * 64 + sc16 * 8;
                        pk_ = *(const u32x4*)ksrc; pv_ = *(const u32x4*)vsrc; }
                    __syncthreads();
                    const LAS bf16* kt = ktl + buf * 64 * RS + fr * RS + 8 * fq; const LAS bf16* vt = vtl + buf * 64 * RS + fr * RS + 8 * fq;
#pragma unroll
                    for (int mt = 0; mt < 2; ++mt) {
                        if (!((wm[mt] >> j) & 1u)) continue;
                        f32x4 sc[4];
#pragma unroll
                        for (int t = 0; t < 4; ++t) { sc[t] = (f32x4){0.f, 0.f, 0.f, 0.f};
                            sc[t] = __builtin_amdgcn_mfma_f32_16x16x32_bf16(*(const LAS bf16x8*)(kt + t * 16 * RS), qf[mt][0], sc[t], 0, 0, 0);
                            sc[t] = __builtin_amdgcn_mfma_f32_16x16x32_bf16(*(const LAS bf16x8*)(kt + t * 16 * RS + 32), qf[mt][1], sc[t], 0, 0, 0); }
                        const int tl = tl0 + 4 * mt;
                        const bool rowok = (tm[mt] >> j) & 1u;
                        const int kphi = j == x ? tl : 63;
                        const int kplo = (pass && j == x - 4) ? tl + 1 : 0;
                        float bm = -INFINITY;
#pragma unroll
                        for (int t = 0; t < 4; ++t)
#pragma unroll
                            for (int r = 0; r < 4; ++r) { const int kp = 16 * t + 4 * fq + r; const bool v = rowok && kp <= kphi && kp >= kplo; sc[t][r] = v ? sc[t][r] : -INFINITY; bm = fmaxf(bm, sc[t][r]); }
                        bm = fmaxf(bm, __shfl_xor(bm, 16)); bm = fmaxf(bm, __shfl_xor(bm, 32));
                        const float mn = fmaxf(mrun[mt], bm); const float mns = mn == -INFINITY ? 0.f : mn;
                        const float alpha = __expf(mrun[mt] - mns);
                        float rs = 0.f;
#pragma unroll
                        for (int t = 0; t < 4; ++t)
#pragma unroll
                            for (int r = 0; r < 4; ++r) { sc[t][r] = __expf(sc[t][r] - mns); rs += sc[t][r]; }
                        rs += __shfl_xor(rs, 16); rs += __shfl_xor(rs, 32);
                        lrun[mt] = lrun[mt] * alpha + rs; mrun[mt] = mn;
                        bf16x8 pf[2];
#pragma unroll
                        for (int s = 0; s < 2; ++s) { u32x4 w; w.x = pk2(sc[2 * s].x, sc[2 * s].y); w.y = pk2(sc[2 * s].z, sc[2 * s].w); w.z = pk2(sc[2 * s + 1].x, sc[2 * s + 1].y); w.w = pk2(sc[2 * s + 1].z, sc[2 * s + 1].w);
                            pf[s] = __builtin_bit_cast(bf16x8, w); }
#pragma unroll
                        for (int n = 0; n < 4; ++n) { o[mt][n] = o[mt][n] * alpha;
                            o[mt][n] = __builtin_amdgcn_mfma_f32_16x16x32_bf16(*(const LAS bf16x8*)(vt + n * 16 * RS), pf[0], o[mt][n], 0, 0, 0);
                            o[mt][n] = __builtin_amdgcn_mfma_f32_16x16x32_bf16(*(const LAS bf16x8*)(vt + n * 16 * RS + 32), pf[1], o[mt][n], 0, 0, 0); }
                    }
                    j = jn; buf ^= 1;
                }
#pragma unroll
                for (int mt = 0; mt < 2; ++mt) { const float sc_ = (pass ? g2v[mt] : g1v[mt]) / lrun[mt];
#pragma unroll
                    for (int n = 0; n < 4; ++n) outacc[mt][n] = outacc[mt][n] + o[mt][n] * sc_; }
                __syncthreads();
            }
#pragma unroll
            for (int mt = 0; mt < 2; ++mt) {
                bf16* dst = CAT + (tokbase + tl0 + 4 * mt) * 1024 + (g * 4 + (fr & 3)) * 64 + 4 * fq;
#pragma unroll
                for (int n = 0; n < 4; ++n) { u32x2 w; w.x = pk2(outacc[mt][n].x, outacc[mt][n].y); w.y = pk2(outacc[mt][n].z, outacc[mt][n].w); *(u32x2*)(dst + 16 * n) = w; }
            }
        }
    }
    __syncthreads();
}

__device__ __forceinline__ void phase_vtiles(KArgs A, int wv_, LAS unsigned char* lds) {
    const int tid_ = opaque_tid(wv_); const int wid = __builtin_amdgcn_readfirstlane(tid_ >> 6), lane = tid_ & 63; const int gw = blockIdx.x * 8 + wid, NGW = gridDim.x * 8;
    unsigned char* ws = opq(A->ws);
    const bf16* HY = (const bf16*)(ws + WS_BIG); bf16* VTA = (bf16*)(ws + WS_VTA);
    constexpr int TS = 66;
    LAS bf16* tl = (LAS bf16*)(lds + 65536) + wid * (64 * TS);
    for (int it = gw; it < NBATCH * 32 * 12; it += NGW) {
        const int cg = it % 12, bc = it / 12;
        const int colbase = cg < 8 ? C_VB + cg * 64 : (cg < 10 ? C_VS + (cg - 8) * 64 : C_VW + (cg - 10) * 64);
        const u32x4* src = (const u32x4*)(HY + (size_t)(bc * 64 + lane) * HYN + colbase);
        u32x4 w[8];
#pragma unroll
        for (int i = 0; i < 8; ++i) w[i] = src[i];
#pragma unroll
        for (int i = 0; i < 8; ++i) { LAS unsigned* d = (LAS unsigned*)(tl + lane * TS + 8 * i); d[0] = w[i].x; d[1] = w[i].y; d[2] = w[i].z; d[3] = w[i].w; }
        LDS_WAIT();
        bf16* dst = VTA + (size_t)it * 4096 + lane * 64;
#pragma unroll
        for (int p8 = 0; p8 < 8; ++p8) {
            unsigned short x[8];
#pragma unroll
            for (int j = 0; j < 8; ++j) x[j] = tl[kperm64(p8 * 8 + j) * TS + lane];
            u32x4 o; o.x = x[0] | ((unsigned)x[1] << 16); o.y = x[2] | ((unsigned)x[3] << 16); o.z = x[4] | ((unsigned)x[5] << 16); o.w = x[6] | ((unsigned)x[7] << 16);
            *(u32x4*)(dst + p8 * 8) = o;
        }
        LDS_WAIT();
    }
}

__device__ __forceinline__ float log_sigmoid16(float z) { return (fminf(z, 0.f) - __logf(1.0f + __expf(-fabsf(z)))) * (1.f / 16.f); }
#define GLA_Z(tokv) ({ float z_ = bias; _Pragma("unroll") for (int r_ = 0; r_ < 16; ++r_) z_ += __builtin_bit_cast(float, __builtin_amdgcn_readlane(__builtin_bit_cast(int, al[r_]), (tokv))) * wc[r_]; z_; })
#define GLA_LOAD_GATE() \
    float al[16], wc[16]; \
    { const u32x4* ap_ = (const u32x4*)(HY + (size_t)(tok0 + lane) * HYN + C_AL); const u32x4 a0_ = ap_[0], a1_ = ap_[1]; \
      al[0] = bflo(a0_.x); al[1] = bfhi(a0_.x); al[2] = bflo(a0_.y); al[3] = bfhi(a0_.y); al[4] = bflo(a0_.z); al[5] = bfhi(a0_.z); al[6] = bflo(a0_.w); al[7] = bfhi(a0_.w); \
      al[8] = bflo(a1_.x); al[9] = bfhi(a1_.x); al[10] = bflo(a1_.y); al[11] = bfhi(a1_.y); al[12] = bflo(a1_.z); al[13] = bfhi(a1_.z); al[14] = bflo(a1_.w); al[15] = bfhi(a1_.w); } \
    _Pragma("unroll") for (int r_ = 0; r_ < 16; ++r_) wc[r_] = A->in[I_WA2][(i * 16 + r_) * 256 + h * 64 + lane]; \
    const float bias = A->in[I_BA][i * 256 + h * 64 + lane];

__device__ __forceinline__ void phase_gla_a(KArgs A, int wv_, int i, LAS unsigned char* lds) {
    const int tid_ = opaque_tid(wv_); const int wid = __builtin_amdgcn_readfirstlane(tid_ >> 6), lane = tid_ & 63, fr = lane & 15, fq = lane >> 4; const int gw = blockIdx.x * 8 + wid, NGW = gridDim.x * 8;
    unsigned char* ws = opq(A->ws);
    const bf16* HY = (const bf16*)(ws + WS_BIG); const bf16* VTA = (const bf16*)(ws + WS_VTA); float* SLOC = (float*)(ws + WS_SLOC); float* DEC = (float*)(ws + WS_DEC);
    constexpr int RS = 72;
    LAS bf16* kh = (LAS bf16*)lds + wid * (64 * RS);
    (void)gw;
    for (int it = wid * (int)gridDim.x + (int)blockIdx.x; it < 1024; it += NGW) {
        const int c = it & 31, bh = it >> 5, b = bh >> 2, h = bh & 3; const size_t tok0 = (size_t)b * S + c * 64;
        GLA_LOAD_GATE();
        float bl = 0.f;
#pragma unroll 8
        for (int tk = 0; tk < 64; ++tk) bl += log_sigmoid16(GLA_Z(tk));
        float bc = 0.f;
        unsigned short kcol[64];
#pragma unroll
        for (int tk = 0; tk < 64; ++tk) kcol[tk] = HY[(tok0 + tk) * HYN + C_KB + h * 64 + lane];
#pragma unroll
        for (int tk = 0; tk < 64; ++tk) {
            bc += log_sigmoid16(GLA_Z(tk));
            kh[lane * RS + kpos64(tk)] = (bf16)f2bf(bf2f(kcol[tk]) * __expf(bl - bc));
        }
        DEC[it * 64 + lane] = __expf(bl);
        LDS_WAIT();
#pragma unroll
        for (int dvh = 0; dvh < 2; ++dvh) {
            const bf16* vt = VTA + ((size_t)((b * 32 + c) * 12 + h * 2 + dvh)) * 4096;
            bf16x8 vf[4][2];
#pragma unroll
            for (int n = 0; n < 4; ++n)
#pragma unroll
                for (int s = 0; s < 2; ++s) vf[n][s] = *(const bf16x8*)(vt + (16 * n + fr) * 64 + 32 * s + 8 * fq);
#pragma unroll
            for (int m = 0; m < 4; ++m) {
                const bf16x8 a0 = *(const LAS bf16x8*)(kh + (16 * m + fr) * RS + 8 * fq), a1 = *(const LAS bf16x8*)(kh + (16 * m + fr) * RS + 32 + 8 * fq);
#pragma unroll
                for (int n = 0; n < 4; ++n) {
                    f32x4 acc = (f32x4){0.f, 0.f, 0.f, 0.f};
                    acc = __builtin_amdgcn_mfma_f32_16x16x32_bf16(a0, vf[n][0], acc, 0, 0, 0);
                    acc = __builtin_amdgcn_mfma_f32_16x16x32_bf16(a1, vf[n][1], acc, 0, 0, 0);
                    float* dst = SLOC + ((size_t)it * 64 + 16 * m + 4 * fq) * 128 + dvh * 64 + 16 * n + fr;
                    dst[0] = acc.x; dst[128] = acc.y; dst[256] = acc.z; dst[384] = acc.w;
                }
            }
        }
        LDS_WAIT();
    }
}
__device__ __forceinline__ void phase_gla_c(KArgs A, int wv_, int i, LAS unsigned char* lds) {
    const int tid_ = opaque_tid(wv_); const int wid = __builtin_amdgcn_readfirstlane(tid_ >> 6), lane = tid_ & 63, fr = lane & 15, fq = lane >> 4; const int gw = blockIdx.x * 8 + wid, NGW = gridDim.x * 8;
    unsigned char* ws = opq(A->ws);
    const bf16* HY = (const bf16*)(ws + WS_BIG); const bf16* VTA = (const bf16*)(ws + WS_VTA); const bf16* STT = (const bf16*)(ws + WS_STT); bf16* CAT = (bf16*)(ws + WS_CAT);
    constexpr int RS = 72;
    LAS bf16* qs = (LAS bf16*)lds + wid * (128 * RS);
    LAS bf16* ks = qs + 64 * RS;
    const float* og = A->in[I_ONORM] + i * 128;
    (void)gw; (void)NGW;
    for (int blk = blockIdx.x; blk < 128; blk += gridDim.x) {
        {
            const float* SLOC = (const float*)(ws + WS_SLOC); const float* DEC = (const float*)(ws + WS_DEC); bf16* STw = (bf16*)(ws + WS_STT);
            const int tid = tid_, dv = tid & 127, ko = tid >> 7, bh = blk >> 2, c0 = (blk & 3) * 8;
            float sv[16];
#pragma unroll
            for (int j = 0; j < 16; ++j) sv[j] = 0.f;
#pragma unroll 4
            for (int c = 0; c < c0 + 8; ++c) {
                const size_t item = (size_t)bh * 32 + c;
                if (c >= c0) {
                    u32x4 o0, o1; o0.x = pk2(sv[0], sv[1]); o0.y = pk2(sv[2], sv[3]); o0.z = pk2(sv[4], sv[5]); o0.w = pk2(sv[6], sv[7]);
                    o1.x = pk2(sv[8], sv[9]); o1.y = pk2(sv[10], sv[11]); o1.z = pk2(sv[12], sv[13]); o1.w = pk2(sv[14], sv[15]);
                    u32x4* d = (u32x4*)(STw + (item * 128 + dv) * 64 + ko * 16); d[0] = o0; d[1] = o1;
                }
                if (c < c0 + 7) {
                    const float* sl = SLOC + (item * 64 + ko * 16) * 128 + dv; const float* dc = DEC + item * 64 + ko * 16;
#pragma unroll
                    for (int j = 0; j < 16; ++j) sv[j] = dc[j] * sv[j] + sl[j * 128];
                }
            }
            asm volatile("s_waitcnt vmcnt(0)" ::: "memory");
            __syncthreads();
        }
        const int it = blk * 8 + wid;
        const int c = it & 31, bh = it >> 5, b = bh >> 2, h = bh & 3; const size_t tok0 = (size_t)b * S + c * 64;
        GLA_LOAD_GATE();
        float bc = 0.f;
        unsigned short qcol[64], kcol[64];
#pragma unroll
        for (int tk = 0; tk < 64; ++tk) { const bf16* row = HY + (tok0 + tk) * HYN; qcol[tk] = row[C_QB + h * 64 + lane]; kcol[tk] = row[C_KB + h * 64 + lane]; }
#pragma unroll
        for (int tk = 0; tk < 64; ++tk) {
            bc += log_sigmoid16(GLA_Z(tk));
            const float eb = __expf(bc);
            qs[tk * RS + lane] = (bf16)f2bf(bf2f(qcol[tk]) * 0.125f * eb); ks[tk * RS + lane] = (bf16)f2bf(bf2f(kcol[tk]) / eb);
        }
        LDS_WAIT();
        bf16x8 st[8][2];
#pragma unroll
        for (int n = 0; n < 8; ++n)
#pragma unroll
            for (int s = 0; s < 2; ++s) st[n][s] = *(const bf16x8*)(STT + ((size_t)it * 128 + 16 * n + fr) * 64 + 32 * s + 8 * fq);
        const bf16* vt = VTA + ((size_t)((b * 32 + c) * 12 + h * 2)) * 4096;
#pragma unroll
        for (int mi = 0; mi < 4; ++mi) {
            const bf16x8 q0 = *(const LAS bf16x8*)(qs + (16 * mi + fr) * RS + 8 * fq), q1 = *(const LAS bf16x8*)(qs + (16 * mi + fr) * RS + 32 + 8 * fq);
            f32x4 sc[4];
#pragma unroll
            for (int t = 0; t < 4; ++t) {
                sc[t] = (f32x4){0.f, 0.f, 0.f, 0.f};
                if (t <= mi) {
                    const bf16x8 k0 = *(const LAS bf16x8*)(ks + (16 * t + fr) * RS + 8 * fq), k1 = *(const LAS bf16x8*)(ks + (16 * t + fr) * RS + 32 + 8 * fq);
                    sc[t] = __builtin_amdgcn_mfma_f32_16x16x32_bf16(k0, q0, sc[t], 0, 0, 0);
                    sc[t] = __builtin_amdgcn_mfma_f32_16x16x32_bf16(k1, q1, sc[t], 0, 0, 0);
                    if (t == mi) {
                        sc[t].x = (4 * fq + 0 <= fr) ? sc[t].x : 0.f; sc[t].y = (4 * fq + 1 <= fr) ? sc[t].y : 0.f; sc[t].z = (4 * fq + 2 <= fr) ? sc[t].z : 0.f; sc[t].w = (4 * fq + 3 <= fr) ? sc[t].w : 0.f; }
                }
            }
            bf16x8 pf[2];
#pragma unroll
            for (int s = 0; s < 2; ++s) { u32x4 w; w.x = pk2(sc[2 * s].x, sc[2 * s].y); w.y = pk2(sc[2 * s].z, sc[2 * s].w); w.z = pk2(sc[2 * s + 1].x, sc[2 * s + 1].y); w.w = pk2(sc[2 * s + 1].z, sc[2 * s + 1].w);
                pf[s] = __builtin_bit_cast(bf16x8, w); }
            f32x4 o[8]; float ssq = 0.f;
#pragma unroll
            for (int n = 0; n < 8; ++n) {
                o[n] = (f32x4){0.f, 0.f, 0.f, 0.f};
                o[n] = __builtin_amdgcn_mfma_f32_16x16x32_bf16(st[n][0], q0, o[n], 0, 0, 0);
                o[n] = __builtin_amdgcn_mfma_f32_16x16x32_bf16(st[n][1], q1, o[n], 0, 0, 0);
                const bf16* vrow = vt + (size_t)(n >> 2) * 4096 + (16 * (n & 3) + fr) * 64 + 8 * fq;
                o[n] = __builtin_amdgcn_mfma_f32_16x16x32_bf16(*(const bf16x8*)vrow, pf[0], o[n], 0, 0, 0);
                if (mi >= 2) o[n] = __builtin_amdgcn_mfma_f32_16x16x32_bf16(*(const bf16x8*)(vrow + 32), pf[1], o[n], 0, 0, 0);
                ssq += (o[n].x * o[n].x + o[n].y * o[n].y) + (o[n].z * o[n].z + o[n].w * o[n].w);
            }
            ssq += __shfl_xor(ssq, 16); ssq += __shfl_xor(ssq, 32);
            const float rstd = rsqrtf(ssq * (1.f / 128.f) + EPS);
            const size_t tok = tok0 + 16 * mi + fr;
#pragma unroll
            for (int n = 0; n < 8; ++n) {
                const int dv = 16 * n + 4 * fq;
                const u32x2 rw = *(const u32x2*)(HY + tok * HYN + C_RB + h * 128 + dv); const f32x4 g = *(const f32x4*)(og + dv);
                const float r0 = bflo(rw.x), r1 = bfhi(rw.x), r2 = bflo(rw.y), r3 = bfhi(rw.y);
                u32x2 w; w.x = pk2(o[n].x * rstd * g.x * (r0 * sigmoidf_(r0)), o[n].y * rstd * g.y * (r1 * sigmoidf_(r1)));
                w.y = pk2(o[n].z * rstd * g.z * (r2 * sigmoidf_(r2)), o[n].w * rstd * g.w * (r3 * sigmoidf_(r3)));
                *(u32x2*)(CAT + tok * 1024 + 512 + h * 128 + dv) = w;
            }
        }
        LDS_WAIT();
        __syncthreads();
    }
}

__device__ __forceinline__ void phase_sgu_mix(KArgs A, int wv_, int i, LAS unsigned char* lds) {
    const int tid = opaque_tid(wv_), wid = __builtin_amdgcn_readfirstlane(tid >> 6), lane = tid & 63;
    unsigned char* ws = opq(A->ws);
    const bf16* U = (const bf16*)(ws + WS_U); const bf16* V = (const bf16*)(ws + WS_V); bf16* UM = (bf16*)(ws + WS_UM);
    LAS float* vt = (LAS float*)lds;
    LAS float* st = vt + 128 * 256;
    const float* lng = A->in[I_LNG] + i * 2048; const float* lnb = A->in[I_LNB] + i * 2048;
    for (int it = blockIdx.x; it < NBATCH * 16 * 8; it += gridDim.x) {
        const int g = it & 7, n = (it >> 3) & 15, b = it >> 7;
        const size_t tok0 = (size_t)b * S + n * 128;
        __syncthreads();
        for (int s = wid * 16; s < wid * 16 + 16; ++s) {
            const u32x4* vr = (const u32x4*)(V + (tok0 + s) * 2048) + lane;
            float x[32]; float sum = 0.f;
#pragma unroll
            for (int j = 0; j < 4; ++j) { const u32x4 w = vr[64 * j];
                x[8 * j + 0] = bflo(w.x); x[8 * j + 1] = bfhi(w.x); x[8 * j + 2] = bflo(w.y); x[8 * j + 3] = bfhi(w.y); x[8 * j + 4] = bflo(w.z); x[8 * j + 5] = bfhi(w.z); x[8 * j + 6] = bflo(w.w); x[8 * j + 7] = bfhi(w.w); }
#pragma unroll
            for (int j = 0; j < 32; ++j) sum += x[j];
            const float mean = wave_sum(sum) * (1.f / 2048.f); float q = 0.f;
#pragma unroll
            for (int j = 0; j < 32; ++j) { const float d = x[j] - mean; q += d * d; }
            const float rstd = rsqrtf(wave_sum(q) * (1.f / 2048.f) + EPS);
            const u32x2 w = *((const u32x2*)(V + (tok0 + s) * 2048 + g * 256) + lane);
            const f32x4 gg = *(const f32x4*)(lng + g * 256 + 4 * lane), bb = *(const f32x4*)(lnb + g * 256 + 4 * lane);
            f32x4 o; o.x = (bflo(w.x) - mean) * rstd * gg.x + bb.x; o.y = (bfhi(w.x) - mean) * rstd * gg.y + bb.y; o.z = (bflo(w.y) - mean) * rstd * gg.z + bb.z; o.w = (bfhi(w.y) - mean) * rstd * gg.w + bb.w;
            *(LAS f32x4*)(vt + s * 256 + 4 * lane) = o;
            (void)st;
        }
        __syncthreads();
        const int c = tid & 255, th = tid >> 8;
        const float* wsg = A->in[I_SGWS] + (size_t)(i * 8 + g) * 128 * 128; const float* bsg = A->in[I_SGBS] + (i * 8 + g) * 128;
        for (int tt = 0; tt < 64; ++tt) {
            const int t = 2 * tt + th;
            const float* wr = wsg + t * 128;
            float acc = 0.f;
            for (int s = 0; s <= t; ++s) acc += wr[s] * vt[s * 256 + c];
            acc += bsg[t];
            const float u = bf2f(U[(tok0 + t) * 2048 + g * 256 + c]);
            UM[(tok0 + t) * 2048 + g * 256 + c] = (bf16)f2bf(u * acc);
        }
    }
    __syncthreads();
}


__device__ __forceinline__ void phase_sgu_mix_mfma(KArgs A, int wv_, int i, LAS unsigned char* lds) {
    const int tid = opaque_tid(wv_), wid = __builtin_amdgcn_readfirstlane(tid >> 6), lane = tid & 63, fr = lane & 15, fq = lane >> 4;
    unsigned char* ws = opq(A->ws);
    const bf16* U = (const bf16*)(ws + WS_U); const bf16* V = (const bf16*)(ws + WS_V); bf16* UM = (bf16*)(ws + WS_UM);
    const bf16* WSB = (const bf16*)(ws + WS_WSB) + (size_t)i * 8 * 16384; const float* M0 = (const float*)(ws + WS_M0) + i * 8 * 128;
    constexpr int VS = 136;
    LAS bf16* vT = (LAS bf16*)lds;
    LAS float* st = (LAS float*)(lds + 256 * VS * 2);
    const float* lng = A->in[I_LNG] + i * 2048; const float* lnb = A->in[I_LNB] + i * 2048; const float* bsg = A->in[I_SGBS] + i * 8 * 128;
    for (int it = blockIdx.x; it < 256; it += gridDim.x) {
        const int gh = it & 1, n_ = (it >> 1) & 15, b = it >> 5; const size_t tok0 = (size_t)b * S + n_ * 128;
        __syncthreads();
        for (int s4 = wid * 16; s4 < wid * 16 + 16; s4 += 4) {
            u32x4 w[4][4];
#pragma unroll
            for (int rr = 0; rr < 4; ++rr) { const u32x4* vr = (const u32x4*)(V + (tok0 + s4 + rr) * 2048) + lane;
#pragma unroll
                for (int j = 0; j < 4; ++j) w[rr][j] = vr[64 * j]; }
#pragma unroll
            for (int rr = 0; rr < 4; ++rr) {
                float sum = 0.f, sq = 0.f;
#pragma unroll
                for (int j = 0; j < 4; ++j) { const float x0 = bflo(w[rr][j].x), x1 = bfhi(w[rr][j].x), x2 = bflo(w[rr][j].y), x3 = bfhi(w[rr][j].y), x4 = bflo(w[rr][j].z), x5 = bfhi(w[rr][j].z), x6 = bflo(w[rr][j].w), x7 = bfhi(w[rr][j].w);
                    sum += ((x0 + x1) + (x2 + x3)) + ((x4 + x5) + (x6 + x7)); sq += ((x0 * x0 + x1 * x1) + (x2 * x2 + x3 * x3)) + ((x4 * x4 + x5 * x5) + (x6 * x6 + x7 * x7)); }
                sum = wave_sum(sum); sq = wave_sum(sq);
                const float mean = sum * (1.f / 2048.f); const float var = fmaxf(sq * (1.f / 2048.f) - mean * mean, 0.f);
                if (lane == 0) { st[2 * (s4 + rr)] = mean; st[2 * (s4 + rr) + 1] = rsqrtf(var + EPS); }
            }
        }
#pragma unroll 1
        for (int gg = 0; gg < 4; ++gg) {
            const int g = gh * 4 + gg;
            __syncthreads();
            {
                const int s = tid & 127, cq = tid >> 7;
                const float mean = st[2 * s], rstd = st[2 * s + 1];
                const u32x4* src = (const u32x4*)(V + (tok0 + s) * 2048 + g * 256 + cq * 64);
#pragma unroll
                for (int i8 = 0; i8 < 8; ++i8) {
                    const u32x4 w = src[i8];
                    LAS bf16* d = vT + (cq * 64 + i8 * 8) * VS + s;
                    d[0 * VS] = (bf16)f2bf((bflo(w.x) - mean) * rstd); d[1 * VS] = (bf16)f2bf((bfhi(w.x) - mean) * rstd); d[2 * VS] = (bf16)f2bf((bflo(w.y) - mean) * rstd); d[3 * VS] = (bf16)f2bf((bfhi(w.y) - mean) * rstd);
                    d[4 * VS] = (bf16)f2bf((bflo(w.z) - mean) * rstd); d[5 * VS] = (bf16)f2bf((bfhi(w.z) - mean) * rstd); d[6 * VS] = (bf16)f2bf((bflo(w.w) - mean) * rstd); d[7 * VS] = (bf16)f2bf((bfhi(w.w) - mean) * rstd);
                }
            }
            __syncthreads();
            bf16x8 vf[2][4];
#pragma unroll
            for (int m = 0; m < 2; ++m)
#pragma unroll
                for (int k = 0; k < 4; ++k) vf[m][k] = *(const LAS bf16x8*)(vT + (32 * wid + 16 * m + fr) * VS + 32 * k + 8 * fq);
            const bf16* wb = WSB + ((size_t)g * 128 + fr) * 128 + 8 * fq;
            f32x4 gc[2], bc[2];
#pragma unroll
            for (int m = 0; m < 2; ++m) { gc[m] = *(const f32x4*)(lng + g * 256 + 32 * wid + 16 * m + 4 * fq); bc[m] = *(const f32x4*)(lnb + g * 256 + 32 * wid + 16 * m + 4 * fq); }
#pragma unroll
            for (int n = 0; n < 8; ++n) {
                f32x4 a0 = (f32x4){0.f, 0.f, 0.f, 0.f}, a1 = (f32x4){0.f, 0.f, 0.f, 0.f};
                asm volatile("" : "+v"(wb));
#pragma unroll
                for (int k = 0; k < 4; ++k) if (k <= (n >> 1)) {
                    const bf16x8 wf = *(const bf16x8*)(wb + 32 * k);
                    a0 = __builtin_amdgcn_mfma_f32_16x16x32_bf16(vf[0][k], wf, a0, 0, 0, 0);
                    a1 = __builtin_amdgcn_mfma_f32_16x16x32_bf16(vf[1][k], wf, a1, 0, 0, 0); }
                wb += 16 * 128;
                const int t = 16 * n + fr; const float m0 = M0[g * 128 + t], bsv = bsg[g * 128 + t];
                const size_t ro = (tok0 + t) * 2048 + g * 256 + 32 * wid + 4 * fq;
#pragma unroll
                for (int m = 0; m < 2; ++m) {
                    const f32x4 a = m ? a1 : a0;
                    const u32x2 uw = *(const u32x2*)(U + ro + 16 * m);
                    u32x2 w; w.x = pk2((a.x * gc[m].x + bc[m].x * m0 + bsv) * bflo(uw.x), (a.y * gc[m].y + bc[m].y * m0 + bsv) * bfhi(uw.x));
                    w.y = pk2((a.z * gc[m].z + bc[m].z * m0 + bsv) * bflo(uw.y), (a.w * gc[m].w + bc[m].w * m0 + bsv) * bfhi(uw.y));
                    *(u32x2*)(UM + ro + 16 * m) = w;
                }
                asm volatile("" ::: "memory");
            }
        }
    }
    __syncthreads();
}

__device__ __forceinline__ void phase_rownorm(KArgs A, int wv_) {
    const int tid_ = opaque_tid(wv_); const int wid = __builtin_amdgcn_readfirstlane(tid_ >> 6), lane = tid_ & 63; const int gw = blockIdx.x * 8 + wid, NGW = gridDim.x * 8;
    bf16* XN = (bf16*)(opq(A->ws) + WS_XN); const float* X = A->out;
    f32x4 v[4], vn[4];
    if (gw < T) {
#pragma unroll
        for (int j = 0; j < 4; ++j) v[j] = ((const f32x4*)(X + (size_t)gw * D) + lane)[64 * j];
    }
    for (int m = gw; m < T; m += NGW) {
        const int mn = m + NGW < T ? m + NGW : m;
#pragma unroll
        for (int j = 0; j < 4; ++j) vn[j] = ((const f32x4*)(X + (size_t)mn * D) + lane)[64 * j];
        float s = 0.f;
#pragma unroll
        for (int j = 0; j < 4; ++j) s += (v[j].x * v[j].x + v[j].y * v[j].y) + (v[j].z * v[j].z + v[j].w * v[j].w);
        const float rstd = rsqrtf(wave_sum(s) * (1.f / 1024.f) + EPS);
        u32x2* o8 = (u32x2*)(XN + (size_t)m * D) + lane;
#pragma unroll
        for (int j = 0; j < 4; ++j) { u32x2 w; w.x = pk2(v[j].x * rstd, v[j].y * rstd); w.y = pk2(v[j].z * rstd, v[j].w * rstd); o8[64 * j] = w; }
#pragma unroll
        for (int j = 0; j < 4; ++j) v[j] = vn[j];
    }
}

__device__ __forceinline__ void phase_xattn(KArgs A, int wv_, int L, LAS unsigned char* lds) {
    const int tid = opaque_tid(wv_), wid = __builtin_amdgcn_readfirstlane(tid >> 6), lane = tid & 63;
    unsigned char* ws = opq(A->ws);
    const bf16* QX = (const bf16*)(ws + WS_QX); const bf16* KV = (const bf16*)(ws + WS_KV); bf16* OX = (bf16*)(ws + WS_OX);
    constexpr int KSTR = 129;
    LAS unsigned* kl = (LAS unsigned*)lds;
    LAS float* qb = (LAS float*)(lds + 132096) + wid * 256;
    LAS float* pb = (LAS float*)(lds + 132096 + 8192) + wid * 256;
    const float* qg = A->in[I_XQN] + L * 256;
    for (int it = blockIdx.x; it < NBATCH * 4 * 8; it += gridDim.x) {
        const int qc = it & 7, h = (it >> 3) & 3, b = it >> 5;
        __syncthreads();
        for (int e = tid; e < 256 * 128; e += 512) { const int m = e >> 7, dw = e & 127;
            kl[m * KSTR + dw] = *((const unsigned*)(KV + (size_t)(b * 256 + m) * 8192 + L * 2048 + h * 256) + dw); }
        __syncthreads();
        const bf16* Vb = KV + (size_t)(b * 256) * 8192 + L * 2048 + 1024 + h * 256;
        for (int tq = 0; tq < 32; ++tq) {
            const size_t tok = (size_t)b * S + qc * 256 + wid * 32 + tq;
            const u32x2 qw = *((const u32x2*)(QX + tok * 1024 + h * 256) + lane);
            const float q0 = bflo(qw.x), q1 = bfhi(qw.x), q2 = bflo(qw.y), q3 = bfhi(qw.y);
            const float rstd = rsqrtf(wave_sum(q0 * q0 + q1 * q1 + q2 * q2 + q3 * q3) * (1.f / 256.f) + EPS);
            const f32x4 gg = *(const f32x4*)(qg + 4 * lane);
            *(LAS f32x4*)(qb + 4 * lane) = (f32x4){q0 * rstd * gg.x, q1 * rstd * gg.y, q2 * rstd * gg.z, q3 * rstd * gg.w};
            LDS_WAIT();
            float s0 = 0.f, s1 = 0.f, s2 = 0.f, s3 = 0.f;
#pragma unroll 4
            for (int dw = 0; dw < 128; ++dw) {
                const f32x2 qq = *(const LAS f32x2*)(qb + 2 * dw);
                const unsigned k0 = kl[lane * KSTR + dw], k1 = kl[(lane + 64) * KSTR + dw], k2 = kl[(lane + 128) * KSTR + dw], k3 = kl[(lane + 192) * KSTR + dw];
                s0 += qq.x * bflo(k0) + qq.y * bfhi(k0); s1 += qq.x * bflo(k1) + qq.y * bfhi(k1);
                s2 += qq.x * bflo(k2) + qq.y * bfhi(k2); s3 += qq.x * bflo(k3) + qq.y * bfhi(k3);
            }
            const float mx = wave_max(fmaxf(fmaxf(s0, s1), fmaxf(s2, s3)));
            const float e0 = __expf(s0 - mx), e1 = __expf(s1 - mx), e2 = __expf(s2 - mx), e3 = __expf(s3 - mx);
            const float inv = 1.f / wave_sum((e0 + e1) + (e2 + e3));
            pb[lane] = e0 * inv; pb[lane + 64] = e1 * inv; pb[lane + 128] = e2 * inv; pb[lane + 192] = e3 * inv;
            LDS_WAIT();
            float o0 = 0.f, o1 = 0.f, o2 = 0.f, o3 = 0.f;
#pragma unroll 8
            for (int m = 0; m < 256; ++m) {
                const float p = pb[m];
                const u32x2 vw = *((const u32x2*)(Vb + (size_t)m * 8192) + lane);
                o0 += p * bflo(vw.x); o1 += p * bfhi(vw.x); o2 += p * bflo(vw.y); o3 += p * bfhi(vw.y);
            }
            u32x2 ow; ow.x = pk2(o0, o1); ow.y = pk2(o2, o3);
            *((u32x2*)(OX + tok * 1024 + h * 256) + lane) = ow;
            LDS_WAIT();
        }
    }
    __syncthreads();
}


__device__ __forceinline__ int kperm32(int p) { const int fq = (p >> 3) & 3, j = p & 7; return (p & ~31) + 16 * (j >> 2) + 4 * fq + (j & 3); }
__device__ __forceinline__ void phase_vtrans(KArgs A, int wv_, LAS unsigned char* lds) {
    const int tid = opaque_tid(wv_);
    unsigned char* ws = opq(A->ws);
    const bf16* KV = (const bf16*)(ws + WS_KV); bf16* VT = (bf16*)(ws + WS_VT);
    LAS bf16* vt = (LAS bf16*)lds;
    constexpr int VS = 258;
    for (int it = blockIdx.x; it < DEPTH * NBATCH * 4; it += gridDim.x) {
        const int h = it & 3, b = (it >> 2) & 7, l = it >> 5;
        __syncthreads();
        for (int e = tid; e < 256 * 32; e += 512) { const int m = e >> 5, c8 = e & 31;
            const u32x4 w = *(const u32x4*)(KV + (size_t)(b * 256 + m) * 8192 + l * 2048 + 1024 + h * 256 + c8 * 8);
            LAS unsigned* d = (LAS unsigned*)(vt + m * VS + c8 * 8); d[0] = w.x; d[1] = w.y; d[2] = w.z; d[3] = w.w; }
        __syncthreads();
        for (int e = tid; e < 256 * 32; e += 512) { const int dv = e & 255, p8 = e >> 8;
            unsigned short x[8];
#pragma unroll
            for (int j = 0; j < 8; ++j) x[j] = vt[kperm32(p8 * 8 + j) * VS + dv];
            u32x4 o; o.x = x[0] | ((unsigned)x[1] << 16); o.y = x[2] | ((unsigned)x[3] << 16); o.z = x[4] | ((unsigned)x[5] << 16); o.w = x[6] | ((unsigned)x[7] << 16);
            *(u32x4*)(VT + ((size_t)it * 256 + dv) * 256 + p8 * 8) = o; }
    }
    __syncthreads();
}

__device__ __forceinline__ void phase_xattn_mfma(KArgs A, int wv_, int L, LAS unsigned char* lds) {
    const int tid = opaque_tid(wv_), wid = __builtin_amdgcn_readfirstlane(tid >> 6), lane = tid & 63, fr = lane & 15, fq = lane >> 4;
    unsigned char* ws = opq(A->ws);
    const bf16* QX = (const bf16*)(ws + WS_QX); const bf16* KV = (const bf16*)(ws + WS_KV); const bf16* VT = (const bf16*)(ws + WS_VT); bf16* OX = (bf16*)(ws + WS_OX);
    constexpr int RS = 264;
    LAS bf16* kl = (LAS bf16*)lds;
    const float* qg = A->in[I_XQN] + L * 256;
    for (int it = blockIdx.x; it < NBATCH * 4 * 16; it += gridDim.x) {
        const int qt = it & 15, h = (it >> 4) & 3, b = it >> 6;
        __syncthreads();
        {
            const int row = tid >> 1, hf = tid & 1;
            const u32x4* src = (const u32x4*)(KV + (size_t)(b * 256 + row) * 8192 + L * 2048 + h * 256 + hf * 128);
#pragma unroll
            for (int i0 = 0; i0 < 16; i0 += 8) {
                u32x4 w[8];
#pragma unroll
                for (int i = 0; i < 8; ++i) w[i] = src[i0 + i];
#pragma unroll
                for (int i = 0; i < 8; ++i) *(LAS u32x4*)(kl + row * RS + hf * 128 + (i0 + i) * 8) = w[i];
            }
        }
        const size_t tok = (size_t)b * S + qt * 128 + wid * 16 + fr;
        bf16x8 qf[8];
        {
            u32x4 qw[8]; float ssq = 0.f;
#pragma unroll
            for (int s = 0; s < 8; ++s) qw[s] = *(const u32x4*)(QX + tok * 1024 + h * 256 + 32 * s + 8 * fq);
#pragma unroll
            for (int s = 0; s < 8; ++s) {
                const float a0 = bflo(qw[s].x), a1 = bfhi(qw[s].x), a2 = bflo(qw[s].y), a3 = bfhi(qw[s].y), a4 = bflo(qw[s].z), a5 = bfhi(qw[s].z), a6 = bflo(qw[s].w), a7 = bfhi(qw[s].w);
                ssq += (a0 * a0 + a1 * a1) + (a2 * a2 + a3 * a3) + (a4 * a4 + a5 * a5) + (a6 * a6 + a7 * a7);
            }
            ssq += __shfl_xor(ssq, 16); ssq += __shfl_xor(ssq, 32);
            const float rstd = rsqrtf(ssq * (1.f / 256.f) + EPS);
#pragma unroll
            for (int s = 0; s < 8; ++s) {
                const f32x4 ga = *(const f32x4*)(qg + 32 * s + 8 * fq), gb = *(const f32x4*)(qg + 32 * s + 8 * fq + 4);
                u32x4 w; w.x = pk2(bflo(qw[s].x) * rstd * ga.x, bfhi(qw[s].x) * rstd * ga.y); w.y = pk2(bflo(qw[s].y) * rstd * ga.z, bfhi(qw[s].y) * rstd * ga.w);
                w.z = pk2(bflo(qw[s].z) * rstd * gb.x, bfhi(qw[s].z) * rstd * gb.y); w.w = pk2(bflo(qw[s].w) * rstd * gb.z, bfhi(qw[s].w) * rstd * gb.w);
                qf[s] = __builtin_bit_cast(bf16x8, w);
            }
        }
        __syncthreads();
        f32x4 sc[16];
#pragma unroll
        for (int hf = 0; hf < 2; ++hf) {
            unsigned kb = (unsigned)(size_t)(kl + (128 * hf + fr) * RS + 8 * fq); asm volatile("" : "+v"(kb));
#pragma unroll
            for (int t8 = 0; t8 < 8; ++t8) { const int t = 8 * hf + t8; sc[t] = (f32x4){0.f, 0.f, 0.f, 0.f};
#pragma unroll
                for (int s = 0; s < 8; ++s) { const bf16x8 kf = *(const LAS bf16x8*)(size_t)(kb + (unsigned)((16 * t8 * RS + 32 * s) * 2));
                    sc[t] = __builtin_amdgcn_mfma_f32_16x16x32_bf16(kf, qf[s], sc[t], 0, 0, 0); }
                if (t & 1) asm volatile("" ::: "memory"); }
        }
        float mx = -INFINITY;
#pragma unroll
        for (int t = 0; t < 16; ++t) mx = fmaxf(mx, fmaxf(fmaxf(sc[t].x, sc[t].y), fmaxf(sc[t].z, sc[t].w)));
        mx = fmaxf(mx, __shfl_xor(mx, 16)); mx = fmaxf(mx, __shfl_xor(mx, 32));
        float lsum = 0.f;
#pragma unroll
        for (int t = 0; t < 16; ++t) { sc[t].x = __expf(sc[t].x - mx); sc[t].y = __expf(sc[t].y - mx); sc[t].z = __expf(sc[t].z - mx); sc[t].w = __expf(sc[t].w - mx); lsum += (sc[t].x + sc[t].y) + (sc[t].z + sc[t].w); }
        lsum += __shfl_xor(lsum, 16); lsum += __shfl_xor(lsum, 32);
        const float inv = 1.f / lsum;
        bf16x8 pf[8];
#pragma unroll
        for (int s = 0; s < 8; ++s) { u32x4 w; w.x = pk2(sc[2 * s].x, sc[2 * s].y); w.y = pk2(sc[2 * s].z, sc[2 * s].w); w.z = pk2(sc[2 * s + 1].x, sc[2 * s + 1].y); w.w = pk2(sc[2 * s + 1].z, sc[2 * s + 1].w);
            pf[s] = __builtin_bit_cast(bf16x8, w); }
        __syncthreads();
        {
            const int row = tid >> 1, hf = tid & 1;
            const u32x4* src = (const u32x4*)(VT + ((size_t)((L * 8 + b) * 4 + h) * 256 + row) * 256 + hf * 128);
#pragma unroll
            for (int i0 = 0; i0 < 16; i0 += 8) {
                u32x4 w[8];
#pragma unroll
                for (int i = 0; i < 8; ++i) w[i] = src[i0 + i];
#pragma unroll
                for (int i = 0; i < 8; ++i) *(LAS u32x4*)(kl + row * RS + hf * 128 + (i0 + i) * 8) = w[i];
            }
        }
        __syncthreads();
#pragma unroll
        for (int hf = 0; hf < 2; ++hf) {
            unsigned vb = (unsigned)(size_t)(kl + (128 * hf + fr) * RS + 8 * fq); asm volatile("" : "+v"(vb));
#pragma unroll
            for (int n8 = 0; n8 < 8; ++n8) { const int n = 8 * hf + n8; f32x4 o = (f32x4){0.f, 0.f, 0.f, 0.f};
#pragma unroll
                for (int s = 0; s < 8; ++s) { const bf16x8 vf = *(const LAS bf16x8*)(size_t)(vb + (unsigned)((16 * n8 * RS + 32 * s) * 2));
                    o = __builtin_amdgcn_mfma_f32_16x16x32_bf16(vf, pf[s], o, 0, 0, 0); }
                u32x2 w; w.x = pk2(o.x * inv, o.y * inv); w.y = pk2(o.z * inv, o.w * inv);
                *(u32x2*)(OX + tok * 1024 + h * 256 + 16 * n + 4 * fq) = w;
                if (n & 1) asm volatile("" ::: "memory"); }
        }
    }
    __syncthreads();
}

__device__ __forceinline__ void phase_route(KArgs A, int wv_, int L, LAS unsigned char* lds) {
    const int tid_ = opaque_tid(wv_); const int wid = __builtin_amdgcn_readfirstlane(tid_ >> 6), lane = tid_ & 63;
    unsigned char* ws = opq(A->ws);
    const float* RW = (const float*)(ws + WS_RW) + (size_t)L * NEXP * D;
    unsigned* cnt = (unsigned*)(ws + WS_CTL) + CW_CNT + L * 64;
    int* list = (int*)(ws + WS_LIST); int* te = (int*)(ws + WS_TOK); int* tp = te + 2 * T; float* tw = (float*)(tp + 2 * T);
    bf16* XN = (bf16*)(ws + WS_XN);
    LAS float* rwl = (LAS float*)lds;
    LAS unsigned* lcnt = (LAS unsigned*)(lds + 65536);
    LAS unsigned* lbase = lcnt + 16;
    const float rbv = A->in[I_RB][lane >> 2];
    for (int e4 = tid_; e4 < NEXP * D / 4; e4 += 512) *(LAS f32x4*)(rwl + 4 * e4) = *(const f32x4*)(RW + 4 * e4);
    for (int blk = blockIdx.x; blk < T / 64; blk += gridDim.x) {
        __syncthreads();
        if (tid_ < 16) lcnt[tid_] = 0u;
        __syncthreads();
        int e0s = 0, e1s = 0, r0s = 0, r1s = 0; float w0s = 0.f;
        f32x4 v[4], vn[4];
#pragma unroll
        for (int j = 0; j < 4; ++j) v[j] = ((const f32x4*)(A->out + (size_t)(blk * 64 + wid * 8) * D) + lane)[64 * j];
#pragma unroll 1
        for (int q = 0; q < 8; ++q) {
            const int t = blk * 64 + wid * 8 + q;
            { const f32x4* xn_ = (const f32x4*)(A->out + (size_t)(t + (q < 7 ? 1 : 0)) * D) + lane;
#pragma unroll
              for (int j = 0; j < 4; ++j) vn[j] = xn_[64 * j]; }
            float s = 0.f;
#pragma unroll
            for (int j = 0; j < 4; ++j) s += (v[j].x * v[j].x + v[j].y * v[j].y) + (v[j].z * v[j].z + v[j].w * v[j].w);
            const float rstd = rsqrtf(wave_sum(s) * (1.f / 1024.f) + EPS);
            u32x2* o8 = (u32x2*)(XN + (size_t)t * D) + lane;
#pragma unroll
            for (int j = 0; j < 4; ++j) { u32x2 w; w.x = pk2(v[j].x * rstd, v[j].y * rstd); w.y = pk2(v[j].z * rstd, v[j].w * rstd); o8[64 * j] = w; }
            float a[16];
#pragma unroll
            for (int e = 0; e < 16; ++e) {
                const LAS f32x4* wr = (const LAS f32x4*)(rwl + e * D) + lane; float acc = 0.f;
#pragma unroll
                for (int j = 0; j < 4; ++j) { const f32x4 w = wr[64 * j]; acc += (v[j].x * w.x + v[j].y * w.y) + (v[j].z * w.z + v[j].w * w.w); }
                a[e] = acc;
            }
            float a8[8], a4[4], a2[2], a1;
            { const bool up = lane & 32;
#pragma unroll
              for (int k = 0; k < 8; ++k) { const float send = up ? a[k] : a[k + 8], keep = up ? a[k + 8] : a[k]; a8[k] = keep + __shfl_xor(send, 32); } }
            { const bool up = lane & 16;
#pragma unroll
              for (int k = 0; k < 4; ++k) { const float send = up ? a8[k] : a8[k + 4], keep = up ? a8[k + 4] : a8[k]; a4[k] = keep + __shfl_xor(send, 16); } }
            { const bool up = lane & 8;
#pragma unroll
              for (int k = 0; k < 2; ++k) { const float send = up ? a4[k] : a4[k + 2], keep = up ? a4[k + 2] : a4[k]; a2[k] = keep + __shfl_xor(send, 8); } }
            { const bool up = lane & 4; const float send = up ? a2[0] : a2[1], keep = up ? a2[1] : a2[0]; a1 = keep + __shfl_xor(send, 4); }
            a1 += __shfl_xor(a1, 2); a1 += __shfl_xor(a1, 1);
            const float lg = a1 * rstd + rbv;
            const float v0 = wave_max(lg);
            const int e0 = (__ffsll((unsigned long long)__ballot(lg == v0)) - 1) >> 2;
            const int gidx = e0 >> 2;
            const bool c2 = (lane >> 4) == gidx && (lane >> 2) != e0;
            const float m2 = c2 ? lg : -INFINITY;
            const float v1 = wave_max(m2);
            const int e1 = (__ffsll((unsigned long long)__ballot(c2 && m2 == v1)) - 1) >> 2;
            const float w0 = 1.f / (1.f + __expf(v1 - v0));
            unsigned r0 = 0, r1 = 0;
            if (lane == 0) { r0 = atomicAdd((unsigned*)(lcnt + e0), 1u); r1 = atomicAdd((unsigned*)(lcnt + e1), 1u); }
            r0 = __builtin_amdgcn_readfirstlane(r0); r1 = __builtin_amdgcn_readfirstlane(r1);
            if (lane == q) { e0s = e0; e1s = e1; r0s = (int)r0; r1s = (int)r1; w0s = w0; }
#pragma unroll
            for (int j = 0; j < 4; ++j) v[j] = vn[j];
        }
        __syncthreads();
        if (tid_ < 16) lbase[tid_] = atomicAdd(&cnt[tid_], lcnt[tid_]);
        __syncthreads();
        if (lane < 8) {
            const int t = blk * 64 + wid * 8 + lane;
            const int p0 = (int)lbase[e0s] + r0s, p1 = (int)lbase[e1s] + r1s;
            list[e0s * T + p0] = t; list[e1s * T + p1] = t;
            te[2 * t] = e0s; te[2 * t + 1] = e1s; tp[2 * t] = p0; tp[2 * t + 1] = p1; tw[2 * t] = w0s; tw[2 * t + 1] = 1.f - w0s;
        }
    }
    __syncthreads();
}
__device__ __forceinline__ void moe_offsets(KArgs A, int wv_, int L, LAS int* off, LAS int* cn) {
    if (opaque_tid(wv_) == 0) {
        const unsigned* cnt = (const unsigned*)(opq(A->ws) + WS_CTL) + CW_CNT + L * 64;
        int o = 0;
        for (int e = 0; e < 16; ++e) { const int c = (int)__hip_atomic_load(cnt + e, __ATOMIC_RELAXED, __HIP_MEMORY_SCOPE_AGENT); off[e] = o; cn[e] = c; o += (c + 255) & ~255; }
        off[16] = o;
    }
    __syncthreads();
}
__device__ __forceinline__ void phase_moe_combine(KArgs A, int wv_, int L, LAS unsigned char* lds) {
    LAS int* off = (LAS int*)lds; LAS int* cn = off + 32;
    moe_offsets(A, wv_, L, off, cn);
    const int tid_ = opaque_tid(wv_); const int wid = __builtin_amdgcn_readfirstlane(tid_ >> 6), lane = tid_ & 63; const int gw = blockIdx.x * 8 + wid, NGW = gridDim.x * 8;
    unsigned char* ws = opq(A->ws);
    const int* te = (const int*)(ws + WS_TOK); const int* tp = te + 2 * T; const float* tw = (const float*)(tp + 2 * T);
    const bf16* Y = (const bf16*)(ws + WS_Y); bf16* XN = (bf16*)(ws + WS_XN);
    const int nq = (T - gw + NGW - 1) / NGW;
    for (int q0 = 0; q0 < nq; q0 += 8) {
        int s0m = 0, s1m = 0; float w0m = 0.f, w1m = 0.f;
        { const int qq = q0 + (lane & 7); const int t = gw + NGW * (qq < nq ? qq : nq - 1);
          s0m = off[te[2 * t]] + tp[2 * t]; s1m = off[te[2 * t + 1]] + tp[2 * t + 1]; w0m = tw[2 * t]; w1m = tw[2 * t + 1]; }
        const int nn = nq - q0 < 8 ? nq - q0 : 8;
        f32x4 v[4], vn[4]; u32x2 ya[4], yb[4], yan[4], ybn[4];
        { const int t = gw + NGW * q0; const int sl0 = __builtin_amdgcn_readlane(s0m, 0), sl1 = __builtin_amdgcn_readlane(s1m, 0);
#pragma unroll
          for (int j = 0; j < 4; ++j) { v[j] = ((const f32x4*)(A->out + (size_t)t * D) + lane)[64 * j]; ya[j] = ((const u32x2*)(Y + (size_t)sl0 * D) + lane)[64 * j]; yb[j] = ((const u32x2*)(Y + (size_t)sl1 * D) + lane)[64 * j]; } }
#pragma unroll 1
        for (int q = 0; q < nn; ++q) {
            const int t = gw + NGW * (q0 + q);
            const int qn = q + 1 < nn ? q + 1 : q;
            { const int tn = gw + NGW * (q0 + qn); const int sl0 = __builtin_amdgcn_readlane(s0m, qn), sl1 = __builtin_amdgcn_readlane(s1m, qn);
#pragma unroll
              for (int j = 0; j < 4; ++j) { vn[j] = ((const f32x4*)(A->out + (size_t)tn * D) + lane)[64 * j]; yan[j] = ((const u32x2*)(Y + (size_t)sl0 * D) + lane)[64 * j]; ybn[j] = ((const u32x2*)(Y + (size_t)sl1 * D) + lane)[64 * j]; } }
            const float w0 = __builtin_bit_cast(float, __builtin_amdgcn_readlane(__builtin_bit_cast(int, w0m), q)), w1 = __builtin_bit_cast(float, __builtin_amdgcn_readlane(__builtin_bit_cast(int, w1m), q));
            float s = 0.f;
#pragma unroll
            for (int j = 0; j < 4; ++j) {
                v[j].x += w0 * bflo(ya[j].x) + w1 * bflo(yb[j].x); v[j].y += w0 * bfhi(ya[j].x) + w1 * bfhi(yb[j].x); v[j].z += w0 * bflo(ya[j].y) + w1 * bflo(yb[j].y); v[j].w += w0 * bfhi(ya[j].y) + w1 * bfhi(yb[j].y);
                s += (v[j].x * v[j].x + v[j].y * v[j].y) + (v[j].z * v[j].z + v[j].w * v[j].w);
            }
            const float rstd = rsqrtf(wave_sum(s) * (1.f / 1024.f) + EPS);
            f32x4* xr = (f32x4*)(A->out + (size_t)t * D) + lane; u32x2* o8 = (u32x2*)(XN + (size_t)t * D) + lane;
#pragma unroll
            for (int j = 0; j < 4; ++j) { xr[64 * j] = v[j]; u32x2 w; w.x = pk2(v[j].x * rstd, v[j].y * rstd); w.y = pk2(v[j].z * rstd, v[j].w * rstd); o8[64 * j] = w; }
#pragma unroll
            for (int j = 0; j < 4; ++j) { v[j] = vn[j]; ya[j] = yan[j]; yb[j] = ybn[j]; }
        }
    }
}

constexpr int PH_PER_EVEN = 5 + 8, PH_PER_ODD = 3 + 8;
constexpr int NPHASES = 3 + 2 * (PH_PER_EVEN + PH_PER_ODD);

__global__ void __launch_bounds__(512, 2) mk_fwd(Args Araw) {
    KArgs A0 = kargs();
    extern __shared__ __attribute__((aligned(16))) unsigned char lds_raw[];
    LAS unsigned char* lds = (LAS unsigned char*)lds_raw;
    volatile LAS unsigned* misc = (volatile LAS unsigned*)(lds + LDS_MISC);
    const int tid = threadIdx.x;
    if (tid < 16) misc[tid] = 0u;
    __syncthreads();
    const int lo = A0->ph_lo, hi = A0->ph_hi;
    const int wv_ = __builtin_amdgcn_readfirstlane(threadIdx.x >> 6);
    if (hi - lo > 1) (void)xcd_barrier_post((unsigned*)(A0->ws + WS_CTL) + CW_BAR, misc);
    int ph = 0;
    unsigned long long tacc_ = 0;
#define PH_BEGIN(k) if (ph >= lo && ph < hi) { const bool tprobe_ = (PROBE_TMASK >> (k)) & 1; unsigned long long tp0_ = 0; if (PROBE_TMASK && tprobe_) tp0_ = __builtin_amdgcn_s_memrealtime(); KArgs A = kargs(); unsigned char* ws = opq(A->ws); _Pragma("unroll 1") for (int rep_ = 0; rep_ < (((PROBE_MASK >> (k)) & 1) ? PROBE_REPS : 1); ++rep_)
#define PH_END   if (ph + 1 < hi) { XcdBarrier b_; b_.bar = (unsigned*)(opq(kargs()->ws) + WS_CTL) + CW_BAR; b_.x = xb_xcc_id(); b_.st = misc; xcd_barrier(b_, opaque_tid(wv_) == 0); } if (PROBE_TMASK && tprobe_) tacc_ += __builtin_amdgcn_s_memrealtime() - tp0_; } ++ph;
    const int G = gridDim.x, cb = blockIdx.x;

    PH_BEGIN(0) phase_prologue(A, wv_, lds); PH_END
    PH_BEGIN(1) {
        pg8::DenseOrder S; S.init(NBATCH * NMEM, 8192, D, (const bf16*)(ws + WS_WKV), G, cb);
        pg8::EpiBf16<0> E{(bf16*)(ws + WS_KV), 8192, 32, 0};
        pg8::gemm_phase(lds, (const bf16*)(ws + WS_MN), D, S, E, wv_);
    } PH_END
    PH_BEGIN(2) { phase_knorm(A, wv_); phase_vtrans(A, wv_, lds); } PH_END

    for (int L = 0; L < DEPTH; ++L) {
        const int i = L >> 1;
        if ((L & 1) == 0) {
            PH_BEGIN(3) {
                pg8::DenseOrder S; S.init(T, HYN, D, (const bf16*)(ws + WS_WHYB) + (size_t)i * HYN * D, G, cb);
                pg8::EpiBf16<0> E{(bf16*)(ws + WS_BIG), HYN, 12, 0};
                pg8::gemm_phase(lds, (const bf16*)(ws + WS_XN), D, S, E, wv_);
            } PH_END
            PH_BEGIN(4) { phase_compress_mfma(A, wv_, i, lds); phase_nsa_prep(A, wv_, i, lds); phase_vtiles(A, wv_, lds); } PH_END
            PH_BEGIN(5) { phase_gla_a(A, wv_, i, lds); __syncthreads(); phase_nsa_attn_mfma(A, wv_, i, lds); } PH_END
            PH_BEGIN(6) phase_gla_c(A, wv_, i, lds); PH_END
            PH_BEGIN(7) {
                pg8::DenseOrder S; S.init(T, D, D, (const bf16*)(ws + WS_WHOUT) + (size_t)i * D * D, G, cb);
                pg8::EpiResAdd E{A->out, D};
                pg8::gemm_phase(lds, (const bf16*)(ws + WS_CAT), D, S, E, wv_);
            } PH_END
        } else {
            PH_BEGIN(8) {
                pg8::DenseOrder S; S.init(T, 4096, D, (const bf16*)(ws + WS_WSGIN) + (size_t)i * 4096 * D, G, cb);
                pg8::EpiBf16<1> E{(bf16*)(ws + WS_U), 2048, 8, (size_t)(WS_V - WS_U) / 2};
                pg8::gemm_phase(lds, (const bf16*)(ws + WS_XN), D, S, E, wv_);
            } PH_END
            PH_BEGIN(9) phase_sgu_mix_mfma(A, wv_, i, lds); PH_END
            PH_BEGIN(10) {
                pg8::DenseOrder S; S.init(T, D, 2048, (const bf16*)(ws + WS_WSGOUT) + (size_t)i * D * 2048, G, cb);
                pg8::EpiResAdd E{A->out, D};
                pg8::gemm_phase(lds, (const bf16*)(ws + WS_UM), 2048, S, E, wv_);
            } PH_END
        }
        PH_BEGIN(11) phase_rownorm(A, wv_); PH_END
        PH_BEGIN(12) {
            pg8::DenseOrder S; S.init(T, D, D, (const bf16*)(ws + WS_WQ) + (size_t)L * D * D, G, cb);
            pg8::EpiBf16<0> E{(bf16*)(ws + WS_QX), D, 4, 0};
            pg8::gemm_phase(lds, (const bf16*)(ws + WS_XN), D, S, E, wv_);
        } PH_END
        PH_BEGIN(13) phase_xattn_mfma(A, wv_, L, lds); PH_END
        PH_BEGIN(14) {
            pg8::DenseOrder S; S.init(T, D, D, (const bf16*)(ws + WS_WO) + (size_t)L * D * D, G, cb);
            pg8::EpiResAdd E{A->out, D};
            pg8::gemm_phase(lds, (const bf16*)(ws + WS_OX), D, S, E, wv_);
        } PH_END
        PH_BEGIN(15) phase_route(A, wv_, L, lds); PH_END
        PH_BEGIN(16) {
            LAS int* off = (LAS int*)(lds + pg8::STAGE_BYTES); LAS int* cn = off + 32;
            moe_offsets(A, wv_, L, off, cn);
            pg8::MoeOrder<true> S{(off[16] / 256) * 3, 3, G, cb, D, off, cn, (const int*)(ws + WS_LIST), (const char*)(ws + WS_WMIN) + (size_t)L * 16 * 768 * D * 2, (size_t)768 * D * 2};
            pg8::EpiSwiglu E{(bf16*)(ws + WS_H), DEXP};
            pg8::gemm_phase(lds, (const bf16*)(ws + WS_XN), D, S, E, wv_);
        } PH_END
        PH_BEGIN(17) {
            LAS int* off = (LAS int*)(lds + pg8::STAGE_BYTES); LAS int* cn = off + 32;
            moe_offsets(A, wv_, L, off, cn);
            pg8::MoeOrder<false> S{(off[16] / 256) * 4, 4, G, cb, DEXP, off, cn, (const int*)(ws + WS_LIST), (const char*)(ws + WS_WMOUT) + (size_t)L * 16 * D * DEXP * 2, (size_t)D * DEXP * 2};
            pg8::EpiBf16<0> E{(bf16*)(ws + WS_Y), D, 4, 0};
            pg8::gemm_phase(lds, (const bf16*)(ws + WS_H), DEXP, S, E, wv_);
        } PH_END
        PH_BEGIN(18) phase_moe_combine(A, wv_, L, lds); PH_END
    }
#undef PH_BEGIN
#undef PH_END
    if (PROBE_TMASK && blockIdx.x == 0) { const unsigned long long t0 = __builtin_amdgcn_s_memrealtime(); while (__builtin_amdgcn_s_memrealtime() - t0 < tacc_) __builtin_amdgcn_s_sleep(8); }
}

extern "C" void kernel_launch(void* const* d_in, const int* in_sizes, int n_in, void* d_out, int out_size, void* d_ws, size_t ws_size, hipStream_t stream) {
    static int grid = 0;
    if (grid == 0) {
        if (n_in != N_IN || out_size != T * D || ws_size < WS_END) { fprintf(stderr, "kernel_launch: unexpected problem (n_in %d, out %d, ws %zu)\n", n_in, out_size, ws_size); grid = -1; return; }
        int dev = 0, cus = 0, per_cu = 0;
        if (hipGetDevice(&dev) != hipSuccess || hipDeviceGetAttribute(&cus, hipDeviceAttributeMultiprocessorCount, dev) != hipSuccess) { grid = -1; return; }
        if (hipFuncSetAttribute((const void*)mk_fwd, hipFuncAttributeMaxDynamicSharedMemorySize, LDS_BYTES) != hipSuccess) { fprintf(stderr, "kernel_launch: hipFuncSetAttribute failed\n"); grid = -1; return; }
        if (hipOccupancyMaxActiveBlocksPerMultiprocessor(&per_cu, (const void*)mk_fwd, 512, LDS_BYTES) != hipSuccess || per_cu < 1) fprintf(stderr, "kernel_launch: occupancy query says %d\n", per_cu);
        (void)hipGetLastError();
        grid = cus;
    }
    if (grid < 0) return;
    (void)hipMemsetAsync((char*)d_ws + WS_CTL, 0, CTL_BYTES, stream);
    Args a{};
    for (int i = 0; i < N_IN; ++i) a.in[i] = (const float*)d_in[i];
    a.out = (float*)d_out; a.ws = (unsigned char*)d_ws;
    for (int j = 0; j < 32; ++j) a.freq[j] = (float)pow(10000.0, -(double)j / 32.0);
#if MK_ONE_LAUNCH
    a.ph_lo = 0; a.ph_hi = NPHASES;
    hipLaunchKernelGGL(mk_fwd, dim3(grid), dim3(512), LDS_BYTES, stream, a);
#else
    for (int p = 0; p < NPHASES; ++p) { a.ph_lo = p; a.ph_hi = p + 1; hipLaunchKernelGGL(mk_fwd, dim3(grid), dim3(512), LDS_BYTES, stream, a); }
#endif
}
```

```cpp
#include <hip/hip_runtime.h>
#include <stdint.h>
#include <stdio.h>
#include <math.h>

#ifndef PROBE_MASK
#define PROBE_MASK 0
#endif
#ifndef PROBE_TMASK
#define PROBE_TMASK 0
#endif
#ifndef PROBE_REPS
#define PROBE_REPS 2
#endif
#ifndef MK_ONE_LAUNCH
#define MK_ONE_LAUNCH 1
#endif

#define LAS __attribute__((address_space(3)))
typedef unsigned short bf16;
typedef short bf16x8 __attribute__((ext_vector_type(8)));
typedef float f32x4 __attribute__((ext_vector_type(4)));
typedef float f32x2 __attribute__((ext_vector_type(2)));
typedef unsigned u32x4 __attribute__((ext_vector_type(4)));
typedef unsigned u32x2 __attribute__((ext_vector_type(2)));

constexpr int T = 16384, D = 1024, NBATCH = 8, S = 2048, DEPTH = 4;
constexpr int NMEM = 256;
constexpr float EPS = 1e-6f;
constexpr int HYN = 3072, HYSRC = 2856;
constexpr int C_QA = 0, C_KC = 512, C_VC = 640, C_KS = 768, C_VS = 896, C_KW = 1024, C_VW = 1152, C_QB = 1280, C_KB = 1536, C_VB = 1792, C_RB = 2304, C_GA = 2816, C_AL = 2840;
constexpr int NCMP = 127;
constexpr int NEXP = 16, DEXP = 384;
constexpr int SLOTS = 2 * T + NEXP * 256;

enum { I_X = 0, I_MEM, I_POS, I_NMIX, I_NXAT, I_NMEM, I_NFFN, I_HYBIN, I_HYBOUT, I_QNORM, I_KNORM, I_CMPPE, I_CMPW1, I_CMPW2, I_GATEB, I_WA2, I_BA, I_ONORM,
       I_SGIN, I_LNG, I_LNB, I_SGWS, I_SGBS, I_SGOUT, I_XWQ, I_XWKV, I_XWO, I_XQN, I_XKN, I_RW, I_RB, I_MOEIN, I_MOEOUT, N_IN };

constexpr size_t MiB = 1u << 20;
constexpr size_t WS_CTL = 0, CTL_BYTES = 1 * MiB;
constexpr size_t WS_WHYB = 1 * MiB;
constexpr size_t WS_WHOUT = WS_WHYB + 12 * MiB;
constexpr size_t WS_WSGIN = WS_WHOUT + 4 * MiB;
constexpr size_t WS_WSGOUT = WS_WSGIN + 16 * MiB;
constexpr size_t WS_WQ = WS_WSGOUT + 8 * MiB;
constexpr size_t WS_WKV = WS_WQ + 8 * MiB;
constexpr size_t WS_WO = WS_WKV + 16 * MiB;
constexpr size_t WS_WMIN = WS_WO + 8 * MiB;
constexpr size_t WS_WMOUT = WS_WMIN + 96 * MiB;
constexpr size_t WS_RW = WS_WMOUT + 48 * MiB;
constexpr size_t WS_XN = WS_RW + 1 * MiB;
constexpr size_t WS_BIG = WS_XN + 32 * MiB;
constexpr size_t WS_QA = WS_BIG + 128 * MiB;
constexpr size_t WS_KS = WS_QA + 16 * MiB;
constexpr size_t WS_KW = WS_KS + 4 * MiB;
constexpr size_t WS_KC = WS_KW + 4 * MiB;
constexpr size_t WS_VC = WS_KC + 1 * MiB;
constexpr size_t WS_CAT = WS_VC + 1 * MiB;
constexpr size_t WS_QX = WS_CAT + 32 * MiB;
constexpr size_t WS_OX = WS_QX + 32 * MiB;
constexpr size_t WS_MN = WS_OX + 32 * MiB;
constexpr size_t WS_KV = WS_MN + 4 * MiB;
constexpr size_t WS_COS = WS_KV + 32 * MiB;
constexpr size_t WS_SIN = WS_COS + 2 * MiB;
constexpr size_t WS_LIST = WS_SIN + 2 * MiB;
constexpr size_t WS_TOK = WS_LIST + 1 * MiB;
constexpr size_t WS_VT = WS_TOK + 1 * MiB;
constexpr size_t WS_VTA = WS_VT + 16 * MiB;
constexpr size_t WS_SLOC = WS_VTA + 32 * MiB;
constexpr size_t WS_DEC = WS_SLOC + 32 * MiB;
constexpr size_t WS_STT = WS_DEC + 1 * MiB;
constexpr size_t WS_WSB = WS_STT + 16 * MiB;
constexpr size_t WS_M0 = WS_WSB + 768 * 1024;
constexpr size_t WS_W1T = WS_WSB + 1 * MiB;
constexpr size_t WS_END = WS_W1T + 1 * MiB;
constexpr size_t WS_Y = WS_BIG, WS_H = WS_BIG + 72 * MiB, WS_U = WS_BIG, WS_V = WS_BIG + 64 * MiB, WS_UM = WS_QX;
constexpr int CW_BAR = 4096;
constexpr int CW_CNT = 8192;

constexpr int LDS_BYTES = 159744;
constexpr int LDS_MISC = LDS_BYTES - 64;

__device__ __forceinline__ unsigned f2bf(float f) { unsigned u = __float_as_uint(f); return (u + 0x7fffu + ((u >> 16) & 1u)) >> 16; }
__device__ __forceinline__ float bf2f(unsigned b) { return __uint_as_float(b << 16); }
__device__ __forceinline__ float bflo(unsigned w) { return __uint_as_float(w << 16); }
__device__ __forceinline__ float bfhi(unsigned w) { return __uint_as_float(w & 0xffff0000u); }
__device__ __forceinline__ unsigned pk2(float lo, float hi) { return f2bf(lo) | (f2bf(hi) << 16); }
__device__ __forceinline__ float wave_sum(float v) {
#pragma unroll
    for (int o = 1; o < 64; o <<= 1) v += __shfl_xor(v, o);
    return v;
}
__device__ __forceinline__ float wave_max(float v) {
#pragma unroll
    for (int o = 1; o < 64; o <<= 1) v = fmaxf(v, __shfl_xor(v, o));
    return v;
}
__device__ __forceinline__ int opaque_tid(int wv) { int l; asm volatile("v_mbcnt_lo_u32_b32 %0, -1, 0\n\tv_mbcnt_hi_u32_b32 %0, -1, %0" : "=v"(l)); return wv * 64 + l; }
__device__ __forceinline__ unsigned char* opq(unsigned char* p) { asm volatile("" : "+s"(p)); return p; }
#define LDS_WAIT() asm volatile("s_waitcnt lgkmcnt(0)" ::: "memory")
__device__ __forceinline__ float gelu_tanh(float x) {
    const float u = 0.7978845608028654f * (x + 0.044715f * x * x * x);
    const float e = __expf(-2.0f * fabsf(u));
    float t = (1.0f - e) / (1.0f + e); t = u < 0.f ? -t : t;
    return 0.5f * x * (1.0f + t);
}
__device__ __forceinline__ float sigmoidf_(float x) { return 1.0f / (1.0f + __expf(-x)); }

#define XB_TMO      128
#define XB_XCNT(j)  (256  + 64 * (j))
#define XB_XSUB(j)  (1280 + 64 * (j))
#define XB_XGEN(j)  (2304 + 64 * (j))
#define XB_TOP      3328
#define XB_TOPGEN   3392
#define XCD_BAR_WORDS 3456
#define XB_SPIN_CAP (1u << 22)

__device__ __forceinline__ unsigned xb_ld(unsigned* p)              { return __hip_atomic_load(p, __ATOMIC_RELAXED, __HIP_MEMORY_SCOPE_AGENT); }
__device__ __forceinline__ unsigned xb_add(unsigned* p, unsigned v) { return __hip_atomic_fetch_add(p, v, __ATOMIC_RELAXED, __HIP_MEMORY_SCOPE_AGENT); }
__device__ __forceinline__ unsigned xb_xcc_id() { return (unsigned)__builtin_amdgcn_s_getreg((3 << 11) | 20) & 0xFu; }
#define XB_SPIN(cond, bar) do { unsigned _sp = 0; while (cond) { __builtin_amdgcn_s_sleep(1); \
    if ((++_sp & 255u) == 0u) { if (xb_ld(&(bar)[XB_TMO])) break; if (_sp > XB_SPIN_CAP) { atomicAdd(&(bar)[XB_TMO], 1u); break; } } } } while (0)

struct XcdBarrier { unsigned* bar; unsigned x; volatile LAS unsigned* st; };
__device__ __forceinline__ unsigned* xb_opaque(unsigned* p) { unsigned long long v = (unsigned long long)p; unsigned lo = __builtin_amdgcn_readfirstlane((unsigned)v), hi = __builtin_amdgcn_readfirstlane((unsigned)(v >> 32));
    asm volatile("" : "+s"(lo), "+s"(hi)); return (unsigned*)(((unsigned long long)hi << 32) | lo); }

__device__ __forceinline__ XcdBarrier xcd_barrier_post(unsigned* bar, volatile LAS unsigned* st) {
    XcdBarrier b; b.bar = bar; b.x = xb_xcc_id(); b.st = st;
    if (threadIdx.x == 0) (void)xb_add(&bar[XB_XCNT(b.x)], 1u);
    return b;
}
__device__ __forceinline__ void xcd_barrier_complete(unsigned* bar, unsigned x, unsigned& nloc, unsigned& nx) {
    const unsigned G = gridDim.x * gridDim.y * gridDim.z;
    unsigned sum, cnt, mine, sp = 0u;
    for (;;) {
        sum = 0u; cnt = 0u; mine = 0u;
#pragma unroll
        for (unsigned j = 0; j < 16; ++j) { const unsigned c = xb_ld(&bar[XB_XCNT(j)]); sum += c; cnt += (c > 0u) ? 1u : 0u; mine = (j == x) ? c : mine; }
        if (sum == G) break;
        __builtin_amdgcn_s_sleep(1);
        if ((++sp & 255u) == 0u) { if (xb_ld(&bar[XB_TMO])) break; if (sp > XB_SPIN_CAP) { atomicAdd(&bar[XB_TMO], 1u); break; } }
    }
    nloc = mine > 0u ? mine : 1u; nx = cnt > 0u ? cnt : 1u;
}
__device__ __forceinline__ void xcd_barrier(const XcdBarrier& b, const bool is_t0) {
    asm volatile("s_waitcnt vmcnt(0)" ::: "memory");
    __syncthreads();
    if (is_t0) {
        unsigned* bar = b.bar;
        __builtin_amdgcn_s_waitcnt(0);
        unsigned nloc = b.st[0], nx = b.st[1];
        if (nloc == 0u) { xcd_barrier_complete(bar, b.x, nloc, nx); b.st[0] = nloc; b.st[1] = nx; }
        const unsigned old = xb_add(&bar[XB_XSUB(b.x)], 1u);
        const unsigned gen = old / nloc;
        if (old + 1u == (gen + 1u) * nloc) {
            __builtin_amdgcn_fence(__ATOMIC_RELEASE, "agent");
            asm volatile("s_waitcnt vmcnt(0)" ::: "memory");
            const unsigned og = xb_add(&bar[XB_TOP], 1u);
            const unsigned tg = og / nx;
            if (og + 1u == (tg + 1u) * nx) xb_add(&bar[XB_TOPGEN], 1u);
            else XB_SPIN(xb_ld(&bar[XB_TOPGEN]) == tg, bar);
            __builtin_amdgcn_fence(__ATOMIC_ACQUIRE, "agent");
            xb_add(&bar[XB_XGEN(b.x)], 1u);
            asm volatile("s_waitcnt vmcnt(0)" ::: "memory");
        } else {
            XB_SPIN(xb_ld(&bar[XB_XGEN(b.x)]) == gen, bar);
            __builtin_amdgcn_fence(__ATOMIC_ACQUIRE, "agent");
            asm volatile("s_waitcnt vmcnt(0)" ::: "memory");
        }
    }
    __syncthreads();
}

struct Args {
    const float* in[N_IN];
    float* out;
    unsigned char* ws;
    float freq[32];
    int ph_lo, ph_hi;
};

typedef const __attribute__((address_space(4))) Args* KArgs;
__device__ __forceinline__ KArgs kargs() { KArgs p = (KArgs)__builtin_amdgcn_kernarg_segment_ptr(); asm volatile("" : "+s"(p)); return p; }

__device__ __forceinline__ void st_bf16x4(bf16* p, f32x4 v) { u32x2 w; w.x = pk2(v[0], v[1]); w.y = pk2(v[2], v[3]); *(u32x2*)p = w; }


namespace pg8 {
constexpr int BM = 256, BK = 64, HALF = 128, HTB = HALF * BK * 2, STAGE_BYTES = 8 * HTB, NXCD = 8, WGM = 8;
__host__ __device__ __forceinline__ int lds_byte(int r, int c) { const int st = (r >> 4) * 2 + (c >> 5), rr = r & 15, cc = c & 31, ob = rr * 64 + cc * 2; return st * 1024 + (ob ^ (((ob >> 9) & 1) << 5)); }
__host__ __device__ __forceinline__ void stage_rc(int b, int& R, int& C) { const int st = b / 1024, sb = b % 1024, swz = sb ^ (((sb >> 9) & 1) << 5); R = (st >> 1) * 16 + swz / 64; C = (st & 1) * 32 + (swz % 64) / 2; }
__host__ __device__ __forceinline__ int perm32(int rho) { const int n = rho >> 4, i = rho & 15; return 8 * (i >> 2) + 4 * n + (i & 3); }
struct Unit { int pm, pn, e; };
struct DenseOrder {
    static constexpr bool GATHER = false;
    int nM, nN, nwg, G, c, K; const char* Bt;
    __device__ __forceinline__ void init(int M, int N, int K_, const bf16* Bt_, int G_, int c_) { nM = M / BM; nN = N / BM; nwg = nM * nN; G = G_; c = c_; K = K_; Bt = (const char*)Bt_; }
    __device__ __forceinline__ bool next(int i, Unit& u) const {
        const long L = (long)i * G + c; if (L >= nwg) return false;
        int wgid = (int)L; { const int q = nwg / NXCD, r = nwg % NXCD, xcd = wgid % NXCD, off = wgid / NXCD; wgid = (xcd < r ? xcd * (q + 1) : r * (q + 1) + (xcd - r) * q) + off; }
        const int nig = WGM * nN, gid = wgid / nig, fm = gid * WGM, gsz = (nM - fm) < WGM ? (nM - fm) : WGM;
        u.pm = fm + ((wgid % nig) % gsz); u.pn = (wgid % nig) / gsz; u.e = 0; return true;
    }
    __device__ __forceinline__ unsigned a_voff(const Unit& u, int half, int R) const { return (unsigned)((u.pm * BM + half * HALF + R) * K) * 2u; }
    __device__ __forceinline__ const char* b_tile(const Unit& u) const { return Bt + (size_t)u.pn * BM * K * 2; }
};
template <bool GATH> struct MoeOrder {
    static constexpr bool GATHER = GATH;
    int nunits, ntn, G, c, K; const LAS int* off; const LAS int* cn; const int* list; const char* Bt; size_t estride;
    __device__ __forceinline__ bool next(int i, Unit& u) const {
        const int L = i * G + c; if (L >= nunits) return false;
        u.pm = L / ntn; u.pn = L % ntn; const int s0 = u.pm * BM; int e = 0;
#pragma unroll
        for (int q = 1; q < 16; ++q) e += (s0 >= off[q]) ? 1 : 0;
        u.e = e; return true;
    }
    __device__ __forceinline__ unsigned a_voff(const Unit& u, int half, int R) const {
        const int slot = u.pm * BM + half * HALF + R;
        const int loc = slot - off[u.e]; const int tk = list[u.e * T + (loc < cn[u.e] ? loc : 0)];
        return (unsigned)(tk * K) * 2u;
    }
    __device__ __forceinline__ const char* b_tile(const Unit& u) const { return Bt + (size_t)u.e * estride + (size_t)u.pn * BM * K * 2; }
};
__device__ __forceinline__ unsigned cvt_pk_bf16(float lo, float hi) { unsigned r; asm volatile("v_cvt_pk_bf16_f32 %0, %1, %2" : "=v"(r) : "v"(lo), "v"(hi)); return r; }

template <class Epi, class Sched>
__device__ __forceinline__ void gemm_phase(LAS unsigned char* lds, const bf16* Aptr, int K, const Sched& S, const Epi& E, int wv_) {
    const int tid = opaque_tid(wv_), wid = __builtin_amdgcn_readfirstlane(tid >> 6), lane = tid & 63, wr = wid >> 2, wc = wid & 3, fr = lane & 15, fq = lane >> 4;
    const int nt = K / BK;
    int Rr[2], Cc[2]; unsigned voffA[2], voffB[2];
#pragma unroll
    for (int i = 0; i < 2; ++i) { stage_rc(tid * 16 + i * 8192, Rr[i], Cc[i]); const int Rb = Epi::PERM ? ((Rr[i] & ~31) + perm32(Rr[i] & 31)) : Rr[i];
        voffA[i] = (unsigned)(Rr[i] * K + Cc[i]) * 2u; voffB[i] = (unsigned)(Rb * K + Cc[i]) * 2u; }
    const size_t kstep = (size_t)(BK * 2);
    const size_t hstep = (size_t)HALF * K * 2;
    const size_t tstep = 2 * hstep;
    const unsigned ldsw = (unsigned)wid * 1024u;
    const int aoff = lds_byte(wr * 64 + fr, fq * 8), boff = lds_byte(wc * 32 + fr, fq * 8);
    const char* const Ab = (const char*)Aptr;
#define PG8_SA(b, h) (((b) * 2 + (h)) * HTB)
#define PG8_SB(b, h) ((4 + (b) * 2 + (h)) * HTB)
#define PG8_STAGE(bufoff, gbase, voff) do { _Pragma("unroll") for (int _i = 0; _i < 2; ++_i) \
        __builtin_amdgcn_global_load_lds((const unsigned*)((const char*)(gbase) + (voff)[_i]), (LAS unsigned*)(lds + (bufoff) + ldsw + _i * 8192), 16, 0, 0); } while (0)
#define PG8_STAGE_A(bufoff, usenext, h, kofs) do { \
        if constexpr (Sched::GATHER) { const char* gb_ = Ab + (kofs); unsigned vv_[2] = {(usenext) ? vN[h][0] : vA[h][0], (usenext) ? vN[h][1] : vA[h][1]}; PG8_STAGE(bufoff, gb_, vv_); } \
        else { const char* gb_ = ((usenext) ? nA : cA) + (size_t)(h) * hstep + (kofs); PG8_STAGE(bufoff, gb_, voffA); } } while (0)
#define PG8_LDA(dst, b, h) do { _Pragma("unroll") for (int m = 0; m < 4; ++m) _Pragma("unroll") for (int k = 0; k < 2; ++k) dst[m][k] = *(const LAS bf16x8*)(lds + PG8_SA(b, h) + aoff + m * 2048 + k * 1024); } while (0)
#define PG8_LDB(dst, b, h) do { _Pragma("unroll") for (int n = 0; n < 2; ++n) _Pragma("unroll") for (int k = 0; k < 2; ++k) dst[n][k] = *(const LAS bf16x8*)(lds + PG8_SB(b, h) + boff + n * 2048 + k * 1024); } while (0)
#define PG8_MMA(ai, bj, At, Bt) do { __builtin_amdgcn_s_setprio(1); _Pragma("unroll") for (int m = 0; m < 4; ++m) _Pragma("unroll") for (int n = 0; n < 2; ++n) _Pragma("unroll") for (int k = 0; k < 2; ++k) \
        acc[ai][bj][m][n] = __builtin_amdgcn_mfma_f32_16x16x32_bf16(Bt[n][k], At[m][k], acc[ai][bj][m][n], 0, 0, 0); __builtin_amdgcn_s_setprio(0); } while (0)
#define PG8_WAIT_V(n) asm volatile("s_waitcnt vmcnt(" #n ")" ::: "memory")
#define PG8_WAIT_L(n) asm volatile("s_waitcnt lgkmcnt(" #n ")" ::: "memory")
#define PG8_BAR __builtin_amdgcn_s_barrier()
#define PG8_SCHED __builtin_amdgcn_sched_barrier(0)
    Unit cur, nxt; int ui = 0;
    if (!S.next(0, cur)) return;
    f32x4 acc[2][2][4][2];
#pragma unroll
    for (int a = 0; a < 2; ++a)
#pragma unroll
        for (int b = 0; b < 2; ++b)
#pragma unroll
            for (int m = 0; m < 4; ++m)
#pragma unroll
                for (int n = 0; n < 2; ++n) acc[a][b][m][n] = (f32x4){0.f, 0.f, 0.f, 0.f};
    bf16x8 At[4][2], B0[2][2], B1[2][2];
    unsigned vA[2][2], vN[2][2];
    const char* cA = Ab; const char* nA = Ab;
    if constexpr (Sched::GATHER) {
#pragma unroll
        for (int h = 0; h < 2; ++h)
#pragma unroll
            for (int i = 0; i < 2; ++i) { vA[h][i] = S.a_voff(cur, h, Rr[i]) + (unsigned)Cc[i] * 2u; vN[h][i] = vA[h][i]; }
    } else { cA = Ab + (size_t)cur.pm * tstep; nA = cA; }
    const char* cB = S.b_tile(cur);
    PG8_STAGE(PG8_SB(0, 0), cB, voffB); PG8_STAGE_A(PG8_SA(0, 0), false, 0, 0); PG8_STAGE(PG8_SB(0, 1), cB + hstep, voffB); PG8_STAGE_A(PG8_SA(0, 1), false, 1, 0);
    if (wr == 1) PG8_BAR;
    PG8_WAIT_V(4); PG8_BAR;
    PG8_STAGE(PG8_SB(1, 0), cB + kstep, voffB); PG8_STAGE_A(PG8_SA(1, 0), false, 0, kstep); PG8_STAGE(PG8_SB(1, 1), cB + hstep + kstep, voffB);
    PG8_WAIT_V(6); PG8_BAR;
    for (;;) {
        const bool has_next = S.next(ui + 1, nxt);
        const char* nB = has_next ? S.b_tile(nxt) : cB;
        if constexpr (Sched::GATHER) {
#pragma unroll
            for (int h = 0; h < 2; ++h)
#pragma unroll
                for (int i = 0; i < 2; ++i) vN[h][i] = has_next ? S.a_voff(nxt, h, Rr[i]) + (unsigned)Cc[i] * 2u : vA[h][i];
        } else nA = has_next ? Ab + (size_t)nxt.pm * tstep : cA;
        for (int t = 0; t < nt; t += 2) {
            const bool last = (t == nt - 2);
            const size_t k1 = (size_t)(t + 1) * kstep, k2 = last ? 0 : (size_t)(t + 2) * kstep, k3 = k2 + kstep;
            const char* b2 = last ? nB : cB + (size_t)(t + 2) * kstep; const char* b3 = b2 + kstep;
            PG8_LDB(B0, 0, 0); PG8_SCHED; PG8_LDA(At, 0, 0); PG8_STAGE_A(PG8_SA(1, 1), false, 1, k1);
            PG8_WAIT_L(8); PG8_BAR; PG8_WAIT_L(0); PG8_MMA(0, 0, At, B0); PG8_BAR; PG8_SCHED;
            PG8_LDB(B1, 0, 1); PG8_STAGE(PG8_SB(0, 0), b2, voffB);
            PG8_BAR; PG8_WAIT_L(0); PG8_MMA(0, 1, At, B1); PG8_BAR;
            PG8_LDA(At, 0, 1); PG8_STAGE_A(PG8_SA(0, 0), last, 0, k2);
            PG8_BAR; PG8_WAIT_L(0); PG8_MMA(1, 0, At, B0); PG8_BAR; PG8_SCHED;
            PG8_STAGE(PG8_SB(0, 1), b2 + hstep, voffB);
            PG8_WAIT_V(6); PG8_BAR; PG8_MMA(1, 1, At, B1); PG8_BAR;
            PG8_LDB(B0, 1, 0); PG8_SCHED; PG8_LDA(At, 1, 0); PG8_STAGE_A(PG8_SA(0, 1), last, 1, k2);
            PG8_WAIT_L(8); PG8_BAR; PG8_WAIT_L(0); PG8_MMA(0, 0, At, B0); PG8_BAR; PG8_SCHED;
            PG8_LDB(B1, 1, 1); PG8_STAGE(PG8_SB(1, 0), b3, voffB);
            PG8_BAR; PG8_WAIT_L(0); PG8_MMA(0, 1, At, B1); PG8_BAR;
            PG8_LDA(At, 1, 1); PG8_STAGE_A(PG8_SA(1, 0), last, 0, k3);
            PG8_BAR; PG8_WAIT_L(0); PG8_MMA(1, 0, At, B0); PG8_BAR; PG8_SCHED;
            PG8_STAGE(PG8_SB(1, 1), b3 + hstep, voffB);
            PG8_WAIT_V(6); PG8_BAR; PG8_MMA(1, 1, At, B1); PG8_BAR;
        }
        E(acc, cur, wr, wc, fr, fq);
        if (!has_next) break;
#pragma unroll
        for (int a = 0; a < 2; ++a)
#pragma unroll
            for (int b = 0; b < 2; ++b)
#pragma unroll
                for (int m = 0; m < 4; ++m)
#pragma unroll
                    for (int n = 0; n < 2; ++n) acc[a][b][m][n] = (f32x4){0.f, 0.f, 0.f, 0.f};
        cur = nxt; cB = nB; cA = nA; ++ui;
        if constexpr (Sched::GATHER) {
#pragma unroll
            for (int h = 0; h < 2; ++h)
#pragma unroll
                for (int i = 0; i < 2; ++i) vA[h][i] = vN[h][i];
        }
    }
    PG8_WAIT_V(0);
    if (wr == 0) PG8_BAR;
    PG8_BAR;
#undef PG8_SA
#undef PG8_SB
#undef PG8_STAGE
#undef PG8_STAGE_A
#undef PG8_LDA
#undef PG8_LDB
#undef PG8_MMA
#undef PG8_WAIT_V
#undef PG8_WAIT_L
#undef PG8_BAR
#undef PG8_SCHED
}
template <int ACT> struct EpiBf16 {
    static constexpr bool PERM = true;
    bf16* O; int ldc; int tpt; size_t tstride;
    __device__ __forceinline__ void operator()(const f32x4 (&acc)[2][2][4][2], const Unit& u, int wr, int wc, int fr, int fq) const {
        const int row0 = u.pm * BM + wr * 64 + fr; const int tt = u.pn / tpt; bf16* base = O + (size_t)tt * tstride; const int col0 = (u.pn - tt * tpt) * BM + wc * 32 + 8 * fq;
#pragma unroll
        for (int ai = 0; ai < 2; ++ai)
#pragma unroll
            for (int m = 0; m < 4; ++m) { bf16* rowp = base + (size_t)(row0 + ai * HALF + m * 16) * ldc + col0;
#pragma unroll
                for (int bj = 0; bj < 2; ++bj) { f32x4 v0 = acc[ai][bj][m][0], v1 = acc[ai][bj][m][1];
                    if (ACT == 1) {
#pragma unroll
                        for (int q = 0; q < 4; ++q) { v0[q] = gelu_tanh(v0[q]); v1[q] = gelu_tanh(v1[q]); } }
                    u32x4 w; w.x = cvt_pk_bf16(v0[0], v0[1]); w.y = cvt_pk_bf16(v0[2], v0[3]); w.z = cvt_pk_bf16(v1[0], v1[1]); w.w = cvt_pk_bf16(v1[2], v1[3]);
                    *(u32x4*)(rowp + bj * HALF) = w; } }
    }
};
struct EpiResAdd {
    static constexpr bool PERM = false;
    float* X; int ldc;
    __device__ __forceinline__ void operator()(const f32x4 (&acc)[2][2][4][2], const Unit& u, int wr, int wc, int fr, int fq) const {
        const int row0 = u.pm * BM + wr * 64 + fr, col0 = u.pn * BM + wc * 32 + 4 * fq;
#pragma unroll
        for (int ai = 0; ai < 2; ++ai)
#pragma unroll
            for (int m2 = 0; m2 < 4; m2 += 2) {
                f32x4 x[2][2][2];
#pragma unroll
                for (int mm = 0; mm < 2; ++mm)
#pragma unroll
                    for (int bj = 0; bj < 2; ++bj)
#pragma unroll
                        for (int n = 0; n < 2; ++n) x[mm][bj][n] = *(const f32x4*)(X + (size_t)(row0 + ai * HALF + (m2 + mm) * 16) * ldc + col0 + bj * HALF + n * 16);
#pragma unroll
                for (int mm = 0; mm < 2; ++mm)
#pragma unroll
                    for (int bj = 0; bj < 2; ++bj)
#pragma unroll
                        for (int n = 0; n < 2; ++n) *(f32x4*)(X + (size_t)(row0 + ai * HALF + (m2 + mm) * 16) * ldc + col0 + bj * HALF + n * 16) = x[mm][bj][n] + acc[ai][bj][m2 + mm][n];
            }
    }
};
struct EpiSwiglu {
    static constexpr bool PERM = true;
    bf16* H; int ldc;
    __device__ __forceinline__ void operator()(const f32x4 (&acc)[2][2][4][2], const Unit& u, int wr, int wc, int fr, int fq) const {
        const int row0 = u.pm * BM + wr * 64 + fr, col0 = u.pn * HALF + wc * 32 + 8 * fq;
#pragma unroll
        for (int ai = 0; ai < 2; ++ai)
#pragma unroll
            for (int m = 0; m < 4; ++m) {
                float o[8];
#pragma unroll
                for (int n = 0; n < 2; ++n)
#pragma unroll
                    for (int q = 0; q < 4; ++q) { const float g = acc[ai][0][m][n][q]; o[4 * n + q] = g * sigmoidf_(g) * acc[ai][1][m][n][q]; }
                u32x4 w; w.x = cvt_pk_bf16(o[0], o[1]); w.y = cvt_pk_bf16(o[2], o[3]); w.z = cvt_pk_bf16(o[4], o[5]); w.w = cvt_pk_bf16(o[6], o[7]);
                *(u32x4*)(H + (size_t)(row0 + ai * HALF + m * 16) * ldc + col0) = w; }
    }
};
}

__device__ __forceinline__ int hyb_colmap(int n) {
    if (n < 1280) return n;
    if (n < 1536) return 1304 + (n - 1280);
    if (n < 1792) return 1560 + (n - 1536);
    if (n < 2304) return 1816 + (n - 1792);
    if (n < 2816) return 2344 + (n - 2304);
    if (n < 2840) return 1280 + (n - 2816);
    if (n < 2856) return 2328 + (n - 2840);
    return -1;
}
__device__ __forceinline__ void tr_item(const float* __restrict__ W, int Nsrc, int K, bf16* __restrict__ Wt, const float* __restrict__ gain, int kind, int nblk, LAS float* scr, int item, int lane) {
    const int kb = item / nblk, nb = item % nblk, k0 = 64 * kb, n0 = 64 * nb;
    const int ksub = lane >> 4, n4 = lane & 15, n = n0 + 4 * n4;
    int col;
    if (kind == 0) col = n; else if (kind == 1) col = hyb_colmap(n); else { const int pn = n >> 8, r = n & 255; col = (r >> 7) * 384 + pn * 128 + (r & 127); }
    f32x4 v[16];
#pragma unroll
    for (int i = 0; i < 16; ++i) v[i] = col >= 0 ? *(const f32x4*)(W + (size_t)(k0 + 4 * i + ksub) * Nsrc + col) : (f32x4){0.f, 0.f, 0.f, 0.f};
    if (gain) {
#pragma unroll
        for (int i = 0; i < 16; ++i) v[i] = v[i] * gain[k0 + 4 * i + ksub];
    }
#pragma unroll
    for (int i = 0; i < 16; ++i) { LAS float* d = scr + (4 * i + ksub) * 65 + 4 * n4; d[0] = v[i].x; d[1] = v[i].y; d[2] = v[i].z; d[3] = v[i].w; }
    LDS_WAIT();
    const int c = lane & 7;
#pragma unroll
    for (int jx = 0; jx < 8; ++jx) {
        const int nn = (lane >> 3) + 8 * jx; const LAS float* s = scr + (8 * c) * 65 + nn;
        u32x4 o; o.x = pk2(s[0 * 65], s[1 * 65]); o.y = pk2(s[2 * 65], s[3 * 65]); o.z = pk2(s[4 * 65], s[5 * 65]); o.w = pk2(s[6 * 65], s[7 * 65]);
        *(u32x4*)(Wt + (size_t)(n0 + nn) * K + k0 + 8 * c) = o;
    }
    LDS_WAIT();
}
__device__ __forceinline__ void rms_row_to_bf16(const float* __restrict__ xrow, bf16* __restrict__ orow, float* __restrict__ copy, int lane) {
    const f32x4* xr = (const f32x4*)xrow + lane;
    f32x4 v[4]; float s = 0.f;
#pragma unroll
    for (int j = 0; j < 4; ++j) { v[j] = xr[64 * j]; s += (v[j].x * v[j].x + v[j].y * v[j].y) + (v[j].z * v[j].z + v[j].w * v[j].w); }
    const float rstd = rsqrtf(wave_sum(s) * (1.f / 1024.f) + EPS);
    u32x2* o8 = (u32x2*)orow + lane;
#pragma unroll
    for (int j = 0; j < 4; ++j) { u32x2 w; w.x = pk2(v[j].x * rstd, v[j].y * rstd); w.y = pk2(v[j].z * rstd, v[j].w * rstd); o8[64 * j] = w; }
    if (copy) { f32x4* c4 = (f32x4*)copy + lane;
#pragma unroll
        for (int j = 0; j < 4; ++j) c4[64 * j] = v[j]; }
}

__device__ __forceinline__ void phase_prologue(KArgs A, int wv_, LAS unsigned char* lds) {
    const int tid = opaque_tid(wv_), wid = __builtin_amdgcn_readfirstlane(tid >> 6), lane = tid & 63;
    const int gw = blockIdx.x * 8 + wid, NGW = gridDim.x * 8;
    LAS float* scr = (LAS float*)(lds + wid * 16640);
    unsigned char* ws = opq(A->ws);
    constexpr int N_HYB = 2 * 768, N_HOUT = 2 * 256, N_SGIN = 2 * 1024, N_SGOUT = 2 * 512, N_WQ = 4 * 256, N_WKV = 4 * 512, N_WO = 4 * 256, N_MIN = 64 * 192, N_MOUT = 64 * 96, N_W1T = 4 * 32;
    constexpr int NITEMS = N_HYB + N_HOUT + N_SGIN + N_SGOUT + N_WQ + N_WKV + N_WO + N_MIN + N_MOUT + N_W1T;
    for (int it = gw; it < NITEMS; it += NGW) {
        int r = it;
        if (r < N_HYB) { const int sl = r / 768; tr_item(A->in[I_HYBIN] + (size_t)sl * 1024 * HYSRC, HYSRC, 1024, (bf16*)(ws + WS_WHYB) + (size_t)sl * HYN * 1024, A->in[I_NMIX] + (2 * sl) * 1024, 1, 48, scr, r % 768, lane); continue; } r -= N_HYB;
        if (r < N_HOUT) { const int sl = r / 256; tr_item(A->in[I_HYBOUT] + (size_t)sl * 1024 * 1024, 1024, 1024, (bf16*)(ws + WS_WHOUT) + (size_t)sl * 1024 * 1024, nullptr, 0, 16, scr, r % 256, lane); continue; } r -= N_HOUT;
        if (r < N_SGIN) { const int sl = r / 1024; tr_item(A->in[I_SGIN] + (size_t)sl * 1024 * 4096, 4096, 1024, (bf16*)(ws + WS_WSGIN) + (size_t)sl * 4096 * 1024, A->in[I_NMIX] + (2 * sl + 1) * 1024, 0, 64, scr, r % 1024, lane); continue; } r -= N_SGIN;
        if (r < N_SGOUT) { const int sl = r / 512; tr_item(A->in[I_SGOUT] + (size_t)sl * 2048 * 1024, 1024, 2048, (bf16*)(ws + WS_WSGOUT) + (size_t)sl * 1024 * 2048, nullptr, 0, 16, scr, r % 512, lane); continue; } r -= N_SGOUT;
        if (r < N_WQ) { const int sl = r / 256; tr_item(A->in[I_XWQ] + (size_t)sl * 1024 * 1024, 1024, 1024, (bf16*)(ws + WS_WQ) + (size_t)sl * 1024 * 1024, A->in[I_NXAT] + sl * 1024, 0, 16, scr, r % 256, lane); continue; } r -= N_WQ;
        if (r < N_WKV) { const int sl = r / 512; tr_item(A->in[I_XWKV] + (size_t)sl * 1024 * 2048, 2048, 1024, (bf16*)(ws + WS_WKV) + (size_t)sl * 2048 * 1024, A->in[I_NMEM] + sl * 1024, 0, 32, scr, r % 512, lane); continue; } r -= N_WKV;
        if (r < N_WO) { const int sl = r / 256; tr_item(A->in[I_XWO] + (size_t)sl * 1024 * 1024, 1024, 1024, (bf16*)(ws + WS_WO) + (size_t)sl * 1024 * 1024, nullptr, 0, 16, scr, r % 256, lane); continue; } r -= N_WO;
        if (r < N_MIN) { const int sl = r / 192; tr_item(A->in[I_MOEIN] + (size_t)sl * 1024 * 768, 768, 1024, (bf16*)(ws + WS_WMIN) + (size_t)sl * 768 * 1024, A->in[I_NFFN] + (sl >> 4) * 1024, 2, 12, scr, r % 192, lane); continue; } r -= N_MIN;
        if (r < N_MOUT) { const int sl = r / 96; tr_item(A->in[I_MOEOUT] + (size_t)sl * 384 * 1024, 1024, 384, (bf16*)(ws + WS_WMOUT) + (size_t)sl * 1024 * 384, nullptr, 0, 16, scr, r % 96, lane); continue; } r -= N_MOUT;
        { const int sl = r / 32; tr_item(A->in[I_CMPW1] + (size_t)sl * 2048 * 64, 64, 2048, (bf16*)(ws + WS_W1T) + (size_t)sl * 64 * 2048, nullptr, 0, 1, scr, r % 32, lane); }
    }
    for (int m = gw; m < T; m += NGW) rms_row_to_bf16(A->in[I_X] + (size_t)m * D, (bf16*)(ws + WS_XN) + (size_t)m * D, A->out + (size_t)m * D, lane);
    for (int m = gw; m < NBATCH * NMEM; m += NGW) rms_row_to_bf16(A->in[I_MEM] + (size_t)m * D, (bf16*)(ws + WS_MN) + (size_t)m * D, nullptr, lane);
    const int gt = blockIdx.x * 512 + tid, NGT = gridDim.x * 512;
    const int* pos = (const int*)A->in[I_POS];
    float* cosT = (float*)(ws + WS_COS); float* sinT = (float*)(ws + WS_SIN);
    for (int i = gt; i < T * 32; i += NGT) {
        const int t = i >> 5, j = i & 31;
        const float ang = (float)pos[t] * A->freq[j];
        const double rev = (double)ang * 0.15915494309189533577;
        const float fr = (float)(rev - rint(rev));
        cosT[i] = __builtin_amdgcn_cosf(fr); sinT[i] = __builtin_amdgcn_sinf(fr);
    }
    { bf16* WSB = (bf16*)(ws + WS_WSB); float* M0 = (float*)(ws + WS_M0); const float* wsg = A->in[I_SGWS];
      for (int e = gt; e < 2 * 8 * 128 * 128; e += NGT) { const int s = e & 127, t = (e >> 7) & 127; WSB[e] = (bf16)f2bf(s <= t ? wsg[e] : 0.f); }
      for (int e = gt; e < 2 * 8 * 128; e += NGT) { const int t = e & 127; const float* r = wsg + (size_t)e * 128; float a = 0.f; for (int s = 0; s <= t; ++s) a += r[s]; M0[e] = a; } }
    float* RW = (float*)(ws + WS_RW);
    for (int i = gt; i < DEPTH * NEXP * D; i += NGT) { const int k = i & 1023, e = (i >> 10) & 15, l = i >> 14; RW[i] = A->in[I_RW][k * NEXP + e] * A->in[I_NFFN][l * D + k]; }
}

__device__ __forceinline__ void phase_knorm(KArgs A, int wv_) {
    const int tid_ = opaque_tid(wv_); const int wid = __builtin_amdgcn_readfirstlane(tid_ >> 6), lane = tid_ & 63; const int gw = blockIdx.x * 8 + wid, NGW = gridDim.x * 8;
    bf16* KV = (bf16*)(opq(A->ws) + WS_KV);
    for (int it = gw; it < DEPTH * 2048 * 4; it += NGW) {
        const int h = it & 3, m = (it >> 2) & 2047, l = it >> 13;
        bf16* p = KV + (size_t)m * 8192 + l * 2048 + h * 256 + 4 * lane;
        const u32x2 w = *(const u32x2*)p;
        float x0 = bflo(w.x), x1 = bfhi(w.x), x2 = bflo(w.y), x3 = bfhi(w.y);
        const float rstd = rsqrtf(wave_sum(x0 * x0 + x1 * x1 + x2 * x2 + x3 * x3) * (1.f / 256.f) + EPS) * 0.0625f;
        const f32x4 g = *(const f32x4*)(A->in[I_XKN] + l * 256 + 4 * lane);
        u32x2 o; o.x = pk2(x0 * rstd * g.x, x1 * rstd * g.y); o.y = pk2(x2 * rstd * g.z, x3 * rstd * g.w);
        *(u32x2*)p = o;
    }
}

__device__ __forceinline__ int kpos64(int tok) { const int k = tok & 31; return (tok & 32) + 8 * ((k >> 2) & 3) + 4 * (k >> 4) + (k & 3); }
__device__ __forceinline__ int kperm64(int p) { const int fq = (p >> 3) & 3, j = p & 7; return (p & 32) + 16 * (j >> 2) + 4 * fq + (j & 3); }

__device__ __forceinline__ void phase_nsa_prep(KArgs A, int wv_, int i, LAS unsigned char* lds) {
    const int tid_ = opaque_tid(wv_); const int wid = __builtin_amdgcn_readfirstlane(tid_ >> 6), lane = tid_ & 63; const int gw = blockIdx.x * 8 + wid, NGW = gridDim.x * 8;
    unsigned char* ws = opq(A->ws);
    const bf16* HY = (const bf16*)(ws + WS_BIG);
    const float* cosT = (const float*)(ws + WS_COS); const float* sinT = (const float*)(ws + WS_SIN);
    bf16* QA = (bf16*)(ws + WS_QA); bf16* KS = (bf16*)(ws + WS_KS); bf16* KW = (bf16*)(ws + WS_KW);
    LAS float* abuf = (LAS float*)(lds + wid * 8192);
    const int NIT = T;
    for (int it = gw; it < NIT; it += NGW) {
        if (it < T) {
            const int t = it;
            const float c = cosT[t * 32 + (lane & 31)], s = sinT[t * 32 + (lane & 31)];
            float xin[12];
#pragma unroll
            for (int u = 0; u < 12; ++u) xin[u] = bf2f(HY[(size_t)t * HYN + (u < 8 ? C_QA + 64 * u : (u < 10 ? C_KS + 64 * (u - 8) : C_KW + 64 * (u - 10))) + lane]);
#pragma unroll
            for (int u = 0; u < 12; ++u) {
                int src; const float* gain; bf16* dst; float scale;
                if (u < 8) { src = C_QA + 64 * u; gain = A->in[I_QNORM] + i * 64; dst = QA + (size_t)t * 512 + 64 * u; scale = 0.125f; }
                else if (u < 10) { src = C_KS + 64 * (u - 8); gain = A->in[I_KNORM] + (i * 3 + 1) * 64; dst = KS + (size_t)t * 128 + 64 * (u - 8); scale = 1.f; }
                else { src = C_KW + 64 * (u - 10); gain = A->in[I_KNORM] + (i * 3 + 2) * 64; dst = KW + (size_t)t * 128 + 64 * (u - 10); scale = 1.f; }
                const float x = xin[u]; (void)src;
                const float y = x * rsqrtf(wave_sum(x * x) * (1.f / 64.f) + EPS) * gain[lane] * scale;
                const float pr = __shfl_xor(y, 32);
                const float o = lane < 32 ? y * c - pr * s : y * c + pr * s;
                dst[lane] = (bf16)f2bf(o);
            }
        }
    }
}


__device__ __forceinline__ void phase_compress_mfma(KArgs A, int wv_, int i, LAS unsigned char* lds) {
    const int tid = opaque_tid(wv_), wid = __builtin_amdgcn_readfirstlane(tid >> 6), lane = tid & 63, fr = lane & 15, fq = lane >> 4;
    unsigned char* ws = opq(A->ws);
    const bf16* HY = (const bf16*)(ws + WS_BIG);
    const float* cosT = (const float*)(ws + WS_COS); const float* sinT = (const float*)(ws + WS_SIN);
    LAS float* part = (LAS float*)lds;
    LAS float* hbuf = part + 8 * 1024;
    LAS float* obuf = hbuf + 1024;
    for (int it = blockIdx.x; it < 2 * 127; it += gridDim.x) {
        const int kv = it / 127, tile = it % 127;
        const float* pe = A->in[I_CMPPE] + (size_t)(i * 2 + kv) * 32 * 64;
        const float* w2 = A->in[I_CMPW2] + (size_t)(i * 2 + kv) * 64 * 64;
        const bf16* w1t = (const bf16*)(ws + WS_W1T) + (size_t)(i * 2 + kv) * 64 * 2048;
        const int coff = kv ? C_VC : C_KC;
        {
            const int R = tile * 16 + fr, g = R & 1, bn = R >> 1, n = bn % NCMP, b = bn / NCMP;
            const bf16* arow = HY + (size_t)(b * S + 16 * n) * HYN + coff + g * 64;
            f32x4 acc[4];
#pragma unroll
            for (int t = 0; t < 4; ++t) acc[t] = (f32x4){0.f, 0.f, 0.f, 0.f};
#pragma unroll 2
            for (int s = 0; s < 8; ++s) {
                const int k0 = 256 * wid + 32 * s, l = k0 >> 6, d0 = (k0 & 63) + 8 * fq;
                const u32x4 hw = *(const u32x4*)(arow + (size_t)l * HYN + d0);
                const f32x4 p0 = *(const f32x4*)(pe + l * 64 + d0), p1 = *(const f32x4*)(pe + l * 64 + d0 + 4);
                u32x4 aw; aw.x = pk2(bflo(hw.x) + p0.x, bfhi(hw.x) + p0.y); aw.y = pk2(bflo(hw.y) + p0.z, bfhi(hw.y) + p0.w); aw.z = pk2(bflo(hw.z) + p1.x, bfhi(hw.z) + p1.y); aw.w = pk2(bflo(hw.w) + p1.z, bfhi(hw.w) + p1.w);
                const bf16x8 af = __builtin_bit_cast(bf16x8, aw);
#pragma unroll
                for (int t = 0; t < 4; ++t) { const bf16x8 bfr = *(const bf16x8*)(w1t + (size_t)(16 * t + fr) * 2048 + k0 + 8 * fq);
                    acc[t] = __builtin_amdgcn_mfma_f32_16x16x32_bf16(af, bfr, acc[t], 0, 0, 0); }
            }
            __syncthreads();
#pragma unroll
            for (int t = 0; t < 4; ++t)
#pragma unroll
                for (int r = 0; r < 4; ++r) part[wid * 1024 + (4 * fq + r) * 64 + 16 * t + fr] = acc[t][r];
        }
        __syncthreads();
        for (int e = tid; e < 1024; e += 512) { float a = 0.f;
#pragma unroll
            for (int w = 0; w < 8; ++w) a += part[w * 1024 + e];
            hbuf[e] = gelu_tanh(a); }
        __syncthreads();
        for (int e = tid; e < 1024; e += 512) { const int r = e >> 6, j = e & 63; float o = 0.f;
#pragma unroll 8
            for (int m = 0; m < 64; ++m) o += hbuf[r * 64 + m] * w2[m * 64 + j];
            obuf[e] = o; }
        __syncthreads();
        for (int r = wid; r < 16; r += 8) {
            const int R = tile * 16 + r, g = R & 1, bn = R >> 1, n = bn % NCMP, b = bn / NCMP;
            const float o = obuf[r * 64 + lane];
            if (kv == 0) {
                const float y = o * rsqrtf(wave_sum(o * o) * (1.f / 64.f) + EPS) * A->in[I_KNORM][(i * 3 + 0) * 64 + lane];
                const int tp = b * S + 16 * n + 31;
                const float c = cosT[tp * 32 + (lane & 31)], sn = sinT[tp * 32 + (lane & 31)];
                const float pr = __shfl_xor(y, 32);
                const float oo = lane < 32 ? y * c - pr * sn : y * c + pr * sn;
                ((bf16*)(ws + WS_KC))[((size_t)(b * 128 + n) * 2 + g) * 64 + lane] = (bf16)f2bf(oo);
            } else {
                bf16* vct = (bf16*)(ws + WS_VC) + ((size_t)(b * 2 + g) * 64 + lane) * 128;
                vct[(n & 64) + kpos64(n & 63)] = (bf16)f2bf(o);
                if (n == 126) vct[127] = 0;
            }
        }
    }
    __syncthreads();
}

__device__ __forceinline__ void nsa_block(const LAS float* qs, const bf16* __restrict__ krow, bool ok, const bf16* __restrict__ vbase, int vstride, int lane,
                                          float (&m)[4], float (&l)[4], float (&o)[4]) {
    float s[4] = {0.f, 0.f, 0.f, 0.f};
#pragma unroll 2
    for (int c = 0; c < 8; ++c) {
        const u32x4 kw = *(const u32x4*)(krow + 8 * c);
        const float k0 = bflo(kw.x), k1 = bfhi(kw.x), k2 = bflo(kw.y), k3 = bfhi(kw.y), k4 = bflo(kw.z), k5 = bfhi(kw.z), k6 = bflo(kw.w), k7 = bfhi(kw.w);
#pragma unroll
        for (int hh = 0; hh < 4; ++hh) {
            const f32x4 qa = *(const LAS f32x4*)(qs + hh * 64 + 8 * c), qb = *(const LAS f32x4*)(qs + hh * 64 + 8 * c + 4);
            s[hh] += (qa.x * k0 + qa.y * k1) + (qa.z * k2 + qa.w * k3) + (qb.x * k4 + qb.y * k5) + (qb.z * k6 + qb.w * k7);
        }
    }
    float p[4];
#pragma unroll
    for (int hh = 0; hh < 4; ++hh) {
        const float sv = ok ? s[hh] : -INFINITY;
        const float bm = wave_max(sv);
        const float mn = fmaxf(m[hh], bm);
        if (mn == -INFINITY) { p[hh] = 0.f; continue; }
        const float alpha = __expf(m[hh] - mn);
        p[hh] = ok ? __expf(sv - mn) : 0.f;
        l[hh] = l[hh] * alpha + wave_sum(p[hh]);
        o[hh] *= alpha; m[hh] = mn;
    }
#pragma unroll 8
    for (int kk = 0; kk < 64; ++kk) {
        const float v = bf2f(vbase[(size_t)kk * vstride + lane]);
#pragma unroll
        for (int hh = 0; hh < 4; ++hh) o[hh] += __shfl(p[hh], kk) * v;
    }
}
__device__ __forceinline__ void phase_nsa_attn(KArgs A, int wv_, int i, LAS unsigned char* lds) {
    const int tid_ = opaque_tid(wv_); const int wid = __builtin_amdgcn_readfirstlane(tid_ >> 6), lane0 = tid_ & 63; const int gw = blockIdx.x * 8 + wid, NGW = gridDim.x * 8;
    unsigned char* ws = opq(A->ws);
    const bf16* HY = (const bf16*)(ws + WS_BIG); const bf16* QA = (const bf16*)(ws + WS_QA); const bf16* KS = (const bf16*)(ws + WS_KS); const bf16* KW = (const bf16*)(ws + WS_KW);
    const bf16* KC = (const bf16*)(ws + WS_KC); const bf16* VC = (const bf16*)(ws + WS_VC); bf16* CAT = (bf16*)(ws + WS_CAT);
    LAS float* qs = (LAS float*)(lds + wid * 2048);
    LAS float* ps = qs + 256;
    for (int it = gw; it < 2 * T; it += NGW) {
        int lane = lane0; asm volatile("" : "+v"(lane));
        const int tok = it >> 1, g = it & 1, b = tok >> 11, t = tok & 2047;
#pragma unroll
        for (int hh = 0; hh < 4; ++hh) qs[hh * 64 + lane] = bf2f(QA[(size_t)tok * 512 + (g * 4 + hh) * 64 + lane]);
        LDS_WAIT();
        const int ncv = t >= 31 ? ((t - 31) >> 4) + 1 : 0;
        float oc[4] = {0.f, 0.f, 0.f, 0.f};
        float psum0 = 0.f, psum1 = 0.f;
        {
            const bool v0 = lane < ncv, v1 = lane + 64 < ncv;
            const bf16* k0p = KC + ((size_t)(b * 128 + lane) * 2 + g) * 64;
            const bf16* k1p = KC + ((size_t)(b * 128 + (lane + 64 < 127 ? lane + 64 : 126)) * 2 + g) * 64;
            float s0[4] = {0.f, 0.f, 0.f, 0.f}, s1[4] = {0.f, 0.f, 0.f, 0.f};
#pragma unroll 2
            for (int c = 0; c < 8; ++c) {
                const u32x4 ka = *(const u32x4*)(k0p + 8 * c), kb = *(const u32x4*)(k1p + 8 * c);
#pragma unroll
                for (int hh = 0; hh < 4; ++hh) {
                    const f32x4 qa = *(const LAS f32x4*)(qs + hh * 64 + 8 * c), qb = *(const LAS f32x4*)(qs + hh * 64 + 8 * c + 4);
                    s0[hh] += (qa.x * bflo(ka.x) + qa.y * bfhi(ka.x)) + (qa.z * bflo(ka.y) + qa.w * bfhi(ka.y)) + (qb.x * bflo(ka.z) + qb.y * bfhi(ka.z)) + (qb.z * bflo(ka.w) + qb.w * bfhi(ka.w));
                    s1[hh] += (qa.x * bflo(kb.x) + qa.y * bfhi(kb.x)) + (qa.z * bflo(kb.y) + qa.w * bfhi(kb.y)) + (qb.x * bflo(kb.z) + qb.y * bfhi(kb.z)) + (qb.z * bflo(kb.w) + qb.w * bfhi(kb.w));
                }
            }
            float p0[4], p1[4];
#pragma unroll
            for (int hh = 0; hh < 4; ++hh) {
                const float a0 = v0 ? s0[hh] : -INFINITY, a1 = v1 ? s1[hh] : -INFINITY;
                const float mx = wave_max(fmaxf(a0, a1));
                if (ncv > 0) {
                    const float e0 = v0 ? __expf(a0 - mx) : 0.f, e1 = v1 ? __expf(a1 - mx) : 0.f;
                    const float inv = 1.0f / wave_sum(e0 + e1);
                    p0[hh] = e0 * inv; p1[hh] = e1 * inv;
                } else { p0[hh] = 0.f; p1[hh] = 0.f; }
                psum0 += p0[hh]; psum1 += p1[hh];
            }
#pragma unroll 2
            for (int c = 0; c < ncv; ++c) {
                const float v = bf2f(VC[((size_t)(b * 128 + c) * 2 + g) * 64 + lane]);
#pragma unroll
                for (int hh = 0; hh < 4; ++hh) oc[hh] += __shfl(c < 64 ? p0[hh] : p1[hh], c & 63) * v;
            }
        }
        ps[lane] = psum0; ps[64 + lane] = psum1;
        LDS_WAIT();
        const int cur = t >> 6;
        unsigned selmask;
        {
            const int j = lane & 31;
            float imp = ps[4 * j] + ps[4 * j + 1] + ps[4 * j + 2] + 0.5f * ps[4 * j + 3] + (j > 0 ? 0.5f * ps[4 * j - 1] : 0.f);
            const bool valid = j <= cur, forced = (j == 0) || (j == cur) || (j == cur - 1);
            const float score = valid ? imp + (forced ? 1000.0f : 0.f) : -INFINITY;
            int rank = 0;
#pragma unroll 8
            for (int jj = 0; jj < 32; ++jj) { const float sj = __shfl(score, jj); rank += (sj > score || (sj == score && jj < j)) ? 1 : 0; }
            const bool sel = valid && rank < 8 && lane < 32;
            selmask = (unsigned)__ballot(sel);
        }
        LDS_WAIT();
        float o1[4] = {0.f, 0.f, 0.f, 0.f}, o2[4] = {0.f, 0.f, 0.f, 0.f};
#pragma unroll 1
        for (int pass = 0; pass < 2; ++pass) {
            float oa[4] = {0.f, 0.f, 0.f, 0.f}, ma[4] = {-INFINITY, -INFINITY, -INFINITY, -INFINITY}, la[4] = {0.f, 0.f, 0.f, 0.f};
            const int lo = pass ? (t - 255 > 0 ? t - 255 : 0) : 0;
            const unsigned bm = pass ? 0xffffffffu : selmask;
            const bf16* Kb = pass ? KW : KS; const int vc = pass ? C_VW : C_VS;
#pragma unroll 1
            for (int j = lo >> 6; j <= cur; ++j) {
                if (!((bm >> j) & 1u)) continue;
                const int key = 64 * j + lane; const size_t kt = (size_t)(b * S + key);
                nsa_block(qs, Kb + kt * 128 + g * 64, key <= t && key >= lo, HY + (size_t)(b * S + 64 * j) * HYN + vc + g * 64, HYN, lane, ma, la, oa);
            }
            if (pass == 0) {
#pragma unroll
                for (int hh = 0; hh < 4; ++hh) o1[hh] = oa[hh] / la[hh];
            } else {
#pragma unroll
                for (int hh = 0; hh < 4; ++hh) o2[hh] = oa[hh] / la[hh];
            }
        }
#pragma unroll
        for (int hh = 0; hh < 4; ++hh) {
            const int head = g * 4 + hh;
            const float* gb = A->in[I_GATEB] + i * 24 + head * 3;
            const bf16* gl = HY + (size_t)tok * HYN + C_GA + head * 3;
            const float g0 = sigmoidf_(bf2f(gl[0]) + gb[0]), g1 = sigmoidf_(bf2f(gl[1]) + gb[1]), g2 = sigmoidf_(bf2f(gl[2]) + gb[2]);
            const float o = g0 * oc[hh] + g1 * o1[hh] + g2 * o2[hh];
            CAT[(size_t)tok * 1024 + head * 64 + lane] = (bf16)f2bf(o);
        }
    }
}

__device__ __forceinline__ void phase_gla_seq(KArgs A, int wv_, int i, LAS unsigned char* lds) {
    const int tid = opaque_tid(wv_), wid = __builtin_amdgcn_readfirstlane(tid >> 6), lane = tid & 63;
    unsigned char* ws = opq(A->ws);
    const bf16* HY = (const bf16*)(ws + WS_BIG); bf16* CAT = (bf16*)(ws + WS_CAT);
    constexpr int CH = 16;
    LAS float* la = (LAS float*)lds;
    LAS float* lk = la + 4 * CH * 64;
    LAS float* lq = lk + 4 * CH * 64;
    LAS float* lo = lq + 4 * CH * 64;
    const float* wa2 = A->in[I_WA2] + i * 16 * 256; const float* ba = A->in[I_BA] + i * 256; const float* og = A->in[I_ONORM] + i * 128;
    for (int it = blockIdx.x; it < 8; it += gridDim.x) {
        const int pl = tid >> 7, v = tid & 127, p = it * 4 + pl, b = p >> 2, h = p & 3;
        float St[64];
#pragma unroll
        for (int k = 0; k < 64; ++k) St[k] = 0.f;
        for (int c0 = 0; c0 < S; c0 += CH) {
            __syncthreads();
            for (int e = tid; e < 4 * CH * 64; e += 512) {
                const int kk = e & 63, tk = (e >> 6) % CH, pp = e / (64 * CH); const int pb = (it * 4 + pp) >> 2, ph = (it * 4 + pp) & 3;
                const size_t tok = (size_t)pb * S + c0 + tk; const bf16* row = HY + tok * HYN;
                float z = ba[ph * 64 + kk];
#pragma unroll
                for (int r = 0; r < 16; ++r) z += bf2f(row[C_AL + r]) * wa2[r * 256 + ph * 64 + kk];
                const float ls_ = fminf(z, 0.f) - log1pf(__expf(-fabsf(z)));
                la[e] = __expf(ls_ * (1.f / 16.f));
                lk[e] = bf2f(row[C_KB + ph * 64 + kk]);
                lq[e] = bf2f(row[C_QB + ph * 64 + kk]) * 0.125f;
            }
            __syncthreads();
            for (int tk = 0; tk < CH; ++tk) {
                const size_t tok = (size_t)b * S + c0 + tk;
                const float vv = bf2f(HY[tok * HYN + C_VB + h * 128 + v]);
                const LAS float* pa = la + (pl * CH + tk) * 64; const LAS float* pk = lk + (pl * CH + tk) * 64; const LAS float* pq = lq + (pl * CH + tk) * 64;
                float o = 0.f;
#pragma unroll
                for (int k4 = 0; k4 < 16; ++k4) {
                    const f32x4 a4 = *(const LAS f32x4*)(pa + 4 * k4), k4v = *(const LAS f32x4*)(pk + 4 * k4), q4 = *(const LAS f32x4*)(pq + 4 * k4);
                    St[4 * k4 + 0] = a4.x * St[4 * k4 + 0] + k4v.x * vv; o += q4.x * St[4 * k4 + 0];
                    St[4 * k4 + 1] = a4.y * St[4 * k4 + 1] + k4v.y * vv; o += q4.y * St[4 * k4 + 1];
                    St[4 * k4 + 2] = a4.z * St[4 * k4 + 2] + k4v.z * vv; o += q4.z * St[4 * k4 + 2];
                    St[4 * k4 + 3] = a4.w * St[4 * k4 + 3] + k4v.w * vv; o += q4.w * St[4 * k4 + 3];
                }
                lo[(pl * CH + tk) * 128 + v] = o;
            }
            __syncthreads();
            for (int r = wid; r < 4 * CH; r += 8) {
                const int pp = r / CH, tk = r % CH; const int pb = (it * 4 + pp) >> 2, ph = (it * 4 + pp) & 3;
                const size_t tok = (size_t)pb * S + c0 + tk;
                const float x0 = lo[r * 128 + lane], x1 = lo[r * 128 + 64 + lane];
                const float rstd = rsqrtf(wave_sum(x0 * x0 + x1 * x1) * (1.f / 128.f) + EPS);
                const float r0 = bf2f(HY[tok * HYN + C_RB + ph * 128 + lane]), r1 = bf2f(HY[tok * HYN + C_RB + ph * 128 + 64 + lane]);
                CAT[tok * 1024 + 512 + ph * 128 + lane] = (bf16)f2bf(x0 * rstd * og[lane] * (r0 * sigmoidf_(r0)));
                CAT[tok * 1024 + 512 + ph * 128 + 64 + lane] = (bf16)f2bf(x1 * rstd * og[64 + lane] * (r1 * sigmoidf_(r1)));
            }
        }
        __syncthreads();
    }
}


__device__ __forceinline__ void phase_nsa_attn_mfma(KArgs A, int wv_, int i, LAS unsigned char* lds) {
    const int tid = opaque_tid(wv_), wid = __builtin_amdgcn_readfirstlane(tid >> 6), lane = tid & 63, fr = lane & 15, fq = lane >> 4;
    unsigned char* ws = opq(A->ws);
    const bf16* HY = (const bf16*)(ws + WS_BIG); const bf16* QA = (const bf16*)(ws + WS_QA); const bf16* KS = (const bf16*)(ws + WS_KS); const bf16* KW = (const bf16*)(ws + WS_KW);
    const bf16* KC = (const bf16*)(ws + WS_KC); const bf16* VCT = (const bf16*)(ws + WS_VC); const bf16* VTA = (const bf16*)(ws + WS_VTA); bf16* CAT = (bf16*)(ws + WS_CAT);
    constexpr int RS = 72;
    LAS bf16* ktl = (LAS bf16*)lds;
    LAS bf16* vtl = ktl + 2 * 64 * RS;
    LAS float* scl = (LAS float*)(lds + 36864) + wid * 256;
    LAS unsigned* msk = (LAS unsigned*)(lds + 36864 + 8192);
    LAS unsigned* umask = msk + 64;
    const float* gb = A->in[I_GATEB] + i * 24;
    for (int pit = blockIdx.x; pit < 256; pit += gridDim.x) {
#pragma unroll 1
        for (int hf = 0; hf < 2; ++hf) {
            const int bg = pit >> 4, xx = pit & 15, x = hf ? 31 - xx : xx, b = bg >> 1, g = bg & 1;
            const size_t tokbase = (size_t)b * S + 64 * x;
            const int tl0 = 8 * wid + (fr >> 2);
            if (tid == 0) *umask = 0u;
            bf16x8 qf[2][2];
#pragma unroll
            for (int mt = 0; mt < 2; ++mt)
#pragma unroll
                for (int s = 0; s < 2; ++s) qf[mt][s] = *(const bf16x8*)(QA + (tokbase + tl0 + 4 * mt) * 512 + (g * 4 + (fr & 3)) * 64 + 32 * s + 8 * fq);
            f32x4 outacc[2][4];
            {
                const int tmaxc = (4 * x + 3 + 15) >> 4;
                const bf16* kcb = KC + ((size_t)(b * 128 + fr) * 2 + g) * 64 + 8 * fq;
                bf16x8 pcf[2][4];
#pragma unroll
                for (int mt = 0; mt < 2; ++mt) {
                    f32x4 sc[8];
                    const bf16* kp = kcb;
#pragma unroll
                    for (int t = 0; t < 8; ++t) { sc[t] = (f32x4){0.f, 0.f, 0.f, 0.f};
                        asm volatile("" : "+v"(kp));
                        if (t < tmaxc) {
                            const bf16x8 k0 = *(const bf16x8*)(kp), k1 = *(const bf16x8*)(kp + 32);
                            sc[t] = __builtin_amdgcn_mfma_f32_16x16x32_bf16(k0, qf[mt][0], sc[t], 0, 0, 0);
                            sc[t] = __builtin_amdgcn_mfma_f32_16x16x32_bf16(k1, qf[mt][1], sc[t], 0, 0, 0); }
                        kp += 16 * 128; }
                    const int tg = 64 * x + tl0 + 4 * mt; const int ncv = tg >= 31 ? ((tg - 31) >> 4) + 1 : 0;
                    float mx = -INFINITY;
#pragma unroll
                    for (int t = 0; t < 8; ++t)
#pragma unroll
                        for (int r = 0; r < 4; ++r) { const bool v = 16 * t + 4 * fq + r < ncv; sc[t][r] = v ? sc[t][r] : -INFINITY; mx = fmaxf(mx, sc[t][r]); }
                    mx = fmaxf(mx, __shfl_xor(mx, 16)); mx = fmaxf(mx, __shfl_xor(mx, 32));
                    const float mxs = mx == -INFINITY ? 0.f : mx;
                    float sum = 0.f;
#pragma unroll
                    for (int t = 0; t < 8; ++t)
#pragma unroll
                        for (int r = 0; r < 4; ++r) { sc[t][r] = __expf(sc[t][r] - mxs); sum += sc[t][r]; }
                    sum += __shfl_xor(sum, 16); sum += __shfl_xor(sum, 32);
                    const float inv = sum > 0.f ? 1.f / sum : 0.f;
#pragma unroll
                    for (int t = 0; t < 8; ++t) sc[t] = sc[t] * inv;
#pragma unroll
                    for (int s = 0; s < 4; ++s) { u32x4 w; w.x = pk2(sc[2 * s].x, sc[2 * s].y); w.y = pk2(sc[2 * s].z, sc[2 * s].w); w.z = pk2(sc[2 * s + 1].x, sc[2 * s + 1].y); w.w = pk2(sc[2 * s + 1].z, sc[2 * s + 1].w);
                        pcf[mt][s] = __builtin_bit_cast(bf16x8, w); }
                    float w3[8];
#pragma unroll
                    for (int t = 0; t < 8; ++t) {
#pragma unroll
                        for (int r = 0; r < 4; ++r) { float v = sc[t][r]; v += __shfl_xor(v, 1); v += __shfl_xor(v, 2); sc[t][r] = v; }
                        w3[t] = __shfl(sc[t].w, (lane + 48) & 63);
                    }
#pragma unroll
                    for (int t = 0; t < 8; ++t) {
                        const float prev = fq > 0 ? w3[t] : (t > 0 ? w3[t > 0 ? t - 1 : 0] : 0.f);
                        const float imp = sc[t].x + sc[t].y + sc[t].z + 0.5f * sc[t].w + 0.5f * prev;
                        if ((fr & 3) == 0) scl[(4 * mt + (fr >> 2)) * 32 + 4 * t + fq] = imp;
                    }
                    asm volatile("" ::: "memory");
                }
                const bf16* vcb = VCT + ((size_t)(b * 2 + g) * 64 + fr) * 128 + 8 * fq;
#pragma unroll
                for (int n = 0; n < 4; ++n) {
                    outacc[0][n] = (f32x4){0.f, 0.f, 0.f, 0.f}; outacc[1][n] = (f32x4){0.f, 0.f, 0.f, 0.f};
                    asm volatile("" : "+v"(vcb));
#pragma unroll
                    for (int s = 0; s < 4; ++s) if (2 * s < tmaxc) {
                        const bf16x8 vf = *(const bf16x8*)(vcb + 32 * s);
                        outacc[0][n] = __builtin_amdgcn_mfma_f32_16x16x32_bf16(vf, pcf[0][s], outacc[0][n], 0, 0, 0);
                        outacc[1][n] = __builtin_amdgcn_mfma_f32_16x16x32_bf16(vf, pcf[1][s], outacc[1][n], 0, 0, 0); }
                    vcb += 16 * 128;
                    asm volatile("" ::: "memory");
                }
            }
            float g1v[2], g2v[2];
#pragma unroll
            for (int mt = 0; mt < 2; ++mt) {
                const int head = g * 4 + (fr & 3);
                const bf16* gl = HY + (tokbase + tl0 + 4 * mt) * HYN + C_GA + head * 3;
                const float g0 = sigmoidf_(bf2f(gl[0]) + gb[head * 3 + 0]);
                g1v[mt] = sigmoidf_(bf2f(gl[1]) + gb[head * 3 + 1]); g2v[mt] = sigmoidf_(bf2f(gl[2]) + gb[head * 3 + 2]);
#pragma unroll
                for (int n = 0; n < 4; ++n) outacc[mt][n] = outacc[mt][n] * g0;
            }
            LDS_WAIT();
            asm volatile("" ::: "memory");
            {
                const int tok8 = lane >> 3, jg = lane & 7;
                float sj[32];
#pragma unroll
                for (int q = 0; q < 8; ++q) { const f32x4 v = *(const LAS f32x4*)(scl + tok8 * 32 + 4 * q); sj[4 * q] = v.x; sj[4 * q + 1] = v.y; sj[4 * q + 2] = v.z; sj[4 * q + 3] = v.w; }
#pragma unroll
                for (int j = 0; j < 32; ++j) sj[j] = j <= x ? sj[j] + ((j == 0 || j == x || j == x - 1) ? 1000.0f : 0.f) : -INFINITY;
                unsigned bits = 0u;
                const f32x4 mv = *(const LAS f32x4*)(scl + tok8 * 32 + 4 * jg);
#pragma unroll
                for (int q = 0; q < 4; ++q) {
                    const int j = 4 * jg + q;
                    const float mine = j <= x ? mv[q] + ((j == 0 || j == x || j == x - 1) ? 1000.0f : 0.f) : -INFINITY;
                    int rank = 0;
#pragma unroll
                    for (int jj = 0; jj < 32; ++jj) rank += (sj[jj] > mine || (sj[jj] == mine && jj < j)) ? 1 : 0;
                    bits |= (j <= x && rank < 8) ? (1u << j) : 0u;
                }
                bits |= __shfl_xor(bits, 1); bits |= __shfl_xor(bits, 2); bits |= __shfl_xor(bits, 4);
                if (jg == 0) { msk[wid * 8 + tok8] = bits; atomicOr((unsigned*)umask, bits); }
            }
            __syncthreads();
#pragma unroll 1
            for (int pass = 0; pass < 2; ++pass) {
                const int jlo = pass ? (x >= 4 ? x - 4 : 0) : 0;
                const unsigned inrange = (x >= 31 ? 0xffffffffu : ((2u << x) - 1u)) & ~((1u << jlo) - 1u);
                unsigned bmask = pass ? inrange : (*umask & inrange);
                const bf16* Kb = pass ? KW : KS; const int cg = (pass ? 10 : 8) + g;
                unsigned tm[2], wm[2];
#pragma unroll
                for (int mt = 0; mt < 2; ++mt) {
                    tm[mt] = pass ? 0xffffffffu : msk[wid * 8 + 4 * mt + (fr >> 2)];
                    wm[mt] = pass ? 0xffffffffu : (msk[wid * 8 + 4 * mt] | msk[wid * 8 + 4 * mt + 1] | msk[wid * 8 + 4 * mt + 2] | msk[wid * 8 + 4 * mt + 3]);
                    wm[mt] = __builtin_amdgcn_readfirstlane(wm[mt]);
                }
                f32x4 o[2][4]; float mrun[2], lrun[2];
#pragma unroll
                for (int mt = 0; mt < 2; ++mt) { mrun[mt] = -INFINITY; lrun[mt] = 0.f;
#pragma unroll
                    for (int n = 0; n < 4; ++n) o[mt][n] = (f32x4){0.f, 0.f, 0.f, 0.f}; }
                const int srow = tid >> 3, sc16 = tid & 7;
                u32x4 pk_, pv_;
                int j = __ffs(bmask) - 1;
                {   const bf16* ksrc = Kb + ((size_t)b * S + 64 * j + srow) * 128 + g * 64 + sc16 * 8; const bf16* vsrc = VTA + ((size_t)((b * 32 + j) * 12 + cg)) * 4096 + srow * 64 + sc16 * 8;
                    pk_ = *(const u32x4*)ksrc; pv_ = *(const u32x4*)vsrc; }
                int buf = 0;
                while (j >= 0) {
                    *(LAS u32x4*)(ktl + buf * 64 * RS + srow * RS + sc16 * 8) = pk_; *(LAS u32x4*)(vtl + buf * 64 * RS + srow * RS + sc16 * 8) = pv_;
                    bmask &= bmask - 1u;
                    const int jn = bmask ? __ffs(bmask) - 1 : -1;
                    if (jn >= 0) { const bf16* ksrc = Kb + ((size_t)b * S + 64 * jn + srow) * 128 + g * 64 + sc16 * 8; const bf16* vsrc = VTA + ((size_t)((b * 32 + jn) * 12 + cg)) * 4096 + srow * 64 + sc16 * 8;
                        pk_ = *(const u32x4*)ksrc; pv_ = *(const u32x4*)vsrc; }
                    __syncthreads();
                    const LAS bf16* kt = ktl + buf * 64 * RS + fr * RS + 8 * fq; const LAS bf16* vt = vtl + buf * 64 * RS + fr * RS + 8 * fq;
#pragma unroll
                    for (int mt = 0; mt < 2; ++mt) {
                        if (!((wm[mt] >> j) & 1u)) continue;
                        f32x4 sc[4];
#pragma unroll
                        for (int t = 0; t < 4; ++t) { sc[t] = (f32x4){0.f, 0.f, 0.f, 0.f};
                            sc[t] = __builtin_amdgcn_mfma_f32_16x16x32_bf16(*(const LAS bf16x8*)(kt + t * 16 * RS), qf[mt][0], sc[t], 0, 0, 0);
                            sc[t] = __builtin_amdgcn_mfma_f32_16x16x32_bf16(*(const LAS bf16x8*)(kt + t * 16 * RS + 32), qf[mt][1], sc[t], 0, 0, 0); }
                        const int tl = tl0 + 4 * mt;
                        const bool rowok = (tm[mt] >> j) & 1u;
                        const int kphi = j == x ? tl : 63;
                        const int kplo = (pass && j == x - 4) ? tl + 1 : 0;
                        float bm = -INFINITY;
#pragma unroll
                        for (int t = 0; t < 4; ++t)
#pragma unroll
                            for (int r = 0; r < 4; ++r) { const int kp = 16 * t + 4 * fq + r; const bool v = rowok && kp <= kphi && kp >= kplo; sc[t][r] = v ? sc[t][r] : -INFINITY; bm = fmaxf(bm, sc[t][r]); }
                        bm = fmaxf(bm, __shfl_xor(bm, 16)); bm = fmaxf(bm, __shfl_xor(bm, 32));
                        const float mn = fmaxf(mrun[mt], bm); const float mns = mn == -INFINITY ? 0.f : mn;
                        const float alpha = __expf(mrun[mt] - mns);
                        float rs = 0.f;
#pragma unroll
                        for (int t = 0; t < 4; ++t)
#pragma unroll
                            for (int r = 0; r < 4; ++r) { sc[t][r] = __expf(sc[t][r] - mns); rs += sc[t][r]; }
                        rs += __shfl_xor(rs, 16); rs += __shfl_xor(rs, 32);
                        lrun[mt] = lrun[mt] * alpha + rs; mrun[mt] = mn;
                        bf16x8 pf[2];
#pragma unroll
                        for (int s = 0; s < 2; ++s) { u32x4 w; w.x = pk2(sc[2 * s].x, sc[2 * s].y); w.y = pk2(sc[2 * s].z, sc[2 * s].w); w.z = pk2(sc[2 * s + 1].x, sc[2 * s + 1].y); w.w = pk2(sc[2 * s + 1].z, sc[2 * s + 1].w);
                            pf[s] = __builtin_bit_cast(bf16x8, w); }
#pragma unroll
                        for (int n = 0; n < 4; ++n) { o[mt][n] = o[mt][n] * alpha;
                            o[mt][n] = __builtin_amdgcn_mfma_f32_16x16x32_bf16(*(const LAS bf16x8*)(vt + n * 16 * RS), pf[0], o[mt][n], 0, 0, 0);
                            o[mt][n] = __builtin_amdgcn_mfma_f32_16x16x32_bf16(*(const LAS bf16x8*)(vt + n * 16 * RS + 32), pf[1], o[mt][n], 0, 0, 0); }
                    }
                    j = jn; buf ^= 1;
                }
#pragma unroll
                for (int mt = 0; mt < 2; ++mt) { const float sc_ = (pass ? g2v[mt] : g1v[mt]) / lrun[mt];
#pragma unroll
                    for (int n = 0; n < 4; ++n) outacc[mt][n] = outacc[mt][n] + o[mt][n] * sc_; }
                __syncthreads();
            }
#pragma unroll
            for (int mt = 0; mt < 2; ++mt) {
                bf16* dst = CAT + (tokbase + tl0 + 4 * mt) * 1024 + (g * 4 + (fr & 3)) * 64 + 4 * fq;
#pragma unroll
                for (int n = 0; n < 4; ++n) { u32x2 w; w.x = pk2(outacc[mt][n].x, outacc[mt][n].y); w.y = pk2(outacc[mt][n].z, outacc[mt][n].w); *(u32x2*)(dst + 16 * n) = w; }
            }
        }
    }
    __syncthreads();
}

__device__ __forceinline__ void phase_vtiles(KArgs A, int wv_, LAS unsigned char* lds) {
    const int tid_ = opaque_tid(wv_); const int wid = __builtin_amdgcn_readfirstlane(tid_ >> 6), lane = tid_ & 63; const int gw = blockIdx.x * 8 + wid, NGW = gridDim.x * 8;
    unsigned char* ws = opq(A->ws);
    const bf16* HY = (const bf16*)(ws + WS_BIG); bf16* VTA = (bf16*)(ws + WS_VTA);
    constexpr int TS = 66;
    LAS bf16* tl = (LAS bf16*)(lds + 65536) + wid * (64 * TS);
    for (int it = gw; it < NBATCH * 32 * 12; it += NGW) {
        const int cg = it % 12, bc = it / 12;
        const int colbase = cg < 8 ? C_VB + cg * 64 : (cg < 10 ? C_VS + (cg - 8) * 64 : C_VW + (cg - 10) * 64);
        const u32x4* src = (const u32x4*)(HY + (size_t)(bc * 64 + lane) * HYN + colbase);
        u32x4 w[8];
#pragma unroll
        for (int i = 0; i < 8; ++i) w[i] = src[i];
#pragma unroll
        for (int i = 0; i < 8; ++i) { LAS unsigned* d = (LAS unsigned*)(tl + lane * TS + 8 * i); d[0] = w[i].x; d[1] = w[i].y; d[2] = w[i].z; d[3] = w[i].w; }
        LDS_WAIT();
        bf16* dst = VTA + (size_t)it * 4096 + lane * 64;
#pragma unroll
        for (int p8 = 0; p8 < 8; ++p8) {
            unsigned short x[8];
#pragma unroll
            for (int j = 0; j < 8; ++j) x[j] = tl[kperm64(p8 * 8 + j) * TS + lane];
            u32x4 o; o.x = x[0] | ((unsigned)x[1] << 16); o.y = x[2] | ((unsigned)x[3] << 16); o.z = x[4] | ((unsigned)x[5] << 16); o.w = x[6] | ((unsigned)x[7] << 16);
            *(u32x4*)(dst + p8 * 8) = o;
        }
        LDS_WAIT();
    }
}

__device__ __forceinline__ float log_sigmoid16(float z) { return (fminf(z, 0.f) - __logf(1.0f + __expf(-fabsf(z)))) * (1.f / 16.f); }
#define GLA_Z(tokv) ({ float z_ = bias; _Pragma("unroll") for (int r_ = 0; r_ < 16; ++r_) z_ += __builtin_bit_cast(float, __builtin_amdgcn_readlane(__builtin_bit_cast(int, al[r_]), (tokv))) * wc[r_]; z_; })
#define GLA_LOAD_GATE() \
    float al[16], wc[16]; \
    { const u32x4* ap_ = (const u32x4*)(HY + (size_t)(tok0 + lane) * HYN + C_AL); const u32x4 a0_ = ap_[0], a1_ = ap_[1]; \
      al[0] = bflo(a0_.x); al[1] = bfhi(a0_.x); al[2] = bflo(a0_.y); al[3] = bfhi(a0_.y); al[4] = bflo(a0_.z); al[5] = bfhi(a0_.z); al[6] = bflo(a0_.w); al[7] = bfhi(a0_.w); \
      al[8] = bflo(a1_.x); al[9] = bfhi(a1_.x); al[10] = bflo(a1_.y); al[11] = bfhi(a1_.y); al[12] = bflo(a1_.z); al[13] = bfhi(a1_.z); al[14] = bflo(a1_.w); al[15] = bfhi(a1_.w); } \
    _Pragma("unroll") for (int r_ = 0; r_ < 16; ++r_) wc[r_] = A->in[I_WA2][(i * 16 + r_) * 256 + h * 64 + lane]; \
    const float bias = A->in[I_BA][i * 256 + h * 64 + lane];

__device__ __forceinline__ void phase_gla_a(KArgs A, int wv_, int i, LAS unsigned char* lds) {
    const int tid_ = opaque_tid(wv_); const int wid = __builtin_amdgcn_readfirstlane(tid_ >> 6), lane = tid_ & 63, fr = lane & 15, fq = lane >> 4; const int gw = blockIdx.x * 8 + wid, NGW = gridDim.x * 8;
    unsigned char* ws = opq(A->ws);
    const bf16* HY = (const bf16*)(ws + WS_BIG); const bf16* VTA = (const bf16*)(ws + WS_VTA); float* SLOC = (float*)(ws + WS_SLOC); float* DEC = (float*)(ws + WS_DEC);
    constexpr int RS = 72;
    LAS bf16* kh = (LAS bf16*)lds + wid * (64 * RS);
    (void)gw;
    for (int it = wid * (int)gridDim.x + (int)blockIdx.x; it < 1024; it += NGW) {
        const int c = it & 31, bh = it >> 5, b = bh >> 2, h = bh & 3; const size_t tok0 = (size_t)b * S + c * 64;
        GLA_LOAD_GATE();
        float bl = 0.f;
#pragma unroll 8
        for (int tk = 0; tk < 64; ++tk) bl += log_sigmoid16(GLA_Z(tk));
        float bc = 0.f;
        unsigned short kcol[64];
#pragma unroll
        for (int tk = 0; tk < 64; ++tk) kcol[tk] = HY[(tok0 + tk) * HYN + C_KB + h * 64 + lane];
#pragma unroll
        for (int tk = 0; tk < 64; ++tk) {
            bc += log_sigmoid16(GLA_Z(tk));
            kh[lane * RS + kpos64(tk)] = (bf16)f2bf(bf2f(kcol[tk]) * __expf(bl - bc));
        }
        DEC[it * 64 + lane] = __expf(bl);
        LDS_WAIT();
#pragma unroll
        for (int dvh = 0; dvh < 2; ++dvh) {
            const bf16* vt = VTA + ((size_t)((b * 32 + c) * 12 + h * 2 + dvh)) * 4096;
            bf16x8 vf[4][2];
#pragma unroll
            for (int n = 0; n < 4; ++n)
#pragma unroll
                for (int s = 0; s < 2; ++s) vf[n][s] = *(const bf16x8*)(vt + (16 * n + fr) * 64 + 32 * s + 8 * fq);
#pragma unroll
            for (int m = 0; m < 4; ++m) {
                const bf16x8 a0 = *(const LAS bf16x8*)(kh + (16 * m + fr) * RS + 8 * fq), a1 = *(const LAS bf16x8*)(kh + (16 * m + fr) * RS + 32 + 8 * fq);
#pragma unroll
                for (int n = 0; n < 4; ++n) {
                    f32x4 acc = (f32x4){0.f, 0.f, 0.f, 0.f};
                    acc = __builtin_amdgcn_mfma_f32_16x16x32_bf16(a0, vf[n][0], acc, 0, 0, 0);
                    acc = __builtin_amdgcn_mfma_f32_16x16x32_bf16(a1, vf[n][1], acc, 0, 0, 0);
                    float* dst = SLOC + ((size_t)it * 64 + 16 * m + 4 * fq) * 128 + dvh * 64 + 16 * n + fr;
                    dst[0] = acc.x; dst[128] = acc.y; dst[256] = acc.z; dst[384] = acc.w;
                }
            }
        }
        LDS_WAIT();
    }
}
__device__ __forceinline__ void phase_gla_c(KArgs A, int wv_, int i, LAS unsigned char* lds) {
    const int tid_ = opaque_tid(wv_); const int wid = __builtin_amdgcn_readfirstlane(tid_ >> 6), lane = tid_ & 63, fr = lane & 15, fq = lane >> 4; const int gw = blockIdx.x * 8 + wid, NGW = gridDim.x * 8;
    unsigned char* ws = opq(A->ws);
    const bf16* HY = (const bf16*)(ws + WS_BIG); const bf16* VTA = (const bf16*)(ws + WS_VTA); const bf16* STT = (const bf16*)(ws + WS_STT); bf16* CAT = (bf16*)(ws + WS_CAT);
    constexpr int RS = 72;
    LAS bf16* qs = (LAS bf16*)lds + wid * (128 * RS);
    LAS bf16* ks = qs + 64 * RS;
    const float* og = A->in[I_ONORM] + i * 128;
    (void)gw; (void)NGW;
    for (int blk = blockIdx.x; blk < 128; blk += gridDim.x) {
        {
            const float* SLOC = (const float*)(ws + WS_SLOC); const float* DEC = (const float*)(ws + WS_DEC); bf16* STw = (bf16*)(ws + WS_STT);
            const int tid = tid_, dv = tid & 127, ko = tid >> 7, bh = blk >> 2, c0 = (blk & 3) * 8;
            float sv[16];
#pragma unroll
            for (int j = 0; j < 16; ++j) sv[j] = 0.f;
#pragma unroll 4
            for (int c = 0; c < c0 + 8; ++c) {
                const size_t item = (size_t)bh * 32 + c;
                if (c >= c0) {
                    u32x4 o0, o1; o0.x = pk2(sv[0], sv[1]); o0.y = pk2(sv[2], sv[3]); o0.z = pk2(sv[4], sv[5]); o0.w = pk2(sv[6], sv[7]);
                    o1.x = pk2(sv[8], sv[9]); o1.y = pk2(sv[10], sv[11]); o1.z = pk2(sv[12], sv[13]); o1.w = pk2(sv[14], sv[15]);
                    u32x4* d = (u32x4*)(STw + (item * 128 + dv) * 64 + ko * 16); d[0] = o0; d[1] = o1;
                }
                if (c < c0 + 7) {
                    const float* sl = SLOC + (item * 64 + ko * 16) * 128 + dv; const float* dc = DEC + item * 64 + ko * 16;
#pragma unroll
                    for (int j = 0; j < 16; ++j) sv[j] = dc[j] * sv[j] + sl[j * 128];
                }
            }
            asm volatile("s_waitcnt vmcnt(0)" ::: "memory");
            __syncthreads();
        }
        const int it = blk * 8 + wid;
        const int c = it & 31, bh = it >> 5, b = bh >> 2, h = bh & 3; const size_t tok0 = (size_t)b * S + c * 64;
        GLA_LOAD_GATE();
        float bc = 0.f;
        unsigned short qcol[64], kcol[64];
#pragma unroll
        for (int tk = 0; tk < 64; ++tk) { const bf16* row = HY + (tok0 + tk) * HYN; qcol[tk] = row[C_QB + h * 64 + lane]; kcol[tk] = row[C_KB + h * 64 + lane]; }
#pragma unroll
        for (int tk = 0; tk < 64; ++tk) {
            bc += log_sigmoid16(GLA_Z(tk));
            const float eb = __expf(bc);
            qs[tk * RS + lane] = (bf16)f2bf(bf2f(qcol[tk]) * 0.125f * eb); ks[tk * RS + lane] = (bf16)f2bf(bf2f(kcol[tk]) / eb);
        }
        LDS_WAIT();
        bf16x8 st[8][2];
#pragma unroll
        for (int n = 0; n < 8; ++n)
#pragma unroll
            for (int s = 0; s < 2; ++s) st[n][s] = *(const bf16x8*)(STT + ((size_t)it * 128 + 16 * n + fr) * 64 + 32 * s + 8 * fq);
        const bf16* vt = VTA + ((size_t)((b * 32 + c) * 12 + h * 2)) * 4096;
#pragma unroll
        for (int mi = 0; mi < 4; ++mi) {
            const bf16x8 q0 = *(const LAS bf16x8*)(qs + (16 * mi + fr) * RS + 8 * fq), q1 = *(const LAS bf16x8*)(qs + (16 * mi + fr) * RS + 32 + 8 * fq);
            f32x4 sc[4];
#pragma unroll
            for (int t = 0; t < 4; ++t) {
                sc[t] = (f32x4){0.f, 0.f, 0.f, 0.f};
                if (t <= mi) {
                    const bf16x8 k0 = *(const LAS bf16x8*)(ks + (16 * t + fr) * RS + 8 * fq), k1 = *(const LAS bf16x8*)(ks + (16 * t + fr) * RS + 32 + 8 * fq);
                    sc[t] = __builtin_amdgcn_mfma_f32_16x16x32_bf16(k0, q0, sc[t], 0, 0, 0);
                    sc[t] = __builtin_amdgcn_mfma_f32_16x16x32_bf16(k1, q1, sc[t], 0, 0, 0);
                    if (t == mi) {
                        sc[t].x = (4 * fq + 0 <= fr) ? sc[t].x : 0.f; sc[t].y = (4 * fq + 1 <= fr) ? sc[t].y : 0.f; sc[t].z = (4 * fq + 2 <= fr) ? sc[t].z : 0.f; sc[t].w = (4 * fq + 3 <= fr) ? sc[t].w : 0.f; }
                }
            }
            bf16x8 pf[2];
#pragma unroll
            for (int s = 0; s < 2; ++s) { u32x4 w; w.x = pk2(sc[2 * s].x, sc[2 * s].y); w.y = pk2(sc[2 * s].z, sc[2 * s].w); w.z = pk2(sc[2 * s + 1].x, sc[2 * s + 1].y); w.w = pk2(sc[2 * s + 1].z, sc[2 * s + 1].w);
                pf[s] = __builtin_bit_cast(bf16x8, w); }
            f32x4 o[8]; float ssq = 0.f;
#pragma unroll
            for (int n = 0; n < 8; ++n) {
                o[n] = (f32x4){0.f, 0.f, 0.f, 0.f};
                o[n] = __builtin_amdgcn_mfma_f32_16x16x32_bf16(st[n][0], q0, o[n], 0, 0, 0);
                o[n] = __builtin_amdgcn_mfma_f32_16x16x32_bf16(st[n][1], q1, o[n], 0, 0, 0);
                const bf16* vrow = vt + (size_t)(n >> 2) * 4096 + (16 * (n & 3) + fr) * 64 + 8 * fq;
                o[n] = __builtin_amdgcn_mfma_f32_16x16x32_bf16(*(const bf16x8*)vrow, pf[0], o[n], 0, 0, 0);
                if (mi >= 2) o[n] = __builtin_amdgcn_mfma_f32_16x16x32_bf16(*(const bf16x8*)(vrow + 32), pf[1], o[n], 0, 0, 0);
                ssq += (o[n].x * o[n].x + o[n].y * o[n].y) + (o[n].z * o[n].z + o[n].w * o[n].w);
            }
            ssq += __shfl_xor(ssq, 16); ssq += __shfl_xor(ssq, 32);
            const float rstd = rsqrtf(ssq * (1.f / 128.f) + EPS);
            const size_t tok = tok0 + 16 * mi + fr;
#pragma unroll
            for (int n = 0; n < 8; ++n) {
                const int dv = 16 * n + 4 * fq;
                const u32x2 rw = *(const u32x2*)(HY + tok * HYN + C_RB + h * 128 + dv); const f32x4 g = *(const f32x4*)(og + dv);
                const float r0 = bflo(rw.x), r1 = bfhi(rw.x), r2 = bflo(rw.y), r3 = bfhi(rw.y);
                u32x2 w; w.x = pk2(o[n].x * rstd * g.x * (r0 * sigmoidf_(r0)), o[n].y * rstd * g.y * (r1 * sigmoidf_(r1)));
                w.y = pk2(o[n].z * rstd * g.z * (r2 * sigmoidf_(r2)), o[n].w * rstd * g.w * (r3 * sigmoidf_(r3)));
                *(u32x2*)(CAT + tok * 1024 + 512 + h * 128 + dv) = w;
            }
        }
        LDS_WAIT();
        __syncthreads();
    }
}

__device__ __forceinline__ void phase_sgu_mix(KArgs A, int wv_, int i, LAS unsigned char* lds) {
    const int tid = opaque_tid(wv_), wid = __builtin_amdgcn_readfirstlane(tid >> 6), lane = tid & 63;
    unsigned char* ws = opq(A->ws);
    const bf16* U = (const bf16*)(ws + WS_U); const bf16* V = (const bf16*)(ws + WS_V); bf16* UM = (bf16*)(ws + WS_UM);
    LAS float* vt = (LAS float*)lds;
    LAS float* st = vt + 128 * 256;
    const float* lng = A->in[I_LNG] + i * 2048; const float* lnb = A->in[I_LNB] + i * 2048;
    for (int it = blockIdx.x; it < NBATCH * 16 * 8; it += gridDim.x) {
        const int g = it & 7, n = (it >> 3) & 15, b = it >> 7;
        const size_t tok0 = (size_t)b * S + n * 128;
        __syncthreads();
        for (int s = wid * 16; s < wid * 16 + 16; ++s) {
            const u32x4* vr = (const u32x4*)(V + (tok0 + s) * 2048) + lane;
            float x[32]; float sum = 0.f;
#pragma unroll
            for (int j = 0; j < 4; ++j) { const u32x4 w = vr[64 * j];
                x[8 * j + 0] = bflo(w.x); x[8 * j + 1] = bfhi(w.x); x[8 * j + 2] = bflo(w.y); x[8 * j + 3] = bfhi(w.y); x[8 * j + 4] = bflo(w.z); x[8 * j + 5] = bfhi(w.z); x[8 * j + 6] = bflo(w.w); x[8 * j + 7] = bfhi(w.w); }
#pragma unroll
            for (int j = 0; j < 32; ++j) sum += x[j];
            const float mean = wave_sum(sum) * (1.f / 2048.f); float q = 0.f;
#pragma unroll
            for (int j = 0; j < 32; ++j) { const float d = x[j] - mean; q += d * d; }
            const float rstd = rsqrtf(wave_sum(q) * (1.f / 2048.f) + EPS);
            const u32x2 w = *((const u32x2*)(V + (tok0 + s) * 2048 + g * 256) + lane);
            const f32x4 gg = *(const f32x4*)(lng + g * 256 + 4 * lane), bb = *(const f32x4*)(lnb + g * 256 + 4 * lane);
            f32x4 o; o.x = (bflo(w.x) - mean) * rstd * gg.x + bb.x; o.y = (bfhi(w.x) - mean) * rstd * gg.y + bb.y; o.z = (bflo(w.y) - mean) * rstd * gg.z + bb.z; o.w = (bfhi(w.y) - mean) * rstd * gg.w + bb.w;
            *(LAS f32x4*)(vt + s * 256 + 4 * lane) = o;
            (void)st;
        }
        __syncthreads();
        const int c = tid & 255, th = tid >> 8;
        const float* wsg = A->in[I_SGWS] + (size_t)(i * 8 + g) * 128 * 128; const float* bsg = A->in[I_SGBS] + (i * 8 + g) * 128;
        for (int tt = 0; tt < 64; ++tt) {
            const int t = 2 * tt + th;
            const float* wr = wsg + t * 128;
            float acc = 0.f;
            for (int s = 0; s <= t; ++s) acc += wr[s] * vt[s * 256 + c];
            acc += bsg[t];
            const float u = bf2f(U[(tok0 + t) * 2048 + g * 256 + c]);
            UM[(tok0 + t) * 2048 + g * 256 + c] = (bf16)f2bf(u * acc);
        }
    }
    __syncthreads();
}


__device__ __forceinline__ void phase_sgu_mix_mfma(KArgs A, int wv_, int i, LAS unsigned char* lds) {
    const int tid = opaque_tid(wv_), wid = __builtin_amdgcn_readfirstlane(tid >> 6), lane = tid & 63, fr = lane & 15, fq = lane >> 4;
    unsigned char* ws = opq(A->ws);
    const bf16* U = (const bf16*)(ws + WS_U); const bf16* V = (const bf16*)(ws + WS_V); bf16* UM = (bf16*)(ws + WS_UM);
    const bf16* WSB = (const bf16*)(ws + WS_WSB) + (size_t)i * 8 * 16384; const float* M0 = (const float*)(ws + WS_M0) + i * 8 * 128;
    constexpr int VS = 136;
    LAS bf16* vT = (LAS bf16*)lds;
    LAS float* st = (LAS float*)(lds + 256 * VS * 2);
    const float* lng = A->in[I_LNG] + i * 2048; const float* lnb = A->in[I_LNB] + i * 2048; const float* bsg = A->in[I_SGBS] + i * 8 * 128;
    for (int it = blockIdx.x; it < 256; it += gridDim.x) {
        const int gh = it & 1, n_ = (it >> 1) & 15, b = it >> 5; const size_t tok0 = (size_t)b * S + n_ * 128;
        __syncthreads();
        for (int s4 = wid * 16; s4 < wid * 16 + 16; s4 += 4) {
            u32x4 w[4][4];
#pragma unroll
            for (int rr = 0; rr < 4; ++rr) { const u32x4* vr = (const u32x4*)(V + (tok0 + s4 + rr) * 2048) + lane;
#pragma unroll
                for (int j = 0; j < 4; ++j) w[rr][j] = vr[64 * j]; }
#pragma unroll
            for (int rr = 0; rr < 4; ++rr) {
                float sum = 0.f, sq = 0.f;
#pragma unroll
                for (int j = 0; j < 4; ++j) { const float x0 = bflo(w[rr][j].x), x1 = bfhi(w[rr][j].x), x2 = bflo(w[rr][j].y), x3 = bfhi(w[rr][j].y), x4 = bflo(w[rr][j].z), x5 = bfhi(w[rr][j].z), x6 = bflo(w[rr][j].w), x7 = bfhi(w[rr][j].w);
                    sum += ((x0 + x1) + (x2 + x3)) + ((x4 + x5) + (x6 + x7)); sq += ((x0 * x0 + x1 * x1) + (x2 * x2 + x3 * x3)) + ((x4 * x4 + x5 * x5) + (x6 * x6 + x7 * x7)); }
                sum = wave_sum(sum); sq = wave_sum(sq);
                const float mean = sum * (1.f / 2048.f); const float var = fmaxf(sq * (1.f / 2048.f) - mean * mean, 0.f);
                if (lane == 0) { st[2 * (s4 + rr)] = mean; st[2 * (s4 + rr) + 1] = rsqrtf(var + EPS); }
            }
        }
#pragma unroll 1
        for (int gg = 0; gg < 4; ++gg) {
            const int g = gh * 4 + gg;
            __syncthreads();
            {
                const int s = tid & 127, cq = tid >> 7;
                const float mean = st[2 * s], rstd = st[2 * s + 1];
                const u32x4* src = (const u32x4*)(V + (tok0 + s) * 2048 + g * 256 + cq * 64);
#pragma unroll
                for (int i8 = 0; i8 < 8; ++i8) {
                    const u32x4 w = src[i8];
                    LAS bf16* d = vT + (cq * 64 + i8 * 8) * VS + s;
                    d[0 * VS] = (bf16)f2bf((bflo(w.x) - mean) * rstd); d[1 * VS] = (bf16)f2bf((bfhi(w.x) - mean) * rstd); d[2 * VS] = (bf16)f2bf((bflo(w.y) - mean) * rstd); d[3 * VS] = (bf16)f2bf((bfhi(w.y) - mean) * rstd);
                    d[4 * VS] = (bf16)f2bf((bflo(w.z) - mean) * rstd); d[5 * VS] = (bf16)f2bf((bfhi(w.z) - mean) * rstd); d[6 * VS] = (bf16)f2bf((bflo(w.w) - mean) * rstd); d[7 * VS] = (bf16)f2bf((bfhi(w.w) - mean) * rstd);
                }
            }
            __syncthreads();
            bf16x8 vf[2][4];
#pragma unroll
            for (int m = 0; m < 2; ++m)
#pragma unroll
                for (int k = 0; k < 4; ++k) vf[m][k] = *(const LAS bf16x8*)(vT + (32 * wid + 16 * m + fr) * VS + 32 * k + 8 * fq);
            const bf16* wb = WSB + ((size_t)g * 128 + fr) * 128 + 8 * fq;
            f32x4 gc[2], bc[2];
#pragma unroll
            for (int m = 0; m < 2; ++m) { gc[m] = *(const f32x4*)(lng + g * 256 + 32 * wid + 16 * m + 4 * fq); bc[m] = *(const f32x4*)(lnb + g * 256 + 32 * wid + 16 * m + 4 * fq); }
#pragma unroll
            for (int n = 0; n < 8; ++n) {
                f32x4 a0 = (f32x4){0.f, 0.f, 0.f, 0.f}, a1 = (f32x4){0.f, 0.f, 0.f, 0.f};
                asm volatile("" : "+v"(wb));
#pragma unroll
                for (int k = 0; k < 4; ++k) if (k <= (n >> 1)) {
                    const bf16x8 wf = *(const bf16x8*)(wb + 32 * k);
                    a0 = __builtin_amdgcn_mfma_f32_16x16x32_bf16(vf[0][k], wf, a0, 0, 0, 0);
                    a1 = __builtin_amdgcn_mfma_f32_16x16x32_bf16(vf[1][k], wf, a1, 0, 0, 0); }
                wb += 16 * 128;
                const int t = 16 * n + fr; const float m0 = M0[g * 128 + t], bsv = bsg[g * 128 + t];
                const size_t ro = (tok0 + t) * 2048 + g * 256 + 32 * wid + 4 * fq;
#pragma unroll
                for (int m = 0; m < 2; ++m) {
                    const f32x4 a = m ? a1 : a0;
                    const u32x2 uw = *(const u32x2*)(U + ro + 16 * m);
                    u32x2 w; w.x = pk2((a.x * gc[m].x + bc[m].x * m0 + bsv) * bflo(uw.x), (a.y * gc[m].y + bc[m].y * m0 + bsv) * bfhi(uw.x));
                    w.y = pk2((a.z * gc[m].z + bc[m].z * m0 + bsv) * bflo(uw.y), (a.w * gc[m].w + bc[m].w * m0 + bsv) * bfhi(uw.y));
                    *(u32x2*)(UM + ro + 16 * m) = w;
                }
                asm volatile("" ::: "memory");
            }
        }
    }
    __syncthreads();
}

__device__ __forceinline__ void phase_rownorm(KArgs A, int wv_) {
    const int tid_ = opaque_tid(wv_); const int wid = __builtin_amdgcn_readfirstlane(tid_ >> 6), lane = tid_ & 63; const int gw = blockIdx.x * 8 + wid, NGW = gridDim.x * 8;
    bf16* XN = (bf16*)(opq(A->ws) + WS_XN); const float* X = A->out;
    f32x4 v[4], vn[4];
    if (gw < T) {
#pragma unroll
        for (int j = 0; j < 4; ++j) v[j] = ((const f32x4*)(X + (size_t)gw * D) + lane)[64 * j];
    }
    for (int m = gw; m < T; m += NGW) {
        const int mn = m + NGW < T ? m + NGW : m;
#pragma unroll
        for (int j = 0; j < 4; ++j) vn[j] = ((const f32x4*)(X + (size_t)mn * D) + lane)[64 * j];
        float s = 0.f;
#pragma unroll
        for (int j = 0; j < 4; ++j) s += (v[j].x * v[j].x + v[j].y * v[j].y) + (v[j].z * v[j].z + v[j].w * v[j].w);
        const float rstd = rsqrtf(wave_sum(s) * (1.f / 1024.f) + EPS);
        u32x2* o8 = (u32x2*)(XN + (size_t)m * D) + lane;
#pragma unroll
        for (int j = 0; j < 4; ++j) { u32x2 w; w.x = pk2(v[j].x * rstd, v[j].y * rstd); w.y = pk2(v[j].z * rstd, v[j].w * rstd); o8[64 * j] = w; }
#pragma unroll
        for (int j = 0; j < 4; ++j) v[j] = vn[j];
    }
}

__device__ __forceinline__ void phase_xattn(KArgs A, int wv_, int L, LAS unsigned char* lds) {
    const int tid = opaque_tid(wv_), wid = __builtin_amdgcn_readfirstlane(tid >> 6), lane = tid & 63;
    unsigned char* ws = opq(A->ws);
    const bf16* QX = (const bf16*)(ws + WS_QX); const bf16* KV = (const bf16*)(ws + WS_KV); bf16* OX = (bf16*)(ws + WS_OX);
    constexpr int KSTR = 129;
    LAS unsigned* kl = (LAS unsigned*)lds;
    LAS float* qb = (LAS float*)(lds + 132096) + wid * 256;
    LAS float* pb = (LAS float*)(lds + 132096 + 8192) + wid * 256;
    const float* qg = A->in[I_XQN] + L * 256;
    for (int it = blockIdx.x; it < NBATCH * 4 * 8; it += gridDim.x) {
        const int qc = it & 7, h = (it >> 3) & 3, b = it >> 5;
        __syncthreads();
        for (int e = tid; e < 256 * 128; e += 512) { const int m = e >> 7, dw = e & 127;
            kl[m * KSTR + dw] = *((const unsigned*)(KV + (size_t)(b * 256 + m) * 8192 + L * 2048 + h * 256) + dw); }
        __syncthreads();
        const bf16* Vb = KV + (size_t)(b * 256) * 8192 + L * 2048 + 1024 + h * 256;
        for (int tq = 0; tq < 32; ++tq) {
            const size_t tok = (size_t)b * S + qc * 256 + wid * 32 + tq;
            const u32x2 qw = *((const u32x2*)(QX + tok * 1024 + h * 256) + lane);
            const float q0 = bflo(qw.x), q1 = bfhi(qw.x), q2 = bflo(qw.y), q3 = bfhi(qw.y);
            const float rstd = rsqrtf(wave_sum(q0 * q0 + q1 * q1 + q2 * q2 + q3 * q3) * (1.f / 256.f) + EPS);
            const f32x4 gg = *(const f32x4*)(qg + 4 * lane);
            *(LAS f32x4*)(qb + 4 * lane) = (f32x4){q0 * rstd * gg.x, q1 * rstd * gg.y, q2 * rstd * gg.z, q3 * rstd * gg.w};
            LDS_WAIT();
            float s0 = 0.f, s1 = 0.f, s2 = 0.f, s3 = 0.f;
#pragma unroll 4
            for (int dw = 0; dw < 128; ++dw) {
                const f32x2 qq = *(const LAS f32x2*)(qb + 2 * dw);
                const unsigned k0 = kl[lane * KSTR + dw], k1 = kl[(lane + 64) * KSTR + dw], k2 = kl[(lane + 128) * KSTR + dw], k3 = kl[(lane + 192) * KSTR + dw];
                s0 += qq.x * bflo(k0) + qq.y * bfhi(k0); s1 += qq.x * bflo(k1) + qq.y * bfhi(k1);
                s2 += qq.x * bflo(k2) + qq.y * bfhi(k2); s3 += qq.x * bflo(k3) + qq.y * bfhi(k3);
            }
            const float mx = wave_max(fmaxf(fmaxf(s0, s1), fmaxf(s2, s3)));
            const float e0 = __expf(s0 - mx), e1 = __expf(s1 - mx), e2 = __expf(s2 - mx), e3 = __expf(s3 - mx);
            const float inv = 1.f / wave_sum((e0 + e1) + (e2 + e3));
            pb[lane] = e0 * inv; pb[lane + 64] = e1 * inv; pb[lane + 128] = e2 * inv; pb[lane + 192] = e3 * inv;
            LDS_WAIT();
            float o0 = 0.f, o1 = 0.f, o2 = 0.f, o3 = 0.f;
#pragma unroll 8
            for (int m = 0; m < 256; ++m) {
                const float p = pb[m];
                const u32x2 vw = *((const u32x2*)(Vb + (size_t)m * 8192) + lane);
                o0 += p * bflo(vw.x); o1 += p * bfhi(vw.x); o2 += p * bflo(vw.y); o3 += p * bfhi(vw.y);
            }
            u32x2 ow; ow.x = pk2(o0, o1); ow.y = pk2(o2, o3);
            *((u32x2*)(OX + tok * 1024 + h * 256) + lane) = ow;
            LDS_WAIT();
        }
    }
    __syncthreads();
}


__device__ __forceinline__ int kperm32(int p) { const int fq = (p >> 3) & 3, j = p & 7; return (p & ~31) + 16 * (j >> 2) + 4 * fq + (j & 3); }
__device__ __forceinline__ void phase_vtrans(KArgs A, int wv_, LAS unsigned char* lds) {
    const int tid = opaque_tid(wv_);
    unsigned char* ws = opq(A->ws);
    const bf16* KV = (const bf16*)(ws + WS_KV); bf16* VT = (bf16*)(ws + WS_VT);
    LAS bf16* vt = (LAS bf16*)lds;
    constexpr int VS = 258;
    for (int it = blockIdx.x; it < DEPTH * NBATCH * 4; it += gridDim.x) {
        const int h = it & 3, b = (it >> 2) & 7, l = it >> 5;
        __syncthreads();
        for (int e = tid; e < 256 * 32; e += 512) { const int m = e >> 5, c8 = e & 31;
            const u32x4 w = *(const u32x4*)(KV + (size_t)(b * 256 + m) * 8192 + l * 2048 + 1024 + h * 256 + c8 * 8);
            LAS unsigned* d = (LAS unsigned*)(vt + m * VS + c8 * 8); d[0] = w.x; d[1] = w.y; d[2] = w.z; d[3] = w.w; }
        __syncthreads();
        for (int e = tid; e < 256 * 32; e += 512) { const int dv = e & 255, p8 = e >> 8;
            unsigned short x[8];
#pragma unroll
            for (int j = 0; j < 8; ++j) x[j] = vt[kperm32(p8 * 8 + j) * VS + dv];
            u32x4 o; o.x = x[0] | ((unsigned)x[1] << 16); o.y = x[2] | ((unsigned)x[3] << 16); o.z = x[4] | ((unsigned)x[5] << 16); o.w = x[6] | ((unsigned)x[7] << 16);
            *(u32x4*)(VT + ((size_t)it * 256 + dv) * 256 + p8 * 8) = o; }
    }
    __syncthreads();
}

__device__ __forceinline__ void phase_xattn_mfma(KArgs A, int wv_, int L, LAS unsigned char* lds) {
    const int tid = opaque_tid(wv_), wid = __builtin_amdgcn_readfirstlane(tid >> 6), lane = tid & 63, fr = lane & 15, fq = lane >> 4;
    unsigned char* ws = opq(A->ws);
    const bf16* QX = (const bf16*)(ws + WS_QX); const bf16* KV = (const bf16*)(ws + WS_KV); const bf16* VT = (const bf16*)(ws + WS_VT); bf16* OX = (bf16*)(ws + WS_OX);
    constexpr int RS = 264;
    LAS bf16* kl = (LAS bf16*)lds;
    const float* qg = A->in[I_XQN] + L * 256;
    for (int it = blockIdx.x; it < NBATCH * 4 * 16; it += gridDim.x) {
        const int qt = it & 15, h = (it >> 4) & 3, b = it >> 6;
        __syncthreads();
        {
            const int row = tid >> 1, hf = tid & 1;
            const u32x4* src = (const u32x4*)(KV + (size_t)(b * 256 + row) * 8192 + L * 2048 + h * 256 + hf * 128);
#pragma unroll
            for (int i0 = 0; i0 < 16; i0 += 8) {
                u32x4 w[8];
#pragma unroll
                for (int i = 0; i < 8; ++i) w[i] = src[i0 + i];
#pragma unroll
                for (int i = 0; i < 8; ++i) *(LAS u32x4*)(kl + row * RS + hf * 128 + (i0 + i) * 8) = w[i];
            }
        }
        const size_t tok = (size_t)b * S + qt * 128 + wid * 16 + fr;
        bf16x8 qf[8];
        {
            u32x4 qw[8]; float ssq = 0.f;
#pragma unroll
            for (int s = 0; s < 8; ++s) qw[s] = *(const u32x4*)(QX + tok * 1024 + h * 256 + 32 * s + 8 * fq);
#pragma unroll
            for (int s = 0; s < 8; ++s) {
                const float a0 = bflo(qw[s].x), a1 = bfhi(qw[s].x), a2 = bflo(qw[s].y), a3 = bfhi(qw[s].y), a4 = bflo(qw[s].z), a5 = bfhi(qw[s].z), a6 = bflo(qw[s].w), a7 = bfhi(qw[s].w);
                ssq += (a0 * a0 + a1 * a1) + (a2 * a2 + a3 * a3) + (a4 * a4 + a5 * a5) + (a6 * a6 + a7 * a7);
            }
            ssq += __shfl_xor(ssq, 16); ssq += __shfl_xor(ssq, 32);
            const float rstd = rsqrtf(ssq * (1.f / 256.f) + EPS);
#pragma unroll
            for (int s = 0; s < 8; ++s) {
                const f32x4 ga = *(const f32x4*)(qg + 32 * s + 8 * fq), gb = *(const f32x4*)(qg + 32 * s + 8 * fq + 4);
                u32x4 w; w.x = pk2(bflo(qw[s].x) * rstd * ga.x, bfhi(qw[s].x) * rstd * ga.y); w.y = pk2(bflo(qw[s].y) * rstd * ga.z, bfhi(qw[s].y) * rstd * ga.w);
                w.z = pk2(bflo(qw[s].z) * rstd * gb.x, bfhi(qw[s].z) * rstd * gb.y); w.w = pk2(bflo(qw[s].w) * rstd * gb.z, bfhi(qw[s].w) * rstd * gb.w);
                qf[s] = __builtin_bit_cast(bf16x8, w);
            }
        }
        __syncthreads();
        f32x4 sc[16];
#pragma unroll
        for (int hf = 0; hf < 2; ++hf) {
            unsigned kb = (unsigned)(size_t)(kl + (128 * hf + fr) * RS + 8 * fq); asm volatile("" : "+v"(kb));
#pragma unroll
            for (int t8 = 0; t8 < 8; ++t8) { const int t = 8 * hf + t8; sc[t] = (f32x4){0.f, 0.f, 0.f, 0.f};
#pragma unroll
                for (int s = 0; s < 8; ++s) { const bf16x8 kf = *(const LAS bf16x8*)(size_t)(kb + (unsigned)((16 * t8 * RS + 32 * s) * 2));
                    sc[t] = __builtin_amdgcn_mfma_f32_16x16x32_bf16(kf, qf[s], sc[t], 0, 0, 0); }
                if (t & 1) asm volatile("" ::: "memory"); }
        }
        float mx = -INFINITY;
#pragma unroll
        for (int t = 0; t < 16; ++t) mx = fmaxf(mx, fmaxf(fmaxf(sc[t].x, sc[t].y), fmaxf(sc[t].z, sc[t].w)));
        mx = fmaxf(mx, __shfl_xor(mx, 16)); mx = fmaxf(mx, __shfl_xor(mx, 32));
        float lsum = 0.f;
#pragma unroll
        for (int t = 0; t < 16; ++t) { sc[t].x = __expf(sc[t].x - mx); sc[t].y = __expf(sc[t].y - mx); sc[t].z = __expf(sc[t].z - mx); sc[t].w = __expf(sc[t].w - mx); lsum += (sc[t].x + sc[t].y) + (sc[t].z + sc[t].w); }
        lsum += __shfl_xor(lsum, 16); lsum += __shfl_xor(lsum, 32);
        const float inv = 1.f / lsum;
        bf16x8 pf[8];
#pragma unroll
        for (int s = 0; s < 8; ++s) { u32x4 w; w.x = pk2(sc[2 * s].x, sc[2 * s].y); w.y = pk2(sc[2 * s].z, sc[2 * s].w); w.z = pk2(sc[2 * s + 1].x, sc[2 * s + 1].y); w.w = pk2(sc[2 * s + 1].z, sc[2 * s + 1].w);
            pf[s] = __builtin_bit_cast(bf16x8, w); }
        __syncthreads();
        {
            const int row = tid >> 1, hf = tid & 1;
            const u32x4* src = (const u32x4*)(VT + ((size_t)((L * 8 + b) * 4 + h) * 256 + row) * 256 + hf * 128);
#pragma unroll
            for (int i0 = 0; i0 < 16; i0 += 8) {
                u32x4 w[8];
#pragma unroll
                for (int i = 0; i < 8; ++i) w[i] = src[i0 + i];
#pragma unroll
                for (int i = 0; i < 8; ++i) *(LAS u32x4*)(kl + row * RS + hf * 128 + (i0 + i) * 8) = w[i];
            }
        }
        __syncthreads();
#pragma unroll
        for (int hf = 0; hf < 2; ++hf) {
            unsigned vb = (unsigned)(size_t)(kl + (128 * hf + fr) * RS + 8 * fq); asm volatile("" : "+v"(vb));
#pragma unroll
            for (int n8 = 0; n8 < 8; ++n8) { const int n = 8 * hf + n8; f32x4 o = (f32x4){0.f, 0.f, 0.f, 0.f};
#pragma unroll
                for (int s = 0; s < 8; ++s) { const bf16x8 vf = *(const LAS bf16x8*)(size_t)(vb + (unsigned)((16 * n8 * RS + 32 * s) * 2));
                    o = __builtin_amdgcn_mfma_f32_16x16x32_bf16(vf, pf[s], o, 0, 0, 0); }
                u32x2 w; w.x = pk2(o.x * inv, o.y * inv); w.y = pk2(o.z * inv, o.w * inv);
                *(u32x2*)(OX + tok * 1024 + h * 256 + 16 * n + 4 * fq) = w;
                if (n & 1) asm volatile("" ::: "memory"); }
        }
    }
    __syncthreads();
}

__device__ __forceinline__ void phase_route(KArgs A, int wv_, int L, LAS unsigned char* lds) {
    const int tid_ = opaque_tid(wv_); const int wid = __builtin_amdgcn_readfirstlane(tid_ >> 6), lane = tid_ & 63;
    unsigned char* ws = opq(A->ws);
    const float* RW = (const float*)(ws + WS_RW) + (size_t)L * NEXP * D;
    unsigned* cnt = (unsigned*)(ws + WS_CTL) + CW_CNT + L * 64;
    int* list = (int*)(ws + WS_LIST); int* te = (int*)(ws + WS_TOK); int* tp = te + 2 * T; float* tw = (float*)(tp + 2 * T);
    bf16* XN = (bf16*)(ws + WS_XN);
    LAS float* rwl = (LAS float*)lds;
    LAS unsigned* lcnt = (LAS unsigned*)(lds + 65536);
    LAS unsigned* lbase = lcnt + 16;
    const float rbv = A->in[I_RB][lane >> 2];
    for (int e4 = tid_; e4 < NEXP * D / 4; e4 += 512) *(LAS f32x4*)(rwl + 4 * e4) = *(const f32x4*)(RW + 4 * e4);
    for (int blk = blockIdx.x; blk < T / 64; blk += gridDim.x) {
        __syncthreads();
        if (tid_ < 16) lcnt[tid_] = 0u;
        __syncthreads();
        int e0s = 0, e1s = 0, r0s = 0, r1s = 0; float w0s = 0.f;
        f32x4 v[4], vn[4];
#pragma unroll
        for (int j = 0; j < 4; ++j) v[j] = ((const f32x4*)(A->out + (size_t)(blk * 64 + wid * 8) * D) + lane)[64 * j];
#pragma unroll 1
        for (int q = 0; q < 8; ++q) {
            const int t = blk * 64 + wid * 8 + q;
            { const f32x4* xn_ = (const f32x4*)(A->out + (size_t)(t + (q < 7 ? 1 : 0)) * D) + lane;
#pragma unroll
              for (int j = 0; j < 4; ++j) vn[j] = xn_[64 * j]; }
            float s = 0.f;
#pragma unroll
            for (int j = 0; j < 4; ++j) s += (v[j].x * v[j].x + v[j].y * v[j].y) + (v[j].z * v[j].z + v[j].w * v[j].w);
            const float rstd = rsqrtf(wave_sum(s) * (1.f / 1024.f) + EPS);
            u32x2* o8 = (u32x2*)(XN + (size_t)t * D) + lane;
#pragma unroll
            for (int j = 0; j < 4; ++j) { u32x2 w; w.x = pk2(v[j].x * rstd, v[j].y * rstd); w.y = pk2(v[j].z * rstd, v[j].w * rstd); o8[64 * j] = w; }
            float a[16];
#pragma unroll
            for (int e = 0; e < 16; ++e) {
                const LAS f32x4* wr = (const LAS f32x4*)(rwl + e * D) + lane; float acc = 0.f;
#pragma unroll
                for (int j = 0; j < 4; ++j) { const f32x4 w = wr[64 * j]; acc += (v[j].x * w.x + v[j].y * w.y) + (v[j].z * w.z + v[j].w * w.w); }
                a[e] = acc;
            }
            float a8[8], a4[4], a2[2], a1;
            { const bool up = lane & 32;
#pragma unroll
              for (int k = 0; k < 8; ++k) { const float send = up ? a[k] : a[k + 8], keep = up ? a[k + 8] : a[k]; a8[k] = keep + __shfl_xor(send, 32); } }
            { const bool up = lane & 16;
#pragma unroll
              for (int k = 0; k < 4; ++k) { const float send = up ? a8[k] : a8[k + 4], keep = up ? a8[k + 4] : a8[k]; a4[k] = keep + __shfl_xor(send, 16); } }
            { const bool up = lane & 8;
#pragma unroll
              for (int k = 0; k < 2; ++k) { const float send = up ? a4[k] : a4[k + 2], keep = up ? a4[k + 2] : a4[k]; a2[k] = keep + __shfl_xor(send, 8); } }
            { const bool up = lane & 4; const float send = up ? a2[0] : a2[1], keep = up ? a2[1] : a2[0]; a1 = keep + __shfl_xor(send, 4); }
            a1 += __shfl_xor(a1, 2); a1 += __shfl_xor(a1, 1);
            const float lg = a1 * rstd + rbv;
            const float v0 = wave_max(lg);
            const int e0 = (__ffsll((unsigned long long)__ballot(lg == v0)) - 1) >> 2;
            const int gidx = e0 >> 2;
            const bool c2 = (lane >> 4) == gidx && (lane >> 2) != e0;
            const float m2 = c2 ? lg : -INFINITY;
            const float v1 = wave_max(m2);
            const int e1 = (__ffsll((unsigned long long)__ballot(c2 && m2 == v1)) - 1) >> 2;
            const float w0 = 1.f / (1.f + __expf(v1 - v0));
            unsigned r0 = 0, r1 = 0;
            if (lane == 0) { r0 = atomicAdd((unsigned*)(lcnt + e0), 1u); r1 = atomicAdd((unsigned*)(lcnt + e1), 1u); }
            r0 = __builtin_amdgcn_readfirstlane(r0); r1 = __builtin_amdgcn_readfirstlane(r1);
            if (lane == q) { e0s = e0; e1s = e1; r0s = (int)r0; r1s = (int)r1; w0s = w0; }
#pragma unroll
            for (int j = 0; j < 4; ++j) v[j] = vn[j];
        }
        __syncthreads();
        if (tid_ < 16) lbase[tid_] = atomicAdd(&cnt[tid_], lcnt[tid_]);
        __syncthreads();
        if (lane < 8) {
            const int t = blk * 64 + wid * 8 + lane;
            const int p0 = (int)lbase[e0s] + r0s, p1 = (int)lbase[e1s] + r1s;
            list[e0s * T + p0] = t; list[e1s * T + p1] = t;
            te[2 * t] = e0s; te[2 * t + 1] = e1s; tp[2 * t] = p0; tp[2 * t + 1] = p1; tw[2 * t] = w0s; tw[2 * t + 1] = 1.f - w0s;
        }
    }
    __syncthreads();
}
__device__ __forceinline__ void moe_offsets(KArgs A, int wv_, int L, LAS int* off, LAS int* cn) {
    if (opaque_tid(wv_) == 0) {
        const unsigned* cnt = (const unsigned*)(opq(A->ws) + WS_CTL) + CW_CNT + L * 64;
        int o = 0;
        for (int e = 0; e < 16; ++e) { const int c = (int)__hip_atomic_load(cnt + e, __ATOMIC_RELAXED, __HIP_MEMORY_SCOPE_AGENT); off[e] = o; cn[e] = c; o += (c + 255) & ~255; }
        off[16] = o;
    }
    __syncthreads();
}
__device__ __forceinline__ void phase_moe_combine(KArgs A, int wv_, int L, LAS unsigned char* lds) {
    LAS int* off = (LAS int*)lds; LAS int* cn = off + 32;
    moe_offsets(A, wv_, L, off, cn);
    const int tid_ = opaque_tid(wv_); const int wid = __builtin_amdgcn_readfirstlane(tid_ >> 6), lane = tid_ & 63; const int gw = blockIdx.x * 8 + wid, NGW = gridDim.x * 8;
    unsigned char* ws = opq(A->ws);
    const int* te = (const int*)(ws + WS_TOK); const int* tp = te + 2 * T; const float* tw = (const float*)(tp + 2 * T);
    const bf16* Y = (const bf16*)(ws + WS_Y); bf16* XN = (bf16*)(ws + WS_XN);
    const int nq = (T - gw + NGW - 1) / NGW;
    for (int q0 = 0; q0 < nq; q0 += 8) {
        int s0m = 0, s1m = 0; float w0m = 0.f, w1m = 0.f;
        { const int qq = q0 + (lane & 7); const int t = gw + NGW * (qq < nq ? qq : nq - 1);
          s0m = off[te[2 * t]] + tp[2 * t]; s1m = off[te[2 * t + 1]] + tp[2 * t + 1]; w0m = tw[2 * t]; w1m = tw[2 * t + 1]; }
        const int nn = nq - q0 < 8 ? nq - q0 : 8;
        f32x4 v[4], vn[4]; u32x2 ya[4], yb[4], yan[4], ybn[4];
        { const int t = gw + NGW * q0; const int sl0 = __builtin_amdgcn_readlane(s0m, 0), sl1 = __builtin_amdgcn_readlane(s1m, 0);
#pragma unroll
          for (int j = 0; j < 4; ++j) { v[j] = ((const f32x4*)(A->out + (size_t)t * D) + lane)[64 * j]; ya[j] = ((const u32x2*)(Y + (size_t)sl0 * D) + lane)[64 * j]; yb[j] = ((const u32x2*)(Y + (size_t)sl1 * D) + lane)[64 * j]; } }
#pragma unroll 1
        for (int q = 0; q < nn; ++q) {
            const int t = gw + NGW * (q0 + q);
            const int qn = q + 1 < nn ? q + 1 : q;
            { const int tn = gw + NGW * (q0 + qn); const int sl0 = __builtin_amdgcn_readlane(s0m, qn), sl1 = __builtin_amdgcn_readlane(s1m, qn);
#pragma unroll
              for (int j = 0; j < 4; ++j) { vn[j] = ((const f32x4*)(A->out + (size_t)tn * D) + lane)[64 * j]; yan[j] = ((const u32x2*)(Y + (size_t)sl0 * D) + lane)[64 * j]; ybn[j] = ((const u32x2*)(Y + (size_t)sl1 * D) + lane)[64 * j]; } }
            const float w0 = __builtin_bit_cast(float, __builtin_amdgcn_readlane(__builtin_bit_cast(int, w0m), q)), w1 = __builtin_bit_cast(float, __builtin_amdgcn_readlane(__builtin_bit_cast(int, w1m), q));
            float s = 0.f;
#pragma unroll
            for (int j = 0; j < 4; ++j) {
                v[j].x += w0 * bflo(ya[j].x) + w1 * bflo(yb[j].x); v[j].y += w0 * bfhi(ya[j].x) + w1 * bfhi(yb[j].x); v[j].z += w0 * bflo(ya[j].y) + w1 * bflo(yb[j].y); v[j].w += w0 * bfhi(ya[j].y) + w1 * bfhi(yb[j].y);
                s += (v[j].x * v[j].x + v[j].y * v[j].y) + (v[j].z * v[j].z + v[j].w * v[j].w);
            }
            const float rstd = rsqrtf(wave_sum(s) * (1.f / 1024.f) + EPS);
            f32x4* xr = (f32x4*)(A->out + (size_t)t * D) + lane; u32x2* o8 = (u32x2*)(XN + (size_t)t * D) + lane;
#pragma unroll
            for (int j = 0; j < 4; ++j) { xr[64 * j] = v[j]; u32x2 w; w.x = pk2(v[j].x * rstd, v[j].y * rstd); w.y = pk2(v[j].z * rstd, v[j].w * rstd); o8[64 * j] = w; }
#pragma unroll
            for (int j = 0; j < 4; ++j) { v[j] = vn[j]; ya[j] = yan[j]; yb[j] = ybn[j]; }
        }
    }
}

constexpr int PH_PER_EVEN = 5 + 8, PH_PER_ODD = 3 + 8;
constexpr int NPHASES = 3 + 2 * (PH_PER_EVEN + PH_PER_ODD);

__global__ void __launch_bounds__(512, 2) mk_fwd(Args Araw) {
    KArgs A0 = kargs();
    extern __shared__ __attribute__((aligned(16))) unsigned char lds_raw[];
    LAS unsigned char* lds = (LAS unsigned char*)lds_raw;
    volatile LAS unsigned* misc = (volatile LAS unsigned*)(lds + LDS_MISC);
    const int tid = threadIdx.x;
    if (tid < 16) misc[tid] = 0u;
    __syncthreads();
    const int lo = A0->ph_lo, hi = A0->ph_hi;
    const int wv_ = __builtin_amdgcn_readfirstlane(threadIdx.x >> 6);
    if (hi - lo > 1) (void)xcd_barrier_post((unsigned*)(A0->ws + WS_CTL) + CW_BAR, misc);
    int ph = 0;
    unsigned long long tacc_ = 0;
#define PH_BEGIN(k) if (ph >= lo && ph < hi) { const bool tprobe_ = (PROBE_TMASK >> (k)) & 1; unsigned long long tp0_ = 0; if (PROBE_TMASK && tprobe_) tp0_ = __builtin_amdgcn_s_memrealtime(); KArgs A = kargs(); unsigned char* ws = opq(A->ws); _Pragma("unroll 1") for (int rep_ = 0; rep_ < (((PROBE_MASK >> (k)) & 1) ? PROBE_REPS : 1); ++rep_)
#define PH_END   if (ph + 1 < hi) { XcdBarrier b_; b_.bar = (unsigned*)(opq(kargs()->ws) + WS_CTL) + CW_BAR; b_.x = xb_xcc_id(); b_.st = misc; xcd_barrier(b_, opaque_tid(wv_) == 0); } if (PROBE_TMASK && tprobe_) tacc_ += __builtin_amdgcn_s_memrealtime() - tp0_; } ++ph;
    const int G = gridDim.x, cb = blockIdx.x;

    PH_BEGIN(0) phase_prologue(A, wv_, lds); PH_END
    PH_BEGIN(1) {
        pg8::DenseOrder S; S.init(NBATCH * NMEM, 8192, D, (const bf16*)(ws + WS_WKV), G, cb);
        pg8::EpiBf16<0> E{(bf16*)(ws + WS_KV), 8192, 32, 0};
        pg8::gemm_phase(lds, (const bf16*)(ws + WS_MN), D, S, E, wv_);
    } PH_END
    PH_BEGIN(2) { phase_knorm(A, wv_); phase_vtrans(A, wv_, lds); } PH_END

    for (int L = 0; L < DEPTH; ++L) {
        const int i = L >> 1;
        if ((L & 1) == 0) {
            PH_BEGIN(3) {
                pg8::DenseOrder S; S.init(T, HYN, D, (const bf16*)(ws + WS_WHYB) + (size_t)i * HYN * D, G, cb);
                pg8::EpiBf16<0> E{(bf16*)(ws + WS_BIG), HYN, 12, 0};
                pg8::gemm_phase(lds, (const bf16*)(ws + WS_XN), D, S, E, wv_);
            } PH_END
            PH_BEGIN(4) { phase_compress_mfma(A, wv_, i, lds); phase_nsa_prep(A, wv_, i, lds); phase_vtiles(A, wv_, lds); } PH_END
            PH_BEGIN(5) { phase_gla_a(A, wv_, i, lds); __syncthreads(); phase_nsa_attn_mfma(A, wv_, i, lds); } PH_END
            PH_BEGIN(6) phase_gla_c(A, wv_, i, lds); PH_END
            PH_BEGIN(7) {
                pg8::DenseOrder S; S.init(T, D, D, (const bf16*)(ws + WS_WHOUT) + (size_t)i * D * D, G, cb);
                pg8::EpiResAdd E{A->out, D};
                pg8::gemm_phase(lds, (const bf16*)(ws + WS_CAT), D, S, E, wv_);
            } PH_END
        } else {
            PH_BEGIN(8) {
                pg8::DenseOrder S; S.init(T, 4096, D, (const bf16*)(ws + WS_WSGIN) + (size_t)i * 4096 * D, G, cb);
                pg8::EpiBf16<1> E{(bf16*)(ws + WS_U), 2048, 8, (size_t)(WS_V - WS_U) / 2};
                pg8::gemm_phase(lds, (const bf16*)(ws + WS_XN), D, S, E, wv_);
            } PH_END
            PH_BEGIN(9) phase_sgu_mix_mfma(A, wv_, i, lds); PH_END
            PH_BEGIN(10) {
                pg8::DenseOrder S; S.init(T, D, 2048, (const bf16*)(ws + WS_WSGOUT) + (size_t)i * D * 2048, G, cb);
                pg8::EpiResAdd E{A->out, D};
                pg8::gemm_phase(lds, (const bf16*)(ws + WS_UM), 2048, S, E, wv_);
            } PH_END
        }
        PH_BEGIN(11) phase_rownorm(A, wv_); PH_END
        PH_BEGIN(12) {
            pg8::DenseOrder S; S.init(T, D, D, (const bf16*)(ws + WS_WQ) + (size_t)L * D * D, G, cb);
            pg8::EpiBf16<0> E{(bf16*)(ws + WS_QX), D, 4, 0};
            pg8::gemm_phase(lds, (const bf16*)(ws + WS_XN), D, S, E, wv_);
        } PH_END
        PH_BEGIN(13) phase_xattn_mfma(A, wv_, L, lds); PH_END
        PH_BEGIN(14) {
            pg8::DenseOrder S; S.init(T, D, D, (const bf16*)(ws + WS_WO) + (size_t)L * D * D, G, cb);
            pg8::EpiResAdd E{A->out, D};
            pg8::gemm_phase(lds, (const bf16*)(ws + WS_OX), D, S, E, wv_);
        } PH_END
        PH_BEGIN(15) phase_route(A, wv_, L, lds); PH_END
        PH_BEGIN(16) {
            LAS int* off = (LAS int*)(lds + pg8::STAGE_BYTES); LAS int* cn = off + 32;
            moe_offsets(A, wv_, L, off, cn);
            pg8::MoeOrder<true> S{(off[16] / 256) * 3, 3, G, cb, D, off, cn, (const int*)(ws + WS_LIST), (const char*)(ws + WS_WMIN) + (size_t)L * 16 * 768 * D * 2, (size_t)768 * D * 2};
            pg8::EpiSwiglu E{(bf16*)(ws + WS_H), DEXP};
            pg8::gemm_phase(lds, (const bf16*)(ws + WS_XN), D, S, E, wv_);
        } PH_END
        PH_BEGIN(17) {
            LAS int* off = (LAS int*)(lds + pg8::STAGE_BYTES); LAS int* cn = off + 32;
            moe_offsets(A, wv_, L, off, cn);
            pg8::MoeOrder<false> S{(off[16] / 256) * 4, 4, G, cb, DEXP, off, cn, (const int*)(ws + WS_LIST), (const char*)(ws + WS_WMOUT) + (size_t)L * 16 * D * DEXP * 2, (size_t)D * DEXP * 2};
            pg8::EpiBf16<0> E{(bf16*)(ws + WS_Y), D, 4, 0};
            pg8::gemm_phase(lds, (const bf16*)(ws + WS_H), DEXP, S, E, wv_);
        } PH_END
        PH_BEGIN(18) phase_moe_combine(A, wv_, L, lds); PH_END
    }
#undef PH_BEGIN
#undef PH_END
    if (PROBE_TMASK && blockIdx.x == 0) { const unsigned long long t0 = __builtin_amdgcn_s_memrealtime(); while (__builtin_amdgcn_s_memrealtime() - t0 < tacc_) __builtin_amdgcn_s_sleep(8); }
}

extern "C" void kernel_launch(void* const* d_in, const int* in_sizes, int n_in, void* d_out, int out_size, void* d_ws, size_t ws_size, hipStream_t stream) {
    static int grid = 0;
    if (grid == 0) {
        if (n_in != N_IN || out_size != T * D || ws_size < WS_END) { fprintf(stderr, "kernel_launch: unexpected problem (n_in %d, out %d, ws %zu)\n", n_in, out_size, ws_size); grid = -1; return; }
        int dev = 0, cus = 0, per_cu = 0;
        if (hipGetDevice(&dev) != hipSuccess || hipDeviceGetAttribute(&cus, hipDeviceAttributeMultiprocessorCount, dev) != hipSuccess) { grid = -1; return; }
        if (hipFuncSetAttribute((const void*)mk_fwd, hipFuncAttributeMaxDynamicSharedMemorySize, LDS_BYTES) != hipSuccess) { fprintf(stderr, "kernel_launch: hipFuncSetAttribute failed\n"); grid = -1; return; }
        if (hipOccupancyMaxActiveBlocksPerMultiprocessor(&per_cu, (const void*)mk_fwd, 512, LDS_BYTES) != hipSuccess || per_cu < 1) fprintf(stderr, "kernel_launch: occupancy query says %d\n", per_cu);
        (void)hipGetLastError();
        grid = cus;
    }
    if (grid < 0) return;
    (void)hipMemsetAsync((char*)d_ws + WS_CTL, 0, CTL_BYTES, stream);
    Args a{};
    for (int i = 0; i < N_IN; ++i) a.in[i] = (const float*)d_in[i];
    a.out = (float*)d_out; a.ws = (unsigned char*)d_ws;
    for (int j = 0; j < 32; ++j) a.freq[j] = (float)pow(10000.0, -(double)j / 32.0);
#if MK_ONE_LAUNCH
    a.ph_lo = 0; a.ph_hi = NPHASES;
    hipLaunchKernelGGL(mk_fwd, dim3(grid), dim3(512), LDS_BYTES, stream, a);
#else
    for (int p = 0; p < NPHASES; ++p) { a.ph_lo = p; a.ph_hi = p + 1; hipLaunchKernelGGL(mk_fwd, dim3(grid), dim3(512), LDS_BYTES, stream, a); }
#endif
}
```

```cpp
#include <hip/hip_runtime.h>
#include <stdint.h>
#include <stdio.h>
#include <math.h>

#ifndef PROBE_MASK
#define PROBE_MASK 0
#endif
#ifndef PROBE_TMASK
#define PROBE_TMASK 0
#endif
#ifndef PROBE_REPS
#define PROBE_REPS 2
#endif
#ifndef MK_ONE_LAUNCH
#define MK_ONE_LAUNCH 1
#endif

#define LAS __attribute__((address_space(3)))
typedef unsigned short bf16;
typedef short bf16x8 __attribute__((ext_vector_type(8)));
typedef float f32x4 __attribute__((ext_vector_type(4)));
typedef float f32x2 __attribute__((ext_vector_type(2)));
typedef unsigned u32x4 __attribute__((ext_vector_type(4)));
typedef unsigned u32x2 __attribute__((ext_vector_type(2)));

constexpr int T = 16384, D = 1024, NBATCH = 8, S = 2048, DEPTH = 4;
constexpr int NMEM = 256;
constexpr float EPS = 1e-6f;
constexpr int HYN = 3072, HYSRC = 2856;
constexpr int C_QA = 0, C_KC = 512, C_VC = 640, C_KS = 768, C_VS = 896, C_KW = 1024, C_VW = 1152, C_QB = 1280, C_KB = 1536, C_VB = 1792, C_RB = 2304, C_GA = 2816, C_AL = 2840;
constexpr int NCMP = 127;
constexpr int NEXP = 16, DEXP = 384;
constexpr int SLOTS = 2 * T + NEXP * 256;

enum { I_X = 0, I_MEM, I_POS, I_NMIX, I_NXAT, I_NMEM, I_NFFN, I_HYBIN, I_HYBOUT, I_QNORM, I_KNORM, I_CMPPE, I_CMPW1, I_CMPW2, I_GATEB, I_WA2, I_BA, I_ONORM,
       I_SGIN, I_LNG, I_LNB, I_SGWS, I_SGBS, I_SGOUT, I_XWQ, I_XWKV, I_XWO, I_XQN, I_XKN, I_RW, I_RB, I_MOEIN, I_MOEOUT, N_IN };

constexpr size_t MiB = 1u << 20;
constexpr size_t WS_CTL = 0, CTL_BYTES = 1 * MiB;
constexpr size_t WS_WHYB = 1 * MiB;
constexpr size_t WS_WHOUT = WS_WHYB + 12 * MiB;
constexpr size_t WS_WSGIN = WS_WHOUT + 4 * MiB;
constexpr size_t WS_WSGOUT = WS_WSGIN + 16 * MiB;
constexpr size_t WS_WQ = WS_WSGOUT + 8 * MiB;
constexpr size_t WS_WKV = WS_WQ + 8 * MiB;
constexpr size_t WS_WO = WS_WKV + 16 * MiB;
constexpr size_t WS_WMIN = WS_WO + 8 * MiB;
constexpr size_t WS_WMOUT = WS_WMIN + 96 * MiB;
constexpr size_t WS_RW = WS_WMOUT + 48 * MiB;
constexpr size_t WS_XN = WS_RW + 1 * MiB;
constexpr size_t WS_BIG = WS_XN + 32 * MiB;
constexpr size_t WS_QA = WS_BIG + 128 * MiB;
constexpr size_t WS_KS = WS_QA + 16 * MiB;
constexpr size_t WS_KW = WS_KS + 4 * MiB;
constexpr size_t WS_KC = WS_KW + 4 * MiB;
constexpr size_t WS_VC = WS_KC + 1 * MiB;
constexpr size_t WS_CAT = WS_VC + 1 * MiB;
constexpr size_t WS_QX = WS_CAT + 32 * MiB;
constexpr size_t WS_OX = WS_QX + 32 * MiB;
constexpr size_t WS_MN = WS_OX + 32 * MiB;
constexpr size_t WS_KV = WS_MN + 4 * MiB;
constexpr size_t WS_COS = WS_KV + 32 * MiB;
constexpr size_t WS_SIN = WS_COS + 2 * MiB;
constexpr size_t WS_LIST = WS_SIN + 2 * MiB;
constexpr size_t WS_TOK = WS_LIST + 1 * MiB;
constexpr size_t WS_VT = WS_TOK + 1 * MiB;
constexpr size_t WS_VTA = WS_VT + 16 * MiB;
constexpr size_t WS_SLOC = WS_VTA + 32 * MiB;
constexpr size_t WS_DEC = WS_SLOC + 32 * MiB;
constexpr size_t WS_STT = WS_DEC + 1 * MiB;
constexpr size_t WS_WSB = WS_STT + 16 * MiB;
constexpr size_t WS_M0 = WS_WSB + 768 * 1024;
constexpr size_t WS_W1T = WS_WSB + 1 * MiB;
constexpr size_t WS_END = WS_W1T + 1 * MiB;
constexpr size_t WS_Y = WS_BIG, WS_H = WS_BIG + 72 * MiB, WS_U = WS_BIG, WS_V = WS_BIG + 64 * MiB, WS_UM = WS_QX;
constexpr int CW_BAR = 4096;
constexpr int CW_CNT = 8192;

constexpr int LDS_BYTES = 159744;
constexpr int LDS_MISC = LDS_BYTES - 64;

__device__ __forceinline__ unsigned pk2(float lo, float hi) { unsigned r; asm volatile("v_cvt_pk_bf16_f32 %0, %1, %2" : "=v"(r) : "v"(lo), "v"(hi)); return r; }
__device__ __forceinline__ unsigned f2bf(float f) { unsigned u = __float_as_uint(f); return (u + 0x7fffu + ((u >> 16) & 1u)) >> 16; }
__device__ __forceinline__ float bf2f(unsigned b) { return __uint_as_float(b << 16); }
__device__ __forceinline__ float bflo(unsigned w) { return __uint_as_float(w << 16); }
__device__ __forceinline__ float bfhi(unsigned w) { return __uint_as_float(w & 0xffff0000u); }
__device__ __forceinline__ float wave_sum(float v) {
#pragma unroll
    for (int o = 1; o < 64; o <<= 1) v += __shfl_xor(v, o);
    return v;
}
__device__ __forceinline__ float wave_max(float v) {
#pragma unroll
    for (int o = 1; o < 64; o <<= 1) v = fmaxf(v, __shfl_xor(v, o));
    return v;
}
__device__ __forceinline__ int opaque_tid(int wv) { int l; asm volatile("v_mbcnt_lo_u32_b32 %0, -1, 0\n\tv_mbcnt_hi_u32_b32 %0, -1, %0" : "=v"(l)); return wv * 64 + l; }
__device__ __forceinline__ unsigned char* opq(unsigned char* p) { asm volatile("" : "+s"(p)); return p; }
#define LDS_WAIT() asm volatile("s_waitcnt lgkmcnt(0)" ::: "memory")
__device__ __forceinline__ float gelu_tanh(float x) {
    const float u = 0.7978845608028654f * (x + 0.044715f * x * x * x);
    const float e = __expf(-2.0f * fabsf(u));
    float t = (1.0f - e) / (1.0f + e); t = u < 0.f ? -t : t;
    return 0.5f * x * (1.0f + t);
}
__device__ __forceinline__ float sigmoidf_(float x) { return 1.0f / (1.0f + __expf(-x)); }

#define XB_TMO      128
#define XB_XCNT(j)  (256  + 64 * (j))
#define XB_XSUB(j)  (1280 + 64 * (j))
#define XB_XGEN(j)  (2304 + 64 * (j))
#define XB_TOP      3328
#define XB_TOPGEN   3392
#define XCD_BAR_WORDS 3456
#define XB_SPIN_CAP (1u << 22)

__device__ __forceinline__ unsigned xb_ld(unsigned* p)              { return __hip_atomic_load(p, __ATOMIC_RELAXED, __HIP_MEMORY_SCOPE_AGENT); }
__device__ __forceinline__ unsigned xb_add(unsigned* p, unsigned v) { return __hip_atomic_fetch_add(p, v, __ATOMIC_RELAXED, __HIP_MEMORY_SCOPE_AGENT); }
__device__ __forceinline__ unsigned xb_xcc_id() { return (unsigned)__builtin_amdgcn_s_getreg((3 << 11) | 20) & 0xFu; }
#define XB_SPIN(cond, bar) do { unsigned _sp = 0; while (cond) { __builtin_amdgcn_s_sleep(1); \
    if ((++_sp & 255u) == 0u) { if (xb_ld(&(bar)[XB_TMO])) break; if (_sp > XB_SPIN_CAP) { atomicAdd(&(bar)[XB_TMO], 1u); break; } } } } while (0)

struct XcdBarrier { unsigned* bar; unsigned x; volatile LAS unsigned* st; };
__device__ __forceinline__ unsigned* xb_opaque(unsigned* p) { unsigned long long v = (unsigned long long)p; unsigned lo = __builtin_amdgcn_readfirstlane((unsigned)v), hi = __builtin_amdgcn_readfirstlane((unsigned)(v >> 32));
    asm volatile("" : "+s"(lo), "+s"(hi)); return (unsigned*)(((unsigned long long)hi << 32) | lo); }

__device__ __forceinline__ XcdBarrier xcd_barrier_post(unsigned* bar, volatile LAS unsigned* st) {
    XcdBarrier b; b.bar = bar; b.x = xb_xcc_id(); b.st = st;
    if (threadIdx.x == 0) (void)xb_add(&bar[XB_XCNT(b.x)], 1u);
    return b;
}
__device__ __forceinline__ void xcd_barrier_complete(unsigned* bar, unsigned x, unsigned& nloc, unsigned& nx) {
    const unsigned G = gridDim.x * gridDim.y * gridDim.z;
    unsigned sum, cnt, mine, sp = 0u;
    for (;;) {
        sum = 0u; cnt = 0u; mine = 0u;
#pragma unroll
        for (unsigned j = 0; j < 16; ++j) { const unsigned c = xb_ld(&bar[XB_XCNT(j)]); sum += c; cnt += (c > 0u) ? 1u : 0u; mine = (j == x) ? c : mine; }
        if (sum == G) break;
        __builtin_amdgcn_s_sleep(1);
        if ((++sp & 255u) == 0u) { if (xb_ld(&bar[XB_TMO])) break; if (sp > XB_SPIN_CAP) { atomicAdd(&bar[XB_TMO], 1u); break; } }
    }
    nloc = mine > 0u ? mine : 1u; nx = cnt > 0u ? cnt : 1u;
}
__device__ __forceinline__ void xcd_barrier(const XcdBarrier& b, const bool is_t0) {
    asm volatile("s_waitcnt vmcnt(0)" ::: "memory");
    __syncthreads();
    if (is_t0) {
        unsigned* bar = b.bar;
        __builtin_amdgcn_s_waitcnt(0);
        unsigned nloc = b.st[0], nx = b.st[1];
        if (nloc == 0u) { xcd_barrier_complete(bar, b.x, nloc, nx); b.st[0] = nloc; b.st[1] = nx; }
        const unsigned old = xb_add(&bar[XB_XSUB(b.x)], 1u);
        const unsigned gen = old / nloc;
        if (old + 1u == (gen + 1u) * nloc) {
            __builtin_amdgcn_fence(__ATOMIC_RELEASE, "agent");
            asm volatile("s_waitcnt vmcnt(0)" ::: "memory");
            const unsigned og = xb_add(&bar[XB_TOP], 1u);
            const unsigned tg = og / nx;
            if (og + 1u == (tg + 1u) * nx) xb_add(&bar[XB_TOPGEN], 1u);
            else XB_SPIN(xb_ld(&bar[XB_TOPGEN]) == tg, bar);
            __builtin_amdgcn_fence(__ATOMIC_ACQUIRE, "agent");
            xb_add(&bar[XB_XGEN(b.x)], 1u);
            asm volatile("s_waitcnt vmcnt(0)" ::: "memory");
        } else {
            XB_SPIN(xb_ld(&bar[XB_XGEN(b.x)]) == gen, bar);
            __builtin_amdgcn_fence(__ATOMIC_ACQUIRE, "agent");
            asm volatile("s_waitcnt vmcnt(0)" ::: "memory");
        }
    }
    __syncthreads();
}

struct Args {
    const float* in[N_IN];
    float* out;
    unsigned char* ws;
    float freq[32];
    int ph_lo, ph_hi;
};

typedef const __attribute__((address_space(4))) Args* KArgs;
__device__ __forceinline__ KArgs kargs() { KArgs p = (KArgs)__builtin_amdgcn_kernarg_segment_ptr(); asm volatile("" : "+s"(p)); return p; }

__device__ __forceinline__ void st_bf16x4(bf16* p, f32x4 v) { u32x2 w; w.x = pk2(v[0], v[1]); w.y = pk2(v[2], v[3]); *(u32x2*)p = w; }


namespace pg8 {
constexpr int BM = 256, BK = 64, HALF = 128, HTB = HALF * BK * 2, STAGE_BYTES = 8 * HTB, NXCD = 8, WGM = 8;
__host__ __device__ __forceinline__ int lds_byte(int r, int c) { const int st = (r >> 4) * 2 + (c >> 5), rr = r & 15, cc = c & 31, ob = rr * 64 + cc * 2; return st * 1024 + (ob ^ (((ob >> 9) & 1) << 5)); }
__host__ __device__ __forceinline__ void stage_rc(int b, int& R, int& C) { const int st = b / 1024, sb = b % 1024, swz = sb ^ (((sb >> 9) & 1) << 5); R = (st >> 1) * 16 + swz / 64; C = (st & 1) * 32 + (swz % 64) / 2; }
__host__ __device__ __forceinline__ int perm32(int rho) { const int n = rho >> 4, i = rho & 15; return 8 * (i >> 2) + 4 * n + (i & 3); }
struct Unit { int pm, pn, e; };
struct DenseOrder {
    static constexpr bool GATHER = false;
    int nM, nN, nwg, G, c, K; const char* Bt;
    __device__ __forceinline__ void init(int M, int N, int K_, const bf16* Bt_, int G_, int c_) { nM = M / BM; nN = N / BM; nwg = nM * nN; G = G_; c = c_; K = K_; Bt = (const char*)Bt_; }
    __device__ __forceinline__ bool next(int i, Unit& u) const {
        const long L = (long)i * G + c; if (L >= nwg) return false;
        int wgid = (int)L; { const int q = nwg / NXCD, r = nwg % NXCD, xcd = wgid % NXCD, off = wgid / NXCD; wgid = (xcd < r ? xcd * (q + 1) : r * (q + 1) + (xcd - r) * q) + off; }
        const int nig = WGM * nN, gid = wgid / nig, fm = gid * WGM, gsz = (nM - fm) < WGM ? (nM - fm) : WGM;
        u.pm = fm + ((wgid % nig) % gsz); u.pn = (wgid % nig) / gsz; u.e = 0; return true;
    }
    __device__ __forceinline__ unsigned a_voff(const Unit& u, int half, int R) const { return (unsigned)((u.pm * BM + half * HALF + R) * K) * 2u; }
    __device__ __forceinline__ const char* b_tile(const Unit& u) const { return Bt + (size_t)u.pn * BM * K * 2; }
};
template <bool GATH> struct MoeOrder {
    static constexpr bool GATHER = GATH;
    int nunits, ntn, G, c, K; const LAS int* off; const LAS int* cn; const int* list; const char* Bt; size_t estride;
    __device__ __forceinline__ bool next(int i, Unit& u) const {
        const int L = i * G + c; if (L >= nunits) return false;
        u.pm = L / ntn; u.pn = L % ntn; const int s0 = u.pm * BM; int e = 0;
#pragma unroll
        for (int q = 1; q < 16; ++q) e += (s0 >= off[q]) ? 1 : 0;
        u.e = e; return true;
    }
    __device__ __forceinline__ unsigned a_voff(const Unit& u, int half, int R) const {
        const int slot = u.pm * BM + half * HALF + R;
        const int loc = slot - off[u.e]; const int tk = list[u.e * T + (loc < cn[u.e] ? loc : 0)];
        return (unsigned)(tk * K) * 2u;
    }
    __device__ __forceinline__ const char* b_tile(const Unit& u) const { return Bt + (size_t)u.e * estride + (size_t)u.pn * BM * K * 2; }
};
__device__ __forceinline__ unsigned cvt_pk_bf16(float lo, float hi) { unsigned r; asm volatile("v_cvt_pk_bf16_f32 %0, %1, %2" : "=v"(r) : "v"(lo), "v"(hi)); return r; }

template <class Epi, class Sched>
__device__ __forceinline__ void gemm_phase(LAS unsigned char* lds, const bf16* Aptr, int K, const Sched& S, const Epi& E, int wv_) {
    const int tid = opaque_tid(wv_), wid = __builtin_amdgcn_readfirstlane(tid >> 6), lane = tid & 63, wr = wid >> 2, wc = wid & 3, fr = lane & 15, fq = lane >> 4;
    const int nt = K / BK;
    int Rr[2], Cc[2]; unsigned voffA[2], voffB[2];
#pragma unroll
    for (int i = 0; i < 2; ++i) { stage_rc(tid * 16 + i * 8192, Rr[i], Cc[i]); const int Rb = Epi::PERM ? ((Rr[i] & ~31) + perm32(Rr[i] & 31)) : Rr[i];
        voffA[i] = (unsigned)(Rr[i] * K + Cc[i]) * 2u; voffB[i] = (unsigned)(Rb * K + Cc[i]) * 2u; }
    const size_t kstep = (size_t)(BK * 2);
    const size_t hstep = (size_t)HALF * K * 2;
    const size_t tstep = 2 * hstep;
    const unsigned ldsw = (unsigned)wid * 1024u;
    const int aoff = lds_byte(wr * 64 + fr, fq * 8), boff = lds_byte(wc * 32 + fr, fq * 8);
    const char* const Ab = (const char*)Aptr;
#define PG8_SA(b, h) (((b) * 2 + (h)) * HTB)
#define PG8_SB(b, h) ((4 + (b) * 2 + (h)) * HTB)
#define PG8_STAGE(bufoff, gbase, voff) do { _Pragma("unroll") for (int _i = 0; _i < 2; ++_i) \
        __builtin_amdgcn_global_load_lds((const unsigned*)((const char*)(gbase) + (voff)[_i]), (LAS unsigned*)(lds + (bufoff) + ldsw + _i * 8192), 16, 0, 0); } while (0)
#define PG8_STAGE_A(bufoff, usenext, h, kofs) do { \
        if constexpr (Sched::GATHER) { const char* gb_ = Ab + (kofs); unsigned vv_[2] = {(usenext) ? vN[h][0] : vA[h][0], (usenext) ? vN[h][1] : vA[h][1]}; PG8_STAGE(bufoff, gb_, vv_); } \
        else { const char* gb_ = ((usenext) ? nA : cA) + (size_t)(h) * hstep + (kofs); PG8_STAGE(bufoff, gb_, voffA); } } while (0)
#define PG8_LDA(dst, b, h) do { _Pragma("unroll") for (int m = 0; m < 4; ++m) _Pragma("unroll") for (int k = 0; k < 2; ++k) dst[m][k] = *(const LAS bf16x8*)(lds + PG8_SA(b, h) + aoff + m * 2048 + k * 1024); } while (0)
#define PG8_LDB(dst, b, h) do { _Pragma("unroll") for (int n = 0; n < 2; ++n) _Pragma("unroll") for (int k = 0; k < 2; ++k) dst[n][k] = *(const LAS bf16x8*)(lds + PG8_SB(b, h) + boff + n * 2048 + k * 1024); } while (0)
#define PG8_MMA(ai, bj, At, Bt) do { __builtin_amdgcn_s_setprio(1); _Pragma("unroll") for (int m = 0; m < 4; ++m) _Pragma("unroll") for (int n = 0; n < 2; ++n) _Pragma("unroll") for (int k = 0; k < 2; ++k) \
        acc[ai][bj][m][n] = __builtin_amdgcn_mfma_f32_16x16x32_bf16(Bt[n][k], At[m][k], acc[ai][bj][m][n], 0, 0, 0); __builtin_amdgcn_s_setprio(0); } while (0)
#define PG8_WAIT_V(n) asm volatile("s_waitcnt vmcnt(" #n ")" ::: "memory")
#define PG8_WAIT_L(n) asm volatile("s_waitcnt lgkmcnt(" #n ")" ::: "memory")
#define PG8_BAR __builtin_amdgcn_s_barrier()
#define PG8_SCHED __builtin_amdgcn_sched_barrier(0)
    Unit cur, nxt; int ui = 0;
    if (!S.next(0, cur)) return;
    f32x4 acc[2][2][4][2];
#pragma unroll
    for (int a = 0; a < 2; ++a)
#pragma unroll
        for (int b = 0; b < 2; ++b)
#pragma unroll
            for (int m = 0; m < 4; ++m)
#pragma unroll
                for (int n = 0; n < 2; ++n) acc[a][b][m][n] = (f32x4){0.f, 0.f, 0.f, 0.f};
    bf16x8 At[4][2], B0[2][2], B1[2][2];
    unsigned vA[2][2], vN[2][2];
    const char* cA = Ab; const char* nA = Ab;
    if constexpr (Sched::GATHER) {
#pragma unroll
        for (int h = 0; h < 2; ++h)
#pragma unroll
            for (int i = 0; i < 2; ++i) { vA[h][i] = S.a_voff(cur, h, Rr[i]) + (unsigned)Cc[i] * 2u; vN[h][i] = vA[h][i]; }
    } else { cA = Ab + (size_t)cur.pm * tstep; nA = cA; }
    const char* cB = S.b_tile(cur);
    PG8_STAGE(PG8_SB(0, 0), cB, voffB); PG8_STAGE_A(PG8_SA(0, 0), false, 0, 0); PG8_STAGE(PG8_SB(0, 1), cB + hstep, voffB); PG8_STAGE_A(PG8_SA(0, 1), false, 1, 0);
    if (wr == 1) PG8_BAR;
    PG8_WAIT_V(4); PG8_BAR;
    PG8_STAGE(PG8_SB(1, 0), cB + kstep, voffB); PG8_STAGE_A(PG8_SA(1, 0), false, 0, kstep); PG8_STAGE(PG8_SB(1, 1), cB + hstep + kstep, voffB);
    PG8_WAIT_V(6); PG8_BAR;
    for (;;) {
        const bool has_next = S.next(ui + 1, nxt);
        const char* nB = has_next ? S.b_tile(nxt) : cB;
        if constexpr (Sched::GATHER) {
#pragma unroll
            for (int h = 0; h < 2; ++h)
#pragma unroll
                for (int i = 0; i < 2; ++i) vN[h][i] = has_next ? S.a_voff(nxt, h, Rr[i]) + (unsigned)Cc[i] * 2u : vA[h][i];
        } else nA = has_next ? Ab + (size_t)nxt.pm * tstep : cA;
        for (int t = 0; t < nt; t += 2) {
            const bool last = (t == nt - 2);
            const size_t k1 = (size_t)(t + 1) * kstep, k2 = last ? 0 : (size_t)(t + 2) * kstep, k3 = k2 + kstep;
            const char* b2 = last ? nB : cB + (size_t)(t + 2) * kstep; const char* b3 = b2 + kstep;
            PG8_LDB(B0, 0, 0); PG8_SCHED; PG8_LDA(At, 0, 0); PG8_STAGE_A(PG8_SA(1, 1), false, 1, k1);
            PG8_WAIT_L(8); PG8_BAR; PG8_WAIT_L(0); PG8_MMA(0, 0, At, B0); PG8_BAR; PG8_SCHED;
            PG8_LDB(B1, 0, 1); PG8_STAGE(PG8_SB(0, 0), b2, voffB);
            PG8_BAR; PG8_WAIT_L(0); PG8_MMA(0, 1, At, B1); PG8_BAR;
            PG8_LDA(At, 0, 1); PG8_STAGE_A(PG8_SA(0, 0), last, 0, k2);
            PG8_BAR; PG8_WAIT_L(0); PG8_MMA(1, 0, At, B0); PG8_BAR; PG8_SCHED;
            PG8_STAGE(PG8_SB(0, 1), b2 + hstep, voffB);
            PG8_WAIT_V(6); PG8_BAR; PG8_MMA(1, 1, At, B1); PG8_BAR;
            PG8_LDB(B0, 1, 0); PG8_SCHED; PG8_LDA(At, 1, 0); PG8_STAGE_A(PG8_SA(0, 1), last, 1, k2);
            PG8_WAIT_L(8); PG8_BAR; PG8_WAIT_L(0); PG8_MMA(0, 0, At, B0); PG8_BAR; PG8_SCHED;
            PG8_LDB(B1, 1, 1); PG8_STAGE(PG8_SB(1, 0), b3, voffB);
            PG8_BAR; PG8_WAIT_L(0); PG8_MMA(0, 1, At, B1); PG8_BAR;
            PG8_LDA(At, 1, 1); PG8_STAGE_A(PG8_SA(1, 0), last, 0, k3);
            PG8_BAR; PG8_WAIT_L(0); PG8_MMA(1, 0, At, B0); PG8_BAR; PG8_SCHED;
            PG8_STAGE(PG8_SB(1, 1), b3 + hstep, voffB);
            PG8_WAIT_V(6); PG8_BAR; PG8_MMA(1, 1, At, B1); PG8_BAR;
        }
        E(acc, cur, wr, wc, fr, fq);
        if (!has_next) break;
#pragma unroll
        for (int a = 0; a < 2; ++a)
#pragma unroll
            for (int b = 0; b < 2; ++b)
#pragma unroll
                for (int m = 0; m < 4; ++m)
#pragma unroll
                    for (int n = 0; n < 2; ++n) acc[a][b][m][n] = (f32x4){0.f, 0.f, 0.f, 0.f};
        cur = nxt; cB = nB; cA = nA; ++ui;
        if constexpr (Sched::GATHER) {
#pragma unroll
            for (int h = 0; h < 2; ++h)
#pragma unroll
                for (int i = 0; i < 2; ++i) vA[h][i] = vN[h][i];
        }
    }
    PG8_WAIT_V(0);
    if (wr == 0) PG8_BAR;
    PG8_BAR;
#undef PG8_SA
#undef PG8_SB
#undef PG8_STAGE
#undef PG8_STAGE_A
#undef PG8_LDA
#undef PG8_LDB
#undef PG8_MMA
#undef PG8_WAIT_V
#undef PG8_WAIT_L
#undef PG8_BAR
#undef PG8_SCHED
}
template <int ACT> struct EpiBf16 {
    static constexpr bool PERM = true;
    bf16* O; int ldc; int tpt; size_t tstride;
    __device__ __forceinline__ void operator()(const f32x4 (&acc)[2][2][4][2], const Unit& u, int wr, int wc, int fr, int fq) const {
        const int row0 = u.pm * BM + wr * 64 + fr; const int tt = u.pn / tpt; bf16* base = O + (size_t)tt * tstride; const int col0 = (u.pn - tt * tpt) * BM + wc * 32 + 8 * fq;
#pragma unroll
        for (int ai = 0; ai < 2; ++ai)
#pragma unroll
            for (int m = 0; m < 4; ++m) { bf16* rowp = base + (size_t)(row0 + ai * HALF + m * 16) * ldc + col0;
#pragma unroll
                for (int bj = 0; bj < 2; ++bj) { f32x4 v0 = acc[ai][bj][m][0], v1 = acc[ai][bj][m][1];
                    if (ACT == 1) {
#pragma unroll
                        for (int q = 0; q < 4; ++q) { v0[q] = gelu_tanh(v0[q]); v1[q] = gelu_tanh(v1[q]); } }
                    u32x4 w; w.x = cvt_pk_bf16(v0[0], v0[1]); w.y = cvt_pk_bf16(v0[2], v0[3]); w.z = cvt_pk_bf16(v1[0], v1[1]); w.w = cvt_pk_bf16(v1[2], v1[3]);
                    *(u32x4*)(rowp + bj * HALF) = w; } }
    }
};
struct EpiResAdd {
    static constexpr bool PERM = false;
    float* X; int ldc;
    __device__ __forceinline__ void operator()(const f32x4 (&acc)[2][2][4][2], const Unit& u, int wr, int wc, int fr, int fq) const {
        const int row0 = u.pm * BM + wr * 64 + fr, col0 = u.pn * BM + wc * 32 + 4 * fq;
#pragma unroll
        for (int ai = 0; ai < 2; ++ai)
#pragma unroll
            for (int m2 = 0; m2 < 4; m2 += 2) {
                f32x4 x[2][2][2];
#pragma unroll
                for (int mm = 0; mm < 2; ++mm)
#pragma unroll
                    for (int bj = 0; bj < 2; ++bj)
#pragma unroll
                        for (int n = 0; n < 2; ++n) x[mm][bj][n] = *(const f32x4*)(X + (size_t)(row0 + ai * HALF + (m2 + mm) * 16) * ldc + col0 + bj * HALF + n * 16);
#pragma unroll
                for (int mm = 0; mm < 2; ++mm)
#pragma unroll
                    for (int bj = 0; bj < 2; ++bj)
#pragma unroll
                        for (int n = 0; n < 2; ++n) *(f32x4*)(X + (size_t)(row0 + ai * HALF + (m2 + mm) * 16) * ldc + col0 + bj * HALF + n * 16) = x[mm][bj][n] + acc[ai][bj][m2 + mm][n];
            }
    }
};
struct EpiSwiglu {
    static constexpr bool PERM = true;
    bf16* H; int ldc;
    __device__ __forceinline__ void operator()(const f32x4 (&acc)[2][2][4][2], const Unit& u, int wr, int wc, int fr, int fq) const {
        const int row0 = u.pm * BM + wr * 64 + fr, col0 = u.pn * HALF + wc * 32 + 8 * fq;
#pragma unroll
        for (int ai = 0; ai < 2; ++ai)
#pragma unroll
            for (int m = 0; m < 4; ++m) {
                float o[8];
#pragma unroll
                for (int n = 0; n < 2; ++n)
#pragma unroll
                    for (int q = 0; q < 4; ++q) { const float g = acc[ai][0][m][n][q]; o[4 * n + q] = g * sigmoidf_(g) * acc[ai][1][m][n][q]; }
                u32x4 w; w.x = cvt_pk_bf16(o[0], o[1]); w.y = cvt_pk_bf16(o[2], o[3]); w.z = cvt_pk_bf16(o[4], o[5]); w.w = cvt_pk_bf16(o[6], o[7]);
                *(u32x4*)(H + (size_t)(row0 + ai * HALF + m * 16) * ldc + col0) = w; }
    }
};
}

__device__ __forceinline__ int hyb_colmap(int n) {
    if (n < 1280) return n;
    if (n < 1536) return 1304 + (n - 1280);
    if (n < 1792) return 1560 + (n - 1536);
    if (n < 2304) return 1816 + (n - 1792);
    if (n < 2816) return 2344 + (n - 2304);
    if (n < 2840) return 1280 + (n - 2816);
    if (n < 2856) return 2328 + (n - 2840);
    return -1;
}
__device__ __forceinline__ void tr_item(const float* __restrict__ W, int Nsrc, int K, bf16* __restrict__ Wt, const float* __restrict__ gain, int kind, int nblk, LAS float* scr, int item, int lane) {
    const int kb = item / nblk, nb = item % nblk, k0 = 64 * kb, n0 = 64 * nb;
    const int ksub = lane >> 4, n4 = lane & 15, n = n0 + 4 * n4;
    int col;
    if (kind == 0) col = n; else if (kind == 1) col = hyb_colmap(n); else { const int pn = n >> 8, r = n & 255; col = (r >> 7) * 384 + pn * 128 + (r & 127); }
    f32x4 v[16];
#pragma unroll
    for (int i = 0; i < 16; ++i) v[i] = col >= 0 ? *(const f32x4*)(W + (size_t)(k0 + 4 * i + ksub) * Nsrc + col) : (f32x4){0.f, 0.f, 0.f, 0.f};
    if (gain) {
#pragma unroll
        for (int i = 0; i < 16; ++i) v[i] = v[i] * gain[k0 + 4 * i + ksub];
    }
#pragma unroll
    for (int i = 0; i < 16; ++i) { LAS float* d = scr + (4 * i + ksub) * 65 + 4 * n4; d[0] = v[i].x; d[1] = v[i].y; d[2] = v[i].z; d[3] = v[i].w; }
    LDS_WAIT();
    const int c = lane & 7;
#pragma unroll
    for (int jx = 0; jx < 8; ++jx) {
        const int nn = (lane >> 3) + 8 * jx; const LAS float* s = scr + (8 * c) * 65 + nn;
        u32x4 o; o.x = pk2(s[0 * 65], s[1 * 65]); o.y = pk2(s[2 * 65], s[3 * 65]); o.z = pk2(s[4 * 65], s[5 * 65]); o.w = pk2(s[6 * 65], s[7 * 65]);
        *(u32x4*)(Wt + (size_t)(n0 + nn) * K + k0 + 8 * c) = o;
    }
    LDS_WAIT();
}
__device__ __forceinline__ void rms_row_to_bf16(const float* __restrict__ xrow, bf16* __restrict__ orow, float* __restrict__ copy, int lane) {
    const f32x4* xr = (const f32x4*)xrow + lane;
    f32x4 v[4]; float s = 0.f;
#pragma unroll
    for (int j = 0; j < 4; ++j) { v[j] = xr[64 * j]; s += (v[j].x * v[j].x + v[j].y * v[j].y) + (v[j].z * v[j].z + v[j].w * v[j].w); }
    const float rstd = rsqrtf(wave_sum(s) * (1.f / 1024.f) + EPS);
    u32x2* o8 = (u32x2*)orow + lane;
#pragma unroll
    for (int j = 0; j < 4; ++j) { u32x2 w; w.x = pk2(v[j].x * rstd, v[j].y * rstd); w.y = pk2(v[j].z * rstd, v[j].w * rstd); o8[64 * j] = w; }
    if (copy) { f32x4* c4 = (f32x4*)copy + lane;
#pragma unroll
        for (int j = 0; j < 4; ++j) c4[64 * j] = v[j]; }
}

__device__ __forceinline__ void phase_prologue(KArgs A, int wv_, LAS unsigned char* lds) {
    const int tid = opaque_tid(wv_), wid = __builtin_amdgcn_readfirstlane(tid >> 6), lane = tid & 63;
    const int gw = blockIdx.x * 8 + wid, NGW = gridDim.x * 8;
    LAS float* scr = (LAS float*)(lds + wid * 16640);
    unsigned char* ws = opq(A->ws);
    constexpr int N_HYB = 2 * 768, N_HOUT = 2 * 256, N_SGIN = 2 * 1024, N_SGOUT = 2 * 512, N_WQ = 4 * 256, N_WKV = 4 * 512, N_WO = 4 * 256, N_MIN = 64 * 192, N_MOUT = 64 * 96, N_W1T = 4 * 32;
    constexpr int NITEMS = N_HYB + N_HOUT + N_SGIN + N_SGOUT + N_WQ + N_WKV + N_WO + N_MIN + N_MOUT + N_W1T;
    for (int it = gw; it < NITEMS; it += NGW) {
        int r = it;
        if (r < N_HYB) { const int sl = r / 768; tr_item(A->in[I_HYBIN] + (size_t)sl * 1024 * HYSRC, HYSRC, 1024, (bf16*)(ws + WS_WHYB) + (size_t)sl * HYN * 1024, A->in[I_NMIX] + (2 * sl) * 1024, 1, 48, scr, r % 768, lane); continue; } r -= N_HYB;
        if (r < N_HOUT) { const int sl = r / 256; tr_item(A->in[I_HYBOUT] + (size_t)sl * 1024 * 1024, 1024, 1024, (bf16*)(ws + WS_WHOUT) + (size_t)sl * 1024 * 1024, nullptr, 0, 16, scr, r % 256, lane); continue; } r -= N_HOUT;
        if (r < N_SGIN) { const int sl = r / 1024; tr_item(A->in[I_SGIN] + (size_t)sl * 1024 * 4096, 4096, 1024, (bf16*)(ws + WS_WSGIN) + (size_t)sl * 4096 * 1024, A->in[I_NMIX] + (2 * sl + 1) * 1024, 0, 64, scr, r % 1024, lane); continue; } r -= N_SGIN;
        if (r < N_SGOUT) { const int sl = r / 512; tr_item(A->in[I_SGOUT] + (size_t)sl * 2048 * 1024, 1024, 2048, (bf16*)(ws + WS_WSGOUT) + (size_t)sl * 1024 * 2048, nullptr, 0, 16, scr, r % 512, lane); continue; } r -= N_SGOUT;
        if (r < N_WQ) { const int sl = r / 256; tr_item(A->in[I_XWQ] + (size_t)sl * 1024 * 1024, 1024, 1024, (bf16*)(ws + WS_WQ) + (size_t)sl * 1024 * 1024, A->in[I_NXAT] + sl * 1024, 0, 16, scr, r % 256, lane); continue; } r -= N_WQ;
        if (r < N_WKV) { const int sl = r / 512; tr_item(A->in[I_XWKV] + (size_t)sl * 1024 * 2048, 2048, 1024, (bf16*)(ws + WS_WKV) + (size_t)sl * 2048 * 1024, A->in[I_NMEM] + sl * 1024, 0, 32, scr, r % 512, lane); continue; } r -= N_WKV;
        if (r < N_WO) { const int sl = r / 256; tr_item(A->in[I_XWO] + (size_t)sl * 1024 * 1024, 1024, 1024, (bf16*)(ws + WS_WO) + (size_t)sl * 1024 * 1024, nullptr, 0, 16, scr, r % 256, lane); continue; } r -= N_WO;
        if (r < N_MIN) { const int sl = r / 192; tr_item(A->in[I_MOEIN] + (size_t)sl * 1024 * 768, 768, 1024, (bf16*)(ws + WS_WMIN) + (size_t)sl * 768 * 1024, A->in[I_NFFN] + (sl >> 4) * 1024, 2, 12, scr, r % 192, lane); continue; } r -= N_MIN;
        if (r < N_MOUT) { const int sl = r / 96; tr_item(A->in[I_MOEOUT] + (size_t)sl * 384 * 1024, 1024, 384, (bf16*)(ws + WS_WMOUT) + (size_t)sl * 1024 * 384, nullptr, 0, 16, scr, r % 96, lane); continue; } r -= N_MOUT;
        { const int sl = r / 32; tr_item(A->in[I_CMPW1] + (size_t)sl * 2048 * 64, 64, 2048, (bf16*)(ws + WS_W1T) + (size_t)sl * 64 * 2048, nullptr, 0, 1, scr, r % 32, lane); }
    }
    for (int m = gw; m < T; m += NGW) rms_row_to_bf16(A->in[I_X] + (size_t)m * D, (bf16*)(ws + WS_XN) + (size_t)m * D, A->out + (size_t)m * D, lane);
    for (int m = gw; m < NBATCH * NMEM; m += NGW) rms_row_to_bf16(A->in[I_MEM] + (size_t)m * D, (bf16*)(ws + WS_MN) + (size_t)m * D, nullptr, lane);
    const int gt = blockIdx.x * 512 + tid, NGT = gridDim.x * 512;
    const int* pos = (const int*)A->in[I_POS];
    float* cosT = (float*)(ws + WS_COS); float* sinT = (float*)(ws + WS_SIN);
    for (int i = gt; i < T * 32; i += NGT) {
        const int t = i >> 5, j = i & 31;
        const float ang = (float)pos[t] * A->freq[j];
        const double rev = (double)ang * 0.15915494309189533577;
        const float fr = (float)(rev - rint(rev));
        cosT[i] = __builtin_amdgcn_cosf(fr); sinT[i] = __builtin_amdgcn_sinf(fr);
    }
    { bf16* WSB = (bf16*)(ws + WS_WSB); float* M0 = (float*)(ws + WS_M0); const float* wsg = A->in[I_SGWS];
      for (int e = gt; e < 2 * 8 * 128 * 128; e += NGT) { const int s = e & 127, t = (e >> 7) & 127; WSB[e] = (bf16)f2bf(s <= t ? wsg[e] : 0.f); }
      for (int e = gt; e < 2 * 8 * 128; e += NGT) { const int t = e & 127; const float* r = wsg + (size_t)e * 128; float a = 0.f; for (int s = 0; s <= t; ++s) a += r[s]; M0[e] = a; } }
    float* RW = (float*)(ws + WS_RW);
    for (int i = gt; i < DEPTH * NEXP * D; i += NGT) { const int k = i & 1023, e = (i >> 10) & 15, l = i >> 14; RW[i] = A->in[I_RW][k * NEXP + e] * A->in[I_NFFN][l * D + k]; }
}

__device__ __forceinline__ void phase_knorm(KArgs A, int wv_) {
    const int tid_ = opaque_tid(wv_); const int wid = __builtin_amdgcn_readfirstlane(tid_ >> 6), lane = tid_ & 63; const int gw = blockIdx.x * 8 + wid, NGW = gridDim.x * 8;
    bf16* KV = (bf16*)(opq(A->ws) + WS_KV);
    for (int it = gw; it < DEPTH * 2048 * 4; it += NGW) {
        const int h = it & 3, m = (it >> 2) & 2047, l = it >> 13;
        bf16* p = KV + (size_t)m * 8192 + l * 2048 + h * 256 + 4 * lane;
        const u32x2 w = *(const u32x2*)p;
        float x0 = bflo(w.x), x1 = bfhi(w.x), x2 = bflo(w.y), x3 = bfhi(w.y);
        const float rstd = rsqrtf(wave_sum(x0 * x0 + x1 * x1 + x2 * x2 + x3 * x3) * (1.f / 256.f) + EPS) * 0.0625f;
        const f32x4 g = *(const f32x4*)(A->in[I_XKN] + l * 256 + 4 * lane) * *(const f32x4*)(A->in[I_XQN] + l * 256 + 4 * lane);
        u32x2 o; o.x = pk2(x0 * rstd * g.x, x1 * rstd * g.y); o.y = pk2(x2 * rstd * g.z, x3 * rstd * g.w);
        *(u32x2*)p = o;
    }
}

__device__ __forceinline__ int kpos64(int tok) { const int k = tok & 31; return (tok & 32) + 8 * ((k >> 2) & 3) + 4 * (k >> 4) + (k & 3); }
__device__ __forceinline__ int kperm64(int p) { const int fq = (p >> 3) & 3, j = p & 7; return (p & 32) + 16 * (j >> 2) + 4 * fq + (j & 3); }

__device__ __forceinline__ void phase_nsa_prep(KArgs A, int wv_, int i, LAS unsigned char* lds) {
    const int tid_ = opaque_tid(wv_); const int wid = __builtin_amdgcn_readfirstlane(tid_ >> 6), lane = tid_ & 63; const int gw = blockIdx.x * 8 + wid, NGW = gridDim.x * 8;
    unsigned char* ws = opq(A->ws);
    const bf16* HY = (const bf16*)(ws + WS_BIG);
    const float* cosT = (const float*)(ws + WS_COS); const float* sinT = (const float*)(ws + WS_SIN);
    bf16* QA = (bf16*)(ws + WS_QA); bf16* KS = (bf16*)(ws + WS_KS); bf16* KW = (bf16*)(ws + WS_KW);
    LAS float* abuf = (LAS float*)(lds + wid * 8192);
    const int NIT = T;
    for (int it = gw; it < NIT; it += NGW) {
        if (it < T) {
            const int t = it;
            const float c = cosT[t * 32 + (lane & 31)], s = sinT[t * 32 + (lane & 31)];
            float xin[12];
#pragma unroll
            for (int u = 0; u < 12; ++u) xin[u] = bf2f(HY[(size_t)t * HYN + (u < 8 ? C_QA + 64 * u : (u < 10 ? C_KS + 64 * (u - 8) : C_KW + 64 * (u - 10))) + lane]);
#pragma unroll
            for (int u = 0; u < 12; ++u) {
                int src; const float* gain; bf16* dst; float scale;
                if (u < 8) { src = C_QA + 64 * u; gain = A->in[I_QNORM] + i * 64; dst = QA + (size_t)t * 512 + 64 * u; scale = 0.125f; }
                else if (u < 10) { src = C_KS + 64 * (u - 8); gain = A->in[I_KNORM] + (i * 3 + 1) * 64; dst = KS + (size_t)t * 128 + 64 * (u - 8); scale = 1.f; }
                else { src = C_KW + 64 * (u - 10); gain = A->in[I_KNORM] + (i * 3 + 2) * 64; dst = KW + (size_t)t * 128 + 64 * (u - 10); scale = 1.f; }
                const float x = xin[u]; (void)src;
                const float y = x * rsqrtf(wave_sum(x * x) * (1.f / 64.f) + EPS) * gain[lane] * scale;
                const float pr = __shfl_xor(y, 32);
                const float o = lane < 32 ? y * c - pr * s : y * c + pr * s;
                dst[lane] = (bf16)f2bf(o);
            }
        }
    }
}


__device__ __forceinline__ void phase_compress_mfma(KArgs A, int wv_, int i, LAS unsigned char* lds) {
    const int tid = opaque_tid(wv_), wid = __builtin_amdgcn_readfirstlane(tid >> 6), lane = tid & 63, fr = lane & 15, fq = lane >> 4;
    unsigned char* ws = opq(A->ws);
    const bf16* HY = (const bf16*)(ws + WS_BIG);
    const float* cosT = (const float*)(ws + WS_COS); const float* sinT = (const float*)(ws + WS_SIN);
    LAS float* part = (LAS float*)lds;
    LAS float* hbuf = part + 8 * 1024;
    LAS float* obuf = hbuf + 1024;
    for (int it = blockIdx.x; it < 2 * 127; it += gridDim.x) {
        const int kv = it / 127, tile = it % 127;
        const float* pe = A->in[I_CMPPE] + (size_t)(i * 2 + kv) * 32 * 64;
        const float* w2 = A->in[I_CMPW2] + (size_t)(i * 2 + kv) * 64 * 64;
        const bf16* w1t = (const bf16*)(ws + WS_W1T) + (size_t)(i * 2 + kv) * 64 * 2048;
        const int coff = kv ? C_VC : C_KC;
        {
            const int R = tile * 16 + fr, g = R & 1, bn = R >> 1, n = bn % NCMP, b = bn / NCMP;
            const bf16* arow = HY + (size_t)(b * S + 16 * n) * HYN + coff + g * 64;
            f32x4 acc[4];
#pragma unroll
            for (int t = 0; t < 4; ++t) acc[t] = (f32x4){0.f, 0.f, 0.f, 0.f};
#pragma unroll 2
            for (int s = 0; s < 8; ++s) {
                const int k0 = 256 * wid + 32 * s, l = k0 >> 6, d0 = (k0 & 63) + 8 * fq;
                const u32x4 hw = *(const u32x4*)(arow + (size_t)l * HYN + d0);
                const f32x4 p0 = *(const f32x4*)(pe + l * 64 + d0), p1 = *(const f32x4*)(pe + l * 64 + d0 + 4);
                u32x4 aw; aw.x = pk2(bflo(hw.x) + p0.x, bfhi(hw.x) + p0.y); aw.y = pk2(bflo(hw.y) + p0.z, bfhi(hw.y) + p0.w); aw.z = pk2(bflo(hw.z) + p1.x, bfhi(hw.z) + p1.y); aw.w = pk2(bflo(hw.w) + p1.z, bfhi(hw.w) + p1.w);
                const bf16x8 af = __builtin_bit_cast(bf16x8, aw);
#pragma unroll
                for (int t = 0; t < 4; ++t) { const bf16x8 bfr = *(const bf16x8*)(w1t + (size_t)(16 * t + fr) * 2048 + k0 + 8 * fq);
                    acc[t] = __builtin_amdgcn_mfma_f32_16x16x32_bf16(af, bfr, acc[t], 0, 0, 0); }
            }
            __syncthreads();
#pragma unroll
            for (int t = 0; t < 4; ++t)
#pragma unroll
                for (int r = 0; r < 4; ++r) part[wid * 1024 + (4 * fq + r) * 64 + 16 * t + fr] = acc[t][r];
        }
        __syncthreads();
        for (int e = tid; e < 1024; e += 512) { float a = 0.f;
#pragma unroll
            for (int w = 0; w < 8; ++w) a += part[w * 1024 + e];
            hbuf[e] = gelu_tanh(a); }
        __syncthreads();
        for (int e = tid; e < 1024; e += 512) { const int r = e >> 6, j = e & 63; float o = 0.f;
#pragma unroll 8
            for (int m = 0; m < 64; ++m) o += hbuf[r * 64 + m] * w2[m * 64 + j];
            obuf[e] = o; }
        __syncthreads();
        for (int r = wid; r < 16; r += 8) {
            const int R = tile * 16 + r, g = R & 1, bn = R >> 1, n = bn % NCMP, b = bn / NCMP;
            const float o = obuf[r * 64 + lane];
            if (kv == 0) {
                const float y = o * rsqrtf(wave_sum(o * o) * (1.f / 64.f) + EPS) * A->in[I_KNORM][(i * 3 + 0) * 64 + lane];
                const int tp = b * S + 16 * n + 31;
                const float c = cosT[tp * 32 + (lane & 31)], sn = sinT[tp * 32 + (lane & 31)];
                const float pr = __shfl_xor(y, 32);
                const float oo = lane < 32 ? y * c - pr * sn : y * c + pr * sn;
                ((bf16*)(ws + WS_KC))[((size_t)(b * 128 + n) * 2 + g) * 64 + lane] = (bf16)f2bf(oo);
            } else {
                bf16* vct = (bf16*)(ws + WS_VC) + ((size_t)(b * 2 + g) * 64 + lane) * 128;
                vct[(n & 64) + kpos64(n & 63)] = (bf16)f2bf(o);
                if (n == 126) vct[127] = 0;
            }
        }
    }
    __syncthreads();
}

__device__ __forceinline__ void nsa_block(const LAS float* qs, const bf16* __restrict__ krow, bool ok, const bf16* __restrict__ vbase, int vstride, int lane,
                                          float (&m)[4], float (&l)[4], float (&o)[4]) {
    float s[4] = {0.f, 0.f, 0.f, 0.f};
#pragma unroll 2
    for (int c = 0; c < 8; ++c) {
        const u32x4 kw = *(const u32x4*)(krow + 8 * c);
        const float k0 = bflo(kw.x), k1 = bfhi(kw.x), k2 = bflo(kw.y), k3 = bfhi(kw.y), k4 = bflo(kw.z), k5 = bfhi(kw.z), k6 = bflo(kw.w), k7 = bfhi(kw.w);
#pragma unroll
        for (int hh = 0; hh < 4; ++hh) {
            const f32x4 qa = *(const LAS f32x4*)(qs + hh * 64 + 8 * c), qb = *(const LAS f32x4*)(qs + hh * 64 + 8 * c + 4);
            s[hh] += (qa.x * k0 + qa.y * k1) + (qa.z * k2 + qa.w * k3) + (qb.x * k4 + qb.y * k5) + (qb.z * k6 + qb.w * k7);
        }
    }
    float p[4];
#pragma unroll
    for (int hh = 0; hh < 4; ++hh) {
        const float sv = ok ? s[hh] : -INFINITY;
        const float bm = wave_max(sv);
        const float mn = fmaxf(m[hh], bm);
        if (mn == -INFINITY) { p[hh] = 0.f; continue; }
        const float alpha = __expf(m[hh] - mn);
        p[hh] = ok ? __expf(sv - mn) : 0.f;
        l[hh] = l[hh] * alpha + wave_sum(p[hh]);
        o[hh] *= alpha; m[hh] = mn;
    }
#pragma unroll 8
    for (int kk = 0; kk < 64; ++kk) {
        const float v = bf2f(vbase[(size_t)kk * vstride + lane]);
#pragma unroll
        for (int hh = 0; hh < 4; ++hh) o[hh] += __shfl(p[hh], kk) * v;
    }
}
__device__ __forceinline__ void phase_nsa_attn(KArgs A, int wv_, int i, LAS unsigned char* lds) {
    const int tid_ = opaque_tid(wv_); const int wid = __builtin_amdgcn_readfirstlane(tid_ >> 6), lane0 = tid_ & 63; const int gw = blockIdx.x * 8 + wid, NGW = gridDim.x * 8;
    unsigned char* ws = opq(A->ws);
    const bf16* HY = (const bf16*)(ws + WS_BIG); const bf16* QA = (const bf16*)(ws + WS_QA); const bf16* KS = (const bf16*)(ws + WS_KS); const bf16* KW = (const bf16*)(ws + WS_KW);
    const bf16* KC = (const bf16*)(ws + WS_KC); const bf16* VC = (const bf16*)(ws + WS_VC); bf16* CAT = (bf16*)(ws + WS_CAT);
    LAS float* qs = (LAS float*)(lds + wid * 2048);
    LAS float* ps = qs + 256;
    for (int it = gw; it < 2 * T; it += NGW) {
        int lane = lane0; asm volatile("" : "+v"(lane));
        const int tok = it >> 1, g = it & 1, b = tok >> 11, t = tok & 2047;
#pragma unroll
        for (int hh = 0; hh < 4; ++hh) qs[hh * 64 + lane] = bf2f(QA[(size_t)tok * 512 + (g * 4 + hh) * 64 + lane]);
        LDS_WAIT();
        const int ncv = t >= 31 ? ((t - 31) >> 4) + 1 : 0;
        float oc[4] = {0.f, 0.f, 0.f, 0.f};
        float psum0 = 0.f, psum1 = 0.f;
        {
            const bool v0 = lane < ncv, v1 = lane + 64 < ncv;
            const bf16* k0p = KC + ((size_t)(b * 128 + lane) * 2 + g) * 64;
            const bf16* k1p = KC + ((size_t)(b * 128 + (lane + 64 < 127 ? lane + 64 : 126)) * 2 + g) * 64;
            float s0[4] = {0.f, 0.f, 0.f, 0.f}, s1[4] = {0.f, 0.f, 0.f, 0.f};
#pragma unroll 2
            for (int c = 0; c < 8; ++c) {
                const u32x4 ka = *(const u32x4*)(k0p + 8 * c), kb = *(const u32x4*)(k1p + 8 * c);
#pragma unroll
                for (int hh = 0; hh < 4; ++hh) {
                    const f32x4 qa = *(const LAS f32x4*)(qs + hh * 64 + 8 * c), qb = *(const LAS f32x4*)(qs + hh * 64 + 8 * c + 4);
                    s0[hh] += (qa.x * bflo(ka.x) + qa.y * bfhi(ka.x)) + (qa.z * bflo(ka.y) + qa.w * bfhi(ka.y)) + (qb.x * bflo(ka.z) + qb.y * bfhi(ka.z)) + (qb.z * bflo(ka.w) + qb.w * bfhi(ka.w));
                    s1[hh] += (qa.x * bflo(kb.x) + qa.y * bfhi(kb.x)) + (qa.z * bflo(kb.y) + qa.w * bfhi(kb.y)) + (qb.x * bflo(kb.z) + qb.y * bfhi(kb.z)) + (qb.z * bflo(kb.w) + qb.w * bfhi(kb.w));
                }
            }
            float p0[4], p1[4];
#pragma unroll
            for (int hh = 0; hh < 4; ++hh) {
                const float a0 = v0 ? s0[hh] : -INFINITY, a1 = v1 ? s1[hh] : -INFINITY;
                const float mx = wave_max(fmaxf(a0, a1));
                if (ncv > 0) {
                    const float e0 = v0 ? __expf(a0 - mx) : 0.f, e1 = v1 ? __expf(a1 - mx) : 0.f;
                    const float inv = 1.0f / wave_sum(e0 + e1);
                    p0[hh] = e0 * inv; p1[hh] = e1 * inv;
                } else { p0[hh] = 0.f; p1[hh] = 0.f; }
                psum0 += p0[hh]; psum1 += p1[hh];
            }
#pragma unroll 2
            for (int c = 0; c < ncv; ++c) {
                const float v = bf2f(VC[((size_t)(b * 128 + c) * 2 + g) * 64 + lane]);
#pragma unroll
                for (int hh = 0; hh < 4; ++hh) oc[hh] += __shfl(c < 64 ? p0[hh] : p1[hh], c & 63) * v;
            }
        }
        ps[lane] = psum0; ps[64 + lane] = psum1;
        LDS_WAIT();
        const int cur = t >> 6;
        unsigned selmask;
        {
            const int j = lane & 31;
            float imp = ps[4 * j] + ps[4 * j + 1] + ps[4 * j + 2] + 0.5f * ps[4 * j + 3] + (j > 0 ? 0.5f * ps[4 * j - 1] : 0.f);
            const bool valid = j <= cur, forced = (j == 0) || (j == cur) || (j == cur - 1);
            const float score = valid ? imp + (forced ? 1000.0f : 0.f) : -INFINITY;
            int rank = 0;
#pragma unroll 8
            for (int jj = 0; jj < 32; ++jj) { const float sj = __shfl(score, jj); rank += (sj > score || (sj == score && jj < j)) ? 1 : 0; }
            const bool sel = valid && rank < 8 && lane < 32;
            selmask = (unsigned)__ballot(sel);
        }
        LDS_WAIT();
        float o1[4] = {0.f, 0.f, 0.f, 0.f}, o2[4] = {0.f, 0.f, 0.f, 0.f};
#pragma unroll 1
        for (int pass = 0; pass < 2; ++pass) {
            float oa[4] = {0.f, 0.f, 0.f, 0.f}, ma[4] = {-INFINITY, -INFINITY, -INFINITY, -INFINITY}, la[4] = {0.f, 0.f, 0.f, 0.f};
            const int lo = pass ? (t - 255 > 0 ? t - 255 : 0) : 0;
            const unsigned bm = pass ? 0xffffffffu : selmask;
            const bf16* Kb = pass ? KW : KS; const int vc = pass ? C_VW : C_VS;
#pragma unroll 1
            for (int j = lo >> 6; j <= cur; ++j) {
                if (!((bm >> j) & 1u)) continue;
                const int key = 64 * j + lane; const size_t kt = (size_t)(b * S + key);
                nsa_block(qs, Kb + kt * 128 + g * 64, key <= t && key >= lo, HY + (size_t)(b * S + 64 * j) * HYN + vc + g * 64, HYN, lane, ma, la, oa);
            }
            if (pass == 0) {
#pragma unroll
                for (int hh = 0; hh < 4; ++hh) o1[hh] = oa[hh] / la[hh];
            } else {
#pragma unroll
                for (int hh = 0; hh < 4; ++hh) o2[hh] = oa[hh] / la[hh];
            }
        }
#pragma unroll
        for (int hh = 0; hh < 4; ++hh) {
            const int head = g * 4 + hh;
            const float* gb = A->in[I_GATEB] + i * 24 + head * 3;
            const bf16* gl = HY + (size_t)tok * HYN + C_GA + head * 3;
            const float g0 = sigmoidf_(bf2f(gl[0]) + gb[0]), g1 = sigmoidf_(bf2f(gl[1]) + gb[1]), g2 = sigmoidf_(bf2f(gl[2]) + gb[2]);
            const float o = g0 * oc[hh] + g1 * o1[hh] + g2 * o2[hh];
            CAT[(size_t)tok * 1024 + head * 64 + lane] = (bf16)f2bf(o);
        }
    }
}

__device__ __forceinline__ void phase_gla_seq(KArgs A, int wv_, int i, LAS unsigned char* lds) {
    const int tid = opaque_tid(wv_), wid = __builtin_amdgcn_readfirstlane(tid >> 6), lane = tid & 63;
    unsigned char* ws = opq(A->ws);
    const bf16* HY = (const bf16*)(ws + WS_BIG); bf16* CAT = (bf16*)(ws + WS_CAT);
    constexpr int CH = 16;
    LAS float* la = (LAS float*)lds;
    LAS float* lk = la + 4 * CH * 64;
    LAS float* lq = lk + 4 * CH * 64;
    LAS float* lo = lq + 4 * CH * 64;
    const float* wa2 = A->in[I_WA2] + i * 16 * 256; const float* ba = A->in[I_BA] + i * 256; const float* og = A->in[I_ONORM] + i * 128;
    for (int it = blockIdx.x; it < 8; it += gridDim.x) {
        const int pl = tid >> 7, v = tid & 127, p = it * 4 + pl, b = p >> 2, h = p & 3;
        float St[64];
#pragma unroll
        for (int k = 0; k < 64; ++k) St[k] = 0.f;
        for (int c0 = 0; c0 < S; c0 += CH) {
            __syncthreads();
            for (int e = tid; e < 4 * CH * 64; e += 512) {
                const int kk = e & 63, tk = (e >> 6) % CH, pp = e / (64 * CH); const int pb = (it * 4 + pp) >> 2, ph = (it * 4 + pp) & 3;
                const size_t tok = (size_t)pb * S + c0 + tk; const bf16* row = HY + tok * HYN;
                float z = ba[ph * 64 + kk];
#pragma unroll
                for (int r = 0; r < 16; ++r) z += bf2f(row[C_AL + r]) * wa2[r * 256 + ph * 64 + kk];
                const float ls_ = fminf(z, 0.f) - log1pf(__expf(-fabsf(z)));
                la[e] = __expf(ls_ * (1.f / 16.f));
                lk[e] = bf2f(row[C_KB + ph * 64 + kk]);
                lq[e] = bf2f(row[C_QB + ph * 64 + kk]) * 0.125f;
            }
            __syncthreads();
            for (int tk = 0; tk < CH; ++tk) {
                const size_t tok = (size_t)b * S + c0 + tk;
                const float vv = bf2f(HY[tok * HYN + C_VB + h * 128 + v]);
                const LAS float* pa = la + (pl * CH + tk) * 64; const LAS float* pk = lk + (pl * CH + tk) * 64; const LAS float* pq = lq + (pl * CH + tk) * 64;
                float o = 0.f;
#pragma unroll
                for (int k4 = 0; k4 < 16; ++k4) {
                    const f32x4 a4 = *(const LAS f32x4*)(pa + 4 * k4), k4v = *(const LAS f32x4*)(pk + 4 * k4), q4 = *(const LAS f32x4*)(pq + 4 * k4);
                    St[4 * k4 + 0] = a4.x * St[4 * k4 + 0] + k4v.x * vv; o += q4.x * St[4 * k4 + 0];
                    St[4 * k4 + 1] = a4.y * St[4 * k4 + 1] + k4v.y * vv; o += q4.y * St[4 * k4 + 1];
                    St[4 * k4 + 2] = a4.z * St[4 * k4 + 2] + k4v.z * vv; o += q4.z * St[4 * k4 + 2];
                    St[4 * k4 + 3] = a4.w * St[4 * k4 + 3] + k4v.w * vv; o += q4.w * St[4 * k4 + 3];
                }
                lo[(pl * CH + tk) * 128 + v] = o;
            }
            __syncthreads();
            for (int r = wid; r < 4 * CH; r += 8) {
                const int pp = r / CH, tk = r % CH; const int pb = (it * 4 + pp) >> 2, ph = (it * 4 + pp) & 3;
                const size_t tok = (size_t)pb * S + c0 + tk;
                const float x0 = lo[r * 128 + lane], x1 = lo[r * 128 + 64 + lane];
                const float rstd = rsqrtf(wave_sum(x0 * x0 + x1 * x1) * (1.f / 128.f) + EPS);
                const float r0 = bf2f(HY[tok * HYN + C_RB + ph * 128 + lane]), r1 = bf2f(HY[tok * HYN + C_RB + ph * 128 + 64 + lane]);
                CAT[tok * 1024 + 512 + ph * 128 + lane] = (bf16)f2bf(x0 * rstd * og[lane] * (r0 * sigmoidf_(r0)));
                CAT[tok * 1024 + 512 + ph * 128 + 64 + lane] = (bf16)f2bf(x1 * rstd * og[64 + lane] * (r1 * sigmoidf_(r1)));
            }
        }
        __syncthreads();
    }
}


__device__ __forceinline__ void phase_nsa_attn_mfma(KArgs A, int wv_, int i, LAS unsigned char* lds) {
    const int tid = opaque_tid(wv_), wid = __builtin_amdgcn_readfirstlane(tid >> 6), lane = tid & 63, fr = lane & 15, fq = lane >> 4;
    unsigned char* ws = opq(A->ws);
    const bf16* HY = (const bf16*)(ws + WS_BIG); const bf16* QA = (const bf16*)(ws + WS_QA); const bf16* KS = (const bf16*)(ws + WS_KS); const bf16* KW = (const bf16*)(ws + WS_KW);
    const bf16* KC = (const bf16*)(ws + WS_KC); const bf16* VCT = (const bf16*)(ws + WS_VC); const bf16* VTA = (const bf16*)(ws + WS_VTA); bf16* CAT = (bf16*)(ws + WS_CAT);
    constexpr int RS = 72;
    LAS bf16* ktl = (LAS bf16*)lds;
    LAS bf16* vtl = ktl + 4 * 64 * RS;
    LAS float* scl = (LAS float*)(lds + 73728) + wid * 256;
    LAS unsigned* msk = (LAS unsigned*)(lds + 73728 + 8192);
    LAS unsigned* umask = msk + 64;
    const float* gb = A->in[I_GATEB] + i * 24;
    for (int pit = blockIdx.x; pit < 256; pit += gridDim.x) {
#pragma unroll 1
        for (int hf = 0; hf < 2; ++hf) {
            const int bg = pit >> 4, xx = pit & 15, x = hf ? 31 - xx : xx, b = bg >> 1, g = bg & 1;
            const size_t tokbase = (size_t)b * S + 64 * x;
            const int tl0 = 8 * wid + (fr >> 2);
            if (tid == 0) *umask = 0u;
            bf16x8 qf[2][2];
#pragma unroll
            for (int mt = 0; mt < 2; ++mt)
#pragma unroll
                for (int s = 0; s < 2; ++s) qf[mt][s] = *(const bf16x8*)(QA + (tokbase + tl0 + 4 * mt) * 512 + (g * 4 + (fr & 3)) * 64 + 32 * s + 8 * fq);
            f32x4 outacc[2][4];
            {
                const int tmaxc = (4 * x + 3 + 15) >> 4;
                const bf16* kcb = KC + ((size_t)(b * 128 + fr) * 2 + g) * 64 + 8 * fq;
                bf16x8 pcf[2][4];
#pragma unroll
                for (int mt = 0; mt < 2; ++mt) {
                    f32x4 sc[8];
                    const bf16* kp = kcb;
#pragma unroll
                    for (int t = 0; t < 8; ++t) { sc[t] = (f32x4){0.f, 0.f, 0.f, 0.f};
                        asm volatile("" : "+v"(kp));
                        if (t < tmaxc) {
                            const bf16x8 k0 = *(const bf16x8*)(kp), k1 = *(const bf16x8*)(kp + 32);
                            sc[t] = __builtin_amdgcn_mfma_f32_16x16x32_bf16(k0, qf[mt][0], sc[t], 0, 0, 0);
                            sc[t] = __builtin_amdgcn_mfma_f32_16x16x32_bf16(k1, qf[mt][1], sc[t], 0, 0, 0); }
                        kp += 16 * 128; }
                    const int tg = 64 * x + tl0 + 4 * mt; const int ncv = tg >= 31 ? ((tg - 31) >> 4) + 1 : 0;
                    float mx = -INFINITY;
#pragma unroll
                    for (int t = 0; t < 8; ++t)
#pragma unroll
                        for (int r = 0; r < 4; ++r) { const bool v = 16 * t + 4 * fq + r < ncv; sc[t][r] = v ? sc[t][r] : -INFINITY; mx = fmaxf(mx, sc[t][r]); }
                    mx = fmaxf(mx, __shfl_xor(mx, 16)); mx = fmaxf(mx, __shfl_xor(mx, 32));
                    const float mxs = mx == -INFINITY ? 0.f : mx;
                    float sum = 0.f;
#pragma unroll
                    for (int t = 0; t < 8; ++t)
#pragma unroll
                        for (int r = 0; r < 4; ++r) { sc[t][r] = __expf(sc[t][r] - mxs); sum += sc[t][r]; }
                    sum += __shfl_xor(sum, 16); sum += __shfl_xor(sum, 32);
                    const float inv = sum > 0.f ? 1.f / sum : 0.f;
#pragma unroll
                    for (int t = 0; t < 8; ++t) sc[t] = sc[t] * inv;
#pragma unroll
                    for (int s = 0; s < 4; ++s) { u32x4 w; w.x = pk2(sc[2 * s].x, sc[2 * s].y); w.y = pk2(sc[2 * s].z, sc[2 * s].w); w.z = pk2(sc[2 * s + 1].x, sc[2 * s + 1].y); w.w = pk2(sc[2 * s + 1].z, sc[2 * s + 1].w);
                        pcf[mt][s] = __builtin_bit_cast(bf16x8, w); }
                    float w3[8];
#pragma unroll
                    for (int t = 0; t < 8; ++t) {
#pragma unroll
                        for (int r = 0; r < 4; ++r) { float v = sc[t][r]; v += __shfl_xor(v, 1); v += __shfl_xor(v, 2); sc[t][r] = v; }
                        w3[t] = __shfl(sc[t].w, (lane + 48) & 63);
                    }
#pragma unroll
                    for (int t = 0; t < 8; ++t) {
                        const float prev = fq > 0 ? w3[t] : (t > 0 ? w3[t > 0 ? t - 1 : 0] : 0.f);
                        const float imp = sc[t].x + sc[t].y + sc[t].z + 0.5f * sc[t].w + 0.5f * prev;
                        if ((fr & 3) == 0) scl[(4 * mt + (fr >> 2)) * 32 + 4 * t + fq] = imp;
                    }
                    asm volatile("" ::: "memory");
                }
                const bf16* vcb = VCT + ((size_t)(b * 2 + g) * 64 + fr) * 128 + 8 * fq;
#pragma unroll
                for (int n = 0; n < 4; ++n) {
                    outacc[0][n] = (f32x4){0.f, 0.f, 0.f, 0.f}; outacc[1][n] = (f32x4){0.f, 0.f, 0.f, 0.f};
                    asm volatile("" : "+v"(vcb));
#pragma unroll
                    for (int s = 0; s < 4; ++s) if (2 * s < tmaxc) {
                        const bf16x8 vf = *(const bf16x8*)(vcb + 32 * s);
                        outacc[0][n] = __builtin_amdgcn_mfma_f32_16x16x32_bf16(vf, pcf[0][s], outacc[0][n], 0, 0, 0);
                        outacc[1][n] = __builtin_amdgcn_mfma_f32_16x16x32_bf16(vf, pcf[1][s], outacc[1][n], 0, 0, 0); }
                    vcb += 16 * 128;
                    asm volatile("" ::: "memory");
                }
            }
            float g1v[2], g2v[2];
#pragma unroll
            for (int mt = 0; mt < 2; ++mt) {
                const int head = g * 4 + (fr & 3);
                const bf16* gl = HY + (tokbase + tl0 + 4 * mt) * HYN + C_GA + head * 3;
                const float g0 = sigmoidf_(bf2f(gl[0]) + gb[head * 3 + 0]);
                g1v[mt] = sigmoidf_(bf2f(gl[1]) + gb[head * 3 + 1]); g2v[mt] = sigmoidf_(bf2f(gl[2]) + gb[head * 3 + 2]);
#pragma unroll
                for (int n = 0; n < 4; ++n) outacc[mt][n] = outacc[mt][n] * g0;
            }
            LDS_WAIT();
            asm volatile("" ::: "memory");
            {
                const int tok8 = lane >> 3, jg = lane & 7;
                float sj[32];
#pragma unroll
                for (int q = 0; q < 8; ++q) { const f32x4 v = *(const LAS f32x4*)(scl + tok8 * 32 + 4 * q); sj[4 * q] = v.x; sj[4 * q + 1] = v.y; sj[4 * q + 2] = v.z; sj[4 * q + 3] = v.w; }
#pragma unroll
                for (int j = 0; j < 32; ++j) sj[j] = j <= x ? sj[j] + ((j == 0 || j == x || j == x - 1) ? 1000.0f : 0.f) : -INFINITY;
                unsigned bits = 0u;
                const f32x4 mv = *(const LAS f32x4*)(scl + tok8 * 32 + 4 * jg);
#pragma unroll
                for (int q = 0; q < 4; ++q) {
                    const int j = 4 * jg + q;
                    const float mine = j <= x ? mv[q] + ((j == 0 || j == x || j == x - 1) ? 1000.0f : 0.f) : -INFINITY;
                    int rank = 0;
#pragma unroll
                    for (int jj = 0; jj < 32; ++jj) rank += (sj[jj] > mine || (sj[jj] == mine && jj < j)) ? 1 : 0;
                    bits |= (j <= x && rank < 8) ? (1u << j) : 0u;
                }
                bits |= __shfl_xor(bits, 1); bits |= __shfl_xor(bits, 2); bits |= __shfl_xor(bits, 4);
                if (jg == 0) { msk[wid * 8 + tok8] = bits; atomicOr((unsigned*)umask, bits); }
            }
            __syncthreads();
#pragma unroll 1
            for (int pass = 0; pass < 2; ++pass) {
                const int jlo = pass ? (x >= 4 ? x - 4 : 0) : 0;
                const unsigned inrange = (x >= 31 ? 0xffffffffu : ((2u << x) - 1u)) & ~((1u << jlo) - 1u);
                unsigned bmask = pass ? inrange : (*umask & inrange);
                const bf16* Kb = pass ? KW : KS; const int cg = (pass ? 10 : 8) + g;
                unsigned tm[2], wm[2];
#pragma unroll
                for (int mt = 0; mt < 2; ++mt) {
                    tm[mt] = pass ? 0xffffffffu : msk[wid * 8 + 4 * mt + (fr >> 2)];
                    wm[mt] = pass ? 0xffffffffu : (msk[wid * 8 + 4 * mt] | msk[wid * 8 + 4 * mt + 1] | msk[wid * 8 + 4 * mt + 2] | msk[wid * 8 + 4 * mt + 3]);
                    wm[mt] = __builtin_amdgcn_readfirstlane(wm[mt]);
                }
                f32x4 o[2][4]; float mrun[2], lrun[2];
#pragma unroll
                for (int mt = 0; mt < 2; ++mt) { mrun[mt] = -INFINITY; lrun[mt] = 0.f;
#pragma unroll
                    for (int n = 0; n < 4; ++n) o[mt][n] = (f32x4){0.f, 0.f, 0.f, 0.f}; }
                const int srow = tid >> 3, sc16 = tid & 7;
                u32x4 pk0 = (u32x4){0u, 0u, 0u, 0u}, pv0 = pk0, pk1 = pk0, pv1 = pk0;
#define NSA_LD(jx, pk, pv) do { const bf16* ksrc = Kb + ((size_t)b * S + 64 * (jx) + srow) * 128 + g * 64 + sc16 * 8; const bf16* vsrc = VTA + ((size_t)((b * 32 + (jx)) * 12 + cg)) * 4096 + srow * 64 + sc16 * 8; \
                    pk = *(const u32x4*)ksrc; pv = *(const u32x4*)vsrc; } while (0)
                int j0 = __ffs(bmask) - 1; bmask &= bmask - 1u;
                int j1 = bmask ? __ffs(bmask) - 1 : -1; bmask &= bmask - 1u;
                NSA_LD(j0, pk0, pv0); if (j1 >= 0) NSA_LD(j1, pk1, pv1);
                int buf = 0;
                while (j0 >= 0) {
                    *(LAS u32x4*)(ktl + (buf * 2 + 0) * 64 * RS + srow * RS + sc16 * 8) = pk0; *(LAS u32x4*)(vtl + (buf * 2 + 0) * 64 * RS + srow * RS + sc16 * 8) = pv0;
                    if (j1 >= 0) { *(LAS u32x4*)(ktl + (buf * 2 + 1) * 64 * RS + srow * RS + sc16 * 8) = pk1; *(LAS u32x4*)(vtl + (buf * 2 + 1) * 64 * RS + srow * RS + sc16 * 8) = pv1; }
                    const int jn0 = bmask ? __ffs(bmask) - 1 : -1; bmask &= bmask - 1u;
                    const int jn1 = bmask ? __ffs(bmask) - 1 : -1; bmask &= bmask - 1u;
                    if (jn0 >= 0) NSA_LD(jn0, pk0, pv0);
                    if (jn1 >= 0) NSA_LD(jn1, pk1, pv1);
                    __syncthreads();
#pragma unroll 1
                    for (int sub = 0; sub < 2; ++sub) {
                        const int j = sub ? j1 : j0;
                        if (j < 0) break;
                        const LAS bf16* kt = ktl + (buf * 2 + sub) * 64 * RS + fr * RS + 8 * fq; const LAS bf16* vt = vtl + (buf * 2 + sub) * 64 * RS + fr * RS + 8 * fq;
#pragma unroll
                        for (int mt = 0; mt < 2; ++mt) {
                            if (!((wm[mt] >> j) & 1u)) continue;
                            f32x4 sc[4];
#pragma unroll
                            for (int t = 0; t < 4; ++t) { sc[t] = (f32x4){0.f, 0.f, 0.f, 0.f};
                                sc[t] = __builtin_amdgcn_mfma_f32_16x16x32_bf16(*(const LAS bf16x8*)(kt + t * 16 * RS), qf[mt][0], sc[t], 0, 0, 0);
                                sc[t] = __builtin_amdgcn_mfma_f32_16x16x32_bf16(*(const LAS bf16x8*)(kt + t * 16 * RS + 32), qf[mt][1], sc[t], 0, 0, 0); }
                            const int tl = tl0 + 4 * mt;
                            const bool rowok = (tm[mt] >> j) & 1u;
                            const int kphi = j == x ? tl : 63;
                            const int kplo = (pass && j == x - 4) ? tl + 1 : 0;
                            float bm = -INFINITY;
#pragma unroll
                            for (int t = 0; t < 4; ++t)
#pragma unroll
                                for (int r = 0; r < 4; ++r) { const int kp = 16 * t + 4 * fq + r; const bool v = rowok && kp <= kphi && kp >= kplo; sc[t][r] = v ? sc[t][r] : -INFINITY; bm = fmaxf(bm, sc[t][r]); }
                            bm = fmaxf(bm, __shfl_xor(bm, 16)); bm = fmaxf(bm, __shfl_xor(bm, 32));
                            const float mn = fmaxf(mrun[mt], bm); const float mns = mn == -INFINITY ? 0.f : mn;
                            const float alpha = __expf(mrun[mt] - mns);
                            float rs = 0.f;
#pragma unroll
                            for (int t = 0; t < 4; ++t)
#pragma unroll
                                for (int r = 0; r < 4; ++r) { sc[t][r] = __expf(sc[t][r] - mns); rs += sc[t][r]; }
                            rs += __shfl_xor(rs, 16); rs += __shfl_xor(rs, 32);
                            lrun[mt] = lrun[mt] * alpha + rs; mrun[mt] = mn;
                            bf16x8 pf[2];
#pragma unroll
                            for (int s = 0; s < 2; ++s) { u32x4 w; w.x = pk2(sc[2 * s].x, sc[2 * s].y); w.y = pk2(sc[2 * s].z, sc[2 * s].w); w.z = pk2(sc[2 * s + 1].x, sc[2 * s + 1].y); w.w = pk2(sc[2 * s + 1].z, sc[2 * s + 1].w);
                                pf[s] = __builtin_bit_cast(bf16x8, w); }
#pragma unroll
                            for (int n = 0; n < 4; ++n) { o[mt][n] = o[mt][n] * alpha;
                                o[mt][n] = __builtin_amdgcn_mfma_f32_16x16x32_bf16(*(const LAS bf16x8*)(vt + n * 16 * RS), pf[0], o[mt][n], 0, 0, 0);
                                o[mt][n] = __builtin_amdgcn_mfma_f32_16x16x32_bf16(*(const LAS bf16x8*)(vt + n * 16 * RS + 32), pf[1], o[mt][n], 0, 0, 0); }
                        }
                    }
                    j0 = jn0; j1 = jn1; buf ^= 1;
                }
#undef NSA_LD
#pragma unroll
                for (int mt = 0; mt < 2; ++mt) { const float sc_ = (pass ? g2v[mt] : g1v[mt]) / lrun[mt];
#pragma unroll
                    for (int n = 0; n < 4; ++n) outacc[mt][n] = outacc[mt][n] + o[mt][n] * sc_; }
                __syncthreads();
            }
#pragma unroll
            for (int mt = 0; mt < 2; ++mt) {
                bf16* dst = CAT + (tokbase + tl0 + 4 * mt) * 1024 + (g * 4 + (fr & 3)) * 64 + 4 * fq;
#pragma unroll
                for (int n = 0; n < 4; ++n) { u32x2 w; w.x = pk2(outacc[mt][n].x, outacc[mt][n].y); w.y = pk2(outacc[mt][n].z, outacc[mt][n].w); *(u32x2*)(dst + 16 * n) = w; }
            }
        }
    }
    __syncthreads();
}

__device__ __forceinline__ void phase_vtiles(KArgs A, int wv_, LAS unsigned char* lds) {
    const int tid_ = opaque_tid(wv_); const int wid = __builtin_amdgcn_readfirstlane(tid_ >> 6), lane = tid_ & 63; const int gw = blockIdx.x * 8 + wid, NGW = gridDim.x * 8;
    unsigned char* ws = opq(A->ws);
    const bf16* HY = (const bf16*)(ws + WS_BIG); bf16* VTA = (bf16*)(ws + WS_VTA);
    constexpr int TS = 66;
    LAS bf16* tl = (LAS bf16*)(lds + 65536) + wid * (64 * TS);
    for (int it = gw; it < NBATCH * 32 * 12; it += NGW) {
        const int cg = it % 12, bc = it / 12;
        const int colbase = cg < 8 ? C_VB + cg * 64 : (cg < 10 ? C_VS + (cg - 8) * 64 : C_VW + (cg - 10) * 64);
        const u32x4* src = (const u32x4*)(HY + (size_t)(bc * 64 + lane) * HYN + colbase);
        u32x4 w[8];
#pragma unroll
        for (int i = 0; i < 8; ++i) w[i] = src[i];
#pragma unroll
        for (int i = 0; i < 8; ++i) { LAS unsigned* d = (LAS unsigned*)(tl + lane * TS + 8 * i); d[0] = w[i].x; d[1] = w[i].y; d[2] = w[i].z; d[3] = w[i].w; }
        LDS_WAIT();
        bf16* dst = VTA + (size_t)it * 4096 + lane * 64;
#pragma unroll
        for (int p8 = 0; p8 < 8; ++p8) {
            unsigned short x[8];
#pragma unroll
            for (int j = 0; j < 8; ++j) x[j] = tl[kperm64(p8 * 8 + j) * TS + lane];
            u32x4 o; o.x = x[0] | ((unsigned)x[1] << 16); o.y = x[2] | ((unsigned)x[3] << 16); o.z = x[4] | ((unsigned)x[5] << 16); o.w = x[6] | ((unsigned)x[7] << 16);
            *(u32x4*)(dst + p8 * 8) = o;
        }
        LDS_WAIT();
    }
}

__device__ __forceinline__ float log_sigmoid16(float z) { return (fminf(z, 0.f) - __logf(1.0f + __expf(-fabsf(z)))) * (1.f / 16.f); }
#define GLA_Z(tokv) ({ float z_ = bias; _Pragma("unroll") for (int r_ = 0; r_ < 16; ++r_) z_ += __builtin_bit_cast(float, __builtin_amdgcn_readlane(__builtin_bit_cast(int, al[r_]), (tokv))) * wc[r_]; z_; })
#define GLA_LOAD_GATE() \
    float al[16], wc[16]; \
    { const u32x4* ap_ = (const u32x4*)(HY + (size_t)(tok0 + lane) * HYN + C_AL); const u32x4 a0_ = ap_[0], a1_ = ap_[1]; \
      al[0] = bflo(a0_.x); al[1] = bfhi(a0_.x); al[2] = bflo(a0_.y); al[3] = bfhi(a0_.y); al[4] = bflo(a0_.z); al[5] = bfhi(a0_.z); al[6] = bflo(a0_.w); al[7] = bfhi(a0_.w); \
      al[8] = bflo(a1_.x); al[9] = bfhi(a1_.x); al[10] = bflo(a1_.y); al[11] = bfhi(a1_.y); al[12] = bflo(a1_.z); al[13] = bfhi(a1_.z); al[14] = bflo(a1_.w); al[15] = bfhi(a1_.w); } \
    _Pragma("unroll") for (int r_ = 0; r_ < 16; ++r_) wc[r_] = A->in[I_WA2][(i * 16 + r_) * 256 + h * 64 + lane]; \
    const float bias = A->in[I_BA][i * 256 + h * 64 + lane];

__device__ __forceinline__ void phase_gla_a(KArgs A, int wv_, int i, LAS unsigned char* lds) {
    const int tid_ = opaque_tid(wv_); const int wid = __builtin_amdgcn_readfirstlane(tid_ >> 6), lane = tid_ & 63, fr = lane & 15, fq = lane >> 4; const int gw = blockIdx.x * 8 + wid, NGW = gridDim.x * 8;
    unsigned char* ws = opq(A->ws);
    const bf16* HY = (const bf16*)(ws + WS_BIG); const bf16* VTA = (const bf16*)(ws + WS_VTA); float* SLOC = (float*)(ws + WS_SLOC); float* DEC = (float*)(ws + WS_DEC);
    constexpr int RS = 72;
    LAS bf16* kh = (LAS bf16*)lds + wid * (64 * RS);
    (void)gw;
    for (int it = wid * (int)gridDim.x + (int)blockIdx.x; it < 1024; it += NGW) {
        const int c = it & 31, bh = it >> 5, b = bh >> 2, h = bh & 3; const size_t tok0 = (size_t)b * S + c * 64;
        GLA_LOAD_GATE();
        float bl = 0.f;
#pragma unroll 8
        for (int tk = 0; tk < 64; ++tk) bl += log_sigmoid16(GLA_Z(tk));
        float bc = 0.f;
        unsigned short kcol[64];
#pragma unroll
        for (int tk = 0; tk < 64; ++tk) kcol[tk] = HY[(tok0 + tk) * HYN + C_KB + h * 64 + lane];
#pragma unroll
        for (int tk = 0; tk < 64; ++tk) {
            bc += log_sigmoid16(GLA_Z(tk));
            kh[lane * RS + kpos64(tk)] = (bf16)f2bf(bf2f(kcol[tk]) * __expf(bl - bc));
        }
        DEC[it * 64 + lane] = __expf(bl);
        LDS_WAIT();
#pragma unroll
        for (int dvh = 0; dvh < 2; ++dvh) {
            const bf16* vt = VTA + ((size_t)((b * 32 + c) * 12 + h * 2 + dvh)) * 4096;
            bf16x8 vf[4][2];
#pragma unroll
            for (int n = 0; n < 4; ++n)
#pragma unroll
                for (int s = 0; s < 2; ++s) vf[n][s] = *(const bf16x8*)(vt + (16 * n + fr) * 64 + 32 * s + 8 * fq);
#pragma unroll
            for (int m = 0; m < 4; ++m) {
                const bf16x8 a0 = *(const LAS bf16x8*)(kh + (16 * m + fr) * RS + 8 * fq), a1 = *(const LAS bf16x8*)(kh + (16 * m + fr) * RS + 32 + 8 * fq);
#pragma unroll
                for (int n = 0; n < 4; ++n) {
                    f32x4 acc = (f32x4){0.f, 0.f, 0.f, 0.f};
                    acc = __builtin_amdgcn_mfma_f32_16x16x32_bf16(a0, vf[n][0], acc, 0, 0, 0);
                    acc = __builtin_amdgcn_mfma_f32_16x16x32_bf16(a1, vf[n][1], acc, 0, 0, 0);
                    float* dst = SLOC + ((size_t)it * 64 + 16 * m + 4 * fq) * 128 + dvh * 64 + 16 * n + fr;
                    dst[0] = acc.x; dst[128] = acc.y; dst[256] = acc.z; dst[384] = acc.w;
                }
            }
        }
        LDS_WAIT();
    }
}
__device__ __forceinline__ void phase_gla_c(KArgs A, int wv_, int i, LAS unsigned char* lds) {
    const int tid_ = opaque_tid(wv_); const int wid = __builtin_amdgcn_readfirstlane(tid_ >> 6), lane = tid_ & 63, fr = lane & 15, fq = lane >> 4; const int gw = blockIdx.x * 8 + wid, NGW = gridDim.x * 8;
    unsigned char* ws = opq(A->ws);
    const bf16* HY = (const bf16*)(ws + WS_BIG); const bf16* VTA = (const bf16*)(ws + WS_VTA); const bf16* STT = (const bf16*)(ws + WS_STT); bf16* CAT = (bf16*)(ws + WS_CAT);
    constexpr int RS = 72;
    LAS bf16* qs = (LAS bf16*)lds + wid * (128 * RS);
    LAS bf16* ks = qs + 64 * RS;
    const float* og = A->in[I_ONORM] + i * 128;
    (void)gw; (void)NGW;
    for (int blk = blockIdx.x; blk < 128; blk += gridDim.x) {
        {
            const float* SLOC = (const float*)(ws + WS_SLOC); const float* DEC = (const float*)(ws + WS_DEC); bf16* STw = (bf16*)(ws + WS_STT);
            const int tid = tid_, dv = tid & 127, ko = tid >> 7, bh = blk >> 2, c0 = (blk & 3) * 8;
            float sv[16];
#pragma unroll
            for (int j = 0; j < 16; ++j) sv[j] = 0.f;
#pragma unroll 4
            for (int c = 0; c < c0 + 8; ++c) {
                const size_t item = (size_t)bh * 32 + c;
                if (c >= c0) {
                    u32x4 o0, o1; o0.x = pk2(sv[0], sv[1]); o0.y = pk2(sv[2], sv[3]); o0.z = pk2(sv[4], sv[5]); o0.w = pk2(sv[6], sv[7]);
                    o1.x = pk2(sv[8], sv[9]); o1.y = pk2(sv[10], sv[11]); o1.z = pk2(sv[12], sv[13]); o1.w = pk2(sv[14], sv[15]);
                    u32x4* d = (u32x4*)(STw + (item * 128 + dv) * 64 + ko * 16); d[0] = o0; d[1] = o1;
                }
                if (c < c0 + 7) {
                    const float* sl = SLOC + (item * 64 + ko * 16) * 128 + dv; const float* dc = DEC + item * 64 + ko * 16;
#pragma unroll
                    for (int j = 0; j < 16; ++j) sv[j] = dc[j] * sv[j] + sl[j * 128];
                }
            }
            asm volatile("s_waitcnt vmcnt(0)" ::: "memory");
            __syncthreads();
        }
        const int it = blk * 8 + wid;
        const int c = it & 31, bh = it >> 5, b = bh >> 2, h = bh & 3; const size_t tok0 = (size_t)b * S + c * 64;
        GLA_LOAD_GATE();
        float bc = 0.f;
        unsigned short qcol[64], kcol[64];
#pragma unroll
        for (int tk = 0; tk < 64; ++tk) { const bf16* row = HY + (tok0 + tk) * HYN; qcol[tk] = row[C_QB + h * 64 + lane]; kcol[tk] = row[C_KB + h * 64 + lane]; }
#pragma unroll
        for (int tk = 0; tk < 64; ++tk) {
            bc += log_sigmoid16(GLA_Z(tk));
            const float eb = __expf(bc);
            qs[tk * RS + lane] = (bf16)f2bf(bf2f(qcol[tk]) * 0.125f * eb); ks[tk * RS + lane] = (bf16)f2bf(bf2f(kcol[tk]) / eb);
        }
        LDS_WAIT();
        bf16x8 st[8][2];
#pragma unroll
        for (int n = 0; n < 8; ++n)
#pragma unroll
            for (int s = 0; s < 2; ++s) st[n][s] = *(const bf16x8*)(STT + ((size_t)it * 128 + 16 * n + fr) * 64 + 32 * s + 8 * fq);
        const bf16* vt = VTA + ((size_t)((b * 32 + c) * 12 + h * 2)) * 4096;
#pragma unroll
        for (int mi = 0; mi < 4; ++mi) {
            const bf16x8 q0 = *(const LAS bf16x8*)(qs + (16 * mi + fr) * RS + 8 * fq), q1 = *(const LAS bf16x8*)(qs + (16 * mi + fr) * RS + 32 + 8 * fq);
            f32x4 sc[4];
#pragma unroll
            for (int t = 0; t < 4; ++t) {
                sc[t] = (f32x4){0.f, 0.f, 0.f, 0.f};
                if (t <= mi) {
                    const bf16x8 k0 = *(const LAS bf16x8*)(ks + (16 * t + fr) * RS + 8 * fq), k1 = *(const LAS bf16x8*)(ks + (16 * t + fr) * RS + 32 + 8 * fq);
                    sc[t] = __builtin_amdgcn_mfma_f32_16x16x32_bf16(k0, q0, sc[t], 0, 0, 0);
                    sc[t] = __builtin_amdgcn_mfma_f32_16x16x32_bf16(k1, q1, sc[t], 0, 0, 0);
                    if (t == mi) {
                        sc[t].x = (4 * fq + 0 <= fr) ? sc[t].x : 0.f; sc[t].y = (4 * fq + 1 <= fr) ? sc[t].y : 0.f; sc[t].z = (4 * fq + 2 <= fr) ? sc[t].z : 0.f; sc[t].w = (4 * fq + 3 <= fr) ? sc[t].w : 0.f; }
                }
            }
            bf16x8 pf[2];
#pragma unroll
            for (int s = 0; s < 2; ++s) { u32x4 w; w.x = pk2(sc[2 * s].x, sc[2 * s].y); w.y = pk2(sc[2 * s].z, sc[2 * s].w); w.z = pk2(sc[2 * s + 1].x, sc[2 * s + 1].y); w.w = pk2(sc[2 * s + 1].z, sc[2 * s + 1].w);
                pf[s] = __builtin_bit_cast(bf16x8, w); }
            f32x4 o[8]; float ssq = 0.f;
#pragma unroll
            for (int n = 0; n < 8; ++n) {
                o[n] = (f32x4){0.f, 0.f, 0.f, 0.f};
                o[n] = __builtin_amdgcn_mfma_f32_16x16x32_bf16(st[n][0], q0, o[n], 0, 0, 0);
                o[n] = __builtin_amdgcn_mfma_f32_16x16x32_bf16(st[n][1], q1, o[n], 0, 0, 0);
                const bf16* vrow = vt + (size_t)(n >> 2) * 4096 + (16 * (n & 3) + fr) * 64 + 8 * fq;
                o[n] = __builtin_amdgcn_mfma_f32_16x16x32_bf16(*(const bf16x8*)vrow, pf[0], o[n], 0, 0, 0);
                if (mi >= 2) o[n] = __builtin_amdgcn_mfma_f32_16x16x32_bf16(*(const bf16x8*)(vrow + 32), pf[1], o[n], 0, 0, 0);
                ssq += (o[n].x * o[n].x + o[n].y * o[n].y) + (o[n].z * o[n].z + o[n].w * o[n].w);
            }
            ssq += __shfl_xor(ssq, 16); ssq += __shfl_xor(ssq, 32);
            const float rstd = rsqrtf(ssq * (1.f / 128.f) + EPS);
            const size_t tok = tok0 + 16 * mi + fr;
#pragma unroll
            for (int n = 0; n < 8; ++n) {
                const int dv = 16 * n + 4 * fq;
                const u32x2 rw = *(const u32x2*)(HY + tok * HYN + C_RB + h * 128 + dv); const f32x4 g = *(const f32x4*)(og + dv);
                const float r0 = bflo(rw.x), r1 = bfhi(rw.x), r2 = bflo(rw.y), r3 = bfhi(rw.y);
                u32x2 w; w.x = pk2(o[n].x * rstd * g.x * (r0 * sigmoidf_(r0)), o[n].y * rstd * g.y * (r1 * sigmoidf_(r1)));
                w.y = pk2(o[n].z * rstd * g.z * (r2 * sigmoidf_(r2)), o[n].w * rstd * g.w * (r3 * sigmoidf_(r3)));
                *(u32x2*)(CAT + tok * 1024 + 512 + h * 128 + dv) = w;
            }
        }
        LDS_WAIT();
        __syncthreads();
    }
}

__device__ __forceinline__ void phase_sgu_mix(KArgs A, int wv_, int i, LAS unsigned char* lds) {
    const int tid = opaque_tid(wv_), wid = __builtin_amdgcn_readfirstlane(tid >> 6), lane = tid & 63;
    unsigned char* ws = opq(A->ws);
    const bf16* U = (const bf16*)(ws + WS_U); const bf16* V = (const bf16*)(ws + WS_V); bf16* UM = (bf16*)(ws + WS_UM);
    LAS float* vt = (LAS float*)lds;
    LAS float* st = vt + 128 * 256;
    const float* lng = A->in[I_LNG] + i * 2048; const float* lnb = A->in[I_LNB] + i * 2048;
    for (int it = blockIdx.x; it < NBATCH * 16 * 8; it += gridDim.x) {
        const int g = it & 7, n = (it >> 3) & 15, b = it >> 7;
        const size_t tok0 = (size_t)b * S + n * 128;
        __syncthreads();
        for (int s = wid * 16; s < wid * 16 + 16; ++s) {
            const u32x4* vr = (const u32x4*)(V + (tok0 + s) * 2048) + lane;
            float x[32]; float sum = 0.f;
#pragma unroll
            for (int j = 0; j < 4; ++j) { const u32x4 w = vr[64 * j];
                x[8 * j + 0] = bflo(w.x); x[8 * j + 1] = bfhi(w.x); x[8 * j + 2] = bflo(w.y); x[8 * j + 3] = bfhi(w.y); x[8 * j + 4] = bflo(w.z); x[8 * j + 5] = bfhi(w.z); x[8 * j + 6] = bflo(w.w); x[8 * j + 7] = bfhi(w.w); }
#pragma unroll
            for (int j = 0; j < 32; ++j) sum += x[j];
            const float mean = wave_sum(sum) * (1.f / 2048.f); float q = 0.f;
#pragma unroll
            for (int j = 0; j < 32; ++j) { const float d = x[j] - mean; q += d * d; }
            const float rstd = rsqrtf(wave_sum(q) * (1.f / 2048.f) + EPS);
            const u32x2 w = *((const u32x2*)(V + (tok0 + s) * 2048 + g * 256) + lane);
            const f32x4 gg = *(const f32x4*)(lng + g * 256 + 4 * lane), bb = *(const f32x4*)(lnb + g * 256 + 4 * lane);
            f32x4 o; o.x = (bflo(w.x) - mean) * rstd * gg.x + bb.x; o.y = (bfhi(w.x) - mean) * rstd * gg.y + bb.y; o.z = (bflo(w.y) - mean) * rstd * gg.z + bb.z; o.w = (bfhi(w.y) - mean) * rstd * gg.w + bb.w;
            *(LAS f32x4*)(vt + s * 256 + 4 * lane) = o;
            (void)st;
        }
        __syncthreads();
        const int c = tid & 255, th = tid >> 8;
        const float* wsg = A->in[I_SGWS] + (size_t)(i * 8 + g) * 128 * 128; const float* bsg = A->in[I_SGBS] + (i * 8 + g) * 128;
        for (int tt = 0; tt < 64; ++tt) {
            const int t = 2 * tt + th;
            const float* wr = wsg + t * 128;
            float acc = 0.f;
            for (int s = 0; s <= t; ++s) acc += wr[s] * vt[s * 256 + c];
            acc += bsg[t];
            const float u = bf2f(U[(tok0 + t) * 2048 + g * 256 + c]);
            UM[(tok0 + t) * 2048 + g * 256 + c] = (bf16)f2bf(u * acc);
        }
    }
    __syncthreads();
}


__device__ __forceinline__ void phase_sgu_mix_mfma(KArgs A, int wv_, int i, LAS unsigned char* lds) {
    const int tid = opaque_tid(wv_), wid = __builtin_amdgcn_readfirstlane(tid >> 6), lane = tid & 63, fr = lane & 15, fq = lane >> 4;
    unsigned char* ws = opq(A->ws);
    const bf16* U = (const bf16*)(ws + WS_U); const bf16* V = (const bf16*)(ws + WS_V); bf16* UM = (bf16*)(ws + WS_UM);
    const bf16* WSB = (const bf16*)(ws + WS_WSB) + (size_t)i * 8 * 16384; const float* M0 = (const float*)(ws + WS_M0) + i * 8 * 128;
    constexpr int VS = 136;
    LAS bf16* vT = (LAS bf16*)lds;
    LAS float* st = (LAS float*)(lds + 256 * VS * 2);
    const float* lng = A->in[I_LNG] + i * 2048; const float* lnb = A->in[I_LNB] + i * 2048; const float* bsg = A->in[I_SGBS] + i * 8 * 128;
    for (int it = blockIdx.x; it < 256; it += gridDim.x) {
        const int gh = it & 1, n_ = (it >> 1) & 15, b = it >> 5; const size_t tok0 = (size_t)b * S + n_ * 128;
        __syncthreads();
        for (int s4 = wid * 16; s4 < wid * 16 + 16; s4 += 4) {
            u32x4 w[4][4];
#pragma unroll
            for (int rr = 0; rr < 4; ++rr) { const u32x4* vr = (const u32x4*)(V + (tok0 + s4 + rr) * 2048) + lane;
#pragma unroll
                for (int j = 0; j < 4; ++j) w[rr][j] = vr[64 * j]; }
#pragma unroll
            for (int rr = 0; rr < 4; ++rr) {
                float sum = 0.f, sq = 0.f;
#pragma unroll
                for (int j = 0; j < 4; ++j) { const float x0 = bflo(w[rr][j].x), x1 = bfhi(w[rr][j].x), x2 = bflo(w[rr][j].y), x3 = bfhi(w[rr][j].y), x4 = bflo(w[rr][j].z), x5 = bfhi(w[rr][j].z), x6 = bflo(w[rr][j].w), x7 = bfhi(w[rr][j].w);
                    sum += ((x0 + x1) + (x2 + x3)) + ((x4 + x5) + (x6 + x7)); sq += ((x0 * x0 + x1 * x1) + (x2 * x2 + x3 * x3)) + ((x4 * x4 + x5 * x5) + (x6 * x6 + x7 * x7)); }
                sum = wave_sum(sum); sq = wave_sum(sq);
                const float mean = sum * (1.f / 2048.f); const float var = fmaxf(sq * (1.f / 2048.f) - mean * mean, 0.f);
                if (lane == 0) { st[2 * (s4 + rr)] = mean; st[2 * (s4 + rr) + 1] = rsqrtf(var + EPS); }
            }
        }
#pragma unroll 1
        for (int gg = 0; gg < 4; ++gg) {
            const int g = gh * 4 + gg;
            __syncthreads();
            {
                const int s = tid & 127, cq = tid >> 7;
                const float mean = st[2 * s], rstd = st[2 * s + 1];
                const u32x4* src = (const u32x4*)(V + (tok0 + s) * 2048 + g * 256 + cq * 64);
#pragma unroll
                for (int i8 = 0; i8 < 8; ++i8) {
                    const u32x4 w = src[i8];
                    LAS bf16* d = vT + (cq * 64 + i8 * 8) * VS + s;
                    d[0 * VS] = (bf16)f2bf((bflo(w.x) - mean) * rstd); d[1 * VS] = (bf16)f2bf((bfhi(w.x) - mean) * rstd); d[2 * VS] = (bf16)f2bf((bflo(w.y) - mean) * rstd); d[3 * VS] = (bf16)f2bf((bfhi(w.y) - mean) * rstd);
                    d[4 * VS] = (bf16)f2bf((bflo(w.z) - mean) * rstd); d[5 * VS] = (bf16)f2bf((bfhi(w.z) - mean) * rstd); d[6 * VS] = (bf16)f2bf((bflo(w.w) - mean) * rstd); d[7 * VS] = (bf16)f2bf((bfhi(w.w) - mean) * rstd);
                }
            }
            __syncthreads();
            bf16x8 vf[2][4];
#pragma unroll
            for (int m = 0; m < 2; ++m)
#pragma unroll
                for (int k = 0; k < 4; ++k) vf[m][k] = *(const LAS bf16x8*)(vT + (32 * wid + 16 * m + fr) * VS + 32 * k + 8 * fq);
            const bf16* wb = WSB + ((size_t)g * 128 + fr) * 128 + 8 * fq;
            f32x4 gc[2], bc[2];
#pragma unroll
            for (int m = 0; m < 2; ++m) { gc[m] = *(const f32x4*)(lng + g * 256 + 32 * wid + 16 * m + 4 * fq); bc[m] = *(const f32x4*)(lnb + g * 256 + 32 * wid + 16 * m + 4 * fq); }
#pragma unroll
            for (int n = 0; n < 8; ++n) {
                f32x4 a0 = (f32x4){0.f, 0.f, 0.f, 0.f}, a1 = (f32x4){0.f, 0.f, 0.f, 0.f};
                asm volatile("" : "+v"(wb));
#pragma unroll
                for (int k = 0; k < 4; ++k) if (k <= (n >> 1)) {
                    const bf16x8 wf = *(const bf16x8*)(wb + 32 * k);
                    a0 = __builtin_amdgcn_mfma_f32_16x16x32_bf16(vf[0][k], wf, a0, 0, 0, 0);
                    a1 = __builtin_amdgcn_mfma_f32_16x16x32_bf16(vf[1][k], wf, a1, 0, 0, 0); }
                wb += 16 * 128;
                const int t = 16 * n + fr; const float m0 = M0[g * 128 + t], bsv = bsg[g * 128 + t];
                const size_t ro = (tok0 + t) * 2048 + g * 256 + 32 * wid + 4 * fq;
#pragma unroll
                for (int m = 0; m < 2; ++m) {
                    const f32x4 a = m ? a1 : a0;
                    const u32x2 uw = *(const u32x2*)(U + ro + 16 * m);
                    u32x2 w; w.x = pk2((a.x * gc[m].x + bc[m].x * m0 + bsv) * bflo(uw.x), (a.y * gc[m].y + bc[m].y * m0 + bsv) * bfhi(uw.x));
                    w.y = pk2((a.z * gc[m].z + bc[m].z * m0 + bsv) * bflo(uw.y), (a.w * gc[m].w + bc[m].w * m0 + bsv) * bfhi(uw.y));
                    *(u32x2*)(UM + ro + 16 * m) = w;
                }
                asm volatile("" ::: "memory");
            }
        }
    }
    __syncthreads();
}

__device__ __forceinline__ void phase_rownorm(KArgs A, int wv_) {
    const int tid_ = opaque_tid(wv_); const int wid = __builtin_amdgcn_readfirstlane(tid_ >> 6), lane = tid_ & 63; const int gw = blockIdx.x * 8 + wid, NGW = gridDim.x * 8;
    bf16* XN = (bf16*)(opq(A->ws) + WS_XN); const float* X = A->out;
    f32x4 v[4], vn[4];
    if (gw < T) {
#pragma unroll
        for (int j = 0; j < 4; ++j) v[j] = ((const f32x4*)(X + (size_t)gw * D) + lane)[64 * j];
    }
    for (int m = gw; m < T; m += NGW) {
        const int mn = m + NGW < T ? m + NGW : m;
#pragma unroll
        for (int j = 0; j < 4; ++j) vn[j] = ((const f32x4*)(X + (size_t)mn * D) + lane)[64 * j];
        float s = 0.f;
#pragma unroll
        for (int j = 0; j < 4; ++j) s += (v[j].x * v[j].x + v[j].y * v[j].y) + (v[j].z * v[j].z + v[j].w * v[j].w);
        const float rstd = rsqrtf(wave_sum(s) * (1.f / 1024.f) + EPS);
        u32x2* o8 = (u32x2*)(XN + (size_t)m * D) + lane;
#pragma unroll
        for (int j = 0; j < 4; ++j) { u32x2 w; w.x = pk2(v[j].x * rstd, v[j].y * rstd); w.y = pk2(v[j].z * rstd, v[j].w * rstd); o8[64 * j] = w; }
#pragma unroll
        for (int j = 0; j < 4; ++j) v[j] = vn[j];
    }
}

__device__ __forceinline__ void phase_xattn(KArgs A, int wv_, int L, LAS unsigned char* lds) {
    const int tid = opaque_tid(wv_), wid = __builtin_amdgcn_readfirstlane(tid >> 6), lane = tid & 63;
    unsigned char* ws = opq(A->ws);
    const bf16* QX = (const bf16*)(ws + WS_QX); const bf16* KV = (const bf16*)(ws + WS_KV); bf16* OX = (bf16*)(ws + WS_OX);
    constexpr int KSTR = 129;
    LAS unsigned* kl = (LAS unsigned*)lds;
    LAS float* qb = (LAS float*)(lds + 132096) + wid * 256;
    LAS float* pb = (LAS float*)(lds + 132096 + 8192) + wid * 256;
    const float* qg = A->in[I_XQN] + L * 256;
    for (int it = blockIdx.x; it < NBATCH * 4 * 8; it += gridDim.x) {
        const int qc = it & 7, h = (it >> 3) & 3, b = it >> 5;
        __syncthreads();
        for (int e = tid; e < 256 * 128; e += 512) { const int m = e >> 7, dw = e & 127;
            kl[m * KSTR + dw] = *((const unsigned*)(KV + (size_t)(b * 256 + m) * 8192 + L * 2048 + h * 256) + dw); }
        __syncthreads();
        const bf16* Vb = KV + (size_t)(b * 256) * 8192 + L * 2048 + 1024 + h * 256;
        for (int tq = 0; tq < 32; ++tq) {
            const size_t tok = (size_t)b * S + qc * 256 + wid * 32 + tq;
            const u32x2 qw = *((const u32x2*)(QX + tok * 1024 + h * 256) + lane);
            const float q0 = bflo(qw.x), q1 = bfhi(qw.x), q2 = bflo(qw.y), q3 = bfhi(qw.y);
            const float rstd = rsqrtf(wave_sum(q0 * q0 + q1 * q1 + q2 * q2 + q3 * q3) * (1.f / 256.f) + EPS);
            const f32x4 gg = *(const f32x4*)(qg + 4 * lane);
            *(LAS f32x4*)(qb + 4 * lane) = (f32x4){q0 * rstd * gg.x, q1 * rstd * gg.y, q2 * rstd * gg.z, q3 * rstd * gg.w};
            LDS_WAIT();
            float s0 = 0.f, s1 = 0.f, s2 = 0.f, s3 = 0.f;
#pragma unroll 4
            for (int dw = 0; dw < 128; ++dw) {
                const f32x2 qq = *(const LAS f32x2*)(qb + 2 * dw);
                const unsigned k0 = kl[lane * KSTR + dw], k1 = kl[(lane + 64) * KSTR + dw], k2 = kl[(lane + 128) * KSTR + dw], k3 = kl[(lane + 192) * KSTR + dw];
                s0 += qq.x * bflo(k0) + qq.y * bfhi(k0); s1 += qq.x * bflo(k1) + qq.y * bfhi(k1);
                s2 += qq.x * bflo(k2) + qq.y * bfhi(k2); s3 += qq.x * bflo(k3) + qq.y * bfhi(k3);
            }
            const float mx = wave_max(fmaxf(fmaxf(s0, s1), fmaxf(s2, s3)));
            const float e0 = __expf(s0 - mx), e1 = __expf(s1 - mx), e2 = __expf(s2 - mx), e3 = __expf(s3 - mx);
            const float inv = 1.f / wave_sum((e0 + e1) + (e2 + e3));
            pb[lane] = e0 * inv; pb[lane + 64] = e1 * inv; pb[lane + 128] = e2 * inv; pb[lane + 192] = e3 * inv;
            LDS_WAIT();
            float o0 = 0.f, o1 = 0.f, o2 = 0.f, o3 = 0.f;
#pragma unroll 8
            for (int m = 0; m < 256; ++m) {
                const float p = pb[m];
                const u32x2 vw = *((const u32x2*)(Vb + (size_t)m * 8192) + lane);
                o0 += p * bflo(vw.x); o1 += p * bfhi(vw.x); o2 += p * bflo(vw.y); o3 += p * bfhi(vw.y);
            }
            u32x2 ow; ow.x = pk2(o0, o1); ow.y = pk2(o2, o3);
            *((u32x2*)(OX + tok * 1024 + h * 256) + lane) = ow;
            LDS_WAIT();
        }
    }
    __syncthreads();
}


__device__ __forceinline__ int kperm32(int p) { const int fq = (p >> 3) & 3, j = p & 7; return (p & ~31) + 16 * (j >> 2) + 4 * fq + (j & 3); }
__device__ __forceinline__ void phase_vtrans(KArgs A, int wv_, LAS unsigned char* lds) {
    const int tid = opaque_tid(wv_);
    unsigned char* ws = opq(A->ws);
    const bf16* KV = (const bf16*)(ws + WS_KV); bf16* VT = (bf16*)(ws + WS_VT);
    LAS bf16* vt = (LAS bf16*)lds;
    constexpr int VS = 258;
    for (int it = blockIdx.x; it < DEPTH * NBATCH * 4; it += gridDim.x) {
        const int h = it & 3, b = (it >> 2) & 7, l = it >> 5;
        __syncthreads();
        for (int e = tid; e < 256 * 32; e += 512) { const int m = e >> 5, c8 = e & 31;
            const u32x4 w = *(const u32x4*)(KV + (size_t)(b * 256 + m) * 8192 + l * 2048 + 1024 + h * 256 + c8 * 8);
            LAS unsigned* d = (LAS unsigned*)(vt + m * VS + c8 * 8); d[0] = w.x; d[1] = w.y; d[2] = w.z; d[3] = w.w; }
        __syncthreads();
        for (int e = tid; e < 256 * 32; e += 512) { const int dv = e & 255, p8 = e >> 8;
            unsigned short x[8];
#pragma unroll
            for (int j = 0; j < 8; ++j) x[j] = vt[kperm32(p8 * 8 + j) * VS + dv];
            u32x4 o; o.x = x[0] | ((unsigned)x[1] << 16); o.y = x[2] | ((unsigned)x[3] << 16); o.z = x[4] | ((unsigned)x[5] << 16); o.w = x[6] | ((unsigned)x[7] << 16);
            *(u32x4*)(VT + ((size_t)it * 256 + dv) * 256 + p8 * 8) = o; }
    }
    __syncthreads();
}

__device__ __forceinline__ void phase_xattn_mfma(KArgs A, int wv_, int L, LAS unsigned char* lds) {
    const int tid = opaque_tid(wv_), wid = __builtin_amdgcn_readfirstlane(tid >> 6), lane = tid & 63, fr = lane & 15, fq = lane >> 4;
    unsigned char* ws = opq(A->ws);
    const bf16* QX = (const bf16*)(ws + WS_QX); const bf16* KV = (const bf16*)(ws + WS_KV); const bf16* VT = (const bf16*)(ws + WS_VT); bf16* OX = (bf16*)(ws + WS_OX);
    constexpr int RS = 264;
    LAS bf16* kl = (LAS bf16*)lds;
    const float* qg = A->in[I_XQN] + L * 256;
    for (int it = blockIdx.x; it < NBATCH * 4 * 8; it += gridDim.x) {
        const int qt = it & 7, h = (it >> 3) & 3, b = it >> 5;
        __syncthreads();
        {
            const int row = tid >> 1, hf = tid & 1;
            const u32x4* src = (const u32x4*)(KV + (size_t)(b * 256 + row) * 8192 + L * 2048 + h * 256 + hf * 128);
#pragma unroll
            for (int i0 = 0; i0 < 16; i0 += 8) {
                u32x4 w[8];
#pragma unroll
                for (int i = 0; i < 8; ++i) w[i] = src[i0 + i];
#pragma unroll
                for (int i = 0; i < 8; ++i) *(LAS u32x4*)(kl + row * RS + hf * 128 + (i0 + i) * 8) = w[i];
            }
        }
        const size_t tok0 = (size_t)b * S + qt * 256 + wid * 32 + fr;
        u32x4 qw0[8], qw1[8];
#pragma unroll
        for (int s = 0; s < 8; ++s) { qw0[s] = *(const u32x4*)(QX + tok0 * 1024 + h * 256 + 32 * s + 8 * fq); qw1[s] = *(const u32x4*)(QX + (tok0 + 16) * 1024 + h * 256 + 32 * s + 8 * fq); }
        __syncthreads();
        bf16x8 pf0[8], pf1[8]; float inv0, inv1;
        auto s_part = [&](const u32x4 (&qw)[8], bf16x8 (&pf)[8], float& inv) __attribute__((always_inline)) {
            float ssq = 0.f;
#pragma unroll
            for (int s = 0; s < 8; ++s) {
                const float a0 = bflo(qw[s].x), a1 = bfhi(qw[s].x), a2 = bflo(qw[s].y), a3 = bfhi(qw[s].y), a4 = bflo(qw[s].z), a5 = bfhi(qw[s].z), a6 = bflo(qw[s].w), a7 = bfhi(qw[s].w);
                ssq += (a0 * a0 + a1 * a1) + (a2 * a2 + a3 * a3) + (a4 * a4 + a5 * a5) + (a6 * a6 + a7 * a7);
            }
            ssq += __shfl_xor(ssq, 16); ssq += __shfl_xor(ssq, 32);
            const float rstd = rsqrtf(ssq * (1.f / 256.f) + EPS);
            bf16x8 qf[8];
#pragma unroll
            for (int s = 0; s < 8; ++s) qf[s] = __builtin_bit_cast(bf16x8, qw[s]);
            f32x4 sc[16];
#pragma unroll
            for (int hf = 0; hf < 2; ++hf) {
                unsigned kb = (unsigned)(size_t)(kl + (128 * hf + fr) * RS + 8 * fq); asm volatile("" : "+v"(kb));
#pragma unroll
                for (int t8 = 0; t8 < 8; ++t8) { const int t = 8 * hf + t8; sc[t] = (f32x4){0.f, 0.f, 0.f, 0.f};
#pragma unroll
                    for (int s = 0; s < 8; ++s) { const bf16x8 kf = *(const LAS bf16x8*)(size_t)(kb + (unsigned)((16 * t8 * RS + 32 * s) * 2));
                        sc[t] = __builtin_amdgcn_mfma_f32_16x16x32_bf16(kf, qf[s], sc[t], 0, 0, 0); }
                    if (t & 1) asm volatile("" ::: "memory"); }
            }
            float mx = -INFINITY;
#pragma unroll
            for (int t = 0; t < 16; ++t) mx = fmaxf(mx, fmaxf(fmaxf(sc[t].x, sc[t].y), fmaxf(sc[t].z, sc[t].w)));
            mx = fmaxf(mx, __shfl_xor(mx, 16)); mx = fmaxf(mx, __shfl_xor(mx, 32));
            float lsum = 0.f;
#pragma unroll
            for (int t = 0; t < 16; ++t) { sc[t].x = __expf((sc[t].x - mx) * rstd); sc[t].y = __expf((sc[t].y - mx) * rstd); sc[t].z = __expf((sc[t].z - mx) * rstd); sc[t].w = __expf((sc[t].w - mx) * rstd); lsum += (sc[t].x + sc[t].y) + (sc[t].z + sc[t].w); }
            lsum += __shfl_xor(lsum, 16); lsum += __shfl_xor(lsum, 32);
            inv = 1.f / lsum;
#pragma unroll
            for (int s = 0; s < 8; ++s) { u32x4 w; w.x = pk2(sc[2 * s].x, sc[2 * s].y); w.y = pk2(sc[2 * s].z, sc[2 * s].w); w.z = pk2(sc[2 * s + 1].x, sc[2 * s + 1].y); w.w = pk2(sc[2 * s + 1].z, sc[2 * s + 1].w);
                pf[s] = __builtin_bit_cast(bf16x8, w); }
        };
        s_part(qw0, pf0, inv0);
        s_part(qw1, pf1, inv1);
        __syncthreads();
        {
            const int row = tid >> 1, hf = tid & 1;
            const u32x4* src = (const u32x4*)(VT + ((size_t)((L * 8 + b) * 4 + h) * 256 + row) * 256 + hf * 128);
#pragma unroll
            for (int i0 = 0; i0 < 16; i0 += 8) {
                u32x4 w[8];
#pragma unroll
                for (int i = 0; i < 8; ++i) w[i] = src[i0 + i];
#pragma unroll
                for (int i = 0; i < 8; ++i) *(LAS u32x4*)(kl + row * RS + hf * 128 + (i0 + i) * 8) = w[i];
            }
        }
        __syncthreads();
#pragma unroll
        for (int hf = 0; hf < 2; ++hf) {
            unsigned vb = (unsigned)(size_t)(kl + (128 * hf + fr) * RS + 8 * fq); asm volatile("" : "+v"(vb));
#pragma unroll
            for (int n8 = 0; n8 < 8; ++n8) { const int n = 8 * hf + n8; f32x4 o0 = (f32x4){0.f, 0.f, 0.f, 0.f}, o1 = o0;
#pragma unroll
                for (int s = 0; s < 8; ++s) { const bf16x8 vf = *(const LAS bf16x8*)(size_t)(vb + (unsigned)((16 * n8 * RS + 32 * s) * 2));
                    o0 = __builtin_amdgcn_mfma_f32_16x16x32_bf16(vf, pf0[s], o0, 0, 0, 0);
                    o1 = __builtin_amdgcn_mfma_f32_16x16x32_bf16(vf, pf1[s], o1, 0, 0, 0); }
                u32x2 w0, w1; w0.x = pk2(o0.x * inv0, o0.y * inv0); w0.y = pk2(o0.z * inv0, o0.w * inv0); w1.x = pk2(o1.x * inv1, o1.y * inv1); w1.y = pk2(o1.z * inv1, o1.w * inv1);
                *(u32x2*)(OX + tok0 * 1024 + h * 256 + 16 * n + 4 * fq) = w0;
                *(u32x2*)(OX + (tok0 + 16) * 1024 + h * 256 + 16 * n + 4 * fq) = w1;
                if (n & 1) asm volatile("" ::: "memory"); }
        }
    }
    __syncthreads();
}

__device__ __forceinline__ void phase_route(KArgs A, int wv_, int L, LAS unsigned char* lds) {
    const int tid_ = opaque_tid(wv_); const int wid = __builtin_amdgcn_readfirstlane(tid_ >> 6), lane = tid_ & 63;
    unsigned char* ws = opq(A->ws);
    const float* RW = (const float*)(ws + WS_RW) + (size_t)L * NEXP * D;
    unsigned* cnt = (unsigned*)(ws + WS_CTL) + CW_CNT + L * 64;
    int* list = (int*)(ws + WS_LIST); int* te = (int*)(ws + WS_TOK); int* tp = te + 2 * T; float* tw = (float*)(tp + 2 * T);
    bf16* XN = (bf16*)(ws + WS_XN);
    LAS float* rwl = (LAS float*)lds;
    LAS unsigned* lcnt = (LAS unsigned*)(lds + 65536);
    LAS unsigned* lbase = lcnt + 16;
    const float rbv = A->in[I_RB][lane >> 2];
    for (int e4 = tid_; e4 < NEXP * D / 4; e4 += 512) *(LAS f32x4*)(rwl + 4 * e4) = *(const f32x4*)(RW + 4 * e4);
    for (int blk = blockIdx.x; blk < T / 64; blk += gridDim.x) {
        __syncthreads();
        if (tid_ < 16) lcnt[tid_] = 0u;
        __syncthreads();
        int e0s = 0, e1s = 0, r0s = 0, r1s = 0; float w0s = 0.f;
        f32x4 v[4], vn[4];
#pragma unroll
        for (int j = 0; j < 4; ++j) v[j] = ((const f32x4*)(A->out + (size_t)(blk * 64 + wid * 8) * D) + lane)[64 * j];
#pragma unroll 1
        for (int q = 0; q < 8; ++q) {
            const int t = blk * 64 + wid * 8 + q;
            { const f32x4* xn_ = (const f32x4*)(A->out + (size_t)(t + (q < 7 ? 1 : 0)) * D) + lane;
#pragma unroll
              for (int j = 0; j < 4; ++j) vn[j] = xn_[64 * j]; }
            float s = 0.f;
#pragma unroll
            for (int j = 0; j < 4; ++j) s += (v[j].x * v[j].x + v[j].y * v[j].y) + (v[j].z * v[j].z + v[j].w * v[j].w);
            const float rstd = rsqrtf(wave_sum(s) * (1.f / 1024.f) + EPS);
            u32x2* o8 = (u32x2*)(XN + (size_t)t * D) + lane;
#pragma unroll
            for (int j = 0; j < 4; ++j) { u32x2 w; w.x = pk2(v[j].x * rstd, v[j].y * rstd); w.y = pk2(v[j].z * rstd, v[j].w * rstd); o8[64 * j] = w; }
            float a[16];
#pragma unroll
            for (int e = 0; e < 16; ++e) {
                const LAS f32x4* wr = (const LAS f32x4*)(rwl + e * D) + lane; float acc = 0.f;
#pragma unroll
                for (int j = 0; j < 4; ++j) { const f32x4 w = wr[64 * j]; acc += (v[j].x * w.x + v[j].y * w.y) + (v[j].z * w.z + v[j].w * w.w); }
                a[e] = acc;
            }
            float a8[8], a4[4], a2[2], a1;
            { const bool up = lane & 32;
#pragma unroll
              for (int k = 0; k < 8; ++k) { const float send = up ? a[k] : a[k + 8], keep = up ? a[k + 8] : a[k]; a8[k] = keep + __shfl_xor(send, 32); } }
            { const bool up = lane & 16;
#pragma unroll
              for (int k = 0; k < 4; ++k) { const float send = up ? a8[k] : a8[k + 4], keep = up ? a8[k + 4] : a8[k]; a4[k] = keep + __shfl_xor(send, 16); } }
            { const bool up = lane & 8;
#pragma unroll
              for (int k = 0; k < 2; ++k) { const float send = up ? a4[k] : a4[k + 2], keep = up ? a4[k + 2] : a4[k]; a2[k] = keep + __shfl_xor(send, 8); } }
            { const bool up = lane & 4; const float send = up ? a2[0] : a2[1], keep = up ? a2[1] : a2[0]; a1 = keep + __shfl_xor(send, 4); }
            a1 += __shfl_xor(a1, 2); a1 += __shfl_xor(a1, 1);
            const float lg = a1 * rstd + rbv;
            const float v0 = wave_max(lg);
            const int e0 = (__ffsll((unsigned long long)__ballot(lg == v0)) - 1) >> 2;
            const int gidx = e0 >> 2;
            const bool c2 = (lane >> 4) == gidx && (lane >> 2) != e0;
            const float m2 = c2 ? lg : -INFINITY;
            const float v1 = wave_max(m2);
            const int e1 = (__ffsll((unsigned long long)__ballot(c2 && m2 == v1)) - 1) >> 2;
            const float w0 = 1.f / (1.f + __expf(v1 - v0));
            unsigned r0 = 0, r1 = 0;
            if (lane == 0) { r0 = atomicAdd((unsigned*)(lcnt + e0), 1u); r1 = atomicAdd((unsigned*)(lcnt + e1), 1u); }
            r0 = __builtin_amdgcn_readfirstlane(r0); r1 = __builtin_amdgcn_readfirstlane(r1);
            if (lane == q) { e0s = e0; e1s = e1; r0s = (int)r0; r1s = (int)r1; w0s = w0; }
#pragma unroll
            for (int j = 0; j < 4; ++j) v[j] = vn[j];
        }
        __syncthreads();
        if (tid_ < 16) lbase[tid_] = atomicAdd(&cnt[tid_], lcnt[tid_]);
        __syncthreads();
        if (lane < 8) {
            const int t = blk * 64 + wid * 8 + lane;
            const int p0 = (int)lbase[e0s] + r0s, p1 = (int)lbase[e1s] + r1s;
            list[e0s * T + p0] = t; list[e1s * T + p1] = t;
            te[2 * t] = e0s; te[2 * t + 1] = e1s; tp[2 * t] = p0; tp[2 * t + 1] = p1; tw[2 * t] = w0s; tw[2 * t + 1] = 1.f - w0s;
        }
    }
    __syncthreads();
}
__device__ __forceinline__ void moe_offsets(KArgs A, int wv_, int L, LAS int* off, LAS int* cn) {
    if (opaque_tid(wv_) == 0) {
        const unsigned* cnt = (const unsigned*)(opq(A->ws) + WS_CTL) + CW_CNT + L * 64;
        int o = 0;
        for (int e = 0; e < 16; ++e) { const int c = (int)__hip_atomic_load(cnt + e, __ATOMIC_RELAXED, __HIP_MEMORY_SCOPE_AGENT); off[e] = o; cn[e] = c; o += (c + 255) & ~255; }
        off[16] = o;
    }
    __syncthreads();
}
__device__ __forceinline__ void phase_moe_combine(KArgs A, int wv_, int L, LAS unsigned char* lds) {
    LAS int* off = (LAS int*)lds; LAS int* cn = off + 32;
    moe_offsets(A, wv_, L, off, cn);
    const int tid_ = opaque_tid(wv_); const int wid = __builtin_amdgcn_readfirstlane(tid_ >> 6), lane = tid_ & 63; const int gw = blockIdx.x * 8 + wid, NGW = gridDim.x * 8;
    unsigned char* ws = opq(A->ws);
    const int* te = (const int*)(ws + WS_TOK); const int* tp = te + 2 * T; const float* tw = (const float*)(tp + 2 * T);
    const bf16* Y = (const bf16*)(ws + WS_Y); bf16* XN = (bf16*)(ws + WS_XN);
    const int nq = (T - gw + NGW - 1) / NGW;
    for (int q0 = 0; q0 < nq; q0 += 8) {
        int s0m = 0, s1m = 0; float w0m = 0.f, w1m = 0.f;
        { const int qq = q0 + (lane & 7); const int t = gw + NGW * (qq < nq ? qq : nq - 1);
          s0m = off[te[2 * t]] + tp[2 * t]; s1m = off[te[2 * t + 1]] + tp[2 * t + 1]; w0m = tw[2 * t]; w1m = tw[2 * t + 1]; }
        const int nn = nq - q0 < 8 ? nq - q0 : 8;
        f32x4 v[4], vn[4]; u32x2 ya[4], yb[4], yan[4], ybn[4];
        { const int t = gw + NGW * q0; const int sl0 = __builtin_amdgcn_readlane(s0m, 0), sl1 = __builtin_amdgcn_readlane(s1m, 0);
#pragma unroll
          for (int j = 0; j < 4; ++j) { v[j] = ((const f32x4*)(A->out + (size_t)t * D) + lane)[64 * j]; ya[j] = ((const u32x2*)(Y + (size_t)sl0 * D) + lane)[64 * j]; yb[j] = ((const u32x2*)(Y + (size_t)sl1 * D) + lane)[64 * j]; } }
#pragma unroll 1
        for (int q = 0; q < nn; ++q) {
            const int t = gw + NGW * (q0 + q);
            const int qn = q + 1 < nn ? q + 1 : q;
            { const int tn = gw + NGW * (q0 + qn); const int sl0 = __builtin_amdgcn_readlane(s0m, qn), sl1 = __builtin_amdgcn_readlane(s1m, qn);
#pragma unroll
              for (int j = 0; j < 4; ++j) { vn[j] = ((const f32x4*)(A->out + (size_t)tn * D) + lane)[64 * j]; yan[j] = ((const u32x2*)(Y + (size_t)sl0 * D) + lane)[64 * j]; ybn[j] = ((const u32x2*)(Y + (size_t)sl1 * D) + lane)[64 * j]; } }
            const float w0 = __builtin_bit_cast(float, __builtin_amdgcn_readlane(__builtin_bit_cast(int, w0m), q)), w1 = __builtin_bit_cast(float, __builtin_amdgcn_readlane(__builtin_bit_cast(int, w1m), q));
            float s = 0.f;
#pragma unroll
            for (int j = 0; j < 4; ++j) {
                v[j].x += w0 * bflo(ya[j].x) + w1 * bflo(yb[j].x); v[j].y += w0 * bfhi(ya[j].x) + w1 * bfhi(yb[j].x); v[j].z += w0 * bflo(ya[j].y) + w1 * bflo(yb[j].y); v[j].w += w0 * bfhi(ya[j].y) + w1 * bfhi(yb[j].y);
                s += (v[j].x * v[j].x + v[j].y * v[j].y) + (v[j].z * v[j].z + v[j].w * v[j].w);
            }
            const float rstd = rsqrtf(wave_sum(s) * (1.f / 1024.f) + EPS);
            f32x4* xr = (f32x4*)(A->out + (size_t)t * D) + lane; u32x2* o8 = (u32x2*)(XN + (size_t)t * D) + lane;
#pragma unroll
            for (int j = 0; j < 4; ++j) { xr[64 * j] = v[j]; u32x2 w; w.x = pk2(v[j].x * rstd, v[j].y * rstd); w.y = pk2(v[j].z * rstd, v[j].w * rstd); o8[64 * j] = w; }
#pragma unroll
            for (int j = 0; j < 4; ++j) { v[j] = vn[j]; ya[j] = yan[j]; yb[j] = ybn[j]; }
        }
    }
}

constexpr int PH_PER_EVEN = 5 + 8, PH_PER_ODD = 3 + 8;
constexpr int NPHASES = 3 + 2 * (PH_PER_EVEN + PH_PER_ODD);

__global__ void __launch_bounds__(512, 2) mk_fwd(Args Araw) {
    KArgs A0 = kargs();
    extern __shared__ __attribute__((aligned(16))) unsigned char lds_raw[];
    LAS unsigned char* lds = (LAS unsigned char*)lds_raw;
    volatile LAS unsigned* misc = (volatile LAS unsigned*)(lds + LDS_MISC);
    const int tid = threadIdx.x;
    if (tid < 16) misc[tid] = 0u;
    __syncthreads();
    const int lo = A0->ph_lo, hi = A0->ph_hi;
    const int wv_ = __builtin_amdgcn_readfirstlane(threadIdx.x >> 6);
    if (hi - lo > 1) (void)xcd_barrier_post((unsigned*)(A0->ws + WS_CTL) + CW_BAR, misc);
    int ph = 0;
    unsigned long long tacc_ = 0;
#define PH_BEGIN(k) if (ph >= lo && ph < hi) { const bool tprobe_ = (PROBE_TMASK >> (k)) & 1; unsigned long long tp0_ = 0; if (PROBE_TMASK && tprobe_) tp0_ = __builtin_amdgcn_s_memrealtime(); KArgs A = kargs(); unsigned char* ws = opq(A->ws); _Pragma("unroll 1") for (int rep_ = 0; rep_ < (((PROBE_MASK >> (k)) & 1) ? PROBE_REPS : 1); ++rep_)
#define PH_END   if (ph + 1 < hi) { XcdBarrier b_; b_.bar = (unsigned*)(opq(kargs()->ws) + WS_CTL) + CW_BAR; b_.x = xb_xcc_id(); b_.st = misc; xcd_barrier(b_, opaque_tid(wv_) == 0); } if (PROBE_TMASK && tprobe_) tacc_ += __builtin_amdgcn_s_memrealtime() - tp0_; } ++ph;
    const int G = gridDim.x, cb = blockIdx.x;

    PH_BEGIN(0) phase_prologue(A, wv_, lds); PH_END
    PH_BEGIN(1) {
        pg8::DenseOrder S; S.init(NBATCH * NMEM, 8192, D, (const bf16*)(ws + WS_WKV), G, cb);
        pg8::EpiBf16<0> E{(bf16*)(ws + WS_KV), 8192, 32, 0};
        pg8::gemm_phase(lds, (const bf16*)(ws + WS_MN), D, S, E, wv_);
    } PH_END
    PH_BEGIN(2) { phase_knorm(A, wv_); phase_vtrans(A, wv_, lds); } PH_END

    for (int L = 0; L < DEPTH; ++L) {
        const int i = L >> 1;
        if ((L & 1) == 0) {
            PH_BEGIN(3) {
                pg8::DenseOrder S; S.init(T, HYN, D, (const bf16*)(ws + WS_WHYB) + (size_t)i * HYN * D, G, cb);
                pg8::EpiBf16<0> E{(bf16*)(ws + WS_BIG), HYN, 12, 0};
                pg8::gemm_phase(lds, (const bf16*)(ws + WS_XN), D, S, E, wv_);
            } PH_END
            PH_BEGIN(4) { phase_compress_mfma(A, wv_, i, lds); phase_nsa_prep(A, wv_, i, lds); phase_vtiles(A, wv_, lds); } PH_END
            PH_BEGIN(5) { phase_gla_a(A, wv_, i, lds); __syncthreads(); phase_nsa_attn_mfma(A, wv_, i, lds); } PH_END
            PH_BEGIN(6) phase_gla_c(A, wv_, i, lds); PH_END
            PH_BEGIN(7) {
                pg8::DenseOrder S; S.init(T, D, D, (const bf16*)(ws + WS_WHOUT) + (size_t)i * D * D, G, cb);
                pg8::EpiResAdd E{A->out, D};
                pg8::gemm_phase(lds, (const bf16*)(ws + WS_CAT), D, S, E, wv_);
            } PH_END
        } else {
            PH_BEGIN(8) {
                pg8::DenseOrder S; S.init(T, 4096, D, (const bf16*)(ws + WS_WSGIN) + (size_t)i * 4096 * D, G, cb);
                pg8::EpiBf16<1> E{(bf16*)(ws + WS_U), 2048, 8, (size_t)(WS_V - WS_U) / 2};
                pg8::gemm_phase(lds, (const bf16*)(ws + WS_XN), D, S, E, wv_);
            } PH_END
            PH_BEGIN(9) phase_sgu_mix_mfma(A, wv_, i, lds); PH_END
            PH_BEGIN(10) {
                pg8::DenseOrder S; S.init(T, D, 2048, (const bf16*)(ws + WS_WSGOUT) + (size_t)i * D * 2048, G, cb);
                pg8::EpiResAdd E{A->out, D};
                pg8::gemm_phase(lds, (const bf16*)(ws + WS_UM), 2048, S, E, wv_);
            } PH_END
        }
        PH_BEGIN(11) phase_rownorm(A, wv_); PH_END
        PH_BEGIN(12) {
            pg8::DenseOrder S; S.init(T, D, D, (const bf16*)(ws + WS_WQ) + (size_t)L * D * D, G, cb);
            pg8::EpiBf16<0> E{(bf16*)(ws + WS_QX), D, 4, 0};
            pg8::gemm_phase(lds, (const bf16*)(ws + WS_XN), D, S, E, wv_);
        } PH_END
        PH_BEGIN(13) phase_xattn_mfma(A, wv_, L, lds); PH_END
        PH_BEGIN(14) {
            pg8::DenseOrder S; S.init(T, D, D, (const bf16*)(ws + WS_WO) + (size_t)L * D * D, G, cb);
            pg8::EpiResAdd E{A->out, D};
            pg8::gemm_phase(lds, (const bf16*)(ws + WS_OX), D, S, E, wv_);
        } PH_END
        PH_BEGIN(15) phase_route(A, wv_, L, lds); PH_END
        PH_BEGIN(16) {
            LAS int* off = (LAS int*)(lds + pg8::STAGE_BYTES); LAS int* cn = off + 32;
            moe_offsets(A, wv_, L, off, cn);
            pg8::MoeOrder<true> S{(off[16] / 256) * 3, 3, G, cb, D, off, cn, (const int*)(ws + WS_LIST), (const char*)(ws + WS_WMIN) + (size_t)L * 16 * 768 * D * 2, (size_t)768 * D * 2};
            pg8::EpiSwiglu E{(bf16*)(ws + WS_H), DEXP};
            pg8::gemm_phase(lds, (const bf16*)(ws + WS_XN), D, S, E, wv_);
        } PH_END
        PH_BEGIN(17) {
            LAS int* off = (LAS int*)(lds + pg8::STAGE_BYTES); LAS int* cn = off + 32;
            moe_offsets(A, wv_, L, off, cn);
            pg8::MoeOrder<false> S{(off[16] / 256) * 4, 4, G, cb, DEXP, off, cn, (const int*)(ws + WS_LIST), (const char*)(ws + WS_WMOUT) + (size_t)L * 16 * D * DEXP * 2, (size_t)D * DEXP * 2};
            pg8::EpiBf16<0> E{(bf16*)(ws + WS_Y), D, 4, 0};
            pg8::gemm_phase(lds, (const bf16*)(ws + WS_H), DEXP, S, E, wv_);
        } PH_END
        PH_BEGIN(18) phase_moe_combine(A, wv_, L, lds); PH_END
    }
#undef PH_BEGIN
#undef PH_END
    if (PROBE_TMASK && blockIdx.x == 0) { const unsigned long long t0 = __builtin_amdgcn_s_memrealtime(); while (__builtin_amdgcn_s_memrealtime() - t0 < tacc_) __builtin_amdgcn_s_sleep(8); }
}

extern "C" void kernel_launch(void* const* d_in, const int* in_sizes, int n_in, void* d_out, int out_size, void* d_ws, size_t ws_size, hipStream_t stream) {
    static int grid = 0;
    if (grid == 0) {
        if (n_in != N_IN || out_size != T * D || ws_size < WS_END) { fprintf(stderr, "kernel_launch: unexpected problem (n_in %d, out %d, ws %zu)\n", n_in, out_size, ws_size); grid = -1; return; }
        int dev = 0, cus = 0, per_cu = 0;
        if (hipGetDevice(&dev) != hipSuccess || hipDeviceGetAttribute(&cus, hipDeviceAttributeMultiprocessorCount, dev) != hipSuccess) { grid = -1; return; }
        if (hipFuncSetAttribute((const void*)mk_fwd, hipFuncAttributeMaxDynamicSharedMemorySize, LDS_BYTES) != hipSuccess) { fprintf(stderr, "kernel_launch: hipFuncSetAttribute failed\n"); grid = -1; return; }
        if (hipOccupancyMaxActiveBlocksPerMultiprocessor(&per_cu, (const void*)mk_fwd, 512, LDS_BYTES) != hipSuccess || per_cu < 1) fprintf(stderr, "kernel_launch: occupancy query says %d\n", per_cu);
        (void)hipGetLastError();
        grid = cus;
    }
    if (grid < 0) return;
    (void)hipMemsetAsync((char*)d_ws + WS_CTL, 0, CTL_BYTES, stream);
    Args a{};
    for (int i = 0; i < N_IN; ++i) a.in[i] = (const float*)d_in[i];
    a.out = (float*)d_out; a.ws = (unsigned char*)d_ws;
    for (int j = 0; j < 32; ++j) a.freq[j] = (float)pow(10000.0, -(double)j / 32.0);
#if MK_ONE_LAUNCH
    a.ph_lo = 0; a.ph_hi = NPHASES;
    hipLaunchKernelGGL(mk_fwd, dim3(grid), dim3(512), LDS_BYTES, stream, a);
#else
    for (int p = 0; p < NPHASES; ++p) { a.ph_lo = p; a.ph_hi = p + 1; hipLaunchKernelGGL(mk_fwd, dim3(grid), dim3(512), LDS_BYTES, stream, a); }
#endif
}
```

```cpp
#include <hip/hip_runtime.h>
#include <stdint.h>
#include <stdio.h>
#include <math.h>

#ifndef PROBE_MASK
#define PROBE_MASK 0
#endif
#ifndef PROBE_TMASK
#define PROBE_TMASK 0
#endif
#ifndef PROBE_REPS
#define PROBE_REPS 2
#endif
#ifndef MK_ONE_LAUNCH
#define MK_ONE_LAUNCH 1
#endif

#define LAS __attribute__((address_space(3)))
typedef unsigned short bf16;
typedef short bf16x8 __attribute__((ext_vector_type(8)));
typedef float f32x4 __attribute__((ext_vector_type(4)));
typedef float f32x2 __attribute__((ext_vector_type(2)));
typedef unsigned u32x4 __attribute__((ext_vector_type(4)));
typedef unsigned u32x2 __attribute__((ext_vector_type(2)));

constexpr int T = 16384, D = 1024, NBATCH = 8, S = 2048, DEPTH = 4;
constexpr int NMEM = 256;
constexpr float EPS = 1e-6f;
constexpr int HYN = 3072, HYSRC = 2856;
constexpr int C_QA = 0, C_KC = 512, C_VC = 640, C_KS = 768, C_VS = 896, C_KW = 1024, C_VW = 1152, C_QB = 1280, C_KB = 1536, C_VB = 1792, C_RB = 2304, C_GA = 2816, C_AL = 2840;
constexpr int NCMP = 127;
constexpr int NEXP = 16, DEXP = 384;
constexpr int SLOTS = 2 * T + NEXP * 256;

enum { I_X = 0, I_MEM, I_POS, I_NMIX, I_NXAT, I_NMEM, I_NFFN, I_HYBIN, I_HYBOUT, I_QNORM, I_KNORM, I_CMPPE, I_CMPW1, I_CMPW2, I_GATEB, I_WA2, I_BA, I_ONORM,
       I_SGIN, I_LNG, I_LNB, I_SGWS, I_SGBS, I_SGOUT, I_XWQ, I_XWKV, I_XWO, I_XQN, I_XKN, I_RW, I_RB, I_MOEIN, I_MOEOUT, N_IN };

constexpr size_t MiB = 1u << 20;
constexpr size_t WS_CTL = 0, CTL_BYTES = 1 * MiB;
constexpr size_t WS_WHYB = 1 * MiB;
constexpr size_t WS_WHOUT = WS_WHYB + 12 * MiB;
constexpr size_t WS_WSGIN = WS_WHOUT + 4 * MiB;
constexpr size_t WS_WSGOUT = WS_WSGIN + 16 * MiB;
constexpr size_t WS_WQ = WS_WSGOUT + 8 * MiB;
constexpr size_t WS_WKV = WS_WQ + 8 * MiB;
constexpr size_t WS_WO = WS_WKV + 16 * MiB;
constexpr size_t WS_WMIN = WS_WO + 8 * MiB;
constexpr size_t WS_WMOUT = WS_WMIN + 96 * MiB;
constexpr size_t WS_RW = WS_WMOUT + 48 * MiB;
constexpr size_t WS_XN = WS_RW + 1 * MiB;
constexpr size_t WS_BIG = WS_XN + 32 * MiB;
constexpr size_t WS_QA = WS_BIG + 128 * MiB;
constexpr size_t WS_KS = WS_QA + 16 * MiB;
constexpr size_t WS_KW = WS_KS + 4 * MiB;
constexpr size_t WS_KC = WS_KW + 4 * MiB;
constexpr size_t WS_VC = WS_KC + 1 * MiB;
constexpr size_t WS_CAT = WS_VC + 1 * MiB;
constexpr size_t WS_QX = WS_CAT + 32 * MiB;
constexpr size_t WS_OX = WS_QX + 32 * MiB;
constexpr size_t WS_MN = WS_OX + 32 * MiB;
constexpr size_t WS_KV = WS_MN + 4 * MiB;
constexpr size_t WS_COS = WS_KV + 32 * MiB;
constexpr size_t WS_SIN = WS_COS + 2 * MiB;
constexpr size_t WS_LIST = WS_SIN + 2 * MiB;
constexpr size_t WS_TOK = WS_LIST + 1 * MiB;
constexpr size_t WS_VT = WS_TOK + 1 * MiB;
constexpr size_t WS_VTA = WS_VT + 16 * MiB;
constexpr size_t WS_SLOC = WS_VTA + 32 * MiB;
constexpr size_t WS_DEC = WS_SLOC + 32 * MiB;
constexpr size_t WS_STT = WS_DEC + 1 * MiB;
constexpr size_t WS_WSB = WS_STT + 16 * MiB;
constexpr size_t WS_M0 = WS_WSB + 768 * 1024;
constexpr size_t WS_W1T = WS_WSB + 1 * MiB;
constexpr size_t WS_ROWSQ = WS_W1T + 1 * MiB;
constexpr size_t WS_END = WS_ROWSQ + 1 * MiB;
constexpr size_t WS_Y = WS_BIG, WS_H = WS_BIG + 72 * MiB, WS_U = WS_BIG, WS_V = WS_BIG + 64 * MiB, WS_UM = WS_QX;
constexpr int CW_BAR = 4096;
constexpr int CW_CNT = 8192;

constexpr int LDS_BYTES = 159744;
constexpr int LDS_MISC = LDS_BYTES - 64;

__device__ __forceinline__ unsigned pk2(float lo, float hi) { unsigned r; asm volatile("v_cvt_pk_bf16_f32 %0, %1, %2" : "=v"(r) : "v"(lo), "v"(hi)); return r; }
__device__ __forceinline__ unsigned f2bf(float f) { unsigned u = __float_as_uint(f); return (u + 0x7fffu + ((u >> 16) & 1u)) >> 16; }
__device__ __forceinline__ float bf2f(unsigned b) { return __uint_as_float(b << 16); }
__device__ __forceinline__ float bflo(unsigned w) { return __uint_as_float(w << 16); }
__device__ __forceinline__ float bfhi(unsigned w) { return __uint_as_float(w & 0xffff0000u); }
__device__ __forceinline__ float wave_sum(float v) {
#pragma unroll
    for (int o = 1; o < 64; o <<= 1) v += __shfl_xor(v, o);
    return v;
}
__device__ __forceinline__ float wave_max(float v) {
#pragma unroll
    for (int o = 1; o < 64; o <<= 1) v = fmaxf(v, __shfl_xor(v, o));
    return v;
}
__device__ __forceinline__ int opaque_tid(int wv) { int l; asm volatile("v_mbcnt_lo_u32_b32 %0, -1, 0\n\tv_mbcnt_hi_u32_b32 %0, -1, %0" : "=v"(l)); return wv * 64 + l; }
__device__ __forceinline__ unsigned char* opq(unsigned char* p) { asm volatile("" : "+s"(p)); return p; }
#define LDS_WAIT() asm volatile("s_waitcnt lgkmcnt(0)" ::: "memory")
__device__ __forceinline__ float gelu_tanh(float x) {
    const float u2 = x * (1.5957691216057308f + 0.07135481283f * x * x);
    return x * __builtin_amdgcn_rcpf(1.0f + __expf(-u2));
}
__device__ __forceinline__ float sigmoidf_(float x) { return 1.0f / (1.0f + __expf(-x)); }

#define XB_TMO      128
#define XB_XCNT(j)  (256  + 64 * (j))
#define XB_XSUB(j)  (1280 + 64 * (j))
#define XB_XGEN(j)  (2304 + 64 * (j))
#define XB_TOP      3328
#define XB_TOPGEN   3392
#define XCD_BAR_WORDS 3456
#define XB_SPIN_CAP (1u << 22)

__device__ __forceinline__ unsigned xb_ld(unsigned* p)              { return __hip_atomic_load(p, __ATOMIC_RELAXED, __HIP_MEMORY_SCOPE_AGENT); }
__device__ __forceinline__ unsigned xb_add(unsigned* p, unsigned v) { return __hip_atomic_fetch_add(p, v, __ATOMIC_RELAXED, __HIP_MEMORY_SCOPE_AGENT); }
__device__ __forceinline__ unsigned xb_xcc_id() { return (unsigned)__builtin_amdgcn_s_getreg((3 << 11) | 20) & 0xFu; }
#define XB_SPIN(cond, bar) do { unsigned _sp = 0; while (cond) { __builtin_amdgcn_s_sleep(1); \
    if ((++_sp & 255u) == 0u) { if (xb_ld(&(bar)[XB_TMO])) break; if (_sp > XB_SPIN_CAP) { atomicAdd(&(bar)[XB_TMO], 1u); break; } } } } while (0)

struct XcdBarrier { unsigned* bar; unsigned x; volatile LAS unsigned* st; };
__device__ __forceinline__ unsigned* xb_opaque(unsigned* p) { unsigned long long v = (unsigned long long)p; unsigned lo = __builtin_amdgcn_readfirstlane((unsigned)v), hi = __builtin_amdgcn_readfirstlane((unsigned)(v >> 32));
    asm volatile("" : "+s"(lo), "+s"(hi)); return (unsigned*)(((unsigned long long)hi << 32) | lo); }

__device__ __forceinline__ XcdBarrier xcd_barrier_post(unsigned* bar, volatile LAS unsigned* st) {
    XcdBarrier b; b.bar = bar; b.x = xb_xcc_id(); b.st = st;
    if (threadIdx.x == 0) (void)xb_add(&bar[XB_XCNT(b.x)], 1u);
    return b;
}
__device__ __forceinline__ void xcd_barrier_complete(unsigned* bar, unsigned x, unsigned& nloc, unsigned& nx) {
    const unsigned G = gridDim.x * gridDim.y * gridDim.z;
    unsigned sum, cnt, mine, sp = 0u;
    for (;;) {
        sum = 0u; cnt = 0u; mine = 0u;
#pragma unroll
        for (unsigned j = 0; j < 16; ++j) { const unsigned c = xb_ld(&bar[XB_XCNT(j)]); sum += c; cnt += (c > 0u) ? 1u : 0u; mine = (j == x) ? c : mine; }
        if (sum == G) break;
        __builtin_amdgcn_s_sleep(1);
        if ((++sp & 255u) == 0u) { if (xb_ld(&bar[XB_TMO])) break; if (sp > XB_SPIN_CAP) { atomicAdd(&bar[XB_TMO], 1u); break; } }
    }
    nloc = mine > 0u ? mine : 1u; nx = cnt > 0u ? cnt : 1u;
}
__device__ __forceinline__ void xcd_barrier(const XcdBarrier& b, const bool is_t0) {
    asm volatile("s_waitcnt vmcnt(0)" ::: "memory");
    __syncthreads();
    if (is_t0) {
        unsigned* bar = b.bar;
        __builtin_amdgcn_s_waitcnt(0);
        unsigned nloc = b.st[0], nx = b.st[1];
        if (nloc == 0u) { xcd_barrier_complete(bar, b.x, nloc, nx); b.st[0] = nloc; b.st[1] = nx; }
        const unsigned old = xb_add(&bar[XB_XSUB(b.x)], 1u);
        const unsigned gen = old / nloc;
        if (old + 1u == (gen + 1u) * nloc) {
            __builtin_amdgcn_fence(__ATOMIC_RELEASE, "agent");
            asm volatile("s_waitcnt vmcnt(0)" ::: "memory");
            const unsigned og = xb_add(&bar[XB_TOP], 1u);
            const unsigned tg = og / nx;
            if (og + 1u == (tg + 1u) * nx) xb_add(&bar[XB_TOPGEN], 1u);
            else XB_SPIN(xb_ld(&bar[XB_TOPGEN]) == tg, bar);
            __builtin_amdgcn_fence(__ATOMIC_ACQUIRE, "agent");
            xb_add(&bar[XB_XGEN(b.x)], 1u);
            asm volatile("s_waitcnt vmcnt(0)" ::: "memory");
        } else {
            XB_SPIN(xb_ld(&bar[XB_XGEN(b.x)]) == gen, bar);
            __builtin_amdgcn_fence(__ATOMIC_ACQUIRE, "agent");
            asm volatile("s_waitcnt vmcnt(0)" ::: "memory");
        }
    }
    __syncthreads();
}

struct Args {
    const float* in[N_IN];
    float* out;
    unsigned char* ws;
    float freq[32];
    int ph_lo, ph_hi;
};

typedef const __attribute__((address_space(4))) Args* KArgs;
__device__ __forceinline__ KArgs kargs() { KArgs p = (KArgs)__builtin_amdgcn_kernarg_segment_ptr(); asm volatile("" : "+s"(p)); return p; }

__device__ __forceinline__ void st_bf16x4(bf16* p, f32x4 v) { u32x2 w; w.x = pk2(v[0], v[1]); w.y = pk2(v[2], v[3]); *(u32x2*)p = w; }


namespace pg8 {
constexpr int BM = 256, BK = 64, HALF = 128, HTB = HALF * BK * 2, STAGE_BYTES = 8 * HTB, NXCD = 8, WGM = 8;
__host__ __device__ __forceinline__ int lds_byte(int r, int c) { const int st = (r >> 4) * 2 + (c >> 5), rr = r & 15, cc = c & 31, ob = rr * 64 + cc * 2; return st * 1024 + (ob ^ (((ob >> 9) & 1) << 5)); }
__host__ __device__ __forceinline__ void stage_rc(int b, int& R, int& C) { const int st = b / 1024, sb = b % 1024, swz = sb ^ (((sb >> 9) & 1) << 5); R = (st >> 1) * 16 + swz / 64; C = (st & 1) * 32 + (swz % 64) / 2; }
__host__ __device__ __forceinline__ int perm32(int rho) { const int n = rho >> 4, i = rho & 15; return 8 * (i >> 2) + 4 * n + (i & 3); }
struct Unit { int pm, pn, e; };
struct DenseOrder {
    static constexpr bool GATHER = false;
    int nM, nN, nwg, G, c, K; const char* Bt;
    __device__ __forceinline__ void init(int M, int N, int K_, const bf16* Bt_, int G_, int c_) { nM = M / BM; nN = N / BM; nwg = nM * nN; G = G_; c = c_; K = K_; Bt = (const char*)Bt_; }
    __device__ __forceinline__ bool next(int i, Unit& u) const {
        const long L = (long)i * G + c; if (L >= nwg) return false;
        int wgid = (int)L; { const int q = nwg / NXCD, r = nwg % NXCD, xcd = wgid % NXCD, off = wgid / NXCD; wgid = (xcd < r ? xcd * (q + 1) : r * (q + 1) + (xcd - r) * q) + off; }
        const int nig = WGM * nN, gid = wgid / nig, fm = gid * WGM, gsz = (nM - fm) < WGM ? (nM - fm) : WGM;
        u.pm = fm + ((wgid % nig) % gsz); u.pn = (wgid % nig) / gsz; u.e = 0; return true;
    }
    __device__ __forceinline__ unsigned a_voff(const Unit& u, int half, int R) const { return (unsigned)((u.pm * BM + half * HALF + R) * K) * 2u; }
    __device__ __forceinline__ const char* b_tile(const Unit& u) const { return Bt + (size_t)u.pn * BM * K * 2; }
};
template <bool GATH> struct MoeOrder {
    static constexpr bool GATHER = GATH;
    int nunits, ntn, G, c, K; const LAS int* off; const LAS int* cn; const int* list; const char* Bt; size_t estride;
    __device__ __forceinline__ bool next(int i, Unit& u) const {
        const int L = i * G + c; if (L >= nunits) return false;
        u.pm = L / ntn; u.pn = L % ntn; const int s0 = u.pm * BM; int e = 0;
#pragma unroll
        for (int q = 1; q < 16; ++q) e += (s0 >= off[q]) ? 1 : 0;
        u.e = e; return true;
    }
    __device__ __forceinline__ unsigned a_voff(const Unit& u, int half, int R) const {
        const int slot = u.pm * BM + half * HALF + R;
        const int loc = slot - off[u.e]; const int tk = list[u.e * T + (loc < cn[u.e] ? loc : 0)];
        return (unsigned)(tk * K) * 2u;
    }
    __device__ __forceinline__ const char* b_tile(const Unit& u) const { return Bt + (size_t)u.e * estride + (size_t)u.pn * BM * K * 2; }
};
__device__ __forceinline__ unsigned cvt_pk_bf16(float lo, float hi) { unsigned r; asm volatile("v_cvt_pk_bf16_f32 %0, %1, %2" : "=v"(r) : "v"(lo), "v"(hi)); return r; }

template <class Epi, class Sched>
__device__ __forceinline__ void gemm_phase(LAS unsigned char* lds, const bf16* Aptr, int K, const Sched& S, const Epi& E, int wv_) {
    const int tid = opaque_tid(wv_), wid = __builtin_amdgcn_readfirstlane(tid >> 6), lane = tid & 63, wr = wid >> 2, wc = wid & 3, fr = lane & 15, fq = lane >> 4;
    const int nt = K / BK;
    int Rr[2], Cc[2]; unsigned voffA[2], voffB[2];
#pragma unroll
    for (int i = 0; i < 2; ++i) { stage_rc(tid * 16 + i * 8192, Rr[i], Cc[i]); const int Rb = Epi::PERM ? ((Rr[i] & ~31) + perm32(Rr[i] & 31)) : Rr[i];
        voffA[i] = (unsigned)(Rr[i] * K + Cc[i]) * 2u; voffB[i] = (unsigned)(Rb * K + Cc[i]) * 2u; }
    const size_t kstep = (size_t)(BK * 2);
    const size_t hstep = (size_t)HALF * K * 2;
    const size_t tstep = 2 * hstep;
    const unsigned ldsw = (unsigned)wid * 1024u;
    const int aoff = lds_byte(wr * 64 + fr, fq * 8), boff = lds_byte(wc * 32 + fr, fq * 8);
    const char* const Ab = (const char*)Aptr;
#define PG8_SA(b, h) (((b) * 2 + (h)) * HTB)
#define PG8_SB(b, h) ((4 + (b) * 2 + (h)) * HTB)
#define PG8_STAGE(bufoff, gbase, voff) do { _Pragma("unroll") for (int _i = 0; _i < 2; ++_i) \
        __builtin_amdgcn_global_load_lds((const unsigned*)((const char*)(gbase) + (voff)[_i]), (LAS unsigned*)(lds + (bufoff) + ldsw + _i * 8192), 16, 0, 0); } while (0)
#define PG8_STAGE_A(bufoff, usenext, h, kofs) do { \
        if constexpr (Sched::GATHER) { const char* gb_ = Ab + (kofs); unsigned vv_[2] = {(usenext) ? vN[h][0] : vA[h][0], (usenext) ? vN[h][1] : vA[h][1]}; PG8_STAGE(bufoff, gb_, vv_); } \
        else { const char* gb_ = ((usenext) ? nA : cA) + (size_t)(h) * hstep + (kofs); PG8_STAGE(bufoff, gb_, voffA); } } while (0)
#define PG8_LDA(dst, b, h) do { _Pragma("unroll") for (int m = 0; m < 4; ++m) _Pragma("unroll") for (int k = 0; k < 2; ++k) dst[m][k] = *(const LAS bf16x8*)(lds + PG8_SA(b, h) + aoff + m * 2048 + k * 1024); } while (0)
#define PG8_LDB(dst, b, h) do { _Pragma("unroll") for (int n = 0; n < 2; ++n) _Pragma("unroll") for (int k = 0; k < 2; ++k) dst[n][k] = *(const LAS bf16x8*)(lds + PG8_SB(b, h) + boff + n * 2048 + k * 1024); } while (0)
#define PG8_MMA(ai, bj, At, Bt) do { __builtin_amdgcn_s_setprio(1); _Pragma("unroll") for (int m = 0; m < 4; ++m) _Pragma("unroll") for (int n = 0; n < 2; ++n) _Pragma("unroll") for (int k = 0; k < 2; ++k) \
        acc[ai][bj][m][n] = __builtin_amdgcn_mfma_f32_16x16x32_bf16(Bt[n][k], At[m][k], acc[ai][bj][m][n], 0, 0, 0); __builtin_amdgcn_s_setprio(0); } while (0)
#define PG8_WAIT_V(n) asm volatile("s_waitcnt vmcnt(" #n ")" ::: "memory")
#define PG8_WAIT_L(n) asm volatile("s_waitcnt lgkmcnt(" #n ")" ::: "memory")
#define PG8_BAR __builtin_amdgcn_s_barrier()
#define PG8_SCHED __builtin_amdgcn_sched_barrier(0)
    Unit cur, nxt; int ui = 0;
    if (!S.next(0, cur)) return;
    f32x4 acc[2][2][4][2];
#pragma unroll
    for (int a = 0; a < 2; ++a)
#pragma unroll
        for (int b = 0; b < 2; ++b)
#pragma unroll
            for (int m = 0; m < 4; ++m)
#pragma unroll
                for (int n = 0; n < 2; ++n) acc[a][b][m][n] = (f32x4){0.f, 0.f, 0.f, 0.f};
    bf16x8 At[4][2], B0[2][2], B1[2][2];
    unsigned vA[2][2], vN[2][2];
    const char* cA = Ab; const char* nA = Ab;
    if constexpr (Sched::GATHER) {
#pragma unroll
        for (int h = 0; h < 2; ++h)
#pragma unroll
            for (int i = 0; i < 2; ++i) { vA[h][i] = S.a_voff(cur, h, Rr[i]) + (unsigned)Cc[i] * 2u; vN[h][i] = vA[h][i]; }
    } else { cA = Ab + (size_t)cur.pm * tstep; nA = cA; }
    const char* cB = S.b_tile(cur);
    PG8_STAGE(PG8_SB(0, 0), cB, voffB); PG8_STAGE_A(PG8_SA(0, 0), false, 0, 0); PG8_STAGE(PG8_SB(0, 1), cB + hstep, voffB); PG8_STAGE_A(PG8_SA(0, 1), false, 1, 0);
    if (wr == 1) PG8_BAR;
    PG8_WAIT_V(4); PG8_BAR;
    PG8_STAGE(PG8_SB(1, 0), cB + kstep, voffB); PG8_STAGE_A(PG8_SA(1, 0), false, 0, kstep); PG8_STAGE(PG8_SB(1, 1), cB + hstep + kstep, voffB);
    PG8_WAIT_V(6); PG8_BAR;
    for (;;) {
        const bool has_next = S.next(ui + 1, nxt);
        const char* nB = has_next ? S.b_tile(nxt) : cB;
        if constexpr (Sched::GATHER) {
#pragma unroll
            for (int h = 0; h < 2; ++h)
#pragma unroll
                for (int i = 0; i < 2; ++i) vN[h][i] = has_next ? S.a_voff(nxt, h, Rr[i]) + (unsigned)Cc[i] * 2u : vA[h][i];
        } else nA = has_next ? Ab + (size_t)nxt.pm * tstep : cA;
        for (int t = 0; t < nt; t += 2) {
            const bool last = (t == nt - 2);
            const size_t k1 = (size_t)(t + 1) * kstep, k2 = last ? 0 : (size_t)(t + 2) * kstep, k3 = k2 + kstep;
            const char* b2 = last ? nB : cB + (size_t)(t + 2) * kstep; const char* b3 = b2 + kstep;
            PG8_LDB(B0, 0, 0); PG8_SCHED; PG8_LDA(At, 0, 0); PG8_STAGE_A(PG8_SA(1, 1), false, 1, k1);
            PG8_WAIT_L(8); PG8_BAR; PG8_WAIT_L(0); PG8_MMA(0, 0, At, B0); PG8_BAR; PG8_SCHED;
            PG8_LDB(B1, 0, 1); PG8_STAGE(PG8_SB(0, 0), b2, voffB);
            PG8_BAR; PG8_WAIT_L(0); PG8_MMA(0, 1, At, B1); PG8_BAR;
            PG8_LDA(At, 0, 1); PG8_STAGE_A(PG8_SA(0, 0), last, 0, k2);
            PG8_BAR; PG8_WAIT_L(0); PG8_MMA(1, 0, At, B0); PG8_BAR; PG8_SCHED;
            PG8_STAGE(PG8_SB(0, 1), b2 + hstep, voffB);
            PG8_WAIT_V(6); PG8_BAR; PG8_MMA(1, 1, At, B1); PG8_BAR;
            PG8_LDB(B0, 1, 0); PG8_SCHED; PG8_LDA(At, 1, 0); PG8_STAGE_A(PG8_SA(0, 1), last, 1, k2);
            PG8_WAIT_L(8); PG8_BAR; PG8_WAIT_L(0); PG8_MMA(0, 0, At, B0); PG8_BAR; PG8_SCHED;
            PG8_LDB(B1, 1, 1); PG8_STAGE(PG8_SB(1, 0), b3, voffB);
            PG8_BAR; PG8_WAIT_L(0); PG8_MMA(0, 1, At, B1); PG8_BAR;
            PG8_LDA(At, 1, 1); PG8_STAGE_A(PG8_SA(1, 0), last, 0, k3);
            PG8_BAR; PG8_WAIT_L(0); PG8_MMA(1, 0, At, B0); PG8_BAR; PG8_SCHED;
            PG8_STAGE(PG8_SB(1, 1), b3 + hstep, voffB);
            PG8_WAIT_V(6); PG8_BAR; PG8_MMA(1, 1, At, B1); PG8_BAR;
        }
        E(acc, cur, wr, wc, fr, fq);
        if (!has_next) break;
#pragma unroll
        for (int a = 0; a < 2; ++a)
#pragma unroll
            for (int b = 0; b < 2; ++b)
#pragma unroll
                for (int m = 0; m < 4; ++m)
#pragma unroll
                    for (int n = 0; n < 2; ++n) acc[a][b][m][n] = (f32x4){0.f, 0.f, 0.f, 0.f};
        cur = nxt; cB = nB; cA = nA; ++ui;
        if constexpr (Sched::GATHER) {
#pragma unroll
            for (int h = 0; h < 2; ++h)
#pragma unroll
                for (int i = 0; i < 2; ++i) vA[h][i] = vN[h][i];
        }
    }
    PG8_WAIT_V(0);
    if (wr == 0) PG8_BAR;
    PG8_BAR;
#undef PG8_SA
#undef PG8_SB
#undef PG8_STAGE
#undef PG8_STAGE_A
#undef PG8_LDA
#undef PG8_LDB
#undef PG8_MMA
#undef PG8_WAIT_V
#undef PG8_WAIT_L
#undef PG8_BAR
#undef PG8_SCHED
}
template <int ACT> struct EpiBf16 {
    static constexpr bool PERM = true;
    bf16* O; int ldc; int tpt; size_t tstride;
    __device__ __forceinline__ void operator()(const f32x4 (&acc)[2][2][4][2], const Unit& u, int wr, int wc, int fr, int fq) const {
        const int row0 = u.pm * BM + wr * 64 + fr; const int tt = u.pn / tpt; bf16* base = O + (size_t)tt * tstride; const int col0 = (u.pn - tt * tpt) * BM + wc * 32 + 8 * fq;
#pragma unroll
        for (int ai = 0; ai < 2; ++ai)
#pragma unroll
            for (int m = 0; m < 4; ++m) { bf16* rowp = base + (size_t)(row0 + ai * HALF + m * 16) * ldc + col0;
#pragma unroll
                for (int bj = 0; bj < 2; ++bj) { f32x4 v0 = acc[ai][bj][m][0], v1 = acc[ai][bj][m][1];
                    if (ACT == 1) {
#pragma unroll
                        for (int q = 0; q < 4; ++q) { v0[q] = gelu_tanh(v0[q]); v1[q] = gelu_tanh(v1[q]); } }
                    u32x4 w; w.x = cvt_pk_bf16(v0[0], v0[1]); w.y = cvt_pk_bf16(v0[2], v0[3]); w.z = cvt_pk_bf16(v1[0], v1[1]); w.w = cvt_pk_bf16(v1[2], v1[3]);
                    *(u32x4*)(rowp + bj * HALF) = w; } }
    }
};
struct EpiResAdd {
    static constexpr bool PERM = false;
    float* X; int ldc;
    __device__ __forceinline__ void operator()(const f32x4 (&acc)[2][2][4][2], const Unit& u, int wr, int wc, int fr, int fq) const {
        const int row0 = u.pm * BM + wr * 64 + fr, col0 = u.pn * BM + wc * 32 + 4 * fq;
#pragma unroll
        for (int ai = 0; ai < 2; ++ai)
#pragma unroll
            for (int m2 = 0; m2 < 4; m2 += 2) {
                f32x4 x[2][2][2];
#pragma unroll
                for (int mm = 0; mm < 2; ++mm)
#pragma unroll
                    for (int bj = 0; bj < 2; ++bj)
#pragma unroll
                        for (int n = 0; n < 2; ++n) x[mm][bj][n] = *(const f32x4*)(X + (size_t)(row0 + ai * HALF + (m2 + mm) * 16) * ldc + col0 + bj * HALF + n * 16);
#pragma unroll
                for (int mm = 0; mm < 2; ++mm)
#pragma unroll
                    for (int bj = 0; bj < 2; ++bj)
#pragma unroll
                        for (int n = 0; n < 2; ++n) *(f32x4*)(X + (size_t)(row0 + ai * HALF + (m2 + mm) * 16) * ldc + col0 + bj * HALF + n * 16) = x[mm][bj][n] + acc[ai][bj][m2 + mm][n];
            }
    }
};
struct EpiResAddNorm {
    static constexpr bool PERM = false;
    float* X; int ldc; bf16* XB; float* rowsq;
    __device__ __forceinline__ void operator()(const f32x4 (&acc)[2][2][4][2], const Unit& u, int wr, int wc, int fr, int fq) const {
        const int row0 = u.pm * BM + wr * 64 + fr, col0 = u.pn * BM + wc * 32 + 4 * fq;
#pragma unroll
        for (int ai = 0; ai < 2; ++ai)
#pragma unroll
            for (int m2 = 0; m2 < 4; m2 += 2) {
                f32x4 x[2][2][2];
#pragma unroll
                for (int mm = 0; mm < 2; ++mm)
#pragma unroll
                    for (int bj = 0; bj < 2; ++bj)
#pragma unroll
                        for (int n = 0; n < 2; ++n) x[mm][bj][n] = *(const f32x4*)(X + (size_t)(row0 + ai * HALF + (m2 + mm) * 16) * ldc + col0 + bj * HALF + n * 16);
#pragma unroll
                for (int mm = 0; mm < 2; ++mm) {
                    const size_t ro = (size_t)(row0 + ai * HALF + (m2 + mm) * 16) * ldc + col0; float ssq = 0.f;
#pragma unroll
                    for (int bj = 0; bj < 2; ++bj)
#pragma unroll
                        for (int n = 0; n < 2; ++n) { const f32x4 v = x[mm][bj][n] + acc[ai][bj][m2 + mm][n];
                            *(f32x4*)(X + ro + bj * HALF + n * 16) = v;
                            u32x2 w; w.x = cvt_pk_bf16(v.x, v.y); w.y = cvt_pk_bf16(v.z, v.w); *(u32x2*)(XB + ro + bj * HALF + n * 16) = w;
                            ssq += (v.x * v.x + v.y * v.y) + (v.z * v.z + v.w * v.w); }
                    ssq += __shfl_xor(ssq, 16); ssq += __shfl_xor(ssq, 32);
                    if (fq == 0) rowsq[(size_t)(row0 + ai * HALF + (m2 + mm) * 16) * 16 + u.pn * 4 + wc] = ssq;
                }
            }
    }
};
struct EpiBf16RowScale {
    static constexpr bool PERM = true;
    bf16* O; int ldc; const float* rowsq;
    __device__ __forceinline__ void operator()(const f32x4 (&acc)[2][2][4][2], const Unit& u, int wr, int wc, int fr, int fq) const {
        const int row0 = u.pm * BM + wr * 64 + fr, col0 = u.pn * BM + wc * 32 + 8 * fq;
#pragma unroll
        for (int ai = 0; ai < 2; ++ai) {
            float rs[4];
#pragma unroll
            for (int m = 0; m < 4; ++m) { const f32x4* p = (const f32x4*)(rowsq + (size_t)(row0 + ai * HALF + m * 16) * 16); const f32x4 a = p[0], b = p[1], c = p[2], d = p[3];
                rs[m] = rsqrtf((((a.x + a.y) + (a.z + a.w)) + ((b.x + b.y) + (b.z + b.w)) + (((c.x + c.y) + (c.z + c.w)) + ((d.x + d.y) + (d.z + d.w)))) * (1.f / 1024.f) + EPS); }
#pragma unroll
            for (int m = 0; m < 4; ++m) { bf16* rowp = O + (size_t)(row0 + ai * HALF + m * 16) * ldc + col0;
#pragma unroll
                for (int bj = 0; bj < 2; ++bj) { const f32x4 v0 = acc[ai][bj][m][0] * rs[m], v1 = acc[ai][bj][m][1] * rs[m];
                    u32x4 w; w.x = cvt_pk_bf16(v0[0], v0[1]); w.y = cvt_pk_bf16(v0[2], v0[3]); w.z = cvt_pk_bf16(v1[0], v1[1]); w.w = cvt_pk_bf16(v1[2], v1[3]);
                    *(u32x4*)(rowp + bj * HALF) = w; } }
        }
    }
};
struct EpiSwiglu {
    static constexpr bool PERM = true;
    bf16* H; int ldc;
    __device__ __forceinline__ void operator()(const f32x4 (&acc)[2][2][4][2], const Unit& u, int wr, int wc, int fr, int fq) const {
        const int row0 = u.pm * BM + wr * 64 + fr, col0 = u.pn * HALF + wc * 32 + 8 * fq;
#pragma unroll
        for (int ai = 0; ai < 2; ++ai)
#pragma unroll
            for (int m = 0; m < 4; ++m) {
                float o[8];
#pragma unroll
                for (int n = 0; n < 2; ++n)
#pragma unroll
                    for (int q = 0; q < 4; ++q) { const float g = acc[ai][0][m][n][q]; o[4 * n + q] = g * sigmoidf_(g) * acc[ai][1][m][n][q]; }
                u32x4 w; w.x = cvt_pk_bf16(o[0], o[1]); w.y = cvt_pk_bf16(o[2], o[3]); w.z = cvt_pk_bf16(o[4], o[5]); w.w = cvt_pk_bf16(o[6], o[7]);
                *(u32x4*)(H + (size_t)(row0 + ai * HALF + m * 16) * ldc + col0) = w; }
    }
};
}

__device__ __forceinline__ int hyb_colmap(int n) {
    if (n < 1280) return n;
    if (n < 1536) return 1304 + (n - 1280);
    if (n < 1792) return 1560 + (n - 1536);
    if (n < 2304) return 1816 + (n - 1792);
    if (n < 2816) return 2344 + (n - 2304);
    if (n < 2840) return 1280 + (n - 2816);
    if (n < 2856) return 2328 + (n - 2840);
    return -1;
}
__device__ __forceinline__ void tr_item(const float* __restrict__ W, int Nsrc, int K, bf16* __restrict__ Wt, const float* __restrict__ gain, int kind, int nblk, LAS float* scr, int item, int lane) {
    const int kb = item / nblk, nb = item % nblk, k0 = 64 * kb, n0 = 64 * nb;
    const int ksub = lane >> 4, n4 = lane & 15, n = n0 + 4 * n4;
    int col;
    if (kind == 0) col = n; else if (kind == 1) col = hyb_colmap(n); else { const int pn = n >> 8, r = n & 255; col = (r >> 7) * 384 + pn * 128 + (r & 127); }
    f32x4 v[16];
#pragma unroll
    for (int i = 0; i < 16; ++i) v[i] = col >= 0 ? *(const f32x4*)(W + (size_t)(k0 + 4 * i + ksub) * Nsrc + col) : (f32x4){0.f, 0.f, 0.f, 0.f};
    if (gain) {
#pragma unroll
        for (int i = 0; i < 16; ++i) v[i] = v[i] * gain[k0 + 4 * i + ksub];
    }
#pragma unroll
    for (int i = 0; i < 16; ++i) { LAS float* d = scr + (4 * i + ksub) * 65 + 4 * n4; d[0] = v[i].x; d[1] = v[i].y; d[2] = v[i].z; d[3] = v[i].w; }
    LDS_WAIT();
    const int c = lane & 7;
#pragma unroll
    for (int jx = 0; jx < 8; ++jx) {
        const int nn = (lane >> 3) + 8 * jx; const LAS float* s = scr + (8 * c) * 65 + nn;
        u32x4 o; o.x = pk2(s[0 * 65], s[1 * 65]); o.y = pk2(s[2 * 65], s[3 * 65]); o.z = pk2(s[4 * 65], s[5 * 65]); o.w = pk2(s[6 * 65], s[7 * 65]);
        *(u32x4*)(Wt + (size_t)(n0 + nn) * K + k0 + 8 * c) = o;
    }
    LDS_WAIT();
}
__device__ __forceinline__ void rms_row_to_bf16(const float* __restrict__ xrow, bf16* __restrict__ orow, float* __restrict__ copy, int lane) {
    const f32x4* xr = (const f32x4*)xrow + lane;
    f32x4 v[4]; float s = 0.f;
#pragma unroll
    for (int j = 0; j < 4; ++j) { v[j] = xr[64 * j]; s += (v[j].x * v[j].x + v[j].y * v[j].y) + (v[j].z * v[j].z + v[j].w * v[j].w); }
    const float rstd = rsqrtf(wave_sum(s) * (1.f / 1024.f) + EPS);
    u32x2* o8 = (u32x2*)orow + lane;
#pragma unroll
    for (int j = 0; j < 4; ++j) { u32x2 w; w.x = pk2(v[j].x * rstd, v[j].y * rstd); w.y = pk2(v[j].z * rstd, v[j].w * rstd); o8[64 * j] = w; }
    if (copy) { f32x4* c4 = (f32x4*)copy + lane;
#pragma unroll
        for (int j = 0; j < 4; ++j) c4[64 * j] = v[j]; }
}

__device__ __forceinline__ void phase_prologue(KArgs A, int wv_, LAS unsigned char* lds) {
    const int tid = opaque_tid(wv_), wid = __builtin_amdgcn_readfirstlane(tid >> 6), lane = tid & 63;
    const int gw = blockIdx.x * 8 + wid, NGW = gridDim.x * 8;
    LAS float* scr = (LAS float*)(lds + wid * 16640);
    unsigned char* ws = opq(A->ws);
    constexpr int N_HYB = 2 * 768, N_HOUT = 2 * 256, N_SGIN = 2 * 1024, N_SGOUT = 2 * 512, N_WQ = 4 * 256, N_WKV = 4 * 512, N_WO = 4 * 256, N_MIN = 64 * 192, N_MOUT = 64 * 96, N_W1T = 4 * 32;
    constexpr int NITEMS = N_HYB + N_HOUT + N_SGIN + N_SGOUT + N_WQ + N_WKV + N_WO + N_MIN + N_MOUT + N_W1T;
    for (int it = gw; it < NITEMS; it += NGW) {
        int r = it;
        if (r < N_HYB) { const int sl = r / 768; tr_item(A->in[I_HYBIN] + (size_t)sl * 1024 * HYSRC, HYSRC, 1024, (bf16*)(ws + WS_WHYB) + (size_t)sl * HYN * 1024, A->in[I_NMIX] + (2 * sl) * 1024, 1, 48, scr, r % 768, lane); continue; } r -= N_HYB;
        if (r < N_HOUT) { const int sl = r / 256; tr_item(A->in[I_HYBOUT] + (size_t)sl * 1024 * 1024, 1024, 1024, (bf16*)(ws + WS_WHOUT) + (size_t)sl * 1024 * 1024, nullptr, 0, 16, scr, r % 256, lane); continue; } r -= N_HOUT;
        if (r < N_SGIN) { const int sl = r / 1024; tr_item(A->in[I_SGIN] + (size_t)sl * 1024 * 4096, 4096, 1024, (bf16*)(ws + WS_WSGIN) + (size_t)sl * 4096 * 1024, A->in[I_NMIX] + (2 * sl + 1) * 1024, 0, 64, scr, r % 1024, lane); continue; } r -= N_SGIN;
        if (r < N_SGOUT) { const int sl = r / 512; tr_item(A->in[I_SGOUT] + (size_t)sl * 2048 * 1024, 1024, 2048, (bf16*)(ws + WS_WSGOUT) + (size_t)sl * 1024 * 2048, nullptr, 0, 16, scr, r % 512, lane); continue; } r -= N_SGOUT;
        if (r < N_WQ) { const int sl = r / 256; tr_item(A->in[I_XWQ] + (size_t)sl * 1024 * 1024, 1024, 1024, (bf16*)(ws + WS_WQ) + (size_t)sl * 1024 * 1024, A->in[I_NXAT] + sl * 1024, 0, 16, scr, r % 256, lane); continue; } r -= N_WQ;
        if (r < N_WKV) { const int sl = r / 512; tr_item(A->in[I_XWKV] + (size_t)sl * 1024 * 2048, 2048, 1024, (bf16*)(ws + WS_WKV) + (size_t)sl * 2048 * 1024, A->in[I_NMEM] + sl * 1024, 0, 32, scr, r % 512, lane); continue; } r -= N_WKV;
        if (r < N_WO) { const int sl = r / 256; tr_item(A->in[I_XWO] + (size_t)sl * 1024 * 1024, 1024, 1024, (bf16*)(ws + WS_WO) + (size_t)sl * 1024 * 1024, nullptr, 0, 16, scr, r % 256, lane); continue; } r -= N_WO;
        if (r < N_MIN) { const int sl = r / 192; tr_item(A->in[I_MOEIN] + (size_t)sl * 1024 * 768, 768, 1024, (bf16*)(ws + WS_WMIN) + (size_t)sl * 768 * 1024, A->in[I_NFFN] + (sl >> 4) * 1024, 2, 12, scr, r % 192, lane); continue; } r -= N_MIN;
        if (r < N_MOUT) { const int sl = r / 96; tr_item(A->in[I_MOEOUT] + (size_t)sl * 384 * 1024, 1024, 384, (bf16*)(ws + WS_WMOUT) + (size_t)sl * 1024 * 384, nullptr, 0, 16, scr, r % 96, lane); continue; } r -= N_MOUT;
        { const int sl = r / 32; tr_item(A->in[I_CMPW1] + (size_t)sl * 2048 * 64, 64, 2048, (bf16*)(ws + WS_W1T) + (size_t)sl * 64 * 2048, nullptr, 0, 1, scr, r % 32, lane); }
    }
    for (int m = gw; m < T; m += NGW) rms_row_to_bf16(A->in[I_X] + (size_t)m * D, (bf16*)(ws + WS_XN) + (size_t)m * D, A->out + (size_t)m * D, lane);
    for (int m = gw; m < NBATCH * NMEM; m += NGW) rms_row_to_bf16(A->in[I_MEM] + (size_t)m * D, (bf16*)(ws + WS_MN) + (size_t)m * D, nullptr, lane);
    const int gt = blockIdx.x * 512 + tid, NGT = gridDim.x * 512;
    const int* pos = (const int*)A->in[I_POS];
    float* cosT = (float*)(ws + WS_COS); float* sinT = (float*)(ws + WS_SIN);
    for (int i = gt; i < T * 32; i += NGT) {
        const int t = i >> 5, j = i & 31;
        const float ang = (float)pos[t] * A->freq[j];
        const double rev = (double)ang * 0.15915494309189533577;
        const float fr = (float)(rev - rint(rev));
        cosT[i] = __builtin_amdgcn_cosf(fr); sinT[i] = __builtin_amdgcn_sinf(fr);
    }
    { bf16* WSB = (bf16*)(ws + WS_WSB); float* M0 = (float*)(ws + WS_M0); const float* wsg = A->in[I_SGWS];
      for (int e = gt; e < 2 * 8 * 128 * 128; e += NGT) { const int s = e & 127, t = (e >> 7) & 127; WSB[e] = (bf16)f2bf(s <= t ? wsg[e] : 0.f); }
      for (int e = gt; e < 2 * 8 * 128; e += NGT) { const int t = e & 127; const float* r = wsg + (size_t)e * 128; float a = 0.f; for (int s = 0; s <= t; ++s) a += r[s]; M0[e] = a; } }
    float* RW = (float*)(ws + WS_RW);
    for (int i = gt; i < DEPTH * NEXP * D; i += NGT) { const int k = i & 1023, e = (i >> 10) & 15, l = i >> 14; RW[i] = A->in[I_RW][k * NEXP + e] * A->in[I_NFFN][l * D + k]; }
}

__device__ __forceinline__ void phase_knorm(KArgs A, int wv_) {
    const int tid_ = opaque_tid(wv_); const int wid = __builtin_amdgcn_readfirstlane(tid_ >> 6), lane = tid_ & 63; const int gw = blockIdx.x * 8 + wid, NGW = gridDim.x * 8;
    bf16* KV = (bf16*)(opq(A->ws) + WS_KV);
    for (int it = gw; it < DEPTH * 2048 * 4; it += NGW) {
        const int h = it & 3, m = (it >> 2) & 2047, l = it >> 13;
        bf16* p = KV + (size_t)m * 8192 + l * 2048 + h * 256 + 4 * lane;
        const u32x2 w = *(const u32x2*)p;
        float x0 = bflo(w.x), x1 = bfhi(w.x), x2 = bflo(w.y), x3 = bfhi(w.y);
        const float rstd = rsqrtf(wave_sum(x0 * x0 + x1 * x1 + x2 * x2 + x3 * x3) * (1.f / 256.f) + EPS) * 0.0625f;
        const f32x4 g = *(const f32x4*)(A->in[I_XKN] + l * 256 + 4 * lane) * *(const f32x4*)(A->in[I_XQN] + l * 256 + 4 * lane);
        u32x2 o; o.x = pk2(x0 * rstd * g.x, x1 * rstd * g.y); o.y = pk2(x2 * rstd * g.z, x3 * rstd * g.w);
        *(u32x2*)p = o;
    }
}

__device__ __forceinline__ int kpos64(int tok) { const int k = tok & 31; return (tok & 32) + 8 * ((k >> 2) & 3) + 4 * (k >> 4) + (k & 3); }
__device__ __forceinline__ int kperm64(int p) { const int fq = (p >> 3) & 3, j = p & 7; return (p & 32) + 16 * (j >> 2) + 4 * fq + (j & 3); }

__device__ __forceinline__ void phase_nsa_prep(KArgs A, int wv_, int i, LAS unsigned char* lds) {
    const int tid_ = opaque_tid(wv_); const int wid = __builtin_amdgcn_readfirstlane(tid_ >> 6), lane = tid_ & 63; const int gw = blockIdx.x * 8 + wid, NGW = gridDim.x * 8;
    unsigned char* ws = opq(A->ws);
    const bf16* HY = (const bf16*)(ws + WS_BIG);
    const float* cosT = (const float*)(ws + WS_COS); const float* sinT = (const float*)(ws + WS_SIN);
    bf16* QA = (bf16*)(ws + WS_QA); bf16* KS = (bf16*)(ws + WS_KS); bf16* KW = (bf16*)(ws + WS_KW);
    LAS float* abuf = (LAS float*)(lds + wid * 8192);
    const int NIT = T;
    for (int it = gw; it < NIT; it += NGW) {
        if (it < T) {
            const int t = it;
            const float c = cosT[t * 32 + (lane & 31)], s = sinT[t * 32 + (lane & 31)];
            float xin[12];
#pragma unroll
            for (int u = 0; u < 12; ++u) xin[u] = bf2f(HY[(size_t)t * HYN + (u < 8 ? C_QA + 64 * u : (u < 10 ? C_KS + 64 * (u - 8) : C_KW + 64 * (u - 10))) + lane]);
#pragma unroll
            for (int u = 0; u < 12; ++u) {
                int src; const float* gain; bf16* dst; float scale;
                if (u < 8) { src = C_QA + 64 * u; gain = A->in[I_QNORM] + i * 64; dst = QA + (size_t)t * 512 + 64 * u; scale = 0.125f; }
                else if (u < 10) { src = C_KS + 64 * (u - 8); gain = A->in[I_KNORM] + (i * 3 + 1) * 64; dst = KS + (size_t)t * 128 + 64 * (u - 8); scale = 1.f; }
                else { src = C_KW + 64 * (u - 10); gain = A->in[I_KNORM] + (i * 3 + 2) * 64; dst = KW + (size_t)t * 128 + 64 * (u - 10); scale = 1.f; }
                const float x = xin[u]; (void)src;
                const float y = x * rsqrtf(wave_sum(x * x) * (1.f / 64.f) + EPS) * gain[lane] * scale;
                const float pr = __shfl_xor(y, 32);
                const float o = lane < 32 ? y * c - pr * s : y * c + pr * s;
                dst[lane] = (bf16)f2bf(o);
            }
        }
    }
}


__device__ __forceinline__ void phase_compress_mfma(KArgs A, int wv_, int i, LAS unsigned char* lds) {
    const int tid = opaque_tid(wv_), wid = __builtin_amdgcn_readfirstlane(tid >> 6), lane = tid & 63, fr = lane & 15, fq = lane >> 4;
    unsigned char* ws = opq(A->ws);
    const bf16* HY = (const bf16*)(ws + WS_BIG);
    const float* cosT = (const float*)(ws + WS_COS); const float* sinT = (const float*)(ws + WS_SIN);
    LAS float* part = (LAS float*)lds;
    LAS float* hbuf = part + 8 * 1024;
    LAS float* obuf = hbuf + 1024;
    for (int it = blockIdx.x; it < 2 * 127; it += gridDim.x) {
        const int kv = it / 127, tile = it % 127;
        const float* pe = A->in[I_CMPPE] + (size_t)(i * 2 + kv) * 32 * 64;
        const float* w2 = A->in[I_CMPW2] + (size_t)(i * 2 + kv) * 64 * 64;
        const bf16* w1t = (const bf16*)(ws + WS_W1T) + (size_t)(i * 2 + kv) * 64 * 2048;
        const int coff = kv ? C_VC : C_KC;
        {
            const int R = tile * 16 + fr, g = R & 1, bn = R >> 1, n = bn % NCMP, b = bn / NCMP;
            const bf16* arow = HY + (size_t)(b * S + 16 * n) * HYN + coff + g * 64;
            f32x4 acc[4];
#pragma unroll
            for (int t = 0; t < 4; ++t) acc[t] = (f32x4){0.f, 0.f, 0.f, 0.f};
#pragma unroll 2
            for (int s = 0; s < 8; ++s) {
                const int k0 = 256 * wid + 32 * s, l = k0 >> 6, d0 = (k0 & 63) + 8 * fq;
                const u32x4 hw = *(const u32x4*)(arow + (size_t)l * HYN + d0);
                const f32x4 p0 = *(const f32x4*)(pe + l * 64 + d0), p1 = *(const f32x4*)(pe + l * 64 + d0 + 4);
                u32x4 aw; aw.x = pk2(bflo(hw.x) + p0.x, bfhi(hw.x) + p0.y); aw.y = pk2(bflo(hw.y) + p0.z, bfhi(hw.y) + p0.w); aw.z = pk2(bflo(hw.z) + p1.x, bfhi(hw.z) + p1.y); aw.w = pk2(bflo(hw.w) + p1.z, bfhi(hw.w) + p1.w);
                const bf16x8 af = __builtin_bit_cast(bf16x8, aw);
#pragma unroll
                for (int t = 0; t < 4; ++t) { const bf16x8 bfr = *(const bf16x8*)(w1t + (size_t)(16 * t + fr) * 2048 + k0 + 8 * fq);
                    acc[t] = __builtin_amdgcn_mfma_f32_16x16x32_bf16(af, bfr, acc[t], 0, 0, 0); }
            }
            __syncthreads();
#pragma unroll
            for (int t = 0; t < 4; ++t)
#pragma unroll
                for (int r = 0; r < 4; ++r) part[wid * 1024 + (4 * fq + r) * 64 + 16 * t + fr] = acc[t][r];
        }
        __syncthreads();
        for (int e = tid; e < 1024; e += 512) { float a = 0.f;
#pragma unroll
            for (int w = 0; w < 8; ++w) a += part[w * 1024 + e];
            hbuf[e] = gelu_tanh(a); }
        __syncthreads();
        for (int e = tid; e < 1024; e += 512) { const int r = e >> 6, j = e & 63; float o = 0.f;
#pragma unroll 8
            for (int m = 0; m < 64; ++m) o += hbuf[r * 64 + m] * w2[m * 64 + j];
            obuf[e] = o; }
        __syncthreads();
        for (int r = wid; r < 16; r += 8) {
            const int R = tile * 16 + r, g = R & 1, bn = R >> 1, n = bn % NCMP, b = bn / NCMP;
            const float o = obuf[r * 64 + lane];
            if (kv == 0) {
                const float y = o * rsqrtf(wave_sum(o * o) * (1.f / 64.f) + EPS) * A->in[I_KNORM][(i * 3 + 0) * 64 + lane];
                const int tp = b * S + 16 * n + 31;
                const float c = cosT[tp * 32 + (lane & 31)], sn = sinT[tp * 32 + (lane & 31)];
                const float pr = __shfl_xor(y, 32);
                const float oo = lane < 32 ? y * c - pr * sn : y * c + pr * sn;
                ((bf16*)(ws + WS_KC))[((size_t)(b * 128 + n) * 2 + g) * 64 + lane] = (bf16)f2bf(oo);
            } else {
                bf16* vct = (bf16*)(ws + WS_VC) + ((size_t)(b * 2 + g) * 64 + lane) * 128;
                vct[(n & 64) + kpos64(n & 63)] = (bf16)f2bf(o);
                if (n == 126) vct[127] = 0;
            }
        }
    }
    __syncthreads();
}

__device__ __forceinline__ void nsa_block(const LAS float* qs, const bf16* __restrict__ krow, bool ok, const bf16* __restrict__ vbase, int vstride, int lane,
                                          float (&m)[4], float (&l)[4], float (&o)[4]) {
    float s[4] = {0.f, 0.f, 0.f, 0.f};
#pragma unroll 2
    for (int c = 0; c < 8; ++c) {
        const u32x4 kw = *(const u32x4*)(krow + 8 * c);
        const float k0 = bflo(kw.x), k1 = bfhi(kw.x), k2 = bflo(kw.y), k3 = bfhi(kw.y), k4 = bflo(kw.z), k5 = bfhi(kw.z), k6 = bflo(kw.w), k7 = bfhi(kw.w);
#pragma unroll
        for (int hh = 0; hh < 4; ++hh) {
            const f32x4 qa = *(const LAS f32x4*)(qs + hh * 64 + 8 * c), qb = *(const LAS f32x4*)(qs + hh * 64 + 8 * c + 4);
            s[hh] += (qa.x * k0 + qa.y * k1) + (qa.z * k2 + qa.w * k3) + (qb.x * k4 + qb.y * k5) + (qb.z * k6 + qb.w * k7);
        }
    }
    float p[4];
#pragma unroll
    for (int hh = 0; hh < 4; ++hh) {
        const float sv = ok ? s[hh] : -INFINITY;
        const float bm = wave_max(sv);
        const float mn = fmaxf(m[hh], bm);
        if (mn == -INFINITY) { p[hh] = 0.f; continue; }
        const float alpha = __expf(m[hh] - mn);
        p[hh] = ok ? __expf(sv - mn) : 0.f;
        l[hh] = l[hh] * alpha + wave_sum(p[hh]);
        o[hh] *= alpha; m[hh] = mn;
    }
#pragma unroll 8
    for (int kk = 0; kk < 64; ++kk) {
        const float v = bf2f(vbase[(size_t)kk * vstride + lane]);
#pragma unroll
        for (int hh = 0; hh < 4; ++hh) o[hh] += __shfl(p[hh], kk) * v;
    }
}
__device__ __forceinline__ void phase_nsa_attn(KArgs A, int wv_, int i, LAS unsigned char* lds) {
    const int tid_ = opaque_tid(wv_); const int wid = __builtin_amdgcn_readfirstlane(tid_ >> 6), lane0 = tid_ & 63; const int gw = blockIdx.x * 8 + wid, NGW = gridDim.x * 8;
    unsigned char* ws = opq(A->ws);
    const bf16* HY = (const bf16*)(ws + WS_BIG); const bf16* QA = (const bf16*)(ws + WS_QA); const bf16* KS = (const bf16*)(ws + WS_KS); const bf16* KW = (const bf16*)(ws + WS_KW);
    const bf16* KC = (const bf16*)(ws + WS_KC); const bf16* VC = (const bf16*)(ws + WS_VC); bf16* CAT = (bf16*)(ws + WS_CAT);
    LAS float* qs = (LAS float*)(lds + wid * 2048);
    LAS float* ps = qs + 256;
    for (int it = gw; it < 2 * T; it += NGW) {
        int lane = lane0; asm volatile("" : "+v"(lane));
        const int tok = it >> 1, g = it & 1, b = tok >> 11, t = tok & 2047;
#pragma unroll
        for (int hh = 0; hh < 4; ++hh) qs[hh * 64 + lane] = bf2f(QA[(size_t)tok * 512 + (g * 4 + hh) * 64 + lane]);
        LDS_WAIT();
        const int ncv = t >= 31 ? ((t - 31) >> 4) + 1 : 0;
        float oc[4] = {0.f, 0.f, 0.f, 0.f};
        float psum0 = 0.f, psum1 = 0.f;
        {
            const bool v0 = lane < ncv, v1 = lane + 64 < ncv;
            const bf16* k0p = KC + ((size_t)(b * 128 + lane) * 2 + g) * 64;
            const bf16* k1p = KC + ((size_t)(b * 128 + (lane + 64 < 127 ? lane + 64 : 126)) * 2 + g) * 64;
            float s0[4] = {0.f, 0.f, 0.f, 0.f}, s1[4] = {0.f, 0.f, 0.f, 0.f};
#pragma unroll 2
            for (int c = 0; c < 8; ++c) {
                const u32x4 ka = *(const u32x4*)(k0p + 8 * c), kb = *(const u32x4*)(k1p + 8 * c);
#pragma unroll
                for (int hh = 0; hh < 4; ++hh) {
                    const f32x4 qa = *(const LAS f32x4*)(qs + hh * 64 + 8 * c), qb = *(const LAS f32x4*)(qs + hh * 64 + 8 * c + 4);
                    s0[hh] += (qa.x * bflo(ka.x) + qa.y * bfhi(ka.x)) + (qa.z * bflo(ka.y) + qa.w * bfhi(ka.y)) + (qb.x * bflo(ka.z) + qb.y * bfhi(ka.z)) + (qb.z * bflo(ka.w) + qb.w * bfhi(ka.w));
                    s1[hh] += (qa.x * bflo(kb.x) + qa.y * bfhi(kb.x)) + (qa.z * bflo(kb.y) + qa.w * bfhi(kb.y)) + (qb.x * bflo(kb.z) + qb.y * bfhi(kb.z)) + (qb.z * bflo(kb.w) + qb.w * bfhi(kb.w));
                }
            }
            float p0[4], p1[4];
#pragma unroll
            for (int hh = 0; hh < 4; ++hh) {
                const float a0 = v0 ? s0[hh] : -INFINITY, a1 = v1 ? s1[hh] : -INFINITY;
                const float mx = wave_max(fmaxf(a0, a1));
                if (ncv > 0) {
                    const float e0 = v0 ? __expf(a0 - mx) : 0.f, e1 = v1 ? __expf(a1 - mx) : 0.f;
                    const float inv = 1.0f / wave_sum(e0 + e1);
                    p0[hh] = e0 * inv; p1[hh] = e1 * inv;
                } else { p0[hh] = 0.f; p1[hh] = 0.f; }
                psum0 += p0[hh]; psum1 += p1[hh];
            }
#pragma unroll 2
            for (int c = 0; c < ncv; ++c) {
                const float v = bf2f(VC[((size_t)(b * 128 + c) * 2 + g) * 64 + lane]);
#pragma unroll
                for (int hh = 0; hh < 4; ++hh) oc[hh] += __shfl(c < 64 ? p0[hh] : p1[hh], c & 63) * v;
            }
        }
        ps[lane] = psum0; ps[64 + lane] = psum1;
        LDS_WAIT();
        const int cur = t >> 6;
        unsigned selmask;
        {
            const int j = lane & 31;
            float imp = ps[4 * j] + ps[4 * j + 1] + ps[4 * j + 2] + 0.5f * ps[4 * j + 3] + (j > 0 ? 0.5f * ps[4 * j - 1] : 0.f);
            const bool valid = j <= cur, forced = (j == 0) || (j == cur) || (j == cur - 1);
            const float score = valid ? imp + (forced ? 1000.0f : 0.f) : -INFINITY;
            int rank = 0;
#pragma unroll 8
            for (int jj = 0; jj < 32; ++jj) { const float sj = __shfl(score, jj); rank += (sj > score || (sj == score && jj < j)) ? 1 : 0; }
            const bool sel = valid && rank < 8 && lane < 32;
            selmask = (unsigned)__ballot(sel);
        }
        LDS_WAIT();
        float o1[4] = {0.f, 0.f, 0.f, 0.f}, o2[4] = {0.f, 0.f, 0.f, 0.f};
#pragma unroll 1
        for (int pass = 0; pass < 2; ++pass) {
            float oa[4] = {0.f, 0.f, 0.f, 0.f}, ma[4] = {-INFINITY, -INFINITY, -INFINITY, -INFINITY}, la[4] = {0.f, 0.f, 0.f, 0.f};
            const int lo = pass ? (t - 255 > 0 ? t - 255 : 0) : 0;
            const unsigned bm = pass ? 0xffffffffu : selmask;
            const bf16* Kb = pass ? KW : KS; const int vc = pass ? C_VW : C_VS;
#pragma unroll 1
            for (int j = lo >> 6; j <= cur; ++j) {
                if (!((bm >> j) & 1u)) continue;
                const int key = 64 * j + lane; const size_t kt = (size_t)(b * S + key);
                nsa_block(qs, Kb + kt * 128 + g * 64, key <= t && key >= lo, HY + (size_t)(b * S + 64 * j) * HYN + vc + g * 64, HYN, lane, ma, la, oa);
            }
            if (pass == 0) {
#pragma unroll
                for (int hh = 0; hh < 4; ++hh) o1[hh] = oa[hh] / la[hh];
            } else {
#pragma unroll
                for (int hh = 0; hh < 4; ++hh) o2[hh] = oa[hh] / la[hh];
            }
        }
#pragma unroll
        for (int hh = 0; hh < 4; ++hh) {
            const int head = g * 4 + hh;
            const float* gb = A->in[I_GATEB] + i * 24 + head * 3;
            const bf16* gl = HY + (size_t)tok * HYN + C_GA + head * 3;
            const float g0 = sigmoidf_(bf2f(gl[0]) + gb[0]), g1 = sigmoidf_(bf2f(gl[1]) + gb[1]), g2 = sigmoidf_(bf2f(gl[2]) + gb[2]);
            const float o = g0 * oc[hh] + g1 * o1[hh] + g2 * o2[hh];
            CAT[(size_t)tok * 1024 + head * 64 + lane] = (bf16)f2bf(o);
        }
    }
}

__device__ __forceinline__ void phase_gla_seq(KArgs A, int wv_, int i, LAS unsigned char* lds) {
    const int tid = opaque_tid(wv_), wid = __builtin_amdgcn_readfirstlane(tid >> 6), lane = tid & 63;
    unsigned char* ws = opq(A->ws);
    const bf16* HY = (const bf16*)(ws + WS_BIG); bf16* CAT = (bf16*)(ws + WS_CAT);
    constexpr int CH = 16;
    LAS float* la = (LAS float*)lds;
    LAS float* lk = la + 4 * CH * 64;
    LAS float* lq = lk + 4 * CH * 64;
    LAS float* lo = lq + 4 * CH * 64;
    const float* wa2 = A->in[I_WA2] + i * 16 * 256; const float* ba = A->in[I_BA] + i * 256; const float* og = A->in[I_ONORM] + i * 128;
    for (int it = blockIdx.x; it < 8; it += gridDim.x) {
        const int pl = tid >> 7, v = tid & 127, p = it * 4 + pl, b = p >> 2, h = p & 3;
        float St[64];
#pragma unroll
        for (int k = 0; k < 64; ++k) St[k] = 0.f;
        for (int c0 = 0; c0 < S; c0 += CH) {
            __syncthreads();
            for (int e = tid; e < 4 * CH * 64; e += 512) {
                const int kk = e & 63, tk = (e >> 6) % CH, pp = e / (64 * CH); const int pb = (it * 4 + pp) >> 2, ph = (it * 4 + pp) & 3;
                const size_t tok = (size_t)pb * S + c0 + tk; const bf16* row = HY + tok * HYN;
                float z = ba[ph * 64 + kk];
#pragma unroll
                for (int r = 0; r < 16; ++r) z += bf2f(row[C_AL + r]) * wa2[r * 256 + ph * 64 + kk];
                const float ls_ = fminf(z, 0.f) - log1pf(__expf(-fabsf(z)));
                la[e] = __expf(ls_ * (1.f / 16.f));
                lk[e] = bf2f(row[C_KB + ph * 64 + kk]);
                lq[e] = bf2f(row[C_QB + ph * 64 + kk]) * 0.125f;
            }
            __syncthreads();
            for (int tk = 0; tk < CH; ++tk) {
                const size_t tok = (size_t)b * S + c0 + tk;
                const float vv = bf2f(HY[tok * HYN + C_VB + h * 128 + v]);
                const LAS float* pa = la + (pl * CH + tk) * 64; const LAS float* pk = lk + (pl * CH + tk) * 64; const LAS float* pq = lq + (pl * CH + tk) * 64;
                float o = 0.f;
#pragma unroll
                for (int k4 = 0; k4 < 16; ++k4) {
                    const f32x4 a4 = *(const LAS f32x4*)(pa + 4 * k4), k4v = *(const LAS f32x4*)(pk + 4 * k4), q4 = *(const LAS f32x4*)(pq + 4 * k4);
                    St[4 * k4 + 0] = a4.x * St[4 * k4 + 0] + k4v.x * vv; o += q4.x * St[4 * k4 + 0];
                    St[4 * k4 + 1] = a4.y * St[4 * k4 + 1] + k4v.y * vv; o += q4.y * St[4 * k4 + 1];
                    St[4 * k4 + 2] = a4.z * St[4 * k4 + 2] + k4v.z * vv; o += q4.z * St[4 * k4 + 2];
                    St[4 * k4 + 3] = a4.w * St[4 * k4 + 3] + k4v.w * vv; o += q4.w * St[4 * k4 + 3];
                }
                lo[(pl * CH + tk) * 128 + v] = o;
            }
            __syncthreads();
            for (int r = wid; r < 4 * CH; r += 8) {
                const int pp = r / CH, tk = r % CH; const int pb = (it * 4 + pp) >> 2, ph = (it * 4 + pp) & 3;
                const size_t tok = (size_t)pb * S + c0 + tk;
                const float x0 = lo[r * 128 + lane], x1 = lo[r * 128 + 64 + lane];
                const float rstd = rsqrtf(wave_sum(x0 * x0 + x1 * x1) * (1.f / 128.f) + EPS);
                const float r0 = bf2f(HY[tok * HYN + C_RB + ph * 128 + lane]), r1 = bf2f(HY[tok * HYN + C_RB + ph * 128 + 64 + lane]);
                CAT[tok * 1024 + 512 + ph * 128 + lane] = (bf16)f2bf(x0 * rstd * og[lane] * (r0 * sigmoidf_(r0)));
                CAT[tok * 1024 + 512 + ph * 128 + 64 + lane] = (bf16)f2bf(x1 * rstd * og[64 + lane] * (r1 * sigmoidf_(r1)));
            }
        }
        __syncthreads();
    }
}


__device__ __forceinline__ void phase_nsa_attn_mfma(KArgs A, int wv_, int i, LAS unsigned char* lds) {
    const int tid = opaque_tid(wv_), wid = __builtin_amdgcn_readfirstlane(tid >> 6), lane = tid & 63, fr = lane & 15, fq = lane >> 4;
    unsigned char* ws = opq(A->ws);
    const bf16* HY = (const bf16*)(ws + WS_BIG); const bf16* QA = (const bf16*)(ws + WS_QA); const bf16* KS = (const bf16*)(ws + WS_KS); const bf16* KW = (const bf16*)(ws + WS_KW);
    const bf16* KC = (const bf16*)(ws + WS_KC); const bf16* VCT = (const bf16*)(ws + WS_VC); const bf16* VTA = (const bf16*)(ws + WS_VTA); bf16* CAT = (bf16*)(ws + WS_CAT);
    constexpr int RS = 72;
    LAS bf16* ktl = (LAS bf16*)lds;
    LAS bf16* vtl = ktl + 4 * 64 * RS;
    LAS float* scl = (LAS float*)(lds + 73728) + wid * 256;
    LAS unsigned* msk = (LAS unsigned*)(lds + 73728 + 8192);
    LAS unsigned* umask = msk + 64;
    const float* gb = A->in[I_GATEB] + i * 24;
    for (int pit = blockIdx.x; pit < 256; pit += gridDim.x) {
#pragma unroll 1
        for (int hf = 0; hf < 2; ++hf) {
            const int bg = pit >> 4, xx = pit & 15, x = hf ? 31 - xx : xx, b = bg >> 1, g = bg & 1;
            const size_t tokbase = (size_t)b * S + 64 * x;
            const int tl0 = 8 * wid + (fr >> 2);
            if (tid == 0) *umask = 0u;
            bf16x8 qf[2][2];
#pragma unroll
            for (int mt = 0; mt < 2; ++mt)
#pragma unroll
                for (int s = 0; s < 2; ++s) qf[mt][s] = *(const bf16x8*)(QA + (tokbase + tl0 + 4 * mt) * 512 + (g * 4 + (fr & 3)) * 64 + 32 * s + 8 * fq);
            f32x4 outacc[2][4];
            {
                const int tmaxc = (4 * x + 3 + 15) >> 4;
                const bf16* kcb = KC + ((size_t)(b * 128 + fr) * 2 + g) * 64 + 8 * fq;
                bf16x8 pcf[2][4];
#pragma unroll
                for (int mt = 0; mt < 2; ++mt) {
                    f32x4 sc[8];
                    const bf16* kp = kcb;
#pragma unroll
                    for (int t = 0; t < 8; ++t) { sc[t] = (f32x4){0.f, 0.f, 0.f, 0.f};
                        asm volatile("" : "+v"(kp));
                        if (t < tmaxc) {
                            const bf16x8 k0 = *(const bf16x8*)(kp), k1 = *(const bf16x8*)(kp + 32);
                            sc[t] = __builtin_amdgcn_mfma_f32_16x16x32_bf16(k0, qf[mt][0], sc[t], 0, 0, 0);
                            sc[t] = __builtin_amdgcn_mfma_f32_16x16x32_bf16(k1, qf[mt][1], sc[t], 0, 0, 0); }
                        kp += 16 * 128; }
                    const int tg = 64 * x + tl0 + 4 * mt; const int ncv = tg >= 31 ? ((tg - 31) >> 4) + 1 : 0;
                    float mx = -INFINITY;
#pragma unroll
                    for (int t = 0; t < 8; ++t)
#pragma unroll
                        for (int r = 0; r < 4; ++r) { const bool v = 16 * t + 4 * fq + r < ncv; sc[t][r] = v ? sc[t][r] : -INFINITY; mx = fmaxf(mx, sc[t][r]); }
                    mx = fmaxf(mx, __shfl_xor(mx, 16)); mx = fmaxf(mx, __shfl_xor(mx, 32));
                    const float mxs = mx == -INFINITY ? 0.f : mx;
                    float sum = 0.f;
#pragma unroll
                    for (int t = 0; t < 8; ++t)
#pragma unroll
                        for (int r = 0; r < 4; ++r) { sc[t][r] = __expf(sc[t][r] - mxs); sum += sc[t][r]; }
                    sum += __shfl_xor(sum, 16); sum += __shfl_xor(sum, 32);
                    const float inv = sum > 0.f ? 1.f / sum : 0.f;
#pragma unroll
                    for (int t = 0; t < 8; ++t) sc[t] = sc[t] * inv;
#pragma unroll
                    for (int s = 0; s < 4; ++s) { u32x4 w; w.x = pk2(sc[2 * s].x, sc[2 * s].y); w.y = pk2(sc[2 * s].z, sc[2 * s].w); w.z = pk2(sc[2 * s + 1].x, sc[2 * s + 1].y); w.w = pk2(sc[2 * s + 1].z, sc[2 * s + 1].w);
                        pcf[mt][s] = __builtin_bit_cast(bf16x8, w); }
                    float w3[8];
#pragma unroll
                    for (int t = 0; t < 8; ++t) {
#pragma unroll
                        for (int r = 0; r < 4; ++r) { float v = sc[t][r]; v += __shfl_xor(v, 1); v += __shfl_xor(v, 2); sc[t][r] = v; }
                        w3[t] = __shfl(sc[t].w, (lane + 48) & 63);
                    }
#pragma unroll
                    for (int t = 0; t < 8; ++t) {
                        const float prev = fq > 0 ? w3[t] : (t > 0 ? w3[t > 0 ? t - 1 : 0] : 0.f);
                        const float imp = sc[t].x + sc[t].y + sc[t].z + 0.5f * sc[t].w + 0.5f * prev;
                        if ((fr & 3) == 0) scl[(4 * mt + (fr >> 2)) * 32 + 4 * t + fq] = imp;
                    }
                    asm volatile("" ::: "memory");
                }
                const bf16* vcb = VCT + ((size_t)(b * 2 + g) * 64 + fr) * 128 + 8 * fq;
#pragma unroll
                for (int n = 0; n < 4; ++n) {
                    outacc[0][n] = (f32x4){0.f, 0.f, 0.f, 0.f}; outacc[1][n] = (f32x4){0.f, 0.f, 0.f, 0.f};
                    asm volatile("" : "+v"(vcb));
#pragma unroll
                    for (int s = 0; s < 4; ++s) if (2 * s < tmaxc) {
                        const bf16x8 vf = *(const bf16x8*)(vcb + 32 * s);
                        outacc[0][n] = __builtin_amdgcn_mfma_f32_16x16x32_bf16(vf, pcf[0][s], outacc[0][n], 0, 0, 0);
                        outacc[1][n] = __builtin_amdgcn_mfma_f32_16x16x32_bf16(vf, pcf[1][s], outacc[1][n], 0, 0, 0); }
                    vcb += 16 * 128;
                    asm volatile("" ::: "memory");
                }
            }
            float g1v[2], g2v[2];
#pragma unroll
            for (int mt = 0; mt < 2; ++mt) {
                const int head = g * 4 + (fr & 3);
                const bf16* gl = HY + (tokbase + tl0 + 4 * mt) * HYN + C_GA + head * 3;
                const float g0 = sigmoidf_(bf2f(gl[0]) + gb[head * 3 + 0]);
                g1v[mt] = sigmoidf_(bf2f(gl[1]) + gb[head * 3 + 1]); g2v[mt] = sigmoidf_(bf2f(gl[2]) + gb[head * 3 + 2]);
#pragma unroll
                for (int n = 0; n < 4; ++n) outacc[mt][n] = outacc[mt][n] * g0;
            }
            LDS_WAIT();
            asm volatile("" ::: "memory");
            {
                const int tok8 = lane >> 3, jg = lane & 7;
                float sj[32];
#pragma unroll
                for (int q = 0; q < 8; ++q) { const f32x4 v = *(const LAS f32x4*)(scl + tok8 * 32 + 4 * q); sj[4 * q] = v.x; sj[4 * q + 1] = v.y; sj[4 * q + 2] = v.z; sj[4 * q + 3] = v.w; }
#pragma unroll
                for (int j = 0; j < 32; ++j) sj[j] = j <= x ? sj[j] + ((j == 0 || j == x || j == x - 1) ? 1000.0f : 0.f) : -INFINITY;
                unsigned bits = 0u;
                const f32x4 mv = *(const LAS f32x4*)(scl + tok8 * 32 + 4 * jg);
#pragma unroll
                for (int q = 0; q < 4; ++q) {
                    const int j = 4 * jg + q;
                    const float mine = j <= x ? mv[q] + ((j == 0 || j == x || j == x - 1) ? 1000.0f : 0.f) : -INFINITY;
                    int rank = 0;
#pragma unroll
                    for (int jj = 0; jj < 32; ++jj) rank += (sj[jj] > mine || (sj[jj] == mine && jj < j)) ? 1 : 0;
                    bits |= (j <= x && rank < 8) ? (1u << j) : 0u;
                }
                bits |= __shfl_xor(bits, 1); bits |= __shfl_xor(bits, 2); bits |= __shfl_xor(bits, 4);
                if (jg == 0) { msk[wid * 8 + tok8] = bits; atomicOr((unsigned*)umask, bits); }
            }
            __syncthreads();
#pragma unroll 1
            for (int pass = 0; pass < 2; ++pass) {
                const int jlo = pass ? (x >= 4 ? x - 4 : 0) : 0;
                const unsigned inrange = (x >= 31 ? 0xffffffffu : ((2u << x) - 1u)) & ~((1u << jlo) - 1u);
                unsigned bmask = pass ? inrange : (*umask & inrange);
                const bf16* Kb = pass ? KW : KS; const int cg = (pass ? 10 : 8) + g;
                unsigned tm[2], wm[2];
#pragma unroll
                for (int mt = 0; mt < 2; ++mt) {
                    tm[mt] = pass ? 0xffffffffu : msk[wid * 8 + 4 * mt + (fr >> 2)];
                    wm[mt] = pass ? 0xffffffffu : (msk[wid * 8 + 4 * mt] | msk[wid * 8 + 4 * mt + 1] | msk[wid * 8 + 4 * mt + 2] | msk[wid * 8 + 4 * mt + 3]);
                    wm[mt] = __builtin_amdgcn_readfirstlane(wm[mt]);
                }
                f32x4 o[2][4]; float mrun[2], lrun[2];
#pragma unroll
                for (int mt = 0; mt < 2; ++mt) { mrun[mt] = -INFINITY; lrun[mt] = 0.f;
#pragma unroll
                    for (int n = 0; n < 4; ++n) o[mt][n] = (f32x4){0.f, 0.f, 0.f, 0.f}; }
                const int srow = tid >> 3, sc16 = tid & 7;
                u32x4 pk0 = (u32x4){0u, 0u, 0u, 0u}, pv0 = pk0, pk1 = pk0, pv1 = pk0;
#define NSA_LD(jx, pk, pv) do { const bf16* ksrc = Kb + ((size_t)b * S + 64 * (jx) + srow) * 128 + g * 64 + sc16 * 8; const bf16* vsrc = VTA + ((size_t)((b * 32 + (jx)) * 12 + cg)) * 4096 + srow * 64 + sc16 * 8; \
                    pk = *(const u32x4*)ksrc; pv = *(const u32x4*)vsrc; } while (0)
                int j0 = __ffs(bmask) - 1; bmask &= bmask - 1u;
                int j1 = bmask ? __ffs(bmask) - 1 : -1; bmask &= bmask - 1u;
                NSA_LD(j0, pk0, pv0); if (j1 >= 0) NSA_LD(j1, pk1, pv1);
                int buf = 0;
                while (j0 >= 0) {
                    *(LAS u32x4*)(ktl + (buf * 2 + 0) * 64 * RS + srow * RS + sc16 * 8) = pk0; *(LAS u32x4*)(vtl + (buf * 2 + 0) * 64 * RS + srow * RS + sc16 * 8) = pv0;
                    if (j1 >= 0) { *(LAS u32x4*)(ktl + (buf * 2 + 1) * 64 * RS + srow * RS + sc16 * 8) = pk1; *(LAS u32x4*)(vtl + (buf * 2 + 1) * 64 * RS + srow * RS + sc16 * 8) = pv1; }
                    const int jn0 = bmask ? __ffs(bmask) - 1 : -1; bmask &= bmask - 1u;
                    const int jn1 = bmask ? __ffs(bmask) - 1 : -1; bmask &= bmask - 1u;
                    if (jn0 >= 0) NSA_LD(jn0, pk0, pv0);
                    if (jn1 >= 0) NSA_LD(jn1, pk1, pv1);
                    __syncthreads();
#pragma unroll 1
                    for (int sub = 0; sub < 2; ++sub) {
                        const int j = sub ? j1 : j0;
                        if (j < 0) break;
                        const LAS bf16* kt = ktl + (buf * 2 + sub) * 64 * RS + fr * RS + 8 * fq; const LAS bf16* vt = vtl + (buf * 2 + sub) * 64 * RS + fr * RS + 8 * fq;
#pragma unroll
                        for (int mt = 0; mt < 2; ++mt) {
                            if (!((wm[mt] >> j) & 1u)) continue;
                            f32x4 sc[4];
#pragma unroll
                            for (int t = 0; t < 4; ++t) { sc[t] = (f32x4){0.f, 0.f, 0.f, 0.f};
                                sc[t] = __builtin_amdgcn_mfma_f32_16x16x32_bf16(*(const LAS bf16x8*)(kt + t * 16 * RS), qf[mt][0], sc[t], 0, 0, 0);
                                sc[t] = __builtin_amdgcn_mfma_f32_16x16x32_bf16(*(const LAS bf16x8*)(kt + t * 16 * RS + 32), qf[mt][1], sc[t], 0, 0, 0); }
                            const int tl = tl0 + 4 * mt;
                            const bool rowok = (tm[mt] >> j) & 1u;
                            const int kphi = j == x ? tl : 63;
                            const int kplo = (pass && j == x - 4) ? tl + 1 : 0;
                            float bm = -INFINITY;
#pragma unroll
                            for (int t = 0; t < 4; ++t)
#pragma unroll
                                for (int r = 0; r < 4; ++r) { const int kp = 16 * t + 4 * fq + r; const bool v = rowok && kp <= kphi && kp >= kplo; sc[t][r] = v ? sc[t][r] : -INFINITY; bm = fmaxf(bm, sc[t][r]); }
                            bm = fmaxf(bm, __shfl_xor(bm, 16)); bm = fmaxf(bm, __shfl_xor(bm, 32));
                            const float mn = fmaxf(mrun[mt], bm); const float mns = mn == -INFINITY ? 0.f : mn;
                            const float alpha = __expf(mrun[mt] - mns);
                            float rs = 0.f;
#pragma unroll
                            for (int t = 0; t < 4; ++t)
#pragma unroll
                                for (int r = 0; r < 4; ++r) { sc[t][r] = __expf(sc[t][r] - mns); rs += sc[t][r]; }
                            rs += __shfl_xor(rs, 16); rs += __shfl_xor(rs, 32);
                            lrun[mt] = lrun[mt] * alpha + rs; mrun[mt] = mn;
                            bf16x8 pf[2];
#pragma unroll
                            for (int s = 0; s < 2; ++s) { u32x4 w; w.x = pk2(sc[2 * s].x, sc[2 * s].y); w.y = pk2(sc[2 * s].z, sc[2 * s].w); w.z = pk2(sc[2 * s + 1].x, sc[2 * s + 1].y); w.w = pk2(sc[2 * s + 1].z, sc[2 * s + 1].w);
                                pf[s] = __builtin_bit_cast(bf16x8, w); }
#pragma unroll
                            for (int n = 0; n < 4; ++n) { o[mt][n] = o[mt][n] * alpha;
                                o[mt][n] = __builtin_amdgcn_mfma_f32_16x16x32_bf16(*(const LAS bf16x8*)(vt + n * 16 * RS), pf[0], o[mt][n], 0, 0, 0);
                                o[mt][n] = __builtin_amdgcn_mfma_f32_16x16x32_bf16(*(const LAS bf16x8*)(vt + n * 16 * RS + 32), pf[1], o[mt][n], 0, 0, 0); }
                        }
                    }
                    j0 = jn0; j1 = jn1; buf ^= 1;
                }
#undef NSA_LD
#pragma unroll
                for (int mt = 0; mt < 2; ++mt) { const float sc_ = (pass ? g2v[mt] : g1v[mt]) / lrun[mt];
#pragma unroll
                    for (int n = 0; n < 4; ++n) outacc[mt][n] = outacc[mt][n] + o[mt][n] * sc_; }
                __syncthreads();
            }
#pragma unroll
            for (int mt = 0; mt < 2; ++mt) {
                bf16* dst = CAT + (tokbase + tl0 + 4 * mt) * 1024 + (g * 4 + (fr & 3)) * 64 + 4 * fq;
#pragma unroll
                for (int n = 0; n < 4; ++n) { u32x2 w; w.x = pk2(outacc[mt][n].x, outacc[mt][n].y); w.y = pk2(outacc[mt][n].z, outacc[mt][n].w); *(u32x2*)(dst + 16 * n) = w; }
            }
        }
    }
    __syncthreads();
}

__device__ __forceinline__ void phase_vtiles(KArgs A, int wv_, LAS unsigned char* lds) {
    const int tid_ = opaque_tid(wv_); const int wid = __builtin_amdgcn_readfirstlane(tid_ >> 6), lane = tid_ & 63; const int gw = blockIdx.x * 8 + wid, NGW = gridDim.x * 8;
    unsigned char* ws = opq(A->ws);
    const bf16* HY = (const bf16*)(ws + WS_BIG); bf16* VTA = (bf16*)(ws + WS_VTA);
    constexpr int TS = 66;
    LAS bf16* tl = (LAS bf16*)(lds + 65536) + wid * (64 * TS);
    for (int it = gw; it < NBATCH * 32 * 12; it += NGW) {
        const int cg = it % 12, bc = it / 12;
        const int colbase = cg < 8 ? C_VB + cg * 64 : (cg < 10 ? C_VS + (cg - 8) * 64 : C_VW + (cg - 10) * 64);
        const u32x4* src = (const u32x4*)(HY + (size_t)(bc * 64 + lane) * HYN + colbase);
        u32x4 w[8];
#pragma unroll
        for (int i = 0; i < 8; ++i) w[i] = src[i];
#pragma unroll
        for (int i = 0; i < 8; ++i) { LAS unsigned* d = (LAS unsigned*)(tl + lane * TS + 8 * i); d[0] = w[i].x; d[1] = w[i].y; d[2] = w[i].z; d[3] = w[i].w; }
        LDS_WAIT();
        bf16* dst = VTA + (size_t)it * 4096 + lane * 64;
#pragma unroll
        for (int p8 = 0; p8 < 8; ++p8) {
            unsigned short x[8];
#pragma unroll
            for (int j = 0; j < 8; ++j) x[j] = tl[kperm64(p8 * 8 + j) * TS + lane];
            u32x4 o; o.x = x[0] | ((unsigned)x[1] << 16); o.y = x[2] | ((unsigned)x[3] << 16); o.z = x[4] | ((unsigned)x[5] << 16); o.w = x[6] | ((unsigned)x[7] << 16);
            *(u32x4*)(dst + p8 * 8) = o;
        }
        LDS_WAIT();
    }
}

__device__ __forceinline__ float log_sigmoid16(float z) { return (fminf(z, 0.f) - __logf(1.0f + __expf(-fabsf(z)))) * (1.f / 16.f); }
#define GLA_Z(tokv) ({ float z_ = bias; _Pragma("unroll") for (int r_ = 0; r_ < 16; ++r_) z_ += __builtin_bit_cast(float, __builtin_amdgcn_readlane(__builtin_bit_cast(int, al[r_]), (tokv))) * wc[r_]; z_; })
#define GLA_LOAD_GATE() \
    float al[16], wc[16]; \
    { const u32x4* ap_ = (const u32x4*)(HY + (size_t)(tok0 + lane) * HYN + C_AL); const u32x4 a0_ = ap_[0], a1_ = ap_[1]; \
      al[0] = bflo(a0_.x); al[1] = bfhi(a0_.x); al[2] = bflo(a0_.y); al[3] = bfhi(a0_.y); al[4] = bflo(a0_.z); al[5] = bfhi(a0_.z); al[6] = bflo(a0_.w); al[7] = bfhi(a0_.w); \
      al[8] = bflo(a1_.x); al[9] = bfhi(a1_.x); al[10] = bflo(a1_.y); al[11] = bfhi(a1_.y); al[12] = bflo(a1_.z); al[13] = bfhi(a1_.z); al[14] = bflo(a1_.w); al[15] = bfhi(a1_.w); } \
    _Pragma("unroll") for (int r_ = 0; r_ < 16; ++r_) wc[r_] = A->in[I_WA2][(i * 16 + r_) * 256 + h * 64 + lane]; \
    const float bias = A->in[I_BA][i * 256 + h * 64 + lane];

__device__ __forceinline__ void phase_gla_a(KArgs A, int wv_, int i, LAS unsigned char* lds) {
    const int tid_ = opaque_tid(wv_); const int wid = __builtin_amdgcn_readfirstlane(tid_ >> 6), lane = tid_ & 63, fr = lane & 15, fq = lane >> 4; const int gw = blockIdx.x * 8 + wid, NGW = gridDim.x * 8;
    unsigned char* ws = opq(A->ws);
    const bf16* HY = (const bf16*)(ws + WS_BIG); const bf16* VTA = (const bf16*)(ws + WS_VTA); float* SLOC = (float*)(ws + WS_SLOC); float* DEC = (float*)(ws + WS_DEC);
    constexpr int RS = 72;
    LAS bf16* kh = (LAS bf16*)lds + wid * (64 * RS);
    (void)gw;
    for (int it = wid * (int)gridDim.x + (int)blockIdx.x; it < 1024; it += NGW) {
        const int c = it & 31, bh = it >> 5, b = bh >> 2, h = bh & 3; const size_t tok0 = (size_t)b * S + c * 64;
        GLA_LOAD_GATE();
        float bl = 0.f;
#pragma unroll 8
        for (int tk = 0; tk < 64; ++tk) bl += log_sigmoid16(GLA_Z(tk));
        float bc = 0.f;
        unsigned short kcol[64];
#pragma unroll
        for (int tk = 0; tk < 64; ++tk) kcol[tk] = HY[(tok0 + tk) * HYN + C_KB + h * 64 + lane];
#pragma unroll
        for (int tk = 0; tk < 64; ++tk) {
            bc += log_sigmoid16(GLA_Z(tk));
            kh[lane * RS + kpos64(tk)] = (bf16)f2bf(bf2f(kcol[tk]) * __expf(bl - bc));
        }
        DEC[it * 64 + lane] = __expf(bl);
        LDS_WAIT();
#pragma unroll
        for (int dvh = 0; dvh < 2; ++dvh) {
            const bf16* vt = VTA + ((size_t)((b * 32 + c) * 12 + h * 2 + dvh)) * 4096;
            bf16x8 vf[4][2];
#pragma unroll
            for (int n = 0; n < 4; ++n)
#pragma unroll
                for (int s = 0; s < 2; ++s) vf[n][s] = *(const bf16x8*)(vt + (16 * n + fr) * 64 + 32 * s + 8 * fq);
#pragma unroll
            for (int m = 0; m < 4; ++m) {
                const bf16x8 a0 = *(const LAS bf16x8*)(kh + (16 * m + fr) * RS + 8 * fq), a1 = *(const LAS bf16x8*)(kh + (16 * m + fr) * RS + 32 + 8 * fq);
#pragma unroll
                for (int n = 0; n < 4; ++n) {
                    f32x4 acc = (f32x4){0.f, 0.f, 0.f, 0.f};
                    acc = __builtin_amdgcn_mfma_f32_16x16x32_bf16(a0, vf[n][0], acc, 0, 0, 0);
                    acc = __builtin_amdgcn_mfma_f32_16x16x32_bf16(a1, vf[n][1], acc, 0, 0, 0);
                    float* dst = SLOC + ((size_t)it * 64 + 16 * m + 4 * fq) * 128 + dvh * 64 + 16 * n + fr;
                    dst[0] = acc.x; dst[128] = acc.y; dst[256] = acc.z; dst[384] = acc.w;
                }
            }
        }
        LDS_WAIT();
    }
}
__device__ __forceinline__ void phase_gla_c(KArgs A, int wv_, int i, LAS unsigned char* lds) {
    const int tid_ = opaque_tid(wv_); const int wid = __builtin_amdgcn_readfirstlane(tid_ >> 6), lane = tid_ & 63, fr = lane & 15, fq = lane >> 4; const int gw = blockIdx.x * 8 + wid, NGW = gridDim.x * 8;
    unsigned char* ws = opq(A->ws);
    const bf16* HY = (const bf16*)(ws + WS_BIG); const bf16* VTA = (const bf16*)(ws + WS_VTA); const bf16* STT = (const bf16*)(ws + WS_STT); bf16* CAT = (bf16*)(ws + WS_CAT);
    constexpr int RS = 72;
    LAS bf16* qs = (LAS bf16*)lds + wid * (128 * RS);
    LAS bf16* ks = qs + 64 * RS;
    const float* og = A->in[I_ONORM] + i * 128;
    (void)gw; (void)NGW;
    for (int blk = blockIdx.x; blk < 128; blk += gridDim.x) {
        {
            const float* SLOC = (const float*)(ws + WS_SLOC); const float* DEC = (const float*)(ws + WS_DEC); bf16* STw = (bf16*)(ws + WS_STT);
            const int tid = tid_, dv = tid & 127, ko = tid >> 7, bh = blk >> 2, c0 = (blk & 3) * 8;
            float sv[16];
#pragma unroll
            for (int j = 0; j < 16; ++j) sv[j] = 0.f;
#pragma unroll 4
            for (int c = 0; c < c0 + 8; ++c) {
                const size_t item = (size_t)bh * 32 + c;
                if (c >= c0) {
                    u32x4 o0, o1; o0.x = pk2(sv[0], sv[1]); o0.y = pk2(sv[2], sv[3]); o0.z = pk2(sv[4], sv[5]); o0.w = pk2(sv[6], sv[7]);
                    o1.x = pk2(sv[8], sv[9]); o1.y = pk2(sv[10], sv[11]); o1.z = pk2(sv[12], sv[13]); o1.w = pk2(sv[14], sv[15]);
                    u32x4* d = (u32x4*)(STw + (item * 128 + dv) * 64 + ko * 16); d[0] = o0; d[1] = o1;
                }
                if (c < c0 + 7) {
                    const float* sl = SLOC + (item * 64 + ko * 16) * 128 + dv; const float* dc = DEC + item * 64 + ko * 16;
#pragma unroll
                    for (int j = 0; j < 16; ++j) sv[j] = dc[j] * sv[j] + sl[j * 128];
                }
            }
            asm volatile("s_waitcnt vmcnt(0)" ::: "memory");
            __syncthreads();
        }
        const int it = blk * 8 + wid;
        const int c = it & 31, bh = it >> 5, b = bh >> 2, h = bh & 3; const size_t tok0 = (size_t)b * S + c * 64;
        GLA_LOAD_GATE();
        float bc = 0.f;
        unsigned short qcol[64], kcol[64];
#pragma unroll
        for (int tk = 0; tk < 64; ++tk) { const bf16* row = HY + (tok0 + tk) * HYN; qcol[tk] = row[C_QB + h * 64 + lane]; kcol[tk] = row[C_KB + h * 64 + lane]; }
#pragma unroll
        for (int tk = 0; tk < 64; ++tk) {
            bc += log_sigmoid16(GLA_Z(tk));
            const float eb = __expf(bc);
            qs[tk * RS + lane] = (bf16)f2bf(bf2f(qcol[tk]) * 0.125f * eb); ks[tk * RS + lane] = (bf16)f2bf(bf2f(kcol[tk]) / eb);
        }
        LDS_WAIT();
        bf16x8 st[8][2];
#pragma unroll
        for (int n = 0; n < 8; ++n)
#pragma unroll
            for (int s = 0; s < 2; ++s) st[n][s] = *(const bf16x8*)(STT + ((size_t)it * 128 + 16 * n + fr) * 64 + 32 * s + 8 * fq);
        const bf16* vt = VTA + ((size_t)((b * 32 + c) * 12 + h * 2)) * 4096;
#pragma unroll
        for (int mi = 0; mi < 4; ++mi) {
            const bf16x8 q0 = *(const LAS bf16x8*)(qs + (16 * mi + fr) * RS + 8 * fq), q1 = *(const LAS bf16x8*)(qs + (16 * mi + fr) * RS + 32 + 8 * fq);
            f32x4 sc[4];
#pragma unroll
            for (int t = 0; t < 4; ++t) {
                sc[t] = (f32x4){0.f, 0.f, 0.f, 0.f};
                if (t <= mi) {
                    const bf16x8 k0 = *(const LAS bf16x8*)(ks + (16 * t + fr) * RS + 8 * fq), k1 = *(const LAS bf16x8*)(ks + (16 * t + fr) * RS + 32 + 8 * fq);
                    sc[t] = __builtin_amdgcn_mfma_f32_16x16x32_bf16(k0, q0, sc[t], 0, 0, 0);
                    sc[t] = __builtin_amdgcn_mfma_f32_16x16x32_bf16(k1, q1, sc[t], 0, 0, 0);
                    if (t == mi) {
                        sc[t].x = (4 * fq + 0 <= fr) ? sc[t].x : 0.f; sc[t].y = (4 * fq + 1 <= fr) ? sc[t].y : 0.f; sc[t].z = (4 * fq + 2 <= fr) ? sc[t].z : 0.f; sc[t].w = (4 * fq + 3 <= fr) ? sc[t].w : 0.f; }
                }
            }
            bf16x8 pf[2];
#pragma unroll
            for (int s = 0; s < 2; ++s) { u32x4 w; w.x = pk2(sc[2 * s].x, sc[2 * s].y); w.y = pk2(sc[2 * s].z, sc[2 * s].w); w.z = pk2(sc[2 * s + 1].x, sc[2 * s + 1].y); w.w = pk2(sc[2 * s + 1].z, sc[2 * s + 1].w);
                pf[s] = __builtin_bit_cast(bf16x8, w); }
            f32x4 o[8]; float ssq = 0.f;
#pragma unroll
            for (int n = 0; n < 8; ++n) {
                o[n] = (f32x4){0.f, 0.f, 0.f, 0.f};
                o[n] = __builtin_amdgcn_mfma_f32_16x16x32_bf16(st[n][0], q0, o[n], 0, 0, 0);
                o[n] = __builtin_amdgcn_mfma_f32_16x16x32_bf16(st[n][1], q1, o[n], 0, 0, 0);
                const bf16* vrow = vt + (size_t)(n >> 2) * 4096 + (16 * (n & 3) + fr) * 64 + 8 * fq;
                o[n] = __builtin_amdgcn_mfma_f32_16x16x32_bf16(*(const bf16x8*)vrow, pf[0], o[n], 0, 0, 0);
                if (mi >= 2) o[n] = __builtin_amdgcn_mfma_f32_16x16x32_bf16(*(const bf16x8*)(vrow + 32), pf[1], o[n], 0, 0, 0);
                ssq += (o[n].x * o[n].x + o[n].y * o[n].y) + (o[n].z * o[n].z + o[n].w * o[n].w);
            }
            ssq += __shfl_xor(ssq, 16); ssq += __shfl_xor(ssq, 32);
            const float rstd = rsqrtf(ssq * (1.f / 128.f) + EPS);
            const size_t tok = tok0 + 16 * mi + fr;
#pragma unroll
            for (int n = 0; n < 8; ++n) {
                const int dv = 16 * n + 4 * fq;
                const u32x2 rw = *(const u32x2*)(HY + tok * HYN + C_RB + h * 128 + dv); const f32x4 g = *(const f32x4*)(og + dv);
                const float r0 = bflo(rw.x), r1 = bfhi(rw.x), r2 = bflo(rw.y), r3 = bfhi(rw.y);
                u32x2 w; w.x = pk2(o[n].x * rstd * g.x * (r0 * sigmoidf_(r0)), o[n].y * rstd * g.y * (r1 * sigmoidf_(r1)));
                w.y = pk2(o[n].z * rstd * g.z * (r2 * sigmoidf_(r2)), o[n].w * rstd * g.w * (r3 * sigmoidf_(r3)));
                *(u32x2*)(CAT + tok * 1024 + 512 + h * 128 + dv) = w;
            }
        }
        LDS_WAIT();
        __syncthreads();
    }
}

__device__ __forceinline__ void phase_sgu_mix(KArgs A, int wv_, int i, LAS unsigned char* lds) {
    const int tid = opaque_tid(wv_), wid = __builtin_amdgcn_readfirstlane(tid >> 6), lane = tid & 63;
    unsigned char* ws = opq(A->ws);
    const bf16* U = (const bf16*)(ws + WS_U); const bf16* V = (const bf16*)(ws + WS_V); bf16* UM = (bf16*)(ws + WS_UM);
    LAS float* vt = (LAS float*)lds;
    LAS float* st = vt + 128 * 256;
    const float* lng = A->in[I_LNG] + i * 2048; const float* lnb = A->in[I_LNB] + i * 2048;
    for (int it = blockIdx.x; it < NBATCH * 16 * 8; it += gridDim.x) {
        const int g = it & 7, n = (it >> 3) & 15, b = it >> 7;
        const size_t tok0 = (size_t)b * S + n * 128;
        __syncthreads();
        for (int s = wid * 16; s < wid * 16 + 16; ++s) {
            const u32x4* vr = (const u32x4*)(V + (tok0 + s) * 2048) + lane;
            float x[32]; float sum = 0.f;
#pragma unroll
            for (int j = 0; j < 4; ++j) { const u32x4 w = vr[64 * j];
                x[8 * j + 0] = bflo(w.x); x[8 * j + 1] = bfhi(w.x); x[8 * j + 2] = bflo(w.y); x[8 * j + 3] = bfhi(w.y); x[8 * j + 4] = bflo(w.z); x[8 * j + 5] = bfhi(w.z); x[8 * j + 6] = bflo(w.w); x[8 * j + 7] = bfhi(w.w); }
#pragma unroll
            for (int j = 0; j < 32; ++j) sum += x[j];
            const float mean = wave_sum(sum) * (1.f / 2048.f); float q = 0.f;
#pragma unroll
            for (int j = 0; j < 32; ++j) { const float d = x[j] - mean; q += d * d; }
            const float rstd = rsqrtf(wave_sum(q) * (1.f / 2048.f) + EPS);
            const u32x2 w = *((const u32x2*)(V + (tok0 + s) * 2048 + g * 256) + lane);
            const f32x4 gg = *(const f32x4*)(lng + g * 256 + 4 * lane), bb = *(const f32x4*)(lnb + g * 256 + 4 * lane);
            f32x4 o; o.x = (bflo(w.x) - mean) * rstd * gg.x + bb.x; o.y = (bfhi(w.x) - mean) * rstd * gg.y + bb.y; o.z = (bflo(w.y) - mean) * rstd * gg.z + bb.z; o.w = (bfhi(w.y) - mean) * rstd * gg.w + bb.w;
            *(LAS f32x4*)(vt + s * 256 + 4 * lane) = o;
            (void)st;
        }
        __syncthreads();
        const int c = tid & 255, th = tid >> 8;
        const float* wsg = A->in[I_SGWS] + (size_t)(i * 8 + g) * 128 * 128; const float* bsg = A->in[I_SGBS] + (i * 8 + g) * 128;
        for (int tt = 0; tt < 64; ++tt) {
            const int t = 2 * tt + th;
            const float* wr = wsg + t * 128;
            float acc = 0.f;
            for (int s = 0; s <= t; ++s) acc += wr[s] * vt[s * 256 + c];
            acc += bsg[t];
            const float u = bf2f(U[(tok0 + t) * 2048 + g * 256 + c]);
            UM[(tok0 + t) * 2048 + g * 256 + c] = (bf16)f2bf(u * acc);
        }
    }
    __syncthreads();
}


__device__ __forceinline__ void phase_sgu_mix_mfma(KArgs A, int wv_, int i, LAS unsigned char* lds) {
    const int tid = opaque_tid(wv_), wid = __builtin_amdgcn_readfirstlane(tid >> 6), lane = tid & 63, fr = lane & 15, fq = lane >> 4;
    unsigned char* ws = opq(A->ws);
    const bf16* U = (const bf16*)(ws + WS_U); const bf16* V = (const bf16*)(ws + WS_V); bf16* UM = (bf16*)(ws + WS_UM);
    const bf16* WSB = (const bf16*)(ws + WS_WSB) + (size_t)i * 8 * 16384; const float* M0 = (const float*)(ws + WS_M0) + i * 8 * 128;
    constexpr int VS = 136;
    LAS bf16* vT = (LAS bf16*)lds;
    LAS float* st = (LAS float*)(lds + 256 * VS * 2);
    const float* lng = A->in[I_LNG] + i * 2048; const float* lnb = A->in[I_LNB] + i * 2048; const float* bsg = A->in[I_SGBS] + i * 8 * 128;
    for (int it = blockIdx.x; it < 256; it += gridDim.x) {
        const int gh = it & 1, n_ = (it >> 1) & 15, b = it >> 5; const size_t tok0 = (size_t)b * S + n_ * 128;
        __syncthreads();
        for (int s4 = wid * 16; s4 < wid * 16 + 16; s4 += 4) {
            u32x4 w[4][4];
#pragma unroll
            for (int rr = 0; rr < 4; ++rr) { const u32x4* vr = (const u32x4*)(V + (tok0 + s4 + rr) * 2048) + lane;
#pragma unroll
                for (int j = 0; j < 4; ++j) w[rr][j] = vr[64 * j]; }
#pragma unroll
            for (int rr = 0; rr < 4; ++rr) {
                float sum = 0.f, sq = 0.f;
#pragma unroll
                for (int j = 0; j < 4; ++j) { const float x0 = bflo(w[rr][j].x), x1 = bfhi(w[rr][j].x), x2 = bflo(w[rr][j].y), x3 = bfhi(w[rr][j].y), x4 = bflo(w[rr][j].z), x5 = bfhi(w[rr][j].z), x6 = bflo(w[rr][j].w), x7 = bfhi(w[rr][j].w);
                    sum += ((x0 + x1) + (x2 + x3)) + ((x4 + x5) + (x6 + x7)); sq += ((x0 * x0 + x1 * x1) + (x2 * x2 + x3 * x3)) + ((x4 * x4 + x5 * x5) + (x6 * x6 + x7 * x7)); }
                sum = wave_sum(sum); sq = wave_sum(sq);
                const float mean = sum * (1.f / 2048.f); const float var = fmaxf(sq * (1.f / 2048.f) - mean * mean, 0.f);
                if (lane == 0) { st[2 * (s4 + rr)] = mean; st[2 * (s4 + rr) + 1] = rsqrtf(var + EPS); }
            }
        }
#pragma unroll 1
        for (int gg = 0; gg < 4; ++gg) {
            const int g = gh * 4 + gg;
            __syncthreads();
            {
                const int s = tid & 127, cq = tid >> 7;
                const float mean = st[2 * s], rstd = st[2 * s + 1];
                const u32x4* src = (const u32x4*)(V + (tok0 + s) * 2048 + g * 256 + cq * 64);
#pragma unroll
                for (int i8 = 0; i8 < 8; ++i8) {
                    const u32x4 w = src[i8];
                    LAS bf16* d = vT + (cq * 64 + i8 * 8) * VS + s;
                    d[0 * VS] = (bf16)f2bf((bflo(w.x) - mean) * rstd); d[1 * VS] = (bf16)f2bf((bfhi(w.x) - mean) * rstd); d[2 * VS] = (bf16)f2bf((bflo(w.y) - mean) * rstd); d[3 * VS] = (bf16)f2bf((bfhi(w.y) - mean) * rstd);
                    d[4 * VS] = (bf16)f2bf((bflo(w.z) - mean) * rstd); d[5 * VS] = (bf16)f2bf((bfhi(w.z) - mean) * rstd); d[6 * VS] = (bf16)f2bf((bflo(w.w) - mean) * rstd); d[7 * VS] = (bf16)f2bf((bfhi(w.w) - mean) * rstd);
                }
            }
            __syncthreads();
            bf16x8 vf[2][4];
#pragma unroll
            for (int m = 0; m < 2; ++m)
#pragma unroll
                for (int k = 0; k < 4; ++k) vf[m][k] = *(const LAS bf16x8*)(vT + (32 * wid + 16 * m + fr) * VS + 32 * k + 8 * fq);
            const bf16* wb = WSB + ((size_t)g * 128 + fr) * 128 + 8 * fq;
            f32x4 gc[2], bc[2];
#pragma unroll
            for (int m = 0; m < 2; ++m) { gc[m] = *(const f32x4*)(lng + g * 256 + 32 * wid + 16 * m + 4 * fq); bc[m] = *(const f32x4*)(lnb + g * 256 + 32 * wid + 16 * m + 4 * fq); }
#pragma unroll
            for (int n = 0; n < 8; ++n) {
                f32x4 a0 = (f32x4){0.f, 0.f, 0.f, 0.f}, a1 = (f32x4){0.f, 0.f, 0.f, 0.f};
                asm volatile("" : "+v"(wb));
#pragma unroll
                for (int k = 0; k < 4; ++k) if (k <= (n >> 1)) {
                    const bf16x8 wf = *(const bf16x8*)(wb + 32 * k);
                    a0 = __builtin_amdgcn_mfma_f32_16x16x32_bf16(vf[0][k], wf, a0, 0, 0, 0);
                    a1 = __builtin_amdgcn_mfma_f32_16x16x32_bf16(vf[1][k], wf, a1, 0, 0, 0); }
                wb += 16 * 128;
                const int t = 16 * n + fr; const float m0 = M0[g * 128 + t], bsv = bsg[g * 128 + t];
                const size_t ro = (tok0 + t) * 2048 + g * 256 + 32 * wid + 4 * fq;
#pragma unroll
                for (int m = 0; m < 2; ++m) {
                    const f32x4 a = m ? a1 : a0;
                    const u32x2 uw = *(const u32x2*)(U + ro + 16 * m);
                    u32x2 w; w.x = pk2((a.x * gc[m].x + bc[m].x * m0 + bsv) * bflo(uw.x), (a.y * gc[m].y + bc[m].y * m0 + bsv) * bfhi(uw.x));
                    w.y = pk2((a.z * gc[m].z + bc[m].z * m0 + bsv) * bflo(uw.y), (a.w * gc[m].w + bc[m].w * m0 + bsv) * bfhi(uw.y));
                    *(u32x2*)(UM + ro + 16 * m) = w;
                }
                asm volatile("" ::: "memory");
            }
        }
    }
    __syncthreads();
}

__device__ __forceinline__ void phase_rownorm(KArgs A, int wv_) {
    const int tid_ = opaque_tid(wv_); const int wid = __builtin_amdgcn_readfirstlane(tid_ >> 6), lane = tid_ & 63; const int gw = blockIdx.x * 8 + wid, NGW = gridDim.x * 8;
    bf16* XN = (bf16*)(opq(A->ws) + WS_XN); const float* X = A->out;
    f32x4 v[4], vn[4];
    if (gw < T) {
#pragma unroll
        for (int j = 0; j < 4; ++j) v[j] = ((const f32x4*)(X + (size_t)gw * D) + lane)[64 * j];
    }
    for (int m = gw; m < T; m += NGW) {
        const int mn = m + NGW < T ? m + NGW : m;
#pragma unroll
        for (int j = 0; j < 4; ++j) vn[j] = ((const f32x4*)(X + (size_t)mn * D) + lane)[64 * j];
        float s = 0.f;
#pragma unroll
        for (int j = 0; j < 4; ++j) s += (v[j].x * v[j].x + v[j].y * v[j].y) + (v[j].z * v[j].z + v[j].w * v[j].w);
        const float rstd = rsqrtf(wave_sum(s) * (1.f / 1024.f) + EPS);
        u32x2* o8 = (u32x2*)(XN + (size_t)m * D) + lane;
#pragma unroll
        for (int j = 0; j < 4; ++j) { u32x2 w; w.x = pk2(v[j].x * rstd, v[j].y * rstd); w.y = pk2(v[j].z * rstd, v[j].w * rstd); o8[64 * j] = w; }
#pragma unroll
        for (int j = 0; j < 4; ++j) v[j] = vn[j];
    }
}

__device__ __forceinline__ void phase_xattn(KArgs A, int wv_, int L, LAS unsigned char* lds) {
    const int tid = opaque_tid(wv_), wid = __builtin_amdgcn_readfirstlane(tid >> 6), lane = tid & 63;
    unsigned char* ws = opq(A->ws);
    const bf16* QX = (const bf16*)(ws + WS_QX); const bf16* KV = (const bf16*)(ws + WS_KV); bf16* OX = (bf16*)(ws + WS_OX);
    constexpr int KSTR = 129;
    LAS unsigned* kl = (LAS unsigned*)lds;
    LAS float* qb = (LAS float*)(lds + 132096) + wid * 256;
    LAS float* pb = (LAS float*)(lds + 132096 + 8192) + wid * 256;
    const float* qg = A->in[I_XQN] + L * 256;
    for (int it = blockIdx.x; it < NBATCH * 4 * 8; it += gridDim.x) {
        const int qc = it & 7, h = (it >> 3) & 3, b = it >> 5;
        __syncthreads();
        for (int e = tid; e < 256 * 128; e += 512) { const int m = e >> 7, dw = e & 127;
            kl[m * KSTR + dw] = *((const unsigned*)(KV + (size_t)(b * 256 + m) * 8192 + L * 2048 + h * 256) + dw); }
        __syncthreads();
        const bf16* Vb = KV + (size_t)(b * 256) * 8192 + L * 2048 + 1024 + h * 256;
        for (int tq = 0; tq < 32; ++tq) {
            const size_t tok = (size_t)b * S + qc * 256 + wid * 32 + tq;
            const u32x2 qw = *((const u32x2*)(QX + tok * 1024 + h * 256) + lane);
            const float q0 = bflo(qw.x), q1 = bfhi(qw.x), q2 = bflo(qw.y), q3 = bfhi(qw.y);
            const float rstd = rsqrtf(wave_sum(q0 * q0 + q1 * q1 + q2 * q2 + q3 * q3) * (1.f / 256.f) + EPS);
            const f32x4 gg = *(const f32x4*)(qg + 4 * lane);
            *(LAS f32x4*)(qb + 4 * lane) = (f32x4){q0 * rstd * gg.x, q1 * rstd * gg.y, q2 * rstd * gg.z, q3 * rstd * gg.w};
            LDS_WAIT();
            float s0 = 0.f, s1 = 0.f, s2 = 0.f, s3 = 0.f;
#pragma unroll 4
            for (int dw = 0; dw < 128; ++dw) {
                const f32x2 qq = *(const LAS f32x2*)(qb + 2 * dw);
                const unsigned k0 = kl[lane * KSTR + dw], k1 = kl[(lane + 64) * KSTR + dw], k2 = kl[(lane + 128) * KSTR + dw], k3 = kl[(lane + 192) * KSTR + dw];
                s0 += qq.x * bflo(k0) + qq.y * bfhi(k0); s1 += qq.x * bflo(k1) + qq.y * bfhi(k1);
                s2 += qq.x * bflo(k2) + qq.y * bfhi(k2); s3 += qq.x * bflo(k3) + qq.y * bfhi(k3);
            }
            const float mx = wave_max(fmaxf(fmaxf(s0, s1), fmaxf(s2, s3)));
            const float e0 = __expf(s0 - mx), e1 = __expf(s1 - mx), e2 = __expf(s2 - mx), e3 = __expf(s3 - mx);
            const float inv = 1.f / wave_sum((e0 + e1) + (e2 + e3));
            pb[lane] = e0 * inv; pb[lane + 64] = e1 * inv; pb[lane + 128] = e2 * inv; pb[lane + 192] = e3 * inv;
            LDS_WAIT();
            float o0 = 0.f, o1 = 0.f, o2 = 0.f, o3 = 0.f;
#pragma unroll 8
            for (int m = 0; m < 256; ++m) {
                const float p = pb[m];
                const u32x2 vw = *((const u32x2*)(Vb + (size_t)m * 8192) + lane);
                o0 += p * bflo(vw.x); o1 += p * bfhi(vw.x); o2 += p * bflo(vw.y); o3 += p * bfhi(vw.y);
            }
            u32x2 ow; ow.x = pk2(o0, o1); ow.y = pk2(o2, o3);
            *((u32x2*)(OX + tok * 1024 + h * 256) + lane) = ow;
            LDS_WAIT();
        }
    }
    __syncthreads();
}


__device__ __forceinline__ int kperm32(int p) { const int fq = (p >> 3) & 3, j = p & 7; return (p & ~31) + 16 * (j >> 2) + 4 * fq + (j & 3); }
__device__ __forceinline__ void phase_vtrans(KArgs A, int wv_, LAS unsigned char* lds) {
    const int tid = opaque_tid(wv_);
    unsigned char* ws = opq(A->ws);
    const bf16* KV = (const bf16*)(ws + WS_KV); bf16* VT = (bf16*)(ws + WS_VT);
    LAS bf16* vt = (LAS bf16*)lds;
    constexpr int VS = 258;
    for (int it = blockIdx.x; it < DEPTH * NBATCH * 4; it += gridDim.x) {
        const int h = it & 3, b = (it >> 2) & 7, l = it >> 5;
        __syncthreads();
        for (int e = tid; e < 256 * 32; e += 512) { const int m = e >> 5, c8 = e & 31;
            const u32x4 w = *(const u32x4*)(KV + (size_t)(b * 256 + m) * 8192 + l * 2048 + 1024 + h * 256 + c8 * 8);
            LAS unsigned* d = (LAS unsigned*)(vt + m * VS + c8 * 8); d[0] = w.x; d[1] = w.y; d[2] = w.z; d[3] = w.w; }
        __syncthreads();
        for (int e = tid; e < 256 * 32; e += 512) { const int dv = e & 255, p8 = e >> 8;
            unsigned short x[8];
#pragma unroll
            for (int j = 0; j < 8; ++j) x[j] = vt[kperm32(p8 * 8 + j) * VS + dv];
            u32x4 o; o.x = x[0] | ((unsigned)x[1] << 16); o.y = x[2] | ((unsigned)x[3] << 16); o.z = x[4] | ((unsigned)x[5] << 16); o.w = x[6] | ((unsigned)x[7] << 16);
            *(u32x4*)(VT + ((size_t)it * 256 + dv) * 256 + p8 * 8) = o; }
    }
    __syncthreads();
}

__device__ __forceinline__ void phase_xattn_mfma(KArgs A, int wv_, int L, LAS unsigned char* lds) {
    const int tid = opaque_tid(wv_), wid = __builtin_amdgcn_readfirstlane(tid >> 6), lane = tid & 63, fr = lane & 15, fq = lane >> 4;
    unsigned char* ws = opq(A->ws);
    const bf16* QX = (const bf16*)(ws + WS_QX); const bf16* KV = (const bf16*)(ws + WS_KV); const bf16* VT = (const bf16*)(ws + WS_VT); bf16* OX = (bf16*)(ws + WS_OX);
    constexpr int RS = 264;
    LAS bf16* kl = (LAS bf16*)lds;
    const float* qg = A->in[I_XQN] + L * 256;
    for (int it = blockIdx.x; it < NBATCH * 4 * 8; it += gridDim.x) {
        const int qt = it & 7, h = (it >> 3) & 3, b = it >> 5;
        __syncthreads();
        {
            const int row = tid >> 1, hf = tid & 1;
            const u32x4* src = (const u32x4*)(KV + (size_t)(b * 256 + row) * 8192 + L * 2048 + h * 256 + hf * 128);
#pragma unroll
            for (int i0 = 0; i0 < 16; i0 += 8) {
                u32x4 w[8];
#pragma unroll
                for (int i = 0; i < 8; ++i) w[i] = src[i0 + i];
#pragma unroll
                for (int i = 0; i < 8; ++i) *(LAS u32x4*)(kl + row * RS + hf * 128 + (i0 + i) * 8) = w[i];
            }
        }
        const size_t tok0 = (size_t)b * S + qt * 256 + wid * 32 + fr;
        u32x4 qw0[8], qw1[8];
#pragma unroll
        for (int s = 0; s < 8; ++s) { qw0[s] = *(const u32x4*)(QX + tok0 * 1024 + h * 256 + 32 * s + 8 * fq); qw1[s] = *(const u32x4*)(QX + (tok0 + 16) * 1024 + h * 256 + 32 * s + 8 * fq); }
        __syncthreads();
        bf16x8 pf0[8], pf1[8]; float inv0, inv1;
        auto s_part = [&](const u32x4 (&qw)[8], bf16x8 (&pf)[8], float& inv) __attribute__((always_inline)) {
            float ssq = 0.f;
#pragma unroll
            for (int s = 0; s < 8; ++s) {
                const float a0 = bflo(qw[s].x), a1 = bfhi(qw[s].x), a2 = bflo(qw[s].y), a3 = bfhi(qw[s].y), a4 = bflo(qw[s].z), a5 = bfhi(qw[s].z), a6 = bflo(qw[s].w), a7 = bfhi(qw[s].w);
                ssq += (a0 * a0 + a1 * a1) + (a2 * a2 + a3 * a3) + (a4 * a4 + a5 * a5) + (a6 * a6 + a7 * a7);
            }
            ssq += __shfl_xor(ssq, 16); ssq += __shfl_xor(ssq, 32);
            const float rstd = rsqrtf(ssq * (1.f / 256.f) + EPS);
            bf16x8 qf[8];
#pragma unroll
            for (int s = 0; s < 8; ++s) qf[s] = __builtin_bit_cast(bf16x8, qw[s]);
            f32x4 sc[16];
#pragma unroll
            for (int hf = 0; hf < 2; ++hf) {
                unsigned kb = (unsigned)(size_t)(kl + (128 * hf + fr) * RS + 8 * fq); asm volatile("" : "+v"(kb));
#pragma unroll
                for (int t8 = 0; t8 < 8; ++t8) { const int t = 8 * hf + t8; sc[t] = (f32x4){0.f, 0.f, 0.f, 0.f};
#pragma unroll
                    for (int s = 0; s < 8; ++s) { const bf16x8 kf = *(const LAS bf16x8*)(size_t)(kb + (unsigned)((16 * t8 * RS + 32 * s) * 2));
                        sc[t] = __builtin_amdgcn_mfma_f32_16x16x32_bf16(kf, qf[s], sc[t], 0, 0, 0); }
                    if (t & 1) asm volatile("" ::: "memory"); }
            }
            float mx = -INFINITY;
#pragma unroll
            for (int t = 0; t < 16; ++t) mx = fmaxf(mx, fmaxf(fmaxf(sc[t].x, sc[t].y), fmaxf(sc[t].z, sc[t].w)));
            mx = fmaxf(mx, __shfl_xor(mx, 16)); mx = fmaxf(mx, __shfl_xor(mx, 32));
            float lsum = 0.f;
#pragma unroll
            for (int t = 0; t < 16; ++t) { sc[t].x = __expf((sc[t].x - mx) * rstd); sc[t].y = __expf((sc[t].y - mx) * rstd); sc[t].z = __expf((sc[t].z - mx) * rstd); sc[t].w = __expf((sc[t].w - mx) * rstd); lsum += (sc[t].x + sc[t].y) + (sc[t].z + sc[t].w); }
            lsum += __shfl_xor(lsum, 16); lsum += __shfl_xor(lsum, 32);
            inv = 1.f / lsum;
#pragma unroll
            for (int s = 0; s < 8; ++s) { u32x4 w; w.x = pk2(sc[2 * s].x, sc[2 * s].y); w.y = pk2(sc[2 * s].z, sc[2 * s].w); w.z = pk2(sc[2 * s + 1].x, sc[2 * s + 1].y); w.w = pk2(sc[2 * s + 1].z, sc[2 * s + 1].w);
                pf[s] = __builtin_bit_cast(bf16x8, w); }
        };
        s_part(qw0, pf0, inv0);
        s_part(qw1, pf1, inv1);
        __syncthreads();
        {
            const int row = tid >> 1, hf = tid & 1;
            const u32x4* src = (const u32x4*)(VT + ((size_t)((L * 8 + b) * 4 + h) * 256 + row) * 256 + hf * 128);
#pragma unroll
            for (int i0 = 0; i0 < 16; i0 += 8) {
                u32x4 w[8];
#pragma unroll
                for (int i = 0; i < 8; ++i) w[i] = src[i0 + i];
#pragma unroll
                for (int i = 0; i < 8; ++i) *(LAS u32x4*)(kl + row * RS + hf * 128 + (i0 + i) * 8) = w[i];
            }
        }
        __syncthreads();
#pragma unroll
        for (int hf = 0; hf < 2; ++hf) {
            unsigned vb = (unsigned)(size_t)(kl + (128 * hf + fr) * RS + 8 * fq); asm volatile("" : "+v"(vb));
#pragma unroll
            for (int n8 = 0; n8 < 8; ++n8) { const int n = 8 * hf + n8; f32x4 o0 = (f32x4){0.f, 0.f, 0.f, 0.f}, o1 = o0;
#pragma unroll
                for (int s = 0; s < 8; ++s) { const bf16x8 vf = *(const LAS bf16x8*)(size_t)(vb + (unsigned)((16 * n8 * RS + 32 * s) * 2));
                    o0 = __builtin_amdgcn_mfma_f32_16x16x32_bf16(vf, pf0[s], o0, 0, 0, 0);
                    o1 = __builtin_amdgcn_mfma_f32_16x16x32_bf16(vf, pf1[s], o1, 0, 0, 0); }
                u32x2 w0, w1; w0.x = pk2(o0.x * inv0, o0.y * inv0); w0.y = pk2(o0.z * inv0, o0.w * inv0); w1.x = pk2(o1.x * inv1, o1.y * inv1); w1.y = pk2(o1.z * inv1, o1.w * inv1);
                *(u32x2*)(OX + tok0 * 1024 + h * 256 + 16 * n + 4 * fq) = w0;
                *(u32x2*)(OX + (tok0 + 16) * 1024 + h * 256 + 16 * n + 4 * fq) = w1;
                if (n & 1) asm volatile("" ::: "memory"); }
        }
    }
    __syncthreads();
}

__device__ __forceinline__ void phase_route(KArgs A, int wv_, int L, LAS unsigned char* lds) {
    const int tid_ = opaque_tid(wv_); const int wid = __builtin_amdgcn_readfirstlane(tid_ >> 6), lane = tid_ & 63;
    unsigned char* ws = opq(A->ws);
    const float* RW = (const float*)(ws + WS_RW) + (size_t)L * NEXP * D;
    unsigned* cnt = (unsigned*)(ws + WS_CTL) + CW_CNT + L * 64;
    int* list = (int*)(ws + WS_LIST); int* te = (int*)(ws + WS_TOK); int* tp = te + 2 * T; float* tw = (float*)(tp + 2 * T);
    bf16* XN = (bf16*)(ws + WS_XN);
    LAS float* rwl = (LAS float*)lds;
    LAS unsigned* lcnt = (LAS unsigned*)(lds + 65536);
    LAS unsigned* lbase = lcnt + 16;
    const float rbv = A->in[I_RB][lane >> 2];
    for (int e4 = tid_; e4 < NEXP * D / 4; e4 += 512) *(LAS f32x4*)(rwl + 4 * e4) = *(const f32x4*)(RW + 4 * e4);
    for (int blk = blockIdx.x; blk < T / 64; blk += gridDim.x) {
        __syncthreads();
        if (tid_ < 16) lcnt[tid_] = 0u;
        __syncthreads();
        int e0s = 0, e1s = 0, r0s = 0, r1s = 0; float w0s = 0.f;
        f32x4 v[4], vn[4];
#pragma unroll
        for (int j = 0; j < 4; ++j) v[j] = ((const f32x4*)(A->out + (size_t)(blk * 64 + wid * 8) * D) + lane)[64 * j];
#pragma unroll 1
        for (int q = 0; q < 8; ++q) {
            const int t = blk * 64 + wid * 8 + q;
            { const f32x4* xn_ = (const f32x4*)(A->out + (size_t)(t + (q < 7 ? 1 : 0)) * D) + lane;
#pragma unroll
              for (int j = 0; j < 4; ++j) vn[j] = xn_[64 * j]; }
            float s = 0.f;
#pragma unroll
            for (int j = 0; j < 4; ++j) s += (v[j].x * v[j].x + v[j].y * v[j].y) + (v[j].z * v[j].z + v[j].w * v[j].w);
            const float rstd = rsqrtf(wave_sum(s) * (1.f / 1024.f) + EPS);
            u32x2* o8 = (u32x2*)(XN + (size_t)t * D) + lane;
#pragma unroll
            for (int j = 0; j < 4; ++j) { u32x2 w; w.x = pk2(v[j].x * rstd, v[j].y * rstd); w.y = pk2(v[j].z * rstd, v[j].w * rstd); o8[64 * j] = w; }
            float a[16];
#pragma unroll
            for (int e = 0; e < 16; ++e) {
                const LAS f32x4* wr = (const LAS f32x4*)(rwl + e * D) + lane; float acc = 0.f;
#pragma unroll
                for (int j = 0; j < 4; ++j) { const f32x4 w = wr[64 * j]; acc += (v[j].x * w.x + v[j].y * w.y) + (v[j].z * w.z + v[j].w * w.w); }
                a[e] = acc;
            }
            float a8[8], a4[4], a2[2], a1;
            { const bool up = lane & 32;
#pragma unroll
              for (int k = 0; k < 8; ++k) { const float send = up ? a[k] : a[k + 8], keep = up ? a[k + 8] : a[k]; a8[k] = keep + __shfl_xor(send, 32); } }
            { const bool up = lane & 16;
#pragma unroll
              for (int k = 0; k < 4; ++k) { const float send = up ? a8[k] : a8[k + 4], keep = up ? a8[k + 4] : a8[k]; a4[k] = keep + __shfl_xor(send, 16); } }
            { const bool up = lane & 8;
#pragma unroll
              for (int k = 0; k < 2; ++k) { const float send = up ? a4[k] : a4[k + 2], keep = up ? a4[k + 2] : a4[k]; a2[k] = keep + __shfl_xor(send, 8); } }
            { const bool up = lane & 4; const float send = up ? a2[0] : a2[1], keep = up ? a2[1] : a2[0]; a1 = keep + __shfl_xor(send, 4); }
            a1 += __shfl_xor(a1, 2); a1 += __shfl_xor(a1, 1);
            const float lg = a1 * rstd + rbv;
            const float v0 = wave_max(lg);
            const int e0 = (__ffsll((unsigned long long)__ballot(lg == v0)) - 1) >> 2;
            const int gidx = e0 >> 2;
            const bool c2 = (lane >> 4) == gidx && (lane >> 2) != e0;
            const float m2 = c2 ? lg : -INFINITY;
            const float v1 = wave_max(m2);
            const int e1 = (__ffsll((unsigned long long)__ballot(c2 && m2 == v1)) - 1) >> 2;
            const float w0 = 1.f / (1.f + __expf(v1 - v0));
            unsigned r0 = 0, r1 = 0;
            if (lane == 0) { r0 = atomicAdd((unsigned*)(lcnt + e0), 1u); r1 = atomicAdd((unsigned*)(lcnt + e1), 1u); }
            r0 = __builtin_amdgcn_readfirstlane(r0); r1 = __builtin_amdgcn_readfirstlane(r1);
            if (lane == q) { e0s = e0; e1s = e1; r0s = (int)r0; r1s = (int)r1; w0s = w0; }
#pragma unroll
            for (int j = 0; j < 4; ++j) v[j] = vn[j];
        }
        __syncthreads();
        if (tid_ < 16) lbase[tid_] = atomicAdd(&cnt[tid_], lcnt[tid_]);
        __syncthreads();
        if (lane < 8) {
            const int t = blk * 64 + wid * 8 + lane;
            const int p0 = (int)lbase[e0s] + r0s, p1 = (int)lbase[e1s] + r1s;
            list[e0s * T + p0] = t; list[e1s * T + p1] = t;
            te[2 * t] = e0s; te[2 * t + 1] = e1s; tp[2 * t] = p0; tp[2 * t + 1] = p1; tw[2 * t] = w0s; tw[2 * t + 1] = 1.f - w0s;
        }
    }
    __syncthreads();
}
__device__ __forceinline__ void moe_offsets(KArgs A, int wv_, int L, LAS int* off, LAS int* cn) {
    if (opaque_tid(wv_) == 0) {
        const unsigned* cnt = (const unsigned*)(opq(A->ws) + WS_CTL) + CW_CNT + L * 64;
        int o = 0;
        for (int e = 0; e < 16; ++e) { const int c = (int)__hip_atomic_load(cnt + e, __ATOMIC_RELAXED, __HIP_MEMORY_SCOPE_AGENT); off[e] = o; cn[e] = c; o += (c + 255) & ~255; }
        off[16] = o;
    }
    __syncthreads();
}
__device__ __forceinline__ void phase_moe_combine(KArgs A, int wv_, int L, LAS unsigned char* lds) {
    LAS int* off = (LAS int*)lds; LAS int* cn = off + 32;
    moe_offsets(A, wv_, L, off, cn);
    const int tid_ = opaque_tid(wv_); const int wid = __builtin_amdgcn_readfirstlane(tid_ >> 6), lane = tid_ & 63; const int gw = blockIdx.x * 8 + wid, NGW = gridDim.x * 8;
    unsigned char* ws = opq(A->ws);
    const int* te = (const int*)(ws + WS_TOK); const int* tp = te + 2 * T; const float* tw = (const float*)(tp + 2 * T);
    const bf16* Y = (const bf16*)(ws + WS_Y); bf16* XN = (bf16*)(ws + WS_XN);
    const int nq = (T - gw + NGW - 1) / NGW;
    for (int q0 = 0; q0 < nq; q0 += 8) {
        int s0m = 0, s1m = 0; float w0m = 0.f, w1m = 0.f;
        { const int qq = q0 + (lane & 7); const int t = gw + NGW * (qq < nq ? qq : nq - 1);
          s0m = off[te[2 * t]] + tp[2 * t]; s1m = off[te[2 * t + 1]] + tp[2 * t + 1]; w0m = tw[2 * t]; w1m = tw[2 * t + 1]; }
        const int nn = nq - q0 < 8 ? nq - q0 : 8;
        f32x4 v[4], vn[4]; u32x2 ya[4], yb[4], yan[4], ybn[4];
        { const int t = gw + NGW * q0; const int sl0 = __builtin_amdgcn_readlane(s0m, 0), sl1 = __builtin_amdgcn_readlane(s1m, 0);
#pragma unroll
          for (int j = 0; j < 4; ++j) { v[j] = ((const f32x4*)(A->out + (size_t)t * D) + lane)[64 * j]; ya[j] = ((const u32x2*)(Y + (size_t)sl0 * D) + lane)[64 * j]; yb[j] = ((const u32x2*)(Y + (size_t)sl1 * D) + lane)[64 * j]; } }
#pragma unroll 1
        for (int q = 0; q < nn; ++q) {
            const int t = gw + NGW * (q0 + q);
            const int qn = q + 1 < nn ? q + 1 : q;
            { const int tn = gw + NGW * (q0 + qn); const int sl0 = __builtin_amdgcn_readlane(s0m, qn), sl1 = __builtin_amdgcn_readlane(s1m, qn);
#pragma unroll
              for (int j = 0; j < 4; ++j) { vn[j] = ((const f32x4*)(A->out + (size_t)tn * D) + lane)[64 * j]; yan[j] = ((const u32x2*)(Y + (size_t)sl0 * D) + lane)[64 * j]; ybn[j] = ((const u32x2*)(Y + (size_t)sl1 * D) + lane)[64 * j]; } }
            const float w0 = __builtin_bit_cast(float, __builtin_amdgcn_readlane(__builtin_bit_cast(int, w0m), q)), w1 = __builtin_bit_cast(float, __builtin_amdgcn_readlane(__builtin_bit_cast(int, w1m), q));
            float s = 0.f;
#pragma unroll
            for (int j = 0; j < 4; ++j) {
                v[j].x += w0 * bflo(ya[j].x) + w1 * bflo(yb[j].x); v[j].y += w0 * bfhi(ya[j].x) + w1 * bfhi(yb[j].x); v[j].z += w0 * bflo(ya[j].y) + w1 * bflo(yb[j].y); v[j].w += w0 * bfhi(ya[j].y) + w1 * bfhi(yb[j].y);
                s += (v[j].x * v[j].x + v[j].y * v[j].y) + (v[j].z * v[j].z + v[j].w * v[j].w);
            }
            const float rstd = rsqrtf(wave_sum(s) * (1.f / 1024.f) + EPS);
            f32x4* xr = (f32x4*)(A->out + (size_t)t * D) + lane; u32x2* o8 = (u32x2*)(XN + (size_t)t * D) + lane;
#pragma unroll
            for (int j = 0; j < 4; ++j) { xr[64 * j] = v[j]; u32x2 w; w.x = pk2(v[j].x * rstd, v[j].y * rstd); w.y = pk2(v[j].z * rstd, v[j].w * rstd); o8[64 * j] = w; }
#pragma unroll
            for (int j = 0; j < 4; ++j) { v[j] = vn[j]; ya[j] = yan[j]; yb[j] = ybn[j]; }
        }
    }
}

constexpr int PH_PER_EVEN = 5 + 7, PH_PER_ODD = 3 + 7;
constexpr int NPHASES = 1 + 2 * (PH_PER_EVEN + PH_PER_ODD);

__global__ void __launch_bounds__(512, 2) mk_fwd(Args Araw) {
    KArgs A0 = kargs();
    extern __shared__ __attribute__((aligned(16))) unsigned char lds_raw[];
    LAS unsigned char* lds = (LAS unsigned char*)lds_raw;
    volatile LAS unsigned* misc = (volatile LAS unsigned*)(lds + LDS_MISC);
    const int tid = threadIdx.x;
    if (tid < 16) misc[tid] = 0u;
    __syncthreads();
    const int lo = A0->ph_lo, hi = A0->ph_hi;
    const int wv_ = __builtin_amdgcn_readfirstlane(threadIdx.x >> 6);
    if (hi - lo > 1) (void)xcd_barrier_post((unsigned*)(A0->ws + WS_CTL) + CW_BAR, misc);
    int ph = 0;
    unsigned long long tacc_ = 0;
#define PH_BEGIN(k) if (ph >= lo && ph < hi) { const bool tprobe_ = (PROBE_TMASK >> (k)) & 1; unsigned long long tp0_ = 0; if (PROBE_TMASK && tprobe_) tp0_ = __builtin_amdgcn_s_memrealtime(); KArgs A = kargs(); unsigned char* ws = opq(A->ws); _Pragma("unroll 1") for (int rep_ = 0; rep_ < (((PROBE_MASK >> (k)) & 1) ? PROBE_REPS : 1); ++rep_)
#define PH_END   if (ph + 1 < hi) { XcdBarrier b_; b_.bar = (unsigned*)(opq(kargs()->ws) + WS_CTL) + CW_BAR; b_.x = xb_xcc_id(); b_.st = misc; xcd_barrier(b_, opaque_tid(wv_) == 0); } if (PROBE_TMASK && tprobe_) tacc_ += __builtin_amdgcn_s_memrealtime() - tp0_; } ++ph;
    const int G = gridDim.x, cb = blockIdx.x;

    PH_BEGIN(0) phase_prologue(A, wv_, lds); PH_END
    for (int L = 0; L < DEPTH; ++L) {
        const int i = L >> 1;
        if ((L & 1) == 0) {
            PH_BEGIN(3) {
                if (L == 0) {
                    pg8::DenseOrder S; S.init(NBATCH * NMEM, 8192, D, (const bf16*)(ws + WS_WKV), G, cb);
                    pg8::EpiBf16<0> E{(bf16*)(ws + WS_KV), 8192, 32, 0};
                    pg8::gemm_phase(lds, (const bf16*)(ws + WS_MN), D, S, E, wv_);
                }
                pg8::DenseOrder S; S.init(T, HYN, D, (const bf16*)(ws + WS_WHYB) + (size_t)i * HYN * D, G, cb);
                pg8::EpiBf16<0> E{(bf16*)(ws + WS_BIG), HYN, 12, 0};
                pg8::gemm_phase(lds, (const bf16*)(ws + WS_XN), D, S, E, wv_);
            } PH_END
            PH_BEGIN(4) { if (L == 0) { phase_knorm(A, wv_); phase_vtrans(A, wv_, lds); } phase_compress_mfma(A, wv_, i, lds); phase_nsa_prep(A, wv_, i, lds); phase_vtiles(A, wv_, lds); } PH_END
            PH_BEGIN(5) { phase_gla_a(A, wv_, i, lds); __syncthreads(); phase_nsa_attn_mfma(A, wv_, i, lds); } PH_END
            PH_BEGIN(6) phase_gla_c(A, wv_, i, lds); PH_END
            PH_BEGIN(7) {
                pg8::DenseOrder S; S.init(T, D, D, (const bf16*)(ws + WS_WHOUT) + (size_t)i * D * D, G, cb);
                pg8::EpiResAddNorm E{A->out, D, (bf16*)(ws + WS_XN), (float*)(ws + WS_ROWSQ)};
                pg8::gemm_phase(lds, (const bf16*)(ws + WS_CAT), D, S, E, wv_);
            } PH_END
        } else {
            PH_BEGIN(8) {
                pg8::DenseOrder S; S.init(T, 4096, D, (const bf16*)(ws + WS_WSGIN) + (size_t)i * 4096 * D, G, cb);
                pg8::EpiBf16<1> E{(bf16*)(ws + WS_U), 2048, 8, (size_t)(WS_V - WS_U) / 2};
                pg8::gemm_phase(lds, (const bf16*)(ws + WS_XN), D, S, E, wv_);
            } PH_END
            PH_BEGIN(9) phase_sgu_mix_mfma(A, wv_, i, lds); PH_END
            PH_BEGIN(10) {
                pg8::DenseOrder S; S.init(T, D, 2048, (const bf16*)(ws + WS_WSGOUT) + (size_t)i * D * 2048, G, cb);
                pg8::EpiResAddNorm E{A->out, D, (bf16*)(ws + WS_XN), (float*)(ws + WS_ROWSQ)};
                pg8::gemm_phase(lds, (const bf16*)(ws + WS_UM), 2048, S, E, wv_);
            } PH_END
        }
        PH_BEGIN(12) {
            pg8::DenseOrder S; S.init(T, D, D, (const bf16*)(ws + WS_WQ) + (size_t)L * D * D, G, cb);
            pg8::EpiBf16RowScale E{(bf16*)(ws + WS_QX), D, (const float*)(ws + WS_ROWSQ)};
            pg8::gemm_phase(lds, (const bf16*)(ws + WS_XN), D, S, E, wv_);
        } PH_END
        PH_BEGIN(13) phase_xattn_mfma(A, wv_, L, lds); PH_END
        PH_BEGIN(14) {
            pg8::DenseOrder S; S.init(T, D, D, (const bf16*)(ws + WS_WO) + (size_t)L * D * D, G, cb);
            pg8::EpiResAdd E{A->out, D};
            pg8::gemm_phase(lds, (const bf16*)(ws + WS_OX), D, S, E, wv_);
        } PH_END
        PH_BEGIN(15) phase_route(A, wv_, L, lds); PH_END
        PH_BEGIN(16) {
            LAS int* off = (LAS int*)(lds + pg8::STAGE_BYTES); LAS int* cn = off + 32;
            moe_offsets(A, wv_, L, off, cn);
            pg8::MoeOrder<true> S{(off[16] / 256) * 3, 3, G, cb, D, off, cn, (const int*)(ws + WS_LIST), (const char*)(ws + WS_WMIN) + (size_t)L * 16 * 768 * D * 2, (size_t)768 * D * 2};
            pg8::EpiSwiglu E{(bf16*)(ws + WS_H), DEXP};
            pg8::gemm_phase(lds, (const bf16*)(ws + WS_XN), D, S, E, wv_);
        } PH_END
        PH_BEGIN(17) {
            LAS int* off = (LAS int*)(lds + pg8::STAGE_BYTES); LAS int* cn = off + 32;
            moe_offsets(A, wv_, L, off, cn);
            pg8::MoeOrder<false> S{(off[16] / 256) * 4, 4, G, cb, DEXP, off, cn, (const int*)(ws + WS_LIST), (const char*)(ws + WS_WMOUT) + (size_t)L * 16 * D * DEXP * 2, (size_t)D * DEXP * 2};
            pg8::EpiBf16<0> E{(bf16*)(ws + WS_Y), D, 4, 0};
            pg8::gemm_phase(lds, (const bf16*)(ws + WS_H), DEXP, S, E, wv_);
        } PH_END
        PH_BEGIN(18) phase_moe_combine(A, wv_, L, lds); PH_END
    }
#undef PH_BEGIN
#undef PH_END
    if (PROBE_TMASK && blockIdx.x == 0) { const unsigned long long t0 = __builtin_amdgcn_s_memrealtime(); while (__builtin_amdgcn_s_memrealtime() - t0 < tacc_) __builtin_amdgcn_s_sleep(8); }
}

extern "C" void kernel_launch(void* const* d_in, const int* in_sizes, int n_in, void* d_out, int out_size, void* d_ws, size_t ws_size, hipStream_t stream) {
    static int grid = 0;
    if (grid == 0) {
        if (n_in != N_IN || out_size != T * D || ws_size < WS_END) { fprintf(stderr, "kernel_launch: unexpected problem (n_in %d, out %d, ws %zu)\n", n_in, out_size, ws_size); grid = -1; return; }
        int dev = 0, cus = 0, per_cu = 0;
        if (hipGetDevice(&dev) != hipSuccess || hipDeviceGetAttribute(&cus, hipDeviceAttributeMultiprocessorCount, dev) != hipSuccess) { grid = -1; return; }
        if (hipFuncSetAttribute((const void*)mk_fwd, hipFuncAttributeMaxDynamicSharedMemorySize, LDS_BYTES) != hipSuccess) { fprintf(stderr, "kernel_launch: hipFuncSetAttribute failed\n"); grid = -1; return; }
        if (hipOccupancyMaxActiveBlocksPerMultiprocessor(&per_cu, (const void*)mk_fwd, 512, LDS_BYTES) != hipSuccess || per_cu < 1) fprintf(stderr, "kernel_launch: occupancy query says %d\n", per_cu);
        (void)hipGetLastError();
        grid = cus;
    }
    if (grid < 0) return;
    (void)hipMemsetAsync((char*)d_ws + WS_CTL, 0, CTL_BYTES, stream);
    Args a{};
    for (int i = 0; i < N_IN; ++i) a.in[i] = (const float*)d_in[i];
    a.out = (float*)d_out; a.ws = (unsigned char*)d_ws;
    for (int j = 0; j < 32; ++j) a.freq[j] = (float)pow(10000.0, -(double)j / 32.0);
#if MK_ONE_LAUNCH
    a.ph_lo = 0; a.ph_hi = NPHASES;
    hipLaunchKernelGGL(mk_fwd, dim3(grid), dim3(512), LDS_BYTES, stream, a);
#else
    for (int p = 0; p < NPHASES; ++p) { a.ph_lo = p; a.ph_hi = p + 1; hipLaunchKernelGGL(mk_fwd, dim3(grid), dim3(512), LDS_BYTES, stream, a); }
#endif
}
```

```cpp
#include <hip/hip_runtime.h>
#include <stdint.h>
#include <stdio.h>
#include <math.h>

#ifndef PROBE_MASK
#define PROBE_MASK 0
#endif
#ifndef PROBE_TMASK
#define PROBE_TMASK 0
#endif
#ifndef PROBE_REPS
#define PROBE_REPS 2
#endif
#ifndef MK_ONE_LAUNCH
#define MK_ONE_LAUNCH 1
#endif

#define LAS __attribute__((address_space(3)))
typedef unsigned short bf16;
typedef short bf16x8 __attribute__((ext_vector_type(8)));
typedef float f32x4 __attribute__((ext_vector_type(4)));
typedef float f32x2 __attribute__((ext_vector_type(2)));
typedef unsigned u32x4 __attribute__((ext_vector_type(4)));
typedef unsigned u32x2 __attribute__((ext_vector_type(2)));

constexpr int T = 16384, D = 1024, NBATCH = 8, S = 2048, DEPTH = 4;
constexpr int NMEM = 256;
constexpr float EPS = 1e-6f;
constexpr int HYN = 3072, HYSRC = 2856;
constexpr int C_QA = 0, C_KC = 512, C_VC = 640, C_KS = 768, C_VS = 896, C_KW = 1024, C_VW = 1152, C_QB = 1280, C_KB = 1536, C_VB = 1792, C_RB = 2304, C_GA = 2816, C_AL = 2840;
constexpr int NCMP = 127;
constexpr int NEXP = 16, DEXP = 384;
constexpr int SLOTS = 2 * T + NEXP * 256;

enum { I_X = 0, I_MEM, I_POS, I_NMIX, I_NXAT, I_NMEM, I_NFFN, I_HYBIN, I_HYBOUT, I_QNORM, I_KNORM, I_CMPPE, I_CMPW1, I_CMPW2, I_GATEB, I_WA2, I_BA, I_ONORM,
       I_SGIN, I_LNG, I_LNB, I_SGWS, I_SGBS, I_SGOUT, I_XWQ, I_XWKV, I_XWO, I_XQN, I_XKN, I_RW, I_RB, I_MOEIN, I_MOEOUT, N_IN };

constexpr size_t MiB = 1u << 20;
constexpr size_t WS_CTL = 0, CTL_BYTES = 1 * MiB;
constexpr size_t WS_WHYB = 1 * MiB;
constexpr size_t WS_WHOUT = WS_WHYB + 12 * MiB;
constexpr size_t WS_WSGIN = WS_WHOUT + 4 * MiB;
constexpr size_t WS_WSGOUT = WS_WSGIN + 16 * MiB;
constexpr size_t WS_WQ = WS_WSGOUT + 8 * MiB;
constexpr size_t WS_WKV = WS_WQ + 8 * MiB;
constexpr size_t WS_WO = WS_WKV + 16 * MiB;
constexpr size_t WS_WMIN = WS_WO + 8 * MiB;
constexpr size_t WS_WMOUT = WS_WMIN + 96 * MiB;
constexpr size_t WS_RW = WS_WMOUT + 48 * MiB;
constexpr size_t WS_XN = WS_RW + 1 * MiB;
constexpr size_t WS_BIG = WS_XN + 32 * MiB;
constexpr size_t WS_QA = WS_BIG + 128 * MiB;
constexpr size_t WS_KS = WS_QA + 16 * MiB;
constexpr size_t WS_KW = WS_KS + 4 * MiB;
constexpr size_t WS_KC = WS_KW + 4 * MiB;
constexpr size_t WS_VC = WS_KC + 1 * MiB;
constexpr size_t WS_CAT = WS_VC + 1 * MiB;
constexpr size_t WS_QX = WS_CAT + 32 * MiB;
constexpr size_t WS_OX = WS_QX + 32 * MiB;
constexpr size_t WS_MN = WS_OX + 32 * MiB;
constexpr size_t WS_KV = WS_MN + 4 * MiB;
constexpr size_t WS_COS = WS_KV + 32 * MiB;
constexpr size_t WS_SIN = WS_COS + 2 * MiB;
constexpr size_t WS_LIST = WS_SIN + 2 * MiB;
constexpr size_t WS_TOK = WS_LIST + 1 * MiB;
constexpr size_t WS_VT = WS_TOK + 1 * MiB;
constexpr size_t WS_VTA = WS_VT + 16 * MiB;
constexpr size_t WS_SLOC = WS_VTA + 32 * MiB;
constexpr size_t WS_DEC = WS_SLOC + 32 * MiB;
constexpr size_t WS_STT = WS_DEC + 1 * MiB;
constexpr size_t WS_WSB = WS_STT + 16 * MiB;
constexpr size_t WS_M0 = WS_WSB + 768 * 1024;
constexpr size_t WS_W1T = WS_WSB + 1 * MiB;
constexpr size_t WS_ROWSQ = WS_W1T + 1 * MiB;
constexpr size_t WS_END = WS_ROWSQ + 1 * MiB;
constexpr size_t WS_Y = WS_BIG, WS_H = WS_BIG + 72 * MiB, WS_U = WS_BIG, WS_V = WS_BIG + 64 * MiB, WS_UM = WS_QX;
constexpr int CW_BAR = 4096;
constexpr int CW_CNT = 8192;

constexpr int LDS_BYTES = 159744;
constexpr int LDS_MISC = LDS_BYTES - 64;

__device__ __forceinline__ unsigned pk2(float lo, float hi) { unsigned r; asm volatile("v_cvt_pk_bf16_f32 %0, %1, %2" : "=v"(r) : "v"(lo), "v"(hi)); return r; }
__device__ __forceinline__ unsigned f2bf(float f) { unsigned u = __float_as_uint(f); return (u + 0x7fffu + ((u >> 16) & 1u)) >> 16; }
__device__ __forceinline__ float bf2f(unsigned b) { return __uint_as_float(b << 16); }
__device__ __forceinline__ float bflo(unsigned w) { return __uint_as_float(w << 16); }
__device__ __forceinline__ float bfhi(unsigned w) { return __uint_as_float(w & 0xffff0000u); }
__device__ __forceinline__ float wave_sum(float v) {
#pragma unroll
    for (int o = 1; o < 64; o <<= 1) v += __shfl_xor(v, o);
    return v;
}
__device__ __forceinline__ float wave_max(float v) {
#pragma unroll
    for (int o = 1; o < 64; o <<= 1) v = fmaxf(v, __shfl_xor(v, o));
    return v;
}
__device__ __forceinline__ int opaque_tid(int wv) { int l; asm volatile("v_mbcnt_lo_u32_b32 %0, -1, 0\n\tv_mbcnt_hi_u32_b32 %0, -1, %0" : "=v"(l)); return wv * 64 + l; }
__device__ __forceinline__ unsigned char* opq(unsigned char* p) { asm volatile("" : "+s"(p)); return p; }
#define LDS_WAIT() asm volatile("s_waitcnt lgkmcnt(0)" ::: "memory")
__device__ __forceinline__ float gelu_tanh(float x) {
    const float u2 = x * (1.5957691216057308f + 0.07135481283f * x * x);
    return x * __builtin_amdgcn_rcpf(1.0f + __expf(-u2));
}
__device__ __forceinline__ float sigmoidf_(float x) { return 1.0f / (1.0f + __expf(-x)); }

#define XB_TMO      128
#define XB_XCNT(j)  (256  + 64 * (j))
#define XB_XSUB(j)  (1280 + 64 * (j))
#define XB_XGEN(j)  (2304 + 64 * (j))
#define XB_TOP      3328
#define XB_TOPGEN   3392
#define XCD_BAR_WORDS 3456
#define XB_SPIN_CAP (1u << 22)

__device__ __forceinline__ unsigned xb_ld(unsigned* p)              { return __hip_atomic_load(p, __ATOMIC_RELAXED, __HIP_MEMORY_SCOPE_AGENT); }
__device__ __forceinline__ unsigned xb_add(unsigned* p, unsigned v) { return __hip_atomic_fetch_add(p, v, __ATOMIC_RELAXED, __HIP_MEMORY_SCOPE_AGENT); }
__device__ __forceinline__ unsigned xb_xcc_id() { return (unsigned)__builtin_amdgcn_s_getreg((3 << 11) | 20) & 0xFu; }
#define XB_SPIN(cond, bar) do { unsigned _sp = 0; while (cond) { __builtin_amdgcn_s_sleep(1); \
    if ((++_sp & 255u) == 0u) { if (xb_ld(&(bar)[XB_TMO])) break; if (_sp > XB_SPIN_CAP) { atomicAdd(&(bar)[XB_TMO], 1u); break; } } } } while (0)

struct XcdBarrier { unsigned* bar; unsigned x; volatile LAS unsigned* st; };
__device__ __forceinline__ unsigned* xb_opaque(unsigned* p) { unsigned long long v = (unsigned long long)p; unsigned lo = __builtin_amdgcn_readfirstlane((unsigned)v), hi = __builtin_amdgcn_readfirstlane((unsigned)(v >> 32));
    asm volatile("" : "+s"(lo), "+s"(hi)); return (unsigned*)(((unsigned long long)hi << 32) | lo); }

__device__ __forceinline__ XcdBarrier xcd_barrier_post(unsigned* bar, volatile LAS unsigned* st) {
    XcdBarrier b; b.bar = bar; b.x = xb_xcc_id(); b.st = st;
    if (threadIdx.x == 0) (void)xb_add(&bar[XB_XCNT(b.x)], 1u);
    return b;
}
__device__ __forceinline__ void xcd_barrier_complete(unsigned* bar, unsigned x, unsigned& nloc, unsigned& nx) {
    const unsigned G = gridDim.x * gridDim.y * gridDim.z;
    unsigned sum, cnt, mine, sp = 0u;
    for (;;) {
        sum = 0u; cnt = 0u; mine = 0u;
#pragma unroll
        for (unsigned j = 0; j < 16; ++j) { const unsigned c = xb_ld(&bar[XB_XCNT(j)]); sum += c; cnt += (c > 0u) ? 1u : 0u; mine = (j == x) ? c : mine; }
        if (sum == G) break;
        __builtin_amdgcn_s_sleep(1);
        if ((++sp & 255u) == 0u) { if (xb_ld(&bar[XB_TMO])) break; if (sp > XB_SPIN_CAP) { atomicAdd(&bar[XB_TMO], 1u); break; } }
    }
    nloc = mine > 0u ? mine : 1u; nx = cnt > 0u ? cnt : 1u;
}
__device__ __forceinline__ void xcd_barrier(const XcdBarrier& b, const bool is_t0) {
    asm volatile("s_waitcnt vmcnt(0)" ::: "memory");
    __syncthreads();
    if (is_t0) {
        unsigned* bar = b.bar;
        __builtin_amdgcn_s_waitcnt(0);
        unsigned nloc = b.st[0], nx = b.st[1];
        if (nloc == 0u) { xcd_barrier_complete(bar, b.x, nloc, nx); b.st[0] = nloc; b.st[1] = nx; }
        const unsigned old = xb_add(&bar[XB_XSUB(b.x)], 1u);
        const unsigned gen = old / nloc;
        if (old + 1u == (gen + 1u) * nloc) {
            __builtin_amdgcn_fence(__ATOMIC_RELEASE, "agent");
            asm volatile("s_waitcnt vmcnt(0)" ::: "memory");
            const unsigned og = xb_add(&bar[XB_TOP], 1u);
            const unsigned tg = og / nx;
            if (og + 1u == (tg + 1u) * nx) xb_add(&bar[XB_TOPGEN], 1u);
            else XB_SPIN(xb_ld(&bar[XB_TOPGEN]) == tg, bar);
            __builtin_amdgcn_fence(__ATOMIC_ACQUIRE, "agent");
            xb_add(&bar[XB_XGEN(b.x)], 1u);
            asm volatile("s_waitcnt vmcnt(0)" ::: "memory");
        } else {
            XB_SPIN(xb_ld(&bar[XB_XGEN(b.x)]) == gen, bar);
            __builtin_amdgcn_fence(__ATOMIC_ACQUIRE, "agent");
            asm volatile("s_waitcnt vmcnt(0)" ::: "memory");
        }
    }
    __syncthreads();
}

struct Args {
    const float* in[N_IN];
    float* out;
    unsigned char* ws;
    float freq[32];
    int ph_lo, ph_hi;
};

typedef const __attribute__((address_space(4))) Args* KArgs;
__device__ __forceinline__ KArgs kargs() { KArgs p = (KArgs)__builtin_amdgcn_kernarg_segment_ptr(); asm volatile("" : "+s"(p)); return p; }

__device__ __forceinline__ void st_bf16x4(bf16* p, f32x4 v) { u32x2 w; w.x = pk2(v[0], v[1]); w.y = pk2(v[2], v[3]); *(u32x2*)p = w; }


namespace pg8 {
constexpr int BM = 256, BK = 64, HALF = 128, HTB = HALF * BK * 2, STAGE_BYTES = 8 * HTB, NXCD = 8, WGM = 8;
__host__ __device__ __forceinline__ int lds_byte(int r, int c) { const int st = (r >> 4) * 2 + (c >> 5), rr = r & 15, cc = c & 31, ob = rr * 64 + cc * 2; return st * 1024 + (ob ^ (((ob >> 9) & 1) << 5)); }
__host__ __device__ __forceinline__ void stage_rc(int b, int& R, int& C) { const int st = b / 1024, sb = b % 1024, swz = sb ^ (((sb >> 9) & 1) << 5); R = (st >> 1) * 16 + swz / 64; C = (st & 1) * 32 + (swz % 64) / 2; }
__host__ __device__ __forceinline__ int perm32(int rho) { const int n = rho >> 4, i = rho & 15; return 8 * (i >> 2) + 4 * n + (i & 3); }
struct Unit { int pm, pn, e; };
struct DenseOrder {
    static constexpr bool GATHER = false;
    int nM, nN, nwg, G, c, K; const char* Bt;
    __device__ __forceinline__ void init(int M, int N, int K_, const bf16* Bt_, int G_, int c_) { nM = M / BM; nN = N / BM; nwg = nM * nN; G = G_; c = c_; K = K_; Bt = (const char*)Bt_; }
    __device__ __forceinline__ bool next(int i, Unit& u) const {
        const long L = (long)i * G + c; if (L >= nwg) return false;
        int wgid = (int)L; { const int q = nwg / NXCD, r = nwg % NXCD, xcd = wgid % NXCD, off = wgid / NXCD; wgid = (xcd < r ? xcd * (q + 1) : r * (q + 1) + (xcd - r) * q) + off; }
        const int nig = WGM * nN, gid = wgid / nig, fm = gid * WGM, gsz = (nM - fm) < WGM ? (nM - fm) : WGM;
        u.pm = fm + ((wgid % nig) % gsz); u.pn = (wgid % nig) / gsz; u.e = 0; return true;
    }
    __device__ __forceinline__ unsigned a_voff(const Unit& u, int half, int R) const { return (unsigned)((u.pm * BM + half * HALF + R) * K) * 2u; }
    __device__ __forceinline__ const char* b_tile(const Unit& u) const { return Bt + (size_t)u.pn * BM * K * 2; }
};
template <bool GATH> struct MoeOrder {
    static constexpr bool GATHER = GATH;
    int nunits, ntn, G, c, K; const LAS int* off; const LAS int* cn; const int* list; const char* Bt; size_t estride;
    __device__ __forceinline__ bool next(int i, Unit& u) const {
        const int L = i * G + c; if (L >= nunits) return false;
        u.pm = L / ntn; u.pn = L % ntn; const int s0 = u.pm * BM; int e = 0;
#pragma unroll
        for (int q = 1; q < 16; ++q) e += (s0 >= off[q]) ? 1 : 0;
        u.e = e; return true;
    }
    __device__ __forceinline__ unsigned a_voff(const Unit& u, int half, int R) const {
        const int slot = u.pm * BM + half * HALF + R;
        const int loc = slot - off[u.e]; const int tk = list[u.e * T + (loc < cn[u.e] ? loc : 0)];
        return (unsigned)(tk * K) * 2u;
    }
    __device__ __forceinline__ const char* b_tile(const Unit& u) const { return Bt + (size_t)u.e * estride + (size_t)u.pn * BM * K * 2; }
};
__device__ __forceinline__ unsigned cvt_pk_bf16(float lo, float hi) { unsigned r; asm volatile("v_cvt_pk_bf16_f32 %0, %1, %2" : "=v"(r) : "v"(lo), "v"(hi)); return r; }

template <class Epi, class Sched>
__device__ __forceinline__ void gemm_phase(LAS unsigned char* lds, const bf16* Aptr, int K, const Sched& S, const Epi& E, int wv_) {
    const int tid = opaque_tid(wv_), wid = __builtin_amdgcn_readfirstlane(tid >> 6), lane = tid & 63, wr = wid >> 2, wc = wid & 3, fr = lane & 15, fq = lane >> 4;
    const int nt = K / BK;
    int Rr[2], Cc[2]; unsigned voffA[2], voffB[2];
#pragma unroll
    for (int i = 0; i < 2; ++i) { stage_rc(tid * 16 + i * 8192, Rr[i], Cc[i]); const int Rb = Epi::PERM ? ((Rr[i] & ~31) + perm32(Rr[i] & 31)) : Rr[i];
        voffA[i] = (unsigned)(Rr[i] * K + Cc[i]) * 2u; voffB[i] = (unsigned)(Rb * K + Cc[i]) * 2u; }
    const size_t kstep = (size_t)(BK * 2);
    const size_t hstep = (size_t)HALF * K * 2;
    const size_t tstep = 2 * hstep;
    const unsigned ldsw = (unsigned)wid * 1024u;
    const int aoff = lds_byte(wr * 64 + fr, fq * 8), boff = lds_byte(wc * 32 + fr, fq * 8);
    const char* const Ab = (const char*)Aptr;
#define PG8_SA(b, h) (((b) * 2 + (h)) * HTB)
#define PG8_SB(b, h) ((4 + (b) * 2 + (h)) * HTB)
#define PG8_STAGE(bufoff, gbase, voff) do { _Pragma("unroll") for (int _i = 0; _i < 2; ++_i) \
        __builtin_amdgcn_global_load_lds((const unsigned*)((const char*)(gbase) + (voff)[_i]), (LAS unsigned*)(lds + (bufoff) + ldsw + _i * 8192), 16, 0, 0); } while (0)
#define PG8_STAGE_A(bufoff, usenext, h, kofs) do { \
        if constexpr (Sched::GATHER) { const char* gb_ = Ab + (kofs); unsigned vv_[2] = {(usenext) ? vN[h][0] : vA[h][0], (usenext) ? vN[h][1] : vA[h][1]}; PG8_STAGE(bufoff, gb_, vv_); } \
        else { const char* gb_ = ((usenext) ? nA : cA) + (size_t)(h) * hstep + (kofs); PG8_STAGE(bufoff, gb_, voffA); } } while (0)
#define PG8_LDA(dst, b, h) do { _Pragma("unroll") for (int m = 0; m < 4; ++m) _Pragma("unroll") for (int k = 0; k < 2; ++k) dst[m][k] = *(const LAS bf16x8*)(lds + PG8_SA(b, h) + aoff + m * 2048 + k * 1024); } while (0)
#define PG8_LDB(dst, b, h) do { _Pragma("unroll") for (int n = 0; n < 2; ++n) _Pragma("unroll") for (int k = 0; k < 2; ++k) dst[n][k] = *(const LAS bf16x8*)(lds + PG8_SB(b, h) + boff + n * 2048 + k * 1024); } while (0)
#define PG8_MMA(ai, bj, At, Bt) do { __builtin_amdgcn_s_setprio(1); _Pragma("unroll") for (int m = 0; m < 4; ++m) _Pragma("unroll") for (int n = 0; n < 2; ++n) _Pragma("unroll") for (int k = 0; k < 2; ++k) \
        acc[ai][bj][m][n] = __builtin_amdgcn_mfma_f32_16x16x32_bf16(Bt[n][k], At[m][k], acc[ai][bj][m][n], 0, 0, 0); __builtin_amdgcn_s_setprio(0); } while (0)
#define PG8_WAIT_V(n) asm volatile("s_waitcnt vmcnt(" #n ")" ::: "memory")
#define PG8_WAIT_L(n) asm volatile("s_waitcnt lgkmcnt(" #n ")" ::: "memory")
#define PG8_BAR __builtin_amdgcn_s_barrier()
#define PG8_SCHED __builtin_amdgcn_sched_barrier(0)
    Unit cur, nxt; int ui = 0;
    if (!S.next(0, cur)) return;
    f32x4 acc[2][2][4][2];
#pragma unroll
    for (int a = 0; a < 2; ++a)
#pragma unroll
        for (int b = 0; b < 2; ++b)
#pragma unroll
            for (int m = 0; m < 4; ++m)
#pragma unroll
                for (int n = 0; n < 2; ++n) acc[a][b][m][n] = (f32x4){0.f, 0.f, 0.f, 0.f};
    bf16x8 At[4][2], B0[2][2], B1[2][2];
    unsigned vA[2][2], vN[2][2];
    const char* cA = Ab; const char* nA = Ab;
    if constexpr (Sched::GATHER) {
#pragma unroll
        for (int h = 0; h < 2; ++h)
#pragma unroll
            for (int i = 0; i < 2; ++i) { vA[h][i] = S.a_voff(cur, h, Rr[i]) + (unsigned)Cc[i] * 2u; vN[h][i] = vA[h][i]; }
    } else { cA = Ab + (size_t)cur.pm * tstep; nA = cA; }
    const char* cB = S.b_tile(cur);
    PG8_STAGE(PG8_SB(0, 0), cB, voffB); PG8_STAGE_A(PG8_SA(0, 0), false, 0, 0); PG8_STAGE(PG8_SB(0, 1), cB + hstep, voffB); PG8_STAGE_A(PG8_SA(0, 1), false, 1, 0);
    if (wr == 1) PG8_BAR;
    PG8_WAIT_V(4); PG8_BAR;
    PG8_STAGE(PG8_SB(1, 0), cB + kstep, voffB); PG8_STAGE_A(PG8_SA(1, 0), false, 0, kstep); PG8_STAGE(PG8_SB(1, 1), cB + hstep + kstep, voffB);
    PG8_WAIT_V(6); PG8_BAR;
    for (;;) {
        const bool has_next = S.next(ui + 1, nxt);
        const char* nB = has_next ? S.b_tile(nxt) : cB;
        if constexpr (Sched::GATHER) {
#pragma unroll
            for (int h = 0; h < 2; ++h)
#pragma unroll
                for (int i = 0; i < 2; ++i) vN[h][i] = has_next ? S.a_voff(nxt, h, Rr[i]) + (unsigned)Cc[i] * 2u : vA[h][i];
        } else nA = has_next ? Ab + (size_t)nxt.pm * tstep : cA;
        for (int t = 0; t < nt; t += 2) {
            const bool last = (t == nt - 2);
            const size_t k1 = (size_t)(t + 1) * kstep, k2 = last ? 0 : (size_t)(t + 2) * kstep, k3 = k2 + kstep;
            const char* b2 = last ? nB : cB + (size_t)(t + 2) * kstep; const char* b3 = b2 + kstep;
            PG8_LDB(B0, 0, 0); PG8_SCHED; PG8_LDA(At, 0, 0); PG8_STAGE_A(PG8_SA(1, 1), false, 1, k1);
            PG8_WAIT_L(8); PG8_BAR; PG8_WAIT_L(0); PG8_MMA(0, 0, At, B0); PG8_BAR; PG8_SCHED;
            PG8_LDB(B1, 0, 1); PG8_STAGE(PG8_SB(0, 0), b2, voffB);
            PG8_BAR; PG8_WAIT_L(0); PG8_MMA(0, 1, At, B1); PG8_BAR;
            PG8_LDA(At, 0, 1); PG8_STAGE_A(PG8_SA(0, 0), last, 0, k2);
            PG8_BAR; PG8_WAIT_L(0); PG8_MMA(1, 0, At, B0); PG8_BAR; PG8_SCHED;
            PG8_STAGE(PG8_SB(0, 1), b2 + hstep, voffB);
            PG8_WAIT_V(6); PG8_BAR; PG8_MMA(1, 1, At, B1); PG8_BAR;
            PG8_LDB(B0, 1, 0); PG8_SCHED; PG8_LDA(At, 1, 0); PG8_STAGE_A(PG8_SA(0, 1), last, 1, k2);
            PG8_WAIT_L(8); PG8_BAR; PG8_WAIT_L(0); PG8_MMA(0, 0, At, B0); PG8_BAR; PG8_SCHED;
            PG8_LDB(B1, 1, 1); PG8_STAGE(PG8_SB(1, 0), b3, voffB);
            PG8_BAR; PG8_WAIT_L(0); PG8_MMA(0, 1, At, B1); PG8_BAR;
            PG8_LDA(At, 1, 1); PG8_STAGE_A(PG8_SA(1, 0), last, 0, k3);
            PG8_BAR; PG8_WAIT_L(0); PG8_MMA(1, 0, At, B0); PG8_BAR; PG8_SCHED;
            PG8_STAGE(PG8_SB(1, 1), b3 + hstep, voffB);
            PG8_WAIT_V(6); PG8_BAR; PG8_MMA(1, 1, At, B1); PG8_BAR;
        }
        E(acc, cur, wr, wc, fr, fq);
        if (!has_next) break;
#pragma unroll
        for (int a = 0; a < 2; ++a)
#pragma unroll
            for (int b = 0; b < 2; ++b)
#pragma unroll
                for (int m = 0; m < 4; ++m)
#pragma unroll
                    for (int n = 0; n < 2; ++n) acc[a][b][m][n] = (f32x4){0.f, 0.f, 0.f, 0.f};
        cur = nxt; cB = nB; cA = nA; ++ui;
        if constexpr (Sched::GATHER) {
#pragma unroll
            for (int h = 0; h < 2; ++h)
#pragma unroll
                for (int i = 0; i < 2; ++i) vA[h][i] = vN[h][i];
        }
    }
    PG8_WAIT_V(0);
    if (wr == 0) PG8_BAR;
    PG8_BAR;
#undef PG8_SA
#undef PG8_SB
#undef PG8_STAGE
#undef PG8_STAGE_A
#undef PG8_LDA
#undef PG8_LDB
#undef PG8_MMA
#undef PG8_WAIT_V
#undef PG8_WAIT_L
#undef PG8_BAR
#undef PG8_SCHED
}
template <int ACT> struct EpiBf16 {
    static constexpr bool PERM = true;
    bf16* O; int ldc; int tpt; size_t tstride;
    __device__ __forceinline__ void operator()(const f32x4 (&acc)[2][2][4][2], const Unit& u, int wr, int wc, int fr, int fq) const {
        const int row0 = u.pm * BM + wr * 64 + fr; const int tt = u.pn / tpt; bf16* base = O + (size_t)tt * tstride; const int col0 = (u.pn - tt * tpt) * BM + wc * 32 + 8 * fq;
#pragma unroll
        for (int ai = 0; ai < 2; ++ai)
#pragma unroll
            for (int m = 0; m < 4; ++m) { bf16* rowp = base + (size_t)(row0 + ai * HALF + m * 16) * ldc + col0;
#pragma unroll
                for (int bj = 0; bj < 2; ++bj) { f32x4 v0 = acc[ai][bj][m][0], v1 = acc[ai][bj][m][1];
                    if (ACT == 1) {
#pragma unroll
                        for (int q = 0; q < 4; ++q) { v0[q] = gelu_tanh(v0[q]); v1[q] = gelu_tanh(v1[q]); } }
                    u32x4 w; w.x = cvt_pk_bf16(v0[0], v0[1]); w.y = cvt_pk_bf16(v0[2], v0[3]); w.z = cvt_pk_bf16(v1[0], v1[1]); w.w = cvt_pk_bf16(v1[2], v1[3]);
                    *(u32x4*)(rowp + bj * HALF) = w; } }
    }
};
struct EpiResAdd {
    static constexpr bool PERM = false;
    float* X; int ldc;
    __device__ __forceinline__ void operator()(const f32x4 (&acc)[2][2][4][2], const Unit& u, int wr, int wc, int fr, int fq) const {
        const int row0 = u.pm * BM + wr * 64 + fr, col0 = u.pn * BM + wc * 32 + 4 * fq;
#pragma unroll
        for (int ai = 0; ai < 2; ++ai)
#pragma unroll
            for (int m2 = 0; m2 < 4; m2 += 2) {
                f32x4 x[2][2][2];
#pragma unroll
                for (int mm = 0; mm < 2; ++mm)
#pragma unroll
                    for (int bj = 0; bj < 2; ++bj)
#pragma unroll
                        for (int n = 0; n < 2; ++n) x[mm][bj][n] = *(const f32x4*)(X + (size_t)(row0 + ai * HALF + (m2 + mm) * 16) * ldc + col0 + bj * HALF + n * 16);
#pragma unroll
                for (int mm = 0; mm < 2; ++mm)
#pragma unroll
                    for (int bj = 0; bj < 2; ++bj)
#pragma unroll
                        for (int n = 0; n < 2; ++n) *(f32x4*)(X + (size_t)(row0 + ai * HALF + (m2 + mm) * 16) * ldc + col0 + bj * HALF + n * 16) = x[mm][bj][n] + acc[ai][bj][m2 + mm][n];
            }
    }
};
struct EpiResAddNorm {
    static constexpr bool PERM = false;
    float* X; int ldc; bf16* XB; float* rowsq;
    __device__ __forceinline__ void operator()(const f32x4 (&acc)[2][2][4][2], const Unit& u, int wr, int wc, int fr, int fq) const {
        const int row0 = u.pm * BM + wr * 64 + fr, col0 = u.pn * BM + wc * 32 + 4 * fq;
#pragma unroll
        for (int ai = 0; ai < 2; ++ai)
#pragma unroll
            for (int m2 = 0; m2 < 4; m2 += 2) {
                f32x4 x[2][2][2];
#pragma unroll
                for (int mm = 0; mm < 2; ++mm)
#pragma unroll
                    for (int bj = 0; bj < 2; ++bj)
#pragma unroll
                        for (int n = 0; n < 2; ++n) x[mm][bj][n] = *(const f32x4*)(X + (size_t)(row0 + ai * HALF + (m2 + mm) * 16) * ldc + col0 + bj * HALF + n * 16);
#pragma unroll
                for (int mm = 0; mm < 2; ++mm) {
                    const size_t ro = (size_t)(row0 + ai * HALF + (m2 + mm) * 16) * ldc + col0; float ssq = 0.f;
#pragma unroll
                    for (int bj = 0; bj < 2; ++bj)
#pragma unroll
                        for (int n = 0; n < 2; ++n) { const f32x4 v = x[mm][bj][n] + acc[ai][bj][m2 + mm][n];
                            *(f32x4*)(X + ro + bj * HALF + n * 16) = v;
                            u32x2 w; w.x = cvt_pk_bf16(v.x, v.y); w.y = cvt_pk_bf16(v.z, v.w); *(u32x2*)(XB + ro + bj * HALF + n * 16) = w;
                            ssq += (v.x * v.x + v.y * v.y) + (v.z * v.z + v.w * v.w); }
                    ssq += __shfl_xor(ssq, 16); ssq += __shfl_xor(ssq, 32);
                    if (fq == 0) rowsq[(size_t)(row0 + ai * HALF + (m2 + mm) * 16) * 16 + u.pn * 4 + wc] = ssq;
                }
            }
    }
};
struct EpiBf16RowScale {
    static constexpr bool PERM = true;
    bf16* O; int ldc; const float* rowsq;
    __device__ __forceinline__ void operator()(const f32x4 (&acc)[2][2][4][2], const Unit& u, int wr, int wc, int fr, int fq) const {
        const int row0 = u.pm * BM + wr * 64 + fr, col0 = u.pn * BM + wc * 32 + 8 * fq;
#pragma unroll
        for (int ai = 0; ai < 2; ++ai) {
            float rs[4];
#pragma unroll
            for (int m = 0; m < 4; ++m) { const f32x4* p = (const f32x4*)(rowsq + (size_t)(row0 + ai * HALF + m * 16) * 16); const f32x4 a = p[0], b = p[1], c = p[2], d = p[3];
                rs[m] = rsqrtf((((a.x + a.y) + (a.z + a.w)) + ((b.x + b.y) + (b.z + b.w)) + (((c.x + c.y) + (c.z + c.w)) + ((d.x + d.y) + (d.z + d.w)))) * (1.f / 1024.f) + EPS); }
#pragma unroll
            for (int m = 0; m < 4; ++m) { bf16* rowp = O + (size_t)(row0 + ai * HALF + m * 16) * ldc + col0;
#pragma unroll
                for (int bj = 0; bj < 2; ++bj) { const f32x4 v0 = acc[ai][bj][m][0] * rs[m], v1 = acc[ai][bj][m][1] * rs[m];
                    u32x4 w; w.x = cvt_pk_bf16(v0[0], v0[1]); w.y = cvt_pk_bf16(v0[2], v0[3]); w.z = cvt_pk_bf16(v1[0], v1[1]); w.w = cvt_pk_bf16(v1[2], v1[3]);
                    *(u32x4*)(rowp + bj * HALF) = w; } }
        }
    }
};
struct EpiSwiglu {
    static constexpr bool PERM = true;
    bf16* H; int ldc;
    __device__ __forceinline__ void operator()(const f32x4 (&acc)[2][2][4][2], const Unit& u, int wr, int wc, int fr, int fq) const {
        const int row0 = u.pm * BM + wr * 64 + fr, col0 = u.pn * HALF + wc * 32 + 8 * fq;
#pragma unroll
        for (int ai = 0; ai < 2; ++ai)
#pragma unroll
            for (int m = 0; m < 4; ++m) {
                float o[8];
#pragma unroll
                for (int n = 0; n < 2; ++n)
#pragma unroll
                    for (int q = 0; q < 4; ++q) { const float g = acc[ai][0][m][n][q]; o[4 * n + q] = g * sigmoidf_(g) * acc[ai][1][m][n][q]; }
                u32x4 w; w.x = cvt_pk_bf16(o[0], o[1]); w.y = cvt_pk_bf16(o[2], o[3]); w.z = cvt_pk_bf16(o[4], o[5]); w.w = cvt_pk_bf16(o[6], o[7]);
                *(u32x4*)(H + (size_t)(row0 + ai * HALF + m * 16) * ldc + col0) = w; }
    }
};
}

__device__ __forceinline__ int hyb_colmap(int n) {
    if (n < 1280) return n;
    if (n < 1536) return 1304 + (n - 1280);
    if (n < 1792) return 1560 + (n - 1536);
    if (n < 2304) return 1816 + (n - 1792);
    if (n < 2816) return 2344 + (n - 2304);
    if (n < 2840) return 1280 + (n - 2816);
    if (n < 2856) return 2328 + (n - 2840);
    return -1;
}
__device__ __forceinline__ void tr_item(const float* __restrict__ W, int Nsrc, int K, bf16* __restrict__ Wt, const float* __restrict__ gain, int kind, int nblk, LAS float* scr, int item, int lane) {
    const int kb = item / nblk, nb = item % nblk, k0 = 64 * kb, n0 = 64 * nb;
    const int ksub = lane >> 4, n4 = lane & 15, n = n0 + 4 * n4;
    int col;
    if (kind == 0) col = n; else if (kind == 1) col = hyb_colmap(n); else { const int pn = n >> 8, r = n & 255; col = (r >> 7) * 384 + pn * 128 + (r & 127); }
    f32x4 v[16];
#pragma unroll
    for (int i = 0; i < 16; ++i) v[i] = col >= 0 ? *(const f32x4*)(W + (size_t)(k0 + 4 * i + ksub) * Nsrc + col) : (f32x4){0.f, 0.f, 0.f, 0.f};
    if (gain) {
#pragma unroll
        for (int i = 0; i < 16; ++i) v[i] = v[i] * gain[k0 + 4 * i + ksub];
    }
#pragma unroll
    for (int i = 0; i < 16; ++i) { LAS float* d = scr + (4 * i + ksub) * 65 + 4 * n4; d[0] = v[i].x; d[1] = v[i].y; d[2] = v[i].z; d[3] = v[i].w; }
    LDS_WAIT();
    const int c = lane & 7;
#pragma unroll
    for (int jx = 0; jx < 8; ++jx) {
        const int nn = (lane >> 3) + 8 * jx; const LAS float* s = scr + (8 * c) * 65 + nn;
        u32x4 o; o.x = pk2(s[0 * 65], s[1 * 65]); o.y = pk2(s[2 * 65], s[3 * 65]); o.z = pk2(s[4 * 65], s[5 * 65]); o.w = pk2(s[6 * 65], s[7 * 65]);
        *(u32x4*)(Wt + (size_t)(n0 + nn) * K + k0 + 8 * c) = o;
    }
    LDS_WAIT();
}
__device__ __forceinline__ void rms_row_to_bf16(const float* __restrict__ xrow, bf16* __restrict__ orow, float* __restrict__ copy, int lane) {
    const f32x4* xr = (const f32x4*)xrow + lane;
    f32x4 v[4]; float s = 0.f;
#pragma unroll
    for (int j = 0; j < 4; ++j) { v[j] = xr[64 * j]; s += (v[j].x * v[j].x + v[j].y * v[j].y) + (v[j].z * v[j].z + v[j].w * v[j].w); }
    const float rstd = rsqrtf(wave_sum(s) * (1.f / 1024.f) + EPS);
    u32x2* o8 = (u32x2*)orow + lane;
#pragma unroll
    for (int j = 0; j < 4; ++j) { u32x2 w; w.x = pk2(v[j].x * rstd, v[j].y * rstd); w.y = pk2(v[j].z * rstd, v[j].w * rstd); o8[64 * j] = w; }
    if (copy) { f32x4* c4 = (f32x4*)copy + lane;
#pragma unroll
        for (int j = 0; j < 4; ++j) c4[64 * j] = v[j]; }
}

__device__ __forceinline__ void phase_prologue(KArgs A, int wv_, LAS unsigned char* lds) {
    const int tid = opaque_tid(wv_), wid = __builtin_amdgcn_readfirstlane(tid >> 6), lane = tid & 63;
    const int gw = blockIdx.x * 8 + wid, NGW = gridDim.x * 8;
    LAS float* scr = (LAS float*)(lds + wid * 16640);
    unsigned char* ws = opq(A->ws);
    constexpr int N_HYB = 2 * 768, N_HOUT = 2 * 256, N_SGIN = 2 * 1024, N_SGOUT = 2 * 512, N_WQ = 4 * 256, N_WKV = 4 * 512, N_WO = 4 * 256, N_MIN = 64 * 192, N_MOUT = 64 * 96, N_W1T = 4 * 32;
    constexpr int NITEMS = N_HYB + N_HOUT + N_SGIN + N_SGOUT + N_WQ + N_WKV + N_WO + N_MIN + N_MOUT + N_W1T;
    for (int it = gw; it < NITEMS; it += NGW) {
        int r = it;
        if (r < N_HYB) { const int sl = r / 768; tr_item(A->in[I_HYBIN] + (size_t)sl * 1024 * HYSRC, HYSRC, 1024, (bf16*)(ws + WS_WHYB) + (size_t)sl * HYN * 1024, A->in[I_NMIX] + (2 * sl) * 1024, 1, 48, scr, r % 768, lane); continue; } r -= N_HYB;
        if (r < N_HOUT) { const int sl = r / 256; tr_item(A->in[I_HYBOUT] + (size_t)sl * 1024 * 1024, 1024, 1024, (bf16*)(ws + WS_WHOUT) + (size_t)sl * 1024 * 1024, nullptr, 0, 16, scr, r % 256, lane); continue; } r -= N_HOUT;
        if (r < N_SGIN) { const int sl = r / 1024; tr_item(A->in[I_SGIN] + (size_t)sl * 1024 * 4096, 4096, 1024, (bf16*)(ws + WS_WSGIN) + (size_t)sl * 4096 * 1024, A->in[I_NMIX] + (2 * sl + 1) * 1024, 0, 64, scr, r % 1024, lane); continue; } r -= N_SGIN;
        if (r < N_SGOUT) { const int sl = r / 512; tr_item(A->in[I_SGOUT] + (size_t)sl * 2048 * 1024, 1024, 2048, (bf16*)(ws + WS_WSGOUT) + (size_t)sl * 1024 * 2048, nullptr, 0, 16, scr, r % 512, lane); continue; } r -= N_SGOUT;
        if (r < N_WQ) { const int sl = r / 256; tr_item(A->in[I_XWQ] + (size_t)sl * 1024 * 1024, 1024, 1024, (bf16*)(ws + WS_WQ) + (size_t)sl * 1024 * 1024, A->in[I_NXAT] + sl * 1024, 0, 16, scr, r % 256, lane); continue; } r -= N_WQ;
        if (r < N_WKV) { const int sl = r / 512; tr_item(A->in[I_XWKV] + (size_t)sl * 1024 * 2048, 2048, 1024, (bf16*)(ws + WS_WKV) + (size_t)sl * 2048 * 1024, A->in[I_NMEM] + sl * 1024, 0, 32, scr, r % 512, lane); continue; } r -= N_WKV;
        if (r < N_WO) { const int sl = r / 256; tr_item(A->in[I_XWO] + (size_t)sl * 1024 * 1024, 1024, 1024, (bf16*)(ws + WS_WO) + (size_t)sl * 1024 * 1024, nullptr, 0, 16, scr, r % 256, lane); continue; } r -= N_WO;
        if (r < N_MIN) { const int sl = r / 192; tr_item(A->in[I_MOEIN] + (size_t)sl * 1024 * 768, 768, 1024, (bf16*)(ws + WS_WMIN) + (size_t)sl * 768 * 1024, A->in[I_NFFN] + (sl >> 4) * 1024, 2, 12, scr, r % 192, lane); continue; } r -= N_MIN;
        if (r < N_MOUT) { const int sl = r / 96; tr_item(A->in[I_MOEOUT] + (size_t)sl * 384 * 1024, 1024, 384, (bf16*)(ws + WS_WMOUT) + (size_t)sl * 1024 * 384, nullptr, 0, 16, scr, r % 96, lane); continue; } r -= N_MOUT;
        { const int sl = r / 32; tr_item(A->in[I_CMPW1] + (size_t)sl * 2048 * 64, 64, 2048, (bf16*)(ws + WS_W1T) + (size_t)sl * 64 * 2048, nullptr, 0, 1, scr, r % 32, lane); }
    }
    for (int m = gw; m < T; m += NGW) rms_row_to_bf16(A->in[I_X] + (size_t)m * D, (bf16*)(ws + WS_XN) + (size_t)m * D, A->out + (size_t)m * D, lane);
    for (int m = gw; m < NBATCH * NMEM; m += NGW) rms_row_to_bf16(A->in[I_MEM] + (size_t)m * D, (bf16*)(ws + WS_MN) + (size_t)m * D, nullptr, lane);
    const int gt = blockIdx.x * 512 + tid, NGT = gridDim.x * 512;
    const int* pos = (const int*)A->in[I_POS];
    float* cosT = (float*)(ws + WS_COS); float* sinT = (float*)(ws + WS_SIN);
    for (int i = gt; i < T * 32; i += NGT) {
        const int t = i >> 5, j = i & 31;
        const float ang = (float)pos[t] * A->freq[j];
        const double rev = (double)ang * 0.15915494309189533577;
        const float fr = (float)(rev - rint(rev));
        cosT[i] = __builtin_amdgcn_cosf(fr); sinT[i] = __builtin_amdgcn_sinf(fr);
    }
    { bf16* WSB = (bf16*)(ws + WS_WSB); float* M0 = (float*)(ws + WS_M0); const float* wsg = A->in[I_SGWS];
      for (int e = gt; e < 2 * 8 * 128 * 128; e += NGT) { const int s = e & 127, t = (e >> 7) & 127; WSB[e] = (bf16)f2bf(s <= t ? wsg[e] : 0.f); }
      for (int e = gt; e < 2 * 8 * 128; e += NGT) { const int t = e & 127; const float* r = wsg + (size_t)e * 128; float a = 0.f; for (int s = 0; s <= t; ++s) a += r[s]; M0[e] = a; } }
    float* RW = (float*)(ws + WS_RW);
    for (int i = gt; i < DEPTH * NEXP * D; i += NGT) { const int k = i & 1023, e = (i >> 10) & 15, l = i >> 14; RW[i] = A->in[I_RW][k * NEXP + e] * A->in[I_NFFN][l * D + k]; }
}

__device__ __forceinline__ void phase_knorm(KArgs A, int wv_) {
    const int tid_ = opaque_tid(wv_); const int wid = __builtin_amdgcn_readfirstlane(tid_ >> 6), lane = tid_ & 63; const int gw = blockIdx.x * 8 + wid, NGW = gridDim.x * 8;
    bf16* KV = (bf16*)(opq(A->ws) + WS_KV);
    for (int it = gw; it < DEPTH * 2048 * 4; it += NGW) {
        const int h = it & 3, m = (it >> 2) & 2047, l = it >> 13;
        bf16* p = KV + (size_t)m * 8192 + l * 2048 + h * 256 + 4 * lane;
        const u32x2 w = *(const u32x2*)p;
        float x0 = bflo(w.x), x1 = bfhi(w.x), x2 = bflo(w.y), x3 = bfhi(w.y);
        const float rstd = rsqrtf(wave_sum(x0 * x0 + x1 * x1 + x2 * x2 + x3 * x3) * (1.f / 256.f) + EPS) * 0.0625f;
        const f32x4 g = *(const f32x4*)(A->in[I_XKN] + l * 256 + 4 * lane) * *(const f32x4*)(A->in[I_XQN] + l * 256 + 4 * lane);
        u32x2 o; o.x = pk2(x0 * rstd * g.x, x1 * rstd * g.y); o.y = pk2(x2 * rstd * g.z, x3 * rstd * g.w);
        *(u32x2*)p = o;
    }
}

__device__ __forceinline__ int kpos64(int tok) { const int k = tok & 31; return (tok & 32) + 8 * ((k >> 2) & 3) + 4 * (k >> 4) + (k & 3); }
__device__ __forceinline__ int kperm64(int p) { const int fq = (p >> 3) & 3, j = p & 7; return (p & 32) + 16 * (j >> 2) + 4 * fq + (j & 3); }

__device__ __forceinline__ void phase_nsa_prep(KArgs A, int wv_, int i, LAS unsigned char* lds) {
    const int tid_ = opaque_tid(wv_); const int wid = __builtin_amdgcn_readfirstlane(tid_ >> 6), lane = tid_ & 63; const int gw = blockIdx.x * 8 + wid, NGW = gridDim.x * 8;
    unsigned char* ws = opq(A->ws);
    const bf16* HY = (const bf16*)(ws + WS_BIG);
    const float* cosT = (const float*)(ws + WS_COS); const float* sinT = (const float*)(ws + WS_SIN);
    bf16* QA = (bf16*)(ws + WS_QA); bf16* KS = (bf16*)(ws + WS_KS); bf16* KW = (bf16*)(ws + WS_KW);
    LAS float* abuf = (LAS float*)(lds + wid * 8192);
    const int NIT = T;
    for (int it = gw; it < NIT; it += NGW) {
        if (it < T) {
            const int t = it;
            const float c = cosT[t * 32 + (lane & 31)], s = sinT[t * 32 + (lane & 31)];
            float xin[12];
#pragma unroll
            for (int u = 0; u < 12; ++u) xin[u] = bf2f(HY[(size_t)t * HYN + (u < 8 ? C_QA + 64 * u : (u < 10 ? C_KS + 64 * (u - 8) : C_KW + 64 * (u - 10))) + lane]);
#pragma unroll
            for (int u = 0; u < 12; ++u) {
                int src; const float* gain; bf16* dst; float scale;
                if (u < 8) { src = C_QA + 64 * u; gain = A->in[I_QNORM] + i * 64; dst = QA + (size_t)t * 512 + 64 * u; scale = 0.125f; }
                else if (u < 10) { src = C_KS + 64 * (u - 8); gain = A->in[I_KNORM] + (i * 3 + 1) * 64; dst = KS + (size_t)t * 128 + 64 * (u - 8); scale = 1.f; }
                else { src = C_KW + 64 * (u - 10); gain = A->in[I_KNORM] + (i * 3 + 2) * 64; dst = KW + (size_t)t * 128 + 64 * (u - 10); scale = 1.f; }
                const float x = xin[u]; (void)src;
                const float y = x * rsqrtf(wave_sum(x * x) * (1.f / 64.f) + EPS) * gain[lane] * scale;
                const float pr = __shfl_xor(y, 32);
                const float o = lane < 32 ? y * c - pr * s : y * c + pr * s;
                dst[lane] = (bf16)f2bf(o);
            }
        }
    }
}


__device__ __forceinline__ void phase_compress_mfma(KArgs A, int wv_, int i, LAS unsigned char* lds) {
    const int tid = opaque_tid(wv_), wid = __builtin_amdgcn_readfirstlane(tid >> 6), lane = tid & 63, fr = lane & 15, fq = lane >> 4;
    unsigned char* ws = opq(A->ws);
    const bf16* HY = (const bf16*)(ws + WS_BIG);
    const float* cosT = (const float*)(ws + WS_COS); const float* sinT = (const float*)(ws + WS_SIN);
    LAS float* part = (LAS float*)lds;
    LAS float* hbuf = part + 8 * 1024;
    LAS float* obuf = hbuf + 1024;
    for (int it = blockIdx.x; it < 2 * 127; it += gridDim.x) {
        const int kv = it / 127, tile = it % 127;
        const float* pe = A->in[I_CMPPE] + (size_t)(i * 2 + kv) * 32 * 64;
        const float* w2 = A->in[I_CMPW2] + (size_t)(i * 2 + kv) * 64 * 64;
        const bf16* w1t = (const bf16*)(ws + WS_W1T) + (size_t)(i * 2 + kv) * 64 * 2048;
        const int coff = kv ? C_VC : C_KC;
        {
            const int R = tile * 16 + fr, g = R & 1, bn = R >> 1, n = bn % NCMP, b = bn / NCMP;
            const bf16* arow = HY + (size_t)(b * S + 16 * n) * HYN + coff + g * 64;
            f32x4 acc[4];
#pragma unroll
            for (int t = 0; t < 4; ++t) acc[t] = (f32x4){0.f, 0.f, 0.f, 0.f};
#pragma unroll 2
            for (int s = 0; s < 8; ++s) {
                const int k0 = 256 * wid + 32 * s, l = k0 >> 6, d0 = (k0 & 63) + 8 * fq;
                const u32x4 hw = *(const u32x4*)(arow + (size_t)l * HYN + d0);
                const f32x4 p0 = *(const f32x4*)(pe + l * 64 + d0), p1 = *(const f32x4*)(pe + l * 64 + d0 + 4);
                u32x4 aw; aw.x = pk2(bflo(hw.x) + p0.x, bfhi(hw.x) + p0.y); aw.y = pk2(bflo(hw.y) + p0.z, bfhi(hw.y) + p0.w); aw.z = pk2(bflo(hw.z) + p1.x, bfhi(hw.z) + p1.y); aw.w = pk2(bflo(hw.w) + p1.z, bfhi(hw.w) + p1.w);
                const bf16x8 af = __builtin_bit_cast(bf16x8, aw);
#pragma unroll
                for (int t = 0; t < 4; ++t) { const bf16x8 bfr = *(const bf16x8*)(w1t + (size_t)(16 * t + fr) * 2048 + k0 + 8 * fq);
                    acc[t] = __builtin_amdgcn_mfma_f32_16x16x32_bf16(af, bfr, acc[t], 0, 0, 0); }
            }
            __syncthreads();
#pragma unroll
            for (int t = 0; t < 4; ++t)
#pragma unroll
                for (int r = 0; r < 4; ++r) part[wid * 1024 + (4 * fq + r) * 64 + 16 * t + fr] = acc[t][r];
        }
        __syncthreads();
        for (int e = tid; e < 1024; e += 512) { float a = 0.f;
#pragma unroll
            for (int w = 0; w < 8; ++w) a += part[w * 1024 + e];
            hbuf[e] = gelu_tanh(a); }
        __syncthreads();
        for (int e = tid; e < 1024; e += 512) { const int r = e >> 6, j = e & 63; float o = 0.f;
#pragma unroll 8
            for (int m = 0; m < 64; ++m) o += hbuf[r * 64 + m] * w2[m * 64 + j];
            obuf[e] = o; }
        __syncthreads();
        for (int r = wid; r < 16; r += 8) {
            const int R = tile * 16 + r, g = R & 1, bn = R >> 1, n = bn % NCMP, b = bn / NCMP;
            const float o = obuf[r * 64 + lane];
            if (kv == 0) {
                const float y = o * rsqrtf(wave_sum(o * o) * (1.f / 64.f) + EPS) * A->in[I_KNORM][(i * 3 + 0) * 64 + lane];
                const int tp = b * S + 16 * n + 31;
                const float c = cosT[tp * 32 + (lane & 31)], sn = sinT[tp * 32 + (lane & 31)];
                const float pr = __shfl_xor(y, 32);
                const float oo = lane < 32 ? y * c - pr * sn : y * c + pr * sn;
                ((bf16*)(ws + WS_KC))[((size_t)(b * 128 + n) * 2 + g) * 64 + lane] = (bf16)f2bf(oo);
            } else {
                bf16* vct = (bf16*)(ws + WS_VC) + ((size_t)(b * 2 + g) * 64 + lane) * 128;
                vct[(n & 64) + kpos64(n & 63)] = (bf16)f2bf(o);
                if (n == 126) vct[127] = 0;
            }
        }
    }
    __syncthreads();
}

__device__ __forceinline__ void nsa_block(const LAS float* qs, const bf16* __restrict__ krow, bool ok, const bf16* __restrict__ vbase, int vstride, int lane,
                                          float (&m)[4], float (&l)[4], float (&o)[4]) {
    float s[4] = {0.f, 0.f, 0.f, 0.f};
#pragma unroll 2
    for (int c = 0; c < 8; ++c) {
        const u32x4 kw = *(const u32x4*)(krow + 8 * c);
        const float k0 = bflo(kw.x), k1 = bfhi(kw.x), k2 = bflo(kw.y), k3 = bfhi(kw.y), k4 = bflo(kw.z), k5 = bfhi(kw.z), k6 = bflo(kw.w), k7 = bfhi(kw.w);
#pragma unroll
        for (int hh = 0; hh < 4; ++hh) {
            const f32x4 qa = *(const LAS f32x4*)(qs + hh * 64 + 8 * c), qb = *(const LAS f32x4*)(qs + hh * 64 + 8 * c + 4);
            s[hh] += (qa.x * k0 + qa.y * k1) + (qa.z * k2 + qa.w * k3) + (qb.x * k4 + qb.y * k5) + (qb.z * k6 + qb.w * k7);
        }
    }
    float p[4];
#pragma unroll
    for (int hh = 0; hh < 4; ++hh) {
        const float sv = ok ? s[hh] : -INFINITY;
        const float bm = wave_max(sv);
        const float mn = fmaxf(m[hh], bm);
        if (mn == -INFINITY) { p[hh] = 0.f; continue; }
        const float alpha = __expf(m[hh] - mn);
        p[hh] = ok ? __expf(sv - mn) : 0.f;
        l[hh] = l[hh] * alpha + wave_sum(p[hh]);
        o[hh] *= alpha; m[hh] = mn;
    }
#pragma unroll 8
    for (int kk = 0; kk < 64; ++kk) {
        const float v = bf2f(vbase[(size_t)kk * vstride + lane]);
#pragma unroll
        for (int hh = 0; hh < 4; ++hh) o[hh] += __shfl(p[hh], kk) * v;
    }
}
__device__ __forceinline__ void phase_nsa_attn(KArgs A, int wv_, int i, LAS unsigned char* lds) {
    const int tid_ = opaque_tid(wv_); const int wid = __builtin_amdgcn_readfirstlane(tid_ >> 6), lane0 = tid_ & 63; const int gw = blockIdx.x * 8 + wid, NGW = gridDim.x * 8;
    unsigned char* ws = opq(A->ws);
    const bf16* HY = (const bf16*)(ws + WS_BIG); const bf16* QA = (const bf16*)(ws + WS_QA); const bf16* KS = (const bf16*)(ws + WS_KS); const bf16* KW = (const bf16*)(ws + WS_KW);
    const bf16* KC = (const bf16*)(ws + WS_KC); const bf16* VC = (const bf16*)(ws + WS_VC); bf16* CAT = (bf16*)(ws + WS_CAT);
    LAS float* qs = (LAS float*)(lds + wid * 2048);
    LAS float* ps = qs + 256;
    for (int it = gw; it < 2 * T; it += NGW) {
        int lane = lane0; asm volatile("" : "+v"(lane));
        const int tok = it >> 1, g = it & 1, b = tok >> 11, t = tok & 2047;
#pragma unroll
        for (int hh = 0; hh < 4; ++hh) qs[hh * 64 + lane] = bf2f(QA[(size_t)tok * 512 + (g * 4 + hh) * 64 + lane]);
        LDS_WAIT();
        const int ncv = t >= 31 ? ((t - 31) >> 4) + 1 : 0;
        float oc[4] = {0.f, 0.f, 0.f, 0.f};
        float psum0 = 0.f, psum1 = 0.f;
        {
            const bool v0 = lane < ncv, v1 = lane + 64 < ncv;
            const bf16* k0p = KC + ((size_t)(b * 128 + lane) * 2 + g) * 64;
            const bf16* k1p = KC + ((size_t)(b * 128 + (lane + 64 < 127 ? lane + 64 : 126)) * 2 + g) * 64;
            float s0[4] = {0.f, 0.f, 0.f, 0.f}, s1[4] = {0.f, 0.f, 0.f, 0.f};
#pragma unroll 2
            for (int c = 0; c < 8; ++c) {
                const u32x4 ka = *(const u32x4*)(k0p + 8 * c), kb = *(const u32x4*)(k1p + 8 * c);
#pragma unroll
                for (int hh = 0; hh < 4; ++hh) {
                    const f32x4 qa = *(const LAS f32x4*)(qs + hh * 64 + 8 * c), qb = *(const LAS f32x4*)(qs + hh * 64 + 8 * c + 4);
                    s0[hh] += (qa.x * bflo(ka.x) + qa.y * bfhi(ka.x)) + (qa.z * bflo(ka.y) + qa.w * bfhi(ka.y)) + (qb.x * bflo(ka.z) + qb.y * bfhi(ka.z)) + (qb.z * bflo(ka.w) + qb.w * bfhi(ka.w));
                    s1[hh] += (qa.x * bflo(kb.x) + qa.y * bfhi(kb.x)) + (qa.z * bflo(kb.y) + qa.w * bfhi(kb.y)) + (qb.x * bflo(kb.z) + qb.y * bfhi(kb.z)) + (qb.z * bflo(kb.w) + qb.w * bfhi(kb.w));
                }
            }
            float p0[4], p1[4];
#pragma unroll
            for (int hh = 0; hh < 4; ++hh) {
                const float a0 = v0 ? s0[hh] : -INFINITY, a1 = v1 ? s1[hh] : -INFINITY;
                const float mx = wave_max(fmaxf(a0, a1));
                if (ncv > 0) {
                    const float e0 = v0 ? __expf(a0 - mx) : 0.f, e1 = v1 ? __expf(a1 - mx) : 0.f;
                    const float inv = 1.0f / wave_sum(e0 + e1);
                    p0[hh] = e0 * inv; p1[hh] = e1 * inv;
                } else { p0[hh] = 0.f; p1[hh] = 0.f; }
                psum0 += p0[hh]; psum1 += p1[hh];
            }
#pragma unroll 2
            for (int c = 0; c < ncv; ++c) {
                const float v = bf2f(VC[((size_t)(b * 128 + c) * 2 + g) * 64 + lane]);
#pragma unroll
                for (int hh = 0; hh < 4; ++hh) oc[hh] += __shfl(c < 64 ? p0[hh] : p1[hh], c & 63) * v;
            }
        }
        ps[lane] = psum0; ps[64 + lane] = psum1;
        LDS_WAIT();
        const int cur = t >> 6;
        unsigned selmask;
        {
            const int j = lane & 31;
            float imp = ps[4 * j] + ps[4 * j + 1] + ps[4 * j + 2] + 0.5f * ps[4 * j + 3] + (j > 0 ? 0.5f * ps[4 * j - 1] : 0.f);
            const bool valid = j <= cur, forced = (j == 0) || (j == cur) || (j == cur - 1);
            const float score = valid ? imp + (forced ? 1000.0f : 0.f) : -INFINITY;
            int rank = 0;
#pragma unroll 8
            for (int jj = 0; jj < 32; ++jj) { const float sj = __shfl(score, jj); rank += (sj > score || (sj == score && jj < j)) ? 1 : 0; }
            const bool sel = valid && rank < 8 && lane < 32;
            selmask = (unsigned)__ballot(sel);
        }
        LDS_WAIT();
        float o1[4] = {0.f, 0.f, 0.f, 0.f}, o2[4] = {0.f, 0.f, 0.f, 0.f};
#pragma unroll 1
        for (int pass = 0; pass < 2; ++pass) {
            float oa[4] = {0.f, 0.f, 0.f, 0.f}, ma[4] = {-INFINITY, -INFINITY, -INFINITY, -INFINITY}, la[4] = {0.f, 0.f, 0.f, 0.f};
            const int lo = pass ? (t - 255 > 0 ? t - 255 : 0) : 0;
            const unsigned bm = pass ? 0xffffffffu : selmask;
            const bf16* Kb = pass ? KW : KS; const int vc = pass ? C_VW : C_VS;
#pragma unroll 1
            for (int j = lo >> 6; j <= cur; ++j) {
                if (!((bm >> j) & 1u)) continue;
                const int key = 64 * j + lane; const size_t kt = (size_t)(b * S + key);
                nsa_block(qs, Kb + kt * 128 + g * 64, key <= t && key >= lo, HY + (size_t)(b * S + 64 * j) * HYN + vc + g * 64, HYN, lane, ma, la, oa);
            }
            if (pass == 0) {
#pragma unroll
                for (int hh = 0; hh < 4; ++hh) o1[hh] = oa[hh] / la[hh];
            } else {
#pragma unroll
                for (int hh = 0; hh < 4; ++hh) o2[hh] = oa[hh] / la[hh];
            }
        }
#pragma unroll
        for (int hh = 0; hh < 4; ++hh) {
            const int head = g * 4 + hh;
            const float* gb = A->in[I_GATEB] + i * 24 + head * 3;
            const bf16* gl = HY + (size_t)tok * HYN + C_GA + head * 3;
            const float g0 = sigmoidf_(bf2f(gl[0]) + gb[0]), g1 = sigmoidf_(bf2f(gl[1]) + gb[1]), g2 = sigmoidf_(bf2f(gl[2]) + gb[2]);
            const float o = g0 * oc[hh] + g1 * o1[hh] + g2 * o2[hh];
            CAT[(size_t)tok * 1024 + head * 64 + lane] = (bf16)f2bf(o);
        }
    }
}

__device__ __forceinline__ void phase_gla_seq(KArgs A, int wv_, int i, LAS unsigned char* lds) {
    const int tid = opaque_tid(wv_), wid = __builtin_amdgcn_readfirstlane(tid >> 6), lane = tid & 63;
    unsigned char* ws = opq(A->ws);
    const bf16* HY = (const bf16*)(ws + WS_BIG); bf16* CAT = (bf16*)(ws + WS_CAT);
    constexpr int CH = 16;
    LAS float* la = (LAS float*)lds;
    LAS float* lk = la + 4 * CH * 64;
    LAS float* lq = lk + 4 * CH * 64;
    LAS float* lo = lq + 4 * CH * 64;
    const float* wa2 = A->in[I_WA2] + i * 16 * 256; const float* ba = A->in[I_BA] + i * 256; const float* og = A->in[I_ONORM] + i * 128;
    for (int it = blockIdx.x; it < 8; it += gridDim.x) {
        const int pl = tid >> 7, v = tid & 127, p = it * 4 + pl, b = p >> 2, h = p & 3;
        float St[64];
#pragma unroll
        for (int k = 0; k < 64; ++k) St[k] = 0.f;
        for (int c0 = 0; c0 < S; c0 += CH) {
            __syncthreads();
            for (int e = tid; e < 4 * CH * 64; e += 512) {
                const int kk = e & 63, tk = (e >> 6) % CH, pp = e / (64 * CH); const int pb = (it * 4 + pp) >> 2, ph = (it * 4 + pp) & 3;
                const size_t tok = (size_t)pb * S + c0 + tk; const bf16* row = HY + tok * HYN;
                float z = ba[ph * 64 + kk];
#pragma unroll
                for (int r = 0; r < 16; ++r) z += bf2f(row[C_AL + r]) * wa2[r * 256 + ph * 64 + kk];
                const float ls_ = fminf(z, 0.f) - log1pf(__expf(-fabsf(z)));
                la[e] = __expf(ls_ * (1.f / 16.f));
                lk[e] = bf2f(row[C_KB + ph * 64 + kk]);
                lq[e] = bf2f(row[C_QB + ph * 64 + kk]) * 0.125f;
            }
            __syncthreads();
            for (int tk = 0; tk < CH; ++tk) {
                const size_t tok = (size_t)b * S + c0 + tk;
                const float vv = bf2f(HY[tok * HYN + C_VB + h * 128 + v]);
                const LAS float* pa = la + (pl * CH + tk) * 64; const LAS float* pk = lk + (pl * CH + tk) * 64; const LAS float* pq = lq + (pl * CH + tk) * 64;
                float o = 0.f;
#pragma unroll
                for (int k4 = 0; k4 < 16; ++k4) {
                    const f32x4 a4 = *(const LAS f32x4*)(pa + 4 * k4), k4v = *(const LAS f32x4*)(pk + 4 * k4), q4 = *(const LAS f32x4*)(pq + 4 * k4);
                    St[4 * k4 + 0] = a4.x * St[4 * k4 + 0] + k4v.x * vv; o += q4.x * St[4 * k4 + 0];
                    St[4 * k4 + 1] = a4.y * St[4 * k4 + 1] + k4v.y * vv; o += q4.y * St[4 * k4 + 1];
                    St[4 * k4 + 2] = a4.z * St[4 * k4 + 2] + k4v.z * vv; o += q4.z * St[4 * k4 + 2];
                    St[4 * k4 + 3] = a4.w * St[4 * k4 + 3] + k4v.w * vv; o += q4.w * St[4 * k4 + 3];
                }
                lo[(pl * CH + tk) * 128 + v] = o;
            }
            __syncthreads();
            for (int r = wid; r < 4 * CH; r += 8) {
                const int pp = r / CH, tk = r % CH; const int pb = (it * 4 + pp) >> 2, ph = (it * 4 + pp) & 3;
                const size_t tok = (size_t)pb * S + c0 + tk;
                const float x0 = lo[r * 128 + lane], x1 = lo[r * 128 + 64 + lane];
                const float rstd = rsqrtf(wave_sum(x0 * x0 + x1 * x1) * (1.f / 128.f) + EPS);
                const float r0 = bf2f(HY[tok * HYN + C_RB + ph * 128 + lane]), r1 = bf2f(HY[tok * HYN + C_RB + ph * 128 + 64 + lane]);
                CAT[tok * 1024 + 512 + ph * 128 + lane] = (bf16)f2bf(x0 * rstd * og[lane] * (r0 * sigmoidf_(r0)));
                CAT[tok * 1024 + 512 + ph * 128 + 64 + lane] = (bf16)f2bf(x1 * rstd * og[64 + lane] * (r1 * sigmoidf_(r1)));
            }
        }
        __syncthreads();
    }
}


__device__ __forceinline__ void phase_nsa_attn_mfma(KArgs A, int wv_, int i, LAS unsigned char* lds) {
    const int tid = opaque_tid(wv_), wid = __builtin_amdgcn_readfirstlane(tid >> 6), lane = tid & 63, fr = lane & 15, fq = lane >> 4;
    unsigned char* ws = opq(A->ws);
    const bf16* HY = (const bf16*)(ws + WS_BIG); const bf16* QA = (const bf16*)(ws + WS_QA); const bf16* KS = (const bf16*)(ws + WS_KS); const bf16* KW = (const bf16*)(ws + WS_KW);
    const bf16* KC = (const bf16*)(ws + WS_KC); const bf16* VCT = (const bf16*)(ws + WS_VC); const bf16* VTA = (const bf16*)(ws + WS_VTA); bf16* CAT = (bf16*)(ws + WS_CAT);
    constexpr int RS = 72;
    LAS bf16* ktl = (LAS bf16*)lds;
    LAS bf16* vtl = ktl + 4 * 64 * RS;
    LAS float* scl = (LAS float*)(lds + 73728) + wid * 256;
    LAS unsigned* msk = (LAS unsigned*)(lds + 73728 + 8192);
    LAS unsigned* umask = msk + 64;
    const float* gb = A->in[I_GATEB] + i * 24;
    for (int pit = blockIdx.x; pit < 256; pit += gridDim.x) {
#pragma unroll 1
        for (int hf = 0; hf < 2; ++hf) {
            const int bg = pit >> 4, xx = pit & 15, x = hf ? 31 - xx : xx, b = bg >> 1, g = bg & 1;
            const size_t tokbase = (size_t)b * S + 64 * x;
            const int tl0 = 8 * wid + (fr >> 2);
            if (tid == 0) *umask = 0u;
            bf16x8 qf[2][2];
#pragma unroll
            for (int mt = 0; mt < 2; ++mt)
#pragma unroll
                for (int s = 0; s < 2; ++s) qf[mt][s] = *(const bf16x8*)(QA + (tokbase + tl0 + 4 * mt) * 512 + (g * 4 + (fr & 3)) * 64 + 32 * s + 8 * fq);
            f32x4 outacc[2][4];
            {
                const int tmaxc = (4 * x + 3 + 15) >> 4;
                const bf16* kcb = KC + ((size_t)(b * 128 + fr) * 2 + g) * 64 + 8 * fq;
                bf16x8 pcf[2][4];
#pragma unroll
                for (int mt = 0; mt < 2; ++mt) {
                    f32x4 sc[8];
                    const bf16* kp = kcb;
#pragma unroll
                    for (int t = 0; t < 8; ++t) { sc[t] = (f32x4){0.f, 0.f, 0.f, 0.f};
                        asm volatile("" : "+v"(kp));
                        if (t < tmaxc) {
                            const bf16x8 k0 = *(const bf16x8*)(kp), k1 = *(const bf16x8*)(kp + 32);
                            sc[t] = __builtin_amdgcn_mfma_f32_16x16x32_bf16(k0, qf[mt][0], sc[t], 0, 0, 0);
                            sc[t] = __builtin_amdgcn_mfma_f32_16x16x32_bf16(k1, qf[mt][1], sc[t], 0, 0, 0); }
                        kp += 16 * 128; }
                    const int tg = 64 * x + tl0 + 4 * mt; const int ncv = tg >= 31 ? ((tg - 31) >> 4) + 1 : 0;
                    float mx = -INFINITY;
#pragma unroll
                    for (int t = 0; t < 8; ++t)
#pragma unroll
                        for (int r = 0; r < 4; ++r) { const bool v = 16 * t + 4 * fq + r < ncv; sc[t][r] = v ? sc[t][r] : -INFINITY; mx = fmaxf(mx, sc[t][r]); }
                    mx = fmaxf(mx, __shfl_xor(mx, 16)); mx = fmaxf(mx, __shfl_xor(mx, 32));
                    const float mxs = mx == -INFINITY ? 0.f : mx;
                    float sum = 0.f;
#pragma unroll
                    for (int t = 0; t < 8; ++t)
#pragma unroll
                        for (int r = 0; r < 4; ++r) { sc[t][r] = __expf(sc[t][r] - mxs); sum += sc[t][r]; }
                    sum += __shfl_xor(sum, 16); sum += __shfl_xor(sum, 32);
                    const float inv = sum > 0.f ? 1.f / sum : 0.f;
#pragma unroll
                    for (int t = 0; t < 8; ++t) sc[t] = sc[t] * inv;
#pragma unroll
                    for (int s = 0; s < 4; ++s) { u32x4 w; w.x = pk2(sc[2 * s].x, sc[2 * s].y); w.y = pk2(sc[2 * s].z, sc[2 * s].w); w.z = pk2(sc[2 * s + 1].x, sc[2 * s + 1].y); w.w = pk2(sc[2 * s + 1].z, sc[2 * s + 1].w);
                        pcf[mt][s] = __builtin_bit_cast(bf16x8, w); }
                    float w3[8];
#pragma unroll
                    for (int t = 0; t < 8; ++t) {
#pragma unroll
                        for (int r = 0; r < 4; ++r) { float v = sc[t][r]; v += __shfl_xor(v, 1); v += __shfl_xor(v, 2); sc[t][r] = v; }
                        w3[t] = __shfl(sc[t].w, (lane + 48) & 63);
                    }
#pragma unroll
                    for (int t = 0; t < 8; ++t) {
                        const float prev = fq > 0 ? w3[t] : (t > 0 ? w3[t > 0 ? t - 1 : 0] : 0.f);
                        const float imp = sc[t].x + sc[t].y + sc[t].z + 0.5f * sc[t].w + 0.5f * prev;
                        if ((fr & 3) == 0) scl[(4 * mt + (fr >> 2)) * 32 + 4 * t + fq] = imp;
                    }
                    asm volatile("" ::: "memory");
                }
                const bf16* vcb = VCT + ((size_t)(b * 2 + g) * 64 + fr) * 128 + 8 * fq;
#pragma unroll
                for (int n = 0; n < 4; ++n) {
                    outacc[0][n] = (f32x4){0.f, 0.f, 0.f, 0.f}; outacc[1][n] = (f32x4){0.f, 0.f, 0.f, 0.f};
                    asm volatile("" : "+v"(vcb));
#pragma unroll
                    for (int s = 0; s < 4; ++s) if (2 * s < tmaxc) {
                        const bf16x8 vf = *(const bf16x8*)(vcb + 32 * s);
                        outacc[0][n] = __builtin_amdgcn_mfma_f32_16x16x32_bf16(vf, pcf[0][s], outacc[0][n], 0, 0, 0);
                        outacc[1][n] = __builtin_amdgcn_mfma_f32_16x16x32_bf16(vf, pcf[1][s], outacc[1][n], 0, 0, 0); }
                    vcb += 16 * 128;
                    asm volatile("" ::: "memory");
                }
            }
            float g1v[2], g2v[2];
#pragma unroll
            for (int mt = 0; mt < 2; ++mt) {
                const int head = g * 4 + (fr & 3);
                const bf16* gl = HY + (tokbase + tl0 + 4 * mt) * HYN + C_GA + head * 3;
                const float g0 = sigmoidf_(bf2f(gl[0]) + gb[head * 3 + 0]);
                g1v[mt] = sigmoidf_(bf2f(gl[1]) + gb[head * 3 + 1]); g2v[mt] = sigmoidf_(bf2f(gl[2]) + gb[head * 3 + 2]);
#pragma unroll
                for (int n = 0; n < 4; ++n) outacc[mt][n] = outacc[mt][n] * g0;
            }
            LDS_WAIT();
            asm volatile("" ::: "memory");
            {
                const int tok8 = lane >> 3, jg = lane & 7;
                float sj[32];
#pragma unroll
                for (int q = 0; q < 8; ++q) { const f32x4 v = *(const LAS f32x4*)(scl + tok8 * 32 + 4 * q); sj[4 * q] = v.x; sj[4 * q + 1] = v.y; sj[4 * q + 2] = v.z; sj[4 * q + 3] = v.w; }
#pragma unroll
                for (int j = 0; j < 32; ++j) sj[j] = j <= x ? sj[j] + ((j == 0 || j == x || j == x - 1) ? 1000.0f : 0.f) : -INFINITY;
                unsigned bits = 0u;
                const f32x4 mv = *(const LAS f32x4*)(scl + tok8 * 32 + 4 * jg);
#pragma unroll
                for (int q = 0; q < 4; ++q) {
                    const int j = 4 * jg + q;
                    const float mine = j <= x ? mv[q] + ((j == 0 || j == x || j == x - 1) ? 1000.0f : 0.f) : -INFINITY;
                    int rank = 0;
#pragma unroll
                    for (int jj = 0; jj < 32; ++jj) rank += (sj[jj] > mine || (sj[jj] == mine && jj < j)) ? 1 : 0;
                    bits |= (j <= x && rank < 8) ? (1u << j) : 0u;
                }
                bits |= __shfl_xor(bits, 1); bits |= __shfl_xor(bits, 2); bits |= __shfl_xor(bits, 4);
                if (jg == 0) { msk[wid * 8 + tok8] = bits; atomicOr((unsigned*)umask, bits); }
            }
            __syncthreads();
#pragma unroll 1
            for (int pass = 0; pass < 2; ++pass) {
                const int jlo = pass ? (x >= 4 ? x - 4 : 0) : 0;
                const unsigned inrange = (x >= 31 ? 0xffffffffu : ((2u << x) - 1u)) & ~((1u << jlo) - 1u);
                unsigned bmask = pass ? inrange : (*umask & inrange);
                const bf16* Kb = pass ? KW : KS; const int cg = (pass ? 10 : 8) + g;
                unsigned tm[2], wm[2];
#pragma unroll
                for (int mt = 0; mt < 2; ++mt) {
                    tm[mt] = pass ? 0xffffffffu : msk[wid * 8 + 4 * mt + (fr >> 2)];
                    wm[mt] = pass ? 0xffffffffu : (msk[wid * 8 + 4 * mt] | msk[wid * 8 + 4 * mt + 1] | msk[wid * 8 + 4 * mt + 2] | msk[wid * 8 + 4 * mt + 3]);
                    wm[mt] = __builtin_amdgcn_readfirstlane(wm[mt]);
                }
                f32x4 o[2][4]; float mrun[2], lrun[2];
#pragma unroll
                for (int mt = 0; mt < 2; ++mt) { mrun[mt] = -INFINITY; lrun[mt] = 0.f;
#pragma unroll
                    for (int n = 0; n < 4; ++n) o[mt][n] = (f32x4){0.f, 0.f, 0.f, 0.f}; }
                const int srow = tid >> 3, sc16 = tid & 7;
                u32x4 pk0 = (u32x4){0u, 0u, 0u, 0u}, pv0 = pk0, pk1 = pk0, pv1 = pk0;
#define NSA_LD(jx, pk, pv) do { const bf16* ksrc = Kb + ((size_t)b * S + 64 * (jx) + srow) * 128 + g * 64 + sc16 * 8; const bf16* vsrc = VTA + ((size_t)((b * 32 + (jx)) * 12 + cg)) * 4096 + srow * 64 + sc16 * 8; \
                    pk = *(const u32x4*)ksrc; pv = *(const u32x4*)vsrc; } while (0)
                int j0 = __ffs(bmask) - 1; bmask &= bmask - 1u;
                int j1 = bmask ? __ffs(bmask) - 1 : -1; bmask &= bmask - 1u;
                NSA_LD(j0, pk0, pv0); if (j1 >= 0) NSA_LD(j1, pk1, pv1);
                int buf = 0;
                while (j0 >= 0) {
                    *(LAS u32x4*)(ktl + (buf * 2 + 0) * 64 * RS + srow * RS + sc16 * 8) = pk0; *(LAS u32x4*)(vtl + (buf * 2 + 0) * 64 * RS + srow * RS + sc16 * 8) = pv0;
                    if (j1 >= 0) { *(LAS u32x4*)(ktl + (buf * 2 + 1) * 64 * RS + srow * RS + sc16 * 8) = pk1; *(LAS u32x4*)(vtl + (buf * 2 + 1) * 64 * RS + srow * RS + sc16 * 8) = pv1; }
                    const int jn0 = bmask ? __ffs(bmask) - 1 : -1; bmask &= bmask - 1u;
                    const int jn1 = bmask ? __ffs(bmask) - 1 : -1; bmask &= bmask - 1u;
                    if (jn0 >= 0) NSA_LD(jn0, pk0, pv0);
                    if (jn1 >= 0) NSA_LD(jn1, pk1, pv1);
                    __syncthreads();
#pragma unroll 1
                    for (int sub = 0; sub < 2; ++sub) {
                        const int j = sub ? j1 : j0;
                        if (j < 0) break;
                        const LAS bf16* kt = ktl + (buf * 2 + sub) * 64 * RS + fr * RS + 8 * fq; const LAS bf16* vt = vtl + (buf * 2 + sub) * 64 * RS + fr * RS + 8 * fq;
#pragma unroll
                        for (int mt = 0; mt < 2; ++mt) {
                            if (!((wm[mt] >> j) & 1u)) continue;
                            f32x4 sc[4];
#pragma unroll
                            for (int t = 0; t < 4; ++t) { sc[t] = (f32x4){0.f, 0.f, 0.f, 0.f};
                                sc[t] = __builtin_amdgcn_mfma_f32_16x16x32_bf16(*(const LAS bf16x8*)(kt + t * 16 * RS), qf[mt][0], sc[t], 0, 0, 0);
                                sc[t] = __builtin_amdgcn_mfma_f32_16x16x32_bf16(*(const LAS bf16x8*)(kt + t * 16 * RS + 32), qf[mt][1], sc[t], 0, 0, 0); }
                            const int tl = tl0 + 4 * mt;
                            const bool rowok = (tm[mt] >> j) & 1u;
                            const int kphi = j == x ? tl : 63;
                            const int kplo = (pass && j == x - 4) ? tl + 1 : 0;
                            float bm = -INFINITY;
#pragma unroll
                            for (int t = 0; t < 4; ++t)
#pragma unroll
                                for (int r = 0; r < 4; ++r) { const int kp = 16 * t + 4 * fq + r; const bool v = rowok && kp <= kphi && kp >= kplo; sc[t][r] = v ? sc[t][r] : -INFINITY; bm = fmaxf(bm, sc[t][r]); }
                            bm = fmaxf(bm, __shfl_xor(bm, 16)); bm = fmaxf(bm, __shfl_xor(bm, 32));
                            const float mn = fmaxf(mrun[mt], bm); const float mns = mn == -INFINITY ? 0.f : mn;
                            const float alpha = __expf(mrun[mt] - mns);
                            float rs = 0.f;
#pragma unroll
                            for (int t = 0; t < 4; ++t)
#pragma unroll
                                for (int r = 0; r < 4; ++r) { sc[t][r] = __expf(sc[t][r] - mns); rs += sc[t][r]; }
                            rs += __shfl_xor(rs, 16); rs += __shfl_xor(rs, 32);
                            lrun[mt] = lrun[mt] * alpha + rs; mrun[mt] = mn;
                            bf16x8 pf[2];
#pragma unroll
                            for (int s = 0; s < 2; ++s) { u32x4 w; w.x = pk2(sc[2 * s].x, sc[2 * s].y); w.y = pk2(sc[2 * s].z, sc[2 * s].w); w.z = pk2(sc[2 * s + 1].x, sc[2 * s + 1].y); w.w = pk2(sc[2 * s + 1].z, sc[2 * s + 1].w);
                                pf[s] = __builtin_bit_cast(bf16x8, w); }
#pragma unroll
                            for (int n = 0; n < 4; ++n) { o[mt][n] = o[mt][n] * alpha;
                                o[mt][n] = __builtin_amdgcn_mfma_f32_16x16x32_bf16(*(const LAS bf16x8*)(vt + n * 16 * RS), pf[0], o[mt][n], 0, 0, 0);
                                o[mt][n] = __builtin_amdgcn_mfma_f32_16x16x32_bf16(*(const LAS bf16x8*)(vt + n * 16 * RS + 32), pf[1], o[mt][n], 0, 0, 0); }
                        }
                    }
                    j0 = jn0; j1 = jn1; buf ^= 1;
                }
#undef NSA_LD
#pragma unroll
                for (int mt = 0; mt < 2; ++mt) { const float sc_ = (pass ? g2v[mt] : g1v[mt]) / lrun[mt];
#pragma unroll
                    for (int n = 0; n < 4; ++n) outacc[mt][n] = outacc[mt][n] + o[mt][n] * sc_; }
                __syncthreads();
            }
#pragma unroll
            for (int mt = 0; mt < 2; ++mt) {
                bf16* dst = CAT + (tokbase + tl0 + 4 * mt) * 1024 + (g * 4 + (fr & 3)) * 64 + 4 * fq;
#pragma unroll
                for (int n = 0; n < 4; ++n) { u32x2 w; w.x = pk2(outacc[mt][n].x, outacc[mt][n].y); w.y = pk2(outacc[mt][n].z, outacc[mt][n].w); *(u32x2*)(dst + 16 * n) = w; }
            }
        }
    }
    __syncthreads();
}

__device__ __forceinline__ void phase_vtiles(KArgs A, int wv_, LAS unsigned char* lds) {
    const int tid_ = opaque_tid(wv_); const int wid = __builtin_amdgcn_readfirstlane(tid_ >> 6), lane = tid_ & 63; const int gw = blockIdx.x * 8 + wid, NGW = gridDim.x * 8;
    unsigned char* ws = opq(A->ws);
    const bf16* HY = (const bf16*)(ws + WS_BIG); bf16* VTA = (bf16*)(ws + WS_VTA);
    constexpr int TS = 66;
    LAS bf16* tl = (LAS bf16*)(lds + 65536) + wid * (64 * TS);
    for (int it = gw; it < NBATCH * 32 * 12; it += NGW) {
        const int cg = it % 12, bc = it / 12;
        const int colbase = cg < 8 ? C_VB + cg * 64 : (cg < 10 ? C_VS + (cg - 8) * 64 : C_VW + (cg - 10) * 64);
        const u32x4* src = (const u32x4*)(HY + (size_t)(bc * 64 + lane) * HYN + colbase);
        u32x4 w[8];
#pragma unroll
        for (int i = 0; i < 8; ++i) w[i] = src[i];
#pragma unroll
        for (int i = 0; i < 8; ++i) { LAS unsigned* d = (LAS unsigned*)(tl + lane * TS + 8 * i); d[0] = w[i].x; d[1] = w[i].y; d[2] = w[i].z; d[3] = w[i].w; }
        LDS_WAIT();
        bf16* dst = VTA + (size_t)it * 4096 + lane * 64;
#pragma unroll
        for (int p8 = 0; p8 < 8; ++p8) {
            unsigned short x[8];
#pragma unroll
            for (int j = 0; j < 8; ++j) x[j] = tl[kperm64(p8 * 8 + j) * TS + lane];
            u32x4 o; o.x = x[0] | ((unsigned)x[1] << 16); o.y = x[2] | ((unsigned)x[3] << 16); o.z = x[4] | ((unsigned)x[5] << 16); o.w = x[6] | ((unsigned)x[7] << 16);
            *(u32x4*)(dst + p8 * 8) = o;
        }
        LDS_WAIT();
    }
}

__device__ __forceinline__ float log_sigmoid16(float z) { return (fminf(z, 0.f) - __logf(1.0f + __expf(-fabsf(z)))) * (1.f / 16.f); }
#define GLA_Z(tokv) ({ float z_ = bias; _Pragma("unroll") for (int r_ = 0; r_ < 16; ++r_) z_ += __builtin_bit_cast(float, __builtin_amdgcn_readlane(__builtin_bit_cast(int, al[r_]), (tokv))) * wc[r_]; z_; })
#define GLA_LOAD_GATE() \
    float al[16], wc[16]; \
    { const u32x4* ap_ = (const u32x4*)(HY + (size_t)(tok0 + lane) * HYN + C_AL); const u32x4 a0_ = ap_[0], a1_ = ap_[1]; \
      al[0] = bflo(a0_.x); al[1] = bfhi(a0_.x); al[2] = bflo(a0_.y); al[3] = bfhi(a0_.y); al[4] = bflo(a0_.z); al[5] = bfhi(a0_.z); al[6] = bflo(a0_.w); al[7] = bfhi(a0_.w); \
      al[8] = bflo(a1_.x); al[9] = bfhi(a1_.x); al[10] = bflo(a1_.y); al[11] = bfhi(a1_.y); al[12] = bflo(a1_.z); al[13] = bfhi(a1_.z); al[14] = bflo(a1_.w); al[15] = bfhi(a1_.w); } \
    _Pragma("unroll") for (int r_ = 0; r_ < 16; ++r_) wc[r_] = A->in[I_WA2][(i * 16 + r_) * 256 + h * 64 + lane]; \
    const float bias = A->in[I_BA][i * 256 + h * 64 + lane];

__device__ __forceinline__ void phase_gla_a(KArgs A, int wv_, int i, LAS unsigned char* lds) {
    const int tid_ = opaque_tid(wv_); const int wid = __builtin_amdgcn_readfirstlane(tid_ >> 6), lane = tid_ & 63, fr = lane & 15, fq = lane >> 4; const int gw = blockIdx.x * 8 + wid, NGW = gridDim.x * 8;
    unsigned char* ws = opq(A->ws);
    const bf16* HY = (const bf16*)(ws + WS_BIG); const bf16* VTA = (const bf16*)(ws + WS_VTA); float* SLOC = (float*)(ws + WS_SLOC); float* DEC = (float*)(ws + WS_DEC);
    constexpr int RS = 72;
    LAS bf16* kh = (LAS bf16*)lds + wid * (64 * RS);
    (void)gw;
    for (int it = wid * (int)gridDim.x + (int)blockIdx.x; it < 1024; it += NGW) {
        const int c = it & 31, bh = it >> 5, b = bh >> 2, h = bh & 3; const size_t tok0 = (size_t)b * S + c * 64;
        GLA_LOAD_GATE();
        float bl = 0.f;
#pragma unroll 8
        for (int tk = 0; tk < 64; ++tk) bl += log_sigmoid16(GLA_Z(tk));
        float bc = 0.f;
        unsigned short kcol[64];
#pragma unroll
        for (int tk = 0; tk < 64; ++tk) kcol[tk] = HY[(tok0 + tk) * HYN + C_KB + h * 64 + lane];
#pragma unroll
        for (int tk = 0; tk < 64; ++tk) {
            bc += log_sigmoid16(GLA_Z(tk));
            kh[lane * RS + kpos64(tk)] = (bf16)f2bf(bf2f(kcol[tk]) * __expf(bl - bc));
        }
        DEC[it * 64 + lane] = __expf(bl);
        LDS_WAIT();
#pragma unroll
        for (int dvh = 0; dvh < 2; ++dvh) {
            const bf16* vt = VTA + ((size_t)((b * 32 + c) * 12 + h * 2 + dvh)) * 4096;
            bf16x8 vf[4][2];
#pragma unroll
            for (int n = 0; n < 4; ++n)
#pragma unroll
                for (int s = 0; s < 2; ++s) vf[n][s] = *(const bf16x8*)(vt + (16 * n + fr) * 64 + 32 * s + 8 * fq);
#pragma unroll
            for (int m = 0; m < 4; ++m) {
                const bf16x8 a0 = *(const LAS bf16x8*)(kh + (16 * m + fr) * RS + 8 * fq), a1 = *(const LAS bf16x8*)(kh + (16 * m + fr) * RS + 32 + 8 * fq);
#pragma unroll
                for (int n = 0; n < 4; ++n) {
                    f32x4 acc = (f32x4){0.f, 0.f, 0.f, 0.f};
                    acc = __builtin_amdgcn_mfma_f32_16x16x32_bf16(a0, vf[n][0], acc, 0, 0, 0);
                    acc = __builtin_amdgcn_mfma_f32_16x16x32_bf16(a1, vf[n][1], acc, 0, 0, 0);
                    float* dst = SLOC + ((size_t)it * 64 + 16 * m + 4 * fq) * 128 + dvh * 64 + 16 * n + fr;
                    dst[0] = acc.x; dst[128] = acc.y; dst[256] = acc.z; dst[384] = acc.w;
                }
            }
        }
        LDS_WAIT();
    }
}
__device__ __forceinline__ void phase_gla_c(KArgs A, int wv_, int i, LAS unsigned char* lds) {
    const int tid_ = opaque_tid(wv_); const int wid = __builtin_amdgcn_readfirstlane(tid_ >> 6), lane = tid_ & 63, fr = lane & 15, fq = lane >> 4; const int gw = blockIdx.x * 8 + wid, NGW = gridDim.x * 8;
    unsigned char* ws = opq(A->ws);
    const bf16* HY = (const bf16*)(ws + WS_BIG); const bf16* VTA = (const bf16*)(ws + WS_VTA); const bf16* STT = (const bf16*)(ws + WS_STT); bf16* CAT = (bf16*)(ws + WS_CAT);
    constexpr int RS = 72;
    LAS bf16* qs = (LAS bf16*)lds + wid * (128 * RS);
    LAS bf16* ks = qs + 64 * RS;
    const float* og = A->in[I_ONORM] + i * 128;
    (void)gw; (void)NGW;
    for (int blk = blockIdx.x; blk < 128; blk += gridDim.x) {
        {
            const float* SLOC = (const float*)(ws + WS_SLOC); const float* DEC = (const float*)(ws + WS_DEC); bf16* STw = (bf16*)(ws + WS_STT);
            const int tid = tid_, dv = tid & 127, ko = tid >> 7, bh = blk >> 2, c0 = (blk & 3) * 8;
            float sv[16], dcn[16], sln[16];
#pragma unroll
            for (int j = 0; j < 16; ++j) sv[j] = 0.f;
            {   const size_t item = (size_t)bh * 32; const float* sl = SLOC + (item * 64 + ko * 16) * 128 + dv; const float* dc = DEC + item * 64 + ko * 16;
#pragma unroll
                for (int j = 0; j < 16; ++j) { dcn[j] = dc[j]; sln[j] = sl[j * 128]; } }
#pragma unroll 1
            for (int c = 0; c < c0 + 8; ++c) {
                const size_t item = (size_t)bh * 32 + c;
                float dcc[16], slc[16];
#pragma unroll
                for (int j = 0; j < 16; ++j) { dcc[j] = dcn[j]; slc[j] = sln[j]; }
                if (c + 1 < c0 + 7) {
                    const float* sl = SLOC + ((item + 1) * 64 + ko * 16) * 128 + dv; const float* dc = DEC + (item + 1) * 64 + ko * 16;
#pragma unroll
                    for (int j = 0; j < 16; ++j) { dcn[j] = dc[j]; sln[j] = sl[j * 128]; }
                }
                if (c >= c0) {
                    u32x4 o0, o1; o0.x = pk2(sv[0], sv[1]); o0.y = pk2(sv[2], sv[3]); o0.z = pk2(sv[4], sv[5]); o0.w = pk2(sv[6], sv[7]);
                    o1.x = pk2(sv[8], sv[9]); o1.y = pk2(sv[10], sv[11]); o1.z = pk2(sv[12], sv[13]); o1.w = pk2(sv[14], sv[15]);
                    u32x4* d = (u32x4*)(STw + (item * 128 + dv) * 64 + ko * 16); d[0] = o0; d[1] = o1;
                }
                if (c < c0 + 7) {
#pragma unroll
                    for (int j = 0; j < 16; ++j) sv[j] = dcc[j] * sv[j] + slc[j];
                }
            }
            asm volatile("s_waitcnt vmcnt(0)" ::: "memory");
            __syncthreads();
        }
        const int it = blk * 8 + wid;
        const int c = it & 31, bh = it >> 5, b = bh >> 2, h = bh & 3; const size_t tok0 = (size_t)b * S + c * 64;
        GLA_LOAD_GATE();
        float bc = 0.f;
        unsigned short qcol[64], kcol[64];
#pragma unroll
        for (int tk = 0; tk < 64; ++tk) { const bf16* row = HY + (tok0 + tk) * HYN; qcol[tk] = row[C_QB + h * 64 + lane]; kcol[tk] = row[C_KB + h * 64 + lane]; }
#pragma unroll
        for (int tk = 0; tk < 64; ++tk) {
            bc += log_sigmoid16(GLA_Z(tk));
            const float eb = __expf(bc);
            qs[tk * RS + lane] = (bf16)f2bf(bf2f(qcol[tk]) * 0.125f * eb); ks[tk * RS + lane] = (bf16)f2bf(bf2f(kcol[tk]) / eb);
        }
        LDS_WAIT();
        bf16x8 st[8][2];
#pragma unroll
        for (int n = 0; n < 8; ++n)
#pragma unroll
            for (int s = 0; s < 2; ++s) st[n][s] = *(const bf16x8*)(STT + ((size_t)it * 128 + 16 * n + fr) * 64 + 32 * s + 8 * fq);
        const bf16* vt = VTA + ((size_t)((b * 32 + c) * 12 + h * 2)) * 4096;
#pragma unroll
        for (int mi = 0; mi < 4; ++mi) {
            const bf16x8 q0 = *(const LAS bf16x8*)(qs + (16 * mi + fr) * RS + 8 * fq), q1 = *(const LAS bf16x8*)(qs + (16 * mi + fr) * RS + 32 + 8 * fq);
            f32x4 sc[4];
#pragma unroll
            for (int t = 0; t < 4; ++t) {
                sc[t] = (f32x4){0.f, 0.f, 0.f, 0.f};
                if (t <= mi) {
                    const bf16x8 k0 = *(const LAS bf16x8*)(ks + (16 * t + fr) * RS + 8 * fq), k1 = *(const LAS bf16x8*)(ks + (16 * t + fr) * RS + 32 + 8 * fq);
                    sc[t] = __builtin_amdgcn_mfma_f32_16x16x32_bf16(k0, q0, sc[t], 0, 0, 0);
                    sc[t] = __builtin_amdgcn_mfma_f32_16x16x32_bf16(k1, q1, sc[t], 0, 0, 0);
                    if (t == mi) {
                        sc[t].x = (4 * fq + 0 <= fr) ? sc[t].x : 0.f; sc[t].y = (4 * fq + 1 <= fr) ? sc[t].y : 0.f; sc[t].z = (4 * fq + 2 <= fr) ? sc[t].z : 0.f; sc[t].w = (4 * fq + 3 <= fr) ? sc[t].w : 0.f; }
                }
            }
            bf16x8 pf[2];
#pragma unroll
            for (int s = 0; s < 2; ++s) { u32x4 w; w.x = pk2(sc[2 * s].x, sc[2 * s].y); w.y = pk2(sc[2 * s].z, sc[2 * s].w); w.z = pk2(sc[2 * s + 1].x, sc[2 * s + 1].y); w.w = pk2(sc[2 * s + 1].z, sc[2 * s + 1].w);
                pf[s] = __builtin_bit_cast(bf16x8, w); }
            f32x4 o[8]; float ssq = 0.f;
#pragma unroll
            for (int n = 0; n < 8; ++n) {
                o[n] = (f32x4){0.f, 0.f, 0.f, 0.f};
                o[n] = __builtin_amdgcn_mfma_f32_16x16x32_bf16(st[n][0], q0, o[n], 0, 0, 0);
                o[n] = __builtin_amdgcn_mfma_f32_16x16x32_bf16(st[n][1], q1, o[n], 0, 0, 0);
                const bf16* vrow = vt + (size_t)(n >> 2) * 4096 + (16 * (n & 3) + fr) * 64 + 8 * fq;
                o[n] = __builtin_amdgcn_mfma_f32_16x16x32_bf16(*(const bf16x8*)vrow, pf[0], o[n], 0, 0, 0);
                if (mi >= 2) o[n] = __builtin_amdgcn_mfma_f32_16x16x32_bf16(*(const bf16x8*)(vrow + 32), pf[1], o[n], 0, 0, 0);
                ssq += (o[n].x * o[n].x + o[n].y * o[n].y) + (o[n].z * o[n].z + o[n].w * o[n].w);
            }
            ssq += __shfl_xor(ssq, 16); ssq += __shfl_xor(ssq, 32);
            const float rstd = rsqrtf(ssq * (1.f / 128.f) + EPS);
            const size_t tok = tok0 + 16 * mi + fr;
#pragma unroll
            for (int n = 0; n < 8; ++n) {
                const int dv = 16 * n + 4 * fq;
                const u32x2 rw = *(const u32x2*)(HY + tok * HYN + C_RB + h * 128 + dv); const f32x4 g = *(const f32x4*)(og + dv);
                const float r0 = bflo(rw.x), r1 = bfhi(rw.x), r2 = bflo(rw.y), r3 = bfhi(rw.y);
                u32x2 w; w.x = pk2(o[n].x * rstd * g.x * (r0 * sigmoidf_(r0)), o[n].y * rstd * g.y * (r1 * sigmoidf_(r1)));
                w.y = pk2(o[n].z * rstd * g.z * (r2 * sigmoidf_(r2)), o[n].w * rstd * g.w * (r3 * sigmoidf_(r3)));
                *(u32x2*)(CAT + tok * 1024 + 512 + h * 128 + dv) = w;
            }
        }
        LDS_WAIT();
        __syncthreads();
    }
}

__device__ __forceinline__ void phase_sgu_mix(KArgs A, int wv_, int i, LAS unsigned char* lds) {
    const int tid = opaque_tid(wv_), wid = __builtin_amdgcn_readfirstlane(tid >> 6), lane = tid & 63;
    unsigned char* ws = opq(A->ws);
    const bf16* U = (const bf16*)(ws + WS_U); const bf16* V = (const bf16*)(ws + WS_V); bf16* UM = (bf16*)(ws + WS_UM);
    LAS float* vt = (LAS float*)lds;
    LAS float* st = vt + 128 * 256;
    const float* lng = A->in[I_LNG] + i * 2048; const float* lnb = A->in[I_LNB] + i * 2048;
    for (int it = blockIdx.x; it < NBATCH * 16 * 8; it += gridDim.x) {
        const int g = it & 7, n = (it >> 3) & 15, b = it >> 7;
        const size_t tok0 = (size_t)b * S + n * 128;
        __syncthreads();
        for (int s = wid * 16; s < wid * 16 + 16; ++s) {
            const u32x4* vr = (const u32x4*)(V + (tok0 + s) * 2048) + lane;
            float x[32]; float sum = 0.f;
#pragma unroll
            for (int j = 0; j < 4; ++j) { const u32x4 w = vr[64 * j];
                x[8 * j + 0] = bflo(w.x); x[8 * j + 1] = bfhi(w.x); x[8 * j + 2] = bflo(w.y); x[8 * j + 3] = bfhi(w.y); x[8 * j + 4] = bflo(w.z); x[8 * j + 5] = bfhi(w.z); x[8 * j + 6] = bflo(w.w); x[8 * j + 7] = bfhi(w.w); }
#pragma unroll
            for (int j = 0; j < 32; ++j) sum += x[j];
            const float mean = wave_sum(sum) * (1.f / 2048.f); float q = 0.f;
#pragma unroll
            for (int j = 0; j < 32; ++j) { const float d = x[j] - mean; q += d * d; }
            const float rstd = rsqrtf(wave_sum(q) * (1.f / 2048.f) + EPS);
            const u32x2 w = *((const u32x2*)(V + (tok0 + s) * 2048 + g * 256) + lane);
            const f32x4 gg = *(const f32x4*)(lng + g * 256 + 4 * lane), bb = *(const f32x4*)(lnb + g * 256 + 4 * lane);
            f32x4 o; o.x = (bflo(w.x) - mean) * rstd * gg.x + bb.x; o.y = (bfhi(w.x) - mean) * rstd * gg.y + bb.y; o.z = (bflo(w.y) - mean) * rstd * gg.z + bb.z; o.w = (bfhi(w.y) - mean) * rstd * gg.w + bb.w;
            *(LAS f32x4*)(vt + s * 256 + 4 * lane) = o;
            (void)st;
        }
        __syncthreads();
        const int c = tid & 255, th = tid >> 8;
        const float* wsg = A->in[I_SGWS] + (size_t)(i * 8 + g) * 128 * 128; const float* bsg = A->in[I_SGBS] + (i * 8 + g) * 128;
        for (int tt = 0; tt < 64; ++tt) {
            const int t = 2 * tt + th;
            const float* wr = wsg + t * 128;
            float acc = 0.f;
            for (int s = 0; s <= t; ++s) acc += wr[s] * vt[s * 256 + c];
            acc += bsg[t];
            const float u = bf2f(U[(tok0 + t) * 2048 + g * 256 + c]);
            UM[(tok0 + t) * 2048 + g * 256 + c] = (bf16)f2bf(u * acc);
        }
    }
    __syncthreads();
}


__device__ __forceinline__ void phase_sgu_mix_mfma(KArgs A, int wv_, int i, LAS unsigned char* lds) {
    const int tid = opaque_tid(wv_), wid = __builtin_amdgcn_readfirstlane(tid >> 6), lane = tid & 63, fr = lane & 15, fq = lane >> 4;
    unsigned char* ws = opq(A->ws);
    const bf16* U = (const bf16*)(ws + WS_U); const bf16* V = (const bf16*)(ws + WS_V); bf16* UM = (bf16*)(ws + WS_UM);
    const bf16* WSB = (const bf16*)(ws + WS_WSB) + (size_t)i * 8 * 16384; const float* M0 = (const float*)(ws + WS_M0) + i * 8 * 128;
    constexpr int VS = 136;
    LAS bf16* vT = (LAS bf16*)lds;
    LAS float* st = (LAS float*)(lds + 256 * VS * 2);
    LAS bf16* wl = (LAS bf16*)(lds + 256 * VS * 2 + 1024);
    const float* lng = A->in[I_LNG] + i * 2048; const float* lnb = A->in[I_LNB] + i * 2048; const float* bsg = A->in[I_SGBS] + i * 8 * 128;
    for (int it = blockIdx.x; it < 256; it += gridDim.x) {
        const int gh = it & 1, n_ = (it >> 1) & 15, b = it >> 5; const size_t tok0 = (size_t)b * S + n_ * 128;
        __syncthreads();
        for (int s4 = wid * 16; s4 < wid * 16 + 16; s4 += 4) {
            u32x4 w[4][4];
#pragma unroll
            for (int rr = 0; rr < 4; ++rr) { const u32x4* vr = (const u32x4*)(V + (tok0 + s4 + rr) * 2048) + lane;
#pragma unroll
                for (int j = 0; j < 4; ++j) w[rr][j] = vr[64 * j]; }
#pragma unroll
            for (int rr = 0; rr < 4; ++rr) {
                float sum = 0.f, sq = 0.f;
#pragma unroll
                for (int j = 0; j < 4; ++j) { const float x0 = bflo(w[rr][j].x), x1 = bfhi(w[rr][j].x), x2 = bflo(w[rr][j].y), x3 = bfhi(w[rr][j].y), x4 = bflo(w[rr][j].z), x5 = bfhi(w[rr][j].z), x6 = bflo(w[rr][j].w), x7 = bfhi(w[rr][j].w);
                    sum += ((x0 + x1) + (x2 + x3)) + ((x4 + x5) + (x6 + x7)); sq += ((x0 * x0 + x1 * x1) + (x2 * x2 + x3 * x3)) + ((x4 * x4 + x5 * x5) + (x6 * x6 + x7 * x7)); }
                sum = wave_sum(sum); sq = wave_sum(sq);
                const float mean = sum * (1.f / 2048.f); const float var = fmaxf(sq * (1.f / 2048.f) - mean * mean, 0.f);
                if (lane == 0) { st[2 * (s4 + rr)] = mean; st[2 * (s4 + rr) + 1] = rsqrtf(var + EPS); }
            }
        }
#pragma unroll 1
        for (int gg = 0; gg < 4; ++gg) {
            const int g = gh * 4 + gg;
            __syncthreads();
            {
                const int s = tid & 127, cq = tid >> 7;
                const float mean = st[2 * s], rstd = st[2 * s + 1];
                const u32x4* src = (const u32x4*)(V + (tok0 + s) * 2048 + g * 256 + cq * 64);
                u32x4 w8[8], ww[4];
#pragma unroll
                for (int i8 = 0; i8 < 8; ++i8) w8[i8] = src[i8];
#pragma unroll
                for (int q = 0; q < 4; ++q) { const int e = tid + 512 * q; ww[q] = *(const u32x4*)(WSB + ((size_t)g * 128 + (e >> 4)) * 128 + (e & 15) * 8); }
#pragma unroll
                for (int i8 = 0; i8 < 8; ++i8) {
                    const u32x4 w = w8[i8];
                    LAS bf16* d = vT + (cq * 64 + i8 * 8) * VS + s;
                    d[0 * VS] = (bf16)f2bf((bflo(w.x) - mean) * rstd); d[1 * VS] = (bf16)f2bf((bfhi(w.x) - mean) * rstd); d[2 * VS] = (bf16)f2bf((bflo(w.y) - mean) * rstd); d[3 * VS] = (bf16)f2bf((bfhi(w.y) - mean) * rstd);
                    d[4 * VS] = (bf16)f2bf((bflo(w.z) - mean) * rstd); d[5 * VS] = (bf16)f2bf((bfhi(w.z) - mean) * rstd); d[6 * VS] = (bf16)f2bf((bflo(w.w) - mean) * rstd); d[7 * VS] = (bf16)f2bf((bfhi(w.w) - mean) * rstd);
                }
#pragma unroll
                for (int q = 0; q < 4; ++q) { const int e = tid + 512 * q; *(LAS u32x4*)(wl + (e >> 4) * VS + (e & 15) * 8) = ww[q]; }
            }
            u32x2 uw[8][2]; float m0v[8], bsv[8];
#pragma unroll
            for (int n = 0; n < 8; ++n) { const int t = 16 * n + fr; m0v[n] = M0[g * 128 + t]; bsv[n] = bsg[g * 128 + t];
                const size_t ro = (tok0 + t) * 2048 + g * 256 + 32 * wid + 4 * fq; uw[n][0] = *(const u32x2*)(U + ro); uw[n][1] = *(const u32x2*)(U + ro + 16); }
            __syncthreads();
            bf16x8 vf[2][4];
#pragma unroll
            for (int m = 0; m < 2; ++m)
#pragma unroll
                for (int k = 0; k < 4; ++k) vf[m][k] = *(const LAS bf16x8*)(vT + (32 * wid + 16 * m + fr) * VS + 32 * k + 8 * fq);
            f32x4 gc[2], bc[2];
#pragma unroll
            for (int m = 0; m < 2; ++m) { gc[m] = *(const f32x4*)(lng + g * 256 + 32 * wid + 16 * m + 4 * fq); bc[m] = *(const f32x4*)(lnb + g * 256 + 32 * wid + 16 * m + 4 * fq); }
#pragma unroll
            for (int n = 0; n < 8; ++n) {
                f32x4 a0 = (f32x4){0.f, 0.f, 0.f, 0.f}, a1 = (f32x4){0.f, 0.f, 0.f, 0.f};
#pragma unroll
                for (int k = 0; k < 4; ++k) if (k <= (n >> 1)) {
                    const bf16x8 wf = *(const LAS bf16x8*)(wl + (16 * n + fr) * VS + 32 * k + 8 * fq);
                    a0 = __builtin_amdgcn_mfma_f32_16x16x32_bf16(vf[0][k], wf, a0, 0, 0, 0);
                    a1 = __builtin_amdgcn_mfma_f32_16x16x32_bf16(vf[1][k], wf, a1, 0, 0, 0); }
                const int t = 16 * n + fr; const float m0 = m0v[n], bsv_ = bsv[n];
                const size_t ro = (tok0 + t) * 2048 + g * 256 + 32 * wid + 4 * fq;
#pragma unroll
                for (int m = 0; m < 2; ++m) {
                    const f32x4 a = m ? a1 : a0;
                    const u32x2 uw_ = uw[n][m];
                    u32x2 w; w.x = pk2((a.x * gc[m].x + bc[m].x * m0 + bsv_) * bflo(uw_.x), (a.y * gc[m].y + bc[m].y * m0 + bsv_) * bfhi(uw_.x));
                    w.y = pk2((a.z * gc[m].z + bc[m].z * m0 + bsv_) * bflo(uw_.y), (a.w * gc[m].w + bc[m].w * m0 + bsv_) * bfhi(uw_.y));
                    *(u32x2*)(UM + ro + 16 * m) = w;
                }
            }
        }
    }
    __syncthreads();
}

__device__ __forceinline__ void phase_rownorm(KArgs A, int wv_) {
    const int tid_ = opaque_tid(wv_); const int wid = __builtin_amdgcn_readfirstlane(tid_ >> 6), lane = tid_ & 63; const int gw = blockIdx.x * 8 + wid, NGW = gridDim.x * 8;
    bf16* XN = (bf16*)(opq(A->ws) + WS_XN); const float* X = A->out;
    f32x4 v[4], vn[4];
    if (gw < T) {
#pragma unroll
        for (int j = 0; j < 4; ++j) v[j] = ((const f32x4*)(X + (size_t)gw * D) + lane)[64 * j];
    }
    for (int m = gw; m < T; m += NGW) {
        const int mn = m + NGW < T ? m + NGW : m;
#pragma unroll
        for (int j = 0; j < 4; ++j) vn[j] = ((const f32x4*)(X + (size_t)mn * D) + lane)[64 * j];
        float s = 0.f;
#pragma unroll
        for (int j = 0; j < 4; ++j) s += (v[j].x * v[j].x + v[j].y * v[j].y) + (v[j].z * v[j].z + v[j].w * v[j].w);
        const float rstd = rsqrtf(wave_sum(s) * (1.f / 1024.f) + EPS);
        u32x2* o8 = (u32x2*)(XN + (size_t)m * D) + lane;
#pragma unroll
        for (int j = 0; j < 4; ++j) { u32x2 w; w.x = pk2(v[j].x * rstd, v[j].y * rstd); w.y = pk2(v[j].z * rstd, v[j].w * rstd); o8[64 * j] = w; }
#pragma unroll
        for (int j = 0; j < 4; ++j) v[j] = vn[j];
    }
}

__device__ __forceinline__ void phase_xattn(KArgs A, int wv_, int L, LAS unsigned char* lds) {
    const int tid = opaque_tid(wv_), wid = __builtin_amdgcn_readfirstlane(tid >> 6), lane = tid & 63;
    unsigned char* ws = opq(A->ws);
    const bf16* QX = (const bf16*)(ws + WS_QX); const bf16* KV = (const bf16*)(ws + WS_KV); bf16* OX = (bf16*)(ws + WS_OX);
    constexpr int KSTR = 129;
    LAS unsigned* kl = (LAS unsigned*)lds;
    LAS float* qb = (LAS float*)(lds + 132096) + wid * 256;
    LAS float* pb = (LAS float*)(lds + 132096 + 8192) + wid * 256;
    const float* qg = A->in[I_XQN] + L * 256;
    for (int it = blockIdx.x; it < NBATCH * 4 * 8; it += gridDim.x) {
        const int qc = it & 7, h = (it >> 3) & 3, b = it >> 5;
        __syncthreads();
        for (int e = tid; e < 256 * 128; e += 512) { const int m = e >> 7, dw = e & 127;
            kl[m * KSTR + dw] = *((const unsigned*)(KV + (size_t)(b * 256 + m) * 8192 + L * 2048 + h * 256) + dw); }
        __syncthreads();
        const bf16* Vb = KV + (size_t)(b * 256) * 8192 + L * 2048 + 1024 + h * 256;
        for (int tq = 0; tq < 32; ++tq) {
            const size_t tok = (size_t)b * S + qc * 256 + wid * 32 + tq;
            const u32x2 qw = *((const u32x2*)(QX + tok * 1024 + h * 256) + lane);
            const float q0 = bflo(qw.x), q1 = bfhi(qw.x), q2 = bflo(qw.y), q3 = bfhi(qw.y);
            const float rstd = rsqrtf(wave_sum(q0 * q0 + q1 * q1 + q2 * q2 + q3 * q3) * (1.f / 256.f) + EPS);
            const f32x4 gg = *(const f32x4*)(qg + 4 * lane);
            *(LAS f32x4*)(qb + 4 * lane) = (f32x4){q0 * rstd * gg.x, q1 * rstd * gg.y, q2 * rstd * gg.z, q3 * rstd * gg.w};
            LDS_WAIT();
            float s0 = 0.f, s1 = 0.f, s2 = 0.f, s3 = 0.f;
#pragma unroll 4
            for (int dw = 0; dw < 128; ++dw) {
                const f32x2 qq = *(const LAS f32x2*)(qb + 2 * dw);
                const unsigned k0 = kl[lane * KSTR + dw], k1 = kl[(lane + 64) * KSTR + dw], k2 = kl[(lane + 128) * KSTR + dw], k3 = kl[(lane + 192) * KSTR + dw];
                s0 += qq.x * bflo(k0) + qq.y * bfhi(k0); s1 += qq.x * bflo(k1) + qq.y * bfhi(k1);
                s2 += qq.x * bflo(k2) + qq.y * bfhi(k2); s3 += qq.x * bflo(k3) + qq.y * bfhi(k3);
            }
            const float mx = wave_max(fmaxf(fmaxf(s0, s1), fmaxf(s2, s3)));
            const float e0 = __expf(s0 - mx), e1 = __expf(s1 - mx), e2 = __expf(s2 - mx), e3 = __expf(s3 - mx);
            const float inv = 1.f / wave_sum((e0 + e1) + (e2 + e3));
            pb[lane] = e0 * inv; pb[lane + 64] = e1 * inv; pb[lane + 128] = e2 * inv; pb[lane + 192] = e3 * inv;
            LDS_WAIT();
            float o0 = 0.f, o1 = 0.f, o2 = 0.f, o3 = 0.f;
#pragma unroll 8
            for (int m = 0; m < 256; ++m) {
                const float p = pb[m];
                const u32x2 vw = *((const u32x2*)(Vb + (size_t)m * 8192) + lane);
                o0 += p * bflo(vw.x); o1 += p * bfhi(vw.x); o2 += p * bflo(vw.y); o3 += p * bfhi(vw.y);
            }
            u32x2 ow; ow.x = pk2(o0, o1); ow.y = pk2(o2, o3);
            *((u32x2*)(OX + tok * 1024 + h * 256) + lane) = ow;
            LDS_WAIT();
        }
    }
    __syncthreads();
}


__device__ __forceinline__ int kperm32(int p) { const int fq = (p >> 3) & 3, j = p & 7; return (p & ~31) + 16 * (j >> 2) + 4 * fq + (j & 3); }
__device__ __forceinline__ void phase_vtrans(KArgs A, int wv_, LAS unsigned char* lds) {
    const int tid = opaque_tid(wv_);
    unsigned char* ws = opq(A->ws);
    const bf16* KV = (const bf16*)(ws + WS_KV); bf16* VT = (bf16*)(ws + WS_VT);
    LAS bf16* vt = (LAS bf16*)lds;
    constexpr int VS = 258;
    for (int it = blockIdx.x; it < DEPTH * NBATCH * 4; it += gridDim.x) {
        const int h = it & 3, b = (it >> 2) & 7, l = it >> 5;
        __syncthreads();
        for (int e = tid; e < 256 * 32; e += 512) { const int m = e >> 5, c8 = e & 31;
            const u32x4 w = *(const u32x4*)(KV + (size_t)(b * 256 + m) * 8192 + l * 2048 + 1024 + h * 256 + c8 * 8);
            LAS unsigned* d = (LAS unsigned*)(vt + m * VS + c8 * 8); d[0] = w.x; d[1] = w.y; d[2] = w.z; d[3] = w.w; }
        __syncthreads();
        for (int e = tid; e < 256 * 32; e += 512) { const int dv = e & 255, p8 = e >> 8;
            unsigned short x[8];
#pragma unroll
            for (int j = 0; j < 8; ++j) x[j] = vt[kperm32(p8 * 8 + j) * VS + dv];
            u32x4 o; o.x = x[0] | ((unsigned)x[1] << 16); o.y = x[2] | ((unsigned)x[3] << 16); o.z = x[4] | ((unsigned)x[5] << 16); o.w = x[6] | ((unsigned)x[7] << 16);
            *(u32x4*)(VT + ((size_t)it * 256 + dv) * 256 + p8 * 8) = o; }
    }
    __syncthreads();
}

__device__ __forceinline__ void phase_xattn_mfma(KArgs A, int wv_, int L, LAS unsigned char* lds) {
    const int tid = opaque_tid(wv_), wid = __builtin_amdgcn_readfirstlane(tid >> 6), lane = tid & 63, fr = lane & 15, fq = lane >> 4;
    unsigned char* ws = opq(A->ws);
    const bf16* QX = (const bf16*)(ws + WS_QX); const bf16* KV = (const bf16*)(ws + WS_KV); const bf16* VT = (const bf16*)(ws + WS_VT); bf16* OX = (bf16*)(ws + WS_OX);
    constexpr int RS = 264;
    LAS bf16* kl = (LAS bf16*)lds;
    const float* qg = A->in[I_XQN] + L * 256;
    for (int it = blockIdx.x; it < NBATCH * 4 * 8; it += gridDim.x) {
        const int qt = it & 7, h = (it >> 3) & 3, b = it >> 5;
        __syncthreads();
        {
            const int row = tid >> 1, hf = tid & 1;
            const u32x4* src = (const u32x4*)(KV + (size_t)(b * 256 + row) * 8192 + L * 2048 + h * 256 + hf * 128);
#pragma unroll
            for (int i0 = 0; i0 < 16; i0 += 8) {
                u32x4 w[8];
#pragma unroll
                for (int i = 0; i < 8; ++i) w[i] = src[i0 + i];
#pragma unroll
                for (int i = 0; i < 8; ++i) *(LAS u32x4*)(kl + row * RS + hf * 128 + (i0 + i) * 8) = w[i];
            }
        }
        const size_t tok0 = (size_t)b * S + qt * 256 + wid * 32 + fr;
        u32x4 qw0[8], qw1[8];
#pragma unroll
        for (int s = 0; s < 8; ++s) { qw0[s] = *(const u32x4*)(QX + tok0 * 1024 + h * 256 + 32 * s + 8 * fq); qw1[s] = *(const u32x4*)(QX + (tok0 + 16) * 1024 + h * 256 + 32 * s + 8 * fq); }
        __syncthreads();
        bf16x8 pf0[8], pf1[8]; float inv0, inv1;
        auto s_part = [&](const u32x4 (&qw)[8], bf16x8 (&pf)[8], float& inv) __attribute__((always_inline)) {
            float ssq = 0.f;
#pragma unroll
            for (int s = 0; s < 8; ++s) {
                const float a0 = bflo(qw[s].x), a1 = bfhi(qw[s].x), a2 = bflo(qw[s].y), a3 = bfhi(qw[s].y), a4 = bflo(qw[s].z), a5 = bfhi(qw[s].z), a6 = bflo(qw[s].w), a7 = bfhi(qw[s].w);
                ssq += (a0 * a0 + a1 * a1) + (a2 * a2 + a3 * a3) + (a4 * a4 + a5 * a5) + (a6 * a6 + a7 * a7);
            }
            ssq += __shfl_xor(ssq, 16); ssq += __shfl_xor(ssq, 32);
            const float rstd = rsqrtf(ssq * (1.f / 256.f) + EPS);
            bf16x8 qf[8];
#pragma unroll
            for (int s = 0; s < 8; ++s) qf[s] = __builtin_bit_cast(bf16x8, qw[s]);
            f32x4 sc[16];
#pragma unroll
            for (int hf = 0; hf < 2; ++hf) {
                unsigned kb = (unsigned)(size_t)(kl + (128 * hf + fr) * RS + 8 * fq); asm volatile("" : "+v"(kb));
#pragma unroll
                for (int t8 = 0; t8 < 8; ++t8) { const int t = 8 * hf + t8; sc[t] = (f32x4){0.f, 0.f, 0.f, 0.f};
#pragma unroll
                    for (int s = 0; s < 8; ++s) { const bf16x8 kf = *(const LAS bf16x8*)(size_t)(kb + (unsigned)((16 * t8 * RS + 32 * s) * 2));
                        sc[t] = __builtin_amdgcn_mfma_f32_16x16x32_bf16(kf, qf[s], sc[t], 0, 0, 0); }
                    if (t & 1) asm volatile("" ::: "memory"); }
            }
            float mx = -INFINITY;
#pragma unroll
            for (int t = 0; t < 16; ++t) mx = fmaxf(mx, fmaxf(fmaxf(sc[t].x, sc[t].y), fmaxf(sc[t].z, sc[t].w)));
            mx = fmaxf(mx, __shfl_xor(mx, 16)); mx = fmaxf(mx, __shfl_xor(mx, 32));
            float lsum = 0.f;
#pragma unroll
            for (int t = 0; t < 16; ++t) { sc[t].x = __expf((sc[t].x - mx) * rstd); sc[t].y = __expf((sc[t].y - mx) * rstd); sc[t].z = __expf((sc[t].z - mx) * rstd); sc[t].w = __expf((sc[t].w - mx) * rstd); lsum += (sc[t].x + sc[t].y) + (sc[t].z + sc[t].w); }
            lsum += __shfl_xor(lsum, 16); lsum += __shfl_xor(lsum, 32);
            inv = 1.f / lsum;
#pragma unroll
            for (int s = 0; s < 8; ++s) { u32x4 w; w.x = pk2(sc[2 * s].x, sc[2 * s].y); w.y = pk2(sc[2 * s].z, sc[2 * s].w); w.z = pk2(sc[2 * s + 1].x, sc[2 * s + 1].y); w.w = pk2(sc[2 * s + 1].z, sc[2 * s + 1].w);
                pf[s] = __builtin_bit_cast(bf16x8, w); }
        };
        s_part(qw0, pf0, inv0);
        s_part(qw1, pf1, inv1);
        __syncthreads();
        {
            const int row = tid >> 1, hf = tid & 1;
            const u32x4* src = (const u32x4*)(VT + ((size_t)((L * 8 + b) * 4 + h) * 256 + row) * 256 + hf * 128);
#pragma unroll
            for (int i0 = 0; i0 < 16; i0 += 8) {
                u32x4 w[8];
#pragma unroll
                for (int i = 0; i < 8; ++i) w[i] = src[i0 + i];
#pragma unroll
                for (int i = 0; i < 8; ++i) *(LAS u32x4*)(kl + row * RS + hf * 128 + (i0 + i) * 8) = w[i];
            }
        }
        __syncthreads();
#pragma unroll
        for (int hf = 0; hf < 2; ++hf) {
            unsigned vb = (unsigned)(size_t)(kl + (128 * hf + fr) * RS + 8 * fq); asm volatile("" : "+v"(vb));
#pragma unroll
            for (int n8 = 0; n8 < 8; ++n8) { const int n = 8 * hf + n8; f32x4 o0 = (f32x4){0.f, 0.f, 0.f, 0.f}, o1 = o0;
#pragma unroll
                for (int s = 0; s < 8; ++s) { const bf16x8 vf = *(const LAS bf16x8*)(size_t)(vb + (unsigned)((16 * n8 * RS + 32 * s) * 2));
                    o0 = __builtin_amdgcn_mfma_f32_16x16x32_bf16(vf, pf0[s], o0, 0, 0, 0);
                    o1 = __builtin_amdgcn_mfma_f32_16x16x32_bf16(vf, pf1[s], o1, 0, 0, 0); }
                u32x2 w0, w1; w0.x = pk2(o0.x * inv0, o0.y * inv0); w0.y = pk2(o0.z * inv0, o0.w * inv0); w1.x = pk2(o1.x * inv1, o1.y * inv1); w1.y = pk2(o1.z * inv1, o1.w * inv1);
                *(u32x2*)(OX + tok0 * 1024 + h * 256 + 16 * n + 4 * fq) = w0;
                *(u32x2*)(OX + (tok0 + 16) * 1024 + h * 256 + 16 * n + 4 * fq) = w1;
                if (n & 1) asm volatile("" ::: "memory"); }
        }
    }
    __syncthreads();
}

__device__ __forceinline__ void phase_route(KArgs A, int wv_, int L, LAS unsigned char* lds) {
    const int tid_ = opaque_tid(wv_); const int wid = __builtin_amdgcn_readfirstlane(tid_ >> 6), lane = tid_ & 63;
    unsigned char* ws = opq(A->ws);
    const float* RW = (const float*)(ws + WS_RW) + (size_t)L * NEXP * D;
    unsigned* cnt = (unsigned*)(ws + WS_CTL) + CW_CNT + L * 64;
    int* list = (int*)(ws + WS_LIST); int* te = (int*)(ws + WS_TOK); int* tp = te + 2 * T; float* tw = (float*)(tp + 2 * T);
    bf16* XN = (bf16*)(ws + WS_XN);
    LAS float* rwl = (LAS float*)lds;
    LAS unsigned* lcnt = (LAS unsigned*)(lds + 65536);
    LAS unsigned* lbase = lcnt + 16;
    const float rbv = A->in[I_RB][lane >> 2];
    for (int e4 = tid_; e4 < NEXP * D / 4; e4 += 512) *(LAS f32x4*)(rwl + 4 * e4) = *(const f32x4*)(RW + 4 * e4);
    for (int blk = blockIdx.x; blk < T / 64; blk += gridDim.x) {
        __syncthreads();
        if (tid_ < 16) lcnt[tid_] = 0u;
        __syncthreads();
        int e0s = 0, e1s = 0, r0s = 0, r1s = 0; float w0s = 0.f;
        f32x4 v[4], vn[4];
#pragma unroll
        for (int j = 0; j < 4; ++j) v[j] = ((const f32x4*)(A->out + (size_t)(blk * 64 + wid * 8) * D) + lane)[64 * j];
#pragma unroll 1
        for (int q = 0; q < 8; ++q) {
            const int t = blk * 64 + wid * 8 + q;
            { const f32x4* xn_ = (const f32x4*)(A->out + (size_t)(t + (q < 7 ? 1 : 0)) * D) + lane;
#pragma unroll
              for (int j = 0; j < 4; ++j) vn[j] = xn_[64 * j]; }
            float s = 0.f;
#pragma unroll
            for (int j = 0; j < 4; ++j) s += (v[j].x * v[j].x + v[j].y * v[j].y) + (v[j].z * v[j].z + v[j].w * v[j].w);
            const float rstd = rsqrtf(wave_sum(s) * (1.f / 1024.f) + EPS);
            u32x2* o8 = (u32x2*)(XN + (size_t)t * D) + lane;
#pragma unroll
            for (int j = 0; j < 4; ++j) { u32x2 w; w.x = pk2(v[j].x * rstd, v[j].y * rstd); w.y = pk2(v[j].z * rstd, v[j].w * rstd); o8[64 * j] = w; }
            float a[16];
#pragma unroll
            for (int e = 0; e < 16; ++e) {
                const LAS f32x4* wr = (const LAS f32x4*)(rwl + e * D) + lane; float acc = 0.f;
#pragma unroll
                for (int j = 0; j < 4; ++j) { const f32x4 w = wr[64 * j]; acc += (v[j].x * w.x + v[j].y * w.y) + (v[j].z * w.z + v[j].w * w.w); }
                a[e] = acc;
            }
            float a8[8], a4[4], a2[2], a1;
            { const bool up = lane & 32;
#pragma unroll
              for (int k = 0; k < 8; ++k) { const float send = up ? a[k] : a[k + 8], keep = up ? a[k + 8] : a[k]; a8[k] = keep + __shfl_xor(send, 32); } }
            { const bool up = lane & 16;
#pragma unroll
              for (int k = 0; k < 4; ++k) { const float send = up ? a8[k] : a8[k + 4], keep = up ? a8[k + 4] : a8[k]; a4[k] = keep + __shfl_xor(send, 16); } }
            { const bool up = lane & 8;
#pragma unroll
              for (int k = 0; k < 2; ++k) { const float send = up ? a4[k] : a4[k + 2], keep = up ? a4[k + 2] : a4[k]; a2[k] = keep + __shfl_xor(send, 8); } }
            { const bool up = lane & 4; const float send = up ? a2[0] : a2[1], keep = up ? a2[1] : a2[0]; a1 = keep + __shfl_xor(send, 4); }
            a1 += __shfl_xor(a1, 2); a1 += __shfl_xor(a1, 1);
            const float lg = a1 * rstd + rbv;
            const float v0 = wave_max(lg);
            const int e0 = (__ffsll((unsigned long long)__ballot(lg == v0)) - 1) >> 2;
            const int gidx = e0 >> 2;
            const bool c2 = (lane >> 4) == gidx && (lane >> 2) != e0;
            const float m2 = c2 ? lg : -INFINITY;
            const float v1 = wave_max(m2);
            const int e1 = (__ffsll((unsigned long long)__ballot(c2 && m2 == v1)) - 1) >> 2;
            const float w0 = 1.f / (1.f + __expf(v1 - v0));
            unsigned r0 = 0, r1 = 0;
            if (lane == 0) { r0 = atomicAdd((unsigned*)(lcnt + e0), 1u); r1 = atomicAdd((unsigned*)(lcnt + e1), 1u); }
            r0 = __builtin_amdgcn_readfirstlane(r0); r1 = __builtin_amdgcn_readfirstlane(r1);
            if (lane == q) { e0s = e0; e1s = e1; r0s = (int)r0; r1s = (int)r1; w0s = w0; }
#pragma unroll
            for (int j = 0; j < 4; ++j) v[j] = vn[j];
        }
        __syncthreads();
        if (tid_ < 16) lbase[tid_] = atomicAdd(&cnt[tid_], lcnt[tid_]);
        __syncthreads();
        if (lane < 8) {
            const int t = blk * 64 + wid * 8 + lane;
            const int p0 = (int)lbase[e0s] + r0s, p1 = (int)lbase[e1s] + r1s;
            list[e0s * T + p0] = t; list[e1s * T + p1] = t;
            te[2 * t] = e0s; te[2 * t + 1] = e1s; tp[2 * t] = p0; tp[2 * t + 1] = p1; tw[2 * t] = w0s; tw[2 * t + 1] = 1.f - w0s;
        }
    }
    __syncthreads();
}
__device__ __forceinline__ void moe_offsets(KArgs A, int wv_, int L, LAS int* off, LAS int* cn) {
    if (opaque_tid(wv_) == 0) {
        const unsigned* cnt = (const unsigned*)(opq(A->ws) + WS_CTL) + CW_CNT + L * 64;
        int o = 0;
        for (int e = 0; e < 16; ++e) { const int c = (int)__hip_atomic_load(cnt + e, __ATOMIC_RELAXED, __HIP_MEMORY_SCOPE_AGENT); off[e] = o; cn[e] = c; o += (c + 255) & ~255; }
        off[16] = o;
    }
    __syncthreads();
}
__device__ __forceinline__ void phase_moe_combine(KArgs A, int wv_, int L, LAS unsigned char* lds) {
    LAS int* off = (LAS int*)lds; LAS int* cn = off + 32;
    moe_offsets(A, wv_, L, off, cn);
    const int tid_ = opaque_tid(wv_); const int wid = __builtin_amdgcn_readfirstlane(tid_ >> 6), lane = tid_ & 63; const int gw = blockIdx.x * 8 + wid, NGW = gridDim.x * 8;
    unsigned char* ws = opq(A->ws);
    const int* te = (const int*)(ws + WS_TOK); const int* tp = te + 2 * T; const float* tw = (const float*)(tp + 2 * T);
    const bf16* Y = (const bf16*)(ws + WS_Y); bf16* XN = (bf16*)(ws + WS_XN);
    const int nq = (T - gw + NGW - 1) / NGW;
    for (int q0 = 0; q0 < nq; q0 += 8) {
        int s0m = 0, s1m = 0; float w0m = 0.f, w1m = 0.f;
        { const int qq = q0 + (lane & 7); const int t = gw + NGW * (qq < nq ? qq : nq - 1);
          s0m = off[te[2 * t]] + tp[2 * t]; s1m = off[te[2 * t + 1]] + tp[2 * t + 1]; w0m = tw[2 * t]; w1m = tw[2 * t + 1]; }
        const int nn = nq - q0 < 8 ? nq - q0 : 8;
        f32x4 v[4], vn[4]; u32x2 ya[4], yb[4], yan[4], ybn[4];
        { const int t = gw + NGW * q0; const int sl0 = __builtin_amdgcn_readlane(s0m, 0), sl1 = __builtin_amdgcn_readlane(s1m, 0);
#pragma unroll
          for (int j = 0; j < 4; ++j) { v[j] = ((const f32x4*)(A->out + (size_t)t * D) + lane)[64 * j]; ya[j] = ((const u32x2*)(Y + (size_t)sl0 * D) + lane)[64 * j]; yb[j] = ((const u32x2*)(Y + (size_t)sl1 * D) + lane)[64 * j]; } }
#pragma unroll 1
        for (int q = 0; q < nn; ++q) {
            const int t = gw + NGW * (q0 + q);
            const int qn = q + 1 < nn ? q + 1 : q;
            { const int tn = gw + NGW * (q0 + qn); const int sl0 = __builtin_amdgcn_readlane(s0m, qn), sl1 = __builtin_amdgcn_readlane(s1m, qn);
#pragma unroll
              for (int j = 0; j < 4; ++j) { vn[j] = ((const f32x4*)(A->out + (size_t)tn * D) + lane)[64 * j]; yan[j] = ((const u32x2*)(Y + (size_t)sl0 * D) + lane)[64 * j]; ybn[j] = ((const u32x2*)(Y + (size_t)sl1 * D) + lane)[64 * j]; } }
            const float w0 = __builtin_bit_cast(float, __builtin_amdgcn_readlane(__builtin_bit_cast(int, w0m), q)), w1 = __builtin_bit_cast(float, __builtin_amdgcn_readlane(__builtin_bit_cast(int, w1m), q));
            float s = 0.f;
#pragma unroll
            for (int j = 0; j < 4; ++j) {
                v[j].x += w0 * bflo(ya[j].x) + w1 * bflo(yb[j].x); v[j].y += w0 * bfhi(ya[j].x) + w1 * bfhi(yb[j].x); v[j].z += w0 * bflo(ya[j].y) + w1 * bflo(yb[j].y); v[j].w += w0 * bfhi(ya[j].y) + w1 * bfhi(yb[j].y);
                s += (v[j].x * v[j].x + v[j].y * v[j].y) + (v[j].z * v[j].z + v[j].w * v[j].w);
            }
            const float rstd = rsqrtf(wave_sum(s) * (1.f / 1024.f) + EPS);
            f32x4* xr = (f32x4*)(A->out + (size_t)t * D) + lane; u32x2* o8 = (u32x2*)(XN + (size_t)t * D) + lane;
#pragma unroll
            for (int j = 0; j < 4; ++j) { xr[64 * j] = v[j]; u32x2 w; w.x = pk2(v[j].x * rstd, v[j].y * rstd); w.y = pk2(v[j].z * rstd, v[j].w * rstd); o8[64 * j] = w; }
#pragma unroll
            for (int j = 0; j < 4; ++j) { v[j] = vn[j]; ya[j] = yan[j]; yb[j] = ybn[j]; }
        }
    }
}

constexpr int PH_PER_EVEN = 5 + 7, PH_PER_ODD = 3 + 7;
constexpr int NPHASES = 1 + 2 * (PH_PER_EVEN + PH_PER_ODD);

__global__ void __launch_bounds__(512, 2) mk_fwd(Args Araw) {
    KArgs A0 = kargs();
    extern __shared__ __attribute__((aligned(16))) unsigned char lds_raw[];
    LAS unsigned char* lds = (LAS unsigned char*)lds_raw;
    volatile LAS unsigned* misc = (volatile LAS unsigned*)(lds + LDS_MISC);
    const int tid = threadIdx.x;
    if (tid < 16) misc[tid] = 0u;
    __syncthreads();
    const int lo = A0->ph_lo, hi = A0->ph_hi;
    const int wv_ = __builtin_amdgcn_readfirstlane(threadIdx.x >> 6);
    if (hi - lo > 1) (void)xcd_barrier_post((unsigned*)(A0->ws + WS_CTL) + CW_BAR, misc);
    int ph = 0;
    unsigned long long tacc_ = 0;
#define PH_BEGIN(k) if (ph >= lo && ph < hi) { const bool tprobe_ = (PROBE_TMASK >> (k)) & 1; unsigned long long tp0_ = 0; if (PROBE_TMASK && tprobe_) tp0_ = __builtin_amdgcn_s_memrealtime(); KArgs A = kargs(); unsigned char* ws = opq(A->ws); _Pragma("unroll 1") for (int rep_ = 0; rep_ < (((PROBE_MASK >> (k)) & 1) ? PROBE_REPS : 1); ++rep_)
#define PH_END   if (ph + 1 < hi) { XcdBarrier b_; b_.bar = (unsigned*)(opq(kargs()->ws) + WS_CTL) + CW_BAR; b_.x = xb_xcc_id(); b_.st = misc; xcd_barrier(b_, opaque_tid(wv_) == 0); } if (PROBE_TMASK && tprobe_) tacc_ += __builtin_amdgcn_s_memrealtime() - tp0_; } ++ph;
    const int G = gridDim.x, cb = blockIdx.x;

    PH_BEGIN(0) phase_prologue(A, wv_, lds); PH_END
    for (int L = 0; L < DEPTH; ++L) {
        const int i = L >> 1;
        if ((L & 1) == 0) {
            PH_BEGIN(3) {
                if (L == 0) {
                    pg8::DenseOrder S; S.init(NBATCH * NMEM, 8192, D, (const bf16*)(ws + WS_WKV), G, cb);
                    pg8::EpiBf16<0> E{(bf16*)(ws + WS_KV), 8192, 32, 0};
                    pg8::gemm_phase(lds, (const bf16*)(ws + WS_MN), D, S, E, wv_);
                }
                pg8::DenseOrder S; S.init(T, HYN, D, (const bf16*)(ws + WS_WHYB) + (size_t)i * HYN * D, G, cb);
                pg8::EpiBf16<0> E{(bf16*)(ws + WS_BIG), HYN, 12, 0};
                pg8::gemm_phase(lds, (const bf16*)(ws + WS_XN), D, S, E, wv_);
            } PH_END
            PH_BEGIN(4) { if (L == 0) { phase_knorm(A, wv_); phase_vtrans(A, wv_, lds); } phase_compress_mfma(A, wv_, i, lds); phase_nsa_prep(A, wv_, i, lds); phase_vtiles(A, wv_, lds); } PH_END
            PH_BEGIN(5) { phase_gla_a(A, wv_, i, lds); __syncthreads(); phase_nsa_attn_mfma(A, wv_, i, lds); } PH_END
            PH_BEGIN(6) phase_gla_c(A, wv_, i, lds); PH_END
            PH_BEGIN(7) {
                pg8::DenseOrder S; S.init(T, D, D, (const bf16*)(ws + WS_WHOUT) + (size_t)i * D * D, G, cb);
                pg8::EpiResAddNorm E{A->out, D, (bf16*)(ws + WS_XN), (float*)(ws + WS_ROWSQ)};
                pg8::gemm_phase(lds, (const bf16*)(ws + WS_CAT), D, S, E, wv_);
            } PH_END
        } else {
            PH_BEGIN(8) {
                pg8::DenseOrder S; S.init(T, 4096, D, (const bf16*)(ws + WS_WSGIN) + (size_t)i * 4096 * D, G, cb);
                pg8::EpiBf16<1> E{(bf16*)(ws + WS_U), 2048, 8, (size_t)(WS_V - WS_U) / 2};
                pg8::gemm_phase(lds, (const bf16*)(ws + WS_XN), D, S, E, wv_);
            } PH_END
            PH_BEGIN(9) phase_sgu_mix_mfma(A, wv_, i, lds); PH_END
            PH_BEGIN(10) {
                pg8::DenseOrder S; S.init(T, D, 2048, (const bf16*)(ws + WS_WSGOUT) + (size_t)i * D * 2048, G, cb);
                pg8::EpiResAddNorm E{A->out, D, (bf16*)(ws + WS_XN), (float*)(ws + WS_ROWSQ)};
                pg8::gemm_phase(lds, (const bf16*)(ws + WS_UM), 2048, S, E, wv_);
            } PH_END
        }
        PH_BEGIN(12) {
            pg8::DenseOrder S; S.init(T, D, D, (const bf16*)(ws + WS_WQ) + (size_t)L * D * D, G, cb);
            pg8::EpiBf16RowScale E{(bf16*)(ws + WS_QX), D, (const float*)(ws + WS_ROWSQ)};
            pg8::gemm_phase(lds, (const bf16*)(ws + WS_XN), D, S, E, wv_);
        } PH_END
        PH_BEGIN(13) phase_xattn_mfma(A, wv_, L, lds); PH_END
        PH_BEGIN(14) {
            pg8::DenseOrder S; S.init(T, D, D, (const bf16*)(ws + WS_WO) + (size_t)L * D * D, G, cb);
            pg8::EpiResAdd E{A->out, D};
            pg8::gemm_phase(lds, (const bf16*)(ws + WS_OX), D, S, E, wv_);
        } PH_END
        PH_BEGIN(15) phase_route(A, wv_, L, lds); PH_END
        PH_BEGIN(16) {
            LAS int* off = (LAS int*)(lds + pg8::STAGE_BYTES); LAS int* cn = off + 32;
            moe_offsets(A, wv_, L, off, cn);
            pg8::MoeOrder<true> S{(off[16] / 256) * 3, 3, G, cb, D, off, cn, (const int*)(ws + WS_LIST), (const char*)(ws + WS_WMIN) + (size_t)L * 16 * 768 * D * 2, (size_t)768 * D * 2};
            pg8::EpiSwiglu E{(bf16*)(ws + WS_H), DEXP};
            pg8::gemm_phase(lds, (const bf16*)(ws + WS_XN), D, S, E, wv_);
        } PH_END
        PH_BEGIN(17) {
            LAS int* off = (LAS int*)(lds + pg8::STAGE_BYTES); LAS int* cn = off + 32;
            moe_offsets(A, wv_, L, off, cn);
            pg8::MoeOrder<false> S{(off[16] / 256) * 4, 4, G, cb, DEXP, off, cn, (const int*)(ws + WS_LIST), (const char*)(ws + WS_WMOUT) + (size_t)L * 16 * D * DEXP * 2, (size_t)D * DEXP * 2};
            pg8::EpiBf16<0> E{(bf16*)(ws + WS_Y), D, 4, 0};
            pg8::gemm_phase(lds, (const bf16*)(ws + WS_H), DEXP, S, E, wv_);
        } PH_END
        PH_BEGIN(18) phase_moe_combine(A, wv_, L, lds); PH_END
    }
#undef PH_BEGIN
#undef PH_END
    if (PROBE_TMASK && blockIdx.x == 0) { const unsigned long long t0 = __builtin_amdgcn_s_memrealtime(); while (__builtin_amdgcn_s_memrealtime() - t0 < tacc_) __builtin_amdgcn_s_sleep(8); }
}

extern "C" void kernel_launch(void* const* d_in, const int* in_sizes, int n_in, void* d_out, int out_size, void* d_ws, size_t ws_size, hipStream_t stream) {
    static int grid = 0;
    if (grid == 0) {
        if (n_in != N_IN || out_size != T * D || ws_size < WS_END) { fprintf(stderr, "kernel_launch: unexpected problem (n_in %d, out %d, ws %zu)\n", n_in, out_size, ws_size); grid = -1; return; }
        int dev = 0, cus = 0, per_cu = 0;
        if (hipGetDevice(&dev) != hipSuccess || hipDeviceGetAttribute(&cus, hipDeviceAttributeMultiprocessorCount, dev) != hipSuccess) { grid = -1; return; }
        if (hipFuncSetAttribute((const void*)mk_fwd, hipFuncAttributeMaxDynamicSharedMemorySize, LDS_BYTES) != hipSuccess) { fprintf(stderr, "kernel_launch: hipFuncSetAttribute failed\n"); grid = -1; return; }
        if (hipOccupancyMaxActiveBlocksPerMultiprocessor(&per_cu, (const void*)mk_fwd, 512, LDS_BYTES) != hipSuccess || per_cu < 1) fprintf(stderr, "kernel_launch: occupancy query says %d\n", per_cu);
        (void)hipGetLastError();
        grid = cus;
    }
    if (grid < 0) return;
    (void)hipMemsetAsync((char*)d_ws + WS_CTL, 0, CTL_BYTES, stream);
    Args a{};
    for (int i = 0; i < N_IN; ++i) a.in[i] = (const float*)d_in[i];
    a.out = (float*)d_out; a.ws = (unsigned char*)d_ws;
    for (int j = 0; j < 32; ++j) a.freq[j] = (float)pow(10000.0, -(double)j / 32.0);
#if MK_ONE_LAUNCH
    a.ph_lo = 0; a.ph_hi = NPHASES;
    hipLaunchKernelGGL(mk_fwd, dim3(grid), dim3(512), LDS_BYTES, stream, a);
#else
    for (int p = 0; p < NPHASES; ++p) { a.ph_lo = p; a.ph_hi = p + 1; hipLaunchKernelGGL(mk_fwd, dim3(grid), dim3(512), LDS_BYTES, stream, a); }
#endif
}
```

```cpp
#include <hip/hip_runtime.h>
#include <stdint.h>
#include <stdio.h>
#include <math.h>

#ifndef PROBE_MASK
#define PROBE_MASK 0
#endif
#ifndef PROBE_TMASK
#define PROBE_TMASK 0
#endif
#ifndef PROBE_NSA
#define PROBE_NSA 0
#endif
#ifndef PROBE_SUB
#define PROBE_SUB 0
#endif
#ifndef PROBE_REPS
#define PROBE_REPS 2
#endif
#ifndef MK_ONE_LAUNCH
#define MK_ONE_LAUNCH 1
#endif

#define LAS __attribute__((address_space(3)))
typedef unsigned short bf16;
typedef short bf16x8 __attribute__((ext_vector_type(8)));
typedef float f32x4 __attribute__((ext_vector_type(4)));
typedef float f32x2 __attribute__((ext_vector_type(2)));
typedef unsigned u32x4 __attribute__((ext_vector_type(4)));
typedef unsigned u32x2 __attribute__((ext_vector_type(2)));

constexpr int T = 16384, D = 1024, NBATCH = 8, S = 2048, DEPTH = 4;
constexpr int NMEM = 256;
constexpr float EPS = 1e-6f;
constexpr int HYN = 3072, HYSRC = 2856;
constexpr int C_QA = 0, C_KC = 512, C_VC = 640, C_KS = 768, C_VS = 896, C_KW = 1024, C_VW = 1152, C_QB = 1280, C_KB = 1536, C_VB = 1792, C_RB = 2304, C_GA = 2816, C_AL = 2840;
constexpr int NCMP = 127;
constexpr int NEXP = 16, DEXP = 384;
constexpr int SLOTS = 2 * T + NEXP * 256;

enum { I_X = 0, I_MEM, I_POS, I_NMIX, I_NXAT, I_NMEM, I_NFFN, I_HYBIN, I_HYBOUT, I_QNORM, I_KNORM, I_CMPPE, I_CMPW1, I_CMPW2, I_GATEB, I_WA2, I_BA, I_ONORM,
       I_SGIN, I_LNG, I_LNB, I_SGWS, I_SGBS, I_SGOUT, I_XWQ, I_XWKV, I_XWO, I_XQN, I_XKN, I_RW, I_RB, I_MOEIN, I_MOEOUT, N_IN };

constexpr size_t MiB = 1u << 20;
constexpr size_t WS_CTL = 0, CTL_BYTES = 1 * MiB;
constexpr size_t WS_WHYB = 1 * MiB;
constexpr size_t WS_WHOUT = WS_WHYB + 12 * MiB;
constexpr size_t WS_WSGIN = WS_WHOUT + 4 * MiB;
constexpr size_t WS_WSGOUT = WS_WSGIN + 16 * MiB;
constexpr size_t WS_WQ = WS_WSGOUT + 8 * MiB;
constexpr size_t WS_WKV = WS_WQ + 8 * MiB;
constexpr size_t WS_WO = WS_WKV + 16 * MiB;
constexpr size_t WS_WMIN = WS_WO + 8 * MiB;
constexpr size_t WS_WMOUT = WS_WMIN + 96 * MiB;
constexpr size_t WS_RW = WS_WMOUT + 48 * MiB;
constexpr size_t WS_XN = WS_RW + 1 * MiB;
constexpr size_t WS_BIG = WS_XN + 32 * MiB;
constexpr size_t WS_QA = WS_BIG + 128 * MiB;
constexpr size_t WS_KS = WS_QA + 16 * MiB;
constexpr size_t WS_KW = WS_KS + 4 * MiB;
constexpr size_t WS_KC = WS_KW + 4 * MiB;
constexpr size_t WS_VC = WS_KC + 1 * MiB;
constexpr size_t WS_CAT = WS_VC + 1 * MiB;
constexpr size_t WS_QX = WS_CAT + 32 * MiB;
constexpr size_t WS_OX = WS_QX + 32 * MiB;
constexpr size_t WS_MN = WS_OX + 32 * MiB;
constexpr size_t WS_KV = WS_MN + 4 * MiB;
constexpr size_t WS_COS = WS_KV + 32 * MiB;
constexpr size_t WS_SIN = WS_COS + 2 * MiB;
constexpr size_t WS_LIST = WS_SIN + 2 * MiB;
constexpr size_t WS_TOK = WS_LIST + 1 * MiB;
constexpr size_t WS_VT = WS_TOK + 1 * MiB;
constexpr size_t WS_VTA = WS_VT + 16 * MiB;
constexpr size_t WS_SLOC = WS_VTA + 32 * MiB;
constexpr size_t WS_DEC = WS_SLOC + 32 * MiB;
constexpr size_t WS_STT = WS_DEC + 1 * MiB;
constexpr size_t WS_WSB = WS_STT + 16 * MiB;
constexpr size_t WS_M0 = WS_WSB + 768 * 1024;
constexpr size_t WS_W1T = WS_WSB + 1 * MiB;
constexpr size_t WS_ROWSQ = WS_W1T + 1 * MiB;
constexpr size_t WS_END = WS_ROWSQ + 1 * MiB;
constexpr size_t WS_Y = WS_BIG, WS_H = WS_BIG + 72 * MiB, WS_U = WS_BIG, WS_V = WS_BIG + 64 * MiB, WS_UM = WS_QX;
constexpr int CW_BAR = 4096;
constexpr int CW_CNT = 8192;

constexpr int LDS_BYTES = 159744;
constexpr int LDS_MISC = LDS_BYTES - 64;

typedef __bf16 bf16x2_t __attribute__((ext_vector_type(2)));
__device__ __forceinline__ unsigned pk2(float lo, float hi) { const f32x2 v = {lo, hi}; return __builtin_bit_cast(unsigned, __builtin_convertvector(v, bf16x2_t)); }
__device__ __forceinline__ unsigned f2bf(float f) { return (unsigned)__builtin_bit_cast(unsigned short, (__bf16)f); }
__device__ __forceinline__ float bf2f(unsigned b) { return __uint_as_float(b << 16); }
__device__ __forceinline__ float bflo(unsigned w) { return __uint_as_float(w << 16); }
__device__ __forceinline__ float bfhi(unsigned w) { return __uint_as_float(w & 0xffff0000u); }
__device__ __forceinline__ float wave_sum(float v) {
#pragma unroll
    for (int o = 1; o < 64; o <<= 1) v += __shfl_xor(v, o);
    return v;
}
__device__ __forceinline__ float wave_max(float v) {
#pragma unroll
    for (int o = 1; o < 64; o <<= 1) v = fmaxf(v, __shfl_xor(v, o));
    return v;
}
__device__ __forceinline__ int opaque_tid(int wv) { int l; asm volatile("v_mbcnt_lo_u32_b32 %0, -1, 0\n\tv_mbcnt_hi_u32_b32 %0, -1, %0" : "=v"(l)); return wv * 64 + l; }
__device__ __forceinline__ unsigned char* opq(unsigned char* p) { asm volatile("" : "+s"(p)); return p; }
#define LDS_WAIT() asm volatile("s_waitcnt lgkmcnt(0)" ::: "memory")
__device__ __forceinline__ float gelu_tanh(float x) {
    const float u2 = x * (1.5957691216057308f + 0.07135481283f * x * x);
    return x * __builtin_amdgcn_rcpf(1.0f + __expf(-u2));
}
__device__ __forceinline__ float sigmoidf_(float x) { return 1.0f / (1.0f + __expf(-x)); }

#define SUBT_BEGIN(id) unsigned long long subt_##id = 0; if (PROBE_SUB == (id)) subt_##id = __builtin_amdgcn_s_memrealtime();
#define SUBT_END(id, wsp, tidv) do { if (PROBE_SUB == (id) && blockIdx.x == 0 && (tidv) == 0) atomicAdd((unsigned long long*)((wsp) + WS_CTL + 48000), __builtin_amdgcn_s_memrealtime() - subt_##id); } while (0)
#define XB_TMO      128
#define XB_XCNT(j)  (256  + 64 * (j))
#define XB_XSUB(j)  (1280 + 64 * (j))
#define XB_XGEN(j)  (2304 + 64 * (j))
#define XB_TOP      3328
#define XB_TOPGEN   3392
#define XCD_BAR_WORDS 3456
#define XB_SPIN_CAP (1u << 22)

__device__ __forceinline__ unsigned xb_ld(unsigned* p)              { return __hip_atomic_load(p, __ATOMIC_RELAXED, __HIP_MEMORY_SCOPE_AGENT); }
__device__ __forceinline__ unsigned xb_add(unsigned* p, unsigned v) { return __hip_atomic_fetch_add(p, v, __ATOMIC_RELAXED, __HIP_MEMORY_SCOPE_AGENT); }
__device__ __forceinline__ unsigned xb_xcc_id() { return (unsigned)__builtin_amdgcn_s_getreg((3 << 11) | 20) & 0xFu; }
#define XB_SPIN(cond, bar) do { unsigned _sp = 0; while (cond) { __builtin_amdgcn_s_sleep(1); \
    if ((++_sp & 255u) == 0u) { if (xb_ld(&(bar)[XB_TMO])) break; if (_sp > XB_SPIN_CAP) { atomicAdd(&(bar)[XB_TMO], 1u); break; } } } } while (0)

struct XcdBarrier { unsigned* bar; unsigned x; volatile LAS unsigned* st; };
__device__ __forceinline__ unsigned* xb_opaque(unsigned* p) { unsigned long long v = (unsigned long long)p; unsigned lo = __builtin_amdgcn_readfirstlane((unsigned)v), hi = __builtin_amdgcn_readfirstlane((unsigned)(v >> 32));
    asm volatile("" : "+s"(lo), "+s"(hi)); return (unsigned*)(((unsigned long long)hi << 32) | lo); }

__device__ __forceinline__ XcdBarrier xcd_barrier_post(unsigned* bar, volatile LAS unsigned* st) {
    XcdBarrier b; b.bar = bar; b.x = xb_xcc_id(); b.st = st;
    if (threadIdx.x == 0) (void)xb_add(&bar[XB_XCNT(b.x)], 1u);
    return b;
}
__device__ __forceinline__ void xcd_barrier_complete(unsigned* bar, unsigned x, unsigned& nloc, unsigned& nx) {
    const unsigned G = gridDim.x * gridDim.y * gridDim.z;
    unsigned sum, cnt, mine, sp = 0u;
    for (;;) {
        sum = 0u; cnt = 0u; mine = 0u;
#pragma unroll
        for (unsigned j = 0; j < 16; ++j) { const unsigned c = xb_ld(&bar[XB_XCNT(j)]); sum += c; cnt += (c > 0u) ? 1u : 0u; mine = (j == x) ? c : mine; }
        if (sum == G) break;
        __builtin_amdgcn_s_sleep(1);
        if ((++sp & 255u) == 0u) { if (xb_ld(&bar[XB_TMO])) break; if (sp > XB_SPIN_CAP) { atomicAdd(&bar[XB_TMO], 1u); break; } }
    }
    nloc = mine > 0u ? mine : 1u; nx = cnt > 0u ? cnt : 1u;
}
__device__ __forceinline__ void xcd_barrier(const XcdBarrier& b, const bool is_t0) {
    asm volatile("s_waitcnt vmcnt(0)" ::: "memory");
    __syncthreads();
    if (is_t0) {
        unsigned* bar = b.bar;
        __builtin_amdgcn_s_waitcnt(0);
        unsigned nloc = b.st[0], nx = b.st[1];
        if (nloc == 0u) { xcd_barrier_complete(bar, b.x, nloc, nx); b.st[0] = nloc; b.st[1] = nx; }
        const unsigned old = xb_add(&bar[XB_XSUB(b.x)], 1u);
        const unsigned gen = old / nloc;
        if (old + 1u == (gen + 1u) * nloc) {
            __builtin_amdgcn_fence(__ATOMIC_RELEASE, "agent");
            asm volatile("s_waitcnt vmcnt(0)" ::: "memory");
            const unsigned og = xb_add(&bar[XB_TOP], 1u);
            const unsigned tg = og / nx;
            if (og + 1u == (tg + 1u) * nx) xb_add(&bar[XB_TOPGEN], 1u);
            else XB_SPIN(xb_ld(&bar[XB_TOPGEN]) == tg, bar);
            __builtin_amdgcn_fence(__ATOMIC_ACQUIRE, "agent");
            xb_add(&bar[XB_XGEN(b.x)], 1u);
            asm volatile("s_waitcnt vmcnt(0)" ::: "memory");
        } else {
            XB_SPIN(xb_ld(&bar[XB_XGEN(b.x)]) == gen, bar);
            __builtin_amdgcn_fence(__ATOMIC_ACQUIRE, "agent");
            asm volatile("s_waitcnt vmcnt(0)" ::: "memory");
        }
    }
    __syncthreads();
}

struct Args {
    const float* in[N_IN];
    float* out;
    unsigned char* ws;
    float freq[32];
    int ph_lo, ph_hi;
};

typedef const __attribute__((address_space(4))) Args* KArgs;
__device__ __forceinline__ KArgs kargs() { KArgs p = (KArgs)__builtin_amdgcn_kernarg_segment_ptr(); asm volatile("" : "+s"(p)); return p; }

__device__ __forceinline__ void st_bf16x4(bf16* p, f32x4 v) { u32x2 w; w.x = pk2(v[0], v[1]); w.y = pk2(v[2], v[3]); *(u32x2*)p = w; }


namespace pg8 {
constexpr int BM = 256, BK = 64, HALF = 128, HTB = HALF * BK * 2, STAGE_BYTES = 8 * HTB, NXCD = 8, WGM = 8;
__host__ __device__ __forceinline__ int lds_byte(int r, int c) { const int st = (r >> 4) * 2 + (c >> 5), rr = r & 15, cc = c & 31, ob = rr * 64 + cc * 2; return st * 1024 + (ob ^ (((ob >> 9) & 1) << 5)); }
__host__ __device__ __forceinline__ void stage_rc(int b, int& R, int& C) { const int st = b / 1024, sb = b % 1024, swz = sb ^ (((sb >> 9) & 1) << 5); R = (st >> 1) * 16 + swz / 64; C = (st & 1) * 32 + (swz % 64) / 2; }
__host__ __device__ __forceinline__ int perm32(int rho) { const int n = rho >> 4, i = rho & 15; return 8 * (i >> 2) + 4 * n + (i & 3); }
struct Unit { int pm, pn, e; };
struct DenseOrder {
    static constexpr bool GATHER = false;
    int nM, nN, nwg, G, c, K; const char* Bt;
    __device__ __forceinline__ void init(int M, int N, int K_, const bf16* Bt_, int G_, int c_) { nM = M / BM; nN = N / BM; nwg = nM * nN; G = G_; c = c_; K = K_; Bt = (const char*)Bt_; }
    __device__ __forceinline__ bool next(int i, Unit& u) const {
        const long L = (long)i * G + c; if (L >= nwg) return false;
        int wgid = (int)L; { const int q = nwg / NXCD, r = nwg % NXCD, xcd = wgid % NXCD, off = wgid / NXCD; wgid = (xcd < r ? xcd * (q + 1) : r * (q + 1) + (xcd - r) * q) + off; }
        const int nig = WGM * nN, gid = wgid / nig, fm = gid * WGM, gsz = (nM - fm) < WGM ? (nM - fm) : WGM;
        u.pm = fm + ((wgid % nig) % gsz); u.pn = (wgid % nig) / gsz; u.e = 0; return true;
    }
    __device__ __forceinline__ unsigned a_voff(const Unit& u, int half, int R) const { return (unsigned)((u.pm * BM + half * HALF + R) * K) * 2u; }
    __device__ __forceinline__ const char* b_tile(const Unit& u) const { return Bt + (size_t)u.pn * BM * K * 2; }
};
template <bool GATH> struct MoeOrder {
    static constexpr bool GATHER = GATH;
    int nunits, ntn, G, c, K; const LAS int* off; const LAS int* cn; const int* list; const char* Bt; size_t estride;
    __device__ __forceinline__ bool next(int i, Unit& u) const {
        const int L = i * G + c; if (L >= nunits) return false;
        u.pm = L / ntn; u.pn = L % ntn; const int s0 = u.pm * BM; int e = 0;
#pragma unroll
        for (int q = 1; q < 16; ++q) e += (s0 >= off[q]) ? 1 : 0;
        u.e = e; return true;
    }
    __device__ __forceinline__ unsigned a_voff(const Unit& u, int half, int R) const {
        const int slot = u.pm * BM + half * HALF + R;
        const int loc = slot - off[u.e]; const int tk = list[u.e * T + (loc < cn[u.e] ? loc : 0)];
        return (unsigned)(tk * K) * 2u;
    }
    __device__ __forceinline__ const char* b_tile(const Unit& u) const { return Bt + (size_t)u.e * estride + (size_t)u.pn * BM * K * 2; }
};
__device__ __forceinline__ unsigned cvt_pk_bf16(float lo, float hi) { return pk2(lo, hi); }

template <class Epi, class Sched>
__device__ __forceinline__ void gemm_phase(LAS unsigned char* lds, const bf16* Aptr, int K, const Sched& S, const Epi& E, int wv_) {
    const int tid = opaque_tid(wv_), wid = __builtin_amdgcn_readfirstlane(tid >> 6), lane = tid & 63, wr = wid >> 2, wc = wid & 3, fr = lane & 15, fq = lane >> 4;
    const int nt = K / BK;
    int Rr[2], Cc[2]; unsigned voffA[2], voffB[2];
#pragma unroll
    for (int i = 0; i < 2; ++i) { stage_rc(tid * 16 + i * 8192, Rr[i], Cc[i]); const int Rb = Epi::PERM ? ((Rr[i] & ~31) + perm32(Rr[i] & 31)) : Rr[i];
        voffA[i] = (unsigned)(Rr[i] * K + Cc[i]) * 2u; voffB[i] = (unsigned)(Rb * K + Cc[i]) * 2u; }
    const size_t kstep = (size_t)(BK * 2);
    const size_t hstep = (size_t)HALF * K * 2;
    const size_t tstep = 2 * hstep;
    const unsigned ldsw = (unsigned)wid * 1024u;
    const int aoff = lds_byte(wr * 64 + fr, fq * 8), boff = lds_byte(wc * 32 + fr, fq * 8);
    const char* const Ab = (const char*)Aptr;
#define PG8_SA(b, h) (((b) * 2 + (h)) * HTB)
#define PG8_SB(b, h) ((4 + (b) * 2 + (h)) * HTB)
#define PG8_STAGE(bufoff, gbase, voff) do { _Pragma("unroll") for (int _i = 0; _i < 2; ++_i) \
        __builtin_amdgcn_global_load_lds((const unsigned*)((const char*)(gbase) + (voff)[_i]), (LAS unsigned*)(lds + (bufoff) + ldsw + _i * 8192), 16, 0, 0); } while (0)
#define PG8_STAGE_A(bufoff, usenext, h, kofs) do { \
        if constexpr (Sched::GATHER) { const char* gb_ = Ab + (kofs); unsigned vv_[2] = {(usenext) ? vN[h][0] : vA[h][0], (usenext) ? vN[h][1] : vA[h][1]}; PG8_STAGE(bufoff, gb_, vv_); } \
        else { const char* gb_ = ((usenext) ? nA : cA) + (size_t)(h) * hstep + (kofs); PG8_STAGE(bufoff, gb_, voffA); } } while (0)
#define PG8_LDA(dst, b, h) do { _Pragma("unroll") for (int m = 0; m < 4; ++m) _Pragma("unroll") for (int k = 0; k < 2; ++k) dst[m][k] = *(const LAS bf16x8*)(lds + PG8_SA(b, h) + aoff + m * 2048 + k * 1024); } while (0)
#define PG8_LDB(dst, b, h) do { _Pragma("unroll") for (int n = 0; n < 2; ++n) _Pragma("unroll") for (int k = 0; k < 2; ++k) dst[n][k] = *(const LAS bf16x8*)(lds + PG8_SB(b, h) + boff + n * 2048 + k * 1024); } while (0)
#define PG8_MMA(ai, bj, At, Bt) do { __builtin_amdgcn_s_setprio(1); _Pragma("unroll") for (int m = 0; m < 4; ++m) _Pragma("unroll") for (int n = 0; n < 2; ++n) _Pragma("unroll") for (int k = 0; k < 2; ++k) \
        acc[ai][bj][m][n] = __builtin_amdgcn_mfma_f32_16x16x32_bf16(Bt[n][k], At[m][k], acc[ai][bj][m][n], 0, 0, 0); __builtin_amdgcn_s_setprio(0); } while (0)
#define PG8_WAIT_V(n) asm volatile("s_waitcnt vmcnt(" #n ")" ::: "memory")
#define PG8_WAIT_L(n) asm volatile("s_waitcnt lgkmcnt(" #n ")" ::: "memory")
#define PG8_BAR __builtin_amdgcn_s_barrier()
#define PG8_SCHED __builtin_amdgcn_sched_barrier(0)
    Unit cur, nxt; int ui = 0;
    if (!S.next(0, cur)) return;
    f32x4 acc[2][2][4][2];
#pragma unroll
    for (int a = 0; a < 2; ++a)
#pragma unroll
        for (int b = 0; b < 2; ++b)
#pragma unroll
            for (int m = 0; m < 4; ++m)
#pragma unroll
                for (int n = 0; n < 2; ++n) acc[a][b][m][n] = (f32x4){0.f, 0.f, 0.f, 0.f};
    bf16x8 At[4][2], B0[2][2], B1[2][2];
    unsigned vA[2][2], vN[2][2];
    const char* cA = Ab; const char* nA = Ab;
    if constexpr (Sched::GATHER) {
#pragma unroll
        for (int h = 0; h < 2; ++h)
#pragma unroll
            for (int i = 0; i < 2; ++i) { vA[h][i] = S.a_voff(cur, h, Rr[i]) + (unsigned)Cc[i] * 2u; vN[h][i] = vA[h][i]; }
    } else { cA = Ab + (size_t)cur.pm * tstep; nA = cA; }
    const char* cB = S.b_tile(cur);
    PG8_STAGE(PG8_SB(0, 0), cB, voffB); PG8_STAGE_A(PG8_SA(0, 0), false, 0, 0); PG8_STAGE(PG8_SB(0, 1), cB + hstep, voffB); PG8_STAGE_A(PG8_SA(0, 1), false, 1, 0);
    if (wr == 1) PG8_BAR;
    PG8_WAIT_V(4); PG8_BAR;
    PG8_STAGE(PG8_SB(1, 0), cB + kstep, voffB); PG8_STAGE_A(PG8_SA(1, 0), false, 0, kstep); PG8_STAGE(PG8_SB(1, 1), cB + hstep + kstep, voffB);
    PG8_WAIT_V(6); PG8_BAR;
    for (;;) {
        const bool has_next = S.next(ui + 1, nxt);
        const char* nB = has_next ? S.b_tile(nxt) : cB;
        if constexpr (Sched::GATHER) {
#pragma unroll
            for (int h = 0; h < 2; ++h)
#pragma unroll
                for (int i = 0; i < 2; ++i) vN[h][i] = has_next ? S.a_voff(nxt, h, Rr[i]) + (unsigned)Cc[i] * 2u : vA[h][i];
        } else nA = has_next ? Ab + (size_t)nxt.pm * tstep : cA;
        for (int t = 0; t < nt; t += 2) {
            const bool last = (t == nt - 2);
            const size_t k1 = (size_t)(t + 1) * kstep, k2 = last ? 0 : (size_t)(t + 2) * kstep, k3 = k2 + kstep;
            const char* b2 = last ? nB : cB + (size_t)(t + 2) * kstep; const char* b3 = b2 + kstep;
            PG8_LDB(B0, 0, 0); PG8_SCHED; PG8_LDA(At, 0, 0); PG8_STAGE_A(PG8_SA(1, 1), false, 1, k1);
            PG8_WAIT_L(8); PG8_BAR; PG8_WAIT_L(0); PG8_MMA(0, 0, At, B0); PG8_BAR; PG8_SCHED;
            PG8_LDB(B1, 0, 1); PG8_STAGE(PG8_SB(0, 0), b2, voffB);
            PG8_BAR; PG8_WAIT_L(0); PG8_MMA(0, 1, At, B1); PG8_BAR;
            PG8_LDA(At, 0, 1); PG8_STAGE_A(PG8_SA(0, 0), last, 0, k2);
            PG8_BAR; PG8_WAIT_L(0); PG8_MMA(1, 0, At, B0); PG8_BAR; PG8_SCHED;
            PG8_STAGE(PG8_SB(0, 1), b2 + hstep, voffB);
            PG8_WAIT_V(6); PG8_BAR; PG8_MMA(1, 1, At, B1); PG8_BAR;
            PG8_LDB(B0, 1, 0); PG8_SCHED; PG8_LDA(At, 1, 0); PG8_STAGE_A(PG8_SA(0, 1), last, 1, k2);
            PG8_WAIT_L(8); PG8_BAR; PG8_WAIT_L(0); PG8_MMA(0, 0, At, B0); PG8_BAR; PG8_SCHED;
            PG8_LDB(B1, 1, 1); PG8_STAGE(PG8_SB(1, 0), b3, voffB);
            PG8_BAR; PG8_WAIT_L(0); PG8_MMA(0, 1, At, B1); PG8_BAR;
            PG8_LDA(At, 1, 1); PG8_STAGE_A(PG8_SA(1, 0), last, 0, k3);
            PG8_BAR; PG8_WAIT_L(0); PG8_MMA(1, 0, At, B0); PG8_BAR; PG8_SCHED;
            PG8_STAGE(PG8_SB(1, 1), b3 + hstep, voffB);
            PG8_WAIT_V(6); PG8_BAR; PG8_MMA(1, 1, At, B1); PG8_BAR;
        }
        E(acc, cur, wr, wc, fr, fq);
        if (!has_next) break;
#pragma unroll
        for (int a = 0; a < 2; ++a)
#pragma unroll
            for (int b = 0; b < 2; ++b)
#pragma unroll
                for (int m = 0; m < 4; ++m)
#pragma unroll
                    for (int n = 0; n < 2; ++n) acc[a][b][m][n] = (f32x4){0.f, 0.f, 0.f, 0.f};
        cur = nxt; cB = nB; cA = nA; ++ui;
        if constexpr (Sched::GATHER) {
#pragma unroll
            for (int h = 0; h < 2; ++h)
#pragma unroll
                for (int i = 0; i < 2; ++i) vA[h][i] = vN[h][i];
        }
    }
    PG8_WAIT_V(0);
    if (wr == 0) PG8_BAR;
    PG8_BAR;
#undef PG8_SA
#undef PG8_SB
#undef PG8_STAGE
#undef PG8_STAGE_A
#undef PG8_LDA
#undef PG8_LDB
#undef PG8_MMA
#undef PG8_WAIT_V
#undef PG8_WAIT_L
#undef PG8_BAR
#undef PG8_SCHED
}
template <int ACT> struct EpiBf16 {
    static constexpr bool PERM = true;
    bf16* O; int ldc; int tpt; size_t tstride;
    __device__ __forceinline__ void operator()(const f32x4 (&acc)[2][2][4][2], const Unit& u, int wr, int wc, int fr, int fq) const {
        const int row0 = u.pm * BM + wr * 64 + fr; const int tt = u.pn / tpt; bf16* base = O + (size_t)tt * tstride; const int col0 = (u.pn - tt * tpt) * BM + wc * 32 + 8 * fq;
#pragma unroll
        for (int ai = 0; ai < 2; ++ai)
#pragma unroll
            for (int m = 0; m < 4; ++m) { bf16* rowp = base + (size_t)(row0 + ai * HALF + m * 16) * ldc + col0;
#pragma unroll
                for (int bj = 0; bj < 2; ++bj) { f32x4 v0 = acc[ai][bj][m][0], v1 = acc[ai][bj][m][1];
                    if (ACT == 1) {
#pragma unroll
                        for (int q = 0; q < 4; ++q) { v0[q] = gelu_tanh(v0[q]); v1[q] = gelu_tanh(v1[q]); } }
                    u32x4 w; w.x = cvt_pk_bf16(v0[0], v0[1]); w.y = cvt_pk_bf16(v0[2], v0[3]); w.z = cvt_pk_bf16(v1[0], v1[1]); w.w = cvt_pk_bf16(v1[2], v1[3]);
                    *(u32x4*)(rowp + bj * HALF) = w; } }
    }
};
struct EpiResAdd {
    static constexpr bool PERM = false;
    float* X; int ldc;
    __device__ __forceinline__ void operator()(const f32x4 (&acc)[2][2][4][2], const Unit& u, int wr, int wc, int fr, int fq) const {
        const int row0 = u.pm * BM + wr * 64 + fr, col0 = u.pn * BM + wc * 32 + 4 * fq;
#pragma unroll
        for (int ai = 0; ai < 2; ++ai)
#pragma unroll
            for (int m2 = 0; m2 < 4; m2 += 2) {
                f32x4 x[2][2][2];
#pragma unroll
                for (int mm = 0; mm < 2; ++mm)
#pragma unroll
                    for (int bj = 0; bj < 2; ++bj)
#pragma unroll
                        for (int n = 0; n < 2; ++n) x[mm][bj][n] = *(const f32x4*)(X + (size_t)(row0 + ai * HALF + (m2 + mm) * 16) * ldc + col0 + bj * HALF + n * 16);
#pragma unroll
                for (int mm = 0; mm < 2; ++mm)
#pragma unroll
                    for (int bj = 0; bj < 2; ++bj)
#pragma unroll
                        for (int n = 0; n < 2; ++n) *(f32x4*)(X + (size_t)(row0 + ai * HALF + (m2 + mm) * 16) * ldc + col0 + bj * HALF + n * 16) = x[mm][bj][n] + acc[ai][bj][m2 + mm][n];
            }
    }
};
struct EpiResAddNorm {
    static constexpr bool PERM = false;
    float* X; int ldc; bf16* XB; float* rowsq;
    __device__ __forceinline__ void operator()(const f32x4 (&acc)[2][2][4][2], const Unit& u, int wr, int wc, int fr, int fq) const {
        const int row0 = u.pm * BM + wr * 64 + fr, col0 = u.pn * BM + wc * 32 + 4 * fq;
#pragma unroll
        for (int ai = 0; ai < 2; ++ai)
#pragma unroll
            for (int m2 = 0; m2 < 4; m2 += 2) {
                f32x4 x[2][2][2];
#pragma unroll
                for (int mm = 0; mm < 2; ++mm)
#pragma unroll
                    for (int bj = 0; bj < 2; ++bj)
#pragma unroll
                        for (int n = 0; n < 2; ++n) x[mm][bj][n] = *(const f32x4*)(X + (size_t)(row0 + ai * HALF + (m2 + mm) * 16) * ldc + col0 + bj * HALF + n * 16);
#pragma unroll
                for (int mm = 0; mm < 2; ++mm) {
                    const size_t ro = (size_t)(row0 + ai * HALF + (m2 + mm) * 16) * ldc + col0; float ssq = 0.f;
#pragma unroll
                    for (int bj = 0; bj < 2; ++bj)
#pragma unroll
                        for (int n = 0; n < 2; ++n) { const f32x4 v = x[mm][bj][n] + acc[ai][bj][m2 + mm][n];
                            *(f32x4*)(X + ro + bj * HALF + n * 16) = v;
                            u32x2 w; w.x = cvt_pk_bf16(v.x, v.y); w.y = cvt_pk_bf16(v.z, v.w); *(u32x2*)(XB + ro + bj * HALF + n * 16) = w;
                            ssq += (v.x * v.x + v.y * v.y) + (v.z * v.z + v.w * v.w); }
                    ssq += __shfl_xor(ssq, 16); ssq += __shfl_xor(ssq, 32);
                    if (fq == 0) rowsq[(size_t)(row0 + ai * HALF + (m2 + mm) * 16) * 16 + u.pn * 4 + wc] = ssq;
                }
            }
    }
};
struct EpiBf16RowScale {
    static constexpr bool PERM = true;
    bf16* O; int ldc; const float* rowsq;
    __device__ __forceinline__ void operator()(const f32x4 (&acc)[2][2][4][2], const Unit& u, int wr, int wc, int fr, int fq) const {
        const int row0 = u.pm * BM + wr * 64 + fr, col0 = u.pn * BM + wc * 32 + 8 * fq;
#pragma unroll
        for (int ai = 0; ai < 2; ++ai) {
            float rs[4];
#pragma unroll
            for (int m = 0; m < 4; ++m) { const f32x4* p = (const f32x4*)(rowsq + (size_t)(row0 + ai * HALF + m * 16) * 16); const f32x4 a = p[0], b = p[1], c = p[2], d = p[3];
                rs[m] = rsqrtf((((a.x + a.y) + (a.z + a.w)) + ((b.x + b.y) + (b.z + b.w)) + (((c.x + c.y) + (c.z + c.w)) + ((d.x + d.y) + (d.z + d.w)))) * (1.f / 1024.f) + EPS); }
#pragma unroll
            for (int m = 0; m < 4; ++m) { bf16* rowp = O + (size_t)(row0 + ai * HALF + m * 16) * ldc + col0;
#pragma unroll
                for (int bj = 0; bj < 2; ++bj) { const f32x4 v0 = acc[ai][bj][m][0] * rs[m], v1 = acc[ai][bj][m][1] * rs[m];
                    u32x4 w; w.x = cvt_pk_bf16(v0[0], v0[1]); w.y = cvt_pk_bf16(v0[2], v0[3]); w.z = cvt_pk_bf16(v1[0], v1[1]); w.w = cvt_pk_bf16(v1[2], v1[3]);
                    *(u32x4*)(rowp + bj * HALF) = w; } }
        }
    }
};
struct EpiSwiglu {
    static constexpr bool PERM = true;
    bf16* H; int ldc;
    __device__ __forceinline__ void operator()(const f32x4 (&acc)[2][2][4][2], const Unit& u, int wr, int wc, int fr, int fq) const {
        const int row0 = u.pm * BM + wr * 64 + fr, col0 = u.pn * HALF + wc * 32 + 8 * fq;
#pragma unroll
        for (int ai = 0; ai < 2; ++ai)
#pragma unroll
            for (int m = 0; m < 4; ++m) {
                float o[8];
#pragma unroll
                for (int n = 0; n < 2; ++n)
#pragma unroll
                    for (int q = 0; q < 4; ++q) { const float g = acc[ai][0][m][n][q]; o[4 * n + q] = g * sigmoidf_(g) * acc[ai][1][m][n][q]; }
                u32x4 w; w.x = cvt_pk_bf16(o[0], o[1]); w.y = cvt_pk_bf16(o[2], o[3]); w.z = cvt_pk_bf16(o[4], o[5]); w.w = cvt_pk_bf16(o[6], o[7]);
                *(u32x4*)(H + (size_t)(row0 + ai * HALF + m * 16) * ldc + col0) = w; }
    }
};
}

__device__ __forceinline__ int hyb_colmap(int n) {
    if (n < 1280) return n;
    if (n < 1536) return 1304 + (n - 1280);
    if (n < 1792) return 1560 + (n - 1536);
    if (n < 2304) return 1816 + (n - 1792);
    if (n < 2816) return 2344 + (n - 2304);
    if (n < 2840) return 1280 + (n - 2816);
    if (n < 2856) return 2328 + (n - 2840);
    return -1;
}
__device__ __forceinline__ void tr_item(const float* __restrict__ W, int Nsrc, int K, bf16* __restrict__ Wt, const float* __restrict__ gain, int kind, int nblk, LAS float* scr, int item, int lane) {
    const int kb = item / nblk, nb = item % nblk, k0 = 64 * kb, n0 = 64 * nb;
    const int ksub = lane >> 4, n4 = lane & 15, n = n0 + 4 * n4;
    int col;
    if (kind == 0) col = n; else if (kind == 1) col = hyb_colmap(n); else { const int pn = n >> 8, r = n & 255; col = (r >> 7) * 384 + pn * 128 + (r & 127); }
    f32x4 v[16];
#pragma unroll
    for (int i = 0; i < 16; ++i) v[i] = col >= 0 ? *(const f32x4*)(W + (size_t)(k0 + 4 * i + ksub) * Nsrc + col) : (f32x4){0.f, 0.f, 0.f, 0.f};
    if (gain) {
#pragma unroll
        for (int i = 0; i < 16; ++i) v[i] = v[i] * gain[k0 + 4 * i + ksub];
    }
#pragma unroll
    for (int i = 0; i < 16; ++i) { LAS float* d = scr + (4 * i + ksub) * 65 + 4 * n4; d[0] = v[i].x; d[1] = v[i].y; d[2] = v[i].z; d[3] = v[i].w; }
    LDS_WAIT();
    const int c = lane & 7;
#pragma unroll
    for (int jx = 0; jx < 8; ++jx) {
        const int nn = (lane >> 3) + 8 * jx; const LAS float* s = scr + (8 * c) * 65 + nn;
        u32x4 o; o.x = pk2(s[0 * 65], s[1 * 65]); o.y = pk2(s[2 * 65], s[3 * 65]); o.z = pk2(s[4 * 65], s[5 * 65]); o.w = pk2(s[6 * 65], s[7 * 65]);
        *(u32x4*)(Wt + (size_t)(n0 + nn) * K + k0 + 8 * c) = o;
    }
    LDS_WAIT();
}
__device__ __forceinline__ void rms_row_to_bf16(const float* __restrict__ xrow, bf16* __restrict__ orow, float* __restrict__ copy, int lane) {
    const f32x4* xr = (const f32x4*)xrow + lane;
    f32x4 v[4]; float s = 0.f;
#pragma unroll
    for (int j = 0; j < 4; ++j) { v[j] = xr[64 * j]; s += (v[j].x * v[j].x + v[j].y * v[j].y) + (v[j].z * v[j].z + v[j].w * v[j].w); }
    const float rstd = rsqrtf(wave_sum(s) * (1.f / 1024.f) + EPS);
    u32x2* o8 = (u32x2*)orow + lane;
#pragma unroll
    for (int j = 0; j < 4; ++j) { u32x2 w; w.x = pk2(v[j].x * rstd, v[j].y * rstd); w.y = pk2(v[j].z * rstd, v[j].w * rstd); o8[64 * j] = w; }
    if (copy) { f32x4* c4 = (f32x4*)copy + lane;
#pragma unroll
        for (int j = 0; j < 4; ++j) c4[64 * j] = v[j]; }
}

__device__ __forceinline__ void phase_prologue(KArgs A, int wv_, LAS unsigned char* lds) {
    const int tid = opaque_tid(wv_), wid = __builtin_amdgcn_readfirstlane(tid >> 6), lane = tid & 63;
    const int gw = blockIdx.x * 8 + wid, NGW = gridDim.x * 8;
    LAS float* scr = (LAS float*)(lds + wid * 16640);
    unsigned char* ws = opq(A->ws);
    constexpr int N_HYB = 2 * 768, N_HOUT = 2 * 256, N_SGIN = 2 * 1024, N_SGOUT = 2 * 512, N_WQ = 4 * 256, N_WKV = 4 * 512, N_WO = 4 * 256, N_MIN = 64 * 192, N_MOUT = 64 * 96, N_W1T = 4 * 32;
    constexpr int NITEMS = N_HYB + N_HOUT + N_SGIN + N_SGOUT + N_WQ + N_WKV + N_WO + N_MIN + N_MOUT + N_W1T;
    for (int it = gw; it < NITEMS; it += NGW) {
        int r = it;
        if (r < N_HYB) { const int sl = r / 768; tr_item(A->in[I_HYBIN] + (size_t)sl * 1024 * HYSRC, HYSRC, 1024, (bf16*)(ws + WS_WHYB) + (size_t)sl * HYN * 1024, A->in[I_NMIX] + (2 * sl) * 1024, 1, 48, scr, r % 768, lane); continue; } r -= N_HYB;
        if (r < N_HOUT) { const int sl = r / 256; tr_item(A->in[I_HYBOUT] + (size_t)sl * 1024 * 1024, 1024, 1024, (bf16*)(ws + WS_WHOUT) + (size_t)sl * 1024 * 1024, nullptr, 0, 16, scr, r % 256, lane); continue; } r -= N_HOUT;
        if (r < N_SGIN) { const int sl = r / 1024; tr_item(A->in[I_SGIN] + (size_t)sl * 1024 * 4096, 4096, 1024, (bf16*)(ws + WS_WSGIN) + (size_t)sl * 4096 * 1024, A->in[I_NMIX] + (2 * sl + 1) * 1024, 0, 64, scr, r % 1024, lane); continue; } r -= N_SGIN;
        if (r < N_SGOUT) { const int sl = r / 512; tr_item(A->in[I_SGOUT] + (size_t)sl * 2048 * 1024, 1024, 2048, (bf16*)(ws + WS_WSGOUT) + (size_t)sl * 1024 * 2048, nullptr, 0, 16, scr, r % 512, lane); continue; } r -= N_SGOUT;
        if (r < N_WQ) { const int sl = r / 256; tr_item(A->in[I_XWQ] + (size_t)sl * 1024 * 1024, 1024, 1024, (bf16*)(ws + WS_WQ) + (size_t)sl * 1024 * 1024, A->in[I_NXAT] + sl * 1024, 0, 16, scr, r % 256, lane); continue; } r -= N_WQ;
        if (r < N_WKV) { const int sl = r / 512; tr_item(A->in[I_XWKV] + (size_t)sl * 1024 * 2048, 2048, 1024, (bf16*)(ws + WS_WKV) + (size_t)sl * 2048 * 1024, A->in[I_NMEM] + sl * 1024, 0, 32, scr, r % 512, lane); continue; } r -= N_WKV;
        if (r < N_WO) { const int sl = r / 256; tr_item(A->in[I_XWO] + (size_t)sl * 1024 * 1024, 1024, 1024, (bf16*)(ws + WS_WO) + (size_t)sl * 1024 * 1024, nullptr, 0, 16, scr, r % 256, lane); continue; } r -= N_WO;
        if (r < N_MIN) { const int sl = r / 192; tr_item(A->in[I_MOEIN] + (size_t)sl * 1024 * 768, 768, 1024, (bf16*)(ws + WS_WMIN) + (size_t)sl * 768 * 1024, A->in[I_NFFN] + (sl >> 4) * 1024, 2, 12, scr, r % 192, lane); continue; } r -= N_MIN;
        if (r < N_MOUT) { const int sl = r / 96; tr_item(A->in[I_MOEOUT] + (size_t)sl * 384 * 1024, 1024, 384, (bf16*)(ws + WS_WMOUT) + (size_t)sl * 1024 * 384, nullptr, 0, 16, scr, r % 96, lane); continue; } r -= N_MOUT;
        { const int sl = r / 32; tr_item(A->in[I_CMPW1] + (size_t)sl * 2048 * 64, 64, 2048, (bf16*)(ws + WS_W1T) + (size_t)sl * 64 * 2048, nullptr, 0, 1, scr, r % 32, lane); }
    }
    for (int m = gw; m < T; m += NGW) rms_row_to_bf16(A->in[I_X] + (size_t)m * D, (bf16*)(ws + WS_XN) + (size_t)m * D, A->out + (size_t)m * D, lane);
    for (int m = gw; m < NBATCH * NMEM; m += NGW) rms_row_to_bf16(A->in[I_MEM] + (size_t)m * D, (bf16*)(ws + WS_MN) + (size_t)m * D, nullptr, lane);
    const int gt = blockIdx.x * 512 + tid, NGT = gridDim.x * 512;
    const int* pos = (const int*)A->in[I_POS];
    float* cosT = (float*)(ws + WS_COS); float* sinT = (float*)(ws + WS_SIN);
    for (int i = gt; i < T * 32; i += NGT) {
        const int t = i >> 5, j = i & 31;
        const float ang = (float)pos[t] * A->freq[j];
        const double rev = (double)ang * 0.15915494309189533577;
        const float fr = (float)(rev - rint(rev));
        cosT[i] = __builtin_amdgcn_cosf(fr); sinT[i] = __builtin_amdgcn_sinf(fr);
    }
    { bf16* WSB = (bf16*)(ws + WS_WSB); float* M0 = (float*)(ws + WS_M0); const float* wsg = A->in[I_SGWS];
      for (int e = gt; e < 2 * 8 * 128 * 128; e += NGT) { const int s = e & 127, t = (e >> 7) & 127; WSB[e] = (bf16)f2bf(s <= t ? wsg[e] : 0.f); }
      for (int e = gt; e < 2 * 8 * 128; e += NGT) { const int t = e & 127; const float* r = wsg + (size_t)e * 128; float a = 0.f; for (int s = 0; s <= t; ++s) a += r[s]; M0[e] = a; } }
    float* RW = (float*)(ws + WS_RW);
    for (int i = gt; i < DEPTH * NEXP * D; i += NGT) { const int k = i & 1023, e = (i >> 10) & 15, l = i >> 14; RW[i] = A->in[I_RW][k * NEXP + e] * A->in[I_NFFN][l * D + k]; }
}

__device__ __forceinline__ void phase_knorm(KArgs A, int wv_) {
    const int tid_ = opaque_tid(wv_); const int wid = __builtin_amdgcn_readfirstlane(tid_ >> 6), lane = tid_ & 63; const int gw = blockIdx.x * 8 + wid, NGW = gridDim.x * 8;
    bf16* KV = (bf16*)(opq(A->ws) + WS_KV);
    for (int it = gw; it < DEPTH * 2048 * 4; it += NGW) {
        const int h = it & 3, m = (it >> 2) & 2047, l = it >> 13;
        bf16* p = KV + (size_t)m * 8192 + l * 2048 + h * 256 + 4 * lane;
        const u32x2 w = *(const u32x2*)p;
        float x0 = bflo(w.x), x1 = bfhi(w.x), x2 = bflo(w.y), x3 = bfhi(w.y);
        const float rstd = rsqrtf(wave_sum(x0 * x0 + x1 * x1 + x2 * x2 + x3 * x3) * (1.f / 256.f) + EPS) * 0.0625f;
        const f32x4 g = *(const f32x4*)(A->in[I_XKN] + l * 256 + 4 * lane) * *(const f32x4*)(A->in[I_XQN] + l * 256 + 4 * lane);
        u32x2 o; o.x = pk2(x0 * rstd * g.x, x1 * rstd * g.y); o.y = pk2(x2 * rstd * g.z, x3 * rstd * g.w);
        *(u32x2*)p = o;
    }
}

__device__ __forceinline__ int kpos64(int tok) { const int k = tok & 31; return (tok & 32) + 8 * ((k >> 2) & 3) + 4 * (k >> 4) + (k & 3); }
__device__ __forceinline__ int kperm64(int p) { const int fq = (p >> 3) & 3, j = p & 7; return (p & 32) + 16 * (j >> 2) + 4 * fq + (j & 3); }

__device__ __forceinline__ void phase_nsa_prep(KArgs A, int wv_, int i, LAS unsigned char* lds) {
    const int tid_ = opaque_tid(wv_); const int wid = __builtin_amdgcn_readfirstlane(tid_ >> 6), lane = tid_ & 63; const int gw = blockIdx.x * 8 + wid, NGW = gridDim.x * 8;
    unsigned char* ws = opq(A->ws);
    const bf16* HY = (const bf16*)(ws + WS_BIG);
    const float* cosT = (const float*)(ws + WS_COS); const float* sinT = (const float*)(ws + WS_SIN);
    bf16* QA = (bf16*)(ws + WS_QA); bf16* KS = (bf16*)(ws + WS_KS); bf16* KW = (bf16*)(ws + WS_KW);
    LAS float* abuf = (LAS float*)(lds + wid * 8192);
    const int NIT = T;
    for (int it = gw; it < NIT; it += NGW) {
        if (it < T) {
            const int t = it;
            const float c = cosT[t * 32 + (lane & 31)], s = sinT[t * 32 + (lane & 31)];
            float xin[12];
#pragma unroll
            for (int u = 0; u < 12; ++u) xin[u] = bf2f(HY[(size_t)t * HYN + (u < 8 ? C_QA + 64 * u : (u < 10 ? C_KS + 64 * (u - 8) : C_KW + 64 * (u - 10))) + lane]);
#pragma unroll
            for (int u = 0; u < 12; ++u) {
                int src; const float* gain; bf16* dst; float scale;
                if (u < 8) { src = C_QA + 64 * u; gain = A->in[I_QNORM] + i * 64; dst = QA + (size_t)t * 512 + 64 * u; scale = 0.125f * 1.4426950408889634f; }
                else if (u < 10) { src = C_KS + 64 * (u - 8); gain = A->in[I_KNORM] + (i * 3 + 1) * 64; dst = KS + (size_t)t * 128 + 64 * (u - 8); scale = 1.f; }
                else { src = C_KW + 64 * (u - 10); gain = A->in[I_KNORM] + (i * 3 + 2) * 64; dst = KW + (size_t)t * 128 + 64 * (u - 10); scale = 1.f; }
                const float x = xin[u]; (void)src;
                const float y = x * rsqrtf(wave_sum(x * x) * (1.f / 64.f) + EPS) * gain[lane] * scale;
                const float pr = __shfl_xor(y, 32);
                const float o = lane < 32 ? y * c - pr * s : y * c + pr * s;
                dst[lane] = (bf16)f2bf(o);
            }
        }
    }
}


__device__ __forceinline__ void phase_compress_mfma(KArgs A, int wv_, int i, LAS unsigned char* lds) {
    const int tid = opaque_tid(wv_), wid = __builtin_amdgcn_readfirstlane(tid >> 6), lane = tid & 63, fr = lane & 15, fq = lane >> 4;
    unsigned char* ws = opq(A->ws);
    const bf16* HY = (const bf16*)(ws + WS_BIG);
    const float* cosT = (const float*)(ws + WS_COS); const float* sinT = (const float*)(ws + WS_SIN);
    LAS float* part = (LAS float*)lds;
    LAS float* hbuf = part + 8 * 1024;
    LAS float* obuf = hbuf + 1024;
    for (int it = blockIdx.x; it < 2 * 127; it += gridDim.x) {
        const int kv = it / 127, tile = it % 127;
        const float* pe = A->in[I_CMPPE] + (size_t)(i * 2 + kv) * 32 * 64;
        const float* w2 = A->in[I_CMPW2] + (size_t)(i * 2 + kv) * 64 * 64;
        const bf16* w1t = (const bf16*)(ws + WS_W1T) + (size_t)(i * 2 + kv) * 64 * 2048;
        const int coff = kv ? C_VC : C_KC;
        {
            const int R = tile * 16 + fr, g = R & 1, bn = R >> 1, n = bn % NCMP, b = bn / NCMP;
            const bf16* arow = HY + (size_t)(b * S + 16 * n) * HYN + coff + g * 64;
            f32x4 acc[4];
#pragma unroll
            for (int t = 0; t < 4; ++t) acc[t] = (f32x4){0.f, 0.f, 0.f, 0.f};
#pragma unroll 2
            for (int s = 0; s < 8; ++s) {
                const int k0 = 256 * wid + 32 * s, l = k0 >> 6, d0 = (k0 & 63) + 8 * fq;
                const u32x4 hw = *(const u32x4*)(arow + (size_t)l * HYN + d0);
                const f32x4 p0 = *(const f32x4*)(pe + l * 64 + d0), p1 = *(const f32x4*)(pe + l * 64 + d0 + 4);
                u32x4 aw; aw.x = pk2(bflo(hw.x) + p0.x, bfhi(hw.x) + p0.y); aw.y = pk2(bflo(hw.y) + p0.z, bfhi(hw.y) + p0.w); aw.z = pk2(bflo(hw.z) + p1.x, bfhi(hw.z) + p1.y); aw.w = pk2(bflo(hw.w) + p1.z, bfhi(hw.w) + p1.w);
                const bf16x8 af = __builtin_bit_cast(bf16x8, aw);
#pragma unroll
                for (int t = 0; t < 4; ++t) { const bf16x8 bfr = *(const bf16x8*)(w1t + (size_t)(16 * t + fr) * 2048 + k0 + 8 * fq);
                    acc[t] = __builtin_amdgcn_mfma_f32_16x16x32_bf16(af, bfr, acc[t], 0, 0, 0); }
            }
            __syncthreads();
#pragma unroll
            for (int t = 0; t < 4; ++t)
#pragma unroll
                for (int r = 0; r < 4; ++r) part[wid * 1024 + (4 * fq + r) * 64 + 16 * t + fr] = acc[t][r];
        }
        __syncthreads();
        for (int e = tid; e < 1024; e += 512) { float a = 0.f;
#pragma unroll
            for (int w = 0; w < 8; ++w) a += part[w * 1024 + e];
            hbuf[e] = gelu_tanh(a); }
        __syncthreads();
        for (int e = tid; e < 1024; e += 512) { const int r = e >> 6, j = e & 63; float o = 0.f;
#pragma unroll 8
            for (int m = 0; m < 64; ++m) o += hbuf[r * 64 + m] * w2[m * 64 + j];
            obuf[e] = o; }
        __syncthreads();
        for (int r = wid; r < 16; r += 8) {
            const int R = tile * 16 + r, g = R & 1, bn = R >> 1, n = bn % NCMP, b = bn / NCMP;
            const float o = obuf[r * 64 + lane];
            if (kv == 0) {
                const float y = o * rsqrtf(wave_sum(o * o) * (1.f / 64.f) + EPS) * A->in[I_KNORM][(i * 3 + 0) * 64 + lane];
                const int tp = b * S + 16 * n + 31;
                const float c = cosT[tp * 32 + (lane & 31)], sn = sinT[tp * 32 + (lane & 31)];
                const float pr = __shfl_xor(y, 32);
                const float oo = lane < 32 ? y * c - pr * sn : y * c + pr * sn;
                ((bf16*)(ws + WS_KC))[((size_t)(b * 128 + n) * 2 + g) * 64 + lane] = (bf16)f2bf(oo);
            } else {
                bf16* vct = (bf16*)(ws + WS_VC) + ((size_t)(b * 2 + g) * 64 + lane) * 128;
                vct[(n & 64) + kpos64(n & 63)] = (bf16)f2bf(o);
                if (n == 126) vct[127] = 0;
            }
        }
    }
    __syncthreads();
}

__device__ __forceinline__ void nsa_block(const LAS float* qs, const bf16* __restrict__ krow, bool ok, const bf16* __restrict__ vbase, int vstride, int lane,
                                          float (&m)[4], float (&l)[4], float (&o)[4]) {
    float s[4] = {0.f, 0.f, 0.f, 0.f};
#pragma unroll 2
    for (int c = 0; c < 8; ++c) {
        const u32x4 kw = *(const u32x4*)(krow + 8 * c);
        const float k0 = bflo(kw.x), k1 = bfhi(kw.x), k2 = bflo(kw.y), k3 = bfhi(kw.y), k4 = bflo(kw.z), k5 = bfhi(kw.z), k6 = bflo(kw.w), k7 = bfhi(kw.w);
#pragma unroll
        for (int hh = 0; hh < 4; ++hh) {
            const f32x4 qa = *(const LAS f32x4*)(qs + hh * 64 + 8 * c), qb = *(const LAS f32x4*)(qs + hh * 64 + 8 * c + 4);
            s[hh] += (qa.x * k0 + qa.y * k1) + (qa.z * k2 + qa.w * k3) + (qb.x * k4 + qb.y * k5) + (qb.z * k6 + qb.w * k7);
        }
    }
    float p[4];
#pragma unroll
    for (int hh = 0; hh < 4; ++hh) {
        const float sv = ok ? s[hh] : -INFINITY;
        const float bm = wave_max(sv);
        const float mn = fmaxf(m[hh], bm);
        if (mn == -INFINITY) { p[hh] = 0.f; continue; }
        const float alpha = __expf(m[hh] - mn);
        p[hh] = ok ? __expf(sv - mn) : 0.f;
        l[hh] = l[hh] * alpha + wave_sum(p[hh]);
        o[hh] *= alpha; m[hh] = mn;
    }
#pragma unroll 8
    for (int kk = 0; kk < 64; ++kk) {
        const float v = bf2f(vbase[(size_t)kk * vstride + lane]);
#pragma unroll
        for (int hh = 0; hh < 4; ++hh) o[hh] += __shfl(p[hh], kk) * v;
    }
}
__device__ __forceinline__ void phase_nsa_attn(KArgs A, int wv_, int i, LAS unsigned char* lds) {
    const int tid_ = opaque_tid(wv_); const int wid = __builtin_amdgcn_readfirstlane(tid_ >> 6), lane0 = tid_ & 63; const int gw = blockIdx.x * 8 + wid, NGW = gridDim.x * 8;
    unsigned char* ws = opq(A->ws);
    const bf16* HY = (const bf16*)(ws + WS_BIG); const bf16* QA = (const bf16*)(ws + WS_QA); const bf16* KS = (const bf16*)(ws + WS_KS); const bf16* KW = (const bf16*)(ws + WS_KW);
    const bf16* KC = (const bf16*)(ws + WS_KC); const bf16* VC = (const bf16*)(ws + WS_VC); bf16* CAT = (bf16*)(ws + WS_CAT);
    LAS float* qs = (LAS float*)(lds + wid * 2048);
    LAS float* ps = qs + 256;
    for (int it = gw; it < 2 * T; it += NGW) {
        int lane = lane0; asm volatile("" : "+v"(lane));
        const int tok = it >> 1, g = it & 1, b = tok >> 11, t = tok & 2047;
#pragma unroll
        for (int hh = 0; hh < 4; ++hh) qs[hh * 64 + lane] = bf2f(QA[(size_t)tok * 512 + (g * 4 + hh) * 64 + lane]);
        LDS_WAIT();
        const int ncv = t >= 31 ? ((t - 31) >> 4) + 1 : 0;
        float oc[4] = {0.f, 0.f, 0.f, 0.f};
        float psum0 = 0.f, psum1 = 0.f;
        {
            const bool v0 = lane < ncv, v1 = lane + 64 < ncv;
            const bf16* k0p = KC + ((size_t)(b * 128 + lane) * 2 + g) * 64;
            const bf16* k1p = KC + ((size_t)(b * 128 + (lane + 64 < 127 ? lane + 64 : 126)) * 2 + g) * 64;
            float s0[4] = {0.f, 0.f, 0.f, 0.f}, s1[4] = {0.f, 0.f, 0.f, 0.f};
#pragma unroll 2
            for (int c = 0; c < 8; ++c) {
                const u32x4 ka = *(const u32x4*)(k0p + 8 * c), kb = *(const u32x4*)(k1p + 8 * c);
#pragma unroll
                for (int hh = 0; hh < 4; ++hh) {
                    const f32x4 qa = *(const LAS f32x4*)(qs + hh * 64 + 8 * c), qb = *(const LAS f32x4*)(qs + hh * 64 + 8 * c + 4);
                    s0[hh] += (qa.x * bflo(ka.x) + qa.y * bfhi(ka.x)) + (qa.z * bflo(ka.y) + qa.w * bfhi(ka.y)) + (qb.x * bflo(ka.z) + qb.y * bfhi(ka.z)) + (qb.z * bflo(ka.w) + qb.w * bfhi(ka.w));
                    s1[hh] += (qa.x * bflo(kb.x) + qa.y * bfhi(kb.x)) + (qa.z * bflo(kb.y) + qa.w * bfhi(kb.y)) + (qb.x * bflo(kb.z) + qb.y * bfhi(kb.z)) + (qb.z * bflo(kb.w) + qb.w * bfhi(kb.w));
                }
            }
            float p0[4], p1[4];
#pragma unroll
            for (int hh = 0; hh < 4; ++hh) {
                const float a0 = v0 ? s0[hh] : -INFINITY, a1 = v1 ? s1[hh] : -INFINITY;
                const float mx = wave_max(fmaxf(a0, a1));
                if (ncv > 0) {
                    const float e0 = v0 ? __expf(a0 - mx) : 0.f, e1 = v1 ? __expf(a1 - mx) : 0.f;
                    const float inv = 1.0f / wave_sum(e0 + e1);
                    p0[hh] = e0 * inv; p1[hh] = e1 * inv;
                } else { p0[hh] = 0.f; p1[hh] = 0.f; }
                psum0 += p0[hh]; psum1 += p1[hh];
            }
#pragma unroll 2
            for (int c = 0; c < ncv; ++c) {
                const float v = bf2f(VC[((size_t)(b * 128 + c) * 2 + g) * 64 + lane]);
#pragma unroll
                for (int hh = 0; hh < 4; ++hh) oc[hh] += __shfl(c < 64 ? p0[hh] : p1[hh], c & 63) * v;
            }
        }
        ps[lane] = psum0; ps[64 + lane] = psum1;
        LDS_WAIT();
        const int cur = t >> 6;
        unsigned selmask;
        {
            const int j = lane & 31;
            float imp = ps[4 * j] + ps[4 * j + 1] + ps[4 * j + 2] + 0.5f * ps[4 * j + 3] + (j > 0 ? 0.5f * ps[4 * j - 1] : 0.f);
            const bool valid = j <= cur, forced = (j == 0) || (j == cur) || (j == cur - 1);
            const float score = valid ? imp + (forced ? 1000.0f : 0.f) : -INFINITY;
            int rank = 0;
#pragma unroll 8
            for (int jj = 0; jj < 32; ++jj) { const float sj = __shfl(score, jj); rank += (sj > score || (sj == score && jj < j)) ? 1 : 0; }
            const bool sel = valid && rank < 8 && lane < 32;
            selmask = (unsigned)__ballot(sel);
        }
        LDS_WAIT();
        float o1[4] = {0.f, 0.f, 0.f, 0.f}, o2[4] = {0.f, 0.f, 0.f, 0.f};
#pragma unroll 1
        for (int pass = 0; pass < 2; ++pass) {
            float oa[4] = {0.f, 0.f, 0.f, 0.f}, ma[4] = {-INFINITY, -INFINITY, -INFINITY, -INFINITY}, la[4] = {0.f, 0.f, 0.f, 0.f};
            const int lo = pass ? (t - 255 > 0 ? t - 255 : 0) : 0;
            const unsigned bm = pass ? 0xffffffffu : selmask;
            const bf16* Kb = pass ? KW : KS; const int vc = pass ? C_VW : C_VS;
#pragma unroll 1
            for (int j = lo >> 6; j <= cur; ++j) {
                if (!((bm >> j) & 1u)) continue;
                const int key = 64 * j + lane; const size_t kt = (size_t)(b * S + key);
                nsa_block(qs, Kb + kt * 128 + g * 64, key <= t && key >= lo, HY + (size_t)(b * S + 64 * j) * HYN + vc + g * 64, HYN, lane, ma, la, oa);
            }
            if (pass == 0) {
#pragma unroll
                for (int hh = 0; hh < 4; ++hh) o1[hh] = oa[hh] / la[hh];
            } else {
#pragma unroll
                for (int hh = 0; hh < 4; ++hh) o2[hh] = oa[hh] / la[hh];
            }
        }
#pragma unroll
        for (int hh = 0; hh < 4; ++hh) {
            const int head = g * 4 + hh;
            const float* gb = A->in[I_GATEB] + i * 24 + head * 3;
            const bf16* gl = HY + (size_t)tok * HYN + C_GA + head * 3;
            const float g0 = sigmoidf_(bf2f(gl[0]) + gb[0]), g1 = sigmoidf_(bf2f(gl[1]) + gb[1]), g2 = sigmoidf_(bf2f(gl[2]) + gb[2]);
            const float o = g0 * oc[hh] + g1 * o1[hh] + g2 * o2[hh];
            CAT[(size_t)tok * 1024 + head * 64 + lane] = (bf16)f2bf(o);
        }
    }
}

__device__ __forceinline__ void phase_gla_seq(KArgs A, int wv_, int i, LAS unsigned char* lds) {
    const int tid = opaque_tid(wv_), wid = __builtin_amdgcn_readfirstlane(tid >> 6), lane = tid & 63;
    unsigned char* ws = opq(A->ws);
    const bf16* HY = (const bf16*)(ws + WS_BIG); bf16* CAT = (bf16*)(ws + WS_CAT);
    constexpr int CH = 16;
    LAS float* la = (LAS float*)lds;
    LAS float* lk = la + 4 * CH * 64;
    LAS float* lq = lk + 4 * CH * 64;
    LAS float* lo = lq + 4 * CH * 64;
    const float* wa2 = A->in[I_WA2] + i * 16 * 256; const float* ba = A->in[I_BA] + i * 256; const float* og = A->in[I_ONORM] + i * 128;
    for (int it = blockIdx.x; it < 8; it += gridDim.x) {
        const int pl = tid >> 7, v = tid & 127, p = it * 4 + pl, b = p >> 2, h = p & 3;
        float St[64];
#pragma unroll
        for (int k = 0; k < 64; ++k) St[k] = 0.f;
        for (int c0 = 0; c0 < S; c0 += CH) {
            __syncthreads();
            for (int e = tid; e < 4 * CH * 64; e += 512) {
                const int kk = e & 63, tk = (e >> 6) % CH, pp = e / (64 * CH); const int pb = (it * 4 + pp) >> 2, ph = (it * 4 + pp) & 3;
                const size_t tok = (size_t)pb * S + c0 + tk; const bf16* row = HY + tok * HYN;
                float z = ba[ph * 64 + kk];
#pragma unroll
                for (int r = 0; r < 16; ++r) z += bf2f(row[C_AL + r]) * wa2[r * 256 + ph * 64 + kk];
                const float ls_ = fminf(z, 0.f) - log1pf(__expf(-fabsf(z)));
                la[e] = __expf(ls_ * (1.f / 16.f));
                lk[e] = bf2f(row[C_KB + ph * 64 + kk]);
                lq[e] = bf2f(row[C_QB + ph * 64 + kk]) * 0.125f;
            }
            __syncthreads();
            for (int tk = 0; tk < CH; ++tk) {
                const size_t tok = (size_t)b * S + c0 + tk;
                const float vv = bf2f(HY[tok * HYN + C_VB + h * 128 + v]);
                const LAS float* pa = la + (pl * CH + tk) * 64; const LAS float* pk = lk + (pl * CH + tk) * 64; const LAS float* pq = lq + (pl * CH + tk) * 64;
                float o = 0.f;
#pragma unroll
                for (int k4 = 0; k4 < 16; ++k4) {
                    const f32x4 a4 = *(const LAS f32x4*)(pa + 4 * k4), k4v = *(const LAS f32x4*)(pk + 4 * k4), q4 = *(const LAS f32x4*)(pq + 4 * k4);
                    St[4 * k4 + 0] = a4.x * St[4 * k4 + 0] + k4v.x * vv; o += q4.x * St[4 * k4 + 0];
                    St[4 * k4 + 1] = a4.y * St[4 * k4 + 1] + k4v.y * vv; o += q4.y * St[4 * k4 + 1];
                    St[4 * k4 + 2] = a4.z * St[4 * k4 + 2] + k4v.z * vv; o += q4.z * St[4 * k4 + 2];
                    St[4 * k4 + 3] = a4.w * St[4 * k4 + 3] + k4v.w * vv; o += q4.w * St[4 * k4 + 3];
                }
                lo[(pl * CH + tk) * 128 + v] = o;
            }
            __syncthreads();
            for (int r = wid; r < 4 * CH; r += 8) {
                const int pp = r / CH, tk = r % CH; const int pb = (it * 4 + pp) >> 2, ph = (it * 4 + pp) & 3;
                const size_t tok = (size_t)pb * S + c0 + tk;
                const float x0 = lo[r * 128 + lane], x1 = lo[r * 128 + 64 + lane];
                const float rstd = rsqrtf(wave_sum(x0 * x0 + x1 * x1) * (1.f / 128.f) + EPS);
                const float r0 = bf2f(HY[tok * HYN + C_RB + ph * 128 + lane]), r1 = bf2f(HY[tok * HYN + C_RB + ph * 128 + 64 + lane]);
                CAT[tok * 1024 + 512 + ph * 128 + lane] = (bf16)f2bf(x0 * rstd * og[lane] * (r0 * sigmoidf_(r0)));
                CAT[tok * 1024 + 512 + ph * 128 + 64 + lane] = (bf16)f2bf(x1 * rstd * og[64 + lane] * (r1 * sigmoidf_(r1)));
            }
        }
        __syncthreads();
    }
}


__device__ __forceinline__ void phase_nsa_attn_mfma(KArgs A, int wv_, int i, LAS unsigned char* lds) {
    const int tid = opaque_tid(wv_), wid = __builtin_amdgcn_readfirstlane(tid >> 6), lane = tid & 63, fr = lane & 15, fq = lane >> 4;
    unsigned char* ws = opq(A->ws);
    const bf16* HY = (const bf16*)(ws + WS_BIG); const bf16* QA = (const bf16*)(ws + WS_QA); const bf16* KS = (const bf16*)(ws + WS_KS); const bf16* KW = (const bf16*)(ws + WS_KW);
    const bf16* KC = (const bf16*)(ws + WS_KC); const bf16* VCT = (const bf16*)(ws + WS_VC); const bf16* VTA = (const bf16*)(ws + WS_VTA); bf16* CAT = (bf16*)(ws + WS_CAT);
    constexpr int RS = 72;
    LAS bf16* ktl = (LAS bf16*)lds;
    LAS bf16* vtl = ktl + 4 * 64 * RS;
    LAS float* scl = (LAS float*)(lds + 73728) + wid * 256;
    LAS unsigned* msk = (LAS unsigned*)(lds + 73728 + 8192);
    LAS unsigned* umask = msk + 64;
    const float* gb = A->in[I_GATEB] + i * 24;
    unsigned long long tsub = 0, tt0 = 0;
    for (int pit = blockIdx.x; pit < 256; pit += gridDim.x) {
#pragma unroll 1
        for (int hf = 0; hf < 2; ++hf) {
            const int bg = pit >> 4, xx = pit & 15, x = hf ? 31 - xx : xx, b = bg >> 1, g = bg & 1;
            const size_t tokbase = (size_t)b * S + 64 * x;
            const int tl0 = 8 * wid + (fr >> 2);
            if (tid == 0) *umask = 0u;
            if (PROBE_NSA == 1) tt0 = __builtin_amdgcn_s_memrealtime();
            bf16x8 qf[2][2];
#pragma unroll
            for (int mt = 0; mt < 2; ++mt)
#pragma unroll
                for (int s = 0; s < 2; ++s) qf[mt][s] = *(const bf16x8*)(QA + (tokbase + tl0 + 4 * mt) * 512 + (g * 4 + (fr & 3)) * 64 + 32 * s + 8 * fq);
            f32x4 outacc[2][4];
            {
                const int tmaxc = (4 * x + 3 + 15) >> 4;
                const bf16* kcb = KC + ((size_t)(b * 128 + fr) * 2 + g) * 64 + 8 * fq;
                bf16x8 pcf[2][4];
#pragma unroll
                for (int mt = 0; mt < 2; ++mt) {
                    f32x4 sc[8];
                    const bf16* kp = kcb;
#pragma unroll
                    for (int t = 0; t < 8; ++t) { sc[t] = (f32x4){0.f, 0.f, 0.f, 0.f};
                        asm volatile("" : "+v"(kp));
                        if (t < tmaxc) {
                            const bf16x8 k0 = *(const bf16x8*)(kp), k1 = *(const bf16x8*)(kp + 32);
                            sc[t] = __builtin_amdgcn_mfma_f32_16x16x32_bf16(k0, qf[mt][0], sc[t], 0, 0, 0);
                            sc[t] = __builtin_amdgcn_mfma_f32_16x16x32_bf16(k1, qf[mt][1], sc[t], 0, 0, 0); }
                        kp += 16 * 128; }
                    const int tg = 64 * x + tl0 + 4 * mt; const int ncv = tg >= 31 ? ((tg - 31) >> 4) + 1 : 0;
                    float mx = -INFINITY;
#pragma unroll
                    for (int t = 0; t < 8; ++t)
#pragma unroll
                        for (int r = 0; r < 4; ++r) { const bool v = 16 * t + 4 * fq + r < ncv; sc[t][r] = v ? sc[t][r] : -INFINITY; mx = fmaxf(mx, sc[t][r]); }
                    mx = fmaxf(mx, __shfl_xor(mx, 16)); mx = fmaxf(mx, __shfl_xor(mx, 32));
                    const float mxs = mx == -INFINITY ? 0.f : mx;
                    float sum = 0.f;
#pragma unroll
                    for (int t = 0; t < 8; ++t)
#pragma unroll
                        for (int r = 0; r < 4; ++r) { sc[t][r] = __builtin_amdgcn_exp2f(sc[t][r] - mxs); sum += sc[t][r]; }
                    sum += __shfl_xor(sum, 16); sum += __shfl_xor(sum, 32);
                    const float inv = sum > 0.f ? 1.f / sum : 0.f;
#pragma unroll
                    for (int t = 0; t < 8; ++t) sc[t] = sc[t] * inv;
#pragma unroll
                    for (int s = 0; s < 4; ++s) { u32x4 w; w.x = pk2(sc[2 * s].x, sc[2 * s].y); w.y = pk2(sc[2 * s].z, sc[2 * s].w); w.z = pk2(sc[2 * s + 1].x, sc[2 * s + 1].y); w.w = pk2(sc[2 * s + 1].z, sc[2 * s + 1].w);
                        pcf[mt][s] = __builtin_bit_cast(bf16x8, w); }
                    float w3[8];
#pragma unroll
                    for (int t = 0; t < 8; ++t) {
#pragma unroll
                        for (int r = 0; r < 4; ++r) { float v = sc[t][r]; v += __shfl_xor(v, 1); v += __shfl_xor(v, 2); sc[t][r] = v; }
                        w3[t] = __shfl(sc[t].w, (lane + 48) & 63);
                    }
#pragma unroll
                    for (int t = 0; t < 8; ++t) {
                        const float prev = fq > 0 ? w3[t] : (t > 0 ? w3[t > 0 ? t - 1 : 0] : 0.f);
                        const float imp = sc[t].x + sc[t].y + sc[t].z + 0.5f * sc[t].w + 0.5f * prev;
                        if ((fr & 3) == 0) scl[(4 * mt + (fr >> 2)) * 32 + 4 * t + fq] = imp;
                    }
                    asm volatile("" ::: "memory");
                }
                const bf16* vcb = VCT + ((size_t)(b * 2 + g) * 64 + fr) * 128 + 8 * fq;
#pragma unroll
                for (int n = 0; n < 4; ++n) {
                    outacc[0][n] = (f32x4){0.f, 0.f, 0.f, 0.f}; outacc[1][n] = (f32x4){0.f, 0.f, 0.f, 0.f};
                    asm volatile("" : "+v"(vcb));
#pragma unroll
                    for (int s = 0; s < 4; ++s) if (2 * s < tmaxc) {
                        const bf16x8 vf = *(const bf16x8*)(vcb + 32 * s);
                        outacc[0][n] = __builtin_amdgcn_mfma_f32_16x16x32_bf16(vf, pcf[0][s], outacc[0][n], 0, 0, 0);
                        outacc[1][n] = __builtin_amdgcn_mfma_f32_16x16x32_bf16(vf, pcf[1][s], outacc[1][n], 0, 0, 0); }
                    vcb += 16 * 128;
                    asm volatile("" ::: "memory");
                }
            }
            float g1v[2], g2v[2];
#pragma unroll
            for (int mt = 0; mt < 2; ++mt) {
                const int head = g * 4 + (fr & 3);
                const bf16* gl = HY + (tokbase + tl0 + 4 * mt) * HYN + C_GA + head * 3;
                const float g0 = sigmoidf_(bf2f(gl[0]) + gb[head * 3 + 0]);
                g1v[mt] = sigmoidf_(bf2f(gl[1]) + gb[head * 3 + 1]); g2v[mt] = sigmoidf_(bf2f(gl[2]) + gb[head * 3 + 2]);
#pragma unroll
                for (int n = 0; n < 4; ++n) outacc[mt][n] = outacc[mt][n] * g0;
            }
            LDS_WAIT();
            asm volatile("" ::: "memory");
            {
                const int tok8 = lane >> 3, jg = lane & 7;
                float sj[32];
#pragma unroll
                for (int q = 0; q < 8; ++q) { const f32x4 v = *(const LAS f32x4*)(scl + tok8 * 32 + 4 * q); sj[4 * q] = v.x; sj[4 * q + 1] = v.y; sj[4 * q + 2] = v.z; sj[4 * q + 3] = v.w; }
#pragma unroll
                for (int j = 0; j < 32; ++j) sj[j] = j <= x ? sj[j] + ((j == 0 || j == x || j == x - 1) ? 1000.0f : 0.f) : -INFINITY;
                unsigned bits = 0u;
                const f32x4 mv = *(const LAS f32x4*)(scl + tok8 * 32 + 4 * jg);
#pragma unroll
                for (int q = 0; q < 4; ++q) {
                    const int j = 4 * jg + q;
                    const float mine = j <= x ? mv[q] + ((j == 0 || j == x || j == x - 1) ? 1000.0f : 0.f) : -INFINITY;
                    int rank = 0;
#pragma unroll
                    for (int jj = 0; jj < 32; ++jj) rank += (sj[jj] > mine || (sj[jj] == mine && jj < j)) ? 1 : 0;
                    bits |= (j <= x && rank < 8) ? (1u << j) : 0u;
                }
                bits |= __shfl_xor(bits, 1); bits |= __shfl_xor(bits, 2); bits |= __shfl_xor(bits, 4);
                if (jg == 0) { msk[wid * 8 + tok8] = bits; atomicOr((unsigned*)umask, bits); }
            }
            __syncthreads();
            if (PROBE_NSA == 1) tsub += __builtin_amdgcn_s_memrealtime() - tt0;
#pragma unroll 1
            for (int pass = 0; pass < 2; ++pass) {
                if (PROBE_NSA == 2 + pass) tt0 = __builtin_amdgcn_s_memrealtime();
                const int jlo = pass ? (x >= 4 ? x - 4 : 0) : 0;
                const unsigned inrange = (x >= 31 ? 0xffffffffu : ((2u << x) - 1u)) & ~((1u << jlo) - 1u);
                unsigned bmask = pass ? inrange : (*umask & inrange);
                const bf16* Kb = pass ? KW : KS; const int cg = (pass ? 10 : 8) + g;
                unsigned tm[2], wm[2], am[2];
#pragma unroll
                for (int mt = 0; mt < 2; ++mt) {
                    tm[mt] = pass ? 0xffffffffu : msk[wid * 8 + 4 * mt + (fr >> 2)];
                    wm[mt] = pass ? 0xffffffffu : (msk[wid * 8 + 4 * mt] | msk[wid * 8 + 4 * mt + 1] | msk[wid * 8 + 4 * mt + 2] | msk[wid * 8 + 4 * mt + 3]);
                    am[mt] = pass ? 0xffffffffu : (msk[wid * 8 + 4 * mt] & msk[wid * 8 + 4 * mt + 1] & msk[wid * 8 + 4 * mt + 2] & msk[wid * 8 + 4 * mt + 3]);
                    wm[mt] = __builtin_amdgcn_readfirstlane(wm[mt]); am[mt] = __builtin_amdgcn_readfirstlane(am[mt]);
                }
                f32x4 o[2][4]; float mrun[2], lrun[2];
#pragma unroll
                for (int mt = 0; mt < 2; ++mt) { mrun[mt] = -INFINITY; lrun[mt] = 0.f;
#pragma unroll
                    for (int n = 0; n < 4; ++n) o[mt][n] = (f32x4){0.f, 0.f, 0.f, 0.f}; }
                const int srow = tid >> 3, sc16 = tid & 7;
                u32x4 pk0 = (u32x4){0u, 0u, 0u, 0u}, pv0 = pk0, pk1 = pk0, pv1 = pk0;
#define NSA_LD(jx, pk, pv) do { const bf16* ksrc = Kb + ((size_t)b * S + 64 * (jx) + srow) * 128 + g * 64 + sc16 * 8; const bf16* vsrc = VTA + ((size_t)((b * 32 + (jx)) * 12 + cg)) * 4096 + srow * 64 + sc16 * 8; \
                    pk = *(const u32x4*)ksrc; pv = *(const u32x4*)vsrc; } while (0)
                int j0 = __ffs(bmask) - 1; bmask &= bmask - 1u;
                int j1 = bmask ? __ffs(bmask) - 1 : -1; bmask &= bmask - 1u;
                NSA_LD(j0, pk0, pv0); if (j1 >= 0) NSA_LD(j1, pk1, pv1);
                int buf = 0;
                while (j0 >= 0) {
                    *(LAS u32x4*)(ktl + (buf * 2 + 0) * 64 * RS + srow * RS + sc16 * 8) = pk0; *(LAS u32x4*)(vtl + (buf * 2 + 0) * 64 * RS + srow * RS + sc16 * 8) = pv0;
                    if (j1 >= 0) { *(LAS u32x4*)(ktl + (buf * 2 + 1) * 64 * RS + srow * RS + sc16 * 8) = pk1; *(LAS u32x4*)(vtl + (buf * 2 + 1) * 64 * RS + srow * RS + sc16 * 8) = pv1; }
                    const int jn0 = bmask ? __ffs(bmask) - 1 : -1; bmask &= bmask - 1u;
                    const int jn1 = bmask ? __ffs(bmask) - 1 : -1; bmask &= bmask - 1u;
                    if (jn0 >= 0) NSA_LD(jn0, pk0, pv0);
                    if (jn1 >= 0) NSA_LD(jn1, pk1, pv1);
                    __syncthreads();
#pragma unroll 1
                    for (int sub = 0; sub < 2; ++sub) {
                        const int j = sub ? j1 : j0;
                        if (j < 0) break;
                        const LAS bf16* kt = ktl + (buf * 2 + sub) * 64 * RS + fr * RS + 8 * fq; const LAS bf16* vt = vtl + (buf * 2 + sub) * 64 * RS + fr * RS + 8 * fq;
#pragma unroll
                        for (int mt = 0; mt < 2; ++mt) {
                            if (!((wm[mt] >> j) & 1u)) continue;
                            f32x4 sc[4];
#pragma unroll
                            for (int t = 0; t < 4; ++t) { sc[t] = (f32x4){0.f, 0.f, 0.f, 0.f};
                                sc[t] = __builtin_amdgcn_mfma_f32_16x16x32_bf16(*(const LAS bf16x8*)(kt + t * 16 * RS), qf[mt][0], sc[t], 0, 0, 0);
                                sc[t] = __builtin_amdgcn_mfma_f32_16x16x32_bf16(*(const LAS bf16x8*)(kt + t * 16 * RS + 32), qf[mt][1], sc[t], 0, 0, 0); }
                            const int tl = tl0 + 4 * mt;
                            const bool rowok = (tm[mt] >> j) & 1u;
                            const bool edge = (j == x) || (pass && j == x - 4);
                            float bm = -INFINITY;
                            if (edge) {
                                const int kphi = j == x ? tl : 63;
                                const int kplo = (pass && j == x - 4) ? tl + 1 : 0;
#pragma unroll
                                for (int t = 0; t < 4; ++t)
#pragma unroll
                                    for (int r = 0; r < 4; ++r) { const int kp = 16 * t + 4 * fq + r; const bool v = rowok && kp <= kphi && kp >= kplo; sc[t][r] = v ? sc[t][r] : -INFINITY; bm = fmaxf(bm, sc[t][r]); }
                            } else {
#pragma unroll
                                for (int t = 0; t < 4; ++t) bm = fmaxf(bm, fmaxf(fmaxf(sc[t].x, sc[t].y), fmaxf(sc[t].z, sc[t].w)));
                                if (!((am[mt] >> j) & 1u)) bm = rowok ? bm : -INFINITY;
                            }
                            bm = fmaxf(bm, __shfl_xor(bm, 16)); bm = fmaxf(bm, __shfl_xor(bm, 32));
                            const float mn = fmaxf(mrun[mt], bm); const float mns = mn == -INFINITY ? 0.f : mn;
                            float rs = 0.f;
#pragma unroll
                            for (int t = 0; t < 4; ++t)
#pragma unroll
                                for (int r = 0; r < 4; ++r) { sc[t][r] = __builtin_amdgcn_exp2f(sc[t][r] - mns); rs += sc[t][r]; }
                            if (!edge && !((am[mt] >> j) & 1u)) {
#pragma unroll
                                for (int t = 0; t < 4; ++t) sc[t] = rowok ? sc[t] : (f32x4){0.f, 0.f, 0.f, 0.f};
                                rs = rowok ? rs : 0.f;
                            }
                            rs += __shfl_xor(rs, 16); rs += __shfl_xor(rs, 32);
                            if (__all(mn == mrun[mt])) { lrun[mt] += rs; }
                            else {
                                const float alpha = __builtin_amdgcn_exp2f(mrun[mt] - mns);
                                lrun[mt] = lrun[mt] * alpha + rs; mrun[mt] = mn;
#pragma unroll
                                for (int n = 0; n < 4; ++n) o[mt][n] = o[mt][n] * alpha;
                            }
                            bf16x8 pf[2];
#pragma unroll
                            for (int s = 0; s < 2; ++s) { u32x4 w; w.x = pk2(sc[2 * s].x, sc[2 * s].y); w.y = pk2(sc[2 * s].z, sc[2 * s].w); w.z = pk2(sc[2 * s + 1].x, sc[2 * s + 1].y); w.w = pk2(sc[2 * s + 1].z, sc[2 * s + 1].w);
                                pf[s] = __builtin_bit_cast(bf16x8, w); }
#pragma unroll
                            for (int n = 0; n < 4; ++n) {
                                o[mt][n] = __builtin_amdgcn_mfma_f32_16x16x32_bf16(*(const LAS bf16x8*)(vt + n * 16 * RS), pf[0], o[mt][n], 0, 0, 0);
                                o[mt][n] = __builtin_amdgcn_mfma_f32_16x16x32_bf16(*(const LAS bf16x8*)(vt + n * 16 * RS + 32), pf[1], o[mt][n], 0, 0, 0); }
                        }
                    }
                    j0 = jn0; j1 = jn1; buf ^= 1;
                }
#undef NSA_LD
#pragma unroll
                for (int mt = 0; mt < 2; ++mt) { const float sc_ = (pass ? g2v[mt] : g1v[mt]) / lrun[mt];
#pragma unroll
                    for (int n = 0; n < 4; ++n) outacc[mt][n] = outacc[mt][n] + o[mt][n] * sc_; }
                __syncthreads();
                if (PROBE_NSA == 2 + pass) tsub += __builtin_amdgcn_s_memrealtime() - tt0;
            }
#pragma unroll
            for (int mt = 0; mt < 2; ++mt) {
                bf16* dst = CAT + (tokbase + tl0 + 4 * mt) * 1024 + (g * 4 + (fr & 3)) * 64 + 4 * fq;
#pragma unroll
                for (int n = 0; n < 4; ++n) { u32x2 w; w.x = pk2(outacc[mt][n].x, outacc[mt][n].y); w.y = pk2(outacc[mt][n].z, outacc[mt][n].w); *(u32x2*)(dst + 16 * n) = w; }
            }
        }
    }
    __syncthreads();
    if (PROBE_NSA && blockIdx.x == 0 && tid == 0) atomicAdd((unsigned long long*)(ws + WS_CTL + 48000), tsub);
}

__device__ __forceinline__ void phase_vtiles(KArgs A, int wv_, LAS unsigned char* lds) {
    const int tid_ = opaque_tid(wv_); const int wid = __builtin_amdgcn_readfirstlane(tid_ >> 6), lane = tid_ & 63; const int gw = blockIdx.x * 8 + wid, NGW = gridDim.x * 8;
    unsigned char* ws = opq(A->ws);
    const bf16* HY = (const bf16*)(ws + WS_BIG); bf16* VTA = (bf16*)(ws + WS_VTA);
    constexpr int TS = 66;
    LAS bf16* tl = (LAS bf16*)(lds + 65536) + wid * (64 * TS);
    for (int it = gw; it < NBATCH * 32 * 12; it += NGW) {
        const int cg = it % 12, bc = it / 12;
        const int colbase = cg < 8 ? C_VB + cg * 64 : (cg < 10 ? C_VS + (cg - 8) * 64 : C_VW + (cg - 10) * 64);
        const u32x4* src = (const u32x4*)(HY + (size_t)(bc * 64 + lane) * HYN + colbase);
        u32x4 w[8];
#pragma unroll
        for (int i = 0; i < 8; ++i) w[i] = src[i];
#pragma unroll
        for (int i = 0; i < 8; ++i) { LAS unsigned* d = (LAS unsigned*)(tl + lane * TS + 8 * i); d[0] = w[i].x; d[1] = w[i].y; d[2] = w[i].z; d[3] = w[i].w; }
        LDS_WAIT();
        bf16* dst = VTA + (size_t)it * 4096 + lane * 64;
#pragma unroll
        for (int p8 = 0; p8 < 8; ++p8) {
            unsigned short x[8];
#pragma unroll
            for (int j = 0; j < 8; ++j) x[j] = tl[kperm64(p8 * 8 + j) * TS + lane];
            u32x4 o; o.x = x[0] | ((unsigned)x[1] << 16); o.y = x[2] | ((unsigned)x[3] << 16); o.z = x[4] | ((unsigned)x[5] << 16); o.w = x[6] | ((unsigned)x[7] << 16);
            *(u32x4*)(dst + p8 * 8) = o;
        }
        LDS_WAIT();
    }
}

__device__ __forceinline__ float log_sigmoid16(float z) { return (fminf(z, 0.f) - __logf(1.0f + __expf(-fabsf(z)))) * (1.f / 16.f); }
#define GLA_Z(tokv) ({ float z_ = bias; _Pragma("unroll") for (int r_ = 0; r_ < 16; ++r_) z_ += __builtin_bit_cast(float, __builtin_amdgcn_readlane(__builtin_bit_cast(int, al[r_]), (tokv))) * wc[r_]; z_; })
#define GLA_LOAD_GATE() \
    float al[16], wc[16]; \
    { const u32x4* ap_ = (const u32x4*)(HY + (size_t)(tok0 + lane) * HYN + C_AL); const u32x4 a0_ = ap_[0], a1_ = ap_[1]; \
      al[0] = bflo(a0_.x); al[1] = bfhi(a0_.x); al[2] = bflo(a0_.y); al[3] = bfhi(a0_.y); al[4] = bflo(a0_.z); al[5] = bfhi(a0_.z); al[6] = bflo(a0_.w); al[7] = bfhi(a0_.w); \
      al[8] = bflo(a1_.x); al[9] = bfhi(a1_.x); al[10] = bflo(a1_.y); al[11] = bfhi(a1_.y); al[12] = bflo(a1_.z); al[13] = bfhi(a1_.z); al[14] = bflo(a1_.w); al[15] = bfhi(a1_.w); } \
    _Pragma("unroll") for (int r_ = 0; r_ < 16; ++r_) wc[r_] = A->in[I_WA2][(i * 16 + r_) * 256 + h * 64 + lane]; \
    const float bias = A->in[I_BA][i * 256 + h * 64 + lane];

__device__ __forceinline__ void phase_gla_a(KArgs A, int wv_, int i, LAS unsigned char* lds) {
    const int tid_ = opaque_tid(wv_); const int wid = __builtin_amdgcn_readfirstlane(tid_ >> 6), lane = tid_ & 63, fr = lane & 15, fq = lane >> 4; const int gw = blockIdx.x * 8 + wid, NGW = gridDim.x * 8;
    unsigned char* ws = opq(A->ws);
    const bf16* HY = (const bf16*)(ws + WS_BIG); const bf16* VTA = (const bf16*)(ws + WS_VTA); float* SLOC = (float*)(ws + WS_SLOC); float* DEC = (float*)(ws + WS_DEC);
    constexpr int RS = 72;
    LAS bf16* kh = (LAS bf16*)lds + wid * (64 * RS);
    (void)gw;
    for (int it = wid * (int)gridDim.x + (int)blockIdx.x; it < 1024; it += NGW) {
        const int c = it & 31, bh = it >> 5, b = bh >> 2, h = bh & 3; const size_t tok0 = (size_t)b * S + c * 64;
        GLA_LOAD_GATE();
        float bl = 0.f;
#pragma unroll 8
        for (int tk = 0; tk < 64; ++tk) bl += log_sigmoid16(GLA_Z(tk));
        float bc = 0.f;
        unsigned short kcol[64];
#pragma unroll
        for (int tk = 0; tk < 64; ++tk) kcol[tk] = HY[(tok0 + tk) * HYN + C_KB + h * 64 + lane];
#pragma unroll
        for (int tk = 0; tk < 64; ++tk) {
            bc += log_sigmoid16(GLA_Z(tk));
            kh[lane * RS + kpos64(tk)] = (bf16)f2bf(bf2f(kcol[tk]) * __expf(bl - bc));
        }
        DEC[it * 64 + lane] = __expf(bl);
        LDS_WAIT();
#pragma unroll
        for (int dvh = 0; dvh < 2; ++dvh) {
            const bf16* vt = VTA + ((size_t)((b * 32 + c) * 12 + h * 2 + dvh)) * 4096;
            bf16x8 vf[4][2];
#pragma unroll
            for (int n = 0; n < 4; ++n)
#pragma unroll
                for (int s = 0; s < 2; ++s) vf[n][s] = *(const bf16x8*)(vt + (16 * n + fr) * 64 + 32 * s + 8 * fq);
#pragma unroll
            for (int m = 0; m < 4; ++m) {
                const bf16x8 a0 = *(const LAS bf16x8*)(kh + (16 * m + fr) * RS + 8 * fq), a1 = *(const LAS bf16x8*)(kh + (16 * m + fr) * RS + 32 + 8 * fq);
#pragma unroll
                for (int n = 0; n < 4; ++n) {
                    f32x4 acc = (f32x4){0.f, 0.f, 0.f, 0.f};
                    acc = __builtin_amdgcn_mfma_f32_16x16x32_bf16(a0, vf[n][0], acc, 0, 0, 0);
                    acc = __builtin_amdgcn_mfma_f32_16x16x32_bf16(a1, vf[n][1], acc, 0, 0, 0);
                    float* dst = SLOC + ((size_t)it * 64 + 16 * m + 4 * fq) * 128 + dvh * 64 + 16 * n + fr;
                    dst[0] = acc.x; dst[128] = acc.y; dst[256] = acc.z; dst[384] = acc.w;
                }
            }
        }
        LDS_WAIT();
    }
}
__device__ __forceinline__ void phase_gla_c(KArgs A, int wv_, int i, LAS unsigned char* lds) {
    const int tid_ = opaque_tid(wv_); const int wid = __builtin_amdgcn_readfirstlane(tid_ >> 6), lane = tid_ & 63, fr = lane & 15, fq = lane >> 4; const int gw = blockIdx.x * 8 + wid, NGW = gridDim.x * 8;
    unsigned char* ws = opq(A->ws);
    const bf16* HY = (const bf16*)(ws + WS_BIG); const bf16* VTA = (const bf16*)(ws + WS_VTA); const bf16* STT = (const bf16*)(ws + WS_STT); bf16* CAT = (bf16*)(ws + WS_CAT);
    constexpr int RS = 72;
    LAS bf16* qs = (LAS bf16*)lds + wid * (128 * RS);
    LAS bf16* ks = qs + 64 * RS;
    const float* og = A->in[I_ONORM] + i * 128;
    LAS float* ogl = (LAS float*)(lds + 8 * 128 * RS * 2);
    if (tid_ < 128) ogl[tid_] = og[tid_];
    (void)gw; (void)NGW;
    for (int blk = blockIdx.x; blk < 256; blk += gridDim.x) {
        SUBT_BEGIN(1);
        {
            const float* SLOC = (const float*)(ws + WS_SLOC); const float* DEC = (const float*)(ws + WS_DEC); bf16* STw = (bf16*)(ws + WS_STT);
            const int tid = tid_, dv = tid & 127, ko = tid >> 7, bh = blk >> 3, c0 = (blk & 7) * 4;
            float sv[16];
#pragma unroll
            for (int j = 0; j < 16; ++j) sv[j] = 0.f;
#pragma unroll 1
            for (int cb = 0; cb < c0 + 4; cb += 4) {
                float dc4[4][16], sl4[4][16];
#pragma unroll
                for (int q = 0; q < 4; ++q) {
                    const size_t item = (size_t)bh * 32 + cb + q; const float* sl = SLOC + (item * 64 + ko * 16) * 128 + dv; const float* dc = DEC + item * 64 + ko * 16;
#pragma unroll
                    for (int j = 0; j < 16; ++j) { dc4[q][j] = dc[j]; sl4[q][j] = sl[j * 128]; }
                }
#pragma unroll
                for (int q = 0; q < 4; ++q) {
                    const int c = cb + q; const size_t item = (size_t)bh * 32 + c;
                    if (c >= c0) {
                        u32x4 o0, o1; o0.x = pk2(sv[0], sv[1]); o0.y = pk2(sv[2], sv[3]); o0.z = pk2(sv[4], sv[5]); o0.w = pk2(sv[6], sv[7]);
                        o1.x = pk2(sv[8], sv[9]); o1.y = pk2(sv[10], sv[11]); o1.z = pk2(sv[12], sv[13]); o1.w = pk2(sv[14], sv[15]);
                        u32x4* d = (u32x4*)(STw + (item * 128 + dv) * 64 + ko * 16); d[0] = o0; d[1] = o1;
                    }
#pragma unroll
                    for (int j = 0; j < 16; ++j) sv[j] = dc4[q][j] * sv[j] + sl4[q][j];
                }
            }
            asm volatile("s_waitcnt vmcnt(0)" ::: "memory");
            __syncthreads();
        }
        SUBT_END(1, ws, tid_);
        SUBT_BEGIN(2);
        SUBT_BEGIN(3);
        if (wid < 4) {
        const int it = blk * 4 + wid;
        const int c = it & 31, bh = it >> 5, b = bh >> 2, h = bh & 3; const size_t tok0 = (size_t)b * S + c * 64;
        GLA_LOAD_GATE();
        float bc = 0.f;
        unsigned short qcol[64], kcol[64];
#pragma unroll
        for (int tk = 0; tk < 64; ++tk) { const bf16* row = HY + (tok0 + tk) * HYN; qcol[tk] = row[C_QB + h * 64 + lane]; kcol[tk] = row[C_KB + h * 64 + lane]; }
#pragma unroll
        for (int tk = 0; tk < 64; ++tk) {
            bc += log_sigmoid16(GLA_Z(tk));
            const float eb = __expf(bc);
            qs[tk * RS + lane] = (bf16)f2bf(bf2f(qcol[tk]) * 0.125f * eb); ks[tk * RS + lane] = (bf16)f2bf(bf2f(kcol[tk]) / eb);
        }
        LDS_WAIT();
        SUBT_END(2, ws, tid_);
        bf16x8 st[8][2];
#pragma unroll
        for (int n = 0; n < 8; ++n)
#pragma unroll
            for (int s = 0; s < 2; ++s) st[n][s] = *(const bf16x8*)(STT + ((size_t)it * 128 + 16 * n + fr) * 64 + 32 * s + 8 * fq);
        const bf16* vt = VTA + ((size_t)((b * 32 + c) * 12 + h * 2)) * 4096;
        bf16x8 vfr[8][2];
#pragma unroll
        for (int n = 0; n < 8; ++n) { const bf16* vrow = vt + (size_t)(n >> 2) * 4096 + (16 * (n & 3) + fr) * 64 + 8 * fq; vfr[n][0] = *(const bf16x8*)vrow; vfr[n][1] = *(const bf16x8*)(vrow + 32); }
#pragma unroll
        for (int mi = 0; mi < 4; ++mi) {
            const bf16x8 q0 = *(const LAS bf16x8*)(qs + (16 * mi + fr) * RS + 8 * fq), q1 = *(const LAS bf16x8*)(qs + (16 * mi + fr) * RS + 32 + 8 * fq);
            u32x2 rwv[8];
#pragma unroll
            for (int n = 0; n < 8; ++n) rwv[n] = *(const u32x2*)(HY + (tok0 + 16 * mi + fr) * HYN + C_RB + h * 128 + 16 * n + 4 * fq);
            f32x4 sc[4];
#pragma unroll
            for (int t = 0; t < 4; ++t) {
                sc[t] = (f32x4){0.f, 0.f, 0.f, 0.f};
                if (t <= mi) {
                    const bf16x8 k0 = *(const LAS bf16x8*)(ks + (16 * t + fr) * RS + 8 * fq), k1 = *(const LAS bf16x8*)(ks + (16 * t + fr) * RS + 32 + 8 * fq);
                    sc[t] = __builtin_amdgcn_mfma_f32_16x16x32_bf16(k0, q0, sc[t], 0, 0, 0);
                    sc[t] = __builtin_amdgcn_mfma_f32_16x16x32_bf16(k1, q1, sc[t], 0, 0, 0);
                    if (t == mi) {
                        sc[t].x = (4 * fq + 0 <= fr) ? sc[t].x : 0.f; sc[t].y = (4 * fq + 1 <= fr) ? sc[t].y : 0.f; sc[t].z = (4 * fq + 2 <= fr) ? sc[t].z : 0.f; sc[t].w = (4 * fq + 3 <= fr) ? sc[t].w : 0.f; }
                }
            }
            bf16x8 pf[2];
#pragma unroll
            for (int s = 0; s < 2; ++s) { u32x4 w; w.x = pk2(sc[2 * s].x, sc[2 * s].y); w.y = pk2(sc[2 * s].z, sc[2 * s].w); w.z = pk2(sc[2 * s + 1].x, sc[2 * s + 1].y); w.w = pk2(sc[2 * s + 1].z, sc[2 * s + 1].w);
                pf[s] = __builtin_bit_cast(bf16x8, w); }
            f32x4 o[8]; float ssq = 0.f;
#pragma unroll
            for (int n = 0; n < 8; ++n) {
                o[n] = (f32x4){0.f, 0.f, 0.f, 0.f};
                o[n] = __builtin_amdgcn_mfma_f32_16x16x32_bf16(st[n][0], q0, o[n], 0, 0, 0);
                o[n] = __builtin_amdgcn_mfma_f32_16x16x32_bf16(st[n][1], q1, o[n], 0, 0, 0);
                o[n] = __builtin_amdgcn_mfma_f32_16x16x32_bf16(vfr[n][0], pf[0], o[n], 0, 0, 0);
                if (mi >= 2) o[n] = __builtin_amdgcn_mfma_f32_16x16x32_bf16(vfr[n][1], pf[1], o[n], 0, 0, 0);
                ssq += (o[n].x * o[n].x + o[n].y * o[n].y) + (o[n].z * o[n].z + o[n].w * o[n].w);
            }
            ssq += __shfl_xor(ssq, 16); ssq += __shfl_xor(ssq, 32);
            const float rstd = rsqrtf(ssq * (1.f / 128.f) + EPS);
            const size_t tok = tok0 + 16 * mi + fr;
#pragma unroll
            for (int n = 0; n < 8; ++n) {
                const int dv = 16 * n + 4 * fq;
                const u32x2 rw = rwv[n]; const f32x4 g = *(const LAS f32x4*)(ogl + dv);
                const float r0 = bflo(rw.x), r1 = bfhi(rw.x), r2 = bflo(rw.y), r3 = bfhi(rw.y);
                u32x2 w; w.x = pk2(o[n].x * rstd * g.x * (r0 * sigmoidf_(r0)), o[n].y * rstd * g.y * (r1 * sigmoidf_(r1)));
                w.y = pk2(o[n].z * rstd * g.z * (r2 * sigmoidf_(r2)), o[n].w * rstd * g.w * (r3 * sigmoidf_(r3)));
                *(u32x2*)(CAT + tok * 1024 + 512 + h * 128 + dv) = w;
            }
        }
        }
        SUBT_END(3, ws, tid_);
        LDS_WAIT();
        __syncthreads();
    }
}

__device__ __forceinline__ void phase_sgu_mix(KArgs A, int wv_, int i, LAS unsigned char* lds) {
    const int tid = opaque_tid(wv_), wid = __builtin_amdgcn_readfirstlane(tid >> 6), lane = tid & 63;
    unsigned char* ws = opq(A->ws);
    const bf16* U = (const bf16*)(ws + WS_U); const bf16* V = (const bf16*)(ws + WS_V); bf16* UM = (bf16*)(ws + WS_UM);
    LAS float* vt = (LAS float*)lds;
    LAS float* st = vt + 128 * 256;
    const float* lng = A->in[I_LNG] + i * 2048; const float* lnb = A->in[I_LNB] + i * 2048;
    for (int it = blockIdx.x; it < NBATCH * 16 * 8; it += gridDim.x) {
        const int g = it & 7, n = (it >> 3) & 15, b = it >> 7;
        const size_t tok0 = (size_t)b * S + n * 128;
        __syncthreads();
        for (int s = wid * 16; s < wid * 16 + 16; ++s) {
            const u32x4* vr = (const u32x4*)(V + (tok0 + s) * 2048) + lane;
            float x[32]; float sum = 0.f;
#pragma unroll
            for (int j = 0; j < 4; ++j) { const u32x4 w = vr[64 * j];
                x[8 * j + 0] = bflo(w.x); x[8 * j + 1] = bfhi(w.x); x[8 * j + 2] = bflo(w.y); x[8 * j + 3] = bfhi(w.y); x[8 * j + 4] = bflo(w.z); x[8 * j + 5] = bfhi(w.z); x[8 * j + 6] = bflo(w.w); x[8 * j + 7] = bfhi(w.w); }
#pragma unroll
            for (int j = 0; j < 32; ++j) sum += x[j];
            const float mean = wave_sum(sum) * (1.f / 2048.f); float q = 0.f;
#pragma unroll
            for (int j = 0; j < 32; ++j) { const float d = x[j] - mean; q += d * d; }
            const float rstd = rsqrtf(wave_sum(q) * (1.f / 2048.f) + EPS);
            const u32x2 w = *((const u32x2*)(V + (tok0 + s) * 2048 + g * 256) + lane);
            const f32x4 gg = *(const f32x4*)(lng + g * 256 + 4 * lane), bb = *(const f32x4*)(lnb + g * 256 + 4 * lane);
            f32x4 o; o.x = (bflo(w.x) - mean) * rstd * gg.x + bb.x; o.y = (bfhi(w.x) - mean) * rstd * gg.y + bb.y; o.z = (bflo(w.y) - mean) * rstd * gg.z + bb.z; o.w = (bfhi(w.y) - mean) * rstd * gg.w + bb.w;
            *(LAS f32x4*)(vt + s * 256 + 4 * lane) = o;
            (void)st;
        }
        __syncthreads();
        const int c = tid & 255, th = tid >> 8;
        const float* wsg = A->in[I_SGWS] + (size_t)(i * 8 + g) * 128 * 128; const float* bsg = A->in[I_SGBS] + (i * 8 + g) * 128;
        for (int tt = 0; tt < 64; ++tt) {
            const int t = 2 * tt + th;
            const float* wr = wsg + t * 128;
            float acc = 0.f;
            for (int s = 0; s <= t; ++s) acc += wr[s] * vt[s * 256 + c];
            acc += bsg[t];
            const float u = bf2f(U[(tok0 + t) * 2048 + g * 256 + c]);
            UM[(tok0 + t) * 2048 + g * 256 + c] = (bf16)f2bf(u * acc);
        }
    }
    __syncthreads();
}


__device__ __forceinline__ void phase_sgu_mix_mfma(KArgs A, int wv_, int i, LAS unsigned char* lds) {
    const int tid = opaque_tid(wv_), wid = __builtin_amdgcn_readfirstlane(tid >> 6), lane = tid & 63, fr = lane & 15, fq = lane >> 4;
    unsigned char* ws = opq(A->ws);
    const bf16* U = (const bf16*)(ws + WS_U); const bf16* V = (const bf16*)(ws + WS_V); bf16* UM = (bf16*)(ws + WS_UM);
    const bf16* WSB = (const bf16*)(ws + WS_WSB) + (size_t)i * 8 * 16384; const float* M0 = (const float*)(ws + WS_M0) + i * 8 * 128;
    constexpr int VS = 136;
    LAS bf16* vT = (LAS bf16*)lds;
    LAS float* st = (LAS float*)(lds + 256 * VS * 2);
    LAS bf16* wl = (LAS bf16*)(lds + 256 * VS * 2 + 1024);
    const float* lng = A->in[I_LNG] + i * 2048; const float* lnb = A->in[I_LNB] + i * 2048; const float* bsg = A->in[I_SGBS] + i * 8 * 128;
    for (int it = blockIdx.x; it < 256; it += gridDim.x) {
        const int gh = it & 1, n_ = (it >> 1) & 15, b = it >> 5; const size_t tok0 = (size_t)b * S + n_ * 128;
        __syncthreads();
        for (int s4 = wid * 16; s4 < wid * 16 + 16; s4 += 4) {
            u32x4 w[4][4];
#pragma unroll
            for (int rr = 0; rr < 4; ++rr) { const u32x4* vr = (const u32x4*)(V + (tok0 + s4 + rr) * 2048) + lane;
#pragma unroll
                for (int j = 0; j < 4; ++j) w[rr][j] = vr[64 * j]; }
#pragma unroll
            for (int rr = 0; rr < 4; ++rr) {
                float sum = 0.f, sq = 0.f;
#pragma unroll
                for (int j = 0; j < 4; ++j) { const float x0 = bflo(w[rr][j].x), x1 = bfhi(w[rr][j].x), x2 = bflo(w[rr][j].y), x3 = bfhi(w[rr][j].y), x4 = bflo(w[rr][j].z), x5 = bfhi(w[rr][j].z), x6 = bflo(w[rr][j].w), x7 = bfhi(w[rr][j].w);
                    sum += ((x0 + x1) + (x2 + x3)) + ((x4 + x5) + (x6 + x7)); sq += ((x0 * x0 + x1 * x1) + (x2 * x2 + x3 * x3)) + ((x4 * x4 + x5 * x5) + (x6 * x6 + x7 * x7)); }
                sum = wave_sum(sum); sq = wave_sum(sq);
                const float mean = sum * (1.f / 2048.f); const float var = fmaxf(sq * (1.f / 2048.f) - mean * mean, 0.f);
                if (lane == 0) { st[2 * (s4 + rr)] = mean; st[2 * (s4 + rr) + 1] = rsqrtf(var + EPS); }
            }
        }
#pragma unroll 1
        for (int gg = 0; gg < 4; ++gg) {
            const int g = gh * 4 + gg;
            __syncthreads();
            {
                const int s = tid & 127, cq = tid >> 7;
                const float mean = st[2 * s], rstd = st[2 * s + 1];
                const u32x4* src = (const u32x4*)(V + (tok0 + s) * 2048 + g * 256 + cq * 64);
                u32x4 w8[8], ww[4];
#pragma unroll
                for (int i8 = 0; i8 < 8; ++i8) w8[i8] = src[i8];
#pragma unroll
                for (int q = 0; q < 4; ++q) { const int e = tid + 512 * q; ww[q] = *(const u32x4*)(WSB + ((size_t)g * 128 + (e >> 4)) * 128 + (e & 15) * 8); }
#pragma unroll
                for (int i8 = 0; i8 < 8; ++i8) {
                    const u32x4 w = w8[i8];
                    LAS bf16* d = vT + (cq * 64 + i8 * 8) * VS + s;
                    d[0 * VS] = (bf16)f2bf((bflo(w.x) - mean) * rstd); d[1 * VS] = (bf16)f2bf((bfhi(w.x) - mean) * rstd); d[2 * VS] = (bf16)f2bf((bflo(w.y) - mean) * rstd); d[3 * VS] = (bf16)f2bf((bfhi(w.y) - mean) * rstd);
                    d[4 * VS] = (bf16)f2bf((bflo(w.z) - mean) * rstd); d[5 * VS] = (bf16)f2bf((bfhi(w.z) - mean) * rstd); d[6 * VS] = (bf16)f2bf((bflo(w.w) - mean) * rstd); d[7 * VS] = (bf16)f2bf((bfhi(w.w) - mean) * rstd);
                }
#pragma unroll
                for (int q = 0; q < 4; ++q) { const int e = tid + 512 * q; *(LAS u32x4*)(wl + (e >> 4) * VS + (e & 15) * 8) = ww[q]; }
            }
            u32x2 uw[8][2]; float m0v[8], bsv[8];
#pragma unroll
            for (int n = 0; n < 8; ++n) { const int t = 16 * n + fr; m0v[n] = M0[g * 128 + t]; bsv[n] = bsg[g * 128 + t];
                const size_t ro = (tok0 + t) * 2048 + g * 256 + 32 * wid + 4 * fq; uw[n][0] = *(const u32x2*)(U + ro); uw[n][1] = *(const u32x2*)(U + ro + 16); }
            __syncthreads();
            bf16x8 vf[2][4];
#pragma unroll
            for (int m = 0; m < 2; ++m)
#pragma unroll
                for (int k = 0; k < 4; ++k) vf[m][k] = *(const LAS bf16x8*)(vT + (32 * wid + 16 * m + fr) * VS + 32 * k + 8 * fq);
            f32x4 gc[2], bc[2];
#pragma unroll
            for (int m = 0; m < 2; ++m) { gc[m] = *(const f32x4*)(lng + g * 256 + 32 * wid + 16 * m + 4 * fq); bc[m] = *(const f32x4*)(lnb + g * 256 + 32 * wid + 16 * m + 4 * fq); }
#pragma unroll
            for (int n = 0; n < 8; ++n) {
                f32x4 a0 = (f32x4){0.f, 0.f, 0.f, 0.f}, a1 = (f32x4){0.f, 0.f, 0.f, 0.f};
#pragma unroll
                for (int k = 0; k < 4; ++k) if (k <= (n >> 1)) {
                    const bf16x8 wf = *(const LAS bf16x8*)(wl + (16 * n + fr) * VS + 32 * k + 8 * fq);
                    a0 = __builtin_amdgcn_mfma_f32_16x16x32_bf16(vf[0][k], wf, a0, 0, 0, 0);
                    a1 = __builtin_amdgcn_mfma_f32_16x16x32_bf16(vf[1][k], wf, a1, 0, 0, 0); }
                const int t = 16 * n + fr; const float m0 = m0v[n], bsv_ = bsv[n];
                const size_t ro = (tok0 + t) * 2048 + g * 256 + 32 * wid + 4 * fq;
#pragma unroll
                for (int m = 0; m < 2; ++m) {
                    const f32x4 a = m ? a1 : a0;
                    const u32x2 uw_ = uw[n][m];
                    u32x2 w; w.x = pk2((a.x * gc[m].x + bc[m].x * m0 + bsv_) * bflo(uw_.x), (a.y * gc[m].y + bc[m].y * m0 + bsv_) * bfhi(uw_.x));
                    w.y = pk2((a.z * gc[m].z + bc[m].z * m0 + bsv_) * bflo(uw_.y), (a.w * gc[m].w + bc[m].w * m0 + bsv_) * bfhi(uw_.y));
                    *(u32x2*)(UM + ro + 16 * m) = w;
                }
            }
        }
    }
    __syncthreads();
}

__device__ __forceinline__ void phase_rownorm(KArgs A, int wv_) {
    const int tid_ = opaque_tid(wv_); const int wid = __builtin_amdgcn_readfirstlane(tid_ >> 6), lane = tid_ & 63; const int gw = blockIdx.x * 8 + wid, NGW = gridDim.x * 8;
    bf16* XN = (bf16*)(opq(A->ws) + WS_XN); const float* X = A->out;
    f32x4 v[4], vn[4];
    if (gw < T) {
#pragma unroll
        for (int j = 0; j < 4; ++j) v[j] = ((const f32x4*)(X + (size_t)gw * D) + lane)[64 * j];
    }
    for (int m = gw; m < T; m += NGW) {
        const int mn = m + NGW < T ? m + NGW : m;
#pragma unroll
        for (int j = 0; j < 4; ++j) vn[j] = ((const f32x4*)(X + (size_t)mn * D) + lane)[64 * j];
        float s = 0.f;
#pragma unroll
        for (int j = 0; j < 4; ++j) s += (v[j].x * v[j].x + v[j].y * v[j].y) + (v[j].z * v[j].z + v[j].w * v[j].w);
        const float rstd = rsqrtf(wave_sum(s) * (1.f / 1024.f) + EPS);
        u32x2* o8 = (u32x2*)(XN + (size_t)m * D) + lane;
#pragma unroll
        for (int j = 0; j < 4; ++j) { u32x2 w; w.x = pk2(v[j].x * rstd, v[j].y * rstd); w.y = pk2(v[j].z * rstd, v[j].w * rstd); o8[64 * j] = w; }
#pragma unroll
        for (int j = 0; j < 4; ++j) v[j] = vn[j];
    }
}

__device__ __forceinline__ void phase_xattn(KArgs A, int wv_, int L, LAS unsigned char* lds) {
    const int tid = opaque_tid(wv_), wid = __builtin_amdgcn_readfirstlane(tid >> 6), lane = tid & 63;
    unsigned char* ws = opq(A->ws);
    const bf16* QX = (const bf16*)(ws + WS_QX); const bf16* KV = (const bf16*)(ws + WS_KV); bf16* OX = (bf16*)(ws + WS_OX);
    constexpr int KSTR = 129;
    LAS unsigned* kl = (LAS unsigned*)lds;
    LAS float* qb = (LAS float*)(lds + 132096) + wid * 256;
    LAS float* pb = (LAS float*)(lds + 132096 + 8192) + wid * 256;
    const float* qg = A->in[I_XQN] + L * 256;
    for (int it = blockIdx.x; it < NBATCH * 4 * 8; it += gridDim.x) {
        const int qc = it & 7, h = (it >> 3) & 3, b = it >> 5;
        __syncthreads();
        for (int e = tid; e < 256 * 128; e += 512) { const int m = e >> 7, dw = e & 127;
            kl[m * KSTR + dw] = *((const unsigned*)(KV + (size_t)(b * 256 + m) * 8192 + L * 2048 + h * 256) + dw); }
        __syncthreads();
        const bf16* Vb = KV + (size_t)(b * 256) * 8192 + L * 2048 + 1024 + h * 256;
        for (int tq = 0; tq < 32; ++tq) {
            const size_t tok = (size_t)b * S + qc * 256 + wid * 32 + tq;
            const u32x2 qw = *((const u32x2*)(QX + tok * 1024 + h * 256) + lane);
            const float q0 = bflo(qw.x), q1 = bfhi(qw.x), q2 = bflo(qw.y), q3 = bfhi(qw.y);
            const float rstd = rsqrtf(wave_sum(q0 * q0 + q1 * q1 + q2 * q2 + q3 * q3) * (1.f / 256.f) + EPS);
            const f32x4 gg = *(const f32x4*)(qg + 4 * lane);
            *(LAS f32x4*)(qb + 4 * lane) = (f32x4){q0 * rstd * gg.x, q1 * rstd * gg.y, q2 * rstd * gg.z, q3 * rstd * gg.w};
            LDS_WAIT();
            float s0 = 0.f, s1 = 0.f, s2 = 0.f, s3 = 0.f;
#pragma unroll 4
            for (int dw = 0; dw < 128; ++dw) {
                const f32x2 qq = *(const LAS f32x2*)(qb + 2 * dw);
                const unsigned k0 = kl[lane * KSTR + dw], k1 = kl[(lane + 64) * KSTR + dw], k2 = kl[(lane + 128) * KSTR + dw], k3 = kl[(lane + 192) * KSTR + dw];
                s0 += qq.x * bflo(k0) + qq.y * bfhi(k0); s1 += qq.x * bflo(k1) + qq.y * bfhi(k1);
                s2 += qq.x * bflo(k2) + qq.y * bfhi(k2); s3 += qq.x * bflo(k3) + qq.y * bfhi(k3);
            }
            const float mx = wave_max(fmaxf(fmaxf(s0, s1), fmaxf(s2, s3)));
            const float e0 = __expf(s0 - mx), e1 = __expf(s1 - mx), e2 = __expf(s2 - mx), e3 = __expf(s3 - mx);
            const float inv = 1.f / wave_sum((e0 + e1) + (e2 + e3));
            pb[lane] = e0 * inv; pb[lane + 64] = e1 * inv; pb[lane + 128] = e2 * inv; pb[lane + 192] = e3 * inv;
            LDS_WAIT();
            float o0 = 0.f, o1 = 0.f, o2 = 0.f, o3 = 0.f;
#pragma unroll 8
            for (int m = 0; m < 256; ++m) {
                const float p = pb[m];
                const u32x2 vw = *((const u32x2*)(Vb + (size_t)m * 8192) + lane);
                o0 += p * bflo(vw.x); o1 += p * bfhi(vw.x); o2 += p * bflo(vw.y); o3 += p * bfhi(vw.y);
            }
            u32x2 ow; ow.x = pk2(o0, o1); ow.y = pk2(o2, o3);
            *((u32x2*)(OX + tok * 1024 + h * 256) + lane) = ow;
            LDS_WAIT();
        }
    }
    __syncthreads();
}


__device__ __forceinline__ int kperm32(int p) { const int fq = (p >> 3) & 3, j = p & 7; return (p & ~31) + 16 * (j >> 2) + 4 * fq + (j & 3); }
__device__ __forceinline__ void phase_vtrans(KArgs A, int wv_, LAS unsigned char* lds) {
    const int tid = opaque_tid(wv_);
    unsigned char* ws = opq(A->ws);
    const bf16* KV = (const bf16*)(ws + WS_KV); bf16* VT = (bf16*)(ws + WS_VT);
    LAS bf16* vt = (LAS bf16*)lds;
    constexpr int VS = 258;
    for (int it = blockIdx.x; it < DEPTH * NBATCH * 4; it += gridDim.x) {
        const int h = it & 3, b = (it >> 2) & 7, l = it >> 5;
        __syncthreads();
        for (int e = tid; e < 256 * 32; e += 512) { const int m = e >> 5, c8 = e & 31;
            const u32x4 w = *(const u32x4*)(KV + (size_t)(b * 256 + m) * 8192 + l * 2048 + 1024 + h * 256 + c8 * 8);
            LAS unsigned* d = (LAS unsigned*)(vt + m * VS + c8 * 8); d[0] = w.x; d[1] = w.y; d[2] = w.z; d[3] = w.w; }
        __syncthreads();
        for (int e = tid; e < 256 * 32; e += 512) { const int dv = e & 255, p8 = e >> 8;
            unsigned short x[8];
#pragma unroll
            for (int j = 0; j < 8; ++j) x[j] = vt[kperm32(p8 * 8 + j) * VS + dv];
            u32x4 o; o.x = x[0] | ((unsigned)x[1] << 16); o.y = x[2] | ((unsigned)x[3] << 16); o.z = x[4] | ((unsigned)x[5] << 16); o.w = x[6] | ((unsigned)x[7] << 16);
            *(u32x4*)(VT + ((size_t)it * 256 + dv) * 256 + p8 * 8) = o; }
    }
    __syncthreads();
}

__device__ __forceinline__ void phase_xattn_mfma(KArgs A, int wv_, int L, LAS unsigned char* lds) {
    const int tid = opaque_tid(wv_), wid = __builtin_amdgcn_readfirstlane(tid >> 6), lane = tid & 63, fr = lane & 15, fq = lane >> 4;
    unsigned char* ws = opq(A->ws);
    const bf16* QX = (const bf16*)(ws + WS_QX); const bf16* KV = (const bf16*)(ws + WS_KV); const bf16* VT = (const bf16*)(ws + WS_VT); bf16* OX = (bf16*)(ws + WS_OX);
    constexpr int RS = 264;
    LAS bf16* kl = (LAS bf16*)lds;
    const float* qg = A->in[I_XQN] + L * 256;
    for (int it = blockIdx.x; it < NBATCH * 4 * 8; it += gridDim.x) {
        const int qt = it & 7, h = (it >> 3) & 3, b = it >> 5;
        __syncthreads();
        {
            const int row = tid >> 1, hf = tid & 1;
            const u32x4* src = (const u32x4*)(KV + (size_t)(b * 256 + row) * 8192 + L * 2048 + h * 256 + hf * 128);
#pragma unroll
            for (int i0 = 0; i0 < 16; i0 += 8) {
                u32x4 w[8];
#pragma unroll
                for (int i = 0; i < 8; ++i) w[i] = src[i0 + i];
#pragma unroll
                for (int i = 0; i < 8; ++i) *(LAS u32x4*)(kl + row * RS + hf * 128 + (i0 + i) * 8) = w[i];
            }
        }
        const size_t tok0 = (size_t)b * S + qt * 256 + wid * 32 + fr;
        u32x4 qw0[8], qw1[8];
#pragma unroll
        for (int s = 0; s < 8; ++s) { qw0[s] = *(const u32x4*)(QX + tok0 * 1024 + h * 256 + 32 * s + 8 * fq); qw1[s] = *(const u32x4*)(QX + (tok0 + 16) * 1024 + h * 256 + 32 * s + 8 * fq); }
        __syncthreads();
        bf16x8 pf0[8], pf1[8]; float inv0, inv1;
        auto s_part = [&](const u32x4 (&qw)[8], bf16x8 (&pf)[8], float& inv) __attribute__((always_inline)) {
            float ssq = 0.f;
#pragma unroll
            for (int s = 0; s < 8; ++s) {
                const float a0 = bflo(qw[s].x), a1 = bfhi(qw[s].x), a2 = bflo(qw[s].y), a3 = bfhi(qw[s].y), a4 = bflo(qw[s].z), a5 = bfhi(qw[s].z), a6 = bflo(qw[s].w), a7 = bfhi(qw[s].w);
                ssq += (a0 * a0 + a1 * a1) + (a2 * a2 + a3 * a3) + (a4 * a4 + a5 * a5) + (a6 * a6 + a7 * a7);
            }
            ssq += __shfl_xor(ssq, 16); ssq += __shfl_xor(ssq, 32);
            const float rstd = rsqrtf(ssq * (1.f / 256.f) + EPS);
            bf16x8 qf[8];
#pragma unroll
            for (int s = 0; s < 8; ++s) qf[s] = __builtin_bit_cast(bf16x8, qw[s]);
            f32x4 sc[16];
#pragma unroll
            for (int hf = 0; hf < 2; ++hf) {
                unsigned kb = (unsigned)(size_t)(kl + (128 * hf + fr) * RS + 8 * fq); asm volatile("" : "+v"(kb));
#pragma unroll
                for (int t8 = 0; t8 < 8; ++t8) { const int t = 8 * hf + t8; sc[t] = (f32x4){0.f, 0.f, 0.f, 0.f};
#pragma unroll
                    for (int s = 0; s < 8; ++s) { const bf16x8 kf = *(const LAS bf16x8*)(size_t)(kb + (unsigned)((16 * t8 * RS + 32 * s) * 2));
                        sc[t] = __builtin_amdgcn_mfma_f32_16x16x32_bf16(kf, qf[s], sc[t], 0, 0, 0); }
                    if (t & 1) asm volatile("" ::: "memory"); }
            }
            float mx = -INFINITY;
#pragma unroll
            for (int t = 0; t < 16; ++t) mx = fmaxf(mx, fmaxf(fmaxf(sc[t].x, sc[t].y), fmaxf(sc[t].z, sc[t].w)));
            mx = fmaxf(mx, __shfl_xor(mx, 16)); mx = fmaxf(mx, __shfl_xor(mx, 32));
            float lsum = 0.f;
#pragma unroll
            for (int t = 0; t < 16; ++t) { sc[t].x = __expf((sc[t].x - mx) * rstd); sc[t].y = __expf((sc[t].y - mx) * rstd); sc[t].z = __expf((sc[t].z - mx) * rstd); sc[t].w = __expf((sc[t].w - mx) * rstd); lsum += (sc[t].x + sc[t].y) + (sc[t].z + sc[t].w); }
            lsum += __shfl_xor(lsum, 16); lsum += __shfl_xor(lsum, 32);
            inv = 1.f / lsum;
#pragma unroll
            for (int s = 0; s < 8; ++s) { u32x4 w; w.x = pk2(sc[2 * s].x, sc[2 * s].y); w.y = pk2(sc[2 * s].z, sc[2 * s].w); w.z = pk2(sc[2 * s + 1].x, sc[2 * s + 1].y); w.w = pk2(sc[2 * s + 1].z, sc[2 * s + 1].w);
                pf[s] = __builtin_bit_cast(bf16x8, w); }
        };
        s_part(qw0, pf0, inv0);
        s_part(qw1, pf1, inv1);
        __syncthreads();
        {
            const int row = tid >> 1, hf = tid & 1;
            const u32x4* src = (const u32x4*)(VT + ((size_t)((L * 8 + b) * 4 + h) * 256 + row) * 256 + hf * 128);
#pragma unroll
            for (int i0 = 0; i0 < 16; i0 += 8) {
                u32x4 w[8];
#pragma unroll
                for (int i = 0; i < 8; ++i) w[i] = src[i0 + i];
#pragma unroll
                for (int i = 0; i < 8; ++i) *(LAS u32x4*)(kl + row * RS + hf * 128 + (i0 + i) * 8) = w[i];
            }
        }
        __syncthreads();
#pragma unroll
        for (int hf = 0; hf < 2; ++hf) {
            unsigned vb = (unsigned)(size_t)(kl + (128 * hf + fr) * RS + 8 * fq); asm volatile("" : "+v"(vb));
#pragma unroll
            for (int n8 = 0; n8 < 8; ++n8) { const int n = 8 * hf + n8; f32x4 o0 = (f32x4){0.f, 0.f, 0.f, 0.f}, o1 = o0;
#pragma unroll
                for (int s = 0; s < 8; ++s) { const bf16x8 vf = *(const LAS bf16x8*)(size_t)(vb + (unsigned)((16 * n8 * RS + 32 * s) * 2));
                    o0 = __builtin_amdgcn_mfma_f32_16x16x32_bf16(vf, pf0[s], o0, 0, 0, 0);
                    o1 = __builtin_amdgcn_mfma_f32_16x16x32_bf16(vf, pf1[s], o1, 0, 0, 0); }
                u32x2 w0, w1; w0.x = pk2(o0.x * inv0, o0.y * inv0); w0.y = pk2(o0.z * inv0, o0.w * inv0); w1.x = pk2(o1.x * inv1, o1.y * inv1); w1.y = pk2(o1.z * inv1, o1.w * inv1);
                *(u32x2*)(OX + tok0 * 1024 + h * 256 + 16 * n + 4 * fq) = w0;
                *(u32x2*)(OX + (tok0 + 16) * 1024 + h * 256 + 16 * n + 4 * fq) = w1;
                if (n & 1) asm volatile("" ::: "memory"); }
        }
    }
    __syncthreads();
}

__device__ __forceinline__ void phase_route(KArgs A, int wv_, int L, LAS unsigned char* lds) {
    const int tid_ = opaque_tid(wv_); const int wid = __builtin_amdgcn_readfirstlane(tid_ >> 6), lane = tid_ & 63;
    unsigned char* ws = opq(A->ws);
    const float* RW = (const float*)(ws + WS_RW) + (size_t)L * NEXP * D;
    unsigned* cnt = (unsigned*)(ws + WS_CTL) + CW_CNT + L * 64;
    int* list = (int*)(ws + WS_LIST); int* te = (int*)(ws + WS_TOK); int* tp = te + 2 * T; float* tw = (float*)(tp + 2 * T);
    bf16* XN = (bf16*)(ws + WS_XN);
    LAS float* rwl = (LAS float*)lds;
    LAS unsigned* lcnt = (LAS unsigned*)(lds + 65536);
    LAS unsigned* lbase = lcnt + 16;
    const float rbv = A->in[I_RB][lane >> 2];
    for (int e4 = tid_; e4 < NEXP * D / 4; e4 += 512) *(LAS f32x4*)(rwl + 4 * e4) = *(const f32x4*)(RW + 4 * e4);
    for (int blk = blockIdx.x; blk < T / 64; blk += gridDim.x) {
        __syncthreads();
        if (tid_ < 16) lcnt[tid_] = 0u;
        __syncthreads();
        int e0s = 0, e1s = 0, r0s = 0, r1s = 0; float w0s = 0.f;
        f32x4 v[4], vn[4];
#pragma unroll
        for (int j = 0; j < 4; ++j) v[j] = ((const f32x4*)(A->out + (size_t)(blk * 64 + wid * 8) * D) + lane)[64 * j];
#pragma unroll 1
        for (int q = 0; q < 8; ++q) {
            const int t = blk * 64 + wid * 8 + q;
            { const f32x4* xn_ = (const f32x4*)(A->out + (size_t)(t + (q < 7 ? 1 : 0)) * D) + lane;
#pragma unroll
              for (int j = 0; j < 4; ++j) vn[j] = xn_[64 * j]; }
            float s = 0.f;
#pragma unroll
            for (int j = 0; j < 4; ++j) s += (v[j].x * v[j].x + v[j].y * v[j].y) + (v[j].z * v[j].z + v[j].w * v[j].w);
            const float rstd = rsqrtf(wave_sum(s) * (1.f / 1024.f) + EPS);
            u32x2* o8 = (u32x2*)(XN + (size_t)t * D) + lane;
#pragma unroll
            for (int j = 0; j < 4; ++j) { u32x2 w; w.x = pk2(v[j].x * rstd, v[j].y * rstd); w.y = pk2(v[j].z * rstd, v[j].w * rstd); o8[64 * j] = w; }
            float a[16];
#pragma unroll
            for (int e = 0; e < 16; ++e) {
                const LAS f32x4* wr = (const LAS f32x4*)(rwl + e * D) + lane; float acc = 0.f;
#pragma unroll
                for (int j = 0; j < 4; ++j) { const f32x4 w = wr[64 * j]; acc += (v[j].x * w.x + v[j].y * w.y) + (v[j].z * w.z + v[j].w * w.w); }
                a[e] = acc;
            }
            float a8[8], a4[4], a2[2], a1;
            { const bool up = lane & 32;
#pragma unroll
              for (int k = 0; k < 8; ++k) { const float send = up ? a[k] : a[k + 8], keep = up ? a[k + 8] : a[k]; a8[k] = keep + __shfl_xor(send, 32); } }
            { const bool up = lane & 16;
#pragma unroll
              for (int k = 0; k < 4; ++k) { const float send = up ? a8[k] : a8[k + 4], keep = up ? a8[k + 4] : a8[k]; a4[k] = keep + __shfl_xor(send, 16); } }
            { const bool up = lane & 8;
#pragma unroll
              for (int k = 0; k < 2; ++k) { const float send = up ? a4[k] : a4[k + 2], keep = up ? a4[k + 2] : a4[k]; a2[k] = keep + __shfl_xor(send, 8); } }
            { const bool up = lane & 4; const float send = up ? a2[0] : a2[1], keep = up ? a2[1] : a2[0]; a1 = keep + __shfl_xor(send, 4); }
            a1 += __shfl_xor(a1, 2); a1 += __shfl_xor(a1, 1);
            const float lg = a1 * rstd + rbv;
            const float v0 = wave_max(lg);
            const int e0 = (__ffsll((unsigned long long)__ballot(lg == v0)) - 1) >> 2;
            const int gidx = e0 >> 2;
            const bool c2 = (lane >> 4) == gidx && (lane >> 2) != e0;
            const float m2 = c2 ? lg : -INFINITY;
            const float v1 = wave_max(m2);
            const int e1 = (__ffsll((unsigned long long)__ballot(c2 && m2 == v1)) - 1) >> 2;
            const float w0 = 1.f / (1.f + __expf(v1 - v0));
            unsigned r0 = 0, r1 = 0;
            if (lane == 0) { r0 = atomicAdd((unsigned*)(lcnt + e0), 1u); r1 = atomicAdd((unsigned*)(lcnt + e1), 1u); }
            r0 = __builtin_amdgcn_readfirstlane(r0); r1 = __builtin_amdgcn_readfirstlane(r1);
            if (lane == q) { e0s = e0; e1s = e1; r0s = (int)r0; r1s = (int)r1; w0s = w0; }
#pragma unroll
            for (int j = 0; j < 4; ++j) v[j] = vn[j];
        }
        __syncthreads();
        if (tid_ < 16) lbase[tid_] = atomicAdd(&cnt[tid_], lcnt[tid_]);
        __syncthreads();
        if (lane < 8) {
            const int t = blk * 64 + wid * 8 + lane;
            const int p0 = (int)lbase[e0s] + r0s, p1 = (int)lbase[e1s] + r1s;
            list[e0s * T + p0] = t; list[e1s * T + p1] = t;
            te[2 * t] = e0s; te[2 * t + 1] = e1s; tp[2 * t] = p0; tp[2 * t + 1] = p1; tw[2 * t] = w0s; tw[2 * t + 1] = 1.f - w0s;
        }
    }
    __syncthreads();
}
__device__ __forceinline__ void moe_offsets(KArgs A, int wv_, int L, LAS int* off, LAS int* cn) {
    if (opaque_tid(wv_) == 0) {
        const unsigned* cnt = (const unsigned*)(opq(A->ws) + WS_CTL) + CW_CNT + L * 64;
        int o = 0;
        for (int e = 0; e < 16; ++e) { const int c = (int)__hip_atomic_load(cnt + e, __ATOMIC_RELAXED, __HIP_MEMORY_SCOPE_AGENT); off[e] = o; cn[e] = c; o += (c + 255) & ~255; }
        off[16] = o;
    }
    __syncthreads();
}
__device__ __forceinline__ void phase_moe_combine(KArgs A, int wv_, int L, LAS unsigned char* lds) {
    LAS int* off = (LAS int*)lds; LAS int* cn = off + 32;
    moe_offsets(A, wv_, L, off, cn);
    const int tid_ = opaque_tid(wv_); const int wid = __builtin_amdgcn_readfirstlane(tid_ >> 6), lane = tid_ & 63; const int gw = blockIdx.x * 8 + wid, NGW = gridDim.x * 8;
    unsigned char* ws = opq(A->ws);
    const int* te = (const int*)(ws + WS_TOK); const int* tp = te + 2 * T; const float* tw = (const float*)(tp + 2 * T);
    const bf16* Y = (const bf16*)(ws + WS_Y); bf16* XN = (bf16*)(ws + WS_XN);
    const int nq = (T - gw + NGW - 1) / NGW;
    for (int q0 = 0; q0 < nq; q0 += 8) {
        int s0m = 0, s1m = 0; float w0m = 0.f, w1m = 0.f;
        { const int qq = q0 + (lane & 7); const int t = gw + NGW * (qq < nq ? qq : nq - 1);
          s0m = off[te[2 * t]] + tp[2 * t]; s1m = off[te[2 * t + 1]] + tp[2 * t + 1]; w0m = tw[2 * t]; w1m = tw[2 * t + 1]; }
        const int nn = nq - q0 < 8 ? nq - q0 : 8;
        f32x4 v[4], vn[4]; u32x2 ya[4], yb[4], yan[4], ybn[4];
        { const int t = gw + NGW * q0; const int sl0 = __builtin_amdgcn_readlane(s0m, 0), sl1 = __builtin_amdgcn_readlane(s1m, 0);
#pragma unroll
          for (int j = 0; j < 4; ++j) { v[j] = ((const f32x4*)(A->out + (size_t)t * D) + lane)[64 * j]; ya[j] = ((const u32x2*)(Y + (size_t)sl0 * D) + lane)[64 * j]; yb[j] = ((const u32x2*)(Y + (size_t)sl1 * D) + lane)[64 * j]; } }
#pragma unroll 1
        for (int q = 0; q < nn; ++q) {
            const int t = gw + NGW * (q0 + q);
            const int qn = q + 1 < nn ? q + 1 : q;
            { const int tn = gw + NGW * (q0 + qn); const int sl0 = __builtin_amdgcn_readlane(s0m, qn), sl1 = __builtin_amdgcn_readlane(s1m, qn);
#pragma unroll
              for (int j = 0; j < 4; ++j) { vn[j] = ((const f32x4*)(A->out + (size_t)tn * D) + lane)[64 * j]; yan[j] = ((const u32x2*)(Y + (size_t)sl0 * D) + lane)[64 * j]; ybn[j] = ((const u32x2*)(Y + (size_t)sl1 * D) + lane)[64 * j]; } }
            const float w0 = __builtin_bit_cast(float, __builtin_amdgcn_readlane(__builtin_bit_cast(int, w0m), q)), w1 = __builtin_bit_cast(float, __builtin_amdgcn_readlane(__builtin_bit_cast(int, w1m), q));
            float s = 0.f;
#pragma unroll
            for (int j = 0; j < 4; ++j) {
                v[j].x += w0 * bflo(ya[j].x) + w1 * bflo(yb[j].x); v[j].y += w0 * bfhi(ya[j].x) + w1 * bfhi(yb[j].x); v[j].z += w0 * bflo(ya[j].y) + w1 * bflo(yb[j].y); v[j].w += w0 * bfhi(ya[j].y) + w1 * bfhi(yb[j].y);
                s += (v[j].x * v[j].x + v[j].y * v[j].y) + (v[j].z * v[j].z + v[j].w * v[j].w);
            }
            const float rstd = rsqrtf(wave_sum(s) * (1.f / 1024.f) + EPS);
            f32x4* xr = (f32x4*)(A->out + (size_t)t * D) + lane; u32x2* o8 = (u32x2*)(XN + (size_t)t * D) + lane;
#pragma unroll
            for (int j = 0; j < 4; ++j) { xr[64 * j] = v[j]; u32x2 w; w.x = pk2(v[j].x * rstd, v[j].y * rstd); w.y = pk2(v[j].z * rstd, v[j].w * rstd); o8[64 * j] = w; }
#pragma unroll
            for (int j = 0; j < 4; ++j) { v[j] = vn[j]; ya[j] = yan[j]; yb[j] = ybn[j]; }
        }
    }
}

constexpr int PH_PER_EVEN = 5 + 7, PH_PER_ODD = 3 + 7;
constexpr int NPHASES = 1 + 2 * (PH_PER_EVEN + PH_PER_ODD);

__global__ void __launch_bounds__(512, 2) mk_fwd(Args Araw) {
    KArgs A0 = kargs();
    extern __shared__ __attribute__((aligned(16))) unsigned char lds_raw[];
    LAS unsigned char* lds = (LAS unsigned char*)lds_raw;
    volatile LAS unsigned* misc = (volatile LAS unsigned*)(lds + LDS_MISC);
    const int tid = threadIdx.x;
    if (tid < 16) misc[tid] = 0u;
    __syncthreads();
    const int lo = A0->ph_lo, hi = A0->ph_hi;
    const int wv_ = __builtin_amdgcn_readfirstlane(threadIdx.x >> 6);
    if (hi - lo > 1) (void)xcd_barrier_post((unsigned*)(A0->ws + WS_CTL) + CW_BAR, misc);
    int ph = 0;
    unsigned long long tacc_ = 0;
#define PH_BEGIN(k) if (ph >= lo && ph < hi) { const bool tprobe_ = (PROBE_TMASK >> (k)) & 1; unsigned long long tp0_ = 0; if (PROBE_TMASK && tprobe_) tp0_ = __builtin_amdgcn_s_memrealtime(); KArgs A = kargs(); unsigned char* ws = opq(A->ws); _Pragma("unroll 1") for (int rep_ = 0; rep_ < (((PROBE_MASK >> (k)) & 1) ? PROBE_REPS : 1); ++rep_)
#define PH_END   if (ph + 1 < hi) { XcdBarrier b_; b_.bar = (unsigned*)(opq(kargs()->ws) + WS_CTL) + CW_BAR; b_.x = xb_xcc_id(); b_.st = misc; xcd_barrier(b_, opaque_tid(wv_) == 0); } if (PROBE_TMASK && tprobe_) tacc_ += __builtin_amdgcn_s_memrealtime() - tp0_; } ++ph;
    const int G = gridDim.x, cb = blockIdx.x;

    PH_BEGIN(0) phase_prologue(A, wv_, lds); PH_END
    for (int L = 0; L < DEPTH; ++L) {
        const int i = L >> 1;
        if ((L & 1) == 0) {
            PH_BEGIN(3) {
                if (L == 0) {
                    pg8::DenseOrder S; S.init(NBATCH * NMEM, 8192, D, (const bf16*)(ws + WS_WKV), G, cb);
                    pg8::EpiBf16<0> E{(bf16*)(ws + WS_KV), 8192, 32, 0};
                    pg8::gemm_phase(lds, (const bf16*)(ws + WS_MN), D, S, E, wv_);
                }
                pg8::DenseOrder S; S.init(T, HYN, D, (const bf16*)(ws + WS_WHYB) + (size_t)i * HYN * D, G, cb);
                pg8::EpiBf16<0> E{(bf16*)(ws + WS_BIG), HYN, 12, 0};
                pg8::gemm_phase(lds, (const bf16*)(ws + WS_XN), D, S, E, wv_);
            } PH_END
            PH_BEGIN(4) { if (L == 0) { phase_knorm(A, wv_); phase_vtrans(A, wv_, lds); } phase_compress_mfma(A, wv_, i, lds); phase_nsa_prep(A, wv_, i, lds); phase_vtiles(A, wv_, lds); } PH_END
            PH_BEGIN(5) { phase_gla_a(A, wv_, i, lds); __syncthreads(); phase_nsa_attn_mfma(A, wv_, i, lds); } PH_END
            PH_BEGIN(6) phase_gla_c(A, wv_, i, lds); PH_END
            PH_BEGIN(7) {
                pg8::DenseOrder S; S.init(T, D, D, (const bf16*)(ws + WS_WHOUT) + (size_t)i * D * D, G, cb);
                pg8::EpiResAddNorm E{A->out, D, (bf16*)(ws + WS_XN), (float*)(ws + WS_ROWSQ)};
                pg8::gemm_phase(lds, (const bf16*)(ws + WS_CAT), D, S, E, wv_);
            } PH_END
        } else {
            PH_BEGIN(8) {
                pg8::DenseOrder S; S.init(T, 4096, D, (const bf16*)(ws + WS_WSGIN) + (size_t)i * 4096 * D, G, cb);
                pg8::EpiBf16<1> E{(bf16*)(ws + WS_U), 2048, 8, (size_t)(WS_V - WS_U) / 2};
                pg8::gemm_phase(lds, (const bf16*)(ws + WS_XN), D, S, E, wv_);
            } PH_END
            PH_BEGIN(9) phase_sgu_mix_mfma(A, wv_, i, lds); PH_END
            PH_BEGIN(10) {
                pg8::DenseOrder S; S.init(T, D, 2048, (const bf16*)(ws + WS_WSGOUT) + (size_t)i * D * 2048, G, cb);
                pg8::EpiResAddNorm E{A->out, D, (bf16*)(ws + WS_XN), (float*)(ws + WS_ROWSQ)};
                pg8::gemm_phase(lds, (const bf16*)(ws + WS_UM), 2048, S, E, wv_);
            } PH_END
        }
        PH_BEGIN(12) {
            pg8::DenseOrder S; S.init(T, D, D, (const bf16*)(ws + WS_WQ) + (size_t)L * D * D, G, cb);
            pg8::EpiBf16RowScale E{(bf16*)(ws + WS_QX), D, (const float*)(ws + WS_ROWSQ)};
            pg8::gemm_phase(lds, (const bf16*)(ws + WS_XN), D, S, E, wv_);
        } PH_END
        PH_BEGIN(13) phase_xattn_mfma(A, wv_, L, lds); PH_END
        PH_BEGIN(14) {
            pg8::DenseOrder S; S.init(T, D, D, (const bf16*)(ws + WS_WO) + (size_t)L * D * D, G, cb);
            pg8::EpiResAdd E{A->out, D};
            pg8::gemm_phase(lds, (const bf16*)(ws + WS_OX), D, S, E, wv_);
        } PH_END
        PH_BEGIN(15) phase_route(A, wv_, L, lds); PH_END
        PH_BEGIN(16) {
            LAS int* off = (LAS int*)(lds + pg8::STAGE_BYTES); LAS int* cn = off + 32;
            moe_offsets(A, wv_, L, off, cn);
            pg8::MoeOrder<true> S{(off[16] / 256) * 3, 3, G, cb, D, off, cn, (const int*)(ws + WS_LIST), (const char*)(ws + WS_WMIN) + (size_t)L * 16 * 768 * D * 2, (size_t)768 * D * 2};
            pg8::EpiSwiglu E{(bf16*)(ws + WS_H), DEXP};
            pg8::gemm_phase(lds, (const bf16*)(ws + WS_XN), D, S, E, wv_);
        } PH_END
        PH_BEGIN(17) {
            LAS int* off = (LAS int*)(lds + pg8::STAGE_BYTES); LAS int* cn = off + 32;
            moe_offsets(A, wv_, L, off, cn);
            pg8::MoeOrder<false> S{(off[16] / 256) * 4, 4, G, cb, DEXP, off, cn, (const int*)(ws + WS_LIST), (const char*)(ws + WS_WMOUT) + (size_t)L * 16 * D * DEXP * 2, (size_t)D * DEXP * 2};
            pg8::EpiBf16<0> E{(bf16*)(ws + WS_Y), D, 4, 0};
            pg8::gemm_phase(lds, (const bf16*)(ws + WS_H), DEXP, S, E, wv_);
        } PH_END
        PH_BEGIN(18) phase_moe_combine(A, wv_, L, lds); PH_END
    }
#undef PH_BEGIN
#undef PH_END
    if ((PROBE_NSA || PROBE_SUB) && blockIdx.x == 0) { const unsigned long long d_ = __hip_atomic_load((unsigned long long*)(A0->ws + WS_CTL + 48000), __ATOMIC_RELAXED, __HIP_MEMORY_SCOPE_AGENT); const unsigned long long t0 = __builtin_amdgcn_s_memrealtime(); while (__builtin_amdgcn_s_memrealtime() - t0 < d_) __builtin_amdgcn_s_sleep(8); }
    if (PROBE_TMASK && blockIdx.x == 0) { const unsigned long long t0 = __builtin_amdgcn_s_memrealtime(); while (__builtin_amdgcn_s_memrealtime() - t0 < tacc_) __builtin_amdgcn_s_sleep(8); }
}

extern "C" void kernel_launch(void* const* d_in, const int* in_sizes, int n_in, void* d_out, int out_size, void* d_ws, size_t ws_size, hipStream_t stream) {
    static int grid = 0;
    if (grid == 0) {
        if (n_in != N_IN || out_size != T * D || ws_size < WS_END) { fprintf(stderr, "kernel_launch: unexpected problem (n_in %d, out %d, ws %zu)\n", n_in, out_size, ws_size); grid = -1; return; }
        int dev = 0, cus = 0, per_cu = 0;
        if (hipGetDevice(&dev) != hipSuccess || hipDeviceGetAttribute(&cus, hipDeviceAttributeMultiprocessorCount, dev) != hipSuccess) { grid = -1; return; }
        if (hipFuncSetAttribute((const void*)mk_fwd, hipFuncAttributeMaxDynamicSharedMemorySize, LDS_BYTES) != hipSuccess) { fprintf(stderr, "kernel_launch: hipFuncSetAttribute failed\n"); grid = -1; return; }
        if (hipOccupancyMaxActiveBlocksPerMultiprocessor(&per_cu, (const void*)mk_fwd, 512, LDS_BYTES) != hipSuccess || per_cu < 1) fprintf(stderr, "kernel_launch: occupancy query says %d\n", per_cu);
        (void)hipGetLastError();
        grid = cus;
    }
    if (grid < 0) return;
    (void)hipMemsetAsync((char*)d_ws + WS_CTL, 0, CTL_BYTES, stream);
    Args a{};
    for (int i = 0; i < N_IN; ++i) a.in[i] = (const float*)d_in[i];
    a.out = (float*)d_out; a.ws = (unsigned char*)d_ws;
    for (int j = 0; j < 32; ++j) a.freq[j] = (float)pow(10000.0, -(double)j / 32.0);
#if MK_ONE_LAUNCH
    a.ph_lo = 0; a.ph_hi = NPHASES;
    hipLaunchKernelGGL(mk_fwd, dim3(grid), dim3(512), LDS_BYTES, stream, a);
#else
    for (int p = 0; p < NPHASES; ++p) { a.ph_lo = p; a.ph_hi = p + 1; hipLaunchKernelGGL(mk_fwd, dim3(grid), dim3(512), LDS_BYTES, stream, a); }
#endif
}
```

```cpp
#include <hip/hip_runtime.h>
#include <stdint.h>
#include <stdio.h>
#include <math.h>

#ifndef PROBE_MASK
#define PROBE_MASK 0
#endif
#ifndef PROBE_TMASK
#define PROBE_TMASK 0
#endif
#ifndef PROBE_NSA
#define PROBE_NSA 0
#endif
#ifndef PROBE_SUB
#define PROBE_SUB 0
#endif
#ifndef PROBE_XBAR
#define PROBE_XBAR 0
#endif
#ifndef PROBE_REPS
#define PROBE_REPS 2
#endif
#ifndef MK_ONE_LAUNCH
#define MK_ONE_LAUNCH 1
#endif

#define LAS __attribute__((address_space(3)))
typedef unsigned short bf16;
typedef short bf16x8 __attribute__((ext_vector_type(8)));
typedef float f32x4 __attribute__((ext_vector_type(4)));
typedef float f32x2 __attribute__((ext_vector_type(2)));
typedef unsigned u32x4 __attribute__((ext_vector_type(4)));
typedef unsigned u32x2 __attribute__((ext_vector_type(2)));

constexpr int T = 16384, D = 1024, NBATCH = 8, S = 2048, DEPTH = 4;
constexpr int NMEM = 256;
constexpr float EPS = 1e-6f;
constexpr int HYN = 3072, HYSRC = 2856;
constexpr int C_QA = 0, C_KC = 512, C_VC = 640, C_KS = 768, C_VS = 896, C_KW = 1024, C_VW = 1152, C_QB = 1280, C_KB = 1536, C_VB = 1792, C_RB = 2304, C_GA = 2816, C_AL = 2840;
constexpr int NCMP = 127;
constexpr int NEXP = 16, DEXP = 384;
constexpr int SLOTS = 2 * T + NEXP * 256;

enum { I_X = 0, I_MEM, I_POS, I_NMIX, I_NXAT, I_NMEM, I_NFFN, I_HYBIN, I_HYBOUT, I_QNORM, I_KNORM, I_CMPPE, I_CMPW1, I_CMPW2, I_GATEB, I_WA2, I_BA, I_ONORM,
       I_SGIN, I_LNG, I_LNB, I_SGWS, I_SGBS, I_SGOUT, I_XWQ, I_XWKV, I_XWO, I_XQN, I_XKN, I_RW, I_RB, I_MOEIN, I_MOEOUT, N_IN };

constexpr size_t MiB = 1u << 20;
constexpr size_t WS_CTL = 0, CTL_BYTES = 1 * MiB;
constexpr size_t WS_WHYB = 1 * MiB;
constexpr size_t WS_WHOUT = WS_WHYB + 12 * MiB;
constexpr size_t WS_WSGIN = WS_WHOUT + 4 * MiB;
constexpr size_t WS_WSGOUT = WS_WSGIN + 16 * MiB;
constexpr size_t WS_WQ = WS_WSGOUT + 8 * MiB;
constexpr size_t WS_WKV = WS_WQ + 8 * MiB;
constexpr size_t WS_WO = WS_WKV + 16 * MiB;
constexpr size_t WS_WMIN = WS_WO + 8 * MiB;
constexpr size_t WS_WMOUT = WS_WMIN + 96 * MiB;
constexpr size_t WS_RW = WS_WMOUT + 48 * MiB;
constexpr size_t WS_XN = WS_RW + 1 * MiB;
constexpr size_t WS_BIG = WS_XN + 32 * MiB;
constexpr size_t WS_QA = WS_BIG + 128 * MiB;
constexpr size_t WS_KS = WS_QA + 16 * MiB;
constexpr size_t WS_KW = WS_KS + 4 * MiB;
constexpr size_t WS_KC = WS_KW + 4 * MiB;
constexpr size_t WS_VC = WS_KC + 1 * MiB;
constexpr size_t WS_CAT = WS_VC + 1 * MiB;
constexpr size_t WS_QX = WS_CAT + 32 * MiB;
constexpr size_t WS_OX = WS_QX + 32 * MiB;
constexpr size_t WS_MN = WS_OX + 32 * MiB;
constexpr size_t WS_KV = WS_MN + 4 * MiB;
constexpr size_t WS_COS = WS_KV + 32 * MiB;
constexpr size_t WS_SIN = WS_COS + 2 * MiB;
constexpr size_t WS_LIST = WS_SIN + 2 * MiB;
constexpr size_t WS_TOK = WS_LIST + 1 * MiB;
constexpr size_t WS_VT = WS_TOK + 1 * MiB;
constexpr size_t WS_VTA = WS_VT + 16 * MiB;
constexpr size_t WS_SLOC = WS_VTA + 32 * MiB;
constexpr size_t WS_DEC = WS_SLOC + 32 * MiB;
constexpr size_t WS_STT = WS_DEC + 1 * MiB;
constexpr size_t WS_WSB = WS_STT + 16 * MiB;
constexpr size_t WS_M0 = WS_WSB + 768 * 1024;
constexpr size_t WS_W1T = WS_WSB + 1 * MiB;
constexpr size_t WS_ROWSQ = WS_W1T + 1 * MiB;
constexpr size_t WS_END = WS_ROWSQ + 1 * MiB;
constexpr size_t WS_Y = WS_BIG, WS_H = WS_BIG + 72 * MiB, WS_U = WS_BIG, WS_V = WS_BIG + 64 * MiB, WS_UM = WS_QX;
constexpr int CW_BAR = 4096;
constexpr int CW_CNT = 8192;

constexpr int LDS_BYTES = 159744;
constexpr int LDS_MISC = LDS_BYTES - 64;

typedef __bf16 bf16x2_t __attribute__((ext_vector_type(2)));
__device__ __forceinline__ unsigned pk2(float lo, float hi) { const f32x2 v = {lo, hi}; return __builtin_bit_cast(unsigned, __builtin_convertvector(v, bf16x2_t)); }
__device__ __forceinline__ unsigned f2bf(float f) { return (unsigned)__builtin_bit_cast(unsigned short, (__bf16)f); }
__device__ __forceinline__ float bf2f(unsigned b) { return __uint_as_float(b << 16); }
__device__ __forceinline__ float bflo(unsigned w) { return __uint_as_float(w << 16); }
__device__ __forceinline__ float bfhi(unsigned w) { return __uint_as_float(w & 0xffff0000u); }
__device__ __forceinline__ float wave_sum(float v) {
#pragma unroll
    for (int o = 1; o < 64; o <<= 1) v += __shfl_xor(v, o);
    return v;
}
__device__ __forceinline__ float wave_max(float v) {
#pragma unroll
    for (int o = 1; o < 64; o <<= 1) v = fmaxf(v, __shfl_xor(v, o));
    return v;
}
__device__ __forceinline__ int opaque_tid(int wv) { int l; asm volatile("v_mbcnt_lo_u32_b32 %0, -1, 0\n\tv_mbcnt_hi_u32_b32 %0, -1, %0" : "=v"(l)); return wv * 64 + l; }
__device__ __forceinline__ unsigned char* opq(unsigned char* p) { asm volatile("" : "+s"(p)); return p; }
#define LDS_WAIT() asm volatile("s_waitcnt lgkmcnt(0)" ::: "memory")
__device__ __forceinline__ float gelu_tanh(float x) {
    const float u2 = x * (1.5957691216057308f + 0.07135481283f * x * x);
    return x * __builtin_amdgcn_rcpf(1.0f + __expf(-u2));
}
__device__ __forceinline__ float sigmoidf_(float x) { return 1.0f / (1.0f + __expf(-x)); }

#define SUBT_BEGIN(id) unsigned long long subt_##id = 0; if (PROBE_SUB == (id)) subt_##id = __builtin_amdgcn_s_memrealtime();
#define SUBT_END(id, wsp, tidv) do { if (PROBE_SUB == (id) && blockIdx.x == 0 && (tidv) == 0) atomicAdd((unsigned long long*)((wsp) + WS_CTL + 48000), __builtin_amdgcn_s_memrealtime() - subt_##id); } while (0)
#define XB_TMO      128
#define XB_XCNT(j)  (256  + 64 * (j))
#define XB_XSUB(j)  (1280 + 64 * (j))
#define XB_XGEN(j)  (2304 + 64 * (j))
#define XB_TOP      3328
#define XB_TOPGEN   3392
#define XCD_BAR_WORDS 3456
#define XB_SPIN_CAP (1u << 22)

__device__ __forceinline__ unsigned xb_ld(unsigned* p)              { return __hip_atomic_load(p, __ATOMIC_RELAXED, __HIP_MEMORY_SCOPE_AGENT); }
__device__ __forceinline__ unsigned xb_add(unsigned* p, unsigned v) { return __hip_atomic_fetch_add(p, v, __ATOMIC_RELAXED, __HIP_MEMORY_SCOPE_AGENT); }
__device__ __forceinline__ unsigned xb_xcc_id() { return (unsigned)__builtin_amdgcn_s_getreg((3 << 11) | 20) & 0xFu; }
#define XB_SPIN(cond, bar) do { unsigned _sp = 0; while (cond) { __builtin_amdgcn_s_sleep(1); \
    if ((++_sp & 255u) == 0u) { if (xb_ld(&(bar)[XB_TMO])) break; if (_sp > XB_SPIN_CAP) { atomicAdd(&(bar)[XB_TMO], 1u); break; } } } } while (0)

struct XcdBarrier { unsigned* bar; unsigned x; volatile LAS unsigned* st; };
__device__ __forceinline__ unsigned* xb_opaque(unsigned* p) { unsigned long long v = (unsigned long long)p; unsigned lo = __builtin_amdgcn_readfirstlane((unsigned)v), hi = __builtin_amdgcn_readfirstlane((unsigned)(v >> 32));
    asm volatile("" : "+s"(lo), "+s"(hi)); return (unsigned*)(((unsigned long long)hi << 32) | lo); }

__device__ __forceinline__ XcdBarrier xcd_barrier_post(unsigned* bar, volatile LAS unsigned* st) {
    XcdBarrier b; b.bar = bar; b.x = xb_xcc_id(); b.st = st;
    if (threadIdx.x == 0) (void)xb_add(&bar[XB_XCNT(b.x)], 1u);
    return b;
}
__device__ __forceinline__ void xcd_barrier_complete(unsigned* bar, unsigned x, unsigned& nloc, unsigned& nx) {
    const unsigned G = gridDim.x * gridDim.y * gridDim.z;
    unsigned sum, cnt, mine, sp = 0u;
    for (;;) {
        sum = 0u; cnt = 0u; mine = 0u;
#pragma unroll
        for (unsigned j = 0; j < 16; ++j) { const unsigned c = xb_ld(&bar[XB_XCNT(j)]); sum += c; cnt += (c > 0u) ? 1u : 0u; mine = (j == x) ? c : mine; }
        if (sum == G) break;
        __builtin_amdgcn_s_sleep(1);
        if ((++sp & 255u) == 0u) { if (xb_ld(&bar[XB_TMO])) break; if (sp > XB_SPIN_CAP) { atomicAdd(&bar[XB_TMO], 1u); break; } }
    }
    nloc = mine > 0u ? mine : 1u; nx = cnt > 0u ? cnt : 1u;
}
__device__ __forceinline__ void xcd_barrier(const XcdBarrier& b, const bool is_t0) {
    asm volatile("s_waitcnt vmcnt(0)" ::: "memory");
    __syncthreads();
    if (is_t0) {
        unsigned* bar = b.bar;
        __builtin_amdgcn_s_waitcnt(0);
        unsigned nloc = b.st[0], nx = b.st[1];
        if (nloc == 0u) { xcd_barrier_complete(bar, b.x, nloc, nx); b.st[0] = nloc; b.st[1] = nx; }
        const unsigned old = xb_add(&bar[XB_XSUB(b.x)], 1u);
        const unsigned gen = old / nloc;
        if (old + 1u == (gen + 1u) * nloc) {
            __builtin_amdgcn_fence(__ATOMIC_RELEASE, "agent");
            asm volatile("s_waitcnt vmcnt(0)" ::: "memory");
            const unsigned og = xb_add(&bar[XB_TOP], 1u);
            const unsigned tg = og / nx;
            if (og + 1u == (tg + 1u) * nx) xb_add(&bar[XB_TOPGEN], 1u);
            else XB_SPIN(xb_ld(&bar[XB_TOPGEN]) == tg, bar);
            __builtin_amdgcn_fence(__ATOMIC_ACQUIRE, "agent");
            xb_add(&bar[XB_XGEN(b.x)], 1u);
            asm volatile("s_waitcnt vmcnt(0)" ::: "memory");
        } else {
            XB_SPIN(xb_ld(&bar[XB_XGEN(b.x)]) == gen, bar);
            __builtin_amdgcn_fence(__ATOMIC_ACQUIRE, "agent");
            asm volatile("s_waitcnt vmcnt(0)" ::: "memory");
        }
    }
    __syncthreads();
}

struct Args {
    const float* in[N_IN];
    float* out;
    unsigned char* ws;
    float freq[32];
    int ph_lo, ph_hi;
};

typedef const __attribute__((address_space(4))) Args* KArgs;
__device__ __forceinline__ KArgs kargs() { KArgs p = (KArgs)__builtin_amdgcn_kernarg_segment_ptr(); asm volatile("" : "+s"(p)); return p; }

__device__ __forceinline__ void st_bf16x4(bf16* p, f32x4 v) { u32x2 w; w.x = pk2(v[0], v[1]); w.y = pk2(v[2], v[3]); *(u32x2*)p = w; }


namespace pg8 {
constexpr int BM = 256, BK = 64, HALF = 128, HTB = HALF * BK * 2, STAGE_BYTES = 8 * HTB, NXCD = 8, WGM = 8;
__host__ __device__ __forceinline__ int lds_byte(int r, int c) { const int st = (r >> 4) * 2 + (c >> 5), rr = r & 15, cc = c & 31, ob = rr * 64 + cc * 2; return st * 1024 + (ob ^ (((ob >> 9) & 1) << 5)); }
__host__ __device__ __forceinline__ void stage_rc(int b, int& R, int& C) { const int st = b / 1024, sb = b % 1024, swz = sb ^ (((sb >> 9) & 1) << 5); R = (st >> 1) * 16 + swz / 64; C = (st & 1) * 32 + (swz % 64) / 2; }
__host__ __device__ __forceinline__ int perm32(int rho) { const int n = rho >> 4, i = rho & 15; return 8 * (i >> 2) + 4 * n + (i & 3); }
struct Unit { int pm, pn, e; };
struct DenseOrder {
    static constexpr bool GATHER = false;
    int nM, nN, nwg, G, c, K; const char* Bt;
    __device__ __forceinline__ void init(int M, int N, int K_, const bf16* Bt_, int G_, int c_) { nM = M / BM; nN = N / BM; nwg = nM * nN; G = G_; c = c_; K = K_; Bt = (const char*)Bt_; }
    __device__ __forceinline__ bool next(int i, Unit& u) const {
        const long L = (long)i * G + c; if (L >= nwg) return false;
        int wgid = (int)L; { const int q = nwg / NXCD, r = nwg % NXCD, xcd = wgid % NXCD, off = wgid / NXCD; wgid = (xcd < r ? xcd * (q + 1) : r * (q + 1) + (xcd - r) * q) + off; }
        const int nig = WGM * nN, gid = wgid / nig, fm = gid * WGM, gsz = (nM - fm) < WGM ? (nM - fm) : WGM;
        u.pm = fm + ((wgid % nig) % gsz); u.pn = (wgid % nig) / gsz; u.e = 0; return true;
    }
    __device__ __forceinline__ unsigned a_voff(const Unit& u, int half, int R) const { return (unsigned)((u.pm * BM + half * HALF + R) * K) * 2u; }
    __device__ __forceinline__ const char* b_tile(const Unit& u) const { return Bt + (size_t)u.pn * BM * K * 2; }
};
template <bool GATH> struct MoeOrder {
    static constexpr bool GATHER = GATH;
    int nunits, ntn, G, c, K; const LAS int* off; const LAS int* cn; const int* list; const char* Bt; size_t estride;
    __device__ __forceinline__ bool next(int i, Unit& u) const {
        const int L = i * G + c; if (L >= nunits) return false;
        u.pm = L / ntn; u.pn = L % ntn; const int s0 = u.pm * BM; int e = 0;
#pragma unroll
        for (int q = 1; q < 16; ++q) e += (s0 >= off[q]) ? 1 : 0;
        u.e = e; return true;
    }
    __device__ __forceinline__ unsigned a_voff(const Unit& u, int half, int R) const {
        const int slot = u.pm * BM + half * HALF + R;
        const int loc = slot - off[u.e]; const int tk = list[u.e * T + (loc < cn[u.e] ? loc : 0)];
        return (unsigned)(tk * K) * 2u;
    }
    __device__ __forceinline__ const char* b_tile(const Unit& u) const { return Bt + (size_t)u.e * estride + (size_t)u.pn * BM * K * 2; }
};
__device__ __forceinline__ unsigned cvt_pk_bf16(float lo, float hi) { return pk2(lo, hi); }

template <class Epi, class Sched>
__device__ __forceinline__ void gemm_phase(LAS unsigned char* lds, const bf16* Aptr, int K, const Sched& S, const Epi& E, int wv_) {
    const int tid = opaque_tid(wv_), wid = __builtin_amdgcn_readfirstlane(tid >> 6), lane = tid & 63, wr = wid >> 2, wc = wid & 3, fr = lane & 15, fq = lane >> 4;
    const int nt = K / BK;
    int Rr[2], Cc[2]; unsigned voffA[2], voffB[2];
#pragma unroll
    for (int i = 0; i < 2; ++i) { stage_rc(tid * 16 + i * 8192, Rr[i], Cc[i]); const int Rb = Epi::PERM ? ((Rr[i] & ~31) + perm32(Rr[i] & 31)) : Rr[i];
        voffA[i] = (unsigned)(Rr[i] * K + Cc[i]) * 2u; voffB[i] = (unsigned)(Rb * K + Cc[i]) * 2u; }
    const size_t kstep = (size_t)(BK * 2);
    const size_t hstep = (size_t)HALF * K * 2;
    const size_t tstep = 2 * hstep;
    const unsigned ldsw = (unsigned)wid * 1024u;
    const int aoff = lds_byte(wr * 64 + fr, fq * 8), boff = lds_byte(wc * 32 + fr, fq * 8);
    const char* const Ab = (const char*)Aptr;
#define PG8_SA(b, h) (((b) * 2 + (h)) * HTB)
#define PG8_SB(b, h) ((4 + (b) * 2 + (h)) * HTB)
#define PG8_STAGE(bufoff, gbase, voff) do { _Pragma("unroll") for (int _i = 0; _i < 2; ++_i) \
        __builtin_amdgcn_global_load_lds((const unsigned*)((const char*)(gbase) + (voff)[_i]), (LAS unsigned*)(lds + (bufoff) + ldsw + _i * 8192), 16, 0, 0); } while (0)
#define PG8_STAGE_A(bufoff, usenext, h, kofs) do { \
        if constexpr (Sched::GATHER) { const char* gb_ = Ab + (kofs); unsigned vv_[2] = {(usenext) ? vN[h][0] : vA[h][0], (usenext) ? vN[h][1] : vA[h][1]}; PG8_STAGE(bufoff, gb_, vv_); } \
        else { const char* gb_ = ((usenext) ? nA : cA) + (size_t)(h) * hstep + (kofs); PG8_STAGE(bufoff, gb_, voffA); } } while (0)
#define PG8_LDA(dst, b, h) do { _Pragma("unroll") for (int m = 0; m < 4; ++m) _Pragma("unroll") for (int k = 0; k < 2; ++k) dst[m][k] = *(const LAS bf16x8*)(lds + PG8_SA(b, h) + aoff + m * 2048 + k * 1024); } while (0)
#define PG8_LDB(dst, b, h) do { _Pragma("unroll") for (int n = 0; n < 2; ++n) _Pragma("unroll") for (int k = 0; k < 2; ++k) dst[n][k] = *(const LAS bf16x8*)(lds + PG8_SB(b, h) + boff + n * 2048 + k * 1024); } while (0)
#define PG8_MMA(ai, bj, At, Bt) do { __builtin_amdgcn_s_setprio(1); _Pragma("unroll") for (int m = 0; m < 4; ++m) _Pragma("unroll") for (int n = 0; n < 2; ++n) _Pragma("unroll") for (int k = 0; k < 2; ++k) \
        acc[ai][bj][m][n] = __builtin_amdgcn_mfma_f32_16x16x32_bf16(Bt[n][k], At[m][k], acc[ai][bj][m][n], 0, 0, 0); __builtin_amdgcn_s_setprio(0); } while (0)
#define PG8_WAIT_V(n) asm volatile("s_waitcnt vmcnt(" #n ")" ::: "memory")
#define PG8_WAIT_L(n) asm volatile("s_waitcnt lgkmcnt(" #n ")" ::: "memory")
#define PG8_BAR __builtin_amdgcn_s_barrier()
#define PG8_SCHED __builtin_amdgcn_sched_barrier(0)
    Unit cur, nxt; int ui = 0;
    if (!S.next(0, cur)) return;
    f32x4 acc[2][2][4][2];
#pragma unroll
    for (int a = 0; a < 2; ++a)
#pragma unroll
        for (int b = 0; b < 2; ++b)
#pragma unroll
            for (int m = 0; m < 4; ++m)
#pragma unroll
                for (int n = 0; n < 2; ++n) acc[a][b][m][n] = (f32x4){0.f, 0.f, 0.f, 0.f};
    bf16x8 At[4][2], B0[2][2], B1[2][2];
    unsigned vA[2][2], vN[2][2];
    const char* cA = Ab; const char* nA = Ab;
    if constexpr (Sched::GATHER) {
#pragma unroll
        for (int h = 0; h < 2; ++h)
#pragma unroll
            for (int i = 0; i < 2; ++i) { vA[h][i] = S.a_voff(cur, h, Rr[i]) + (unsigned)Cc[i] * 2u; vN[h][i] = vA[h][i]; }
    } else { cA = Ab + (size_t)cur.pm * tstep; nA = cA; }
    const char* cB = S.b_tile(cur);
    PG8_STAGE(PG8_SB(0, 0), cB, voffB); PG8_STAGE_A(PG8_SA(0, 0), false, 0, 0); PG8_STAGE(PG8_SB(0, 1), cB + hstep, voffB); PG8_STAGE_A(PG8_SA(0, 1), false, 1, 0);
    if (wr == 1) PG8_BAR;
    PG8_WAIT_V(4); PG8_BAR;
    PG8_STAGE(PG8_SB(1, 0), cB + kstep, voffB); PG8_STAGE_A(PG8_SA(1, 0), false, 0, kstep); PG8_STAGE(PG8_SB(1, 1), cB + hstep + kstep, voffB);
    PG8_WAIT_V(6); PG8_BAR;
    for (;;) {
        const bool has_next = S.next(ui + 1, nxt);
        const char* nB = has_next ? S.b_tile(nxt) : cB;
        if constexpr (Sched::GATHER) {
#pragma unroll
            for (int h = 0; h < 2; ++h)
#pragma unroll
                for (int i = 0; i < 2; ++i) vN[h][i] = has_next ? S.a_voff(nxt, h, Rr[i]) + (unsigned)Cc[i] * 2u : vA[h][i];
        } else nA = has_next ? Ab + (size_t)nxt.pm * tstep : cA;
        for (int t = 0; t < nt; t += 2) {
            const bool last = (t == nt - 2);
            const size_t k1 = (size_t)(t + 1) * kstep, k2 = last ? 0 : (size_t)(t + 2) * kstep, k3 = k2 + kstep;
            const char* b2 = last ? nB : cB + (size_t)(t + 2) * kstep; const char* b3 = b2 + kstep;
            PG8_LDB(B0, 0, 0); PG8_SCHED; PG8_LDA(At, 0, 0); PG8_STAGE_A(PG8_SA(1, 1), false, 1, k1);
            PG8_WAIT_L(8); PG8_BAR; PG8_WAIT_L(0); PG8_MMA(0, 0, At, B0); PG8_BAR; PG8_SCHED;
            PG8_LDB(B1, 0, 1); PG8_STAGE(PG8_SB(0, 0), b2, voffB);
            PG8_BAR; PG8_WAIT_L(0); PG8_MMA(0, 1, At, B1); PG8_BAR;
            PG8_LDA(At, 0, 1); PG8_STAGE_A(PG8_SA(0, 0), last, 0, k2);
            PG8_BAR; PG8_WAIT_L(0); PG8_MMA(1, 0, At, B0); PG8_BAR; PG8_SCHED;
            PG8_STAGE(PG8_SB(0, 1), b2 + hstep, voffB);
            PG8_WAIT_V(6); PG8_BAR; PG8_MMA(1, 1, At, B1); PG8_BAR;
            PG8_LDB(B0, 1, 0); PG8_SCHED; PG8_LDA(At, 1, 0); PG8_STAGE_A(PG8_SA(0, 1), last, 1, k2);
            PG8_WAIT_L(8); PG8_BAR; PG8_WAIT_L(0); PG8_MMA(0, 0, At, B0); PG8_BAR; PG8_SCHED;
            PG8_LDB(B1, 1, 1); PG8_STAGE(PG8_SB(1, 0), b3, voffB);
            PG8_BAR; PG8_WAIT_L(0); PG8_MMA(0, 1, At, B1); PG8_BAR;
            PG8_LDA(At, 1, 1); PG8_STAGE_A(PG8_SA(1, 0), last, 0, k3);
            PG8_BAR; PG8_WAIT_L(0); PG8_MMA(1, 0, At, B0); PG8_BAR; PG8_SCHED;
            PG8_STAGE(PG8_SB(1, 1), b3 + hstep, voffB);
            PG8_WAIT_V(6); PG8_BAR; PG8_MMA(1, 1, At, B1); PG8_BAR;
        }
        E(acc, cur, wr, wc, fr, fq);
        if (!has_next) break;
#pragma unroll
        for (int a = 0; a < 2; ++a)
#pragma unroll
            for (int b = 0; b < 2; ++b)
#pragma unroll
                for (int m = 0; m < 4; ++m)
#pragma unroll
                    for (int n = 0; n < 2; ++n) acc[a][b][m][n] = (f32x4){0.f, 0.f, 0.f, 0.f};
        cur = nxt; cB = nB; cA = nA; ++ui;
        if constexpr (Sched::GATHER) {
#pragma unroll
            for (int h = 0; h < 2; ++h)
#pragma unroll
                for (int i = 0; i < 2; ++i) vA[h][i] = vN[h][i];
        }
    }
    PG8_WAIT_V(0);
    if (wr == 0) PG8_BAR;
    PG8_BAR;
#undef PG8_SA
#undef PG8_SB
#undef PG8_STAGE
#undef PG8_STAGE_A
#undef PG8_LDA
#undef PG8_LDB
#undef PG8_MMA
#undef PG8_WAIT_V
#undef PG8_WAIT_L
#undef PG8_BAR
#undef PG8_SCHED
}
template <int ACT> struct EpiBf16 {
    static constexpr bool PERM = true;
    bf16* O; int ldc; int tpt; size_t tstride;
    __device__ __forceinline__ void operator()(const f32x4 (&acc)[2][2][4][2], const Unit& u, int wr, int wc, int fr, int fq) const {
        const int row0 = u.pm * BM + wr * 64 + fr; const int tt = u.pn / tpt; bf16* base = O + (size_t)tt * tstride; const int col0 = (u.pn - tt * tpt) * BM + wc * 32 + 8 * fq;
#pragma unroll
        for (int ai = 0; ai < 2; ++ai)
#pragma unroll
            for (int m = 0; m < 4; ++m) { bf16* rowp = base + (size_t)(row0 + ai * HALF + m * 16) * ldc + col0;
#pragma unroll
                for (int bj = 0; bj < 2; ++bj) { f32x4 v0 = acc[ai][bj][m][0], v1 = acc[ai][bj][m][1];
                    if (ACT == 1) {
#pragma unroll
                        for (int q = 0; q < 4; ++q) { v0[q] = gelu_tanh(v0[q]); v1[q] = gelu_tanh(v1[q]); } }
                    u32x4 w; w.x = cvt_pk_bf16(v0[0], v0[1]); w.y = cvt_pk_bf16(v0[2], v0[3]); w.z = cvt_pk_bf16(v1[0], v1[1]); w.w = cvt_pk_bf16(v1[2], v1[3]);
                    *(u32x4*)(rowp + bj * HALF) = w; } }
    }
};
struct EpiResAdd {
    static constexpr bool PERM = false;
    float* X; int ldc;
    __device__ __forceinline__ void operator()(const f32x4 (&acc)[2][2][4][2], const Unit& u, int wr, int wc, int fr, int fq) const {
        const int row0 = u.pm * BM + wr * 64 + fr, col0 = u.pn * BM + wc * 32 + 4 * fq;
#pragma unroll
        for (int ai = 0; ai < 2; ++ai)
#pragma unroll
            for (int m2 = 0; m2 < 4; m2 += 2) {
                f32x4 x[2][2][2];
#pragma unroll
                for (int mm = 0; mm < 2; ++mm)
#pragma unroll
                    for (int bj = 0; bj < 2; ++bj)
#pragma unroll
                        for (int n = 0; n < 2; ++n) x[mm][bj][n] = *(const f32x4*)(X + (size_t)(row0 + ai * HALF + (m2 + mm) * 16) * ldc + col0 + bj * HALF + n * 16);
#pragma unroll
                for (int mm = 0; mm < 2; ++mm)
#pragma unroll
                    for (int bj = 0; bj < 2; ++bj)
#pragma unroll
                        for (int n = 0; n < 2; ++n) *(f32x4*)(X + (size_t)(row0 + ai * HALF + (m2 + mm) * 16) * ldc + col0 + bj * HALF + n * 16) = x[mm][bj][n] + acc[ai][bj][m2 + mm][n];
            }
    }
};
struct EpiResAddNorm {
    static constexpr bool PERM = false;
    float* X; int ldc; bf16* XB; float* rowsq;
    __device__ __forceinline__ void operator()(const f32x4 (&acc)[2][2][4][2], const Unit& u, int wr, int wc, int fr, int fq) const {
        const int row0 = u.pm * BM + wr * 64 + fr, col0 = u.pn * BM + wc * 32 + 4 * fq;
#pragma unroll
        for (int ai = 0; ai < 2; ++ai)
#pragma unroll
            for (int m2 = 0; m2 < 4; m2 += 2) {
                f32x4 x[2][2][2];
#pragma unroll
                for (int mm = 0; mm < 2; ++mm)
#pragma unroll
                    for (int bj = 0; bj < 2; ++bj)
#pragma unroll
                        for (int n = 0; n < 2; ++n) x[mm][bj][n] = *(const f32x4*)(X + (size_t)(row0 + ai * HALF + (m2 + mm) * 16) * ldc + col0 + bj * HALF + n * 16);
#pragma unroll
                for (int mm = 0; mm < 2; ++mm) {
                    const size_t ro = (size_t)(row0 + ai * HALF + (m2 + mm) * 16) * ldc + col0; float ssq = 0.f;
#pragma unroll
                    for (int bj = 0; bj < 2; ++bj)
#pragma unroll
                        for (int n = 0; n < 2; ++n) { const f32x4 v = x[mm][bj][n] + acc[ai][bj][m2 + mm][n];
                            *(f32x4*)(X + ro + bj * HALF + n * 16) = v;
                            u32x2 w; w.x = cvt_pk_bf16(v.x, v.y); w.y = cvt_pk_bf16(v.z, v.w); *(u32x2*)(XB + ro + bj * HALF + n * 16) = w;
                            ssq += (v.x * v.x + v.y * v.y) + (v.z * v.z + v.w * v.w); }
                    ssq += __shfl_xor(ssq, 16); ssq += __shfl_xor(ssq, 32);
                    if (fq == 0) rowsq[(size_t)(row0 + ai * HALF + (m2 + mm) * 16) * 16 + u.pn * 4 + wc] = ssq;
                }
            }
    }
};
struct EpiBf16RowScale {
    static constexpr bool PERM = true;
    bf16* O; int ldc; const float* rowsq;
    __device__ __forceinline__ void operator()(const f32x4 (&acc)[2][2][4][2], const Unit& u, int wr, int wc, int fr, int fq) const {
        const int row0 = u.pm * BM + wr * 64 + fr, col0 = u.pn * BM + wc * 32 + 8 * fq;
#pragma unroll
        for (int ai = 0; ai < 2; ++ai) {
            float rs[4];
#pragma unroll
            for (int m = 0; m < 4; ++m) { const f32x4* p = (const f32x4*)(rowsq + (size_t)(row0 + ai * HALF + m * 16) * 16); const f32x4 a = p[0], b = p[1], c = p[2], d = p[3];
                rs[m] = rsqrtf((((a.x + a.y) + (a.z + a.w)) + ((b.x + b.y) + (b.z + b.w)) + (((c.x + c.y) + (c.z + c.w)) + ((d.x + d.y) + (d.z + d.w)))) * (1.f / 1024.f) + EPS); }
#pragma unroll
            for (int m = 0; m < 4; ++m) { bf16* rowp = O + (size_t)(row0 + ai * HALF + m * 16) * ldc + col0;
#pragma unroll
                for (int bj = 0; bj < 2; ++bj) { const f32x4 v0 = acc[ai][bj][m][0] * rs[m], v1 = acc[ai][bj][m][1] * rs[m];
                    u32x4 w; w.x = cvt_pk_bf16(v0[0], v0[1]); w.y = cvt_pk_bf16(v0[2], v0[3]); w.z = cvt_pk_bf16(v1[0], v1[1]); w.w = cvt_pk_bf16(v1[2], v1[3]);
                    *(u32x4*)(rowp + bj * HALF) = w; } }
        }
    }
};
struct EpiSwiglu {
    static constexpr bool PERM = true;
    bf16* H; int ldc;
    __device__ __forceinline__ void operator()(const f32x4 (&acc)[2][2][4][2], const Unit& u, int wr, int wc, int fr, int fq) const {
        const int row0 = u.pm * BM + wr * 64 + fr, col0 = u.pn * HALF + wc * 32 + 8 * fq;
#pragma unroll
        for (int ai = 0; ai < 2; ++ai)
#pragma unroll
            for (int m = 0; m < 4; ++m) {
                float o[8];
#pragma unroll
                for (int n = 0; n < 2; ++n)
#pragma unroll
                    for (int q = 0; q < 4; ++q) { const float g = acc[ai][0][m][n][q]; o[4 * n + q] = g * sigmoidf_(g) * acc[ai][1][m][n][q]; }
                u32x4 w; w.x = cvt_pk_bf16(o[0], o[1]); w.y = cvt_pk_bf16(o[2], o[3]); w.z = cvt_pk_bf16(o[4], o[5]); w.w = cvt_pk_bf16(o[6], o[7]);
                *(u32x4*)(H + (size_t)(row0 + ai * HALF + m * 16) * ldc + col0) = w; }
    }
};
}

__device__ __forceinline__ int hyb_colmap(int n) {
    if (n < 1280) return n;
    if (n < 1536) return 1304 + (n - 1280);
    if (n < 1792) return 1560 + (n - 1536);
    if (n < 2304) return 1816 + (n - 1792);
    if (n < 2816) return 2344 + (n - 2304);
    if (n < 2840) return 1280 + (n - 2816);
    if (n < 2856) return 2328 + (n - 2840);
    return -1;
}
__device__ __forceinline__ void tr_item(const float* __restrict__ W, int Nsrc, int K, bf16* __restrict__ Wt, const float* __restrict__ gain, int kind, int nblk, LAS float* scr, int item, int lane) {
    const int kb = item / nblk, nb = item % nblk, k0 = 64 * kb, n0 = 64 * nb;
    const int ksub = lane >> 4, n4 = lane & 15, n = n0 + 4 * n4;
    int col;
    if (kind == 0) col = n; else if (kind == 1) col = hyb_colmap(n); else { const int pn = n >> 8, r = n & 255; col = (r >> 7) * 384 + pn * 128 + (r & 127); }
    f32x4 v[16];
#pragma unroll
    for (int i = 0; i < 16; ++i) v[i] = col >= 0 ? *(const f32x4*)(W + (size_t)(k0 + 4 * i + ksub) * Nsrc + col) : (f32x4){0.f, 0.f, 0.f, 0.f};
    if (gain) {
#pragma unroll
        for (int i = 0; i < 16; ++i) v[i] = v[i] * gain[k0 + 4 * i + ksub];
    }
#pragma unroll
    for (int i = 0; i < 16; ++i) { LAS float* d = scr + (4 * i + ksub) * 65 + 4 * n4; d[0] = v[i].x; d[1] = v[i].y; d[2] = v[i].z; d[3] = v[i].w; }
    LDS_WAIT();
    const int c = lane & 7;
#pragma unroll
    for (int jx = 0; jx < 8; ++jx) {
        const int nn = (lane >> 3) + 8 * jx; const LAS float* s = scr + (8 * c) * 65 + nn;
        u32x4 o; o.x = pk2(s[0 * 65], s[1 * 65]); o.y = pk2(s[2 * 65], s[3 * 65]); o.z = pk2(s[4 * 65], s[5 * 65]); o.w = pk2(s[6 * 65], s[7 * 65]);
        *(u32x4*)(Wt + (size_t)(n0 + nn) * K + k0 + 8 * c) = o;
    }
    LDS_WAIT();
}
__device__ __forceinline__ void rms_row_to_bf16(const float* __restrict__ xrow, bf16* __restrict__ orow, float* __restrict__ copy, int lane) {
    const f32x4* xr = (const f32x4*)xrow + lane;
    f32x4 v[4]; float s = 0.f;
#pragma unroll
    for (int j = 0; j < 4; ++j) { v[j] = xr[64 * j]; s += (v[j].x * v[j].x + v[j].y * v[j].y) + (v[j].z * v[j].z + v[j].w * v[j].w); }
    const float rstd = rsqrtf(wave_sum(s) * (1.f / 1024.f) + EPS);
    u32x2* o8 = (u32x2*)orow + lane;
#pragma unroll
    for (int j = 0; j < 4; ++j) { u32x2 w; w.x = pk2(v[j].x * rstd, v[j].y * rstd); w.y = pk2(v[j].z * rstd, v[j].w * rstd); o8[64 * j] = w; }
    if (copy) { f32x4* c4 = (f32x4*)copy + lane;
#pragma unroll
        for (int j = 0; j < 4; ++j) c4[64 * j] = v[j]; }
}

__device__ __forceinline__ void phase_prologue(KArgs A, int wv_, LAS unsigned char* lds) {
    const int tid = opaque_tid(wv_), wid = __builtin_amdgcn_readfirstlane(tid >> 6), lane = tid & 63;
    const int gw = blockIdx.x * 8 + wid, NGW = gridDim.x * 8;
    LAS float* scr = (LAS float*)(lds + wid * 16640);
    unsigned char* ws = opq(A->ws);
    constexpr int N_HYB = 2 * 768, N_HOUT = 2 * 256, N_SGIN = 2 * 1024, N_SGOUT = 2 * 512, N_WQ = 4 * 256, N_WKV = 4 * 512, N_WO = 4 * 256, N_MIN = 64 * 192, N_MOUT = 64 * 96, N_W1T = 4 * 32;
    constexpr int NITEMS = N_HYB + N_HOUT + N_SGIN + N_SGOUT + N_WQ + N_WKV + N_WO + N_MIN + N_MOUT + N_W1T;
    for (int it = gw; it < NITEMS; it += NGW) {
        int r = it;
        if (r < N_HYB) { const int sl = r / 768; tr_item(A->in[I_HYBIN] + (size_t)sl * 1024 * HYSRC, HYSRC, 1024, (bf16*)(ws + WS_WHYB) + (size_t)sl * HYN * 1024, A->in[I_NMIX] + (2 * sl) * 1024, 1, 48, scr, r % 768, lane); continue; } r -= N_HYB;
        if (r < N_HOUT) { const int sl = r / 256; tr_item(A->in[I_HYBOUT] + (size_t)sl * 1024 * 1024, 1024, 1024, (bf16*)(ws + WS_WHOUT) + (size_t)sl * 1024 * 1024, nullptr, 0, 16, scr, r % 256, lane); continue; } r -= N_HOUT;
        if (r < N_SGIN) { const int sl = r / 1024; tr_item(A->in[I_SGIN] + (size_t)sl * 1024 * 4096, 4096, 1024, (bf16*)(ws + WS_WSGIN) + (size_t)sl * 4096 * 1024, A->in[I_NMIX] + (2 * sl + 1) * 1024, 0, 64, scr, r % 1024, lane); continue; } r -= N_SGIN;
        if (r < N_SGOUT) { const int sl = r / 512; tr_item(A->in[I_SGOUT] + (size_t)sl * 2048 * 1024, 1024, 2048, (bf16*)(ws + WS_WSGOUT) + (size_t)sl * 1024 * 2048, nullptr, 0, 16, scr, r % 512, lane); continue; } r -= N_SGOUT;
        if (r < N_WQ) { const int sl = r / 256; tr_item(A->in[I_XWQ] + (size_t)sl * 1024 * 1024, 1024, 1024, (bf16*)(ws + WS_WQ) + (size_t)sl * 1024 * 1024, A->in[I_NXAT] + sl * 1024, 0, 16, scr, r % 256, lane); continue; } r -= N_WQ;
        if (r < N_WKV) { const int sl = r / 512; tr_item(A->in[I_XWKV] + (size_t)sl * 1024 * 2048, 2048, 1024, (bf16*)(ws + WS_WKV) + (size_t)sl * 2048 * 1024, A->in[I_NMEM] + sl * 1024, 0, 32, scr, r % 512, lane); continue; } r -= N_WKV;
        if (r < N_WO) { const int sl = r / 256; tr_item(A->in[I_XWO] + (size_t)sl * 1024 * 1024, 1024, 1024, (bf16*)(ws + WS_WO) + (size_t)sl * 1024 * 1024, nullptr, 0, 16, scr, r % 256, lane); continue; } r -= N_WO;
        if (r < N_MIN) { const int sl = r / 192; tr_item(A->in[I_MOEIN] + (size_t)sl * 1024 * 768, 768, 1024, (bf16*)(ws + WS_WMIN) + (size_t)sl * 768 * 1024, A->in[I_NFFN] + (sl >> 4) * 1024, 2, 12, scr, r % 192, lane); continue; } r -= N_MIN;
        if (r < N_MOUT) { const int sl = r / 96; tr_item(A->in[I_MOEOUT] + (size_t)sl * 384 * 1024, 1024, 384, (bf16*)(ws + WS_WMOUT) + (size_t)sl * 1024 * 384, nullptr, 0, 16, scr, r % 96, lane); continue; } r -= N_MOUT;
        { const int sl = r / 32; tr_item(A->in[I_CMPW1] + (size_t)sl * 2048 * 64, 64, 2048, (bf16*)(ws + WS_W1T) + (size_t)sl * 64 * 2048, nullptr, 0, 1, scr, r % 32, lane); }
    }
    for (int m = gw; m < T; m += NGW) rms_row_to_bf16(A->in[I_X] + (size_t)m * D, (bf16*)(ws + WS_XN) + (size_t)m * D, A->out + (size_t)m * D, lane);
    for (int m = gw; m < NBATCH * NMEM; m += NGW) rms_row_to_bf16(A->in[I_MEM] + (size_t)m * D, (bf16*)(ws + WS_MN) + (size_t)m * D, nullptr, lane);
    const int gt = blockIdx.x * 512 + tid, NGT = gridDim.x * 512;
    const int* pos = (const int*)A->in[I_POS];
    float* cosT = (float*)(ws + WS_COS); float* sinT = (float*)(ws + WS_SIN);
    for (int i = gt; i < T * 32; i += NGT) {
        const int t = i >> 5, j = i & 31;
        const float ang = (float)pos[t] * A->freq[j];
        const double rev = (double)ang * 0.15915494309189533577;
        const float fr = (float)(rev - rint(rev));
        cosT[i] = __builtin_amdgcn_cosf(fr); sinT[i] = __builtin_amdgcn_sinf(fr);
    }
    { bf16* WSB = (bf16*)(ws + WS_WSB); float* M0 = (float*)(ws + WS_M0); const float* wsg = A->in[I_SGWS];
      for (int e = gt; e < 2 * 8 * 128 * 128; e += NGT) { const int s = e & 127, t = (e >> 7) & 127; WSB[e] = (bf16)f2bf(s <= t ? wsg[e] : 0.f); }
      for (int e = gt; e < 2 * 8 * 128; e += NGT) { const int t = e & 127; const float* r = wsg + (size_t)e * 128; float a = 0.f; for (int s = 0; s <= t; ++s) a += r[s]; M0[e] = a; } }
    float* RW = (float*)(ws + WS_RW);
    for (int i = gt; i < DEPTH * NEXP * D; i += NGT) { const int k = i & 1023, e = (i >> 10) & 15, l = i >> 14; RW[i] = A->in[I_RW][k * NEXP + e] * A->in[I_NFFN][l * D + k]; }
}

__device__ __forceinline__ void phase_knorm(KArgs A, int wv_) {
    const int tid_ = opaque_tid(wv_); const int wid = __builtin_amdgcn_readfirstlane(tid_ >> 6), lane = tid_ & 63; const int gw = blockIdx.x * 8 + wid, NGW = gridDim.x * 8;
    bf16* KV = (bf16*)(opq(A->ws) + WS_KV);
    for (int it0 = gw * 4; it0 < DEPTH * 2048 * 4; it0 += NGW * 4) {
        u32x2 w[4];
#pragma unroll
        for (int q = 0; q < 4; ++q) { const int it = it0 + q; const int h = it & 3, m = (it >> 2) & 2047, l = it >> 13; w[q] = *(const u32x2*)(KV + (size_t)m * 8192 + l * 2048 + h * 256 + 4 * lane); }
#pragma unroll
        for (int q = 0; q < 4; ++q) {
            const int it = it0 + q; const int h = it & 3, m = (it >> 2) & 2047, l = it >> 13;
            const float x0 = bflo(w[q].x), x1 = bfhi(w[q].x), x2 = bflo(w[q].y), x3 = bfhi(w[q].y);
            const float rstd = rsqrtf(wave_sum(x0 * x0 + x1 * x1 + x2 * x2 + x3 * x3) * (1.f / 256.f) + EPS) * 0.0625f;
            const f32x4 g = *(const f32x4*)(A->in[I_XKN] + l * 256 + 4 * lane) * *(const f32x4*)(A->in[I_XQN] + l * 256 + 4 * lane);
            u32x2 o; o.x = pk2(x0 * rstd * g.x, x1 * rstd * g.y); o.y = pk2(x2 * rstd * g.z, x3 * rstd * g.w);
            *(u32x2*)(KV + (size_t)m * 8192 + l * 2048 + h * 256 + 4 * lane) = o;
        }
    }
}

__device__ __forceinline__ int kpos64(int tok) { const int k = tok & 31; return (tok & 32) + 8 * ((k >> 2) & 3) + 4 * (k >> 4) + (k & 3); }
__device__ __forceinline__ int kperm64(int p) { const int fq = (p >> 3) & 3, j = p & 7; return (p & 32) + 16 * (j >> 2) + 4 * fq + (j & 3); }

__device__ __forceinline__ void phase_nsa_prep(KArgs A, int wv_, int i, LAS unsigned char* lds) {
    const int tid_ = opaque_tid(wv_); const int wid = __builtin_amdgcn_readfirstlane(tid_ >> 6), lane = tid_ & 63; const int gw = blockIdx.x * 8 + wid, NGW = gridDim.x * 8;
    unsigned char* ws = opq(A->ws);
    const bf16* HY = (const bf16*)(ws + WS_BIG);
    const float* cosT = (const float*)(ws + WS_COS); const float* sinT = (const float*)(ws + WS_SIN);
    bf16* QA = (bf16*)(ws + WS_QA); bf16* KS = (bf16*)(ws + WS_KS); bf16* KW = (bf16*)(ws + WS_KW);
    LAS float* abuf = (LAS float*)(lds + wid * 8192);
    const int NIT = T;
    for (int it = gw; it < NIT; it += NGW) {
        if (it < T) {
            const int t = it;
            const float c = cosT[t * 32 + (lane & 31)], s = sinT[t * 32 + (lane & 31)];
            float xin[12];
#pragma unroll
            for (int u = 0; u < 12; ++u) xin[u] = bf2f(HY[(size_t)t * HYN + (u < 8 ? C_QA + 64 * u : (u < 10 ? C_KS + 64 * (u - 8) : C_KW + 64 * (u - 10))) + lane]);
#pragma unroll
            for (int u = 0; u < 12; ++u) {
                int src; const float* gain; bf16* dst; float scale;
                if (u < 8) { src = C_QA + 64 * u; gain = A->in[I_QNORM] + i * 64; dst = QA + (size_t)t * 512 + 64 * u; scale = 0.125f * 1.4426950408889634f; }
                else if (u < 10) { src = C_KS + 64 * (u - 8); gain = A->in[I_KNORM] + (i * 3 + 1) * 64; dst = KS + (size_t)t * 128 + 64 * (u - 8); scale = 1.f; }
                else { src = C_KW + 64 * (u - 10); gain = A->in[I_KNORM] + (i * 3 + 2) * 64; dst = KW + (size_t)t * 128 + 64 * (u - 10); scale = 1.f; }
                const float x = xin[u]; (void)src;
                const float y = x * rsqrtf(wave_sum(x * x) * (1.f / 64.f) + EPS) * gain[lane] * scale;
                const float pr = __shfl_xor(y, 32);
                const float o = lane < 32 ? y * c - pr * s : y * c + pr * s;
                dst[lane] = (bf16)f2bf(o);
            }
        }
    }
}


__device__ __forceinline__ void phase_compress_mfma(KArgs A, int wv_, int i, LAS unsigned char* lds) {
    const int tid = opaque_tid(wv_), wid = __builtin_amdgcn_readfirstlane(tid >> 6), lane = tid & 63, fr = lane & 15, fq = lane >> 4;
    unsigned char* ws = opq(A->ws);
    const bf16* HY = (const bf16*)(ws + WS_BIG);
    const float* cosT = (const float*)(ws + WS_COS); const float* sinT = (const float*)(ws + WS_SIN);
    LAS float* part = (LAS float*)lds;
    LAS float* hbuf = part + 8 * 1024;
    LAS float* obuf = hbuf + 1024;
    LAS float* w2l = obuf + 1024;
    int w2kv = -1;
    for (int it = blockIdx.x; it < 2 * 127; it += gridDim.x) {
        const int kv = it / 127, tile = it % 127;
        const float* pe = A->in[I_CMPPE] + (size_t)(i * 2 + kv) * 32 * 64;
        const float* w2 = A->in[I_CMPW2] + (size_t)(i * 2 + kv) * 64 * 64;
        const bf16* w1t = (const bf16*)(ws + WS_W1T) + (size_t)(i * 2 + kv) * 64 * 2048;
        const int coff = kv ? C_VC : C_KC;
        if (kv != w2kv) { __syncthreads(); for (int e4 = tid; e4 < 1024; e4 += 512) *(LAS f32x4*)(w2l + 4 * e4) = *(const f32x4*)(w2 + 4 * e4); w2kv = kv; }
        {
            const int R = tile * 16 + fr, g = R & 1, bn = R >> 1, n = bn % NCMP, b = bn / NCMP;
            const bf16* arow = HY + (size_t)(b * S + 16 * n) * HYN + coff + g * 64;
            f32x4 acc[4];
#pragma unroll
            for (int t = 0; t < 4; ++t) acc[t] = (f32x4){0.f, 0.f, 0.f, 0.f};
#pragma unroll 4
            for (int s = 0; s < 8; ++s) {
                const int k0 = 256 * wid + 32 * s, l = k0 >> 6, d0 = (k0 & 63) + 8 * fq;
                const u32x4 hw = *(const u32x4*)(arow + (size_t)l * HYN + d0);
                const f32x4 p0 = *(const f32x4*)(pe + l * 64 + d0), p1 = *(const f32x4*)(pe + l * 64 + d0 + 4);
                u32x4 aw; aw.x = pk2(bflo(hw.x) + p0.x, bfhi(hw.x) + p0.y); aw.y = pk2(bflo(hw.y) + p0.z, bfhi(hw.y) + p0.w); aw.z = pk2(bflo(hw.z) + p1.x, bfhi(hw.z) + p1.y); aw.w = pk2(bflo(hw.w) + p1.z, bfhi(hw.w) + p1.w);
                const bf16x8 af = __builtin_bit_cast(bf16x8, aw);
#pragma unroll
                for (int t = 0; t < 4; ++t) { const bf16x8 bfr = *(const bf16x8*)(w1t + (size_t)(16 * t + fr) * 2048 + k0 + 8 * fq);
                    acc[t] = __builtin_amdgcn_mfma_f32_16x16x32_bf16(af, bfr, acc[t], 0, 0, 0); }
            }
            __syncthreads();
#pragma unroll
            for (int t = 0; t < 4; ++t)
#pragma unroll
                for (int r = 0; r < 4; ++r) part[wid * 1024 + (4 * fq + r) * 64 + 16 * t + fr] = acc[t][r];
        }
        __syncthreads();
        for (int e = tid; e < 1024; e += 512) { float a = 0.f;
#pragma unroll
            for (int w = 0; w < 8; ++w) a += part[w * 1024 + e];
            hbuf[e] = gelu_tanh(a); }
        __syncthreads();
        for (int e = tid; e < 1024; e += 512) { const int r = e >> 6, j = e & 63; float o = 0.f;
#pragma unroll 8
            for (int m = 0; m < 64; ++m) o += hbuf[r * 64 + m] * w2l[m * 64 + j];
            obuf[e] = o; }
        __syncthreads();
        for (int r = wid; r < 16; r += 8) {
            const int R = tile * 16 + r, g = R & 1, bn = R >> 1, n = bn % NCMP, b = bn / NCMP;
            const float o = obuf[r * 64 + lane];
            if (kv == 0) {
                const float y = o * rsqrtf(wave_sum(o * o) * (1.f / 64.f) + EPS) * A->in[I_KNORM][(i * 3 + 0) * 64 + lane];
                const int tp = b * S + 16 * n + 31;
                const float c = cosT[tp * 32 + (lane & 31)], sn = sinT[tp * 32 + (lane & 31)];
                const float pr = __shfl_xor(y, 32);
                const float oo = lane < 32 ? y * c - pr * sn : y * c + pr * sn;
                ((bf16*)(ws + WS_KC))[((size_t)(b * 128 + n) * 2 + g) * 64 + lane] = (bf16)f2bf(oo);
            } else {
                bf16* vct = (bf16*)(ws + WS_VC) + ((size_t)(b * 2 + g) * 64 + lane) * 128;
                vct[(n & 64) + kpos64(n & 63)] = (bf16)f2bf(o);
                if (n == 126) vct[127] = 0;
            }
        }
    }
    __syncthreads();
}

__device__ __forceinline__ void nsa_block(const LAS float* qs, const bf16* __restrict__ krow, bool ok, const bf16* __restrict__ vbase, int vstride, int lane,
                                          float (&m)[4], float (&l)[4], float (&o)[4]) {
    float s[4] = {0.f, 0.f, 0.f, 0.f};
#pragma unroll 2
    for (int c = 0; c < 8; ++c) {
        const u32x4 kw = *(const u32x4*)(krow + 8 * c);
        const float k0 = bflo(kw.x), k1 = bfhi(kw.x), k2 = bflo(kw.y), k3 = bfhi(kw.y), k4 = bflo(kw.z), k5 = bfhi(kw.z), k6 = bflo(kw.w), k7 = bfhi(kw.w);
#pragma unroll
        for (int hh = 0; hh < 4; ++hh) {
            const f32x4 qa = *(const LAS f32x4*)(qs + hh * 64 + 8 * c), qb = *(const LAS f32x4*)(qs + hh * 64 + 8 * c + 4);
            s[hh] += (qa.x * k0 + qa.y * k1) + (qa.z * k2 + qa.w * k3) + (qb.x * k4 + qb.y * k5) + (qb.z * k6 + qb.w * k7);
        }
    }
    float p[4];
#pragma unroll
    for (int hh = 0; hh < 4; ++hh) {
        const float sv = ok ? s[hh] : -INFINITY;
        const float bm = wave_max(sv);
        const float mn = fmaxf(m[hh], bm);
        if (mn == -INFINITY) { p[hh] = 0.f; continue; }
        const float alpha = __expf(m[hh] - mn);
        p[hh] = ok ? __expf(sv - mn) : 0.f;
        l[hh] = l[hh] * alpha + wave_sum(p[hh]);
        o[hh] *= alpha; m[hh] = mn;
    }
#pragma unroll 8
    for (int kk = 0; kk < 64; ++kk) {
        const float v = bf2f(vbase[(size_t)kk * vstride + lane]);
#pragma unroll
        for (int hh = 0; hh < 4; ++hh) o[hh] += __shfl(p[hh], kk) * v;
    }
}
__device__ __forceinline__ void phase_nsa_attn(KArgs A, int wv_, int i, LAS unsigned char* lds) {
    const int tid_ = opaque_tid(wv_); const int wid = __builtin_amdgcn_readfirstlane(tid_ >> 6), lane0 = tid_ & 63; const int gw = blockIdx.x * 8 + wid, NGW = gridDim.x * 8;
    unsigned char* ws = opq(A->ws);
    const bf16* HY = (const bf16*)(ws + WS_BIG); const bf16* QA = (const bf16*)(ws + WS_QA); const bf16* KS = (const bf16*)(ws + WS_KS); const bf16* KW = (const bf16*)(ws + WS_KW);
    const bf16* KC = (const bf16*)(ws + WS_KC); const bf16* VC = (const bf16*)(ws + WS_VC); bf16* CAT = (bf16*)(ws + WS_CAT);
    LAS float* qs = (LAS float*)(lds + wid * 2048);
    LAS float* ps = qs + 256;
    for (int it = gw; it < 2 * T; it += NGW) {
        int lane = lane0; asm volatile("" : "+v"(lane));
        const int tok = it >> 1, g = it & 1, b = tok >> 11, t = tok & 2047;
#pragma unroll
        for (int hh = 0; hh < 4; ++hh) qs[hh * 64 + lane] = bf2f(QA[(size_t)tok * 512 + (g * 4 + hh) * 64 + lane]);
        LDS_WAIT();
        const int ncv = t >= 31 ? ((t - 31) >> 4) + 1 : 0;
        float oc[4] = {0.f, 0.f, 0.f, 0.f};
        float psum0 = 0.f, psum1 = 0.f;
        {
            const bool v0 = lane < ncv, v1 = lane + 64 < ncv;
            const bf16* k0p = KC + ((size_t)(b * 128 + lane) * 2 + g) * 64;
            const bf16* k1p = KC + ((size_t)(b * 128 + (lane + 64 < 127 ? lane + 64 : 126)) * 2 + g) * 64;
            float s0[4] = {0.f, 0.f, 0.f, 0.f}, s1[4] = {0.f, 0.f, 0.f, 0.f};
#pragma unroll 2
            for (int c = 0; c < 8; ++c) {
                const u32x4 ka = *(const u32x4*)(k0p + 8 * c), kb = *(const u32x4*)(k1p + 8 * c);
#pragma unroll
                for (int hh = 0; hh < 4; ++hh) {
                    const f32x4 qa = *(const LAS f32x4*)(qs + hh * 64 + 8 * c), qb = *(const LAS f32x4*)(qs + hh * 64 + 8 * c + 4);
                    s0[hh] += (qa.x * bflo(ka.x) + qa.y * bfhi(ka.x)) + (qa.z * bflo(ka.y) + qa.w * bfhi(ka.y)) + (qb.x * bflo(ka.z) + qb.y * bfhi(ka.z)) + (qb.z * bflo(ka.w) + qb.w * bfhi(ka.w));
                    s1[hh] += (qa.x * bflo(kb.x) + qa.y * bfhi(kb.x)) + (qa.z * bflo(kb.y) + qa.w * bfhi(kb.y)) + (qb.x * bflo(kb.z) + qb.y * bfhi(kb.z)) + (qb.z * bflo(kb.w) + qb.w * bfhi(kb.w));
                }
            }
            float p0[4], p1[4];
#pragma unroll
            for (int hh = 0; hh < 4; ++hh) {
                const float a0 = v0 ? s0[hh] : -INFINITY, a1 = v1 ? s1[hh] : -INFINITY;
                const float mx = wave_max(fmaxf(a0, a1));
                if (ncv > 0) {
                    const float e0 = v0 ? __expf(a0 - mx) : 0.f, e1 = v1 ? __expf(a1 - mx) : 0.f;
                    const float inv = 1.0f / wave_sum(e0 + e1);
                    p0[hh] = e0 * inv; p1[hh] = e1 * inv;
                } else { p0[hh] = 0.f; p1[hh] = 0.f; }
                psum0 += p0[hh]; psum1 += p1[hh];
            }
#pragma unroll 2
            for (int c = 0; c < ncv; ++c) {
                const float v = bf2f(VC[((size_t)(b * 128 + c) * 2 + g) * 64 + lane]);
#pragma unroll
                for (int hh = 0; hh < 4; ++hh) oc[hh] += __shfl(c < 64 ? p0[hh] : p1[hh], c & 63) * v;
            }
        }
        ps[lane] = psum0; ps[64 + lane] = psum1;
        LDS_WAIT();
        const int cur = t >> 6;
        unsigned selmask;
        {
            const int j = lane & 31;
            float imp = ps[4 * j] + ps[4 * j + 1] + ps[4 * j + 2] + 0.5f * ps[4 * j + 3] + (j > 0 ? 0.5f * ps[4 * j - 1] : 0.f);
            const bool valid = j <= cur, forced = (j == 0) || (j == cur) || (j == cur - 1);
            const float score = valid ? imp + (forced ? 1000.0f : 0.f) : -INFINITY;
            int rank = 0;
#pragma unroll 8
            for (int jj = 0; jj < 32; ++jj) { const float sj = __shfl(score, jj); rank += (sj > score || (sj == score && jj < j)) ? 1 : 0; }
            const bool sel = valid && rank < 8 && lane < 32;
            selmask = (unsigned)__ballot(sel);
        }
        LDS_WAIT();
        float o1[4] = {0.f, 0.f, 0.f, 0.f}, o2[4] = {0.f, 0.f, 0.f, 0.f};
#pragma unroll 1
        for (int pass = 0; pass < 2; ++pass) {
            float oa[4] = {0.f, 0.f, 0.f, 0.f}, ma[4] = {-INFINITY, -INFINITY, -INFINITY, -INFINITY}, la[4] = {0.f, 0.f, 0.f, 0.f};
            const int lo = pass ? (t - 255 > 0 ? t - 255 : 0) : 0;
            const unsigned bm = pass ? 0xffffffffu : selmask;
            const bf16* Kb = pass ? KW : KS; const int vc = pass ? C_VW : C_VS;
#pragma unroll 1
            for (int j = lo >> 6; j <= cur; ++j) {
                if (!((bm >> j) & 1u)) continue;
                const int key = 64 * j + lane; const size_t kt = (size_t)(b * S + key);
                nsa_block(qs, Kb + kt * 128 + g * 64, key <= t && key >= lo, HY + (size_t)(b * S + 64 * j) * HYN + vc + g * 64, HYN, lane, ma, la, oa);
            }
            if (pass == 0) {
#pragma unroll
                for (int hh = 0; hh < 4; ++hh) o1[hh] = oa[hh] / la[hh];
            } else {
#pragma unroll
                for (int hh = 0; hh < 4; ++hh) o2[hh] = oa[hh] / la[hh];
            }
        }
#pragma unroll
        for (int hh = 0; hh < 4; ++hh) {
            const int head = g * 4 + hh;
            const float* gb = A->in[I_GATEB] + i * 24 + head * 3;
            const bf16* gl = HY + (size_t)tok * HYN + C_GA + head * 3;
            const float g0 = sigmoidf_(bf2f(gl[0]) + gb[0]), g1 = sigmoidf_(bf2f(gl[1]) + gb[1]), g2 = sigmoidf_(bf2f(gl[2]) + gb[2]);
            const float o = g0 * oc[hh] + g1 * o1[hh] + g2 * o2[hh];
            CAT[(size_t)tok * 1024 + head * 64 + lane] = (bf16)f2bf(o);
        }
    }
}

__device__ __forceinline__ void phase_gla_seq(KArgs A, int wv_, int i, LAS unsigned char* lds) {
    const int tid = opaque_tid(wv_), wid = __builtin_amdgcn_readfirstlane(tid >> 6), lane = tid & 63;
    unsigned char* ws = opq(A->ws);
    const bf16* HY = (const bf16*)(ws + WS_BIG); bf16* CAT = (bf16*)(ws + WS_CAT);
    constexpr int CH = 16;
    LAS float* la = (LAS float*)lds;
    LAS float* lk = la + 4 * CH * 64;
    LAS float* lq = lk + 4 * CH * 64;
    LAS float* lo = lq + 4 * CH * 64;
    const float* wa2 = A->in[I_WA2] + i * 16 * 256; const float* ba = A->in[I_BA] + i * 256; const float* og = A->in[I_ONORM] + i * 128;
    for (int it = blockIdx.x; it < 8; it += gridDim.x) {
        const int pl = tid >> 7, v = tid & 127, p = it * 4 + pl, b = p >> 2, h = p & 3;
        float St[64];
#pragma unroll
        for (int k = 0; k < 64; ++k) St[k] = 0.f;
        for (int c0 = 0; c0 < S; c0 += CH) {
            __syncthreads();
            for (int e = tid; e < 4 * CH * 64; e += 512) {
                const int kk = e & 63, tk = (e >> 6) % CH, pp = e / (64 * CH); const int pb = (it * 4 + pp) >> 2, ph = (it * 4 + pp) & 3;
                const size_t tok = (size_t)pb * S + c0 + tk; const bf16* row = HY + tok * HYN;
                float z = ba[ph * 64 + kk];
#pragma unroll
                for (int r = 0; r < 16; ++r) z += bf2f(row[C_AL + r]) * wa2[r * 256 + ph * 64 + kk];
                const float ls_ = fminf(z, 0.f) - log1pf(__expf(-fabsf(z)));
                la[e] = __expf(ls_ * (1.f / 16.f));
                lk[e] = bf2f(row[C_KB + ph * 64 + kk]);
                lq[e] = bf2f(row[C_QB + ph * 64 + kk]) * 0.125f;
            }
            __syncthreads();
            for (int tk = 0; tk < CH; ++tk) {
                const size_t tok = (size_t)b * S + c0 + tk;
                const float vv = bf2f(HY[tok * HYN + C_VB + h * 128 + v]);
                const LAS float* pa = la + (pl * CH + tk) * 64; const LAS float* pk = lk + (pl * CH + tk) * 64; const LAS float* pq = lq + (pl * CH + tk) * 64;
                float o = 0.f;
#pragma unroll
                for (int k4 = 0; k4 < 16; ++k4) {
                    const f32x4 a4 = *(const LAS f32x4*)(pa + 4 * k4), k4v = *(const LAS f32x4*)(pk + 4 * k4), q4 = *(const LAS f32x4*)(pq + 4 * k4);
                    St[4 * k4 + 0] = a4.x * St[4 * k4 + 0] + k4v.x * vv; o += q4.x * St[4 * k4 + 0];
                    St[4 * k4 + 1] = a4.y * St[4 * k4 + 1] + k4v.y * vv; o += q4.y * St[4 * k4 + 1];
                    St[4 * k4 + 2] = a4.z * St[4 * k4 + 2] + k4v.z * vv; o += q4.z * St[4 * k4 + 2];
                    St[4 * k4 + 3] = a4.w * St[4 * k4 + 3] + k4v.w * vv; o += q4.w * St[4 * k4 + 3];
                }
                lo[(pl * CH + tk) * 128 + v] = o;
            }
            __syncthreads();
            for (int r = wid; r < 4 * CH; r += 8) {
                const int pp = r / CH, tk = r % CH; const int pb = (it * 4 + pp) >> 2, ph = (it * 4 + pp) & 3;
                const size_t tok = (size_t)pb * S + c0 + tk;
                const float x0 = lo[r * 128 + lane], x1 = lo[r * 128 + 64 + lane];
                const float rstd = rsqrtf(wave_sum(x0 * x0 + x1 * x1) * (1.f / 128.f) + EPS);
                const float r0 = bf2f(HY[tok * HYN + C_RB + ph * 128 + lane]), r1 = bf2f(HY[tok * HYN + C_RB + ph * 128 + 64 + lane]);
                CAT[tok * 1024 + 512 + ph * 128 + lane] = (bf16)f2bf(x0 * rstd * og[lane] * (r0 * sigmoidf_(r0)));
                CAT[tok * 1024 + 512 + ph * 128 + 64 + lane] = (bf16)f2bf(x1 * rstd * og[64 + lane] * (r1 * sigmoidf_(r1)));
            }
        }
        __syncthreads();
    }
}


__device__ __forceinline__ void phase_nsa_attn_mfma(KArgs A, int wv_, int i, LAS unsigned char* lds) {
    const int tid = opaque_tid(wv_), wid = __builtin_amdgcn_readfirstlane(tid >> 6), lane = tid & 63, fr = lane & 15, fq = lane >> 4;
    unsigned char* ws = opq(A->ws);
    const bf16* HY = (const bf16*)(ws + WS_BIG); const bf16* QA = (const bf16*)(ws + WS_QA); const bf16* KS = (const bf16*)(ws + WS_KS); const bf16* KW = (const bf16*)(ws + WS_KW);
    const bf16* KC = (const bf16*)(ws + WS_KC); const bf16* VCT = (const bf16*)(ws + WS_VC); const bf16* VTA = (const bf16*)(ws + WS_VTA); bf16* CAT = (bf16*)(ws + WS_CAT);
    constexpr int RS = 72;
    LAS bf16* ktl = (LAS bf16*)lds;
    LAS bf16* vtl = ktl + 4 * 64 * RS;
    LAS float* scl = (LAS float*)(lds + 73728) + wid * 256;
    LAS unsigned* msk = (LAS unsigned*)(lds + 73728 + 8192);
    LAS unsigned* umask = msk + 64;
    const float* gb = A->in[I_GATEB] + i * 24;
    unsigned long long tsub = 0, tt0 = 0;
    for (int pit = blockIdx.x; pit < 256; pit += gridDim.x) {
#pragma unroll 1
        for (int hf = 0; hf < 2; ++hf) {
            const int bg = pit >> 4, xx = pit & 15, x = hf ? 31 - xx : xx, b = bg >> 1, g = bg & 1;
            const size_t tokbase = (size_t)b * S + 64 * x;
            const int tl0 = 8 * wid + (fr >> 2);
            if (tid == 0) *umask = 0u;
            if (PROBE_NSA == 1) tt0 = __builtin_amdgcn_s_memrealtime();
            bf16x8 qf[2][2];
#pragma unroll
            for (int mt = 0; mt < 2; ++mt)
#pragma unroll
                for (int s = 0; s < 2; ++s) qf[mt][s] = *(const bf16x8*)(QA + (tokbase + tl0 + 4 * mt) * 512 + (g * 4 + (fr & 3)) * 64 + 32 * s + 8 * fq);
            f32x4 outacc[2][4];
            {
                const int tmaxc = (4 * x + 3 + 15) >> 4;
                const bf16* kcb = KC + ((size_t)(b * 128 + fr) * 2 + g) * 64 + 8 * fq;
                bf16x8 pcf[2][4];
#pragma unroll
                for (int mt = 0; mt < 2; ++mt) {
                    f32x4 sc[8];
                    const bf16* kp = kcb;
#pragma unroll
                    for (int t = 0; t < 8; ++t) { sc[t] = (f32x4){0.f, 0.f, 0.f, 0.f};
                        asm volatile("" : "+v"(kp));
                        if (t < tmaxc) {
                            const bf16x8 k0 = *(const bf16x8*)(kp), k1 = *(const bf16x8*)(kp + 32);
                            sc[t] = __builtin_amdgcn_mfma_f32_16x16x32_bf16(k0, qf[mt][0], sc[t], 0, 0, 0);
                            sc[t] = __builtin_amdgcn_mfma_f32_16x16x32_bf16(k1, qf[mt][1], sc[t], 0, 0, 0); }
                        kp += 16 * 128; }
                    const int tg = 64 * x + tl0 + 4 * mt; const int ncv = tg >= 31 ? ((tg - 31) >> 4) + 1 : 0;
                    float mx = -INFINITY;
#pragma unroll
                    for (int t = 0; t < 8; ++t)
#pragma unroll
                        for (int r = 0; r < 4; ++r) { const bool v = 16 * t + 4 * fq + r < ncv; sc[t][r] = v ? sc[t][r] : -INFINITY; mx = fmaxf(mx, sc[t][r]); }
                    mx = fmaxf(mx, __shfl_xor(mx, 16)); mx = fmaxf(mx, __shfl_xor(mx, 32));
                    const float mxs = mx == -INFINITY ? 0.f : mx;
                    float sum = 0.f;
#pragma unroll
                    for (int t = 0; t < 8; ++t)
#pragma unroll
                        for (int r = 0; r < 4; ++r) { sc[t][r] = __builtin_amdgcn_exp2f(sc[t][r] - mxs); sum += sc[t][r]; }
                    sum += __shfl_xor(sum, 16); sum += __shfl_xor(sum, 32);
                    const float inv = sum > 0.f ? 1.f / sum : 0.f;
#pragma unroll
                    for (int t = 0; t < 8; ++t) sc[t] = sc[t] * inv;
#pragma unroll
                    for (int s = 0; s < 4; ++s) { u32x4 w; w.x = pk2(sc[2 * s].x, sc[2 * s].y); w.y = pk2(sc[2 * s].z, sc[2 * s].w); w.z = pk2(sc[2 * s + 1].x, sc[2 * s + 1].y); w.w = pk2(sc[2 * s + 1].z, sc[2 * s + 1].w);
                        pcf[mt][s] = __builtin_bit_cast(bf16x8, w); }
                    float w3[8];
#pragma unroll
                    for (int t = 0; t < 8; ++t) {
#pragma unroll
                        for (int r = 0; r < 4; ++r) { float v = sc[t][r]; v += __shfl_xor(v, 1); v += __shfl_xor(v, 2); sc[t][r] = v; }
                        w3[t] = __shfl(sc[t].w, (lane + 48) & 63);
                    }
#pragma unroll
                    for (int t = 0; t < 8; ++t) {
                        const float prev = fq > 0 ? w3[t] : (t > 0 ? w3[t > 0 ? t - 1 : 0] : 0.f);
                        const float imp = sc[t].x + sc[t].y + sc[t].z + 0.5f * sc[t].w + 0.5f * prev;
                        if ((fr & 3) == 0) scl[(4 * mt + (fr >> 2)) * 32 + 4 * t + fq] = imp;
                    }
                    asm volatile("" ::: "memory");
                }
                const bf16* vcb = VCT + ((size_t)(b * 2 + g) * 64 + fr) * 128 + 8 * fq;
#pragma unroll
                for (int n = 0; n < 4; ++n) {
                    outacc[0][n] = (f32x4){0.f, 0.f, 0.f, 0.f}; outacc[1][n] = (f32x4){0.f, 0.f, 0.f, 0.f};
                    asm volatile("" : "+v"(vcb));
#pragma unroll
                    for (int s = 0; s < 4; ++s) if (2 * s < tmaxc) {
                        const bf16x8 vf = *(const bf16x8*)(vcb + 32 * s);
                        outacc[0][n] = __builtin_amdgcn_mfma_f32_16x16x32_bf16(vf, pcf[0][s], outacc[0][n], 0, 0, 0);
                        outacc[1][n] = __builtin_amdgcn_mfma_f32_16x16x32_bf16(vf, pcf[1][s], outacc[1][n], 0, 0, 0); }
                    vcb += 16 * 128;
                    asm volatile("" ::: "memory");
                }
            }
            float g1v[2], g2v[2];
#pragma unroll
            for (int mt = 0; mt < 2; ++mt) {
                const int head = g * 4 + (fr & 3);
                const bf16* gl = HY + (tokbase + tl0 + 4 * mt) * HYN + C_GA + head * 3;
                const float g0 = sigmoidf_(bf2f(gl[0]) + gb[head * 3 + 0]);
                g1v[mt] = sigmoidf_(bf2f(gl[1]) + gb[head * 3 + 1]); g2v[mt] = sigmoidf_(bf2f(gl[2]) + gb[head * 3 + 2]);
#pragma unroll
                for (int n = 0; n < 4; ++n) outacc[mt][n] = outacc[mt][n] * g0;
            }
            LDS_WAIT();
            asm volatile("" ::: "memory");
            {
                const int tok8 = lane >> 3, jg = lane & 7;
                float sj[32];
#pragma unroll
                for (int q = 0; q < 8; ++q) { const f32x4 v = *(const LAS f32x4*)(scl + tok8 * 32 + 4 * q); sj[4 * q] = v.x; sj[4 * q + 1] = v.y; sj[4 * q + 2] = v.z; sj[4 * q + 3] = v.w; }
#pragma unroll
                for (int j = 0; j < 32; ++j) sj[j] = j <= x ? sj[j] + ((j == 0 || j == x || j == x - 1) ? 1000.0f : 0.f) : -INFINITY;
                unsigned bits = 0u;
                const f32x4 mv = *(const LAS f32x4*)(scl + tok8 * 32 + 4 * jg);
#pragma unroll
                for (int q = 0; q < 4; ++q) {
                    const int j = 4 * jg + q;
                    const float mine = j <= x ? mv[q] + ((j == 0 || j == x || j == x - 1) ? 1000.0f : 0.f) : -INFINITY;
                    int rank = 0;
#pragma unroll
                    for (int jj = 0; jj < 32; ++jj) rank += (sj[jj] > mine || (sj[jj] == mine && jj < j)) ? 1 : 0;
                    bits |= (j <= x && rank < 8) ? (1u << j) : 0u;
                }
                bits |= __shfl_xor(bits, 1); bits |= __shfl_xor(bits, 2); bits |= __shfl_xor(bits, 4);
                if (jg == 0) { msk[wid * 8 + tok8] = bits; atomicOr((unsigned*)umask, bits); }
            }
            __syncthreads();
            if (PROBE_NSA == 1) tsub += __builtin_amdgcn_s_memrealtime() - tt0;
#pragma unroll 1
            for (int pass = 0; pass < 2; ++pass) {
                if (PROBE_NSA == 2 + pass) tt0 = __builtin_amdgcn_s_memrealtime();
                const int jlo = pass ? (x >= 4 ? x - 4 : 0) : 0;
                const unsigned inrange = (x >= 31 ? 0xffffffffu : ((2u << x) - 1u)) & ~((1u << jlo) - 1u);
                unsigned bmask = pass ? inrange : (*umask & inrange);
                const bf16* Kb = pass ? KW : KS; const int cg = (pass ? 10 : 8) + g;
                unsigned tm[2], wm[2], am[2];
#pragma unroll
                for (int mt = 0; mt < 2; ++mt) {
                    tm[mt] = pass ? 0xffffffffu : msk[wid * 8 + 4 * mt + (fr >> 2)];
                    wm[mt] = pass ? 0xffffffffu : (msk[wid * 8 + 4 * mt] | msk[wid * 8 + 4 * mt + 1] | msk[wid * 8 + 4 * mt + 2] | msk[wid * 8 + 4 * mt + 3]);
                    am[mt] = pass ? 0xffffffffu : (msk[wid * 8 + 4 * mt] & msk[wid * 8 + 4 * mt + 1] & msk[wid * 8 + 4 * mt + 2] & msk[wid * 8 + 4 * mt + 3]);
                    wm[mt] = __builtin_amdgcn_readfirstlane(wm[mt]); am[mt] = __builtin_amdgcn_readfirstlane(am[mt]);
                }
                f32x4 o[2][4]; float mrun[2], lrun[2];
#pragma unroll
                for (int mt = 0; mt < 2; ++mt) { mrun[mt] = -INFINITY; lrun[mt] = 0.f;
#pragma unroll
                    for (int n = 0; n < 4; ++n) o[mt][n] = (f32x4){0.f, 0.f, 0.f, 0.f}; }
                const int srow = tid >> 3, sc16 = tid & 7;
                u32x4 pk0 = (u32x4){0u, 0u, 0u, 0u}, pv0 = pk0, pk1 = pk0, pv1 = pk0;
#define NSA_LD(jx, pk, pv) do { const bf16* ksrc = Kb + ((size_t)b * S + 64 * (jx) + srow) * 128 + g * 64 + sc16 * 8; const bf16* vsrc = VTA + ((size_t)((b * 32 + (jx)) * 12 + cg)) * 4096 + srow * 64 + sc16 * 8; \
                    pk = *(const u32x4*)ksrc; pv = *(const u32x4*)vsrc; } while (0)
                int j0 = __ffs(bmask) - 1; bmask &= bmask - 1u;
                int j1 = bmask ? __ffs(bmask) - 1 : -1; bmask &= bmask - 1u;
                NSA_LD(j0, pk0, pv0); if (j1 >= 0) NSA_LD(j1, pk1, pv1);
                int buf = 0;
                while (j0 >= 0) {
                    *(LAS u32x4*)(ktl + (buf * 2 + 0) * 64 * RS + srow * RS + sc16 * 8) = pk0; *(LAS u32x4*)(vtl + (buf * 2 + 0) * 64 * RS + srow * RS + sc16 * 8) = pv0;
                    if (j1 >= 0) { *(LAS u32x4*)(ktl + (buf * 2 + 1) * 64 * RS + srow * RS + sc16 * 8) = pk1; *(LAS u32x4*)(vtl + (buf * 2 + 1) * 64 * RS + srow * RS + sc16 * 8) = pv1; }
                    const int jn0 = bmask ? __ffs(bmask) - 1 : -1; bmask &= bmask - 1u;
                    const int jn1 = bmask ? __ffs(bmask) - 1 : -1; bmask &= bmask - 1u;
                    if (jn0 >= 0) NSA_LD(jn0, pk0, pv0);
                    if (jn1 >= 0) NSA_LD(jn1, pk1, pv1);
                    __syncthreads();
#pragma unroll 1
                    for (int sub = 0; sub < 2; ++sub) {
                        const int j = sub ? j1 : j0;
                        if (j < 0) break;
                        const LAS bf16* kt = ktl + (buf * 2 + sub) * 64 * RS + fr * RS + 8 * fq; const LAS bf16* vt = vtl + (buf * 2 + sub) * 64 * RS + fr * RS + 8 * fq;
#pragma unroll
                        for (int mt = 0; mt < 2; ++mt) {
                            if (!((wm[mt] >> j) & 1u)) continue;
                            f32x4 sc[4];
#pragma unroll
                            for (int t = 0; t < 4; ++t) { sc[t] = (f32x4){0.f, 0.f, 0.f, 0.f};
                                sc[t] = __builtin_amdgcn_mfma_f32_16x16x32_bf16(*(const LAS bf16x8*)(kt + t * 16 * RS), qf[mt][0], sc[t], 0, 0, 0);
                                sc[t] = __builtin_amdgcn_mfma_f32_16x16x32_bf16(*(const LAS bf16x8*)(kt + t * 16 * RS + 32), qf[mt][1], sc[t], 0, 0, 0); }
                            const int tl = tl0 + 4 * mt;
                            const bool rowok = (tm[mt] >> j) & 1u;
                            const bool edge = (j == x) || (pass && j == x - 4);
                            float bm = -INFINITY;
                            if (edge) {
                                const int kphi = j == x ? tl : 63;
                                const int kplo = (pass && j == x - 4) ? tl + 1 : 0;
#pragma unroll
                                for (int t = 0; t < 4; ++t)
#pragma unroll
                                    for (int r = 0; r < 4; ++r) { const int kp = 16 * t + 4 * fq + r; const bool v = rowok && kp <= kphi && kp >= kplo; sc[t][r] = v ? sc[t][r] : -INFINITY; bm = fmaxf(bm, sc[t][r]); }
                            } else {
#pragma unroll
                                for (int t = 0; t < 4; ++t) bm = fmaxf(bm, fmaxf(fmaxf(sc[t].x, sc[t].y), fmaxf(sc[t].z, sc[t].w)));
                                if (!((am[mt] >> j) & 1u)) bm = rowok ? bm : -INFINITY;
                            }
                            bm = fmaxf(bm, __shfl_xor(bm, 16)); bm = fmaxf(bm, __shfl_xor(bm, 32));
                            const float mn = fmaxf(mrun[mt], bm); const float mns = mn == -INFINITY ? 0.f : mn;
                            float rs = 0.f;
#pragma unroll
                            for (int t = 0; t < 4; ++t)
#pragma unroll
                                for (int r = 0; r < 4; ++r) { sc[t][r] = __builtin_amdgcn_exp2f(sc[t][r] - mns); rs += sc[t][r]; }
                            if (!edge && !((am[mt] >> j) & 1u)) {
#pragma unroll
                                for (int t = 0; t < 4; ++t) sc[t] = rowok ? sc[t] : (f32x4){0.f, 0.f, 0.f, 0.f};
                                rs = rowok ? rs : 0.f;
                            }
                            rs += __shfl_xor(rs, 16); rs += __shfl_xor(rs, 32);
                            if (__all(mn == mrun[mt])) { lrun[mt] += rs; }
                            else {
                                const float alpha = __builtin_amdgcn_exp2f(mrun[mt] - mns);
                                lrun[mt] = lrun[mt] * alpha + rs; mrun[mt] = mn;
#pragma unroll
                                for (int n = 0; n < 4; ++n) o[mt][n] = o[mt][n] * alpha;
                            }
                            bf16x8 pf[2];
#pragma unroll
                            for (int s = 0; s < 2; ++s) { u32x4 w; w.x = pk2(sc[2 * s].x, sc[2 * s].y); w.y = pk2(sc[2 * s].z, sc[2 * s].w); w.z = pk2(sc[2 * s + 1].x, sc[2 * s + 1].y); w.w = pk2(sc[2 * s + 1].z, sc[2 * s + 1].w);
                                pf[s] = __builtin_bit_cast(bf16x8, w); }
#pragma unroll
                            for (int n = 0; n < 4; ++n) {
                                o[mt][n] = __builtin_amdgcn_mfma_f32_16x16x32_bf16(*(const LAS bf16x8*)(vt + n * 16 * RS), pf[0], o[mt][n], 0, 0, 0);
                                o[mt][n] = __builtin_amdgcn_mfma_f32_16x16x32_bf16(*(const LAS bf16x8*)(vt + n * 16 * RS + 32), pf[1], o[mt][n], 0, 0, 0); }
                        }
                    }
                    j0 = jn0; j1 = jn1; buf ^= 1;
                }
#undef NSA_LD
#pragma unroll
                for (int mt = 0; mt < 2; ++mt) { const float sc_ = (pass ? g2v[mt] : g1v[mt]) / lrun[mt];
#pragma unroll
                    for (int n = 0; n < 4; ++n) outacc[mt][n] = outacc[mt][n] + o[mt][n] * sc_; }
                __syncthreads();
                if (PROBE_NSA == 2 + pass) tsub += __builtin_amdgcn_s_memrealtime() - tt0;
            }
#pragma unroll
            for (int mt = 0; mt < 2; ++mt) {
                bf16* dst = CAT + (tokbase + tl0 + 4 * mt) * 1024 + (g * 4 + (fr & 3)) * 64 + 4 * fq;
#pragma unroll
                for (int n = 0; n < 4; ++n) { u32x2 w; w.x = pk2(outacc[mt][n].x, outacc[mt][n].y); w.y = pk2(outacc[mt][n].z, outacc[mt][n].w); *(u32x2*)(dst + 16 * n) = w; }
            }
        }
    }
    __syncthreads();
    if (PROBE_NSA && blockIdx.x == 0 && tid == 0) atomicAdd((unsigned long long*)(ws + WS_CTL + 48000), tsub);
}

__device__ __forceinline__ void phase_vtiles(KArgs A, int wv_, LAS unsigned char* lds) {
    const int tid_ = opaque_tid(wv_); const int wid = __builtin_amdgcn_readfirstlane(tid_ >> 6), lane = tid_ & 63; const int gw = blockIdx.x * 8 + wid, NGW = gridDim.x * 8;
    unsigned char* ws = opq(A->ws);
    const bf16* HY = (const bf16*)(ws + WS_BIG); bf16* VTA = (bf16*)(ws + WS_VTA);
    constexpr int TS = 66;
    LAS bf16* tl = (LAS bf16*)(lds + 65536) + wid * (64 * TS);
    for (int it = gw; it < NBATCH * 32 * 12; it += NGW) {
        const int cg = it % 12, bc = it / 12;
        const int colbase = cg < 8 ? C_VB + cg * 64 : (cg < 10 ? C_VS + (cg - 8) * 64 : C_VW + (cg - 10) * 64);
        const u32x4* src = (const u32x4*)(HY + (size_t)(bc * 64 + lane) * HYN + colbase);
        u32x4 w[8];
#pragma unroll
        for (int i = 0; i < 8; ++i) w[i] = src[i];
#pragma unroll
        for (int i = 0; i < 8; ++i) { LAS unsigned* d = (LAS unsigned*)(tl + lane * TS + 8 * i); d[0] = w[i].x; d[1] = w[i].y; d[2] = w[i].z; d[3] = w[i].w; }
        LDS_WAIT();
        bf16* dst = VTA + (size_t)it * 4096 + lane * 64;
#pragma unroll
        for (int p8 = 0; p8 < 8; ++p8) {
            unsigned short x[8];
#pragma unroll
            for (int j = 0; j < 8; ++j) x[j] = tl[kperm64(p8 * 8 + j) * TS + lane];
            u32x4 o; o.x = x[0] | ((unsigned)x[1] << 16); o.y = x[2] | ((unsigned)x[3] << 16); o.z = x[4] | ((unsigned)x[5] << 16); o.w = x[6] | ((unsigned)x[7] << 16);
            *(u32x4*)(dst + p8 * 8) = o;
        }
        LDS_WAIT();
    }
}

__device__ __forceinline__ float log_sigmoid16(float z) { return (fminf(z, 0.f) - __logf(1.0f + __expf(-fabsf(z)))) * (1.f / 16.f); }
#define GLA_Z(tokv) ({ float z_ = bias; _Pragma("unroll") for (int r_ = 0; r_ < 16; ++r_) z_ += __builtin_bit_cast(float, __builtin_amdgcn_readlane(__builtin_bit_cast(int, al[r_]), (tokv))) * wc[r_]; z_; })
#define GLA_LOAD_GATE() \
    float al[16], wc[16]; \
    { const u32x4* ap_ = (const u32x4*)(HY + (size_t)(tok0 + lane) * HYN + C_AL); const u32x4 a0_ = ap_[0], a1_ = ap_[1]; \
      al[0] = bflo(a0_.x); al[1] = bfhi(a0_.x); al[2] = bflo(a0_.y); al[3] = bfhi(a0_.y); al[4] = bflo(a0_.z); al[5] = bfhi(a0_.z); al[6] = bflo(a0_.w); al[7] = bfhi(a0_.w); \
      al[8] = bflo(a1_.x); al[9] = bfhi(a1_.x); al[10] = bflo(a1_.y); al[11] = bfhi(a1_.y); al[12] = bflo(a1_.z); al[13] = bfhi(a1_.z); al[14] = bflo(a1_.w); al[15] = bfhi(a1_.w); } \
    _Pragma("unroll") for (int r_ = 0; r_ < 16; ++r_) wc[r_] = A->in[I_WA2][(i * 16 + r_) * 256 + h * 64 + lane]; \
    const float bias = A->in[I_BA][i * 256 + h * 64 + lane];

__device__ __forceinline__ void phase_gla_a(KArgs A, int wv_, int i, LAS unsigned char* lds) {
    const int tid_ = opaque_tid(wv_); const int wid = __builtin_amdgcn_readfirstlane(tid_ >> 6), lane = tid_ & 63, fr = lane & 15, fq = lane >> 4; const int gw = blockIdx.x * 8 + wid, NGW = gridDim.x * 8;
    unsigned char* ws = opq(A->ws);
    const bf16* HY = (const bf16*)(ws + WS_BIG); const bf16* VTA = (const bf16*)(ws + WS_VTA); float* SLOC = (float*)(ws + WS_SLOC); float* DEC = (float*)(ws + WS_DEC);
    constexpr int RS = 72;
    LAS bf16* kh = (LAS bf16*)lds + wid * (64 * RS);
    (void)gw;
    for (int it = wid * (int)gridDim.x + (int)blockIdx.x; it < 1024; it += NGW) {
        const int c = it & 31, bh = it >> 5, b = bh >> 2, h = bh & 3; const size_t tok0 = (size_t)b * S + c * 64;
        GLA_LOAD_GATE();
        float bl = 0.f;
#pragma unroll 8
        for (int tk = 0; tk < 64; ++tk) bl += log_sigmoid16(GLA_Z(tk));
        float bc = 0.f;
        unsigned short kcol[64];
#pragma unroll
        for (int tk = 0; tk < 64; ++tk) kcol[tk] = HY[(tok0 + tk) * HYN + C_KB + h * 64 + lane];
#pragma unroll
        for (int tk = 0; tk < 64; ++tk) {
            bc += log_sigmoid16(GLA_Z(tk));
            kh[lane * RS + kpos64(tk)] = (bf16)f2bf(bf2f(kcol[tk]) * __expf(bl - bc));
        }
        DEC[it * 64 + lane] = __expf(bl);
        LDS_WAIT();
#pragma unroll
        for (int dvh = 0; dvh < 2; ++dvh) {
            const bf16* vt = VTA + ((size_t)((b * 32 + c) * 12 + h * 2 + dvh)) * 4096;
            bf16x8 vf[4][2];
#pragma unroll
            for (int n = 0; n < 4; ++n)
#pragma unroll
                for (int s = 0; s < 2; ++s) vf[n][s] = *(const bf16x8*)(vt + (16 * n + fr) * 64 + 32 * s + 8 * fq);
#pragma unroll
            for (int m = 0; m < 4; ++m) {
                const bf16x8 a0 = *(const LAS bf16x8*)(kh + (16 * m + fr) * RS + 8 * fq), a1 = *(const LAS bf16x8*)(kh + (16 * m + fr) * RS + 32 + 8 * fq);
#pragma unroll
                for (int n = 0; n < 4; ++n) {
                    f32x4 acc = (f32x4){0.f, 0.f, 0.f, 0.f};
                    acc = __builtin_amdgcn_mfma_f32_16x16x32_bf16(a0, vf[n][0], acc, 0, 0, 0);
                    acc = __builtin_amdgcn_mfma_f32_16x16x32_bf16(a1, vf[n][1], acc, 0, 0, 0);
                    float* dst = SLOC + ((size_t)it * 64 + 16 * m + 4 * fq) * 128 + dvh * 64 + 16 * n + fr;
                    dst[0] = acc.x; dst[128] = acc.y; dst[256] = acc.z; dst[384] = acc.w;
                }
            }
        }
        LDS_WAIT();
    }
}
__device__ __forceinline__ void phase_gla_c(KArgs A, int wv_, int i, LAS unsigned char* lds) {
    const int tid_ = opaque_tid(wv_); const int wid = __builtin_amdgcn_readfirstlane(tid_ >> 6), lane = tid_ & 63, fr = lane & 15, fq = lane >> 4; const int gw = blockIdx.x * 8 + wid, NGW = gridDim.x * 8;
    unsigned char* ws = opq(A->ws);
    const bf16* HY = (const bf16*)(ws + WS_BIG); const bf16* VTA = (const bf16*)(ws + WS_VTA); const bf16* STT = (const bf16*)(ws + WS_STT); bf16* CAT = (bf16*)(ws + WS_CAT);
    constexpr int RS = 72;
    LAS bf16* qs = (LAS bf16*)lds + wid * (128 * RS);
    LAS bf16* ks = qs + 64 * RS;
    const float* og = A->in[I_ONORM] + i * 128;
    LAS float* ogl = (LAS float*)(lds + 8 * 128 * RS * 2);
    if (tid_ < 128) ogl[tid_] = og[tid_];
    (void)gw; (void)NGW;
    for (int blk = blockIdx.x; blk < 256; blk += gridDim.x) {
        SUBT_BEGIN(1);
        {
            const float* SLOC = (const float*)(ws + WS_SLOC); const float* DEC = (const float*)(ws + WS_DEC); bf16* STw = (bf16*)(ws + WS_STT);
            const int tid = tid_, dv = tid & 127, ko = tid >> 7, bh = blk >> 3, c0 = (blk & 7) * 4;
            float sv[16];
#pragma unroll
            for (int j = 0; j < 16; ++j) sv[j] = 0.f;
#pragma unroll 1
            for (int cb = 0; cb < c0 + 4; cb += 4) {
                float dc4[4][16], sl4[4][16];
#pragma unroll
                for (int q = 0; q < 4; ++q) {
                    const size_t item = (size_t)bh * 32 + cb + q; const float* sl = SLOC + (item * 64 + ko * 16) * 128 + dv; const float* dc = DEC + item * 64 + ko * 16;
#pragma unroll
                    for (int j = 0; j < 16; ++j) { dc4[q][j] = dc[j]; sl4[q][j] = sl[j * 128]; }
                }
#pragma unroll
                for (int q = 0; q < 4; ++q) {
                    const int c = cb + q; const size_t item = (size_t)bh * 32 + c;
                    if (c >= c0) {
                        u32x4 o0, o1; o0.x = pk2(sv[0], sv[1]); o0.y = pk2(sv[2], sv[3]); o0.z = pk2(sv[4], sv[5]); o0.w = pk2(sv[6], sv[7]);
                        o1.x = pk2(sv[8], sv[9]); o1.y = pk2(sv[10], sv[11]); o1.z = pk2(sv[12], sv[13]); o1.w = pk2(sv[14], sv[15]);
                        u32x4* d = (u32x4*)(STw + (item * 128 + dv) * 64 + ko * 16); d[0] = o0; d[1] = o1;
                    }
#pragma unroll
                    for (int j = 0; j < 16; ++j) sv[j] = dc4[q][j] * sv[j] + sl4[q][j];
                }
            }
            asm volatile("s_waitcnt vmcnt(0)" ::: "memory");
            __syncthreads();
        }
        SUBT_END(1, ws, tid_);
        SUBT_BEGIN(2);
        SUBT_BEGIN(3);
        if (wid < 4) {
        const int it = blk * 4 + wid;
        const int c = it & 31, bh = it >> 5, b = bh >> 2, h = bh & 3; const size_t tok0 = (size_t)b * S + c * 64;
        GLA_LOAD_GATE();
        float bc = 0.f;
        unsigned short qcol[64], kcol[64];
#pragma unroll
        for (int tk = 0; tk < 64; ++tk) { const bf16* row = HY + (tok0 + tk) * HYN; qcol[tk] = row[C_QB + h * 64 + lane]; kcol[tk] = row[C_KB + h * 64 + lane]; }
#pragma unroll
        for (int tk = 0; tk < 64; ++tk) {
            bc += log_sigmoid16(GLA_Z(tk));
            const float eb = __expf(bc);
            qs[tk * RS + lane] = (bf16)f2bf(bf2f(qcol[tk]) * 0.125f * eb); ks[tk * RS + lane] = (bf16)f2bf(bf2f(kcol[tk]) / eb);
        }
        LDS_WAIT();
        SUBT_END(2, ws, tid_);
        bf16x8 st[8][2];
#pragma unroll
        for (int n = 0; n < 8; ++n)
#pragma unroll
            for (int s = 0; s < 2; ++s) st[n][s] = *(const bf16x8*)(STT + ((size_t)it * 128 + 16 * n + fr) * 64 + 32 * s + 8 * fq);
        const bf16* vt = VTA + ((size_t)((b * 32 + c) * 12 + h * 2)) * 4096;
        bf16x8 vfr[8][2];
#pragma unroll
        for (int n = 0; n < 8; ++n) { const bf16* vrow = vt + (size_t)(n >> 2) * 4096 + (16 * (n & 3) + fr) * 64 + 8 * fq; vfr[n][0] = *(const bf16x8*)vrow; vfr[n][1] = *(const bf16x8*)(vrow + 32); }
#pragma unroll
        for (int mi = 0; mi < 4; ++mi) {
            const bf16x8 q0 = *(const LAS bf16x8*)(qs + (16 * mi + fr) * RS + 8 * fq), q1 = *(const LAS bf16x8*)(qs + (16 * mi + fr) * RS + 32 + 8 * fq);
            u32x2 rwv[8];
#pragma unroll
            for (int n = 0; n < 8; ++n) rwv[n] = *(const u32x2*)(HY + (tok0 + 16 * mi + fr) * HYN + C_RB + h * 128 + 16 * n + 4 * fq);
            f32x4 sc[4];
#pragma unroll
            for (int t = 0; t < 4; ++t) {
                sc[t] = (f32x4){0.f, 0.f, 0.f, 0.f};
                if (t <= mi) {
                    const bf16x8 k0 = *(const LAS bf16x8*)(ks + (16 * t + fr) * RS + 8 * fq), k1 = *(const LAS bf16x8*)(ks + (16 * t + fr) * RS + 32 + 8 * fq);
                    sc[t] = __builtin_amdgcn_mfma_f32_16x16x32_bf16(k0, q0, sc[t], 0, 0, 0);
                    sc[t] = __builtin_amdgcn_mfma_f32_16x16x32_bf16(k1, q1, sc[t], 0, 0, 0);
                    if (t == mi) {
                        sc[t].x = (4 * fq + 0 <= fr) ? sc[t].x : 0.f; sc[t].y = (4 * fq + 1 <= fr) ? sc[t].y : 0.f; sc[t].z = (4 * fq + 2 <= fr) ? sc[t].z : 0.f; sc[t].w = (4 * fq + 3 <= fr) ? sc[t].w : 0.f; }
                }
            }
            bf16x8 pf[2];
#pragma unroll
            for (int s = 0; s < 2; ++s) { u32x4 w; w.x = pk2(sc[2 * s].x, sc[2 * s].y); w.y = pk2(sc[2 * s].z, sc[2 * s].w); w.z = pk2(sc[2 * s + 1].x, sc[2 * s + 1].y); w.w = pk2(sc[2 * s + 1].z, sc[2 * s + 1].w);
                pf[s] = __builtin_bit_cast(bf16x8, w); }
            f32x4 o[8]; float ssq = 0.f;
#pragma unroll
            for (int n = 0; n < 8; ++n) {
                o[n] = (f32x4){0.f, 0.f, 0.f, 0.f};
                o[n] = __builtin_amdgcn_mfma_f32_16x16x32_bf16(st[n][0], q0, o[n], 0, 0, 0);
                o[n] = __builtin_amdgcn_mfma_f32_16x16x32_bf16(st[n][1], q1, o[n], 0, 0, 0);
                o[n] = __builtin_amdgcn_mfma_f32_16x16x32_bf16(vfr[n][0], pf[0], o[n], 0, 0, 0);
                if (mi >= 2) o[n] = __builtin_amdgcn_mfma_f32_16x16x32_bf16(vfr[n][1], pf[1], o[n], 0, 0, 0);
                ssq += (o[n].x * o[n].x + o[n].y * o[n].y) + (o[n].z * o[n].z + o[n].w * o[n].w);
            }
            ssq += __shfl_xor(ssq, 16); ssq += __shfl_xor(ssq, 32);
            const float rstd = rsqrtf(ssq * (1.f / 128.f) + EPS);
            const size_t tok = tok0 + 16 * mi + fr;
#pragma unroll
            for (int n = 0; n < 8; ++n) {
                const int dv = 16 * n + 4 * fq;
                const u32x2 rw = rwv[n]; const f32x4 g = *(const LAS f32x4*)(ogl + dv);
                const float r0 = bflo(rw.x), r1 = bfhi(rw.x), r2 = bflo(rw.y), r3 = bfhi(rw.y);
                u32x2 w; w.x = pk2(o[n].x * rstd * g.x * (r0 * sigmoidf_(r0)), o[n].y * rstd * g.y * (r1 * sigmoidf_(r1)));
                w.y = pk2(o[n].z * rstd * g.z * (r2 * sigmoidf_(r2)), o[n].w * rstd * g.w * (r3 * sigmoidf_(r3)));
                *(u32x2*)(CAT + tok * 1024 + 512 + h * 128 + dv) = w;
            }
        }
        }
        SUBT_END(3, ws, tid_);
        LDS_WAIT();
        __syncthreads();
    }
}

__device__ __forceinline__ void phase_sgu_mix(KArgs A, int wv_, int i, LAS unsigned char* lds) {
    const int tid = opaque_tid(wv_), wid = __builtin_amdgcn_readfirstlane(tid >> 6), lane = tid & 63;
    unsigned char* ws = opq(A->ws);
    const bf16* U = (const bf16*)(ws + WS_U); const bf16* V = (const bf16*)(ws + WS_V); bf16* UM = (bf16*)(ws + WS_UM);
    LAS float* vt = (LAS float*)lds;
    LAS float* st = vt + 128 * 256;
    const float* lng = A->in[I_LNG] + i * 2048; const float* lnb = A->in[I_LNB] + i * 2048;
    for (int it = blockIdx.x; it < NBATCH * 16 * 8; it += gridDim.x) {
        const int g = it & 7, n = (it >> 3) & 15, b = it >> 7;
        const size_t tok0 = (size_t)b * S + n * 128;
        __syncthreads();
        for (int s = wid * 16; s < wid * 16 + 16; ++s) {
            const u32x4* vr = (const u32x4*)(V + (tok0 + s) * 2048) + lane;
            float x[32]; float sum = 0.f;
#pragma unroll
            for (int j = 0; j < 4; ++j) { const u32x4 w = vr[64 * j];
                x[8 * j + 0] = bflo(w.x); x[8 * j + 1] = bfhi(w.x); x[8 * j + 2] = bflo(w.y); x[8 * j + 3] = bfhi(w.y); x[8 * j + 4] = bflo(w.z); x[8 * j + 5] = bfhi(w.z); x[8 * j + 6] = bflo(w.w); x[8 * j + 7] = bfhi(w.w); }
#pragma unroll
            for (int j = 0; j < 32; ++j) sum += x[j];
            const float mean = wave_sum(sum) * (1.f / 2048.f); float q = 0.f;
#pragma unroll
            for (int j = 0; j < 32; ++j) { const float d = x[j] - mean; q += d * d; }
            const float rstd = rsqrtf(wave_sum(q) * (1.f / 2048.f) + EPS);
            const u32x2 w = *((const u32x2*)(V + (tok0 + s) * 2048 + g * 256) + lane);
            const f32x4 gg = *(const f32x4*)(lng + g * 256 + 4 * lane), bb = *(const f32x4*)(lnb + g * 256 + 4 * lane);
            f32x4 o; o.x = (bflo(w.x) - mean) * rstd * gg.x + bb.x; o.y = (bfhi(w.x) - mean) * rstd * gg.y + bb.y; o.z = (bflo(w.y) - mean) * rstd * gg.z + bb.z; o.w = (bfhi(w.y) - mean) * rstd * gg.w + bb.w;
            *(LAS f32x4*)(vt + s * 256 + 4 * lane) = o;
            (void)st;
        }
        __syncthreads();
        const int c = tid & 255, th = tid >> 8;
        const float* wsg = A->in[I_SGWS] + (size_t)(i * 8 + g) * 128 * 128; const float* bsg = A->in[I_SGBS] + (i * 8 + g) * 128;
        for (int tt = 0; tt < 64; ++tt) {
            const int t = 2 * tt + th;
            const float* wr = wsg + t * 128;
            float acc = 0.f;
            for (int s = 0; s <= t; ++s) acc += wr[s] * vt[s * 256 + c];
            acc += bsg[t];
            const float u = bf2f(U[(tok0 + t) * 2048 + g * 256 + c]);
            UM[(tok0 + t) * 2048 + g * 256 + c] = (bf16)f2bf(u * acc);
        }
    }
    __syncthreads();
}


__device__ __forceinline__ void phase_sgu_mix_mfma(KArgs A, int wv_, int i, LAS unsigned char* lds) {
    const int tid = opaque_tid(wv_), wid = __builtin_amdgcn_readfirstlane(tid >> 6), lane = tid & 63, fr = lane & 15, fq = lane >> 4;
    unsigned char* ws = opq(A->ws);
    const bf16* U = (const bf16*)(ws + WS_U); const bf16* V = (const bf16*)(ws + WS_V); bf16* UM = (bf16*)(ws + WS_UM);
    const bf16* WSB = (const bf16*)(ws + WS_WSB) + (size_t)i * 8 * 16384; const float* M0 = (const float*)(ws + WS_M0) + i * 8 * 128;
    constexpr int VS = 136;
    LAS bf16* vT = (LAS bf16*)lds;
    LAS float* st = (LAS float*)(lds + 256 * VS * 2);
    LAS bf16* wl = (LAS bf16*)(lds + 256 * VS * 2 + 1024);
    const float* lng = A->in[I_LNG] + i * 2048; const float* lnb = A->in[I_LNB] + i * 2048; const float* bsg = A->in[I_SGBS] + i * 8 * 128;
    for (int it = blockIdx.x; it < 256; it += gridDim.x) {
        const int gh = it & 1, n_ = (it >> 1) & 15, b = it >> 5; const size_t tok0 = (size_t)b * S + n_ * 128;
        __syncthreads();
        for (int s4 = wid * 16; s4 < wid * 16 + 16; s4 += 4) {
            u32x4 w[4][4];
#pragma unroll
            for (int rr = 0; rr < 4; ++rr) { const u32x4* vr = (const u32x4*)(V + (tok0 + s4 + rr) * 2048) + lane;
#pragma unroll
                for (int j = 0; j < 4; ++j) w[rr][j] = vr[64 * j]; }
#pragma unroll
            for (int rr = 0; rr < 4; ++rr) {
                float sum = 0.f, sq = 0.f;
#pragma unroll
                for (int j = 0; j < 4; ++j) { const float x0 = bflo(w[rr][j].x), x1 = bfhi(w[rr][j].x), x2 = bflo(w[rr][j].y), x3 = bfhi(w[rr][j].y), x4 = bflo(w[rr][j].z), x5 = bfhi(w[rr][j].z), x6 = bflo(w[rr][j].w), x7 = bfhi(w[rr][j].w);
                    sum += ((x0 + x1) + (x2 + x3)) + ((x4 + x5) + (x6 + x7)); sq += ((x0 * x0 + x1 * x1) + (x2 * x2 + x3 * x3)) + ((x4 * x4 + x5 * x5) + (x6 * x6 + x7 * x7)); }
                sum = wave_sum(sum); sq = wave_sum(sq);
                const float mean = sum * (1.f / 2048.f); const float var = fmaxf(sq * (1.f / 2048.f) - mean * mean, 0.f);
                if (lane == 0) { st[2 * (s4 + rr)] = mean; st[2 * (s4 + rr) + 1] = rsqrtf(var + EPS); }
            }
        }
#pragma unroll 1
        for (int gg = 0; gg < 4; ++gg) {
            const int g = gh * 4 + gg;
            __syncthreads();
            {
                const int s = tid & 127, cq = tid >> 7;
                const float mean = st[2 * s], rstd = st[2 * s + 1];
                const u32x4* src = (const u32x4*)(V + (tok0 + s) * 2048 + g * 256 + cq * 64);
                u32x4 w8[8], ww[4];
#pragma unroll
                for (int i8 = 0; i8 < 8; ++i8) w8[i8] = src[i8];
#pragma unroll
                for (int q = 0; q < 4; ++q) { const int e = tid + 512 * q; ww[q] = *(const u32x4*)(WSB + ((size_t)g * 128 + (e >> 4)) * 128 + (e & 15) * 8); }
#pragma unroll
                for (int i8 = 0; i8 < 8; ++i8) {
                    const u32x4 w = w8[i8];
                    LAS bf16* d = vT + (cq * 64 + i8 * 8) * VS + s;
                    d[0 * VS] = (bf16)f2bf((bflo(w.x) - mean) * rstd); d[1 * VS] = (bf16)f2bf((bfhi(w.x) - mean) * rstd); d[2 * VS] = (bf16)f2bf((bflo(w.y) - mean) * rstd); d[3 * VS] = (bf16)f2bf((bfhi(w.y) - mean) * rstd);
                    d[4 * VS] = (bf16)f2bf((bflo(w.z) - mean) * rstd); d[5 * VS] = (bf16)f2bf((bfhi(w.z) - mean) * rstd); d[6 * VS] = (bf16)f2bf((bflo(w.w) - mean) * rstd); d[7 * VS] = (bf16)f2bf((bfhi(w.w) - mean) * rstd);
                }
#pragma unroll
                for (int q = 0; q < 4; ++q) { const int e = tid + 512 * q; *(LAS u32x4*)(wl + (e >> 4) * VS + (e & 15) * 8) = ww[q]; }
            }
            u32x2 uw[8][2]; float m0v[8], bsv[8];
#pragma unroll
            for (int n = 0; n < 8; ++n) { const int t = 16 * n + fr; m0v[n] = M0[g * 128 + t]; bsv[n] = bsg[g * 128 + t];
                const size_t ro = (tok0 + t) * 2048 + g * 256 + 32 * wid + 4 * fq; uw[n][0] = *(const u32x2*)(U + ro); uw[n][1] = *(const u32x2*)(U + ro + 16); }
            __syncthreads();
            bf16x8 vf[2][4];
#pragma unroll
            for (int m = 0; m < 2; ++m)
#pragma unroll
                for (int k = 0; k < 4; ++k) vf[m][k] = *(const LAS bf16x8*)(vT + (32 * wid + 16 * m + fr) * VS + 32 * k + 8 * fq);
            f32x4 gc[2], bc[2];
#pragma unroll
            for (int m = 0; m < 2; ++m) { gc[m] = *(const f32x4*)(lng + g * 256 + 32 * wid + 16 * m + 4 * fq); bc[m] = *(const f32x4*)(lnb + g * 256 + 32 * wid + 16 * m + 4 * fq); }
#pragma unroll
            for (int n = 0; n < 8; ++n) {
                f32x4 a0 = (f32x4){0.f, 0.f, 0.f, 0.f}, a1 = (f32x4){0.f, 0.f, 0.f, 0.f};
#pragma unroll
                for (int k = 0; k < 4; ++k) if (k <= (n >> 1)) {
                    const bf16x8 wf = *(const LAS bf16x8*)(wl + (16 * n + fr) * VS + 32 * k + 8 * fq);
                    a0 = __builtin_amdgcn_mfma_f32_16x16x32_bf16(vf[0][k], wf, a0, 0, 0, 0);
                    a1 = __builtin_amdgcn_mfma_f32_16x16x32_bf16(vf[1][k], wf, a1, 0, 0, 0); }
                const int t = 16 * n + fr; const float m0 = m0v[n], bsv_ = bsv[n];
                const size_t ro = (tok0 + t) * 2048 + g * 256 + 32 * wid + 4 * fq;
#pragma unroll
                for (int m = 0; m < 2; ++m) {
                    const f32x4 a = m ? a1 : a0;
                    const u32x2 uw_ = uw[n][m];
                    u32x2 w; w.x = pk2((a.x * gc[m].x + bc[m].x * m0 + bsv_) * bflo(uw_.x), (a.y * gc[m].y + bc[m].y * m0 + bsv_) * bfhi(uw_.x));
                    w.y = pk2((a.z * gc[m].z + bc[m].z * m0 + bsv_) * bflo(uw_.y), (a.w * gc[m].w + bc[m].w * m0 + bsv_) * bfhi(uw_.y));
                    *(u32x2*)(UM + ro + 16 * m) = w;
                }
            }
        }
    }
    __syncthreads();
}

__device__ __forceinline__ void phase_rownorm(KArgs A, int wv_) {
    const int tid_ = opaque_tid(wv_); const int wid = __builtin_amdgcn_readfirstlane(tid_ >> 6), lane = tid_ & 63; const int gw = blockIdx.x * 8 + wid, NGW = gridDim.x * 8;
    bf16* XN = (bf16*)(opq(A->ws) + WS_XN); const float* X = A->out;
    f32x4 v[4], vn[4];
    if (gw < T) {
#pragma unroll
        for (int j = 0; j < 4; ++j) v[j] = ((const f32x4*)(X + (size_t)gw * D) + lane)[64 * j];
    }
    for (int m = gw; m < T; m += NGW) {
        const int mn = m + NGW < T ? m + NGW : m;
#pragma unroll
        for (int j = 0; j < 4; ++j) vn[j] = ((const f32x4*)(X + (size_t)mn * D) + lane)[64 * j];
        float s = 0.f;
#pragma unroll
        for (int j = 0; j < 4; ++j) s += (v[j].x * v[j].x + v[j].y * v[j].y) + (v[j].z * v[j].z + v[j].w * v[j].w);
        const float rstd = rsqrtf(wave_sum(s) * (1.f / 1024.f) + EPS);
        u32x2* o8 = (u32x2*)(XN + (size_t)m * D) + lane;
#pragma unroll
        for (int j = 0; j < 4; ++j) { u32x2 w; w.x = pk2(v[j].x * rstd, v[j].y * rstd); w.y = pk2(v[j].z * rstd, v[j].w * rstd); o8[64 * j] = w; }
#pragma unroll
        for (int j = 0; j < 4; ++j) v[j] = vn[j];
    }
}

__device__ __forceinline__ void phase_xattn(KArgs A, int wv_, int L, LAS unsigned char* lds) {
    const int tid = opaque_tid(wv_), wid = __builtin_amdgcn_readfirstlane(tid >> 6), lane = tid & 63;
    unsigned char* ws = opq(A->ws);
    const bf16* QX = (const bf16*)(ws + WS_QX); const bf16* KV = (const bf16*)(ws + WS_KV); bf16* OX = (bf16*)(ws + WS_OX);
    constexpr int KSTR = 129;
    LAS unsigned* kl = (LAS unsigned*)lds;
    LAS float* qb = (LAS float*)(lds + 132096) + wid * 256;
    LAS float* pb = (LAS float*)(lds + 132096 + 8192) + wid * 256;
    const float* qg = A->in[I_XQN] + L * 256;
    for (int it = blockIdx.x; it < NBATCH * 4 * 8; it += gridDim.x) {
        const int qc = it & 7, h = (it >> 3) & 3, b = it >> 5;
        __syncthreads();
        for (int e = tid; e < 256 * 128; e += 512) { const int m = e >> 7, dw = e & 127;
            kl[m * KSTR + dw] = *((const unsigned*)(KV + (size_t)(b * 256 + m) * 8192 + L * 2048 + h * 256) + dw); }
        __syncthreads();
        const bf16* Vb = KV + (size_t)(b * 256) * 8192 + L * 2048 + 1024 + h * 256;
        for (int tq = 0; tq < 32; ++tq) {
            const size_t tok = (size_t)b * S + qc * 256 + wid * 32 + tq;
            const u32x2 qw = *((const u32x2*)(QX + tok * 1024 + h * 256) + lane);
            const float q0 = bflo(qw.x), q1 = bfhi(qw.x), q2 = bflo(qw.y), q3 = bfhi(qw.y);
            const float rstd = rsqrtf(wave_sum(q0 * q0 + q1 * q1 + q2 * q2 + q3 * q3) * (1.f / 256.f) + EPS);
            const f32x4 gg = *(const f32x4*)(qg + 4 * lane);
            *(LAS f32x4*)(qb + 4 * lane) = (f32x4){q0 * rstd * gg.x, q1 * rstd * gg.y, q2 * rstd * gg.z, q3 * rstd * gg.w};
            LDS_WAIT();
            float s0 = 0.f, s1 = 0.f, s2 = 0.f, s3 = 0.f;
#pragma unroll 4
            for (int dw = 0; dw < 128; ++dw) {
                const f32x2 qq = *(const LAS f32x2*)(qb + 2 * dw);
                const unsigned k0 = kl[lane * KSTR + dw], k1 = kl[(lane + 64) * KSTR + dw], k2 = kl[(lane + 128) * KSTR + dw], k3 = kl[(lane + 192) * KSTR + dw];
                s0 += qq.x * bflo(k0) + qq.y * bfhi(k0); s1 += qq.x * bflo(k1) + qq.y * bfhi(k1);
                s2 += qq.x * bflo(k2) + qq.y * bfhi(k2); s3 += qq.x * bflo(k3) + qq.y * bfhi(k3);
            }
            const float mx = wave_max(fmaxf(fmaxf(s0, s1), fmaxf(s2, s3)));
            const float e0 = __expf(s0 - mx), e1 = __expf(s1 - mx), e2 = __expf(s2 - mx), e3 = __expf(s3 - mx);
            const float inv = 1.f / wave_sum((e0 + e1) + (e2 + e3));
            pb[lane] = e0 * inv; pb[lane + 64] = e1 * inv; pb[lane + 128] = e2 * inv; pb[lane + 192] = e3 * inv;
            LDS_WAIT();
            float o0 = 0.f, o1 = 0.f, o2 = 0.f, o3 = 0.f;
#pragma unroll 8
            for (int m = 0; m < 256; ++m) {
                const float p = pb[m];
                const u32x2 vw = *((const u32x2*)(Vb + (size_t)m * 8192) + lane);
                o0 += p * bflo(vw.x); o1 += p * bfhi(vw.x); o2 += p * bflo(vw.y); o3 += p * bfhi(vw.y);
            }
            u32x2 ow; ow.x = pk2(o0, o1); ow.y = pk2(o2, o3);
            *((u32x2*)(OX + tok * 1024 + h * 256) + lane) = ow;
            LDS_WAIT();
        }
    }
    __syncthreads();
}


__device__ __forceinline__ int kperm32(int p) { const int fq = (p >> 3) & 3, j = p & 7; return (p & ~31) + 16 * (j >> 2) + 4 * fq + (j & 3); }
__device__ __forceinline__ void phase_vtrans(KArgs A, int wv_, LAS unsigned char* lds) {
    const int tid = opaque_tid(wv_);
    unsigned char* ws = opq(A->ws);
    const bf16* KV = (const bf16*)(ws + WS_KV); bf16* VT = (bf16*)(ws + WS_VT);
    LAS bf16* vt = (LAS bf16*)lds;
    constexpr int VS = 258;
    for (int it = blockIdx.x; it < DEPTH * NBATCH * 4; it += gridDim.x) {
        const int h = it & 3, b = (it >> 2) & 7, l = it >> 5;
        __syncthreads();
        for (int e = tid; e < 256 * 32; e += 512) { const int m = e >> 5, c8 = e & 31;
            const u32x4 w = *(const u32x4*)(KV + (size_t)(b * 256 + m) * 8192 + l * 2048 + 1024 + h * 256 + c8 * 8);
            LAS unsigned* d = (LAS unsigned*)(vt + m * VS + c8 * 8); d[0] = w.x; d[1] = w.y; d[2] = w.z; d[3] = w.w; }
        __syncthreads();
        for (int e = tid; e < 256 * 32; e += 512) { const int dv = e & 255, p8 = e >> 8;
            unsigned short x[8];
#pragma unroll
            for (int j = 0; j < 8; ++j) x[j] = vt[kperm32(p8 * 8 + j) * VS + dv];
            u32x4 o; o.x = x[0] | ((unsigned)x[1] << 16); o.y = x[2] | ((unsigned)x[3] << 16); o.z = x[4] | ((unsigned)x[5] << 16); o.w = x[6] | ((unsigned)x[7] << 16);
            *(u32x4*)(VT + ((size_t)it * 256 + dv) * 256 + p8 * 8) = o; }
    }
    __syncthreads();
}

__device__ __forceinline__ void xattn_item(KArgs A, int wv_, int L, LAS unsigned char* lds, const int b, const int h, const int qt) {
    const int tid = opaque_tid(wv_), wid = __builtin_amdgcn_readfirstlane(tid >> 6), lane = tid & 63, fr = lane & 15, fq = lane >> 4;
    unsigned char* ws = opq(A->ws);
    const bf16* QX = (const bf16*)(ws + WS_QX); const bf16* KV = (const bf16*)(ws + WS_KV); const bf16* VT = (const bf16*)(ws + WS_VT); bf16* OX = (bf16*)(ws + WS_OX);
    constexpr int RS = 264;
    LAS bf16* kl = (LAS bf16*)lds;
    const float* qg = A->in[I_XQN] + L * 256;
    {
        __syncthreads();
        {
            const int row = tid >> 1, hf = tid & 1;
            const u32x4* src = (const u32x4*)(KV + (size_t)(b * 256 + row) * 8192 + L * 2048 + h * 256 + hf * 128);
#pragma unroll
            for (int i0 = 0; i0 < 16; i0 += 8) {
                u32x4 w[8];
#pragma unroll
                for (int i = 0; i < 8; ++i) w[i] = src[i0 + i];
#pragma unroll
                for (int i = 0; i < 8; ++i) *(LAS u32x4*)(kl + row * RS + hf * 128 + (i0 + i) * 8) = w[i];
            }
        }
        const size_t tok0 = (size_t)b * S + qt * 256 + wid * 32 + fr;
        u32x4 qw0[8], qw1[8];
#pragma unroll
        for (int s = 0; s < 8; ++s) { qw0[s] = *(const u32x4*)(QX + tok0 * 1024 + h * 256 + 32 * s + 8 * fq); qw1[s] = *(const u32x4*)(QX + (tok0 + 16) * 1024 + h * 256 + 32 * s + 8 * fq); }
        __syncthreads();
        bf16x8 pf0[8], pf1[8]; float inv0, inv1;
        auto s_part = [&](const u32x4 (&qw)[8], bf16x8 (&pf)[8], float& inv) __attribute__((always_inline)) {
            float ssq = 0.f;
#pragma unroll
            for (int s = 0; s < 8; ++s) {
                const float a0 = bflo(qw[s].x), a1 = bfhi(qw[s].x), a2 = bflo(qw[s].y), a3 = bfhi(qw[s].y), a4 = bflo(qw[s].z), a5 = bfhi(qw[s].z), a6 = bflo(qw[s].w), a7 = bfhi(qw[s].w);
                ssq += (a0 * a0 + a1 * a1) + (a2 * a2 + a3 * a3) + (a4 * a4 + a5 * a5) + (a6 * a6 + a7 * a7);
            }
            ssq += __shfl_xor(ssq, 16); ssq += __shfl_xor(ssq, 32);
            const float rstd = rsqrtf(ssq * (1.f / 256.f) + EPS);
            bf16x8 qf[8];
#pragma unroll
            for (int s = 0; s < 8; ++s) qf[s] = __builtin_bit_cast(bf16x8, qw[s]);
            f32x4 sc[16];
#pragma unroll
            for (int hf = 0; hf < 2; ++hf) {
                unsigned kb = (unsigned)(size_t)(kl + (128 * hf + fr) * RS + 8 * fq); asm volatile("" : "+v"(kb));
#pragma unroll
                for (int t8 = 0; t8 < 8; ++t8) { const int t = 8 * hf + t8; sc[t] = (f32x4){0.f, 0.f, 0.f, 0.f};
#pragma unroll
                    for (int s = 0; s < 8; ++s) { const bf16x8 kf = *(const LAS bf16x8*)(size_t)(kb + (unsigned)((16 * t8 * RS + 32 * s) * 2));
                        sc[t] = __builtin_amdgcn_mfma_f32_16x16x32_bf16(kf, qf[s], sc[t], 0, 0, 0); }
                    if (t & 1) asm volatile("" ::: "memory"); }
            }
            float mx = -INFINITY;
#pragma unroll
            for (int t = 0; t < 16; ++t) mx = fmaxf(mx, fmaxf(fmaxf(sc[t].x, sc[t].y), fmaxf(sc[t].z, sc[t].w)));
            mx = fmaxf(mx, __shfl_xor(mx, 16)); mx = fmaxf(mx, __shfl_xor(mx, 32));
            float lsum = 0.f;
#pragma unroll
            for (int t = 0; t < 16; ++t) { sc[t].x = __expf((sc[t].x - mx) * rstd); sc[t].y = __expf((sc[t].y - mx) * rstd); sc[t].z = __expf((sc[t].z - mx) * rstd); sc[t].w = __expf((sc[t].w - mx) * rstd); lsum += (sc[t].x + sc[t].y) + (sc[t].z + sc[t].w); }
            lsum += __shfl_xor(lsum, 16); lsum += __shfl_xor(lsum, 32);
            inv = 1.f / lsum;
#pragma unroll
            for (int s = 0; s < 8; ++s) { u32x4 w; w.x = pk2(sc[2 * s].x, sc[2 * s].y); w.y = pk2(sc[2 * s].z, sc[2 * s].w); w.z = pk2(sc[2 * s + 1].x, sc[2 * s + 1].y); w.w = pk2(sc[2 * s + 1].z, sc[2 * s + 1].w);
                pf[s] = __builtin_bit_cast(bf16x8, w); }
        };
        s_part(qw0, pf0, inv0);
        s_part(qw1, pf1, inv1);
        __syncthreads();
        {
            const int row = tid >> 1, hf = tid & 1;
            const u32x4* src = (const u32x4*)(VT + ((size_t)((L * 8 + b) * 4 + h) * 256 + row) * 256 + hf * 128);
#pragma unroll
            for (int i0 = 0; i0 < 16; i0 += 8) {
                u32x4 w[8];
#pragma unroll
                for (int i = 0; i < 8; ++i) w[i] = src[i0 + i];
#pragma unroll
                for (int i = 0; i < 8; ++i) *(LAS u32x4*)(kl + row * RS + hf * 128 + (i0 + i) * 8) = w[i];
            }
        }
        __syncthreads();
#pragma unroll
        for (int hf = 0; hf < 2; ++hf) {
            unsigned vb = (unsigned)(size_t)(kl + (128 * hf + fr) * RS + 8 * fq); asm volatile("" : "+v"(vb));
#pragma unroll
            for (int n8 = 0; n8 < 8; ++n8) { const int n = 8 * hf + n8; f32x4 o0 = (f32x4){0.f, 0.f, 0.f, 0.f}, o1 = o0;
#pragma unroll
                for (int s = 0; s < 8; ++s) { const bf16x8 vf = *(const LAS bf16x8*)(size_t)(vb + (unsigned)((16 * n8 * RS + 32 * s) * 2));
                    o0 = __builtin_amdgcn_mfma_f32_16x16x32_bf16(vf, pf0[s], o0, 0, 0, 0);
                    o1 = __builtin_amdgcn_mfma_f32_16x16x32_bf16(vf, pf1[s], o1, 0, 0, 0); }
                u32x2 w0, w1; w0.x = pk2(o0.x * inv0, o0.y * inv0); w0.y = pk2(o0.z * inv0, o0.w * inv0); w1.x = pk2(o1.x * inv1, o1.y * inv1); w1.y = pk2(o1.z * inv1, o1.w * inv1);
                *(u32x2*)(OX + tok0 * 1024 + h * 256 + 16 * n + 4 * fq) = w0;
                *(u32x2*)(OX + (tok0 + 16) * 1024 + h * 256 + 16 * n + 4 * fq) = w1;
                if (n & 1) asm volatile("" ::: "memory"); }
        }
    }
    __syncthreads();
}

__device__ __forceinline__ void phase_route(KArgs A, int wv_, int L, LAS unsigned char* lds) {
    const int tid_ = opaque_tid(wv_); const int wid = __builtin_amdgcn_readfirstlane(tid_ >> 6), lane = tid_ & 63;
    unsigned char* ws = opq(A->ws);
    const float* RW = (const float*)(ws + WS_RW) + (size_t)L * NEXP * D;
    unsigned* cnt = (unsigned*)(ws + WS_CTL) + CW_CNT + L * 64;
    int* list = (int*)(ws + WS_LIST); int* te = (int*)(ws + WS_TOK); int* tp = te + 2 * T; float* tw = (float*)(tp + 2 * T);
    bf16* XN = (bf16*)(ws + WS_XN);
    LAS float* rwl = (LAS float*)lds;
    LAS unsigned* lcnt = (LAS unsigned*)(lds + 65536);
    LAS unsigned* lbase = lcnt + 16;
    const float rbv = A->in[I_RB][lane >> 2];
    for (int e4 = tid_; e4 < NEXP * D / 4; e4 += 512) *(LAS f32x4*)(rwl + 4 * e4) = *(const f32x4*)(RW + 4 * e4);
    for (int blk = blockIdx.x; blk < T / 64; blk += gridDim.x) {
        __syncthreads();
        if (tid_ < 16) lcnt[tid_] = 0u;
        __syncthreads();
        int e0s = 0, e1s = 0, r0s = 0, r1s = 0; float w0s = 0.f;
        f32x4 v[4], vn[4];
#pragma unroll
        for (int j = 0; j < 4; ++j) v[j] = ((const f32x4*)(A->out + (size_t)(blk * 64 + wid * 8) * D) + lane)[64 * j];
#pragma unroll 1
        for (int q = 0; q < 8; ++q) {
            const int t = blk * 64 + wid * 8 + q;
            { const f32x4* xn_ = (const f32x4*)(A->out + (size_t)(t + (q < 7 ? 1 : 0)) * D) + lane;
#pragma unroll
              for (int j = 0; j < 4; ++j) vn[j] = xn_[64 * j]; }
            float s = 0.f;
#pragma unroll
            for (int j = 0; j < 4; ++j) s += (v[j].x * v[j].x + v[j].y * v[j].y) + (v[j].z * v[j].z + v[j].w * v[j].w);
            const float rstd = rsqrtf(wave_sum(s) * (1.f / 1024.f) + EPS);
            u32x2* o8 = (u32x2*)(XN + (size_t)t * D) + lane;
#pragma unroll
            for (int j = 0; j < 4; ++j) { u32x2 w; w.x = pk2(v[j].x * rstd, v[j].y * rstd); w.y = pk2(v[j].z * rstd, v[j].w * rstd); o8[64 * j] = w; }
            float a[16];
#pragma unroll
            for (int e = 0; e < 16; ++e) {
                const LAS f32x4* wr = (const LAS f32x4*)(rwl + e * D) + lane; float acc = 0.f;
#pragma unroll
                for (int j = 0; j < 4; ++j) { const f32x4 w = wr[64 * j]; acc += (v[j].x * w.x + v[j].y * w.y) + (v[j].z * w.z + v[j].w * w.w); }
                a[e] = acc;
            }
            float a8[8], a4[4], a2[2], a1;
            { const bool up = lane & 32;
#pragma unroll
              for (int k = 0; k < 8; ++k) { const float send = up ? a[k] : a[k + 8], keep = up ? a[k + 8] : a[k]; a8[k] = keep + __shfl_xor(send, 32); } }
            { const bool up = lane & 16;
#pragma unroll
              for (int k = 0; k < 4; ++k) { const float send = up ? a8[k] : a8[k + 4], keep = up ? a8[k + 4] : a8[k]; a4[k] = keep + __shfl_xor(send, 16); } }
            { const bool up = lane & 8;
#pragma unroll
              for (int k = 0; k < 2; ++k) { const float send = up ? a4[k] : a4[k + 2], keep = up ? a4[k + 2] : a4[k]; a2[k] = keep + __shfl_xor(send, 8); } }
            { const bool up = lane & 4; const float send = up ? a2[0] : a2[1], keep = up ? a2[1] : a2[0]; a1 = keep + __shfl_xor(send, 4); }
            a1 += __shfl_xor(a1, 2); a1 += __shfl_xor(a1, 1);
            const float lg = a1 * rstd + rbv;
            const float v0 = wave_max(lg);
            const int e0 = (__ffsll((unsigned long long)__ballot(lg == v0)) - 1) >> 2;
            const int gidx = e0 >> 2;
            const bool c2 = (lane >> 4) == gidx && (lane >> 2) != e0;
            const float m2 = c2 ? lg : -INFINITY;
            const float v1 = wave_max(m2);
            const int e1 = (__ffsll((unsigned long long)__ballot(c2 && m2 == v1)) - 1) >> 2;
            const float w0 = 1.f / (1.f + __expf(v1 - v0));
            unsigned r0 = 0, r1 = 0;
            if (lane == 0) { r0 = atomicAdd((unsigned*)(lcnt + e0), 1u); r1 = atomicAdd((unsigned*)(lcnt + e1), 1u); }
            r0 = __builtin_amdgcn_readfirstlane(r0); r1 = __builtin_amdgcn_readfirstlane(r1);
            if (lane == q) { e0s = e0; e1s = e1; r0s = (int)r0; r1s = (int)r1; w0s = w0; }
#pragma unroll
            for (int j = 0; j < 4; ++j) v[j] = vn[j];
        }
        __syncthreads();
        if (tid_ < 16) lbase[tid_] = atomicAdd(&cnt[tid_], lcnt[tid_]);
        __syncthreads();
        if (lane < 8) {
            const int t = blk * 64 + wid * 8 + lane;
            const int p0 = (int)lbase[e0s] + r0s, p1 = (int)lbase[e1s] + r1s;
            list[e0s * T + p0] = t; list[e1s * T + p1] = t;
            te[2 * t] = e0s; te[2 * t + 1] = e1s; tp[2 * t] = p0; tp[2 * t + 1] = p1; tw[2 * t] = w0s; tw[2 * t + 1] = 1.f - w0s;
        }
    }
    __syncthreads();
}
__device__ __forceinline__ void moe_offsets(KArgs A, int wv_, int L, LAS int* off, LAS int* cn) {
    if (opaque_tid(wv_) == 0) {
        const unsigned* cnt = (const unsigned*)(opq(A->ws) + WS_CTL) + CW_CNT + L * 64;
        int o = 0;
        for (int e = 0; e < 16; ++e) { const int c = (int)__hip_atomic_load(cnt + e, __ATOMIC_RELAXED, __HIP_MEMORY_SCOPE_AGENT); off[e] = o; cn[e] = c; o += (c + 255) & ~255; }
        off[16] = o;
    }
    __syncthreads();
}
__device__ __forceinline__ void phase_moe_combine(KArgs A, int wv_, int L, LAS unsigned char* lds) {
    LAS int* off = (LAS int*)lds; LAS int* cn = off + 32;
    moe_offsets(A, wv_, L, off, cn);
    const int tid_ = opaque_tid(wv_); const int wid = __builtin_amdgcn_readfirstlane(tid_ >> 6), lane = tid_ & 63; const int gw = blockIdx.x * 8 + wid, NGW = gridDim.x * 8;
    unsigned char* ws = opq(A->ws);
    const int* te = (const int*)(ws + WS_TOK); const int* tp = te + 2 * T; const float* tw = (const float*)(tp + 2 * T);
    const bf16* Y = (const bf16*)(ws + WS_Y); bf16* XN = (bf16*)(ws + WS_XN);
    const int nq = (T - gw + NGW - 1) / NGW;
    for (int q0 = 0; q0 < nq; q0 += 8) {
        int s0m = 0, s1m = 0; float w0m = 0.f, w1m = 0.f;
        { const int qq = q0 + (lane & 7); const int t = gw + NGW * (qq < nq ? qq : nq - 1);
          s0m = off[te[2 * t]] + tp[2 * t]; s1m = off[te[2 * t + 1]] + tp[2 * t + 1]; w0m = tw[2 * t]; w1m = tw[2 * t + 1]; }
        const int nn = nq - q0 < 8 ? nq - q0 : 8;
        f32x4 v[4], vn[4]; u32x2 ya[4], yb[4], yan[4], ybn[4];
        { const int t = gw + NGW * q0; const int sl0 = __builtin_amdgcn_readlane(s0m, 0), sl1 = __builtin_amdgcn_readlane(s1m, 0);
#pragma unroll
          for (int j = 0; j < 4; ++j) { v[j] = ((const f32x4*)(A->out + (size_t)t * D) + lane)[64 * j]; ya[j] = ((const u32x2*)(Y + (size_t)sl0 * D) + lane)[64 * j]; yb[j] = ((const u32x2*)(Y + (size_t)sl1 * D) + lane)[64 * j]; } }
#pragma unroll 1
        for (int q = 0; q < nn; ++q) {
            const int t = gw + NGW * (q0 + q);
            const int qn = q + 1 < nn ? q + 1 : q;
            { const int tn = gw + NGW * (q0 + qn); const int sl0 = __builtin_amdgcn_readlane(s0m, qn), sl1 = __builtin_amdgcn_readlane(s1m, qn);
#pragma unroll
              for (int j = 0; j < 4; ++j) { vn[j] = ((const f32x4*)(A->out + (size_t)tn * D) + lane)[64 * j]; yan[j] = ((const u32x2*)(Y + (size_t)sl0 * D) + lane)[64 * j]; ybn[j] = ((const u32x2*)(Y + (size_t)sl1 * D) + lane)[64 * j]; } }
            const float w0 = __builtin_bit_cast(float, __builtin_amdgcn_readlane(__builtin_bit_cast(int, w0m), q)), w1 = __builtin_bit_cast(float, __builtin_amdgcn_readlane(__builtin_bit_cast(int, w1m), q));
            float s = 0.f;
#pragma unroll
            for (int j = 0; j < 4; ++j) {
                v[j].x += w0 * bflo(ya[j].x) + w1 * bflo(yb[j].x); v[j].y += w0 * bfhi(ya[j].x) + w1 * bfhi(yb[j].x); v[j].z += w0 * bflo(ya[j].y) + w1 * bflo(yb[j].y); v[j].w += w0 * bfhi(ya[j].y) + w1 * bfhi(yb[j].y);
                s += (v[j].x * v[j].x + v[j].y * v[j].y) + (v[j].z * v[j].z + v[j].w * v[j].w);
            }
            const float rstd = rsqrtf(wave_sum(s) * (1.f / 1024.f) + EPS);
            f32x4* xr = (f32x4*)(A->out + (size_t)t * D) + lane; u32x2* o8 = (u32x2*)(XN + (size_t)t * D) + lane;
#pragma unroll
            for (int j = 0; j < 4; ++j) { xr[64 * j] = v[j]; u32x2 w; w.x = pk2(v[j].x * rstd, v[j].y * rstd); w.y = pk2(v[j].z * rstd, v[j].w * rstd); o8[64 * j] = w; }
#pragma unroll
            for (int j = 0; j < 4; ++j) { v[j] = vn[j]; ya[j] = yan[j]; yb[j] = ybn[j]; }
        }
    }
}

constexpr int PH_PER_EVEN = 5 + 6, PH_PER_ODD = 3 + 6;
constexpr int NPHASES = 1 + 2 * (PH_PER_EVEN + PH_PER_ODD);

__global__ void __launch_bounds__(512, 2) mk_fwd(Args Araw) {
    KArgs A0 = kargs();
    extern __shared__ __attribute__((aligned(16))) unsigned char lds_raw[];
    LAS unsigned char* lds = (LAS unsigned char*)lds_raw;
    volatile LAS unsigned* misc = (volatile LAS unsigned*)(lds + LDS_MISC);
    const int tid = threadIdx.x;
    if (tid < 16) misc[tid] = 0u;
    __syncthreads();
    const int lo = A0->ph_lo, hi = A0->ph_hi;
    const int wv_ = __builtin_amdgcn_readfirstlane(threadIdx.x >> 6);
    if (hi - lo > 1) (void)xcd_barrier_post((unsigned*)(A0->ws + WS_CTL) + CW_BAR, misc);
    int ph = 0;
    unsigned long long tacc_ = 0;
#define PH_BEGIN(k) if (ph >= lo && ph < hi) { const bool tprobe_ = (PROBE_TMASK >> (k)) & 1; unsigned long long tp0_ = 0; if (PROBE_TMASK && tprobe_) tp0_ = __builtin_amdgcn_s_memrealtime(); KArgs A = kargs(); unsigned char* ws = opq(A->ws); _Pragma("unroll 1") for (int rep_ = 0; rep_ < (((PROBE_MASK >> (k)) & 1) ? PROBE_REPS : 1); ++rep_)
#define PH_END   if (ph + 1 < hi) { XcdBarrier b_; b_.bar = (unsigned*)(opq(kargs()->ws) + WS_CTL) + CW_BAR; b_.x = xb_xcc_id(); b_.st = misc; xcd_barrier(b_, opaque_tid(wv_) == 0); } if (PROBE_TMASK && tprobe_) tacc_ += __builtin_amdgcn_s_memrealtime() - tp0_; } ++ph;
    const int G = gridDim.x, cb = blockIdx.x;

    PH_BEGIN(0) phase_prologue(A, wv_, lds); PH_END
    for (int L = 0; L < DEPTH; ++L) {
        const int i = L >> 1;
        if ((L & 1) == 0) {
            PH_BEGIN(3) {
                if (L == 0) {
                    pg8::DenseOrder S; S.init(NBATCH * NMEM, 8192, D, (const bf16*)(ws + WS_WKV), G, cb);
                    pg8::EpiBf16<0> E{(bf16*)(ws + WS_KV), 8192, 32, 0};
                    pg8::gemm_phase(lds, (const bf16*)(ws + WS_MN), D, S, E, wv_);
                }
                pg8::DenseOrder S; S.init(T, HYN, D, (const bf16*)(ws + WS_WHYB) + (size_t)i * HYN * D, G, cb);
                pg8::EpiBf16<0> E{(bf16*)(ws + WS_BIG), HYN, 12, 0};
                pg8::gemm_phase(lds, (const bf16*)(ws + WS_XN), D, S, E, wv_);
            } PH_END
            PH_BEGIN(4) { const int t4_ = opaque_tid(wv_); SUBT_BEGIN(4); if (L == 0) { phase_knorm(A, wv_); phase_vtrans(A, wv_, lds); } SUBT_END(4, ws, t4_); SUBT_BEGIN(5); phase_compress_mfma(A, wv_, i, lds); SUBT_END(5, ws, t4_); SUBT_BEGIN(6); phase_nsa_prep(A, wv_, i, lds); SUBT_END(6, ws, t4_); SUBT_BEGIN(7); phase_vtiles(A, wv_, lds); SUBT_END(7, ws, t4_); } PH_END
            PH_BEGIN(5) { phase_gla_a(A, wv_, i, lds); __syncthreads(); phase_nsa_attn_mfma(A, wv_, i, lds); } PH_END
            PH_BEGIN(6) phase_gla_c(A, wv_, i, lds); PH_END
            PH_BEGIN(7) {
                pg8::DenseOrder S; S.init(T, D, D, (const bf16*)(ws + WS_WHOUT) + (size_t)i * D * D, G, cb);
                pg8::EpiResAddNorm E{A->out, D, (bf16*)(ws + WS_XN), (float*)(ws + WS_ROWSQ)};
                pg8::gemm_phase(lds, (const bf16*)(ws + WS_CAT), D, S, E, wv_);
            } PH_END
        } else {
            PH_BEGIN(8) {
                pg8::DenseOrder S; S.init(T, 4096, D, (const bf16*)(ws + WS_WSGIN) + (size_t)i * 4096 * D, G, cb);
                pg8::EpiBf16<1> E{(bf16*)(ws + WS_U), 2048, 8, (size_t)(WS_V - WS_U) / 2};
                pg8::gemm_phase(lds, (const bf16*)(ws + WS_XN), D, S, E, wv_);
            } PH_END
            PH_BEGIN(9) phase_sgu_mix_mfma(A, wv_, i, lds); PH_END
            PH_BEGIN(10) {
                pg8::DenseOrder S; S.init(T, D, 2048, (const bf16*)(ws + WS_WSGOUT) + (size_t)i * D * 2048, G, cb);
                pg8::EpiResAddNorm E{A->out, D, (bf16*)(ws + WS_XN), (float*)(ws + WS_ROWSQ)};
                pg8::gemm_phase(lds, (const bf16*)(ws + WS_UM), 2048, S, E, wv_);
            } PH_END
        }
        PH_BEGIN(12) {
            pg8::DenseOrder S; S.init(T, D, D, (const bf16*)(ws + WS_WQ) + (size_t)L * D * D, G, cb);
            pg8::EpiBf16RowScale E{(bf16*)(ws + WS_QX), D, (const float*)(ws + WS_ROWSQ)};
            pg8::gemm_phase(lds, (const bf16*)(ws + WS_XN), D, S, E, wv_);
            asm volatile("s_waitcnt vmcnt(0)" ::: "memory");
            __syncthreads();
            pg8::Unit u_;
#pragma unroll 1
            for (int ui_ = 0; S.next(ui_, u_); ++ui_) xattn_item(A, wv_, L, lds, u_.pm >> 3, u_.pn, u_.pm & 7);
        } PH_END
        PH_BEGIN(14) {
            pg8::DenseOrder S; S.init(T, D, D, (const bf16*)(ws + WS_WO) + (size_t)L * D * D, G, cb);
            pg8::EpiResAdd E{A->out, D};
            pg8::gemm_phase(lds, (const bf16*)(ws + WS_OX), D, S, E, wv_);
        } PH_END
        PH_BEGIN(15) phase_route(A, wv_, L, lds); PH_END
        PH_BEGIN(16) {
            LAS int* off = (LAS int*)(lds + pg8::STAGE_BYTES); LAS int* cn = off + 32;
            moe_offsets(A, wv_, L, off, cn);
            pg8::MoeOrder<true> S{(off[16] / 256) * 3, 3, G, cb, D, off, cn, (const int*)(ws + WS_LIST), (const char*)(ws + WS_WMIN) + (size_t)L * 16 * 768 * D * 2, (size_t)768 * D * 2};
            pg8::EpiSwiglu E{(bf16*)(ws + WS_H), DEXP};
            pg8::gemm_phase(lds, (const bf16*)(ws + WS_XN), D, S, E, wv_);
        } PH_END
        PH_BEGIN(17) {
            LAS int* off = (LAS int*)(lds + pg8::STAGE_BYTES); LAS int* cn = off + 32;
            moe_offsets(A, wv_, L, off, cn);
            pg8::MoeOrder<false> S{(off[16] / 256) * 4, 4, G, cb, DEXP, off, cn, (const int*)(ws + WS_LIST), (const char*)(ws + WS_WMOUT) + (size_t)L * 16 * D * DEXP * 2, (size_t)D * DEXP * 2};
            pg8::EpiBf16<0> E{(bf16*)(ws + WS_Y), D, 4, 0};
            pg8::gemm_phase(lds, (const bf16*)(ws + WS_H), DEXP, S, E, wv_);
        } PH_END
        PH_BEGIN(18) phase_moe_combine(A, wv_, L, lds); PH_END
    }
#undef PH_BEGIN
#undef PH_END
    if (hi - lo > 1) { for (int q_ = 0; q_ < PROBE_XBAR; ++q_) { XcdBarrier b_; b_.bar = (unsigned*)(opq(kargs()->ws) + WS_CTL) + CW_BAR; b_.x = xb_xcc_id(); b_.st = misc; xcd_barrier(b_, opaque_tid(wv_) == 0); } }
    if ((PROBE_NSA || PROBE_SUB) && blockIdx.x == 0) { const unsigned long long d_ = __hip_atomic_load((unsigned long long*)(A0->ws + WS_CTL + 48000), __ATOMIC_RELAXED, __HIP_MEMORY_SCOPE_AGENT); const unsigned long long t0 = __builtin_amdgcn_s_memrealtime(); while (__builtin_amdgcn_s_memrealtime() - t0 < d_) __builtin_amdgcn_s_sleep(8); }
    if (PROBE_TMASK && blockIdx.x == 0) { const unsigned long long t0 = __builtin_amdgcn_s_memrealtime(); while (__builtin_amdgcn_s_memrealtime() - t0 < tacc_) __builtin_amdgcn_s_sleep(8); }
}

extern "C" void kernel_launch(void* const* d_in, const int* in_sizes, int n_in, void* d_out, int out_size, void* d_ws, size_t ws_size, hipStream_t stream) {
    static int grid = 0;
    if (grid == 0) {
        if (n_in != N_IN || out_size != T * D || ws_size < WS_END) { fprintf(stderr, "kernel_launch: unexpected problem (n_in %d, out %d, ws %zu)\n", n_in, out_size, ws_size); grid = -1; return; }
        int dev = 0, cus = 0, per_cu = 0;
        if (hipGetDevice(&dev) != hipSuccess || hipDeviceGetAttribute(&cus, hipDeviceAttributeMultiprocessorCount, dev) != hipSuccess) { grid = -1; return; }
        if (hipFuncSetAttribute((const void*)mk_fwd, hipFuncAttributeMaxDynamicSharedMemorySize, LDS_BYTES) != hipSuccess) { fprintf(stderr, "kernel_launch: hipFuncSetAttribute failed\n"); grid = -1; return; }
        if (hipOccupancyMaxActiveBlocksPerMultiprocessor(&per_cu, (const void*)mk_fwd, 512, LDS_BYTES) != hipSuccess || per_cu < 1) fprintf(stderr, "kernel_launch: occupancy query says %d\n", per_cu);
        (void)hipGetLastError();
        grid = cus;
    }
    if (grid < 0) return;
    (void)hipMemsetAsync((char*)d_ws + WS_CTL, 0, CTL_BYTES, stream);
    Args a{};
    for (int i = 0; i < N_IN; ++i) a.in[i] = (const float*)d_in[i];
    a.out = (float*)d_out; a.ws = (unsigned char*)d_ws;
    for (int j = 0; j < 32; ++j) a.freq[j] = (float)pow(10000.0, -(double)j / 32.0);
#if MK_ONE_LAUNCH
    a.ph_lo = 0; a.ph_hi = NPHASES;
    hipLaunchKernelGGL(mk_fwd, dim3(grid), dim3(512), LDS_BYTES, stream, a);
#else
    for (int p = 0; p < NPHASES; ++p) { a.ph_lo = p; a.ph_hi = p + 1; hipLaunchKernelGGL(mk_fwd, dim3(grid), dim3(512), LDS_BYTES, stream, a); }
#endif
}
```

```cpp
#include <hip/hip_runtime.h>
#include <stdint.h>
#include <stdio.h>
#include <math.h>

#ifndef PROBE_MASK
#define PROBE_MASK 0
#endif
#ifndef PROBE_TMASK
#define PROBE_TMASK 0
#endif
#ifndef PROBE_NSA
#define PROBE_NSA 0
#endif
#ifndef PROBE_SUB
#define PROBE_SUB 0
#endif
#ifndef PROBE_XBAR
#define PROBE_XBAR 0
#endif
#ifndef PROBE_REPS
#define PROBE_REPS 2
#endif
#ifndef MK_ONE_LAUNCH
#define MK_ONE_LAUNCH 1
#endif

#define LAS __attribute__((address_space(3)))
typedef unsigned short bf16;
typedef short bf16x8 __attribute__((ext_vector_type(8)));
typedef float f32x4 __attribute__((ext_vector_type(4)));
typedef float f32x2 __attribute__((ext_vector_type(2)));
typedef unsigned u32x4 __attribute__((ext_vector_type(4)));
typedef unsigned u32x2 __attribute__((ext_vector_type(2)));

constexpr int T = 16384, D = 1024, NBATCH = 8, S = 2048, DEPTH = 4;
constexpr int NMEM = 256;
constexpr float EPS = 1e-6f;
constexpr int HYN = 3072, HYSRC = 2856;
constexpr int C_QA = 0, C_KC = 512, C_VC = 640, C_KS = 768, C_VS = 896, C_KW = 1024, C_VW = 1152, C_QB = 1280, C_KB = 1536, C_VB = 1792, C_RB = 2304, C_GA = 2816, C_AL = 2840;
constexpr int NCMP = 127;
constexpr int NEXP = 16, DEXP = 384;
constexpr int SLOTS = 2 * T + NEXP * 256;

enum { I_X = 0, I_MEM, I_POS, I_NMIX, I_NXAT, I_NMEM, I_NFFN, I_HYBIN, I_HYBOUT, I_QNORM, I_KNORM, I_CMPPE, I_CMPW1, I_CMPW2, I_GATEB, I_WA2, I_BA, I_ONORM,
       I_SGIN, I_LNG, I_LNB, I_SGWS, I_SGBS, I_SGOUT, I_XWQ, I_XWKV, I_XWO, I_XQN, I_XKN, I_RW, I_RB, I_MOEIN, I_MOEOUT, N_IN };

constexpr size_t MiB = 1u << 20;
constexpr size_t WS_CTL = 0, CTL_BYTES = 1 * MiB;
constexpr size_t WS_WHYB = 1 * MiB;
constexpr size_t WS_WHOUT = WS_WHYB + 12 * MiB;
constexpr size_t WS_WSGIN = WS_WHOUT + 4 * MiB;
constexpr size_t WS_WSGOUT = WS_WSGIN + 16 * MiB;
constexpr size_t WS_WQ = WS_WSGOUT + 8 * MiB;
constexpr size_t WS_WKV = WS_WQ + 8 * MiB;
constexpr size_t WS_WO = WS_WKV + 16 * MiB;
constexpr size_t WS_WMIN = WS_WO + 8 * MiB;
constexpr size_t WS_WMOUT = WS_WMIN + 96 * MiB;
constexpr size_t WS_RW = WS_WMOUT + 48 * MiB;
constexpr size_t WS_XN = WS_RW + 1 * MiB;
constexpr size_t WS_BIG = WS_XN + 32 * MiB;
constexpr size_t WS_QA = WS_BIG + 128 * MiB;
constexpr size_t WS_KS = WS_QA + 16 * MiB;
constexpr size_t WS_KW = WS_KS + 4 * MiB;
constexpr size_t WS_KC = WS_KW + 4 * MiB;
constexpr size_t WS_VC = WS_KC + 1 * MiB;
constexpr size_t WS_CAT = WS_VC + 1 * MiB;
constexpr size_t WS_QX = WS_CAT + 32 * MiB;
constexpr size_t WS_OX = WS_QX + 32 * MiB;
constexpr size_t WS_MN = WS_OX + 32 * MiB;
constexpr size_t WS_KV = WS_MN + 4 * MiB;
constexpr size_t WS_COS = WS_KV + 32 * MiB;
constexpr size_t WS_SIN = WS_COS + 2 * MiB;
constexpr size_t WS_LIST = WS_SIN + 2 * MiB;
constexpr size_t WS_TOK = WS_LIST + 1 * MiB;
constexpr size_t WS_VT = WS_TOK + 1 * MiB;
constexpr size_t WS_VTA = WS_VT + 16 * MiB;
constexpr size_t WS_SLOC = WS_VTA + 32 * MiB;
constexpr size_t WS_DEC = WS_SLOC + 32 * MiB;
constexpr size_t WS_STT = WS_DEC + 1 * MiB;
constexpr size_t WS_WSB = WS_STT + 16 * MiB;
constexpr size_t WS_M0 = WS_WSB + 768 * 1024;
constexpr size_t WS_W1T = WS_WSB + 1 * MiB;
constexpr size_t WS_ROWSQ = WS_W1T + 1 * MiB;
constexpr size_t WS_END = WS_ROWSQ + 1 * MiB;
constexpr size_t WS_Y = WS_BIG, WS_H = WS_BIG + 72 * MiB, WS_U = WS_BIG, WS_V = WS_BIG + 64 * MiB, WS_UM = WS_QX;
constexpr int CW_BAR = 4096;
constexpr int CW_CNT = 8192;

constexpr int LDS_BYTES = 159744;
constexpr int LDS_MISC = LDS_BYTES - 64;

typedef __bf16 bf16x2_t __attribute__((ext_vector_type(2)));
__device__ __forceinline__ unsigned pk2(float lo, float hi) { const f32x2 v = {lo, hi}; return __builtin_bit_cast(unsigned, __builtin_convertvector(v, bf16x2_t)); }
__device__ __forceinline__ unsigned f2bf(float f) { return (unsigned)__builtin_bit_cast(unsigned short, (__bf16)f); }
__device__ __forceinline__ float bf2f(unsigned b) { return __uint_as_float(b << 16); }
__device__ __forceinline__ float bflo(unsigned w) { return __uint_as_float(w << 16); }
__device__ __forceinline__ float bfhi(unsigned w) { return __uint_as_float(w & 0xffff0000u); }
__device__ __forceinline__ float wave_sum(float v) {
#pragma unroll
    for (int o = 1; o < 64; o <<= 1) v += __shfl_xor(v, o);
    return v;
}
__device__ __forceinline__ float wave_max(float v) {
#pragma unroll
    for (int o = 1; o < 64; o <<= 1) v = fmaxf(v, __shfl_xor(v, o));
    return v;
}
__device__ __forceinline__ int opaque_tid(int wv) { int l; asm volatile("v_mbcnt_lo_u32_b32 %0, -1, 0\n\tv_mbcnt_hi_u32_b32 %0, -1, %0" : "=v"(l)); return wv * 64 + l; }
__device__ __forceinline__ unsigned char* opq(unsigned char* p) { asm volatile("" : "+s"(p)); return p; }
#define LDS_WAIT() asm volatile("s_waitcnt lgkmcnt(0)" ::: "memory")
__device__ __forceinline__ float gelu_tanh(float x) {
    const float u2 = x * (1.5957691216057308f + 0.07135481283f * x * x);
    return x * __builtin_amdgcn_rcpf(1.0f + __expf(-u2));
}
__device__ __forceinline__ float sigmoidf_(float x) { return 1.0f / (1.0f + __expf(-x)); }

#define SUBT_BEGIN(id) unsigned long long subt_##id = 0; if (PROBE_SUB == (id)) subt_##id = __builtin_amdgcn_s_memrealtime();
#define SUBT_END(id, wsp, tidv) do { if (PROBE_SUB == (id) && blockIdx.x == 0 && (tidv) == 0) atomicAdd((unsigned long long*)((wsp) + WS_CTL + 48000), __builtin_amdgcn_s_memrealtime() - subt_##id); } while (0)
#define XB_TMO      128
#define XB_XCNT(j)  (256  + 64 * (j))
#define XB_XSUB(j)  (1280 + 64 * (j))
#define XB_XGEN(j)  (2304 + 64 * (j))
#define XB_TOP      3328
#define XB_TOPGEN   3392
#define XCD_BAR_WORDS 3456
#define XB_SPIN_CAP (1u << 22)

__device__ __forceinline__ unsigned xb_ld(unsigned* p)              { return __hip_atomic_load(p, __ATOMIC_RELAXED, __HIP_MEMORY_SCOPE_AGENT); }
__device__ __forceinline__ unsigned xb_add(unsigned* p, unsigned v) { return __hip_atomic_fetch_add(p, v, __ATOMIC_RELAXED, __HIP_MEMORY_SCOPE_AGENT); }
__device__ __forceinline__ unsigned xb_xcc_id() { return (unsigned)__builtin_amdgcn_s_getreg((3 << 11) | 20) & 0xFu; }
#define XB_SPIN(cond, bar) do { unsigned _sp = 0; while (cond) { __builtin_amdgcn_s_sleep(1); \
    if ((++_sp & 255u) == 0u) { if (xb_ld(&(bar)[XB_TMO])) break; if (_sp > XB_SPIN_CAP) { atomicAdd(&(bar)[XB_TMO], 1u); break; } } } } while (0)

struct XcdBarrier { unsigned* bar; unsigned x; volatile LAS unsigned* st; };
__device__ __forceinline__ unsigned* xb_opaque(unsigned* p) { unsigned long long v = (unsigned long long)p; unsigned lo = __builtin_amdgcn_readfirstlane((unsigned)v), hi = __builtin_amdgcn_readfirstlane((unsigned)(v >> 32));
    asm volatile("" : "+s"(lo), "+s"(hi)); return (unsigned*)(((unsigned long long)hi << 32) | lo); }

__device__ __forceinline__ XcdBarrier xcd_barrier_post(unsigned* bar, volatile LAS unsigned* st) {
    XcdBarrier b; b.bar = bar; b.x = xb_xcc_id(); b.st = st;
    if (threadIdx.x == 0) (void)xb_add(&bar[XB_XCNT(b.x)], 1u);
    return b;
}
__device__ __forceinline__ void xcd_barrier_complete(unsigned* bar, unsigned x, unsigned& nloc, unsigned& nx) {
    const unsigned G = gridDim.x * gridDim.y * gridDim.z;
    unsigned sum, cnt, mine, sp = 0u;
    for (;;) {
        sum = 0u; cnt = 0u; mine = 0u;
#pragma unroll
        for (unsigned j = 0; j < 16; ++j) { const unsigned c = xb_ld(&bar[XB_XCNT(j)]); sum += c; cnt += (c > 0u) ? 1u : 0u; mine = (j == x) ? c : mine; }
        if (sum == G) break;
        __builtin_amdgcn_s_sleep(1);
        if ((++sp & 255u) == 0u) { if (xb_ld(&bar[XB_TMO])) break; if (sp > XB_SPIN_CAP) { atomicAdd(&bar[XB_TMO], 1u); break; } }
    }
    nloc = mine > 0u ? mine : 1u; nx = cnt > 0u ? cnt : 1u;
}
__device__ __forceinline__ void xcd_barrier(const XcdBarrier& b, const bool is_t0) {
    asm volatile("s_waitcnt vmcnt(0)" ::: "memory");
    __syncthreads();
    if (is_t0) {
        unsigned* bar = b.bar;
        __builtin_amdgcn_s_waitcnt(0);
        unsigned nloc = b.st[0], nx = b.st[1];
        if (nloc == 0u) { xcd_barrier_complete(bar, b.x, nloc, nx); b.st[0] = nloc; b.st[1] = nx; }
        const unsigned old = xb_add(&bar[XB_XSUB(b.x)], 1u);
        const unsigned gen = old / nloc;
        if (old + 1u == (gen + 1u) * nloc) {
            __builtin_amdgcn_fence(__ATOMIC_RELEASE, "agent");
            asm volatile("s_waitcnt vmcnt(0)" ::: "memory");
            const unsigned og = xb_add(&bar[XB_TOP], 1u);
            const unsigned tg = og / nx;
            if (og + 1u == (tg + 1u) * nx) xb_add(&bar[XB_TOPGEN], 1u);
            else XB_SPIN(xb_ld(&bar[XB_TOPGEN]) == tg, bar);
            __builtin_amdgcn_fence(__ATOMIC_ACQUIRE, "agent");
            xb_add(&bar[XB_XGEN(b.x)], 1u);
            asm volatile("s_waitcnt vmcnt(0)" ::: "memory");
        } else {
            XB_SPIN(xb_ld(&bar[XB_XGEN(b.x)]) == gen, bar);
            __builtin_amdgcn_fence(__ATOMIC_ACQUIRE, "agent");
            asm volatile("s_waitcnt vmcnt(0)" ::: "memory");
        }
    }
    __syncthreads();
}

struct Args {
    const float* in[N_IN];
    float* out;
    unsigned char* ws;
    float freq[32];
    int ph_lo, ph_hi;
};

typedef const __attribute__((address_space(4))) Args* KArgs;
__device__ __forceinline__ KArgs kargs() { KArgs p = (KArgs)__builtin_amdgcn_kernarg_segment_ptr(); asm volatile("" : "+s"(p)); return p; }

__device__ __forceinline__ void st_bf16x4(bf16* p, f32x4 v) { u32x2 w; w.x = pk2(v[0], v[1]); w.y = pk2(v[2], v[3]); *(u32x2*)p = w; }


namespace pg8 {
constexpr int BM = 256, BK = 64, HALF = 128, HTB = HALF * BK * 2, STAGE_BYTES = 8 * HTB, NXCD = 8, WGM = 8;
__host__ __device__ __forceinline__ int lds_byte(int r, int c) { const int st = (r >> 4) * 2 + (c >> 5), rr = r & 15, cc = c & 31, ob = rr * 64 + cc * 2; return st * 1024 + (ob ^ (((ob >> 9) & 1) << 5)); }
__host__ __device__ __forceinline__ void stage_rc(int b, int& R, int& C) { const int st = b / 1024, sb = b % 1024, swz = sb ^ (((sb >> 9) & 1) << 5); R = (st >> 1) * 16 + swz / 64; C = (st & 1) * 32 + (swz % 64) / 2; }
__host__ __device__ __forceinline__ int perm32(int rho) { const int n = rho >> 4, i = rho & 15; return 8 * (i >> 2) + 4 * n + (i & 3); }
struct Unit { int pm, pn, e; };
struct DenseOrder {
    static constexpr bool GATHER = false;
    int nM, nN, nwg, G, c, K; const char* Bt;
    __device__ __forceinline__ void init(int M, int N, int K_, const bf16* Bt_, int G_, int c_) { nM = M / BM; nN = N / BM; nwg = nM * nN; G = G_; c = c_; K = K_; Bt = (const char*)Bt_; }
    __device__ __forceinline__ bool next(int i, Unit& u) const {
        const long L = (long)i * G + c; if (L >= nwg) return false;
        int wgid = (int)L; { const int q = nwg / NXCD, r = nwg % NXCD, xcd = wgid % NXCD, off = wgid / NXCD; wgid = (xcd < r ? xcd * (q + 1) : r * (q + 1) + (xcd - r) * q) + off; }
        const int nig = WGM * nN, gid = wgid / nig, fm = gid * WGM, gsz = (nM - fm) < WGM ? (nM - fm) : WGM;
        u.pm = fm + ((wgid % nig) % gsz); u.pn = (wgid % nig) / gsz; u.e = 0; return true;
    }
    __device__ __forceinline__ unsigned a_voff(const Unit& u, int half, int R) const { return (unsigned)((u.pm * BM + half * HALF + R) * K) * 2u; }
    __device__ __forceinline__ const char* b_tile(const Unit& u) const { return Bt + (size_t)u.pn * BM * K * 2; }
};
template <bool GATH> struct MoeOrder {
    static constexpr bool GATHER = GATH;
    int nunits, ntn, G, c, K; const LAS int* off; const LAS int* cn; const int* list; const char* Bt; size_t estride;
    __device__ __forceinline__ bool next(int i, Unit& u) const {
        const int L = i * G + c; if (L >= nunits) return false;
        u.pm = L / ntn; u.pn = L % ntn; const int s0 = u.pm * BM; int e = 0;
#pragma unroll
        for (int q = 1; q < 16; ++q) e += (s0 >= off[q]) ? 1 : 0;
        u.e = e; return true;
    }
    __device__ __forceinline__ unsigned a_voff(const Unit& u, int half, int R) const {
        const int slot = u.pm * BM + half * HALF + R;
        const int loc = slot - off[u.e]; const int tk = list[u.e * T + (loc < cn[u.e] ? loc : 0)];
        return (unsigned)(tk * K) * 2u;
    }
    __device__ __forceinline__ const char* b_tile(const Unit& u) const { return Bt + (size_t)u.e * estride + (size_t)u.pn * BM * K * 2; }
};
__device__ __forceinline__ unsigned cvt_pk_bf16(float lo, float hi) { return pk2(lo, hi); }

template <class Epi, class Sched>
__device__ __forceinline__ void gemm_phase(LAS unsigned char* lds, const bf16* Aptr, int K, const Sched& S, const Epi& E, int wv_) {
    const int tid = opaque_tid(wv_), wid = __builtin_amdgcn_readfirstlane(tid >> 6), lane = tid & 63, wr = wid >> 2, wc = wid & 3, fr = lane & 15, fq = lane >> 4;
    const int nt = K / BK;
    int Rr[2], Cc[2]; unsigned voffA[2], voffB[2];
#pragma unroll
    for (int i = 0; i < 2; ++i) { stage_rc(tid * 16 + i * 8192, Rr[i], Cc[i]); const int Rb = Epi::PERM ? ((Rr[i] & ~31) + perm32(Rr[i] & 31)) : Rr[i];
        voffA[i] = (unsigned)(Rr[i] * K + Cc[i]) * 2u; voffB[i] = (unsigned)(Rb * K + Cc[i]) * 2u; }
    const size_t kstep = (size_t)(BK * 2);
    const size_t hstep = (size_t)HALF * K * 2;
    const size_t tstep = 2 * hstep;
    const unsigned ldsw = (unsigned)wid * 1024u;
    const int aoff = lds_byte(wr * 64 + fr, fq * 8), boff = lds_byte(wc * 32 + fr, fq * 8);
    const char* const Ab = (const char*)Aptr;
#define PG8_SA(b, h) (((b) * 2 + (h)) * HTB)
#define PG8_SB(b, h) ((4 + (b) * 2 + (h)) * HTB)
#define PG8_STAGE(bufoff, gbase, voff) do { _Pragma("unroll") for (int _i = 0; _i < 2; ++_i) \
        __builtin_amdgcn_global_load_lds((const unsigned*)((const char*)(gbase) + (voff)[_i]), (LAS unsigned*)(lds + (bufoff) + ldsw + _i * 8192), 16, 0, 0); } while (0)
#define PG8_STAGE_A(bufoff, usenext, h, kofs) do { \
        if constexpr (Sched::GATHER) { const char* gb_ = Ab + (kofs); unsigned vv_[2] = {(usenext) ? vN[h][0] : vA[h][0], (usenext) ? vN[h][1] : vA[h][1]}; PG8_STAGE(bufoff, gb_, vv_); } \
        else { const char* gb_ = ((usenext) ? nA : cA) + (size_t)(h) * hstep + (kofs); PG8_STAGE(bufoff, gb_, voffA); } } while (0)
#define PG8_LDA(dst, b, h) do { _Pragma("unroll") for (int m = 0; m < 4; ++m) _Pragma("unroll") for (int k = 0; k < 2; ++k) dst[m][k] = *(const LAS bf16x8*)(lds + PG8_SA(b, h) + aoff + m * 2048 + k * 1024); } while (0)
#define PG8_LDB(dst, b, h) do { _Pragma("unroll") for (int n = 0; n < 2; ++n) _Pragma("unroll") for (int k = 0; k < 2; ++k) dst[n][k] = *(const LAS bf16x8*)(lds + PG8_SB(b, h) + boff + n * 2048 + k * 1024); } while (0)
#define PG8_MMA(ai, bj, At, Bt) do { __builtin_amdgcn_s_setprio(1); _Pragma("unroll") for (int m = 0; m < 4; ++m) _Pragma("unroll") for (int n = 0; n < 2; ++n) _Pragma("unroll") for (int k = 0; k < 2; ++k) \
        acc[ai][bj][m][n] = __builtin_amdgcn_mfma_f32_16x16x32_bf16(Bt[n][k], At[m][k], acc[ai][bj][m][n], 0, 0, 0); __builtin_amdgcn_s_setprio(0); } while (0)
#define PG8_WAIT_V(n) asm volatile("s_waitcnt vmcnt(" #n ")" ::: "memory")
#define PG8_WAIT_L(n) asm volatile("s_waitcnt lgkmcnt(" #n ")" ::: "memory")
#define PG8_BAR __builtin_amdgcn_s_barrier()
#define PG8_SCHED __builtin_amdgcn_sched_barrier(0)
    Unit cur, nxt; int ui = 0;
    if (!S.next(0, cur)) return;
    f32x4 acc[2][2][4][2];
#pragma unroll
    for (int a = 0; a < 2; ++a)
#pragma unroll
        for (int b = 0; b < 2; ++b)
#pragma unroll
            for (int m = 0; m < 4; ++m)
#pragma unroll
                for (int n = 0; n < 2; ++n) acc[a][b][m][n] = (f32x4){0.f, 0.f, 0.f, 0.f};
    bf16x8 At[4][2], B0[2][2], B1[2][2];
    unsigned vA[2][2], vN[2][2];
    const char* cA = Ab; const char* nA = Ab;
    if constexpr (Sched::GATHER) {
#pragma unroll
        for (int h = 0; h < 2; ++h)
#pragma unroll
            for (int i = 0; i < 2; ++i) { vA[h][i] = S.a_voff(cur, h, Rr[i]) + (unsigned)Cc[i] * 2u; vN[h][i] = vA[h][i]; }
    } else { cA = Ab + (size_t)cur.pm * tstep; nA = cA; }
    const char* cB = S.b_tile(cur);
    PG8_STAGE(PG8_SB(0, 0), cB, voffB); PG8_STAGE_A(PG8_SA(0, 0), false, 0, 0); PG8_STAGE(PG8_SB(0, 1), cB + hstep, voffB); PG8_STAGE_A(PG8_SA(0, 1), false, 1, 0);
    if (wr == 1) PG8_BAR;
    PG8_WAIT_V(4); PG8_BAR;
    PG8_STAGE(PG8_SB(1, 0), cB + kstep, voffB); PG8_STAGE_A(PG8_SA(1, 0), false, 0, kstep); PG8_STAGE(PG8_SB(1, 1), cB + hstep + kstep, voffB);
    PG8_WAIT_V(6); PG8_BAR;
    for (;;) {
        const bool has_next = S.next(ui + 1, nxt);
        const char* nB = has_next ? S.b_tile(nxt) : cB;
        if constexpr (Sched::GATHER) {
#pragma unroll
            for (int h = 0; h < 2; ++h)
#pragma unroll
                for (int i = 0; i < 2; ++i) vN[h][i] = has_next ? S.a_voff(nxt, h, Rr[i]) + (unsigned)Cc[i] * 2u : vA[h][i];
        } else nA = has_next ? Ab + (size_t)nxt.pm * tstep : cA;
        for (int t = 0; t < nt; t += 2) {
            const bool last = (t == nt - 2);
            const size_t k1 = (size_t)(t + 1) * kstep, k2 = last ? 0 : (size_t)(t + 2) * kstep, k3 = k2 + kstep;
            const char* b2 = last ? nB : cB + (size_t)(t + 2) * kstep; const char* b3 = b2 + kstep;
            PG8_LDB(B0, 0, 0); PG8_SCHED; PG8_LDA(At, 0, 0); PG8_STAGE_A(PG8_SA(1, 1), false, 1, k1);
            PG8_WAIT_L(8); PG8_BAR; PG8_WAIT_L(0); PG8_MMA(0, 0, At, B0); PG8_BAR; PG8_SCHED;
            PG8_LDB(B1, 0, 1); PG8_STAGE(PG8_SB(0, 0), b2, voffB);
            PG8_BAR; PG8_WAIT_L(0); PG8_MMA(0, 1, At, B1); PG8_BAR;
            PG8_LDA(At, 0, 1); PG8_STAGE_A(PG8_SA(0, 0), last, 0, k2);
            PG8_BAR; PG8_WAIT_L(0); PG8_MMA(1, 0, At, B0); PG8_BAR; PG8_SCHED;
            PG8_STAGE(PG8_SB(0, 1), b2 + hstep, voffB);
            PG8_WAIT_V(6); PG8_BAR; PG8_MMA(1, 1, At, B1); PG8_BAR;
            PG8_LDB(B0, 1, 0); PG8_SCHED; PG8_LDA(At, 1, 0); PG8_STAGE_A(PG8_SA(0, 1), last, 1, k2);
            PG8_WAIT_L(8); PG8_BAR; PG8_WAIT_L(0); PG8_MMA(0, 0, At, B0); PG8_BAR; PG8_SCHED;
            PG8_LDB(B1, 1, 1); PG8_STAGE(PG8_SB(1, 0), b3, voffB);
            PG8_BAR; PG8_WAIT_L(0); PG8_MMA(0, 1, At, B1); PG8_BAR;
            PG8_LDA(At, 1, 1); PG8_STAGE_A(PG8_SA(1, 0), last, 0, k3);
            PG8_BAR; PG8_WAIT_L(0); PG8_MMA(1, 0, At, B0); PG8_BAR; PG8_SCHED;
            PG8_STAGE(PG8_SB(1, 1), b3 + hstep, voffB);
            PG8_WAIT_V(6); PG8_BAR; PG8_MMA(1, 1, At, B1); PG8_BAR;
        }
        E(acc, cur, wr, wc, fr, fq);
        if (!has_next) break;
#pragma unroll
        for (int a = 0; a < 2; ++a)
#pragma unroll
            for (int b = 0; b < 2; ++b)
#pragma unroll
                for (int m = 0; m < 4; ++m)
#pragma unroll
                    for (int n = 0; n < 2; ++n) acc[a][b][m][n] = (f32x4){0.f, 0.f, 0.f, 0.f};
        cur = nxt; cB = nB; cA = nA; ++ui;
        if constexpr (Sched::GATHER) {
#pragma unroll
            for (int h = 0; h < 2; ++h)
#pragma unroll
                for (int i = 0; i < 2; ++i) vA[h][i] = vN[h][i];
        }
    }
    PG8_WAIT_V(0);
    if (wr == 0) PG8_BAR;
    PG8_BAR;
#undef PG8_SA
#undef PG8_SB
#undef PG8_STAGE
#undef PG8_STAGE_A
#undef PG8_LDA
#undef PG8_LDB
#undef PG8_MMA
#undef PG8_WAIT_V
#undef PG8_WAIT_L
#undef PG8_BAR
#undef PG8_SCHED
}
template <int ACT> struct EpiBf16 {
    static constexpr bool PERM = true;
    bf16* O; int ldc; int tpt; size_t tstride;
    __device__ __forceinline__ void operator()(const f32x4 (&acc)[2][2][4][2], const Unit& u, int wr, int wc, int fr, int fq) const {
        const int row0 = u.pm * BM + wr * 64 + fr; const int tt = u.pn / tpt; bf16* base = O + (size_t)tt * tstride; const int col0 = (u.pn - tt * tpt) * BM + wc * 32 + 8 * fq;
#pragma unroll
        for (int ai = 0; ai < 2; ++ai)
#pragma unroll
            for (int m = 0; m < 4; ++m) { bf16* rowp = base + (size_t)(row0 + ai * HALF + m * 16) * ldc + col0;
#pragma unroll
                for (int bj = 0; bj < 2; ++bj) { f32x4 v0 = acc[ai][bj][m][0], v1 = acc[ai][bj][m][1];
                    if (ACT == 1) {
#pragma unroll
                        for (int q = 0; q < 4; ++q) { v0[q] = gelu_tanh(v0[q]); v1[q] = gelu_tanh(v1[q]); } }
                    u32x4 w; w.x = cvt_pk_bf16(v0[0], v0[1]); w.y = cvt_pk_bf16(v0[2], v0[3]); w.z = cvt_pk_bf16(v1[0], v1[1]); w.w = cvt_pk_bf16(v1[2], v1[3]);
                    *(u32x4*)(rowp + bj * HALF) = w; } }
    }
};
struct EpiResAdd {
    static constexpr bool PERM = false;
    float* X; int ldc;
    __device__ __forceinline__ void operator()(const f32x4 (&acc)[2][2][4][2], const Unit& u, int wr, int wc, int fr, int fq) const {
        const int row0 = u.pm * BM + wr * 64 + fr, col0 = u.pn * BM + wc * 32 + 4 * fq;
#pragma unroll
        for (int ai = 0; ai < 2; ++ai)
#pragma unroll
            for (int m2 = 0; m2 < 4; m2 += 2) {
                f32x4 x[2][2][2];
#pragma unroll
                for (int mm = 0; mm < 2; ++mm)
#pragma unroll
                    for (int bj = 0; bj < 2; ++bj)
#pragma unroll
                        for (int n = 0; n < 2; ++n) x[mm][bj][n] = *(const f32x4*)(X + (size_t)(row0 + ai * HALF + (m2 + mm) * 16) * ldc + col0 + bj * HALF + n * 16);
#pragma unroll
                for (int mm = 0; mm < 2; ++mm)
#pragma unroll
                    for (int bj = 0; bj < 2; ++bj)
#pragma unroll
                        for (int n = 0; n < 2; ++n) *(f32x4*)(X + (size_t)(row0 + ai * HALF + (m2 + mm) * 16) * ldc + col0 + bj * HALF + n * 16) = x[mm][bj][n] + acc[ai][bj][m2 + mm][n];
            }
    }
};
struct EpiResAddNorm {
    static constexpr bool PERM = false;
    float* X; int ldc; bf16* XB; float* rowsq;
    __device__ __forceinline__ void operator()(const f32x4 (&acc)[2][2][4][2], const Unit& u, int wr, int wc, int fr, int fq) const {
        const int row0 = u.pm * BM + wr * 64 + fr, col0 = u.pn * BM + wc * 32 + 4 * fq;
#pragma unroll
        for (int ai = 0; ai < 2; ++ai)
#pragma unroll
            for (int m2 = 0; m2 < 4; m2 += 2) {
                f32x4 x[2][2][2];
#pragma unroll
                for (int mm = 0; mm < 2; ++mm)
#pragma unroll
                    for (int bj = 0; bj < 2; ++bj)
#pragma unroll
                        for (int n = 0; n < 2; ++n) x[mm][bj][n] = *(const f32x4*)(X + (size_t)(row0 + ai * HALF + (m2 + mm) * 16) * ldc + col0 + bj * HALF + n * 16);
#pragma unroll
                for (int mm = 0; mm < 2; ++mm) {
                    const size_t ro = (size_t)(row0 + ai * HALF + (m2 + mm) * 16) * ldc + col0; float ssq = 0.f;
#pragma unroll
                    for (int bj = 0; bj < 2; ++bj)
#pragma unroll
                        for (int n = 0; n < 2; ++n) { const f32x4 v = x[mm][bj][n] + acc[ai][bj][m2 + mm][n];
                            *(f32x4*)(X + ro + bj * HALF + n * 16) = v;
                            u32x2 w; w.x = cvt_pk_bf16(v.x, v.y); w.y = cvt_pk_bf16(v.z, v.w); *(u32x2*)(XB + ro + bj * HALF + n * 16) = w;
                            ssq += (v.x * v.x + v.y * v.y) + (v.z * v.z + v.w * v.w); }
                    ssq += __shfl_xor(ssq, 16); ssq += __shfl_xor(ssq, 32);
                    if (fq == 0) rowsq[(size_t)(row0 + ai * HALF + (m2 + mm) * 16) * 16 + u.pn * 4 + wc] = ssq;
                }
            }
    }
};
struct EpiBf16RowScale {
    static constexpr bool PERM = true;
    bf16* O; int ldc; const float* rowsq;
    __device__ __forceinline__ void operator()(const f32x4 (&acc)[2][2][4][2], const Unit& u, int wr, int wc, int fr, int fq) const {
        const int row0 = u.pm * BM + wr * 64 + fr, col0 = u.pn * BM + wc * 32 + 8 * fq;
#pragma unroll
        for (int ai = 0; ai < 2; ++ai) {
            float rs[4];
#pragma unroll
            for (int m = 0; m < 4; ++m) { const f32x4* p = (const f32x4*)(rowsq + (size_t)(row0 + ai * HALF + m * 16) * 16); const f32x4 a = p[0], b = p[1], c = p[2], d = p[3];
                rs[m] = rsqrtf((((a.x + a.y) + (a.z + a.w)) + ((b.x + b.y) + (b.z + b.w)) + (((c.x + c.y) + (c.z + c.w)) + ((d.x + d.y) + (d.z + d.w)))) * (1.f / 1024.f) + EPS); }
#pragma unroll
            for (int m = 0; m < 4; ++m) { bf16* rowp = O + (size_t)(row0 + ai * HALF + m * 16) * ldc + col0;
#pragma unroll
                for (int bj = 0; bj < 2; ++bj) { const f32x4 v0 = acc[ai][bj][m][0] * rs[m], v1 = acc[ai][bj][m][1] * rs[m];
                    u32x4 w; w.x = cvt_pk_bf16(v0[0], v0[1]); w.y = cvt_pk_bf16(v0[2], v0[3]); w.z = cvt_pk_bf16(v1[0], v1[1]); w.w = cvt_pk_bf16(v1[2], v1[3]);
                    *(u32x4*)(rowp + bj * HALF) = w; } }
        }
    }
};
struct EpiSwiglu {
    static constexpr bool PERM = true;
    bf16* H; int ldc;
    __device__ __forceinline__ void operator()(const f32x4 (&acc)[2][2][4][2], const Unit& u, int wr, int wc, int fr, int fq) const {
        const int row0 = u.pm * BM + wr * 64 + fr, col0 = u.pn * HALF + wc * 32 + 8 * fq;
#pragma unroll
        for (int ai = 0; ai < 2; ++ai)
#pragma unroll
            for (int m = 0; m < 4; ++m) {
                float o[8];
#pragma unroll
                for (int n = 0; n < 2; ++n)
#pragma unroll
                    for (int q = 0; q < 4; ++q) { const float g = acc[ai][0][m][n][q]; o[4 * n + q] = g * sigmoidf_(g) * acc[ai][1][m][n][q]; }
                u32x4 w; w.x = cvt_pk_bf16(o[0], o[1]); w.y = cvt_pk_bf16(o[2], o[3]); w.z = cvt_pk_bf16(o[4], o[5]); w.w = cvt_pk_bf16(o[6], o[7]);
                *(u32x4*)(H + (size_t)(row0 + ai * HALF + m * 16) * ldc + col0) = w; }
    }
};
}

__device__ __forceinline__ int hyb_colmap(int n) {
    if (n < 1280) return n;
    if (n < 1536) return 1304 + (n - 1280);
    if (n < 1792) return 1560 + (n - 1536);
    if (n < 2304) return 1816 + (n - 1792);
    if (n < 2816) return 2344 + (n - 2304);
    if (n < 2840) return 1280 + (n - 2816);
    if (n < 2856) return 2328 + (n - 2840);
    return -1;
}
__device__ __forceinline__ void tr_item(const float* __restrict__ W, int Nsrc, int K, bf16* __restrict__ Wt, const float* __restrict__ gain, int kind, int nblk, LAS float* scr, int item, int lane) {
    const int kb = item / nblk, nb = item % nblk, k0 = 64 * kb, n0 = 64 * nb;
    const int ksub = lane >> 4, n4 = lane & 15, n = n0 + 4 * n4;
    int col;
    if (kind == 0) col = n; else if (kind == 1) col = hyb_colmap(n); else { const int pn = n >> 8, r = n & 255; col = (r >> 7) * 384 + pn * 128 + (r & 127); }
    f32x4 v[16];
#pragma unroll
    for (int i = 0; i < 16; ++i) v[i] = col >= 0 ? *(const f32x4*)(W + (size_t)(k0 + 4 * i + ksub) * Nsrc + col) : (f32x4){0.f, 0.f, 0.f, 0.f};
    if (gain) {
#pragma unroll
        for (int i = 0; i < 16; ++i) v[i] = v[i] * gain[k0 + 4 * i + ksub];
    }
#pragma unroll
    for (int i = 0; i < 16; ++i) { LAS float* d = scr + (4 * i + ksub) * 65 + 4 * n4; d[0] = v[i].x; d[1] = v[i].y; d[2] = v[i].z; d[3] = v[i].w; }
    LDS_WAIT();
    const int c = lane & 7;
#pragma unroll
    for (int jx = 0; jx < 8; ++jx) {
        const int nn = (lane >> 3) + 8 * jx; const LAS float* s = scr + (8 * c) * 65 + nn;
        u32x4 o; o.x = pk2(s[0 * 65], s[1 * 65]); o.y = pk2(s[2 * 65], s[3 * 65]); o.z = pk2(s[4 * 65], s[5 * 65]); o.w = pk2(s[6 * 65], s[7 * 65]);
        *(u32x4*)(Wt + (size_t)(n0 + nn) * K + k0 + 8 * c) = o;
    }
    LDS_WAIT();
}
__device__ __forceinline__ void rms_row_to_bf16(const float* __restrict__ xrow, bf16* __restrict__ orow, float* __restrict__ copy, int lane) {
    const f32x4* xr = (const f32x4*)xrow + lane;
    f32x4 v[4]; float s = 0.f;
#pragma unroll
    for (int j = 0; j < 4; ++j) { v[j] = xr[64 * j]; s += (v[j].x * v[j].x + v[j].y * v[j].y) + (v[j].z * v[j].z + v[j].w * v[j].w); }
    const float rstd = rsqrtf(wave_sum(s) * (1.f / 1024.f) + EPS);
    u32x2* o8 = (u32x2*)orow + lane;
#pragma unroll
    for (int j = 0; j < 4; ++j) { u32x2 w; w.x = pk2(v[j].x * rstd, v[j].y * rstd); w.y = pk2(v[j].z * rstd, v[j].w * rstd); o8[64 * j] = w; }
    if (copy) { f32x4* c4 = (f32x4*)copy + lane;
#pragma unroll
        for (int j = 0; j < 4; ++j) c4[64 * j] = v[j]; }
}

__device__ __forceinline__ void phase_prologue(KArgs A, int wv_, LAS unsigned char* lds) {
    const int tid = opaque_tid(wv_), wid = __builtin_amdgcn_readfirstlane(tid >> 6), lane = tid & 63;
    const int gw = blockIdx.x * 8 + wid, NGW = gridDim.x * 8;
    LAS float* scr = (LAS float*)(lds + wid * 16640);
    unsigned char* ws = opq(A->ws);
    constexpr int N_HYB = 2 * 768, N_HOUT = 2 * 256, N_SGIN = 2 * 1024, N_SGOUT = 2 * 512, N_WQ = 4 * 256, N_WKV = 4 * 512, N_WO = 4 * 256, N_MIN = 64 * 192, N_MOUT = 64 * 96, N_W1T = 4 * 32;
    constexpr int NITEMS = N_HYB + N_HOUT + N_SGIN + N_SGOUT + N_WQ + N_WKV + N_WO + N_MIN + N_MOUT + N_W1T;
    for (int it = gw; it < NITEMS; it += NGW) {
        int r = it;
        if (r < N_HYB) { const int sl = r / 768; tr_item(A->in[I_HYBIN] + (size_t)sl * 1024 * HYSRC, HYSRC, 1024, (bf16*)(ws + WS_WHYB) + (size_t)sl * HYN * 1024, A->in[I_NMIX] + (2 * sl) * 1024, 1, 48, scr, r % 768, lane); continue; } r -= N_HYB;
        if (r < N_HOUT) { const int sl = r / 256; tr_item(A->in[I_HYBOUT] + (size_t)sl * 1024 * 1024, 1024, 1024, (bf16*)(ws + WS_WHOUT) + (size_t)sl * 1024 * 1024, nullptr, 0, 16, scr, r % 256, lane); continue; } r -= N_HOUT;
        if (r < N_SGIN) { const int sl = r / 1024; tr_item(A->in[I_SGIN] + (size_t)sl * 1024 * 4096, 4096, 1024, (bf16*)(ws + WS_WSGIN) + (size_t)sl * 4096 * 1024, A->in[I_NMIX] + (2 * sl + 1) * 1024, 0, 64, scr, r % 1024, lane); continue; } r -= N_SGIN;
        if (r < N_SGOUT) { const int sl = r / 512; tr_item(A->in[I_SGOUT] + (size_t)sl * 2048 * 1024, 1024, 2048, (bf16*)(ws + WS_WSGOUT) + (size_t)sl * 1024 * 2048, nullptr, 0, 16, scr, r % 512, lane); continue; } r -= N_SGOUT;
        if (r < N_WQ) { const int sl = r / 256; tr_item(A->in[I_XWQ] + (size_t)sl * 1024 * 1024, 1024, 1024, (bf16*)(ws + WS_WQ) + (size_t)sl * 1024 * 1024, A->in[I_NXAT] + sl * 1024, 0, 16, scr, r % 256, lane); continue; } r -= N_WQ;
        if (r < N_WKV) { const int sl = r / 512; tr_item(A->in[I_XWKV] + (size_t)sl * 1024 * 2048, 2048, 1024, (bf16*)(ws + WS_WKV) + (size_t)sl * 2048 * 1024, A->in[I_NMEM] + sl * 1024, 0, 32, scr, r % 512, lane); continue; } r -= N_WKV;
        if (r < N_WO) { const int sl = r / 256; tr_item(A->in[I_XWO] + (size_t)sl * 1024 * 1024, 1024, 1024, (bf16*)(ws + WS_WO) + (size_t)sl * 1024 * 1024, nullptr, 0, 16, scr, r % 256, lane); continue; } r -= N_WO;
        if (r < N_MIN) { const int sl = r / 192; tr_item(A->in[I_MOEIN] + (size_t)sl * 1024 * 768, 768, 1024, (bf16*)(ws + WS_WMIN) + (size_t)sl * 768 * 1024, A->in[I_NFFN] + (sl >> 4) * 1024, 2, 12, scr, r % 192, lane); continue; } r -= N_MIN;
        if (r < N_MOUT) { const int sl = r / 96; tr_item(A->in[I_MOEOUT] + (size_t)sl * 384 * 1024, 1024, 384, (bf16*)(ws + WS_WMOUT) + (size_t)sl * 1024 * 384, nullptr, 0, 16, scr, r % 96, lane); continue; } r -= N_MOUT;
        { const int sl = r / 32; tr_item(A->in[I_CMPW1] + (size_t)sl * 2048 * 64, 64, 2048, (bf16*)(ws + WS_W1T) + (size_t)sl * 64 * 2048, nullptr, 0, 1, scr, r % 32, lane); }
    }
    for (int m = gw; m < T; m += NGW) rms_row_to_bf16(A->in[I_X] + (size_t)m * D, (bf16*)(ws + WS_XN) + (size_t)m * D, A->out + (size_t)m * D, lane);
    for (int m = gw; m < NBATCH * NMEM; m += NGW) rms_row_to_bf16(A->in[I_MEM] + (size_t)m * D, (bf16*)(ws + WS_MN) + (size_t)m * D, nullptr, lane);
    const int gt = blockIdx.x * 512 + tid, NGT = gridDim.x * 512;
    const int* pos = (const int*)A->in[I_POS];
    float* cosT = (float*)(ws + WS_COS); float* sinT = (float*)(ws + WS_SIN);
    for (int i = gt; i < T * 32; i += NGT) {
        const int t = i >> 5, j = i & 31;
        const float ang = (float)pos[t] * A->freq[j];
        const double rev = (double)ang * 0.15915494309189533577;
        const float fr = (float)(rev - rint(rev));
        cosT[i] = __builtin_amdgcn_cosf(fr); sinT[i] = __builtin_amdgcn_sinf(fr);
    }
    { bf16* WSB = (bf16*)(ws + WS_WSB); float* M0 = (float*)(ws + WS_M0); const float* wsg = A->in[I_SGWS];
      for (int e = gt; e < 2 * 8 * 128 * 128; e += NGT) { const int s = e & 127, t = (e >> 7) & 127; WSB[e] = (bf16)f2bf(s <= t ? wsg[e] : 0.f); }
      for (int e = gt; e < 2 * 8 * 128; e += NGT) { const int t = e & 127; const float* r = wsg + (size_t)e * 128; float a = 0.f; for (int s = 0; s <= t; ++s) a += r[s]; M0[e] = a; } }
    float* RW = (float*)(ws + WS_RW);
    for (int i = gt; i < DEPTH * NEXP * D; i += NGT) { const int k = i & 1023, e = (i >> 10) & 15, l = i >> 14; RW[i] = A->in[I_RW][k * NEXP + e] * A->in[I_NFFN][l * D + k]; }
}

__device__ __forceinline__ void phase_knorm(KArgs A, int wv_) {
    const int tid_ = opaque_tid(wv_); const int wid = __builtin_amdgcn_readfirstlane(tid_ >> 6), lane = tid_ & 63; const int gw = blockIdx.x * 8 + wid, NGW = gridDim.x * 8;
    bf16* KV = (bf16*)(opq(A->ws) + WS_KV);
    for (int it0 = gw * 4; it0 < DEPTH * 2048 * 4; it0 += NGW * 4) {
        u32x2 w[4];
#pragma unroll
        for (int q = 0; q < 4; ++q) { const int it = it0 + q; const int h = it & 3, m = (it >> 2) & 2047, l = it >> 13; w[q] = *(const u32x2*)(KV + (size_t)m * 8192 + l * 2048 + h * 256 + 4 * lane); }
#pragma unroll
        for (int q = 0; q < 4; ++q) {
            const int it = it0 + q; const int h = it & 3, m = (it >> 2) & 2047, l = it >> 13;
            const float x0 = bflo(w[q].x), x1 = bfhi(w[q].x), x2 = bflo(w[q].y), x3 = bfhi(w[q].y);
            const float rstd = rsqrtf(wave_sum(x0 * x0 + x1 * x1 + x2 * x2 + x3 * x3) * (1.f / 256.f) + EPS) * 0.0625f;
            const f32x4 g = *(const f32x4*)(A->in[I_XKN] + l * 256 + 4 * lane) * *(const f32x4*)(A->in[I_XQN] + l * 256 + 4 * lane);
            u32x2 o; o.x = pk2(x0 * rstd * g.x, x1 * rstd * g.y); o.y = pk2(x2 * rstd * g.z, x3 * rstd * g.w);
            *(u32x2*)(KV + (size_t)m * 8192 + l * 2048 + h * 256 + 4 * lane) = o;
        }
    }
}

__device__ __forceinline__ int kpos64(int tok) { const int k = tok & 31; return (tok & 32) + 8 * ((k >> 2) & 3) + 4 * (k >> 4) + (k & 3); }
__device__ __forceinline__ int kperm64(int p) { const int fq = (p >> 3) & 3, j = p & 7; return (p & 32) + 16 * (j >> 2) + 4 * fq + (j & 3); }

__device__ __forceinline__ void phase_nsa_prep(KArgs A, int wv_, int i, LAS unsigned char* lds) {
    const int tid_ = opaque_tid(wv_); const int wid = __builtin_amdgcn_readfirstlane(tid_ >> 6), lane = tid_ & 63; const int gw = blockIdx.x * 8 + wid, NGW = gridDim.x * 8;
    unsigned char* ws = opq(A->ws);
    const bf16* HY = (const bf16*)(ws + WS_BIG);
    const float* cosT = (const float*)(ws + WS_COS); const float* sinT = (const float*)(ws + WS_SIN);
    bf16* QA = (bf16*)(ws + WS_QA); bf16* KS = (bf16*)(ws + WS_KS); bf16* KW = (bf16*)(ws + WS_KW);
    LAS float* abuf = (LAS float*)(lds + wid * 8192);
    const int NIT = T;
    for (int it = gw; it < NIT; it += NGW) {
        if (it < T) {
            const int t = it;
            const float c = cosT[t * 32 + (lane & 31)], s = sinT[t * 32 + (lane & 31)];
            float xin[12];
#pragma unroll
            for (int u = 0; u < 12; ++u) xin[u] = bf2f(HY[(size_t)t * HYN + (u < 8 ? C_QA + 64 * u : (u < 10 ? C_KS + 64 * (u - 8) : C_KW + 64 * (u - 10))) + lane]);
#pragma unroll
            for (int u = 0; u < 12; ++u) {
                int src; const float* gain; bf16* dst; float scale;
                if (u < 8) { src = C_QA + 64 * u; gain = A->in[I_QNORM] + i * 64; dst = QA + (size_t)t * 512 + 64 * u; scale = 0.125f * 1.4426950408889634f; }
                else if (u < 10) { src = C_KS + 64 * (u - 8); gain = A->in[I_KNORM] + (i * 3 + 1) * 64; dst = KS + (size_t)t * 128 + 64 * (u - 8); scale = 1.f; }
                else { src = C_KW + 64 * (u - 10); gain = A->in[I_KNORM] + (i * 3 + 2) * 64; dst = KW + (size_t)t * 128 + 64 * (u - 10); scale = 1.f; }
                const float x = xin[u]; (void)src;
                const float y = x * rsqrtf(wave_sum(x * x) * (1.f / 64.f) + EPS) * gain[lane] * scale;
                const float pr = __shfl_xor(y, 32);
                const float o = lane < 32 ? y * c - pr * s : y * c + pr * s;
                dst[lane] = (bf16)f2bf(o);
            }
        }
    }
}


__device__ __forceinline__ void phase_compress_mfma(KArgs A, int wv_, int i, LAS unsigned char* lds) {
    const int tid = opaque_tid(wv_), wid = __builtin_amdgcn_readfirstlane(tid >> 6), lane = tid & 63, fr = lane & 15, fq = lane >> 4;
    unsigned char* ws = opq(A->ws);
    const bf16* HY = (const bf16*)(ws + WS_BIG);
    const float* cosT = (const float*)(ws + WS_COS); const float* sinT = (const float*)(ws + WS_SIN);
    LAS float* part = (LAS float*)lds;
    LAS float* hbuf = part + 8 * 1024;
    LAS float* obuf = hbuf + 1024;
    LAS float* w2l = obuf + 1024;
    int w2kv = -1;
    for (int it = blockIdx.x; it < 2 * 127; it += gridDim.x) {
        const int kv = it / 127, tile = it % 127;
        const float* pe = A->in[I_CMPPE] + (size_t)(i * 2 + kv) * 32 * 64;
        const float* w2 = A->in[I_CMPW2] + (size_t)(i * 2 + kv) * 64 * 64;
        const bf16* w1t = (const bf16*)(ws + WS_W1T) + (size_t)(i * 2 + kv) * 64 * 2048;
        const int coff = kv ? C_VC : C_KC;
        if (kv != w2kv) { __syncthreads(); for (int e4 = tid; e4 < 1024; e4 += 512) *(LAS f32x4*)(w2l + 4 * e4) = *(const f32x4*)(w2 + 4 * e4); w2kv = kv; }
        {
            const int R = tile * 16 + fr, g = R & 1, bn = R >> 1, n = bn % NCMP, b = bn / NCMP;
            const bf16* arow = HY + (size_t)(b * S + 16 * n) * HYN + coff + g * 64;
            f32x4 acc[4];
#pragma unroll
            for (int t = 0; t < 4; ++t) acc[t] = (f32x4){0.f, 0.f, 0.f, 0.f};
#pragma unroll 4
            for (int s = 0; s < 8; ++s) {
                const int k0 = 256 * wid + 32 * s, l = k0 >> 6, d0 = (k0 & 63) + 8 * fq;
                const u32x4 hw = *(const u32x4*)(arow + (size_t)l * HYN + d0);
                const f32x4 p0 = *(const f32x4*)(pe + l * 64 + d0), p1 = *(const f32x4*)(pe + l * 64 + d0 + 4);
                u32x4 aw; aw.x = pk2(bflo(hw.x) + p0.x, bfhi(hw.x) + p0.y); aw.y = pk2(bflo(hw.y) + p0.z, bfhi(hw.y) + p0.w); aw.z = pk2(bflo(hw.z) + p1.x, bfhi(hw.z) + p1.y); aw.w = pk2(bflo(hw.w) + p1.z, bfhi(hw.w) + p1.w);
                const bf16x8 af = __builtin_bit_cast(bf16x8, aw);
#pragma unroll
                for (int t = 0; t < 4; ++t) { const bf16x8 bfr = *(const bf16x8*)(w1t + (size_t)(16 * t + fr) * 2048 + k0 + 8 * fq);
                    acc[t] = __builtin_amdgcn_mfma_f32_16x16x32_bf16(af, bfr, acc[t], 0, 0, 0); }
            }
            __syncthreads();
#pragma unroll
            for (int t = 0; t < 4; ++t)
#pragma unroll
                for (int r = 0; r < 4; ++r) part[wid * 1024 + (4 * fq + r) * 64 + 16 * t + fr] = acc[t][r];
        }
        __syncthreads();
        for (int e = tid; e < 1024; e += 512) { float a = 0.f;
#pragma unroll
            for (int w = 0; w < 8; ++w) a += part[w * 1024 + e];
            hbuf[e] = gelu_tanh(a); }
        __syncthreads();
        for (int e = tid; e < 1024; e += 512) { const int r = e >> 6, j = e & 63; float o = 0.f;
#pragma unroll 8
            for (int m = 0; m < 64; ++m) o += hbuf[r * 64 + m] * w2l[m * 64 + j];
            obuf[e] = o; }
        __syncthreads();
        for (int r = wid; r < 16; r += 8) {
            const int R = tile * 16 + r, g = R & 1, bn = R >> 1, n = bn % NCMP, b = bn / NCMP;
            const float o = obuf[r * 64 + lane];
            if (kv == 0) {
                const float y = o * rsqrtf(wave_sum(o * o) * (1.f / 64.f) + EPS) * A->in[I_KNORM][(i * 3 + 0) * 64 + lane];
                const int tp = b * S + 16 * n + 31;
                const float c = cosT[tp * 32 + (lane & 31)], sn = sinT[tp * 32 + (lane & 31)];
                const float pr = __shfl_xor(y, 32);
                const float oo = lane < 32 ? y * c - pr * sn : y * c + pr * sn;
                ((bf16*)(ws + WS_KC))[((size_t)(b * 128 + n) * 2 + g) * 64 + lane] = (bf16)f2bf(oo);
            } else {
                bf16* vct = (bf16*)(ws + WS_VC) + ((size_t)(b * 2 + g) * 64 + lane) * 128;
                vct[(n & 64) + kpos64(n & 63)] = (bf16)f2bf(o);
                if (n == 126) vct[127] = 0;
            }
        }
    }
    __syncthreads();
}

__device__ __forceinline__ void nsa_block(const LAS float* qs, const bf16* __restrict__ krow, bool ok, const bf16* __restrict__ vbase, int vstride, int lane,
                                          float (&m)[4], float (&l)[4], float (&o)[4]) {
    float s[4] = {0.f, 0.f, 0.f, 0.f};
#pragma unroll 2
    for (int c = 0; c < 8; ++c) {
        const u32x4 kw = *(const u32x4*)(krow + 8 * c);
        const float k0 = bflo(kw.x), k1 = bfhi(kw.x), k2 = bflo(kw.y), k3 = bfhi(kw.y), k4 = bflo(kw.z), k5 = bfhi(kw.z), k6 = bflo(kw.w), k7 = bfhi(kw.w);
#pragma unroll
        for (int hh = 0; hh < 4; ++hh) {
            const f32x4 qa = *(const LAS f32x4*)(qs + hh * 64 + 8 * c), qb = *(const LAS f32x4*)(qs + hh * 64 + 8 * c + 4);
            s[hh] += (qa.x * k0 + qa.y * k1) + (qa.z * k2 + qa.w * k3) + (qb.x * k4 + qb.y * k5) + (qb.z * k6 + qb.w * k7);
        }
    }
    float p[4];
#pragma unroll
    for (int hh = 0; hh < 4; ++hh) {
        const float sv = ok ? s[hh] : -INFINITY;
        const float bm = wave_max(sv);
        const float mn = fmaxf(m[hh], bm);
        if (mn == -INFINITY) { p[hh] = 0.f; continue; }
        const float alpha = __expf(m[hh] - mn);
        p[hh] = ok ? __expf(sv - mn) : 0.f;
        l[hh] = l[hh] * alpha + wave_sum(p[hh]);
        o[hh] *= alpha; m[hh] = mn;
    }
#pragma unroll 8
    for (int kk = 0; kk < 64; ++kk) {
        const float v = bf2f(vbase[(size_t)kk * vstride + lane]);
#pragma unroll
        for (int hh = 0; hh < 4; ++hh) o[hh] += __shfl(p[hh], kk) * v;
    }
}
__device__ __forceinline__ void phase_nsa_attn(KArgs A, int wv_, int i, LAS unsigned char* lds) {
    const int tid_ = opaque_tid(wv_); const int wid = __builtin_amdgcn_readfirstlane(tid_ >> 6), lane0 = tid_ & 63; const int gw = blockIdx.x * 8 + wid, NGW = gridDim.x * 8;
    unsigned char* ws = opq(A->ws);
    const bf16* HY = (const bf16*)(ws + WS_BIG); const bf16* QA = (const bf16*)(ws + WS_QA); const bf16* KS = (const bf16*)(ws + WS_KS); const bf16* KW = (const bf16*)(ws + WS_KW);
    const bf16* KC = (const bf16*)(ws + WS_KC); const bf16* VC = (const bf16*)(ws + WS_VC); bf16* CAT = (bf16*)(ws + WS_CAT);
    LAS float* qs = (LAS float*)(lds + wid * 2048);
    LAS float* ps = qs + 256;
    for (int it = gw; it < 2 * T; it += NGW) {
        int lane = lane0; asm volatile("" : "+v"(lane));
        const int tok = it >> 1, g = it & 1, b = tok >> 11, t = tok & 2047;
#pragma unroll
        for (int hh = 0; hh < 4; ++hh) qs[hh * 64 + lane] = bf2f(QA[(size_t)tok * 512 + (g * 4 + hh) * 64 + lane]);
        LDS_WAIT();
        const int ncv = t >= 31 ? ((t - 31) >> 4) + 1 : 0;
        float oc[4] = {0.f, 0.f, 0.f, 0.f};
        float psum0 = 0.f, psum1 = 0.f;
        {
            const bool v0 = lane < ncv, v1 = lane + 64 < ncv;
            const bf16* k0p = KC + ((size_t)(b * 128 + lane) * 2 + g) * 64;
            const bf16* k1p = KC + ((size_t)(b * 128 + (lane + 64 < 127 ? lane + 64 : 126)) * 2 + g) * 64;
            float s0[4] = {0.f, 0.f, 0.f, 0.f}, s1[4] = {0.f, 0.f, 0.f, 0.f};
#pragma unroll 2
            for (int c = 0; c < 8; ++c) {
                const u32x4 ka = *(const u32x4*)(k0p + 8 * c), kb = *(const u32x4*)(k1p + 8 * c);
#pragma unroll
                for (int hh = 0; hh < 4; ++hh) {
                    const f32x4 qa = *(const LAS f32x4*)(qs + hh * 64 + 8 * c), qb = *(const LAS f32x4*)(qs + hh * 64 + 8 * c + 4);
                    s0[hh] += (qa.x * bflo(ka.x) + qa.y * bfhi(ka.x)) + (qa.z * bflo(ka.y) + qa.w * bfhi(ka.y)) + (qb.x * bflo(ka.z) + qb.y * bfhi(ka.z)) + (qb.z * bflo(ka.w) + qb.w * bfhi(ka.w));
                    s1[hh] += (qa.x * bflo(kb.x) + qa.y * bfhi(kb.x)) + (qa.z * bflo(kb.y) + qa.w * bfhi(kb.y)) + (qb.x * bflo(kb.z) + qb.y * bfhi(kb.z)) + (qb.z * bflo(kb.w) + qb.w * bfhi(kb.w));
                }
            }
            float p0[4], p1[4];
#pragma unroll
            for (int hh = 0; hh < 4; ++hh) {
                const float a0 = v0 ? s0[hh] : -INFINITY, a1 = v1 ? s1[hh] : -INFINITY;
                const float mx = wave_max(fmaxf(a0, a1));
                if (ncv > 0) {
                    const float e0 = v0 ? __expf(a0 - mx) : 0.f, e1 = v1 ? __expf(a1 - mx) : 0.f;
                    const float inv = 1.0f / wave_sum(e0 + e1);
                    p0[hh] = e0 * inv; p1[hh] = e1 * inv;
                } else { p0[hh] = 0.f; p1[hh] = 0.f; }
                psum0 += p0[hh]; psum1 += p1[hh];
            }
#pragma unroll 2
            for (int c = 0; c < ncv; ++c) {
                const float v = bf2f(VC[((size_t)(b * 128 + c) * 2 + g) * 64 + lane]);
#pragma unroll
                for (int hh = 0; hh < 4; ++hh) oc[hh] += __shfl(c < 64 ? p0[hh] : p1[hh], c & 63) * v;
            }
        }
        ps[lane] = psum0; ps[64 + lane] = psum1;
        LDS_WAIT();
        const int cur = t >> 6;
        unsigned selmask;
        {
            const int j = lane & 31;
            float imp = ps[4 * j] + ps[4 * j + 1] + ps[4 * j + 2] + 0.5f * ps[4 * j + 3] + (j > 0 ? 0.5f * ps[4 * j - 1] : 0.f);
            const bool valid = j <= cur, forced = (j == 0) || (j == cur) || (j == cur - 1);
            const float score = valid ? imp + (forced ? 1000.0f : 0.f) : -INFINITY;
            int rank = 0;
#pragma unroll 8
            for (int jj = 0; jj < 32; ++jj) { const float sj = __shfl(score, jj); rank += (sj > score || (sj == score && jj < j)) ? 1 : 0; }
            const bool sel = valid && rank < 8 && lane < 32;
            selmask = (unsigned)__ballot(sel);
        }
        LDS_WAIT();
        float o1[4] = {0.f, 0.f, 0.f, 0.f}, o2[4] = {0.f, 0.f, 0.f, 0.f};
#pragma unroll 1
        for (int pass = 0; pass < 2; ++pass) {
            float oa[4] = {0.f, 0.f, 0.f, 0.f}, ma[4] = {-INFINITY, -INFINITY, -INFINITY, -INFINITY}, la[4] = {0.f, 0.f, 0.f, 0.f};
            const int lo = pass ? (t - 255 > 0 ? t - 255 : 0) : 0;
            const unsigned bm = pass ? 0xffffffffu : selmask;
            const bf16* Kb = pass ? KW : KS; const int vc = pass ? C_VW : C_VS;
#pragma unroll 1
            for (int j = lo >> 6; j <= cur; ++j) {
                if (!((bm >> j) & 1u)) continue;
                const int key = 64 * j + lane; const size_t kt = (size_t)(b * S + key);
                nsa_block(qs, Kb + kt * 128 + g * 64, key <= t && key >= lo, HY + (size_t)(b * S + 64 * j) * HYN + vc + g * 64, HYN, lane, ma, la, oa);
            }
            if (pass == 0) {
#pragma unroll
                for (int hh = 0; hh < 4; ++hh) o1[hh] = oa[hh] / la[hh];
            } else {
#pragma unroll
                for (int hh = 0; hh < 4; ++hh) o2[hh] = oa[hh] / la[hh];
            }
        }
#pragma unroll
        for (int hh = 0; hh < 4; ++hh) {
            const int head = g * 4 + hh;
            const float* gb = A->in[I_GATEB] + i * 24 + head * 3;
            const bf16* gl = HY + (size_t)tok * HYN + C_GA + head * 3;
            const float g0 = sigmoidf_(bf2f(gl[0]) + gb[0]), g1 = sigmoidf_(bf2f(gl[1]) + gb[1]), g2 = sigmoidf_(bf2f(gl[2]) + gb[2]);
            const float o = g0 * oc[hh] + g1 * o1[hh] + g2 * o2[hh];
            CAT[(size_t)tok * 1024 + head * 64 + lane] = (bf16)f2bf(o);
        }
    }
}

__device__ __forceinline__ void phase_gla_seq(KArgs A, int wv_, int i, LAS unsigned char* lds) {
    const int tid = opaque_tid(wv_), wid = __builtin_amdgcn_readfirstlane(tid >> 6), lane = tid & 63;
    unsigned char* ws = opq(A->ws);
    const bf16* HY = (const bf16*)(ws + WS_BIG); bf16* CAT = (bf16*)(ws + WS_CAT);
    constexpr int CH = 16;
    LAS float* la = (LAS float*)lds;
    LAS float* lk = la + 4 * CH * 64;
    LAS float* lq = lk + 4 * CH * 64;
    LAS float* lo = lq + 4 * CH * 64;
    const float* wa2 = A->in[I_WA2] + i * 16 * 256; const float* ba = A->in[I_BA] + i * 256; const float* og = A->in[I_ONORM] + i * 128;
    for (int it = blockIdx.x; it < 8; it += gridDim.x) {
        const int pl = tid >> 7, v = tid & 127, p = it * 4 + pl, b = p >> 2, h = p & 3;
        float St[64];
#pragma unroll
        for (int k = 0; k < 64; ++k) St[k] = 0.f;
        for (int c0 = 0; c0 < S; c0 += CH) {
            __syncthreads();
            for (int e = tid; e < 4 * CH * 64; e += 512) {
                const int kk = e & 63, tk = (e >> 6) % CH, pp = e / (64 * CH); const int pb = (it * 4 + pp) >> 2, ph = (it * 4 + pp) & 3;
                const size_t tok = (size_t)pb * S + c0 + tk; const bf16* row = HY + tok * HYN;
                float z = ba[ph * 64 + kk];
#pragma unroll
                for (int r = 0; r < 16; ++r) z += bf2f(row[C_AL + r]) * wa2[r * 256 + ph * 64 + kk];
                const float ls_ = fminf(z, 0.f) - log1pf(__expf(-fabsf(z)));
                la[e] = __expf(ls_ * (1.f / 16.f));
                lk[e] = bf2f(row[C_KB + ph * 64 + kk]);
                lq[e] = bf2f(row[C_QB + ph * 64 + kk]) * 0.125f;
            }
            __syncthreads();
            for (int tk = 0; tk < CH; ++tk) {
                const size_t tok = (size_t)b * S + c0 + tk;
                const float vv = bf2f(HY[tok * HYN + C_VB + h * 128 + v]);
                const LAS float* pa = la + (pl * CH + tk) * 64; const LAS float* pk = lk + (pl * CH + tk) * 64; const LAS float* pq = lq + (pl * CH + tk) * 64;
                float o = 0.f;
#pragma unroll
                for (int k4 = 0; k4 < 16; ++k4) {
                    const f32x4 a4 = *(const LAS f32x4*)(pa + 4 * k4), k4v = *(const LAS f32x4*)(pk + 4 * k4), q4 = *(const LAS f32x4*)(pq + 4 * k4);
                    St[4 * k4 + 0] = a4.x * St[4 * k4 + 0] + k4v.x * vv; o += q4.x * St[4 * k4 + 0];
                    St[4 * k4 + 1] = a4.y * St[4 * k4 + 1] + k4v.y * vv; o += q4.y * St[4 * k4 + 1];
                    St[4 * k4 + 2] = a4.z * St[4 * k4 + 2] + k4v.z * vv; o += q4.z * St[4 * k4 + 2];
                    St[4 * k4 + 3] = a4.w * St[4 * k4 + 3] + k4v.w * vv; o += q4.w * St[4 * k4 + 3];
                }
                lo[(pl * CH + tk) * 128 + v] = o;
            }
            __syncthreads();
            for (int r = wid; r < 4 * CH; r += 8) {
                const int pp = r / CH, tk = r % CH; const int pb = (it * 4 + pp) >> 2, ph = (it * 4 + pp) & 3;
                const size_t tok = (size_t)pb * S + c0 + tk;
                const float x0 = lo[r * 128 + lane], x1 = lo[r * 128 + 64 + lane];
                const float rstd = rsqrtf(wave_sum(x0 * x0 + x1 * x1) * (1.f / 128.f) + EPS);
                const float r0 = bf2f(HY[tok * HYN + C_RB + ph * 128 + lane]), r1 = bf2f(HY[tok * HYN + C_RB + ph * 128 + 64 + lane]);
                CAT[tok * 1024 + 512 + ph * 128 + lane] = (bf16)f2bf(x0 * rstd * og[lane] * (r0 * sigmoidf_(r0)));
                CAT[tok * 1024 + 512 + ph * 128 + 64 + lane] = (bf16)f2bf(x1 * rstd * og[64 + lane] * (r1 * sigmoidf_(r1)));
            }
        }
        __syncthreads();
    }
}


__device__ __forceinline__ void phase_nsa_attn_mfma(KArgs A, int wv_, int i, LAS unsigned char* lds) {
    const int tid = opaque_tid(wv_), wid = __builtin_amdgcn_readfirstlane(tid >> 6), lane = tid & 63, fr = lane & 15, fq = lane >> 4;
    unsigned char* ws = opq(A->ws);
    const bf16* HY = (const bf16*)(ws + WS_BIG); const bf16* QA = (const bf16*)(ws + WS_QA); const bf16* KS = (const bf16*)(ws + WS_KS); const bf16* KW = (const bf16*)(ws + WS_KW);
    const bf16* KC = (const bf16*)(ws + WS_KC); const bf16* VCT = (const bf16*)(ws + WS_VC); const bf16* VTA = (const bf16*)(ws + WS_VTA); bf16* CAT = (bf16*)(ws + WS_CAT);
    constexpr int RS = 72;
    LAS bf16* ktl = (LAS bf16*)lds;
    LAS bf16* vtl = ktl + 4 * 64 * RS;
    LAS float* scl = (LAS float*)(lds + 73728) + wid * 256;
    LAS unsigned* msk = (LAS unsigned*)(lds + 73728 + 8192);
    LAS unsigned* umask = msk + 64;
    const float* gb = A->in[I_GATEB] + i * 24;
    unsigned long long tsub = 0, tt0 = 0;
    for (int pit = blockIdx.x; pit < 256; pit += gridDim.x) {
#pragma unroll 1
        for (int hf = 0; hf < 2; ++hf) {
            const int bg = pit >> 4, xx = pit & 15, x = hf ? 31 - xx : xx, b = bg >> 1, g = bg & 1;
            const size_t tokbase = (size_t)b * S + 64 * x;
            const int tl0 = 8 * wid + (fr >> 2);
            if (tid == 0) *umask = 0u;
            if (PROBE_NSA == 1) tt0 = __builtin_amdgcn_s_memrealtime();
            bf16x8 qf[2][2];
#pragma unroll
            for (int mt = 0; mt < 2; ++mt)
#pragma unroll
                for (int s = 0; s < 2; ++s) qf[mt][s] = *(const bf16x8*)(QA + (tokbase + tl0 + 4 * mt) * 512 + (g * 4 + (fr & 3)) * 64 + 32 * s + 8 * fq);
            f32x4 outacc[2][4];
            {
                const int tmaxc = (4 * x + 3 + 15) >> 4;
                const bf16* kcb = KC + ((size_t)(b * 128 + fr) * 2 + g) * 64 + 8 * fq;
                bf16x8 pcf[2][4];
#pragma unroll
                for (int mt = 0; mt < 2; ++mt) {
                    f32x4 sc[8];
                    const bf16* kp = kcb;
#pragma unroll
                    for (int t = 0; t < 8; ++t) { sc[t] = (f32x4){0.f, 0.f, 0.f, 0.f};
                        asm volatile("" : "+v"(kp));
                        if (t < tmaxc) {
                            const bf16x8 k0 = *(const bf16x8*)(kp), k1 = *(const bf16x8*)(kp + 32);
                            sc[t] = __builtin_amdgcn_mfma_f32_16x16x32_bf16(k0, qf[mt][0], sc[t], 0, 0, 0);
                            sc[t] = __builtin_amdgcn_mfma_f32_16x16x32_bf16(k1, qf[mt][1], sc[t], 0, 0, 0); }
                        kp += 16 * 128; }
                    const int tg = 64 * x + tl0 + 4 * mt; const int ncv = tg >= 31 ? ((tg - 31) >> 4) + 1 : 0;
                    float mx = -INFINITY;
#pragma unroll
                    for (int t = 0; t < 8; ++t)
#pragma unroll
                        for (int r = 0; r < 4; ++r) { const bool v = 16 * t + 4 * fq + r < ncv; sc[t][r] = v ? sc[t][r] : -INFINITY; mx = fmaxf(mx, sc[t][r]); }
                    mx = fmaxf(mx, __shfl_xor(mx, 16)); mx = fmaxf(mx, __shfl_xor(mx, 32));
                    const float mxs = mx == -INFINITY ? 0.f : mx;
                    float sum = 0.f;
#pragma unroll
                    for (int t = 0; t < 8; ++t)
#pragma unroll
                        for (int r = 0; r < 4; ++r) { sc[t][r] = __builtin_amdgcn_exp2f(sc[t][r] - mxs); sum += sc[t][r]; }
                    sum += __shfl_xor(sum, 16); sum += __shfl_xor(sum, 32);
                    const float inv = sum > 0.f ? 1.f / sum : 0.f;
#pragma unroll
                    for (int t = 0; t < 8; ++t) sc[t] = sc[t] * inv;
#pragma unroll
                    for (int s = 0; s < 4; ++s) { u32x4 w; w.x = pk2(sc[2 * s].x, sc[2 * s].y); w.y = pk2(sc[2 * s].z, sc[2 * s].w); w.z = pk2(sc[2 * s + 1].x, sc[2 * s + 1].y); w.w = pk2(sc[2 * s + 1].z, sc[2 * s + 1].w);
                        pcf[mt][s] = __builtin_bit_cast(bf16x8, w); }
                    float w3[8];
#pragma unroll
                    for (int t = 0; t < 8; ++t) {
#pragma unroll
                        for (int r = 0; r < 4; ++r) { float v = sc[t][r]; v += __shfl_xor(v, 1); v += __shfl_xor(v, 2); sc[t][r] = v; }
                        w3[t] = __shfl(sc[t].w, (lane + 48) & 63);
                    }
#pragma unroll
                    for (int t = 0; t < 8; ++t) {
                        const float prev = fq > 0 ? w3[t] : (t > 0 ? w3[t > 0 ? t - 1 : 0] : 0.f);
                        const float imp = sc[t].x + sc[t].y + sc[t].z + 0.5f * sc[t].w + 0.5f * prev;
                        if ((fr & 3) == 0) scl[(4 * mt + (fr >> 2)) * 32 + 4 * t + fq] = imp;
                    }
                    asm volatile("" ::: "memory");
                }
                const bf16* vcb = VCT + ((size_t)(b * 2 + g) * 64 + fr) * 128 + 8 * fq;
#pragma unroll
                for (int n = 0; n < 4; ++n) {
                    outacc[0][n] = (f32x4){0.f, 0.f, 0.f, 0.f}; outacc[1][n] = (f32x4){0.f, 0.f, 0.f, 0.f};
                    asm volatile("" : "+v"(vcb));
#pragma unroll
                    for (int s = 0; s < 4; ++s) if (2 * s < tmaxc) {
                        const bf16x8 vf = *(const bf16x8*)(vcb + 32 * s);
                        outacc[0][n] = __builtin_amdgcn_mfma_f32_16x16x32_bf16(vf, pcf[0][s], outacc[0][n], 0, 0, 0);
                        outacc[1][n] = __builtin_amdgcn_mfma_f32_16x16x32_bf16(vf, pcf[1][s], outacc[1][n], 0, 0, 0); }
                    vcb += 16 * 128;
                    asm volatile("" ::: "memory");
                }
            }
            float g1v[2], g2v[2];
#pragma unroll
            for (int mt = 0; mt < 2; ++mt) {
                const int head = g * 4 + (fr & 3);
                const bf16* gl = HY + (tokbase + tl0 + 4 * mt) * HYN + C_GA + head * 3;
                const float g0 = sigmoidf_(bf2f(gl[0]) + gb[head * 3 + 0]);
                g1v[mt] = sigmoidf_(bf2f(gl[1]) + gb[head * 3 + 1]); g2v[mt] = sigmoidf_(bf2f(gl[2]) + gb[head * 3 + 2]);
#pragma unroll
                for (int n = 0; n < 4; ++n) outacc[mt][n] = outacc[mt][n] * g0;
            }
            LDS_WAIT();
            asm volatile("" ::: "memory");
            {
                const int tok8 = lane >> 3, jg = lane & 7;
                float sj[32];
#pragma unroll
                for (int q = 0; q < 8; ++q) { const f32x4 v = *(const LAS f32x4*)(scl + tok8 * 32 + 4 * q); sj[4 * q] = v.x; sj[4 * q + 1] = v.y; sj[4 * q + 2] = v.z; sj[4 * q + 3] = v.w; }
#pragma unroll
                for (int j = 0; j < 32; ++j) sj[j] = j <= x ? sj[j] + ((j == 0 || j == x || j == x - 1) ? 1000.0f : 0.f) : -INFINITY;
                unsigned bits = 0u;
                const f32x4 mv = *(const LAS f32x4*)(scl + tok8 * 32 + 4 * jg);
#pragma unroll
                for (int q = 0; q < 4; ++q) {
                    const int j = 4 * jg + q;
                    const float mine = j <= x ? mv[q] + ((j == 0 || j == x || j == x - 1) ? 1000.0f : 0.f) : -INFINITY;
                    int rank = 0;
#pragma unroll
                    for (int jj = 0; jj < 32; ++jj) rank += (sj[jj] > mine || (sj[jj] == mine && jj < j)) ? 1 : 0;
                    bits |= (j <= x && rank < 8) ? (1u << j) : 0u;
                }
                bits |= __shfl_xor(bits, 1); bits |= __shfl_xor(bits, 2); bits |= __shfl_xor(bits, 4);
                if (jg == 0) { msk[wid * 8 + tok8] = bits; atomicOr((unsigned*)umask, bits); }
            }
            __syncthreads();
            if (PROBE_NSA == 1) tsub += __builtin_amdgcn_s_memrealtime() - tt0;
#pragma unroll 1
            for (int pass = 0; pass < 2; ++pass) {
                if (PROBE_NSA == 2 + pass) tt0 = __builtin_amdgcn_s_memrealtime();
                const int jlo = pass ? (x >= 4 ? x - 4 : 0) : 0;
                const unsigned inrange = (x >= 31 ? 0xffffffffu : ((2u << x) - 1u)) & ~((1u << jlo) - 1u);
                unsigned bmask = pass ? inrange : (*umask & inrange);
                const bf16* Kb = pass ? KW : KS; const int cg = (pass ? 10 : 8) + g;
                unsigned tm[2], wm[2], am[2];
#pragma unroll
                for (int mt = 0; mt < 2; ++mt) {
                    tm[mt] = pass ? 0xffffffffu : msk[wid * 8 + 4 * mt + (fr >> 2)];
                    wm[mt] = pass ? 0xffffffffu : (msk[wid * 8 + 4 * mt] | msk[wid * 8 + 4 * mt + 1] | msk[wid * 8 + 4 * mt + 2] | msk[wid * 8 + 4 * mt + 3]);
                    am[mt] = pass ? 0xffffffffu : (msk[wid * 8 + 4 * mt] & msk[wid * 8 + 4 * mt + 1] & msk[wid * 8 + 4 * mt + 2] & msk[wid * 8 + 4 * mt + 3]);
                    wm[mt] = __builtin_amdgcn_readfirstlane(wm[mt]); am[mt] = __builtin_amdgcn_readfirstlane(am[mt]);
                }
                f32x4 o[2][4]; float mrun[2], lrun[2];
#pragma unroll
                for (int mt = 0; mt < 2; ++mt) { mrun[mt] = -INFINITY; lrun[mt] = 0.f;
#pragma unroll
                    for (int n = 0; n < 4; ++n) o[mt][n] = (f32x4){0.f, 0.f, 0.f, 0.f}; }
                const int srow = tid >> 3, sc16 = tid & 7;
                u32x4 pk0 = (u32x4){0u, 0u, 0u, 0u}, pv0 = pk0, pk1 = pk0, pv1 = pk0;
#define NSA_LD(jx, pk, pv) do { const bf16* ksrc = Kb + ((size_t)b * S + 64 * (jx) + srow) * 128 + g * 64 + sc16 * 8; const bf16* vsrc = VTA + ((size_t)((b * 32 + (jx)) * 12 + cg)) * 4096 + srow * 64 + sc16 * 8; \
                    pk = *(const u32x4*)ksrc; pv = *(const u32x4*)vsrc; } while (0)
                int j0 = __ffs(bmask) - 1; bmask &= bmask - 1u;
                int j1 = bmask ? __ffs(bmask) - 1 : -1; bmask &= bmask - 1u;
                NSA_LD(j0, pk0, pv0); if (j1 >= 0) NSA_LD(j1, pk1, pv1);
                int buf = 0;
                while (j0 >= 0) {
                    *(LAS u32x4*)(ktl + (buf * 2 + 0) * 64 * RS + srow * RS + sc16 * 8) = pk0; *(LAS u32x4*)(vtl + (buf * 2 + 0) * 64 * RS + srow * RS + sc16 * 8) = pv0;
                    if (j1 >= 0) { *(LAS u32x4*)(ktl + (buf * 2 + 1) * 64 * RS + srow * RS + sc16 * 8) = pk1; *(LAS u32x4*)(vtl + (buf * 2 + 1) * 64 * RS + srow * RS + sc16 * 8) = pv1; }
                    const int jn0 = bmask ? __ffs(bmask) - 1 : -1; bmask &= bmask - 1u;
                    const int jn1 = bmask ? __ffs(bmask) - 1 : -1; bmask &= bmask - 1u;
                    if (jn0 >= 0) NSA_LD(jn0, pk0, pv0);
                    if (jn1 >= 0) NSA_LD(jn1, pk1, pv1);
                    __syncthreads();
#pragma unroll 1
                    for (int sub = 0; sub < 2; ++sub) {
                        const int j = sub ? j1 : j0;
                        if (j < 0) break;
                        const LAS bf16* kt = ktl + (buf * 2 + sub) * 64 * RS + fr * RS + 8 * fq; const LAS bf16* vt = vtl + (buf * 2 + sub) * 64 * RS + fr * RS + 8 * fq;
#pragma unroll
                        for (int mt = 0; mt < 2; ++mt) {
                            if (!((wm[mt] >> j) & 1u)) continue;
                            f32x4 sc[4];
#pragma unroll
                            for (int t = 0; t < 4; ++t) { sc[t] = (f32x4){0.f, 0.f, 0.f, 0.f};
                                sc[t] = __builtin_amdgcn_mfma_f32_16x16x32_bf16(*(const LAS bf16x8*)(kt + t * 16 * RS), qf[mt][0], sc[t], 0, 0, 0);
                                sc[t] = __builtin_amdgcn_mfma_f32_16x16x32_bf16(*(const LAS bf16x8*)(kt + t * 16 * RS + 32), qf[mt][1], sc[t], 0, 0, 0); }
                            const int tl = tl0 + 4 * mt;
                            const bool rowok = (tm[mt] >> j) & 1u;
                            const bool edge = (j == x) || (pass && j == x - 4);
                            float bm = -INFINITY;
                            if (edge) {
                                const int kphi = j == x ? tl : 63;
                                const int kplo = (pass && j == x - 4) ? tl + 1 : 0;
#pragma unroll
                                for (int t = 0; t < 4; ++t)
#pragma unroll
                                    for (int r = 0; r < 4; ++r) { const int kp = 16 * t + 4 * fq + r; const bool v = rowok && kp <= kphi && kp >= kplo; sc[t][r] = v ? sc[t][r] : -INFINITY; bm = fmaxf(bm, sc[t][r]); }
                            } else {
#pragma unroll
                                for (int t = 0; t < 4; ++t) bm = fmaxf(bm, fmaxf(fmaxf(sc[t].x, sc[t].y), fmaxf(sc[t].z, sc[t].w)));
                                if (!((am[mt] >> j) & 1u)) bm = rowok ? bm : -INFINITY;
                            }
                            bm = fmaxf(bm, __shfl_xor(bm, 16)); bm = fmaxf(bm, __shfl_xor(bm, 32));
                            const float mn = fmaxf(mrun[mt], bm); const float mns = mn == -INFINITY ? 0.f : mn;
                            float rs = 0.f;
#pragma unroll
                            for (int t = 0; t < 4; ++t)
#pragma unroll
                                for (int r = 0; r < 4; ++r) { sc[t][r] = __builtin_amdgcn_exp2f(sc[t][r] - mns); rs += sc[t][r]; }
                            if (!edge && !((am[mt] >> j) & 1u)) {
#pragma unroll
                                for (int t = 0; t < 4; ++t) sc[t] = rowok ? sc[t] : (f32x4){0.f, 0.f, 0.f, 0.f};
                                rs = rowok ? rs : 0.f;
                            }
                            rs += __shfl_xor(rs, 16); rs += __shfl_xor(rs, 32);
                            if (__all(mn == mrun[mt])) { lrun[mt] += rs; }
                            else {
                                const float alpha = __builtin_amdgcn_exp2f(mrun[mt] - mns);
                                lrun[mt] = lrun[mt] * alpha + rs; mrun[mt] = mn;
#pragma unroll
                                for (int n = 0; n < 4; ++n) o[mt][n] = o[mt][n] * alpha;
                            }
                            bf16x8 pf[2];
#pragma unroll
                            for (int s = 0; s < 2; ++s) { u32x4 w; w.x = pk2(sc[2 * s].x, sc[2 * s].y); w.y = pk2(sc[2 * s].z, sc[2 * s].w); w.z = pk2(sc[2 * s + 1].x, sc[2 * s + 1].y); w.w = pk2(sc[2 * s + 1].z, sc[2 * s + 1].w);
                                pf[s] = __builtin_bit_cast(bf16x8, w); }
#pragma unroll
                            for (int n = 0; n < 4; ++n) {
                                o[mt][n] = __builtin_amdgcn_mfma_f32_16x16x32_bf16(*(const LAS bf16x8*)(vt + n * 16 * RS), pf[0], o[mt][n], 0, 0, 0);
                                o[mt][n] = __builtin_amdgcn_mfma_f32_16x16x32_bf16(*(const LAS bf16x8*)(vt + n * 16 * RS + 32), pf[1], o[mt][n], 0, 0, 0); }
                        }
                    }
                    j0 = jn0; j1 = jn1; buf ^= 1;
                }
#undef NSA_LD
#pragma unroll
                for (int mt = 0; mt < 2; ++mt) { const float sc_ = (pass ? g2v[mt] : g1v[mt]) / lrun[mt];
#pragma unroll
                    for (int n = 0; n < 4; ++n) outacc[mt][n] = outacc[mt][n] + o[mt][n] * sc_; }
                __syncthreads();
                if (PROBE_NSA == 2 + pass) tsub += __builtin_amdgcn_s_memrealtime() - tt0;
            }
#pragma unroll
            for (int mt = 0; mt < 2; ++mt) {
                bf16* dst = CAT + (tokbase + tl0 + 4 * mt) * 1024 + (g * 4 + (fr & 3)) * 64 + 4 * fq;
#pragma unroll
                for (int n = 0; n < 4; ++n) { u32x2 w; w.x = pk2(outacc[mt][n].x, outacc[mt][n].y); w.y = pk2(outacc[mt][n].z, outacc[mt][n].w); *(u32x2*)(dst + 16 * n) = w; }
            }
        }
    }
    __syncthreads();
    if (PROBE_NSA && blockIdx.x == 0 && tid == 0) atomicAdd((unsigned long long*)(ws + WS_CTL + 48000), tsub);
}

__device__ __forceinline__ void phase_vtiles(KArgs A, int wv_, LAS unsigned char* lds) {
    const int tid_ = opaque_tid(wv_); const int wid = __builtin_amdgcn_readfirstlane(tid_ >> 6), lane = tid_ & 63; const int gw = blockIdx.x * 8 + wid, NGW = gridDim.x * 8;
    unsigned char* ws = opq(A->ws);
    const bf16* HY = (const bf16*)(ws + WS_BIG); bf16* VTA = (bf16*)(ws + WS_VTA);
    constexpr int TS = 66;
    LAS bf16* tl = (LAS bf16*)(lds + 65536) + wid * (64 * TS);
    for (int it = gw; it < NBATCH * 32 * 12; it += NGW) {
        const int cg = it % 12, bc = it / 12;
        const int colbase = cg < 8 ? C_VB + cg * 64 : (cg < 10 ? C_VS + (cg - 8) * 64 : C_VW + (cg - 10) * 64);
        const u32x4* src = (const u32x4*)(HY + (size_t)(bc * 64 + lane) * HYN + colbase);
        u32x4 w[8];
#pragma unroll
        for (int i = 0; i < 8; ++i) w[i] = src[i];
#pragma unroll
        for (int i = 0; i < 8; ++i) { LAS unsigned* d = (LAS unsigned*)(tl + lane * TS + 8 * i); d[0] = w[i].x; d[1] = w[i].y; d[2] = w[i].z; d[3] = w[i].w; }
        LDS_WAIT();
        bf16* dst = VTA + (size_t)it * 4096 + lane * 64;
#pragma unroll
        for (int p8 = 0; p8 < 8; ++p8) {
            unsigned short x[8];
#pragma unroll
            for (int j = 0; j < 8; ++j) x[j] = tl[kperm64(p8 * 8 + j) * TS + lane];
            u32x4 o; o.x = x[0] | ((unsigned)x[1] << 16); o.y = x[2] | ((unsigned)x[3] << 16); o.z = x[4] | ((unsigned)x[5] << 16); o.w = x[6] | ((unsigned)x[7] << 16);
            *(u32x4*)(dst + p8 * 8) = o;
        }
        LDS_WAIT();
    }
}

__device__ __forceinline__ float log_sigmoid16(float z) { return (fminf(z, 0.f) - __logf(1.0f + __expf(-fabsf(z)))) * (1.f / 16.f); }
#define GLA_Z(tokv) ({ float z_ = bias; _Pragma("unroll") for (int r_ = 0; r_ < 16; ++r_) z_ += __builtin_bit_cast(float, __builtin_amdgcn_readlane(__builtin_bit_cast(int, al[r_]), (tokv))) * wc[r_]; z_; })
#define GLA_LOAD_GATE() \
    float al[16], wc[16]; \
    { const u32x4* ap_ = (const u32x4*)(HY + (size_t)(tok0 + lane) * HYN + C_AL); const u32x4 a0_ = ap_[0], a1_ = ap_[1]; \
      al[0] = bflo(a0_.x); al[1] = bfhi(a0_.x); al[2] = bflo(a0_.y); al[3] = bfhi(a0_.y); al[4] = bflo(a0_.z); al[5] = bfhi(a0_.z); al[6] = bflo(a0_.w); al[7] = bfhi(a0_.w); \
      al[8] = bflo(a1_.x); al[9] = bfhi(a1_.x); al[10] = bflo(a1_.y); al[11] = bfhi(a1_.y); al[12] = bflo(a1_.z); al[13] = bfhi(a1_.z); al[14] = bflo(a1_.w); al[15] = bfhi(a1_.w); } \
    _Pragma("unroll") for (int r_ = 0; r_ < 16; ++r_) wc[r_] = A->in[I_WA2][(i * 16 + r_) * 256 + h * 64 + lane]; \
    const float bias = A->in[I_BA][i * 256 + h * 64 + lane];

__device__ __forceinline__ void phase_gla_a(KArgs A, int wv_, int i, LAS unsigned char* lds) {
    const int tid_ = opaque_tid(wv_); const int wid = __builtin_amdgcn_readfirstlane(tid_ >> 6), lane = tid_ & 63, fr = lane & 15, fq = lane >> 4; const int gw = blockIdx.x * 8 + wid, NGW = gridDim.x * 8;
    unsigned char* ws = opq(A->ws);
    const bf16* HY = (const bf16*)(ws + WS_BIG); const bf16* VTA = (const bf16*)(ws + WS_VTA); float* SLOC = (float*)(ws + WS_SLOC); float* DEC = (float*)(ws + WS_DEC);
    constexpr int RS = 72;
    LAS bf16* kh = (LAS bf16*)lds + wid * (64 * RS);
    (void)gw;
    for (int it = wid * (int)gridDim.x + (int)blockIdx.x; it < 1024; it += NGW) {
        const int c = it & 31, bh = it >> 5, b = bh >> 2, h = bh & 3; const size_t tok0 = (size_t)b * S + c * 64;
        GLA_LOAD_GATE();
        float bl = 0.f;
#pragma unroll 8
        for (int tk = 0; tk < 64; ++tk) bl += log_sigmoid16(GLA_Z(tk));
        float bc = 0.f;
        unsigned short kcol[64];
#pragma unroll
        for (int tk = 0; tk < 64; ++tk) kcol[tk] = HY[(tok0 + tk) * HYN + C_KB + h * 64 + lane];
#pragma unroll
        for (int tk = 0; tk < 64; ++tk) {
            bc += log_sigmoid16(GLA_Z(tk));
            kh[lane * RS + kpos64(tk)] = (bf16)f2bf(bf2f(kcol[tk]) * __expf(bl - bc));
        }
        DEC[it * 64 + lane] = __expf(bl);
        LDS_WAIT();
#pragma unroll
        for (int dvh = 0; dvh < 2; ++dvh) {
            const bf16* vt = VTA + ((size_t)((b * 32 + c) * 12 + h * 2 + dvh)) * 4096;
            bf16x8 vf[4][2];
#pragma unroll
            for (int n = 0; n < 4; ++n)
#pragma unroll
                for (int s = 0; s < 2; ++s) vf[n][s] = *(const bf16x8*)(vt + (16 * n + fr) * 64 + 32 * s + 8 * fq);
#pragma unroll
            for (int m = 0; m < 4; ++m) {
                const bf16x8 a0 = *(const LAS bf16x8*)(kh + (16 * m + fr) * RS + 8 * fq), a1 = *(const LAS bf16x8*)(kh + (16 * m + fr) * RS + 32 + 8 * fq);
#pragma unroll
                for (int n = 0; n < 4; ++n) {
                    f32x4 acc = (f32x4){0.f, 0.f, 0.f, 0.f};
                    acc = __builtin_amdgcn_mfma_f32_16x16x32_bf16(a0, vf[n][0], acc, 0, 0, 0);
                    acc = __builtin_amdgcn_mfma_f32_16x16x32_bf16(a1, vf[n][1], acc, 0, 0, 0);
                    float* dst = SLOC + ((size_t)it * 64 + 16 * m + 4 * fq) * 128 + dvh * 64 + 16 * n + fr;
                    dst[0] = acc.x; dst[128] = acc.y; dst[256] = acc.z; dst[384] = acc.w;
                }
            }
        }
        LDS_WAIT();
    }
}
__device__ __forceinline__ void phase_gla_c(KArgs A, int wv_, int i, LAS unsigned char* lds) {
    const int tid_ = opaque_tid(wv_); const int wid = __builtin_amdgcn_readfirstlane(tid_ >> 6), lane = tid_ & 63, fr = lane & 15, fq = lane >> 4; const int gw = blockIdx.x * 8 + wid, NGW = gridDim.x * 8;
    unsigned char* ws = opq(A->ws);
    const bf16* HY = (const bf16*)(ws + WS_BIG); const bf16* VTA = (const bf16*)(ws + WS_VTA); const bf16* STT = (const bf16*)(ws + WS_STT); bf16* CAT = (bf16*)(ws + WS_CAT);
    constexpr int RS = 72;
    LAS bf16* qs = (LAS bf16*)lds + wid * (128 * RS);
    LAS bf16* ks = qs + 64 * RS;
    const float* og = A->in[I_ONORM] + i * 128;
    LAS float* ogl = (LAS float*)(lds + 8 * 128 * RS * 2);
    if (tid_ < 128) ogl[tid_] = og[tid_];
    (void)gw; (void)NGW;
    for (int blk = blockIdx.x; blk < 256; blk += gridDim.x) {
        SUBT_BEGIN(1);
        {
            const float* SLOC = (const float*)(ws + WS_SLOC); const float* DEC = (const float*)(ws + WS_DEC); bf16* STw = (bf16*)(ws + WS_STT);
            const int tid = tid_, dv = tid & 127, ko = tid >> 7, bh = blk >> 3, c0 = (blk & 7) * 4;
            float sv[16];
#pragma unroll
            for (int j = 0; j < 16; ++j) sv[j] = 0.f;
#pragma unroll 1
            for (int cb = 0; cb < c0 + 4; cb += 4) {
                float dc4[4][16], sl4[4][16];
#pragma unroll
                for (int q = 0; q < 4; ++q) {
                    const size_t item = (size_t)bh * 32 + cb + q; const float* sl = SLOC + (item * 64 + ko * 16) * 128 + dv; const float* dc = DEC + item * 64 + ko * 16;
#pragma unroll
                    for (int j = 0; j < 16; ++j) { dc4[q][j] = dc[j]; sl4[q][j] = sl[j * 128]; }
                }
#pragma unroll
                for (int q = 0; q < 4; ++q) {
                    const int c = cb + q; const size_t item = (size_t)bh * 32 + c;
                    if (c >= c0) {
                        u32x4 o0, o1; o0.x = pk2(sv[0], sv[1]); o0.y = pk2(sv[2], sv[3]); o0.z = pk2(sv[4], sv[5]); o0.w = pk2(sv[6], sv[7]);
                        o1.x = pk2(sv[8], sv[9]); o1.y = pk2(sv[10], sv[11]); o1.z = pk2(sv[12], sv[13]); o1.w = pk2(sv[14], sv[15]);
                        u32x4* d = (u32x4*)(STw + (item * 128 + dv) * 64 + ko * 16); d[0] = o0; d[1] = o1;
                    }
#pragma unroll
                    for (int j = 0; j < 16; ++j) sv[j] = dc4[q][j] * sv[j] + sl4[q][j];
                }
            }
            asm volatile("s_waitcnt vmcnt(0)" ::: "memory");
            __syncthreads();
        }
        SUBT_END(1, ws, tid_);
        SUBT_BEGIN(2);
        SUBT_BEGIN(3);
        if (wid < 4) {
        const int it = blk * 4 + wid;
        const int c = it & 31, bh = it >> 5, b = bh >> 2, h = bh & 3; const size_t tok0 = (size_t)b * S + c * 64;
        GLA_LOAD_GATE();
        float bc = 0.f;
        unsigned short qcol[64], kcol[64];
#pragma unroll
        for (int tk = 0; tk < 64; ++tk) { const bf16* row = HY + (tok0 + tk) * HYN; qcol[tk] = row[C_QB + h * 64 + lane]; kcol[tk] = row[C_KB + h * 64 + lane]; }
#pragma unroll
        for (int tk = 0; tk < 64; ++tk) {
            bc += log_sigmoid16(GLA_Z(tk));
            const float eb = __expf(bc);
            qs[tk * RS + lane] = (bf16)f2bf(bf2f(qcol[tk]) * 0.125f * eb); ks[tk * RS + lane] = (bf16)f2bf(bf2f(kcol[tk]) / eb);
        }
        LDS_WAIT();
        SUBT_END(2, ws, tid_);
        bf16x8 st[8][2];
#pragma unroll
        for (int n = 0; n < 8; ++n)
#pragma unroll
            for (int s = 0; s < 2; ++s) st[n][s] = *(const bf16x8*)(STT + ((size_t)it * 128 + 16 * n + fr) * 64 + 32 * s + 8 * fq);
        const bf16* vt = VTA + ((size_t)((b * 32 + c) * 12 + h * 2)) * 4096;
        bf16x8 vfr[8][2];
#pragma unroll
        for (int n = 0; n < 8; ++n) { const bf16* vrow = vt + (size_t)(n >> 2) * 4096 + (16 * (n & 3) + fr) * 64 + 8 * fq; vfr[n][0] = *(const bf16x8*)vrow; vfr[n][1] = *(const bf16x8*)(vrow + 32); }
#pragma unroll
        for (int mi = 0; mi < 4; ++mi) {
            const bf16x8 q0 = *(const LAS bf16x8*)(qs + (16 * mi + fr) * RS + 8 * fq), q1 = *(const LAS bf16x8*)(qs + (16 * mi + fr) * RS + 32 + 8 * fq);
            u32x2 rwv[8];
#pragma unroll
            for (int n = 0; n < 8; ++n) rwv[n] = *(const u32x2*)(HY + (tok0 + 16 * mi + fr) * HYN + C_RB + h * 128 + 16 * n + 4 * fq);
            f32x4 sc[4];
#pragma unroll
            for (int t = 0; t < 4; ++t) {
                sc[t] = (f32x4){0.f, 0.f, 0.f, 0.f};
                if (t <= mi) {
                    const bf16x8 k0 = *(const LAS bf16x8*)(ks + (16 * t + fr) * RS + 8 * fq), k1 = *(const LAS bf16x8*)(ks + (16 * t + fr) * RS + 32 + 8 * fq);
                    sc[t] = __builtin_amdgcn_mfma_f32_16x16x32_bf16(k0, q0, sc[t], 0, 0, 0);
                    sc[t] = __builtin_amdgcn_mfma_f32_16x16x32_bf16(k1, q1, sc[t], 0, 0, 0);
                    if (t == mi) {
                        sc[t].x = (4 * fq + 0 <= fr) ? sc[t].x : 0.f; sc[t].y = (4 * fq + 1 <= fr) ? sc[t].y : 0.f; sc[t].z = (4 * fq + 2 <= fr) ? sc[t].z : 0.f; sc[t].w = (4 * fq + 3 <= fr) ? sc[t].w : 0.f; }
                }
            }
            bf16x8 pf[2];
#pragma unroll
            for (int s = 0; s < 2; ++s) { u32x4 w; w.x = pk2(sc[2 * s].x, sc[2 * s].y); w.y = pk2(sc[2 * s].z, sc[2 * s].w); w.z = pk2(sc[2 * s + 1].x, sc[2 * s + 1].y); w.w = pk2(sc[2 * s + 1].z, sc[2 * s + 1].w);
                pf[s] = __builtin_bit_cast(bf16x8, w); }
            f32x4 o[8]; float ssq = 0.f;
#pragma unroll
            for (int n = 0; n < 8; ++n) {
                o[n] = (f32x4){0.f, 0.f, 0.f, 0.f};
                o[n] = __builtin_amdgcn_mfma_f32_16x16x32_bf16(st[n][0], q0, o[n], 0, 0, 0);
                o[n] = __builtin_amdgcn_mfma_f32_16x16x32_bf16(st[n][1], q1, o[n], 0, 0, 0);
                o[n] = __builtin_amdgcn_mfma_f32_16x16x32_bf16(vfr[n][0], pf[0], o[n], 0, 0, 0);
                if (mi >= 2) o[n] = __builtin_amdgcn_mfma_f32_16x16x32_bf16(vfr[n][1], pf[1], o[n], 0, 0, 0);
                ssq += (o[n].x * o[n].x + o[n].y * o[n].y) + (o[n].z * o[n].z + o[n].w * o[n].w);
            }
            ssq += __shfl_xor(ssq, 16); ssq += __shfl_xor(ssq, 32);
            const float rstd = rsqrtf(ssq * (1.f / 128.f) + EPS);
            const size_t tok = tok0 + 16 * mi + fr;
#pragma unroll
            for (int n = 0; n < 8; ++n) {
                const int dv = 16 * n + 4 * fq;
                const u32x2 rw = rwv[n]; const f32x4 g = *(const LAS f32x4*)(ogl + dv);
                const float r0 = bflo(rw.x), r1 = bfhi(rw.x), r2 = bflo(rw.y), r3 = bfhi(rw.y);
                u32x2 w; w.x = pk2(o[n].x * rstd * g.x * (r0 * sigmoidf_(r0)), o[n].y * rstd * g.y * (r1 * sigmoidf_(r1)));
                w.y = pk2(o[n].z * rstd * g.z * (r2 * sigmoidf_(r2)), o[n].w * rstd * g.w * (r3 * sigmoidf_(r3)));
                *(u32x2*)(CAT + tok * 1024 + 512 + h * 128 + dv) = w;
            }
        }
        }
        SUBT_END(3, ws, tid_);
        LDS_WAIT();
        __syncthreads();
    }
}

__device__ __forceinline__ void phase_sgu_mix(KArgs A, int wv_, int i, LAS unsigned char* lds) {
    const int tid = opaque_tid(wv_), wid = __builtin_amdgcn_readfirstlane(tid >> 6), lane = tid & 63;
    unsigned char* ws = opq(A->ws);
    const bf16* U = (const bf16*)(ws + WS_U); const bf16* V = (const bf16*)(ws + WS_V); bf16* UM = (bf16*)(ws + WS_UM);
    LAS float* vt = (LAS float*)lds;
    LAS float* st = vt + 128 * 256;
    const float* lng = A->in[I_LNG] + i * 2048; const float* lnb = A->in[I_LNB] + i * 2048;
    for (int it = blockIdx.x; it < NBATCH * 16 * 8; it += gridDim.x) {
        const int g = it & 7, n = (it >> 3) & 15, b = it >> 7;
        const size_t tok0 = (size_t)b * S + n * 128;
        __syncthreads();
        for (int s = wid * 16; s < wid * 16 + 16; ++s) {
            const u32x4* vr = (const u32x4*)(V + (tok0 + s) * 2048) + lane;
            float x[32]; float sum = 0.f;
#pragma unroll
            for (int j = 0; j < 4; ++j) { const u32x4 w = vr[64 * j];
                x[8 * j + 0] = bflo(w.x); x[8 * j + 1] = bfhi(w.x); x[8 * j + 2] = bflo(w.y); x[8 * j + 3] = bfhi(w.y); x[8 * j + 4] = bflo(w.z); x[8 * j + 5] = bfhi(w.z); x[8 * j + 6] = bflo(w.w); x[8 * j + 7] = bfhi(w.w); }
#pragma unroll
            for (int j = 0; j < 32; ++j) sum += x[j];
            const float mean = wave_sum(sum) * (1.f / 2048.f); float q = 0.f;
#pragma unroll
            for (int j = 0; j < 32; ++j) { const float d = x[j] - mean; q += d * d; }
            const float rstd = rsqrtf(wave_sum(q) * (1.f / 2048.f) + EPS);
            const u32x2 w = *((const u32x2*)(V + (tok0 + s) * 2048 + g * 256) + lane);
            const f32x4 gg = *(const f32x4*)(lng + g * 256 + 4 * lane), bb = *(const f32x4*)(lnb + g * 256 + 4 * lane);
            f32x4 o; o.x = (bflo(w.x) - mean) * rstd * gg.x + bb.x; o.y = (bfhi(w.x) - mean) * rstd * gg.y + bb.y; o.z = (bflo(w.y) - mean) * rstd * gg.z + bb.z; o.w = (bfhi(w.y) - mean) * rstd * gg.w + bb.w;
            *(LAS f32x4*)(vt + s * 256 + 4 * lane) = o;
            (void)st;
        }
        __syncthreads();
        const int c = tid & 255, th = tid >> 8;
        const float* wsg = A->in[I_SGWS] + (size_t)(i * 8 + g) * 128 * 128; const float* bsg = A->in[I_SGBS] + (i * 8 + g) * 128;
        for (int tt = 0; tt < 64; ++tt) {
            const int t = 2 * tt + th;
            const float* wr = wsg + t * 128;
            float acc = 0.f;
            for (int s = 0; s <= t; ++s) acc += wr[s] * vt[s * 256 + c];
            acc += bsg[t];
            const float u = bf2f(U[(tok0 + t) * 2048 + g * 256 + c]);
            UM[(tok0 + t) * 2048 + g * 256 + c] = (bf16)f2bf(u * acc);
        }
    }
    __syncthreads();
}


__device__ __forceinline__ void phase_sgu_mix_mfma(KArgs A, int wv_, int i, LAS unsigned char* lds) {
    const int tid = opaque_tid(wv_), wid = __builtin_amdgcn_readfirstlane(tid >> 6), lane = tid & 63, fr = lane & 15, fq = lane >> 4;
    unsigned char* ws = opq(A->ws);
    const bf16* U = (const bf16*)(ws + WS_U); const bf16* V = (const bf16*)(ws + WS_V); bf16* UM = (bf16*)(ws + WS_UM);
    const bf16* WSB = (const bf16*)(ws + WS_WSB) + (size_t)i * 8 * 16384; const float* M0 = (const float*)(ws + WS_M0) + i * 8 * 128;
    constexpr int VS = 136;
    LAS bf16* vT = (LAS bf16*)lds;
    LAS float* st = (LAS float*)(lds + 256 * VS * 2);
    LAS bf16* wl = (LAS bf16*)(lds + 256 * VS * 2 + 1024);
    const float* lng = A->in[I_LNG] + i * 2048; const float* lnb = A->in[I_LNB] + i * 2048; const float* bsg = A->in[I_SGBS] + i * 8 * 128;
    for (int it = blockIdx.x; it < 256; it += gridDim.x) {
        const int gh = it & 1, n_ = (it >> 1) & 15, b = it >> 5; const size_t tok0 = (size_t)b * S + n_ * 128;
        __syncthreads();
        for (int s4 = wid * 16; s4 < wid * 16 + 16; s4 += 4) {
            u32x4 w[4][4];
#pragma unroll
            for (int rr = 0; rr < 4; ++rr) { const u32x4* vr = (const u32x4*)(V + (tok0 + s4 + rr) * 2048) + lane;
#pragma unroll
                for (int j = 0; j < 4; ++j) w[rr][j] = vr[64 * j]; }
#pragma unroll
            for (int rr = 0; rr < 4; ++rr) {
                float sum = 0.f, sq = 0.f;
#pragma unroll
                for (int j = 0; j < 4; ++j) { const float x0 = bflo(w[rr][j].x), x1 = bfhi(w[rr][j].x), x2 = bflo(w[rr][j].y), x3 = bfhi(w[rr][j].y), x4 = bflo(w[rr][j].z), x5 = bfhi(w[rr][j].z), x6 = bflo(w[rr][j].w), x7 = bfhi(w[rr][j].w);
                    sum += ((x0 + x1) + (x2 + x3)) + ((x4 + x5) + (x6 + x7)); sq += ((x0 * x0 + x1 * x1) + (x2 * x2 + x3 * x3)) + ((x4 * x4 + x5 * x5) + (x6 * x6 + x7 * x7)); }
                sum = wave_sum(sum); sq = wave_sum(sq);
                const float mean = sum * (1.f / 2048.f); const float var = fmaxf(sq * (1.f / 2048.f) - mean * mean, 0.f);
                if (lane == 0) { st[2 * (s4 + rr)] = mean; st[2 * (s4 + rr) + 1] = rsqrtf(var + EPS); }
            }
        }
#pragma unroll 1
        for (int gg = 0; gg < 4; ++gg) {
            const int g = gh * 4 + gg;
            __syncthreads();
            {
                const int s = tid & 127, cq = tid >> 7;
                const float mean = st[2 * s], rstd = st[2 * s + 1];
                const u32x4* src = (const u32x4*)(V + (tok0 + s) * 2048 + g * 256 + cq * 64);
                u32x4 w8[8], ww[4];
#pragma unroll
                for (int i8 = 0; i8 < 8; ++i8) w8[i8] = src[i8];
#pragma unroll
                for (int q = 0; q < 4; ++q) { const int e = tid + 512 * q; ww[q] = *(const u32x4*)(WSB + ((size_t)g * 128 + (e >> 4)) * 128 + (e & 15) * 8); }
#pragma unroll
                for (int i8 = 0; i8 < 8; ++i8) {
                    const u32x4 w = w8[i8];
                    LAS bf16* d = vT + (cq * 64 + i8 * 8) * VS + s;
                    d[0 * VS] = (bf16)f2bf((bflo(w.x) - mean) * rstd); d[1 * VS] = (bf16)f2bf((bfhi(w.x) - mean) * rstd); d[2 * VS] = (bf16)f2bf((bflo(w.y) - mean) * rstd); d[3 * VS] = (bf16)f2bf((bfhi(w.y) - mean) * rstd);
                    d[4 * VS] = (bf16)f2bf((bflo(w.z) - mean) * rstd); d[5 * VS] = (bf16)f2bf((bfhi(w.z) - mean) * rstd); d[6 * VS] = (bf16)f2bf((bflo(w.w) - mean) * rstd); d[7 * VS] = (bf16)f2bf((bfhi(w.w) - mean) * rstd);
                }
#pragma unroll
                for (int q = 0; q < 4; ++q) { const int e = tid + 512 * q; *(LAS u32x4*)(wl + (e >> 4) * VS + (e & 15) * 8) = ww[q]; }
            }
            u32x2 uw[8][2]; float m0v[8], bsv[8];
#pragma unroll
            for (int n = 0; n < 8; ++n) { const int t = 16 * n + fr; m0v[n] = M0[g * 128 + t]; bsv[n] = bsg[g * 128 + t];
                const size_t ro = (tok0 + t) * 2048 + g * 256 + 32 * wid + 4 * fq; uw[n][0] = *(const u32x2*)(U + ro); uw[n][1] = *(const u32x2*)(U + ro + 16); }
            __syncthreads();
            bf16x8 vf[2][4];
#pragma unroll
            for (int m = 0; m < 2; ++m)
#pragma unroll
                for (int k = 0; k < 4; ++k) vf[m][k] = *(const LAS bf16x8*)(vT + (32 * wid + 16 * m + fr) * VS + 32 * k + 8 * fq);
            f32x4 gc[2], bc[2];
#pragma unroll
            for (int m = 0; m < 2; ++m) { gc[m] = *(const f32x4*)(lng + g * 256 + 32 * wid + 16 * m + 4 * fq); bc[m] = *(const f32x4*)(lnb + g * 256 + 32 * wid + 16 * m + 4 * fq); }
#pragma unroll
            for (int n = 0; n < 8; ++n) {
                f32x4 a0 = (f32x4){0.f, 0.f, 0.f, 0.f}, a1 = (f32x4){0.f, 0.f, 0.f, 0.f};
#pragma unroll
                for (int k = 0; k < 4; ++k) if (k <= (n >> 1)) {
                    const bf16x8 wf = *(const LAS bf16x8*)(wl + (16 * n + fr) * VS + 32 * k + 8 * fq);
                    a0 = __builtin_amdgcn_mfma_f32_16x16x32_bf16(vf[0][k], wf, a0, 0, 0, 0);
                    a1 = __builtin_amdgcn_mfma_f32_16x16x32_bf16(vf[1][k], wf, a1, 0, 0, 0); }
                const int t = 16 * n + fr; const float m0 = m0v[n], bsv_ = bsv[n];
                const size_t ro = (tok0 + t) * 2048 + g * 256 + 32 * wid + 4 * fq;
#pragma unroll
                for (int m = 0; m < 2; ++m) {
                    const f32x4 a = m ? a1 : a0;
                    const u32x2 uw_ = uw[n][m];
                    u32x2 w; w.x = pk2((a.x * gc[m].x + bc[m].x * m0 + bsv_) * bflo(uw_.x), (a.y * gc[m].y + bc[m].y * m0 + bsv_) * bfhi(uw_.x));
                    w.y = pk2((a.z * gc[m].z + bc[m].z * m0 + bsv_) * bflo(uw_.y), (a.w * gc[m].w + bc[m].w * m0 + bsv_) * bfhi(uw_.y));
                    *(u32x2*)(UM + ro + 16 * m) = w;
                }
            }
        }
    }
    __syncthreads();
}

__device__ __forceinline__ void phase_rownorm(KArgs A, int wv_) {
    const int tid_ = opaque_tid(wv_); const int wid = __builtin_amdgcn_readfirstlane(tid_ >> 6), lane = tid_ & 63; const int gw = blockIdx.x * 8 + wid, NGW = gridDim.x * 8;
    bf16* XN = (bf16*)(opq(A->ws) + WS_XN); const float* X = A->out;
    f32x4 v[4], vn[4];
    if (gw < T) {
#pragma unroll
        for (int j = 0; j < 4; ++j) v[j] = ((const f32x4*)(X + (size_t)gw * D) + lane)[64 * j];
    }
    for (int m = gw; m < T; m += NGW) {
        const int mn = m + NGW < T ? m + NGW : m;
#pragma unroll
        for (int j = 0; j < 4; ++j) vn[j] = ((const f32x4*)(X + (size_t)mn * D) + lane)[64 * j];
        float s = 0.f;
#pragma unroll
        for (int j = 0; j < 4; ++j) s += (v[j].x * v[j].x + v[j].y * v[j].y) + (v[j].z * v[j].z + v[j].w * v[j].w);
        const float rstd = rsqrtf(wave_sum(s) * (1.f / 1024.f) + EPS);
        u32x2* o8 = (u32x2*)(XN + (size_t)m * D) + lane;
#pragma unroll
        for (int j = 0; j < 4; ++j) { u32x2 w; w.x = pk2(v[j].x * rstd, v[j].y * rstd); w.y = pk2(v[j].z * rstd, v[j].w * rstd); o8[64 * j] = w; }
#pragma unroll
        for (int j = 0; j < 4; ++j) v[j] = vn[j];
    }
}

__device__ __forceinline__ void phase_xattn(KArgs A, int wv_, int L, LAS unsigned char* lds) {
    const int tid = opaque_tid(wv_), wid = __builtin_amdgcn_readfirstlane(tid >> 6), lane = tid & 63;
    unsigned char* ws = opq(A->ws);
    const bf16* QX = (const bf16*)(ws + WS_QX); const bf16* KV = (const bf16*)(ws + WS_KV); bf16* OX = (bf16*)(ws + WS_OX);
    constexpr int KSTR = 129;
    LAS unsigned* kl = (LAS unsigned*)lds;
    LAS float* qb = (LAS float*)(lds + 132096) + wid * 256;
    LAS float* pb = (LAS float*)(lds + 132096 + 8192) + wid * 256;
    const float* qg = A->in[I_XQN] + L * 256;
    for (int it = blockIdx.x; it < NBATCH * 4 * 8; it += gridDim.x) {
        const int qc = it & 7, h = (it >> 3) & 3, b = it >> 5;
        __syncthreads();
        for (int e = tid; e < 256 * 128; e += 512) { const int m = e >> 7, dw = e & 127;
            kl[m * KSTR + dw] = *((const unsigned*)(KV + (size_t)(b * 256 + m) * 8192 + L * 2048 + h * 256) + dw); }
        __syncthreads();
        const bf16* Vb = KV + (size_t)(b * 256) * 8192 + L * 2048 + 1024 + h * 256;
        for (int tq = 0; tq < 32; ++tq) {
            const size_t tok = (size_t)b * S + qc * 256 + wid * 32 + tq;
            const u32x2 qw = *((const u32x2*)(QX + tok * 1024 + h * 256) + lane);
            const float q0 = bflo(qw.x), q1 = bfhi(qw.x), q2 = bflo(qw.y), q3 = bfhi(qw.y);
            const float rstd = rsqrtf(wave_sum(q0 * q0 + q1 * q1 + q2 * q2 + q3 * q3) * (1.f / 256.f) + EPS);
            const f32x4 gg = *(const f32x4*)(qg + 4 * lane);
            *(LAS f32x4*)(qb + 4 * lane) = (f32x4){q0 * rstd * gg.x, q1 * rstd * gg.y, q2 * rstd * gg.z, q3 * rstd * gg.w};
            LDS_WAIT();
            float s0 = 0.f, s1 = 0.f, s2 = 0.f, s3 = 0.f;
#pragma unroll 4
            for (int dw = 0; dw < 128; ++dw) {
                const f32x2 qq = *(const LAS f32x2*)(qb + 2 * dw);
                const unsigned k0 = kl[lane * KSTR + dw], k1 = kl[(lane + 64) * KSTR + dw], k2 = kl[(lane + 128) * KSTR + dw], k3 = kl[(lane + 192) * KSTR + dw];
                s0 += qq.x * bflo(k0) + qq.y * bfhi(k0); s1 += qq.x * bflo(k1) + qq.y * bfhi(k1);
                s2 += qq.x * bflo(k2) + qq.y * bfhi(k2); s3 += qq.x * bflo(k3) + qq.y * bfhi(k3);
            }
            const float mx = wave_max(fmaxf(fmaxf(s0, s1), fmaxf(s2, s3)));
            const float e0 = __expf(s0 - mx), e1 = __expf(s1 - mx), e2 = __expf(s2 - mx), e3 = __expf(s3 - mx);
            const float inv = 1.f / wave_sum((e0 + e1) + (e2 + e3));
            pb[lane] = e0 * inv; pb[lane + 64] = e1 * inv; pb[lane + 128] = e2 * inv; pb[lane + 192] = e3 * inv;
            LDS_WAIT();
            float o0 = 0.f, o1 = 0.f, o2 = 0.f, o3 = 0.f;
#pragma unroll 8
            for (int m = 0; m < 256; ++m) {
                const float p = pb[m];
                const u32x2 vw = *((const u32x2*)(Vb + (size_t)m * 8192) + lane);
                o0 += p * bflo(vw.x); o1 += p * bfhi(vw.x); o2 += p * bflo(vw.y); o3 += p * bfhi(vw.y);
            }
            u32x2 ow; ow.x = pk2(o0, o1); ow.y = pk2(o2, o3);
            *((u32x2*)(OX + tok * 1024 + h * 256) + lane) = ow;
            LDS_WAIT();
        }
    }
    __syncthreads();
}


__device__ __forceinline__ int kperm32(int p) { const int fq = (p >> 3) & 3, j = p & 7; return (p & ~31) + 16 * (j >> 2) + 4 * fq + (j & 3); }
__device__ __forceinline__ void phase_vtrans(KArgs A, int wv_, LAS unsigned char* lds) {
    const int tid = opaque_tid(wv_);
    unsigned char* ws = opq(A->ws);
    const bf16* KV = (const bf16*)(ws + WS_KV); bf16* VT = (bf16*)(ws + WS_VT);
    LAS bf16* vt = (LAS bf16*)lds;
    constexpr int VS = 258;
    for (int it = blockIdx.x; it < DEPTH * NBATCH * 4; it += gridDim.x) {
        const int h = it & 3, b = (it >> 2) & 7, l = it >> 5;
        __syncthreads();
        for (int e = tid; e < 256 * 32; e += 512) { const int m = e >> 5, c8 = e & 31;
            const u32x4 w = *(const u32x4*)(KV + (size_t)(b * 256 + m) * 8192 + l * 2048 + 1024 + h * 256 + c8 * 8);
            LAS unsigned* d = (LAS unsigned*)(vt + m * VS + c8 * 8); d[0] = w.x; d[1] = w.y; d[2] = w.z; d[3] = w.w; }
        __syncthreads();
        for (int e = tid; e < 256 * 32; e += 512) { const int dv = e & 255, p8 = e >> 8;
            unsigned short x[8];
#pragma unroll
            for (int j = 0; j < 8; ++j) x[j] = vt[kperm32(p8 * 8 + j) * VS + dv];
            u32x4 o; o.x = x[0] | ((unsigned)x[1] << 16); o.y = x[2] | ((unsigned)x[3] << 16); o.z = x[4] | ((unsigned)x[5] << 16); o.w = x[6] | ((unsigned)x[7] << 16);
            *(u32x4*)(VT + ((size_t)it * 256 + dv) * 256 + p8 * 8) = o; }
    }
    __syncthreads();
}

__device__ __forceinline__ void xattn_item(KArgs A, int wv_, int L, LAS unsigned char* lds, const int b, const int h, const int qt) {
    const int tid = opaque_tid(wv_), wid = __builtin_amdgcn_readfirstlane(tid >> 6), lane = tid & 63, fr = lane & 15, fq = lane >> 4;
    unsigned char* ws = opq(A->ws);
    const bf16* QX = (const bf16*)(ws + WS_QX); const bf16* KV = (const bf16*)(ws + WS_KV); const bf16* VT = (const bf16*)(ws + WS_VT); bf16* OX = (bf16*)(ws + WS_OX);
    constexpr int RS = 264;
    LAS bf16* kl = (LAS bf16*)lds;
    const float* qg = A->in[I_XQN] + L * 256;
    {
        __syncthreads();
        {
            const int row = tid >> 1, hf = tid & 1;
            const u32x4* src = (const u32x4*)(KV + (size_t)(b * 256 + row) * 8192 + L * 2048 + h * 256 + hf * 128);
#pragma unroll
            for (int i0 = 0; i0 < 16; i0 += 8) {
                u32x4 w[8];
#pragma unroll
                for (int i = 0; i < 8; ++i) w[i] = src[i0 + i];
#pragma unroll
                for (int i = 0; i < 8; ++i) *(LAS u32x4*)(kl + row * RS + hf * 128 + (i0 + i) * 8) = w[i];
            }
        }
        const size_t tok0 = (size_t)b * S + qt * 256 + wid * 32 + fr;
        u32x4 qw0[8], qw1[8];
#pragma unroll
        for (int s = 0; s < 8; ++s) { qw0[s] = *(const u32x4*)(QX + tok0 * 1024 + h * 256 + 32 * s + 8 * fq); qw1[s] = *(const u32x4*)(QX + (tok0 + 16) * 1024 + h * 256 + 32 * s + 8 * fq); }
        __syncthreads();
        bf16x8 pf0[8], pf1[8]; float inv0, inv1;
        auto s_part = [&](const u32x4 (&qw)[8], bf16x8 (&pf)[8], float& inv) __attribute__((always_inline)) {
            float ssq = 0.f;
#pragma unroll
            for (int s = 0; s < 8; ++s) {
                const float a0 = bflo(qw[s].x), a1 = bfhi(qw[s].x), a2 = bflo(qw[s].y), a3 = bfhi(qw[s].y), a4 = bflo(qw[s].z), a5 = bfhi(qw[s].z), a6 = bflo(qw[s].w), a7 = bfhi(qw[s].w);
                ssq += (a0 * a0 + a1 * a1) + (a2 * a2 + a3 * a3) + (a4 * a4 + a5 * a5) + (a6 * a6 + a7 * a7);
            }
            ssq += __shfl_xor(ssq, 16); ssq += __shfl_xor(ssq, 32);
            const float rstd = rsqrtf(ssq * (1.f / 256.f) + EPS);
            bf16x8 qf[8];
#pragma unroll
            for (int s = 0; s < 8; ++s) qf[s] = __builtin_bit_cast(bf16x8, qw[s]);
            f32x4 sc[16];
#pragma unroll
            for (int hf = 0; hf < 2; ++hf) {
                unsigned kb = (unsigned)(size_t)(kl + (128 * hf + fr) * RS + 8 * fq); asm volatile("" : "+v"(kb));
#pragma unroll
                for (int t8 = 0; t8 < 8; ++t8) { const int t = 8 * hf + t8; sc[t] = (f32x4){0.f, 0.f, 0.f, 0.f};
#pragma unroll
                    for (int s = 0; s < 8; ++s) { const bf16x8 kf = *(const LAS bf16x8*)(size_t)(kb + (unsigned)((16 * t8 * RS + 32 * s) * 2));
                        sc[t] = __builtin_amdgcn_mfma_f32_16x16x32_bf16(kf, qf[s], sc[t], 0, 0, 0); }
                    if (t & 1) asm volatile("" ::: "memory"); }
            }
            float mx = -INFINITY;
#pragma unroll
            for (int t = 0; t < 16; ++t) mx = fmaxf(mx, fmaxf(fmaxf(sc[t].x, sc[t].y), fmaxf(sc[t].z, sc[t].w)));
            mx = fmaxf(mx, __shfl_xor(mx, 16)); mx = fmaxf(mx, __shfl_xor(mx, 32));
            float lsum = 0.f;
#pragma unroll
            for (int t = 0; t < 16; ++t) { sc[t].x = __expf((sc[t].x - mx) * rstd); sc[t].y = __expf((sc[t].y - mx) * rstd); sc[t].z = __expf((sc[t].z - mx) * rstd); sc[t].w = __expf((sc[t].w - mx) * rstd); lsum += (sc[t].x + sc[t].y) + (sc[t].z + sc[t].w); }
            lsum += __shfl_xor(lsum, 16); lsum += __shfl_xor(lsum, 32);
            inv = 1.f / lsum;
#pragma unroll
            for (int s = 0; s < 8; ++s) { u32x4 w; w.x = pk2(sc[2 * s].x, sc[2 * s].y); w.y = pk2(sc[2 * s].z, sc[2 * s].w); w.z = pk2(sc[2 * s + 1].x, sc[2 * s + 1].y); w.w = pk2(sc[2 * s + 1].z, sc[2 * s + 1].w);
                pf[s] = __builtin_bit_cast(bf16x8, w); }
        };
        s_part(qw0, pf0, inv0);
        s_part(qw1, pf1, inv1);
        __syncthreads();
        {
            const int row = tid >> 1, hf = tid & 1;
            const u32x4* src = (const u32x4*)(VT + ((size_t)((L * 8 + b) * 4 + h) * 256 + row) * 256 + hf * 128);
#pragma unroll
            for (int i0 = 0; i0 < 16; i0 += 8) {
                u32x4 w[8];
#pragma unroll
                for (int i = 0; i < 8; ++i) w[i] = src[i0 + i];
#pragma unroll
                for (int i = 0; i < 8; ++i) *(LAS u32x4*)(kl + row * RS + hf * 128 + (i0 + i) * 8) = w[i];
            }
        }
        __syncthreads();
#pragma unroll
        for (int hf = 0; hf < 2; ++hf) {
            unsigned vb = (unsigned)(size_t)(kl + (128 * hf + fr) * RS + 8 * fq); asm volatile("" : "+v"(vb));
#pragma unroll
            for (int n8 = 0; n8 < 8; ++n8) { const int n = 8 * hf + n8; f32x4 o0 = (f32x4){0.f, 0.f, 0.f, 0.f}, o1 = o0;
#pragma unroll
                for (int s = 0; s < 8; ++s) { const bf16x8 vf = *(const LAS bf16x8*)(size_t)(vb + (unsigned)((16 * n8 * RS + 32 * s) * 2));
                    o0 = __builtin_amdgcn_mfma_f32_16x16x32_bf16(vf, pf0[s], o0, 0, 0, 0);
                    o1 = __builtin_amdgcn_mfma_f32_16x16x32_bf16(vf, pf1[s], o1, 0, 0, 0); }
                u32x2 w0, w1; w0.x = pk2(o0.x * inv0, o0.y * inv0); w0.y = pk2(o0.z * inv0, o0.w * inv0); w1.x = pk2(o1.x * inv1, o1.y * inv1); w1.y = pk2(o1.z * inv1, o1.w * inv1);
                *(u32x2*)(OX + tok0 * 1024 + h * 256 + 16 * n + 4 * fq) = w0;
                *(u32x2*)(OX + (tok0 + 16) * 1024 + h * 256 + 16 * n + 4 * fq) = w1;
                if (n & 1) asm volatile("" ::: "memory"); }
        }
    }
    __syncthreads();
}

__device__ __forceinline__ void phase_route(KArgs A, int wv_, int L, LAS unsigned char* lds) {
    const int tid_ = opaque_tid(wv_); const int wid = __builtin_amdgcn_readfirstlane(tid_ >> 6), lane = tid_ & 63;
    unsigned char* ws = opq(A->ws);
    const float* RW = (const float*)(ws + WS_RW) + (size_t)L * NEXP * D;
    unsigned* cnt = (unsigned*)(ws + WS_CTL) + CW_CNT + L * 64;
    int* list = (int*)(ws + WS_LIST); int* te = (int*)(ws + WS_TOK); int* tp = te + 2 * T; float* tw = (float*)(tp + 2 * T);
    bf16* XN = (bf16*)(ws + WS_XN);
    LAS float* rwl = (LAS float*)lds;
    LAS unsigned* lcnt = (LAS unsigned*)(lds + 65536);
    LAS unsigned* lbase = lcnt + 16;
    const float rbv = A->in[I_RB][lane >> 2];
    for (int e4 = tid_; e4 < NEXP * D / 4; e4 += 512) *(LAS f32x4*)(rwl + 4 * e4) = *(const f32x4*)(RW + 4 * e4);
    for (int blk = blockIdx.x; blk < T / 64; blk += gridDim.x) {
        __syncthreads();
        if (tid_ < 16) lcnt[tid_] = 0u;
        __syncthreads();
        int e0s = 0, e1s = 0, r0s = 0, r1s = 0; float w0s = 0.f;
        f32x4 v[4], vn[4];
#pragma unroll
        for (int j = 0; j < 4; ++j) v[j] = ((const f32x4*)(A->out + (size_t)(blk * 64 + wid * 8) * D) + lane)[64 * j];
#pragma unroll 1
        for (int q = 0; q < 8; ++q) {
            const int t = blk * 64 + wid * 8 + q;
            { const f32x4* xn_ = (const f32x4*)(A->out + (size_t)(t + (q < 7 ? 1 : 0)) * D) + lane;
#pragma unroll
              for (int j = 0; j < 4; ++j) vn[j] = xn_[64 * j]; }
            float s = 0.f;
#pragma unroll
            for (int j = 0; j < 4; ++j) s += (v[j].x * v[j].x + v[j].y * v[j].y) + (v[j].z * v[j].z + v[j].w * v[j].w);
            const float rstd = rsqrtf(wave_sum(s) * (1.f / 1024.f) + EPS);
            u32x2* o8 = (u32x2*)(XN + (size_t)t * D) + lane;
#pragma unroll
            for (int j = 0; j < 4; ++j) { u32x2 w; w.x = pk2(v[j].x * rstd, v[j].y * rstd); w.y = pk2(v[j].z * rstd, v[j].w * rstd); o8[64 * j] = w; }
            float a[16];
#pragma unroll
            for (int e = 0; e < 16; ++e) {
                const LAS f32x4* wr = (const LAS f32x4*)(rwl + e * D) + lane; float acc = 0.f;
#pragma unroll
                for (int j = 0; j < 4; ++j) { const f32x4 w = wr[64 * j]; acc += (v[j].x * w.x + v[j].y * w.y) + (v[j].z * w.z + v[j].w * w.w); }
                a[e] = acc;
            }
            float a8[8], a4[4], a2[2], a1;
            { const bool up = lane & 32;
#pragma unroll
              for (int k = 0; k < 8; ++k) { const float send = up ? a[k] : a[k + 8], keep = up ? a[k + 8] : a[k]; a8[k] = keep + __shfl_xor(send, 32); } }
            { const bool up = lane & 16;
#pragma unroll
              for (int k = 0; k < 4; ++k) { const float send = up ? a8[k] : a8[k + 4], keep = up ? a8[k + 4] : a8[k]; a4[k] = keep + __shfl_xor(send, 16); } }
            { const bool up = lane & 8;
#pragma unroll
              for (int k = 0; k < 2; ++k) { const float send = up ? a4[k] : a4[k + 2], keep = up ? a4[k + 2] : a4[k]; a2[k] = keep + __shfl_xor(send, 8); } }
            { const bool up = lane & 4; const float send = up ? a2[0] : a2[1], keep = up ? a2[1] : a2[0]; a1 = keep + __shfl_xor(send, 4); }
            a1 += __shfl_xor(a1, 2); a1 += __shfl_xor(a1, 1);
            const float lg = a1 * rstd + rbv;
            const float v0 = wave_max(lg);
            const int e0 = (__ffsll((unsigned long long)__ballot(lg == v0)) - 1) >> 2;
            const int gidx = e0 >> 2;
            const bool c2 = (lane >> 4) == gidx && (lane >> 2) != e0;
            const float m2 = c2 ? lg : -INFINITY;
            const float v1 = wave_max(m2);
            const int e1 = (__ffsll((unsigned long long)__ballot(c2 && m2 == v1)) - 1) >> 2;
            const float w0 = 1.f / (1.f + __expf(v1 - v0));
            unsigned r0 = 0, r1 = 0;
            if (lane == 0) { r0 = atomicAdd((unsigned*)(lcnt + e0), 1u); r1 = atomicAdd((unsigned*)(lcnt + e1), 1u); }
            r0 = __builtin_amdgcn_readfirstlane(r0); r1 = __builtin_amdgcn_readfirstlane(r1);
            if (lane == q) { e0s = e0; e1s = e1; r0s = (int)r0; r1s = (int)r1; w0s = w0; }
#pragma unroll
            for (int j = 0; j < 4; ++j) v[j] = vn[j];
        }
        __syncthreads();
        if (tid_ < 16) lbase[tid_] = atomicAdd(&cnt[tid_], lcnt[tid_]);
        __syncthreads();
        if (lane < 8) {
            const int t = blk * 64 + wid * 8 + lane;
            const int p0 = (int)lbase[e0s] + r0s, p1 = (int)lbase[e1s] + r1s;
            list[e0s * T + p0] = t; list[e1s * T + p1] = t;
            te[2 * t] = e0s; te[2 * t + 1] = e1s; tp[2 * t] = p0; tp[2 * t + 1] = p1; tw[2 * t] = w0s; tw[2 * t + 1] = 1.f - w0s;
        }
    }
    __syncthreads();
}
__device__ __forceinline__ void phase_route_mfma(KArgs A, int wv_, int L, LAS unsigned char* lds) {
    const int tid = opaque_tid(wv_), wid = __builtin_amdgcn_readfirstlane(tid >> 6), lane = tid & 63, fr = lane & 15, fq = lane >> 4;
    unsigned char* ws = opq(A->ws);
    const float* RW = (const float*)(ws + WS_RW) + (size_t)L * NEXP * D;
    unsigned* cnt = (unsigned*)(ws + WS_CTL) + CW_CNT + L * 64;
    int* list = (int*)(ws + WS_LIST); int* te = (int*)(ws + WS_TOK); int* tp = te + 2 * T; float* tw = (float*)(tp + 2 * T);
    bf16* XN = (bf16*)(ws + WS_XN);
    constexpr int WSTR = 1032;
    LAS bf16* rwh = (LAS bf16*)lds;
    LAS bf16* rwl = rwh + 16 * WSTR;
    LAS float* xch = (LAS float*)(lds + 2 * 16 * WSTR * 2);
    LAS unsigned* lcnt = (LAS unsigned*)(lds + 2 * 16 * WSTR * 2 + 8 * 320 * 4);
    LAS unsigned* lbase = lcnt + 16;
    for (int e4 = tid; e4 < NEXP * D / 4; e4 += 512) {
        const f32x4 w = *(const f32x4*)(RW + 4 * e4);
        u32x2 h; h.x = pk2(w.x, w.y); h.y = pk2(w.z, w.w);
        u32x2 l; l.x = pk2(w.x - bflo(h.x), w.y - bfhi(h.x)); l.y = pk2(w.z - bflo(h.y), w.w - bfhi(h.y));
        const int e = (4 * e4) >> 10, k = (4 * e4) & 1023;
        *(LAS u32x2*)(rwh + e * WSTR + k) = h; *(LAS u32x2*)(rwl + e * WSTR + k) = l;
    }
    const int tg = wid >> 1, kh = wid & 1;
    const float rbv = A->in[I_RB][fr];
    for (int blk = blockIdx.x; blk < T / 64; blk += gridDim.x) {
        __syncthreads();
        if (tid < 16) lcnt[tid] = 0u;
        const size_t tok = (size_t)blk * 64 + 16 * tg + fr;
        const float* xrow = A->out + tok * D + 512 * kh + 8 * fq;
        f32x4 acc = (f32x4){0.f, 0.f, 0.f, 0.f}; float ssq = 0.f;
        bf16x8 ah[16];
#pragma unroll
        for (int s4 = 0; s4 < 16; s4 += 4) {
            f32x4 xa[4], xb[4];
#pragma unroll
            for (int q = 0; q < 4; ++q) { xa[q] = *(const f32x4*)(xrow + 32 * (s4 + q)); xb[q] = *(const f32x4*)(xrow + 32 * (s4 + q) + 4); }
#pragma unroll
            for (int q = 0; q < 4; ++q) {
                const int s = s4 + q; const f32x4 x0 = xa[q], x1 = xb[q];
                ssq += ((x0.x * x0.x + x0.y * x0.y) + (x0.z * x0.z + x0.w * x0.w)) + ((x1.x * x1.x + x1.y * x1.y) + (x1.z * x1.z + x1.w * x1.w));
                u32x4 hw; hw.x = pk2(x0.x, x0.y); hw.y = pk2(x0.z, x0.w); hw.z = pk2(x1.x, x1.y); hw.w = pk2(x1.z, x1.w);
                u32x4 lw; lw.x = pk2(x0.x - bflo(hw.x), x0.y - bfhi(hw.x)); lw.y = pk2(x0.z - bflo(hw.y), x0.w - bfhi(hw.y)); lw.z = pk2(x1.x - bflo(hw.z), x1.y - bfhi(hw.z)); lw.w = pk2(x1.z - bflo(hw.w), x1.w - bfhi(hw.w));
                ah[s] = __builtin_bit_cast(bf16x8, hw); const bf16x8 al = __builtin_bit_cast(bf16x8, lw);
                const bf16x8 bh = *(const LAS bf16x8*)(rwh + fr * WSTR + 512 * kh + 32 * s + 8 * fq), bl = *(const LAS bf16x8*)(rwl + fr * WSTR + 512 * kh + 32 * s + 8 * fq);
                acc = __builtin_amdgcn_mfma_f32_16x16x32_bf16(ah[s], bh, acc, 0, 0, 0);
                acc = __builtin_amdgcn_mfma_f32_16x16x32_bf16(ah[s], bl, acc, 0, 0, 0);
                acc = __builtin_amdgcn_mfma_f32_16x16x32_bf16(al, bh, acc, 0, 0, 0);
            }
        }
        ssq += __shfl_xor(ssq, 16); ssq += __shfl_xor(ssq, 32);
        LAS float* mine = xch + wid * 320; const LAS float* other = xch + (wid ^ 1) * 320;
#pragma unroll
        for (int r = 0; r < 4; ++r) mine[(4 * fq + r) * 20 + fr] = acc[r];
        if (fq == 0) mine[fr * 20 + 16] = ssq;
        __syncthreads();
        const float rstd = rsqrtf((ssq + other[fr * 20 + 16]) * (1.f / 1024.f) + EPS);
        {
            bf16* xo = XN + tok * D + 512 * kh + 8 * fq;
#pragma unroll
            for (int s = 0; s < 16; ++s) { const u32x4 hw = __builtin_bit_cast(u32x4, ah[s]);
                u32x4 o; o.x = pk2(bflo(hw.x) * rstd, bfhi(hw.x) * rstd); o.y = pk2(bflo(hw.y) * rstd, bfhi(hw.y) * rstd); o.z = pk2(bflo(hw.z) * rstd, bfhi(hw.z) * rstd); o.w = pk2(bflo(hw.w) * rstd, bfhi(hw.w) * rstd);
                *(u32x4*)(xo + 32 * s) = o; }
        }
        int e0r[4], e1r[4], r0r[4], r1r[4]; float w0r[4];
        if (kh == 0) {
#pragma unroll
            for (int r = 0; r < 4; ++r) {
                const float rs = __shfl(rstd, 4 * fq + r);
                const float lg = (acc[r] + other[(4 * fq + r) * 20 + fr]) * rs + rbv;
                float v0 = lg; v0 = fmaxf(v0, __shfl_xor(v0, 1)); v0 = fmaxf(v0, __shfl_xor(v0, 2)); v0 = fmaxf(v0, __shfl_xor(v0, 4)); v0 = fmaxf(v0, __shfl_xor(v0, 8));
                const unsigned long long bm0 = __ballot(lg == v0);
                const int e0 = __ffs((unsigned)(bm0 >> (16 * fq)) & 0xffffu) - 1;
                const bool c2 = (fr >> 2) == (e0 >> 2) && fr != e0;
                const float m2 = c2 ? lg : -INFINITY;
                float v1 = m2; v1 = fmaxf(v1, __shfl_xor(v1, 1)); v1 = fmaxf(v1, __shfl_xor(v1, 2)); v1 = fmaxf(v1, __shfl_xor(v1, 4)); v1 = fmaxf(v1, __shfl_xor(v1, 8));
                const unsigned long long bm1 = __ballot(c2 && m2 == v1);
                const int e1 = __ffs((unsigned)(bm1 >> (16 * fq)) & 0xffffu) - 1;
                e0r[r] = e0; e1r[r] = e1; w0r[r] = 1.f / (1.f + __expf(v1 - v0));
                r0r[r] = 0; r1r[r] = 0;
                if (fr == 0) { r0r[r] = (int)atomicAdd((unsigned*)(lcnt + e0), 1u); r1r[r] = (int)atomicAdd((unsigned*)(lcnt + e1), 1u); }
            }
        }
        __syncthreads();
        if (tid < 16) lbase[tid] = atomicAdd(&cnt[tid], lcnt[tid]);
        __syncthreads();
        if (kh == 0 && fr == 0) {
#pragma unroll
            for (int r = 0; r < 4; ++r) {
                const int t = blk * 64 + 16 * tg + 4 * fq + r;
                const int p0 = (int)lbase[e0r[r]] + r0r[r], p1 = (int)lbase[e1r[r]] + r1r[r];
                list[e0r[r] * T + p0] = t; list[e1r[r] * T + p1] = t;
                te[2 * t] = e0r[r]; te[2 * t + 1] = e1r[r]; tp[2 * t] = p0; tp[2 * t + 1] = p1; tw[2 * t] = w0r[r]; tw[2 * t + 1] = 1.f - w0r[r];
            }
        }
    }
    __syncthreads();
}

__device__ __forceinline__ void moe_offsets(KArgs A, int wv_, int L, LAS int* off, LAS int* cn) {
    if (opaque_tid(wv_) == 0) {
        const unsigned* cnt = (const unsigned*)(opq(A->ws) + WS_CTL) + CW_CNT + L * 64;
        int o = 0;
        for (int e = 0; e < 16; ++e) { const int c = (int)__hip_atomic_load(cnt + e, __ATOMIC_RELAXED, __HIP_MEMORY_SCOPE_AGENT); off[e] = o; cn[e] = c; o += (c + 255) & ~255; }
        off[16] = o;
    }
    __syncthreads();
}
__device__ __forceinline__ void phase_moe_combine(KArgs A, int wv_, int L, LAS unsigned char* lds) {
    LAS int* off = (LAS int*)lds; LAS int* cn = off + 32;
    moe_offsets(A, wv_, L, off, cn);
    const int tid_ = opaque_tid(wv_); const int wid = __builtin_amdgcn_readfirstlane(tid_ >> 6), lane = tid_ & 63; const int gw = blockIdx.x * 8 + wid, NGW = gridDim.x * 8;
    unsigned char* ws = opq(A->ws);
    const int* te = (const int*)(ws + WS_TOK); const int* tp = te + 2 * T; const float* tw = (const float*)(tp + 2 * T);
    const bf16* Y = (const bf16*)(ws + WS_Y); bf16* XN = (bf16*)(ws + WS_XN);
    const int nq = (T - gw + NGW - 1) / NGW;
    for (int q0 = 0; q0 < nq; q0 += 8) {
        int s0m = 0, s1m = 0; float w0m = 0.f, w1m = 0.f;
        { const int qq = q0 + (lane & 7); const int t = gw + NGW * (qq < nq ? qq : nq - 1);
          s0m = off[te[2 * t]] + tp[2 * t]; s1m = off[te[2 * t + 1]] + tp[2 * t + 1]; w0m = tw[2 * t]; w1m = tw[2 * t + 1]; }
        const int nn = nq - q0 < 8 ? nq - q0 : 8;
        f32x4 v[4], vn[4]; u32x2 ya[4], yb[4], yan[4], ybn[4];
        { const int t = gw + NGW * q0; const int sl0 = __builtin_amdgcn_readlane(s0m, 0), sl1 = __builtin_amdgcn_readlane(s1m, 0);
#pragma unroll
          for (int j = 0; j < 4; ++j) { v[j] = ((const f32x4*)(A->out + (size_t)t * D) + lane)[64 * j]; ya[j] = ((const u32x2*)(Y + (size_t)sl0 * D) + lane)[64 * j]; yb[j] = ((const u32x2*)(Y + (size_t)sl1 * D) + lane)[64 * j]; } }
#pragma unroll 1
        for (int q = 0; q < nn; ++q) {
            const int t = gw + NGW * (q0 + q);
            const int qn = q + 1 < nn ? q + 1 : q;
            { const int tn = gw + NGW * (q0 + qn); const int sl0 = __builtin_amdgcn_readlane(s0m, qn), sl1 = __builtin_amdgcn_readlane(s1m, qn);
#pragma unroll
              for (int j = 0; j < 4; ++j) { vn[j] = ((const f32x4*)(A->out + (size_t)tn * D) + lane)[64 * j]; yan[j] = ((const u32x2*)(Y + (size_t)sl0 * D) + lane)[64 * j]; ybn[j] = ((const u32x2*)(Y + (size_t)sl1 * D) + lane)[64 * j]; } }
            const float w0 = __builtin_bit_cast(float, __builtin_amdgcn_readlane(__builtin_bit_cast(int, w0m), q)), w1 = __builtin_bit_cast(float, __builtin_amdgcn_readlane(__builtin_bit_cast(int, w1m), q));
            float s = 0.f;
#pragma unroll
            for (int j = 0; j < 4; ++j) {
                v[j].x += w0 * bflo(ya[j].x) + w1 * bflo(yb[j].x); v[j].y += w0 * bfhi(ya[j].x) + w1 * bfhi(yb[j].x); v[j].z += w0 * bflo(ya[j].y) + w1 * bflo(yb[j].y); v[j].w += w0 * bfhi(ya[j].y) + w1 * bfhi(yb[j].y);
                s += (v[j].x * v[j].x + v[j].y * v[j].y) + (v[j].z * v[j].z + v[j].w * v[j].w);
            }
            const float rstd = rsqrtf(wave_sum(s) * (1.f / 1024.f) + EPS);
            f32x4* xr = (f32x4*)(A->out + (size_t)t * D) + lane; u32x2* o8 = (u32x2*)(XN + (size_t)t * D) + lane;
#pragma unroll
            for (int j = 0; j < 4; ++j) { xr[64 * j] = v[j]; u32x2 w; w.x = pk2(v[j].x * rstd, v[j].y * rstd); w.y = pk2(v[j].z * rstd, v[j].w * rstd); o8[64 * j] = w; }
#pragma unroll
            for (int j = 0; j < 4; ++j) { v[j] = vn[j]; ya[j] = yan[j]; yb[j] = ybn[j]; }
        }
    }
}

constexpr int PH_PER_EVEN = 5 + 6, PH_PER_ODD = 3 + 6;
constexpr int NPHASES = 1 + 2 * (PH_PER_EVEN + PH_PER_ODD);

__global__ void __launch_bounds__(512, 2) mk_fwd(Args Araw) {
    KArgs A0 = kargs();
    extern __shared__ __attribute__((aligned(16))) unsigned char lds_raw[];
    LAS unsigned char* lds = (LAS unsigned char*)lds_raw;
    volatile LAS unsigned* misc = (volatile LAS unsigned*)(lds + LDS_MISC);
    const int tid = threadIdx.x;
    if (tid < 16) misc[tid] = 0u;
    __syncthreads();
    const int lo = A0->ph_lo, hi = A0->ph_hi;
    const int wv_ = __builtin_amdgcn_readfirstlane(threadIdx.x >> 6);
    if (hi - lo > 1) (void)xcd_barrier_post((unsigned*)(A0->ws + WS_CTL) + CW_BAR, misc);
    int ph = 0;
    unsigned long long tacc_ = 0;
#define PH_BEGIN(k) if (ph >= lo && ph < hi) { const bool tprobe_ = (PROBE_TMASK >> (k)) & 1; unsigned long long tp0_ = 0; if (PROBE_TMASK && tprobe_) tp0_ = __builtin_amdgcn_s_memrealtime(); KArgs A = kargs(); unsigned char* ws = opq(A->ws); _Pragma("unroll 1") for (int rep_ = 0; rep_ < (((PROBE_MASK >> (k)) & 1) ? PROBE_REPS : 1); ++rep_)
#define PH_END   if (ph + 1 < hi) { XcdBarrier b_; b_.bar = (unsigned*)(opq(kargs()->ws) + WS_CTL) + CW_BAR; b_.x = xb_xcc_id(); b_.st = misc; xcd_barrier(b_, opaque_tid(wv_) == 0); } if (PROBE_TMASK && tprobe_) tacc_ += __builtin_amdgcn_s_memrealtime() - tp0_; } ++ph;
    const int G = gridDim.x, cb = blockIdx.x;

    PH_BEGIN(0) phase_prologue(A, wv_, lds); PH_END
    for (int L = 0; L < DEPTH; ++L) {
        const int i = L >> 1;
        if ((L & 1) == 0) {
            PH_BEGIN(3) {
                if (L == 0) {
                    pg8::DenseOrder S; S.init(NBATCH * NMEM, 8192, D, (const bf16*)(ws + WS_WKV), G, cb);
                    pg8::EpiBf16<0> E{(bf16*)(ws + WS_KV), 8192, 32, 0};
                    pg8::gemm_phase(lds, (const bf16*)(ws + WS_MN), D, S, E, wv_);
                }
                pg8::DenseOrder S; S.init(T, HYN, D, (const bf16*)(ws + WS_WHYB) + (size_t)i * HYN * D, G, cb);
                pg8::EpiBf16<0> E{(bf16*)(ws + WS_BIG), HYN, 12, 0};
                pg8::gemm_phase(lds, (const bf16*)(ws + WS_XN), D, S, E, wv_);
            } PH_END
            PH_BEGIN(4) { const int t4_ = opaque_tid(wv_); SUBT_BEGIN(4); if (L == 0) { phase_knorm(A, wv_); phase_vtrans(A, wv_, lds); } SUBT_END(4, ws, t4_); SUBT_BEGIN(5); phase_compress_mfma(A, wv_, i, lds); SUBT_END(5, ws, t4_); SUBT_BEGIN(6); phase_nsa_prep(A, wv_, i, lds); SUBT_END(6, ws, t4_); SUBT_BEGIN(7); phase_vtiles(A, wv_, lds); SUBT_END(7, ws, t4_); } PH_END
            PH_BEGIN(5) { phase_gla_a(A, wv_, i, lds); __syncthreads(); phase_nsa_attn_mfma(A, wv_, i, lds); } PH_END
            PH_BEGIN(6) phase_gla_c(A, wv_, i, lds); PH_END
            PH_BEGIN(7) {
                pg8::DenseOrder S; S.init(T, D, D, (const bf16*)(ws + WS_WHOUT) + (size_t)i * D * D, G, cb);
                pg8::EpiResAddNorm E{A->out, D, (bf16*)(ws + WS_XN), (float*)(ws + WS_ROWSQ)};
                pg8::gemm_phase(lds, (const bf16*)(ws + WS_CAT), D, S, E, wv_);
            } PH_END
        } else {
            PH_BEGIN(8) {
                pg8::DenseOrder S; S.init(T, 4096, D, (const bf16*)(ws + WS_WSGIN) + (size_t)i * 4096 * D, G, cb);
                pg8::EpiBf16<1> E{(bf16*)(ws + WS_U), 2048, 8, (size_t)(WS_V - WS_U) / 2};
                pg8::gemm_phase(lds, (const bf16*)(ws + WS_XN), D, S, E, wv_);
            } PH_END
            PH_BEGIN(9) phase_sgu_mix_mfma(A, wv_, i, lds); PH_END
            PH_BEGIN(10) {
                pg8::DenseOrder S; S.init(T, D, 2048, (const bf16*)(ws + WS_WSGOUT) + (size_t)i * D * 2048, G, cb);
                pg8::EpiResAddNorm E{A->out, D, (bf16*)(ws + WS_XN), (float*)(ws + WS_ROWSQ)};
                pg8::gemm_phase(lds, (const bf16*)(ws + WS_UM), 2048, S, E, wv_);
            } PH_END
        }
        PH_BEGIN(12) {
            pg8::DenseOrder S; S.init(T, D, D, (const bf16*)(ws + WS_WQ) + (size_t)L * D * D, G, cb);
            pg8::EpiBf16RowScale E{(bf16*)(ws + WS_QX), D, (const float*)(ws + WS_ROWSQ)};
            pg8::gemm_phase(lds, (const bf16*)(ws + WS_XN), D, S, E, wv_);
            asm volatile("s_waitcnt vmcnt(0)" ::: "memory");
            __syncthreads();
            pg8::Unit u_;
#pragma unroll 1
            for (int ui_ = 0; S.next(ui_, u_); ++ui_) xattn_item(A, wv_, L, lds, u_.pm >> 3, u_.pn, u_.pm & 7);
        } PH_END
        PH_BEGIN(14) {
            pg8::DenseOrder S; S.init(T, D, D, (const bf16*)(ws + WS_WO) + (size_t)L * D * D, G, cb);
            pg8::EpiResAdd E{A->out, D};
            pg8::gemm_phase(lds, (const bf16*)(ws + WS_OX), D, S, E, wv_);
        } PH_END
        PH_BEGIN(15) phase_route_mfma(A, wv_, L, lds); PH_END
        PH_BEGIN(16) {
            LAS int* off = (LAS int*)(lds + pg8::STAGE_BYTES); LAS int* cn = off + 32;
            moe_offsets(A, wv_, L, off, cn);
            pg8::MoeOrder<true> S{(off[16] / 256) * 3, 3, G, cb, D, off, cn, (const int*)(ws + WS_LIST), (const char*)(ws + WS_WMIN) + (size_t)L * 16 * 768 * D * 2, (size_t)768 * D * 2};
            pg8::EpiSwiglu E{(bf16*)(ws + WS_H), DEXP};
            pg8::gemm_phase(lds, (const bf16*)(ws + WS_XN), D, S, E, wv_);
        } PH_END
        PH_BEGIN(17) {
            LAS int* off = (LAS int*)(lds + pg8::STAGE_BYTES); LAS int* cn = off + 32;
            moe_offsets(A, wv_, L, off, cn);
            pg8::MoeOrder<false> S{(off[16] / 256) * 4, 4, G, cb, DEXP, off, cn, (const int*)(ws + WS_LIST), (const char*)(ws + WS_WMOUT) + (size_t)L * 16 * D * DEXP * 2, (size_t)D * DEXP * 2};
            pg8::EpiBf16<0> E{(bf16*)(ws + WS_Y), D, 4, 0};
            pg8::gemm_phase(lds, (const bf16*)(ws + WS_H), DEXP, S, E, wv_);
        } PH_END
        PH_BEGIN(18) phase_moe_combine(A, wv_, L, lds); PH_END
    }
#undef PH_BEGIN
#undef PH_END
    if (hi - lo > 1) { for (int q_ = 0; q_ < PROBE_XBAR; ++q_) { XcdBarrier b_; b_.bar = (unsigned*)(opq(kargs()->ws) + WS_CTL) + CW_BAR; b_.x = xb_xcc_id(); b_.st = misc; xcd_barrier(b_, opaque_tid(wv_) == 0); } }
    if ((PROBE_NSA || PROBE_SUB) && blockIdx.x == 0) { const unsigned long long d_ = __hip_atomic_load((unsigned long long*)(A0->ws + WS_CTL + 48000), __ATOMIC_RELAXED, __HIP_MEMORY_SCOPE_AGENT); const unsigned long long t0 = __builtin_amdgcn_s_memrealtime(); while (__builtin_amdgcn_s_memrealtime() - t0 < d_) __builtin_amdgcn_s_sleep(8); }
    if (PROBE_TMASK && blockIdx.x == 0) { const unsigned long long t0 = __builtin_amdgcn_s_memrealtime(); while (__builtin_amdgcn_s_memrealtime() - t0 < tacc_) __builtin_amdgcn_s_sleep(8); }
}

extern "C" void kernel_launch(void* const* d_in, const int* in_sizes, int n_in, void* d_out, int out_size, void* d_ws, size_t ws_size, hipStream_t stream) {
    static int grid = 0;
    if (grid == 0) {
        if (n_in != N_IN || out_size != T * D || ws_size < WS_END) { fprintf(stderr, "kernel_launch: unexpected problem (n_in %d, out %d, ws %zu)\n", n_in, out_size, ws_size); grid = -1; return; }
        int dev = 0, cus = 0, per_cu = 0;
        if (hipGetDevice(&dev) != hipSuccess || hipDeviceGetAttribute(&cus, hipDeviceAttributeMultiprocessorCount, dev) != hipSuccess) { grid = -1; return; }
        if (hipFuncSetAttribute((const void*)mk_fwd, hipFuncAttributeMaxDynamicSharedMemorySize, LDS_BYTES) != hipSuccess) { fprintf(stderr, "kernel_launch: hipFuncSetAttribute failed\n"); grid = -1; return; }
        if (hipOccupancyMaxActiveBlocksPerMultiprocessor(&per_cu, (const void*)mk_fwd, 512, LDS_BYTES) != hipSuccess || per_cu < 1) fprintf(stderr, "kernel_launch: occupancy query says %d\n", per_cu);
        (void)hipGetLastError();
        grid = cus;
    }
    if (grid < 0) return;
    (void)hipMemsetAsync((char*)d_ws + WS_CTL, 0, CTL_BYTES, stream);
    Args a{};
    for (int i = 0; i < N_IN; ++i) a.in[i] = (const float*)d_in[i];
    a.out = (float*)d_out; a.ws = (unsigned char*)d_ws;
    for (int j = 0; j < 32; ++j) a.freq[j] = (float)pow(10000.0, -(double)j / 32.0);
#if MK_ONE_LAUNCH
    a.ph_lo = 0; a.ph_hi = NPHASES;
    hipLaunchKernelGGL(mk_fwd, dim3(grid), dim3(512), LDS_BYTES, stream, a);
#else
    for (int p = 0; p < NPHASES; ++p) { a.ph_lo = p; a.ph_hi = p + 1; hipLaunchKernelGGL(mk_fwd, dim3(grid), dim3(512), LDS_BYTES, stream, a); }
#endif
}
```

```cpp
#include <hip/hip_runtime.h>
#include <stdint.h>
#include <stdio.h>
#include <math.h>

#ifndef PROBE_MASK
#define PROBE_MASK 0
#endif
#ifndef PROBE_TMASK
#define PROBE_TMASK 0
#endif
#ifndef PROBE_NSA
#define PROBE_NSA 0
#endif
#ifndef PROBE_SUB
#define PROBE_SUB 0
#endif
#ifndef PROBE_XBAR
#define PROBE_XBAR 0
#endif
#ifndef PROBE_NSAX
#define PROBE_NSAX 0
#endif
#ifndef PROBE_REPS
#define PROBE_REPS 2
#endif
#ifndef MK_ONE_LAUNCH
#define MK_ONE_LAUNCH 1
#endif

#define LAS __attribute__((address_space(3)))
typedef unsigned short bf16;
typedef short bf16x8 __attribute__((ext_vector_type(8)));
typedef float f32x4 __attribute__((ext_vector_type(4)));
typedef float f32x2 __attribute__((ext_vector_type(2)));
typedef unsigned u32x4 __attribute__((ext_vector_type(4)));
typedef unsigned u32x2 __attribute__((ext_vector_type(2)));

constexpr int T = 16384, D = 1024, NBATCH = 8, S = 2048, DEPTH = 4;
constexpr int NMEM = 256;
constexpr float EPS = 1e-6f;
constexpr int HYN = 3072, HYSRC = 2856;
constexpr int C_QA = 0, C_KC = 512, C_VC = 640, C_KS = 768, C_VS = 896, C_KW = 1024, C_VW = 1152, C_QB = 1280, C_KB = 1536, C_VB = 1792, C_RB = 2304, C_GA = 2816, C_AL = 2840;
constexpr int NCMP = 127;
constexpr int NEXP = 16, DEXP = 384;
constexpr int SLOTS = 2 * T + NEXP * 256;

enum { I_X = 0, I_MEM, I_POS, I_NMIX, I_NXAT, I_NMEM, I_NFFN, I_HYBIN, I_HYBOUT, I_QNORM, I_KNORM, I_CMPPE, I_CMPW1, I_CMPW2, I_GATEB, I_WA2, I_BA, I_ONORM,
       I_SGIN, I_LNG, I_LNB, I_SGWS, I_SGBS, I_SGOUT, I_XWQ, I_XWKV, I_XWO, I_XQN, I_XKN, I_RW, I_RB, I_MOEIN, I_MOEOUT, N_IN };

constexpr size_t MiB = 1u << 20;
constexpr size_t WS_CTL = 0, CTL_BYTES = 1 * MiB;
constexpr size_t WS_WHYB = 1 * MiB;
constexpr size_t WS_WHOUT = WS_WHYB + 12 * MiB;
constexpr size_t WS_WSGIN = WS_WHOUT + 4 * MiB;
constexpr size_t WS_WSGOUT = WS_WSGIN + 16 * MiB;
constexpr size_t WS_WQ = WS_WSGOUT + 8 * MiB;
constexpr size_t WS_WKV = WS_WQ + 8 * MiB;
constexpr size_t WS_WO = WS_WKV + 16 * MiB;
constexpr size_t WS_WMIN = WS_WO + 8 * MiB;
constexpr size_t WS_WMOUT = WS_WMIN + 96 * MiB;
constexpr size_t WS_RW = WS_WMOUT + 48 * MiB;
constexpr size_t WS_XN = WS_RW + 1 * MiB;
constexpr size_t WS_BIG = WS_XN + 32 * MiB;
constexpr size_t WS_QA = WS_BIG + 128 * MiB;
constexpr size_t WS_KS = WS_QA + 16 * MiB;
constexpr size_t WS_KW = WS_KS + 4 * MiB;
constexpr size_t WS_KC = WS_KW + 4 * MiB;
constexpr size_t WS_VC = WS_KC + 1 * MiB;
constexpr size_t WS_CAT = WS_VC + 1 * MiB;
constexpr size_t WS_QX = WS_CAT + 32 * MiB;
constexpr size_t WS_OX = WS_QX + 32 * MiB;
constexpr size_t WS_MN = WS_OX + 32 * MiB;
constexpr size_t WS_KV = WS_MN + 4 * MiB;
constexpr size_t WS_COS = WS_KV + 32 * MiB;
constexpr size_t WS_SIN = WS_COS + 2 * MiB;
constexpr size_t WS_LIST = WS_SIN + 2 * MiB;
constexpr size_t WS_TOK = WS_LIST + 1 * MiB;
constexpr size_t WS_VT = WS_TOK + 1 * MiB;
constexpr size_t WS_VTA = WS_VT + 16 * MiB;
constexpr size_t WS_SLOC = WS_VTA + 32 * MiB;
constexpr size_t WS_DEC = WS_SLOC + 32 * MiB;
constexpr size_t WS_STT = WS_DEC + 1 * MiB;
constexpr size_t WS_WSB = WS_STT + 16 * MiB;
constexpr size_t WS_M0 = WS_WSB + 768 * 1024;
constexpr size_t WS_W1T = WS_WSB + 1 * MiB;
constexpr size_t WS_ROWSQ = WS_W1T + 1 * MiB;
constexpr size_t WS_VSTAT = WS_ROWSQ + 1 * MiB;
constexpr size_t WS_END = WS_VSTAT + 4 * MiB;
constexpr size_t WS_Y = WS_BIG, WS_H = WS_BIG + 72 * MiB, WS_U = WS_BIG, WS_V = WS_BIG + 64 * MiB, WS_UM = WS_QX;
constexpr int CW_BAR = 4096;
constexpr int CW_CNT = 8192;

constexpr int LDS_BYTES = 159744;
constexpr int LDS_MISC = LDS_BYTES - 64;

typedef __bf16 bf16x2_t __attribute__((ext_vector_type(2)));
__device__ __forceinline__ unsigned pk2(float lo, float hi) { const f32x2 v = {lo, hi}; return __builtin_bit_cast(unsigned, __builtin_convertvector(v, bf16x2_t)); }
__device__ __forceinline__ unsigned f2bf(float f) { return (unsigned)__builtin_bit_cast(unsigned short, (__bf16)f); }
__device__ __forceinline__ float bf2f(unsigned b) { return __uint_as_float(b << 16); }
__device__ __forceinline__ float bflo(unsigned w) { return __uint_as_float(w << 16); }
__device__ __forceinline__ float bfhi(unsigned w) { return __uint_as_float(w & 0xffff0000u); }
__device__ __forceinline__ float wave_sum(float v) {
#pragma unroll
    for (int o = 1; o < 64; o <<= 1) v += __shfl_xor(v, o);
    return v;
}
__device__ __forceinline__ float wave_max(float v) {
#pragma unroll
    for (int o = 1; o < 64; o <<= 1) v = fmaxf(v, __shfl_xor(v, o));
    return v;
}
__device__ __forceinline__ int opaque_tid(int wv) { int l; asm volatile("v_mbcnt_lo_u32_b32 %0, -1, 0\n\tv_mbcnt_hi_u32_b32 %0, -1, %0" : "=v"(l)); return wv * 64 + l; }
__device__ __forceinline__ unsigned char* opq(unsigned char* p) { asm volatile("" : "+s"(p)); return p; }
#define LDS_WAIT() asm volatile("s_waitcnt lgkmcnt(0)" ::: "memory")
__device__ __forceinline__ float gelu_tanh(float x) {
    const float u2 = x * (1.5957691216057308f + 0.07135481283f * x * x);
    return x * __builtin_amdgcn_rcpf(1.0f + __expf(-u2));
}
__device__ __forceinline__ float sigmoidf_(float x) { return __builtin_amdgcn_rcpf(1.0f + __expf(-x)); }

#define SUBT_BEGIN(id) unsigned long long subt_##id = 0; if (PROBE_SUB == (id)) subt_##id = __builtin_amdgcn_s_memrealtime();
#define SUBT_END(id, wsp, tidv) do { if (PROBE_SUB == (id) && blockIdx.x == 0 && (tidv) == 0) atomicAdd((unsigned long long*)((wsp) + WS_CTL + 48000), __builtin_amdgcn_s_memrealtime() - subt_##id); } while (0)
#define XB_TMO      128
#define XB_XCNT(j)  (256  + 64 * (j))
#define XB_XSUB(j)  (1280 + 64 * (j))
#define XB_XGEN(j)  (2304 + 64 * (j))
#define XB_TOP      3328
#define XB_TOPGEN   3392
#define XCD_BAR_WORDS 3456
#define XB_SPIN_CAP (1u << 22)

__device__ __forceinline__ unsigned xb_ld(unsigned* p)              { return __hip_atomic_load(p, __ATOMIC_RELAXED, __HIP_MEMORY_SCOPE_AGENT); }
__device__ __forceinline__ unsigned xb_add(unsigned* p, unsigned v) { return __hip_atomic_fetch_add(p, v, __ATOMIC_RELAXED, __HIP_MEMORY_SCOPE_AGENT); }
__device__ __forceinline__ unsigned xb_xcc_id() { return (unsigned)__builtin_amdgcn_s_getreg((3 << 11) | 20) & 0xFu; }
#define XB_SPIN(cond, bar) do { unsigned _sp = 0; while (cond) { __builtin_amdgcn_s_sleep(1); \
    if ((++_sp & 255u) == 0u) { if (xb_ld(&(bar)[XB_TMO])) break; if (_sp > XB_SPIN_CAP) { atomicAdd(&(bar)[XB_TMO], 1u); break; } } } } while (0)

struct XcdBarrier { unsigned* bar; unsigned x; volatile LAS unsigned* st; };
__device__ __forceinline__ unsigned* xb_opaque(unsigned* p) { unsigned long long v = (unsigned long long)p; unsigned lo = __builtin_amdgcn_readfirstlane((unsigned)v), hi = __builtin_amdgcn_readfirstlane((unsigned)(v >> 32));
    asm volatile("" : "+s"(lo), "+s"(hi)); return (unsigned*)(((unsigned long long)hi << 32) | lo); }

__device__ __forceinline__ XcdBarrier xcd_barrier_post(unsigned* bar, volatile LAS unsigned* st) {
    XcdBarrier b; b.bar = bar; b.x = xb_xcc_id(); b.st = st;
    if (threadIdx.x == 0) (void)xb_add(&bar[XB_XCNT(b.x)], 1u);
    return b;
}
__device__ __forceinline__ void xcd_barrier_complete(unsigned* bar, unsigned x, unsigned& nloc, unsigned& nx) {
    const unsigned G = gridDim.x * gridDim.y * gridDim.z;
    unsigned sum, cnt, mine, sp = 0u;
    for (;;) {
        sum = 0u; cnt = 0u; mine = 0u;
#pragma unroll
        for (unsigned j = 0; j < 16; ++j) { const unsigned c = xb_ld(&bar[XB_XCNT(j)]); sum += c; cnt += (c > 0u) ? 1u : 0u; mine = (j == x) ? c : mine; }
        if (sum == G) break;
        __builtin_amdgcn_s_sleep(1);
        if ((++sp & 255u) == 0u) { if (xb_ld(&bar[XB_TMO])) break; if (sp > XB_SPIN_CAP) { atomicAdd(&bar[XB_TMO], 1u); break; } }
    }
    nloc = mine > 0u ? mine : 1u; nx = cnt > 0u ? cnt : 1u;
}
__device__ __forceinline__ void xcd_barrier(const XcdBarrier& b, const bool is_t0) {
    asm volatile("s_waitcnt vmcnt(0)" ::: "memory");
    __syncthreads();
    if (is_t0) {
        unsigned* bar = b.bar;
        __builtin_amdgcn_s_waitcnt(0);
        unsigned nloc = b.st[0], nx = b.st[1];
        if (nloc == 0u) { xcd_barrier_complete(bar, b.x, nloc, nx); b.st[0] = nloc; b.st[1] = nx; }
        const unsigned old = xb_add(&bar[XB_XSUB(b.x)], 1u);
        const unsigned gen = old / nloc;
        if (old + 1u == (gen + 1u) * nloc) {
            __builtin_amdgcn_fence(__ATOMIC_RELEASE, "agent");
            asm volatile("s_waitcnt vmcnt(0)" ::: "memory");
            const unsigned og = xb_add(&bar[XB_TOP], 1u);
            const unsigned tg = og / nx;
            if (og + 1u == (tg + 1u) * nx) xb_add(&bar[XB_TOPGEN], 1u);
            else XB_SPIN(xb_ld(&bar[XB_TOPGEN]) == tg, bar);
            __builtin_amdgcn_fence(__ATOMIC_ACQUIRE, "agent");
            xb_add(&bar[XB_XGEN(b.x)], 1u);
            asm volatile("s_waitcnt vmcnt(0)" ::: "memory");
        } else {
            XB_SPIN(xb_ld(&bar[XB_XGEN(b.x)]) == gen, bar);
            __builtin_amdgcn_fence(__ATOMIC_ACQUIRE, "agent");
            asm volatile("s_waitcnt vmcnt(0)" ::: "memory");
        }
    }
    __syncthreads();
}

struct Args {
    const float* in[N_IN];
    float* out;
    unsigned char* ws;
    float freq[32];
    int ph_lo, ph_hi;
};

typedef const __attribute__((address_space(4))) Args* KArgs;
__device__ __forceinline__ KArgs kargs() { KArgs p = (KArgs)__builtin_amdgcn_kernarg_segment_ptr(); asm volatile("" : "+s"(p)); return p; }

__device__ __forceinline__ void st_bf16x4(bf16* p, f32x4 v) { u32x2 w; w.x = pk2(v[0], v[1]); w.y = pk2(v[2], v[3]); *(u32x2*)p = w; }


namespace pg8 {
constexpr int BM = 256, BK = 64, HALF = 128, HTB = HALF * BK * 2, STAGE_BYTES = 8 * HTB, NXCD = 8, WGM = 8;
__host__ __device__ __forceinline__ int lds_byte(int r, int c) { const int st = (r >> 4) * 2 + (c >> 5), rr = r & 15, cc = c & 31, ob = rr * 64 + cc * 2; return st * 1024 + (ob ^ (((ob >> 9) & 1) << 5)); }
__host__ __device__ __forceinline__ void stage_rc(int b, int& R, int& C) { const int st = b / 1024, sb = b % 1024, swz = sb ^ (((sb >> 9) & 1) << 5); R = (st >> 1) * 16 + swz / 64; C = (st & 1) * 32 + (swz % 64) / 2; }
__host__ __device__ __forceinline__ int perm32(int rho) { const int n = rho >> 4, i = rho & 15; return 8 * (i >> 2) + 4 * n + (i & 3); }
struct Unit { int pm, pn, e; };
struct DenseOrder {
    static constexpr bool GATHER = false;
    int nM, nN, nwg, G, c, K; const char* Bt;
    __device__ __forceinline__ void init(int M, int N, int K_, const bf16* Bt_, int G_, int c_) { nM = M / BM; nN = N / BM; nwg = nM * nN; G = G_; c = c_; K = K_; Bt = (const char*)Bt_; }
    __device__ __forceinline__ bool next(int i, Unit& u) const {
        const long L = (long)i * G + c; if (L >= nwg) return false;
        int wgid = (int)L; { const int q = nwg / NXCD, r = nwg % NXCD, xcd = wgid % NXCD, off = wgid / NXCD; wgid = (xcd < r ? xcd * (q + 1) : r * (q + 1) + (xcd - r) * q) + off; }
        const int nig = WGM * nN, gid = wgid / nig, fm = gid * WGM, gsz = (nM - fm) < WGM ? (nM - fm) : WGM;
        u.pm = fm + ((wgid % nig) % gsz); u.pn = (wgid % nig) / gsz; u.e = 0; return true;
    }
    __device__ __forceinline__ unsigned a_voff(const Unit& u, int half, int R) const { return (unsigned)((u.pm * BM + half * HALF + R) * K) * 2u; }
    __device__ __forceinline__ const char* b_tile(const Unit& u) const { return Bt + (size_t)u.pn * BM * K * 2; }
};
template <bool GATH> struct MoeOrder {
    static constexpr bool GATHER = GATH;
    int nunits, ntn, G, c, K; const LAS int* off; const LAS int* cn; const int* list; const char* Bt; size_t estride;
    __device__ __forceinline__ bool next(int i, Unit& u) const {
        const int L = i * G + c; if (L >= nunits) return false;
        u.pm = L / ntn; u.pn = L % ntn; const int s0 = u.pm * BM; int e = 0;
#pragma unroll
        for (int q = 1; q < 16; ++q) e += (s0 >= off[q]) ? 1 : 0;
        u.e = e; return true;
    }
    __device__ __forceinline__ unsigned a_voff(const Unit& u, int half, int R) const {
        const int slot = u.pm * BM + half * HALF + R;
        const int loc = slot - off[u.e]; const int tk = list[u.e * T + (loc < cn[u.e] ? loc : 0)];
        return (unsigned)(tk * K) * 2u;
    }
    __device__ __forceinline__ const char* b_tile(const Unit& u) const { return Bt + (size_t)u.e * estride + (size_t)u.pn * BM * K * 2; }
};
__device__ __forceinline__ unsigned cvt_pk_bf16(float lo, float hi) { return pk2(lo, hi); }

template <class Epi, class Sched>
__device__ __forceinline__ void gemm_phase(LAS unsigned char* lds, const bf16* Aptr, int K, const Sched& S, const Epi& E, int wv_) {
    const int tid = opaque_tid(wv_), wid = __builtin_amdgcn_readfirstlane(tid >> 6), lane = tid & 63, wr = wid >> 2, wc = wid & 3, fr = lane & 15, fq = lane >> 4;
    const int nt = K / BK;
    int Rr[2], Cc[2]; unsigned voffA[2], voffB[2];
#pragma unroll
    for (int i = 0; i < 2; ++i) { stage_rc(tid * 16 + i * 8192, Rr[i], Cc[i]); const int Rb = Epi::PERM ? ((Rr[i] & ~31) + perm32(Rr[i] & 31)) : Rr[i];
        voffA[i] = (unsigned)(Rr[i] * K + Cc[i]) * 2u; voffB[i] = (unsigned)(Rb * K + Cc[i]) * 2u; }
    const size_t kstep = (size_t)(BK * 2);
    const size_t hstep = (size_t)HALF * K * 2;
    const size_t tstep = 2 * hstep;
    const unsigned ldsw = (unsigned)wid * 1024u;
    const int aoff = lds_byte(wr * 64 + fr, fq * 8), boff = lds_byte(wc * 32 + fr, fq * 8);
    const char* const Ab = (const char*)Aptr;
#define PG8_SA(b, h) (((b) * 2 + (h)) * HTB)
#define PG8_SB(b, h) ((4 + (b) * 2 + (h)) * HTB)
#define PG8_STAGE(bufoff, gbase, voff) do { _Pragma("unroll") for (int _i = 0; _i < 2; ++_i) \
        __builtin_amdgcn_global_load_lds((const unsigned*)((const char*)(gbase) + (voff)[_i]), (LAS unsigned*)(lds + (bufoff) + ldsw + _i * 8192), 16, 0, 0); } while (0)
#define PG8_STAGE_A(bufoff, usenext, h, kofs) do { \
        if constexpr (Sched::GATHER) { const char* gb_ = Ab + (kofs); unsigned vv_[2] = {(usenext) ? vN[h][0] : vA[h][0], (usenext) ? vN[h][1] : vA[h][1]}; PG8_STAGE(bufoff, gb_, vv_); } \
        else { const char* gb_ = ((usenext) ? nA : cA) + (size_t)(h) * hstep + (kofs); PG8_STAGE(bufoff, gb_, voffA); } } while (0)
#define PG8_LDA(dst, b, h) do { _Pragma("unroll") for (int m = 0; m < 4; ++m) _Pragma("unroll") for (int k = 0; k < 2; ++k) dst[m][k] = *(const LAS bf16x8*)(lds + PG8_SA(b, h) + aoff + m * 2048 + k * 1024); } while (0)
#define PG8_LDB(dst, b, h) do { _Pragma("unroll") for (int n = 0; n < 2; ++n) _Pragma("unroll") for (int k = 0; k < 2; ++k) dst[n][k] = *(const LAS bf16x8*)(lds + PG8_SB(b, h) + boff + n * 2048 + k * 1024); } while (0)
#define PG8_MMA(ai, bj, At, Bt) do { __builtin_amdgcn_s_setprio(1); _Pragma("unroll") for (int m = 0; m < 4; ++m) _Pragma("unroll") for (int n = 0; n < 2; ++n) _Pragma("unroll") for (int k = 0; k < 2; ++k) \
        acc[ai][bj][m][n] = __builtin_amdgcn_mfma_f32_16x16x32_bf16(Bt[n][k], At[m][k], acc[ai][bj][m][n], 0, 0, 0); __builtin_amdgcn_s_setprio(0); } while (0)
#define PG8_WAIT_V(n) asm volatile("s_waitcnt vmcnt(" #n ")" ::: "memory")
#define PG8_WAIT_L(n) asm volatile("s_waitcnt lgkmcnt(" #n ")" ::: "memory")
#define PG8_BAR __builtin_amdgcn_s_barrier()
#define PG8_SCHED __builtin_amdgcn_sched_barrier(0)
    Unit cur, nxt; int ui = 0;
    if (!S.next(0, cur)) return;
    f32x4 acc[2][2][4][2];
#pragma unroll
    for (int a = 0; a < 2; ++a)
#pragma unroll
        for (int b = 0; b < 2; ++b)
#pragma unroll
            for (int m = 0; m < 4; ++m)
#pragma unroll
                for (int n = 0; n < 2; ++n) acc[a][b][m][n] = (f32x4){0.f, 0.f, 0.f, 0.f};
    bf16x8 At[4][2], B0[2][2], B1[2][2];
    unsigned vA[2][2], vN[2][2];
    const char* cA = Ab; const char* nA = Ab;
    if constexpr (Sched::GATHER) {
#pragma unroll
        for (int h = 0; h < 2; ++h)
#pragma unroll
            for (int i = 0; i < 2; ++i) { vA[h][i] = S.a_voff(cur, h, Rr[i]) + (unsigned)Cc[i] * 2u; vN[h][i] = vA[h][i]; }
    } else { cA = Ab + (size_t)cur.pm * tstep; nA = cA; }
    const char* cB = S.b_tile(cur);
    PG8_STAGE(PG8_SB(0, 0), cB, voffB); PG8_STAGE_A(PG8_SA(0, 0), false, 0, 0); PG8_STAGE(PG8_SB(0, 1), cB + hstep, voffB); PG8_STAGE_A(PG8_SA(0, 1), false, 1, 0);
    if (wr == 1) PG8_BAR;
    PG8_WAIT_V(4); PG8_BAR;
    PG8_STAGE(PG8_SB(1, 0), cB + kstep, voffB); PG8_STAGE_A(PG8_SA(1, 0), false, 0, kstep); PG8_STAGE(PG8_SB(1, 1), cB + hstep + kstep, voffB);
    PG8_WAIT_V(6); PG8_BAR;
    for (;;) {
        const bool has_next = S.next(ui + 1, nxt);
        const char* nB = has_next ? S.b_tile(nxt) : cB;
        if constexpr (Sched::GATHER) {
#pragma unroll
            for (int h = 0; h < 2; ++h)
#pragma unroll
                for (int i = 0; i < 2; ++i) vN[h][i] = has_next ? S.a_voff(nxt, h, Rr[i]) + (unsigned)Cc[i] * 2u : vA[h][i];
        } else nA = has_next ? Ab + (size_t)nxt.pm * tstep : cA;
        for (int t = 0; t < nt; t += 2) {
            const bool last = (t == nt - 2);
            const size_t k1 = (size_t)(t + 1) * kstep, k2 = last ? 0 : (size_t)(t + 2) * kstep, k3 = k2 + kstep;
            const char* b2 = last ? nB : cB + (size_t)(t + 2) * kstep; const char* b3 = b2 + kstep;
            PG8_LDB(B0, 0, 0); PG8_SCHED; PG8_LDA(At, 0, 0); PG8_STAGE_A(PG8_SA(1, 1), false, 1, k1);
            PG8_WAIT_L(8); PG8_BAR; PG8_WAIT_L(0); PG8_MMA(0, 0, At, B0); PG8_BAR; PG8_SCHED;
            PG8_LDB(B1, 0, 1); PG8_STAGE(PG8_SB(0, 0), b2, voffB);
            PG8_BAR; PG8_WAIT_L(0); PG8_MMA(0, 1, At, B1); PG8_BAR;
            PG8_LDA(At, 0, 1); PG8_STAGE_A(PG8_SA(0, 0), last, 0, k2);
            PG8_BAR; PG8_WAIT_L(0); PG8_MMA(1, 0, At, B0); PG8_BAR; PG8_SCHED;
            PG8_STAGE(PG8_SB(0, 1), b2 + hstep, voffB);
            PG8_WAIT_V(6); PG8_BAR; PG8_MMA(1, 1, At, B1); PG8_BAR;
            PG8_LDB(B0, 1, 0); PG8_SCHED; PG8_LDA(At, 1, 0); PG8_STAGE_A(PG8_SA(0, 1), last, 1, k2);
            PG8_WAIT_L(8); PG8_BAR; PG8_WAIT_L(0); PG8_MMA(0, 0, At, B0); PG8_BAR; PG8_SCHED;
            PG8_LDB(B1, 1, 1); PG8_STAGE(PG8_SB(1, 0), b3, voffB);
            PG8_BAR; PG8_WAIT_L(0); PG8_MMA(0, 1, At, B1); PG8_BAR;
            PG8_LDA(At, 1, 1); PG8_STAGE_A(PG8_SA(1, 0), last, 0, k3);
            PG8_BAR; PG8_WAIT_L(0); PG8_MMA(1, 0, At, B0); PG8_BAR; PG8_SCHED;
            PG8_STAGE(PG8_SB(1, 1), b3 + hstep, voffB);
            PG8_WAIT_V(6); PG8_BAR; PG8_MMA(1, 1, At, B1); PG8_BAR;
        }
        E(acc, cur, wr, wc, fr, fq);
        if (!has_next) break;
#pragma unroll
        for (int a = 0; a < 2; ++a)
#pragma unroll
            for (int b = 0; b < 2; ++b)
#pragma unroll
                for (int m = 0; m < 4; ++m)
#pragma unroll
                    for (int n = 0; n < 2; ++n) acc[a][b][m][n] = (f32x4){0.f, 0.f, 0.f, 0.f};
        cur = nxt; cB = nB; cA = nA; ++ui;
        if constexpr (Sched::GATHER) {
#pragma unroll
            for (int h = 0; h < 2; ++h)
#pragma unroll
                for (int i = 0; i < 2; ++i) vA[h][i] = vN[h][i];
        }
    }
    PG8_WAIT_V(0);
    if (wr == 0) PG8_BAR;
    PG8_BAR;
#undef PG8_SA
#undef PG8_SB
#undef PG8_STAGE
#undef PG8_STAGE_A
#undef PG8_LDA
#undef PG8_LDB
#undef PG8_MMA
#undef PG8_WAIT_V
#undef PG8_WAIT_L
#undef PG8_BAR
#undef PG8_SCHED
}
template <int ACT> struct EpiBf16 {
    static constexpr bool PERM = true;
    bf16* O; int ldc; int tpt; size_t tstride; float* stats; int stat_pn0;
    __device__ __forceinline__ void operator()(const f32x4 (&acc)[2][2][4][2], const Unit& u, int wr, int wc, int fr, int fq) const {
        const int row0 = u.pm * BM + wr * 64 + fr; const int tt = u.pn / tpt; bf16* base = O + (size_t)tt * tstride; const int col0 = (u.pn - tt * tpt) * BM + wc * 32 + 8 * fq;
#pragma unroll
        for (int ai = 0; ai < 2; ++ai)
#pragma unroll
            for (int m = 0; m < 4; ++m) { bf16* rowp = base + (size_t)(row0 + ai * HALF + m * 16) * ldc + col0; float psum = 0.f, psq = 0.f;
#pragma unroll
                for (int bj = 0; bj < 2; ++bj) { f32x4 v0 = acc[ai][bj][m][0], v1 = acc[ai][bj][m][1];
                    if (ACT == 1) {
#pragma unroll
                        for (int q = 0; q < 4; ++q) { v0[q] = gelu_tanh(v0[q]); v1[q] = gelu_tanh(v1[q]); } }
                    if (ACT == 1) { psum += ((v0[0] + v0[1]) + (v0[2] + v0[3])) + ((v1[0] + v1[1]) + (v1[2] + v1[3]));
                        psq += ((v0[0] * v0[0] + v0[1] * v0[1]) + (v0[2] * v0[2] + v0[3] * v0[3])) + ((v1[0] * v1[0] + v1[1] * v1[1]) + (v1[2] * v1[2] + v1[3] * v1[3])); }
                    u32x4 w; w.x = cvt_pk_bf16(v0[0], v0[1]); w.y = cvt_pk_bf16(v0[2], v0[3]); w.z = cvt_pk_bf16(v1[0], v1[1]); w.w = cvt_pk_bf16(v1[2], v1[3]);
                    *(u32x4*)(rowp + bj * HALF) = w; }
                if (ACT == 1 && stats && u.pn >= stat_pn0) {
                    psum += __shfl_xor(psum, 16); psum += __shfl_xor(psum, 32); psq += __shfl_xor(psq, 16); psq += __shfl_xor(psq, 32);
                    if (fq == 0) { f32x2 st2 = {psum, psq}; *(f32x2*)(stats + ((size_t)(row0 + ai * HALF + m * 16) * 32 + (u.pn - stat_pn0) * 4 + wc) * 2) = st2; } } }
    }
};
struct EpiResAdd {
    static constexpr bool PERM = false;
    float* X; int ldc;
    __device__ __forceinline__ void operator()(const f32x4 (&acc)[2][2][4][2], const Unit& u, int wr, int wc, int fr, int fq) const {
        const int row0 = u.pm * BM + wr * 64 + fr, col0 = u.pn * BM + wc * 32 + 4 * fq;
#pragma unroll
        for (int ai = 0; ai < 2; ++ai)
#pragma unroll
            for (int m2 = 0; m2 < 4; m2 += 2) {
                f32x4 x[2][2][2];
#pragma unroll
                for (int mm = 0; mm < 2; ++mm)
#pragma unroll
                    for (int bj = 0; bj < 2; ++bj)
#pragma unroll
                        for (int n = 0; n < 2; ++n) x[mm][bj][n] = *(const f32x4*)(X + (size_t)(row0 + ai * HALF + (m2 + mm) * 16) * ldc + col0 + bj * HALF + n * 16);
#pragma unroll
                for (int mm = 0; mm < 2; ++mm)
#pragma unroll
                    for (int bj = 0; bj < 2; ++bj)
#pragma unroll
                        for (int n = 0; n < 2; ++n) *(f32x4*)(X + (size_t)(row0 + ai * HALF + (m2 + mm) * 16) * ldc + col0 + bj * HALF + n * 16) = x[mm][bj][n] + acc[ai][bj][m2 + mm][n];
            }
    }
};
struct EpiResAddNorm {
    static constexpr bool PERM = false;
    float* X; int ldc; bf16* XB; float* rowsq;
    __device__ __forceinline__ void operator()(const f32x4 (&acc)[2][2][4][2], const Unit& u, int wr, int wc, int fr, int fq) const {
        const int row0 = u.pm * BM + wr * 64 + fr, col0 = u.pn * BM + wc * 32 + 4 * fq;
#pragma unroll
        for (int ai = 0; ai < 2; ++ai)
#pragma unroll
            for (int m2 = 0; m2 < 4; m2 += 2) {
                f32x4 x[2][2][2];
#pragma unroll
                for (int mm = 0; mm < 2; ++mm)
#pragma unroll
                    for (int bj = 0; bj < 2; ++bj)
#pragma unroll
                        for (int n = 0; n < 2; ++n) x[mm][bj][n] = *(const f32x4*)(X + (size_t)(row0 + ai * HALF + (m2 + mm) * 16) * ldc + col0 + bj * HALF + n * 16);
#pragma unroll
                for (int mm = 0; mm < 2; ++mm) {
                    const size_t ro = (size_t)(row0 + ai * HALF + (m2 + mm) * 16) * ldc + col0; float ssq = 0.f;
#pragma unroll
                    for (int bj = 0; bj < 2; ++bj)
#pragma unroll
                        for (int n = 0; n < 2; ++n) { const f32x4 v = x[mm][bj][n] + acc[ai][bj][m2 + mm][n];
                            *(f32x4*)(X + ro + bj * HALF + n * 16) = v;
                            u32x2 w; w.x = cvt_pk_bf16(v.x, v.y); w.y = cvt_pk_bf16(v.z, v.w); *(u32x2*)(XB + ro + bj * HALF + n * 16) = w;
                            ssq += (v.x * v.x + v.y * v.y) + (v.z * v.z + v.w * v.w); }
                    ssq += __shfl_xor(ssq, 16); ssq += __shfl_xor(ssq, 32);
                    if (fq == 0) rowsq[(size_t)(row0 + ai * HALF + (m2 + mm) * 16) * 16 + u.pn * 4 + wc] = ssq;
                }
            }
    }
};
struct EpiBf16RowScale {
    static constexpr bool PERM = true;
    bf16* O; int ldc; const float* rowsq;
    __device__ __forceinline__ void operator()(const f32x4 (&acc)[2][2][4][2], const Unit& u, int wr, int wc, int fr, int fq) const {
        const int row0 = u.pm * BM + wr * 64 + fr, col0 = u.pn * BM + wc * 32 + 8 * fq;
#pragma unroll
        for (int ai = 0; ai < 2; ++ai) {
            float rs[4];
#pragma unroll
            for (int m = 0; m < 4; ++m) { const f32x4* p = (const f32x4*)(rowsq + (size_t)(row0 + ai * HALF + m * 16) * 16); const f32x4 a = p[0], b = p[1], c = p[2], d = p[3];
                rs[m] = rsqrtf((((a.x + a.y) + (a.z + a.w)) + ((b.x + b.y) + (b.z + b.w)) + (((c.x + c.y) + (c.z + c.w)) + ((d.x + d.y) + (d.z + d.w)))) * (1.f / 1024.f) + EPS); }
#pragma unroll
            for (int m = 0; m < 4; ++m) { bf16* rowp = O + (size_t)(row0 + ai * HALF + m * 16) * ldc + col0;
#pragma unroll
                for (int bj = 0; bj < 2; ++bj) { const f32x4 v0 = acc[ai][bj][m][0] * rs[m], v1 = acc[ai][bj][m][1] * rs[m];
                    u32x4 w; w.x = cvt_pk_bf16(v0[0], v0[1]); w.y = cvt_pk_bf16(v0[2], v0[3]); w.z = cvt_pk_bf16(v1[0], v1[1]); w.w = cvt_pk_bf16(v1[2], v1[3]);
                    *(u32x4*)(rowp + bj * HALF) = w; } }
        }
    }
};
struct EpiSwiglu {
    static constexpr bool PERM = true;
    bf16* H; int ldc;
    __device__ __forceinline__ void operator()(const f32x4 (&acc)[2][2][4][2], const Unit& u, int wr, int wc, int fr, int fq) const {
        const int row0 = u.pm * BM + wr * 64 + fr, col0 = u.pn * HALF + wc * 32 + 8 * fq;
#pragma unroll
        for (int ai = 0; ai < 2; ++ai)
#pragma unroll
            for (int m = 0; m < 4; ++m) {
                float o[8];
#pragma unroll
                for (int n = 0; n < 2; ++n)
#pragma unroll
                    for (int q = 0; q < 4; ++q) { const float g = acc[ai][0][m][n][q]; o[4 * n + q] = g * sigmoidf_(g) * acc[ai][1][m][n][q]; }
                u32x4 w; w.x = cvt_pk_bf16(o[0], o[1]); w.y = cvt_pk_bf16(o[2], o[3]); w.z = cvt_pk_bf16(o[4], o[5]); w.w = cvt_pk_bf16(o[6], o[7]);
                *(u32x4*)(H + (size_t)(row0 + ai * HALF + m * 16) * ldc + col0) = w; }
    }
};
}

__device__ __forceinline__ int hyb_colmap(int n) {
    if (n < 1280) return n;
    if (n < 1536) return 1304 + (n - 1280);
    if (n < 1792) return 1560 + (n - 1536);
    if (n < 2304) return 1816 + (n - 1792);
    if (n < 2816) return 2344 + (n - 2304);
    if (n < 2840) return 1280 + (n - 2816);
    if (n < 2856) return 2328 + (n - 2840);
    return -1;
}
__device__ __forceinline__ void tr_item(const float* __restrict__ W, int Nsrc, int K, bf16* __restrict__ Wt, const float* __restrict__ gain, int kind, int nblk, LAS float* scr, int item, int lane) {
    const int kb = item / nblk, nb = item % nblk, k0 = 64 * kb, n0 = 64 * nb;
    const int ksub = lane >> 4, n4 = lane & 15, n = n0 + 4 * n4;
    int col;
    if (kind == 0) col = n; else if (kind == 1) col = hyb_colmap(n); else { const int pn = n >> 8, r = n & 255; col = (r >> 7) * 384 + pn * 128 + (r & 127); }
    f32x4 v[16];
#pragma unroll
    for (int i = 0; i < 16; ++i) v[i] = col >= 0 ? *(const f32x4*)(W + (size_t)(k0 + 4 * i + ksub) * Nsrc + col) : (f32x4){0.f, 0.f, 0.f, 0.f};
    if (gain) {
#pragma unroll
        for (int i = 0; i < 16; ++i) v[i] = v[i] * gain[k0 + 4 * i + ksub];
    }
#pragma unroll
    for (int i = 0; i < 16; ++i) { LAS float* d = scr + (4 * i + ksub) * 65 + 4 * n4; d[0] = v[i].x; d[1] = v[i].y; d[2] = v[i].z; d[3] = v[i].w; }
    LDS_WAIT();
    const int c = lane & 7;
#pragma unroll
    for (int jx = 0; jx < 8; ++jx) {
        const int nn = (lane >> 3) + 8 * jx; const LAS float* s = scr + (8 * c) * 65 + nn;
        u32x4 o; o.x = pk2(s[0 * 65], s[1 * 65]); o.y = pk2(s[2 * 65], s[3 * 65]); o.z = pk2(s[4 * 65], s[5 * 65]); o.w = pk2(s[6 * 65], s[7 * 65]);
        *(u32x4*)(Wt + (size_t)(n0 + nn) * K + k0 + 8 * c) = o;
    }
    LDS_WAIT();
}
__device__ __forceinline__ void rms_row_to_bf16(const float* __restrict__ xrow, bf16* __restrict__ orow, float* __restrict__ copy, int lane) {
    const f32x4* xr = (const f32x4*)xrow + lane;
    f32x4 v[4]; float s = 0.f;
#pragma unroll
    for (int j = 0; j < 4; ++j) { v[j] = xr[64 * j]; s += (v[j].x * v[j].x + v[j].y * v[j].y) + (v[j].z * v[j].z + v[j].w * v[j].w); }
    const float rstd = rsqrtf(wave_sum(s) * (1.f / 1024.f) + EPS);
    u32x2* o8 = (u32x2*)orow + lane;
#pragma unroll
    for (int j = 0; j < 4; ++j) { u32x2 w; w.x = pk2(v[j].x * rstd, v[j].y * rstd); w.y = pk2(v[j].z * rstd, v[j].w * rstd); o8[64 * j] = w; }
    if (copy) { f32x4* c4 = (f32x4*)copy + lane;
#pragma unroll
        for (int j = 0; j < 4; ++j) c4[64 * j] = v[j]; }
}

__device__ __forceinline__ void phase_prologue(KArgs A, int wv_, LAS unsigned char* lds) {
    const int tid = opaque_tid(wv_), wid = __builtin_amdgcn_readfirstlane(tid >> 6), lane = tid & 63;
    const int gw = blockIdx.x * 8 + wid, NGW = gridDim.x * 8;
    LAS float* scr = (LAS float*)(lds + wid * 16640);
    unsigned char* ws = opq(A->ws);
    constexpr int N_HYB = 2 * 768, N_HOUT = 2 * 256, N_SGIN = 2 * 1024, N_SGOUT = 2 * 512, N_WQ = 4 * 256, N_WKV = 4 * 512, N_WO = 4 * 256, N_MIN = 64 * 192, N_MOUT = 64 * 96, N_W1T = 4 * 32;
    constexpr int NITEMS = N_HYB + N_HOUT + N_SGIN + N_SGOUT + N_WQ + N_WKV + N_WO + N_MIN + N_MOUT + N_W1T;
    for (int it = gw; it < NITEMS; it += NGW) {
        int r = it;
        if (r < N_HYB) { const int sl = r / 768; tr_item(A->in[I_HYBIN] + (size_t)sl * 1024 * HYSRC, HYSRC, 1024, (bf16*)(ws + WS_WHYB) + (size_t)sl * HYN * 1024, A->in[I_NMIX] + (2 * sl) * 1024, 1, 48, scr, r % 768, lane); continue; } r -= N_HYB;
        if (r < N_HOUT) { const int sl = r / 256; tr_item(A->in[I_HYBOUT] + (size_t)sl * 1024 * 1024, 1024, 1024, (bf16*)(ws + WS_WHOUT) + (size_t)sl * 1024 * 1024, nullptr, 0, 16, scr, r % 256, lane); continue; } r -= N_HOUT;
        if (r < N_SGIN) { const int sl = r / 1024; tr_item(A->in[I_SGIN] + (size_t)sl * 1024 * 4096, 4096, 1024, (bf16*)(ws + WS_WSGIN) + (size_t)sl * 4096 * 1024, A->in[I_NMIX] + (2 * sl + 1) * 1024, 0, 64, scr, r % 1024, lane); continue; } r -= N_SGIN;
        if (r < N_SGOUT) { const int sl = r / 512; tr_item(A->in[I_SGOUT] + (size_t)sl * 2048 * 1024, 1024, 2048, (bf16*)(ws + WS_WSGOUT) + (size_t)sl * 1024 * 2048, nullptr, 0, 16, scr, r % 512, lane); continue; } r -= N_SGOUT;
        if (r < N_WQ) { const int sl = r / 256; tr_item(A->in[I_XWQ] + (size_t)sl * 1024 * 1024, 1024, 1024, (bf16*)(ws + WS_WQ) + (size_t)sl * 1024 * 1024, A->in[I_NXAT] + sl * 1024, 0, 16, scr, r % 256, lane); continue; } r -= N_WQ;
        if (r < N_WKV) { const int sl = r / 512; tr_item(A->in[I_XWKV] + (size_t)sl * 1024 * 2048, 2048, 1024, (bf16*)(ws + WS_WKV) + (size_t)sl * 2048 * 1024, A->in[I_NMEM] + sl * 1024, 0, 32, scr, r % 512, lane); continue; } r -= N_WKV;
        if (r < N_WO) { const int sl = r / 256; tr_item(A->in[I_XWO] + (size_t)sl * 1024 * 1024, 1024, 1024, (bf16*)(ws + WS_WO) + (size_t)sl * 1024 * 1024, nullptr, 0, 16, scr, r % 256, lane); continue; } r -= N_WO;
        if (r < N_MIN) { const int sl = r / 192; tr_item(A->in[I_MOEIN] + (size_t)sl * 1024 * 768, 768, 1024, (bf16*)(ws + WS_WMIN) + (size_t)sl * 768 * 1024, A->in[I_NFFN] + (sl >> 4) * 1024, 2, 12, scr, r % 192, lane); continue; } r -= N_MIN;
        if (r < N_MOUT) { const int sl = r / 96; tr_item(A->in[I_MOEOUT] + (size_t)sl * 384 * 1024, 1024, 384, (bf16*)(ws + WS_WMOUT) + (size_t)sl * 1024 * 384, nullptr, 0, 16, scr, r % 96, lane); continue; } r -= N_MOUT;
        { const int sl = r / 32; tr_item(A->in[I_CMPW1] + (size_t)sl * 2048 * 64, 64, 2048, (bf16*)(ws + WS_W1T) + (size_t)sl * 64 * 2048, nullptr, 0, 1, scr, r % 32, lane); }
    }
    for (int m = gw; m < T; m += NGW) rms_row_to_bf16(A->in[I_X] + (size_t)m * D, (bf16*)(ws + WS_XN) + (size_t)m * D, A->out + (size_t)m * D, lane);
    for (int m = gw; m < NBATCH * NMEM; m += NGW) rms_row_to_bf16(A->in[I_MEM] + (size_t)m * D, (bf16*)(ws + WS_MN) + (size_t)m * D, nullptr, lane);
    const int gt = blockIdx.x * 512 + tid, NGT = gridDim.x * 512;
    const int* pos = (const int*)A->in[I_POS];
    float* cosT = (float*)(ws + WS_COS); float* sinT = (float*)(ws + WS_SIN);
    for (int i = gt; i < T * 32; i += NGT) {
        const int t = i >> 5, j = i & 31;
        const float ang = (float)pos[t] * A->freq[j];
        const double rev = (double)ang * 0.15915494309189533577;
        const float fr = (float)(rev - rint(rev));
        cosT[i] = __builtin_amdgcn_cosf(fr); sinT[i] = __builtin_amdgcn_sinf(fr);
    }
    { bf16* WSB = (bf16*)(ws + WS_WSB); float* M0 = (float*)(ws + WS_M0); const float* wsg = A->in[I_SGWS];
      for (int e = gt; e < 2 * 8 * 128 * 128; e += NGT) { const int s = e & 127, t = (e >> 7) & 127; WSB[e] = (bf16)f2bf(s <= t ? wsg[e] : 0.f); }
      for (int e = gt; e < 2 * 8 * 128; e += NGT) { const int t = e & 127; const float* r = wsg + (size_t)e * 128; float a = 0.f; for (int s = 0; s <= t; ++s) a += r[s]; M0[e] = a; } }
    float* RW = (float*)(ws + WS_RW);
    for (int i = gt; i < DEPTH * NEXP * D; i += NGT) { const int k = i & 1023, e = (i >> 10) & 15, l = i >> 14; RW[i] = A->in[I_RW][k * NEXP + e] * A->in[I_NFFN][l * D + k]; }
}

__device__ __forceinline__ void phase_knorm(KArgs A, int wv_, const int gw, const int NGW) {
    const int tid_ = opaque_tid(wv_); const int lane = tid_ & 63;
    bf16* KV = (bf16*)(opq(A->ws) + WS_KV);
    for (int it0 = gw * 4; it0 < DEPTH * 2048 * 4; it0 += NGW * 4) {
        u32x2 w[4];
#pragma unroll
        for (int q = 0; q < 4; ++q) { const int it = it0 + q; const int h = it & 3, m = (it >> 2) & 2047, l = it >> 13; w[q] = *(const u32x2*)(KV + (size_t)m * 8192 + l * 2048 + h * 256 + 4 * lane); }
#pragma unroll
        for (int q = 0; q < 4; ++q) {
            const int it = it0 + q; const int h = it & 3, m = (it >> 2) & 2047, l = it >> 13;
            const float x0 = bflo(w[q].x), x1 = bfhi(w[q].x), x2 = bflo(w[q].y), x3 = bfhi(w[q].y);
            const float rstd = rsqrtf(wave_sum(x0 * x0 + x1 * x1 + x2 * x2 + x3 * x3) * (1.f / 256.f) + EPS) * 0.0625f;
            const f32x4 g = *(const f32x4*)(A->in[I_XKN] + l * 256 + 4 * lane) * *(const f32x4*)(A->in[I_XQN] + l * 256 + 4 * lane);
            u32x2 o; o.x = pk2(x0 * rstd * g.x, x1 * rstd * g.y); o.y = pk2(x2 * rstd * g.z, x3 * rstd * g.w);
            *(u32x2*)(KV + (size_t)m * 8192 + l * 2048 + h * 256 + 4 * lane) = o;
        }
    }
}

__device__ __forceinline__ int kpos64(int tok) { const int k = tok & 31; return (tok & 32) + 8 * ((k >> 2) & 3) + 4 * (k >> 4) + (k & 3); }
__device__ __forceinline__ int kperm64(int p) { const int fq = (p >> 3) & 3, j = p & 7; return (p & 32) + 16 * (j >> 2) + 4 * fq + (j & 3); }

__device__ __forceinline__ void phase_nsa_prep(KArgs A, int wv_, int i, LAS unsigned char* lds) {
    const int tid_ = opaque_tid(wv_); const int wid = __builtin_amdgcn_readfirstlane(tid_ >> 6), lane = tid_ & 63; const int gw = blockIdx.x * 8 + wid, NGW = gridDim.x * 8;
    unsigned char* ws = opq(A->ws);
    const bf16* HY = (const bf16*)(ws + WS_BIG);
    const float* cosT = (const float*)(ws + WS_COS); const float* sinT = (const float*)(ws + WS_SIN);
    bf16* QA = (bf16*)(ws + WS_QA); bf16* KS = (bf16*)(ws + WS_KS); bf16* KW = (bf16*)(ws + WS_KW);
    LAS float* abuf = (LAS float*)(lds + wid * 8192);
    const int NIT = T;
    for (int it = gw; it < NIT; it += NGW) {
        if (it < T) {
            const int t = it;
            const float c = cosT[t * 32 + (lane & 31)], s = sinT[t * 32 + (lane & 31)];
            float xin[12];
#pragma unroll
            for (int u = 0; u < 12; ++u) xin[u] = bf2f(HY[(size_t)t * HYN + (u < 8 ? C_QA + 64 * u : (u < 10 ? C_KS + 64 * (u - 8) : C_KW + 64 * (u - 10))) + lane]);
#pragma unroll
            for (int u = 0; u < 12; ++u) {
                int src; const float* gain; bf16* dst; float scale;
                if (u < 8) { src = C_QA + 64 * u; gain = A->in[I_QNORM] + i * 64; dst = QA + (size_t)t * 512 + 64 * u; scale = 0.125f * 1.4426950408889634f; }
                else if (u < 10) { src = C_KS + 64 * (u - 8); gain = A->in[I_KNORM] + (i * 3 + 1) * 64; dst = KS + (size_t)t * 128 + 64 * (u - 8); scale = 1.f; }
                else { src = C_KW + 64 * (u - 10); gain = A->in[I_KNORM] + (i * 3 + 2) * 64; dst = KW + (size_t)t * 128 + 64 * (u - 10); scale = 1.f; }
                const float x = xin[u]; (void)src;
                const float y = x * rsqrtf(wave_sum(x * x) * (1.f / 64.f) + EPS) * gain[lane] * scale;
                const float pr = __shfl_xor(y, 32);
                const float o = lane < 32 ? y * c - pr * s : y * c + pr * s;
                dst[lane] = (bf16)f2bf(o);
            }
        }
    }
}


__device__ __forceinline__ void phase_compress_mfma(KArgs A, int wv_, int i, LAS unsigned char* lds) {
    const int tid = opaque_tid(wv_), wid = __builtin_amdgcn_readfirstlane(tid >> 6), lane = tid & 63, fr = lane & 15, fq = lane >> 4;
    unsigned char* ws = opq(A->ws);
    const bf16* HY = (const bf16*)(ws + WS_BIG);
    const float* cosT = (const float*)(ws + WS_COS); const float* sinT = (const float*)(ws + WS_SIN);
    LAS float* part = (LAS float*)lds;
    LAS float* hbuf = part + 8 * 1024;
    LAS float* obuf = hbuf + 1024;
    LAS float* w2l = obuf + 1024;
    int w2kv = -1;
    for (int it = blockIdx.x; it < 2 * 127; it += gridDim.x) {
        const int kv = it / 127, tile = it % 127;
        const float* pe = A->in[I_CMPPE] + (size_t)(i * 2 + kv) * 32 * 64;
        const float* w2 = A->in[I_CMPW2] + (size_t)(i * 2 + kv) * 64 * 64;
        const bf16* w1t = (const bf16*)(ws + WS_W1T) + (size_t)(i * 2 + kv) * 64 * 2048;
        const int coff = kv ? C_VC : C_KC;
        if (kv != w2kv) { __syncthreads(); for (int e4 = tid; e4 < 1024; e4 += 512) *(LAS f32x4*)(w2l + 4 * e4) = *(const f32x4*)(w2 + 4 * e4); w2kv = kv; }
        {
            const int R = tile * 16 + fr, g = R & 1, bn = R >> 1, n = bn % NCMP, b = bn / NCMP;
            const bf16* arow = HY + (size_t)(b * S + 16 * n) * HYN + coff + g * 64;
            f32x4 acc[4];
#pragma unroll
            for (int t = 0; t < 4; ++t) acc[t] = (f32x4){0.f, 0.f, 0.f, 0.f};
#pragma unroll 4
            for (int s = 0; s < 8; ++s) {
                const int k0 = 256 * wid + 32 * s, l = k0 >> 6, d0 = (k0 & 63) + 8 * fq;
                const u32x4 hw = *(const u32x4*)(arow + (size_t)l * HYN + d0);
                const f32x4 p0 = *(const f32x4*)(pe + l * 64 + d0), p1 = *(const f32x4*)(pe + l * 64 + d0 + 4);
                u32x4 aw; aw.x = pk2(bflo(hw.x) + p0.x, bfhi(hw.x) + p0.y); aw.y = pk2(bflo(hw.y) + p0.z, bfhi(hw.y) + p0.w); aw.z = pk2(bflo(hw.z) + p1.x, bfhi(hw.z) + p1.y); aw.w = pk2(bflo(hw.w) + p1.z, bfhi(hw.w) + p1.w);
                const bf16x8 af = __builtin_bit_cast(bf16x8, aw);
#pragma unroll
                for (int t = 0; t < 4; ++t) { const bf16x8 bfr = *(const bf16x8*)(w1t + (size_t)(16 * t + fr) * 2048 + k0 + 8 * fq);
                    acc[t] = __builtin_amdgcn_mfma_f32_16x16x32_bf16(af, bfr, acc[t], 0, 0, 0); }
            }
            __syncthreads();
#pragma unroll
            for (int t = 0; t < 4; ++t)
#pragma unroll
                for (int r = 0; r < 4; ++r) part[wid * 1024 + (4 * fq + r) * 64 + 16 * t + fr] = acc[t][r];
        }
        __syncthreads();
        for (int e = tid; e < 1024; e += 512) { float a = 0.f;
#pragma unroll
            for (int w = 0; w < 8; ++w) a += part[w * 1024 + e];
            hbuf[e] = gelu_tanh(a); }
        __syncthreads();
        for (int e = tid; e < 1024; e += 512) { const int r = e >> 6, j = e & 63; float o = 0.f;
#pragma unroll 8
            for (int m = 0; m < 64; ++m) o += hbuf[r * 64 + m] * w2l[m * 64 + j];
            obuf[e] = o; }
        __syncthreads();
        for (int r = wid; r < 16; r += 8) {
            const int R = tile * 16 + r, g = R & 1, bn = R >> 1, n = bn % NCMP, b = bn / NCMP;
            const float o = obuf[r * 64 + lane];
            if (kv == 0) {
                const float y = o * rsqrtf(wave_sum(o * o) * (1.f / 64.f) + EPS) * A->in[I_KNORM][(i * 3 + 0) * 64 + lane];
                const int tp = b * S + 16 * n + 31;
                const float c = cosT[tp * 32 + (lane & 31)], sn = sinT[tp * 32 + (lane & 31)];
                const float pr = __shfl_xor(y, 32);
                const float oo = lane < 32 ? y * c - pr * sn : y * c + pr * sn;
                ((bf16*)(ws + WS_KC))[((size_t)(b * 128 + n) * 2 + g) * 64 + lane] = (bf16)f2bf(oo);
            } else {
                bf16* vct = (bf16*)(ws + WS_VC) + ((size_t)(b * 2 + g) * 64 + lane) * 128;
                vct[(n & 64) + kpos64(n & 63)] = (bf16)f2bf(o);
                if (n == 126) vct[127] = 0;
            }
        }
    }
    __syncthreads();
}

__device__ __forceinline__ void nsa_block(const LAS float* qs, const bf16* __restrict__ krow, bool ok, const bf16* __restrict__ vbase, int vstride, int lane,
                                          float (&m)[4], float (&l)[4], float (&o)[4]) {
    float s[4] = {0.f, 0.f, 0.f, 0.f};
#pragma unroll 2
    for (int c = 0; c < 8; ++c) {
        const u32x4 kw = *(const u32x4*)(krow + 8 * c);
        const float k0 = bflo(kw.x), k1 = bfhi(kw.x), k2 = bflo(kw.y), k3 = bfhi(kw.y), k4 = bflo(kw.z), k5 = bfhi(kw.z), k6 = bflo(kw.w), k7 = bfhi(kw.w);
#pragma unroll
        for (int hh = 0; hh < 4; ++hh) {
            const f32x4 qa = *(const LAS f32x4*)(qs + hh * 64 + 8 * c), qb = *(const LAS f32x4*)(qs + hh * 64 + 8 * c + 4);
            s[hh] += (qa.x * k0 + qa.y * k1) + (qa.z * k2 + qa.w * k3) + (qb.x * k4 + qb.y * k5) + (qb.z * k6 + qb.w * k7);
        }
    }
    float p[4];
#pragma unroll
    for (int hh = 0; hh < 4; ++hh) {
        const float sv = ok ? s[hh] : -INFINITY;
        const float bm = wave_max(sv);
        const float mn = fmaxf(m[hh], bm);
        if (mn == -INFINITY) { p[hh] = 0.f; continue; }
        const float alpha = __expf(m[hh] - mn);
        p[hh] = ok ? __expf(sv - mn) : 0.f;
        l[hh] = l[hh] * alpha + wave_sum(p[hh]);
        o[hh] *= alpha; m[hh] = mn;
    }
#pragma unroll 8
    for (int kk = 0; kk < 64; ++kk) {
        const float v = bf2f(vbase[(size_t)kk * vstride + lane]);
#pragma unroll
        for (int hh = 0; hh < 4; ++hh) o[hh] += __shfl(p[hh], kk) * v;
    }
}
__device__ __forceinline__ void phase_nsa_attn(KArgs A, int wv_, int i, LAS unsigned char* lds) {
    const int tid_ = opaque_tid(wv_); const int wid = __builtin_amdgcn_readfirstlane(tid_ >> 6), lane0 = tid_ & 63; const int gw = blockIdx.x * 8 + wid, NGW = gridDim.x * 8;
    unsigned char* ws = opq(A->ws);
    const bf16* HY = (const bf16*)(ws + WS_BIG); const bf16* QA = (const bf16*)(ws + WS_QA); const bf16* KS = (const bf16*)(ws + WS_KS); const bf16* KW = (const bf16*)(ws + WS_KW);
    const bf16* KC = (const bf16*)(ws + WS_KC); const bf16* VC = (const bf16*)(ws + WS_VC); bf16* CAT = (bf16*)(ws + WS_CAT);
    LAS float* qs = (LAS float*)(lds + wid * 2048);
    LAS float* ps = qs + 256;
    for (int it = gw; it < 2 * T; it += NGW) {
        int lane = lane0; asm volatile("" : "+v"(lane));
        const int tok = it >> 1, g = it & 1, b = tok >> 11, t = tok & 2047;
#pragma unroll
        for (int hh = 0; hh < 4; ++hh) qs[hh * 64 + lane] = bf2f(QA[(size_t)tok * 512 + (g * 4 + hh) * 64 + lane]);
        LDS_WAIT();
        const int ncv = t >= 31 ? ((t - 31) >> 4) + 1 : 0;
        float oc[4] = {0.f, 0.f, 0.f, 0.f};
        float psum0 = 0.f, psum1 = 0.f;
        {
            const bool v0 = lane < ncv, v1 = lane + 64 < ncv;
            const bf16* k0p = KC + ((size_t)(b * 128 + lane) * 2 + g) * 64;
            const bf16* k1p = KC + ((size_t)(b * 128 + (lane + 64 < 127 ? lane + 64 : 126)) * 2 + g) * 64;
            float s0[4] = {0.f, 0.f, 0.f, 0.f}, s1[4] = {0.f, 0.f, 0.f, 0.f};
#pragma unroll 2
            for (int c = 0; c < 8; ++c) {
                const u32x4 ka = *(const u32x4*)(k0p + 8 * c), kb = *(const u32x4*)(k1p + 8 * c);
#pragma unroll
                for (int hh = 0; hh < 4; ++hh) {
                    const f32x4 qa = *(const LAS f32x4*)(qs + hh * 64 + 8 * c), qb = *(const LAS f32x4*)(qs + hh * 64 + 8 * c + 4);
                    s0[hh] += (qa.x * bflo(ka.x) + qa.y * bfhi(ka.x)) + (qa.z * bflo(ka.y) + qa.w * bfhi(ka.y)) + (qb.x * bflo(ka.z) + qb.y * bfhi(ka.z)) + (qb.z * bflo(ka.w) + qb.w * bfhi(ka.w));
                    s1[hh] += (qa.x * bflo(kb.x) + qa.y * bfhi(kb.x)) + (qa.z * bflo(kb.y) + qa.w * bfhi(kb.y)) + (qb.x * bflo(kb.z) + qb.y * bfhi(kb.z)) + (qb.z * bflo(kb.w) + qb.w * bfhi(kb.w));
                }
            }
            float p0[4], p1[4];
#pragma unroll
            for (int hh = 0; hh < 4; ++hh) {
                const float a0 = v0 ? s0[hh] : -INFINITY, a1 = v1 ? s1[hh] : -INFINITY;
                const float mx = wave_max(fmaxf(a0, a1));
                if (ncv > 0) {
                    const float e0 = v0 ? __expf(a0 - mx) : 0.f, e1 = v1 ? __expf(a1 - mx) : 0.f;
                    const float inv = 1.0f / wave_sum(e0 + e1);
                    p0[hh] = e0 * inv; p1[hh] = e1 * inv;
                } else { p0[hh] = 0.f; p1[hh] = 0.f; }
                psum0 += p0[hh]; psum1 += p1[hh];
            }
#pragma unroll 2
            for (int c = 0; c < ncv; ++c) {
                const float v = bf2f(VC[((size_t)(b * 128 + c) * 2 + g) * 64 + lane]);
#pragma unroll
                for (int hh = 0; hh < 4; ++hh) oc[hh] += __shfl(c < 64 ? p0[hh] : p1[hh], c & 63) * v;
            }
        }
        ps[lane] = psum0; ps[64 + lane] = psum1;
        LDS_WAIT();
        const int cur = t >> 6;
        unsigned selmask;
        {
            const int j = lane & 31;
            float imp = ps[4 * j] + ps[4 * j + 1] + ps[4 * j + 2] + 0.5f * ps[4 * j + 3] + (j > 0 ? 0.5f * ps[4 * j - 1] : 0.f);
            const bool valid = j <= cur, forced = (j == 0) || (j == cur) || (j == cur - 1);
            const float score = valid ? imp + (forced ? 1000.0f : 0.f) : -INFINITY;
            int rank = 0;
#pragma unroll 8
            for (int jj = 0; jj < 32; ++jj) { const float sj = __shfl(score, jj); rank += (sj > score || (sj == score && jj < j)) ? 1 : 0; }
            const bool sel = valid && rank < 8 && lane < 32;
            selmask = (unsigned)__ballot(sel);
        }
        LDS_WAIT();
        float o1[4] = {0.f, 0.f, 0.f, 0.f}, o2[4] = {0.f, 0.f, 0.f, 0.f};
#pragma unroll 1
        for (int pass = 0; pass < 2; ++pass) {
            float oa[4] = {0.f, 0.f, 0.f, 0.f}, ma[4] = {-INFINITY, -INFINITY, -INFINITY, -INFINITY}, la[4] = {0.f, 0.f, 0.f, 0.f};
            const int lo = pass ? (t - 255 > 0 ? t - 255 : 0) : 0;
            const unsigned bm = pass ? 0xffffffffu : selmask;
            const bf16* Kb = pass ? KW : KS; const int vc = pass ? C_VW : C_VS;
#pragma unroll 1
            for (int j = lo >> 6; j <= cur; ++j) {
                if (!((bm >> j) & 1u)) continue;
                const int key = 64 * j + lane; const size_t kt = (size_t)(b * S + key);
                nsa_block(qs, Kb + kt * 128 + g * 64, key <= t && key >= lo, HY + (size_t)(b * S + 64 * j) * HYN + vc + g * 64, HYN, lane, ma, la, oa);
            }
            if (pass == 0) {
#pragma unroll
                for (int hh = 0; hh < 4; ++hh) o1[hh] = oa[hh] / la[hh];
            } else {
#pragma unroll
                for (int hh = 0; hh < 4; ++hh) o2[hh] = oa[hh] / la[hh];
            }
        }
#pragma unroll
        for (int hh = 0; hh < 4; ++hh) {
            const int head = g * 4 + hh;
            const float* gb = A->in[I_GATEB] + i * 24 + head * 3;
            const bf16* gl = HY + (size_t)tok * HYN + C_GA + head * 3;
            const float g0 = sigmoidf_(bf2f(gl[0]) + gb[0]), g1 = sigmoidf_(bf2f(gl[1]) + gb[1]), g2 = sigmoidf_(bf2f(gl[2]) + gb[2]);
            const float o = g0 * oc[hh] + g1 * o1[hh] + g2 * o2[hh];
            CAT[(size_t)tok * 1024 + head * 64 + lane] = (bf16)f2bf(o);
        }
    }
}

__device__ __forceinline__ void phase_gla_seq(KArgs A, int wv_, int i, LAS unsigned char* lds) {
    const int tid = opaque_tid(wv_), wid = __builtin_amdgcn_readfirstlane(tid >> 6), lane = tid & 63;
    unsigned char* ws = opq(A->ws);
    const bf16* HY = (const bf16*)(ws + WS_BIG); bf16* CAT = (bf16*)(ws + WS_CAT);
    constexpr int CH = 16;
    LAS float* la = (LAS float*)lds;
    LAS float* lk = la + 4 * CH * 64;
    LAS float* lq = lk + 4 * CH * 64;
    LAS float* lo = lq + 4 * CH * 64;
    const float* wa2 = A->in[I_WA2] + i * 16 * 256; const float* ba = A->in[I_BA] + i * 256; const float* og = A->in[I_ONORM] + i * 128;
    for (int it = blockIdx.x; it < 8; it += gridDim.x) {
        const int pl = tid >> 7, v = tid & 127, p = it * 4 + pl, b = p >> 2, h = p & 3;
        float St[64];
#pragma unroll
        for (int k = 0; k < 64; ++k) St[k] = 0.f;
        for (int c0 = 0; c0 < S; c0 += CH) {
            __syncthreads();
            for (int e = tid; e < 4 * CH * 64; e += 512) {
                const int kk = e & 63, tk = (e >> 6) % CH, pp = e / (64 * CH); const int pb = (it * 4 + pp) >> 2, ph = (it * 4 + pp) & 3;
                const size_t tok = (size_t)pb * S + c0 + tk; const bf16* row = HY + tok * HYN;
                float z = ba[ph * 64 + kk];
#pragma unroll
                for (int r = 0; r < 16; ++r) z += bf2f(row[C_AL + r]) * wa2[r * 256 + ph * 64 + kk];
                const float ls_ = fminf(z, 0.f) - log1pf(__expf(-fabsf(z)));
                la[e] = __expf(ls_ * (1.f / 16.f));
                lk[e] = bf2f(row[C_KB + ph * 64 + kk]);
                lq[e] = bf2f(row[C_QB + ph * 64 + kk]) * 0.125f;
            }
            __syncthreads();
            for (int tk = 0; tk < CH; ++tk) {
                const size_t tok = (size_t)b * S + c0 + tk;
                const float vv = bf2f(HY[tok * HYN + C_VB + h * 128 + v]);
                const LAS float* pa = la + (pl * CH + tk) * 64; const LAS float* pk = lk + (pl * CH + tk) * 64; const LAS float* pq = lq + (pl * CH + tk) * 64;
                float o = 0.f;
#pragma unroll
                for (int k4 = 0; k4 < 16; ++k4) {
                    const f32x4 a4 = *(const LAS f32x4*)(pa + 4 * k4), k4v = *(const LAS f32x4*)(pk + 4 * k4), q4 = *(const LAS f32x4*)(pq + 4 * k4);
                    St[4 * k4 + 0] = a4.x * St[4 * k4 + 0] + k4v.x * vv; o += q4.x * St[4 * k4 + 0];
                    St[4 * k4 + 1] = a4.y * St[4 * k4 + 1] + k4v.y * vv; o += q4.y * St[4 * k4 + 1];
                    St[4 * k4 + 2] = a4.z * St[4 * k4 + 2] + k4v.z * vv; o += q4.z * St[4 * k4 + 2];
                    St[4 * k4 + 3] = a4.w * St[4 * k4 + 3] + k4v.w * vv; o += q4.w * St[4 * k4 + 3];
                }
                lo[(pl * CH + tk) * 128 + v] = o;
            }
            __syncthreads();
            for (int r = wid; r < 4 * CH; r += 8) {
                const int pp = r / CH, tk = r % CH; const int pb = (it * 4 + pp) >> 2, ph = (it * 4 + pp) & 3;
                const size_t tok = (size_t)pb * S + c0 + tk;
                const float x0 = lo[r * 128 + lane], x1 = lo[r * 128 + 64 + lane];
                const float rstd = rsqrtf(wave_sum(x0 * x0 + x1 * x1) * (1.f / 128.f) + EPS);
                const float r0 = bf2f(HY[tok * HYN + C_RB + ph * 128 + lane]), r1 = bf2f(HY[tok * HYN + C_RB + ph * 128 + 64 + lane]);
                CAT[tok * 1024 + 512 + ph * 128 + lane] = (bf16)f2bf(x0 * rstd * og[lane] * (r0 * sigmoidf_(r0)));
                CAT[tok * 1024 + 512 + ph * 128 + 64 + lane] = (bf16)f2bf(x1 * rstd * og[64 + lane] * (r1 * sigmoidf_(r1)));
            }
        }
        __syncthreads();
    }
}


__device__ __forceinline__ void phase_nsa_attn_mfma(KArgs A, int wv_, int i, LAS unsigned char* lds) {
    const int tid = opaque_tid(wv_), wid = __builtin_amdgcn_readfirstlane(tid >> 6), lane = tid & 63, fr = lane & 15, fq = lane >> 4;
    unsigned char* ws = opq(A->ws);
    const bf16* HY = (const bf16*)(ws + WS_BIG); const bf16* QA = (const bf16*)(ws + WS_QA); const bf16* KS = (const bf16*)(ws + WS_KS); const bf16* KW = (const bf16*)(ws + WS_KW);
    const bf16* KC = (const bf16*)(ws + WS_KC); const bf16* VCT = (const bf16*)(ws + WS_VC); const bf16* VTA = (const bf16*)(ws + WS_VTA); bf16* CAT = (bf16*)(ws + WS_CAT);
    constexpr int RS = 72;
    LAS bf16* ktl = (LAS bf16*)lds;
    LAS bf16* vtl = ktl + 4 * 64 * RS;
    LAS float* scl = (LAS float*)(lds + 73728) + wid * 256;
    LAS unsigned* msk = (LAS unsigned*)(lds + 73728 + 8192);
    LAS unsigned* umask = msk + 64;
    const float* gb = A->in[I_GATEB] + i * 24;
    unsigned long long tsub = 0, tt0 = 0;
    for (int pit = blockIdx.x; pit < 256; pit += gridDim.x) {
#pragma unroll 1
        for (int hf = 0; hf < 2; ++hf) {
            const int bg = pit >> 4, xx = pit & 15, x = hf ? 31 - xx : xx, b = bg >> 1, g = bg & 1;
            const size_t tokbase = (size_t)b * S + 64 * x;
            const int tl0 = 8 * wid + (fr >> 2);
            if (tid == 0) *umask = 0u;
            if (PROBE_NSA == 1) tt0 = __builtin_amdgcn_s_memrealtime();
            bf16x8 qf[2][2];
#pragma unroll
            for (int mt = 0; mt < 2; ++mt)
#pragma unroll
                for (int s = 0; s < 2; ++s) qf[mt][s] = *(const bf16x8*)(QA + (tokbase + tl0 + 4 * mt) * 512 + (g * 4 + (fr & 3)) * 64 + 32 * s + 8 * fq);
            f32x4 outacc[2][4];
            {
                const int tmaxc = (4 * x + 3 + 15) >> 4;
                const bf16* kcb = KC + ((size_t)(b * 128 + fr) * 2 + g) * 64 + 8 * fq;
                bf16x8 pcf[2][4];
#pragma unroll
                for (int mt = 0; mt < 2; ++mt) {
                    f32x4 sc[8];
                    const bf16* kp = kcb;
#pragma unroll
                    for (int t = 0; t < 8; ++t) { sc[t] = (f32x4){0.f, 0.f, 0.f, 0.f};
                        asm volatile("" : "+v"(kp));
                        if (t < tmaxc) {
                            const bf16x8 k0 = *(const bf16x8*)(kp), k1 = *(const bf16x8*)(kp + 32);
                            sc[t] = __builtin_amdgcn_mfma_f32_16x16x32_bf16(k0, qf[mt][0], sc[t], 0, 0, 0);
                            sc[t] = __builtin_amdgcn_mfma_f32_16x16x32_bf16(k1, qf[mt][1], sc[t], 0, 0, 0); }
                        kp += 16 * 128; }
                    const int tg = 64 * x + tl0 + 4 * mt; const int ncv = tg >= 31 ? ((tg - 31) >> 4) + 1 : 0;
                    float mx = -INFINITY;
#pragma unroll
                    for (int t = 0; t < 8; ++t)
#pragma unroll
                        for (int r = 0; r < 4; ++r) { const bool v = 16 * t + 4 * fq + r < ncv; sc[t][r] = v ? sc[t][r] : -INFINITY; mx = fmaxf(mx, sc[t][r]); }
                    mx = fmaxf(mx, __shfl_xor(mx, 16)); mx = fmaxf(mx, __shfl_xor(mx, 32));
                    const float mxs = mx == -INFINITY ? 0.f : mx;
                    float sum = 0.f;
#pragma unroll
                    for (int t = 0; t < 8; ++t)
#pragma unroll
                        for (int r = 0; r < 4; ++r) { sc[t][r] = __builtin_amdgcn_exp2f(sc[t][r] - mxs); sum += sc[t][r]; }
                    sum += __shfl_xor(sum, 16); sum += __shfl_xor(sum, 32);
                    const float inv = sum > 0.f ? 1.f / sum : 0.f;
#pragma unroll
                    for (int t = 0; t < 8; ++t) sc[t] = sc[t] * inv;
#pragma unroll
                    for (int s = 0; s < 4; ++s) { u32x4 w; w.x = pk2(sc[2 * s].x, sc[2 * s].y); w.y = pk2(sc[2 * s].z, sc[2 * s].w); w.z = pk2(sc[2 * s + 1].x, sc[2 * s + 1].y); w.w = pk2(sc[2 * s + 1].z, sc[2 * s + 1].w);
                        pcf[mt][s] = __builtin_bit_cast(bf16x8, w); }
                    float w3[8];
#pragma unroll
                    for (int t = 0; t < 8; ++t) {
#pragma unroll
                        for (int r = 0; r < 4; ++r) { float v = sc[t][r]; v += __shfl_xor(v, 1); v += __shfl_xor(v, 2); sc[t][r] = v; }
                        w3[t] = __shfl(sc[t].w, (lane + 48) & 63);
                    }
#pragma unroll
                    for (int t = 0; t < 8; ++t) {
                        const float prev = fq > 0 ? w3[t] : (t > 0 ? w3[t > 0 ? t - 1 : 0] : 0.f);
                        const float imp = sc[t].x + sc[t].y + sc[t].z + 0.5f * sc[t].w + 0.5f * prev;
                        if ((fr & 3) == 0) scl[(4 * mt + (fr >> 2)) * 32 + 4 * t + fq] = imp;
                    }
                    asm volatile("" ::: "memory");
                }
                const bf16* vcb = VCT + ((size_t)(b * 2 + g) * 64 + fr) * 128 + 8 * fq;
#pragma unroll
                for (int n = 0; n < 4; ++n) {
                    outacc[0][n] = (f32x4){0.f, 0.f, 0.f, 0.f}; outacc[1][n] = (f32x4){0.f, 0.f, 0.f, 0.f};
                    asm volatile("" : "+v"(vcb));
#pragma unroll
                    for (int s = 0; s < 4; ++s) if (2 * s < tmaxc) {
                        const bf16x8 vf = *(const bf16x8*)(vcb + 32 * s);
                        outacc[0][n] = __builtin_amdgcn_mfma_f32_16x16x32_bf16(vf, pcf[0][s], outacc[0][n], 0, 0, 0);
                        outacc[1][n] = __builtin_amdgcn_mfma_f32_16x16x32_bf16(vf, pcf[1][s], outacc[1][n], 0, 0, 0); }
                    vcb += 16 * 128;
                    asm volatile("" ::: "memory");
                }
            }
            float g1v[2], g2v[2];
#pragma unroll
            for (int mt = 0; mt < 2; ++mt) {
                const int head = g * 4 + (fr & 3);
                const bf16* gl = HY + (tokbase + tl0 + 4 * mt) * HYN + C_GA + head * 3;
                const float g0 = sigmoidf_(bf2f(gl[0]) + gb[head * 3 + 0]);
                g1v[mt] = sigmoidf_(bf2f(gl[1]) + gb[head * 3 + 1]); g2v[mt] = sigmoidf_(bf2f(gl[2]) + gb[head * 3 + 2]);
#pragma unroll
                for (int n = 0; n < 4; ++n) outacc[mt][n] = outacc[mt][n] * g0;
            }
            LDS_WAIT();
            asm volatile("" ::: "memory");
            {
                const int tok8 = lane >> 3, jg = lane & 7;
                float sj[32];
#pragma unroll
                for (int q = 0; q < 8; ++q) { const f32x4 v = *(const LAS f32x4*)(scl + tok8 * 32 + 4 * q); sj[4 * q] = v.x; sj[4 * q + 1] = v.y; sj[4 * q + 2] = v.z; sj[4 * q + 3] = v.w; }
#pragma unroll
                for (int j = 0; j < 32; ++j) sj[j] = j <= x ? sj[j] + ((j == 0 || j == x || j == x - 1) ? 1000.0f : 0.f) : -INFINITY;
                unsigned bits = 0u;
                const f32x4 mv = *(const LAS f32x4*)(scl + tok8 * 32 + 4 * jg);
#pragma unroll
                for (int q = 0; q < 4; ++q) {
                    const int j = 4 * jg + q;
                    const float mine = j <= x ? mv[q] + ((j == 0 || j == x || j == x - 1) ? 1000.0f : 0.f) : -INFINITY;
                    int rank = 0;
#pragma unroll
                    for (int jj = 0; jj < 32; ++jj) rank += (sj[jj] > mine || (sj[jj] == mine && jj < j)) ? 1 : 0;
                    bits |= (j <= x && rank < 8) ? (1u << j) : 0u;
                }
                bits |= __shfl_xor(bits, 1); bits |= __shfl_xor(bits, 2); bits |= __shfl_xor(bits, 4);
                if (jg == 0) { msk[wid * 8 + tok8] = bits; atomicOr((unsigned*)umask, bits); }
            }
            __syncthreads();
            if (PROBE_NSA == 1) tsub += __builtin_amdgcn_s_memrealtime() - tt0;
#pragma unroll 1
            for (int pp = 0; pp < 2 + (PROBE_NSAX ? 1 : 0); ++pp) {
                const int pass = pp == 2 ? 0 : pp; const bool dummy = pp == 2;
                if (PROBE_NSA == 2 + pass) tt0 = __builtin_amdgcn_s_memrealtime();
                const int jlo = pass ? (x >= 4 ? x - 4 : 0) : 0;
                const unsigned inrange = (x >= 31 ? 0xffffffffu : ((2u << x) - 1u)) & ~((1u << jlo) - 1u);
                unsigned bmask = pass ? inrange : (*umask & inrange);
                const bf16* Kb = pass ? KW : KS; const int cg = (pass ? 10 : 8) + g;
                unsigned tm[2], wm[2], am[2];
#pragma unroll
                for (int mt = 0; mt < 2; ++mt) {
                    tm[mt] = pass ? 0xffffffffu : msk[wid * 8 + 4 * mt + (fr >> 2)];
                    wm[mt] = pass ? 0xffffffffu : (msk[wid * 8 + 4 * mt] | msk[wid * 8 + 4 * mt + 1] | msk[wid * 8 + 4 * mt + 2] | msk[wid * 8 + 4 * mt + 3]);
                    am[mt] = pass ? 0xffffffffu : (msk[wid * 8 + 4 * mt] & msk[wid * 8 + 4 * mt + 1] & msk[wid * 8 + 4 * mt + 2] & msk[wid * 8 + 4 * mt + 3]);
                    wm[mt] = __builtin_amdgcn_readfirstlane(wm[mt]); am[mt] = __builtin_amdgcn_readfirstlane(am[mt]);
                    if (PROBE_NSAX == 2 && dummy) wm[mt] = 0u;
                }
                f32x4 o[2][4]; float mrun[2], lrun[2];
#pragma unroll
                for (int mt = 0; mt < 2; ++mt) { mrun[mt] = -INFINITY; lrun[mt] = 0.f;
#pragma unroll
                    for (int n = 0; n < 4; ++n) o[mt][n] = (f32x4){0.f, 0.f, 0.f, 0.f}; }
                const int srow = tid >> 3, sc16 = tid & 7;
                u32x4 pk0 = (u32x4){0u, 0u, 0u, 0u}, pv0 = pk0, pk1 = pk0, pv1 = pk0;
#define NSA_LD(jx, pk, pv) do { const bf16* ksrc = Kb + ((size_t)b * S + 64 * (jx) + srow) * 128 + g * 64 + sc16 * 8; const bf16* vsrc = VTA + ((size_t)((b * 32 + (jx)) * 12 + cg)) * 4096 + srow * 64 + sc16 * 8; \
                    pk = *(const u32x4*)ksrc; pv = *(const u32x4*)vsrc; } while (0)
                int j0 = __ffs(bmask) - 1; bmask &= bmask - 1u;
                int j1 = bmask ? __ffs(bmask) - 1 : -1; bmask &= bmask - 1u;
                NSA_LD(j0, pk0, pv0); if (j1 >= 0) NSA_LD(j1, pk1, pv1);
                int buf = 0;
                while (j0 >= 0) {
                    *(LAS u32x4*)(ktl + (buf * 2 + 0) * 64 * RS + srow * RS + sc16 * 8) = pk0; *(LAS u32x4*)(vtl + (buf * 2 + 0) * 64 * RS + srow * RS + sc16 * 8) = pv0;
                    if (j1 >= 0) { *(LAS u32x4*)(ktl + (buf * 2 + 1) * 64 * RS + srow * RS + sc16 * 8) = pk1; *(LAS u32x4*)(vtl + (buf * 2 + 1) * 64 * RS + srow * RS + sc16 * 8) = pv1; }
                    const int jn0 = bmask ? __ffs(bmask) - 1 : -1; bmask &= bmask - 1u;
                    const int jn1 = bmask ? __ffs(bmask) - 1 : -1; bmask &= bmask - 1u;
                    if (jn0 >= 0) NSA_LD(jn0, pk0, pv0);
                    if (jn1 >= 0) NSA_LD(jn1, pk1, pv1);
                    __syncthreads();
#pragma unroll 1
                    for (int sub = 0; sub < 2; ++sub) {
                        const int j = sub ? j1 : j0;
                        if (j < 0) break;
                        const LAS bf16* kt = ktl + (buf * 2 + sub) * 64 * RS + fr * RS + 8 * fq; const LAS bf16* vt = vtl + (buf * 2 + sub) * 64 * RS + fr * RS + 8 * fq;
#pragma unroll
                        for (int mt = 0; mt < 2; ++mt) {
                            if (!((wm[mt] >> j) & 1u)) continue;
                            f32x4 sc[4];
#pragma unroll
                            for (int t = 0; t < 4; ++t) { sc[t] = (f32x4){0.f, 0.f, 0.f, 0.f};
                                sc[t] = __builtin_amdgcn_mfma_f32_16x16x32_bf16(*(const LAS bf16x8*)(kt + t * 16 * RS), qf[mt][0], sc[t], 0, 0, 0);
                                sc[t] = __builtin_amdgcn_mfma_f32_16x16x32_bf16(*(const LAS bf16x8*)(kt + t * 16 * RS + 32), qf[mt][1], sc[t], 0, 0, 0); }
                            const int tl = tl0 + 4 * mt;
                            const bool rowok = (tm[mt] >> j) & 1u;
                            const bool edge = (j == x) || (pass && j == x - 4);
                            float bm = -INFINITY;
                            if (edge) {
                                const int kphi = j == x ? tl : 63;
                                const int kplo = (pass && j == x - 4) ? tl + 1 : 0;
#pragma unroll
                                for (int t = 0; t < 4; ++t)
#pragma unroll
                                    for (int r = 0; r < 4; ++r) { const int kp = 16 * t + 4 * fq + r; const bool v = rowok && kp <= kphi && kp >= kplo; sc[t][r] = v ? sc[t][r] : -INFINITY; bm = fmaxf(bm, sc[t][r]); }
                            } else {
#pragma unroll
                                for (int t = 0; t < 4; ++t) bm = fmaxf(bm, fmaxf(fmaxf(sc[t].x, sc[t].y), fmaxf(sc[t].z, sc[t].w)));
                                if (!((am[mt] >> j) & 1u)) bm = rowok ? bm : -INFINITY;
                            }
                            bm = fmaxf(bm, __shfl_xor(bm, 16)); bm = fmaxf(bm, __shfl_xor(bm, 32));
                            const float mn = fmaxf(mrun[mt], bm); const float mns = mn == -INFINITY ? 0.f : mn;
                            float rs = 0.f;
#pragma unroll
                            for (int t = 0; t < 4; ++t)
#pragma unroll
                                for (int r = 0; r < 4; ++r) { sc[t][r] = __builtin_amdgcn_exp2f(sc[t][r] - mns); rs += sc[t][r]; }
                            if (!edge && !((am[mt] >> j) & 1u)) {
#pragma unroll
                                for (int t = 0; t < 4; ++t) sc[t] = rowok ? sc[t] : (f32x4){0.f, 0.f, 0.f, 0.f};
                                rs = rowok ? rs : 0.f;
                            }
                            rs += __shfl_xor(rs, 16); rs += __shfl_xor(rs, 32);
                            if (__all(mn == mrun[mt])) { lrun[mt] += rs; }
                            else {
                                const float alpha = __builtin_amdgcn_exp2f(mrun[mt] - mns);
                                lrun[mt] = lrun[mt] * alpha + rs; mrun[mt] = mn;
#pragma unroll
                                for (int n = 0; n < 4; ++n) o[mt][n] = o[mt][n] * alpha;
                            }
                            bf16x8 pf[2];
#pragma unroll
                            for (int s = 0; s < 2; ++s) { u32x4 w; w.x = pk2(sc[2 * s].x, sc[2 * s].y); w.y = pk2(sc[2 * s].z, sc[2 * s].w); w.z = pk2(sc[2 * s + 1].x, sc[2 * s + 1].y); w.w = pk2(sc[2 * s + 1].z, sc[2 * s + 1].w);
                                pf[s] = __builtin_bit_cast(bf16x8, w); }
#pragma unroll
                            for (int n = 0; n < 4; ++n) {
                                o[mt][n] = __builtin_amdgcn_mfma_f32_16x16x32_bf16(*(const LAS bf16x8*)(vt + n * 16 * RS), pf[0], o[mt][n], 0, 0, 0);
                                o[mt][n] = __builtin_amdgcn_mfma_f32_16x16x32_bf16(*(const LAS bf16x8*)(vt + n * 16 * RS + 32), pf[1], o[mt][n], 0, 0, 0); }
                        }
                    }
                    j0 = jn0; j1 = jn1; buf ^= 1;
                }
#undef NSA_LD
#pragma unroll
                for (int mt = 0; mt < 2; ++mt) { const float sc_ = (pass ? g2v[mt] : g1v[mt]) / lrun[mt];
                    if (!dummy) {
#pragma unroll
                    for (int n = 0; n < 4; ++n) outacc[mt][n] = outacc[mt][n] + o[mt][n] * sc_; } }
                __syncthreads();
                if (PROBE_NSA == 2 + pass) tsub += __builtin_amdgcn_s_memrealtime() - tt0;
            }
#pragma unroll
            for (int mt = 0; mt < 2; ++mt) {
                bf16* dst = CAT + (tokbase + tl0 + 4 * mt) * 1024 + (g * 4 + (fr & 3)) * 64 + 4 * fq;
#pragma unroll
                for (int n = 0; n < 4; ++n) { u32x2 w; w.x = pk2(outacc[mt][n].x, outacc[mt][n].y); w.y = pk2(outacc[mt][n].z, outacc[mt][n].w); *(u32x2*)(dst + 16 * n) = w; }
            }
        }
    }
    __syncthreads();
    if (PROBE_NSA && blockIdx.x == 0 && tid == 0) atomicAdd((unsigned long long*)(ws + WS_CTL + 48000), tsub);
}

__device__ __forceinline__ void phase_vtiles(KArgs A, int wv_, LAS unsigned char* lds) {
    const int tid_ = opaque_tid(wv_); const int wid = __builtin_amdgcn_readfirstlane(tid_ >> 6), lane = tid_ & 63; const int gw = blockIdx.x * 8 + wid, NGW = gridDim.x * 8;
    unsigned char* ws = opq(A->ws);
    const bf16* HY = (const bf16*)(ws + WS_BIG); bf16* VTA = (bf16*)(ws + WS_VTA);
    constexpr int TS = 66;
    LAS bf16* tl = (LAS bf16*)(lds + 65536) + wid * (64 * TS);
    for (int it = gw; it < NBATCH * 32 * 12; it += NGW) {
        const int cg = it % 12, bc = it / 12;
        const int colbase = cg < 8 ? C_VB + cg * 64 : (cg < 10 ? C_VS + (cg - 8) * 64 : C_VW + (cg - 10) * 64);
        const u32x4* src = (const u32x4*)(HY + (size_t)(bc * 64 + lane) * HYN + colbase);
        u32x4 w[8];
#pragma unroll
        for (int i = 0; i < 8; ++i) w[i] = src[i];
#pragma unroll
        for (int i = 0; i < 8; ++i) { LAS unsigned* d = (LAS unsigned*)(tl + lane * TS + 8 * i); d[0] = w[i].x; d[1] = w[i].y; d[2] = w[i].z; d[3] = w[i].w; }
        LDS_WAIT();
        bf16* dst = VTA + (size_t)it * 4096 + lane * 64;
#pragma unroll
        for (int p8 = 0; p8 < 8; ++p8) {
            unsigned short x[8];
#pragma unroll
            for (int j = 0; j < 8; ++j) x[j] = tl[kperm64(p8 * 8 + j) * TS + lane];
            u32x4 o; o.x = x[0] | ((unsigned)x[1] << 16); o.y = x[2] | ((unsigned)x[3] << 16); o.z = x[4] | ((unsigned)x[5] << 16); o.w = x[6] | ((unsigned)x[7] << 16);
            *(u32x4*)(dst + p8 * 8) = o;
        }
        LDS_WAIT();
    }
}

__device__ __forceinline__ void vtrans_wave(KArgs A, int wv_, LAS bf16* tl, const int gw, const int NGW) {
    const int tid_ = opaque_tid(wv_); const int lane = tid_ & 63;
    unsigned char* ws = opq(A->ws);
    const bf16* KV = (const bf16*)(ws + WS_KV); bf16* VT = (bf16*)(ws + WS_VT);
    constexpr int TS = 66;
    for (int it = gw; it < DEPTH * NBATCH * 4 * 16; it += NGW) {
        const int db = it & 3, kb = (it >> 2) & 3, h = (it >> 4) & 3, b = (it >> 6) & 7, l = it >> 9;
        const u32x4* src = (const u32x4*)(KV + (size_t)(b * 256 + 64 * kb + lane) * 8192 + l * 2048 + 1024 + h * 256 + 64 * db);
        u32x4 w[8];
#pragma unroll
        for (int i = 0; i < 8; ++i) w[i] = src[i];
#pragma unroll
        for (int i = 0; i < 8; ++i) { LAS unsigned* d = (LAS unsigned*)(tl + lane * TS + 8 * i); d[0] = w[i].x; d[1] = w[i].y; d[2] = w[i].z; d[3] = w[i].w; }
        LDS_WAIT();
        bf16* dst = VT + ((size_t)((l * 8 + b) * 4 + h) * 256 + 64 * db + lane) * 256 + 64 * kb;
#pragma unroll
        for (int p8 = 0; p8 < 8; ++p8) {
            unsigned short x[8];
#pragma unroll
            for (int j = 0; j < 8; ++j) x[j] = tl[kperm64(p8 * 8 + j) * TS + lane];
            u32x4 o; o.x = x[0] | ((unsigned)x[1] << 16); o.y = x[2] | ((unsigned)x[3] << 16); o.z = x[4] | ((unsigned)x[5] << 16); o.w = x[6] | ((unsigned)x[7] << 16);
            *(u32x4*)(dst + p8 * 8) = o;
        }
        LDS_WAIT();
    }
}

__device__ __forceinline__ float log_sigmoid16(float z) { return (fminf(z, 0.f) - __logf(1.0f + __expf(-fabsf(z)))) * (1.f / 16.f); }
#define GLA_Z(tokv) ({ float z_ = bias; _Pragma("unroll") for (int r_ = 0; r_ < 16; ++r_) z_ += __builtin_bit_cast(float, __builtin_amdgcn_readlane(__builtin_bit_cast(int, al[r_]), (tokv))) * wc[r_]; z_; })
#define GLA_LOAD_GATE() \
    float al[16], wc[16]; \
    { const u32x4* ap_ = (const u32x4*)(HY + (size_t)(tok0 + lane) * HYN + C_AL); const u32x4 a0_ = ap_[0], a1_ = ap_[1]; \
      al[0] = bflo(a0_.x); al[1] = bfhi(a0_.x); al[2] = bflo(a0_.y); al[3] = bfhi(a0_.y); al[4] = bflo(a0_.z); al[5] = bfhi(a0_.z); al[6] = bflo(a0_.w); al[7] = bfhi(a0_.w); \
      al[8] = bflo(a1_.x); al[9] = bfhi(a1_.x); al[10] = bflo(a1_.y); al[11] = bfhi(a1_.y); al[12] = bflo(a1_.z); al[13] = bfhi(a1_.z); al[14] = bflo(a1_.w); al[15] = bfhi(a1_.w); } \
    _Pragma("unroll") for (int r_ = 0; r_ < 16; ++r_) wc[r_] = A->in[I_WA2][(i * 16 + r_) * 256 + h * 64 + lane]; \
    const float bias = A->in[I_BA][i * 256 + h * 64 + lane];

__device__ __forceinline__ void phase_gla_a(KArgs A, int wv_, int i, LAS unsigned char* lds) {
    const int tid_ = opaque_tid(wv_); const int wid = __builtin_amdgcn_readfirstlane(tid_ >> 6), lane = tid_ & 63, fr = lane & 15, fq = lane >> 4; const int gw = blockIdx.x * 8 + wid, NGW = gridDim.x * 8;
    unsigned char* ws = opq(A->ws);
    const bf16* HY = (const bf16*)(ws + WS_BIG); const bf16* VTA = (const bf16*)(ws + WS_VTA); float* SLOC = (float*)(ws + WS_SLOC); float* DEC = (float*)(ws + WS_DEC);
    constexpr int RS = 72;
    LAS bf16* kh = (LAS bf16*)lds + wid * (64 * RS);
    (void)gw;
    for (int it = wid * (int)gridDim.x + (int)blockIdx.x; it < 1024; it += NGW) {
        const int c = it & 31, bh = it >> 5, b = bh >> 2, h = bh & 3; const size_t tok0 = (size_t)b * S + c * 64;
        GLA_LOAD_GATE();
        float bl = 0.f;
#pragma unroll 8
        for (int tk = 0; tk < 64; ++tk) bl += log_sigmoid16(GLA_Z(tk));
        float bc = 0.f;
        unsigned short kcol[64];
#pragma unroll
        for (int tk = 0; tk < 64; ++tk) kcol[tk] = HY[(tok0 + tk) * HYN + C_KB + h * 64 + lane];
#pragma unroll
        for (int tk = 0; tk < 64; ++tk) {
            bc += log_sigmoid16(GLA_Z(tk));
            kh[lane * RS + kpos64(tk)] = (bf16)f2bf(bf2f(kcol[tk]) * __expf(bl - bc));
        }
        DEC[it * 64 + lane] = __expf(bl);
        LDS_WAIT();
#pragma unroll
        for (int dvh = 0; dvh < 2; ++dvh) {
            const bf16* vt = VTA + ((size_t)((b * 32 + c) * 12 + h * 2 + dvh)) * 4096;
            bf16x8 vf[4][2];
#pragma unroll
            for (int n = 0; n < 4; ++n)
#pragma unroll
                for (int s = 0; s < 2; ++s) vf[n][s] = *(const bf16x8*)(vt + (16 * n + fr) * 64 + 32 * s + 8 * fq);
#pragma unroll
            for (int m = 0; m < 4; ++m) {
                const bf16x8 a0 = *(const LAS bf16x8*)(kh + (16 * m + fr) * RS + 8 * fq), a1 = *(const LAS bf16x8*)(kh + (16 * m + fr) * RS + 32 + 8 * fq);
#pragma unroll
                for (int n = 0; n < 4; ++n) {
                    f32x4 acc = (f32x4){0.f, 0.f, 0.f, 0.f};
                    acc = __builtin_amdgcn_mfma_f32_16x16x32_bf16(a0, vf[n][0], acc, 0, 0, 0);
                    acc = __builtin_amdgcn_mfma_f32_16x16x32_bf16(a1, vf[n][1], acc, 0, 0, 0);
                    float* dst = SLOC + ((size_t)it * 64 + 16 * m + 4 * fq) * 128 + dvh * 64 + 16 * n + fr;
                    dst[0] = acc.x; dst[128] = acc.y; dst[256] = acc.z; dst[384] = acc.w;
                }
            }
        }
        LDS_WAIT();
    }
}
__device__ __forceinline__ void phase_gla_c(KArgs A, int wv_, int i, LAS unsigned char* lds, const bool kv_post) {
    const int tid_ = opaque_tid(wv_); const int wid = __builtin_amdgcn_readfirstlane(tid_ >> 6), lane = tid_ & 63, fr = lane & 15, fq = lane >> 4; const int gw = blockIdx.x * 8 + wid, NGW = gridDim.x * 8;
    unsigned char* ws = opq(A->ws);
    const bf16* HY = (const bf16*)(ws + WS_BIG); const bf16* VTA = (const bf16*)(ws + WS_VTA); const bf16* STT = (const bf16*)(ws + WS_STT); bf16* CAT = (bf16*)(ws + WS_CAT);
    constexpr int RS = 72;
    LAS bf16* qs = (LAS bf16*)lds + wid * (128 * RS);
    LAS bf16* ks = qs + 64 * RS;
    const float* og = A->in[I_ONORM] + i * 128;
    LAS float* ogl = (LAS float*)(lds + 8 * 128 * RS * 2);
    if (tid_ < 128) ogl[tid_] = og[tid_];
    (void)gw; (void)NGW;
    for (int blk = blockIdx.x; blk < 256; blk += gridDim.x) {
        SUBT_BEGIN(1);
        {
            const float* SLOC = (const float*)(ws + WS_SLOC); const float* DEC = (const float*)(ws + WS_DEC); bf16* STw = (bf16*)(ws + WS_STT);
            const int tid = tid_, dv = tid & 127, ko = tid >> 7, bh = blk >> 3, c0 = (blk & 7) * 4;
            float sv[16];
#pragma unroll
            for (int j = 0; j < 16; ++j) sv[j] = 0.f;
#pragma unroll 1
            for (int cb = 0; cb < c0 + 4; cb += 4) {
                float dc4[4][16], sl4[4][16];
#pragma unroll
                for (int q = 0; q < 4; ++q) {
                    const size_t item = (size_t)bh * 32 + cb + q; const float* sl = SLOC + (item * 64 + ko * 16) * 128 + dv; const float* dc = DEC + item * 64 + ko * 16;
#pragma unroll
                    for (int j = 0; j < 16; ++j) { dc4[q][j] = dc[j]; sl4[q][j] = sl[j * 128]; }
                }
#pragma unroll
                for (int q = 0; q < 4; ++q) {
                    const int c = cb + q; const size_t item = (size_t)bh * 32 + c;
                    if (c >= c0) {
                        u32x4 o0, o1; o0.x = pk2(sv[0], sv[1]); o0.y = pk2(sv[2], sv[3]); o0.z = pk2(sv[4], sv[5]); o0.w = pk2(sv[6], sv[7]);
                        o1.x = pk2(sv[8], sv[9]); o1.y = pk2(sv[10], sv[11]); o1.z = pk2(sv[12], sv[13]); o1.w = pk2(sv[14], sv[15]);
                        u32x4* d = (u32x4*)(STw + (item * 128 + dv) * 64 + ko * 16); d[0] = o0; d[1] = o1;
                    }
#pragma unroll
                    for (int j = 0; j < 16; ++j) sv[j] = dc4[q][j] * sv[j] + sl4[q][j];
                }
            }
            asm volatile("s_waitcnt vmcnt(0)" ::: "memory");
            __syncthreads();
        }
        SUBT_END(1, ws, tid_);
        SUBT_BEGIN(2);
        SUBT_BEGIN(3);
        if (wid < 4) {
        const int it = blk * 4 + wid;
        const int c = it & 31, bh = it >> 5, b = bh >> 2, h = bh & 3; const size_t tok0 = (size_t)b * S + c * 64;
        GLA_LOAD_GATE();
        float bc = 0.f;
        unsigned short qcol[64], kcol[64];
#pragma unroll
        for (int tk = 0; tk < 64; ++tk) { const bf16* row = HY + (tok0 + tk) * HYN; qcol[tk] = row[C_QB + h * 64 + lane]; kcol[tk] = row[C_KB + h * 64 + lane]; }
#pragma unroll
        for (int tk = 0; tk < 64; ++tk) {
            bc += log_sigmoid16(GLA_Z(tk));
            const float eb = __expf(bc);
            qs[tk * RS + lane] = (bf16)f2bf(bf2f(qcol[tk]) * 0.125f * eb); ks[tk * RS + lane] = (bf16)f2bf(bf2f(kcol[tk]) / eb);
        }
        LDS_WAIT();
        SUBT_END(2, ws, tid_);
        bf16x8 st[8][2];
#pragma unroll
        for (int n = 0; n < 8; ++n)
#pragma unroll
            for (int s = 0; s < 2; ++s) st[n][s] = *(const bf16x8*)(STT + ((size_t)it * 128 + 16 * n + fr) * 64 + 32 * s + 8 * fq);
        const bf16* vt = VTA + ((size_t)((b * 32 + c) * 12 + h * 2)) * 4096;
        bf16x8 vfr[8][2];
#pragma unroll
        for (int n = 0; n < 8; ++n) { const bf16* vrow = vt + (size_t)(n >> 2) * 4096 + (16 * (n & 3) + fr) * 64 + 8 * fq; vfr[n][0] = *(const bf16x8*)vrow; vfr[n][1] = *(const bf16x8*)(vrow + 32); }
#pragma unroll
        for (int mi = 0; mi < 4; ++mi) {
            const bf16x8 q0 = *(const LAS bf16x8*)(qs + (16 * mi + fr) * RS + 8 * fq), q1 = *(const LAS bf16x8*)(qs + (16 * mi + fr) * RS + 32 + 8 * fq);
            u32x2 rwv[8];
#pragma unroll
            for (int n = 0; n < 8; ++n) rwv[n] = *(const u32x2*)(HY + (tok0 + 16 * mi + fr) * HYN + C_RB + h * 128 + 16 * n + 4 * fq);
            f32x4 sc[4];
#pragma unroll
            for (int t = 0; t < 4; ++t) {
                sc[t] = (f32x4){0.f, 0.f, 0.f, 0.f};
                if (t <= mi) {
                    const bf16x8 k0 = *(const LAS bf16x8*)(ks + (16 * t + fr) * RS + 8 * fq), k1 = *(const LAS bf16x8*)(ks + (16 * t + fr) * RS + 32 + 8 * fq);
                    sc[t] = __builtin_amdgcn_mfma_f32_16x16x32_bf16(k0, q0, sc[t], 0, 0, 0);
                    sc[t] = __builtin_amdgcn_mfma_f32_16x16x32_bf16(k1, q1, sc[t], 0, 0, 0);
                    if (t == mi) {
                        sc[t].x = (4 * fq + 0 <= fr) ? sc[t].x : 0.f; sc[t].y = (4 * fq + 1 <= fr) ? sc[t].y : 0.f; sc[t].z = (4 * fq + 2 <= fr) ? sc[t].z : 0.f; sc[t].w = (4 * fq + 3 <= fr) ? sc[t].w : 0.f; }
                }
            }
            bf16x8 pf[2];
#pragma unroll
            for (int s = 0; s < 2; ++s) { u32x4 w; w.x = pk2(sc[2 * s].x, sc[2 * s].y); w.y = pk2(sc[2 * s].z, sc[2 * s].w); w.z = pk2(sc[2 * s + 1].x, sc[2 * s + 1].y); w.w = pk2(sc[2 * s + 1].z, sc[2 * s + 1].w);
                pf[s] = __builtin_bit_cast(bf16x8, w); }
            f32x4 o[8]; float ssq = 0.f;
#pragma unroll
            for (int n = 0; n < 8; ++n) {
                o[n] = (f32x4){0.f, 0.f, 0.f, 0.f};
                o[n] = __builtin_amdgcn_mfma_f32_16x16x32_bf16(st[n][0], q0, o[n], 0, 0, 0);
                o[n] = __builtin_amdgcn_mfma_f32_16x16x32_bf16(st[n][1], q1, o[n], 0, 0, 0);
                o[n] = __builtin_amdgcn_mfma_f32_16x16x32_bf16(vfr[n][0], pf[0], o[n], 0, 0, 0);
                if (mi >= 2) o[n] = __builtin_amdgcn_mfma_f32_16x16x32_bf16(vfr[n][1], pf[1], o[n], 0, 0, 0);
                ssq += (o[n].x * o[n].x + o[n].y * o[n].y) + (o[n].z * o[n].z + o[n].w * o[n].w);
            }
            ssq += __shfl_xor(ssq, 16); ssq += __shfl_xor(ssq, 32);
            const float rstd = rsqrtf(ssq * (1.f / 128.f) + EPS);
            const size_t tok = tok0 + 16 * mi + fr;
#pragma unroll
            for (int n = 0; n < 8; ++n) {
                const int dv = 16 * n + 4 * fq;
                const u32x2 rw = rwv[n]; const f32x4 g = *(const LAS f32x4*)(ogl + dv);
                const float r0 = bflo(rw.x), r1 = bfhi(rw.x), r2 = bflo(rw.y), r3 = bfhi(rw.y);
                u32x2 w; w.x = pk2(o[n].x * rstd * g.x * (r0 * sigmoidf_(r0)), o[n].y * rstd * g.y * (r1 * sigmoidf_(r1)));
                w.y = pk2(o[n].z * rstd * g.z * (r2 * sigmoidf_(r2)), o[n].w * rstd * g.w * (r3 * sigmoidf_(r3)));
                *(u32x2*)(CAT + tok * 1024 + 512 + h * 128 + dv) = w;
            }
        }
        } else if (kv_post) {
            phase_knorm(A, wv_, blk * 4 + (wid - 4), 256 * 4);
            vtrans_wave(A, wv_, (LAS bf16*)(lds + 81920) + (wid - 4) * (64 * 66), blk * 4 + (wid - 4), 256 * 4);
        }
        SUBT_END(3, ws, tid_);
        LDS_WAIT();
        __syncthreads();
    }
}

__device__ __forceinline__ void phase_sgu_mix(KArgs A, int wv_, int i, LAS unsigned char* lds) {
    const int tid = opaque_tid(wv_), wid = __builtin_amdgcn_readfirstlane(tid >> 6), lane = tid & 63;
    unsigned char* ws = opq(A->ws);
    const bf16* U = (const bf16*)(ws + WS_U); const bf16* V = (const bf16*)(ws + WS_V); bf16* UM = (bf16*)(ws + WS_UM);
    LAS float* vt = (LAS float*)lds;
    LAS float* st = vt + 128 * 256;
    const float* lng = A->in[I_LNG] + i * 2048; const float* lnb = A->in[I_LNB] + i * 2048;
    for (int it = blockIdx.x; it < NBATCH * 16 * 8; it += gridDim.x) {
        const int g = it & 7, n = (it >> 3) & 15, b = it >> 7;
        const size_t tok0 = (size_t)b * S + n * 128;
        __syncthreads();
        for (int s = wid * 16; s < wid * 16 + 16; ++s) {
            const u32x4* vr = (const u32x4*)(V + (tok0 + s) * 2048) + lane;
            float x[32]; float sum = 0.f;
#pragma unroll
            for (int j = 0; j < 4; ++j) { const u32x4 w = vr[64 * j];
                x[8 * j + 0] = bflo(w.x); x[8 * j + 1] = bfhi(w.x); x[8 * j + 2] = bflo(w.y); x[8 * j + 3] = bfhi(w.y); x[8 * j + 4] = bflo(w.z); x[8 * j + 5] = bfhi(w.z); x[8 * j + 6] = bflo(w.w); x[8 * j + 7] = bfhi(w.w); }
#pragma unroll
            for (int j = 0; j < 32; ++j) sum += x[j];
            const float mean = wave_sum(sum) * (1.f / 2048.f); float q = 0.f;
#pragma unroll
            for (int j = 0; j < 32; ++j) { const float d = x[j] - mean; q += d * d; }
            const float rstd = rsqrtf(wave_sum(q) * (1.f / 2048.f) + EPS);
            const u32x2 w = *((const u32x2*)(V + (tok0 + s) * 2048 + g * 256) + lane);
            const f32x4 gg = *(const f32x4*)(lng + g * 256 + 4 * lane), bb = *(const f32x4*)(lnb + g * 256 + 4 * lane);
            f32x4 o; o.x = (bflo(w.x) - mean) * rstd * gg.x + bb.x; o.y = (bfhi(w.x) - mean) * rstd * gg.y + bb.y; o.z = (bflo(w.y) - mean) * rstd * gg.z + bb.z; o.w = (bfhi(w.y) - mean) * rstd * gg.w + bb.w;
            *(LAS f32x4*)(vt + s * 256 + 4 * lane) = o;
            (void)st;
        }
        __syncthreads();
        const int c = tid & 255, th = tid >> 8;
        const float* wsg = A->in[I_SGWS] + (size_t)(i * 8 + g) * 128 * 128; const float* bsg = A->in[I_SGBS] + (i * 8 + g) * 128;
        for (int tt = 0; tt < 64; ++tt) {
            const int t = 2 * tt + th;
            const float* wr = wsg + t * 128;
            float acc = 0.f;
            for (int s = 0; s <= t; ++s) acc += wr[s] * vt[s * 256 + c];
            acc += bsg[t];
            const float u = bf2f(U[(tok0 + t) * 2048 + g * 256 + c]);
            UM[(tok0 + t) * 2048 + g * 256 + c] = (bf16)f2bf(u * acc);
        }
    }
    __syncthreads();
}


__device__ __forceinline__ void phase_sgu_mix_mfma(KArgs A, int wv_, int i, LAS unsigned char* lds) {
    const int tid = opaque_tid(wv_), wid = __builtin_amdgcn_readfirstlane(tid >> 6), lane = tid & 63, fr = lane & 15, fq = lane >> 4;
    unsigned char* ws = opq(A->ws);
    const bf16* U = (const bf16*)(ws + WS_U); const bf16* V = (const bf16*)(ws + WS_V); bf16* UM = (bf16*)(ws + WS_UM);
    const bf16* WSB = (const bf16*)(ws + WS_WSB) + (size_t)i * 8 * 16384; const float* M0 = (const float*)(ws + WS_M0) + i * 8 * 128;
    constexpr int VS = 136;
    LAS bf16* vT = (LAS bf16*)lds;
    LAS float* st = (LAS float*)(lds + 256 * VS * 2);
    LAS bf16* wl = (LAS bf16*)(lds + 256 * VS * 2 + 1024);
    const float* lng = A->in[I_LNG] + i * 2048; const float* lnb = A->in[I_LNB] + i * 2048; const float* bsg = A->in[I_SGBS] + i * 8 * 128;
    for (int it = blockIdx.x; it < 256; it += gridDim.x) {
        const int gh = it & 1, n_ = (it >> 1) & 15, b = it >> 5; const size_t tok0 = (size_t)b * S + n_ * 128;
        __syncthreads();
        {
            const float* vst = (const float*)(ws + WS_VSTAT);
#pragma unroll
            for (int s4 = 0; s4 < 16; s4 += 4) {
                const int s = wid * 16 + s4 + (lane >> 4);
                const f32x4 p = *(const f32x4*)(vst + (tok0 + s) * 64 + 4 * (lane & 15));
                float sum = p.x + p.z, sq = p.y + p.w;
                sum += __shfl_xor(sum, 1); sq += __shfl_xor(sq, 1); sum += __shfl_xor(sum, 2); sq += __shfl_xor(sq, 2);
                sum += __shfl_xor(sum, 4); sq += __shfl_xor(sq, 4); sum += __shfl_xor(sum, 8); sq += __shfl_xor(sq, 8);
                const float mean = sum * (1.f / 2048.f); const float var = fmaxf(sq * (1.f / 2048.f) - mean * mean, 0.f);
                if ((lane & 15) == 0) { st[2 * s] = mean; st[2 * s + 1] = rsqrtf(var + EPS); }
            }
        }
#pragma unroll 1
        for (int gg = 0; gg < 4; ++gg) {
            const int g = gh * 4 + gg;
            __syncthreads();
            {
                const int s = tid & 127, cq = tid >> 7;
                const float mean = st[2 * s], rstd = st[2 * s + 1];
                const u32x4* src = (const u32x4*)(V + (tok0 + s) * 2048 + g * 256 + cq * 64);
                u32x4 w8[8], ww[4];
#pragma unroll
                for (int i8 = 0; i8 < 8; ++i8) w8[i8] = src[i8];
#pragma unroll
                for (int q = 0; q < 4; ++q) { const int e = tid + 512 * q; ww[q] = *(const u32x4*)(WSB + ((size_t)g * 128 + (e >> 4)) * 128 + (e & 15) * 8); }
#pragma unroll
                for (int i8 = 0; i8 < 8; ++i8) {
                    const u32x4 w = w8[i8];
                    LAS bf16* d = vT + (cq * 64 + i8 * 8) * VS + s;
                    d[0 * VS] = (bf16)f2bf((bflo(w.x) - mean) * rstd); d[1 * VS] = (bf16)f2bf((bfhi(w.x) - mean) * rstd); d[2 * VS] = (bf16)f2bf((bflo(w.y) - mean) * rstd); d[3 * VS] = (bf16)f2bf((bfhi(w.y) - mean) * rstd);
                    d[4 * VS] = (bf16)f2bf((bflo(w.z) - mean) * rstd); d[5 * VS] = (bf16)f2bf((bfhi(w.z) - mean) * rstd); d[6 * VS] = (bf16)f2bf((bflo(w.w) - mean) * rstd); d[7 * VS] = (bf16)f2bf((bfhi(w.w) - mean) * rstd);
                }
#pragma unroll
                for (int q = 0; q < 4; ++q) { const int e = tid + 512 * q; *(LAS u32x4*)(wl + (e >> 4) * VS + (e & 15) * 8) = ww[q]; }
            }
            u32x2 uw[8][2]; float m0v[8], bsv[8];
#pragma unroll
            for (int n = 0; n < 8; ++n) { const int t = 16 * n + fr; m0v[n] = M0[g * 128 + t]; bsv[n] = bsg[g * 128 + t];
                const size_t ro = (tok0 + t) * 2048 + g * 256 + 32 * wid + 4 * fq; uw[n][0] = *(const u32x2*)(U + ro); uw[n][1] = *(const u32x2*)(U + ro + 16); }
            __syncthreads();
            bf16x8 vf[2][4];
#pragma unroll
            for (int m = 0; m < 2; ++m)
#pragma unroll
                for (int k = 0; k < 4; ++k) vf[m][k] = *(const LAS bf16x8*)(vT + (32 * wid + 16 * m + fr) * VS + 32 * k + 8 * fq);
            f32x4 gc[2], bc[2];
#pragma unroll
            for (int m = 0; m < 2; ++m) { gc[m] = *(const f32x4*)(lng + g * 256 + 32 * wid + 16 * m + 4 * fq); bc[m] = *(const f32x4*)(lnb + g * 256 + 32 * wid + 16 * m + 4 * fq); }
#pragma unroll
            for (int n = 0; n < 8; ++n) {
                f32x4 a0 = (f32x4){0.f, 0.f, 0.f, 0.f}, a1 = (f32x4){0.f, 0.f, 0.f, 0.f};
#pragma unroll
                for (int k = 0; k < 4; ++k) if (k <= (n >> 1)) {
                    const bf16x8 wf = *(const LAS bf16x8*)(wl + (16 * n + fr) * VS + 32 * k + 8 * fq);
                    a0 = __builtin_amdgcn_mfma_f32_16x16x32_bf16(vf[0][k], wf, a0, 0, 0, 0);
                    a1 = __builtin_amdgcn_mfma_f32_16x16x32_bf16(vf[1][k], wf, a1, 0, 0, 0); }
                const int t = 16 * n + fr; const float m0 = m0v[n], bsv_ = bsv[n];
                const size_t ro = (tok0 + t) * 2048 + g * 256 + 32 * wid + 4 * fq;
#pragma unroll
                for (int m = 0; m < 2; ++m) {
                    const f32x4 a = m ? a1 : a0;
                    const u32x2 uw_ = uw[n][m];
                    u32x2 w; w.x = pk2((a.x * gc[m].x + bc[m].x * m0 + bsv_) * bflo(uw_.x), (a.y * gc[m].y + bc[m].y * m0 + bsv_) * bfhi(uw_.x));
                    w.y = pk2((a.z * gc[m].z + bc[m].z * m0 + bsv_) * bflo(uw_.y), (a.w * gc[m].w + bc[m].w * m0 + bsv_) * bfhi(uw_.y));
                    *(u32x2*)(UM + ro + 16 * m) = w;
                }
            }
        }
    }
    __syncthreads();
}

__device__ __forceinline__ void phase_rownorm(KArgs A, int wv_) {
    const int tid_ = opaque_tid(wv_); const int wid = __builtin_amdgcn_readfirstlane(tid_ >> 6), lane = tid_ & 63; const int gw = blockIdx.x * 8 + wid, NGW = gridDim.x * 8;
    bf16* XN = (bf16*)(opq(A->ws) + WS_XN); const float* X = A->out;
    f32x4 v[4], vn[4];
    if (gw < T) {
#pragma unroll
        for (int j = 0; j < 4; ++j) v[j] = ((const f32x4*)(X + (size_t)gw * D) + lane)[64 * j];
    }
    for (int m = gw; m < T; m += NGW) {
        const int mn = m + NGW < T ? m + NGW : m;
#pragma unroll
        for (int j = 0; j < 4; ++j) vn[j] = ((const f32x4*)(X + (size_t)mn * D) + lane)[64 * j];
        float s = 0.f;
#pragma unroll
        for (int j = 0; j < 4; ++j) s += (v[j].x * v[j].x + v[j].y * v[j].y) + (v[j].z * v[j].z + v[j].w * v[j].w);
        const float rstd = rsqrtf(wave_sum(s) * (1.f / 1024.f) + EPS);
        u32x2* o8 = (u32x2*)(XN + (size_t)m * D) + lane;
#pragma unroll
        for (int j = 0; j < 4; ++j) { u32x2 w; w.x = pk2(v[j].x * rstd, v[j].y * rstd); w.y = pk2(v[j].z * rstd, v[j].w * rstd); o8[64 * j] = w; }
#pragma unroll
        for (int j = 0; j < 4; ++j) v[j] = vn[j];
    }
}

__device__ __forceinline__ void phase_xattn(KArgs A, int wv_, int L, LAS unsigned char* lds) {
    const int tid = opaque_tid(wv_), wid = __builtin_amdgcn_readfirstlane(tid >> 6), lane = tid & 63;
    unsigned char* ws = opq(A->ws);
    const bf16* QX = (const bf16*)(ws + WS_QX); const bf16* KV = (const bf16*)(ws + WS_KV); bf16* OX = (bf16*)(ws + WS_OX);
    constexpr int KSTR = 129;
    LAS unsigned* kl = (LAS unsigned*)lds;
    LAS float* qb = (LAS float*)(lds + 132096) + wid * 256;
    LAS float* pb = (LAS float*)(lds + 132096 + 8192) + wid * 256;
    const float* qg = A->in[I_XQN] + L * 256;
    for (int it = blockIdx.x; it < NBATCH * 4 * 8; it += gridDim.x) {
        const int qc = it & 7, h = (it >> 3) & 3, b = it >> 5;
        __syncthreads();
        for (int e = tid; e < 256 * 128; e += 512) { const int m = e >> 7, dw = e & 127;
            kl[m * KSTR + dw] = *((const unsigned*)(KV + (size_t)(b * 256 + m) * 8192 + L * 2048 + h * 256) + dw); }
        __syncthreads();
        const bf16* Vb = KV + (size_t)(b * 256) * 8192 + L * 2048 + 1024 + h * 256;
        for (int tq = 0; tq < 32; ++tq) {
            const size_t tok = (size_t)b * S + qc * 256 + wid * 32 + tq;
            const u32x2 qw = *((const u32x2*)(QX + tok * 1024 + h * 256) + lane);
            const float q0 = bflo(qw.x), q1 = bfhi(qw.x), q2 = bflo(qw.y), q3 = bfhi(qw.y);
            const float rstd = rsqrtf(wave_sum(q0 * q0 + q1 * q1 + q2 * q2 + q3 * q3) * (1.f / 256.f) + EPS);
            const f32x4 gg = *(const f32x4*)(qg + 4 * lane);
            *(LAS f32x4*)(qb + 4 * lane) = (f32x4){q0 * rstd * gg.x, q1 * rstd * gg.y, q2 * rstd * gg.z, q3 * rstd * gg.w};
            LDS_WAIT();
            float s0 = 0.f, s1 = 0.f, s2 = 0.f, s3 = 0.f;
#pragma unroll 4
            for (int dw = 0; dw < 128; ++dw) {
                const f32x2 qq = *(const LAS f32x2*)(qb + 2 * dw);
                const unsigned k0 = kl[lane * KSTR + dw], k1 = kl[(lane + 64) * KSTR + dw], k2 = kl[(lane + 128) * KSTR + dw], k3 = kl[(lane + 192) * KSTR + dw];
                s0 += qq.x * bflo(k0) + qq.y * bfhi(k0); s1 += qq.x * bflo(k1) + qq.y * bfhi(k1);
                s2 += qq.x * bflo(k2) + qq.y * bfhi(k2); s3 += qq.x * bflo(k3) + qq.y * bfhi(k3);
            }
            const float mx = wave_max(fmaxf(fmaxf(s0, s1), fmaxf(s2, s3)));
            const float e0 = __expf(s0 - mx), e1 = __expf(s1 - mx), e2 = __expf(s2 - mx), e3 = __expf(s3 - mx);
            const float inv = 1.f / wave_sum((e0 + e1) + (e2 + e3));
            pb[lane] = e0 * inv; pb[lane + 64] = e1 * inv; pb[lane + 128] = e2 * inv; pb[lane + 192] = e3 * inv;
            LDS_WAIT();
            float o0 = 0.f, o1 = 0.f, o2 = 0.f, o3 = 0.f;
#pragma unroll 8
            for (int m = 0; m < 256; ++m) {
                const float p = pb[m];
                const u32x2 vw = *((const u32x2*)(Vb + (size_t)m * 8192) + lane);
                o0 += p * bflo(vw.x); o1 += p * bfhi(vw.x); o2 += p * bflo(vw.y); o3 += p * bfhi(vw.y);
            }
            u32x2 ow; ow.x = pk2(o0, o1); ow.y = pk2(o2, o3);
            *((u32x2*)(OX + tok * 1024 + h * 256) + lane) = ow;
            LDS_WAIT();
        }
    }
    __syncthreads();
}


__device__ __forceinline__ int kperm32(int p) { const int fq = (p >> 3) & 3, j = p & 7; return (p & ~31) + 16 * (j >> 2) + 4 * fq + (j & 3); }
__device__ __forceinline__ void phase_vtrans(KArgs A, int wv_, LAS unsigned char* lds) {
    const int tid = opaque_tid(wv_);
    unsigned char* ws = opq(A->ws);
    const bf16* KV = (const bf16*)(ws + WS_KV); bf16* VT = (bf16*)(ws + WS_VT);
    LAS bf16* vt = (LAS bf16*)lds;
    constexpr int VS = 258;
    for (int it = blockIdx.x; it < DEPTH * NBATCH * 4; it += gridDim.x) {
        const int h = it & 3, b = (it >> 2) & 7, l = it >> 5;
        __syncthreads();
        for (int e = tid; e < 256 * 32; e += 512) { const int m = e >> 5, c8 = e & 31;
            const u32x4 w = *(const u32x4*)(KV + (size_t)(b * 256 + m) * 8192 + l * 2048 + 1024 + h * 256 + c8 * 8);
            LAS unsigned* d = (LAS unsigned*)(vt + m * VS + c8 * 8); d[0] = w.x; d[1] = w.y; d[2] = w.z; d[3] = w.w; }
        __syncthreads();
        for (int e = tid; e < 256 * 32; e += 512) { const int dv = e & 255, p8 = e >> 8;
            unsigned short x[8];
#pragma unroll
            for (int j = 0; j < 8; ++j) x[j] = vt[kperm32(p8 * 8 + j) * VS + dv];
            u32x4 o; o.x = x[0] | ((unsigned)x[1] << 16); o.y = x[2] | ((unsigned)x[3] << 16); o.z = x[4] | ((unsigned)x[5] << 16); o.w = x[6] | ((unsigned)x[7] << 16);
            *(u32x4*)(VT + ((size_t)it * 256 + dv) * 256 + p8 * 8) = o; }
    }
    __syncthreads();
}

__device__ __forceinline__ void xattn_item(KArgs A, int wv_, int L, LAS unsigned char* lds, const int b, const int h, const int qt) {
    const int tid = opaque_tid(wv_), wid = __builtin_amdgcn_readfirstlane(tid >> 6), lane = tid & 63, fr = lane & 15, fq = lane >> 4;
    unsigned char* ws = opq(A->ws);
    const bf16* QX = (const bf16*)(ws + WS_QX); const bf16* KV = (const bf16*)(ws + WS_KV); const bf16* VT = (const bf16*)(ws + WS_VT); bf16* OX = (bf16*)(ws + WS_OX);
    constexpr int RS = 264;
    LAS bf16* kl = (LAS bf16*)lds;
    const float* qg = A->in[I_XQN] + L * 256;
    {
        __syncthreads();
        {
            const int row = tid >> 1, hf = tid & 1;
            const u32x4* src = (const u32x4*)(KV + (size_t)(b * 256 + row) * 8192 + L * 2048 + h * 256 + hf * 128);
#pragma unroll
            for (int i0 = 0; i0 < 16; i0 += 8) {
                u32x4 w[8];
#pragma unroll
                for (int i = 0; i < 8; ++i) w[i] = src[i0 + i];
#pragma unroll
                for (int i = 0; i < 8; ++i) *(LAS u32x4*)(kl + row * RS + hf * 128 + (i0 + i) * 8) = w[i];
            }
        }
        const size_t tok0 = (size_t)b * S + qt * 256 + wid * 32 + fr;
        u32x4 qw0[8], qw1[8];
#pragma unroll
        for (int s = 0; s < 8; ++s) { qw0[s] = *(const u32x4*)(QX + tok0 * 1024 + h * 256 + 32 * s + 8 * fq); qw1[s] = *(const u32x4*)(QX + (tok0 + 16) * 1024 + h * 256 + 32 * s + 8 * fq); }
        __syncthreads();
        bf16x8 pf0[8], pf1[8]; float inv0, inv1;
        auto s_part = [&](const u32x4 (&qw)[8], bf16x8 (&pf)[8], float& inv) __attribute__((always_inline)) {
            float ssq = 0.f;
#pragma unroll
            for (int s = 0; s < 8; ++s) {
                const float a0 = bflo(qw[s].x), a1 = bfhi(qw[s].x), a2 = bflo(qw[s].y), a3 = bfhi(qw[s].y), a4 = bflo(qw[s].z), a5 = bfhi(qw[s].z), a6 = bflo(qw[s].w), a7 = bfhi(qw[s].w);
                ssq += (a0 * a0 + a1 * a1) + (a2 * a2 + a3 * a3) + (a4 * a4 + a5 * a5) + (a6 * a6 + a7 * a7);
            }
            ssq += __shfl_xor(ssq, 16); ssq += __shfl_xor(ssq, 32);
            const float rstd = rsqrtf(ssq * (1.f / 256.f) + EPS);
            bf16x8 qf[8];
#pragma unroll
            for (int s = 0; s < 8; ++s) qf[s] = __builtin_bit_cast(bf16x8, qw[s]);
            f32x4 sc[16];
#pragma unroll
            for (int hf = 0; hf < 2; ++hf) {
                unsigned kb = (unsigned)(size_t)(kl + (128 * hf + fr) * RS + 8 * fq); asm volatile("" : "+v"(kb));
#pragma unroll
                for (int t8 = 0; t8 < 8; ++t8) { const int t = 8 * hf + t8; sc[t] = (f32x4){0.f, 0.f, 0.f, 0.f};
#pragma unroll
                    for (int s = 0; s < 8; ++s) { const bf16x8 kf = *(const LAS bf16x8*)(size_t)(kb + (unsigned)((16 * t8 * RS + 32 * s) * 2));
                        sc[t] = __builtin_amdgcn_mfma_f32_16x16x32_bf16(kf, qf[s], sc[t], 0, 0, 0); }
                    if (t & 1) asm volatile("" ::: "memory"); }
            }
            float mx = -INFINITY;
#pragma unroll
            for (int t = 0; t < 16; ++t) mx = fmaxf(mx, fmaxf(fmaxf(sc[t].x, sc[t].y), fmaxf(sc[t].z, sc[t].w)));
            mx = fmaxf(mx, __shfl_xor(mx, 16)); mx = fmaxf(mx, __shfl_xor(mx, 32));
            float lsum = 0.f;
#pragma unroll
            for (int t = 0; t < 16; ++t) { sc[t].x = __expf((sc[t].x - mx) * rstd); sc[t].y = __expf((sc[t].y - mx) * rstd); sc[t].z = __expf((sc[t].z - mx) * rstd); sc[t].w = __expf((sc[t].w - mx) * rstd); lsum += (sc[t].x + sc[t].y) + (sc[t].z + sc[t].w); }
            lsum += __shfl_xor(lsum, 16); lsum += __shfl_xor(lsum, 32);
            inv = 1.f / lsum;
#pragma unroll
            for (int s = 0; s < 8; ++s) { u32x4 w; w.x = pk2(sc[2 * s].x, sc[2 * s].y); w.y = pk2(sc[2 * s].z, sc[2 * s].w); w.z = pk2(sc[2 * s + 1].x, sc[2 * s + 1].y); w.w = pk2(sc[2 * s + 1].z, sc[2 * s + 1].w);
                pf[s] = __builtin_bit_cast(bf16x8, w); }
        };
        s_part(qw0, pf0, inv0);
        s_part(qw1, pf1, inv1);
        __syncthreads();
        {
            const int row = tid >> 1, hf = tid & 1;
            const u32x4* src = (const u32x4*)(VT + ((size_t)((L * 8 + b) * 4 + h) * 256 + row) * 256 + hf * 128);
#pragma unroll
            for (int i0 = 0; i0 < 16; i0 += 8) {
                u32x4 w[8];
#pragma unroll
                for (int i = 0; i < 8; ++i) w[i] = src[i0 + i];
#pragma unroll
                for (int i = 0; i < 8; ++i) *(LAS u32x4*)(kl + row * RS + hf * 128 + (i0 + i) * 8) = w[i];
            }
        }
        __syncthreads();
#pragma unroll
        for (int hf = 0; hf < 2; ++hf) {
            unsigned vb = (unsigned)(size_t)(kl + (128 * hf + fr) * RS + 8 * fq); asm volatile("" : "+v"(vb));
#pragma unroll
            for (int n8 = 0; n8 < 8; ++n8) { const int n = 8 * hf + n8; f32x4 o0 = (f32x4){0.f, 0.f, 0.f, 0.f}, o1 = o0;
#pragma unroll
                for (int s = 0; s < 8; ++s) { const bf16x8 vf = *(const LAS bf16x8*)(size_t)(vb + (unsigned)((16 * n8 * RS + 32 * s) * 2));
                    o0 = __builtin_amdgcn_mfma_f32_16x16x32_bf16(vf, pf0[s], o0, 0, 0, 0);
                    o1 = __builtin_amdgcn_mfma_f32_16x16x32_bf16(vf, pf1[s], o1, 0, 0, 0); }
                u32x2 w0, w1; w0.x = pk2(o0.x * inv0, o0.y * inv0); w0.y = pk2(o0.z * inv0, o0.w * inv0); w1.x = pk2(o1.x * inv1, o1.y * inv1); w1.y = pk2(o1.z * inv1, o1.w * inv1);
                *(u32x2*)(OX + tok0 * 1024 + h * 256 + 16 * n + 4 * fq) = w0;
                *(u32x2*)(OX + (tok0 + 16) * 1024 + h * 256 + 16 * n + 4 * fq) = w1;
                if (n & 1) asm volatile("" ::: "memory"); }
        }
    }
    __syncthreads();
}

__device__ __forceinline__ void phase_route(KArgs A, int wv_, int L, LAS unsigned char* lds) {
    const int tid_ = opaque_tid(wv_); const int wid = __builtin_amdgcn_readfirstlane(tid_ >> 6), lane = tid_ & 63;
    unsigned char* ws = opq(A->ws);
    const float* RW = (const float*)(ws + WS_RW) + (size_t)L * NEXP * D;
    unsigned* cnt = (unsigned*)(ws + WS_CTL) + CW_CNT + L * 64;
    int* list = (int*)(ws + WS_LIST); int* te = (int*)(ws + WS_TOK); int* tp = te + 2 * T; float* tw = (float*)(tp + 2 * T);
    bf16* XN = (bf16*)(ws + WS_XN);
    LAS float* rwl = (LAS float*)lds;
    LAS unsigned* lcnt = (LAS unsigned*)(lds + 65536);
    LAS unsigned* lbase = lcnt + 16;
    const float rbv = A->in[I_RB][lane >> 2];
    for (int e4 = tid_; e4 < NEXP * D / 4; e4 += 512) *(LAS f32x4*)(rwl + 4 * e4) = *(const f32x4*)(RW + 4 * e4);
    for (int blk = blockIdx.x; blk < T / 64; blk += gridDim.x) {
        __syncthreads();
        if (tid_ < 16) lcnt[tid_] = 0u;
        __syncthreads();
        int e0s = 0, e1s = 0, r0s = 0, r1s = 0; float w0s = 0.f;
        f32x4 v[4], vn[4];
#pragma unroll
        for (int j = 0; j < 4; ++j) v[j] = ((const f32x4*)(A->out + (size_t)(blk * 64 + wid * 8) * D) + lane)[64 * j];
#pragma unroll 1
        for (int q = 0; q < 8; ++q) {
            const int t = blk * 64 + wid * 8 + q;
            { const f32x4* xn_ = (const f32x4*)(A->out + (size_t)(t + (q < 7 ? 1 : 0)) * D) + lane;
#pragma unroll
              for (int j = 0; j < 4; ++j) vn[j] = xn_[64 * j]; }
            float s = 0.f;
#pragma unroll
            for (int j = 0; j < 4; ++j) s += (v[j].x * v[j].x + v[j].y * v[j].y) + (v[j].z * v[j].z + v[j].w * v[j].w);
            const float rstd = rsqrtf(wave_sum(s) * (1.f / 1024.f) + EPS);
            u32x2* o8 = (u32x2*)(XN + (size_t)t * D) + lane;
#pragma unroll
            for (int j = 0; j < 4; ++j) { u32x2 w; w.x = pk2(v[j].x * rstd, v[j].y * rstd); w.y = pk2(v[j].z * rstd, v[j].w * rstd); o8[64 * j] = w; }
            float a[16];
#pragma unroll
            for (int e = 0; e < 16; ++e) {
                const LAS f32x4* wr = (const LAS f32x4*)(rwl + e * D) + lane; float acc = 0.f;
#pragma unroll
                for (int j = 0; j < 4; ++j) { const f32x4 w = wr[64 * j]; acc += (v[j].x * w.x + v[j].y * w.y) + (v[j].z * w.z + v[j].w * w.w); }
                a[e] = acc;
            }
            float a8[8], a4[4], a2[2], a1;
            { const bool up = lane & 32;
#pragma unroll
              for (int k = 0; k < 8; ++k) { const float send = up ? a[k] : a[k + 8], keep = up ? a[k + 8] : a[k]; a8[k] = keep + __shfl_xor(send, 32); } }
            { const bool up = lane & 16;
#pragma unroll
              for (int k = 0; k < 4; ++k) { const float send = up ? a8[k] : a8[k + 4], keep = up ? a8[k + 4] : a8[k]; a4[k] = keep + __shfl_xor(send, 16); } }
            { const bool up = lane & 8;
#pragma unroll
              for (int k = 0; k < 2; ++k) { const float send = up ? a4[k] : a4[k + 2], keep = up ? a4[k + 2] : a4[k]; a2[k] = keep + __shfl_xor(send, 8); } }
            { const bool up = lane & 4; const float send = up ? a2[0] : a2[1], keep = up ? a2[1] : a2[0]; a1 = keep + __shfl_xor(send, 4); }
            a1 += __shfl_xor(a1, 2); a1 += __shfl_xor(a1, 1);
            const float lg = a1 * rstd + rbv;
            const float v0 = wave_max(lg);
            const int e0 = (__ffsll((unsigned long long)__ballot(lg == v0)) - 1) >> 2;
            const int gidx = e0 >> 2;
            const bool c2 = (lane >> 4) == gidx && (lane >> 2) != e0;
            const float m2 = c2 ? lg : -INFINITY;
            const float v1 = wave_max(m2);
            const int e1 = (__ffsll((unsigned long long)__ballot(c2 && m2 == v1)) - 1) >> 2;
            const float w0 = 1.f / (1.f + __expf(v1 - v0));
            unsigned r0 = 0, r1 = 0;
            if (lane == 0) { r0 = atomicAdd((unsigned*)(lcnt + e0), 1u); r1 = atomicAdd((unsigned*)(lcnt + e1), 1u); }
            r0 = __builtin_amdgcn_readfirstlane(r0); r1 = __builtin_amdgcn_readfirstlane(r1);
            if (lane == q) { e0s = e0; e1s = e1; r0s = (int)r0; r1s = (int)r1; w0s = w0; }
#pragma unroll
            for (int j = 0; j < 4; ++j) v[j] = vn[j];
        }
        __syncthreads();
        if (tid_ < 16) lbase[tid_] = atomicAdd(&cnt[tid_], lcnt[tid_]);
        __syncthreads();
        if (lane < 8) {
            const int t = blk * 64 + wid * 8 + lane;
            const int p0 = (int)lbase[e0s] + r0s, p1 = (int)lbase[e1s] + r1s;
            list[e0s * T + p0] = t; list[e1s * T + p1] = t;
            te[2 * t] = e0s; te[2 * t + 1] = e1s; tp[2 * t] = p0; tp[2 * t + 1] = p1; tw[2 * t] = w0s; tw[2 * t + 1] = 1.f - w0s;
        }
    }
    __syncthreads();
}
__device__ __forceinline__ void phase_route_mfma(KArgs A, int wv_, int L, LAS unsigned char* lds) {
    const int tid = opaque_tid(wv_), wid = __builtin_amdgcn_readfirstlane(tid >> 6), lane = tid & 63, fr = lane & 15, fq = lane >> 4;
    unsigned char* ws = opq(A->ws);
    const float* RW = (const float*)(ws + WS_RW) + (size_t)L * NEXP * D;
    unsigned* cnt = (unsigned*)(ws + WS_CTL) + CW_CNT + L * 64;
    int* list = (int*)(ws + WS_LIST); int* te = (int*)(ws + WS_TOK); int* tp = te + 2 * T; float* tw = (float*)(tp + 2 * T);
    bf16* XN = (bf16*)(ws + WS_XN);
    constexpr int WSTR = 1032;
    LAS bf16* rwh = (LAS bf16*)lds;
    LAS bf16* rwl = rwh + 16 * WSTR;
    LAS float* xch = (LAS float*)(lds + 2 * 16 * WSTR * 2);
    LAS unsigned* lcnt = (LAS unsigned*)(lds + 2 * 16 * WSTR * 2 + 8 * 320 * 4);
    LAS unsigned* lbase = lcnt + 16;
    for (int e4 = tid; e4 < NEXP * D / 4; e4 += 512) {
        const f32x4 w = *(const f32x4*)(RW + 4 * e4);
        u32x2 h; h.x = pk2(w.x, w.y); h.y = pk2(w.z, w.w);
        u32x2 l; l.x = pk2(w.x - bflo(h.x), w.y - bfhi(h.x)); l.y = pk2(w.z - bflo(h.y), w.w - bfhi(h.y));
        const int e = (4 * e4) >> 10, k = (4 * e4) & 1023;
        *(LAS u32x2*)(rwh + e * WSTR + k) = h; *(LAS u32x2*)(rwl + e * WSTR + k) = l;
    }
    const int tg = wid >> 1, kh = wid & 1;
    const float rbv = A->in[I_RB][fr];
    for (int blk = blockIdx.x; blk < T / 64; blk += gridDim.x) {
        __syncthreads();
        if (tid < 16) lcnt[tid] = 0u;
        const size_t tok = (size_t)blk * 64 + 16 * tg + fr;
        const float* xrow = A->out + tok * D + 512 * kh + 8 * fq;
        f32x4 acc = (f32x4){0.f, 0.f, 0.f, 0.f}; float ssq = 0.f;
        bf16x8 ah[16];
#pragma unroll
        for (int s4 = 0; s4 < 16; s4 += 4) {
            f32x4 xa[4], xb[4];
#pragma unroll
            for (int q = 0; q < 4; ++q) { xa[q] = *(const f32x4*)(xrow + 32 * (s4 + q)); xb[q] = *(const f32x4*)(xrow + 32 * (s4 + q) + 4); }
#pragma unroll
            for (int q = 0; q < 4; ++q) {
                const int s = s4 + q; const f32x4 x0 = xa[q], x1 = xb[q];
                ssq += ((x0.x * x0.x + x0.y * x0.y) + (x0.z * x0.z + x0.w * x0.w)) + ((x1.x * x1.x + x1.y * x1.y) + (x1.z * x1.z + x1.w * x1.w));
                u32x4 hw; hw.x = pk2(x0.x, x0.y); hw.y = pk2(x0.z, x0.w); hw.z = pk2(x1.x, x1.y); hw.w = pk2(x1.z, x1.w);
                u32x4 lw; lw.x = pk2(x0.x - bflo(hw.x), x0.y - bfhi(hw.x)); lw.y = pk2(x0.z - bflo(hw.y), x0.w - bfhi(hw.y)); lw.z = pk2(x1.x - bflo(hw.z), x1.y - bfhi(hw.z)); lw.w = pk2(x1.z - bflo(hw.w), x1.w - bfhi(hw.w));
                ah[s] = __builtin_bit_cast(bf16x8, hw); const bf16x8 al = __builtin_bit_cast(bf16x8, lw);
                const bf16x8 bh = *(const LAS bf16x8*)(rwh + fr * WSTR + 512 * kh + 32 * s + 8 * fq), bl = *(const LAS bf16x8*)(rwl + fr * WSTR + 512 * kh + 32 * s + 8 * fq);
                acc = __builtin_amdgcn_mfma_f32_16x16x32_bf16(ah[s], bh, acc, 0, 0, 0);
                acc = __builtin_amdgcn_mfma_f32_16x16x32_bf16(ah[s], bl, acc, 0, 0, 0);
                acc = __builtin_amdgcn_mfma_f32_16x16x32_bf16(al, bh, acc, 0, 0, 0);
            }
        }
        ssq += __shfl_xor(ssq, 16); ssq += __shfl_xor(ssq, 32);
        LAS float* mine = xch + wid * 320; const LAS float* other = xch + (wid ^ 1) * 320;
#pragma unroll
        for (int r = 0; r < 4; ++r) mine[(4 * fq + r) * 20 + fr] = acc[r];
        if (fq == 0) mine[fr * 20 + 16] = ssq;
        __syncthreads();
        const float rstd = rsqrtf((ssq + other[fr * 20 + 16]) * (1.f / 1024.f) + EPS);
        {
            bf16* xo = XN + tok * D + 512 * kh + 8 * fq;
#pragma unroll
            for (int s = 0; s < 16; ++s) { const u32x4 hw = __builtin_bit_cast(u32x4, ah[s]);
                u32x4 o; o.x = pk2(bflo(hw.x) * rstd, bfhi(hw.x) * rstd); o.y = pk2(bflo(hw.y) * rstd, bfhi(hw.y) * rstd); o.z = pk2(bflo(hw.z) * rstd, bfhi(hw.z) * rstd); o.w = pk2(bflo(hw.w) * rstd, bfhi(hw.w) * rstd);
                *(u32x4*)(xo + 32 * s) = o; }
        }
        int e0r[4], e1r[4], r0r[4], r1r[4]; float w0r[4];
        if (kh == 0) {
#pragma unroll
            for (int r = 0; r < 4; ++r) {
                const float rs = __shfl(rstd, 4 * fq + r);
                const float lg = (acc[r] + other[(4 * fq + r) * 20 + fr]) * rs + rbv;
                float v0 = lg; v0 = fmaxf(v0, __shfl_xor(v0, 1)); v0 = fmaxf(v0, __shfl_xor(v0, 2)); v0 = fmaxf(v0, __shfl_xor(v0, 4)); v0 = fmaxf(v0, __shfl_xor(v0, 8));
                const unsigned long long bm0 = __ballot(lg == v0);
                const int e0 = __ffs((unsigned)(bm0 >> (16 * fq)) & 0xffffu) - 1;
                const bool c2 = (fr >> 2) == (e0 >> 2) && fr != e0;
                const float m2 = c2 ? lg : -INFINITY;
                float v1 = m2; v1 = fmaxf(v1, __shfl_xor(v1, 1)); v1 = fmaxf(v1, __shfl_xor(v1, 2)); v1 = fmaxf(v1, __shfl_xor(v1, 4)); v1 = fmaxf(v1, __shfl_xor(v1, 8));
                const unsigned long long bm1 = __ballot(c2 && m2 == v1);
                const int e1 = __ffs((unsigned)(bm1 >> (16 * fq)) & 0xffffu) - 1;
                e0r[r] = e0; e1r[r] = e1; w0r[r] = 1.f / (1.f + __expf(v1 - v0));
                r0r[r] = 0; r1r[r] = 0;
                if (fr == 0) { r0r[r] = (int)atomicAdd((unsigned*)(lcnt + e0), 1u); r1r[r] = (int)atomicAdd((unsigned*)(lcnt + e1), 1u); }
            }
        }
        __syncthreads();
        if (tid < 16) lbase[tid] = atomicAdd(&cnt[tid], lcnt[tid]);
        __syncthreads();
        if (kh == 0 && fr == 0) {
#pragma unroll
            for (int r = 0; r < 4; ++r) {
                const int t = blk * 64 + 16 * tg + 4 * fq + r;
                const int p0 = (int)lbase[e0r[r]] + r0r[r], p1 = (int)lbase[e1r[r]] + r1r[r];
                list[e0r[r] * T + p0] = t; list[e1r[r] * T + p1] = t;
                te[2 * t] = e0r[r]; te[2 * t + 1] = e1r[r]; tp[2 * t] = p0; tp[2 * t + 1] = p1; tw[2 * t] = w0r[r]; tw[2 * t + 1] = 1.f - w0r[r];
            }
        }
    }
    __syncthreads();
}

__device__ __forceinline__ void moe_offsets(KArgs A, int wv_, int L, LAS int* off, LAS int* cn) {
    if (opaque_tid(wv_) == 0) {
        const unsigned* cnt = (const unsigned*)(opq(A->ws) + WS_CTL) + CW_CNT + L * 64;
        int o = 0;
        for (int e = 0; e < 16; ++e) { const int c = (int)__hip_atomic_load(cnt + e, __ATOMIC_RELAXED, __HIP_MEMORY_SCOPE_AGENT); off[e] = o; cn[e] = c; o += (c + 255) & ~255; }
        off[16] = o;
    }
    __syncthreads();
}
__device__ __forceinline__ void phase_moe_combine(KArgs A, int wv_, int L, LAS unsigned char* lds) {
    LAS int* off = (LAS int*)lds; LAS int* cn = off + 32;
    moe_offsets(A, wv_, L, off, cn);
    const int tid_ = opaque_tid(wv_); const int wid = __builtin_amdgcn_readfirstlane(tid_ >> 6), lane = tid_ & 63; const int gw = blockIdx.x * 8 + wid, NGW = gridDim.x * 8;
    unsigned char* ws = opq(A->ws);
    const int* te = (const int*)(ws + WS_TOK); const int* tp = te + 2 * T; const float* tw = (const float*)(tp + 2 * T);
    const bf16* Y = (const bf16*)(ws + WS_Y); bf16* XN = (bf16*)(ws + WS_XN);
    const int nq = (T - gw + NGW - 1) / NGW;
    for (int q0 = 0; q0 < nq; q0 += 8) {
        int s0m = 0, s1m = 0; float w0m = 0.f, w1m = 0.f;
        { const int qq = q0 + (lane & 7); const int t = gw + NGW * (qq < nq ? qq : nq - 1);
          s0m = off[te[2 * t]] + tp[2 * t]; s1m = off[te[2 * t + 1]] + tp[2 * t + 1]; w0m = tw[2 * t]; w1m = tw[2 * t + 1]; }
        const int nn = nq - q0 < 8 ? nq - q0 : 8;
        f32x4 v[4], vn[4]; u32x2 ya[4], yb[4], yan[4], ybn[4];
        { const int t = gw + NGW * q0; const int sl0 = __builtin_amdgcn_readlane(s0m, 0), sl1 = __builtin_amdgcn_readlane(s1m, 0);
#pragma unroll
          for (int j = 0; j < 4; ++j) { v[j] = ((const f32x4*)(A->out + (size_t)t * D) + lane)[64 * j]; ya[j] = ((const u32x2*)(Y + (size_t)sl0 * D) + lane)[64 * j]; yb[j] = ((const u32x2*)(Y + (size_t)sl1 * D) + lane)[64 * j]; } }
#pragma unroll 1
        for (int q = 0; q < nn; ++q) {
            const int t = gw + NGW * (q0 + q);
            const int qn = q + 1 < nn ? q + 1 : q;
            { const int tn = gw + NGW * (q0 + qn); const int sl0 = __builtin_amdgcn_readlane(s0m, qn), sl1 = __builtin_amdgcn_readlane(s1m, qn);
#pragma unroll
              for (int j = 0; j < 4; ++j) { vn[j] = ((const f32x4*)(A->out + (size_t)tn * D) + lane)[64 * j]; yan[j] = ((const u32x2*)(Y + (size_t)sl0 * D) + lane)[64 * j]; ybn[j] = ((const u32x2*)(Y + (size_t)sl1 * D) + lane)[64 * j]; } }
            const float w0 = __builtin_bit_cast(float, __builtin_amdgcn_readlane(__builtin_bit_cast(int, w0m), q)), w1 = __builtin_bit_cast(float, __builtin_amdgcn_readlane(__builtin_bit_cast(int, w1m), q));
            float s = 0.f;
#pragma unroll
            for (int j = 0; j < 4; ++j) {
                v[j].x += w0 * bflo(ya[j].x) + w1 * bflo(yb[j].x); v[j].y += w0 * bfhi(ya[j].x) + w1 * bfhi(yb[j].x); v[j].z += w0 * bflo(ya[j].y) + w1 * bflo(yb[j].y); v[j].w += w0 * bfhi(ya[j].y) + w1 * bfhi(yb[j].y);
                s += (v[j].x * v[j].x + v[j].y * v[j].y) + (v[j].z * v[j].z + v[j].w * v[j].w);
            }
            const float rstd = rsqrtf(wave_sum(s) * (1.f / 1024.f) + EPS);
            f32x4* xr = (f32x4*)(A->out + (size_t)t * D) + lane; u32x2* o8 = (u32x2*)(XN + (size_t)t * D) + lane;
#pragma unroll
            for (int j = 0; j < 4; ++j) { xr[64 * j] = v[j]; u32x2 w; w.x = pk2(v[j].x * rstd, v[j].y * rstd); w.y = pk2(v[j].z * rstd, v[j].w * rstd); o8[64 * j] = w; }
#pragma unroll
            for (int j = 0; j < 4; ++j) { v[j] = vn[j]; ya[j] = yan[j]; yb[j] = ybn[j]; }
        }
    }
}

constexpr int PH_PER_EVEN = 5 + 6, PH_PER_ODD = 3 + 6;
constexpr int NPHASES = 1 + 2 * (PH_PER_EVEN + PH_PER_ODD);

__global__ void __launch_bounds__(512, 2) mk_fwd(Args Araw) {
    KArgs A0 = kargs();
    extern __shared__ __attribute__((aligned(16))) unsigned char lds_raw[];
    LAS unsigned char* lds = (LAS unsigned char*)lds_raw;
    volatile LAS unsigned* misc = (volatile LAS unsigned*)(lds + LDS_MISC);
    const int tid = threadIdx.x;
    if (tid < 16) misc[tid] = 0u;
    __syncthreads();
    const int lo = A0->ph_lo, hi = A0->ph_hi;
    const int wv_ = __builtin_amdgcn_readfirstlane(threadIdx.x >> 6);
    if (hi - lo > 1) (void)xcd_barrier_post((unsigned*)(A0->ws + WS_CTL) + CW_BAR, misc);
    int ph = 0;
    unsigned long long tacc_ = 0;
#define PH_BEGIN(k) if (ph >= lo && ph < hi) { const bool tprobe_ = (PROBE_TMASK >> (k)) & 1; unsigned long long tp0_ = 0; if (PROBE_TMASK && tprobe_) tp0_ = __builtin_amdgcn_s_memrealtime(); KArgs A = kargs(); unsigned char* ws = opq(A->ws); _Pragma("unroll 1") for (int rep_ = 0; rep_ < (((PROBE_MASK >> (k)) & 1) ? PROBE_REPS : 1); ++rep_)
#define PH_END   if (ph + 1 < hi) { XcdBarrier b_; b_.bar = (unsigned*)(opq(kargs()->ws) + WS_CTL) + CW_BAR; b_.x = xb_xcc_id(); b_.st = misc; xcd_barrier(b_, opaque_tid(wv_) == 0); } if (PROBE_TMASK && tprobe_) tacc_ += __builtin_amdgcn_s_memrealtime() - tp0_; } ++ph;
    const int G = gridDim.x, cb = blockIdx.x;

    PH_BEGIN(0) phase_prologue(A, wv_, lds); PH_END
    for (int L = 0; L < DEPTH; ++L) {
        const int i = L >> 1;
        if ((L & 1) == 0) {
            PH_BEGIN(3) {
                if (L == 0) {
                    pg8::DenseOrder S; S.init(NBATCH * NMEM, 8192, D, (const bf16*)(ws + WS_WKV), G, cb);
                    pg8::EpiBf16<0> E{(bf16*)(ws + WS_KV), 8192, 32, 0, nullptr, 0};
                    pg8::gemm_phase(lds, (const bf16*)(ws + WS_MN), D, S, E, wv_);
                }
                pg8::DenseOrder S; S.init(T, HYN, D, (const bf16*)(ws + WS_WHYB) + (size_t)i * HYN * D, G, cb);
                pg8::EpiBf16<0> E{(bf16*)(ws + WS_BIG), HYN, 12, 0, nullptr, 0};
                pg8::gemm_phase(lds, (const bf16*)(ws + WS_XN), D, S, E, wv_);
            } PH_END
            PH_BEGIN(4) { const int t4_ = opaque_tid(wv_); SUBT_BEGIN(4); SUBT_END(4, ws, t4_); SUBT_BEGIN(5); phase_compress_mfma(A, wv_, i, lds); SUBT_END(5, ws, t4_); SUBT_BEGIN(6); phase_nsa_prep(A, wv_, i, lds); SUBT_END(6, ws, t4_); SUBT_BEGIN(7); phase_vtiles(A, wv_, lds); SUBT_END(7, ws, t4_); } PH_END
            PH_BEGIN(5) { phase_gla_a(A, wv_, i, lds); __syncthreads(); phase_nsa_attn_mfma(A, wv_, i, lds); } PH_END
            PH_BEGIN(6) phase_gla_c(A, wv_, i, lds, L == 0); PH_END
            PH_BEGIN(7) {
                pg8::DenseOrder S; S.init(T, D, D, (const bf16*)(ws + WS_WHOUT) + (size_t)i * D * D, G, cb);
                pg8::EpiResAddNorm E{A->out, D, (bf16*)(ws + WS_XN), (float*)(ws + WS_ROWSQ)};
                pg8::gemm_phase(lds, (const bf16*)(ws + WS_CAT), D, S, E, wv_);
            } PH_END
        } else {
            PH_BEGIN(8) {
                pg8::DenseOrder S; S.init(T, 4096, D, (const bf16*)(ws + WS_WSGIN) + (size_t)i * 4096 * D, G, cb);
                pg8::EpiBf16<1> E{(bf16*)(ws + WS_U), 2048, 8, (size_t)(WS_V - WS_U) / 2, (float*)(ws + WS_VSTAT), 8};
                pg8::gemm_phase(lds, (const bf16*)(ws + WS_XN), D, S, E, wv_);
            } PH_END
            PH_BEGIN(9) phase_sgu_mix_mfma(A, wv_, i, lds); PH_END
            PH_BEGIN(10) {
                pg8::DenseOrder S; S.init(T, D, 2048, (const bf16*)(ws + WS_WSGOUT) + (size_t)i * D * 2048, G, cb);
                pg8::EpiResAddNorm E{A->out, D, (bf16*)(ws + WS_XN), (float*)(ws + WS_ROWSQ)};
                pg8::gemm_phase(lds, (const bf16*)(ws + WS_UM), 2048, S, E, wv_);
            } PH_END
        }
        PH_BEGIN(12) {
            pg8::DenseOrder S; S.init(T, D, D, (const bf16*)(ws + WS_WQ) + (size_t)L * D * D, G, cb);
            pg8::EpiBf16RowScale E{(bf16*)(ws + WS_QX), D, (const float*)(ws + WS_ROWSQ)};
            pg8::gemm_phase(lds, (const bf16*)(ws + WS_XN), D, S, E, wv_);
            asm volatile("s_waitcnt vmcnt(0)" ::: "memory");
            __syncthreads();
            pg8::Unit u_;
#pragma unroll 1
            for (int ui_ = 0; S.next(ui_, u_); ++ui_) xattn_item(A, wv_, L, lds, u_.pm >> 3, u_.pn, u_.pm & 7);
        } PH_END
        PH_BEGIN(14) {
            pg8::DenseOrder S; S.init(T, D, D, (const bf16*)(ws + WS_WO) + (size_t)L * D * D, G, cb);
            pg8::EpiResAdd E{A->out, D};
            pg8::gemm_phase(lds, (const bf16*)(ws + WS_OX), D, S, E, wv_);
        } PH_END
        PH_BEGIN(15) phase_route_mfma(A, wv_, L, lds); PH_END
        PH_BEGIN(16) {
            LAS int* off = (LAS int*)(lds + pg8::STAGE_BYTES); LAS int* cn = off + 32;
            moe_offsets(A, wv_, L, off, cn);
            pg8::MoeOrder<true> S{(off[16] / 256) * 3, 3, G, cb, D, off, cn, (const int*)(ws + WS_LIST), (const char*)(ws + WS_WMIN) + (size_t)L * 16 * 768 * D * 2, (size_t)768 * D * 2};
            pg8::EpiSwiglu E{(bf16*)(ws + WS_H), DEXP};
            pg8::gemm_phase(lds, (const bf16*)(ws + WS_XN), D, S, E, wv_);
        } PH_END
        PH_BEGIN(17) {
            LAS int* off = (LAS int*)(lds + pg8::STAGE_BYTES); LAS int* cn = off + 32;
            moe_offsets(A, wv_, L, off, cn);
            pg8::MoeOrder<false> S{(off[16] / 256) * 4, 4, G, cb, DEXP, off, cn, (const int*)(ws + WS_LIST), (const char*)(ws + WS_WMOUT) + (size_t)L * 16 * D * DEXP * 2, (size_t)D * DEXP * 2};
            pg8::EpiBf16<0> E{(bf16*)(ws + WS_Y), D, 4, 0, nullptr, 0};
            pg8::gemm_phase(lds, (const bf16*)(ws + WS_H), DEXP, S, E, wv_);
        } PH_END
        PH_BEGIN(18) phase_moe_combine(A, wv_, L, lds); PH_END
    }
#undef PH_BEGIN
#undef PH_END
    if (hi - lo > 1) { for (int q_ = 0; q_ < PROBE_XBAR; ++q_) { XcdBarrier b_; b_.bar = (unsigned*)(opq(kargs()->ws) + WS_CTL) + CW_BAR; b_.x = xb_xcc_id(); b_.st = misc; xcd_barrier(b_, opaque_tid(wv_) == 0); } }
    if ((PROBE_NSA || PROBE_SUB) && blockIdx.x == 0) { const unsigned long long d_ = __hip_atomic_load((unsigned long long*)(A0->ws + WS_CTL + 48000), __ATOMIC_RELAXED, __HIP_MEMORY_SCOPE_AGENT); const unsigned long long t0 = __builtin_amdgcn_s_memrealtime(); while (__builtin_amdgcn_s_memrealtime() - t0 < d_) __builtin_amdgcn_s_sleep(8); }
    if (PROBE_TMASK && blockIdx.x == 0) { const unsigned long long t0 = __builtin_amdgcn_s_memrealtime(); while (__builtin_amdgcn_s_memrealtime() - t0 < tacc_) __builtin_amdgcn_s_sleep(8); }
}

extern "C" void kernel_launch(void* const* d_in, const int* in_sizes, int n_in, void* d_out, int out_size, void* d_ws, size_t ws_size, hipStream_t stream) {
    static int grid = 0;
    if (grid == 0) {
        if (n_in != N_IN || out_size != T * D || ws_size < WS_END) { fprintf(stderr, "kernel_launch: unexpected problem (n_in %d, out %d, ws %zu)\n", n_in, out_size, ws_size); grid = -1; return; }
        int dev = 0, cus = 0, per_cu = 0;
        if (hipGetDevice(&dev) != hipSuccess || hipDeviceGetAttribute(&cus, hipDeviceAttributeMultiprocessorCount, dev) != hipSuccess) { grid = -1; return; }
        if (hipFuncSetAttribute((const void*)mk_fwd, hipFuncAttributeMaxDynamicSharedMemorySize, LDS_BYTES) != hipSuccess) { fprintf(stderr, "kernel_launch: hipFuncSetAttribute failed\n"); grid = -1; return; }
        if (hipOccupancyMaxActiveBlocksPerMultiprocessor(&per_cu, (const void*)mk_fwd, 512, LDS_BYTES) != hipSuccess || per_cu < 1) fprintf(stderr, "kernel_launch: occupancy query says %d\n", per_cu);
        (void)hipGetLastError();
        grid = cus;
    }
    if (grid < 0) return;
    (void)hipMemsetAsync((char*)d_ws + WS_CTL, 0, CTL_BYTES, stream);
    Args a{};
    for (int i = 0; i < N_IN; ++i) a.in[i] = (const float*)d_in[i];
    a.out = (float*)d_out; a.ws = (unsigned char*)d_ws;
    for (int j = 0; j < 32; ++j) a.freq[j] = (float)pow(10000.0, -(double)j / 32.0);
#if MK_ONE_LAUNCH
    a.ph_lo = 0; a.ph_hi = NPHASES;
    hipLaunchKernelGGL(mk_fwd, dim3(grid), dim3(512), LDS_BYTES, stream, a);
#else
    for (int p = 0; p < NPHASES; ++p) { a.ph_lo = p; a.ph_hi = p + 1; hipLaunchKernelGGL(mk_fwd, dim3(grid), dim3(512), LDS_BYTES, stream, a); }
#endif
}
```

```cpp
#include <hip/hip_runtime.h>
#include <stdint.h>
#include <stdio.h>
#include <math.h>

#ifndef PROBE_MASK
#define PROBE_MASK 0
#endif
#ifndef PROBE_TMASK
#define PROBE_TMASK 0
#endif
#ifndef PROBE_NSA
#define PROBE_NSA 0
#endif
#ifndef PROBE_SUB
#define PROBE_SUB 0
#endif
#ifndef PROBE_XBAR
#define PROBE_XBAR 0
#endif
#ifndef PROBE_NSAX
#define PROBE_NSAX 0
#endif
#ifndef PROBE_REPS
#define PROBE_REPS 2
#endif
#ifndef MK_ONE_LAUNCH
#define MK_ONE_LAUNCH 1
#endif

#define LAS __attribute__((address_space(3)))
typedef unsigned short bf16;
typedef short bf16x8 __attribute__((ext_vector_type(8)));
typedef float f32x4 __attribute__((ext_vector_type(4)));
typedef float f32x2 __attribute__((ext_vector_type(2)));
typedef unsigned u32x4 __attribute__((ext_vector_type(4)));
typedef unsigned u32x2 __attribute__((ext_vector_type(2)));

constexpr int T = 16384, D = 1024, NBATCH = 8, S = 2048, DEPTH = 4;
constexpr int NMEM = 256;
constexpr float EPS = 1e-6f;
constexpr int HYN = 3072, HYSRC = 2856;
constexpr int C_QA = 0, C_KC = 512, C_VC = 640, C_KS = 768, C_VS = 896, C_KW = 1024, C_VW = 1152, C_QB = 1280, C_KB = 1536, C_VB = 1792, C_RB = 2304, C_GA = 2816, C_AL = 2840;
constexpr int NCMP = 127;
constexpr int NEXP = 16, DEXP = 384;
constexpr int SLOTS = 2 * T + NEXP * 256;

enum { I_X = 0, I_MEM, I_POS, I_NMIX, I_NXAT, I_NMEM, I_NFFN, I_HYBIN, I_HYBOUT, I_QNORM, I_KNORM, I_CMPPE, I_CMPW1, I_CMPW2, I_GATEB, I_WA2, I_BA, I_ONORM,
       I_SGIN, I_LNG, I_LNB, I_SGWS, I_SGBS, I_SGOUT, I_XWQ, I_XWKV, I_XWO, I_XQN, I_XKN, I_RW, I_RB, I_MOEIN, I_MOEOUT, N_IN };

constexpr size_t MiB = 1u << 20;
constexpr size_t WS_CTL = 0, CTL_BYTES = 1 * MiB;
constexpr size_t WS_WHYB = 1 * MiB;
constexpr size_t WS_WHOUT = WS_WHYB + 12 * MiB;
constexpr size_t WS_WSGIN = WS_WHOUT + 4 * MiB;
constexpr size_t WS_WSGOUT = WS_WSGIN + 16 * MiB;
constexpr size_t WS_WQ = WS_WSGOUT + 8 * MiB;
constexpr size_t WS_WKV = WS_WQ + 8 * MiB;
constexpr size_t WS_WO = WS_WKV + 16 * MiB;
constexpr size_t WS_WMIN = WS_WO + 8 * MiB;
constexpr size_t WS_WMOUT = WS_WMIN + 96 * MiB;
constexpr size_t WS_RW = WS_WMOUT + 48 * MiB;
constexpr size_t WS_XN = WS_RW + 1 * MiB;
constexpr size_t WS_BIG = WS_XN + 32 * MiB;
constexpr size_t WS_QA = WS_BIG + 128 * MiB;
constexpr size_t WS_KS = WS_QA + 16 * MiB;
constexpr size_t WS_KW = WS_KS + 4 * MiB;
constexpr size_t WS_KC = WS_KW + 4 * MiB;
constexpr size_t WS_VC = WS_KC + 1 * MiB;
constexpr size_t WS_CAT = WS_VC + 1 * MiB;
constexpr size_t WS_QX = WS_CAT + 32 * MiB;
constexpr size_t WS_OX = WS_QX + 32 * MiB;
constexpr size_t WS_MN = WS_OX + 32 * MiB;
constexpr size_t WS_KV = WS_MN + 4 * MiB;
constexpr size_t WS_COS = WS_KV + 32 * MiB;
constexpr size_t WS_SIN = WS_COS + 2 * MiB;
constexpr size_t WS_LIST = WS_SIN + 2 * MiB;
constexpr size_t WS_TOK = WS_LIST + 1 * MiB;
constexpr size_t WS_VT = WS_TOK + 1 * MiB;
constexpr size_t WS_VTA = WS_VT + 16 * MiB;
constexpr size_t WS_SLOC = WS_VTA + 32 * MiB;
constexpr size_t WS_DEC = WS_SLOC + 32 * MiB;
constexpr size_t WS_STT = WS_DEC + 1 * MiB;
constexpr size_t WS_WSB = WS_STT + 16 * MiB;
constexpr size_t WS_M0 = WS_WSB + 768 * 1024;
constexpr size_t WS_W1T = WS_WSB + 1 * MiB;
constexpr size_t WS_ROWSQ = WS_W1T + 1 * MiB;
constexpr size_t WS_VSTAT = WS_ROWSQ + 1 * MiB;
constexpr size_t WS_END = WS_VSTAT + 4 * MiB;
constexpr size_t WS_Y = WS_BIG, WS_H = WS_BIG + 72 * MiB, WS_U = WS_BIG, WS_V = WS_BIG + 64 * MiB, WS_UM = WS_QX;
constexpr int CW_BAR = 4096;
constexpr int CW_CNT = 8192;

constexpr int LDS_BYTES = 159744;
constexpr int LDS_MISC = LDS_BYTES - 64;

typedef __bf16 bf16x2_t __attribute__((ext_vector_type(2)));
__device__ __forceinline__ unsigned pk2(float lo, float hi) { const f32x2 v = {lo, hi}; return __builtin_bit_cast(unsigned, __builtin_convertvector(v, bf16x2_t)); }
__device__ __forceinline__ unsigned f2bf(float f) { return (unsigned)__builtin_bit_cast(unsigned short, (__bf16)f); }
__device__ __forceinline__ float bf2f(unsigned b) { return __uint_as_float(b << 16); }
__device__ __forceinline__ float bflo(unsigned w) { return __uint_as_float(w << 16); }
__device__ __forceinline__ float bfhi(unsigned w) { return __uint_as_float(w & 0xffff0000u); }
__device__ __forceinline__ float wave_sum(float v) {
#pragma unroll
    for (int o = 1; o < 64; o <<= 1) v += __shfl_xor(v, o);
    return v;
}
__device__ __forceinline__ float wave_max(float v) {
#pragma unroll
    for (int o = 1; o < 64; o <<= 1) v = fmaxf(v, __shfl_xor(v, o));
    return v;
}
__device__ __forceinline__ int opaque_tid(int wv) { int l; asm volatile("v_mbcnt_lo_u32_b32 %0, -1, 0\n\tv_mbcnt_hi_u32_b32 %0, -1, %0" : "=v"(l)); return wv * 64 + l; }
__device__ __forceinline__ unsigned char* opq(unsigned char* p) { asm volatile("" : "+s"(p)); return p; }
#define LDS_WAIT() asm volatile("s_waitcnt lgkmcnt(0)" ::: "memory")
__device__ __forceinline__ float gelu_tanh(float x) {
    const float u2 = x * (1.5957691216057308f + 0.07135481283f * x * x);
    return x * __builtin_amdgcn_rcpf(1.0f + __expf(-u2));
}
__device__ __forceinline__ float sigmoidf_(float x) { return __builtin_amdgcn_rcpf(1.0f + __expf(-x)); }

#define SUBT_BEGIN(id) unsigned long long subt_##id = 0; if (PROBE_SUB == (id)) subt_##id = __builtin_amdgcn_s_memrealtime();
#define SUBT_END(id, wsp, tidv) do { if (PROBE_SUB == (id) && blockIdx.x == 0 && (tidv) == 0) atomicAdd((unsigned long long*)((wsp) + WS_CTL + 48000), __builtin_amdgcn_s_memrealtime() - subt_##id); } while (0)
#define XB_TMO      128
#define XB_XCNT(j)  (256  + 64 * (j))
#define XB_XSUB(j)  (1280 + 64 * (j))
#define XB_XGEN(j)  (2304 + 64 * (j))
#define XB_TOP      3328
#define XB_TOPGEN   3392
#define XCD_BAR_WORDS 3456
#define XB_SPIN_CAP (1u << 22)

__device__ __forceinline__ unsigned xb_ld(unsigned* p)              { return __hip_atomic_load(p, __ATOMIC_RELAXED, __HIP_MEMORY_SCOPE_AGENT); }
__device__ __forceinline__ unsigned xb_add(unsigned* p, unsigned v) { return __hip_atomic_fetch_add(p, v, __ATOMIC_RELAXED, __HIP_MEMORY_SCOPE_AGENT); }
__device__ __forceinline__ unsigned xb_xcc_id() { return (unsigned)__builtin_amdgcn_s_getreg((3 << 11) | 20) & 0xFu; }
#define XB_SPIN(cond, bar) do { unsigned _sp = 0; while (cond) { __builtin_amdgcn_s_sleep(1); \
    if ((++_sp & 255u) == 0u) { if (xb_ld(&(bar)[XB_TMO])) break; if (_sp > XB_SPIN_CAP) { atomicAdd(&(bar)[XB_TMO], 1u); break; } } } } while (0)

struct XcdBarrier { unsigned* bar; unsigned x; volatile LAS unsigned* st; };
__device__ __forceinline__ unsigned* xb_opaque(unsigned* p) { unsigned long long v = (unsigned long long)p; unsigned lo = __builtin_amdgcn_readfirstlane((unsigned)v), hi = __builtin_amdgcn_readfirstlane((unsigned)(v >> 32));
    asm volatile("" : "+s"(lo), "+s"(hi)); return (unsigned*)(((unsigned long long)hi << 32) | lo); }

__device__ __forceinline__ XcdBarrier xcd_barrier_post(unsigned* bar, volatile LAS unsigned* st) {
    XcdBarrier b; b.bar = bar; b.x = xb_xcc_id(); b.st = st;
    if (threadIdx.x == 0) (void)xb_add(&bar[XB_XCNT(b.x)], 1u);
    return b;
}
__device__ __forceinline__ void xcd_barrier_complete(unsigned* bar, unsigned x, unsigned& nloc, unsigned& nx) {
    const unsigned G = gridDim.x * gridDim.y * gridDim.z;
    unsigned sum, cnt, mine, sp = 0u;
    for (;;) {
        sum = 0u; cnt = 0u; mine = 0u;
#pragma unroll
        for (unsigned j = 0; j < 16; ++j) { const unsigned c = xb_ld(&bar[XB_XCNT(j)]); sum += c; cnt += (c > 0u) ? 1u : 0u; mine = (j == x) ? c : mine; }
        if (sum == G) break;
        __builtin_amdgcn_s_sleep(1);
        if ((++sp & 255u) == 0u) { if (xb_ld(&bar[XB_TMO])) break; if (sp > XB_SPIN_CAP) { atomicAdd(&bar[XB_TMO], 1u); break; } }
    }
    nloc = mine > 0u ? mine : 1u; nx = cnt > 0u ? cnt : 1u;
}
__device__ __forceinline__ void xcd_barrier(const XcdBarrier& b, const bool is_t0) {
    asm volatile("s_waitcnt vmcnt(0)" ::: "memory");
    __syncthreads();
    if (is_t0) {
        unsigned* bar = b.bar;
        __builtin_amdgcn_s_waitcnt(0);
        unsigned nloc = b.st[0], nx = b.st[1];
        if (nloc == 0u) { xcd_barrier_complete(bar, b.x, nloc, nx); b.st[0] = nloc; b.st[1] = nx; }
        const unsigned old = xb_add(&bar[XB_XSUB(b.x)], 1u);
        const unsigned gen = old / nloc;
        if (old + 1u == (gen + 1u) * nloc) {
            __builtin_amdgcn_fence(__ATOMIC_RELEASE, "agent");
            asm volatile("s_waitcnt vmcnt(0)" ::: "memory");
            const unsigned og = xb_add(&bar[XB_TOP], 1u);
            const unsigned tg = og / nx;
            if (og + 1u == (tg + 1u) * nx) xb_add(&bar[XB_TOPGEN], 1u);
            else XB_SPIN(xb_ld(&bar[XB_TOPGEN]) == tg, bar);
            __builtin_amdgcn_fence(__ATOMIC_ACQUIRE, "agent");
            xb_add(&bar[XB_XGEN(b.x)], 1u);
            asm volatile("s_waitcnt vmcnt(0)" ::: "memory");
        } else {
            XB_SPIN(xb_ld(&bar[XB_XGEN(b.x)]) == gen, bar);
            __builtin_amdgcn_fence(__ATOMIC_ACQUIRE, "agent");
            asm volatile("s_waitcnt vmcnt(0)" ::: "memory");
        }
    }
    __syncthreads();
}

struct Args {
    const float* in[N_IN];
    float* out;
    unsigned char* ws;
    float freq[32];
    int ph_lo, ph_hi;
};

typedef const __attribute__((address_space(4))) Args* KArgs;
__device__ __forceinline__ KArgs kargs() { KArgs p = (KArgs)__builtin_amdgcn_kernarg_segment_ptr(); asm volatile("" : "+s"(p)); return p; }

__device__ __forceinline__ void st_bf16x4(bf16* p, f32x4 v) { u32x2 w; w.x = pk2(v[0], v[1]); w.y = pk2(v[2], v[3]); *(u32x2*)p = w; }


namespace pg8 {
constexpr int BM = 256, BK = 64, HALF = 128, HTB = HALF * BK * 2, STAGE_BYTES = 8 * HTB, NXCD = 8, WGM = 8;
__host__ __device__ __forceinline__ int lds_byte(int r, int c) { const int st = (r >> 4) * 2 + (c >> 5), rr = r & 15, cc = c & 31, ob = rr * 64 + cc * 2; return st * 1024 + (ob ^ (((ob >> 9) & 1) << 5)); }
__host__ __device__ __forceinline__ void stage_rc(int b, int& R, int& C) { const int st = b / 1024, sb = b % 1024, swz = sb ^ (((sb >> 9) & 1) << 5); R = (st >> 1) * 16 + swz / 64; C = (st & 1) * 32 + (swz % 64) / 2; }
__host__ __device__ __forceinline__ int perm32(int rho) { const int n = rho >> 4, i = rho & 15; return 8 * (i >> 2) + 4 * n + (i & 3); }
struct Unit { int pm, pn, e; };
struct DenseOrder {
    static constexpr bool GATHER = false;
    int nM, nN, nwg, G, c, K; const char* Bt;
    __device__ __forceinline__ void init(int M, int N, int K_, const bf16* Bt_, int G_, int c_) { nM = M / BM; nN = N / BM; nwg = nM * nN; G = G_; c = c_; K = K_; Bt = (const char*)Bt_; }
    __device__ __forceinline__ bool next(int i, Unit& u) const {
        const long L = (long)i * G + c; if (L >= nwg) return false;
        int wgid = (int)L; { const int q = nwg / NXCD, r = nwg % NXCD, xcd = wgid % NXCD, off = wgid / NXCD; wgid = (xcd < r ? xcd * (q + 1) : r * (q + 1) + (xcd - r) * q) + off; }
        const int nig = WGM * nN, gid = wgid / nig, fm = gid * WGM, gsz = (nM - fm) < WGM ? (nM - fm) : WGM;
        u.pm = fm + ((wgid % nig) % gsz); u.pn = (wgid % nig) / gsz; u.e = 0; return true;
    }
    __device__ __forceinline__ unsigned a_voff(const Unit& u, int half, int R) const { return (unsigned)((u.pm * BM + half * HALF + R) * K) * 2u; }
    __device__ __forceinline__ const char* b_tile(const Unit& u) const { return Bt + (size_t)u.pn * BM * K * 2; }
};
template <bool GATH> struct MoeOrder {
    static constexpr bool GATHER = GATH;
    int nunits, ntn, G, c, K; const LAS int* off; const LAS int* cn; const int* list; const char* Bt; size_t estride;
    __device__ __forceinline__ bool next(int i, Unit& u) const {
        const int L = i * G + c; if (L >= nunits) return false;
        u.pm = L / ntn; u.pn = L % ntn; const int s0 = u.pm * BM; int e = 0;
#pragma unroll
        for (int q = 1; q < 16; ++q) e += (s0 >= off[q]) ? 1 : 0;
        u.e = e; return true;
    }
    __device__ __forceinline__ unsigned a_voff(const Unit& u, int half, int R) const {
        const int slot = u.pm * BM + half * HALF + R;
        const int loc = slot - off[u.e]; const int tk = list[u.e * T + (loc < cn[u.e] ? loc : 0)];
        return (unsigned)(tk * K) * 2u;
    }
    __device__ __forceinline__ const char* b_tile(const Unit& u) const { return Bt + (size_t)u.e * estride + (size_t)u.pn * BM * K * 2; }
};
__device__ __forceinline__ unsigned cvt_pk_bf16(float lo, float hi) { return pk2(lo, hi); }

template <class Epi, class Sched>
__device__ __forceinline__ void gemm_phase(LAS unsigned char* lds, const bf16* Aptr, int K, const Sched& S, const Epi& E, int wv_) {
    const int tid = opaque_tid(wv_), wid = __builtin_amdgcn_readfirstlane(tid >> 6), lane = tid & 63, wr = wid >> 2, wc = wid & 3, fr = lane & 15, fq = lane >> 4;
    const int nt = K / BK;
    int Rr[2], Cc[2]; unsigned voffA[2], voffB[2];
#pragma unroll
    for (int i = 0; i < 2; ++i) { stage_rc(tid * 16 + i * 8192, Rr[i], Cc[i]); const int Rb = Epi::PERM ? ((Rr[i] & ~31) + perm32(Rr[i] & 31)) : Rr[i];
        voffA[i] = (unsigned)(Rr[i] * K + Cc[i]) * 2u; voffB[i] = (unsigned)(Rb * K + Cc[i]) * 2u; }
    const size_t kstep = (size_t)(BK * 2);
    const size_t hstep = (size_t)HALF * K * 2;
    const size_t tstep = 2 * hstep;
    const unsigned ldsw = (unsigned)wid * 1024u;
    const int aoff = lds_byte(wr * 64 + fr, fq * 8), boff = lds_byte(wc * 32 + fr, fq * 8);
    const char* const Ab = (const char*)Aptr;
#define PG8_SA(b, h) (((b) * 2 + (h)) * HTB)
#define PG8_SB(b, h) ((4 + (b) * 2 + (h)) * HTB)
#define PG8_STAGE(bufoff, gbase, voff) do { _Pragma("unroll") for (int _i = 0; _i < 2; ++_i) \
        __builtin_amdgcn_global_load_lds((const unsigned*)((const char*)(gbase) + (voff)[_i]), (LAS unsigned*)(lds + (bufoff) + ldsw + _i * 8192), 16, 0, 0); } while (0)
#define PG8_STAGE_A(bufoff, usenext, h, kofs) do { \
        if constexpr (Sched::GATHER) { const char* gb_ = Ab + (kofs); unsigned vv_[2] = {(usenext) ? vN[h][0] : vA[h][0], (usenext) ? vN[h][1] : vA[h][1]}; PG8_STAGE(bufoff, gb_, vv_); } \
        else { const char* gb_ = ((usenext) ? nA : cA) + (size_t)(h) * hstep + (kofs); PG8_STAGE(bufoff, gb_, voffA); } } while (0)
#define PG8_LDA(dst, b, h) do { _Pragma("unroll") for (int m = 0; m < 4; ++m) _Pragma("unroll") for (int k = 0; k < 2; ++k) dst[m][k] = *(const LAS bf16x8*)(lds + PG8_SA(b, h) + aoff + m * 2048 + k * 1024); } while (0)
#define PG8_LDB(dst, b, h) do { _Pragma("unroll") for (int n = 0; n < 2; ++n) _Pragma("unroll") for (int k = 0; k < 2; ++k) dst[n][k] = *(const LAS bf16x8*)(lds + PG8_SB(b, h) + boff + n * 2048 + k * 1024); } while (0)
#define PG8_MMA(ai, bj, At, Bt) do { __builtin_amdgcn_s_setprio(1); _Pragma("unroll") for (int m = 0; m < 4; ++m) _Pragma("unroll") for (int n = 0; n < 2; ++n) _Pragma("unroll") for (int k = 0; k < 2; ++k) \
        acc[ai][bj][m][n] = __builtin_amdgcn_mfma_f32_16x16x32_bf16(Bt[n][k], At[m][k], acc[ai][bj][m][n], 0, 0, 0); __builtin_amdgcn_s_setprio(0); } while (0)
#define PG8_WAIT_V(n) asm volatile("s_waitcnt vmcnt(" #n ")" ::: "memory")
#define PG8_WAIT_L(n) asm volatile("s_waitcnt lgkmcnt(" #n ")" ::: "memory")
#define PG8_BAR __builtin_amdgcn_s_barrier()
#define PG8_SCHED __builtin_amdgcn_sched_barrier(0)
    Unit cur, nxt; int ui = 0;
    if (!S.next(0, cur)) return;
    f32x4 acc[2][2][4][2];
#pragma unroll
    for (int a = 0; a < 2; ++a)
#pragma unroll
        for (int b = 0; b < 2; ++b)
#pragma unroll
            for (int m = 0; m < 4; ++m)
#pragma unroll
                for (int n = 0; n < 2; ++n) acc[a][b][m][n] = (f32x4){0.f, 0.f, 0.f, 0.f};
    bf16x8 At[4][2], B0[2][2], B1[2][2];
    unsigned vA[2][2], vN[2][2];
    const char* cA = Ab; const char* nA = Ab;
    if constexpr (Sched::GATHER) {
#pragma unroll
        for (int h = 0; h < 2; ++h)
#pragma unroll
            for (int i = 0; i < 2; ++i) { vA[h][i] = S.a_voff(cur, h, Rr[i]) + (unsigned)Cc[i] * 2u; vN[h][i] = vA[h][i]; }
    } else { cA = Ab + (size_t)cur.pm * tstep; nA = cA; }
    const char* cB = S.b_tile(cur);
    PG8_STAGE(PG8_SB(0, 0), cB, voffB); PG8_STAGE_A(PG8_SA(0, 0), false, 0, 0); PG8_STAGE(PG8_SB(0, 1), cB + hstep, voffB); PG8_STAGE_A(PG8_SA(0, 1), false, 1, 0);
    if (wr == 1) PG8_BAR;
    PG8_WAIT_V(4); PG8_BAR;
    PG8_STAGE(PG8_SB(1, 0), cB + kstep, voffB); PG8_STAGE_A(PG8_SA(1, 0), false, 0, kstep); PG8_STAGE(PG8_SB(1, 1), cB + hstep + kstep, voffB);
    PG8_WAIT_V(6); PG8_BAR;
    for (;;) {
        const bool has_next = S.next(ui + 1, nxt);
        const char* nB = has_next ? S.b_tile(nxt) : cB;
        if constexpr (Sched::GATHER) {
#pragma unroll
            for (int h = 0; h < 2; ++h)
#pragma unroll
                for (int i = 0; i < 2; ++i) vN[h][i] = has_next ? S.a_voff(nxt, h, Rr[i]) + (unsigned)Cc[i] * 2u : vA[h][i];
        } else nA = has_next ? Ab + (size_t)nxt.pm * tstep : cA;
        for (int t = 0; t < nt; t += 2) {
            const bool last = (t == nt - 2);
            const size_t k1 = (size_t)(t + 1) * kstep, k2 = last ? 0 : (size_t)(t + 2) * kstep, k3 = k2 + kstep;
            const char* b2 = last ? nB : cB + (size_t)(t + 2) * kstep; const char* b3 = b2 + kstep;
            PG8_LDB(B0, 0, 0); PG8_SCHED; PG8_LDA(At, 0, 0); PG8_STAGE_A(PG8_SA(1, 1), false, 1, k1);
            PG8_WAIT_L(8); PG8_BAR; PG8_WAIT_L(0); PG8_MMA(0, 0, At, B0); PG8_BAR; PG8_SCHED;
            PG8_LDB(B1, 0, 1); PG8_STAGE(PG8_SB(0, 0), b2, voffB);
            PG8_BAR; PG8_WAIT_L(0); PG8_MMA(0, 1, At, B1); PG8_BAR;
            PG8_LDA(At, 0, 1); PG8_STAGE_A(PG8_SA(0, 0), last, 0, k2);
            PG8_BAR; PG8_WAIT_L(0); PG8_MMA(1, 0, At, B0); PG8_BAR; PG8_SCHED;
            PG8_STAGE(PG8_SB(0, 1), b2 + hstep, voffB);
            PG8_WAIT_V(6); PG8_BAR; PG8_MMA(1, 1, At, B1); PG8_BAR;
            PG8_LDB(B0, 1, 0); PG8_SCHED; PG8_LDA(At, 1, 0); PG8_STAGE_A(PG8_SA(0, 1), last, 1, k2);
            PG8_WAIT_L(8); PG8_BAR; PG8_WAIT_L(0); PG8_MMA(0, 0, At, B0); PG8_BAR; PG8_SCHED;
            PG8_LDB(B1, 1, 1); PG8_STAGE(PG8_SB(1, 0), b3, voffB);
            PG8_BAR; PG8_WAIT_L(0); PG8_MMA(0, 1, At, B1); PG8_BAR;
            PG8_LDA(At, 1, 1); PG8_STAGE_A(PG8_SA(1, 0), last, 0, k3);
            PG8_BAR; PG8_WAIT_L(0); PG8_MMA(1, 0, At, B0); PG8_BAR; PG8_SCHED;
            PG8_STAGE(PG8_SB(1, 1), b3 + hstep, voffB);
            PG8_WAIT_V(6); PG8_BAR; PG8_MMA(1, 1, At, B1); PG8_BAR;
        }
        E(acc, cur, wr, wc, fr, fq);
        if (!has_next) break;
#pragma unroll
        for (int a = 0; a < 2; ++a)
#pragma unroll
            for (int b = 0; b < 2; ++b)
#pragma unroll
                for (int m = 0; m < 4; ++m)
#pragma unroll
                    for (int n = 0; n < 2; ++n) acc[a][b][m][n] = (f32x4){0.f, 0.f, 0.f, 0.f};
        cur = nxt; cB = nB; cA = nA; ++ui;
        if constexpr (Sched::GATHER) {
#pragma unroll
            for (int h = 0; h < 2; ++h)
#pragma unroll
                for (int i = 0; i < 2; ++i) vA[h][i] = vN[h][i];
        }
    }
    PG8_WAIT_V(0);
    if (wr == 0) PG8_BAR;
    PG8_BAR;
#undef PG8_SA
#undef PG8_SB
#undef PG8_STAGE
#undef PG8_STAGE_A
#undef PG8_LDA
#undef PG8_LDB
#undef PG8_MMA
#undef PG8_WAIT_V
#undef PG8_WAIT_L
#undef PG8_BAR
#undef PG8_SCHED
}
template <int ACT> struct EpiBf16 {
    static constexpr bool PERM = true;
    bf16* O; int ldc; int tpt; size_t tstride; float* stats; int stat_pn0;
    __device__ __forceinline__ void operator()(const f32x4 (&acc)[2][2][4][2], const Unit& u, int wr, int wc, int fr, int fq) const {
        const int row0 = u.pm * BM + wr * 64 + fr; const int tt = u.pn / tpt; bf16* base = O + (size_t)tt * tstride; const int col0 = (u.pn - tt * tpt) * BM + wc * 32 + 8 * fq;
#pragma unroll
        for (int ai = 0; ai < 2; ++ai)
#pragma unroll
            for (int m = 0; m < 4; ++m) { bf16* rowp = base + (size_t)(row0 + ai * HALF + m * 16) * ldc + col0; float psum = 0.f, psq = 0.f;
#pragma unroll
                for (int bj = 0; bj < 2; ++bj) { f32x4 v0 = acc[ai][bj][m][0], v1 = acc[ai][bj][m][1];
                    if (ACT == 1) {
#pragma unroll
                        for (int q = 0; q < 4; ++q) { v0[q] = gelu_tanh(v0[q]); v1[q] = gelu_tanh(v1[q]); } }
                    if (ACT == 1) { psum += ((v0[0] + v0[1]) + (v0[2] + v0[3])) + ((v1[0] + v1[1]) + (v1[2] + v1[3]));
                        psq += ((v0[0] * v0[0] + v0[1] * v0[1]) + (v0[2] * v0[2] + v0[3] * v0[3])) + ((v1[0] * v1[0] + v1[1] * v1[1]) + (v1[2] * v1[2] + v1[3] * v1[3])); }
                    u32x4 w; w.x = cvt_pk_bf16(v0[0], v0[1]); w.y = cvt_pk_bf16(v0[2], v0[3]); w.z = cvt_pk_bf16(v1[0], v1[1]); w.w = cvt_pk_bf16(v1[2], v1[3]);
                    *(u32x4*)(rowp + bj * HALF) = w; }
                if (ACT == 1 && stats && u.pn >= stat_pn0) {
                    psum += __shfl_xor(psum, 16); psum += __shfl_xor(psum, 32); psq += __shfl_xor(psq, 16); psq += __shfl_xor(psq, 32);
                    if (fq == 0) { f32x2 st2 = {psum, psq}; *(f32x2*)(stats + ((size_t)(row0 + ai * HALF + m * 16) * 32 + (u.pn - stat_pn0) * 4 + wc) * 2) = st2; } } }
    }
};
struct EpiResAdd {
    static constexpr bool PERM = false;
    float* X; int ldc;
    __device__ __forceinline__ void operator()(const f32x4 (&acc)[2][2][4][2], const Unit& u, int wr, int wc, int fr, int fq) const {
        const int row0 = u.pm * BM + wr * 64 + fr, col0 = u.pn * BM + wc * 32 + 4 * fq;
#pragma unroll
        for (int ai = 0; ai < 2; ++ai)
#pragma unroll
            for (int m2 = 0; m2 < 4; m2 += 2) {
                f32x4 x[2][2][2];
#pragma unroll
                for (int mm = 0; mm < 2; ++mm)
#pragma unroll
                    for (int bj = 0; bj < 2; ++bj)
#pragma unroll
                        for (int n = 0; n < 2; ++n) x[mm][bj][n] = *(const f32x4*)(X + (size_t)(row0 + ai * HALF + (m2 + mm) * 16) * ldc + col0 + bj * HALF + n * 16);
#pragma unroll
                for (int mm = 0; mm < 2; ++mm)
#pragma unroll
                    for (int bj = 0; bj < 2; ++bj)
#pragma unroll
                        for (int n = 0; n < 2; ++n) *(f32x4*)(X + (size_t)(row0 + ai * HALF + (m2 + mm) * 16) * ldc + col0 + bj * HALF + n * 16) = x[mm][bj][n] + acc[ai][bj][m2 + mm][n];
            }
    }
};
struct EpiResAddNorm {
    static constexpr bool PERM = false;
    float* X; int ldc; bf16* XB; float* rowsq;
    __device__ __forceinline__ void operator()(const f32x4 (&acc)[2][2][4][2], const Unit& u, int wr, int wc, int fr, int fq) const {
        const int row0 = u.pm * BM + wr * 64 + fr, col0 = u.pn * BM + wc * 32 + 4 * fq;
#pragma unroll
        for (int ai = 0; ai < 2; ++ai)
#pragma unroll
            for (int m2 = 0; m2 < 4; m2 += 2) {
                f32x4 x[2][2][2];
#pragma unroll
                for (int mm = 0; mm < 2; ++mm)
#pragma unroll
                    for (int bj = 0; bj < 2; ++bj)
#pragma unroll
                        for (int n = 0; n < 2; ++n) x[mm][bj][n] = *(const f32x4*)(X + (size_t)(row0 + ai * HALF + (m2 + mm) * 16) * ldc + col0 + bj * HALF + n * 16);
#pragma unroll
                for (int mm = 0; mm < 2; ++mm) {
                    const size_t ro = (size_t)(row0 + ai * HALF + (m2 + mm) * 16) * ldc + col0; float ssq = 0.f;
#pragma unroll
                    for (int bj = 0; bj < 2; ++bj)
#pragma unroll
                        for (int n = 0; n < 2; ++n) { const f32x4 v = x[mm][bj][n] + acc[ai][bj][m2 + mm][n];
                            *(f32x4*)(X + ro + bj * HALF + n * 16) = v;
                            u32x2 w; w.x = cvt_pk_bf16(v.x, v.y); w.y = cvt_pk_bf16(v.z, v.w); *(u32x2*)(XB + ro + bj * HALF + n * 16) = w;
                            ssq += (v.x * v.x + v.y * v.y) + (v.z * v.z + v.w * v.w); }
                    ssq += __shfl_xor(ssq, 16); ssq += __shfl_xor(ssq, 32);
                    if (fq == 0) rowsq[(size_t)(row0 + ai * HALF + (m2 + mm) * 16) * 16 + u.pn * 4 + wc] = ssq;
                }
            }
    }
};
struct EpiBf16RowScale {
    static constexpr bool PERM = true;
    bf16* O; int ldc; const float* rowsq;
    __device__ __forceinline__ void operator()(const f32x4 (&acc)[2][2][4][2], const Unit& u, int wr, int wc, int fr, int fq) const {
        const int row0 = u.pm * BM + wr * 64 + fr, col0 = u.pn * BM + wc * 32 + 8 * fq;
#pragma unroll
        for (int ai = 0; ai < 2; ++ai) {
            float rs[4];
#pragma unroll
            for (int m = 0; m < 4; ++m) { const f32x4* p = (const f32x4*)(rowsq + (size_t)(row0 + ai * HALF + m * 16) * 16); const f32x4 a = p[0], b = p[1], c = p[2], d = p[3];
                rs[m] = rsqrtf((((a.x + a.y) + (a.z + a.w)) + ((b.x + b.y) + (b.z + b.w)) + (((c.x + c.y) + (c.z + c.w)) + ((d.x + d.y) + (d.z + d.w)))) * (1.f / 1024.f) + EPS); }
#pragma unroll
            for (int m = 0; m < 4; ++m) { bf16* rowp = O + (size_t)(row0 + ai * HALF + m * 16) * ldc + col0;
#pragma unroll
                for (int bj = 0; bj < 2; ++bj) { const f32x4 v0 = acc[ai][bj][m][0] * rs[m], v1 = acc[ai][bj][m][1] * rs[m];
                    u32x4 w; w.x = cvt_pk_bf16(v0[0], v0[1]); w.y = cvt_pk_bf16(v0[2], v0[3]); w.z = cvt_pk_bf16(v1[0], v1[1]); w.w = cvt_pk_bf16(v1[2], v1[3]);
                    *(u32x4*)(rowp + bj * HALF) = w; } }
        }
    }
};
struct EpiSwiglu {
    static constexpr bool PERM = true;
    bf16* H; int ldc;
    __device__ __forceinline__ void operator()(const f32x4 (&acc)[2][2][4][2], const Unit& u, int wr, int wc, int fr, int fq) const {
        const int row0 = u.pm * BM + wr * 64 + fr, col0 = u.pn * HALF + wc * 32 + 8 * fq;
#pragma unroll
        for (int ai = 0; ai < 2; ++ai)
#pragma unroll
            for (int m = 0; m < 4; ++m) {
                float o[8];
#pragma unroll
                for (int n = 0; n < 2; ++n)
#pragma unroll
                    for (int q = 0; q < 4; ++q) { const float g = acc[ai][0][m][n][q]; o[4 * n + q] = g * sigmoidf_(g) * acc[ai][1][m][n][q]; }
                u32x4 w; w.x = cvt_pk_bf16(o[0], o[1]); w.y = cvt_pk_bf16(o[2], o[3]); w.z = cvt_pk_bf16(o[4], o[5]); w.w = cvt_pk_bf16(o[6], o[7]);
                *(u32x4*)(H + (size_t)(row0 + ai * HALF + m * 16) * ldc + col0) = w; }
    }
};
}

__device__ __forceinline__ int hyb_colmap(int n) {
    if (n < 1280) return n;
    if (n < 1536) return 1304 + (n - 1280);
    if (n < 1792) return 1560 + (n - 1536);
    if (n < 2304) return 1816 + (n - 1792);
    if (n < 2816) return 2344 + (n - 2304);
    if (n < 2840) return 1280 + (n - 2816);
    if (n < 2856) return 2328 + (n - 2840);
    return -1;
}
__device__ __forceinline__ void tr_item(const float* __restrict__ W, int Nsrc, int K, bf16* __restrict__ Wt, const float* __restrict__ gain, int kind, int nblk, LAS float* scr, int item, int lane) {
    const int kb = item / nblk, nb = item % nblk, k0 = 64 * kb, n0 = 64 * nb;
    const int ksub = lane >> 4, n4 = lane & 15, n = n0 + 4 * n4;
    int col;
    if (kind == 0) col = n; else if (kind == 1) col = hyb_colmap(n); else { const int pn = n >> 8, r = n & 255; col = (r >> 7) * 384 + pn * 128 + (r & 127); }
    f32x4 v[16];
#pragma unroll
    for (int i = 0; i < 16; ++i) v[i] = col >= 0 ? *(const f32x4*)(W + (size_t)(k0 + 4 * i + ksub) * Nsrc + col) : (f32x4){0.f, 0.f, 0.f, 0.f};
    if (gain) {
#pragma unroll
        for (int i = 0; i < 16; ++i) v[i] = v[i] * gain[k0 + 4 * i + ksub];
    }
#pragma unroll
    for (int i = 0; i < 16; ++i) { LAS float* d = scr + (4 * i + ksub) * 65 + 4 * n4; d[0] = v[i].x; d[1] = v[i].y; d[2] = v[i].z; d[3] = v[i].w; }
    LDS_WAIT();
    const int c = lane & 7;
#pragma unroll
    for (int jx = 0; jx < 8; ++jx) {
        const int nn = (lane >> 3) + 8 * jx; const LAS float* s = scr + (8 * c) * 65 + nn;
        u32x4 o; o.x = pk2(s[0 * 65], s[1 * 65]); o.y = pk2(s[2 * 65], s[3 * 65]); o.z = pk2(s[4 * 65], s[5 * 65]); o.w = pk2(s[6 * 65], s[7 * 65]);
        *(u32x4*)(Wt + (size_t)(n0 + nn) * K + k0 + 8 * c) = o;
    }
    LDS_WAIT();
}
__device__ __forceinline__ void rms_row_to_bf16(const float* __restrict__ xrow, bf16* __restrict__ orow, float* __restrict__ copy, int lane) {
    const f32x4* xr = (const f32x4*)xrow + lane;
    f32x4 v[4]; float s = 0.f;
#pragma unroll
    for (int j = 0; j < 4; ++j) { v[j] = xr[64 * j]; s += (v[j].x * v[j].x + v[j].y * v[j].y) + (v[j].z * v[j].z + v[j].w * v[j].w); }
    const float rstd = rsqrtf(wave_sum(s) * (1.f / 1024.f) + EPS);
    u32x2* o8 = (u32x2*)orow + lane;
#pragma unroll
    for (int j = 0; j < 4; ++j) { u32x2 w; w.x = pk2(v[j].x * rstd, v[j].y * rstd); w.y = pk2(v[j].z * rstd, v[j].w * rstd); o8[64 * j] = w; }
    if (copy) { f32x4* c4 = (f32x4*)copy + lane;
#pragma unroll
        for (int j = 0; j < 4; ++j) c4[64 * j] = v[j]; }
}

__device__ __forceinline__ void phase_prologue(KArgs A, int wv_, LAS unsigned char* lds) {
    const int tid = opaque_tid(wv_), wid = __builtin_amdgcn_readfirstlane(tid >> 6), lane = tid & 63;
    const int gw = blockIdx.x * 8 + wid, NGW = gridDim.x * 8;
    LAS float* scr = (LAS float*)(lds + wid * 16640);
    unsigned char* ws = opq(A->ws);
    constexpr int N_HYB = 2 * 768, N_HOUT = 2 * 256, N_SGIN = 2 * 1024, N_SGOUT = 2 * 512, N_WQ = 4 * 256, N_WKV = 4 * 512, N_WO = 4 * 256, N_MIN = 64 * 192, N_MOUT = 64 * 96, N_W1T = 4 * 32;
    constexpr int NITEMS = N_HYB + N_HOUT + N_SGIN + N_SGOUT + N_WQ + N_WKV + N_WO + N_MIN + N_MOUT + N_W1T;
    for (int it = gw; it < NITEMS; it += NGW) {
        int r = it;
        if (r < N_HYB) { const int sl = r / 768; tr_item(A->in[I_HYBIN] + (size_t)sl * 1024 * HYSRC, HYSRC, 1024, (bf16*)(ws + WS_WHYB) + (size_t)sl * HYN * 1024, A->in[I_NMIX] + (2 * sl) * 1024, 1, 48, scr, r % 768, lane); continue; } r -= N_HYB;
        if (r < N_HOUT) { const int sl = r / 256; tr_item(A->in[I_HYBOUT] + (size_t)sl * 1024 * 1024, 1024, 1024, (bf16*)(ws + WS_WHOUT) + (size_t)sl * 1024 * 1024, nullptr, 0, 16, scr, r % 256, lane); continue; } r -= N_HOUT;
        if (r < N_SGIN) { const int sl = r / 1024; tr_item(A->in[I_SGIN] + (size_t)sl * 1024 * 4096, 4096, 1024, (bf16*)(ws + WS_WSGIN) + (size_t)sl * 4096 * 1024, A->in[I_NMIX] + (2 * sl + 1) * 1024, 0, 64, scr, r % 1024, lane); continue; } r -= N_SGIN;
        if (r < N_SGOUT) { const int sl = r / 512; tr_item(A->in[I_SGOUT] + (size_t)sl * 2048 * 1024, 1024, 2048, (bf16*)(ws + WS_WSGOUT) + (size_t)sl * 1024 * 2048, nullptr, 0, 16, scr, r % 512, lane); continue; } r -= N_SGOUT;
        if (r < N_WQ) { const int sl = r / 256; tr_item(A->in[I_XWQ] + (size_t)sl * 1024 * 1024, 1024, 1024, (bf16*)(ws + WS_WQ) + (size_t)sl * 1024 * 1024, A->in[I_NXAT] + sl * 1024, 0, 16, scr, r % 256, lane); continue; } r -= N_WQ;
        if (r < N_WKV) { const int sl = r / 512; tr_item(A->in[I_XWKV] + (size_t)sl * 1024 * 2048, 2048, 1024, (bf16*)(ws + WS_WKV) + (size_t)sl * 2048 * 1024, A->in[I_NMEM] + sl * 1024, 0, 32, scr, r % 512, lane); continue; } r -= N_WKV;
        if (r < N_WO) { const int sl = r / 256; tr_item(A->in[I_XWO] + (size_t)sl * 1024 * 1024, 1024, 1024, (bf16*)(ws + WS_WO) + (size_t)sl * 1024 * 1024, nullptr, 0, 16, scr, r % 256, lane); continue; } r -= N_WO;
        if (r < N_MIN) { const int sl = r / 192; tr_item(A->in[I_MOEIN] + (size_t)sl * 1024 * 768, 768, 1024, (bf16*)(ws + WS_WMIN) + (size_t)sl * 768 * 1024, A->in[I_NFFN] + (sl >> 4) * 1024, 2, 12, scr, r % 192, lane); continue; } r -= N_MIN;
        if (r < N_MOUT) { const int sl = r / 96; tr_item(A->in[I_MOEOUT] + (size_t)sl * 384 * 1024, 1024, 384, (bf16*)(ws + WS_WMOUT) + (size_t)sl * 1024 * 384, nullptr, 0, 16, scr, r % 96, lane); continue; } r -= N_MOUT;
        { const int sl = r / 32; tr_item(A->in[I_CMPW1] + (size_t)sl * 2048 * 64, 64, 2048, (bf16*)(ws + WS_W1T) + (size_t)sl * 64 * 2048, nullptr, 0, 1, scr, r % 32, lane); }
    }
    for (int m = gw; m < T; m += NGW) rms_row_to_bf16(A->in[I_X] + (size_t)m * D, (bf16*)(ws + WS_XN) + (size_t)m * D, A->out + (size_t)m * D, lane);
    for (int m = gw; m < NBATCH * NMEM; m += NGW) rms_row_to_bf16(A->in[I_MEM] + (size_t)m * D, (bf16*)(ws + WS_MN) + (size_t)m * D, nullptr, lane);
    const int gt = blockIdx.x * 512 + tid, NGT = gridDim.x * 512;
    const int* pos = (const int*)A->in[I_POS];
    float* cosT = (float*)(ws + WS_COS); float* sinT = (float*)(ws + WS_SIN);
    for (int i = gt; i < T * 32; i += NGT) {
        const int t = i >> 5, j = i & 31;
        const float ang = (float)pos[t] * A->freq[j];
        const double rev = (double)ang * 0.15915494309189533577;
        const float fr = (float)(rev - rint(rev));
        cosT[i] = __builtin_amdgcn_cosf(fr); sinT[i] = __builtin_amdgcn_sinf(fr);
    }
    { bf16* WSB = (bf16*)(ws + WS_WSB); float* M0 = (float*)(ws + WS_M0); const float* wsg = A->in[I_SGWS];
      for (int e = gt; e < 2 * 8 * 128 * 128; e += NGT) { const int s = e & 127, t = (e >> 7) & 127; WSB[e] = (bf16)f2bf(s <= t ? wsg[e] : 0.f); }
      for (int e = gt; e < 2 * 8 * 128; e += NGT) { const int t = e & 127; const float* r = wsg + (size_t)e * 128; float a = 0.f; for (int s = 0; s <= t; ++s) a += r[s]; M0[e] = a; } }
    float* RW = (float*)(ws + WS_RW);
    for (int i = gt; i < DEPTH * NEXP * D; i += NGT) { const int k = i & 1023, e = (i >> 10) & 15, l = i >> 14; RW[i] = A->in[I_RW][k * NEXP + e] * A->in[I_NFFN][l * D + k]; }
}

__device__ __forceinline__ void phase_knorm(KArgs A, int wv_, const int gw, const int NGW) {
    const int tid_ = opaque_tid(wv_); const int lane = tid_ & 63;
    bf16* KV = (bf16*)(opq(A->ws) + WS_KV);
    for (int it0 = gw * 4; it0 < DEPTH * 2048 * 4; it0 += NGW * 4) {
        u32x2 w[4];
#pragma unroll
        for (int q = 0; q < 4; ++q) { const int it = it0 + q; const int h = it & 3, m = (it >> 2) & 2047, l = it >> 13; w[q] = *(const u32x2*)(KV + (size_t)m * 8192 + l * 2048 + h * 256 + 4 * lane); }
#pragma unroll
        for (int q = 0; q < 4; ++q) {
            const int it = it0 + q; const int h = it & 3, m = (it >> 2) & 2047, l = it >> 13;
            const float x0 = bflo(w[q].x), x1 = bfhi(w[q].x), x2 = bflo(w[q].y), x3 = bfhi(w[q].y);
            const float rstd = rsqrtf(wave_sum(x0 * x0 + x1 * x1 + x2 * x2 + x3 * x3) * (1.f / 256.f) + EPS) * 0.0625f;
            const f32x4 g = *(const f32x4*)(A->in[I_XKN] + l * 256 + 4 * lane) * *(const f32x4*)(A->in[I_XQN] + l * 256 + 4 * lane);
            u32x2 o; o.x = pk2(x0 * rstd * g.x, x1 * rstd * g.y); o.y = pk2(x2 * rstd * g.z, x3 * rstd * g.w);
            *(u32x2*)(KV + (size_t)m * 8192 + l * 2048 + h * 256 + 4 * lane) = o;
        }
    }
}

__device__ __forceinline__ int kpos64(int tok) { const int k = tok & 31; return (tok & 32) + 8 * ((k >> 2) & 3) + 4 * (k >> 4) + (k & 3); }
__device__ __forceinline__ int kperm64(int p) { const int fq = (p >> 3) & 3, j = p & 7; return (p & 32) + 16 * (j >> 2) + 4 * fq + (j & 3); }

__device__ __forceinline__ void phase_nsa_prep(KArgs A, int wv_, int i, LAS unsigned char* lds) {
    const int tid_ = opaque_tid(wv_); const int wid = __builtin_amdgcn_readfirstlane(tid_ >> 6), lane = tid_ & 63; const int gw = blockIdx.x * 8 + wid, NGW = gridDim.x * 8;
    unsigned char* ws = opq(A->ws);
    const bf16* HY = (const bf16*)(ws + WS_BIG);
    const float* cosT = (const float*)(ws + WS_COS); const float* sinT = (const float*)(ws + WS_SIN);
    bf16* QA = (bf16*)(ws + WS_QA); bf16* KS = (bf16*)(ws + WS_KS); bf16* KW = (bf16*)(ws + WS_KW);
    (void)lds;
    const int j8 = lane & 7, ug = lane >> 3;
    const int u1 = 8 + (ug & 3);
    const int src0 = C_QA + 64 * ug, src1 = u1 < 10 ? C_KS + 64 * (u1 - 8) : C_KW + 64 * (u1 - 10);
    const float* g0p = A->in[I_QNORM] + i * 64 + 8 * j8; const float* g1p = A->in[I_KNORM] + (i * 3 + (u1 < 10 ? 1 : 2)) * 64 + 8 * j8;
    const f32x4 g0a = *(const f32x4*)g0p, g0b = *(const f32x4*)(g0p + 4), g1a = *(const f32x4*)g1p, g1b = *(const f32x4*)(g1p + 4);
    u32x4 w0 = (u32x4){0u, 0u, 0u, 0u}, w1 = w0; f32x4 ca, cb, sa, sb;
    if (gw < T) { w0 = *(const u32x4*)(HY + (size_t)gw * HYN + src0 + 8 * j8); w1 = *(const u32x4*)(HY + (size_t)gw * HYN + src1 + 8 * j8);
        const float* cp = cosT + gw * 32 + 8 * (j8 & 3); const float* sp = sinT + gw * 32 + 8 * (j8 & 3); ca = *(const f32x4*)cp; cb = *(const f32x4*)(cp + 4); sa = *(const f32x4*)sp; sb = *(const f32x4*)(sp + 4); }
    for (int t = gw; t < T; t += NGW) {
        const int tn = t + NGW < T ? t + NGW : t;
        const u32x4 n0 = *(const u32x4*)(HY + (size_t)tn * HYN + src0 + 8 * j8), n1 = *(const u32x4*)(HY + (size_t)tn * HYN + src1 + 8 * j8);
        const float* cp = cosT + tn * 32 + 8 * (j8 & 3); const float* sp = sinT + tn * 32 + 8 * (j8 & 3);
        const f32x4 nca = *(const f32x4*)cp, ncb = *(const f32x4*)(cp + 4), nsa = *(const f32x4*)sp, nsb = *(const f32x4*)(sp + 4);
#pragma unroll
        for (int pass = 0; pass < 2; ++pass) {
            const u32x4 w = pass ? w1 : w0; const f32x4 ga = pass ? g1a : g0a, gb = pass ? g1b : g0b;
            float x[8] = {bflo(w.x), bfhi(w.x), bflo(w.y), bfhi(w.y), bflo(w.z), bfhi(w.z), bflo(w.w), bfhi(w.w)};
            float ssq = 0.f;
#pragma unroll
            for (int q = 0; q < 8; ++q) ssq += x[q] * x[q];
            ssq += __shfl_xor(ssq, 1); ssq += __shfl_xor(ssq, 2); ssq += __shfl_xor(ssq, 4);
            const float rs = rsqrtf(ssq * (1.f / 64.f) + EPS) * (pass ? 1.f : 0.125f * 1.4426950408889634f);
            const float gg[8] = {ga.x, ga.y, ga.z, ga.w, gb.x, gb.y, gb.z, gb.w}, cc[8] = {ca.x, ca.y, ca.z, ca.w, cb.x, cb.y, cb.z, cb.w}, ss[8] = {sa.x, sa.y, sa.z, sa.w, sb.x, sb.y, sb.z, sb.w};
            float o[8];
#pragma unroll
            for (int q = 0; q < 8; ++q) { const float y = x[q] * rs * gg[q]; const float pr = __shfl_xor(y, 4);
                o[q] = j8 < 4 ? y * cc[q] - pr * ss[q] : y * cc[q] + pr * ss[q]; }
            u32x4 ow; ow.x = pk2(o[0], o[1]); ow.y = pk2(o[2], o[3]); ow.z = pk2(o[4], o[5]); ow.w = pk2(o[6], o[7]);
            if (pass == 0) *(u32x4*)(QA + (size_t)t * 512 + 64 * ug + 8 * j8) = ow;
            else if (lane < 32) { bf16* dst = (u1 < 10 ? KS + (size_t)t * 128 + 64 * (u1 - 8) : KW + (size_t)t * 128 + 64 * (u1 - 10)); *(u32x4*)(dst + 8 * j8) = ow; }
        }
        w0 = n0; w1 = n1; ca = nca; cb = ncb; sa = nsa; sb = nsb;
    }
}

__device__ __forceinline__ void phase_compress_mfma(KArgs A, int wv_, int i, LAS unsigned char* lds) {
    const int tid = opaque_tid(wv_), wid = __builtin_amdgcn_readfirstlane(tid >> 6), lane = tid & 63, fr = lane & 15, fq = lane >> 4;
    unsigned char* ws = opq(A->ws);
    const bf16* HY = (const bf16*)(ws + WS_BIG);
    const float* cosT = (const float*)(ws + WS_COS); const float* sinT = (const float*)(ws + WS_SIN);
    LAS float* part = (LAS float*)lds;
    LAS float* hbuf = part + 8 * 1024;
    LAS float* obuf = hbuf + 1024;
    LAS float* w2l = obuf + 1024;
    int w2kv = -1;
    for (int it = blockIdx.x; it < 2 * 127; it += gridDim.x) {
        const int kv = it / 127, tile = it % 127;
        const float* pe = A->in[I_CMPPE] + (size_t)(i * 2 + kv) * 32 * 64;
        const float* w2 = A->in[I_CMPW2] + (size_t)(i * 2 + kv) * 64 * 64;
        const bf16* w1t = (const bf16*)(ws + WS_W1T) + (size_t)(i * 2 + kv) * 64 * 2048;
        const int coff = kv ? C_VC : C_KC;
        if (kv != w2kv) { __syncthreads(); for (int e4 = tid; e4 < 1024; e4 += 512) *(LAS f32x4*)(w2l + 4 * e4) = *(const f32x4*)(w2 + 4 * e4); w2kv = kv; }
        {
            const int R = tile * 16 + fr, g = R & 1, bn = R >> 1, n = bn % NCMP, b = bn / NCMP;
            const bf16* arow = HY + (size_t)(b * S + 16 * n) * HYN + coff + g * 64;
            f32x4 acc[4];
#pragma unroll
            for (int t = 0; t < 4; ++t) acc[t] = (f32x4){0.f, 0.f, 0.f, 0.f};
#pragma unroll 4
            for (int s = 0; s < 8; ++s) {
                const int k0 = 256 * wid + 32 * s, l = k0 >> 6, d0 = (k0 & 63) + 8 * fq;
                const u32x4 hw = *(const u32x4*)(arow + (size_t)l * HYN + d0);
                const f32x4 p0 = *(const f32x4*)(pe + l * 64 + d0), p1 = *(const f32x4*)(pe + l * 64 + d0 + 4);
                u32x4 aw; aw.x = pk2(bflo(hw.x) + p0.x, bfhi(hw.x) + p0.y); aw.y = pk2(bflo(hw.y) + p0.z, bfhi(hw.y) + p0.w); aw.z = pk2(bflo(hw.z) + p1.x, bfhi(hw.z) + p1.y); aw.w = pk2(bflo(hw.w) + p1.z, bfhi(hw.w) + p1.w);
                const bf16x8 af = __builtin_bit_cast(bf16x8, aw);
#pragma unroll
                for (int t = 0; t < 4; ++t) { const bf16x8 bfr = *(const bf16x8*)(w1t + (size_t)(16 * t + fr) * 2048 + k0 + 8 * fq);
                    acc[t] = __builtin_amdgcn_mfma_f32_16x16x32_bf16(af, bfr, acc[t], 0, 0, 0); }
            }
            __syncthreads();
#pragma unroll
            for (int t = 0; t < 4; ++t)
#pragma unroll
                for (int r = 0; r < 4; ++r) part[wid * 1024 + (4 * fq + r) * 64 + 16 * t + fr] = acc[t][r];
        }
        __syncthreads();
        for (int e = tid; e < 1024; e += 512) { float a = 0.f;
#pragma unroll
            for (int w = 0; w < 8; ++w) a += part[w * 1024 + e];
            hbuf[e] = gelu_tanh(a); }
        __syncthreads();
        for (int e = tid; e < 1024; e += 512) { const int r = e >> 6, j = e & 63; float o = 0.f;
#pragma unroll 8
            for (int m = 0; m < 64; ++m) o += hbuf[r * 64 + m] * w2l[m * 64 + j];
            obuf[e] = o; }
        __syncthreads();
        for (int r = wid; r < 16; r += 8) {
            const int R = tile * 16 + r, g = R & 1, bn = R >> 1, n = bn % NCMP, b = bn / NCMP;
            const float o = obuf[r * 64 + lane];
            if (kv == 0) {
                const float y = o * rsqrtf(wave_sum(o * o) * (1.f / 64.f) + EPS) * A->in[I_KNORM][(i * 3 + 0) * 64 + lane];
                const int tp = b * S + 16 * n + 31;
                const float c = cosT[tp * 32 + (lane & 31)], sn = sinT[tp * 32 + (lane & 31)];
                const float pr = __shfl_xor(y, 32);
                const float oo = lane < 32 ? y * c - pr * sn : y * c + pr * sn;
                ((bf16*)(ws + WS_KC))[((size_t)(b * 128 + n) * 2 + g) * 64 + lane] = (bf16)f2bf(oo);
            } else {
                bf16* vct = (bf16*)(ws + WS_VC) + ((size_t)(b * 2 + g) * 64 + lane) * 128;
                vct[(n & 64) + kpos64(n & 63)] = (bf16)f2bf(o);
                if (n == 126) vct[127] = 0;
            }
        }
    }
    __syncthreads();
}

__device__ __forceinline__ void nsa_block(const LAS float* qs, const bf16* __restrict__ krow, bool ok, const bf16* __restrict__ vbase, int vstride, int lane,
                                          float (&m)[4], float (&l)[4], float (&o)[4]) {
    float s[4] = {0.f, 0.f, 0.f, 0.f};
#pragma unroll 2
    for (int c = 0; c < 8; ++c) {
        const u32x4 kw = *(const u32x4*)(krow + 8 * c);
        const float k0 = bflo(kw.x), k1 = bfhi(kw.x), k2 = bflo(kw.y), k3 = bfhi(kw.y), k4 = bflo(kw.z), k5 = bfhi(kw.z), k6 = bflo(kw.w), k7 = bfhi(kw.w);
#pragma unroll
        for (int hh = 0; hh < 4; ++hh) {
            const f32x4 qa = *(const LAS f32x4*)(qs + hh * 64 + 8 * c), qb = *(const LAS f32x4*)(qs + hh * 64 + 8 * c + 4);
            s[hh] += (qa.x * k0 + qa.y * k1) + (qa.z * k2 + qa.w * k3) + (qb.x * k4 + qb.y * k5) + (qb.z * k6 + qb.w * k7);
        }
    }
    float p[4];
#pragma unroll
    for (int hh = 0; hh < 4; ++hh) {
        const float sv = ok ? s[hh] : -INFINITY;
        const float bm = wave_max(sv);
        const float mn = fmaxf(m[hh], bm);
        if (mn == -INFINITY) { p[hh] = 0.f; continue; }
        const float alpha = __expf(m[hh] - mn);
        p[hh] = ok ? __expf(sv - mn) : 0.f;
        l[hh] = l[hh] * alpha + wave_sum(p[hh]);
        o[hh] *= alpha; m[hh] = mn;
    }
#pragma unroll 8
    for (int kk = 0; kk < 64; ++kk) {
        const float v = bf2f(vbase[(size_t)kk * vstride + lane]);
#pragma unroll
        for (int hh = 0; hh < 4; ++hh) o[hh] += __shfl(p[hh], kk) * v;
    }
}
__device__ __forceinline__ void phase_nsa_attn(KArgs A, int wv_, int i, LAS unsigned char* lds) {
    const int tid_ = opaque_tid(wv_); const int wid = __builtin_amdgcn_readfirstlane(tid_ >> 6), lane0 = tid_ & 63; const int gw = blockIdx.x * 8 + wid, NGW = gridDim.x * 8;
    unsigned char* ws = opq(A->ws);
    const bf16* HY = (const bf16*)(ws + WS_BIG); const bf16* QA = (const bf16*)(ws + WS_QA); const bf16* KS = (const bf16*)(ws + WS_KS); const bf16* KW = (const bf16*)(ws + WS_KW);
    const bf16* KC = (const bf16*)(ws + WS_KC); const bf16* VC = (const bf16*)(ws + WS_VC); bf16* CAT = (bf16*)(ws + WS_CAT);
    LAS float* qs = (LAS float*)(lds + wid * 2048);
    LAS float* ps = qs + 256;
    for (int it = gw; it < 2 * T; it += NGW) {
        int lane = lane0; asm volatile("" : "+v"(lane));
        const int tok = it >> 1, g = it & 1, b = tok >> 11, t = tok & 2047;
#pragma unroll
        for (int hh = 0; hh < 4; ++hh) qs[hh * 64 + lane] = bf2f(QA[(size_t)tok * 512 + (g * 4 + hh) * 64 + lane]);
        LDS_WAIT();
        const int ncv = t >= 31 ? ((t - 31) >> 4) + 1 : 0;
        float oc[4] = {0.f, 0.f, 0.f, 0.f};
        float psum0 = 0.f, psum1 = 0.f;
        {
            const bool v0 = lane < ncv, v1 = lane + 64 < ncv;
            const bf16* k0p = KC + ((size_t)(b * 128 + lane) * 2 + g) * 64;
            const bf16* k1p = KC + ((size_t)(b * 128 + (lane + 64 < 127 ? lane + 64 : 126)) * 2 + g) * 64;
            float s0[4] = {0.f, 0.f, 0.f, 0.f}, s1[4] = {0.f, 0.f, 0.f, 0.f};
#pragma unroll 2
            for (int c = 0; c < 8; ++c) {
                const u32x4 ka = *(const u32x4*)(k0p + 8 * c), kb = *(const u32x4*)(k1p + 8 * c);
#pragma unroll
                for (int hh = 0; hh < 4; ++hh) {
                    const f32x4 qa = *(const LAS f32x4*)(qs + hh * 64 + 8 * c), qb = *(const LAS f32x4*)(qs + hh * 64 + 8 * c + 4);
                    s0[hh] += (qa.x * bflo(ka.x) + qa.y * bfhi(ka.x)) + (qa.z * bflo(ka.y) + qa.w * bfhi(ka.y)) + (qb.x * bflo(ka.z) + qb.y * bfhi(ka.z)) + (qb.z * bflo(ka.w) + qb.w * bfhi(ka.w));
                    s1[hh] += (qa.x * bflo(kb.x) + qa.y * bfhi(kb.x)) + (qa.z * bflo(kb.y) + qa.w * bfhi(kb.y)) + (qb.x * bflo(kb.z) + qb.y * bfhi(kb.z)) + (qb.z * bflo(kb.w) + qb.w * bfhi(kb.w));
                }
            }
            float p0[4], p1[4];
#pragma unroll
            for (int hh = 0; hh < 4; ++hh) {
                const float a0 = v0 ? s0[hh] : -INFINITY, a1 = v1 ? s1[hh] : -INFINITY;
                const float mx = wave_max(fmaxf(a0, a1));
                if (ncv > 0) {
                    const float e0 = v0 ? __expf(a0 - mx) : 0.f, e1 = v1 ? __expf(a1 - mx) : 0.f;
                    const float inv = 1.0f / wave_sum(e0 + e1);
                    p0[hh] = e0 * inv; p1[hh] = e1 * inv;
                } else { p0[hh] = 0.f; p1[hh] = 0.f; }
                psum0 += p0[hh]; psum1 += p1[hh];
            }
#pragma unroll 2
            for (int c = 0; c < ncv; ++c) {
                const float v = bf2f(VC[((size_t)(b * 128 + c) * 2 + g) * 64 + lane]);
#pragma unroll
                for (int hh = 0; hh < 4; ++hh) oc[hh] += __shfl(c < 64 ? p0[hh] : p1[hh], c & 63) * v;
            }
        }
        ps[lane] = psum0; ps[64 + lane] = psum1;
        LDS_WAIT();
        const int cur = t >> 6;
        unsigned selmask;
        {
            const int j = lane & 31;
            float imp = ps[4 * j] + ps[4 * j + 1] + ps[4 * j + 2] + 0.5f * ps[4 * j + 3] + (j > 0 ? 0.5f * ps[4 * j - 1] : 0.f);
            const bool valid = j <= cur, forced = (j == 0) || (j == cur) || (j == cur - 1);
            const float score = valid ? imp + (forced ? 1000.0f : 0.f) : -INFINITY;
            int rank = 0;
#pragma unroll 8
            for (int jj = 0; jj < 32; ++jj) { const float sj = __shfl(score, jj); rank += (sj > score || (sj == score && jj < j)) ? 1 : 0; }
            const bool sel = valid && rank < 8 && lane < 32;
            selmask = (unsigned)__ballot(sel);
        }
        LDS_WAIT();
        float o1[4] = {0.f, 0.f, 0.f, 0.f}, o2[4] = {0.f, 0.f, 0.f, 0.f};
#pragma unroll 1
        for (int pass = 0; pass < 2; ++pass) {
            float oa[4] = {0.f, 0.f, 0.f, 0.f}, ma[4] = {-INFINITY, -INFINITY, -INFINITY, -INFINITY}, la[4] = {0.f, 0.f, 0.f, 0.f};
            const int lo = pass ? (t - 255 > 0 ? t - 255 : 0) : 0;
            const unsigned bm = pass ? 0xffffffffu : selmask;
            const bf16* Kb = pass ? KW : KS; const int vc = pass ? C_VW : C_VS;
#pragma unroll 1
            for (int j = lo >> 6; j <= cur; ++j) {
                if (!((bm >> j) & 1u)) continue;
                const int key = 64 * j + lane; const size_t kt = (size_t)(b * S + key);
                nsa_block(qs, Kb + kt * 128 + g * 64, key <= t && key >= lo, HY + (size_t)(b * S + 64 * j) * HYN + vc + g * 64, HYN, lane, ma, la, oa);
            }
            if (pass == 0) {
#pragma unroll
                for (int hh = 0; hh < 4; ++hh) o1[hh] = oa[hh] / la[hh];
            } else {
#pragma unroll
                for (int hh = 0; hh < 4; ++hh) o2[hh] = oa[hh] / la[hh];
            }
        }
#pragma unroll
        for (int hh = 0; hh < 4; ++hh) {
            const int head = g * 4 + hh;
            const float* gb = A->in[I_GATEB] + i * 24 + head * 3;
            const bf16* gl = HY + (size_t)tok * HYN + C_GA + head * 3;
            const float g0 = sigmoidf_(bf2f(gl[0]) + gb[0]), g1 = sigmoidf_(bf2f(gl[1]) + gb[1]), g2 = sigmoidf_(bf2f(gl[2]) + gb[2]);
            const float o = g0 * oc[hh] + g1 * o1[hh] + g2 * o2[hh];
            CAT[(size_t)tok * 1024 + head * 64 + lane] = (bf16)f2bf(o);
        }
    }
}

__device__ __forceinline__ void phase_gla_seq(KArgs A, int wv_, int i, LAS unsigned char* lds) {
    const int tid = opaque_tid(wv_), wid = __builtin_amdgcn_readfirstlane(tid >> 6), lane = tid & 63;
    unsigned char* ws = opq(A->ws);
    const bf16* HY = (const bf16*)(ws + WS_BIG); bf16* CAT = (bf16*)(ws + WS_CAT);
    constexpr int CH = 16;
    LAS float* la = (LAS float*)lds;
    LAS float* lk = la + 4 * CH * 64;
    LAS float* lq = lk + 4 * CH * 64;
    LAS float* lo = lq + 4 * CH * 64;
    const float* wa2 = A->in[I_WA2] + i * 16 * 256; const float* ba = A->in[I_BA] + i * 256; const float* og = A->in[I_ONORM] + i * 128;
    for (int it = blockIdx.x; it < 8; it += gridDim.x) {
        const int pl = tid >> 7, v = tid & 127, p = it * 4 + pl, b = p >> 2, h = p & 3;
        float St[64];
#pragma unroll
        for (int k = 0; k < 64; ++k) St[k] = 0.f;
        for (int c0 = 0; c0 < S; c0 += CH) {
            __syncthreads();
            for (int e = tid; e < 4 * CH * 64; e += 512) {
                const int kk = e & 63, tk = (e >> 6) % CH, pp = e / (64 * CH); const int pb = (it * 4 + pp) >> 2, ph = (it * 4 + pp) & 3;
                const size_t tok = (size_t)pb * S + c0 + tk; const bf16* row = HY + tok * HYN;
                float z = ba[ph * 64 + kk];
#pragma unroll
                for (int r = 0; r < 16; ++r) z += bf2f(row[C_AL + r]) * wa2[r * 256 + ph * 64 + kk];
                const float ls_ = fminf(z, 0.f) - log1pf(__expf(-fabsf(z)));
                la[e] = __expf(ls_ * (1.f / 16.f));
                lk[e] = bf2f(row[C_KB + ph * 64 + kk]);
                lq[e] = bf2f(row[C_QB + ph * 64 + kk]) * 0.125f;
            }
            __syncthreads();
            for (int tk = 0; tk < CH; ++tk) {
                const size_t tok = (size_t)b * S + c0 + tk;
                const float vv = bf2f(HY[tok * HYN + C_VB + h * 128 + v]);
                const LAS float* pa = la + (pl * CH + tk) * 64; const LAS float* pk = lk + (pl * CH + tk) * 64; const LAS float* pq = lq + (pl * CH + tk) * 64;
                float o = 0.f;
#pragma unroll
                for (int k4 = 0; k4 < 16; ++k4) {
                    const f32x4 a4 = *(const LAS f32x4*)(pa + 4 * k4), k4v = *(const LAS f32x4*)(pk + 4 * k4), q4 = *(const LAS f32x4*)(pq + 4 * k4);
                    St[4 * k4 + 0] = a4.x * St[4 * k4 + 0] + k4v.x * vv; o += q4.x * St[4 * k4 + 0];
                    St[4 * k4 + 1] = a4.y * St[4 * k4 + 1] + k4v.y * vv; o += q4.y * St[4 * k4 + 1];
                    St[4 * k4 + 2] = a4.z * St[4 * k4 + 2] + k4v.z * vv; o += q4.z * St[4 * k4 + 2];
                    St[4 * k4 + 3] = a4.w * St[4 * k4 + 3] + k4v.w * vv; o += q4.w * St[4 * k4 + 3];
                }
                lo[(pl * CH + tk) * 128 + v] = o;
            }
            __syncthreads();
            for (int r = wid; r < 4 * CH; r += 8) {
                const int pp = r / CH, tk = r % CH; const int pb = (it * 4 + pp) >> 2, ph = (it * 4 + pp) & 3;
                const size_t tok = (size_t)pb * S + c0 + tk;
                const float x0 = lo[r * 128 + lane], x1 = lo[r * 128 + 64 + lane];
                const float rstd = rsqrtf(wave_sum(x0 * x0 + x1 * x1) * (1.f / 128.f) + EPS);
                const float r0 = bf2f(HY[tok * HYN + C_RB + ph * 128 + lane]), r1 = bf2f(HY[tok * HYN + C_RB + ph * 128 + 64 + lane]);
                CAT[tok * 1024 + 512 + ph * 128 + lane] = (bf16)f2bf(x0 * rstd * og[lane] * (r0 * sigmoidf_(r0)));
                CAT[tok * 1024 + 512 + ph * 128 + 64 + lane] = (bf16)f2bf(x1 * rstd * og[64 + lane] * (r1 * sigmoidf_(r1)));
            }
        }
        __syncthreads();
    }
}


__device__ __forceinline__ void phase_nsa_attn_mfma(KArgs A, int wv_, int i, LAS unsigned char* lds) {
    const int tid = opaque_tid(wv_), wid = __builtin_amdgcn_readfirstlane(tid >> 6), lane = tid & 63, fr = lane & 15, fq = lane >> 4;
    unsigned char* ws = opq(A->ws);
    const bf16* HY = (const bf16*)(ws + WS_BIG); const bf16* QA = (const bf16*)(ws + WS_QA); const bf16* KS = (const bf16*)(ws + WS_KS); const bf16* KW = (const bf16*)(ws + WS_KW);
    const bf16* KC = (const bf16*)(ws + WS_KC); const bf16* VCT = (const bf16*)(ws + WS_VC); const bf16* VTA = (const bf16*)(ws + WS_VTA); bf16* CAT = (bf16*)(ws + WS_CAT);
    constexpr int RS = 72;
    LAS bf16* ktl = (LAS bf16*)lds;
    LAS bf16* vtl = ktl + 4 * 64 * RS;
    LAS float* scl = (LAS float*)(lds + 73728) + wid * 256;
    LAS unsigned* msk = (LAS unsigned*)(lds + 73728 + 8192);
    LAS unsigned* umask = msk + 64;
    const float* gb = A->in[I_GATEB] + i * 24;
    unsigned long long tsub = 0, tt0 = 0;
    for (int pit = blockIdx.x; pit < 256; pit += gridDim.x) {
#pragma unroll 1
        for (int hf = 0; hf < 2; ++hf) {
            const int bg = pit >> 4, xx = pit & 15, x = hf ? 31 - xx : xx, b = bg >> 1, g = bg & 1;
            const size_t tokbase = (size_t)b * S + 64 * x;
            const int tl0 = 8 * wid + (fr >> 2);
            if (tid == 0) *umask = 0u;
            if (PROBE_NSA == 1) tt0 = __builtin_amdgcn_s_memrealtime();
            bf16x8 qf[2][2];
#pragma unroll
            for (int mt = 0; mt < 2; ++mt)
#pragma unroll
                for (int s = 0; s < 2; ++s) qf[mt][s] = *(const bf16x8*)(QA + (tokbase + tl0 + 4 * mt) * 512 + (g * 4 + (fr & 3)) * 64 + 32 * s + 8 * fq);
            f32x4 outacc[2][4];
            {
                const int tmaxc = (4 * x + 3 + 15) >> 4;
                const bf16* kcb = KC + ((size_t)(b * 128 + fr) * 2 + g) * 64 + 8 * fq;
                bf16x8 pcf[2][4];
#pragma unroll
                for (int mt = 0; mt < 2; ++mt) {
                    f32x4 sc[8];
                    const bf16* kp = kcb;
#pragma unroll
                    for (int t = 0; t < 8; ++t) { sc[t] = (f32x4){0.f, 0.f, 0.f, 0.f};
                        asm volatile("" : "+v"(kp));
                        if (t < tmaxc) {
                            const bf16x8 k0 = *(const bf16x8*)(kp), k1 = *(const bf16x8*)(kp + 32);
                            sc[t] = __builtin_amdgcn_mfma_f32_16x16x32_bf16(k0, qf[mt][0], sc[t], 0, 0, 0);
                            sc[t] = __builtin_amdgcn_mfma_f32_16x16x32_bf16(k1, qf[mt][1], sc[t], 0, 0, 0); }
                        kp += 16 * 128; }
                    const int tg = 64 * x + tl0 + 4 * mt; const int ncv = tg >= 31 ? ((tg - 31) >> 4) + 1 : 0;
                    float mx = -INFINITY;
#pragma unroll
                    for (int t = 0; t < 8; ++t)
#pragma unroll
                        for (int r = 0; r < 4; ++r) { const bool v = 16 * t + 4 * fq + r < ncv; sc[t][r] = v ? sc[t][r] : -INFINITY; mx = fmaxf(mx, sc[t][r]); }
                    mx = fmaxf(mx, __shfl_xor(mx, 16)); mx = fmaxf(mx, __shfl_xor(mx, 32));
                    const float mxs = mx == -INFINITY ? 0.f : mx;
                    float sum = 0.f;
#pragma unroll
                    for (int t = 0; t < 8; ++t)
#pragma unroll
                        for (int r = 0; r < 4; ++r) { sc[t][r] = __builtin_amdgcn_exp2f(sc[t][r] - mxs); sum += sc[t][r]; }
                    sum += __shfl_xor(sum, 16); sum += __shfl_xor(sum, 32);
                    const float inv = sum > 0.f ? 1.f / sum : 0.f;
#pragma unroll
                    for (int t = 0; t < 8; ++t) sc[t] = sc[t] * inv;
#pragma unroll
                    for (int s = 0; s < 4; ++s) { u32x4 w; w.x = pk2(sc[2 * s].x, sc[2 * s].y); w.y = pk2(sc[2 * s].z, sc[2 * s].w); w.z = pk2(sc[2 * s + 1].x, sc[2 * s + 1].y); w.w = pk2(sc[2 * s + 1].z, sc[2 * s + 1].w);
                        pcf[mt][s] = __builtin_bit_cast(bf16x8, w); }
                    float w3[8];
#pragma unroll
                    for (int t = 0; t < 8; ++t) {
#pragma unroll
                        for (int r = 0; r < 4; ++r) { float v = sc[t][r]; v += __shfl_xor(v, 1); v += __shfl_xor(v, 2); sc[t][r] = v; }
                        w3[t] = __shfl(sc[t].w, (lane + 48) & 63);
                    }
#pragma unroll
                    for (int t = 0; t < 8; ++t) {
                        const float prev = fq > 0 ? w3[t] : (t > 0 ? w3[t > 0 ? t - 1 : 0] : 0.f);
                        const float imp = sc[t].x + sc[t].y + sc[t].z + 0.5f * sc[t].w + 0.5f * prev;
                        if ((fr & 3) == 0) scl[(4 * mt + (fr >> 2)) * 32 + 4 * t + fq] = imp;
                    }
                    asm volatile("" ::: "memory");
                }
                const bf16* vcb = VCT + ((size_t)(b * 2 + g) * 64 + fr) * 128 + 8 * fq;
#pragma unroll
                for (int n = 0; n < 4; ++n) {
                    outacc[0][n] = (f32x4){0.f, 0.f, 0.f, 0.f}; outacc[1][n] = (f32x4){0.f, 0.f, 0.f, 0.f};
                    asm volatile("" : "+v"(vcb));
#pragma unroll
                    for (int s = 0; s < 4; ++s) if (2 * s < tmaxc) {
                        const bf16x8 vf = *(const bf16x8*)(vcb + 32 * s);
                        outacc[0][n] = __builtin_amdgcn_mfma_f32_16x16x32_bf16(vf, pcf[0][s], outacc[0][n], 0, 0, 0);
                        outacc[1][n] = __builtin_amdgcn_mfma_f32_16x16x32_bf16(vf, pcf[1][s], outacc[1][n], 0, 0, 0); }
                    vcb += 16 * 128;
                    asm volatile("" ::: "memory");
                }
            }
            float g1v[2], g2v[2];
#pragma unroll
            for (int mt = 0; mt < 2; ++mt) {
                const int head = g * 4 + (fr & 3);
                const bf16* gl = HY + (tokbase + tl0 + 4 * mt) * HYN + C_GA + head * 3;
                const float g0 = sigmoidf_(bf2f(gl[0]) + gb[head * 3 + 0]);
                g1v[mt] = sigmoidf_(bf2f(gl[1]) + gb[head * 3 + 1]); g2v[mt] = sigmoidf_(bf2f(gl[2]) + gb[head * 3 + 2]);
#pragma unroll
                for (int n = 0; n < 4; ++n) outacc[mt][n] = outacc[mt][n] * g0;
            }
            LDS_WAIT();
            asm volatile("" ::: "memory");
            {
                const int tok8 = lane >> 3, jg = lane & 7;
                float sj[32];
#pragma unroll
                for (int q = 0; q < 8; ++q) { const f32x4 v = *(const LAS f32x4*)(scl + tok8 * 32 + 4 * q); sj[4 * q] = v.x; sj[4 * q + 1] = v.y; sj[4 * q + 2] = v.z; sj[4 * q + 3] = v.w; }
#pragma unroll
                for (int j = 0; j < 32; ++j) sj[j] = j <= x ? sj[j] + ((j == 0 || j == x || j == x - 1) ? 1000.0f : 0.f) : -INFINITY;
                unsigned bits = 0u;
                const f32x4 mv = *(const LAS f32x4*)(scl + tok8 * 32 + 4 * jg);
#pragma unroll
                for (int q = 0; q < 4; ++q) {
                    const int j = 4 * jg + q;
                    const float mine = j <= x ? mv[q] + ((j == 0 || j == x || j == x - 1) ? 1000.0f : 0.f) : -INFINITY;
                    int rank = 0;
#pragma unroll
                    for (int jj = 0; jj < 32; ++jj) rank += (sj[jj] > mine || (sj[jj] == mine && jj < j)) ? 1 : 0;
                    bits |= (j <= x && rank < 8) ? (1u << j) : 0u;
                }
                bits |= __shfl_xor(bits, 1); bits |= __shfl_xor(bits, 2); bits |= __shfl_xor(bits, 4);
                if (jg == 0) { msk[wid * 8 + tok8] = bits; atomicOr((unsigned*)umask, bits); }
            }
            __syncthreads();
            if (PROBE_NSA == 1) tsub += __builtin_amdgcn_s_memrealtime() - tt0;
#pragma unroll 1
            for (int pp = 0; pp < 2 + (PROBE_NSAX ? 1 : 0); ++pp) {
                const int pass = pp == 2 ? 0 : pp; const bool dummy = pp == 2;
                if (PROBE_NSA == 2 + pass) tt0 = __builtin_amdgcn_s_memrealtime();
                const int jlo = pass ? (x >= 4 ? x - 4 : 0) : 0;
                const unsigned inrange = (x >= 31 ? 0xffffffffu : ((2u << x) - 1u)) & ~((1u << jlo) - 1u);
                unsigned bmask = pass ? inrange : (*umask & inrange);
                const bf16* Kb = pass ? KW : KS; const int cg = (pass ? 10 : 8) + g;
                unsigned tm[2], wm[2], am[2];
#pragma unroll
                for (int mt = 0; mt < 2; ++mt) {
                    tm[mt] = pass ? 0xffffffffu : msk[wid * 8 + 4 * mt + (fr >> 2)];
                    wm[mt] = pass ? 0xffffffffu : (msk[wid * 8 + 4 * mt] | msk[wid * 8 + 4 * mt + 1] | msk[wid * 8 + 4 * mt + 2] | msk[wid * 8 + 4 * mt + 3]);
                    am[mt] = pass ? 0xffffffffu : (msk[wid * 8 + 4 * mt] & msk[wid * 8 + 4 * mt + 1] & msk[wid * 8 + 4 * mt + 2] & msk[wid * 8 + 4 * mt + 3]);
                    wm[mt] = __builtin_amdgcn_readfirstlane(wm[mt]); am[mt] = __builtin_amdgcn_readfirstlane(am[mt]);
                    if (PROBE_NSAX == 2 && dummy) wm[mt] = 0u;
                }
                f32x4 o[2][4]; float mrun[2], lrun[2];
#pragma unroll
                for (int mt = 0; mt < 2; ++mt) { mrun[mt] = -INFINITY; lrun[mt] = 0.f;
#pragma unroll
                    for (int n = 0; n < 4; ++n) o[mt][n] = (f32x4){0.f, 0.f, 0.f, 0.f}; }
                const int srow = tid >> 3, sc16 = tid & 7;
                u32x4 pk0 = (u32x4){0u, 0u, 0u, 0u}, pv0 = pk0, pk1 = pk0, pv1 = pk0;
#define NSA_LD(jx, pk, pv) do { const bf16* ksrc = Kb + ((size_t)b * S + 64 * (jx) + srow) * 128 + g * 64 + sc16 * 8; const bf16* vsrc = VTA + ((size_t)((b * 32 + (jx)) * 12 + cg)) * 4096 + srow * 64 + sc16 * 8; \
                    pk = *(const u32x4*)ksrc; pv = *(const u32x4*)vsrc; } while (0)
                int j0 = __ffs(bmask) - 1; bmask &= bmask - 1u;
                int j1 = bmask ? __ffs(bmask) - 1 : -1; bmask &= bmask - 1u;
                NSA_LD(j0, pk0, pv0); if (j1 >= 0) NSA_LD(j1, pk1, pv1);
                int buf = 0;
                while (j0 >= 0) {
                    *(LAS u32x4*)(ktl + (buf * 2 + 0) * 64 * RS + srow * RS + sc16 * 8) = pk0; *(LAS u32x4*)(vtl + (buf * 2 + 0) * 64 * RS + srow * RS + sc16 * 8) = pv0;
                    if (j1 >= 0) { *(LAS u32x4*)(ktl + (buf * 2 + 1) * 64 * RS + srow * RS + sc16 * 8) = pk1; *(LAS u32x4*)(vtl + (buf * 2 + 1) * 64 * RS + srow * RS + sc16 * 8) = pv1; }
                    const int jn0 = bmask ? __ffs(bmask) - 1 : -1; bmask &= bmask - 1u;
                    const int jn1 = bmask ? __ffs(bmask) - 1 : -1; bmask &= bmask - 1u;
                    if (jn0 >= 0) NSA_LD(jn0, pk0, pv0);
                    if (jn1 >= 0) NSA_LD(jn1, pk1, pv1);
                    __syncthreads();
#pragma unroll 1
                    for (int sub = 0; sub < 2; ++sub) {
                        const int j = sub ? j1 : j0;
                        if (j < 0) break;
                        const LAS bf16* kt = ktl + (buf * 2 + sub) * 64 * RS + fr * RS + 8 * fq; const LAS bf16* vt = vtl + (buf * 2 + sub) * 64 * RS + fr * RS + 8 * fq;
#pragma unroll
                        for (int mt = 0; mt < 2; ++mt) {
                            if (!((wm[mt] >> j) & 1u)) continue;
                            f32x4 sc[4];
#pragma unroll
                            for (int t = 0; t < 4; ++t) { sc[t] = (f32x4){0.f, 0.f, 0.f, 0.f};
                                sc[t] = __builtin_amdgcn_mfma_f32_16x16x32_bf16(*(const LAS bf16x8*)(kt + t * 16 * RS), qf[mt][0], sc[t], 0, 0, 0);
                                sc[t] = __builtin_amdgcn_mfma_f32_16x16x32_bf16(*(const LAS bf16x8*)(kt + t * 16 * RS + 32), qf[mt][1], sc[t], 0, 0, 0); }
                            const int tl = tl0 + 4 * mt;
                            const bool rowok = (tm[mt] >> j) & 1u;
                            const bool edge = (j == x) || (pass && j == x - 4);
                            float bm = -INFINITY;
                            if (edge) {
                                const int kphi = j == x ? tl : 63;
                                const int kplo = (pass && j == x - 4) ? tl + 1 : 0;
#pragma unroll
                                for (int t = 0; t < 4; ++t)
#pragma unroll
                                    for (int r = 0; r < 4; ++r) { const int kp = 16 * t + 4 * fq + r; const bool v = rowok && kp <= kphi && kp >= kplo; sc[t][r] = v ? sc[t][r] : -INFINITY; bm = fmaxf(bm, sc[t][r]); }
                            } else {
#pragma unroll
                                for (int t = 0; t < 4; ++t) bm = fmaxf(bm, fmaxf(fmaxf(sc[t].x, sc[t].y), fmaxf(sc[t].z, sc[t].w)));
                                if (!((am[mt] >> j) & 1u)) bm = rowok ? bm : -INFINITY;
                            }
                            bm = fmaxf(bm, __shfl_xor(bm, 16)); bm = fmaxf(bm, __shfl_xor(bm, 32));
                            const float mn = fmaxf(mrun[mt], bm); const float mns = mn == -INFINITY ? 0.f : mn;
                            float rs = 0.f;
#pragma unroll
                            for (int t = 0; t < 4; ++t)
#pragma unroll
                                for (int r = 0; r < 4; ++r) { sc[t][r] = __builtin_amdgcn_exp2f(sc[t][r] - mns); rs += sc[t][r]; }
                            if (!edge && !((am[mt] >> j) & 1u)) {
#pragma unroll
                                for (int t = 0; t < 4; ++t) sc[t] = rowok ? sc[t] : (f32x4){0.f, 0.f, 0.f, 0.f};
                                rs = rowok ? rs : 0.f;
                            }
                            rs += __shfl_xor(rs, 16); rs += __shfl_xor(rs, 32);
                            if (__all(mn == mrun[mt])) { lrun[mt] += rs; }
                            else {
                                const float alpha = __builtin_amdgcn_exp2f(mrun[mt] - mns);
                                lrun[mt] = lrun[mt] * alpha + rs; mrun[mt] = mn;
#pragma unroll
                                for (int n = 0; n < 4; ++n) o[mt][n] = o[mt][n] * alpha;
                            }
                            bf16x8 pf[2];
#pragma unroll
                            for (int s = 0; s < 2; ++s) { u32x4 w; w.x = pk2(sc[2 * s].x, sc[2 * s].y); w.y = pk2(sc[2 * s].z, sc[2 * s].w); w.z = pk2(sc[2 * s + 1].x, sc[2 * s + 1].y); w.w = pk2(sc[2 * s + 1].z, sc[2 * s + 1].w);
                                pf[s] = __builtin_bit_cast(bf16x8, w); }
#pragma unroll
                            for (int n = 0; n < 4; ++n) {
                                o[mt][n] = __builtin_amdgcn_mfma_f32_16x16x32_bf16(*(const LAS bf16x8*)(vt + n * 16 * RS), pf[0], o[mt][n], 0, 0, 0);
                                o[mt][n] = __builtin_amdgcn_mfma_f32_16x16x32_bf16(*(const LAS bf16x8*)(vt + n * 16 * RS + 32), pf[1], o[mt][n], 0, 0, 0); }
                        }
                    }
                    j0 = jn0; j1 = jn1; buf ^= 1;
                }
#undef NSA_LD
#pragma unroll
                for (int mt = 0; mt < 2; ++mt) { const float sc_ = (pass ? g2v[mt] : g1v[mt]) / lrun[mt];
                    if (!dummy) {
#pragma unroll
                    for (int n = 0; n < 4; ++n) outacc[mt][n] = outacc[mt][n] + o[mt][n] * sc_; } }
                __syncthreads();
                if (PROBE_NSA == 2 + pass) tsub += __builtin_amdgcn_s_memrealtime() - tt0;
            }
#pragma unroll
            for (int mt = 0; mt < 2; ++mt) {
                bf16* dst = CAT + (tokbase + tl0 + 4 * mt) * 1024 + (g * 4 + (fr & 3)) * 64 + 4 * fq;
#pragma unroll
                for (int n = 0; n < 4; ++n) { u32x2 w; w.x = pk2(outacc[mt][n].x, outacc[mt][n].y); w.y = pk2(outacc[mt][n].z, outacc[mt][n].w); *(u32x2*)(dst + 16 * n) = w; }
            }
        }
    }
    __syncthreads();
    if (PROBE_NSA && blockIdx.x == 0 && tid == 0) atomicAdd((unsigned long long*)(ws + WS_CTL + 48000), tsub);
}

__device__ __forceinline__ void phase_vtiles(KArgs A, int wv_, LAS unsigned char* lds) {
    const int tid_ = opaque_tid(wv_); const int wid = __builtin_amdgcn_readfirstlane(tid_ >> 6), lane = tid_ & 63; const int gw = blockIdx.x * 8 + wid, NGW = gridDim.x * 8;
    unsigned char* ws = opq(A->ws);
    const bf16* HY = (const bf16*)(ws + WS_BIG); bf16* VTA = (bf16*)(ws + WS_VTA);
    constexpr int TS = 66;
    LAS bf16* tl = (LAS bf16*)(lds + 65536) + wid * (64 * TS);
    for (int it = gw; it < NBATCH * 32 * 12; it += NGW) {
        const int cg = it % 12, bc = it / 12;
        const int colbase = cg < 8 ? C_VB + cg * 64 : (cg < 10 ? C_VS + (cg - 8) * 64 : C_VW + (cg - 10) * 64);
        const u32x4* src = (const u32x4*)(HY + (size_t)(bc * 64 + lane) * HYN + colbase);
        u32x4 w[8];
#pragma unroll
        for (int i = 0; i < 8; ++i) w[i] = src[i];
#pragma unroll
        for (int i = 0; i < 8; ++i) { LAS unsigned* d = (LAS unsigned*)(tl + lane * TS + 8 * i); d[0] = w[i].x; d[1] = w[i].y; d[2] = w[i].z; d[3] = w[i].w; }
        LDS_WAIT();
        bf16* dst = VTA + (size_t)it * 4096 + lane * 64;
#pragma unroll
        for (int p8 = 0; p8 < 8; ++p8) {
            unsigned short x[8];
#pragma unroll
            for (int j = 0; j < 8; ++j) x[j] = tl[kperm64(p8 * 8 + j) * TS + lane];
            u32x4 o; o.x = x[0] | ((unsigned)x[1] << 16); o.y = x[2] | ((unsigned)x[3] << 16); o.z = x[4] | ((unsigned)x[5] << 16); o.w = x[6] | ((unsigned)x[7] << 16);
            *(u32x4*)(dst + p8 * 8) = o;
        }
        LDS_WAIT();
    }
}

__device__ __forceinline__ void vtrans_wave(KArgs A, int wv_, LAS bf16* tl, const int gw, const int NGW) {
    const int tid_ = opaque_tid(wv_); const int lane = tid_ & 63;
    unsigned char* ws = opq(A->ws);
    const bf16* KV = (const bf16*)(ws + WS_KV); bf16* VT = (bf16*)(ws + WS_VT);
    constexpr int TS = 66;
    for (int it = gw; it < DEPTH * NBATCH * 4 * 16; it += NGW) {
        const int db = it & 3, kb = (it >> 2) & 3, h = (it >> 4) & 3, b = (it >> 6) & 7, l = it >> 9;
        const u32x4* src = (const u32x4*)(KV + (size_t)(b * 256 + 64 * kb + lane) * 8192 + l * 2048 + 1024 + h * 256 + 64 * db);
        u32x4 w[8];
#pragma unroll
        for (int i = 0; i < 8; ++i) w[i] = src[i];
#pragma unroll
        for (int i = 0; i < 8; ++i) { LAS unsigned* d = (LAS unsigned*)(tl + lane * TS + 8 * i); d[0] = w[i].x; d[1] = w[i].y; d[2] = w[i].z; d[3] = w[i].w; }
        LDS_WAIT();
        bf16* dst = VT + ((size_t)((l * 8 + b) * 4 + h) * 256 + 64 * db + lane) * 256 + 64 * kb;
#pragma unroll
        for (int p8 = 0; p8 < 8; ++p8) {
            unsigned short x[8];
#pragma unroll
            for (int j = 0; j < 8; ++j) x[j] = tl[kperm64(p8 * 8 + j) * TS + lane];
            u32x4 o; o.x = x[0] | ((unsigned)x[1] << 16); o.y = x[2] | ((unsigned)x[3] << 16); o.z = x[4] | ((unsigned)x[5] << 16); o.w = x[6] | ((unsigned)x[7] << 16);
            *(u32x4*)(dst + p8 * 8) = o;
        }
        LDS_WAIT();
    }
}

__device__ __forceinline__ float log_sigmoid16(float z) { return (fminf(z, 0.f) - __logf(1.0f + __expf(-fabsf(z)))) * (1.f / 16.f); }
#define GLA_Z(tokv) ({ float z_ = bias; _Pragma("unroll") for (int r_ = 0; r_ < 16; ++r_) z_ += __builtin_bit_cast(float, __builtin_amdgcn_readlane(__builtin_bit_cast(int, al[r_]), (tokv))) * wc[r_]; z_; })
#define GLA_LOAD_GATE() \
    float al[16], wc[16]; \
    { const u32x4* ap_ = (const u32x4*)(HY + (size_t)(tok0 + lane) * HYN + C_AL); const u32x4 a0_ = ap_[0], a1_ = ap_[1]; \
      al[0] = bflo(a0_.x); al[1] = bfhi(a0_.x); al[2] = bflo(a0_.y); al[3] = bfhi(a0_.y); al[4] = bflo(a0_.z); al[5] = bfhi(a0_.z); al[6] = bflo(a0_.w); al[7] = bfhi(a0_.w); \
      al[8] = bflo(a1_.x); al[9] = bfhi(a1_.x); al[10] = bflo(a1_.y); al[11] = bfhi(a1_.y); al[12] = bflo(a1_.z); al[13] = bfhi(a1_.z); al[14] = bflo(a1_.w); al[15] = bfhi(a1_.w); } \
    _Pragma("unroll") for (int r_ = 0; r_ < 16; ++r_) wc[r_] = A->in[I_WA2][(i * 16 + r_) * 256 + h * 64 + lane]; \
    const float bias = A->in[I_BA][i * 256 + h * 64 + lane];

__device__ __forceinline__ void phase_gla_a(KArgs A, int wv_, int i, LAS unsigned char* lds) {
    const int tid_ = opaque_tid(wv_); const int wid = __builtin_amdgcn_readfirstlane(tid_ >> 6), lane = tid_ & 63, fr = lane & 15, fq = lane >> 4; const int gw = blockIdx.x * 8 + wid, NGW = gridDim.x * 8;
    unsigned char* ws = opq(A->ws);
    const bf16* HY = (const bf16*)(ws + WS_BIG); const bf16* VTA = (const bf16*)(ws + WS_VTA); float* SLOC = (float*)(ws + WS_SLOC); float* DEC = (float*)(ws + WS_DEC);
    constexpr int RS = 72;
    LAS bf16* kh = (LAS bf16*)lds + wid * (64 * RS);
    (void)gw;
    for (int it = wid * (int)gridDim.x + (int)blockIdx.x; it < 1024; it += NGW) {
        const int c = it & 31, bh = it >> 5, b = bh >> 2, h = bh & 3; const size_t tok0 = (size_t)b * S + c * 64;
        GLA_LOAD_GATE();
        float bl = 0.f;
#pragma unroll 8
        for (int tk = 0; tk < 64; ++tk) bl += log_sigmoid16(GLA_Z(tk));
        float bc = 0.f;
        unsigned short kcol[64];
#pragma unroll
        for (int tk = 0; tk < 64; ++tk) kcol[tk] = HY[(tok0 + tk) * HYN + C_KB + h * 64 + lane];
#pragma unroll
        for (int tk = 0; tk < 64; ++tk) {
            bc += log_sigmoid16(GLA_Z(tk));
            kh[lane * RS + kpos64(tk)] = (bf16)f2bf(bf2f(kcol[tk]) * __expf(bl - bc));
        }
        DEC[it * 64 + lane] = __expf(bl);
        LDS_WAIT();
#pragma unroll
        for (int dvh = 0; dvh < 2; ++dvh) {
            const bf16* vt = VTA + ((size_t)((b * 32 + c) * 12 + h * 2 + dvh)) * 4096;
            bf16x8 vf[4][2];
#pragma unroll
            for (int n = 0; n < 4; ++n)
#pragma unroll
                for (int s = 0; s < 2; ++s) vf[n][s] = *(const bf16x8*)(vt + (16 * n + fr) * 64 + 32 * s + 8 * fq);
#pragma unroll
            for (int m = 0; m < 4; ++m) {
                const bf16x8 a0 = *(const LAS bf16x8*)(kh + (16 * m + fr) * RS + 8 * fq), a1 = *(const LAS bf16x8*)(kh + (16 * m + fr) * RS + 32 + 8 * fq);
#pragma unroll
                for (int n = 0; n < 4; ++n) {
                    f32x4 acc = (f32x4){0.f, 0.f, 0.f, 0.f};
                    acc = __builtin_amdgcn_mfma_f32_16x16x32_bf16(a0, vf[n][0], acc, 0, 0, 0);
                    acc = __builtin_amdgcn_mfma_f32_16x16x32_bf16(a1, vf[n][1], acc, 0, 0, 0);
                    float* dst = SLOC + ((size_t)it * 64 + 16 * m + 4 * fq) * 128 + dvh * 64 + 16 * n + fr;
                    dst[0] = acc.x; dst[128] = acc.y; dst[256] = acc.z; dst[384] = acc.w;
                }
            }
        }
        LDS_WAIT();
    }
}
__device__ __forceinline__ void phase_gla_c(KArgs A, int wv_, int i, LAS unsigned char* lds, const bool kv_post) {
    const int tid_ = opaque_tid(wv_); const int wid = __builtin_amdgcn_readfirstlane(tid_ >> 6), lane = tid_ & 63, fr = lane & 15, fq = lane >> 4; const int gw = blockIdx.x * 8 + wid, NGW = gridDim.x * 8;
    unsigned char* ws = opq(A->ws);
    const bf16* HY = (const bf16*)(ws + WS_BIG); const bf16* VTA = (const bf16*)(ws + WS_VTA); const bf16* STT = (const bf16*)(ws + WS_STT); bf16* CAT = (bf16*)(ws + WS_CAT);
    constexpr int RS = 72;
    LAS bf16* qs = (LAS bf16*)lds + wid * (128 * RS);
    LAS bf16* ks = qs + 64 * RS;
    const float* og = A->in[I_ONORM] + i * 128;
    LAS float* ogl = (LAS float*)(lds + 8 * 128 * RS * 2);
    if (tid_ < 128) ogl[tid_] = og[tid_];
    (void)gw; (void)NGW;
    for (int blk = blockIdx.x; blk < 256; blk += gridDim.x) {
        SUBT_BEGIN(1);
        {
            const float* SLOC = (const float*)(ws + WS_SLOC); const float* DEC = (const float*)(ws + WS_DEC); bf16* STw = (bf16*)(ws + WS_STT);
            const int tid = tid_, dv = tid & 127, ko = tid >> 7, bh = blk >> 3, c0 = (blk & 7) * 4;
            float sv[16];
#pragma unroll
            for (int j = 0; j < 16; ++j) sv[j] = 0.f;
#pragma unroll 1
            for (int cb = 0; cb < c0 + 4; cb += 4) {
                float dc4[4][16], sl4[4][16];
#pragma unroll
                for (int q = 0; q < 4; ++q) {
                    const size_t item = (size_t)bh * 32 + cb + q; const float* sl = SLOC + (item * 64 + ko * 16) * 128 + dv; const float* dc = DEC + item * 64 + ko * 16;
#pragma unroll
                    for (int j = 0; j < 16; ++j) { dc4[q][j] = dc[j]; sl4[q][j] = sl[j * 128]; }
                }
#pragma unroll
                for (int q = 0; q < 4; ++q) {
                    const int c = cb + q; const size_t item = (size_t)bh * 32 + c;
                    if (c >= c0) {
                        u32x4 o0, o1; o0.x = pk2(sv[0], sv[1]); o0.y = pk2(sv[2], sv[3]); o0.z = pk2(sv[4], sv[5]); o0.w = pk2(sv[6], sv[7]);
                        o1.x = pk2(sv[8], sv[9]); o1.y = pk2(sv[10], sv[11]); o1.z = pk2(sv[12], sv[13]); o1.w = pk2(sv[14], sv[15]);
                        u32x4* d = (u32x4*)(STw + (item * 128 + dv) * 64 + ko * 16); d[0] = o0; d[1] = o1;
                    }
#pragma unroll
                    for (int j = 0; j < 16; ++j) sv[j] = dc4[q][j] * sv[j] + sl4[q][j];
                }
            }
            asm volatile("s_waitcnt vmcnt(0)" ::: "memory");
            __syncthreads();
        }
        SUBT_END(1, ws, tid_);
        SUBT_BEGIN(2);
        SUBT_BEGIN(3);
        if (wid < 4) {
        const int it = blk * 4 + wid;
        const int c = it & 31, bh = it >> 5, b = bh >> 2, h = bh & 3; const size_t tok0 = (size_t)b * S + c * 64;
        GLA_LOAD_GATE();
        float bc = 0.f;
        unsigned short qcol[64], kcol[64];
#pragma unroll
        for (int tk = 0; tk < 64; ++tk) { const bf16* row = HY + (tok0 + tk) * HYN; qcol[tk] = row[C_QB + h * 64 + lane]; kcol[tk] = row[C_KB + h * 64 + lane]; }
#pragma unroll
        for (int tk = 0; tk < 64; ++tk) {
            bc += log_sigmoid16(GLA_Z(tk));
            const float eb = __expf(bc);
            qs[tk * RS + lane] = (bf16)f2bf(bf2f(qcol[tk]) * 0.125f * eb); ks[tk * RS + lane] = (bf16)f2bf(bf2f(kcol[tk]) / eb);
        }
        LDS_WAIT();
        SUBT_END(2, ws, tid_);
        bf16x8 st[8][2];
#pragma unroll
        for (int n = 0; n < 8; ++n)
#pragma unroll
            for (int s = 0; s < 2; ++s) st[n][s] = *(const bf16x8*)(STT + ((size_t)it * 128 + 16 * n + fr) * 64 + 32 * s + 8 * fq);
        const bf16* vt = VTA + ((size_t)((b * 32 + c) * 12 + h * 2)) * 4096;
        bf16x8 vfr[8][2];
#pragma unroll
        for (int n = 0; n < 8; ++n) { const bf16* vrow = vt + (size_t)(n >> 2) * 4096 + (16 * (n & 3) + fr) * 64 + 8 * fq; vfr[n][0] = *(const bf16x8*)vrow; vfr[n][1] = *(const bf16x8*)(vrow + 32); }
#pragma unroll
        for (int mi = 0; mi < 4; ++mi) {
            const bf16x8 q0 = *(const LAS bf16x8*)(qs + (16 * mi + fr) * RS + 8 * fq), q1 = *(const LAS bf16x8*)(qs + (16 * mi + fr) * RS + 32 + 8 * fq);
            u32x2 rwv[8];
#pragma unroll
            for (int n = 0; n < 8; ++n) rwv[n] = *(const u32x2*)(HY + (tok0 + 16 * mi + fr) * HYN + C_RB + h * 128 + 16 * n + 4 * fq);
            f32x4 sc[4];
#pragma unroll
            for (int t = 0; t < 4; ++t) {
                sc[t] = (f32x4){0.f, 0.f, 0.f, 0.f};
                if (t <= mi) {
                    const bf16x8 k0 = *(const LAS bf16x8*)(ks + (16 * t + fr) * RS + 8 * fq), k1 = *(const LAS bf16x8*)(ks + (16 * t + fr) * RS + 32 + 8 * fq);
                    sc[t] = __builtin_amdgcn_mfma_f32_16x16x32_bf16(k0, q0, sc[t], 0, 0, 0);
                    sc[t] = __builtin_amdgcn_mfma_f32_16x16x32_bf16(k1, q1, sc[t], 0, 0, 0);
                    if (t == mi) {
                        sc[t].x = (4 * fq + 0 <= fr) ? sc[t].x : 0.f; sc[t].y = (4 * fq + 1 <= fr) ? sc[t].y : 0.f; sc[t].z = (4 * fq + 2 <= fr) ? sc[t].z : 0.f; sc[t].w = (4 * fq + 3 <= fr) ? sc[t].w : 0.f; }
                }
            }
            bf16x8 pf[2];
#pragma unroll
            for (int s = 0; s < 2; ++s) { u32x4 w; w.x = pk2(sc[2 * s].x, sc[2 * s].y); w.y = pk2(sc[2 * s].z, sc[2 * s].w); w.z = pk2(sc[2 * s + 1].x, sc[2 * s + 1].y); w.w = pk2(sc[2 * s + 1].z, sc[2 * s + 1].w);
                pf[s] = __builtin_bit_cast(bf16x8, w); }
            f32x4 o[8]; float ssq = 0.f;
#pragma unroll
            for (int n = 0; n < 8; ++n) {
                o[n] = (f32x4){0.f, 0.f, 0.f, 0.f};
                o[n] = __builtin_amdgcn_mfma_f32_16x16x32_bf16(st[n][0], q0, o[n], 0, 0, 0);
                o[n] = __builtin_amdgcn_mfma_f32_16x16x32_bf16(st[n][1], q1, o[n], 0, 0, 0);
                o[n] = __builtin_amdgcn_mfma_f32_16x16x32_bf16(vfr[n][0], pf[0], o[n], 0, 0, 0);
                if (mi >= 2) o[n] = __builtin_amdgcn_mfma_f32_16x16x32_bf16(vfr[n][1], pf[1], o[n], 0, 0, 0);
                ssq += (o[n].x * o[n].x + o[n].y * o[n].y) + (o[n].z * o[n].z + o[n].w * o[n].w);
            }
            ssq += __shfl_xor(ssq, 16); ssq += __shfl_xor(ssq, 32);
            const float rstd = rsqrtf(ssq * (1.f / 128.f) + EPS);
            const size_t tok = tok0 + 16 * mi + fr;
#pragma unroll
            for (int n = 0; n < 8; ++n) {
                const int dv = 16 * n + 4 * fq;
                const u32x2 rw = rwv[n]; const f32x4 g = *(const LAS f32x4*)(ogl + dv);
                const float r0 = bflo(rw.x), r1 = bfhi(rw.x), r2 = bflo(rw.y), r3 = bfhi(rw.y);
                u32x2 w; w.x = pk2(o[n].x * rstd * g.x * (r0 * sigmoidf_(r0)), o[n].y * rstd * g.y * (r1 * sigmoidf_(r1)));
                w.y = pk2(o[n].z * rstd * g.z * (r2 * sigmoidf_(r2)), o[n].w * rstd * g.w * (r3 * sigmoidf_(r3)));
                *(u32x2*)(CAT + tok * 1024 + 512 + h * 128 + dv) = w;
            }
        }
        } else if (kv_post) {
            phase_knorm(A, wv_, blk * 4 + (wid - 4), 256 * 4);
            vtrans_wave(A, wv_, (LAS bf16*)(lds + 81920) + (wid - 4) * (64 * 66), blk * 4 + (wid - 4), 256 * 4);
        }
        SUBT_END(3, ws, tid_);
        LDS_WAIT();
        __syncthreads();
    }
}

__device__ __forceinline__ void phase_sgu_mix(KArgs A, int wv_, int i, LAS unsigned char* lds) {
    const int tid = opaque_tid(wv_), wid = __builtin_amdgcn_readfirstlane(tid >> 6), lane = tid & 63;
    unsigned char* ws = opq(A->ws);
    const bf16* U = (const bf16*)(ws + WS_U); const bf16* V = (const bf16*)(ws + WS_V); bf16* UM = (bf16*)(ws + WS_UM);
    LAS float* vt = (LAS float*)lds;
    LAS float* st = vt + 128 * 256;
    const float* lng = A->in[I_LNG] + i * 2048; const float* lnb = A->in[I_LNB] + i * 2048;
    for (int it = blockIdx.x; it < NBATCH * 16 * 8; it += gridDim.x) {
        const int g = it & 7, n = (it >> 3) & 15, b = it >> 7;
        const size_t tok0 = (size_t)b * S + n * 128;
        __syncthreads();
        for (int s = wid * 16; s < wid * 16 + 16; ++s) {
            const u32x4* vr = (const u32x4*)(V + (tok0 + s) * 2048) + lane;
            float x[32]; float sum = 0.f;
#pragma unroll
            for (int j = 0; j < 4; ++j) { const u32x4 w = vr[64 * j];
                x[8 * j + 0] = bflo(w.x); x[8 * j + 1] = bfhi(w.x); x[8 * j + 2] = bflo(w.y); x[8 * j + 3] = bfhi(w.y); x[8 * j + 4] = bflo(w.z); x[8 * j + 5] = bfhi(w.z); x[8 * j + 6] = bflo(w.w); x[8 * j + 7] = bfhi(w.w); }
#pragma unroll
            for (int j = 0; j < 32; ++j) sum += x[j];
            const float mean = wave_sum(sum) * (1.f / 2048.f); float q = 0.f;
#pragma unroll
            for (int j = 0; j < 32; ++j) { const float d = x[j] - mean; q += d * d; }
            const float rstd = rsqrtf(wave_sum(q) * (1.f / 2048.f) + EPS);
            const u32x2 w = *((const u32x2*)(V + (tok0 + s) * 2048 + g * 256) + lane);
            const f32x4 gg = *(const f32x4*)(lng + g * 256 + 4 * lane), bb = *(const f32x4*)(lnb + g * 256 + 4 * lane);
            f32x4 o; o.x = (bflo(w.x) - mean) * rstd * gg.x + bb.x; o.y = (bfhi(w.x) - mean) * rstd * gg.y + bb.y; o.z = (bflo(w.y) - mean) * rstd * gg.z + bb.z; o.w = (bfhi(w.y) - mean) * rstd * gg.w + bb.w;
            *(LAS f32x4*)(vt + s * 256 + 4 * lane) = o;
            (void)st;
        }
        __syncthreads();
        const int c = tid & 255, th = tid >> 8;
        const float* wsg = A->in[I_SGWS] + (size_t)(i * 8 + g) * 128 * 128; const float* bsg = A->in[I_SGBS] + (i * 8 + g) * 128;
        for (int tt = 0; tt < 64; ++tt) {
            const int t = 2 * tt + th;
            const float* wr = wsg + t * 128;
            float acc = 0.f;
            for (int s = 0; s <= t; ++s) acc += wr[s] * vt[s * 256 + c];
            acc += bsg[t];
            const float u = bf2f(U[(tok0 + t) * 2048 + g * 256 + c]);
            UM[(tok0 + t) * 2048 + g * 256 + c] = (bf16)f2bf(u * acc);
        }
    }
    __syncthreads();
}


__device__ __forceinline__ void phase_sgu_mix_mfma(KArgs A, int wv_, int i, LAS unsigned char* lds) {
    const int tid = opaque_tid(wv_), wid = __builtin_amdgcn_readfirstlane(tid >> 6), lane = tid & 63, fr = lane & 15, fq = lane >> 4;
    unsigned char* ws = opq(A->ws);
    const bf16* U = (const bf16*)(ws + WS_U); const bf16* V = (const bf16*)(ws + WS_V); bf16* UM = (bf16*)(ws + WS_UM);
    const bf16* WSB = (const bf16*)(ws + WS_WSB) + (size_t)i * 8 * 16384; const float* M0 = (const float*)(ws + WS_M0) + i * 8 * 128;
    constexpr int VS = 136;
    LAS bf16* vT = (LAS bf16*)lds;
    LAS float* st = (LAS float*)(lds + 256 * VS * 2);
    LAS bf16* wl = (LAS bf16*)(lds + 256 * VS * 2 + 1024);
    const float* lng = A->in[I_LNG] + i * 2048; const float* lnb = A->in[I_LNB] + i * 2048; const float* bsg = A->in[I_SGBS] + i * 8 * 128;
    for (int it = blockIdx.x; it < 256; it += gridDim.x) {
        const int gh = it & 1, n_ = (it >> 1) & 15, b = it >> 5; const size_t tok0 = (size_t)b * S + n_ * 128;
        __syncthreads();
        {
            const float* vst = (const float*)(ws + WS_VSTAT);
#pragma unroll
            for (int s4 = 0; s4 < 16; s4 += 4) {
                const int s = wid * 16 + s4 + (lane >> 4);
                const f32x4 p = *(const f32x4*)(vst + (tok0 + s) * 64 + 4 * (lane & 15));
                float sum = p.x + p.z, sq = p.y + p.w;
                sum += __shfl_xor(sum, 1); sq += __shfl_xor(sq, 1); sum += __shfl_xor(sum, 2); sq += __shfl_xor(sq, 2);
                sum += __shfl_xor(sum, 4); sq += __shfl_xor(sq, 4); sum += __shfl_xor(sum, 8); sq += __shfl_xor(sq, 8);
                const float mean = sum * (1.f / 2048.f); const float var = fmaxf(sq * (1.f / 2048.f) - mean * mean, 0.f);
                if ((lane & 15) == 0) { st[2 * s] = mean; st[2 * s + 1] = rsqrtf(var + EPS); }
            }
        }
#pragma unroll 1
        for (int gg = 0; gg < 4; ++gg) {
            const int g = gh * 4 + gg;
            __syncthreads();
            {
                const int s = tid & 127, cq = tid >> 7;
                const float mean = st[2 * s], rstd = st[2 * s + 1];
                const u32x4* src = (const u32x4*)(V + (tok0 + s) * 2048 + g * 256 + cq * 64);
                u32x4 w8[8], ww[4];
#pragma unroll
                for (int i8 = 0; i8 < 8; ++i8) w8[i8] = src[i8];
#pragma unroll
                for (int q = 0; q < 4; ++q) { const int e = tid + 512 * q; ww[q] = *(const u32x4*)(WSB + ((size_t)g * 128 + (e >> 4)) * 128 + (e & 15) * 8); }
#pragma unroll
                for (int i8 = 0; i8 < 8; ++i8) {
                    const u32x4 w = w8[i8];
                    LAS bf16* d = vT + (cq * 64 + i8 * 8) * VS + s;
                    d[0 * VS] = (bf16)f2bf((bflo(w.x) - mean) * rstd); d[1 * VS] = (bf16)f2bf((bfhi(w.x) - mean) * rstd); d[2 * VS] = (bf16)f2bf((bflo(w.y) - mean) * rstd); d[3 * VS] = (bf16)f2bf((bfhi(w.y) - mean) * rstd);
                    d[4 * VS] = (bf16)f2bf((bflo(w.z) - mean) * rstd); d[5 * VS] = (bf16)f2bf((bfhi(w.z) - mean) * rstd); d[6 * VS] = (bf16)f2bf((bflo(w.w) - mean) * rstd); d[7 * VS] = (bf16)f2bf((bfhi(w.w) - mean) * rstd);
                }
#pragma unroll
                for (int q = 0; q < 4; ++q) { const int e = tid + 512 * q; *(LAS u32x4*)(wl + (e >> 4) * VS + (e & 15) * 8) = ww[q]; }
            }
            u32x2 uw[8][2]; float m0v[8], bsv[8];
#pragma unroll
            for (int n = 0; n < 8; ++n) { const int t = 16 * n + fr; m0v[n] = M0[g * 128 + t]; bsv[n] = bsg[g * 128 + t];
                const size_t ro = (tok0 + t) * 2048 + g * 256 + 32 * wid + 4 * fq; uw[n][0] = *(const u32x2*)(U + ro); uw[n][1] = *(const u32x2*)(U + ro + 16); }
            __syncthreads();
            bf16x8 vf[2][4];
#pragma unroll
            for (int m = 0; m < 2; ++m)
#pragma unroll
                for (int k = 0; k < 4; ++k) vf[m][k] = *(const LAS bf16x8*)(vT + (32 * wid + 16 * m + fr) * VS + 32 * k + 8 * fq);
            f32x4 gc[2], bc[2];
#pragma unroll
            for (int m = 0; m < 2; ++m) { gc[m] = *(const f32x4*)(lng + g * 256 + 32 * wid + 16 * m + 4 * fq); bc[m] = *(const f32x4*)(lnb + g * 256 + 32 * wid + 16 * m + 4 * fq); }
#pragma unroll
            for (int n = 0; n < 8; ++n) {
                f32x4 a0 = (f32x4){0.f, 0.f, 0.f, 0.f}, a1 = (f32x4){0.f, 0.f, 0.f, 0.f};
#pragma unroll
                for (int k = 0; k < 4; ++k) if (k <= (n >> 1)) {
                    const bf16x8 wf = *(const LAS bf16x8*)(wl + (16 * n + fr) * VS + 32 * k + 8 * fq);
                    a0 = __builtin_amdgcn_mfma_f32_16x16x32_bf16(vf[0][k], wf, a0, 0, 0, 0);
                    a1 = __builtin_amdgcn_mfma_f32_16x16x32_bf16(vf[1][k], wf, a1, 0, 0, 0); }
                const int t = 16 * n + fr; const float m0 = m0v[n], bsv_ = bsv[n];
                const size_t ro = (tok0 + t) * 2048 + g * 256 + 32 * wid + 4 * fq;
#pragma unroll
                for (int m = 0; m < 2; ++m) {
                    const f32x4 a = m ? a1 : a0;
                    const u32x2 uw_ = uw[n][m];
                    u32x2 w; w.x = pk2((a.x * gc[m].x + bc[m].x * m0 + bsv_) * bflo(uw_.x), (a.y * gc[m].y + bc[m].y * m0 + bsv_) * bfhi(uw_.x));
                    w.y = pk2((a.z * gc[m].z + bc[m].z * m0 + bsv_) * bflo(uw_.y), (a.w * gc[m].w + bc[m].w * m0 + bsv_) * bfhi(uw_.y));
                    *(u32x2*)(UM + ro + 16 * m) = w;
                }
            }
        }
    }
    __syncthreads();
}

__device__ __forceinline__ void phase_rownorm(KArgs A, int wv_) {
    const int tid_ = opaque_tid(wv_); const int wid = __builtin_amdgcn_readfirstlane(tid_ >> 6), lane = tid_ & 63; const int gw = blockIdx.x * 8 + wid, NGW = gridDim.x * 8;
    bf16* XN = (bf16*)(opq(A->ws) + WS_XN); const float* X = A->out;
    f32x4 v[4], vn[4];
    if (gw < T) {
#pragma unroll
        for (int j = 0; j < 4; ++j) v[j] = ((const f32x4*)(X + (size_t)gw * D) + lane)[64 * j];
    }
    for (int m = gw; m < T; m += NGW) {
        const int mn = m + NGW < T ? m + NGW : m;
#pragma unroll
        for (int j = 0; j < 4; ++j) vn[j] = ((const f32x4*)(X + (size_t)mn * D) + lane)[64 * j];
        float s = 0.f;
#pragma unroll
        for (int j = 0; j < 4; ++j) s += (v[j].x * v[j].x + v[j].y * v[j].y) + (v[j].z * v[j].z + v[j].w * v[j].w);
        const float rstd = rsqrtf(wave_sum(s) * (1.f / 1024.f) + EPS);
        u32x2* o8 = (u32x2*)(XN + (size_t)m * D) + lane;
#pragma unroll
        for (int j = 0; j < 4; ++j) { u32x2 w; w.x = pk2(v[j].x * rstd, v[j].y * rstd); w.y = pk2(v[j].z * rstd, v[j].w * rstd); o8[64 * j] = w; }
#pragma unroll
        for (int j = 0; j < 4; ++j) v[j] = vn[j];
    }
}

__device__ __forceinline__ void phase_xattn(KArgs A, int wv_, int L, LAS unsigned char* lds) {
    const int tid = opaque_tid(wv_), wid = __builtin_amdgcn_readfirstlane(tid >> 6), lane = tid & 63;
    unsigned char* ws = opq(A->ws);
    const bf16* QX = (const bf16*)(ws + WS_QX); const bf16* KV = (const bf16*)(ws + WS_KV); bf16* OX = (bf16*)(ws + WS_OX);
    constexpr int KSTR = 129;
    LAS unsigned* kl = (LAS unsigned*)lds;
    LAS float* qb = (LAS float*)(lds + 132096) + wid * 256;
    LAS float* pb = (LAS float*)(lds + 132096 + 8192) + wid * 256;
    const float* qg = A->in[I_XQN] + L * 256;
    for (int it = blockIdx.x; it < NBATCH * 4 * 8; it += gridDim.x) {
        const int qc = it & 7, h = (it >> 3) & 3, b = it >> 5;
        __syncthreads();
        for (int e = tid; e < 256 * 128; e += 512) { const int m = e >> 7, dw = e & 127;
            kl[m * KSTR + dw] = *((const unsigned*)(KV + (size_t)(b * 256 + m) * 8192 + L * 2048 + h * 256) + dw); }
        __syncthreads();
        const bf16* Vb = KV + (size_t)(b * 256) * 8192 + L * 2048 + 1024 + h * 256;
        for (int tq = 0; tq < 32; ++tq) {
            const size_t tok = (size_t)b * S + qc * 256 + wid * 32 + tq;
            const u32x2 qw = *((const u32x2*)(QX + tok * 1024 + h * 256) + lane);
            const float q0 = bflo(qw.x), q1 = bfhi(qw.x), q2 = bflo(qw.y), q3 = bfhi(qw.y);
            const float rstd = rsqrtf(wave_sum(q0 * q0 + q1 * q1 + q2 * q2 + q3 * q3) * (1.f / 256.f) + EPS);
            const f32x4 gg = *(const f32x4*)(qg + 4 * lane);
            *(LAS f32x4*)(qb + 4 * lane) = (f32x4){q0 * rstd * gg.x, q1 * rstd * gg.y, q2 * rstd * gg.z, q3 * rstd * gg.w};
            LDS_WAIT();
            float s0 = 0.f, s1 = 0.f, s2 = 0.f, s3 = 0.f;
#pragma unroll 4
            for (int dw = 0; dw < 128; ++dw) {
                const f32x2 qq = *(const LAS f32x2*)(qb + 2 * dw);
                const unsigned k0 = kl[lane * KSTR + dw], k1 = kl[(lane + 64) * KSTR + dw], k2 = kl[(lane + 128) * KSTR + dw], k3 = kl[(lane + 192) * KSTR + dw];
                s0 += qq.x * bflo(k0) + qq.y * bfhi(k0); s1 += qq.x * bflo(k1) + qq.y * bfhi(k1);
                s2 += qq.x * bflo(k2) + qq.y * bfhi(k2); s3 += qq.x * bflo(k3) + qq.y * bfhi(k3);
            }
            const float mx = wave_max(fmaxf(fmaxf(s0, s1), fmaxf(s2, s3)));
            const float e0 = __expf(s0 - mx), e1 = __expf(s1 - mx), e2 = __expf(s2 - mx), e3 = __expf(s3 - mx);
            const float inv = 1.f / wave_sum((e0 + e1) + (e2 + e3));
            pb[lane] = e0 * inv; pb[lane + 64] = e1 * inv; pb[lane + 128] = e2 * inv; pb[lane + 192] = e3 * inv;
            LDS_WAIT();
            float o0 = 0.f, o1 = 0.f, o2 = 0.f, o3 = 0.f;
#pragma unroll 8
            for (int m = 0; m < 256; ++m) {
                const float p = pb[m];
                const u32x2 vw = *((const u32x2*)(Vb + (size_t)m * 8192) + lane);
                o0 += p * bflo(vw.x); o1 += p * bfhi(vw.x); o2 += p * bflo(vw.y); o3 += p * bfhi(vw.y);
            }
            u32x2 ow; ow.x = pk2(o0, o1); ow.y = pk2(o2, o3);
            *((u32x2*)(OX + tok * 1024 + h * 256) + lane) = ow;
            LDS_WAIT();
        }
    }
    __syncthreads();
}


__device__ __forceinline__ int kperm32(int p) { const int fq = (p >> 3) & 3, j = p & 7; return (p & ~31) + 16 * (j >> 2) + 4 * fq + (j & 3); }
__device__ __forceinline__ void phase_vtrans(KArgs A, int wv_, LAS unsigned char* lds) {
    const int tid = opaque_tid(wv_);
    unsigned char* ws = opq(A->ws);
    const bf16* KV = (const bf16*)(ws + WS_KV); bf16* VT = (bf16*)(ws + WS_VT);
    LAS bf16* vt = (LAS bf16*)lds;
    constexpr int VS = 258;
    for (int it = blockIdx.x; it < DEPTH * NBATCH * 4; it += gridDim.x) {
        const int h = it & 3, b = (it >> 2) & 7, l = it >> 5;
        __syncthreads();
        for (int e = tid; e < 256 * 32; e += 512) { const int m = e >> 5, c8 = e & 31;
            const u32x4 w = *(const u32x4*)(KV + (size_t)(b * 256 + m) * 8192 + l * 2048 + 1024 + h * 256 + c8 * 8);
            LAS unsigned* d = (LAS unsigned*)(vt + m * VS + c8 * 8); d[0] = w.x; d[1] = w.y; d[2] = w.z; d[3] = w.w; }
        __syncthreads();
        for (int e = tid; e < 256 * 32; e += 512) { const int dv = e & 255, p8 = e >> 8;
            unsigned short x[8];
#pragma unroll
            for (int j = 0; j < 8; ++j) x[j] = vt[kperm32(p8 * 8 + j) * VS + dv];
            u32x4 o; o.x = x[0] | ((unsigned)x[1] << 16); o.y = x[2] | ((unsigned)x[3] << 16); o.z = x[4] | ((unsigned)x[5] << 16); o.w = x[6] | ((unsigned)x[7] << 16);
            *(u32x4*)(VT + ((size_t)it * 256 + dv) * 256 + p8 * 8) = o; }
    }
    __syncthreads();
}

__device__ __forceinline__ void xattn_item(KArgs A, int wv_, int L, LAS unsigned char* lds, const int b, const int h, const int qt) {
    const int tid = opaque_tid(wv_), wid = __builtin_amdgcn_readfirstlane(tid >> 6), lane = tid & 63, fr = lane & 15, fq = lane >> 4;
    unsigned char* ws = opq(A->ws);
    const bf16* QX = (const bf16*)(ws + WS_QX); const bf16* KV = (const bf16*)(ws + WS_KV); const bf16* VT = (const bf16*)(ws + WS_VT); bf16* OX = (bf16*)(ws + WS_OX);
    constexpr int RS = 264;
    LAS bf16* kl = (LAS bf16*)lds;
    const float* qg = A->in[I_XQN] + L * 256;
    {
        __syncthreads();
        {
            const int row = tid >> 1, hf = tid & 1;
            const u32x4* src = (const u32x4*)(KV + (size_t)(b * 256 + row) * 8192 + L * 2048 + h * 256 + hf * 128);
#pragma unroll
            for (int i0 = 0; i0 < 16; i0 += 8) {
                u32x4 w[8];
#pragma unroll
                for (int i = 0; i < 8; ++i) w[i] = src[i0 + i];
#pragma unroll
                for (int i = 0; i < 8; ++i) *(LAS u32x4*)(kl + row * RS + hf * 128 + (i0 + i) * 8) = w[i];
            }
        }
        const size_t tok0 = (size_t)b * S + qt * 256 + wid * 32 + fr;
        u32x4 qw0[8], qw1[8];
#pragma unroll
        for (int s = 0; s < 8; ++s) { qw0[s] = *(const u32x4*)(QX + tok0 * 1024 + h * 256 + 32 * s + 8 * fq); qw1[s] = *(const u32x4*)(QX + (tok0 + 16) * 1024 + h * 256 + 32 * s + 8 * fq); }
        __syncthreads();
        bf16x8 pf0[8], pf1[8]; float inv0, inv1;
        auto s_part = [&](const u32x4 (&qw)[8], bf16x8 (&pf)[8], float& inv) __attribute__((always_inline)) {
            float ssq = 0.f;
#pragma unroll
            for (int s = 0; s < 8; ++s) {
                const float a0 = bflo(qw[s].x), a1 = bfhi(qw[s].x), a2 = bflo(qw[s].y), a3 = bfhi(qw[s].y), a4 = bflo(qw[s].z), a5 = bfhi(qw[s].z), a6 = bflo(qw[s].w), a7 = bfhi(qw[s].w);
                ssq += (a0 * a0 + a1 * a1) + (a2 * a2 + a3 * a3) + (a4 * a4 + a5 * a5) + (a6 * a6 + a7 * a7);
            }
            ssq += __shfl_xor(ssq, 16); ssq += __shfl_xor(ssq, 32);
            const float rstd = rsqrtf(ssq * (1.f / 256.f) + EPS);
            bf16x8 qf[8];
#pragma unroll
            for (int s = 0; s < 8; ++s) qf[s] = __builtin_bit_cast(bf16x8, qw[s]);
            f32x4 sc[16];
#pragma unroll
            for (int hf = 0; hf < 2; ++hf) {
                unsigned kb = (unsigned)(size_t)(kl + (128 * hf + fr) * RS + 8 * fq); asm volatile("" : "+v"(kb));
#pragma unroll
                for (int t8 = 0; t8 < 8; ++t8) { const int t = 8 * hf + t8; sc[t] = (f32x4){0.f, 0.f, 0.f, 0.f};
#pragma unroll
                    for (int s = 0; s < 8; ++s) { const bf16x8 kf = *(const LAS bf16x8*)(size_t)(kb + (unsigned)((16 * t8 * RS + 32 * s) * 2));
                        sc[t] = __builtin_amdgcn_mfma_f32_16x16x32_bf16(kf, qf[s], sc[t], 0, 0, 0); }
                    if (t & 1) asm volatile("" ::: "memory"); }
            }
            float mx = -INFINITY;
#pragma unroll
            for (int t = 0; t < 16; ++t) mx = fmaxf(mx, fmaxf(fmaxf(sc[t].x, sc[t].y), fmaxf(sc[t].z, sc[t].w)));
            mx = fmaxf(mx, __shfl_xor(mx, 16)); mx = fmaxf(mx, __shfl_xor(mx, 32));
            float lsum = 0.f;
#pragma unroll
            for (int t = 0; t < 16; ++t) { sc[t].x = __expf((sc[t].x - mx) * rstd); sc[t].y = __expf((sc[t].y - mx) * rstd); sc[t].z = __expf((sc[t].z - mx) * rstd); sc[t].w = __expf((sc[t].w - mx) * rstd); lsum += (sc[t].x + sc[t].y) + (sc[t].z + sc[t].w); }
            lsum += __shfl_xor(lsum, 16); lsum += __shfl_xor(lsum, 32);
            inv = 1.f / lsum;
#pragma unroll
            for (int s = 0; s < 8; ++s) { u32x4 w; w.x = pk2(sc[2 * s].x, sc[2 * s].y); w.y = pk2(sc[2 * s].z, sc[2 * s].w); w.z = pk2(sc[2 * s + 1].x, sc[2 * s + 1].y); w.w = pk2(sc[2 * s + 1].z, sc[2 * s + 1].w);
                pf[s] = __builtin_bit_cast(bf16x8, w); }
        };
        s_part(qw0, pf0, inv0);
        s_part(qw1, pf1, inv1);
        __syncthreads();
        {
            const int row = tid >> 1, hf = tid & 1;
            const u32x4* src = (const u32x4*)(VT + ((size_t)((L * 8 + b) * 4 + h) * 256 + row) * 256 + hf * 128);
#pragma unroll
            for (int i0 = 0; i0 < 16; i0 += 8) {
                u32x4 w[8];
#pragma unroll
                for (int i = 0; i < 8; ++i) w[i] = src[i0 + i];
#pragma unroll
                for (int i = 0; i < 8; ++i) *(LAS u32x4*)(kl + row * RS + hf * 128 + (i0 + i) * 8) = w[i];
            }
        }
        __syncthreads();
#pragma unroll
        for (int hf = 0; hf < 2; ++hf) {
            unsigned vb = (unsigned)(size_t)(kl + (128 * hf + fr) * RS + 8 * fq); asm volatile("" : "+v"(vb));
#pragma unroll
            for (int n8 = 0; n8 < 8; ++n8) { const int n = 8 * hf + n8; f32x4 o0 = (f32x4){0.f, 0.f, 0.f, 0.f}, o1 = o0;
#pragma unroll
                for (int s = 0; s < 8; ++s) { const bf16x8 vf = *(const LAS bf16x8*)(size_t)(vb + (unsigned)((16 * n8 * RS + 32 * s) * 2));
                    o0 = __builtin_amdgcn_mfma_f32_16x16x32_bf16(vf, pf0[s], o0, 0, 0, 0);
                    o1 = __builtin_amdgcn_mfma_f32_16x16x32_bf16(vf, pf1[s], o1, 0, 0, 0); }
                u32x2 w0, w1; w0.x = pk2(o0.x * inv0, o0.y * inv0); w0.y = pk2(o0.z * inv0, o0.w * inv0); w1.x = pk2(o1.x * inv1, o1.y * inv1); w1.y = pk2(o1.z * inv1, o1.w * inv1);
                *(u32x2*)(OX + tok0 * 1024 + h * 256 + 16 * n + 4 * fq) = w0;
                *(u32x2*)(OX + (tok0 + 16) * 1024 + h * 256 + 16 * n + 4 * fq) = w1;
                if (n & 1) asm volatile("" ::: "memory"); }
        }
    }
    __syncthreads();
}

__device__ __forceinline__ void phase_route(KArgs A, int wv_, int L, LAS unsigned char* lds) {
    const int tid_ = opaque_tid(wv_); const int wid = __builtin_amdgcn_readfirstlane(tid_ >> 6), lane = tid_ & 63;
    unsigned char* ws = opq(A->ws);
    const float* RW = (const float*)(ws + WS_RW) + (size_t)L * NEXP * D;
    unsigned* cnt = (unsigned*)(ws + WS_CTL) + CW_CNT + L * 64;
    int* list = (int*)(ws + WS_LIST); int* te = (int*)(ws + WS_TOK); int* tp = te + 2 * T; float* tw = (float*)(tp + 2 * T);
    bf16* XN = (bf16*)(ws + WS_XN);
    LAS float* rwl = (LAS float*)lds;
    LAS unsigned* lcnt = (LAS unsigned*)(lds + 65536);
    LAS unsigned* lbase = lcnt + 16;
    const float rbv = A->in[I_RB][lane >> 2];
    for (int e4 = tid_; e4 < NEXP * D / 4; e4 += 512) *(LAS f32x4*)(rwl + 4 * e4) = *(const f32x4*)(RW + 4 * e4);
    for (int blk = blockIdx.x; blk < T / 64; blk += gridDim.x) {
        __syncthreads();
        if (tid_ < 16) lcnt[tid_] = 0u;
        __syncthreads();
        int e0s = 0, e1s = 0, r0s = 0, r1s = 0; float w0s = 0.f;
        f32x4 v[4], vn[4];
#pragma unroll
        for (int j = 0; j < 4; ++j) v[j] = ((const f32x4*)(A->out + (size_t)(blk * 64 + wid * 8) * D) + lane)[64 * j];
#pragma unroll 1
        for (int q = 0; q < 8; ++q) {
            const int t = blk * 64 + wid * 8 + q;
            { const f32x4* xn_ = (const f32x4*)(A->out + (size_t)(t + (q < 7 ? 1 : 0)) * D) + lane;
#pragma unroll
              for (int j = 0; j < 4; ++j) vn[j] = xn_[64 * j]; }
            float s = 0.f;
#pragma unroll
            for (int j = 0; j < 4; ++j) s += (v[j].x * v[j].x + v[j].y * v[j].y) + (v[j].z * v[j].z + v[j].w * v[j].w);
            const float rstd = rsqrtf(wave_sum(s) * (1.f / 1024.f) + EPS);
            u32x2* o8 = (u32x2*)(XN + (size_t)t * D) + lane;
#pragma unroll
            for (int j = 0; j < 4; ++j) { u32x2 w; w.x = pk2(v[j].x * rstd, v[j].y * rstd); w.y = pk2(v[j].z * rstd, v[j].w * rstd); o8[64 * j] = w; }
            float a[16];
#pragma unroll
            for (int e = 0; e < 16; ++e) {
                const LAS f32x4* wr = (const LAS f32x4*)(rwl + e * D) + lane; float acc = 0.f;
#pragma unroll
                for (int j = 0; j < 4; ++j) { const f32x4 w = wr[64 * j]; acc += (v[j].x * w.x + v[j].y * w.y) + (v[j].z * w.z + v[j].w * w.w); }
                a[e] = acc;
            }
            float a8[8], a4[4], a2[2], a1;
            { const bool up = lane & 32;
#pragma unroll
              for (int k = 0; k < 8; ++k) { const float send = up ? a[k] : a[k + 8], keep = up ? a[k + 8] : a[k]; a8[k] = keep + __shfl_xor(send, 32); } }
            { const bool up = lane & 16;
#pragma unroll
              for (int k = 0; k < 4; ++k) { const float send = up ? a8[k] : a8[k + 4], keep = up ? a8[k + 4] : a8[k]; a4[k] = keep + __shfl_xor(send, 16); } }
            { const bool up = lane & 8;
#pragma unroll
              for (int k = 0; k < 2; ++k) { const float send = up ? a4[k] : a4[k + 2], keep = up ? a4[k + 2] : a4[k]; a2[k] = keep + __shfl_xor(send, 8); } }
            { const bool up = lane & 4; const float send = up ? a2[0] : a2[1], keep = up ? a2[1] : a2[0]; a1 = keep + __shfl_xor(send, 4); }
            a1 += __shfl_xor(a1, 2); a1 += __shfl_xor(a1, 1);
            const float lg = a1 * rstd + rbv;
            const float v0 = wave_max(lg);
            const int e0 = (__ffsll((unsigned long long)__ballot(lg == v0)) - 1) >> 2;
            const int gidx = e0 >> 2;
            const bool c2 = (lane >> 4) == gidx && (lane >> 2) != e0;
            const float m2 = c2 ? lg : -INFINITY;
            const float v1 = wave_max(m2);
            const int e1 = (__ffsll((unsigned long long)__ballot(c2 && m2 == v1)) - 1) >> 2;
            const float w0 = 1.f / (1.f + __expf(v1 - v0));
            unsigned r0 = 0, r1 = 0;
            if (lane == 0) { r0 = atomicAdd((unsigned*)(lcnt + e0), 1u); r1 = atomicAdd((unsigned*)(lcnt + e1), 1u); }
            r0 = __builtin_amdgcn_readfirstlane(r0); r1 = __builtin_amdgcn_readfirstlane(r1);
            if (lane == q) { e0s = e0; e1s = e1; r0s = (int)r0; r1s = (int)r1; w0s = w0; }
#pragma unroll
            for (int j = 0; j < 4; ++j) v[j] = vn[j];
        }
        __syncthreads();
        if (tid_ < 16) lbase[tid_] = atomicAdd(&cnt[tid_], lcnt[tid_]);
        __syncthreads();
        if (lane < 8) {
            const int t = blk * 64 + wid * 8 + lane;
            const int p0 = (int)lbase[e0s] + r0s, p1 = (int)lbase[e1s] + r1s;
            list[e0s * T + p0] = t; list[e1s * T + p1] = t;
            te[2 * t] = e0s; te[2 * t + 1] = e1s; tp[2 * t] = p0; tp[2 * t + 1] = p1; tw[2 * t] = w0s; tw[2 * t + 1] = 1.f - w0s;
        }
    }
    __syncthreads();
}
__device__ __forceinline__ void phase_route_mfma(KArgs A, int wv_, int L, LAS unsigned char* lds) {
    const int tid = opaque_tid(wv_), wid = __builtin_amdgcn_readfirstlane(tid >> 6), lane = tid & 63, fr = lane & 15, fq = lane >> 4;
    unsigned char* ws = opq(A->ws);
    const float* RW = (const float*)(ws + WS_RW) + (size_t)L * NEXP * D;
    unsigned* cnt = (unsigned*)(ws + WS_CTL) + CW_CNT + L * 64;
    int* list = (int*)(ws + WS_LIST); int* te = (int*)(ws + WS_TOK); int* tp = te + 2 * T; float* tw = (float*)(tp + 2 * T);
    bf16* XN = (bf16*)(ws + WS_XN);
    constexpr int WSTR = 1032;
    LAS bf16* rwh = (LAS bf16*)lds;
    LAS bf16* rwl = rwh + 16 * WSTR;
    LAS float* xch = (LAS float*)(lds + 2 * 16 * WSTR * 2);
    LAS unsigned* lcnt = (LAS unsigned*)(lds + 2 * 16 * WSTR * 2 + 8 * 320 * 4);
    LAS unsigned* lbase = lcnt + 16;
    for (int e4 = tid; e4 < NEXP * D / 4; e4 += 512) {
        const f32x4 w = *(const f32x4*)(RW + 4 * e4);
        u32x2 h; h.x = pk2(w.x, w.y); h.y = pk2(w.z, w.w);
        u32x2 l; l.x = pk2(w.x - bflo(h.x), w.y - bfhi(h.x)); l.y = pk2(w.z - bflo(h.y), w.w - bfhi(h.y));
        const int e = (4 * e4) >> 10, k = (4 * e4) & 1023;
        *(LAS u32x2*)(rwh + e * WSTR + k) = h; *(LAS u32x2*)(rwl + e * WSTR + k) = l;
    }
    const int tg = wid >> 1, kh = wid & 1;
    const float rbv = A->in[I_RB][fr];
    for (int blk = blockIdx.x; blk < T / 64; blk += gridDim.x) {
        __syncthreads();
        if (tid < 16) lcnt[tid] = 0u;
        const size_t tok = (size_t)blk * 64 + 16 * tg + fr;
        const float* xrow = A->out + tok * D + 512 * kh + 8 * fq;
        f32x4 acc = (f32x4){0.f, 0.f, 0.f, 0.f}; float ssq = 0.f;
        bf16x8 ah[16];
#pragma unroll
        for (int s4 = 0; s4 < 16; s4 += 4) {
            f32x4 xa[4], xb[4];
#pragma unroll
            for (int q = 0; q < 4; ++q) { xa[q] = *(const f32x4*)(xrow + 32 * (s4 + q)); xb[q] = *(const f32x4*)(xrow + 32 * (s4 + q) + 4); }
#pragma unroll
            for (int q = 0; q < 4; ++q) {
                const int s = s4 + q; const f32x4 x0 = xa[q], x1 = xb[q];
                ssq += ((x0.x * x0.x + x0.y * x0.y) + (x0.z * x0.z + x0.w * x0.w)) + ((x1.x * x1.x + x1.y * x1.y) + (x1.z * x1.z + x1.w * x1.w));
                u32x4 hw; hw.x = pk2(x0.x, x0.y); hw.y = pk2(x0.z, x0.w); hw.z = pk2(x1.x, x1.y); hw.w = pk2(x1.z, x1.w);
                u32x4 lw; lw.x = pk2(x0.x - bflo(hw.x), x0.y - bfhi(hw.x)); lw.y = pk2(x0.z - bflo(hw.y), x0.w - bfhi(hw.y)); lw.z = pk2(x1.x - bflo(hw.z), x1.y - bfhi(hw.z)); lw.w = pk2(x1.z - bflo(hw.w), x1.w - bfhi(hw.w));
                ah[s] = __builtin_bit_cast(bf16x8, hw); const bf16x8 al = __builtin_bit_cast(bf16x8, lw);
                const bf16x8 bh = *(const LAS bf16x8*)(rwh + fr * WSTR + 512 * kh + 32 * s + 8 * fq), bl = *(const LAS bf16x8*)(rwl + fr * WSTR + 512 * kh + 32 * s + 8 * fq);
                acc = __builtin_amdgcn_mfma_f32_16x16x32_bf16(ah[s], bh, acc, 0, 0, 0);
                acc = __builtin_amdgcn_mfma_f32_16x16x32_bf16(ah[s], bl, acc, 0, 0, 0);
                acc = __builtin_amdgcn_mfma_f32_16x16x32_bf16(al, bh, acc, 0, 0, 0);
            }
        }
        ssq += __shfl_xor(ssq, 16); ssq += __shfl_xor(ssq, 32);
        LAS float* mine = xch + wid * 320; const LAS float* other = xch + (wid ^ 1) * 320;
#pragma unroll
        for (int r = 0; r < 4; ++r) mine[(4 * fq + r) * 20 + fr] = acc[r];
        if (fq == 0) mine[fr * 20 + 16] = ssq;
        __syncthreads();
        const float rstd = rsqrtf((ssq + other[fr * 20 + 16]) * (1.f / 1024.f) + EPS);
        {
            bf16* xo = XN + tok * D + 512 * kh + 8 * fq;
#pragma unroll
            for (int s = 0; s < 16; ++s) { const u32x4 hw = __builtin_bit_cast(u32x4, ah[s]);
                u32x4 o; o.x = pk2(bflo(hw.x) * rstd, bfhi(hw.x) * rstd); o.y = pk2(bflo(hw.y) * rstd, bfhi(hw.y) * rstd); o.z = pk2(bflo(hw.z) * rstd, bfhi(hw.z) * rstd); o.w = pk2(bflo(hw.w) * rstd, bfhi(hw.w) * rstd);
                *(u32x4*)(xo + 32 * s) = o; }
        }
        int e0r[4], e1r[4], r0r[4], r1r[4]; float w0r[4];
        if (kh == 0) {
#pragma unroll
            for (int r = 0; r < 4; ++r) {
                const float rs = __shfl(rstd, 4 * fq + r);
                const float lg = (acc[r] + other[(4 * fq + r) * 20 + fr]) * rs + rbv;
                float v0 = lg; v0 = fmaxf(v0, __shfl_xor(v0, 1)); v0 = fmaxf(v0, __shfl_xor(v0, 2)); v0 = fmaxf(v0, __shfl_xor(v0, 4)); v0 = fmaxf(v0, __shfl_xor(v0, 8));
                const unsigned long long bm0 = __ballot(lg == v0);
                const int e0 = __ffs((unsigned)(bm0 >> (16 * fq)) & 0xffffu) - 1;
                const bool c2 = (fr >> 2) == (e0 >> 2) && fr != e0;
                const float m2 = c2 ? lg : -INFINITY;
                float v1 = m2; v1 = fmaxf(v1, __shfl_xor(v1, 1)); v1 = fmaxf(v1, __shfl_xor(v1, 2)); v1 = fmaxf(v1, __shfl_xor(v1, 4)); v1 = fmaxf(v1, __shfl_xor(v1, 8));
                const unsigned long long bm1 = __ballot(c2 && m2 == v1);
                const int e1 = __ffs((unsigned)(bm1 >> (16 * fq)) & 0xffffu) - 1;
                e0r[r] = e0; e1r[r] = e1; w0r[r] = 1.f / (1.f + __expf(v1 - v0));
                r0r[r] = 0; r1r[r] = 0;
                if (fr == 0) { r0r[r] = (int)atomicAdd((unsigned*)(lcnt + e0), 1u); r1r[r] = (int)atomicAdd((unsigned*)(lcnt + e1), 1u); }
            }
        }
        __syncthreads();
        if (tid < 16) lbase[tid] = atomicAdd(&cnt[tid], lcnt[tid]);
        __syncthreads();
        if (kh == 0 && fr == 0) {
#pragma unroll
            for (int r = 0; r < 4; ++r) {
                const int t = blk * 64 + 16 * tg + 4 * fq + r;
                const int p0 = (int)lbase[e0r[r]] + r0r[r], p1 = (int)lbase[e1r[r]] + r1r[r];
                list[e0r[r] * T + p0] = t; list[e1r[r] * T + p1] = t;
                te[2 * t] = e0r[r]; te[2 * t + 1] = e1r[r]; tp[2 * t] = p0; tp[2 * t + 1] = p1; tw[2 * t] = w0r[r]; tw[2 * t + 1] = 1.f - w0r[r];
            }
        }
    }
    __syncthreads();
}

__device__ __forceinline__ void moe_offsets(KArgs A, int wv_, int L, LAS int* off, LAS int* cn) {
    if (opaque_tid(wv_) == 0) {
        const unsigned* cnt = (const unsigned*)(opq(A->ws) + WS_CTL) + CW_CNT + L * 64;
        int o = 0;
        for (int e = 0; e < 16; ++e) { const int c = (int)__hip_atomic_load(cnt + e, __ATOMIC_RELAXED, __HIP_MEMORY_SCOPE_AGENT); off[e] = o; cn[e] = c; o += (c + 255) & ~255; }
        off[16] = o;
    }
    __syncthreads();
}
__device__ __forceinline__ void phase_moe_combine(KArgs A, int wv_, int L, LAS unsigned char* lds) {
    LAS int* off = (LAS int*)lds; LAS int* cn = off + 32;
    moe_offsets(A, wv_, L, off, cn);
    const int tid_ = opaque_tid(wv_); const int wid = __builtin_amdgcn_readfirstlane(tid_ >> 6), lane = tid_ & 63; const int gw = blockIdx.x * 8 + wid, NGW = gridDim.x * 8;
    unsigned char* ws = opq(A->ws);
    const int* te = (const int*)(ws + WS_TOK); const int* tp = te + 2 * T; const float* tw = (const float*)(tp + 2 * T);
    const bf16* Y = (const bf16*)(ws + WS_Y); bf16* XN = (bf16*)(ws + WS_XN);
    const int nq = (T - gw + NGW - 1) / NGW;
    for (int q0 = 0; q0 < nq; q0 += 8) {
        int s0m = 0, s1m = 0; float w0m = 0.f, w1m = 0.f;
        { const int qq = q0 + (lane & 7); const int t = gw + NGW * (qq < nq ? qq : nq - 1);
          s0m = off[te[2 * t]] + tp[2 * t]; s1m = off[te[2 * t + 1]] + tp[2 * t + 1]; w0m = tw[2 * t]; w1m = tw[2 * t + 1]; }
        const int nn = nq - q0 < 8 ? nq - q0 : 8;
        f32x4 v[4], vn[4]; u32x2 ya[4], yb[4], yan[4], ybn[4];
        { const int t = gw + NGW * q0; const int sl0 = __builtin_amdgcn_readlane(s0m, 0), sl1 = __builtin_amdgcn_readlane(s1m, 0);
#pragma unroll
          for (int j = 0; j < 4; ++j) { v[j] = ((const f32x4*)(A->out + (size_t)t * D) + lane)[64 * j]; ya[j] = ((const u32x2*)(Y + (size_t)sl0 * D) + lane)[64 * j]; yb[j] = ((const u32x2*)(Y + (size_t)sl1 * D) + lane)[64 * j]; } }
#pragma unroll 1
        for (int q = 0; q < nn; ++q) {
            const int t = gw + NGW * (q0 + q);
            const int qn = q + 1 < nn ? q + 1 : q;
            { const int tn = gw + NGW * (q0 + qn); const int sl0 = __builtin_amdgcn_readlane(s0m, qn), sl1 = __builtin_amdgcn_readlane(s1m, qn);
#pragma unroll
              for (int j = 0; j < 4; ++j) { vn[j] = ((const f32x4*)(A->out + (size_t)tn * D) + lane)[64 * j]; yan[j] = ((const u32x2*)(Y + (size_t)sl0 * D) + lane)[64 * j]; ybn[j] = ((const u32x2*)(Y + (size_t)sl1 * D) + lane)[64 * j]; } }
            const float w0 = __builtin_bit_cast(float, __builtin_amdgcn_readlane(__builtin_bit_cast(int, w0m), q)), w1 = __builtin_bit_cast(float, __builtin_amdgcn_readlane(__builtin_bit_cast(int, w1m), q));
            float s = 0.f;
#pragma unroll
            for (int j = 0; j < 4; ++j) {
                v[j].x += w0 * bflo(ya[j].x) + w1 * bflo(yb[j].x); v[j].y += w0 * bfhi(ya[j].x) + w1 * bfhi(yb[j].x); v[j].z += w0 * bflo(ya[j].y) + w1 * bflo(yb[j].y); v[j].w += w0 * bfhi(ya[j].y) + w1 * bfhi(yb[j].y);
                s += (v[j].x * v[j].x + v[j].y * v[j].y) + (v[j].z * v[j].z + v[j].w * v[j].w);
            }
            const float rstd = rsqrtf(wave_sum(s) * (1.f / 1024.f) + EPS);
            f32x4* xr = (f32x4*)(A->out + (size_t)t * D) + lane; u32x2* o8 = (u32x2*)(XN + (size_t)t * D) + lane;
#pragma unroll
            for (int j = 0; j < 4; ++j) { xr[64 * j] = v[j]; u32x2 w; w.x = pk2(v[j].x * rstd, v[j].y * rstd); w.y = pk2(v[j].z * rstd, v[j].w * rstd); o8[64 * j] = w; }
#pragma unroll
            for (int j = 0; j < 4; ++j) { v[j] = vn[j]; ya[j] = yan[j]; yb[j] = ybn[j]; }
        }
    }
}

constexpr int PH_PER_EVEN = 5 + 6, PH_PER_ODD = 3 + 6;
constexpr int NPHASES = 1 + 2 * (PH_PER_EVEN + PH_PER_ODD);

__global__ void __launch_bounds__(512, 2) mk_fwd(Args Araw) {
    KArgs A0 = kargs();
    extern __shared__ __attribute__((aligned(16))) unsigned char lds_raw[];
    LAS unsigned char* lds = (LAS unsigned char*)lds_raw;
    volatile LAS unsigned* misc = (volatile LAS unsigned*)(lds + LDS_MISC);
    const int tid = threadIdx.x;
    if (tid < 16) misc[tid] = 0u;
    __syncthreads();
    const int lo = A0->ph_lo, hi = A0->ph_hi;
    const int wv_ = __builtin_amdgcn_readfirstlane(threadIdx.x >> 6);
    if (hi - lo > 1) (void)xcd_barrier_post((unsigned*)(A0->ws + WS_CTL) + CW_BAR, misc);
    int ph = 0;
    unsigned long long tacc_ = 0;
#define PH_BEGIN(k) if (ph >= lo && ph < hi) { const bool tprobe_ = (PROBE_TMASK >> (k)) & 1; unsigned long long tp0_ = 0; if (PROBE_TMASK && tprobe_) tp0_ = __builtin_amdgcn_s_memrealtime(); KArgs A = kargs(); unsigned char* ws = opq(A->ws); _Pragma("unroll 1") for (int rep_ = 0; rep_ < (((PROBE_MASK >> (k)) & 1) ? PROBE_REPS : 1); ++rep_)
#define PH_END   if (ph + 1 < hi) { XcdBarrier b_; b_.bar = (unsigned*)(opq(kargs()->ws) + WS_CTL) + CW_BAR; b_.x = xb_xcc_id(); b_.st = misc; xcd_barrier(b_, opaque_tid(wv_) == 0); } if (PROBE_TMASK && tprobe_) tacc_ += __builtin_amdgcn_s_memrealtime() - tp0_; } ++ph;
    const int G = gridDim.x, cb = blockIdx.x;

    PH_BEGIN(0) phase_prologue(A, wv_, lds); PH_END
    for (int L = 0; L < DEPTH; ++L) {
        const int i = L >> 1;
        if ((L & 1) == 0) {
            PH_BEGIN(3) {
                if (L == 0) {
                    pg8::DenseOrder S; S.init(NBATCH * NMEM, 8192, D, (const bf16*)(ws + WS_WKV), G, cb);
                    pg8::EpiBf16<0> E{(bf16*)(ws + WS_KV), 8192, 32, 0, nullptr, 0};
                    pg8::gemm_phase(lds, (const bf16*)(ws + WS_MN), D, S, E, wv_);
                }
                pg8::DenseOrder S; S.init(T, HYN, D, (const bf16*)(ws + WS_WHYB) + (size_t)i * HYN * D, G, cb);
                pg8::EpiBf16<0> E{(bf16*)(ws + WS_BIG), HYN, 12, 0, nullptr, 0};
                pg8::gemm_phase(lds, (const bf16*)(ws + WS_XN), D, S, E, wv_);
            } PH_END
            PH_BEGIN(4) { const int t4_ = opaque_tid(wv_); SUBT_BEGIN(4); SUBT_END(4, ws, t4_); SUBT_BEGIN(5); phase_compress_mfma(A, wv_, i, lds); SUBT_END(5, ws, t4_); SUBT_BEGIN(6); phase_nsa_prep(A, wv_, i, lds); SUBT_END(6, ws, t4_); SUBT_BEGIN(7); phase_vtiles(A, wv_, lds); SUBT_END(7, ws, t4_); } PH_END
            PH_BEGIN(5) { phase_gla_a(A, wv_, i, lds); __syncthreads(); phase_nsa_attn_mfma(A, wv_, i, lds); } PH_END
            PH_BEGIN(6) phase_gla_c(A, wv_, i, lds, L == 0); PH_END
            PH_BEGIN(7) {
                pg8::DenseOrder S; S.init(T, D, D, (const bf16*)(ws + WS_WHOUT) + (size_t)i * D * D, G, cb);
                pg8::EpiResAddNorm E{A->out, D, (bf16*)(ws + WS_XN), (float*)(ws + WS_ROWSQ)};
                pg8::gemm_phase(lds, (const bf16*)(ws + WS_CAT), D, S, E, wv_);
            } PH_END
        } else {
            PH_BEGIN(8) {
                pg8::DenseOrder S; S.init(T, 4096, D, (const bf16*)(ws + WS_WSGIN) + (size_t)i * 4096 * D, G, cb);
                pg8::EpiBf16<1> E{(bf16*)(ws + WS_U), 2048, 8, (size_t)(WS_V - WS_U) / 2, (float*)(ws + WS_VSTAT), 8};
                pg8::gemm_phase(lds, (const bf16*)(ws + WS_XN), D, S, E, wv_);
            } PH_END
            PH_BEGIN(9) phase_sgu_mix_mfma(A, wv_, i, lds); PH_END
            PH_BEGIN(10) {
                pg8::DenseOrder S; S.init(T, D, 2048, (const bf16*)(ws + WS_WSGOUT) + (size_t)i * D * 2048, G, cb);
                pg8::EpiResAddNorm E{A->out, D, (bf16*)(ws + WS_XN), (float*)(ws + WS_ROWSQ)};
                pg8::gemm_phase(lds, (const bf16*)(ws + WS_UM), 2048, S, E, wv_);
            } PH_END
        }
        PH_BEGIN(12) {
            pg8::DenseOrder S; S.init(T, D, D, (const bf16*)(ws + WS_WQ) + (size_t)L * D * D, G, cb);
            pg8::EpiBf16RowScale E{(bf16*)(ws + WS_QX), D, (const float*)(ws + WS_ROWSQ)};
            pg8::gemm_phase(lds, (const bf16*)(ws + WS_XN), D, S, E, wv_);
            asm volatile("s_waitcnt vmcnt(0)" ::: "memory");
            __syncthreads();
            pg8::Unit u_;
#pragma unroll 1
            for (int ui_ = 0; S.next(ui_, u_); ++ui_) xattn_item(A, wv_, L, lds, u_.pm >> 3, u_.pn, u_.pm & 7);
        } PH_END
        PH_BEGIN(14) {
            pg8::DenseOrder S; S.init(T, D, D, (const bf16*)(ws + WS_WO) + (size_t)L * D * D, G, cb);
            pg8::EpiResAdd E{A->out, D};
            pg8::gemm_phase(lds, (const bf16*)(ws + WS_OX), D, S, E, wv_);
        } PH_END
        PH_BEGIN(15) phase_route_mfma(A, wv_, L, lds); PH_END
        PH_BEGIN(16) {
            LAS int* off = (LAS int*)(lds + pg8::STAGE_BYTES); LAS int* cn = off + 32;
            moe_offsets(A, wv_, L, off, cn);
            pg8::MoeOrder<true> S{(off[16] / 256) * 3, 3, G, cb, D, off, cn, (const int*)(ws + WS_LIST), (const char*)(ws + WS_WMIN) + (size_t)L * 16 * 768 * D * 2, (size_t)768 * D * 2};
            pg8::EpiSwiglu E{(bf16*)(ws + WS_H), DEXP};
            pg8::gemm_phase(lds, (const bf16*)(ws + WS_XN), D, S, E, wv_);
        } PH_END
        PH_BEGIN(17) {
            LAS int* off = (LAS int*)(lds + pg8::STAGE_BYTES); LAS int* cn = off + 32;
            moe_offsets(A, wv_, L, off, cn);
            pg8::MoeOrder<false> S{(off[16] / 256) * 4, 4, G, cb, DEXP, off, cn, (const int*)(ws + WS_LIST), (const char*)(ws + WS_WMOUT) + (size_t)L * 16 * D * DEXP * 2, (size_t)D * DEXP * 2};
            pg8::EpiBf16<0> E{(bf16*)(ws + WS_Y), D, 4, 0, nullptr, 0};
            pg8::gemm_phase(lds, (const bf16*)(ws + WS_H), DEXP, S, E, wv_);
        } PH_END
        PH_BEGIN(18) phase_moe_combine(A, wv_, L, lds); PH_END
    }
#undef PH_BEGIN
#undef PH_END
    if (hi - lo > 1) { for (int q_ = 0; q_ < PROBE_XBAR; ++q_) { XcdBarrier b_; b_.bar = (unsigned*)(opq(kargs()->ws) + WS_CTL) + CW_BAR; b_.x = xb_xcc_id(); b_.st = misc; xcd_barrier(b_, opaque_tid(wv_) == 0); } }
    if ((PROBE_NSA || PROBE_SUB) && blockIdx.x == 0) { const unsigned long long d_ = __hip_atomic_load((unsigned long long*)(A0->ws + WS_CTL + 48000), __ATOMIC_RELAXED, __HIP_MEMORY_SCOPE_AGENT); const unsigned long long t0 = __builtin_amdgcn_s_memrealtime(); while (__builtin_amdgcn_s_memrealtime() - t0 < d_) __builtin_amdgcn_s_sleep(8); }
    if (PROBE_TMASK && blockIdx.x == 0) { const unsigned long long t0 = __builtin_amdgcn_s_memrealtime(); while (__builtin_amdgcn_s_memrealtime() - t0 < tacc_) __builtin_amdgcn_s_sleep(8); }
}

extern "C" void kernel_launch(void* const* d_in, const int* in_sizes, int n_in, void* d_out, int out_size, void* d_ws, size_t ws_size, hipStream_t stream) {
    static int grid = 0;
    if (grid == 0) {
        if (n_in != N_IN || out_size != T * D || ws_size < WS_END) { fprintf(stderr, "kernel_launch: unexpected problem (n_in %d, out %d, ws %zu)\n", n_in, out_size, ws_size); grid = -1; return; }
        int dev = 0, cus = 0, per_cu = 0;
        if (hipGetDevice(&dev) != hipSuccess || hipDeviceGetAttribute(&cus, hipDeviceAttributeMultiprocessorCount, dev) != hipSuccess) { grid = -1; return; }
        if (hipFuncSetAttribute((const void*)mk_fwd, hipFuncAttributeMaxDynamicSharedMemorySize, LDS_BYTES) != hipSuccess) { fprintf(stderr, "kernel_launch: hipFuncSetAttribute failed\n"); grid = -1; return; }
        if (hipOccupancyMaxActiveBlocksPerMultiprocessor(&per_cu, (const void*)mk_fwd, 512, LDS_BYTES) != hipSuccess || per_cu < 1) fprintf(stderr, "kernel_launch: occupancy query says %d\n", per_cu);
        (void)hipGetLastError();
        grid = cus;
    }
    if (grid < 0) return;
    (void)hipMemsetAsync((char*)d_ws + WS_CTL, 0, CTL_BYTES, stream);
    Args a{};
    for (int i = 0; i < N_IN; ++i) a.in[i] = (const float*)d_in[i];
    a.out = (float*)d_out; a.ws = (unsigned char*)d_ws;
    for (int j = 0; j < 32; ++j) a.freq[j] = (float)pow(10000.0, -(double)j / 32.0);
#if MK_ONE_LAUNCH
    a.ph_lo = 0; a.ph_hi = NPHASES;
    hipLaunchKernelGGL(mk_fwd, dim3(grid), dim3(512), LDS_BYTES, stream, a);
#else
    for (int p = 0; p < NPHASES; ++p) { a.ph_lo = p; a.ph_hi = p + 1; hipLaunchKernelGGL(mk_fwd, dim3(grid), dim3(512), LDS_BYTES, stream, a); }
#endif
}
```

```cpp
#include <hip/hip_runtime.h>
#include <stdint.h>
#include <stdio.h>
#include <math.h>

#ifndef PROBE_MASK
#define PROBE_MASK 0
#endif
#ifndef PROBE_TMASK
#define PROBE_TMASK 0
#endif
#ifndef PROBE_NSA
#define PROBE_NSA 0
#endif
#ifndef PROBE_SUB
#define PROBE_SUB 0
#endif
#ifndef PROBE_XBAR
#define PROBE_XBAR 0
#endif
#ifndef PROBE_NSAX
#define PROBE_NSAX 0
#endif
#ifndef PROBE_REPS
#define PROBE_REPS 2
#endif
#ifndef MK_ONE_LAUNCH
#define MK_ONE_LAUNCH 1
#endif

#define LAS __attribute__((address_space(3)))
typedef unsigned short bf16;
typedef short bf16x8 __attribute__((ext_vector_type(8)));
typedef float f32x4 __attribute__((ext_vector_type(4)));
typedef float f32x2 __attribute__((ext_vector_type(2)));
typedef unsigned u32x4 __attribute__((ext_vector_type(4)));
typedef unsigned u32x2 __attribute__((ext_vector_type(2)));

constexpr int T = 16384, D = 1024, NBATCH = 8, S = 2048, DEPTH = 4;
constexpr int NMEM = 256;
constexpr float EPS = 1e-6f;
constexpr int HYN = 3072, HYSRC = 2856;
constexpr int C_QA = 0, C_KC = 512, C_VC = 640, C_KS = 768, C_VS = 896, C_KW = 1024, C_VW = 1152, C_QB = 1280, C_KB = 1536, C_VB = 1792, C_RB = 2304, C_GA = 2816, C_AL = 2840;
constexpr int NCMP = 127;
constexpr int NEXP = 16, DEXP = 384;
constexpr int SLOTS = 2 * T + NEXP * 256;

enum { I_X = 0, I_MEM, I_POS, I_NMIX, I_NXAT, I_NMEM, I_NFFN, I_HYBIN, I_HYBOUT, I_QNORM, I_KNORM, I_CMPPE, I_CMPW1, I_CMPW2, I_GATEB, I_WA2, I_BA, I_ONORM,
       I_SGIN, I_LNG, I_LNB, I_SGWS, I_SGBS, I_SGOUT, I_XWQ, I_XWKV, I_XWO, I_XQN, I_XKN, I_RW, I_RB, I_MOEIN, I_MOEOUT, N_IN };

constexpr size_t MiB = 1u << 20;
constexpr size_t WS_CTL = 0, CTL_BYTES = 1 * MiB;
constexpr size_t WS_WHYB = 1 * MiB;
constexpr size_t WS_WHOUT = WS_WHYB + 12 * MiB;
constexpr size_t WS_WSGIN = WS_WHOUT + 4 * MiB;
constexpr size_t WS_WSGOUT = WS_WSGIN + 16 * MiB;
constexpr size_t WS_WQ = WS_WSGOUT + 8 * MiB;
constexpr size_t WS_WKV = WS_WQ + 8 * MiB;
constexpr size_t WS_WO = WS_WKV + 16 * MiB;
constexpr size_t WS_WMIN = WS_WO + 8 * MiB;
constexpr size_t WS_WMOUT = WS_WMIN + 96 * MiB;
constexpr size_t WS_RW = WS_WMOUT + 48 * MiB;
constexpr size_t WS_XN = WS_RW + 1 * MiB;
constexpr size_t WS_BIG = WS_XN + 32 * MiB;
constexpr size_t WS_QA = WS_BIG + 128 * MiB;
constexpr size_t WS_KS = WS_QA + 16 * MiB;
constexpr size_t WS_KW = WS_KS + 4 * MiB;
constexpr size_t WS_KC = WS_KW + 4 * MiB;
constexpr size_t WS_VC = WS_KC + 1 * MiB;
constexpr size_t WS_CAT = WS_VC + 1 * MiB;
constexpr size_t WS_QX = WS_CAT + 32 * MiB;
constexpr size_t WS_OX = WS_QX + 32 * MiB;
constexpr size_t WS_MN = WS_OX + 32 * MiB;
constexpr size_t WS_KV = WS_MN + 4 * MiB;
constexpr size_t WS_COS = WS_KV + 32 * MiB;
constexpr size_t WS_SIN = WS_COS + 2 * MiB;
constexpr size_t WS_LIST = WS_SIN + 2 * MiB;
constexpr size_t WS_TOK = WS_LIST + 1 * MiB;
constexpr size_t WS_VT = WS_TOK + 1 * MiB;
constexpr size_t WS_VTA = WS_VT + 16 * MiB;
constexpr size_t WS_SLOC = WS_VTA + 32 * MiB;
constexpr size_t WS_DEC = WS_SLOC + 32 * MiB;
constexpr size_t WS_STT = WS_DEC + 1 * MiB;
constexpr size_t WS_WSB = WS_STT + 16 * MiB;
constexpr size_t WS_M0 = WS_WSB + 768 * 1024;
constexpr size_t WS_W1T = WS_WSB + 1 * MiB;
constexpr size_t WS_ROWSQ = WS_W1T + 1 * MiB;
constexpr size_t WS_VSTAT = WS_ROWSQ + 1 * MiB;
constexpr size_t WS_END = WS_VSTAT + 4 * MiB;
constexpr size_t WS_Y = WS_BIG, WS_H = WS_BIG + 72 * MiB, WS_U = WS_BIG, WS_V = WS_BIG + 64 * MiB, WS_UM = WS_QX;
constexpr int CW_BAR = 4096;
constexpr int CW_CNT = 8192;

constexpr int LDS_BYTES = 159744;
constexpr int LDS_MISC = LDS_BYTES - 64;

typedef __bf16 bf16x2_t __attribute__((ext_vector_type(2)));
__device__ __forceinline__ unsigned pk2(float lo, float hi) { const f32x2 v = {lo, hi}; return __builtin_bit_cast(unsigned, __builtin_convertvector(v, bf16x2_t)); }
__device__ __forceinline__ unsigned f2bf(float f) { return (unsigned)__builtin_bit_cast(unsigned short, (__bf16)f); }
__device__ __forceinline__ float bf2f(unsigned b) { return __uint_as_float(b << 16); }
__device__ __forceinline__ float bflo(unsigned w) { return __uint_as_float(w << 16); }
__device__ __forceinline__ float bfhi(unsigned w) { return __uint_as_float(w & 0xffff0000u); }
__device__ __forceinline__ float wave_sum(float v) {
#pragma unroll
    for (int o = 1; o < 64; o <<= 1) v += __shfl_xor(v, o);
    return v;
}
__device__ __forceinline__ float wave_max(float v) {
#pragma unroll
    for (int o = 1; o < 64; o <<= 1) v = fmaxf(v, __shfl_xor(v, o));
    return v;
}
__device__ __forceinline__ int opaque_tid(int wv) { int l; asm volatile("v_mbcnt_lo_u32_b32 %0, -1, 0\n\tv_mbcnt_hi_u32_b32 %0, -1, %0" : "=v"(l)); return wv * 64 + l; }
__device__ __forceinline__ unsigned char* opq(unsigned char* p) { asm volatile("" : "+s"(p)); return p; }
#define LDS_WAIT() asm volatile("s_waitcnt lgkmcnt(0)" ::: "memory")
__device__ __forceinline__ float gelu_tanh(float x) {
    const float u2 = x * (1.5957691216057308f + 0.07135481283f * x * x);
    return x * __builtin_amdgcn_rcpf(1.0f + __expf(-u2));
}
__device__ __forceinline__ float sigmoidf_(float x) { return __builtin_amdgcn_rcpf(1.0f + __expf(-x)); }

#define SUBT_BEGIN(id) unsigned long long subt_##id = 0; if (PROBE_SUB == (id)) subt_##id = __builtin_amdgcn_s_memrealtime();
#define SUBT_END(id, wsp, tidv) do { if (PROBE_SUB == (id) && blockIdx.x == 0 && (tidv) == 0) atomicAdd((unsigned long long*)((wsp) + WS_CTL + 48000), __builtin_amdgcn_s_memrealtime() - subt_##id); } while (0)
#define XB_TMO      128
#define XB_XCNT(j)  (256  + 64 * (j))
#define XB_XSUB(j)  (1280 + 64 * (j))
#define XB_XGEN(j)  (2304 + 64 * (j))
#define XB_TOP      3328
#define XB_TOPGEN   3392
#define XCD_BAR_WORDS 3456
#define XB_SPIN_CAP (1u << 22)

__device__ __forceinline__ unsigned xb_ld(unsigned* p)              { return __hip_atomic_load(p, __ATOMIC_RELAXED, __HIP_MEMORY_SCOPE_AGENT); }
__device__ __forceinline__ unsigned xb_add(unsigned* p, unsigned v) { return __hip_atomic_fetch_add(p, v, __ATOMIC_RELAXED, __HIP_MEMORY_SCOPE_AGENT); }
__device__ __forceinline__ unsigned xb_xcc_id() { return (unsigned)__builtin_amdgcn_s_getreg((3 << 11) | 20) & 0xFu; }
#define XB_SPIN(cond, bar) do { unsigned _sp = 0; while (cond) { __builtin_amdgcn_s_sleep(1); \
    if ((++_sp & 255u) == 0u) { if (xb_ld(&(bar)[XB_TMO])) break; if (_sp > XB_SPIN_CAP) { atomicAdd(&(bar)[XB_TMO], 1u); break; } } } } while (0)

struct XcdBarrier { unsigned* bar; unsigned x; volatile LAS unsigned* st; };
__device__ __forceinline__ unsigned* xb_opaque(unsigned* p) { unsigned long long v = (unsigned long long)p; unsigned lo = __builtin_amdgcn_readfirstlane((unsigned)v), hi = __builtin_amdgcn_readfirstlane((unsigned)(v >> 32));
    asm volatile("" : "+s"(lo), "+s"(hi)); return (unsigned*)(((unsigned long long)hi << 32) | lo); }

__device__ __forceinline__ XcdBarrier xcd_barrier_post(unsigned* bar, volatile LAS unsigned* st) {
    XcdBarrier b; b.bar = bar; b.x = xb_xcc_id(); b.st = st;
    if (threadIdx.x == 0) (void)xb_add(&bar[XB_XCNT(b.x)], 1u);
    return b;
}
__device__ __forceinline__ void xcd_barrier_complete(unsigned* bar, unsigned x, unsigned& nloc, unsigned& nx) {
    const unsigned G = gridDim.x * gridDim.y * gridDim.z;
    unsigned sum, cnt, mine, sp = 0u;
    for (;;) {
        sum = 0u; cnt = 0u; mine = 0u;
#pragma unroll
        for (unsigned j = 0; j < 16; ++j) { const unsigned c = xb_ld(&bar[XB_XCNT(j)]); sum += c; cnt += (c > 0u) ? 1u : 0u; mine = (j == x) ? c : mine; }
        if (sum == G) break;
        __builtin_amdgcn_s_sleep(1);
        if ((++sp & 255u) == 0u) { if (xb_ld(&bar[XB_TMO])) break; if (sp > XB_SPIN_CAP) { atomicAdd(&bar[XB_TMO], 1u); break; } }
    }
    nloc = mine > 0u ? mine : 1u; nx = cnt > 0u ? cnt : 1u;
}
__device__ __forceinline__ void xcd_barrier(const XcdBarrier& b, const bool is_t0) {
    asm volatile("s_waitcnt vmcnt(0)" ::: "memory");
    __syncthreads();
    if (is_t0) {
        unsigned* bar = b.bar;
        __builtin_amdgcn_s_waitcnt(0);
        unsigned nloc = b.st[0], nx = b.st[1];
        if (nloc == 0u) { xcd_barrier_complete(bar, b.x, nloc, nx); b.st[0] = nloc; b.st[1] = nx; }
        const unsigned old = xb_add(&bar[XB_XSUB(b.x)], 1u);
        const unsigned gen = old / nloc;
        if (old + 1u == (gen + 1u) * nloc) {
            __builtin_amdgcn_fence(__ATOMIC_RELEASE, "agent");
            asm volatile("s_waitcnt vmcnt(0)" ::: "memory");
            const unsigned og = xb_add(&bar[XB_TOP], 1u);
            const unsigned tg = og / nx;
            if (og + 1u == (tg + 1u) * nx) xb_add(&bar[XB_TOPGEN], 1u);
            else XB_SPIN(xb_ld(&bar[XB_TOPGEN]) == tg, bar);
            __builtin_amdgcn_fence(__ATOMIC_ACQUIRE, "agent");
            xb_add(&bar[XB_XGEN(b.x)], 1u);
            asm volatile("s_waitcnt vmcnt(0)" ::: "memory");
        } else {
            XB_SPIN(xb_ld(&bar[XB_XGEN(b.x)]) == gen, bar);
            __builtin_amdgcn_fence(__ATOMIC_ACQUIRE, "agent");
            asm volatile("s_waitcnt vmcnt(0)" ::: "memory");
        }
    }
    __syncthreads();
}

struct Args {
    const float* in[N_IN];
    float* out;
    unsigned char* ws;
    float freq[32];
    int ph_lo, ph_hi;
};

typedef const __attribute__((address_space(4))) Args* KArgs;
__device__ __forceinline__ KArgs kargs() { KArgs p = (KArgs)__builtin_amdgcn_kernarg_segment_ptr(); asm volatile("" : "+s"(p)); return p; }

__device__ __forceinline__ void st_bf16x4(bf16* p, f32x4 v) { u32x2 w; w.x = pk2(v[0], v[1]); w.y = pk2(v[2], v[3]); *(u32x2*)p = w; }


namespace pg8 {
constexpr int BM = 256, BK = 64, HALF = 128, HTB = HALF * BK * 2, STAGE_BYTES = 8 * HTB, NXCD = 8, WGM = 8;
__host__ __device__ __forceinline__ int lds_byte(int r, int c) { const int st = (r >> 4) * 2 + (c >> 5), rr = r & 15, cc = c & 31, ob = rr * 64 + cc * 2; return st * 1024 + (ob ^ (((ob >> 9) & 1) << 5)); }
__host__ __device__ __forceinline__ void stage_rc(int b, int& R, int& C) { const int st = b / 1024, sb = b % 1024, swz = sb ^ (((sb >> 9) & 1) << 5); R = (st >> 1) * 16 + swz / 64; C = (st & 1) * 32 + (swz % 64) / 2; }
__host__ __device__ __forceinline__ int perm32(int rho) { const int n = rho >> 4, i = rho & 15; return 8 * (i >> 2) + 4 * n + (i & 3); }
struct Unit { int pm, pn, e; };
struct DenseOrder {
    static constexpr bool GATHER = false;
    int nM, nN, nwg, G, c, K; const char* Bt;
    __device__ __forceinline__ void init(int M, int N, int K_, const bf16* Bt_, int G_, int c_) { nM = M / BM; nN = N / BM; nwg = nM * nN; G = G_; c = c_; K = K_; Bt = (const char*)Bt_; }
    __device__ __forceinline__ bool next(int i, Unit& u) const {
        const long L = (long)i * G + c; if (L >= nwg) return false;
        int wgid = (int)L; { const int q = nwg / NXCD, r = nwg % NXCD, xcd = wgid % NXCD, off = wgid / NXCD; wgid = (xcd < r ? xcd * (q + 1) : r * (q + 1) + (xcd - r) * q) + off; }
        const int nig = WGM * nN, gid = wgid / nig, fm = gid * WGM, gsz = (nM - fm) < WGM ? (nM - fm) : WGM;
        u.pm = fm + ((wgid % nig) % gsz); u.pn = (wgid % nig) / gsz; u.e = 0; return true;
    }
    __device__ __forceinline__ unsigned a_voff(const Unit& u, int half, int R) const { return (unsigned)((u.pm * BM + half * HALF + R) * K) * 2u; }
    __device__ __forceinline__ const char* b_tile(const Unit& u) const { return Bt + (size_t)u.pn * BM * K * 2; }
};
template <bool GATH> struct MoeOrder {
    static constexpr bool GATHER = GATH;
    int nunits, ntn, G, c, K; const LAS int* off; const LAS int* cn; const int* list; const char* Bt; size_t estride;
    __device__ __forceinline__ bool next(int i, Unit& u) const {
        const int L = i * G + c; if (L >= nunits) return false;
        u.pm = L / ntn; u.pn = L % ntn; const int s0 = u.pm * BM; int e = 0;
#pragma unroll
        for (int q = 1; q < 16; ++q) e += (s0 >= off[q]) ? 1 : 0;
        u.e = e; return true;
    }
    __device__ __forceinline__ unsigned a_voff(const Unit& u, int half, int R) const {
        const int slot = u.pm * BM + half * HALF + R;
        const int loc = slot - off[u.e]; const int tk = list[u.e * T + (loc < cn[u.e] ? loc : 0)];
        return (unsigned)(tk * K) * 2u;
    }
    __device__ __forceinline__ const char* b_tile(const Unit& u) const { return Bt + (size_t)u.e * estride + (size_t)u.pn * BM * K * 2; }
};
__device__ __forceinline__ unsigned cvt_pk_bf16(float lo, float hi) { return pk2(lo, hi); }

template <class Epi, class Sched>
__device__ __forceinline__ void gemm_phase(LAS unsigned char* lds, const bf16* Aptr, int K, const Sched& S, const Epi& E, int wv_) {
    const int tid = opaque_tid(wv_), wid = __builtin_amdgcn_readfirstlane(tid >> 6), lane = tid & 63, wr = wid >> 2, wc = wid & 3, fr = lane & 15, fq = lane >> 4;
    const int nt = K / BK;
    int Rr[2], Cc[2]; unsigned voffA[2], voffB[2];
#pragma unroll
    for (int i = 0; i < 2; ++i) { stage_rc(tid * 16 + i * 8192, Rr[i], Cc[i]); const int Rb = Epi::PERM ? ((Rr[i] & ~31) + perm32(Rr[i] & 31)) : Rr[i];
        voffA[i] = (unsigned)(Rr[i] * K + Cc[i]) * 2u; voffB[i] = (unsigned)(Rb * K + Cc[i]) * 2u; }
    const size_t kstep = (size_t)(BK * 2);
    const size_t hstep = (size_t)HALF * K * 2;
    const size_t tstep = 2 * hstep;
    const unsigned ldsw = (unsigned)wid * 1024u;
    const int aoff = lds_byte(wr * 64 + fr, fq * 8), boff = lds_byte(wc * 32 + fr, fq * 8);
    const char* const Ab = (const char*)Aptr;
#define PG8_SA(b, h) (((b) * 2 + (h)) * HTB)
#define PG8_SB(b, h) ((4 + (b) * 2 + (h)) * HTB)
#define PG8_STAGE(bufoff, gbase, voff) do { _Pragma("unroll") for (int _i = 0; _i < 2; ++_i) \
        __builtin_amdgcn_global_load_lds((const unsigned*)((const char*)(gbase) + (voff)[_i]), (LAS unsigned*)(lds + (bufoff) + ldsw + _i * 8192), 16, 0, 0); } while (0)
#define PG8_STAGE_A(bufoff, usenext, h, kofs) do { \
        if constexpr (Sched::GATHER) { const char* gb_ = Ab + (kofs); unsigned vv_[2] = {(usenext) ? vN[h][0] : vA[h][0], (usenext) ? vN[h][1] : vA[h][1]}; PG8_STAGE(bufoff, gb_, vv_); } \
        else { const char* gb_ = ((usenext) ? nA : cA) + (size_t)(h) * hstep + (kofs); PG8_STAGE(bufoff, gb_, voffA); } } while (0)
#define PG8_LDA(dst, b, h) do { _Pragma("unroll") for (int m = 0; m < 4; ++m) _Pragma("unroll") for (int k = 0; k < 2; ++k) dst[m][k] = *(const LAS bf16x8*)(lds + PG8_SA(b, h) + aoff + m * 2048 + k * 1024); } while (0)
#define PG8_LDB(dst, b, h) do { _Pragma("unroll") for (int n = 0; n < 2; ++n) _Pragma("unroll") for (int k = 0; k < 2; ++k) dst[n][k] = *(const LAS bf16x8*)(lds + PG8_SB(b, h) + boff + n * 2048 + k * 1024); } while (0)
#define PG8_MMA(ai, bj, At, Bt) do { __builtin_amdgcn_s_setprio(1); _Pragma("unroll") for (int m = 0; m < 4; ++m) _Pragma("unroll") for (int n = 0; n < 2; ++n) _Pragma("unroll") for (int k = 0; k < 2; ++k) \
        acc[ai][bj][m][n] = __builtin_amdgcn_mfma_f32_16x16x32_bf16(Bt[n][k], At[m][k], acc[ai][bj][m][n], 0, 0, 0); __builtin_amdgcn_s_setprio(0); } while (0)
#define PG8_WAIT_V(n) asm volatile("s_waitcnt vmcnt(" #n ")" ::: "memory")
#define PG8_WAIT_L(n) asm volatile("s_waitcnt lgkmcnt(" #n ")" ::: "memory")
#define PG8_BAR __builtin_amdgcn_s_barrier()
#define PG8_SCHED __builtin_amdgcn_sched_barrier(0)
    Unit cur, nxt; int ui = 0;
    if (!S.next(0, cur)) return;
    f32x4 acc[2][2][4][2];
#pragma unroll
    for (int a = 0; a < 2; ++a)
#pragma unroll
        for (int b = 0; b < 2; ++b)
#pragma unroll
            for (int m = 0; m < 4; ++m)
#pragma unroll
                for (int n = 0; n < 2; ++n) acc[a][b][m][n] = (f32x4){0.f, 0.f, 0.f, 0.f};
    bf16x8 At[4][2], B0[2][2], B1[2][2];
    unsigned vA[2][2], vN[2][2];
    const char* cA = Ab; const char* nA = Ab;
    if constexpr (Sched::GATHER) {
#pragma unroll
        for (int h = 0; h < 2; ++h)
#pragma unroll
            for (int i = 0; i < 2; ++i) { vA[h][i] = S.a_voff(cur, h, Rr[i]) + (unsigned)Cc[i] * 2u; vN[h][i] = vA[h][i]; }
    } else { cA = Ab + (size_t)cur.pm * tstep; nA = cA; }
    const char* cB = S.b_tile(cur);
    PG8_STAGE(PG8_SB(0, 0), cB, voffB); PG8_STAGE_A(PG8_SA(0, 0), false, 0, 0); PG8_STAGE(PG8_SB(0, 1), cB + hstep, voffB); PG8_STAGE_A(PG8_SA(0, 1), false, 1, 0);
    if (wr == 1) PG8_BAR;
    PG8_WAIT_V(4); PG8_BAR;
    PG8_STAGE(PG8_SB(1, 0), cB + kstep, voffB); PG8_STAGE_A(PG8_SA(1, 0), false, 0, kstep); PG8_STAGE(PG8_SB(1, 1), cB + hstep + kstep, voffB);
    PG8_WAIT_V(6); PG8_BAR;
    for (;;) {
        const bool has_next = S.next(ui + 1, nxt);
        const char* nB = has_next ? S.b_tile(nxt) : cB;
        if constexpr (Sched::GATHER) {
#pragma unroll
            for (int h = 0; h < 2; ++h)
#pragma unroll
                for (int i = 0; i < 2; ++i) vN[h][i] = has_next ? S.a_voff(nxt, h, Rr[i]) + (unsigned)Cc[i] * 2u : vA[h][i];
        } else nA = has_next ? Ab + (size_t)nxt.pm * tstep : cA;
        for (int t = 0; t < nt; t += 2) {
            const bool last = (t == nt - 2);
            const size_t k1 = (size_t)(t + 1) * kstep, k2 = last ? 0 : (size_t)(t + 2) * kstep, k3 = k2 + kstep;
            const char* b2 = last ? nB : cB + (size_t)(t + 2) * kstep; const char* b3 = b2 + kstep;
            PG8_LDB(B0, 0, 0); PG8_SCHED; PG8_LDA(At, 0, 0); PG8_STAGE_A(PG8_SA(1, 1), false, 1, k1);
            PG8_WAIT_L(8); PG8_BAR; PG8_WAIT_L(0); PG8_MMA(0, 0, At, B0); PG8_BAR; PG8_SCHED;
            PG8_LDB(B1, 0, 1); PG8_STAGE(PG8_SB(0, 0), b2, voffB);
            PG8_BAR; PG8_WAIT_L(0); PG8_MMA(0, 1, At, B1); PG8_BAR;
            PG8_LDA(At, 0, 1); PG8_STAGE_A(PG8_SA(0, 0), last, 0, k2);
            PG8_BAR; PG8_WAIT_L(0); PG8_MMA(1, 0, At, B0); PG8_BAR; PG8_SCHED;
            PG8_STAGE(PG8_SB(0, 1), b2 + hstep, voffB);
            PG8_WAIT_V(6); PG8_BAR; PG8_MMA(1, 1, At, B1); PG8_BAR;
            PG8_LDB(B0, 1, 0); PG8_SCHED; PG8_LDA(At, 1, 0); PG8_STAGE_A(PG8_SA(0, 1), last, 1, k2);
            PG8_WAIT_L(8); PG8_BAR; PG8_WAIT_L(0); PG8_MMA(0, 0, At, B0); PG8_BAR; PG8_SCHED;
            PG8_LDB(B1, 1, 1); PG8_STAGE(PG8_SB(1, 0), b3, voffB);
            PG8_BAR; PG8_WAIT_L(0); PG8_MMA(0, 1, At, B1); PG8_BAR;
            PG8_LDA(At, 1, 1); PG8_STAGE_A(PG8_SA(1, 0), last, 0, k3);
            PG8_BAR; PG8_WAIT_L(0); PG8_MMA(1, 0, At, B0); PG8_BAR; PG8_SCHED;
            PG8_STAGE(PG8_SB(1, 1), b3 + hstep, voffB);
            PG8_WAIT_V(6); PG8_BAR; PG8_MMA(1, 1, At, B1); PG8_BAR;
        }
        E(acc, cur, wr, wc, fr, fq);
        if (!has_next) break;
#pragma unroll
        for (int a = 0; a < 2; ++a)
#pragma unroll
            for (int b = 0; b < 2; ++b)
#pragma unroll
                for (int m = 0; m < 4; ++m)
#pragma unroll
                    for (int n = 0; n < 2; ++n) acc[a][b][m][n] = (f32x4){0.f, 0.f, 0.f, 0.f};
        cur = nxt; cB = nB; cA = nA; ++ui;
        if constexpr (Sched::GATHER) {
#pragma unroll
            for (int h = 0; h < 2; ++h)
#pragma unroll
                for (int i = 0; i < 2; ++i) vA[h][i] = vN[h][i];
        }
    }
    PG8_WAIT_V(0);
    if (wr == 0) PG8_BAR;
    PG8_BAR;
#undef PG8_SA
#undef PG8_SB
#undef PG8_STAGE
#undef PG8_STAGE_A
#undef PG8_LDA
#undef PG8_LDB
#undef PG8_MMA
#undef PG8_WAIT_V
#undef PG8_WAIT_L
#undef PG8_BAR
#undef PG8_SCHED
}
template <int ACT> struct EpiBf16 {
    static constexpr bool PERM = true;
    bf16* O; int ldc; int tpt; size_t tstride; float* stats; int stat_pn0;
    __device__ __forceinline__ void operator()(const f32x4 (&acc)[2][2][4][2], const Unit& u, int wr, int wc, int fr, int fq) const {
        const int row0 = u.pm * BM + wr * 64 + fr; const int tt = u.pn / tpt; bf16* base = O + (size_t)tt * tstride; const int col0 = (u.pn - tt * tpt) * BM + wc * 32 + 8 * fq;
#pragma unroll
        for (int ai = 0; ai < 2; ++ai)
#pragma unroll
            for (int m = 0; m < 4; ++m) { bf16* rowp = base + (size_t)(row0 + ai * HALF + m * 16) * ldc + col0; float psum = 0.f, psq = 0.f;
#pragma unroll
                for (int bj = 0; bj < 2; ++bj) { f32x4 v0 = acc[ai][bj][m][0], v1 = acc[ai][bj][m][1];
                    if (ACT == 1) {
#pragma unroll
                        for (int q = 0; q < 4; ++q) { v0[q] = gelu_tanh(v0[q]); v1[q] = gelu_tanh(v1[q]); } }
                    if (ACT == 1) { psum += ((v0[0] + v0[1]) + (v0[2] + v0[3])) + ((v1[0] + v1[1]) + (v1[2] + v1[3]));
                        psq += ((v0[0] * v0[0] + v0[1] * v0[1]) + (v0[2] * v0[2] + v0[3] * v0[3])) + ((v1[0] * v1[0] + v1[1] * v1[1]) + (v1[2] * v1[2] + v1[3] * v1[3])); }
                    u32x4 w; w.x = cvt_pk_bf16(v0[0], v0[1]); w.y = cvt_pk_bf16(v0[2], v0[3]); w.z = cvt_pk_bf16(v1[0], v1[1]); w.w = cvt_pk_bf16(v1[2], v1[3]);
                    *(u32x4*)(rowp + bj * HALF) = w; }
                if (ACT == 1 && stats && u.pn >= stat_pn0) {
                    psum += __shfl_xor(psum, 16); psum += __shfl_xor(psum, 32); psq += __shfl_xor(psq, 16); psq += __shfl_xor(psq, 32);
                    if (fq == 0) { f32x2 st2 = {psum, psq}; *(f32x2*)(stats + ((size_t)(row0 + ai * HALF + m * 16) * 32 + (u.pn - stat_pn0) * 4 + wc) * 2) = st2; } } }
    }
};
struct EpiResAdd {
    static constexpr bool PERM = false;
    float* X; int ldc;
    __device__ __forceinline__ void operator()(const f32x4 (&acc)[2][2][4][2], const Unit& u, int wr, int wc, int fr, int fq) const {
        const int row0 = u.pm * BM + wr * 64 + fr, col0 = u.pn * BM + wc * 32 + 4 * fq;
#pragma unroll
        for (int ai = 0; ai < 2; ++ai)
#pragma unroll
            for (int m2 = 0; m2 < 4; m2 += 2) {
                f32x4 x[2][2][2];
#pragma unroll
                for (int mm = 0; mm < 2; ++mm)
#pragma unroll
                    for (int bj = 0; bj < 2; ++bj)
#pragma unroll
                        for (int n = 0; n < 2; ++n) x[mm][bj][n] = *(const f32x4*)(X + (size_t)(row0 + ai * HALF + (m2 + mm) * 16) * ldc + col0 + bj * HALF + n * 16);
#pragma unroll
                for (int mm = 0; mm < 2; ++mm)
#pragma unroll
                    for (int bj = 0; bj < 2; ++bj)
#pragma unroll
                        for (int n = 0; n < 2; ++n) *(f32x4*)(X + (size_t)(row0 + ai * HALF + (m2 + mm) * 16) * ldc + col0 + bj * HALF + n * 16) = x[mm][bj][n] + acc[ai][bj][m2 + mm][n];
            }
    }
};
struct EpiResAddNorm {
    static constexpr bool PERM = false;
    float* X; int ldc; bf16* XB; float* rowsq;
    __device__ __forceinline__ void operator()(const f32x4 (&acc)[2][2][4][2], const Unit& u, int wr, int wc, int fr, int fq) const {
        const int row0 = u.pm * BM + wr * 64 + fr, col0 = u.pn * BM + wc * 32 + 4 * fq;
#pragma unroll
        for (int ai = 0; ai < 2; ++ai)
#pragma unroll
            for (int m2 = 0; m2 < 4; m2 += 2) {
                f32x4 x[2][2][2];
#pragma unroll
                for (int mm = 0; mm < 2; ++mm)
#pragma unroll
                    for (int bj = 0; bj < 2; ++bj)
#pragma unroll
                        for (int n = 0; n < 2; ++n) x[mm][bj][n] = *(const f32x4*)(X + (size_t)(row0 + ai * HALF + (m2 + mm) * 16) * ldc + col0 + bj * HALF + n * 16);
#pragma unroll
                for (int mm = 0; mm < 2; ++mm) {
                    const size_t ro = (size_t)(row0 + ai * HALF + (m2 + mm) * 16) * ldc + col0; float ssq = 0.f;
#pragma unroll
                    for (int bj = 0; bj < 2; ++bj)
#pragma unroll
                        for (int n = 0; n < 2; ++n) { const f32x4 v = x[mm][bj][n] + acc[ai][bj][m2 + mm][n];
                            *(f32x4*)(X + ro + bj * HALF + n * 16) = v;
                            u32x2 w; w.x = cvt_pk_bf16(v.x, v.y); w.y = cvt_pk_bf16(v.z, v.w); *(u32x2*)(XB + ro + bj * HALF + n * 16) = w;
                            ssq += (v.x * v.x + v.y * v.y) + (v.z * v.z + v.w * v.w); }
                    ssq += __shfl_xor(ssq, 16); ssq += __shfl_xor(ssq, 32);
                    if (fq == 0) rowsq[(size_t)(row0 + ai * HALF + (m2 + mm) * 16) * 16 + u.pn * 4 + wc] = ssq;
                }
            }
    }
};
struct EpiBf16RowScale {
    static constexpr bool PERM = true;
    bf16* O; int ldc; const float* rowsq;
    __device__ __forceinline__ void operator()(const f32x4 (&acc)[2][2][4][2], const Unit& u, int wr, int wc, int fr, int fq) const {
        const int row0 = u.pm * BM + wr * 64 + fr, col0 = u.pn * BM + wc * 32 + 8 * fq;
#pragma unroll
        for (int ai = 0; ai < 2; ++ai) {
            float rs[4];
#pragma unroll
            for (int m = 0; m < 4; ++m) { const f32x4* p = (const f32x4*)(rowsq + (size_t)(row0 + ai * HALF + m * 16) * 16); const f32x4 a = p[0], b = p[1], c = p[2], d = p[3];
                rs[m] = rsqrtf((((a.x + a.y) + (a.z + a.w)) + ((b.x + b.y) + (b.z + b.w)) + (((c.x + c.y) + (c.z + c.w)) + ((d.x + d.y) + (d.z + d.w)))) * (1.f / 1024.f) + EPS); }
#pragma unroll
            for (int m = 0; m < 4; ++m) { bf16* rowp = O + (size_t)(row0 + ai * HALF + m * 16) * ldc + col0;
#pragma unroll
                for (int bj = 0; bj < 2; ++bj) { const f32x4 v0 = acc[ai][bj][m][0] * rs[m], v1 = acc[ai][bj][m][1] * rs[m];
                    u32x4 w; w.x = cvt_pk_bf16(v0[0], v0[1]); w.y = cvt_pk_bf16(v0[2], v0[3]); w.z = cvt_pk_bf16(v1[0], v1[1]); w.w = cvt_pk_bf16(v1[2], v1[3]);
                    *(u32x4*)(rowp + bj * HALF) = w; } }
        }
    }
};
struct EpiSwiglu {
    static constexpr bool PERM = true;
    bf16* H; int ldc;
    __device__ __forceinline__ void operator()(const f32x4 (&acc)[2][2][4][2], const Unit& u, int wr, int wc, int fr, int fq) const {
        const int row0 = u.pm * BM + wr * 64 + fr, col0 = u.pn * HALF + wc * 32 + 8 * fq;
#pragma unroll
        for (int ai = 0; ai < 2; ++ai)
#pragma unroll
            for (int m = 0; m < 4; ++m) {
                float o[8];
#pragma unroll
                for (int n = 0; n < 2; ++n)
#pragma unroll
                    for (int q = 0; q < 4; ++q) { const float g = acc[ai][0][m][n][q]; o[4 * n + q] = g * sigmoidf_(g) * acc[ai][1][m][n][q]; }
                u32x4 w; w.x = cvt_pk_bf16(o[0], o[1]); w.y = cvt_pk_bf16(o[2], o[3]); w.z = cvt_pk_bf16(o[4], o[5]); w.w = cvt_pk_bf16(o[6], o[7]);
                *(u32x4*)(H + (size_t)(row0 + ai * HALF + m * 16) * ldc + col0) = w; }
    }
};
}

__device__ __forceinline__ int hyb_colmap(int n) {
    if (n < 1280) return n;
    if (n < 1536) return 1304 + (n - 1280);
    if (n < 1792) return 1560 + (n - 1536);
    if (n < 2304) return 1816 + (n - 1792);
    if (n < 2816) return 2344 + (n - 2304);
    if (n < 2840) return 1280 + (n - 2816);
    if (n < 2856) return 2328 + (n - 2840);
    return -1;
}
__device__ __forceinline__ void tr_item(const float* __restrict__ W, int Nsrc, int K, bf16* __restrict__ Wt, const float* __restrict__ gain, int kind, int nblk, LAS float* scr, int item, int lane) {
    const int kb = item / nblk, nb = item % nblk, k0 = 64 * kb, n0 = 64 * nb;
    const int ksub = lane >> 4, n4 = lane & 15, n = n0 + 4 * n4;
    int col;
    if (kind == 0) col = n; else if (kind == 1) col = hyb_colmap(n); else { const int pn = n >> 8, r = n & 255; col = (r >> 7) * 384 + pn * 128 + (r & 127); }
    f32x4 v[16];
#pragma unroll
    for (int i = 0; i < 16; ++i) v[i] = col >= 0 ? *(const f32x4*)(W + (size_t)(k0 + 4 * i + ksub) * Nsrc + col) : (f32x4){0.f, 0.f, 0.f, 0.f};
    if (gain) {
#pragma unroll
        for (int i = 0; i < 16; ++i) v[i] = v[i] * gain[k0 + 4 * i + ksub];
    }
#pragma unroll
    for (int i = 0; i < 16; ++i) { LAS float* d = scr + (4 * i + ksub) * 65 + 4 * n4; d[0] = v[i].x; d[1] = v[i].y; d[2] = v[i].z; d[3] = v[i].w; }
    LDS_WAIT();
    const int c = lane & 7;
#pragma unroll
    for (int jx = 0; jx < 8; ++jx) {
        const int nn = (lane >> 3) + 8 * jx; const LAS float* s = scr + (8 * c) * 65 + nn;
        u32x4 o; o.x = pk2(s[0 * 65], s[1 * 65]); o.y = pk2(s[2 * 65], s[3 * 65]); o.z = pk2(s[4 * 65], s[5 * 65]); o.w = pk2(s[6 * 65], s[7 * 65]);
        *(u32x4*)(Wt + (size_t)(n0 + nn) * K + k0 + 8 * c) = o;
    }
    LDS_WAIT();
}
__device__ __forceinline__ void rms_row_to_bf16(const float* __restrict__ xrow, bf16* __restrict__ orow, float* __restrict__ copy, int lane) {
    const f32x4* xr = (const f32x4*)xrow + lane;
    f32x4 v[4]; float s = 0.f;
#pragma unroll
    for (int j = 0; j < 4; ++j) { v[j] = xr[64 * j]; s += (v[j].x * v[j].x + v[j].y * v[j].y) + (v[j].z * v[j].z + v[j].w * v[j].w); }
    const float rstd = rsqrtf(wave_sum(s) * (1.f / 1024.f) + EPS);
    u32x2* o8 = (u32x2*)orow + lane;
#pragma unroll
    for (int j = 0; j < 4; ++j) { u32x2 w; w.x = pk2(v[j].x * rstd, v[j].y * rstd); w.y = pk2(v[j].z * rstd, v[j].w * rstd); o8[64 * j] = w; }
    if (copy) { f32x4* c4 = (f32x4*)copy + lane;
#pragma unroll
        for (int j = 0; j < 4; ++j) c4[64 * j] = v[j]; }
}

__device__ __forceinline__ void phase_prologue(KArgs A, int wv_, LAS unsigned char* lds) {
    const int tid = opaque_tid(wv_), wid = __builtin_amdgcn_readfirstlane(tid >> 6), lane = tid & 63;
    const int gw = blockIdx.x * 8 + wid, NGW = gridDim.x * 8;
    LAS float* scr = (LAS float*)(lds + wid * 16640);
    unsigned char* ws = opq(A->ws);
    constexpr int N_HYB = 2 * 768, N_HOUT = 2 * 256, N_SGIN = 2 * 1024, N_SGOUT = 2 * 512, N_WQ = 4 * 256, N_WKV = 4 * 512, N_WO = 4 * 256, N_MIN = 64 * 192, N_MOUT = 64 * 96, N_W1T = 4 * 32;
    constexpr int NITEMS = N_HYB + N_HOUT + N_SGIN + N_SGOUT + N_WQ + N_WKV + N_WO + N_MIN + N_MOUT + N_W1T;
    for (int it = gw; it < NITEMS; it += NGW) {
        int r = it;
        if (r < N_HYB) { const int sl = r / 768; tr_item(A->in[I_HYBIN] + (size_t)sl * 1024 * HYSRC, HYSRC, 1024, (bf16*)(ws + WS_WHYB) + (size_t)sl * HYN * 1024, A->in[I_NMIX] + (2 * sl) * 1024, 1, 48, scr, r % 768, lane); continue; } r -= N_HYB;
        if (r < N_HOUT) { const int sl = r / 256; tr_item(A->in[I_HYBOUT] + (size_t)sl * 1024 * 1024, 1024, 1024, (bf16*)(ws + WS_WHOUT) + (size_t)sl * 1024 * 1024, nullptr, 0, 16, scr, r % 256, lane); continue; } r -= N_HOUT;
        if (r < N_SGIN) { const int sl = r / 1024; tr_item(A->in[I_SGIN] + (size_t)sl * 1024 * 4096, 4096, 1024, (bf16*)(ws + WS_WSGIN) + (size_t)sl * 4096 * 1024, A->in[I_NMIX] + (2 * sl + 1) * 1024, 0, 64, scr, r % 1024, lane); continue; } r -= N_SGIN;
        if (r < N_SGOUT) { const int sl = r / 512; tr_item(A->in[I_SGOUT] + (size_t)sl * 2048 * 1024, 1024, 2048, (bf16*)(ws + WS_WSGOUT) + (size_t)sl * 1024 * 2048, nullptr, 0, 16, scr, r % 512, lane); continue; } r -= N_SGOUT;
        if (r < N_WQ) { const int sl = r / 256; tr_item(A->in[I_XWQ] + (size_t)sl * 1024 * 1024, 1024, 1024, (bf16*)(ws + WS_WQ) + (size_t)sl * 1024 * 1024, A->in[I_NXAT] + sl * 1024, 0, 16, scr, r % 256, lane); continue; } r -= N_WQ;
        if (r < N_WKV) { const int sl = r / 512; tr_item(A->in[I_XWKV] + (size_t)sl * 1024 * 2048, 2048, 1024, (bf16*)(ws + WS_WKV) + (size_t)sl * 2048 * 1024, A->in[I_NMEM] + sl * 1024, 0, 32, scr, r % 512, lane); continue; } r -= N_WKV;
        if (r < N_WO) { const int sl = r / 256; tr_item(A->in[I_XWO] + (size_t)sl * 1024 * 1024, 1024, 1024, (bf16*)(ws + WS_WO) + (size_t)sl * 1024 * 1024, nullptr, 0, 16, scr, r % 256, lane); continue; } r -= N_WO;
        if (r < N_MIN) { const int sl = r / 192; tr_item(A->in[I_MOEIN] + (size_t)sl * 1024 * 768, 768, 1024, (bf16*)(ws + WS_WMIN) + (size_t)sl * 768 * 1024, A->in[I_NFFN] + (sl >> 4) * 1024, 2, 12, scr, r % 192, lane); continue; } r -= N_MIN;
        if (r < N_MOUT) { const int sl = r / 96; tr_item(A->in[I_MOEOUT] + (size_t)sl * 384 * 1024, 1024, 384, (bf16*)(ws + WS_WMOUT) + (size_t)sl * 1024 * 384, nullptr, 0, 16, scr, r % 96, lane); continue; } r -= N_MOUT;
        { const int sl = r / 32; tr_item(A->in[I_CMPW1] + (size_t)sl * 2048 * 64, 64, 2048, (bf16*)(ws + WS_W1T) + (size_t)sl * 64 * 2048, nullptr, 0, 1, scr, r % 32, lane); }
    }
    for (int m = gw; m < T; m += NGW) rms_row_to_bf16(A->in[I_X] + (size_t)m * D, (bf16*)(ws + WS_XN) + (size_t)m * D, A->out + (size_t)m * D, lane);
    for (int m = gw; m < NBATCH * NMEM; m += NGW) rms_row_to_bf16(A->in[I_MEM] + (size_t)m * D, (bf16*)(ws + WS_MN) + (size_t)m * D, nullptr, lane);
    const int gt = blockIdx.x * 512 + tid, NGT = gridDim.x * 512;
    const int* pos = (const int*)A->in[I_POS];
    float* cosT = (float*)(ws + WS_COS); float* sinT = (float*)(ws + WS_SIN);
    for (int i = gt; i < T * 32; i += NGT) {
        const int t = i >> 5, j = i & 31;
        const float ang = (float)pos[t] * A->freq[j];
        const double rev = (double)ang * 0.15915494309189533577;
        const float fr = (float)(rev - rint(rev));
        cosT[i] = __builtin_amdgcn_cosf(fr); sinT[i] = __builtin_amdgcn_sinf(fr);
    }
    { bf16* WSB = (bf16*)(ws + WS_WSB); float* M0 = (float*)(ws + WS_M0); const float* wsg = A->in[I_SGWS];
      for (int e = gt; e < 2 * 8 * 128 * 128; e += NGT) { const int s = e & 127, t = (e >> 7) & 127; WSB[e] = (bf16)f2bf(s <= t ? wsg[e] : 0.f); }
      for (int e = gt; e < 2 * 8 * 128; e += NGT) { const int t = e & 127; const float* r = wsg + (size_t)e * 128; float a = 0.f; for (int s = 0; s <= t; ++s) a += r[s]; M0[e] = a; } }
    float* RW = (float*)(ws + WS_RW);
    for (int i = gt; i < DEPTH * NEXP * D; i += NGT) { const int k = i & 1023, e = (i >> 10) & 15, l = i >> 14; RW[i] = A->in[I_RW][k * NEXP + e] * A->in[I_NFFN][l * D + k]; }
}

__device__ __forceinline__ void phase_knorm(KArgs A, int wv_, const int gw, const int NGW) {
    const int tid_ = opaque_tid(wv_); const int lane = tid_ & 63;
    bf16* KV = (bf16*)(opq(A->ws) + WS_KV);
    for (int it0 = gw * 4; it0 < DEPTH * 2048 * 4; it0 += NGW * 4) {
        u32x2 w[4];
#pragma unroll
        for (int q = 0; q < 4; ++q) { const int it = it0 + q; const int h = it & 3, m = (it >> 2) & 2047, l = it >> 13; w[q] = *(const u32x2*)(KV + (size_t)m * 8192 + l * 2048 + h * 256 + 4 * lane); }
#pragma unroll
        for (int q = 0; q < 4; ++q) {
            const int it = it0 + q; const int h = it & 3, m = (it >> 2) & 2047, l = it >> 13;
            const float x0 = bflo(w[q].x), x1 = bfhi(w[q].x), x2 = bflo(w[q].y), x3 = bfhi(w[q].y);
            const float rstd = rsqrtf(wave_sum(x0 * x0 + x1 * x1 + x2 * x2 + x3 * x3) * (1.f / 256.f) + EPS) * 0.0625f;
            const f32x4 g = *(const f32x4*)(A->in[I_XKN] + l * 256 + 4 * lane) * *(const f32x4*)(A->in[I_XQN] + l * 256 + 4 * lane);
            u32x2 o; o.x = pk2(x0 * rstd * g.x, x1 * rstd * g.y); o.y = pk2(x2 * rstd * g.z, x3 * rstd * g.w);
            *(u32x2*)(KV + (size_t)m * 8192 + l * 2048 + h * 256 + 4 * lane) = o;
        }
    }
}

__device__ __forceinline__ int kpos64(int tok) { const int k = tok & 31; return (tok & 32) + 8 * ((k >> 2) & 3) + 4 * (k >> 4) + (k & 3); }
__device__ __forceinline__ int kperm64(int p) { const int fq = (p >> 3) & 3, j = p & 7; return (p & 32) + 16 * (j >> 2) + 4 * fq + (j & 3); }

__device__ __forceinline__ void phase_nsa_prep(KArgs A, int wv_, int i, LAS unsigned char* lds) {
    const int tid_ = opaque_tid(wv_); const int wid = __builtin_amdgcn_readfirstlane(tid_ >> 6), lane = tid_ & 63; const int gw = blockIdx.x * 8 + wid, NGW = gridDim.x * 8;
    unsigned char* ws = opq(A->ws);
    const bf16* HY = (const bf16*)(ws + WS_BIG);
    const float* cosT = (const float*)(ws + WS_COS); const float* sinT = (const float*)(ws + WS_SIN);
    bf16* QA = (bf16*)(ws + WS_QA); bf16* KS = (bf16*)(ws + WS_KS); bf16* KW = (bf16*)(ws + WS_KW);
    (void)lds;
    const int j8 = lane & 7, ug = lane >> 3;
    const int u1 = 8 + (ug & 3);
    const int src0 = C_QA + 64 * ug, src1 = u1 < 10 ? C_KS + 64 * (u1 - 8) : C_KW + 64 * (u1 - 10);
    const float* g0p = A->in[I_QNORM] + i * 64 + 8 * j8; const float* g1p = A->in[I_KNORM] + (i * 3 + (u1 < 10 ? 1 : 2)) * 64 + 8 * j8;
    const f32x4 g0a = *(const f32x4*)g0p, g0b = *(const f32x4*)(g0p + 4), g1a = *(const f32x4*)g1p, g1b = *(const f32x4*)(g1p + 4);
    u32x4 w0 = (u32x4){0u, 0u, 0u, 0u}, w1 = w0; f32x4 ca, cb, sa, sb;
    if (gw < T) { w0 = *(const u32x4*)(HY + (size_t)gw * HYN + src0 + 8 * j8); w1 = *(const u32x4*)(HY + (size_t)gw * HYN + src1 + 8 * j8);
        const float* cp = cosT + gw * 32 + 8 * (j8 & 3); const float* sp = sinT + gw * 32 + 8 * (j8 & 3); ca = *(const f32x4*)cp; cb = *(const f32x4*)(cp + 4); sa = *(const f32x4*)sp; sb = *(const f32x4*)(sp + 4); }
    for (int t = gw; t < T; t += NGW) {
        const int tn = t + NGW < T ? t + NGW : t;
        const u32x4 n0 = *(const u32x4*)(HY + (size_t)tn * HYN + src0 + 8 * j8), n1 = *(const u32x4*)(HY + (size_t)tn * HYN + src1 + 8 * j8);
        const float* cp = cosT + tn * 32 + 8 * (j8 & 3); const float* sp = sinT + tn * 32 + 8 * (j8 & 3);
        const f32x4 nca = *(const f32x4*)cp, ncb = *(const f32x4*)(cp + 4), nsa = *(const f32x4*)sp, nsb = *(const f32x4*)(sp + 4);
#pragma unroll
        for (int pass = 0; pass < 2; ++pass) {
            const u32x4 w = pass ? w1 : w0; const f32x4 ga = pass ? g1a : g0a, gb = pass ? g1b : g0b;
            float x[8] = {bflo(w.x), bfhi(w.x), bflo(w.y), bfhi(w.y), bflo(w.z), bfhi(w.z), bflo(w.w), bfhi(w.w)};
            float ssq = 0.f;
#pragma unroll
            for (int q = 0; q < 8; ++q) ssq += x[q] * x[q];
            ssq += __shfl_xor(ssq, 1); ssq += __shfl_xor(ssq, 2); ssq += __shfl_xor(ssq, 4);
            const float rs = rsqrtf(ssq * (1.f / 64.f) + EPS) * (pass ? 1.f : 0.125f * 1.4426950408889634f);
            const float gg[8] = {ga.x, ga.y, ga.z, ga.w, gb.x, gb.y, gb.z, gb.w}, cc[8] = {ca.x, ca.y, ca.z, ca.w, cb.x, cb.y, cb.z, cb.w}, ss[8] = {sa.x, sa.y, sa.z, sa.w, sb.x, sb.y, sb.z, sb.w};
            float o[8];
#pragma unroll
            for (int q = 0; q < 8; ++q) { const float y = x[q] * rs * gg[q]; const float pr = __shfl_xor(y, 4);
                o[q] = j8 < 4 ? y * cc[q] - pr * ss[q] : y * cc[q] + pr * ss[q]; }
            u32x4 ow; ow.x = pk2(o[0], o[1]); ow.y = pk2(o[2], o[3]); ow.z = pk2(o[4], o[5]); ow.w = pk2(o[6], o[7]);
            if (pass == 0) *(u32x4*)(QA + (size_t)t * 512 + 64 * ug + 8 * j8) = ow;
            else if (lane < 32) { bf16* dst = (u1 < 10 ? KS + (size_t)t * 128 + 64 * (u1 - 8) : KW + (size_t)t * 128 + 64 * (u1 - 10)); *(u32x4*)(dst + 8 * j8) = ow; }
        }
        w0 = n0; w1 = n1; ca = nca; cb = ncb; sa = nsa; sb = nsb;
    }
}

__device__ __forceinline__ void phase_compress_mfma(KArgs A, int wv_, int i, LAS unsigned char* lds) {
    const int tid = opaque_tid(wv_), wid = __builtin_amdgcn_readfirstlane(tid >> 6), lane = tid & 63, fr = lane & 15, fq = lane >> 4;
    unsigned char* ws = opq(A->ws);
    const bf16* HY = (const bf16*)(ws + WS_BIG);
    const float* cosT = (const float*)(ws + WS_COS); const float* sinT = (const float*)(ws + WS_SIN);
    LAS float* part = (LAS float*)lds;
    LAS float* hbuf = part + 8 * 1024;
    LAS float* obuf = hbuf + 1024;
    LAS float* w2l = obuf + 1024;
    int w2kv = -1;
    for (int it = blockIdx.x; it < 2 * 127; it += gridDim.x) {
        const int kv = it / 127, tile = it % 127;
        const float* pe = A->in[I_CMPPE] + (size_t)(i * 2 + kv) * 32 * 64;
        const float* w2 = A->in[I_CMPW2] + (size_t)(i * 2 + kv) * 64 * 64;
        const bf16* w1t = (const bf16*)(ws + WS_W1T) + (size_t)(i * 2 + kv) * 64 * 2048;
        const int coff = kv ? C_VC : C_KC;
        if (kv != w2kv) { __syncthreads(); for (int e4 = tid; e4 < 1024; e4 += 512) *(LAS f32x4*)(w2l + 4 * e4) = *(const f32x4*)(w2 + 4 * e4); w2kv = kv; }
        {
            const int R = tile * 16 + fr, g = R & 1, bn = R >> 1, n = bn % NCMP, b = bn / NCMP;
            const bf16* arow = HY + (size_t)(b * S + 16 * n) * HYN + coff + g * 64;
            f32x4 acc[4];
#pragma unroll
            for (int t = 0; t < 4; ++t) acc[t] = (f32x4){0.f, 0.f, 0.f, 0.f};
#pragma unroll 4
            for (int s = 0; s < 8; ++s) {
                const int k0 = 256 * wid + 32 * s, l = k0 >> 6, d0 = (k0 & 63) + 8 * fq;
                const u32x4 hw = *(const u32x4*)(arow + (size_t)l * HYN + d0);
                const f32x4 p0 = *(const f32x4*)(pe + l * 64 + d0), p1 = *(const f32x4*)(pe + l * 64 + d0 + 4);
                u32x4 aw; aw.x = pk2(bflo(hw.x) + p0.x, bfhi(hw.x) + p0.y); aw.y = pk2(bflo(hw.y) + p0.z, bfhi(hw.y) + p0.w); aw.z = pk2(bflo(hw.z) + p1.x, bfhi(hw.z) + p1.y); aw.w = pk2(bflo(hw.w) + p1.z, bfhi(hw.w) + p1.w);
                const bf16x8 af = __builtin_bit_cast(bf16x8, aw);
#pragma unroll
                for (int t = 0; t < 4; ++t) { const bf16x8 bfr = *(const bf16x8*)(w1t + (size_t)(16 * t + fr) * 2048 + k0 + 8 * fq);
                    acc[t] = __builtin_amdgcn_mfma_f32_16x16x32_bf16(af, bfr, acc[t], 0, 0, 0); }
            }
            __syncthreads();
#pragma unroll
            for (int t = 0; t < 4; ++t)
#pragma unroll
                for (int r = 0; r < 4; ++r) part[wid * 1024 + (4 * fq + r) * 64 + 16 * t + fr] = acc[t][r];
        }
        __syncthreads();
        for (int e = tid; e < 1024; e += 512) { float a = 0.f;
#pragma unroll
            for (int w = 0; w < 8; ++w) a += part[w * 1024 + e];
            hbuf[e] = gelu_tanh(a); }
        __syncthreads();
        for (int e = tid; e < 1024; e += 512) { const int r = e >> 6, j = e & 63; float o = 0.f;
#pragma unroll 8
            for (int m = 0; m < 64; ++m) o += hbuf[r * 64 + m] * w2l[m * 64 + j];
            obuf[e] = o; }
        __syncthreads();
        for (int r = wid; r < 16; r += 8) {
            const int R = tile * 16 + r, g = R & 1, bn = R >> 1, n = bn % NCMP, b = bn / NCMP;
            const float o = obuf[r * 64 + lane];
            if (kv == 0) {
                const float y = o * rsqrtf(wave_sum(o * o) * (1.f / 64.f) + EPS) * A->in[I_KNORM][(i * 3 + 0) * 64 + lane];
                const int tp = b * S + 16 * n + 31;
                const float c = cosT[tp * 32 + (lane & 31)], sn = sinT[tp * 32 + (lane & 31)];
                const float pr = __shfl_xor(y, 32);
                const float oo = lane < 32 ? y * c - pr * sn : y * c + pr * sn;
                ((bf16*)(ws + WS_KC))[((size_t)(b * 128 + n) * 2 + g) * 64 + lane] = (bf16)f2bf(oo);
            } else {
                bf16* vct = (bf16*)(ws + WS_VC) + ((size_t)(b * 2 + g) * 64 + lane) * 128;
                vct[(n & 64) + kpos64(n & 63)] = (bf16)f2bf(o);
                if (n == 126) vct[127] = 0;
            }
        }
    }
    __syncthreads();
}

__device__ __forceinline__ void phase_nsa_attn_mfma(KArgs A, int wv_, int i, LAS unsigned char* lds) {
    const int tid = opaque_tid(wv_), wid = __builtin_amdgcn_readfirstlane(tid >> 6), lane = tid & 63, fr = lane & 15, fq = lane >> 4;
    unsigned char* ws = opq(A->ws);
    const bf16* HY = (const bf16*)(ws + WS_BIG); const bf16* QA = (const bf16*)(ws + WS_QA); const bf16* KS = (const bf16*)(ws + WS_KS); const bf16* KW = (const bf16*)(ws + WS_KW);
    const bf16* KC = (const bf16*)(ws + WS_KC); const bf16* VCT = (const bf16*)(ws + WS_VC); const bf16* VTA = (const bf16*)(ws + WS_VTA); bf16* CAT = (bf16*)(ws + WS_CAT);
    constexpr int RS = 72;
    LAS bf16* ktl = (LAS bf16*)lds;
    LAS bf16* vtl = ktl + 4 * 64 * RS;
    LAS float* scl = (LAS float*)(lds + 73728) + wid * 256;
    LAS unsigned* msk = (LAS unsigned*)(lds + 73728 + 8192);
    LAS unsigned* umask = msk + 64;
    const float* gb = A->in[I_GATEB] + i * 24;
    unsigned long long tsub = 0, tt0 = 0;
    for (int pit = blockIdx.x; pit < 256; pit += gridDim.x) {
#pragma unroll 1
        for (int hf = 0; hf < 2; ++hf) {
            const int bg = pit >> 4, xx = pit & 15, x = hf ? 31 - xx : xx, b = bg >> 1, g = bg & 1;
            const size_t tokbase = (size_t)b * S + 64 * x;
            const int tl0 = 8 * wid + (fr >> 2);
            if (tid == 0) *umask = 0u;
            if (PROBE_NSA == 1) tt0 = __builtin_amdgcn_s_memrealtime();
            bf16x8 qf[2][2];
#pragma unroll
            for (int mt = 0; mt < 2; ++mt)
#pragma unroll
                for (int s = 0; s < 2; ++s) qf[mt][s] = *(const bf16x8*)(QA + (tokbase + tl0 + 4 * mt) * 512 + (g * 4 + (fr & 3)) * 64 + 32 * s + 8 * fq);
            f32x4 outacc[2][4];
            {
                const int tmaxc = (4 * x + 3 + 15) >> 4;
                const bf16* kcb = KC + ((size_t)(b * 128 + fr) * 2 + g) * 64 + 8 * fq;
                bf16x8 pcf[2][4];
#pragma unroll
                for (int mt = 0; mt < 2; ++mt) {
                    f32x4 sc[8];
                    const bf16* kp = kcb;
#pragma unroll
                    for (int t = 0; t < 8; ++t) { sc[t] = (f32x4){0.f, 0.f, 0.f, 0.f};
                        asm volatile("" : "+v"(kp));
                        if (t < tmaxc) {
                            const bf16x8 k0 = *(const bf16x8*)(kp), k1 = *(const bf16x8*)(kp + 32);
                            sc[t] = __builtin_amdgcn_mfma_f32_16x16x32_bf16(k0, qf[mt][0], sc[t], 0, 0, 0);
                            sc[t] = __builtin_amdgcn_mfma_f32_16x16x32_bf16(k1, qf[mt][1], sc[t], 0, 0, 0); }
                        kp += 16 * 128; }
                    const int tg = 64 * x + tl0 + 4 * mt; const int ncv = tg >= 31 ? ((tg - 31) >> 4) + 1 : 0;
                    float mx = -INFINITY;
#pragma unroll
                    for (int t = 0; t < 8; ++t)
#pragma unroll
                        for (int r = 0; r < 4; ++r) { const bool v = 16 * t + 4 * fq + r < ncv; sc[t][r] = v ? sc[t][r] : -INFINITY; mx = fmaxf(mx, sc[t][r]); }
                    mx = fmaxf(mx, __shfl_xor(mx, 16)); mx = fmaxf(mx, __shfl_xor(mx, 32));
                    const float mxs = mx == -INFINITY ? 0.f : mx;
                    float sum = 0.f;
#pragma unroll
                    for (int t = 0; t < 8; ++t)
#pragma unroll
                        for (int r = 0; r < 4; ++r) { sc[t][r] = __builtin_amdgcn_exp2f(sc[t][r] - mxs); sum += sc[t][r]; }
                    sum += __shfl_xor(sum, 16); sum += __shfl_xor(sum, 32);
                    const float inv = sum > 0.f ? 1.f / sum : 0.f;
#pragma unroll
                    for (int t = 0; t < 8; ++t) sc[t] = sc[t] * inv;
#pragma unroll
                    for (int s = 0; s < 4; ++s) { u32x4 w; w.x = pk2(sc[2 * s].x, sc[2 * s].y); w.y = pk2(sc[2 * s].z, sc[2 * s].w); w.z = pk2(sc[2 * s + 1].x, sc[2 * s + 1].y); w.w = pk2(sc[2 * s + 1].z, sc[2 * s + 1].w);
                        pcf[mt][s] = __builtin_bit_cast(bf16x8, w); }
                    float w3[8];
#pragma unroll
                    for (int t = 0; t < 8; ++t) {
#pragma unroll
                        for (int r = 0; r < 4; ++r) { float v = sc[t][r]; v += __shfl_xor(v, 1); v += __shfl_xor(v, 2); sc[t][r] = v; }
                        w3[t] = __shfl(sc[t].w, (lane + 48) & 63);
                    }
#pragma unroll
                    for (int t = 0; t < 8; ++t) {
                        const float prev = fq > 0 ? w3[t] : (t > 0 ? w3[t > 0 ? t - 1 : 0] : 0.f);
                        const float imp = sc[t].x + sc[t].y + sc[t].z + 0.5f * sc[t].w + 0.5f * prev;
                        if ((fr & 3) == 0) scl[(4 * mt + (fr >> 2)) * 32 + 4 * t + fq] = imp;
                    }
                    asm volatile("" ::: "memory");
                }
                const bf16* vcb = VCT + ((size_t)(b * 2 + g) * 64 + fr) * 128 + 8 * fq;
#pragma unroll
                for (int n = 0; n < 4; ++n) {
                    outacc[0][n] = (f32x4){0.f, 0.f, 0.f, 0.f}; outacc[1][n] = (f32x4){0.f, 0.f, 0.f, 0.f};
                    asm volatile("" : "+v"(vcb));
#pragma unroll
                    for (int s = 0; s < 4; ++s) if (2 * s < tmaxc) {
                        const bf16x8 vf = *(const bf16x8*)(vcb + 32 * s);
                        outacc[0][n] = __builtin_amdgcn_mfma_f32_16x16x32_bf16(vf, pcf[0][s], outacc[0][n], 0, 0, 0);
                        outacc[1][n] = __builtin_amdgcn_mfma_f32_16x16x32_bf16(vf, pcf[1][s], outacc[1][n], 0, 0, 0); }
                    vcb += 16 * 128;
                    asm volatile("" ::: "memory");
                }
            }
            float g1v[2], g2v[2];
#pragma unroll
            for (int mt = 0; mt < 2; ++mt) {
                const int head = g * 4 + (fr & 3);
                const bf16* gl = HY + (tokbase + tl0 + 4 * mt) * HYN + C_GA + head * 3;
                const float g0 = sigmoidf_(bf2f(gl[0]) + gb[head * 3 + 0]);
                g1v[mt] = sigmoidf_(bf2f(gl[1]) + gb[head * 3 + 1]); g2v[mt] = sigmoidf_(bf2f(gl[2]) + gb[head * 3 + 2]);
#pragma unroll
                for (int n = 0; n < 4; ++n) outacc[mt][n] = outacc[mt][n] * g0;
            }
            LDS_WAIT();
            asm volatile("" ::: "memory");
            {
                const int tok8 = lane >> 3, jg = lane & 7;
                float sj[32];
#pragma unroll
                for (int q = 0; q < 8; ++q) { const f32x4 v = *(const LAS f32x4*)(scl + tok8 * 32 + 4 * q); sj[4 * q] = v.x; sj[4 * q + 1] = v.y; sj[4 * q + 2] = v.z; sj[4 * q + 3] = v.w; }
#pragma unroll
                for (int j = 0; j < 32; ++j) sj[j] = j <= x ? sj[j] + ((j == 0 || j == x || j == x - 1) ? 1000.0f : 0.f) : -INFINITY;
                unsigned bits = 0u;
                const f32x4 mv = *(const LAS f32x4*)(scl + tok8 * 32 + 4 * jg);
#pragma unroll
                for (int q = 0; q < 4; ++q) {
                    const int j = 4 * jg + q;
                    const float mine = j <= x ? mv[q] + ((j == 0 || j == x || j == x - 1) ? 1000.0f : 0.f) : -INFINITY;
                    int rank = 0;
#pragma unroll
                    for (int jj = 0; jj < 32; ++jj) rank += (sj[jj] > mine || (sj[jj] == mine && jj < j)) ? 1 : 0;
                    bits |= (j <= x && rank < 8) ? (1u << j) : 0u;
                }
                bits |= __shfl_xor(bits, 1); bits |= __shfl_xor(bits, 2); bits |= __shfl_xor(bits, 4);
                if (jg == 0) { msk[wid * 8 + tok8] = bits; atomicOr((unsigned*)umask, bits); }
            }
            __syncthreads();
            if (PROBE_NSA == 1) tsub += __builtin_amdgcn_s_memrealtime() - tt0;
#pragma unroll 1
            for (int pp = 0; pp < 2 + (PROBE_NSAX ? 1 : 0); ++pp) {
                const int pass = pp == 2 ? 0 : pp; const bool dummy = pp == 2;
                if (PROBE_NSA == 2 + pass) tt0 = __builtin_amdgcn_s_memrealtime();
                const int jlo = pass ? (x >= 4 ? x - 4 : 0) : 0;
                const unsigned inrange = (x >= 31 ? 0xffffffffu : ((2u << x) - 1u)) & ~((1u << jlo) - 1u);
                unsigned bmask = pass ? inrange : (*umask & inrange);
                const bf16* Kb = pass ? KW : KS; const int cg = (pass ? 10 : 8) + g;
                unsigned tm[2], wm[2], am[2];
#pragma unroll
                for (int mt = 0; mt < 2; ++mt) {
                    tm[mt] = pass ? 0xffffffffu : msk[wid * 8 + 4 * mt + (fr >> 2)];
                    wm[mt] = pass ? 0xffffffffu : (msk[wid * 8 + 4 * mt] | msk[wid * 8 + 4 * mt + 1] | msk[wid * 8 + 4 * mt + 2] | msk[wid * 8 + 4 * mt + 3]);
                    am[mt] = pass ? 0xffffffffu : (msk[wid * 8 + 4 * mt] & msk[wid * 8 + 4 * mt + 1] & msk[wid * 8 + 4 * mt + 2] & msk[wid * 8 + 4 * mt + 3]);
                    wm[mt] = __builtin_amdgcn_readfirstlane(wm[mt]); am[mt] = __builtin_amdgcn_readfirstlane(am[mt]);
                    if (PROBE_NSAX == 2 && dummy) wm[mt] = 0u;
                }
                f32x4 o[2][4]; float mrun[2], lrun[2];
#pragma unroll
                for (int mt = 0; mt < 2; ++mt) { mrun[mt] = -INFINITY; lrun[mt] = 0.f;
#pragma unroll
                    for (int n = 0; n < 4; ++n) o[mt][n] = (f32x4){0.f, 0.f, 0.f, 0.f}; }
                const int srow = tid >> 3, sc16 = tid & 7;
                u32x4 pk0 = (u32x4){0u, 0u, 0u, 0u}, pv0 = pk0, pk1 = pk0, pv1 = pk0;
#define NSA_LD(jx, pk, pv) do { const bf16* ksrc = Kb + ((size_t)b * S + 64 * (jx) + srow) * 128 + g * 64 + sc16 * 8; const bf16* vsrc = VTA + ((size_t)((b * 32 + (jx)) * 12 + cg)) * 4096 + srow * 64 + sc16 * 8; \
                    pk = *(const u32x4*)ksrc; pv = *(const u32x4*)vsrc; } while (0)
                int j0 = __ffs(bmask) - 1; bmask &= bmask - 1u;
                int j1 = bmask ? __ffs(bmask) - 1 : -1; bmask &= bmask - 1u;
                NSA_LD(j0, pk0, pv0); if (j1 >= 0) NSA_LD(j1, pk1, pv1);
                int buf = 0;
                while (j0 >= 0) {
                    *(LAS u32x4*)(ktl + (buf * 2 + 0) * 64 * RS + srow * RS + sc16 * 8) = pk0; *(LAS u32x4*)(vtl + (buf * 2 + 0) * 64 * RS + srow * RS + sc16 * 8) = pv0;
                    if (j1 >= 0) { *(LAS u32x4*)(ktl + (buf * 2 + 1) * 64 * RS + srow * RS + sc16 * 8) = pk1; *(LAS u32x4*)(vtl + (buf * 2 + 1) * 64 * RS + srow * RS + sc16 * 8) = pv1; }
                    const int jn0 = bmask ? __ffs(bmask) - 1 : -1; bmask &= bmask - 1u;
                    const int jn1 = bmask ? __ffs(bmask) - 1 : -1; bmask &= bmask - 1u;
                    if (jn0 >= 0) NSA_LD(jn0, pk0, pv0);
                    if (jn1 >= 0) NSA_LD(jn1, pk1, pv1);
                    __syncthreads();
#pragma unroll 1
                    for (int sub = 0; sub < 2; ++sub) {
                        const int j = sub ? j1 : j0;
                        if (j < 0) break;
                        const LAS bf16* kt = ktl + (buf * 2 + sub) * 64 * RS + fr * RS + 8 * fq; const LAS bf16* vt = vtl + (buf * 2 + sub) * 64 * RS + fr * RS + 8 * fq;
#pragma unroll
                        for (int mt = 0; mt < 2; ++mt) {
                            if (!((wm[mt] >> j) & 1u)) continue;
                            f32x4 sc[4];
#pragma unroll
                            for (int t = 0; t < 4; ++t) { sc[t] = (f32x4){0.f, 0.f, 0.f, 0.f};
                                sc[t] = __builtin_amdgcn_mfma_f32_16x16x32_bf16(*(const LAS bf16x8*)(kt + t * 16 * RS), qf[mt][0], sc[t], 0, 0, 0);
                                sc[t] = __builtin_amdgcn_mfma_f32_16x16x32_bf16(*(const LAS bf16x8*)(kt + t * 16 * RS + 32), qf[mt][1], sc[t], 0, 0, 0); }
                            const int tl = tl0 + 4 * mt;
                            const bool rowok = (tm[mt] >> j) & 1u;
                            const bool edge = (j == x) || (pass && j == x - 4);
                            float bm = -INFINITY;
                            if (edge) {
                                const int kphi = j == x ? tl : 63;
                                const int kplo = (pass && j == x - 4) ? tl + 1 : 0;
#pragma unroll
                                for (int t = 0; t < 4; ++t)
#pragma unroll
                                    for (int r = 0; r < 4; ++r) { const int kp = 16 * t + 4 * fq + r; const bool v = rowok && kp <= kphi && kp >= kplo; sc[t][r] = v ? sc[t][r] : -INFINITY; bm = fmaxf(bm, sc[t][r]); }
                            } else {
#pragma unroll
                                for (int t = 0; t < 4; ++t) bm = fmaxf(bm, fmaxf(fmaxf(sc[t].x, sc[t].y), fmaxf(sc[t].z, sc[t].w)));
                                if (!((am[mt] >> j) & 1u)) bm = rowok ? bm : -INFINITY;
                            }
                            bm = fmaxf(bm, __shfl_xor(bm, 16)); bm = fmaxf(bm, __shfl_xor(bm, 32));
                            const float mn = fmaxf(mrun[mt], bm); const float mns = mn == -INFINITY ? 0.f : mn;
                            float rs = 0.f;
#pragma unroll
                            for (int t = 0; t < 4; ++t)
#pragma unroll
                                for (int r = 0; r < 4; ++r) { sc[t][r] = __builtin_amdgcn_exp2f(sc[t][r] - mns); rs += sc[t][r]; }
                            if (!edge && !((am[mt] >> j) & 1u)) {
#pragma unroll
                                for (int t = 0; t < 4; ++t) sc[t] = rowok ? sc[t] : (f32x4){0.f, 0.f, 0.f, 0.f};
                                rs = rowok ? rs : 0.f;
                            }
                            rs += __shfl_xor(rs, 16); rs += __shfl_xor(rs, 32);
                            if (__all(mn == mrun[mt])) { lrun[mt] += rs; }
                            else {
                                const float alpha = __builtin_amdgcn_exp2f(mrun[mt] - mns);
                                lrun[mt] = lrun[mt] * alpha + rs; mrun[mt] = mn;
#pragma unroll
                                for (int n = 0; n < 4; ++n) o[mt][n] = o[mt][n] * alpha;
                            }
                            bf16x8 pf[2];
#pragma unroll
                            for (int s = 0; s < 2; ++s) { u32x4 w; w.x = pk2(sc[2 * s].x, sc[2 * s].y); w.y = pk2(sc[2 * s].z, sc[2 * s].w); w.z = pk2(sc[2 * s + 1].x, sc[2 * s + 1].y); w.w = pk2(sc[2 * s + 1].z, sc[2 * s + 1].w);
                                pf[s] = __builtin_bit_cast(bf16x8, w); }
#pragma unroll
                            for (int n = 0; n < 4; ++n) {
                                o[mt][n] = __builtin_amdgcn_mfma_f32_16x16x32_bf16(*(const LAS bf16x8*)(vt + n * 16 * RS), pf[0], o[mt][n], 0, 0, 0);
                                o[mt][n] = __builtin_amdgcn_mfma_f32_16x16x32_bf16(*(const LAS bf16x8*)(vt + n * 16 * RS + 32), pf[1], o[mt][n], 0, 0, 0); }
                        }
                    }
                    j0 = jn0; j1 = jn1; buf ^= 1;
                }
#undef NSA_LD
#pragma unroll
                for (int mt = 0; mt < 2; ++mt) { const float sc_ = (pass ? g2v[mt] : g1v[mt]) / lrun[mt];
                    if (!dummy) {
#pragma unroll
                    for (int n = 0; n < 4; ++n) outacc[mt][n] = outacc[mt][n] + o[mt][n] * sc_; } }
                __syncthreads();
                if (PROBE_NSA == 2 + pass) tsub += __builtin_amdgcn_s_memrealtime() - tt0;
            }
#pragma unroll
            for (int mt = 0; mt < 2; ++mt) {
                bf16* dst = CAT + (tokbase + tl0 + 4 * mt) * 1024 + (g * 4 + (fr & 3)) * 64 + 4 * fq;
#pragma unroll
                for (int n = 0; n < 4; ++n) { u32x2 w; w.x = pk2(outacc[mt][n].x, outacc[mt][n].y); w.y = pk2(outacc[mt][n].z, outacc[mt][n].w); *(u32x2*)(dst + 16 * n) = w; }
            }
        }
    }
    __syncthreads();
    if (PROBE_NSA && blockIdx.x == 0 && tid == 0) atomicAdd((unsigned long long*)(ws + WS_CTL + 48000), tsub);
}

__device__ __forceinline__ void phase_vtiles(KArgs A, int wv_, LAS unsigned char* lds) {
    const int tid_ = opaque_tid(wv_); const int wid = __builtin_amdgcn_readfirstlane(tid_ >> 6), lane = tid_ & 63; const int gw = blockIdx.x * 8 + wid, NGW = gridDim.x * 8;
    unsigned char* ws = opq(A->ws);
    const bf16* HY = (const bf16*)(ws + WS_BIG); bf16* VTA = (bf16*)(ws + WS_VTA);
    constexpr int TS = 66;
    LAS bf16* tl = (LAS bf16*)(lds + 65536) + wid * (64 * TS);
    for (int it = gw; it < NBATCH * 32 * 12; it += NGW) {
        const int cg = it % 12, bc = it / 12;
        const int colbase = cg < 8 ? C_VB + cg * 64 : (cg < 10 ? C_VS + (cg - 8) * 64 : C_VW + (cg - 10) * 64);
        const u32x4* src = (const u32x4*)(HY + (size_t)(bc * 64 + lane) * HYN + colbase);
        u32x4 w[8];
#pragma unroll
        for (int i = 0; i < 8; ++i) w[i] = src[i];
#pragma unroll
        for (int i = 0; i < 8; ++i) { LAS unsigned* d = (LAS unsigned*)(tl + lane * TS + 8 * i); d[0] = w[i].x; d[1] = w[i].y; d[2] = w[i].z; d[3] = w[i].w; }
        LDS_WAIT();
        bf16* dst = VTA + (size_t)it * 4096 + lane * 64;
#pragma unroll
        for (int p8 = 0; p8 < 8; ++p8) {
            unsigned short x[8];
#pragma unroll
            for (int j = 0; j < 8; ++j) x[j] = tl[kperm64(p8 * 8 + j) * TS + lane];
            u32x4 o; o.x = x[0] | ((unsigned)x[1] << 16); o.y = x[2] | ((unsigned)x[3] << 16); o.z = x[4] | ((unsigned)x[5] << 16); o.w = x[6] | ((unsigned)x[7] << 16);
            *(u32x4*)(dst + p8 * 8) = o;
        }
        LDS_WAIT();
    }
}

__device__ __forceinline__ void vtrans_wave(KArgs A, int wv_, LAS bf16* tl, const int gw, const int NGW) {
    const int tid_ = opaque_tid(wv_); const int lane = tid_ & 63;
    unsigned char* ws = opq(A->ws);
    const bf16* KV = (const bf16*)(ws + WS_KV); bf16* VT = (bf16*)(ws + WS_VT);
    constexpr int TS = 66;
    for (int it = gw; it < DEPTH * NBATCH * 4 * 16; it += NGW) {
        const int db = it & 3, kb = (it >> 2) & 3, h = (it >> 4) & 3, b = (it >> 6) & 7, l = it >> 9;
        const u32x4* src = (const u32x4*)(KV + (size_t)(b * 256 + 64 * kb + lane) * 8192 + l * 2048 + 1024 + h * 256 + 64 * db);
        u32x4 w[8];
#pragma unroll
        for (int i = 0; i < 8; ++i) w[i] = src[i];
#pragma unroll
        for (int i = 0; i < 8; ++i) { LAS unsigned* d = (LAS unsigned*)(tl + lane * TS + 8 * i); d[0] = w[i].x; d[1] = w[i].y; d[2] = w[i].z; d[3] = w[i].w; }
        LDS_WAIT();
        bf16* dst = VT + ((size_t)((l * 8 + b) * 4 + h) * 256 + 64 * db + lane) * 256 + 64 * kb;
#pragma unroll
        for (int p8 = 0; p8 < 8; ++p8) {
            unsigned short x[8];
#pragma unroll
            for (int j = 0; j < 8; ++j) x[j] = tl[kperm64(p8 * 8 + j) * TS + lane];
            u32x4 o; o.x = x[0] | ((unsigned)x[1] << 16); o.y = x[2] | ((unsigned)x[3] << 16); o.z = x[4] | ((unsigned)x[5] << 16); o.w = x[6] | ((unsigned)x[7] << 16);
            *(u32x4*)(dst + p8 * 8) = o;
        }
        LDS_WAIT();
    }
}

__device__ __forceinline__ float log_sigmoid16(float z) { return (fminf(z, 0.f) - __logf(1.0f + __expf(-fabsf(z)))) * (1.f / 16.f); }
#define GLA_Z(tokv) ({ float z_ = bias; _Pragma("unroll") for (int r_ = 0; r_ < 16; ++r_) z_ += __builtin_bit_cast(float, __builtin_amdgcn_readlane(__builtin_bit_cast(int, al[r_]), (tokv))) * wc[r_]; z_; })
#define GLA_LOAD_GATE() \
    float al[16], wc[16]; \
    { const u32x4* ap_ = (const u32x4*)(HY + (size_t)(tok0 + lane) * HYN + C_AL); const u32x4 a0_ = ap_[0], a1_ = ap_[1]; \
      al[0] = bflo(a0_.x); al[1] = bfhi(a0_.x); al[2] = bflo(a0_.y); al[3] = bfhi(a0_.y); al[4] = bflo(a0_.z); al[5] = bfhi(a0_.z); al[6] = bflo(a0_.w); al[7] = bfhi(a0_.w); \
      al[8] = bflo(a1_.x); al[9] = bfhi(a1_.x); al[10] = bflo(a1_.y); al[11] = bfhi(a1_.y); al[12] = bflo(a1_.z); al[13] = bfhi(a1_.z); al[14] = bflo(a1_.w); al[15] = bfhi(a1_.w); } \
    _Pragma("unroll") for (int r_ = 0; r_ < 16; ++r_) wc[r_] = A->in[I_WA2][(i * 16 + r_) * 256 + h * 64 + lane]; \
    const float bias = A->in[I_BA][i * 256 + h * 64 + lane];

__device__ __forceinline__ void phase_gla_a(KArgs A, int wv_, int i, LAS unsigned char* lds) {
    const int tid_ = opaque_tid(wv_); const int wid = __builtin_amdgcn_readfirstlane(tid_ >> 6), lane = tid_ & 63, fr = lane & 15, fq = lane >> 4; const int gw = blockIdx.x * 8 + wid, NGW = gridDim.x * 8;
    unsigned char* ws = opq(A->ws);
    const bf16* HY = (const bf16*)(ws + WS_BIG); const bf16* VTA = (const bf16*)(ws + WS_VTA); float* SLOC = (float*)(ws + WS_SLOC); float* DEC = (float*)(ws + WS_DEC);
    constexpr int RS = 72;
    LAS bf16* kh = (LAS bf16*)lds + wid * (64 * RS);
    (void)gw;
    for (int it = wid * (int)gridDim.x + (int)blockIdx.x; it < 1024; it += NGW) {
        const int c = it & 31, bh = it >> 5, b = bh >> 2, h = bh & 3; const size_t tok0 = (size_t)b * S + c * 64;
        GLA_LOAD_GATE();
        float bl = 0.f; float la[64];
#pragma unroll
        for (int tk = 0; tk < 64; ++tk) { la[tk] = log_sigmoid16(GLA_Z(tk)); bl += la[tk]; }
        float bc = 0.f;
        unsigned short kcol[64];
#pragma unroll
        for (int tk = 0; tk < 64; ++tk) kcol[tk] = HY[(tok0 + tk) * HYN + C_KB + h * 64 + lane];
#pragma unroll
        for (int tk = 0; tk < 64; ++tk) {
            bc += la[tk];
            kh[lane * RS + kpos64(tk)] = (bf16)f2bf(bf2f(kcol[tk]) * __expf(bl - bc));
        }
        DEC[it * 64 + lane] = __expf(bl);
        LDS_WAIT();
#pragma unroll
        for (int dvh = 0; dvh < 2; ++dvh) {
            const bf16* vt = VTA + ((size_t)((b * 32 + c) * 12 + h * 2 + dvh)) * 4096;
            bf16x8 vf[4][2];
#pragma unroll
            for (int n = 0; n < 4; ++n)
#pragma unroll
                for (int s = 0; s < 2; ++s) vf[n][s] = *(const bf16x8*)(vt + (16 * n + fr) * 64 + 32 * s + 8 * fq);
#pragma unroll
            for (int m = 0; m < 4; ++m) {
                const bf16x8 a0 = *(const LAS bf16x8*)(kh + (16 * m + fr) * RS + 8 * fq), a1 = *(const LAS bf16x8*)(kh + (16 * m + fr) * RS + 32 + 8 * fq);
#pragma unroll
                for (int n = 0; n < 4; ++n) {
                    f32x4 acc = (f32x4){0.f, 0.f, 0.f, 0.f};
                    acc = __builtin_amdgcn_mfma_f32_16x16x32_bf16(a0, vf[n][0], acc, 0, 0, 0);
                    acc = __builtin_amdgcn_mfma_f32_16x16x32_bf16(a1, vf[n][1], acc, 0, 0, 0);
                    float* dst = SLOC + ((size_t)it * 64 + 16 * m + 4 * fq) * 128 + dvh * 64 + 16 * n + fr;
                    dst[0] = acc.x; dst[128] = acc.y; dst[256] = acc.z; dst[384] = acc.w;
                }
            }
        }
        LDS_WAIT();
    }
}
__device__ __forceinline__ void phase_gla_c(KArgs A, int wv_, int i, LAS unsigned char* lds, const bool kv_post) {
    const int tid_ = opaque_tid(wv_); const int wid = __builtin_amdgcn_readfirstlane(tid_ >> 6), lane = tid_ & 63, fr = lane & 15, fq = lane >> 4; const int gw = blockIdx.x * 8 + wid, NGW = gridDim.x * 8;
    unsigned char* ws = opq(A->ws);
    const bf16* HY = (const bf16*)(ws + WS_BIG); const bf16* VTA = (const bf16*)(ws + WS_VTA); const bf16* STT = (const bf16*)(ws + WS_STT); bf16* CAT = (bf16*)(ws + WS_CAT);
    constexpr int RS = 72;
    LAS bf16* qs = (LAS bf16*)lds + wid * (128 * RS);
    LAS bf16* ks = qs + 64 * RS;
    const float* og = A->in[I_ONORM] + i * 128;
    LAS float* ogl = (LAS float*)(lds + 8 * 128 * RS * 2);
    if (tid_ < 128) ogl[tid_] = og[tid_];
    (void)gw; (void)NGW;
    for (int blk = blockIdx.x; blk < 256; blk += gridDim.x) {
        SUBT_BEGIN(1);
        {
            const float* SLOC = (const float*)(ws + WS_SLOC); const float* DEC = (const float*)(ws + WS_DEC); bf16* STw = (bf16*)(ws + WS_STT);
            const int tid = tid_, dv = tid & 127, ko = tid >> 7, bh = blk >> 3, c0 = (blk & 7) * 4;
            float sv[16];
#pragma unroll
            for (int j = 0; j < 16; ++j) sv[j] = 0.f;
#pragma unroll 1
            for (int cb = 0; cb < c0 + 4; cb += 4) {
                float dc4[4][16], sl4[4][16];
#pragma unroll
                for (int q = 0; q < 4; ++q) {
                    const size_t item = (size_t)bh * 32 + cb + q; const float* sl = SLOC + (item * 64 + ko * 16) * 128 + dv; const float* dc = DEC + item * 64 + ko * 16;
#pragma unroll
                    for (int j = 0; j < 16; ++j) { dc4[q][j] = dc[j]; sl4[q][j] = sl[j * 128]; }
                }
#pragma unroll
                for (int q = 0; q < 4; ++q) {
                    const int c = cb + q; const size_t item = (size_t)bh * 32 + c;
                    if (c >= c0) {
                        u32x4 o0, o1; o0.x = pk2(sv[0], sv[1]); o0.y = pk2(sv[2], sv[3]); o0.z = pk2(sv[4], sv[5]); o0.w = pk2(sv[6], sv[7]);
                        o1.x = pk2(sv[8], sv[9]); o1.y = pk2(sv[10], sv[11]); o1.z = pk2(sv[12], sv[13]); o1.w = pk2(sv[14], sv[15]);
                        u32x4* d = (u32x4*)(STw + (item * 128 + dv) * 64 + ko * 16); d[0] = o0; d[1] = o1;
                    }
#pragma unroll
                    for (int j = 0; j < 16; ++j) sv[j] = dc4[q][j] * sv[j] + sl4[q][j];
                }
            }
            asm volatile("s_waitcnt vmcnt(0)" ::: "memory");
            __syncthreads();
        }
        SUBT_END(1, ws, tid_);
        SUBT_BEGIN(2);
        SUBT_BEGIN(3);
        if (wid < 4) {
        const int it = blk * 4 + wid;
        const int c = it & 31, bh = it >> 5, b = bh >> 2, h = bh & 3; const size_t tok0 = (size_t)b * S + c * 64;
        GLA_LOAD_GATE();
        float bc = 0.f;
        unsigned short qcol[64], kcol[64];
#pragma unroll
        for (int tk = 0; tk < 64; ++tk) { const bf16* row = HY + (tok0 + tk) * HYN; qcol[tk] = row[C_QB + h * 64 + lane]; kcol[tk] = row[C_KB + h * 64 + lane]; }
#pragma unroll
        for (int tk = 0; tk < 64; ++tk) {
            bc += log_sigmoid16(GLA_Z(tk));
            const float eb = __expf(bc);
            qs[tk * RS + lane] = (bf16)f2bf(bf2f(qcol[tk]) * 0.125f * eb); ks[tk * RS + lane] = (bf16)f2bf(bf2f(kcol[tk]) / eb);
        }
        LDS_WAIT();
        SUBT_END(2, ws, tid_);
        bf16x8 st[8][2];
#pragma unroll
        for (int n = 0; n < 8; ++n)
#pragma unroll
            for (int s = 0; s < 2; ++s) st[n][s] = *(const bf16x8*)(STT + ((size_t)it * 128 + 16 * n + fr) * 64 + 32 * s + 8 * fq);
        const bf16* vt = VTA + ((size_t)((b * 32 + c) * 12 + h * 2)) * 4096;
        bf16x8 vfr[8][2];
#pragma unroll
        for (int n = 0; n < 8; ++n) { const bf16* vrow = vt + (size_t)(n >> 2) * 4096 + (16 * (n & 3) + fr) * 64 + 8 * fq; vfr[n][0] = *(const bf16x8*)vrow; vfr[n][1] = *(const bf16x8*)(vrow + 32); }
#pragma unroll
        for (int mi = 0; mi < 4; ++mi) {
            const bf16x8 q0 = *(const LAS bf16x8*)(qs + (16 * mi + fr) * RS + 8 * fq), q1 = *(const LAS bf16x8*)(qs + (16 * mi + fr) * RS + 32 + 8 * fq);
            u32x2 rwv[8];
#pragma unroll
            for (int n = 0; n < 8; ++n) rwv[n] = *(const u32x2*)(HY + (tok0 + 16 * mi + fr) * HYN + C_RB + h * 128 + 16 * n + 4 * fq);
            f32x4 sc[4];
#pragma unroll
            for (int t = 0; t < 4; ++t) {
                sc[t] = (f32x4){0.f, 0.f, 0.f, 0.f};
                if (t <= mi) {
                    const bf16x8 k0 = *(const LAS bf16x8*)(ks + (16 * t + fr) * RS + 8 * fq), k1 = *(const LAS bf16x8*)(ks + (16 * t + fr) * RS + 32 + 8 * fq);
                    sc[t] = __builtin_amdgcn_mfma_f32_16x16x32_bf16(k0, q0, sc[t], 0, 0, 0);
                    sc[t] = __builtin_amdgcn_mfma_f32_16x16x32_bf16(k1, q1, sc[t], 0, 0, 0);
                    if (t == mi) {
                        sc[t].x = (4 * fq + 0 <= fr) ? sc[t].x : 0.f; sc[t].y = (4 * fq + 1 <= fr) ? sc[t].y : 0.f; sc[t].z = (4 * fq + 2 <= fr) ? sc[t].z : 0.f; sc[t].w = (4 * fq + 3 <= fr) ? sc[t].w : 0.f; }
                }
            }
            bf16x8 pf[2];
#pragma unroll
            for (int s = 0; s < 2; ++s) { u32x4 w; w.x = pk2(sc[2 * s].x, sc[2 * s].y); w.y = pk2(sc[2 * s].z, sc[2 * s].w); w.z = pk2(sc[2 * s + 1].x, sc[2 * s + 1].y); w.w = pk2(sc[2 * s + 1].z, sc[2 * s + 1].w);
                pf[s] = __builtin_bit_cast(bf16x8, w); }
            f32x4 o[8]; float ssq = 0.f;
#pragma unroll
            for (int n = 0; n < 8; ++n) {
                o[n] = (f32x4){0.f, 0.f, 0.f, 0.f};
                o[n] = __builtin_amdgcn_mfma_f32_16x16x32_bf16(st[n][0], q0, o[n], 0, 0, 0);
                o[n] = __builtin_amdgcn_mfma_f32_16x16x32_bf16(st[n][1], q1, o[n], 0, 0, 0);
                o[n] = __builtin_amdgcn_mfma_f32_16x16x32_bf16(vfr[n][0], pf[0], o[n], 0, 0, 0);
                if (mi >= 2) o[n] = __builtin_amdgcn_mfma_f32_16x16x32_bf16(vfr[n][1], pf[1], o[n], 0, 0, 0);
                ssq += (o[n].x * o[n].x + o[n].y * o[n].y) + (o[n].z * o[n].z + o[n].w * o[n].w);
            }
            ssq += __shfl_xor(ssq, 16); ssq += __shfl_xor(ssq, 32);
            const float rstd = rsqrtf(ssq * (1.f / 128.f) + EPS);
            const size_t tok = tok0 + 16 * mi + fr;
#pragma unroll
            for (int n = 0; n < 8; ++n) {
                const int dv = 16 * n + 4 * fq;
                const u32x2 rw = rwv[n]; const f32x4 g = *(const LAS f32x4*)(ogl + dv);
                const float r0 = bflo(rw.x), r1 = bfhi(rw.x), r2 = bflo(rw.y), r3 = bfhi(rw.y);
                u32x2 w; w.x = pk2(o[n].x * rstd * g.x * (r0 * sigmoidf_(r0)), o[n].y * rstd * g.y * (r1 * sigmoidf_(r1)));
                w.y = pk2(o[n].z * rstd * g.z * (r2 * sigmoidf_(r2)), o[n].w * rstd * g.w * (r3 * sigmoidf_(r3)));
                *(u32x2*)(CAT + tok * 1024 + 512 + h * 128 + dv) = w;
            }
        }
        } else if (kv_post) {
            phase_knorm(A, wv_, blk * 4 + (wid - 4), 256 * 4);
            vtrans_wave(A, wv_, (LAS bf16*)(lds + 81920) + (wid - 4) * (64 * 66), blk * 4 + (wid - 4), 256 * 4);
        }
        SUBT_END(3, ws, tid_);
        LDS_WAIT();
        __syncthreads();
    }
}

__device__ __forceinline__ void phase_sgu_mix_mfma(KArgs A, int wv_, int i, LAS unsigned char* lds) {
    const int tid = opaque_tid(wv_), wid = __builtin_amdgcn_readfirstlane(tid >> 6), lane = tid & 63, fr = lane & 15, fq = lane >> 4;
    unsigned char* ws = opq(A->ws);
    const bf16* U = (const bf16*)(ws + WS_U); const bf16* V = (const bf16*)(ws + WS_V); bf16* UM = (bf16*)(ws + WS_UM);
    const bf16* WSB = (const bf16*)(ws + WS_WSB) + (size_t)i * 8 * 16384; const float* M0 = (const float*)(ws + WS_M0) + i * 8 * 128;
    constexpr int VS = 136;
    LAS bf16* vT = (LAS bf16*)lds;
    LAS float* st = (LAS float*)(lds + 256 * VS * 2);
    LAS bf16* wl = (LAS bf16*)(lds + 256 * VS * 2 + 1024);
    const float* lng = A->in[I_LNG] + i * 2048; const float* lnb = A->in[I_LNB] + i * 2048; const float* bsg = A->in[I_SGBS] + i * 8 * 128;
    for (int it = blockIdx.x; it < 256; it += gridDim.x) {
        const int gh = it & 1, n_ = (it >> 1) & 15, b = it >> 5; const size_t tok0 = (size_t)b * S + n_ * 128;
        __syncthreads();
        {
            const float* vst = (const float*)(ws + WS_VSTAT);
#pragma unroll
            for (int s4 = 0; s4 < 16; s4 += 4) {
                const int s = wid * 16 + s4 + (lane >> 4);
                const f32x4 p = *(const f32x4*)(vst + (tok0 + s) * 64 + 4 * (lane & 15));
                float sum = p.x + p.z, sq = p.y + p.w;
                sum += __shfl_xor(sum, 1); sq += __shfl_xor(sq, 1); sum += __shfl_xor(sum, 2); sq += __shfl_xor(sq, 2);
                sum += __shfl_xor(sum, 4); sq += __shfl_xor(sq, 4); sum += __shfl_xor(sum, 8); sq += __shfl_xor(sq, 8);
                const float mean = sum * (1.f / 2048.f); const float var = fmaxf(sq * (1.f / 2048.f) - mean * mean, 0.f);
                if ((lane & 15) == 0) { st[2 * s] = mean; st[2 * s + 1] = rsqrtf(var + EPS); }
            }
        }
#pragma unroll 1
        for (int gg = 0; gg < 4; ++gg) {
            const int g = gh * 4 + gg;
            __syncthreads();
            {
                const int s = tid & 127, cq = tid >> 7;
                const float mean = st[2 * s], rstd = st[2 * s + 1];
                const u32x4* src = (const u32x4*)(V + (tok0 + s) * 2048 + g * 256 + cq * 64);
                u32x4 w8[8], ww[4];
#pragma unroll
                for (int i8 = 0; i8 < 8; ++i8) w8[i8] = src[i8];
#pragma unroll
                for (int q = 0; q < 4; ++q) { const int e = tid + 512 * q; ww[q] = *(const u32x4*)(WSB + ((size_t)g * 128 + (e >> 4)) * 128 + (e & 15) * 8); }
#pragma unroll
                for (int i8 = 0; i8 < 8; ++i8) {
                    const u32x4 w = w8[i8];
                    LAS bf16* d = vT + (cq * 64 + i8 * 8) * VS + s;
                    d[0 * VS] = (bf16)f2bf((bflo(w.x) - mean) * rstd); d[1 * VS] = (bf16)f2bf((bfhi(w.x) - mean) * rstd); d[2 * VS] = (bf16)f2bf((bflo(w.y) - mean) * rstd); d[3 * VS] = (bf16)f2bf((bfhi(w.y) - mean) * rstd);
                    d[4 * VS] = (bf16)f2bf((bflo(w.z) - mean) * rstd); d[5 * VS] = (bf16)f2bf((bfhi(w.z) - mean) * rstd); d[6 * VS] = (bf16)f2bf((bflo(w.w) - mean) * rstd); d[7 * VS] = (bf16)f2bf((bfhi(w.w) - mean) * rstd);
                }
#pragma unroll
                for (int q = 0; q < 4; ++q) { const int e = tid + 512 * q; *(LAS u32x4*)(wl + (e >> 4) * VS + (e & 15) * 8) = ww[q]; }
            }
            u32x2 uw[8][2]; float m0v[8], bsv[8];
#pragma unroll
            for (int n = 0; n < 8; ++n) { const int t = 16 * n + fr; m0v[n] = M0[g * 128 + t]; bsv[n] = bsg[g * 128 + t];
                const size_t ro = (tok0 + t) * 2048 + g * 256 + 32 * wid + 4 * fq; uw[n][0] = *(const u32x2*)(U + ro); uw[n][1] = *(const u32x2*)(U + ro + 16); }
            __syncthreads();
            bf16x8 vf[2][4];
#pragma unroll
            for (int m = 0; m < 2; ++m)
#pragma unroll
                for (int k = 0; k < 4; ++k) vf[m][k] = *(const LAS bf16x8*)(vT + (32 * wid + 16 * m + fr) * VS + 32 * k + 8 * fq);
            f32x4 gc[2], bc[2];
#pragma unroll
            for (int m = 0; m < 2; ++m) { gc[m] = *(const f32x4*)(lng + g * 256 + 32 * wid + 16 * m + 4 * fq); bc[m] = *(const f32x4*)(lnb + g * 256 + 32 * wid + 16 * m + 4 * fq); }
#pragma unroll
            for (int n = 0; n < 8; ++n) {
                f32x4 a0 = (f32x4){0.f, 0.f, 0.f, 0.f}, a1 = (f32x4){0.f, 0.f, 0.f, 0.f};
#pragma unroll
                for (int k = 0; k < 4; ++k) if (k <= (n >> 1)) {
                    const bf16x8 wf = *(const LAS bf16x8*)(wl + (16 * n + fr) * VS + 32 * k + 8 * fq);
                    a0 = __builtin_amdgcn_mfma_f32_16x16x32_bf16(vf[0][k], wf, a0, 0, 0, 0);
                    a1 = __builtin_amdgcn_mfma_f32_16x16x32_bf16(vf[1][k], wf, a1, 0, 0, 0); }
                const int t = 16 * n + fr; const float m0 = m0v[n], bsv_ = bsv[n];
                const size_t ro = (tok0 + t) * 2048 + g * 256 + 32 * wid + 4 * fq;
#pragma unroll
                for (int m = 0; m < 2; ++m) {
                    const f32x4 a = m ? a1 : a0;
                    const u32x2 uw_ = uw[n][m];
                    u32x2 w; w.x = pk2((a.x * gc[m].x + bc[m].x * m0 + bsv_) * bflo(uw_.x), (a.y * gc[m].y + bc[m].y * m0 + bsv_) * bfhi(uw_.x));
                    w.y = pk2((a.z * gc[m].z + bc[m].z * m0 + bsv_) * bflo(uw_.y), (a.w * gc[m].w + bc[m].w * m0 + bsv_) * bfhi(uw_.y));
                    *(u32x2*)(UM + ro + 16 * m) = w;
                }
            }
        }
    }
    __syncthreads();
}

__device__ __forceinline__ void xattn_item(KArgs A, int wv_, int L, LAS unsigned char* lds, const int b, const int h, const int qt) {
    const int tid = opaque_tid(wv_), wid = __builtin_amdgcn_readfirstlane(tid >> 6), lane = tid & 63, fr = lane & 15, fq = lane >> 4;
    unsigned char* ws = opq(A->ws);
    const bf16* QX = (const bf16*)(ws + WS_QX); const bf16* KV = (const bf16*)(ws + WS_KV); const bf16* VT = (const bf16*)(ws + WS_VT); bf16* OX = (bf16*)(ws + WS_OX);
    constexpr int RS = 264;
    LAS bf16* kl = (LAS bf16*)lds;
    const float* qg = A->in[I_XQN] + L * 256;
    {
        __syncthreads();
        {
            const int row = tid >> 1, hf = tid & 1;
            const u32x4* src = (const u32x4*)(KV + (size_t)(b * 256 + row) * 8192 + L * 2048 + h * 256 + hf * 128);
#pragma unroll
            for (int i0 = 0; i0 < 16; i0 += 8) {
                u32x4 w[8];
#pragma unroll
                for (int i = 0; i < 8; ++i) w[i] = src[i0 + i];
#pragma unroll
                for (int i = 0; i < 8; ++i) *(LAS u32x4*)(kl + row * RS + hf * 128 + (i0 + i) * 8) = w[i];
            }
        }
        const size_t tok0 = (size_t)b * S + qt * 256 + wid * 32 + fr;
        u32x4 qw0[8], qw1[8];
#pragma unroll
        for (int s = 0; s < 8; ++s) { qw0[s] = *(const u32x4*)(QX + tok0 * 1024 + h * 256 + 32 * s + 8 * fq); qw1[s] = *(const u32x4*)(QX + (tok0 + 16) * 1024 + h * 256 + 32 * s + 8 * fq); }
        __syncthreads();
        bf16x8 pf0[8], pf1[8]; float inv0, inv1;
        auto s_part = [&](const u32x4 (&qw)[8], bf16x8 (&pf)[8], float& inv) __attribute__((always_inline)) {
            float ssq = 0.f;
#pragma unroll
            for (int s = 0; s < 8; ++s) {
                const float a0 = bflo(qw[s].x), a1 = bfhi(qw[s].x), a2 = bflo(qw[s].y), a3 = bfhi(qw[s].y), a4 = bflo(qw[s].z), a5 = bfhi(qw[s].z), a6 = bflo(qw[s].w), a7 = bfhi(qw[s].w);
                ssq += (a0 * a0 + a1 * a1) + (a2 * a2 + a3 * a3) + (a4 * a4 + a5 * a5) + (a6 * a6 + a7 * a7);
            }
            ssq += __shfl_xor(ssq, 16); ssq += __shfl_xor(ssq, 32);
            const float rstd = rsqrtf(ssq * (1.f / 256.f) + EPS);
            bf16x8 qf[8];
#pragma unroll
            for (int s = 0; s < 8; ++s) qf[s] = __builtin_bit_cast(bf16x8, qw[s]);
            f32x4 sc[16];
#pragma unroll
            for (int hf = 0; hf < 2; ++hf) {
                unsigned kb = (unsigned)(size_t)(kl + (128 * hf + fr) * RS + 8 * fq); asm volatile("" : "+v"(kb));
#pragma unroll
                for (int t8 = 0; t8 < 8; ++t8) { const int t = 8 * hf + t8; sc[t] = (f32x4){0.f, 0.f, 0.f, 0.f};
#pragma unroll
                    for (int s = 0; s < 8; ++s) { const bf16x8 kf = *(const LAS bf16x8*)(size_t)(kb + (unsigned)((16 * t8 * RS + 32 * s) * 2));
                        sc[t] = __builtin_amdgcn_mfma_f32_16x16x32_bf16(kf, qf[s], sc[t], 0, 0, 0); }
                    if (t & 1) asm volatile("" ::: "memory"); }
            }
            float mx = -INFINITY;
#pragma unroll
            for (int t = 0; t < 16; ++t) mx = fmaxf(mx, fmaxf(fmaxf(sc[t].x, sc[t].y), fmaxf(sc[t].z, sc[t].w)));
            mx = fmaxf(mx, __shfl_xor(mx, 16)); mx = fmaxf(mx, __shfl_xor(mx, 32));
            float lsum = 0.f;
#pragma unroll
            for (int t = 0; t < 16; ++t) { sc[t].x = __expf((sc[t].x - mx) * rstd); sc[t].y = __expf((sc[t].y - mx) * rstd); sc[t].z = __expf((sc[t].z - mx) * rstd); sc[t].w = __expf((sc[t].w - mx) * rstd); lsum += (sc[t].x + sc[t].y) + (sc[t].z + sc[t].w); }
            lsum += __shfl_xor(lsum, 16); lsum += __shfl_xor(lsum, 32);
            inv = 1.f / lsum;
#pragma unroll
            for (int s = 0; s < 8; ++s) { u32x4 w; w.x = pk2(sc[2 * s].x, sc[2 * s].y); w.y = pk2(sc[2 * s].z, sc[2 * s].w); w.z = pk2(sc[2 * s + 1].x, sc[2 * s + 1].y); w.w = pk2(sc[2 * s + 1].z, sc[2 * s + 1].w);
                pf[s] = __builtin_bit_cast(bf16x8, w); }
        };
        s_part(qw0, pf0, inv0);
        s_part(qw1, pf1, inv1);
        __syncthreads();
        {
            const int row = tid >> 1, hf = tid & 1;
            const u32x4* src = (const u32x4*)(VT + ((size_t)((L * 8 + b) * 4 + h) * 256 + row) * 256 + hf * 128);
#pragma unroll
            for (int i0 = 0; i0 < 16; i0 += 8) {
                u32x4 w[8];
#pragma unroll
                for (int i = 0; i < 8; ++i) w[i] = src[i0 + i];
#pragma unroll
                for (int i = 0; i < 8; ++i) *(LAS u32x4*)(kl + row * RS + hf * 128 + (i0 + i) * 8) = w[i];
            }
        }
        __syncthreads();
#pragma unroll
        for (int hf = 0; hf < 2; ++hf) {
            unsigned vb = (unsigned)(size_t)(kl + (128 * hf + fr) * RS + 8 * fq); asm volatile("" : "+v"(vb));
#pragma unroll
            for (int n8 = 0; n8 < 8; ++n8) { const int n = 8 * hf + n8; f32x4 o0 = (f32x4){0.f, 0.f, 0.f, 0.f}, o1 = o0;
#pragma unroll
                for (int s = 0; s < 8; ++s) { const bf16x8 vf = *(const LAS bf16x8*)(size_t)(vb + (unsigned)((16 * n8 * RS + 32 * s) * 2));
                    o0 = __builtin_amdgcn_mfma_f32_16x16x32_bf16(vf, pf0[s], o0, 0, 0, 0);
                    o1 = __builtin_amdgcn_mfma_f32_16x16x32_bf16(vf, pf1[s], o1, 0, 0, 0); }
                u32x2 w0, w1; w0.x = pk2(o0.x * inv0, o0.y * inv0); w0.y = pk2(o0.z * inv0, o0.w * inv0); w1.x = pk2(o1.x * inv1, o1.y * inv1); w1.y = pk2(o1.z * inv1, o1.w * inv1);
                *(u32x2*)(OX + tok0 * 1024 + h * 256 + 16 * n + 4 * fq) = w0;
                *(u32x2*)(OX + (tok0 + 16) * 1024 + h * 256 + 16 * n + 4 * fq) = w1;
                if (n & 1) asm volatile("" ::: "memory"); }
        }
    }
    __syncthreads();
}

__device__ __forceinline__ void phase_route_mfma(KArgs A, int wv_, int L, LAS unsigned char* lds) {
    const int tid = opaque_tid(wv_), wid = __builtin_amdgcn_readfirstlane(tid >> 6), lane = tid & 63, fr = lane & 15, fq = lane >> 4;
    unsigned char* ws = opq(A->ws);
    const float* RW = (const float*)(ws + WS_RW) + (size_t)L * NEXP * D;
    unsigned* cnt = (unsigned*)(ws + WS_CTL) + CW_CNT + L * 64;
    int* list = (int*)(ws + WS_LIST); int* te = (int*)(ws + WS_TOK); int* tp = te + 2 * T; float* tw = (float*)(tp + 2 * T);
    bf16* XN = (bf16*)(ws + WS_XN);
    constexpr int WSTR = 1032;
    LAS bf16* rwh = (LAS bf16*)lds;
    LAS bf16* rwl = rwh + 16 * WSTR;
    LAS float* xch = (LAS float*)(lds + 2 * 16 * WSTR * 2);
    LAS unsigned* lcnt = (LAS unsigned*)(lds + 2 * 16 * WSTR * 2 + 8 * 320 * 4);
    LAS unsigned* lbase = lcnt + 16;
    for (int e4 = tid; e4 < NEXP * D / 4; e4 += 512) {
        const f32x4 w = *(const f32x4*)(RW + 4 * e4);
        u32x2 h; h.x = pk2(w.x, w.y); h.y = pk2(w.z, w.w);
        u32x2 l; l.x = pk2(w.x - bflo(h.x), w.y - bfhi(h.x)); l.y = pk2(w.z - bflo(h.y), w.w - bfhi(h.y));
        const int e = (4 * e4) >> 10, k = (4 * e4) & 1023;
        *(LAS u32x2*)(rwh + e * WSTR + k) = h; *(LAS u32x2*)(rwl + e * WSTR + k) = l;
    }
    const int tg = wid >> 1, kh = wid & 1;
    const float rbv = A->in[I_RB][fr];
    for (int blk = blockIdx.x; blk < T / 64; blk += gridDim.x) {
        __syncthreads();
        if (tid < 16) lcnt[tid] = 0u;
        const size_t tok = (size_t)blk * 64 + 16 * tg + fr;
        const float* xrow = A->out + tok * D + 512 * kh + 8 * fq;
        f32x4 acc = (f32x4){0.f, 0.f, 0.f, 0.f}; float ssq = 0.f;
        bf16x8 ah[16];
#pragma unroll
        for (int s4 = 0; s4 < 16; s4 += 4) {
            f32x4 xa[4], xb[4];
#pragma unroll
            for (int q = 0; q < 4; ++q) { xa[q] = *(const f32x4*)(xrow + 32 * (s4 + q)); xb[q] = *(const f32x4*)(xrow + 32 * (s4 + q) + 4); }
#pragma unroll
            for (int q = 0; q < 4; ++q) {
                const int s = s4 + q; const f32x4 x0 = xa[q], x1 = xb[q];
                ssq += ((x0.x * x0.x + x0.y * x0.y) + (x0.z * x0.z + x0.w * x0.w)) + ((x1.x * x1.x + x1.y * x1.y) + (x1.z * x1.z + x1.w * x1.w));
                u32x4 hw; hw.x = pk2(x0.x, x0.y); hw.y = pk2(x0.z, x0.w); hw.z = pk2(x1.x, x1.y); hw.w = pk2(x1.z, x1.w);
                u32x4 lw; lw.x = pk2(x0.x - bflo(hw.x), x0.y - bfhi(hw.x)); lw.y = pk2(x0.z - bflo(hw.y), x0.w - bfhi(hw.y)); lw.z = pk2(x1.x - bflo(hw.z), x1.y - bfhi(hw.z)); lw.w = pk2(x1.z - bflo(hw.w), x1.w - bfhi(hw.w));
                ah[s] = __builtin_bit_cast(bf16x8, hw); const bf16x8 al = __builtin_bit_cast(bf16x8, lw);
                const bf16x8 bh = *(const LAS bf16x8*)(rwh + fr * WSTR + 512 * kh + 32 * s + 8 * fq), bl = *(const LAS bf16x8*)(rwl + fr * WSTR + 512 * kh + 32 * s + 8 * fq);
                acc = __builtin_amdgcn_mfma_f32_16x16x32_bf16(ah[s], bh, acc, 0, 0, 0);
                acc = __builtin_amdgcn_mfma_f32_16x16x32_bf16(ah[s], bl, acc, 0, 0, 0);
                acc = __builtin_amdgcn_mfma_f32_16x16x32_bf16(al, bh, acc, 0, 0, 0);
            }
        }
        ssq += __shfl_xor(ssq, 16); ssq += __shfl_xor(ssq, 32);
        LAS float* mine = xch + wid * 320; const LAS float* other = xch + (wid ^ 1) * 320;
#pragma unroll
        for (int r = 0; r < 4; ++r) mine[(4 * fq + r) * 20 + fr] = acc[r];
        if (fq == 0) mine[fr * 20 + 16] = ssq;
        __syncthreads();
        const float rstd = rsqrtf((ssq + other[fr * 20 + 16]) * (1.f / 1024.f) + EPS);
        {
            bf16* xo = XN + tok * D + 512 * kh + 8 * fq;
#pragma unroll
            for (int s = 0; s < 16; ++s) { const u32x4 hw = __builtin_bit_cast(u32x4, ah[s]);
                u32x4 o; o.x = pk2(bflo(hw.x) * rstd, bfhi(hw.x) * rstd); o.y = pk2(bflo(hw.y) * rstd, bfhi(hw.y) * rstd); o.z = pk2(bflo(hw.z) * rstd, bfhi(hw.z) * rstd); o.w = pk2(bflo(hw.w) * rstd, bfhi(hw.w) * rstd);
                *(u32x4*)(xo + 32 * s) = o; }
        }
        int e0r[4], e1r[4], r0r[4], r1r[4]; float w0r[4];
        if (kh == 0) {
#pragma unroll
            for (int r = 0; r < 4; ++r) {
                const float rs = __shfl(rstd, 4 * fq + r);
                const float lg = (acc[r] + other[(4 * fq + r) * 20 + fr]) * rs + rbv;
                float v0 = lg; v0 = fmaxf(v0, __shfl_xor(v0, 1)); v0 = fmaxf(v0, __shfl_xor(v0, 2)); v0 = fmaxf(v0, __shfl_xor(v0, 4)); v0 = fmaxf(v0, __shfl_xor(v0, 8));
                const unsigned long long bm0 = __ballot(lg == v0);
                const int e0 = __ffs((unsigned)(bm0 >> (16 * fq)) & 0xffffu) - 1;
                const bool c2 = (fr >> 2) == (e0 >> 2) && fr != e0;
                const float m2 = c2 ? lg : -INFINITY;
                float v1 = m2; v1 = fmaxf(v1, __shfl_xor(v1, 1)); v1 = fmaxf(v1, __shfl_xor(v1, 2)); v1 = fmaxf(v1, __shfl_xor(v1, 4)); v1 = fmaxf(v1, __shfl_xor(v1, 8));
                const unsigned long long bm1 = __ballot(c2 && m2 == v1);
                const int e1 = __ffs((unsigned)(bm1 >> (16 * fq)) & 0xffffu) - 1;
                e0r[r] = e0; e1r[r] = e1; w0r[r] = 1.f / (1.f + __expf(v1 - v0));
                r0r[r] = 0; r1r[r] = 0;
                if (fr == 0) { r0r[r] = (int)atomicAdd((unsigned*)(lcnt + e0), 1u); r1r[r] = (int)atomicAdd((unsigned*)(lcnt + e1), 1u); }
            }
        }
        __syncthreads();
        if (tid < 16) lbase[tid] = atomicAdd(&cnt[tid], lcnt[tid]);
        __syncthreads();
        if (kh == 0 && fr == 0) {
#pragma unroll
            for (int r = 0; r < 4; ++r) {
                const int t = blk * 64 + 16 * tg + 4 * fq + r;
                const int p0 = (int)lbase[e0r[r]] + r0r[r], p1 = (int)lbase[e1r[r]] + r1r[r];
                list[e0r[r] * T + p0] = t; list[e1r[r] * T + p1] = t;
                te[2 * t] = e0r[r]; te[2 * t + 1] = e1r[r]; tp[2 * t] = p0; tp[2 * t + 1] = p1; tw[2 * t] = w0r[r]; tw[2 * t + 1] = 1.f - w0r[r];
            }
        }
    }
    __syncthreads();
}

__device__ __forceinline__ void moe_offsets(KArgs A, int wv_, int L, LAS int* off, LAS int* cn) {
    if (opaque_tid(wv_) == 0) {
        const unsigned* cnt = (const unsigned*)(opq(A->ws) + WS_CTL) + CW_CNT + L * 64;
        int o = 0;
        for (int e = 0; e < 16; ++e) { const int c = (int)__hip_atomic_load(cnt + e, __ATOMIC_RELAXED, __HIP_MEMORY_SCOPE_AGENT); off[e] = o; cn[e] = c; o += (c + 255) & ~255; }
        off[16] = o;
    }
    __syncthreads();
}
__device__ __forceinline__ void phase_moe_combine(KArgs A, int wv_, int L, LAS unsigned char* lds) {
    LAS int* off = (LAS int*)lds; LAS int* cn = off + 32;
    moe_offsets(A, wv_, L, off, cn);
    const int tid_ = opaque_tid(wv_); const int wid = __builtin_amdgcn_readfirstlane(tid_ >> 6), lane = tid_ & 63; const int gw = blockIdx.x * 8 + wid, NGW = gridDim.x * 8;
    unsigned char* ws = opq(A->ws);
    const int* te = (const int*)(ws + WS_TOK); const int* tp = te + 2 * T; const float* tw = (const float*)(tp + 2 * T);
    const bf16* Y = (const bf16*)(ws + WS_Y); bf16* XN = (bf16*)(ws + WS_XN);
    const int nq = (T - gw + NGW - 1) / NGW;
    for (int q0 = 0; q0 < nq; q0 += 8) {
        int s0m = 0, s1m = 0; float w0m = 0.f, w1m = 0.f;
        { const int qq = q0 + (lane & 7); const int t = gw + NGW * (qq < nq ? qq : nq - 1);
          s0m = off[te[2 * t]] + tp[2 * t]; s1m = off[te[2 * t + 1]] + tp[2 * t + 1]; w0m = tw[2 * t]; w1m = tw[2 * t + 1]; }
        const int nn = nq - q0 < 8 ? nq - q0 : 8;
        f32x4 v[4], vn[4]; u32x2 ya[4], yb[4], yan[4], ybn[4];
        { const int t = gw + NGW * q0; const int sl0 = __builtin_amdgcn_readlane(s0m, 0), sl1 = __builtin_amdgcn_readlane(s1m, 0);
#pragma unroll
          for (int j = 0; j < 4; ++j) { v[j] = ((const f32x4*)(A->out + (size_t)t * D) + lane)[64 * j]; ya[j] = ((const u32x2*)(Y + (size_t)sl0 * D) + lane)[64 * j]; yb[j] = ((const u32x2*)(Y + (size_t)sl1 * D) + lane)[64 * j]; } }
#pragma unroll 1
        for (int q = 0; q < nn; ++q) {
            const int t = gw + NGW * (q0 + q);
            const int qn = q + 1 < nn ? q + 1 : q;
            { const int tn = gw + NGW * (q0 + qn); const int sl0 = __builtin_amdgcn_readlane(s0m, qn), sl1 = __builtin_amdgcn_readlane(s1m, qn);
#pragma unroll
              for (int j = 0; j < 4; ++j) { vn[j] = ((const f32x4*)(A->out + (size_t)tn * D) + lane)[64 * j]; yan[j] = ((const u32x2*)(Y + (size_t)sl0 * D) + lane)[64 * j]; ybn[j] = ((const u32x2*)(Y + (size_t)sl1 * D) + lane)[64 * j]; } }
            const float w0 = __builtin_bit_cast(float, __builtin_amdgcn_readlane(__builtin_bit_cast(int, w0m), q)), w1 = __builtin_bit_cast(float, __builtin_amdgcn_readlane(__builtin_bit_cast(int, w1m), q));
            float s = 0.f;
#pragma unroll
            for (int j = 0; j < 4; ++j) {
                v[j].x += w0 * bflo(ya[j].x) + w1 * bflo(yb[j].x); v[j].y += w0 * bfhi(ya[j].x) + w1 * bfhi(yb[j].x); v[j].z += w0 * bflo(ya[j].y) + w1 * bflo(yb[j].y); v[j].w += w0 * bfhi(ya[j].y) + w1 * bfhi(yb[j].y);
                s += (v[j].x * v[j].x + v[j].y * v[j].y) + (v[j].z * v[j].z + v[j].w * v[j].w);
            }
            const float rstd = rsqrtf(wave_sum(s) * (1.f / 1024.f) + EPS);
            f32x4* xr = (f32x4*)(A->out + (size_t)t * D) + lane; u32x2* o8 = (u32x2*)(XN + (size_t)t * D) + lane;
#pragma unroll
            for (int j = 0; j < 4; ++j) { xr[64 * j] = v[j]; u32x2 w; w.x = pk2(v[j].x * rstd, v[j].y * rstd); w.y = pk2(v[j].z * rstd, v[j].w * rstd); o8[64 * j] = w; }
#pragma unroll
            for (int j = 0; j < 4; ++j) { v[j] = vn[j]; ya[j] = yan[j]; yb[j] = ybn[j]; }
        }
    }
}

constexpr int PH_PER_EVEN = 5 + 6, PH_PER_ODD = 3 + 6;
constexpr int NPHASES = 1 + 2 * (PH_PER_EVEN + PH_PER_ODD);

__global__ void __launch_bounds__(512, 2) mk_fwd(Args Araw) {
    KArgs A0 = kargs();
    extern __shared__ __attribute__((aligned(16))) unsigned char lds_raw[];
    LAS unsigned char* lds = (LAS unsigned char*)lds_raw;
    volatile LAS unsigned* misc = (volatile LAS unsigned*)(lds + LDS_MISC);
    const int tid = threadIdx.x;
    if (tid < 16) misc[tid] = 0u;
    __syncthreads();
    const int lo = A0->ph_lo, hi = A0->ph_hi;
    const int wv_ = __builtin_amdgcn_readfirstlane(threadIdx.x >> 6);
    if (hi - lo > 1) (void)xcd_barrier_post((unsigned*)(A0->ws + WS_CTL) + CW_BAR, misc);
    int ph = 0;
    unsigned long long tacc_ = 0;
#define PH_BEGIN(k) if (ph >= lo && ph < hi) { const bool tprobe_ = (PROBE_TMASK >> (k)) & 1; unsigned long long tp0_ = 0; if (PROBE_TMASK && tprobe_) tp0_ = __builtin_amdgcn_s_memrealtime(); KArgs A = kargs(); unsigned char* ws = opq(A->ws); _Pragma("unroll 1") for (int rep_ = 0; rep_ < (((PROBE_MASK >> (k)) & 1) ? PROBE_REPS : 1); ++rep_)
#define PH_END   if (ph + 1 < hi) { XcdBarrier b_; b_.bar = (unsigned*)(opq(kargs()->ws) + WS_CTL) + CW_BAR; b_.x = xb_xcc_id(); b_.st = misc; xcd_barrier(b_, opaque_tid(wv_) == 0); } if (PROBE_TMASK && tprobe_) tacc_ += __builtin_amdgcn_s_memrealtime() - tp0_; } ++ph;
    const int G = gridDim.x, cb = blockIdx.x;

    PH_BEGIN(0) phase_prologue(A, wv_, lds); PH_END
    for (int L = 0; L < DEPTH; ++L) {
        const int i = L >> 1;
        if ((L & 1) == 0) {
            PH_BEGIN(3) {
                if (L == 0) {
                    pg8::DenseOrder S; S.init(NBATCH * NMEM, 8192, D, (const bf16*)(ws + WS_WKV), G, cb);
                    pg8::EpiBf16<0> E{(bf16*)(ws + WS_KV), 8192, 32, 0, nullptr, 0};
                    pg8::gemm_phase(lds, (const bf16*)(ws + WS_MN), D, S, E, wv_);
                }
                pg8::DenseOrder S; S.init(T, HYN, D, (const bf16*)(ws + WS_WHYB) + (size_t)i * HYN * D, G, cb);
                pg8::EpiBf16<0> E{(bf16*)(ws + WS_BIG), HYN, 12, 0, nullptr, 0};
                pg8::gemm_phase(lds, (const bf16*)(ws + WS_XN), D, S, E, wv_);
            } PH_END
            PH_BEGIN(4) { const int t4_ = opaque_tid(wv_); SUBT_BEGIN(4); SUBT_END(4, ws, t4_); SUBT_BEGIN(5); phase_compress_mfma(A, wv_, i, lds); SUBT_END(5, ws, t4_); SUBT_BEGIN(6); phase_nsa_prep(A, wv_, i, lds); SUBT_END(6, ws, t4_); SUBT_BEGIN(7); phase_vtiles(A, wv_, lds); SUBT_END(7, ws, t4_); } PH_END
            PH_BEGIN(5) { phase_gla_a(A, wv_, i, lds); __syncthreads(); phase_nsa_attn_mfma(A, wv_, i, lds); } PH_END
            PH_BEGIN(6) phase_gla_c(A, wv_, i, lds, L == 0); PH_END
            PH_BEGIN(7) {
                pg8::DenseOrder S; S.init(T, D, D, (const bf16*)(ws + WS_WHOUT) + (size_t)i * D * D, G, cb);
                pg8::EpiResAddNorm E{A->out, D, (bf16*)(ws + WS_XN), (float*)(ws + WS_ROWSQ)};
                pg8::gemm_phase(lds, (const bf16*)(ws + WS_CAT), D, S, E, wv_);
            } PH_END
        } else {
            PH_BEGIN(8) {
                pg8::DenseOrder S; S.init(T, 4096, D, (const bf16*)(ws + WS_WSGIN) + (size_t)i * 4096 * D, G, cb);
                pg8::EpiBf16<1> E{(bf16*)(ws + WS_U), 2048, 8, (size_t)(WS_V - WS_U) / 2, (float*)(ws + WS_VSTAT), 8};
                pg8::gemm_phase(lds, (const bf16*)(ws + WS_XN), D, S, E, wv_);
            } PH_END
            PH_BEGIN(9) phase_sgu_mix_mfma(A, wv_, i, lds); PH_END
            PH_BEGIN(10) {
                pg8::DenseOrder S; S.init(T, D, 2048, (const bf16*)(ws + WS_WSGOUT) + (size_t)i * D * 2048, G, cb);
                pg8::EpiResAddNorm E{A->out, D, (bf16*)(ws + WS_XN), (float*)(ws + WS_ROWSQ)};
                pg8::gemm_phase(lds, (const bf16*)(ws + WS_UM), 2048, S, E, wv_);
            } PH_END
        }
        PH_BEGIN(12) {
            pg8::DenseOrder S; S.init(T, D, D, (const bf16*)(ws + WS_WQ) + (size_t)L * D * D, G, cb);
            pg8::EpiBf16RowScale E{(bf16*)(ws + WS_QX), D, (const float*)(ws + WS_ROWSQ)};
            pg8::gemm_phase(lds, (const bf16*)(ws + WS_XN), D, S, E, wv_);
            asm volatile("s_waitcnt vmcnt(0)" ::: "memory");
            __syncthreads();
            pg8::Unit u_;
#pragma unroll 1
            for (int ui_ = 0; S.next(ui_, u_); ++ui_) xattn_item(A, wv_, L, lds, u_.pm >> 3, u_.pn, u_.pm & 7);
        } PH_END
        PH_BEGIN(14) {
            pg8::DenseOrder S; S.init(T, D, D, (const bf16*)(ws + WS_WO) + (size_t)L * D * D, G, cb);
            pg8::EpiResAdd E{A->out, D};
            pg8::gemm_phase(lds, (const bf16*)(ws + WS_OX), D, S, E, wv_);
        } PH_END
        PH_BEGIN(15) phase_route_mfma(A, wv_, L, lds); PH_END
        PH_BEGIN(16) {
            LAS int* off = (LAS int*)(lds + pg8::STAGE_BYTES); LAS int* cn = off + 32;
            moe_offsets(A, wv_, L, off, cn);
            pg8::MoeOrder<true> S{(off[16] / 256) * 3, 3, G, cb, D, off, cn, (const int*)(ws + WS_LIST), (const char*)(ws + WS_WMIN) + (size_t)L * 16 * 768 * D * 2, (size_t)768 * D * 2};
            pg8::EpiSwiglu E{(bf16*)(ws + WS_H), DEXP};
            pg8::gemm_phase(lds, (const bf16*)(ws + WS_XN), D, S, E, wv_);
        } PH_END
        PH_BEGIN(17) {
            LAS int* off = (LAS int*)(lds + pg8::STAGE_BYTES); LAS int* cn = off + 32;
            moe_offsets(A, wv_, L, off, cn);
            pg8::MoeOrder<false> S{(off[16] / 256) * 4, 4, G, cb, DEXP, off, cn, (const int*)(ws + WS_LIST), (const char*)(ws + WS_WMOUT) + (size_t)L * 16 * D * DEXP * 2, (size_t)D * DEXP * 2};
            pg8::EpiBf16<0> E{(bf16*)(ws + WS_Y), D, 4, 0, nullptr, 0};
            pg8::gemm_phase(lds, (const bf16*)(ws + WS_H), DEXP, S, E, wv_);
        } PH_END
        PH_BEGIN(18) phase_moe_combine(A, wv_, L, lds); PH_END
    }
#undef PH_BEGIN
#undef PH_END
    if (hi - lo > 1) { for (int q_ = 0; q_ < PROBE_XBAR; ++q_) { XcdBarrier b_; b_.bar = (unsigned*)(opq(kargs()->ws) + WS_CTL) + CW_BAR; b_.x = xb_xcc_id(); b_.st = misc; xcd_barrier(b_, opaque_tid(wv_) == 0); } }
    if ((PROBE_NSA || PROBE_SUB) && blockIdx.x == 0) { const unsigned long long d_ = __hip_atomic_load((unsigned long long*)(A0->ws + WS_CTL + 48000), __ATOMIC_RELAXED, __HIP_MEMORY_SCOPE_AGENT); const unsigned long long t0 = __builtin_amdgcn_s_memrealtime(); while (__builtin_amdgcn_s_memrealtime() - t0 < d_) __builtin_amdgcn_s_sleep(8); }
    if (PROBE_TMASK && blockIdx.x == 0) { const unsigned long long t0 = __builtin_amdgcn_s_memrealtime(); while (__builtin_amdgcn_s_memrealtime() - t0 < tacc_) __builtin_amdgcn_s_sleep(8); }
}

extern "C" void kernel_launch(void* const* d_in, const int* in_sizes, int n_in, void* d_out, int out_size, void* d_ws, size_t ws_size, hipStream_t stream) {
    static int grid = 0;
    if (grid == 0) {
        if (n_in != N_IN || out_size != T * D || ws_size < WS_END) { fprintf(stderr, "kernel_launch: unexpected problem (n_in %d, out %d, ws %zu)\n", n_in, out_size, ws_size); grid = -1; return; }
        int dev = 0, cus = 0, per_cu = 0;
        if (hipGetDevice(&dev) != hipSuccess || hipDeviceGetAttribute(&cus, hipDeviceAttributeMultiprocessorCount, dev) != hipSuccess) { grid = -1; return; }
        if (hipFuncSetAttribute((const void*)mk_fwd, hipFuncAttributeMaxDynamicSharedMemorySize, LDS_BYTES) != hipSuccess) { fprintf(stderr, "kernel_launch: hipFuncSetAttribute failed\n"); grid = -1; return; }
        if (hipOccupancyMaxActiveBlocksPerMultiprocessor(&per_cu, (const void*)mk_fwd, 512, LDS_BYTES) != hipSuccess || per_cu < 1) fprintf(stderr, "kernel_launch: occupancy query says %d\n", per_cu);
        (void)hipGetLastError();
        grid = cus;
    }
    if (grid < 0) return;
    (void)hipMemsetAsync((char*)d_ws + WS_CTL, 0, CTL_BYTES, stream);
    Args a{};
    for (int i = 0; i < N_IN; ++i) a.in[i] = (const float*)d_in[i];
    a.out = (float*)d_out; a.ws = (unsigned char*)d_ws;
    for (int j = 0; j < 32; ++j) a.freq[j] = (float)pow(10000.0, -(double)j / 32.0);
#if MK_ONE_LAUNCH
    a.ph_lo = 0; a.ph_hi = NPHASES;
    hipLaunchKernelGGL(mk_fwd, dim3(grid), dim3(512), LDS_BYTES, stream, a);
#else
    for (int p = 0; p < NPHASES; ++p) { a.ph_lo = p; a.ph_hi = p + 1; hipLaunchKernelGGL(mk_fwd, dim3(grid), dim3(512), LDS_BYTES, stream, a); }
#endif
}
```

```cpp
#include <hip/hip_runtime.h>
#include <stdint.h>
#include <stdio.h>
#include <math.h>

#ifndef PROBE_MASK
#define PROBE_MASK 0
#endif
#ifndef PROBE_TMASK
#define PROBE_TMASK 0
#endif
#ifndef PROBE_NSA
#define PROBE_NSA 0
#endif
#ifndef PROBE_SUB
#define PROBE_SUB 0
#endif
#ifndef PROBE_XBAR
#define PROBE_XBAR 0
#endif
#ifndef PROBE_NSAX
#define PROBE_NSAX 0
#endif
#ifndef PROBE_REPS
#define PROBE_REPS 2
#endif
#ifndef MK_ONE_LAUNCH
#define MK_ONE_LAUNCH 1
#endif

#define LAS __attribute__((address_space(3)))
typedef unsigned short bf16;
typedef short bf16x8 __attribute__((ext_vector_type(8)));
typedef float f32x4 __attribute__((ext_vector_type(4)));
typedef float f32x2 __attribute__((ext_vector_type(2)));
typedef unsigned u32x4 __attribute__((ext_vector_type(4)));
typedef unsigned u32x2 __attribute__((ext_vector_type(2)));

constexpr int T = 16384, D = 1024, NBATCH = 8, S = 2048, DEPTH = 4;
constexpr int NMEM = 256;
constexpr float EPS = 1e-6f;
constexpr int HYN = 3072, HYSRC = 2856;
constexpr int C_QA = 0, C_KC = 512, C_VC = 640, C_KS = 768, C_VS = 896, C_KW = 1024, C_VW = 1152, C_QB = 1280, C_KB = 1536, C_VB = 1792, C_RB = 2304, C_GA = 2816, C_AL = 2840;
constexpr int NCMP = 127;
constexpr int NEXP = 16, DEXP = 384;
constexpr int SLOTS = 2 * T + NEXP * 256;

enum { I_X = 0, I_MEM, I_POS, I_NMIX, I_NXAT, I_NMEM, I_NFFN, I_HYBIN, I_HYBOUT, I_QNORM, I_KNORM, I_CMPPE, I_CMPW1, I_CMPW2, I_GATEB, I_WA2, I_BA, I_ONORM,
       I_SGIN, I_LNG, I_LNB, I_SGWS, I_SGBS, I_SGOUT, I_XWQ, I_XWKV, I_XWO, I_XQN, I_XKN, I_RW, I_RB, I_MOEIN, I_MOEOUT, N_IN };

constexpr size_t MiB = 1u << 20;
constexpr size_t WS_CTL = 0, CTL_BYTES = 1 * MiB;
constexpr size_t WS_WHYB = 1 * MiB;
constexpr size_t WS_WHOUT = WS_WHYB + 12 * MiB;
constexpr size_t WS_WSGIN = WS_WHOUT + 4 * MiB;
constexpr size_t WS_WSGOUT = WS_WSGIN + 16 * MiB;
constexpr size_t WS_WQ = WS_WSGOUT + 8 * MiB;
constexpr size_t WS_WKV = WS_WQ + 8 * MiB;
constexpr size_t WS_WO = WS_WKV + 16 * MiB;
constexpr size_t WS_WMIN = WS_WO + 8 * MiB;
constexpr size_t WS_WMOUT = WS_WMIN + 96 * MiB;
constexpr size_t WS_RW = WS_WMOUT + 48 * MiB;
constexpr size_t WS_XN = WS_RW + 1 * MiB;
constexpr size_t WS_BIG = WS_XN + 32 * MiB;
constexpr size_t WS_QA = WS_BIG + 128 * MiB;
constexpr size_t WS_KS = WS_QA + 16 * MiB;
constexpr size_t WS_KW = WS_KS + 4 * MiB;
constexpr size_t WS_KC = WS_KW + 4 * MiB;
constexpr size_t WS_VC = WS_KC + 1 * MiB;
constexpr size_t WS_CAT = WS_VC + 1 * MiB;
constexpr size_t WS_QX = WS_CAT + 32 * MiB;
constexpr size_t WS_OX = WS_QX + 32 * MiB;
constexpr size_t WS_MN = WS_OX + 32 * MiB;
constexpr size_t WS_KV = WS_MN + 4 * MiB;
constexpr size_t WS_COS = WS_KV + 32 * MiB;
constexpr size_t WS_SIN = WS_COS + 2 * MiB;
constexpr size_t WS_LIST = WS_SIN + 2 * MiB;
constexpr size_t WS_TOK = WS_LIST + 1 * MiB;
constexpr size_t WS_VT = WS_TOK + 1 * MiB;
constexpr size_t WS_VTA = WS_VT + 16 * MiB;
constexpr size_t WS_SLOC = WS_VTA + 32 * MiB;
constexpr size_t WS_DEC = WS_SLOC + 32 * MiB;
constexpr size_t WS_STT = WS_DEC + 1 * MiB;
constexpr size_t WS_WSB = WS_STT + 16 * MiB;
constexpr size_t WS_M0 = WS_WSB + 768 * 1024;
constexpr size_t WS_W1T = WS_WSB + 1 * MiB;
constexpr size_t WS_ROWSQ = WS_W1T + 1 * MiB;
constexpr size_t WS_VSTAT = WS_ROWSQ + 1 * MiB;
constexpr size_t WS_END = WS_VSTAT + 4 * MiB;
constexpr size_t WS_Y = WS_BIG, WS_H = WS_BIG + 72 * MiB, WS_U = WS_BIG, WS_V = WS_BIG + 64 * MiB, WS_UM = WS_QX;
constexpr int CW_BAR = 4096;
constexpr int CW_CNT = 8192;

constexpr int LDS_BYTES = 159744;
constexpr int LDS_MISC = LDS_BYTES - 64;

typedef __bf16 bf16x2_t __attribute__((ext_vector_type(2)));
__device__ __forceinline__ unsigned pk2(float lo, float hi) { const f32x2 v = {lo, hi}; return __builtin_bit_cast(unsigned, __builtin_convertvector(v, bf16x2_t)); }
__device__ __forceinline__ unsigned f2bf(float f) { return (unsigned)__builtin_bit_cast(unsigned short, (__bf16)f); }
__device__ __forceinline__ float bf2f(unsigned b) { return __uint_as_float(b << 16); }
__device__ __forceinline__ float bflo(unsigned w) { return __uint_as_float(w << 16); }
__device__ __forceinline__ float bfhi(unsigned w) { return __uint_as_float(w & 0xffff0000u); }
__device__ __forceinline__ void xswap16(float v, float& a, float& b) { unsigned u = __builtin_bit_cast(unsigned, v), u2 = u; asm volatile("" : "+v"(u2));
    const u32x2 r = __builtin_amdgcn_permlane16_swap(u, u2, false, false); unsigned r0 = r[0], r1 = r[1]; asm volatile("" : "+v"(r0), "+v"(r1)); a = __builtin_bit_cast(float, r0); b = __builtin_bit_cast(float, r1); }
__device__ __forceinline__ void xswap32(float v, float& a, float& b) { unsigned u = __builtin_bit_cast(unsigned, v), u2 = u; asm volatile("" : "+v"(u2));
    const u32x2 r = __builtin_amdgcn_permlane32_swap(u, u2, false, false); unsigned r0 = r[0], r1 = r[1]; asm volatile("" : "+v"(r0), "+v"(r1)); a = __builtin_bit_cast(float, r0); b = __builtin_bit_cast(float, r1); }
__device__ __forceinline__ float xadd16(float v) { float a, b; xswap16(v, a, b); return a + b; }
__device__ __forceinline__ float xadd32(float v) { float a, b; xswap32(v, a, b); return a + b; }
__device__ __forceinline__ float xmax16(float v) { float a, b; xswap16(v, a, b); return fmaxf(a, b); }
__device__ __forceinline__ float xmax32(float v) { float a, b; xswap32(v, a, b); return fmaxf(a, b); }
__device__ __forceinline__ float wave_sum(float v) {
#pragma unroll
    for (int o = 1; o < 16; o <<= 1) v += __shfl_xor(v, o);
    return xadd32(xadd16(v));
}
__device__ __forceinline__ float wave_max(float v) {
#pragma unroll
    for (int o = 1; o < 16; o <<= 1) v = fmaxf(v, __shfl_xor(v, o));
    return xmax32(xmax16(v));
}
__device__ __forceinline__ int opaque_tid(int wv) { int l; asm volatile("v_mbcnt_lo_u32_b32 %0, -1, 0\n\tv_mbcnt_hi_u32_b32 %0, -1, %0" : "=v"(l)); return wv * 64 + l; }
__device__ __forceinline__ unsigned char* opq(unsigned char* p) { asm volatile("" : "+s"(p)); return p; }
#define LDS_WAIT() asm volatile("s_waitcnt lgkmcnt(0)" ::: "memory")
__device__ __forceinline__ float gelu_tanh(float x) {
    const float u2 = x * (1.5957691216057308f + 0.07135481283f * x * x);
    return x * __builtin_amdgcn_rcpf(1.0f + __expf(-u2));
}
__device__ __forceinline__ float sigmoidf_(float x) { return __builtin_amdgcn_rcpf(1.0f + __expf(-x)); }

#define SUBT_BEGIN(id) unsigned long long subt_##id = 0; if (PROBE_SUB == (id)) subt_##id = __builtin_amdgcn_s_memrealtime();
#define SUBT_END(id, wsp, tidv) do { if (PROBE_SUB == (id) && blockIdx.x == 0 && (tidv) == 0) atomicAdd((unsigned long long*)((wsp) + WS_CTL + 48000), __builtin_amdgcn_s_memrealtime() - subt_##id); } while (0)
#define XB_TMO      128
#define XB_XCNT(j)  (256  + 64 * (j))
#define XB_XSUB(j)  (1280 + 64 * (j))
#define XB_XGEN(j)  (2304 + 64 * (j))
#define XB_TOP      3328
#define XB_TOPGEN   3392
#define XCD_BAR_WORDS 3456
#define XB_SPIN_CAP (1u << 22)

__device__ __forceinline__ unsigned xb_ld(unsigned* p)              { return __hip_atomic_load(p, __ATOMIC_RELAXED, __HIP_MEMORY_SCOPE_AGENT); }
__device__ __forceinline__ unsigned xb_add(unsigned* p, unsigned v) { return __hip_atomic_fetch_add(p, v, __ATOMIC_RELAXED, __HIP_MEMORY_SCOPE_AGENT); }
__device__ __forceinline__ unsigned xb_xcc_id() { return (unsigned)__builtin_amdgcn_s_getreg((3 << 11) | 20) & 0xFu; }
#define XB_SPIN(cond, bar) do { unsigned _sp = 0; while (cond) { __builtin_amdgcn_s_sleep(1); \
    if ((++_sp & 255u) == 0u) { if (xb_ld(&(bar)[XB_TMO])) break; if (_sp > XB_SPIN_CAP) { atomicAdd(&(bar)[XB_TMO], 1u); break; } } } } while (0)

struct XcdBarrier { unsigned* bar; unsigned x; volatile LAS unsigned* st; };
__device__ __forceinline__ unsigned* xb_opaque(unsigned* p) { unsigned long long v = (unsigned long long)p; unsigned lo = __builtin_amdgcn_readfirstlane((unsigned)v), hi = __builtin_amdgcn_readfirstlane((unsigned)(v >> 32));
    asm volatile("" : "+s"(lo), "+s"(hi)); return (unsigned*)(((unsigned long long)hi << 32) | lo); }

__device__ __forceinline__ XcdBarrier xcd_barrier_post(unsigned* bar, volatile LAS unsigned* st) {
    XcdBarrier b; b.bar = bar; b.x = xb_xcc_id(); b.st = st;
    if (threadIdx.x == 0) (void)xb_add(&bar[XB_XCNT(b.x)], 1u);
    return b;
}
__device__ __forceinline__ void xcd_barrier_complete(unsigned* bar, unsigned x, unsigned& nloc, unsigned& nx) {
    const unsigned G = gridDim.x * gridDim.y * gridDim.z;
    unsigned sum, cnt, mine, sp = 0u;
    for (;;) {
        sum = 0u; cnt = 0u; mine = 0u;
#pragma unroll
        for (unsigned j = 0; j < 16; ++j) { const unsigned c = xb_ld(&bar[XB_XCNT(j)]); sum += c; cnt += (c > 0u) ? 1u : 0u; mine = (j == x) ? c : mine; }
        if (sum == G) break;
        __builtin_amdgcn_s_sleep(1);
        if ((++sp & 255u) == 0u) { if (xb_ld(&bar[XB_TMO])) break; if (sp > XB_SPIN_CAP) { atomicAdd(&bar[XB_TMO], 1u); break; } }
    }
    nloc = mine > 0u ? mine : 1u; nx = cnt > 0u ? cnt : 1u;
}
__device__ __forceinline__ void xcd_barrier(const XcdBarrier& b, const bool is_t0) {
    asm volatile("s_waitcnt vmcnt(0)" ::: "memory");
    __syncthreads();
    if (is_t0) {
        unsigned* bar = b.bar;
        __builtin_amdgcn_s_waitcnt(0);
        unsigned nloc = b.st[0], nx = b.st[1];
        if (nloc == 0u) { xcd_barrier_complete(bar, b.x, nloc, nx); b.st[0] = nloc; b.st[1] = nx; }
        const unsigned old = xb_add(&bar[XB_XSUB(b.x)], 1u);
        const unsigned gen = old / nloc;
        if (old + 1u == (gen + 1u) * nloc) {
            __builtin_amdgcn_fence(__ATOMIC_RELEASE, "agent");
            asm volatile("s_waitcnt vmcnt(0)" ::: "memory");
            const unsigned og = xb_add(&bar[XB_TOP], 1u);
            const unsigned tg = og / nx;
            if (og + 1u == (tg + 1u) * nx) xb_add(&bar[XB_TOPGEN], 1u);
            else XB_SPIN(xb_ld(&bar[XB_TOPGEN]) == tg, bar);
            __builtin_amdgcn_fence(__ATOMIC_ACQUIRE, "agent");
            xb_add(&bar[XB_XGEN(b.x)], 1u);
            asm volatile("s_waitcnt vmcnt(0)" ::: "memory");
        } else {
            XB_SPIN(xb_ld(&bar[XB_XGEN(b.x)]) == gen, bar);
            __builtin_amdgcn_fence(__ATOMIC_ACQUIRE, "agent");
            asm volatile("s_waitcnt vmcnt(0)" ::: "memory");
        }
    }
    __syncthreads();
}

struct Args {
    const float* in[N_IN];
    float* out;
    unsigned char* ws;
    float freq[32];
    int ph_lo, ph_hi;
};

typedef const __attribute__((address_space(4))) Args* KArgs;
__device__ __forceinline__ KArgs kargs() { KArgs p = (KArgs)__builtin_amdgcn_kernarg_segment_ptr(); asm volatile("" : "+s"(p)); return p; }

__device__ __forceinline__ void st_bf16x4(bf16* p, f32x4 v) { u32x2 w; w.x = pk2(v[0], v[1]); w.y = pk2(v[2], v[3]); *(u32x2*)p = w; }


namespace pg8 {
constexpr int BM = 256, BK = 64, HALF = 128, HTB = HALF * BK * 2, STAGE_BYTES = 8 * HTB, NXCD = 8, WGM = 8;
__host__ __device__ __forceinline__ int lds_byte(int r, int c) { const int st = (r >> 4) * 2 + (c >> 5), rr = r & 15, cc = c & 31, ob = rr * 64 + cc * 2; return st * 1024 + (ob ^ (((ob >> 9) & 1) << 5)); }
__host__ __device__ __forceinline__ void stage_rc(int b, int& R, int& C) { const int st = b / 1024, sb = b % 1024, swz = sb ^ (((sb >> 9) & 1) << 5); R = (st >> 1) * 16 + swz / 64; C = (st & 1) * 32 + (swz % 64) / 2; }
__host__ __device__ __forceinline__ int perm32(int rho) { const int n = rho >> 4, i = rho & 15; return 8 * (i >> 2) + 4 * n + (i & 3); }
struct Unit { int pm, pn, e; };
struct DenseOrder {
    static constexpr bool GATHER = false;
    int nM, nN, nwg, G, c, K; const char* Bt;
    __device__ __forceinline__ void init(int M, int N, int K_, const bf16* Bt_, int G_, int c_) { nM = M / BM; nN = N / BM; nwg = nM * nN; G = G_; c = c_; K = K_; Bt = (const char*)Bt_; }
    __device__ __forceinline__ bool next(int i, Unit& u) const {
        const long L = (long)i * G + c; if (L >= nwg) return false;
        int wgid = (int)L; { const int q = nwg / NXCD, r = nwg % NXCD, xcd = wgid % NXCD, off = wgid / NXCD; wgid = (xcd < r ? xcd * (q + 1) : r * (q + 1) + (xcd - r) * q) + off; }
        const int nig = WGM * nN, gid = wgid / nig, fm = gid * WGM, gsz = (nM - fm) < WGM ? (nM - fm) : WGM;
        u.pm = fm + ((wgid % nig) % gsz); u.pn = (wgid % nig) / gsz; u.e = 0; return true;
    }
    __device__ __forceinline__ unsigned a_voff(const Unit& u, int half, int R) const { return (unsigned)((u.pm * BM + half * HALF + R) * K) * 2u; }
    __device__ __forceinline__ const char* b_tile(const Unit& u) const { return Bt + (size_t)u.pn * BM * K * 2; }
};
template <bool GATH> struct MoeOrder {
    static constexpr bool GATHER = GATH;
    int nunits, ntn, G, c, K; const LAS int* off; const LAS int* cn; const int* list; const char* Bt; size_t estride;
    __device__ __forceinline__ bool next(int i, Unit& u) const {
        const int L = i * G + c; if (L >= nunits) return false;
        u.pm = L / ntn; u.pn = L % ntn; const int s0 = u.pm * BM; int e = 0;
#pragma unroll
        for (int q = 1; q < 16; ++q) e += (s0 >= off[q]) ? 1 : 0;
        u.e = e; return true;
    }
    __device__ __forceinline__ unsigned a_voff(const Unit& u, int half, int R) const {
        const int slot = u.pm * BM + half * HALF + R;
        const int loc = slot - off[u.e]; const int tk = list[u.e * T + (loc < cn[u.e] ? loc : 0)];
        return (unsigned)(tk * K) * 2u;
    }
    __device__ __forceinline__ const char* b_tile(const Unit& u) const { return Bt + (size_t)u.e * estride + (size_t)u.pn * BM * K * 2; }
};
__device__ __forceinline__ unsigned cvt_pk_bf16(float lo, float hi) { return pk2(lo, hi); }

template <class Epi, class Sched>
__device__ __forceinline__ void gemm_phase(LAS unsigned char* lds, const bf16* Aptr, int K, const Sched& S, const Epi& E, int wv_) {
    const int tid = opaque_tid(wv_), wid = __builtin_amdgcn_readfirstlane(tid >> 6), lane = tid & 63, wr = wid >> 2, wc = wid & 3, fr = lane & 15, fq = lane >> 4;
    const int nt = K / BK;
    int Rr[2], Cc[2]; unsigned voffA[2], voffB[2];
#pragma unroll
    for (int i = 0; i < 2; ++i) { stage_rc(tid * 16 + i * 8192, Rr[i], Cc[i]); const int Rb = Epi::PERM ? ((Rr[i] & ~31) + perm32(Rr[i] & 31)) : Rr[i];
        voffA[i] = (unsigned)(Rr[i] * K + Cc[i]) * 2u; voffB[i] = (unsigned)(Rb * K + Cc[i]) * 2u; }
    const size_t kstep = (size_t)(BK * 2);
    const size_t hstep = (size_t)HALF * K * 2;
    const size_t tstep = 2 * hstep;
    const unsigned ldsw = (unsigned)wid * 1024u;
    const int aoff = lds_byte(wr * 64 + fr, fq * 8), boff = lds_byte(wc * 32 + fr, fq * 8);
    const char* const Ab = (const char*)Aptr;
#define PG8_SA(b, h) (((b) * 2 + (h)) * HTB)
#define PG8_SB(b, h) ((4 + (b) * 2 + (h)) * HTB)
#define PG8_STAGE(bufoff, gbase, voff) do { _Pragma("unroll") for (int _i = 0; _i < 2; ++_i) \
        __builtin_amdgcn_global_load_lds((const unsigned*)((const char*)(gbase) + (voff)[_i]), (LAS unsigned*)(lds + (bufoff) + ldsw + _i * 8192), 16, 0, 0); } while (0)
#define PG8_STAGE_A(bufoff, usenext, h, kofs) do { \
        if constexpr (Sched::GATHER) { const char* gb_ = Ab + (kofs); unsigned vv_[2] = {(usenext) ? vN[h][0] : vA[h][0], (usenext) ? vN[h][1] : vA[h][1]}; PG8_STAGE(bufoff, gb_, vv_); } \
        else { const char* gb_ = ((usenext) ? nA : cA) + (size_t)(h) * hstep + (kofs); PG8_STAGE(bufoff, gb_, voffA); } } while (0)
#define PG8_LDA(dst, b, h) do { _Pragma("unroll") for (int m = 0; m < 4; ++m) _Pragma("unroll") for (int k = 0; k < 2; ++k) dst[m][k] = *(const LAS bf16x8*)(lds + PG8_SA(b, h) + aoff + m * 2048 + k * 1024); } while (0)
#define PG8_LDB(dst, b, h) do { _Pragma("unroll") for (int n = 0; n < 2; ++n) _Pragma("unroll") for (int k = 0; k < 2; ++k) dst[n][k] = *(const LAS bf16x8*)(lds + PG8_SB(b, h) + boff + n * 2048 + k * 1024); } while (0)
#define PG8_MMA(ai, bj, At, Bt) do { __builtin_amdgcn_s_setprio(1); _Pragma("unroll") for (int m = 0; m < 4; ++m) _Pragma("unroll") for (int n = 0; n < 2; ++n) _Pragma("unroll") for (int k = 0; k < 2; ++k) \
        acc[ai][bj][m][n] = __builtin_amdgcn_mfma_f32_16x16x32_bf16(Bt[n][k], At[m][k], acc[ai][bj][m][n], 0, 0, 0); __builtin_amdgcn_s_setprio(0); } while (0)
#define PG8_WAIT_V(n) asm volatile("s_waitcnt vmcnt(" #n ")" ::: "memory")
#define PG8_WAIT_L(n) asm volatile("s_waitcnt lgkmcnt(" #n ")" ::: "memory")
#define PG8_BAR __builtin_amdgcn_s_barrier()
#define PG8_SCHED __builtin_amdgcn_sched_barrier(0)
    Unit cur, nxt; int ui = 0;
    if (!S.next(0, cur)) return;
    f32x4 acc[2][2][4][2];
#pragma unroll
    for (int a = 0; a < 2; ++a)
#pragma unroll
        for (int b = 0; b < 2; ++b)
#pragma unroll
            for (int m = 0; m < 4; ++m)
#pragma unroll
                for (int n = 0; n < 2; ++n) acc[a][b][m][n] = (f32x4){0.f, 0.f, 0.f, 0.f};
    bf16x8 At[4][2], B0[2][2], B1[2][2];
    unsigned vA[2][2], vN[2][2];
    const char* cA = Ab; const char* nA = Ab;
    if constexpr (Sched::GATHER) {
#pragma unroll
        for (int h = 0; h < 2; ++h)
#pragma unroll
            for (int i = 0; i < 2; ++i) { vA[h][i] = S.a_voff(cur, h, Rr[i]) + (unsigned)Cc[i] * 2u; vN[h][i] = vA[h][i]; }
    } else { cA = Ab + (size_t)cur.pm * tstep; nA = cA; }
    const char* cB = S.b_tile(cur);
    PG8_STAGE(PG8_SB(0, 0), cB, voffB); PG8_STAGE_A(PG8_SA(0, 0), false, 0, 0); PG8_STAGE(PG8_SB(0, 1), cB + hstep, voffB); PG8_STAGE_A(PG8_SA(0, 1), false, 1, 0);
    if (wr == 1) PG8_BAR;
    PG8_WAIT_V(4); PG8_BAR;
    PG8_STAGE(PG8_SB(1, 0), cB + kstep, voffB); PG8_STAGE_A(PG8_SA(1, 0), false, 0, kstep); PG8_STAGE(PG8_SB(1, 1), cB + hstep + kstep, voffB);
    PG8_WAIT_V(6); PG8_BAR;
    for (;;) {
        const bool has_next = S.next(ui + 1, nxt);
        const char* nB = has_next ? S.b_tile(nxt) : cB;
        if constexpr (Sched::GATHER) {
#pragma unroll
            for (int h = 0; h < 2; ++h)
#pragma unroll
                for (int i = 0; i < 2; ++i) vN[h][i] = has_next ? S.a_voff(nxt, h, Rr[i]) + (unsigned)Cc[i] * 2u : vA[h][i];
        } else nA = has_next ? Ab + (size_t)nxt.pm * tstep : cA;
        for (int t = 0; t < nt; t += 2) {
            const bool last = (t == nt - 2);
            const size_t k1 = (size_t)(t + 1) * kstep, k2 = last ? 0 : (size_t)(t + 2) * kstep, k3 = k2 + kstep;
            const char* b2 = last ? nB : cB + (size_t)(t + 2) * kstep; const char* b3 = b2 + kstep;
            PG8_LDB(B0, 0, 0); PG8_SCHED; PG8_LDA(At, 0, 0); PG8_STAGE_A(PG8_SA(1, 1), false, 1, k1);
            PG8_WAIT_L(8); PG8_BAR; PG8_WAIT_L(0); PG8_MMA(0, 0, At, B0); PG8_BAR; PG8_SCHED;
            PG8_LDB(B1, 0, 1); PG8_STAGE(PG8_SB(0, 0), b2, voffB);
            PG8_BAR; PG8_WAIT_L(0); PG8_MMA(0, 1, At, B1); PG8_BAR;
            PG8_LDA(At, 0, 1); PG8_STAGE_A(PG8_SA(0, 0), last, 0, k2);
            PG8_BAR; PG8_WAIT_L(0); PG8_MMA(1, 0, At, B0); PG8_BAR; PG8_SCHED;
            PG8_STAGE(PG8_SB(0, 1), b2 + hstep, voffB);
            PG8_WAIT_V(6); PG8_BAR; PG8_MMA(1, 1, At, B1); PG8_BAR;
            PG8_LDB(B0, 1, 0); PG8_SCHED; PG8_LDA(At, 1, 0); PG8_STAGE_A(PG8_SA(0, 1), last, 1, k2);
            PG8_WAIT_L(8); PG8_BAR; PG8_WAIT_L(0); PG8_MMA(0, 0, At, B0); PG8_BAR; PG8_SCHED;
            PG8_LDB(B1, 1, 1); PG8_STAGE(PG8_SB(1, 0), b3, voffB);
            PG8_BAR; PG8_WAIT_L(0); PG8_MMA(0, 1, At, B1); PG8_BAR;
            PG8_LDA(At, 1, 1); PG8_STAGE_A(PG8_SA(1, 0), last, 0, k3);
            PG8_BAR; PG8_WAIT_L(0); PG8_MMA(1, 0, At, B0); PG8_BAR; PG8_SCHED;
            PG8_STAGE(PG8_SB(1, 1), b3 + hstep, voffB);
            PG8_WAIT_V(6); PG8_BAR; PG8_MMA(1, 1, At, B1); PG8_BAR;
        }
        E(acc, cur, wr, wc, fr, fq);
        if (!has_next) break;
#pragma unroll
        for (int a = 0; a < 2; ++a)
#pragma unroll
            for (int b = 0; b < 2; ++b)
#pragma unroll
                for (int m = 0; m < 4; ++m)
#pragma unroll
                    for (int n = 0; n < 2; ++n) acc[a][b][m][n] = (f32x4){0.f, 0.f, 0.f, 0.f};
        cur = nxt; cB = nB; cA = nA; ++ui;
        if constexpr (Sched::GATHER) {
#pragma unroll
            for (int h = 0; h < 2; ++h)
#pragma unroll
                for (int i = 0; i < 2; ++i) vA[h][i] = vN[h][i];
        }
    }
    PG8_WAIT_V(0);
    if (wr == 0) PG8_BAR;
    PG8_BAR;
#undef PG8_SA
#undef PG8_SB
#undef PG8_STAGE
#undef PG8_STAGE_A
#undef PG8_LDA
#undef PG8_LDB
#undef PG8_MMA
#undef PG8_WAIT_V
#undef PG8_WAIT_L
#undef PG8_BAR
#undef PG8_SCHED
}
template <int ACT> struct EpiBf16 {
    static constexpr bool PERM = true;
    bf16* O; int ldc; int tpt; size_t tstride; float* stats; int stat_pn0;
    __device__ __forceinline__ void operator()(const f32x4 (&acc)[2][2][4][2], const Unit& u, int wr, int wc, int fr, int fq) const {
        const int row0 = u.pm * BM + wr * 64 + fr; const int tt = u.pn / tpt; bf16* base = O + (size_t)tt * tstride; const int col0 = (u.pn - tt * tpt) * BM + wc * 32 + 8 * fq;
#pragma unroll
        for (int ai = 0; ai < 2; ++ai)
#pragma unroll
            for (int m = 0; m < 4; ++m) { bf16* rowp = base + (size_t)(row0 + ai * HALF + m * 16) * ldc + col0; float psum = 0.f, psq = 0.f;
#pragma unroll
                for (int bj = 0; bj < 2; ++bj) { f32x4 v0 = acc[ai][bj][m][0], v1 = acc[ai][bj][m][1];
                    if (ACT == 1) {
#pragma unroll
                        for (int q = 0; q < 4; ++q) { v0[q] = gelu_tanh(v0[q]); v1[q] = gelu_tanh(v1[q]); } }
                    if (ACT == 1) { psum += ((v0[0] + v0[1]) + (v0[2] + v0[3])) + ((v1[0] + v1[1]) + (v1[2] + v1[3]));
                        psq += ((v0[0] * v0[0] + v0[1] * v0[1]) + (v0[2] * v0[2] + v0[3] * v0[3])) + ((v1[0] * v1[0] + v1[1] * v1[1]) + (v1[2] * v1[2] + v1[3] * v1[3])); }
                    u32x4 w; w.x = cvt_pk_bf16(v0[0], v0[1]); w.y = cvt_pk_bf16(v0[2], v0[3]); w.z = cvt_pk_bf16(v1[0], v1[1]); w.w = cvt_pk_bf16(v1[2], v1[3]);
                    *(u32x4*)(rowp + bj * HALF) = w; }
                if (ACT == 1 && stats && u.pn >= stat_pn0) {
                    psum = xadd32(xadd16(psum)); psq = xadd32(xadd16(psq));
                    if (fq == 0) { f32x2 st2 = {psum, psq}; *(f32x2*)(stats + ((size_t)(row0 + ai * HALF + m * 16) * 32 + (u.pn - stat_pn0) * 4 + wc) * 2) = st2; } } }
    }
};
struct EpiResAdd {
    static constexpr bool PERM = false;
    float* X; int ldc;
    __device__ __forceinline__ void operator()(const f32x4 (&acc)[2][2][4][2], const Unit& u, int wr, int wc, int fr, int fq) const {
        const int row0 = u.pm * BM + wr * 64 + fr, col0 = u.pn * BM + wc * 32 + 4 * fq;
#pragma unroll
        for (int ai = 0; ai < 2; ++ai)
#pragma unroll
            for (int m2 = 0; m2 < 4; m2 += 2) {
                f32x4 x[2][2][2];
#pragma unroll
                for (int mm = 0; mm < 2; ++mm)
#pragma unroll
                    for (int bj = 0; bj < 2; ++bj)
#pragma unroll
                        for (int n = 0; n < 2; ++n) x[mm][bj][n] = *(const f32x4*)(X + (size_t)(row0 + ai * HALF + (m2 + mm) * 16) * ldc + col0 + bj * HALF + n * 16);
#pragma unroll
                for (int mm = 0; mm < 2; ++mm)
#pragma unroll
                    for (int bj = 0; bj < 2; ++bj)
#pragma unroll
                        for (int n = 0; n < 2; ++n) *(f32x4*)(X + (size_t)(row0 + ai * HALF + (m2 + mm) * 16) * ldc + col0 + bj * HALF + n * 16) = x[mm][bj][n] + acc[ai][bj][m2 + mm][n];
            }
    }
};
struct EpiResAddNorm {
    static constexpr bool PERM = false;
    float* X; int ldc; bf16* XB; float* rowsq;
    __device__ __forceinline__ void operator()(const f32x4 (&acc)[2][2][4][2], const Unit& u, int wr, int wc, int fr, int fq) const {
        const int row0 = u.pm * BM + wr * 64 + fr, col0 = u.pn * BM + wc * 32 + 4 * fq;
#pragma unroll
        for (int ai = 0; ai < 2; ++ai)
#pragma unroll
            for (int m2 = 0; m2 < 4; m2 += 2) {
                f32x4 x[2][2][2];
#pragma unroll
                for (int mm = 0; mm < 2; ++mm)
#pragma unroll
                    for (int bj = 0; bj < 2; ++bj)
#pragma unroll
                        for (int n = 0; n < 2; ++n) x[mm][bj][n] = *(const f32x4*)(X + (size_t)(row0 + ai * HALF + (m2 + mm) * 16) * ldc + col0 + bj * HALF + n * 16);
#pragma unroll
                for (int mm = 0; mm < 2; ++mm) {
                    const size_t ro = (size_t)(row0 + ai * HALF + (m2 + mm) * 16) * ldc + col0; float ssq = 0.f;
#pragma unroll
                    for (int bj = 0; bj < 2; ++bj)
#pragma unroll
                        for (int n = 0; n < 2; ++n) { const f32x4 v = x[mm][bj][n] + acc[ai][bj][m2 + mm][n];
                            *(f32x4*)(X + ro + bj * HALF + n * 16) = v;
                            u32x2 w; w.x = cvt_pk_bf16(v.x, v.y); w.y = cvt_pk_bf16(v.z, v.w); *(u32x2*)(XB + ro + bj * HALF + n * 16) = w;
                            ssq += (v.x * v.x + v.y * v.y) + (v.z * v.z + v.w * v.w); }
                    ssq = xadd32(xadd16(ssq));
                    if (fq == 0) rowsq[(size_t)(row0 + ai * HALF + (m2 + mm) * 16) * 16 + u.pn * 4 + wc] = ssq;
                }
            }
    }
};
struct EpiBf16RowScale {
    static constexpr bool PERM = true;
    bf16* O; int ldc; const float* rowsq;
    __device__ __forceinline__ void operator()(const f32x4 (&acc)[2][2][4][2], const Unit& u, int wr, int wc, int fr, int fq) const {
        const int row0 = u.pm * BM + wr * 64 + fr, col0 = u.pn * BM + wc * 32 + 8 * fq;
#pragma unroll
        for (int ai = 0; ai < 2; ++ai) {
            float rs[4];
#pragma unroll
            for (int m = 0; m < 4; ++m) { const f32x4* p = (const f32x4*)(rowsq + (size_t)(row0 + ai * HALF + m * 16) * 16); const f32x4 a = p[0], b = p[1], c = p[2], d = p[3];
                rs[m] = rsqrtf((((a.x + a.y) + (a.z + a.w)) + ((b.x + b.y) + (b.z + b.w)) + (((c.x + c.y) + (c.z + c.w)) + ((d.x + d.y) + (d.z + d.w)))) * (1.f / 1024.f) + EPS); }
#pragma unroll
            for (int m = 0; m < 4; ++m) { bf16* rowp = O + (size_t)(row0 + ai * HALF + m * 16) * ldc + col0;
#pragma unroll
                for (int bj = 0; bj < 2; ++bj) { const f32x4 v0 = acc[ai][bj][m][0] * rs[m], v1 = acc[ai][bj][m][1] * rs[m];
                    u32x4 w; w.x = cvt_pk_bf16(v0[0], v0[1]); w.y = cvt_pk_bf16(v0[2], v0[3]); w.z = cvt_pk_bf16(v1[0], v1[1]); w.w = cvt_pk_bf16(v1[2], v1[3]);
                    *(u32x4*)(rowp + bj * HALF) = w; } }
        }
    }
};
struct EpiSwiglu {
    static constexpr bool PERM = true;
    bf16* H; int ldc;
    __device__ __forceinline__ void operator()(const f32x4 (&acc)[2][2][4][2], const Unit& u, int wr, int wc, int fr, int fq) const {
        const int row0 = u.pm * BM + wr * 64 + fr, col0 = u.pn * HALF + wc * 32 + 8 * fq;
#pragma unroll
        for (int ai = 0; ai < 2; ++ai)
#pragma unroll
            for (int m = 0; m < 4; ++m) {
                float o[8];
#pragma unroll
                for (int n = 0; n < 2; ++n)
#pragma unroll
                    for (int q = 0; q < 4; ++q) { const float g = acc[ai][0][m][n][q]; o[4 * n + q] = g * sigmoidf_(g) * acc[ai][1][m][n][q]; }
                u32x4 w; w.x = cvt_pk_bf16(o[0], o[1]); w.y = cvt_pk_bf16(o[2], o[3]); w.z = cvt_pk_bf16(o[4], o[5]); w.w = cvt_pk_bf16(o[6], o[7]);
                *(u32x4*)(H + (size_t)(row0 + ai * HALF + m * 16) * ldc + col0) = w; }
    }
};
}

__device__ __forceinline__ int hyb_colmap(int n) {
    if (n < 1280) return n;
    if (n < 1536) return 1304 + (n - 1280);
    if (n < 1792) return 1560 + (n - 1536);
    if (n < 2304) return 1816 + (n - 1792);
    if (n < 2816) return 2344 + (n - 2304);
    if (n < 2840) return 1280 + (n - 2816);
    if (n < 2856) return 2328 + (n - 2840);
    return -1;
}
__device__ __forceinline__ void tr_item(const float* __restrict__ W, int Nsrc, int K, bf16* __restrict__ Wt, const float* __restrict__ gain, int kind, int nblk, LAS float* scr, int item, int lane) {
    const int kb = item / nblk, nb = item % nblk, k0 = 64 * kb, n0 = 64 * nb;
    const int ksub = lane >> 4, n4 = lane & 15, n = n0 + 4 * n4;
    int col;
    if (kind == 0) col = n; else if (kind == 1) col = hyb_colmap(n); else { const int pn = n >> 8, r = n & 255; col = (r >> 7) * 384 + pn * 128 + (r & 127); }
    f32x4 v[16];
#pragma unroll
    for (int i = 0; i < 16; ++i) v[i] = col >= 0 ? *(const f32x4*)(W + (size_t)(k0 + 4 * i + ksub) * Nsrc + col) : (f32x4){0.f, 0.f, 0.f, 0.f};
    if (gain) {
#pragma unroll
        for (int i = 0; i < 16; ++i) v[i] = v[i] * gain[k0 + 4 * i + ksub];
    }
#pragma unroll
    for (int i = 0; i < 16; ++i) { LAS float* d = scr + (4 * i + ksub) * 65 + 4 * n4; d[0] = v[i].x; d[1] = v[i].y; d[2] = v[i].z; d[3] = v[i].w; }
    LDS_WAIT();
    const int c = lane & 7;
#pragma unroll
    for (int jx = 0; jx < 8; ++jx) {
        const int nn = (lane >> 3) + 8 * jx; const LAS float* s = scr + (8 * c) * 65 + nn;
        u32x4 o; o.x = pk2(s[0 * 65], s[1 * 65]); o.y = pk2(s[2 * 65], s[3 * 65]); o.z = pk2(s[4 * 65], s[5 * 65]); o.w = pk2(s[6 * 65], s[7 * 65]);
        *(u32x4*)(Wt + (size_t)(n0 + nn) * K + k0 + 8 * c) = o;
    }
    LDS_WAIT();
}
__device__ __forceinline__ void rms_row_to_bf16(const float* __restrict__ xrow, bf16* __restrict__ orow, float* __restrict__ copy, int lane) {
    const f32x4* xr = (const f32x4*)xrow + lane;
    f32x4 v[4]; float s = 0.f;
#pragma unroll
    for (int j = 0; j < 4; ++j) { v[j] = xr[64 * j]; s += (v[j].x * v[j].x + v[j].y * v[j].y) + (v[j].z * v[j].z + v[j].w * v[j].w); }
    const float rstd = rsqrtf(wave_sum(s) * (1.f / 1024.f) + EPS);
    u32x2* o8 = (u32x2*)orow + lane;
#pragma unroll
    for (int j = 0; j < 4; ++j) { u32x2 w; w.x = pk2(v[j].x * rstd, v[j].y * rstd); w.y = pk2(v[j].z * rstd, v[j].w * rstd); o8[64 * j] = w; }
    if (copy) { f32x4* c4 = (f32x4*)copy + lane;
#pragma unroll
        for (int j = 0; j < 4; ++j) c4[64 * j] = v[j]; }
}

__device__ __forceinline__ void phase_prologue(KArgs A, int wv_, LAS unsigned char* lds) {
    const int tid = opaque_tid(wv_), wid = __builtin_amdgcn_readfirstlane(tid >> 6), lane = tid & 63;
    const int gw = blockIdx.x * 8 + wid, NGW = gridDim.x * 8;
    LAS float* scr = (LAS float*)(lds + wid * 16640);
    unsigned char* ws = opq(A->ws);
    constexpr int N_HYB = 2 * 768, N_HOUT = 2 * 256, N_SGIN = 2 * 1024, N_SGOUT = 2 * 512, N_WQ = 4 * 256, N_WKV = 4 * 512, N_WO = 4 * 256, N_MIN = 64 * 192, N_MOUT = 64 * 96, N_W1T = 4 * 32;
    constexpr int NITEMS = N_HYB + N_HOUT + N_SGIN + N_SGOUT + N_WQ + N_WKV + N_WO + N_MIN + N_MOUT + N_W1T;
    for (int it = gw; it < NITEMS; it += NGW) {
        int r = it;
        if (r < N_HYB) { const int sl = r / 768; tr_item(A->in[I_HYBIN] + (size_t)sl * 1024 * HYSRC, HYSRC, 1024, (bf16*)(ws + WS_WHYB) + (size_t)sl * HYN * 1024, A->in[I_NMIX] + (2 * sl) * 1024, 1, 48, scr, r % 768, lane); continue; } r -= N_HYB;
        if (r < N_HOUT) { const int sl = r / 256; tr_item(A->in[I_HYBOUT] + (size_t)sl * 1024 * 1024, 1024, 1024, (bf16*)(ws + WS_WHOUT) + (size_t)sl * 1024 * 1024, nullptr, 0, 16, scr, r % 256, lane); continue; } r -= N_HOUT;
        if (r < N_SGIN) { const int sl = r / 1024; tr_item(A->in[I_SGIN] + (size_t)sl * 1024 * 4096, 4096, 1024, (bf16*)(ws + WS_WSGIN) + (size_t)sl * 4096 * 1024, A->in[I_NMIX] + (2 * sl + 1) * 1024, 0, 64, scr, r % 1024, lane); continue; } r -= N_SGIN;
        if (r < N_SGOUT) { const int sl = r / 512; tr_item(A->in[I_SGOUT] + (size_t)sl * 2048 * 1024, 1024, 2048, (bf16*)(ws + WS_WSGOUT) + (size_t)sl * 1024 * 2048, nullptr, 0, 16, scr, r % 512, lane); continue; } r -= N_SGOUT;
        if (r < N_WQ) { const int sl = r / 256; tr_item(A->in[I_XWQ] + (size_t)sl * 1024 * 1024, 1024, 1024, (bf16*)(ws + WS_WQ) + (size_t)sl * 1024 * 1024, A->in[I_NXAT] + sl * 1024, 0, 16, scr, r % 256, lane); continue; } r -= N_WQ;
        if (r < N_WKV) { const int sl = r / 512; tr_item(A->in[I_XWKV] + (size_t)sl * 1024 * 2048, 2048, 1024, (bf16*)(ws + WS_WKV) + (size_t)sl * 2048 * 1024, A->in[I_NMEM] + sl * 1024, 0, 32, scr, r % 512, lane); continue; } r -= N_WKV;
        if (r < N_WO) { const int sl = r / 256; tr_item(A->in[I_XWO] + (size_t)sl * 1024 * 1024, 1024, 1024, (bf16*)(ws + WS_WO) + (size_t)sl * 1024 * 1024, nullptr, 0, 16, scr, r % 256, lane); continue; } r -= N_WO;
        if (r < N_MIN) { const int sl = r / 192; tr_item(A->in[I_MOEIN] + (size_t)sl * 1024 * 768, 768, 1024, (bf16*)(ws + WS_WMIN) + (size_t)sl * 768 * 1024, A->in[I_NFFN] + (sl >> 4) * 1024, 2, 12, scr, r % 192, lane); continue; } r -= N_MIN;
        if (r < N_MOUT) { const int sl = r / 96; tr_item(A->in[I_MOEOUT] + (size_t)sl * 384 * 1024, 1024, 384, (bf16*)(ws + WS_WMOUT) + (size_t)sl * 1024 * 384, nullptr, 0, 16, scr, r % 96, lane); continue; } r -= N_MOUT;
        { const int sl = r / 32; tr_item(A->in[I_CMPW1] + (size_t)sl * 2048 * 64, 64, 2048, (bf16*)(ws + WS_W1T) + (size_t)sl * 64 * 2048, nullptr, 0, 1, scr, r % 32, lane); }
    }
    for (int m = gw; m < T; m += NGW) rms_row_to_bf16(A->in[I_X] + (size_t)m * D, (bf16*)(ws + WS_XN) + (size_t)m * D, A->out + (size_t)m * D, lane);
    for (int m = gw; m < NBATCH * NMEM; m += NGW) rms_row_to_bf16(A->in[I_MEM] + (size_t)m * D, (bf16*)(ws + WS_MN) + (size_t)m * D, nullptr, lane);
    const int gt = blockIdx.x * 512 + tid, NGT = gridDim.x * 512;
    const int* pos = (const int*)A->in[I_POS];
    float* cosT = (float*)(ws + WS_COS); float* sinT = (float*)(ws + WS_SIN);
    for (int i = gt; i < T * 32; i += NGT) {
        const int t = i >> 5, j = i & 31;
        const float ang = (float)pos[t] * A->freq[j];
        const double rev = (double)ang * 0.15915494309189533577;
        const float fr = (float)(rev - rint(rev));
        cosT[i] = __builtin_amdgcn_cosf(fr); sinT[i] = __builtin_amdgcn_sinf(fr);
    }
    { bf16* WSB = (bf16*)(ws + WS_WSB); float* M0 = (float*)(ws + WS_M0); const float* wsg = A->in[I_SGWS];
      for (int e = gt; e < 2 * 8 * 128 * 128; e += NGT) { const int s = e & 127, t = (e >> 7) & 127; WSB[e] = (bf16)f2bf(s <= t ? wsg[e] : 0.f); }
      for (int e = gt; e < 2 * 8 * 128; e += NGT) { const int t = e & 127; const float* r = wsg + (size_t)e * 128; float a = 0.f; for (int s = 0; s <= t; ++s) a += r[s]; M0[e] = a; } }
    float* RW = (float*)(ws + WS_RW);
    for (int i = gt; i < DEPTH * NEXP * D; i += NGT) { const int k = i & 1023, e = (i >> 10) & 15, l = i >> 14; RW[i] = A->in[I_RW][k * NEXP + e] * A->in[I_NFFN][l * D + k]; }
}

__device__ __forceinline__ void phase_knorm(KArgs A, int wv_, const int gw, const int NGW) {
    const int tid_ = opaque_tid(wv_); const int lane = tid_ & 63;
    bf16* KV = (bf16*)(opq(A->ws) + WS_KV);
    for (int it0 = gw * 4; it0 < DEPTH * 2048 * 4; it0 += NGW * 4) {
        u32x2 w[4];
#pragma unroll
        for (int q = 0; q < 4; ++q) { const int it = it0 + q; const int h = it & 3, m = (it >> 2) & 2047, l = it >> 13; w[q] = *(const u32x2*)(KV + (size_t)m * 8192 + l * 2048 + h * 256 + 4 * lane); }
#pragma unroll
        for (int q = 0; q < 4; ++q) {
            const int it = it0 + q; const int h = it & 3, m = (it >> 2) & 2047, l = it >> 13;
            const float x0 = bflo(w[q].x), x1 = bfhi(w[q].x), x2 = bflo(w[q].y), x3 = bfhi(w[q].y);
            const float rstd = rsqrtf(wave_sum(x0 * x0 + x1 * x1 + x2 * x2 + x3 * x3) * (1.f / 256.f) + EPS) * 0.0625f;
            const f32x4 g = *(const f32x4*)(A->in[I_XKN] + l * 256 + 4 * lane) * *(const f32x4*)(A->in[I_XQN] + l * 256 + 4 * lane);
            u32x2 o; o.x = pk2(x0 * rstd * g.x, x1 * rstd * g.y); o.y = pk2(x2 * rstd * g.z, x3 * rstd * g.w);
            *(u32x2*)(KV + (size_t)m * 8192 + l * 2048 + h * 256 + 4 * lane) = o;
        }
    }
}

__device__ __forceinline__ int kpos64(int tok) { const int k = tok & 31; return (tok & 32) + 8 * ((k >> 2) & 3) + 4 * (k >> 4) + (k & 3); }
__device__ __forceinline__ int kperm64(int p) { const int fq = (p >> 3) & 3, j = p & 7; return (p & 32) + 16 * (j >> 2) + 4 * fq + (j & 3); }

__device__ __forceinline__ void phase_nsa_prep(KArgs A, int wv_, int i, LAS unsigned char* lds) {
    const int tid_ = opaque_tid(wv_); const int wid = __builtin_amdgcn_readfirstlane(tid_ >> 6), lane = tid_ & 63; const int gw = blockIdx.x * 8 + wid, NGW = gridDim.x * 8;
    unsigned char* ws = opq(A->ws);
    const bf16* HY = (const bf16*)(ws + WS_BIG);
    const float* cosT = (const float*)(ws + WS_COS); const float* sinT = (const float*)(ws + WS_SIN);
    bf16* QA = (bf16*)(ws + WS_QA); bf16* KS = (bf16*)(ws + WS_KS); bf16* KW = (bf16*)(ws + WS_KW);
    (void)lds;
    const int j8 = lane & 7, ug = lane >> 3;
    const int u1 = 8 + (ug & 3);
    const int src0 = C_QA + 64 * ug, src1 = u1 < 10 ? C_KS + 64 * (u1 - 8) : C_KW + 64 * (u1 - 10);
    const float* g0p = A->in[I_QNORM] + i * 64 + 8 * j8; const float* g1p = A->in[I_KNORM] + (i * 3 + (u1 < 10 ? 1 : 2)) * 64 + 8 * j8;
    const f32x4 g0a = *(const f32x4*)g0p, g0b = *(const f32x4*)(g0p + 4), g1a = *(const f32x4*)g1p, g1b = *(const f32x4*)(g1p + 4);
    u32x4 w0 = (u32x4){0u, 0u, 0u, 0u}, w1 = w0; f32x4 ca, cb, sa, sb;
    if (gw < T) { w0 = *(const u32x4*)(HY + (size_t)gw * HYN + src0 + 8 * j8); w1 = *(const u32x4*)(HY + (size_t)gw * HYN + src1 + 8 * j8);
        const float* cp = cosT + gw * 32 + 8 * (j8 & 3); const float* sp = sinT + gw * 32 + 8 * (j8 & 3); ca = *(const f32x4*)cp; cb = *(const f32x4*)(cp + 4); sa = *(const f32x4*)sp; sb = *(const f32x4*)(sp + 4); }
    for (int t = gw; t < T; t += NGW) {
        const int tn = t + NGW < T ? t + NGW : t;
        const u32x4 n0 = *(const u32x4*)(HY + (size_t)tn * HYN + src0 + 8 * j8), n1 = *(const u32x4*)(HY + (size_t)tn * HYN + src1 + 8 * j8);
        const float* cp = cosT + tn * 32 + 8 * (j8 & 3); const float* sp = sinT + tn * 32 + 8 * (j8 & 3);
        const f32x4 nca = *(const f32x4*)cp, ncb = *(const f32x4*)(cp + 4), nsa = *(const f32x4*)sp, nsb = *(const f32x4*)(sp + 4);
#pragma unroll
        for (int pass = 0; pass < 2; ++pass) {
            const u32x4 w = pass ? w1 : w0; const f32x4 ga = pass ? g1a : g0a, gb = pass ? g1b : g0b;
            float x[8] = {bflo(w.x), bfhi(w.x), bflo(w.y), bfhi(w.y), bflo(w.z), bfhi(w.z), bflo(w.w), bfhi(w.w)};
            float ssq = 0.f;
#pragma unroll
            for (int q = 0; q < 8; ++q) ssq += x[q] * x[q];
            ssq += __shfl_xor(ssq, 1); ssq += __shfl_xor(ssq, 2); ssq += __shfl_xor(ssq, 4);
            const float rs = rsqrtf(ssq * (1.f / 64.f) + EPS) * (pass ? 1.f : 0.125f * 1.4426950408889634f);
            const float gg[8] = {ga.x, ga.y, ga.z, ga.w, gb.x, gb.y, gb.z, gb.w}, cc[8] = {ca.x, ca.y, ca.z, ca.w, cb.x, cb.y, cb.z, cb.w}, ss[8] = {sa.x, sa.y, sa.z, sa.w, sb.x, sb.y, sb.z, sb.w};
            float o[8];
#pragma unroll
            for (int q = 0; q < 8; ++q) { const float y = x[q] * rs * gg[q]; const float pr = __shfl_xor(y, 4);
                o[q] = j8 < 4 ? y * cc[q] - pr * ss[q] : y * cc[q] + pr * ss[q]; }
            u32x4 ow; ow.x = pk2(o[0], o[1]); ow.y = pk2(o[2], o[3]); ow.z = pk2(o[4], o[5]); ow.w = pk2(o[6], o[7]);
            if (pass == 0) *(u32x4*)(QA + (size_t)t * 512 + 64 * ug + 8 * j8) = ow;
            else if (lane < 32) { bf16* dst = (u1 < 10 ? KS + (size_t)t * 128 + 64 * (u1 - 8) : KW + (size_t)t * 128 + 64 * (u1 - 10)); *(u32x4*)(dst + 8 * j8) = ow; }
        }
        w0 = n0; w1 = n1; ca = nca; cb = ncb; sa = nsa; sb = nsb;
    }
}

__device__ __forceinline__ void phase_compress_mfma(KArgs A, int wv_, int i, LAS unsigned char* lds) {
    const int tid = opaque_tid(wv_), wid = __builtin_amdgcn_readfirstlane(tid >> 6), lane = tid & 63, fr = lane & 15, fq = lane >> 4;
    unsigned char* ws = opq(A->ws);
    const bf16* HY = (const bf16*)(ws + WS_BIG);
    const float* cosT = (const float*)(ws + WS_COS); const float* sinT = (const float*)(ws + WS_SIN);
    LAS float* part = (LAS float*)lds;
    LAS float* hbuf = part + 8 * 1024;
    LAS float* obuf = hbuf + 1024;
    LAS float* w2l = obuf + 1024;
    int w2kv = -1;
    for (int it = blockIdx.x; it < 2 * 127; it += gridDim.x) {
        const int kv = it / 127, tile = it % 127;
        const float* pe = A->in[I_CMPPE] + (size_t)(i * 2 + kv) * 32 * 64;
        const float* w2 = A->in[I_CMPW2] + (size_t)(i * 2 + kv) * 64 * 64;
        const bf16* w1t = (const bf16*)(ws + WS_W1T) + (size_t)(i * 2 + kv) * 64 * 2048;
        const int coff = kv ? C_VC : C_KC;
        if (kv != w2kv) { __syncthreads(); for (int e4 = tid; e4 < 1024; e4 += 512) *(LAS f32x4*)(w2l + 4 * e4) = *(const f32x4*)(w2 + 4 * e4); w2kv = kv; }
        {
            const int R = tile * 16 + fr, g = R & 1, bn = R >> 1, n = bn % NCMP, b = bn / NCMP;
            const bf16* arow = HY + (size_t)(b * S + 16 * n) * HYN + coff + g * 64;
            f32x4 acc[4];
#pragma unroll
            for (int t = 0; t < 4; ++t) acc[t] = (f32x4){0.f, 0.f, 0.f, 0.f};
#pragma unroll 4
            for (int s = 0; s < 8; ++s) {
                const int k0 = 256 * wid + 32 * s, l = k0 >> 6, d0 = (k0 & 63) + 8 * fq;
                const u32x4 hw = *(const u32x4*)(arow + (size_t)l * HYN + d0);
                const f32x4 p0 = *(const f32x4*)(pe + l * 64 + d0), p1 = *(const f32x4*)(pe + l * 64 + d0 + 4);
                u32x4 aw; aw.x = pk2(bflo(hw.x) + p0.x, bfhi(hw.x) + p0.y); aw.y = pk2(bflo(hw.y) + p0.z, bfhi(hw.y) + p0.w); aw.z = pk2(bflo(hw.z) + p1.x, bfhi(hw.z) + p1.y); aw.w = pk2(bflo(hw.w) + p1.z, bfhi(hw.w) + p1.w);
                const bf16x8 af = __builtin_bit_cast(bf16x8, aw);
#pragma unroll
                for (int t = 0; t < 4; ++t) { const bf16x8 bfr = *(const bf16x8*)(w1t + (size_t)(16 * t + fr) * 2048 + k0 + 8 * fq);
                    acc[t] = __builtin_amdgcn_mfma_f32_16x16x32_bf16(af, bfr, acc[t], 0, 0, 0); }
            }
            __syncthreads();
#pragma unroll
            for (int t = 0; t < 4; ++t)
#pragma unroll
                for (int r = 0; r < 4; ++r) part[wid * 1024 + (4 * fq + r) * 64 + 16 * t + fr] = acc[t][r];
        }
        __syncthreads();
        for (int e = tid; e < 1024; e += 512) { float a = 0.f;
#pragma unroll
            for (int w = 0; w < 8; ++w) a += part[w * 1024 + e];
            hbuf[e] = gelu_tanh(a); }
        __syncthreads();
        for (int e = tid; e < 1024; e += 512) { const int r = e >> 6, j = e & 63; float o = 0.f;
#pragma unroll 8
            for (int m = 0; m < 64; ++m) o += hbuf[r * 64 + m] * w2l[m * 64 + j];
            obuf[e] = o; }
        __syncthreads();
        for (int r = wid; r < 16; r += 8) {
            const int R = tile * 16 + r, g = R & 1, bn = R >> 1, n = bn % NCMP, b = bn / NCMP;
            const float o = obuf[r * 64 + lane];
            if (kv == 0) {
                const float y = o * rsqrtf(wave_sum(o * o) * (1.f / 64.f) + EPS) * A->in[I_KNORM][(i * 3 + 0) * 64 + lane];
                const int tp = b * S + 16 * n + 31;
                const float c = cosT[tp * 32 + (lane & 31)], sn = sinT[tp * 32 + (lane & 31)];
                const float pr = __shfl_xor(y, 32);
                const float oo = lane < 32 ? y * c - pr * sn : y * c + pr * sn;
                ((bf16*)(ws + WS_KC))[((size_t)(b * 128 + n) * 2 + g) * 64 + lane] = (bf16)f2bf(oo);
            } else {
                bf16* vct = (bf16*)(ws + WS_VC) + ((size_t)(b * 2 + g) * 64 + lane) * 128;
                vct[(n & 64) + kpos64(n & 63)] = (bf16)f2bf(o);
                if (n == 126) vct[127] = 0;
            }
        }
    }
    __syncthreads();
}

__device__ __forceinline__ void nsa_softmax(f32x4 (&sc)[4], bf16x8 (&pf)[2], float& mrun, float& lrun, f32x4 (&o)[4], const bool rowok, const bool edge, const int kphi, const int kplo, const bool allrows, const int fq) {
    float bm = -INFINITY;
    if (edge) {
#pragma unroll
        for (int t = 0; t < 4; ++t)
#pragma unroll
            for (int r = 0; r < 4; ++r) { const int kp = 16 * t + 4 * fq + r; const bool v = rowok && kp <= kphi && kp >= kplo; sc[t][r] = v ? sc[t][r] : -INFINITY; bm = fmaxf(bm, sc[t][r]); }
    } else {
#pragma unroll
        for (int t = 0; t < 4; ++t) bm = fmaxf(bm, fmaxf(fmaxf(sc[t].x, sc[t].y), fmaxf(sc[t].z, sc[t].w)));
        if (!allrows) bm = rowok ? bm : -INFINITY;
    }
    bm = xmax32(xmax16(bm));
    const float mn = fmaxf(mrun, bm); const float mns = mn == -INFINITY ? 0.f : mn;
    float rs = 0.f;
#pragma unroll
    for (int t = 0; t < 4; ++t)
#pragma unroll
        for (int r = 0; r < 4; ++r) { sc[t][r] = __builtin_amdgcn_exp2f(sc[t][r] - mns); rs += sc[t][r]; }
    if (!edge && !allrows) {
#pragma unroll
        for (int t = 0; t < 4; ++t) sc[t] = rowok ? sc[t] : (f32x4){0.f, 0.f, 0.f, 0.f};
        rs = rowok ? rs : 0.f;
    }
    rs = xadd32(xadd16(rs));
    if (__all(mn == mrun)) { lrun += rs; }
    else {
        const float alpha = __builtin_amdgcn_exp2f(mrun - mns);
        lrun = lrun * alpha + rs; mrun = mn;
#pragma unroll
        for (int n = 0; n < 4; ++n) o[n] = o[n] * alpha;
    }
#pragma unroll
    for (int s = 0; s < 2; ++s) { u32x4 w; w.x = pk2(sc[2 * s].x, sc[2 * s].y); w.y = pk2(sc[2 * s].z, sc[2 * s].w); w.z = pk2(sc[2 * s + 1].x, sc[2 * s + 1].y); w.w = pk2(sc[2 * s + 1].z, sc[2 * s + 1].w);
        pf[s] = __builtin_bit_cast(bf16x8, w); }
}

__device__ __forceinline__ void phase_nsa_attn_mfma(KArgs A, int wv_, int i, LAS unsigned char* lds) {
    const int wid = wv_;
    unsigned char* ws = opq(A->ws);
    const bf16* HY = (const bf16*)(ws + WS_BIG); const bf16* QA = (const bf16*)(ws + WS_QA); const bf16* KS = (const bf16*)(ws + WS_KS); const bf16* KW = (const bf16*)(ws + WS_KW);
    const bf16* KC = (const bf16*)(ws + WS_KC); const bf16* VCT = (const bf16*)(ws + WS_VC); const bf16* VTA = (const bf16*)(ws + WS_VTA); bf16* CAT = (bf16*)(ws + WS_CAT);
    constexpr int RS = 72;
    LAS bf16* ktl = (LAS bf16*)lds;
    LAS bf16* vtl = ktl + 4 * 64 * RS;
    LAS float* scl = (LAS float*)(lds + 73728) + wid * 256;
    LAS unsigned* msk = (LAS unsigned*)(lds + 73728 + 8192);
    LAS unsigned* umask = msk + 64;
    const float* gb = A->in[I_GATEB] + i * 24;
    unsigned long long tsub = 0, tt0 = 0;
    for (int pit = blockIdx.x; pit < 256; pit += gridDim.x) {
#pragma unroll 1
        for (int hf = 0; hf < 2; ++hf) {
            const int tid = opaque_tid(wv_), lane = tid & 63, fr = lane & 15, fq = lane >> 4;
            const int bg = pit >> 4, xx = pit & 15, x = hf ? 31 - xx : xx, b = bg >> 1, g = bg & 1;
            const size_t tokbase = (size_t)b * S + 64 * x;
            const int tl0 = 8 * wid + (fr >> 2);
            if (tid == 0) *umask = 0u;
            if (PROBE_NSA == 1) tt0 = __builtin_amdgcn_s_memrealtime();
            bf16x8 qf[2][2];
#pragma unroll
            for (int mt = 0; mt < 2; ++mt)
#pragma unroll
                for (int s = 0; s < 2; ++s) qf[mt][s] = *(const bf16x8*)(QA + (tokbase + tl0 + 4 * mt) * 512 + (g * 4 + (fr & 3)) * 64 + 32 * s + 8 * fq);
            f32x4 outacc[2][4];
            {
                const int tmaxc = (4 * x + 3 + 15) >> 4;
                const bf16* kcb = KC + ((size_t)(b * 128 + fr) * 2 + g) * 64 + 8 * fq;
                bf16x8 pcf[2][4];
#pragma unroll
                for (int mt = 0; mt < 2; ++mt) {
                    f32x4 sc[8];
                    const bf16* kp = kcb;
#pragma unroll
                    for (int t = 0; t < 8; ++t) { sc[t] = (f32x4){0.f, 0.f, 0.f, 0.f};
                        asm volatile("" : "+v"(kp));
                        if (t < tmaxc) {
                            const bf16x8 k0 = *(const bf16x8*)(kp), k1 = *(const bf16x8*)(kp + 32);
                            sc[t] = __builtin_amdgcn_mfma_f32_16x16x32_bf16(k0, qf[mt][0], sc[t], 0, 0, 0);
                            sc[t] = __builtin_amdgcn_mfma_f32_16x16x32_bf16(k1, qf[mt][1], sc[t], 0, 0, 0); }
                        kp += 16 * 128; }
                    const int tg = 64 * x + tl0 + 4 * mt; const int ncv = tg >= 31 ? ((tg - 31) >> 4) + 1 : 0;
                    float mx = -INFINITY;
#pragma unroll
                    for (int t = 0; t < 8; ++t)
#pragma unroll
                        for (int r = 0; r < 4; ++r) { const bool v = 16 * t + 4 * fq + r < ncv; sc[t][r] = v ? sc[t][r] : -INFINITY; mx = fmaxf(mx, sc[t][r]); }
                    mx = xmax32(xmax16(mx));
                    const float mxs = mx == -INFINITY ? 0.f : mx;
                    float sum = 0.f;
#pragma unroll
                    for (int t = 0; t < 8; ++t)
#pragma unroll
                        for (int r = 0; r < 4; ++r) { sc[t][r] = __builtin_amdgcn_exp2f(sc[t][r] - mxs); sum += sc[t][r]; }
                    sum = xadd32(xadd16(sum));
                    const float inv = sum > 0.f ? 1.f / sum : 0.f;
#pragma unroll
                    for (int t = 0; t < 8; ++t) sc[t] = sc[t] * inv;
#pragma unroll
                    for (int s = 0; s < 4; ++s) { u32x4 w; w.x = pk2(sc[2 * s].x, sc[2 * s].y); w.y = pk2(sc[2 * s].z, sc[2 * s].w); w.z = pk2(sc[2 * s + 1].x, sc[2 * s + 1].y); w.w = pk2(sc[2 * s + 1].z, sc[2 * s + 1].w);
                        pcf[mt][s] = __builtin_bit_cast(bf16x8, w); }
                    float w3[8];
#pragma unroll
                    for (int t = 0; t < 8; ++t) {
#pragma unroll
                        for (int r = 0; r < 4; ++r) { float v = sc[t][r]; v += __shfl_xor(v, 1); v += __shfl_xor(v, 2); sc[t][r] = v; }
                        w3[t] = __shfl(sc[t].w, (lane + 48) & 63);
                    }
#pragma unroll
                    for (int t = 0; t < 8; ++t) {
                        const float prev = fq > 0 ? w3[t] : (t > 0 ? w3[t > 0 ? t - 1 : 0] : 0.f);
                        const float imp = sc[t].x + sc[t].y + sc[t].z + 0.5f * sc[t].w + 0.5f * prev;
                        if ((fr & 3) == 0) scl[(4 * mt + (fr >> 2)) * 32 + 4 * t + fq] = imp;
                    }
                    asm volatile("" ::: "memory");
                }
                const bf16* vcb = VCT + ((size_t)(b * 2 + g) * 64 + fr) * 128 + 8 * fq;
#pragma unroll
                for (int n = 0; n < 4; ++n) {
                    outacc[0][n] = (f32x4){0.f, 0.f, 0.f, 0.f}; outacc[1][n] = (f32x4){0.f, 0.f, 0.f, 0.f};
                    asm volatile("" : "+v"(vcb));
#pragma unroll
                    for (int s = 0; s < 4; ++s) if (2 * s < tmaxc) {
                        const bf16x8 vf = *(const bf16x8*)(vcb + 32 * s);
                        outacc[0][n] = __builtin_amdgcn_mfma_f32_16x16x32_bf16(vf, pcf[0][s], outacc[0][n], 0, 0, 0);
                        outacc[1][n] = __builtin_amdgcn_mfma_f32_16x16x32_bf16(vf, pcf[1][s], outacc[1][n], 0, 0, 0); }
                    vcb += 16 * 128;
                    asm volatile("" ::: "memory");
                }
            }
            float g1v[2], g2v[2];
#pragma unroll
            for (int mt = 0; mt < 2; ++mt) {
                const int head = g * 4 + (fr & 3);
                const bf16* gl = HY + (tokbase + tl0 + 4 * mt) * HYN + C_GA + head * 3;
                const float g0 = sigmoidf_(bf2f(gl[0]) + gb[head * 3 + 0]);
                g1v[mt] = sigmoidf_(bf2f(gl[1]) + gb[head * 3 + 1]); g2v[mt] = sigmoidf_(bf2f(gl[2]) + gb[head * 3 + 2]);
#pragma unroll
                for (int n = 0; n < 4; ++n) outacc[mt][n] = outacc[mt][n] * g0;
            }
            LDS_WAIT();
            asm volatile("" ::: "memory");
            {
                const int tok8 = lane >> 3, jg = lane & 7;
                float sj[32];
#pragma unroll
                for (int q = 0; q < 8; ++q) { const f32x4 v = *(const LAS f32x4*)(scl + tok8 * 32 + 4 * q); sj[4 * q] = v.x; sj[4 * q + 1] = v.y; sj[4 * q + 2] = v.z; sj[4 * q + 3] = v.w; }
#pragma unroll
                for (int j = 0; j < 32; ++j) sj[j] = j <= x ? sj[j] + ((j == 0 || j == x || j == x - 1) ? 1000.0f : 0.f) : -INFINITY;
                unsigned bits = 0u;
                const f32x4 mv = *(const LAS f32x4*)(scl + tok8 * 32 + 4 * jg);
#pragma unroll
                for (int q = 0; q < 4; ++q) {
                    const int j = 4 * jg + q;
                    const float mine = j <= x ? mv[q] + ((j == 0 || j == x || j == x - 1) ? 1000.0f : 0.f) : -INFINITY;
                    int rank = 0;
#pragma unroll
                    for (int jj = 0; jj < 32; ++jj) rank += (sj[jj] > mine || (sj[jj] == mine && jj < j)) ? 1 : 0;
                    bits |= (j <= x && rank < 8) ? (1u << j) : 0u;
                }
                bits |= __shfl_xor(bits, 1); bits |= __shfl_xor(bits, 2); bits |= __shfl_xor(bits, 4);
                if (jg == 0) { msk[wid * 8 + tok8] = bits; atomicOr((unsigned*)umask, bits); }
            }
            __syncthreads();
            if (PROBE_NSA == 1) tsub += __builtin_amdgcn_s_memrealtime() - tt0;
#pragma unroll 1
            for (int pp = 0; pp < 2 + (PROBE_NSAX ? 1 : 0); ++pp) {
                const int pass = pp == 2 ? 0 : pp; const bool dummy = pp == 2;
                if (PROBE_NSA == 2 + pass) tt0 = __builtin_amdgcn_s_memrealtime();
                const int jlo = pass ? (x >= 4 ? x - 4 : 0) : 0;
                const unsigned inrange = (x >= 31 ? 0xffffffffu : ((2u << x) - 1u)) & ~((1u << jlo) - 1u);
                unsigned bmask = pass ? inrange : (*umask & inrange);
                const bf16* Kb = pass ? KW : KS; const int cg = (pass ? 10 : 8) + g;
                unsigned tm[2], wm[2], am[2];
#pragma unroll
                for (int mt = 0; mt < 2; ++mt) {
                    tm[mt] = pass ? 0xffffffffu : msk[wid * 8 + 4 * mt + (fr >> 2)];
                    wm[mt] = pass ? 0xffffffffu : (msk[wid * 8 + 4 * mt] | msk[wid * 8 + 4 * mt + 1] | msk[wid * 8 + 4 * mt + 2] | msk[wid * 8 + 4 * mt + 3]);
                    am[mt] = pass ? 0xffffffffu : (msk[wid * 8 + 4 * mt] & msk[wid * 8 + 4 * mt + 1] & msk[wid * 8 + 4 * mt + 2] & msk[wid * 8 + 4 * mt + 3]);
                    wm[mt] = __builtin_amdgcn_readfirstlane(wm[mt]); am[mt] = __builtin_amdgcn_readfirstlane(am[mt]);
                    if (PROBE_NSAX == 2 && dummy) wm[mt] = 0u;
                }
                f32x4 o[2][4]; float mrun[2], lrun[2];
#pragma unroll
                for (int mt = 0; mt < 2; ++mt) { mrun[mt] = -INFINITY; lrun[mt] = 0.f;
#pragma unroll
                    for (int n = 0; n < 4; ++n) o[mt][n] = (f32x4){0.f, 0.f, 0.f, 0.f}; }
                const int srow = tid >> 3, sc16 = tid & 7;
                u32x4 pk0 = (u32x4){0u, 0u, 0u, 0u}, pv0 = pk0, pk1 = pk0, pv1 = pk0;
#define NSA_LD(jx, pk, pv) do { const bf16* ksrc = Kb + ((size_t)b * S + 64 * (jx) + srow) * 128 + g * 64 + sc16 * 8; const bf16* vsrc = VTA + ((size_t)((b * 32 + (jx)) * 12 + cg)) * 4096 + srow * 64 + sc16 * 8; \
                    pk = *(const u32x4*)ksrc; pv = *(const u32x4*)vsrc; } while (0)
                int j0 = __ffs(bmask) - 1; bmask &= bmask - 1u;
                int j1 = bmask ? __ffs(bmask) - 1 : -1; bmask &= bmask - 1u;
                NSA_LD(j0, pk0, pv0); if (j1 >= 0) NSA_LD(j1, pk1, pv1);
                int buf = 0;
                while (j0 >= 0) {
                    *(LAS u32x4*)(ktl + (buf * 2 + 0) * 64 * RS + srow * RS + sc16 * 8) = pk0; *(LAS u32x4*)(vtl + (buf * 2 + 0) * 64 * RS + srow * RS + sc16 * 8) = pv0;
                    if (j1 >= 0) { *(LAS u32x4*)(ktl + (buf * 2 + 1) * 64 * RS + srow * RS + sc16 * 8) = pk1; *(LAS u32x4*)(vtl + (buf * 2 + 1) * 64 * RS + srow * RS + sc16 * 8) = pv1; }
                    const int jn0 = bmask ? __ffs(bmask) - 1 : -1; bmask &= bmask - 1u;
                    const int jn1 = bmask ? __ffs(bmask) - 1 : -1; bmask &= bmask - 1u;
                    if (jn0 >= 0) NSA_LD(jn0, pk0, pv0);
                    if (jn1 >= 0) NSA_LD(jn1, pk1, pv1);
                    __syncthreads();
#pragma unroll 1
                    for (int sub = 0; sub < 2; ++sub) {
                        const int j = sub ? j1 : j0;
                        if (j < 0) break;
                        const LAS bf16* kt = ktl + (buf * 2 + sub) * 64 * RS + fr * RS + 8 * fq; const LAS bf16* vt = vtl + (buf * 2 + sub) * 64 * RS + fr * RS + 8 * fq;
                        const bool nd0 = (wm[0] >> j) & 1u, nd1 = (wm[1] >> j) & 1u;
                        if (!(nd0 || nd1)) continue;
                        const bool edge = (j == x) || (pass && j == x - 4);
                        f32x4 sc0[4], sc1[4];
#pragma unroll
                        for (int t = 0; t < 4; ++t) { sc0[t] = (f32x4){0.f, 0.f, 0.f, 0.f}; sc1[t] = (f32x4){0.f, 0.f, 0.f, 0.f};
                            const bf16x8 k0_ = *(const LAS bf16x8*)(kt + t * 16 * RS), k1_ = *(const LAS bf16x8*)(kt + t * 16 * RS + 32);
                            if (nd0) { sc0[t] = __builtin_amdgcn_mfma_f32_16x16x32_bf16(k0_, qf[0][0], sc0[t], 0, 0, 0); sc0[t] = __builtin_amdgcn_mfma_f32_16x16x32_bf16(k1_, qf[0][1], sc0[t], 0, 0, 0); }
                            if (nd1) { sc1[t] = __builtin_amdgcn_mfma_f32_16x16x32_bf16(k0_, qf[1][0], sc1[t], 0, 0, 0); sc1[t] = __builtin_amdgcn_mfma_f32_16x16x32_bf16(k1_, qf[1][1], sc1[t], 0, 0, 0); } }
                        bf16x8 pf0[2], pf1[2];
                        if (nd0) nsa_softmax(sc0, pf0, mrun[0], lrun[0], o[0], (tm[0] >> j) & 1u, edge, j == x ? tl0 : 63, (pass && j == x - 4) ? tl0 + 1 : 0, (am[0] >> j) & 1u, fq);
                        if (nd1) nsa_softmax(sc1, pf1, mrun[1], lrun[1], o[1], (tm[1] >> j) & 1u, edge, j == x ? tl0 + 4 : 63, (pass && j == x - 4) ? tl0 + 5 : 0, (am[1] >> j) & 1u, fq);
#pragma unroll
                        for (int n = 0; n < 4; ++n) {
                            const bf16x8 v0_ = *(const LAS bf16x8*)(vt + n * 16 * RS), v1_ = *(const LAS bf16x8*)(vt + n * 16 * RS + 32);
                            if (nd0) { o[0][n] = __builtin_amdgcn_mfma_f32_16x16x32_bf16(v0_, pf0[0], o[0][n], 0, 0, 0); o[0][n] = __builtin_amdgcn_mfma_f32_16x16x32_bf16(v1_, pf0[1], o[0][n], 0, 0, 0); }
                            if (nd1) { o[1][n] = __builtin_amdgcn_mfma_f32_16x16x32_bf16(v0_, pf1[0], o[1][n], 0, 0, 0); o[1][n] = __builtin_amdgcn_mfma_f32_16x16x32_bf16(v1_, pf1[1], o[1][n], 0, 0, 0); } }
                    }
                    j0 = jn0; j1 = jn1; buf ^= 1;
                }
#undef NSA_LD
#pragma unroll
                for (int mt = 0; mt < 2; ++mt) { const float sc_ = (pass ? g2v[mt] : g1v[mt]) / lrun[mt];
                    if (!dummy) {
#pragma unroll
                    for (int n = 0; n < 4; ++n) outacc[mt][n] = outacc[mt][n] + o[mt][n] * sc_; } }
                __syncthreads();
                if (PROBE_NSA == 2 + pass) tsub += __builtin_amdgcn_s_memrealtime() - tt0;
            }
#pragma unroll
            for (int mt = 0; mt < 2; ++mt) {
                bf16* dst = CAT + (tokbase + tl0 + 4 * mt) * 1024 + (g * 4 + (fr & 3)) * 64 + 4 * fq;
#pragma unroll
                for (int n = 0; n < 4; ++n) { u32x2 w; w.x = pk2(outacc[mt][n].x, outacc[mt][n].y); w.y = pk2(outacc[mt][n].z, outacc[mt][n].w); *(u32x2*)(dst + 16 * n) = w; }
            }
        }
    }
    __syncthreads();
    if (PROBE_NSA && blockIdx.x == 0 && opaque_tid(wv_) == 0) atomicAdd((unsigned long long*)(ws + WS_CTL + 48000), tsub);
}

__device__ __forceinline__ void phase_vtiles(KArgs A, int wv_, LAS unsigned char* lds) {
    const int tid_ = opaque_tid(wv_); const int wid = __builtin_amdgcn_readfirstlane(tid_ >> 6), lane = tid_ & 63; const int gw = blockIdx.x * 8 + wid, NGW = gridDim.x * 8;
    unsigned char* ws = opq(A->ws);
    const bf16* HY = (const bf16*)(ws + WS_BIG); bf16* VTA = (bf16*)(ws + WS_VTA);
    constexpr int TS = 66;
    LAS bf16* tl = (LAS bf16*)(lds + 65536) + wid * (64 * TS);
    for (int it = gw; it < NBATCH * 32 * 12; it += NGW) {
        const int cg = it % 12, bc = it / 12;
        const int colbase = cg < 8 ? C_VB + cg * 64 : (cg < 10 ? C_VS + (cg - 8) * 64 : C_VW + (cg - 10) * 64);
        const u32x4* src = (const u32x4*)(HY + (size_t)(bc * 64 + lane) * HYN + colbase);
        u32x4 w[8];
#pragma unroll
        for (int i = 0; i < 8; ++i) w[i] = src[i];
#pragma unroll
        for (int i = 0; i < 8; ++i) { LAS unsigned* d = (LAS unsigned*)(tl + lane * TS + 8 * i); d[0] = w[i].x; d[1] = w[i].y; d[2] = w[i].z; d[3] = w[i].w; }
        LDS_WAIT();
        bf16* dst = VTA + (size_t)it * 4096 + lane * 64;
#pragma unroll
        for (int p8 = 0; p8 < 8; ++p8) {
            unsigned short x[8];
#pragma unroll
            for (int j = 0; j < 8; ++j) x[j] = tl[kperm64(p8 * 8 + j) * TS + lane];
            u32x4 o; o.x = x[0] | ((unsigned)x[1] << 16); o.y = x[2] | ((unsigned)x[3] << 16); o.z = x[4] | ((unsigned)x[5] << 16); o.w = x[6] | ((unsigned)x[7] << 16);
            *(u32x4*)(dst + p8 * 8) = o;
        }
        LDS_WAIT();
    }
}

__device__ __forceinline__ void vtrans_wave(KArgs A, int wv_, LAS bf16* tl, const int gw, const int NGW) {
    const int tid_ = opaque_tid(wv_); const int lane = tid_ & 63;
    unsigned char* ws = opq(A->ws);
    const bf16* KV = (const bf16*)(ws + WS_KV); bf16* VT = (bf16*)(ws + WS_VT);
    constexpr int TS = 66;
    for (int it = gw; it < DEPTH * NBATCH * 4 * 16; it += NGW) {
        const int db = it & 3, kb = (it >> 2) & 3, h = (it >> 4) & 3, b = (it >> 6) & 7, l = it >> 9;
        const u32x4* src = (const u32x4*)(KV + (size_t)(b * 256 + 64 * kb + lane) * 8192 + l * 2048 + 1024 + h * 256 + 64 * db);
        u32x4 w[8];
#pragma unroll
        for (int i = 0; i < 8; ++i) w[i] = src[i];
#pragma unroll
        for (int i = 0; i < 8; ++i) { LAS unsigned* d = (LAS unsigned*)(tl + lane * TS + 8 * i); d[0] = w[i].x; d[1] = w[i].y; d[2] = w[i].z; d[3] = w[i].w; }
        LDS_WAIT();
        bf16* dst = VT + ((size_t)((l * 8 + b) * 4 + h) * 256 + 64 * db + lane) * 256 + 64 * kb;
#pragma unroll
        for (int p8 = 0; p8 < 8; ++p8) {
            unsigned short x[8];
#pragma unroll
            for (int j = 0; j < 8; ++j) x[j] = tl[kperm64(p8 * 8 + j) * TS + lane];
            u32x4 o; o.x = x[0] | ((unsigned)x[1] << 16); o.y = x[2] | ((unsigned)x[3] << 16); o.z = x[4] | ((unsigned)x[5] << 16); o.w = x[6] | ((unsigned)x[7] << 16);
            *(u32x4*)(dst + p8 * 8) = o;
        }
        LDS_WAIT();
    }
}

__device__ __forceinline__ float log_sigmoid16(float z) { return (fminf(z, 0.f) - __logf(1.0f + __expf(-fabsf(z)))) * (1.f / 16.f); }
#define GLA_Z(tokv) ({ float z_ = bias; _Pragma("unroll") for (int r_ = 0; r_ < 16; ++r_) z_ += __builtin_bit_cast(float, __builtin_amdgcn_readlane(__builtin_bit_cast(int, al[r_]), (tokv))) * wc[r_]; z_; })
#define GLA_LOAD_GATE() \
    float al[16], wc[16]; \
    { const u32x4* ap_ = (const u32x4*)(HY + (size_t)(tok0 + lane) * HYN + C_AL); const u32x4 a0_ = ap_[0], a1_ = ap_[1]; \
      al[0] = bflo(a0_.x); al[1] = bfhi(a0_.x); al[2] = bflo(a0_.y); al[3] = bfhi(a0_.y); al[4] = bflo(a0_.z); al[5] = bfhi(a0_.z); al[6] = bflo(a0_.w); al[7] = bfhi(a0_.w); \
      al[8] = bflo(a1_.x); al[9] = bfhi(a1_.x); al[10] = bflo(a1_.y); al[11] = bfhi(a1_.y); al[12] = bflo(a1_.z); al[13] = bfhi(a1_.z); al[14] = bflo(a1_.w); al[15] = bfhi(a1_.w); } \
    _Pragma("unroll") for (int r_ = 0; r_ < 16; ++r_) wc[r_] = A->in[I_WA2][(i * 16 + r_) * 256 + h * 64 + lane]; \
    const float bias = A->in[I_BA][i * 256 + h * 64 + lane];

__device__ __forceinline__ void phase_gla_a(KArgs A, int wv_, int i, LAS unsigned char* lds) {
    const int tid_ = opaque_tid(wv_); const int wid = __builtin_amdgcn_readfirstlane(tid_ >> 6), lane = tid_ & 63, fr = lane & 15, fq = lane >> 4; const int gw = blockIdx.x * 8 + wid, NGW = gridDim.x * 8;
    unsigned char* ws = opq(A->ws);
    const bf16* HY = (const bf16*)(ws + WS_BIG); const bf16* VTA = (const bf16*)(ws + WS_VTA); float* SLOC = (float*)(ws + WS_SLOC); float* DEC = (float*)(ws + WS_DEC);
    constexpr int RS = 72;
    LAS bf16* kh = (LAS bf16*)lds + wid * (64 * RS);
    (void)gw;
    for (int it = wid * (int)gridDim.x + (int)blockIdx.x; it < 1024; it += NGW) {
        const int c = it & 31, bh = it >> 5, b = bh >> 2, h = bh & 3; const size_t tok0 = (size_t)b * S + c * 64;
        GLA_LOAD_GATE();
        float bl = 0.f; float la[64];
#pragma unroll
        for (int tk = 0; tk < 64; ++tk) { la[tk] = log_sigmoid16(GLA_Z(tk)); bl += la[tk]; }
        float bc = 0.f;
        unsigned short kcol[64];
#pragma unroll
        for (int tk = 0; tk < 64; ++tk) kcol[tk] = HY[(tok0 + tk) * HYN + C_KB + h * 64 + lane];
#pragma unroll
        for (int tk = 0; tk < 64; ++tk) {
            bc += la[tk];
            kh[lane * RS + kpos64(tk)] = (bf16)f2bf(bf2f(kcol[tk]) * __expf(bl - bc));
        }
        DEC[it * 64 + lane] = __expf(bl);
        LDS_WAIT();
#pragma unroll
        for (int dvh = 0; dvh < 2; ++dvh) {
            const bf16* vt = VTA + ((size_t)((b * 32 + c) * 12 + h * 2 + dvh)) * 4096;
            bf16x8 vf[4][2];
#pragma unroll
            for (int n = 0; n < 4; ++n)
#pragma unroll
                for (int s = 0; s < 2; ++s) vf[n][s] = *(const bf16x8*)(vt + (16 * n + fr) * 64 + 32 * s + 8 * fq);
#pragma unroll
            for (int m = 0; m < 4; ++m) {
                const bf16x8 a0 = *(const LAS bf16x8*)(kh + (16 * m + fr) * RS + 8 * fq), a1 = *(const LAS bf16x8*)(kh + (16 * m + fr) * RS + 32 + 8 * fq);
#pragma unroll
                for (int n = 0; n < 4; ++n) {
                    f32x4 acc = (f32x4){0.f, 0.f, 0.f, 0.f};
                    acc = __builtin_amdgcn_mfma_f32_16x16x32_bf16(a0, vf[n][0], acc, 0, 0, 0);
                    acc = __builtin_amdgcn_mfma_f32_16x16x32_bf16(a1, vf[n][1], acc, 0, 0, 0);
                    float* dst = SLOC + ((size_t)it * 64 + 16 * m + 4 * fq) * 128 + dvh * 64 + 16 * n + fr;
                    dst[0] = acc.x; dst[128] = acc.y; dst[256] = acc.z; dst[384] = acc.w;
                }
            }
        }
        LDS_WAIT();
    }
}
__device__ __forceinline__ void phase_gla_c(KArgs A, int wv_, int i, LAS unsigned char* lds, const bool kv_post) {
    const int tid_ = opaque_tid(wv_); const int wid = __builtin_amdgcn_readfirstlane(tid_ >> 6), lane = tid_ & 63, fr = lane & 15, fq = lane >> 4; const int gw = blockIdx.x * 8 + wid, NGW = gridDim.x * 8;
    unsigned char* ws = opq(A->ws);
    const bf16* HY = (const bf16*)(ws + WS_BIG); const bf16* VTA = (const bf16*)(ws + WS_VTA); const bf16* STT = (const bf16*)(ws + WS_STT); bf16* CAT = (bf16*)(ws + WS_CAT);
    constexpr int RS = 72;
    LAS bf16* qs = (LAS bf16*)lds + wid * (128 * RS);
    LAS bf16* ks = qs + 64 * RS;
    const float* og = A->in[I_ONORM] + i * 128;
    LAS float* ogl = (LAS float*)(lds + 8 * 128 * RS * 2);
    if (tid_ < 128) ogl[tid_] = og[tid_];
    (void)gw; (void)NGW;
    for (int blk = blockIdx.x; blk < 256; blk += gridDim.x) {
        SUBT_BEGIN(1);
        {
            const float* SLOC = (const float*)(ws + WS_SLOC); const float* DEC = (const float*)(ws + WS_DEC); bf16* STw = (bf16*)(ws + WS_STT);
            const int tid = tid_, dv = tid & 127, ko = tid >> 7, bh = blk >> 3, c0 = (blk & 7) * 4;
            float sv[16];
#pragma unroll
            for (int j = 0; j < 16; ++j) sv[j] = 0.f;
#pragma unroll 1
            for (int cb = 0; cb < c0 + 4; cb += 4) {
                float dc4[4][16], sl4[4][16];
#pragma unroll
                for (int q = 0; q < 4; ++q) {
                    const size_t item = (size_t)bh * 32 + cb + q; const float* sl = SLOC + (item * 64 + ko * 16) * 128 + dv; const float* dc = DEC + item * 64 + ko * 16;
#pragma unroll
                    for (int j = 0; j < 16; ++j) { dc4[q][j] = dc[j]; sl4[q][j] = sl[j * 128]; }
                }
#pragma unroll
                for (int q = 0; q < 4; ++q) {
                    const int c = cb + q; const size_t item = (size_t)bh * 32 + c;
                    if (c >= c0) {
                        u32x4 o0, o1; o0.x = pk2(sv[0], sv[1]); o0.y = pk2(sv[2], sv[3]); o0.z = pk2(sv[4], sv[5]); o0.w = pk2(sv[6], sv[7]);
                        o1.x = pk2(sv[8], sv[9]); o1.y = pk2(sv[10], sv[11]); o1.z = pk2(sv[12], sv[13]); o1.w = pk2(sv[14], sv[15]);
                        u32x4* d = (u32x4*)(STw + (item * 128 + dv) * 64 + ko * 16); d[0] = o0; d[1] = o1;
                    }
#pragma unroll
                    for (int j = 0; j < 16; ++j) sv[j] = dc4[q][j] * sv[j] + sl4[q][j];
                }
            }
            asm volatile("s_waitcnt vmcnt(0)" ::: "memory");
            __syncthreads();
        }
        SUBT_END(1, ws, tid_);
        SUBT_BEGIN(2);
        SUBT_BEGIN(3);
        if (wid < 4) {
        const int it = blk * 4 + wid;
        const int c = it & 31, bh = it >> 5, b = bh >> 2, h = bh & 3; const size_t tok0 = (size_t)b * S + c * 64;
        GLA_LOAD_GATE();
        float bc = 0.f;
        unsigned short qcol[64], kcol[64];
#pragma unroll
        for (int tk = 0; tk < 64; ++tk) { const bf16* row = HY + (tok0 + tk) * HYN; qcol[tk] = row[C_QB + h * 64 + lane]; kcol[tk] = row[C_KB + h * 64 + lane]; }
#pragma unroll
        for (int tk = 0; tk < 64; ++tk) {
            bc += log_sigmoid16(GLA_Z(tk));
            const float eb = __expf(bc);
            qs[tk * RS + lane] = (bf16)f2bf(bf2f(qcol[tk]) * 0.125f * eb); ks[tk * RS + lane] = (bf16)f2bf(bf2f(kcol[tk]) / eb);
        }
        LDS_WAIT();
        SUBT_END(2, ws, tid_);
        bf16x8 st[8][2];
#pragma unroll
        for (int n = 0; n < 8; ++n)
#pragma unroll
            for (int s = 0; s < 2; ++s) st[n][s] = *(const bf16x8*)(STT + ((size_t)it * 128 + 16 * n + fr) * 64 + 32 * s + 8 * fq);
        const bf16* vt = VTA + ((size_t)((b * 32 + c) * 12 + h * 2)) * 4096;
        bf16x8 vfr[8];
#pragma unroll
        for (int n = 0; n < 8; ++n) { const bf16* vrow = vt + (size_t)(n >> 2) * 4096 + (16 * (n & 3) + fr) * 64 + 8 * fq; vfr[n] = *(const bf16x8*)vrow; }
#pragma unroll
        for (int mi = 0; mi < 4; ++mi) {
            const bf16x8 q0 = *(const LAS bf16x8*)(qs + (16 * mi + fr) * RS + 8 * fq), q1 = *(const LAS bf16x8*)(qs + (16 * mi + fr) * RS + 32 + 8 * fq);
            u32x2 rwv[8];
#pragma unroll
            for (int n = 0; n < 8; ++n) rwv[n] = *(const u32x2*)(HY + (tok0 + 16 * mi + fr) * HYN + C_RB + h * 128 + 16 * n + 4 * fq);
            f32x4 sc[4];
#pragma unroll
            for (int t = 0; t < 4; ++t) {
                sc[t] = (f32x4){0.f, 0.f, 0.f, 0.f};
                if (t <= mi) {
                    const bf16x8 k0 = *(const LAS bf16x8*)(ks + (16 * t + fr) * RS + 8 * fq), k1 = *(const LAS bf16x8*)(ks + (16 * t + fr) * RS + 32 + 8 * fq);
                    sc[t] = __builtin_amdgcn_mfma_f32_16x16x32_bf16(k0, q0, sc[t], 0, 0, 0);
                    sc[t] = __builtin_amdgcn_mfma_f32_16x16x32_bf16(k1, q1, sc[t], 0, 0, 0);
                    if (t == mi) {
                        sc[t].x = (4 * fq + 0 <= fr) ? sc[t].x : 0.f; sc[t].y = (4 * fq + 1 <= fr) ? sc[t].y : 0.f; sc[t].z = (4 * fq + 2 <= fr) ? sc[t].z : 0.f; sc[t].w = (4 * fq + 3 <= fr) ? sc[t].w : 0.f; }
                }
            }
            bf16x8 pf[2];
#pragma unroll
            for (int s = 0; s < 2; ++s) { u32x4 w; w.x = pk2(sc[2 * s].x, sc[2 * s].y); w.y = pk2(sc[2 * s].z, sc[2 * s].w); w.z = pk2(sc[2 * s + 1].x, sc[2 * s + 1].y); w.w = pk2(sc[2 * s + 1].z, sc[2 * s + 1].w);
                pf[s] = __builtin_bit_cast(bf16x8, w); }
            f32x4 o[8]; float ssq = 0.f;
#pragma unroll
            for (int n = 0; n < 8; ++n) {
                o[n] = (f32x4){0.f, 0.f, 0.f, 0.f};
                o[n] = __builtin_amdgcn_mfma_f32_16x16x32_bf16(st[n][0], q0, o[n], 0, 0, 0);
                o[n] = __builtin_amdgcn_mfma_f32_16x16x32_bf16(st[n][1], q1, o[n], 0, 0, 0);
                o[n] = __builtin_amdgcn_mfma_f32_16x16x32_bf16(vfr[n], pf[0], o[n], 0, 0, 0);
                if (mi >= 2) o[n] = __builtin_amdgcn_mfma_f32_16x16x32_bf16(*(const bf16x8*)(vt + (size_t)(n >> 2) * 4096 + (16 * (n & 3) + fr) * 64 + 8 * fq + 32), pf[1], o[n], 0, 0, 0);
                ssq += (o[n].x * o[n].x + o[n].y * o[n].y) + (o[n].z * o[n].z + o[n].w * o[n].w);
            }
            ssq = xadd32(xadd16(ssq));
            const float rstd = rsqrtf(ssq * (1.f / 128.f) + EPS);
            const size_t tok = tok0 + 16 * mi + fr;
#pragma unroll
            for (int n = 0; n < 8; ++n) {
                const int dv = 16 * n + 4 * fq;
                const u32x2 rw = rwv[n]; const f32x4 g = *(const LAS f32x4*)(ogl + dv);
                const float r0 = bflo(rw.x), r1 = bfhi(rw.x), r2 = bflo(rw.y), r3 = bfhi(rw.y);
                u32x2 w; w.x = pk2(o[n].x * rstd * g.x * (r0 * sigmoidf_(r0)), o[n].y * rstd * g.y * (r1 * sigmoidf_(r1)));
                w.y = pk2(o[n].z * rstd * g.z * (r2 * sigmoidf_(r2)), o[n].w * rstd * g.w * (r3 * sigmoidf_(r3)));
                *(u32x2*)(CAT + tok * 1024 + 512 + h * 128 + dv) = w;
            }
        }
        } else if (kv_post) {
            phase_knorm(A, wv_, blk * 4 + (wid - 4), 256 * 4);
            vtrans_wave(A, wv_, (LAS bf16*)(lds + 81920) + (wid - 4) * (64 * 66), blk * 4 + (wid - 4), 256 * 4);
        }
        SUBT_END(3, ws, tid_);
        LDS_WAIT();
        __syncthreads();
    }
}

__device__ __forceinline__ void phase_sgu_mix_mfma(KArgs A, int wv_, int i, LAS unsigned char* lds) {
    const int tid = opaque_tid(wv_), wid = __builtin_amdgcn_readfirstlane(tid >> 6), lane = tid & 63, fr = lane & 15, fq = lane >> 4;
    unsigned char* ws = opq(A->ws);
    const bf16* U = (const bf16*)(ws + WS_U); const bf16* V = (const bf16*)(ws + WS_V); bf16* UM = (bf16*)(ws + WS_UM);
    const bf16* WSB = (const bf16*)(ws + WS_WSB) + (size_t)i * 8 * 16384; const float* M0 = (const float*)(ws + WS_M0) + i * 8 * 128;
    constexpr int VS = 136;
    LAS bf16* vT = (LAS bf16*)lds;
    LAS float* st = (LAS float*)(lds + 256 * VS * 2);
    LAS bf16* wl = (LAS bf16*)(lds + 256 * VS * 2 + 1024);
    const float* lng = A->in[I_LNG] + i * 2048; const float* lnb = A->in[I_LNB] + i * 2048; const float* bsg = A->in[I_SGBS] + i * 8 * 128;
    for (int it = blockIdx.x; it < 256; it += gridDim.x) {
        const int gh = it & 1, n_ = (it >> 1) & 15, b = it >> 5; const size_t tok0 = (size_t)b * S + n_ * 128;
        __syncthreads();
        {
            const float* vst = (const float*)(ws + WS_VSTAT);
#pragma unroll
            for (int s4 = 0; s4 < 16; s4 += 4) {
                const int s = wid * 16 + s4 + (lane >> 4);
                const f32x4 p = *(const f32x4*)(vst + (tok0 + s) * 64 + 4 * (lane & 15));
                float sum = p.x + p.z, sq = p.y + p.w;
                sum += __shfl_xor(sum, 1); sq += __shfl_xor(sq, 1); sum += __shfl_xor(sum, 2); sq += __shfl_xor(sq, 2);
                sum += __shfl_xor(sum, 4); sq += __shfl_xor(sq, 4); sum += __shfl_xor(sum, 8); sq += __shfl_xor(sq, 8);
                const float mean = sum * (1.f / 2048.f); const float var = fmaxf(sq * (1.f / 2048.f) - mean * mean, 0.f);
                if ((lane & 15) == 0) { st[2 * s] = mean; st[2 * s + 1] = rsqrtf(var + EPS); }
            }
        }
#pragma unroll 1
        for (int gg = 0; gg < 4; ++gg) {
            const int g = gh * 4 + gg;
            __syncthreads();
            {
                const int s = tid & 127, cq = tid >> 7;
                const float mean = st[2 * s], rstd = st[2 * s + 1];
                const u32x4* src = (const u32x4*)(V + (tok0 + s) * 2048 + g * 256 + cq * 64);
                u32x4 w8[8], ww[4];
#pragma unroll
                for (int i8 = 0; i8 < 8; ++i8) w8[i8] = src[i8];
#pragma unroll
                for (int q = 0; q < 4; ++q) { const int e = tid + 512 * q; ww[q] = *(const u32x4*)(WSB + ((size_t)g * 128 + (e >> 4)) * 128 + (e & 15) * 8); }
#pragma unroll
                for (int i8 = 0; i8 < 8; ++i8) {
                    const u32x4 w = w8[i8];
                    LAS bf16* d = vT + (cq * 64 + i8 * 8) * VS + s;
                    d[0 * VS] = (bf16)f2bf((bflo(w.x) - mean) * rstd); d[1 * VS] = (bf16)f2bf((bfhi(w.x) - mean) * rstd); d[2 * VS] = (bf16)f2bf((bflo(w.y) - mean) * rstd); d[3 * VS] = (bf16)f2bf((bfhi(w.y) - mean) * rstd);
                    d[4 * VS] = (bf16)f2bf((bflo(w.z) - mean) * rstd); d[5 * VS] = (bf16)f2bf((bfhi(w.z) - mean) * rstd); d[6 * VS] = (bf16)f2bf((bflo(w.w) - mean) * rstd); d[7 * VS] = (bf16)f2bf((bfhi(w.w) - mean) * rstd);
                }
#pragma unroll
                for (int q = 0; q < 4; ++q) { const int e = tid + 512 * q; *(LAS u32x4*)(wl + (e >> 4) * VS + (e & 15) * 8) = ww[q]; }
            }
            u32x2 uw[8][2]; float m0v[8], bsv[8];
#pragma unroll
            for (int n = 0; n < 8; ++n) { const int t = 16 * n + fr; m0v[n] = M0[g * 128 + t]; bsv[n] = bsg[g * 128 + t];
                const size_t ro = (tok0 + t) * 2048 + g * 256 + 32 * wid + 4 * fq; uw[n][0] = *(const u32x2*)(U + ro); uw[n][1] = *(const u32x2*)(U + ro + 16); }
            __syncthreads();
            bf16x8 vf[2][4];
#pragma unroll
            for (int m = 0; m < 2; ++m)
#pragma unroll
                for (int k = 0; k < 4; ++k) vf[m][k] = *(const LAS bf16x8*)(vT + (32 * wid + 16 * m + fr) * VS + 32 * k + 8 * fq);
            f32x4 gc[2], bc[2];
#pragma unroll
            for (int m = 0; m < 2; ++m) { gc[m] = *(const f32x4*)(lng + g * 256 + 32 * wid + 16 * m + 4 * fq); bc[m] = *(const f32x4*)(lnb + g * 256 + 32 * wid + 16 * m + 4 * fq); }
#pragma unroll
            for (int n = 0; n < 8; ++n) {
                f32x4 a0 = (f32x4){0.f, 0.f, 0.f, 0.f}, a1 = (f32x4){0.f, 0.f, 0.f, 0.f};
#pragma unroll
                for (int k = 0; k < 4; ++k) if (k <= (n >> 1)) {
                    const bf16x8 wf = *(const LAS bf16x8*)(wl + (16 * n + fr) * VS + 32 * k + 8 * fq);
                    a0 = __builtin_amdgcn_mfma_f32_16x16x32_bf16(vf[0][k], wf, a0, 0, 0, 0);
                    a1 = __builtin_amdgcn_mfma_f32_16x16x32_bf16(vf[1][k], wf, a1, 0, 0, 0); }
                const int t = 16 * n + fr; const float m0 = m0v[n], bsv_ = bsv[n];
                const size_t ro = (tok0 + t) * 2048 + g * 256 + 32 * wid + 4 * fq;
#pragma unroll
                for (int m = 0; m < 2; ++m) {
                    const f32x4 a = m ? a1 : a0;
                    const u32x2 uw_ = uw[n][m];
                    u32x2 w; w.x = pk2((a.x * gc[m].x + bc[m].x * m0 + bsv_) * bflo(uw_.x), (a.y * gc[m].y + bc[m].y * m0 + bsv_) * bfhi(uw_.x));
                    w.y = pk2((a.z * gc[m].z + bc[m].z * m0 + bsv_) * bflo(uw_.y), (a.w * gc[m].w + bc[m].w * m0 + bsv_) * bfhi(uw_.y));
                    *(u32x2*)(UM + ro + 16 * m) = w;
                }
            }
        }
    }
    __syncthreads();
}

__device__ __forceinline__ void xattn_item(KArgs A, int wv_, int L, LAS unsigned char* lds, const int b, const int h, const int qt) {
    const int tid = opaque_tid(wv_), wid = __builtin_amdgcn_readfirstlane(tid >> 6), lane = tid & 63, fr = lane & 15, fq = lane >> 4;
    unsigned char* ws = opq(A->ws);
    const bf16* QX = (const bf16*)(ws + WS_QX); const bf16* KV = (const bf16*)(ws + WS_KV); const bf16* VT = (const bf16*)(ws + WS_VT); bf16* OX = (bf16*)(ws + WS_OX);
    constexpr int RS = 264;
    LAS bf16* kl = (LAS bf16*)lds;
    const float* qg = A->in[I_XQN] + L * 256;
    {
        __syncthreads();
        {
            const int row = tid >> 1, hf = tid & 1;
            const u32x4* src = (const u32x4*)(KV + (size_t)(b * 256 + row) * 8192 + L * 2048 + h * 256 + hf * 128);
#pragma unroll
            for (int i0 = 0; i0 < 16; i0 += 8) {
                u32x4 w[8];
#pragma unroll
                for (int i = 0; i < 8; ++i) w[i] = src[i0 + i];
#pragma unroll
                for (int i = 0; i < 8; ++i) *(LAS u32x4*)(kl + row * RS + hf * 128 + (i0 + i) * 8) = w[i];
            }
        }
        const size_t tok0 = (size_t)b * S + qt * 256 + wid * 32 + fr;
        u32x4 qw0[8], qw1[8];
#pragma unroll
        for (int s = 0; s < 8; ++s) { qw0[s] = *(const u32x4*)(QX + tok0 * 1024 + h * 256 + 32 * s + 8 * fq); qw1[s] = *(const u32x4*)(QX + (tok0 + 16) * 1024 + h * 256 + 32 * s + 8 * fq); }
        __syncthreads();
        bf16x8 pf0[8], pf1[8]; float inv0, inv1;
        auto s_part = [&](const u32x4 (&qw)[8], bf16x8 (&pf)[8], float& inv) __attribute__((always_inline)) {
            float ssq = 0.f;
#pragma unroll
            for (int s = 0; s < 8; ++s) {
                const float a0 = bflo(qw[s].x), a1 = bfhi(qw[s].x), a2 = bflo(qw[s].y), a3 = bfhi(qw[s].y), a4 = bflo(qw[s].z), a5 = bfhi(qw[s].z), a6 = bflo(qw[s].w), a7 = bfhi(qw[s].w);
                ssq += (a0 * a0 + a1 * a1) + (a2 * a2 + a3 * a3) + (a4 * a4 + a5 * a5) + (a6 * a6 + a7 * a7);
            }
            ssq = xadd32(xadd16(ssq));
            const float rstd = rsqrtf(ssq * (1.f / 256.f) + EPS);
            bf16x8 qf[8];
#pragma unroll
            for (int s = 0; s < 8; ++s) qf[s] = __builtin_bit_cast(bf16x8, qw[s]);
            f32x4 sc[16];
#pragma unroll
            for (int hf = 0; hf < 2; ++hf) {
                unsigned kb = (unsigned)(size_t)(kl + (128 * hf + fr) * RS + 8 * fq); asm volatile("" : "+v"(kb));
#pragma unroll
                for (int t8 = 0; t8 < 8; ++t8) { const int t = 8 * hf + t8; sc[t] = (f32x4){0.f, 0.f, 0.f, 0.f};
#pragma unroll
                    for (int s = 0; s < 8; ++s) { const bf16x8 kf = *(const LAS bf16x8*)(size_t)(kb + (unsigned)((16 * t8 * RS + 32 * s) * 2));
                        sc[t] = __builtin_amdgcn_mfma_f32_16x16x32_bf16(kf, qf[s], sc[t], 0, 0, 0); }
                    if (t & 1) asm volatile("" ::: "memory"); }
            }
            float mx = -INFINITY;
#pragma unroll
            for (int t = 0; t < 16; ++t) mx = fmaxf(mx, fmaxf(fmaxf(sc[t].x, sc[t].y), fmaxf(sc[t].z, sc[t].w)));
            mx = xmax32(xmax16(mx));
            float lsum = 0.f;
#pragma unroll
            for (int t = 0; t < 16; ++t) { sc[t].x = __expf((sc[t].x - mx) * rstd); sc[t].y = __expf((sc[t].y - mx) * rstd); sc[t].z = __expf((sc[t].z - mx) * rstd); sc[t].w = __expf((sc[t].w - mx) * rstd); lsum += (sc[t].x + sc[t].y) + (sc[t].z + sc[t].w); }
            lsum = xadd32(xadd16(lsum));
            inv = 1.f / lsum;
#pragma unroll
            for (int s = 0; s < 8; ++s) { u32x4 w; w.x = pk2(sc[2 * s].x, sc[2 * s].y); w.y = pk2(sc[2 * s].z, sc[2 * s].w); w.z = pk2(sc[2 * s + 1].x, sc[2 * s + 1].y); w.w = pk2(sc[2 * s + 1].z, sc[2 * s + 1].w);
                pf[s] = __builtin_bit_cast(bf16x8, w); }
        };
        s_part(qw0, pf0, inv0);
        s_part(qw1, pf1, inv1);
        __syncthreads();
        {
            const int row = tid >> 1, hf = tid & 1;
            const u32x4* src = (const u32x4*)(VT + ((size_t)((L * 8 + b) * 4 + h) * 256 + row) * 256 + hf * 128);
#pragma unroll
            for (int i0 = 0; i0 < 16; i0 += 8) {
                u32x4 w[8];
#pragma unroll
                for (int i = 0; i < 8; ++i) w[i] = src[i0 + i];
#pragma unroll
                for (int i = 0; i < 8; ++i) *(LAS u32x4*)(kl + row * RS + hf * 128 + (i0 + i) * 8) = w[i];
            }
        }
        __syncthreads();
#pragma unroll
        for (int hf = 0; hf < 2; ++hf) {
            unsigned vb = (unsigned)(size_t)(kl + (128 * hf + fr) * RS + 8 * fq); asm volatile("" : "+v"(vb));
#pragma unroll
            for (int n8 = 0; n8 < 8; ++n8) { const int n = 8 * hf + n8; f32x4 o0 = (f32x4){0.f, 0.f, 0.f, 0.f}, o1 = o0;
#pragma unroll
                for (int s = 0; s < 8; ++s) { const bf16x8 vf = *(const LAS bf16x8*)(size_t)(vb + (unsigned)((16 * n8 * RS + 32 * s) * 2));
                    o0 = __builtin_amdgcn_mfma_f32_16x16x32_bf16(vf, pf0[s], o0, 0, 0, 0);
                    o1 = __builtin_amdgcn_mfma_f32_16x16x32_bf16(vf, pf1[s], o1, 0, 0, 0); }
                u32x2 w0, w1; w0.x = pk2(o0.x * inv0, o0.y * inv0); w0.y = pk2(o0.z * inv0, o0.w * inv0); w1.x = pk2(o1.x * inv1, o1.y * inv1); w1.y = pk2(o1.z * inv1, o1.w * inv1);
                *(u32x2*)(OX + tok0 * 1024 + h * 256 + 16 * n + 4 * fq) = w0;
                *(u32x2*)(OX + (tok0 + 16) * 1024 + h * 256 + 16 * n + 4 * fq) = w1;
                if (n & 1) asm volatile("" ::: "memory"); }
        }
    }
    __syncthreads();
}

__device__ __forceinline__ void phase_route_mfma(KArgs A, int wv_, int L, LAS unsigned char* lds) {
    const int tid = opaque_tid(wv_), wid = __builtin_amdgcn_readfirstlane(tid >> 6), lane = tid & 63, fr = lane & 15, fq = lane >> 4;
    unsigned char* ws = opq(A->ws);
    const float* RW = (const float*)(ws + WS_RW) + (size_t)L * NEXP * D;
    unsigned* cnt = (unsigned*)(ws + WS_CTL) + CW_CNT + L * 64;
    int* list = (int*)(ws + WS_LIST); int* te = (int*)(ws + WS_TOK); int* tp = te + 2 * T; float* tw = (float*)(tp + 2 * T);
    bf16* XN = (bf16*)(ws + WS_XN);
    constexpr int WSTR = 1032;
    LAS bf16* rwh = (LAS bf16*)lds;
    LAS bf16* rwl = rwh + 16 * WSTR;
    LAS float* xch = (LAS float*)(lds + 2 * 16 * WSTR * 2);
    LAS unsigned* lcnt = (LAS unsigned*)(lds + 2 * 16 * WSTR * 2 + 8 * 320 * 4);
    LAS unsigned* lbase = lcnt + 16;
    for (int e4 = tid; e4 < NEXP * D / 4; e4 += 512) {
        const f32x4 w = *(const f32x4*)(RW + 4 * e4);
        u32x2 h; h.x = pk2(w.x, w.y); h.y = pk2(w.z, w.w);
        u32x2 l; l.x = pk2(w.x - bflo(h.x), w.y - bfhi(h.x)); l.y = pk2(w.z - bflo(h.y), w.w - bfhi(h.y));
        const int e = (4 * e4) >> 10, k = (4 * e4) & 1023;
        *(LAS u32x2*)(rwh + e * WSTR + k) = h; *(LAS u32x2*)(rwl + e * WSTR + k) = l;
    }
    const int tg = wid >> 1, kh = wid & 1;
    const float rbv = A->in[I_RB][fr];
    for (int blk = blockIdx.x; blk < T / 64; blk += gridDim.x) {
        __syncthreads();
        if (tid < 16) lcnt[tid] = 0u;
        const size_t tok = (size_t)blk * 64 + 16 * tg + fr;
        const float* xrow = A->out + tok * D + 512 * kh + 8 * fq;
        f32x4 acc = (f32x4){0.f, 0.f, 0.f, 0.f}; float ssq = 0.f;
        bf16x8 ah[16];
#pragma unroll
        for (int s4 = 0; s4 < 16; s4 += 4) {
            f32x4 xa[4], xb[4];
#pragma unroll
            for (int q = 0; q < 4; ++q) { xa[q] = *(const f32x4*)(xrow + 32 * (s4 + q)); xb[q] = *(const f32x4*)(xrow + 32 * (s4 + q) + 4); }
#pragma unroll
            for (int q = 0; q < 4; ++q) {
                const int s = s4 + q; const f32x4 x0 = xa[q], x1 = xb[q];
                ssq += ((x0.x * x0.x + x0.y * x0.y) + (x0.z * x0.z + x0.w * x0.w)) + ((x1.x * x1.x + x1.y * x1.y) + (x1.z * x1.z + x1.w * x1.w));
                u32x4 hw; hw.x = pk2(x0.x, x0.y); hw.y = pk2(x0.z, x0.w); hw.z = pk2(x1.x, x1.y); hw.w = pk2(x1.z, x1.w);
                u32x4 lw; lw.x = pk2(x0.x - bflo(hw.x), x0.y - bfhi(hw.x)); lw.y = pk2(x0.z - bflo(hw.y), x0.w - bfhi(hw.y)); lw.z = pk2(x1.x - bflo(hw.z), x1.y - bfhi(hw.z)); lw.w = pk2(x1.z - bflo(hw.w), x1.w - bfhi(hw.w));
                ah[s] = __builtin_bit_cast(bf16x8, hw); const bf16x8 al = __builtin_bit_cast(bf16x8, lw);
                const bf16x8 bh = *(const LAS bf16x8*)(rwh + fr * WSTR + 512 * kh + 32 * s + 8 * fq), bl = *(const LAS bf16x8*)(rwl + fr * WSTR + 512 * kh + 32 * s + 8 * fq);
                acc = __builtin_amdgcn_mfma_f32_16x16x32_bf16(ah[s], bh, acc, 0, 0, 0);
                acc = __builtin_amdgcn_mfma_f32_16x16x32_bf16(ah[s], bl, acc, 0, 0, 0);
                acc = __builtin_amdgcn_mfma_f32_16x16x32_bf16(al, bh, acc, 0, 0, 0);
            }
        }
        ssq = xadd32(xadd16(ssq));
        LAS float* mine = xch + wid * 320; const LAS float* other = xch + (wid ^ 1) * 320;
#pragma unroll
        for (int r = 0; r < 4; ++r) mine[(4 * fq + r) * 20 + fr] = acc[r];
        if (fq == 0) mine[fr * 20 + 16] = ssq;
        __syncthreads();
        const float rstd = rsqrtf((ssq + other[fr * 20 + 16]) * (1.f / 1024.f) + EPS);
        {
            bf16* xo = XN + tok * D + 512 * kh + 8 * fq;
#pragma unroll
            for (int s = 0; s < 16; ++s) { const u32x4 hw = __builtin_bit_cast(u32x4, ah[s]);
                u32x4 o; o.x = pk2(bflo(hw.x) * rstd, bfhi(hw.x) * rstd); o.y = pk2(bflo(hw.y) * rstd, bfhi(hw.y) * rstd); o.z = pk2(bflo(hw.z) * rstd, bfhi(hw.z) * rstd); o.w = pk2(bflo(hw.w) * rstd, bfhi(hw.w) * rstd);
                *(u32x4*)(xo + 32 * s) = o; }
        }
        int e0r[4], e1r[4], r0r[4], r1r[4]; float w0r[4];
        if (kh == 0) {
#pragma unroll
            for (int r = 0; r < 4; ++r) {
                const float rs = __shfl(rstd, 4 * fq + r);
                const float lg = (acc[r] + other[(4 * fq + r) * 20 + fr]) * rs + rbv;
                float v0 = lg; v0 = fmaxf(v0, __shfl_xor(v0, 1)); v0 = fmaxf(v0, __shfl_xor(v0, 2)); v0 = fmaxf(v0, __shfl_xor(v0, 4)); v0 = fmaxf(v0, __shfl_xor(v0, 8));
                const unsigned long long bm0 = __ballot(lg == v0);
                const int e0 = __ffs((unsigned)(bm0 >> (16 * fq)) & 0xffffu) - 1;
                const bool c2 = (fr >> 2) == (e0 >> 2) && fr != e0;
                const float m2 = c2 ? lg : -INFINITY;
                float v1 = m2; v1 = fmaxf(v1, __shfl_xor(v1, 1)); v1 = fmaxf(v1, __shfl_xor(v1, 2)); v1 = fmaxf(v1, __shfl_xor(v1, 4)); v1 = fmaxf(v1, __shfl_xor(v1, 8));
                const unsigned long long bm1 = __ballot(c2 && m2 == v1);
                const int e1 = __ffs((unsigned)(bm1 >> (16 * fq)) & 0xffffu) - 1;
                e0r[r] = e0; e1r[r] = e1; w0r[r] = 1.f / (1.f + __expf(v1 - v0));
                r0r[r] = 0; r1r[r] = 0;
                if (fr == 0) { r0r[r] = (int)atomicAdd((unsigned*)(lcnt + e0), 1u); r1r[r] = (int)atomicAdd((unsigned*)(lcnt + e1), 1u); }
            }
        }
        __syncthreads();
        if (tid < 16) lbase[tid] = atomicAdd(&cnt[tid], lcnt[tid]);
        __syncthreads();
        if (kh == 0 && fr == 0) {
#pragma unroll
            for (int r = 0; r < 4; ++r) {
                const int t = blk * 64 + 16 * tg + 4 * fq + r;
                const int p0 = (int)lbase[e0r[r]] + r0r[r], p1 = (int)lbase[e1r[r]] + r1r[r];
                list[e0r[r] * T + p0] = t; list[e1r[r] * T + p1] = t;
                te[2 * t] = e0r[r]; te[2 * t + 1] = e1r[r]; tp[2 * t] = p0; tp[2 * t + 1] = p1; tw[2 * t] = w0r[r]; tw[2 * t + 1] = 1.f - w0r[r];
            }
        }
    }
    __syncthreads();
}

__device__ __forceinline__ void moe_offsets(KArgs A, int wv_, int L, LAS int* off, LAS int* cn) {
    if (opaque_tid(wv_) == 0) {
        const unsigned* cnt = (const unsigned*)(opq(A->ws) + WS_CTL) + CW_CNT + L * 64;
        int o = 0;
        for (int e = 0; e < 16; ++e) { const int c = (int)__hip_atomic_load(cnt + e, __ATOMIC_RELAXED, __HIP_MEMORY_SCOPE_AGENT); off[e] = o; cn[e] = c; o += (c + 255) & ~255; }
        off[16] = o;
    }
    __syncthreads();
}
__device__ __forceinline__ void phase_moe_combine(KArgs A, int wv_, int L, LAS unsigned char* lds) {
    LAS int* off = (LAS int*)lds; LAS int* cn = off + 32;
    moe_offsets(A, wv_, L, off, cn);
    const int tid_ = opaque_tid(wv_); const int wid = __builtin_amdgcn_readfirstlane(tid_ >> 6), lane = tid_ & 63; const int gw = blockIdx.x * 8 + wid, NGW = gridDim.x * 8;
    unsigned char* ws = opq(A->ws);
    const int* te = (const int*)(ws + WS_TOK); const int* tp = te + 2 * T; const float* tw = (const float*)(tp + 2 * T);
    const bf16* Y = (const bf16*)(ws + WS_Y); bf16* XN = (bf16*)(ws + WS_XN);
    const int nq = (T - gw + NGW - 1) / NGW;
    for (int q0 = 0; q0 < nq; q0 += 8) {
        int s0m = 0, s1m = 0; float w0m = 0.f, w1m = 0.f;
        { const int qq = q0 + (lane & 7); const int t = gw + NGW * (qq < nq ? qq : nq - 1);
          s0m = off[te[2 * t]] + tp[2 * t]; s1m = off[te[2 * t + 1]] + tp[2 * t + 1]; w0m = tw[2 * t]; w1m = tw[2 * t + 1]; }
        const int nn = nq - q0 < 8 ? nq - q0 : 8;
        f32x4 v[4], vn[4]; u32x2 ya[4], yb[4], yan[4], ybn[4];
        { const int t = gw + NGW * q0; const int sl0 = __builtin_amdgcn_readlane(s0m, 0), sl1 = __builtin_amdgcn_readlane(s1m, 0);
#pragma unroll
          for (int j = 0; j < 4; ++j) { v[j] = ((const f32x4*)(A->out + (size_t)t * D) + lane)[64 * j]; ya[j] = ((const u32x2*)(Y + (size_t)sl0 * D) + lane)[64 * j]; yb[j] = ((const u32x2*)(Y + (size_t)sl1 * D) + lane)[64 * j]; } }
#pragma unroll 1
        for (int q = 0; q < nn; ++q) {
            const int t = gw + NGW * (q0 + q);
            const int qn = q + 1 < nn ? q + 1 : q;
            { const int tn = gw + NGW * (q0 + qn); const int sl0 = __builtin_amdgcn_readlane(s0m, qn), sl1 = __builtin_amdgcn_readlane(s1m, qn);
#pragma unroll
              for (int j = 0; j < 4; ++j) { vn[j] = ((const f32x4*)(A->out + (size_t)tn * D) + lane)[64 * j]; yan[j] = ((const u32x2*)(Y + (size_t)sl0 * D) + lane)[64 * j]; ybn[j] = ((const u32x2*)(Y + (size_t)sl1 * D) + lane)[64 * j]; } }
            const float w0 = __builtin_bit_cast(float, __builtin_amdgcn_readlane(__builtin_bit_cast(int, w0m), q)), w1 = __builtin_bit_cast(float, __builtin_amdgcn_readlane(__builtin_bit_cast(int, w1m), q));
            float s = 0.f;
#pragma unroll
            for (int j = 0; j < 4; ++j) {
                v[j].x += w0 * bflo(ya[j].x) + w1 * bflo(yb[j].x); v[j].y += w0 * bfhi(ya[j].x) + w1 * bfhi(yb[j].x); v[j].z += w0 * bflo(ya[j].y) + w1 * bflo(yb[j].y); v[j].w += w0 * bfhi(ya[j].y) + w1 * bfhi(yb[j].y);
                s += (v[j].x * v[j].x + v[j].y * v[j].y) + (v[j].z * v[j].z + v[j].w * v[j].w);
            }
            const float rstd = rsqrtf(wave_sum(s) * (1.f / 1024.f) + EPS);
            f32x4* xr = (f32x4*)(A->out + (size_t)t * D) + lane; u32x2* o8 = (u32x2*)(XN + (size_t)t * D) + lane;
#pragma unroll
            for (int j = 0; j < 4; ++j) { xr[64 * j] = v[j]; u32x2 w; w.x = pk2(v[j].x * rstd, v[j].y * rstd); w.y = pk2(v[j].z * rstd, v[j].w * rstd); o8[64 * j] = w; }
#pragma unroll
            for (int j = 0; j < 4; ++j) { v[j] = vn[j]; ya[j] = yan[j]; yb[j] = ybn[j]; }
        }
    }
}

constexpr int PH_PER_EVEN = 5 + 6, PH_PER_ODD = 3 + 6;
constexpr int NPHASES = 1 + 2 * (PH_PER_EVEN + PH_PER_ODD);

__global__ void __launch_bounds__(512, 2) mk_fwd(Args Araw) {
    KArgs A0 = kargs();
    extern __shared__ __attribute__((aligned(16))) unsigned char lds_raw[];
    LAS unsigned char* lds = (LAS unsigned char*)lds_raw;
    volatile LAS unsigned* misc = (volatile LAS unsigned*)(lds + LDS_MISC);
    const int tid = threadIdx.x;
    if (tid < 16) misc[tid] = 0u;
    __syncthreads();
    const int lo = A0->ph_lo, hi = A0->ph_hi;
    const int wv_ = __builtin_amdgcn_readfirstlane(threadIdx.x >> 6);
    if (hi - lo > 1) (void)xcd_barrier_post((unsigned*)(A0->ws + WS_CTL) + CW_BAR, misc);
    int ph = 0;
    unsigned long long tacc_ = 0;
#define PH_BEGIN(k) if (ph >= lo && ph < hi) { const bool tprobe_ = (PROBE_TMASK >> (k)) & 1; unsigned long long tp0_ = 0; if (PROBE_TMASK && tprobe_) tp0_ = __builtin_amdgcn_s_memrealtime(); KArgs A = kargs(); unsigned char* ws = opq(A->ws); _Pragma("unroll 1") for (int rep_ = 0; rep_ < (((PROBE_MASK >> (k)) & 1) ? PROBE_REPS : 1); ++rep_)
#define PH_END   if (ph + 1 < hi) { XcdBarrier b_; b_.bar = (unsigned*)(opq(kargs()->ws) + WS_CTL) + CW_BAR; b_.x = xb_xcc_id(); b_.st = misc; xcd_barrier(b_, opaque_tid(wv_) == 0); } if (PROBE_TMASK && tprobe_) tacc_ += __builtin_amdgcn_s_memrealtime() - tp0_; } ++ph;
    const int G = gridDim.x, cb = blockIdx.x;

    PH_BEGIN(0) phase_prologue(A, wv_, lds); PH_END
    for (int L = 0; L < DEPTH; ++L) {
        const int i = L >> 1;
        if ((L & 1) == 0) {
            PH_BEGIN(3) {
                if (L == 0) {
                    pg8::DenseOrder S; S.init(NBATCH * NMEM, 8192, D, (const bf16*)(ws + WS_WKV), G, cb);
                    pg8::EpiBf16<0> E{(bf16*)(ws + WS_KV), 8192, 32, 0, nullptr, 0};
                    pg8::gemm_phase(lds, (const bf16*)(ws + WS_MN), D, S, E, wv_);
                }
                pg8::DenseOrder S; S.init(T, HYN, D, (const bf16*)(ws + WS_WHYB) + (size_t)i * HYN * D, G, cb);
                pg8::EpiBf16<0> E{(bf16*)(ws + WS_BIG), HYN, 12, 0, nullptr, 0};
                pg8::gemm_phase(lds, (const bf16*)(ws + WS_XN), D, S, E, wv_);
            } PH_END
            PH_BEGIN(4) { const int t4_ = opaque_tid(wv_); SUBT_BEGIN(4); SUBT_END(4, ws, t4_); SUBT_BEGIN(5); phase_compress_mfma(A, wv_, i, lds); SUBT_END(5, ws, t4_); SUBT_BEGIN(6); phase_nsa_prep(A, wv_, i, lds); SUBT_END(6, ws, t4_); SUBT_BEGIN(7); phase_vtiles(A, wv_, lds); SUBT_END(7, ws, t4_); } PH_END
            PH_BEGIN(5) { phase_gla_a(A, wv_, i, lds); __syncthreads(); phase_nsa_attn_mfma(A, wv_, i, lds); } PH_END
            PH_BEGIN(6) phase_gla_c(A, wv_, i, lds, L == 0); PH_END
            PH_BEGIN(7) {
                pg8::DenseOrder S; S.init(T, D, D, (const bf16*)(ws + WS_WHOUT) + (size_t)i * D * D, G, cb);
                pg8::EpiResAddNorm E{A->out, D, (bf16*)(ws + WS_XN), (float*)(ws + WS_ROWSQ)};
                pg8::gemm_phase(lds, (const bf16*)(ws + WS_CAT), D, S, E, wv_);
            } PH_END
        } else {
            PH_BEGIN(8) {
                pg8::DenseOrder S; S.init(T, 4096, D, (const bf16*)(ws + WS_WSGIN) + (size_t)i * 4096 * D, G, cb);
                pg8::EpiBf16<1> E{(bf16*)(ws + WS_U), 2048, 8, (size_t)(WS_V - WS_U) / 2, (float*)(ws + WS_VSTAT), 8};
                pg8::gemm_phase(lds, (const bf16*)(ws + WS_XN), D, S, E, wv_);
            } PH_END
            PH_BEGIN(9) phase_sgu_mix_mfma(A, wv_, i, lds); PH_END
            PH_BEGIN(10) {
                pg8::DenseOrder S; S.init(T, D, 2048, (const bf16*)(ws + WS_WSGOUT) + (size_t)i * D * 2048, G, cb);
                pg8::EpiResAddNorm E{A->out, D, (bf16*)(ws + WS_XN), (float*)(ws + WS_ROWSQ)};
                pg8::gemm_phase(lds, (const bf16*)(ws + WS_UM), 2048, S, E, wv_);
            } PH_END
        }
        PH_BEGIN(12) {
            pg8::DenseOrder S; S.init(T, D, D, (const bf16*)(ws + WS_WQ) + (size_t)L * D * D, G, cb);
            pg8::EpiBf16RowScale E{(bf16*)(ws + WS_QX), D, (const float*)(ws + WS_ROWSQ)};
            pg8::gemm_phase(lds, (const bf16*)(ws + WS_XN), D, S, E, wv_);
            asm volatile("s_waitcnt vmcnt(0)" ::: "memory");
            __syncthreads();
            pg8::Unit u_;
#pragma unroll 1
            for (int ui_ = 0; S.next(ui_, u_); ++ui_) xattn_item(A, wv_, L, lds, u_.pm >> 3, u_.pn, u_.pm & 7);
        } PH_END
        PH_BEGIN(14) {
            pg8::DenseOrder S; S.init(T, D, D, (const bf16*)(ws + WS_WO) + (size_t)L * D * D, G, cb);
            pg8::EpiResAdd E{A->out, D};
            pg8::gemm_phase(lds, (const bf16*)(ws + WS_OX), D, S, E, wv_);
        } PH_END
        PH_BEGIN(15) phase_route_mfma(A, wv_, L, lds); PH_END
        PH_BEGIN(16) {
            LAS int* off = (LAS int*)(lds + pg8::STAGE_BYTES); LAS int* cn = off + 32;
            moe_offsets(A, wv_, L, off, cn);
            pg8::MoeOrder<true> S{(off[16] / 256) * 3, 3, G, cb, D, off, cn, (const int*)(ws + WS_LIST), (const char*)(ws + WS_WMIN) + (size_t)L * 16 * 768 * D * 2, (size_t)768 * D * 2};
            pg8::EpiSwiglu E{(bf16*)(ws + WS_H), DEXP};
            pg8::gemm_phase(lds, (const bf16*)(ws + WS_XN), D, S, E, wv_);
        } PH_END
        PH_BEGIN(17) {
            LAS int* off = (LAS int*)(lds + pg8::STAGE_BYTES); LAS int* cn = off + 32;
            moe_offsets(A, wv_, L, off, cn);
            pg8::MoeOrder<false> S{(off[16] / 256) * 4, 4, G, cb, DEXP, off, cn, (const int*)(ws + WS_LIST), (const char*)(ws + WS_WMOUT) + (size_t)L * 16 * D * DEXP * 2, (size_t)D * DEXP * 2};
            pg8::EpiBf16<0> E{(bf16*)(ws + WS_Y), D, 4, 0, nullptr, 0};
            pg8::gemm_phase(lds, (const bf16*)(ws + WS_H), DEXP, S, E, wv_);
        } PH_END
        PH_BEGIN(18) phase_moe_combine(A, wv_, L, lds); PH_END
    }
#undef PH_BEGIN
#undef PH_END
    if (hi - lo > 1) { for (int q_ = 0; q_ < PROBE_XBAR; ++q_) { XcdBarrier b_; b_.bar = (unsigned*)(opq(kargs()->ws) + WS_CTL) + CW_BAR; b_.x = xb_xcc_id(); b_.st = misc; xcd_barrier(b_, opaque_tid(wv_) == 0); } }
    if ((PROBE_NSA || PROBE_SUB) && blockIdx.x == 0) { const unsigned long long d_ = __hip_atomic_load((unsigned long long*)(A0->ws + WS_CTL + 48000), __ATOMIC_RELAXED, __HIP_MEMORY_SCOPE_AGENT); const unsigned long long t0 = __builtin_amdgcn_s_memrealtime(); while (__builtin_amdgcn_s_memrealtime() - t0 < d_) __builtin_amdgcn_s_sleep(8); }
    if (PROBE_TMASK && blockIdx.x == 0) { const unsigned long long t0 = __builtin_amdgcn_s_memrealtime(); while (__builtin_amdgcn_s_memrealtime() - t0 < tacc_) __builtin_amdgcn_s_sleep(8); }
}

extern "C" void kernel_launch(void* const* d_in, const int* in_sizes, int n_in, void* d_out, int out_size, void* d_ws, size_t ws_size, hipStream_t stream) {
    static int grid = 0;
    if (grid == 0) {
        if (n_in != N_IN || out_size != T * D || ws_size < WS_END) { fprintf(stderr, "kernel_launch: unexpected problem (n_in %d, out %d, ws %zu)\n", n_in, out_size, ws_size); grid = -1; return; }
        int dev = 0, cus = 0, per_cu = 0;
        if (hipGetDevice(&dev) != hipSuccess || hipDeviceGetAttribute(&cus, hipDeviceAttributeMultiprocessorCount, dev) != hipSuccess) { grid = -1; return; }
        if (hipFuncSetAttribute((const void*)mk_fwd, hipFuncAttributeMaxDynamicSharedMemorySize, LDS_BYTES) != hipSuccess) { fprintf(stderr, "kernel_launch: hipFuncSetAttribute failed\n"); grid = -1; return; }
        if (hipOccupancyMaxActiveBlocksPerMultiprocessor(&per_cu, (const void*)mk_fwd, 512, LDS_BYTES) != hipSuccess || per_cu < 1) fprintf(stderr, "kernel_launch: occupancy query says %d\n", per_cu);
        (void)hipGetLastError();
        grid = cus;
    }
    if (grid < 0) return;
    (void)hipMemsetAsync((char*)d_ws + WS_CTL, 0, CTL_BYTES, stream);
    Args a{};
    for (int i = 0; i < N_IN; ++i) a.in[i] = (const float*)d_in[i];
    a.out = (float*)d_out; a.ws = (unsigned char*)d_ws;
    for (int j = 0; j < 32; ++j) a.freq[j] = (float)pow(10000.0, -(double)j / 32.0);
#if MK_ONE_LAUNCH
    a.ph_lo = 0; a.ph_hi = NPHASES;
    hipLaunchKernelGGL(mk_fwd, dim3(grid), dim3(512), LDS_BYTES, stream, a);
#else
    for (int p = 0; p < NPHASES; ++p) { a.ph_lo = p; a.ph_hi = p + 1; hipLaunchKernelGGL(mk_fwd, dim3(grid), dim3(512), LDS_BYTES, stream, a); }
#endif
}
```

```cpp
#include <hip/hip_runtime.h>
#include <stdint.h>
#include <stdio.h>
#include <math.h>

#ifndef PROBE_MASK
#define PROBE_MASK 0
#endif
#ifndef PROBE_TMASK
#define PROBE_TMASK 0
#endif
#ifndef PROBE_NSA
#define PROBE_NSA 0
#endif
#ifndef PROBE_SUB
#define PROBE_SUB 0
#endif
#ifndef PROBE_XBAR
#define PROBE_XBAR 0
#endif
#ifndef PROBE_NSAX
#define PROBE_NSAX 0
#endif
#ifndef PROBE_REPS
#define PROBE_REPS 2
#endif
#ifndef MK_ONE_LAUNCH
#define MK_ONE_LAUNCH 1
#endif

#define LAS __attribute__((address_space(3)))
typedef unsigned short bf16;
typedef short bf16x8 __attribute__((ext_vector_type(8)));
typedef float f32x4 __attribute__((ext_vector_type(4)));
typedef float f32x2 __attribute__((ext_vector_type(2)));
typedef unsigned u32x4 __attribute__((ext_vector_type(4)));
typedef unsigned u32x2 __attribute__((ext_vector_type(2)));

constexpr int T = 16384, D = 1024, NBATCH = 8, S = 2048, DEPTH = 4;
constexpr int NMEM = 256;
constexpr float EPS = 1e-6f;
constexpr int HYN = 3072, HYSRC = 2856;
constexpr int C_QA = 0, C_KC = 512, C_VC = 640, C_KS = 768, C_VS = 896, C_KW = 1024, C_VW = 1152, C_QB = 1280, C_KB = 1536, C_VB = 1792, C_RB = 2304, C_GA = 2816, C_AL = 2840;
constexpr int NCMP = 127;
constexpr int NEXP = 16, DEXP = 384;
constexpr int SLOTS = 2 * T + NEXP * 256;

enum { I_X = 0, I_MEM, I_POS, I_NMIX, I_NXAT, I_NMEM, I_NFFN, I_HYBIN, I_HYBOUT, I_QNORM, I_KNORM, I_CMPPE, I_CMPW1, I_CMPW2, I_GATEB, I_WA2, I_BA, I_ONORM,
       I_SGIN, I_LNG, I_LNB, I_SGWS, I_SGBS, I_SGOUT, I_XWQ, I_XWKV, I_XWO, I_XQN, I_XKN, I_RW, I_RB, I_MOEIN, I_MOEOUT, N_IN };

constexpr size_t MiB = 1u << 20;
constexpr size_t WS_CTL = 0, CTL_BYTES = 1 * MiB;
constexpr size_t WS_WHYB = 1 * MiB;
constexpr size_t WS_WHOUT = WS_WHYB + 12 * MiB;
constexpr size_t WS_WSGIN = WS_WHOUT + 4 * MiB;
constexpr size_t WS_WSGOUT = WS_WSGIN + 16 * MiB;
constexpr size_t WS_WQ = WS_WSGOUT + 8 * MiB;
constexpr size_t WS_WKV = WS_WQ + 8 * MiB;
constexpr size_t WS_WO = WS_WKV + 16 * MiB;
constexpr size_t WS_WMIN = WS_WO + 8 * MiB;
constexpr size_t WS_WMOUT = WS_WMIN + 96 * MiB;
constexpr size_t WS_RW = WS_WMOUT + 48 * MiB;
constexpr size_t WS_XN = WS_RW + 1 * MiB;
constexpr size_t WS_BIG = WS_XN + 32 * MiB;
constexpr size_t WS_QA = WS_BIG + 128 * MiB;
constexpr size_t WS_KS = WS_QA + 16 * MiB;
constexpr size_t WS_KW = WS_KS + 4 * MiB;
constexpr size_t WS_KC = WS_KW + 4 * MiB;
constexpr size_t WS_VC = WS_KC + 1 * MiB;
constexpr size_t WS_CAT = WS_VC + 1 * MiB;
constexpr size_t WS_QX = WS_CAT + 32 * MiB;
constexpr size_t WS_OX = WS_QX + 32 * MiB;
constexpr size_t WS_MN = WS_OX + 32 * MiB;
constexpr size_t WS_KV = WS_MN + 4 * MiB;
constexpr size_t WS_COS = WS_KV + 32 * MiB;
constexpr size_t WS_SIN = WS_COS + 2 * MiB;
constexpr size_t WS_LIST = WS_SIN + 2 * MiB;
constexpr size_t WS_TOK = WS_LIST + 1 * MiB;
constexpr size_t WS_VT = WS_TOK + 1 * MiB;
constexpr size_t WS_VTA = WS_VT + 16 * MiB;
constexpr size_t WS_SLOC = WS_VTA + 32 * MiB;
constexpr size_t WS_DEC = WS_SLOC + 32 * MiB;
constexpr size_t WS_STT = WS_DEC + 1 * MiB;
constexpr size_t WS_WSB = WS_STT + 16 * MiB;
constexpr size_t WS_M0 = WS_WSB + 768 * 1024;
constexpr size_t WS_W1T = WS_WSB + 1 * MiB;
constexpr size_t WS_ROWSQ = WS_W1T + 1 * MiB;
constexpr size_t WS_VSTAT = WS_ROWSQ + 1 * MiB;
constexpr size_t WS_X16 = WS_VSTAT + 4 * MiB;
constexpr size_t WS_END = WS_X16 + 32 * MiB;
constexpr size_t WS_Y = WS_BIG, WS_H = WS_BIG + 72 * MiB, WS_U = WS_BIG, WS_V = WS_BIG + 64 * MiB, WS_UM = WS_QX;
constexpr int CW_BAR = 4096;
constexpr int CW_CNT = 8192;

constexpr int LDS_BYTES = 159744;
constexpr int LDS_MISC = LDS_BYTES - 64;

typedef __bf16 bf16x2_t __attribute__((ext_vector_type(2)));
__device__ __forceinline__ unsigned pk2(float lo, float hi) { const f32x2 v = {lo, hi}; return __builtin_bit_cast(unsigned, __builtin_convertvector(v, bf16x2_t)); }
__device__ __forceinline__ unsigned f2bf(float f) { return (unsigned)__builtin_bit_cast(unsigned short, (__bf16)f); }
__device__ __forceinline__ float bf2f(unsigned b) { return __uint_as_float(b << 16); }
__device__ __forceinline__ float bflo(unsigned w) { return __uint_as_float(w << 16); }
__device__ __forceinline__ float bfhi(unsigned w) { return __uint_as_float(w & 0xffff0000u); }
__device__ __forceinline__ void xswap16(float v, float& a, float& b) { unsigned u = __builtin_bit_cast(unsigned, v), u2 = u; asm volatile("" : "+v"(u2));
    const u32x2 r = __builtin_amdgcn_permlane16_swap(u, u2, false, false); unsigned r0 = r[0], r1 = r[1]; asm volatile("" : "+v"(r0), "+v"(r1)); a = __builtin_bit_cast(float, r0); b = __builtin_bit_cast(float, r1); }
__device__ __forceinline__ void xswap32(float v, float& a, float& b) { unsigned u = __builtin_bit_cast(unsigned, v), u2 = u; asm volatile("" : "+v"(u2));
    const u32x2 r = __builtin_amdgcn_permlane32_swap(u, u2, false, false); unsigned r0 = r[0], r1 = r[1]; asm volatile("" : "+v"(r0), "+v"(r1)); a = __builtin_bit_cast(float, r0); b = __builtin_bit_cast(float, r1); }
__device__ __forceinline__ float xadd16(float v) { float a, b; xswap16(v, a, b); return a + b; }
__device__ __forceinline__ float xadd32(float v) { float a, b; xswap32(v, a, b); return a + b; }
__device__ __forceinline__ float xmax16(float v) { float a, b; xswap16(v, a, b); return fmaxf(a, b); }
__device__ __forceinline__ float xmax32(float v) { float a, b; xswap32(v, a, b); return fmaxf(a, b); }
__device__ __forceinline__ float wave_sum(float v) {
#pragma unroll
    for (int o = 1; o < 16; o <<= 1) v += __shfl_xor(v, o);
    return xadd32(xadd16(v));
}
__device__ __forceinline__ float wave_max(float v) {
#pragma unroll
    for (int o = 1; o < 16; o <<= 1) v = fmaxf(v, __shfl_xor(v, o));
    return xmax32(xmax16(v));
}
__device__ __forceinline__ int opaque_tid(int wv) { int l; asm volatile("v_mbcnt_lo_u32_b32 %0, -1, 0\n\tv_mbcnt_hi_u32_b32 %0, -1, %0" : "=v"(l)); return wv * 64 + l; }
__device__ __forceinline__ unsigned char* opq(unsigned char* p) { asm volatile("" : "+s"(p)); return p; }
#define LDS_WAIT() asm volatile("s_waitcnt lgkmcnt(0)" ::: "memory")
__device__ __forceinline__ float gelu_tanh(float x) {
    const float u2 = x * (1.5957691216057308f + 0.07135481283f * x * x);
    return x * __builtin_amdgcn_rcpf(1.0f + __expf(-u2));
}
__device__ __forceinline__ float sigmoidf_(float x) { return __builtin_amdgcn_rcpf(1.0f + __expf(-x)); }

#define SUBT_BEGIN(id) unsigned long long subt_##id = 0; if (PROBE_SUB == (id)) subt_##id = __builtin_amdgcn_s_memrealtime();
#define SUBT_END(id, wsp, tidv) do { if (PROBE_SUB == (id) && blockIdx.x == 0 && (tidv) == 0) atomicAdd((unsigned long long*)((wsp) + WS_CTL + 48000), __builtin_amdgcn_s_memrealtime() - subt_##id); } while (0)
#define XB_TMO      128
#define XB_XCNT(j)  (256  + 64 * (j))
#define XB_XSUB(j)  (1280 + 64 * (j))
#define XB_XGEN(j)  (2304 + 64 * (j))
#define XB_TOP      3328
#define XB_TOPGEN   3392
#define XCD_BAR_WORDS 3456
#define XB_SPIN_CAP (1u << 22)

__device__ __forceinline__ unsigned xb_ld(unsigned* p)              { return __hip_atomic_load(p, __ATOMIC_RELAXED, __HIP_MEMORY_SCOPE_AGENT); }
__device__ __forceinline__ unsigned xb_add(unsigned* p, unsigned v) { return __hip_atomic_fetch_add(p, v, __ATOMIC_RELAXED, __HIP_MEMORY_SCOPE_AGENT); }
__device__ __forceinline__ unsigned xb_xcc_id() { return (unsigned)__builtin_amdgcn_s_getreg((3 << 11) | 20) & 0xFu; }
#define XB_SPIN(cond, bar) do { unsigned _sp = 0; while (cond) { __builtin_amdgcn_s_sleep(1); \
    if ((++_sp & 255u) == 0u) { if (xb_ld(&(bar)[XB_TMO])) break; if (_sp > XB_SPIN_CAP) { atomicAdd(&(bar)[XB_TMO], 1u); break; } } } } while (0)

struct XcdBarrier { unsigned* bar; unsigned x; volatile LAS unsigned* st; };
__device__ __forceinline__ unsigned* xb_opaque(unsigned* p) { unsigned long long v = (unsigned long long)p; unsigned lo = __builtin_amdgcn_readfirstlane((unsigned)v), hi = __builtin_amdgcn_readfirstlane((unsigned)(v >> 32));
    asm volatile("" : "+s"(lo), "+s"(hi)); return (unsigned*)(((unsigned long long)hi << 32) | lo); }

__device__ __forceinline__ XcdBarrier xcd_barrier_post(unsigned* bar, volatile LAS unsigned* st) {
    XcdBarrier b; b.bar = bar; b.x = xb_xcc_id(); b.st = st;
    if (threadIdx.x == 0) (void)xb_add(&bar[XB_XCNT(b.x)], 1u);
    return b;
}
__device__ __forceinline__ void xcd_barrier_complete(unsigned* bar, unsigned x, unsigned& nloc, unsigned& nx) {
    const unsigned G = gridDim.x * gridDim.y * gridDim.z;
    unsigned sum, cnt, mine, sp = 0u;
    for (;;) {
        sum = 0u; cnt = 0u; mine = 0u;
#pragma unroll
        for (unsigned j = 0; j < 16; ++j) { const unsigned c = xb_ld(&bar[XB_XCNT(j)]); sum += c; cnt += (c > 0u) ? 1u : 0u; mine = (j == x) ? c : mine; }
        if (sum == G) break;
        __builtin_amdgcn_s_sleep(1);
        if ((++sp & 255u) == 0u) { if (xb_ld(&bar[XB_TMO])) break; if (sp > XB_SPIN_CAP) { atomicAdd(&bar[XB_TMO], 1u); break; } }
    }
    nloc = mine > 0u ? mine : 1u; nx = cnt > 0u ? cnt : 1u;
}
__device__ __forceinline__ void xcd_barrier(const XcdBarrier& b, const bool is_t0) {
    asm volatile("s_waitcnt vmcnt(0)" ::: "memory");
    __syncthreads();
    if (is_t0) {
        unsigned* bar = b.bar;
        __builtin_amdgcn_s_waitcnt(0);
        unsigned nloc = b.st[0], nx = b.st[1];
        if (nloc == 0u) { xcd_barrier_complete(bar, b.x, nloc, nx); b.st[0] = nloc; b.st[1] = nx; }
        const unsigned old = xb_add(&bar[XB_XSUB(b.x)], 1u);
        const unsigned gen = old / nloc;
        if (old + 1u == (gen + 1u) * nloc) {
            __builtin_amdgcn_fence(__ATOMIC_RELEASE, "agent");
            asm volatile("s_waitcnt vmcnt(0)" ::: "memory");
            const unsigned og = xb_add(&bar[XB_TOP], 1u);
            const unsigned tg = og / nx;
            if (og + 1u == (tg + 1u) * nx) xb_add(&bar[XB_TOPGEN], 1u);
            else XB_SPIN(xb_ld(&bar[XB_TOPGEN]) == tg, bar);
            __builtin_amdgcn_fence(__ATOMIC_ACQUIRE, "agent");
            xb_add(&bar[XB_XGEN(b.x)], 1u);
            asm volatile("s_waitcnt vmcnt(0)" ::: "memory");
        } else {
            XB_SPIN(xb_ld(&bar[XB_XGEN(b.x)]) == gen, bar);
            __builtin_amdgcn_fence(__ATOMIC_ACQUIRE, "agent");
            asm volatile("s_waitcnt vmcnt(0)" ::: "memory");
        }
    }
    __syncthreads();
}

struct Args {
    const float* in[N_IN];
    float* out;
    unsigned char* ws;
    float freq[32];
    int ph_lo, ph_hi;
};

typedef const __attribute__((address_space(4))) Args* KArgs;
__device__ __forceinline__ KArgs kargs() { KArgs p = (KArgs)__builtin_amdgcn_kernarg_segment_ptr(); asm volatile("" : "+s"(p)); return p; }

__device__ __forceinline__ void st_bf16x4(bf16* p, f32x4 v) { u32x2 w; w.x = pk2(v[0], v[1]); w.y = pk2(v[2], v[3]); *(u32x2*)p = w; }


namespace pg8 {
constexpr int BM = 256, BK = 64, HALF = 128, HTB = HALF * BK * 2, STAGE_BYTES = 8 * HTB, NXCD = 8, WGM = 8;
__host__ __device__ __forceinline__ int lds_byte(int r, int c) { const int st = (r >> 4) * 2 + (c >> 5), rr = r & 15, cc = c & 31, ob = rr * 64 + cc * 2; return st * 1024 + (ob ^ (((ob >> 9) & 1) << 5)); }
__host__ __device__ __forceinline__ void stage_rc(int b, int& R, int& C) { const int st = b / 1024, sb = b % 1024, swz = sb ^ (((sb >> 9) & 1) << 5); R = (st >> 1) * 16 + swz / 64; C = (st & 1) * 32 + (swz % 64) / 2; }
__host__ __device__ __forceinline__ int perm32(int rho) { const int n = rho >> 4, i = rho & 15; return 8 * (i >> 2) + 4 * n + (i & 3); }
struct Unit { int pm, pn, e; };
struct DenseOrder {
    static constexpr bool GATHER = false;
    int nM, nN, nwg, G, c, K; const char* Bt;
    __device__ __forceinline__ void init(int M, int N, int K_, const bf16* Bt_, int G_, int c_) { nM = M / BM; nN = N / BM; nwg = nM * nN; G = G_; c = c_; K = K_; Bt = (const char*)Bt_; }
    __device__ __forceinline__ bool next(int i, Unit& u) const {
        const long L = (long)i * G + c; if (L >= nwg) return false;
        int wgid = (int)L; { const int q = nwg / NXCD, r = nwg % NXCD, xcd = wgid % NXCD, off = wgid / NXCD; wgid = (xcd < r ? xcd * (q + 1) : r * (q + 1) + (xcd - r) * q) + off; }
        const int nig = WGM * nN, gid = wgid / nig, fm = gid * WGM, gsz = (nM - fm) < WGM ? (nM - fm) : WGM;
        u.pm = fm + ((wgid % nig) % gsz); u.pn = (wgid % nig) / gsz; u.e = 0; return true;
    }
    __device__ __forceinline__ unsigned a_voff(const Unit& u, int half, int R) const { return (unsigned)((u.pm * BM + half * HALF + R) * K) * 2u; }
    __device__ __forceinline__ const char* b_tile(const Unit& u) const { return Bt + (size_t)u.pn * BM * K * 2; }
};
template <bool GATH> struct MoeOrder {
    static constexpr bool GATHER = GATH;
    int nunits, ntn, G, c, K; const LAS int* off; const LAS int* cn; const int* list; const char* Bt; size_t estride;
    __device__ __forceinline__ bool next(int i, Unit& u) const {
        const int L = i * G + c; if (L >= nunits) return false;
        u.pm = L / ntn; u.pn = L % ntn; const int s0 = u.pm * BM; int e = 0;
#pragma unroll
        for (int q = 1; q < 16; ++q) e += (s0 >= off[q]) ? 1 : 0;
        u.e = e; return true;
    }
    __device__ __forceinline__ unsigned a_voff(const Unit& u, int half, int R) const {
        const int slot = u.pm * BM + half * HALF + R;
        const int loc = slot - off[u.e]; const int tk = list[u.e * T + (loc < cn[u.e] ? loc : 0)];
        return (unsigned)(tk * K) * 2u;
    }
    __device__ __forceinline__ const char* b_tile(const Unit& u) const { return Bt + (size_t)u.e * estride + (size_t)u.pn * BM * K * 2; }
};
__device__ __forceinline__ unsigned cvt_pk_bf16(float lo, float hi) { return pk2(lo, hi); }

template <class Epi, class Sched>
__device__ __forceinline__ void gemm_phase(LAS unsigned char* lds, const bf16* Aptr, int K, const Sched& S, const Epi& E, int wv_) {
    const int tid = opaque_tid(wv_), wid = __builtin_amdgcn_readfirstlane(tid >> 6), lane = tid & 63, wr = wid >> 2, wc = wid & 3, fr = lane & 15, fq = lane >> 4;
    const int nt = K / BK;
    int Rr[2], Cc[2]; unsigned voffA[2], voffB[2];
#pragma unroll
    for (int i = 0; i < 2; ++i) { stage_rc(tid * 16 + i * 8192, Rr[i], Cc[i]); const int Rb = Epi::PERM ? ((Rr[i] & ~31) + perm32(Rr[i] & 31)) : Rr[i];
        voffA[i] = (unsigned)(Rr[i] * K + Cc[i]) * 2u; voffB[i] = (unsigned)(Rb * K + Cc[i]) * 2u; }
    const size_t kstep = (size_t)(BK * 2);
    const size_t hstep = (size_t)HALF * K * 2;
    const size_t tstep = 2 * hstep;
    const unsigned ldsw = (unsigned)wid * 1024u;
    const int aoff = lds_byte(wr * 64 + fr, fq * 8), boff = lds_byte(wc * 32 + fr, fq * 8);
    const char* const Ab = (const char*)Aptr;
#define PG8_SA(b, h) (((b) * 2 + (h)) * HTB)
#define PG8_SB(b, h) ((4 + (b) * 2 + (h)) * HTB)
#define PG8_STAGE(bufoff, gbase, voff) do { _Pragma("unroll") for (int _i = 0; _i < 2; ++_i) \
        __builtin_amdgcn_global_load_lds((const unsigned*)((const char*)(gbase) + (voff)[_i]), (LAS unsigned*)(lds + (bufoff) + ldsw + _i * 8192), 16, 0, 0); } while (0)
#define PG8_STAGE_A(bufoff, usenext, h, kofs) do { \
        if constexpr (Sched::GATHER) { const char* gb_ = Ab + (kofs); unsigned vv_[2] = {(usenext) ? vN[h][0] : vA[h][0], (usenext) ? vN[h][1] : vA[h][1]}; PG8_STAGE(bufoff, gb_, vv_); } \
        else { const char* gb_ = ((usenext) ? nA : cA) + (size_t)(h) * hstep + (kofs); PG8_STAGE(bufoff, gb_, voffA); } } while (0)
#define PG8_LDA(dst, b, h) do { _Pragma("unroll") for (int m = 0; m < 4; ++m) _Pragma("unroll") for (int k = 0; k < 2; ++k) dst[m][k] = *(const LAS bf16x8*)(lds + PG8_SA(b, h) + aoff + m * 2048 + k * 1024); } while (0)
#define PG8_LDB(dst, b, h) do { _Pragma("unroll") for (int n = 0; n < 2; ++n) _Pragma("unroll") for (int k = 0; k < 2; ++k) dst[n][k] = *(const LAS bf16x8*)(lds + PG8_SB(b, h) + boff + n * 2048 + k * 1024); } while (0)
#define PG8_MMA(ai, bj, At, Bt) do { __builtin_amdgcn_s_setprio(1); _Pragma("unroll") for (int m = 0; m < 4; ++m) _Pragma("unroll") for (int n = 0; n < 2; ++n) _Pragma("unroll") for (int k = 0; k < 2; ++k) \
        acc[ai][bj][m][n] = __builtin_amdgcn_mfma_f32_16x16x32_bf16(Bt[n][k], At[m][k], acc[ai][bj][m][n], 0, 0, 0); __builtin_amdgcn_s_setprio(0); } while (0)
#define PG8_WAIT_V(n) asm volatile("s_waitcnt vmcnt(" #n ")" ::: "memory")
#define PG8_WAIT_L(n) asm volatile("s_waitcnt lgkmcnt(" #n ")" ::: "memory")
#define PG8_BAR __builtin_amdgcn_s_barrier()
#define PG8_SCHED __builtin_amdgcn_sched_barrier(0)
    Unit cur, nxt; int ui = 0;
    if (!S.next(0, cur)) return;
    f32x4 acc[2][2][4][2];
#pragma unroll
    for (int a = 0; a < 2; ++a)
#pragma unroll
        for (int b = 0; b < 2; ++b)
#pragma unroll
            for (int m = 0; m < 4; ++m)
#pragma unroll
                for (int n = 0; n < 2; ++n) acc[a][b][m][n] = (f32x4){0.f, 0.f, 0.f, 0.f};
    bf16x8 At[4][2], B0[2][2], B1[2][2];
    unsigned vA[2][2], vN[2][2];
    const char* cA = Ab; const char* nA = Ab;
    if constexpr (Sched::GATHER) {
#pragma unroll
        for (int h = 0; h < 2; ++h)
#pragma unroll
            for (int i = 0; i < 2; ++i) { vA[h][i] = S.a_voff(cur, h, Rr[i]) + (unsigned)Cc[i] * 2u; vN[h][i] = vA[h][i]; }
    } else { cA = Ab + (size_t)cur.pm * tstep; nA = cA; }
    const char* cB = S.b_tile(cur);
    PG8_STAGE(PG8_SB(0, 0), cB, voffB); PG8_STAGE_A(PG8_SA(0, 0), false, 0, 0); PG8_STAGE(PG8_SB(0, 1), cB + hstep, voffB); PG8_STAGE_A(PG8_SA(0, 1), false, 1, 0);
    if (wr == 1) PG8_BAR;
    PG8_WAIT_V(4); PG8_BAR;
    PG8_STAGE(PG8_SB(1, 0), cB + kstep, voffB); PG8_STAGE_A(PG8_SA(1, 0), false, 0, kstep); PG8_STAGE(PG8_SB(1, 1), cB + hstep + kstep, voffB);
    PG8_WAIT_V(6); PG8_BAR;
    for (;;) {
        const bool has_next = S.next(ui + 1, nxt);
        const char* nB = has_next ? S.b_tile(nxt) : cB;
        if constexpr (Sched::GATHER) {
#pragma unroll
            for (int h = 0; h < 2; ++h)
#pragma unroll
                for (int i = 0; i < 2; ++i) vN[h][i] = has_next ? S.a_voff(nxt, h, Rr[i]) + (unsigned)Cc[i] * 2u : vA[h][i];
        } else nA = has_next ? Ab + (size_t)nxt.pm * tstep : cA;
        for (int t = 0; t < nt; t += 2) {
            const bool last = (t == nt - 2);
            const size_t k1 = (size_t)(t + 1) * kstep, k2 = last ? 0 : (size_t)(t + 2) * kstep, k3 = k2 + kstep;
            const char* b2 = last ? nB : cB + (size_t)(t + 2) * kstep; const char* b3 = b2 + kstep;
            PG8_LDB(B0, 0, 0); PG8_SCHED; PG8_LDA(At, 0, 0); PG8_STAGE_A(PG8_SA(1, 1), false, 1, k1);
            PG8_WAIT_L(8); PG8_BAR; PG8_WAIT_L(0); PG8_MMA(0, 0, At, B0); PG8_BAR; PG8_SCHED;
            PG8_LDB(B1, 0, 1); PG8_STAGE(PG8_SB(0, 0), b2, voffB);
            PG8_BAR; PG8_WAIT_L(0); PG8_MMA(0, 1, At, B1); PG8_BAR;
            PG8_LDA(At, 0, 1); PG8_STAGE_A(PG8_SA(0, 0), last, 0, k2);
            PG8_BAR; PG8_WAIT_L(0); PG8_MMA(1, 0, At, B0); PG8_BAR; PG8_SCHED;
            PG8_STAGE(PG8_SB(0, 1), b2 + hstep, voffB);
            PG8_WAIT_V(6); PG8_BAR; PG8_MMA(1, 1, At, B1); PG8_BAR;
            PG8_LDB(B0, 1, 0); PG8_SCHED; PG8_LDA(At, 1, 0); PG8_STAGE_A(PG8_SA(0, 1), last, 1, k2);
            PG8_WAIT_L(8); PG8_BAR; PG8_WAIT_L(0); PG8_MMA(0, 0, At, B0); PG8_BAR; PG8_SCHED;
            PG8_LDB(B1, 1, 1); PG8_STAGE(PG8_SB(1, 0), b3, voffB);
            PG8_BAR; PG8_WAIT_L(0); PG8_MMA(0, 1, At, B1); PG8_BAR;
            PG8_LDA(At, 1, 1); PG8_STAGE_A(PG8_SA(1, 0), last, 0, k3);
            PG8_BAR; PG8_WAIT_L(0); PG8_MMA(1, 0, At, B0); PG8_BAR; PG8_SCHED;
            PG8_STAGE(PG8_SB(1, 1), b3 + hstep, voffB);
            PG8_WAIT_V(6); PG8_BAR; PG8_MMA(1, 1, At, B1); PG8_BAR;
        }
        E(acc, cur, wr, wc, fr, fq);
        if (!has_next) break;
#pragma unroll
        for (int a = 0; a < 2; ++a)
#pragma unroll
            for (int b = 0; b < 2; ++b)
#pragma unroll
                for (int m = 0; m < 4; ++m)
#pragma unroll
                    for (int n = 0; n < 2; ++n) acc[a][b][m][n] = (f32x4){0.f, 0.f, 0.f, 0.f};
        cur = nxt; cB = nB; cA = nA; ++ui;
        if constexpr (Sched::GATHER) {
#pragma unroll
            for (int h = 0; h < 2; ++h)
#pragma unroll
                for (int i = 0; i < 2; ++i) vA[h][i] = vN[h][i];
        }
    }
    PG8_WAIT_V(0);
    if (wr == 0) PG8_BAR;
    PG8_BAR;
#undef PG8_SA
#undef PG8_SB
#undef PG8_STAGE
#undef PG8_STAGE_A
#undef PG8_LDA
#undef PG8_LDB
#undef PG8_MMA
#undef PG8_WAIT_V
#undef PG8_WAIT_L
#undef PG8_BAR
#undef PG8_SCHED
}
template <int ACT> struct EpiBf16 {
    static constexpr bool PERM = true;
    bf16* O; int ldc; int tpt; size_t tstride; float* stats; int stat_pn0;
    __device__ __forceinline__ void operator()(const f32x4 (&acc)[2][2][4][2], const Unit& u, int wr, int wc, int fr, int fq) const {
        const int row0 = u.pm * BM + wr * 64 + fr; const int tt = u.pn / tpt; bf16* base = O + (size_t)tt * tstride; const int col0 = (u.pn - tt * tpt) * BM + wc * 32 + 8 * fq;
#pragma unroll
        for (int ai = 0; ai < 2; ++ai)
#pragma unroll
            for (int m = 0; m < 4; ++m) { bf16* rowp = base + (size_t)(row0 + ai * HALF + m * 16) * ldc + col0; float psum = 0.f, psq = 0.f;
#pragma unroll
                for (int bj = 0; bj < 2; ++bj) { f32x4 v0 = acc[ai][bj][m][0], v1 = acc[ai][bj][m][1];
                    if (ACT == 1) {
#pragma unroll
                        for (int q = 0; q < 4; ++q) { v0[q] = gelu_tanh(v0[q]); v1[q] = gelu_tanh(v1[q]); } }
                    if (ACT == 1) { psum += ((v0[0] + v0[1]) + (v0[2] + v0[3])) + ((v1[0] + v1[1]) + (v1[2] + v1[3]));
                        psq += ((v0[0] * v0[0] + v0[1] * v0[1]) + (v0[2] * v0[2] + v0[3] * v0[3])) + ((v1[0] * v1[0] + v1[1] * v1[1]) + (v1[2] * v1[2] + v1[3] * v1[3])); }
                    u32x4 w; w.x = cvt_pk_bf16(v0[0], v0[1]); w.y = cvt_pk_bf16(v0[2], v0[3]); w.z = cvt_pk_bf16(v1[0], v1[1]); w.w = cvt_pk_bf16(v1[2], v1[3]);
                    *(u32x4*)(rowp + bj * HALF) = w; }
                if (ACT == 1 && stats && u.pn >= stat_pn0) {
                    psum = xadd32(xadd16(psum)); psq = xadd32(xadd16(psq));
                    if (fq == 0) { f32x2 st2 = {psum, psq}; *(f32x2*)(stats + ((size_t)(row0 + ai * HALF + m * 16) * 32 + (u.pn - stat_pn0) * 4 + wc) * 2) = st2; } } }
    }
};
struct EpiResAdd {
    static constexpr bool PERM = false;
    bf16* X; int ldc;
    __device__ __forceinline__ void operator()(const f32x4 (&acc)[2][2][4][2], const Unit& u, int wr, int wc, int fr, int fq) const {
        const int row0 = u.pm * BM + wr * 64 + fr, col0 = u.pn * BM + wc * 32 + 4 * fq;
#pragma unroll
        for (int ai = 0; ai < 2; ++ai) {
            u32x2 x[4][2][2];
#pragma unroll
            for (int m = 0; m < 4; ++m)
#pragma unroll
                for (int bj = 0; bj < 2; ++bj)
#pragma unroll
                    for (int n = 0; n < 2; ++n) x[m][bj][n] = *(const u32x2*)(X + (size_t)(row0 + ai * HALF + m * 16) * ldc + col0 + bj * HALF + n * 16);
#pragma unroll
            for (int m = 0; m < 4; ++m)
#pragma unroll
                for (int bj = 0; bj < 2; ++bj)
#pragma unroll
                    for (int n = 0; n < 2; ++n) { const f32x4 a = acc[ai][bj][m][n]; const u32x2 xv = x[m][bj][n];
                        u32x2 w; w.x = pk2(bflo(xv.x) + a.x, bfhi(xv.x) + a.y); w.y = pk2(bflo(xv.y) + a.z, bfhi(xv.y) + a.w);
                        *(u32x2*)(X + (size_t)(row0 + ai * HALF + m * 16) * ldc + col0 + bj * HALF + n * 16) = w; }
        }
    }
};
struct EpiResAddNorm {
    static constexpr bool PERM = false;
    bf16* X; int ldc; float* rowsq;
    __device__ __forceinline__ void operator()(const f32x4 (&acc)[2][2][4][2], const Unit& u, int wr, int wc, int fr, int fq) const {
        const int row0 = u.pm * BM + wr * 64 + fr, col0 = u.pn * BM + wc * 32 + 4 * fq;
#pragma unroll
        for (int ai = 0; ai < 2; ++ai) {
            u32x2 x[4][2][2];
#pragma unroll
            for (int m = 0; m < 4; ++m)
#pragma unroll
                for (int bj = 0; bj < 2; ++bj)
#pragma unroll
                    for (int n = 0; n < 2; ++n) x[m][bj][n] = *(const u32x2*)(X + (size_t)(row0 + ai * HALF + m * 16) * ldc + col0 + bj * HALF + n * 16);
#pragma unroll
            for (int m = 0; m < 4; ++m) {
                const size_t ro = (size_t)(row0 + ai * HALF + m * 16) * ldc + col0; float ssq = 0.f;
#pragma unroll
                for (int bj = 0; bj < 2; ++bj)
#pragma unroll
                    for (int n = 0; n < 2; ++n) { const f32x4 a = acc[ai][bj][m][n]; const u32x2 xv = x[m][bj][n];
                        u32x2 w; w.x = pk2(bflo(xv.x) + a.x, bfhi(xv.x) + a.y); w.y = pk2(bflo(xv.y) + a.z, bfhi(xv.y) + a.w);
                        *(u32x2*)(X + ro + bj * HALF + n * 16) = w;
                        const float v0 = bflo(w.x), v1 = bfhi(w.x), v2 = bflo(w.y), v3 = bfhi(w.y);
                        ssq += (v0 * v0 + v1 * v1) + (v2 * v2 + v3 * v3); }
                ssq = xadd32(xadd16(ssq));
                if (fq == 0) rowsq[(size_t)(row0 + ai * HALF + m * 16) * 16 + u.pn * 4 + wc] = ssq;
            }
        }
    }
};
struct EpiBf16RowScale {
    static constexpr bool PERM = true;
    bf16* O; int ldc; const float* rowsq;
    __device__ __forceinline__ void operator()(const f32x4 (&acc)[2][2][4][2], const Unit& u, int wr, int wc, int fr, int fq) const {
        const int row0 = u.pm * BM + wr * 64 + fr, col0 = u.pn * BM + wc * 32 + 8 * fq;
#pragma unroll
        for (int ai = 0; ai < 2; ++ai) {
            float rs[4];
#pragma unroll
            for (int m = 0; m < 4; ++m) { const f32x4* p = (const f32x4*)(rowsq + (size_t)(row0 + ai * HALF + m * 16) * 16); const f32x4 a = p[0], b = p[1], c = p[2], d = p[3];
                rs[m] = rsqrtf((((a.x + a.y) + (a.z + a.w)) + ((b.x + b.y) + (b.z + b.w)) + (((c.x + c.y) + (c.z + c.w)) + ((d.x + d.y) + (d.z + d.w)))) * (1.f / 1024.f) + EPS); }
#pragma unroll
            for (int m = 0; m < 4; ++m) { bf16* rowp = O + (size_t)(row0 + ai * HALF + m * 16) * ldc + col0;
#pragma unroll
                for (int bj = 0; bj < 2; ++bj) { const f32x4 v0 = acc[ai][bj][m][0] * rs[m], v1 = acc[ai][bj][m][1] * rs[m];
                    u32x4 w; w.x = cvt_pk_bf16(v0[0], v0[1]); w.y = cvt_pk_bf16(v0[2], v0[3]); w.z = cvt_pk_bf16(v1[0], v1[1]); w.w = cvt_pk_bf16(v1[2], v1[3]);
                    *(u32x4*)(rowp + bj * HALF) = w; } }
        }
    }
};
struct EpiSwiglu {
    static constexpr bool PERM = true;
    bf16* H; int ldc;
    __device__ __forceinline__ void operator()(const f32x4 (&acc)[2][2][4][2], const Unit& u, int wr, int wc, int fr, int fq) const {
        const int row0 = u.pm * BM + wr * 64 + fr, col0 = u.pn * HALF + wc * 32 + 8 * fq;
#pragma unroll
        for (int ai = 0; ai < 2; ++ai)
#pragma unroll
            for (int m = 0; m < 4; ++m) {
                float o[8];
#pragma unroll
                for (int n = 0; n < 2; ++n)
#pragma unroll
                    for (int q = 0; q < 4; ++q) { const float g = acc[ai][0][m][n][q]; o[4 * n + q] = g * sigmoidf_(g) * acc[ai][1][m][n][q]; }
                u32x4 w; w.x = cvt_pk_bf16(o[0], o[1]); w.y = cvt_pk_bf16(o[2], o[3]); w.z = cvt_pk_bf16(o[4], o[5]); w.w = cvt_pk_bf16(o[6], o[7]);
                *(u32x4*)(H + (size_t)(row0 + ai * HALF + m * 16) * ldc + col0) = w; }
    }
};
}

__device__ __forceinline__ int hyb_colmap(int n) {
    if (n < 1280) return n;
    if (n < 1536) return 1304 + (n - 1280);
    if (n < 1792) return 1560 + (n - 1536);
    if (n < 2304) return 1816 + (n - 1792);
    if (n < 2816) return 2344 + (n - 2304);
    if (n < 2840) return 1280 + (n - 2816);
    if (n < 2856) return 2328 + (n - 2840);
    return -1;
}
__device__ __forceinline__ void tr_item(const float* __restrict__ W, int Nsrc, int K, bf16* __restrict__ Wt, const float* __restrict__ gain, int kind, int nblk, LAS float* scr, int item, int lane) {
    const int kb = item / nblk, nb = item % nblk, k0 = 64 * kb, n0 = 64 * nb;
    const int ksub = lane >> 4, n4 = lane & 15, n = n0 + 4 * n4;
    int col;
    if (kind == 0) col = n; else if (kind == 1) col = hyb_colmap(n); else { const int pn = n >> 8, r = n & 255; col = (r >> 7) * 384 + pn * 128 + (r & 127); }
    f32x4 v[16];
#pragma unroll
    for (int i = 0; i < 16; ++i) v[i] = col >= 0 ? *(const f32x4*)(W + (size_t)(k0 + 4 * i + ksub) * Nsrc + col) : (f32x4){0.f, 0.f, 0.f, 0.f};
    if (gain) {
#pragma unroll
        for (int i = 0; i < 16; ++i) v[i] = v[i] * gain[k0 + 4 * i + ksub];
    }
#pragma unroll
    for (int i = 0; i < 16; ++i) { LAS float* d = scr + (4 * i + ksub) * 65 + 4 * n4; d[0] = v[i].x; d[1] = v[i].y; d[2] = v[i].z; d[3] = v[i].w; }
    LDS_WAIT();
    const int c = lane & 7;
#pragma unroll
    for (int jx = 0; jx < 8; ++jx) {
        const int nn = (lane >> 3) + 8 * jx; const LAS float* s = scr + (8 * c) * 65 + nn;
        u32x4 o; o.x = pk2(s[0 * 65], s[1 * 65]); o.y = pk2(s[2 * 65], s[3 * 65]); o.z = pk2(s[4 * 65], s[5 * 65]); o.w = pk2(s[6 * 65], s[7 * 65]);
        *(u32x4*)(Wt + (size_t)(n0 + nn) * K + k0 + 8 * c) = o;
    }
    LDS_WAIT();
}
__device__ __forceinline__ void rms_row_to_bf16(const float* __restrict__ xrow, bf16* __restrict__ orow, bf16* __restrict__ copy, int lane) {
    const f32x4* xr = (const f32x4*)xrow + lane;
    f32x4 v[4]; float s = 0.f;
#pragma unroll
    for (int j = 0; j < 4; ++j) { v[j] = xr[64 * j]; s += (v[j].x * v[j].x + v[j].y * v[j].y) + (v[j].z * v[j].z + v[j].w * v[j].w); }
    const float rstd = rsqrtf(wave_sum(s) * (1.f / 1024.f) + EPS);
    u32x2* o8 = (u32x2*)orow + lane;
#pragma unroll
    for (int j = 0; j < 4; ++j) { u32x2 w; w.x = pk2(v[j].x * rstd, v[j].y * rstd); w.y = pk2(v[j].z * rstd, v[j].w * rstd); o8[64 * j] = w; }
    if (copy) { u32x2* c4 = (u32x2*)copy + lane;
#pragma unroll
        for (int j = 0; j < 4; ++j) { u32x2 w; w.x = pk2(v[j].x, v[j].y); w.y = pk2(v[j].z, v[j].w); c4[64 * j] = w; } }
}

__device__ __forceinline__ void phase_prologue(KArgs A, int wv_, LAS unsigned char* lds) {
    const int tid = opaque_tid(wv_), wid = __builtin_amdgcn_readfirstlane(tid >> 6), lane = tid & 63;
    const int gw = blockIdx.x * 8 + wid, NGW = gridDim.x * 8;
    LAS float* scr = (LAS float*)(lds + wid * 16640);
    unsigned char* ws = opq(A->ws);
    constexpr int N_HYB = 2 * 768, N_HOUT = 2 * 256, N_SGIN = 2 * 1024, N_SGOUT = 2 * 512, N_WQ = 4 * 256, N_WKV = 4 * 512, N_WO = 4 * 256, N_MIN = 64 * 192, N_MOUT = 64 * 96, N_W1T = 4 * 32;
    constexpr int NITEMS = N_HYB + N_HOUT + N_SGIN + N_SGOUT + N_WQ + N_WKV + N_WO + N_MIN + N_MOUT + N_W1T;
    for (int it = gw; it < NITEMS; it += NGW) {
        int r = it;
        if (r < N_HYB) { const int sl = r / 768; tr_item(A->in[I_HYBIN] + (size_t)sl * 1024 * HYSRC, HYSRC, 1024, (bf16*)(ws + WS_WHYB) + (size_t)sl * HYN * 1024, A->in[I_NMIX] + (2 * sl) * 1024, 1, 48, scr, r % 768, lane); continue; } r -= N_HYB;
        if (r < N_HOUT) { const int sl = r / 256; tr_item(A->in[I_HYBOUT] + (size_t)sl * 1024 * 1024, 1024, 1024, (bf16*)(ws + WS_WHOUT) + (size_t)sl * 1024 * 1024, nullptr, 0, 16, scr, r % 256, lane); continue; } r -= N_HOUT;
        if (r < N_SGIN) { const int sl = r / 1024; tr_item(A->in[I_SGIN] + (size_t)sl * 1024 * 4096, 4096, 1024, (bf16*)(ws + WS_WSGIN) + (size_t)sl * 4096 * 1024, A->in[I_NMIX] + (2 * sl + 1) * 1024, 0, 64, scr, r % 1024, lane); continue; } r -= N_SGIN;
        if (r < N_SGOUT) { const int sl = r / 512; tr_item(A->in[I_SGOUT] + (size_t)sl * 2048 * 1024, 1024, 2048, (bf16*)(ws + WS_WSGOUT) + (size_t)sl * 1024 * 2048, nullptr, 0, 16, scr, r % 512, lane); continue; } r -= N_SGOUT;
        if (r < N_WQ) { const int sl = r / 256; tr_item(A->in[I_XWQ] + (size_t)sl * 1024 * 1024, 1024, 1024, (bf16*)(ws + WS_WQ) + (size_t)sl * 1024 * 1024, A->in[I_NXAT] + sl * 1024, 0, 16, scr, r % 256, lane); continue; } r -= N_WQ;
        if (r < N_WKV) { const int sl = r / 512; tr_item(A->in[I_XWKV] + (size_t)sl * 1024 * 2048, 2048, 1024, (bf16*)(ws + WS_WKV) + (size_t)sl * 2048 * 1024, A->in[I_NMEM] + sl * 1024, 0, 32, scr, r % 512, lane); continue; } r -= N_WKV;
        if (r < N_WO) { const int sl = r / 256; tr_item(A->in[I_XWO] + (size_t)sl * 1024 * 1024, 1024, 1024, (bf16*)(ws + WS_WO) + (size_t)sl * 1024 * 1024, nullptr, 0, 16, scr, r % 256, lane); continue; } r -= N_WO;
        if (r < N_MIN) { const int sl = r / 192; tr_item(A->in[I_MOEIN] + (size_t)sl * 1024 * 768, 768, 1024, (bf16*)(ws + WS_WMIN) + (size_t)sl * 768 * 1024, A->in[I_NFFN] + (sl >> 4) * 1024, 2, 12, scr, r % 192, lane); continue; } r -= N_MIN;
        if (r < N_MOUT) { const int sl = r / 96; tr_item(A->in[I_MOEOUT] + (size_t)sl * 384 * 1024, 1024, 384, (bf16*)(ws + WS_WMOUT) + (size_t)sl * 1024 * 384, nullptr, 0, 16, scr, r % 96, lane); continue; } r -= N_MOUT;
        { const int sl = r / 32; tr_item(A->in[I_CMPW1] + (size_t)sl * 2048 * 64, 64, 2048, (bf16*)(ws + WS_W1T) + (size_t)sl * 64 * 2048, nullptr, 0, 1, scr, r % 32, lane); }
    }
    for (int m = gw; m < T; m += NGW) rms_row_to_bf16(A->in[I_X] + (size_t)m * D, (bf16*)(ws + WS_XN) + (size_t)m * D, (bf16*)(ws + WS_X16) + (size_t)m * D, lane);
    for (int m = gw; m < NBATCH * NMEM; m += NGW) rms_row_to_bf16(A->in[I_MEM] + (size_t)m * D, (bf16*)(ws + WS_MN) + (size_t)m * D, nullptr, lane);
    const int gt = blockIdx.x * 512 + tid, NGT = gridDim.x * 512;
    const int* pos = (const int*)A->in[I_POS];
    float* cosT = (float*)(ws + WS_COS); float* sinT = (float*)(ws + WS_SIN);
    for (int i = gt; i < T * 32; i += NGT) {
        const int t = i >> 5, j = i & 31;
        const float ang = (float)pos[t] * A->freq[j];
        const double rev = (double)ang * 0.15915494309189533577;
        const float fr = (float)(rev - rint(rev));
        cosT[i] = __builtin_amdgcn_cosf(fr); sinT[i] = __builtin_amdgcn_sinf(fr);
    }
    { bf16* WSB = (bf16*)(ws + WS_WSB); float* M0 = (float*)(ws + WS_M0); const float* wsg = A->in[I_SGWS];
      for (int e = gt; e < 2 * 8 * 128 * 128; e += NGT) { const int s = e & 127, t = (e >> 7) & 127; WSB[e] = (bf16)f2bf(s <= t ? wsg[e] : 0.f); }
      for (int e = gt; e < 2 * 8 * 128; e += NGT) { const int t = e & 127; const float* r = wsg + (size_t)e * 128; float a = 0.f; for (int s = 0; s <= t; ++s) a += r[s]; M0[e] = a; } }
    float* RW = (float*)(ws + WS_RW);
    for (int i = gt; i < DEPTH * NEXP * D; i += NGT) { const int k = i & 1023, e = (i >> 10) & 15, l = i >> 14; RW[i] = A->in[I_RW][k * NEXP + e] * A->in[I_NFFN][l * D + k]; }
}

__device__ __forceinline__ void phase_knorm(KArgs A, int wv_, const int gw, const int NGW) {
    const int tid_ = opaque_tid(wv_); const int lane = tid_ & 63;
    bf16* KV = (bf16*)(opq(A->ws) + WS_KV);
    for (int it0 = gw * 4; it0 < DEPTH * 2048 * 4; it0 += NGW * 4) {
        u32x2 w[4];
#pragma unroll
        for (int q = 0; q < 4; ++q) { const int it = it0 + q; const int h = it & 3, m = (it >> 2) & 2047, l = it >> 13; w[q] = *(const u32x2*)(KV + (size_t)m * 8192 + l * 2048 + h * 256 + 4 * lane); }
#pragma unroll
        for (int q = 0; q < 4; ++q) {
            const int it = it0 + q; const int h = it & 3, m = (it >> 2) & 2047, l = it >> 13;
            const float x0 = bflo(w[q].x), x1 = bfhi(w[q].x), x2 = bflo(w[q].y), x3 = bfhi(w[q].y);
            const float rstd = rsqrtf(wave_sum(x0 * x0 + x1 * x1 + x2 * x2 + x3 * x3) * (1.f / 256.f) + EPS) * 0.0625f;
            const f32x4 g = *(const f32x4*)(A->in[I_XKN] + l * 256 + 4 * lane) * *(const f32x4*)(A->in[I_XQN] + l * 256 + 4 * lane);
            u32x2 o; o.x = pk2(x0 * rstd * g.x, x1 * rstd * g.y); o.y = pk2(x2 * rstd * g.z, x3 * rstd * g.w);
            *(u32x2*)(KV + (size_t)m * 8192 + l * 2048 + h * 256 + 4 * lane) = o;
        }
    }
}

__device__ __forceinline__ int kpos64(int tok) { const int k = tok & 31; return (tok & 32) + 8 * ((k >> 2) & 3) + 4 * (k >> 4) + (k & 3); }
__device__ __forceinline__ int kperm64(int p) { const int fq = (p >> 3) & 3, j = p & 7; return (p & 32) + 16 * (j >> 2) + 4 * fq + (j & 3); }

__device__ __forceinline__ void phase_nsa_prep(KArgs A, int wv_, int i, LAS unsigned char* lds) {
    const int tid_ = opaque_tid(wv_); const int wid = __builtin_amdgcn_readfirstlane(tid_ >> 6), lane = tid_ & 63; const int gw = blockIdx.x * 8 + wid, NGW = gridDim.x * 8;
    unsigned char* ws = opq(A->ws);
    const bf16* HY = (const bf16*)(ws + WS_BIG);
    const float* cosT = (const float*)(ws + WS_COS); const float* sinT = (const float*)(ws + WS_SIN);
    bf16* QA = (bf16*)(ws + WS_QA); bf16* KS = (bf16*)(ws + WS_KS); bf16* KW = (bf16*)(ws + WS_KW);
    (void)lds;
    const int j8 = lane & 7, ug = lane >> 3;
    const int u1 = 8 + (ug & 3);
    const int src0 = C_QA + 64 * ug, src1 = u1 < 10 ? C_KS + 64 * (u1 - 8) : C_KW + 64 * (u1 - 10);
    const float* g0p = A->in[I_QNORM] + i * 64 + 8 * j8; const float* g1p = A->in[I_KNORM] + (i * 3 + (u1 < 10 ? 1 : 2)) * 64 + 8 * j8;
    const f32x4 g0a = *(const f32x4*)g0p, g0b = *(const f32x4*)(g0p + 4), g1a = *(const f32x4*)g1p, g1b = *(const f32x4*)(g1p + 4);
    u32x4 w0 = (u32x4){0u, 0u, 0u, 0u}, w1 = w0; f32x4 ca, cb, sa, sb;
    if (gw < T) { w0 = *(const u32x4*)(HY + (size_t)gw * HYN + src0 + 8 * j8); w1 = *(const u32x4*)(HY + (size_t)gw * HYN + src1 + 8 * j8);
        const float* cp = cosT + gw * 32 + 8 * (j8 & 3); const float* sp = sinT + gw * 32 + 8 * (j8 & 3); ca = *(const f32x4*)cp; cb = *(const f32x4*)(cp + 4); sa = *(const f32x4*)sp; sb = *(const f32x4*)(sp + 4); }
    for (int t = gw; t < T; t += NGW) {
        const int tn = t + NGW < T ? t + NGW : t;
        const u32x4 n0 = *(const u32x4*)(HY + (size_t)tn * HYN + src0 + 8 * j8), n1 = *(const u32x4*)(HY + (size_t)tn * HYN + src1 + 8 * j8);
        const float* cp = cosT + tn * 32 + 8 * (j8 & 3); const float* sp = sinT + tn * 32 + 8 * (j8 & 3);
        const f32x4 nca = *(const f32x4*)cp, ncb = *(const f32x4*)(cp + 4), nsa = *(const f32x4*)sp, nsb = *(const f32x4*)(sp + 4);
#pragma unroll
        for (int pass = 0; pass < 2; ++pass) {
            const u32x4 w = pass ? w1 : w0; const f32x4 ga = pass ? g1a : g0a, gb = pass ? g1b : g0b;
            float x[8] = {bflo(w.x), bfhi(w.x), bflo(w.y), bfhi(w.y), bflo(w.z), bfhi(w.z), bflo(w.w), bfhi(w.w)};
            float ssq = 0.f;
#pragma unroll
            for (int q = 0; q < 8; ++q) ssq += x[q] * x[q];
            ssq += __shfl_xor(ssq, 1); ssq += __shfl_xor(ssq, 2); ssq += __shfl_xor(ssq, 4);
            const float rs = rsqrtf(ssq * (1.f / 64.f) + EPS) * (pass ? 1.f : 0.125f * 1.4426950408889634f);
            const float gg[8] = {ga.x, ga.y, ga.z, ga.w, gb.x, gb.y, gb.z, gb.w}, cc[8] = {ca.x, ca.y, ca.z, ca.w, cb.x, cb.y, cb.z, cb.w}, ss[8] = {sa.x, sa.y, sa.z, sa.w, sb.x, sb.y, sb.z, sb.w};
            float o[8];
#pragma unroll
            for (int q = 0; q < 8; ++q) { const float y = x[q] * rs * gg[q]; const float pr = __shfl_xor(y, 4);
                o[q] = j8 < 4 ? y * cc[q] - pr * ss[q] : y * cc[q] + pr * ss[q]; }
            u32x4 ow; ow.x = pk2(o[0], o[1]); ow.y = pk2(o[2], o[3]); ow.z = pk2(o[4], o[5]); ow.w = pk2(o[6], o[7]);
            if (pass == 0) *(u32x4*)(QA + (size_t)t * 512 + 64 * ug + 8 * j8) = ow;
            else if (lane < 32) { bf16* dst = (u1 < 10 ? KS + (size_t)t * 128 + 64 * (u1 - 8) : KW + (size_t)t * 128 + 64 * (u1 - 10)); *(u32x4*)(dst + 8 * j8) = ow; }
        }
        w0 = n0; w1 = n1; ca = nca; cb = ncb; sa = nsa; sb = nsb;
    }
}

__device__ __forceinline__ void phase_compress_mfma(KArgs A, int wv_, int i, LAS unsigned char* lds) {
    const int tid = opaque_tid(wv_), wid = __builtin_amdgcn_readfirstlane(tid >> 6), lane = tid & 63, fr = lane & 15, fq = lane >> 4;
    unsigned char* ws = opq(A->ws);
    const bf16* HY = (const bf16*)(ws + WS_BIG);
    const float* cosT = (const float*)(ws + WS_COS); const float* sinT = (const float*)(ws + WS_SIN);
    LAS float* part = (LAS float*)lds;
    LAS float* hbuf = part + 8 * 1024;
    LAS float* obuf = hbuf + 1024;
    LAS float* w2l = obuf + 1024;
    int w2kv = -1;
    for (int it = blockIdx.x; it < 2 * 127; it += gridDim.x) {
        const int kv = it / 127, tile = it % 127;
        const float* pe = A->in[I_CMPPE] + (size_t)(i * 2 + kv) * 32 * 64;
        const float* w2 = A->in[I_CMPW2] + (size_t)(i * 2 + kv) * 64 * 64;
        const bf16* w1t = (const bf16*)(ws + WS_W1T) + (size_t)(i * 2 + kv) * 64 * 2048;
        const int coff = kv ? C_VC : C_KC;
        if (kv != w2kv) { __syncthreads(); for (int e4 = tid; e4 < 1024; e4 += 512) *(LAS f32x4*)(w2l + 4 * e4) = *(const f32x4*)(w2 + 4 * e4); w2kv = kv; }
        {
            const int R = tile * 16 + fr, g = R & 1, bn = R >> 1, n = bn % NCMP, b = bn / NCMP;
            const bf16* arow = HY + (size_t)(b * S + 16 * n) * HYN + coff + g * 64;
            f32x4 acc[4];
#pragma unroll
            for (int t = 0; t < 4; ++t) acc[t] = (f32x4){0.f, 0.f, 0.f, 0.f};
#pragma unroll 4
            for (int s = 0; s < 8; ++s) {
                const int k0 = 256 * wid + 32 * s, l = k0 >> 6, d0 = (k0 & 63) + 8 * fq;
                const u32x4 hw = *(const u32x4*)(arow + (size_t)l * HYN + d0);
                const f32x4 p0 = *(const f32x4*)(pe + l * 64 + d0), p1 = *(const f32x4*)(pe + l * 64 + d0 + 4);
                u32x4 aw; aw.x = pk2(bflo(hw.x) + p0.x, bfhi(hw.x) + p0.y); aw.y = pk2(bflo(hw.y) + p0.z, bfhi(hw.y) + p0.w); aw.z = pk2(bflo(hw.z) + p1.x, bfhi(hw.z) + p1.y); aw.w = pk2(bflo(hw.w) + p1.z, bfhi(hw.w) + p1.w);
                const bf16x8 af = __builtin_bit_cast(bf16x8, aw);
#pragma unroll
                for (int t = 0; t < 4; ++t) { const bf16x8 bfr = *(const bf16x8*)(w1t + (size_t)(16 * t + fr) * 2048 + k0 + 8 * fq);
                    acc[t] = __builtin_amdgcn_mfma_f32_16x16x32_bf16(af, bfr, acc[t], 0, 0, 0); }
            }
            __syncthreads();
#pragma unroll
            for (int t = 0; t < 4; ++t)
#pragma unroll
                for (int r = 0; r < 4; ++r) part[wid * 1024 + (4 * fq + r) * 64 + 16 * t + fr] = acc[t][r];
        }
        __syncthreads();
        for (int e = tid; e < 1024; e += 512) { float a = 0.f;
#pragma unroll
            for (int w = 0; w < 8; ++w) a += part[w * 1024 + e];
            hbuf[e] = gelu_tanh(a); }
        __syncthreads();
        for (int e = tid; e < 1024; e += 512) { const int r = e >> 6, j = e & 63; float o = 0.f;
#pragma unroll 8
            for (int m = 0; m < 64; ++m) o += hbuf[r * 64 + m] * w2l[m * 64 + j];
            obuf[e] = o; }
        __syncthreads();
        for (int r = wid; r < 16; r += 8) {
            const int R = tile * 16 + r, g = R & 1, bn = R >> 1, n = bn % NCMP, b = bn / NCMP;
            const float o = obuf[r * 64 + lane];
            if (kv == 0) {
                const float y = o * rsqrtf(wave_sum(o * o) * (1.f / 64.f) + EPS) * A->in[I_KNORM][(i * 3 + 0) * 64 + lane];
                const int tp = b * S + 16 * n + 31;
                const float c = cosT[tp * 32 + (lane & 31)], sn = sinT[tp * 32 + (lane & 31)];
                const float pr = __shfl_xor(y, 32);
                const float oo = lane < 32 ? y * c - pr * sn : y * c + pr * sn;
                ((bf16*)(ws + WS_KC))[((size_t)(b * 128 + n) * 2 + g) * 64 + lane] = (bf16)f2bf(oo);
            } else {
                bf16* vct = (bf16*)(ws + WS_VC) + ((size_t)(b * 2 + g) * 64 + lane) * 128;
                vct[(n & 64) + kpos64(n & 63)] = (bf16)f2bf(o);
                if (n == 126) vct[127] = 0;
            }
        }
    }
    __syncthreads();
}

__device__ __forceinline__ void nsa_softmax(f32x4 (&sc)[4], bf16x8 (&pf)[2], float& mrun, float& lrun, f32x4 (&o)[4], const bool rowok, const bool edge, const int kphi, const int kplo, const bool allrows, const int fq) {
    float bm = -INFINITY;
    if (edge) {
#pragma unroll
        for (int t = 0; t < 4; ++t)
#pragma unroll
            for (int r = 0; r < 4; ++r) { const int kp = 16 * t + 4 * fq + r; const bool v = rowok && kp <= kphi && kp >= kplo; sc[t][r] = v ? sc[t][r] : -INFINITY; bm = fmaxf(bm, sc[t][r]); }
    } else {
#pragma unroll
        for (int t = 0; t < 4; ++t) bm = fmaxf(bm, fmaxf(fmaxf(sc[t].x, sc[t].y), fmaxf(sc[t].z, sc[t].w)));
        if (!allrows) bm = rowok ? bm : -INFINITY;
    }
    bm = xmax32(xmax16(bm));
    const float mn = fmaxf(mrun, bm); const float mns = mn == -INFINITY ? 0.f : mn;
    float rs = 0.f;
#pragma unroll
    for (int t = 0; t < 4; ++t)
#pragma unroll
        for (int r = 0; r < 4; ++r) { sc[t][r] = __builtin_amdgcn_exp2f(sc[t][r] - mns); rs += sc[t][r]; }
    if (!edge && !allrows) {
#pragma unroll
        for (int t = 0; t < 4; ++t) sc[t] = rowok ? sc[t] : (f32x4){0.f, 0.f, 0.f, 0.f};
        rs = rowok ? rs : 0.f;
    }
    rs = xadd32(xadd16(rs));
    if (__all(mn == mrun)) { lrun += rs; }
    else {
        const float alpha = __builtin_amdgcn_exp2f(mrun - mns);
        lrun = lrun * alpha + rs; mrun = mn;
#pragma unroll
        for (int n = 0; n < 4; ++n) o[n] = o[n] * alpha;
    }
#pragma unroll
    for (int s = 0; s < 2; ++s) { u32x4 w; w.x = pk2(sc[2 * s].x, sc[2 * s].y); w.y = pk2(sc[2 * s].z, sc[2 * s].w); w.z = pk2(sc[2 * s + 1].x, sc[2 * s + 1].y); w.w = pk2(sc[2 * s + 1].z, sc[2 * s + 1].w);
        pf[s] = __builtin_bit_cast(bf16x8, w); }
}

__device__ __forceinline__ void phase_nsa_attn_mfma(KArgs A, int wv_, int i, LAS unsigned char* lds) {
    const int wid = wv_;
    unsigned char* ws = opq(A->ws);
    const bf16* HY = (const bf16*)(ws + WS_BIG); const bf16* QA = (const bf16*)(ws + WS_QA); const bf16* KS = (const bf16*)(ws + WS_KS); const bf16* KW = (const bf16*)(ws + WS_KW);
    const bf16* KC = (const bf16*)(ws + WS_KC); const bf16* VCT = (const bf16*)(ws + WS_VC); const bf16* VTA = (const bf16*)(ws + WS_VTA); bf16* CAT = (bf16*)(ws + WS_CAT);
    constexpr int RS = 72;
    LAS bf16* ktl = (LAS bf16*)lds;
    LAS bf16* vtl = ktl + 4 * 64 * RS;
    LAS float* scl = (LAS float*)(lds + 73728) + wid * 256;
    LAS unsigned* msk = (LAS unsigned*)(lds + 73728 + 8192);
    LAS unsigned* umask = msk + 64;
    const float* gb = A->in[I_GATEB] + i * 24;
    unsigned long long tsub = 0, tt0 = 0;
    for (int pit = blockIdx.x; pit < 256; pit += gridDim.x) {
#pragma unroll 1
        for (int hf = 0; hf < 2; ++hf) {
            const int tid = opaque_tid(wv_), lane = tid & 63, fr = lane & 15, fq = lane >> 4;
            const int bg = pit >> 4, xx = pit & 15, x = hf ? 31 - xx : xx, b = bg >> 1, g = bg & 1;
            const size_t tokbase = (size_t)b * S + 64 * x;
            const int tl0 = 8 * wid + (fr >> 2);
            if (tid == 0) *umask = 0u;
            if (PROBE_NSA == 1) tt0 = __builtin_amdgcn_s_memrealtime();
            bf16x8 qf[2][2];
#pragma unroll
            for (int mt = 0; mt < 2; ++mt)
#pragma unroll
                for (int s = 0; s < 2; ++s) qf[mt][s] = *(const bf16x8*)(QA + (tokbase + tl0 + 4 * mt) * 512 + (g * 4 + (fr & 3)) * 64 + 32 * s + 8 * fq);
            f32x4 outacc[2][4];
            {
                const int tmaxc = (4 * x + 3 + 15) >> 4;
                const bf16* kcb = KC + ((size_t)(b * 128 + fr) * 2 + g) * 64 + 8 * fq;
                bf16x8 pcf[2][4];
#pragma unroll
                for (int mt = 0; mt < 2; ++mt) {
                    f32x4 sc[8];
                    const bf16* kp = kcb;
#pragma unroll
                    for (int t = 0; t < 8; ++t) { sc[t] = (f32x4){0.f, 0.f, 0.f, 0.f};
                        asm volatile("" : "+v"(kp));
                        if (t < tmaxc) {
                            const bf16x8 k0 = *(const bf16x8*)(kp), k1 = *(const bf16x8*)(kp + 32);
                            sc[t] = __builtin_amdgcn_mfma_f32_16x16x32_bf16(k0, qf[mt][0], sc[t], 0, 0, 0);
                            sc[t] = __builtin_amdgcn_mfma_f32_16x16x32_bf16(k1, qf[mt][1], sc[t], 0, 0, 0); }
                        kp += 16 * 128; }
                    const int tg = 64 * x + tl0 + 4 * mt; const int ncv = tg >= 31 ? ((tg - 31) >> 4) + 1 : 0;
                    float mx = -INFINITY;
#pragma unroll
                    for (int t = 0; t < 8; ++t)
#pragma unroll
                        for (int r = 0; r < 4; ++r) { const bool v = 16 * t + 4 * fq + r < ncv; sc[t][r] = v ? sc[t][r] : -INFINITY; mx = fmaxf(mx, sc[t][r]); }
                    mx = xmax32(xmax16(mx));
                    const float mxs = mx == -INFINITY ? 0.f : mx;
                    float sum = 0.f;
#pragma unroll
                    for (int t = 0; t < 8; ++t)
#pragma unroll
                        for (int r = 0; r < 4; ++r) { sc[t][r] = __builtin_amdgcn_exp2f(sc[t][r] - mxs); sum += sc[t][r]; }
                    sum = xadd32(xadd16(sum));
                    const float inv = sum > 0.f ? 1.f / sum : 0.f;
#pragma unroll
                    for (int t = 0; t < 8; ++t) sc[t] = sc[t] * inv;
#pragma unroll
                    for (int s = 0; s < 4; ++s) { u32x4 w; w.x = pk2(sc[2 * s].x, sc[2 * s].y); w.y = pk2(sc[2 * s].z, sc[2 * s].w); w.z = pk2(sc[2 * s + 1].x, sc[2 * s + 1].y); w.w = pk2(sc[2 * s + 1].z, sc[2 * s + 1].w);
                        pcf[mt][s] = __builtin_bit_cast(bf16x8, w); }
                    float w3[8];
#pragma unroll
                    for (int t = 0; t < 8; ++t) {
#pragma unroll
                        for (int r = 0; r < 4; ++r) { float v = sc[t][r]; v += __shfl_xor(v, 1); v += __shfl_xor(v, 2); sc[t][r] = v; }
                        w3[t] = __shfl(sc[t].w, (lane + 48) & 63);
                    }
#pragma unroll
                    for (int t = 0; t < 8; ++t) {
                        const float prev = fq > 0 ? w3[t] : (t > 0 ? w3[t > 0 ? t - 1 : 0] : 0.f);
                        const float imp = sc[t].x + sc[t].y + sc[t].z + 0.5f * sc[t].w + 0.5f * prev;
                        if ((fr & 3) == 0) scl[(4 * mt + (fr >> 2)) * 32 + 4 * t + fq] = imp;
                    }
                    asm volatile("" ::: "memory");
                }
                const bf16* vcb = VCT + ((size_t)(b * 2 + g) * 64 + fr) * 128 + 8 * fq;
#pragma unroll
                for (int n = 0; n < 4; ++n) {
                    outacc[0][n] = (f32x4){0.f, 0.f, 0.f, 0.f}; outacc[1][n] = (f32x4){0.f, 0.f, 0.f, 0.f};
                    asm volatile("" : "+v"(vcb));
#pragma unroll
                    for (int s = 0; s < 4; ++s) if (2 * s < tmaxc) {
                        const bf16x8 vf = *(const bf16x8*)(vcb + 32 * s);
                        outacc[0][n] = __builtin_amdgcn_mfma_f32_16x16x32_bf16(vf, pcf[0][s], outacc[0][n], 0, 0, 0);
                        outacc[1][n] = __builtin_amdgcn_mfma_f32_16x16x32_bf16(vf, pcf[1][s], outacc[1][n], 0, 0, 0); }
                    vcb += 16 * 128;
                    asm volatile("" ::: "memory");
                }
            }
            float g1v[2], g2v[2];
#pragma unroll
            for (int mt = 0; mt < 2; ++mt) {
                const int head = g * 4 + (fr & 3);
                const bf16* gl = HY + (tokbase + tl0 + 4 * mt) * HYN + C_GA + head * 3;
                const float g0 = sigmoidf_(bf2f(gl[0]) + gb[head * 3 + 0]);
                g1v[mt] = sigmoidf_(bf2f(gl[1]) + gb[head * 3 + 1]); g2v[mt] = sigmoidf_(bf2f(gl[2]) + gb[head * 3 + 2]);
#pragma unroll
                for (int n = 0; n < 4; ++n) outacc[mt][n] = outacc[mt][n] * g0;
            }
            LDS_WAIT();
            asm volatile("" ::: "memory");
            {
                const int tok8 = lane >> 3, jg = lane & 7;
                float sj[32];
#pragma unroll
                for (int q = 0; q < 8; ++q) { const f32x4 v = *(const LAS f32x4*)(scl + tok8 * 32 + 4 * q); sj[4 * q] = v.x; sj[4 * q + 1] = v.y; sj[4 * q + 2] = v.z; sj[4 * q + 3] = v.w; }
#pragma unroll
                for (int j = 0; j < 32; ++j) sj[j] = j <= x ? sj[j] + ((j == 0 || j == x || j == x - 1) ? 1000.0f : 0.f) : -INFINITY;
                unsigned bits = 0u;
                const f32x4 mv = *(const LAS f32x4*)(scl + tok8 * 32 + 4 * jg);
#pragma unroll
                for (int q = 0; q < 4; ++q) {
                    const int j = 4 * jg + q;
                    const float mine = j <= x ? mv[q] + ((j == 0 || j == x || j == x - 1) ? 1000.0f : 0.f) : -INFINITY;
                    int rank = 0;
#pragma unroll
                    for (int jj = 0; jj < 32; ++jj) rank += (sj[jj] > mine || (sj[jj] == mine && jj < j)) ? 1 : 0;
                    bits |= (j <= x && rank < 8) ? (1u << j) : 0u;
                }
                bits |= __shfl_xor(bits, 1); bits |= __shfl_xor(bits, 2); bits |= __shfl_xor(bits, 4);
                if (jg == 0) { msk[wid * 8 + tok8] = bits; atomicOr((unsigned*)umask, bits); }
            }
            __syncthreads();
            if (PROBE_NSA == 1) tsub += __builtin_amdgcn_s_memrealtime() - tt0;
#pragma unroll 1
            for (int pp = 0; pp < 2 + (PROBE_NSAX ? 1 : 0); ++pp) {
                const int pass = pp == 2 ? 0 : pp; const bool dummy = pp == 2;
                if (PROBE_NSA == 2 + pass) tt0 = __builtin_amdgcn_s_memrealtime();
                const int jlo = pass ? (x >= 4 ? x - 4 : 0) : 0;
                const unsigned inrange = (x >= 31 ? 0xffffffffu : ((2u << x) - 1u)) & ~((1u << jlo) - 1u);
                unsigned bmask = pass ? inrange : (*umask & inrange);
                const bf16* Kb = pass ? KW : KS; const int cg = (pass ? 10 : 8) + g;
                unsigned tm[2], wm[2], am[2];
#pragma unroll
                for (int mt = 0; mt < 2; ++mt) {
                    tm[mt] = pass ? 0xffffffffu : msk[wid * 8 + 4 * mt + (fr >> 2)];
                    wm[mt] = pass ? 0xffffffffu : (msk[wid * 8 + 4 * mt] | msk[wid * 8 + 4 * mt + 1] | msk[wid * 8 + 4 * mt + 2] | msk[wid * 8 + 4 * mt + 3]);
                    am[mt] = pass ? 0xffffffffu : (msk[wid * 8 + 4 * mt] & msk[wid * 8 + 4 * mt + 1] & msk[wid * 8 + 4 * mt + 2] & msk[wid * 8 + 4 * mt + 3]);
                    wm[mt] = __builtin_amdgcn_readfirstlane(wm[mt]); am[mt] = __builtin_amdgcn_readfirstlane(am[mt]);
                    if (PROBE_NSAX == 2 && dummy) wm[mt] = 0u;
                }
                f32x4 o[2][4]; float mrun[2], lrun[2];
#pragma unroll
                for (int mt = 0; mt < 2; ++mt) { mrun[mt] = -INFINITY; lrun[mt] = 0.f;
#pragma unroll
                    for (int n = 0; n < 4; ++n) o[mt][n] = (f32x4){0.f, 0.f, 0.f, 0.f}; }
                const int srow = tid >> 3, sc16 = tid & 7;
                u32x4 pk0 = (u32x4){0u, 0u, 0u, 0u}, pv0 = pk0, pk1 = pk0, pv1 = pk0;
#define NSA_LD(jx, pk, pv) do { const bf16* ksrc = Kb + ((size_t)b * S + 64 * (jx) + srow) * 128 + g * 64 + sc16 * 8; const bf16* vsrc = VTA + ((size_t)((b * 32 + (jx)) * 12 + cg)) * 4096 + srow * 64 + sc16 * 8; \
                    pk = *(const u32x4*)ksrc; pv = *(const u32x4*)vsrc; } while (0)
                int j0 = __ffs(bmask) - 1; bmask &= bmask - 1u;
                int j1 = bmask ? __ffs(bmask) - 1 : -1; bmask &= bmask - 1u;
                NSA_LD(j0, pk0, pv0); if (j1 >= 0) NSA_LD(j1, pk1, pv1);
                int buf = 0;
                while (j0 >= 0) {
                    *(LAS u32x4*)(ktl + (buf * 2 + 0) * 64 * RS + srow * RS + sc16 * 8) = pk0; *(LAS u32x4*)(vtl + (buf * 2 + 0) * 64 * RS + srow * RS + sc16 * 8) = pv0;
                    if (j1 >= 0) { *(LAS u32x4*)(ktl + (buf * 2 + 1) * 64 * RS + srow * RS + sc16 * 8) = pk1; *(LAS u32x4*)(vtl + (buf * 2 + 1) * 64 * RS + srow * RS + sc16 * 8) = pv1; }
                    const int jn0 = bmask ? __ffs(bmask) - 1 : -1; bmask &= bmask - 1u;
                    const int jn1 = bmask ? __ffs(bmask) - 1 : -1; bmask &= bmask - 1u;
                    if (jn0 >= 0) NSA_LD(jn0, pk0, pv0);
                    if (jn1 >= 0) NSA_LD(jn1, pk1, pv1);
                    __syncthreads();
#pragma unroll 1
                    for (int sub = 0; sub < 2; ++sub) {
                        const int j = sub ? j1 : j0;
                        if (j < 0) break;
                        const LAS bf16* kt = ktl + (buf * 2 + sub) * 64 * RS + fr * RS + 8 * fq; const LAS bf16* vt = vtl + (buf * 2 + sub) * 64 * RS + fr * RS + 8 * fq;
                        const bool nd0 = (wm[0] >> j) & 1u, nd1 = (wm[1] >> j) & 1u;
                        if (!(nd0 || nd1)) continue;
                        const bool edge = (j == x) || (pass && j == x - 4);
                        f32x4 sc0[4], sc1[4];
#pragma unroll
                        for (int t = 0; t < 4; ++t) { sc0[t] = (f32x4){0.f, 0.f, 0.f, 0.f}; sc1[t] = (f32x4){0.f, 0.f, 0.f, 0.f};
                            const bf16x8 k0_ = *(const LAS bf16x8*)(kt + t * 16 * RS), k1_ = *(const LAS bf16x8*)(kt + t * 16 * RS + 32);
                            if (nd0) { sc0[t] = __builtin_amdgcn_mfma_f32_16x16x32_bf16(k0_, qf[0][0], sc0[t], 0, 0, 0); sc0[t] = __builtin_amdgcn_mfma_f32_16x16x32_bf16(k1_, qf[0][1], sc0[t], 0, 0, 0); }
                            if (nd1) { sc1[t] = __builtin_amdgcn_mfma_f32_16x16x32_bf16(k0_, qf[1][0], sc1[t], 0, 0, 0); sc1[t] = __builtin_amdgcn_mfma_f32_16x16x32_bf16(k1_, qf[1][1], sc1[t], 0, 0, 0); } }
                        bf16x8 pf0[2], pf1[2];
                        if (nd0) nsa_softmax(sc0, pf0, mrun[0], lrun[0], o[0], (tm[0] >> j) & 1u, edge, j == x ? tl0 : 63, (pass && j == x - 4) ? tl0 + 1 : 0, (am[0] >> j) & 1u, fq);
                        if (nd1) nsa_softmax(sc1, pf1, mrun[1], lrun[1], o[1], (tm[1] >> j) & 1u, edge, j == x ? tl0 + 4 : 63, (pass && j == x - 4) ? tl0 + 5 : 0, (am[1] >> j) & 1u, fq);
#pragma unroll
                        for (int n = 0; n < 4; ++n) {
                            const bf16x8 v0_ = *(const LAS bf16x8*)(vt + n * 16 * RS), v1_ = *(const LAS bf16x8*)(vt + n * 16 * RS + 32);
                            if (nd0) { o[0][n] = __builtin_amdgcn_mfma_f32_16x16x32_bf16(v0_, pf0[0], o[0][n], 0, 0, 0); o[0][n] = __builtin_amdgcn_mfma_f32_16x16x32_bf16(v1_, pf0[1], o[0][n], 0, 0, 0); }
                            if (nd1) { o[1][n] = __builtin_amdgcn_mfma_f32_16x16x32_bf16(v0_, pf1[0], o[1][n], 0, 0, 0); o[1][n] = __builtin_amdgcn_mfma_f32_16x16x32_bf16(v1_, pf1[1], o[1][n], 0, 0, 0); } }
                    }
                    j0 = jn0; j1 = jn1; buf ^= 1;
                }
#undef NSA_LD
#pragma unroll
                for (int mt = 0; mt < 2; ++mt) { const float sc_ = (pass ? g2v[mt] : g1v[mt]) / lrun[mt];
                    if (!dummy) {
#pragma unroll
                    for (int n = 0; n < 4; ++n) outacc[mt][n] = outacc[mt][n] + o[mt][n] * sc_; } }
                __syncthreads();
                if (PROBE_NSA == 2 + pass) tsub += __builtin_amdgcn_s_memrealtime() - tt0;
            }
#pragma unroll
            for (int mt = 0; mt < 2; ++mt) {
                bf16* dst = CAT + (tokbase + tl0 + 4 * mt) * 1024 + (g * 4 + (fr & 3)) * 64 + 4 * fq;
#pragma unroll
                for (int n = 0; n < 4; ++n) { u32x2 w; w.x = pk2(outacc[mt][n].x, outacc[mt][n].y); w.y = pk2(outacc[mt][n].z, outacc[mt][n].w); *(u32x2*)(dst + 16 * n) = w; }
            }
        }
    }
    __syncthreads();
    if (PROBE_NSA && blockIdx.x == 0 && opaque_tid(wv_) == 0) atomicAdd((unsigned long long*)(ws + WS_CTL + 48000), tsub);
}

__device__ __forceinline__ void phase_vtiles(KArgs A, int wv_, LAS unsigned char* lds) {
    const int tid_ = opaque_tid(wv_); const int wid = __builtin_amdgcn_readfirstlane(tid_ >> 6), lane = tid_ & 63; const int gw = blockIdx.x * 8 + wid, NGW = gridDim.x * 8;
    unsigned char* ws = opq(A->ws);
    const bf16* HY = (const bf16*)(ws + WS_BIG); bf16* VTA = (bf16*)(ws + WS_VTA);
    constexpr int TS = 66;
    LAS bf16* tl = (LAS bf16*)(lds + 65536) + wid * (64 * TS);
    for (int it = gw; it < NBATCH * 32 * 12; it += NGW) {
        const int cg = it % 12, bc = it / 12;
        const int colbase = cg < 8 ? C_VB + cg * 64 : (cg < 10 ? C_VS + (cg - 8) * 64 : C_VW + (cg - 10) * 64);
        const u32x4* src = (const u32x4*)(HY + (size_t)(bc * 64 + lane) * HYN + colbase);
        u32x4 w[8];
#pragma unroll
        for (int i = 0; i < 8; ++i) w[i] = src[i];
#pragma unroll
        for (int i = 0; i < 8; ++i) { LAS unsigned* d = (LAS unsigned*)(tl + lane * TS + 8 * i); d[0] = w[i].x; d[1] = w[i].y; d[2] = w[i].z; d[3] = w[i].w; }
        LDS_WAIT();
        bf16* dst = VTA + (size_t)it * 4096 + lane * 64;
#pragma unroll
        for (int p8 = 0; p8 < 8; ++p8) {
            unsigned short x[8];
#pragma unroll
            for (int j = 0; j < 8; ++j) x[j] = tl[kperm64(p8 * 8 + j) * TS + lane];
            u32x4 o; o.x = x[0] | ((unsigned)x[1] << 16); o.y = x[2] | ((unsigned)x[3] << 16); o.z = x[4] | ((unsigned)x[5] << 16); o.w = x[6] | ((unsigned)x[7] << 16);
            *(u32x4*)(dst + p8 * 8) = o;
        }
        LDS_WAIT();
    }
}

__device__ __forceinline__ void vtrans_wave(KArgs A, int wv_, LAS bf16* tl, const int gw, const int NGW) {
    const int tid_ = opaque_tid(wv_); const int lane = tid_ & 63;
    unsigned char* ws = opq(A->ws);
    const bf16* KV = (const bf16*)(ws + WS_KV); bf16* VT = (bf16*)(ws + WS_VT);
    constexpr int TS = 66;
    for (int it = gw; it < DEPTH * NBATCH * 4 * 16; it += NGW) {
        const int db = it & 3, kb = (it >> 2) & 3, h = (it >> 4) & 3, b = (it >> 6) & 7, l = it >> 9;
        const u32x4* src = (const u32x4*)(KV + (size_t)(b * 256 + 64 * kb + lane) * 8192 + l * 2048 + 1024 + h * 256 + 64 * db);
        u32x4 w[8];
#pragma unroll
        for (int i = 0; i < 8; ++i) w[i] = src[i];
#pragma unroll
        for (int i = 0; i < 8; ++i) { LAS unsigned* d = (LAS unsigned*)(tl + lane * TS + 8 * i); d[0] = w[i].x; d[1] = w[i].y; d[2] = w[i].z; d[3] = w[i].w; }
        LDS_WAIT();
        bf16* dst = VT + ((size_t)((l * 8 + b) * 4 + h) * 256 + 64 * db + lane) * 256 + 64 * kb;
#pragma unroll
        for (int p8 = 0; p8 < 8; ++p8) {
            unsigned short x[8];
#pragma unroll
            for (int j = 0; j < 8; ++j) x[j] = tl[kperm64(p8 * 8 + j) * TS + lane];
            u32x4 o; o.x = x[0] | ((unsigned)x[1] << 16); o.y = x[2] | ((unsigned)x[3] << 16); o.z = x[4] | ((unsigned)x[5] << 16); o.w = x[6] | ((unsigned)x[7] << 16);
            *(u32x4*)(dst + p8 * 8) = o;
        }
        LDS_WAIT();
    }
}

__device__ __forceinline__ float log_sigmoid16(float z) { return (fminf(z, 0.f) - __logf(1.0f + __expf(-fabsf(z)))) * (1.f / 16.f); }
#define GLA_Z(tokv) ({ float z_ = bias; _Pragma("unroll") for (int r_ = 0; r_ < 16; ++r_) z_ += __builtin_bit_cast(float, __builtin_amdgcn_readlane(__builtin_bit_cast(int, al[r_]), (tokv))) * wc[r_]; z_; })
#define GLA_LOAD_GATE() \
    float al[16], wc[16]; \
    { const u32x4* ap_ = (const u32x4*)(HY + (size_t)(tok0 + lane) * HYN + C_AL); const u32x4 a0_ = ap_[0], a1_ = ap_[1]; \
      al[0] = bflo(a0_.x); al[1] = bfhi(a0_.x); al[2] = bflo(a0_.y); al[3] = bfhi(a0_.y); al[4] = bflo(a0_.z); al[5] = bfhi(a0_.z); al[6] = bflo(a0_.w); al[7] = bfhi(a0_.w); \
      al[8] = bflo(a1_.x); al[9] = bfhi(a1_.x); al[10] = bflo(a1_.y); al[11] = bfhi(a1_.y); al[12] = bflo(a1_.z); al[13] = bfhi(a1_.z); al[14] = bflo(a1_.w); al[15] = bfhi(a1_.w); } \
    _Pragma("unroll") for (int r_ = 0; r_ < 16; ++r_) wc[r_] = A->in[I_WA2][(i * 16 + r_) * 256 + h * 64 + lane]; \
    const float bias = A->in[I_BA][i * 256 + h * 64 + lane];

__device__ __forceinline__ void phase_gla_a(KArgs A, int wv_, int i, LAS unsigned char* lds) {
    const int tid_ = opaque_tid(wv_); const int wid = __builtin_amdgcn_readfirstlane(tid_ >> 6), lane = tid_ & 63, fr = lane & 15, fq = lane >> 4; const int gw = blockIdx.x * 8 + wid, NGW = gridDim.x * 8;
    unsigned char* ws = opq(A->ws);
    const bf16* HY = (const bf16*)(ws + WS_BIG); const bf16* VTA = (const bf16*)(ws + WS_VTA); float* SLOC = (float*)(ws + WS_SLOC); float* DEC = (float*)(ws + WS_DEC);
    constexpr int RS = 72;
    LAS bf16* kh = (LAS bf16*)lds + wid * (64 * RS);
    (void)gw;
    for (int it = wid * (int)gridDim.x + (int)blockIdx.x; it < 1024; it += NGW) {
        const int c = it & 31, bh = it >> 5, b = bh >> 2, h = bh & 3; const size_t tok0 = (size_t)b * S + c * 64;
        GLA_LOAD_GATE();
        float bl = 0.f; float la[64];
#pragma unroll
        for (int tk = 0; tk < 64; ++tk) { la[tk] = log_sigmoid16(GLA_Z(tk)); bl += la[tk]; }
        float bc = 0.f;
        unsigned short kcol[64];
#pragma unroll
        for (int tk = 0; tk < 64; ++tk) kcol[tk] = HY[(tok0 + tk) * HYN + C_KB + h * 64 + lane];
#pragma unroll
        for (int tk = 0; tk < 64; ++tk) {
            bc += la[tk];
            kh[lane * RS + kpos64(tk)] = (bf16)f2bf(bf2f(kcol[tk]) * __expf(bl - bc));
        }
        DEC[it * 64 + lane] = __expf(bl);
        LDS_WAIT();
#pragma unroll
        for (int dvh = 0; dvh < 2; ++dvh) {
            const bf16* vt = VTA + ((size_t)((b * 32 + c) * 12 + h * 2 + dvh)) * 4096;
            bf16x8 vf[4][2];
#pragma unroll
            for (int n = 0; n < 4; ++n)
#pragma unroll
                for (int s = 0; s < 2; ++s) vf[n][s] = *(const bf16x8*)(vt + (16 * n + fr) * 64 + 32 * s + 8 * fq);
#pragma unroll
            for (int m = 0; m < 4; ++m) {
                const bf16x8 a0 = *(const LAS bf16x8*)(kh + (16 * m + fr) * RS + 8 * fq), a1 = *(const LAS bf16x8*)(kh + (16 * m + fr) * RS + 32 + 8 * fq);
#pragma unroll
                for (int n = 0; n < 4; ++n) {
                    f32x4 acc = (f32x4){0.f, 0.f, 0.f, 0.f};
                    acc = __builtin_amdgcn_mfma_f32_16x16x32_bf16(a0, vf[n][0], acc, 0, 0, 0);
                    acc = __builtin_amdgcn_mfma_f32_16x16x32_bf16(a1, vf[n][1], acc, 0, 0, 0);
                    float* dst = SLOC + ((size_t)it * 64 + 16 * m + 4 * fq) * 128 + dvh * 64 + 16 * n + fr;
                    dst[0] = acc.x; dst[128] = acc.y; dst[256] = acc.z; dst[384] = acc.w;
                }
            }
        }
        LDS_WAIT();
    }
}
__device__ __forceinline__ void phase_gla_c(KArgs A, int wv_, int i, LAS unsigned char* lds, const bool kv_post) {
    const int tid_ = opaque_tid(wv_); const int wid = __builtin_amdgcn_readfirstlane(tid_ >> 6), lane = tid_ & 63, fr = lane & 15, fq = lane >> 4; const int gw = blockIdx.x * 8 + wid, NGW = gridDim.x * 8;
    unsigned char* ws = opq(A->ws);
    const bf16* HY = (const bf16*)(ws + WS_BIG); const bf16* VTA = (const bf16*)(ws + WS_VTA); const bf16* STT = (const bf16*)(ws + WS_STT); bf16* CAT = (bf16*)(ws + WS_CAT);
    constexpr int RS = 72;
    LAS bf16* qs = (LAS bf16*)lds + wid * (128 * RS);
    LAS bf16* ks = qs + 64 * RS;
    const float* og = A->in[I_ONORM] + i * 128;
    LAS float* ogl = (LAS float*)(lds + 8 * 128 * RS * 2);
    if (tid_ < 128) ogl[tid_] = og[tid_];
    (void)gw; (void)NGW;
    for (int blk = blockIdx.x; blk < 256; blk += gridDim.x) {
        SUBT_BEGIN(1);
        {
            const float* SLOC = (const float*)(ws + WS_SLOC); const float* DEC = (const float*)(ws + WS_DEC); bf16* STw = (bf16*)(ws + WS_STT);
            const int tid = tid_, dv = tid & 127, ko = tid >> 7, bh = blk >> 3, c0 = (blk & 7) * 4;
            float sv[16];
#pragma unroll
            for (int j = 0; j < 16; ++j) sv[j] = 0.f;
#pragma unroll 1
            for (int cb = 0; cb < c0 + 4; cb += 4) {
                float dc4[4][16], sl4[4][16];
#pragma unroll
                for (int q = 0; q < 4; ++q) {
                    const size_t item = (size_t)bh * 32 + cb + q; const float* sl = SLOC + (item * 64 + ko * 16) * 128 + dv; const float* dc = DEC + item * 64 + ko * 16;
#pragma unroll
                    for (int j = 0; j < 16; ++j) { dc4[q][j] = dc[j]; sl4[q][j] = sl[j * 128]; }
                }
#pragma unroll
                for (int q = 0; q < 4; ++q) {
                    const int c = cb + q; const size_t item = (size_t)bh * 32 + c;
                    if (c >= c0) {
                        u32x4 o0, o1; o0.x = pk2(sv[0], sv[1]); o0.y = pk2(sv[2], sv[3]); o0.z = pk2(sv[4], sv[5]); o0.w = pk2(sv[6], sv[7]);
                        o1.x = pk2(sv[8], sv[9]); o1.y = pk2(sv[10], sv[11]); o1.z = pk2(sv[12], sv[13]); o1.w = pk2(sv[14], sv[15]);
                        u32x4* d = (u32x4*)(STw + (item * 128 + dv) * 64 + ko * 16); d[0] = o0; d[1] = o1;
                    }
#pragma unroll
                    for (int j = 0; j < 16; ++j) sv[j] = dc4[q][j] * sv[j] + sl4[q][j];
                }
            }
            asm volatile("s_waitcnt vmcnt(0)" ::: "memory");
            __syncthreads();
        }
        SUBT_END(1, ws, tid_);
        SUBT_BEGIN(2);
        SUBT_BEGIN(3);
        if (wid < 4) {
        const int it = blk * 4 + wid;
        const int c = it & 31, bh = it >> 5, b = bh >> 2, h = bh & 3; const size_t tok0 = (size_t)b * S + c * 64;
        GLA_LOAD_GATE();
        float bc = 0.f;
        unsigned short qcol[64], kcol[64];
#pragma unroll
        for (int tk = 0; tk < 64; ++tk) { const bf16* row = HY + (tok0 + tk) * HYN; qcol[tk] = row[C_QB + h * 64 + lane]; kcol[tk] = row[C_KB + h * 64 + lane]; }
#pragma unroll
        for (int tk = 0; tk < 64; ++tk) {
            bc += log_sigmoid16(GLA_Z(tk));
            const float eb = __expf(bc);
            qs[tk * RS + lane] = (bf16)f2bf(bf2f(qcol[tk]) * 0.125f * eb); ks[tk * RS + lane] = (bf16)f2bf(bf2f(kcol[tk]) / eb);
        }
        LDS_WAIT();
        SUBT_END(2, ws, tid_);
        bf16x8 st[8][2];
#pragma unroll
        for (int n = 0; n < 8; ++n)
#pragma unroll
            for (int s = 0; s < 2; ++s) st[n][s] = *(const bf16x8*)(STT + ((size_t)it * 128 + 16 * n + fr) * 64 + 32 * s + 8 * fq);
        const bf16* vt = VTA + ((size_t)((b * 32 + c) * 12 + h * 2)) * 4096;
        bf16x8 vfr[8];
#pragma unroll
        for (int n = 0; n < 8; ++n) { const bf16* vrow = vt + (size_t)(n >> 2) * 4096 + (16 * (n & 3) + fr) * 64 + 8 * fq; vfr[n] = *(const bf16x8*)vrow; }
#pragma unroll
        for (int mi = 0; mi < 4; ++mi) {
            const bf16x8 q0 = *(const LAS bf16x8*)(qs + (16 * mi + fr) * RS + 8 * fq), q1 = *(const LAS bf16x8*)(qs + (16 * mi + fr) * RS + 32 + 8 * fq);
            u32x2 rwv[8];
#pragma unroll
            for (int n = 0; n < 8; ++n) rwv[n] = *(const u32x2*)(HY + (tok0 + 16 * mi + fr) * HYN + C_RB + h * 128 + 16 * n + 4 * fq);
            f32x4 sc[4];
#pragma unroll
            for (int t = 0; t < 4; ++t) {
                sc[t] = (f32x4){0.f, 0.f, 0.f, 0.f};
                if (t <= mi) {
                    const bf16x8 k0 = *(const LAS bf16x8*)(ks + (16 * t + fr) * RS + 8 * fq), k1 = *(const LAS bf16x8*)(ks + (16 * t + fr) * RS + 32 + 8 * fq);
                    sc[t] = __builtin_amdgcn_mfma_f32_16x16x32_bf16(k0, q0, sc[t], 0, 0, 0);
                    sc[t] = __builtin_amdgcn_mfma_f32_16x16x32_bf16(k1, q1, sc[t], 0, 0, 0);
                    if (t == mi) {
                        sc[t].x = (4 * fq + 0 <= fr) ? sc[t].x : 0.f; sc[t].y = (4 * fq + 1 <= fr) ? sc[t].y : 0.f; sc[t].z = (4 * fq + 2 <= fr) ? sc[t].z : 0.f; sc[t].w = (4 * fq + 3 <= fr) ? sc[t].w : 0.f; }
                }
            }
            bf16x8 pf[2];
#pragma unroll
            for (int s = 0; s < 2; ++s) { u32x4 w; w.x = pk2(sc[2 * s].x, sc[2 * s].y); w.y = pk2(sc[2 * s].z, sc[2 * s].w); w.z = pk2(sc[2 * s + 1].x, sc[2 * s + 1].y); w.w = pk2(sc[2 * s + 1].z, sc[2 * s + 1].w);
                pf[s] = __builtin_bit_cast(bf16x8, w); }
            f32x4 o[8]; float ssq = 0.f;
#pragma unroll
            for (int n = 0; n < 8; ++n) {
                o[n] = (f32x4){0.f, 0.f, 0.f, 0.f};
                o[n] = __builtin_amdgcn_mfma_f32_16x16x32_bf16(st[n][0], q0, o[n], 0, 0, 0);
                o[n] = __builtin_amdgcn_mfma_f32_16x16x32_bf16(st[n][1], q1, o[n], 0, 0, 0);
                o[n] = __builtin_amdgcn_mfma_f32_16x16x32_bf16(vfr[n], pf[0], o[n], 0, 0, 0);
                if (mi >= 2) o[n] = __builtin_amdgcn_mfma_f32_16x16x32_bf16(*(const bf16x8*)(vt + (size_t)(n >> 2) * 4096 + (16 * (n & 3) + fr) * 64 + 8 * fq + 32), pf[1], o[n], 0, 0, 0);
                ssq += (o[n].x * o[n].x + o[n].y * o[n].y) + (o[n].z * o[n].z + o[n].w * o[n].w);
            }
            ssq = xadd32(xadd16(ssq));
            const float rstd = rsqrtf(ssq * (1.f / 128.f) + EPS);
            const size_t tok = tok0 + 16 * mi + fr;
#pragma unroll
            for (int n = 0; n < 8; ++n) {
                const int dv = 16 * n + 4 * fq;
                const u32x2 rw = rwv[n]; const f32x4 g = *(const LAS f32x4*)(ogl + dv);
                const float r0 = bflo(rw.x), r1 = bfhi(rw.x), r2 = bflo(rw.y), r3 = bfhi(rw.y);
                u32x2 w; w.x = pk2(o[n].x * rstd * g.x * (r0 * sigmoidf_(r0)), o[n].y * rstd * g.y * (r1 * sigmoidf_(r1)));
                w.y = pk2(o[n].z * rstd * g.z * (r2 * sigmoidf_(r2)), o[n].w * rstd * g.w * (r3 * sigmoidf_(r3)));
                *(u32x2*)(CAT + tok * 1024 + 512 + h * 128 + dv) = w;
            }
        }
        } else if (kv_post) {
            phase_knorm(A, wv_, blk * 4 + (wid - 4), 256 * 4);
            vtrans_wave(A, wv_, (LAS bf16*)(lds + 81920) + (wid - 4) * (64 * 66), blk * 4 + (wid - 4), 256 * 4);
        }
        SUBT_END(3, ws, tid_);
        LDS_WAIT();
        __syncthreads();
    }
}

__device__ __forceinline__ void phase_sgu_mix_mfma(KArgs A, int wv_, int i, LAS unsigned char* lds) {
    const int tid = opaque_tid(wv_), wid = __builtin_amdgcn_readfirstlane(tid >> 6), lane = tid & 63, fr = lane & 15, fq = lane >> 4;
    unsigned char* ws = opq(A->ws);
    const bf16* U = (const bf16*)(ws + WS_U); const bf16* V = (const bf16*)(ws + WS_V); bf16* UM = (bf16*)(ws + WS_UM);
    const bf16* WSB = (const bf16*)(ws + WS_WSB) + (size_t)i * 8 * 16384; const float* M0 = (const float*)(ws + WS_M0) + i * 8 * 128;
    constexpr int VS = 136;
    LAS bf16* vT = (LAS bf16*)lds;
    LAS float* st = (LAS float*)(lds + 256 * VS * 2);
    LAS bf16* wl = (LAS bf16*)(lds + 256 * VS * 2 + 1024);
    const float* lng = A->in[I_LNG] + i * 2048; const float* lnb = A->in[I_LNB] + i * 2048; const float* bsg = A->in[I_SGBS] + i * 8 * 128;
    for (int it = blockIdx.x; it < 256; it += gridDim.x) {
        const int gh = it & 1, n_ = (it >> 1) & 15, b = it >> 5; const size_t tok0 = (size_t)b * S + n_ * 128;
        __syncthreads();
        {
            const float* vst = (const float*)(ws + WS_VSTAT);
#pragma unroll
            for (int s4 = 0; s4 < 16; s4 += 4) {
                const int s = wid * 16 + s4 + (lane >> 4);
                const f32x4 p = *(const f32x4*)(vst + (tok0 + s) * 64 + 4 * (lane & 15));
                float sum = p.x + p.z, sq = p.y + p.w;
                sum += __shfl_xor(sum, 1); sq += __shfl_xor(sq, 1); sum += __shfl_xor(sum, 2); sq += __shfl_xor(sq, 2);
                sum += __shfl_xor(sum, 4); sq += __shfl_xor(sq, 4); sum += __shfl_xor(sum, 8); sq += __shfl_xor(sq, 8);
                const float mean = sum * (1.f / 2048.f); const float var = fmaxf(sq * (1.f / 2048.f) - mean * mean, 0.f);
                if ((lane & 15) == 0) { st[2 * s] = mean; st[2 * s + 1] = rsqrtf(var + EPS); }
            }
        }
#pragma unroll 1
        for (int gg = 0; gg < 4; ++gg) {
            const int g = gh * 4 + gg;
            __syncthreads();
            {
                const int s = tid & 127, cq = tid >> 7;
                const float mean = st[2 * s], rstd = st[2 * s + 1];
                const u32x4* src = (const u32x4*)(V + (tok0 + s) * 2048 + g * 256 + cq * 64);
                u32x4 w8[8], ww[4];
#pragma unroll
                for (int i8 = 0; i8 < 8; ++i8) w8[i8] = src[i8];
#pragma unroll
                for (int q = 0; q < 4; ++q) { const int e = tid + 512 * q; ww[q] = *(const u32x4*)(WSB + ((size_t)g * 128 + (e >> 4)) * 128 + (e & 15) * 8); }
#pragma unroll
                for (int i8 = 0; i8 < 8; ++i8) {
                    const u32x4 w = w8[i8];
                    LAS bf16* d = vT + (cq * 64 + i8 * 8) * VS + s;
                    d[0 * VS] = (bf16)f2bf((bflo(w.x) - mean) * rstd); d[1 * VS] = (bf16)f2bf((bfhi(w.x) - mean) * rstd); d[2 * VS] = (bf16)f2bf((bflo(w.y) - mean) * rstd); d[3 * VS] = (bf16)f2bf((bfhi(w.y) - mean) * rstd);
                    d[4 * VS] = (bf16)f2bf((bflo(w.z) - mean) * rstd); d[5 * VS] = (bf16)f2bf((bfhi(w.z) - mean) * rstd); d[6 * VS] = (bf16)f2bf((bflo(w.w) - mean) * rstd); d[7 * VS] = (bf16)f2bf((bfhi(w.w) - mean) * rstd);
                }
#pragma unroll
                for (int q = 0; q < 4; ++q) { const int e = tid + 512 * q; *(LAS u32x4*)(wl + (e >> 4) * VS + (e & 15) * 8) = ww[q]; }
            }
            u32x2 uw[8][2]; float m0v[8], bsv[8];
#pragma unroll
            for (int n = 0; n < 8; ++n) { const int t = 16 * n + fr; m0v[n] = M0[g * 128 + t]; bsv[n] = bsg[g * 128 + t];
                const size_t ro = (tok0 + t) * 2048 + g * 256 + 32 * wid + 4 * fq; uw[n][0] = *(const u32x2*)(U + ro); uw[n][1] = *(const u32x2*)(U + ro + 16); }
            __syncthreads();
            bf16x8 vf[2][4];
#pragma unroll
            for (int m = 0; m < 2; ++m)
#pragma unroll
                for (int k = 0; k < 4; ++k) vf[m][k] = *(const LAS bf16x8*)(vT + (32 * wid + 16 * m + fr) * VS + 32 * k + 8 * fq);
            f32x4 gc[2], bc[2];
#pragma unroll
            for (int m = 0; m < 2; ++m) { gc[m] = *(const f32x4*)(lng + g * 256 + 32 * wid + 16 * m + 4 * fq); bc[m] = *(const f32x4*)(lnb + g * 256 + 32 * wid + 16 * m + 4 * fq); }
#pragma unroll
            for (int n = 0; n < 8; ++n) {
                f32x4 a0 = (f32x4){0.f, 0.f, 0.f, 0.f}, a1 = (f32x4){0.f, 0.f, 0.f, 0.f};
#pragma unroll
                for (int k = 0; k < 4; ++k) if (k <= (n >> 1)) {
                    const bf16x8 wf = *(const LAS bf16x8*)(wl + (16 * n + fr) * VS + 32 * k + 8 * fq);
                    a0 = __builtin_amdgcn_mfma_f32_16x16x32_bf16(vf[0][k], wf, a0, 0, 0, 0);
                    a1 = __builtin_amdgcn_mfma_f32_16x16x32_bf16(vf[1][k], wf, a1, 0, 0, 0); }
                const int t = 16 * n + fr; const float m0 = m0v[n], bsv_ = bsv[n];
                const size_t ro = (tok0 + t) * 2048 + g * 256 + 32 * wid + 4 * fq;
#pragma unroll
                for (int m = 0; m < 2; ++m) {
                    const f32x4 a = m ? a1 : a0;
                    const u32x2 uw_ = uw[n][m];
                    u32x2 w; w.x = pk2((a.x * gc[m].x + bc[m].x * m0 + bsv_) * bflo(uw_.x), (a.y * gc[m].y + bc[m].y * m0 + bsv_) * bfhi(uw_.x));
                    w.y = pk2((a.z * gc[m].z + bc[m].z * m0 + bsv_) * bflo(uw_.y), (a.w * gc[m].w + bc[m].w * m0 + bsv_) * bfhi(uw_.y));
                    *(u32x2*)(UM + ro + 16 * m) = w;
                }
            }
        }
    }
    __syncthreads();
}

__device__ __forceinline__ void xattn_item(KArgs A, int wv_, int L, LAS unsigned char* lds, const int b, const int h, const int qt) {
    const int tid = opaque_tid(wv_), wid = __builtin_amdgcn_readfirstlane(tid >> 6), lane = tid & 63, fr = lane & 15, fq = lane >> 4;
    unsigned char* ws = opq(A->ws);
    const bf16* QX = (const bf16*)(ws + WS_QX); const bf16* KV = (const bf16*)(ws + WS_KV); const bf16* VT = (const bf16*)(ws + WS_VT); bf16* OX = (bf16*)(ws + WS_OX);
    constexpr int RS = 264;
    LAS bf16* kl = (LAS bf16*)lds;
    const float* qg = A->in[I_XQN] + L * 256;
    {
        __syncthreads();
        {
            const int row = tid >> 1, hf = tid & 1;
            const u32x4* src = (const u32x4*)(KV + (size_t)(b * 256 + row) * 8192 + L * 2048 + h * 256 + hf * 128);
#pragma unroll
            for (int i0 = 0; i0 < 16; i0 += 8) {
                u32x4 w[8];
#pragma unroll
                for (int i = 0; i < 8; ++i) w[i] = src[i0 + i];
#pragma unroll
                for (int i = 0; i < 8; ++i) *(LAS u32x4*)(kl + row * RS + hf * 128 + (i0 + i) * 8) = w[i];
            }
        }
        const size_t tok0 = (size_t)b * S + qt * 256 + wid * 32 + fr;
        u32x4 qw0[8], qw1[8];
#pragma unroll
        for (int s = 0; s < 8; ++s) { qw0[s] = *(const u32x4*)(QX + tok0 * 1024 + h * 256 + 32 * s + 8 * fq); qw1[s] = *(const u32x4*)(QX + (tok0 + 16) * 1024 + h * 256 + 32 * s + 8 * fq); }
        __syncthreads();
        bf16x8 pf0[8], pf1[8]; float inv0, inv1;
        auto s_part = [&](const u32x4 (&qw)[8], bf16x8 (&pf)[8], float& inv) __attribute__((always_inline)) {
            float ssq = 0.f;
#pragma unroll
            for (int s = 0; s < 8; ++s) {
                const float a0 = bflo(qw[s].x), a1 = bfhi(qw[s].x), a2 = bflo(qw[s].y), a3 = bfhi(qw[s].y), a4 = bflo(qw[s].z), a5 = bfhi(qw[s].z), a6 = bflo(qw[s].w), a7 = bfhi(qw[s].w);
                ssq += (a0 * a0 + a1 * a1) + (a2 * a2 + a3 * a3) + (a4 * a4 + a5 * a5) + (a6 * a6 + a7 * a7);
            }
            ssq = xadd32(xadd16(ssq));
            const float rstd = rsqrtf(ssq * (1.f / 256.f) + EPS);
            bf16x8 qf[8];
#pragma unroll
            for (int s = 0; s < 8; ++s) qf[s] = __builtin_bit_cast(bf16x8, qw[s]);
            f32x4 sc[16];
#pragma unroll
            for (int hf = 0; hf < 2; ++hf) {
                unsigned kb = (unsigned)(size_t)(kl + (128 * hf + fr) * RS + 8 * fq); asm volatile("" : "+v"(kb));
#pragma unroll
                for (int t8 = 0; t8 < 8; ++t8) { const int t = 8 * hf + t8; sc[t] = (f32x4){0.f, 0.f, 0.f, 0.f};
#pragma unroll
                    for (int s = 0; s < 8; ++s) { const bf16x8 kf = *(const LAS bf16x8*)(size_t)(kb + (unsigned)((16 * t8 * RS + 32 * s) * 2));
                        sc[t] = __builtin_amdgcn_mfma_f32_16x16x32_bf16(kf, qf[s], sc[t], 0, 0, 0); }
                    if (t & 1) asm volatile("" ::: "memory"); }
            }
            float mx = -INFINITY;
#pragma unroll
            for (int t = 0; t < 16; ++t) mx = fmaxf(mx, fmaxf(fmaxf(sc[t].x, sc[t].y), fmaxf(sc[t].z, sc[t].w)));
            mx = xmax32(xmax16(mx));
            float lsum = 0.f;
#pragma unroll
            for (int t = 0; t < 16; ++t) { sc[t].x = __expf((sc[t].x - mx) * rstd); sc[t].y = __expf((sc[t].y - mx) * rstd); sc[t].z = __expf((sc[t].z - mx) * rstd); sc[t].w = __expf((sc[t].w - mx) * rstd); lsum += (sc[t].x + sc[t].y) + (sc[t].z + sc[t].w); }
            lsum = xadd32(xadd16(lsum));
            inv = 1.f / lsum;
#pragma unroll
            for (int s = 0; s < 8; ++s) { u32x4 w; w.x = pk2(sc[2 * s].x, sc[2 * s].y); w.y = pk2(sc[2 * s].z, sc[2 * s].w); w.z = pk2(sc[2 * s + 1].x, sc[2 * s + 1].y); w.w = pk2(sc[2 * s + 1].z, sc[2 * s + 1].w);
                pf[s] = __builtin_bit_cast(bf16x8, w); }
        };
        s_part(qw0, pf0, inv0);
        s_part(qw1, pf1, inv1);
        __syncthreads();
        {
            const int row = tid >> 1, hf = tid & 1;
            const u32x4* src = (const u32x4*)(VT + ((size_t)((L * 8 + b) * 4 + h) * 256 + row) * 256 + hf * 128);
#pragma unroll
            for (int i0 = 0; i0 < 16; i0 += 8) {
                u32x4 w[8];
#pragma unroll
                for (int i = 0; i < 8; ++i) w[i] = src[i0 + i];
#pragma unroll
                for (int i = 0; i < 8; ++i) *(LAS u32x4*)(kl + row * RS + hf * 128 + (i0 + i) * 8) = w[i];
            }
        }
        __syncthreads();
#pragma unroll
        for (int hf = 0; hf < 2; ++hf) {
            unsigned vb = (unsigned)(size_t)(kl + (128 * hf + fr) * RS + 8 * fq); asm volatile("" : "+v"(vb));
#pragma unroll
            for (int n8 = 0; n8 < 8; ++n8) { const int n = 8 * hf + n8; f32x4 o0 = (f32x4){0.f, 0.f, 0.f, 0.f}, o1 = o0;
#pragma unroll
                for (int s = 0; s < 8; ++s) { const bf16x8 vf = *(const LAS bf16x8*)(size_t)(vb + (unsigned)((16 * n8 * RS + 32 * s) * 2));
                    o0 = __builtin_amdgcn_mfma_f32_16x16x32_bf16(vf, pf0[s], o0, 0, 0, 0);
                    o1 = __builtin_amdgcn_mfma_f32_16x16x32_bf16(vf, pf1[s], o1, 0, 0, 0); }
                u32x2 w0, w1; w0.x = pk2(o0.x * inv0, o0.y * inv0); w0.y = pk2(o0.z * inv0, o0.w * inv0); w1.x = pk2(o1.x * inv1, o1.y * inv1); w1.y = pk2(o1.z * inv1, o1.w * inv1);
                *(u32x2*)(OX + tok0 * 1024 + h * 256 + 16 * n + 4 * fq) = w0;
                *(u32x2*)(OX + (tok0 + 16) * 1024 + h * 256 + 16 * n + 4 * fq) = w1;
                if (n & 1) asm volatile("" ::: "memory"); }
        }
    }
    __syncthreads();
}

__device__ __forceinline__ void phase_route_mfma(KArgs A, int wv_, int L, LAS unsigned char* lds) {
    const int tid = opaque_tid(wv_), wid = __builtin_amdgcn_readfirstlane(tid >> 6), lane = tid & 63, fr = lane & 15, fq = lane >> 4;
    unsigned char* ws = opq(A->ws);
    const float* RW = (const float*)(ws + WS_RW) + (size_t)L * NEXP * D;
    unsigned* cnt = (unsigned*)(ws + WS_CTL) + CW_CNT + L * 64;
    int* list = (int*)(ws + WS_LIST); int* te = (int*)(ws + WS_TOK); int* tp = te + 2 * T; float* tw = (float*)(tp + 2 * T);
    bf16* XN = (bf16*)(ws + WS_XN);
    constexpr int WSTR = 1032;
    LAS bf16* rwh = (LAS bf16*)lds;
    LAS bf16* rwl = rwh + 16 * WSTR;
    LAS float* xch = (LAS float*)(lds + 2 * 16 * WSTR * 2);
    LAS unsigned* lcnt = (LAS unsigned*)(lds + 2 * 16 * WSTR * 2 + 8 * 320 * 4);
    LAS unsigned* lbase = lcnt + 16;
    for (int e4 = tid; e4 < NEXP * D / 4; e4 += 512) {
        const f32x4 w = *(const f32x4*)(RW + 4 * e4);
        u32x2 h; h.x = pk2(w.x, w.y); h.y = pk2(w.z, w.w);
        u32x2 l; l.x = pk2(w.x - bflo(h.x), w.y - bfhi(h.x)); l.y = pk2(w.z - bflo(h.y), w.w - bfhi(h.y));
        const int e = (4 * e4) >> 10, k = (4 * e4) & 1023;
        *(LAS u32x2*)(rwh + e * WSTR + k) = h; *(LAS u32x2*)(rwl + e * WSTR + k) = l;
    }
    const int tg = wid >> 1, kh = wid & 1;
    const float rbv = A->in[I_RB][fr];
    for (int blk = blockIdx.x; blk < T / 64; blk += gridDim.x) {
        __syncthreads();
        if (tid < 16) lcnt[tid] = 0u;
        const size_t tok = (size_t)blk * 64 + 16 * tg + fr;
        const bf16* xrow = (const bf16*)(ws + WS_X16) + tok * D + 512 * kh + 8 * fq;
        f32x4 acc = (f32x4){0.f, 0.f, 0.f, 0.f}; float ssq = 0.f;
        bf16x8 ah[16];
#pragma unroll
        for (int s = 0; s < 16; ++s) ah[s] = *(const bf16x8*)(xrow + 32 * s);
#pragma unroll
        for (int s = 0; s < 16; ++s) {
            const u32x4 hw = __builtin_bit_cast(u32x4, ah[s]);
            const float x0 = bflo(hw.x), x1 = bfhi(hw.x), x2 = bflo(hw.y), x3 = bfhi(hw.y), x4 = bflo(hw.z), x5 = bfhi(hw.z), x6 = bflo(hw.w), x7 = bfhi(hw.w);
            ssq += ((x0 * x0 + x1 * x1) + (x2 * x2 + x3 * x3)) + ((x4 * x4 + x5 * x5) + (x6 * x6 + x7 * x7));
            const bf16x8 bh = *(const LAS bf16x8*)(rwh + fr * WSTR + 512 * kh + 32 * s + 8 * fq), bl = *(const LAS bf16x8*)(rwl + fr * WSTR + 512 * kh + 32 * s + 8 * fq);
            acc = __builtin_amdgcn_mfma_f32_16x16x32_bf16(ah[s], bh, acc, 0, 0, 0);
            acc = __builtin_amdgcn_mfma_f32_16x16x32_bf16(ah[s], bl, acc, 0, 0, 0);
        }
        ssq = xadd32(xadd16(ssq));
        LAS float* mine = xch + wid * 320; const LAS float* other = xch + (wid ^ 1) * 320;
#pragma unroll
        for (int r = 0; r < 4; ++r) mine[(4 * fq + r) * 20 + fr] = acc[r];
        if (fq == 0) mine[fr * 20 + 16] = ssq;
        __syncthreads();
        const float rstd = rsqrtf((ssq + other[fr * 20 + 16]) * (1.f / 1024.f) + EPS);
        {
            bf16* xo = XN + tok * D + 512 * kh + 8 * fq;
#pragma unroll
            for (int s = 0; s < 16; ++s) { const u32x4 hw = __builtin_bit_cast(u32x4, ah[s]);
                u32x4 o; o.x = pk2(bflo(hw.x) * rstd, bfhi(hw.x) * rstd); o.y = pk2(bflo(hw.y) * rstd, bfhi(hw.y) * rstd); o.z = pk2(bflo(hw.z) * rstd, bfhi(hw.z) * rstd); o.w = pk2(bflo(hw.w) * rstd, bfhi(hw.w) * rstd);
                *(u32x4*)(xo + 32 * s) = o; }
        }
        int e0r[4], e1r[4], r0r[4], r1r[4]; float w0r[4];
        if (kh == 0) {
#pragma unroll
            for (int r = 0; r < 4; ++r) {
                const float rs = __shfl(rstd, 4 * fq + r);
                const float lg = (acc[r] + other[(4 * fq + r) * 20 + fr]) * rs + rbv;
                float v0 = lg; v0 = fmaxf(v0, __shfl_xor(v0, 1)); v0 = fmaxf(v0, __shfl_xor(v0, 2)); v0 = fmaxf(v0, __shfl_xor(v0, 4)); v0 = fmaxf(v0, __shfl_xor(v0, 8));
                const unsigned long long bm0 = __ballot(lg == v0);
                const int e0 = __ffs((unsigned)(bm0 >> (16 * fq)) & 0xffffu) - 1;
                const bool c2 = (fr >> 2) == (e0 >> 2) && fr != e0;
                const float m2 = c2 ? lg : -INFINITY;
                float v1 = m2; v1 = fmaxf(v1, __shfl_xor(v1, 1)); v1 = fmaxf(v1, __shfl_xor(v1, 2)); v1 = fmaxf(v1, __shfl_xor(v1, 4)); v1 = fmaxf(v1, __shfl_xor(v1, 8));
                const unsigned long long bm1 = __ballot(c2 && m2 == v1);
                const int e1 = __ffs((unsigned)(bm1 >> (16 * fq)) & 0xffffu) - 1;
                e0r[r] = e0; e1r[r] = e1; w0r[r] = 1.f / (1.f + __expf(v1 - v0));
                r0r[r] = 0; r1r[r] = 0;
                if (fr == 0) { r0r[r] = (int)atomicAdd((unsigned*)(lcnt + e0), 1u); r1r[r] = (int)atomicAdd((unsigned*)(lcnt + e1), 1u); }
            }
        }
        __syncthreads();
        if (tid < 16) lbase[tid] = atomicAdd(&cnt[tid], lcnt[tid]);
        __syncthreads();
        if (kh == 0 && fr == 0) {
#pragma unroll
            for (int r = 0; r < 4; ++r) {
                const int t = blk * 64 + 16 * tg + 4 * fq + r;
                const int p0 = (int)lbase[e0r[r]] + r0r[r], p1 = (int)lbase[e1r[r]] + r1r[r];
                list[e0r[r] * T + p0] = t; list[e1r[r] * T + p1] = t;
                te[2 * t] = e0r[r]; te[2 * t + 1] = e1r[r]; tp[2 * t] = p0; tp[2 * t + 1] = p1; tw[2 * t] = w0r[r]; tw[2 * t + 1] = 1.f - w0r[r];
            }
        }
    }
    __syncthreads();
}

__device__ __forceinline__ void moe_offsets(KArgs A, int wv_, int L, LAS int* off, LAS int* cn) {
    if (opaque_tid(wv_) == 0) {
        const unsigned* cnt = (const unsigned*)(opq(A->ws) + WS_CTL) + CW_CNT + L * 64;
        int o = 0;
        for (int e = 0; e < 16; ++e) { const int c = (int)__hip_atomic_load(cnt + e, __ATOMIC_RELAXED, __HIP_MEMORY_SCOPE_AGENT); off[e] = o; cn[e] = c; o += (c + 255) & ~255; }
        off[16] = o;
    }
    __syncthreads();
}
__device__ __forceinline__ void phase_moe_combine(KArgs A, int wv_, int L, LAS unsigned char* lds) {
    LAS int* off = (LAS int*)lds; LAS int* cn = off + 32;
    moe_offsets(A, wv_, L, off, cn);
    const int tid_ = opaque_tid(wv_); const int wid = __builtin_amdgcn_readfirstlane(tid_ >> 6), lane = tid_ & 63; const int gw = blockIdx.x * 8 + wid, NGW = gridDim.x * 8;
    unsigned char* ws = opq(A->ws);
    const int* te = (const int*)(ws + WS_TOK); const int* tp = te + 2 * T; const float* tw = (const float*)(tp + 2 * T);
    const bf16* Y = (const bf16*)(ws + WS_Y); bf16* XN = (bf16*)(ws + WS_XN); bf16* X16 = (bf16*)(ws + WS_X16); const bool last = L == DEPTH - 1;
    const int nq = (T - gw + NGW - 1) / NGW;
    for (int q0 = 0; q0 < nq; q0 += 8) {
        int s0m = 0, s1m = 0; float w0m = 0.f, w1m = 0.f;
        { const int qq = q0 + (lane & 7); const int t = gw + NGW * (qq < nq ? qq : nq - 1);
          s0m = off[te[2 * t]] + tp[2 * t]; s1m = off[te[2 * t + 1]] + tp[2 * t + 1]; w0m = tw[2 * t]; w1m = tw[2 * t + 1]; }
        const int nn = nq - q0 < 8 ? nq - q0 : 8;
        f32x4 v[4]; u32x2 xv[4], xn[4], ya[4], yb[4], yan[4], ybn[4];
        { const int t = gw + NGW * q0; const int sl0 = __builtin_amdgcn_readlane(s0m, 0), sl1 = __builtin_amdgcn_readlane(s1m, 0);
#pragma unroll
          for (int j = 0; j < 4; ++j) { xv[j] = ((const u32x2*)(X16 + (size_t)t * D) + lane)[64 * j]; ya[j] = ((const u32x2*)(Y + (size_t)sl0 * D) + lane)[64 * j]; yb[j] = ((const u32x2*)(Y + (size_t)sl1 * D) + lane)[64 * j]; } }
#pragma unroll 1
        for (int q = 0; q < nn; ++q) {
            const int t = gw + NGW * (q0 + q);
            const int qn = q + 1 < nn ? q + 1 : q;
            { const int tn = gw + NGW * (q0 + qn); const int sl0 = __builtin_amdgcn_readlane(s0m, qn), sl1 = __builtin_amdgcn_readlane(s1m, qn);
#pragma unroll
              for (int j = 0; j < 4; ++j) { xn[j] = ((const u32x2*)(X16 + (size_t)tn * D) + lane)[64 * j]; yan[j] = ((const u32x2*)(Y + (size_t)sl0 * D) + lane)[64 * j]; ybn[j] = ((const u32x2*)(Y + (size_t)sl1 * D) + lane)[64 * j]; } }
            const float w0 = __builtin_bit_cast(float, __builtin_amdgcn_readlane(__builtin_bit_cast(int, w0m), q)), w1 = __builtin_bit_cast(float, __builtin_amdgcn_readlane(__builtin_bit_cast(int, w1m), q));
            float s = 0.f;
#pragma unroll
            for (int j = 0; j < 4; ++j) {
                v[j].x = bflo(xv[j].x) + w0 * bflo(ya[j].x) + w1 * bflo(yb[j].x); v[j].y = bfhi(xv[j].x) + w0 * bfhi(ya[j].x) + w1 * bfhi(yb[j].x); v[j].z = bflo(xv[j].y) + w0 * bflo(ya[j].y) + w1 * bflo(yb[j].y); v[j].w = bfhi(xv[j].y) + w0 * bfhi(ya[j].y) + w1 * bfhi(yb[j].y);
                s += (v[j].x * v[j].x + v[j].y * v[j].y) + (v[j].z * v[j].z + v[j].w * v[j].w);
            }
            const float rstd = rsqrtf(wave_sum(s) * (1.f / 1024.f) + EPS);
            u32x2* o8 = (u32x2*)(XN + (size_t)t * D) + lane;
            if (last) { f32x4* xr = (f32x4*)(A->out + (size_t)t * D) + lane;
#pragma unroll
                for (int j = 0; j < 4; ++j) xr[64 * j] = v[j]; }
            else { u32x2* xr = (u32x2*)(X16 + (size_t)t * D) + lane;
#pragma unroll
                for (int j = 0; j < 4; ++j) { u32x2 w; w.x = pk2(v[j].x, v[j].y); w.y = pk2(v[j].z, v[j].w); xr[64 * j] = w; } }
#pragma unroll
            for (int j = 0; j < 4; ++j) { u32x2 w; w.x = pk2(v[j].x * rstd, v[j].y * rstd); w.y = pk2(v[j].z * rstd, v[j].w * rstd); o8[64 * j] = w; }
#pragma unroll
            for (int j = 0; j < 4; ++j) { xv[j] = xn[j]; ya[j] = yan[j]; yb[j] = ybn[j]; }
        }
    }
}

constexpr int PH_PER_EVEN = 5 + 6, PH_PER_ODD = 3 + 6;
constexpr int NPHASES = 1 + 2 * (PH_PER_EVEN + PH_PER_ODD);

__global__ void __launch_bounds__(512, 2) mk_fwd(Args Araw) {
    KArgs A0 = kargs();
    extern __shared__ __attribute__((aligned(16))) unsigned char lds_raw[];
    LAS unsigned char* lds = (LAS unsigned char*)lds_raw;
    volatile LAS unsigned* misc = (volatile LAS unsigned*)(lds + LDS_MISC);
    const int tid = threadIdx.x;
    if (tid < 16) misc[tid] = 0u;
    __syncthreads();
    const int lo = A0->ph_lo, hi = A0->ph_hi;
    const int wv_ = __builtin_amdgcn_readfirstlane(threadIdx.x >> 6);
    if (hi - lo > 1) (void)xcd_barrier_post((unsigned*)(A0->ws + WS_CTL) + CW_BAR, misc);
    int ph = 0;
    unsigned long long tacc_ = 0;
#define PH_BEGIN(k) if (ph >= lo && ph < hi) { const bool tprobe_ = (PROBE_TMASK >> (k)) & 1; unsigned long long tp0_ = 0; if (PROBE_TMASK && tprobe_) tp0_ = __builtin_amdgcn_s_memrealtime(); KArgs A = kargs(); unsigned char* ws = opq(A->ws); _Pragma("unroll 1") for (int rep_ = 0; rep_ < (((PROBE_MASK >> (k)) & 1) ? PROBE_REPS : 1); ++rep_)
#define PH_END   if (ph + 1 < hi) { XcdBarrier b_; b_.bar = (unsigned*)(opq(kargs()->ws) + WS_CTL) + CW_BAR; b_.x = xb_xcc_id(); b_.st = misc; xcd_barrier(b_, opaque_tid(wv_) == 0); } if (PROBE_TMASK && tprobe_) tacc_ += __builtin_amdgcn_s_memrealtime() - tp0_; } ++ph;
    const int G = gridDim.x, cb = blockIdx.x;

    PH_BEGIN(0) phase_prologue(A, wv_, lds); PH_END
    for (int L = 0; L < DEPTH; ++L) {
        const int i = L >> 1;
        if ((L & 1) == 0) {
            PH_BEGIN(3) {
                if (L == 0) {
                    pg8::DenseOrder S; S.init(NBATCH * NMEM, 8192, D, (const bf16*)(ws + WS_WKV), G, cb);
                    pg8::EpiBf16<0> E{(bf16*)(ws + WS_KV), 8192, 32, 0, nullptr, 0};
                    pg8::gemm_phase(lds, (const bf16*)(ws + WS_MN), D, S, E, wv_);
                }
                pg8::DenseOrder S; S.init(T, HYN, D, (const bf16*)(ws + WS_WHYB) + (size_t)i * HYN * D, G, cb);
                pg8::EpiBf16<0> E{(bf16*)(ws + WS_BIG), HYN, 12, 0, nullptr, 0};
                pg8::gemm_phase(lds, (const bf16*)(ws + WS_XN), D, S, E, wv_);
            } PH_END
            PH_BEGIN(4) { const int t4_ = opaque_tid(wv_); SUBT_BEGIN(4); SUBT_END(4, ws, t4_); SUBT_BEGIN(5); phase_compress_mfma(A, wv_, i, lds); SUBT_END(5, ws, t4_); SUBT_BEGIN(6); phase_nsa_prep(A, wv_, i, lds); SUBT_END(6, ws, t4_); SUBT_BEGIN(7); phase_vtiles(A, wv_, lds); SUBT_END(7, ws, t4_); } PH_END
            PH_BEGIN(5) { phase_gla_a(A, wv_, i, lds); __syncthreads(); phase_nsa_attn_mfma(A, wv_, i, lds); } PH_END
            PH_BEGIN(6) phase_gla_c(A, wv_, i, lds, L == 0); PH_END
            PH_BEGIN(7) {
                pg8::DenseOrder S; S.init(T, D, D, (const bf16*)(ws + WS_WHOUT) + (size_t)i * D * D, G, cb);
                pg8::EpiResAddNorm E{(bf16*)(ws + WS_X16), D, (float*)(ws + WS_ROWSQ)};
                pg8::gemm_phase(lds, (const bf16*)(ws + WS_CAT), D, S, E, wv_);
            } PH_END
        } else {
            PH_BEGIN(8) {
                pg8::DenseOrder S; S.init(T, 4096, D, (const bf16*)(ws + WS_WSGIN) + (size_t)i * 4096 * D, G, cb);
                pg8::EpiBf16<1> E{(bf16*)(ws + WS_U), 2048, 8, (size_t)(WS_V - WS_U) / 2, (float*)(ws + WS_VSTAT), 8};
                pg8::gemm_phase(lds, (const bf16*)(ws + WS_XN), D, S, E, wv_);
            } PH_END
            PH_BEGIN(9) phase_sgu_mix_mfma(A, wv_, i, lds); PH_END
            PH_BEGIN(10) {
                pg8::DenseOrder S; S.init(T, D, 2048, (const bf16*)(ws + WS_WSGOUT) + (size_t)i * D * 2048, G, cb);
                pg8::EpiResAddNorm E{(bf16*)(ws + WS_X16), D, (float*)(ws + WS_ROWSQ)};
                pg8::gemm_phase(lds, (const bf16*)(ws + WS_UM), 2048, S, E, wv_);
            } PH_END
        }
        PH_BEGIN(12) {
            pg8::DenseOrder S; S.init(T, D, D, (const bf16*)(ws + WS_WQ) + (size_t)L * D * D, G, cb);
            pg8::EpiBf16RowScale E{(bf16*)(ws + WS_QX), D, (const float*)(ws + WS_ROWSQ)};
            pg8::gemm_phase(lds, (const bf16*)(ws + WS_X16), D, S, E, wv_);
            asm volatile("s_waitcnt vmcnt(0)" ::: "memory");
            __syncthreads();
            pg8::Unit u_;
#pragma unroll 1
            for (int ui_ = 0; S.next(ui_, u_); ++ui_) xattn_item(A, wv_, L, lds, u_.pm >> 3, u_.pn, u_.pm & 7);
        } PH_END
        PH_BEGIN(14) {
            pg8::DenseOrder S; S.init(T, D, D, (const bf16*)(ws + WS_WO) + (size_t)L * D * D, G, cb);
            pg8::EpiResAdd E{(bf16*)(ws + WS_X16), D};
            pg8::gemm_phase(lds, (const bf16*)(ws + WS_OX), D, S, E, wv_);
        } PH_END
        PH_BEGIN(15) phase_route_mfma(A, wv_, L, lds); PH_END
        PH_BEGIN(16) {
            LAS int* off = (LAS int*)(lds + pg8::STAGE_BYTES); LAS int* cn = off + 32;
            moe_offsets(A, wv_, L, off, cn);
            pg8::MoeOrder<true> S{(off[16] / 256) * 3, 3, G, cb, D, off, cn, (const int*)(ws + WS_LIST), (const char*)(ws + WS_WMIN) + (size_t)L * 16 * 768 * D * 2, (size_t)768 * D * 2};
            pg8::EpiSwiglu E{(bf16*)(ws + WS_H), DEXP};
            pg8::gemm_phase(lds, (const bf16*)(ws + WS_XN), D, S, E, wv_);
        } PH_END
        PH_BEGIN(17) {
            LAS int* off = (LAS int*)(lds + pg8::STAGE_BYTES); LAS int* cn = off + 32;
            moe_offsets(A, wv_, L, off, cn);
            pg8::MoeOrder<false> S{(off[16] / 256) * 4, 4, G, cb, DEXP, off, cn, (const int*)(ws + WS_LIST), (const char*)(ws + WS_WMOUT) + (size_t)L * 16 * D * DEXP * 2, (size_t)D * DEXP * 2};
            pg8::EpiBf16<0> E{(bf16*)(ws + WS_Y), D, 4, 0, nullptr, 0};
            pg8::gemm_phase(lds, (const bf16*)(ws + WS_H), DEXP, S, E, wv_);
        } PH_END
        PH_BEGIN(18) phase_moe_combine(A, wv_, L, lds); PH_END
    }
#undef PH_BEGIN
#undef PH_END
    if (hi - lo > 1) { for (int q_ = 0; q_ < PROBE_XBAR; ++q_) { XcdBarrier b_; b_.bar = (unsigned*)(opq(kargs()->ws) + WS_CTL) + CW_BAR; b_.x = xb_xcc_id(); b_.st = misc; xcd_barrier(b_, opaque_tid(wv_) == 0); } }
    if ((PROBE_NSA || PROBE_SUB) && blockIdx.x == 0) { const unsigned long long d_ = __hip_atomic_load((unsigned long long*)(A0->ws + WS_CTL + 48000), __ATOMIC_RELAXED, __HIP_MEMORY_SCOPE_AGENT); const unsigned long long t0 = __builtin_amdgcn_s_memrealtime(); while (__builtin_amdgcn_s_memrealtime() - t0 < d_) __builtin_amdgcn_s_sleep(8); }
    if (PROBE_TMASK && blockIdx.x == 0) { const unsigned long long t0 = __builtin_amdgcn_s_memrealtime(); while (__builtin_amdgcn_s_memrealtime() - t0 < tacc_) __builtin_amdgcn_s_sleep(8); }
}

extern "C" void kernel_launch(void* const* d_in, const int* in_sizes, int n_in, void* d_out, int out_size, void* d_ws, size_t ws_size, hipStream_t stream) {
    static int grid = 0;
    if (grid == 0) {
        if (n_in != N_IN || out_size != T * D || ws_size < WS_END) { fprintf(stderr, "kernel_launch: unexpected problem (n_in %d, out %d, ws %zu)\n", n_in, out_size, ws_size); grid = -1; return; }
        int dev = 0, cus = 0, per_cu = 0;
        if (hipGetDevice(&dev) != hipSuccess || hipDeviceGetAttribute(&cus, hipDeviceAttributeMultiprocessorCount, dev) != hipSuccess) { grid = -1; return; }
        if (hipFuncSetAttribute((const void*)mk_fwd, hipFuncAttributeMaxDynamicSharedMemorySize, LDS_BYTES) != hipSuccess) { fprintf(stderr, "kernel_launch: hipFuncSetAttribute failed\n"); grid = -1; return; }
        if (hipOccupancyMaxActiveBlocksPerMultiprocessor(&per_cu, (const void*)mk_fwd, 512, LDS_BYTES) != hipSuccess || per_cu < 1) fprintf(stderr, "kernel_launch: occupancy query says %d\n", per_cu);
        (void)hipGetLastError();
        grid = cus;
    }
    if (grid < 0) return;
    (void)hipMemsetAsync((char*)d_ws + WS_CTL, 0, CTL_BYTES, stream);
    Args a{};
    for (int i = 0; i < N_IN; ++i) a.in[i] = (const float*)d_in[i];
    a.out = (float*)d_out; a.ws = (unsigned char*)d_ws;
    for (int j = 0; j < 32; ++j) a.freq[j] = (float)pow(10000.0, -(double)j / 32.0);
#if MK_ONE_LAUNCH
    a.ph_lo = 0; a.ph_hi = NPHASES;
    hipLaunchKernelGGL(mk_fwd, dim3(grid), dim3(512), LDS_BYTES, stream, a);
#else
    for (int p = 0; p < NPHASES; ++p) { a.ph_lo = p; a.ph_hi = p + 1; hipLaunchKernelGGL(mk_fwd, dim3(grid), dim3(512), LDS_BYTES, stream, a); }
#endif
}
```

```cpp
#include <hip/hip_runtime.h>
#include <stdint.h>
#include <stdio.h>
#include <math.h>

#ifndef PROBE_MASK
#define PROBE_MASK 0
#endif
#ifndef PROBE_TMASK
#define PROBE_TMASK 0
#endif
#ifndef PROBE_NSA
#define PROBE_NSA 0
#endif
#ifndef PROBE_SUB
#define PROBE_SUB 0
#endif
#ifndef PROBE_XBAR
#define PROBE_XBAR 0
#endif
#ifndef PROBE_NSAX
#define PROBE_NSAX 0
#endif
#ifndef PROBE_REPS
#define PROBE_REPS 2
#endif
#ifndef MK_ONE_LAUNCH
#define MK_ONE_LAUNCH 1
#endif

#define LAS __attribute__((address_space(3)))
typedef unsigned short bf16;
typedef short bf16x8 __attribute__((ext_vector_type(8)));
typedef float f32x4 __attribute__((ext_vector_type(4)));
typedef float f32x2 __attribute__((ext_vector_type(2)));
typedef unsigned u32x4 __attribute__((ext_vector_type(4)));
typedef unsigned u32x2 __attribute__((ext_vector_type(2)));

constexpr int T = 16384, D = 1024, NBATCH = 8, S = 2048, DEPTH = 4;
constexpr int NMEM = 256;
constexpr float EPS = 1e-6f;
constexpr int HYN = 3072, HYSRC = 2856;
constexpr int C_QA = 0, C_KC = 512, C_VC = 640, C_KS = 768, C_VS = 896, C_KW = 1024, C_VW = 1152, C_QB = 1280, C_KB = 1536, C_VB = 1792, C_RB = 2304, C_GA = 2816, C_AL = 2840;
constexpr int NCMP = 127;
constexpr int NEXP = 16, DEXP = 384;
constexpr int SLOTS = 2 * T + NEXP * 256;

enum { I_X = 0, I_MEM, I_POS, I_NMIX, I_NXAT, I_NMEM, I_NFFN, I_HYBIN, I_HYBOUT, I_QNORM, I_KNORM, I_CMPPE, I_CMPW1, I_CMPW2, I_GATEB, I_WA2, I_BA, I_ONORM,
       I_SGIN, I_LNG, I_LNB, I_SGWS, I_SGBS, I_SGOUT, I_XWQ, I_XWKV, I_XWO, I_XQN, I_XKN, I_RW, I_RB, I_MOEIN, I_MOEOUT, N_IN };

constexpr size_t MiB = 1u << 20;
constexpr size_t WS_CTL = 0, CTL_BYTES = 1 * MiB;
constexpr size_t WS_WHYB = 1 * MiB;
constexpr size_t WS_WHOUT = WS_WHYB + 12 * MiB;
constexpr size_t WS_WSGIN = WS_WHOUT + 4 * MiB;
constexpr size_t WS_WSGOUT = WS_WSGIN + 16 * MiB;
constexpr size_t WS_WQ = WS_WSGOUT + 8 * MiB;
constexpr size_t WS_WKV = WS_WQ + 8 * MiB;
constexpr size_t WS_WO = WS_WKV + 16 * MiB;
constexpr size_t WS_WMIN = WS_WO + 8 * MiB;
constexpr size_t WS_WMOUT = WS_WMIN + 96 * MiB;
constexpr size_t WS_RW = WS_WMOUT + 48 * MiB;
constexpr size_t WS_XN = WS_RW + 1 * MiB;
constexpr size_t WS_BIG = WS_XN + 32 * MiB;
constexpr size_t WS_QA = WS_BIG + 128 * MiB;
constexpr size_t WS_KS = WS_QA + 16 * MiB;
constexpr size_t WS_KW = WS_KS + 4 * MiB;
constexpr size_t WS_KC = WS_KW + 4 * MiB;
constexpr size_t WS_VC = WS_KC + 1 * MiB;
constexpr size_t WS_CAT = WS_VC + 1 * MiB;
constexpr size_t WS_QX = WS_CAT + 32 * MiB;
constexpr size_t WS_OX = WS_QX + 32 * MiB;
constexpr size_t WS_MN = WS_OX + 32 * MiB;
constexpr size_t WS_KV = WS_MN + 4 * MiB;
constexpr size_t WS_COS = WS_KV + 32 * MiB;
constexpr size_t WS_SIN = WS_COS + 2 * MiB;
constexpr size_t WS_LIST = WS_SIN + 2 * MiB;
constexpr size_t WS_TOK = WS_LIST + 1 * MiB;
constexpr size_t WS_VT = WS_TOK + 1 * MiB;
constexpr size_t WS_VTA = WS_VT + 16 * MiB;
constexpr size_t WS_SLOC = WS_VTA + 32 * MiB;
constexpr size_t WS_DEC = WS_SLOC + 32 * MiB;
constexpr size_t WS_STT = WS_DEC + 1 * MiB;
constexpr size_t WS_WSB = WS_STT + 16 * MiB;
constexpr size_t WS_M0 = WS_WSB + 768 * 1024;
constexpr size_t WS_W1T = WS_WSB + 1 * MiB;
constexpr size_t WS_ROWSQ = WS_W1T + 1 * MiB;
constexpr size_t WS_VSTAT = WS_ROWSQ + 1 * MiB;
constexpr size_t WS_X16 = WS_VSTAT + 4 * MiB;
constexpr size_t WS_END = WS_X16 + 32 * MiB;
constexpr size_t WS_Y = WS_BIG, WS_H = WS_BIG + 72 * MiB, WS_U = WS_BIG, WS_V = WS_BIG + 64 * MiB, WS_UM = WS_QX;
constexpr int CW_BAR = 4096;
constexpr int CW_CNT = 8192;

constexpr int LDS_BYTES = 159744;
constexpr int LDS_MISC = LDS_BYTES - 64;

typedef __bf16 bf16x2_t __attribute__((ext_vector_type(2)));
__device__ __forceinline__ unsigned pk2(float lo, float hi) { const f32x2 v = {lo, hi}; return __builtin_bit_cast(unsigned, __builtin_convertvector(v, bf16x2_t)); }
__device__ __forceinline__ unsigned f2bf(float f) { return (unsigned)__builtin_bit_cast(unsigned short, (__bf16)f); }
__device__ __forceinline__ float bf2f(unsigned b) { return __uint_as_float(b << 16); }
__device__ __forceinline__ float bflo(unsigned w) { return __uint_as_float(w << 16); }
__device__ __forceinline__ float bfhi(unsigned w) { return __uint_as_float(w & 0xffff0000u); }
__device__ __forceinline__ void xswap16(float v, float& a, float& b) { unsigned u = __builtin_bit_cast(unsigned, v), u2 = u; asm volatile("" : "+v"(u2));
    const u32x2 r = __builtin_amdgcn_permlane16_swap(u, u2, false, false); unsigned r0 = r[0], r1 = r[1]; asm volatile("" : "+v"(r0), "+v"(r1)); a = __builtin_bit_cast(float, r0); b = __builtin_bit_cast(float, r1); }
__device__ __forceinline__ void xswap32(float v, float& a, float& b) { unsigned u = __builtin_bit_cast(unsigned, v), u2 = u; asm volatile("" : "+v"(u2));
    const u32x2 r = __builtin_amdgcn_permlane32_swap(u, u2, false, false); unsigned r0 = r[0], r1 = r[1]; asm volatile("" : "+v"(r0), "+v"(r1)); a = __builtin_bit_cast(float, r0); b = __builtin_bit_cast(float, r1); }
__device__ __forceinline__ float xadd16(float v) { float a, b; xswap16(v, a, b); return a + b; }
__device__ __forceinline__ float xadd32(float v) { float a, b; xswap32(v, a, b); return a + b; }
__device__ __forceinline__ float xmax16(float v) { float a, b; xswap16(v, a, b); return fmaxf(a, b); }
__device__ __forceinline__ float xmax32(float v) { float a, b; xswap32(v, a, b); return fmaxf(a, b); }
__device__ __forceinline__ float wave_sum(float v) {
#pragma unroll
    for (int o = 1; o < 16; o <<= 1) v += __shfl_xor(v, o);
    return xadd32(xadd16(v));
}
__device__ __forceinline__ float wave_max(float v) {
#pragma unroll
    for (int o = 1; o < 16; o <<= 1) v = fmaxf(v, __shfl_xor(v, o));
    return xmax32(xmax16(v));
}
__device__ __forceinline__ int opaque_tid(int wv) { int l; asm volatile("v_mbcnt_lo_u32_b32 %0, -1, 0\n\tv_mbcnt_hi_u32_b32 %0, -1, %0" : "=v"(l)); return wv * 64 + l; }
__device__ __forceinline__ unsigned char* opq(unsigned char* p) { asm volatile("" : "+s"(p)); return p; }
#define LDS_WAIT() asm volatile("s_waitcnt lgkmcnt(0)" ::: "memory")
__device__ __forceinline__ float gelu_tanh(float x) {
    const float u2 = x * (1.5957691216057308f + 0.07135481283f * x * x);
    return x * __builtin_amdgcn_rcpf(1.0f + __expf(-u2));
}
__device__ __forceinline__ float sigmoidf_(float x) { return __builtin_amdgcn_rcpf(1.0f + __expf(-x)); }

#define SUBT_BEGIN(id) unsigned long long subt_##id = 0; if (PROBE_SUB == (id)) subt_##id = __builtin_amdgcn_s_memrealtime();
#define SUBT_END(id, wsp, tidv) do { if (PROBE_SUB == (id) && blockIdx.x == 0 && (tidv) == 0) atomicAdd((unsigned long long*)((wsp) + WS_CTL + 48000), __builtin_amdgcn_s_memrealtime() - subt_##id); } while (0)
#define XB_TMO      128
#define XB_XCNT(j)  (256  + 64 * (j))
#define XB_XSUB(j)  (1280 + 64 * (j))
#define XB_XGEN(j)  (2304 + 64 * (j))
#define XB_TOP      3328
#define XB_TOPGEN   3392
#define XCD_BAR_WORDS 3456
#define XB_SPIN_CAP (1u << 22)

__device__ __forceinline__ unsigned xb_ld(unsigned* p)              { return __hip_atomic_load(p, __ATOMIC_RELAXED, __HIP_MEMORY_SCOPE_AGENT); }
__device__ __forceinline__ unsigned xb_add(unsigned* p, unsigned v) { return __hip_atomic_fetch_add(p, v, __ATOMIC_RELAXED, __HIP_MEMORY_SCOPE_AGENT); }
__device__ __forceinline__ unsigned xb_xcc_id() { return (unsigned)__builtin_amdgcn_s_getreg((3 << 11) | 20) & 0xFu; }
#define XB_SPIN(cond, bar) do { unsigned _sp = 0; while (cond) { __builtin_amdgcn_s_sleep(1); \
    if ((++_sp & 255u) == 0u) { if (xb_ld(&(bar)[XB_TMO])) break; if (_sp > XB_SPIN_CAP) { atomicAdd(&(bar)[XB_TMO], 1u); break; } } } } while (0)

struct XcdBarrier { unsigned* bar; unsigned x; volatile LAS unsigned* st; };
__device__ __forceinline__ unsigned* xb_opaque(unsigned* p) { unsigned long long v = (unsigned long long)p; unsigned lo = __builtin_amdgcn_readfirstlane((unsigned)v), hi = __builtin_amdgcn_readfirstlane((unsigned)(v >> 32));
    asm volatile("" : "+s"(lo), "+s"(hi)); return (unsigned*)(((unsigned long long)hi << 32) | lo); }

__device__ __forceinline__ XcdBarrier xcd_barrier_post(unsigned* bar, volatile LAS unsigned* st) {
    XcdBarrier b; b.bar = bar; b.x = xb_xcc_id(); b.st = st;
    if (threadIdx.x == 0) (void)xb_add(&bar[XB_XCNT(b.x)], 1u);
    return b;
}
__device__ __forceinline__ void xcd_barrier_complete(unsigned* bar, unsigned x, unsigned& nloc, unsigned& nx) {
    const unsigned G = gridDim.x * gridDim.y * gridDim.z;
    unsigned sum, cnt, mine, sp = 0u;
    for (;;) {
        sum = 0u; cnt = 0u; mine = 0u;
#pragma unroll
        for (unsigned j = 0; j < 16; ++j) { const unsigned c = xb_ld(&bar[XB_XCNT(j)]); sum += c; cnt += (c > 0u) ? 1u : 0u; mine = (j == x) ? c : mine; }
        if (sum == G) break;
        __builtin_amdgcn_s_sleep(1);
        if ((++sp & 255u) == 0u) { if (xb_ld(&bar[XB_TMO])) break; if (sp > XB_SPIN_CAP) { atomicAdd(&bar[XB_TMO], 1u); break; } }
    }
    nloc = mine > 0u ? mine : 1u; nx = cnt > 0u ? cnt : 1u;
}
__device__ __forceinline__ void xcd_barrier(const XcdBarrier& b, const bool is_t0) {
    asm volatile("s_waitcnt vmcnt(0)" ::: "memory");
    __syncthreads();
    if (is_t0) {
        unsigned* bar = b.bar;
        __builtin_amdgcn_s_waitcnt(0);
        unsigned nloc = b.st[0], nx = b.st[1];
        if (nloc == 0u) { xcd_barrier_complete(bar, b.x, nloc, nx); b.st[0] = nloc; b.st[1] = nx; }
        const unsigned old = xb_add(&bar[XB_XSUB(b.x)], 1u);
        const unsigned gen = old / nloc;
        if (old + 1u == (gen + 1u) * nloc) {
            __builtin_amdgcn_fence(__ATOMIC_RELEASE, "agent");
            asm volatile("s_waitcnt vmcnt(0)" ::: "memory");
            const unsigned og = xb_add(&bar[XB_TOP], 1u);
            const unsigned tg = og / nx;
            if (og + 1u == (tg + 1u) * nx) xb_add(&bar[XB_TOPGEN], 1u);
            else XB_SPIN(xb_ld(&bar[XB_TOPGEN]) == tg, bar);
            __builtin_amdgcn_fence(__ATOMIC_ACQUIRE, "agent");
            xb_add(&bar[XB_XGEN(b.x)], 1u);
            asm volatile("s_waitcnt vmcnt(0)" ::: "memory");
        } else {
            XB_SPIN(xb_ld(&bar[XB_XGEN(b.x)]) == gen, bar);
            __builtin_amdgcn_fence(__ATOMIC_ACQUIRE, "agent");
            asm volatile("s_waitcnt vmcnt(0)" ::: "memory");
        }
    }
    __syncthreads();
}

struct Args {
    const float* in[N_IN];
    float* out;
    unsigned char* ws;
    float freq[32];
    int ph_lo, ph_hi;
};

typedef const __attribute__((address_space(4))) Args* KArgs;
__device__ __forceinline__ KArgs kargs() { KArgs p = (KArgs)__builtin_amdgcn_kernarg_segment_ptr(); asm volatile("" : "+s"(p)); return p; }

__device__ __forceinline__ void st_bf16x4(bf16* p, f32x4 v) { u32x2 w; w.x = pk2(v[0], v[1]); w.y = pk2(v[2], v[3]); *(u32x2*)p = w; }


namespace pg8 {
constexpr int BM = 256, BK = 64, HALF = 128, HTB = HALF * BK * 2, STAGE_BYTES = 8 * HTB, NXCD = 8, WGM = 8;
__host__ __device__ __forceinline__ int lds_byte(int r, int c) { const int st = (r >> 4) * 2 + (c >> 5), rr = r & 15, cc = c & 31, ob = rr * 64 + cc * 2; return st * 1024 + (ob ^ (((ob >> 9) & 1) << 5)); }
__host__ __device__ __forceinline__ void stage_rc(int b, int& R, int& C) { const int st = b / 1024, sb = b % 1024, swz = sb ^ (((sb >> 9) & 1) << 5); R = (st >> 1) * 16 + swz / 64; C = (st & 1) * 32 + (swz % 64) / 2; }
__host__ __device__ __forceinline__ int perm32(int rho) { const int n = rho >> 4, i = rho & 15; return 8 * (i >> 2) + 4 * n + (i & 3); }
struct Unit { int pm, pn, e; };
struct DenseOrder {
    static constexpr bool GATHER = false;
    int nM, nN, nwg, G, c, K; const char* Bt;
    __device__ __forceinline__ void init(int M, int N, int K_, const bf16* Bt_, int G_, int c_) { nM = M / BM; nN = N / BM; nwg = nM * nN; G = G_; c = c_; K = K_; Bt = (const char*)Bt_; }
    __device__ __forceinline__ bool next(int i, Unit& u) const {
        const long L = (long)i * G + c; if (L >= nwg) return false;
        int wgid = (int)L; { const int q = nwg / NXCD, r = nwg % NXCD, xcd = wgid % NXCD, off = wgid / NXCD; wgid = (xcd < r ? xcd * (q + 1) : r * (q + 1) + (xcd - r) * q) + off; }
        const int nig = WGM * nN, gid = wgid / nig, fm = gid * WGM, gsz = (nM - fm) < WGM ? (nM - fm) : WGM;
        u.pm = fm + ((wgid % nig) % gsz); u.pn = (wgid % nig) / gsz; u.e = 0; return true;
    }
    __device__ __forceinline__ unsigned a_voff(const Unit& u, int half, int R) const { return (unsigned)((u.pm * BM + half * HALF + R) * K) * 2u; }
    __device__ __forceinline__ const char* b_tile(const Unit& u) const { return Bt + (size_t)u.pn * BM * K * 2; }
};
template <bool GATH> struct MoeOrder {
    static constexpr bool GATHER = GATH;
    int nunits, ntn, G, c, K; const LAS int* off; const LAS int* cn; const int* list; const char* Bt; size_t estride;
    __device__ __forceinline__ bool next(int i, Unit& u) const {
        const int L = i * G + c; if (L >= nunits) return false;
        u.pm = L / ntn; u.pn = L % ntn; const int s0 = u.pm * BM; int e = 0;
#pragma unroll
        for (int q = 1; q < 16; ++q) e += (s0 >= off[q]) ? 1 : 0;
        u.e = e; return true;
    }
    __device__ __forceinline__ unsigned a_voff(const Unit& u, int half, int R) const {
        const int slot = u.pm * BM + half * HALF + R;
        const int loc = slot - off[u.e]; const int tk = list[u.e * T + (loc < cn[u.e] ? loc : 0)];
        return (unsigned)(tk * K) * 2u;
    }
    __device__ __forceinline__ const char* b_tile(const Unit& u) const { return Bt + (size_t)u.e * estride + (size_t)u.pn * BM * K * 2; }
};
__device__ __forceinline__ unsigned cvt_pk_bf16(float lo, float hi) { return pk2(lo, hi); }

template <class Epi, class Sched>
__device__ __forceinline__ void gemm_phase(LAS unsigned char* lds, const bf16* Aptr, int K, const Sched& S, const Epi& E, int wv_) {
    const int tid = opaque_tid(wv_), wid = __builtin_amdgcn_readfirstlane(tid >> 6), lane = tid & 63, wr = wid >> 2, wc = wid & 3, fr = lane & 15, fq = lane >> 4;
    const int nt = K / BK;
    int Rr[2], Cc[2]; unsigned voffA[2], voffB[2];
#pragma unroll
    for (int i = 0; i < 2; ++i) { stage_rc(tid * 16 + i * 8192, Rr[i], Cc[i]); const int Rb = Epi::PERM ? ((Rr[i] & ~31) + perm32(Rr[i] & 31)) : Rr[i];
        voffA[i] = (unsigned)(Rr[i] * K + Cc[i]) * 2u; voffB[i] = (unsigned)(Rb * K + Cc[i]) * 2u; }
    const size_t kstep = (size_t)(BK * 2);
    const size_t hstep = (size_t)HALF * K * 2;
    const size_t tstep = 2 * hstep;
    const unsigned ldsw = (unsigned)wid * 1024u;
    const int aoff = lds_byte(wr * 64 + fr, fq * 8), boff = lds_byte(wc * 32 + fr, fq * 8);
    const char* const Ab = (const char*)Aptr;
#define PG8_SA(b, h) (((b) * 2 + (h)) * HTB)
#define PG8_SB(b, h) ((4 + (b) * 2 + (h)) * HTB)
#define PG8_STAGE(bufoff, gbase, voff) do { _Pragma("unroll") for (int _i = 0; _i < 2; ++_i) \
        __builtin_amdgcn_global_load_lds((const unsigned*)((const char*)(gbase) + (voff)[_i]), (LAS unsigned*)(lds + (bufoff) + ldsw + _i * 8192), 16, 0, 0); } while (0)
#define PG8_STAGE_A(bufoff, usenext, h, kofs) do { \
        if constexpr (Sched::GATHER) { const char* gb_ = Ab + (kofs); unsigned vv_[2] = {(usenext) ? vN[h][0] : vA[h][0], (usenext) ? vN[h][1] : vA[h][1]}; PG8_STAGE(bufoff, gb_, vv_); } \
        else { const char* gb_ = ((usenext) ? nA : cA) + (size_t)(h) * hstep + (kofs); PG8_STAGE(bufoff, gb_, voffA); } } while (0)
#define PG8_LDA(dst, b, h) do { _Pragma("unroll") for (int m = 0; m < 4; ++m) _Pragma("unroll") for (int k = 0; k < 2; ++k) dst[m][k] = *(const LAS bf16x8*)(lds + PG8_SA(b, h) + aoff + m * 2048 + k * 1024); } while (0)
#define PG8_LDB(dst, b, h) do { _Pragma("unroll") for (int n = 0; n < 2; ++n) _Pragma("unroll") for (int k = 0; k < 2; ++k) dst[n][k] = *(const LAS bf16x8*)(lds + PG8_SB(b, h) + boff + n * 2048 + k * 1024); } while (0)
#define PG8_MMA(ai, bj, At, Bt) do { __builtin_amdgcn_s_setprio(1); _Pragma("unroll") for (int m = 0; m < 4; ++m) _Pragma("unroll") for (int n = 0; n < 2; ++n) _Pragma("unroll") for (int k = 0; k < 2; ++k) \
        acc[ai][bj][m][n] = __builtin_amdgcn_mfma_f32_16x16x32_bf16(Bt[n][k], At[m][k], acc[ai][bj][m][n], 0, 0, 0); __builtin_amdgcn_s_setprio(0); } while (0)
#define PG8_WAIT_V(n) asm volatile("s_waitcnt vmcnt(" #n ")" ::: "memory")
#define PG8_WAIT_L(n) asm volatile("s_waitcnt lgkmcnt(" #n ")" ::: "memory")
#define PG8_BAR __builtin_amdgcn_s_barrier()
#define PG8_SCHED __builtin_amdgcn_sched_barrier(0)
    Unit cur, nxt; int ui = 0;
    if (!S.next(0, cur)) return;
    f32x4 acc[2][2][4][2];
#pragma unroll
    for (int a = 0; a < 2; ++a)
#pragma unroll
        for (int b = 0; b < 2; ++b)
#pragma unroll
            for (int m = 0; m < 4; ++m)
#pragma unroll
                for (int n = 0; n < 2; ++n) acc[a][b][m][n] = (f32x4){0.f, 0.f, 0.f, 0.f};
    bf16x8 At[4][2], B0[2][2], B1[2][2];
    unsigned vA[2][2], vN[2][2];
    const char* cA = Ab; const char* nA = Ab;
    if constexpr (Sched::GATHER) {
#pragma unroll
        for (int h = 0; h < 2; ++h)
#pragma unroll
            for (int i = 0; i < 2; ++i) { vA[h][i] = S.a_voff(cur, h, Rr[i]) + (unsigned)Cc[i] * 2u; vN[h][i] = vA[h][i]; }
    } else { cA = Ab + (size_t)cur.pm * tstep; nA = cA; }
    const char* cB = S.b_tile(cur);
    PG8_STAGE(PG8_SB(0, 0), cB, voffB); PG8_STAGE_A(PG8_SA(0, 0), false, 0, 0); PG8_STAGE(PG8_SB(0, 1), cB + hstep, voffB); PG8_STAGE_A(PG8_SA(0, 1), false, 1, 0);
    if (wr == 1) PG8_BAR;
    PG8_WAIT_V(4); PG8_BAR;
    PG8_STAGE(PG8_SB(1, 0), cB + kstep, voffB); PG8_STAGE_A(PG8_SA(1, 0), false, 0, kstep); PG8_STAGE(PG8_SB(1, 1), cB + hstep + kstep, voffB);
    PG8_WAIT_V(6); PG8_BAR;
    for (;;) {
        const bool has_next = S.next(ui + 1, nxt);
        const char* nB = has_next ? S.b_tile(nxt) : cB;
        if constexpr (Sched::GATHER) {
#pragma unroll
            for (int h = 0; h < 2; ++h)
#pragma unroll
                for (int i = 0; i < 2; ++i) vN[h][i] = has_next ? S.a_voff(nxt, h, Rr[i]) + (unsigned)Cc[i] * 2u : vA[h][i];
        } else nA = has_next ? Ab + (size_t)nxt.pm * tstep : cA;
        for (int t = 0; t < nt; t += 2) {
            const bool last = (t == nt - 2);
            const size_t k1 = (size_t)(t + 1) * kstep, k2 = last ? 0 : (size_t)(t + 2) * kstep, k3 = k2 + kstep;
            const char* b2 = last ? nB : cB + (size_t)(t + 2) * kstep; const char* b3 = b2 + kstep;
            PG8_LDB(B0, 0, 0); PG8_SCHED; PG8_LDA(At, 0, 0); PG8_STAGE_A(PG8_SA(1, 1), false, 1, k1);
            PG8_WAIT_L(8); PG8_BAR; PG8_WAIT_L(0); PG8_MMA(0, 0, At, B0); PG8_BAR; PG8_SCHED;
            PG8_LDB(B1, 0, 1); PG8_STAGE(PG8_SB(0, 0), b2, voffB);
            PG8_BAR; PG8_WAIT_L(0); PG8_MMA(0, 1, At, B1); PG8_BAR;
            PG8_LDA(At, 0, 1); PG8_STAGE_A(PG8_SA(0, 0), last, 0, k2);
            PG8_BAR; PG8_WAIT_L(0); PG8_MMA(1, 0, At, B0); PG8_BAR; PG8_SCHED;
            PG8_STAGE(PG8_SB(0, 1), b2 + hstep, voffB);
            PG8_WAIT_V(6); PG8_BAR; PG8_MMA(1, 1, At, B1); PG8_BAR;
            PG8_LDB(B0, 1, 0); PG8_SCHED; PG8_LDA(At, 1, 0); PG8_STAGE_A(PG8_SA(0, 1), last, 1, k2);
            PG8_WAIT_L(8); PG8_BAR; PG8_WAIT_L(0); PG8_MMA(0, 0, At, B0); PG8_BAR; PG8_SCHED;
            PG8_LDB(B1, 1, 1); PG8_STAGE(PG8_SB(1, 0), b3, voffB);
            PG8_BAR; PG8_WAIT_L(0); PG8_MMA(0, 1, At, B1); PG8_BAR;
            PG8_LDA(At, 1, 1); PG8_STAGE_A(PG8_SA(1, 0), last, 0, k3);
            PG8_BAR; PG8_WAIT_L(0); PG8_MMA(1, 0, At, B0); PG8_BAR; PG8_SCHED;
            PG8_STAGE(PG8_SB(1, 1), b3 + hstep, voffB);
            PG8_WAIT_V(6); PG8_BAR; PG8_MMA(1, 1, At, B1); PG8_BAR;
        }
        E(acc, cur, wr, wc, fr, fq);
        if (!has_next) break;
#pragma unroll
        for (int a = 0; a < 2; ++a)
#pragma unroll
            for (int b = 0; b < 2; ++b)
#pragma unroll
                for (int m = 0; m < 4; ++m)
#pragma unroll
                    for (int n = 0; n < 2; ++n) acc[a][b][m][n] = (f32x4){0.f, 0.f, 0.f, 0.f};
        cur = nxt; cB = nB; cA = nA; ++ui;
        if constexpr (Sched::GATHER) {
#pragma unroll
            for (int h = 0; h < 2; ++h)
#pragma unroll
                for (int i = 0; i < 2; ++i) vA[h][i] = vN[h][i];
        }
    }
    PG8_WAIT_V(0);
    if (wr == 0) PG8_BAR;
    PG8_BAR;
#undef PG8_SA
#undef PG8_SB
#undef PG8_STAGE
#undef PG8_STAGE_A
#undef PG8_LDA
#undef PG8_LDB
#undef PG8_MMA
#undef PG8_WAIT_V
#undef PG8_WAIT_L
#undef PG8_BAR
#undef PG8_SCHED
}
template <int ACT> struct EpiBf16 {
    static constexpr bool PERM = true;
    bf16* O; int ldc; int tpt; size_t tstride; float* stats; int stat_pn0;
    __device__ __forceinline__ void operator()(const f32x4 (&acc)[2][2][4][2], const Unit& u, int wr, int wc, int fr, int fq) const {
        const int row0 = u.pm * BM + wr * 64 + fr; const int tt = u.pn / tpt; bf16* base = O + (size_t)tt * tstride; const int col0 = (u.pn - tt * tpt) * BM + wc * 32 + 8 * fq;
#pragma unroll
        for (int ai = 0; ai < 2; ++ai)
#pragma unroll
            for (int m = 0; m < 4; ++m) { bf16* rowp = base + (size_t)(row0 + ai * HALF + m * 16) * ldc + col0; float psum = 0.f, psq = 0.f;
#pragma unroll
                for (int bj = 0; bj < 2; ++bj) { f32x4 v0 = acc[ai][bj][m][0], v1 = acc[ai][bj][m][1];
                    if (ACT == 1) {
#pragma unroll
                        for (int q = 0; q < 4; ++q) { v0[q] = gelu_tanh(v0[q]); v1[q] = gelu_tanh(v1[q]); } }
                    if (ACT == 1) { psum += ((v0[0] + v0[1]) + (v0[2] + v0[3])) + ((v1[0] + v1[1]) + (v1[2] + v1[3]));
                        psq += ((v0[0] * v0[0] + v0[1] * v0[1]) + (v0[2] * v0[2] + v0[3] * v0[3])) + ((v1[0] * v1[0] + v1[1] * v1[1]) + (v1[2] * v1[2] + v1[3] * v1[3])); }
                    u32x4 w; w.x = cvt_pk_bf16(v0[0], v0[1]); w.y = cvt_pk_bf16(v0[2], v0[3]); w.z = cvt_pk_bf16(v1[0], v1[1]); w.w = cvt_pk_bf16(v1[2], v1[3]);
                    *(u32x4*)(rowp + bj * HALF) = w; }
                if (ACT == 1 && stats && u.pn >= stat_pn0) {
                    psum = xadd32(xadd16(psum)); psq = xadd32(xadd16(psq));
                    if (fq == 0) { f32x2 st2 = {psum, psq}; *(f32x2*)(stats + ((size_t)(row0 + ai * HALF + m * 16) * 32 + (u.pn - stat_pn0) * 4 + wc) * 2) = st2; } } }
    }
};
struct EpiResAdd {
    static constexpr bool PERM = false;
    bf16* X; int ldc;
    __device__ __forceinline__ void operator()(const f32x4 (&acc)[2][2][4][2], const Unit& u, int wr, int wc, int fr, int fq) const {
        const int row0 = u.pm * BM + wr * 64 + fr, col0 = u.pn * BM + wc * 32 + 4 * fq;
#pragma unroll
        for (int ai = 0; ai < 2; ++ai) {
            u32x2 x[4][2][2];
#pragma unroll
            for (int m = 0; m < 4; ++m)
#pragma unroll
                for (int bj = 0; bj < 2; ++bj)
#pragma unroll
                    for (int n = 0; n < 2; ++n) x[m][bj][n] = *(const u32x2*)(X + (size_t)(row0 + ai * HALF + m * 16) * ldc + col0 + bj * HALF + n * 16);
#pragma unroll
            for (int m = 0; m < 4; ++m)
#pragma unroll
                for (int bj = 0; bj < 2; ++bj)
#pragma unroll
                    for (int n = 0; n < 2; ++n) { const f32x4 a = acc[ai][bj][m][n]; const u32x2 xv = x[m][bj][n];
                        u32x2 w; w.x = pk2(bflo(xv.x) + a.x, bfhi(xv.x) + a.y); w.y = pk2(bflo(xv.y) + a.z, bfhi(xv.y) + a.w);
                        *(u32x2*)(X + (size_t)(row0 + ai * HALF + m * 16) * ldc + col0 + bj * HALF + n * 16) = w; }
        }
    }
};
struct EpiResAddNorm {
    static constexpr bool PERM = false;
    bf16* X; int ldc; float* rowsq;
    __device__ __forceinline__ void operator()(const f32x4 (&acc)[2][2][4][2], const Unit& u, int wr, int wc, int fr, int fq) const {
        const int row0 = u.pm * BM + wr * 64 + fr, col0 = u.pn * BM + wc * 32 + 4 * fq;
#pragma unroll
        for (int ai = 0; ai < 2; ++ai) {
            u32x2 x[4][2][2];
#pragma unroll
            for (int m = 0; m < 4; ++m)
#pragma unroll
                for (int bj = 0; bj < 2; ++bj)
#pragma unroll
                    for (int n = 0; n < 2; ++n) x[m][bj][n] = *(const u32x2*)(X + (size_t)(row0 + ai * HALF + m * 16) * ldc + col0 + bj * HALF + n * 16);
#pragma unroll
            for (int m = 0; m < 4; ++m) {
                const size_t ro = (size_t)(row0 + ai * HALF + m * 16) * ldc + col0; float ssq = 0.f;
#pragma unroll
                for (int bj = 0; bj < 2; ++bj)
#pragma unroll
                    for (int n = 0; n < 2; ++n) { const f32x4 a = acc[ai][bj][m][n]; const u32x2 xv = x[m][bj][n];
                        u32x2 w; w.x = pk2(bflo(xv.x) + a.x, bfhi(xv.x) + a.y); w.y = pk2(bflo(xv.y) + a.z, bfhi(xv.y) + a.w);
                        *(u32x2*)(X + ro + bj * HALF + n * 16) = w;
                        const float v0 = bflo(w.x), v1 = bfhi(w.x), v2 = bflo(w.y), v3 = bfhi(w.y);
                        ssq += (v0 * v0 + v1 * v1) + (v2 * v2 + v3 * v3); }
                ssq = xadd32(xadd16(ssq));
                if (fq == 0) rowsq[(size_t)(row0 + ai * HALF + m * 16) * 16 + u.pn * 4 + wc] = ssq;
            }
        }
    }
};
struct EpiBf16RowScale {
    static constexpr bool PERM = true;
    bf16* O; int ldc; const float* rowsq;
    __device__ __forceinline__ void operator()(const f32x4 (&acc)[2][2][4][2], const Unit& u, int wr, int wc, int fr, int fq) const {
        const int row0 = u.pm * BM + wr * 64 + fr, col0 = u.pn * BM + wc * 32 + 8 * fq;
#pragma unroll
        for (int ai = 0; ai < 2; ++ai) {
            float rs[4];
#pragma unroll
            for (int m = 0; m < 4; ++m) { const f32x4* p = (const f32x4*)(rowsq + (size_t)(row0 + ai * HALF + m * 16) * 16); const f32x4 a = p[0], b = p[1], c = p[2], d = p[3];
                rs[m] = rsqrtf((((a.x + a.y) + (a.z + a.w)) + ((b.x + b.y) + (b.z + b.w)) + (((c.x + c.y) + (c.z + c.w)) + ((d.x + d.y) + (d.z + d.w)))) * (1.f / 1024.f) + EPS); }
#pragma unroll
            for (int m = 0; m < 4; ++m) { bf16* rowp = O + (size_t)(row0 + ai * HALF + m * 16) * ldc + col0;
#pragma unroll
                for (int bj = 0; bj < 2; ++bj) { const f32x4 v0 = acc[ai][bj][m][0] * rs[m], v1 = acc[ai][bj][m][1] * rs[m];
                    u32x4 w; w.x = cvt_pk_bf16(v0[0], v0[1]); w.y = cvt_pk_bf16(v0[2], v0[3]); w.z = cvt_pk_bf16(v1[0], v1[1]); w.w = cvt_pk_bf16(v1[2], v1[3]);
                    *(u32x4*)(rowp + bj * HALF) = w; } }
        }
    }
};
struct EpiSwiglu {
    static constexpr bool PERM = true;
    bf16* H; int ldc;
    __device__ __forceinline__ void operator()(const f32x4 (&acc)[2][2][4][2], const Unit& u, int wr, int wc, int fr, int fq) const {
        const int row0 = u.pm * BM + wr * 64 + fr, col0 = u.pn * HALF + wc * 32 + 8 * fq;
#pragma unroll
        for (int ai = 0; ai < 2; ++ai)
#pragma unroll
            for (int m = 0; m < 4; ++m) {
                float o[8];
#pragma unroll
                for (int n = 0; n < 2; ++n)
#pragma unroll
                    for (int q = 0; q < 4; ++q) { const float g = acc[ai][0][m][n][q]; o[4 * n + q] = g * sigmoidf_(g) * acc[ai][1][m][n][q]; }
                u32x4 w; w.x = cvt_pk_bf16(o[0], o[1]); w.y = cvt_pk_bf16(o[2], o[3]); w.z = cvt_pk_bf16(o[4], o[5]); w.w = cvt_pk_bf16(o[6], o[7]);
                *(u32x4*)(H + (size_t)(row0 + ai * HALF + m * 16) * ldc + col0) = w; }
    }
};
}

__device__ __forceinline__ int hyb_colmap(int n) {
    if (n < 1280) return n;
    if (n < 1536) return 1304 + (n - 1280);
    if (n < 1792) return 1560 + (n - 1536);
    if (n < 2304) return 1816 + (n - 1792);
    if (n < 2816) return 2344 + (n - 2304);
    if (n < 2840) return 1280 + (n - 2816);
    if (n < 2856) return 2328 + (n - 2840);
    return -1;
}
__device__ __forceinline__ void tr_item(const float* __restrict__ W, int Nsrc, int K, bf16* __restrict__ Wt, const float* __restrict__ gain, int kind, int nblk, LAS float* scr, int item, int lane) {
    const int kb = item / nblk, nb = item % nblk, k0 = 64 * kb, n0 = 64 * nb;
    const int ksub = lane >> 4, n4 = lane & 15, n = n0 + 4 * n4;
    int col;
    if (kind == 0) col = n; else if (kind == 1) col = hyb_colmap(n); else { const int pn = n >> 8, r = n & 255; col = (r >> 7) * 384 + pn * 128 + (r & 127); }
    f32x4 v[16];
#pragma unroll
    for (int i = 0; i < 16; ++i) v[i] = col >= 0 ? *(const f32x4*)(W + (size_t)(k0 + 4 * i + ksub) * Nsrc + col) : (f32x4){0.f, 0.f, 0.f, 0.f};
    if (gain) {
#pragma unroll
        for (int i = 0; i < 16; ++i) v[i] = v[i] * gain[k0 + 4 * i + ksub];
    }
#pragma unroll
    for (int i = 0; i < 16; ++i) { LAS float* d = scr + (4 * i + ksub) * 65 + 4 * n4; d[0] = v[i].x; d[1] = v[i].y; d[2] = v[i].z; d[3] = v[i].w; }
    LDS_WAIT();
    const int c = lane & 7;
#pragma unroll
    for (int jx = 0; jx < 8; ++jx) {
        const int nn = (lane >> 3) + 8 * jx; const LAS float* s = scr + (8 * c) * 65 + nn;
        u32x4 o; o.x = pk2(s[0 * 65], s[1 * 65]); o.y = pk2(s[2 * 65], s[3 * 65]); o.z = pk2(s[4 * 65], s[5 * 65]); o.w = pk2(s[6 * 65], s[7 * 65]);
        *(u32x4*)(Wt + (size_t)(n0 + nn) * K + k0 + 8 * c) = o;
    }
    LDS_WAIT();
}
__device__ __forceinline__ void rms_row_to_bf16(const float* __restrict__ xrow, bf16* __restrict__ orow, bf16* __restrict__ copy, int lane) {
    const f32x4* xr = (const f32x4*)xrow + lane;
    f32x4 v[4]; float s = 0.f;
#pragma unroll
    for (int j = 0; j < 4; ++j) { v[j] = xr[64 * j]; s += (v[j].x * v[j].x + v[j].y * v[j].y) + (v[j].z * v[j].z + v[j].w * v[j].w); }
    const float rstd = rsqrtf(wave_sum(s) * (1.f / 1024.f) + EPS);
    u32x2* o8 = (u32x2*)orow + lane;
#pragma unroll
    for (int j = 0; j < 4; ++j) { u32x2 w; w.x = pk2(v[j].x * rstd, v[j].y * rstd); w.y = pk2(v[j].z * rstd, v[j].w * rstd); o8[64 * j] = w; }
    if (copy) { u32x2* c4 = (u32x2*)copy + lane;
#pragma unroll
        for (int j = 0; j < 4; ++j) { u32x2 w; w.x = pk2(v[j].x, v[j].y); w.y = pk2(v[j].z, v[j].w); c4[64 * j] = w; } }
}

__device__ __forceinline__ void moe_weight_items(KArgs A, int wv_, LAS float* scr, const int l_lo, const int l_hi, const int gw, const int NGW) {
    const int lane = opaque_tid(wv_) & 63;
    unsigned char* ws = opq(A->ws);
    constexpr int PER_L = 16 * (192 + 96);
    for (int it = gw; it < (l_hi - l_lo) * PER_L; it += NGW) {
        const int l = l_lo + it / PER_L; int r = it % PER_L;
        if (r < 16 * 192) { const int sl = l * 16 + r / 192; tr_item(A->in[I_MOEIN] + (size_t)sl * 1024 * 768, 768, 1024, (bf16*)(ws + WS_WMIN) + (size_t)sl * 768 * 1024, A->in[I_NFFN] + l * 1024, 2, 12, scr, r % 192, lane); }
        else { r -= 16 * 192; const int sl = l * 16 + r / 96; tr_item(A->in[I_MOEOUT] + (size_t)sl * 384 * 1024, 1024, 384, (bf16*)(ws + WS_WMOUT) + (size_t)sl * 1024 * 384, nullptr, 0, 16, scr, r % 96, lane); }
    }
}

__device__ __forceinline__ void phase_prologue(KArgs A, int wv_, LAS unsigned char* lds) {
    const int tid = opaque_tid(wv_), wid = __builtin_amdgcn_readfirstlane(tid >> 6), lane = tid & 63;
    const int gw = blockIdx.x * 8 + wid, NGW = gridDim.x * 8;
    LAS float* scr = (LAS float*)(lds + wid * 16640);
    unsigned char* ws = opq(A->ws);
    constexpr int N_HYB = 2 * 768, N_HOUT = 2 * 256, N_SGIN = 2 * 1024, N_SGOUT = 2 * 512, N_WQ = 4 * 256, N_WKV = 4 * 512, N_WO = 4 * 256, N_W1T = 4 * 32;
    constexpr int NITEMS = N_HYB + N_HOUT + N_SGIN + N_SGOUT + N_WQ + N_WKV + N_WO + N_W1T;
    for (int it = gw; it < NITEMS; it += NGW) {
        int r = it;
        if (r < N_HYB) { const int sl = r / 768; tr_item(A->in[I_HYBIN] + (size_t)sl * 1024 * HYSRC, HYSRC, 1024, (bf16*)(ws + WS_WHYB) + (size_t)sl * HYN * 1024, A->in[I_NMIX] + (2 * sl) * 1024, 1, 48, scr, r % 768, lane); continue; } r -= N_HYB;
        if (r < N_HOUT) { const int sl = r / 256; tr_item(A->in[I_HYBOUT] + (size_t)sl * 1024 * 1024, 1024, 1024, (bf16*)(ws + WS_WHOUT) + (size_t)sl * 1024 * 1024, nullptr, 0, 16, scr, r % 256, lane); continue; } r -= N_HOUT;
        if (r < N_SGIN) { const int sl = r / 1024; tr_item(A->in[I_SGIN] + (size_t)sl * 1024 * 4096, 4096, 1024, (bf16*)(ws + WS_WSGIN) + (size_t)sl * 4096 * 1024, A->in[I_NMIX] + (2 * sl + 1) * 1024, 0, 64, scr, r % 1024, lane); continue; } r -= N_SGIN;
        if (r < N_SGOUT) { const int sl = r / 512; tr_item(A->in[I_SGOUT] + (size_t)sl * 2048 * 1024, 1024, 2048, (bf16*)(ws + WS_WSGOUT) + (size_t)sl * 1024 * 2048, nullptr, 0, 16, scr, r % 512, lane); continue; } r -= N_SGOUT;
        if (r < N_WQ) { const int sl = r / 256; tr_item(A->in[I_XWQ] + (size_t)sl * 1024 * 1024, 1024, 1024, (bf16*)(ws + WS_WQ) + (size_t)sl * 1024 * 1024, A->in[I_NXAT] + sl * 1024, 0, 16, scr, r % 256, lane); continue; } r -= N_WQ;
        if (r < N_WKV) { const int sl = r / 512; tr_item(A->in[I_XWKV] + (size_t)sl * 1024 * 2048, 2048, 1024, (bf16*)(ws + WS_WKV) + (size_t)sl * 2048 * 1024, A->in[I_NMEM] + sl * 1024, 0, 32, scr, r % 512, lane); continue; } r -= N_WKV;
        if (r < N_WO) { const int sl = r / 256; tr_item(A->in[I_XWO] + (size_t)sl * 1024 * 1024, 1024, 1024, (bf16*)(ws + WS_WO) + (size_t)sl * 1024 * 1024, nullptr, 0, 16, scr, r % 256, lane); continue; } r -= N_WO;
        { const int sl = r / 32; tr_item(A->in[I_CMPW1] + (size_t)sl * 2048 * 64, 64, 2048, (bf16*)(ws + WS_W1T) + (size_t)sl * 64 * 2048, nullptr, 0, 1, scr, r % 32, lane); }
    }
    for (int m = gw; m < T; m += NGW) rms_row_to_bf16(A->in[I_X] + (size_t)m * D, (bf16*)(ws + WS_XN) + (size_t)m * D, (bf16*)(ws + WS_X16) + (size_t)m * D, lane);
    for (int m = gw; m < NBATCH * NMEM; m += NGW) rms_row_to_bf16(A->in[I_MEM] + (size_t)m * D, (bf16*)(ws + WS_MN) + (size_t)m * D, nullptr, lane);
    const int gt = blockIdx.x * 512 + tid, NGT = gridDim.x * 512;
    const int* pos = (const int*)A->in[I_POS];
    float* cosT = (float*)(ws + WS_COS); float* sinT = (float*)(ws + WS_SIN);
    for (int i = gt; i < T * 32; i += NGT) {
        const int t = i >> 5, j = i & 31;
        const float ang = (float)pos[t] * A->freq[j];
        const double rev = (double)ang * 0.15915494309189533577;
        const float fr = (float)(rev - rint(rev));
        cosT[i] = __builtin_amdgcn_cosf(fr); sinT[i] = __builtin_amdgcn_sinf(fr);
    }
    { bf16* WSB = (bf16*)(ws + WS_WSB); float* M0 = (float*)(ws + WS_M0); const float* wsg = A->in[I_SGWS];
      for (int e = gt; e < 2 * 8 * 128 * 128; e += NGT) { const int s = e & 127, t = (e >> 7) & 127; WSB[e] = (bf16)f2bf(s <= t ? wsg[e] : 0.f); }
      for (int e = gt; e < 2 * 8 * 128; e += NGT) { const int t = e & 127; const float* r = wsg + (size_t)e * 128; float a = 0.f; for (int s = 0; s <= t; ++s) a += r[s]; M0[e] = a; } }
    float* RW = (float*)(ws + WS_RW);
    for (int i = gt; i < DEPTH * NEXP * D; i += NGT) { const int k = i & 1023, e = (i >> 10) & 15, l = i >> 14; RW[i] = A->in[I_RW][k * NEXP + e] * A->in[I_NFFN][l * D + k]; }
}

__device__ __forceinline__ void phase_knorm(KArgs A, int wv_, const int gw, const int NGW) {
    const int tid_ = opaque_tid(wv_); const int lane = tid_ & 63;
    bf16* KV = (bf16*)(opq(A->ws) + WS_KV);
    for (int it0 = gw * 4; it0 < DEPTH * 2048 * 4; it0 += NGW * 4) {
        u32x2 w[4];
#pragma unroll
        for (int q = 0; q < 4; ++q) { const int it = it0 + q; const int h = it & 3, m = (it >> 2) & 2047, l = it >> 13; w[q] = *(const u32x2*)(KV + (size_t)m * 8192 + l * 2048 + h * 256 + 4 * lane); }
#pragma unroll
        for (int q = 0; q < 4; ++q) {
            const int it = it0 + q; const int h = it & 3, m = (it >> 2) & 2047, l = it >> 13;
            const float x0 = bflo(w[q].x), x1 = bfhi(w[q].x), x2 = bflo(w[q].y), x3 = bfhi(w[q].y);
            const float rstd = rsqrtf(wave_sum(x0 * x0 + x1 * x1 + x2 * x2 + x3 * x3) * (1.f / 256.f) + EPS) * 0.0625f;
            const f32x4 g = *(const f32x4*)(A->in[I_XKN] + l * 256 + 4 * lane) * *(const f32x4*)(A->in[I_XQN] + l * 256 + 4 * lane);
            u32x2 o; o.x = pk2(x0 * rstd * g.x, x1 * rstd * g.y); o.y = pk2(x2 * rstd * g.z, x3 * rstd * g.w);
            *(u32x2*)(KV + (size_t)m * 8192 + l * 2048 + h * 256 + 4 * lane) = o;
        }
    }
}

__device__ __forceinline__ int kpos64(int tok) { const int k = tok & 31; return (tok & 32) + 8 * ((k >> 2) & 3) + 4 * (k >> 4) + (k & 3); }
__device__ __forceinline__ int kperm64(int p) { const int fq = (p >> 3) & 3, j = p & 7; return (p & 32) + 16 * (j >> 2) + 4 * fq + (j & 3); }

__device__ __forceinline__ void phase_nsa_prep(KArgs A, int wv_, int i, LAS unsigned char* lds) {
    const int tid_ = opaque_tid(wv_); const int wid = __builtin_amdgcn_readfirstlane(tid_ >> 6), lane = tid_ & 63; const int gw = blockIdx.x * 8 + wid, NGW = gridDim.x * 8;
    unsigned char* ws = opq(A->ws);
    const bf16* HY = (const bf16*)(ws + WS_BIG);
    const float* cosT = (const float*)(ws + WS_COS); const float* sinT = (const float*)(ws + WS_SIN);
    bf16* QA = (bf16*)(ws + WS_QA); bf16* KS = (bf16*)(ws + WS_KS); bf16* KW = (bf16*)(ws + WS_KW);
    (void)lds;
    const int j8 = lane & 7, ug = lane >> 3;
    const int u1 = 8 + (ug & 3);
    const int src0 = C_QA + 64 * ug, src1 = u1 < 10 ? C_KS + 64 * (u1 - 8) : C_KW + 64 * (u1 - 10);
    const float* g0p = A->in[I_QNORM] + i * 64 + 8 * j8; const float* g1p = A->in[I_KNORM] + (i * 3 + (u1 < 10 ? 1 : 2)) * 64 + 8 * j8;
    const f32x4 g0a = *(const f32x4*)g0p, g0b = *(const f32x4*)(g0p + 4), g1a = *(const f32x4*)g1p, g1b = *(const f32x4*)(g1p + 4);
    u32x4 w0 = (u32x4){0u, 0u, 0u, 0u}, w1 = w0; f32x4 ca, cb, sa, sb;
    if (gw < T) { w0 = *(const u32x4*)(HY + (size_t)gw * HYN + src0 + 8 * j8); w1 = *(const u32x4*)(HY + (size_t)gw * HYN + src1 + 8 * j8);
        const float* cp = cosT + gw * 32 + 8 * (j8 & 3); const float* sp = sinT + gw * 32 + 8 * (j8 & 3); ca = *(const f32x4*)cp; cb = *(const f32x4*)(cp + 4); sa = *(const f32x4*)sp; sb = *(const f32x4*)(sp + 4); }
    for (int t = gw; t < T; t += NGW) {
        const int tn = t + NGW < T ? t + NGW : t;
        const u32x4 n0 = *(const u32x4*)(HY + (size_t)tn * HYN + src0 + 8 * j8), n1 = *(const u32x4*)(HY + (size_t)tn * HYN + src1 + 8 * j8);
        const float* cp = cosT + tn * 32 + 8 * (j8 & 3); const float* sp = sinT + tn * 32 + 8 * (j8 & 3);
        const f32x4 nca = *(const f32x4*)cp, ncb = *(const f32x4*)(cp + 4), nsa = *(const f32x4*)sp, nsb = *(const f32x4*)(sp + 4);
#pragma unroll
        for (int pass = 0; pass < 2; ++pass) {
            const u32x4 w = pass ? w1 : w0; const f32x4 ga = pass ? g1a : g0a, gb = pass ? g1b : g0b;
            float x[8] = {bflo(w.x), bfhi(w.x), bflo(w.y), bfhi(w.y), bflo(w.z), bfhi(w.z), bflo(w.w), bfhi(w.w)};
            float ssq = 0.f;
#pragma unroll
            for (int q = 0; q < 8; ++q) ssq += x[q] * x[q];
            ssq += __shfl_xor(ssq, 1); ssq += __shfl_xor(ssq, 2); ssq += __shfl_xor(ssq, 4);
            const float rs = rsqrtf(ssq * (1.f / 64.f) + EPS) * (pass ? 1.f : 0.125f * 1.4426950408889634f);
            const float gg[8] = {ga.x, ga.y, ga.z, ga.w, gb.x, gb.y, gb.z, gb.w}, cc[8] = {ca.x, ca.y, ca.z, ca.w, cb.x, cb.y, cb.z, cb.w}, ss[8] = {sa.x, sa.y, sa.z, sa.w, sb.x, sb.y, sb.z, sb.w};
            float o[8];
#pragma unroll
            for (int q = 0; q < 8; ++q) { const float y = x[q] * rs * gg[q]; const float pr = __shfl_xor(y, 4);
                o[q] = j8 < 4 ? y * cc[q] - pr * ss[q] : y * cc[q] + pr * ss[q]; }
            u32x4 ow; ow.x = pk2(o[0], o[1]); ow.y = pk2(o[2], o[3]); ow.z = pk2(o[4], o[5]); ow.w = pk2(o[6], o[7]);
            if (pass == 0) *(u32x4*)(QA + (size_t)t * 512 + 64 * ug + 8 * j8) = ow;
            else if (lane < 32) { bf16* dst = (u1 < 10 ? KS + (size_t)t * 128 + 64 * (u1 - 8) : KW + (size_t)t * 128 + 64 * (u1 - 10)); *(u32x4*)(dst + 8 * j8) = ow; }
        }
        w0 = n0; w1 = n1; ca = nca; cb = ncb; sa = nsa; sb = nsb;
    }
}

__device__ __forceinline__ void phase_compress_mfma(KArgs A, int wv_, int i, LAS unsigned char* lds) {
    const int tid = opaque_tid(wv_), wid = __builtin_amdgcn_readfirstlane(tid >> 6), lane = tid & 63, fr = lane & 15, fq = lane >> 4;
    unsigned char* ws = opq(A->ws);
    const bf16* HY = (const bf16*)(ws + WS_BIG);
    const float* cosT = (const float*)(ws + WS_COS); const float* sinT = (const float*)(ws + WS_SIN);
    LAS float* part = (LAS float*)lds;
    LAS float* hbuf = part + 8 * 1024;
    LAS float* obuf = hbuf + 1024;
    LAS float* w2l = obuf + 1024;
    int w2kv = -1;
    for (int it = blockIdx.x; it < 2 * 127; it += gridDim.x) {
        const int kv = it / 127, tile = it % 127;
        const float* pe = A->in[I_CMPPE] + (size_t)(i * 2 + kv) * 32 * 64;
        const float* w2 = A->in[I_CMPW2] + (size_t)(i * 2 + kv) * 64 * 64;
        const bf16* w1t = (const bf16*)(ws + WS_W1T) + (size_t)(i * 2 + kv) * 64 * 2048;
        const int coff = kv ? C_VC : C_KC;
        if (kv != w2kv) { __syncthreads(); for (int e4 = tid; e4 < 1024; e4 += 512) *(LAS f32x4*)(w2l + 4 * e4) = *(const f32x4*)(w2 + 4 * e4); w2kv = kv; }
        {
            const int R = tile * 16 + fr, g = R & 1, bn = R >> 1, n = bn % NCMP, b = bn / NCMP;
            const bf16* arow = HY + (size_t)(b * S + 16 * n) * HYN + coff + g * 64;
            f32x4 acc[4];
#pragma unroll
            for (int t = 0; t < 4; ++t) acc[t] = (f32x4){0.f, 0.f, 0.f, 0.f};
#pragma unroll 4
            for (int s = 0; s < 8; ++s) {
                const int k0 = 256 * wid + 32 * s, l = k0 >> 6, d0 = (k0 & 63) + 8 * fq;
                const u32x4 hw = *(const u32x4*)(arow + (size_t)l * HYN + d0);
                const f32x4 p0 = *(const f32x4*)(pe + l * 64 + d0), p1 = *(const f32x4*)(pe + l * 64 + d0 + 4);
                u32x4 aw; aw.x = pk2(bflo(hw.x) + p0.x, bfhi(hw.x) + p0.y); aw.y = pk2(bflo(hw.y) + p0.z, bfhi(hw.y) + p0.w); aw.z = pk2(bflo(hw.z) + p1.x, bfhi(hw.z) + p1.y); aw.w = pk2(bflo(hw.w) + p1.z, bfhi(hw.w) + p1.w);
                const bf16x8 af = __builtin_bit_cast(bf16x8, aw);
#pragma unroll
                for (int t = 0; t < 4; ++t) { const bf16x8 bfr = *(const bf16x8*)(w1t + (size_t)(16 * t + fr) * 2048 + k0 + 8 * fq);
                    acc[t] = __builtin_amdgcn_mfma_f32_16x16x32_bf16(af, bfr, acc[t], 0, 0, 0); }
            }
            __syncthreads();
#pragma unroll
            for (int t = 0; t < 4; ++t)
#pragma unroll
                for (int r = 0; r < 4; ++r) part[wid * 1024 + (4 * fq + r) * 64 + 16 * t + fr] = acc[t][r];
        }
        __syncthreads();
        for (int e = tid; e < 1024; e += 512) { float a = 0.f;
#pragma unroll
            for (int w = 0; w < 8; ++w) a += part[w * 1024 + e];
            hbuf[e] = gelu_tanh(a); }
        __syncthreads();
        for (int e = tid; e < 1024; e += 512) { const int r = e >> 6, j = e & 63; float o = 0.f;
#pragma unroll 8
            for (int m = 0; m < 64; ++m) o += hbuf[r * 64 + m] * w2l[m * 64 + j];
            obuf[e] = o; }
        __syncthreads();
        for (int r = wid; r < 16; r += 8) {
            const int R = tile * 16 + r, g = R & 1, bn = R >> 1, n = bn % NCMP, b = bn / NCMP;
            const float o = obuf[r * 64 + lane];
            if (kv == 0) {
                const float y = o * rsqrtf(wave_sum(o * o) * (1.f / 64.f) + EPS) * A->in[I_KNORM][(i * 3 + 0) * 64 + lane];
                const int tp = b * S + 16 * n + 31;
                const float c = cosT[tp * 32 + (lane & 31)], sn = sinT[tp * 32 + (lane & 31)];
                const float pr = __shfl_xor(y, 32);
                const float oo = lane < 32 ? y * c - pr * sn : y * c + pr * sn;
                ((bf16*)(ws + WS_KC))[((size_t)(b * 128 + n) * 2 + g) * 64 + lane] = (bf16)f2bf(oo);
            } else {
                bf16* vct = (bf16*)(ws + WS_VC) + ((size_t)(b * 2 + g) * 64 + lane) * 128;
                vct[(n & 64) + kpos64(n & 63)] = (bf16)f2bf(o);
                if (n == 126) vct[127] = 0;
            }
        }
    }
    __syncthreads();
}

__device__ __forceinline__ void nsa_softmax(f32x4 (&sc)[4], bf16x8 (&pf)[2], float& mrun, float& lrun, f32x4 (&o)[4], const bool rowok, const bool edge, const int kphi, const int kplo, const bool allrows, const int fq) {
    float bm = -INFINITY;
    if (edge) {
#pragma unroll
        for (int t = 0; t < 4; ++t)
#pragma unroll
            for (int r = 0; r < 4; ++r) { const int kp = 16 * t + 4 * fq + r; const bool v = rowok && kp <= kphi && kp >= kplo; sc[t][r] = v ? sc[t][r] : -INFINITY; bm = fmaxf(bm, sc[t][r]); }
    } else {
#pragma unroll
        for (int t = 0; t < 4; ++t) bm = fmaxf(bm, fmaxf(fmaxf(sc[t].x, sc[t].y), fmaxf(sc[t].z, sc[t].w)));
        if (!allrows) bm = rowok ? bm : -INFINITY;
    }
    bm = xmax32(xmax16(bm));
    const float mn = fmaxf(mrun, bm); const float mns = mn == -INFINITY ? 0.f : mn;
    float rs = 0.f;
#pragma unroll
    for (int t = 0; t < 4; ++t)
#pragma unroll
        for (int r = 0; r < 4; ++r) { sc[t][r] = __builtin_amdgcn_exp2f(sc[t][r] - mns); rs += sc[t][r]; }
    if (!edge && !allrows) {
#pragma unroll
        for (int t = 0; t < 4; ++t) sc[t] = rowok ? sc[t] : (f32x4){0.f, 0.f, 0.f, 0.f};
        rs = rowok ? rs : 0.f;
    }
    rs = xadd32(xadd16(rs));
    if (__all(mn == mrun)) { lrun += rs; }
    else {
        const float alpha = __builtin_amdgcn_exp2f(mrun - mns);
        lrun = lrun * alpha + rs; mrun = mn;
#pragma unroll
        for (int n = 0; n < 4; ++n) o[n] = o[n] * alpha;
    }
#pragma unroll
    for (int s = 0; s < 2; ++s) { u32x4 w; w.x = pk2(sc[2 * s].x, sc[2 * s].y); w.y = pk2(sc[2 * s].z, sc[2 * s].w); w.z = pk2(sc[2 * s + 1].x, sc[2 * s + 1].y); w.w = pk2(sc[2 * s + 1].z, sc[2 * s + 1].w);
        pf[s] = __builtin_bit_cast(bf16x8, w); }
}

__device__ __forceinline__ void phase_nsa_attn_mfma(KArgs A, int wv_, int i, LAS unsigned char* lds) {
    const int wid = wv_;
    unsigned char* ws = opq(A->ws);
    const bf16* HY = (const bf16*)(ws + WS_BIG); const bf16* QA = (const bf16*)(ws + WS_QA); const bf16* KS = (const bf16*)(ws + WS_KS); const bf16* KW = (const bf16*)(ws + WS_KW);
    const bf16* KC = (const bf16*)(ws + WS_KC); const bf16* VCT = (const bf16*)(ws + WS_VC); const bf16* VTA = (const bf16*)(ws + WS_VTA); bf16* CAT = (bf16*)(ws + WS_CAT);
    constexpr int RS = 72;
    LAS bf16* ktl = (LAS bf16*)lds;
    LAS bf16* vtl = ktl + 4 * 64 * RS;
    LAS float* scl = (LAS float*)(lds + 73728) + wid * 256;
    LAS unsigned* msk = (LAS unsigned*)(lds + 73728 + 8192);
    LAS unsigned* umask = msk + 64;
    const float* gb = A->in[I_GATEB] + i * 24;
    unsigned long long tsub = 0, tt0 = 0;
    for (int pit = blockIdx.x; pit < 256; pit += gridDim.x) {
#pragma unroll 1
        for (int hf = 0; hf < 2; ++hf) {
            const int tid = opaque_tid(wv_), lane = tid & 63, fr = lane & 15, fq = lane >> 4;
            const int bg = pit >> 4, xx = pit & 15, x = hf ? 31 - xx : xx, b = bg >> 1, g = bg & 1;
            const size_t tokbase = (size_t)b * S + 64 * x;
            const int tl0 = 8 * wid + (fr >> 2);
            if (tid == 0) *umask = 0u;
            if (PROBE_NSA == 1) tt0 = __builtin_amdgcn_s_memrealtime();
            bf16x8 qf[2][2];
#pragma unroll
            for (int mt = 0; mt < 2; ++mt)
#pragma unroll
                for (int s = 0; s < 2; ++s) qf[mt][s] = *(const bf16x8*)(QA + (tokbase + tl0 + 4 * mt) * 512 + (g * 4 + (fr & 3)) * 64 + 32 * s + 8 * fq);
            f32x4 outacc[2][4];
            {
                const int tmaxc = (4 * x + 3 + 15) >> 4;
                const bf16* kcb = KC + ((size_t)(b * 128 + fr) * 2 + g) * 64 + 8 * fq;
                bf16x8 pcf[2][4];
#pragma unroll
                for (int mt = 0; mt < 2; ++mt) {
                    f32x4 sc[8];
                    const bf16* kp = kcb;
#pragma unroll
                    for (int t = 0; t < 8; ++t) { sc[t] = (f32x4){0.f, 0.f, 0.f, 0.f};
                        asm volatile("" : "+v"(kp));
                        if (t < tmaxc) {
                            const bf16x8 k0 = *(const bf16x8*)(kp), k1 = *(const bf16x8*)(kp + 32);
                            sc[t] = __builtin_amdgcn_mfma_f32_16x16x32_bf16(k0, qf[mt][0], sc[t], 0, 0, 0);
                            sc[t] = __builtin_amdgcn_mfma_f32_16x16x32_bf16(k1, qf[mt][1], sc[t], 0, 0, 0); }
                        kp += 16 * 128; }
                    const int tg = 64 * x + tl0 + 4 * mt; const int ncv = tg >= 31 ? ((tg - 31) >> 4) + 1 : 0;
                    float mx = -INFINITY;
#pragma unroll
                    for (int t = 0; t < 8; ++t)
#pragma unroll
                        for (int r = 0; r < 4; ++r) { const bool v = 16 * t + 4 * fq + r < ncv; sc[t][r] = v ? sc[t][r] : -INFINITY; mx = fmaxf(mx, sc[t][r]); }
                    mx = xmax32(xmax16(mx));
                    const float mxs = mx == -INFINITY ? 0.f : mx;
                    float sum = 0.f;
#pragma unroll
                    for (int t = 0; t < 8; ++t)
#pragma unroll
                        for (int r = 0; r < 4; ++r) { sc[t][r] = __builtin_amdgcn_exp2f(sc[t][r] - mxs); sum += sc[t][r]; }
                    sum = xadd32(xadd16(sum));
                    const float inv = sum > 0.f ? 1.f / sum : 0.f;
#pragma unroll
                    for (int t = 0; t < 8; ++t) sc[t] = sc[t] * inv;
#pragma unroll
                    for (int s = 0; s < 4; ++s) { u32x4 w; w.x = pk2(sc[2 * s].x, sc[2 * s].y); w.y = pk2(sc[2 * s].z, sc[2 * s].w); w.z = pk2(sc[2 * s + 1].x, sc[2 * s + 1].y); w.w = pk2(sc[2 * s + 1].z, sc[2 * s + 1].w);
                        pcf[mt][s] = __builtin_bit_cast(bf16x8, w); }
                    float w3[8];
#pragma unroll
                    for (int t = 0; t < 8; ++t) {
#pragma unroll
                        for (int r = 0; r < 4; ++r) { float v = sc[t][r]; v += __shfl_xor(v, 1); v += __shfl_xor(v, 2); sc[t][r] = v; }
                        w3[t] = __shfl(sc[t].w, (lane + 48) & 63);
                    }
#pragma unroll
                    for (int t = 0; t < 8; ++t) {
                        const float prev = fq > 0 ? w3[t] : (t > 0 ? w3[t > 0 ? t - 1 : 0] : 0.f);
                        const float imp = sc[t].x + sc[t].y + sc[t].z + 0.5f * sc[t].w + 0.5f * prev;
                        if ((fr & 3) == 0) scl[(4 * mt + (fr >> 2)) * 32 + 4 * t + fq] = imp;
                    }
                    asm volatile("" ::: "memory");
                }
                const bf16* vcb = VCT + ((size_t)(b * 2 + g) * 64 + fr) * 128 + 8 * fq;
#pragma unroll
                for (int n = 0; n < 4; ++n) {
                    outacc[0][n] = (f32x4){0.f, 0.f, 0.f, 0.f}; outacc[1][n] = (f32x4){0.f, 0.f, 0.f, 0.f};
                    asm volatile("" : "+v"(vcb));
#pragma unroll
                    for (int s = 0; s < 4; ++s) if (2 * s < tmaxc) {
                        const bf16x8 vf = *(const bf16x8*)(vcb + 32 * s);
                        outacc[0][n] = __builtin_amdgcn_mfma_f32_16x16x32_bf16(vf, pcf[0][s], outacc[0][n], 0, 0, 0);
                        outacc[1][n] = __builtin_amdgcn_mfma_f32_16x16x32_bf16(vf, pcf[1][s], outacc[1][n], 0, 0, 0); }
                    vcb += 16 * 128;
                    asm volatile("" ::: "memory");
                }
            }
            float g1v[2], g2v[2];
#pragma unroll
            for (int mt = 0; mt < 2; ++mt) {
                const int head = g * 4 + (fr & 3);
                const bf16* gl = HY + (tokbase + tl0 + 4 * mt) * HYN + C_GA + head * 3;
                const float g0 = sigmoidf_(bf2f(gl[0]) + gb[head * 3 + 0]);
                g1v[mt] = sigmoidf_(bf2f(gl[1]) + gb[head * 3 + 1]); g2v[mt] = sigmoidf_(bf2f(gl[2]) + gb[head * 3 + 2]);
#pragma unroll
                for (int n = 0; n < 4; ++n) outacc[mt][n] = outacc[mt][n] * g0;
            }
            LDS_WAIT();
            asm volatile("" ::: "memory");
            {
                const int tok8 = lane >> 3, jg = lane & 7;
                float sj[32];
#pragma unroll
                for (int q = 0; q < 8; ++q) { const f32x4 v = *(const LAS f32x4*)(scl + tok8 * 32 + 4 * q); sj[4 * q] = v.x; sj[4 * q + 1] = v.y; sj[4 * q + 2] = v.z; sj[4 * q + 3] = v.w; }
#pragma unroll
                for (int j = 0; j < 32; ++j) sj[j] = j <= x ? sj[j] + ((j == 0 || j == x || j == x - 1) ? 1000.0f : 0.f) : -INFINITY;
                unsigned bits = 0u;
                const f32x4 mv = *(const LAS f32x4*)(scl + tok8 * 32 + 4 * jg);
#pragma unroll
                for (int q = 0; q < 4; ++q) {
                    const int j = 4 * jg + q;
                    const float mine = j <= x ? mv[q] + ((j == 0 || j == x || j == x - 1) ? 1000.0f : 0.f) : -INFINITY;
                    int rank = 0;
#pragma unroll
                    for (int jj = 0; jj < 32; ++jj) rank += (sj[jj] > mine || (sj[jj] == mine && jj < j)) ? 1 : 0;
                    bits |= (j <= x && rank < 8) ? (1u << j) : 0u;
                }
                bits |= __shfl_xor(bits, 1); bits |= __shfl_xor(bits, 2); bits |= __shfl_xor(bits, 4);
                if (jg == 0) { msk[wid * 8 + tok8] = bits; atomicOr((unsigned*)umask, bits); }
            }
            __syncthreads();
            if (PROBE_NSA == 1) tsub += __builtin_amdgcn_s_memrealtime() - tt0;
#pragma unroll 1
            for (int pp = 0; pp < 2 + (PROBE_NSAX ? 1 : 0); ++pp) {
                const int pass = pp == 2 ? 0 : pp; const bool dummy = pp == 2;
                if (PROBE_NSA == 2 + pass) tt0 = __builtin_amdgcn_s_memrealtime();
                const int jlo = pass ? (x >= 4 ? x - 4 : 0) : 0;
                const unsigned inrange = (x >= 31 ? 0xffffffffu : ((2u << x) - 1u)) & ~((1u << jlo) - 1u);
                unsigned bmask = pass ? inrange : (*umask & inrange);
                const bf16* Kb = pass ? KW : KS; const int cg = (pass ? 10 : 8) + g;
                unsigned tm[2], wm[2], am[2];
#pragma unroll
                for (int mt = 0; mt < 2; ++mt) {
                    tm[mt] = pass ? 0xffffffffu : msk[wid * 8 + 4 * mt + (fr >> 2)];
                    wm[mt] = pass ? 0xffffffffu : (msk[wid * 8 + 4 * mt] | msk[wid * 8 + 4 * mt + 1] | msk[wid * 8 + 4 * mt + 2] | msk[wid * 8 + 4 * mt + 3]);
                    am[mt] = pass ? 0xffffffffu : (msk[wid * 8 + 4 * mt] & msk[wid * 8 + 4 * mt + 1] & msk[wid * 8 + 4 * mt + 2] & msk[wid * 8 + 4 * mt + 3]);
                    wm[mt] = __builtin_amdgcn_readfirstlane(wm[mt]); am[mt] = __builtin_amdgcn_readfirstlane(am[mt]);
                    if (PROBE_NSAX == 2 && dummy) wm[mt] = 0u;
                }
                f32x4 o[2][4]; float mrun[2], lrun[2];
#pragma unroll
                for (int mt = 0; mt < 2; ++mt) { mrun[mt] = -INFINITY; lrun[mt] = 0.f;
#pragma unroll
                    for (int n = 0; n < 4; ++n) o[mt][n] = (f32x4){0.f, 0.f, 0.f, 0.f}; }
                const int srow = tid >> 3, sc16 = tid & 7;
                u32x4 pk0 = (u32x4){0u, 0u, 0u, 0u}, pv0 = pk0, pk1 = pk0, pv1 = pk0;
#define NSA_LD(jx, pk, pv) do { const bf16* ksrc = Kb + ((size_t)b * S + 64 * (jx) + srow) * 128 + g * 64 + sc16 * 8; const bf16* vsrc = VTA + ((size_t)((b * 32 + (jx)) * 12 + cg)) * 4096 + srow * 64 + sc16 * 8; \
                    pk = *(const u32x4*)ksrc; pv = *(const u32x4*)vsrc; } while (0)
                int j0 = __ffs(bmask) - 1; bmask &= bmask - 1u;
                int j1 = bmask ? __ffs(bmask) - 1 : -1; bmask &= bmask - 1u;
                NSA_LD(j0, pk0, pv0); if (j1 >= 0) NSA_LD(j1, pk1, pv1);
                int buf = 0;
                while (j0 >= 0) {
                    *(LAS u32x4*)(ktl + (buf * 2 + 0) * 64 * RS + srow * RS + sc16 * 8) = pk0; *(LAS u32x4*)(vtl + (buf * 2 + 0) * 64 * RS + srow * RS + sc16 * 8) = pv0;
                    if (j1 >= 0) { *(LAS u32x4*)(ktl + (buf * 2 + 1) * 64 * RS + srow * RS + sc16 * 8) = pk1; *(LAS u32x4*)(vtl + (buf * 2 + 1) * 64 * RS + srow * RS + sc16 * 8) = pv1; }
                    const int jn0 = bmask ? __ffs(bmask) - 1 : -1; bmask &= bmask - 1u;
                    const int jn1 = bmask ? __ffs(bmask) - 1 : -1; bmask &= bmask - 1u;
                    if (jn0 >= 0) NSA_LD(jn0, pk0, pv0);
                    if (jn1 >= 0) NSA_LD(jn1, pk1, pv1);
                    __syncthreads();
#pragma unroll 1
                    for (int sub = 0; sub < 2; ++sub) {
                        const int j = sub ? j1 : j0;
                        if (j < 0) break;
                        const LAS bf16* kt = ktl + (buf * 2 + sub) * 64 * RS + fr * RS + 8 * fq; const LAS bf16* vt = vtl + (buf * 2 + sub) * 64 * RS + fr * RS + 8 * fq;
                        const bool nd0 = (wm[0] >> j) & 1u, nd1 = (wm[1] >> j) & 1u;
                        if (!(nd0 || nd1)) continue;
                        const bool edge = (j == x) || (pass && j == x - 4);
                        f32x4 sc0[4], sc1[4];
#pragma unroll
                        for (int t = 0; t < 4; ++t) { sc0[t] = (f32x4){0.f, 0.f, 0.f, 0.f}; sc1[t] = (f32x4){0.f, 0.f, 0.f, 0.f};
                            const bf16x8 k0_ = *(const LAS bf16x8*)(kt + t * 16 * RS), k1_ = *(const LAS bf16x8*)(kt + t * 16 * RS + 32);
                            if (nd0) { sc0[t] = __builtin_amdgcn_mfma_f32_16x16x32_bf16(k0_, qf[0][0], sc0[t], 0, 0, 0); sc0[t] = __builtin_amdgcn_mfma_f32_16x16x32_bf16(k1_, qf[0][1], sc0[t], 0, 0, 0); }
                            if (nd1) { sc1[t] = __builtin_amdgcn_mfma_f32_16x16x32_bf16(k0_, qf[1][0], sc1[t], 0, 0, 0); sc1[t] = __builtin_amdgcn_mfma_f32_16x16x32_bf16(k1_, qf[1][1], sc1[t], 0, 0, 0); } }
                        bf16x8 pf0[2], pf1[2];
                        if (nd0) nsa_softmax(sc0, pf0, mrun[0], lrun[0], o[0], (tm[0] >> j) & 1u, edge, j == x ? tl0 : 63, (pass && j == x - 4) ? tl0 + 1 : 0, (am[0] >> j) & 1u, fq);
                        if (nd1) nsa_softmax(sc1, pf1, mrun[1], lrun[1], o[1], (tm[1] >> j) & 1u, edge, j == x ? tl0 + 4 : 63, (pass && j == x - 4) ? tl0 + 5 : 0, (am[1] >> j) & 1u, fq);
#pragma unroll
                        for (int n = 0; n < 4; ++n) {
                            const bf16x8 v0_ = *(const LAS bf16x8*)(vt + n * 16 * RS), v1_ = *(const LAS bf16x8*)(vt + n * 16 * RS + 32);
                            if (nd0) { o[0][n] = __builtin_amdgcn_mfma_f32_16x16x32_bf16(v0_, pf0[0], o[0][n], 0, 0, 0); o[0][n] = __builtin_amdgcn_mfma_f32_16x16x32_bf16(v1_, pf0[1], o[0][n], 0, 0, 0); }
                            if (nd1) { o[1][n] = __builtin_amdgcn_mfma_f32_16x16x32_bf16(v0_, pf1[0], o[1][n], 0, 0, 0); o[1][n] = __builtin_amdgcn_mfma_f32_16x16x32_bf16(v1_, pf1[1], o[1][n], 0, 0, 0); } }
                    }
                    j0 = jn0; j1 = jn1; buf ^= 1;
                }
#undef NSA_LD
#pragma unroll
                for (int mt = 0; mt < 2; ++mt) { const float sc_ = (pass ? g2v[mt] : g1v[mt]) / lrun[mt];
                    if (!dummy) {
#pragma unroll
                    for (int n = 0; n < 4; ++n) outacc[mt][n] = outacc[mt][n] + o[mt][n] * sc_; } }
                __syncthreads();
                if (PROBE_NSA == 2 + pass) tsub += __builtin_amdgcn_s_memrealtime() - tt0;
            }
#pragma unroll
            for (int mt = 0; mt < 2; ++mt) {
                bf16* dst = CAT + (tokbase + tl0 + 4 * mt) * 1024 + (g * 4 + (fr & 3)) * 64 + 4 * fq;
#pragma unroll
                for (int n = 0; n < 4; ++n) { u32x2 w; w.x = pk2(outacc[mt][n].x, outacc[mt][n].y); w.y = pk2(outacc[mt][n].z, outacc[mt][n].w); *(u32x2*)(dst + 16 * n) = w; }
            }
        }
    }
    __syncthreads();
    if (PROBE_NSA && blockIdx.x == 0 && opaque_tid(wv_) == 0) atomicAdd((unsigned long long*)(ws + WS_CTL + 48000), tsub);
}

__device__ __forceinline__ void phase_vtiles(KArgs A, int wv_, LAS unsigned char* lds) {
    const int tid_ = opaque_tid(wv_); const int wid = __builtin_amdgcn_readfirstlane(tid_ >> 6), lane = tid_ & 63; const int gw = blockIdx.x * 8 + wid, NGW = gridDim.x * 8;
    unsigned char* ws = opq(A->ws);
    const bf16* HY = (const bf16*)(ws + WS_BIG); bf16* VTA = (bf16*)(ws + WS_VTA);
    constexpr int TS = 66;
    LAS bf16* tl = (LAS bf16*)(lds + 65536) + wid * (64 * TS);
    for (int it = gw; it < NBATCH * 32 * 12; it += NGW) {
        const int cg = it % 12, bc = it / 12;
        const int colbase = cg < 8 ? C_VB + cg * 64 : (cg < 10 ? C_VS + (cg - 8) * 64 : C_VW + (cg - 10) * 64);
        const u32x4* src = (const u32x4*)(HY + (size_t)(bc * 64 + lane) * HYN + colbase);
        u32x4 w[8];
#pragma unroll
        for (int i = 0; i < 8; ++i) w[i] = src[i];
#pragma unroll
        for (int i = 0; i < 8; ++i) { LAS unsigned* d = (LAS unsigned*)(tl + lane * TS + 8 * i); d[0] = w[i].x; d[1] = w[i].y; d[2] = w[i].z; d[3] = w[i].w; }
        LDS_WAIT();
        bf16* dst = VTA + (size_t)it * 4096 + lane * 64;
#pragma unroll
        for (int p8 = 0; p8 < 8; ++p8) {
            unsigned short x[8];
#pragma unroll
            for (int j = 0; j < 8; ++j) x[j] = tl[kperm64(p8 * 8 + j) * TS + lane];
            u32x4 o; o.x = x[0] | ((unsigned)x[1] << 16); o.y = x[2] | ((unsigned)x[3] << 16); o.z = x[4] | ((unsigned)x[5] << 16); o.w = x[6] | ((unsigned)x[7] << 16);
            *(u32x4*)(dst + p8 * 8) = o;
        }
        LDS_WAIT();
    }
}

__device__ __forceinline__ void vtrans_wave(KArgs A, int wv_, LAS bf16* tl, const int gw, const int NGW) {
    const int tid_ = opaque_tid(wv_); const int lane = tid_ & 63;
    unsigned char* ws = opq(A->ws);
    const bf16* KV = (const bf16*)(ws + WS_KV); bf16* VT = (bf16*)(ws + WS_VT);
    constexpr int TS = 66;
    for (int it = gw; it < DEPTH * NBATCH * 4 * 16; it += NGW) {
        const int db = it & 3, kb = (it >> 2) & 3, h = (it >> 4) & 3, b = (it >> 6) & 7, l = it >> 9;
        const u32x4* src = (const u32x4*)(KV + (size_t)(b * 256 + 64 * kb + lane) * 8192 + l * 2048 + 1024 + h * 256 + 64 * db);
        u32x4 w[8];
#pragma unroll
        for (int i = 0; i < 8; ++i) w[i] = src[i];
#pragma unroll
        for (int i = 0; i < 8; ++i) { LAS unsigned* d = (LAS unsigned*)(tl + lane * TS + 8 * i); d[0] = w[i].x; d[1] = w[i].y; d[2] = w[i].z; d[3] = w[i].w; }
        LDS_WAIT();
        bf16* dst = VT + ((size_t)((l * 8 + b) * 4 + h) * 256 + 64 * db + lane) * 256 + 64 * kb;
#pragma unroll
        for (int p8 = 0; p8 < 8; ++p8) {
            unsigned short x[8];
#pragma unroll
            for (int j = 0; j < 8; ++j) x[j] = tl[kperm64(p8 * 8 + j) * TS + lane];
            u32x4 o; o.x = x[0] | ((unsigned)x[1] << 16); o.y = x[2] | ((unsigned)x[3] << 16); o.z = x[4] | ((unsigned)x[5] << 16); o.w = x[6] | ((unsigned)x[7] << 16);
            *(u32x4*)(dst + p8 * 8) = o;
        }
        LDS_WAIT();
    }
}

__device__ __forceinline__ float log_sigmoid16(float z) { return (fminf(z, 0.f) - __logf(1.0f + __expf(-fabsf(z)))) * (1.f / 16.f); }
#define GLA_Z(tokv) ({ float z_ = bias; _Pragma("unroll") for (int r_ = 0; r_ < 16; ++r_) z_ += __builtin_bit_cast(float, __builtin_amdgcn_readlane(__builtin_bit_cast(int, al[r_]), (tokv))) * wc[r_]; z_; })
#define GLA_LOAD_GATE() \
    float al[16], wc[16]; \
    { const u32x4* ap_ = (const u32x4*)(HY + (size_t)(tok0 + lane) * HYN + C_AL); const u32x4 a0_ = ap_[0], a1_ = ap_[1]; \
      al[0] = bflo(a0_.x); al[1] = bfhi(a0_.x); al[2] = bflo(a0_.y); al[3] = bfhi(a0_.y); al[4] = bflo(a0_.z); al[5] = bfhi(a0_.z); al[6] = bflo(a0_.w); al[7] = bfhi(a0_.w); \
      al[8] = bflo(a1_.x); al[9] = bfhi(a1_.x); al[10] = bflo(a1_.y); al[11] = bfhi(a1_.y); al[12] = bflo(a1_.z); al[13] = bfhi(a1_.z); al[14] = bflo(a1_.w); al[15] = bfhi(a1_.w); } \
    _Pragma("unroll") for (int r_ = 0; r_ < 16; ++r_) wc[r_] = A->in[I_WA2][(i * 16 + r_) * 256 + h * 64 + lane]; \
    const float bias = A->in[I_BA][i * 256 + h * 64 + lane];

__device__ __forceinline__ void phase_gla_a(KArgs A, int wv_, int i, LAS unsigned char* lds) {
    const int tid_ = opaque_tid(wv_); const int wid = __builtin_amdgcn_readfirstlane(tid_ >> 6), lane = tid_ & 63, fr = lane & 15, fq = lane >> 4; const int gw = blockIdx.x * 8 + wid, NGW = gridDim.x * 8;
    unsigned char* ws = opq(A->ws);
    const bf16* HY = (const bf16*)(ws + WS_BIG); const bf16* VTA = (const bf16*)(ws + WS_VTA); float* SLOC = (float*)(ws + WS_SLOC); float* DEC = (float*)(ws + WS_DEC);
    constexpr int RS = 72;
    LAS bf16* kh = (LAS bf16*)lds + wid * (64 * RS);
    (void)gw;
    for (int it = wid * (int)gridDim.x + (int)blockIdx.x; it < 1024; it += NGW) {
        const int c = it & 31, bh = it >> 5, b = bh >> 2, h = bh & 3; const size_t tok0 = (size_t)b * S + c * 64;
        GLA_LOAD_GATE();
        float bl = 0.f; float la[64];
#pragma unroll
        for (int tk = 0; tk < 64; ++tk) { la[tk] = log_sigmoid16(GLA_Z(tk)); bl += la[tk]; }
        float bc = 0.f;
        unsigned short kcol[64];
#pragma unroll
        for (int tk = 0; tk < 64; ++tk) kcol[tk] = HY[(tok0 + tk) * HYN + C_KB + h * 64 + lane];
#pragma unroll
        for (int tk = 0; tk < 64; ++tk) {
            bc += la[tk];
            kh[lane * RS + kpos64(tk)] = (bf16)f2bf(bf2f(kcol[tk]) * __expf(bl - bc));
        }
        DEC[it * 64 + lane] = __expf(bl);
        LDS_WAIT();
#pragma unroll
        for (int dvh = 0; dvh < 2; ++dvh) {
            const bf16* vt = VTA + ((size_t)((b * 32 + c) * 12 + h * 2 + dvh)) * 4096;
            bf16x8 vf[4][2];
#pragma unroll
            for (int n = 0; n < 4; ++n)
#pragma unroll
                for (int s = 0; s < 2; ++s) vf[n][s] = *(const bf16x8*)(vt + (16 * n + fr) * 64 + 32 * s + 8 * fq);
#pragma unroll
            for (int m = 0; m < 4; ++m) {
                const bf16x8 a0 = *(const LAS bf16x8*)(kh + (16 * m + fr) * RS + 8 * fq), a1 = *(const LAS bf16x8*)(kh + (16 * m + fr) * RS + 32 + 8 * fq);
#pragma unroll
                for (int n = 0; n < 4; ++n) {
                    f32x4 acc = (f32x4){0.f, 0.f, 0.f, 0.f};
                    acc = __builtin_amdgcn_mfma_f32_16x16x32_bf16(a0, vf[n][0], acc, 0, 0, 0);
                    acc = __builtin_amdgcn_mfma_f32_16x16x32_bf16(a1, vf[n][1], acc, 0, 0, 0);
                    float* dst = SLOC + ((size_t)it * 64 + 16 * m + 4 * fq) * 128 + dvh * 64 + 16 * n + fr;
                    dst[0] = acc.x; dst[128] = acc.y; dst[256] = acc.z; dst[384] = acc.w;
                }
            }
        }
        LDS_WAIT();
    }
}
__device__ __forceinline__ void phase_gla_c(KArgs A, int wv_, int i, LAS unsigned char* lds, const bool kv_post, const int Lcur) {
    const int tid_ = opaque_tid(wv_); const int wid = __builtin_amdgcn_readfirstlane(tid_ >> 6), lane = tid_ & 63, fr = lane & 15, fq = lane >> 4; const int gw = blockIdx.x * 8 + wid, NGW = gridDim.x * 8;
    unsigned char* ws = opq(A->ws);
    const bf16* HY = (const bf16*)(ws + WS_BIG); const bf16* VTA = (const bf16*)(ws + WS_VTA); const bf16* STT = (const bf16*)(ws + WS_STT); bf16* CAT = (bf16*)(ws + WS_CAT);
    constexpr int RS = 72;
    LAS bf16* qs = (LAS bf16*)lds + wid * (128 * RS);
    LAS bf16* ks = qs + 64 * RS;
    const float* og = A->in[I_ONORM] + i * 128;
    LAS float* ogl = (LAS float*)(lds + 152064);
    if (tid_ < 128) ogl[tid_] = og[tid_];
    (void)gw; (void)NGW;
    for (int blk = blockIdx.x; blk < 256; blk += gridDim.x) {
        SUBT_BEGIN(1);
        {
            const float* SLOC = (const float*)(ws + WS_SLOC); const float* DEC = (const float*)(ws + WS_DEC); bf16* STw = (bf16*)(ws + WS_STT);
            const int tid = tid_, dv = tid & 127, ko = tid >> 7, bh = blk >> 3, c0 = (blk & 7) * 4;
            float sv[16];
#pragma unroll
            for (int j = 0; j < 16; ++j) sv[j] = 0.f;
#pragma unroll 1
            for (int cb = 0; cb < c0 + 4; cb += 4) {
                float dc4[4][16], sl4[4][16];
#pragma unroll
                for (int q = 0; q < 4; ++q) {
                    const size_t item = (size_t)bh * 32 + cb + q; const float* sl = SLOC + (item * 64 + ko * 16) * 128 + dv; const float* dc = DEC + item * 64 + ko * 16;
#pragma unroll
                    for (int j = 0; j < 16; ++j) { dc4[q][j] = dc[j]; sl4[q][j] = sl[j * 128]; }
                }
#pragma unroll
                for (int q = 0; q < 4; ++q) {
                    const int c = cb + q; const size_t item = (size_t)bh * 32 + c;
                    if (c >= c0) {
                        u32x4 o0, o1; o0.x = pk2(sv[0], sv[1]); o0.y = pk2(sv[2], sv[3]); o0.z = pk2(sv[4], sv[5]); o0.w = pk2(sv[6], sv[7]);
                        o1.x = pk2(sv[8], sv[9]); o1.y = pk2(sv[10], sv[11]); o1.z = pk2(sv[12], sv[13]); o1.w = pk2(sv[14], sv[15]);
                        u32x4* d = (u32x4*)(STw + (item * 128 + dv) * 64 + ko * 16); d[0] = o0; d[1] = o1;
                    }
#pragma unroll
                    for (int j = 0; j < 16; ++j) sv[j] = dc4[q][j] * sv[j] + sl4[q][j];
                }
            }
            asm volatile("s_waitcnt vmcnt(0)" ::: "memory");
            __syncthreads();
        }
        SUBT_END(1, ws, tid_);
        SUBT_BEGIN(2);
        SUBT_BEGIN(3);
        if (wid < 4) {
        const int it = blk * 4 + wid;
        const int c = it & 31, bh = it >> 5, b = bh >> 2, h = bh & 3; const size_t tok0 = (size_t)b * S + c * 64;
        GLA_LOAD_GATE();
        float bc = 0.f;
        unsigned short qcol[64], kcol[64];
#pragma unroll
        for (int tk = 0; tk < 64; ++tk) { const bf16* row = HY + (tok0 + tk) * HYN; qcol[tk] = row[C_QB + h * 64 + lane]; kcol[tk] = row[C_KB + h * 64 + lane]; }
#pragma unroll
        for (int tk = 0; tk < 64; ++tk) {
            bc += log_sigmoid16(GLA_Z(tk));
            const float eb = __expf(bc);
            qs[tk * RS + lane] = (bf16)f2bf(bf2f(qcol[tk]) * 0.125f * eb); ks[tk * RS + lane] = (bf16)f2bf(bf2f(kcol[tk]) / eb);
        }
        LDS_WAIT();
        SUBT_END(2, ws, tid_);
        bf16x8 st[8][2];
#pragma unroll
        for (int n = 0; n < 8; ++n)
#pragma unroll
            for (int s = 0; s < 2; ++s) st[n][s] = *(const bf16x8*)(STT + ((size_t)it * 128 + 16 * n + fr) * 64 + 32 * s + 8 * fq);
        const bf16* vt = VTA + ((size_t)((b * 32 + c) * 12 + h * 2)) * 4096;
        bf16x8 vfr[8];
#pragma unroll
        for (int n = 0; n < 8; ++n) { const bf16* vrow = vt + (size_t)(n >> 2) * 4096 + (16 * (n & 3) + fr) * 64 + 8 * fq; vfr[n] = *(const bf16x8*)vrow; }
#pragma unroll
        for (int mi = 0; mi < 4; ++mi) {
            const bf16x8 q0 = *(const LAS bf16x8*)(qs + (16 * mi + fr) * RS + 8 * fq), q1 = *(const LAS bf16x8*)(qs + (16 * mi + fr) * RS + 32 + 8 * fq);
            u32x2 rwv[8];
#pragma unroll
            for (int n = 0; n < 8; ++n) rwv[n] = *(const u32x2*)(HY + (tok0 + 16 * mi + fr) * HYN + C_RB + h * 128 + 16 * n + 4 * fq);
            f32x4 sc[4];
#pragma unroll
            for (int t = 0; t < 4; ++t) {
                sc[t] = (f32x4){0.f, 0.f, 0.f, 0.f};
                if (t <= mi) {
                    const bf16x8 k0 = *(const LAS bf16x8*)(ks + (16 * t + fr) * RS + 8 * fq), k1 = *(const LAS bf16x8*)(ks + (16 * t + fr) * RS + 32 + 8 * fq);
                    sc[t] = __builtin_amdgcn_mfma_f32_16x16x32_bf16(k0, q0, sc[t], 0, 0, 0);
                    sc[t] = __builtin_amdgcn_mfma_f32_16x16x32_bf16(k1, q1, sc[t], 0, 0, 0);
                    if (t == mi) {
                        sc[t].x = (4 * fq + 0 <= fr) ? sc[t].x : 0.f; sc[t].y = (4 * fq + 1 <= fr) ? sc[t].y : 0.f; sc[t].z = (4 * fq + 2 <= fr) ? sc[t].z : 0.f; sc[t].w = (4 * fq + 3 <= fr) ? sc[t].w : 0.f; }
                }
            }
            bf16x8 pf[2];
#pragma unroll
            for (int s = 0; s < 2; ++s) { u32x4 w; w.x = pk2(sc[2 * s].x, sc[2 * s].y); w.y = pk2(sc[2 * s].z, sc[2 * s].w); w.z = pk2(sc[2 * s + 1].x, sc[2 * s + 1].y); w.w = pk2(sc[2 * s + 1].z, sc[2 * s + 1].w);
                pf[s] = __builtin_bit_cast(bf16x8, w); }
            f32x4 o[8]; float ssq = 0.f;
#pragma unroll
            for (int n = 0; n < 8; ++n) {
                o[n] = (f32x4){0.f, 0.f, 0.f, 0.f};
                o[n] = __builtin_amdgcn_mfma_f32_16x16x32_bf16(st[n][0], q0, o[n], 0, 0, 0);
                o[n] = __builtin_amdgcn_mfma_f32_16x16x32_bf16(st[n][1], q1, o[n], 0, 0, 0);
                o[n] = __builtin_amdgcn_mfma_f32_16x16x32_bf16(vfr[n], pf[0], o[n], 0, 0, 0);
                if (mi >= 2) o[n] = __builtin_amdgcn_mfma_f32_16x16x32_bf16(*(const bf16x8*)(vt + (size_t)(n >> 2) * 4096 + (16 * (n & 3) + fr) * 64 + 8 * fq + 32), pf[1], o[n], 0, 0, 0);
                ssq += (o[n].x * o[n].x + o[n].y * o[n].y) + (o[n].z * o[n].z + o[n].w * o[n].w);
            }
            ssq = xadd32(xadd16(ssq));
            const float rstd = rsqrtf(ssq * (1.f / 128.f) + EPS);
            const size_t tok = tok0 + 16 * mi + fr;
#pragma unroll
            for (int n = 0; n < 8; ++n) {
                const int dv = 16 * n + 4 * fq;
                const u32x2 rw = rwv[n]; const f32x4 g = *(const LAS f32x4*)(ogl + dv);
                const float r0 = bflo(rw.x), r1 = bfhi(rw.x), r2 = bflo(rw.y), r3 = bfhi(rw.y);
                u32x2 w; w.x = pk2(o[n].x * rstd * g.x * (r0 * sigmoidf_(r0)), o[n].y * rstd * g.y * (r1 * sigmoidf_(r1)));
                w.y = pk2(o[n].z * rstd * g.z * (r2 * sigmoidf_(r2)), o[n].w * rstd * g.w * (r3 * sigmoidf_(r3)));
                *(u32x2*)(CAT + tok * 1024 + 512 + h * 128 + dv) = w;
            }
        }
        } else {
            if (kv_post) {
                phase_knorm(A, wv_, blk * 4 + (wid - 4), 256 * 4);
                vtrans_wave(A, wv_, (LAS bf16*)(lds + 81920 + (wid - 4) * 16640), blk * 4 + (wid - 4), 256 * 4);
            }
            moe_weight_items(A, wv_, (LAS float*)(lds + 81920 + (wid - 4) * 16640), Lcur, Lcur + 2, blk * 4 + (wid - 4), 256 * 4);
        }
        SUBT_END(3, ws, tid_);
        LDS_WAIT();
        __syncthreads();
    }
}

__device__ __forceinline__ void phase_sgu_mix_mfma(KArgs A, int wv_, int i, LAS unsigned char* lds) {
    const int tid = opaque_tid(wv_), wid = __builtin_amdgcn_readfirstlane(tid >> 6), lane = tid & 63, fr = lane & 15, fq = lane >> 4;
    unsigned char* ws = opq(A->ws);
    const bf16* U = (const bf16*)(ws + WS_U); const bf16* V = (const bf16*)(ws + WS_V); bf16* UM = (bf16*)(ws + WS_UM);
    const bf16* WSB = (const bf16*)(ws + WS_WSB) + (size_t)i * 8 * 16384; const float* M0 = (const float*)(ws + WS_M0) + i * 8 * 128;
    constexpr int VS = 136;
    LAS bf16* vT = (LAS bf16*)lds;
    LAS float* st = (LAS float*)(lds + 256 * VS * 2);
    LAS bf16* wl = (LAS bf16*)(lds + 256 * VS * 2 + 1024);
    const float* lng = A->in[I_LNG] + i * 2048; const float* lnb = A->in[I_LNB] + i * 2048; const float* bsg = A->in[I_SGBS] + i * 8 * 128;
    for (int it = blockIdx.x; it < 256; it += gridDim.x) {
        const int gh = it & 1, n_ = (it >> 1) & 15, b = it >> 5; const size_t tok0 = (size_t)b * S + n_ * 128;
        __syncthreads();
        {
            const float* vst = (const float*)(ws + WS_VSTAT);
#pragma unroll
            for (int s4 = 0; s4 < 16; s4 += 4) {
                const int s = wid * 16 + s4 + (lane >> 4);
                const f32x4 p = *(const f32x4*)(vst + (tok0 + s) * 64 + 4 * (lane & 15));
                float sum = p.x + p.z, sq = p.y + p.w;
                sum += __shfl_xor(sum, 1); sq += __shfl_xor(sq, 1); sum += __shfl_xor(sum, 2); sq += __shfl_xor(sq, 2);
                sum += __shfl_xor(sum, 4); sq += __shfl_xor(sq, 4); sum += __shfl_xor(sum, 8); sq += __shfl_xor(sq, 8);
                const float mean = sum * (1.f / 2048.f); const float var = fmaxf(sq * (1.f / 2048.f) - mean * mean, 0.f);
                if ((lane & 15) == 0) { st[2 * s] = mean; st[2 * s + 1] = rsqrtf(var + EPS); }
            }
        }
#pragma unroll 1
        for (int gg = 0; gg < 4; ++gg) {
            const int g = gh * 4 + gg;
            __syncthreads();
            {
                const int s = tid & 127, cq = tid >> 7;
                const float mean = st[2 * s], rstd = st[2 * s + 1];
                const u32x4* src = (const u32x4*)(V + (tok0 + s) * 2048 + g * 256 + cq * 64);
                u32x4 w8[8], ww[4];
#pragma unroll
                for (int i8 = 0; i8 < 8; ++i8) w8[i8] = src[i8];
#pragma unroll
                for (int q = 0; q < 4; ++q) { const int e = tid + 512 * q; ww[q] = *(const u32x4*)(WSB + ((size_t)g * 128 + (e >> 4)) * 128 + (e & 15) * 8); }
#pragma unroll
                for (int i8 = 0; i8 < 8; ++i8) {
                    const u32x4 w = w8[i8];
                    LAS bf16* d = vT + (cq * 64 + i8 * 8) * VS + s;
                    d[0 * VS] = (bf16)f2bf((bflo(w.x) - mean) * rstd); d[1 * VS] = (bf16)f2bf((bfhi(w.x) - mean) * rstd); d[2 * VS] = (bf16)f2bf((bflo(w.y) - mean) * rstd); d[3 * VS] = (bf16)f2bf((bfhi(w.y) - mean) * rstd);
                    d[4 * VS] = (bf16)f2bf((bflo(w.z) - mean) * rstd); d[5 * VS] = (bf16)f2bf((bfhi(w.z) - mean) * rstd); d[6 * VS] = (bf16)f2bf((bflo(w.w) - mean) * rstd); d[7 * VS] = (bf16)f2bf((bfhi(w.w) - mean) * rstd);
                }
#pragma unroll
                for (int q = 0; q < 4; ++q) { const int e = tid + 512 * q; *(LAS u32x4*)(wl + (e >> 4) * VS + (e & 15) * 8) = ww[q]; }
            }
            u32x2 uw[8][2]; float m0v[8], bsv[8];
#pragma unroll
            for (int n = 0; n < 8; ++n) { const int t = 16 * n + fr; m0v[n] = M0[g * 128 + t]; bsv[n] = bsg[g * 128 + t];
                const size_t ro = (tok0 + t) * 2048 + g * 256 + 32 * wid + 4 * fq; uw[n][0] = *(const u32x2*)(U + ro); uw[n][1] = *(const u32x2*)(U + ro + 16); }
            __syncthreads();
            bf16x8 vf[2][4];
#pragma unroll
            for (int m = 0; m < 2; ++m)
#pragma unroll
                for (int k = 0; k < 4; ++k) vf[m][k] = *(const LAS bf16x8*)(vT + (32 * wid + 16 * m + fr) * VS + 32 * k + 8 * fq);
            f32x4 gc[2], bc[2];
#pragma unroll
            for (int m = 0; m < 2; ++m) { gc[m] = *(const f32x4*)(lng + g * 256 + 32 * wid + 16 * m + 4 * fq); bc[m] = *(const f32x4*)(lnb + g * 256 + 32 * wid + 16 * m + 4 * fq); }
#pragma unroll
            for (int n = 0; n < 8; ++n) {
                f32x4 a0 = (f32x4){0.f, 0.f, 0.f, 0.f}, a1 = (f32x4){0.f, 0.f, 0.f, 0.f};
#pragma unroll
                for (int k = 0; k < 4; ++k) if (k <= (n >> 1)) {
                    const bf16x8 wf = *(const LAS bf16x8*)(wl + (16 * n + fr) * VS + 32 * k + 8 * fq);
                    a0 = __builtin_amdgcn_mfma_f32_16x16x32_bf16(vf[0][k], wf, a0, 0, 0, 0);
                    a1 = __builtin_amdgcn_mfma_f32_16x16x32_bf16(vf[1][k], wf, a1, 0, 0, 0); }
                const int t = 16 * n + fr; const float m0 = m0v[n], bsv_ = bsv[n];
                const size_t ro = (tok0 + t) * 2048 + g * 256 + 32 * wid + 4 * fq;
#pragma unroll
                for (int m = 0; m < 2; ++m) {
                    const f32x4 a = m ? a1 : a0;
                    const u32x2 uw_ = uw[n][m];
                    u32x2 w; w.x = pk2((a.x * gc[m].x + bc[m].x * m0 + bsv_) * bflo(uw_.x), (a.y * gc[m].y + bc[m].y * m0 + bsv_) * bfhi(uw_.x));
                    w.y = pk2((a.z * gc[m].z + bc[m].z * m0 + bsv_) * bflo(uw_.y), (a.w * gc[m].w + bc[m].w * m0 + bsv_) * bfhi(uw_.y));
                    *(u32x2*)(UM + ro + 16 * m) = w;
                }
            }
        }
    }
    __syncthreads();
}

__device__ __forceinline__ void xattn_item(KArgs A, int wv_, int L, LAS unsigned char* lds, const int b, const int h, const int qt) {
    const int tid = opaque_tid(wv_), wid = __builtin_amdgcn_readfirstlane(tid >> 6), lane = tid & 63, fr = lane & 15, fq = lane >> 4;
    unsigned char* ws = opq(A->ws);
    const bf16* QX = (const bf16*)(ws + WS_QX); const bf16* KV = (const bf16*)(ws + WS_KV); const bf16* VT = (const bf16*)(ws + WS_VT); bf16* OX = (bf16*)(ws + WS_OX);
    constexpr int RS = 264;
    LAS bf16* kl = (LAS bf16*)lds;
    const float* qg = A->in[I_XQN] + L * 256;
    {
        __syncthreads();
        {
            const int row = tid >> 1, hf = tid & 1;
            const u32x4* src = (const u32x4*)(KV + (size_t)(b * 256 + row) * 8192 + L * 2048 + h * 256 + hf * 128);
#pragma unroll
            for (int i0 = 0; i0 < 16; i0 += 8) {
                u32x4 w[8];
#pragma unroll
                for (int i = 0; i < 8; ++i) w[i] = src[i0 + i];
#pragma unroll
                for (int i = 0; i < 8; ++i) *(LAS u32x4*)(kl + row * RS + hf * 128 + (i0 + i) * 8) = w[i];
            }
        }
        const size_t tok0 = (size_t)b * S + qt * 256 + wid * 32 + fr;
        u32x4 qw0[8], qw1[8];
#pragma unroll
        for (int s = 0; s < 8; ++s) { qw0[s] = *(const u32x4*)(QX + tok0 * 1024 + h * 256 + 32 * s + 8 * fq); qw1[s] = *(const u32x4*)(QX + (tok0 + 16) * 1024 + h * 256 + 32 * s + 8 * fq); }
        __syncthreads();
        bf16x8 pf0[8], pf1[8]; float inv0, inv1;
        auto s_part = [&](const u32x4 (&qw)[8], bf16x8 (&pf)[8], float& inv) __attribute__((always_inline)) {
            float ssq = 0.f;
#pragma unroll
            for (int s = 0; s < 8; ++s) {
                const float a0 = bflo(qw[s].x), a1 = bfhi(qw[s].x), a2 = bflo(qw[s].y), a3 = bfhi(qw[s].y), a4 = bflo(qw[s].z), a5 = bfhi(qw[s].z), a6 = bflo(qw[s].w), a7 = bfhi(qw[s].w);
                ssq += (a0 * a0 + a1 * a1) + (a2 * a2 + a3 * a3) + (a4 * a4 + a5 * a5) + (a6 * a6 + a7 * a7);
            }
            ssq = xadd32(xadd16(ssq));
            const float rstd = rsqrtf(ssq * (1.f / 256.f) + EPS);
            bf16x8 qf[8];
#pragma unroll
            for (int s = 0; s < 8; ++s) qf[s] = __builtin_bit_cast(bf16x8, qw[s]);
            f32x4 sc[16];
#pragma unroll
            for (int hf = 0; hf < 2; ++hf) {
                unsigned kb = (unsigned)(size_t)(kl + (128 * hf + fr) * RS + 8 * fq); asm volatile("" : "+v"(kb));
#pragma unroll
                for (int t8 = 0; t8 < 8; ++t8) { const int t = 8 * hf + t8; sc[t] = (f32x4){0.f, 0.f, 0.f, 0.f};
#pragma unroll
                    for (int s = 0; s < 8; ++s) { const bf16x8 kf = *(const LAS bf16x8*)(size_t)(kb + (unsigned)((16 * t8 * RS + 32 * s) * 2));
                        sc[t] = __builtin_amdgcn_mfma_f32_16x16x32_bf16(kf, qf[s], sc[t], 0, 0, 0); }
                    if (t & 1) asm volatile("" ::: "memory"); }
            }
            float mx = -INFINITY;
#pragma unroll
            for (int t = 0; t < 16; ++t) mx = fmaxf(mx, fmaxf(fmaxf(sc[t].x, sc[t].y), fmaxf(sc[t].z, sc[t].w)));
            mx = xmax32(xmax16(mx));
            float lsum = 0.f;
#pragma unroll
            for (int t = 0; t < 16; ++t) { sc[t].x = __expf((sc[t].x - mx) * rstd); sc[t].y = __expf((sc[t].y - mx) * rstd); sc[t].z = __expf((sc[t].z - mx) * rstd); sc[t].w = __expf((sc[t].w - mx) * rstd); lsum += (sc[t].x + sc[t].y) + (sc[t].z + sc[t].w); }
            lsum = xadd32(xadd16(lsum));
            inv = 1.f / lsum;
#pragma unroll
            for (int s = 0; s < 8; ++s) { u32x4 w; w.x = pk2(sc[2 * s].x, sc[2 * s].y); w.y = pk2(sc[2 * s].z, sc[2 * s].w); w.z = pk2(sc[2 * s + 1].x, sc[2 * s + 1].y); w.w = pk2(sc[2 * s + 1].z, sc[2 * s + 1].w);
                pf[s] = __builtin_bit_cast(bf16x8, w); }
        };
        s_part(qw0, pf0, inv0);
        s_part(qw1, pf1, inv1);
        __syncthreads();
        {
            const int row = tid >> 1, hf = tid & 1;
            const u32x4* src = (const u32x4*)(VT + ((size_t)((L * 8 + b) * 4 + h) * 256 + row) * 256 + hf * 128);
#pragma unroll
            for (int i0 = 0; i0 < 16; i0 += 8) {
                u32x4 w[8];
#pragma unroll
                for (int i = 0; i < 8; ++i) w[i] = src[i0 + i];
#pragma unroll
                for (int i = 0; i < 8; ++i) *(LAS u32x4*)(kl + row * RS + hf * 128 + (i0 + i) * 8) = w[i];
            }
        }
        __syncthreads();
#pragma unroll
        for (int hf = 0; hf < 2; ++hf) {
            unsigned vb = (unsigned)(size_t)(kl + (128 * hf + fr) * RS + 8 * fq); asm volatile("" : "+v"(vb));
#pragma unroll
            for (int n8 = 0; n8 < 8; ++n8) { const int n = 8 * hf + n8; f32x4 o0 = (f32x4){0.f, 0.f, 0.f, 0.f}, o1 = o0;
#pragma unroll
                for (int s = 0; s < 8; ++s) { const bf16x8 vf = *(const LAS bf16x8*)(size_t)(vb + (unsigned)((16 * n8 * RS + 32 * s) * 2));
                    o0 = __builtin_amdgcn_mfma_f32_16x16x32_bf16(vf, pf0[s], o0, 0, 0, 0);
                    o1 = __builtin_amdgcn_mfma_f32_16x16x32_bf16(vf, pf1[s], o1, 0, 0, 0); }
                u32x2 w0, w1; w0.x = pk2(o0.x * inv0, o0.y * inv0); w0.y = pk2(o0.z * inv0, o0.w * inv0); w1.x = pk2(o1.x * inv1, o1.y * inv1); w1.y = pk2(o1.z * inv1, o1.w * inv1);
                *(u32x2*)(OX + tok0 * 1024 + h * 256 + 16 * n + 4 * fq) = w0;
                *(u32x2*)(OX + (tok0 + 16) * 1024 + h * 256 + 16 * n + 4 * fq) = w1;
                if (n & 1) asm volatile("" ::: "memory"); }
        }
    }
    __syncthreads();
}

__device__ __forceinline__ void phase_route_mfma(KArgs A, int wv_, int L, LAS unsigned char* lds) {
    const int tid = opaque_tid(wv_), wid = __builtin_amdgcn_readfirstlane(tid >> 6), lane = tid & 63, fr = lane & 15, fq = lane >> 4;
    unsigned char* ws = opq(A->ws);
    const float* RW = (const float*)(ws + WS_RW) + (size_t)L * NEXP * D;
    unsigned* cnt = (unsigned*)(ws + WS_CTL) + CW_CNT + L * 64;
    int* list = (int*)(ws + WS_LIST); int* te = (int*)(ws + WS_TOK); int* tp = te + 2 * T; float* tw = (float*)(tp + 2 * T);
    bf16* XN = (bf16*)(ws + WS_XN);
    constexpr int WSTR = 1032;
    LAS bf16* rwh = (LAS bf16*)lds;
    LAS bf16* rwl = rwh + 16 * WSTR;
    LAS float* xch = (LAS float*)(lds + 2 * 16 * WSTR * 2);
    LAS unsigned* lcnt = (LAS unsigned*)(lds + 2 * 16 * WSTR * 2 + 8 * 320 * 4);
    LAS unsigned* lbase = lcnt + 16;
    for (int e4 = tid; e4 < NEXP * D / 4; e4 += 512) {
        const f32x4 w = *(const f32x4*)(RW + 4 * e4);
        u32x2 h; h.x = pk2(w.x, w.y); h.y = pk2(w.z, w.w);
        u32x2 l; l.x = pk2(w.x - bflo(h.x), w.y - bfhi(h.x)); l.y = pk2(w.z - bflo(h.y), w.w - bfhi(h.y));
        const int e = (4 * e4) >> 10, k = (4 * e4) & 1023;
        *(LAS u32x2*)(rwh + e * WSTR + k) = h; *(LAS u32x2*)(rwl + e * WSTR + k) = l;
    }
    const int tg = wid >> 1, kh = wid & 1;
    const float rbv = A->in[I_RB][fr];
    for (int blk = blockIdx.x; blk < T / 64; blk += gridDim.x) {
        __syncthreads();
        if (tid < 16) lcnt[tid] = 0u;
        const size_t tok = (size_t)blk * 64 + 16 * tg + fr;
        const bf16* xrow = (const bf16*)(ws + WS_X16) + tok * D + 512 * kh + 8 * fq;
        f32x4 acc = (f32x4){0.f, 0.f, 0.f, 0.f}; float ssq = 0.f;
        bf16x8 ah[16];
#pragma unroll
        for (int s = 0; s < 16; ++s) ah[s] = *(const bf16x8*)(xrow + 32 * s);
#pragma unroll
        for (int s = 0; s < 16; ++s) {
            const u32x4 hw = __builtin_bit_cast(u32x4, ah[s]);
            const float x0 = bflo(hw.x), x1 = bfhi(hw.x), x2 = bflo(hw.y), x3 = bfhi(hw.y), x4 = bflo(hw.z), x5 = bfhi(hw.z), x6 = bflo(hw.w), x7 = bfhi(hw.w);
            ssq += ((x0 * x0 + x1 * x1) + (x2 * x2 + x3 * x3)) + ((x4 * x4 + x5 * x5) + (x6 * x6 + x7 * x7));
            const bf16x8 bh = *(const LAS bf16x8*)(rwh + fr * WSTR + 512 * kh + 32 * s + 8 * fq), bl = *(const LAS bf16x8*)(rwl + fr * WSTR + 512 * kh + 32 * s + 8 * fq);
            acc = __builtin_amdgcn_mfma_f32_16x16x32_bf16(ah[s], bh, acc, 0, 0, 0);
            acc = __builtin_amdgcn_mfma_f32_16x16x32_bf16(ah[s], bl, acc, 0, 0, 0);
        }
        ssq = xadd32(xadd16(ssq));
        LAS float* mine = xch + wid * 320; const LAS float* other = xch + (wid ^ 1) * 320;
#pragma unroll
        for (int r = 0; r < 4; ++r) mine[(4 * fq + r) * 20 + fr] = acc[r];
        if (fq == 0) mine[fr * 20 + 16] = ssq;
        __syncthreads();
        const float rstd = rsqrtf((ssq + other[fr * 20 + 16]) * (1.f / 1024.f) + EPS);
        {
            bf16* xo = XN + tok * D + 512 * kh + 8 * fq;
#pragma unroll
            for (int s = 0; s < 16; ++s) { const u32x4 hw = __builtin_bit_cast(u32x4, ah[s]);
                u32x4 o; o.x = pk2(bflo(hw.x) * rstd, bfhi(hw.x) * rstd); o.y = pk2(bflo(hw.y) * rstd, bfhi(hw.y) * rstd); o.z = pk2(bflo(hw.z) * rstd, bfhi(hw.z) * rstd); o.w = pk2(bflo(hw.w) * rstd, bfhi(hw.w) * rstd);
                *(u32x4*)(xo + 32 * s) = o; }
        }
        int e0r[4], e1r[4], r0r[4], r1r[4]; float w0r[4];
        if (kh == 0) {
#pragma unroll
            for (int r = 0; r < 4; ++r) {
                const float rs = __shfl(rstd, 4 * fq + r);
                const float lg = (acc[r] + other[(4 * fq + r) * 20 + fr]) * rs + rbv;
                float v0 = lg; v0 = fmaxf(v0, __shfl_xor(v0, 1)); v0 = fmaxf(v0, __shfl_xor(v0, 2)); v0 = fmaxf(v0, __shfl_xor(v0, 4)); v0 = fmaxf(v0, __shfl_xor(v0, 8));
                const unsigned long long bm0 = __ballot(lg == v0);
                const int e0 = __ffs((unsigned)(bm0 >> (16 * fq)) & 0xffffu) - 1;
                const bool c2 = (fr >> 2) == (e0 >> 2) && fr != e0;
                const float m2 = c2 ? lg : -INFINITY;
                float v1 = m2; v1 = fmaxf(v1, __shfl_xor(v1, 1)); v1 = fmaxf(v1, __shfl_xor(v1, 2)); v1 = fmaxf(v1, __shfl_xor(v1, 4)); v1 = fmaxf(v1, __shfl_xor(v1, 8));
                const unsigned long long bm1 = __ballot(c2 && m2 == v1);
                const int e1 = __ffs((unsigned)(bm1 >> (16 * fq)) & 0xffffu) - 1;
                e0r[r] = e0; e1r[r] = e1; w0r[r] = 1.f / (1.f + __expf(v1 - v0));
                r0r[r] = 0; r1r[r] = 0;
                if (fr == 0) { r0r[r] = (int)atomicAdd((unsigned*)(lcnt + e0), 1u); r1r[r] = (int)atomicAdd((unsigned*)(lcnt + e1), 1u); }
            }
        }
        __syncthreads();
        if (tid < 16) lbase[tid] = atomicAdd(&cnt[tid], lcnt[tid]);
        __syncthreads();
        if (kh == 0 && fr == 0) {
#pragma unroll
            for (int r = 0; r < 4; ++r) {
                const int t = blk * 64 + 16 * tg + 4 * fq + r;
                const int p0 = (int)lbase[e0r[r]] + r0r[r], p1 = (int)lbase[e1r[r]] + r1r[r];
                list[e0r[r] * T + p0] = t; list[e1r[r] * T + p1] = t;
                te[2 * t] = e0r[r]; te[2 * t + 1] = e1r[r]; tp[2 * t] = p0; tp[2 * t + 1] = p1; tw[2 * t] = w0r[r]; tw[2 * t + 1] = 1.f - w0r[r];
            }
        }
    }
    __syncthreads();
}

__device__ __forceinline__ void moe_offsets(KArgs A, int wv_, int L, LAS int* off, LAS int* cn) {
    if (opaque_tid(wv_) == 0) {
        const unsigned* cnt = (const unsigned*)(opq(A->ws) + WS_CTL) + CW_CNT + L * 64;
        int o = 0;
        for (int e = 0; e < 16; ++e) { const int c = (int)__hip_atomic_load(cnt + e, __ATOMIC_RELAXED, __HIP_MEMORY_SCOPE_AGENT); off[e] = o; cn[e] = c; o += (c + 255) & ~255; }
        off[16] = o;
    }
    __syncthreads();
}
__device__ __forceinline__ void phase_moe_combine(KArgs A, int wv_, int L, LAS unsigned char* lds) {
    LAS int* off = (LAS int*)lds; LAS int* cn = off + 32;
    moe_offsets(A, wv_, L, off, cn);
    const int tid_ = opaque_tid(wv_); const int wid = __builtin_amdgcn_readfirstlane(tid_ >> 6), lane = tid_ & 63; const int gw = blockIdx.x * 8 + wid, NGW = gridDim.x * 8;
    unsigned char* ws = opq(A->ws);
    const int* te = (const int*)(ws + WS_TOK); const int* tp = te + 2 * T; const float* tw = (const float*)(tp + 2 * T);
    const bf16* Y = (const bf16*)(ws + WS_Y); bf16* XN = (bf16*)(ws + WS_XN); bf16* X16 = (bf16*)(ws + WS_X16); const bool last = L == DEPTH - 1;
    const int nq = (T - gw + NGW - 1) / NGW;
    for (int q0 = 0; q0 < nq; q0 += 8) {
        int s0m = 0, s1m = 0; float w0m = 0.f, w1m = 0.f;
        { const int qq = q0 + (lane & 7); const int t = gw + NGW * (qq < nq ? qq : nq - 1);
          s0m = off[te[2 * t]] + tp[2 * t]; s1m = off[te[2 * t + 1]] + tp[2 * t + 1]; w0m = tw[2 * t]; w1m = tw[2 * t + 1]; }
        const int nn = nq - q0 < 8 ? nq - q0 : 8;
        f32x4 v[4]; u32x2 xv[4], xn[4], ya[4], yb[4], yan[4], ybn[4];
        { const int t = gw + NGW * q0; const int sl0 = __builtin_amdgcn_readlane(s0m, 0), sl1 = __builtin_amdgcn_readlane(s1m, 0);
#pragma unroll
          for (int j = 0; j < 4; ++j) { xv[j] = ((const u32x2*)(X16 + (size_t)t * D) + lane)[64 * j]; ya[j] = ((const u32x2*)(Y + (size_t)sl0 * D) + lane)[64 * j]; yb[j] = ((const u32x2*)(Y + (size_t)sl1 * D) + lane)[64 * j]; } }
#pragma unroll 1
        for (int q = 0; q < nn; ++q) {
            const int t = gw + NGW * (q0 + q);
            const int qn = q + 1 < nn ? q + 1 : q;
            { const int tn = gw + NGW * (q0 + qn); const int sl0 = __builtin_amdgcn_readlane(s0m, qn), sl1 = __builtin_amdgcn_readlane(s1m, qn);
#pragma unroll
              for (int j = 0; j < 4; ++j) { xn[j] = ((const u32x2*)(X16 + (size_t)tn * D) + lane)[64 * j]; yan[j] = ((const u32x2*)(Y + (size_t)sl0 * D) + lane)[64 * j]; ybn[j] = ((const u32x2*)(Y + (size_t)sl1 * D) + lane)[64 * j]; } }
            const float w0 = __builtin_bit_cast(float, __builtin_amdgcn_readlane(__builtin_bit_cast(int, w0m), q)), w1 = __builtin_bit_cast(float, __builtin_amdgcn_readlane(__builtin_bit_cast(int, w1m), q));
            float s = 0.f;
#pragma unroll
            for (int j = 0; j < 4; ++j) {
                v[j].x = bflo(xv[j].x) + w0 * bflo(ya[j].x) + w1 * bflo(yb[j].x); v[j].y = bfhi(xv[j].x) + w0 * bfhi(ya[j].x) + w1 * bfhi(yb[j].x); v[j].z = bflo(xv[j].y) + w0 * bflo(ya[j].y) + w1 * bflo(yb[j].y); v[j].w = bfhi(xv[j].y) + w0 * bfhi(ya[j].y) + w1 * bfhi(yb[j].y);
                s += (v[j].x * v[j].x + v[j].y * v[j].y) + (v[j].z * v[j].z + v[j].w * v[j].w);
            }
            const float rstd = rsqrtf(wave_sum(s) * (1.f / 1024.f) + EPS);
            u32x2* o8 = (u32x2*)(XN + (size_t)t * D) + lane;
            if (last) { f32x4* xr = (f32x4*)(A->out + (size_t)t * D) + lane;
#pragma unroll
                for (int j = 0; j < 4; ++j) xr[64 * j] = v[j]; }
            else { u32x2* xr = (u32x2*)(X16 + (size_t)t * D) + lane;
#pragma unroll
                for (int j = 0; j < 4; ++j) { u32x2 w; w.x = pk2(v[j].x, v[j].y); w.y = pk2(v[j].z, v[j].w); xr[64 * j] = w; } }
#pragma unroll
            for (int j = 0; j < 4; ++j) { u32x2 w; w.x = pk2(v[j].x * rstd, v[j].y * rstd); w.y = pk2(v[j].z * rstd, v[j].w * rstd); o8[64 * j] = w; }
#pragma unroll
            for (int j = 0; j < 4; ++j) { xv[j] = xn[j]; ya[j] = yan[j]; yb[j] = ybn[j]; }
        }
    }
}

constexpr int PH_PER_EVEN = 5 + 6, PH_PER_ODD = 3 + 6;
constexpr int NPHASES = 1 + 2 * (PH_PER_EVEN + PH_PER_ODD);

__global__ void __launch_bounds__(512, 2) mk_fwd(Args Araw) {
    KArgs A0 = kargs();
    extern __shared__ __attribute__((aligned(16))) unsigned char lds_raw[];
    LAS unsigned char* lds = (LAS unsigned char*)lds_raw;
    volatile LAS unsigned* misc = (volatile LAS unsigned*)(lds + LDS_MISC);
    const int tid = threadIdx.x;
    if (tid < 16) misc[tid] = 0u;
    __syncthreads();
    const int lo = A0->ph_lo, hi = A0->ph_hi;
    const int wv_ = __builtin_amdgcn_readfirstlane(threadIdx.x >> 6);
    if (hi - lo > 1) (void)xcd_barrier_post((unsigned*)(A0->ws + WS_CTL) + CW_BAR, misc);
    int ph = 0;
    unsigned long long tacc_ = 0;
#define PH_BEGIN(k) if (ph >= lo && ph < hi) { const bool tprobe_ = (PROBE_TMASK >> (k)) & 1; unsigned long long tp0_ = 0; if (PROBE_TMASK && tprobe_) tp0_ = __builtin_amdgcn_s_memrealtime(); KArgs A = kargs(); unsigned char* ws = opq(A->ws); _Pragma("unroll 1") for (int rep_ = 0; rep_ < (((PROBE_MASK >> (k)) & 1) ? PROBE_REPS : 1); ++rep_)
#define PH_END   if (ph + 1 < hi) { XcdBarrier b_; b_.bar = (unsigned*)(opq(kargs()->ws) + WS_CTL) + CW_BAR; b_.x = xb_xcc_id(); b_.st = misc; xcd_barrier(b_, opaque_tid(wv_) == 0); } if (PROBE_TMASK && tprobe_) tacc_ += __builtin_amdgcn_s_memrealtime() - tp0_; } ++ph;
    const int G = gridDim.x, cb = blockIdx.x;

    PH_BEGIN(0) phase_prologue(A, wv_, lds); PH_END
    for (int L = 0; L < DEPTH; ++L) {
        const int i = L >> 1;
        if ((L & 1) == 0) {
            PH_BEGIN(3) {
                if (L == 0) {
                    pg8::DenseOrder S; S.init(NBATCH * NMEM, 8192, D, (const bf16*)(ws + WS_WKV), G, cb);
                    pg8::EpiBf16<0> E{(bf16*)(ws + WS_KV), 8192, 32, 0, nullptr, 0};
                    pg8::gemm_phase(lds, (const bf16*)(ws + WS_MN), D, S, E, wv_);
                }
                pg8::DenseOrder S; S.init(T, HYN, D, (const bf16*)(ws + WS_WHYB) + (size_t)i * HYN * D, G, cb);
                pg8::EpiBf16<0> E{(bf16*)(ws + WS_BIG), HYN, 12, 0, nullptr, 0};
                pg8::gemm_phase(lds, (const bf16*)(ws + WS_XN), D, S, E, wv_);
            } PH_END
            PH_BEGIN(4) { const int t4_ = opaque_tid(wv_); SUBT_BEGIN(4); SUBT_END(4, ws, t4_); SUBT_BEGIN(5); phase_compress_mfma(A, wv_, i, lds); SUBT_END(5, ws, t4_); SUBT_BEGIN(6); phase_nsa_prep(A, wv_, i, lds); SUBT_END(6, ws, t4_); SUBT_BEGIN(7); phase_vtiles(A, wv_, lds); SUBT_END(7, ws, t4_); } PH_END
            PH_BEGIN(5) { phase_gla_a(A, wv_, i, lds); __syncthreads(); phase_nsa_attn_mfma(A, wv_, i, lds); } PH_END
            PH_BEGIN(6) phase_gla_c(A, wv_, i, lds, L == 0, L); PH_END
            PH_BEGIN(7) {
                pg8::DenseOrder S; S.init(T, D, D, (const bf16*)(ws + WS_WHOUT) + (size_t)i * D * D, G, cb);
                pg8::EpiResAddNorm E{(bf16*)(ws + WS_X16), D, (float*)(ws + WS_ROWSQ)};
                pg8::gemm_phase(lds, (const bf16*)(ws + WS_CAT), D, S, E, wv_);
            } PH_END
        } else {
            PH_BEGIN(8) {
                pg8::DenseOrder S; S.init(T, 4096, D, (const bf16*)(ws + WS_WSGIN) + (size_t)i * 4096 * D, G, cb);
                pg8::EpiBf16<1> E{(bf16*)(ws + WS_U), 2048, 8, (size_t)(WS_V - WS_U) / 2, (float*)(ws + WS_VSTAT), 8};
                pg8::gemm_phase(lds, (const bf16*)(ws + WS_XN), D, S, E, wv_);
            } PH_END
            PH_BEGIN(9) phase_sgu_mix_mfma(A, wv_, i, lds); PH_END
            PH_BEGIN(10) {
                pg8::DenseOrder S; S.init(T, D, 2048, (const bf16*)(ws + WS_WSGOUT) + (size_t)i * D * 2048, G, cb);
                pg8::EpiResAddNorm E{(bf16*)(ws + WS_X16), D, (float*)(ws + WS_ROWSQ)};
                pg8::gemm_phase(lds, (const bf16*)(ws + WS_UM), 2048, S, E, wv_);
            } PH_END
        }
        PH_BEGIN(12) {
            pg8::DenseOrder S; S.init(T, D, D, (const bf16*)(ws + WS_WQ) + (size_t)L * D * D, G, cb);
            pg8::EpiBf16RowScale E{(bf16*)(ws + WS_QX), D, (const float*)(ws + WS_ROWSQ)};
            pg8::gemm_phase(lds, (const bf16*)(ws + WS_X16), D, S, E, wv_);
            asm volatile("s_waitcnt vmcnt(0)" ::: "memory");
            __syncthreads();
            pg8::Unit u_;
#pragma unroll 1
            for (int ui_ = 0; S.next(ui_, u_); ++ui_) xattn_item(A, wv_, L, lds, u_.pm >> 3, u_.pn, u_.pm & 7);
        } PH_END
        PH_BEGIN(14) {
            pg8::DenseOrder S; S.init(T, D, D, (const bf16*)(ws + WS_WO) + (size_t)L * D * D, G, cb);
            pg8::EpiResAdd E{(bf16*)(ws + WS_X16), D};
            pg8::gemm_phase(lds, (const bf16*)(ws + WS_OX), D, S, E, wv_);
        } PH_END
        PH_BEGIN(15) phase_route_mfma(A, wv_, L, lds); PH_END
        PH_BEGIN(16) {
            LAS int* off = (LAS int*)(lds + pg8::STAGE_BYTES); LAS int* cn = off + 32;
            moe_offsets(A, wv_, L, off, cn);
            pg8::MoeOrder<true> S{(off[16] / 256) * 3, 3, G, cb, D, off, cn, (const int*)(ws + WS_LIST), (const char*)(ws + WS_WMIN) + (size_t)L * 16 * 768 * D * 2, (size_t)768 * D * 2};
            pg8::EpiSwiglu E{(bf16*)(ws + WS_H), DEXP};
            pg8::gemm_phase(lds, (const bf16*)(ws + WS_XN), D, S, E, wv_);
        } PH_END
        PH_BEGIN(17) {
            LAS int* off = (LAS int*)(lds + pg8::STAGE_BYTES); LAS int* cn = off + 32;
            moe_offsets(A, wv_, L, off, cn);
            pg8::MoeOrder<false> S{(off[16] / 256) * 4, 4, G, cb, DEXP, off, cn, (const int*)(ws + WS_LIST), (const char*)(ws + WS_WMOUT) + (size_t)L * 16 * D * DEXP * 2, (size_t)D * DEXP * 2};
            pg8::EpiBf16<0> E{(bf16*)(ws + WS_Y), D, 4, 0, nullptr, 0};
            pg8::gemm_phase(lds, (const bf16*)(ws + WS_H), DEXP, S, E, wv_);
        } PH_END
        PH_BEGIN(18) phase_moe_combine(A, wv_, L, lds); PH_END
    }
#undef PH_BEGIN
#undef PH_END
    if (hi - lo > 1) { for (int q_ = 0; q_ < PROBE_XBAR; ++q_) { XcdBarrier b_; b_.bar = (unsigned*)(opq(kargs()->ws) + WS_CTL) + CW_BAR; b_.x = xb_xcc_id(); b_.st = misc; xcd_barrier(b_, opaque_tid(wv_) == 0); } }
    if ((PROBE_NSA || PROBE_SUB) && blockIdx.x == 0) { const unsigned long long d_ = __hip_atomic_load((unsigned long long*)(A0->ws + WS_CTL + 48000), __ATOMIC_RELAXED, __HIP_MEMORY_SCOPE_AGENT); const unsigned long long t0 = __builtin_amdgcn_s_memrealtime(); while (__builtin_amdgcn_s_memrealtime() - t0 < d_) __builtin_amdgcn_s_sleep(8); }
    if (PROBE_TMASK && blockIdx.x == 0) { const unsigned long long t0 = __builtin_amdgcn_s_memrealtime(); while (__builtin_amdgcn_s_memrealtime() - t0 < tacc_) __builtin_amdgcn_s_sleep(8); }
}

extern "C" void kernel_launch(void* const* d_in, const int* in_sizes, int n_in, void* d_out, int out_size, void* d_ws, size_t ws_size, hipStream_t stream) {
    static int grid = 0;
    if (grid == 0) {
        if (n_in != N_IN || out_size != T * D || ws_size < WS_END) { fprintf(stderr, "kernel_launch: unexpected problem (n_in %d, out %d, ws %zu)\n", n_in, out_size, ws_size); grid = -1; return; }
        int dev = 0, cus = 0, per_cu = 0;
        if (hipGetDevice(&dev) != hipSuccess || hipDeviceGetAttribute(&cus, hipDeviceAttributeMultiprocessorCount, dev) != hipSuccess) { grid = -1; return; }
        if (hipFuncSetAttribute((const void*)mk_fwd, hipFuncAttributeMaxDynamicSharedMemorySize, LDS_BYTES) != hipSuccess) { fprintf(stderr, "kernel_launch: hipFuncSetAttribute failed\n"); grid = -1; return; }
        if (hipOccupancyMaxActiveBlocksPerMultiprocessor(&per_cu, (const void*)mk_fwd, 512, LDS_BYTES) != hipSuccess || per_cu < 1) fprintf(stderr, "kernel_launch: occupancy query says %d\n", per_cu);
        (void)hipGetLastError();
        grid = cus;
    }
    if (grid < 0) return;
    (void)hipMemsetAsync((char*)d_ws + WS_CTL, 0, CTL_BYTES, stream);
    Args a{};
    for (int i = 0; i < N_IN; ++i) a.in[i] = (const float*)d_in[i];
    a.out = (float*)d_out; a.ws = (unsigned char*)d_ws;
    for (int j = 0; j < 32; ++j) a.freq[j] = (float)pow(10000.0, -(double)j / 32.0);
#if MK_ONE_LAUNCH
    a.ph_lo = 0; a.ph_hi = NPHASES;
    hipLaunchKernelGGL(mk_fwd, dim3(grid), dim3(512), LDS_BYTES, stream, a);
#else
    for (int p = 0; p < NPHASES; ++p) { a.ph_lo = p; a.ph_hi = p + 1; hipLaunchKernelGGL(mk_fwd, dim3(grid), dim3(512), LDS_BYTES, stream, a); }
#endif
}
```

```cpp
#include <hip/hip_runtime.h>
#include <stdint.h>
#include <stdio.h>
#include <math.h>

#ifndef PROBE_MASK
#define PROBE_MASK 0
#endif
#ifndef PROBE_TMASK
#define PROBE_TMASK 0
#endif
#ifndef PROBE_NSA
#define PROBE_NSA 0
#endif
#ifndef PROBE_SUB
#define PROBE_SUB 0
#endif
#ifndef PROBE_XBAR
#define PROBE_XBAR 0
#endif
#ifndef PROBE_NSAX
#define PROBE_NSAX 0
#endif
#ifndef PROBE_REPS
#define PROBE_REPS 2
#endif
#ifndef MK_ONE_LAUNCH
#define MK_ONE_LAUNCH 1
#endif

#define LAS __attribute__((address_space(3)))
typedef unsigned short bf16;
typedef short bf16x8 __attribute__((ext_vector_type(8)));
typedef float f32x4 __attribute__((ext_vector_type(4)));
typedef float f32x2 __attribute__((ext_vector_type(2)));
typedef unsigned u32x4 __attribute__((ext_vector_type(4)));
typedef unsigned u32x2 __attribute__((ext_vector_type(2)));

constexpr int T = 16384, D = 1024, NBATCH = 8, S = 2048, DEPTH = 4;
constexpr int NMEM = 256;
constexpr float EPS = 1e-6f;
constexpr int HYN = 3072, HYSRC = 2856;
constexpr int C_QA = 0, C_KC = 512, C_VC = 640, C_KS = 768, C_VS = 896, C_KW = 1024, C_VW = 1152, C_QB = 1280, C_KB = 1536, C_VB = 1792, C_RB = 2304, C_GA = 2816, C_AL = 2840;
constexpr int NCMP = 127;
constexpr int NEXP = 16, DEXP = 384;
constexpr int SLOTS = 2 * T + NEXP * 256;

enum { I_X = 0, I_MEM, I_POS, I_NMIX, I_NXAT, I_NMEM, I_NFFN, I_HYBIN, I_HYBOUT, I_QNORM, I_KNORM, I_CMPPE, I_CMPW1, I_CMPW2, I_GATEB, I_WA2, I_BA, I_ONORM,
       I_SGIN, I_LNG, I_LNB, I_SGWS, I_SGBS, I_SGOUT, I_XWQ, I_XWKV, I_XWO, I_XQN, I_XKN, I_RW, I_RB, I_MOEIN, I_MOEOUT, N_IN };

constexpr size_t MiB = 1u << 20;
constexpr size_t WS_CTL = 0, CTL_BYTES = 1 * MiB;
constexpr size_t WS_WHYB = 1 * MiB;
constexpr size_t WS_WHOUT = WS_WHYB + 12 * MiB;
constexpr size_t WS_WSGIN = WS_WHOUT + 4 * MiB;
constexpr size_t WS_WSGOUT = WS_WSGIN + 16 * MiB;
constexpr size_t WS_WQ = WS_WSGOUT + 8 * MiB;
constexpr size_t WS_WKV = WS_WQ + 8 * MiB;
constexpr size_t WS_WO = WS_WKV + 16 * MiB;
constexpr size_t WS_WMIN = WS_WO + 8 * MiB;
constexpr size_t WS_WMOUT = WS_WMIN + 96 * MiB;
constexpr size_t WS_RW = WS_WMOUT + 48 * MiB;
constexpr size_t WS_XN = WS_RW + 1 * MiB;
constexpr size_t WS_BIG = WS_XN + 32 * MiB;
constexpr size_t WS_QA = WS_BIG + 128 * MiB;
constexpr size_t WS_KS = WS_QA + 16 * MiB;
constexpr size_t WS_KW = WS_KS + 4 * MiB;
constexpr size_t WS_KC = WS_KW + 4 * MiB;
constexpr size_t WS_VC = WS_KC + 1 * MiB;
constexpr size_t WS_CAT = WS_VC + 1 * MiB;
constexpr size_t WS_QX = WS_CAT + 32 * MiB;
constexpr size_t WS_OX = WS_QX + 32 * MiB;
constexpr size_t WS_MN = WS_OX + 32 * MiB;
constexpr size_t WS_KV = WS_MN + 4 * MiB;
constexpr size_t WS_COS = WS_KV + 32 * MiB;
constexpr size_t WS_SIN = WS_COS + 2 * MiB;
constexpr size_t WS_LIST = WS_SIN + 2 * MiB;
constexpr size_t WS_TOK = WS_LIST + 1 * MiB;
constexpr size_t WS_VT = WS_TOK + 1 * MiB;
constexpr size_t WS_VTA = WS_VT + 16 * MiB;
constexpr size_t WS_SLOC = WS_VTA + 32 * MiB;
constexpr size_t WS_DEC = WS_SLOC + 32 * MiB;
constexpr size_t WS_STT = WS_DEC + 1 * MiB;
constexpr size_t WS_WSB = WS_STT + 16 * MiB;
constexpr size_t WS_M0 = WS_WSB + 768 * 1024;
constexpr size_t WS_W1T = WS_WSB + 1 * MiB;
constexpr size_t WS_ROWSQ = WS_W1T + 1 * MiB;
constexpr size_t WS_VSTAT = WS_ROWSQ + 1 * MiB;
constexpr size_t WS_X16 = WS_VSTAT + 4 * MiB;
constexpr size_t WS_END = WS_X16 + 32 * MiB;
constexpr size_t WS_Y = WS_BIG, WS_H = WS_BIG + 72 * MiB, WS_U = WS_BIG, WS_V = WS_BIG + 64 * MiB, WS_UM = WS_QX;
constexpr int CW_BAR = 4096;
constexpr int CW_CNT = 8192;

constexpr int LDS_BYTES = 159744;
constexpr int LDS_MISC = LDS_BYTES - 64;

typedef __bf16 bf16x2_t __attribute__((ext_vector_type(2)));
__device__ __forceinline__ unsigned pk2(float lo, float hi) { const f32x2 v = {lo, hi}; return __builtin_bit_cast(unsigned, __builtin_convertvector(v, bf16x2_t)); }
__device__ __forceinline__ unsigned f2bf(float f) { return (unsigned)__builtin_bit_cast(unsigned short, (__bf16)f); }
__device__ __forceinline__ float bf2f(unsigned b) { return __uint_as_float(b << 16); }
__device__ __forceinline__ float bflo(unsigned w) { return __uint_as_float(w << 16); }
__device__ __forceinline__ float bfhi(unsigned w) { return __uint_as_float(w & 0xffff0000u); }
__device__ __forceinline__ void xswap16(float v, float& a, float& b) { unsigned u = __builtin_bit_cast(unsigned, v), u2 = u; asm volatile("" : "+v"(u2));
    const u32x2 r = __builtin_amdgcn_permlane16_swap(u, u2, false, false); unsigned r0 = r[0], r1 = r[1]; asm volatile("" : "+v"(r0), "+v"(r1)); a = __builtin_bit_cast(float, r0); b = __builtin_bit_cast(float, r1); }
__device__ __forceinline__ void xswap32(float v, float& a, float& b) { unsigned u = __builtin_bit_cast(unsigned, v), u2 = u; asm volatile("" : "+v"(u2));
    const u32x2 r = __builtin_amdgcn_permlane32_swap(u, u2, false, false); unsigned r0 = r[0], r1 = r[1]; asm volatile("" : "+v"(r0), "+v"(r1)); a = __builtin_bit_cast(float, r0); b = __builtin_bit_cast(float, r1); }
__device__ __forceinline__ float xadd16(float v) { float a, b; xswap16(v, a, b); return a + b; }
__device__ __forceinline__ float xadd32(float v) { float a, b; xswap32(v, a, b); return a + b; }
__device__ __forceinline__ float xmax16(float v) { float a, b; xswap16(v, a, b); return fmaxf(a, b); }
__device__ __forceinline__ float xmax32(float v) { float a, b; xswap32(v, a, b); return fmaxf(a, b); }
__device__ __forceinline__ float wave_sum(float v) {
#pragma unroll
    for (int o = 1; o < 16; o <<= 1) v += __shfl_xor(v, o);
    return xadd32(xadd16(v));
}
__device__ __forceinline__ float wave_max(float v) {
#pragma unroll
    for (int o = 1; o < 16; o <<= 1) v = fmaxf(v, __shfl_xor(v, o));
    return xmax32(xmax16(v));
}
__device__ __forceinline__ int opaque_tid(int wv) { int l; asm volatile("v_mbcnt_lo_u32_b32 %0, -1, 0\n\tv_mbcnt_hi_u32_b32 %0, -1, %0" : "=v"(l)); return wv * 64 + l; }
__device__ __forceinline__ unsigned char* opq(unsigned char* p) { asm volatile("" : "+s"(p)); return p; }
#define LDS_WAIT() asm volatile("s_waitcnt lgkmcnt(0)" ::: "memory")
__device__ __forceinline__ float gelu_tanh(float x) {
    const float u2 = x * (1.5957691216057308f + 0.07135481283f * x * x);
    return x * __builtin_amdgcn_rcpf(1.0f + __expf(-u2));
}
__device__ __forceinline__ float sigmoidf_(float x) { return __builtin_amdgcn_rcpf(1.0f + __expf(-x)); }

#define SUBT_BEGIN(id) unsigned long long subt_##id = 0; if (PROBE_SUB == (id)) subt_##id = __builtin_amdgcn_s_memrealtime();
#define SUBT_END(id, wsp, tidv) do { if (PROBE_SUB == (id) && blockIdx.x == 0 && (tidv) == 0) atomicAdd((unsigned long long*)((wsp) + WS_CTL + 48000), __builtin_amdgcn_s_memrealtime() - subt_##id); } while (0)
#define XB_TMO      128
#define XB_XCNT(j)  (256  + 64 * (j))
#define XB_XSUB(j)  (1280 + 64 * (j))
#define XB_XGEN(j)  (2304 + 64 * (j))
#define XB_TOP      3328
#define XB_TOPGEN   3392
#define XCD_BAR_WORDS 3456
#define XB_SPIN_CAP (1u << 22)

__device__ __forceinline__ unsigned xb_ld(unsigned* p)              { return __hip_atomic_load(p, __ATOMIC_RELAXED, __HIP_MEMORY_SCOPE_AGENT); }
__device__ __forceinline__ unsigned xb_add(unsigned* p, unsigned v) { return __hip_atomic_fetch_add(p, v, __ATOMIC_RELAXED, __HIP_MEMORY_SCOPE_AGENT); }
__device__ __forceinline__ unsigned xb_xcc_id() { return (unsigned)__builtin_amdgcn_s_getreg((3 << 11) | 20) & 0xFu; }
#define XB_SPIN(cond, bar) do { unsigned _sp = 0; while (cond) { __builtin_amdgcn_s_sleep(1); \
    if ((++_sp & 255u) == 0u) { if (xb_ld(&(bar)[XB_TMO])) break; if (_sp > XB_SPIN_CAP) { atomicAdd(&(bar)[XB_TMO], 1u); break; } } } } while (0)

struct XcdBarrier { unsigned* bar; unsigned x; volatile LAS unsigned* st; };
__device__ __forceinline__ unsigned* xb_opaque(unsigned* p) { unsigned long long v = (unsigned long long)p; unsigned lo = __builtin_amdgcn_readfirstlane((unsigned)v), hi = __builtin_amdgcn_readfirstlane((unsigned)(v >> 32));
    asm volatile("" : "+s"(lo), "+s"(hi)); return (unsigned*)(((unsigned long long)hi << 32) | lo); }

__device__ __forceinline__ XcdBarrier xcd_barrier_post(unsigned* bar, volatile LAS unsigned* st) {
    XcdBarrier b; b.bar = bar; b.x = xb_xcc_id(); b.st = st;
    if (threadIdx.x == 0) (void)xb_add(&bar[XB_XCNT(b.x)], 1u);
    return b;
}
__device__ __forceinline__ void xcd_barrier_complete(unsigned* bar, unsigned x, unsigned& nloc, unsigned& nx) {
    const unsigned G = gridDim.x * gridDim.y * gridDim.z;
    unsigned sum, cnt, mine, sp = 0u;
    for (;;) {
        sum = 0u; cnt = 0u; mine = 0u;
#pragma unroll
        for (unsigned j = 0; j < 16; ++j) { const unsigned c = xb_ld(&bar[XB_XCNT(j)]); sum += c; cnt += (c > 0u) ? 1u : 0u; mine = (j == x) ? c : mine; }
        if (sum == G) break;
        __builtin_amdgcn_s_sleep(1);
        if ((++sp & 255u) == 0u) { if (xb_ld(&bar[XB_TMO])) break; if (sp > XB_SPIN_CAP) { atomicAdd(&bar[XB_TMO], 1u); break; } }
    }
    nloc = mine > 0u ? mine : 1u; nx = cnt > 0u ? cnt : 1u;
}
__device__ __forceinline__ void xcd_barrier(const XcdBarrier& b, const bool is_t0) {
    asm volatile("s_waitcnt vmcnt(0)" ::: "memory");
    __syncthreads();
    if (is_t0) {
        unsigned* bar = b.bar;
        __builtin_amdgcn_s_waitcnt(0);
        unsigned nloc = b.st[0], nx = b.st[1];
        if (nloc == 0u) { xcd_barrier_complete(bar, b.x, nloc, nx); b.st[0] = nloc; b.st[1] = nx; }
        const unsigned old = xb_add(&bar[XB_XSUB(b.x)], 1u);
        const unsigned gen = old / nloc;
        if (old + 1u == (gen + 1u) * nloc) {
            __builtin_amdgcn_fence(__ATOMIC_RELEASE, "agent");
            asm volatile("s_waitcnt vmcnt(0)" ::: "memory");
            const unsigned og = xb_add(&bar[XB_TOP], 1u);
            const unsigned tg = og / nx;
            if (og + 1u == (tg + 1u) * nx) xb_add(&bar[XB_TOPGEN], 1u);
            else XB_SPIN(xb_ld(&bar[XB_TOPGEN]) == tg, bar);
            __builtin_amdgcn_fence(__ATOMIC_ACQUIRE, "agent");
            xb_add(&bar[XB_XGEN(b.x)], 1u);
            asm volatile("s_waitcnt vmcnt(0)" ::: "memory");
        } else {
            XB_SPIN(xb_ld(&bar[XB_XGEN(b.x)]) == gen, bar);
            __builtin_amdgcn_fence(__ATOMIC_ACQUIRE, "agent");
            asm volatile("s_waitcnt vmcnt(0)" ::: "memory");
        }
    }
    __syncthreads();
}

struct Args {
    const float* in[N_IN];
    float* out;
    unsigned char* ws;
    float freq[32];
    int ph_lo, ph_hi;
};

typedef const __attribute__((address_space(4))) Args* KArgs;
__device__ __forceinline__ KArgs kargs() { KArgs p = (KArgs)__builtin_amdgcn_kernarg_segment_ptr(); asm volatile("" : "+s"(p)); return p; }

__device__ __forceinline__ void st_bf16x4(bf16* p, f32x4 v) { u32x2 w; w.x = pk2(v[0], v[1]); w.y = pk2(v[2], v[3]); *(u32x2*)p = w; }


namespace pg8 {
constexpr int BM = 256, BK = 64, HALF = 128, HTB = HALF * BK * 2, STAGE_BYTES = 8 * HTB, NXCD = 8, WGM = 8;
__host__ __device__ __forceinline__ int lds_byte(int r, int c) { const int st = (r >> 4) * 2 + (c >> 5), rr = r & 15, cc = c & 31, ob = rr * 64 + cc * 2; return st * 1024 + (ob ^ (((ob >> 9) & 1) << 5)); }
__host__ __device__ __forceinline__ void stage_rc(int b, int& R, int& C) { const int st = b / 1024, sb = b % 1024, swz = sb ^ (((sb >> 9) & 1) << 5); R = (st >> 1) * 16 + swz / 64; C = (st & 1) * 32 + (swz % 64) / 2; }
__host__ __device__ __forceinline__ int perm32(int rho) { const int n = rho >> 4, i = rho & 15; return 8 * (i >> 2) + 4 * n + (i & 3); }
struct Unit { int pm, pn, e; };
struct DenseOrder {
    static constexpr bool GATHER = false;
    int nM, nN, nwg, G, c, K; const char* Bt;
    __device__ __forceinline__ void init(int M, int N, int K_, const bf16* Bt_, int G_, int c_) { nM = M / BM; nN = N / BM; nwg = nM * nN; G = G_; c = c_; K = K_; Bt = (const char*)Bt_; }
    __device__ __forceinline__ bool next(int i, Unit& u) const {
        const long L = (long)i * G + c; if (L >= nwg) return false;
        int wgid = (int)L; { const int q = nwg / NXCD, r = nwg % NXCD, xcd = wgid % NXCD, off = wgid / NXCD; wgid = (xcd < r ? xcd * (q + 1) : r * (q + 1) + (xcd - r) * q) + off; }
        const int nig = WGM * nN, gid = wgid / nig, fm = gid * WGM, gsz = (nM - fm) < WGM ? (nM - fm) : WGM;
        u.pm = fm + ((wgid % nig) % gsz); u.pn = (wgid % nig) / gsz; u.e = 0; return true;
    }
    __device__ __forceinline__ unsigned a_voff(const Unit& u, int half, int R) const { return (unsigned)((u.pm * BM + half * HALF + R) * K) * 2u; }
    __device__ __forceinline__ const char* b_tile(const Unit& u) const { return Bt + (size_t)u.pn * BM * K * 2; }
};
template <bool GATH> struct MoeOrder {
    static constexpr bool GATHER = GATH;
    int nunits, ntn, G, c, K; const LAS int* off; const LAS int* cn; const int* list; const char* Bt; size_t estride;
    __device__ __forceinline__ bool next(int i, Unit& u) const {
        const int L = i * G + c; if (L >= nunits) return false;
        u.pm = L / ntn; u.pn = L % ntn; const int s0 = u.pm * BM; int e = 0;
#pragma unroll
        for (int q = 1; q < 16; ++q) e += (s0 >= off[q]) ? 1 : 0;
        u.e = e; return true;
    }
    __device__ __forceinline__ unsigned a_voff(const Unit& u, int half, int R) const {
        const int slot = u.pm * BM + half * HALF + R;
        const int loc = slot - off[u.e]; const int tk = list[u.e * T + (loc < cn[u.e] ? loc : 0)];
        return (unsigned)(tk * K) * 2u;
    }
    __device__ __forceinline__ const char* b_tile(const Unit& u) const { return Bt + (size_t)u.e * estride + (size_t)u.pn * BM * K * 2; }
};
__device__ __forceinline__ unsigned cvt_pk_bf16(float lo, float hi) { return pk2(lo, hi); }

template <class Epi, class Sched>
__device__ __forceinline__ void gemm_phase(LAS unsigned char* lds, const bf16* Aptr, int K, const Sched& S, const Epi& E, int wv_) {
    const int tid = opaque_tid(wv_), wid = __builtin_amdgcn_readfirstlane(tid >> 6), lane = tid & 63, wr = wid >> 2, wc = wid & 3, fr = lane & 15, fq = lane >> 4;
    const int nt = K / BK;
    int Rr[2], Cc[2]; unsigned voffA[2], voffB[2];
#pragma unroll
    for (int i = 0; i < 2; ++i) { stage_rc(tid * 16 + i * 8192, Rr[i], Cc[i]); const int Rb = Epi::PERM ? ((Rr[i] & ~31) + perm32(Rr[i] & 31)) : Rr[i];
        voffA[i] = (unsigned)(Rr[i] * K + Cc[i]) * 2u; voffB[i] = (unsigned)(Rb * K + Cc[i]) * 2u; }
    const size_t kstep = (size_t)(BK * 2);
    const size_t hstep = (size_t)HALF * K * 2;
    const size_t tstep = 2 * hstep;
    const unsigned ldsw = (unsigned)wid * 1024u;
    const int aoff = lds_byte(wr * 64 + fr, fq * 8), boff = lds_byte(wc * 32 + fr, fq * 8);
    const char* const Ab = (const char*)Aptr;
#define PG8_SA(b, h) (((b) * 2 + (h)) * HTB)
#define PG8_SB(b, h) ((4 + (b) * 2 + (h)) * HTB)
#define PG8_STAGE(bufoff, gbase, voff) do { _Pragma("unroll") for (int _i = 0; _i < 2; ++_i) \
        __builtin_amdgcn_global_load_lds((const unsigned*)((const char*)(gbase) + (voff)[_i]), (LAS unsigned*)(lds + (bufoff) + ldsw + _i * 8192), 16, 0, 0); } while (0)
#define PG8_STAGE_A(bufoff, usenext, h, kofs) do { \
        if constexpr (Sched::GATHER) { const char* gb_ = Ab + (kofs); unsigned vv_[2] = {(usenext) ? vN[h][0] : vA[h][0], (usenext) ? vN[h][1] : vA[h][1]}; PG8_STAGE(bufoff, gb_, vv_); } \
        else { const char* gb_ = ((usenext) ? nA : cA) + (size_t)(h) * hstep + (kofs); PG8_STAGE(bufoff, gb_, voffA); } } while (0)
#define PG8_LDA(dst, b, h) do { _Pragma("unroll") for (int m = 0; m < 4; ++m) _Pragma("unroll") for (int k = 0; k < 2; ++k) dst[m][k] = *(const LAS bf16x8*)(lds + PG8_SA(b, h) + aoff + m * 2048 + k * 1024); } while (0)
#define PG8_LDB(dst, b, h) do { _Pragma("unroll") for (int n = 0; n < 2; ++n) _Pragma("unroll") for (int k = 0; k < 2; ++k) dst[n][k] = *(const LAS bf16x8*)(lds + PG8_SB(b, h) + boff + n * 2048 + k * 1024); } while (0)
#define PG8_MMA(ai, bj, At, Bt) do { __builtin_amdgcn_s_setprio(1); _Pragma("unroll") for (int m = 0; m < 4; ++m) _Pragma("unroll") for (int n = 0; n < 2; ++n) _Pragma("unroll") for (int k = 0; k < 2; ++k) \
        acc[ai][bj][m][n] = __builtin_amdgcn_mfma_f32_16x16x32_bf16(Bt[n][k], At[m][k], acc[ai][bj][m][n], 0, 0, 0); __builtin_amdgcn_s_setprio(0); } while (0)
#define PG8_WAIT_V(n) asm volatile("s_waitcnt vmcnt(" #n ")" ::: "memory")
#define PG8_WAIT_L(n) asm volatile("s_waitcnt lgkmcnt(" #n ")" ::: "memory")
#define PG8_BAR __builtin_amdgcn_s_barrier()
#define PG8_SCHED __builtin_amdgcn_sched_barrier(0)
    Unit cur, nxt; int ui = 0;
    if (!S.next(0, cur)) return;
    f32x4 acc[2][2][4][2];
#pragma unroll
    for (int a = 0; a < 2; ++a)
#pragma unroll
        for (int b = 0; b < 2; ++b)
#pragma unroll
            for (int m = 0; m < 4; ++m)
#pragma unroll
                for (int n = 0; n < 2; ++n) acc[a][b][m][n] = (f32x4){0.f, 0.f, 0.f, 0.f};
    bf16x8 At[4][2], B0[2][2], B1[2][2];
    unsigned vA[2][2], vN[2][2];
    const char* cA = Ab; const char* nA = Ab;
    if constexpr (Sched::GATHER) {
#pragma unroll
        for (int h = 0; h < 2; ++h)
#pragma unroll
            for (int i = 0; i < 2; ++i) { vA[h][i] = S.a_voff(cur, h, Rr[i]) + (unsigned)Cc[i] * 2u; vN[h][i] = vA[h][i]; }
    } else { cA = Ab + (size_t)cur.pm * tstep; nA = cA; }
    const char* cB = S.b_tile(cur);
    PG8_STAGE(PG8_SB(0, 0), cB, voffB); PG8_STAGE_A(PG8_SA(0, 0), false, 0, 0); PG8_STAGE(PG8_SB(0, 1), cB + hstep, voffB); PG8_STAGE_A(PG8_SA(0, 1), false, 1, 0);
    if (wr == 1) PG8_BAR;
    PG8_WAIT_V(4); PG8_BAR;
    PG8_STAGE(PG8_SB(1, 0), cB + kstep, voffB); PG8_STAGE_A(PG8_SA(1, 0), false, 0, kstep); PG8_STAGE(PG8_SB(1, 1), cB + hstep + kstep, voffB);
    PG8_WAIT_V(6); PG8_BAR;
    for (;;) {
        const bool has_next = S.next(ui + 1, nxt);
        const char* nB = has_next ? S.b_tile(nxt) : cB;
        if constexpr (Sched::GATHER) {
#pragma unroll
            for (int h = 0; h < 2; ++h)
#pragma unroll
                for (int i = 0; i < 2; ++i) vN[h][i] = has_next ? S.a_voff(nxt, h, Rr[i]) + (unsigned)Cc[i] * 2u : vA[h][i];
        } else nA = has_next ? Ab + (size_t)nxt.pm * tstep : cA;
        for (int t = 0; t < nt; t += 2) {
            const bool last = (t == nt - 2);
            const size_t k1 = (size_t)(t + 1) * kstep, k2 = last ? 0 : (size_t)(t + 2) * kstep, k3 = k2 + kstep;
            const char* b2 = last ? nB : cB + (size_t)(t + 2) * kstep; const char* b3 = b2 + kstep;
            PG8_LDB(B0, 0, 0); PG8_SCHED; PG8_LDA(At, 0, 0); PG8_STAGE_A(PG8_SA(1, 1), false, 1, k1);
            PG8_WAIT_L(8); PG8_BAR; PG8_WAIT_L(0); PG8_MMA(0, 0, At, B0); PG8_BAR; PG8_SCHED;
            PG8_LDB(B1, 0, 1); PG8_STAGE(PG8_SB(0, 0), b2, voffB);
            PG8_BAR; PG8_WAIT_L(0); PG8_MMA(0, 1, At, B1); PG8_BAR;
            PG8_LDA(At, 0, 1); PG8_STAGE_A(PG8_SA(0, 0), last, 0, k2);
            PG8_BAR; PG8_WAIT_L(0); PG8_MMA(1, 0, At, B0); PG8_BAR; PG8_SCHED;
            PG8_STAGE(PG8_SB(0, 1), b2 + hstep, voffB);
            PG8_WAIT_V(6); PG8_BAR; PG8_MMA(1, 1, At, B1); PG8_BAR;
            PG8_LDB(B0, 1, 0); PG8_SCHED; PG8_LDA(At, 1, 0); PG8_STAGE_A(PG8_SA(0, 1), last, 1, k2);
            PG8_WAIT_L(8); PG8_BAR; PG8_WAIT_L(0); PG8_MMA(0, 0, At, B0); PG8_BAR; PG8_SCHED;
            PG8_LDB(B1, 1, 1); PG8_STAGE(PG8_SB(1, 0), b3, voffB);
            PG8_BAR; PG8_WAIT_L(0); PG8_MMA(0, 1, At, B1); PG8_BAR;
            PG8_LDA(At, 1, 1); PG8_STAGE_A(PG8_SA(1, 0), last, 0, k3);
            PG8_BAR; PG8_WAIT_L(0); PG8_MMA(1, 0, At, B0); PG8_BAR; PG8_SCHED;
            PG8_STAGE(PG8_SB(1, 1), b3 + hstep, voffB);
            PG8_WAIT_V(6); PG8_BAR; PG8_MMA(1, 1, At, B1); PG8_BAR;
        }
        E(acc, cur, wr, wc, fr, fq);
        if (!has_next) break;
#pragma unroll
        for (int a = 0; a < 2; ++a)
#pragma unroll
            for (int b = 0; b < 2; ++b)
#pragma unroll
                for (int m = 0; m < 4; ++m)
#pragma unroll
                    for (int n = 0; n < 2; ++n) acc[a][b][m][n] = (f32x4){0.f, 0.f, 0.f, 0.f};
        cur = nxt; cB = nB; cA = nA; ++ui;
        if constexpr (Sched::GATHER) {
#pragma unroll
            for (int h = 0; h < 2; ++h)
#pragma unroll
                for (int i = 0; i < 2; ++i) vA[h][i] = vN[h][i];
        }
    }
    PG8_WAIT_V(0);
    if (wr == 0) PG8_BAR;
    PG8_BAR;
#undef PG8_SA
#undef PG8_SB
#undef PG8_STAGE
#undef PG8_STAGE_A
#undef PG8_LDA
#undef PG8_LDB
#undef PG8_MMA
#undef PG8_WAIT_V
#undef PG8_WAIT_L
#undef PG8_BAR
#undef PG8_SCHED
}
template <int ACT> struct EpiBf16 {
    static constexpr bool PERM = true;
    bf16* O; int ldc; int tpt; size_t tstride; float* stats; int stat_pn0;
    __device__ __forceinline__ void operator()(const f32x4 (&acc)[2][2][4][2], const Unit& u, int wr, int wc, int fr, int fq) const {
        const int row0 = u.pm * BM + wr * 64 + fr; const int tt = u.pn / tpt; bf16* base = O + (size_t)tt * tstride; const int col0 = (u.pn - tt * tpt) * BM + wc * 32 + 8 * fq;
#pragma unroll
        for (int ai = 0; ai < 2; ++ai)
#pragma unroll
            for (int m = 0; m < 4; ++m) { bf16* rowp = base + (size_t)(row0 + ai * HALF + m * 16) * ldc + col0; float psum = 0.f, psq = 0.f;
#pragma unroll
                for (int bj = 0; bj < 2; ++bj) { f32x4 v0 = acc[ai][bj][m][0], v1 = acc[ai][bj][m][1];
                    if (ACT == 1) {
#pragma unroll
                        for (int q = 0; q < 4; ++q) { v0[q] = gelu_tanh(v0[q]); v1[q] = gelu_tanh(v1[q]); } }
                    if (ACT == 1) { psum += ((v0[0] + v0[1]) + (v0[2] + v0[3])) + ((v1[0] + v1[1]) + (v1[2] + v1[3]));
                        psq += ((v0[0] * v0[0] + v0[1] * v0[1]) + (v0[2] * v0[2] + v0[3] * v0[3])) + ((v1[0] * v1[0] + v1[1] * v1[1]) + (v1[2] * v1[2] + v1[3] * v1[3])); }
                    u32x4 w; w.x = cvt_pk_bf16(v0[0], v0[1]); w.y = cvt_pk_bf16(v0[2], v0[3]); w.z = cvt_pk_bf16(v1[0], v1[1]); w.w = cvt_pk_bf16(v1[2], v1[3]);
                    *(u32x4*)(rowp + bj * HALF) = w; }
                if (ACT == 1 && stats && u.pn >= stat_pn0) {
                    psum = xadd32(xadd16(psum)); psq = xadd32(xadd16(psq));
                    if (fq == 0) { f32x2 st2 = {psum, psq}; *(f32x2*)(stats + ((size_t)(row0 + ai * HALF + m * 16) * 32 + (u.pn - stat_pn0) * 4 + wc) * 2) = st2; } } }
    }
};
struct EpiResAdd {
    static constexpr bool PERM = false;
    bf16* X; int ldc;
    __device__ __forceinline__ void operator()(const f32x4 (&acc)[2][2][4][2], const Unit& u, int wr, int wc, int fr, int fq) const {
        const int row0 = u.pm * BM + wr * 64 + fr, col0 = u.pn * BM + wc * 32 + 4 * fq;
#pragma unroll
        for (int ai = 0; ai < 2; ++ai) {
            u32x2 x[4][2][2];
#pragma unroll
            for (int m = 0; m < 4; ++m)
#pragma unroll
                for (int bj = 0; bj < 2; ++bj)
#pragma unroll
                    for (int n = 0; n < 2; ++n) x[m][bj][n] = *(const u32x2*)(X + (size_t)(row0 + ai * HALF + m * 16) * ldc + col0 + bj * HALF + n * 16);
#pragma unroll
            for (int m = 0; m < 4; ++m)
#pragma unroll
                for (int bj = 0; bj < 2; ++bj)
#pragma unroll
                    for (int n = 0; n < 2; ++n) { const f32x4 a = acc[ai][bj][m][n]; const u32x2 xv = x[m][bj][n];
                        u32x2 w; w.x = pk2(bflo(xv.x) + a.x, bfhi(xv.x) + a.y); w.y = pk2(bflo(xv.y) + a.z, bfhi(xv.y) + a.w);
                        *(u32x2*)(X + (size_t)(row0 + ai * HALF + m * 16) * ldc + col0 + bj * HALF + n * 16) = w; }
        }
    }
};
struct EpiResAddNorm {
    static constexpr bool PERM = false;
    bf16* X; int ldc; float* rowsq;
    __device__ __forceinline__ void operator()(const f32x4 (&acc)[2][2][4][2], const Unit& u, int wr, int wc, int fr, int fq) const {
        const int row0 = u.pm * BM + wr * 64 + fr, col0 = u.pn * BM + wc * 32 + 4 * fq;
#pragma unroll
        for (int ai = 0; ai < 2; ++ai) {
            u32x2 x[4][2][2];
#pragma unroll
            for (int m = 0; m < 4; ++m)
#pragma unroll
                for (int bj = 0; bj < 2; ++bj)
#pragma unroll
                    for (int n = 0; n < 2; ++n) x[m][bj][n] = *(const u32x2*)(X + (size_t)(row0 + ai * HALF + m * 16) * ldc + col0 + bj * HALF + n * 16);
#pragma unroll
            for (int m = 0; m < 4; ++m) {
                const size_t ro = (size_t)(row0 + ai * HALF + m * 16) * ldc + col0; float ssq = 0.f;
#pragma unroll
                for (int bj = 0; bj < 2; ++bj)
#pragma unroll
                    for (int n = 0; n < 2; ++n) { const f32x4 a = acc[ai][bj][m][n]; const u32x2 xv = x[m][bj][n];
                        u32x2 w; w.x = pk2(bflo(xv.x) + a.x, bfhi(xv.x) + a.y); w.y = pk2(bflo(xv.y) + a.z, bfhi(xv.y) + a.w);
                        *(u32x2*)(X + ro + bj * HALF + n * 16) = w;
                        const float v0 = bflo(w.x), v1 = bfhi(w.x), v2 = bflo(w.y), v3 = bfhi(w.y);
                        ssq += (v0 * v0 + v1 * v1) + (v2 * v2 + v3 * v3); }
                ssq = xadd32(xadd16(ssq));
                if (fq == 0) rowsq[(size_t)(row0 + ai * HALF + m * 16) * 16 + u.pn * 4 + wc] = ssq;
            }
        }
    }
};
struct EpiBf16RowScale {
    static constexpr bool PERM = true;
    bf16* O; int ldc; const float* rowsq;
    __device__ __forceinline__ void operator()(const f32x4 (&acc)[2][2][4][2], const Unit& u, int wr, int wc, int fr, int fq) const {
        const int row0 = u.pm * BM + wr * 64 + fr, col0 = u.pn * BM + wc * 32 + 8 * fq;
#pragma unroll
        for (int ai = 0; ai < 2; ++ai) {
            float rs[4];
#pragma unroll
            for (int m = 0; m < 4; ++m) { const f32x4* p = (const f32x4*)(rowsq + (size_t)(row0 + ai * HALF + m * 16) * 16); const f32x4 a = p[0], b = p[1], c = p[2], d = p[3];
                rs[m] = rsqrtf((((a.x + a.y) + (a.z + a.w)) + ((b.x + b.y) + (b.z + b.w)) + (((c.x + c.y) + (c.z + c.w)) + ((d.x + d.y) + (d.z + d.w)))) * (1.f / 1024.f) + EPS); }
#pragma unroll
            for (int m = 0; m < 4; ++m) { bf16* rowp = O + (size_t)(row0 + ai * HALF + m * 16) * ldc + col0;
#pragma unroll
                for (int bj = 0; bj < 2; ++bj) { const f32x4 v0 = acc[ai][bj][m][0] * rs[m], v1 = acc[ai][bj][m][1] * rs[m];
                    u32x4 w; w.x = cvt_pk_bf16(v0[0], v0[1]); w.y = cvt_pk_bf16(v0[2], v0[3]); w.z = cvt_pk_bf16(v1[0], v1[1]); w.w = cvt_pk_bf16(v1[2], v1[3]);
                    *(u32x4*)(rowp + bj * HALF) = w; } }
        }
    }
};
struct EpiSwiglu {
    static constexpr bool PERM = true;
    bf16* H; int ldc;
    __device__ __forceinline__ void operator()(const f32x4 (&acc)[2][2][4][2], const Unit& u, int wr, int wc, int fr, int fq) const {
        const int row0 = u.pm * BM + wr * 64 + fr, col0 = u.pn * HALF + wc * 32 + 8 * fq;
#pragma unroll
        for (int ai = 0; ai < 2; ++ai)
#pragma unroll
            for (int m = 0; m < 4; ++m) {
                float o[8];
#pragma unroll
                for (int n = 0; n < 2; ++n)
#pragma unroll
                    for (int q = 0; q < 4; ++q) { const float g = acc[ai][0][m][n][q]; o[4 * n + q] = g * sigmoidf_(g) * acc[ai][1][m][n][q]; }
                u32x4 w; w.x = cvt_pk_bf16(o[0], o[1]); w.y = cvt_pk_bf16(o[2], o[3]); w.z = cvt_pk_bf16(o[4], o[5]); w.w = cvt_pk_bf16(o[6], o[7]);
                *(u32x4*)(H + (size_t)(row0 + ai * HALF + m * 16) * ldc + col0) = w; }
    }
};
}

__device__ __forceinline__ int hyb_colmap(int n) {
    if (n < 1280) return n;
    if (n < 1536) return 1304 + (n - 1280);
    if (n < 1792) return 1560 + (n - 1536);
    if (n < 2304) return 1816 + (n - 1792);
    if (n < 2816) return 2344 + (n - 2304);
    if (n < 2840) return 1280 + (n - 2816);
    if (n < 2856) return 2328 + (n - 2840);
    return -1;
}
__device__ __forceinline__ void tr_item(const float* __restrict__ W, int Nsrc, int K, bf16* __restrict__ Wt, const float* __restrict__ gain, int kind, int nblk, LAS float* scr, int item, int lane) {
    const int kb = item / nblk, nb = item % nblk, k0 = 64 * kb, n0 = 64 * nb;
    const int ksub = lane >> 4, n4 = lane & 15, n = n0 + 4 * n4;
    int col;
    if (kind == 0) col = n; else if (kind == 1) col = hyb_colmap(n); else { const int pn = n >> 8, r = n & 255; col = (r >> 7) * 384 + pn * 128 + (r & 127); }
    f32x4 v[16];
#pragma unroll
    for (int i = 0; i < 16; ++i) v[i] = col >= 0 ? *(const f32x4*)(W + (size_t)(k0 + 4 * i + ksub) * Nsrc + col) : (f32x4){0.f, 0.f, 0.f, 0.f};
    if (gain) {
#pragma unroll
        for (int i = 0; i < 16; ++i) v[i] = v[i] * gain[k0 + 4 * i + ksub];
    }
#pragma unroll
    for (int i = 0; i < 16; ++i) { LAS float* d = scr + (4 * i + ksub) * 65 + 4 * n4; d[0] = v[i].x; d[1] = v[i].y; d[2] = v[i].z; d[3] = v[i].w; }
    LDS_WAIT();
    const int c = lane & 7;
#pragma unroll
    for (int jx = 0; jx < 8; ++jx) {
        const int nn = (lane >> 3) + 8 * jx; const LAS float* s = scr + (8 * c) * 65 + nn;
        u32x4 o; o.x = pk2(s[0 * 65], s[1 * 65]); o.y = pk2(s[2 * 65], s[3 * 65]); o.z = pk2(s[4 * 65], s[5 * 65]); o.w = pk2(s[6 * 65], s[7 * 65]);
        *(u32x4*)(Wt + (size_t)(n0 + nn) * K + k0 + 8 * c) = o;
    }
    LDS_WAIT();
}
__device__ __forceinline__ void rms_row_to_bf16(const float* __restrict__ xrow, bf16* __restrict__ orow, bf16* __restrict__ copy, int lane) {
    const f32x4* xr = (const f32x4*)xrow + lane;
    f32x4 v[4]; float s = 0.f;
#pragma unroll
    for (int j = 0; j < 4; ++j) { v[j] = xr[64 * j]; s += (v[j].x * v[j].x + v[j].y * v[j].y) + (v[j].z * v[j].z + v[j].w * v[j].w); }
    const float rstd = rsqrtf(wave_sum(s) * (1.f / 1024.f) + EPS);
    u32x2* o8 = (u32x2*)orow + lane;
#pragma unroll
    for (int j = 0; j < 4; ++j) { u32x2 w; w.x = pk2(v[j].x * rstd, v[j].y * rstd); w.y = pk2(v[j].z * rstd, v[j].w * rstd); o8[64 * j] = w; }
    if (copy) { u32x2* c4 = (u32x2*)copy + lane;
#pragma unroll
        for (int j = 0; j < 4; ++j) { u32x2 w; w.x = pk2(v[j].x, v[j].y); w.y = pk2(v[j].z, v[j].w); c4[64 * j] = w; } }
}

constexpr int MOE_W_PER_L = 16 * (192 + 96);
__device__ __forceinline__ void moe_weight_item(KArgs A, unsigned char* ws, LAS float* scr, const int l_lo, const int it, const int lane) {
    const int l = l_lo + it / MOE_W_PER_L; int r = it % MOE_W_PER_L;
    if (r < 16 * 192) { const int sl = l * 16 + r / 192; tr_item(A->in[I_MOEIN] + (size_t)sl * 1024 * 768, 768, 1024, (bf16*)(ws + WS_WMIN) + (size_t)sl * 768 * 1024, A->in[I_NFFN] + l * 1024, 2, 12, scr, r % 192, lane); }
    else { r -= 16 * 192; const int sl = l * 16 + r / 96; tr_item(A->in[I_MOEOUT] + (size_t)sl * 384 * 1024, 1024, 384, (bf16*)(ws + WS_WMOUT) + (size_t)sl * 1024 * 384, nullptr, 0, 16, scr, r % 96, lane); }
}
__device__ __forceinline__ void moe_weight_share(KArgs A, int wv_, LAS float* scr, LAS unsigned* wq, const int l_lo, const int blk) {
    const int lane = opaque_tid(wv_) & 63;
    unsigned char* ws = opq(A->ws);
    constexpr int PER_BLK = 2 * MOE_W_PER_L / 256;
    for (;;) {
        unsigned k = 0; if (lane == 0) k = atomicAdd((unsigned*)wq, 1u);
        k = __builtin_amdgcn_readfirstlane(k);
        if (k >= (unsigned)PER_BLK) break;
        moe_weight_item(A, ws, scr, l_lo, blk * PER_BLK + (int)k, lane);
    }
}

__device__ __forceinline__ void phase_prologue(KArgs A, int wv_, LAS unsigned char* lds) {
    const int tid = opaque_tid(wv_), wid = __builtin_amdgcn_readfirstlane(tid >> 6), lane = tid & 63;
    const int gw = blockIdx.x * 8 + wid, NGW = gridDim.x * 8;
    LAS float* scr = (LAS float*)(lds + wid * 16640);
    unsigned char* ws = opq(A->ws);
    constexpr int N_HYB = 2 * 768, N_HOUT = 2 * 256, N_SGIN = 2 * 1024, N_SGOUT = 2 * 512, N_WQ = 4 * 256, N_WKV = 4 * 512, N_WO = 4 * 256, N_W1T = 4 * 32;
    constexpr int NITEMS = N_HYB + N_HOUT + N_SGIN + N_SGOUT + N_WQ + N_WKV + N_WO + N_W1T;
    for (int it = gw; it < NITEMS; it += NGW) {
        int r = it;
        if (r < N_HYB) { const int sl = r / 768; tr_item(A->in[I_HYBIN] + (size_t)sl * 1024 * HYSRC, HYSRC, 1024, (bf16*)(ws + WS_WHYB) + (size_t)sl * HYN * 1024, A->in[I_NMIX] + (2 * sl) * 1024, 1, 48, scr, r % 768, lane); continue; } r -= N_HYB;
        if (r < N_HOUT) { const int sl = r / 256; tr_item(A->in[I_HYBOUT] + (size_t)sl * 1024 * 1024, 1024, 1024, (bf16*)(ws + WS_WHOUT) + (size_t)sl * 1024 * 1024, nullptr, 0, 16, scr, r % 256, lane); continue; } r -= N_HOUT;
        if (r < N_SGIN) { const int sl = r / 1024; tr_item(A->in[I_SGIN] + (size_t)sl * 1024 * 4096, 4096, 1024, (bf16*)(ws + WS_WSGIN) + (size_t)sl * 4096 * 1024, A->in[I_NMIX] + (2 * sl + 1) * 1024, 0, 64, scr, r % 1024, lane); continue; } r -= N_SGIN;
        if (r < N_SGOUT) { const int sl = r / 512; tr_item(A->in[I_SGOUT] + (size_t)sl * 2048 * 1024, 1024, 2048, (bf16*)(ws + WS_WSGOUT) + (size_t)sl * 1024 * 2048, nullptr, 0, 16, scr, r % 512, lane); continue; } r -= N_SGOUT;
        if (r < N_WQ) { const int sl = r / 256; tr_item(A->in[I_XWQ] + (size_t)sl * 1024 * 1024, 1024, 1024, (bf16*)(ws + WS_WQ) + (size_t)sl * 1024 * 1024, A->in[I_NXAT] + sl * 1024, 0, 16, scr, r % 256, lane); continue; } r -= N_WQ;
        if (r < N_WKV) { const int sl = r / 512; tr_item(A->in[I_XWKV] + (size_t)sl * 1024 * 2048, 2048, 1024, (bf16*)(ws + WS_WKV) + (size_t)sl * 2048 * 1024, A->in[I_NMEM] + sl * 1024, 0, 32, scr, r % 512, lane); continue; } r -= N_WKV;
        if (r < N_WO) { const int sl = r / 256; tr_item(A->in[I_XWO] + (size_t)sl * 1024 * 1024, 1024, 1024, (bf16*)(ws + WS_WO) + (size_t)sl * 1024 * 1024, nullptr, 0, 16, scr, r % 256, lane); continue; } r -= N_WO;
        { const int sl = r / 32; tr_item(A->in[I_CMPW1] + (size_t)sl * 2048 * 64, 64, 2048, (bf16*)(ws + WS_W1T) + (size_t)sl * 64 * 2048, nullptr, 0, 1, scr, r % 32, lane); }
    }
    for (int m = gw; m < T; m += NGW) rms_row_to_bf16(A->in[I_X] + (size_t)m * D, (bf16*)(ws + WS_XN) + (size_t)m * D, (bf16*)(ws + WS_X16) + (size_t)m * D, lane);
    for (int m = gw; m < NBATCH * NMEM; m += NGW) rms_row_to_bf16(A->in[I_MEM] + (size_t)m * D, (bf16*)(ws + WS_MN) + (size_t)m * D, nullptr, lane);
    const int gt = blockIdx.x * 512 + tid, NGT = gridDim.x * 512;
    const int* pos = (const int*)A->in[I_POS];
    float* cosT = (float*)(ws + WS_COS); float* sinT = (float*)(ws + WS_SIN);
    for (int i = gt; i < T * 32; i += NGT) {
        const int t = i >> 5, j = i & 31;
        const float ang = (float)pos[t] * A->freq[j];
        const double rev = (double)ang * 0.15915494309189533577;
        const float fr = (float)(rev - rint(rev));
        cosT[i] = __builtin_amdgcn_cosf(fr); sinT[i] = __builtin_amdgcn_sinf(fr);
    }
    { bf16* WSB = (bf16*)(ws + WS_WSB); float* M0 = (float*)(ws + WS_M0); const float* wsg = A->in[I_SGWS];
      for (int e = gt; e < 2 * 8 * 128 * 128; e += NGT) { const int s = e & 127, t = (e >> 7) & 127; WSB[e] = (bf16)f2bf(s <= t ? wsg[e] : 0.f); }
      for (int e = gt; e < 2 * 8 * 128; e += NGT) { const int t = e & 127; const float* r = wsg + (size_t)e * 128; float a = 0.f; for (int s = 0; s <= t; ++s) a += r[s]; M0[e] = a; } }
    float* RW = (float*)(ws + WS_RW);
    for (int i = gt; i < DEPTH * NEXP * D; i += NGT) { const int k = i & 1023, e = (i >> 10) & 15, l = i >> 14; RW[i] = A->in[I_RW][k * NEXP + e] * A->in[I_NFFN][l * D + k]; }
}

__device__ __forceinline__ void phase_knorm(KArgs A, int wv_, const int gw, const int NGW) {
    const int tid_ = opaque_tid(wv_); const int lane = tid_ & 63;
    bf16* KV = (bf16*)(opq(A->ws) + WS_KV);
    for (int it0 = gw * 4; it0 < DEPTH * 2048 * 4; it0 += NGW * 4) {
        u32x2 w[4];
#pragma unroll
        for (int q = 0; q < 4; ++q) { const int it = it0 + q; const int h = it & 3, m = (it >> 2) & 2047, l = it >> 13; w[q] = *(const u32x2*)(KV + (size_t)m * 8192 + l * 2048 + h * 256 + 4 * lane); }
#pragma unroll
        for (int q = 0; q < 4; ++q) {
            const int it = it0 + q; const int h = it & 3, m = (it >> 2) & 2047, l = it >> 13;
            const float x0 = bflo(w[q].x), x1 = bfhi(w[q].x), x2 = bflo(w[q].y), x3 = bfhi(w[q].y);
            const float rstd = rsqrtf(wave_sum(x0 * x0 + x1 * x1 + x2 * x2 + x3 * x3) * (1.f / 256.f) + EPS) * 0.0625f;
            const f32x4 g = *(const f32x4*)(A->in[I_XKN] + l * 256 + 4 * lane) * *(const f32x4*)(A->in[I_XQN] + l * 256 + 4 * lane);
            u32x2 o; o.x = pk2(x0 * rstd * g.x, x1 * rstd * g.y); o.y = pk2(x2 * rstd * g.z, x3 * rstd * g.w);
            *(u32x2*)(KV + (size_t)m * 8192 + l * 2048 + h * 256 + 4 * lane) = o;
        }
    }
}

__device__ __forceinline__ int kpos64(int tok) { const int k = tok & 31; return (tok & 32) + 8 * ((k >> 2) & 3) + 4 * (k >> 4) + (k & 3); }
__device__ __forceinline__ int kperm64(int p) { const int fq = (p >> 3) & 3, j = p & 7; return (p & 32) + 16 * (j >> 2) + 4 * fq + (j & 3); }

__device__ __forceinline__ void phase_nsa_prep(KArgs A, int wv_, int i, LAS unsigned char* lds) {
    const int tid_ = opaque_tid(wv_); const int wid = __builtin_amdgcn_readfirstlane(tid_ >> 6), lane = tid_ & 63; const int gw = blockIdx.x * 8 + wid, NGW = gridDim.x * 8;
    unsigned char* ws = opq(A->ws);
    const bf16* HY = (const bf16*)(ws + WS_BIG);
    const float* cosT = (const float*)(ws + WS_COS); const float* sinT = (const float*)(ws + WS_SIN);
    bf16* QA = (bf16*)(ws + WS_QA); bf16* KS = (bf16*)(ws + WS_KS); bf16* KW = (bf16*)(ws + WS_KW);
    (void)lds;
    const int j8 = lane & 7, ug = lane >> 3;
    const int u1 = 8 + (ug & 3);
    const int src0 = C_QA + 64 * ug, src1 = u1 < 10 ? C_KS + 64 * (u1 - 8) : C_KW + 64 * (u1 - 10);
    const float* g0p = A->in[I_QNORM] + i * 64 + 8 * j8; const float* g1p = A->in[I_KNORM] + (i * 3 + (u1 < 10 ? 1 : 2)) * 64 + 8 * j8;
    const f32x4 g0a = *(const f32x4*)g0p, g0b = *(const f32x4*)(g0p + 4), g1a = *(const f32x4*)g1p, g1b = *(const f32x4*)(g1p + 4);
    u32x4 w0 = (u32x4){0u, 0u, 0u, 0u}, w1 = w0; f32x4 ca, cb, sa, sb;
    if (gw < T) { w0 = *(const u32x4*)(HY + (size_t)gw * HYN + src0 + 8 * j8); w1 = *(const u32x4*)(HY + (size_t)gw * HYN + src1 + 8 * j8);
        const float* cp = cosT + gw * 32 + 8 * (j8 & 3); const float* sp = sinT + gw * 32 + 8 * (j8 & 3); ca = *(const f32x4*)cp; cb = *(const f32x4*)(cp + 4); sa = *(const f32x4*)sp; sb = *(const f32x4*)(sp + 4); }
    for (int t = gw; t < T; t += NGW) {
        const int tn = t + NGW < T ? t + NGW : t;
        const u32x4 n0 = *(const u32x4*)(HY + (size_t)tn * HYN + src0 + 8 * j8), n1 = *(const u32x4*)(HY + (size_t)tn * HYN + src1 + 8 * j8);
        const float* cp = cosT + tn * 32 + 8 * (j8 & 3); const float* sp = sinT + tn * 32 + 8 * (j8 & 3);
        const f32x4 nca = *(const f32x4*)cp, ncb = *(const f32x4*)(cp + 4), nsa = *(const f32x4*)sp, nsb = *(const f32x4*)(sp + 4);
#pragma unroll
        for (int pass = 0; pass < 2; ++pass) {
            const u32x4 w = pass ? w1 : w0; const f32x4 ga = pass ? g1a : g0a, gb = pass ? g1b : g0b;
            float x[8] = {bflo(w.x), bfhi(w.x), bflo(w.y), bfhi(w.y), bflo(w.z), bfhi(w.z), bflo(w.w), bfhi(w.w)};
            float ssq = 0.f;
#pragma unroll
            for (int q = 0; q < 8; ++q) ssq += x[q] * x[q];
            ssq += __shfl_xor(ssq, 1); ssq += __shfl_xor(ssq, 2); ssq += __shfl_xor(ssq, 4);
            const float rs = rsqrtf(ssq * (1.f / 64.f) + EPS) * (pass ? 1.f : 0.125f * 1.4426950408889634f);
            const float gg[8] = {ga.x, ga.y, ga.z, ga.w, gb.x, gb.y, gb.z, gb.w}, cc[8] = {ca.x, ca.y, ca.z, ca.w, cb.x, cb.y, cb.z, cb.w}, ss[8] = {sa.x, sa.y, sa.z, sa.w, sb.x, sb.y, sb.z, sb.w};
            float o[8];
#pragma unroll
            for (int q = 0; q < 8; ++q) { const float y = x[q] * rs * gg[q]; const float pr = __shfl_xor(y, 4);
                o[q] = j8 < 4 ? y * cc[q] - pr * ss[q] : y * cc[q] + pr * ss[q]; }
            u32x4 ow; ow.x = pk2(o[0], o[1]); ow.y = pk2(o[2], o[3]); ow.z = pk2(o[4], o[5]); ow.w = pk2(o[6], o[7]);
            if (pass == 0) *(u32x4*)(QA + (size_t)t * 512 + 64 * ug + 8 * j8) = ow;
            else if (lane < 32) { bf16* dst = (u1 < 10 ? KS + (size_t)t * 128 + 64 * (u1 - 8) : KW + (size_t)t * 128 + 64 * (u1 - 10)); *(u32x4*)(dst + 8 * j8) = ow; }
        }
        w0 = n0; w1 = n1; ca = nca; cb = ncb; sa = nsa; sb = nsb;
    }
}

__device__ __forceinline__ void phase_compress_mfma(KArgs A, int wv_, int i, LAS unsigned char* lds) {
    const int tid = opaque_tid(wv_), wid = __builtin_amdgcn_readfirstlane(tid >> 6), lane = tid & 63, fr = lane & 15, fq = lane >> 4;
    unsigned char* ws = opq(A->ws);
    const bf16* HY = (const bf16*)(ws + WS_BIG);
    const float* cosT = (const float*)(ws + WS_COS); const float* sinT = (const float*)(ws + WS_SIN);
    LAS float* part = (LAS float*)lds;
    LAS float* hbuf = part + 8 * 1024;
    LAS float* obuf = hbuf + 1024;
    LAS float* w2l = obuf + 1024;
    int w2kv = -1;
    for (int it = blockIdx.x; it < 2 * 127; it += gridDim.x) {
        const int kv = it / 127, tile = it % 127;
        const float* pe = A->in[I_CMPPE] + (size_t)(i * 2 + kv) * 32 * 64;
        const float* w2 = A->in[I_CMPW2] + (size_t)(i * 2 + kv) * 64 * 64;
        const bf16* w1t = (const bf16*)(ws + WS_W1T) + (size_t)(i * 2 + kv) * 64 * 2048;
        const int coff = kv ? C_VC : C_KC;
        if (kv != w2kv) { __syncthreads(); for (int e4 = tid; e4 < 1024; e4 += 512) *(LAS f32x4*)(w2l + 4 * e4) = *(const f32x4*)(w2 + 4 * e4); w2kv = kv; }
        {
            const int R = tile * 16 + fr, g = R & 1, bn = R >> 1, n = bn % NCMP, b = bn / NCMP;
            const bf16* arow = HY + (size_t)(b * S + 16 * n) * HYN + coff + g * 64;
            f32x4 acc[4];
#pragma unroll
            for (int t = 0; t < 4; ++t) acc[t] = (f32x4){0.f, 0.f, 0.f, 0.f};
#pragma unroll 4
            for (int s = 0; s < 8; ++s) {
                const int k0 = 256 * wid + 32 * s, l = k0 >> 6, d0 = (k0 & 63) + 8 * fq;
                const u32x4 hw = *(const u32x4*)(arow + (size_t)l * HYN + d0);
                const f32x4 p0 = *(const f32x4*)(pe + l * 64 + d0), p1 = *(const f32x4*)(pe + l * 64 + d0 + 4);
                u32x4 aw; aw.x = pk2(bflo(hw.x) + p0.x, bfhi(hw.x) + p0.y); aw.y = pk2(bflo(hw.y) + p0.z, bfhi(hw.y) + p0.w); aw.z = pk2(bflo(hw.z) + p1.x, bfhi(hw.z) + p1.y); aw.w = pk2(bflo(hw.w) + p1.z, bfhi(hw.w) + p1.w);
                const bf16x8 af = __builtin_bit_cast(bf16x8, aw);
#pragma unroll
                for (int t = 0; t < 4; ++t) { const bf16x8 bfr = *(const bf16x8*)(w1t + (size_t)(16 * t + fr) * 2048 + k0 + 8 * fq);
                    acc[t] = __builtin_amdgcn_mfma_f32_16x16x32_bf16(af, bfr, acc[t], 0, 0, 0); }
            }
            __syncthreads();
#pragma unroll
            for (int t = 0; t < 4; ++t)
#pragma unroll
                for (int r = 0; r < 4; ++r) part[wid * 1024 + (4 * fq + r) * 64 + 16 * t + fr] = acc[t][r];
        }
        __syncthreads();
        for (int e = tid; e < 1024; e += 512) { float a = 0.f;
#pragma unroll
            for (int w = 0; w < 8; ++w) a += part[w * 1024 + e];
            hbuf[e] = gelu_tanh(a); }
        __syncthreads();
        for (int e = tid; e < 1024; e += 512) { const int r = e >> 6, j = e & 63; float o = 0.f;
#pragma unroll 8
            for (int m = 0; m < 64; ++m) o += hbuf[r * 64 + m] * w2l[m * 64 + j];
            obuf[e] = o; }
        __syncthreads();
        for (int r = wid; r < 16; r += 8) {
            const int R = tile * 16 + r, g = R & 1, bn = R >> 1, n = bn % NCMP, b = bn / NCMP;
            const float o = obuf[r * 64 + lane];
            if (kv == 0) {
                const float y = o * rsqrtf(wave_sum(o * o) * (1.f / 64.f) + EPS) * A->in[I_KNORM][(i * 3 + 0) * 64 + lane];
                const int tp = b * S + 16 * n + 31;
                const float c = cosT[tp * 32 + (lane & 31)], sn = sinT[tp * 32 + (lane & 31)];
                const float pr = __shfl_xor(y, 32);
                const float oo = lane < 32 ? y * c - pr * sn : y * c + pr * sn;
                ((bf16*)(ws + WS_KC))[((size_t)(b * 128 + n) * 2 + g) * 64 + lane] = (bf16)f2bf(oo);
            } else {
                bf16* vct = (bf16*)(ws + WS_VC) + ((size_t)(b * 2 + g) * 64 + lane) * 128;
                vct[(n & 64) + kpos64(n & 63)] = (bf16)f2bf(o);
                if (n == 126) vct[127] = 0;
            }
        }
    }
    __syncthreads();
}

__device__ __forceinline__ void nsa_softmax(f32x4 (&sc)[4], bf16x8 (&pf)[2], float& mrun, float& lrun, f32x4 (&o)[4], const bool rowok, const bool edge, const int kphi, const int kplo, const bool allrows, const int fq) {
    float bm = -INFINITY;
    if (edge) {
#pragma unroll
        for (int t = 0; t < 4; ++t)
#pragma unroll
            for (int r = 0; r < 4; ++r) { const int kp = 16 * t + 4 * fq + r; const bool v = rowok && kp <= kphi && kp >= kplo; sc[t][r] = v ? sc[t][r] : -INFINITY; bm = fmaxf(bm, sc[t][r]); }
    } else {
#pragma unroll
        for (int t = 0; t < 4; ++t) bm = fmaxf(bm, fmaxf(fmaxf(sc[t].x, sc[t].y), fmaxf(sc[t].z, sc[t].w)));
        if (!allrows) bm = rowok ? bm : -INFINITY;
    }
    bm = xmax32(xmax16(bm));
    const float mn = fmaxf(mrun, bm); const float mns = mn == -INFINITY ? 0.f : mn;
    float rs = 0.f;
#pragma unroll
    for (int t = 0; t < 4; ++t)
#pragma unroll
        for (int r = 0; r < 4; ++r) { sc[t][r] = __builtin_amdgcn_exp2f(sc[t][r] - mns); rs += sc[t][r]; }
    if (!edge && !allrows) {
#pragma unroll
        for (int t = 0; t < 4; ++t) sc[t] = rowok ? sc[t] : (f32x4){0.f, 0.f, 0.f, 0.f};
        rs = rowok ? rs : 0.f;
    }
    rs = xadd32(xadd16(rs));
    if (__all(mn == mrun)) { lrun += rs; }
    else {
        const float alpha = __builtin_amdgcn_exp2f(mrun - mns);
        lrun = lrun * alpha + rs; mrun = mn;
#pragma unroll
        for (int n = 0; n < 4; ++n) o[n] = o[n] * alpha;
    }
#pragma unroll
    for (int s = 0; s < 2; ++s) { u32x4 w; w.x = pk2(sc[2 * s].x, sc[2 * s].y); w.y = pk2(sc[2 * s].z, sc[2 * s].w); w.z = pk2(sc[2 * s + 1].x, sc[2 * s + 1].y); w.w = pk2(sc[2 * s + 1].z, sc[2 * s + 1].w);
        pf[s] = __builtin_bit_cast(bf16x8, w); }
}

__device__ __forceinline__ void phase_nsa_attn_mfma(KArgs A, int wv_, int i, LAS unsigned char* lds) {
    const int wid = wv_;
    unsigned char* ws = opq(A->ws);
    const bf16* HY = (const bf16*)(ws + WS_BIG); const bf16* QA = (const bf16*)(ws + WS_QA); const bf16* KS = (const bf16*)(ws + WS_KS); const bf16* KW = (const bf16*)(ws + WS_KW);
    const bf16* KC = (const bf16*)(ws + WS_KC); const bf16* VCT = (const bf16*)(ws + WS_VC); const bf16* VTA = (const bf16*)(ws + WS_VTA); bf16* CAT = (bf16*)(ws + WS_CAT);
    constexpr int RS = 72;
    LAS bf16* ktl = (LAS bf16*)lds;
    LAS bf16* vtl = ktl + 4 * 64 * RS;
    LAS float* scl = (LAS float*)(lds + 73728) + wid * 256;
    LAS unsigned* msk = (LAS unsigned*)(lds + 73728 + 8192);
    LAS unsigned* umask = msk + 64;
    const float* gb = A->in[I_GATEB] + i * 24;
    unsigned long long tsub = 0, tt0 = 0;
    for (int pit = blockIdx.x; pit < 256; pit += gridDim.x) {
#pragma unroll 1
        for (int hf = 0; hf < 2; ++hf) {
            const int tid = opaque_tid(wv_), lane = tid & 63, fr = lane & 15, fq = lane >> 4;
            const int bg = pit >> 4, xx = pit & 15, x = hf ? 31 - xx : xx, b = bg >> 1, g = bg & 1;
            const size_t tokbase = (size_t)b * S + 64 * x;
            const int tl0 = 8 * wid + (fr >> 2);
            if (tid == 0) *umask = 0u;
            if (PROBE_NSA == 1) tt0 = __builtin_amdgcn_s_memrealtime();
            bf16x8 qf[2][2];
#pragma unroll
            for (int mt = 0; mt < 2; ++mt)
#pragma unroll
                for (int s = 0; s < 2; ++s) qf[mt][s] = *(const bf16x8*)(QA + (tokbase + tl0 + 4 * mt) * 512 + (g * 4 + (fr & 3)) * 64 + 32 * s + 8 * fq);
            f32x4 outacc[2][4];
            {
                const int tmaxc = (4 * x + 3 + 15) >> 4;
                const bf16* kcb = KC + ((size_t)(b * 128 + fr) * 2 + g) * 64 + 8 * fq;
                bf16x8 pcf[2][4];
#pragma unroll
                for (int mt = 0; mt < 2; ++mt) {
                    f32x4 sc[8];
                    const bf16* kp = kcb;
#pragma unroll
                    for (int t = 0; t < 8; ++t) { sc[t] = (f32x4){0.f, 0.f, 0.f, 0.f};
                        asm volatile("" : "+v"(kp));
                        if (t < tmaxc) {
                            const bf16x8 k0 = *(const bf16x8*)(kp), k1 = *(const bf16x8*)(kp + 32);
                            sc[t] = __builtin_amdgcn_mfma_f32_16x16x32_bf16(k0, qf[mt][0], sc[t], 0, 0, 0);
                            sc[t] = __builtin_amdgcn_mfma_f32_16x16x32_bf16(k1, qf[mt][1], sc[t], 0, 0, 0); }
                        kp += 16 * 128; }
                    const int tg = 64 * x + tl0 + 4 * mt; const int ncv = tg >= 31 ? ((tg - 31) >> 4) + 1 : 0;
                    float mx = -INFINITY;
#pragma unroll
                    for (int t = 0; t < 8; ++t)
#pragma unroll
                        for (int r = 0; r < 4; ++r) { const bool v = 16 * t + 4 * fq + r < ncv; sc[t][r] = v ? sc[t][r] : -INFINITY; mx = fmaxf(mx, sc[t][r]); }
                    mx = xmax32(xmax16(mx));
                    const float mxs = mx == -INFINITY ? 0.f : mx;
                    float sum = 0.f;
#pragma unroll
                    for (int t = 0; t < 8; ++t)
#pragma unroll
                        for (int r = 0; r < 4; ++r) { sc[t][r] = __builtin_amdgcn_exp2f(sc[t][r] - mxs); sum += sc[t][r]; }
                    sum = xadd32(xadd16(sum));
                    const float inv = sum > 0.f ? 1.f / sum : 0.f;
#pragma unroll
                    for (int t = 0; t < 8; ++t) sc[t] = sc[t] * inv;
#pragma unroll
                    for (int s = 0; s < 4; ++s) { u32x4 w; w.x = pk2(sc[2 * s].x, sc[2 * s].y); w.y = pk2(sc[2 * s].z, sc[2 * s].w); w.z = pk2(sc[2 * s + 1].x, sc[2 * s + 1].y); w.w = pk2(sc[2 * s + 1].z, sc[2 * s + 1].w);
                        pcf[mt][s] = __builtin_bit_cast(bf16x8, w); }
                    float w3[8];
#pragma unroll
                    for (int t = 0; t < 8; ++t) {
#pragma unroll
                        for (int r = 0; r < 4; ++r) { float v = sc[t][r]; v += __shfl_xor(v, 1); v += __shfl_xor(v, 2); sc[t][r] = v; }
                        w3[t] = __shfl(sc[t].w, (lane + 48) & 63);
                    }
#pragma unroll
                    for (int t = 0; t < 8; ++t) {
                        const float prev = fq > 0 ? w3[t] : (t > 0 ? w3[t > 0 ? t - 1 : 0] : 0.f);
                        const float imp = sc[t].x + sc[t].y + sc[t].z + 0.5f * sc[t].w + 0.5f * prev;
                        if ((fr & 3) == 0) scl[(4 * mt + (fr >> 2)) * 32 + 4 * t + fq] = imp;
                    }
                    asm volatile("" ::: "memory");
                }
                const bf16* vcb = VCT + ((size_t)(b * 2 + g) * 64 + fr) * 128 + 8 * fq;
#pragma unroll
                for (int n = 0; n < 4; ++n) {
                    outacc[0][n] = (f32x4){0.f, 0.f, 0.f, 0.f}; outacc[1][n] = (f32x4){0.f, 0.f, 0.f, 0.f};
                    asm volatile("" : "+v"(vcb));
#pragma unroll
                    for (int s = 0; s < 4; ++s) if (2 * s < tmaxc) {
                        const bf16x8 vf = *(const bf16x8*)(vcb + 32 * s);
                        outacc[0][n] = __builtin_amdgcn_mfma_f32_16x16x32_bf16(vf, pcf[0][s], outacc[0][n], 0, 0, 0);
                        outacc[1][n] = __builtin_amdgcn_mfma_f32_16x16x32_bf16(vf, pcf[1][s], outacc[1][n], 0, 0, 0); }
                    vcb += 16 * 128;
                    asm volatile("" ::: "memory");
                }
            }
            float g1v[2], g2v[2];
#pragma unroll
            for (int mt = 0; mt < 2; ++mt) {
                const int head = g * 4 + (fr & 3);
                const bf16* gl = HY + (tokbase + tl0 + 4 * mt) * HYN + C_GA + head * 3;
                const float g0 = sigmoidf_(bf2f(gl[0]) + gb[head * 3 + 0]);
                g1v[mt] = sigmoidf_(bf2f(gl[1]) + gb[head * 3 + 1]); g2v[mt] = sigmoidf_(bf2f(gl[2]) + gb[head * 3 + 2]);
#pragma unroll
                for (int n = 0; n < 4; ++n) outacc[mt][n] = outacc[mt][n] * g0;
            }
            LDS_WAIT();
            asm volatile("" ::: "memory");
            {
                const int tok8 = lane >> 3, jg = lane & 7;
                float sj[32];
#pragma unroll
                for (int q = 0; q < 8; ++q) { const f32x4 v = *(const LAS f32x4*)(scl + tok8 * 32 + 4 * q); sj[4 * q] = v.x; sj[4 * q + 1] = v.y; sj[4 * q + 2] = v.z; sj[4 * q + 3] = v.w; }
#pragma unroll
                for (int j = 0; j < 32; ++j) sj[j] = j <= x ? sj[j] + ((j == 0 || j == x || j == x - 1) ? 1000.0f : 0.f) : -INFINITY;
                unsigned bits = 0u;
                const f32x4 mv = *(const LAS f32x4*)(scl + tok8 * 32 + 4 * jg);
#pragma unroll
                for (int q = 0; q < 4; ++q) {
                    const int j = 4 * jg + q;
                    const float mine = j <= x ? mv[q] + ((j == 0 || j == x || j == x - 1) ? 1000.0f : 0.f) : -INFINITY;
                    int rank = 0;
#pragma unroll
                    for (int jj = 0; jj < 32; ++jj) rank += (sj[jj] > mine || (sj[jj] == mine && jj < j)) ? 1 : 0;
                    bits |= (j <= x && rank < 8) ? (1u << j) : 0u;
                }
                bits |= __shfl_xor(bits, 1); bits |= __shfl_xor(bits, 2); bits |= __shfl_xor(bits, 4);
                if (jg == 0) { msk[wid * 8 + tok8] = bits; atomicOr((unsigned*)umask, bits); }
            }
            __syncthreads();
            if (PROBE_NSA == 1) tsub += __builtin_amdgcn_s_memrealtime() - tt0;
#pragma unroll 1
            for (int pp = 0; pp < 2 + (PROBE_NSAX ? 1 : 0); ++pp) {
                const int pass = pp == 2 ? 0 : pp; const bool dummy = pp == 2;
                if (PROBE_NSA == 2 + pass) tt0 = __builtin_amdgcn_s_memrealtime();
                const int jlo = pass ? (x >= 4 ? x - 4 : 0) : 0;
                const unsigned inrange = (x >= 31 ? 0xffffffffu : ((2u << x) - 1u)) & ~((1u << jlo) - 1u);
                unsigned bmask = pass ? inrange : (*umask & inrange);
                const bf16* Kb = pass ? KW : KS; const int cg = (pass ? 10 : 8) + g;
                unsigned tm[2], wm[2], am[2];
#pragma unroll
                for (int mt = 0; mt < 2; ++mt) {
                    tm[mt] = pass ? 0xffffffffu : msk[wid * 8 + 4 * mt + (fr >> 2)];
                    wm[mt] = pass ? 0xffffffffu : (msk[wid * 8 + 4 * mt] | msk[wid * 8 + 4 * mt + 1] | msk[wid * 8 + 4 * mt + 2] | msk[wid * 8 + 4 * mt + 3]);
                    am[mt] = pass ? 0xffffffffu : (msk[wid * 8 + 4 * mt] & msk[wid * 8 + 4 * mt + 1] & msk[wid * 8 + 4 * mt + 2] & msk[wid * 8 + 4 * mt + 3]);
                    wm[mt] = __builtin_amdgcn_readfirstlane(wm[mt]); am[mt] = __builtin_amdgcn_readfirstlane(am[mt]);
                    if (PROBE_NSAX == 2 && dummy) wm[mt] = 0u;
                }
                f32x4 o[2][4]; float mrun[2], lrun[2];
#pragma unroll
                for (int mt = 0; mt < 2; ++mt) { mrun[mt] = -INFINITY; lrun[mt] = 0.f;
#pragma unroll
                    for (int n = 0; n < 4; ++n) o[mt][n] = (f32x4){0.f, 0.f, 0.f, 0.f}; }
                const int srow = tid >> 3, sc16 = tid & 7;
                u32x4 pk0 = (u32x4){0u, 0u, 0u, 0u}, pv0 = pk0, pk1 = pk0, pv1 = pk0;
#define NSA_LD(jx, pk, pv) do { const bf16* ksrc = Kb + ((size_t)b * S + 64 * (jx) + srow) * 128 + g * 64 + sc16 * 8; const bf16* vsrc = VTA + ((size_t)((b * 32 + (jx)) * 12 + cg)) * 4096 + srow * 64 + sc16 * 8; \
                    pk = *(const u32x4*)ksrc; pv = *(const u32x4*)vsrc; } while (0)
                int j0 = __ffs(bmask) - 1; bmask &= bmask - 1u;
                int j1 = bmask ? __ffs(bmask) - 1 : -1; bmask &= bmask - 1u;
                NSA_LD(j0, pk0, pv0); if (j1 >= 0) NSA_LD(j1, pk1, pv1);
                int buf = 0;
                while (j0 >= 0) {
                    *(LAS u32x4*)(ktl + (buf * 2 + 0) * 64 * RS + srow * RS + sc16 * 8) = pk0; *(LAS u32x4*)(vtl + (buf * 2 + 0) * 64 * RS + srow * RS + sc16 * 8) = pv0;
                    if (j1 >= 0) { *(LAS u32x4*)(ktl + (buf * 2 + 1) * 64 * RS + srow * RS + sc16 * 8) = pk1; *(LAS u32x4*)(vtl + (buf * 2 + 1) * 64 * RS + srow * RS + sc16 * 8) = pv1; }
                    const int jn0 = bmask ? __ffs(bmask) - 1 : -1; bmask &= bmask - 1u;
                    const int jn1 = bmask ? __ffs(bmask) - 1 : -1; bmask &= bmask - 1u;
                    if (jn0 >= 0) NSA_LD(jn0, pk0, pv0);
                    if (jn1 >= 0) NSA_LD(jn1, pk1, pv1);
                    __syncthreads();
#pragma unroll 1
                    for (int sub = 0; sub < 2; ++sub) {
                        const int j = sub ? j1 : j0;
                        if (j < 0) break;
                        const LAS bf16* kt = ktl + (buf * 2 + sub) * 64 * RS + fr * RS + 8 * fq; const LAS bf16* vt = vtl + (buf * 2 + sub) * 64 * RS + fr * RS + 8 * fq;
                        const bool nd0 = (wm[0] >> j) & 1u, nd1 = (wm[1] >> j) & 1u;
                        if (!(nd0 || nd1)) continue;
                        const bool edge = (j == x) || (pass && j == x - 4);
                        f32x4 sc0[4], sc1[4];
#pragma unroll
                        for (int t = 0; t < 4; ++t) { sc0[t] = (f32x4){0.f, 0.f, 0.f, 0.f}; sc1[t] = (f32x4){0.f, 0.f, 0.f, 0.f};
                            const bf16x8 k0_ = *(const LAS bf16x8*)(kt + t * 16 * RS), k1_ = *(const LAS bf16x8*)(kt + t * 16 * RS + 32);
                            if (nd0) { sc0[t] = __builtin_amdgcn_mfma_f32_16x16x32_bf16(k0_, qf[0][0], sc0[t], 0, 0, 0); sc0[t] = __builtin_amdgcn_mfma_f32_16x16x32_bf16(k1_, qf[0][1], sc0[t], 0, 0, 0); }
                            if (nd1) { sc1[t] = __builtin_amdgcn_mfma_f32_16x16x32_bf16(k0_, qf[1][0], sc1[t], 0, 0, 0); sc1[t] = __builtin_amdgcn_mfma_f32_16x16x32_bf16(k1_, qf[1][1], sc1[t], 0, 0, 0); } }
                        bf16x8 pf0[2], pf1[2];
                        if (nd0) nsa_softmax(sc0, pf0, mrun[0], lrun[0], o[0], (tm[0] >> j) & 1u, edge, j == x ? tl0 : 63, (pass && j == x - 4) ? tl0 + 1 : 0, (am[0] >> j) & 1u, fq);
                        if (nd1) nsa_softmax(sc1, pf1, mrun[1], lrun[1], o[1], (tm[1] >> j) & 1u, edge, j == x ? tl0 + 4 : 63, (pass && j == x - 4) ? tl0 + 5 : 0, (am[1] >> j) & 1u, fq);
#pragma unroll
                        for (int n = 0; n < 4; ++n) {
                            const bf16x8 v0_ = *(const LAS bf16x8*)(vt + n * 16 * RS), v1_ = *(const LAS bf16x8*)(vt + n * 16 * RS + 32);
                            if (nd0) { o[0][n] = __builtin_amdgcn_mfma_f32_16x16x32_bf16(v0_, pf0[0], o[0][n], 0, 0, 0); o[0][n] = __builtin_amdgcn_mfma_f32_16x16x32_bf16(v1_, pf0[1], o[0][n], 0, 0, 0); }
                            if (nd1) { o[1][n] = __builtin_amdgcn_mfma_f32_16x16x32_bf16(v0_, pf1[0], o[1][n], 0, 0, 0); o[1][n] = __builtin_amdgcn_mfma_f32_16x16x32_bf16(v1_, pf1[1], o[1][n], 0, 0, 0); } }
                    }
                    j0 = jn0; j1 = jn1; buf ^= 1;
                }
#undef NSA_LD
#pragma unroll
                for (int mt = 0; mt < 2; ++mt) { const float sc_ = (pass ? g2v[mt] : g1v[mt]) / lrun[mt];
                    if (!dummy) {
#pragma unroll
                    for (int n = 0; n < 4; ++n) outacc[mt][n] = outacc[mt][n] + o[mt][n] * sc_; } }
                __syncthreads();
                if (PROBE_NSA == 2 + pass) tsub += __builtin_amdgcn_s_memrealtime() - tt0;
            }
#pragma unroll
            for (int mt = 0; mt < 2; ++mt) {
                bf16* dst = CAT + (tokbase + tl0 + 4 * mt) * 1024 + (g * 4 + (fr & 3)) * 64 + 4 * fq;
#pragma unroll
                for (int n = 0; n < 4; ++n) { u32x2 w; w.x = pk2(outacc[mt][n].x, outacc[mt][n].y); w.y = pk2(outacc[mt][n].z, outacc[mt][n].w); *(u32x2*)(dst + 16 * n) = w; }
            }
        }
    }
    __syncthreads();
    if (PROBE_NSA && blockIdx.x == 0 && opaque_tid(wv_) == 0) atomicAdd((unsigned long long*)(ws + WS_CTL + 48000), tsub);
}

__device__ __forceinline__ void phase_vtiles(KArgs A, int wv_, LAS unsigned char* lds) {
    const int tid_ = opaque_tid(wv_); const int wid = __builtin_amdgcn_readfirstlane(tid_ >> 6), lane = tid_ & 63; const int gw = blockIdx.x * 8 + wid, NGW = gridDim.x * 8;
    unsigned char* ws = opq(A->ws);
    const bf16* HY = (const bf16*)(ws + WS_BIG); bf16* VTA = (bf16*)(ws + WS_VTA);
    constexpr int TS = 66;
    LAS bf16* tl = (LAS bf16*)(lds + 65536) + wid * (64 * TS);
    for (int it = gw; it < NBATCH * 32 * 12; it += NGW) {
        const int cg = it % 12, bc = it / 12;
        const int colbase = cg < 8 ? C_VB + cg * 64 : (cg < 10 ? C_VS + (cg - 8) * 64 : C_VW + (cg - 10) * 64);
        const u32x4* src = (const u32x4*)(HY + (size_t)(bc * 64 + lane) * HYN + colbase);
        u32x4 w[8];
#pragma unroll
        for (int i = 0; i < 8; ++i) w[i] = src[i];
#pragma unroll
        for (int i = 0; i < 8; ++i) { LAS unsigned* d = (LAS unsigned*)(tl + lane * TS + 8 * i); d[0] = w[i].x; d[1] = w[i].y; d[2] = w[i].z; d[3] = w[i].w; }
        LDS_WAIT();
        bf16* dst = VTA + (size_t)it * 4096 + lane * 64;
#pragma unroll
        for (int p8 = 0; p8 < 8; ++p8) {
            unsigned short x[8];
#pragma unroll
            for (int j = 0; j < 8; ++j) x[j] = tl[kperm64(p8 * 8 + j) * TS + lane];
            u32x4 o; o.x = x[0] | ((unsigned)x[1] << 16); o.y = x[2] | ((unsigned)x[3] << 16); o.z = x[4] | ((unsigned)x[5] << 16); o.w = x[6] | ((unsigned)x[7] << 16);
            *(u32x4*)(dst + p8 * 8) = o;
        }
        LDS_WAIT();
    }
}

__device__ __forceinline__ void vtrans_wave(KArgs A, int wv_, LAS bf16* tl, const int gw, const int NGW) {
    const int tid_ = opaque_tid(wv_); const int lane = tid_ & 63;
    unsigned char* ws = opq(A->ws);
    const bf16* KV = (const bf16*)(ws + WS_KV); bf16* VT = (bf16*)(ws + WS_VT);
    constexpr int TS = 66;
    for (int it = gw; it < DEPTH * NBATCH * 4 * 16; it += NGW) {
        const int db = it & 3, kb = (it >> 2) & 3, h = (it >> 4) & 3, b = (it >> 6) & 7, l = it >> 9;
        const u32x4* src = (const u32x4*)(KV + (size_t)(b * 256 + 64 * kb + lane) * 8192 + l * 2048 + 1024 + h * 256 + 64 * db);
        u32x4 w[8];
#pragma unroll
        for (int i = 0; i < 8; ++i) w[i] = src[i];
#pragma unroll
        for (int i = 0; i < 8; ++i) { LAS unsigned* d = (LAS unsigned*)(tl + lane * TS + 8 * i); d[0] = w[i].x; d[1] = w[i].y; d[2] = w[i].z; d[3] = w[i].w; }
        LDS_WAIT();
        bf16* dst = VT + ((size_t)((l * 8 + b) * 4 + h) * 256 + 64 * db + lane) * 256 + 64 * kb;
#pragma unroll
        for (int p8 = 0; p8 < 8; ++p8) {
            unsigned short x[8];
#pragma unroll
            for (int j = 0; j < 8; ++j) x[j] = tl[kperm64(p8 * 8 + j) * TS + lane];
            u32x4 o; o.x = x[0] | ((unsigned)x[1] << 16); o.y = x[2] | ((unsigned)x[3] << 16); o.z = x[4] | ((unsigned)x[5] << 16); o.w = x[6] | ((unsigned)x[7] << 16);
            *(u32x4*)(dst + p8 * 8) = o;
        }
        LDS_WAIT();
    }
}

__device__ __forceinline__ float log_sigmoid16(float z) { return (fminf(z, 0.f) - __logf(1.0f + __expf(-fabsf(z)))) * (1.f / 16.f); }
#define GLA_Z(tokv) ({ float z_ = bias; _Pragma("unroll") for (int r_ = 0; r_ < 16; ++r_) z_ += __builtin_bit_cast(float, __builtin_amdgcn_readlane(__builtin_bit_cast(int, al[r_]), (tokv))) * wc[r_]; z_; })
#define GLA_LOAD_GATE() \
    float al[16], wc[16]; \
    { const u32x4* ap_ = (const u32x4*)(HY + (size_t)(tok0 + lane) * HYN + C_AL); const u32x4 a0_ = ap_[0], a1_ = ap_[1]; \
      al[0] = bflo(a0_.x); al[1] = bfhi(a0_.x); al[2] = bflo(a0_.y); al[3] = bfhi(a0_.y); al[4] = bflo(a0_.z); al[5] = bfhi(a0_.z); al[6] = bflo(a0_.w); al[7] = bfhi(a0_.w); \
      al[8] = bflo(a1_.x); al[9] = bfhi(a1_.x); al[10] = bflo(a1_.y); al[11] = bfhi(a1_.y); al[12] = bflo(a1_.z); al[13] = bfhi(a1_.z); al[14] = bflo(a1_.w); al[15] = bfhi(a1_.w); } \
    _Pragma("unroll") for (int r_ = 0; r_ < 16; ++r_) wc[r_] = A->in[I_WA2][(i * 16 + r_) * 256 + h * 64 + lane]; \
    const float bias = A->in[I_BA][i * 256 + h * 64 + lane];

__device__ __forceinline__ void phase_gla_a(KArgs A, int wv_, int i, LAS unsigned char* lds) {
    const int tid_ = opaque_tid(wv_); const int wid = __builtin_amdgcn_readfirstlane(tid_ >> 6), lane = tid_ & 63, fr = lane & 15, fq = lane >> 4; const int gw = blockIdx.x * 8 + wid, NGW = gridDim.x * 8;
    unsigned char* ws = opq(A->ws);
    const bf16* HY = (const bf16*)(ws + WS_BIG); const bf16* VTA = (const bf16*)(ws + WS_VTA); float* SLOC = (float*)(ws + WS_SLOC); float* DEC = (float*)(ws + WS_DEC);
    constexpr int RS = 72;
    LAS bf16* kh = (LAS bf16*)lds + wid * (64 * RS);
    (void)gw;
    for (int it = wid * (int)gridDim.x + (int)blockIdx.x; it < 1024; it += NGW) {
        const int c = it & 31, bh = it >> 5, b = bh >> 2, h = bh & 3; const size_t tok0 = (size_t)b * S + c * 64;
        GLA_LOAD_GATE();
        float bl = 0.f; float la[64];
#pragma unroll
        for (int tk = 0; tk < 64; ++tk) { la[tk] = log_sigmoid16(GLA_Z(tk)); bl += la[tk]; }
        float bc = 0.f;
        unsigned short kcol[64];
#pragma unroll
        for (int tk = 0; tk < 64; ++tk) kcol[tk] = HY[(tok0 + tk) * HYN + C_KB + h * 64 + lane];
#pragma unroll
        for (int tk = 0; tk < 64; ++tk) {
            bc += la[tk];
            kh[lane * RS + kpos64(tk)] = (bf16)f2bf(bf2f(kcol[tk]) * __expf(bl - bc));
        }
        DEC[it * 64 + lane] = __expf(bl);
        LDS_WAIT();
#pragma unroll
        for (int dvh = 0; dvh < 2; ++dvh) {
            const bf16* vt = VTA + ((size_t)((b * 32 + c) * 12 + h * 2 + dvh)) * 4096;
            bf16x8 vf[4][2];
#pragma unroll
            for (int n = 0; n < 4; ++n)
#pragma unroll
                for (int s = 0; s < 2; ++s) vf[n][s] = *(const bf16x8*)(vt + (16 * n + fr) * 64 + 32 * s + 8 * fq);
#pragma unroll
            for (int m = 0; m < 4; ++m) {
                const bf16x8 a0 = *(const LAS bf16x8*)(kh + (16 * m + fr) * RS + 8 * fq), a1 = *(const LAS bf16x8*)(kh + (16 * m + fr) * RS + 32 + 8 * fq);
#pragma unroll
                for (int n = 0; n < 4; ++n) {
                    f32x4 acc = (f32x4){0.f, 0.f, 0.f, 0.f};
                    acc = __builtin_amdgcn_mfma_f32_16x16x32_bf16(a0, vf[n][0], acc, 0, 0, 0);
                    acc = __builtin_amdgcn_mfma_f32_16x16x32_bf16(a1, vf[n][1], acc, 0, 0, 0);
                    float* dst = SLOC + ((size_t)it * 64 + 16 * m + 4 * fq) * 128 + dvh * 64 + 16 * n + fr;
                    dst[0] = acc.x; dst[128] = acc.y; dst[256] = acc.z; dst[384] = acc.w;
                }
            }
        }
        LDS_WAIT();
    }
}
__device__ __forceinline__ void phase_gla_c(KArgs A, int wv_, int i, LAS unsigned char* lds, const bool kv_post, const int Lcur) {
    const int tid_ = opaque_tid(wv_); const int wid = __builtin_amdgcn_readfirstlane(tid_ >> 6), lane = tid_ & 63, fr = lane & 15, fq = lane >> 4; const int gw = blockIdx.x * 8 + wid, NGW = gridDim.x * 8;
    unsigned char* ws = opq(A->ws);
    const bf16* HY = (const bf16*)(ws + WS_BIG); const bf16* VTA = (const bf16*)(ws + WS_VTA); const bf16* STT = (const bf16*)(ws + WS_STT); bf16* CAT = (bf16*)(ws + WS_CAT);
    constexpr int RS = 72;
    LAS bf16* qs = (LAS bf16*)lds + wid * (128 * RS);
    LAS bf16* ks = qs + 64 * RS;
    const float* og = A->in[I_ONORM] + i * 128;
    LAS unsigned* wq = (LAS unsigned*)(lds + 152064 + 1024);
    LAS float* ogl = (LAS float*)(lds + 152064);
    if (tid_ < 128) ogl[tid_] = og[tid_];
    (void)gw; (void)NGW;
    for (int blk = blockIdx.x; blk < 256; blk += gridDim.x) {
        if (tid_ == 0) *wq = 0u;
        SUBT_BEGIN(1);
        {
            const float* SLOC = (const float*)(ws + WS_SLOC); const float* DEC = (const float*)(ws + WS_DEC); bf16* STw = (bf16*)(ws + WS_STT);
            const int tid = tid_, dv = tid & 127, ko = tid >> 7, bh = blk >> 3, c0 = (blk & 7) * 4;
            float sv[16];
#pragma unroll
            for (int j = 0; j < 16; ++j) sv[j] = 0.f;
#pragma unroll 1
            for (int cb = 0; cb < c0 + 4; cb += 4) {
                float dc4[4][16], sl4[4][16];
#pragma unroll
                for (int q = 0; q < 4; ++q) {
                    const size_t item = (size_t)bh * 32 + cb + q; const float* sl = SLOC + (item * 64 + ko * 16) * 128 + dv; const float* dc = DEC + item * 64 + ko * 16;
#pragma unroll
                    for (int j = 0; j < 16; ++j) { dc4[q][j] = dc[j]; sl4[q][j] = sl[j * 128]; }
                }
#pragma unroll
                for (int q = 0; q < 4; ++q) {
                    const int c = cb + q; const size_t item = (size_t)bh * 32 + c;
                    if (c >= c0) {
                        u32x4 o0, o1; o0.x = pk2(sv[0], sv[1]); o0.y = pk2(sv[2], sv[3]); o0.z = pk2(sv[4], sv[5]); o0.w = pk2(sv[6], sv[7]);
                        o1.x = pk2(sv[8], sv[9]); o1.y = pk2(sv[10], sv[11]); o1.z = pk2(sv[12], sv[13]); o1.w = pk2(sv[14], sv[15]);
                        u32x4* d = (u32x4*)(STw + (item * 128 + dv) * 64 + ko * 16); d[0] = o0; d[1] = o1;
                    }
#pragma unroll
                    for (int j = 0; j < 16; ++j) sv[j] = dc4[q][j] * sv[j] + sl4[q][j];
                }
            }
            asm volatile("s_waitcnt vmcnt(0)" ::: "memory");
            __syncthreads();
        }
        SUBT_END(1, ws, tid_);
        SUBT_BEGIN(2);
        SUBT_BEGIN(3);
        if (wid < 4) {
        const int it = blk * 4 + wid;
        const int c = it & 31, bh = it >> 5, b = bh >> 2, h = bh & 3; const size_t tok0 = (size_t)b * S + c * 64;
        GLA_LOAD_GATE();
        float bc = 0.f;
        unsigned short qcol[64], kcol[64];
#pragma unroll
        for (int tk = 0; tk < 64; ++tk) { const bf16* row = HY + (tok0 + tk) * HYN; qcol[tk] = row[C_QB + h * 64 + lane]; kcol[tk] = row[C_KB + h * 64 + lane]; }
#pragma unroll
        for (int tk = 0; tk < 64; ++tk) {
            bc += log_sigmoid16(GLA_Z(tk));
            const float eb = __expf(bc);
            qs[tk * RS + lane] = (bf16)f2bf(bf2f(qcol[tk]) * 0.125f * eb); ks[tk * RS + lane] = (bf16)f2bf(bf2f(kcol[tk]) / eb);
        }
        LDS_WAIT();
        SUBT_END(2, ws, tid_);
        bf16x8 st[8][2];
#pragma unroll
        for (int n = 0; n < 8; ++n)
#pragma unroll
            for (int s = 0; s < 2; ++s) st[n][s] = *(const bf16x8*)(STT + ((size_t)it * 128 + 16 * n + fr) * 64 + 32 * s + 8 * fq);
        const bf16* vt = VTA + ((size_t)((b * 32 + c) * 12 + h * 2)) * 4096;
        bf16x8 vfr[8];
#pragma unroll
        for (int n = 0; n < 8; ++n) { const bf16* vrow = vt + (size_t)(n >> 2) * 4096 + (16 * (n & 3) + fr) * 64 + 8 * fq; vfr[n] = *(const bf16x8*)vrow; }
#pragma unroll
        for (int mi = 0; mi < 4; ++mi) {
            const bf16x8 q0 = *(const LAS bf16x8*)(qs + (16 * mi + fr) * RS + 8 * fq), q1 = *(const LAS bf16x8*)(qs + (16 * mi + fr) * RS + 32 + 8 * fq);
            u32x2 rwv[8];
#pragma unroll
            for (int n = 0; n < 8; ++n) rwv[n] = *(const u32x2*)(HY + (tok0 + 16 * mi + fr) * HYN + C_RB + h * 128 + 16 * n + 4 * fq);
            f32x4 sc[4];
#pragma unroll
            for (int t = 0; t < 4; ++t) {
                sc[t] = (f32x4){0.f, 0.f, 0.f, 0.f};
                if (t <= mi) {
                    const bf16x8 k0 = *(const LAS bf16x8*)(ks + (16 * t + fr) * RS + 8 * fq), k1 = *(const LAS bf16x8*)(ks + (16 * t + fr) * RS + 32 + 8 * fq);
                    sc[t] = __builtin_amdgcn_mfma_f32_16x16x32_bf16(k0, q0, sc[t], 0, 0, 0);
                    sc[t] = __builtin_amdgcn_mfma_f32_16x16x32_bf16(k1, q1, sc[t], 0, 0, 0);
                    if (t == mi) {
                        sc[t].x = (4 * fq + 0 <= fr) ? sc[t].x : 0.f; sc[t].y = (4 * fq + 1 <= fr) ? sc[t].y : 0.f; sc[t].z = (4 * fq + 2 <= fr) ? sc[t].z : 0.f; sc[t].w = (4 * fq + 3 <= fr) ? sc[t].w : 0.f; }
                }
            }
            bf16x8 pf[2];
#pragma unroll
            for (int s = 0; s < 2; ++s) { u32x4 w; w.x = pk2(sc[2 * s].x, sc[2 * s].y); w.y = pk2(sc[2 * s].z, sc[2 * s].w); w.z = pk2(sc[2 * s + 1].x, sc[2 * s + 1].y); w.w = pk2(sc[2 * s + 1].z, sc[2 * s + 1].w);
                pf[s] = __builtin_bit_cast(bf16x8, w); }
            f32x4 o[8]; float ssq = 0.f;
#pragma unroll
            for (int n = 0; n < 8; ++n) {
                o[n] = (f32x4){0.f, 0.f, 0.f, 0.f};
                o[n] = __builtin_amdgcn_mfma_f32_16x16x32_bf16(st[n][0], q0, o[n], 0, 0, 0);
                o[n] = __builtin_amdgcn_mfma_f32_16x16x32_bf16(st[n][1], q1, o[n], 0, 0, 0);
                o[n] = __builtin_amdgcn_mfma_f32_16x16x32_bf16(vfr[n], pf[0], o[n], 0, 0, 0);
                if (mi >= 2) o[n] = __builtin_amdgcn_mfma_f32_16x16x32_bf16(*(const bf16x8*)(vt + (size_t)(n >> 2) * 4096 + (16 * (n & 3) + fr) * 64 + 8 * fq + 32), pf[1], o[n], 0, 0, 0);
                ssq += (o[n].x * o[n].x + o[n].y * o[n].y) + (o[n].z * o[n].z + o[n].w * o[n].w);
            }
            ssq = xadd32(xadd16(ssq));
            const float rstd = rsqrtf(ssq * (1.f / 128.f) + EPS);
            const size_t tok = tok0 + 16 * mi + fr;
#pragma unroll
            for (int n = 0; n < 8; ++n) {
                const int dv = 16 * n + 4 * fq;
                const u32x2 rw = rwv[n]; const f32x4 g = *(const LAS f32x4*)(ogl + dv);
                const float r0 = bflo(rw.x), r1 = bfhi(rw.x), r2 = bflo(rw.y), r3 = bfhi(rw.y);
                u32x2 w; w.x = pk2(o[n].x * rstd * g.x * (r0 * sigmoidf_(r0)), o[n].y * rstd * g.y * (r1 * sigmoidf_(r1)));
                w.y = pk2(o[n].z * rstd * g.z * (r2 * sigmoidf_(r2)), o[n].w * rstd * g.w * (r3 * sigmoidf_(r3)));
                *(u32x2*)(CAT + tok * 1024 + 512 + h * 128 + dv) = w;
            }
        }
        } else {
            if (kv_post) {
                phase_knorm(A, wv_, blk * 4 + (wid - 4), 256 * 4);
                vtrans_wave(A, wv_, (LAS bf16*)(lds + 81920 + (wid - 4) * 16640), blk * 4 + (wid - 4), 256 * 4);
            }
            moe_weight_share(A, wv_, (LAS float*)(lds + 81920 + (wid - 4) * 16640), wq, Lcur, blk);
        }
        if (wid < 4) { LDS_WAIT(); moe_weight_share(A, wv_, (LAS float*)(lds + wid * 18432), wq, Lcur, blk); }
        SUBT_END(3, ws, tid_);
        LDS_WAIT();
        __syncthreads();
    }
}

__device__ __forceinline__ void phase_sgu_mix_mfma(KArgs A, int wv_, int i, LAS unsigned char* lds) {
    const int tid = opaque_tid(wv_), wid = __builtin_amdgcn_readfirstlane(tid >> 6), lane = tid & 63, fr = lane & 15, fq = lane >> 4;
    unsigned char* ws = opq(A->ws);
    const bf16* U = (const bf16*)(ws + WS_U); const bf16* V = (const bf16*)(ws + WS_V); bf16* UM = (bf16*)(ws + WS_UM);
    const bf16* WSB = (const bf16*)(ws + WS_WSB) + (size_t)i * 8 * 16384; const float* M0 = (const float*)(ws + WS_M0) + i * 8 * 128;
    constexpr int VS = 136;
    LAS bf16* vT = (LAS bf16*)lds;
    LAS float* st = (LAS float*)(lds + 256 * VS * 2);
    LAS bf16* wl = (LAS bf16*)(lds + 256 * VS * 2 + 1024);
    const float* lng = A->in[I_LNG] + i * 2048; const float* lnb = A->in[I_LNB] + i * 2048; const float* bsg = A->in[I_SGBS] + i * 8 * 128;
    for (int it = blockIdx.x; it < 256; it += gridDim.x) {
        const int gh = it & 1, n_ = (it >> 1) & 15, b = it >> 5; const size_t tok0 = (size_t)b * S + n_ * 128;
        __syncthreads();
        {
            const float* vst = (const float*)(ws + WS_VSTAT);
#pragma unroll
            for (int s4 = 0; s4 < 16; s4 += 4) {
                const int s = wid * 16 + s4 + (lane >> 4);
                const f32x4 p = *(const f32x4*)(vst + (tok0 + s) * 64 + 4 * (lane & 15));
                float sum = p.x + p.z, sq = p.y + p.w;
                sum += __shfl_xor(sum, 1); sq += __shfl_xor(sq, 1); sum += __shfl_xor(sum, 2); sq += __shfl_xor(sq, 2);
                sum += __shfl_xor(sum, 4); sq += __shfl_xor(sq, 4); sum += __shfl_xor(sum, 8); sq += __shfl_xor(sq, 8);
                const float mean = sum * (1.f / 2048.f); const float var = fmaxf(sq * (1.f / 2048.f) - mean * mean, 0.f);
                if ((lane & 15) == 0) { st[2 * s] = mean; st[2 * s + 1] = rsqrtf(var + EPS); }
            }
        }
#pragma unroll 1
        for (int gg = 0; gg < 4; ++gg) {
            const int g = gh * 4 + gg;
            __syncthreads();
            {
                const int s = tid & 127, cq = tid >> 7;
                const float mean = st[2 * s], rstd = st[2 * s + 1];
                const u32x4* src = (const u32x4*)(V + (tok0 + s) * 2048 + g * 256 + cq * 64);
                u32x4 w8[8], ww[4];
#pragma unroll
                for (int i8 = 0; i8 < 8; ++i8) w8[i8] = src[i8];
#pragma unroll
                for (int q = 0; q < 4; ++q) { const int e = tid + 512 * q; ww[q] = *(const u32x4*)(WSB + ((size_t)g * 128 + (e >> 4)) * 128 + (e & 15) * 8); }
#pragma unroll
                for (int i8 = 0; i8 < 8; ++i8) {
                    const u32x4 w = w8[i8];
                    LAS bf16* d = vT + (cq * 64 + i8 * 8) * VS + s;
                    d[0 * VS] = (bf16)f2bf((bflo(w.x) - mean) * rstd); d[1 * VS] = (bf16)f2bf((bfhi(w.x) - mean) * rstd); d[2 * VS] = (bf16)f2bf((bflo(w.y) - mean) * rstd); d[3 * VS] = (bf16)f2bf((bfhi(w.y) - mean) * rstd);
                    d[4 * VS] = (bf16)f2bf((bflo(w.z) - mean) * rstd); d[5 * VS] = (bf16)f2bf((bfhi(w.z) - mean) * rstd); d[6 * VS] = (bf16)f2bf((bflo(w.w) - mean) * rstd); d[7 * VS] = (bf16)f2bf((bfhi(w.w) - mean) * rstd);
                }
#pragma unroll
                for (int q = 0; q < 4; ++q) { const int e = tid + 512 * q; *(LAS u32x4*)(wl + (e >> 4) * VS + (e & 15) * 8) = ww[q]; }
            }
            u32x2 uw[8][2]; float m0v[8], bsv[8];
#pragma unroll
            for (int n = 0; n < 8; ++n) { const int t = 16 * n + fr; m0v[n] = M0[g * 128 + t]; bsv[n] = bsg[g * 128 + t];
                const size_t ro = (tok0 + t) * 2048 + g * 256 + 32 * wid + 4 * fq; uw[n][0] = *(const u32x2*)(U + ro); uw[n][1] = *(const u32x2*)(U + ro + 16); }
            __syncthreads();
            bf16x8 vf[2][4];
#pragma unroll
            for (int m = 0; m < 2; ++m)
#pragma unroll
                for (int k = 0; k < 4; ++k) vf[m][k] = *(const LAS bf16x8*)(vT + (32 * wid + 16 * m + fr) * VS + 32 * k + 8 * fq);
            f32x4 gc[2], bc[2];
#pragma unroll
            for (int m = 0; m < 2; ++m) { gc[m] = *(const f32x4*)(lng + g * 256 + 32 * wid + 16 * m + 4 * fq); bc[m] = *(const f32x4*)(lnb + g * 256 + 32 * wid + 16 * m + 4 * fq); }
#pragma unroll
            for (int n = 0; n < 8; ++n) {
                f32x4 a0 = (f32x4){0.f, 0.f, 0.f, 0.f}, a1 = (f32x4){0.f, 0.f, 0.f, 0.f};
#pragma unroll
                for (int k = 0; k < 4; ++k) if (k <= (n >> 1)) {
                    const bf16x8 wf = *(const LAS bf16x8*)(wl + (16 * n + fr) * VS + 32 * k + 8 * fq);
                    a0 = __builtin_amdgcn_mfma_f32_16x16x32_bf16(vf[0][k], wf, a0, 0, 0, 0);
                    a1 = __builtin_amdgcn_mfma_f32_16x16x32_bf16(vf[1][k], wf, a1, 0, 0, 0); }
                const int t = 16 * n + fr; const float m0 = m0v[n], bsv_ = bsv[n];
                const size_t ro = (tok0 + t) * 2048 + g * 256 + 32 * wid + 4 * fq;
#pragma unroll
                for (int m = 0; m < 2; ++m) {
                    const f32x4 a = m ? a1 : a0;
                    const u32x2 uw_ = uw[n][m];
                    u32x2 w; w.x = pk2((a.x * gc[m].x + bc[m].x * m0 + bsv_) * bflo(uw_.x), (a.y * gc[m].y + bc[m].y * m0 + bsv_) * bfhi(uw_.x));
                    w.y = pk2((a.z * gc[m].z + bc[m].z * m0 + bsv_) * bflo(uw_.y), (a.w * gc[m].w + bc[m].w * m0 + bsv_) * bfhi(uw_.y));
                    *(u32x2*)(UM + ro + 16 * m) = w;
                }
            }
        }
    }
    __syncthreads();
}

__device__ __forceinline__ void xattn_item(KArgs A, int wv_, int L, LAS unsigned char* lds, const int b, const int h, const int qt) {
    const int tid = opaque_tid(wv_), wid = __builtin_amdgcn_readfirstlane(tid >> 6), lane = tid & 63, fr = lane & 15, fq = lane >> 4;
    unsigned char* ws = opq(A->ws);
    const bf16* QX = (const bf16*)(ws + WS_QX); const bf16* KV = (const bf16*)(ws + WS_KV); const bf16* VT = (const bf16*)(ws + WS_VT); bf16* OX = (bf16*)(ws + WS_OX);
    constexpr int RS = 264;
    LAS bf16* kl = (LAS bf16*)lds;
    const float* qg = A->in[I_XQN] + L * 256;
    {
        __syncthreads();
        {
            const int row = tid >> 1, hf = tid & 1;
            const u32x4* src = (const u32x4*)(KV + (size_t)(b * 256 + row) * 8192 + L * 2048 + h * 256 + hf * 128);
#pragma unroll
            for (int i0 = 0; i0 < 16; i0 += 8) {
                u32x4 w[8];
#pragma unroll
                for (int i = 0; i < 8; ++i) w[i] = src[i0 + i];
#pragma unroll
                for (int i = 0; i < 8; ++i) *(LAS u32x4*)(kl + row * RS + hf * 128 + (i0 + i) * 8) = w[i];
            }
        }
        const size_t tok0 = (size_t)b * S + qt * 256 + wid * 32 + fr;
        u32x4 qw0[8], qw1[8];
#pragma unroll
        for (int s = 0; s < 8; ++s) { qw0[s] = *(const u32x4*)(QX + tok0 * 1024 + h * 256 + 32 * s + 8 * fq); qw1[s] = *(const u32x4*)(QX + (tok0 + 16) * 1024 + h * 256 + 32 * s + 8 * fq); }
        __syncthreads();
        bf16x8 pf0[8], pf1[8]; float inv0, inv1;
        auto s_part = [&](const u32x4 (&qw)[8], bf16x8 (&pf)[8], float& inv) __attribute__((always_inline)) {
            float ssq = 0.f;
#pragma unroll
            for (int s = 0; s < 8; ++s) {
                const float a0 = bflo(qw[s].x), a1 = bfhi(qw[s].x), a2 = bflo(qw[s].y), a3 = bfhi(qw[s].y), a4 = bflo(qw[s].z), a5 = bfhi(qw[s].z), a6 = bflo(qw[s].w), a7 = bfhi(qw[s].w);
                ssq += (a0 * a0 + a1 * a1) + (a2 * a2 + a3 * a3) + (a4 * a4 + a5 * a5) + (a6 * a6 + a7 * a7);
            }
            ssq = xadd32(xadd16(ssq));
            const float rstd = rsqrtf(ssq * (1.f / 256.f) + EPS);
            bf16x8 qf[8];
#pragma unroll
            for (int s = 0; s < 8; ++s) qf[s] = __builtin_bit_cast(bf16x8, qw[s]);
            f32x4 sc[16];
#pragma unroll
            for (int hf = 0; hf < 2; ++hf) {
                unsigned kb = (unsigned)(size_t)(kl + (128 * hf + fr) * RS + 8 * fq); asm volatile("" : "+v"(kb));
#pragma unroll
                for (int t8 = 0; t8 < 8; ++t8) { const int t = 8 * hf + t8; sc[t] = (f32x4){0.f, 0.f, 0.f, 0.f};
#pragma unroll
                    for (int s = 0; s < 8; ++s) { const bf16x8 kf = *(const LAS bf16x8*)(size_t)(kb + (unsigned)((16 * t8 * RS + 32 * s) * 2));
                        sc[t] = __builtin_amdgcn_mfma_f32_16x16x32_bf16(kf, qf[s], sc[t], 0, 0, 0); }
                    if (t & 1) asm volatile("" ::: "memory"); }
            }
            float mx = -INFINITY;
#pragma unroll
            for (int t = 0; t < 16; ++t) mx = fmaxf(mx, fmaxf(fmaxf(sc[t].x, sc[t].y), fmaxf(sc[t].z, sc[t].w)));
            mx = xmax32(xmax16(mx));
            float lsum = 0.f;
#pragma unroll
            for (int t = 0; t < 16; ++t) { sc[t].x = __expf((sc[t].x - mx) * rstd); sc[t].y = __expf((sc[t].y - mx) * rstd); sc[t].z = __expf((sc[t].z - mx) * rstd); sc[t].w = __expf((sc[t].w - mx) * rstd); lsum += (sc[t].x + sc[t].y) + (sc[t].z + sc[t].w); }
            lsum = xadd32(xadd16(lsum));
            inv = 1.f / lsum;
#pragma unroll
            for (int s = 0; s < 8; ++s) { u32x4 w; w.x = pk2(sc[2 * s].x, sc[2 * s].y); w.y = pk2(sc[2 * s].z, sc[2 * s].w); w.z = pk2(sc[2 * s + 1].x, sc[2 * s + 1].y); w.w = pk2(sc[2 * s + 1].z, sc[2 * s + 1].w);
                pf[s] = __builtin_bit_cast(bf16x8, w); }
        };
        s_part(qw0, pf0, inv0);
        s_part(qw1, pf1, inv1);
        __syncthreads();
        {
            const int row = tid >> 1, hf = tid & 1;
            const u32x4* src = (const u32x4*)(VT + ((size_t)((L * 8 + b) * 4 + h) * 256 + row) * 256 + hf * 128);
#pragma unroll
            for (int i0 = 0; i0 < 16; i0 += 8) {
                u32x4 w[8];
#pragma unroll
                for (int i = 0; i < 8; ++i) w[i] = src[i0 + i];
#pragma unroll
                for (int i = 0; i < 8; ++i) *(LAS u32x4*)(kl + row * RS + hf * 128 + (i0 + i) * 8) = w[i];
            }
        }
        __syncthreads();
#pragma unroll
        for (int hf = 0; hf < 2; ++hf) {
            unsigned vb = (unsigned)(size_t)(kl + (128 * hf + fr) * RS + 8 * fq); asm volatile("" : "+v"(vb));
#pragma unroll
            for (int n8 = 0; n8 < 8; ++n8) { const int n = 8 * hf + n8; f32x4 o0 = (f32x4){0.f, 0.f, 0.f, 0.f}, o1 = o0;
#pragma unroll
                for (int s = 0; s < 8; ++s) { const bf16x8 vf = *(const LAS bf16x8*)(size_t)(vb + (unsigned)((16 * n8 * RS + 32 * s) * 2));
                    o0 = __builtin_amdgcn_mfma_f32_16x16x32_bf16(vf, pf0[s], o0, 0, 0, 0);
                    o1 = __builtin_amdgcn_mfma_f32_16x16x32_bf16(vf, pf1[s], o1, 0, 0, 0); }
                u32x2 w0, w1; w0.x = pk2(o0.x * inv0, o0.y * inv0); w0.y = pk2(o0.z * inv0, o0.w * inv0); w1.x = pk2(o1.x * inv1, o1.y * inv1); w1.y = pk2(o1.z * inv1, o1.w * inv1);
                *(u32x2*)(OX + tok0 * 1024 + h * 256 + 16 * n + 4 * fq) = w0;
                *(u32x2*)(OX + (tok0 + 16) * 1024 + h * 256 + 16 * n + 4 * fq) = w1;
                if (n & 1) asm volatile("" ::: "memory"); }
        }
    }
    __syncthreads();
}

__device__ __forceinline__ void phase_route_mfma(KArgs A, int wv_, int L, LAS unsigned char* lds) {
    const int tid = opaque_tid(wv_), wid = __builtin_amdgcn_readfirstlane(tid >> 6), lane = tid & 63, fr = lane & 15, fq = lane >> 4;
    unsigned char* ws = opq(A->ws);
    const float* RW = (const float*)(ws + WS_RW) + (size_t)L * NEXP * D;
    unsigned* cnt = (unsigned*)(ws + WS_CTL) + CW_CNT + L * 64;
    int* list = (int*)(ws + WS_LIST); int* te = (int*)(ws + WS_TOK); int* tp = te + 2 * T; float* tw = (float*)(tp + 2 * T);
    bf16* XN = (bf16*)(ws + WS_XN);
    constexpr int WSTR = 1032;
    LAS bf16* rwh = (LAS bf16*)lds;
    LAS bf16* rwl = rwh + 16 * WSTR;
    LAS float* xch = (LAS float*)(lds + 2 * 16 * WSTR * 2);
    LAS unsigned* lcnt = (LAS unsigned*)(lds + 2 * 16 * WSTR * 2 + 8 * 320 * 4);
    LAS unsigned* lbase = lcnt + 16;
    for (int e4 = tid; e4 < NEXP * D / 4; e4 += 512) {
        const f32x4 w = *(const f32x4*)(RW + 4 * e4);
        u32x2 h; h.x = pk2(w.x, w.y); h.y = pk2(w.z, w.w);
        u32x2 l; l.x = pk2(w.x - bflo(h.x), w.y - bfhi(h.x)); l.y = pk2(w.z - bflo(h.y), w.w - bfhi(h.y));
        const int e = (4 * e4) >> 10, k = (4 * e4) & 1023;
        *(LAS u32x2*)(rwh + e * WSTR + k) = h; *(LAS u32x2*)(rwl + e * WSTR + k) = l;
    }
    const int tg = wid >> 1, kh = wid & 1;
    const float rbv = A->in[I_RB][fr];
    for (int blk = blockIdx.x; blk < T / 64; blk += gridDim.x) {
        __syncthreads();
        if (tid < 16) lcnt[tid] = 0u;
        const size_t tok = (size_t)blk * 64 + 16 * tg + fr;
        const bf16* xrow = (const bf16*)(ws + WS_X16) + tok * D + 512 * kh + 8 * fq;
        f32x4 acc = (f32x4){0.f, 0.f, 0.f, 0.f}; float ssq = 0.f;
        bf16x8 ah[16];
#pragma unroll
        for (int s = 0; s < 16; ++s) ah[s] = *(const bf16x8*)(xrow + 32 * s);
#pragma unroll
        for (int s = 0; s < 16; ++s) {
            const u32x4 hw = __builtin_bit_cast(u32x4, ah[s]);
            const float x0 = bflo(hw.x), x1 = bfhi(hw.x), x2 = bflo(hw.y), x3 = bfhi(hw.y), x4 = bflo(hw.z), x5 = bfhi(hw.z), x6 = bflo(hw.w), x7 = bfhi(hw.w);
            ssq += ((x0 * x0 + x1 * x1) + (x2 * x2 + x3 * x3)) + ((x4 * x4 + x5 * x5) + (x6 * x6 + x7 * x7));
            const bf16x8 bh = *(const LAS bf16x8*)(rwh + fr * WSTR + 512 * kh + 32 * s + 8 * fq), bl = *(const LAS bf16x8*)(rwl + fr * WSTR + 512 * kh + 32 * s + 8 * fq);
            acc = __builtin_amdgcn_mfma_f32_16x16x32_bf16(ah[s], bh, acc, 0, 0, 0);
            acc = __builtin_amdgcn_mfma_f32_16x16x32_bf16(ah[s], bl, acc, 0, 0, 0);
        }
        ssq = xadd32(xadd16(ssq));
        LAS float* mine = xch + wid * 320; const LAS float* other = xch + (wid ^ 1) * 320;
#pragma unroll
        for (int r = 0; r < 4; ++r) mine[(4 * fq + r) * 20 + fr] = acc[r];
        if (fq == 0) mine[fr * 20 + 16] = ssq;
        __syncthreads();
        const float rstd = rsqrtf((ssq + other[fr * 20 + 16]) * (1.f / 1024.f) + EPS);
        {
            bf16* xo = XN + tok * D + 512 * kh + 8 * fq;
#pragma unroll
            for (int s = 0; s < 16; ++s) { const u32x4 hw = __builtin_bit_cast(u32x4, ah[s]);
                u32x4 o; o.x = pk2(bflo(hw.x) * rstd, bfhi(hw.x) * rstd); o.y = pk2(bflo(hw.y) * rstd, bfhi(hw.y) * rstd); o.z = pk2(bflo(hw.z) * rstd, bfhi(hw.z) * rstd); o.w = pk2(bflo(hw.w) * rstd, bfhi(hw.w) * rstd);
                *(u32x4*)(xo + 32 * s) = o; }
        }
        int e0r[4], e1r[4], r0r[4], r1r[4]; float w0r[4];
        if (kh == 0) {
#pragma unroll
            for (int r = 0; r < 4; ++r) {
                const float rs = __shfl(rstd, 4 * fq + r);
                const float lg = (acc[r] + other[(4 * fq + r) * 20 + fr]) * rs + rbv;
                float v0 = lg; v0 = fmaxf(v0, __shfl_xor(v0, 1)); v0 = fmaxf(v0, __shfl_xor(v0, 2)); v0 = fmaxf(v0, __shfl_xor(v0, 4)); v0 = fmaxf(v0, __shfl_xor(v0, 8));
                const unsigned long long bm0 = __ballot(lg == v0);
                const int e0 = __ffs((unsigned)(bm0 >> (16 * fq)) & 0xffffu) - 1;
                const bool c2 = (fr >> 2) == (e0 >> 2) && fr != e0;
                const float m2 = c2 ? lg : -INFINITY;
                float v1 = m2; v1 = fmaxf(v1, __shfl_xor(v1, 1)); v1 = fmaxf(v1, __shfl_xor(v1, 2)); v1 = fmaxf(v1, __shfl_xor(v1, 4)); v1 = fmaxf(v1, __shfl_xor(v1, 8));
                const unsigned long long bm1 = __ballot(c2 && m2 == v1);
                const int e1 = __ffs((unsigned)(bm1 >> (16 * fq)) & 0xffffu) - 1;
                e0r[r] = e0; e1r[r] = e1; w0r[r] = 1.f / (1.f + __expf(v1 - v0));
                r0r[r] = 0; r1r[r] = 0;
                if (fr == 0) { r0r[r] = (int)atomicAdd((unsigned*)(lcnt + e0), 1u); r1r[r] = (int)atomicAdd((unsigned*)(lcnt + e1), 1u); }
            }
        }
        __syncthreads();
        if (tid < 16) lbase[tid] = atomicAdd(&cnt[tid], lcnt[tid]);
        __syncthreads();
        if (kh == 0 && fr == 0) {
#pragma unroll
            for (int r = 0; r < 4; ++r) {
                const int t = blk * 64 + 16 * tg + 4 * fq + r;
                const int p0 = (int)lbase[e0r[r]] + r0r[r], p1 = (int)lbase[e1r[r]] + r1r[r];
                list[e0r[r] * T + p0] = t; list[e1r[r] * T + p1] = t;
                te[2 * t] = e0r[r]; te[2 * t + 1] = e1r[r]; tp[2 * t] = p0; tp[2 * t + 1] = p1; tw[2 * t] = w0r[r]; tw[2 * t + 1] = 1.f - w0r[r];
            }
        }
    }
    __syncthreads();
}

__device__ __forceinline__ void moe_offsets(KArgs A, int wv_, int L, LAS int* off, LAS int* cn) {
    const int t = opaque_tid(wv_);
    if (t < 64) {
        const unsigned* cnt = (const unsigned*)(opq(A->ws) + WS_CTL) + CW_CNT + L * 64;
        const int c = t < 16 ? (int)cnt[t] : 0;
        const int p = (c + 255) & ~255;
        int incl = p;
#pragma unroll
        for (int d = 1; d < 16; d <<= 1) { const int v = __shfl_up(incl, d); incl += (t & 15) >= d ? v : 0; }
        if (t < 16) { off[t] = incl - p; cn[t] = c; }
        if (t == 15) off[16] = incl;
    }
    __syncthreads();
}
__device__ __forceinline__ void phase_moe_combine(KArgs A, int wv_, int L, LAS unsigned char* lds) {
    LAS int* off = (LAS int*)lds; LAS int* cn = off + 32;
    moe_offsets(A, wv_, L, off, cn);
    const int tid_ = opaque_tid(wv_); const int wid = __builtin_amdgcn_readfirstlane(tid_ >> 6), lane = tid_ & 63; const int gw = blockIdx.x * 8 + wid, NGW = gridDim.x * 8;
    unsigned char* ws = opq(A->ws);
    const int* te = (const int*)(ws + WS_TOK); const int* tp = te + 2 * T; const float* tw = (const float*)(tp + 2 * T);
    const bf16* Y = (const bf16*)(ws + WS_Y); bf16* XN = (bf16*)(ws + WS_XN); bf16* X16 = (bf16*)(ws + WS_X16); const bool last = L == DEPTH - 1;
    const int nq = (T - gw + NGW - 1) / NGW;
    for (int q0 = 0; q0 < nq; q0 += 8) {
        int s0m = 0, s1m = 0; float w0m = 0.f, w1m = 0.f;
        { const int qq = q0 + (lane & 7); const int t = gw + NGW * (qq < nq ? qq : nq - 1);
          s0m = off[te[2 * t]] + tp[2 * t]; s1m = off[te[2 * t + 1]] + tp[2 * t + 1]; w0m = tw[2 * t]; w1m = tw[2 * t + 1]; }
        const int nn = nq - q0 < 8 ? nq - q0 : 8;
        f32x4 v[4]; u32x2 xv[4], xn[4], ya[4], yb[4], yan[4], ybn[4];
        { const int t = gw + NGW * q0; const int sl0 = __builtin_amdgcn_readlane(s0m, 0), sl1 = __builtin_amdgcn_readlane(s1m, 0);
#pragma unroll
          for (int j = 0; j < 4; ++j) { xv[j] = ((const u32x2*)(X16 + (size_t)t * D) + lane)[64 * j]; ya[j] = ((const u32x2*)(Y + (size_t)sl0 * D) + lane)[64 * j]; yb[j] = ((const u32x2*)(Y + (size_t)sl1 * D) + lane)[64 * j]; } }
#pragma unroll 1
        for (int q = 0; q < nn; ++q) {
            const int t = gw + NGW * (q0 + q);
            const int qn = q + 1 < nn ? q + 1 : q;
            { const int tn = gw + NGW * (q0 + qn); const int sl0 = __builtin_amdgcn_readlane(s0m, qn), sl1 = __builtin_amdgcn_readlane(s1m, qn);
#pragma unroll
              for (int j = 0; j < 4; ++j) { xn[j] = ((const u32x2*)(X16 + (size_t)tn * D) + lane)[64 * j]; yan[j] = ((const u32x2*)(Y + (size_t)sl0 * D) + lane)[64 * j]; ybn[j] = ((const u32x2*)(Y + (size_t)sl1 * D) + lane)[64 * j]; } }
            const float w0 = __builtin_bit_cast(float, __builtin_amdgcn_readlane(__builtin_bit_cast(int, w0m), q)), w1 = __builtin_bit_cast(float, __builtin_amdgcn_readlane(__builtin_bit_cast(int, w1m), q));
            float s = 0.f;
#pragma unroll
            for (int j = 0; j < 4; ++j) {
                v[j].x = bflo(xv[j].x) + w0 * bflo(ya[j].x) + w1 * bflo(yb[j].x); v[j].y = bfhi(xv[j].x) + w0 * bfhi(ya[j].x) + w1 * bfhi(yb[j].x); v[j].z = bflo(xv[j].y) + w0 * bflo(ya[j].y) + w1 * bflo(yb[j].y); v[j].w = bfhi(xv[j].y) + w0 * bfhi(ya[j].y) + w1 * bfhi(yb[j].y);
                s += (v[j].x * v[j].x + v[j].y * v[j].y) + (v[j].z * v[j].z + v[j].w * v[j].w);
            }
            const float rstd = rsqrtf(wave_sum(s) * (1.f / 1024.f) + EPS);
            u32x2* o8 = (u32x2*)(XN + (size_t)t * D) + lane;
            if (last) { f32x4* xr = (f32x4*)(A->out + (size_t)t * D) + lane;
#pragma unroll
                for (int j = 0; j < 4; ++j) xr[64 * j] = v[j]; }
            else { u32x2* xr = (u32x2*)(X16 + (size_t)t * D) + lane;
#pragma unroll
                for (int j = 0; j < 4; ++j) { u32x2 w; w.x = pk2(v[j].x, v[j].y); w.y = pk2(v[j].z, v[j].w); xr[64 * j] = w; } }
#pragma unroll
            for (int j = 0; j < 4; ++j) { u32x2 w; w.x = pk2(v[j].x * rstd, v[j].y * rstd); w.y = pk2(v[j].z * rstd, v[j].w * rstd); o8[64 * j] = w; }
#pragma unroll
            for (int j = 0; j < 4; ++j) { xv[j] = xn[j]; ya[j] = yan[j]; yb[j] = ybn[j]; }
        }
    }
}

constexpr int PH_PER_EVEN = 5 + 6, PH_PER_ODD = 3 + 6;
constexpr int NPHASES = 1 + 2 * (PH_PER_EVEN + PH_PER_ODD);

__global__ void __launch_bounds__(512, 2) mk_fwd(Args Araw) {
    KArgs A0 = kargs();
    extern __shared__ __attribute__((aligned(16))) unsigned char lds_raw[];
    LAS unsigned char* lds = (LAS unsigned char*)lds_raw;
    volatile LAS unsigned* misc = (volatile LAS unsigned*)(lds + LDS_MISC);
    const int tid = threadIdx.x;
    if (tid < 16) misc[tid] = 0u;
    __syncthreads();
    const int lo = A0->ph_lo, hi = A0->ph_hi;
    const int wv_ = __builtin_amdgcn_readfirstlane(threadIdx.x >> 6);
    if (hi - lo > 1) (void)xcd_barrier_post((unsigned*)(A0->ws + WS_CTL) + CW_BAR, misc);
    int ph = 0;
    unsigned long long tacc_ = 0;
#define PH_BEGIN(k) if (ph >= lo && ph < hi) { const bool tprobe_ = (PROBE_TMASK >> (k)) & 1; unsigned long long tp0_ = 0; if (PROBE_TMASK && tprobe_) tp0_ = __builtin_amdgcn_s_memrealtime(); KArgs A = kargs(); unsigned char* ws = opq(A->ws); _Pragma("unroll 1") for (int rep_ = 0; rep_ < (((PROBE_MASK >> (k)) & 1) ? PROBE_REPS : 1); ++rep_)
#define PH_END   if (ph + 1 < hi) { XcdBarrier b_; b_.bar = (unsigned*)(opq(kargs()->ws) + WS_CTL) + CW_BAR; b_.x = xb_xcc_id(); b_.st = misc; xcd_barrier(b_, opaque_tid(wv_) == 0); } if (PROBE_TMASK && tprobe_) tacc_ += __builtin_amdgcn_s_memrealtime() - tp0_; } ++ph;
    const int G = gridDim.x, cb = blockIdx.x;

    PH_BEGIN(0) phase_prologue(A, wv_, lds); PH_END
    for (int L = 0; L < DEPTH; ++L) {
        const int i = L >> 1;
        if ((L & 1) == 0) {
            PH_BEGIN(3) {
                if (L == 0) {
                    pg8::DenseOrder S; S.init(NBATCH * NMEM, 8192, D, (const bf16*)(ws + WS_WKV), G, cb);
                    pg8::EpiBf16<0> E{(bf16*)(ws + WS_KV), 8192, 32, 0, nullptr, 0};
                    pg8::gemm_phase(lds, (const bf16*)(ws + WS_MN), D, S, E, wv_);
                }
                pg8::DenseOrder S; S.init(T, HYN, D, (const bf16*)(ws + WS_WHYB) + (size_t)i * HYN * D, G, cb);
                pg8::EpiBf16<0> E{(bf16*)(ws + WS_BIG), HYN, 12, 0, nullptr, 0};
                pg8::gemm_phase(lds, (const bf16*)(ws + WS_XN), D, S, E, wv_);
            } PH_END
            PH_BEGIN(4) { const int t4_ = opaque_tid(wv_); SUBT_BEGIN(4); SUBT_END(4, ws, t4_); SUBT_BEGIN(5); phase_compress_mfma(A, wv_, i, lds); SUBT_END(5, ws, t4_); SUBT_BEGIN(6); phase_nsa_prep(A, wv_, i, lds); SUBT_END(6, ws, t4_); SUBT_BEGIN(7); phase_vtiles(A, wv_, lds); SUBT_END(7, ws, t4_); } PH_END
            PH_BEGIN(5) { phase_gla_a(A, wv_, i, lds); __syncthreads(); phase_nsa_attn_mfma(A, wv_, i, lds); } PH_END
            PH_BEGIN(6) phase_gla_c(A, wv_, i, lds, L == 0, L); PH_END
            PH_BEGIN(7) {
                pg8::DenseOrder S; S.init(T, D, D, (const bf16*)(ws + WS_WHOUT) + (size_t)i * D * D, G, cb);
                pg8::EpiResAddNorm E{(bf16*)(ws + WS_X16), D, (float*)(ws + WS_ROWSQ)};
                pg8::gemm_phase(lds, (const bf16*)(ws + WS_CAT), D, S, E, wv_);
            } PH_END
        } else {
            PH_BEGIN(8) {
                pg8::DenseOrder S; S.init(T, 4096, D, (const bf16*)(ws + WS_WSGIN) + (size_t)i * 4096 * D, G, cb);
                pg8::EpiBf16<1> E{(bf16*)(ws + WS_U), 2048, 8, (size_t)(WS_V - WS_U) / 2, (float*)(ws + WS_VSTAT), 8};
                pg8::gemm_phase(lds, (const bf16*)(ws + WS_XN), D, S, E, wv_);
            } PH_END
            PH_BEGIN(9) phase_sgu_mix_mfma(A, wv_, i, lds); PH_END
            PH_BEGIN(10) {
                pg8::DenseOrder S; S.init(T, D, 2048, (const bf16*)(ws + WS_WSGOUT) + (size_t)i * D * 2048, G, cb);
                pg8::EpiResAddNorm E{(bf16*)(ws + WS_X16), D, (float*)(ws + WS_ROWSQ)};
                pg8::gemm_phase(lds, (const bf16*)(ws + WS_UM), 2048, S, E, wv_);
            } PH_END
        }
        PH_BEGIN(12) {
            pg8::DenseOrder S; S.init(T, D, D, (const bf16*)(ws + WS_WQ) + (size_t)L * D * D, G, cb);
            pg8::EpiBf16RowScale E{(bf16*)(ws + WS_QX), D, (const float*)(ws + WS_ROWSQ)};
            pg8::gemm_phase(lds, (const bf16*)(ws + WS_X16), D, S, E, wv_);
            asm volatile("s_waitcnt vmcnt(0)" ::: "memory");
            __syncthreads();
            pg8::Unit u_;
#pragma unroll 1
            for (int ui_ = 0; S.next(ui_, u_); ++ui_) xattn_item(A, wv_, L, lds, u_.pm >> 3, u_.pn, u_.pm & 7);
        } PH_END
        PH_BEGIN(14) {
            pg8::DenseOrder S; S.init(T, D, D, (const bf16*)(ws + WS_WO) + (size_t)L * D * D, G, cb);
            pg8::EpiResAdd E{(bf16*)(ws + WS_X16), D};
            pg8::gemm_phase(lds, (const bf16*)(ws + WS_OX), D, S, E, wv_);
        } PH_END
        PH_BEGIN(15) phase_route_mfma(A, wv_, L, lds); PH_END
        PH_BEGIN(16) {
            LAS int* off = (LAS int*)(lds + pg8::STAGE_BYTES); LAS int* cn = off + 32;
            moe_offsets(A, wv_, L, off, cn);
            pg8::MoeOrder<true> S{(off[16] / 256) * 3, 3, G, cb, D, off, cn, (const int*)(ws + WS_LIST), (const char*)(ws + WS_WMIN) + (size_t)L * 16 * 768 * D * 2, (size_t)768 * D * 2};
            pg8::EpiSwiglu E{(bf16*)(ws + WS_H), DEXP};
            pg8::gemm_phase(lds, (const bf16*)(ws + WS_XN), D, S, E, wv_);
        } PH_END
        PH_BEGIN(17) {
            LAS int* off = (LAS int*)(lds + pg8::STAGE_BYTES); LAS int* cn = off + 32;
            moe_offsets(A, wv_, L, off, cn);
            pg8::MoeOrder<false> S{(off[16] / 256) * 4, 4, G, cb, DEXP, off, cn, (const int*)(ws + WS_LIST), (const char*)(ws + WS_WMOUT) + (size_t)L * 16 * D * DEXP * 2, (size_t)D * DEXP * 2};
            pg8::EpiBf16<0> E{(bf16*)(ws + WS_Y), D, 4, 0, nullptr, 0};
            pg8::gemm_phase(lds, (const bf16*)(ws + WS_H), DEXP, S, E, wv_);
        } PH_END
        PH_BEGIN(18) phase_moe_combine(A, wv_, L, lds); PH_END
    }
#undef PH_BEGIN
#undef PH_END
    if (hi - lo > 1) { for (int q_ = 0; q_ < PROBE_XBAR; ++q_) { XcdBarrier b_; b_.bar = (unsigned*)(opq(kargs()->ws) + WS_CTL) + CW_BAR; b_.x = xb_xcc_id(); b_.st = misc; xcd_barrier(b_, opaque_tid(wv_) == 0); } }
    if ((PROBE_NSA || PROBE_SUB) && blockIdx.x == 0) { const unsigned long long d_ = __hip_atomic_load((unsigned long long*)(A0->ws + WS_CTL + 48000), __ATOMIC_RELAXED, __HIP_MEMORY_SCOPE_AGENT); const unsigned long long t0 = __builtin_amdgcn_s_memrealtime(); while (__builtin_amdgcn_s_memrealtime() - t0 < d_) __builtin_amdgcn_s_sleep(8); }
    if (PROBE_TMASK && blockIdx.x == 0) { const unsigned long long t0 = __builtin_amdgcn_s_memrealtime(); while (__builtin_amdgcn_s_memrealtime() - t0 < tacc_) __builtin_amdgcn_s_sleep(8); }
}

extern "C" void kernel_launch(void* const* d_in, const int* in_sizes, int n_in, void* d_out, int out_size, void* d_ws, size_t ws_size, hipStream_t stream) {
    static int grid = 0;
    if (grid == 0) {
        if (n_in != N_IN || out_size != T * D || ws_size < WS_END) { fprintf(stderr, "kernel_launch: unexpected problem (n_in %d, out %d, ws %zu)\n", n_in, out_size, ws_size); grid = -1; return; }
        int dev = 0, cus = 0, per_cu = 0;
        if (hipGetDevice(&dev) != hipSuccess || hipDeviceGetAttribute(&cus, hipDeviceAttributeMultiprocessorCount, dev) != hipSuccess) { grid = -1; return; }
        if (hipFuncSetAttribute((const void*)mk_fwd, hipFuncAttributeMaxDynamicSharedMemorySize, LDS_BYTES) != hipSuccess) { fprintf(stderr, "kernel_launch: hipFuncSetAttribute failed\n"); grid = -1; return; }
        if (hipOccupancyMaxActiveBlocksPerMultiprocessor(&per_cu, (const void*)mk_fwd, 512, LDS_BYTES) != hipSuccess || per_cu < 1) fprintf(stderr, "kernel_launch: occupancy query says %d\n", per_cu);
        (void)hipGetLastError();
        grid = cus;
    }
    if (grid < 0) return;
    (void)hipMemsetAsync((char*)d_ws + WS_CTL, 0, CTL_BYTES, stream);
    Args a{};
    for (int i = 0; i < N_IN; ++i) a.in[i] = (const float*)d_in[i];
    a.out = (float*)d_out; a.ws = (unsigned char*)d_ws;
    for (int j = 0; j < 32; ++j) a.freq[j] = (float)pow(10000.0, -(double)j / 32.0);
#if MK_ONE_LAUNCH
    a.ph_lo = 0; a.ph_hi = NPHASES;
    hipLaunchKernelGGL(mk_fwd, dim3(grid), dim3(512), LDS_BYTES, stream, a);
#else
    for (int p = 0; p < NPHASES; ++p) { a.ph_lo = p; a.ph_hi = p + 1; hipLaunchKernelGGL(mk_fwd, dim3(grid), dim3(512), LDS_BYTES, stream, a); }
#endif
}
```

```cpp
#include <hip/hip_runtime.h>
#include <stdint.h>
#include <stdio.h>
#include <math.h>

#ifndef PROBE_MASK
#define PROBE_MASK 0
#endif
#ifndef PROBE_TMASK
#define PROBE_TMASK 0
#endif
#ifndef PROBE_NSA
#define PROBE_NSA 0
#endif
#ifndef PROBE_SUB
#define PROBE_SUB 0
#endif
#ifndef PROBE_XBAR
#define PROBE_XBAR 0
#endif
#ifndef PROBE_NSAX
#define PROBE_NSAX 0
#endif
#ifndef PROBE_REPS
#define PROBE_REPS 2
#endif
#ifndef MK_ONE_LAUNCH
#define MK_ONE_LAUNCH 1
#endif

#define LAS __attribute__((address_space(3)))
typedef unsigned short bf16;
typedef short bf16x8 __attribute__((ext_vector_type(8)));
typedef float f32x4 __attribute__((ext_vector_type(4)));
typedef float f32x2 __attribute__((ext_vector_type(2)));
typedef unsigned u32x4 __attribute__((ext_vector_type(4)));
typedef unsigned u32x2 __attribute__((ext_vector_type(2)));

constexpr int T = 16384, D = 1024, NBATCH = 8, S = 2048, DEPTH = 4;
constexpr int NMEM = 256;
constexpr float EPS = 1e-6f;
constexpr int HYN = 3072, HYSRC = 2856;
constexpr int C_QA = 0, C_KC = 512, C_VC = 640, C_KS = 768, C_VS = 896, C_KW = 1024, C_VW = 1152, C_QB = 1280, C_KB = 1536, C_VB = 1792, C_RB = 2304, C_GA = 2816, C_AL = 2840;
constexpr int NCMP = 127;
constexpr int NEXP = 16, DEXP = 384;
constexpr int SLOTS = 2 * T + NEXP * 256;

enum { I_X = 0, I_MEM, I_POS, I_NMIX, I_NXAT, I_NMEM, I_NFFN, I_HYBIN, I_HYBOUT, I_QNORM, I_KNORM, I_CMPPE, I_CMPW1, I_CMPW2, I_GATEB, I_WA2, I_BA, I_ONORM,
       I_SGIN, I_LNG, I_LNB, I_SGWS, I_SGBS, I_SGOUT, I_XWQ, I_XWKV, I_XWO, I_XQN, I_XKN, I_RW, I_RB, I_MOEIN, I_MOEOUT, N_IN };

constexpr size_t MiB = 1u << 20;
constexpr size_t WS_CTL = 0, CTL_BYTES = 1 * MiB;
constexpr size_t WS_WHYB = 1 * MiB;
constexpr size_t WS_WHOUT = WS_WHYB + 12 * MiB;
constexpr size_t WS_WSGIN = WS_WHOUT + 4 * MiB;
constexpr size_t WS_WSGOUT = WS_WSGIN + 16 * MiB;
constexpr size_t WS_WQ = WS_WSGOUT + 8 * MiB;
constexpr size_t WS_WKV = WS_WQ + 8 * MiB;
constexpr size_t WS_WO = WS_WKV + 16 * MiB;
constexpr size_t WS_WMIN = WS_WO + 8 * MiB;
constexpr size_t WS_WMOUT = WS_WMIN + 96 * MiB;
constexpr size_t WS_RW = WS_WMOUT + 48 * MiB;
constexpr size_t WS_XN = WS_RW + 1 * MiB;
constexpr size_t WS_BIG = WS_XN + 32 * MiB;
constexpr size_t WS_QA = WS_BIG + 128 * MiB;
constexpr size_t WS_KS = WS_QA + 16 * MiB;
constexpr size_t WS_KW = WS_KS + 4 * MiB;
constexpr size_t WS_KC = WS_KW + 4 * MiB;
constexpr size_t WS_VC = WS_KC + 1 * MiB;
constexpr size_t WS_CAT = WS_VC + 1 * MiB;
constexpr size_t WS_QX = WS_CAT + 32 * MiB;
constexpr size_t WS_OX = WS_QX + 32 * MiB;
constexpr size_t WS_MN = WS_OX + 32 * MiB;
constexpr size_t WS_KV = WS_MN + 4 * MiB;
constexpr size_t WS_COS = WS_KV + 32 * MiB;
constexpr size_t WS_SIN = WS_COS + 2 * MiB;
constexpr size_t WS_LIST = WS_SIN + 2 * MiB;
constexpr size_t WS_TOK = WS_LIST + 1 * MiB;
constexpr size_t WS_VT = WS_TOK + 1 * MiB;
constexpr size_t WS_VTA = WS_VT + 16 * MiB;
constexpr size_t WS_SLOC = WS_VTA + 32 * MiB;
constexpr size_t WS_DEC = WS_SLOC + 32 * MiB;
constexpr size_t WS_STT = WS_DEC + 1 * MiB;
constexpr size_t WS_WSB = WS_STT + 16 * MiB;
constexpr size_t WS_M0 = WS_WSB + 768 * 1024;
constexpr size_t WS_W1T = WS_WSB + 1 * MiB;
constexpr size_t WS_ROWSQ = WS_W1T + 1 * MiB;
constexpr size_t WS_VSTAT = WS_ROWSQ + 1 * MiB;
constexpr size_t WS_X16 = WS_VSTAT + 4 * MiB;
constexpr size_t WS_END = WS_X16 + 32 * MiB;
constexpr size_t WS_H_BYTES = (size_t)36864 * 384 * 2;
constexpr size_t WS_Y = WS_BIG, WS_H = WS_BIG + 72 * MiB, WS_U = WS_BIG, WS_V = WS_BIG + 64 * MiB, WS_UM = WS_QX;
constexpr int CW_BAR = 4096;
constexpr int CW_RDY = 16384;
constexpr int CW_CNT = 8192;

constexpr int LDS_BYTES = 159744;
constexpr int LDS_MISC = LDS_BYTES - 64;

typedef __bf16 bf16x2_t __attribute__((ext_vector_type(2)));
__device__ __forceinline__ unsigned pk2(float lo, float hi) { const f32x2 v = {lo, hi}; return __builtin_bit_cast(unsigned, __builtin_convertvector(v, bf16x2_t)); }
__device__ __forceinline__ unsigned f2bf(float f) { return (unsigned)__builtin_bit_cast(unsigned short, (__bf16)f); }
__device__ __forceinline__ float bf2f(unsigned b) { return __uint_as_float(b << 16); }
__device__ __forceinline__ float bflo(unsigned w) { return __uint_as_float(w << 16); }
__device__ __forceinline__ float bfhi(unsigned w) { return __uint_as_float(w & 0xffff0000u); }
__device__ __forceinline__ void xswap16(float v, float& a, float& b) { unsigned u = __builtin_bit_cast(unsigned, v), u2 = u; asm volatile("" : "+v"(u2));
    const u32x2 r = __builtin_amdgcn_permlane16_swap(u, u2, false, false); unsigned r0 = r[0], r1 = r[1]; asm volatile("" : "+v"(r0), "+v"(r1)); a = __builtin_bit_cast(float, r0); b = __builtin_bit_cast(float, r1); }
__device__ __forceinline__ void xswap32(float v, float& a, float& b) { unsigned u = __builtin_bit_cast(unsigned, v), u2 = u; asm volatile("" : "+v"(u2));
    const u32x2 r = __builtin_amdgcn_permlane32_swap(u, u2, false, false); unsigned r0 = r[0], r1 = r[1]; asm volatile("" : "+v"(r0), "+v"(r1)); a = __builtin_bit_cast(float, r0); b = __builtin_bit_cast(float, r1); }
__device__ __forceinline__ float xadd16(float v) { float a, b; xswap16(v, a, b); return a + b; }
__device__ __forceinline__ float xadd32(float v) { float a, b; xswap32(v, a, b); return a + b; }
__device__ __forceinline__ float xmax16(float v) { float a, b; xswap16(v, a, b); return fmaxf(a, b); }
__device__ __forceinline__ float xmax32(float v) { float a, b; xswap32(v, a, b); return fmaxf(a, b); }
__device__ __forceinline__ float wave_sum(float v) {
#pragma unroll
    for (int o = 1; o < 16; o <<= 1) v += __shfl_xor(v, o);
    return xadd32(xadd16(v));
}
__device__ __forceinline__ float wave_max(float v) {
#pragma unroll
    for (int o = 1; o < 16; o <<= 1) v = fmaxf(v, __shfl_xor(v, o));
    return xmax32(xmax16(v));
}
__device__ __forceinline__ int opaque_tid(int wv) { int l; asm volatile("v_mbcnt_lo_u32_b32 %0, -1, 0\n\tv_mbcnt_hi_u32_b32 %0, -1, %0" : "=v"(l)); return wv * 64 + l; }
__device__ __forceinline__ unsigned char* opq(unsigned char* p) { asm volatile("" : "+s"(p)); return p; }
#define LDS_WAIT() asm volatile("s_waitcnt lgkmcnt(0)" ::: "memory")
__device__ __forceinline__ float gelu_tanh(float x) {
    const float u2 = x * (1.5957691216057308f + 0.07135481283f * x * x);
    return x * __builtin_amdgcn_rcpf(1.0f + __expf(-u2));
}
__device__ __forceinline__ float sigmoidf_(float x) { return __builtin_amdgcn_rcpf(1.0f + __expf(-x)); }

#define SUBT_BEGIN(id) unsigned long long subt_##id = 0; if (PROBE_SUB == (id)) subt_##id = __builtin_amdgcn_s_memrealtime();
#define SUBT_END(id, wsp, tidv) do { if (PROBE_SUB == (id) && blockIdx.x == 0 && (tidv) == 0) atomicAdd((unsigned long long*)((wsp) + WS_CTL + 48000), __builtin_amdgcn_s_memrealtime() - subt_##id); } while (0)
#define XB_TMO      128
#define XB_XCNT(j)  (256  + 64 * (j))
#define XB_XSUB(j)  (1280 + 64 * (j))
#define XB_XGEN(j)  (2304 + 64 * (j))
#define XB_TOP      3328
#define XB_TOPGEN   3392
#define XCD_BAR_WORDS 3456
#define XB_SPIN_CAP (1u << 22)

__device__ __forceinline__ unsigned xb_ld(unsigned* p)              { return __hip_atomic_load(p, __ATOMIC_RELAXED, __HIP_MEMORY_SCOPE_AGENT); }
__device__ __forceinline__ unsigned xb_add(unsigned* p, unsigned v) { return __hip_atomic_fetch_add(p, v, __ATOMIC_RELAXED, __HIP_MEMORY_SCOPE_AGENT); }
__device__ __forceinline__ unsigned xb_xcc_id() { return (unsigned)__builtin_amdgcn_s_getreg((3 << 11) | 20) & 0xFu; }
#define XB_SPIN(cond, bar) do { unsigned _sp = 0; while (cond) { __builtin_amdgcn_s_sleep(1); \
    if ((++_sp & 255u) == 0u) { if (xb_ld(&(bar)[XB_TMO])) break; if (_sp > XB_SPIN_CAP) { atomicAdd(&(bar)[XB_TMO], 1u); break; } } } } while (0)

struct XcdBarrier { unsigned* bar; unsigned x; volatile LAS unsigned* st; };
__device__ __forceinline__ unsigned* xb_opaque(unsigned* p) { unsigned long long v = (unsigned long long)p; unsigned lo = __builtin_amdgcn_readfirstlane((unsigned)v), hi = __builtin_amdgcn_readfirstlane((unsigned)(v >> 32));
    asm volatile("" : "+s"(lo), "+s"(hi)); return (unsigned*)(((unsigned long long)hi << 32) | lo); }

__device__ __forceinline__ XcdBarrier xcd_barrier_post(unsigned* bar, volatile LAS unsigned* st) {
    XcdBarrier b; b.bar = bar; b.x = xb_xcc_id(); b.st = st;
    if (threadIdx.x == 0) (void)xb_add(&bar[XB_XCNT(b.x)], 1u);
    return b;
}
__device__ __forceinline__ void xcd_barrier_complete(unsigned* bar, unsigned x, unsigned& nloc, unsigned& nx) {
    const unsigned G = gridDim.x * gridDim.y * gridDim.z;
    unsigned sum, cnt, mine, sp = 0u;
    for (;;) {
        sum = 0u; cnt = 0u; mine = 0u;
#pragma unroll
        for (unsigned j = 0; j < 16; ++j) { const unsigned c = xb_ld(&bar[XB_XCNT(j)]); sum += c; cnt += (c > 0u) ? 1u : 0u; mine = (j == x) ? c : mine; }
        if (sum == G) break;
        __builtin_amdgcn_s_sleep(1);
        if ((++sp & 255u) == 0u) { if (xb_ld(&bar[XB_TMO])) break; if (sp > XB_SPIN_CAP) { atomicAdd(&bar[XB_TMO], 1u); break; } }
    }
    nloc = mine > 0u ? mine : 1u; nx = cnt > 0u ? cnt : 1u;
}
__device__ __forceinline__ void xcd_barrier(const XcdBarrier& b, const bool is_t0, const bool wb = true) {
    asm volatile("s_waitcnt vmcnt(0)" ::: "memory");
    __syncthreads();
    if (is_t0) {
        unsigned* bar = b.bar;
        __builtin_amdgcn_s_waitcnt(0);
        asm volatile("buffer_inv sc1" ::: "memory");
        unsigned nloc = b.st[0], nx = b.st[1];
        if (nloc == 0u) { xcd_barrier_complete(bar, b.x, nloc, nx); b.st[0] = nloc; b.st[1] = nx; }
        const unsigned old = xb_add(&bar[XB_XSUB(b.x)], 1u);
        const unsigned gen = old / nloc;
        if (old + 1u == (gen + 1u) * nloc) {
            if (wb) __builtin_amdgcn_fence(__ATOMIC_RELEASE, "agent");
            asm volatile("s_waitcnt vmcnt(0)" ::: "memory");
            const unsigned og = xb_add(&bar[XB_TOP], 1u);
            const unsigned tg = og / nx;
            if (og + 1u == (tg + 1u) * nx) xb_add(&bar[XB_TOPGEN], 1u);
            else XB_SPIN(xb_ld(&bar[XB_TOPGEN]) == tg, bar);
            asm volatile("" ::: "memory");
            xb_add(&bar[XB_XGEN(b.x)], 1u);
            asm volatile("s_waitcnt vmcnt(0)" ::: "memory");
        } else {
            XB_SPIN(xb_ld(&bar[XB_XGEN(b.x)]) == gen, bar);
            asm volatile("s_waitcnt vmcnt(0)" ::: "memory");
        }
    }
    __syncthreads();
}

struct Args {
    const float* in[N_IN];
    float* out;
    unsigned char* ws;
    float freq[32];
    int ph_lo, ph_hi;
};

typedef const __attribute__((address_space(4))) Args* KArgs;
__device__ __forceinline__ KArgs kargs() { KArgs p = (KArgs)__builtin_amdgcn_kernarg_segment_ptr(); asm volatile("" : "+s"(p)); return p; }

__device__ __forceinline__ void st_bf16x4(bf16* p, f32x4 v) { u32x2 w; w.x = pk2(v[0], v[1]); w.y = pk2(v[2], v[3]); *(u32x2*)p = w; }


__device__ __forceinline__ __amdgpu_buffer_rsrc_t wt_rsrc(const void* base) { return __builtin_amdgcn_make_buffer_rsrc((void*)base, 0, 0x7FFFFFFF, 0x00020000); }
__device__ __forceinline__ void st16_wt(__amdgpu_buffer_rsrc_t r, unsigned byte_off, u32x4 v) { __builtin_amdgcn_raw_buffer_store_b128(v, r, byte_off, 0, 16); }

namespace pg8 {
constexpr int BM = 256, BK = 64, HALF = 128, HTB = HALF * BK * 2, STAGE_BYTES = 8 * HTB, NXCD = 8, WGM = 8;
__host__ __device__ __forceinline__ int lds_byte(int r, int c) { const int st = (r >> 4) * 2 + (c >> 5), rr = r & 15, cc = c & 31, ob = rr * 64 + cc * 2; return st * 1024 + (ob ^ (((ob >> 9) & 1) << 5)); }
__host__ __device__ __forceinline__ void stage_rc(int b, int& R, int& C) { const int st = b / 1024, sb = b % 1024, swz = sb ^ (((sb >> 9) & 1) << 5); R = (st >> 1) * 16 + swz / 64; C = (st & 1) * 32 + (swz % 64) / 2; }
__host__ __device__ __forceinline__ int perm32(int rho) { const int n = rho >> 4, i = rho & 15; return 8 * (i >> 2) + 4 * n + (i & 3); }
struct Unit { int pm, pn, e; };
struct DenseOrder {
    static constexpr bool GATHER = false; static constexpr int SYNC = 0;
    int nM, nN, nwg, G, c, K; const char* Bt;
    __device__ __forceinline__ void init(int M, int N, int K_, const bf16* Bt_, int G_, int c_) { nM = M / BM; nN = N / BM; nwg = nM * nN; G = G_; c = c_; K = K_; Bt = (const char*)Bt_; }
    __device__ __forceinline__ bool next(int i, Unit& u) const {
        const long L = (long)i * G + c; if (L >= nwg) return false;
        int wgid = (int)L; { const int q = nwg / NXCD, r = nwg % NXCD, xcd = wgid % NXCD, off = wgid / NXCD; wgid = (xcd < r ? xcd * (q + 1) : r * (q + 1) + (xcd - r) * q) + off; }
        const int nig = WGM * nN, gid = wgid / nig, fm = gid * WGM, gsz = (nM - fm) < WGM ? (nM - fm) : WGM;
        u.pm = fm + ((wgid % nig) % gsz); u.pn = (wgid % nig) / gsz; u.e = 0; return true;
    }
    __device__ __forceinline__ unsigned a_voff(const Unit& u, int half, int R) const { return (unsigned)((u.pm * BM + half * HALF + R) * K) * 2u; }
    __device__ __forceinline__ const char* b_tile(const Unit& u) const { return Bt + (size_t)u.pn * BM * K * 2; }
};
template <bool GATH, int SYNC_> struct MoeOrder {
    static constexpr bool GATHER = GATH; static constexpr int SYNC = SYNC_;
    int nunits, ntn, G, c, K; const LAS int* off; const LAS int* cn; const int* list; const char* Bt; size_t estride; unsigned* rdy; unsigned need;
    __device__ __forceinline__ void wait(const Unit& u) const {
        unsigned* p = rdy + u.pm; unsigned sp = 0u;
        while (xb_ld(p) < need) { __builtin_amdgcn_s_sleep(1); if (++sp > XB_SPIN_CAP) break; }
        __builtin_amdgcn_fence(__ATOMIC_ACQUIRE, "agent");
        asm volatile("s_waitcnt vmcnt(0)" ::: "memory");
    }
    __device__ __forceinline__ void signal(const Unit& u) const { (void)xb_add(rdy + u.pm, 1u); }
    __device__ __forceinline__ bool next(int i, Unit& u) const {
        const int L = i * G + c; if (L >= nunits) return false;
        u.pm = L / ntn; u.pn = L % ntn; const int s0 = u.pm * BM; int e = 0;
#pragma unroll
        for (int q = 1; q < 16; ++q) e += (s0 >= off[q]) ? 1 : 0;
        u.e = e; return true;
    }
    __device__ __forceinline__ unsigned a_voff(const Unit& u, int half, int R) const {
        const int slot = u.pm * BM + half * HALF + R;
        const int loc = slot - off[u.e]; const int tk = list[u.e * T + (loc < cn[u.e] ? loc : 0)];
        return (unsigned)(tk * K) * 2u;
    }
    __device__ __forceinline__ const char* b_tile(const Unit& u) const { return Bt + (size_t)u.e * estride + (size_t)u.pn * BM * K * 2; }
};
__device__ __forceinline__ unsigned cvt_pk_bf16(float lo, float hi) { return pk2(lo, hi); }

template <class Epi, class Sched>
__device__ __forceinline__ void gemm_phase(LAS unsigned char* lds, const bf16* Aptr, int K, const Sched& S, const Epi& E, int wv_) {
    const int tid = opaque_tid(wv_), wid = __builtin_amdgcn_readfirstlane(tid >> 6), lane = tid & 63, wr = wid >> 2, wc = wid & 3, fr = lane & 15, fq = lane >> 4;
    const int nt = K / BK;
    int Rr[2], Cc[2]; unsigned voffA[2], voffB[2];
#pragma unroll
    for (int i = 0; i < 2; ++i) { stage_rc(tid * 16 + i * 8192, Rr[i], Cc[i]); const int Rb = Epi::PERM ? ((Rr[i] & ~31) + perm32(Rr[i] & 31)) : Rr[i];
        voffA[i] = (unsigned)(Rr[i] * K + Cc[i]) * 2u; voffB[i] = (unsigned)(Rb * K + Cc[i]) * 2u; }
    const size_t kstep = (size_t)(BK * 2);
    const size_t hstep = (size_t)HALF * K * 2;
    const size_t tstep = 2 * hstep;
    const unsigned ldsw = (unsigned)wid * 1024u;
    const int aoff = lds_byte(wr * 64 + fr, fq * 8), boff = lds_byte(wc * 32 + fr, fq * 8);
    const char* const Ab = (const char*)Aptr;
#define PG8_SA(b, h) (((b) * 2 + (h)) * HTB)
#define PG8_SB(b, h) ((4 + (b) * 2 + (h)) * HTB)
#define PG8_STAGE(bufoff, gbase, voff) do { _Pragma("unroll") for (int _i = 0; _i < 2; ++_i) \
        __builtin_amdgcn_global_load_lds((const unsigned*)((const char*)(gbase) + (voff)[_i]), (LAS unsigned*)(lds + (bufoff) + ldsw + _i * 8192), 16, 0, 0); } while (0)
#define PG8_STAGE_A(bufoff, usenext, h, kofs) do { \
        if constexpr (Sched::GATHER) { const char* gb_ = Ab + (kofs); unsigned vv_[2] = {(usenext) ? vN[h][0] : vA[h][0], (usenext) ? vN[h][1] : vA[h][1]}; PG8_STAGE(bufoff, gb_, vv_); } \
        else { const char* gb_ = ((usenext) ? nA : cA) + (size_t)(h) * hstep + (kofs); PG8_STAGE(bufoff, gb_, voffA); } } while (0)
#define PG8_LDA(dst, b, h) do { _Pragma("unroll") for (int m = 0; m < 4; ++m) _Pragma("unroll") for (int k = 0; k < 2; ++k) dst[m][k] = *(const LAS bf16x8*)(lds + PG8_SA(b, h) + aoff + m * 2048 + k * 1024); } while (0)
#define PG8_LDB(dst, b, h) do { _Pragma("unroll") for (int n = 0; n < 2; ++n) _Pragma("unroll") for (int k = 0; k < 2; ++k) dst[n][k] = *(const LAS bf16x8*)(lds + PG8_SB(b, h) + boff + n * 2048 + k * 1024); } while (0)
#define PG8_MMA(ai, bj, At, Bt) do { __builtin_amdgcn_s_setprio(1); _Pragma("unroll") for (int m = 0; m < 4; ++m) _Pragma("unroll") for (int n = 0; n < 2; ++n) _Pragma("unroll") for (int k = 0; k < 2; ++k) \
        acc[ai][bj][m][n] = __builtin_amdgcn_mfma_f32_16x16x32_bf16(Bt[n][k], At[m][k], acc[ai][bj][m][n], 0, 0, 0); __builtin_amdgcn_s_setprio(0); } while (0)
#define PG8_WAIT_V(n) asm volatile("s_waitcnt vmcnt(" #n ")" ::: "memory")
#define PG8_WAIT_L(n) asm volatile("s_waitcnt lgkmcnt(" #n ")" ::: "memory")
#define PG8_BAR __builtin_amdgcn_s_barrier()
#define PG8_SCHED __builtin_amdgcn_sched_barrier(0)
    Unit cur, nxt; int ui = 0;
    if (!S.next(0, cur)) return;
    if constexpr (Sched::SYNC == 2) { if (wid == 0) S.wait(cur); __syncthreads(); }
    f32x4 acc[2][2][4][2];
#pragma unroll
    for (int a = 0; a < 2; ++a)
#pragma unroll
        for (int b = 0; b < 2; ++b)
#pragma unroll
            for (int m = 0; m < 4; ++m)
#pragma unroll
                for (int n = 0; n < 2; ++n) acc[a][b][m][n] = (f32x4){0.f, 0.f, 0.f, 0.f};
    bf16x8 At[4][2], B0[2][2], B1[2][2];
    unsigned vA[2][2], vN[2][2];
    const char* cA = Ab; const char* nA = Ab;
    if constexpr (Sched::GATHER) {
#pragma unroll
        for (int h = 0; h < 2; ++h)
#pragma unroll
            for (int i = 0; i < 2; ++i) { vA[h][i] = S.a_voff(cur, h, Rr[i]) + (unsigned)Cc[i] * 2u; vN[h][i] = vA[h][i]; }
    } else { cA = Ab + (size_t)cur.pm * tstep; nA = cA; }
    const char* cB = S.b_tile(cur);
    PG8_STAGE(PG8_SB(0, 0), cB, voffB); PG8_STAGE_A(PG8_SA(0, 0), false, 0, 0); PG8_STAGE(PG8_SB(0, 1), cB + hstep, voffB); PG8_STAGE_A(PG8_SA(0, 1), false, 1, 0);
    if (wr == 1) PG8_BAR;
    PG8_WAIT_V(4); PG8_BAR;
    PG8_STAGE(PG8_SB(1, 0), cB + kstep, voffB); PG8_STAGE_A(PG8_SA(1, 0), false, 0, kstep); PG8_STAGE(PG8_SB(1, 1), cB + hstep + kstep, voffB);
    PG8_WAIT_V(6); PG8_BAR;
    for (;;) {
        const bool has_next = S.next(ui + 1, nxt);
        if constexpr (Sched::SYNC == 2) { if (has_next && wid == 0) S.wait(nxt); }
        const char* nB = has_next ? S.b_tile(nxt) : cB;
        if constexpr (Sched::GATHER) {
#pragma unroll
            for (int h = 0; h < 2; ++h)
#pragma unroll
                for (int i = 0; i < 2; ++i) vN[h][i] = has_next ? S.a_voff(nxt, h, Rr[i]) + (unsigned)Cc[i] * 2u : vA[h][i];
        } else nA = has_next ? Ab + (size_t)nxt.pm * tstep : cA;
        for (int t = 0; t < nt; t += 2) {
            const bool last = (t == nt - 2);
            const size_t k1 = (size_t)(t + 1) * kstep, k2 = last ? 0 : (size_t)(t + 2) * kstep, k3 = k2 + kstep;
            const char* b2 = last ? nB : cB + (size_t)(t + 2) * kstep; const char* b3 = b2 + kstep;
            PG8_LDB(B0, 0, 0); PG8_SCHED; PG8_LDA(At, 0, 0); PG8_STAGE_A(PG8_SA(1, 1), false, 1, k1);
            PG8_WAIT_L(8); PG8_BAR; PG8_WAIT_L(0); PG8_MMA(0, 0, At, B0); PG8_BAR; PG8_SCHED;
            PG8_LDB(B1, 0, 1); PG8_STAGE(PG8_SB(0, 0), b2, voffB);
            PG8_BAR; PG8_WAIT_L(0); PG8_MMA(0, 1, At, B1); PG8_BAR;
            PG8_LDA(At, 0, 1); PG8_STAGE_A(PG8_SA(0, 0), last, 0, k2);
            PG8_BAR; PG8_WAIT_L(0); PG8_MMA(1, 0, At, B0); PG8_BAR; PG8_SCHED;
            PG8_STAGE(PG8_SB(0, 1), b2 + hstep, voffB);
            PG8_WAIT_V(6); PG8_BAR; PG8_MMA(1, 1, At, B1); PG8_BAR;
            PG8_LDB(B0, 1, 0); PG8_SCHED; PG8_LDA(At, 1, 0); PG8_STAGE_A(PG8_SA(0, 1), last, 1, k2);
            PG8_WAIT_L(8); PG8_BAR; PG8_WAIT_L(0); PG8_MMA(0, 0, At, B0); PG8_BAR; PG8_SCHED;
            PG8_LDB(B1, 1, 1); PG8_STAGE(PG8_SB(1, 0), b3, voffB);
            PG8_BAR; PG8_WAIT_L(0); PG8_MMA(0, 1, At, B1); PG8_BAR;
            PG8_LDA(At, 1, 1); PG8_STAGE_A(PG8_SA(1, 0), last, 0, k3);
            PG8_BAR; PG8_WAIT_L(0); PG8_MMA(1, 0, At, B0); PG8_BAR; PG8_SCHED;
            PG8_STAGE(PG8_SB(1, 1), b3 + hstep, voffB);
            PG8_WAIT_V(6); PG8_BAR; PG8_MMA(1, 1, At, B1); PG8_BAR;
        }
        E(acc, cur, wr, wc, fr, fq);
        if constexpr (Sched::SYNC == 1) {
            PG8_WAIT_V(0); PG8_BAR; PG8_BAR;
            if (tid == 0) S.signal(cur);
        }
        if (!has_next) break;
#pragma unroll
        for (int a = 0; a < 2; ++a)
#pragma unroll
            for (int b = 0; b < 2; ++b)
#pragma unroll
                for (int m = 0; m < 4; ++m)
#pragma unroll
                    for (int n = 0; n < 2; ++n) acc[a][b][m][n] = (f32x4){0.f, 0.f, 0.f, 0.f};
        cur = nxt; cB = nB; cA = nA; ++ui;
        if constexpr (Sched::GATHER) {
#pragma unroll
            for (int h = 0; h < 2; ++h)
#pragma unroll
                for (int i = 0; i < 2; ++i) vA[h][i] = vN[h][i];
        }
    }
    PG8_WAIT_V(0);
    if (wr == 0) PG8_BAR;
    PG8_BAR;
#undef PG8_SA
#undef PG8_SB
#undef PG8_STAGE
#undef PG8_STAGE_A
#undef PG8_LDA
#undef PG8_LDB
#undef PG8_MMA
#undef PG8_WAIT_V
#undef PG8_WAIT_L
#undef PG8_BAR
#undef PG8_SCHED
}
template <int ACT> struct EpiBf16 {
    static constexpr bool PERM = true;
    bf16* O; int ldc; int tpt; size_t tstride; float* stats; int stat_pn0;
    __device__ __forceinline__ void operator()(const f32x4 (&acc)[2][2][4][2], const Unit& u, int wr, int wc, int fr, int fq) const {
        const int row0 = u.pm * BM + wr * 64 + fr; const int tt = u.pn / tpt; bf16* base = O + (size_t)tt * tstride; const int col0 = (u.pn - tt * tpt) * BM + wc * 32 + 8 * fq;
        const __amdgpu_buffer_rsrc_t rs_ = wt_rsrc(base);
#pragma unroll
        for (int ai = 0; ai < 2; ++ai)
#pragma unroll
            for (int m = 0; m < 4; ++m) { const unsigned rowo = (unsigned)((row0 + ai * HALF + m * 16) * ldc + col0) * 2u; float psum = 0.f, psq = 0.f;
#pragma unroll
                for (int bj = 0; bj < 2; ++bj) { f32x4 v0 = acc[ai][bj][m][0], v1 = acc[ai][bj][m][1];
                    if (ACT == 1) {
#pragma unroll
                        for (int q = 0; q < 4; ++q) { v0[q] = gelu_tanh(v0[q]); v1[q] = gelu_tanh(v1[q]); } }
                    if (ACT == 1) { psum += ((v0[0] + v0[1]) + (v0[2] + v0[3])) + ((v1[0] + v1[1]) + (v1[2] + v1[3]));
                        psq += ((v0[0] * v0[0] + v0[1] * v0[1]) + (v0[2] * v0[2] + v0[3] * v0[3])) + ((v1[0] * v1[0] + v1[1] * v1[1]) + (v1[2] * v1[2] + v1[3] * v1[3])); }
                    u32x4 w; w.x = cvt_pk_bf16(v0[0], v0[1]); w.y = cvt_pk_bf16(v0[2], v0[3]); w.z = cvt_pk_bf16(v1[0], v1[1]); w.w = cvt_pk_bf16(v1[2], v1[3]);
                    st16_wt(rs_, rowo + (unsigned)(bj * HALF * 2), w); }
                if (ACT == 1 && stats && u.pn >= stat_pn0) {
                    psum = xadd32(xadd16(psum)); psq = xadd32(xadd16(psq));
                    if (fq == 0) { const unsigned long long st2 = (unsigned long long)__builtin_bit_cast(unsigned, psum) | ((unsigned long long)__builtin_bit_cast(unsigned, psq) << 32);
                        __hip_atomic_store((unsigned long long*)(stats + ((size_t)(row0 + ai * HALF + m * 16) * 32 + (u.pn - stat_pn0) * 4 + wc) * 2), st2, __ATOMIC_RELAXED, __HIP_MEMORY_SCOPE_AGENT); } } }
    }
};
struct EpiResAdd {
    static constexpr bool PERM = true;
    bf16* X; int ldc;
    __device__ __forceinline__ void operator()(const f32x4 (&acc)[2][2][4][2], const Unit& u, int wr, int wc, int fr, int fq) const {
        const int row0 = u.pm * BM + wr * 64 + fr, col0 = u.pn * BM + wc * 32 + 8 * fq;
        const __amdgpu_buffer_rsrc_t rs_ = wt_rsrc(X);
#pragma unroll
        for (int ai = 0; ai < 2; ++ai) {
            u32x4 x[4][2];
#pragma unroll
            for (int m = 0; m < 4; ++m)
#pragma unroll
                for (int bj = 0; bj < 2; ++bj) x[m][bj] = *(const u32x4*)(X + (size_t)(row0 + ai * HALF + m * 16) * ldc + col0 + bj * HALF);
#pragma unroll
            for (int m = 0; m < 4; ++m)
#pragma unroll
                for (int bj = 0; bj < 2; ++bj) { const f32x4 a0 = acc[ai][bj][m][0], a1 = acc[ai][bj][m][1]; const u32x4 xv = x[m][bj];
                    u32x4 w; w.x = pk2(bflo(xv.x) + a0.x, bfhi(xv.x) + a0.y); w.y = pk2(bflo(xv.y) + a0.z, bfhi(xv.y) + a0.w); w.z = pk2(bflo(xv.z) + a1.x, bfhi(xv.z) + a1.y); w.w = pk2(bflo(xv.w) + a1.z, bfhi(xv.w) + a1.w);
                    st16_wt(rs_, (unsigned)((row0 + ai * HALF + m * 16) * ldc + col0 + bj * HALF) * 2u, w); }
        }
    }
};
struct EpiResAddNorm {
    static constexpr bool PERM = true;
    bf16* X; int ldc; float* rowsq;
    __device__ __forceinline__ void operator()(const f32x4 (&acc)[2][2][4][2], const Unit& u, int wr, int wc, int fr, int fq) const {
        const int row0 = u.pm * BM + wr * 64 + fr, col0 = u.pn * BM + wc * 32 + 8 * fq;
        const __amdgpu_buffer_rsrc_t rs_ = wt_rsrc(X);
#pragma unroll
        for (int ai = 0; ai < 2; ++ai) {
            u32x4 x[4][2];
#pragma unroll
            for (int m = 0; m < 4; ++m)
#pragma unroll
                for (int bj = 0; bj < 2; ++bj) x[m][bj] = *(const u32x4*)(X + (size_t)(row0 + ai * HALF + m * 16) * ldc + col0 + bj * HALF);
#pragma unroll
            for (int m = 0; m < 4; ++m) {
                const size_t ro = (size_t)(row0 + ai * HALF + m * 16) * ldc + col0; float ssq = 0.f;
#pragma unroll
                for (int bj = 0; bj < 2; ++bj) { const f32x4 a0 = acc[ai][bj][m][0], a1 = acc[ai][bj][m][1]; const u32x4 xv = x[m][bj];
                    u32x4 w; w.x = pk2(bflo(xv.x) + a0.x, bfhi(xv.x) + a0.y); w.y = pk2(bflo(xv.y) + a0.z, bfhi(xv.y) + a0.w); w.z = pk2(bflo(xv.z) + a1.x, bfhi(xv.z) + a1.y); w.w = pk2(bflo(xv.w) + a1.z, bfhi(xv.w) + a1.w);
                    st16_wt(rs_, (unsigned)(ro + bj * HALF) * 2u, w);
                    const float v0 = bflo(w.x), v1 = bfhi(w.x), v2 = bflo(w.y), v3 = bfhi(w.y), v4 = bflo(w.z), v5 = bfhi(w.z), v6 = bflo(w.w), v7 = bfhi(w.w);
                    ssq += ((v0 * v0 + v1 * v1) + (v2 * v2 + v3 * v3)) + ((v4 * v4 + v5 * v5) + (v6 * v6 + v7 * v7)); }
                ssq = xadd32(xadd16(ssq));
                if (fq == 0) __hip_atomic_store(rowsq + (size_t)(row0 + ai * HALF + m * 16) * 16 + u.pn * 4 + wc, ssq, __ATOMIC_RELAXED, __HIP_MEMORY_SCOPE_AGENT);
            }
        }
    }
};
struct EpiBf16RowScale {
    static constexpr bool PERM = true;
    bf16* O; int ldc; const float* rowsq;
    __device__ __forceinline__ void operator()(const f32x4 (&acc)[2][2][4][2], const Unit& u, int wr, int wc, int fr, int fq) const {
        const int row0 = u.pm * BM + wr * 64 + fr, col0 = u.pn * BM + wc * 32 + 8 * fq;
#pragma unroll
        for (int ai = 0; ai < 2; ++ai) {
            float rs[4];
#pragma unroll
            for (int m = 0; m < 4; ++m) { const f32x4* p = (const f32x4*)(rowsq + (size_t)(row0 + ai * HALF + m * 16) * 16); const f32x4 a = p[0], b = p[1], c = p[2], d = p[3];
                rs[m] = rsqrtf((((a.x + a.y) + (a.z + a.w)) + ((b.x + b.y) + (b.z + b.w)) + (((c.x + c.y) + (c.z + c.w)) + ((d.x + d.y) + (d.z + d.w)))) * (1.f / 1024.f) + EPS); }
#pragma unroll
            for (int m = 0; m < 4; ++m) { const unsigned rowo = (unsigned)((row0 + ai * HALF + m * 16) * ldc + col0) * 2u;
#pragma unroll
                for (int bj = 0; bj < 2; ++bj) { const f32x4 v0 = acc[ai][bj][m][0] * rs[m], v1 = acc[ai][bj][m][1] * rs[m];
                    u32x4 w; w.x = cvt_pk_bf16(v0[0], v0[1]); w.y = cvt_pk_bf16(v0[2], v0[3]); w.z = cvt_pk_bf16(v1[0], v1[1]); w.w = cvt_pk_bf16(v1[2], v1[3]);
                    st16_wt(wt_rsrc(O), rowo + (unsigned)(bj * HALF * 2), w); } }
        }
    }
};
template <bool WT> struct EpiSwiglu {
    static constexpr bool PERM = true;
    bf16* H; int ldc; unsigned hbytes;
    __device__ __forceinline__ void operator()(const f32x4 (&acc)[2][2][4][2], const Unit& u, int wr, int wc, int fr, int fq) const {
        const int row0 = u.pm * BM + wr * 64 + fr, col0 = u.pn * HALF + wc * 32 + 8 * fq;
        const __amdgpu_buffer_rsrc_t rsrc = __builtin_amdgcn_make_buffer_rsrc(H, 0, hbytes, 0x00020000);
#pragma unroll
        for (int ai = 0; ai < 2; ++ai)
#pragma unroll
            for (int m = 0; m < 4; ++m) {
                float o[8];
#pragma unroll
                for (int n = 0; n < 2; ++n)
#pragma unroll
                    for (int q = 0; q < 4; ++q) { const float g = acc[ai][0][m][n][q]; o[4 * n + q] = g * sigmoidf_(g) * acc[ai][1][m][n][q]; }
                u32x4 w; w.x = cvt_pk_bf16(o[0], o[1]); w.y = cvt_pk_bf16(o[2], o[3]); w.z = cvt_pk_bf16(o[4], o[5]); w.w = cvt_pk_bf16(o[6], o[7]);
                if constexpr (WT) __builtin_amdgcn_raw_buffer_store_b128(w, rsrc, (unsigned)(((row0 + ai * HALF + m * 16) * ldc + col0) * 2), 0, 16);
                else *(u32x4*)(H + (size_t)(row0 + ai * HALF + m * 16) * ldc + col0) = w; }
    }
};
}

__device__ __forceinline__ int hyb_colmap(int n) {
    if (n < 1280) return n;
    if (n < 1536) return 1304 + (n - 1280);
    if (n < 1792) return 1560 + (n - 1536);
    if (n < 2304) return 1816 + (n - 1792);
    if (n < 2816) return 2344 + (n - 2304);
    if (n < 2840) return 1280 + (n - 2816);
    if (n < 2856) return 2328 + (n - 2840);
    return -1;
}
__device__ __forceinline__ void tr_item(const float* __restrict__ W, int Nsrc, int K, bf16* __restrict__ Wt, const float* __restrict__ gain, int kind, int nblk, LAS float* scr, int item, int lane) {
    const int kb = item / nblk, nb = item % nblk, k0 = 64 * kb, n0 = 64 * nb;
    const int ksub = lane >> 4, n4 = lane & 15, n = n0 + 4 * n4;
    int col;
    if (kind == 0) col = n; else if (kind == 1) col = hyb_colmap(n); else { const int pn = n >> 8, r = n & 255; col = (r >> 7) * 384 + pn * 128 + (r & 127); }
    f32x4 v[16];
#pragma unroll
    for (int i = 0; i < 16; ++i) v[i] = col >= 0 ? *(const f32x4*)(W + (size_t)(k0 + 4 * i + ksub) * Nsrc + col) : (f32x4){0.f, 0.f, 0.f, 0.f};
    if (gain) {
#pragma unroll
        for (int i = 0; i < 16; ++i) v[i] = v[i] * gain[k0 + 4 * i + ksub];
    }
#pragma unroll
    for (int i = 0; i < 16; ++i) { LAS float* d = scr + (4 * i + ksub) * 65 + 4 * n4; d[0] = v[i].x; d[1] = v[i].y; d[2] = v[i].z; d[3] = v[i].w; }
    LDS_WAIT();
    const int c = lane & 7;
#pragma unroll
    for (int jx = 0; jx < 8; ++jx) {
        const int nn = (lane >> 3) + 8 * jx; const LAS float* s = scr + (8 * c) * 65 + nn;
        u32x4 o; o.x = pk2(s[0 * 65], s[1 * 65]); o.y = pk2(s[2 * 65], s[3 * 65]); o.z = pk2(s[4 * 65], s[5 * 65]); o.w = pk2(s[6 * 65], s[7 * 65]);
        *(u32x4*)(Wt + (size_t)(n0 + nn) * K + k0 + 8 * c) = o;
    }
    LDS_WAIT();
}
__device__ __forceinline__ void rms_row_to_bf16(const float* __restrict__ xrow, bf16* __restrict__ orow, bf16* __restrict__ copy, int lane) {
    const f32x4* xr = (const f32x4*)xrow + lane;
    f32x4 v[4]; float s = 0.f;
#pragma unroll
    for (int j = 0; j < 4; ++j) { v[j] = xr[64 * j]; s += (v[j].x * v[j].x + v[j].y * v[j].y) + (v[j].z * v[j].z + v[j].w * v[j].w); }
    const float rstd = rsqrtf(wave_sum(s) * (1.f / 1024.f) + EPS);
    u32x2* o8 = (u32x2*)orow + lane;
#pragma unroll
    for (int j = 0; j < 4; ++j) { u32x2 w; w.x = pk2(v[j].x * rstd, v[j].y * rstd); w.y = pk2(v[j].z * rstd, v[j].w * rstd); o8[64 * j] = w; }
    if (copy) { u32x2* c4 = (u32x2*)copy + lane;
#pragma unroll
        for (int j = 0; j < 4; ++j) { u32x2 w; w.x = pk2(v[j].x, v[j].y); w.y = pk2(v[j].z, v[j].w); c4[64 * j] = w; } }
}

constexpr int MOE_W_PER_L = 16 * (192 + 96);
__device__ __forceinline__ void moe_weight_item(KArgs A, unsigned char* ws, LAS float* scr, const int l_lo, const int it, const int lane) {
    const int l = l_lo + it / MOE_W_PER_L; int r = it % MOE_W_PER_L;
    if (r < 16 * 192) { const int sl = l * 16 + r / 192; tr_item(A->in[I_MOEIN] + (size_t)sl * 1024 * 768, 768, 1024, (bf16*)(ws + WS_WMIN) + (size_t)sl * 768 * 1024, A->in[I_NFFN] + l * 1024, 2, 12, scr, r % 192, lane); }
    else { r -= 16 * 192; const int sl = l * 16 + r / 96; tr_item(A->in[I_MOEOUT] + (size_t)sl * 384 * 1024, 1024, 384, (bf16*)(ws + WS_WMOUT) + (size_t)sl * 1024 * 384, nullptr, 0, 16, scr, r % 96, lane); }
}
__device__ __forceinline__ void moe_weight_share(KArgs A, int wv_, LAS float* scr, LAS unsigned* wq, const int l_lo, const int blk) {
    const int lane = opaque_tid(wv_) & 63;
    unsigned char* ws = opq(A->ws);
    constexpr int PER_BLK = 2 * MOE_W_PER_L / 256;
    for (;;) {
        unsigned k = 0; if (lane == 0) k = atomicAdd((unsigned*)wq, 1u);
        k = __builtin_amdgcn_readfirstlane(k);
        if (k >= (unsigned)PER_BLK) break;
        moe_weight_item(A, ws, scr, l_lo, blk * PER_BLK + (int)k, lane);
    }
}

__device__ __forceinline__ void phase_prologue(KArgs A, int wv_, LAS unsigned char* lds) {
    const int tid = opaque_tid(wv_), wid = __builtin_amdgcn_readfirstlane(tid >> 6), lane = tid & 63;
    const int gw = blockIdx.x * 8 + wid, NGW = gridDim.x * 8;
    LAS float* scr = (LAS float*)(lds + wid * 16640);
    unsigned char* ws = opq(A->ws);
    constexpr int N_HYB = 2 * 768, N_HOUT = 2 * 256, N_SGIN = 2 * 1024, N_SGOUT = 2 * 512, N_WQ = 4 * 256, N_WKV = 4 * 512, N_WO = 4 * 256, N_W1T = 4 * 32;
    constexpr int NITEMS = N_HYB + N_HOUT + N_SGIN + N_SGOUT + N_WQ + N_WKV + N_WO + N_W1T;
    for (int it = gw; it < NITEMS; it += NGW) {
        int r = it;
        if (r < N_HYB) { const int sl = r / 768; tr_item(A->in[I_HYBIN] + (size_t)sl * 1024 * HYSRC, HYSRC, 1024, (bf16*)(ws + WS_WHYB) + (size_t)sl * HYN * 1024, A->in[I_NMIX] + (2 * sl) * 1024, 1, 48, scr, r % 768, lane); continue; } r -= N_HYB;
        if (r < N_HOUT) { const int sl = r / 256; tr_item(A->in[I_HYBOUT] + (size_t)sl * 1024 * 1024, 1024, 1024, (bf16*)(ws + WS_WHOUT) + (size_t)sl * 1024 * 1024, nullptr, 0, 16, scr, r % 256, lane); continue; } r -= N_HOUT;
        if (r < N_SGIN) { const int sl = r / 1024; tr_item(A->in[I_SGIN] + (size_t)sl * 1024 * 4096, 4096, 1024, (bf16*)(ws + WS_WSGIN) + (size_t)sl * 4096 * 1024, A->in[I_NMIX] + (2 * sl + 1) * 1024, 0, 64, scr, r % 1024, lane); continue; } r -= N_SGIN;
        if (r < N_SGOUT) { const int sl = r / 512; tr_item(A->in[I_SGOUT] + (size_t)sl * 2048 * 1024, 1024, 2048, (bf16*)(ws + WS_WSGOUT) + (size_t)sl * 1024 * 2048, nullptr, 0, 16, scr, r % 512, lane); continue; } r -= N_SGOUT;
        if (r < N_WQ) { const int sl = r / 256; tr_item(A->in[I_XWQ] + (size_t)sl * 1024 * 1024, 1024, 1024, (bf16*)(ws + WS_WQ) + (size_t)sl * 1024 * 1024, A->in[I_NXAT] + sl * 1024, 0, 16, scr, r % 256, lane); continue; } r -= N_WQ;
        if (r < N_WKV) { const int sl = r / 512; tr_item(A->in[I_XWKV] + (size_t)sl * 1024 * 2048, 2048, 1024, (bf16*)(ws + WS_WKV) + (size_t)sl * 2048 * 1024, A->in[I_NMEM] + sl * 1024, 0, 32, scr, r % 512, lane); continue; } r -= N_WKV;
        if (r < N_WO) { const int sl = r / 256; tr_item(A->in[I_XWO] + (size_t)sl * 1024 * 1024, 1024, 1024, (bf16*)(ws + WS_WO) + (size_t)sl * 1024 * 1024, nullptr, 0, 16, scr, r % 256, lane); continue; } r -= N_WO;
        { const int sl = r / 32; tr_item(A->in[I_CMPW1] + (size_t)sl * 2048 * 64, 64, 2048, (bf16*)(ws + WS_W1T) + (size_t)sl * 64 * 2048, nullptr, 0, 1, scr, r % 32, lane); }
    }
    for (int m = gw; m < T; m += NGW) rms_row_to_bf16(A->in[I_X] + (size_t)m * D, (bf16*)(ws + WS_XN) + (size_t)m * D, (bf16*)(ws + WS_X16) + (size_t)m * D, lane);
    for (int m = gw; m < NBATCH * NMEM; m += NGW) rms_row_to_bf16(A->in[I_MEM] + (size_t)m * D, (bf16*)(ws + WS_MN) + (size_t)m * D, nullptr, lane);
    const int gt = blockIdx.x * 512 + tid, NGT = gridDim.x * 512;
    const int* pos = (const int*)A->in[I_POS];
    float* cosT = (float*)(ws + WS_COS); float* sinT = (float*)(ws + WS_SIN);
    for (int i = gt; i < T * 32; i += NGT) {
        const int t = i >> 5, j = i & 31;
        const float ang = (float)pos[t] * A->freq[j];
        const double rev = (double)ang * 0.15915494309189533577;
        const float fr = (float)(rev - rint(rev));
        cosT[i] = __builtin_amdgcn_cosf(fr); sinT[i] = __builtin_amdgcn_sinf(fr);
    }
    { bf16* WSB = (bf16*)(ws + WS_WSB); float* M0 = (float*)(ws + WS_M0); const float* wsg = A->in[I_SGWS];
      for (int e = gt; e < 2 * 8 * 128 * 128; e += NGT) { const int s = e & 127, t = (e >> 7) & 127; WSB[e] = (bf16)f2bf(s <= t ? wsg[e] : 0.f); }
      for (int e = gt; e < 2 * 8 * 128; e += NGT) { const int t = e & 127; const float* r = wsg + (size_t)e * 128; float a = 0.f; for (int s = 0; s <= t; ++s) a += r[s]; M0[e] = a; } }
    float* RW = (float*)(ws + WS_RW);
    for (int i = gt; i < DEPTH * NEXP * D; i += NGT) { const int k = i & 1023, e = (i >> 10) & 15, l = i >> 14; RW[i] = A->in[I_RW][k * NEXP + e] * A->in[I_NFFN][l * D + k]; }
}

__device__ __forceinline__ void phase_knorm(KArgs A, int wv_, const int gw, const int NGW) {
    const int tid_ = opaque_tid(wv_); const int lane = tid_ & 63;
    bf16* KV = (bf16*)(opq(A->ws) + WS_KV);
    for (int it0 = gw * 4; it0 < DEPTH * 2048 * 4; it0 += NGW * 4) {
        u32x2 w[4];
#pragma unroll
        for (int q = 0; q < 4; ++q) { const int it = it0 + q; const int h = it & 3, m = (it >> 2) & 2047, l = it >> 13; w[q] = *(const u32x2*)(KV + (size_t)m * 8192 + l * 2048 + h * 256 + 4 * lane); }
#pragma unroll
        for (int q = 0; q < 4; ++q) {
            const int it = it0 + q; const int h = it & 3, m = (it >> 2) & 2047, l = it >> 13;
            const float x0 = bflo(w[q].x), x1 = bfhi(w[q].x), x2 = bflo(w[q].y), x3 = bfhi(w[q].y);
            const float rstd = rsqrtf(wave_sum(x0 * x0 + x1 * x1 + x2 * x2 + x3 * x3) * (1.f / 256.f) + EPS) * 0.0625f;
            const f32x4 g = *(const f32x4*)(A->in[I_XKN] + l * 256 + 4 * lane) * *(const f32x4*)(A->in[I_XQN] + l * 256 + 4 * lane);
            u32x2 o; o.x = pk2(x0 * rstd * g.x, x1 * rstd * g.y); o.y = pk2(x2 * rstd * g.z, x3 * rstd * g.w);
            *(u32x2*)(KV + (size_t)m * 8192 + l * 2048 + h * 256 + 4 * lane) = o;
        }
    }
}

__device__ __forceinline__ int kpos64(int tok) { const int k = tok & 31; return (tok & 32) + 8 * ((k >> 2) & 3) + 4 * (k >> 4) + (k & 3); }
__device__ __forceinline__ int kperm64(int p) { const int fq = (p >> 3) & 3, j = p & 7; return (p & 32) + 16 * (j >> 2) + 4 * fq + (j & 3); }

__device__ __forceinline__ void phase_nsa_prep(KArgs A, int wv_, int i, LAS unsigned char* lds) {
    const int tid_ = opaque_tid(wv_); const int wid = __builtin_amdgcn_readfirstlane(tid_ >> 6), lane = tid_ & 63; const int gw = blockIdx.x * 8 + wid, NGW = gridDim.x * 8;
    unsigned char* ws = opq(A->ws);
    const bf16* HY = (const bf16*)(ws + WS_BIG);
    const float* cosT = (const float*)(ws + WS_COS); const float* sinT = (const float*)(ws + WS_SIN);
    bf16* QA = (bf16*)(ws + WS_QA); bf16* KS = (bf16*)(ws + WS_KS); bf16* KW = (bf16*)(ws + WS_KW);
    (void)lds;
    const int j8 = lane & 7, ug = lane >> 3;
    const int u1 = 8 + (ug & 3);
    const int src0 = C_QA + 64 * ug, src1 = u1 < 10 ? C_KS + 64 * (u1 - 8) : C_KW + 64 * (u1 - 10);
    const float* g0p = A->in[I_QNORM] + i * 64 + 8 * j8; const float* g1p = A->in[I_KNORM] + (i * 3 + (u1 < 10 ? 1 : 2)) * 64 + 8 * j8;
    const f32x4 g0a = *(const f32x4*)g0p, g0b = *(const f32x4*)(g0p + 4), g1a = *(const f32x4*)g1p, g1b = *(const f32x4*)(g1p + 4);
    u32x4 w0 = (u32x4){0u, 0u, 0u, 0u}, w1 = w0; f32x4 ca, cb, sa, sb;
    if (gw < T) { w0 = *(const u32x4*)(HY + (size_t)gw * HYN + src0 + 8 * j8); w1 = *(const u32x4*)(HY + (size_t)gw * HYN + src1 + 8 * j8);
        const float* cp = cosT + gw * 32 + 8 * (j8 & 3); const float* sp = sinT + gw * 32 + 8 * (j8 & 3); ca = *(const f32x4*)cp; cb = *(const f32x4*)(cp + 4); sa = *(const f32x4*)sp; sb = *(const f32x4*)(sp + 4); }
    for (int t = gw; t < T; t += NGW) {
        const int tn = t + NGW < T ? t + NGW : t;
        const u32x4 n0 = *(const u32x4*)(HY + (size_t)tn * HYN + src0 + 8 * j8), n1 = *(const u32x4*)(HY + (size_t)tn * HYN + src1 + 8 * j8);
        const float* cp = cosT + tn * 32 + 8 * (j8 & 3); const float* sp = sinT + tn * 32 + 8 * (j8 & 3);
        const f32x4 nca = *(const f32x4*)cp, ncb = *(const f32x4*)(cp + 4), nsa = *(const f32x4*)sp, nsb = *(const f32x4*)(sp + 4);
#pragma unroll
        for (int pass = 0; pass < 2; ++pass) {
            const u32x4 w = pass ? w1 : w0; const f32x4 ga = pass ? g1a : g0a, gb = pass ? g1b : g0b;
            float x[8] = {bflo(w.x), bfhi(w.x), bflo(w.y), bfhi(w.y), bflo(w.z), bfhi(w.z), bflo(w.w), bfhi(w.w)};
            float ssq = 0.f;
#pragma unroll
            for (int q = 0; q < 8; ++q) ssq += x[q] * x[q];
            ssq += __shfl_xor(ssq, 1); ssq += __shfl_xor(ssq, 2); ssq += __shfl_xor(ssq, 4);
            const float rs = rsqrtf(ssq * (1.f / 64.f) + EPS) * (pass ? 1.f : 0.125f * 1.4426950408889634f);
            const float gg[8] = {ga.x, ga.y, ga.z, ga.w, gb.x, gb.y, gb.z, gb.w}, cc[8] = {ca.x, ca.y, ca.z, ca.w, cb.x, cb.y, cb.z, cb.w}, ss[8] = {sa.x, sa.y, sa.z, sa.w, sb.x, sb.y, sb.z, sb.w};
            float o[8];
#pragma unroll
            for (int q = 0; q < 8; ++q) { const float y = x[q] * rs * gg[q]; const float pr = __shfl_xor(y, 4);
                o[q] = j8 < 4 ? y * cc[q] - pr * ss[q] : y * cc[q] + pr * ss[q]; }
            u32x4 ow; ow.x = pk2(o[0], o[1]); ow.y = pk2(o[2], o[3]); ow.z = pk2(o[4], o[5]); ow.w = pk2(o[6], o[7]);
            if (pass == 0) *(u32x4*)(QA + (size_t)t * 512 + 64 * ug + 8 * j8) = ow;
            else if (lane < 32) { bf16* dst = (u1 < 10 ? KS + (size_t)t * 128 + 64 * (u1 - 8) : KW + (size_t)t * 128 + 64 * (u1 - 10)); *(u32x4*)(dst + 8 * j8) = ow; }
        }
        w0 = n0; w1 = n1; ca = nca; cb = ncb; sa = nsa; sb = nsb;
    }
}

__device__ __forceinline__ void phase_compress_mfma(KArgs A, int wv_, int i, LAS unsigned char* lds) {
    const int tid = opaque_tid(wv_), wid = __builtin_amdgcn_readfirstlane(tid >> 6), lane = tid & 63, fr = lane & 15, fq = lane >> 4;
    unsigned char* ws = opq(A->ws);
    const bf16* HY = (const bf16*)(ws + WS_BIG);
    const float* cosT = (const float*)(ws + WS_COS); const float* sinT = (const float*)(ws + WS_SIN);
    LAS float* part = (LAS float*)lds;
    LAS float* hbuf = part + 8 * 1024;
    LAS float* obuf = hbuf + 1024;
    LAS float* w2l = obuf + 1024;
    int w2kv = -1;
    for (int it = blockIdx.x; it < 2 * 127; it += gridDim.x) {
        const int kv = it / 127, tile = it % 127;
        const float* pe = A->in[I_CMPPE] + (size_t)(i * 2 + kv) * 32 * 64;
        const float* w2 = A->in[I_CMPW2] + (size_t)(i * 2 + kv) * 64 * 64;
        const bf16* w1t = (const bf16*)(ws + WS_W1T) + (size_t)(i * 2 + kv) * 64 * 2048;
        const int coff = kv ? C_VC : C_KC;
        if (kv != w2kv) { __syncthreads(); for (int e4 = tid; e4 < 1024; e4 += 512) *(LAS f32x4*)(w2l + 4 * e4) = *(const f32x4*)(w2 + 4 * e4); w2kv = kv; }
        {
            const int R = tile * 16 + fr, g = R & 1, bn = R >> 1, n = bn % NCMP, b = bn / NCMP;
            const bf16* arow = HY + (size_t)(b * S + 16 * n) * HYN + coff + g * 64;
            f32x4 acc[4];
#pragma unroll
            for (int t = 0; t < 4; ++t) acc[t] = (f32x4){0.f, 0.f, 0.f, 0.f};
#pragma unroll 4
            for (int s = 0; s < 8; ++s) {
                const int k0 = 256 * wid + 32 * s, l = k0 >> 6, d0 = (k0 & 63) + 8 * fq;
                const u32x4 hw = *(const u32x4*)(arow + (size_t)l * HYN + d0);
                const f32x4 p0 = *(const f32x4*)(pe + l * 64 + d0), p1 = *(const f32x4*)(pe + l * 64 + d0 + 4);
                u32x4 aw; aw.x = pk2(bflo(hw.x) + p0.x, bfhi(hw.x) + p0.y); aw.y = pk2(bflo(hw.y) + p0.z, bfhi(hw.y) + p0.w); aw.z = pk2(bflo(hw.z) + p1.x, bfhi(hw.z) + p1.y); aw.w = pk2(bflo(hw.w) + p1.z, bfhi(hw.w) + p1.w);
                const bf16x8 af = __builtin_bit_cast(bf16x8, aw);
#pragma unroll
                for (int t = 0; t < 4; ++t) { const bf16x8 bfr = *(const bf16x8*)(w1t + (size_t)(16 * t + fr) * 2048 + k0 + 8 * fq);
                    acc[t] = __builtin_amdgcn_mfma_f32_16x16x32_bf16(af, bfr, acc[t], 0, 0, 0); }
            }
            __syncthreads();
#pragma unroll
            for (int t = 0; t < 4; ++t)
#pragma unroll
                for (int r = 0; r < 4; ++r) part[wid * 1024 + (4 * fq + r) * 64 + 16 * t + fr] = acc[t][r];
        }
        __syncthreads();
        for (int e = tid; e < 1024; e += 512) { float a = 0.f;
#pragma unroll
            for (int w = 0; w < 8; ++w) a += part[w * 1024 + e];
            hbuf[e] = gelu_tanh(a); }
        __syncthreads();
        for (int e = tid; e < 1024; e += 512) { const int r = e >> 6, j = e & 63; float o = 0.f;
#pragma unroll 8
            for (int m = 0; m < 64; ++m) o += hbuf[r * 64 + m] * w2l[m * 64 + j];
            obuf[e] = o; }
        __syncthreads();
        for (int r = wid; r < 16; r += 8) {
            const int R = tile * 16 + r, g = R & 1, bn = R >> 1, n = bn % NCMP, b = bn / NCMP;
            const float o = obuf[r * 64 + lane];
            if (kv == 0) {
                const float y = o * rsqrtf(wave_sum(o * o) * (1.f / 64.f) + EPS) * A->in[I_KNORM][(i * 3 + 0) * 64 + lane];
                const int tp = b * S + 16 * n + 31;
                const float c = cosT[tp * 32 + (lane & 31)], sn = sinT[tp * 32 + (lane & 31)];
                const float pr = __shfl_xor(y, 32);
                const float oo = lane < 32 ? y * c - pr * sn : y * c + pr * sn;
                ((bf16*)(ws + WS_KC))[((size_t)(b * 128 + n) * 2 + g) * 64 + lane] = (bf16)f2bf(oo);
            } else {
                bf16* vct = (bf16*)(ws + WS_VC) + ((size_t)(b * 2 + g) * 64 + lane) * 128;
                vct[(n & 64) + kpos64(n & 63)] = (bf16)f2bf(o);
                if (n == 126) vct[127] = 0;
            }
        }
    }
    __syncthreads();
}

__device__ __forceinline__ void nsa_softmax(f32x4 (&sc)[4], bf16x8 (&pf)[2], float& mrun, float& lrun, f32x4 (&o)[4], const bool rowok, const bool edge, const int kphi, const int kplo, const bool allrows, const int fq) {
    float bm = -INFINITY;
    if (edge) {
#pragma unroll
        for (int t = 0; t < 4; ++t)
#pragma unroll
            for (int r = 0; r < 4; ++r) { const int kp = 16 * t + 4 * fq + r; const bool v = rowok && kp <= kphi && kp >= kplo; sc[t][r] = v ? sc[t][r] : -INFINITY; bm = fmaxf(bm, sc[t][r]); }
    } else {
#pragma unroll
        for (int t = 0; t < 4; ++t) bm = fmaxf(bm, fmaxf(fmaxf(sc[t].x, sc[t].y), fmaxf(sc[t].z, sc[t].w)));
        if (!allrows) bm = rowok ? bm : -INFINITY;
    }
    bm = xmax32(xmax16(bm));
    const float mn = fmaxf(mrun, bm); const float mns = mn == -INFINITY ? 0.f : mn;
    float rs = 0.f;
#pragma unroll
    for (int t = 0; t < 4; ++t)
#pragma unroll
        for (int r = 0; r < 4; ++r) { sc[t][r] = __builtin_amdgcn_exp2f(sc[t][r] - mns); rs += sc[t][r]; }
    if (!edge && !allrows) {
#pragma unroll
        for (int t = 0; t < 4; ++t) sc[t] = rowok ? sc[t] : (f32x4){0.f, 0.f, 0.f, 0.f};
        rs = rowok ? rs : 0.f;
    }
    rs = xadd32(xadd16(rs));
    if (__all(mn == mrun)) { lrun += rs; }
    else {
        const float alpha = __builtin_amdgcn_exp2f(mrun - mns);
        lrun = lrun * alpha + rs; mrun = mn;
#pragma unroll
        for (int n = 0; n < 4; ++n) o[n] = o[n] * alpha;
    }
#pragma unroll
    for (int s = 0; s < 2; ++s) { u32x4 w; w.x = pk2(sc[2 * s].x, sc[2 * s].y); w.y = pk2(sc[2 * s].z, sc[2 * s].w); w.z = pk2(sc[2 * s + 1].x, sc[2 * s + 1].y); w.w = pk2(sc[2 * s + 1].z, sc[2 * s + 1].w);
        pf[s] = __builtin_bit_cast(bf16x8, w); }
}

__device__ __forceinline__ void phase_nsa_attn_mfma(KArgs A, int wv_, int i, LAS unsigned char* lds) {
    const int wid = wv_;
    unsigned char* ws = opq(A->ws);
    const bf16* HY = (const bf16*)(ws + WS_BIG); const bf16* QA = (const bf16*)(ws + WS_QA); const bf16* KS = (const bf16*)(ws + WS_KS); const bf16* KW = (const bf16*)(ws + WS_KW);
    const bf16* KC = (const bf16*)(ws + WS_KC); const bf16* VCT = (const bf16*)(ws + WS_VC); const bf16* VTA = (const bf16*)(ws + WS_VTA); bf16* CAT = (bf16*)(ws + WS_CAT);
    constexpr int RS = 80;
    LAS bf16* ktl = (LAS bf16*)lds;
    LAS bf16* vtl = ktl + 4 * 64 * RS;
    LAS float* scl = (LAS float*)(lds + 81920) + wid * 256;
    LAS unsigned* msk = (LAS unsigned*)(lds + 81920 + 8192);
    LAS unsigned* umask = msk + 64;
    const float* gb = A->in[I_GATEB] + i * 24;
    unsigned long long tsub = 0, tt0 = 0;
    for (int pit = blockIdx.x; pit < 256; pit += gridDim.x) {
#pragma unroll 1
        for (int hf = 0; hf < 2; ++hf) {
            const int tid = opaque_tid(wv_), lane = tid & 63, fr = lane & 15, fq = lane >> 4;
            const int bg = pit >> 4, xx = pit & 15, x = hf ? 31 - xx : xx, b = bg >> 1, g = bg & 1;
            const size_t tokbase = (size_t)b * S + 64 * x;
            const int tl0 = 8 * wid + (fr >> 2);
            if (tid == 0) *umask = 0u;
            if (PROBE_NSA == 1) tt0 = __builtin_amdgcn_s_memrealtime();
            bf16x8 qf[2][2];
#pragma unroll
            for (int mt = 0; mt < 2; ++mt)
#pragma unroll
                for (int s = 0; s < 2; ++s) qf[mt][s] = *(const bf16x8*)(QA + (tokbase + tl0 + 4 * mt) * 512 + (g * 4 + (fr & 3)) * 64 + 32 * s + 8 * fq);
            f32x4 outacc[2][4];
            {
                const int tmaxc = (4 * x + 3 + 15) >> 4;
                const bf16* kcb = KC + ((size_t)(b * 128 + fr) * 2 + g) * 64 + 8 * fq;
                bf16x8 pcf[2][4];
#pragma unroll
                for (int mt = 0; mt < 2; ++mt) {
                    f32x4 sc[8];
                    const bf16* kp = kcb;
#pragma unroll
                    for (int t = 0; t < 8; ++t) { sc[t] = (f32x4){0.f, 0.f, 0.f, 0.f};
                        asm volatile("" : "+v"(kp));
                        if (t < tmaxc) {
                            const bf16x8 k0 = *(const bf16x8*)(kp), k1 = *(const bf16x8*)(kp + 32);
                            sc[t] = __builtin_amdgcn_mfma_f32_16x16x32_bf16(k0, qf[mt][0], sc[t], 0, 0, 0);
                            sc[t] = __builtin_amdgcn_mfma_f32_16x16x32_bf16(k1, qf[mt][1], sc[t], 0, 0, 0); }
                        kp += 16 * 128; }
                    const int tg = 64 * x + tl0 + 4 * mt; const int ncv = tg >= 31 ? ((tg - 31) >> 4) + 1 : 0;
                    float mx = -INFINITY;
#pragma unroll
                    for (int t = 0; t < 8; ++t)
#pragma unroll
                        for (int r = 0; r < 4; ++r) { const bool v = 16 * t + 4 * fq + r < ncv; sc[t][r] = v ? sc[t][r] : -INFINITY; mx = fmaxf(mx, sc[t][r]); }
                    mx = xmax32(xmax16(mx));
                    const float mxs = mx == -INFINITY ? 0.f : mx;
                    float sum = 0.f;
#pragma unroll
                    for (int t = 0; t < 8; ++t)
#pragma unroll
                        for (int r = 0; r < 4; ++r) { sc[t][r] = __builtin_amdgcn_exp2f(sc[t][r] - mxs); sum += sc[t][r]; }
                    sum = xadd32(xadd16(sum));
                    const float inv = sum > 0.f ? 1.f / sum : 0.f;
#pragma unroll
                    for (int t = 0; t < 8; ++t) sc[t] = sc[t] * inv;
#pragma unroll
                    for (int s = 0; s < 4; ++s) { u32x4 w; w.x = pk2(sc[2 * s].x, sc[2 * s].y); w.y = pk2(sc[2 * s].z, sc[2 * s].w); w.z = pk2(sc[2 * s + 1].x, sc[2 * s + 1].y); w.w = pk2(sc[2 * s + 1].z, sc[2 * s + 1].w);
                        pcf[mt][s] = __builtin_bit_cast(bf16x8, w); }
                    float w3[8];
#pragma unroll
                    for (int t = 0; t < 8; ++t) {
#pragma unroll
                        for (int r = 0; r < 4; ++r) { float v = sc[t][r]; v += __shfl_xor(v, 1); v += __shfl_xor(v, 2); sc[t][r] = v; }
                        w3[t] = __shfl(sc[t].w, (lane + 48) & 63);
                    }
#pragma unroll
                    for (int t = 0; t < 8; ++t) {
                        const float prev = fq > 0 ? w3[t] : (t > 0 ? w3[t > 0 ? t - 1 : 0] : 0.f);
                        const float imp = sc[t].x + sc[t].y + sc[t].z + 0.5f * sc[t].w + 0.5f * prev;
                        if ((fr & 3) == 0) scl[(4 * mt + (fr >> 2)) * 32 + 4 * t + fq] = imp;
                    }
                    asm volatile("" ::: "memory");
                }
                const bf16* vcb = VCT + ((size_t)(b * 2 + g) * 64 + fr) * 128 + 8 * fq;
#pragma unroll
                for (int n = 0; n < 4; ++n) {
                    outacc[0][n] = (f32x4){0.f, 0.f, 0.f, 0.f}; outacc[1][n] = (f32x4){0.f, 0.f, 0.f, 0.f};
                    asm volatile("" : "+v"(vcb));
#pragma unroll
                    for (int s = 0; s < 4; ++s) if (2 * s < tmaxc) {
                        const bf16x8 vf = *(const bf16x8*)(vcb + 32 * s);
                        outacc[0][n] = __builtin_amdgcn_mfma_f32_16x16x32_bf16(vf, pcf[0][s], outacc[0][n], 0, 0, 0);
                        outacc[1][n] = __builtin_amdgcn_mfma_f32_16x16x32_bf16(vf, pcf[1][s], outacc[1][n], 0, 0, 0); }
                    vcb += 16 * 128;
                    asm volatile("" ::: "memory");
                }
            }
            float g1v[2], g2v[2];
#pragma unroll
            for (int mt = 0; mt < 2; ++mt) {
                const int head = g * 4 + (fr & 3);
                const bf16* gl = HY + (tokbase + tl0 + 4 * mt) * HYN + C_GA + head * 3;
                const float g0 = sigmoidf_(bf2f(gl[0]) + gb[head * 3 + 0]);
                g1v[mt] = sigmoidf_(bf2f(gl[1]) + gb[head * 3 + 1]); g2v[mt] = sigmoidf_(bf2f(gl[2]) + gb[head * 3 + 2]);
#pragma unroll
                for (int n = 0; n < 4; ++n) outacc[mt][n] = outacc[mt][n] * g0;
            }
            LDS_WAIT();
            asm volatile("" ::: "memory");
            {
                const int tok8 = lane >> 3, jg = lane & 7;
                float sj[32];
#pragma unroll
                for (int q = 0; q < 8; ++q) { const f32x4 v = *(const LAS f32x4*)(scl + tok8 * 32 + 4 * q); sj[4 * q] = v.x; sj[4 * q + 1] = v.y; sj[4 * q + 2] = v.z; sj[4 * q + 3] = v.w; }
#pragma unroll
                for (int j = 0; j < 32; ++j) sj[j] = j <= x ? sj[j] + ((j == 0 || j == x || j == x - 1) ? 1000.0f : 0.f) : -INFINITY;
                unsigned bits = 0u;
                const f32x4 mv = *(const LAS f32x4*)(scl + tok8 * 32 + 4 * jg);
#pragma unroll
                for (int q = 0; q < 4; ++q) {
                    const int j = 4 * jg + q;
                    const float mine = j <= x ? mv[q] + ((j == 0 || j == x || j == x - 1) ? 1000.0f : 0.f) : -INFINITY;
                    int rank = 0;
#pragma unroll
                    for (int jj = 0; jj < 32; ++jj) rank += (sj[jj] > mine || (sj[jj] == mine && jj < j)) ? 1 : 0;
                    bits |= (j <= x && rank < 8) ? (1u << j) : 0u;
                }
                bits |= __shfl_xor(bits, 1); bits |= __shfl_xor(bits, 2); bits |= __shfl_xor(bits, 4);
                if (jg == 0) { msk[wid * 8 + tok8] = bits; atomicOr((unsigned*)umask, bits); }
            }
            __syncthreads();
            if (PROBE_NSA == 1) tsub += __builtin_amdgcn_s_memrealtime() - tt0;
#pragma unroll 1
            for (int pp = 0; pp < 2 + (PROBE_NSAX ? 1 : 0); ++pp) {
                const int pass = pp == 2 ? 0 : pp; const bool dummy = pp == 2;
                if (PROBE_NSA == 2 + pass) tt0 = __builtin_amdgcn_s_memrealtime();
                const int jlo = pass ? (x >= 4 ? x - 4 : 0) : 0;
                const unsigned inrange = (x >= 31 ? 0xffffffffu : ((2u << x) - 1u)) & ~((1u << jlo) - 1u);
                unsigned bmask = pass ? inrange : (*umask & inrange);
                const bf16* Kb = pass ? KW : KS; const int cg = (pass ? 10 : 8) + g;
                unsigned tm[2], wm[2], am[2];
#pragma unroll
                for (int mt = 0; mt < 2; ++mt) {
                    tm[mt] = pass ? 0xffffffffu : msk[wid * 8 + 4 * mt + (fr >> 2)];
                    wm[mt] = pass ? 0xffffffffu : (msk[wid * 8 + 4 * mt] | msk[wid * 8 + 4 * mt + 1] | msk[wid * 8 + 4 * mt + 2] | msk[wid * 8 + 4 * mt + 3]);
                    am[mt] = pass ? 0xffffffffu : (msk[wid * 8 + 4 * mt] & msk[wid * 8 + 4 * mt + 1] & msk[wid * 8 + 4 * mt + 2] & msk[wid * 8 + 4 * mt + 3]);
                    wm[mt] = __builtin_amdgcn_readfirstlane(wm[mt]); am[mt] = __builtin_amdgcn_readfirstlane(am[mt]);
                    if (PROBE_NSAX == 2 && dummy) wm[mt] = 0u;
                }
                f32x4 o[2][4]; float mrun[2], lrun[2];
#pragma unroll
                for (int mt = 0; mt < 2; ++mt) { mrun[mt] = -INFINITY; lrun[mt] = 0.f;
#pragma unroll
                    for (int n = 0; n < 4; ++n) o[mt][n] = (f32x4){0.f, 0.f, 0.f, 0.f}; }
                const int srow = tid >> 3, sc16 = tid & 7;
                u32x4 pk0 = (u32x4){0u, 0u, 0u, 0u}, pv0 = pk0, pk1 = pk0, pv1 = pk0;
#define NSA_LD(jx, pk, pv) do { const bf16* ksrc = Kb + ((size_t)b * S + 64 * (jx) + srow) * 128 + g * 64 + sc16 * 8; const bf16* vsrc = VTA + ((size_t)((b * 32 + (jx)) * 12 + cg)) * 4096 + srow * 64 + sc16 * 8; \
                    pk = *(const u32x4*)ksrc; pv = *(const u32x4*)vsrc; } while (0)
                int j0 = __ffs(bmask) - 1; bmask &= bmask - 1u;
                int j1 = bmask ? __ffs(bmask) - 1 : -1; bmask &= bmask - 1u;
                NSA_LD(j0, pk0, pv0); if (j1 >= 0) NSA_LD(j1, pk1, pv1);
                int buf = 0;
                while (j0 >= 0) {
                    *(LAS u32x4*)(ktl + (buf * 2 + 0) * 64 * RS + srow * RS + sc16 * 8) = pk0; *(LAS u32x4*)(vtl + (buf * 2 + 0) * 64 * RS + srow * RS + sc16 * 8) = pv0;
                    if (j1 >= 0) { *(LAS u32x4*)(ktl + (buf * 2 + 1) * 64 * RS + srow * RS + sc16 * 8) = pk1; *(LAS u32x4*)(vtl + (buf * 2 + 1) * 64 * RS + srow * RS + sc16 * 8) = pv1; }
                    const int jn0 = bmask ? __ffs(bmask) - 1 : -1; bmask &= bmask - 1u;
                    const int jn1 = bmask ? __ffs(bmask) - 1 : -1; bmask &= bmask - 1u;
                    if (jn0 >= 0) NSA_LD(jn0, pk0, pv0);
                    if (jn1 >= 0) NSA_LD(jn1, pk1, pv1);
                    __syncthreads();
#pragma unroll 1
                    for (int sub = 0; sub < 2; ++sub) {
                        const int j = sub ? j1 : j0;
                        if (j < 0) break;
                        const LAS bf16* kt = ktl + (buf * 2 + sub) * 64 * RS + fr * RS + 8 * fq; const LAS bf16* vt = vtl + (buf * 2 + sub) * 64 * RS + fr * RS + 8 * fq;
                        const bool nd0 = (wm[0] >> j) & 1u, nd1 = (wm[1] >> j) & 1u;
                        if (!(nd0 || nd1)) continue;
                        const bool edge = (j == x) || (pass && j == x - 4);
                        f32x4 sc0[4], sc1[4];
#pragma unroll
                        for (int t = 0; t < 4; ++t) { sc0[t] = (f32x4){0.f, 0.f, 0.f, 0.f}; sc1[t] = (f32x4){0.f, 0.f, 0.f, 0.f};
                            const bf16x8 k0_ = *(const LAS bf16x8*)(kt + t * 16 * RS), k1_ = *(const LAS bf16x8*)(kt + t * 16 * RS + 32);
                            if (nd0) { sc0[t] = __builtin_amdgcn_mfma_f32_16x16x32_bf16(k0_, qf[0][0], sc0[t], 0, 0, 0); sc0[t] = __builtin_amdgcn_mfma_f32_16x16x32_bf16(k1_, qf[0][1], sc0[t], 0, 0, 0); }
                            if (nd1) { sc1[t] = __builtin_amdgcn_mfma_f32_16x16x32_bf16(k0_, qf[1][0], sc1[t], 0, 0, 0); sc1[t] = __builtin_amdgcn_mfma_f32_16x16x32_bf16(k1_, qf[1][1], sc1[t], 0, 0, 0); } }
                        bf16x8 pf0[2], pf1[2];
                        if (nd0) nsa_softmax(sc0, pf0, mrun[0], lrun[0], o[0], (tm[0] >> j) & 1u, edge, j == x ? tl0 : 63, (pass && j == x - 4) ? tl0 + 1 : 0, (am[0] >> j) & 1u, fq);
                        if (nd1) nsa_softmax(sc1, pf1, mrun[1], lrun[1], o[1], (tm[1] >> j) & 1u, edge, j == x ? tl0 + 4 : 63, (pass && j == x - 4) ? tl0 + 5 : 0, (am[1] >> j) & 1u, fq);
#pragma unroll
                        for (int n = 0; n < 4; ++n) {
                            const bf16x8 v0_ = *(const LAS bf16x8*)(vt + n * 16 * RS), v1_ = *(const LAS bf16x8*)(vt + n * 16 * RS + 32);
                            if (nd0) { o[0][n] = __builtin_amdgcn_mfma_f32_16x16x32_bf16(v0_, pf0[0], o[0][n], 0, 0, 0); o[0][n] = __builtin_amdgcn_mfma_f32_16x16x32_bf16(v1_, pf0[1], o[0][n], 0, 0, 0); }
                            if (nd1) { o[1][n] = __builtin_amdgcn_mfma_f32_16x16x32_bf16(v0_, pf1[0], o[1][n], 0, 0, 0); o[1][n] = __builtin_amdgcn_mfma_f32_16x16x32_bf16(v1_, pf1[1], o[1][n], 0, 0, 0); } }
                    }
                    j0 = jn0; j1 = jn1; buf ^= 1;
                }
#undef NSA_LD
#pragma unroll
                for (int mt = 0; mt < 2; ++mt) { const float sc_ = (pass ? g2v[mt] : g1v[mt]) / lrun[mt];
                    if (!dummy) {
#pragma unroll
                    for (int n = 0; n < 4; ++n) outacc[mt][n] = outacc[mt][n] + o[mt][n] * sc_; } }
                __syncthreads();
                if (PROBE_NSA == 2 + pass) tsub += __builtin_amdgcn_s_memrealtime() - tt0;
            }
#pragma unroll
            for (int mt = 0; mt < 2; ++mt) {
                bf16* dst = CAT + (tokbase + tl0 + 4 * mt) * 1024 + (g * 4 + (fr & 3)) * 64 + 4 * fq;
#pragma unroll
                for (int n = 0; n < 4; ++n) { u32x2 w; w.x = pk2(outacc[mt][n].x, outacc[mt][n].y); w.y = pk2(outacc[mt][n].z, outacc[mt][n].w); *(u32x2*)(dst + 16 * n) = w; }
            }
        }
    }
    __syncthreads();
    if (PROBE_NSA && blockIdx.x == 0 && opaque_tid(wv_) == 0) atomicAdd((unsigned long long*)(ws + WS_CTL + 48000), tsub);
}

__device__ __forceinline__ void phase_vtiles(KArgs A, int wv_, LAS unsigned char* lds) {
    const int tid_ = opaque_tid(wv_); const int wid = __builtin_amdgcn_readfirstlane(tid_ >> 6), lane = tid_ & 63; const int gw = blockIdx.x * 8 + wid, NGW = gridDim.x * 8;
    unsigned char* ws = opq(A->ws);
    const bf16* HY = (const bf16*)(ws + WS_BIG); bf16* VTA = (bf16*)(ws + WS_VTA);
    constexpr int TS = 66;
    LAS bf16* tl = (LAS bf16*)(lds + 65536) + wid * (64 * TS);
    for (int it = gw; it < NBATCH * 32 * 12; it += NGW) {
        const int cg = it % 12, bc = it / 12;
        const int colbase = cg < 8 ? C_VB + cg * 64 : (cg < 10 ? C_VS + (cg - 8) * 64 : C_VW + (cg - 10) * 64);
        const u32x4* src = (const u32x4*)(HY + (size_t)(bc * 64 + lane) * HYN + colbase);
        u32x4 w[8];
#pragma unroll
        for (int i = 0; i < 8; ++i) w[i] = src[i];
#pragma unroll
        for (int i = 0; i < 8; ++i) { LAS unsigned* d = (LAS unsigned*)(tl + lane * TS + 8 * i); d[0] = w[i].x; d[1] = w[i].y; d[2] = w[i].z; d[3] = w[i].w; }
        LDS_WAIT();
        bf16* dst = VTA + (size_t)it * 4096 + lane * 64;
#pragma unroll
        for (int p8 = 0; p8 < 8; ++p8) {
            unsigned short x[8];
#pragma unroll
            for (int j = 0; j < 8; ++j) x[j] = tl[kperm64(p8 * 8 + j) * TS + lane];
            u32x4 o; o.x = x[0] | ((unsigned)x[1] << 16); o.y = x[2] | ((unsigned)x[3] << 16); o.z = x[4] | ((unsigned)x[5] << 16); o.w = x[6] | ((unsigned)x[7] << 16);
            *(u32x4*)(dst + p8 * 8) = o;
        }
        LDS_WAIT();
    }
}

__device__ __forceinline__ void vtrans_wave(KArgs A, int wv_, LAS bf16* tl, const int gw, const int NGW) {
    const int tid_ = opaque_tid(wv_); const int lane = tid_ & 63;
    unsigned char* ws = opq(A->ws);
    const bf16* KV = (const bf16*)(ws + WS_KV); bf16* VT = (bf16*)(ws + WS_VT);
    constexpr int TS = 66;
    for (int it = gw; it < DEPTH * NBATCH * 4 * 16; it += NGW) {
        const int db = it & 3, kb = (it >> 2) & 3, h = (it >> 4) & 3, b = (it >> 6) & 7, l = it >> 9;
        const u32x4* src = (const u32x4*)(KV + (size_t)(b * 256 + 64 * kb + lane) * 8192 + l * 2048 + 1024 + h * 256 + 64 * db);
        u32x4 w[8];
#pragma unroll
        for (int i = 0; i < 8; ++i) w[i] = src[i];
#pragma unroll
        for (int i = 0; i < 8; ++i) { LAS unsigned* d = (LAS unsigned*)(tl + lane * TS + 8 * i); d[0] = w[i].x; d[1] = w[i].y; d[2] = w[i].z; d[3] = w[i].w; }
        LDS_WAIT();
        bf16* dst = VT + ((size_t)((l * 8 + b) * 4 + h) * 256 + 64 * db + lane) * 256 + 64 * kb;
#pragma unroll
        for (int p8 = 0; p8 < 8; ++p8) {
            unsigned short x[8];
#pragma unroll
            for (int j = 0; j < 8; ++j) x[j] = tl[kperm64(p8 * 8 + j) * TS + lane];
            u32x4 o; o.x = x[0] | ((unsigned)x[1] << 16); o.y = x[2] | ((unsigned)x[3] << 16); o.z = x[4] | ((unsigned)x[5] << 16); o.w = x[6] | ((unsigned)x[7] << 16);
            *(u32x4*)(dst + p8 * 8) = o;
        }
        LDS_WAIT();
    }
}

__device__ __forceinline__ float log_sigmoid16(float z) { return (fminf(z, 0.f) - __logf(1.0f + __expf(-fabsf(z)))) * (1.f / 16.f); }
#define GLA_Z(tokv) ({ float z_ = bias; _Pragma("unroll") for (int r_ = 0; r_ < 16; ++r_) z_ += __builtin_bit_cast(float, __builtin_amdgcn_readlane(__builtin_bit_cast(int, al[r_]), (tokv))) * wc[r_]; z_; })
#define GLA_LOAD_GATE() \
    float al[16], wc[16]; \
    { const u32x4* ap_ = (const u32x4*)(HY + (size_t)(tok0 + lane) * HYN + C_AL); const u32x4 a0_ = ap_[0], a1_ = ap_[1]; \
      al[0] = bflo(a0_.x); al[1] = bfhi(a0_.x); al[2] = bflo(a0_.y); al[3] = bfhi(a0_.y); al[4] = bflo(a0_.z); al[5] = bfhi(a0_.z); al[6] = bflo(a0_.w); al[7] = bfhi(a0_.w); \
      al[8] = bflo(a1_.x); al[9] = bfhi(a1_.x); al[10] = bflo(a1_.y); al[11] = bfhi(a1_.y); al[12] = bflo(a1_.z); al[13] = bfhi(a1_.z); al[14] = bflo(a1_.w); al[15] = bfhi(a1_.w); } \
    _Pragma("unroll") for (int r_ = 0; r_ < 16; ++r_) wc[r_] = A->in[I_WA2][(i * 16 + r_) * 256 + h * 64 + lane]; \
    const float bias = A->in[I_BA][i * 256 + h * 64 + lane];

__device__ __forceinline__ void phase_gla_a(KArgs A, int wv_, int i, LAS unsigned char* lds) {
    const int tid_ = opaque_tid(wv_); const int wid = __builtin_amdgcn_readfirstlane(tid_ >> 6), lane = tid_ & 63, fr = lane & 15, fq = lane >> 4; const int gw = blockIdx.x * 8 + wid, NGW = gridDim.x * 8;
    unsigned char* ws = opq(A->ws);
    const bf16* HY = (const bf16*)(ws + WS_BIG); const bf16* VTA = (const bf16*)(ws + WS_VTA); float* SLOC = (float*)(ws + WS_SLOC); float* DEC = (float*)(ws + WS_DEC);
    constexpr int RS = 80;
    LAS bf16* kh = (LAS bf16*)lds + wid * (64 * RS);
    (void)gw;
    for (int it = wid * (int)gridDim.x + (int)blockIdx.x; it < 1024; it += NGW) {
        const int c = it & 31, bh = it >> 5, b = bh >> 2, h = bh & 3; const size_t tok0 = (size_t)b * S + c * 64;
        GLA_LOAD_GATE();
        float bl = 0.f; float la[64];
#pragma unroll
        for (int tk = 0; tk < 64; ++tk) { la[tk] = log_sigmoid16(GLA_Z(tk)); bl += la[tk]; }
        float bc = 0.f;
        unsigned short kcol[64];
#pragma unroll
        for (int tk = 0; tk < 64; ++tk) kcol[tk] = HY[(tok0 + tk) * HYN + C_KB + h * 64 + lane];
#pragma unroll
        for (int tk = 0; tk < 64; ++tk) {
            bc += la[tk];
            kh[lane * RS + kpos64(tk)] = (bf16)f2bf(bf2f(kcol[tk]) * __expf(bl - bc));
        }
        DEC[it * 64 + lane] = __expf(bl);
        LDS_WAIT();
#pragma unroll
        for (int dvh = 0; dvh < 2; ++dvh) {
            const bf16* vt = VTA + ((size_t)((b * 32 + c) * 12 + h * 2 + dvh)) * 4096;
            bf16x8 vf[4][2];
#pragma unroll
            for (int n = 0; n < 4; ++n)
#pragma unroll
                for (int s = 0; s < 2; ++s) vf[n][s] = *(const bf16x8*)(vt + (16 * n + fr) * 64 + 32 * s + 8 * fq);
#pragma unroll
            for (int m = 0; m < 4; ++m) {
                const bf16x8 a0 = *(const LAS bf16x8*)(kh + (16 * m + fr) * RS + 8 * fq), a1 = *(const LAS bf16x8*)(kh + (16 * m + fr) * RS + 32 + 8 * fq);
#pragma unroll
                for (int n = 0; n < 4; ++n) {
                    f32x4 acc = (f32x4){0.f, 0.f, 0.f, 0.f};
                    acc = __builtin_amdgcn_mfma_f32_16x16x32_bf16(vf[n][0], a0, acc, 0, 0, 0);
                    acc = __builtin_amdgcn_mfma_f32_16x16x32_bf16(vf[n][1], a1, acc, 0, 0, 0);
                    *(f32x4*)(SLOC + ((size_t)it * 64 + 16 * m + fr) * 128 + dvh * 64 + 16 * n + 4 * fq) = acc;
                }
            }
        }
        LDS_WAIT();
    }
}
__device__ __forceinline__ void phase_gla_c(KArgs A, int wv_, int i, LAS unsigned char* lds, const bool kv_post, const int Lcur) {
    const int tid_ = opaque_tid(wv_); const int wid = __builtin_amdgcn_readfirstlane(tid_ >> 6), lane = tid_ & 63, fr = lane & 15, fq = lane >> 4; const int gw = blockIdx.x * 8 + wid, NGW = gridDim.x * 8;
    unsigned char* ws = opq(A->ws);
    const bf16* HY = (const bf16*)(ws + WS_BIG); const bf16* VTA = (const bf16*)(ws + WS_VTA); const bf16* STT = (const bf16*)(ws + WS_STT); bf16* CAT = (bf16*)(ws + WS_CAT);
    constexpr int RS = 80;
    LAS bf16* qs = (LAS bf16*)lds + wid * (128 * RS);
    LAS bf16* ks = qs + 64 * RS;
    const float* og = A->in[I_ONORM] + i * 128;
    LAS unsigned* wq = (LAS unsigned*)(lds + 152064 + 1024);
    LAS float* ogl = (LAS float*)(lds + 152064);
    if (tid_ < 128) ogl[tid_] = og[tid_];
    (void)gw; (void)NGW;
    for (int blk = blockIdx.x; blk < 256; blk += gridDim.x) {
        if (tid_ == 0) *wq = 0u;
        SUBT_BEGIN(1);
        {
            const float* SLOC = (const float*)(ws + WS_SLOC); const float* DEC = (const float*)(ws + WS_DEC); bf16* STw = (bf16*)(ws + WS_STT);
            const int tid = tid_, dv = tid & 127, ko = tid >> 7, bh = blk >> 3, c0 = (blk & 7) * 4;
            float sv[16];
#pragma unroll
            for (int j = 0; j < 16; ++j) sv[j] = 0.f;
#pragma unroll 1
            for (int cb = 0; cb < c0 + 4; cb += 4) {
                float dc4[4][16], sl4[4][16];
#pragma unroll
                for (int q = 0; q < 4; ++q) {
                    const size_t item = (size_t)bh * 32 + cb + q; const float* sl = SLOC + (item * 64 + ko * 16) * 128 + dv; const float* dc = DEC + item * 64 + ko * 16;
#pragma unroll
                    for (int j = 0; j < 16; ++j) { dc4[q][j] = dc[j]; sl4[q][j] = sl[j * 128]; }
                }
#pragma unroll
                for (int q = 0; q < 4; ++q) {
                    const int c = cb + q; const size_t item = (size_t)bh * 32 + c;
                    if (c >= c0) {
                        u32x4 o0, o1; o0.x = pk2(sv[0], sv[1]); o0.y = pk2(sv[2], sv[3]); o0.z = pk2(sv[4], sv[5]); o0.w = pk2(sv[6], sv[7]);
                        o1.x = pk2(sv[8], sv[9]); o1.y = pk2(sv[10], sv[11]); o1.z = pk2(sv[12], sv[13]); o1.w = pk2(sv[14], sv[15]);
                        u32x4* d = (u32x4*)(STw + (item * 128 + dv) * 64 + ko * 16); d[0] = o0; d[1] = o1;
                    }
#pragma unroll
                    for (int j = 0; j < 16; ++j) sv[j] = dc4[q][j] * sv[j] + sl4[q][j];
                }
            }
            asm volatile("s_waitcnt vmcnt(0)" ::: "memory");
            __syncthreads();
        }
        SUBT_END(1, ws, tid_);
        SUBT_BEGIN(2);
        SUBT_BEGIN(3);
        if (wid < 4) {
        const int it = blk * 4 + wid;
        const int c = it & 31, bh = it >> 5, b = bh >> 2, h = bh & 3; const size_t tok0 = (size_t)b * S + c * 64;
        GLA_LOAD_GATE();
        float bc = 0.f;
        unsigned short qcol[64], kcol[64];
#pragma unroll
        for (int tk = 0; tk < 64; ++tk) { const bf16* row = HY + (tok0 + tk) * HYN; qcol[tk] = row[C_QB + h * 64 + lane]; kcol[tk] = row[C_KB + h * 64 + lane]; }
#pragma unroll
        for (int tk = 0; tk < 64; ++tk) {
            bc += log_sigmoid16(GLA_Z(tk));
            const float eb = __expf(bc);
            qs[tk * RS + lane] = (bf16)f2bf(bf2f(qcol[tk]) * 0.125f * eb); ks[tk * RS + lane] = (bf16)f2bf(bf2f(kcol[tk]) / eb);
        }
        LDS_WAIT();
        SUBT_END(2, ws, tid_);
        bf16x8 st[8][2];
#pragma unroll
        for (int n = 0; n < 8; ++n)
#pragma unroll
            for (int s = 0; s < 2; ++s) st[n][s] = *(const bf16x8*)(STT + ((size_t)it * 128 + 16 * n + fr) * 64 + 32 * s + 8 * fq);
        const bf16* vt = VTA + ((size_t)((b * 32 + c) * 12 + h * 2)) * 4096;
        bf16x8 vfr[8];
#pragma unroll
        for (int n = 0; n < 8; ++n) { const bf16* vrow = vt + (size_t)(n >> 2) * 4096 + (16 * (n & 3) + fr) * 64 + 8 * fq; vfr[n] = *(const bf16x8*)vrow; }
#pragma unroll
        for (int mi = 0; mi < 4; ++mi) {
            const bf16x8 q0 = *(const LAS bf16x8*)(qs + (16 * mi + fr) * RS + 8 * fq), q1 = *(const LAS bf16x8*)(qs + (16 * mi + fr) * RS + 32 + 8 * fq);
            u32x2 rwv[8];
#pragma unroll
            for (int n = 0; n < 8; ++n) rwv[n] = *(const u32x2*)(HY + (tok0 + 16 * mi + fr) * HYN + C_RB + h * 128 + 16 * n + 4 * fq);
            f32x4 sc[4];
#pragma unroll
            for (int t = 0; t < 4; ++t) {
                sc[t] = (f32x4){0.f, 0.f, 0.f, 0.f};
                if (t <= mi) {
                    const bf16x8 k0 = *(const LAS bf16x8*)(ks + (16 * t + fr) * RS + 8 * fq), k1 = *(const LAS bf16x8*)(ks + (16 * t + fr) * RS + 32 + 8 * fq);
                    sc[t] = __builtin_amdgcn_mfma_f32_16x16x32_bf16(k0, q0, sc[t], 0, 0, 0);
                    sc[t] = __builtin_amdgcn_mfma_f32_16x16x32_bf16(k1, q1, sc[t], 0, 0, 0);
                    if (t == mi) {
                        sc[t].x = (4 * fq + 0 <= fr) ? sc[t].x : 0.f; sc[t].y = (4 * fq + 1 <= fr) ? sc[t].y : 0.f; sc[t].z = (4 * fq + 2 <= fr) ? sc[t].z : 0.f; sc[t].w = (4 * fq + 3 <= fr) ? sc[t].w : 0.f; }
                }
            }
            bf16x8 pf[2];
#pragma unroll
            for (int s = 0; s < 2; ++s) { u32x4 w; w.x = pk2(sc[2 * s].x, sc[2 * s].y); w.y = pk2(sc[2 * s].z, sc[2 * s].w); w.z = pk2(sc[2 * s + 1].x, sc[2 * s + 1].y); w.w = pk2(sc[2 * s + 1].z, sc[2 * s + 1].w);
                pf[s] = __builtin_bit_cast(bf16x8, w); }
            f32x4 o[8]; float ssq = 0.f;
#pragma unroll
            for (int n = 0; n < 8; ++n) {
                o[n] = (f32x4){0.f, 0.f, 0.f, 0.f};
                o[n] = __builtin_amdgcn_mfma_f32_16x16x32_bf16(st[n][0], q0, o[n], 0, 0, 0);
                o[n] = __builtin_amdgcn_mfma_f32_16x16x32_bf16(st[n][1], q1, o[n], 0, 0, 0);
                o[n] = __builtin_amdgcn_mfma_f32_16x16x32_bf16(vfr[n], pf[0], o[n], 0, 0, 0);
                if (mi >= 2) o[n] = __builtin_amdgcn_mfma_f32_16x16x32_bf16(*(const bf16x8*)(vt + (size_t)(n >> 2) * 4096 + (16 * (n & 3) + fr) * 64 + 8 * fq + 32), pf[1], o[n], 0, 0, 0);
                ssq += (o[n].x * o[n].x + o[n].y * o[n].y) + (o[n].z * o[n].z + o[n].w * o[n].w);
            }
            ssq = xadd32(xadd16(ssq));
            const float rstd = rsqrtf(ssq * (1.f / 128.f) + EPS);
            const size_t tok = tok0 + 16 * mi + fr;
#pragma unroll
            for (int n = 0; n < 8; ++n) {
                const int dv = 16 * n + 4 * fq;
                const u32x2 rw = rwv[n]; const f32x4 g = *(const LAS f32x4*)(ogl + dv);
                const float r0 = bflo(rw.x), r1 = bfhi(rw.x), r2 = bflo(rw.y), r3 = bfhi(rw.y);
                u32x2 w; w.x = pk2(o[n].x * rstd * g.x * (r0 * sigmoidf_(r0)), o[n].y * rstd * g.y * (r1 * sigmoidf_(r1)));
                w.y = pk2(o[n].z * rstd * g.z * (r2 * sigmoidf_(r2)), o[n].w * rstd * g.w * (r3 * sigmoidf_(r3)));
                *(u32x2*)(CAT + tok * 1024 + 512 + h * 128 + dv) = w;
            }
        }
        } else {
            if (kv_post) {
                phase_knorm(A, wv_, blk * 4 + (wid - 4), 256 * 4);
                vtrans_wave(A, wv_, (LAS bf16*)(lds + 81920 + (wid - 4) * 16640), blk * 4 + (wid - 4), 256 * 4);
            }
            moe_weight_share(A, wv_, (LAS float*)(lds + 81920 + (wid - 4) * 16640), wq, Lcur, blk);
        }
        if (wid < 4) { LDS_WAIT(); moe_weight_share(A, wv_, (LAS float*)(lds + wid * 20480), wq, Lcur, blk); }
        SUBT_END(3, ws, tid_);
        LDS_WAIT();
        __syncthreads();
    }
}

__device__ __forceinline__ void phase_sgu_mix_mfma(KArgs A, int wv_, int i, LAS unsigned char* lds) {
    const int tid = opaque_tid(wv_), wid = __builtin_amdgcn_readfirstlane(tid >> 6), lane = tid & 63, fr = lane & 15, fq = lane >> 4;
    unsigned char* ws = opq(A->ws);
    const bf16* U = (const bf16*)(ws + WS_U); const bf16* V = (const bf16*)(ws + WS_V); bf16* UM = (bf16*)(ws + WS_UM);
    const bf16* WSB = (const bf16*)(ws + WS_WSB) + (size_t)i * 8 * 16384; const float* M0 = (const float*)(ws + WS_M0) + i * 8 * 128;
    constexpr int VS = 144;
    LAS bf16* vT = (LAS bf16*)lds;
    LAS float* st = (LAS float*)(lds + 256 * VS * 2);
    LAS bf16* wl = (LAS bf16*)(lds + 256 * VS * 2 + 1024);
    const float* lng = A->in[I_LNG] + i * 2048; const float* lnb = A->in[I_LNB] + i * 2048; const float* bsg = A->in[I_SGBS] + i * 8 * 128;
    for (int it = blockIdx.x; it < 256; it += gridDim.x) {
        const int gh = it & 1, n_ = (it >> 1) & 15, b = it >> 5; const size_t tok0 = (size_t)b * S + n_ * 128;
        __syncthreads();
        {
            const float* vst = (const float*)(ws + WS_VSTAT);
#pragma unroll
            for (int s4 = 0; s4 < 16; s4 += 4) {
                const int s = wid * 16 + s4 + (lane >> 4);
                const f32x4 p = *(const f32x4*)(vst + (tok0 + s) * 64 + 4 * (lane & 15));
                float sum = p.x + p.z, sq = p.y + p.w;
                sum += __shfl_xor(sum, 1); sq += __shfl_xor(sq, 1); sum += __shfl_xor(sum, 2); sq += __shfl_xor(sq, 2);
                sum += __shfl_xor(sum, 4); sq += __shfl_xor(sq, 4); sum += __shfl_xor(sum, 8); sq += __shfl_xor(sq, 8);
                const float mean = sum * (1.f / 2048.f); const float var = fmaxf(sq * (1.f / 2048.f) - mean * mean, 0.f);
                if ((lane & 15) == 0) { st[2 * s] = mean; st[2 * s + 1] = rsqrtf(var + EPS); }
            }
        }
#pragma unroll 1
        for (int gg = 0; gg < 4; ++gg) {
            const int g = gh * 4 + gg;
            __syncthreads();
            {
                const int s = tid & 127, cq = tid >> 7;
                const float mean = st[2 * s], rstd = st[2 * s + 1];
                const u32x4* src = (const u32x4*)(V + (tok0 + s) * 2048 + g * 256 + cq * 64);
                u32x4 w8[8], ww[4];
#pragma unroll
                for (int i8 = 0; i8 < 8; ++i8) w8[i8] = src[i8];
#pragma unroll
                for (int q = 0; q < 4; ++q) { const int e = tid + 512 * q; ww[q] = *(const u32x4*)(WSB + ((size_t)g * 128 + (e >> 4)) * 128 + (e & 15) * 8); }
#pragma unroll
                for (int i8 = 0; i8 < 8; ++i8) {
                    const u32x4 w = w8[i8];
                    LAS bf16* d = vT + (cq * 64 + i8 * 8) * VS + s;
                    d[0 * VS] = (bf16)f2bf((bflo(w.x) - mean) * rstd); d[1 * VS] = (bf16)f2bf((bfhi(w.x) - mean) * rstd); d[2 * VS] = (bf16)f2bf((bflo(w.y) - mean) * rstd); d[3 * VS] = (bf16)f2bf((bfhi(w.y) - mean) * rstd);
                    d[4 * VS] = (bf16)f2bf((bflo(w.z) - mean) * rstd); d[5 * VS] = (bf16)f2bf((bfhi(w.z) - mean) * rstd); d[6 * VS] = (bf16)f2bf((bflo(w.w) - mean) * rstd); d[7 * VS] = (bf16)f2bf((bfhi(w.w) - mean) * rstd);
                }
#pragma unroll
                for (int q = 0; q < 4; ++q) { const int e = tid + 512 * q; *(LAS u32x4*)(wl + (e >> 4) * VS + (e & 15) * 8) = ww[q]; }
            }
            u32x2 uw[8][2]; float m0v[8], bsv[8];
#pragma unroll
            for (int n = 0; n < 8; ++n) { const int t = 16 * n + fr; m0v[n] = M0[g * 128 + t]; bsv[n] = bsg[g * 128 + t];
                const size_t ro = (tok0 + t) * 2048 + g * 256 + 32 * wid + 4 * fq; uw[n][0] = *(const u32x2*)(U + ro); uw[n][1] = *(const u32x2*)(U + ro + 16); }
            __syncthreads();
            bf16x8 vf[2][4];
#pragma unroll
            for (int m = 0; m < 2; ++m)
#pragma unroll
                for (int k = 0; k < 4; ++k) vf[m][k] = *(const LAS bf16x8*)(vT + (32 * wid + 16 * m + fr) * VS + 32 * k + 8 * fq);
            f32x4 gc[2], bc[2];
#pragma unroll
            for (int m = 0; m < 2; ++m) { gc[m] = *(const f32x4*)(lng + g * 256 + 32 * wid + 16 * m + 4 * fq); bc[m] = *(const f32x4*)(lnb + g * 256 + 32 * wid + 16 * m + 4 * fq); }
#pragma unroll
            for (int n = 0; n < 8; ++n) {
                f32x4 a0 = (f32x4){0.f, 0.f, 0.f, 0.f}, a1 = (f32x4){0.f, 0.f, 0.f, 0.f};
#pragma unroll
                for (int k = 0; k < 4; ++k) if (k <= (n >> 1)) {
                    const bf16x8 wf = *(const LAS bf16x8*)(wl + (16 * n + fr) * VS + 32 * k + 8 * fq);
                    a0 = __builtin_amdgcn_mfma_f32_16x16x32_bf16(vf[0][k], wf, a0, 0, 0, 0);
                    a1 = __builtin_amdgcn_mfma_f32_16x16x32_bf16(vf[1][k], wf, a1, 0, 0, 0); }
                const int t = 16 * n + fr; const float m0 = m0v[n], bsv_ = bsv[n];
                const size_t ro = (tok0 + t) * 2048 + g * 256 + 32 * wid + 4 * fq;
#pragma unroll
                for (int m = 0; m < 2; ++m) {
                    const f32x4 a = m ? a1 : a0;
                    const u32x2 uw_ = uw[n][m];
                    u32x2 w; w.x = pk2((a.x * gc[m].x + bc[m].x * m0 + bsv_) * bflo(uw_.x), (a.y * gc[m].y + bc[m].y * m0 + bsv_) * bfhi(uw_.x));
                    w.y = pk2((a.z * gc[m].z + bc[m].z * m0 + bsv_) * bflo(uw_.y), (a.w * gc[m].w + bc[m].w * m0 + bsv_) * bfhi(uw_.y));
                    *(u32x2*)(UM + ro + 16 * m) = w;
                }
            }
        }
    }
    __syncthreads();
}

__device__ __forceinline__ void xattn_item(KArgs A, int wv_, int L, LAS unsigned char* lds, const int b, const int h, const int qt) {
    const int tid = opaque_tid(wv_), wid = __builtin_amdgcn_readfirstlane(tid >> 6), lane = tid & 63, fr = lane & 15, fq = lane >> 4;
    unsigned char* ws = opq(A->ws);
    const bf16* QX = (const bf16*)(ws + WS_QX); const bf16* KV = (const bf16*)(ws + WS_KV); const bf16* VT = (const bf16*)(ws + WS_VT); bf16* OX = (bf16*)(ws + WS_OX);
    constexpr int RS = 272;
    LAS bf16* kl = (LAS bf16*)lds;
    const float* qg = A->in[I_XQN] + L * 256;
    {
        __syncthreads();
        {
            const int row = tid >> 1, hf = tid & 1;
            const u32x4* src = (const u32x4*)(KV + (size_t)(b * 256 + row) * 8192 + L * 2048 + h * 256 + hf * 128);
#pragma unroll
            for (int i0 = 0; i0 < 16; i0 += 8) {
                u32x4 w[8];
#pragma unroll
                for (int i = 0; i < 8; ++i) w[i] = src[i0 + i];
#pragma unroll
                for (int i = 0; i < 8; ++i) *(LAS u32x4*)(kl + row * RS + hf * 128 + (i0 + i) * 8) = w[i];
            }
        }
        const size_t tok0 = (size_t)b * S + qt * 256 + wid * 32 + fr;
        u32x4 qw0[8], qw1[8];
#pragma unroll
        for (int s = 0; s < 8; ++s) { qw0[s] = *(const u32x4*)(QX + tok0 * 1024 + h * 256 + 32 * s + 8 * fq); qw1[s] = *(const u32x4*)(QX + (tok0 + 16) * 1024 + h * 256 + 32 * s + 8 * fq); }
        __syncthreads();
        bf16x8 pf0[8], pf1[8]; float inv0, inv1;
        auto s_part = [&](const u32x4 (&qw)[8], bf16x8 (&pf)[8], float& inv) __attribute__((always_inline)) {
            float ssq = 0.f;
#pragma unroll
            for (int s = 0; s < 8; ++s) {
                const float a0 = bflo(qw[s].x), a1 = bfhi(qw[s].x), a2 = bflo(qw[s].y), a3 = bfhi(qw[s].y), a4 = bflo(qw[s].z), a5 = bfhi(qw[s].z), a6 = bflo(qw[s].w), a7 = bfhi(qw[s].w);
                ssq += (a0 * a0 + a1 * a1) + (a2 * a2 + a3 * a3) + (a4 * a4 + a5 * a5) + (a6 * a6 + a7 * a7);
            }
            ssq = xadd32(xadd16(ssq));
            const float rstd = rsqrtf(ssq * (1.f / 256.f) + EPS);
            bf16x8 qf[8];
#pragma unroll
            for (int s = 0; s < 8; ++s) qf[s] = __builtin_bit_cast(bf16x8, qw[s]);
            f32x4 sc[16];
#pragma unroll
            for (int hf = 0; hf < 2; ++hf) {
                unsigned kb = (unsigned)(size_t)(kl + (128 * hf + fr) * RS + 8 * fq); asm volatile("" : "+v"(kb));
#pragma unroll
                for (int t8 = 0; t8 < 8; ++t8) { const int t = 8 * hf + t8; sc[t] = (f32x4){0.f, 0.f, 0.f, 0.f};
#pragma unroll
                    for (int s = 0; s < 8; ++s) { const bf16x8 kf = *(const LAS bf16x8*)(size_t)(kb + (unsigned)((16 * t8 * RS + 32 * s) * 2));
                        sc[t] = __builtin_amdgcn_mfma_f32_16x16x32_bf16(kf, qf[s], sc[t], 0, 0, 0); }
                    if (t & 1) asm volatile("" ::: "memory"); }
            }
            float mx = -INFINITY;
#pragma unroll
            for (int t = 0; t < 16; ++t) mx = fmaxf(mx, fmaxf(fmaxf(sc[t].x, sc[t].y), fmaxf(sc[t].z, sc[t].w)));
            mx = xmax32(xmax16(mx));
            float lsum = 0.f;
#pragma unroll
            for (int t = 0; t < 16; ++t) { sc[t].x = __expf((sc[t].x - mx) * rstd); sc[t].y = __expf((sc[t].y - mx) * rstd); sc[t].z = __expf((sc[t].z - mx) * rstd); sc[t].w = __expf((sc[t].w - mx) * rstd); lsum += (sc[t].x + sc[t].y) + (sc[t].z + sc[t].w); }
            lsum = xadd32(xadd16(lsum));
            inv = 1.f / lsum;
#pragma unroll
            for (int s = 0; s < 8; ++s) { u32x4 w; w.x = pk2(sc[2 * s].x, sc[2 * s].y); w.y = pk2(sc[2 * s].z, sc[2 * s].w); w.z = pk2(sc[2 * s + 1].x, sc[2 * s + 1].y); w.w = pk2(sc[2 * s + 1].z, sc[2 * s + 1].w);
                pf[s] = __builtin_bit_cast(bf16x8, w); }
        };
        s_part(qw0, pf0, inv0);
        s_part(qw1, pf1, inv1);
        __syncthreads();
        {
            const int row = tid >> 1, hf = tid & 1;
            const u32x4* src = (const u32x4*)(VT + ((size_t)((L * 8 + b) * 4 + h) * 256 + (row & ~31) + pg8::perm32(row & 31)) * 256 + hf * 128);
#pragma unroll
            for (int i0 = 0; i0 < 16; i0 += 8) {
                u32x4 w[8];
#pragma unroll
                for (int i = 0; i < 8; ++i) w[i] = src[i0 + i];
#pragma unroll
                for (int i = 0; i < 8; ++i) *(LAS u32x4*)(kl + row * RS + hf * 128 + (i0 + i) * 8) = w[i];
            }
        }
        __syncthreads();
#pragma unroll
        for (int hf = 0; hf < 2; ++hf) {
            unsigned vb = (unsigned)(size_t)(kl + (128 * hf + fr) * RS + 8 * fq); asm volatile("" : "+v"(vb));
#pragma unroll
            for (int p4 = 0; p4 < 4; ++p4) { const int p = 4 * hf + p4; f32x4 o0a = (f32x4){0.f, 0.f, 0.f, 0.f}, o1a = o0a, o0b = o0a, o1b = o0a;
#pragma unroll
                for (int s = 0; s < 8; ++s) { const bf16x8 va = *(const LAS bf16x8*)(size_t)(vb + (unsigned)((32 * p4 * RS + 32 * s) * 2)), vc = *(const LAS bf16x8*)(size_t)(vb + (unsigned)(((32 * p4 + 16) * RS + 32 * s) * 2));
                    o0a = __builtin_amdgcn_mfma_f32_16x16x32_bf16(va, pf0[s], o0a, 0, 0, 0);
                    o1a = __builtin_amdgcn_mfma_f32_16x16x32_bf16(va, pf1[s], o1a, 0, 0, 0);
                    o0b = __builtin_amdgcn_mfma_f32_16x16x32_bf16(vc, pf0[s], o0b, 0, 0, 0);
                    o1b = __builtin_amdgcn_mfma_f32_16x16x32_bf16(vc, pf1[s], o1b, 0, 0, 0); }
                u32x4 w0, w1; w0.x = pk2(o0a.x * inv0, o0a.y * inv0); w0.y = pk2(o0a.z * inv0, o0a.w * inv0); w0.z = pk2(o0b.x * inv0, o0b.y * inv0); w0.w = pk2(o0b.z * inv0, o0b.w * inv0);
                w1.x = pk2(o1a.x * inv1, o1a.y * inv1); w1.y = pk2(o1a.z * inv1, o1a.w * inv1); w1.z = pk2(o1b.x * inv1, o1b.y * inv1); w1.w = pk2(o1b.z * inv1, o1b.w * inv1);
                st16_wt(wt_rsrc(OX), (unsigned)(tok0 * 1024 + h * 256 + 32 * p + 8 * fq) * 2u, w0);
                st16_wt(wt_rsrc(OX), (unsigned)((tok0 + 16) * 1024 + h * 256 + 32 * p + 8 * fq) * 2u, w1);
                asm volatile("" ::: "memory"); }
        }
    }
    __syncthreads();
}

__device__ __forceinline__ void phase_route_mfma(KArgs A, int wv_, int L, LAS unsigned char* lds) {
    const int tid = opaque_tid(wv_), wid = __builtin_amdgcn_readfirstlane(tid >> 6), lane = tid & 63, fr = lane & 15, fq = lane >> 4;
    unsigned char* ws = opq(A->ws);
    const float* RW = (const float*)(ws + WS_RW) + (size_t)L * NEXP * D;
    unsigned* cnt = (unsigned*)(ws + WS_CTL) + CW_CNT + L * 64;
    int* list = (int*)(ws + WS_LIST); int* te = (int*)(ws + WS_TOK); int* tp = te + 2 * T; float* tw = (float*)(tp + 2 * T);
    bf16* XN = (bf16*)(ws + WS_XN);
    constexpr int WSTR = 1040;
    LAS bf16* rwh = (LAS bf16*)lds;
    LAS bf16* rwl = rwh + 16 * WSTR;
    LAS float* xch = (LAS float*)(lds + 2 * 16 * WSTR * 2);
    LAS unsigned* lcnt = (LAS unsigned*)(lds + 2 * 16 * WSTR * 2 + 8 * 320 * 4);
    LAS unsigned* lbase = lcnt + 16;
    for (int e4 = tid; e4 < NEXP * D / 4; e4 += 512) {
        const f32x4 w = *(const f32x4*)(RW + 4 * e4);
        u32x2 h; h.x = pk2(w.x, w.y); h.y = pk2(w.z, w.w);
        u32x2 l; l.x = pk2(w.x - bflo(h.x), w.y - bfhi(h.x)); l.y = pk2(w.z - bflo(h.y), w.w - bfhi(h.y));
        const int e = (4 * e4) >> 10, k = (4 * e4) & 1023;
        *(LAS u32x2*)(rwh + e * WSTR + k) = h; *(LAS u32x2*)(rwl + e * WSTR + k) = l;
    }
    const int tg = wid >> 1, kh = wid & 1;
    const float rbv = A->in[I_RB][fr];
    for (int blk = blockIdx.x; blk < T / 64; blk += gridDim.x) {
        __syncthreads();
        if (tid < 16) lcnt[tid] = 0u;
        const size_t tok = (size_t)blk * 64 + 16 * tg + fr;
        const bf16* xrow = (const bf16*)(ws + WS_X16) + tok * D + 512 * kh + 8 * fq;
        f32x4 acc = (f32x4){0.f, 0.f, 0.f, 0.f}; float ssq = 0.f;
        bf16x8 ah[16];
#pragma unroll
        for (int s = 0; s < 16; ++s) ah[s] = *(const bf16x8*)(xrow + 32 * s);
#pragma unroll
        for (int s = 0; s < 16; ++s) {
            const u32x4 hw = __builtin_bit_cast(u32x4, ah[s]);
            const float x0 = bflo(hw.x), x1 = bfhi(hw.x), x2 = bflo(hw.y), x3 = bfhi(hw.y), x4 = bflo(hw.z), x5 = bfhi(hw.z), x6 = bflo(hw.w), x7 = bfhi(hw.w);
            ssq += ((x0 * x0 + x1 * x1) + (x2 * x2 + x3 * x3)) + ((x4 * x4 + x5 * x5) + (x6 * x6 + x7 * x7));
            const bf16x8 bh = *(const LAS bf16x8*)(rwh + fr * WSTR + 512 * kh + 32 * s + 8 * fq), bl = *(const LAS bf16x8*)(rwl + fr * WSTR + 512 * kh + 32 * s + 8 * fq);
            acc = __builtin_amdgcn_mfma_f32_16x16x32_bf16(ah[s], bh, acc, 0, 0, 0);
            acc = __builtin_amdgcn_mfma_f32_16x16x32_bf16(ah[s], bl, acc, 0, 0, 0);
        }
        ssq = xadd32(xadd16(ssq));
        LAS float* mine = xch + wid * 320; const LAS float* other = xch + (wid ^ 1) * 320;
#pragma unroll
        for (int r = 0; r < 4; ++r) mine[(4 * fq + r) * 20 + fr] = acc[r];
        if (fq == 0) mine[fr * 20 + 16] = ssq;
        __syncthreads();
        const float rstd = rsqrtf((ssq + other[fr * 20 + 16]) * (1.f / 1024.f) + EPS);
        {
            bf16* xo = XN + tok * D + 512 * kh + 8 * fq;
#pragma unroll
            for (int s = 0; s < 16; ++s) { const u32x4 hw = __builtin_bit_cast(u32x4, ah[s]);
                u32x4 o; o.x = pk2(bflo(hw.x) * rstd, bfhi(hw.x) * rstd); o.y = pk2(bflo(hw.y) * rstd, bfhi(hw.y) * rstd); o.z = pk2(bflo(hw.z) * rstd, bfhi(hw.z) * rstd); o.w = pk2(bflo(hw.w) * rstd, bfhi(hw.w) * rstd);
                *(u32x4*)(xo + 32 * s) = o; }
        }
        int e0r[4], e1r[4], r0r[4], r1r[4]; float w0r[4];
        if (kh == 0) {
#pragma unroll
            for (int r = 0; r < 4; ++r) {
                const float rs = __shfl(rstd, 4 * fq + r);
                const float lg = (acc[r] + other[(4 * fq + r) * 20 + fr]) * rs + rbv;
                float v0 = lg; v0 = fmaxf(v0, __shfl_xor(v0, 1)); v0 = fmaxf(v0, __shfl_xor(v0, 2)); v0 = fmaxf(v0, __shfl_xor(v0, 4)); v0 = fmaxf(v0, __shfl_xor(v0, 8));
                const unsigned long long bm0 = __ballot(lg == v0);
                const int e0 = __ffs((unsigned)(bm0 >> (16 * fq)) & 0xffffu) - 1;
                const bool c2 = (fr >> 2) == (e0 >> 2) && fr != e0;
                const float m2 = c2 ? lg : -INFINITY;
                float v1 = m2; v1 = fmaxf(v1, __shfl_xor(v1, 1)); v1 = fmaxf(v1, __shfl_xor(v1, 2)); v1 = fmaxf(v1, __shfl_xor(v1, 4)); v1 = fmaxf(v1, __shfl_xor(v1, 8));
                const unsigned long long bm1 = __ballot(c2 && m2 == v1);
                const int e1 = __ffs((unsigned)(bm1 >> (16 * fq)) & 0xffffu) - 1;
                e0r[r] = e0; e1r[r] = e1; w0r[r] = 1.f / (1.f + __expf(v1 - v0));
                r0r[r] = 0; r1r[r] = 0;
                if (fr == 0) { r0r[r] = (int)atomicAdd((unsigned*)(lcnt + e0), 1u); r1r[r] = (int)atomicAdd((unsigned*)(lcnt + e1), 1u); }
            }
        }
        __syncthreads();
        if (tid < 16) lbase[tid] = atomicAdd(&cnt[tid], lcnt[tid]);
        __syncthreads();
        if (kh == 0 && fr == 0) {
#pragma unroll
            for (int r = 0; r < 4; ++r) {
                const int t = blk * 64 + 16 * tg + 4 * fq + r;
                const int p0 = (int)lbase[e0r[r]] + r0r[r], p1 = (int)lbase[e1r[r]] + r1r[r];
                list[e0r[r] * T + p0] = t; list[e1r[r] * T + p1] = t;
                te[2 * t] = e0r[r]; te[2 * t + 1] = e1r[r]; tp[2 * t] = p0; tp[2 * t + 1] = p1; tw[2 * t] = w0r[r]; tw[2 * t + 1] = 1.f - w0r[r];
            }
        }
    }
    __syncthreads();
}

__device__ __forceinline__ void moe_offsets(KArgs A, int wv_, int L, LAS int* off, LAS int* cn) {
    const int t = opaque_tid(wv_);
    if (t < 64) {
        const unsigned* cnt = (const unsigned*)(opq(A->ws) + WS_CTL) + CW_CNT + L * 64;
        const int c = t < 16 ? (int)cnt[t] : 0;
        const int p = (c + 255) & ~255;
        int incl = p;
#pragma unroll
        for (int d = 1; d < 16; d <<= 1) { const int v = __shfl_up(incl, d); incl += (t & 15) >= d ? v : 0; }
        if (t < 16) { off[t] = incl - p; cn[t] = c; }
        if (t == 15) off[16] = incl;
    }
    __syncthreads();
}
__device__ __forceinline__ void phase_moe_combine(KArgs A, int wv_, int L, LAS unsigned char* lds) {
    LAS int* off = (LAS int*)lds; LAS int* cn = off + 32;
    moe_offsets(A, wv_, L, off, cn);
    const int tid_ = opaque_tid(wv_); const int wid = __builtin_amdgcn_readfirstlane(tid_ >> 6), lane = tid_ & 63; const int gw = blockIdx.x * 8 + wid, NGW = gridDim.x * 8;
    unsigned char* ws = opq(A->ws);
    const int* te = (const int*)(ws + WS_TOK); const int* tp = te + 2 * T; const float* tw = (const float*)(tp + 2 * T);
    const bf16* Y = (const bf16*)(ws + WS_Y); bf16* XN = (bf16*)(ws + WS_XN); bf16* X16 = (bf16*)(ws + WS_X16); const bool last = L == DEPTH - 1;
    const int nq = (T - gw + NGW - 1) / NGW;
    for (int q0 = 0; q0 < nq; q0 += 8) {
        int s0m = 0, s1m = 0; float w0m = 0.f, w1m = 0.f;
        { const int qq = q0 + (lane & 7); const int t = gw + NGW * (qq < nq ? qq : nq - 1);
          s0m = off[te[2 * t]] + tp[2 * t]; s1m = off[te[2 * t + 1]] + tp[2 * t + 1]; w0m = tw[2 * t]; w1m = tw[2 * t + 1]; }
        const int nn = nq - q0 < 8 ? nq - q0 : 8;
        f32x4 v[4]; u32x2 xv[4], xn[4], ya[4], yb[4], yan[4], ybn[4];
        { const int t = gw + NGW * q0; const int sl0 = __builtin_amdgcn_readlane(s0m, 0), sl1 = __builtin_amdgcn_readlane(s1m, 0);
#pragma unroll
          for (int j = 0; j < 4; ++j) { xv[j] = ((const u32x2*)(X16 + (size_t)t * D) + lane)[64 * j]; ya[j] = ((const u32x2*)(Y + (size_t)sl0 * D) + lane)[64 * j]; yb[j] = ((const u32x2*)(Y + (size_t)sl1 * D) + lane)[64 * j]; } }
#pragma unroll 1
        for (int q = 0; q < nn; ++q) {
            const int t = gw + NGW * (q0 + q);
            const int qn = q + 1 < nn ? q + 1 : q;
            { const int tn = gw + NGW * (q0 + qn); const int sl0 = __builtin_amdgcn_readlane(s0m, qn), sl1 = __builtin_amdgcn_readlane(s1m, qn);
#pragma unroll
              for (int j = 0; j < 4; ++j) { xn[j] = ((const u32x2*)(X16 + (size_t)tn * D) + lane)[64 * j]; yan[j] = ((const u32x2*)(Y + (size_t)sl0 * D) + lane)[64 * j]; ybn[j] = ((const u32x2*)(Y + (size_t)sl1 * D) + lane)[64 * j]; } }
            const float w0 = __builtin_bit_cast(float, __builtin_amdgcn_readlane(__builtin_bit_cast(int, w0m), q)), w1 = __builtin_bit_cast(float, __builtin_amdgcn_readlane(__builtin_bit_cast(int, w1m), q));
            float s = 0.f;
#pragma unroll
            for (int j = 0; j < 4; ++j) {
                v[j].x = bflo(xv[j].x) + w0 * bflo(ya[j].x) + w1 * bflo(yb[j].x); v[j].y = bfhi(xv[j].x) + w0 * bfhi(ya[j].x) + w1 * bfhi(yb[j].x); v[j].z = bflo(xv[j].y) + w0 * bflo(ya[j].y) + w1 * bflo(yb[j].y); v[j].w = bfhi(xv[j].y) + w0 * bfhi(ya[j].y) + w1 * bfhi(yb[j].y);
                s += (v[j].x * v[j].x + v[j].y * v[j].y) + (v[j].z * v[j].z + v[j].w * v[j].w);
            }
            const float rstd = rsqrtf(wave_sum(s) * (1.f / 1024.f) + EPS);
            u32x2* o8 = (u32x2*)(XN + (size_t)t * D) + lane;
            if (last) { f32x4* xr = (f32x4*)(A->out + (size_t)t * D) + lane;
#pragma unroll
                for (int j = 0; j < 4; ++j) xr[64 * j] = v[j]; }
            else { u32x2* xr = (u32x2*)(X16 + (size_t)t * D) + lane;
#pragma unroll
                for (int j = 0; j < 4; ++j) { u32x2 w; w.x = pk2(v[j].x, v[j].y); w.y = pk2(v[j].z, v[j].w); xr[64 * j] = w; } }
#pragma unroll
            for (int j = 0; j < 4; ++j) { u32x2 w; w.x = pk2(v[j].x * rstd, v[j].y * rstd); w.y = pk2(v[j].z * rstd, v[j].w * rstd); o8[64 * j] = w; }
#pragma unroll
            for (int j = 0; j < 4; ++j) { xv[j] = xn[j]; ya[j] = yan[j]; yb[j] = ybn[j]; }
        }
    }
}

constexpr int PH_PER_EVEN = 5 + 5, PH_PER_ODD = 3 + 5;
constexpr int NPHASES = 1 + 2 * (PH_PER_EVEN + PH_PER_ODD);

__global__ void __launch_bounds__(512, 2) mk_fwd(Args Araw) {
    KArgs A0 = kargs();
    extern __shared__ __attribute__((aligned(16))) unsigned char lds_raw[];
    LAS unsigned char* lds = (LAS unsigned char*)lds_raw;
    volatile LAS unsigned* misc = (volatile LAS unsigned*)(lds + LDS_MISC);
    const int tid = threadIdx.x;
    if (tid < 16) misc[tid] = 0u;
    __syncthreads();
    const int lo = A0->ph_lo, hi = A0->ph_hi;
    const int wv_ = __builtin_amdgcn_readfirstlane(threadIdx.x >> 6);
    if (hi - lo > 1) (void)xcd_barrier_post((unsigned*)(A0->ws + WS_CTL) + CW_BAR, misc);
    int ph = 0;
    unsigned long long tacc_ = 0;
#define PH_BEGIN(k) if (ph >= lo && ph < hi) { const bool tprobe_ = (PROBE_TMASK >> (k)) & 1; unsigned long long tp0_ = 0; if (PROBE_TMASK && tprobe_) tp0_ = __builtin_amdgcn_s_memrealtime(); KArgs A = kargs(); unsigned char* ws = opq(A->ws); _Pragma("unroll 1") for (int rep_ = 0; rep_ < (((PROBE_MASK >> (k)) & 1) ? PROBE_REPS : 1); ++rep_)
#define PH_END_(wb_)   if (ph + 1 < hi) { XcdBarrier b_; b_.bar = (unsigned*)(opq(kargs()->ws) + WS_CTL) + CW_BAR; b_.x = xb_xcc_id(); b_.st = misc; xcd_barrier(b_, opaque_tid(wv_) == 0, wb_); } if (PROBE_TMASK && tprobe_) tacc_ += __builtin_amdgcn_s_memrealtime() - tp0_; } ++ph;
#define PH_END PH_END_(true)
#define PH_END_WT PH_END_(false)
    const int G = gridDim.x, cb = blockIdx.x;

    PH_BEGIN(0) phase_prologue(A, wv_, lds); PH_END
    for (int L = 0; L < DEPTH; ++L) {
        const int i = L >> 1;
        if ((L & 1) == 0) {
            PH_BEGIN(3) {
                if (L == 0) {
                    pg8::DenseOrder S; S.init(NBATCH * NMEM, 8192, D, (const bf16*)(ws + WS_WKV), G, cb);
                    pg8::EpiBf16<0> E{(bf16*)(ws + WS_KV), 8192, 32, 0, nullptr, 0};
                    pg8::gemm_phase(lds, (const bf16*)(ws + WS_MN), D, S, E, wv_);
                }
                pg8::DenseOrder S; S.init(T, HYN, D, (const bf16*)(ws + WS_WHYB) + (size_t)i * HYN * D, G, cb);
                pg8::EpiBf16<0> E{(bf16*)(ws + WS_BIG), HYN, 12, 0, nullptr, 0};
                pg8::gemm_phase(lds, (const bf16*)(ws + WS_XN), D, S, E, wv_);
            } PH_END_WT
            PH_BEGIN(4) { const int t4_ = opaque_tid(wv_); SUBT_BEGIN(4); SUBT_END(4, ws, t4_); SUBT_BEGIN(5); phase_compress_mfma(A, wv_, i, lds); SUBT_END(5, ws, t4_); SUBT_BEGIN(6); phase_nsa_prep(A, wv_, i, lds); SUBT_END(6, ws, t4_); SUBT_BEGIN(7); phase_vtiles(A, wv_, lds); SUBT_END(7, ws, t4_); } PH_END
            PH_BEGIN(5) { phase_gla_a(A, wv_, i, lds); __syncthreads(); phase_nsa_attn_mfma(A, wv_, i, lds); } PH_END
            PH_BEGIN(6) phase_gla_c(A, wv_, i, lds, L == 0, L); PH_END
            PH_BEGIN(7) {
                pg8::DenseOrder S; S.init(T, D, D, (const bf16*)(ws + WS_WHOUT) + (size_t)i * D * D, G, cb);
                pg8::EpiResAddNorm E{(bf16*)(ws + WS_X16), D, (float*)(ws + WS_ROWSQ)};
                pg8::gemm_phase(lds, (const bf16*)(ws + WS_CAT), D, S, E, wv_);
            } PH_END_WT
        } else {
            PH_BEGIN(8) {
                pg8::DenseOrder S; S.init(T, 4096, D, (const bf16*)(ws + WS_WSGIN) + (size_t)i * 4096 * D, G, cb);
                pg8::EpiBf16<1> E{(bf16*)(ws + WS_U), 2048, 8, (size_t)(WS_V - WS_U) / 2, (float*)(ws + WS_VSTAT), 8};
                pg8::gemm_phase(lds, (const bf16*)(ws + WS_XN), D, S, E, wv_);
            } PH_END_WT
            PH_BEGIN(9) phase_sgu_mix_mfma(A, wv_, i, lds); PH_END
            PH_BEGIN(10) {
                pg8::DenseOrder S; S.init(T, D, 2048, (const bf16*)(ws + WS_WSGOUT) + (size_t)i * D * 2048, G, cb);
                pg8::EpiResAddNorm E{(bf16*)(ws + WS_X16), D, (float*)(ws + WS_ROWSQ)};
                pg8::gemm_phase(lds, (const bf16*)(ws + WS_UM), 2048, S, E, wv_);
            } PH_END_WT
        }
        PH_BEGIN(12) {
            pg8::DenseOrder S; S.init(T, D, D, (const bf16*)(ws + WS_WQ) + (size_t)L * D * D, G, cb);
            pg8::EpiBf16RowScale E{(bf16*)(ws + WS_QX), D, (const float*)(ws + WS_ROWSQ)};
            pg8::gemm_phase(lds, (const bf16*)(ws + WS_X16), D, S, E, wv_);
            asm volatile("s_waitcnt vmcnt(0)" ::: "memory");
            __syncthreads();
            pg8::Unit u_;
#pragma unroll 1
            for (int ui_ = 0; S.next(ui_, u_); ++ui_) xattn_item(A, wv_, L, lds, u_.pm >> 3, u_.pn, u_.pm & 7);
        } PH_END_WT
        PH_BEGIN(14) {
            pg8::DenseOrder S; S.init(T, D, D, (const bf16*)(ws + WS_WO) + (size_t)L * D * D, G, cb);
            pg8::EpiResAdd E{(bf16*)(ws + WS_X16), D};
            pg8::gemm_phase(lds, (const bf16*)(ws + WS_OX), D, S, E, wv_);
        } PH_END_WT
        PH_BEGIN(15) phase_route_mfma(A, wv_, L, lds); PH_END
        PH_BEGIN(16) {
            LAS int* off = (LAS int*)(lds + pg8::STAGE_BYTES); LAS int* cn = off + 32;
            moe_offsets(A, wv_, L, off, cn);
            unsigned* rdy = (unsigned*)(ws + WS_CTL) + CW_RDY + L * 256;
            {
                pg8::MoeOrder<true, 1> S{(off[16] / 256) * 3, 3, G, cb, D, off, cn, (const int*)(ws + WS_LIST), (const char*)(ws + WS_WMIN) + (size_t)L * 16 * 768 * D * 2, (size_t)768 * D * 2, rdy, 3u};
                pg8::EpiSwiglu<true> E{(bf16*)(ws + WS_H), DEXP, (unsigned)(WS_H_BYTES)};
                pg8::gemm_phase(lds, (const bf16*)(ws + WS_XN), D, S, E, wv_);
            }
            {
                pg8::MoeOrder<false, 2> S{(off[16] / 256) * 4, 4, G, G - 1 - cb, DEXP, off, cn, (const int*)(ws + WS_LIST), (const char*)(ws + WS_WMOUT) + (size_t)L * 16 * D * DEXP * 2, (size_t)D * DEXP * 2, rdy, 3u};
                pg8::EpiBf16<0> E{(bf16*)(ws + WS_Y), D, 4, 0, nullptr, 0};
                pg8::gemm_phase(lds, (const bf16*)(ws + WS_H), DEXP, S, E, wv_);
            }
        } PH_END_WT
        PH_BEGIN(18) phase_moe_combine(A, wv_, L, lds); PH_END
    }
#undef PH_BEGIN
#undef PH_END
#undef PH_END_
#undef PH_END_WT
    if (hi - lo > 1) { for (int q_ = 0; q_ < PROBE_XBAR; ++q_) { XcdBarrier b_; b_.bar = (unsigned*)(opq(kargs()->ws) + WS_CTL) + CW_BAR; b_.x = xb_xcc_id(); b_.st = misc; xcd_barrier(b_, opaque_tid(wv_) == 0); } }
    if ((PROBE_NSA || PROBE_SUB) && blockIdx.x == 0) { const unsigned long long d_ = __hip_atomic_load((unsigned long long*)(A0->ws + WS_CTL + 48000), __ATOMIC_RELAXED, __HIP_MEMORY_SCOPE_AGENT); const unsigned long long t0 = __builtin_amdgcn_s_memrealtime(); while (__builtin_amdgcn_s_memrealtime() - t0 < d_) __builtin_amdgcn_s_sleep(8); }
    if (PROBE_TMASK && blockIdx.x == 0) { const unsigned long long t0 = __builtin_amdgcn_s_memrealtime(); while (__builtin_amdgcn_s_memrealtime() - t0 < tacc_) __builtin_amdgcn_s_sleep(8); }
}

extern "C" void kernel_launch(void* const* d_in, const int* in_sizes, int n_in, void* d_out, int out_size, void* d_ws, size_t ws_size, hipStream_t stream) {
    static int grid = 0;
    if (grid == 0) {
        if (n_in != N_IN || out_size != T * D || ws_size < WS_END) { fprintf(stderr, "kernel_launch: unexpected problem (n_in %d, out %d, ws %zu)\n", n_in, out_size, ws_size); grid = -1; return; }
        int dev = 0, cus = 0, per_cu = 0;
        if (hipGetDevice(&dev) != hipSuccess || hipDeviceGetAttribute(&cus, hipDeviceAttributeMultiprocessorCount, dev) != hipSuccess) { grid = -1; return; }
        if (hipFuncSetAttribute((const void*)mk_fwd, hipFuncAttributeMaxDynamicSharedMemorySize, LDS_BYTES) != hipSuccess) { fprintf(stderr, "kernel_launch: hipFuncSetAttribute failed\n"); grid = -1; return; }
        if (hipOccupancyMaxActiveBlocksPerMultiprocessor(&per_cu, (const void*)mk_fwd, 512, LDS_BYTES) != hipSuccess || per_cu < 1) fprintf(stderr, "kernel_launch: occupancy query says %d\n", per_cu);
        (void)hipGetLastError();
        grid = cus;
    }
    if (grid < 0) return;
    (void)hipMemsetAsync((char*)d_ws + WS_CTL, 0, CTL_BYTES, stream);
    Args a{};
    for (int i = 0; i < N_IN; ++i) a.in[i] = (const float*)d_in[i];
    a.out = (float*)d_out; a.ws = (unsigned char*)d_ws;
    for (int j = 0; j < 32; ++j) a.freq[j] = (float)pow(10000.0, -(double)j / 32.0);
#if MK_ONE_LAUNCH
    a.ph_lo = 0; a.ph_hi = NPHASES;
    hipLaunchKernelGGL(mk_fwd, dim3(grid), dim3(512), LDS_BYTES, stream, a);
#else
    for (int p = 0; p < NPHASES; ++p) { a.ph_lo = p; a.ph_hi = p + 1; hipLaunchKernelGGL(mk_fwd, dim3(grid), dim3(512), LDS_BYTES, stream, a); }
#endif
}
```

```cpp
#include <hip/hip_runtime.h>
#include <stdint.h>
#include <stdio.h>
#include <math.h>

#ifndef PROBE_MASK
#define PROBE_MASK 0
#endif
#ifndef PROBE_TMASK
#define PROBE_TMASK 0
#endif
#ifndef PROBE_NSA
#define PROBE_NSA 0
#endif
#ifndef PROBE_SUB
#define PROBE_SUB 0
#endif
#ifndef PROBE_XBAR
#define PROBE_XBAR 0
#endif
#ifndef PROBE_NSAX
#define PROBE_NSAX 0
#endif
#ifndef PROBE_REPS
#define PROBE_REPS 2
#endif
#ifndef MK_ONE_LAUNCH
#define MK_ONE_LAUNCH 1
#endif

#define LAS __attribute__((address_space(3)))
typedef unsigned short bf16;
typedef short bf16x8 __attribute__((ext_vector_type(8)));
typedef float f32x4 __attribute__((ext_vector_type(4)));
typedef float f32x2 __attribute__((ext_vector_type(2)));
typedef unsigned u32x4 __attribute__((ext_vector_type(4)));
typedef unsigned u32x2 __attribute__((ext_vector_type(2)));

constexpr int T = 16384, D = 1024, NBATCH = 8, S = 2048, DEPTH = 4;
constexpr int NMEM = 256;
constexpr float EPS = 1e-6f;
constexpr int HYN = 3072, HYSRC = 2856;
constexpr int C_QA = 0, C_KC = 512, C_VC = 640, C_KS = 768, C_VS = 896, C_KW = 1024, C_VW = 1152, C_QB = 1280, C_KB = 1536, C_VB = 1792, C_RB = 2304, C_GA = 2816, C_AL = 2840;
constexpr int NCMP = 127;
constexpr int NEXP = 16, DEXP = 384;
constexpr int SLOTS = 2 * T + NEXP * 256;

enum { I_X = 0, I_MEM, I_POS, I_NMIX, I_NXAT, I_NMEM, I_NFFN, I_HYBIN, I_HYBOUT, I_QNORM, I_KNORM, I_CMPPE, I_CMPW1, I_CMPW2, I_GATEB, I_WA2, I_BA, I_ONORM,
       I_SGIN, I_LNG, I_LNB, I_SGWS, I_SGBS, I_SGOUT, I_XWQ, I_XWKV, I_XWO, I_XQN, I_XKN, I_RW, I_RB, I_MOEIN, I_MOEOUT, N_IN };

constexpr size_t MiB = 1u << 20;
constexpr size_t WS_CTL = 0, CTL_BYTES = 1 * MiB;
constexpr size_t WS_WHYB = 1 * MiB;
constexpr size_t WS_WHOUT = WS_WHYB + 12 * MiB;
constexpr size_t WS_WSGIN = WS_WHOUT + 4 * MiB;
constexpr size_t WS_WSGOUT = WS_WSGIN + 16 * MiB;
constexpr size_t WS_WQ = WS_WSGOUT + 8 * MiB;
constexpr size_t WS_WKV = WS_WQ + 8 * MiB;
constexpr size_t WS_WO = WS_WKV + 16 * MiB;
constexpr size_t WS_WMIN = WS_WO + 8 * MiB;
constexpr size_t WS_WMOUT = WS_WMIN + 96 * MiB;
constexpr size_t WS_RW = WS_WMOUT + 48 * MiB;
constexpr size_t WS_XN = WS_RW + 1 * MiB;
constexpr size_t WS_BIG = WS_XN + 32 * MiB;
constexpr size_t WS_QA = WS_BIG + 128 * MiB;
constexpr size_t WS_KS = WS_QA + 16 * MiB;
constexpr size_t WS_KW = WS_KS + 4 * MiB;
constexpr size_t WS_KC = WS_KW + 4 * MiB;
constexpr size_t WS_VC = WS_KC + 1 * MiB;
constexpr size_t WS_CAT = WS_VC + 1 * MiB;
constexpr size_t WS_QX = WS_CAT + 32 * MiB;
constexpr size_t WS_OX = WS_QX + 32 * MiB;
constexpr size_t WS_MN = WS_OX + 32 * MiB;
constexpr size_t WS_KV = WS_MN + 4 * MiB;
constexpr size_t WS_COS = WS_KV + 32 * MiB;
constexpr size_t WS_SIN = WS_COS + 2 * MiB;
constexpr size_t WS_LIST = WS_SIN + 2 * MiB;
constexpr size_t WS_TOK = WS_LIST + 1 * MiB;
constexpr size_t WS_VT = WS_TOK + 1 * MiB;
constexpr size_t WS_VTA = WS_VT + 16 * MiB;
constexpr size_t WS_SLOC = WS_VTA + 32 * MiB;
constexpr size_t WS_DEC = WS_SLOC + 32 * MiB;
constexpr size_t WS_STT = WS_DEC + 1 * MiB;
constexpr size_t WS_WSB = WS_STT + 16 * MiB;
constexpr size_t WS_M0 = WS_WSB + 768 * 1024;
constexpr size_t WS_W1T = WS_WSB + 1 * MiB;
constexpr size_t WS_ROWSQ = WS_W1T + 1 * MiB;
constexpr size_t WS_VSTAT = WS_ROWSQ + 1 * MiB;
constexpr size_t WS_X16 = WS_VSTAT + 4 * MiB;
constexpr size_t WS_END = WS_X16 + 32 * MiB;
constexpr size_t WS_H_BYTES = (size_t)36864 * 384 * 2;
constexpr size_t WS_Y = WS_BIG, WS_H = WS_BIG + 72 * MiB, WS_U = WS_BIG, WS_V = WS_BIG + 64 * MiB, WS_UM = WS_QX;
constexpr int CW_BAR = 4096;
constexpr int CW_RDY = 16384;
constexpr int CW_CNT = 8192;

constexpr int LDS_BYTES = 159744;
constexpr int LDS_MISC = LDS_BYTES - 64;

typedef __bf16 bf16x2_t __attribute__((ext_vector_type(2)));
__device__ __forceinline__ unsigned pk2(float lo, float hi) { const f32x2 v = {lo, hi}; return __builtin_bit_cast(unsigned, __builtin_convertvector(v, bf16x2_t)); }
__device__ __forceinline__ unsigned f2bf(float f) { return (unsigned)__builtin_bit_cast(unsigned short, (__bf16)f); }
__device__ __forceinline__ float bf2f(unsigned b) { return __uint_as_float(b << 16); }
__device__ __forceinline__ float bflo(unsigned w) { return __uint_as_float(w << 16); }
__device__ __forceinline__ float bfhi(unsigned w) { return __uint_as_float(w & 0xffff0000u); }
__device__ __forceinline__ void xswap16(float v, float& a, float& b) { unsigned u = __builtin_bit_cast(unsigned, v), u2 = u; asm volatile("" : "+v"(u2));
    const u32x2 r = __builtin_amdgcn_permlane16_swap(u, u2, false, false); unsigned r0 = r[0], r1 = r[1]; asm volatile("" : "+v"(r0), "+v"(r1)); a = __builtin_bit_cast(float, r0); b = __builtin_bit_cast(float, r1); }
__device__ __forceinline__ void xswap32(float v, float& a, float& b) { unsigned u = __builtin_bit_cast(unsigned, v), u2 = u; asm volatile("" : "+v"(u2));
    const u32x2 r = __builtin_amdgcn_permlane32_swap(u, u2, false, false); unsigned r0 = r[0], r1 = r[1]; asm volatile("" : "+v"(r0), "+v"(r1)); a = __builtin_bit_cast(float, r0); b = __builtin_bit_cast(float, r1); }
__device__ __forceinline__ float xadd16(float v) { float a, b; xswap16(v, a, b); return a + b; }
__device__ __forceinline__ float xadd32(float v) { float a, b; xswap32(v, a, b); return a + b; }
__device__ __forceinline__ float xmax16(float v) { float a, b; xswap16(v, a, b); return fmaxf(a, b); }
__device__ __forceinline__ float xmax32(float v) { float a, b; xswap32(v, a, b); return fmaxf(a, b); }
__device__ __forceinline__ float wave_sum(float v) {
#pragma unroll
    for (int o = 1; o < 16; o <<= 1) v += __shfl_xor(v, o);
    return xadd32(xadd16(v));
}
__device__ __forceinline__ float wave_max(float v) {
#pragma unroll
    for (int o = 1; o < 16; o <<= 1) v = fmaxf(v, __shfl_xor(v, o));
    return xmax32(xmax16(v));
}
__device__ __forceinline__ int opaque_tid(int wv) { int l; asm volatile("v_mbcnt_lo_u32_b32 %0, -1, 0\n\tv_mbcnt_hi_u32_b32 %0, -1, %0" : "=v"(l)); return wv * 64 + l; }
__device__ __forceinline__ unsigned char* opq(unsigned char* p) { asm volatile("" : "+s"(p)); return p; }
#define LDS_WAIT() asm volatile("s_waitcnt lgkmcnt(0)" ::: "memory")
__device__ __forceinline__ float gelu_tanh(float x) {
    const float u2 = x * (1.5957691216057308f + 0.07135481283f * x * x);
    return x * __builtin_amdgcn_rcpf(1.0f + __expf(-u2));
}
__device__ __forceinline__ float sigmoidf_(float x) { return __builtin_amdgcn_rcpf(1.0f + __expf(-x)); }

#define SUBT_BEGIN(id) unsigned long long subt_##id = 0; if (PROBE_SUB == (id)) subt_##id = __builtin_amdgcn_s_memrealtime();
#define SUBT_END(id, wsp, tidv) do { if (PROBE_SUB == (id) && blockIdx.x == 0 && (tidv) == 0) atomicAdd((unsigned long long*)((wsp) + WS_CTL + 48000), __builtin_amdgcn_s_memrealtime() - subt_##id); } while (0)
#define XB_TMO      128
#define XB_XCNT(j)  (256  + 64 * (j))
#define XB_XSUB(j)  (1280 + 64 * (j))
#define XB_XGEN(j)  (2304 + 64 * (j))
#define XB_TOP      3328
#define XB_TOPGEN   3392
#define XCD_BAR_WORDS 3456
#define XB_SPIN_CAP (1u << 22)

__device__ __forceinline__ unsigned xb_ld(unsigned* p)              { return __hip_atomic_load(p, __ATOMIC_RELAXED, __HIP_MEMORY_SCOPE_AGENT); }
__device__ __forceinline__ unsigned xb_add(unsigned* p, unsigned v) { return __hip_atomic_fetch_add(p, v, __ATOMIC_RELAXED, __HIP_MEMORY_SCOPE_AGENT); }
__device__ __forceinline__ unsigned xb_xcc_id() { return (unsigned)__builtin_amdgcn_s_getreg((3 << 11) | 20) & 0xFu; }
#define XB_SPIN(cond, bar) do { unsigned _sp = 0; while (cond) { __builtin_amdgcn_s_sleep(1); \
    if ((++_sp & 255u) == 0u) { if (xb_ld(&(bar)[XB_TMO])) break; if (_sp > XB_SPIN_CAP) { atomicAdd(&(bar)[XB_TMO], 1u); break; } } } } while (0)

struct XcdBarrier { unsigned* bar; unsigned x; volatile LAS unsigned* st; };
__device__ __forceinline__ unsigned* xb_opaque(unsigned* p) { unsigned long long v = (unsigned long long)p; unsigned lo = __builtin_amdgcn_readfirstlane((unsigned)v), hi = __builtin_amdgcn_readfirstlane((unsigned)(v >> 32));
    asm volatile("" : "+s"(lo), "+s"(hi)); return (unsigned*)(((unsigned long long)hi << 32) | lo); }

__device__ __forceinline__ XcdBarrier xcd_barrier_post(unsigned* bar, volatile LAS unsigned* st) {
    XcdBarrier b; b.bar = bar; b.x = xb_xcc_id(); b.st = st;
    if (threadIdx.x == 0) (void)xb_add(&bar[XB_XCNT(b.x)], 1u);
    return b;
}
__device__ __forceinline__ void xcd_barrier_complete(unsigned* bar, unsigned x, unsigned& nloc, unsigned& nx) {
    const unsigned G = gridDim.x * gridDim.y * gridDim.z;
    unsigned sum, cnt, mine, sp = 0u;
    for (;;) {
        sum = 0u; cnt = 0u; mine = 0u;
#pragma unroll
        for (unsigned j = 0; j < 16; ++j) { const unsigned c = xb_ld(&bar[XB_XCNT(j)]); sum += c; cnt += (c > 0u) ? 1u : 0u; mine = (j == x) ? c : mine; }
        if (sum == G) break;
        __builtin_amdgcn_s_sleep(1);
        if ((++sp & 255u) == 0u) { if (xb_ld(&bar[XB_TMO])) break; if (sp > XB_SPIN_CAP) { atomicAdd(&bar[XB_TMO], 1u); break; } }
    }
    nloc = mine > 0u ? mine : 1u; nx = cnt > 0u ? cnt : 1u;
}
__device__ __forceinline__ void xcd_barrier(const XcdBarrier& b, const bool is_t0, const bool wb = true) {
    asm volatile("s_waitcnt vmcnt(0)" ::: "memory");
    __syncthreads();
    if (is_t0) {
        unsigned* bar = b.bar;
        __builtin_amdgcn_s_waitcnt(0);
        asm volatile("buffer_inv sc1" ::: "memory");
        unsigned nloc = b.st[0], nx = b.st[1];
        if (nloc == 0u) { xcd_barrier_complete(bar, b.x, nloc, nx); b.st[0] = nloc; b.st[1] = nx; }
        const unsigned old = xb_add(&bar[XB_XSUB(b.x)], 1u);
        const unsigned gen = old / nloc;
        if (old + 1u == (gen + 1u) * nloc) {
            if (wb) __builtin_amdgcn_fence(__ATOMIC_RELEASE, "agent");
            asm volatile("s_waitcnt vmcnt(0)" ::: "memory");
            const unsigned og = xb_add(&bar[XB_TOP], 1u);
            const unsigned tg = og / nx;
            if (og + 1u == (tg + 1u) * nx) xb_add(&bar[XB_TOPGEN], 1u);
            else XB_SPIN(xb_ld(&bar[XB_TOPGEN]) == tg, bar);
            asm volatile("" ::: "memory");
            xb_add(&bar[XB_XGEN(b.x)], 1u);
            asm volatile("s_waitcnt vmcnt(0)" ::: "memory");
        } else {
            XB_SPIN(xb_ld(&bar[XB_XGEN(b.x)]) == gen, bar);
            asm volatile("s_waitcnt vmcnt(0)" ::: "memory");
        }
    }
    __syncthreads();
}

struct Args {
    const float* in[N_IN];
    float* out;
    unsigned char* ws;
    float freq[32];
    int ph_lo, ph_hi;
};

typedef const __attribute__((address_space(4))) Args* KArgs;
__device__ __forceinline__ KArgs kargs() { KArgs p = (KArgs)__builtin_amdgcn_kernarg_segment_ptr(); asm volatile("" : "+s"(p)); return p; }

__device__ __forceinline__ void st_bf16x4(bf16* p, f32x4 v) { u32x2 w; w.x = pk2(v[0], v[1]); w.y = pk2(v[2], v[3]); *(u32x2*)p = w; }


__device__ __forceinline__ __amdgpu_buffer_rsrc_t wt_rsrc(const void* base) { return __builtin_amdgcn_make_buffer_rsrc((void*)base, 0, 0x7FFFFFFF, 0x00020000); }
__device__ __forceinline__ void st16_wt(__amdgpu_buffer_rsrc_t r, unsigned byte_off, u32x4 v) { __builtin_amdgcn_raw_buffer_store_b128(v, r, byte_off, 0, 16); }

namespace pg8 {
constexpr int BM = 256, BK = 64, HALF = 128, HTB = HALF * BK * 2, STAGE_BYTES = 8 * HTB, NXCD = 8, WGM = 8;
__host__ __device__ __forceinline__ int lds_byte(int r, int c) { const int st = (r >> 4) * 2 + (c >> 5), rr = r & 15, cc = c & 31, ob = rr * 64 + cc * 2; return st * 1024 + (ob ^ (((ob >> 9) & 1) << 5)); }
__host__ __device__ __forceinline__ void stage_rc(int b, int& R, int& C) { const int st = b / 1024, sb = b % 1024, swz = sb ^ (((sb >> 9) & 1) << 5); R = (st >> 1) * 16 + swz / 64; C = (st & 1) * 32 + (swz % 64) / 2; }
__host__ __device__ __forceinline__ int perm32(int rho) { const int n = rho >> 4, i = rho & 15; return 8 * (i >> 2) + 4 * n + (i & 3); }
struct Unit { int pm, pn, e; };
struct DenseOrder {
    static constexpr bool GATHER = false; static constexpr int SYNC = 0;
    int nM, nN, nwg, G, c, K; const char* Bt;
    __device__ __forceinline__ void init(int M, int N, int K_, const bf16* Bt_, int G_, int c_) { nM = M / BM; nN = N / BM; nwg = nM * nN; G = G_; c = c_; K = K_; Bt = (const char*)Bt_; }
    __device__ __forceinline__ bool next(int i, Unit& u) const {
        const long L = (long)i * G + c; if (L >= nwg) return false;
        int wgid = (int)L; { const int q = nwg / NXCD, r = nwg % NXCD, xcd = wgid % NXCD, off = wgid / NXCD; wgid = (xcd < r ? xcd * (q + 1) : r * (q + 1) + (xcd - r) * q) + off; }
        const int nig = WGM * nN, gid = wgid / nig, fm = gid * WGM, gsz = (nM - fm) < WGM ? (nM - fm) : WGM;
        u.pm = fm + ((wgid % nig) % gsz); u.pn = (wgid % nig) / gsz; u.e = 0; return true;
    }
    __device__ __forceinline__ unsigned a_voff(const Unit& u, int half, int R) const { return (unsigned)((u.pm * BM + half * HALF + R) * K) * 2u; }
    __device__ __forceinline__ const char* b_tile(const Unit& u) const { return Bt + (size_t)u.pn * BM * K * 2; }
};
template <bool GATH, int SYNC_> struct MoeOrder {
    static constexpr bool GATHER = GATH; static constexpr int SYNC = SYNC_;
    int nunits, ntn, G, c, K; const LAS int* off; const LAS int* cn; const int* list; const char* Bt; size_t estride; unsigned* rdy; unsigned need;
    __device__ __forceinline__ void wait(const Unit& u) const {
        unsigned* p = rdy + u.pm; unsigned sp = 0u;
        while (xb_ld(p) < need) { __builtin_amdgcn_s_sleep(1); if (++sp > XB_SPIN_CAP) break; }
        __builtin_amdgcn_fence(__ATOMIC_ACQUIRE, "agent");
        asm volatile("s_waitcnt vmcnt(0)" ::: "memory");
    }
    __device__ __forceinline__ void signal(const Unit& u) const { (void)xb_add(rdy + u.pm, 1u); }
    __device__ __forceinline__ bool next(int i, Unit& u) const {
        const int L = i * G + c; if (L >= nunits) return false;
        u.pm = L / ntn; u.pn = L % ntn; const int s0 = u.pm * BM; int e = 0;
#pragma unroll
        for (int q = 1; q < 16; ++q) e += (s0 >= off[q]) ? 1 : 0;
        u.e = e; return true;
    }
    __device__ __forceinline__ unsigned a_voff(const Unit& u, int half, int R) const {
        const int slot = u.pm * BM + half * HALF + R;
        const int loc = slot - off[u.e]; const int tk = list[u.e * T + (loc < cn[u.e] ? loc : 0)];
        return (unsigned)(tk * K) * 2u;
    }
    __device__ __forceinline__ const char* b_tile(const Unit& u) const { return Bt + (size_t)u.e * estride + (size_t)u.pn * BM * K * 2; }
};
__device__ __forceinline__ unsigned cvt_pk_bf16(float lo, float hi) { return pk2(lo, hi); }

template <class Epi, class Sched>
__device__ __forceinline__ void gemm_phase(LAS unsigned char* lds, const bf16* Aptr, int K, const Sched& S, const Epi& E, int wv_) {
    const int tid = opaque_tid(wv_), wid = __builtin_amdgcn_readfirstlane(tid >> 6), lane = tid & 63, wr = wid >> 2, wc = wid & 3, fr = lane & 15, fq = lane >> 4;
    const int nt = K / BK;
    int Rr[2], Cc[2]; unsigned voffA[2], voffB[2];
#pragma unroll
    for (int i = 0; i < 2; ++i) { stage_rc(tid * 16 + i * 8192, Rr[i], Cc[i]); const int Rb = Epi::PERM ? ((Rr[i] & ~31) + perm32(Rr[i] & 31)) : Rr[i];
        voffA[i] = (unsigned)(Rr[i] * K + Cc[i]) * 2u; voffB[i] = (unsigned)(Rb * K + Cc[i]) * 2u; }
    const size_t kstep = (size_t)(BK * 2);
    const size_t hstep = (size_t)HALF * K * 2;
    const size_t tstep = 2 * hstep;
    const unsigned ldsw = (unsigned)wid * 1024u;
    const int aoff = lds_byte(wr * 64 + fr, fq * 8), boff = lds_byte(wc * 32 + fr, fq * 8);
    const char* const Ab = (const char*)Aptr;
#define PG8_SA(b, h) (((b) * 2 + (h)) * HTB)
#define PG8_SB(b, h) ((4 + (b) * 2 + (h)) * HTB)
#define PG8_STAGE(bufoff, gbase, voff) do { _Pragma("unroll") for (int _i = 0; _i < 2; ++_i) \
        __builtin_amdgcn_global_load_lds((const unsigned*)((const char*)(gbase) + (voff)[_i]), (LAS unsigned*)(lds + (bufoff) + ldsw + _i * 8192), 16, 0, 0); } while (0)
#define PG8_STAGE_A(bufoff, usenext, h, kofs) do { \
        if constexpr (Sched::GATHER) { const char* gb_ = Ab + (kofs); unsigned vv_[2] = {(usenext) ? vN[h][0] : vA[h][0], (usenext) ? vN[h][1] : vA[h][1]}; PG8_STAGE(bufoff, gb_, vv_); } \
        else { const char* gb_ = ((usenext) ? nA : cA) + (size_t)(h) * hstep + (kofs); PG8_STAGE(bufoff, gb_, voffA); } } while (0)
#define PG8_LDA(dst, b, h) do { _Pragma("unroll") for (int m = 0; m < 4; ++m) _Pragma("unroll") for (int k = 0; k < 2; ++k) dst[m][k] = *(const LAS bf16x8*)(lds + PG8_SA(b, h) + aoff + m * 2048 + k * 1024); } while (0)
#define PG8_LDB(dst, b, h) do { _Pragma("unroll") for (int n = 0; n < 2; ++n) _Pragma("unroll") for (int k = 0; k < 2; ++k) dst[n][k] = *(const LAS bf16x8*)(lds + PG8_SB(b, h) + boff + n * 2048 + k * 1024); } while (0)
#define PG8_MMA(ai, bj, At, Bt) do { __builtin_amdgcn_s_setprio(1); _Pragma("unroll") for (int m = 0; m < 4; ++m) _Pragma("unroll") for (int n = 0; n < 2; ++n) _Pragma("unroll") for (int k = 0; k < 2; ++k) \
        acc[ai][bj][m][n] = __builtin_amdgcn_mfma_f32_16x16x32_bf16(Bt[n][k], At[m][k], acc[ai][bj][m][n], 0, 0, 0); __builtin_amdgcn_s_setprio(0); } while (0)
#define PG8_WAIT_V(n) asm volatile("s_waitcnt vmcnt(" #n ")" ::: "memory")
#define PG8_WAIT_L(n) asm volatile("s_waitcnt lgkmcnt(" #n ")" ::: "memory")
#define PG8_BAR __builtin_amdgcn_s_barrier()
#define PG8_SCHED __builtin_amdgcn_sched_barrier(0)
    Unit cur, nxt; int ui = 0;
    if (!S.next(0, cur)) return;
    if constexpr (Sched::SYNC == 2) { if (wid == 0) S.wait(cur); __syncthreads(); }
    f32x4 acc[2][2][4][2];
#pragma unroll
    for (int a = 0; a < 2; ++a)
#pragma unroll
        for (int b = 0; b < 2; ++b)
#pragma unroll
            for (int m = 0; m < 4; ++m)
#pragma unroll
                for (int n = 0; n < 2; ++n) acc[a][b][m][n] = (f32x4){0.f, 0.f, 0.f, 0.f};
    bf16x8 At[4][2], B0[2][2], B1[2][2];
    unsigned vA[2][2], vN[2][2];
    const char* cA = Ab; const char* nA = Ab;
    if constexpr (Sched::GATHER) {
#pragma unroll
        for (int h = 0; h < 2; ++h)
#pragma unroll
            for (int i = 0; i < 2; ++i) { vA[h][i] = S.a_voff(cur, h, Rr[i]) + (unsigned)Cc[i] * 2u; vN[h][i] = vA[h][i]; }
    } else { cA = Ab + (size_t)cur.pm * tstep; nA = cA; }
    const char* cB = S.b_tile(cur);
    PG8_STAGE(PG8_SB(0, 0), cB, voffB); PG8_STAGE_A(PG8_SA(0, 0), false, 0, 0); PG8_STAGE(PG8_SB(0, 1), cB + hstep, voffB); PG8_STAGE_A(PG8_SA(0, 1), false, 1, 0);
    if (wr == 1) PG8_BAR;
    PG8_WAIT_V(4); PG8_BAR;
    PG8_STAGE(PG8_SB(1, 0), cB + kstep, voffB); PG8_STAGE_A(PG8_SA(1, 0), false, 0, kstep); PG8_STAGE(PG8_SB(1, 1), cB + hstep + kstep, voffB);
    PG8_WAIT_V(6); PG8_BAR;
    for (;;) {
        const bool has_next = S.next(ui + 1, nxt);
        if constexpr (Sched::SYNC == 2) { if (has_next && wid == 0) S.wait(nxt); }
        const char* nB = has_next ? S.b_tile(nxt) : cB;
        if constexpr (Sched::GATHER) {
#pragma unroll
            for (int h = 0; h < 2; ++h)
#pragma unroll
                for (int i = 0; i < 2; ++i) vN[h][i] = has_next ? S.a_voff(nxt, h, Rr[i]) + (unsigned)Cc[i] * 2u : vA[h][i];
        } else nA = has_next ? Ab + (size_t)nxt.pm * tstep : cA;
        for (int t = 0; t < nt; t += 2) {
            const bool last = (t == nt - 2);
            const size_t k1 = (size_t)(t + 1) * kstep, k2 = last ? 0 : (size_t)(t + 2) * kstep, k3 = k2 + kstep;
            const char* b2 = last ? nB : cB + (size_t)(t + 2) * kstep; const char* b3 = b2 + kstep;
            PG8_LDB(B0, 0, 0); PG8_SCHED; PG8_LDA(At, 0, 0); PG8_STAGE_A(PG8_SA(1, 1), false, 1, k1);
            PG8_WAIT_L(8); PG8_BAR; PG8_WAIT_L(0); PG8_MMA(0, 0, At, B0); PG8_BAR; PG8_SCHED;
            PG8_LDB(B1, 0, 1); PG8_STAGE(PG8_SB(0, 0), b2, voffB);
            PG8_BAR; PG8_WAIT_L(0); PG8_MMA(0, 1, At, B1); PG8_BAR;
            PG8_LDA(At, 0, 1); PG8_STAGE_A(PG8_SA(0, 0), last, 0, k2);
            PG8_BAR; PG8_WAIT_L(0); PG8_MMA(1, 0, At, B0); PG8_BAR; PG8_SCHED;
            PG8_STAGE(PG8_SB(0, 1), b2 + hstep, voffB);
            PG8_WAIT_V(6); PG8_BAR; PG8_MMA(1, 1, At, B1); PG8_BAR;
            PG8_LDB(B0, 1, 0); PG8_SCHED; PG8_LDA(At, 1, 0); PG8_STAGE_A(PG8_SA(0, 1), last, 1, k2);
            PG8_WAIT_L(8); PG8_BAR; PG8_WAIT_L(0); PG8_MMA(0, 0, At, B0); PG8_BAR; PG8_SCHED;
            PG8_LDB(B1, 1, 1); PG8_STAGE(PG8_SB(1, 0), b3, voffB);
            PG8_BAR; PG8_WAIT_L(0); PG8_MMA(0, 1, At, B1); PG8_BAR;
            PG8_LDA(At, 1, 1); PG8_STAGE_A(PG8_SA(1, 0), last, 0, k3);
            PG8_BAR; PG8_WAIT_L(0); PG8_MMA(1, 0, At, B0); PG8_BAR; PG8_SCHED;
            PG8_STAGE(PG8_SB(1, 1), b3 + hstep, voffB);
            PG8_WAIT_V(6); PG8_BAR; PG8_MMA(1, 1, At, B1); PG8_BAR;
        }
        E(acc, cur, wr, wc, fr, fq);
        if constexpr (Sched::SYNC == 1) {
            PG8_WAIT_V(0); PG8_BAR; PG8_BAR;
            if (tid == 0) S.signal(cur);
        }
        if (!has_next) break;
#pragma unroll
        for (int a = 0; a < 2; ++a)
#pragma unroll
            for (int b = 0; b < 2; ++b)
#pragma unroll
                for (int m = 0; m < 4; ++m)
#pragma unroll
                    for (int n = 0; n < 2; ++n) acc[a][b][m][n] = (f32x4){0.f, 0.f, 0.f, 0.f};
        cur = nxt; cB = nB; cA = nA; ++ui;
        if constexpr (Sched::GATHER) {
#pragma unroll
            for (int h = 0; h < 2; ++h)
#pragma unroll
                for (int i = 0; i < 2; ++i) vA[h][i] = vN[h][i];
        }
    }
    PG8_WAIT_V(0);
    if (wr == 0) PG8_BAR;
    PG8_BAR;
#undef PG8_SA
#undef PG8_SB
#undef PG8_STAGE
#undef PG8_STAGE_A
#undef PG8_LDA
#undef PG8_LDB
#undef PG8_MMA
#undef PG8_WAIT_V
#undef PG8_WAIT_L
#undef PG8_BAR
#undef PG8_SCHED
}
template <int ACT> struct EpiBf16 {
    static constexpr bool PERM = true;
    bf16* O; int ldc; int tpt; size_t tstride; float* stats; int stat_pn0;
    __device__ __forceinline__ void operator()(const f32x4 (&acc)[2][2][4][2], const Unit& u, int wr, int wc, int fr, int fq) const {
        const int row0 = u.pm * BM + wr * 64 + fr; const int tt = u.pn / tpt; bf16* base = O + (size_t)tt * tstride; const int col0 = (u.pn - tt * tpt) * BM + wc * 32 + 8 * fq;
        const __amdgpu_buffer_rsrc_t rs_ = wt_rsrc(base);
#pragma unroll
        for (int ai = 0; ai < 2; ++ai)
#pragma unroll
            for (int m = 0; m < 4; ++m) { const unsigned rowo = (unsigned)((row0 + ai * HALF + m * 16) * ldc + col0) * 2u; float psum = 0.f, psq = 0.f;
#pragma unroll
                for (int bj = 0; bj < 2; ++bj) { f32x4 v0 = acc[ai][bj][m][0], v1 = acc[ai][bj][m][1];
                    if (ACT == 1) {
#pragma unroll
                        for (int q = 0; q < 4; ++q) { v0[q] = gelu_tanh(v0[q]); v1[q] = gelu_tanh(v1[q]); } }
                    if (ACT == 1) { psum += ((v0[0] + v0[1]) + (v0[2] + v0[3])) + ((v1[0] + v1[1]) + (v1[2] + v1[3]));
                        psq += ((v0[0] * v0[0] + v0[1] * v0[1]) + (v0[2] * v0[2] + v0[3] * v0[3])) + ((v1[0] * v1[0] + v1[1] * v1[1]) + (v1[2] * v1[2] + v1[3] * v1[3])); }
                    u32x4 w; w.x = cvt_pk_bf16(v0[0], v0[1]); w.y = cvt_pk_bf16(v0[2], v0[3]); w.z = cvt_pk_bf16(v1[0], v1[1]); w.w = cvt_pk_bf16(v1[2], v1[3]);
                    st16_wt(rs_, rowo + (unsigned)(bj * HALF * 2), w); }
                if (ACT == 1 && stats && u.pn >= stat_pn0) {
                    psum = xadd32(xadd16(psum)); psq = xadd32(xadd16(psq));
                    if (fq == 0) { f32x2 st2 = {psum, psq}; *(f32x2*)(stats + ((size_t)(row0 + ai * HALF + m * 16) * 32 + (u.pn - stat_pn0) * 4 + wc) * 2) = st2; } } }
    }
};
struct EpiResAdd {
    static constexpr bool PERM = true;
    bf16* X; int ldc;
    __device__ __forceinline__ void operator()(const f32x4 (&acc)[2][2][4][2], const Unit& u, int wr, int wc, int fr, int fq) const {
        const int row0 = u.pm * BM + wr * 64 + fr, col0 = u.pn * BM + wc * 32 + 8 * fq;
        const __amdgpu_buffer_rsrc_t rs_ = wt_rsrc(X);
#pragma unroll
        for (int ai = 0; ai < 2; ++ai) {
            u32x4 x[4][2];
#pragma unroll
            for (int m = 0; m < 4; ++m)
#pragma unroll
                for (int bj = 0; bj < 2; ++bj) x[m][bj] = *(const u32x4*)(X + (size_t)(row0 + ai * HALF + m * 16) * ldc + col0 + bj * HALF);
#pragma unroll
            for (int m = 0; m < 4; ++m)
#pragma unroll
                for (int bj = 0; bj < 2; ++bj) { const f32x4 a0 = acc[ai][bj][m][0], a1 = acc[ai][bj][m][1]; const u32x4 xv = x[m][bj];
                    u32x4 w; w.x = pk2(bflo(xv.x) + a0.x, bfhi(xv.x) + a0.y); w.y = pk2(bflo(xv.y) + a0.z, bfhi(xv.y) + a0.w); w.z = pk2(bflo(xv.z) + a1.x, bfhi(xv.z) + a1.y); w.w = pk2(bflo(xv.w) + a1.z, bfhi(xv.w) + a1.w);
                    st16_wt(rs_, (unsigned)((row0 + ai * HALF + m * 16) * ldc + col0 + bj * HALF) * 2u, w); }
        }
    }
};
struct EpiResAddNorm {
    static constexpr bool PERM = true;
    bf16* X; int ldc; float* rowsq;
    __device__ __forceinline__ void operator()(const f32x4 (&acc)[2][2][4][2], const Unit& u, int wr, int wc, int fr, int fq) const {
        const int row0 = u.pm * BM + wr * 64 + fr, col0 = u.pn * BM + wc * 32 + 8 * fq;
        const __amdgpu_buffer_rsrc_t rs_ = wt_rsrc(X);
#pragma unroll
        for (int ai = 0; ai < 2; ++ai) {
            u32x4 x[4][2];
#pragma unroll
            for (int m = 0; m < 4; ++m)
#pragma unroll
                for (int bj = 0; bj < 2; ++bj) x[m][bj] = *(const u32x4*)(X + (size_t)(row0 + ai * HALF + m * 16) * ldc + col0 + bj * HALF);
#pragma unroll
            for (int m = 0; m < 4; ++m) {
                const size_t ro = (size_t)(row0 + ai * HALF + m * 16) * ldc + col0; float ssq = 0.f;
#pragma unroll
                for (int bj = 0; bj < 2; ++bj) { const f32x4 a0 = acc[ai][bj][m][0], a1 = acc[ai][bj][m][1]; const u32x4 xv = x[m][bj];
                    u32x4 w; w.x = pk2(bflo(xv.x) + a0.x, bfhi(xv.x) + a0.y); w.y = pk2(bflo(xv.y) + a0.z, bfhi(xv.y) + a0.w); w.z = pk2(bflo(xv.z) + a1.x, bfhi(xv.z) + a1.y); w.w = pk2(bflo(xv.w) + a1.z, bfhi(xv.w) + a1.w);
                    st16_wt(rs_, (unsigned)(ro + bj * HALF) * 2u, w);
                    const float v0 = bflo(w.x), v1 = bfhi(w.x), v2 = bflo(w.y), v3 = bfhi(w.y), v4 = bflo(w.z), v5 = bfhi(w.z), v6 = bflo(w.w), v7 = bfhi(w.w);
                    ssq += ((v0 * v0 + v1 * v1) + (v2 * v2 + v3 * v3)) + ((v4 * v4 + v5 * v5) + (v6 * v6 + v7 * v7)); }
                ssq = xadd32(xadd16(ssq));
                if (fq == 0) rowsq[(size_t)(row0 + ai * HALF + m * 16) * 16 + u.pn * 4 + wc] = ssq;
            }
        }
    }
};
struct EpiBf16RowScale {
    static constexpr bool PERM = true;
    bf16* O; int ldc; const float* rowsq;
    __device__ __forceinline__ void operator()(const f32x4 (&acc)[2][2][4][2], const Unit& u, int wr, int wc, int fr, int fq) const {
        const int row0 = u.pm * BM + wr * 64 + fr, col0 = u.pn * BM + wc * 32 + 8 * fq;
#pragma unroll
        for (int ai = 0; ai < 2; ++ai) {
            float rs[4];
#pragma unroll
            for (int m = 0; m < 4; ++m) { const f32x4* p = (const f32x4*)(rowsq + (size_t)(row0 + ai * HALF + m * 16) * 16); const f32x4 a = p[0], b = p[1], c = p[2], d = p[3];
                rs[m] = rsqrtf((((a.x + a.y) + (a.z + a.w)) + ((b.x + b.y) + (b.z + b.w)) + (((c.x + c.y) + (c.z + c.w)) + ((d.x + d.y) + (d.z + d.w)))) * (1.f / 1024.f) + EPS); }
#pragma unroll
            for (int m = 0; m < 4; ++m) { const unsigned rowo = (unsigned)((row0 + ai * HALF + m * 16) * ldc + col0) * 2u;
#pragma unroll
                for (int bj = 0; bj < 2; ++bj) { const f32x4 v0 = acc[ai][bj][m][0] * rs[m], v1 = acc[ai][bj][m][1] * rs[m];
                    u32x4 w; w.x = cvt_pk_bf16(v0[0], v0[1]); w.y = cvt_pk_bf16(v0[2], v0[3]); w.z = cvt_pk_bf16(v1[0], v1[1]); w.w = cvt_pk_bf16(v1[2], v1[3]);
                    st16_wt(wt_rsrc(O), rowo + (unsigned)(bj * HALF * 2), w); } }
        }
    }
};
template <bool WT> struct EpiSwiglu {
    static constexpr bool PERM = true;
    bf16* H; int ldc; unsigned hbytes;
    __device__ __forceinline__ void operator()(const f32x4 (&acc)[2][2][4][2], const Unit& u, int wr, int wc, int fr, int fq) const {
        const int row0 = u.pm * BM + wr * 64 + fr, col0 = u.pn * HALF + wc * 32 + 8 * fq;
        const __amdgpu_buffer_rsrc_t rsrc = __builtin_amdgcn_make_buffer_rsrc(H, 0, hbytes, 0x00020000);
#pragma unroll
        for (int ai = 0; ai < 2; ++ai)
#pragma unroll
            for (int m = 0; m < 4; ++m) {
                float o[8];
#pragma unroll
                for (int n = 0; n < 2; ++n)
#pragma unroll
                    for (int q = 0; q < 4; ++q) { const float g = acc[ai][0][m][n][q]; o[4 * n + q] = g * sigmoidf_(g) * acc[ai][1][m][n][q]; }
                u32x4 w; w.x = cvt_pk_bf16(o[0], o[1]); w.y = cvt_pk_bf16(o[2], o[3]); w.z = cvt_pk_bf16(o[4], o[5]); w.w = cvt_pk_bf16(o[6], o[7]);
                if constexpr (WT) __builtin_amdgcn_raw_buffer_store_b128(w, rsrc, (unsigned)(((row0 + ai * HALF + m * 16) * ldc + col0) * 2), 0, 16);
                else *(u32x4*)(H + (size_t)(row0 + ai * HALF + m * 16) * ldc + col0) = w; }
    }
};
}

__device__ __forceinline__ int hyb_colmap(int n) {
    if (n < 1280) return n;
    if (n < 1536) return 1304 + (n - 1280);
    if (n < 1792) return 1560 + (n - 1536);
    if (n < 2304) return 1816 + (n - 1792);
    if (n < 2816) return 2344 + (n - 2304);
    if (n < 2840) return 1280 + (n - 2816);
    if (n < 2856) return 2328 + (n - 2840);
    return -1;
}
__device__ __forceinline__ void tr_item(const float* __restrict__ W, int Nsrc, int K, bf16* __restrict__ Wt, const float* __restrict__ gain, int kind, int nblk, LAS float* scr, int item, int lane) {
    const int kb = item / nblk, nb = item % nblk, k0 = 64 * kb, n0 = 64 * nb;
    const int ksub = lane >> 4, n4 = lane & 15, n = n0 + 4 * n4;
    int col;
    if (kind == 0) col = n; else if (kind == 1) col = hyb_colmap(n); else { const int pn = n >> 8, r = n & 255; col = (r >> 7) * 384 + pn * 128 + (r & 127); }
    f32x4 v[16];
#pragma unroll
    for (int i = 0; i < 16; ++i) v[i] = col >= 0 ? *(const f32x4*)(W + (size_t)(k0 + 4 * i + ksub) * Nsrc + col) : (f32x4){0.f, 0.f, 0.f, 0.f};
    if (gain) {
#pragma unroll
        for (int i = 0; i < 16; ++i) v[i] = v[i] * gain[k0 + 4 * i + ksub];
    }
#pragma unroll
    for (int i = 0; i < 16; ++i) { LAS float* d = scr + (4 * i + ksub) * 65 + 4 * n4; d[0] = v[i].x; d[1] = v[i].y; d[2] = v[i].z; d[3] = v[i].w; }
    LDS_WAIT();
    const int c = lane & 7;
#pragma unroll
    for (int jx = 0; jx < 8; ++jx) {
        const int nn = (lane >> 3) + 8 * jx; const LAS float* s = scr + (8 * c) * 65 + nn;
        u32x4 o; o.x = pk2(s[0 * 65], s[1 * 65]); o.y = pk2(s[2 * 65], s[3 * 65]); o.z = pk2(s[4 * 65], s[5 * 65]); o.w = pk2(s[6 * 65], s[7 * 65]);
        *(u32x4*)(Wt + (size_t)(n0 + nn) * K + k0 + 8 * c) = o;
    }
    LDS_WAIT();
}
__device__ __forceinline__ void rms_row_to_bf16(const float* __restrict__ xrow, bf16* __restrict__ orow, bf16* __restrict__ copy, int lane) {
    const f32x4* xr = (const f32x4*)xrow + lane;
    f32x4 v[4]; float s = 0.f;
#pragma unroll
    for (int j = 0; j < 4; ++j) { v[j] = xr[64 * j]; s += (v[j].x * v[j].x + v[j].y * v[j].y) + (v[j].z * v[j].z + v[j].w * v[j].w); }
    const float rstd = rsqrtf(wave_sum(s) * (1.f / 1024.f) + EPS);
    u32x2* o8 = (u32x2*)orow + lane;
#pragma unroll
    for (int j = 0; j < 4; ++j) { u32x2 w; w.x = pk2(v[j].x * rstd, v[j].y * rstd); w.y = pk2(v[j].z * rstd, v[j].w * rstd); o8[64 * j] = w; }
    if (copy) { u32x2* c4 = (u32x2*)copy + lane;
#pragma unroll
        for (int j = 0; j < 4; ++j) { u32x2 w; w.x = pk2(v[j].x, v[j].y); w.y = pk2(v[j].z, v[j].w); c4[64 * j] = w; } }
}

constexpr int MOE_W_PER_L = 16 * (192 + 96);
__device__ __forceinline__ void moe_weight_item(KArgs A, unsigned char* ws, LAS float* scr, const int l_lo, const int it, const int lane) {
    const int l = l_lo + it / MOE_W_PER_L; int r = it % MOE_W_PER_L;
    if (r < 16 * 192) { const int sl = l * 16 + r / 192; tr_item(A->in[I_MOEIN] + (size_t)sl * 1024 * 768, 768, 1024, (bf16*)(ws + WS_WMIN) + (size_t)sl * 768 * 1024, A->in[I_NFFN] + l * 1024, 2, 12, scr, r % 192, lane); }
    else { r -= 16 * 192; const int sl = l * 16 + r / 96; tr_item(A->in[I_MOEOUT] + (size_t)sl * 384 * 1024, 1024, 384, (bf16*)(ws + WS_WMOUT) + (size_t)sl * 1024 * 384, nullptr, 0, 16, scr, r % 96, lane); }
}
__device__ __forceinline__ void moe_weight_share(KArgs A, int wv_, LAS float* scr, LAS unsigned* wq, const int l_lo, const int blk) {
    const int lane = opaque_tid(wv_) & 63;
    unsigned char* ws = opq(A->ws);
    constexpr int PER_BLK = 2 * MOE_W_PER_L / 256;
    for (;;) {
        unsigned k = 0; if (lane == 0) k = atomicAdd((unsigned*)wq, 1u);
        k = __builtin_amdgcn_readfirstlane(k);
        if (k >= (unsigned)PER_BLK) break;
        moe_weight_item(A, ws, scr, l_lo, blk * PER_BLK + (int)k, lane);
    }
}

__device__ __forceinline__ void phase_prologue(KArgs A, int wv_, LAS unsigned char* lds) {
    const int tid = opaque_tid(wv_), wid = __builtin_amdgcn_readfirstlane(tid >> 6), lane = tid & 63;
    const int gw = blockIdx.x * 8 + wid, NGW = gridDim.x * 8;
    LAS float* scr = (LAS float*)(lds + wid * 16640);
    unsigned char* ws = opq(A->ws);
    constexpr int N_HYB = 2 * 768, N_HOUT = 2 * 256, N_SGIN = 2 * 1024, N_SGOUT = 2 * 512, N_WQ = 4 * 256, N_WKV = 4 * 512, N_WO = 4 * 256, N_W1T = 4 * 32;
    constexpr int NITEMS = N_HYB + N_HOUT + N_SGIN + N_SGOUT + N_WQ + N_WKV + N_WO + N_W1T;
    for (int it = gw; it < NITEMS; it += NGW) {
        int r = it;
        if (r < N_HYB) { const int sl = r / 768; tr_item(A->in[I_HYBIN] + (size_t)sl * 1024 * HYSRC, HYSRC, 1024, (bf16*)(ws + WS_WHYB) + (size_t)sl * HYN * 1024, A->in[I_NMIX] + (2 * sl) * 1024, 1, 48, scr, r % 768, lane); continue; } r -= N_HYB;
        if (r < N_HOUT) { const int sl = r / 256; tr_item(A->in[I_HYBOUT] + (size_t)sl * 1024 * 1024, 1024, 1024, (bf16*)(ws + WS_WHOUT) + (size_t)sl * 1024 * 1024, nullptr, 0, 16, scr, r % 256, lane); continue; } r -= N_HOUT;
        if (r < N_SGIN) { const int sl = r / 1024; tr_item(A->in[I_SGIN] + (size_t)sl * 1024 * 4096, 4096, 1024, (bf16*)(ws + WS_WSGIN) + (size_t)sl * 4096 * 1024, A->in[I_NMIX] + (2 * sl + 1) * 1024, 0, 64, scr, r % 1024, lane); continue; } r -= N_SGIN;
        if (r < N_SGOUT) { const int sl = r / 512; tr_item(A->in[I_SGOUT] + (size_t)sl * 2048 * 1024, 1024, 2048, (bf16*)(ws + WS_WSGOUT) + (size_t)sl * 1024 * 2048, nullptr, 0, 16, scr, r % 512, lane); continue; } r -= N_SGOUT;
        if (r < N_WQ) { const int sl = r / 256; tr_item(A->in[I_XWQ] + (size_t)sl * 1024 * 1024, 1024, 1024, (bf16*)(ws + WS_WQ) + (size_t)sl * 1024 * 1024, A->in[I_NXAT] + sl * 1024, 0, 16, scr, r % 256, lane); continue; } r -= N_WQ;
        if (r < N_WKV) { const int sl = r / 512; tr_item(A->in[I_XWKV] + (size_t)sl * 1024 * 2048, 2048, 1024, (bf16*)(ws + WS_WKV) + (size_t)sl * 2048 * 1024, A->in[I_NMEM] + sl * 1024, 0, 32, scr, r % 512, lane); continue; } r -= N_WKV;
        if (r < N_WO) { const int sl = r / 256; tr_item(A->in[I_XWO] + (size_t)sl * 1024 * 1024, 1024, 1024, (bf16*)(ws + WS_WO) + (size_t)sl * 1024 * 1024, nullptr, 0, 16, scr, r % 256, lane); continue; } r -= N_WO;
        { const int sl = r / 32; tr_item(A->in[I_CMPW1] + (size_t)sl * 2048 * 64, 64, 2048, (bf16*)(ws + WS_W1T) + (size_t)sl * 64 * 2048, nullptr, 0, 1, scr, r % 32, lane); }
    }
    for (int m = gw; m < T; m += NGW) rms_row_to_bf16(A->in[I_X] + (size_t)m * D, (bf16*)(ws + WS_XN) + (size_t)m * D, (bf16*)(ws + WS_X16) + (size_t)m * D, lane);
    for (int m = gw; m < NBATCH * NMEM; m += NGW) rms_row_to_bf16(A->in[I_MEM] + (size_t)m * D, (bf16*)(ws + WS_MN) + (size_t)m * D, nullptr, lane);
    const int gt = blockIdx.x * 512 + tid, NGT = gridDim.x * 512;
    const int* pos = (const int*)A->in[I_POS];
    float* cosT = (float*)(ws + WS_COS); float* sinT = (float*)(ws + WS_SIN);
    for (int i = gt; i < T * 32; i += NGT) {
        const int t = i >> 5, j = i & 31;
        const float ang = (float)pos[t] * A->freq[j];
        const double rev = (double)ang * 0.15915494309189533577;
        const float fr = (float)(rev - rint(rev));
        cosT[i] = __builtin_amdgcn_cosf(fr); sinT[i] = __builtin_amdgcn_sinf(fr);
    }
    { bf16* WSB = (bf16*)(ws + WS_WSB); float* M0 = (float*)(ws + WS_M0); const float* wsg = A->in[I_SGWS];
      for (int e = gt; e < 2 * 8 * 128 * 128; e += NGT) { const int s = e & 127, t = (e >> 7) & 127; WSB[e] = (bf16)f2bf(s <= t ? wsg[e] : 0.f); }
      for (int e = gt; e < 2 * 8 * 128; e += NGT) { const int t = e & 127; const float* r = wsg + (size_t)e * 128; float a = 0.f; for (int s = 0; s <= t; ++s) a += r[s]; M0[e] = a; } }
    float* RW = (float*)(ws + WS_RW);
    for (int i = gt; i < DEPTH * NEXP * D; i += NGT) { const int k = i & 1023, e = (i >> 10) & 15, l = i >> 14; RW[i] = A->in[I_RW][k * NEXP + e] * A->in[I_NFFN][l * D + k]; }
}

__device__ __forceinline__ void phase_knorm(KArgs A, int wv_, const int gw, const int NGW) {
    const int tid_ = opaque_tid(wv_); const int lane = tid_ & 63;
    bf16* KV = (bf16*)(opq(A->ws) + WS_KV);
    for (int it0 = gw * 4; it0 < DEPTH * 2048 * 4; it0 += NGW * 4) {
        u32x2 w[4];
#pragma unroll
        for (int q = 0; q < 4; ++q) { const int it = it0 + q; const int h = it & 3, m = (it >> 2) & 2047, l = it >> 13; w[q] = *(const u32x2*)(KV + (size_t)m * 8192 + l * 2048 + h * 256 + 4 * lane); }
#pragma unroll
        for (int q = 0; q < 4; ++q) {
            const int it = it0 + q; const int h = it & 3, m = (it >> 2) & 2047, l = it >> 13;
            const float x0 = bflo(w[q].x), x1 = bfhi(w[q].x), x2 = bflo(w[q].y), x3 = bfhi(w[q].y);
            const float rstd = rsqrtf(wave_sum(x0 * x0 + x1 * x1 + x2 * x2 + x3 * x3) * (1.f / 256.f) + EPS) * 0.0625f;
            const f32x4 g = *(const f32x4*)(A->in[I_XKN] + l * 256 + 4 * lane) * *(const f32x4*)(A->in[I_XQN] + l * 256 + 4 * lane);
            u32x2 o; o.x = pk2(x0 * rstd * g.x, x1 * rstd * g.y); o.y = pk2(x2 * rstd * g.z, x3 * rstd * g.w);
            *(u32x2*)(KV + (size_t)m * 8192 + l * 2048 + h * 256 + 4 * lane) = o;
        }
    }
}

__device__ __forceinline__ int kpos64(int tok) { const int k = tok & 31; return (tok & 32) + 8 * ((k >> 2) & 3) + 4 * (k >> 4) + (k & 3); }
__device__ __forceinline__ int kperm64(int p) { const int fq = (p >> 3) & 3, j = p & 7; return (p & 32) + 16 * (j >> 2) + 4 * fq + (j & 3); }

__device__ __forceinline__ void phase_nsa_prep(KArgs A, int wv_, int i, LAS unsigned char* lds) {
    const int tid_ = opaque_tid(wv_); const int wid = __builtin_amdgcn_readfirstlane(tid_ >> 6), lane = tid_ & 63; const int gw = blockIdx.x * 8 + wid, NGW = gridDim.x * 8;
    unsigned char* ws = opq(A->ws);
    const bf16* HY = (const bf16*)(ws + WS_BIG);
    const float* cosT = (const float*)(ws + WS_COS); const float* sinT = (const float*)(ws + WS_SIN);
    bf16* QA = (bf16*)(ws + WS_QA); bf16* KS = (bf16*)(ws + WS_KS); bf16* KW = (bf16*)(ws + WS_KW);
    (void)lds;
    const int j8 = lane & 7, ug = lane >> 3;
    const int u1 = 8 + (ug & 3);
    const int src0 = C_QA + 64 * ug, src1 = u1 < 10 ? C_KS + 64 * (u1 - 8) : C_KW + 64 * (u1 - 10);
    const float* g0p = A->in[I_QNORM] + i * 64 + 8 * j8; const float* g1p = A->in[I_KNORM] + (i * 3 + (u1 < 10 ? 1 : 2)) * 64 + 8 * j8;
    const f32x4 g0a = *(const f32x4*)g0p, g0b = *(const f32x4*)(g0p + 4), g1a = *(const f32x4*)g1p, g1b = *(const f32x4*)(g1p + 4);
    u32x4 w0 = (u32x4){0u, 0u, 0u, 0u}, w1 = w0; f32x4 ca, cb, sa, sb;
    if (gw < T) { w0 = *(const u32x4*)(HY + (size_t)gw * HYN + src0 + 8 * j8); w1 = *(const u32x4*)(HY + (size_t)gw * HYN + src1 + 8 * j8);
        const float* cp = cosT + gw * 32 + 8 * (j8 & 3); const float* sp = sinT + gw * 32 + 8 * (j8 & 3); ca = *(const f32x4*)cp; cb = *(const f32x4*)(cp + 4); sa = *(const f32x4*)sp; sb = *(const f32x4*)(sp + 4); }
    for (int t = gw; t < T; t += NGW) {
        const int tn = t + NGW < T ? t + NGW : t;
        const u32x4 n0 = *(const u32x4*)(HY + (size_t)tn * HYN + src0 + 8 * j8), n1 = *(const u32x4*)(HY + (size_t)tn * HYN + src1 + 8 * j8);
        const float* cp = cosT + tn * 32 + 8 * (j8 & 3); const float* sp = sinT + tn * 32 + 8 * (j8 & 3);
        const f32x4 nca = *(const f32x4*)cp, ncb = *(const f32x4*)(cp + 4), nsa = *(const f32x4*)sp, nsb = *(const f32x4*)(sp + 4);
#pragma unroll
        for (int pass = 0; pass < 2; ++pass) {
            const u32x4 w = pass ? w1 : w0; const f32x4 ga = pass ? g1a : g0a, gb = pass ? g1b : g0b;
            float x[8] = {bflo(w.x), bfhi(w.x), bflo(w.y), bfhi(w.y), bflo(w.z), bfhi(w.z), bflo(w.w), bfhi(w.w)};
            float ssq = 0.f;
#pragma unroll
            for (int q = 0; q < 8; ++q) ssq += x[q] * x[q];
            ssq += __shfl_xor(ssq, 1); ssq += __shfl_xor(ssq, 2); ssq += __shfl_xor(ssq, 4);
            const float rs = rsqrtf(ssq * (1.f / 64.f) + EPS) * (pass ? 1.f : 0.125f * 1.4426950408889634f);
            const float gg[8] = {ga.x, ga.y, ga.z, ga.w, gb.x, gb.y, gb.z, gb.w}, cc[8] = {ca.x, ca.y, ca.z, ca.w, cb.x, cb.y, cb.z, cb.w}, ss[8] = {sa.x, sa.y, sa.z, sa.w, sb.x, sb.y, sb.z, sb.w};
            float o[8];
#pragma unroll
            for (int q = 0; q < 8; ++q) { const float y = x[q] * rs * gg[q]; const float pr = __shfl_xor(y, 4);
                o[q] = j8 < 4 ? y * cc[q] - pr * ss[q] : y * cc[q] + pr * ss[q]; }
            u32x4 ow; ow.x = pk2(o[0], o[1]); ow.y = pk2(o[2], o[3]); ow.z = pk2(o[4], o[5]); ow.w = pk2(o[6], o[7]);
            if (pass == 0) *(u32x4*)(QA + (size_t)t * 512 + 64 * ug + 8 * j8) = ow;
            else if (lane < 32) { bf16* dst = (u1 < 10 ? KS + (size_t)t * 128 + 64 * (u1 - 8) : KW + (size_t)t * 128 + 64 * (u1 - 10)); *(u32x4*)(dst + 8 * j8) = ow; }
        }
        w0 = n0; w1 = n1; ca = nca; cb = ncb; sa = nsa; sb = nsb;
    }
}

__device__ __forceinline__ void phase_compress_mfma(KArgs A, int wv_, int i, LAS unsigned char* lds) {
    const int tid = opaque_tid(wv_), wid = __builtin_amdgcn_readfirstlane(tid >> 6), lane = tid & 63, fr = lane & 15, fq = lane >> 4;
    unsigned char* ws = opq(A->ws);
    const bf16* HY = (const bf16*)(ws + WS_BIG);
    const float* cosT = (const float*)(ws + WS_COS); const float* sinT = (const float*)(ws + WS_SIN);
    LAS float* part = (LAS float*)lds;
    LAS float* hbuf = part + 8 * 1024;
    LAS float* obuf = hbuf + 1024;
    LAS float* w2l = obuf + 1024;
    int w2kv = -1;
    for (int it = blockIdx.x; it < 2 * 127; it += gridDim.x) {
        const int kv = it / 127, tile = it % 127;
        const float* pe = A->in[I_CMPPE] + (size_t)(i * 2 + kv) * 32 * 64;
        const float* w2 = A->in[I_CMPW2] + (size_t)(i * 2 + kv) * 64 * 64;
        const bf16* w1t = (const bf16*)(ws + WS_W1T) + (size_t)(i * 2 + kv) * 64 * 2048;
        const int coff = kv ? C_VC : C_KC;
        if (kv != w2kv) { __syncthreads(); for (int e4 = tid; e4 < 1024; e4 += 512) *(LAS f32x4*)(w2l + 4 * e4) = *(const f32x4*)(w2 + 4 * e4); w2kv = kv; }
        {
            const int R = tile * 16 + fr, g = R & 1, bn = R >> 1, n = bn % NCMP, b = bn / NCMP;
            const bf16* arow = HY + (size_t)(b * S + 16 * n) * HYN + coff + g * 64;
            f32x4 acc[4];
#pragma unroll
            for (int t = 0; t < 4; ++t) acc[t] = (f32x4){0.f, 0.f, 0.f, 0.f};
#pragma unroll 4
            for (int s = 0; s < 8; ++s) {
                const int k0 = 256 * wid + 32 * s, l = k0 >> 6, d0 = (k0 & 63) + 8 * fq;
                const u32x4 hw = *(const u32x4*)(arow + (size_t)l * HYN + d0);
                const f32x4 p0 = *(const f32x4*)(pe + l * 64 + d0), p1 = *(const f32x4*)(pe + l * 64 + d0 + 4);
                u32x4 aw; aw.x = pk2(bflo(hw.x) + p0.x, bfhi(hw.x) + p0.y); aw.y = pk2(bflo(hw.y) + p0.z, bfhi(hw.y) + p0.w); aw.z = pk2(bflo(hw.z) + p1.x, bfhi(hw.z) + p1.y); aw.w = pk2(bflo(hw.w) + p1.z, bfhi(hw.w) + p1.w);
                const bf16x8 af = __builtin_bit_cast(bf16x8, aw);
#pragma unroll
                for (int t = 0; t < 4; ++t) { const bf16x8 bfr = *(const bf16x8*)(w1t + (size_t)(16 * t + fr) * 2048 + k0 + 8 * fq);
                    acc[t] = __builtin_amdgcn_mfma_f32_16x16x32_bf16(af, bfr, acc[t], 0, 0, 0); }
            }
            __syncthreads();
#pragma unroll
            for (int t = 0; t < 4; ++t)
#pragma unroll
                for (int r = 0; r < 4; ++r) part[wid * 1024 + (4 * fq + r) * 64 + 16 * t + fr] = acc[t][r];
        }
        __syncthreads();
        for (int e = tid; e < 1024; e += 512) { float a = 0.f;
#pragma unroll
            for (int w = 0; w < 8; ++w) a += part[w * 1024 + e];
            hbuf[e] = gelu_tanh(a); }
        __syncthreads();
        for (int e = tid; e < 1024; e += 512) { const int r = e >> 6, j = e & 63; float o = 0.f;
#pragma unroll 8
            for (int m = 0; m < 64; ++m) o += hbuf[r * 64 + m] * w2l[m * 64 + j];
            obuf[e] = o; }
        __syncthreads();
        for (int r = wid; r < 16; r += 8) {
            const int R = tile * 16 + r, g = R & 1, bn = R >> 1, n = bn % NCMP, b = bn / NCMP;
            const float o = obuf[r * 64 + lane];
            if (kv == 0) {
                const float y = o * rsqrtf(wave_sum(o * o) * (1.f / 64.f) + EPS) * A->in[I_KNORM][(i * 3 + 0) * 64 + lane];
                const int tp = b * S + 16 * n + 31;
                const float c = cosT[tp * 32 + (lane & 31)], sn = sinT[tp * 32 + (lane & 31)];
                const float pr = __shfl_xor(y, 32);
                const float oo = lane < 32 ? y * c - pr * sn : y * c + pr * sn;
                ((bf16*)(ws + WS_KC))[((size_t)(b * 128 + n) * 2 + g) * 64 + lane] = (bf16)f2bf(oo);
            } else {
                bf16* vct = (bf16*)(ws + WS_VC) + ((size_t)(b * 2 + g) * 64 + lane) * 128;
                vct[(n & 64) + kpos64(n & 63)] = (bf16)f2bf(o);
                if (n == 126) vct[127] = 0;
            }
        }
    }
    __syncthreads();
}

__device__ __forceinline__ void nsa_softmax(f32x4 (&sc)[4], bf16x8 (&pf)[2], float& mrun, float& lrun, f32x4 (&o)[4], const bool rowok, const bool edge, const int kphi, const int kplo, const bool allrows, const int fq) {
    float bm = -INFINITY;
    if (edge) {
#pragma unroll
        for (int t = 0; t < 4; ++t)
#pragma unroll
            for (int r = 0; r < 4; ++r) { const int kp = 16 * t + 4 * fq + r; const bool v = rowok && kp <= kphi && kp >= kplo; sc[t][r] = v ? sc[t][r] : -INFINITY; bm = fmaxf(bm, sc[t][r]); }
    } else {
#pragma unroll
        for (int t = 0; t < 4; ++t) bm = fmaxf(bm, fmaxf(fmaxf(sc[t].x, sc[t].y), fmaxf(sc[t].z, sc[t].w)));
        if (!allrows) bm = rowok ? bm : -INFINITY;
    }
    bm = xmax32(xmax16(bm));
    const float mn = fmaxf(mrun, bm); const float mns = mn == -INFINITY ? 0.f : mn;
    float rs = 0.f;
#pragma unroll
    for (int t = 0; t < 4; ++t)
#pragma unroll
        for (int r = 0; r < 4; ++r) { sc[t][r] = __builtin_amdgcn_exp2f(sc[t][r] - mns); rs += sc[t][r]; }
    if (!edge && !allrows) {
#pragma unroll
        for (int t = 0; t < 4; ++t) sc[t] = rowok ? sc[t] : (f32x4){0.f, 0.f, 0.f, 0.f};
        rs = rowok ? rs : 0.f;
    }
    rs = xadd32(xadd16(rs));
    if (__all(mn == mrun)) { lrun += rs; }
    else {
        const float alpha = __builtin_amdgcn_exp2f(mrun - mns);
        lrun = lrun * alpha + rs; mrun = mn;
#pragma unroll
        for (int n = 0; n < 4; ++n) o[n] = o[n] * alpha;
    }
#pragma unroll
    for (int s = 0; s < 2; ++s) { u32x4 w; w.x = pk2(sc[2 * s].x, sc[2 * s].y); w.y = pk2(sc[2 * s].z, sc[2 * s].w); w.z = pk2(sc[2 * s + 1].x, sc[2 * s + 1].y); w.w = pk2(sc[2 * s + 1].z, sc[2 * s + 1].w);
        pf[s] = __builtin_bit_cast(bf16x8, w); }
}

__device__ __forceinline__ void phase_nsa_attn_mfma(KArgs A, int wv_, int i, LAS unsigned char* lds) {
    const int wid = wv_;
    unsigned char* ws = opq(A->ws);
    const bf16* HY = (const bf16*)(ws + WS_BIG); const bf16* QA = (const bf16*)(ws + WS_QA); const bf16* KS = (const bf16*)(ws + WS_KS); const bf16* KW = (const bf16*)(ws + WS_KW);
    const bf16* KC = (const bf16*)(ws + WS_KC); const bf16* VCT = (const bf16*)(ws + WS_VC); const bf16* VTA = (const bf16*)(ws + WS_VTA); bf16* CAT = (bf16*)(ws + WS_CAT);
    constexpr int RS = 80;
    LAS bf16* ktl = (LAS bf16*)lds;
    LAS bf16* vtl = ktl + 4 * 64 * RS;
    LAS float* scl = (LAS float*)(lds + 81920) + wid * 256;
    LAS unsigned* msk = (LAS unsigned*)(lds + 81920 + 8192);
    LAS unsigned* umask = msk + 64;
    const float* gb = A->in[I_GATEB] + i * 24;
    unsigned long long tsub = 0, tt0 = 0;
    for (int pit = blockIdx.x; pit < 256; pit += gridDim.x) {
#pragma unroll 1
        for (int hf = 0; hf < 2; ++hf) {
            const int tid = opaque_tid(wv_), lane = tid & 63, fr = lane & 15, fq = lane >> 4;
            const int bg = pit >> 4, xx = pit & 15, x = hf ? 31 - xx : xx, b = bg >> 1, g = bg & 1;
            const size_t tokbase = (size_t)b * S + 64 * x;
            const int tl0 = 8 * wid + (fr >> 2);
            if (tid == 0) *umask = 0u;
            if (PROBE_NSA == 1) tt0 = __builtin_amdgcn_s_memrealtime();
            bf16x8 qf[2][2];
#pragma unroll
            for (int mt = 0; mt < 2; ++mt)
#pragma unroll
                for (int s = 0; s < 2; ++s) qf[mt][s] = *(const bf16x8*)(QA + (tokbase + tl0 + 4 * mt) * 512 + (g * 4 + (fr & 3)) * 64 + 32 * s + 8 * fq);
            f32x4 outacc[2][4];
            {
                const int tmaxc = (4 * x + 3 + 15) >> 4;
                const bf16* kcb = KC + ((size_t)(b * 128 + fr) * 2 + g) * 64 + 8 * fq;
                bf16x8 pcf[2][4];
#pragma unroll
                for (int mt = 0; mt < 2; ++mt) {
                    f32x4 sc[8];
                    const bf16* kp = kcb;
#pragma unroll
                    for (int t = 0; t < 8; ++t) { sc[t] = (f32x4){0.f, 0.f, 0.f, 0.f};
                        asm volatile("" : "+v"(kp));
                        if (t < tmaxc) {
                            const bf16x8 k0 = *(const bf16x8*)(kp), k1 = *(const bf16x8*)(kp + 32);
                            sc[t] = __builtin_amdgcn_mfma_f32_16x16x32_bf16(k0, qf[mt][0], sc[t], 0, 0, 0);
                            sc[t] = __builtin_amdgcn_mfma_f32_16x16x32_bf16(k1, qf[mt][1], sc[t], 0, 0, 0); }
                        kp += 16 * 128; }
                    const int tg = 64 * x + tl0 + 4 * mt; const int ncv = tg >= 31 ? ((tg - 31) >> 4) + 1 : 0;
                    float mx = -INFINITY;
#pragma unroll
                    for (int t = 0; t < 8; ++t)
#pragma unroll
                        for (int r = 0; r < 4; ++r) { const bool v = 16 * t + 4 * fq + r < ncv; sc[t][r] = v ? sc[t][r] : -INFINITY; mx = fmaxf(mx, sc[t][r]); }
                    mx = xmax32(xmax16(mx));
                    const float mxs = mx == -INFINITY ? 0.f : mx;
                    float sum = 0.f;
#pragma unroll
                    for (int t = 0; t < 8; ++t)
#pragma unroll
                        for (int r = 0; r < 4; ++r) { sc[t][r] = __builtin_amdgcn_exp2f(sc[t][r] - mxs); sum += sc[t][r]; }
                    sum = xadd32(xadd16(sum));
                    const float inv = sum > 0.f ? 1.f / sum : 0.f;
#pragma unroll
                    for (int t = 0; t < 8; ++t) sc[t] = sc[t] * inv;
#pragma unroll
                    for (int s = 0; s < 4; ++s) { u32x4 w; w.x = pk2(sc[2 * s].x, sc[2 * s].y); w.y = pk2(sc[2 * s].z, sc[2 * s].w); w.z = pk2(sc[2 * s + 1].x, sc[2 * s + 1].y); w.w = pk2(sc[2 * s + 1].z, sc[2 * s + 1].w);
                        pcf[mt][s] = __builtin_bit_cast(bf16x8, w); }
                    float w3[8];
#pragma unroll
                    for (int t = 0; t < 8; ++t) {
#pragma unroll
                        for (int r = 0; r < 4; ++r) { float v = sc[t][r]; v += __shfl_xor(v, 1); v += __shfl_xor(v, 2); sc[t][r] = v; }
                        w3[t] = __shfl(sc[t].w, (lane + 48) & 63);
                    }
#pragma unroll
                    for (int t = 0; t < 8; ++t) {
                        const float prev = fq > 0 ? w3[t] : (t > 0 ? w3[t > 0 ? t - 1 : 0] : 0.f);
                        const float imp = sc[t].x + sc[t].y + sc[t].z + 0.5f * sc[t].w + 0.5f * prev;
                        if ((fr & 3) == 0) scl[(4 * mt + (fr >> 2)) * 32 + 4 * t + fq] = imp;
                    }
                    asm volatile("" ::: "memory");
                }
                const bf16* vcb = VCT + ((size_t)(b * 2 + g) * 64 + fr) * 128 + 8 * fq;
#pragma unroll
                for (int n = 0; n < 4; ++n) {
                    outacc[0][n] = (f32x4){0.f, 0.f, 0.f, 0.f}; outacc[1][n] = (f32x4){0.f, 0.f, 0.f, 0.f};
                    asm volatile("" : "+v"(vcb));
#pragma unroll
                    for (int s = 0; s < 4; ++s) if (2 * s < tmaxc) {
                        const bf16x8 vf = *(const bf16x8*)(vcb + 32 * s);
                        outacc[0][n] = __builtin_amdgcn_mfma_f32_16x16x32_bf16(vf, pcf[0][s], outacc[0][n], 0, 0, 0);
                        outacc[1][n] = __builtin_amdgcn_mfma_f32_16x16x32_bf16(vf, pcf[1][s], outacc[1][n], 0, 0, 0); }
                    vcb += 16 * 128;
                    asm volatile("" ::: "memory");
                }
            }
            float g1v[2], g2v[2];
#pragma unroll
            for (int mt = 0; mt < 2; ++mt) {
                const int head = g * 4 + (fr & 3);
                const bf16* gl = HY + (tokbase + tl0 + 4 * mt) * HYN + C_GA + head * 3;
                const float g0 = sigmoidf_(bf2f(gl[0]) + gb[head * 3 + 0]);
                g1v[mt] = sigmoidf_(bf2f(gl[1]) + gb[head * 3 + 1]); g2v[mt] = sigmoidf_(bf2f(gl[2]) + gb[head * 3 + 2]);
#pragma unroll
                for (int n = 0; n < 4; ++n) outacc[mt][n] = outacc[mt][n] * g0;
            }
            LDS_WAIT();
            asm volatile("" ::: "memory");
            {
                const int tok8 = lane >> 3, jg = lane & 7;
                float sj[32];
#pragma unroll
                for (int q = 0; q < 8; ++q) { const f32x4 v = *(const LAS f32x4*)(scl + tok8 * 32 + 4 * q); sj[4 * q] = v.x; sj[4 * q + 1] = v.y; sj[4 * q + 2] = v.z; sj[4 * q + 3] = v.w; }
#pragma unroll
                for (int j = 0; j < 32; ++j) sj[j] = j <= x ? sj[j] + ((j == 0 || j == x || j == x - 1) ? 1000.0f : 0.f) : -INFINITY;
                unsigned bits = 0u;
                const f32x4 mv = *(const LAS f32x4*)(scl + tok8 * 32 + 4 * jg);
#pragma unroll
                for (int q = 0; q < 4; ++q) {
                    const int j = 4 * jg + q;
                    const float mine = j <= x ? mv[q] + ((j == 0 || j == x || j == x - 1) ? 1000.0f : 0.f) : -INFINITY;
                    int rank = 0;
#pragma unroll
                    for (int jj = 0; jj < 32; ++jj) rank += (sj[jj] > mine || (sj[jj] == mine && jj < j)) ? 1 : 0;
                    bits |= (j <= x && rank < 8) ? (1u << j) : 0u;
                }
                bits |= __shfl_xor(bits, 1); bits |= __shfl_xor(bits, 2); bits |= __shfl_xor(bits, 4);
                if (jg == 0) { msk[wid * 8 + tok8] = bits; atomicOr((unsigned*)umask, bits); }
            }
            __syncthreads();
            if (PROBE_NSA == 1) tsub += __builtin_amdgcn_s_memrealtime() - tt0;
#pragma unroll 1
            for (int pp = 0; pp < 2 + (PROBE_NSAX ? 1 : 0); ++pp) {
                const int pass = pp == 2 ? 0 : pp; const bool dummy = pp == 2;
                if (PROBE_NSA == 2 + pass) tt0 = __builtin_amdgcn_s_memrealtime();
                const int jlo = pass ? (x >= 4 ? x - 4 : 0) : 0;
                const unsigned inrange = (x >= 31 ? 0xffffffffu : ((2u << x) - 1u)) & ~((1u << jlo) - 1u);
                unsigned bmask = pass ? inrange : (*umask & inrange);
                const bf16* Kb = pass ? KW : KS; const int cg = (pass ? 10 : 8) + g;
                unsigned tm[2], wm[2], am[2];
#pragma unroll
                for (int mt = 0; mt < 2; ++mt) {
                    tm[mt] = pass ? 0xffffffffu : msk[wid * 8 + 4 * mt + (fr >> 2)];
                    wm[mt] = pass ? 0xffffffffu : (msk[wid * 8 + 4 * mt] | msk[wid * 8 + 4 * mt + 1] | msk[wid * 8 + 4 * mt + 2] | msk[wid * 8 + 4 * mt + 3]);
                    am[mt] = pass ? 0xffffffffu : (msk[wid * 8 + 4 * mt] & msk[wid * 8 + 4 * mt + 1] & msk[wid * 8 + 4 * mt + 2] & msk[wid * 8 + 4 * mt + 3]);
                    wm[mt] = __builtin_amdgcn_readfirstlane(wm[mt]); am[mt] = __builtin_amdgcn_readfirstlane(am[mt]);
                    if (PROBE_NSAX == 2 && dummy) wm[mt] = 0u;
                }
                f32x4 o[2][4]; float mrun[2], lrun[2];
#pragma unroll
                for (int mt = 0; mt < 2; ++mt) { mrun[mt] = -INFINITY; lrun[mt] = 0.f;
#pragma unroll
                    for (int n = 0; n < 4; ++n) o[mt][n] = (f32x4){0.f, 0.f, 0.f, 0.f}; }
                const int srow = tid >> 3, sc16 = tid & 7;
                u32x4 pk0 = (u32x4){0u, 0u, 0u, 0u}, pv0 = pk0, pk1 = pk0, pv1 = pk0;
#define NSA_LD(jx, pk, pv) do { const bf16* ksrc = Kb + ((size_t)b * S + 64 * (jx) + srow) * 128 + g * 64 + sc16 * 8; const bf16* vsrc = VTA + ((size_t)((b * 32 + (jx)) * 12 + cg)) * 4096 + srow * 64 + sc16 * 8; \
                    pk = *(const u32x4*)ksrc; pv = *(const u32x4*)vsrc; } while (0)
                int j0 = __ffs(bmask) - 1; bmask &= bmask - 1u;
                int j1 = bmask ? __ffs(bmask) - 1 : -1; bmask &= bmask - 1u;
                NSA_LD(j0, pk0, pv0); if (j1 >= 0) NSA_LD(j1, pk1, pv1);
                int buf = 0;
                while (j0 >= 0) {
                    *(LAS u32x4*)(ktl + (buf * 2 + 0) * 64 * RS + srow * RS + sc16 * 8) = pk0; *(LAS u32x4*)(vtl + (buf * 2 + 0) * 64 * RS + srow * RS + sc16 * 8) = pv0;
                    if (j1 >= 0) { *(LAS u32x4*)(ktl + (buf * 2 + 1) * 64 * RS + srow * RS + sc16 * 8) = pk1; *(LAS u32x4*)(vtl + (buf * 2 + 1) * 64 * RS + srow * RS + sc16 * 8) = pv1; }
                    const int jn0 = bmask ? __ffs(bmask) - 1 : -1; bmask &= bmask - 1u;
                    const int jn1 = bmask ? __ffs(bmask) - 1 : -1; bmask &= bmask - 1u;
                    if (jn0 >= 0) NSA_LD(jn0, pk0, pv0);
                    if (jn1 >= 0) NSA_LD(jn1, pk1, pv1);
                    __syncthreads();
#pragma unroll 1
                    for (int sub = 0; sub < 2; ++sub) {
                        const int j = sub ? j1 : j0;
                        if (j < 0) break;
                        const LAS bf16* kt = ktl + (buf * 2 + sub) * 64 * RS + fr * RS + 8 * fq; const LAS bf16* vt = vtl + (buf * 2 + sub) * 64 * RS + fr * RS + 8 * fq;
                        const bool nd0 = (wm[0] >> j) & 1u, nd1 = (wm[1] >> j) & 1u;
                        if (!(nd0 || nd1)) continue;
                        const bool edge = (j == x) || (pass && j == x - 4);
                        f32x4 sc0[4], sc1[4];
#pragma unroll
                        for (int t = 0; t < 4; ++t) { sc0[t] = (f32x4){0.f, 0.f, 0.f, 0.f}; sc1[t] = (f32x4){0.f, 0.f, 0.f, 0.f};
                            const bf16x8 k0_ = *(const LAS bf16x8*)(kt + t * 16 * RS), k1_ = *(const LAS bf16x8*)(kt + t * 16 * RS + 32);
                            if (nd0) { sc0[t] = __builtin_amdgcn_mfma_f32_16x16x32_bf16(k0_, qf[0][0], sc0[t], 0, 0, 0); sc0[t] = __builtin_amdgcn_mfma_f32_16x16x32_bf16(k1_, qf[0][1], sc0[t], 0, 0, 0); }
                            if (nd1) { sc1[t] = __builtin_amdgcn_mfma_f32_16x16x32_bf16(k0_, qf[1][0], sc1[t], 0, 0, 0); sc1[t] = __builtin_amdgcn_mfma_f32_16x16x32_bf16(k1_, qf[1][1], sc1[t], 0, 0, 0); } }
                        bf16x8 pf0[2], pf1[2];
                        if (nd0) nsa_softmax(sc0, pf0, mrun[0], lrun[0], o[0], (tm[0] >> j) & 1u, edge, j == x ? tl0 : 63, (pass && j == x - 4) ? tl0 + 1 : 0, (am[0] >> j) & 1u, fq);
                        if (nd1) nsa_softmax(sc1, pf1, mrun[1], lrun[1], o[1], (tm[1] >> j) & 1u, edge, j == x ? tl0 + 4 : 63, (pass && j == x - 4) ? tl0 + 5 : 0, (am[1] >> j) & 1u, fq);
#pragma unroll
                        for (int n = 0; n < 4; ++n) {
                            const bf16x8 v0_ = *(const LAS bf16x8*)(vt + n * 16 * RS), v1_ = *(const LAS bf16x8*)(vt + n * 16 * RS + 32);
                            if (nd0) { o[0][n] = __builtin_amdgcn_mfma_f32_16x16x32_bf16(v0_, pf0[0], o[0][n], 0, 0, 0); o[0][n] = __builtin_amdgcn_mfma_f32_16x16x32_bf16(v1_, pf0[1], o[0][n], 0, 0, 0); }
                            if (nd1) { o[1][n] = __builtin_amdgcn_mfma_f32_16x16x32_bf16(v0_, pf1[0], o[1][n], 0, 0, 0); o[1][n] = __builtin_amdgcn_mfma_f32_16x16x32_bf16(v1_, pf1[1], o[1][n], 0, 0, 0); } }
                    }
                    j0 = jn0; j1 = jn1; buf ^= 1;
                }
#undef NSA_LD
#pragma unroll
                for (int mt = 0; mt < 2; ++mt) { const float sc_ = (pass ? g2v[mt] : g1v[mt]) / lrun[mt];
                    if (!dummy) {
#pragma unroll
                    for (int n = 0; n < 4; ++n) outacc[mt][n] = outacc[mt][n] + o[mt][n] * sc_; } }
                __syncthreads();
                if (PROBE_NSA == 2 + pass) tsub += __builtin_amdgcn_s_memrealtime() - tt0;
            }
#pragma unroll
            for (int mt = 0; mt < 2; ++mt) {
                bf16* dst = CAT + (tokbase + tl0 + 4 * mt) * 1024 + (g * 4 + (fr & 3)) * 64 + 4 * fq;
#pragma unroll
                for (int n = 0; n < 4; ++n) { u32x2 w; w.x = pk2(outacc[mt][n].x, outacc[mt][n].y); w.y = pk2(outacc[mt][n].z, outacc[mt][n].w); *(u32x2*)(dst + 16 * n) = w; }
            }
        }
    }
    __syncthreads();
    if (PROBE_NSA && blockIdx.x == 0 && opaque_tid(wv_) == 0) atomicAdd((unsigned long long*)(ws + WS_CTL + 48000), tsub);
}

__device__ __forceinline__ void phase_vtiles(KArgs A, int wv_, LAS unsigned char* lds) {
    const int tid_ = opaque_tid(wv_); const int wid = __builtin_amdgcn_readfirstlane(tid_ >> 6), lane = tid_ & 63; const int gw = blockIdx.x * 8 + wid, NGW = gridDim.x * 8;
    unsigned char* ws = opq(A->ws);
    const bf16* HY = (const bf16*)(ws + WS_BIG); bf16* VTA = (bf16*)(ws + WS_VTA);
    constexpr int TS = 66;
    LAS bf16* tl = (LAS bf16*)(lds + 65536) + wid * (64 * TS);
    for (int it = gw; it < NBATCH * 32 * 12; it += NGW) {
        const int cg = it % 12, bc = it / 12;
        const int colbase = cg < 8 ? C_VB + cg * 64 : (cg < 10 ? C_VS + (cg - 8) * 64 : C_VW + (cg - 10) * 64);
        const u32x4* src = (const u32x4*)(HY + (size_t)(bc * 64 + lane) * HYN + colbase);
        u32x4 w[8];
#pragma unroll
        for (int i = 0; i < 8; ++i) w[i] = src[i];
#pragma unroll
        for (int i = 0; i < 8; ++i) { LAS unsigned* d = (LAS unsigned*)(tl + lane * TS + 8 * i); d[0] = w[i].x; d[1] = w[i].y; d[2] = w[i].z; d[3] = w[i].w; }
        LDS_WAIT();
        bf16* dst = VTA + (size_t)it * 4096 + lane * 64;
#pragma unroll
        for (int p8 = 0; p8 < 8; ++p8) {
            unsigned short x[8];
#pragma unroll
            for (int j = 0; j < 8; ++j) x[j] = tl[kperm64(p8 * 8 + j) * TS + lane];
            u32x4 o; o.x = x[0] | ((unsigned)x[1] << 16); o.y = x[2] | ((unsigned)x[3] << 16); o.z = x[4] | ((unsigned)x[5] << 16); o.w = x[6] | ((unsigned)x[7] << 16);
            *(u32x4*)(dst + p8 * 8) = o;
        }
        LDS_WAIT();
    }
}

__device__ __forceinline__ void vtrans_wave(KArgs A, int wv_, LAS bf16* tl, const int gw, const int NGW) {
    const int tid_ = opaque_tid(wv_); const int lane = tid_ & 63;
    unsigned char* ws = opq(A->ws);
    const bf16* KV = (const bf16*)(ws + WS_KV); bf16* VT = (bf16*)(ws + WS_VT);
    constexpr int TS = 66;
    for (int it = gw; it < DEPTH * NBATCH * 4 * 16; it += NGW) {
        const int db = it & 3, kb = (it >> 2) & 3, h = (it >> 4) & 3, b = (it >> 6) & 7, l = it >> 9;
        const u32x4* src = (const u32x4*)(KV + (size_t)(b * 256 + 64 * kb + lane) * 8192 + l * 2048 + 1024 + h * 256 + 64 * db);
        u32x4 w[8];
#pragma unroll
        for (int i = 0; i < 8; ++i) w[i] = src[i];
#pragma unroll
        for (int i = 0; i < 8; ++i) { LAS unsigned* d = (LAS unsigned*)(tl + lane * TS + 8 * i); d[0] = w[i].x; d[1] = w[i].y; d[2] = w[i].z; d[3] = w[i].w; }
        LDS_WAIT();
        bf16* dst = VT + ((size_t)((l * 8 + b) * 4 + h) * 256 + 64 * db + lane) * 256 + 64 * kb;
#pragma unroll
        for (int p8 = 0; p8 < 8; ++p8) {
            unsigned short x[8];
#pragma unroll
            for (int j = 0; j < 8; ++j) x[j] = tl[kperm64(p8 * 8 + j) * TS + lane];
            u32x4 o; o.x = x[0] | ((unsigned)x[1] << 16); o.y = x[2] | ((unsigned)x[3] << 16); o.z = x[4] | ((unsigned)x[5] << 16); o.w = x[6] | ((unsigned)x[7] << 16);
            *(u32x4*)(dst + p8 * 8) = o;
        }
        LDS_WAIT();
    }
}

__device__ __forceinline__ float log_sigmoid16(float z) { return (fminf(z, 0.f) - __logf(1.0f + __expf(-fabsf(z)))) * (1.f / 16.f); }
#define GLA_Z(tokv) ({ float z_ = bias; _Pragma("unroll") for (int r_ = 0; r_ < 16; ++r_) z_ += __builtin_bit_cast(float, __builtin_amdgcn_readlane(__builtin_bit_cast(int, al[r_]), (tokv))) * wc[r_]; z_; })
#define GLA_LOAD_GATE() \
    float al[16], wc[16]; \
    { const u32x4* ap_ = (const u32x4*)(HY + (size_t)(tok0 + lane) * HYN + C_AL); const u32x4 a0_ = ap_[0], a1_ = ap_[1]; \
      al[0] = bflo(a0_.x); al[1] = bfhi(a0_.x); al[2] = bflo(a0_.y); al[3] = bfhi(a0_.y); al[4] = bflo(a0_.z); al[5] = bfhi(a0_.z); al[6] = bflo(a0_.w); al[7] = bfhi(a0_.w); \
      al[8] = bflo(a1_.x); al[9] = bfhi(a1_.x); al[10] = bflo(a1_.y); al[11] = bfhi(a1_.y); al[12] = bflo(a1_.z); al[13] = bfhi(a1_.z); al[14] = bflo(a1_.w); al[15] = bfhi(a1_.w); } \
    _Pragma("unroll") for (int r_ = 0; r_ < 16; ++r_) wc[r_] = A->in[I_WA2][(i * 16 + r_) * 256 + h * 64 + lane]; \
    const float bias = A->in[I_BA][i * 256 + h * 64 + lane];

__device__ __forceinline__ void phase_gla_a(KArgs A, int wv_, int i, LAS unsigned char* lds) {
    const int tid_ = opaque_tid(wv_); const int wid = __builtin_amdgcn_readfirstlane(tid_ >> 6), lane = tid_ & 63, fr = lane & 15, fq = lane >> 4; const int gw = blockIdx.x * 8 + wid, NGW = gridDim.x * 8;
    unsigned char* ws = opq(A->ws);
    const bf16* HY = (const bf16*)(ws + WS_BIG); const bf16* VTA = (const bf16*)(ws + WS_VTA); float* SLOC = (float*)(ws + WS_SLOC); float* DEC = (float*)(ws + WS_DEC);
    constexpr int RS = 80;
    LAS bf16* kh = (LAS bf16*)lds + wid * (64 * RS);
    (void)gw;
    for (int it = wid * (int)gridDim.x + (int)blockIdx.x; it < 1024; it += NGW) {
        const int c = it & 31, bh = it >> 5, b = bh >> 2, h = bh & 3; const size_t tok0 = (size_t)b * S + c * 64;
        GLA_LOAD_GATE();
        float bl = 0.f; float la[64];
#pragma unroll
        for (int tk = 0; tk < 64; ++tk) { la[tk] = log_sigmoid16(GLA_Z(tk)); bl += la[tk]; }
        float bc = 0.f;
        unsigned short kcol[64];
#pragma unroll
        for (int tk = 0; tk < 64; ++tk) kcol[tk] = HY[(tok0 + tk) * HYN + C_KB + h * 64 + lane];
#pragma unroll
        for (int tk = 0; tk < 64; ++tk) {
            bc += la[tk];
            kh[lane * RS + kpos64(tk)] = (bf16)f2bf(bf2f(kcol[tk]) * __expf(bl - bc));
        }
        DEC[it * 64 + lane] = __expf(bl);
        LDS_WAIT();
#pragma unroll
        for (int dvh = 0; dvh < 2; ++dvh) {
            const bf16* vt = VTA + ((size_t)((b * 32 + c) * 12 + h * 2 + dvh)) * 4096;
            bf16x8 vf[4][2];
#pragma unroll
            for (int n = 0; n < 4; ++n)
#pragma unroll
                for (int s = 0; s < 2; ++s) vf[n][s] = *(const bf16x8*)(vt + (16 * n + fr) * 64 + 32 * s + 8 * fq);
#pragma unroll
            for (int m = 0; m < 4; ++m) {
                const bf16x8 a0 = *(const LAS bf16x8*)(kh + (16 * m + fr) * RS + 8 * fq), a1 = *(const LAS bf16x8*)(kh + (16 * m + fr) * RS + 32 + 8 * fq);
#pragma unroll
                for (int n = 0; n < 4; ++n) {
                    f32x4 acc = (f32x4){0.f, 0.f, 0.f, 0.f};
                    acc = __builtin_amdgcn_mfma_f32_16x16x32_bf16(vf[n][0], a0, acc, 0, 0, 0);
                    acc = __builtin_amdgcn_mfma_f32_16x16x32_bf16(vf[n][1], a1, acc, 0, 0, 0);
                    *(f32x4*)(SLOC + ((size_t)it * 64 + 16 * m + fr) * 128 + dvh * 64 + 16 * n + 4 * fq) = acc;
                }
            }
        }
        LDS_WAIT();
    }
}
__device__ __forceinline__ void phase_gla_c(KArgs A, int wv_, int i, LAS unsigned char* lds, const bool kv_post, const int Lcur) {
    const int tid_ = opaque_tid(wv_); const int wid = __builtin_amdgcn_readfirstlane(tid_ >> 6), lane = tid_ & 63, fr = lane & 15, fq = lane >> 4; const int gw = blockIdx.x * 8 + wid, NGW = gridDim.x * 8;
    unsigned char* ws = opq(A->ws);
    const bf16* HY = (const bf16*)(ws + WS_BIG); const bf16* VTA = (const bf16*)(ws + WS_VTA); const bf16* STT = (const bf16*)(ws + WS_STT); bf16* CAT = (bf16*)(ws + WS_CAT);
    constexpr int RS = 80;
    LAS bf16* qs = (LAS bf16*)lds + wid * (128 * RS);
    LAS bf16* ks = qs + 64 * RS;
    const float* og = A->in[I_ONORM] + i * 128;
    LAS unsigned* wq = (LAS unsigned*)(lds + 152064 + 1024);
    LAS float* ogl = (LAS float*)(lds + 152064);
    if (tid_ < 128) ogl[tid_] = og[tid_];
    (void)gw; (void)NGW;
    for (int blk = blockIdx.x; blk < 256; blk += gridDim.x) {
        if (tid_ == 0) *wq = 0u;
        SUBT_BEGIN(1);
        {
            const float* SLOC = (const float*)(ws + WS_SLOC); const float* DEC = (const float*)(ws + WS_DEC); bf16* STw = (bf16*)(ws + WS_STT);
            const int tid = tid_, dv = tid & 127, ko = tid >> 7, bh = blk >> 3, c0 = (blk & 7) * 4;
            float sv[16];
#pragma unroll
            for (int j = 0; j < 16; ++j) sv[j] = 0.f;
#pragma unroll 1
            for (int cb = 0; cb < c0 + 4; cb += 4) {
                float dc4[4][16], sl4[4][16];
#pragma unroll
                for (int q = 0; q < 4; ++q) {
                    const size_t item = (size_t)bh * 32 + cb + q; const float* sl = SLOC + (item * 64 + ko * 16) * 128 + dv; const float* dc = DEC + item * 64 + ko * 16;
#pragma unroll
                    for (int j = 0; j < 16; ++j) { dc4[q][j] = dc[j]; sl4[q][j] = sl[j * 128]; }
                }
#pragma unroll
                for (int q = 0; q < 4; ++q) {
                    const int c = cb + q; const size_t item = (size_t)bh * 32 + c;
                    if (c >= c0) {
                        u32x4 o0, o1; o0.x = pk2(sv[0], sv[1]); o0.y = pk2(sv[2], sv[3]); o0.z = pk2(sv[4], sv[5]); o0.w = pk2(sv[6], sv[7]);
                        o1.x = pk2(sv[8], sv[9]); o1.y = pk2(sv[10], sv[11]); o1.z = pk2(sv[12], sv[13]); o1.w = pk2(sv[14], sv[15]);
                        u32x4* d = (u32x4*)(STw + (item * 128 + dv) * 64 + ko * 16); d[0] = o0; d[1] = o1;
                    }
#pragma unroll
                    for (int j = 0; j < 16; ++j) sv[j] = dc4[q][j] * sv[j] + sl4[q][j];
                }
            }
            asm volatile("s_waitcnt vmcnt(0)" ::: "memory");
            __syncthreads();
        }
        SUBT_END(1, ws, tid_);
        SUBT_BEGIN(2);
        SUBT_BEGIN(3);
        if (wid < 4) {
        const int it = blk * 4 + wid;
        const int c = it & 31, bh = it >> 5, b = bh >> 2, h = bh & 3; const size_t tok0 = (size_t)b * S + c * 64;
        GLA_LOAD_GATE();
        float bc = 0.f;
        unsigned short qcol[64], kcol[64];
#pragma unroll
        for (int tk = 0; tk < 64; ++tk) { const bf16* row = HY + (tok0 + tk) * HYN; qcol[tk] = row[C_QB + h * 64 + lane]; kcol[tk] = row[C_KB + h * 64 + lane]; }
#pragma unroll
        for (int tk = 0; tk < 64; ++tk) {
            bc += log_sigmoid16(GLA_Z(tk));
            const float eb = __expf(bc);
            qs[tk * RS + lane] = (bf16)f2bf(bf2f(qcol[tk]) * 0.125f * eb); ks[tk * RS + lane] = (bf16)f2bf(bf2f(kcol[tk]) / eb);
        }
        LDS_WAIT();
        SUBT_END(2, ws, tid_);
        bf16x8 st[8][2];
#pragma unroll
        for (int n = 0; n < 8; ++n)
#pragma unroll
            for (int s = 0; s < 2; ++s) st[n][s] = *(const bf16x8*)(STT + ((size_t)it * 128 + 16 * n + fr) * 64 + 32 * s + 8 * fq);
        const bf16* vt = VTA + ((size_t)((b * 32 + c) * 12 + h * 2)) * 4096;
        bf16x8 vfr[8];
#pragma unroll
        for (int n = 0; n < 8; ++n) { const bf16* vrow = vt + (size_t)(n >> 2) * 4096 + (16 * (n & 3) + fr) * 64 + 8 * fq; vfr[n] = *(const bf16x8*)vrow; }
#pragma unroll
        for (int mi = 0; mi < 4; ++mi) {
            const bf16x8 q0 = *(const LAS bf16x8*)(qs + (16 * mi + fr) * RS + 8 * fq), q1 = *(const LAS bf16x8*)(qs + (16 * mi + fr) * RS + 32 + 8 * fq);
            u32x2 rwv[8];
#pragma unroll
            for (int n = 0; n < 8; ++n) rwv[n] = *(const u32x2*)(HY + (tok0 + 16 * mi + fr) * HYN + C_RB + h * 128 + 16 * n + 4 * fq);
            f32x4 sc[4];
#pragma unroll
            for (int t = 0; t < 4; ++t) {
                sc[t] = (f32x4){0.f, 0.f, 0.f, 0.f};
                if (t <= mi) {
                    const bf16x8 k0 = *(const LAS bf16x8*)(ks + (16 * t + fr) * RS + 8 * fq), k1 = *(const LAS bf16x8*)(ks + (16 * t + fr) * RS + 32 + 8 * fq);
                    sc[t] = __builtin_amdgcn_mfma_f32_16x16x32_bf16(k0, q0, sc[t], 0, 0, 0);
                    sc[t] = __builtin_amdgcn_mfma_f32_16x16x32_bf16(k1, q1, sc[t], 0, 0, 0);
                    if (t == mi) {
                        sc[t].x = (4 * fq + 0 <= fr) ? sc[t].x : 0.f; sc[t].y = (4 * fq + 1 <= fr) ? sc[t].y : 0.f; sc[t].z = (4 * fq + 2 <= fr) ? sc[t].z : 0.f; sc[t].w = (4 * fq + 3 <= fr) ? sc[t].w : 0.f; }
                }
            }
            bf16x8 pf[2];
#pragma unroll
            for (int s = 0; s < 2; ++s) { u32x4 w; w.x = pk2(sc[2 * s].x, sc[2 * s].y); w.y = pk2(sc[2 * s].z, sc[2 * s].w); w.z = pk2(sc[2 * s + 1].x, sc[2 * s + 1].y); w.w = pk2(sc[2 * s + 1].z, sc[2 * s + 1].w);
                pf[s] = __builtin_bit_cast(bf16x8, w); }
            f32x4 o[8]; float ssq = 0.f;
#pragma unroll
            for (int n = 0; n < 8; ++n) {
                o[n] = (f32x4){0.f, 0.f, 0.f, 0.f};
                o[n] = __builtin_amdgcn_mfma_f32_16x16x32_bf16(st[n][0], q0, o[n], 0, 0, 0);
                o[n] = __builtin_amdgcn_mfma_f32_16x16x32_bf16(st[n][1], q1, o[n], 0, 0, 0);
                o[n] = __builtin_amdgcn_mfma_f32_16x16x32_bf16(vfr[n], pf[0], o[n], 0, 0, 0);
                if (mi >= 2) o[n] = __builtin_amdgcn_mfma_f32_16x16x32_bf16(*(const bf16x8*)(vt + (size_t)(n >> 2) * 4096 + (16 * (n & 3) + fr) * 64 + 8 * fq + 32), pf[1], o[n], 0, 0, 0);
                ssq += (o[n].x * o[n].x + o[n].y * o[n].y) + (o[n].z * o[n].z + o[n].w * o[n].w);
            }
            ssq = xadd32(xadd16(ssq));
            const float rstd = rsqrtf(ssq * (1.f / 128.f) + EPS);
            const size_t tok = tok0 + 16 * mi + fr;
#pragma unroll
            for (int n = 0; n < 8; ++n) {
                const int dv = 16 * n + 4 * fq;
                const u32x2 rw = rwv[n]; const f32x4 g = *(const LAS f32x4*)(ogl + dv);
                const float r0 = bflo(rw.x), r1 = bfhi(rw.x), r2 = bflo(rw.y), r3 = bfhi(rw.y);
                u32x2 w; w.x = pk2(o[n].x * rstd * g.x * (r0 * sigmoidf_(r0)), o[n].y * rstd * g.y * (r1 * sigmoidf_(r1)));
                w.y = pk2(o[n].z * rstd * g.z * (r2 * sigmoidf_(r2)), o[n].w * rstd * g.w * (r3 * sigmoidf_(r3)));
                *(u32x2*)(CAT + tok * 1024 + 512 + h * 128 + dv) = w;
            }
        }
        } else {
            if (kv_post) {
                phase_knorm(A, wv_, blk * 4 + (wid - 4), 256 * 4);
                vtrans_wave(A, wv_, (LAS bf16*)(lds + 81920 + (wid - 4) * 16640), blk * 4 + (wid - 4), 256 * 4);
            }
            moe_weight_share(A, wv_, (LAS float*)(lds + 81920 + (wid - 4) * 16640), wq, Lcur, blk);
        }
        if (wid < 4) { LDS_WAIT(); moe_weight_share(A, wv_, (LAS float*)(lds + wid * 20480), wq, Lcur, blk); }
        SUBT_END(3, ws, tid_);
        LDS_WAIT();
        __syncthreads();
    }
}

__device__ __forceinline__ void phase_sgu_mix_mfma(KArgs A, int wv_, int i, LAS unsigned char* lds) {
    const int tid = opaque_tid(wv_), wid = __builtin_amdgcn_readfirstlane(tid >> 6), lane = tid & 63, fr = lane & 15, fq = lane >> 4;
    unsigned char* ws = opq(A->ws);
    const bf16* U = (const bf16*)(ws + WS_U); const bf16* V = (const bf16*)(ws + WS_V); bf16* UM = (bf16*)(ws + WS_UM);
    const bf16* WSB = (const bf16*)(ws + WS_WSB) + (size_t)i * 8 * 16384; const float* M0 = (const float*)(ws + WS_M0) + i * 8 * 128;
    constexpr int VS = 144;
    LAS bf16* vT = (LAS bf16*)lds;
    LAS float* st = (LAS float*)(lds + 256 * VS * 2);
    LAS bf16* wl = (LAS bf16*)(lds + 256 * VS * 2 + 1024);
    const float* lng = A->in[I_LNG] + i * 2048; const float* lnb = A->in[I_LNB] + i * 2048; const float* bsg = A->in[I_SGBS] + i * 8 * 128;
    for (int it = blockIdx.x; it < 256; it += gridDim.x) {
        const int gh = it & 1, n_ = (it >> 1) & 15, b = it >> 5; const size_t tok0 = (size_t)b * S + n_ * 128;
        __syncthreads();
        {
            const float* vst = (const float*)(ws + WS_VSTAT);
#pragma unroll
            for (int s4 = 0; s4 < 16; s4 += 4) {
                const int s = wid * 16 + s4 + (lane >> 4);
                const f32x4 p = *(const f32x4*)(vst + (tok0 + s) * 64 + 4 * (lane & 15));
                float sum = p.x + p.z, sq = p.y + p.w;
                sum += __shfl_xor(sum, 1); sq += __shfl_xor(sq, 1); sum += __shfl_xor(sum, 2); sq += __shfl_xor(sq, 2);
                sum += __shfl_xor(sum, 4); sq += __shfl_xor(sq, 4); sum += __shfl_xor(sum, 8); sq += __shfl_xor(sq, 8);
                const float mean = sum * (1.f / 2048.f); const float var = fmaxf(sq * (1.f / 2048.f) - mean * mean, 0.f);
                if ((lane & 15) == 0) { st[2 * s] = mean; st[2 * s + 1] = rsqrtf(var + EPS); }
            }
        }
#pragma unroll 1
        for (int gg = 0; gg < 4; ++gg) {
            const int g = gh * 4 + gg;
            __syncthreads();
            {
                const int s = tid & 127, cq = tid >> 7;
                const float mean = st[2 * s], rstd = st[2 * s + 1];
                const u32x4* src = (const u32x4*)(V + (tok0 + s) * 2048 + g * 256 + cq * 64);
                u32x4 w8[8], ww[4];
#pragma unroll
                for (int i8 = 0; i8 < 8; ++i8) w8[i8] = src[i8];
#pragma unroll
                for (int q = 0; q < 4; ++q) { const int e = tid + 512 * q; ww[q] = *(const u32x4*)(WSB + ((size_t)g * 128 + (e >> 4)) * 128 + (e & 15) * 8); }
#pragma unroll
                for (int i8 = 0; i8 < 8; ++i8) {
                    const u32x4 w = w8[i8];
                    LAS bf16* d = vT + (cq * 64 + i8 * 8) * VS + s;
                    d[0 * VS] = (bf16)f2bf((bflo(w.x) - mean) * rstd); d[1 * VS] = (bf16)f2bf((bfhi(w.x) - mean) * rstd); d[2 * VS] = (bf16)f2bf((bflo(w.y) - mean) * rstd); d[3 * VS] = (bf16)f2bf((bfhi(w.y) - mean) * rstd);
                    d[4 * VS] = (bf16)f2bf((bflo(w.z) - mean) * rstd); d[5 * VS] = (bf16)f2bf((bfhi(w.z) - mean) * rstd); d[6 * VS] = (bf16)f2bf((bflo(w.w) - mean) * rstd); d[7 * VS] = (bf16)f2bf((bfhi(w.w) - mean) * rstd);
                }
#pragma unroll
                for (int q = 0; q < 4; ++q) { const int e = tid + 512 * q; *(LAS u32x4*)(wl + (e >> 4) * VS + (e & 15) * 8) = ww[q]; }
            }
            u32x2 uw[8][2]; float m0v[8], bsv[8];
#pragma unroll
            for (int n = 0; n < 8; ++n) { const int t = 16 * n + fr; m0v[n] = M0[g * 128 + t]; bsv[n] = bsg[g * 128 + t];
                const size_t ro = (tok0 + t) * 2048 + g * 256 + 32 * wid + 4 * fq; uw[n][0] = *(const u32x2*)(U + ro); uw[n][1] = *(const u32x2*)(U + ro + 16); }
            __syncthreads();
            bf16x8 vf[2][4];
#pragma unroll
            for (int m = 0; m < 2; ++m)
#pragma unroll
                for (int k = 0; k < 4; ++k) vf[m][k] = *(const LAS bf16x8*)(vT + (32 * wid + 16 * m + fr) * VS + 32 * k + 8 * fq);
            f32x4 gc[2], bc[2];
#pragma unroll
            for (int m = 0; m < 2; ++m) { gc[m] = *(const f32x4*)(lng + g * 256 + 32 * wid + 16 * m + 4 * fq); bc[m] = *(const f32x4*)(lnb + g * 256 + 32 * wid + 16 * m + 4 * fq); }
#pragma unroll
            for (int n = 0; n < 8; ++n) {
                f32x4 a0 = (f32x4){0.f, 0.f, 0.f, 0.f}, a1 = (f32x4){0.f, 0.f, 0.f, 0.f};
#pragma unroll
                for (int k = 0; k < 4; ++k) if (k <= (n >> 1)) {
                    const bf16x8 wf = *(const LAS bf16x8*)(wl + (16 * n + fr) * VS + 32 * k + 8 * fq);
                    a0 = __builtin_amdgcn_mfma_f32_16x16x32_bf16(vf[0][k], wf, a0, 0, 0, 0);
                    a1 = __builtin_amdgcn_mfma_f32_16x16x32_bf16(vf[1][k], wf, a1, 0, 0, 0); }
                const int t = 16 * n + fr; const float m0 = m0v[n], bsv_ = bsv[n];
                const size_t ro = (tok0 + t) * 2048 + g * 256 + 32 * wid + 4 * fq;
#pragma unroll
                for (int m = 0; m < 2; ++m) {
                    const f32x4 a = m ? a1 : a0;
                    const u32x2 uw_ = uw[n][m];
                    u32x2 w; w.x = pk2((a.x * gc[m].x + bc[m].x * m0 + bsv_) * bflo(uw_.x), (a.y * gc[m].y + bc[m].y * m0 + bsv_) * bfhi(uw_.x));
                    w.y = pk2((a.z * gc[m].z + bc[m].z * m0 + bsv_) * bflo(uw_.y), (a.w * gc[m].w + bc[m].w * m0 + bsv_) * bfhi(uw_.y));
                    *(u32x2*)(UM + ro + 16 * m) = w;
                }
            }
        }
    }
    __syncthreads();
}

__device__ __forceinline__ void xattn_item(KArgs A, int wv_, int L, LAS unsigned char* lds, const int b, const int h, const int qt) {
    const int tid = opaque_tid(wv_), wid = __builtin_amdgcn_readfirstlane(tid >> 6), lane = tid & 63, fr = lane & 15, fq = lane >> 4;
    unsigned char* ws = opq(A->ws);
    const bf16* QX = (const bf16*)(ws + WS_QX); const bf16* KV = (const bf16*)(ws + WS_KV); const bf16* VT = (const bf16*)(ws + WS_VT); bf16* OX = (bf16*)(ws + WS_OX);
    constexpr int RS = 272;
    LAS bf16* kl = (LAS bf16*)lds;
    const float* qg = A->in[I_XQN] + L * 256;
    {
        __syncthreads();
        {
            const int row = tid >> 1, hf = tid & 1;
            const u32x4* src = (const u32x4*)(KV + (size_t)(b * 256 + row) * 8192 + L * 2048 + h * 256 + hf * 128);
#pragma unroll
            for (int i0 = 0; i0 < 16; i0 += 8) {
                u32x4 w[8];
#pragma unroll
                for (int i = 0; i < 8; ++i) w[i] = src[i0 + i];
#pragma unroll
                for (int i = 0; i < 8; ++i) *(LAS u32x4*)(kl + row * RS + hf * 128 + (i0 + i) * 8) = w[i];
            }
        }
        const size_t tok0 = (size_t)b * S + qt * 256 + wid * 32 + fr;
        u32x4 qw0[8], qw1[8];
#pragma unroll
        for (int s = 0; s < 8; ++s) { qw0[s] = *(const u32x4*)(QX + tok0 * 1024 + h * 256 + 32 * s + 8 * fq); qw1[s] = *(const u32x4*)(QX + (tok0 + 16) * 1024 + h * 256 + 32 * s + 8 * fq); }
        __syncthreads();
        bf16x8 pf0[8], pf1[8]; float inv0, inv1;
        auto s_part = [&](const u32x4 (&qw)[8], bf16x8 (&pf)[8], float& inv) __attribute__((always_inline)) {
            float ssq = 0.f;
#pragma unroll
            for (int s = 0; s < 8; ++s) {
                const float a0 = bflo(qw[s].x), a1 = bfhi(qw[s].x), a2 = bflo(qw[s].y), a3 = bfhi(qw[s].y), a4 = bflo(qw[s].z), a5 = bfhi(qw[s].z), a6 = bflo(qw[s].w), a7 = bfhi(qw[s].w);
                ssq += (a0 * a0 + a1 * a1) + (a2 * a2 + a3 * a3) + (a4 * a4 + a5 * a5) + (a6 * a6 + a7 * a7);
            }
            ssq = xadd32(xadd16(ssq));
            const float rstd = rsqrtf(ssq * (1.f / 256.f) + EPS);
            bf16x8 qf[8];
#pragma unroll
            for (int s = 0; s < 8; ++s) qf[s] = __builtin_bit_cast(bf16x8, qw[s]);
            f32x4 sc[16];
#pragma unroll
            for (int hf = 0; hf < 2; ++hf) {
                unsigned kb = (unsigned)(size_t)(kl + (128 * hf + fr) * RS + 8 * fq); asm volatile("" : "+v"(kb));
#pragma unroll
                for (int t8 = 0; t8 < 8; ++t8) { const int t = 8 * hf + t8; sc[t] = (f32x4){0.f, 0.f, 0.f, 0.f};
#pragma unroll
                    for (int s = 0; s < 8; ++s) { const bf16x8 kf = *(const LAS bf16x8*)(size_t)(kb + (unsigned)((16 * t8 * RS + 32 * s) * 2));
                        sc[t] = __builtin_amdgcn_mfma_f32_16x16x32_bf16(kf, qf[s], sc[t], 0, 0, 0); }
                    if (t & 1) asm volatile("" ::: "memory"); }
            }
            float mx = -INFINITY;
#pragma unroll
            for (int t = 0; t < 16; ++t) mx = fmaxf(mx, fmaxf(fmaxf(sc[t].x, sc[t].y), fmaxf(sc[t].z, sc[t].w)));
            mx = xmax32(xmax16(mx));
            float lsum = 0.f;
#pragma unroll
            for (int t = 0; t < 16; ++t) { sc[t].x = __expf((sc[t].x - mx) * rstd); sc[t].y = __expf((sc[t].y - mx) * rstd); sc[t].z = __expf((sc[t].z - mx) * rstd); sc[t].w = __expf((sc[t].w - mx) * rstd); lsum += (sc[t].x + sc[t].y) + (sc[t].z + sc[t].w); }
            lsum = xadd32(xadd16(lsum));
            inv = 1.f / lsum;
#pragma unroll
            for (int s = 0; s < 8; ++s) { u32x4 w; w.x = pk2(sc[2 * s].x, sc[2 * s].y); w.y = pk2(sc[2 * s].z, sc[2 * s].w); w.z = pk2(sc[2 * s + 1].x, sc[2 * s + 1].y); w.w = pk2(sc[2 * s + 1].z, sc[2 * s + 1].w);
                pf[s] = __builtin_bit_cast(bf16x8, w); }
        };
        s_part(qw0, pf0, inv0);
        s_part(qw1, pf1, inv1);
        __syncthreads();
        {
            const int row = tid >> 1, hf = tid & 1;
            const u32x4* src = (const u32x4*)(VT + ((size_t)((L * 8 + b) * 4 + h) * 256 + (row & ~31) + pg8::perm32(row & 31)) * 256 + hf * 128);
#pragma unroll
            for (int i0 = 0; i0 < 16; i0 += 8) {
                u32x4 w[8];
#pragma unroll
                for (int i = 0; i < 8; ++i) w[i] = src[i0 + i];
#pragma unroll
                for (int i = 0; i < 8; ++i) *(LAS u32x4*)(kl + row * RS + hf * 128 + (i0 + i) * 8) = w[i];
            }
        }
        __syncthreads();
#pragma unroll
        for (int hf = 0; hf < 2; ++hf) {
            unsigned vb = (unsigned)(size_t)(kl + (128 * hf + fr) * RS + 8 * fq); asm volatile("" : "+v"(vb));
#pragma unroll
            for (int p4 = 0; p4 < 4; ++p4) { const int p = 4 * hf + p4; f32x4 o0a = (f32x4){0.f, 0.f, 0.f, 0.f}, o1a = o0a, o0b = o0a, o1b = o0a;
#pragma unroll
                for (int s = 0; s < 8; ++s) { const bf16x8 va = *(const LAS bf16x8*)(size_t)(vb + (unsigned)((32 * p4 * RS + 32 * s) * 2)), vc = *(const LAS bf16x8*)(size_t)(vb + (unsigned)(((32 * p4 + 16) * RS + 32 * s) * 2));
                    o0a = __builtin_amdgcn_mfma_f32_16x16x32_bf16(va, pf0[s], o0a, 0, 0, 0);
                    o1a = __builtin_amdgcn_mfma_f32_16x16x32_bf16(va, pf1[s], o1a, 0, 0, 0);
                    o0b = __builtin_amdgcn_mfma_f32_16x16x32_bf16(vc, pf0[s], o0b, 0, 0, 0);
                    o1b = __builtin_amdgcn_mfma_f32_16x16x32_bf16(vc, pf1[s], o1b, 0, 0, 0); }
                u32x4 w0, w1; w0.x = pk2(o0a.x * inv0, o0a.y * inv0); w0.y = pk2(o0a.z * inv0, o0a.w * inv0); w0.z = pk2(o0b.x * inv0, o0b.y * inv0); w0.w = pk2(o0b.z * inv0, o0b.w * inv0);
                w1.x = pk2(o1a.x * inv1, o1a.y * inv1); w1.y = pk2(o1a.z * inv1, o1a.w * inv1); w1.z = pk2(o1b.x * inv1, o1b.y * inv1); w1.w = pk2(o1b.z * inv1, o1b.w * inv1);
                st16_wt(wt_rsrc(OX), (unsigned)(tok0 * 1024 + h * 256 + 32 * p + 8 * fq) * 2u, w0);
                st16_wt(wt_rsrc(OX), (unsigned)((tok0 + 16) * 1024 + h * 256 + 32 * p + 8 * fq) * 2u, w1);
                asm volatile("" ::: "memory"); }
        }
    }
    __syncthreads();
}

__device__ __forceinline__ void phase_route_mfma(KArgs A, int wv_, int L, LAS unsigned char* lds) {
    const int tid = opaque_tid(wv_), wid = __builtin_amdgcn_readfirstlane(tid >> 6), lane = tid & 63, fr = lane & 15, fq = lane >> 4;
    unsigned char* ws = opq(A->ws);
    const float* RW = (const float*)(ws + WS_RW) + (size_t)L * NEXP * D;
    unsigned* cnt = (unsigned*)(ws + WS_CTL) + CW_CNT + L * 64;
    int* list = (int*)(ws + WS_LIST); int* te = (int*)(ws + WS_TOK); int* tp = te + 2 * T; float* tw = (float*)(tp + 2 * T);
    bf16* XN = (bf16*)(ws + WS_XN);
    constexpr int WSTR = 1040;
    LAS bf16* rwh = (LAS bf16*)lds;
    LAS bf16* rwl = rwh + 16 * WSTR;
    LAS float* xch = (LAS float*)(lds + 2 * 16 * WSTR * 2);
    LAS unsigned* lcnt = (LAS unsigned*)(lds + 2 * 16 * WSTR * 2 + 8 * 320 * 4);
    LAS unsigned* lbase = lcnt + 16;
    for (int e4 = tid; e4 < NEXP * D / 4; e4 += 512) {
        const f32x4 w = *(const f32x4*)(RW + 4 * e4);
        u32x2 h; h.x = pk2(w.x, w.y); h.y = pk2(w.z, w.w);
        u32x2 l; l.x = pk2(w.x - bflo(h.x), w.y - bfhi(h.x)); l.y = pk2(w.z - bflo(h.y), w.w - bfhi(h.y));
        const int e = (4 * e4) >> 10, k = (4 * e4) & 1023;
        *(LAS u32x2*)(rwh + e * WSTR + k) = h; *(LAS u32x2*)(rwl + e * WSTR + k) = l;
    }
    const int tg = wid >> 1, kh = wid & 1;
    const float rbv = A->in[I_RB][fr];
    for (int blk = blockIdx.x; blk < T / 64; blk += gridDim.x) {
        __syncthreads();
        if (tid < 16) lcnt[tid] = 0u;
        const size_t tok = (size_t)blk * 64 + 16 * tg + fr;
        const bf16* xrow = (const bf16*)(ws + WS_X16) + tok * D + 512 * kh + 8 * fq;
        f32x4 acc = (f32x4){0.f, 0.f, 0.f, 0.f}; float ssq = 0.f;
        bf16x8 ah[16];
#pragma unroll
        for (int s = 0; s < 16; ++s) ah[s] = *(const bf16x8*)(xrow + 32 * s);
#pragma unroll
        for (int s = 0; s < 16; ++s) {
            const u32x4 hw = __builtin_bit_cast(u32x4, ah[s]);
            const float x0 = bflo(hw.x), x1 = bfhi(hw.x), x2 = bflo(hw.y), x3 = bfhi(hw.y), x4 = bflo(hw.z), x5 = bfhi(hw.z), x6 = bflo(hw.w), x7 = bfhi(hw.w);
            ssq += ((x0 * x0 + x1 * x1) + (x2 * x2 + x3 * x3)) + ((x4 * x4 + x5 * x5) + (x6 * x6 + x7 * x7));
            const bf16x8 bh = *(const LAS bf16x8*)(rwh + fr * WSTR + 512 * kh + 32 * s + 8 * fq), bl = *(const LAS bf16x8*)(rwl + fr * WSTR + 512 * kh + 32 * s + 8 * fq);
            acc = __builtin_amdgcn_mfma_f32_16x16x32_bf16(ah[s], bh, acc, 0, 0, 0);
            acc = __builtin_amdgcn_mfma_f32_16x16x32_bf16(ah[s], bl, acc, 0, 0, 0);
        }
        ssq = xadd32(xadd16(ssq));
        LAS float* mine = xch + wid * 320; const LAS float* other = xch + (wid ^ 1) * 320;
#pragma unroll
        for (int r = 0; r < 4; ++r) mine[(4 * fq + r) * 20 + fr] = acc[r];
        if (fq == 0) mine[fr * 20 + 16] = ssq;
        __syncthreads();
        const float rstd = rsqrtf((ssq + other[fr * 20 + 16]) * (1.f / 1024.f) + EPS);
        {
            bf16* xo = XN + tok * D + 512 * kh + 8 * fq;
#pragma unroll
            for (int s = 0; s < 16; ++s) { const u32x4 hw = __builtin_bit_cast(u32x4, ah[s]);
                u32x4 o; o.x = pk2(bflo(hw.x) * rstd, bfhi(hw.x) * rstd); o.y = pk2(bflo(hw.y) * rstd, bfhi(hw.y) * rstd); o.z = pk2(bflo(hw.z) * rstd, bfhi(hw.z) * rstd); o.w = pk2(bflo(hw.w) * rstd, bfhi(hw.w) * rstd);
                *(u32x4*)(xo + 32 * s) = o; }
        }
        int e0r[4], e1r[4], r0r[4], r1r[4]; float w0r[4];
        if (kh == 0) {
#pragma unroll
            for (int r = 0; r < 4; ++r) {
                const float rs = __shfl(rstd, 4 * fq + r);
                const float lg = (acc[r] + other[(4 * fq + r) * 20 + fr]) * rs + rbv;
                float v0 = lg; v0 = fmaxf(v0, __shfl_xor(v0, 1)); v0 = fmaxf(v0, __shfl_xor(v0, 2)); v0 = fmaxf(v0, __shfl_xor(v0, 4)); v0 = fmaxf(v0, __shfl_xor(v0, 8));
                const unsigned long long bm0 = __ballot(lg == v0);
                const int e0 = __ffs((unsigned)(bm0 >> (16 * fq)) & 0xffffu) - 1;
                const bool c2 = (fr >> 2) == (e0 >> 2) && fr != e0;
                const float m2 = c2 ? lg : -INFINITY;
                float v1 = m2; v1 = fmaxf(v1, __shfl_xor(v1, 1)); v1 = fmaxf(v1, __shfl_xor(v1, 2)); v1 = fmaxf(v1, __shfl_xor(v1, 4)); v1 = fmaxf(v1, __shfl_xor(v1, 8));
                const unsigned long long bm1 = __ballot(c2 && m2 == v1);
                const int e1 = __ffs((unsigned)(bm1 >> (16 * fq)) & 0xffffu) - 1;
                e0r[r] = e0; e1r[r] = e1; w0r[r] = 1.f / (1.f + __expf(v1 - v0));
                r0r[r] = 0; r1r[r] = 0;
                if (fr == 0) { r0r[r] = (int)atomicAdd((unsigned*)(lcnt + e0), 1u); r1r[r] = (int)atomicAdd((unsigned*)(lcnt + e1), 1u); }
            }
        }
        __syncthreads();
        if (tid < 16) lbase[tid] = atomicAdd(&cnt[tid], lcnt[tid]);
        __syncthreads();
        if (kh == 0 && fr == 0) {
#pragma unroll
            for (int r = 0; r < 4; ++r) {
                const int t = blk * 64 + 16 * tg + 4 * fq + r;
                const int p0 = (int)lbase[e0r[r]] + r0r[r], p1 = (int)lbase[e1r[r]] + r1r[r];
                list[e0r[r] * T + p0] = t; list[e1r[r] * T + p1] = t;
                te[2 * t] = e0r[r]; te[2 * t + 1] = e1r[r]; tp[2 * t] = p0; tp[2 * t + 1] = p1; tw[2 * t] = w0r[r]; tw[2 * t + 1] = 1.f - w0r[r];
            }
        }
    }
    __syncthreads();
}

__device__ __forceinline__ void moe_offsets(KArgs A, int wv_, int L, LAS int* off, LAS int* cn) {
    const int t = opaque_tid(wv_);
    if (t < 64) {
        const unsigned* cnt = (const unsigned*)(opq(A->ws) + WS_CTL) + CW_CNT + L * 64;
        const int c = t < 16 ? (int)cnt[t] : 0;
        const int p = (c + 255) & ~255;
        int incl = p;
#pragma unroll
        for (int d = 1; d < 16; d <<= 1) { const int v = __shfl_up(incl, d); incl += (t & 15) >= d ? v : 0; }
        if (t < 16) { off[t] = incl - p; cn[t] = c; }
        if (t == 15) off[16] = incl;
    }
    __syncthreads();
}
__device__ __forceinline__ void phase_moe_combine(KArgs A, int wv_, int L, LAS unsigned char* lds) {
    LAS int* off = (LAS int*)lds; LAS int* cn = off + 32;
    moe_offsets(A, wv_, L, off, cn);
    const int tid_ = opaque_tid(wv_); const int wid = __builtin_amdgcn_readfirstlane(tid_ >> 6), lane = tid_ & 63; const int gw = blockIdx.x * 8 + wid, NGW = gridDim.x * 8;
    unsigned char* ws = opq(A->ws);
    const int* te = (const int*)(ws + WS_TOK); const int* tp = te + 2 * T; const float* tw = (const float*)(tp + 2 * T);
    const bf16* Y = (const bf16*)(ws + WS_Y); bf16* XN = (bf16*)(ws + WS_XN); bf16* X16 = (bf16*)(ws + WS_X16); const bool last = L == DEPTH - 1;
    const int nq = (T - gw + NGW - 1) / NGW;
    for (int q0 = 0; q0 < nq; q0 += 8) {
        int s0m = 0, s1m = 0; float w0m = 0.f, w1m = 0.f;
        { const int qq = q0 + (lane & 7); const int t = gw + NGW * (qq < nq ? qq : nq - 1);
          s0m = off[te[2 * t]] + tp[2 * t]; s1m = off[te[2 * t + 1]] + tp[2 * t + 1]; w0m = tw[2 * t]; w1m = tw[2 * t + 1]; }
        const int nn = nq - q0 < 8 ? nq - q0 : 8;
        f32x4 v[4]; u32x2 xv[4], xn[4], ya[4], yb[4], yan[4], ybn[4];
        { const int t = gw + NGW * q0; const int sl0 = __builtin_amdgcn_readlane(s0m, 0), sl1 = __builtin_amdgcn_readlane(s1m, 0);
#pragma unroll
          for (int j = 0; j < 4; ++j) { xv[j] = ((const u32x2*)(X16 + (size_t)t * D) + lane)[64 * j]; ya[j] = ((const u32x2*)(Y + (size_t)sl0 * D) + lane)[64 * j]; yb[j] = ((const u32x2*)(Y + (size_t)sl1 * D) + lane)[64 * j]; } }
#pragma unroll 1
        for (int q = 0; q < nn; ++q) {
            const int t = gw + NGW * (q0 + q);
            const int qn = q + 1 < nn ? q + 1 : q;
            { const int tn = gw + NGW * (q0 + qn); const int sl0 = __builtin_amdgcn_readlane(s0m, qn), sl1 = __builtin_amdgcn_readlane(s1m, qn);
#pragma unroll
              for (int j = 0; j < 4; ++j) { xn[j] = ((const u32x2*)(X16 + (size_t)tn * D) + lane)[64 * j]; yan[j] = ((const u32x2*)(Y + (size_t)sl0 * D) + lane)[64 * j]; ybn[j] = ((const u32x2*)(Y + (size_t)sl1 * D) + lane)[64 * j]; } }
            const float w0 = __builtin_bit_cast(float, __builtin_amdgcn_readlane(__builtin_bit_cast(int, w0m), q)), w1 = __builtin_bit_cast(float, __builtin_amdgcn_readlane(__builtin_bit_cast(int, w1m), q));
            float s = 0.f;
#pragma unroll
            for (int j = 0; j < 4; ++j) {
                v[j].x = bflo(xv[j].x) + w0 * bflo(ya[j].x) + w1 * bflo(yb[j].x); v[j].y = bfhi(xv[j].x) + w0 * bfhi(ya[j].x) + w1 * bfhi(yb[j].x); v[j].z = bflo(xv[j].y) + w0 * bflo(ya[j].y) + w1 * bflo(yb[j].y); v[j].w = bfhi(xv[j].y) + w0 * bfhi(ya[j].y) + w1 * bfhi(yb[j].y);
                s += (v[j].x * v[j].x + v[j].y * v[j].y) + (v[j].z * v[j].z + v[j].w * v[j].w);
            }
            const float rstd = rsqrtf(wave_sum(s) * (1.f / 1024.f) + EPS);
            u32x2* o8 = (u32x2*)(XN + (size_t)t * D) + lane;
            if (last) { f32x4* xr = (f32x4*)(A->out + (size_t)t * D) + lane;
#pragma unroll
                for (int j = 0; j < 4; ++j) xr[64 * j] = v[j]; }
            else { u32x2* xr = (u32x2*)(X16 + (size_t)t * D) + lane;
#pragma unroll
                for (int j = 0; j < 4; ++j) { u32x2 w; w.x = pk2(v[j].x, v[j].y); w.y = pk2(v[j].z, v[j].w); xr[64 * j] = w; } }
#pragma unroll
            for (int j = 0; j < 4; ++j) { u32x2 w; w.x = pk2(v[j].x * rstd, v[j].y * rstd); w.y = pk2(v[j].z * rstd, v[j].w * rstd); o8[64 * j] = w; }
#pragma unroll
            for (int j = 0; j < 4; ++j) { xv[j] = xn[j]; ya[j] = yan[j]; yb[j] = ybn[j]; }
        }
    }
}

constexpr int PH_PER_EVEN = 5 + 5, PH_PER_ODD = 3 + 5;
constexpr int NPHASES = 1 + 2 * (PH_PER_EVEN + PH_PER_ODD);

__global__ void __launch_bounds__(512, 2) mk_fwd(Args Araw) {
    KArgs A0 = kargs();
    extern __shared__ __attribute__((aligned(16))) unsigned char lds_raw[];
    LAS unsigned char* lds = (LAS unsigned char*)lds_raw;
    volatile LAS unsigned* misc = (volatile LAS unsigned*)(lds + LDS_MISC);
    const int tid = threadIdx.x;
    if (tid < 16) misc[tid] = 0u;
    __syncthreads();
    const int lo = A0->ph_lo, hi = A0->ph_hi;
    const int wv_ = __builtin_amdgcn_readfirstlane(threadIdx.x >> 6);
    if (hi - lo > 1) (void)xcd_barrier_post((unsigned*)(A0->ws + WS_CTL) + CW_BAR, misc);
    int ph = 0;
    unsigned long long tacc_ = 0;
#define PH_BEGIN(k) if (ph >= lo && ph < hi) { const bool tprobe_ = (PROBE_TMASK >> (k)) & 1; unsigned long long tp0_ = 0; if (PROBE_TMASK && tprobe_) tp0_ = __builtin_amdgcn_s_memrealtime(); KArgs A = kargs(); unsigned char* ws = opq(A->ws); _Pragma("unroll 1") for (int rep_ = 0; rep_ < (((PROBE_MASK >> (k)) & 1) ? PROBE_REPS : 1); ++rep_)
#define PH_END_(wb_)   if (ph + 1 < hi) { XcdBarrier b_; b_.bar = (unsigned*)(opq(kargs()->ws) + WS_CTL) + CW_BAR; b_.x = xb_xcc_id(); b_.st = misc; xcd_barrier(b_, opaque_tid(wv_) == 0, wb_); } if (PROBE_TMASK && tprobe_) tacc_ += __builtin_amdgcn_s_memrealtime() - tp0_; } ++ph;
#define PH_END PH_END_(true)
#define PH_END_WT PH_END_(false)
    const int G = gridDim.x, cb = blockIdx.x;

    PH_BEGIN(0) phase_prologue(A, wv_, lds); PH_END
    for (int L = 0; L < DEPTH; ++L) {
        const int i = L >> 1;
        if ((L & 1) == 0) {
            PH_BEGIN(3) {
                if (L == 0) {
                    pg8::DenseOrder S; S.init(NBATCH * NMEM, 8192, D, (const bf16*)(ws + WS_WKV), G, cb);
                    pg8::EpiBf16<0> E{(bf16*)(ws + WS_KV), 8192, 32, 0, nullptr, 0};
                    pg8::gemm_phase(lds, (const bf16*)(ws + WS_MN), D, S, E, wv_);
                }
                pg8::DenseOrder S; S.init(T, HYN, D, (const bf16*)(ws + WS_WHYB) + (size_t)i * HYN * D, G, cb);
                pg8::EpiBf16<0> E{(bf16*)(ws + WS_BIG), HYN, 12, 0, nullptr, 0};
                pg8::gemm_phase(lds, (const bf16*)(ws + WS_XN), D, S, E, wv_);
            } PH_END_WT
            PH_BEGIN(4) { const int t4_ = opaque_tid(wv_); SUBT_BEGIN(4); SUBT_END(4, ws, t4_); SUBT_BEGIN(5); phase_compress_mfma(A, wv_, i, lds); SUBT_END(5, ws, t4_); SUBT_BEGIN(6); phase_nsa_prep(A, wv_, i, lds); SUBT_END(6, ws, t4_); SUBT_BEGIN(7); phase_vtiles(A, wv_, lds); SUBT_END(7, ws, t4_); } PH_END
            PH_BEGIN(5) { phase_gla_a(A, wv_, i, lds); __syncthreads(); phase_nsa_attn_mfma(A, wv_, i, lds); } PH_END
            PH_BEGIN(6) phase_gla_c(A, wv_, i, lds, L == 0, L); PH_END
            PH_BEGIN(7) {
                pg8::DenseOrder S; S.init(T, D, D, (const bf16*)(ws + WS_WHOUT) + (size_t)i * D * D, G, cb);
                pg8::EpiResAddNorm E{(bf16*)(ws + WS_X16), D, (float*)(ws + WS_ROWSQ)};
                pg8::gemm_phase(lds, (const bf16*)(ws + WS_CAT), D, S, E, wv_);
            } PH_END
        } else {
            PH_BEGIN(8) {
                pg8::DenseOrder S; S.init(T, 4096, D, (const bf16*)(ws + WS_WSGIN) + (size_t)i * 4096 * D, G, cb);
                pg8::EpiBf16<1> E{(bf16*)(ws + WS_U), 2048, 8, (size_t)(WS_V - WS_U) / 2, (float*)(ws + WS_VSTAT), 8};
                pg8::gemm_phase(lds, (const bf16*)(ws + WS_XN), D, S, E, wv_);
            } PH_END
            PH_BEGIN(9) phase_sgu_mix_mfma(A, wv_, i, lds); PH_END
            PH_BEGIN(10) {
                pg8::DenseOrder S; S.init(T, D, 2048, (const bf16*)(ws + WS_WSGOUT) + (size_t)i * D * 2048, G, cb);
                pg8::EpiResAddNorm E{(bf16*)(ws + WS_X16), D, (float*)(ws + WS_ROWSQ)};
                pg8::gemm_phase(lds, (const bf16*)(ws + WS_UM), 2048, S, E, wv_);
            } PH_END
        }
        PH_BEGIN(12) {
            pg8::DenseOrder S; S.init(T, D, D, (const bf16*)(ws + WS_WQ) + (size_t)L * D * D, G, cb);
            pg8::EpiBf16RowScale E{(bf16*)(ws + WS_QX), D, (const float*)(ws + WS_ROWSQ)};
            pg8::gemm_phase(lds, (const bf16*)(ws + WS_X16), D, S, E, wv_);
            asm volatile("s_waitcnt vmcnt(0)" ::: "memory");
            __syncthreads();
            pg8::Unit u_;
#pragma unroll 1
            for (int ui_ = 0; S.next(ui_, u_); ++ui_) xattn_item(A, wv_, L, lds, u_.pm >> 3, u_.pn, u_.pm & 7);
        } PH_END_WT
        PH_BEGIN(14) {
            pg8::DenseOrder S; S.init(T, D, D, (const bf16*)(ws + WS_WO) + (size_t)L * D * D, G, cb);
            pg8::EpiResAdd E{(bf16*)(ws + WS_X16), D};
            pg8::gemm_phase(lds, (const bf16*)(ws + WS_OX), D, S, E, wv_);
        } PH_END_WT
        PH_BEGIN(15) phase_route_mfma(A, wv_, L, lds); PH_END
        PH_BEGIN(16) {
            LAS int* off = (LAS int*)(lds + pg8::STAGE_BYTES); LAS int* cn = off + 32;
            moe_offsets(A, wv_, L, off, cn);
            unsigned* rdy = (unsigned*)(ws + WS_CTL) + CW_RDY + L * 256;
            {
                pg8::MoeOrder<true, 1> S{(off[16] / 256) * 3, 3, G, cb, D, off, cn, (const int*)(ws + WS_LIST), (const char*)(ws + WS_WMIN) + (size_t)L * 16 * 768 * D * 2, (size_t)768 * D * 2, rdy, 3u};
                pg8::EpiSwiglu<true> E{(bf16*)(ws + WS_H), DEXP, (unsigned)(WS_H_BYTES)};
                pg8::gemm_phase(lds, (const bf16*)(ws + WS_XN), D, S, E, wv_);
            }
            {
                pg8::MoeOrder<false, 2> S{(off[16] / 256) * 4, 4, G, G - 1 - cb, DEXP, off, cn, (const int*)(ws + WS_LIST), (const char*)(ws + WS_WMOUT) + (size_t)L * 16 * D * DEXP * 2, (size_t)D * DEXP * 2, rdy, 3u};
                pg8::EpiBf16<0> E{(bf16*)(ws + WS_Y), D, 4, 0, nullptr, 0};
                pg8::gemm_phase(lds, (const bf16*)(ws + WS_H), DEXP, S, E, wv_);
            }
        } PH_END_WT
        PH_BEGIN(18) phase_moe_combine(A, wv_, L, lds); PH_END
    }
#undef PH_BEGIN
#undef PH_END
#undef PH_END_
#undef PH_END_WT
    if (hi - lo > 1) { for (int q_ = 0; q_ < PROBE_XBAR; ++q_) { XcdBarrier b_; b_.bar = (unsigned*)(opq(kargs()->ws) + WS_CTL) + CW_BAR; b_.x = xb_xcc_id(); b_.st = misc; xcd_barrier(b_, opaque_tid(wv_) == 0); } }
    if ((PROBE_NSA || PROBE_SUB) && blockIdx.x == 0) { const unsigned long long d_ = __hip_atomic_load((unsigned long long*)(A0->ws + WS_CTL + 48000), __ATOMIC_RELAXED, __HIP_MEMORY_SCOPE_AGENT); const unsigned long long t0 = __builtin_amdgcn_s_memrealtime(); while (__builtin_amdgcn_s_memrealtime() - t0 < d_) __builtin_amdgcn_s_sleep(8); }
    if (PROBE_TMASK && blockIdx.x == 0) { const unsigned long long t0 = __builtin_amdgcn_s_memrealtime(); while (__builtin_amdgcn_s_memrealtime() - t0 < tacc_) __builtin_amdgcn_s_sleep(8); }
}

extern "C" void kernel_launch(void* const* d_in, const int* in_sizes, int n_in, void* d_out, int out_size, void* d_ws, size_t ws_size, hipStream_t stream) {
    static int grid = 0;
    if (grid == 0) {
        if (n_in != N_IN || out_size != T * D || ws_size < WS_END) { fprintf(stderr, "kernel_launch: unexpected problem (n_in %d, out %d, ws %zu)\n", n_in, out_size, ws_size); grid = -1; return; }
        int dev = 0, cus = 0, per_cu = 0;
        if (hipGetDevice(&dev) != hipSuccess || hipDeviceGetAttribute(&cus, hipDeviceAttributeMultiprocessorCount, dev) != hipSuccess) { grid = -1; return; }
        if (hipFuncSetAttribute((const void*)mk_fwd, hipFuncAttributeMaxDynamicSharedMemorySize, LDS_BYTES) != hipSuccess) { fprintf(stderr, "kernel_launch: hipFuncSetAttribute failed\n"); grid = -1; return; }
        if (hipOccupancyMaxActiveBlocksPerMultiprocessor(&per_cu, (const void*)mk_fwd, 512, LDS_BYTES) != hipSuccess || per_cu < 1) fprintf(stderr, "kernel_launch: occupancy query says %d\n", per_cu);
        (void)hipGetLastError();
        grid = cus;
    }
    if (grid < 0) return;
    (void)hipMemsetAsync((char*)d_ws + WS_CTL, 0, CTL_BYTES, stream);
    Args a{};
    for (int i = 0; i < N_IN; ++i) a.in[i] = (const float*)d_in[i];
    a.out = (float*)d_out; a.ws = (unsigned char*)d_ws;
    for (int j = 0; j < 32; ++j) a.freq[j] = (float)pow(10000.0, -(double)j / 32.0);
#if MK_ONE_LAUNCH
    a.ph_lo = 0; a.ph_hi = NPHASES;
    hipLaunchKernelGGL(mk_fwd, dim3(grid), dim3(512), LDS_BYTES, stream, a);
#else
    for (int p = 0; p < NPHASES; ++p) { a.ph_lo = p; a.ph_hi = p + 1; hipLaunchKernelGGL(mk_fwd, dim3(grid), dim3(512), LDS_BYTES, stream, a); }
#endif
}
```

```cpp
#include <hip/hip_runtime.h>
#include <stdint.h>
#include <stdio.h>
#include <math.h>

#ifndef PROBE_MASK
#define PROBE_MASK 0
#endif
#ifndef PROBE_TMASK
#define PROBE_TMASK 0
#endif
#ifndef PROBE_NSA
#define PROBE_NSA 0
#endif
#ifndef PROBE_SUB
#define PROBE_SUB 0
#endif
#ifndef PROBE_XBAR
#define PROBE_XBAR 0
#endif
#ifndef PROBE_NSAX
#define PROBE_NSAX 0
#endif
#ifndef PROBE_REPS
#define PROBE_REPS 2
#endif
#ifndef MK_ONE_LAUNCH
#define MK_ONE_LAUNCH 1
#endif

#define LAS __attribute__((address_space(3)))
typedef unsigned short bf16;
typedef short bf16x8 __attribute__((ext_vector_type(8)));
typedef float f32x4 __attribute__((ext_vector_type(4)));
typedef float f32x2 __attribute__((ext_vector_type(2)));
typedef unsigned u32x4 __attribute__((ext_vector_type(4)));
typedef unsigned u32x2 __attribute__((ext_vector_type(2)));

constexpr int T = 16384, D = 1024, NBATCH = 8, S = 2048, DEPTH = 4;
constexpr int NMEM = 256;
constexpr float EPS = 1e-6f;
constexpr int HYN = 3072, HYSRC = 2856;
constexpr int C_QA = 0, C_KC = 512, C_VC = 640, C_KS = 768, C_VS = 896, C_KW = 1024, C_VW = 1152, C_QB = 1280, C_KB = 1536, C_VB = 1792, C_RB = 2304, C_GA = 2816, C_AL = 2840;
constexpr int NCMP = 127;
constexpr int NEXP = 16, DEXP = 384;
constexpr int SLOTS = 2 * T + NEXP * 256;

enum { I_X = 0, I_MEM, I_POS, I_NMIX, I_NXAT, I_NMEM, I_NFFN, I_HYBIN, I_HYBOUT, I_QNORM, I_KNORM, I_CMPPE, I_CMPW1, I_CMPW2, I_GATEB, I_WA2, I_BA, I_ONORM,
       I_SGIN, I_LNG, I_LNB, I_SGWS, I_SGBS, I_SGOUT, I_XWQ, I_XWKV, I_XWO, I_XQN, I_XKN, I_RW, I_RB, I_MOEIN, I_MOEOUT, N_IN };

constexpr size_t MiB = 1u << 20;
constexpr size_t WS_CTL = 0, CTL_BYTES = 1 * MiB;
constexpr size_t WS_WHYB = 1 * MiB;
constexpr size_t WS_WHOUT = WS_WHYB + 12 * MiB;
constexpr size_t WS_WSGIN = WS_WHOUT + 4 * MiB;
constexpr size_t WS_WSGOUT = WS_WSGIN + 16 * MiB;
constexpr size_t WS_WQ = WS_WSGOUT + 8 * MiB;
constexpr size_t WS_WKV = WS_WQ + 8 * MiB;
constexpr size_t WS_WO = WS_WKV + 16 * MiB;
constexpr size_t WS_WMIN = WS_WO + 8 * MiB;
constexpr size_t WS_WMOUT = WS_WMIN + 96 * MiB;
constexpr size_t WS_RW = WS_WMOUT + 48 * MiB;
constexpr size_t WS_XN = WS_RW + 1 * MiB;
constexpr size_t WS_BIG = WS_XN + 32 * MiB;
constexpr size_t WS_QA = WS_BIG + 128 * MiB;
constexpr size_t WS_KS = WS_QA + 16 * MiB;
constexpr size_t WS_KW = WS_KS + 4 * MiB;
constexpr size_t WS_KC = WS_KW + 4 * MiB;
constexpr size_t WS_VC = WS_KC + 1 * MiB;
constexpr size_t WS_CAT = WS_VC + 1 * MiB;
constexpr size_t WS_QX = WS_CAT + 32 * MiB;
constexpr size_t WS_OX = WS_QX + 32 * MiB;
constexpr size_t WS_MN = WS_OX + 32 * MiB;
constexpr size_t WS_KV = WS_MN + 4 * MiB;
constexpr size_t WS_COS = WS_KV + 32 * MiB;
constexpr size_t WS_SIN = WS_COS + 2 * MiB;
constexpr size_t WS_LIST = WS_SIN + 2 * MiB;
constexpr size_t WS_TOK = WS_LIST + 1 * MiB;
constexpr size_t WS_VT = WS_TOK + 1 * MiB;
constexpr size_t WS_VTA = WS_VT + 16 * MiB;
constexpr size_t WS_SLOC = WS_VTA + 32 * MiB;
constexpr size_t WS_DEC = WS_SLOC + 32 * MiB;
constexpr size_t WS_STT = WS_DEC + 1 * MiB;
constexpr size_t WS_WSB = WS_STT + 16 * MiB;
constexpr size_t WS_M0 = WS_WSB + 768 * 1024;
constexpr size_t WS_W1T = WS_WSB + 1 * MiB;
constexpr size_t WS_ROWSQ = WS_W1T + 1 * MiB;
constexpr size_t WS_VSTAT = WS_ROWSQ + 1 * MiB;
constexpr size_t WS_X16 = WS_VSTAT + 4 * MiB;
constexpr size_t WS_END = WS_X16 + 32 * MiB;
constexpr size_t WS_H_BYTES = (size_t)36864 * 384 * 2;
constexpr size_t WS_Y = WS_BIG, WS_H = WS_BIG + 72 * MiB, WS_U = WS_BIG, WS_V = WS_BIG + 64 * MiB, WS_UM = WS_QX;
constexpr int CW_BAR = 4096;
constexpr int CW_RDY = 16384;
constexpr int CW_CNT = 8192;

constexpr int LDS_BYTES = 159744;
constexpr int LDS_MISC = LDS_BYTES - 64;

typedef __bf16 bf16x2_t __attribute__((ext_vector_type(2)));
__device__ __forceinline__ unsigned pk2(float lo, float hi) { const f32x2 v = {lo, hi}; return __builtin_bit_cast(unsigned, __builtin_convertvector(v, bf16x2_t)); }
__device__ __forceinline__ unsigned f2bf(float f) { return (unsigned)__builtin_bit_cast(unsigned short, (__bf16)f); }
__device__ __forceinline__ float bf2f(unsigned b) { return __uint_as_float(b << 16); }
__device__ __forceinline__ float bflo(unsigned w) { return __uint_as_float(w << 16); }
__device__ __forceinline__ float bfhi(unsigned w) { return __uint_as_float(w & 0xffff0000u); }
__device__ __forceinline__ void xswap16(float v, float& a, float& b) { unsigned u = __builtin_bit_cast(unsigned, v), u2 = u; asm volatile("" : "+v"(u2));
    const u32x2 r = __builtin_amdgcn_permlane16_swap(u, u2, false, false); unsigned r0 = r[0], r1 = r[1]; asm volatile("" : "+v"(r0), "+v"(r1)); a = __builtin_bit_cast(float, r0); b = __builtin_bit_cast(float, r1); }
__device__ __forceinline__ void xswap32(float v, float& a, float& b) { unsigned u = __builtin_bit_cast(unsigned, v), u2 = u; asm volatile("" : "+v"(u2));
    const u32x2 r = __builtin_amdgcn_permlane32_swap(u, u2, false, false); unsigned r0 = r[0], r1 = r[1]; asm volatile("" : "+v"(r0), "+v"(r1)); a = __builtin_bit_cast(float, r0); b = __builtin_bit_cast(float, r1); }
__device__ __forceinline__ float xadd16(float v) { float a, b; xswap16(v, a, b); return a + b; }
__device__ __forceinline__ float xadd32(float v) { float a, b; xswap32(v, a, b); return a + b; }
__device__ __forceinline__ float xmax16(float v) { float a, b; xswap16(v, a, b); return fmaxf(a, b); }
__device__ __forceinline__ float xmax32(float v) { float a, b; xswap32(v, a, b); return fmaxf(a, b); }
__device__ __forceinline__ float wave_sum(float v) {
#pragma unroll
    for (int o = 1; o < 16; o <<= 1) v += __shfl_xor(v, o);
    return xadd32(xadd16(v));
}
__device__ __forceinline__ float wave_max(float v) {
#pragma unroll
    for (int o = 1; o < 16; o <<= 1) v = fmaxf(v, __shfl_xor(v, o));
    return xmax32(xmax16(v));
}
__device__ __forceinline__ int opaque_tid(int wv) { int l; asm volatile("v_mbcnt_lo_u32_b32 %0, -1, 0\n\tv_mbcnt_hi_u32_b32 %0, -1, %0" : "=v"(l)); return wv * 64 + l; }
__device__ __forceinline__ unsigned char* opq(unsigned char* p) { asm volatile("" : "+s"(p)); return p; }
#define LDS_WAIT() asm volatile("s_waitcnt lgkmcnt(0)" ::: "memory")
__device__ __forceinline__ float gelu_tanh(float x) {
    const float u2 = x * (1.5957691216057308f + 0.07135481283f * x * x);
    return x * __builtin_amdgcn_rcpf(1.0f + __expf(-u2));
}
__device__ __forceinline__ float sigmoidf_(float x) { return __builtin_amdgcn_rcpf(1.0f + __expf(-x)); }

#define SUBT_BEGIN(id) unsigned long long subt_##id = 0; if (PROBE_SUB == (id)) subt_##id = __builtin_amdgcn_s_memrealtime();
#define SUBT_END(id, wsp, tidv) do { if (PROBE_SUB == (id) && blockIdx.x == 0 && (tidv) == 0) atomicAdd((unsigned long long*)((wsp) + WS_CTL + 48000), __builtin_amdgcn_s_memrealtime() - subt_##id); } while (0)
#define XB_TMO      128
#define XB_XCNT(j)  (256  + 64 * (j))
#define XB_XSUB(j)  (1280 + 64 * (j))
#define XB_XGEN(j)  (2304 + 64 * (j))
#define XB_TOP      3328
#define XB_TOPGEN   3392
#define XCD_BAR_WORDS 3456
#define XB_SPIN_CAP (1u << 22)

__device__ __forceinline__ unsigned xb_ld(unsigned* p)              { return __hip_atomic_load(p, __ATOMIC_RELAXED, __HIP_MEMORY_SCOPE_AGENT); }
__device__ __forceinline__ unsigned xb_add(unsigned* p, unsigned v) { return __hip_atomic_fetch_add(p, v, __ATOMIC_RELAXED, __HIP_MEMORY_SCOPE_AGENT); }
__device__ __forceinline__ unsigned xb_xcc_id() { return (unsigned)__builtin_amdgcn_s_getreg((3 << 11) | 20) & 0xFu; }
#define XB_SPIN(cond, bar) do { unsigned _sp = 0; while (cond) { __builtin_amdgcn_s_sleep(1); \
    if ((++_sp & 255u) == 0u) { if (xb_ld(&(bar)[XB_TMO])) break; if (_sp > XB_SPIN_CAP) { atomicAdd(&(bar)[XB_TMO], 1u); break; } } } } while (0)

struct XcdBarrier { unsigned* bar; unsigned x; volatile LAS unsigned* st; };
__device__ __forceinline__ unsigned* xb_opaque(unsigned* p) { unsigned long long v = (unsigned long long)p; unsigned lo = __builtin_amdgcn_readfirstlane((unsigned)v), hi = __builtin_amdgcn_readfirstlane((unsigned)(v >> 32));
    asm volatile("" : "+s"(lo), "+s"(hi)); return (unsigned*)(((unsigned long long)hi << 32) | lo); }

__device__ __forceinline__ XcdBarrier xcd_barrier_post(unsigned* bar, volatile LAS unsigned* st) {
    XcdBarrier b; b.bar = bar; b.x = xb_xcc_id(); b.st = st;
    if (threadIdx.x == 0) (void)xb_add(&bar[XB_XCNT(b.x)], 1u);
    return b;
}
__device__ __forceinline__ void xcd_barrier_complete(unsigned* bar, unsigned x, unsigned& nloc, unsigned& nx) {
    const unsigned G = gridDim.x * gridDim.y * gridDim.z;
    unsigned sum, cnt, mine, sp = 0u;
    for (;;) {
        sum = 0u; cnt = 0u; mine = 0u;
#pragma unroll
        for (unsigned j = 0; j < 16; ++j) { const unsigned c = xb_ld(&bar[XB_XCNT(j)]); sum += c; cnt += (c > 0u) ? 1u : 0u; mine = (j == x) ? c : mine; }
        if (sum == G) break;
        __builtin_amdgcn_s_sleep(1);
        if ((++sp & 255u) == 0u) { if (xb_ld(&bar[XB_TMO])) break; if (sp > XB_SPIN_CAP) { atomicAdd(&bar[XB_TMO], 1u); break; } }
    }
    nloc = mine > 0u ? mine : 1u; nx = cnt > 0u ? cnt : 1u;
}
__device__ __forceinline__ void xcd_barrier(const XcdBarrier& b, const bool is_t0) {
    asm volatile("s_waitcnt vmcnt(0)" ::: "memory");
    __syncthreads();
    if (is_t0) {
        unsigned* bar = b.bar;
        __builtin_amdgcn_s_waitcnt(0);
        asm volatile("buffer_inv sc1" ::: "memory");
        unsigned nloc = b.st[0], nx = b.st[1];
        if (nloc == 0u) { xcd_barrier_complete(bar, b.x, nloc, nx); b.st[0] = nloc; b.st[1] = nx; }
        const unsigned old = xb_add(&bar[XB_XSUB(b.x)], 1u);
        const unsigned gen = old / nloc;
        if (old + 1u == (gen + 1u) * nloc) {
            __builtin_amdgcn_fence(__ATOMIC_RELEASE, "agent");
            asm volatile("s_waitcnt vmcnt(0)" ::: "memory");
            const unsigned og = xb_add(&bar[XB_TOP], 1u);
            const unsigned tg = og / nx;
            if (og + 1u == (tg + 1u) * nx) {
#pragma unroll
                for (unsigned j = 0; j < 16; ++j) (void)xb_add(&bar[XB_XGEN(j)], 1u);
            }
        }
        XB_SPIN(xb_ld(&bar[XB_XGEN(b.x)]) == gen, bar);
        asm volatile("s_waitcnt vmcnt(0)" ::: "memory");
    }
    __syncthreads();
}

struct Args {
    const float* in[N_IN];
    float* out;
    unsigned char* ws;
    float freq[32];
    int ph_lo, ph_hi;
};

typedef const __attribute__((address_space(4))) Args* KArgs;
__device__ __forceinline__ KArgs kargs() { KArgs p = (KArgs)__builtin_amdgcn_kernarg_segment_ptr(); asm volatile("" : "+s"(p)); return p; }

__device__ __forceinline__ void st_bf16x4(bf16* p, f32x4 v) { u32x2 w; w.x = pk2(v[0], v[1]); w.y = pk2(v[2], v[3]); *(u32x2*)p = w; }


__device__ __forceinline__ __amdgpu_buffer_rsrc_t wt_rsrc(const void* base) { return __builtin_amdgcn_make_buffer_rsrc((void*)base, 0, 0x7FFFFFFF, 0x00020000); }
__device__ __forceinline__ void st16_wt(__amdgpu_buffer_rsrc_t r, unsigned byte_off, u32x4 v) { __builtin_amdgcn_raw_buffer_store_b128(v, r, byte_off, 0, 16); }

namespace pg8 {
constexpr int BM = 256, BK = 64, HALF = 128, HTB = HALF * BK * 2, STAGE_BYTES = 8 * HTB, NXCD = 8, WGM = 8;
__host__ __device__ __forceinline__ int lds_byte(int r, int c) { const int st = (r >> 4) * 2 + (c >> 5), rr = r & 15, cc = c & 31, ob = rr * 64 + cc * 2; return st * 1024 + (ob ^ (((ob >> 9) & 1) << 5)); }
__host__ __device__ __forceinline__ void stage_rc(int b, int& R, int& C) { const int st = b / 1024, sb = b % 1024, swz = sb ^ (((sb >> 9) & 1) << 5); R = (st >> 1) * 16 + swz / 64; C = (st & 1) * 32 + (swz % 64) / 2; }
__host__ __device__ __forceinline__ int perm32(int rho) { const int n = rho >> 4, i = rho & 15; return 8 * (i >> 2) + 4 * n + (i & 3); }
struct Unit { int pm, pn, e; };
typedef int i32x4_ __attribute__((ext_vector_type(4)));
typedef int i32x8_ __attribute__((ext_vector_type(8)));
__device__ __forceinline__ i32x8_ cat8(bf16x8 a, bf16x8 b) { return __builtin_shufflevector(__builtin_bit_cast(i32x4_, a), __builtin_bit_cast(i32x4_, b), 0, 1, 2, 3, 4, 5, 6, 7); }
template <bool F8 = false> struct DenseOrderT {
    static constexpr bool GATHER = false; static constexpr int SYNC = 0; static constexpr bool FP8 = F8;
    int nM, nN, nwg, G, c, K; const char* Bt;
    __device__ __forceinline__ void init(int M, int N, int K_, const bf16* Bt_, int G_, int c_) { nM = M / BM; nN = N / BM; nwg = nM * nN; G = G_; c = c_; K = K_; Bt = (const char*)Bt_; }
    __device__ __forceinline__ bool next(int i, Unit& u) const {
        const long L = (long)i * G + c; if (L >= nwg) return false;
        int wgid = (int)L; { const int q = nwg / NXCD, r = nwg % NXCD, xcd = wgid % NXCD, off = wgid / NXCD; wgid = (xcd < r ? xcd * (q + 1) : r * (q + 1) + (xcd - r) * q) + off; }
        const int nig = WGM * nN, gid = wgid / nig, fm = gid * WGM, gsz = (nM - fm) < WGM ? (nM - fm) : WGM;
        u.pm = fm + ((wgid % nig) % gsz); u.pn = (wgid % nig) / gsz; u.e = 0; return true;
    }
    __device__ __forceinline__ unsigned a_voff(const Unit& u, int half, int R) const { return (unsigned)((u.pm * BM + half * HALF + R) * K) * 2u; }
    __device__ __forceinline__ const char* b_tile(const Unit& u) const { return Bt + (size_t)u.pn * BM * K * 2; }
};
typedef DenseOrderT<false> DenseOrder;
template <bool GATH, int SYNC_, bool F8 = false> struct MoeOrder {
    static constexpr bool GATHER = GATH; static constexpr int SYNC = SYNC_; static constexpr bool FP8 = F8;
    int nunits, ntn, G, c, K; const LAS int* off; const LAS int* cn; const int* list; const char* Bt; size_t estride; unsigned* rdy; unsigned need;
    __device__ __forceinline__ void wait(const Unit& u) const {
        unsigned* p = rdy + u.pm; unsigned sp = 0u;
        while (xb_ld(p) < need) { __builtin_amdgcn_s_sleep(1); if (++sp > XB_SPIN_CAP) break; }
        __builtin_amdgcn_fence(__ATOMIC_ACQUIRE, "agent");
        asm volatile("s_waitcnt vmcnt(0)" ::: "memory");
    }
    __device__ __forceinline__ void signal(const Unit& u) const { (void)xb_add(rdy + u.pm, 1u); }
    __device__ __forceinline__ bool next(int i, Unit& u) const {
        const int L = i * G + c; if (L >= nunits) return false;
        u.pm = L / ntn; u.pn = L % ntn; const int s0 = u.pm * BM; int e = 0;
#pragma unroll
        for (int q = 1; q < 16; ++q) e += (s0 >= off[q]) ? 1 : 0;
        u.e = e; return true;
    }
    __device__ __forceinline__ unsigned a_voff(const Unit& u, int half, int R) const {
        const int slot = u.pm * BM + half * HALF + R;
        const int loc = slot - off[u.e]; const int tk = list[u.e * T + (loc < cn[u.e] ? loc : 0)];
        return (unsigned)(tk * K) * 2u;
    }
    __device__ __forceinline__ const char* b_tile(const Unit& u) const { return Bt + (size_t)u.e * estride + (size_t)u.pn * BM * K * 2; }
};
__device__ __forceinline__ unsigned cvt_pk_bf16(float lo, float hi) { return pk2(lo, hi); }

template <class Epi, class Sched>
__device__ __forceinline__ void gemm_phase(LAS unsigned char* lds, const bf16* Aptr, int K, const Sched& S, const Epi& E, int wv_) {
    const int tid = opaque_tid(wv_), wid = __builtin_amdgcn_readfirstlane(tid >> 6), lane = tid & 63, wr = wid >> 2, wc = wid & 3, fr = lane & 15, fq = lane >> 4;
    const int nt = K / BK;
    int Rr[2], Cc[2]; unsigned voffA[2], voffB[2];
#pragma unroll
    for (int i = 0; i < 2; ++i) { stage_rc(tid * 16 + i * 8192, Rr[i], Cc[i]); const int Rb = Epi::PERM ? ((Rr[i] & ~31) + perm32(Rr[i] & 31)) : Rr[i];
        voffA[i] = (unsigned)(Rr[i] * K + Cc[i]) * 2u; voffB[i] = (unsigned)(Rb * K + Cc[i]) * 2u; }
    const size_t kstep = (size_t)(BK * 2);
    const size_t hstep = (size_t)HALF * K * 2;
    const size_t tstep = 2 * hstep;
    const unsigned ldsw = (unsigned)wid * 1024u;
    const int aoff = lds_byte(wr * 64 + fr, fq * 8), boff = lds_byte(wc * 32 + fr, fq * 8);
    const char* const Ab = (const char*)Aptr;
#define PG8_SA(b, h) (((b) * 2 + (h)) * HTB)
#define PG8_SB(b, h) ((4 + (b) * 2 + (h)) * HTB)
#define PG8_STAGE(bufoff, gbase, voff) do { _Pragma("unroll") for (int _i = 0; _i < 2; ++_i) \
        __builtin_amdgcn_global_load_lds((const unsigned*)((const char*)(gbase) + (voff)[_i]), (LAS unsigned*)(lds + (bufoff) + ldsw + _i * 8192), 16, 0, 0); } while (0)
#define PG8_STAGE_A(bufoff, usenext, h, kofs) do { \
        if constexpr (Sched::GATHER) { const char* gb_ = Ab + (kofs); unsigned vv_[2] = {(usenext) ? vN[h][0] : vA[h][0], (usenext) ? vN[h][1] : vA[h][1]}; PG8_STAGE(bufoff, gb_, vv_); } \
        else { const char* gb_ = ((usenext) ? nA : cA) + (size_t)(h) * hstep + (kofs); PG8_STAGE(bufoff, gb_, voffA); } } while (0)
#define PG8_LDA(dst, b, h) do { if constexpr (Sched::FP8) { _Pragma("unroll") for (int m = 0; m < 4; ++m) dst##8[m] = cat8(*(const LAS bf16x8*)(lds + PG8_SA(b, h) + aoff + m * 2048), *(const LAS bf16x8*)(lds + PG8_SA(b, h) + aoff + m * 2048 + 1024)); } \
        else { _Pragma("unroll") for (int m = 0; m < 4; ++m) _Pragma("unroll") for (int k = 0; k < 2; ++k) dst[m][k] = *(const LAS bf16x8*)(lds + PG8_SA(b, h) + aoff + m * 2048 + k * 1024); } } while (0)
#define PG8_LDB(dst, b, h) do { if constexpr (Sched::FP8) { _Pragma("unroll") for (int n = 0; n < 2; ++n) dst##8[n] = cat8(*(const LAS bf16x8*)(lds + PG8_SB(b, h) + boff + n * 2048), *(const LAS bf16x8*)(lds + PG8_SB(b, h) + boff + n * 2048 + 1024)); } \
        else { _Pragma("unroll") for (int n = 0; n < 2; ++n) _Pragma("unroll") for (int k = 0; k < 2; ++k) dst[n][k] = *(const LAS bf16x8*)(lds + PG8_SB(b, h) + boff + n * 2048 + k * 1024); } } while (0)
#define PG8_MMA(ai, bj, At, Bt) do { __builtin_amdgcn_s_setprio(1); \
        if constexpr (Sched::FP8) { \
            _Pragma("unroll") for (int m = 0; m < 4; ++m) _Pragma("unroll") for (int n = 0; n < 2; ++n) \
                asm volatile("v_mfma_f32_16x16x128_f8f6f4 %0, %1, %2, %0" : "+v"(acc[ai][bj][m][n]) : "v"(Bt##8[n]), "v"(At##8[m])); \
        } else { \
            _Pragma("unroll") for (int m = 0; m < 4; ++m) _Pragma("unroll") for (int n = 0; n < 2; ++n) _Pragma("unroll") for (int k = 0; k < 2; ++k) \
                acc[ai][bj][m][n] = __builtin_amdgcn_mfma_f32_16x16x32_bf16(Bt[n][k], At[m][k], acc[ai][bj][m][n], 0, 0, 0); \
        } __builtin_amdgcn_s_setprio(0); } while (0)
#define PG8_WAIT_V(n) asm volatile("s_waitcnt vmcnt(" #n ")" ::: "memory")
#define PG8_WAIT_L(n) asm volatile("s_waitcnt lgkmcnt(" #n ")" ::: "memory")
#define PG8_BAR __builtin_amdgcn_s_barrier()
#define PG8_SCHED __builtin_amdgcn_sched_barrier(0)
    Unit cur, nxt; int ui = 0;
    if (!S.next(0, cur)) return;
    if constexpr (Sched::SYNC == 2) { if (wid == 0) S.wait(cur); __syncthreads(); }
    f32x4 acc[2][2][4][2];
#pragma unroll
    for (int a = 0; a < 2; ++a)
#pragma unroll
        for (int b = 0; b < 2; ++b)
#pragma unroll
            for (int m = 0; m < 4; ++m)
#pragma unroll
                for (int n = 0; n < 2; ++n) acc[a][b][m][n] = (f32x4){0.f, 0.f, 0.f, 0.f};
    bf16x8 At[4][2], B0[2][2], B1[2][2];
    i32x8_ At8[4], B08[2], B18[2];
    unsigned vA[2][2], vN[2][2];
    const char* cA = Ab; const char* nA = Ab;
    if constexpr (Sched::GATHER) {
#pragma unroll
        for (int h = 0; h < 2; ++h)
#pragma unroll
            for (int i = 0; i < 2; ++i) { vA[h][i] = S.a_voff(cur, h, Rr[i]) + (unsigned)Cc[i] * 2u; vN[h][i] = vA[h][i]; }
    } else { cA = Ab + (size_t)cur.pm * tstep; nA = cA; }
    const char* cB = S.b_tile(cur);
    PG8_STAGE(PG8_SB(0, 0), cB, voffB); PG8_STAGE_A(PG8_SA(0, 0), false, 0, 0); PG8_STAGE(PG8_SB(0, 1), cB + hstep, voffB); PG8_STAGE_A(PG8_SA(0, 1), false, 1, 0);
    if (wr == 1) PG8_BAR;
    PG8_WAIT_V(4); PG8_BAR;
    PG8_STAGE(PG8_SB(1, 0), cB + kstep, voffB); PG8_STAGE_A(PG8_SA(1, 0), false, 0, kstep); PG8_STAGE(PG8_SB(1, 1), cB + hstep + kstep, voffB);
    PG8_WAIT_V(6); PG8_BAR;
    for (;;) {
        const bool has_next = S.next(ui + 1, nxt);
        if constexpr (Sched::SYNC == 2) { if (has_next && wid == 0) S.wait(nxt); }
        const char* nB = has_next ? S.b_tile(nxt) : cB;
        if constexpr (Sched::GATHER) {
#pragma unroll
            for (int h = 0; h < 2; ++h)
#pragma unroll
                for (int i = 0; i < 2; ++i) vN[h][i] = has_next ? S.a_voff(nxt, h, Rr[i]) + (unsigned)Cc[i] * 2u : vA[h][i];
        } else nA = has_next ? Ab + (size_t)nxt.pm * tstep : cA;
        for (int t = 0; t < nt; t += 2) {
            const bool last = (t == nt - 2);
            const size_t k1 = (size_t)(t + 1) * kstep, k2 = last ? 0 : (size_t)(t + 2) * kstep, k3 = k2 + kstep;
            const char* b2 = last ? nB : cB + (size_t)(t + 2) * kstep; const char* b3 = b2 + kstep;
            PG8_LDB(B0, 0, 0); PG8_SCHED; PG8_LDA(At, 0, 0); PG8_STAGE_A(PG8_SA(1, 1), false, 1, k1);
            PG8_WAIT_L(8); PG8_BAR; PG8_WAIT_L(0); PG8_MMA(0, 0, At, B0); PG8_BAR; PG8_SCHED;
            PG8_LDB(B1, 0, 1); PG8_STAGE(PG8_SB(0, 0), b2, voffB);
            PG8_BAR; PG8_WAIT_L(0); PG8_MMA(0, 1, At, B1); PG8_BAR;
            PG8_LDA(At, 0, 1); PG8_STAGE_A(PG8_SA(0, 0), last, 0, k2);
            PG8_BAR; PG8_WAIT_L(0); PG8_MMA(1, 0, At, B0); PG8_BAR; PG8_SCHED;
            PG8_STAGE(PG8_SB(0, 1), b2 + hstep, voffB);
            PG8_WAIT_V(6); PG8_BAR; PG8_MMA(1, 1, At, B1); PG8_BAR;
            PG8_LDB(B0, 1, 0); PG8_SCHED; PG8_LDA(At, 1, 0); PG8_STAGE_A(PG8_SA(0, 1), last, 1, k2);
            PG8_WAIT_L(8); PG8_BAR; PG8_WAIT_L(0); PG8_MMA(0, 0, At, B0); PG8_BAR; PG8_SCHED;
            PG8_LDB(B1, 1, 1); PG8_STAGE(PG8_SB(1, 0), b3, voffB);
            PG8_BAR; PG8_WAIT_L(0); PG8_MMA(0, 1, At, B1); PG8_BAR;
            PG8_LDA(At, 1, 1); PG8_STAGE_A(PG8_SA(1, 0), last, 0, k3);
            PG8_BAR; PG8_WAIT_L(0); PG8_MMA(1, 0, At, B0); PG8_BAR; PG8_SCHED;
            PG8_STAGE(PG8_SB(1, 1), b3 + hstep, voffB);
            PG8_WAIT_V(6); PG8_BAR; PG8_MMA(1, 1, At, B1); PG8_BAR;
        }
        if constexpr (Sched::FP8) {
            asm volatile("s_nop 15\n\ts_nop 15" : "+v"(acc[0][0][0][0]), "+v"(acc[0][0][0][1]), "+v"(acc[0][0][1][0]), "+v"(acc[0][0][1][1]), "+v"(acc[0][0][2][0]), "+v"(acc[0][0][2][1]), "+v"(acc[0][0][3][0]), "+v"(acc[0][0][3][1]),
                         "+v"(acc[0][1][0][0]), "+v"(acc[0][1][0][1]), "+v"(acc[0][1][1][0]), "+v"(acc[0][1][1][1]), "+v"(acc[0][1][2][0]), "+v"(acc[0][1][2][1]), "+v"(acc[0][1][3][0]), "+v"(acc[0][1][3][1]));
            asm volatile("" : "+v"(acc[1][0][0][0]), "+v"(acc[1][0][0][1]), "+v"(acc[1][0][1][0]), "+v"(acc[1][0][1][1]), "+v"(acc[1][0][2][0]), "+v"(acc[1][0][2][1]), "+v"(acc[1][0][3][0]), "+v"(acc[1][0][3][1]),
                         "+v"(acc[1][1][0][0]), "+v"(acc[1][1][0][1]), "+v"(acc[1][1][1][0]), "+v"(acc[1][1][1][1]), "+v"(acc[1][1][2][0]), "+v"(acc[1][1][2][1]), "+v"(acc[1][1][3][0]), "+v"(acc[1][1][3][1]));
        }
        E(acc, cur, wr, wc, fr, fq);
        if constexpr (Sched::SYNC == 1) {
            PG8_WAIT_V(0); PG8_BAR; PG8_BAR;
            if (tid == 0) S.signal(cur);
        }
        if (!has_next) break;
#pragma unroll
        for (int a = 0; a < 2; ++a)
#pragma unroll
            for (int b = 0; b < 2; ++b)
#pragma unroll
                for (int m = 0; m < 4; ++m)
#pragma unroll
                    for (int n = 0; n < 2; ++n) acc[a][b][m][n] = (f32x4){0.f, 0.f, 0.f, 0.f};
        cur = nxt; cB = nB; cA = nA; ++ui;
        if constexpr (Sched::GATHER) {
#pragma unroll
            for (int h = 0; h < 2; ++h)
#pragma unroll
                for (int i = 0; i < 2; ++i) vA[h][i] = vN[h][i];
        }
    }
    PG8_WAIT_V(0);
    if (wr == 0) PG8_BAR;
    PG8_BAR;
#undef PG8_SA
#undef PG8_SB
#undef PG8_STAGE
#undef PG8_STAGE_A
#undef PG8_LDA
#undef PG8_LDB
#undef PG8_MMA
#undef PG8_WAIT_V
#undef PG8_WAIT_L
#undef PG8_BAR
#undef PG8_SCHED
}
template <int ACT, bool PRE = false, bool OUT8 = false> struct EpiBf16 {
    static constexpr bool PERM = true;
    bf16* O; int ldc; int tpt; size_t tstride; float* stats; int stat_pn0; float pre;
    __device__ __forceinline__ void operator()(const f32x4 (&acc)[2][2][4][2], const Unit& u, int wr, int wc, int fr, int fq) const {
        const int row0 = u.pm * BM + wr * 64 + fr; const int tt = u.pn / tpt; bf16* base = O + (size_t)tt * tstride; const int col0 = (u.pn - tt * tpt) * BM + wc * 32 + 8 * fq;
        const __amdgpu_buffer_rsrc_t rs_ = wt_rsrc(base);
#pragma unroll
        for (int ai = 0; ai < 2; ++ai)
#pragma unroll
            for (int m = 0; m < 4; ++m) { const unsigned rowo = (unsigned)((row0 + ai * HALF + m * 16) * ldc + col0) * 2u; float psum = 0.f, psq = 0.f;
#pragma unroll
                for (int bj = 0; bj < 2; ++bj) { f32x4 v0 = acc[ai][bj][m][0], v1 = acc[ai][bj][m][1];
                    if constexpr (PRE) { v0 = v0 * pre; v1 = v1 * pre; }
                    if (ACT == 1) {
#pragma unroll
                        for (int q = 0; q < 4; ++q) { v0[q] = gelu_tanh(v0[q]); v1[q] = gelu_tanh(v1[q]); } }
                    if (ACT == 1) { psum += ((v0[0] + v0[1]) + (v0[2] + v0[3])) + ((v1[0] + v1[1]) + (v1[2] + v1[3]));
                        psq += ((v0[0] * v0[0] + v0[1] * v0[1]) + (v0[2] * v0[2] + v0[3] * v0[3])) + ((v1[0] * v1[0] + v1[1] * v1[1]) + (v1[2] * v1[2] + v1[3] * v1[3])); }
                    if constexpr (OUT8) {
                        int t0_ = __builtin_amdgcn_cvt_pk_fp8_f32(v0[0], v0[1], 0, false); t0_ = __builtin_amdgcn_cvt_pk_fp8_f32(v0[2], v0[3], t0_, true);
                        int t1_ = __builtin_amdgcn_cvt_pk_fp8_f32(v1[0], v1[1], 0, false); t1_ = __builtin_amdgcn_cvt_pk_fp8_f32(v1[2], v1[3], t1_, true);
                        u32x2 w8; w8.x = (unsigned)t0_; w8.y = (unsigned)t1_; __builtin_amdgcn_raw_buffer_store_b64(w8, rs_, (rowo >> 1) + (unsigned)(bj * HALF), 0, 16);
                    } else {
                    u32x4 w; w.x = cvt_pk_bf16(v0[0], v0[1]); w.y = cvt_pk_bf16(v0[2], v0[3]); w.z = cvt_pk_bf16(v1[0], v1[1]); w.w = cvt_pk_bf16(v1[2], v1[3]);
                    st16_wt(rs_, rowo + (unsigned)(bj * HALF * 2), w); } }
                if (ACT == 1 && stats && u.pn >= stat_pn0) {
                    psum = xadd32(xadd16(psum)); psq = xadd32(xadd16(psq));
                    if (fq == 0) { f32x2 st2 = {psum, psq}; *(f32x2*)(stats + ((size_t)(row0 + ai * HALF + m * 16) * 32 + (u.pn - stat_pn0) * 4 + wc) * 2) = st2; } } }
    }
};
struct EpiResAdd {
    static constexpr bool PERM = true;
    bf16* X; int ldc; float pre;
    __device__ __forceinline__ void operator()(const f32x4 (&acc)[2][2][4][2], const Unit& u, int wr, int wc, int fr, int fq) const {
        const int row0 = u.pm * BM + wr * 64 + fr, col0 = u.pn * BM + wc * 32 + 8 * fq;
        const __amdgpu_buffer_rsrc_t rs_ = wt_rsrc(X);
#pragma unroll
        for (int ai = 0; ai < 2; ++ai) {
            u32x4 x[4][2];
#pragma unroll
            for (int m = 0; m < 4; ++m)
#pragma unroll
                for (int bj = 0; bj < 2; ++bj) x[m][bj] = *(const u32x4*)(X + (size_t)(row0 + ai * HALF + m * 16) * ldc + col0 + bj * HALF);
#pragma unroll
            for (int m = 0; m < 4; ++m)
#pragma unroll
                for (int bj = 0; bj < 2; ++bj) { const f32x4 a0 = acc[ai][bj][m][0] * pre, a1 = acc[ai][bj][m][1] * pre; const u32x4 xv = x[m][bj];
                    u32x4 w; w.x = pk2(bflo(xv.x) + a0.x, bfhi(xv.x) + a0.y); w.y = pk2(bflo(xv.y) + a0.z, bfhi(xv.y) + a0.w); w.z = pk2(bflo(xv.z) + a1.x, bfhi(xv.z) + a1.y); w.w = pk2(bflo(xv.w) + a1.z, bfhi(xv.w) + a1.w);
                    st16_wt(rs_, (unsigned)((row0 + ai * HALF + m * 16) * ldc + col0 + bj * HALF) * 2u, w); }
        }
    }
};
struct EpiResAddNorm {
    static constexpr bool PERM = true;
    bf16* X; int ldc; float* rowsq; float pre; unsigned char* x8;
    __device__ __forceinline__ void operator()(const f32x4 (&acc)[2][2][4][2], const Unit& u, int wr, int wc, int fr, int fq) const {
        const int row0 = u.pm * BM + wr * 64 + fr, col0 = u.pn * BM + wc * 32 + 8 * fq;
        const __amdgpu_buffer_rsrc_t rs_ = wt_rsrc(x8);
        const unsigned xd = (unsigned)((const char*)X - (const char*)x8);
#pragma unroll
        for (int ai = 0; ai < 2; ++ai)
#pragma unroll
            for (int mh = 0; mh < 2; ++mh) {
                u32x4 x[2][2];
#pragma unroll
                for (int m2 = 0; m2 < 2; ++m2)
#pragma unroll
                    for (int bj = 0; bj < 2; ++bj) x[m2][bj] = *(const u32x4*)(X + (size_t)(row0 + ai * HALF + (2 * mh + m2) * 16) * ldc + col0 + bj * HALF);
#pragma unroll
                for (int m2 = 0; m2 < 2; ++m2) {
                    const int m = 2 * mh + m2;
                    const size_t ro = (size_t)(row0 + ai * HALF + m * 16) * ldc + col0; float ssq = 0.f;
#pragma unroll
                    for (int bj = 0; bj < 2; ++bj) { const f32x4 a0 = acc[ai][bj][m][0] * pre, a1 = acc[ai][bj][m][1] * pre; const u32x4 xv = x[m2][bj];
                        u32x4 w; w.x = pk2(bflo(xv.x) + a0.x, bfhi(xv.x) + a0.y); w.y = pk2(bflo(xv.y) + a0.z, bfhi(xv.y) + a0.w); w.z = pk2(bflo(xv.z) + a1.x, bfhi(xv.z) + a1.y); w.w = pk2(bflo(xv.w) + a1.z, bfhi(xv.w) + a1.w);
                        st16_wt(rs_, xd + (unsigned)(ro + bj * HALF) * 2u, w);
                        const float v0 = bflo(w.x), v1 = bfhi(w.x), v2 = bflo(w.y), v3 = bfhi(w.y), v4 = bflo(w.z), v5 = bfhi(w.z), v6 = bflo(w.w), v7 = bfhi(w.w);
                        ssq += ((v0 * v0 + v1 * v1) + (v2 * v2 + v3 * v3)) + ((v4 * v4 + v5 * v5) + (v6 * v6 + v7 * v7));
                        int t0_ = __builtin_amdgcn_cvt_pk_fp8_f32(v0, v1, 0, false); t0_ = __builtin_amdgcn_cvt_pk_fp8_f32(v2, v3, t0_, true); int t1_ = __builtin_amdgcn_cvt_pk_fp8_f32(v4, v5, 0, false); t1_ = __builtin_amdgcn_cvt_pk_fp8_f32(v6, v7, t1_, true);
                        u32x2 w8; w8.x = (unsigned)t0_; w8.y = (unsigned)t1_; __builtin_amdgcn_raw_buffer_store_b64(w8, rs_, (unsigned)(ro + bj * HALF), 0, 0); }
                    ssq = xadd32(xadd16(ssq));
                    if (fq == 0) rowsq[(size_t)(row0 + ai * HALF + m * 16) * 16 + u.pn * 4 + wc] = ssq;
                }
            }
    }
};
struct EpiBf16RowScale {
    static constexpr bool PERM = true;
    bf16* O; int ldc; const float* rowsq; float pre;
    __device__ __forceinline__ void operator()(const f32x4 (&acc)[2][2][4][2], const Unit& u, int wr, int wc, int fr, int fq) const {
        const int row0 = u.pm * BM + wr * 64 + fr, col0 = u.pn * BM + wc * 32 + 8 * fq;
#pragma unroll
        for (int ai = 0; ai < 2; ++ai) {
            float rs[4];
#pragma unroll
            for (int m = 0; m < 4; ++m) { const f32x4* p = (const f32x4*)(rowsq + (size_t)(row0 + ai * HALF + m * 16) * 16); const f32x4 a = p[0], b = p[1], c = p[2], d = p[3];
                rs[m] = rsqrtf((((a.x + a.y) + (a.z + a.w)) + ((b.x + b.y) + (b.z + b.w)) + (((c.x + c.y) + (c.z + c.w)) + ((d.x + d.y) + (d.z + d.w)))) * (1.f / 1024.f) + EPS) * pre; }
#pragma unroll
            for (int m = 0; m < 4; ++m) { const unsigned rowo = (unsigned)((row0 + ai * HALF + m * 16) * ldc + col0) * 2u;
#pragma unroll
                for (int bj = 0; bj < 2; ++bj) { const f32x4 v0 = acc[ai][bj][m][0] * rs[m], v1 = acc[ai][bj][m][1] * rs[m];
                    int t0_ = __builtin_amdgcn_cvt_pk_fp8_f32(v0[0], v0[1], 0, false); t0_ = __builtin_amdgcn_cvt_pk_fp8_f32(v0[2], v0[3], t0_, true);
                    int t1_ = __builtin_amdgcn_cvt_pk_fp8_f32(v1[0], v1[1], 0, false); t1_ = __builtin_amdgcn_cvt_pk_fp8_f32(v1[2], v1[3], t1_, true);
                    u32x2 w8; w8.x = (unsigned)t0_; w8.y = (unsigned)t1_; __builtin_amdgcn_raw_buffer_store_b64(w8, wt_rsrc(O), (rowo >> 1) + (unsigned)(bj * HALF), 0, 16); } }
        }
    }
};
template <bool WT> struct EpiSwiglu {
    static constexpr bool PERM = true;
    bf16* H; int ldc; unsigned hbytes; float pre;
    __device__ __forceinline__ void operator()(const f32x4 (&acc)[2][2][4][2], const Unit& u, int wr, int wc, int fr, int fq) const {
        const int row0 = u.pm * BM + wr * 64 + fr, col0 = u.pn * HALF + wc * 32 + 8 * fq;
        const __amdgpu_buffer_rsrc_t rsrc = __builtin_amdgcn_make_buffer_rsrc(H, 0, hbytes, 0x00020000);
#pragma unroll
        for (int ai = 0; ai < 2; ++ai)
#pragma unroll
            for (int m = 0; m < 4; ++m) {
                float o[8];
#pragma unroll
                for (int n = 0; n < 2; ++n)
#pragma unroll
                    for (int q = 0; q < 4; ++q) { const float g = acc[ai][0][m][n][q] * pre; o[4 * n + q] = g * sigmoidf_(g) * (acc[ai][1][m][n][q] * pre); }
                u32x4 w; w.x = cvt_pk_bf16(o[0], o[1]); w.y = cvt_pk_bf16(o[2], o[3]); w.z = cvt_pk_bf16(o[4], o[5]); w.w = cvt_pk_bf16(o[6], o[7]);
                if constexpr (WT) __builtin_amdgcn_raw_buffer_store_b128(w, rsrc, (unsigned)(((row0 + ai * HALF + m * 16) * ldc + col0) * 2), 0, 16);
                else *(u32x4*)(H + (size_t)(row0 + ai * HALF + m * 16) * ldc + col0) = w; }
    }
};
}

__device__ __forceinline__ int hyb_colmap(int n) {
    if (n < 1280) return n;
    if (n < 1536) return 1304 + (n - 1280);
    if (n < 1792) return 1560 + (n - 1536);
    if (n < 2304) return 1816 + (n - 1792);
    if (n < 2816) return 2344 + (n - 2304);
    if (n < 2840) return 1280 + (n - 2816);
    if (n < 2856) return 2328 + (n - 2840);
    return -1;
}
__device__ __forceinline__ void tr_item(const float* __restrict__ W, int Nsrc, int K, bf16* __restrict__ Wt, const float* __restrict__ gain, int kind, int nblk, LAS float* scr, int item, int lane) {
    const int kb = item / nblk, nb = item % nblk, k0 = 64 * kb, n0 = 64 * nb;
    const int ksub = lane >> 4, n4 = lane & 15, n = n0 + 4 * n4;
    int col;
    if (kind == 0) col = n; else if (kind == 1) col = hyb_colmap(n); else { const int pn = n >> 8, r = n & 255; col = (r >> 7) * 384 + pn * 128 + (r & 127); }
    f32x4 v[16];
#pragma unroll
    for (int i = 0; i < 16; ++i) v[i] = col >= 0 ? *(const f32x4*)(W + (size_t)(k0 + 4 * i + ksub) * Nsrc + col) : (f32x4){0.f, 0.f, 0.f, 0.f};
    if (gain) {
#pragma unroll
        for (int i = 0; i < 16; ++i) v[i] = v[i] * gain[k0 + 4 * i + ksub];
    }
#pragma unroll
    for (int i = 0; i < 16; ++i) { LAS float* d = scr + (4 * i + ksub) * 65 + 4 * n4; d[0] = v[i].x; d[1] = v[i].y; d[2] = v[i].z; d[3] = v[i].w; }
    LDS_WAIT();
    const int c = lane & 7;
#pragma unroll
    for (int jx = 0; jx < 8; ++jx) {
        const int nn = (lane >> 3) + 8 * jx; const LAS float* s = scr + (8 * c) * 65 + nn;
        u32x4 o; o.x = pk2(s[0 * 65], s[1 * 65]); o.y = pk2(s[2 * 65], s[3 * 65]); o.z = pk2(s[4 * 65], s[5 * 65]); o.w = pk2(s[6 * 65], s[7 * 65]);
        *(u32x4*)(Wt + (size_t)(n0 + nn) * K + k0 + 8 * c) = o;
    }
    LDS_WAIT();
}
__device__ __forceinline__ void tr_item_f8(const float* __restrict__ W, int Nsrc, int K, unsigned char* __restrict__ Wt8, const float* __restrict__ gain, int kind, int nblk, LAS float* scr, int item, int lane) {
    const int kb = item / nblk, nb = item % nblk, k0 = 64 * kb, n0 = 64 * nb;
    const int ksub = lane >> 4, n4 = lane & 15, n = n0 + 4 * n4;
    const int pn = n >> 8, r = n & 255; const int colr = kind == 0 ? n : (kind == 1 ? hyb_colmap(n) : (r >> 7) * 384 + pn * 128 + (r & 127));
    const bool okc = colr >= 0; const int col = okc ? colr : 0;
    {
        const char* base = (const char*)W;
        unsigned off = (unsigned)((k0 + ksub) * Nsrc + col) * 4u; const unsigned stride = (unsigned)Nsrc * 16u;
        f32x4 v[16];
#pragma unroll
        for (int i = 0; i < 16; ++i) { v[i] = *(const f32x4*)(base + off); off += stride; asm volatile("" : "+v"(off)); }
        if (kind == 1) {
#pragma unroll
            for (int i = 0; i < 16; ++i) v[i] = okc ? v[i] : (f32x4){0.f, 0.f, 0.f, 0.f};
        }
#pragma unroll
        for (int i = 0; i < 16; ++i) { LAS float* d = scr + (4 * i + ksub) * 65 + 4 * n4; d[0] = v[i].x; d[1] = v[i].y; d[2] = v[i].z; d[3] = v[i].w; }
    }
    const int c = lane & 3;
    f32x4 g[4];
#pragma unroll
    for (int q = 0; q < 4; ++q) g[q] = gain ? *(const f32x4*)(gain + k0 + 16 * c + 4 * q) * 32.f : (f32x4){32.f, 32.f, 32.f, 32.f};
    LDS_WAIT();
#pragma unroll
    for (int jx = 0; jx < 4; ++jx) {
        const int nn = (lane >> 2) + 16 * jx; const LAS float* s = scr + (16 * c) * 65 + nn;
        u32x4 o;
#pragma unroll
        for (int q = 0; q < 4; ++q) { int w = __builtin_amdgcn_cvt_pk_fp8_f32(s[(4 * q) * 65] * g[q].x, s[(4 * q + 1) * 65] * g[q].y, 0, false); w = __builtin_amdgcn_cvt_pk_fp8_f32(s[(4 * q + 2) * 65] * g[q].z, s[(4 * q + 3) * 65] * g[q].w, w, true); o[q] = (unsigned)w; }
        *(u32x4*)(Wt8 + (size_t)(n0 + nn) * K + k0 + 16 * c) = o;
    }
    LDS_WAIT();
}
__device__ __forceinline__ void rms_row_to_bf16(const float* __restrict__ xrow, bf16* __restrict__ orow, bf16* __restrict__ copy, int lane) {
    const f32x4* xr = (const f32x4*)xrow + lane;
    f32x4 v[4]; float s = 0.f;
#pragma unroll
    for (int j = 0; j < 4; ++j) { v[j] = xr[64 * j]; s += (v[j].x * v[j].x + v[j].y * v[j].y) + (v[j].z * v[j].z + v[j].w * v[j].w); }
    const float rstd = rsqrtf(wave_sum(s) * (1.f / 1024.f) + EPS);
    u32x2* o8 = (u32x2*)orow + lane;
#pragma unroll
    for (int j = 0; j < 4; ++j) { u32x2 w; w.x = pk2(v[j].x * rstd, v[j].y * rstd); w.y = pk2(v[j].z * rstd, v[j].w * rstd); o8[64 * j] = w; }
    if (copy) { u32x2* c4 = (u32x2*)copy + lane;
#pragma unroll
        for (int j = 0; j < 4; ++j) { u32x2 w; w.x = pk2(v[j].x, v[j].y); w.y = pk2(v[j].z, v[j].w); c4[64 * j] = w; } }
}

constexpr int MOE_W_PER_L = 16 * (192 + 96);
__device__ __forceinline__ void moe_weight_item(KArgs A, unsigned char* ws, LAS float* scr, const int l_lo, const int it, const int lane) {
    const int l = l_lo + it / MOE_W_PER_L; int r = it % MOE_W_PER_L;
    if (r < 16 * 192) { const int sl = l * 16 + r / 192; tr_item_f8(A->in[I_MOEIN] + (size_t)sl * 1024 * 768, 768, 1024, (unsigned char*)(ws + WS_WMIN) + (size_t)sl * 768 * 1024, A->in[I_NFFN] + l * 1024, 2, 12, scr, r % 192, lane); }
    else { r -= 16 * 192; const int sl = l * 16 + r / 96; tr_item(A->in[I_MOEOUT] + (size_t)sl * 384 * 1024, 1024, 384, (bf16*)(ws + WS_WMOUT) + (size_t)sl * 1024 * 384, nullptr, 0, 16, scr, r % 96, lane); }
}
__device__ __forceinline__ void moe_weight_share(KArgs A, int wv_, LAS float* scr, LAS unsigned* wq, const int l_lo, const int blk) {
    const int lane = opaque_tid(wv_) & 63;
    unsigned char* ws = opq(A->ws);
    constexpr int PER_BLK = 2 * MOE_W_PER_L / 256;
    for (;;) {
        unsigned k = 0; if (lane == 0) k = atomicAdd((unsigned*)wq, 1u);
        k = __builtin_amdgcn_readfirstlane(k);
        if (k >= (unsigned)PER_BLK) break;
        moe_weight_item(A, ws, scr, l_lo, blk * PER_BLK + (int)k, lane);
    }
}

__device__ __forceinline__ void phase_prologue(KArgs A, int wv_, LAS unsigned char* lds) {
    const int tid = opaque_tid(wv_), wid = __builtin_amdgcn_readfirstlane(tid >> 6), lane = tid & 63;
    const int gw = blockIdx.x * 8 + wid, NGW = gridDim.x * 8;
    LAS float* scr = (LAS float*)(lds + wid * 16640);
    unsigned char* ws = opq(A->ws);
    constexpr int N_HYB = 2 * 768, N_HOUT = 2 * 256, N_SGIN = 2 * 1024, N_SGOUT = 2 * 512, N_WQ = 4 * 256, N_WKV = 4 * 512, N_WO = 4 * 256, N_W1T = 4 * 32;
    constexpr int NITEMS = N_HYB + N_HOUT + N_SGIN + N_SGOUT + N_WQ + N_WKV + N_WO + N_W1T;
    for (int it = gw; it < NITEMS; it += NGW) {
        int r = it;
        if (r < N_HYB) { const int sl = r / 768; tr_item_f8(A->in[I_HYBIN] + (size_t)sl * 1024 * HYSRC, HYSRC, 1024, (unsigned char*)(ws + WS_WHYB) + (size_t)sl * HYN * 1024, A->in[I_NMIX] + (2 * sl) * 1024, 1, 48, scr, r % 768, lane); continue; } r -= N_HYB;
        if (r < N_HOUT) { const int sl = r / 256; tr_item_f8(A->in[I_HYBOUT] + (size_t)sl * 1024 * 1024, 1024, 1024, (unsigned char*)(ws + WS_WHOUT) + (size_t)sl * 1024 * 1024, nullptr, 0, 16, scr, r % 256, lane); continue; } r -= N_HOUT;
        if (r < N_SGIN) { const int sl = r / 1024; tr_item_f8(A->in[I_SGIN] + (size_t)sl * 1024 * 4096, 4096, 1024, (unsigned char*)(ws + WS_WSGIN) + (size_t)sl * 4096 * 1024, A->in[I_NMIX] + (2 * sl + 1) * 1024, 0, 64, scr, r % 1024, lane); continue; } r -= N_SGIN;
        if (r < N_SGOUT) { const int sl = r / 512; tr_item_f8(A->in[I_SGOUT] + (size_t)sl * 2048 * 1024, 1024, 2048, (unsigned char*)(ws + WS_WSGOUT) + (size_t)sl * 1024 * 2048, nullptr, 0, 16, scr, r % 512, lane); continue; } r -= N_SGOUT;
        if (r < N_WQ) { const int sl = r / 256; tr_item_f8(A->in[I_XWQ] + (size_t)sl * 1024 * 1024, 1024, 1024, (unsigned char*)(ws + WS_WQ) + (size_t)sl * 1024 * 1024, A->in[I_NXAT] + sl * 1024, 0, 16, scr, r % 256, lane); continue; } r -= N_WQ;
        if (r < N_WKV) { const int sl = r / 512; tr_item_f8(A->in[I_XWKV] + (size_t)sl * 1024 * 2048, 2048, 1024, (unsigned char*)(ws + WS_WKV) + (size_t)sl * 2048 * 1024, A->in[I_NMEM] + sl * 1024, 0, 32, scr, r % 512, lane); continue; } r -= N_WKV;
        if (r < N_WO) { const int sl = r / 256; tr_item_f8(A->in[I_XWO] + (size_t)sl * 1024 * 1024, 1024, 1024, (unsigned char*)(ws + WS_WO) + (size_t)sl * 1024 * 1024, nullptr, 0, 16, scr, r % 256, lane); continue; } r -= N_WO;
        { const int sl = r / 32; tr_item(A->in[I_CMPW1] + (size_t)sl * 2048 * 64, 64, 2048, (bf16*)(ws + WS_W1T) + (size_t)sl * 64 * 2048, nullptr, 0, 1, scr, r % 32, lane); }
    }
    for (int m = gw; m < T; m += NGW) {
        const f32x4* xr = (const f32x4*)(A->in[I_X] + (size_t)m * D) + lane;
        f32x4 v[4]; float sq = 0.f;
#pragma unroll
        for (int j = 0; j < 4; ++j) { v[j] = xr[64 * j]; sq += (v[j].x * v[j].x + v[j].y * v[j].y) + (v[j].z * v[j].z + v[j].w * v[j].w); }
        const float rstd = rsqrtf(wave_sum(sq) * (1.f / 1024.f) + EPS);
        unsigned* o4 = (unsigned*)((unsigned char*)(ws + WS_XN) + (size_t)m * D) + lane; u32x2* c4 = (u32x2*)((bf16*)(ws + WS_X16) + (size_t)m * D) + lane;
#pragma unroll
        for (int j = 0; j < 4; ++j) { int w = __builtin_amdgcn_cvt_pk_fp8_f32(v[j].x * rstd, v[j].y * rstd, 0, false); w = __builtin_amdgcn_cvt_pk_fp8_f32(v[j].z * rstd, v[j].w * rstd, w, true); o4[64 * j] = (unsigned)w; }
#pragma unroll
        for (int j = 0; j < 4; ++j) { u32x2 w; w.x = pk2(v[j].x, v[j].y); w.y = pk2(v[j].z, v[j].w); c4[64 * j] = w; }
    }
    for (int m = gw; m < NBATCH * NMEM; m += NGW) {
        const f32x4* xr = (const f32x4*)(A->in[I_MEM] + (size_t)m * D) + lane;
        f32x4 v[4]; float sq = 0.f;
#pragma unroll
        for (int j = 0; j < 4; ++j) { v[j] = xr[64 * j]; sq += (v[j].x * v[j].x + v[j].y * v[j].y) + (v[j].z * v[j].z + v[j].w * v[j].w); }
        const float rstd = rsqrtf(wave_sum(sq) * (1.f / 1024.f) + EPS);
        unsigned* o4 = (unsigned*)((unsigned char*)(ws + WS_MN) + (size_t)m * D) + lane;
#pragma unroll
        for (int j = 0; j < 4; ++j) { int w = __builtin_amdgcn_cvt_pk_fp8_f32(v[j].x * rstd, v[j].y * rstd, 0, false); w = __builtin_amdgcn_cvt_pk_fp8_f32(v[j].z * rstd, v[j].w * rstd, w, true); o4[64 * j] = (unsigned)w; }
    }
    const int gt = blockIdx.x * 512 + tid, NGT = gridDim.x * 512;
    const int* pos = (const int*)A->in[I_POS];
    float* cosT = (float*)(ws + WS_COS); float* sinT = (float*)(ws + WS_SIN);
    for (int i = gt; i < T * 32; i += NGT) {
        const int t = i >> 5, j = i & 31;
        const float ang = (float)pos[t] * A->freq[j];
        const double rev = (double)ang * 0.15915494309189533577;
        const float fr = (float)(rev - rint(rev));
        cosT[i] = __builtin_amdgcn_cosf(fr); sinT[i] = __builtin_amdgcn_sinf(fr);
    }
    { bf16* WSB = (bf16*)(ws + WS_WSB); float* M0 = (float*)(ws + WS_M0); const float* wsg = A->in[I_SGWS];
      for (int e = gt; e < 2 * 8 * 128 * 128; e += NGT) { const int s = e & 127, t = (e >> 7) & 127; WSB[e] = (bf16)f2bf(s <= t ? wsg[e] : 0.f); }
      for (int e = gt; e < 2 * 8 * 128; e += NGT) { const int t = e & 127; const float* r = wsg + (size_t)e * 128; float a = 0.f; for (int s = 0; s <= t; ++s) a += r[s]; M0[e] = a; } }
    float* RW = (float*)(ws + WS_RW);
    for (int i = gt; i < DEPTH * NEXP * D; i += NGT) { const int k = i & 1023, e = (i >> 10) & 15, l = i >> 14; RW[i] = A->in[I_RW][k * NEXP + e] * A->in[I_NFFN][l * D + k]; }
}

__device__ __forceinline__ void phase_knorm(KArgs A, int wv_, const int gw, const int NGW) {
    const int tid_ = opaque_tid(wv_); const int lane = tid_ & 63;
    bf16* KV = (bf16*)(opq(A->ws) + WS_KV);
    for (int it0 = gw * 4; it0 < DEPTH * 2048 * 4; it0 += NGW * 4) {
        u32x2 w[4];
#pragma unroll
        for (int q = 0; q < 4; ++q) { const int it = it0 + q; const int h = it & 3, m = (it >> 2) & 2047, l = it >> 13; w[q] = *(const u32x2*)(KV + (size_t)m * 8192 + l * 2048 + h * 256 + 4 * lane); }
        asm volatile("s_waitcnt vmcnt(0)" ::: "memory");
#pragma unroll
        for (int q = 0; q < 4; ++q) {
            const int it = it0 + q; const int h = it & 3, m = (it >> 2) & 2047, l = it >> 13;
            const float x0 = bflo(w[q].x), x1 = bfhi(w[q].x), x2 = bflo(w[q].y), x3 = bfhi(w[q].y);
            const float rstd = rsqrtf(wave_sum(x0 * x0 + x1 * x1 + x2 * x2 + x3 * x3) * (1.f / 256.f) + EPS);
            const f32x4 g = *(const f32x4*)(A->in[I_XKN] + l * 256 + 4 * lane) * *(const f32x4*)(A->in[I_XQN] + l * 256 + 4 * lane);
            int o = __builtin_amdgcn_cvt_pk_fp8_f32(x0 * rstd * g.x, x1 * rstd * g.y, 0, false); o = __builtin_amdgcn_cvt_pk_fp8_f32(x2 * rstd * g.z, x3 * rstd * g.w, o, true);
            *(unsigned*)((unsigned char*)KV + (size_t)m * 16384 + l * 4096 + h * 256 + 4 * lane) = (unsigned)o;
        }
    }
}

__device__ __forceinline__ int kpos64(int tok) { const int k = tok & 31; return (tok & 32) + 8 * ((k >> 2) & 3) + 4 * (k >> 4) + (k & 3); }
__device__ __forceinline__ int kperm64(int p) { const int fq = (p >> 3) & 3, j = p & 7; return (p & 32) + 16 * (j >> 2) + 4 * fq + (j & 3); }

__device__ __forceinline__ void phase_nsa_prep(KArgs A, int wv_, int i, LAS unsigned char* lds) {
    const int tid_ = opaque_tid(wv_); const int wid = __builtin_amdgcn_readfirstlane(tid_ >> 6), lane = tid_ & 63; const int gw = blockIdx.x * 8 + wid, NGW = gridDim.x * 8;
    unsigned char* ws = opq(A->ws);
    const bf16* HY = (const bf16*)(ws + WS_BIG);
    const float* cosT = (const float*)(ws + WS_COS); const float* sinT = (const float*)(ws + WS_SIN);
    bf16* QA = (bf16*)(ws + WS_QA); bf16* KS = (bf16*)(ws + WS_KS); bf16* KW = (bf16*)(ws + WS_KW);
    (void)lds;
    const int j8 = lane & 7, ug = lane >> 3;
    const int u1 = 8 + (ug & 3);
    const int src0 = C_QA + 64 * ug, src1 = u1 < 10 ? C_KS + 64 * (u1 - 8) : C_KW + 64 * (u1 - 10);
    const float* g0p = A->in[I_QNORM] + i * 64 + 8 * j8; const float* g1p = A->in[I_KNORM] + (i * 3 + (u1 < 10 ? 1 : 2)) * 64 + 8 * j8;
    const f32x4 g0a = *(const f32x4*)g0p, g0b = *(const f32x4*)(g0p + 4), g1a = *(const f32x4*)g1p, g1b = *(const f32x4*)(g1p + 4);
    u32x4 w0 = (u32x4){0u, 0u, 0u, 0u}, w1 = w0; f32x4 ca, cb, sa, sb;
    if (gw < T) { w0 = *(const u32x4*)(HY + (size_t)gw * HYN + src0 + 8 * j8); w1 = *(const u32x4*)(HY + (size_t)gw * HYN + src1 + 8 * j8);
        const float* cp = cosT + gw * 32 + 8 * (j8 & 3); const float* sp = sinT + gw * 32 + 8 * (j8 & 3); ca = *(const f32x4*)cp; cb = *(const f32x4*)(cp + 4); sa = *(const f32x4*)sp; sb = *(const f32x4*)(sp + 4); }
    for (int t = gw; t < T; t += NGW) {
        const int tn = t + NGW < T ? t + NGW : t;
        const u32x4 n0 = *(const u32x4*)(HY + (size_t)tn * HYN + src0 + 8 * j8), n1 = *(const u32x4*)(HY + (size_t)tn * HYN + src1 + 8 * j8);
        const float* cp = cosT + tn * 32 + 8 * (j8 & 3); const float* sp = sinT + tn * 32 + 8 * (j8 & 3);
        const f32x4 nca = *(const f32x4*)cp, ncb = *(const f32x4*)(cp + 4), nsa = *(const f32x4*)sp, nsb = *(const f32x4*)(sp + 4);
#pragma unroll
        for (int pass = 0; pass < 2; ++pass) {
            const u32x4 w = pass ? w1 : w0; const f32x4 ga = pass ? g1a : g0a, gb = pass ? g1b : g0b;
            float x[8] = {bflo(w.x), bfhi(w.x), bflo(w.y), bfhi(w.y), bflo(w.z), bfhi(w.z), bflo(w.w), bfhi(w.w)};
            float ssq = 0.f;
#pragma unroll
            for (int q = 0; q < 8; ++q) ssq += x[q] * x[q];
            ssq += __shfl_xor(ssq, 1); ssq += __shfl_xor(ssq, 2); ssq += __shfl_xor(ssq, 4);
            const float rs = rsqrtf(ssq * (1.f / 64.f) + EPS) * (pass ? 1.f : 0.125f * 1.4426950408889634f);
            const float gg[8] = {ga.x, ga.y, ga.z, ga.w, gb.x, gb.y, gb.z, gb.w}, cc[8] = {ca.x, ca.y, ca.z, ca.w, cb.x, cb.y, cb.z, cb.w}, ss[8] = {sa.x, sa.y, sa.z, sa.w, sb.x, sb.y, sb.z, sb.w};
            float o[8];
#pragma unroll
            for (int q = 0; q < 8; ++q) { const float y = x[q] * rs * gg[q]; const float pr = __shfl_xor(y, 4);
                o[q] = j8 < 4 ? y * cc[q] - pr * ss[q] : y * cc[q] + pr * ss[q]; }
            u32x4 ow; ow.x = pk2(o[0], o[1]); ow.y = pk2(o[2], o[3]); ow.z = pk2(o[4], o[5]); ow.w = pk2(o[6], o[7]);
            if (pass == 0) *(u32x4*)(QA + (size_t)t * 512 + 64 * ug + 8 * j8) = ow;
            else if (lane < 32) { bf16* dst = (u1 < 10 ? KS + (size_t)t * 128 + 64 * (u1 - 8) : KW + (size_t)t * 128 + 64 * (u1 - 10)); *(u32x4*)(dst + 8 * j8) = ow; }
        }
        w0 = n0; w1 = n1; ca = nca; cb = ncb; sa = nsa; sb = nsb;
    }
}

__device__ __forceinline__ void phase_compress_mfma(KArgs A, int wv_, int i, LAS unsigned char* lds) {
    const int tid = opaque_tid(wv_), wid = __builtin_amdgcn_readfirstlane(tid >> 6), lane = tid & 63, fr = lane & 15, fq = lane >> 4;
    unsigned char* ws = opq(A->ws);
    const bf16* HY = (const bf16*)(ws + WS_BIG);
    const float* cosT = (const float*)(ws + WS_COS); const float* sinT = (const float*)(ws + WS_SIN);
    LAS float* part = (LAS float*)lds;
    LAS float* hbuf = part + 8 * 1024;
    LAS float* obuf = hbuf + 1024;
    LAS float* w2l = obuf + 1024;
    int w2kv = -1;
    for (int it = blockIdx.x; it < 2 * 127; it += gridDim.x) {
        const int kv = it / 127, tile = it % 127;
        const float* pe = A->in[I_CMPPE] + (size_t)(i * 2 + kv) * 32 * 64;
        const float* w2 = A->in[I_CMPW2] + (size_t)(i * 2 + kv) * 64 * 64;
        const bf16* w1t = (const bf16*)(ws + WS_W1T) + (size_t)(i * 2 + kv) * 64 * 2048;
        const int coff = kv ? C_VC : C_KC;
        if (kv != w2kv) { __syncthreads(); for (int e4 = tid; e4 < 1024; e4 += 512) *(LAS f32x4*)(w2l + 4 * e4) = *(const f32x4*)(w2 + 4 * e4); w2kv = kv; }
        {
            const int R = tile * 16 + fr, g = R & 1, bn = R >> 1, n = bn % NCMP, b = bn / NCMP;
            const bf16* arow = HY + (size_t)(b * S + 16 * n) * HYN + coff + g * 64;
            f32x4 acc[4];
#pragma unroll
            for (int t = 0; t < 4; ++t) acc[t] = (f32x4){0.f, 0.f, 0.f, 0.f};
#pragma unroll 4
            for (int s = 0; s < 8; ++s) {
                const int k0 = 256 * wid + 32 * s, l = k0 >> 6, d0 = (k0 & 63) + 8 * fq;
                const u32x4 hw = *(const u32x4*)(arow + (size_t)l * HYN + d0);
                const f32x4 p0 = *(const f32x4*)(pe + l * 64 + d0), p1 = *(const f32x4*)(pe + l * 64 + d0 + 4);
                u32x4 aw; aw.x = pk2(bflo(hw.x) + p0.x, bfhi(hw.x) + p0.y); aw.y = pk2(bflo(hw.y) + p0.z, bfhi(hw.y) + p0.w); aw.z = pk2(bflo(hw.z) + p1.x, bfhi(hw.z) + p1.y); aw.w = pk2(bflo(hw.w) + p1.z, bfhi(hw.w) + p1.w);
                const bf16x8 af = __builtin_bit_cast(bf16x8, aw);
#pragma unroll
                for (int t = 0; t < 4; ++t) { const bf16x8 bfr = *(const bf16x8*)(w1t + (size_t)(16 * t + fr) * 2048 + k0 + 8 * fq);
                    acc[t] = __builtin_amdgcn_mfma_f32_16x16x32_bf16(af, bfr, acc[t], 0, 0, 0); }
            }
            __syncthreads();
#pragma unroll
            for (int t = 0; t < 4; ++t)
#pragma unroll
                for (int r = 0; r < 4; ++r) part[wid * 1024 + (4 * fq + r) * 64 + 16 * t + fr] = acc[t][r];
        }
        __syncthreads();
        for (int e = tid; e < 1024; e += 512) { float a = 0.f;
#pragma unroll
            for (int w = 0; w < 8; ++w) a += part[w * 1024 + e];
            hbuf[e] = gelu_tanh(a); }
        __syncthreads();
        for (int e = tid; e < 1024; e += 512) { const int r = e >> 6, j = e & 63; float o = 0.f;
#pragma unroll 8
            for (int m = 0; m < 64; ++m) o += hbuf[r * 64 + m] * w2l[m * 64 + j];
            obuf[e] = o; }
        __syncthreads();
        for (int r = wid; r < 16; r += 8) {
            const int R = tile * 16 + r, g = R & 1, bn = R >> 1, n = bn % NCMP, b = bn / NCMP;
            const float o = obuf[r * 64 + lane];
            if (kv == 0) {
                const float y = o * rsqrtf(wave_sum(o * o) * (1.f / 64.f) + EPS) * A->in[I_KNORM][(i * 3 + 0) * 64 + lane];
                const int tp = b * S + 16 * n + 31;
                const float c = cosT[tp * 32 + (lane & 31)], sn = sinT[tp * 32 + (lane & 31)];
                const float pr = __shfl_xor(y, 32);
                const float oo = lane < 32 ? y * c - pr * sn : y * c + pr * sn;
                ((bf16*)(ws + WS_KC))[((size_t)(b * 128 + n) * 2 + g) * 64 + lane] = (bf16)f2bf(oo);
            } else {
                bf16* vct = (bf16*)(ws + WS_VC) + ((size_t)(b * 2 + g) * 64 + lane) * 128;
                vct[(n & 64) + kpos64(n & 63)] = (bf16)f2bf(o);
                if (n == 126) vct[127] = 0;
            }
        }
    }
    __syncthreads();
}

__device__ __forceinline__ void nsa_softmax(f32x4 (&sc)[4], bf16x8 (&pf)[2], float& mrun, float& lrun, f32x4 (&o)[4], const bool rowok, const bool edge, const int kphi, const int kplo, const bool allrows, const int fq) {
    float bm = -INFINITY;
    if (edge) {
#pragma unroll
        for (int t = 0; t < 4; ++t)
#pragma unroll
            for (int r = 0; r < 4; ++r) { const int kp = 16 * t + 4 * fq + r; const bool v = rowok && kp <= kphi && kp >= kplo; sc[t][r] = v ? sc[t][r] : -INFINITY; bm = fmaxf(bm, sc[t][r]); }
    } else {
#pragma unroll
        for (int t = 0; t < 4; ++t) bm = fmaxf(bm, fmaxf(fmaxf(sc[t].x, sc[t].y), fmaxf(sc[t].z, sc[t].w)));
        if (!allrows) bm = rowok ? bm : -INFINITY;
    }
    bm = xmax32(xmax16(bm));
    const float mn = fmaxf(mrun, bm); const float mns = mn == -INFINITY ? 0.f : mn;
    float rs = 0.f;
#pragma unroll
    for (int t = 0; t < 4; ++t)
#pragma unroll
        for (int r = 0; r < 4; ++r) { sc[t][r] = __builtin_amdgcn_exp2f(sc[t][r] - mns); rs += sc[t][r]; }
    if (!edge && !allrows) {
#pragma unroll
        for (int t = 0; t < 4; ++t) sc[t] = rowok ? sc[t] : (f32x4){0.f, 0.f, 0.f, 0.f};
        rs = rowok ? rs : 0.f;
    }
    rs = xadd32(xadd16(rs));
    if (__all(mn == mrun)) { lrun += rs; }
    else {
        const float alpha = __builtin_amdgcn_exp2f(mrun - mns);
        lrun = lrun * alpha + rs; mrun = mn;
#pragma unroll
        for (int n = 0; n < 4; ++n) o[n] = o[n] * alpha;
    }
#pragma unroll
    for (int s = 0; s < 2; ++s) { u32x4 w; w.x = pk2(sc[2 * s].x, sc[2 * s].y); w.y = pk2(sc[2 * s].z, sc[2 * s].w); w.z = pk2(sc[2 * s + 1].x, sc[2 * s + 1].y); w.w = pk2(sc[2 * s + 1].z, sc[2 * s + 1].w);
        pf[s] = __builtin_bit_cast(bf16x8, w); }
}

__device__ __forceinline__ void phase_nsa_attn_mfma(KArgs A, int wv_, int i, LAS unsigned char* lds) {
    const int wid = wv_;
    unsigned char* ws = opq(A->ws);
    const bf16* HY = (const bf16*)(ws + WS_BIG); const bf16* QA = (const bf16*)(ws + WS_QA); const bf16* KS = (const bf16*)(ws + WS_KS); const bf16* KW = (const bf16*)(ws + WS_KW);
    const bf16* KC = (const bf16*)(ws + WS_KC); const bf16* VCT = (const bf16*)(ws + WS_VC); const bf16* VTA = (const bf16*)(ws + WS_VTA); bf16* CAT = (bf16*)(ws + WS_CAT);
    constexpr int RS = 80;
    LAS bf16* ktl = (LAS bf16*)lds;
    LAS bf16* vtl = ktl + 4 * 64 * RS;
    LAS float* scl = (LAS float*)(lds + 81920) + wid * 256;
    LAS unsigned* msk = (LAS unsigned*)(lds + 81920 + 8192);
    LAS unsigned* umask = msk + 64;
    const float* gb = A->in[I_GATEB] + i * 24;
    unsigned long long tsub = 0, tt0 = 0;
    for (int pit = blockIdx.x; pit < 256; pit += gridDim.x) {
#pragma unroll 1
        for (int hf = 0; hf < 2; ++hf) {
            const int tid = opaque_tid(wv_), lane = tid & 63, fr = lane & 15, fq = lane >> 4;
            const int bg = pit >> 4, xx = pit & 15, x = hf ? 31 - xx : xx, b = bg >> 1, g = bg & 1;
            const size_t tokbase = (size_t)b * S + 64 * x;
            const int tl0 = 8 * wid + (fr >> 2);
            if (tid == 0) *umask = 0u;
            if (PROBE_NSA == 1) tt0 = __builtin_amdgcn_s_memrealtime();
            bf16x8 qf[2][2];
#pragma unroll
            for (int mt = 0; mt < 2; ++mt)
#pragma unroll
                for (int s = 0; s < 2; ++s) qf[mt][s] = *(const bf16x8*)(QA + (tokbase + tl0 + 4 * mt) * 512 + (g * 4 + (fr & 3)) * 64 + 32 * s + 8 * fq);
            f32x4 outacc[2][4];
            {
                const int tmaxc = (4 * x + 3 + 15) >> 4;
                const bf16* kcb = KC + ((size_t)(b * 128 + fr) * 2 + g) * 64 + 8 * fq;
                bf16x8 pcf[2][4];
#pragma unroll
                for (int mt = 0; mt < 2; ++mt) {
                    f32x4 sc[8];
                    const bf16* kp = kcb;
#pragma unroll
                    for (int t = 0; t < 8; ++t) { sc[t] = (f32x4){0.f, 0.f, 0.f, 0.f};
                        asm volatile("" : "+v"(kp));
                        if (t < tmaxc) {
                            const bf16x8 k0 = *(const bf16x8*)(kp), k1 = *(const bf16x8*)(kp + 32);
                            sc[t] = __builtin_amdgcn_mfma_f32_16x16x32_bf16(k0, qf[mt][0], sc[t], 0, 0, 0);
                            sc[t] = __builtin_amdgcn_mfma_f32_16x16x32_bf16(k1, qf[mt][1], sc[t], 0, 0, 0); }
                        kp += 16 * 128; }
                    const int tg = 64 * x + tl0 + 4 * mt; const int ncv = tg >= 31 ? ((tg - 31) >> 4) + 1 : 0;
                    float mx = -INFINITY;
#pragma unroll
                    for (int t = 0; t < 8; ++t)
#pragma unroll
                        for (int r = 0; r < 4; ++r) { const bool v = 16 * t + 4 * fq + r < ncv; sc[t][r] = v ? sc[t][r] : -INFINITY; mx = fmaxf(mx, sc[t][r]); }
                    mx = xmax32(xmax16(mx));
                    const float mxs = mx == -INFINITY ? 0.f : mx;
                    float sum = 0.f;
#pragma unroll
                    for (int t = 0; t < 8; ++t)
#pragma unroll
                        for (int r = 0; r < 4; ++r) { sc[t][r] = __builtin_amdgcn_exp2f(sc[t][r] - mxs); sum += sc[t][r]; }
                    sum = xadd32(xadd16(sum));
                    const float inv = sum > 0.f ? 1.f / sum : 0.f;
#pragma unroll
                    for (int t = 0; t < 8; ++t) sc[t] = sc[t] * inv;
#pragma unroll
                    for (int s = 0; s < 4; ++s) { u32x4 w; w.x = pk2(sc[2 * s].x, sc[2 * s].y); w.y = pk2(sc[2 * s].z, sc[2 * s].w); w.z = pk2(sc[2 * s + 1].x, sc[2 * s + 1].y); w.w = pk2(sc[2 * s + 1].z, sc[2 * s + 1].w);
                        pcf[mt][s] = __builtin_bit_cast(bf16x8, w); }
                    float w3[8];
#pragma unroll
                    for (int t = 0; t < 8; ++t) {
#pragma unroll
                        for (int r = 0; r < 4; ++r) { float v = sc[t][r]; v += __shfl_xor(v, 1); v += __shfl_xor(v, 2); sc[t][r] = v; }
                        w3[t] = __shfl(sc[t].w, (lane + 48) & 63);
                    }
#pragma unroll
                    for (int t = 0; t < 8; ++t) {
                        const float prev = fq > 0 ? w3[t] : (t > 0 ? w3[t > 0 ? t - 1 : 0] : 0.f);
                        const float imp = sc[t].x + sc[t].y + sc[t].z + 0.5f * sc[t].w + 0.5f * prev;
                        if ((fr & 3) == 0) scl[(4 * mt + (fr >> 2)) * 32 + 4 * t + fq] = imp;
                    }
                    asm volatile("" ::: "memory");
                }
                const bf16* vcb = VCT + ((size_t)(b * 2 + g) * 64 + fr) * 128 + 8 * fq;
#pragma unroll
                for (int n = 0; n < 4; ++n) {
                    outacc[0][n] = (f32x4){0.f, 0.f, 0.f, 0.f}; outacc[1][n] = (f32x4){0.f, 0.f, 0.f, 0.f};
                    asm volatile("" : "+v"(vcb));
#pragma unroll
                    for (int s = 0; s < 4; ++s) if (2 * s < tmaxc) {
                        const bf16x8 vf = *(const bf16x8*)(vcb + 32 * s);
                        outacc[0][n] = __builtin_amdgcn_mfma_f32_16x16x32_bf16(vf, pcf[0][s], outacc[0][n], 0, 0, 0);
                        outacc[1][n] = __builtin_amdgcn_mfma_f32_16x16x32_bf16(vf, pcf[1][s], outacc[1][n], 0, 0, 0); }
                    vcb += 16 * 128;
                    asm volatile("" ::: "memory");
                }
            }
            float g1v[2], g2v[2];
#pragma unroll
            for (int mt = 0; mt < 2; ++mt) {
                const int head = g * 4 + (fr & 3);
                const bf16* gl = HY + (tokbase + tl0 + 4 * mt) * HYN + C_GA + head * 3;
                const float g0 = sigmoidf_(bf2f(gl[0]) + gb[head * 3 + 0]);
                g1v[mt] = sigmoidf_(bf2f(gl[1]) + gb[head * 3 + 1]); g2v[mt] = sigmoidf_(bf2f(gl[2]) + gb[head * 3 + 2]);
#pragma unroll
                for (int n = 0; n < 4; ++n) outacc[mt][n] = outacc[mt][n] * g0;
            }
            LDS_WAIT();
            asm volatile("" ::: "memory");
            {
                const int tok8 = lane >> 3, jg = lane & 7;
                float sj[32];
#pragma unroll
                for (int q = 0; q < 8; ++q) { const f32x4 v = *(const LAS f32x4*)(scl + tok8 * 32 + 4 * q); sj[4 * q] = v.x; sj[4 * q + 1] = v.y; sj[4 * q + 2] = v.z; sj[4 * q + 3] = v.w; }
#pragma unroll
                for (int j = 0; j < 32; ++j) sj[j] = j <= x ? sj[j] + ((j == 0 || j == x || j == x - 1) ? 1000.0f : 0.f) : -INFINITY;
                unsigned bits = 0u;
                const f32x4 mv = *(const LAS f32x4*)(scl + tok8 * 32 + 4 * jg);
#pragma unroll
                for (int q = 0; q < 4; ++q) {
                    const int j = 4 * jg + q;
                    const float mine = j <= x ? mv[q] + ((j == 0 || j == x || j == x - 1) ? 1000.0f : 0.f) : -INFINITY;
                    int rank = 0;
#pragma unroll
                    for (int jj = 0; jj < 32; ++jj) rank += (sj[jj] > mine || (sj[jj] == mine && jj < j)) ? 1 : 0;
                    bits |= (j <= x && rank < 8) ? (1u << j) : 0u;
                }
                bits |= __shfl_xor(bits, 1); bits |= __shfl_xor(bits, 2); bits |= __shfl_xor(bits, 4);
                if (jg == 0) { msk[wid * 8 + tok8] = bits; atomicOr((unsigned*)umask, bits); }
            }
            __syncthreads();
            if (PROBE_NSA == 1) tsub += __builtin_amdgcn_s_memrealtime() - tt0;
#pragma unroll 1
            for (int pp = 0; pp < 2 + (PROBE_NSAX ? 1 : 0); ++pp) {
                const int pass = pp == 2 ? 0 : pp; const bool dummy = pp == 2;
                if (PROBE_NSA == 2 + pass) tt0 = __builtin_amdgcn_s_memrealtime();
                const int jlo = pass ? (x >= 4 ? x - 4 : 0) : 0;
                const unsigned inrange = (x >= 31 ? 0xffffffffu : ((2u << x) - 1u)) & ~((1u << jlo) - 1u);
                unsigned bmask = pass ? inrange : (*umask & inrange);
                const bf16* Kb = pass ? KW : KS; const int cg = (pass ? 10 : 8) + g;
                unsigned tm[2], wm[2], am[2];
#pragma unroll
                for (int mt = 0; mt < 2; ++mt) {
                    tm[mt] = pass ? 0xffffffffu : msk[wid * 8 + 4 * mt + (fr >> 2)];
                    wm[mt] = pass ? 0xffffffffu : (msk[wid * 8 + 4 * mt] | msk[wid * 8 + 4 * mt + 1] | msk[wid * 8 + 4 * mt + 2] | msk[wid * 8 + 4 * mt + 3]);
                    am[mt] = pass ? 0xffffffffu : (msk[wid * 8 + 4 * mt] & msk[wid * 8 + 4 * mt + 1] & msk[wid * 8 + 4 * mt + 2] & msk[wid * 8 + 4 * mt + 3]);
                    wm[mt] = __builtin_amdgcn_readfirstlane(wm[mt]); am[mt] = __builtin_amdgcn_readfirstlane(am[mt]);
                    if (PROBE_NSAX == 2 && dummy) wm[mt] = 0u;
                }
                f32x4 o[2][4]; float mrun[2], lrun[2];
#pragma unroll
                for (int mt = 0; mt < 2; ++mt) { mrun[mt] = -INFINITY; lrun[mt] = 0.f;
#pragma unroll
                    for (int n = 0; n < 4; ++n) o[mt][n] = (f32x4){0.f, 0.f, 0.f, 0.f}; }
                const int srow = tid >> 3, sc16 = tid & 7;
                u32x4 pk0 = (u32x4){0u, 0u, 0u, 0u}, pv0 = pk0, pk1 = pk0, pv1 = pk0;
#define NSA_LD(jx, pk, pv) do { const bf16* ksrc = Kb + ((size_t)b * S + 64 * (jx) + srow) * 128 + g * 64 + sc16 * 8; const bf16* vsrc = VTA + ((size_t)((b * 32 + (jx)) * 12 + cg)) * 4096 + srow * 64 + sc16 * 8; \
                    pk = *(const u32x4*)ksrc; pv = *(const u32x4*)vsrc; } while (0)
                int j0 = __ffs(bmask) - 1; bmask &= bmask - 1u;
                int j1 = bmask ? __ffs(bmask) - 1 : -1; bmask &= bmask - 1u;
                NSA_LD(j0, pk0, pv0); if (j1 >= 0) NSA_LD(j1, pk1, pv1);
                int buf = 0;
                while (j0 >= 0) {
                    *(LAS u32x4*)(ktl + (buf * 2 + 0) * 64 * RS + srow * RS + sc16 * 8) = pk0; *(LAS u32x4*)(vtl + (buf * 2 + 0) * 64 * RS + srow * RS + sc16 * 8) = pv0;
                    if (j1 >= 0) { *(LAS u32x4*)(ktl + (buf * 2 + 1) * 64 * RS + srow * RS + sc16 * 8) = pk1; *(LAS u32x4*)(vtl + (buf * 2 + 1) * 64 * RS + srow * RS + sc16 * 8) = pv1; }
                    const int jn0 = bmask ? __ffs(bmask) - 1 : -1; bmask &= bmask - 1u;
                    const int jn1 = bmask ? __ffs(bmask) - 1 : -1; bmask &= bmask - 1u;
                    if (jn0 >= 0) NSA_LD(jn0, pk0, pv0);
                    if (jn1 >= 0) NSA_LD(jn1, pk1, pv1);
                    __syncthreads();
#pragma unroll 1
                    for (int sub = 0; sub < 2; ++sub) {
                        const int j = sub ? j1 : j0;
                        if (j < 0) break;
                        const LAS bf16* kt = ktl + (buf * 2 + sub) * 64 * RS + fr * RS + 8 * fq; const LAS bf16* vt = vtl + (buf * 2 + sub) * 64 * RS + fr * RS + 8 * fq;
                        const bool nd0 = (wm[0] >> j) & 1u, nd1 = (wm[1] >> j) & 1u;
                        if (!(nd0 || nd1)) continue;
                        const bool edge = (j == x) || (pass && j == x - 4);
                        f32x4 sc0[4], sc1[4];
#pragma unroll
                        for (int t = 0; t < 4; ++t) { sc0[t] = (f32x4){0.f, 0.f, 0.f, 0.f}; sc1[t] = (f32x4){0.f, 0.f, 0.f, 0.f};
                            const bf16x8 k0_ = *(const LAS bf16x8*)(kt + t * 16 * RS), k1_ = *(const LAS bf16x8*)(kt + t * 16 * RS + 32);
                            if (nd0) { sc0[t] = __builtin_amdgcn_mfma_f32_16x16x32_bf16(k0_, qf[0][0], sc0[t], 0, 0, 0); sc0[t] = __builtin_amdgcn_mfma_f32_16x16x32_bf16(k1_, qf[0][1], sc0[t], 0, 0, 0); }
                            if (nd1) { sc1[t] = __builtin_amdgcn_mfma_f32_16x16x32_bf16(k0_, qf[1][0], sc1[t], 0, 0, 0); sc1[t] = __builtin_amdgcn_mfma_f32_16x16x32_bf16(k1_, qf[1][1], sc1[t], 0, 0, 0); } }
                        bf16x8 pf0[2], pf1[2];
                        if (nd0) nsa_softmax(sc0, pf0, mrun[0], lrun[0], o[0], (tm[0] >> j) & 1u, edge, j == x ? tl0 : 63, (pass && j == x - 4) ? tl0 + 1 : 0, (am[0] >> j) & 1u, fq);
                        if (nd1) nsa_softmax(sc1, pf1, mrun[1], lrun[1], o[1], (tm[1] >> j) & 1u, edge, j == x ? tl0 + 4 : 63, (pass && j == x - 4) ? tl0 + 5 : 0, (am[1] >> j) & 1u, fq);
#pragma unroll
                        for (int n = 0; n < 4; ++n) {
                            const bf16x8 v0_ = *(const LAS bf16x8*)(vt + n * 16 * RS), v1_ = *(const LAS bf16x8*)(vt + n * 16 * RS + 32);
                            if (nd0) { o[0][n] = __builtin_amdgcn_mfma_f32_16x16x32_bf16(v0_, pf0[0], o[0][n], 0, 0, 0); o[0][n] = __builtin_amdgcn_mfma_f32_16x16x32_bf16(v1_, pf0[1], o[0][n], 0, 0, 0); }
                            if (nd1) { o[1][n] = __builtin_amdgcn_mfma_f32_16x16x32_bf16(v0_, pf1[0], o[1][n], 0, 0, 0); o[1][n] = __builtin_amdgcn_mfma_f32_16x16x32_bf16(v1_, pf1[1], o[1][n], 0, 0, 0); } }
                    }
                    j0 = jn0; j1 = jn1; buf ^= 1;
                }
#undef NSA_LD
#pragma unroll
                for (int mt = 0; mt < 2; ++mt) { const float sc_ = (pass ? g2v[mt] : g1v[mt]) / lrun[mt];
                    if (!dummy) {
#pragma unroll
                    for (int n = 0; n < 4; ++n) outacc[mt][n] = outacc[mt][n] + o[mt][n] * sc_; } }
                __syncthreads();
                if (PROBE_NSA == 2 + pass) tsub += __builtin_amdgcn_s_memrealtime() - tt0;
            }
#pragma unroll
            for (int mt = 0; mt < 2; ++mt) {
                unsigned char* dst = (unsigned char*)CAT + (tokbase + tl0 + 4 * mt) * 1024 + (g * 4 + (fr & 3)) * 64 + 4 * fq;
#pragma unroll
                for (int n = 0; n < 4; ++n) { int w = __builtin_amdgcn_cvt_pk_fp8_f32(outacc[mt][n].x, outacc[mt][n].y, 0, false); w = __builtin_amdgcn_cvt_pk_fp8_f32(outacc[mt][n].z, outacc[mt][n].w, w, true); *(unsigned*)(dst + 16 * n) = (unsigned)w; }
            }
        }
    }
    __syncthreads();
    if (PROBE_NSA && blockIdx.x == 0 && opaque_tid(wv_) == 0) atomicAdd((unsigned long long*)(ws + WS_CTL + 48000), tsub);
}

__device__ __forceinline__ void phase_vtiles(KArgs A, int wv_, LAS unsigned char* lds) {
    const int tid_ = opaque_tid(wv_); const int wid = __builtin_amdgcn_readfirstlane(tid_ >> 6), lane = tid_ & 63; const int gw = blockIdx.x * 8 + wid, NGW = gridDim.x * 8;
    unsigned char* ws = opq(A->ws);
    const bf16* HY = (const bf16*)(ws + WS_BIG); bf16* VTA = (bf16*)(ws + WS_VTA);
    constexpr int TS = 66;
    LAS bf16* tl = (LAS bf16*)(lds + 65536) + wid * (64 * TS);
    for (int it = gw; it < NBATCH * 32 * 12; it += NGW) {
        const int cg = it % 12, bc = it / 12;
        const int colbase = cg < 8 ? C_VB + cg * 64 : (cg < 10 ? C_VS + (cg - 8) * 64 : C_VW + (cg - 10) * 64);
        const u32x4* src = (const u32x4*)(HY + (size_t)(bc * 64 + lane) * HYN + colbase);
        u32x4 w[8];
#pragma unroll
        for (int i = 0; i < 8; ++i) w[i] = src[i];
#pragma unroll
        for (int i = 0; i < 8; ++i) { LAS unsigned* d = (LAS unsigned*)(tl + lane * TS + 8 * i); d[0] = w[i].x; d[1] = w[i].y; d[2] = w[i].z; d[3] = w[i].w; }
        LDS_WAIT();
        bf16* dst = VTA + (size_t)it * 4096 + lane * 64;
#pragma unroll
        for (int p8 = 0; p8 < 8; ++p8) {
            unsigned short x[8];
#pragma unroll
            for (int j = 0; j < 8; ++j) x[j] = tl[kperm64(p8 * 8 + j) * TS + lane];
            u32x4 o; o.x = x[0] | ((unsigned)x[1] << 16); o.y = x[2] | ((unsigned)x[3] << 16); o.z = x[4] | ((unsigned)x[5] << 16); o.w = x[6] | ((unsigned)x[7] << 16);
            *(u32x4*)(dst + p8 * 8) = o;
        }
        LDS_WAIT();
    }
}

__device__ __forceinline__ void vtrans_wave(KArgs A, int wv_, LAS bf16* tl, const int gw, const int NGW) {
    const int tid_ = opaque_tid(wv_); const int lane = tid_ & 63;
    unsigned char* ws = opq(A->ws);
    const bf16* KV = (const bf16*)(ws + WS_KV); bf16* VT = (bf16*)(ws + WS_VT);
    constexpr int TS = 66;
    for (int it = gw; it < DEPTH * NBATCH * 4 * 16; it += NGW) {
        const int db = it & 3, kb = (it >> 2) & 3, h = (it >> 4) & 3, b = (it >> 6) & 7, l = it >> 9;
        const u32x4* src = (const u32x4*)(KV + (size_t)(b * 256 + 64 * kb + lane) * 8192 + l * 2048 + 1024 + h * 256 + 64 * db);
        u32x4 w[8];
#pragma unroll
        for (int i = 0; i < 8; ++i) w[i] = src[i];
#pragma unroll
        for (int i = 0; i < 8; ++i) { LAS unsigned* d = (LAS unsigned*)(tl + lane * TS + 8 * i); d[0] = w[i].x; d[1] = w[i].y; d[2] = w[i].z; d[3] = w[i].w; }
        LDS_WAIT();
        unsigned char* dst = (unsigned char*)VT + ((size_t)((l * 8 + b) * 4 + h) * 256 + 64 * db + lane) * 256 + 64 * kb;
#pragma unroll
        for (int c = 0; c < 4; ++c) {
            u32x4 o;
#pragma unroll
            for (int q = 0; q < 4; ++q) {
                const float v0 = bf2f(tl[(16 * q + 4 * c + 0) * TS + lane]), v1 = bf2f(tl[(16 * q + 4 * c + 1) * TS + lane]), v2 = bf2f(tl[(16 * q + 4 * c + 2) * TS + lane]), v3 = bf2f(tl[(16 * q + 4 * c + 3) * TS + lane]);
                int t_ = __builtin_amdgcn_cvt_pk_fp8_f32(v0, v1, 0, false); t_ = __builtin_amdgcn_cvt_pk_fp8_f32(v2, v3, t_, true); o[q] = (unsigned)t_; }
            *(u32x4*)(dst + 16 * c) = o;
        }
        LDS_WAIT();
    }
}

__device__ __forceinline__ float log_sigmoid16(float z) { return (fminf(z, 0.f) - __logf(1.0f + __expf(-fabsf(z)))) * (1.f / 16.f); }
#define GLA_Z(tokv) ({ float z_ = bias; _Pragma("unroll") for (int r_ = 0; r_ < 16; ++r_) z_ += __builtin_bit_cast(float, __builtin_amdgcn_readlane(__builtin_bit_cast(int, al[r_]), (tokv))) * wc[r_]; z_; })
#define GLA_LOAD_GATE() \
    float al[16], wc[16]; \
    { const u32x4* ap_ = (const u32x4*)(HY + (size_t)(tok0 + lane) * HYN + C_AL); const u32x4 a0_ = ap_[0], a1_ = ap_[1]; \
      al[0] = bflo(a0_.x); al[1] = bfhi(a0_.x); al[2] = bflo(a0_.y); al[3] = bfhi(a0_.y); al[4] = bflo(a0_.z); al[5] = bfhi(a0_.z); al[6] = bflo(a0_.w); al[7] = bfhi(a0_.w); \
      al[8] = bflo(a1_.x); al[9] = bfhi(a1_.x); al[10] = bflo(a1_.y); al[11] = bfhi(a1_.y); al[12] = bflo(a1_.z); al[13] = bfhi(a1_.z); al[14] = bflo(a1_.w); al[15] = bfhi(a1_.w); } \
    _Pragma("unroll") for (int r_ = 0; r_ < 16; ++r_) wc[r_] = A->in[I_WA2][(i * 16 + r_) * 256 + h * 64 + lane]; \
    const float bias = A->in[I_BA][i * 256 + h * 64 + lane];

__device__ __forceinline__ void phase_gla_a(KArgs A, int wv_, int i, LAS unsigned char* lds) {
    const int tid_ = opaque_tid(wv_); const int wid = __builtin_amdgcn_readfirstlane(tid_ >> 6), lane = tid_ & 63, fr = lane & 15, fq = lane >> 4;
    unsigned char* ws = opq(A->ws);
    const bf16* HY = (const bf16*)(ws + WS_BIG); const bf16* VTA = (const bf16*)(ws + WS_VTA); float* SLOC = (float*)(ws + WS_SLOC); float* DEC = (float*)(ws + WS_DEC); float* EB = (float*)(ws + WS_QX);
    constexpr int RS = 80;
    const int p = wid & 3, half = wid >> 2;
    LAS bf16* kh = (LAS bf16*)lds + p * (64 * RS);
    LAS float* xs = (LAS float*)(lds + 4 * 64 * RS * 2) + p * 128;
    const int G = (int)gridDim.x;
    for (int base = 0; base < 1024; base += 4 * G) {
        const int it = base + p * G + (int)blockIdx.x; const bool valid = it < 1024;
        const int itc = valid ? it : 0;
        const int c = itc & 31, bh = itc >> 5, b = bh >> 2, h = bh & 3; const size_t tok0 = (size_t)b * S + c * 64;
        GLA_LOAD_GATE();
        float hs = 0.f; float la[32];
#pragma unroll
        for (int tk = 0; tk < 32; ++tk) { la[tk] = log_sigmoid16(GLA_Z(32 * half + tk)); hs += la[tk]; }
        xs[half * 64 + lane] = hs;
        unsigned short kcol[32];
#pragma unroll
        for (int tk = 0; tk < 32; ++tk) kcol[tk] = HY[(tok0 + 32 * half + tk) * HYN + C_KB + h * 64 + lane];
        const bf16* vt = VTA + ((size_t)((b * 32 + c) * 12 + h * 2 + half)) * 4096;
        bf16x8 vf[4][2];
#pragma unroll
        for (int n = 0; n < 4; ++n)
#pragma unroll
            for (int s = 0; s < 2; ++s) vf[n][s] = *(const bf16x8*)(vt + (16 * n + fr) * 64 + 32 * s + 8 * fq);
        __syncthreads();
        const float h0 = xs[lane], h1 = xs[64 + lane]; const float bl = h0 + h1;
        float bc = half ? h0 : 0.f;
        if (valid) {
#pragma unroll
            for (int tk = 0; tk < 32; ++tk) {
                bc += la[tk];
                EB[(tok0 + 32 * half + tk) * 256 + h * 64 + lane] = bc;
                kh[lane * RS + kpos64(32 * half + tk)] = (bf16)f2bf(bf2f(kcol[tk]) * __expf(bl - bc));
            }
            if (half == 0) DEC[it * 64 + lane] = __expf(bl);
        }
        __syncthreads();
        if (valid) {
#pragma unroll
            for (int m = 0; m < 4; ++m) {
                const bf16x8 a0 = *(const LAS bf16x8*)(kh + (16 * m + fr) * RS + 8 * fq), a1 = *(const LAS bf16x8*)(kh + (16 * m + fr) * RS + 32 + 8 * fq);
#pragma unroll
                for (int n = 0; n < 4; ++n) {
                    f32x4 acc = (f32x4){0.f, 0.f, 0.f, 0.f};
                    acc = __builtin_amdgcn_mfma_f32_16x16x32_bf16(vf[n][0], a0, acc, 0, 0, 0);
                    acc = __builtin_amdgcn_mfma_f32_16x16x32_bf16(vf[n][1], a1, acc, 0, 0, 0);
                    *(f32x4*)(SLOC + ((size_t)it * 64 + 16 * m + fr) * 128 + half * 64 + 16 * n + 4 * fq) = acc;
                }
            }
        }
        __syncthreads();
    }
}
__device__ __forceinline__ void phase_gla_c(KArgs A, int wv_, int i, LAS unsigned char* lds, const bool kv_post, const int Lcur) {
    const int tid_ = opaque_tid(wv_); const int wid = __builtin_amdgcn_readfirstlane(tid_ >> 6), lane = tid_ & 63, fr = lane & 15, fq = lane >> 4; const int gw = blockIdx.x * 8 + wid, NGW = gridDim.x * 8;
    unsigned char* ws = opq(A->ws);
    const bf16* HY = (const bf16*)(ws + WS_BIG); const bf16* VTA = (const bf16*)(ws + WS_VTA); const bf16* STT = (const bf16*)(ws + WS_STT); bf16* CAT = (bf16*)(ws + WS_CAT);
    constexpr int RS = 80;
    LAS bf16* qs = (LAS bf16*)lds + wid * (128 * RS);
    LAS bf16* ks = qs + 64 * RS;
    const float* og = A->in[I_ONORM] + i * 128;
    LAS unsigned* wq = (LAS unsigned*)(lds + 152064 + 1024);
    LAS float* ogl = (LAS float*)(lds + 152064);
    if (tid_ < 128) ogl[tid_] = og[tid_];
    (void)gw; (void)NGW;
    for (int blk = blockIdx.x; blk < 256; blk += gridDim.x) {
        if (tid_ == 0) *wq = 0u;
        SUBT_BEGIN(1);
        {
            const float* SLOC = (const float*)(ws + WS_SLOC); const float* DEC = (const float*)(ws + WS_DEC); bf16* STw = (bf16*)(ws + WS_STT);
            const int tid = tid_, dv = tid & 127, ko = tid >> 7, bh = blk >> 3, c0 = (blk & 7) * 4;
            float sv[16];
#pragma unroll
            for (int j = 0; j < 16; ++j) sv[j] = 0.f;
#pragma unroll 1
            for (int cb = 0; cb < c0 + 4; cb += 4) {
                float dc4[4][16], sl4[4][16];
#pragma unroll
                for (int q = 0; q < 4; ++q) {
                    const size_t item = (size_t)bh * 32 + cb + q; const float* sl = SLOC + (item * 64 + ko * 16) * 128 + dv; const float* dc = DEC + item * 64 + ko * 16;
#pragma unroll
                    for (int j = 0; j < 16; ++j) { dc4[q][j] = dc[j]; sl4[q][j] = sl[j * 128]; }
                }
#pragma unroll
                for (int q = 0; q < 4; ++q) {
                    const int c = cb + q; const size_t item = (size_t)bh * 32 + c;
                    if (c >= c0) {
                        u32x4 o0, o1; o0.x = pk2(sv[0], sv[1]); o0.y = pk2(sv[2], sv[3]); o0.z = pk2(sv[4], sv[5]); o0.w = pk2(sv[6], sv[7]);
                        o1.x = pk2(sv[8], sv[9]); o1.y = pk2(sv[10], sv[11]); o1.z = pk2(sv[12], sv[13]); o1.w = pk2(sv[14], sv[15]);
                        u32x4* d = (u32x4*)(STw + (item * 128 + dv) * 64 + ko * 16); d[0] = o0; d[1] = o1;
                    }
#pragma unroll
                    for (int j = 0; j < 16; ++j) sv[j] = dc4[q][j] * sv[j] + sl4[q][j];
                }
            }
            asm volatile("s_waitcnt vmcnt(0)" ::: "memory");
            __syncthreads();
        }
        SUBT_END(1, ws, tid_);
        SUBT_BEGIN(2);
        SUBT_BEGIN(3);
        if (wid < 4) {
        const int it = blk * 4 + wid;
        const int c = it & 31, bh = it >> 5, b = bh >> 2, h = bh & 3; const size_t tok0 = (size_t)b * S + c * 64;
        const float* EB = (const float*)(ws + WS_QX);
#pragma unroll
        for (int hh = 0; hh < 2; ++hh) {
            unsigned short qcol[32], kcol[32]; float bcv[32];
#pragma unroll
            for (int tk = 0; tk < 32; ++tk) { const bf16* row = HY + (tok0 + 32 * hh + tk) * HYN; qcol[tk] = row[C_QB + h * 64 + lane]; kcol[tk] = row[C_KB + h * 64 + lane]; bcv[tk] = EB[(tok0 + 32 * hh + tk) * 256 + h * 64 + lane]; }
#pragma unroll
            for (int tk = 0; tk < 32; ++tk) {
                const float eb = __expf(bcv[tk]), ei = __expf(-bcv[tk]);
                qs[(32 * hh + tk) * RS + lane] = (bf16)f2bf(bf2f(qcol[tk]) * 0.125f * eb); ks[(32 * hh + tk) * RS + lane] = (bf16)f2bf(bf2f(kcol[tk]) * ei);
            }
        }
        LDS_WAIT();
        SUBT_END(2, ws, tid_);
        bf16x8 st[8][2];
#pragma unroll
        for (int n = 0; n < 8; ++n)
#pragma unroll
            for (int s = 0; s < 2; ++s) st[n][s] = *(const bf16x8*)(STT + ((size_t)it * 128 + 16 * n + fr) * 64 + 32 * s + 8 * fq);
        const bf16* vt = VTA + ((size_t)((b * 32 + c) * 12 + h * 2)) * 4096;
        bf16x8 vfr[8];
#pragma unroll
        for (int n = 0; n < 8; ++n) { const bf16* vrow = vt + (size_t)(n >> 2) * 4096 + (16 * (n & 3) + fr) * 64 + 8 * fq; vfr[n] = *(const bf16x8*)vrow; }
#pragma unroll
        for (int mi = 0; mi < 4; ++mi) {
            const bf16x8 q0 = *(const LAS bf16x8*)(qs + (16 * mi + fr) * RS + 8 * fq), q1 = *(const LAS bf16x8*)(qs + (16 * mi + fr) * RS + 32 + 8 * fq);
            u32x2 rwv[8];
#pragma unroll
            for (int n = 0; n < 8; ++n) rwv[n] = *(const u32x2*)(HY + (tok0 + 16 * mi + fr) * HYN + C_RB + h * 128 + 16 * n + 4 * fq);
            f32x4 sc[4];
#pragma unroll
            for (int t = 0; t < 4; ++t) {
                sc[t] = (f32x4){0.f, 0.f, 0.f, 0.f};
                if (t <= mi) {
                    const bf16x8 k0 = *(const LAS bf16x8*)(ks + (16 * t + fr) * RS + 8 * fq), k1 = *(const LAS bf16x8*)(ks + (16 * t + fr) * RS + 32 + 8 * fq);
                    sc[t] = __builtin_amdgcn_mfma_f32_16x16x32_bf16(k0, q0, sc[t], 0, 0, 0);
                    sc[t] = __builtin_amdgcn_mfma_f32_16x16x32_bf16(k1, q1, sc[t], 0, 0, 0);
                    if (t == mi) {
                        sc[t].x = (4 * fq + 0 <= fr) ? sc[t].x : 0.f; sc[t].y = (4 * fq + 1 <= fr) ? sc[t].y : 0.f; sc[t].z = (4 * fq + 2 <= fr) ? sc[t].z : 0.f; sc[t].w = (4 * fq + 3 <= fr) ? sc[t].w : 0.f; }
                }
            }
            bf16x8 pf[2];
#pragma unroll
            for (int s = 0; s < 2; ++s) { u32x4 w; w.x = pk2(sc[2 * s].x, sc[2 * s].y); w.y = pk2(sc[2 * s].z, sc[2 * s].w); w.z = pk2(sc[2 * s + 1].x, sc[2 * s + 1].y); w.w = pk2(sc[2 * s + 1].z, sc[2 * s + 1].w);
                pf[s] = __builtin_bit_cast(bf16x8, w); }
            f32x4 o[8]; float ssq = 0.f;
#pragma unroll
            for (int n = 0; n < 8; ++n) {
                o[n] = (f32x4){0.f, 0.f, 0.f, 0.f};
                o[n] = __builtin_amdgcn_mfma_f32_16x16x32_bf16(st[n][0], q0, o[n], 0, 0, 0);
                o[n] = __builtin_amdgcn_mfma_f32_16x16x32_bf16(st[n][1], q1, o[n], 0, 0, 0);
                o[n] = __builtin_amdgcn_mfma_f32_16x16x32_bf16(vfr[n], pf[0], o[n], 0, 0, 0);
                if (mi >= 2) o[n] = __builtin_amdgcn_mfma_f32_16x16x32_bf16(*(const bf16x8*)(vt + (size_t)(n >> 2) * 4096 + (16 * (n & 3) + fr) * 64 + 8 * fq + 32), pf[1], o[n], 0, 0, 0);
                ssq += (o[n].x * o[n].x + o[n].y * o[n].y) + (o[n].z * o[n].z + o[n].w * o[n].w);
            }
            ssq = xadd32(xadd16(ssq));
            const float rstd = rsqrtf(ssq * (1.f / 128.f) + EPS);
            const size_t tok = tok0 + 16 * mi + fr;
#pragma unroll
            for (int n = 0; n < 8; ++n) {
                const int dv = 16 * n + 4 * fq;
                const u32x2 rw = rwv[n]; const f32x4 g = *(const LAS f32x4*)(ogl + dv);
                const float r0 = bflo(rw.x), r1 = bfhi(rw.x), r2 = bflo(rw.y), r3 = bfhi(rw.y);
                int w = __builtin_amdgcn_cvt_pk_fp8_f32(o[n].x * rstd * g.x * (r0 * sigmoidf_(r0)), o[n].y * rstd * g.y * (r1 * sigmoidf_(r1)), 0, false);
                w = __builtin_amdgcn_cvt_pk_fp8_f32(o[n].z * rstd * g.z * (r2 * sigmoidf_(r2)), o[n].w * rstd * g.w * (r3 * sigmoidf_(r3)), w, true);
                *(unsigned*)((unsigned char*)CAT + tok * 1024 + 512 + h * 128 + dv) = (unsigned)w;
            }
        }
        } else {
            if (kv_post) {
                phase_knorm(A, wv_, blk * 4 + (wid - 4), 256 * 4);
                vtrans_wave(A, wv_, (LAS bf16*)(lds + 81920 + (wid - 4) * 16640), blk * 4 + (wid - 4), 256 * 4);
            }
            moe_weight_share(A, wv_, (LAS float*)(lds + 81920 + (wid - 4) * 16640), wq, Lcur, blk);
        }
        if (wid < 4) { LDS_WAIT(); moe_weight_share(A, wv_, (LAS float*)(lds + wid * 20480), wq, Lcur, blk); }
        SUBT_END(3, ws, tid_);
        LDS_WAIT();
        __syncthreads();
    }
}

__device__ __forceinline__ void phase_sgu_mix_mfma(KArgs A, int wv_, int i, LAS unsigned char* lds) {
    const int tid = opaque_tid(wv_), wid = __builtin_amdgcn_readfirstlane(tid >> 6), lane = tid & 63, fr = lane & 15, fq = lane >> 4;
    unsigned char* ws = opq(A->ws);
    const bf16* U = (const bf16*)(ws + WS_U); const bf16* V = (const bf16*)(ws + WS_V); bf16* UM = (bf16*)(ws + WS_UM);
    const bf16* WSB = (const bf16*)(ws + WS_WSB) + (size_t)i * 8 * 16384; const float* M0 = (const float*)(ws + WS_M0) + i * 8 * 128;
    constexpr int VS = 144;
    LAS bf16* vT = (LAS bf16*)lds;
    LAS float* st = (LAS float*)(lds + 256 * VS * 2);
    LAS bf16* wl = (LAS bf16*)(lds + 256 * VS * 2 + 1024);
    const float* lng = A->in[I_LNG] + i * 2048; const float* lnb = A->in[I_LNB] + i * 2048; const float* bsg = A->in[I_SGBS] + i * 8 * 128;
    for (int it = blockIdx.x; it < 256; it += gridDim.x) {
        const int gh = it & 1, n_ = (it >> 1) & 15, b = it >> 5; const size_t tok0 = (size_t)b * S + n_ * 128;
        __syncthreads();
        {
            const float* vst = (const float*)(ws + WS_VSTAT);
#pragma unroll
            for (int s4 = 0; s4 < 16; s4 += 4) {
                const int s = wid * 16 + s4 + (lane >> 4);
                const f32x4 p = *(const f32x4*)(vst + (tok0 + s) * 64 + 4 * (lane & 15));
                float sum = p.x + p.z, sq = p.y + p.w;
                sum += __shfl_xor(sum, 1); sq += __shfl_xor(sq, 1); sum += __shfl_xor(sum, 2); sq += __shfl_xor(sq, 2);
                sum += __shfl_xor(sum, 4); sq += __shfl_xor(sq, 4); sum += __shfl_xor(sum, 8); sq += __shfl_xor(sq, 8);
                const float mean = sum * (1.f / 2048.f); const float var = fmaxf(sq * (1.f / 2048.f) - mean * mean, 0.f);
                if ((lane & 15) == 0) { st[2 * s] = mean; st[2 * s + 1] = rsqrtf(var + EPS); }
            }
        }
#pragma unroll 1
        for (int gg = 0; gg < 4; ++gg) {
            const int g = gh * 4 + gg;
            __syncthreads();
            {
                const int s = tid & 127, cq = tid >> 7;
                const float mean = st[2 * s], rstd = st[2 * s + 1];
                const u32x4* src = (const u32x4*)((const unsigned char*)V + (tok0 + s) * 2048 + g * 256 + cq * 64);
                u32x4 w8[4], ww[4];
#pragma unroll
                for (int i4 = 0; i4 < 4; ++i4) w8[i4] = src[i4];
#pragma unroll
                for (int q = 0; q < 4; ++q) { const int e = tid + 512 * q; ww[q] = *(const u32x4*)(WSB + ((size_t)g * 128 + (e >> 4)) * 128 + (e & 15) * 8); }
#pragma unroll
                for (int i4 = 0; i4 < 4; ++i4)
#pragma unroll
                    for (int q = 0; q < 4; ++q) {
                        const int wq_ = (int)w8[i4][q];
                        const f32x2 lo = __builtin_amdgcn_cvt_pk_f32_fp8(wq_, false), hi = __builtin_amdgcn_cvt_pk_f32_fp8(wq_, true);
                        LAS bf16* d = vT + (cq * 64 + i4 * 16 + q * 4) * VS + s;
                        d[0 * VS] = (bf16)f2bf((lo.x - mean) * rstd); d[1 * VS] = (bf16)f2bf((lo.y - mean) * rstd); d[2 * VS] = (bf16)f2bf((hi.x - mean) * rstd); d[3 * VS] = (bf16)f2bf((hi.y - mean) * rstd);
                    }
#pragma unroll
                for (int q = 0; q < 4; ++q) { const int e = tid + 512 * q; *(LAS u32x4*)(wl + (e >> 4) * VS + (e & 15) * 8) = ww[q]; }
            }
            unsigned uw[8][2]; float m0v[8], bsv[8];
#pragma unroll
            for (int n = 0; n < 8; ++n) { const int t = 16 * n + fr; m0v[n] = M0[g * 128 + t]; bsv[n] = bsg[g * 128 + t];
                const size_t ro = (tok0 + t) * 2048 + g * 256 + 32 * wid + 4 * fq; uw[n][0] = *(const unsigned*)((const unsigned char*)U + ro); uw[n][1] = *(const unsigned*)((const unsigned char*)U + ro + 16); }
            __syncthreads();
            bf16x8 vf[2][4];
#pragma unroll
            for (int m = 0; m < 2; ++m)
#pragma unroll
                for (int k = 0; k < 4; ++k) vf[m][k] = *(const LAS bf16x8*)(vT + (32 * wid + 16 * m + fr) * VS + 32 * k + 8 * fq);
            f32x4 gc[2], bc[2];
#pragma unroll
            for (int m = 0; m < 2; ++m) { gc[m] = *(const f32x4*)(lng + g * 256 + 32 * wid + 16 * m + 4 * fq); bc[m] = *(const f32x4*)(lnb + g * 256 + 32 * wid + 16 * m + 4 * fq); }
#pragma unroll
            for (int n = 0; n < 8; ++n) {
                f32x4 a0 = (f32x4){0.f, 0.f, 0.f, 0.f}, a1 = (f32x4){0.f, 0.f, 0.f, 0.f};
#pragma unroll
                for (int k = 0; k < 4; ++k) if (k <= (n >> 1)) {
                    const bf16x8 wf = *(const LAS bf16x8*)(wl + (16 * n + fr) * VS + 32 * k + 8 * fq);
                    a0 = __builtin_amdgcn_mfma_f32_16x16x32_bf16(vf[0][k], wf, a0, 0, 0, 0);
                    a1 = __builtin_amdgcn_mfma_f32_16x16x32_bf16(vf[1][k], wf, a1, 0, 0, 0); }
                const int t = 16 * n + fr; const float m0 = m0v[n], bsv_ = bsv[n];
                const size_t ro = (tok0 + t) * 2048 + g * 256 + 32 * wid + 4 * fq;
#pragma unroll
                for (int m = 0; m < 2; ++m) {
                    const f32x4 a = m ? a1 : a0;
                    const f32x2 u01 = __builtin_amdgcn_cvt_pk_f32_fp8((int)uw[n][m], false), u23 = __builtin_amdgcn_cvt_pk_f32_fp8((int)uw[n][m], true);
                    int w = __builtin_amdgcn_cvt_pk_fp8_f32((a.x * gc[m].x + bc[m].x * m0 + bsv_) * u01.x, (a.y * gc[m].y + bc[m].y * m0 + bsv_) * u01.y, 0, false);
                    w = __builtin_amdgcn_cvt_pk_fp8_f32((a.z * gc[m].z + bc[m].z * m0 + bsv_) * u23.x, (a.w * gc[m].w + bc[m].w * m0 + bsv_) * u23.y, w, true);
                    *(unsigned*)((unsigned char*)UM + ro + 16 * m) = (unsigned)w;
                }
            }
        }
    }
    __syncthreads();
}

#define XA_MFMA8(accv, av, bv) asm volatile("v_mfma_f32_16x16x128_f8f6f4 %0, %1, %2, %0" : "+v"(accv) : "v"(av), "v"(bv))
__device__ __forceinline__ void xattn_item(KArgs A, int wv_, int L, LAS unsigned char* lds, const int b, const int h, const int qt) {
    const int tid = opaque_tid(wv_), wid = __builtin_amdgcn_readfirstlane(tid >> 6), lane = tid & 63, fr = lane & 15, fq = lane >> 4;
    unsigned char* ws = opq(A->ws);
    const unsigned char* QX = ws + WS_QX; const unsigned char* KV = ws + WS_KV; const unsigned char* VT = ws + WS_VT; unsigned char* OX = ws + WS_OX;
    constexpr int RS = 288;
    LAS unsigned char* kl = lds;
    {
        __syncthreads();
        {
            const int row = tid >> 1, hf = tid & 1;
            const u32x4* src = (const u32x4*)(KV + (size_t)(b * 256 + row) * 16384 + L * 4096 + h * 256 + hf * 128);
            u32x4 w[8];
#pragma unroll
            for (int i = 0; i < 8; ++i) w[i] = src[i];
#pragma unroll
            for (int i = 0; i < 8; ++i) *(LAS u32x4*)(kl + row * RS + hf * 128 + i * 16) = w[i];
        }
        const size_t tok0 = (size_t)b * S + qt * 256 + wid * 32 + fr;
        pg8::i32x8_ qf[2][2];
#pragma unroll
        for (int mt = 0; mt < 2; ++mt)
#pragma unroll
            for (int f = 0; f < 2; ++f) { const unsigned char* qp = QX + (tok0 + 16 * mt) * 1024 + h * 256 + 128 * f + 16 * fq;
                qf[mt][f] = __builtin_shufflevector(*(const pg8::i32x4_*)qp, *(const pg8::i32x4_*)(qp + 64), 0, 1, 2, 3, 4, 5, 6, 7); }
        __syncthreads();
        pg8::i32x8_ pf[2][2]; float inv[2];
#pragma unroll
        for (int mt = 0; mt < 2; ++mt) {
            float ssq = 0.f;
#pragma unroll
            for (int f = 0; f < 2; ++f)
#pragma unroll
                for (int q = 0; q < 8; ++q) { const f32x2 lo = __builtin_amdgcn_cvt_pk_f32_fp8(qf[mt][f][q], false), hi = __builtin_amdgcn_cvt_pk_f32_fp8(qf[mt][f][q], true); ssq += (lo.x * lo.x + lo.y * lo.y) + (hi.x * hi.x + hi.y * hi.y); }
            ssq = xadd32(xadd16(ssq));
            const float rstd = rsqrtf(ssq * (1.f / 256.f) + EPS) * 0.0625f;
            f32x4 sc[16];
#pragma unroll
            for (int hf = 0; hf < 2; ++hf) {
                unsigned kb = (unsigned)(size_t)(kl + (128 * hf + fr) * RS + 16 * fq); asm volatile("" : "+v"(kb));
#pragma unroll
                for (int t8 = 0; t8 < 8; ++t8) sc[8 * hf + t8] = (f32x4){0.f, 0.f, 0.f, 0.f};
                asm volatile("s_nop 15" : "+v"(sc[8 * hf + 0]), "+v"(sc[8 * hf + 1]), "+v"(sc[8 * hf + 2]), "+v"(sc[8 * hf + 3]), "+v"(sc[8 * hf + 4]), "+v"(sc[8 * hf + 5]), "+v"(sc[8 * hf + 6]), "+v"(sc[8 * hf + 7]));
#pragma unroll
                for (int f = 0; f < 2; ++f) {
#pragma unroll
                    for (int t8 = 0; t8 < 8; ++t8) { const int t = 8 * hf + t8;
                        const pg8::i32x8_ kf = __builtin_shufflevector(*(const LAS pg8::i32x4_*)(size_t)(kb + (unsigned)(16 * t8 * RS + 128 * f)), *(const LAS pg8::i32x4_*)(size_t)(kb + (unsigned)(16 * t8 * RS + 128 * f + 64)), 0, 1, 2, 3, 4, 5, 6, 7);
                        XA_MFMA8(sc[t], kf, qf[mt][f]);
                        if (t8 & 1) asm volatile("" ::: "memory"); }
                }
            }
            asm volatile("s_nop 15\n\ts_nop 15" : "+v"(sc[0]), "+v"(sc[1]), "+v"(sc[2]), "+v"(sc[3]), "+v"(sc[4]), "+v"(sc[5]), "+v"(sc[6]), "+v"(sc[7]), "+v"(sc[8]), "+v"(sc[9]), "+v"(sc[10]), "+v"(sc[11]), "+v"(sc[12]), "+v"(sc[13]), "+v"(sc[14]), "+v"(sc[15]));
            float mx = -INFINITY;
#pragma unroll
            for (int t = 0; t < 16; ++t) mx = fmaxf(mx, fmaxf(fmaxf(sc[t].x, sc[t].y), fmaxf(sc[t].z, sc[t].w)));
            mx = xmax32(xmax16(mx));
            float lsum = 0.f;
#pragma unroll
            for (int t = 0; t < 16; ++t) { sc[t].x = __expf((sc[t].x - mx) * rstd); sc[t].y = __expf((sc[t].y - mx) * rstd); sc[t].z = __expf((sc[t].z - mx) * rstd); sc[t].w = __expf((sc[t].w - mx) * rstd); lsum += (sc[t].x + sc[t].y) + (sc[t].z + sc[t].w); }
            lsum = xadd32(xadd16(lsum));
            inv[mt] = 1.f / lsum;
#pragma unroll
            for (int f = 0; f < 2; ++f)
#pragma unroll
                for (int q = 0; q < 8; ++q) { int w_ = __builtin_amdgcn_cvt_pk_fp8_f32(sc[8 * f + q].x, sc[8 * f + q].y, 0, false); w_ = __builtin_amdgcn_cvt_pk_fp8_f32(sc[8 * f + q].z, sc[8 * f + q].w, w_, true); pf[mt][f][q] = w_; }
        }
        __syncthreads();
        {
            const int row = tid >> 1, hf = tid & 1;
            const u32x4* src = (const u32x4*)(VT + ((size_t)((L * 8 + b) * 4 + h) * 256 + (row & ~31) + pg8::perm32(row & 31)) * 256 + hf * 128);
            u32x4 w[8];
#pragma unroll
            for (int i = 0; i < 8; ++i) w[i] = src[i];
#pragma unroll
            for (int i = 0; i < 8; ++i) *(LAS u32x4*)(kl + row * RS + hf * 128 + i * 16) = w[i];
        }
        __syncthreads();
        asm volatile("s_nop 15" : "+v"(pf[0][0]), "+v"(pf[0][1]), "+v"(pf[1][0]), "+v"(pf[1][1]));
#pragma unroll
        for (int hf = 0; hf < 2; ++hf) {
            unsigned vb = (unsigned)(size_t)(kl + (128 * hf + fr) * RS + 16 * fq); asm volatile("" : "+v"(vb));
#pragma unroll
            for (int p4 = 0; p4 < 4; ++p4) { const int p = 4 * hf + p4; f32x4 o0a = (f32x4){0.f, 0.f, 0.f, 0.f}, o1a = o0a, o0b = o0a, o1b = o0a;
#pragma unroll
                for (int f = 0; f < 2; ++f) {
                    const pg8::i32x8_ va = __builtin_shufflevector(*(const LAS pg8::i32x4_*)(size_t)(vb + (unsigned)(32 * p4 * RS + 128 * f)), *(const LAS pg8::i32x4_*)(size_t)(vb + (unsigned)(32 * p4 * RS + 128 * f + 64)), 0, 1, 2, 3, 4, 5, 6, 7);
                    const pg8::i32x8_ vc = __builtin_shufflevector(*(const LAS pg8::i32x4_*)(size_t)(vb + (unsigned)((32 * p4 + 16) * RS + 128 * f)), *(const LAS pg8::i32x4_*)(size_t)(vb + (unsigned)((32 * p4 + 16) * RS + 128 * f + 64)), 0, 1, 2, 3, 4, 5, 6, 7);
                    if (f == 0) asm volatile("s_nop 15" : "+v"(o0a), "+v"(o1a), "+v"(o0b), "+v"(o1b));
                    XA_MFMA8(o0a, va, pf[0][f]); XA_MFMA8(o1a, va, pf[1][f]); XA_MFMA8(o0b, vc, pf[0][f]); XA_MFMA8(o1b, vc, pf[1][f]); }
                asm volatile("s_nop 15\n\ts_nop 15" : "+v"(o0a), "+v"(o1a), "+v"(o0b), "+v"(o1b));
                u32x2 w0, w1; int t_; const float inv0 = inv[0], inv1 = inv[1];
                t_ = __builtin_amdgcn_cvt_pk_fp8_f32(o0a.x * inv0, o0a.y * inv0, 0, false); t_ = __builtin_amdgcn_cvt_pk_fp8_f32(o0a.z * inv0, o0a.w * inv0, t_, true); w0.x = (unsigned)t_;
                t_ = __builtin_amdgcn_cvt_pk_fp8_f32(o0b.x * inv0, o0b.y * inv0, 0, false); t_ = __builtin_amdgcn_cvt_pk_fp8_f32(o0b.z * inv0, o0b.w * inv0, t_, true); w0.y = (unsigned)t_;
                t_ = __builtin_amdgcn_cvt_pk_fp8_f32(o1a.x * inv1, o1a.y * inv1, 0, false); t_ = __builtin_amdgcn_cvt_pk_fp8_f32(o1a.z * inv1, o1a.w * inv1, t_, true); w1.x = (unsigned)t_;
                t_ = __builtin_amdgcn_cvt_pk_fp8_f32(o1b.x * inv1, o1b.y * inv1, 0, false); t_ = __builtin_amdgcn_cvt_pk_fp8_f32(o1b.z * inv1, o1b.w * inv1, t_, true); w1.y = (unsigned)t_;
                *(u32x2*)(OX + tok0 * 1024 + h * 256 + 32 * p + 8 * fq) = w0;
                *(u32x2*)(OX + (tok0 + 16) * 1024 + h * 256 + 32 * p + 8 * fq) = w1;
                asm volatile("" ::: "memory"); }
        }
    }
    __syncthreads();
}
#undef XA_MFMA8

__device__ __forceinline__ void phase_route_mfma(KArgs A, int wv_, int L, LAS unsigned char* lds) {
    const int tid = opaque_tid(wv_), wid = __builtin_amdgcn_readfirstlane(tid >> 6), lane = tid & 63, fr = lane & 15, fq = lane >> 4;
    unsigned char* ws = opq(A->ws);
    const float* RW = (const float*)(ws + WS_RW) + (size_t)L * NEXP * D;
    unsigned* cnt = (unsigned*)(ws + WS_CTL) + CW_CNT + L * 64;
    int* list = (int*)(ws + WS_LIST); int* te = (int*)(ws + WS_TOK); int* tp = te + 2 * T; float* tw = (float*)(tp + 2 * T);
    bf16* XN = (bf16*)(ws + WS_XN);
    constexpr int WSTR = 1040;
    LAS bf16* rwh = (LAS bf16*)lds;
    LAS bf16* rwl = rwh + 16 * WSTR;
    LAS float* xch = (LAS float*)(lds + 2 * 16 * WSTR * 2);
    LAS unsigned* lcnt = (LAS unsigned*)(lds + 2 * 16 * WSTR * 2 + 8 * 320 * 4);
    LAS unsigned* lbase = lcnt + 16;
    for (int e4 = tid; e4 < NEXP * D / 4; e4 += 512) {
        const f32x4 w = *(const f32x4*)(RW + 4 * e4);
        u32x2 h; h.x = pk2(w.x, w.y); h.y = pk2(w.z, w.w);
        u32x2 l; l.x = pk2(w.x - bflo(h.x), w.y - bfhi(h.x)); l.y = pk2(w.z - bflo(h.y), w.w - bfhi(h.y));
        const int e = (4 * e4) >> 10, k = (4 * e4) & 1023;
        *(LAS u32x2*)(rwh + e * WSTR + k) = h; *(LAS u32x2*)(rwl + e * WSTR + k) = l;
    }
    const int tg = wid >> 1, kh = wid & 1;
    const float rbv = A->in[I_RB][fr];
    for (int blk = blockIdx.x; blk < T / 64; blk += gridDim.x) {
        __syncthreads();
        if (tid < 16) lcnt[tid] = 0u;
        const size_t tok = (size_t)blk * 64 + 16 * tg + fr;
        const bf16* xrow = (const bf16*)(ws + WS_X16) + tok * D + 512 * kh + 8 * fq;
        f32x4 acc = (f32x4){0.f, 0.f, 0.f, 0.f}; float ssq = 0.f;
        bf16x8 ah[16];
#pragma unroll
        for (int s = 0; s < 16; ++s) ah[s] = *(const bf16x8*)(xrow + 32 * s);
#pragma unroll
        for (int s = 0; s < 16; ++s) {
            const u32x4 hw = __builtin_bit_cast(u32x4, ah[s]);
            const float x0 = bflo(hw.x), x1 = bfhi(hw.x), x2 = bflo(hw.y), x3 = bfhi(hw.y), x4 = bflo(hw.z), x5 = bfhi(hw.z), x6 = bflo(hw.w), x7 = bfhi(hw.w);
            ssq += ((x0 * x0 + x1 * x1) + (x2 * x2 + x3 * x3)) + ((x4 * x4 + x5 * x5) + (x6 * x6 + x7 * x7));
            const bf16x8 bh = *(const LAS bf16x8*)(rwh + fr * WSTR + 512 * kh + 32 * s + 8 * fq), bl = *(const LAS bf16x8*)(rwl + fr * WSTR + 512 * kh + 32 * s + 8 * fq);
            acc = __builtin_amdgcn_mfma_f32_16x16x32_bf16(ah[s], bh, acc, 0, 0, 0);
            acc = __builtin_amdgcn_mfma_f32_16x16x32_bf16(ah[s], bl, acc, 0, 0, 0);
        }
        ssq = xadd32(xadd16(ssq));
        LAS float* mine = xch + wid * 320; const LAS float* other = xch + (wid ^ 1) * 320;
#pragma unroll
        for (int r = 0; r < 4; ++r) mine[(4 * fq + r) * 20 + fr] = acc[r];
        if (fq == 0) mine[fr * 20 + 16] = ssq;
        __syncthreads();
        const float rstd = rsqrtf((ssq + other[fr * 20 + 16]) * (1.f / 1024.f) + EPS);
        {
            unsigned char* xo = (unsigned char*)XN + tok * D + 512 * kh + 8 * fq;
#pragma unroll
            for (int s = 0; s < 16; ++s) { const u32x4 hw = __builtin_bit_cast(u32x4, ah[s]);
                int w0 = __builtin_amdgcn_cvt_pk_fp8_f32(bflo(hw.x) * rstd, bfhi(hw.x) * rstd, 0, false); w0 = __builtin_amdgcn_cvt_pk_fp8_f32(bflo(hw.y) * rstd, bfhi(hw.y) * rstd, w0, true);
                int w1 = __builtin_amdgcn_cvt_pk_fp8_f32(bflo(hw.z) * rstd, bfhi(hw.z) * rstd, 0, false); w1 = __builtin_amdgcn_cvt_pk_fp8_f32(bflo(hw.w) * rstd, bfhi(hw.w) * rstd, w1, true);
                u32x2 o; o.x = (unsigned)w0; o.y = (unsigned)w1;
                *(u32x2*)(xo + 32 * s) = o; }
        }
        int e0r[4], e1r[4], r0r[4], r1r[4]; float w0r[4];
        if (kh == 0) {
#pragma unroll
            for (int r = 0; r < 4; ++r) {
                const float rs = __shfl(rstd, 4 * fq + r);
                const float lg = (acc[r] + other[(4 * fq + r) * 20 + fr]) * rs + rbv;
                float v0 = lg; v0 = fmaxf(v0, __shfl_xor(v0, 1)); v0 = fmaxf(v0, __shfl_xor(v0, 2)); v0 = fmaxf(v0, __shfl_xor(v0, 4)); v0 = fmaxf(v0, __shfl_xor(v0, 8));
                const unsigned long long bm0 = __ballot(lg == v0);
                const int e0 = __ffs((unsigned)(bm0 >> (16 * fq)) & 0xffffu) - 1;
                const bool c2 = (fr >> 2) == (e0 >> 2) && fr != e0;
                const float m2 = c2 ? lg : -INFINITY;
                float v1 = m2; v1 = fmaxf(v1, __shfl_xor(v1, 1)); v1 = fmaxf(v1, __shfl_xor(v1, 2)); v1 = fmaxf(v1, __shfl_xor(v1, 4)); v1 = fmaxf(v1, __shfl_xor(v1, 8));
                const unsigned long long bm1 = __ballot(c2 && m2 == v1);
                const int e1 = __ffs((unsigned)(bm1 >> (16 * fq)) & 0xffffu) - 1;
                e0r[r] = e0; e1r[r] = e1; w0r[r] = 1.f / (1.f + __expf(v1 - v0));
                r0r[r] = 0; r1r[r] = 0;
                if (fr == 0) { r0r[r] = (int)atomicAdd((unsigned*)(lcnt + e0), 1u); r1r[r] = (int)atomicAdd((unsigned*)(lcnt + e1), 1u); }
            }
        }
        __syncthreads();
        if (tid < 16) lbase[tid] = atomicAdd(&cnt[tid], lcnt[tid]);
        __syncthreads();
        if (kh == 0 && fr == 0) {
#pragma unroll
            for (int r = 0; r < 4; ++r) {
                const int t = blk * 64 + 16 * tg + 4 * fq + r;
                const int p0 = (int)lbase[e0r[r]] + r0r[r], p1 = (int)lbase[e1r[r]] + r1r[r];
                list[e0r[r] * T + p0] = t; list[e1r[r] * T + p1] = t;
                te[2 * t] = e0r[r]; te[2 * t + 1] = e1r[r]; tp[2 * t] = p0; tp[2 * t + 1] = p1; tw[2 * t] = w0r[r]; tw[2 * t + 1] = 1.f - w0r[r];
            }
        }
    }
    __syncthreads();
}

__device__ __forceinline__ void moe_offsets(KArgs A, int wv_, int L, LAS int* off, LAS int* cn) {
    const int t = opaque_tid(wv_);
    if (t < 64) {
        const unsigned* cnt = (const unsigned*)(opq(A->ws) + WS_CTL) + CW_CNT + L * 64;
        const int c = t < 16 ? (int)cnt[t] : 0;
        const int p = (c + 255) & ~255;
        int incl = p;
#pragma unroll
        for (int d = 1; d < 16; d <<= 1) { const int v = __shfl_up(incl, d); incl += (t & 15) >= d ? v : 0; }
        if (t < 16) { off[t] = incl - p; cn[t] = c; }
        if (t == 15) off[16] = incl;
    }
    __syncthreads();
}
__device__ __forceinline__ void phase_moe_combine(KArgs A, int wv_, int L, LAS unsigned char* lds) {
    LAS int* off = (LAS int*)lds; LAS int* cn = off + 32;
    moe_offsets(A, wv_, L, off, cn);
    const int tid_ = opaque_tid(wv_); const int wid = __builtin_amdgcn_readfirstlane(tid_ >> 6), lane = tid_ & 63; const int gw = blockIdx.x * 8 + wid, NGW = gridDim.x * 8;
    unsigned char* ws = opq(A->ws);
    const int* te = (const int*)(ws + WS_TOK); const int* tp = te + 2 * T; const float* tw = (const float*)(tp + 2 * T);
    const unsigned char* Y8 = (const unsigned char*)(ws + WS_Y); bf16* XN = (bf16*)(ws + WS_XN); bf16* X16 = (bf16*)(ws + WS_X16); const bool last = L == DEPTH - 1;
    const int nq = (T - gw + NGW - 1) / NGW;
    for (int q0 = 0; q0 < nq; q0 += 8) {
        int s0m = 0, s1m = 0; float w0m = 0.f, w1m = 0.f;
        { const int qq = q0 + (lane & 7); const int t = gw + NGW * (qq < nq ? qq : nq - 1);
          s0m = off[te[2 * t]] + tp[2 * t]; s1m = off[te[2 * t + 1]] + tp[2 * t + 1]; w0m = tw[2 * t]; w1m = tw[2 * t + 1]; }
        const int nn = nq - q0 < 8 ? nq - q0 : 8;
        f32x4 v[4]; u32x2 xv[4], xn[4]; unsigned ya[4], yb[4], yan[4], ybn[4];
        { const int t = gw + NGW * q0; const int sl0 = __builtin_amdgcn_readlane(s0m, 0), sl1 = __builtin_amdgcn_readlane(s1m, 0);
#pragma unroll
          for (int j = 0; j < 4; ++j) { xv[j] = ((const u32x2*)(X16 + (size_t)t * D) + lane)[64 * j]; ya[j] = ((const unsigned*)(Y8 + (size_t)sl0 * D) + lane)[64 * j]; yb[j] = ((const unsigned*)(Y8 + (size_t)sl1 * D) + lane)[64 * j]; } }
#pragma unroll 1
        for (int q = 0; q < nn; ++q) {
            const int t = gw + NGW * (q0 + q);
            const int qn = q + 1 < nn ? q + 1 : q;
            { const int tn = gw + NGW * (q0 + qn); const int sl0 = __builtin_amdgcn_readlane(s0m, qn), sl1 = __builtin_amdgcn_readlane(s1m, qn);
#pragma unroll
              for (int j = 0; j < 4; ++j) { xn[j] = ((const u32x2*)(X16 + (size_t)tn * D) + lane)[64 * j]; yan[j] = ((const unsigned*)(Y8 + (size_t)sl0 * D) + lane)[64 * j]; ybn[j] = ((const unsigned*)(Y8 + (size_t)sl1 * D) + lane)[64 * j]; } }
            const float w0 = 0.125f * __builtin_bit_cast(float, __builtin_amdgcn_readlane(__builtin_bit_cast(int, w0m), q)), w1 = 0.125f * __builtin_bit_cast(float, __builtin_amdgcn_readlane(__builtin_bit_cast(int, w1m), q));
            float s = 0.f;
#pragma unroll
            for (int j = 0; j < 4; ++j) {
                const f32x2 a01 = __builtin_amdgcn_cvt_pk_f32_fp8((int)ya[j], false), a23 = __builtin_amdgcn_cvt_pk_f32_fp8((int)ya[j], true), b01 = __builtin_amdgcn_cvt_pk_f32_fp8((int)yb[j], false), b23 = __builtin_amdgcn_cvt_pk_f32_fp8((int)yb[j], true);
                v[j].x = bflo(xv[j].x) + w0 * a01.x + w1 * b01.x; v[j].y = bfhi(xv[j].x) + w0 * a01.y + w1 * b01.y; v[j].z = bflo(xv[j].y) + w0 * a23.x + w1 * b23.x; v[j].w = bfhi(xv[j].y) + w0 * a23.y + w1 * b23.y;
                s += (v[j].x * v[j].x + v[j].y * v[j].y) + (v[j].z * v[j].z + v[j].w * v[j].w);
            }
            const float rstd = rsqrtf(wave_sum(s) * (1.f / 1024.f) + EPS);
            if (last) { f32x4* xr = (f32x4*)(A->out + (size_t)t * D) + lane;
#pragma unroll
                for (int j = 0; j < 4; ++j) xr[64 * j] = v[j]; }
            else { u32x2* xr = (u32x2*)(X16 + (size_t)t * D) + lane;
#pragma unroll
                for (int j = 0; j < 4; ++j) { u32x2 w; w.x = pk2(v[j].x, v[j].y); w.y = pk2(v[j].z, v[j].w); xr[64 * j] = w; } }
            if (!last) {
                unsigned* o4 = (unsigned*)((unsigned char*)XN + (size_t)t * D) + lane;
#pragma unroll
                for (int j = 0; j < 4; ++j) { int w = __builtin_amdgcn_cvt_pk_fp8_f32(v[j].x * rstd, v[j].y * rstd, 0, false); w = __builtin_amdgcn_cvt_pk_fp8_f32(v[j].z * rstd, v[j].w * rstd, w, true); o4[64 * j] = (unsigned)w; }
            }
#pragma unroll
            for (int j = 0; j < 4; ++j) { xv[j] = xn[j]; ya[j] = yan[j]; yb[j] = ybn[j]; }
        }
    }
}

constexpr int PH_PER_EVEN = 5 + 5, PH_PER_ODD = 3 + 5;
constexpr int NPHASES = 1 + 2 * (PH_PER_EVEN + PH_PER_ODD);

__global__ void __launch_bounds__(512, 2) mk_fwd(Args Araw) {
    KArgs A0 = kargs();
    extern __shared__ __attribute__((aligned(16))) unsigned char lds_raw[];
    LAS unsigned char* lds = (LAS unsigned char*)lds_raw;
    volatile LAS unsigned* misc = (volatile LAS unsigned*)(lds + LDS_MISC);
    const int tid = threadIdx.x;
    if (tid < 16) misc[tid] = 0u;
    __syncthreads();
    const int lo = A0->ph_lo, hi = A0->ph_hi;
    const int wv_ = __builtin_amdgcn_readfirstlane(threadIdx.x >> 6);
    if (hi - lo > 1) (void)xcd_barrier_post((unsigned*)(A0->ws + WS_CTL) + CW_BAR, misc);
    int ph = 0;
    unsigned long long tacc_ = 0;
#define PH_BEGIN(k) if (ph >= lo && ph < hi) { const bool tprobe_ = (PROBE_TMASK >> (k)) & 1; unsigned long long tp0_ = 0; if (PROBE_TMASK && tprobe_) tp0_ = __builtin_amdgcn_s_memrealtime(); KArgs A = kargs(); unsigned char* ws = opq(A->ws); _Pragma("unroll 1") for (int rep_ = 0; rep_ < (((PROBE_MASK >> (k)) & 1) ? PROBE_REPS : 1); ++rep_)
#define PH_END   if (ph + 1 < hi) { XcdBarrier b_; b_.bar = (unsigned*)(opq(kargs()->ws) + WS_CTL) + CW_BAR; b_.x = xb_xcc_id(); b_.st = misc; xcd_barrier(b_, opaque_tid(wv_) == 0); } if (PROBE_TMASK && tprobe_) tacc_ += __builtin_amdgcn_s_memrealtime() - tp0_; } ++ph;
    const int G = gridDim.x, cb = blockIdx.x;

    PH_BEGIN(0) phase_prologue(A, wv_, lds); PH_END
    for (int L = 0; L < DEPTH; ++L) {
        const int i = L >> 1;
        if ((L & 1) == 0) {
            PH_BEGIN(3) {
                if (L == 0) {
                    pg8::DenseOrderT<true> S; S.init(NBATCH * NMEM, 8192, D / 2, (const bf16*)(ws + WS_WKV), G, cb);
                    pg8::EpiBf16<0, true> E{(bf16*)(ws + WS_KV), 8192, 32, 0, nullptr, 0, 1.f / 32.f};
                    pg8::gemm_phase(lds, (const bf16*)(ws + WS_MN), D / 2, S, E, wv_);
                }
                pg8::DenseOrderT<true> S; S.init(T, HYN, D / 2, (const bf16*)((const unsigned char*)(ws + WS_WHYB) + (size_t)i * HYN * D), G, cb);
                pg8::EpiBf16<0, true> E{(bf16*)(ws + WS_BIG), HYN, 12, 0, nullptr, 0, 1.f / 32.f};
                pg8::gemm_phase(lds, (const bf16*)(ws + WS_XN), D / 2, S, E, wv_);
            } PH_END
            PH_BEGIN(4) { const int t4_ = opaque_tid(wv_); SUBT_BEGIN(4); SUBT_END(4, ws, t4_); SUBT_BEGIN(5); phase_compress_mfma(A, wv_, i, lds); SUBT_END(5, ws, t4_); SUBT_BEGIN(6); phase_nsa_prep(A, wv_, i, lds); SUBT_END(6, ws, t4_); SUBT_BEGIN(7); phase_vtiles(A, wv_, lds); SUBT_END(7, ws, t4_); } PH_END
            PH_BEGIN(5) { phase_gla_a(A, wv_, i, lds); __syncthreads(); phase_nsa_attn_mfma(A, wv_, i, lds); } PH_END
            PH_BEGIN(6) phase_gla_c(A, wv_, i, lds, L == 0, L); PH_END
            PH_BEGIN(7) {
                pg8::DenseOrderT<true> S; S.init(T, D, D / 2, (const bf16*)((const unsigned char*)(ws + WS_WHOUT) + (size_t)i * D * D), G, cb);
                pg8::EpiResAddNorm E{(bf16*)(ws + WS_X16), D, (float*)(ws + WS_ROWSQ), 1.f / 32.f, ws + WS_XN + 16 * MiB};
                pg8::gemm_phase(lds, (const bf16*)(ws + WS_CAT), D / 2, S, E, wv_);
            } PH_END
        } else {
            PH_BEGIN(8) {
                pg8::DenseOrderT<true> S; S.init(T, 4096, D / 2, (const bf16*)((const unsigned char*)(ws + WS_WSGIN) + (size_t)i * 4096 * D), G, cb);
                pg8::EpiBf16<1, true, true> E{(bf16*)(ws + WS_U), 2048, 8, (size_t)(WS_V - WS_U) / 2, (float*)(ws + WS_VSTAT), 8, 1.f / 32.f};
                pg8::gemm_phase(lds, (const bf16*)(ws + WS_XN), D / 2, S, E, wv_);
            } PH_END
            PH_BEGIN(9) phase_sgu_mix_mfma(A, wv_, i, lds); PH_END
            PH_BEGIN(10) {
                pg8::DenseOrderT<true> S; S.init(T, D, 1024, (const bf16*)((const unsigned char*)(ws + WS_WSGOUT) + (size_t)i * D * 2048), G, cb);
                pg8::EpiResAddNorm E{(bf16*)(ws + WS_X16), D, (float*)(ws + WS_ROWSQ), 1.f / 32.f, ws + WS_XN + 16 * MiB};
                pg8::gemm_phase(lds, (const bf16*)(ws + WS_UM), 1024, S, E, wv_);
            } PH_END
        }
        PH_BEGIN(12) {
            pg8::DenseOrderT<true> S; S.init(T, D, D / 2, (const bf16*)((const unsigned char*)(ws + WS_WQ) + (size_t)L * D * D), G, cb);
            pg8::EpiBf16RowScale E{(bf16*)(ws + WS_QX), D, (const float*)(ws + WS_ROWSQ), 1.f / 32.f};
            pg8::gemm_phase(lds, (const bf16*)(ws + WS_XN + 16 * MiB), D / 2, S, E, wv_);
            asm volatile("s_waitcnt vmcnt(0)" ::: "memory");
            __syncthreads();
            pg8::Unit u_;
#pragma unroll 1
            for (int ui_ = 0; S.next(ui_, u_); ++ui_) xattn_item(A, wv_, L, lds, u_.pm >> 3, u_.pn, u_.pm & 7);
        } PH_END
        PH_BEGIN(14) {
            pg8::DenseOrderT<true> S; S.init(T, D, D / 2, (const bf16*)((const unsigned char*)(ws + WS_WO) + (size_t)L * D * D), G, cb);
            pg8::EpiResAdd E{(bf16*)(ws + WS_X16), D, 1.f / 32.f};
            pg8::gemm_phase(lds, (const bf16*)(ws + WS_OX), D / 2, S, E, wv_);
        } PH_END
        PH_BEGIN(15) phase_route_mfma(A, wv_, L, lds); PH_END
        PH_BEGIN(16) {
            LAS int* off = (LAS int*)(lds + pg8::STAGE_BYTES); LAS int* cn = off + 32;
            moe_offsets(A, wv_, L, off, cn);
            unsigned* rdy = (unsigned*)(ws + WS_CTL) + CW_RDY + L * 256;
            {
                pg8::MoeOrder<true, 1, true> S{(off[16] / 256) * 3, 3, G, cb, D / 2, off, cn, (const int*)(ws + WS_LIST), (const char*)(ws + WS_WMIN) + (size_t)L * 16 * 768 * D, (size_t)768 * D, rdy, 3u};
                pg8::EpiSwiglu<true> E{(bf16*)(ws + WS_H), DEXP, (unsigned)(WS_H_BYTES), 1.f / 32.f};
                pg8::gemm_phase(lds, (const bf16*)(ws + WS_XN), D / 2, S, E, wv_);
            }
            {
                pg8::MoeOrder<false, 2> S{(off[16] / 256) * 4, 4, G, G - 1 - cb, DEXP, off, cn, (const int*)(ws + WS_LIST), (const char*)(ws + WS_WMOUT) + (size_t)L * 16 * D * DEXP * 2, (size_t)D * DEXP * 2, rdy, 3u};
                pg8::EpiBf16<0, true, true> E{(bf16*)(ws + WS_Y), D, 4, 0, nullptr, 0, 8.f};
                pg8::gemm_phase(lds, (const bf16*)(ws + WS_H), DEXP, S, E, wv_);
            }
        } PH_END
        PH_BEGIN(18) phase_moe_combine(A, wv_, L, lds); PH_END
    }
#undef PH_BEGIN
#undef PH_END
    if (hi - lo > 1) { for (int q_ = 0; q_ < PROBE_XBAR; ++q_) { XcdBarrier b_; b_.bar = (unsigned*)(opq(kargs()->ws) + WS_CTL) + CW_BAR; b_.x = xb_xcc_id(); b_.st = misc; xcd_barrier(b_, opaque_tid(wv_) == 0); } }
    if ((PROBE_NSA || PROBE_SUB) && blockIdx.x == 0) { const unsigned long long d_ = __hip_atomic_load((unsigned long long*)(A0->ws + WS_CTL + 48000), __ATOMIC_RELAXED, __HIP_MEMORY_SCOPE_AGENT); const unsigned long long t0 = __builtin_amdgcn_s_memrealtime(); while (__builtin_amdgcn_s_memrealtime() - t0 < d_) __builtin_amdgcn_s_sleep(8); }
    if (PROBE_TMASK && blockIdx.x == 0) { const unsigned long long t0 = __builtin_amdgcn_s_memrealtime(); while (__builtin_amdgcn_s_memrealtime() - t0 < tacc_) __builtin_amdgcn_s_sleep(8); }
}

extern "C" void kernel_launch(void* const* d_in, const int* in_sizes, int n_in, void* d_out, int out_size, void* d_ws, size_t ws_size, hipStream_t stream) {
    static int grid = 0;
    if (grid == 0) {
        if (n_in != N_IN || out_size != T * D || ws_size < WS_END) { fprintf(stderr, "kernel_launch: unexpected problem (n_in %d, out %d, ws %zu)\n", n_in, out_size, ws_size); grid = -1; return; }
        int dev = 0, cus = 0, per_cu = 0;
        if (hipGetDevice(&dev) != hipSuccess || hipDeviceGetAttribute(&cus, hipDeviceAttributeMultiprocessorCount, dev) != hipSuccess) { grid = -1; return; }
        if (hipFuncSetAttribute((const void*)mk_fwd, hipFuncAttributeMaxDynamicSharedMemorySize, LDS_BYTES) != hipSuccess) { fprintf(stderr, "kernel_launch: hipFuncSetAttribute failed\n"); grid = -1; return; }
        if (hipOccupancyMaxActiveBlocksPerMultiprocessor(&per_cu, (const void*)mk_fwd, 512, LDS_BYTES) != hipSuccess || per_cu < 1) fprintf(stderr, "kernel_launch: occupancy query says %d\n", per_cu);
        (void)hipGetLastError();
        grid = cus;
    }
    if (grid < 0) return;
    (void)hipMemsetAsync((char*)d_ws + WS_CTL, 0, CTL_BYTES, stream);
    Args a{};
    for (int i = 0; i < N_IN; ++i) a.in[i] = (const float*)d_in[i];
    a.out = (float*)d_out; a.ws = (unsigned char*)d_ws;
    for (int j = 0; j < 32; ++j) a.freq[j] = (float)pow(10000.0, -(double)j / 32.0);
#if MK_ONE_LAUNCH
    a.ph_lo = 0; a.ph_hi = NPHASES;
    hipLaunchKernelGGL(mk_fwd, dim3(grid), dim3(512), LDS_BYTES, stream, a);
#else
    for (int p = 0; p < NPHASES; ++p) { a.ph_lo = p; a.ph_hi = p + 1; hipLaunchKernelGGL(mk_fwd, dim3(grid), dim3(512), LDS_BYTES, stream, a); }
#endif
}
```
